# Optimizing an MI355X kernel written in HIP

```python
import jax, jax.numpy as jnp
from jax import lax
import numpy as np

D_MODEL = 1024
BATCH = 2
SEQ = 8192
DEPTH = 1

CHUNK = 64
MEM_LEN = 256
EPS = 1e-6
CONV_W = 4

GDN_HEADS = 4
GDN_DK = 128
GDN_DV = 128
GDN_QK = GDN_HEADS * GDN_DK
GDN_VD = GDN_HEADS * GDN_DV
LRU_DIM = D_MODEL // 2
LRU_BLOCKS = 8
LRU_BW = LRU_DIM // LRU_BLOCKS
LRU_C = 8.0
MIX_DIM = GDN_VD + LRU_DIM
IN_SPLITS = (3 * GDN_QK, GDN_VD, GDN_HEADS, GDN_HEADS, LRU_DIM, LRU_DIM)
IN_COLS = 3 * GDN_QK + GDN_VD + 2 * GDN_HEADS + 2 * LRU_DIM

XA_HEADS = 4
XA_DH = D_MODEL // XA_HEADS

PEER_HEADS = 8
PEER_NKEYS = 128
PEER_N = PEER_NKEYS * PEER_NKEYS
PEER_DQ = 256
PEER_DH = PEER_DQ // 2
PEER_TOPK = 16
PEER_BLOCK = 128

kernel_name = 'hybrid_gdn_rglru_peer_block'


def rmsnorm(x, w):
    xf = x.astype(jnp.float32)
    y = xf * lax.rsqrt(jnp.mean(xf * xf, axis=-1, keepdims=True) + EPS)
    return (y * w.astype(jnp.float32)).astype(x.dtype)


def l2norm(x):
    return x * lax.rsqrt(jnp.sum(x * x, axis=-1, keepdims=True) + EPS)


def causal_dwconv(x, w, b=None):
    s = x.shape[1]
    xp = jnp.pad(x, ((0, 0), (CONV_W - 1, 0), (0, 0)))
    y = sum(xp[:, j:j + s] * w[j] for j in range(CONV_W))
    return y if b is None else y + b


def gated_delta_rule(q, k, v, g, beta):
    bsz, s, h, dk = q.shape
    dv = v.shape[-1]
    n = s // CHUNK
    f32 = jnp.float32
    q = l2norm(q.astype(f32)) * (dk ** -0.5)
    k = l2norm(k.astype(f32))
    v = v.astype(f32)

    def chunks(t):
        return t.reshape(bsz, n, CHUNK, h, -1).transpose(0, 3, 1, 2, 4)

    qc, kc, vc = chunks(q), chunks(k), chunks(v)
    gc = g.astype(f32).reshape(bsz, n, CHUNK, h).transpose(0, 3, 1, 2)
    bc = beta.astype(f32).reshape(bsz, n, CHUNK, h).transpose(0, 3, 1, 2)
    gcum = jnp.cumsum(gc, axis=-1)
    pos = jnp.arange(CHUNK)
    causal = pos[:, None] >= pos[None, :]
    strict = pos[:, None] > pos[None, :]
    decay = jnp.exp(jnp.where(causal, gcum[..., :, None] - gcum[..., None, :], -jnp.inf))
    kb = kc * bc[..., None]
    vb = vc * bc[..., None]
    a_mat = jnp.where(strict, jnp.einsum('bhncd,bhnsd->bhncs', kb, kc) * decay, 0.0)
    t_mat = a_mat + jnp.eye(CHUNK, dtype=f32)
    rhs = jnp.concatenate([vb, kb * jnp.exp(gcum)[..., None]], axis=-1)
    sol = lax.linalg.triangular_solve(t_mat, rhs, left_side=True, lower=True, unit_diagonal=True)
    u, w = sol[..., :dv], sol[..., dv:]
    attn = jnp.where(causal, jnp.einsum('bhncd,bhnsd->bhncs', qc, kc) * decay, 0.0)
    q_dec = qc * jnp.exp(gcum)[..., None]
    k_dec = kc * jnp.exp(gcum[..., -1:] - gcum)[..., None]
    chunk_decay = jnp.exp(gcum[..., -1])

    def step(state, xs):
        q_i, w_i, u_i, a_i, k_i, d_i = xs
        v_new = u_i - jnp.einsum('bhcd,bhdv->bhcv', w_i, state)
        o = jnp.einsum('bhcd,bhdv->bhcv', q_i, state) + jnp.einsum('bhcs,bhsv->bhcv', a_i, v_new)
        state = state * d_i[..., None, None] + jnp.einsum('bhcd,bhcv->bhdv', k_i, v_new)
        return state, o

    xs = tuple(jnp.moveaxis(t, 2, 0) for t in (q_dec, w, u, attn, k_dec, chunk_decay))
    state0 = jnp.zeros((bsz, h, dk, dv), f32)
    _, o = lax.scan(step, state0, xs)
    return o.transpose(1, 0, 3, 2, 4).reshape(bsz, s, h, dv)


def rg_lru(xr, w_a, b_a, w_x, b_x, lam):
    bsz, s, c = xr.shape
    f32 = jnp.float32
    xf = xr.astype(f32)
    xb = xf.reshape(bsz, s, LRU_BLOCKS, LRU_BW)
    r = jax.nn.sigmoid(jnp.einsum('bsgi,gij->bsgj', xb, w_a.astype(f32)).reshape(bsz, s, c) + b_a.astype(f32))
    i = jax.nn.sigmoid(jnp.einsum('bsgi,gij->bsgj', xb, w_x.astype(f32)).reshape(bsz, s, c) + b_x.astype(f32))
    log_a = -LRU_C * r * jax.nn.softplus(-lam.astype(f32))
    a = jnp.exp(log_a)
    b_term = jnp.sqrt(-jnp.expm1(2.0 * log_a)) * (i * xf)

    def combine(c1, c2):
        a1, b1 = c1
        a2, b2 = c2
        return a1 * a2, a2 * b1 + b2

    _, hs = lax.associative_scan(combine, (a, b_term), axis=1)
    return hs


def hybrid_mixer(h, w_in, conv_qkv_w, gdn_a_log, gdn_dt_bias, gdn_norm_w,
                 lru_conv_w, lru_conv_b, lru_wa, lru_ba, lru_wx, lru_bx, lru_lambda, w_out):
    bsz, s, _ = h.shape
    f32 = jnp.float32
    proj = h @ w_in
    offs = np.cumsum(IN_SPLITS)[:-1].tolist()
    qkv, z, a_in, b_in, xr, gate = jnp.split(proj, offs, axis=-1)
    qkv = jax.nn.silu(causal_dwconv(qkv, conv_qkv_w))
    q, k, v = jnp.split(qkv, [GDN_QK, 2 * GDN_QK], axis=-1)
    g = -jnp.exp(gdn_a_log.astype(f32)) * jax.nn.softplus(a_in.astype(f32) + gdn_dt_bias.astype(f32))
    beta = jax.nn.sigmoid(b_in.astype(f32))
    o = gated_delta_rule(q.reshape(bsz, s, GDN_HEADS, GDN_DK), k.reshape(bsz, s, GDN_HEADS, GDN_DK),
                         v.reshape(bsz, s, GDN_HEADS, GDN_DV), g, beta)
    o = rmsnorm(o, gdn_norm_w) * jax.nn.silu(z.reshape(bsz, s, GDN_HEADS, GDN_DV).astype(f32))
    y_gdn = o.reshape(bsz, s, GDN_VD).astype(h.dtype)
    xr = causal_dwconv(xr, lru_conv_w, lru_conv_b)
    y_lru = (rg_lru(xr, lru_wa, lru_ba, lru_wx, lru_bx, lru_lambda) * jax.nn.gelu(gate.astype(f32))).astype(h.dtype)
    return jnp.concatenate([y_gdn, y_lru], axis=-1) @ w_out


def memory_cross_attention(h, mem_n, wq, wkv, wo):
    bsz, s, _ = h.shape
    m = mem_n.shape[1]
    f32 = jnp.float32
    q = (h @ wq).reshape(bsz, s, XA_HEADS, XA_DH)
    kv = (mem_n @ wkv).reshape(bsz, m, 2, XA_HEADS, XA_DH)
    k, v = kv[:, :, 0], kv[:, :, 1]
    scores = jnp.einsum('bshd,bmhd->bhsm', q.astype(f32), k.astype(f32)) * (XA_DH ** -0.5)
    p = jax.nn.softmax(scores, axis=-1)
    o = jnp.einsum('bhsm,bmhd->bshd', p, v.astype(f32)).reshape(bsz, s, XA_HEADS * XA_DH).astype(h.dtype)
    return o @ wo


def peer_ffn(h, wq, subkeys, u_tab, v_tab):
    bsz, s, d = h.shape
    t = h.reshape(bsz * s, d)
    ntok = t.shape[0]
    f32 = jnp.float32
    q = (t @ wq).reshape(ntok, PEER_HEADS, 2, PEER_DH).astype(f32)
    sc = jnp.einsum('thpd,hpkd->thpk', q, subkeys.astype(f32))
    s1, i1 = lax.top_k(sc[:, :, 0], PEER_TOPK)
    s2, i2 = lax.top_k(sc[:, :, 1], PEER_TOPK)
    cand = (s1[..., :, None] + s2[..., None, :]).reshape(ntok, PEER_HEADS, PEER_TOPK * PEER_TOPK)
    best, pos = lax.top_k(cand, PEER_TOPK)
    e1 = jnp.take_along_axis(i1, pos // PEER_TOPK, axis=-1)
    e2 = jnp.take_along_axis(i2, pos % PEER_TOPK, axis=-1)
    idx = e1 * PEER_NKEYS + e2
    gate = jax.nn.softmax(best, axis=-1).astype(h.dtype)
    nb = ntok // PEER_BLOCK

    def block(args):
        tb, ib, gb = args
        act = jax.nn.gelu(jnp.einsum('phkd,pd->phk', u_tab[ib], tb)) * gb
        return jnp.einsum('phk,phkd->pd', act, v_tab[ib])

    out = lax.map(block, (t.reshape(nb, PEER_BLOCK, d),
                          idx.reshape(nb, PEER_BLOCK, PEER_HEADS, PEER_TOPK),
                          gate.reshape(nb, PEER_BLOCK, PEER_HEADS, PEER_TOPK)))
    return out.reshape(bsz, s, d)


def setup_inputs(seed: int = 0) -> dict:
    key = jax.random.key(seed)
    ks = jax.random.split(key, 32)
    f32 = jnp.float32
    L = DEPTH

    def nrm(k, shape, scale):
        return jax.random.normal(k, shape, f32) * scale

    def gain(k, shape):
        return 1.0 + 0.05 * jax.random.normal(k, shape, f32)

    x = nrm(ks[0], (BATCH, SEQ, D_MODEL), 1.0)
    mem = nrm(ks[1], (BATCH, MEM_LEN, D_MODEL), 1.0)
    norm_mix_w = gain(ks[2], (L, D_MODEL))
    w_in = nrm(ks[3], (L, D_MODEL, IN_COLS), D_MODEL ** -0.5)
    conv_qkv_w = nrm(ks[4], (L, CONV_W, 3 * GDN_QK), 0.5)
    gdn_a_log = jnp.log(jax.random.uniform(ks[5], (L, GDN_HEADS), f32, 1.0, 16.0))
    dt = jnp.exp(jax.random.uniform(ks[6], (L, GDN_HEADS), f32, np.log(1e-3), np.log(1e-1)))
    gdn_dt_bias = dt + jnp.log(-jnp.expm1(-dt))
    gdn_norm_w = gain(ks[7], (L, GDN_DV))
    lru_conv_w = nrm(ks[8], (L, CONV_W, LRU_DIM), 0.5)
    lru_conv_b = nrm(ks[9], (L, LRU_DIM), 0.01)
    lru_wa = nrm(ks[10], (L, LRU_BLOCKS, LRU_BW, LRU_BW), LRU_BW ** -0.5)
    lru_ba = nrm(ks[11], (L, LRU_DIM), 0.01)
    lru_wx = nrm(ks[12], (L, LRU_BLOCKS, LRU_BW, LRU_BW), LRU_BW ** -0.5)
    lru_bx = nrm(ks[13], (L, LRU_DIM), 0.01)
    a0 = jax.random.uniform(ks[14], (L, LRU_DIM), f32, 0.9, 0.999)
    a_base = a0 ** (1.0 / LRU_C)
    lru_lambda = jnp.log(a_base) - jnp.log1p(-a_base)
    w_out = nrm(ks[15], (L, MIX_DIM, D_MODEL), MIX_DIM ** -0.5)
    norm_xattn_w = gain(ks[16], (L, D_MODEL))
    norm_mem_w = gain(ks[17], (L, D_MODEL))
    xattn_wq = nrm(ks[18], (L, D_MODEL, XA_HEADS * XA_DH), D_MODEL ** -0.5)
    xattn_wkv = nrm(ks[19], (L, D_MODEL, 2 * XA_HEADS * XA_DH), D_MODEL ** -0.5)
    xattn_wo = nrm(ks[20], (L, XA_HEADS * XA_DH, D_MODEL), (XA_HEADS * XA_DH) ** -0.5)
    norm_ffn_w = gain(ks[21], (L, D_MODEL))
    peer_wq = nrm(ks[22], (L, D_MODEL, PEER_HEADS * PEER_DQ), D_MODEL ** -0.5)
    peer_subkeys = nrm(ks[23], (L, PEER_HEADS, 2, PEER_NKEYS, PEER_DH), PEER_DH ** -0.5)
    peer_u = nrm(ks[24], (L, PEER_N, D_MODEL), D_MODEL ** -0.5)
    peer_v = nrm(ks[25], (L, PEER_N, D_MODEL), PEER_HEADS ** -0.5)
    norm_final_w = gain(ks[26], (D_MODEL,))
    return {'x': x, 'mem': mem, 'norm_mix_w': norm_mix_w, 'w_in': w_in, 'conv_qkv_w': conv_qkv_w,
            'gdn_a_log': gdn_a_log, 'gdn_dt_bias': gdn_dt_bias, 'gdn_norm_w': gdn_norm_w,
            'lru_conv_w': lru_conv_w, 'lru_conv_b': lru_conv_b, 'lru_wa': lru_wa, 'lru_ba': lru_ba,
            'lru_wx': lru_wx, 'lru_bx': lru_bx, 'lru_lambda': lru_lambda, 'w_out': w_out,
            'norm_xattn_w': norm_xattn_w, 'norm_mem_w': norm_mem_w, 'xattn_wq': xattn_wq,
            'xattn_wkv': xattn_wkv, 'xattn_wo': xattn_wo, 'norm_ffn_w': norm_ffn_w,
            'peer_wq': peer_wq, 'peer_subkeys': peer_subkeys, 'peer_u': peer_u, 'peer_v': peer_v,
            'norm_final_w': norm_final_w}


def reference(x, mem, norm_mix_w, w_in, conv_qkv_w, gdn_a_log, gdn_dt_bias, gdn_norm_w,
              lru_conv_w, lru_conv_b, lru_wa, lru_ba, lru_wx, lru_bx, lru_lambda, w_out,
              norm_xattn_w, norm_mem_w, xattn_wq, xattn_wkv, xattn_wo, norm_ffn_w,
              peer_wq, peer_subkeys, peer_u, peer_v, norm_final_w):
    for l in range(DEPTH):
        x = x + hybrid_mixer(rmsnorm(x, norm_mix_w[l]), w_in[l], conv_qkv_w[l], gdn_a_log[l],
                             gdn_dt_bias[l], gdn_norm_w[l], lru_conv_w[l], lru_conv_b[l],
                             lru_wa[l], lru_ba[l], lru_wx[l], lru_bx[l], lru_lambda[l], w_out[l])
        x = x + memory_cross_attention(rmsnorm(x, norm_xattn_w[l]), rmsnorm(mem, norm_mem_w[l]),
                                       xattn_wq[l], xattn_wkv[l], xattn_wo[l])
        x = x + peer_ffn(rmsnorm(x, norm_ffn_w[l]), peer_wq[l], peer_subkeys[l], peer_u[l], peer_v[l])
    return rmsnorm(x, norm_final_w)
```

```cpp
#include <hip/hip_runtime.h>
#include <cstdio>
#include <cstdint>
namespace pg8 {
#define PG8_LAS __attribute__((address_space(3)))
typedef unsigned short bf16_t;
typedef short bf16x8 __attribute__((ext_vector_type(8)));
typedef float f32x4 __attribute__((ext_vector_type(4)));
typedef unsigned u32x4 __attribute__((ext_vector_type(4)));
constexpr int BM = 256, BK = 64, HALF = 128, HTB = HALF * BK * 2  , STAGE_BYTES = 8 * HTB, NXCD = 8, WGM = 8;

__host__ __device__ __forceinline__ int lds_byte(int r, int c) { const int st = (r >> 4) * 2 + (c >> 5), rr = r & 15, cc = c & 31, ob = rr * 64 + cc * 2; return st * 1024 + (ob ^ (((ob >> 9) & 1) << 5)); }
__host__ __device__ __forceinline__ void stage_rc(int b, int& R, int& C) { const int st = b / 1024, sb = b % 1024, swz = sb ^ (((sb >> 9) & 1) << 5); R = (st >> 1) * 16 + swz / 64; C = (st & 1) * 32 + (swz % 64) / 2; }
__host__ __device__ __forceinline__ int perm32(int rho) { const int n = rho >> 4, i = rho & 15; return 8 * (i >> 2) + 4 * n + (i & 3); }

struct Unit { int pm, pn; };
struct Gemm { const bf16_t* A; const bf16_t* Bt; int M, N, K; };

struct StaticOrder {
    int nM, nN, nwg, G, c;
    __host__ __device__ void init(int M, int N, int G_, int c_) { nM = M / BM; nN = N / BM; nwg = nM * nN; G = G_; c = c_; }
    __host__ __device__ bool next(int i, Unit& u) const {
        const long L = (long)i * G + c; if (L >= nwg) return false;
        int wgid = (int)L; { const int q = nwg / NXCD, r = nwg % NXCD, xcd = wgid % NXCD, off = wgid / NXCD; wgid = (xcd < r ? xcd * (q + 1) : r * (q + 1) + (xcd - r) * q) + off; }
        const int nig = WGM * nN, gid = wgid / nig, fm = gid * WGM, gsz = (nM - fm) < WGM ? (nM - fm) : WGM;
        u.pm = fm + ((wgid % nig) % gsz); u.pn = (wgid % nig) / gsz; return true;
    }
    __device__ __forceinline__ void a_ready(const Unit&) const {}
    __device__ __forceinline__ void done(const Unit&) const {}
};

__device__ __forceinline__ unsigned cvt_pk_bf16(float lo, float hi) { unsigned r; asm volatile("v_cvt_pk_bf16_f32 %0, %1, %2" : "=v"(r) : "v"(lo), "v"(hi)); return r; }
template <class Epi, class Sched, bool ALIGN_EPI = false, bool SP2 = false>
__device__ __forceinline__ void gemm_phase(PG8_LAS unsigned char* lds, const Gemm g, const Sched& S, const Epi& E) {
    const int tid = threadIdx.x, wid = __builtin_amdgcn_readfirstlane(tid >> 6), lane = tid & 63, wr = wid >> 2, wc = wid & 3, fr = lane & 15, fq = lane >> 4;
    const int K = g.K, nt = K / BK;
    unsigned voffA[2], voffB[2];
#pragma unroll
    for (int i = 0; i < 2; ++i) { int R, C; stage_rc(tid * 16 + i * 8192, R, C); const int Rb = Epi::PERM ? ((R & ~31) + perm32(R & 31)) : R;
        voffA[i] = (unsigned)(R * K + C) * 2u; voffB[i] = (unsigned)(Rb * K + C) * 2u; }
    const size_t kstep = (size_t)(BK * 2);
    const size_t hstep = (size_t)HALF * K * 2;
    const size_t tstep = 2 * hstep;
    const unsigned ldsw = (unsigned)wid * 1024u;
    const int aoff = lds_byte(wr * 64 + fr, fq * 8), boff = lds_byte(wc * 32 + fr, fq * 8);
#define PG8_SA(b, h) (((b) * 2 + (h)) * HTB)
#define PG8_SB(b, h) ((4 + (b) * 2 + (h)) * HTB)
#define PG8_STAGE(bufoff, gbase, voff) do { _Pragma("unroll") for (int _i = 0; _i < 2; ++_i) \
        __builtin_amdgcn_global_load_lds((const unsigned*)((const char*)(gbase) + (voff)[_i]), (PG8_LAS unsigned*)(lds + (bufoff) + ldsw + _i * 8192), 16, 0, 0); } while (0)
#define PG8_LDA(dst, b, h) do { _Pragma("unroll") for (int m = 0; m < 4; ++m) _Pragma("unroll") for (int k = 0; k < 2; ++k) dst[m][k] = *(const PG8_LAS bf16x8*)(lds + PG8_SA(b, h) + aoff + m * 2048 + k * 1024); } while (0)
#define PG8_LDB(dst, b, h) do { _Pragma("unroll") for (int n = 0; n < 2; ++n) _Pragma("unroll") for (int k = 0; k < 2; ++k) dst[n][k] = *(const PG8_LAS bf16x8*)(lds + PG8_SB(b, h) + boff + n * 2048 + k * 1024); } while (0)
#define PG8_MMA(ai, bj, At, Bt) do { __builtin_amdgcn_s_setprio(1); _Pragma("unroll") for (int m = 0; m < 4; ++m) _Pragma("unroll") for (int n = 0; n < 2; ++n) _Pragma("unroll") for (int k = 0; k < 2; ++k) \
        acc[ai][bj][m][n] = __builtin_amdgcn_mfma_f32_16x16x32_bf16(Bt[n][k], At[m][k], acc[ai][bj][m][n], 0, 0, 0); __builtin_amdgcn_s_setprio(0); } while (0)
#define PG8_WAIT_V(n) asm volatile("s_waitcnt vmcnt(" #n ")" ::: "memory")
#define PG8_WAIT_L(n) asm volatile("s_waitcnt lgkmcnt(" #n ")" ::: "memory")
#define PG8_BAR __builtin_amdgcn_s_barrier()
#define PG8_SCHED __builtin_amdgcn_sched_barrier(0)
    Unit cur, nxt; int ui = 0;
    if (!S.next(0, cur)) return;
    f32x4 acc[2][2][4][2];
#pragma unroll
    for (int a = 0; a < 2; ++a)
#pragma unroll
        for (int b = 0; b < 2; ++b)
#pragma unroll
            for (int m = 0; m < 4; ++m)
#pragma unroll
                for (int n = 0; n < 2; ++n) acc[a][b][m][n] = (f32x4){0.f, 0.f, 0.f, 0.f};
    bf16x8 At[4][2], B0[2][2], B1[2][2];
    const char* cA = (const char*)g.A + (size_t)cur.pm * tstep; const char* cB = (const char*)g.Bt + (size_t)cur.pn * tstep;
    S.a_ready(cur);
    if constexpr (SP2) {
        PG8_STAGE(PG8_SB(0, 0), cB, voffB); PG8_STAGE(PG8_SB(0, 1), cB + hstep, voffB); PG8_STAGE(PG8_SA(0, 0), cA, voffA); PG8_STAGE(PG8_SA(0, 1), cA + hstep, voffA);
        if (wr == 1) PG8_BAR;
        PG8_WAIT_V(2); PG8_BAR;
        PG8_STAGE(PG8_SB(1, 0), cB + kstep, voffB); PG8_STAGE(PG8_SA(1, 0), cA + kstep, voffA); PG8_STAGE(PG8_SB(1, 1), cB + hstep + kstep, voffB);
        PG8_WAIT_V(6); PG8_BAR;
    } else {
        PG8_STAGE(PG8_SB(0, 0), cB, voffB); PG8_STAGE(PG8_SA(0, 0), cA, voffA); PG8_STAGE(PG8_SB(0, 1), cB + hstep, voffB); PG8_STAGE(PG8_SA(0, 1), cA + hstep, voffA);
        if (wr == 1) PG8_BAR;
        PG8_WAIT_V(4); PG8_BAR;
        PG8_STAGE(PG8_SB(1, 0), cB + kstep, voffB); PG8_STAGE(PG8_SA(1, 0), cA + kstep, voffA); PG8_STAGE(PG8_SB(1, 1), cB + hstep + kstep, voffB);
        PG8_WAIT_V(6); PG8_BAR;
    }
    for (;;) {
        const bool has_next = S.next(ui + 1, nxt);
        const char* nA = has_next ? (const char*)g.A + (size_t)nxt.pm * tstep : cA; const char* nB = has_next ? (const char*)g.Bt + (size_t)nxt.pn * tstep : cB;
        for (int t = 0; t < nt; t += 2) {
            const bool last = (t == nt - 2);
            const char* a1 = cA + (size_t)(t + 1) * kstep;
            const char* a2 = last ? nA : cA + (size_t)(t + 2) * kstep; const char* b2 = last ? nB : cB + (size_t)(t + 2) * kstep;
            const char* a3 = a2 + kstep; const char* b3 = b2 + kstep;
            if (last && has_next) S.a_ready(nxt);
            if constexpr (SP2) {
            PG8_LDB(B0, 0, 0); PG8_LDB(B1, 0, 1); PG8_SCHED; PG8_LDA(At, 0, 0); PG8_STAGE(PG8_SA(1, 1), a1 + hstep, voffA);
            PG8_WAIT_V(8); PG8_WAIT_L(0); PG8_BAR; PG8_MMA(0, 0, At, B0); PG8_MMA(0, 1, At, B1); PG8_BAR; PG8_SCHED;
            PG8_LDA(At, 0, 1); PG8_STAGE(PG8_SB(0, 0), b2, voffB); PG8_STAGE(PG8_SB(0, 1), b2 + hstep, voffB); PG8_STAGE(PG8_SA(0, 0), a2, voffA);
            PG8_WAIT_V(8); PG8_WAIT_L(0); PG8_BAR; PG8_MMA(1, 0, At, B0); PG8_MMA(1, 1, At, B1); PG8_BAR; PG8_SCHED;
            PG8_LDB(B0, 1, 0); PG8_LDB(B1, 1, 1); PG8_SCHED; PG8_LDA(At, 1, 0); PG8_STAGE(PG8_SA(0, 1), a2 + hstep, voffA);
            PG8_WAIT_V(8); PG8_WAIT_L(0); PG8_BAR; PG8_MMA(0, 0, At, B0); PG8_MMA(0, 1, At, B1); PG8_BAR; PG8_SCHED;
            PG8_LDA(At, 1, 1); PG8_STAGE(PG8_SB(1, 0), b3, voffB); PG8_STAGE(PG8_SB(1, 1), b3 + hstep, voffB); PG8_STAGE(PG8_SA(1, 0), a3, voffA);
            PG8_WAIT_V(8); PG8_WAIT_L(0); PG8_BAR; PG8_MMA(1, 0, At, B0); PG8_MMA(1, 1, At, B1); PG8_BAR; PG8_SCHED;
            } else {
            PG8_LDB(B0, 0, 0); PG8_SCHED; PG8_LDA(At, 0, 0); PG8_STAGE(PG8_SA(1, 1), a1 + hstep, voffA);
            PG8_WAIT_L(8); PG8_BAR; PG8_WAIT_L(0); PG8_MMA(0, 0, At, B0); PG8_BAR; PG8_SCHED;
            PG8_LDB(B1, 0, 1); PG8_STAGE(PG8_SB(0, 0), b2, voffB);
            PG8_BAR; PG8_WAIT_L(0); PG8_MMA(0, 1, At, B1); PG8_BAR;
            PG8_LDA(At, 0, 1); PG8_STAGE(PG8_SA(0, 0), a2, voffA);
            PG8_BAR; PG8_WAIT_L(0); PG8_MMA(1, 0, At, B0); PG8_BAR; PG8_SCHED;
            PG8_STAGE(PG8_SB(0, 1), b2 + hstep, voffB);
            PG8_WAIT_V(6); PG8_BAR; PG8_MMA(1, 1, At, B1); PG8_BAR;
            PG8_LDB(B0, 1, 0); PG8_SCHED; PG8_LDA(At, 1, 0); PG8_STAGE(PG8_SA(0, 1), a2 + hstep, voffA);
            PG8_WAIT_L(8); PG8_BAR; PG8_WAIT_L(0); PG8_MMA(0, 0, At, B0); PG8_BAR; PG8_SCHED;
            PG8_LDB(B1, 1, 1); PG8_STAGE(PG8_SB(1, 0), b3, voffB);
            PG8_BAR; PG8_WAIT_L(0); PG8_MMA(0, 1, At, B1); PG8_BAR;
            PG8_LDA(At, 1, 1); PG8_STAGE(PG8_SA(1, 0), a3, voffA);
            PG8_BAR; PG8_WAIT_L(0); PG8_MMA(1, 0, At, B0); PG8_BAR; PG8_SCHED;
            PG8_STAGE(PG8_SB(1, 1), b3 + hstep, voffB);
            PG8_WAIT_V(6); PG8_BAR; PG8_MMA(1, 1, At, B1); PG8_BAR;
            }
        }
        if constexpr (ALIGN_EPI) { if (wr == 0) PG8_BAR; }
        if constexpr (!Epi::AFTER_DRAIN) { E(acc, cur, wr, wc, fr, fq); S.done(cur); }
        if (!has_next) break;
#pragma unroll
        for (int a = 0; a < 2; ++a)
#pragma unroll
            for (int b = 0; b < 2; ++b)
#pragma unroll
                for (int m = 0; m < 4; ++m)
#pragma unroll
                    for (int n = 0; n < 2; ++n) acc[a][b][m][n] = (f32x4){0.f, 0.f, 0.f, 0.f};
        cur = nxt; cA = nA; cB = nB; ++ui;
        if constexpr (ALIGN_EPI) { if (wr == 1) PG8_BAR; }
    }
    PG8_WAIT_V(0);
    if constexpr (!ALIGN_EPI) { if (wr == 0) PG8_BAR; }
    PG8_BAR;
    if constexpr (Epi::AFTER_DRAIN) { E.fused(acc, cur, wr, wc, fr, fq, lds, wid, lane); S.done(cur); }
#undef PG8_SA
#undef PG8_SB
#undef PG8_STAGE
#undef PG8_LDA
#undef PG8_LDB
#undef PG8_MMA
#undef PG8_WAIT_V
#undef PG8_WAIT_L
#undef PG8_BAR
#undef PG8_SCHED
}
}

namespace pg8 {
__host__ __device__ __forceinline__ int permk(int kl) { return 8 * ((kl & 15) >> 2) + 4 * (kl >> 4) + (kl & 3); }
struct EpiBf16Rs {
    static constexpr bool PERM = true, AFTER_DRAIN = false;
    bf16_t* O0; int ld0; int ntile0; bf16_t* O1; int ld1; size_t stride1; const float* ssq; float cs;
    __device__ __forceinline__ void operator()(const f32x4 (&acc)[2][2][4][2], const Unit& u, int wr, int wc, int fr, int fq) const {
        bf16_t* base; int ld, colt;
        if (u.pn < ntile0) { base = O0; ld = ld0; colt = u.pn * BM; }
        else { const int q = u.pn - ntile0, per = ld1 / BM; base = O1 + (size_t)(q / per) * stride1; ld = ld1; colt = (q % per) * BM; }
        const int row0 = u.pm * BM + wr * 64 + fr, col0 = colt + wc * 32 + 8 * fq;
#pragma unroll
        for (int ai = 0; ai < 2; ++ai)
#pragma unroll
            for (int m = 0; m < 4; ++m) {
                const int row = row0 + ai * HALF + m * 16;
                float sc = cs; if (ssq) sc *= rsqrtf(ssq[row] * (1.0f / 1024.0f) + 1e-6f);
                bf16_t* rowp = base + (size_t)row * ld + col0;
#pragma unroll
                for (int bj = 0; bj < 2; ++bj) { const f32x4 v0 = acc[ai][bj][m][0] * sc, v1 = acc[ai][bj][m][1] * sc;
                    u32x4 w; w.x = cvt_pk_bf16(v0[0], v0[1]); w.y = cvt_pk_bf16(v0[2], v0[3]); w.z = cvt_pk_bf16(v1[0], v1[1]); w.w = cvt_pk_bf16(v1[2], v1[3]);
                    *(u32x4*)(rowp + bj * HALF) = w; } }
    }
};
struct EpiResid {
    static constexpr bool PERM = false, AFTER_DRAIN = false;
    const float* base; float* out; bf16_t* xb; float* ssq;
    __device__ __forceinline__ void operator()(const f32x4 (&acc)[2][2][4][2], const Unit& u, int wr, int wc, int fr, int fq) const {
        typedef unsigned u32x2v __attribute__((ext_vector_type(2)));
        const int row0 = u.pm * BM + wr * 64 + fr, col0 = u.pn * BM + wc * 32 + 4 * fq;
#pragma unroll
        for (int ai = 0; ai < 2; ++ai)
#pragma unroll
            for (int m = 0; m < 4; ++m) {
                const int row = row0 + ai * HALF + m * 16; const size_t off = (size_t)row * 1024 + col0; float s = 0.f;
#pragma unroll
                for (int bj = 0; bj < 2; ++bj)
#pragma unroll
                    for (int n = 0; n < 2; ++n) { const size_t o2 = off + bj * HALF + n * 16;
                        const f32x4 o = *(const f32x4*)(base + o2) + acc[ai][bj][m][n];
                        *(f32x4*)(out + o2) = o; s += (o[0] * o[0] + o[1] * o[1]) + (o[2] * o[2] + o[3] * o[3]);
                        u32x2v w; w.x = cvt_pk_bf16(o[0], o[1]); w.y = cvt_pk_bf16(o[2], o[3]); *(u32x2v*)(xb + o2) = w; }
                s += __shfl_xor(s, 16); s += __shfl_xor(s, 32);
                if (fq == 0) atomicAdd(ssq + row, s);
            }
    }
};
struct EpiKV {
    static constexpr bool PERM = false, AFTER_DRAIN = false;
    bf16_t* Kb; bf16_t* VTp;
    __device__ __forceinline__ void operator()(const f32x4 (&acc)[2][2][4][2], const Unit& u, int wr, int wc, int fr, int fq) const {
        typedef unsigned u32x2v __attribute__((ext_vector_type(2)));
        const int row0 = u.pm * BM + wr * 64 + fr, col0 = u.pn * BM + wc * 32 + 4 * fq;
#pragma unroll
        for (int ai = 0; ai < 2; ++ai)
#pragma unroll
            for (int m = 0; m < 4; ++m) {
                const int row = row0 + ai * HALF + m * 16, b = row >> 8, key = row & 255;
#pragma unroll
                for (int bj = 0; bj < 2; ++bj)
#pragma unroll
                    for (int n = 0; n < 2; ++n) { const int col = col0 + bj * HALF + n * 16; const f32x4 v = acc[ai][bj][m][n];
                        const unsigned p01 = cvt_pk_bf16(v[0], v[1]), p23 = cvt_pk_bf16(v[2], v[3]);
                        if (col < 1024) { const int h = col >> 8, dh = col & 255; u32x2v w; w.x = p01; w.y = p23;
                            *(u32x2v*)(Kb + ((size_t)((b * 4 + h) * 256 + key)) * 256 + dh) = w; }
                        else { const int c2 = col - 1024, h = c2 >> 8, dv = c2 & 255, kp = (key & ~31) | permk(key & 31);
                            bf16_t* d = VTp + ((size_t)((b * 4 + h) * 256 + dv)) * 256 + kp;
                            d[0] = (bf16_t)(p01 & 0xffffu); d[256] = (bf16_t)(p01 >> 16); d[512] = (bf16_t)(p23 & 0xffffu); d[768] = (bf16_t)(p23 >> 16); } }
            }
    }
};
}
#ifndef PG8_SP2
#define PG8_SP2 true
#endif
#ifndef PG8_ALIGN
#define PG8_ALIGN true
#endif

constexpr int NWAVES = 8;
#ifndef MK_PER_PHASE
#define MK_PER_PHASE 0
#endif
constexpr int T = 16384, SEQ = 8192, D = 1024;
constexpr int N_PHASES = 12;

constexpr size_t MiB = 1u << 20, KiB = 1u << 10;
constexpr size_t WS_CTL = 0, CTL_ZERO_BYTES = 1 * MiB;
constexpr int CW_BAR = 4096;
constexpr size_t WS_SSQ1 = 64 * KiB, WS_SSQ2 = 128 * KiB;
constexpr size_t WS_AB = 1 * MiB;
constexpr size_t WS_HEND = WS_AB + 512 * KiB, WS_PEND = WS_HEND + 512 * KiB, WS_HIN = WS_PEND + 512 * KiB;
constexpr size_t WS_DEC = WS_HIN + 512 * KiB;
constexpr size_t WS_SUBK = 3 * MiB + 256 * KiB;
constexpr size_t WS_WIN = 4 * MiB, WS_WOUT = 10 * MiB, WS_WQ = 12 * MiB, WS_WKV = 14 * MiB, WS_WO = 18 * MiB, WS_PWQ = 20 * MiB;
constexpr size_t WS_MEMN = 24 * MiB, WS_KB = 25 * MiB, WS_VTP = 26 * MiB;
constexpr size_t WS_XB = 28 * MiB;
constexpr size_t WS_HLOC = 28 * MiB, WS_PCUM = 44 * MiB;
constexpr size_t WS_QKV = 60 * MiB;
constexpr size_t WS_Y = 60 * MiB;
constexpr size_t WS_IDX = 60 * MiB, WS_GW = 68 * MiB;
constexpr size_t WS_UB = 92 * MiB;
constexpr size_t WS_XR = 108 * MiB, WS_Z = 124 * MiB, WS_GATE = 140 * MiB;
constexpr size_t WS_WN = 156 * MiB, WS_UF = 172 * MiB, WS_QD = 188 * MiB, WS_KD = 204 * MiB, WS_ATT = 220 * MiB;
constexpr size_t WS_VB = 156 * MiB;
constexpr size_t WS_Q = 188 * MiB, WS_AO = 220 * MiB;
constexpr size_t WS_PQ = 188 * MiB;
constexpr size_t WS_END = 252 * MiB;
static_assert(WS_XR - WS_QKV == (size_t)T * 1536 * 2 && WS_Z - WS_XR == (size_t)T * 512 * 2 && WS_GATE - WS_Z == (size_t)T * 512 * 2, "in-proj outputs are contiguous");

constexpr int LDS_BYTES = 160 * 1024;
constexpr int MISC_OFF = 159 * 1024;

#define GAS __attribute__((address_space(1)))
#define LAS __attribute__((address_space(3)))
typedef unsigned short bf16;
typedef unsigned v4u __attribute__((ext_vector_type(4)));
typedef unsigned v2u __attribute__((ext_vector_type(2)));
typedef float f32x4 __attribute__((ext_vector_type(4)));
typedef short bf16x8 __attribute__((ext_vector_type(8)));
typedef GAS unsigned gu32;
#define LDS_WAIT() asm volatile("s_waitcnt lgkmcnt(0)" ::: "memory")
__device__ __forceinline__ unsigned f2bf(float f) { unsigned u = __builtin_bit_cast(unsigned, f); return (u + 0x7fffu + ((u >> 16) & 1u)) >> 16; }
__device__ __forceinline__ unsigned pk2(float lo, float hi) { return f2bf(lo) | (f2bf(hi) << 16); }
__device__ __forceinline__ float bflo(unsigned u) { return __builtin_bit_cast(float, u << 16); }
__device__ __forceinline__ float bfhi(unsigned u) { return __builtin_bit_cast(float, u & 0xffff0000u); }
__device__ __forceinline__ float bf1(bf16 h) { return __builtin_bit_cast(float, (unsigned)h << 16); }
__device__ __forceinline__ float wave_sum(float v) {
#pragma unroll
    for (int o = 1; o < 64; o <<= 1) v += __shfl_xor(v, o);
    return v;
}
__device__ __forceinline__ float sigmoidf_(float x) { return 1.0f / (1.0f + __expf(-x)); }
__device__ __forceinline__ float softplusf_(float x) { return fmaxf(x, 0.f) + log1pf(__expf(-fabsf(x))); }
__device__ __forceinline__ float siluf_(float x) { return x / (1.0f + __expf(-x)); }
__device__ __forceinline__ float gelu_tanh(float x) { const float y = 0.7978845608028654f * (x + 0.044715f * x * x * x); const float e = __expf(2.0f * y); return 0.5f * x * (2.0f - 2.0f / (1.0f + e)); }
__device__ __forceinline__ int permk(int kl) { return 8 * ((kl & 15) >> 2) + 4 * (kl >> 4) + (kl & 3); }

struct Params {
    const float *x, *mem, *norm_mix_w, *w_in, *conv_qkv_w, *gdn_a_log, *gdn_dt_bias, *gdn_norm_w, *lru_conv_w, *lru_conv_b, *lru_wa, *lru_ba, *lru_wx, *lru_bx, *lru_lambda, *w_out,
                *norm_xattn_w, *norm_mem_w, *xattn_wq, *xattn_wkv, *xattn_wo, *norm_ffn_w, *peer_wq, *peer_subkeys, *peer_u, *peer_v, *norm_final_w;
    float* out; unsigned char* ws; int ph_lo, ph_hi;
};
#define XB_TMO      128
#define XB_XCNT(j)  (256  + 64 * (j))
#define XB_XSUB(j)  (1280 + 64 * (j))
#define XB_XGEN(j)  (2304 + 64 * (j))
#define XB_TOP      3328
#define XB_TOPGEN   3392
#define XCD_BAR_WORDS 3456
#define XB_SPIN_CAP (1u << 18)

__device__ __forceinline__ unsigned xb_ld(unsigned* p)              { return __hip_atomic_load(p, __ATOMIC_RELAXED, __HIP_MEMORY_SCOPE_AGENT); }
__device__ __forceinline__ unsigned xb_add(unsigned* p, unsigned v) { return __hip_atomic_fetch_add(p, v, __ATOMIC_RELAXED, __HIP_MEMORY_SCOPE_AGENT); }
__device__ __forceinline__ unsigned xb_xcc_id() { return (unsigned)__builtin_amdgcn_s_getreg((3 << 11) | 20) & 0xFu; }
#define XB_SPIN(cond, bar) do { unsigned _sp = 0; while (cond) { __builtin_amdgcn_s_sleep(1); \
    if ((++_sp & 255u) == 0u) { if (xb_ld(&(bar)[XB_TMO])) break; if (_sp > XB_SPIN_CAP) { atomicAdd(&(bar)[XB_TMO], 1u); break; } } } } while (0)

struct XcdBarrier {
    unsigned* bar; unsigned x;
    volatile LAS unsigned* st;
};

__device__ __forceinline__ XcdBarrier xcd_barrier_post(unsigned* bar, volatile LAS unsigned* st) {
    XcdBarrier b; b.bar = bar; b.x = xb_xcc_id(); b.st = st;
    if (threadIdx.x == 0) (void)xb_add(&bar[XB_XCNT(b.x)], 1u);
    return b;
}
__device__ __forceinline__ void xcd_barrier_complete(unsigned* bar, unsigned x, unsigned& nloc, unsigned& nx) {
    const unsigned G = gridDim.x * gridDim.y * gridDim.z;
    unsigned sum, cnt, mine, sp = 0u;
    for (;;) {
        sum = 0u; cnt = 0u; mine = 0u;
#pragma unroll
        for (unsigned j = 0; j < 16; ++j) { const unsigned c = xb_ld(&bar[XB_XCNT(j)]); sum += c; cnt += (c > 0u) ? 1u : 0u; mine = (j == x) ? c : mine; }
        if (sum == G) break;
        __builtin_amdgcn_s_sleep(1);
        if ((++sp & 255u) == 0u) { if (xb_ld(&bar[XB_TMO])) break; if (sp > XB_SPIN_CAP) { atomicAdd(&bar[XB_TMO], 1u); break; } }
    }
    nloc = mine > 0u ? mine : 1u; nx = cnt > 0u ? cnt : 1u;
}

__device__ __forceinline__ void xcd_barrier(const XcdBarrier& b) {
    asm volatile("s_waitcnt vmcnt(0)" ::: "memory");
    __syncthreads();
    if (threadIdx.x == 0) {
        unsigned* bar = b.bar;
        __builtin_amdgcn_s_waitcnt(0);
        unsigned nloc = b.st[0], nx = b.st[1];
        if (nloc == 0u) { xcd_barrier_complete(bar, b.x, nloc, nx); b.st[0] = nloc; b.st[1] = nx; }
        const unsigned old = xb_add(&bar[XB_XSUB(b.x)], 1u);
        const unsigned gen = old / nloc;
        if (old + 1u == (gen + 1u) * nloc) {
            __builtin_amdgcn_fence(__ATOMIC_RELEASE, "agent");
            asm volatile("s_waitcnt vmcnt(0)" ::: "memory");
            const unsigned og = xb_add(&bar[XB_TOP], 1u);
            const unsigned tg = og / nx;
            if (og + 1u == (tg + 1u) * nx) xb_add(&bar[XB_TOPGEN], 1u);
            else XB_SPIN(xb_ld(&bar[XB_TOPGEN]) == tg, bar);
            __builtin_amdgcn_fence(__ATOMIC_ACQUIRE, "agent");
            xb_add(&bar[XB_XGEN(b.x)], 1u);
            asm volatile("s_waitcnt vmcnt(0)" ::: "memory");
        } else {
            XB_SPIN(xb_ld(&bar[XB_XGEN(b.x)]) == gen, bar);
            __builtin_amdgcn_fence(__ATOMIC_ACQUIRE, "agent");
            asm volatile("s_waitcnt vmcnt(0)" ::: "memory");
        }
    }
    __syncthreads();
}

__device__ __forceinline__ void p0_transpose_item(const float* W, int K, int ldw, int c0, int nblk, bf16* WT, int row_off, const float* ks, LAS float* scr, int item, int lane) {
    const int kb = item / nblk, nb = item % nblk, k0 = 64 * kb, n0 = 32 * nb;
#pragma unroll 8
    for (int i = 0; i < 32; ++i) { const int kk = 2 * i + (lane >> 5); float v = W[(size_t)(k0 + kk) * ldw + c0 + n0 + (lane & 31)]; if (ks) v *= ks[k0 + kk]; scr[kk * 33 + (lane & 31)] = v; }
    LDS_WAIT(); asm volatile("" ::: "memory");
    const int c = lane & 7;
#pragma unroll
    for (int j = 0; j < 4; ++j) { const int n = (lane >> 3) + 8 * j; const LAS float* s = scr + (8 * c) * 33 + n;
        v4u o; o.x = pk2(s[0 * 33], s[1 * 33]); o.y = pk2(s[2 * 33], s[3 * 33]); o.z = pk2(s[4 * 33], s[5 * 33]); o.w = pk2(s[6 * 33], s[7 * 33]);
        *(GAS v4u*)(WT + (size_t)(row_off + n0 + n) * K + k0 + 8 * c) = o; }
    LDS_WAIT(); asm volatile("" ::: "memory");
}

__device__ __forceinline__ void p0_prologue(const Params& P, LAS unsigned char* lds, int tid, int lane, int wave, int vcu, int G) {
    unsigned char* ws = P.ws;
    const int gw = vcu * NWAVES + wave, NGW = G * NWAVES;
    LAS float* wabl = (LAS float*)lds;
    for (int idx = tid; idx < 8192; idx += NWAVES * 64) { const int k = idx >> 3, c = idx & 7, j = k >> 8, l = (k >> 2) & 63, e = k & 3;
        wabl[((((j * 4 + e) * 2 + (c >> 2)) * 64 + l) << 2) + (c & 3)] = P.w_in[(size_t)k * 3080 + 2048 + c]; }
    __syncthreads();
    {
        bf16* XB0 = (bf16*)(ws + WS_XB); float* AB = (float*)(ws + WS_AB);
        f32x4 w4[4];
#pragma unroll
        for (int j = 0; j < 4; ++j) w4[j] = ((const f32x4*)P.norm_mix_w)[64 * j + lane];
        for (int m = gw; m < T; m += NGW) {
            const f32x4* xr = (const f32x4*)(P.x + (size_t)m * D) + lane;
            f32x4 v[4]; float s = 0.f;
#pragma unroll
            for (int j = 0; j < 4; ++j) { v[j] = xr[64 * j]; s += (v[j].x * v[j].x + v[j].y * v[j].y) + (v[j].z * v[j].z + v[j].w * v[j].w); }
            const float rstd = rsqrtf(wave_sum(s) * (1.0f / D) + 1e-6f);
            v2u* o8 = (v2u*)(XB0 + (size_t)m * D) + lane;
            float part[8];
#pragma unroll
            for (int c = 0; c < 8; ++c) part[c] = 0.f;
#pragma unroll
            for (int j = 0; j < 4; ++j) {
                v[j] = v[j] * rstd * w4[j];
                v2u o; o.x = pk2(v[j].x, v[j].y); o.y = pk2(v[j].z, v[j].w); o8[64 * j] = o;
#pragma unroll
                for (int e = 0; e < 4; ++e) {
                    const f32x4 wa = *(const LAS f32x4*)(wabl + ((((j * 4 + e) * 2 + 0) * 64 + lane) << 2));
                    const f32x4 wb = *(const LAS f32x4*)(wabl + ((((j * 4 + e) * 2 + 1) * 64 + lane) << 2));
                    const float hv = v[j][e];
                    part[0] += hv * wa.x; part[1] += hv * wa.y; part[2] += hv * wa.z; part[3] += hv * wa.w;
                    part[4] += hv * wb.x; part[5] += hv * wb.y; part[6] += hv * wb.z; part[7] += hv * wb.w;
                }
            }
#pragma unroll
            for (int c = 0; c < 8; ++c) part[c] = wave_sum(part[c]);
            float o = part[0];
#pragma unroll
            for (int c = 1; c < 8; ++c) o = (lane == c) ? part[c] : o;
            if (lane < 8) AB[(size_t)m * 8 + lane] = o;
        }
    }
    {
        bf16* MEMN = (bf16*)(ws + WS_MEMN);
        for (int m = gw; m < 512; m += NGW) {
            const f32x4* xr = (const f32x4*)(P.mem + (size_t)m * D) + lane;
            f32x4 v[4]; float s = 0.f;
#pragma unroll
            for (int j = 0; j < 4; ++j) { v[j] = xr[64 * j]; s += (v[j].x * v[j].x + v[j].y * v[j].y) + (v[j].z * v[j].z + v[j].w * v[j].w); }
            const float rstd = rsqrtf(wave_sum(s) * (1.0f / D) + 1e-6f);
            v2u* o8 = (v2u*)(MEMN + (size_t)m * D) + lane;
#pragma unroll
            for (int j = 0; j < 4; ++j) { const f32x4 w = ((const f32x4*)P.norm_mem_w)[64 * j + lane]; const f32x4 y = v[j] * rstd * w;
                v2u o; o.x = pk2(y.x, y.y); o.y = pk2(y.z, y.w); o8[64 * j] = o; }
        }
    }
    __syncthreads();
    {
        LAS float* scr = (LAS float*)(lds + wave * 16384);
        constexpr int I_IN1 = 16 * 48, I_IN2 = 16 * 16, I_OUT = 16 * 32, I_Q = 16 * 32, I_KV = 16 * 64, I_O = 16 * 32, I_PQ = 16 * 64;
        constexpr int NITEMS = I_IN1 + 3 * I_IN2 + I_OUT + I_Q + I_KV + I_O + I_PQ;
        for (int it = gw; it < NITEMS; it += NGW) {
            int r = it;
            if (r < I_IN1) { p0_transpose_item(P.w_in, 1024, 3080, 0, 48, (bf16*)(ws + WS_WIN), 0, nullptr, scr, r, lane); continue; } r -= I_IN1;
            if (r < I_IN2) { p0_transpose_item(P.w_in, 1024, 3080, 2056, 16, (bf16*)(ws + WS_WIN), 1536, nullptr, scr, r, lane); continue; } r -= I_IN2;
            if (r < I_IN2) { p0_transpose_item(P.w_in, 1024, 3080, 1536, 16, (bf16*)(ws + WS_WIN), 2048, nullptr, scr, r, lane); continue; } r -= I_IN2;
            if (r < I_IN2) { p0_transpose_item(P.w_in, 1024, 3080, 2568, 16, (bf16*)(ws + WS_WIN), 2560, nullptr, scr, r, lane); continue; } r -= I_IN2;
            if (r < I_OUT) { p0_transpose_item(P.w_out, 1024, 1024, 0, 32, (bf16*)(ws + WS_WOUT), 0, nullptr, scr, r, lane); continue; } r -= I_OUT;
            if (r < I_Q) { p0_transpose_item(P.xattn_wq, 1024, 1024, 0, 32, (bf16*)(ws + WS_WQ), 0, P.norm_xattn_w, scr, r, lane); continue; } r -= I_Q;
            if (r < I_KV) { p0_transpose_item(P.xattn_wkv, 1024, 2048, 0, 64, (bf16*)(ws + WS_WKV), 0, nullptr, scr, r, lane); continue; } r -= I_KV;
            if (r < I_O) { p0_transpose_item(P.xattn_wo, 1024, 1024, 0, 32, (bf16*)(ws + WS_WO), 0, nullptr, scr, r, lane); continue; } r -= I_O;
            p0_transpose_item(P.peer_wq, 1024, 2048, 0, 64, (bf16*)(ws + WS_PWQ), 0, P.norm_ffn_w, scr, r, lane);
        }
    }
    {
        bf16* SUBK = (bf16*)(ws + WS_SUBK);
        for (int i = (vcu * NWAVES * 64 + tid); i < 16 * 128 * 128 / 4; i += G * NWAVES * 64) {
            const f32x4 v = ((const f32x4*)P.peer_subkeys)[i]; v2u o; o.x = pk2(v.x, v.y); o.y = pk2(v.z, v.w); ((v2u*)SUBK)[i] = o; }
    }
}

__device__ __forceinline__ void gdn_local_item(const Params& P, LAS unsigned char* lds, int item, int tid) {
    unsigned char* ws = P.ws;
    const int b = item >> 9, h = (item >> 7) & 3, n = item & 127;
    const int t0 = b * SEQ + n * 64;
    LAS float* ks = (LAS float*)lds;
    LAS float* vs = ks + 64 * 132;
    LAS float* AmT = vs + 64 * 132;
    LAS float* sg = AmT + 64 * 68;
    LAS float* sbeta = sg + 64;
    LAS float* sgc = sbeta + 64;
    LAS float* seg = sgc + 64;
    LAS float* sek = seg + 64;
    LAS float* qs = sek + 64;
    LAS float* solw = qs;
    static_assert((2 * 64 * 132 + 64 * 68 + 5 * 64 + 64 * 256) * 4 <= 156 * 1024, "gdn_local LDS");
    const bf16* QKV = (const bf16*)(ws + WS_QKV);
    const float* AB = (const float*)(ws + WS_AB);
#ifndef SKIP_S1
    {
        const int c = tid >> 3, grp = tid & 7;
#pragma unroll 1
        for (int part = 0; part < 3; ++part) {
            const int ch0 = part * 512 + h * 128 + grp * 16;
            float y[16];
#pragma unroll
            for (int i = 0; i < 16; ++i) y[i] = 0.f;
#pragma unroll
            for (int j = 0; j < 4; ++j) {
                const int s = n * 64 + c - 3 + j;
                if (s >= 0) {
                    const v4u* src = (const v4u*)(QKV + (size_t)(b * SEQ + s) * 1536 + ch0);
                    const v4u x0 = src[0], x1 = src[1];
                    const f32x4* wp = (const f32x4*)(P.conv_qkv_w + j * 1536 + ch0);
                    const f32x4 w0 = wp[0], w1 = wp[1], w2 = wp[2], w3 = wp[3];
                    y[0] += w0.x * bflo(x0.x); y[1] += w0.y * bfhi(x0.x); y[2] += w0.z * bflo(x0.y); y[3] += w0.w * bfhi(x0.y);
                    y[4] += w1.x * bflo(x0.z); y[5] += w1.y * bfhi(x0.z); y[6] += w1.z * bflo(x0.w); y[7] += w1.w * bfhi(x0.w);
                    y[8] += w2.x * bflo(x1.x); y[9] += w2.y * bfhi(x1.x); y[10] += w2.z * bflo(x1.y); y[11] += w2.w * bfhi(x1.y);
                    y[12] += w3.x * bflo(x1.z); y[13] += w3.y * bfhi(x1.z); y[14] += w3.z * bflo(x1.w); y[15] += w3.w * bfhi(x1.w);
                }
            }
            float ss = 0.f;
#pragma unroll
            for (int i = 0; i < 16; ++i) { y[i] = siluf_(y[i]); ss += y[i] * y[i]; }
            if (part < 2) {
                ss += __shfl_xor(ss, 1); ss += __shfl_xor(ss, 2); ss += __shfl_xor(ss, 4);
                const float sc = rsqrtf(ss + 1e-6f) * (part == 0 ? 0.08838834764831845f : 1.0f);
#pragma unroll
                for (int i = 0; i < 16; ++i) y[i] *= sc;
            }
            LAS float* dst = (part == 0 ? qs : (part == 1 ? ks : vs)) + c * 132 + grp * 16;
#pragma unroll
            for (int i = 0; i < 4; ++i) *(LAS f32x4*)(dst + 4 * i) = (f32x4){y[4 * i], y[4 * i + 1], y[4 * i + 2], y[4 * i + 3]};
        }
        if (tid < 64) {
            const int t = t0 + tid;
            const float a_in = AB[(size_t)t * 8 + h], b_in = AB[(size_t)t * 8 + 4 + h];
            sg[tid] = -__expf(P.gdn_a_log[h]) * softplusf_(a_in + P.gdn_dt_bias[h]);
            sbeta[tid] = sigmoidf_(b_in);
        }
    }
#endif
    __syncthreads();
    if (tid < 64) {
        float v = sg[tid];
#pragma unroll
        for (int off = 1; off < 64; off <<= 1) { const float t = __shfl_up(v, off); if (tid >= off) v += t; }
        sgc[tid] = v; seg[tid] = __expf(v);
        const float gl = __shfl(v, 63);
        sek[tid] = __expf(gl - v);
        if (tid == 63) ((float*)(ws + WS_DEC))[item] = __expf(v);
    }
    __syncthreads();
#ifndef SKIP_S3
    {
        const int c = tid >> 3, sgp = tid & 7;
        float akk[8], aqk[8];
#pragma unroll
        for (int i = 0; i < 8; ++i) { akk[i] = 0.f; aqk[i] = 0.f; }
#pragma unroll 2
        for (int d4 = 0; d4 < 32; ++d4) {
            const f32x4 kc = *(const LAS f32x4*)(ks + c * 132 + 4 * d4), qc = *(const LAS f32x4*)(qs + c * 132 + 4 * d4);
#pragma unroll
            for (int i = 0; i < 8; ++i) { const f32x4 kv = *(const LAS f32x4*)(ks + (sgp + 8 * i) * 132 + 4 * d4);
                akk[i] += (kc.x * kv.x + kc.y * kv.y) + (kc.z * kv.z + kc.w * kv.w);
                aqk[i] += (qc.x * kv.x + qc.y * kv.y) + (qc.z * kv.z + qc.w * kv.w); }
        }
        const float gc = sgc[c], bc = sbeta[c];
        bf16* ATT = (bf16*)(ws + WS_ATT) + (size_t)item * 4096;
#pragma unroll
        for (int i = 0; i < 8; ++i) { const int s = sgp + 8 * i;
            const float dec = (c >= s) ? __expf(gc - sgc[s]) : 0.f;
            AmT[s * 68 + c] = (c > s) ? bc * akk[i] * dec : 0.f;
            ATT[c * 64 + ((s & ~31) | permk(s & 31))] = (bf16)f2bf(aqk[i] * dec); }
    }
#endif
#ifndef SKIP_S4
    {
        bf16* QD = (bf16*)(ws + WS_QD) + (size_t)item * 8192;
        bf16* KD = (bf16*)(ws + WS_KD) + (size_t)item * 8192;
#pragma unroll
        for (int r = 0; r < 2; ++r) {
            const int id = tid + 512 * r;
            { const int c = id >> 4, gam = id & 15, s32 = gam >> 2, g = gam & 3;
              const f32x4 lo = *(const LAS f32x4*)(qs + c * 132 + 32 * s32 + 4 * g), hi = *(const LAS f32x4*)(qs + c * 132 + 32 * s32 + 16 + 4 * g);
              const float e = seg[c];
              v4u o; o.x = pk2(lo.x * e, lo.y * e); o.y = pk2(lo.z * e, lo.w * e); o.z = pk2(hi.x * e, hi.y * e); o.w = pk2(hi.z * e, hi.w * e);
              *(v4u*)(QD + c * 128 + 8 * gam) = o; }
            { const int dk = id >> 3, gam = id & 7, s32 = gam >> 2, g = gam & 3, c0 = 32 * s32 + 4 * g;
              float v[8];
#pragma unroll
              for (int j = 0; j < 4; ++j) { v[j] = ks[(c0 + j) * 132 + dk] * sek[c0 + j]; v[4 + j] = ks[(c0 + 16 + j) * 132 + dk] * sek[c0 + 16 + j]; }
              v4u o; o.x = pk2(v[0], v[1]); o.y = pk2(v[2], v[3]); o.z = pk2(v[4], v[5]); o.w = pk2(v[6], v[7]);
              *(v4u*)(KD + dk * 64 + 8 * gam) = o; }
        }
    }
#endif
    __syncthreads();
#ifndef SKIP_S5
    if (tid < 256) {
        const int j = tid;
        const LAS float* src = (j < 128) ? (vs + j) : (ks + (j - 128));
#pragma unroll 1
        for (int rb = 0; rb < 4; ++rb) {
            float acc[16];
#pragma unroll
            for (int i = 0; i < 16; ++i) { const int c = 16 * rb + i; float a = src[c * 132] * sbeta[c]; if (j >= 128) a *= seg[c]; acc[i] = a; }
#pragma unroll 2
            for (int s = 0; s < 16 * rb; ++s) {
                const float sv = solw[s * 256 + j];
                const LAS float* ar = AmT + s * 68 + 16 * rb;
#pragma unroll
                for (int q = 0; q < 4; ++q) { const f32x4 A4 = *(const LAS f32x4*)(ar + 4 * q);
                    acc[4 * q] -= A4.x * sv; acc[4 * q + 1] -= A4.y * sv; acc[4 * q + 2] -= A4.z * sv; acc[4 * q + 3] -= A4.w * sv; }
            }
#pragma unroll
            for (int i = 0; i < 16; ++i) {
                const int s = 16 * rb + i; const float sv = acc[i];
                solw[s * 256 + j] = sv;
                const LAS float* ar = AmT + s * 68 + 16 * rb;
#pragma unroll
                for (int q = (i + 1) / 4; q < 4; ++q) { const f32x4 A4 = *(const LAS f32x4*)(ar + 4 * q);
                    if (4 * q > i) acc[4 * q] -= A4.x * sv; if (4 * q + 1 > i) acc[4 * q + 1] -= A4.y * sv; if (4 * q + 2 > i) acc[4 * q + 2] -= A4.z * sv; if (4 * q + 3 > i) acc[4 * q + 3] -= A4.w * sv; }
            }
        }
        LDS_WAIT(); asm volatile("" ::: "memory");
        if (j < 128) {
            bf16* UF = (bf16*)(ws + WS_UF) + (size_t)item * 8192 + (size_t)(j >> 4) * 1024;
#pragma unroll
            for (int g = 0; g < 4; ++g) {
                float v[16];
#pragma unroll
                for (int rho = 0; rho < 4; ++rho)
#pragma unroll
                    for (int i = 0; i < 4; ++i) v[rho * 4 + i] = solw[(16 * rho + 4 * g + i) * 256 + j];
                v4u o0, o1;
                o0.x = pk2(v[0], v[1]); o0.y = pk2(v[2], v[3]); o0.z = pk2(v[4], v[5]); o0.w = pk2(v[6], v[7]);
                o1.x = pk2(v[8], v[9]); o1.y = pk2(v[10], v[11]); o1.z = pk2(v[12], v[13]); o1.w = pk2(v[14], v[15]);
                v4u* d = (v4u*)(UF + (g * 16 + (j & 15)) * 16);
                d[0] = o0; d[1] = o1;
            }
        } else {
            const int dk = j - 128, pos = (dk & ~31) | permk(dk & 31);
            bf16* WN = (bf16*)(ws + WS_WN) + (size_t)item * 8192 + pos;
#pragma unroll 8
            for (int c = 0; c < 64; ++c) WN[c * 128] = (bf16)f2bf(-solw[c * 256 + j]);
        }
    }
#endif
    __syncthreads();
}

__device__ __forceinline__ void lru_local_item(const Params& P, LAS unsigned char* lds, int lt, int tid, int lane, int wave) {
    unsigned char* ws = P.ws;
    const int b = lt >> 7, n = lt & 127, t0 = b * SEQ + n * 64;
    LAS float* xc = (LAS float*)lds;
    const bf16* XR = (const bf16*)(ws + WS_XR);
    {
        const int ch = tid;
        const float w0 = P.lru_conv_w[ch], w1 = P.lru_conv_w[512 + ch], w2 = P.lru_conv_w[1024 + ch], w3 = P.lru_conv_w[1536 + ch], cb = P.lru_conv_b[ch];
        float x0 = 0.f, x1 = 0.f, x2 = 0.f;
        if (n > 0) { x0 = bf1(XR[(size_t)(t0 - 3) * 512 + ch]); x1 = bf1(XR[(size_t)(t0 - 2) * 512 + ch]); x2 = bf1(XR[(size_t)(t0 - 1) * 512 + ch]); }
#pragma unroll 8
        for (int c = 0; c < 64; ++c) { const float x3 = bf1(XR[(size_t)(t0 + c) * 512 + ch]);
            xc[c * 516 + ch] = (w0 * x0 + w1 * x1) + (w2 * x2 + w3 * x3) + cb; x0 = x1; x1 = x2; x2 = x3; }
    }
    __syncthreads();
    {
        const int g = wave, ch = g * 64 + lane;
        float wa[64], wx[64];
        const float* wap = P.lru_wa + (size_t)g * 4096 + lane; const float* wxp = P.lru_wx + (size_t)g * 4096 + lane;
        asm volatile("" : "+v"(wap), "+v"(wxp));
#pragma unroll
        for (int i = 0; i < 64; ++i) { wa[i] = wap[i * 64]; wx[i] = wxp[i * 64]; }
        const float ba = P.lru_ba[ch], bx = P.lru_bx[ch], sp = softplusf_(-P.lru_lambda[ch]);
        bf16* HLOC = (bf16*)(ws + WS_HLOC); bf16* PCUM = (bf16*)(ws + WS_PCUM);
        float hst = 0.f, pc = 1.f;
#pragma unroll 1
        for (int c = 0; c < 64; ++c) {
            float ra = ba, ri = bx;
            const LAS float* xrow = xc + c * 516 + g * 64;
#pragma unroll
            for (int i4 = 0; i4 < 16; ++i4) { const f32x4 x4 = *(const LAS f32x4*)(xrow + 4 * i4);
                ra += x4.x * wa[4 * i4]; ra += x4.y * wa[4 * i4 + 1]; ra += x4.z * wa[4 * i4 + 2]; ra += x4.w * wa[4 * i4 + 3];
                ri += x4.x * wx[4 * i4]; ri += x4.y * wx[4 * i4 + 1]; ri += x4.z * wx[4 * i4 + 2]; ri += x4.w * wx[4 * i4 + 3];
                if ((i4 & 3) == 3) asm volatile("" ::: "memory"); }
            const float r = sigmoidf_(ra), ig = sigmoidf_(ri);
            const float log_a = -8.0f * r * sp;
            const float a = __expf(log_a);
            const float xo = xrow[lane];
            const float bt = sqrtf(fmaxf(-expm1f(2.0f * log_a), 0.f)) * (ig * xo);
            hst = a * hst + bt; pc *= a;
            HLOC[(size_t)(t0 + c) * 512 + ch] = (bf16)f2bf(hst); PCUM[(size_t)(t0 + c) * 512 + ch] = (bf16)f2bf(pc);
        }
        ((float*)(ws + WS_HEND))[(size_t)lt * 512 + ch] = hst; ((float*)(ws + WS_PEND))[(size_t)lt * 512 + ch] = pc;
    }
    __syncthreads();
}

constexpr int SC_WN = 0, SC_QD = 64 * 272, SC_KD = 2 * 64 * 272, SC_ATT = 2 * 64 * 272 + 128 * 144, SC_BUF = 2 * 64 * 272 + 128 * 144 + 64 * 144;
constexpr int SC_SSQ = 2 * SC_BUF;
__device__ __forceinline__ int sc_lds_off(int id) {
    if (id < 1024) return SC_WN + (id >> 4) * 272 + (id & 15) * 16;
    if (id < 2048) { const int q = id - 1024; return SC_QD + (q >> 4) * 272 + (q & 15) * 16; }
    if (id < 3072) { const int q = id - 2048; return SC_KD + (q >> 3) * 144 + (q & 7) * 16; }
    const int q = id - 3072; return SC_ATT + (q >> 3) * 144 + (q & 7) * 16;
}
__device__ __forceinline__ const v4u* sc_src(const unsigned char* ws, int item, int id) {
    if (id < 1024) return (const v4u*)(ws + WS_WN + (size_t)item * 16384) + id;
    if (id < 2048) return (const v4u*)(ws + WS_QD + (size_t)item * 16384) + (id - 1024);
    if (id < 3072) return (const v4u*)(ws + WS_KD + (size_t)item * 16384) + (id - 2048);
    return (const v4u*)(ws + WS_ATT + (size_t)item * 8192) + (id - 3072);
}
__device__ __forceinline__ bf16x8 pack_b(const f32x4 a, const f32x4 b) {
    v4u r; r.x = pk2(a.x, a.y); r.y = pk2(a.z, a.w); r.z = pk2(b.x, b.y); r.w = pk2(b.z, b.w);
    return __builtin_bit_cast(bf16x8, r);
}
__device__ __forceinline__ void gdn_scan(const Params& P, LAS unsigned char* lds, int bh, int tid, int lane, int wave) {
    const unsigned char* ws = P.ws;
    const int b = bh >> 2, h = bh & 3, col = lane & 15, g = lane >> 4, w = wave;
    const int item0 = bh * 128;
    LAS float* ssqb = (LAS float*)(lds + SC_SSQ);
    const bf16* Z = (const bf16*)(ws + WS_Z);
    bf16* Y = (bf16*)(P.ws + WS_Y);
    const float* DEC = (const float*)(ws + WS_DEC);
    const float nw = P.gdn_norm_w[16 * w + col];
    f32x4 S[8];
#pragma unroll
    for (int i = 0; i < 8; ++i) S[i] = (f32x4){0.f, 0.f, 0.f, 0.f};
#pragma unroll
    for (int r = 0; r < 7; ++r) { const int id = tid + 512 * r; *(LAS v4u*)(lds + sc_lds_off(id)) = *sc_src(ws, item0, id); }
    v4u uf0, uf1;
    { const v4u* up = (const v4u*)(ws + WS_UF + (size_t)item0 * 16384 + (size_t)(w * 64 + lane) * 32); uf0 = up[0]; uf1 = up[1]; }
    __syncthreads();
#pragma unroll 1
    for (int n = 0; n < 128; ++n) {
        const int item = item0 + n, t0 = b * SEQ + n * 64;
        LAS unsigned char* buf = lds + (n & 1) * SC_BUF;
        v4u pre[7]; v4u nuf0 = uf0, nuf1 = uf1;
        const bool has_next = (n + 1 < 128);
        if (has_next) {
#pragma unroll
            for (int r = 0; r < 7; ++r) pre[r] = *sc_src(ws, item + 1, tid + 512 * r);
            const v4u* up = (const v4u*)(ws + WS_UF + (size_t)(item + 1) * 16384 + (size_t)(w * 64 + lane) * 32); nuf0 = up[0]; nuf1 = up[1];
        }
        bf16 zr[16];
#pragma unroll
        for (int rho = 0; rho < 4; ++rho)
#pragma unroll
            for (int i = 0; i < 4; ++i) zr[rho * 4 + i] = Z[(size_t)(t0 + 16 * rho + 4 * g + i) * 512 + h * 128 + 16 * w + col];
        const float dec = DEC[item];
        bf16x8 Bs[4];
#pragma unroll
        for (int s = 0; s < 4; ++s) Bs[s] = pack_b(S[2 * s], S[2 * s + 1]);
        f32x4 Vn[4], Oc[4];
        Vn[0] = (f32x4){bflo(uf0.x), bfhi(uf0.x), bflo(uf0.y), bfhi(uf0.y)}; Vn[1] = (f32x4){bflo(uf0.z), bfhi(uf0.z), bflo(uf0.w), bfhi(uf0.w)};
        Vn[2] = (f32x4){bflo(uf1.x), bfhi(uf1.x), bflo(uf1.y), bfhi(uf1.y)}; Vn[3] = (f32x4){bflo(uf1.z), bfhi(uf1.z), bflo(uf1.w), bfhi(uf1.w)};
#pragma unroll
        for (int rho = 0; rho < 4; ++rho) {
            Oc[rho] = (f32x4){0.f, 0.f, 0.f, 0.f};
#pragma unroll
            for (int s = 0; s < 4; ++s) {
                const bf16x8 aw = *(const LAS bf16x8*)(buf + SC_WN + (16 * rho + col) * 272 + (32 * s + 8 * g) * 2);
                const bf16x8 aq = *(const LAS bf16x8*)(buf + SC_QD + (16 * rho + col) * 272 + (32 * s + 8 * g) * 2);
                Vn[rho] = __builtin_amdgcn_mfma_f32_16x16x32_bf16(aw, Bs[s], Vn[rho], 0, 0, 0);
                Oc[rho] = __builtin_amdgcn_mfma_f32_16x16x32_bf16(aq, Bs[s], Oc[rho], 0, 0, 0);
            }
        }
        bf16x8 Bv[2];
        Bv[0] = pack_b(Vn[0], Vn[1]); Bv[1] = pack_b(Vn[2], Vn[3]);
#pragma unroll
        for (int rho = 0; rho < 4; ++rho)
#pragma unroll
            for (int s = 0; s < 2; ++s) {
                const bf16x8 aa = *(const LAS bf16x8*)(buf + SC_ATT + (16 * rho + col) * 144 + (32 * s + 8 * g) * 2);
                Oc[rho] = __builtin_amdgcn_mfma_f32_16x16x32_bf16(aa, Bv[s], Oc[rho], 0, 0, 0);
            }
#pragma unroll
        for (int tau = 0; tau < 8; ++tau) {
            S[tau] = S[tau] * dec;
#pragma unroll
            for (int s = 0; s < 2; ++s) {
                const bf16x8 ak = *(const LAS bf16x8*)(buf + SC_KD + (16 * tau + col) * 144 + (32 * s + 8 * g) * 2);
                S[tau] = __builtin_amdgcn_mfma_f32_16x16x32_bf16(ak, Bv[s], S[tau], 0, 0, 0);
            }
        }
        LAS float* sq = ssqb + (n & 1) * 512;
#pragma unroll
        for (int rho = 0; rho < 4; ++rho)
#pragma unroll
            for (int i = 0; i < 4; ++i) {
                float s2 = Oc[rho][i] * Oc[rho][i];
                s2 += __shfl_xor(s2, 1); s2 += __shfl_xor(s2, 2); s2 += __shfl_xor(s2, 4); s2 += __shfl_xor(s2, 8);
                if (col == 0) sq[(16 * rho + 4 * g + i) * 8 + w] = s2;
            }
        if (has_next) {
            LAS unsigned char* nb = lds + ((n + 1) & 1) * SC_BUF;
#pragma unroll
            for (int r = 0; r < 7; ++r) *(LAS v4u*)(nb + sc_lds_off(tid + 512 * r)) = pre[r];
        }
        uf0 = nuf0; uf1 = nuf1;
        __syncthreads();
#pragma unroll
        for (int rho = 0; rho < 4; ++rho)
#pragma unroll
            for (int i = 0; i < 4; ++i) {
                const int c = 16 * rho + 4 * g + i;
                const f32x4 p0 = *(const LAS f32x4*)(sq + c * 8), p1 = *(const LAS f32x4*)(sq + c * 8 + 4);
                const float tot = ((p0.x + p0.y) + (p0.z + p0.w)) + ((p1.x + p1.y) + (p1.z + p1.w));
                const float rstd = rsqrtf(tot * (1.0f / 128.0f) + 1e-6f);
                const float zv = bf1(zr[rho * 4 + i]);
                Y[(size_t)(t0 + c) * 1024 + h * 128 + 16 * w + col] = (bf16)f2bf(Oc[rho][i] * rstd * nw * siluf_(zv));
            }
    }
}

__device__ __forceinline__ void lru_carry(const Params& P, int gwv, int lane) {
    unsigned char* ws = P.ws;
    const int b = gwv >> 3, g = gwv & 7, ch = g * 64 + lane;
    const float* HEND = (const float*)(ws + WS_HEND); const float* PEND = (const float*)(ws + WS_PEND); float* HIN = (float*)(ws + WS_HIN);
    float hin = 0.f;
#pragma unroll 1
    for (int n0 = 0; n0 < 128; n0 += 16) {
        float he[16], pe[16];
#pragma unroll
        for (int i = 0; i < 16; ++i) { const size_t o = (size_t)(b * 128 + n0 + i) * 512 + ch; he[i] = HEND[o]; pe[i] = PEND[o]; }
#pragma unroll
        for (int i = 0; i < 16; ++i) { HIN[(size_t)(b * 128 + n0 + i) * 512 + ch] = hin; hin = he[i] + pe[i] * hin; }
    }
}

__device__ __forceinline__ void cvt_table(const float* src, bf16* dst, size_t n8, size_t wi, size_t nw) {
    for (size_t i = wi; i < n8; i += nw) {
        const f32x4 a = ((const f32x4*)src)[2 * i], c = ((const f32x4*)src)[2 * i + 1];
        v4u o; o.x = pk2(a.x, a.y); o.y = pk2(a.z, a.w); o.z = pk2(c.x, c.y); o.w = pk2(c.z, c.w);
        ((v4u*)dst)[i] = o;
    }
}

__device__ __forceinline__ void lru_combine(const Params& P, size_t wi, size_t nw) {
    unsigned char* ws = P.ws;
    const v4u* HLOC = (const v4u*)(ws + WS_HLOC); const v4u* PCUM = (const v4u*)(ws + WS_PCUM); const v4u* GATE = (const v4u*)(ws + WS_GATE);
    const float* HIN = (const float*)(ws + WS_HIN); bf16* Y = (bf16*)(ws + WS_Y);
    for (size_t i = wi; i < (size_t)T * 64; i += nw) {
        const size_t t = i >> 6; const int ch0 = (int)(i & 63) * 8;
        const v4u hl = HLOC[i], pc = PCUM[i], gt = GATE[i];
        const f32x4 h0 = *(const f32x4*)(HIN + (t >> 6) * 512 + ch0), h1 = *(const f32x4*)(HIN + (t >> 6) * 512 + ch0 + 4);
        float y[8];
        y[0] = (bflo(hl.x) + bflo(pc.x) * h0.x) * gelu_tanh(bflo(gt.x)); y[1] = (bfhi(hl.x) + bfhi(pc.x) * h0.y) * gelu_tanh(bfhi(gt.x));
        y[2] = (bflo(hl.y) + bflo(pc.y) * h0.z) * gelu_tanh(bflo(gt.y)); y[3] = (bfhi(hl.y) + bfhi(pc.y) * h0.w) * gelu_tanh(bfhi(gt.y));
        y[4] = (bflo(hl.z) + bflo(pc.z) * h1.x) * gelu_tanh(bflo(gt.z)); y[5] = (bfhi(hl.z) + bfhi(pc.z) * h1.y) * gelu_tanh(bfhi(gt.z));
        y[6] = (bflo(hl.w) + bflo(pc.w) * h1.z) * gelu_tanh(bflo(gt.w)); y[7] = (bfhi(hl.w) + bfhi(pc.w) * h1.w) * gelu_tanh(bfhi(gt.w));
        v4u o; o.x = pk2(y[0], y[1]); o.y = pk2(y[2], y[3]); o.z = pk2(y[4], y[5]); o.w = pk2(y[6], y[7]);
        *(v4u*)(Y + t * 1024 + 512 + ch0) = o;
    }
}

__device__ __forceinline__ void xattn_unit(const Params& P, int wu, int lane) {
    const unsigned char* ws = P.ws;
    const int h = wu & 3, t0 = (wu >> 2) * 16, b = t0 >> 13, col = lane & 15, g = lane >> 4;
    const bf16* Q = (const bf16*)(ws + WS_Q) + (size_t)(t0 + col) * 1024 + h * 256 + 8 * g;
    const bf16* Kb = (const bf16*)(ws + WS_KB) + (size_t)((b * 4 + h) * 256 + col) * 256 + 8 * g;
    const bf16* Vt = (const bf16*)(ws + WS_VTP) + (size_t)((b * 4 + h) * 256 + col) * 256 + 8 * g;
    bf16x8 Bq[8];
#pragma unroll
    for (int s = 0; s < 8; ++s) Bq[s] = *(const bf16x8*)(Q + 32 * s);
    f32x4 St[16];
#pragma unroll
    for (int kap = 0; kap < 16; ++kap) {
        f32x4 acc = (f32x4){0.f, 0.f, 0.f, 0.f};
#pragma unroll
        for (int s = 0; s < 8; ++s) { const bf16x8 a = *(const bf16x8*)(Kb + (size_t)(16 * kap) * 256 + 32 * s); acc = __builtin_amdgcn_mfma_f32_16x16x32_bf16(a, Bq[s], acc, 0, 0, 0); }
        St[kap] = acc;
    }
    float mx = -3.0e38f;
#pragma unroll
    for (int kap = 0; kap < 16; ++kap) mx = fmaxf(fmaxf(fmaxf(St[kap].x, St[kap].y), fmaxf(St[kap].z, St[kap].w)), mx);
    mx = fmaxf(mx, __shfl_xor(mx, 16)); mx = fmaxf(mx, __shfl_xor(mx, 32));
    float l = 0.f;
#pragma unroll
    for (int kap = 0; kap < 16; ++kap) { St[kap].x = __expf(St[kap].x - mx); St[kap].y = __expf(St[kap].y - mx); St[kap].z = __expf(St[kap].z - mx); St[kap].w = __expf(St[kap].w - mx);
        l += (St[kap].x + St[kap].y) + (St[kap].z + St[kap].w); }
    l += __shfl_xor(l, 16); l += __shfl_xor(l, 32);
    const float inv = 1.0f / l;
    bf16x8 Bp[8];
#pragma unroll
    for (int s = 0; s < 8; ++s) Bp[s] = pack_b(St[2 * s], St[2 * s + 1]);
    bf16* AO = (bf16*)(P.ws + WS_AO) + (size_t)(t0 + col) * 1024 + h * 256 + 4 * g;
#pragma unroll
    for (int del = 0; del < 16; ++del) {
        f32x4 acc = (f32x4){0.f, 0.f, 0.f, 0.f};
#pragma unroll
        for (int s = 0; s < 8; ++s) { const bf16x8 a = *(const bf16x8*)(Vt + (size_t)(16 * del) * 256 + 32 * s); acc = __builtin_amdgcn_mfma_f32_16x16x32_bf16(a, Bp[s], acc, 0, 0, 0); }
        v2u o; o.x = pk2(acc.x * inv, acc.y * inv); o.y = pk2(acc.z * inv, acc.w * inv);
        *(v2u*)(AO + 16 * del) = o;
    }
}

__device__ __forceinline__ unsigned key_enc(float f) { const unsigned u = __builtin_bit_cast(unsigned, f); return (u & 0x80000000u) ? ~u : (u | 0x80000000u); }
__device__ __forceinline__ float key_dec(unsigned k) { const unsigned u = (k & 0x80000000u) ? (k & 0x7fffffffu) : ~k; return __builtin_bit_cast(float, u); }
#define INS16(L, kv) do { unsigned carry_ = (kv); _Pragma("unroll") for (int q_ = 0; q_ < 16; ++q_) { const unsigned hi_ = max(L[q_], carry_); carry_ = min(L[q_], carry_); L[q_] = hi_; } } while (0)
__device__ __forceinline__ void peer_topk_item(const Params& P, LAS unsigned char* lds, int item, int tid, int lane, int wave) {
    const unsigned char* ws = P.ws;
    const int h = item & 7, tile = item >> 3, tt0 = tile * 256;
    LAS float* S = (LAS float*)lds;
    LAS int* tab = (LAS int*)(lds + 140 * 1024);
    if (tid == 0) { int id = 0; for (int a = 0; a < 16; ++a) for (int bq = 0; bq < 16 / (a + 1); ++bq) tab[id++] = a * 16 + bq; }
    const bf16* PQ = (const bf16*)(ws + WS_PQ); const bf16* SUBK = (const bf16*)(ws + WS_SUBK);
    const int col = lane & 15, g = lane >> 4;
    unsigned L1[16], L2[16];
#pragma unroll
    for (int q = 0; q < 16; ++q) { L1[q] = 0u; L2[q] = 0u; }
#pragma unroll
    for (int p = 0; p < 2; ++p) {
        {
            bf16x8 Af[2][4];
#pragma unroll
            for (int rho = 0; rho < 2; ++rho)
#pragma unroll
                for (int s = 0; s < 4; ++s) Af[rho][s] = *(const bf16x8*)(PQ + (size_t)(tt0 + 32 * wave + 16 * rho + col) * 2048 + h * 256 + p * 128 + 32 * s + 8 * g);
#pragma unroll
            for (int kap = 0; kap < 8; ++kap) {
                f32x4 a0 = (f32x4){0.f, 0.f, 0.f, 0.f}, a1 = a0;
#pragma unroll
                for (int s = 0; s < 4; ++s) { const bf16x8 bk = *(const bf16x8*)(SUBK + (size_t)((h * 2 + p) * 128 + 16 * kap + col) * 128 + 32 * s + 8 * g);
                    a0 = __builtin_amdgcn_mfma_f32_16x16x32_bf16(Af[0][s], bk, a0, 0, 0, 0); a1 = __builtin_amdgcn_mfma_f32_16x16x32_bf16(Af[1][s], bk, a1, 0, 0, 0); }
#pragma unroll
                for (int i = 0; i < 4; ++i) { S[(32 * wave + 4 * g + i) * 132 + 16 * kap + col] = a0[i]; S[(32 * wave + 16 + 4 * g + i) * 132 + 16 * kap + col] = a1[i]; }
            }
        }
        __syncthreads();
        if (tid < 256) {
            const LAS float* row = S + tid * 132;
#pragma unroll 2
            for (int k4 = 0; k4 < 32; ++k4) { const f32x4 v = *(const LAS f32x4*)(row + 4 * k4);
#pragma unroll
                for (int e = 0; e < 4; ++e) { const unsigned kv = (key_enc(v[e]) & ~127u) | (unsigned)(127 - (4 * k4 + e));
                    if (p == 0) INS16(L1, kv); else INS16(L2, kv); } }
        }
        __syncthreads();
    }
    if (tid < 256) {
        float v1[16], v2[16];
        LAS int* il = (LAS int*)lds + tid * 33;
#pragma unroll
        for (int q = 0; q < 16; ++q) { v1[q] = key_dec((L1[q] & ~127u) | 64u); v2[q] = key_dec((L2[q] & ~127u) | 64u); il[q] = 127 - (int)(L1[q] & 127u); il[16 + q] = 127 - (int)(L2[q] & 127u); }
        unsigned C[16];
#pragma unroll
        for (int q = 0; q < 16; ++q) C[q] = 0u;
        {
            int id = 0;
#pragma unroll
            for (int a = 0; a < 16; ++a)
#pragma unroll
                for (int bq = 0; bq < 16 / (a + 1); ++bq) { const unsigned kv = (key_enc(v1[a] + v2[bq]) & ~63u) | (unsigned)(63 - id); INS16(C, kv); ++id; }
        }
        LDS_WAIT(); asm volatile("" ::: "memory");
        float best[16], e[16], sum = 0.f; int ex[16];
#pragma unroll
        for (int q = 0; q < 16; ++q) { best[q] = key_dec((C[q] & ~63u) | 32u); const int ab = tab[63 - (int)(C[q] & 63u)]; ex[q] = il[ab >> 4] * 128 + il[16 + (ab & 15)]; }
#pragma unroll
        for (int q = 0; q < 16; ++q) { e[q] = __expf(best[q] - best[0]); sum += e[q]; }
        const float inv = 1.0f / sum;
        int* IDX = (int*)(P.ws + WS_IDX) + ((size_t)(tt0 + tid) * 8 + h) * 16; float* GW = (float*)(P.ws + WS_GW) + ((size_t)(tt0 + tid) * 8 + h) * 16;
#pragma unroll
        for (int q = 0; q < 16; ++q) { IDX[q] = ex[q]; GW[q] = e[q] * inv; }
    }
    __syncthreads();
}

__device__ __forceinline__ void peer_token(const Params& P, int t, int lane) {
    const unsigned char* ws = P.ws;
    float* xrow = P.out + (size_t)t * 1024;
    const float rstd2 = rsqrtf(((const float*)(ws + WS_SSQ2))[t] * (1.0f / 1024.0f) + 1e-6f);
    float x2[16], hn[16], acc[16];
    {
        const f32x4 a0 = *(const f32x4*)(xrow + 8 * lane), a1 = *(const f32x4*)(xrow + 8 * lane + 4), a2 = *(const f32x4*)(xrow + 512 + 8 * lane), a3 = *(const f32x4*)(xrow + 512 + 8 * lane + 4);
        const f32x4 w0 = *(const f32x4*)(P.norm_ffn_w + 8 * lane), w1 = *(const f32x4*)(P.norm_ffn_w + 8 * lane + 4), w2 = *(const f32x4*)(P.norm_ffn_w + 512 + 8 * lane), w3 = *(const f32x4*)(P.norm_ffn_w + 512 + 8 * lane + 4);
#pragma unroll
        for (int i = 0; i < 4; ++i) { x2[i] = a0[i]; x2[4 + i] = a1[i]; x2[8 + i] = a2[i]; x2[12 + i] = a3[i];
            hn[i] = a0[i] * rstd2 * w0[i]; hn[4 + i] = a1[i] * rstd2 * w1[i]; hn[8 + i] = a2[i] * rstd2 * w2[i]; hn[12 + i] = a3[i] * rstd2 * w3[i]; }
    }
#pragma unroll
    for (int i = 0; i < 16; ++i) acc[i] = 0.f;
    const int* IDX = (const int*)(ws + WS_IDX) + (size_t)t * 128; const float* GW = (const float*)(ws + WS_GW) + (size_t)t * 128;
    const bf16* UB = (const bf16*)(ws + WS_UB); const bf16* VB = (const bf16*)(ws + WS_VB);
#pragma unroll 1
    for (int hh = 0; hh < 8; ++hh) {
        const int idv = IDX[hh * 16 + (lane & 15)]; const float gv = GW[hh * 16 + (lane & 15)];
#pragma unroll 1
        for (int half = 0; half < 2; ++half) {
            v4u ur[8][2], vr[8][2];
#pragma unroll
            for (int k = 0; k < 8; ++k) { const int e = __builtin_amdgcn_readlane(idv, half * 8 + k);
                const v4u* up = (const v4u*)(UB + (size_t)e * 1024 + 8 * lane); ur[k][0] = up[0]; ur[k][1] = up[64];
                const v4u* vp = (const v4u*)(VB + (size_t)e * 1024 + 8 * lane); vr[k][0] = vp[0]; vr[k][1] = vp[64]; }
            float d[8];
#pragma unroll
            for (int k = 0; k < 8; ++k) {
                const v4u a = ur[k][0], c = ur[k][1];
                float s = hn[0] * bflo(a.x); s += hn[1] * bfhi(a.x); s += hn[2] * bflo(a.y); s += hn[3] * bfhi(a.y);
                s += hn[4] * bflo(a.z); s += hn[5] * bfhi(a.z); s += hn[6] * bflo(a.w); s += hn[7] * bfhi(a.w);
                s += hn[8] * bflo(c.x); s += hn[9] * bfhi(c.x); s += hn[10] * bflo(c.y); s += hn[11] * bfhi(c.y);
                s += hn[12] * bflo(c.z); s += hn[13] * bfhi(c.z); s += hn[14] * bflo(c.w); s += hn[15] * bfhi(c.w);
                d[k] = s;
            }
            float r4[4], r2[2], r1;
            { const bool up = (lane & 32) != 0;
#pragma unroll
              for (int i = 0; i < 4; ++i) { const float keep = up ? d[4 + i] : d[i], send = up ? d[i] : d[4 + i]; r4[i] = keep + __shfl_xor(send, 32); } }
            { const bool up = (lane & 16) != 0;
#pragma unroll
              for (int i = 0; i < 2; ++i) { const float keep = up ? r4[2 + i] : r4[i], send = up ? r4[i] : r4[2 + i]; r2[i] = keep + __shfl_xor(send, 16); } }
            { const bool up = (lane & 8) != 0; const float keep = up ? r2[1] : r2[0], send = up ? r2[0] : r2[1]; r1 = keep + __shfl_xor(send, 8); }
            r1 += __shfl_xor(r1, 4); r1 += __shfl_xor(r1, 2); r1 += __shfl_xor(r1, 1);
            const int myk = ((lane >> 5) & 1) * 4 + ((lane >> 4) & 1) * 2 + ((lane >> 3) & 1);
            const float act = gelu_tanh(r1) * __shfl(gv, half * 8 + myk);
#pragma unroll
            for (int k = 0; k < 8; ++k) {
                const int srcl = ((k >> 2) & 1) * 32 + ((k >> 1) & 1) * 16 + (k & 1) * 8;
                const float a = __builtin_bit_cast(float, __builtin_amdgcn_readlane(__builtin_bit_cast(int, act), srcl));
                const v4u p = vr[k][0], q = vr[k][1];
                acc[0] += a * bflo(p.x); acc[1] += a * bfhi(p.x); acc[2] += a * bflo(p.y); acc[3] += a * bfhi(p.y);
                acc[4] += a * bflo(p.z); acc[5] += a * bfhi(p.z); acc[6] += a * bflo(p.w); acc[7] += a * bfhi(p.w);
                acc[8] += a * bflo(q.x); acc[9] += a * bfhi(q.x); acc[10] += a * bflo(q.y); acc[11] += a * bfhi(q.y);
                acc[12] += a * bflo(q.z); acc[13] += a * bfhi(q.z); acc[14] += a * bflo(q.w); acc[15] += a * bfhi(q.w);
            }
        }
    }
    float ss = 0.f;
#pragma unroll
    for (int i = 0; i < 16; ++i) { x2[i] += acc[i]; ss += x2[i] * x2[i]; }
    const float rstd3 = rsqrtf(wave_sum(ss) * (1.0f / 1024.0f) + 1e-6f);
    const f32x4 w0 = *(const f32x4*)(P.norm_final_w + 8 * lane), w1 = *(const f32x4*)(P.norm_final_w + 8 * lane + 4), w2 = *(const f32x4*)(P.norm_final_w + 512 + 8 * lane), w3 = *(const f32x4*)(P.norm_final_w + 512 + 8 * lane + 4);
    *(f32x4*)(xrow + 8 * lane) = (f32x4){x2[0] * rstd3 * w0.x, x2[1] * rstd3 * w0.y, x2[2] * rstd3 * w0.z, x2[3] * rstd3 * w0.w};
    *(f32x4*)(xrow + 8 * lane + 4) = (f32x4){x2[4] * rstd3 * w1.x, x2[5] * rstd3 * w1.y, x2[6] * rstd3 * w1.z, x2[7] * rstd3 * w1.w};
    *(f32x4*)(xrow + 512 + 8 * lane) = (f32x4){x2[8] * rstd3 * w2.x, x2[9] * rstd3 * w2.y, x2[10] * rstd3 * w2.z, x2[11] * rstd3 * w2.w};
    *(f32x4*)(xrow + 512 + 8 * lane + 4) = (f32x4){x2[12] * rstd3 * w3.x, x2[13] * rstd3 * w3.y, x2[14] * rstd3 * w3.z, x2[15] * rstd3 * w3.w};
}

__global__ void __launch_bounds__(NWAVES * 64, 2) hybrid_fwd(Params P) {
    extern __shared__ __attribute__((aligned(16))) unsigned char lds_raw[];
    LAS unsigned char* lds = (LAS unsigned char*)lds_raw;
    volatile LAS unsigned* MISC = (volatile LAS unsigned*)(lds + MISC_OFF);
    const int tid = threadIdx.x, lane = tid & 63, wave = __builtin_amdgcn_readfirstlane(tid >> 6);
    const int G = gridDim.x, bx = blockIdx.x;
    const int vcu = (G % 8 == 0) ? (bx % 8) * (G / 8) + bx / 8 : bx;
    unsigned char* ws = P.ws;
    for (int u = tid; u < 64; u += NWAVES * 64) MISC[u] = 0u;
    __syncthreads();
    XcdBarrier bar; bar.bar = (unsigned*)(ws + WS_CTL) + CW_BAR; bar.x = 0; bar.st = nullptr;
    if (!MK_PER_PHASE) bar = xcd_barrier_post((unsigned*)(ws + WS_CTL) + CW_BAR, MISC + 8);
    const int lo = P.ph_lo, hi = P.ph_hi;
#ifndef PHASE_MASK
#define PHASE_MASK 0xFFF
#endif
#define IN(k) (((PHASE_MASK >> (k)) & 1) && lo <= (k) && (k) < hi)
#define SEAM(k) do { if (IN(k) && IN((k) + 1)) xcd_barrier(bar); } while (0)
    using namespace pg8;
    bf16* XB = (bf16*)(ws + WS_XB);

    if (IN(0)) { p0_prologue(P, lds, tid, lane, wave, vcu, G); }
    SEAM(0);
    if (IN(1)) {
        { Gemm gm{XB, (const bf16_t*)(ws + WS_WIN), T, 3072, 1024}; StaticOrder S; S.init(T, 3072, G, bx);
          EpiBf16Rs E{(bf16_t*)(ws + WS_QKV), 1536, 6, (bf16_t*)(ws + WS_XR), 512, (size_t)T * 512, nullptr, 1.0f};
          gemm_phase<EpiBf16Rs, StaticOrder, PG8_ALIGN, PG8_SP2>(lds, gm, S, E); }
        { Gemm gm{(const bf16_t*)(ws + WS_MEMN), (const bf16_t*)(ws + WS_WKV), 512, 2048, 1024}; StaticOrder S; S.init(512, 2048, G, bx);
          EpiKV E{(bf16_t*)(ws + WS_KB), (bf16_t*)(ws + WS_VTP)};
          gemm_phase<EpiKV, StaticOrder, PG8_ALIGN, PG8_SP2>(lds, gm, S, E); }
    }
    SEAM(1);
    if (IN(2)) {
#ifndef NO_GDNL
        for (int it = bx; it < 1024; it += G) gdn_local_item(P, lds, it, tid);
#endif
#ifndef NO_LRUL
        for (int lt = bx; lt < 256; lt += G) lru_local_item(P, lds, lt, tid, lane, wave);
#endif
    }
    SEAM(2);
    if (IN(3)) {
        if (bx < 8) gdn_scan(P, lds, bx, tid, lane, wave);
        else if (bx < 10) lru_carry(P, (bx - 8) * NWAVES + wave, lane);
        else cvt_table(P.peer_u, (bf16*)(ws + WS_UB), (size_t)16384 * 1024 / 8, (size_t)(bx - 10) * (NWAVES * 64) + tid, (size_t)(G - 10) * (NWAVES * 64));
    }
    SEAM(3);
    if (IN(4)) {
        lru_combine(P, (size_t)bx * (NWAVES * 64) + tid, (size_t)G * (NWAVES * 64));
        cvt_table(P.peer_v, (bf16*)(ws + WS_VB), (size_t)16384 * 1024 / 8, (size_t)bx * (NWAVES * 64) + tid, (size_t)G * (NWAVES * 64));
    }
    SEAM(4);
    if (IN(5)) {
        Gemm gm{(const bf16_t*)(ws + WS_Y), (const bf16_t*)(ws + WS_WOUT), T, 1024, 1024}; StaticOrder S; S.init(T, 1024, G, bx);
        EpiResid E{P.x, P.out, XB, (float*)(ws + WS_SSQ1)};
        gemm_phase<EpiResid, StaticOrder, PG8_ALIGN, PG8_SP2>(lds, gm, S, E);
    }
    SEAM(5);
    if (IN(6)) {
        Gemm gm{XB, (const bf16_t*)(ws + WS_WQ), T, 1024, 1024}; StaticOrder S; S.init(T, 1024, G, bx);
        EpiBf16Rs E{(bf16_t*)(ws + WS_Q), 1024, 4, nullptr, 256, 0, (const float*)(ws + WS_SSQ1), 0.0625f};
        gemm_phase<EpiBf16Rs, StaticOrder, PG8_ALIGN, PG8_SP2>(lds, gm, S, E);
    }
    SEAM(6);
    if (IN(7)) {
        for (int wu = bx * NWAVES + wave; wu < 4096; wu += G * NWAVES) xattn_unit(P, wu, lane);
    }
    SEAM(7);
    if (IN(8)) {
        Gemm gm{(const bf16_t*)(ws + WS_AO), (const bf16_t*)(ws + WS_WO), T, 1024, 1024}; StaticOrder S; S.init(T, 1024, G, bx);
        EpiResid E{P.out, P.out, XB, (float*)(ws + WS_SSQ2)};
        gemm_phase<EpiResid, StaticOrder, PG8_ALIGN, PG8_SP2>(lds, gm, S, E);
    }
    SEAM(8);
    if (IN(9)) {
        Gemm gm{XB, (const bf16_t*)(ws + WS_PWQ), T, 2048, 1024}; StaticOrder S; S.init(T, 2048, G, bx);
        EpiBf16Rs E{(bf16_t*)(ws + WS_PQ), 2048, 8, nullptr, 256, 0, (const float*)(ws + WS_SSQ2), 1.0f};
        gemm_phase<EpiBf16Rs, StaticOrder, PG8_ALIGN, PG8_SP2>(lds, gm, S, E);
    }
    SEAM(9);
    if (IN(10)) {
        for (int it = bx; it < 512; it += G) peer_topk_item(P, lds, it, tid, lane, wave);
    }
    SEAM(10);
    if (IN(11)) {
        for (int t = bx * NWAVES + wave; t < T; t += G * NWAVES) peer_token(P, t, lane);
    }
#undef IN
#undef SEAM
}

extern "C" void kernel_launch(void* const* d_in, const int* in_sizes, int n_in, void* d_out, int out_size, void* d_ws, size_t ws_size, hipStream_t stream) {
    static int grid = 0;
    if (grid == 0) {
        if (n_in != 27 || in_sizes[0] != T * D || out_size != T * D || ws_size < WS_END) {
            fprintf(stderr, "kernel_launch: unexpected shapes (n_in %d, in0 %d, out %d, ws %zu); nothing launched\n", n_in, n_in > 0 ? in_sizes[0] : -1, out_size, ws_size); grid = -1; return; }
        int dev = 0, cus = 0, per_cu = 0;
        if (hipGetDevice(&dev) != hipSuccess || hipDeviceGetAttribute(&cus, hipDeviceAttributeMultiprocessorCount, dev) != hipSuccess) { grid = -1; return; }
        if (hipFuncSetAttribute((const void*)hybrid_fwd, hipFuncAttributeMaxDynamicSharedMemorySize, LDS_BYTES) != hipSuccess) { fprintf(stderr, "kernel_launch: hipFuncSetAttribute failed\n"); grid = -1; return; }
        if (hipOccupancyMaxActiveBlocksPerMultiprocessor(&per_cu, (const void*)hybrid_fwd, NWAVES * 64, LDS_BYTES) != hipSuccess || per_cu < 1)
            fprintf(stderr, "kernel_launch: note: occupancy query reports %d workgroups per CU\n", per_cu);
        (void)hipGetLastError();
        grid = cus;
        if (grid != 256) fprintf(stderr, "kernel_launch: %d CUs (built for 256)\n", grid);
    }
    if (grid < 0) return;
    if (hipMemsetAsync((char*)d_ws + WS_CTL, 0, CTL_ZERO_BYTES, stream) != hipSuccess) { fprintf(stderr, "kernel_launch: hipMemsetAsync failed\n"); return; }
    Params p{};
    const float** pp = (const float**)&p;
    for (int i = 0; i < 27; ++i) pp[i] = (const float*)d_in[i];
    p.out = (float*)d_out; p.ws = (unsigned char*)d_ws;
#if MK_PER_PHASE
    for (int k = 0; k < N_PHASES; ++k) { p.ph_lo = k; p.ph_hi = k + 1; hipLaunchKernelGGL(hybrid_fwd, dim3(grid), dim3(NWAVES * 64), LDS_BYTES, stream, p); }
#else
    p.ph_lo = 0; p.ph_hi = N_PHASES;
    hipLaunchKernelGGL(hybrid_fwd, dim3(grid), dim3(NWAVES * 64), LDS_BYTES, stream, p);
#endif
    const hipError_t le = hipPeekAtLastError();
    if (le != hipSuccess) fprintf(stderr, "kernel_launch: launch failed: %s\n", hipGetErrorName(le));
}
```

```cpp
#include <hip/hip_runtime.h>
#include <cstdio>
#include <cstdint>
namespace pg8 {
#define PG8_LAS __attribute__((address_space(3)))
typedef unsigned short bf16_t;
typedef short bf16x8 __attribute__((ext_vector_type(8)));
typedef float f32x4 __attribute__((ext_vector_type(4)));
typedef unsigned u32x4 __attribute__((ext_vector_type(4)));
constexpr int BM = 256, BK = 64, HALF = 128, HTB = HALF * BK * 2  , STAGE_BYTES = 8 * HTB, NXCD = 8, WGM = 8;

__host__ __device__ __forceinline__ int lds_byte(int r, int c) { const int st = (r >> 4) * 2 + (c >> 5), rr = r & 15, cc = c & 31, ob = rr * 64 + cc * 2; return st * 1024 + (ob ^ (((ob >> 9) & 1) << 5)); }
__host__ __device__ __forceinline__ void stage_rc(int b, int& R, int& C) { const int st = b / 1024, sb = b % 1024, swz = sb ^ (((sb >> 9) & 1) << 5); R = (st >> 1) * 16 + swz / 64; C = (st & 1) * 32 + (swz % 64) / 2; }
__host__ __device__ __forceinline__ int perm32(int rho) { const int n = rho >> 4, i = rho & 15; return 8 * (i >> 2) + 4 * n + (i & 3); }

struct Unit { int pm, pn; };
struct Gemm { const bf16_t* A; const bf16_t* Bt; int M, N, K; };

struct StaticOrder {
    int nM, nN, nwg, G, c;
    __host__ __device__ void init(int M, int N, int G_, int c_) { nM = M / BM; nN = N / BM; nwg = nM * nN; G = G_; c = c_; }
    __host__ __device__ bool next(int i, Unit& u) const {
        const long L = (long)i * G + c; if (L >= nwg) return false;
        int wgid = (int)L; { const int q = nwg / NXCD, r = nwg % NXCD, xcd = wgid % NXCD, off = wgid / NXCD; wgid = (xcd < r ? xcd * (q + 1) : r * (q + 1) + (xcd - r) * q) + off; }
        const int nig = WGM * nN, gid = wgid / nig, fm = gid * WGM, gsz = (nM - fm) < WGM ? (nM - fm) : WGM;
        u.pm = fm + ((wgid % nig) % gsz); u.pn = (wgid % nig) / gsz; return true;
    }
    __device__ __forceinline__ void a_ready(const Unit&) const {}
    __device__ __forceinline__ void done(const Unit&) const {}
};

__device__ __forceinline__ unsigned cvt_pk_bf16(float lo, float hi) { unsigned r; asm volatile("v_cvt_pk_bf16_f32 %0, %1, %2" : "=v"(r) : "v"(lo), "v"(hi)); return r; }
template <class Epi, class Sched, bool ALIGN_EPI = false, bool SP2 = false>
__device__ __forceinline__ void gemm_phase(PG8_LAS unsigned char* lds, const Gemm g, const Sched& S, const Epi& E) {
    const int tid = threadIdx.x, wid = __builtin_amdgcn_readfirstlane(tid >> 6), lane = tid & 63, wr = wid >> 2, wc = wid & 3, fr = lane & 15, fq = lane >> 4;
    const int K = g.K, nt = K / BK;
    unsigned voffA[2], voffB[2];
#pragma unroll
    for (int i = 0; i < 2; ++i) { int R, C; stage_rc(tid * 16 + i * 8192, R, C); const int Rb = Epi::PERM ? ((R & ~31) + perm32(R & 31)) : R;
        voffA[i] = (unsigned)(R * K + C) * 2u; voffB[i] = (unsigned)(Rb * K + C) * 2u; }
    const size_t kstep = (size_t)(BK * 2);
    const size_t hstep = (size_t)HALF * K * 2;
    const size_t tstep = 2 * hstep;
    const unsigned ldsw = (unsigned)wid * 1024u;
    const int aoff = lds_byte(wr * 64 + fr, fq * 8), boff = lds_byte(wc * 32 + fr, fq * 8);
#define PG8_SA(b, h) (((b) * 2 + (h)) * HTB)
#define PG8_SB(b, h) ((4 + (b) * 2 + (h)) * HTB)
#define PG8_STAGE(bufoff, gbase, voff) do { _Pragma("unroll") for (int _i = 0; _i < 2; ++_i) \
        __builtin_amdgcn_global_load_lds((const unsigned*)((const char*)(gbase) + (voff)[_i]), (PG8_LAS unsigned*)(lds + (bufoff) + ldsw + _i * 8192), 16, 0, 0); } while (0)
#define PG8_LDA(dst, b, h) do { _Pragma("unroll") for (int m = 0; m < 4; ++m) _Pragma("unroll") for (int k = 0; k < 2; ++k) dst[m][k] = *(const PG8_LAS bf16x8*)(lds + PG8_SA(b, h) + aoff + m * 2048 + k * 1024); } while (0)
#define PG8_LDB(dst, b, h) do { _Pragma("unroll") for (int n = 0; n < 2; ++n) _Pragma("unroll") for (int k = 0; k < 2; ++k) dst[n][k] = *(const PG8_LAS bf16x8*)(lds + PG8_SB(b, h) + boff + n * 2048 + k * 1024); } while (0)
#define PG8_MMA(ai, bj, At, Bt) do { __builtin_amdgcn_s_setprio(1); _Pragma("unroll") for (int m = 0; m < 4; ++m) _Pragma("unroll") for (int n = 0; n < 2; ++n) _Pragma("unroll") for (int k = 0; k < 2; ++k) \
        acc[ai][bj][m][n] = __builtin_amdgcn_mfma_f32_16x16x32_bf16(Bt[n][k], At[m][k], acc[ai][bj][m][n], 0, 0, 0); __builtin_amdgcn_s_setprio(0); } while (0)
#define PG8_WAIT_V(n) asm volatile("s_waitcnt vmcnt(" #n ")" ::: "memory")
#define PG8_WAIT_L(n) asm volatile("s_waitcnt lgkmcnt(" #n ")" ::: "memory")
#define PG8_BAR __builtin_amdgcn_s_barrier()
#define PG8_SCHED __builtin_amdgcn_sched_barrier(0)
    Unit cur, nxt; int ui = 0;
    if (!S.next(0, cur)) return;
    f32x4 acc[2][2][4][2];
#pragma unroll
    for (int a = 0; a < 2; ++a)
#pragma unroll
        for (int b = 0; b < 2; ++b)
#pragma unroll
            for (int m = 0; m < 4; ++m)
#pragma unroll
                for (int n = 0; n < 2; ++n) acc[a][b][m][n] = (f32x4){0.f, 0.f, 0.f, 0.f};
    bf16x8 At[4][2], B0[2][2], B1[2][2];
    const char* cA = (const char*)g.A + (size_t)cur.pm * tstep; const char* cB = (const char*)g.Bt + (size_t)cur.pn * tstep;
    S.a_ready(cur);
    if constexpr (SP2) {
        PG8_STAGE(PG8_SB(0, 0), cB, voffB); PG8_STAGE(PG8_SB(0, 1), cB + hstep, voffB); PG8_STAGE(PG8_SA(0, 0), cA, voffA); PG8_STAGE(PG8_SA(0, 1), cA + hstep, voffA);
        if (wr == 1) PG8_BAR;
        PG8_WAIT_V(2); PG8_BAR;
        PG8_STAGE(PG8_SB(1, 0), cB + kstep, voffB); PG8_STAGE(PG8_SA(1, 0), cA + kstep, voffA); PG8_STAGE(PG8_SB(1, 1), cB + hstep + kstep, voffB);
        PG8_WAIT_V(6); PG8_BAR;
    } else {
        PG8_STAGE(PG8_SB(0, 0), cB, voffB); PG8_STAGE(PG8_SA(0, 0), cA, voffA); PG8_STAGE(PG8_SB(0, 1), cB + hstep, voffB); PG8_STAGE(PG8_SA(0, 1), cA + hstep, voffA);
        if (wr == 1) PG8_BAR;
        PG8_WAIT_V(4); PG8_BAR;
        PG8_STAGE(PG8_SB(1, 0), cB + kstep, voffB); PG8_STAGE(PG8_SA(1, 0), cA + kstep, voffA); PG8_STAGE(PG8_SB(1, 1), cB + hstep + kstep, voffB);
        PG8_WAIT_V(6); PG8_BAR;
    }
    for (;;) {
        const bool has_next = S.next(ui + 1, nxt);
        const char* nA = has_next ? (const char*)g.A + (size_t)nxt.pm * tstep : cA; const char* nB = has_next ? (const char*)g.Bt + (size_t)nxt.pn * tstep : cB;
        for (int t = 0; t < nt; t += 2) {
            const bool last = (t == nt - 2);
            const char* a1 = cA + (size_t)(t + 1) * kstep;
            const char* a2 = last ? nA : cA + (size_t)(t + 2) * kstep; const char* b2 = last ? nB : cB + (size_t)(t + 2) * kstep;
            const char* a3 = a2 + kstep; const char* b3 = b2 + kstep;
            if (last && has_next) S.a_ready(nxt);
            if constexpr (SP2) {
            PG8_LDB(B0, 0, 0); PG8_LDB(B1, 0, 1); PG8_SCHED; PG8_LDA(At, 0, 0); PG8_STAGE(PG8_SA(1, 1), a1 + hstep, voffA);
            PG8_WAIT_V(8); PG8_WAIT_L(0); PG8_BAR; PG8_MMA(0, 0, At, B0); PG8_MMA(0, 1, At, B1); PG8_BAR; PG8_SCHED;
            PG8_LDA(At, 0, 1); PG8_STAGE(PG8_SB(0, 0), b2, voffB); PG8_STAGE(PG8_SB(0, 1), b2 + hstep, voffB); PG8_STAGE(PG8_SA(0, 0), a2, voffA);
            PG8_WAIT_V(8); PG8_WAIT_L(0); PG8_BAR; PG8_MMA(1, 0, At, B0); PG8_MMA(1, 1, At, B1); PG8_BAR; PG8_SCHED;
            PG8_LDB(B0, 1, 0); PG8_LDB(B1, 1, 1); PG8_SCHED; PG8_LDA(At, 1, 0); PG8_STAGE(PG8_SA(0, 1), a2 + hstep, voffA);
            PG8_WAIT_V(8); PG8_WAIT_L(0); PG8_BAR; PG8_MMA(0, 0, At, B0); PG8_MMA(0, 1, At, B1); PG8_BAR; PG8_SCHED;
            PG8_LDA(At, 1, 1); PG8_STAGE(PG8_SB(1, 0), b3, voffB); PG8_STAGE(PG8_SB(1, 1), b3 + hstep, voffB); PG8_STAGE(PG8_SA(1, 0), a3, voffA);
            PG8_WAIT_V(8); PG8_WAIT_L(0); PG8_BAR; PG8_MMA(1, 0, At, B0); PG8_MMA(1, 1, At, B1); PG8_BAR; PG8_SCHED;
            } else {
            PG8_LDB(B0, 0, 0); PG8_SCHED; PG8_LDA(At, 0, 0); PG8_STAGE(PG8_SA(1, 1), a1 + hstep, voffA);
            PG8_WAIT_L(8); PG8_BAR; PG8_WAIT_L(0); PG8_MMA(0, 0, At, B0); PG8_BAR; PG8_SCHED;
            PG8_LDB(B1, 0, 1); PG8_STAGE(PG8_SB(0, 0), b2, voffB);
            PG8_BAR; PG8_WAIT_L(0); PG8_MMA(0, 1, At, B1); PG8_BAR;
            PG8_LDA(At, 0, 1); PG8_STAGE(PG8_SA(0, 0), a2, voffA);
            PG8_BAR; PG8_WAIT_L(0); PG8_MMA(1, 0, At, B0); PG8_BAR; PG8_SCHED;
            PG8_STAGE(PG8_SB(0, 1), b2 + hstep, voffB);
            PG8_WAIT_V(6); PG8_BAR; PG8_MMA(1, 1, At, B1); PG8_BAR;
            PG8_LDB(B0, 1, 0); PG8_SCHED; PG8_LDA(At, 1, 0); PG8_STAGE(PG8_SA(0, 1), a2 + hstep, voffA);
            PG8_WAIT_L(8); PG8_BAR; PG8_WAIT_L(0); PG8_MMA(0, 0, At, B0); PG8_BAR; PG8_SCHED;
            PG8_LDB(B1, 1, 1); PG8_STAGE(PG8_SB(1, 0), b3, voffB);
            PG8_BAR; PG8_WAIT_L(0); PG8_MMA(0, 1, At, B1); PG8_BAR;
            PG8_LDA(At, 1, 1); PG8_STAGE(PG8_SA(1, 0), a3, voffA);
            PG8_BAR; PG8_WAIT_L(0); PG8_MMA(1, 0, At, B0); PG8_BAR; PG8_SCHED;
            PG8_STAGE(PG8_SB(1, 1), b3 + hstep, voffB);
            PG8_WAIT_V(6); PG8_BAR; PG8_MMA(1, 1, At, B1); PG8_BAR;
            }
        }
        if constexpr (ALIGN_EPI) { if (wr == 0) PG8_BAR; }
        if constexpr (!Epi::AFTER_DRAIN) { E(acc, cur, wr, wc, fr, fq); S.done(cur); }
        if (!has_next) break;
#pragma unroll
        for (int a = 0; a < 2; ++a)
#pragma unroll
            for (int b = 0; b < 2; ++b)
#pragma unroll
                for (int m = 0; m < 4; ++m)
#pragma unroll
                    for (int n = 0; n < 2; ++n) acc[a][b][m][n] = (f32x4){0.f, 0.f, 0.f, 0.f};
        cur = nxt; cA = nA; cB = nB; ++ui;
        if constexpr (ALIGN_EPI) { if (wr == 1) PG8_BAR; }
    }
    PG8_WAIT_V(0);
    if constexpr (!ALIGN_EPI) { if (wr == 0) PG8_BAR; }
    PG8_BAR;
    if constexpr (Epi::AFTER_DRAIN) { E.fused(acc, cur, wr, wc, fr, fq, lds, wid, lane); S.done(cur); }
#undef PG8_SA
#undef PG8_SB
#undef PG8_STAGE
#undef PG8_LDA
#undef PG8_LDB
#undef PG8_MMA
#undef PG8_WAIT_V
#undef PG8_WAIT_L
#undef PG8_BAR
#undef PG8_SCHED
}
}

namespace pg8 {
__host__ __device__ __forceinline__ int permk(int kl) { return 8 * ((kl & 15) >> 2) + 4 * (kl >> 4) + (kl & 3); }
struct EpiBf16Rs {
    static constexpr bool PERM = true, AFTER_DRAIN = false;
    bf16_t* O0; int ld0; int ntile0; bf16_t* O1; int ld1; size_t stride1; const float* ssq; float cs;
    __device__ __forceinline__ void operator()(const f32x4 (&acc)[2][2][4][2], const Unit& u, int wr, int wc, int fr, int fq) const {
        bf16_t* base; int ld, colt;
        if (u.pn < ntile0) { base = O0; ld = ld0; colt = u.pn * BM; }
        else { const int q = u.pn - ntile0, per = ld1 / BM; base = O1 + (size_t)(q / per) * stride1; ld = ld1; colt = (q % per) * BM; }
        const int row0 = u.pm * BM + wr * 64 + fr, col0 = colt + wc * 32 + 8 * fq;
#pragma unroll
        for (int ai = 0; ai < 2; ++ai)
#pragma unroll
            for (int m = 0; m < 4; ++m) {
                const int row = row0 + ai * HALF + m * 16;
                float sc = cs; if (ssq) sc *= rsqrtf(ssq[row] * (1.0f / 1024.0f) + 1e-6f);
                bf16_t* rowp = base + (size_t)row * ld + col0;
#pragma unroll
                for (int bj = 0; bj < 2; ++bj) { const f32x4 v0 = acc[ai][bj][m][0] * sc, v1 = acc[ai][bj][m][1] * sc;
                    u32x4 w; w.x = cvt_pk_bf16(v0[0], v0[1]); w.y = cvt_pk_bf16(v0[2], v0[3]); w.z = cvt_pk_bf16(v1[0], v1[1]); w.w = cvt_pk_bf16(v1[2], v1[3]);
                    *(u32x4*)(rowp + bj * HALF) = w; } }
    }
};
struct EpiResid {
    static constexpr bool PERM = false, AFTER_DRAIN = false;
    const float* base; float* out; bf16_t* xb; float* ssq;
    __device__ __forceinline__ void operator()(const f32x4 (&acc)[2][2][4][2], const Unit& u, int wr, int wc, int fr, int fq) const {
        typedef unsigned u32x2v __attribute__((ext_vector_type(2)));
        const int row0 = u.pm * BM + wr * 64 + fr, col0 = u.pn * BM + wc * 32 + 4 * fq;
#pragma unroll
        for (int ai = 0; ai < 2; ++ai)
#pragma unroll
            for (int m = 0; m < 4; ++m) {
                const int row = row0 + ai * HALF + m * 16; const size_t off = (size_t)row * 1024 + col0; float s = 0.f;
#pragma unroll
                for (int bj = 0; bj < 2; ++bj)
#pragma unroll
                    for (int n = 0; n < 2; ++n) { const size_t o2 = off + bj * HALF + n * 16;
                        const f32x4 o = *(const f32x4*)(base + o2) + acc[ai][bj][m][n];
                        *(f32x4*)(out + o2) = o; s += (o[0] * o[0] + o[1] * o[1]) + (o[2] * o[2] + o[3] * o[3]);
                        u32x2v w; w.x = cvt_pk_bf16(o[0], o[1]); w.y = cvt_pk_bf16(o[2], o[3]); *(u32x2v*)(xb + o2) = w; }
                s += __shfl_xor(s, 16); s += __shfl_xor(s, 32);
                if (fq == 0) atomicAdd(ssq + row, s);
            }
    }
};
struct EpiKV {
    static constexpr bool PERM = false, AFTER_DRAIN = false;
    bf16_t* Kb; bf16_t* VTp;
    __device__ __forceinline__ void operator()(const f32x4 (&acc)[2][2][4][2], const Unit& u, int wr, int wc, int fr, int fq) const {
        typedef unsigned u32x2v __attribute__((ext_vector_type(2)));
        const int row0 = u.pm * BM + wr * 64 + fr, col0 = u.pn * BM + wc * 32 + 4 * fq;
#pragma unroll
        for (int ai = 0; ai < 2; ++ai)
#pragma unroll
            for (int m = 0; m < 4; ++m) {
                const int row = row0 + ai * HALF + m * 16, b = row >> 8, key = row & 255;
#pragma unroll
                for (int bj = 0; bj < 2; ++bj)
#pragma unroll
                    for (int n = 0; n < 2; ++n) { const int col = col0 + bj * HALF + n * 16; const f32x4 v = acc[ai][bj][m][n];
                        const unsigned p01 = cvt_pk_bf16(v[0], v[1]), p23 = cvt_pk_bf16(v[2], v[3]);
                        if (col < 1024) { const int h = col >> 8, dh = col & 255; u32x2v w; w.x = p01; w.y = p23;
                            *(u32x2v*)(Kb + ((size_t)((b * 4 + h) * 256 + key)) * 256 + dh) = w; }
                        else { const int c2 = col - 1024, h = c2 >> 8, dv = c2 & 255, kp = (key & ~31) | permk(key & 31);
                            bf16_t* d = VTp + ((size_t)((b * 4 + h) * 256 + dv)) * 256 + kp;
                            d[0] = (bf16_t)(p01 & 0xffffu); d[256] = (bf16_t)(p01 >> 16); d[512] = (bf16_t)(p23 & 0xffffu); d[768] = (bf16_t)(p23 >> 16); } }
            }
    }
};
}
#ifndef PG8_SP2
#define PG8_SP2 true
#endif
#ifndef PG8_ALIGN
#define PG8_ALIGN true
#endif

constexpr int NWAVES = 8;
#ifndef MK_PER_PHASE
#define MK_PER_PHASE 0
#endif
constexpr int T = 16384, SEQ = 8192, D = 1024;
constexpr int N_PHASES = 12;

constexpr size_t MiB = 1u << 20, KiB = 1u << 10;
constexpr size_t WS_CTL = 0, CTL_ZERO_BYTES = 1 * MiB;
constexpr int CW_BAR = 4096;
constexpr size_t WS_SSQ1 = 64 * KiB, WS_SSQ2 = 128 * KiB;
constexpr size_t WS_AB = 1 * MiB;
constexpr size_t WS_HEND = WS_AB + 512 * KiB, WS_PEND = WS_HEND + 512 * KiB, WS_HIN = WS_PEND + 512 * KiB;
constexpr size_t WS_DEC = WS_HIN + 512 * KiB;
constexpr size_t WS_SUBK = 3 * MiB + 256 * KiB;
constexpr size_t WS_WIN = 4 * MiB, WS_WOUT = 10 * MiB, WS_WQ = 12 * MiB, WS_WKV = 14 * MiB, WS_WO = 18 * MiB, WS_PWQ = 20 * MiB;
constexpr size_t WS_MEMN = 24 * MiB, WS_KB = 25 * MiB, WS_VTP = 26 * MiB;
constexpr size_t WS_XB = 28 * MiB;
constexpr size_t WS_HLOC = 28 * MiB, WS_PCUM = 44 * MiB;
constexpr size_t WS_QKV = 60 * MiB;
constexpr size_t WS_Y = 60 * MiB;
constexpr size_t WS_IDX = 60 * MiB, WS_GW = 68 * MiB;
constexpr size_t WS_UB = 92 * MiB;
constexpr size_t WS_XR = 108 * MiB, WS_Z = 124 * MiB, WS_GATE = 140 * MiB;
constexpr size_t WS_WN = 156 * MiB, WS_UF = 172 * MiB, WS_QD = 188 * MiB, WS_KD = 204 * MiB, WS_ATT = 220 * MiB;
constexpr size_t WS_VB = 156 * MiB;
constexpr size_t WS_Q = 188 * MiB, WS_AO = 220 * MiB;
constexpr size_t WS_PQ = 188 * MiB;
constexpr size_t WS_END = 252 * MiB;
static_assert(WS_XR - WS_QKV == (size_t)T * 1536 * 2 && WS_Z - WS_XR == (size_t)T * 512 * 2 && WS_GATE - WS_Z == (size_t)T * 512 * 2, "in-proj outputs are contiguous");

constexpr int LDS_BYTES = 160 * 1024;
constexpr int MISC_OFF = 159 * 1024;

#define GAS __attribute__((address_space(1)))
#define LAS __attribute__((address_space(3)))
typedef unsigned short bf16;
typedef unsigned v4u __attribute__((ext_vector_type(4)));
typedef unsigned v2u __attribute__((ext_vector_type(2)));
typedef float f32x4 __attribute__((ext_vector_type(4)));
typedef short bf16x8 __attribute__((ext_vector_type(8)));
typedef GAS unsigned gu32;
#define LDS_WAIT() asm volatile("s_waitcnt lgkmcnt(0)" ::: "memory")
__device__ __forceinline__ unsigned f2bf(float f) { unsigned u = __builtin_bit_cast(unsigned, f); return (u + 0x7fffu + ((u >> 16) & 1u)) >> 16; }
__device__ __forceinline__ unsigned pk2(float lo, float hi) { return f2bf(lo) | (f2bf(hi) << 16); }
__device__ __forceinline__ float bflo(unsigned u) { return __builtin_bit_cast(float, u << 16); }
__device__ __forceinline__ float bfhi(unsigned u) { return __builtin_bit_cast(float, u & 0xffff0000u); }
__device__ __forceinline__ float bf1(bf16 h) { return __builtin_bit_cast(float, (unsigned)h << 16); }
__device__ __forceinline__ float wave_sum(float v) {
#pragma unroll
    for (int o = 1; o < 64; o <<= 1) v += __shfl_xor(v, o);
    return v;
}
__device__ __forceinline__ float sigmoidf_(float x) { return 1.0f / (1.0f + __expf(-x)); }
__device__ __forceinline__ float softplusf_(float x) { return fmaxf(x, 0.f) + log1pf(__expf(-fabsf(x))); }
__device__ __forceinline__ float siluf_(float x) { return x / (1.0f + __expf(-x)); }
__device__ __forceinline__ float gelu_tanh(float x) { const float y = 0.7978845608028654f * (x + 0.044715f * x * x * x); const float e = __expf(2.0f * y); return 0.5f * x * (2.0f - 2.0f / (1.0f + e)); }
__device__ __forceinline__ int permk(int kl) { return 8 * ((kl & 15) >> 2) + 4 * (kl >> 4) + (kl & 3); }

struct Params {
    const float *x, *mem, *norm_mix_w, *w_in, *conv_qkv_w, *gdn_a_log, *gdn_dt_bias, *gdn_norm_w, *lru_conv_w, *lru_conv_b, *lru_wa, *lru_ba, *lru_wx, *lru_bx, *lru_lambda, *w_out,
                *norm_xattn_w, *norm_mem_w, *xattn_wq, *xattn_wkv, *xattn_wo, *norm_ffn_w, *peer_wq, *peer_subkeys, *peer_u, *peer_v, *norm_final_w;
    float* out; unsigned char* ws; int ph_lo, ph_hi;
};
#define XB_TMO      128
#define XB_XCNT(j)  (256  + 64 * (j))
#define XB_XSUB(j)  (1280 + 64 * (j))
#define XB_XGEN(j)  (2304 + 64 * (j))
#define XB_TOP      3328
#define XB_TOPGEN   3392
#define XCD_BAR_WORDS 3456
#define XB_SPIN_CAP (1u << 18)

__device__ __forceinline__ unsigned xb_ld(unsigned* p)              { return __hip_atomic_load(p, __ATOMIC_RELAXED, __HIP_MEMORY_SCOPE_AGENT); }
__device__ __forceinline__ unsigned xb_add(unsigned* p, unsigned v) { return __hip_atomic_fetch_add(p, v, __ATOMIC_RELAXED, __HIP_MEMORY_SCOPE_AGENT); }
__device__ __forceinline__ unsigned xb_xcc_id() { return (unsigned)__builtin_amdgcn_s_getreg((3 << 11) | 20) & 0xFu; }
#define XB_SPIN(cond, bar) do { unsigned _sp = 0; while (cond) { __builtin_amdgcn_s_sleep(1); \
    if ((++_sp & 255u) == 0u) { if (xb_ld(&(bar)[XB_TMO])) break; if (_sp > XB_SPIN_CAP) { atomicAdd(&(bar)[XB_TMO], 1u); break; } } } } while (0)

struct XcdBarrier {
    unsigned* bar; unsigned x;
    volatile LAS unsigned* st;
};

__device__ __forceinline__ XcdBarrier xcd_barrier_post(unsigned* bar, volatile LAS unsigned* st) {
    XcdBarrier b; b.bar = bar; b.x = xb_xcc_id(); b.st = st;
    if (threadIdx.x == 0) (void)xb_add(&bar[XB_XCNT(b.x)], 1u);
    return b;
}
__device__ __forceinline__ void xcd_barrier_complete(unsigned* bar, unsigned x, unsigned& nloc, unsigned& nx) {
    const unsigned G = gridDim.x * gridDim.y * gridDim.z;
    unsigned sum, cnt, mine, sp = 0u;
    for (;;) {
        sum = 0u; cnt = 0u; mine = 0u;
#pragma unroll
        for (unsigned j = 0; j < 16; ++j) { const unsigned c = xb_ld(&bar[XB_XCNT(j)]); sum += c; cnt += (c > 0u) ? 1u : 0u; mine = (j == x) ? c : mine; }
        if (sum == G) break;
        __builtin_amdgcn_s_sleep(1);
        if ((++sp & 255u) == 0u) { if (xb_ld(&bar[XB_TMO])) break; if (sp > XB_SPIN_CAP) { atomicAdd(&bar[XB_TMO], 1u); break; } }
    }
    nloc = mine > 0u ? mine : 1u; nx = cnt > 0u ? cnt : 1u;
}

__device__ __forceinline__ void xcd_barrier(const XcdBarrier& b) {
    asm volatile("s_waitcnt vmcnt(0)" ::: "memory");
    __syncthreads();
    if (threadIdx.x == 0) {
        unsigned* bar = b.bar;
        __builtin_amdgcn_s_waitcnt(0);
        unsigned nloc = b.st[0], nx = b.st[1];
        if (nloc == 0u) { xcd_barrier_complete(bar, b.x, nloc, nx); b.st[0] = nloc; b.st[1] = nx; }
        const unsigned old = xb_add(&bar[XB_XSUB(b.x)], 1u);
        const unsigned gen = old / nloc;
        if (old + 1u == (gen + 1u) * nloc) {
            __builtin_amdgcn_fence(__ATOMIC_RELEASE, "agent");
            asm volatile("s_waitcnt vmcnt(0)" ::: "memory");
            const unsigned og = xb_add(&bar[XB_TOP], 1u);
            const unsigned tg = og / nx;
            if (og + 1u == (tg + 1u) * nx) xb_add(&bar[XB_TOPGEN], 1u);
            else XB_SPIN(xb_ld(&bar[XB_TOPGEN]) == tg, bar);
            __builtin_amdgcn_fence(__ATOMIC_ACQUIRE, "agent");
            xb_add(&bar[XB_XGEN(b.x)], 1u);
            asm volatile("s_waitcnt vmcnt(0)" ::: "memory");
        } else {
            XB_SPIN(xb_ld(&bar[XB_XGEN(b.x)]) == gen, bar);
            __builtin_amdgcn_fence(__ATOMIC_ACQUIRE, "agent");
            asm volatile("s_waitcnt vmcnt(0)" ::: "memory");
        }
    }
    __syncthreads();
}

__device__ __forceinline__ void p0_transpose_item(const float* W, int K, int ldw, int c0, int nblk, bf16* WT, int row_off, const float* ks, LAS float* scr, int item, int lane) {
    const int kb = item / nblk, nb = item % nblk, k0 = 64 * kb, n0 = 32 * nb;
#pragma unroll 8
    for (int i = 0; i < 32; ++i) { const int kk = 2 * i + (lane >> 5); float v = W[(size_t)(k0 + kk) * ldw + c0 + n0 + (lane & 31)]; if (ks) v *= ks[k0 + kk]; scr[kk * 33 + (lane & 31)] = v; }
    LDS_WAIT(); asm volatile("" ::: "memory");
    const int c = lane & 7;
#pragma unroll
    for (int j = 0; j < 4; ++j) { const int n = (lane >> 3) + 8 * j; const LAS float* s = scr + (8 * c) * 33 + n;
        v4u o; o.x = pk2(s[0 * 33], s[1 * 33]); o.y = pk2(s[2 * 33], s[3 * 33]); o.z = pk2(s[4 * 33], s[5 * 33]); o.w = pk2(s[6 * 33], s[7 * 33]);
        *(GAS v4u*)(WT + (size_t)(row_off + n0 + n) * K + k0 + 8 * c) = o; }
    LDS_WAIT(); asm volatile("" ::: "memory");
}

__device__ __forceinline__ void p0_prologue(const Params& P, LAS unsigned char* lds, int tid, int lane, int wave, int vcu, int G) {
    unsigned char* ws = P.ws;
    const int gw = vcu * NWAVES + wave, NGW = G * NWAVES;
    LAS float* wabl = (LAS float*)lds;
    for (int idx = tid; idx < 8192; idx += NWAVES * 64) { const int k = idx >> 3, c = idx & 7, j = k >> 8, l = (k >> 2) & 63, e = k & 3;
        wabl[((((j * 4 + e) * 2 + (c >> 2)) * 64 + l) << 2) + (c & 3)] = P.w_in[(size_t)k * 3080 + 2048 + c]; }
    __syncthreads();
    {
        bf16* XB0 = (bf16*)(ws + WS_XB); float* AB = (float*)(ws + WS_AB);
        f32x4 w4[4];
#pragma unroll
        for (int j = 0; j < 4; ++j) w4[j] = ((const f32x4*)P.norm_mix_w)[64 * j + lane];
        for (int m = gw; m < T; m += NGW) {
            const f32x4* xr = (const f32x4*)(P.x + (size_t)m * D) + lane;
            f32x4 v[4]; float s = 0.f;
#pragma unroll
            for (int j = 0; j < 4; ++j) { v[j] = xr[64 * j]; s += (v[j].x * v[j].x + v[j].y * v[j].y) + (v[j].z * v[j].z + v[j].w * v[j].w); }
            const float rstd = rsqrtf(wave_sum(s) * (1.0f / D) + 1e-6f);
            v2u* o8 = (v2u*)(XB0 + (size_t)m * D) + lane;
            float part[8];
#pragma unroll
            for (int c = 0; c < 8; ++c) part[c] = 0.f;
#pragma unroll
            for (int j = 0; j < 4; ++j) {
                v[j] = v[j] * rstd * w4[j];
                v2u o; o.x = pk2(v[j].x, v[j].y); o.y = pk2(v[j].z, v[j].w); o8[64 * j] = o;
#pragma unroll
                for (int e = 0; e < 4; ++e) {
                    const f32x4 wa = *(const LAS f32x4*)(wabl + ((((j * 4 + e) * 2 + 0) * 64 + lane) << 2));
                    const f32x4 wb = *(const LAS f32x4*)(wabl + ((((j * 4 + e) * 2 + 1) * 64 + lane) << 2));
                    const float hv = v[j][e];
                    part[0] += hv * wa.x; part[1] += hv * wa.y; part[2] += hv * wa.z; part[3] += hv * wa.w;
                    part[4] += hv * wb.x; part[5] += hv * wb.y; part[6] += hv * wb.z; part[7] += hv * wb.w;
                }
            }
#pragma unroll
            for (int c = 0; c < 8; ++c) part[c] = wave_sum(part[c]);
            float o = part[0];
#pragma unroll
            for (int c = 1; c < 8; ++c) o = (lane == c) ? part[c] : o;
            if (lane < 8) AB[(size_t)m * 8 + lane] = o;
        }
    }
    {
        bf16* MEMN = (bf16*)(ws + WS_MEMN);
        for (int m = gw; m < 512; m += NGW) {
            const f32x4* xr = (const f32x4*)(P.mem + (size_t)m * D) + lane;
            f32x4 v[4]; float s = 0.f;
#pragma unroll
            for (int j = 0; j < 4; ++j) { v[j] = xr[64 * j]; s += (v[j].x * v[j].x + v[j].y * v[j].y) + (v[j].z * v[j].z + v[j].w * v[j].w); }
            const float rstd = rsqrtf(wave_sum(s) * (1.0f / D) + 1e-6f);
            v2u* o8 = (v2u*)(MEMN + (size_t)m * D) + lane;
#pragma unroll
            for (int j = 0; j < 4; ++j) { const f32x4 w = ((const f32x4*)P.norm_mem_w)[64 * j + lane]; const f32x4 y = v[j] * rstd * w;
                v2u o; o.x = pk2(y.x, y.y); o.y = pk2(y.z, y.w); o8[64 * j] = o; }
        }
    }
    __syncthreads();
    {
        LAS float* scr = (LAS float*)(lds + wave * 16384);
        constexpr int I_IN1 = 16 * 48, I_IN2 = 16 * 16, I_OUT = 16 * 32, I_Q = 16 * 32, I_KV = 16 * 64, I_O = 16 * 32, I_PQ = 16 * 64;
        constexpr int NITEMS = I_IN1 + 3 * I_IN2 + I_OUT + I_Q + I_KV + I_O + I_PQ;
        for (int it = gw; it < NITEMS; it += NGW) {
            int r = it;
            if (r < I_IN1) { p0_transpose_item(P.w_in, 1024, 3080, 0, 48, (bf16*)(ws + WS_WIN), 0, nullptr, scr, r, lane); continue; } r -= I_IN1;
            if (r < I_IN2) { p0_transpose_item(P.w_in, 1024, 3080, 2056, 16, (bf16*)(ws + WS_WIN), 1536, nullptr, scr, r, lane); continue; } r -= I_IN2;
            if (r < I_IN2) { p0_transpose_item(P.w_in, 1024, 3080, 1536, 16, (bf16*)(ws + WS_WIN), 2048, nullptr, scr, r, lane); continue; } r -= I_IN2;
            if (r < I_IN2) { p0_transpose_item(P.w_in, 1024, 3080, 2568, 16, (bf16*)(ws + WS_WIN), 2560, nullptr, scr, r, lane); continue; } r -= I_IN2;
            if (r < I_OUT) { p0_transpose_item(P.w_out, 1024, 1024, 0, 32, (bf16*)(ws + WS_WOUT), 0, nullptr, scr, r, lane); continue; } r -= I_OUT;
            if (r < I_Q) { p0_transpose_item(P.xattn_wq, 1024, 1024, 0, 32, (bf16*)(ws + WS_WQ), 0, P.norm_xattn_w, scr, r, lane); continue; } r -= I_Q;
            if (r < I_KV) { p0_transpose_item(P.xattn_wkv, 1024, 2048, 0, 64, (bf16*)(ws + WS_WKV), 0, nullptr, scr, r, lane); continue; } r -= I_KV;
            if (r < I_O) { p0_transpose_item(P.xattn_wo, 1024, 1024, 0, 32, (bf16*)(ws + WS_WO), 0, nullptr, scr, r, lane); continue; } r -= I_O;
            p0_transpose_item(P.peer_wq, 1024, 2048, 0, 64, (bf16*)(ws + WS_PWQ), 0, P.norm_ffn_w, scr, r, lane);
        }
    }
    {
        bf16* SUBK = (bf16*)(ws + WS_SUBK);
        for (int i = (vcu * NWAVES * 64 + tid); i < 16 * 128 * 128 / 4; i += G * NWAVES * 64) {
            const f32x4 v = ((const f32x4*)P.peer_subkeys)[i]; v2u o; o.x = pk2(v.x, v.y); o.y = pk2(v.z, v.w); ((v2u*)SUBK)[i] = o; }
    }
}

__device__ __forceinline__ void gdn_local_item(const Params& P, LAS unsigned char* lds, int item, int tid) {
    unsigned char* ws = P.ws;
    const int b = item >> 9, h = (item >> 7) & 3, n = item & 127;
    const int t0 = b * SEQ + n * 64;
    LAS float* ks = (LAS float*)lds;
    LAS float* vs = ks + 64 * 132;
    LAS float* AmT = vs + 64 * 132;
    LAS float* sg = AmT + 64 * 68;
    LAS float* sbeta = sg + 64;
    LAS float* sgc = sbeta + 64;
    LAS float* seg = sgc + 64;
    LAS float* sek = seg + 64;
    LAS float* qs = sek + 64;
    LAS float* solw = qs;
    static_assert((2 * 64 * 132 + 64 * 68 + 5 * 64 + 64 * 256) * 4 <= 156 * 1024, "gdn_local LDS");
    const bf16* QKV = (const bf16*)(ws + WS_QKV);
    const float* AB = (const float*)(ws + WS_AB);
#ifndef SKIP_S1
    {
        const int c = tid >> 3, grp = tid & 7;
#pragma unroll 1
        for (int part = 0; part < 3; ++part) {
            const int ch0 = part * 512 + h * 128 + grp * 16;
            float y[16];
#pragma unroll
            for (int i = 0; i < 16; ++i) y[i] = 0.f;
#pragma unroll
            for (int j = 0; j < 4; ++j) {
                const int s = n * 64 + c - 3 + j;
                if (s >= 0) {
                    const v4u* src = (const v4u*)(QKV + (size_t)(b * SEQ + s) * 1536 + ch0);
                    const v4u x0 = src[0], x1 = src[1];
                    const f32x4* wp = (const f32x4*)(P.conv_qkv_w + j * 1536 + ch0);
                    const f32x4 w0 = wp[0], w1 = wp[1], w2 = wp[2], w3 = wp[3];
                    y[0] += w0.x * bflo(x0.x); y[1] += w0.y * bfhi(x0.x); y[2] += w0.z * bflo(x0.y); y[3] += w0.w * bfhi(x0.y);
                    y[4] += w1.x * bflo(x0.z); y[5] += w1.y * bfhi(x0.z); y[6] += w1.z * bflo(x0.w); y[7] += w1.w * bfhi(x0.w);
                    y[8] += w2.x * bflo(x1.x); y[9] += w2.y * bfhi(x1.x); y[10] += w2.z * bflo(x1.y); y[11] += w2.w * bfhi(x1.y);
                    y[12] += w3.x * bflo(x1.z); y[13] += w3.y * bfhi(x1.z); y[14] += w3.z * bflo(x1.w); y[15] += w3.w * bfhi(x1.w);
                }
            }
            float ss = 0.f;
#pragma unroll
            for (int i = 0; i < 16; ++i) { y[i] = siluf_(y[i]); ss += y[i] * y[i]; }
            if (part < 2) {
                ss += __shfl_xor(ss, 1); ss += __shfl_xor(ss, 2); ss += __shfl_xor(ss, 4);
                const float sc = rsqrtf(ss + 1e-6f) * (part == 0 ? 0.08838834764831845f : 1.0f);
#pragma unroll
                for (int i = 0; i < 16; ++i) y[i] *= sc;
            }
            LAS float* dst = (part == 0 ? qs : (part == 1 ? ks : vs)) + c * 132 + grp * 16;
#pragma unroll
            for (int i = 0; i < 4; ++i) *(LAS f32x4*)(dst + 4 * i) = (f32x4){y[4 * i], y[4 * i + 1], y[4 * i + 2], y[4 * i + 3]};
        }
        if (tid < 64) {
            const int t = t0 + tid;
            const float a_in = AB[(size_t)t * 8 + h], b_in = AB[(size_t)t * 8 + 4 + h];
            sg[tid] = -__expf(P.gdn_a_log[h]) * softplusf_(a_in + P.gdn_dt_bias[h]);
            sbeta[tid] = sigmoidf_(b_in);
        }
    }
#endif
    __syncthreads();
    if (tid < 64) {
        float v = sg[tid];
#pragma unroll
        for (int off = 1; off < 64; off <<= 1) { const float t = __shfl_up(v, off); if (tid >= off) v += t; }
        sgc[tid] = v; seg[tid] = __expf(v);
        const float gl = __shfl(v, 63);
        sek[tid] = __expf(gl - v);
        if (tid == 63) ((float*)(ws + WS_DEC))[item] = __expf(v);
    }
    __syncthreads();
#ifndef SKIP_S3
    {
        const int c = tid >> 3, sgp = tid & 7;
        float akk[8], aqk[8];
#pragma unroll
        for (int i = 0; i < 8; ++i) { akk[i] = 0.f; aqk[i] = 0.f; }
#pragma unroll 2
        for (int d4 = 0; d4 < 32; ++d4) {
            const f32x4 kc = *(const LAS f32x4*)(ks + c * 132 + 4 * d4), qc = *(const LAS f32x4*)(qs + c * 132 + 4 * d4);
#pragma unroll
            for (int i = 0; i < 8; ++i) { const f32x4 kv = *(const LAS f32x4*)(ks + (sgp + 8 * i) * 132 + 4 * d4);
                akk[i] += (kc.x * kv.x + kc.y * kv.y) + (kc.z * kv.z + kc.w * kv.w);
                aqk[i] += (qc.x * kv.x + qc.y * kv.y) + (qc.z * kv.z + qc.w * kv.w); }
        }
        const float gc = sgc[c], bc = sbeta[c];
        bf16* ATT = (bf16*)(ws + WS_ATT) + (size_t)item * 4096;
#pragma unroll
        for (int i = 0; i < 8; ++i) { const int s = sgp + 8 * i;
            const float dec = (c >= s) ? __expf(gc - sgc[s]) : 0.f;
            AmT[s * 68 + c] = (c > s) ? bc * akk[i] * dec : 0.f;
            ATT[c * 64 + ((s & ~31) | permk(s & 31))] = (bf16)f2bf(aqk[i] * dec); }
    }
#endif
#ifndef SKIP_S4
    {
        bf16* QD = (bf16*)(ws + WS_QD) + (size_t)item * 8192;
        bf16* KD = (bf16*)(ws + WS_KD) + (size_t)item * 8192;
#pragma unroll
        for (int r = 0; r < 2; ++r) {
            const int id = tid + 512 * r;
            { const int c = id >> 4, gam = id & 15, s32 = gam >> 2, g = gam & 3;
              const f32x4 lo = *(const LAS f32x4*)(qs + c * 132 + 32 * s32 + 4 * g), hi = *(const LAS f32x4*)(qs + c * 132 + 32 * s32 + 16 + 4 * g);
              const float e = seg[c];
              v4u o; o.x = pk2(lo.x * e, lo.y * e); o.y = pk2(lo.z * e, lo.w * e); o.z = pk2(hi.x * e, hi.y * e); o.w = pk2(hi.z * e, hi.w * e);
              *(v4u*)(QD + c * 128 + 8 * gam) = o; }
            { const int dk = id >> 3, gam = id & 7, s32 = gam >> 2, g = gam & 3, c0 = 32 * s32 + 4 * g;
              float v[8];
#pragma unroll
              for (int j = 0; j < 4; ++j) { v[j] = ks[(c0 + j) * 132 + dk] * sek[c0 + j]; v[4 + j] = ks[(c0 + 16 + j) * 132 + dk] * sek[c0 + 16 + j]; }
              v4u o; o.x = pk2(v[0], v[1]); o.y = pk2(v[2], v[3]); o.z = pk2(v[4], v[5]); o.w = pk2(v[6], v[7]);
              *(v4u*)(KD + dk * 64 + 8 * gam) = o; }
        }
    }
#endif
    __syncthreads();
#ifndef SKIP_S5
    if (tid < 256) {
        const int j = tid;
        const LAS float* src = (j < 128) ? (vs + j) : (ks + (j - 128));
#pragma unroll 1
        for (int rb = 0; rb < 4; ++rb) {
            float acc[16];
#pragma unroll
            for (int i = 0; i < 16; ++i) { const int c = 16 * rb + i; float a = src[c * 132] * sbeta[c]; if (j >= 128) a *= seg[c]; acc[i] = a; }
#pragma unroll 2
            for (int s = 0; s < 16 * rb; ++s) {
                const float sv = solw[s * 256 + j];
                const LAS float* ar = AmT + s * 68 + 16 * rb;
#pragma unroll
                for (int q = 0; q < 4; ++q) { const f32x4 A4 = *(const LAS f32x4*)(ar + 4 * q);
                    acc[4 * q] -= A4.x * sv; acc[4 * q + 1] -= A4.y * sv; acc[4 * q + 2] -= A4.z * sv; acc[4 * q + 3] -= A4.w * sv; }
            }
#pragma unroll
            for (int i = 0; i < 16; ++i) {
                const int s = 16 * rb + i; const float sv = acc[i];
                solw[s * 256 + j] = sv;
                const LAS float* ar = AmT + s * 68 + 16 * rb;
#pragma unroll
                for (int q = (i + 1) / 4; q < 4; ++q) { const f32x4 A4 = *(const LAS f32x4*)(ar + 4 * q);
                    if (4 * q > i) acc[4 * q] -= A4.x * sv; if (4 * q + 1 > i) acc[4 * q + 1] -= A4.y * sv; if (4 * q + 2 > i) acc[4 * q + 2] -= A4.z * sv; if (4 * q + 3 > i) acc[4 * q + 3] -= A4.w * sv; }
            }
        }
        LDS_WAIT(); asm volatile("" ::: "memory");
        if (j < 128) {
            bf16* UF = (bf16*)(ws + WS_UF) + (size_t)item * 8192 + (size_t)(j >> 4) * 1024;
#pragma unroll
            for (int g = 0; g < 4; ++g) {
                float v[16];
#pragma unroll
                for (int rho = 0; rho < 4; ++rho)
#pragma unroll
                    for (int i = 0; i < 4; ++i) v[rho * 4 + i] = solw[(16 * rho + 4 * g + i) * 256 + j];
                v4u o0, o1;
                o0.x = pk2(v[0], v[1]); o0.y = pk2(v[2], v[3]); o0.z = pk2(v[4], v[5]); o0.w = pk2(v[6], v[7]);
                o1.x = pk2(v[8], v[9]); o1.y = pk2(v[10], v[11]); o1.z = pk2(v[12], v[13]); o1.w = pk2(v[14], v[15]);
                v4u* d = (v4u*)(UF + (g * 16 + (j & 15)) * 16);
                d[0] = o0; d[1] = o1;
            }
        } else {
            const int dk = j - 128, pos = (dk & ~31) | permk(dk & 31);
            bf16* WN = (bf16*)(ws + WS_WN) + (size_t)item * 8192 + pos;
#pragma unroll 8
            for (int c = 0; c < 64; ++c) WN[c * 128] = (bf16)f2bf(-solw[c * 256 + j]);
        }
    }
#endif
    __syncthreads();
}

__device__ __forceinline__ void lru_local_item(const Params& P, LAS unsigned char* lds, int lt, int tid, int lane, int wave) {
    unsigned char* ws = P.ws;
    const int b = lt >> 7, n = lt & 127, t0 = b * SEQ + n * 64;
    LAS float* xc = (LAS float*)lds;
    const bf16* XR = (const bf16*)(ws + WS_XR);
    {
        const int ch = tid;
        const float w0 = P.lru_conv_w[ch], w1 = P.lru_conv_w[512 + ch], w2 = P.lru_conv_w[1024 + ch], w3 = P.lru_conv_w[1536 + ch], cb = P.lru_conv_b[ch];
        float x0 = 0.f, x1 = 0.f, x2 = 0.f;
        if (n > 0) { x0 = bf1(XR[(size_t)(t0 - 3) * 512 + ch]); x1 = bf1(XR[(size_t)(t0 - 2) * 512 + ch]); x2 = bf1(XR[(size_t)(t0 - 1) * 512 + ch]); }
#pragma unroll 8
        for (int c = 0; c < 64; ++c) { const float x3 = bf1(XR[(size_t)(t0 + c) * 512 + ch]);
            xc[c * 516 + ch] = (w0 * x0 + w1 * x1) + (w2 * x2 + w3 * x3) + cb; x0 = x1; x1 = x2; x2 = x3; }
    }
    __syncthreads();
    {
        const int g = wave, ch = g * 64 + lane;
        float wa[64], wx[64];
        const float* wap = P.lru_wa + (size_t)g * 4096 + lane; const float* wxp = P.lru_wx + (size_t)g * 4096 + lane;
        asm volatile("" : "+v"(wap), "+v"(wxp));
#pragma unroll
        for (int i = 0; i < 64; ++i) { wa[i] = wap[i * 64]; wx[i] = wxp[i * 64]; }
        const float ba = P.lru_ba[ch], bx = P.lru_bx[ch], sp = softplusf_(-P.lru_lambda[ch]);
        bf16* HLOC = (bf16*)(ws + WS_HLOC); bf16* PCUM = (bf16*)(ws + WS_PCUM);
        float hst = 0.f, pc = 1.f;
#pragma unroll 1
        for (int c = 0; c < 64; ++c) {
            float ra = ba, ri = bx;
            const LAS float* xrow = xc + c * 516 + g * 64;
#pragma unroll
            for (int i4 = 0; i4 < 16; ++i4) { const f32x4 x4 = *(const LAS f32x4*)(xrow + 4 * i4);
                ra += x4.x * wa[4 * i4]; ra += x4.y * wa[4 * i4 + 1]; ra += x4.z * wa[4 * i4 + 2]; ra += x4.w * wa[4 * i4 + 3];
                ri += x4.x * wx[4 * i4]; ri += x4.y * wx[4 * i4 + 1]; ri += x4.z * wx[4 * i4 + 2]; ri += x4.w * wx[4 * i4 + 3];
                if ((i4 & 3) == 3) asm volatile("" ::: "memory"); }
            const float r = sigmoidf_(ra), ig = sigmoidf_(ri);
            const float log_a = -8.0f * r * sp;
            const float a = __expf(log_a);
            const float xo = xrow[lane];
            const float bt = sqrtf(fmaxf(-expm1f(2.0f * log_a), 0.f)) * (ig * xo);
            hst = a * hst + bt; pc *= a;
            HLOC[(size_t)(t0 + c) * 512 + ch] = (bf16)f2bf(hst); PCUM[(size_t)(t0 + c) * 512 + ch] = (bf16)f2bf(pc);
        }
        ((float*)(ws + WS_HEND))[(size_t)lt * 512 + ch] = hst; ((float*)(ws + WS_PEND))[(size_t)lt * 512 + ch] = pc;
    }
    __syncthreads();
}

constexpr int SC_WN = 0, SC_QD = 64 * 272, SC_KD = 2 * 64 * 272, SC_ATT = 2 * 64 * 272 + 128 * 144, SC_BUF = 2 * 64 * 272 + 128 * 144 + 64 * 144;
constexpr int SC_SSQ = 2 * SC_BUF;
__device__ __forceinline__ int sc_lds_off(int id) {
    if (id < 1024) return SC_WN + (id >> 4) * 272 + (id & 15) * 16;
    if (id < 2048) { const int q = id - 1024; return SC_QD + (q >> 4) * 272 + (q & 15) * 16; }
    if (id < 3072) { const int q = id - 2048; return SC_KD + (q >> 3) * 144 + (q & 7) * 16; }
    const int q = id - 3072; return SC_ATT + (q >> 3) * 144 + (q & 7) * 16;
}
__device__ __forceinline__ const v4u* sc_src(const unsigned char* ws, int item, int id) {
    if (id < 1024) return (const v4u*)(ws + WS_WN + (size_t)item * 16384) + id;
    if (id < 2048) return (const v4u*)(ws + WS_QD + (size_t)item * 16384) + (id - 1024);
    if (id < 3072) return (const v4u*)(ws + WS_KD + (size_t)item * 16384) + (id - 2048);
    return (const v4u*)(ws + WS_ATT + (size_t)item * 8192) + (id - 3072);
}
__device__ __forceinline__ bf16x8 pack_b(const f32x4 a, const f32x4 b) {
    v4u r; r.x = pk2(a.x, a.y); r.y = pk2(a.z, a.w); r.z = pk2(b.x, b.y); r.w = pk2(b.z, b.w);
    return __builtin_bit_cast(bf16x8, r);
}
#define SC_BAR() do { asm volatile("s_waitcnt lgkmcnt(0)" ::: "memory"); __builtin_amdgcn_s_barrier(); asm volatile("" ::: "memory"); } while (0)
#define SC_GLD(dst, ptr) asm volatile("global_load_dwordx4 %0, %1, off" : "=v"(dst) : "v"(ptr) : "memory")
#define PIN8(a) asm volatile("" : "+v"(a[0]), "+v"(a[1]), "+v"(a[2]), "+v"(a[3]), "+v"(a[4]), "+v"(a[5]), "+v"(a[6]), "+v"(a[7]))
#define PIN16(a) asm volatile("" : "+v"(a[0]), "+v"(a[1]), "+v"(a[2]), "+v"(a[3]), "+v"(a[4]), "+v"(a[5]), "+v"(a[6]), "+v"(a[7]), "+v"(a[8]), "+v"(a[9]), "+v"(a[10]), "+v"(a[11]), "+v"(a[12]), "+v"(a[13]), "+v"(a[14]), "+v"(a[15]))
constexpr int SCAN_NWC = 2, SCAN_PARTS = 4, SCAN_WGS = 8 * SCAN_PARTS;
constexpr int SC_UFS = 2 * SC_BUF;
constexpr int SC_DECS = SC_UFS + 2 * SCAN_NWC * 2048;
constexpr int SC_OT = SC_DECS + 512;
constexpr int SC_END = SC_OT + 2 * 64 * 36 * 4;
static_assert(SC_END <= MISC_OFF, "scan LDS");
#ifndef SCAN_REPS
#define SCAN_REPS 1
#endif
#ifndef SCAN_EXP
#define SCAN_EXP 0
#endif
__device__ __forceinline__ int sc3_lds_off(int id) {
    if (id < 3584) return sc_lds_off(id);
    return SC_UFS + (id - 3584) * 16;
}
__device__ __forceinline__ const v4u* sc3_src(const unsigned char* ws, int item, int id, int part) {
    if (id < 3584) return sc_src(ws, item, id);
    return (const v4u*)(ws + WS_UF + (size_t)item * 16384 + (size_t)(part * SCAN_NWC) * 2048) + (id - 3584);
}
__device__ __forceinline__ void gdn_scan(const Params& P, LAS unsigned char* lds, int sb, int tid, int lane, int wave) {
    const unsigned char* ws = P.ws;
    constexpr int NCH = 128 * SCAN_REPS, NPC = 15;
    const int bh = sb & 7, part = sb >> 3;
    const int b = bh >> 2, h = bh & 3, col = lane & 15, g = lane >> 4;
    const int item0 = bh * 128;
    const float* DEC = (const float*)(ws + WS_DEC);
    if (wave >= 4) {
        constexpr int NP = 15, DEP = 3;
        const int lt = tid - 256;
        const unsigned voff = (unsigned)lt * 16u;
        const int lA = (lt >> 4) * 272 + (lt & 15) * 16, lB = (lt >> 3) * 144 + (lt & 7) * 16, lU = SC_UFS + lt * 16;
        v4u rs[DEP][NP];
#define SC_ISSUE(set, itm) do { const unsigned char* gq_ = ws + (size_t)(itm) * 16384; const unsigned char* ga_ = ws + WS_ATT + (size_t)(itm) * 8192; \
            asm volatile("s_nop 4\n\tglobal_load_dwordx4 %0, %8, %9\n\tglobal_load_dwordx4 %1, %8, %10\n\tglobal_load_dwordx4 %2, %8, %11\n\tglobal_load_dwordx4 %3, %8, %12\n\t" \
                         "global_load_dwordx4 %4, %8, %13\n\tglobal_load_dwordx4 %5, %8, %14\n\tglobal_load_dwordx4 %6, %8, %15\n\tglobal_load_dwordx4 %7, %8, %16" \
                : "=&v"(rs[set][0]), "=&v"(rs[set][1]), "=&v"(rs[set][2]), "=&v"(rs[set][3]), "=&v"(rs[set][4]), "=&v"(rs[set][5]), "=&v"(rs[set][6]), "=&v"(rs[set][7]) \
                : "v"(voff), "s"(gq_ + WS_WN), "s"(gq_ + WS_WN + 4096), "s"(gq_ + WS_WN + 8192), "s"(gq_ + WS_WN + 12288), \
                  "s"(gq_ + WS_QD), "s"(gq_ + WS_QD + 4096), "s"(gq_ + WS_QD + 8192), "s"(gq_ + WS_QD + 12288) : "memory"); \
            asm volatile("s_nop 4\n\tglobal_load_dwordx4 %0, %7, %8\n\tglobal_load_dwordx4 %1, %7, %9\n\tglobal_load_dwordx4 %2, %7, %10\n\tglobal_load_dwordx4 %3, %7, %11\n\t" \
                         "global_load_dwordx4 %4, %7, %12\n\tglobal_load_dwordx4 %5, %7, %13\n\tglobal_load_dwordx4 %6, %7, %14" \
                : "=&v"(rs[set][8]), "=&v"(rs[set][9]), "=&v"(rs[set][10]), "=&v"(rs[set][11]), "=&v"(rs[set][12]), "=&v"(rs[set][13]), "=&v"(rs[set][14]) \
                : "v"(voff), "s"(gq_ + WS_KD), "s"(gq_ + WS_KD + 4096), "s"(gq_ + WS_KD + 8192), "s"(gq_ + WS_KD + 12288), \
                  "s"(ga_), "s"(ga_ + 4096), "s"(gq_ + WS_UF + (size_t)(part * SCAN_NWC) * 2048) : "memory"); } while (0)
#define SC_WAITSET(set, cnt) asm volatile("s_waitcnt " cnt : "+v"(rs[set][0]), "+v"(rs[set][1]), "+v"(rs[set][2]), "+v"(rs[set][3]), "+v"(rs[set][4]), "+v"(rs[set][5]), "+v"(rs[set][6]), "+v"(rs[set][7]), \
            "+v"(rs[set][8]), "+v"(rs[set][9]), "+v"(rs[set][10]), "+v"(rs[set][11]), "+v"(rs[set][12]), "+v"(rs[set][13]), "+v"(rs[set][14]) :: "memory")
#define SC_WRITE(set, par) do { LAS unsigned char* wb_ = lds + (par) * SC_BUF; \
            _Pragma("unroll") for (int r = 0; r < 4; ++r) { *(LAS v4u*)(wb_ + SC_WN + lA + r * (16 * 272)) = rs[set][r]; *(LAS v4u*)(wb_ + SC_QD + lA + r * (16 * 272)) = rs[set][4 + r]; \
                                                          *(LAS v4u*)(wb_ + SC_KD + lB + r * (32 * 144)) = rs[set][8 + r]; } \
            *(LAS v4u*)(wb_ + SC_ATT + lB) = rs[set][12]; *(LAS v4u*)(wb_ + SC_ATT + lB + 32 * 144) = rs[set][13]; \
            *(LAS v4u*)(lds + lU + (par) * (SCAN_NWC * 2048)) = rs[set][14]; } while (0)
        {
#pragma unroll
            for (int r = 0; r < NP; ++r) { const int id = lt + 256 * r; *(LAS v4u*)(lds + sc3_lds_off(id)) = *sc3_src(ws, item0, id, part); }
            if (lt < 128) ((LAS float*)(lds + SC_DECS))[lt] = DEC[item0 + lt];
            asm volatile("s_waitcnt vmcnt(0)" ::: "memory");
        }
        SC_ISSUE(1, item0 + 1); SC_ISSUE(2, item0 + 2); SC_ISSUE(0, item0 + 3);
        SC_BAR();
        int n2 = 0;
#define SC_INTERVAL(set) do { SC_WAITSET(set, "vmcnt(30)"); SC_WRITE(set, (n2 + 1) & 1); SC_WAITSET(set, "lgkmcnt(0)"); SC_ISSUE(set, item0 + ((n2 + 1 + DEP) & 127)); SC_BAR(); ++n2; } while (0)
#pragma unroll 1
        for (int it = 0; it < NCH / 3; ++it) { SC_INTERVAL(1); SC_INTERVAL(2); SC_INTERVAL(0); }
        if (NCH % 3 >= 1) SC_INTERVAL(1);
        if (NCH % 3 >= 2) SC_INTERVAL(2);
        SC_WAITSET(0, "vmcnt(0)"); SC_WAITSET(1, "vmcnt(0)"); SC_WAITSET(2, "vmcnt(0)");
#undef SC_INTERVAL
#undef SC_WRITE
#undef SC_WAITSET
#undef SC_ISSUE
        return;
    }
    if (wave == 3) {
        SC_BAR();
#pragma unroll 1
        for (int n2 = 0; n2 < NCH; ++n2) SC_BAR();
        return;
    }
    if (wave == 2) {
        const int row = lane;
        bf16* Y = (bf16*)(P.ws + WS_Y);
        float* SSQG = P.out;
        SC_BAR();
#pragma unroll 1
        for (int n2 = 0; n2 <= NCH; ++n2) {
            if (n2 > 0) {
                const int n = (n2 - 1) & 127, t = b * SEQ + n * 64 + row;
                const LAS float* src = (const LAS float*)(lds + SC_OT + ((n2 - 1) & 1) * (64 * 36 * 4)) + row * 36;
                f32x4 a[8]; float s2 = 0.f;
#pragma unroll
                for (int q = 0; q < 8; ++q) { a[q] = *(const LAS f32x4*)(src + 4 * q); s2 += (a[q].x * a[q].x + a[q].y * a[q].y) + (a[q].z * a[q].z + a[q].w * a[q].w); }
                SSQG[(size_t)t * 32 + h * 8 + part] = s2;
                v4u* d = (v4u*)(Y + (size_t)t * 1024 + h * 128 + 32 * part);
#pragma unroll
                for (int q = 0; q < 4; ++q) { v4u o; o.x = pk2(a[2 * q].x, a[2 * q].y); o.y = pk2(a[2 * q].z, a[2 * q].w); o.z = pk2(a[2 * q + 1].x, a[2 * q + 1].y); o.w = pk2(a[2 * q + 1].z, a[2 * q + 1].w); d[q] = o; }
            }
            if (n2 < NCH) SC_BAR();
        }
        return;
    }
    f32x4 S[8];
#pragma unroll
    for (int i = 0; i < 8; ++i) S[i] = (f32x4){0.f, 0.f, 0.f, 0.f};
    SC_BAR();
#pragma unroll 1
    for (int n2 = 0; n2 < NCH; ++n2) {
        if (SCAN_REPS > 1 && (n2 & 127) == 0) {
#pragma unroll
            for (int i = 0; i < 8; ++i) S[i] = (f32x4){0.f, 0.f, 0.f, 0.f};
        }
        if (SCAN_EXP == 2 && n2 < 128) { SC_BAR(); continue; }
        const int par = n2 & 1;
        LAS unsigned char* buf = lds + par * SC_BUF;
        bf16x8 fA[16], fB[16], fC[16], fD[8];
#pragma unroll
        for (int rho = 0; rho < 4; ++rho)
#pragma unroll
            for (int s = 0; s < 4; ++s) fA[rho * 4 + s] = *(const LAS bf16x8*)(buf + SC_WN + (16 * rho + col) * 272 + (32 * s + 8 * g) * 2);
#pragma unroll
        for (int rho = 0; rho < 4; ++rho)
#pragma unroll
            for (int s = 0; s < 4; ++s) fB[rho * 4 + s] = *(const LAS bf16x8*)(buf + SC_QD + (16 * rho + col) * 272 + (32 * s + 8 * g) * 2);
        const LAS v4u* ufp = (const LAS v4u*)(lds + SC_UFS + par * (SCAN_NWC * 2048) + wave * 2048 + lane * 32);
        const v4u uf0 = ufp[0], uf1 = ufp[1];
        const float dec = ((const LAS float*)(lds + SC_DECS))[n2 & 127];
        bf16x8 Bs[4];
#pragma unroll
        for (int s = 0; s < 4; ++s) Bs[s] = pack_b(S[2 * s], S[2 * s + 1]);
        f32x4 Vn[4], Oc[4];
        Vn[0] = (f32x4){bflo(uf0.x), bfhi(uf0.x), bflo(uf0.y), bfhi(uf0.y)}; Vn[1] = (f32x4){bflo(uf0.z), bfhi(uf0.z), bflo(uf0.w), bfhi(uf0.w)};
        Vn[2] = (f32x4){bflo(uf1.x), bfhi(uf1.x), bflo(uf1.y), bfhi(uf1.y)}; Vn[3] = (f32x4){bflo(uf1.z), bfhi(uf1.z), bflo(uf1.w), bfhi(uf1.w)};
        __builtin_amdgcn_sched_barrier(0);
        PIN16(fA);
#pragma unroll
        for (int s = 0; s < 4; ++s)
#pragma unroll
            for (int rho = 0; rho < 4; ++rho) Vn[rho] = __builtin_amdgcn_mfma_f32_16x16x32_bf16(fA[rho * 4 + s], Bs[s], Vn[rho], 0, 0, 0);
        __builtin_amdgcn_sched_barrier(0);
#pragma unroll
        for (int tau = 0; tau < 8; ++tau)
#pragma unroll
            for (int s = 0; s < 2; ++s) fC[tau * 2 + s] = *(const LAS bf16x8*)(buf + SC_KD + (16 * tau + col) * 144 + (32 * s + 8 * g) * 2);
        __builtin_amdgcn_sched_barrier(0);
        PIN16(fB);
#pragma unroll
        for (int rho = 0; rho < 4; ++rho) Oc[rho] = (f32x4){0.f, 0.f, 0.f, 0.f};
#pragma unroll
        for (int s = 0; s < 4; ++s)
#pragma unroll
            for (int rho = 0; rho < 4; ++rho) Oc[rho] = __builtin_amdgcn_mfma_f32_16x16x32_bf16(fB[rho * 4 + s], Bs[s], Oc[rho], 0, 0, 0);
        __builtin_amdgcn_sched_barrier(0);
#pragma unroll
        for (int rho = 0; rho < 4; ++rho)
#pragma unroll
            for (int s = 0; s < 2; ++s) fD[rho * 2 + s] = *(const LAS bf16x8*)(buf + SC_ATT + (16 * rho + col) * 144 + (32 * s + 8 * g) * 2);
        bf16x8 Bv[2];
        Bv[0] = pack_b(Vn[0], Vn[1]); Bv[1] = pack_b(Vn[2], Vn[3]);
#pragma unroll
        for (int tau = 0; tau < 8; ++tau) S[tau] = S[tau] * dec;
        __builtin_amdgcn_sched_barrier(0);
        PIN16(fC);
#pragma unroll
        for (int s = 0; s < 2; ++s)
#pragma unroll
            for (int tau = 0; tau < 8; ++tau) S[tau] = __builtin_amdgcn_mfma_f32_16x16x32_bf16(fC[tau * 2 + s], Bv[s], S[tau], 0, 0, 0);
        __builtin_amdgcn_sched_barrier(0);
        PIN8(fD);
#pragma unroll
        for (int s = 0; s < 2; ++s)
#pragma unroll
            for (int rho = 0; rho < 4; ++rho) Oc[rho] = __builtin_amdgcn_mfma_f32_16x16x32_bf16(fD[rho * 2 + s], Bv[s], Oc[rho], 0, 0, 0);
        LAS float* ot = (LAS float*)(lds + SC_OT + par * (64 * 36 * 4)) + 16 * wave + col;
#pragma unroll
        for (int rho = 0; rho < 4; ++rho)
#pragma unroll
            for (int i = 0; i < 4; ++i) ot[(16 * rho + 4 * g + i) * 36] = Oc[rho][i];
        SC_BAR();
    }
}

__device__ __forceinline__ void lru_carry(const Params& P, int gwv, int lane) {
    unsigned char* ws = P.ws;
    const int b = gwv >> 3, g = gwv & 7, ch = g * 64 + lane;
    const float* HEND = (const float*)(ws + WS_HEND); const float* PEND = (const float*)(ws + WS_PEND); float* HIN = (float*)(ws + WS_HIN);
    float hin = 0.f;
#pragma unroll 1
    for (int n0 = 0; n0 < 128; n0 += 16) {
        float he[16], pe[16];
#pragma unroll
        for (int i = 0; i < 16; ++i) { const size_t o = (size_t)(b * 128 + n0 + i) * 512 + ch; he[i] = HEND[o]; pe[i] = PEND[o]; }
#pragma unroll
        for (int i = 0; i < 16; ++i) { HIN[(size_t)(b * 128 + n0 + i) * 512 + ch] = hin; hin = he[i] + pe[i] * hin; }
    }
}

__device__ __forceinline__ void cvt_table(const float* src, bf16* dst, size_t n8, size_t wi, size_t nw) {
    for (size_t i = wi; i < n8; i += nw) {
        const f32x4 a = ((const f32x4*)src)[2 * i], c = ((const f32x4*)src)[2 * i + 1];
        v4u o; o.x = pk2(a.x, a.y); o.y = pk2(a.z, a.w); o.z = pk2(c.x, c.y); o.w = pk2(c.z, c.w);
        ((v4u*)dst)[i] = o;
    }
}

__device__ __forceinline__ void lru_combine(const Params& P, size_t wi, size_t nw) {
    unsigned char* ws = P.ws;
    const v4u* HLOC = (const v4u*)(ws + WS_HLOC); const v4u* PCUM = (const v4u*)(ws + WS_PCUM); const v4u* GATE = (const v4u*)(ws + WS_GATE);
    const float* HIN = (const float*)(ws + WS_HIN); bf16* Y = (bf16*)(ws + WS_Y);
    for (size_t i = wi; i < (size_t)T * 64; i += nw) {
        const size_t t = i >> 6; const int ch0 = (int)(i & 63) * 8;
        const v4u hl = HLOC[i], pc = PCUM[i], gt = GATE[i];
        const f32x4 h0 = *(const f32x4*)(HIN + (t >> 6) * 512 + ch0), h1 = *(const f32x4*)(HIN + (t >> 6) * 512 + ch0 + 4);
        float y[8];
        y[0] = (bflo(hl.x) + bflo(pc.x) * h0.x) * gelu_tanh(bflo(gt.x)); y[1] = (bfhi(hl.x) + bfhi(pc.x) * h0.y) * gelu_tanh(bfhi(gt.x));
        y[2] = (bflo(hl.y) + bflo(pc.y) * h0.z) * gelu_tanh(bflo(gt.y)); y[3] = (bfhi(hl.y) + bfhi(pc.y) * h0.w) * gelu_tanh(bfhi(gt.y));
        y[4] = (bflo(hl.z) + bflo(pc.z) * h1.x) * gelu_tanh(bflo(gt.z)); y[5] = (bfhi(hl.z) + bfhi(pc.z) * h1.y) * gelu_tanh(bfhi(gt.z));
        y[6] = (bflo(hl.w) + bflo(pc.w) * h1.z) * gelu_tanh(bflo(gt.w)); y[7] = (bfhi(hl.w) + bfhi(pc.w) * h1.w) * gelu_tanh(bfhi(gt.w));
        v4u o; o.x = pk2(y[0], y[1]); o.y = pk2(y[2], y[3]); o.z = pk2(y[4], y[5]); o.w = pk2(y[6], y[7]);
        *(v4u*)(Y + t * 1024 + 512 + ch0) = o;
    }
}

__device__ __forceinline__ void gdn_gate_norm(const Params& P, size_t wi, size_t nw) {
    unsigned char* ws = P.ws;
    bf16* Y = (bf16*)(ws + WS_Y); const v4u* Z = (const v4u*)(ws + WS_Z); const float* SSQG = P.out;
    for (size_t i = wi; i < (size_t)T * 64; i += nw) {
        const size_t t = i >> 6; const int c0 = (int)(i & 63) * 8, h = c0 >> 7;
        const f32x4 q0 = *(const f32x4*)(SSQG + t * 32 + h * 8);
        const float rstd = rsqrtf(((q0.x + q0.y) + (q0.z + q0.w)) * (1.0f / 128.0f) + 1e-6f);
        const v4u o = *(const v4u*)(Y + t * 1024 + c0), z = Z[i];
        const f32x4 w0 = *(const f32x4*)(P.gdn_norm_w + (c0 & 127)), w1 = *(const f32x4*)(P.gdn_norm_w + (c0 & 127) + 4);
        float y[8];
        y[0] = bflo(o.x) * rstd * w0.x * siluf_(bflo(z.x)); y[1] = bfhi(o.x) * rstd * w0.y * siluf_(bfhi(z.x));
        y[2] = bflo(o.y) * rstd * w0.z * siluf_(bflo(z.y)); y[3] = bfhi(o.y) * rstd * w0.w * siluf_(bfhi(z.y));
        y[4] = bflo(o.z) * rstd * w1.x * siluf_(bflo(z.z)); y[5] = bfhi(o.z) * rstd * w1.y * siluf_(bfhi(z.z));
        y[6] = bflo(o.w) * rstd * w1.z * siluf_(bflo(z.w)); y[7] = bfhi(o.w) * rstd * w1.w * siluf_(bfhi(z.w));
        v4u r; r.x = pk2(y[0], y[1]); r.y = pk2(y[2], y[3]); r.z = pk2(y[4], y[5]); r.w = pk2(y[6], y[7]);
        *(v4u*)(Y + t * 1024 + c0) = r;
    }
}

__device__ __forceinline__ void xattn_unit(const Params& P, int wu, int lane) {
    const unsigned char* ws = P.ws;
    const int h = wu & 3, t0 = (wu >> 2) * 16, b = t0 >> 13, col = lane & 15, g = lane >> 4;
    const bf16* Q = (const bf16*)(ws + WS_Q) + (size_t)(t0 + col) * 1024 + h * 256 + 8 * g;
    const bf16* Kb = (const bf16*)(ws + WS_KB) + (size_t)((b * 4 + h) * 256 + col) * 256 + 8 * g;
    const bf16* Vt = (const bf16*)(ws + WS_VTP) + (size_t)((b * 4 + h) * 256 + col) * 256 + 8 * g;
    bf16x8 Bq[8];
#pragma unroll
    for (int s = 0; s < 8; ++s) Bq[s] = *(const bf16x8*)(Q + 32 * s);
    f32x4 St[16];
#pragma unroll
    for (int kap = 0; kap < 16; ++kap) {
        f32x4 acc = (f32x4){0.f, 0.f, 0.f, 0.f};
#pragma unroll
        for (int s = 0; s < 8; ++s) { const bf16x8 a = *(const bf16x8*)(Kb + (size_t)(16 * kap) * 256 + 32 * s); acc = __builtin_amdgcn_mfma_f32_16x16x32_bf16(a, Bq[s], acc, 0, 0, 0); }
        St[kap] = acc;
    }
    float mx = -3.0e38f;
#pragma unroll
    for (int kap = 0; kap < 16; ++kap) mx = fmaxf(fmaxf(fmaxf(St[kap].x, St[kap].y), fmaxf(St[kap].z, St[kap].w)), mx);
    mx = fmaxf(mx, __shfl_xor(mx, 16)); mx = fmaxf(mx, __shfl_xor(mx, 32));
    float l = 0.f;
#pragma unroll
    for (int kap = 0; kap < 16; ++kap) { St[kap].x = __expf(St[kap].x - mx); St[kap].y = __expf(St[kap].y - mx); St[kap].z = __expf(St[kap].z - mx); St[kap].w = __expf(St[kap].w - mx);
        l += (St[kap].x + St[kap].y) + (St[kap].z + St[kap].w); }
    l += __shfl_xor(l, 16); l += __shfl_xor(l, 32);
    const float inv = 1.0f / l;
    bf16x8 Bp[8];
#pragma unroll
    for (int s = 0; s < 8; ++s) Bp[s] = pack_b(St[2 * s], St[2 * s + 1]);
    bf16* AO = (bf16*)(P.ws + WS_AO) + (size_t)(t0 + col) * 1024 + h * 256 + 4 * g;
#pragma unroll
    for (int del = 0; del < 16; ++del) {
        f32x4 acc = (f32x4){0.f, 0.f, 0.f, 0.f};
#pragma unroll
        for (int s = 0; s < 8; ++s) { const bf16x8 a = *(const bf16x8*)(Vt + (size_t)(16 * del) * 256 + 32 * s); acc = __builtin_amdgcn_mfma_f32_16x16x32_bf16(a, Bp[s], acc, 0, 0, 0); }
        v2u o; o.x = pk2(acc.x * inv, acc.y * inv); o.y = pk2(acc.z * inv, acc.w * inv);
        *(v2u*)(AO + 16 * del) = o;
    }
}

__device__ __forceinline__ unsigned key_enc(float f) { const unsigned u = __builtin_bit_cast(unsigned, f); return (u & 0x80000000u) ? ~u : (u | 0x80000000u); }
__device__ __forceinline__ float key_dec(unsigned k) { const unsigned u = (k & 0x80000000u) ? (k & 0x7fffffffu) : ~k; return __builtin_bit_cast(float, u); }
#define INS16(L, kv) do { unsigned carry_ = (kv); _Pragma("unroll") for (int q_ = 0; q_ < 16; ++q_) { const unsigned hi_ = max(L[q_], carry_); carry_ = min(L[q_], carry_); L[q_] = hi_; } } while (0)
__device__ __forceinline__ void peer_topk_item(const Params& P, LAS unsigned char* lds, int item, int tid, int lane, int wave) {
    const unsigned char* ws = P.ws;
    const int h = item & 7, tile = item >> 3, tt0 = tile * 256;
    LAS float* S = (LAS float*)lds;
    LAS int* tab = (LAS int*)(lds + 140 * 1024);
    if (tid == 0) { int id = 0; for (int a = 0; a < 16; ++a) for (int bq = 0; bq < 16 / (a + 1); ++bq) tab[id++] = a * 16 + bq; }
    const bf16* PQ = (const bf16*)(ws + WS_PQ); const bf16* SUBK = (const bf16*)(ws + WS_SUBK);
    const int col = lane & 15, g = lane >> 4;
    unsigned L1[16], L2[16];
#pragma unroll
    for (int q = 0; q < 16; ++q) { L1[q] = 0u; L2[q] = 0u; }
#pragma unroll
    for (int p = 0; p < 2; ++p) {
        {
            bf16x8 Af[2][4];
#pragma unroll
            for (int rho = 0; rho < 2; ++rho)
#pragma unroll
                for (int s = 0; s < 4; ++s) Af[rho][s] = *(const bf16x8*)(PQ + (size_t)(tt0 + 32 * wave + 16 * rho + col) * 2048 + h * 256 + p * 128 + 32 * s + 8 * g);
#pragma unroll
            for (int kap = 0; kap < 8; ++kap) {
                f32x4 a0 = (f32x4){0.f, 0.f, 0.f, 0.f}, a1 = a0;
#pragma unroll
                for (int s = 0; s < 4; ++s) { const bf16x8 bk = *(const bf16x8*)(SUBK + (size_t)((h * 2 + p) * 128 + 16 * kap + col) * 128 + 32 * s + 8 * g);
                    a0 = __builtin_amdgcn_mfma_f32_16x16x32_bf16(Af[0][s], bk, a0, 0, 0, 0); a1 = __builtin_amdgcn_mfma_f32_16x16x32_bf16(Af[1][s], bk, a1, 0, 0, 0); }
#pragma unroll
                for (int i = 0; i < 4; ++i) { S[(32 * wave + 4 * g + i) * 132 + 16 * kap + col] = a0[i]; S[(32 * wave + 16 + 4 * g + i) * 132 + 16 * kap + col] = a1[i]; }
            }
        }
        __syncthreads();
        if (tid < 256) {
            const LAS float* row = S + tid * 132;
#pragma unroll 2
            for (int k4 = 0; k4 < 32; ++k4) { const f32x4 v = *(const LAS f32x4*)(row + 4 * k4);
#pragma unroll
                for (int e = 0; e < 4; ++e) { const unsigned kv = (key_enc(v[e]) & ~127u) | (unsigned)(127 - (4 * k4 + e));
                    if (p == 0) INS16(L1, kv); else INS16(L2, kv); } }
        }
        __syncthreads();
    }
    if (tid < 256) {
        float v1[16], v2[16];
        LAS int* il = (LAS int*)lds + tid * 33;
#pragma unroll
        for (int q = 0; q < 16; ++q) { v1[q] = key_dec((L1[q] & ~127u) | 64u); v2[q] = key_dec((L2[q] & ~127u) | 64u); il[q] = 127 - (int)(L1[q] & 127u); il[16 + q] = 127 - (int)(L2[q] & 127u); }
        unsigned C[16];
#pragma unroll
        for (int q = 0; q < 16; ++q) C[q] = 0u;
        {
            int id = 0;
#pragma unroll
            for (int a = 0; a < 16; ++a)
#pragma unroll
                for (int bq = 0; bq < 16 / (a + 1); ++bq) { const unsigned kv = (key_enc(v1[a] + v2[bq]) & ~63u) | (unsigned)(63 - id); INS16(C, kv); ++id; }
        }
        LDS_WAIT(); asm volatile("" ::: "memory");
        float best[16], e[16], sum = 0.f; int ex[16];
#pragma unroll
        for (int q = 0; q < 16; ++q) { best[q] = key_dec((C[q] & ~63u) | 32u); const int ab = tab[63 - (int)(C[q] & 63u)]; ex[q] = il[ab >> 4] * 128 + il[16 + (ab & 15)]; }
#pragma unroll
        for (int q = 0; q < 16; ++q) { e[q] = __expf(best[q] - best[0]); sum += e[q]; }
        const float inv = 1.0f / sum;
        int* IDX = (int*)(P.ws + WS_IDX) + ((size_t)(tt0 + tid) * 8 + h) * 16; float* GW = (float*)(P.ws + WS_GW) + ((size_t)(tt0 + tid) * 8 + h) * 16;
#pragma unroll
        for (int q = 0; q < 16; ++q) { IDX[q] = ex[q]; GW[q] = e[q] * inv; }
    }
    __syncthreads();
}

__device__ __forceinline__ void peer_token(const Params& P, int t, int lane, float* dstbase) {
    const unsigned char* ws = P.ws;
    float* xrow = P.out + (size_t)t * 1024;
    const float rstd2 = rsqrtf(((const float*)(ws + WS_SSQ2))[t] * (1.0f / 1024.0f) + 1e-6f);
    float x2[16], hn[16], acc[16];
    {
        const f32x4 a0 = *(const f32x4*)(xrow + 8 * lane), a1 = *(const f32x4*)(xrow + 8 * lane + 4), a2 = *(const f32x4*)(xrow + 512 + 8 * lane), a3 = *(const f32x4*)(xrow + 512 + 8 * lane + 4);
        const f32x4 w0 = *(const f32x4*)(P.norm_ffn_w + 8 * lane), w1 = *(const f32x4*)(P.norm_ffn_w + 8 * lane + 4), w2 = *(const f32x4*)(P.norm_ffn_w + 512 + 8 * lane), w3 = *(const f32x4*)(P.norm_ffn_w + 512 + 8 * lane + 4);
#pragma unroll
        for (int i = 0; i < 4; ++i) { x2[i] = a0[i]; x2[4 + i] = a1[i]; x2[8 + i] = a2[i]; x2[12 + i] = a3[i];
            hn[i] = a0[i] * rstd2 * w0[i]; hn[4 + i] = a1[i] * rstd2 * w1[i]; hn[8 + i] = a2[i] * rstd2 * w2[i]; hn[12 + i] = a3[i] * rstd2 * w3[i]; }
    }
#pragma unroll
    for (int i = 0; i < 16; ++i) acc[i] = 0.f;
    const int* IDX = (const int*)(ws + WS_IDX) + (size_t)t * 128; const float* GW = (const float*)(ws + WS_GW) + (size_t)t * 128;
    const bf16* UB = (const bf16*)(ws + WS_UB); const bf16* VB = (const bf16*)(ws + WS_VB);
#pragma unroll 1
    for (int hh = 0; hh < 8; ++hh) {
        const int idv = IDX[hh * 16 + (lane & 15)]; const float gv = GW[hh * 16 + (lane & 15)];
#pragma unroll 1
        for (int half = 0; half < 2; ++half) {
            v4u ur[8][2], vr[8][2];
#pragma unroll
            for (int k = 0; k < 8; ++k) { const int e = __builtin_amdgcn_readlane(idv, half * 8 + k);
                const v4u* up = (const v4u*)(UB + (size_t)e * 1024 + 8 * lane); ur[k][0] = up[0]; ur[k][1] = up[64];
                const v4u* vp = (const v4u*)(VB + (size_t)e * 1024 + 8 * lane); vr[k][0] = vp[0]; vr[k][1] = vp[64]; }
            float d[8];
#pragma unroll
            for (int k = 0; k < 8; ++k) {
                const v4u a = ur[k][0], c = ur[k][1];
                float s = hn[0] * bflo(a.x); s += hn[1] * bfhi(a.x); s += hn[2] * bflo(a.y); s += hn[3] * bfhi(a.y);
                s += hn[4] * bflo(a.z); s += hn[5] * bfhi(a.z); s += hn[6] * bflo(a.w); s += hn[7] * bfhi(a.w);
                s += hn[8] * bflo(c.x); s += hn[9] * bfhi(c.x); s += hn[10] * bflo(c.y); s += hn[11] * bfhi(c.y);
                s += hn[12] * bflo(c.z); s += hn[13] * bfhi(c.z); s += hn[14] * bflo(c.w); s += hn[15] * bfhi(c.w);
                d[k] = s;
            }
            float r4[4], r2[2], r1;
            { const bool up = (lane & 32) != 0;
#pragma unroll
              for (int i = 0; i < 4; ++i) { const float keep = up ? d[4 + i] : d[i], send = up ? d[i] : d[4 + i]; r4[i] = keep + __shfl_xor(send, 32); } }
            { const bool up = (lane & 16) != 0;
#pragma unroll
              for (int i = 0; i < 2; ++i) { const float keep = up ? r4[2 + i] : r4[i], send = up ? r4[i] : r4[2 + i]; r2[i] = keep + __shfl_xor(send, 16); } }
            { const bool up = (lane & 8) != 0; const float keep = up ? r2[1] : r2[0], send = up ? r2[0] : r2[1]; r1 = keep + __shfl_xor(send, 8); }
            r1 += __shfl_xor(r1, 4); r1 += __shfl_xor(r1, 2); r1 += __shfl_xor(r1, 1);
            const int myk = ((lane >> 5) & 1) * 4 + ((lane >> 4) & 1) * 2 + ((lane >> 3) & 1);
            const float act = gelu_tanh(r1) * __shfl(gv, half * 8 + myk);
#pragma unroll
            for (int k = 0; k < 8; ++k) {
                const int srcl = ((k >> 2) & 1) * 32 + ((k >> 1) & 1) * 16 + (k & 1) * 8;
                const float a = __builtin_bit_cast(float, __builtin_amdgcn_readlane(__builtin_bit_cast(int, act), srcl));
                const v4u p = vr[k][0], q = vr[k][1];
                acc[0] += a * bflo(p.x); acc[1] += a * bfhi(p.x); acc[2] += a * bflo(p.y); acc[3] += a * bfhi(p.y);
                acc[4] += a * bflo(p.z); acc[5] += a * bfhi(p.z); acc[6] += a * bflo(p.w); acc[7] += a * bfhi(p.w);
                acc[8] += a * bflo(q.x); acc[9] += a * bfhi(q.x); acc[10] += a * bflo(q.y); acc[11] += a * bfhi(q.y);
                acc[12] += a * bflo(q.z); acc[13] += a * bfhi(q.z); acc[14] += a * bflo(q.w); acc[15] += a * bfhi(q.w);
            }
        }
    }
    float ss = 0.f;
#pragma unroll
    for (int i = 0; i < 16; ++i) { x2[i] += acc[i]; ss += x2[i] * x2[i]; }
    const float rstd3 = rsqrtf(wave_sum(ss) * (1.0f / 1024.0f) + 1e-6f);
    const f32x4 w0 = *(const f32x4*)(P.norm_final_w + 8 * lane), w1 = *(const f32x4*)(P.norm_final_w + 8 * lane + 4), w2 = *(const f32x4*)(P.norm_final_w + 512 + 8 * lane), w3 = *(const f32x4*)(P.norm_final_w + 512 + 8 * lane + 4);
    float* orow = dstbase + (size_t)t * 1024;
    *(f32x4*)(orow + 8 * lane) = (f32x4){x2[0] * rstd3 * w0.x, x2[1] * rstd3 * w0.y, x2[2] * rstd3 * w0.z, x2[3] * rstd3 * w0.w};
    *(f32x4*)(orow + 8 * lane + 4) = (f32x4){x2[4] * rstd3 * w1.x, x2[5] * rstd3 * w1.y, x2[6] * rstd3 * w1.z, x2[7] * rstd3 * w1.w};
    *(f32x4*)(orow + 512 + 8 * lane) = (f32x4){x2[8] * rstd3 * w2.x, x2[9] * rstd3 * w2.y, x2[10] * rstd3 * w2.z, x2[11] * rstd3 * w2.w};
    *(f32x4*)(orow + 512 + 8 * lane + 4) = (f32x4){x2[12] * rstd3 * w3.x, x2[13] * rstd3 * w3.y, x2[14] * rstd3 * w3.z, x2[15] * rstd3 * w3.w};
}

__global__ void __launch_bounds__(NWAVES * 64, 2) hybrid_fwd(Params P) {
    extern __shared__ __attribute__((aligned(16))) unsigned char lds_raw[];
    LAS unsigned char* lds = (LAS unsigned char*)lds_raw;
    volatile LAS unsigned* MISC = (volatile LAS unsigned*)(lds + MISC_OFF);
    const int tid = threadIdx.x, lane = tid & 63, wave = __builtin_amdgcn_readfirstlane(tid >> 6);
    const int G = gridDim.x, bx = blockIdx.x;
    const int vcu = (G % 8 == 0) ? (bx % 8) * (G / 8) + bx / 8 : bx;
    unsigned char* ws = P.ws;
    for (int u = tid; u < 64; u += NWAVES * 64) MISC[u] = 0u;
    __syncthreads();
    XcdBarrier bar; bar.bar = (unsigned*)(ws + WS_CTL) + CW_BAR; bar.x = 0; bar.st = nullptr;
    if (!MK_PER_PHASE) bar = xcd_barrier_post((unsigned*)(ws + WS_CTL) + CW_BAR, MISC + 8);
    const int lo = P.ph_lo, hi = P.ph_hi;
#ifndef PHASE_MASK
#define PHASE_MASK 0xFFF
#endif
#define IN(k) (((PHASE_MASK >> (k)) & 1) && lo <= (k) && (k) < hi)
#define SEAM(k) do { if (IN(k) && IN((k) + 1)) xcd_barrier(bar); } while (0)
#ifndef REP_MASK
#define REP_MASK 0
#endif
#define REPS(k) for (int rep_ = 0; rep_ < (((REP_MASK >> (k)) & 1) ? 2 : 1); ++rep_, (rep_ < (((REP_MASK >> (k)) & 1) ? 2 : 1) ? xcd_barrier(bar) : (void)0))
    using namespace pg8;
    bf16* XB = (bf16*)(ws + WS_XB);

    if (IN(0)) REPS(0) { p0_prologue(P, lds, tid, lane, wave, vcu, G); }
    SEAM(0);
    if (IN(1)) REPS(1) {
        { Gemm gm{XB, (const bf16_t*)(ws + WS_WIN), T, 3072, 1024}; StaticOrder S; S.init(T, 3072, G, bx);
          EpiBf16Rs E{(bf16_t*)(ws + WS_QKV), 1536, 6, (bf16_t*)(ws + WS_XR), 512, (size_t)T * 512, nullptr, 1.0f};
          gemm_phase<EpiBf16Rs, StaticOrder, PG8_ALIGN, PG8_SP2>(lds, gm, S, E); }
        { Gemm gm{(const bf16_t*)(ws + WS_MEMN), (const bf16_t*)(ws + WS_WKV), 512, 2048, 1024}; StaticOrder S; S.init(512, 2048, G, bx);
          EpiKV E{(bf16_t*)(ws + WS_KB), (bf16_t*)(ws + WS_VTP)};
          gemm_phase<EpiKV, StaticOrder, PG8_ALIGN, PG8_SP2>(lds, gm, S, E); }
    }
    SEAM(1);
    if (IN(2)) REPS(2) {
#ifndef NO_GDNL
        for (int it = bx; it < 1024; it += G) gdn_local_item(P, lds, it, tid);
#endif
#ifndef NO_LRUL
        for (int lt = bx; lt < 256; lt += G) lru_local_item(P, lds, lt, tid, lane, wave);
#endif
    }
    SEAM(2);
    if (IN(3)) REPS(3) {
        if (bx < SCAN_WGS) gdn_scan(P, lds, bx, tid, lane, wave);
        else if (bx < SCAN_WGS + 2) lru_carry(P, (bx - SCAN_WGS) * NWAVES + wave, lane);
        else cvt_table(P.peer_u, (bf16*)(ws + WS_UB), (size_t)16384 * 1024 / 8, (size_t)(bx - SCAN_WGS - 2) * (NWAVES * 64) + tid, (size_t)(G - SCAN_WGS - 2) * (NWAVES * 64));
    }
    SEAM(3);
    if (IN(4)) REPS(4) {
        gdn_gate_norm(P, (size_t)bx * (NWAVES * 64) + tid, (size_t)G * (NWAVES * 64));
        lru_combine(P, (size_t)bx * (NWAVES * 64) + tid, (size_t)G * (NWAVES * 64));
        cvt_table(P.peer_v, (bf16*)(ws + WS_VB), (size_t)16384 * 1024 / 8, (size_t)bx * (NWAVES * 64) + tid, (size_t)G * (NWAVES * 64));
    }
    SEAM(4);
    if (IN(5)) {
        Gemm gm{(const bf16_t*)(ws + WS_Y), (const bf16_t*)(ws + WS_WOUT), T, 1024, 1024}; StaticOrder S; S.init(T, 1024, G, bx);
        EpiResid E{P.x, P.out, XB, (float*)(ws + WS_SSQ1)};
        gemm_phase<EpiResid, StaticOrder, PG8_ALIGN, PG8_SP2>(lds, gm, S, E);
    }
    SEAM(5);
    if (IN(6)) REPS(6) {
        Gemm gm{XB, (const bf16_t*)(ws + WS_WQ), T, 1024, 1024}; StaticOrder S; S.init(T, 1024, G, bx);
        EpiBf16Rs E{(bf16_t*)(ws + WS_Q), 1024, 4, nullptr, 256, 0, (const float*)(ws + WS_SSQ1), 0.0625f};
        gemm_phase<EpiBf16Rs, StaticOrder, PG8_ALIGN, PG8_SP2>(lds, gm, S, E);
    }
    SEAM(6);
    if (IN(7)) REPS(7) {
        for (int wu = bx * NWAVES + wave; wu < 4096; wu += G * NWAVES) xattn_unit(P, wu, lane);
    }
    SEAM(7);
    if (IN(8)) {
        Gemm gm{(const bf16_t*)(ws + WS_AO), (const bf16_t*)(ws + WS_WO), T, 1024, 1024}; StaticOrder S; S.init(T, 1024, G, bx);
        EpiResid E{P.out, P.out, XB, (float*)(ws + WS_SSQ2)};
        gemm_phase<EpiResid, StaticOrder, PG8_ALIGN, PG8_SP2>(lds, gm, S, E);
    }
    SEAM(8);
    if (IN(9)) REPS(9) {
        Gemm gm{XB, (const bf16_t*)(ws + WS_PWQ), T, 2048, 1024}; StaticOrder S; S.init(T, 2048, G, bx);
        EpiBf16Rs E{(bf16_t*)(ws + WS_PQ), 2048, 8, nullptr, 256, 0, (const float*)(ws + WS_SSQ2), 1.0f};
        gemm_phase<EpiBf16Rs, StaticOrder, PG8_ALIGN, PG8_SP2>(lds, gm, S, E);
    }
    SEAM(9);
    if (IN(10)) REPS(10) {
        for (int it = bx; it < 512; it += G) peer_topk_item(P, lds, it, tid, lane, wave);
    }
    SEAM(10);
    if (IN(11)) REPS(11) {
        for (int t = bx * NWAVES + wave; t < T; t += G * NWAVES) peer_token(P, t, lane, (((REP_MASK >> 11) & 1) && rep_ == 0) ? (float*)(ws + WS_PQ) : P.out);
    }
#undef IN
#undef SEAM
}

extern "C" void kernel_launch(void* const* d_in, const int* in_sizes, int n_in, void* d_out, int out_size, void* d_ws, size_t ws_size, hipStream_t stream) {
    static int grid = 0;
    if (grid == 0) {
        if (n_in != 27 || in_sizes[0] != T * D || out_size != T * D || ws_size < WS_END) {
            fprintf(stderr, "kernel_launch: unexpected shapes (n_in %d, in0 %d, out %d, ws %zu); nothing launched\n", n_in, n_in > 0 ? in_sizes[0] : -1, out_size, ws_size); grid = -1; return; }
        int dev = 0, cus = 0, per_cu = 0;
        if (hipGetDevice(&dev) != hipSuccess || hipDeviceGetAttribute(&cus, hipDeviceAttributeMultiprocessorCount, dev) != hipSuccess) { grid = -1; return; }
        if (hipFuncSetAttribute((const void*)hybrid_fwd, hipFuncAttributeMaxDynamicSharedMemorySize, LDS_BYTES) != hipSuccess) { fprintf(stderr, "kernel_launch: hipFuncSetAttribute failed\n"); grid = -1; return; }
        if (hipOccupancyMaxActiveBlocksPerMultiprocessor(&per_cu, (const void*)hybrid_fwd, NWAVES * 64, LDS_BYTES) != hipSuccess || per_cu < 1)
            fprintf(stderr, "kernel_launch: note: occupancy query reports %d workgroups per CU\n", per_cu);
        (void)hipGetLastError();
        grid = cus;
        if (grid != 256) fprintf(stderr, "kernel_launch: %d CUs (built for 256)\n", grid);
    }
    if (grid < 0) return;
    if (hipMemsetAsync((char*)d_ws + WS_CTL, 0, CTL_ZERO_BYTES, stream) != hipSuccess) { fprintf(stderr, "kernel_launch: hipMemsetAsync failed\n"); return; }
    Params p{};
    const float** pp = (const float**)&p;
    for (int i = 0; i < 27; ++i) pp[i] = (const float*)d_in[i];
    p.out = (float*)d_out; p.ws = (unsigned char*)d_ws;
#if MK_PER_PHASE
    for (int k = 0; k < N_PHASES; ++k) { p.ph_lo = k; p.ph_hi = k + 1; hipLaunchKernelGGL(hybrid_fwd, dim3(grid), dim3(NWAVES * 64), LDS_BYTES, stream, p); }
#else
    p.ph_lo = 0; p.ph_hi = N_PHASES;
    hipLaunchKernelGGL(hybrid_fwd, dim3(grid), dim3(NWAVES * 64), LDS_BYTES, stream, p);
#endif
    const hipError_t le = hipPeekAtLastError();
    if (le != hipSuccess) fprintf(stderr, "kernel_launch: launch failed: %s\n", hipGetErrorName(le));
}
```

```cpp
#include <hip/hip_runtime.h>
#include <cstdio>
#include <cstdint>
namespace pg8 {
#define PG8_LAS __attribute__((address_space(3)))
typedef unsigned short bf16_t;
typedef short bf16x8 __attribute__((ext_vector_type(8)));
typedef float f32x4 __attribute__((ext_vector_type(4)));
typedef unsigned u32x4 __attribute__((ext_vector_type(4)));
constexpr int BM = 256, BK = 64, HALF = 128, HTB = HALF * BK * 2  , STAGE_BYTES = 8 * HTB, NXCD = 8, WGM = 8;

__host__ __device__ __forceinline__ int lds_byte(int r, int c) { const int st = (r >> 4) * 2 + (c >> 5), rr = r & 15, cc = c & 31, ob = rr * 64 + cc * 2; return st * 1024 + (ob ^ (((ob >> 9) & 1) << 5)); }
__host__ __device__ __forceinline__ void stage_rc(int b, int& R, int& C) { const int st = b / 1024, sb = b % 1024, swz = sb ^ (((sb >> 9) & 1) << 5); R = (st >> 1) * 16 + swz / 64; C = (st & 1) * 32 + (swz % 64) / 2; }
__host__ __device__ __forceinline__ int perm32(int rho) { const int n = rho >> 4, i = rho & 15; return 8 * (i >> 2) + 4 * n + (i & 3); }

struct Unit { int pm, pn; };
struct Gemm { const bf16_t* A; const bf16_t* Bt; int M, N, K; };

struct StaticOrder {
    int nM, nN, nwg, G, c;
    __host__ __device__ void init(int M, int N, int G_, int c_) { nM = M / BM; nN = N / BM; nwg = nM * nN; G = G_; c = c_; }
    __host__ __device__ bool next(int i, Unit& u) const {
        const long L = (long)i * G + c; if (L >= nwg) return false;
        int wgid = (int)L; { const int q = nwg / NXCD, r = nwg % NXCD, xcd = wgid % NXCD, off = wgid / NXCD; wgid = (xcd < r ? xcd * (q + 1) : r * (q + 1) + (xcd - r) * q) + off; }
        const int nig = WGM * nN, gid = wgid / nig, fm = gid * WGM, gsz = (nM - fm) < WGM ? (nM - fm) : WGM;
        u.pm = fm + ((wgid % nig) % gsz); u.pn = (wgid % nig) / gsz; return true;
    }
    __device__ __forceinline__ void a_ready(const Unit&) const {}
    __device__ __forceinline__ void done(const Unit&) const {}
};

__device__ __forceinline__ unsigned cvt_pk_bf16(float lo, float hi) { unsigned r; asm volatile("v_cvt_pk_bf16_f32 %0, %1, %2" : "=v"(r) : "v"(lo), "v"(hi)); return r; }
template <class Epi, class Sched, bool ALIGN_EPI = false, bool SP2 = false>
__device__ __forceinline__ void gemm_phase(PG8_LAS unsigned char* lds, const Gemm g, const Sched& S, const Epi& E) {
    const int tid = threadIdx.x, wid = __builtin_amdgcn_readfirstlane(tid >> 6), lane = tid & 63, wr = wid >> 2, wc = wid & 3, fr = lane & 15, fq = lane >> 4;
    const int K = g.K, nt = K / BK;
    unsigned voffA[2], voffB[2];
#pragma unroll
    for (int i = 0; i < 2; ++i) { int R, C; stage_rc(tid * 16 + i * 8192, R, C); const int Rb = Epi::PERM ? ((R & ~31) + perm32(R & 31)) : R;
        voffA[i] = (unsigned)(R * K + C) * 2u; voffB[i] = (unsigned)(Rb * K + C) * 2u; }
    const size_t kstep = (size_t)(BK * 2);
    const size_t hstep = (size_t)HALF * K * 2;
    const size_t tstep = 2 * hstep;
    const unsigned ldsw = (unsigned)wid * 1024u;
    const int aoff = lds_byte(wr * 64 + fr, fq * 8), boff = lds_byte(wc * 32 + fr, fq * 8);
#define PG8_SA(b, h) (((b) * 2 + (h)) * HTB)
#define PG8_SB(b, h) ((4 + (b) * 2 + (h)) * HTB)
#define PG8_STAGE(bufoff, gbase, voff) do { _Pragma("unroll") for (int _i = 0; _i < 2; ++_i) \
        __builtin_amdgcn_global_load_lds((const unsigned*)((const char*)(gbase) + (voff)[_i]), (PG8_LAS unsigned*)(lds + (bufoff) + ldsw + _i * 8192), 16, 0, 0); } while (0)
#define PG8_LDA(dst, b, h) do { _Pragma("unroll") for (int m = 0; m < 4; ++m) _Pragma("unroll") for (int k = 0; k < 2; ++k) dst[m][k] = *(const PG8_LAS bf16x8*)(lds + PG8_SA(b, h) + aoff + m * 2048 + k * 1024); } while (0)
#define PG8_LDB(dst, b, h) do { _Pragma("unroll") for (int n = 0; n < 2; ++n) _Pragma("unroll") for (int k = 0; k < 2; ++k) dst[n][k] = *(const PG8_LAS bf16x8*)(lds + PG8_SB(b, h) + boff + n * 2048 + k * 1024); } while (0)
#define PG8_MMA(ai, bj, At, Bt) do { __builtin_amdgcn_s_setprio(1); _Pragma("unroll") for (int m = 0; m < 4; ++m) _Pragma("unroll") for (int n = 0; n < 2; ++n) _Pragma("unroll") for (int k = 0; k < 2; ++k) \
        acc[ai][bj][m][n] = __builtin_amdgcn_mfma_f32_16x16x32_bf16(Bt[n][k], At[m][k], acc[ai][bj][m][n], 0, 0, 0); __builtin_amdgcn_s_setprio(0); } while (0)
#define PG8_WAIT_V(n) asm volatile("s_waitcnt vmcnt(" #n ")" ::: "memory")
#define PG8_WAIT_L(n) asm volatile("s_waitcnt lgkmcnt(" #n ")" ::: "memory")
#define PG8_BAR __builtin_amdgcn_s_barrier()
#define PG8_SCHED __builtin_amdgcn_sched_barrier(0)
    Unit cur, nxt; int ui = 0;
    if (!S.next(0, cur)) return;
    f32x4 acc[2][2][4][2];
#pragma unroll
    for (int a = 0; a < 2; ++a)
#pragma unroll
        for (int b = 0; b < 2; ++b)
#pragma unroll
            for (int m = 0; m < 4; ++m)
#pragma unroll
                for (int n = 0; n < 2; ++n) acc[a][b][m][n] = (f32x4){0.f, 0.f, 0.f, 0.f};
    bf16x8 At[4][2], B0[2][2], B1[2][2];
    const char* cA = (const char*)g.A + (size_t)cur.pm * tstep; const char* cB = (const char*)g.Bt + (size_t)cur.pn * tstep;
    S.a_ready(cur);
    if constexpr (SP2) {
        PG8_STAGE(PG8_SB(0, 0), cB, voffB); PG8_STAGE(PG8_SB(0, 1), cB + hstep, voffB); PG8_STAGE(PG8_SA(0, 0), cA, voffA); PG8_STAGE(PG8_SA(0, 1), cA + hstep, voffA);
        if (wr == 1) PG8_BAR;
        PG8_WAIT_V(2); PG8_BAR;
        PG8_STAGE(PG8_SB(1, 0), cB + kstep, voffB); PG8_STAGE(PG8_SA(1, 0), cA + kstep, voffA); PG8_STAGE(PG8_SB(1, 1), cB + hstep + kstep, voffB);
        PG8_WAIT_V(6); PG8_BAR;
    } else {
        PG8_STAGE(PG8_SB(0, 0), cB, voffB); PG8_STAGE(PG8_SA(0, 0), cA, voffA); PG8_STAGE(PG8_SB(0, 1), cB + hstep, voffB); PG8_STAGE(PG8_SA(0, 1), cA + hstep, voffA);
        if (wr == 1) PG8_BAR;
        PG8_WAIT_V(4); PG8_BAR;
        PG8_STAGE(PG8_SB(1, 0), cB + kstep, voffB); PG8_STAGE(PG8_SA(1, 0), cA + kstep, voffA); PG8_STAGE(PG8_SB(1, 1), cB + hstep + kstep, voffB);
        PG8_WAIT_V(6); PG8_BAR;
    }
    for (;;) {
        const bool has_next = S.next(ui + 1, nxt);
        const char* nA = has_next ? (const char*)g.A + (size_t)nxt.pm * tstep : cA; const char* nB = has_next ? (const char*)g.Bt + (size_t)nxt.pn * tstep : cB;
        for (int t = 0; t < nt; t += 2) {
            const bool last = (t == nt - 2);
            const char* a1 = cA + (size_t)(t + 1) * kstep;
            const char* a2 = last ? nA : cA + (size_t)(t + 2) * kstep; const char* b2 = last ? nB : cB + (size_t)(t + 2) * kstep;
            const char* a3 = a2 + kstep; const char* b3 = b2 + kstep;
            if (last && has_next) S.a_ready(nxt);
            if constexpr (SP2) {
            PG8_LDB(B0, 0, 0); PG8_LDB(B1, 0, 1); PG8_SCHED; PG8_LDA(At, 0, 0); PG8_STAGE(PG8_SA(1, 1), a1 + hstep, voffA);
            PG8_WAIT_V(8); PG8_WAIT_L(0); PG8_BAR; PG8_MMA(0, 0, At, B0); PG8_MMA(0, 1, At, B1); PG8_BAR; PG8_SCHED;
            PG8_LDA(At, 0, 1); PG8_STAGE(PG8_SB(0, 0), b2, voffB); PG8_STAGE(PG8_SB(0, 1), b2 + hstep, voffB); PG8_STAGE(PG8_SA(0, 0), a2, voffA);
            PG8_WAIT_V(8); PG8_WAIT_L(0); PG8_BAR; PG8_MMA(1, 0, At, B0); PG8_MMA(1, 1, At, B1); PG8_BAR; PG8_SCHED;
            PG8_LDB(B0, 1, 0); PG8_LDB(B1, 1, 1); PG8_SCHED; PG8_LDA(At, 1, 0); PG8_STAGE(PG8_SA(0, 1), a2 + hstep, voffA);
            PG8_WAIT_V(8); PG8_WAIT_L(0); PG8_BAR; PG8_MMA(0, 0, At, B0); PG8_MMA(0, 1, At, B1); PG8_BAR; PG8_SCHED;
            PG8_LDA(At, 1, 1); PG8_STAGE(PG8_SB(1, 0), b3, voffB); PG8_STAGE(PG8_SB(1, 1), b3 + hstep, voffB); PG8_STAGE(PG8_SA(1, 0), a3, voffA);
            PG8_WAIT_V(8); PG8_WAIT_L(0); PG8_BAR; PG8_MMA(1, 0, At, B0); PG8_MMA(1, 1, At, B1); PG8_BAR; PG8_SCHED;
            } else {
            PG8_LDB(B0, 0, 0); PG8_SCHED; PG8_LDA(At, 0, 0); PG8_STAGE(PG8_SA(1, 1), a1 + hstep, voffA);
            PG8_WAIT_L(8); PG8_BAR; PG8_WAIT_L(0); PG8_MMA(0, 0, At, B0); PG8_BAR; PG8_SCHED;
            PG8_LDB(B1, 0, 1); PG8_STAGE(PG8_SB(0, 0), b2, voffB);
            PG8_BAR; PG8_WAIT_L(0); PG8_MMA(0, 1, At, B1); PG8_BAR;
            PG8_LDA(At, 0, 1); PG8_STAGE(PG8_SA(0, 0), a2, voffA);
            PG8_BAR; PG8_WAIT_L(0); PG8_MMA(1, 0, At, B0); PG8_BAR; PG8_SCHED;
            PG8_STAGE(PG8_SB(0, 1), b2 + hstep, voffB);
            PG8_WAIT_V(6); PG8_BAR; PG8_MMA(1, 1, At, B1); PG8_BAR;
            PG8_LDB(B0, 1, 0); PG8_SCHED; PG8_LDA(At, 1, 0); PG8_STAGE(PG8_SA(0, 1), a2 + hstep, voffA);
            PG8_WAIT_L(8); PG8_BAR; PG8_WAIT_L(0); PG8_MMA(0, 0, At, B0); PG8_BAR; PG8_SCHED;
            PG8_LDB(B1, 1, 1); PG8_STAGE(PG8_SB(1, 0), b3, voffB);
            PG8_BAR; PG8_WAIT_L(0); PG8_MMA(0, 1, At, B1); PG8_BAR;
            PG8_LDA(At, 1, 1); PG8_STAGE(PG8_SA(1, 0), a3, voffA);
            PG8_BAR; PG8_WAIT_L(0); PG8_MMA(1, 0, At, B0); PG8_BAR; PG8_SCHED;
            PG8_STAGE(PG8_SB(1, 1), b3 + hstep, voffB);
            PG8_WAIT_V(6); PG8_BAR; PG8_MMA(1, 1, At, B1); PG8_BAR;
            }
        }
        if constexpr (ALIGN_EPI) { if (wr == 0) PG8_BAR; }
        if constexpr (!Epi::AFTER_DRAIN) { E(acc, cur, wr, wc, fr, fq); S.done(cur); }
        if (!has_next) break;
#pragma unroll
        for (int a = 0; a < 2; ++a)
#pragma unroll
            for (int b = 0; b < 2; ++b)
#pragma unroll
                for (int m = 0; m < 4; ++m)
#pragma unroll
                    for (int n = 0; n < 2; ++n) acc[a][b][m][n] = (f32x4){0.f, 0.f, 0.f, 0.f};
        cur = nxt; cA = nA; cB = nB; ++ui;
        if constexpr (ALIGN_EPI) { if (wr == 1) PG8_BAR; }
    }
    PG8_WAIT_V(0);
    if constexpr (!ALIGN_EPI) { if (wr == 0) PG8_BAR; }
    PG8_BAR;
    if constexpr (Epi::AFTER_DRAIN) { E.fused(acc, cur, wr, wc, fr, fq, lds, wid, lane); S.done(cur); }
#undef PG8_SA
#undef PG8_SB
#undef PG8_STAGE
#undef PG8_LDA
#undef PG8_LDB
#undef PG8_MMA
#undef PG8_WAIT_V
#undef PG8_WAIT_L
#undef PG8_BAR
#undef PG8_SCHED
}
}

namespace pg8 {
__host__ __device__ __forceinline__ int permk(int kl) { return 8 * ((kl & 15) >> 2) + 4 * (kl >> 4) + (kl & 3); }
struct EpiBf16Rs {
    static constexpr bool PERM = true, AFTER_DRAIN = false;
    bf16_t* O0; int ld0; int ntile0; bf16_t* O1; int ld1; size_t stride1; const float* ssq; float cs;
    __device__ __forceinline__ void operator()(const f32x4 (&acc)[2][2][4][2], const Unit& u, int wr, int wc, int fr, int fq) const {
        bf16_t* base; int ld, colt;
        if (u.pn < ntile0) { base = O0; ld = ld0; colt = u.pn * BM; }
        else { const int q = u.pn - ntile0, per = ld1 / BM; base = O1 + (size_t)(q / per) * stride1; ld = ld1; colt = (q % per) * BM; }
        const int row0 = u.pm * BM + wr * 64 + fr, col0 = colt + wc * 32 + 8 * fq;
#pragma unroll
        for (int ai = 0; ai < 2; ++ai)
#pragma unroll
            for (int m = 0; m < 4; ++m) {
                const int row = row0 + ai * HALF + m * 16;
                float sc = cs; if (ssq) sc *= rsqrtf(ssq[row] * (1.0f / 1024.0f) + 1e-6f);
                bf16_t* rowp = base + (size_t)row * ld + col0;
#pragma unroll
                for (int bj = 0; bj < 2; ++bj) { const f32x4 v0 = acc[ai][bj][m][0] * sc, v1 = acc[ai][bj][m][1] * sc;
                    u32x4 w; w.x = cvt_pk_bf16(v0[0], v0[1]); w.y = cvt_pk_bf16(v0[2], v0[3]); w.z = cvt_pk_bf16(v1[0], v1[1]); w.w = cvt_pk_bf16(v1[2], v1[3]);
                    *(u32x4*)(rowp + bj * HALF) = w; } }
    }
};
struct EpiResid {
    static constexpr bool PERM = false, AFTER_DRAIN = false;
    const float* base; float* out; bf16_t* xb; float* ssq;
    __device__ __forceinline__ void operator()(const f32x4 (&acc)[2][2][4][2], const Unit& u, int wr, int wc, int fr, int fq) const {
        typedef unsigned u32x2v __attribute__((ext_vector_type(2)));
        const int row0 = u.pm * BM + wr * 64 + fr, col0 = u.pn * BM + wc * 32 + 4 * fq;
#pragma unroll
        for (int ai = 0; ai < 2; ++ai)
#pragma unroll
            for (int m = 0; m < 4; ++m) {
                const int row = row0 + ai * HALF + m * 16; const size_t off = (size_t)row * 1024 + col0; float s = 0.f;
#pragma unroll
                for (int bj = 0; bj < 2; ++bj)
#pragma unroll
                    for (int n = 0; n < 2; ++n) { const size_t o2 = off + bj * HALF + n * 16;
                        const f32x4 o = *(const f32x4*)(base + o2) + acc[ai][bj][m][n];
                        *(f32x4*)(out + o2) = o; s += (o[0] * o[0] + o[1] * o[1]) + (o[2] * o[2] + o[3] * o[3]);
                        u32x2v w; w.x = cvt_pk_bf16(o[0], o[1]); w.y = cvt_pk_bf16(o[2], o[3]); *(u32x2v*)(xb + o2) = w; }
                s += __shfl_xor(s, 16); s += __shfl_xor(s, 32);
                if (fq == 0) atomicAdd(ssq + row, s);
            }
    }
};
struct EpiKV {
    static constexpr bool PERM = false, AFTER_DRAIN = false;
    bf16_t* Kb; bf16_t* VTp;
    __device__ __forceinline__ void operator()(const f32x4 (&acc)[2][2][4][2], const Unit& u, int wr, int wc, int fr, int fq) const {
        typedef unsigned u32x2v __attribute__((ext_vector_type(2)));
        const int row0 = u.pm * BM + wr * 64 + fr, col0 = u.pn * BM + wc * 32 + 4 * fq;
#pragma unroll
        for (int ai = 0; ai < 2; ++ai)
#pragma unroll
            for (int m = 0; m < 4; ++m) {
                const int row = row0 + ai * HALF + m * 16, b = row >> 8, key = row & 255;
#pragma unroll
                for (int bj = 0; bj < 2; ++bj)
#pragma unroll
                    for (int n = 0; n < 2; ++n) { const int col = col0 + bj * HALF + n * 16; const f32x4 v = acc[ai][bj][m][n];
                        const unsigned p01 = cvt_pk_bf16(v[0], v[1]), p23 = cvt_pk_bf16(v[2], v[3]);
                        if (col < 1024) { const int h = col >> 8, dh = col & 255; u32x2v w; w.x = p01; w.y = p23;
                            *(u32x2v*)(Kb + ((size_t)((b * 4 + h) * 256 + key)) * 256 + dh) = w; }
                        else { const int c2 = col - 1024, h = c2 >> 8, dv = c2 & 255, kp = (key & ~31) | permk(key & 31);
                            bf16_t* d = VTp + ((size_t)((b * 4 + h) * 256 + dv)) * 256 + kp;
                            d[0] = (bf16_t)(p01 & 0xffffu); d[256] = (bf16_t)(p01 >> 16); d[512] = (bf16_t)(p23 & 0xffffu); d[768] = (bf16_t)(p23 >> 16); } }
            }
    }
};
}
#ifndef PG8_SP2
#define PG8_SP2 true
#endif
#ifndef PG8_ALIGN
#define PG8_ALIGN true
#endif

constexpr int NWAVES = 8;
#ifndef MK_PER_PHASE
#define MK_PER_PHASE 0
#endif
constexpr int T = 16384, SEQ = 8192, D = 1024;
constexpr int N_PHASES = 12;

constexpr size_t MiB = 1u << 20, KiB = 1u << 10;
constexpr size_t WS_CTL = 0, CTL_ZERO_BYTES = 1 * MiB;
constexpr int CW_BAR = 4096;
constexpr size_t WS_SSQ1 = 64 * KiB, WS_SSQ2 = 128 * KiB;
constexpr size_t WS_AB = 1 * MiB;
constexpr size_t WS_HEND = WS_AB + 512 * KiB, WS_PEND = WS_HEND + 512 * KiB, WS_HIN = WS_PEND + 512 * KiB;
constexpr size_t WS_DEC = WS_HIN + 512 * KiB;
constexpr size_t WS_SUBK = 3 * MiB + 256 * KiB;
constexpr size_t WS_WIN = 4 * MiB, WS_WOUT = 10 * MiB, WS_WQ = 12 * MiB, WS_WKV = 14 * MiB, WS_WO = 18 * MiB, WS_PWQ = 20 * MiB;
constexpr size_t WS_MEMN = 24 * MiB, WS_KB = 25 * MiB, WS_VTP = 26 * MiB;
constexpr size_t WS_XB = 28 * MiB;
constexpr size_t WS_HLOC = 28 * MiB, WS_PCUM = 44 * MiB;
constexpr size_t WS_QKV = 60 * MiB;
constexpr size_t WS_Y = 60 * MiB;
constexpr size_t WS_IDX = 60 * MiB, WS_GW = 68 * MiB;
constexpr size_t WS_UB = 92 * MiB;
constexpr size_t WS_XR = 108 * MiB, WS_Z = 124 * MiB, WS_GATE = 140 * MiB;
constexpr size_t WS_WN = 156 * MiB, WS_UF = 172 * MiB, WS_QD = 188 * MiB, WS_KD = 204 * MiB, WS_ATT = 220 * MiB;
constexpr size_t WS_VB = 156 * MiB;
constexpr size_t WS_Q = 188 * MiB, WS_AO = 220 * MiB;
constexpr size_t WS_PQ = 188 * MiB;
constexpr size_t WS_END = 252 * MiB;
static_assert(WS_XR - WS_QKV == (size_t)T * 1536 * 2 && WS_Z - WS_XR == (size_t)T * 512 * 2 && WS_GATE - WS_Z == (size_t)T * 512 * 2, "in-proj outputs are contiguous");

constexpr int LDS_BYTES = 160 * 1024;
constexpr int MISC_OFF = 159 * 1024;

#define GAS __attribute__((address_space(1)))
#define LAS __attribute__((address_space(3)))
typedef unsigned short bf16;
typedef unsigned v4u __attribute__((ext_vector_type(4)));
typedef unsigned v2u __attribute__((ext_vector_type(2)));
typedef float f32x4 __attribute__((ext_vector_type(4)));
typedef short bf16x8 __attribute__((ext_vector_type(8)));
typedef GAS unsigned gu32;
#define LDS_WAIT() asm volatile("s_waitcnt lgkmcnt(0)" ::: "memory")
__device__ __forceinline__ unsigned f2bf(float f) { unsigned u = __builtin_bit_cast(unsigned, f); return (u + 0x7fffu + ((u >> 16) & 1u)) >> 16; }
__device__ __forceinline__ unsigned pk2(float lo, float hi) { return f2bf(lo) | (f2bf(hi) << 16); }
__device__ __forceinline__ float bflo(unsigned u) { return __builtin_bit_cast(float, u << 16); }
__device__ __forceinline__ float bfhi(unsigned u) { return __builtin_bit_cast(float, u & 0xffff0000u); }
__device__ __forceinline__ float bf1(bf16 h) { return __builtin_bit_cast(float, (unsigned)h << 16); }
__device__ __forceinline__ float wave_sum(float v) {
#pragma unroll
    for (int o = 1; o < 64; o <<= 1) v += __shfl_xor(v, o);
    return v;
}
__device__ __forceinline__ float sigmoidf_(float x) { return 1.0f / (1.0f + __expf(-x)); }
__device__ __forceinline__ float softplusf_(float x) { return fmaxf(x, 0.f) + log1pf(__expf(-fabsf(x))); }
__device__ __forceinline__ float siluf_(float x) { return x / (1.0f + __expf(-x)); }
__device__ __forceinline__ float gelu_tanh(float x) { const float y = 0.7978845608028654f * (x + 0.044715f * x * x * x); const float e = __expf(2.0f * y); return 0.5f * x * (2.0f - 2.0f / (1.0f + e)); }
__device__ __forceinline__ int permk(int kl) { return 8 * ((kl & 15) >> 2) + 4 * (kl >> 4) + (kl & 3); }

struct Params {
    const float *x, *mem, *norm_mix_w, *w_in, *conv_qkv_w, *gdn_a_log, *gdn_dt_bias, *gdn_norm_w, *lru_conv_w, *lru_conv_b, *lru_wa, *lru_ba, *lru_wx, *lru_bx, *lru_lambda, *w_out,
                *norm_xattn_w, *norm_mem_w, *xattn_wq, *xattn_wkv, *xattn_wo, *norm_ffn_w, *peer_wq, *peer_subkeys, *peer_u, *peer_v, *norm_final_w;
    float* out; unsigned char* ws; int ph_lo, ph_hi;
};
#define XB_TMO      128
#define XB_XCNT(j)  (256  + 64 * (j))
#define XB_XSUB(j)  (1280 + 64 * (j))
#define XB_XGEN(j)  (2304 + 64 * (j))
#define XB_TOP      3328
#define XB_TOPGEN   3392
#define XCD_BAR_WORDS 3456
#define XB_SPIN_CAP (1u << 18)

__device__ __forceinline__ unsigned xb_ld(unsigned* p)              { return __hip_atomic_load(p, __ATOMIC_RELAXED, __HIP_MEMORY_SCOPE_AGENT); }
__device__ __forceinline__ unsigned xb_add(unsigned* p, unsigned v) { return __hip_atomic_fetch_add(p, v, __ATOMIC_RELAXED, __HIP_MEMORY_SCOPE_AGENT); }
__device__ __forceinline__ unsigned xb_xcc_id() { return (unsigned)__builtin_amdgcn_s_getreg((3 << 11) | 20) & 0xFu; }
#define XB_SPIN(cond, bar) do { unsigned _sp = 0; while (cond) { __builtin_amdgcn_s_sleep(1); \
    if ((++_sp & 255u) == 0u) { if (xb_ld(&(bar)[XB_TMO])) break; if (_sp > XB_SPIN_CAP) { atomicAdd(&(bar)[XB_TMO], 1u); break; } } } } while (0)

struct XcdBarrier {
    unsigned* bar; unsigned x;
    volatile LAS unsigned* st;
};

__device__ __forceinline__ XcdBarrier xcd_barrier_post(unsigned* bar, volatile LAS unsigned* st) {
    XcdBarrier b; b.bar = bar; b.x = xb_xcc_id(); b.st = st;
    if (threadIdx.x == 0) (void)xb_add(&bar[XB_XCNT(b.x)], 1u);
    return b;
}
__device__ __forceinline__ void xcd_barrier_complete(unsigned* bar, unsigned x, unsigned& nloc, unsigned& nx) {
    const unsigned G = gridDim.x * gridDim.y * gridDim.z;
    unsigned sum, cnt, mine, sp = 0u;
    for (;;) {
        sum = 0u; cnt = 0u; mine = 0u;
#pragma unroll
        for (unsigned j = 0; j < 16; ++j) { const unsigned c = xb_ld(&bar[XB_XCNT(j)]); sum += c; cnt += (c > 0u) ? 1u : 0u; mine = (j == x) ? c : mine; }
        if (sum == G) break;
        __builtin_amdgcn_s_sleep(1);
        if ((++sp & 255u) == 0u) { if (xb_ld(&bar[XB_TMO])) break; if (sp > XB_SPIN_CAP) { atomicAdd(&bar[XB_TMO], 1u); break; } }
    }
    nloc = mine > 0u ? mine : 1u; nx = cnt > 0u ? cnt : 1u;
}

__device__ __forceinline__ void xcd_barrier(const XcdBarrier& b) {
    asm volatile("s_waitcnt vmcnt(0)" ::: "memory");
    __syncthreads();
    if (threadIdx.x == 0) {
        unsigned* bar = b.bar;
        __builtin_amdgcn_s_waitcnt(0);
        unsigned nloc = b.st[0], nx = b.st[1];
        if (nloc == 0u) { xcd_barrier_complete(bar, b.x, nloc, nx); b.st[0] = nloc; b.st[1] = nx; }
        const unsigned old = xb_add(&bar[XB_XSUB(b.x)], 1u);
        const unsigned gen = old / nloc;
        if (old + 1u == (gen + 1u) * nloc) {
            __builtin_amdgcn_fence(__ATOMIC_RELEASE, "agent");
            asm volatile("s_waitcnt vmcnt(0)" ::: "memory");
            const unsigned og = xb_add(&bar[XB_TOP], 1u);
            const unsigned tg = og / nx;
            if (og + 1u == (tg + 1u) * nx) xb_add(&bar[XB_TOPGEN], 1u);
            else XB_SPIN(xb_ld(&bar[XB_TOPGEN]) == tg, bar);
            __builtin_amdgcn_fence(__ATOMIC_ACQUIRE, "agent");
            xb_add(&bar[XB_XGEN(b.x)], 1u);
            asm volatile("s_waitcnt vmcnt(0)" ::: "memory");
        } else {
            XB_SPIN(xb_ld(&bar[XB_XGEN(b.x)]) == gen, bar);
            __builtin_amdgcn_fence(__ATOMIC_ACQUIRE, "agent");
            asm volatile("s_waitcnt vmcnt(0)" ::: "memory");
        }
    }
    __syncthreads();
}

__device__ __forceinline__ void p0_transpose_item(const float* W, int K, int ldw, int c0, int nblk, bf16* WT, int row_off, const float* ks, LAS float* scr, int item, int lane) {
    const int kb = item / nblk, nb = item % nblk, k0 = 64 * kb, n0 = 32 * nb;
#pragma unroll 8
    for (int i = 0; i < 32; ++i) { const int kk = 2 * i + (lane >> 5); float v = W[(size_t)(k0 + kk) * ldw + c0 + n0 + (lane & 31)]; if (ks) v *= ks[k0 + kk]; scr[kk * 33 + (lane & 31)] = v; }
    LDS_WAIT(); asm volatile("" ::: "memory");
    const int c = lane & 7;
#pragma unroll
    for (int j = 0; j < 4; ++j) { const int n = (lane >> 3) + 8 * j; const LAS float* s = scr + (8 * c) * 33 + n;
        v4u o; o.x = pk2(s[0 * 33], s[1 * 33]); o.y = pk2(s[2 * 33], s[3 * 33]); o.z = pk2(s[4 * 33], s[5 * 33]); o.w = pk2(s[6 * 33], s[7 * 33]);
        *(GAS v4u*)(WT + (size_t)(row_off + n0 + n) * K + k0 + 8 * c) = o; }
    LDS_WAIT(); asm volatile("" ::: "memory");
}

__device__ __forceinline__ void p0_prologue(const Params& P, LAS unsigned char* lds, int tid, int lane, int wave, int vcu, int G) {
    unsigned char* ws = P.ws;
    const int gw = vcu * NWAVES + wave, NGW = G * NWAVES;
    LAS float* wabl = (LAS float*)lds;
    for (int idx = tid; idx < 8192; idx += NWAVES * 64) { const int k = idx >> 3, c = idx & 7, j = k >> 8, l = (k >> 2) & 63, e = k & 3;
        wabl[((((j * 4 + e) * 2 + (c >> 2)) * 64 + l) << 2) + (c & 3)] = P.w_in[(size_t)k * 3080 + 2048 + c]; }
    __syncthreads();
    {
        bf16* XB0 = (bf16*)(ws + WS_XB); float* AB = (float*)(ws + WS_AB);
        f32x4 w4[4];
#pragma unroll
        for (int j = 0; j < 4; ++j) w4[j] = ((const f32x4*)P.norm_mix_w)[64 * j + lane];
        for (int m = gw; m < T; m += NGW) {
            const f32x4* xr = (const f32x4*)(P.x + (size_t)m * D) + lane;
            f32x4 v[4]; float s = 0.f;
#pragma unroll
            for (int j = 0; j < 4; ++j) { v[j] = xr[64 * j]; s += (v[j].x * v[j].x + v[j].y * v[j].y) + (v[j].z * v[j].z + v[j].w * v[j].w); }
            const float rstd = rsqrtf(wave_sum(s) * (1.0f / D) + 1e-6f);
            v2u* o8 = (v2u*)(XB0 + (size_t)m * D) + lane;
            float part[8];
#pragma unroll
            for (int c = 0; c < 8; ++c) part[c] = 0.f;
#pragma unroll
            for (int j = 0; j < 4; ++j) {
                v[j] = v[j] * rstd * w4[j];
                v2u o; o.x = pk2(v[j].x, v[j].y); o.y = pk2(v[j].z, v[j].w); o8[64 * j] = o;
#pragma unroll
                for (int e = 0; e < 4; ++e) {
                    const f32x4 wa = *(const LAS f32x4*)(wabl + ((((j * 4 + e) * 2 + 0) * 64 + lane) << 2));
                    const f32x4 wb = *(const LAS f32x4*)(wabl + ((((j * 4 + e) * 2 + 1) * 64 + lane) << 2));
                    const float hv = v[j][e];
                    part[0] += hv * wa.x; part[1] += hv * wa.y; part[2] += hv * wa.z; part[3] += hv * wa.w;
                    part[4] += hv * wb.x; part[5] += hv * wb.y; part[6] += hv * wb.z; part[7] += hv * wb.w;
                }
            }
#pragma unroll
            for (int c = 0; c < 8; ++c) part[c] = wave_sum(part[c]);
            float o = part[0];
#pragma unroll
            for (int c = 1; c < 8; ++c) o = (lane == c) ? part[c] : o;
            if (lane < 8) AB[(size_t)m * 8 + lane] = o;
        }
    }
    {
        bf16* MEMN = (bf16*)(ws + WS_MEMN);
        for (int m = gw; m < 512; m += NGW) {
            const f32x4* xr = (const f32x4*)(P.mem + (size_t)m * D) + lane;
            f32x4 v[4]; float s = 0.f;
#pragma unroll
            for (int j = 0; j < 4; ++j) { v[j] = xr[64 * j]; s += (v[j].x * v[j].x + v[j].y * v[j].y) + (v[j].z * v[j].z + v[j].w * v[j].w); }
            const float rstd = rsqrtf(wave_sum(s) * (1.0f / D) + 1e-6f);
            v2u* o8 = (v2u*)(MEMN + (size_t)m * D) + lane;
#pragma unroll
            for (int j = 0; j < 4; ++j) { const f32x4 w = ((const f32x4*)P.norm_mem_w)[64 * j + lane]; const f32x4 y = v[j] * rstd * w;
                v2u o; o.x = pk2(y.x, y.y); o.y = pk2(y.z, y.w); o8[64 * j] = o; }
        }
    }
    __syncthreads();
    {
        LAS float* scr = (LAS float*)(lds + wave * 16384);
        constexpr int I_IN1 = 16 * 48, I_IN2 = 16 * 16, I_OUT = 16 * 32, I_Q = 16 * 32, I_KV = 16 * 64, I_O = 16 * 32, I_PQ = 16 * 64;
        constexpr int NITEMS = I_IN1 + 3 * I_IN2 + I_OUT + I_Q + I_KV + I_O + I_PQ;
        for (int it = gw; it < NITEMS; it += NGW) {
            int r = it;
            if (r < I_IN1) { p0_transpose_item(P.w_in, 1024, 3080, 0, 48, (bf16*)(ws + WS_WIN), 0, nullptr, scr, r, lane); continue; } r -= I_IN1;
            if (r < I_IN2) { p0_transpose_item(P.w_in, 1024, 3080, 2056, 16, (bf16*)(ws + WS_WIN), 1536, nullptr, scr, r, lane); continue; } r -= I_IN2;
            if (r < I_IN2) { p0_transpose_item(P.w_in, 1024, 3080, 1536, 16, (bf16*)(ws + WS_WIN), 2048, nullptr, scr, r, lane); continue; } r -= I_IN2;
            if (r < I_IN2) { p0_transpose_item(P.w_in, 1024, 3080, 2568, 16, (bf16*)(ws + WS_WIN), 2560, nullptr, scr, r, lane); continue; } r -= I_IN2;
            if (r < I_OUT) { p0_transpose_item(P.w_out, 1024, 1024, 0, 32, (bf16*)(ws + WS_WOUT), 0, nullptr, scr, r, lane); continue; } r -= I_OUT;
            if (r < I_Q) { p0_transpose_item(P.xattn_wq, 1024, 1024, 0, 32, (bf16*)(ws + WS_WQ), 0, P.norm_xattn_w, scr, r, lane); continue; } r -= I_Q;
            if (r < I_KV) { p0_transpose_item(P.xattn_wkv, 1024, 2048, 0, 64, (bf16*)(ws + WS_WKV), 0, nullptr, scr, r, lane); continue; } r -= I_KV;
            if (r < I_O) { p0_transpose_item(P.xattn_wo, 1024, 1024, 0, 32, (bf16*)(ws + WS_WO), 0, nullptr, scr, r, lane); continue; } r -= I_O;
            p0_transpose_item(P.peer_wq, 1024, 2048, 0, 64, (bf16*)(ws + WS_PWQ), 0, P.norm_ffn_w, scr, r, lane);
        }
    }
    {
        bf16* SUBK = (bf16*)(ws + WS_SUBK);
        for (int i = (vcu * NWAVES * 64 + tid); i < 16 * 128 * 128 / 4; i += G * NWAVES * 64) {
            const f32x4 v = ((const f32x4*)P.peer_subkeys)[i]; v2u o; o.x = pk2(v.x, v.y); o.y = pk2(v.z, v.w); ((v2u*)SUBK)[i] = o; }
    }
}

__device__ __forceinline__ void gdn_local_item(const Params& P, LAS unsigned char* lds, int item, int tid) {
    unsigned char* ws = P.ws;
    const int b = item >> 9, h = (item >> 7) & 3, n = item & 127;
    const int t0 = b * SEQ + n * 64;
    LAS float* ks = (LAS float*)lds;
    LAS float* vs = ks + 64 * 132;
    LAS float* AmT = vs + 64 * 132;
    LAS float* sg = AmT + 64 * 68;
    LAS float* sbeta = sg + 64;
    LAS float* sgc = sbeta + 64;
    LAS float* seg = sgc + 64;
    LAS float* sek = seg + 64;
    LAS float* qs = sek + 64;
    LAS float* solw = qs;
    static_assert((2 * 64 * 132 + 64 * 68 + 5 * 64 + 64 * 256) * 4 <= 156 * 1024, "gdn_local LDS");
    const bf16* QKV = (const bf16*)(ws + WS_QKV);
    const float* AB = (const float*)(ws + WS_AB);
#ifndef SKIP_S1
    {
        const int c = tid >> 3, grp = tid & 7;
#pragma unroll 1
        for (int part = 0; part < 3; ++part) {
            const int ch0 = part * 512 + h * 128 + grp * 16;
            float y[16];
#pragma unroll
            for (int i = 0; i < 16; ++i) y[i] = 0.f;
#pragma unroll
            for (int j = 0; j < 4; ++j) {
                const int s = n * 64 + c - 3 + j;
                if (s >= 0) {
                    const v4u* src = (const v4u*)(QKV + (size_t)(b * SEQ + s) * 1536 + ch0);
                    const v4u x0 = src[0], x1 = src[1];
                    const f32x4* wp = (const f32x4*)(P.conv_qkv_w + j * 1536 + ch0);
                    const f32x4 w0 = wp[0], w1 = wp[1], w2 = wp[2], w3 = wp[3];
                    y[0] += w0.x * bflo(x0.x); y[1] += w0.y * bfhi(x0.x); y[2] += w0.z * bflo(x0.y); y[3] += w0.w * bfhi(x0.y);
                    y[4] += w1.x * bflo(x0.z); y[5] += w1.y * bfhi(x0.z); y[6] += w1.z * bflo(x0.w); y[7] += w1.w * bfhi(x0.w);
                    y[8] += w2.x * bflo(x1.x); y[9] += w2.y * bfhi(x1.x); y[10] += w2.z * bflo(x1.y); y[11] += w2.w * bfhi(x1.y);
                    y[12] += w3.x * bflo(x1.z); y[13] += w3.y * bfhi(x1.z); y[14] += w3.z * bflo(x1.w); y[15] += w3.w * bfhi(x1.w);
                }
            }
            float ss = 0.f;
#pragma unroll
            for (int i = 0; i < 16; ++i) { y[i] = siluf_(y[i]); ss += y[i] * y[i]; }
            if (part < 2) {
                ss += __shfl_xor(ss, 1); ss += __shfl_xor(ss, 2); ss += __shfl_xor(ss, 4);
                const float sc = rsqrtf(ss + 1e-6f) * (part == 0 ? 0.08838834764831845f : 1.0f);
#pragma unroll
                for (int i = 0; i < 16; ++i) y[i] *= sc;
            }
            LAS float* dst = (part == 0 ? qs : (part == 1 ? ks : vs)) + c * 132 + grp * 16;
#pragma unroll
            for (int i = 0; i < 4; ++i) *(LAS f32x4*)(dst + 4 * i) = (f32x4){y[4 * i], y[4 * i + 1], y[4 * i + 2], y[4 * i + 3]};
        }
        if (tid < 64) {
            const int t = t0 + tid;
            const float a_in = AB[(size_t)t * 8 + h], b_in = AB[(size_t)t * 8 + 4 + h];
            sg[tid] = -__expf(P.gdn_a_log[h]) * softplusf_(a_in + P.gdn_dt_bias[h]);
            sbeta[tid] = sigmoidf_(b_in);
        }
    }
#endif
    __syncthreads();
    if (tid < 64) {
        float v = sg[tid];
#pragma unroll
        for (int off = 1; off < 64; off <<= 1) { const float t = __shfl_up(v, off); if (tid >= off) v += t; }
        sgc[tid] = v; seg[tid] = __expf(v);
        const float gl = __shfl(v, 63);
        sek[tid] = __expf(gl - v);
        if (tid == 63) ((float*)(ws + WS_DEC))[item] = __expf(v);
    }
    __syncthreads();
#ifndef SKIP_S3
    {
        const int c = tid >> 3, sgp = tid & 7;
        float akk[8], aqk[8];
#pragma unroll
        for (int i = 0; i < 8; ++i) { akk[i] = 0.f; aqk[i] = 0.f; }
#pragma unroll 2
        for (int d4 = 0; d4 < 32; ++d4) {
            const f32x4 kc = *(const LAS f32x4*)(ks + c * 132 + 4 * d4), qc = *(const LAS f32x4*)(qs + c * 132 + 4 * d4);
#pragma unroll
            for (int i = 0; i < 8; ++i) { const f32x4 kv = *(const LAS f32x4*)(ks + (sgp + 8 * i) * 132 + 4 * d4);
                akk[i] += (kc.x * kv.x + kc.y * kv.y) + (kc.z * kv.z + kc.w * kv.w);
                aqk[i] += (qc.x * kv.x + qc.y * kv.y) + (qc.z * kv.z + qc.w * kv.w); }
        }
        const float gc = sgc[c], bc = sbeta[c];
        bf16* ATT = (bf16*)(ws + WS_ATT) + (size_t)item * 4096;
#pragma unroll
        for (int i = 0; i < 8; ++i) { const int s = sgp + 8 * i;
            const float dec = (c >= s) ? __expf(gc - sgc[s]) : 0.f;
            AmT[s * 68 + c] = (c > s) ? bc * akk[i] * dec : 0.f;
            ATT[c * 64 + ((s & ~31) | permk(s & 31))] = (bf16)f2bf(aqk[i] * dec); }
    }
#endif
#ifndef SKIP_S4
    {
        bf16* QD = (bf16*)(ws + WS_QD) + (size_t)item * 8192;
        bf16* KD = (bf16*)(ws + WS_KD) + (size_t)item * 8192;
#pragma unroll
        for (int r = 0; r < 2; ++r) {
            const int id = tid + 512 * r;
            { const int c = id >> 4, gam = id & 15, s32 = gam >> 2, g = gam & 3;
              const f32x4 lo = *(const LAS f32x4*)(qs + c * 132 + 32 * s32 + 4 * g), hi = *(const LAS f32x4*)(qs + c * 132 + 32 * s32 + 16 + 4 * g);
              const float e = seg[c];
              v4u o; o.x = pk2(lo.x * e, lo.y * e); o.y = pk2(lo.z * e, lo.w * e); o.z = pk2(hi.x * e, hi.y * e); o.w = pk2(hi.z * e, hi.w * e);
              *(v4u*)(QD + c * 128 + 8 * gam) = o; }
            { const int dk = id >> 3, gam = id & 7, s32 = gam >> 2, g = gam & 3, c0 = 32 * s32 + 4 * g;
              float v[8];
#pragma unroll
              for (int j = 0; j < 4; ++j) { v[j] = ks[(c0 + j) * 132 + dk] * sek[c0 + j]; v[4 + j] = ks[(c0 + 16 + j) * 132 + dk] * sek[c0 + 16 + j]; }
              v4u o; o.x = pk2(v[0], v[1]); o.y = pk2(v[2], v[3]); o.z = pk2(v[4], v[5]); o.w = pk2(v[6], v[7]);
              *(v4u*)(KD + dk * 64 + 8 * gam) = o; }
        }
    }
#endif
    __syncthreads();
#ifndef SKIP_S5
    if (tid < 256) {
        const int j = tid;
        const LAS float* src = (j < 128) ? (vs + j) : (ks + (j - 128));
#pragma unroll 1
        for (int rb = 0; rb < 4; ++rb) {
            float acc[16];
#pragma unroll
            for (int i = 0; i < 16; ++i) { const int c = 16 * rb + i; float a = src[c * 132] * sbeta[c]; if (j >= 128) a *= seg[c]; acc[i] = a; }
#pragma unroll 2
            for (int s = 0; s < 16 * rb; ++s) {
                const float sv = solw[s * 256 + j];
                const LAS float* ar = AmT + s * 68 + 16 * rb;
#pragma unroll
                for (int q = 0; q < 4; ++q) { const f32x4 A4 = *(const LAS f32x4*)(ar + 4 * q);
                    acc[4 * q] -= A4.x * sv; acc[4 * q + 1] -= A4.y * sv; acc[4 * q + 2] -= A4.z * sv; acc[4 * q + 3] -= A4.w * sv; }
            }
#pragma unroll
            for (int i = 0; i < 16; ++i) {
                const int s = 16 * rb + i; const float sv = acc[i];
                solw[s * 256 + j] = sv;
                const LAS float* ar = AmT + s * 68 + 16 * rb;
#pragma unroll
                for (int q = (i + 1) / 4; q < 4; ++q) { const f32x4 A4 = *(const LAS f32x4*)(ar + 4 * q);
                    if (4 * q > i) acc[4 * q] -= A4.x * sv; if (4 * q + 1 > i) acc[4 * q + 1] -= A4.y * sv; if (4 * q + 2 > i) acc[4 * q + 2] -= A4.z * sv; if (4 * q + 3 > i) acc[4 * q + 3] -= A4.w * sv; }
            }
        }
        LDS_WAIT(); asm volatile("" ::: "memory");
        if (j < 128) {
            bf16* UF = (bf16*)(ws + WS_UF) + (size_t)item * 8192 + (size_t)(j >> 4) * 1024;
#pragma unroll
            for (int g = 0; g < 4; ++g) {
                float v[16];
#pragma unroll
                for (int rho = 0; rho < 4; ++rho)
#pragma unroll
                    for (int i = 0; i < 4; ++i) v[rho * 4 + i] = solw[(16 * rho + 4 * g + i) * 256 + j];
                v4u o0, o1;
                o0.x = pk2(v[0], v[1]); o0.y = pk2(v[2], v[3]); o0.z = pk2(v[4], v[5]); o0.w = pk2(v[6], v[7]);
                o1.x = pk2(v[8], v[9]); o1.y = pk2(v[10], v[11]); o1.z = pk2(v[12], v[13]); o1.w = pk2(v[14], v[15]);
                v4u* d = (v4u*)(UF + (g * 16 + (j & 15)) * 16);
                d[0] = o0; d[1] = o1;
            }
        } else {
            const int dk = j - 128, pos = (dk & ~31) | permk(dk & 31);
            bf16* WN = (bf16*)(ws + WS_WN) + (size_t)item * 8192 + pos;
#pragma unroll 8
            for (int c = 0; c < 64; ++c) WN[c * 128] = (bf16)f2bf(-solw[c * 256 + j]);
        }
    }
#endif
    __syncthreads();
}

__device__ __forceinline__ void lru_local_item(const Params& P, LAS unsigned char* lds, int lt, int tid, int lane, int wave) {
    unsigned char* ws = P.ws;
    const int b = lt >> 7, n = lt & 127, t0 = b * SEQ + n * 64;
    LAS float* xc = (LAS float*)lds;
    const bf16* XR = (const bf16*)(ws + WS_XR);
    {
        const int ch = tid;
        const float w0 = P.lru_conv_w[ch], w1 = P.lru_conv_w[512 + ch], w2 = P.lru_conv_w[1024 + ch], w3 = P.lru_conv_w[1536 + ch], cb = P.lru_conv_b[ch];
        float x0 = 0.f, x1 = 0.f, x2 = 0.f;
        if (n > 0) { x0 = bf1(XR[(size_t)(t0 - 3) * 512 + ch]); x1 = bf1(XR[(size_t)(t0 - 2) * 512 + ch]); x2 = bf1(XR[(size_t)(t0 - 1) * 512 + ch]); }
#pragma unroll 8
        for (int c = 0; c < 64; ++c) { const float x3 = bf1(XR[(size_t)(t0 + c) * 512 + ch]);
            xc[c * 516 + ch] = (w0 * x0 + w1 * x1) + (w2 * x2 + w3 * x3) + cb; x0 = x1; x1 = x2; x2 = x3; }
    }
    __syncthreads();
    {
        const int g = wave, ch = g * 64 + lane;
        float wa[64], wx[64];
        const float* wap = P.lru_wa + (size_t)g * 4096 + lane; const float* wxp = P.lru_wx + (size_t)g * 4096 + lane;
        asm volatile("" : "+v"(wap), "+v"(wxp));
#pragma unroll
        for (int i = 0; i < 64; ++i) { wa[i] = wap[i * 64]; wx[i] = wxp[i * 64]; }
        const float ba = P.lru_ba[ch], bx = P.lru_bx[ch], sp = softplusf_(-P.lru_lambda[ch]);
        bf16* HLOC = (bf16*)(ws + WS_HLOC); bf16* PCUM = (bf16*)(ws + WS_PCUM);
        float hst = 0.f, pc = 1.f;
#pragma unroll 1
        for (int c = 0; c < 64; ++c) {
            float ra = ba, ri = bx;
            const LAS float* xrow = xc + c * 516 + g * 64;
#pragma unroll
            for (int i4 = 0; i4 < 16; ++i4) { const f32x4 x4 = *(const LAS f32x4*)(xrow + 4 * i4);
                ra += x4.x * wa[4 * i4]; ra += x4.y * wa[4 * i4 + 1]; ra += x4.z * wa[4 * i4 + 2]; ra += x4.w * wa[4 * i4 + 3];
                ri += x4.x * wx[4 * i4]; ri += x4.y * wx[4 * i4 + 1]; ri += x4.z * wx[4 * i4 + 2]; ri += x4.w * wx[4 * i4 + 3];
                if ((i4 & 3) == 3) asm volatile("" ::: "memory"); }
            const float r = sigmoidf_(ra), ig = sigmoidf_(ri);
            const float log_a = -8.0f * r * sp;
            const float a = __expf(log_a);
            const float xo = xrow[lane];
            const float bt = sqrtf(fmaxf(-expm1f(2.0f * log_a), 0.f)) * (ig * xo);
            hst = a * hst + bt; pc *= a;
            HLOC[(size_t)(t0 + c) * 512 + ch] = (bf16)f2bf(hst); PCUM[(size_t)(t0 + c) * 512 + ch] = (bf16)f2bf(pc);
        }
        ((float*)(ws + WS_HEND))[(size_t)lt * 512 + ch] = hst; ((float*)(ws + WS_PEND))[(size_t)lt * 512 + ch] = pc;
    }
    __syncthreads();
}

constexpr int SC_WN = 0, SC_QD = 64 * 272, SC_KD = 2 * 64 * 272, SC_ATT = 2 * 64 * 272 + 128 * 144, SC_BUF = 2 * 64 * 272 + 128 * 144 + 64 * 144;
constexpr int SC_SSQ = 2 * SC_BUF;
__device__ __forceinline__ int sc_lds_off(int id) {
    if (id < 1024) return SC_WN + (id >> 4) * 272 + (id & 15) * 16;
    if (id < 2048) { const int q = id - 1024; return SC_QD + (q >> 4) * 272 + (q & 15) * 16; }
    if (id < 3072) { const int q = id - 2048; return SC_KD + (q >> 3) * 144 + (q & 7) * 16; }
    const int q = id - 3072; return SC_ATT + (q >> 3) * 144 + (q & 7) * 16;
}
__device__ __forceinline__ const v4u* sc_src(const unsigned char* ws, int item, int id) {
    if (id < 1024) return (const v4u*)(ws + WS_WN + (size_t)item * 16384) + id;
    if (id < 2048) return (const v4u*)(ws + WS_QD + (size_t)item * 16384) + (id - 1024);
    if (id < 3072) return (const v4u*)(ws + WS_KD + (size_t)item * 16384) + (id - 2048);
    return (const v4u*)(ws + WS_ATT + (size_t)item * 8192) + (id - 3072);
}
__device__ __forceinline__ bf16x8 pack_b(const f32x4 a, const f32x4 b) {
    v4u r; r.x = pk2(a.x, a.y); r.y = pk2(a.z, a.w); r.z = pk2(b.x, b.y); r.w = pk2(b.z, b.w);
    return __builtin_bit_cast(bf16x8, r);
}
#define SC_BAR() do { asm volatile("s_waitcnt lgkmcnt(0)" ::: "memory"); __builtin_amdgcn_s_barrier(); asm volatile("" ::: "memory"); } while (0)
#define SC_GLD(dst, ptr) asm volatile("global_load_dwordx4 %0, %1, off" : "=v"(dst) : "v"(ptr) : "memory")
#define PIN8(a) asm volatile("" : "+v"(a[0]), "+v"(a[1]), "+v"(a[2]), "+v"(a[3]), "+v"(a[4]), "+v"(a[5]), "+v"(a[6]), "+v"(a[7]))
#define PIN16(a) asm volatile("" : "+v"(a[0]), "+v"(a[1]), "+v"(a[2]), "+v"(a[3]), "+v"(a[4]), "+v"(a[5]), "+v"(a[6]), "+v"(a[7]), "+v"(a[8]), "+v"(a[9]), "+v"(a[10]), "+v"(a[11]), "+v"(a[12]), "+v"(a[13]), "+v"(a[14]), "+v"(a[15]))
constexpr int SCAN_NWC = 2, SCAN_PARTS = 4, SCAN_WGS = 8 * SCAN_PARTS;
constexpr int SC_UFS = 2 * SC_BUF;
constexpr int SC_DECS = SC_UFS + 2 * SCAN_NWC * 2048;
constexpr int SC_OT = SC_DECS + 512;
constexpr int SC_END = SC_OT + 2 * 64 * 36 * 4;
static_assert(SC_END <= MISC_OFF, "scan LDS");
#ifndef SCAN_REPS
#define SCAN_REPS 1
#endif
#ifndef SCAN_EXP
#define SCAN_EXP 0
#endif
__device__ __forceinline__ int sc3_lds_off(int id) {
    if (id < 3584) return sc_lds_off(id);
    return SC_UFS + (id - 3584) * 16;
}
__device__ __forceinline__ const v4u* sc3_src(const unsigned char* ws, int item, int id, int part) {
    if (id < 3584) return sc_src(ws, item, id);
    return (const v4u*)(ws + WS_UF + (size_t)item * 16384 + (size_t)(part * SCAN_NWC) * 2048) + (id - 3584);
}
__device__ __forceinline__ void gdn_scan(const Params& P, LAS unsigned char* lds, int sb, int tid, int lane, int wave) {
    const unsigned char* ws = P.ws;
    constexpr int NCH = 128 * SCAN_REPS, NPC = 15;
    const int bh = sb & 7, part = sb >> 3;
    const int b = bh >> 2, h = bh & 3, col = lane & 15, g = lane >> 4;
    const int item0 = bh * 128;
    const float* DEC = (const float*)(ws + WS_DEC);
    if (wave >= 4) {
        constexpr int NP = 15, DEP = 3;
        const int lt = tid - 256;
        const unsigned voff = (unsigned)lt * 16u;
        const int lA = (lt >> 4) * 272 + (lt & 15) * 16, lB = (lt >> 3) * 144 + (lt & 7) * 16, lU = SC_UFS + lt * 16;
        v4u rs[DEP][NP];
#define SC_ISSUE(set, itm) do { const unsigned char* gq_ = ws + (size_t)(itm) * 16384; const unsigned char* ga_ = ws + WS_ATT + (size_t)(itm) * 8192; \
            asm volatile("s_nop 4\n\tglobal_load_dwordx4 %0, %8, %9\n\tglobal_load_dwordx4 %1, %8, %10\n\tglobal_load_dwordx4 %2, %8, %11\n\tglobal_load_dwordx4 %3, %8, %12\n\t" \
                         "global_load_dwordx4 %4, %8, %13\n\tglobal_load_dwordx4 %5, %8, %14\n\tglobal_load_dwordx4 %6, %8, %15\n\tglobal_load_dwordx4 %7, %8, %16" \
                : "=&v"(rs[set][0]), "=&v"(rs[set][1]), "=&v"(rs[set][2]), "=&v"(rs[set][3]), "=&v"(rs[set][4]), "=&v"(rs[set][5]), "=&v"(rs[set][6]), "=&v"(rs[set][7]) \
                : "v"(voff), "s"(gq_ + WS_WN), "s"(gq_ + WS_WN + 4096), "s"(gq_ + WS_WN + 8192), "s"(gq_ + WS_WN + 12288), \
                  "s"(gq_ + WS_QD), "s"(gq_ + WS_QD + 4096), "s"(gq_ + WS_QD + 8192), "s"(gq_ + WS_QD + 12288) : "memory"); \
            asm volatile("s_nop 4\n\tglobal_load_dwordx4 %0, %7, %8\n\tglobal_load_dwordx4 %1, %7, %9\n\tglobal_load_dwordx4 %2, %7, %10\n\tglobal_load_dwordx4 %3, %7, %11\n\t" \
                         "global_load_dwordx4 %4, %7, %12\n\tglobal_load_dwordx4 %5, %7, %13\n\tglobal_load_dwordx4 %6, %7, %14" \
                : "=&v"(rs[set][8]), "=&v"(rs[set][9]), "=&v"(rs[set][10]), "=&v"(rs[set][11]), "=&v"(rs[set][12]), "=&v"(rs[set][13]), "=&v"(rs[set][14]) \
                : "v"(voff), "s"(gq_ + WS_KD), "s"(gq_ + WS_KD + 4096), "s"(gq_ + WS_KD + 8192), "s"(gq_ + WS_KD + 12288), \
                  "s"(ga_), "s"(ga_ + 4096), "s"(gq_ + WS_UF + (size_t)(part * SCAN_NWC) * 2048) : "memory"); } while (0)
#define SC_WAITSET(set, cnt) asm volatile("s_waitcnt " cnt : "+v"(rs[set][0]), "+v"(rs[set][1]), "+v"(rs[set][2]), "+v"(rs[set][3]), "+v"(rs[set][4]), "+v"(rs[set][5]), "+v"(rs[set][6]), "+v"(rs[set][7]), \
            "+v"(rs[set][8]), "+v"(rs[set][9]), "+v"(rs[set][10]), "+v"(rs[set][11]), "+v"(rs[set][12]), "+v"(rs[set][13]), "+v"(rs[set][14]) :: "memory")
#define SC_WRITE(set, par) do { LAS unsigned char* wb_ = lds + (par) * SC_BUF; \
            _Pragma("unroll") for (int r = 0; r < 4; ++r) { *(LAS v4u*)(wb_ + SC_WN + lA + r * (16 * 272)) = rs[set][r]; *(LAS v4u*)(wb_ + SC_QD + lA + r * (16 * 272)) = rs[set][4 + r]; \
                                                          *(LAS v4u*)(wb_ + SC_KD + lB + r * (32 * 144)) = rs[set][8 + r]; } \
            *(LAS v4u*)(wb_ + SC_ATT + lB) = rs[set][12]; *(LAS v4u*)(wb_ + SC_ATT + lB + 32 * 144) = rs[set][13]; \
            *(LAS v4u*)(lds + lU + (par) * (SCAN_NWC * 2048)) = rs[set][14]; } while (0)
        {
#pragma unroll
            for (int r = 0; r < NP; ++r) { const int id = lt + 256 * r; *(LAS v4u*)(lds + sc3_lds_off(id)) = *sc3_src(ws, item0, id, part); }
            if (lt < 128) ((LAS float*)(lds + SC_DECS))[lt] = DEC[item0 + lt];
            asm volatile("s_waitcnt vmcnt(0)" ::: "memory");
        }
        SC_ISSUE(1, item0 + 1); SC_ISSUE(2, item0 + 2); SC_ISSUE(0, item0 + 3);
        SC_BAR();
        int n2 = 0;
#define SC_INTERVAL(set) do { SC_WAITSET(set, "vmcnt(30)"); SC_WRITE(set, (n2 + 1) & 1); SC_WAITSET(set, "lgkmcnt(0)"); SC_ISSUE(set, item0 + ((n2 + 1 + DEP) & 127)); SC_BAR(); ++n2; } while (0)
#pragma unroll 1
        for (int it = 0; it < NCH / 3; ++it) { SC_INTERVAL(1); SC_INTERVAL(2); SC_INTERVAL(0); }
        if (NCH % 3 >= 1) SC_INTERVAL(1);
        if (NCH % 3 >= 2) SC_INTERVAL(2);
        SC_WAITSET(0, "vmcnt(0)"); SC_WAITSET(1, "vmcnt(0)"); SC_WAITSET(2, "vmcnt(0)");
#undef SC_INTERVAL
#undef SC_WRITE
#undef SC_WAITSET
#undef SC_ISSUE
        return;
    }
    if (wave == 3) {
        SC_BAR();
#pragma unroll 1
        for (int n2 = 0; n2 < NCH; ++n2) SC_BAR();
        return;
    }
    if (wave == 2) {
        const int row = lane;
        bf16* Y = (bf16*)(P.ws + WS_Y);
        float* SSQG = P.out;
        SC_BAR();
#pragma unroll 1
        for (int n2 = 0; n2 <= NCH; ++n2) {
            if (n2 > 0) {
                const int n = (n2 - 1) & 127, t = b * SEQ + n * 64 + row;
                const LAS float* src = (const LAS float*)(lds + SC_OT + ((n2 - 1) & 1) * (64 * 36 * 4)) + row * 36;
                f32x4 a[8]; float s2 = 0.f;
#pragma unroll
                for (int q = 0; q < 8; ++q) { a[q] = *(const LAS f32x4*)(src + 4 * q); s2 += (a[q].x * a[q].x + a[q].y * a[q].y) + (a[q].z * a[q].z + a[q].w * a[q].w); }
                SSQG[(size_t)t * 32 + h * 8 + part] = s2;
                v4u* d = (v4u*)(Y + (size_t)t * 1024 + h * 128 + 32 * part);
#pragma unroll
                for (int q = 0; q < 4; ++q) { v4u o; o.x = pk2(a[2 * q].x, a[2 * q].y); o.y = pk2(a[2 * q].z, a[2 * q].w); o.z = pk2(a[2 * q + 1].x, a[2 * q + 1].y); o.w = pk2(a[2 * q + 1].z, a[2 * q + 1].w); d[q] = o; }
            }
            if (n2 < NCH) SC_BAR();
        }
        return;
    }
    f32x4 S[8];
#pragma unroll
    for (int i = 0; i < 8; ++i) S[i] = (f32x4){0.f, 0.f, 0.f, 0.f};
    SC_BAR();
#pragma unroll 1
    for (int n2 = 0; n2 < NCH; ++n2) {
        if (SCAN_REPS > 1 && (n2 & 127) == 0) {
#pragma unroll
            for (int i = 0; i < 8; ++i) S[i] = (f32x4){0.f, 0.f, 0.f, 0.f};
        }
        if (SCAN_EXP == 2 && n2 < 128) { SC_BAR(); continue; }
        const int par = n2 & 1;
        LAS unsigned char* buf = lds + par * SC_BUF;
        bf16x8 fA[16], fB[16], fC[16], fD[8];
#pragma unroll
        for (int rho = 0; rho < 4; ++rho)
#pragma unroll
            for (int s = 0; s < 4; ++s) fA[rho * 4 + s] = *(const LAS bf16x8*)(buf + SC_WN + (16 * rho + col) * 272 + (32 * s + 8 * g) * 2);
#pragma unroll
        for (int rho = 0; rho < 4; ++rho)
#pragma unroll
            for (int s = 0; s < 4; ++s) fB[rho * 4 + s] = *(const LAS bf16x8*)(buf + SC_QD + (16 * rho + col) * 272 + (32 * s + 8 * g) * 2);
        const LAS v4u* ufp = (const LAS v4u*)(lds + SC_UFS + par * (SCAN_NWC * 2048) + wave * 2048 + lane * 32);
        const v4u uf0 = ufp[0], uf1 = ufp[1];
        const float dec = ((const LAS float*)(lds + SC_DECS))[n2 & 127];
        bf16x8 Bs[4];
#pragma unroll
        for (int s = 0; s < 4; ++s) Bs[s] = pack_b(S[2 * s], S[2 * s + 1]);
        f32x4 Vn[4], Oc[4];
        Vn[0] = (f32x4){bflo(uf0.x), bfhi(uf0.x), bflo(uf0.y), bfhi(uf0.y)}; Vn[1] = (f32x4){bflo(uf0.z), bfhi(uf0.z), bflo(uf0.w), bfhi(uf0.w)};
        Vn[2] = (f32x4){bflo(uf1.x), bfhi(uf1.x), bflo(uf1.y), bfhi(uf1.y)}; Vn[3] = (f32x4){bflo(uf1.z), bfhi(uf1.z), bflo(uf1.w), bfhi(uf1.w)};
        __builtin_amdgcn_sched_barrier(0);
        PIN16(fA);
#pragma unroll
        for (int s = 0; s < 4; ++s)
#pragma unroll
            for (int rho = 0; rho < 4; ++rho) Vn[rho] = __builtin_amdgcn_mfma_f32_16x16x32_bf16(fA[rho * 4 + s], Bs[s], Vn[rho], 0, 0, 0);
        __builtin_amdgcn_sched_barrier(0);
#pragma unroll
        for (int tau = 0; tau < 8; ++tau)
#pragma unroll
            for (int s = 0; s < 2; ++s) fC[tau * 2 + s] = *(const LAS bf16x8*)(buf + SC_KD + (16 * tau + col) * 144 + (32 * s + 8 * g) * 2);
        __builtin_amdgcn_sched_barrier(0);
        PIN16(fB);
#pragma unroll
        for (int rho = 0; rho < 4; ++rho) Oc[rho] = (f32x4){0.f, 0.f, 0.f, 0.f};
#pragma unroll
        for (int s = 0; s < 4; ++s)
#pragma unroll
            for (int rho = 0; rho < 4; ++rho) Oc[rho] = __builtin_amdgcn_mfma_f32_16x16x32_bf16(fB[rho * 4 + s], Bs[s], Oc[rho], 0, 0, 0);
        __builtin_amdgcn_sched_barrier(0);
#pragma unroll
        for (int rho = 0; rho < 4; ++rho)
#pragma unroll
            for (int s = 0; s < 2; ++s) fD[rho * 2 + s] = *(const LAS bf16x8*)(buf + SC_ATT + (16 * rho + col) * 144 + (32 * s + 8 * g) * 2);
        bf16x8 Bv[2];
        Bv[0] = pack_b(Vn[0], Vn[1]); Bv[1] = pack_b(Vn[2], Vn[3]);
#pragma unroll
        for (int tau = 0; tau < 8; ++tau) S[tau] = S[tau] * dec;
        __builtin_amdgcn_sched_barrier(0);
        PIN16(fC);
#pragma unroll
        for (int s = 0; s < 2; ++s)
#pragma unroll
            for (int tau = 0; tau < 8; ++tau) S[tau] = __builtin_amdgcn_mfma_f32_16x16x32_bf16(fC[tau * 2 + s], Bv[s], S[tau], 0, 0, 0);
        __builtin_amdgcn_sched_barrier(0);
        PIN8(fD);
#pragma unroll
        for (int s = 0; s < 2; ++s)
#pragma unroll
            for (int rho = 0; rho < 4; ++rho) Oc[rho] = __builtin_amdgcn_mfma_f32_16x16x32_bf16(fD[rho * 2 + s], Bv[s], Oc[rho], 0, 0, 0);
        LAS float* ot = (LAS float*)(lds + SC_OT + par * (64 * 36 * 4)) + 16 * wave + col;
#pragma unroll
        for (int rho = 0; rho < 4; ++rho)
#pragma unroll
            for (int i = 0; i < 4; ++i) ot[(16 * rho + 4 * g + i) * 36] = Oc[rho][i];
        SC_BAR();
    }
}

__device__ __forceinline__ void lru_carry(const Params& P, int gwv, int lane) {
    unsigned char* ws = P.ws;
    const int b = gwv >> 3, g = gwv & 7, ch = g * 64 + lane;
    const float* HEND = (const float*)(ws + WS_HEND); const float* PEND = (const float*)(ws + WS_PEND); float* HIN = (float*)(ws + WS_HIN);
    float hin = 0.f;
#pragma unroll 1
    for (int n0 = 0; n0 < 128; n0 += 16) {
        float he[16], pe[16];
#pragma unroll
        for (int i = 0; i < 16; ++i) { const size_t o = (size_t)(b * 128 + n0 + i) * 512 + ch; he[i] = HEND[o]; pe[i] = PEND[o]; }
#pragma unroll
        for (int i = 0; i < 16; ++i) { HIN[(size_t)(b * 128 + n0 + i) * 512 + ch] = hin; hin = he[i] + pe[i] * hin; }
    }
}

__device__ __forceinline__ void cvt_table(const float* src, bf16* dst, size_t n8, size_t wi, size_t nw) {
    for (size_t i = wi; i < n8; i += nw) {
        const f32x4 a = ((const f32x4*)src)[2 * i], c = ((const f32x4*)src)[2 * i + 1];
        v4u o; o.x = pk2(a.x, a.y); o.y = pk2(a.z, a.w); o.z = pk2(c.x, c.y); o.w = pk2(c.z, c.w);
        ((v4u*)dst)[i] = o;
    }
}

__device__ __forceinline__ void lru_combine(const Params& P, size_t wi, size_t nw) {
    unsigned char* ws = P.ws;
    const v4u* HLOC = (const v4u*)(ws + WS_HLOC); const v4u* PCUM = (const v4u*)(ws + WS_PCUM); const v4u* GATE = (const v4u*)(ws + WS_GATE);
    const float* HIN = (const float*)(ws + WS_HIN); bf16* Y = (bf16*)(ws + WS_Y);
    for (size_t i = wi; i < (size_t)T * 64; i += nw) {
        const size_t t = i >> 6; const int ch0 = (int)(i & 63) * 8;
        const v4u hl = HLOC[i], pc = PCUM[i], gt = GATE[i];
        const f32x4 h0 = *(const f32x4*)(HIN + (t >> 6) * 512 + ch0), h1 = *(const f32x4*)(HIN + (t >> 6) * 512 + ch0 + 4);
        float y[8];
        y[0] = (bflo(hl.x) + bflo(pc.x) * h0.x) * gelu_tanh(bflo(gt.x)); y[1] = (bfhi(hl.x) + bfhi(pc.x) * h0.y) * gelu_tanh(bfhi(gt.x));
        y[2] = (bflo(hl.y) + bflo(pc.y) * h0.z) * gelu_tanh(bflo(gt.y)); y[3] = (bfhi(hl.y) + bfhi(pc.y) * h0.w) * gelu_tanh(bfhi(gt.y));
        y[4] = (bflo(hl.z) + bflo(pc.z) * h1.x) * gelu_tanh(bflo(gt.z)); y[5] = (bfhi(hl.z) + bfhi(pc.z) * h1.y) * gelu_tanh(bfhi(gt.z));
        y[6] = (bflo(hl.w) + bflo(pc.w) * h1.z) * gelu_tanh(bflo(gt.w)); y[7] = (bfhi(hl.w) + bfhi(pc.w) * h1.w) * gelu_tanh(bfhi(gt.w));
        v4u o; o.x = pk2(y[0], y[1]); o.y = pk2(y[2], y[3]); o.z = pk2(y[4], y[5]); o.w = pk2(y[6], y[7]);
        *(v4u*)(Y + t * 1024 + 512 + ch0) = o;
    }
}

__device__ __forceinline__ void gdn_gate_norm(const Params& P, size_t wi, size_t nw) {
    unsigned char* ws = P.ws;
    bf16* Y = (bf16*)(ws + WS_Y); const v4u* Z = (const v4u*)(ws + WS_Z); const float* SSQG = P.out;
    for (size_t i = wi; i < (size_t)T * 64; i += nw) {
        const size_t t = i >> 6; const int c0 = (int)(i & 63) * 8, h = c0 >> 7;
        const f32x4 q0 = *(const f32x4*)(SSQG + t * 32 + h * 8);
        const float rstd = rsqrtf(((q0.x + q0.y) + (q0.z + q0.w)) * (1.0f / 128.0f) + 1e-6f);
        const v4u o = *(const v4u*)(Y + t * 1024 + c0), z = Z[i];
        const f32x4 w0 = *(const f32x4*)(P.gdn_norm_w + (c0 & 127)), w1 = *(const f32x4*)(P.gdn_norm_w + (c0 & 127) + 4);
        float y[8];
        y[0] = bflo(o.x) * rstd * w0.x * siluf_(bflo(z.x)); y[1] = bfhi(o.x) * rstd * w0.y * siluf_(bfhi(z.x));
        y[2] = bflo(o.y) * rstd * w0.z * siluf_(bflo(z.y)); y[3] = bfhi(o.y) * rstd * w0.w * siluf_(bfhi(z.y));
        y[4] = bflo(o.z) * rstd * w1.x * siluf_(bflo(z.z)); y[5] = bfhi(o.z) * rstd * w1.y * siluf_(bfhi(z.z));
        y[6] = bflo(o.w) * rstd * w1.z * siluf_(bflo(z.w)); y[7] = bfhi(o.w) * rstd * w1.w * siluf_(bfhi(z.w));
        v4u r; r.x = pk2(y[0], y[1]); r.y = pk2(y[2], y[3]); r.z = pk2(y[4], y[5]); r.w = pk2(y[6], y[7]);
        *(v4u*)(Y + t * 1024 + c0) = r;
    }
}

__device__ __forceinline__ void xattn_unit(const Params& P, int wu, int lane) {
    const unsigned char* ws = P.ws;
    const int h = wu & 3, t0 = (wu >> 2) * 16, b = t0 >> 13, col = lane & 15, g = lane >> 4;
    const bf16* Q = (const bf16*)(ws + WS_Q) + (size_t)(t0 + col) * 1024 + h * 256 + 8 * g;
    const bf16* Kb = (const bf16*)(ws + WS_KB) + (size_t)((b * 4 + h) * 256 + col) * 256 + 8 * g;
    const bf16* Vt = (const bf16*)(ws + WS_VTP) + (size_t)((b * 4 + h) * 256 + col) * 256 + 8 * g;
    bf16x8 Bq[8];
#pragma unroll
    for (int s = 0; s < 8; ++s) Bq[s] = *(const bf16x8*)(Q + 32 * s);
    f32x4 St[16];
#pragma unroll
    for (int kap = 0; kap < 16; ++kap) {
        f32x4 acc = (f32x4){0.f, 0.f, 0.f, 0.f};
#pragma unroll
        for (int s = 0; s < 8; ++s) { const bf16x8 a = *(const bf16x8*)(Kb + (size_t)(16 * kap) * 256 + 32 * s); acc = __builtin_amdgcn_mfma_f32_16x16x32_bf16(a, Bq[s], acc, 0, 0, 0); }
        St[kap] = acc;
    }
    float mx = -3.0e38f;
#pragma unroll
    for (int kap = 0; kap < 16; ++kap) mx = fmaxf(fmaxf(fmaxf(St[kap].x, St[kap].y), fmaxf(St[kap].z, St[kap].w)), mx);
    mx = fmaxf(mx, __shfl_xor(mx, 16)); mx = fmaxf(mx, __shfl_xor(mx, 32));
    float l = 0.f;
#pragma unroll
    for (int kap = 0; kap < 16; ++kap) { St[kap].x = __expf(St[kap].x - mx); St[kap].y = __expf(St[kap].y - mx); St[kap].z = __expf(St[kap].z - mx); St[kap].w = __expf(St[kap].w - mx);
        l += (St[kap].x + St[kap].y) + (St[kap].z + St[kap].w); }
    l += __shfl_xor(l, 16); l += __shfl_xor(l, 32);
    const float inv = 1.0f / l;
    bf16x8 Bp[8];
#pragma unroll
    for (int s = 0; s < 8; ++s) Bp[s] = pack_b(St[2 * s], St[2 * s + 1]);
    bf16* AO = (bf16*)(P.ws + WS_AO) + (size_t)(t0 + col) * 1024 + h * 256 + 4 * g;
#pragma unroll
    for (int del = 0; del < 16; ++del) {
        f32x4 acc = (f32x4){0.f, 0.f, 0.f, 0.f};
#pragma unroll
        for (int s = 0; s < 8; ++s) { const bf16x8 a = *(const bf16x8*)(Vt + (size_t)(16 * del) * 256 + 32 * s); acc = __builtin_amdgcn_mfma_f32_16x16x32_bf16(a, Bp[s], acc, 0, 0, 0); }
        v2u o; o.x = pk2(acc.x * inv, acc.y * inv); o.y = pk2(acc.z * inv, acc.w * inv);
        *(v2u*)(AO + 16 * del) = o;
    }
}

__device__ __forceinline__ unsigned key_enc(float f) { const unsigned u = __builtin_bit_cast(unsigned, f); return (u & 0x80000000u) ? ~u : (u | 0x80000000u); }
__device__ __forceinline__ float key_dec(unsigned k) { const unsigned u = (k & 0x80000000u) ? (k & 0x7fffffffu) : ~k; return __builtin_bit_cast(float, u); }
#define INS16(L, kv) do { unsigned carry_ = (kv); _Pragma("unroll") for (int q_ = 0; q_ < 16; ++q_) { const unsigned hi_ = max(L[q_], carry_); carry_ = min(L[q_], carry_); L[q_] = hi_; } } while (0)
__device__ __forceinline__ void peer_topk_item(const Params& P, LAS unsigned char* lds, int item, int tid, int lane, int wave) {
    const unsigned char* ws = P.ws;
    const int h = item & 7, tile = item >> 3, tt0 = tile * 256;
    LAS float* S = (LAS float*)lds;
    LAS int* tab = (LAS int*)(lds + 140 * 1024);
    if (tid == 0) { int id = 0; for (int a = 0; a < 16; ++a) for (int bq = 0; bq < 16 / (a + 1); ++bq) tab[id++] = a * 16 + bq; }
    const bf16* PQ = (const bf16*)(ws + WS_PQ); const bf16* SUBK = (const bf16*)(ws + WS_SUBK);
    const int col = lane & 15, g = lane >> 4;
    unsigned L1[16], L2[16];
#pragma unroll
    for (int q = 0; q < 16; ++q) { L1[q] = 0u; L2[q] = 0u; }
#pragma unroll
    for (int p = 0; p < 2; ++p) {
        {
            bf16x8 Af[2][4];
#pragma unroll
            for (int rho = 0; rho < 2; ++rho)
#pragma unroll
                for (int s = 0; s < 4; ++s) Af[rho][s] = *(const bf16x8*)(PQ + (size_t)(tt0 + 32 * wave + 16 * rho + col) * 2048 + h * 256 + p * 128 + 32 * s + 8 * g);
#pragma unroll
            for (int kap = 0; kap < 8; ++kap) {
                f32x4 a0 = (f32x4){0.f, 0.f, 0.f, 0.f}, a1 = a0;
#pragma unroll
                for (int s = 0; s < 4; ++s) { const bf16x8 bk = *(const bf16x8*)(SUBK + (size_t)((h * 2 + p) * 128 + 16 * kap + col) * 128 + 32 * s + 8 * g);
                    a0 = __builtin_amdgcn_mfma_f32_16x16x32_bf16(Af[0][s], bk, a0, 0, 0, 0); a1 = __builtin_amdgcn_mfma_f32_16x16x32_bf16(Af[1][s], bk, a1, 0, 0, 0); }
#pragma unroll
                for (int i = 0; i < 4; ++i) { S[(32 * wave + 4 * g + i) * 132 + 16 * kap + col] = a0[i]; S[(32 * wave + 16 + 4 * g + i) * 132 + 16 * kap + col] = a1[i]; }
            }
        }
        __syncthreads();
        if (tid < 256) {
            const LAS float* row = S + tid * 132;
#pragma unroll 2
            for (int k4 = 0; k4 < 32; ++k4) { const f32x4 v = *(const LAS f32x4*)(row + 4 * k4);
#pragma unroll
                for (int e = 0; e < 4; ++e) { const unsigned kv = (key_enc(v[e]) & ~127u) | (unsigned)(127 - (4 * k4 + e));
                    if (p == 0) INS16(L1, kv); else INS16(L2, kv); } }
        }
        __syncthreads();
    }
    if (tid < 256) {
        float v1[16], v2[16];
        LAS int* il = (LAS int*)lds + tid * 33;
#pragma unroll
        for (int q = 0; q < 16; ++q) { v1[q] = key_dec((L1[q] & ~127u) | 64u); v2[q] = key_dec((L2[q] & ~127u) | 64u); il[q] = 127 - (int)(L1[q] & 127u); il[16 + q] = 127 - (int)(L2[q] & 127u); }
        unsigned C[16];
#pragma unroll
        for (int q = 0; q < 16; ++q) C[q] = 0u;
        {
            int id = 0;
#pragma unroll
            for (int a = 0; a < 16; ++a)
#pragma unroll
                for (int bq = 0; bq < 16 / (a + 1); ++bq) { const unsigned kv = (key_enc(v1[a] + v2[bq]) & ~63u) | (unsigned)(63 - id); INS16(C, kv); ++id; }
        }
        LDS_WAIT(); asm volatile("" ::: "memory");
        float best[16], e[16], sum = 0.f; int ex[16];
#pragma unroll
        for (int q = 0; q < 16; ++q) { best[q] = key_dec((C[q] & ~63u) | 32u); const int ab = tab[63 - (int)(C[q] & 63u)]; ex[q] = il[ab >> 4] * 128 + il[16 + (ab & 15)]; }
#pragma unroll
        for (int q = 0; q < 16; ++q) { e[q] = __expf(best[q] - best[0]); sum += e[q]; }
        const float inv = 1.0f / sum;
        int* IDX = (int*)(P.ws + WS_IDX) + ((size_t)(tt0 + tid) * 8 + h) * 16; float* GW = (float*)(P.ws + WS_GW) + ((size_t)(tt0 + tid) * 8 + h) * 16;
#pragma unroll
        for (int q = 0; q < 16; ++q) { IDX[q] = ex[q]; GW[q] = e[q] * inv; }
    }
    __syncthreads();
}

typedef float f32x2 __attribute__((ext_vector_type(2)));
__device__ __forceinline__ void cvt_table_fp8(const float* src, unsigned char* dst, float* scl, int gw, int ngw, int lane) {
    for (int row = gw; row < 16384; row += ngw) {
        const f32x4* sp = (const f32x4*)(src + (size_t)row * 1024 + 16 * lane);
        const f32x4 a0 = sp[0], a1 = sp[1], a2 = sp[2], a3 = sp[3];
        float m = fmaxf(fmaxf(fmaxf(fabsf(a0.x), fabsf(a0.y)), fmaxf(fabsf(a0.z), fabsf(a0.w))), fmaxf(fmaxf(fabsf(a1.x), fabsf(a1.y)), fmaxf(fabsf(a1.z), fabsf(a1.w))));
        m = fmaxf(m, fmaxf(fmaxf(fmaxf(fabsf(a2.x), fabsf(a2.y)), fmaxf(fabsf(a2.z), fabsf(a2.w))), fmaxf(fmaxf(fabsf(a3.x), fabsf(a3.y)), fmaxf(fabsf(a3.z), fabsf(a3.w)))));
#pragma unroll
        for (int o = 1; o < 64; o <<= 1) m = fmaxf(m, __shfl_xor(m, o));
        m = fmaxf(m, 1e-30f);
        const float q = 224.0f / m;
        v4u o;
        int p;
        p = __builtin_amdgcn_cvt_pk_fp8_f32(a0.x * q, a0.y * q, 0, false); p = __builtin_amdgcn_cvt_pk_fp8_f32(a0.z * q, a0.w * q, p, true); o.x = (unsigned)p;
        p = __builtin_amdgcn_cvt_pk_fp8_f32(a1.x * q, a1.y * q, 0, false); p = __builtin_amdgcn_cvt_pk_fp8_f32(a1.z * q, a1.w * q, p, true); o.y = (unsigned)p;
        p = __builtin_amdgcn_cvt_pk_fp8_f32(a2.x * q, a2.y * q, 0, false); p = __builtin_amdgcn_cvt_pk_fp8_f32(a2.z * q, a2.w * q, p, true); o.z = (unsigned)p;
        p = __builtin_amdgcn_cvt_pk_fp8_f32(a3.x * q, a3.y * q, 0, false); p = __builtin_amdgcn_cvt_pk_fp8_f32(a3.z * q, a3.w * q, p, true); o.w = (unsigned)p;
        *(v4u*)(dst + (size_t)row * 1024 + 16 * lane) = o;
        if (lane == 0) scl[row] = m * (1.0f / 224.0f);
    }
}
__device__ __forceinline__ void peer_token(const Params& P, int t, int lane, float* dstbase) {
    const unsigned char* ws = P.ws;
    const float* xrow = P.out + (size_t)t * 1024 + 16 * lane;
    const float rstd2 = rsqrtf(((const float*)(ws + WS_SSQ2))[t] * (1.0f / 1024.0f) + 1e-6f);
    f32x4 x2[4]; f32x2 hn[8], acc[8];
#pragma unroll
    for (int i = 0; i < 4; ++i) { x2[i] = ((const f32x4*)xrow)[i]; const f32x4 w = ((const f32x4*)(P.norm_ffn_w + 16 * lane))[i];
        hn[2 * i] = (f32x2){x2[i].x * rstd2 * w.x, x2[i].y * rstd2 * w.y}; hn[2 * i + 1] = (f32x2){x2[i].z * rstd2 * w.z, x2[i].w * rstd2 * w.w}; }
#pragma unroll
    for (int i = 0; i < 8; ++i) acc[i] = (f32x2){0.f, 0.f};
    const int* IDX = (const int*)(ws + WS_IDX) + (size_t)t * 128; const float* GW = (const float*)(ws + WS_GW) + (size_t)t * 128;
    const unsigned char* UB8 = ws + WS_UB; const unsigned char* VB8 = ws + WS_VB;
    const float* USC = (const float*)(ws + WS_UB + 16 * MiB); const float* VSC = (const float*)(ws + WS_VB + 16 * MiB);
    const int myk = (lane >> 2) & 15;
#pragma unroll 1
    for (int hh = 0; hh < 8; ++hh) {
        const int idv = IDX[hh * 16 + (lane & 15)];
        const float gsc = GW[hh * 16 + (lane & 15)] * VSC[idv], usc = USC[idv];
        v4u uq[16], vq[16];
#pragma unroll
        for (int k = 0; k < 16; ++k) { const int e = __builtin_amdgcn_readlane(idv, k);
            uq[k] = *(const v4u*)(UB8 + (size_t)e * 1024 + 16 * lane); vq[k] = *(const v4u*)(VB8 + (size_t)e * 1024 + 16 * lane); }
        float d[16];
#pragma unroll
        for (int k = 0; k < 16; ++k) {
            f32x2 s = __builtin_amdgcn_cvt_pk_f32_fp8((int)uq[k].x, false) * hn[0];
            s = __builtin_elementwise_fma(__builtin_amdgcn_cvt_pk_f32_fp8((int)uq[k].x, true), hn[1], s);
            s = __builtin_elementwise_fma(__builtin_amdgcn_cvt_pk_f32_fp8((int)uq[k].y, false), hn[2], s);
            s = __builtin_elementwise_fma(__builtin_amdgcn_cvt_pk_f32_fp8((int)uq[k].y, true), hn[3], s);
            s = __builtin_elementwise_fma(__builtin_amdgcn_cvt_pk_f32_fp8((int)uq[k].z, false), hn[4], s);
            s = __builtin_elementwise_fma(__builtin_amdgcn_cvt_pk_f32_fp8((int)uq[k].z, true), hn[5], s);
            s = __builtin_elementwise_fma(__builtin_amdgcn_cvt_pk_f32_fp8((int)uq[k].w, false), hn[6], s);
            s = __builtin_elementwise_fma(__builtin_amdgcn_cvt_pk_f32_fp8((int)uq[k].w, true), hn[7], s);
            d[k] = s.x + s.y;
        }
        float r8[8], r4[4], r2[2], r1;
        { const bool up = (lane & 32) != 0;
#pragma unroll
          for (int i = 0; i < 8; ++i) { const float keep = up ? d[8 + i] : d[i], send = up ? d[i] : d[8 + i]; r8[i] = keep + __shfl_xor(send, 32); } }
        { const bool up = (lane & 16) != 0;
#pragma unroll
          for (int i = 0; i < 4; ++i) { const float keep = up ? r8[4 + i] : r8[i], send = up ? r8[i] : r8[4 + i]; r4[i] = keep + __shfl_xor(send, 16); } }
        { const bool up = (lane & 8) != 0;
#pragma unroll
          for (int i = 0; i < 2; ++i) { const float keep = up ? r4[2 + i] : r4[i], send = up ? r4[i] : r4[2 + i]; r2[i] = keep + __shfl_xor(send, 8); } }
        { const bool up = (lane & 4) != 0; const float keep = up ? r2[1] : r2[0], send = up ? r2[0] : r2[1]; r1 = keep + __shfl_xor(send, 4); }
        r1 += __shfl_xor(r1, 2); r1 += __shfl_xor(r1, 1);
        const float act = gelu_tanh(r1 * __shfl(usc, myk)) * __shfl(gsc, myk);
#pragma unroll
        for (int k = 0; k < 16; ++k) {
            const float a = __builtin_bit_cast(float, __builtin_amdgcn_readlane(__builtin_bit_cast(int, act), 4 * k));
            const f32x2 a2 = (f32x2){a, a};
            acc[0] = __builtin_elementwise_fma(__builtin_amdgcn_cvt_pk_f32_fp8((int)vq[k].x, false), a2, acc[0]);
            acc[1] = __builtin_elementwise_fma(__builtin_amdgcn_cvt_pk_f32_fp8((int)vq[k].x, true), a2, acc[1]);
            acc[2] = __builtin_elementwise_fma(__builtin_amdgcn_cvt_pk_f32_fp8((int)vq[k].y, false), a2, acc[2]);
            acc[3] = __builtin_elementwise_fma(__builtin_amdgcn_cvt_pk_f32_fp8((int)vq[k].y, true), a2, acc[3]);
            acc[4] = __builtin_elementwise_fma(__builtin_amdgcn_cvt_pk_f32_fp8((int)vq[k].z, false), a2, acc[4]);
            acc[5] = __builtin_elementwise_fma(__builtin_amdgcn_cvt_pk_f32_fp8((int)vq[k].z, true), a2, acc[5]);
            acc[6] = __builtin_elementwise_fma(__builtin_amdgcn_cvt_pk_f32_fp8((int)vq[k].w, false), a2, acc[6]);
            acc[7] = __builtin_elementwise_fma(__builtin_amdgcn_cvt_pk_f32_fp8((int)vq[k].w, true), a2, acc[7]);
        }
    }
    float ss = 0.f;
#pragma unroll
    for (int i = 0; i < 4; ++i) { x2[i].x += acc[2 * i].x; x2[i].y += acc[2 * i].y; x2[i].z += acc[2 * i + 1].x; x2[i].w += acc[2 * i + 1].y;
        ss += (x2[i].x * x2[i].x + x2[i].y * x2[i].y) + (x2[i].z * x2[i].z + x2[i].w * x2[i].w); }
    const float rstd3 = rsqrtf(wave_sum(ss) * (1.0f / 1024.0f) + 1e-6f);
    float* orow = dstbase + (size_t)t * 1024 + 16 * lane;
#pragma unroll
    for (int i = 0; i < 4; ++i) { const f32x4 w = ((const f32x4*)(P.norm_final_w + 16 * lane))[i];
        ((f32x4*)orow)[i] = (f32x4){x2[i].x * rstd3 * w.x, x2[i].y * rstd3 * w.y, x2[i].z * rstd3 * w.z, x2[i].w * rstd3 * w.w}; }
}

__global__ void __launch_bounds__(NWAVES * 64, 2) hybrid_fwd(Params P) {
    extern __shared__ __attribute__((aligned(16))) unsigned char lds_raw[];
    LAS unsigned char* lds = (LAS unsigned char*)lds_raw;
    volatile LAS unsigned* MISC = (volatile LAS unsigned*)(lds + MISC_OFF);
    const int tid = threadIdx.x, lane = tid & 63, wave = __builtin_amdgcn_readfirstlane(tid >> 6);
    const int G = gridDim.x, bx = blockIdx.x;
    const int vcu = (G % 8 == 0) ? (bx % 8) * (G / 8) + bx / 8 : bx;
    unsigned char* ws = P.ws;
    for (int u = tid; u < 64; u += NWAVES * 64) MISC[u] = 0u;
    __syncthreads();
    XcdBarrier bar; bar.bar = (unsigned*)(ws + WS_CTL) + CW_BAR; bar.x = 0; bar.st = nullptr;
    if (!MK_PER_PHASE) bar = xcd_barrier_post((unsigned*)(ws + WS_CTL) + CW_BAR, MISC + 8);
    const int lo = P.ph_lo, hi = P.ph_hi;
#ifndef PHASE_MASK
#define PHASE_MASK 0xFFF
#endif
#define IN(k) (((PHASE_MASK >> (k)) & 1) && lo <= (k) && (k) < hi)
#define SEAM(k) do { if (IN(k) && IN((k) + 1)) xcd_barrier(bar); } while (0)
#ifndef REP_MASK
#define REP_MASK 0
#endif
#define REPS(k) for (int rep_ = 0; rep_ < (((REP_MASK >> (k)) & 1) ? 2 : 1); ++rep_, (rep_ < (((REP_MASK >> (k)) & 1) ? 2 : 1) ? xcd_barrier(bar) : (void)0))
    using namespace pg8;
    bf16* XB = (bf16*)(ws + WS_XB);

    if (IN(0)) REPS(0) { p0_prologue(P, lds, tid, lane, wave, vcu, G); }
    SEAM(0);
    if (IN(1)) REPS(1) {
        { Gemm gm{XB, (const bf16_t*)(ws + WS_WIN), T, 3072, 1024}; StaticOrder S; S.init(T, 3072, G, bx);
          EpiBf16Rs E{(bf16_t*)(ws + WS_QKV), 1536, 6, (bf16_t*)(ws + WS_XR), 512, (size_t)T * 512, nullptr, 1.0f};
          gemm_phase<EpiBf16Rs, StaticOrder, PG8_ALIGN, PG8_SP2>(lds, gm, S, E); }
        { Gemm gm{(const bf16_t*)(ws + WS_MEMN), (const bf16_t*)(ws + WS_WKV), 512, 2048, 1024}; StaticOrder S; S.init(512, 2048, G, bx);
          EpiKV E{(bf16_t*)(ws + WS_KB), (bf16_t*)(ws + WS_VTP)};
          gemm_phase<EpiKV, StaticOrder, PG8_ALIGN, PG8_SP2>(lds, gm, S, E); }
    }
    SEAM(1);
    if (IN(2)) REPS(2) {
#ifndef NO_GDNL
        for (int it = bx; it < 1024; it += G) gdn_local_item(P, lds, it, tid);
#endif
#ifndef NO_LRUL
        for (int lt = bx; lt < 256; lt += G) lru_local_item(P, lds, lt, tid, lane, wave);
#endif
    }
    SEAM(2);
    if (IN(3)) REPS(3) {
        if (bx < SCAN_WGS) gdn_scan(P, lds, bx, tid, lane, wave);
        else if (bx < SCAN_WGS + 2) lru_carry(P, (bx - SCAN_WGS) * NWAVES + wave, lane);
        else cvt_table_fp8(P.peer_u, ws + WS_UB, (float*)(ws + WS_UB + 16 * MiB), (bx - SCAN_WGS - 2) * NWAVES + wave, (G - SCAN_WGS - 2) * NWAVES, lane);
    }
    SEAM(3);
    if (IN(4)) REPS(4) {
        gdn_gate_norm(P, (size_t)bx * (NWAVES * 64) + tid, (size_t)G * (NWAVES * 64));
        lru_combine(P, (size_t)bx * (NWAVES * 64) + tid, (size_t)G * (NWAVES * 64));
        cvt_table_fp8(P.peer_v, ws + WS_VB, (float*)(ws + WS_VB + 16 * MiB), bx * NWAVES + wave, G * NWAVES, lane);
    }
    SEAM(4);
    if (IN(5)) {
        Gemm gm{(const bf16_t*)(ws + WS_Y), (const bf16_t*)(ws + WS_WOUT), T, 1024, 1024}; StaticOrder S; S.init(T, 1024, G, bx);
        EpiResid E{P.x, P.out, XB, (float*)(ws + WS_SSQ1)};
        gemm_phase<EpiResid, StaticOrder, PG8_ALIGN, PG8_SP2>(lds, gm, S, E);
    }
    SEAM(5);
    if (IN(6)) REPS(6) {
        Gemm gm{XB, (const bf16_t*)(ws + WS_WQ), T, 1024, 1024}; StaticOrder S; S.init(T, 1024, G, bx);
        EpiBf16Rs E{(bf16_t*)(ws + WS_Q), 1024, 4, nullptr, 256, 0, (const float*)(ws + WS_SSQ1), 0.0625f};
        gemm_phase<EpiBf16Rs, StaticOrder, PG8_ALIGN, PG8_SP2>(lds, gm, S, E);
    }
    SEAM(6);
    if (IN(7)) REPS(7) {
        for (int wu = bx * NWAVES + wave; wu < 4096; wu += G * NWAVES) xattn_unit(P, wu, lane);
    }
    SEAM(7);
    if (IN(8)) {
        Gemm gm{(const bf16_t*)(ws + WS_AO), (const bf16_t*)(ws + WS_WO), T, 1024, 1024}; StaticOrder S; S.init(T, 1024, G, bx);
        EpiResid E{P.out, P.out, XB, (float*)(ws + WS_SSQ2)};
        gemm_phase<EpiResid, StaticOrder, PG8_ALIGN, PG8_SP2>(lds, gm, S, E);
    }
    SEAM(8);
    if (IN(9)) REPS(9) {
        Gemm gm{XB, (const bf16_t*)(ws + WS_PWQ), T, 2048, 1024}; StaticOrder S; S.init(T, 2048, G, bx);
        EpiBf16Rs E{(bf16_t*)(ws + WS_PQ), 2048, 8, nullptr, 256, 0, (const float*)(ws + WS_SSQ2), 1.0f};
        gemm_phase<EpiBf16Rs, StaticOrder, PG8_ALIGN, PG8_SP2>(lds, gm, S, E);
    }
    SEAM(9);
    if (IN(10)) REPS(10) {
        for (int it = bx; it < 512; it += G) peer_topk_item(P, lds, it, tid, lane, wave);
    }
    SEAM(10);
    if (IN(11)) REPS(11) {
        for (int t = bx * NWAVES + wave; t < T; t += G * NWAVES) peer_token(P, t, lane, (((REP_MASK >> 11) & 1) && rep_ == 0) ? (float*)(ws + WS_PQ) : P.out);
    }
#undef IN
#undef SEAM
}

extern "C" void kernel_launch(void* const* d_in, const int* in_sizes, int n_in, void* d_out, int out_size, void* d_ws, size_t ws_size, hipStream_t stream) {
    static int grid = 0;
    if (grid == 0) {
        if (n_in != 27 || in_sizes[0] != T * D || out_size != T * D || ws_size < WS_END) {
            fprintf(stderr, "kernel_launch: unexpected shapes (n_in %d, in0 %d, out %d, ws %zu); nothing launched\n", n_in, n_in > 0 ? in_sizes[0] : -1, out_size, ws_size); grid = -1; return; }
        int dev = 0, cus = 0, per_cu = 0;
        if (hipGetDevice(&dev) != hipSuccess || hipDeviceGetAttribute(&cus, hipDeviceAttributeMultiprocessorCount, dev) != hipSuccess) { grid = -1; return; }
        if (hipFuncSetAttribute((const void*)hybrid_fwd, hipFuncAttributeMaxDynamicSharedMemorySize, LDS_BYTES) != hipSuccess) { fprintf(stderr, "kernel_launch: hipFuncSetAttribute failed\n"); grid = -1; return; }
        if (hipOccupancyMaxActiveBlocksPerMultiprocessor(&per_cu, (const void*)hybrid_fwd, NWAVES * 64, LDS_BYTES) != hipSuccess || per_cu < 1)
            fprintf(stderr, "kernel_launch: note: occupancy query reports %d workgroups per CU\n", per_cu);
        (void)hipGetLastError();
        grid = cus;
        if (grid != 256) fprintf(stderr, "kernel_launch: %d CUs (built for 256)\n", grid);
    }
    if (grid < 0) return;
    if (hipMemsetAsync((char*)d_ws + WS_CTL, 0, CTL_ZERO_BYTES, stream) != hipSuccess) { fprintf(stderr, "kernel_launch: hipMemsetAsync failed\n"); return; }
    Params p{};
    const float** pp = (const float**)&p;
    for (int i = 0; i < 27; ++i) pp[i] = (const float*)d_in[i];
    p.out = (float*)d_out; p.ws = (unsigned char*)d_ws;
#if MK_PER_PHASE
    for (int k = 0; k < N_PHASES; ++k) { p.ph_lo = k; p.ph_hi = k + 1; hipLaunchKernelGGL(hybrid_fwd, dim3(grid), dim3(NWAVES * 64), LDS_BYTES, stream, p); }
#else
    p.ph_lo = 0; p.ph_hi = N_PHASES;
    hipLaunchKernelGGL(hybrid_fwd, dim3(grid), dim3(NWAVES * 64), LDS_BYTES, stream, p);
#endif
    const hipError_t le = hipPeekAtLastError();
    if (le != hipSuccess) fprintf(stderr, "kernel_launch: launch failed: %s\n", hipGetErrorName(le));
}
```

```cpp
#include <hip/hip_runtime.h>
#include <cstdio>
#include <cstdint>
namespace pg8 {
#define PG8_LAS __attribute__((address_space(3)))
typedef unsigned short bf16_t;
typedef short bf16x8 __attribute__((ext_vector_type(8)));
typedef float f32x4 __attribute__((ext_vector_type(4)));
typedef unsigned u32x4 __attribute__((ext_vector_type(4)));
constexpr int BM = 256, BK = 64, HALF = 128, HTB = HALF * BK * 2  , STAGE_BYTES = 8 * HTB, NXCD = 8, WGM = 8;

__host__ __device__ __forceinline__ int lds_byte(int r, int c) { const int st = (r >> 4) * 2 + (c >> 5), rr = r & 15, cc = c & 31, ob = rr * 64 + cc * 2; return st * 1024 + (ob ^ (((ob >> 9) & 1) << 5)); }
__host__ __device__ __forceinline__ void stage_rc(int b, int& R, int& C) { const int st = b / 1024, sb = b % 1024, swz = sb ^ (((sb >> 9) & 1) << 5); R = (st >> 1) * 16 + swz / 64; C = (st & 1) * 32 + (swz % 64) / 2; }
__host__ __device__ __forceinline__ int perm32(int rho) { const int n = rho >> 4, i = rho & 15; return 8 * (i >> 2) + 4 * n + (i & 3); }

struct Unit { int pm, pn; };
struct Gemm { const bf16_t* A; const bf16_t* Bt; int M, N, K; };

struct StaticOrder {
    int nM, nN, nwg, G, c;
    __host__ __device__ void init(int M, int N, int G_, int c_) { nM = M / BM; nN = N / BM; nwg = nM * nN; G = G_; c = c_; }
    __host__ __device__ bool next(int i, Unit& u) const {
        const long L = (long)i * G + c; if (L >= nwg) return false;
        int wgid = (int)L; { const int q = nwg / NXCD, r = nwg % NXCD, xcd = wgid % NXCD, off = wgid / NXCD; wgid = (xcd < r ? xcd * (q + 1) : r * (q + 1) + (xcd - r) * q) + off; }
        const int nig = WGM * nN, gid = wgid / nig, fm = gid * WGM, gsz = (nM - fm) < WGM ? (nM - fm) : WGM;
        u.pm = fm + ((wgid % nig) % gsz); u.pn = (wgid % nig) / gsz; return true;
    }
    __device__ __forceinline__ void a_ready(const Unit&) const {}
    __device__ __forceinline__ void done(const Unit&) const {}
};

__device__ __forceinline__ unsigned cvt_pk_bf16(float lo, float hi) { unsigned r; asm volatile("v_cvt_pk_bf16_f32 %0, %1, %2" : "=v"(r) : "v"(lo), "v"(hi)); return r; }
template <class Epi, class Sched, bool ALIGN_EPI = false, bool SP2 = false>
__device__ __forceinline__ void gemm_phase(PG8_LAS unsigned char* lds, const Gemm g, const Sched& S, const Epi& E) {
    const int tid = threadIdx.x, wid = __builtin_amdgcn_readfirstlane(tid >> 6), lane = tid & 63, wr = wid >> 2, wc = wid & 3, fr = lane & 15, fq = lane >> 4;
    const int K = g.K, nt = K / BK;
    unsigned voffA[2], voffB[2];
#pragma unroll
    for (int i = 0; i < 2; ++i) { int R, C; stage_rc(tid * 16 + i * 8192, R, C); const int Rb = Epi::PERM ? ((R & ~31) + perm32(R & 31)) : R;
        voffA[i] = (unsigned)(R * K + C) * 2u; voffB[i] = (unsigned)(Rb * K + C) * 2u; }
    const size_t kstep = (size_t)(BK * 2);
    const size_t hstep = (size_t)HALF * K * 2;
    const size_t tstep = 2 * hstep;
    const unsigned ldsw = (unsigned)wid * 1024u;
    const int aoff = lds_byte(wr * 64 + fr, fq * 8), boff = lds_byte(wc * 32 + fr, fq * 8);
#define PG8_SA(b, h) (((b) * 2 + (h)) * HTB)
#define PG8_SB(b, h) ((4 + (b) * 2 + (h)) * HTB)
#define PG8_STAGE(bufoff, gbase, voff) do { _Pragma("unroll") for (int _i = 0; _i < 2; ++_i) \
        __builtin_amdgcn_global_load_lds((const unsigned*)((const char*)(gbase) + (voff)[_i]), (PG8_LAS unsigned*)(lds + (bufoff) + ldsw + _i * 8192), 16, 0, 0); } while (0)
#define PG8_LDA(dst, b, h) do { _Pragma("unroll") for (int m = 0; m < 4; ++m) _Pragma("unroll") for (int k = 0; k < 2; ++k) dst[m][k] = *(const PG8_LAS bf16x8*)(lds + PG8_SA(b, h) + aoff + m * 2048 + k * 1024); } while (0)
#define PG8_LDB(dst, b, h) do { _Pragma("unroll") for (int n = 0; n < 2; ++n) _Pragma("unroll") for (int k = 0; k < 2; ++k) dst[n][k] = *(const PG8_LAS bf16x8*)(lds + PG8_SB(b, h) + boff + n * 2048 + k * 1024); } while (0)
#define PG8_MMA(ai, bj, At, Bt) do { __builtin_amdgcn_s_setprio(1); _Pragma("unroll") for (int m = 0; m < 4; ++m) _Pragma("unroll") for (int n = 0; n < 2; ++n) _Pragma("unroll") for (int k = 0; k < 2; ++k) \
        acc[ai][bj][m][n] = __builtin_amdgcn_mfma_f32_16x16x32_bf16(Bt[n][k], At[m][k], acc[ai][bj][m][n], 0, 0, 0); __builtin_amdgcn_s_setprio(0); } while (0)
#define PG8_WAIT_V(n) asm volatile("s_waitcnt vmcnt(" #n ")" ::: "memory")
#define PG8_WAIT_L(n) asm volatile("s_waitcnt lgkmcnt(" #n ")" ::: "memory")
#define PG8_BAR __builtin_amdgcn_s_barrier()
#define PG8_SCHED __builtin_amdgcn_sched_barrier(0)
    Unit cur, nxt; int ui = 0;
    if (!S.next(0, cur)) return;
    f32x4 acc[2][2][4][2];
#pragma unroll
    for (int a = 0; a < 2; ++a)
#pragma unroll
        for (int b = 0; b < 2; ++b)
#pragma unroll
            for (int m = 0; m < 4; ++m)
#pragma unroll
                for (int n = 0; n < 2; ++n) acc[a][b][m][n] = (f32x4){0.f, 0.f, 0.f, 0.f};
    bf16x8 At[4][2], B0[2][2], B1[2][2];
    const char* cA = (const char*)g.A + (size_t)cur.pm * tstep; const char* cB = (const char*)g.Bt + (size_t)cur.pn * tstep;
    S.a_ready(cur);
    if constexpr (SP2) {
        PG8_STAGE(PG8_SB(0, 0), cB, voffB); PG8_STAGE(PG8_SB(0, 1), cB + hstep, voffB); PG8_STAGE(PG8_SA(0, 0), cA, voffA); PG8_STAGE(PG8_SA(0, 1), cA + hstep, voffA);
        if (wr == 1) PG8_BAR;
        PG8_WAIT_V(2); PG8_BAR;
        PG8_STAGE(PG8_SB(1, 0), cB + kstep, voffB); PG8_STAGE(PG8_SA(1, 0), cA + kstep, voffA); PG8_STAGE(PG8_SB(1, 1), cB + hstep + kstep, voffB);
        PG8_WAIT_V(6); PG8_BAR;
    } else {
        PG8_STAGE(PG8_SB(0, 0), cB, voffB); PG8_STAGE(PG8_SA(0, 0), cA, voffA); PG8_STAGE(PG8_SB(0, 1), cB + hstep, voffB); PG8_STAGE(PG8_SA(0, 1), cA + hstep, voffA);
        if (wr == 1) PG8_BAR;
        PG8_WAIT_V(4); PG8_BAR;
        PG8_STAGE(PG8_SB(1, 0), cB + kstep, voffB); PG8_STAGE(PG8_SA(1, 0), cA + kstep, voffA); PG8_STAGE(PG8_SB(1, 1), cB + hstep + kstep, voffB);
        PG8_WAIT_V(6); PG8_BAR;
    }
    for (;;) {
        const bool has_next = S.next(ui + 1, nxt);
        const char* nA = has_next ? (const char*)g.A + (size_t)nxt.pm * tstep : cA; const char* nB = has_next ? (const char*)g.Bt + (size_t)nxt.pn * tstep : cB;
        for (int t = 0; t < nt; t += 2) {
            const bool last = (t == nt - 2);
            const char* a1 = cA + (size_t)(t + 1) * kstep;
            const char* a2 = last ? nA : cA + (size_t)(t + 2) * kstep; const char* b2 = last ? nB : cB + (size_t)(t + 2) * kstep;
            const char* a3 = a2 + kstep; const char* b3 = b2 + kstep;
            if (last && has_next) S.a_ready(nxt);
            if constexpr (SP2) {
            PG8_LDB(B0, 0, 0); PG8_LDB(B1, 0, 1); PG8_SCHED; PG8_LDA(At, 0, 0); PG8_STAGE(PG8_SA(1, 1), a1 + hstep, voffA);
            PG8_WAIT_V(8); PG8_WAIT_L(0); PG8_BAR; PG8_MMA(0, 0, At, B0); PG8_MMA(0, 1, At, B1); PG8_BAR; PG8_SCHED;
            PG8_LDA(At, 0, 1); PG8_STAGE(PG8_SB(0, 0), b2, voffB); PG8_STAGE(PG8_SB(0, 1), b2 + hstep, voffB); PG8_STAGE(PG8_SA(0, 0), a2, voffA);
            PG8_WAIT_V(8); PG8_WAIT_L(0); PG8_BAR; PG8_MMA(1, 0, At, B0); PG8_MMA(1, 1, At, B1); PG8_BAR; PG8_SCHED;
            PG8_LDB(B0, 1, 0); PG8_LDB(B1, 1, 1); PG8_SCHED; PG8_LDA(At, 1, 0); PG8_STAGE(PG8_SA(0, 1), a2 + hstep, voffA);
            PG8_WAIT_V(8); PG8_WAIT_L(0); PG8_BAR; PG8_MMA(0, 0, At, B0); PG8_MMA(0, 1, At, B1); PG8_BAR; PG8_SCHED;
            PG8_LDA(At, 1, 1); PG8_STAGE(PG8_SB(1, 0), b3, voffB); PG8_STAGE(PG8_SB(1, 1), b3 + hstep, voffB); PG8_STAGE(PG8_SA(1, 0), a3, voffA);
            PG8_WAIT_V(8); PG8_WAIT_L(0); PG8_BAR; PG8_MMA(1, 0, At, B0); PG8_MMA(1, 1, At, B1); PG8_BAR; PG8_SCHED;
            } else {
            PG8_LDB(B0, 0, 0); PG8_SCHED; PG8_LDA(At, 0, 0); PG8_STAGE(PG8_SA(1, 1), a1 + hstep, voffA);
            PG8_WAIT_L(8); PG8_BAR; PG8_WAIT_L(0); PG8_MMA(0, 0, At, B0); PG8_BAR; PG8_SCHED;
            PG8_LDB(B1, 0, 1); PG8_STAGE(PG8_SB(0, 0), b2, voffB);
            PG8_BAR; PG8_WAIT_L(0); PG8_MMA(0, 1, At, B1); PG8_BAR;
            PG8_LDA(At, 0, 1); PG8_STAGE(PG8_SA(0, 0), a2, voffA);
            PG8_BAR; PG8_WAIT_L(0); PG8_MMA(1, 0, At, B0); PG8_BAR; PG8_SCHED;
            PG8_STAGE(PG8_SB(0, 1), b2 + hstep, voffB);
            PG8_WAIT_V(6); PG8_BAR; PG8_MMA(1, 1, At, B1); PG8_BAR;
            PG8_LDB(B0, 1, 0); PG8_SCHED; PG8_LDA(At, 1, 0); PG8_STAGE(PG8_SA(0, 1), a2 + hstep, voffA);
            PG8_WAIT_L(8); PG8_BAR; PG8_WAIT_L(0); PG8_MMA(0, 0, At, B0); PG8_BAR; PG8_SCHED;
            PG8_LDB(B1, 1, 1); PG8_STAGE(PG8_SB(1, 0), b3, voffB);
            PG8_BAR; PG8_WAIT_L(0); PG8_MMA(0, 1, At, B1); PG8_BAR;
            PG8_LDA(At, 1, 1); PG8_STAGE(PG8_SA(1, 0), a3, voffA);
            PG8_BAR; PG8_WAIT_L(0); PG8_MMA(1, 0, At, B0); PG8_BAR; PG8_SCHED;
            PG8_STAGE(PG8_SB(1, 1), b3 + hstep, voffB);
            PG8_WAIT_V(6); PG8_BAR; PG8_MMA(1, 1, At, B1); PG8_BAR;
            }
        }
        if constexpr (ALIGN_EPI) { if (wr == 0) PG8_BAR; }
        if constexpr (!Epi::AFTER_DRAIN) { E(acc, cur, wr, wc, fr, fq); S.done(cur); }
        if (!has_next) break;
#pragma unroll
        for (int a = 0; a < 2; ++a)
#pragma unroll
            for (int b = 0; b < 2; ++b)
#pragma unroll
                for (int m = 0; m < 4; ++m)
#pragma unroll
                    for (int n = 0; n < 2; ++n) acc[a][b][m][n] = (f32x4){0.f, 0.f, 0.f, 0.f};
        cur = nxt; cA = nA; cB = nB; ++ui;
        if constexpr (ALIGN_EPI) { if (wr == 1) PG8_BAR; }
    }
    PG8_WAIT_V(0);
    if constexpr (!ALIGN_EPI) { if (wr == 0) PG8_BAR; }
    PG8_BAR;
    if constexpr (Epi::AFTER_DRAIN) { E.fused(acc, cur, wr, wc, fr, fq, lds, wid, lane); S.done(cur); }
#undef PG8_SA
#undef PG8_SB
#undef PG8_STAGE
#undef PG8_LDA
#undef PG8_LDB
#undef PG8_MMA
#undef PG8_WAIT_V
#undef PG8_WAIT_L
#undef PG8_BAR
#undef PG8_SCHED
}
}

namespace pg8 {
__host__ __device__ __forceinline__ int permk(int kl) { return 8 * ((kl & 15) >> 2) + 4 * (kl >> 4) + (kl & 3); }
struct EpiBf16Rs {
    static constexpr bool PERM = true, AFTER_DRAIN = false;
    bf16_t* O0; int ld0; int ntile0; bf16_t* O1; int ld1; size_t stride1; const float* ssq; float cs;
    __device__ __forceinline__ void operator()(const f32x4 (&acc)[2][2][4][2], const Unit& u, int wr, int wc, int fr, int fq) const {
        bf16_t* base; int ld, colt;
        if (u.pn < ntile0) { base = O0; ld = ld0; colt = u.pn * BM; }
        else { const int q = u.pn - ntile0, per = ld1 / BM; base = O1 + (size_t)(q / per) * stride1; ld = ld1; colt = (q % per) * BM; }
        const int row0 = u.pm * BM + wr * 64 + fr, col0 = colt + wc * 32 + 8 * fq;
#pragma unroll
        for (int ai = 0; ai < 2; ++ai)
#pragma unroll
            for (int m = 0; m < 4; ++m) {
                const int row = row0 + ai * HALF + m * 16;
                float sc = cs; if (ssq) sc *= rsqrtf(ssq[row] * (1.0f / 1024.0f) + 1e-6f);
                bf16_t* rowp = base + (size_t)row * ld + col0;
#pragma unroll
                for (int bj = 0; bj < 2; ++bj) { const f32x4 v0 = acc[ai][bj][m][0] * sc, v1 = acc[ai][bj][m][1] * sc;
                    u32x4 w; w.x = cvt_pk_bf16(v0[0], v0[1]); w.y = cvt_pk_bf16(v0[2], v0[3]); w.z = cvt_pk_bf16(v1[0], v1[1]); w.w = cvt_pk_bf16(v1[2], v1[3]);
                    *(u32x4*)(rowp + bj * HALF) = w; } }
    }
};
struct EpiResid {
    static constexpr bool PERM = false, AFTER_DRAIN = false;
    const float* base; float* out; bf16_t* xb; float* ssq;
    __device__ __forceinline__ void operator()(const f32x4 (&acc)[2][2][4][2], const Unit& u, int wr, int wc, int fr, int fq) const {
        typedef unsigned u32x2v __attribute__((ext_vector_type(2)));
        const int row0 = u.pm * BM + wr * 64 + fr, col0 = u.pn * BM + wc * 32 + 4 * fq;
#pragma unroll
        for (int ai = 0; ai < 2; ++ai)
#pragma unroll
            for (int m = 0; m < 4; ++m) {
                const int row = row0 + ai * HALF + m * 16; const size_t off = (size_t)row * 1024 + col0; float s = 0.f;
#pragma unroll
                for (int bj = 0; bj < 2; ++bj)
#pragma unroll
                    for (int n = 0; n < 2; ++n) { const size_t o2 = off + bj * HALF + n * 16;
                        const f32x4 o = *(const f32x4*)(base + o2) + acc[ai][bj][m][n];
                        *(f32x4*)(out + o2) = o; s += (o[0] * o[0] + o[1] * o[1]) + (o[2] * o[2] + o[3] * o[3]);
                        u32x2v w; w.x = cvt_pk_bf16(o[0], o[1]); w.y = cvt_pk_bf16(o[2], o[3]); *(u32x2v*)(xb + o2) = w; }
                s += __shfl_xor(s, 16); s += __shfl_xor(s, 32);
                if (fq == 0) atomicAdd(ssq + row, s);
            }
    }
};
struct EpiKV {
    static constexpr bool PERM = false, AFTER_DRAIN = false;
    bf16_t* Kb; bf16_t* VTp;
    __device__ __forceinline__ void operator()(const f32x4 (&acc)[2][2][4][2], const Unit& u, int wr, int wc, int fr, int fq) const {
        typedef unsigned u32x2v __attribute__((ext_vector_type(2)));
        const int row0 = u.pm * BM + wr * 64 + fr, col0 = u.pn * BM + wc * 32 + 4 * fq;
#pragma unroll
        for (int ai = 0; ai < 2; ++ai)
#pragma unroll
            for (int m = 0; m < 4; ++m) {
                const int row = row0 + ai * HALF + m * 16, b = row >> 8, key = row & 255;
#pragma unroll
                for (int bj = 0; bj < 2; ++bj)
#pragma unroll
                    for (int n = 0; n < 2; ++n) { const int col = col0 + bj * HALF + n * 16; const f32x4 v = acc[ai][bj][m][n];
                        const unsigned p01 = cvt_pk_bf16(v[0], v[1]), p23 = cvt_pk_bf16(v[2], v[3]);
                        if (col < 1024) { const int h = col >> 8, dh = col & 255; u32x2v w; w.x = p01; w.y = p23;
                            *(u32x2v*)(Kb + ((size_t)((b * 4 + h) * 256 + key)) * 256 + dh) = w; }
                        else { const int c2 = col - 1024, h = c2 >> 8, dv = c2 & 255, kp = (key & ~31) | permk(key & 31);
                            bf16_t* d = VTp + ((size_t)((b * 4 + h) * 256 + dv)) * 256 + kp;
                            d[0] = (bf16_t)(p01 & 0xffffu); d[256] = (bf16_t)(p01 >> 16); d[512] = (bf16_t)(p23 & 0xffffu); d[768] = (bf16_t)(p23 >> 16); } }
            }
    }
};
}
#ifndef PG8_SP2
#define PG8_SP2 true
#endif
#ifndef PG8_ALIGN
#define PG8_ALIGN true
#endif

constexpr int NWAVES = 8;
#ifndef MK_PER_PHASE
#define MK_PER_PHASE 0
#endif
constexpr int T = 16384, SEQ = 8192, D = 1024;
constexpr int N_PHASES = 12;

constexpr size_t MiB = 1u << 20, KiB = 1u << 10;
constexpr size_t WS_CTL = 0, CTL_ZERO_BYTES = 1 * MiB;
constexpr int CW_BAR = 4096;
constexpr size_t WS_SSQ1 = 64 * KiB, WS_SSQ2 = 128 * KiB;
constexpr size_t WS_AB = 1 * MiB;
constexpr size_t WS_HEND = WS_AB + 512 * KiB, WS_PEND = WS_HEND + 512 * KiB, WS_HIN = WS_PEND + 512 * KiB;
constexpr size_t WS_DEC = WS_HIN + 512 * KiB;
constexpr size_t WS_SUBK = 3 * MiB + 256 * KiB;
constexpr size_t WS_WIN = 4 * MiB, WS_WOUT = 10 * MiB, WS_WQ = 12 * MiB, WS_WKV = 14 * MiB, WS_WO = 18 * MiB, WS_PWQ = 20 * MiB;
constexpr size_t WS_MEMN = 24 * MiB, WS_KB = 25 * MiB, WS_VTP = 26 * MiB;
constexpr size_t WS_XB = 28 * MiB;
constexpr size_t WS_HLOC = 28 * MiB, WS_PCUM = 44 * MiB;
constexpr size_t WS_QKV = 60 * MiB;
constexpr size_t WS_Y = 60 * MiB;
constexpr size_t WS_IDX = 60 * MiB, WS_GW = 68 * MiB;
constexpr size_t WS_UB = 92 * MiB;
constexpr size_t WS_XR = 108 * MiB, WS_Z = 124 * MiB, WS_GATE = 140 * MiB;
constexpr size_t WS_WN = 156 * MiB, WS_UF = 172 * MiB, WS_QD = 188 * MiB, WS_KD = 204 * MiB, WS_ATT = 220 * MiB;
constexpr size_t WS_VB = 156 * MiB;
constexpr size_t WS_Q = 188 * MiB, WS_AO = 220 * MiB;
constexpr size_t WS_PQ = 188 * MiB;
constexpr size_t WS_END = 252 * MiB;
static_assert(WS_XR - WS_QKV == (size_t)T * 1536 * 2 && WS_Z - WS_XR == (size_t)T * 512 * 2 && WS_GATE - WS_Z == (size_t)T * 512 * 2, "in-proj outputs are contiguous");

constexpr int LDS_BYTES = 160 * 1024;
constexpr int MISC_OFF = 159 * 1024;

#define GAS __attribute__((address_space(1)))
#define LAS __attribute__((address_space(3)))
typedef unsigned short bf16;
typedef unsigned v4u __attribute__((ext_vector_type(4)));
typedef unsigned v2u __attribute__((ext_vector_type(2)));
typedef float f32x4 __attribute__((ext_vector_type(4)));
typedef short bf16x8 __attribute__((ext_vector_type(8)));
typedef GAS unsigned gu32;
#define LDS_WAIT() asm volatile("s_waitcnt lgkmcnt(0)" ::: "memory")
__device__ __forceinline__ unsigned f2bf(float f) { unsigned u = __builtin_bit_cast(unsigned, f); return (u + 0x7fffu + ((u >> 16) & 1u)) >> 16; }
__device__ __forceinline__ unsigned pk2(float lo, float hi) { return f2bf(lo) | (f2bf(hi) << 16); }
__device__ __forceinline__ float bflo(unsigned u) { return __builtin_bit_cast(float, u << 16); }
__device__ __forceinline__ float bfhi(unsigned u) { return __builtin_bit_cast(float, u & 0xffff0000u); }
__device__ __forceinline__ float bf1(bf16 h) { return __builtin_bit_cast(float, (unsigned)h << 16); }
__device__ __forceinline__ float wave_sum(float v) {
#pragma unroll
    for (int o = 1; o < 64; o <<= 1) v += __shfl_xor(v, o);
    return v;
}
__device__ __forceinline__ float sigmoidf_(float x) { return 1.0f / (1.0f + __expf(-x)); }
__device__ __forceinline__ float softplusf_(float x) { return fmaxf(x, 0.f) + log1pf(__expf(-fabsf(x))); }
__device__ __forceinline__ float siluf_(float x) { return x / (1.0f + __expf(-x)); }
__device__ __forceinline__ float gelu_tanh(float x) { const float y = 0.7978845608028654f * (x + 0.044715f * x * x * x); const float e = __expf(2.0f * y); return 0.5f * x * (2.0f - 2.0f / (1.0f + e)); }
__device__ __forceinline__ int permk(int kl) { return 8 * ((kl & 15) >> 2) + 4 * (kl >> 4) + (kl & 3); }

struct Params {
    const float *x, *mem, *norm_mix_w, *w_in, *conv_qkv_w, *gdn_a_log, *gdn_dt_bias, *gdn_norm_w, *lru_conv_w, *lru_conv_b, *lru_wa, *lru_ba, *lru_wx, *lru_bx, *lru_lambda, *w_out,
                *norm_xattn_w, *norm_mem_w, *xattn_wq, *xattn_wkv, *xattn_wo, *norm_ffn_w, *peer_wq, *peer_subkeys, *peer_u, *peer_v, *norm_final_w;
    float* out; unsigned char* ws; int ph_lo, ph_hi;
};
#define XB_TMO      128
#define XB_XCNT(j)  (256  + 64 * (j))
#define XB_XSUB(j)  (1280 + 64 * (j))
#define XB_XGEN(j)  (2304 + 64 * (j))
#define XB_TOP      3328
#define XB_TOPGEN   3392
#define XCD_BAR_WORDS 3456
#define XB_SPIN_CAP (1u << 18)

__device__ __forceinline__ unsigned xb_ld(unsigned* p)              { return __hip_atomic_load(p, __ATOMIC_RELAXED, __HIP_MEMORY_SCOPE_AGENT); }
__device__ __forceinline__ unsigned xb_add(unsigned* p, unsigned v) { return __hip_atomic_fetch_add(p, v, __ATOMIC_RELAXED, __HIP_MEMORY_SCOPE_AGENT); }
__device__ __forceinline__ unsigned xb_xcc_id() { return (unsigned)__builtin_amdgcn_s_getreg((3 << 11) | 20) & 0xFu; }
#define XB_SPIN(cond, bar) do { unsigned _sp = 0; while (cond) { __builtin_amdgcn_s_sleep(1); \
    if ((++_sp & 255u) == 0u) { if (xb_ld(&(bar)[XB_TMO])) break; if (_sp > XB_SPIN_CAP) { atomicAdd(&(bar)[XB_TMO], 1u); break; } } } } while (0)

struct XcdBarrier {
    unsigned* bar; unsigned x;
    volatile LAS unsigned* st;
};

__device__ __forceinline__ XcdBarrier xcd_barrier_post(unsigned* bar, volatile LAS unsigned* st) {
    XcdBarrier b; b.bar = bar; b.x = xb_xcc_id(); b.st = st;
    if (threadIdx.x == 0) (void)xb_add(&bar[XB_XCNT(b.x)], 1u);
    return b;
}
__device__ __forceinline__ void xcd_barrier_complete(unsigned* bar, unsigned x, unsigned& nloc, unsigned& nx) {
    const unsigned G = gridDim.x * gridDim.y * gridDim.z;
    unsigned sum, cnt, mine, sp = 0u;
    for (;;) {
        sum = 0u; cnt = 0u; mine = 0u;
#pragma unroll
        for (unsigned j = 0; j < 16; ++j) { const unsigned c = xb_ld(&bar[XB_XCNT(j)]); sum += c; cnt += (c > 0u) ? 1u : 0u; mine = (j == x) ? c : mine; }
        if (sum == G) break;
        __builtin_amdgcn_s_sleep(1);
        if ((++sp & 255u) == 0u) { if (xb_ld(&bar[XB_TMO])) break; if (sp > XB_SPIN_CAP) { atomicAdd(&bar[XB_TMO], 1u); break; } }
    }
    nloc = mine > 0u ? mine : 1u; nx = cnt > 0u ? cnt : 1u;
}

__device__ __forceinline__ void xcd_barrier(const XcdBarrier& b) {
    asm volatile("s_waitcnt vmcnt(0)" ::: "memory");
    __syncthreads();
    if (threadIdx.x == 0) {
        unsigned* bar = b.bar;
        __builtin_amdgcn_s_waitcnt(0);
        unsigned nloc = b.st[0], nx = b.st[1];
        if (nloc == 0u) { xcd_barrier_complete(bar, b.x, nloc, nx); b.st[0] = nloc; b.st[1] = nx; }
        const unsigned old = xb_add(&bar[XB_XSUB(b.x)], 1u);
        const unsigned gen = old / nloc;
        if (old + 1u == (gen + 1u) * nloc) {
            __builtin_amdgcn_fence(__ATOMIC_RELEASE, "agent");
            asm volatile("s_waitcnt vmcnt(0)" ::: "memory");
            const unsigned og = xb_add(&bar[XB_TOP], 1u);
            const unsigned tg = og / nx;
            if (og + 1u == (tg + 1u) * nx) xb_add(&bar[XB_TOPGEN], 1u);
            else XB_SPIN(xb_ld(&bar[XB_TOPGEN]) == tg, bar);
            __builtin_amdgcn_fence(__ATOMIC_ACQUIRE, "agent");
            xb_add(&bar[XB_XGEN(b.x)], 1u);
            asm volatile("s_waitcnt vmcnt(0)" ::: "memory");
        } else {
            XB_SPIN(xb_ld(&bar[XB_XGEN(b.x)]) == gen, bar);
            __builtin_amdgcn_fence(__ATOMIC_ACQUIRE, "agent");
            asm volatile("s_waitcnt vmcnt(0)" ::: "memory");
        }
    }
    __syncthreads();
}

__device__ __forceinline__ void p0_transpose_item(const float* W, int K, int ldw, int c0, int nblk, bf16* WT, int row_off, const float* ks, LAS float* scr, int item, int lane) {
    const int kb = item / nblk, nb = item % nblk, k0 = 64 * kb, n0 = 32 * nb;
#pragma unroll 8
    for (int i = 0; i < 32; ++i) { const int kk = 2 * i + (lane >> 5); float v = W[(size_t)(k0 + kk) * ldw + c0 + n0 + (lane & 31)]; if (ks) v *= ks[k0 + kk]; scr[kk * 33 + (lane & 31)] = v; }
    LDS_WAIT(); asm volatile("" ::: "memory");
    const int c = lane & 7;
#pragma unroll
    for (int j = 0; j < 4; ++j) { const int n = (lane >> 3) + 8 * j; const LAS float* s = scr + (8 * c) * 33 + n;
        v4u o; o.x = pk2(s[0 * 33], s[1 * 33]); o.y = pk2(s[2 * 33], s[3 * 33]); o.z = pk2(s[4 * 33], s[5 * 33]); o.w = pk2(s[6 * 33], s[7 * 33]);
        *(GAS v4u*)(WT + (size_t)(row_off + n0 + n) * K + k0 + 8 * c) = o; }
    LDS_WAIT(); asm volatile("" ::: "memory");
}

__device__ __forceinline__ void p0_prologue(const Params& P, LAS unsigned char* lds, int tid, int lane, int wave, int vcu, int G) {
    unsigned char* ws = P.ws;
    const int gw = vcu * NWAVES + wave, NGW = G * NWAVES;
    LAS float* wabl = (LAS float*)lds;
    for (int idx = tid; idx < 8192; idx += NWAVES * 64) { const int k = idx >> 3, c = idx & 7, j = k >> 8, l = (k >> 2) & 63, e = k & 3;
        wabl[((((j * 4 + e) * 2 + (c >> 2)) * 64 + l) << 2) + (c & 3)] = P.w_in[(size_t)k * 3080 + 2048 + c]; }
    __syncthreads();
    {
        bf16* XB0 = (bf16*)(ws + WS_XB); float* AB = (float*)(ws + WS_AB);
        f32x4 w4[4];
#pragma unroll
        for (int j = 0; j < 4; ++j) w4[j] = ((const f32x4*)P.norm_mix_w)[64 * j + lane];
        for (int m = gw; m < T; m += NGW) {
            const f32x4* xr = (const f32x4*)(P.x + (size_t)m * D) + lane;
            f32x4 v[4]; float s = 0.f;
#pragma unroll
            for (int j = 0; j < 4; ++j) { v[j] = xr[64 * j]; s += (v[j].x * v[j].x + v[j].y * v[j].y) + (v[j].z * v[j].z + v[j].w * v[j].w); }
            const float rstd = rsqrtf(wave_sum(s) * (1.0f / D) + 1e-6f);
            v2u* o8 = (v2u*)(XB0 + (size_t)m * D) + lane;
            float part[8];
#pragma unroll
            for (int c = 0; c < 8; ++c) part[c] = 0.f;
#pragma unroll
            for (int j = 0; j < 4; ++j) {
                v[j] = v[j] * rstd * w4[j];
                v2u o; o.x = pk2(v[j].x, v[j].y); o.y = pk2(v[j].z, v[j].w); o8[64 * j] = o;
#pragma unroll
                for (int e = 0; e < 4; ++e) {
                    const f32x4 wa = *(const LAS f32x4*)(wabl + ((((j * 4 + e) * 2 + 0) * 64 + lane) << 2));
                    const f32x4 wb = *(const LAS f32x4*)(wabl + ((((j * 4 + e) * 2 + 1) * 64 + lane) << 2));
                    const float hv = v[j][e];
                    part[0] += hv * wa.x; part[1] += hv * wa.y; part[2] += hv * wa.z; part[3] += hv * wa.w;
                    part[4] += hv * wb.x; part[5] += hv * wb.y; part[6] += hv * wb.z; part[7] += hv * wb.w;
                }
            }
#pragma unroll
            for (int c = 0; c < 8; ++c) part[c] = wave_sum(part[c]);
            float o = part[0];
#pragma unroll
            for (int c = 1; c < 8; ++c) o = (lane == c) ? part[c] : o;
            if (lane < 8) AB[(size_t)m * 8 + lane] = o;
        }
    }
    {
        bf16* MEMN = (bf16*)(ws + WS_MEMN);
        for (int m = gw; m < 512; m += NGW) {
            const f32x4* xr = (const f32x4*)(P.mem + (size_t)m * D) + lane;
            f32x4 v[4]; float s = 0.f;
#pragma unroll
            for (int j = 0; j < 4; ++j) { v[j] = xr[64 * j]; s += (v[j].x * v[j].x + v[j].y * v[j].y) + (v[j].z * v[j].z + v[j].w * v[j].w); }
            const float rstd = rsqrtf(wave_sum(s) * (1.0f / D) + 1e-6f);
            v2u* o8 = (v2u*)(MEMN + (size_t)m * D) + lane;
#pragma unroll
            for (int j = 0; j < 4; ++j) { const f32x4 w = ((const f32x4*)P.norm_mem_w)[64 * j + lane]; const f32x4 y = v[j] * rstd * w;
                v2u o; o.x = pk2(y.x, y.y); o.y = pk2(y.z, y.w); o8[64 * j] = o; }
        }
    }
    __syncthreads();
    {
        LAS float* scr = (LAS float*)(lds + wave * 16384);
        constexpr int I_IN1 = 16 * 48, I_IN2 = 16 * 16, I_OUT = 16 * 32, I_Q = 16 * 32, I_KV = 16 * 64, I_O = 16 * 32, I_PQ = 16 * 64;
        constexpr int NITEMS = I_IN1 + 3 * I_IN2 + I_OUT + I_Q + I_KV + I_O + I_PQ;
        for (int it = gw; it < NITEMS; it += NGW) {
            int r = it;
            if (r < I_IN1) { p0_transpose_item(P.w_in, 1024, 3080, 0, 48, (bf16*)(ws + WS_WIN), 0, nullptr, scr, r, lane); continue; } r -= I_IN1;
            if (r < I_IN2) { p0_transpose_item(P.w_in, 1024, 3080, 2056, 16, (bf16*)(ws + WS_WIN), 1536, nullptr, scr, r, lane); continue; } r -= I_IN2;
            if (r < I_IN2) { p0_transpose_item(P.w_in, 1024, 3080, 1536, 16, (bf16*)(ws + WS_WIN), 2048, nullptr, scr, r, lane); continue; } r -= I_IN2;
            if (r < I_IN2) { p0_transpose_item(P.w_in, 1024, 3080, 2568, 16, (bf16*)(ws + WS_WIN), 2560, nullptr, scr, r, lane); continue; } r -= I_IN2;
            if (r < I_OUT) { p0_transpose_item(P.w_out, 1024, 1024, 0, 32, (bf16*)(ws + WS_WOUT), 0, nullptr, scr, r, lane); continue; } r -= I_OUT;
            if (r < I_Q) { p0_transpose_item(P.xattn_wq, 1024, 1024, 0, 32, (bf16*)(ws + WS_WQ), 0, P.norm_xattn_w, scr, r, lane); continue; } r -= I_Q;
            if (r < I_KV) { p0_transpose_item(P.xattn_wkv, 1024, 2048, 0, 64, (bf16*)(ws + WS_WKV), 0, nullptr, scr, r, lane); continue; } r -= I_KV;
            if (r < I_O) { p0_transpose_item(P.xattn_wo, 1024, 1024, 0, 32, (bf16*)(ws + WS_WO), 0, nullptr, scr, r, lane); continue; } r -= I_O;
            p0_transpose_item(P.peer_wq, 1024, 2048, 0, 64, (bf16*)(ws + WS_PWQ), 0, P.norm_ffn_w, scr, r, lane);
        }
    }
    {
        bf16* SUBK = (bf16*)(ws + WS_SUBK);
        for (int i = (vcu * NWAVES * 64 + tid); i < 16 * 128 * 128 / 4; i += G * NWAVES * 64) {
            const f32x4 v = ((const f32x4*)P.peer_subkeys)[i]; v2u o; o.x = pk2(v.x, v.y); o.y = pk2(v.z, v.w); ((v2u*)SUBK)[i] = o; }
    }
}

__device__ __forceinline__ void gdn_local_item(const Params& P, LAS unsigned char* lds, int item, int tid) {
    unsigned char* ws = P.ws;
    const int b = item >> 9, h = (item >> 7) & 3, n = item & 127;
    const int t0 = b * SEQ + n * 64;
    LAS float* ks = (LAS float*)lds;
    LAS float* vs = ks + 64 * 132;
    LAS float* AmT = vs + 64 * 132;
    LAS float* sg = AmT + 64 * 68;
    LAS float* sbeta = sg + 64;
    LAS float* sgc = sbeta + 64;
    LAS float* seg = sgc + 64;
    LAS float* sek = seg + 64;
    LAS float* qs = sek + 64;
    LAS float* solw = qs;
    static_assert((2 * 64 * 132 + 64 * 68 + 5 * 64 + 64 * 256) * 4 <= 156 * 1024, "gdn_local LDS");
    const bf16* QKV = (const bf16*)(ws + WS_QKV);
    const float* AB = (const float*)(ws + WS_AB);
#ifndef SKIP_S1
    {
        const int c = tid >> 3, grp = tid & 7;
#pragma unroll 1
        for (int part = 0; part < 3; ++part) {
            const int ch0 = part * 512 + h * 128 + grp * 16;
            float y[16];
#pragma unroll
            for (int i = 0; i < 16; ++i) y[i] = 0.f;
#pragma unroll
            for (int j = 0; j < 4; ++j) {
                const int s = n * 64 + c - 3 + j;
                if (s >= 0) {
                    const v4u* src = (const v4u*)(QKV + (size_t)(b * SEQ + s) * 1536 + ch0);
                    const v4u x0 = src[0], x1 = src[1];
                    const f32x4* wp = (const f32x4*)(P.conv_qkv_w + j * 1536 + ch0);
                    const f32x4 w0 = wp[0], w1 = wp[1], w2 = wp[2], w3 = wp[3];
                    y[0] += w0.x * bflo(x0.x); y[1] += w0.y * bfhi(x0.x); y[2] += w0.z * bflo(x0.y); y[3] += w0.w * bfhi(x0.y);
                    y[4] += w1.x * bflo(x0.z); y[5] += w1.y * bfhi(x0.z); y[6] += w1.z * bflo(x0.w); y[7] += w1.w * bfhi(x0.w);
                    y[8] += w2.x * bflo(x1.x); y[9] += w2.y * bfhi(x1.x); y[10] += w2.z * bflo(x1.y); y[11] += w2.w * bfhi(x1.y);
                    y[12] += w3.x * bflo(x1.z); y[13] += w3.y * bfhi(x1.z); y[14] += w3.z * bflo(x1.w); y[15] += w3.w * bfhi(x1.w);
                }
            }
            float ss = 0.f;
#pragma unroll
            for (int i = 0; i < 16; ++i) { y[i] = siluf_(y[i]); ss += y[i] * y[i]; }
            if (part < 2) {
                ss += __shfl_xor(ss, 1); ss += __shfl_xor(ss, 2); ss += __shfl_xor(ss, 4);
                const float sc = rsqrtf(ss + 1e-6f) * (part == 0 ? 0.08838834764831845f : 1.0f);
#pragma unroll
                for (int i = 0; i < 16; ++i) y[i] *= sc;
            }
            LAS float* dst = (part == 0 ? qs : (part == 1 ? ks : vs)) + c * 132 + grp * 16;
#pragma unroll
            for (int i = 0; i < 4; ++i) *(LAS f32x4*)(dst + 4 * i) = (f32x4){y[4 * i], y[4 * i + 1], y[4 * i + 2], y[4 * i + 3]};
        }
        if (tid < 64) {
            const int t = t0 + tid;
            const float a_in = AB[(size_t)t * 8 + h], b_in = AB[(size_t)t * 8 + 4 + h];
            sg[tid] = -__expf(P.gdn_a_log[h]) * softplusf_(a_in + P.gdn_dt_bias[h]);
            sbeta[tid] = sigmoidf_(b_in);
        }
    }
#endif
    __syncthreads();
    if (tid < 64) {
        float v = sg[tid];
#pragma unroll
        for (int off = 1; off < 64; off <<= 1) { const float t = __shfl_up(v, off); if (tid >= off) v += t; }
        sgc[tid] = v; seg[tid] = __expf(v);
        const float gl = __shfl(v, 63);
        sek[tid] = __expf(gl - v);
        if (tid == 63) ((float*)(ws + WS_DEC))[item] = __expf(v);
    }
    __syncthreads();
#ifndef SKIP_S3
    {
        const int c = tid >> 3, sgp = tid & 7;
        float akk[8], aqk[8];
#pragma unroll
        for (int i = 0; i < 8; ++i) { akk[i] = 0.f; aqk[i] = 0.f; }
#pragma unroll 2
        for (int d4 = 0; d4 < 32; ++d4) {
            const f32x4 kc = *(const LAS f32x4*)(ks + c * 132 + 4 * d4), qc = *(const LAS f32x4*)(qs + c * 132 + 4 * d4);
#pragma unroll
            for (int i = 0; i < 8; ++i) { const f32x4 kv = *(const LAS f32x4*)(ks + (sgp + 8 * i) * 132 + 4 * d4);
                akk[i] += (kc.x * kv.x + kc.y * kv.y) + (kc.z * kv.z + kc.w * kv.w);
                aqk[i] += (qc.x * kv.x + qc.y * kv.y) + (qc.z * kv.z + qc.w * kv.w); }
        }
        const float gc = sgc[c], bc = sbeta[c];
        bf16* ATT = (bf16*)(ws + WS_ATT) + (size_t)item * 4096;
#pragma unroll
        for (int i = 0; i < 8; ++i) { const int s = sgp + 8 * i;
            const float dec = (c >= s) ? __expf(gc - sgc[s]) : 0.f;
            AmT[s * 68 + c] = (c > s) ? bc * akk[i] * dec : 0.f;
            ATT[c * 64 + ((s & ~31) | permk(s & 31))] = (bf16)f2bf(aqk[i] * dec); }
    }
#endif
#ifndef SKIP_S4
    {
        bf16* QD = (bf16*)(ws + WS_QD) + (size_t)item * 8192;
        bf16* KD = (bf16*)(ws + WS_KD) + (size_t)item * 8192;
#pragma unroll
        for (int r = 0; r < 2; ++r) {
            const int id = tid + 512 * r;
            { const int c = id >> 4, gam = id & 15, s32 = gam >> 2, g = gam & 3;
              const f32x4 lo = *(const LAS f32x4*)(qs + c * 132 + 32 * s32 + 4 * g), hi = *(const LAS f32x4*)(qs + c * 132 + 32 * s32 + 16 + 4 * g);
              const float e = seg[c];
              v4u o; o.x = pk2(lo.x * e, lo.y * e); o.y = pk2(lo.z * e, lo.w * e); o.z = pk2(hi.x * e, hi.y * e); o.w = pk2(hi.z * e, hi.w * e);
              *(v4u*)(QD + c * 128 + 8 * gam) = o; }
            { const int dk = id >> 3, gam = id & 7, s32 = gam >> 2, g = gam & 3, c0 = 32 * s32 + 4 * g;
              float v[8];
#pragma unroll
              for (int j = 0; j < 4; ++j) { v[j] = ks[(c0 + j) * 132 + dk] * sek[c0 + j]; v[4 + j] = ks[(c0 + 16 + j) * 132 + dk] * sek[c0 + 16 + j]; }
              v4u o; o.x = pk2(v[0], v[1]); o.y = pk2(v[2], v[3]); o.z = pk2(v[4], v[5]); o.w = pk2(v[6], v[7]);
              *(v4u*)(KD + dk * 64 + 8 * gam) = o; }
        }
    }
#endif
    __syncthreads();
#ifndef SKIP_S5
    if (tid < 256) {
        const int j = tid;
        const LAS float* src = (j < 128) ? (vs + j) : (ks + (j - 128));
#pragma unroll 1
        for (int rb = 0; rb < 4; ++rb) {
            float acc[16];
#pragma unroll
            for (int i = 0; i < 16; ++i) { const int c = 16 * rb + i; float a = src[c * 132] * sbeta[c]; if (j >= 128) a *= seg[c]; acc[i] = a; }
#pragma unroll 2
            for (int s = 0; s < 16 * rb; ++s) {
                const float sv = solw[s * 256 + j];
                const LAS float* ar = AmT + s * 68 + 16 * rb;
#pragma unroll
                for (int q = 0; q < 4; ++q) { const f32x4 A4 = *(const LAS f32x4*)(ar + 4 * q);
                    acc[4 * q] -= A4.x * sv; acc[4 * q + 1] -= A4.y * sv; acc[4 * q + 2] -= A4.z * sv; acc[4 * q + 3] -= A4.w * sv; }
            }
#pragma unroll
            for (int i = 0; i < 16; ++i) {
                const int s = 16 * rb + i; const float sv = acc[i];
                solw[s * 256 + j] = sv;
                const LAS float* ar = AmT + s * 68 + 16 * rb;
#pragma unroll
                for (int q = (i + 1) / 4; q < 4; ++q) { const f32x4 A4 = *(const LAS f32x4*)(ar + 4 * q);
                    if (4 * q > i) acc[4 * q] -= A4.x * sv; if (4 * q + 1 > i) acc[4 * q + 1] -= A4.y * sv; if (4 * q + 2 > i) acc[4 * q + 2] -= A4.z * sv; if (4 * q + 3 > i) acc[4 * q + 3] -= A4.w * sv; }
            }
        }
        LDS_WAIT(); asm volatile("" ::: "memory");
        if (j < 128) {
            bf16* UF = (bf16*)(ws + WS_UF) + (size_t)item * 8192 + (size_t)(j >> 4) * 1024;
#pragma unroll
            for (int g = 0; g < 4; ++g) {
                float v[16];
#pragma unroll
                for (int rho = 0; rho < 4; ++rho)
#pragma unroll
                    for (int i = 0; i < 4; ++i) v[rho * 4 + i] = solw[(16 * rho + 4 * g + i) * 256 + j];
                v4u o0, o1;
                o0.x = pk2(v[0], v[1]); o0.y = pk2(v[2], v[3]); o0.z = pk2(v[4], v[5]); o0.w = pk2(v[6], v[7]);
                o1.x = pk2(v[8], v[9]); o1.y = pk2(v[10], v[11]); o1.z = pk2(v[12], v[13]); o1.w = pk2(v[14], v[15]);
                v4u* d = (v4u*)(UF + (g * 16 + (j & 15)) * 16);
                d[0] = o0; d[1] = o1;
            }
        } else {
            const int dk = j - 128, pos = (dk & ~31) | permk(dk & 31);
            bf16* WN = (bf16*)(ws + WS_WN) + (size_t)item * 8192 + pos;
#pragma unroll 8
            for (int c = 0; c < 64; ++c) WN[c * 128] = (bf16)f2bf(-solw[c * 256 + j]);
        }
    }
#endif
    __syncthreads();
}

__device__ __forceinline__ void lru_local_item(const Params& P, LAS unsigned char* lds, int lt, int tid, int lane, int wave) {
    unsigned char* ws = P.ws;
    const int b = lt >> 7, n = lt & 127, t0 = b * SEQ + n * 64;
    LAS float* xc = (LAS float*)lds;
    const bf16* XR = (const bf16*)(ws + WS_XR);
    {
        const int ch = tid;
        const float w0 = P.lru_conv_w[ch], w1 = P.lru_conv_w[512 + ch], w2 = P.lru_conv_w[1024 + ch], w3 = P.lru_conv_w[1536 + ch], cb = P.lru_conv_b[ch];
        float x0 = 0.f, x1 = 0.f, x2 = 0.f;
        if (n > 0) { x0 = bf1(XR[(size_t)(t0 - 3) * 512 + ch]); x1 = bf1(XR[(size_t)(t0 - 2) * 512 + ch]); x2 = bf1(XR[(size_t)(t0 - 1) * 512 + ch]); }
#pragma unroll 8
        for (int c = 0; c < 64; ++c) { const float x3 = bf1(XR[(size_t)(t0 + c) * 512 + ch]);
            xc[c * 516 + ch] = (w0 * x0 + w1 * x1) + (w2 * x2 + w3 * x3) + cb; x0 = x1; x1 = x2; x2 = x3; }
    }
    __syncthreads();
    {
        const int g = wave, ch = g * 64 + lane;
        float wa[64], wx[64];
        const float* wap = P.lru_wa + (size_t)g * 4096 + lane; const float* wxp = P.lru_wx + (size_t)g * 4096 + lane;
        asm volatile("" : "+v"(wap), "+v"(wxp));
#pragma unroll
        for (int i = 0; i < 64; ++i) { wa[i] = wap[i * 64]; wx[i] = wxp[i * 64]; }
        const float ba = P.lru_ba[ch], bx = P.lru_bx[ch], sp = softplusf_(-P.lru_lambda[ch]);
        bf16* HLOC = (bf16*)(ws + WS_HLOC); bf16* PCUM = (bf16*)(ws + WS_PCUM);
        float hst = 0.f, pc = 1.f;
#pragma unroll 1
        for (int c = 0; c < 64; ++c) {
            float ra = ba, ri = bx;
            const LAS float* xrow = xc + c * 516 + g * 64;
#pragma unroll
            for (int i4 = 0; i4 < 16; ++i4) { const f32x4 x4 = *(const LAS f32x4*)(xrow + 4 * i4);
                ra += x4.x * wa[4 * i4]; ra += x4.y * wa[4 * i4 + 1]; ra += x4.z * wa[4 * i4 + 2]; ra += x4.w * wa[4 * i4 + 3];
                ri += x4.x * wx[4 * i4]; ri += x4.y * wx[4 * i4 + 1]; ri += x4.z * wx[4 * i4 + 2]; ri += x4.w * wx[4 * i4 + 3];
                if ((i4 & 3) == 3) asm volatile("" ::: "memory"); }
            const float r = sigmoidf_(ra), ig = sigmoidf_(ri);
            const float log_a = -8.0f * r * sp;
            const float a = __expf(log_a);
            const float xo = xrow[lane];
            const float bt = sqrtf(fmaxf(-expm1f(2.0f * log_a), 0.f)) * (ig * xo);
            hst = a * hst + bt; pc *= a;
            HLOC[(size_t)(t0 + c) * 512 + ch] = (bf16)f2bf(hst); PCUM[(size_t)(t0 + c) * 512 + ch] = (bf16)f2bf(pc);
        }
        ((float*)(ws + WS_HEND))[(size_t)lt * 512 + ch] = hst; ((float*)(ws + WS_PEND))[(size_t)lt * 512 + ch] = pc;
    }
    __syncthreads();
}

constexpr int SC_WN = 0, SC_QD = 64 * 272, SC_KD = 2 * 64 * 272, SC_ATT = 2 * 64 * 272 + 128 * 144, SC_BUF = 2 * 64 * 272 + 128 * 144 + 64 * 144;
constexpr int SC_SSQ = 2 * SC_BUF;
__device__ __forceinline__ int sc_lds_off(int id) {
    if (id < 1024) return SC_WN + (id >> 4) * 272 + (id & 15) * 16;
    if (id < 2048) { const int q = id - 1024; return SC_QD + (q >> 4) * 272 + (q & 15) * 16; }
    if (id < 3072) { const int q = id - 2048; return SC_KD + (q >> 3) * 144 + (q & 7) * 16; }
    const int q = id - 3072; return SC_ATT + (q >> 3) * 144 + (q & 7) * 16;
}
__device__ __forceinline__ const v4u* sc_src(const unsigned char* ws, int item, int id) {
    if (id < 1024) return (const v4u*)(ws + WS_WN + (size_t)item * 16384) + id;
    if (id < 2048) return (const v4u*)(ws + WS_QD + (size_t)item * 16384) + (id - 1024);
    if (id < 3072) return (const v4u*)(ws + WS_KD + (size_t)item * 16384) + (id - 2048);
    return (const v4u*)(ws + WS_ATT + (size_t)item * 8192) + (id - 3072);
}
__device__ __forceinline__ bf16x8 pack_b(const f32x4 a, const f32x4 b) {
    v4u r; r.x = pk2(a.x, a.y); r.y = pk2(a.z, a.w); r.z = pk2(b.x, b.y); r.w = pk2(b.z, b.w);
    return __builtin_bit_cast(bf16x8, r);
}
#define SC_BAR() do { asm volatile("s_waitcnt lgkmcnt(0)" ::: "memory"); __builtin_amdgcn_s_barrier(); asm volatile("" ::: "memory"); } while (0)
#define SC_GLD(dst, ptr) asm volatile("global_load_dwordx4 %0, %1, off" : "=v"(dst) : "v"(ptr) : "memory")
#define PIN8(a) asm volatile("" : "+v"(a[0]), "+v"(a[1]), "+v"(a[2]), "+v"(a[3]), "+v"(a[4]), "+v"(a[5]), "+v"(a[6]), "+v"(a[7]))
#define PIN16(a) asm volatile("" : "+v"(a[0]), "+v"(a[1]), "+v"(a[2]), "+v"(a[3]), "+v"(a[4]), "+v"(a[5]), "+v"(a[6]), "+v"(a[7]), "+v"(a[8]), "+v"(a[9]), "+v"(a[10]), "+v"(a[11]), "+v"(a[12]), "+v"(a[13]), "+v"(a[14]), "+v"(a[15]))
constexpr int SCAN_NWC = 2, SCAN_PARTS = 4, SCAN_WGS = 8 * SCAN_PARTS;
constexpr int SC_UFS = 2 * SC_BUF;
constexpr int SC_DECS = SC_UFS + 2 * SCAN_NWC * 2048;
constexpr int SC_OT = SC_DECS + 512;
constexpr int SC_END = SC_OT + 2 * 64 * 36 * 4;
static_assert(SC_END <= MISC_OFF, "scan LDS");
#ifndef SCAN_REPS
#define SCAN_REPS 1
#endif
#ifndef SCAN_EXP
#define SCAN_EXP 0
#endif
__device__ __forceinline__ int sc3_lds_off(int id) {
    if (id < 3584) return sc_lds_off(id);
    return SC_UFS + (id - 3584) * 16;
}
__device__ __forceinline__ const v4u* sc3_src(const unsigned char* ws, int item, int id, int part) {
    if (id < 3584) return sc_src(ws, item, id);
    return (const v4u*)(ws + WS_UF + (size_t)item * 16384 + (size_t)(part * SCAN_NWC) * 2048) + (id - 3584);
}
__device__ __forceinline__ void gdn_scan(const Params& P, LAS unsigned char* lds, int sb, int tid, int lane, int wave) {
    const unsigned char* ws = P.ws;
    constexpr int NCH = 128 * SCAN_REPS, NPC = 15;
    const int bh = sb & 7, part = sb >> 3;
    const int b = bh >> 2, h = bh & 3, col = lane & 15, g = lane >> 4;
    const int item0 = bh * 128;
    const float* DEC = (const float*)(ws + WS_DEC);
    if (wave >= 4) {
        constexpr int NP = 15, DEP = 3;
        const int lt = tid - 256;
        const unsigned voff = (unsigned)lt * 16u;
        const int lA = (lt >> 4) * 272 + (lt & 15) * 16, lB = (lt >> 3) * 144 + (lt & 7) * 16, lU = SC_UFS + lt * 16;
        v4u rs[DEP][NP];
#define SC_ISSUE(set, itm) do { const unsigned char* gq_ = ws + (size_t)(itm) * 16384; const unsigned char* ga_ = ws + WS_ATT + (size_t)(itm) * 8192; \
            asm volatile("s_nop 4\n\tglobal_load_dwordx4 %0, %8, %9\n\tglobal_load_dwordx4 %1, %8, %10\n\tglobal_load_dwordx4 %2, %8, %11\n\tglobal_load_dwordx4 %3, %8, %12\n\t" \
                         "global_load_dwordx4 %4, %8, %13\n\tglobal_load_dwordx4 %5, %8, %14\n\tglobal_load_dwordx4 %6, %8, %15\n\tglobal_load_dwordx4 %7, %8, %16" \
                : "=&v"(rs[set][0]), "=&v"(rs[set][1]), "=&v"(rs[set][2]), "=&v"(rs[set][3]), "=&v"(rs[set][4]), "=&v"(rs[set][5]), "=&v"(rs[set][6]), "=&v"(rs[set][7]) \
                : "v"(voff), "s"(gq_ + WS_WN), "s"(gq_ + WS_WN + 4096), "s"(gq_ + WS_WN + 8192), "s"(gq_ + WS_WN + 12288), \
                  "s"(gq_ + WS_QD), "s"(gq_ + WS_QD + 4096), "s"(gq_ + WS_QD + 8192), "s"(gq_ + WS_QD + 12288) : "memory"); \
            asm volatile("s_nop 4\n\tglobal_load_dwordx4 %0, %7, %8\n\tglobal_load_dwordx4 %1, %7, %9\n\tglobal_load_dwordx4 %2, %7, %10\n\tglobal_load_dwordx4 %3, %7, %11\n\t" \
                         "global_load_dwordx4 %4, %7, %12\n\tglobal_load_dwordx4 %5, %7, %13\n\tglobal_load_dwordx4 %6, %7, %14" \
                : "=&v"(rs[set][8]), "=&v"(rs[set][9]), "=&v"(rs[set][10]), "=&v"(rs[set][11]), "=&v"(rs[set][12]), "=&v"(rs[set][13]), "=&v"(rs[set][14]) \
                : "v"(voff), "s"(gq_ + WS_KD), "s"(gq_ + WS_KD + 4096), "s"(gq_ + WS_KD + 8192), "s"(gq_ + WS_KD + 12288), \
                  "s"(ga_), "s"(ga_ + 4096), "s"(gq_ + WS_UF + (size_t)(part * SCAN_NWC) * 2048) : "memory"); } while (0)
#define SC_WAITSET(set, cnt) asm volatile("s_waitcnt " cnt : "+v"(rs[set][0]), "+v"(rs[set][1]), "+v"(rs[set][2]), "+v"(rs[set][3]), "+v"(rs[set][4]), "+v"(rs[set][5]), "+v"(rs[set][6]), "+v"(rs[set][7]), \
            "+v"(rs[set][8]), "+v"(rs[set][9]), "+v"(rs[set][10]), "+v"(rs[set][11]), "+v"(rs[set][12]), "+v"(rs[set][13]), "+v"(rs[set][14]) :: "memory")
#define SC_WRITE(set, par) do { LAS unsigned char* wb_ = lds + (par) * SC_BUF; \
            _Pragma("unroll") for (int r = 0; r < 4; ++r) { *(LAS v4u*)(wb_ + SC_WN + lA + r * (16 * 272)) = rs[set][r]; *(LAS v4u*)(wb_ + SC_QD + lA + r * (16 * 272)) = rs[set][4 + r]; \
                                                          *(LAS v4u*)(wb_ + SC_KD + lB + r * (32 * 144)) = rs[set][8 + r]; } \
            *(LAS v4u*)(wb_ + SC_ATT + lB) = rs[set][12]; *(LAS v4u*)(wb_ + SC_ATT + lB + 32 * 144) = rs[set][13]; \
            *(LAS v4u*)(lds + lU + (par) * (SCAN_NWC * 2048)) = rs[set][14]; } while (0)
        {
#pragma unroll
            for (int r = 0; r < NP; ++r) { const int id = lt + 256 * r; *(LAS v4u*)(lds + sc3_lds_off(id)) = *sc3_src(ws, item0, id, part); }
            if (lt < 128) ((LAS float*)(lds + SC_DECS))[lt] = DEC[item0 + lt];
            asm volatile("s_waitcnt vmcnt(0)" ::: "memory");
        }
        SC_ISSUE(1, item0 + 1); SC_ISSUE(2, item0 + 2); SC_ISSUE(0, item0 + 3);
        SC_BAR();
        int n2 = 0;
#define SC_INTERVAL(set) do { SC_WAITSET(set, "vmcnt(30)"); SC_WRITE(set, (n2 + 1) & 1); SC_WAITSET(set, "lgkmcnt(0)"); SC_ISSUE(set, item0 + ((n2 + 1 + DEP) & 127)); SC_BAR(); ++n2; } while (0)
#pragma unroll 1
        for (int it = 0; it < NCH / 3; ++it) { SC_INTERVAL(1); SC_INTERVAL(2); SC_INTERVAL(0); }
        if (NCH % 3 >= 1) SC_INTERVAL(1);
        if (NCH % 3 >= 2) SC_INTERVAL(2);
        SC_WAITSET(0, "vmcnt(0)"); SC_WAITSET(1, "vmcnt(0)"); SC_WAITSET(2, "vmcnt(0)");
#undef SC_INTERVAL
#undef SC_WRITE
#undef SC_WAITSET
#undef SC_ISSUE
        return;
    }
    if (wave == 3) {
        SC_BAR();
#pragma unroll 1
        for (int n2 = 0; n2 < NCH; ++n2) SC_BAR();
        return;
    }
    if (wave == 2) {
        const int row = lane;
        bf16* Y = (bf16*)(P.ws + WS_Y);
        float* SSQG = P.out;
        SC_BAR();
#pragma unroll 1
        for (int n2 = 0; n2 <= NCH; ++n2) {
            if (n2 > 0) {
                const int n = (n2 - 1) & 127, t = b * SEQ + n * 64 + row;
                const LAS float* src = (const LAS float*)(lds + SC_OT + ((n2 - 1) & 1) * (64 * 36 * 4)) + row * 36;
                f32x4 a[8]; float s2 = 0.f;
#pragma unroll
                for (int q = 0; q < 8; ++q) { a[q] = *(const LAS f32x4*)(src + 4 * q); s2 += (a[q].x * a[q].x + a[q].y * a[q].y) + (a[q].z * a[q].z + a[q].w * a[q].w); }
                SSQG[(size_t)t * 32 + h * 8 + part] = s2;
                v4u* d = (v4u*)(Y + (size_t)t * 1024 + h * 128 + 32 * part);
#pragma unroll
                for (int q = 0; q < 4; ++q) { v4u o; o.x = pk2(a[2 * q].x, a[2 * q].y); o.y = pk2(a[2 * q].z, a[2 * q].w); o.z = pk2(a[2 * q + 1].x, a[2 * q + 1].y); o.w = pk2(a[2 * q + 1].z, a[2 * q + 1].w); d[q] = o; }
            }
            if (n2 < NCH) SC_BAR();
        }
        return;
    }
    f32x4 S[8];
#pragma unroll
    for (int i = 0; i < 8; ++i) S[i] = (f32x4){0.f, 0.f, 0.f, 0.f};
    SC_BAR();
#pragma unroll 1
    for (int n2 = 0; n2 < NCH; ++n2) {
        if (SCAN_REPS > 1 && (n2 & 127) == 0) {
#pragma unroll
            for (int i = 0; i < 8; ++i) S[i] = (f32x4){0.f, 0.f, 0.f, 0.f};
        }
        if (SCAN_EXP == 2 && n2 < 128) { SC_BAR(); continue; }
        const int par = n2 & 1;
        LAS unsigned char* buf = lds + par * SC_BUF;
        bf16x8 fA[16], fB[16], fC[16], fD[8];
#pragma unroll
        for (int rho = 0; rho < 4; ++rho)
#pragma unroll
            for (int s = 0; s < 4; ++s) fA[rho * 4 + s] = *(const LAS bf16x8*)(buf + SC_WN + (16 * rho + col) * 272 + (32 * s + 8 * g) * 2);
#pragma unroll
        for (int rho = 0; rho < 4; ++rho)
#pragma unroll
            for (int s = 0; s < 4; ++s) fB[rho * 4 + s] = *(const LAS bf16x8*)(buf + SC_QD + (16 * rho + col) * 272 + (32 * s + 8 * g) * 2);
        const LAS v4u* ufp = (const LAS v4u*)(lds + SC_UFS + par * (SCAN_NWC * 2048) + wave * 2048 + lane * 32);
        const v4u uf0 = ufp[0], uf1 = ufp[1];
        const float dec = ((const LAS float*)(lds + SC_DECS))[n2 & 127];
        bf16x8 Bs[4];
#pragma unroll
        for (int s = 0; s < 4; ++s) Bs[s] = pack_b(S[2 * s], S[2 * s + 1]);
        f32x4 Vn[4], Oc[4];
        Vn[0] = (f32x4){bflo(uf0.x), bfhi(uf0.x), bflo(uf0.y), bfhi(uf0.y)}; Vn[1] = (f32x4){bflo(uf0.z), bfhi(uf0.z), bflo(uf0.w), bfhi(uf0.w)};
        Vn[2] = (f32x4){bflo(uf1.x), bfhi(uf1.x), bflo(uf1.y), bfhi(uf1.y)}; Vn[3] = (f32x4){bflo(uf1.z), bfhi(uf1.z), bflo(uf1.w), bfhi(uf1.w)};
        __builtin_amdgcn_sched_barrier(0);
        PIN16(fA);
#pragma unroll
        for (int s = 0; s < 4; ++s)
#pragma unroll
            for (int rho = 0; rho < 4; ++rho) Vn[rho] = __builtin_amdgcn_mfma_f32_16x16x32_bf16(fA[rho * 4 + s], Bs[s], Vn[rho], 0, 0, 0);
        __builtin_amdgcn_sched_barrier(0);
#pragma unroll
        for (int tau = 0; tau < 8; ++tau)
#pragma unroll
            for (int s = 0; s < 2; ++s) fC[tau * 2 + s] = *(const LAS bf16x8*)(buf + SC_KD + (16 * tau + col) * 144 + (32 * s + 8 * g) * 2);
        __builtin_amdgcn_sched_barrier(0);
        PIN16(fB);
#pragma unroll
        for (int rho = 0; rho < 4; ++rho) Oc[rho] = (f32x4){0.f, 0.f, 0.f, 0.f};
#pragma unroll
        for (int s = 0; s < 4; ++s)
#pragma unroll
            for (int rho = 0; rho < 4; ++rho) Oc[rho] = __builtin_amdgcn_mfma_f32_16x16x32_bf16(fB[rho * 4 + s], Bs[s], Oc[rho], 0, 0, 0);
        __builtin_amdgcn_sched_barrier(0);
#pragma unroll
        for (int rho = 0; rho < 4; ++rho)
#pragma unroll
            for (int s = 0; s < 2; ++s) fD[rho * 2 + s] = *(const LAS bf16x8*)(buf + SC_ATT + (16 * rho + col) * 144 + (32 * s + 8 * g) * 2);
        bf16x8 Bv[2];
        Bv[0] = pack_b(Vn[0], Vn[1]); Bv[1] = pack_b(Vn[2], Vn[3]);
#pragma unroll
        for (int tau = 0; tau < 8; ++tau) S[tau] = S[tau] * dec;
        __builtin_amdgcn_sched_barrier(0);
        PIN16(fC);
#pragma unroll
        for (int s = 0; s < 2; ++s)
#pragma unroll
            for (int tau = 0; tau < 8; ++tau) S[tau] = __builtin_amdgcn_mfma_f32_16x16x32_bf16(fC[tau * 2 + s], Bv[s], S[tau], 0, 0, 0);
        __builtin_amdgcn_sched_barrier(0);
        PIN8(fD);
#pragma unroll
        for (int s = 0; s < 2; ++s)
#pragma unroll
            for (int rho = 0; rho < 4; ++rho) Oc[rho] = __builtin_amdgcn_mfma_f32_16x16x32_bf16(fD[rho * 2 + s], Bv[s], Oc[rho], 0, 0, 0);
        LAS float* ot = (LAS float*)(lds + SC_OT + par * (64 * 36 * 4)) + 16 * wave + col;
#pragma unroll
        for (int rho = 0; rho < 4; ++rho)
#pragma unroll
            for (int i = 0; i < 4; ++i) ot[(16 * rho + 4 * g + i) * 36] = Oc[rho][i];
        SC_BAR();
    }
}

__device__ __forceinline__ void lru_carry(const Params& P, int gwv, int lane) {
    unsigned char* ws = P.ws;
    const int b = gwv >> 3, g = gwv & 7, ch = g * 64 + lane;
    const float* HEND = (const float*)(ws + WS_HEND); const float* PEND = (const float*)(ws + WS_PEND); float* HIN = (float*)(ws + WS_HIN);
    float hin = 0.f;
#pragma unroll 1
    for (int n0 = 0; n0 < 128; n0 += 16) {
        float he[16], pe[16];
#pragma unroll
        for (int i = 0; i < 16; ++i) { const size_t o = (size_t)(b * 128 + n0 + i) * 512 + ch; he[i] = HEND[o]; pe[i] = PEND[o]; }
#pragma unroll
        for (int i = 0; i < 16; ++i) { HIN[(size_t)(b * 128 + n0 + i) * 512 + ch] = hin; hin = he[i] + pe[i] * hin; }
    }
}

__device__ __forceinline__ void cvt_table(const float* src, bf16* dst, size_t n8, size_t wi, size_t nw) {
    for (size_t i = wi; i < n8; i += nw) {
        const f32x4 a = ((const f32x4*)src)[2 * i], c = ((const f32x4*)src)[2 * i + 1];
        v4u o; o.x = pk2(a.x, a.y); o.y = pk2(a.z, a.w); o.z = pk2(c.x, c.y); o.w = pk2(c.z, c.w);
        ((v4u*)dst)[i] = o;
    }
}

__device__ __forceinline__ void lru_combine(const Params& P, size_t wi, size_t nw) {
    unsigned char* ws = P.ws;
    const v4u* HLOC = (const v4u*)(ws + WS_HLOC); const v4u* PCUM = (const v4u*)(ws + WS_PCUM); const v4u* GATE = (const v4u*)(ws + WS_GATE);
    const float* HIN = (const float*)(ws + WS_HIN); bf16* Y = (bf16*)(ws + WS_Y);
    for (size_t i = wi; i < (size_t)T * 64; i += nw) {
        const size_t t = i >> 6; const int ch0 = (int)(i & 63) * 8;
        const v4u hl = HLOC[i], pc = PCUM[i], gt = GATE[i];
        const f32x4 h0 = *(const f32x4*)(HIN + (t >> 6) * 512 + ch0), h1 = *(const f32x4*)(HIN + (t >> 6) * 512 + ch0 + 4);
        float y[8];
        y[0] = (bflo(hl.x) + bflo(pc.x) * h0.x) * gelu_tanh(bflo(gt.x)); y[1] = (bfhi(hl.x) + bfhi(pc.x) * h0.y) * gelu_tanh(bfhi(gt.x));
        y[2] = (bflo(hl.y) + bflo(pc.y) * h0.z) * gelu_tanh(bflo(gt.y)); y[3] = (bfhi(hl.y) + bfhi(pc.y) * h0.w) * gelu_tanh(bfhi(gt.y));
        y[4] = (bflo(hl.z) + bflo(pc.z) * h1.x) * gelu_tanh(bflo(gt.z)); y[5] = (bfhi(hl.z) + bfhi(pc.z) * h1.y) * gelu_tanh(bfhi(gt.z));
        y[6] = (bflo(hl.w) + bflo(pc.w) * h1.z) * gelu_tanh(bflo(gt.w)); y[7] = (bfhi(hl.w) + bfhi(pc.w) * h1.w) * gelu_tanh(bfhi(gt.w));
        v4u o; o.x = pk2(y[0], y[1]); o.y = pk2(y[2], y[3]); o.z = pk2(y[4], y[5]); o.w = pk2(y[6], y[7]);
        *(v4u*)(Y + t * 1024 + 512 + ch0) = o;
    }
}

__device__ __forceinline__ void gdn_gate_norm(const Params& P, size_t wi, size_t nw) {
    unsigned char* ws = P.ws;
    bf16* Y = (bf16*)(ws + WS_Y); const v4u* Z = (const v4u*)(ws + WS_Z); const float* SSQG = P.out;
    for (size_t i = wi; i < (size_t)T * 64; i += nw) {
        const size_t t = i >> 6; const int c0 = (int)(i & 63) * 8, h = c0 >> 7;
        const f32x4 q0 = *(const f32x4*)(SSQG + t * 32 + h * 8);
        const float rstd = rsqrtf(((q0.x + q0.y) + (q0.z + q0.w)) * (1.0f / 128.0f) + 1e-6f);
        const v4u o = *(const v4u*)(Y + t * 1024 + c0), z = Z[i];
        const f32x4 w0 = *(const f32x4*)(P.gdn_norm_w + (c0 & 127)), w1 = *(const f32x4*)(P.gdn_norm_w + (c0 & 127) + 4);
        float y[8];
        y[0] = bflo(o.x) * rstd * w0.x * siluf_(bflo(z.x)); y[1] = bfhi(o.x) * rstd * w0.y * siluf_(bfhi(z.x));
        y[2] = bflo(o.y) * rstd * w0.z * siluf_(bflo(z.y)); y[3] = bfhi(o.y) * rstd * w0.w * siluf_(bfhi(z.y));
        y[4] = bflo(o.z) * rstd * w1.x * siluf_(bflo(z.z)); y[5] = bfhi(o.z) * rstd * w1.y * siluf_(bfhi(z.z));
        y[6] = bflo(o.w) * rstd * w1.z * siluf_(bflo(z.w)); y[7] = bfhi(o.w) * rstd * w1.w * siluf_(bfhi(z.w));
        v4u r; r.x = pk2(y[0], y[1]); r.y = pk2(y[2], y[3]); r.z = pk2(y[4], y[5]); r.w = pk2(y[6], y[7]);
        *(v4u*)(Y + t * 1024 + c0) = r;
    }
}

__device__ __forceinline__ void xattn_stage(LAS unsigned char* lds, const bf16* src, int tid) {
    v4u tmp[16];
#pragma unroll
    for (int r = 0; r < 16; ++r) tmp[r] = *(const v4u*)(src + (size_t)(tid + 512 * r) * 8);
#pragma unroll
    for (int r = 0; r < 16; ++r) { const int id = tid + 512 * r; *(LAS v4u*)(lds + (id >> 5) * 528 + (id & 31) * 16) = tmp[r]; }
}
__device__ __forceinline__ void xattn_unit(const Params& P, LAS unsigned char* lds, int unit, int tid, int lane, int wave) {
    const unsigned char* ws = P.ws;
    const int h = unit & 3, qb = (unit >> 2) & 63, b = unit >> 8, col = lane & 15, g = lane >> 4;
    const int tw = b * SEQ + qb * 128 + 16 * wave;
    const bf16* Kb = (const bf16*)(ws + WS_KB) + (size_t)((b * 4 + h) * 256) * 256;
    const bf16* Vt = (const bf16*)(ws + WS_VTP) + (size_t)((b * 4 + h) * 256) * 256;
    xattn_stage(lds, Kb, tid);
    __syncthreads();
    const LAS unsigned char* arow = lds + col * 528 + g * 16;
    bf16x8 Bp[1][8]; float inv[1];
#pragma unroll
    for (int ps = 0; ps < 1; ++ps) {
        const bf16* Q = (const bf16*)(ws + WS_Q) + (size_t)(tw + 16 * ps + col) * 1024 + h * 256 + 8 * g;
        bf16x8 Bq[8];
#pragma unroll
        for (int s = 0; s < 8; ++s) Bq[s] = *(const bf16x8*)(Q + 32 * s);
        f32x4 St[16];
        bf16x8 fr[2][8];
#pragma unroll
        for (int s = 0; s < 8; ++s) fr[0][s] = *(const LAS bf16x8*)(arow + 64 * s);
#pragma unroll
        for (int kap = 0; kap < 16; ++kap) {
            if (kap + 1 < 16) {
#pragma unroll
                for (int s = 0; s < 8; ++s) fr[(kap + 1) & 1][s] = *(const LAS bf16x8*)(arow + (16 * (kap + 1)) * 528 + 64 * s);
            }
            __builtin_amdgcn_sched_barrier(0);
            PIN8(fr[kap & 1]);
            f32x4 acc = (f32x4){0.f, 0.f, 0.f, 0.f};
#pragma unroll
            for (int s = 0; s < 8; ++s) acc = __builtin_amdgcn_mfma_f32_16x16x32_bf16(fr[kap & 1][s], Bq[s], acc, 0, 0, 0);
            St[kap] = acc;
            __builtin_amdgcn_sched_barrier(0);
        }
        float mx = -3.0e38f;
#pragma unroll
        for (int kap = 0; kap < 16; ++kap) mx = fmaxf(fmaxf(fmaxf(St[kap].x, St[kap].y), fmaxf(St[kap].z, St[kap].w)), mx);
        mx = fmaxf(mx, __shfl_xor(mx, 16)); mx = fmaxf(mx, __shfl_xor(mx, 32));
        float l = 0.f;
#pragma unroll
        for (int kap = 0; kap < 16; ++kap) { St[kap].x = __expf(St[kap].x - mx); St[kap].y = __expf(St[kap].y - mx); St[kap].z = __expf(St[kap].z - mx); St[kap].w = __expf(St[kap].w - mx);
            l += (St[kap].x + St[kap].y) + (St[kap].z + St[kap].w); }
        l += __shfl_xor(l, 16); l += __shfl_xor(l, 32);
        inv[ps] = 1.0f / l;
#pragma unroll
        for (int s = 0; s < 8; ++s) Bp[ps][s] = pack_b(St[2 * s], St[2 * s + 1]);
    }
    __syncthreads();
    xattn_stage(lds, Vt, tid);
    __syncthreads();
#pragma unroll
    for (int ps = 0; ps < 1; ++ps) {
        bf16* AO = (bf16*)(P.ws + WS_AO) + (size_t)(tw + 16 * ps + col) * 1024 + h * 256 + 4 * g;
        bf16x8 fr[2][8];
#pragma unroll
        for (int s = 0; s < 8; ++s) fr[0][s] = *(const LAS bf16x8*)(arow + 64 * s);
#pragma unroll
        for (int del = 0; del < 16; ++del) {
            if (del + 1 < 16) {
#pragma unroll
                for (int s = 0; s < 8; ++s) fr[(del + 1) & 1][s] = *(const LAS bf16x8*)(arow + (16 * (del + 1)) * 528 + 64 * s);
            }
            __builtin_amdgcn_sched_barrier(0);
            PIN8(fr[del & 1]);
            f32x4 acc = (f32x4){0.f, 0.f, 0.f, 0.f};
#pragma unroll
            for (int s = 0; s < 8; ++s) acc = __builtin_amdgcn_mfma_f32_16x16x32_bf16(fr[del & 1][s], Bp[ps][s], acc, 0, 0, 0);
            v2u o; o.x = pk2(acc.x * inv[ps], acc.y * inv[ps]); o.y = pk2(acc.z * inv[ps], acc.w * inv[ps]);
            *(v2u*)(AO + 16 * del) = o;
            __builtin_amdgcn_sched_barrier(0);
        }
    }
    __syncthreads();
}

__device__ __forceinline__ unsigned key_enc(float f) { const unsigned u = __builtin_bit_cast(unsigned, f); return (u & 0x80000000u) ? ~u : (u | 0x80000000u); }
__device__ __forceinline__ float key_dec(unsigned k) { const unsigned u = (k & 0x80000000u) ? (k & 0x7fffffffu) : ~k; return __builtin_bit_cast(float, u); }
#define INS16(L, kv) do { unsigned carry_ = (kv); _Pragma("unroll") for (int q_ = 0; q_ < 16; ++q_) { const unsigned hi_ = max(L[q_], carry_); carry_ = min(L[q_], carry_); L[q_] = hi_; } } while (0)
__device__ __forceinline__ void peer_topk_item(const Params& P, LAS unsigned char* lds, int item, int tid, int lane, int wave) {
    const unsigned char* ws = P.ws;
    const int h = item & 7, tile = item >> 3, tt0 = tile * 256;
    LAS float* S = (LAS float*)lds;
    LAS int* tab = (LAS int*)(lds + 140 * 1024);
    if (tid == 0) { int id = 0; for (int a = 0; a < 16; ++a) for (int bq = 0; bq < 16 / (a + 1); ++bq) tab[id++] = a * 16 + bq; }
    const bf16* PQ = (const bf16*)(ws + WS_PQ); const bf16* SUBK = (const bf16*)(ws + WS_SUBK);
    const int col = lane & 15, g = lane >> 4;
    unsigned L1[16], L2[16];
#pragma unroll
    for (int q = 0; q < 16; ++q) { L1[q] = 0u; L2[q] = 0u; }
#pragma unroll
    for (int p = 0; p < 2; ++p) {
        {
            bf16x8 Af[2][4];
#pragma unroll
            for (int rho = 0; rho < 2; ++rho)
#pragma unroll
                for (int s = 0; s < 4; ++s) Af[rho][s] = *(const bf16x8*)(PQ + (size_t)(tt0 + 32 * wave + 16 * rho + col) * 2048 + h * 256 + p * 128 + 32 * s + 8 * g);
#pragma unroll
            for (int kap = 0; kap < 8; ++kap) {
                f32x4 a0 = (f32x4){0.f, 0.f, 0.f, 0.f}, a1 = a0;
#pragma unroll
                for (int s = 0; s < 4; ++s) { const bf16x8 bk = *(const bf16x8*)(SUBK + (size_t)((h * 2 + p) * 128 + 16 * kap + col) * 128 + 32 * s + 8 * g);
                    a0 = __builtin_amdgcn_mfma_f32_16x16x32_bf16(Af[0][s], bk, a0, 0, 0, 0); a1 = __builtin_amdgcn_mfma_f32_16x16x32_bf16(Af[1][s], bk, a1, 0, 0, 0); }
#pragma unroll
                for (int i = 0; i < 4; ++i) { S[(32 * wave + 4 * g + i) * 132 + 16 * kap + col] = a0[i]; S[(32 * wave + 16 + 4 * g + i) * 132 + 16 * kap + col] = a1[i]; }
            }
        }
        __syncthreads();
        if (tid < 256) {
            const LAS float* row = S + tid * 132;
#pragma unroll 2
            for (int k4 = 0; k4 < 32; ++k4) { const f32x4 v = *(const LAS f32x4*)(row + 4 * k4);
#pragma unroll
                for (int e = 0; e < 4; ++e) { const unsigned kv = (key_enc(v[e]) & ~127u) | (unsigned)(127 - (4 * k4 + e));
                    if (p == 0) INS16(L1, kv); else INS16(L2, kv); } }
        }
        __syncthreads();
    }
    if (tid < 256) {
        float v1[16], v2[16];
        LAS int* il = (LAS int*)lds + tid * 33;
#pragma unroll
        for (int q = 0; q < 16; ++q) { v1[q] = key_dec((L1[q] & ~127u) | 64u); v2[q] = key_dec((L2[q] & ~127u) | 64u); il[q] = 127 - (int)(L1[q] & 127u); il[16 + q] = 127 - (int)(L2[q] & 127u); }
        unsigned C[16];
#pragma unroll
        for (int q = 0; q < 16; ++q) C[q] = 0u;
        {
            int id = 0;
#pragma unroll
            for (int a = 0; a < 16; ++a)
#pragma unroll
                for (int bq = 0; bq < 16 / (a + 1); ++bq) { const unsigned kv = (key_enc(v1[a] + v2[bq]) & ~63u) | (unsigned)(63 - id); INS16(C, kv); ++id; }
        }
        LDS_WAIT(); asm volatile("" ::: "memory");
        float best[16], e[16], sum = 0.f; int ex[16];
#pragma unroll
        for (int q = 0; q < 16; ++q) { best[q] = key_dec((C[q] & ~63u) | 32u); const int ab = tab[63 - (int)(C[q] & 63u)]; ex[q] = il[ab >> 4] * 128 + il[16 + (ab & 15)]; }
#pragma unroll
        for (int q = 0; q < 16; ++q) { e[q] = __expf(best[q] - best[0]); sum += e[q]; }
        const float inv = 1.0f / sum;
        int* IDX = (int*)(P.ws + WS_IDX) + ((size_t)(tt0 + tid) * 8 + h) * 16; float* GW = (float*)(P.ws + WS_GW) + ((size_t)(tt0 + tid) * 8 + h) * 16;
#pragma unroll
        for (int q = 0; q < 16; ++q) { IDX[q] = ex[q]; GW[q] = e[q] * inv; }
    }
    __syncthreads();
}

typedef float f32x2 __attribute__((ext_vector_type(2)));
__device__ __forceinline__ void cvt_table_fp8(const float* src, unsigned char* dst, float* scl, int gw, int ngw, int lane) {
    for (int row = gw; row < 16384; row += ngw) {
        const f32x4* sp = (const f32x4*)(src + (size_t)row * 1024 + 16 * lane);
        const f32x4 a0 = sp[0], a1 = sp[1], a2 = sp[2], a3 = sp[3];
        float m = fmaxf(fmaxf(fmaxf(fabsf(a0.x), fabsf(a0.y)), fmaxf(fabsf(a0.z), fabsf(a0.w))), fmaxf(fmaxf(fabsf(a1.x), fabsf(a1.y)), fmaxf(fabsf(a1.z), fabsf(a1.w))));
        m = fmaxf(m, fmaxf(fmaxf(fmaxf(fabsf(a2.x), fabsf(a2.y)), fmaxf(fabsf(a2.z), fabsf(a2.w))), fmaxf(fmaxf(fabsf(a3.x), fabsf(a3.y)), fmaxf(fabsf(a3.z), fabsf(a3.w)))));
#pragma unroll
        for (int o = 1; o < 64; o <<= 1) m = fmaxf(m, __shfl_xor(m, o));
        m = fmaxf(m, 1e-30f);
        const float q = 224.0f / m;
        v4u o;
        int p;
        p = __builtin_amdgcn_cvt_pk_fp8_f32(a0.x * q, a0.y * q, 0, false); p = __builtin_amdgcn_cvt_pk_fp8_f32(a0.z * q, a0.w * q, p, true); o.x = (unsigned)p;
        p = __builtin_amdgcn_cvt_pk_fp8_f32(a1.x * q, a1.y * q, 0, false); p = __builtin_amdgcn_cvt_pk_fp8_f32(a1.z * q, a1.w * q, p, true); o.y = (unsigned)p;
        p = __builtin_amdgcn_cvt_pk_fp8_f32(a2.x * q, a2.y * q, 0, false); p = __builtin_amdgcn_cvt_pk_fp8_f32(a2.z * q, a2.w * q, p, true); o.z = (unsigned)p;
        p = __builtin_amdgcn_cvt_pk_fp8_f32(a3.x * q, a3.y * q, 0, false); p = __builtin_amdgcn_cvt_pk_fp8_f32(a3.z * q, a3.w * q, p, true); o.w = (unsigned)p;
        *(v4u*)(dst + (size_t)row * 1024 + 16 * lane) = o;
        if (lane == 0) scl[row] = m * (1.0f / 224.0f);
    }
}
__device__ __forceinline__ void peer_token(const Params& P, int t, int lane, float* dstbase) {
    const unsigned char* ws = P.ws;
    const float* xrow = P.out + (size_t)t * 1024 + 16 * lane;
    const float rstd2 = rsqrtf(((const float*)(ws + WS_SSQ2))[t] * (1.0f / 1024.0f) + 1e-6f);
    f32x4 x2[4]; f32x2 hn[8], acc[8];
#pragma unroll
    for (int i = 0; i < 4; ++i) { x2[i] = ((const f32x4*)xrow)[i]; const f32x4 w = ((const f32x4*)(P.norm_ffn_w + 16 * lane))[i];
        hn[2 * i] = (f32x2){x2[i].x * rstd2 * w.x, x2[i].y * rstd2 * w.y}; hn[2 * i + 1] = (f32x2){x2[i].z * rstd2 * w.z, x2[i].w * rstd2 * w.w}; }
#pragma unroll
    for (int i = 0; i < 8; ++i) acc[i] = (f32x2){0.f, 0.f};
    const int* IDX = (const int*)(ws + WS_IDX) + (size_t)t * 128; const float* GW = (const float*)(ws + WS_GW) + (size_t)t * 128;
    const unsigned char* UB8 = ws + WS_UB; const unsigned char* VB8 = ws + WS_VB;
    const float* USC = (const float*)(ws + WS_UB + 16 * MiB); const float* VSC = (const float*)(ws + WS_VB + 16 * MiB);
    const int myk = (lane >> 2) & 15;
#pragma unroll 1
    for (int hh = 0; hh < 8; ++hh) {
        const int idv = IDX[hh * 16 + (lane & 15)];
        const float gsc = GW[hh * 16 + (lane & 15)] * VSC[idv], usc = USC[idv];
        v4u uq[16], vq[16];
#pragma unroll
        for (int k = 0; k < 16; ++k) { const int e = __builtin_amdgcn_readlane(idv, k);
            uq[k] = *(const v4u*)(UB8 + (size_t)e * 1024 + 16 * lane); vq[k] = *(const v4u*)(VB8 + (size_t)e * 1024 + 16 * lane); }
        float d[16];
#pragma unroll
        for (int k = 0; k < 16; ++k) {
            f32x2 s = __builtin_amdgcn_cvt_pk_f32_fp8((int)uq[k].x, false) * hn[0];
            s = __builtin_elementwise_fma(__builtin_amdgcn_cvt_pk_f32_fp8((int)uq[k].x, true), hn[1], s);
            s = __builtin_elementwise_fma(__builtin_amdgcn_cvt_pk_f32_fp8((int)uq[k].y, false), hn[2], s);
            s = __builtin_elementwise_fma(__builtin_amdgcn_cvt_pk_f32_fp8((int)uq[k].y, true), hn[3], s);
            s = __builtin_elementwise_fma(__builtin_amdgcn_cvt_pk_f32_fp8((int)uq[k].z, false), hn[4], s);
            s = __builtin_elementwise_fma(__builtin_amdgcn_cvt_pk_f32_fp8((int)uq[k].z, true), hn[5], s);
            s = __builtin_elementwise_fma(__builtin_amdgcn_cvt_pk_f32_fp8((int)uq[k].w, false), hn[6], s);
            s = __builtin_elementwise_fma(__builtin_amdgcn_cvt_pk_f32_fp8((int)uq[k].w, true), hn[7], s);
            d[k] = s.x + s.y;
        }
        float r8[8], r4[4], r2[2], r1;
        { const bool up = (lane & 32) != 0;
#pragma unroll
          for (int i = 0; i < 8; ++i) { const float keep = up ? d[8 + i] : d[i], send = up ? d[i] : d[8 + i]; r8[i] = keep + __shfl_xor(send, 32); } }
        { const bool up = (lane & 16) != 0;
#pragma unroll
          for (int i = 0; i < 4; ++i) { const float keep = up ? r8[4 + i] : r8[i], send = up ? r8[i] : r8[4 + i]; r4[i] = keep + __shfl_xor(send, 16); } }
        { const bool up = (lane & 8) != 0;
#pragma unroll
          for (int i = 0; i < 2; ++i) { const float keep = up ? r4[2 + i] : r4[i], send = up ? r4[i] : r4[2 + i]; r2[i] = keep + __shfl_xor(send, 8); } }
        { const bool up = (lane & 4) != 0; const float keep = up ? r2[1] : r2[0], send = up ? r2[0] : r2[1]; r1 = keep + __shfl_xor(send, 4); }
        r1 += __shfl_xor(r1, 2); r1 += __shfl_xor(r1, 1);
        const float act = gelu_tanh(r1 * __shfl(usc, myk)) * __shfl(gsc, myk);
#pragma unroll
        for (int k = 0; k < 16; ++k) {
            const float a = __builtin_bit_cast(float, __builtin_amdgcn_readlane(__builtin_bit_cast(int, act), 4 * k));
            const f32x2 a2 = (f32x2){a, a};
            acc[0] = __builtin_elementwise_fma(__builtin_amdgcn_cvt_pk_f32_fp8((int)vq[k].x, false), a2, acc[0]);
            acc[1] = __builtin_elementwise_fma(__builtin_amdgcn_cvt_pk_f32_fp8((int)vq[k].x, true), a2, acc[1]);
            acc[2] = __builtin_elementwise_fma(__builtin_amdgcn_cvt_pk_f32_fp8((int)vq[k].y, false), a2, acc[2]);
            acc[3] = __builtin_elementwise_fma(__builtin_amdgcn_cvt_pk_f32_fp8((int)vq[k].y, true), a2, acc[3]);
            acc[4] = __builtin_elementwise_fma(__builtin_amdgcn_cvt_pk_f32_fp8((int)vq[k].z, false), a2, acc[4]);
            acc[5] = __builtin_elementwise_fma(__builtin_amdgcn_cvt_pk_f32_fp8((int)vq[k].z, true), a2, acc[5]);
            acc[6] = __builtin_elementwise_fma(__builtin_amdgcn_cvt_pk_f32_fp8((int)vq[k].w, false), a2, acc[6]);
            acc[7] = __builtin_elementwise_fma(__builtin_amdgcn_cvt_pk_f32_fp8((int)vq[k].w, true), a2, acc[7]);
        }
    }
    float ss = 0.f;
#pragma unroll
    for (int i = 0; i < 4; ++i) { x2[i].x += acc[2 * i].x; x2[i].y += acc[2 * i].y; x2[i].z += acc[2 * i + 1].x; x2[i].w += acc[2 * i + 1].y;
        ss += (x2[i].x * x2[i].x + x2[i].y * x2[i].y) + (x2[i].z * x2[i].z + x2[i].w * x2[i].w); }
    const float rstd3 = rsqrtf(wave_sum(ss) * (1.0f / 1024.0f) + 1e-6f);
    float* orow = dstbase + (size_t)t * 1024 + 16 * lane;
#pragma unroll
    for (int i = 0; i < 4; ++i) { const f32x4 w = ((const f32x4*)(P.norm_final_w + 16 * lane))[i];
        ((f32x4*)orow)[i] = (f32x4){x2[i].x * rstd3 * w.x, x2[i].y * rstd3 * w.y, x2[i].z * rstd3 * w.z, x2[i].w * rstd3 * w.w}; }
}

__global__ void __launch_bounds__(NWAVES * 64, 2) hybrid_fwd(Params P) {
    extern __shared__ __attribute__((aligned(16))) unsigned char lds_raw[];
    LAS unsigned char* lds = (LAS unsigned char*)lds_raw;
    volatile LAS unsigned* MISC = (volatile LAS unsigned*)(lds + MISC_OFF);
    const int tid = threadIdx.x, lane = tid & 63, wave = __builtin_amdgcn_readfirstlane(tid >> 6);
    const int G = gridDim.x, bx = blockIdx.x;
    const int vcu = (G % 8 == 0) ? (bx % 8) * (G / 8) + bx / 8 : bx;
    unsigned char* ws = P.ws;
    for (int u = tid; u < 64; u += NWAVES * 64) MISC[u] = 0u;
    __syncthreads();
    XcdBarrier bar; bar.bar = (unsigned*)(ws + WS_CTL) + CW_BAR; bar.x = 0; bar.st = nullptr;
    if (!MK_PER_PHASE) bar = xcd_barrier_post((unsigned*)(ws + WS_CTL) + CW_BAR, MISC + 8);
    const int lo = P.ph_lo, hi = P.ph_hi;
#ifndef PHASE_MASK
#define PHASE_MASK 0xFFF
#endif
#define IN(k) (((PHASE_MASK >> (k)) & 1) && lo <= (k) && (k) < hi)
#define SEAM(k) do { if (IN(k) && IN((k) + 1)) xcd_barrier(bar); } while (0)
#ifndef REP_MASK
#define REP_MASK 0
#endif
#define REPS(k) for (int rep_ = 0; rep_ < (((REP_MASK >> (k)) & 1) ? 2 : 1); ++rep_, (rep_ < (((REP_MASK >> (k)) & 1) ? 2 : 1) ? xcd_barrier(bar) : (void)0))
    using namespace pg8;
    bf16* XB = (bf16*)(ws + WS_XB);

    if (IN(0)) REPS(0) { p0_prologue(P, lds, tid, lane, wave, vcu, G); }
    SEAM(0);
    if (IN(1)) REPS(1) {
        { Gemm gm{XB, (const bf16_t*)(ws + WS_WIN), T, 3072, 1024}; StaticOrder S; S.init(T, 3072, G, bx);
          EpiBf16Rs E{(bf16_t*)(ws + WS_QKV), 1536, 6, (bf16_t*)(ws + WS_XR), 512, (size_t)T * 512, nullptr, 1.0f};
          gemm_phase<EpiBf16Rs, StaticOrder, PG8_ALIGN, PG8_SP2>(lds, gm, S, E); }
        { Gemm gm{(const bf16_t*)(ws + WS_MEMN), (const bf16_t*)(ws + WS_WKV), 512, 2048, 1024}; StaticOrder S; S.init(512, 2048, G, bx);
          EpiKV E{(bf16_t*)(ws + WS_KB), (bf16_t*)(ws + WS_VTP)};
          gemm_phase<EpiKV, StaticOrder, PG8_ALIGN, PG8_SP2>(lds, gm, S, E); }
    }
    SEAM(1);
    if (IN(2)) REPS(2) {
#ifndef P2_REP_GDN
#define P2_REP_GDN 1
#endif
#ifndef P2_REP_LRU
#define P2_REP_LRU 1
#endif
        for (int rr = 0; rr < P2_REP_GDN; ++rr) for (int it = bx; it < 1024; it += G) gdn_local_item(P, lds, it, tid);
        for (int rr = 0; rr < P2_REP_LRU; ++rr) for (int lt = bx; lt < 256; lt += G) lru_local_item(P, lds, lt, tid, lane, wave);
    }
    SEAM(2);
    if (IN(3)) REPS(3) {
        if (bx < SCAN_WGS) gdn_scan(P, lds, bx, tid, lane, wave);
        else if (bx < SCAN_WGS + 2) lru_carry(P, (bx - SCAN_WGS) * NWAVES + wave, lane);
        else cvt_table_fp8(P.peer_u, ws + WS_UB, (float*)(ws + WS_UB + 16 * MiB), (bx - SCAN_WGS - 2) * NWAVES + wave, (G - SCAN_WGS - 2) * NWAVES, lane);
    }
    SEAM(3);
    if (IN(4)) REPS(4) {
        gdn_gate_norm(P, (size_t)bx * (NWAVES * 64) + tid, (size_t)G * (NWAVES * 64));
        lru_combine(P, (size_t)bx * (NWAVES * 64) + tid, (size_t)G * (NWAVES * 64));
        cvt_table_fp8(P.peer_v, ws + WS_VB, (float*)(ws + WS_VB + 16 * MiB), bx * NWAVES + wave, G * NWAVES, lane);
    }
    SEAM(4);
    if (IN(5)) {
        Gemm gm{(const bf16_t*)(ws + WS_Y), (const bf16_t*)(ws + WS_WOUT), T, 1024, 1024}; StaticOrder S; S.init(T, 1024, G, bx);
        EpiResid E{P.x, P.out, XB, (float*)(ws + WS_SSQ1)};
        gemm_phase<EpiResid, StaticOrder, PG8_ALIGN, PG8_SP2>(lds, gm, S, E);
    }
    SEAM(5);
    if (IN(6)) REPS(6) {
        Gemm gm{XB, (const bf16_t*)(ws + WS_WQ), T, 1024, 1024}; StaticOrder S; S.init(T, 1024, G, bx);
        EpiBf16Rs E{(bf16_t*)(ws + WS_Q), 1024, 4, nullptr, 256, 0, (const float*)(ws + WS_SSQ1), 0.0625f};
        gemm_phase<EpiBf16Rs, StaticOrder, PG8_ALIGN, PG8_SP2>(lds, gm, S, E);
    }
    SEAM(6);
    if (IN(7)) REPS(7) {
        for (int un = bx; un < 512; un += G) xattn_unit(P, lds, un, tid, lane, wave);
    }
    SEAM(7);
    if (IN(8)) {
        Gemm gm{(const bf16_t*)(ws + WS_AO), (const bf16_t*)(ws + WS_WO), T, 1024, 1024}; StaticOrder S; S.init(T, 1024, G, bx);
        EpiResid E{P.out, P.out, XB, (float*)(ws + WS_SSQ2)};
        gemm_phase<EpiResid, StaticOrder, PG8_ALIGN, PG8_SP2>(lds, gm, S, E);
    }
    SEAM(8);
    if (IN(9)) REPS(9) {
        Gemm gm{XB, (const bf16_t*)(ws + WS_PWQ), T, 2048, 1024}; StaticOrder S; S.init(T, 2048, G, bx);
        EpiBf16Rs E{(bf16_t*)(ws + WS_PQ), 2048, 8, nullptr, 256, 0, (const float*)(ws + WS_SSQ2), 1.0f};
        gemm_phase<EpiBf16Rs, StaticOrder, PG8_ALIGN, PG8_SP2>(lds, gm, S, E);
    }
    SEAM(9);
    if (IN(10)) REPS(10) {
        for (int it = bx; it < 512; it += G) peer_topk_item(P, lds, it, tid, lane, wave);
    }
    SEAM(10);
    if (IN(11)) REPS(11) {
        for (int t = bx * NWAVES + wave; t < T; t += G * NWAVES) peer_token(P, t, lane, (((REP_MASK >> 11) & 1) && rep_ == 0) ? (float*)(ws + WS_PQ) : P.out);
    }
#undef IN
#undef SEAM
}

extern "C" void kernel_launch(void* const* d_in, const int* in_sizes, int n_in, void* d_out, int out_size, void* d_ws, size_t ws_size, hipStream_t stream) {
    static int grid = 0;
    if (grid == 0) {
        if (n_in != 27 || in_sizes[0] != T * D || out_size != T * D || ws_size < WS_END) {
            fprintf(stderr, "kernel_launch: unexpected shapes (n_in %d, in0 %d, out %d, ws %zu); nothing launched\n", n_in, n_in > 0 ? in_sizes[0] : -1, out_size, ws_size); grid = -1; return; }
        int dev = 0, cus = 0, per_cu = 0;
        if (hipGetDevice(&dev) != hipSuccess || hipDeviceGetAttribute(&cus, hipDeviceAttributeMultiprocessorCount, dev) != hipSuccess) { grid = -1; return; }
        if (hipFuncSetAttribute((const void*)hybrid_fwd, hipFuncAttributeMaxDynamicSharedMemorySize, LDS_BYTES) != hipSuccess) { fprintf(stderr, "kernel_launch: hipFuncSetAttribute failed\n"); grid = -1; return; }
        if (hipOccupancyMaxActiveBlocksPerMultiprocessor(&per_cu, (const void*)hybrid_fwd, NWAVES * 64, LDS_BYTES) != hipSuccess || per_cu < 1)
            fprintf(stderr, "kernel_launch: note: occupancy query reports %d workgroups per CU\n", per_cu);
        (void)hipGetLastError();
        grid = cus;
        if (grid != 256) fprintf(stderr, "kernel_launch: %d CUs (built for 256)\n", grid);
    }
    if (grid < 0) return;
    if (hipMemsetAsync((char*)d_ws + WS_CTL, 0, CTL_ZERO_BYTES, stream) != hipSuccess) { fprintf(stderr, "kernel_launch: hipMemsetAsync failed\n"); return; }
    Params p{};
    const float** pp = (const float**)&p;
    for (int i = 0; i < 27; ++i) pp[i] = (const float*)d_in[i];
    p.out = (float*)d_out; p.ws = (unsigned char*)d_ws;
#if MK_PER_PHASE
    for (int k = 0; k < N_PHASES; ++k) { p.ph_lo = k; p.ph_hi = k + 1; hipLaunchKernelGGL(hybrid_fwd, dim3(grid), dim3(NWAVES * 64), LDS_BYTES, stream, p); }
#else
    p.ph_lo = 0; p.ph_hi = N_PHASES;
    hipLaunchKernelGGL(hybrid_fwd, dim3(grid), dim3(NWAVES * 64), LDS_BYTES, stream, p);
#endif
    const hipError_t le = hipPeekAtLastError();
    if (le != hipSuccess) fprintf(stderr, "kernel_launch: launch failed: %s\n", hipGetErrorName(le));
}
```

```cpp
#include <hip/hip_runtime.h>
#include <cstdio>
#include <cstdint>
namespace pg8 {
#define PG8_LAS __attribute__((address_space(3)))
typedef unsigned short bf16_t;
typedef short bf16x8 __attribute__((ext_vector_type(8)));
typedef float f32x4 __attribute__((ext_vector_type(4)));
typedef unsigned u32x4 __attribute__((ext_vector_type(4)));
constexpr int BM = 256, BK = 64, HALF = 128, HTB = HALF * BK * 2  , STAGE_BYTES = 8 * HTB, NXCD = 8, WGM = 8;

__host__ __device__ __forceinline__ int lds_byte(int r, int c) { const int st = (r >> 4) * 2 + (c >> 5), rr = r & 15, cc = c & 31, ob = rr * 64 + cc * 2; return st * 1024 + (ob ^ (((ob >> 9) & 1) << 5)); }
__host__ __device__ __forceinline__ void stage_rc(int b, int& R, int& C) { const int st = b / 1024, sb = b % 1024, swz = sb ^ (((sb >> 9) & 1) << 5); R = (st >> 1) * 16 + swz / 64; C = (st & 1) * 32 + (swz % 64) / 2; }
__host__ __device__ __forceinline__ int perm32(int rho) { const int n = rho >> 4, i = rho & 15; return 8 * (i >> 2) + 4 * n + (i & 3); }

struct Unit { int pm, pn; };
struct Gemm { const bf16_t* A; const bf16_t* Bt; int M, N, K; };

struct StaticOrder {
    int nM, nN, nwg, G, c;
    __host__ __device__ void init(int M, int N, int G_, int c_) { nM = M / BM; nN = N / BM; nwg = nM * nN; G = G_; c = c_; }
    __host__ __device__ bool next(int i, Unit& u) const {
        const long L = (long)i * G + c; if (L >= nwg) return false;
        int wgid = (int)L; { const int q = nwg / NXCD, r = nwg % NXCD, xcd = wgid % NXCD, off = wgid / NXCD; wgid = (xcd < r ? xcd * (q + 1) : r * (q + 1) + (xcd - r) * q) + off; }
        const int nig = WGM * nN, gid = wgid / nig, fm = gid * WGM, gsz = (nM - fm) < WGM ? (nM - fm) : WGM;
        u.pm = fm + ((wgid % nig) % gsz); u.pn = (wgid % nig) / gsz; return true;
    }
    __device__ __forceinline__ void a_ready(const Unit&) const {}
    __device__ __forceinline__ void done(const Unit&) const {}
};

__device__ __forceinline__ unsigned cvt_pk_bf16(float lo, float hi) { unsigned r; asm volatile("v_cvt_pk_bf16_f32 %0, %1, %2" : "=v"(r) : "v"(lo), "v"(hi)); return r; }
template <class Epi, class Sched, bool ALIGN_EPI = false, bool SP2 = false>
__device__ __forceinline__ void gemm_phase(PG8_LAS unsigned char* lds, const Gemm g, const Sched& S, const Epi& E) {
    const int tid = threadIdx.x, wid = __builtin_amdgcn_readfirstlane(tid >> 6), lane = tid & 63, wr = wid >> 2, wc = wid & 3, fr = lane & 15, fq = lane >> 4;
    const int K = g.K, nt = K / BK;
    unsigned voffA[2], voffB[2];
#pragma unroll
    for (int i = 0; i < 2; ++i) { int R, C; stage_rc(tid * 16 + i * 8192, R, C); const int Rb = Epi::PERM ? ((R & ~31) + perm32(R & 31)) : R;
        voffA[i] = (unsigned)(R * K + C) * 2u; voffB[i] = (unsigned)(Rb * K + C) * 2u; }
    const size_t kstep = (size_t)(BK * 2);
    const size_t hstep = (size_t)HALF * K * 2;
    const size_t tstep = 2 * hstep;
    const unsigned ldsw = (unsigned)wid * 1024u;
    const int aoff = lds_byte(wr * 64 + fr, fq * 8), boff = lds_byte(wc * 32 + fr, fq * 8);
#define PG8_SA(b, h) (((b) * 2 + (h)) * HTB)
#define PG8_SB(b, h) ((4 + (b) * 2 + (h)) * HTB)
#define PG8_STAGE(bufoff, gbase, voff) do { _Pragma("unroll") for (int _i = 0; _i < 2; ++_i) \
        __builtin_amdgcn_global_load_lds((const unsigned*)((const char*)(gbase) + (voff)[_i]), (PG8_LAS unsigned*)(lds + (bufoff) + ldsw + _i * 8192), 16, 0, 0); } while (0)
#define PG8_LDA(dst, b, h) do { _Pragma("unroll") for (int m = 0; m < 4; ++m) _Pragma("unroll") for (int k = 0; k < 2; ++k) dst[m][k] = *(const PG8_LAS bf16x8*)(lds + PG8_SA(b, h) + aoff + m * 2048 + k * 1024); } while (0)
#define PG8_LDB(dst, b, h) do { _Pragma("unroll") for (int n = 0; n < 2; ++n) _Pragma("unroll") for (int k = 0; k < 2; ++k) dst[n][k] = *(const PG8_LAS bf16x8*)(lds + PG8_SB(b, h) + boff + n * 2048 + k * 1024); } while (0)
#define PG8_MMA(ai, bj, At, Bt) do { __builtin_amdgcn_s_setprio(1); _Pragma("unroll") for (int m = 0; m < 4; ++m) _Pragma("unroll") for (int n = 0; n < 2; ++n) _Pragma("unroll") for (int k = 0; k < 2; ++k) \
        acc[ai][bj][m][n] = __builtin_amdgcn_mfma_f32_16x16x32_bf16(Bt[n][k], At[m][k], acc[ai][bj][m][n], 0, 0, 0); __builtin_amdgcn_s_setprio(0); } while (0)
#define PG8_WAIT_V(n) asm volatile("s_waitcnt vmcnt(" #n ")" ::: "memory")
#define PG8_WAIT_L(n) asm volatile("s_waitcnt lgkmcnt(" #n ")" ::: "memory")
#define PG8_BAR __builtin_amdgcn_s_barrier()
#define PG8_SCHED __builtin_amdgcn_sched_barrier(0)
    Unit cur, nxt; int ui = 0;
    if (!S.next(0, cur)) return;
    f32x4 acc[2][2][4][2];
#pragma unroll
    for (int a = 0; a < 2; ++a)
#pragma unroll
        for (int b = 0; b < 2; ++b)
#pragma unroll
            for (int m = 0; m < 4; ++m)
#pragma unroll
                for (int n = 0; n < 2; ++n) acc[a][b][m][n] = (f32x4){0.f, 0.f, 0.f, 0.f};
    bf16x8 At[4][2], B0[2][2], B1[2][2];
    const char* cA = (const char*)g.A + (size_t)cur.pm * tstep; const char* cB = (const char*)g.Bt + (size_t)cur.pn * tstep;
    S.a_ready(cur);
    if constexpr (SP2) {
        PG8_STAGE(PG8_SB(0, 0), cB, voffB); PG8_STAGE(PG8_SB(0, 1), cB + hstep, voffB); PG8_STAGE(PG8_SA(0, 0), cA, voffA); PG8_STAGE(PG8_SA(0, 1), cA + hstep, voffA);
        if (wr == 1) PG8_BAR;
        PG8_WAIT_V(2); PG8_BAR;
        PG8_STAGE(PG8_SB(1, 0), cB + kstep, voffB); PG8_STAGE(PG8_SA(1, 0), cA + kstep, voffA); PG8_STAGE(PG8_SB(1, 1), cB + hstep + kstep, voffB);
        PG8_WAIT_V(6); PG8_BAR;
    } else {
        PG8_STAGE(PG8_SB(0, 0), cB, voffB); PG8_STAGE(PG8_SA(0, 0), cA, voffA); PG8_STAGE(PG8_SB(0, 1), cB + hstep, voffB); PG8_STAGE(PG8_SA(0, 1), cA + hstep, voffA);
        if (wr == 1) PG8_BAR;
        PG8_WAIT_V(4); PG8_BAR;
        PG8_STAGE(PG8_SB(1, 0), cB + kstep, voffB); PG8_STAGE(PG8_SA(1, 0), cA + kstep, voffA); PG8_STAGE(PG8_SB(1, 1), cB + hstep + kstep, voffB);
        PG8_WAIT_V(6); PG8_BAR;
    }
    for (;;) {
        const bool has_next = S.next(ui + 1, nxt);
        const char* nA = has_next ? (const char*)g.A + (size_t)nxt.pm * tstep : cA; const char* nB = has_next ? (const char*)g.Bt + (size_t)nxt.pn * tstep : cB;
        for (int t = 0; t < nt; t += 2) {
            const bool last = (t == nt - 2);
            const char* a1 = cA + (size_t)(t + 1) * kstep;
            const char* a2 = last ? nA : cA + (size_t)(t + 2) * kstep; const char* b2 = last ? nB : cB + (size_t)(t + 2) * kstep;
            const char* a3 = a2 + kstep; const char* b3 = b2 + kstep;
            if (last && has_next) S.a_ready(nxt);
            if constexpr (SP2) {
            PG8_LDB(B0, 0, 0); PG8_LDB(B1, 0, 1); PG8_SCHED; PG8_LDA(At, 0, 0); PG8_STAGE(PG8_SA(1, 1), a1 + hstep, voffA);
            PG8_WAIT_V(8); PG8_WAIT_L(0); PG8_BAR; PG8_MMA(0, 0, At, B0); PG8_MMA(0, 1, At, B1); PG8_BAR; PG8_SCHED;
            PG8_LDA(At, 0, 1); PG8_STAGE(PG8_SB(0, 0), b2, voffB); PG8_STAGE(PG8_SB(0, 1), b2 + hstep, voffB); PG8_STAGE(PG8_SA(0, 0), a2, voffA);
            PG8_WAIT_V(8); PG8_WAIT_L(0); PG8_BAR; PG8_MMA(1, 0, At, B0); PG8_MMA(1, 1, At, B1); PG8_BAR; PG8_SCHED;
            PG8_LDB(B0, 1, 0); PG8_LDB(B1, 1, 1); PG8_SCHED; PG8_LDA(At, 1, 0); PG8_STAGE(PG8_SA(0, 1), a2 + hstep, voffA);
            PG8_WAIT_V(8); PG8_WAIT_L(0); PG8_BAR; PG8_MMA(0, 0, At, B0); PG8_MMA(0, 1, At, B1); PG8_BAR; PG8_SCHED;
            PG8_LDA(At, 1, 1); PG8_STAGE(PG8_SB(1, 0), b3, voffB); PG8_STAGE(PG8_SB(1, 1), b3 + hstep, voffB); PG8_STAGE(PG8_SA(1, 0), a3, voffA);
            PG8_WAIT_V(8); PG8_WAIT_L(0); PG8_BAR; PG8_MMA(1, 0, At, B0); PG8_MMA(1, 1, At, B1); PG8_BAR; PG8_SCHED;
            } else {
            PG8_LDB(B0, 0, 0); PG8_SCHED; PG8_LDA(At, 0, 0); PG8_STAGE(PG8_SA(1, 1), a1 + hstep, voffA);
            PG8_WAIT_L(8); PG8_BAR; PG8_WAIT_L(0); PG8_MMA(0, 0, At, B0); PG8_BAR; PG8_SCHED;
            PG8_LDB(B1, 0, 1); PG8_STAGE(PG8_SB(0, 0), b2, voffB);
            PG8_BAR; PG8_WAIT_L(0); PG8_MMA(0, 1, At, B1); PG8_BAR;
            PG8_LDA(At, 0, 1); PG8_STAGE(PG8_SA(0, 0), a2, voffA);
            PG8_BAR; PG8_WAIT_L(0); PG8_MMA(1, 0, At, B0); PG8_BAR; PG8_SCHED;
            PG8_STAGE(PG8_SB(0, 1), b2 + hstep, voffB);
            PG8_WAIT_V(6); PG8_BAR; PG8_MMA(1, 1, At, B1); PG8_BAR;
            PG8_LDB(B0, 1, 0); PG8_SCHED; PG8_LDA(At, 1, 0); PG8_STAGE(PG8_SA(0, 1), a2 + hstep, voffA);
            PG8_WAIT_L(8); PG8_BAR; PG8_WAIT_L(0); PG8_MMA(0, 0, At, B0); PG8_BAR; PG8_SCHED;
            PG8_LDB(B1, 1, 1); PG8_STAGE(PG8_SB(1, 0), b3, voffB);
            PG8_BAR; PG8_WAIT_L(0); PG8_MMA(0, 1, At, B1); PG8_BAR;
            PG8_LDA(At, 1, 1); PG8_STAGE(PG8_SA(1, 0), a3, voffA);
            PG8_BAR; PG8_WAIT_L(0); PG8_MMA(1, 0, At, B0); PG8_BAR; PG8_SCHED;
            PG8_STAGE(PG8_SB(1, 1), b3 + hstep, voffB);
            PG8_WAIT_V(6); PG8_BAR; PG8_MMA(1, 1, At, B1); PG8_BAR;
            }
        }
        if constexpr (ALIGN_EPI) { if (wr == 0) PG8_BAR; }
        if constexpr (!Epi::AFTER_DRAIN) { E(acc, cur, wr, wc, fr, fq); S.done(cur); }
        if (!has_next) break;
#pragma unroll
        for (int a = 0; a < 2; ++a)
#pragma unroll
            for (int b = 0; b < 2; ++b)
#pragma unroll
                for (int m = 0; m < 4; ++m)
#pragma unroll
                    for (int n = 0; n < 2; ++n) acc[a][b][m][n] = (f32x4){0.f, 0.f, 0.f, 0.f};
        cur = nxt; cA = nA; cB = nB; ++ui;
        if constexpr (ALIGN_EPI) { if (wr == 1) PG8_BAR; }
    }
    PG8_WAIT_V(0);
    if constexpr (!ALIGN_EPI) { if (wr == 0) PG8_BAR; }
    PG8_BAR;
    if constexpr (Epi::AFTER_DRAIN) { E.fused(acc, cur, wr, wc, fr, fq, lds, wid, lane); S.done(cur); }
#undef PG8_SA
#undef PG8_SB
#undef PG8_STAGE
#undef PG8_LDA
#undef PG8_LDB
#undef PG8_MMA
#undef PG8_WAIT_V
#undef PG8_WAIT_L
#undef PG8_BAR
#undef PG8_SCHED
}
}

namespace pg8 {
__host__ __device__ __forceinline__ int permk(int kl) { return 8 * ((kl & 15) >> 2) + 4 * (kl >> 4) + (kl & 3); }
struct EpiBf16Rs {
    static constexpr bool PERM = true, AFTER_DRAIN = false;
    bf16_t* O0; int ld0; int ntile0; bf16_t* O1; int ld1; size_t stride1; const float* ssq; float cs;
    __device__ __forceinline__ void operator()(const f32x4 (&acc)[2][2][4][2], const Unit& u, int wr, int wc, int fr, int fq) const {
        bf16_t* base; int ld, colt;
        if (u.pn < ntile0) { base = O0; ld = ld0; colt = u.pn * BM; }
        else { const int q = u.pn - ntile0, per = ld1 / BM; base = O1 + (size_t)(q / per) * stride1; ld = ld1; colt = (q % per) * BM; }
        const int row0 = u.pm * BM + wr * 64 + fr, col0 = colt + wc * 32 + 8 * fq;
#pragma unroll
        for (int ai = 0; ai < 2; ++ai)
#pragma unroll
            for (int m = 0; m < 4; ++m) {
                const int row = row0 + ai * HALF + m * 16;
                float sc = cs; if (ssq) sc *= rsqrtf(ssq[row] * (1.0f / 1024.0f) + 1e-6f);
                bf16_t* rowp = base + (size_t)row * ld + col0;
#pragma unroll
                for (int bj = 0; bj < 2; ++bj) { const f32x4 v0 = acc[ai][bj][m][0] * sc, v1 = acc[ai][bj][m][1] * sc;
                    u32x4 w; w.x = cvt_pk_bf16(v0[0], v0[1]); w.y = cvt_pk_bf16(v0[2], v0[3]); w.z = cvt_pk_bf16(v1[0], v1[1]); w.w = cvt_pk_bf16(v1[2], v1[3]);
                    *(u32x4*)(rowp + bj * HALF) = w; } }
    }
};
struct EpiResid {
    static constexpr bool PERM = false, AFTER_DRAIN = false;
    const float* base; float* out; bf16_t* xb; float* ssq;
    __device__ __forceinline__ void operator()(const f32x4 (&acc)[2][2][4][2], const Unit& u, int wr, int wc, int fr, int fq) const {
        typedef unsigned u32x2v __attribute__((ext_vector_type(2)));
        const int row0 = u.pm * BM + wr * 64 + fr, col0 = u.pn * BM + wc * 32 + 4 * fq;
#pragma unroll
        for (int ai = 0; ai < 2; ++ai)
#pragma unroll
            for (int m = 0; m < 4; ++m) {
                const int row = row0 + ai * HALF + m * 16; const size_t off = (size_t)row * 1024 + col0; float s = 0.f;
#pragma unroll
                for (int bj = 0; bj < 2; ++bj)
#pragma unroll
                    for (int n = 0; n < 2; ++n) { const size_t o2 = off + bj * HALF + n * 16;
                        const f32x4 o = *(const f32x4*)(base + o2) + acc[ai][bj][m][n];
                        *(f32x4*)(out + o2) = o; s += (o[0] * o[0] + o[1] * o[1]) + (o[2] * o[2] + o[3] * o[3]);
                        u32x2v w; w.x = cvt_pk_bf16(o[0], o[1]); w.y = cvt_pk_bf16(o[2], o[3]); *(u32x2v*)(xb + o2) = w; }
                s += __shfl_xor(s, 16); s += __shfl_xor(s, 32);
                if (fq == 0) atomicAdd(ssq + row, s);
            }
    }
};
struct EpiKV {
    static constexpr bool PERM = false, AFTER_DRAIN = false;
    bf16_t* Kb; bf16_t* VTp;
    __device__ __forceinline__ void operator()(const f32x4 (&acc)[2][2][4][2], const Unit& u, int wr, int wc, int fr, int fq) const {
        typedef unsigned u32x2v __attribute__((ext_vector_type(2)));
        const int row0 = u.pm * BM + wr * 64 + fr, col0 = u.pn * BM + wc * 32 + 4 * fq;
#pragma unroll
        for (int ai = 0; ai < 2; ++ai)
#pragma unroll
            for (int m = 0; m < 4; ++m) {
                const int row = row0 + ai * HALF + m * 16, b = row >> 8, key = row & 255;
#pragma unroll
                for (int bj = 0; bj < 2; ++bj)
#pragma unroll
                    for (int n = 0; n < 2; ++n) { const int col = col0 + bj * HALF + n * 16; const f32x4 v = acc[ai][bj][m][n];
                        const unsigned p01 = cvt_pk_bf16(v[0], v[1]), p23 = cvt_pk_bf16(v[2], v[3]);
                        if (col < 1024) { const int h = col >> 8, dh = col & 255; u32x2v w; w.x = p01; w.y = p23;
                            *(u32x2v*)(Kb + ((size_t)((b * 4 + h) * 256 + key)) * 256 + dh) = w; }
                        else { const int c2 = col - 1024, h = c2 >> 8, dv = c2 & 255, kp = (key & ~31) | permk(key & 31);
                            bf16_t* d = VTp + ((size_t)((b * 4 + h) * 256 + dv)) * 256 + kp;
                            d[0] = (bf16_t)(p01 & 0xffffu); d[256] = (bf16_t)(p01 >> 16); d[512] = (bf16_t)(p23 & 0xffffu); d[768] = (bf16_t)(p23 >> 16); } }
            }
    }
};
}
#ifndef PG8_SP2
#define PG8_SP2 true
#endif
#ifndef PG8_ALIGN
#define PG8_ALIGN true
#endif

constexpr int NWAVES = 8;
#ifndef MK_PER_PHASE
#define MK_PER_PHASE 0
#endif
constexpr int T = 16384, SEQ = 8192, D = 1024;
constexpr int N_PHASES = 12;

constexpr size_t MiB = 1u << 20, KiB = 1u << 10;
constexpr size_t WS_CTL = 0, CTL_ZERO_BYTES = 1 * MiB;
constexpr int CW_BAR = 4096;
constexpr size_t WS_SSQ1 = 64 * KiB, WS_SSQ2 = 128 * KiB;
constexpr size_t WS_AB = 1 * MiB;
constexpr size_t WS_HEND = WS_AB + 512 * KiB, WS_PEND = WS_HEND + 512 * KiB, WS_HIN = WS_PEND + 512 * KiB;
constexpr size_t WS_DEC = WS_HIN + 512 * KiB;
constexpr size_t WS_SUBK = 3 * MiB + 256 * KiB;
constexpr size_t WS_WIN = 4 * MiB, WS_WOUT = 10 * MiB, WS_WQ = 12 * MiB, WS_WKV = 14 * MiB, WS_WO = 18 * MiB, WS_PWQ = 20 * MiB;
constexpr size_t WS_MEMN = 24 * MiB, WS_KB = 25 * MiB, WS_VTP = 26 * MiB;
constexpr size_t WS_XB = 28 * MiB;
constexpr size_t WS_HLOC = 28 * MiB, WS_PCUM = 44 * MiB;
constexpr size_t WS_QKV = 60 * MiB;
constexpr size_t WS_Y = 60 * MiB;
constexpr size_t WS_IDX = 60 * MiB, WS_GW = 68 * MiB;
constexpr size_t WS_UB = 92 * MiB;
constexpr size_t WS_XR = 108 * MiB, WS_Z = 124 * MiB, WS_GATE = 140 * MiB;
constexpr size_t WS_WN = 156 * MiB, WS_UF = 172 * MiB, WS_QD = 188 * MiB, WS_KD = 204 * MiB, WS_ATT = 220 * MiB;
constexpr size_t WS_VB = 156 * MiB;
constexpr size_t WS_Q = 188 * MiB, WS_AO = 220 * MiB;
constexpr size_t WS_PQ = 188 * MiB;
constexpr size_t WS_END = 252 * MiB;
static_assert(WS_XR - WS_QKV == (size_t)T * 1536 * 2 && WS_Z - WS_XR == (size_t)T * 512 * 2 && WS_GATE - WS_Z == (size_t)T * 512 * 2, "in-proj outputs are contiguous");

constexpr int LDS_BYTES = 160 * 1024;
constexpr int MISC_OFF = 159 * 1024;

#define GAS __attribute__((address_space(1)))
#define LAS __attribute__((address_space(3)))
typedef unsigned short bf16;
typedef unsigned v4u __attribute__((ext_vector_type(4)));
typedef unsigned v2u __attribute__((ext_vector_type(2)));
typedef float f32x4 __attribute__((ext_vector_type(4)));
typedef short bf16x8 __attribute__((ext_vector_type(8)));
typedef GAS unsigned gu32;
#define LDS_WAIT() asm volatile("s_waitcnt lgkmcnt(0)" ::: "memory")
__device__ __forceinline__ unsigned f2bf(float f) { unsigned u = __builtin_bit_cast(unsigned, f); return (u + 0x7fffu + ((u >> 16) & 1u)) >> 16; }
__device__ __forceinline__ unsigned pk2(float lo, float hi) { return f2bf(lo) | (f2bf(hi) << 16); }
__device__ __forceinline__ float bflo(unsigned u) { return __builtin_bit_cast(float, u << 16); }
__device__ __forceinline__ float bfhi(unsigned u) { return __builtin_bit_cast(float, u & 0xffff0000u); }
__device__ __forceinline__ float bf1(bf16 h) { return __builtin_bit_cast(float, (unsigned)h << 16); }
__device__ __forceinline__ float wave_sum(float v) {
#pragma unroll
    for (int o = 1; o < 64; o <<= 1) v += __shfl_xor(v, o);
    return v;
}
__device__ __forceinline__ float sigmoidf_(float x) { return __builtin_amdgcn_rcpf(1.0f + __expf(-x)); }
__device__ __forceinline__ float softplusf_(float x) { return fmaxf(x, 0.f) + log1pf(__expf(-fabsf(x))); }
__device__ __forceinline__ float siluf_(float x) { return x * __builtin_amdgcn_rcpf(1.0f + __expf(-x)); }
__device__ __forceinline__ float gelu_tanh(float x) { const float y = 0.7978845608028654f * (x + 0.044715f * x * x * x); const float e = __expf(2.0f * y); return x * (1.0f - __builtin_amdgcn_rcpf(1.0f + e)); }
__device__ __forceinline__ int permk(int kl) { return 8 * ((kl & 15) >> 2) + 4 * (kl >> 4) + (kl & 3); }

struct Params {
    const float *x, *mem, *norm_mix_w, *w_in, *conv_qkv_w, *gdn_a_log, *gdn_dt_bias, *gdn_norm_w, *lru_conv_w, *lru_conv_b, *lru_wa, *lru_ba, *lru_wx, *lru_bx, *lru_lambda, *w_out,
                *norm_xattn_w, *norm_mem_w, *xattn_wq, *xattn_wkv, *xattn_wo, *norm_ffn_w, *peer_wq, *peer_subkeys, *peer_u, *peer_v, *norm_final_w;
    float* out; unsigned char* ws; int ph_lo, ph_hi;
};
#define XB_TMO      128
#define XB_XCNT(j)  (256  + 64 * (j))
#define XB_XSUB(j)  (1280 + 64 * (j))
#define XB_XGEN(j)  (2304 + 64 * (j))
#define XB_TOP      3328
#define XB_TOPGEN   3392
#define XCD_BAR_WORDS 3456
#define XB_SPIN_CAP (1u << 18)

__device__ __forceinline__ unsigned xb_ld(unsigned* p)              { return __hip_atomic_load(p, __ATOMIC_RELAXED, __HIP_MEMORY_SCOPE_AGENT); }
__device__ __forceinline__ unsigned xb_add(unsigned* p, unsigned v) { return __hip_atomic_fetch_add(p, v, __ATOMIC_RELAXED, __HIP_MEMORY_SCOPE_AGENT); }
__device__ __forceinline__ unsigned xb_xcc_id() { return (unsigned)__builtin_amdgcn_s_getreg((3 << 11) | 20) & 0xFu; }
#define XB_SPIN(cond, bar) do { unsigned _sp = 0; while (cond) { __builtin_amdgcn_s_sleep(1); \
    if ((++_sp & 255u) == 0u) { if (xb_ld(&(bar)[XB_TMO])) break; if (_sp > XB_SPIN_CAP) { atomicAdd(&(bar)[XB_TMO], 1u); break; } } } } while (0)

struct XcdBarrier {
    unsigned* bar; unsigned x;
    volatile LAS unsigned* st;
};

__device__ __forceinline__ XcdBarrier xcd_barrier_post(unsigned* bar, volatile LAS unsigned* st) {
    XcdBarrier b; b.bar = bar; b.x = xb_xcc_id(); b.st = st;
    if (threadIdx.x == 0) (void)xb_add(&bar[XB_XCNT(b.x)], 1u);
    return b;
}
__device__ __forceinline__ void xcd_barrier_complete(unsigned* bar, unsigned x, unsigned& nloc, unsigned& nx) {
    const unsigned G = gridDim.x * gridDim.y * gridDim.z;
    unsigned sum, cnt, mine, sp = 0u;
    for (;;) {
        sum = 0u; cnt = 0u; mine = 0u;
#pragma unroll
        for (unsigned j = 0; j < 16; ++j) { const unsigned c = xb_ld(&bar[XB_XCNT(j)]); sum += c; cnt += (c > 0u) ? 1u : 0u; mine = (j == x) ? c : mine; }
        if (sum == G) break;
        __builtin_amdgcn_s_sleep(1);
        if ((++sp & 255u) == 0u) { if (xb_ld(&bar[XB_TMO])) break; if (sp > XB_SPIN_CAP) { atomicAdd(&bar[XB_TMO], 1u); break; } }
    }
    nloc = mine > 0u ? mine : 1u; nx = cnt > 0u ? cnt : 1u;
}

__device__ __forceinline__ void xcd_barrier(const XcdBarrier& b) {
    asm volatile("s_waitcnt vmcnt(0)" ::: "memory");
    __syncthreads();
    if (threadIdx.x == 0) {
        unsigned* bar = b.bar;
        __builtin_amdgcn_s_waitcnt(0);
        unsigned nloc = b.st[0], nx = b.st[1];
        if (nloc == 0u) { xcd_barrier_complete(bar, b.x, nloc, nx); b.st[0] = nloc; b.st[1] = nx; }
        const unsigned old = xb_add(&bar[XB_XSUB(b.x)], 1u);
        const unsigned gen = old / nloc;
        if (old + 1u == (gen + 1u) * nloc) {
            __builtin_amdgcn_fence(__ATOMIC_RELEASE, "agent");
            asm volatile("s_waitcnt vmcnt(0)" ::: "memory");
            const unsigned og = xb_add(&bar[XB_TOP], 1u);
            const unsigned tg = og / nx;
            if (og + 1u == (tg + 1u) * nx) xb_add(&bar[XB_TOPGEN], 1u);
            else XB_SPIN(xb_ld(&bar[XB_TOPGEN]) == tg, bar);
            __builtin_amdgcn_fence(__ATOMIC_ACQUIRE, "agent");
            xb_add(&bar[XB_XGEN(b.x)], 1u);
            asm volatile("s_waitcnt vmcnt(0)" ::: "memory");
        } else {
            XB_SPIN(xb_ld(&bar[XB_XGEN(b.x)]) == gen, bar);
            __builtin_amdgcn_fence(__ATOMIC_ACQUIRE, "agent");
            asm volatile("s_waitcnt vmcnt(0)" ::: "memory");
        }
    }
    __syncthreads();
}

__device__ __forceinline__ void p0_transpose_item(const float* W, int K, int ldw, int c0, int nblk, bf16* WT, int row_off, const float* ks, LAS float* scr, int item, int lane) {
    const int kb = item / nblk, nb = item % nblk, k0 = 64 * kb, n0 = 32 * nb;
#pragma unroll 8
    for (int i = 0; i < 32; ++i) { const int kk = 2 * i + (lane >> 5); float v = W[(size_t)(k0 + kk) * ldw + c0 + n0 + (lane & 31)]; if (ks) v *= ks[k0 + kk]; scr[kk * 33 + (lane & 31)] = v; }
    LDS_WAIT(); asm volatile("" ::: "memory");
    const int c = lane & 7;
#pragma unroll
    for (int j = 0; j < 4; ++j) { const int n = (lane >> 3) + 8 * j; const LAS float* s = scr + (8 * c) * 33 + n;
        v4u o; o.x = pk2(s[0 * 33], s[1 * 33]); o.y = pk2(s[2 * 33], s[3 * 33]); o.z = pk2(s[4 * 33], s[5 * 33]); o.w = pk2(s[6 * 33], s[7 * 33]);
        *(GAS v4u*)(WT + (size_t)(row_off + n0 + n) * K + k0 + 8 * c) = o; }
    LDS_WAIT(); asm volatile("" ::: "memory");
}

__device__ __forceinline__ void p0_prologue(const Params& P, LAS unsigned char* lds, int tid, int lane, int wave, int vcu, int G) {
    unsigned char* ws = P.ws;
    const int gw = vcu * NWAVES + wave, NGW = G * NWAVES;
    LAS float* wabl = (LAS float*)lds;
    for (int idx = tid; idx < 8192; idx += NWAVES * 64) { const int k = idx >> 3, c = idx & 7, j = k >> 8, l = (k >> 2) & 63, e = k & 3;
        wabl[((((j * 4 + e) * 2 + (c >> 2)) * 64 + l) << 2) + (c & 3)] = P.w_in[(size_t)k * 3080 + 2048 + c]; }
    __syncthreads();
    {
        bf16* XB0 = (bf16*)(ws + WS_XB); float* AB = (float*)(ws + WS_AB);
        f32x4 w4[4];
#pragma unroll
        for (int j = 0; j < 4; ++j) w4[j] = ((const f32x4*)P.norm_mix_w)[64 * j + lane];
        for (int m = gw; m < T; m += NGW) {
            const f32x4* xr = (const f32x4*)(P.x + (size_t)m * D) + lane;
            f32x4 v[4]; float s = 0.f;
#pragma unroll
            for (int j = 0; j < 4; ++j) { v[j] = xr[64 * j]; s += (v[j].x * v[j].x + v[j].y * v[j].y) + (v[j].z * v[j].z + v[j].w * v[j].w); }
            const float rstd = rsqrtf(wave_sum(s) * (1.0f / D) + 1e-6f);
            v2u* o8 = (v2u*)(XB0 + (size_t)m * D) + lane;
            float part[8];
#pragma unroll
            for (int c = 0; c < 8; ++c) part[c] = 0.f;
#pragma unroll
            for (int j = 0; j < 4; ++j) {
                v[j] = v[j] * rstd * w4[j];
                v2u o; o.x = pk2(v[j].x, v[j].y); o.y = pk2(v[j].z, v[j].w); o8[64 * j] = o;
#pragma unroll
                for (int e = 0; e < 4; ++e) {
                    const f32x4 wa = *(const LAS f32x4*)(wabl + ((((j * 4 + e) * 2 + 0) * 64 + lane) << 2));
                    const f32x4 wb = *(const LAS f32x4*)(wabl + ((((j * 4 + e) * 2 + 1) * 64 + lane) << 2));
                    const float hv = v[j][e];
                    part[0] += hv * wa.x; part[1] += hv * wa.y; part[2] += hv * wa.z; part[3] += hv * wa.w;
                    part[4] += hv * wb.x; part[5] += hv * wb.y; part[6] += hv * wb.z; part[7] += hv * wb.w;
                }
            }
#pragma unroll
            for (int c = 0; c < 8; ++c) part[c] = wave_sum(part[c]);
            float o = part[0];
#pragma unroll
            for (int c = 1; c < 8; ++c) o = (lane == c) ? part[c] : o;
            if (lane < 8) AB[(size_t)m * 8 + lane] = o;
        }
    }
    {
        bf16* MEMN = (bf16*)(ws + WS_MEMN);
        for (int m = gw; m < 512; m += NGW) {
            const f32x4* xr = (const f32x4*)(P.mem + (size_t)m * D) + lane;
            f32x4 v[4]; float s = 0.f;
#pragma unroll
            for (int j = 0; j < 4; ++j) { v[j] = xr[64 * j]; s += (v[j].x * v[j].x + v[j].y * v[j].y) + (v[j].z * v[j].z + v[j].w * v[j].w); }
            const float rstd = rsqrtf(wave_sum(s) * (1.0f / D) + 1e-6f);
            v2u* o8 = (v2u*)(MEMN + (size_t)m * D) + lane;
#pragma unroll
            for (int j = 0; j < 4; ++j) { const f32x4 w = ((const f32x4*)P.norm_mem_w)[64 * j + lane]; const f32x4 y = v[j] * rstd * w;
                v2u o; o.x = pk2(y.x, y.y); o.y = pk2(y.z, y.w); o8[64 * j] = o; }
        }
    }
    __syncthreads();
    {
        LAS float* scr = (LAS float*)(lds + wave * 16384);
        constexpr int I_IN1 = 16 * 48, I_IN2 = 16 * 16, I_OUT = 16 * 32, I_Q = 16 * 32, I_KV = 16 * 64, I_O = 16 * 32, I_PQ = 16 * 64;
        constexpr int NITEMS = I_IN1 + 3 * I_IN2 + I_OUT + I_Q + I_KV + I_O + I_PQ;
        for (int it = gw; it < NITEMS; it += NGW) {
            int r = it;
            if (r < I_IN1) { p0_transpose_item(P.w_in, 1024, 3080, 0, 48, (bf16*)(ws + WS_WIN), 0, nullptr, scr, r, lane); continue; } r -= I_IN1;
            if (r < I_IN2) { p0_transpose_item(P.w_in, 1024, 3080, 2056, 16, (bf16*)(ws + WS_WIN), 1536, nullptr, scr, r, lane); continue; } r -= I_IN2;
            if (r < I_IN2) { p0_transpose_item(P.w_in, 1024, 3080, 1536, 16, (bf16*)(ws + WS_WIN), 2048, nullptr, scr, r, lane); continue; } r -= I_IN2;
            if (r < I_IN2) { p0_transpose_item(P.w_in, 1024, 3080, 2568, 16, (bf16*)(ws + WS_WIN), 2560, nullptr, scr, r, lane); continue; } r -= I_IN2;
            if (r < I_OUT) { p0_transpose_item(P.w_out, 1024, 1024, 0, 32, (bf16*)(ws + WS_WOUT), 0, nullptr, scr, r, lane); continue; } r -= I_OUT;
            if (r < I_Q) { p0_transpose_item(P.xattn_wq, 1024, 1024, 0, 32, (bf16*)(ws + WS_WQ), 0, P.norm_xattn_w, scr, r, lane); continue; } r -= I_Q;
            if (r < I_KV) { p0_transpose_item(P.xattn_wkv, 1024, 2048, 0, 64, (bf16*)(ws + WS_WKV), 0, nullptr, scr, r, lane); continue; } r -= I_KV;
            if (r < I_O) { p0_transpose_item(P.xattn_wo, 1024, 1024, 0, 32, (bf16*)(ws + WS_WO), 0, nullptr, scr, r, lane); continue; } r -= I_O;
            p0_transpose_item(P.peer_wq, 1024, 2048, 0, 64, (bf16*)(ws + WS_PWQ), 0, P.norm_ffn_w, scr, r, lane);
        }
    }
    {
        bf16* SUBK = (bf16*)(ws + WS_SUBK);
        for (int i = (vcu * NWAVES * 64 + tid); i < 16 * 128 * 128 / 4; i += G * NWAVES * 64) {
            const f32x4 v = ((const f32x4*)P.peer_subkeys)[i]; v2u o; o.x = pk2(v.x, v.y); o.y = pk2(v.z, v.w); ((v2u*)SUBK)[i] = o; }
    }
}

constexpr int GL_KS = 0, GL_VS = 33792, GL_KB = 67584, GL_QB = 84992, GL_RAW = 102400, GL_CW = 153856, GL_AMT = 133120, GL_SM = 160000, GL_ATT = 151808, GL_SOL = 67584;
static_assert(GL_CW + 6144 <= GL_SM && GL_SM + 1280 <= MISC_OFF && GL_SOL + 65536 <= GL_AMT && GL_AMT + 17408 <= GL_ATT && GL_ATT + 8192 <= GL_SM && GL_RAW + 51456 <= GL_CW, "gdn_local LDS map");
#ifndef GL_REP_STEP
#define GL_REP_STEP -1
#endif
#define GL_REPF(k) for (int rr_ = 0; rr_ < ((GL_REP_STEP == (k)) ? 2 : 1); ++rr_)
#define GL_BAR() do { asm volatile("s_waitcnt lgkmcnt(0)" ::: "memory"); __builtin_amdgcn_s_barrier(); asm volatile("" ::: "memory"); } while (0)
__device__ __forceinline__ void gdn_local_item(const Params& P, LAS unsigned char* lds, int item, int tid) {
    unsigned char* ws = P.ws;
    asm volatile("" : "+v"(tid));
    const int b = item >> 9, h = (item >> 7) & 3, n = item & 127;
    const int t0 = b * SEQ + n * 64;
    const int lane = tid & 63, wave = __builtin_amdgcn_readfirstlane(tid >> 6);
    LAS float* ks = (LAS float*)(lds + GL_KS);
    LAS float* vs = (LAS float*)(lds + GL_VS);
    LAS bf16* kb16 = (LAS bf16*)(lds + GL_KB);
    LAS bf16* qb16 = (LAS bf16*)(lds + GL_QB);
    LAS bf16* raw = (LAS bf16*)(lds + GL_RAW);
    LAS float* cw = (LAS float*)(lds + GL_CW);
    LAS float* AmT = (LAS float*)(lds + GL_AMT);
    LAS float* sg = (LAS float*)(lds + GL_SM);
    LAS float* sbeta = sg + 64; LAS float* sgc = sbeta + 64; LAS float* seg = sgc + 64; LAS float* sek = seg + 64;
    LAS bf16* atts = (LAS bf16*)(lds + GL_ATT);
    const bf16* QKV = (const bf16*)(ws + WS_QKV);
    const float* AB = (const float*)(ws + WS_AB);
    GL_REPF(0) {
        v4u pr[7];
#pragma unroll
        for (int r = 0; r < 7; ++r) {
            const int id = tid + 512 * r;
            const int row = id / 48, rem = id - row * 48, part = rem >> 4, ck = rem & 15, s = n * 64 + row - 3;
            pr[r] = (v4u){0u, 0u, 0u, 0u};
            if (id < 67 * 48 && s >= 0) pr[r] = *(const v4u*)(QKV + (size_t)(b * SEQ + s) * 1536 + part * 512 + h * 128 + ck * 8);
        }
        f32x4 cwv = (f32x4){0.f, 0.f, 0.f, 0.f};
        if (tid < 384) { const int j = tid / 96, rem = tid - j * 96, part = rem >> 5, c4 = rem & 31; cwv = *(const f32x4*)(P.conv_qkv_w + j * 1536 + part * 512 + h * 128 + c4 * 4); }
        float a_in = 0.f, b_in = 0.f;
        if (tid < 64) { a_in = AB[(size_t)(t0 + tid) * 8 + h]; b_in = AB[(size_t)(t0 + tid) * 8 + 4 + h]; }
#pragma unroll
        for (int r = 0; r < 7; ++r) { const int id = tid + 512 * r; if (id < 67 * 48) *(LAS v4u*)(raw + id * 8) = pr[r]; }
        if (tid < 384) *(LAS f32x4*)(cw + tid * 4) = cwv;
        if (tid < 64) { sg[tid] = -__expf(P.gdn_a_log[h]) * softplusf_(a_in + P.gdn_dt_bias[h]); sbeta[tid] = sigmoidf_(b_in); }
    }
    GL_BAR();
    GL_REPF(1) {
        const int c = tid >> 3, grp = tid & 7;
#pragma unroll 1
        for (int part = 0; part < 3; ++part) {
            float y[16];
#pragma unroll
            for (int i = 0; i < 16; ++i) y[i] = 0.f;
#pragma unroll
            for (int j = 0; j < 4; ++j) {
                const LAS v4u* src = (const LAS v4u*)(raw + (c + j) * 384 + part * 128 + grp * 16);
                const v4u x0 = src[0], x1 = src[1];
                const LAS f32x4* wp = (const LAS f32x4*)(cw + (j * 3 + part) * 128 + grp * 16);
                const f32x4 w0 = wp[0], w1 = wp[1], w2 = wp[2], w3 = wp[3];
                y[0] += w0.x * bflo(x0.x); y[1] += w0.y * bfhi(x0.x); y[2] += w0.z * bflo(x0.y); y[3] += w0.w * bfhi(x0.y);
                y[4] += w1.x * bflo(x0.z); y[5] += w1.y * bfhi(x0.z); y[6] += w1.z * bflo(x0.w); y[7] += w1.w * bfhi(x0.w);
                y[8] += w2.x * bflo(x1.x); y[9] += w2.y * bfhi(x1.x); y[10] += w2.z * bflo(x1.y); y[11] += w2.w * bfhi(x1.y);
                y[12] += w3.x * bflo(x1.z); y[13] += w3.y * bfhi(x1.z); y[14] += w3.z * bflo(x1.w); y[15] += w3.w * bfhi(x1.w);
            }
            float ss = 0.f;
#pragma unroll
            for (int i = 0; i < 16; ++i) { y[i] = siluf_(y[i]); ss += y[i] * y[i]; }
            if (part < 2) {
                ss += __shfl_xor(ss, 1); ss += __shfl_xor(ss, 2); ss += __shfl_xor(ss, 4);
                const float sc = rsqrtf(ss + 1e-6f) * (part == 0 ? 0.08838834764831845f : 1.0f);
#pragma unroll
                for (int i = 0; i < 16; ++i) y[i] *= sc;
            }
            if (part >= 1) {
                LAS float* dst = (part == 1 ? ks : vs) + c * 132 + grp * 16;
#pragma unroll
                for (int i = 0; i < 4; ++i) *(LAS f32x4*)(dst + 4 * i) = (f32x4){y[4 * i], y[4 * i + 1], y[4 * i + 2], y[4 * i + 3]};
            }
            if (part <= 1) {
                LAS bf16* dst = (part == 0 ? qb16 : kb16) + c * 136 + grp * 16;
                v4u o0, o1; o0.x = pk2(y[0], y[1]); o0.y = pk2(y[2], y[3]); o0.z = pk2(y[4], y[5]); o0.w = pk2(y[6], y[7]);
                o1.x = pk2(y[8], y[9]); o1.y = pk2(y[10], y[11]); o1.z = pk2(y[12], y[13]); o1.w = pk2(y[14], y[15]);
                *(LAS v4u*)dst = o0; *(LAS v4u*)(dst + 8) = o1;
            }
        }
    }
    if (tid < 64) {
        float v = sg[tid];
#pragma unroll
        for (int off = 1; off < 64; off <<= 1) { const float t = __shfl_up(v, off); if (tid >= off) v += t; }
        sgc[tid] = v; seg[tid] = __expf(v);
        const float gl = __shfl(v, 63);
        sek[tid] = __expf(gl - v);
        if (tid == 63) ((float*)(ws + WS_DEC))[item] = __expf(v);
    }
    GL_BAR();
    {
        const int mat = wave >> 2, rho = wave & 3, col = lane & 15, g = lane >> 4;
        const LAS bf16* X = mat ? qb16 : kb16;
        bf16x8 af[4];
#pragma unroll
        for (int s = 0; s < 4; ++s) af[s] = *(const LAS bf16x8*)(X + (16 * rho + col) * 136 + 32 * s + 8 * g);
#pragma unroll
        for (int sig = 0; sig < 4; ++sig) {
            f32x4 acc = (f32x4){0.f, 0.f, 0.f, 0.f};
#pragma unroll
            for (int s = 0; s < 4; ++s) { const bf16x8 bfr = *(const LAS bf16x8*)(kb16 + (16 * sig + col) * 136 + 32 * s + 8 * g); acc = __builtin_amdgcn_mfma_f32_16x16x32_bf16(af[s], bfr, acc, 0, 0, 0); }
            const int sidx = 16 * sig + col; const float gs = sgc[sidx];
#pragma unroll
            for (int i = 0; i < 4; ++i) {
                const int c = 16 * rho + 4 * g + i;
                const float dec = (c >= sidx) ? __expf(sgc[c] - gs) : 0.f;
                if (mat == 0) AmT[sidx * 68 + c] = (c > sidx) ? sbeta[c] * acc[i] * dec : 0.f;
                else atts[c * 64 + sidx] = (bf16)f2bf(acc[i] * dec);
            }
        }
    }
    GL_BAR();
    GL_REPF(4) {
        bf16* QD = (bf16*)(ws + WS_QD) + (size_t)item * 8192;
        bf16* KD = (bf16*)(ws + WS_KD) + (size_t)item * 8192;
        bf16* ATT = (bf16*)(ws + WS_ATT) + (size_t)item * 4096;
#pragma unroll
        for (int r = 0; r < 2; ++r) {
            const int id = tid + 512 * r;
            { const int c = id >> 4, gam = id & 15, s32 = gam >> 2, g = gam & 3;
              const v2u lo = *(const LAS v2u*)(qb16 + c * 136 + 32 * s32 + 4 * g), hi = *(const LAS v2u*)(qb16 + c * 136 + 32 * s32 + 16 + 4 * g);
              const float e = seg[c];
              v4u o; o.x = pk2(bflo(lo.x) * e, bfhi(lo.x) * e); o.y = pk2(bflo(lo.y) * e, bfhi(lo.y) * e); o.z = pk2(bflo(hi.x) * e, bfhi(hi.x) * e); o.w = pk2(bflo(hi.y) * e, bfhi(hi.y) * e);
              *(v4u*)(QD + c * 128 + 8 * gam) = o; }
            { const int dk = id >> 3, gam = id & 7, s32 = gam >> 2, g = gam & 3, c0 = 32 * s32 + 4 * g;
              float v[8];
#pragma unroll
              for (int j = 0; j < 4; ++j) { v[j] = ks[(c0 + j) * 132 + dk] * sek[c0 + j]; v[4 + j] = ks[(c0 + 16 + j) * 132 + dk] * sek[c0 + 16 + j]; }
              v4u o; o.x = pk2(v[0], v[1]); o.y = pk2(v[2], v[3]); o.z = pk2(v[4], v[5]); o.w = pk2(v[6], v[7]);
              *(v4u*)(KD + dk * 64 + 8 * gam) = o; }
        }
        { const int c = tid >> 3, gam = tid & 7, s32 = gam >> 2, g = gam & 3;
          const v2u lo = *(const LAS v2u*)(atts + c * 64 + 32 * s32 + 4 * g), hi = *(const LAS v2u*)(atts + c * 64 + 32 * s32 + 16 + 4 * g);
          v4u o; o.x = lo.x; o.y = lo.y; o.z = hi.x; o.w = hi.y;
          *(v4u*)(ATT + c * 64 + 8 * gam) = o; }
    }
    GL_BAR();
    GL_REPF(5) {
        LAS float* xcol = (LAS float*)(lds + GL_SOL);
        LAS bf16* tinv = (LAS bf16*)(lds + GL_SOL + 17408);
        const int j = tid >> 3, part = tid & 7, jb = j >> 4, jo = j & 15;
#pragma unroll 1
        for (int rb = jb; rb < 4; ++rb) {
            float acc[16];
#pragma unroll
            for (int i = 0; i < 16; ++i) acc[i] = 0.f;
            if (rb > jb) {
#pragma unroll 2
                for (int s = 16 * jb + part; s < 16 * rb; s += 8) {
                    const float sv = xcol[j * 68 + s];
                    const LAS float* ar = AmT + s * 68 + 16 * rb;
#pragma unroll
                    for (int q = 0; q < 4; ++q) { const f32x4 A4 = *(const LAS f32x4*)(ar + 4 * q);
                        acc[4 * q] -= A4.x * sv; acc[4 * q + 1] -= A4.y * sv; acc[4 * q + 2] -= A4.z * sv; acc[4 * q + 3] -= A4.w * sv; }
                }
#pragma unroll
                for (int i = 0; i < 16; ++i) {
                    acc[i] += __builtin_bit_cast(float, __builtin_amdgcn_update_dpp(0, __builtin_bit_cast(int, acc[i]), 0xB1, 0xF, 0xF, true));
                    acc[i] += __builtin_bit_cast(float, __builtin_amdgcn_update_dpp(0, __builtin_bit_cast(int, acc[i]), 0x4E, 0xF, 0xF, true));
                    acc[i] += __builtin_bit_cast(float, __builtin_amdgcn_update_dpp(0, __builtin_bit_cast(int, acc[i]), 0x141, 0xF, 0xF, true));
                }
            } else {
#pragma unroll
                for (int i = 0; i < 16; ++i) acc[i] = (i == jo) ? 1.f : 0.f;
            }
#pragma unroll
            for (int i = 0; i < 16; ++i) {
                const float sv = acc[i];
                const LAS float* ar = AmT + (16 * rb + i) * 68 + 16 * rb;
#pragma unroll
                for (int q = (i + 1) / 4; q < 4; ++q) { const f32x4 A4 = *(const LAS f32x4*)(ar + 4 * q);
                    if (4 * q > i) acc[4 * q] -= A4.x * sv; if (4 * q + 1 > i) acc[4 * q + 1] -= A4.y * sv; if (4 * q + 2 > i) acc[4 * q + 2] -= A4.z * sv; if (4 * q + 3 > i) acc[4 * q + 3] -= A4.w * sv; }
            }
            if (part == 0) {
#pragma unroll
                for (int i = 0; i < 16; ++i) { xcol[j * 68 + 16 * rb + i] = acc[i]; tinv[(16 * rb + i) * 72 + j] = (bf16)f2bf(acc[i]); }
            }
            LDS_WAIT(); asm volatile("" ::: "memory");
        }
        for (int rb = 0; rb < jb; ++rb) {
            if (part == 0) {
#pragma unroll
                for (int i = 0; i < 16; ++i) tinv[(16 * rb + i) * 72 + j] = (bf16)0;
            }
        }
    }
    GL_BAR();
    GL_REPF(6) {
        const LAS bf16* tinv = (const LAS bf16*)(lds + GL_SOL + 17408);
        LAS bf16* wst = (LAS bf16*)(lds + GL_SOL + 17408 + 9216);
        const int col = lane & 15, g = lane >> 4, isw = wave >> 2;
        bf16x8 af[4][2];
#pragma unroll
        for (int rho = 0; rho < 4; ++rho)
#pragma unroll
            for (int s2 = 0; s2 < 2; ++s2) af[rho][s2] = *(const LAS bf16x8*)(tinv + (16 * rho + col) * 72 + 32 * s2 + 8 * g);
        bf16* UF = (bf16*)(ws + WS_UF) + (size_t)item * 8192;
#pragma unroll
        for (int sig = 0; sig < 2; ++sig) {
            const int jj = 32 * (wave & 3) + 16 * sig + col;
            const LAS float* src = (isw ? ks : vs) + jj;
            bf16x8 bfr[2];
#pragma unroll
            for (int s2 = 0; s2 < 2; ++s2) {
                float v[8];
#pragma unroll
                for (int e = 0; e < 8; ++e) { const int sidx = 32 * s2 + 8 * g + e; float x = src[sidx * 132] * sbeta[sidx]; if (isw) x *= seg[sidx]; v[e] = x; }
                v4u pk; pk.x = pk2(v[0], v[1]); pk.y = pk2(v[2], v[3]); pk.z = pk2(v[4], v[5]); pk.w = pk2(v[6], v[7]);
                bfr[s2] = __builtin_bit_cast(bf16x8, pk);
            }
            f32x4 acc[4];
#pragma unroll
            for (int rho = 0; rho < 4; ++rho) { acc[rho] = (f32x4){0.f, 0.f, 0.f, 0.f};
#pragma unroll
                for (int s2 = 0; s2 < 2; ++s2) acc[rho] = __builtin_amdgcn_mfma_f32_16x16x32_bf16(af[rho][s2], bfr[s2], acc[rho], 0, 0, 0); }
            if (!isw) {
                v4u o0, o1;
                o0.x = pk2(acc[0].x, acc[0].y); o0.y = pk2(acc[0].z, acc[0].w); o0.z = pk2(acc[1].x, acc[1].y); o0.w = pk2(acc[1].z, acc[1].w);
                o1.x = pk2(acc[2].x, acc[2].y); o1.y = pk2(acc[2].z, acc[2].w); o1.z = pk2(acc[3].x, acc[3].y); o1.w = pk2(acc[3].z, acc[3].w);
                v4u* d = (v4u*)(UF + (size_t)(2 * (wave & 3) + sig) * 1024 + lane * 16);
                d[0] = o0; d[1] = o1;
            } else {
#pragma unroll
                for (int rho = 0; rho < 4; ++rho)
#pragma unroll
                    for (int i = 0; i < 4; ++i) wst[(16 * rho + 4 * g + i) * 136 + jj] = (bf16)f2bf(-acc[rho][i]);
            }
        }
    }
    GL_BAR();
    {
        const LAS bf16* wst = (const LAS bf16*)(lds + GL_SOL + 17408 + 9216);
        bf16* WN = (bf16*)(ws + WS_WN) + (size_t)item * 8192;
#pragma unroll
        for (int r = 0; r < 2; ++r) {
            const int id = tid + 512 * r, c = id >> 4, gam = id & 15, s32 = gam >> 2, g = gam & 3;
            const v2u lo = *(const LAS v2u*)(wst + c * 136 + 32 * s32 + 4 * g), hi = *(const LAS v2u*)(wst + c * 136 + 32 * s32 + 16 + 4 * g);
            v4u o; o.x = lo.x; o.y = lo.y; o.z = hi.x; o.w = hi.y;
            *(v4u*)(WN + c * 128 + 8 * gam) = o;
        }
    }
    GL_BAR();
}

__device__ __forceinline__ void lru_local_item(const Params& P, LAS unsigned char* lds, int lt, int tid, int lane, int wave) {
    unsigned char* ws = P.ws;
    const int b = lt >> 7, n = lt & 127, t0 = b * SEQ + n * 64;
    LAS float* xc = (LAS float*)lds;
    const bf16* XR = (const bf16*)(ws + WS_XR);
    {
        const int ch = tid;
        const float w0 = P.lru_conv_w[ch], w1 = P.lru_conv_w[512 + ch], w2 = P.lru_conv_w[1024 + ch], w3 = P.lru_conv_w[1536 + ch], cb = P.lru_conv_b[ch];
        float x0 = 0.f, x1 = 0.f, x2 = 0.f;
        if (n > 0) { x0 = bf1(XR[(size_t)(t0 - 3) * 512 + ch]); x1 = bf1(XR[(size_t)(t0 - 2) * 512 + ch]); x2 = bf1(XR[(size_t)(t0 - 1) * 512 + ch]); }
#pragma unroll 8
        for (int c = 0; c < 64; ++c) { const float x3 = bf1(XR[(size_t)(t0 + c) * 512 + ch]);
            xc[c * 516 + ch] = (w0 * x0 + w1 * x1) + (w2 * x2 + w3 * x3) + cb; x0 = x1; x1 = x2; x2 = x3; }
    }
    __syncthreads();
    {
        const int g = wave, ch = g * 64 + lane;
        float wa[64], wx[64];
        const float* wap = P.lru_wa + (size_t)g * 4096 + lane; const float* wxp = P.lru_wx + (size_t)g * 4096 + lane;
        asm volatile("" : "+v"(wap), "+v"(wxp));
#pragma unroll
        for (int i = 0; i < 64; ++i) { wa[i] = wap[i * 64]; wx[i] = wxp[i * 64]; }
        const float ba = P.lru_ba[ch], bx = P.lru_bx[ch], sp = softplusf_(-P.lru_lambda[ch]);
        bf16* HLOC = (bf16*)(ws + WS_HLOC); bf16* PCUM = (bf16*)(ws + WS_PCUM);
        float hst = 0.f, pc = 1.f;
#pragma unroll 1
        for (int c = 0; c < 64; ++c) {
            float ra = ba, ri = bx;
            const LAS float* xrow = xc + c * 516 + g * 64;
#pragma unroll
            for (int i4 = 0; i4 < 16; ++i4) { const f32x4 x4 = *(const LAS f32x4*)(xrow + 4 * i4);
                ra += x4.x * wa[4 * i4]; ra += x4.y * wa[4 * i4 + 1]; ra += x4.z * wa[4 * i4 + 2]; ra += x4.w * wa[4 * i4 + 3];
                ri += x4.x * wx[4 * i4]; ri += x4.y * wx[4 * i4 + 1]; ri += x4.z * wx[4 * i4 + 2]; ri += x4.w * wx[4 * i4 + 3];
                if ((i4 & 3) == 3) asm volatile("" ::: "memory"); }
            const float r = sigmoidf_(ra), ig = sigmoidf_(ri);
            const float log_a = -8.0f * r * sp;
            const float a = __expf(log_a);
            const float xo = xrow[lane];
            const float bt = sqrtf(fmaxf(-expm1f(2.0f * log_a), 0.f)) * (ig * xo);
            hst = a * hst + bt; pc *= a;
            HLOC[(size_t)(t0 + c) * 512 + ch] = (bf16)f2bf(hst); PCUM[(size_t)(t0 + c) * 512 + ch] = (bf16)f2bf(pc);
        }
        ((float*)(ws + WS_HEND))[(size_t)lt * 512 + ch] = hst; ((float*)(ws + WS_PEND))[(size_t)lt * 512 + ch] = pc;
    }
    __syncthreads();
}

constexpr int SC_WN = 0, SC_QD = 64 * 272, SC_KD = 2 * 64 * 272, SC_ATT = 2 * 64 * 272 + 128 * 144, SC_BUF = 2 * 64 * 272 + 128 * 144 + 64 * 144;
constexpr int SC_SSQ = 2 * SC_BUF;
__device__ __forceinline__ int sc_lds_off(int id) {
    if (id < 1024) return SC_WN + (id >> 4) * 272 + (id & 15) * 16;
    if (id < 2048) { const int q = id - 1024; return SC_QD + (q >> 4) * 272 + (q & 15) * 16; }
    if (id < 3072) { const int q = id - 2048; return SC_KD + (q >> 3) * 144 + (q & 7) * 16; }
    const int q = id - 3072; return SC_ATT + (q >> 3) * 144 + (q & 7) * 16;
}
__device__ __forceinline__ const v4u* sc_src(const unsigned char* ws, int item, int id) {
    if (id < 1024) return (const v4u*)(ws + WS_WN + (size_t)item * 16384) + id;
    if (id < 2048) return (const v4u*)(ws + WS_QD + (size_t)item * 16384) + (id - 1024);
    if (id < 3072) return (const v4u*)(ws + WS_KD + (size_t)item * 16384) + (id - 2048);
    return (const v4u*)(ws + WS_ATT + (size_t)item * 8192) + (id - 3072);
}
__device__ __forceinline__ bf16x8 pack_b(const f32x4 a, const f32x4 b) {
    v4u r; r.x = pk2(a.x, a.y); r.y = pk2(a.z, a.w); r.z = pk2(b.x, b.y); r.w = pk2(b.z, b.w);
    return __builtin_bit_cast(bf16x8, r);
}
#define SC_BAR() do { asm volatile("s_waitcnt lgkmcnt(0)" ::: "memory"); __builtin_amdgcn_s_barrier(); asm volatile("" ::: "memory"); } while (0)
#define SC_GLD(dst, ptr) asm volatile("global_load_dwordx4 %0, %1, off" : "=v"(dst) : "v"(ptr) : "memory")
#define PIN8(a) asm volatile("" : "+v"(a[0]), "+v"(a[1]), "+v"(a[2]), "+v"(a[3]), "+v"(a[4]), "+v"(a[5]), "+v"(a[6]), "+v"(a[7]))
#define PIN16(a) asm volatile("" : "+v"(a[0]), "+v"(a[1]), "+v"(a[2]), "+v"(a[3]), "+v"(a[4]), "+v"(a[5]), "+v"(a[6]), "+v"(a[7]), "+v"(a[8]), "+v"(a[9]), "+v"(a[10]), "+v"(a[11]), "+v"(a[12]), "+v"(a[13]), "+v"(a[14]), "+v"(a[15]))
constexpr int SCAN_NWC = 2, SCAN_PARTS = 4, SCAN_WGS = 8 * SCAN_PARTS;
constexpr int SC_UFS = 2 * SC_BUF;
constexpr int SC_DECS = SC_UFS + 2 * SCAN_NWC * 2048;
constexpr int SC_OT = SC_DECS + 512;
constexpr int SC_END = SC_OT + 2 * 64 * 36 * 4;
static_assert(SC_END <= MISC_OFF, "scan LDS");
#ifndef SCAN_REPS
#define SCAN_REPS 1
#endif
#ifndef SCAN_EXP
#define SCAN_EXP 0
#endif
__device__ __forceinline__ int sc3_lds_off(int id) {
    if (id < 3584) return sc_lds_off(id);
    return SC_UFS + (id - 3584) * 16;
}
__device__ __forceinline__ const v4u* sc3_src(const unsigned char* ws, int item, int id, int part) {
    if (id < 3584) return sc_src(ws, item, id);
    return (const v4u*)(ws + WS_UF + (size_t)item * 16384 + (size_t)(part * SCAN_NWC) * 2048) + (id - 3584);
}
__device__ __forceinline__ void gdn_scan(const Params& P, LAS unsigned char* lds, int sb, int tid, int lane, int wave) {
    const unsigned char* ws = P.ws;
    constexpr int NCH = 128 * SCAN_REPS, NPC = 15;
    const int bh = sb & 7, part = sb >> 3;
    const int b = bh >> 2, h = bh & 3, col = lane & 15, g = lane >> 4;
    const int item0 = bh * 128;
    const float* DEC = (const float*)(ws + WS_DEC);
    if (wave >= 4) {
        constexpr int NP = 15, DEP = 3;
        const int lt = tid - 256;
        const unsigned voff = (unsigned)lt * 16u;
        const int lA = (lt >> 4) * 272 + (lt & 15) * 16, lB = (lt >> 3) * 144 + (lt & 7) * 16, lU = SC_UFS + lt * 16;
        v4u rs[DEP][NP];
#define SC_ISSUE(set, itm) do { const unsigned char* gq_ = ws + (size_t)(itm) * 16384; const unsigned char* ga_ = ws + WS_ATT + (size_t)(itm) * 8192; \
            asm volatile("s_nop 4\n\tglobal_load_dwordx4 %0, %8, %9\n\tglobal_load_dwordx4 %1, %8, %10\n\tglobal_load_dwordx4 %2, %8, %11\n\tglobal_load_dwordx4 %3, %8, %12\n\t" \
                         "global_load_dwordx4 %4, %8, %13\n\tglobal_load_dwordx4 %5, %8, %14\n\tglobal_load_dwordx4 %6, %8, %15\n\tglobal_load_dwordx4 %7, %8, %16" \
                : "=&v"(rs[set][0]), "=&v"(rs[set][1]), "=&v"(rs[set][2]), "=&v"(rs[set][3]), "=&v"(rs[set][4]), "=&v"(rs[set][5]), "=&v"(rs[set][6]), "=&v"(rs[set][7]) \
                : "v"(voff), "s"(gq_ + WS_WN), "s"(gq_ + WS_WN + 4096), "s"(gq_ + WS_WN + 8192), "s"(gq_ + WS_WN + 12288), \
                  "s"(gq_ + WS_QD), "s"(gq_ + WS_QD + 4096), "s"(gq_ + WS_QD + 8192), "s"(gq_ + WS_QD + 12288) : "memory"); \
            asm volatile("s_nop 4\n\tglobal_load_dwordx4 %0, %7, %8\n\tglobal_load_dwordx4 %1, %7, %9\n\tglobal_load_dwordx4 %2, %7, %10\n\tglobal_load_dwordx4 %3, %7, %11\n\t" \
                         "global_load_dwordx4 %4, %7, %12\n\tglobal_load_dwordx4 %5, %7, %13\n\tglobal_load_dwordx4 %6, %7, %14" \
                : "=&v"(rs[set][8]), "=&v"(rs[set][9]), "=&v"(rs[set][10]), "=&v"(rs[set][11]), "=&v"(rs[set][12]), "=&v"(rs[set][13]), "=&v"(rs[set][14]) \
                : "v"(voff), "s"(gq_ + WS_KD), "s"(gq_ + WS_KD + 4096), "s"(gq_ + WS_KD + 8192), "s"(gq_ + WS_KD + 12288), \
                  "s"(ga_), "s"(ga_ + 4096), "s"(gq_ + WS_UF + (size_t)(part * SCAN_NWC) * 2048) : "memory"); } while (0)
#define SC_WAITSET(set, cnt) asm volatile("s_waitcnt " cnt : "+v"(rs[set][0]), "+v"(rs[set][1]), "+v"(rs[set][2]), "+v"(rs[set][3]), "+v"(rs[set][4]), "+v"(rs[set][5]), "+v"(rs[set][6]), "+v"(rs[set][7]), \
            "+v"(rs[set][8]), "+v"(rs[set][9]), "+v"(rs[set][10]), "+v"(rs[set][11]), "+v"(rs[set][12]), "+v"(rs[set][13]), "+v"(rs[set][14]) :: "memory")
#define SC_WRITE(set, par) do { LAS unsigned char* wb_ = lds + (par) * SC_BUF; \
            _Pragma("unroll") for (int r = 0; r < 4; ++r) { *(LAS v4u*)(wb_ + SC_WN + lA + r * (16 * 272)) = rs[set][r]; *(LAS v4u*)(wb_ + SC_QD + lA + r * (16 * 272)) = rs[set][4 + r]; \
                                                          *(LAS v4u*)(wb_ + SC_KD + lB + r * (32 * 144)) = rs[set][8 + r]; } \
            *(LAS v4u*)(wb_ + SC_ATT + lB) = rs[set][12]; *(LAS v4u*)(wb_ + SC_ATT + lB + 32 * 144) = rs[set][13]; \
            *(LAS v4u*)(lds + lU + (par) * (SCAN_NWC * 2048)) = rs[set][14]; } while (0)
        {
#pragma unroll
            for (int r = 0; r < NP; ++r) { const int id = lt + 256 * r; *(LAS v4u*)(lds + sc3_lds_off(id)) = *sc3_src(ws, item0, id, part); }
            if (lt < 128) ((LAS float*)(lds + SC_DECS))[lt] = DEC[item0 + lt];
            asm volatile("s_waitcnt vmcnt(0)" ::: "memory");
        }
        SC_ISSUE(1, item0 + 1); SC_ISSUE(2, item0 + 2); SC_ISSUE(0, item0 + 3);
        SC_BAR();
        int n2 = 0;
#define SC_INTERVAL(set) do { SC_WAITSET(set, "vmcnt(30)"); SC_WRITE(set, (n2 + 1) & 1); SC_WAITSET(set, "lgkmcnt(0)"); SC_ISSUE(set, item0 + ((n2 + 1 + DEP) & 127)); SC_BAR(); ++n2; } while (0)
#pragma unroll 1
        for (int it = 0; it < NCH / 3; ++it) { SC_INTERVAL(1); SC_INTERVAL(2); SC_INTERVAL(0); }
        if (NCH % 3 >= 1) SC_INTERVAL(1);
        if (NCH % 3 >= 2) SC_INTERVAL(2);
        SC_WAITSET(0, "vmcnt(0)"); SC_WAITSET(1, "vmcnt(0)"); SC_WAITSET(2, "vmcnt(0)");
#undef SC_INTERVAL
#undef SC_WRITE
#undef SC_WAITSET
#undef SC_ISSUE
        return;
    }
    if (wave == 3) {
        SC_BAR();
#pragma unroll 1
        for (int n2 = 0; n2 < NCH; ++n2) SC_BAR();
        return;
    }
    if (wave == 2) {
        const int row = lane;
        bf16* Y = (bf16*)(P.ws + WS_Y);
        float* SSQG = P.out;
        SC_BAR();
#pragma unroll 1
        for (int n2 = 0; n2 <= NCH; ++n2) {
            if (n2 > 0) {
                const int n = (n2 - 1) & 127, t = b * SEQ + n * 64 + row;
                const LAS float* src = (const LAS float*)(lds + SC_OT + ((n2 - 1) & 1) * (64 * 36 * 4)) + row * 36;
                f32x4 a[8]; float s2 = 0.f;
#pragma unroll
                for (int q = 0; q < 8; ++q) { a[q] = *(const LAS f32x4*)(src + 4 * q); s2 += (a[q].x * a[q].x + a[q].y * a[q].y) + (a[q].z * a[q].z + a[q].w * a[q].w); }
                SSQG[(size_t)t * 32 + h * 8 + part] = s2;
                v4u* d = (v4u*)(Y + (size_t)t * 1024 + h * 128 + 32 * part);
#pragma unroll
                for (int q = 0; q < 4; ++q) { v4u o; o.x = pk2(a[2 * q].x, a[2 * q].y); o.y = pk2(a[2 * q].z, a[2 * q].w); o.z = pk2(a[2 * q + 1].x, a[2 * q + 1].y); o.w = pk2(a[2 * q + 1].z, a[2 * q + 1].w); d[q] = o; }
            }
            if (n2 < NCH) SC_BAR();
        }
        return;
    }
    f32x4 S[8];
#pragma unroll
    for (int i = 0; i < 8; ++i) S[i] = (f32x4){0.f, 0.f, 0.f, 0.f};
    SC_BAR();
#pragma unroll 1
    for (int n2 = 0; n2 < NCH; ++n2) {
        if (SCAN_REPS > 1 && (n2 & 127) == 0) {
#pragma unroll
            for (int i = 0; i < 8; ++i) S[i] = (f32x4){0.f, 0.f, 0.f, 0.f};
        }
        if (SCAN_EXP == 2 && n2 < 128) { SC_BAR(); continue; }
        const int par = n2 & 1;
        LAS unsigned char* buf = lds + par * SC_BUF;
        bf16x8 fA[16], fB[16], fC[16], fD[8];
#pragma unroll
        for (int rho = 0; rho < 4; ++rho)
#pragma unroll
            for (int s = 0; s < 4; ++s) fA[rho * 4 + s] = *(const LAS bf16x8*)(buf + SC_WN + (16 * rho + col) * 272 + (32 * s + 8 * g) * 2);
#pragma unroll
        for (int rho = 0; rho < 4; ++rho)
#pragma unroll
            for (int s = 0; s < 4; ++s) fB[rho * 4 + s] = *(const LAS bf16x8*)(buf + SC_QD + (16 * rho + col) * 272 + (32 * s + 8 * g) * 2);
        const LAS v4u* ufp = (const LAS v4u*)(lds + SC_UFS + par * (SCAN_NWC * 2048) + wave * 2048 + lane * 32);
        const v4u uf0 = ufp[0], uf1 = ufp[1];
        const float dec = ((const LAS float*)(lds + SC_DECS))[n2 & 127];
        bf16x8 Bs[4];
#pragma unroll
        for (int s = 0; s < 4; ++s) Bs[s] = pack_b(S[2 * s], S[2 * s + 1]);
        f32x4 Vn[4], Oc[4];
        Vn[0] = (f32x4){bflo(uf0.x), bfhi(uf0.x), bflo(uf0.y), bfhi(uf0.y)}; Vn[1] = (f32x4){bflo(uf0.z), bfhi(uf0.z), bflo(uf0.w), bfhi(uf0.w)};
        Vn[2] = (f32x4){bflo(uf1.x), bfhi(uf1.x), bflo(uf1.y), bfhi(uf1.y)}; Vn[3] = (f32x4){bflo(uf1.z), bfhi(uf1.z), bflo(uf1.w), bfhi(uf1.w)};
        __builtin_amdgcn_sched_barrier(0);
        PIN16(fA);
#pragma unroll
        for (int s = 0; s < 4; ++s)
#pragma unroll
            for (int rho = 0; rho < 4; ++rho) Vn[rho] = __builtin_amdgcn_mfma_f32_16x16x32_bf16(fA[rho * 4 + s], Bs[s], Vn[rho], 0, 0, 0);
        __builtin_amdgcn_sched_barrier(0);
#pragma unroll
        for (int tau = 0; tau < 8; ++tau)
#pragma unroll
            for (int s = 0; s < 2; ++s) fC[tau * 2 + s] = *(const LAS bf16x8*)(buf + SC_KD + (16 * tau + col) * 144 + (32 * s + 8 * g) * 2);
        __builtin_amdgcn_sched_barrier(0);
        PIN16(fB);
#pragma unroll
        for (int rho = 0; rho < 4; ++rho) Oc[rho] = (f32x4){0.f, 0.f, 0.f, 0.f};
#pragma unroll
        for (int s = 0; s < 4; ++s)
#pragma unroll
            for (int rho = 0; rho < 4; ++rho) Oc[rho] = __builtin_amdgcn_mfma_f32_16x16x32_bf16(fB[rho * 4 + s], Bs[s], Oc[rho], 0, 0, 0);
        __builtin_amdgcn_sched_barrier(0);
#pragma unroll
        for (int rho = 0; rho < 4; ++rho)
#pragma unroll
            for (int s = 0; s < 2; ++s) fD[rho * 2 + s] = *(const LAS bf16x8*)(buf + SC_ATT + (16 * rho + col) * 144 + (32 * s + 8 * g) * 2);
        bf16x8 Bv[2];
        Bv[0] = pack_b(Vn[0], Vn[1]); Bv[1] = pack_b(Vn[2], Vn[3]);
#pragma unroll
        for (int tau = 0; tau < 8; ++tau) S[tau] = S[tau] * dec;
        __builtin_amdgcn_sched_barrier(0);
        PIN16(fC);
#pragma unroll
        for (int s = 0; s < 2; ++s)
#pragma unroll
            for (int tau = 0; tau < 8; ++tau) S[tau] = __builtin_amdgcn_mfma_f32_16x16x32_bf16(fC[tau * 2 + s], Bv[s], S[tau], 0, 0, 0);
        __builtin_amdgcn_sched_barrier(0);
        PIN8(fD);
#pragma unroll
        for (int s = 0; s < 2; ++s)
#pragma unroll
            for (int rho = 0; rho < 4; ++rho) Oc[rho] = __builtin_amdgcn_mfma_f32_16x16x32_bf16(fD[rho * 2 + s], Bv[s], Oc[rho], 0, 0, 0);
        LAS float* ot = (LAS float*)(lds + SC_OT + par * (64 * 36 * 4)) + 16 * wave + col;
#pragma unroll
        for (int rho = 0; rho < 4; ++rho)
#pragma unroll
            for (int i = 0; i < 4; ++i) ot[(16 * rho + 4 * g + i) * 36] = Oc[rho][i];
        SC_BAR();
    }
}

__device__ __forceinline__ void lru_carry(const Params& P, int gwv, int lane) {
    unsigned char* ws = P.ws;
    const int b = gwv >> 3, g = gwv & 7, ch = g * 64 + lane;
    const float* HEND = (const float*)(ws + WS_HEND); const float* PEND = (const float*)(ws + WS_PEND); float* HIN = (float*)(ws + WS_HIN);
    float hin = 0.f;
#pragma unroll 1
    for (int n0 = 0; n0 < 128; n0 += 16) {
        float he[16], pe[16];
#pragma unroll
        for (int i = 0; i < 16; ++i) { const size_t o = (size_t)(b * 128 + n0 + i) * 512 + ch; he[i] = HEND[o]; pe[i] = PEND[o]; }
#pragma unroll
        for (int i = 0; i < 16; ++i) { HIN[(size_t)(b * 128 + n0 + i) * 512 + ch] = hin; hin = he[i] + pe[i] * hin; }
    }
}

__device__ __forceinline__ void cvt_table(const float* src, bf16* dst, size_t n8, size_t wi, size_t nw) {
    for (size_t i = wi; i < n8; i += nw) {
        const f32x4 a = ((const f32x4*)src)[2 * i], c = ((const f32x4*)src)[2 * i + 1];
        v4u o; o.x = pk2(a.x, a.y); o.y = pk2(a.z, a.w); o.z = pk2(c.x, c.y); o.w = pk2(c.z, c.w);
        ((v4u*)dst)[i] = o;
    }
}

__device__ __forceinline__ void lru_combine(const Params& P, size_t wi, size_t nw) {
    unsigned char* ws = P.ws;
    const v4u* HLOC = (const v4u*)(ws + WS_HLOC); const v4u* PCUM = (const v4u*)(ws + WS_PCUM); const v4u* GATE = (const v4u*)(ws + WS_GATE);
    const float* HIN = (const float*)(ws + WS_HIN); bf16* Y = (bf16*)(ws + WS_Y);
    for (size_t i = wi; i < (size_t)T * 64; i += nw) {
        const size_t t = i >> 6; const int ch0 = (int)(i & 63) * 8;
        const v4u hl = HLOC[i], pc = PCUM[i], gt = GATE[i];
        const f32x4 h0 = *(const f32x4*)(HIN + (t >> 6) * 512 + ch0), h1 = *(const f32x4*)(HIN + (t >> 6) * 512 + ch0 + 4);
        float y[8];
        y[0] = (bflo(hl.x) + bflo(pc.x) * h0.x) * gelu_tanh(bflo(gt.x)); y[1] = (bfhi(hl.x) + bfhi(pc.x) * h0.y) * gelu_tanh(bfhi(gt.x));
        y[2] = (bflo(hl.y) + bflo(pc.y) * h0.z) * gelu_tanh(bflo(gt.y)); y[3] = (bfhi(hl.y) + bfhi(pc.y) * h0.w) * gelu_tanh(bfhi(gt.y));
        y[4] = (bflo(hl.z) + bflo(pc.z) * h1.x) * gelu_tanh(bflo(gt.z)); y[5] = (bfhi(hl.z) + bfhi(pc.z) * h1.y) * gelu_tanh(bfhi(gt.z));
        y[6] = (bflo(hl.w) + bflo(pc.w) * h1.z) * gelu_tanh(bflo(gt.w)); y[7] = (bfhi(hl.w) + bfhi(pc.w) * h1.w) * gelu_tanh(bfhi(gt.w));
        v4u o; o.x = pk2(y[0], y[1]); o.y = pk2(y[2], y[3]); o.z = pk2(y[4], y[5]); o.w = pk2(y[6], y[7]);
        *(v4u*)(Y + t * 1024 + 512 + ch0) = o;
    }
}

__device__ __forceinline__ void gdn_gate_norm(const Params& P, size_t wi, size_t nw) {
    unsigned char* ws = P.ws;
    bf16* Y = (bf16*)(ws + WS_Y); const v4u* Z = (const v4u*)(ws + WS_Z); const float* SSQG = P.out;
    for (size_t i = wi; i < (size_t)T * 64; i += nw) {
        const size_t t = i >> 6; const int c0 = (int)(i & 63) * 8, h = c0 >> 7;
        const f32x4 q0 = *(const f32x4*)(SSQG + t * 32 + h * 8);
        const float rstd = rsqrtf(((q0.x + q0.y) + (q0.z + q0.w)) * (1.0f / 128.0f) + 1e-6f);
        const v4u o = *(const v4u*)(Y + t * 1024 + c0), z = Z[i];
        const f32x4 w0 = *(const f32x4*)(P.gdn_norm_w + (c0 & 127)), w1 = *(const f32x4*)(P.gdn_norm_w + (c0 & 127) + 4);
        float y[8];
        y[0] = bflo(o.x) * rstd * w0.x * siluf_(bflo(z.x)); y[1] = bfhi(o.x) * rstd * w0.y * siluf_(bfhi(z.x));
        y[2] = bflo(o.y) * rstd * w0.z * siluf_(bflo(z.y)); y[3] = bfhi(o.y) * rstd * w0.w * siluf_(bfhi(z.y));
        y[4] = bflo(o.z) * rstd * w1.x * siluf_(bflo(z.z)); y[5] = bfhi(o.z) * rstd * w1.y * siluf_(bfhi(z.z));
        y[6] = bflo(o.w) * rstd * w1.z * siluf_(bflo(z.w)); y[7] = bfhi(o.w) * rstd * w1.w * siluf_(bfhi(z.w));
        v4u r; r.x = pk2(y[0], y[1]); r.y = pk2(y[2], y[3]); r.z = pk2(y[4], y[5]); r.w = pk2(y[6], y[7]);
        *(v4u*)(Y + t * 1024 + c0) = r;
    }
}

__device__ __forceinline__ void xattn_stage(LAS unsigned char* lds, const bf16* src, int tid) {
    v4u tmp[16];
#pragma unroll
    for (int r = 0; r < 16; ++r) tmp[r] = *(const v4u*)(src + (size_t)(tid + 512 * r) * 8);
#pragma unroll
    for (int r = 0; r < 16; ++r) { const int id = tid + 512 * r; *(LAS v4u*)(lds + (id >> 5) * 528 + (id & 31) * 16) = tmp[r]; }
}
__device__ __forceinline__ void xattn_unit(const Params& P, LAS unsigned char* lds, int unit, int tid, int lane, int wave) {
    const unsigned char* ws = P.ws;
    const int h = unit & 3, qb = (unit >> 2) & 63, b = unit >> 8, col = lane & 15, g = lane >> 4;
    const int tw = b * SEQ + qb * 128 + 16 * wave;
    const bf16* Kb = (const bf16*)(ws + WS_KB) + (size_t)((b * 4 + h) * 256) * 256;
    const bf16* Vt = (const bf16*)(ws + WS_VTP) + (size_t)((b * 4 + h) * 256) * 256;
    xattn_stage(lds, Kb, tid);
    __syncthreads();
    const LAS unsigned char* arow = lds + col * 528 + g * 16;
    bf16x8 Bp[1][8]; float inv[1];
#pragma unroll
    for (int ps = 0; ps < 1; ++ps) {
        const bf16* Q = (const bf16*)(ws + WS_Q) + (size_t)(tw + 16 * ps + col) * 1024 + h * 256 + 8 * g;
        bf16x8 Bq[8];
#pragma unroll
        for (int s = 0; s < 8; ++s) Bq[s] = *(const bf16x8*)(Q + 32 * s);
        f32x4 St[16];
        bf16x8 fr[2][8];
#pragma unroll
        for (int s = 0; s < 8; ++s) fr[0][s] = *(const LAS bf16x8*)(arow + 64 * s);
#pragma unroll
        for (int kap = 0; kap < 16; ++kap) {
            if (kap + 1 < 16) {
#pragma unroll
                for (int s = 0; s < 8; ++s) fr[(kap + 1) & 1][s] = *(const LAS bf16x8*)(arow + (16 * (kap + 1)) * 528 + 64 * s);
            }
            __builtin_amdgcn_sched_barrier(0);
            PIN8(fr[kap & 1]);
            f32x4 acc = (f32x4){0.f, 0.f, 0.f, 0.f};
#pragma unroll
            for (int s = 0; s < 8; ++s) acc = __builtin_amdgcn_mfma_f32_16x16x32_bf16(fr[kap & 1][s], Bq[s], acc, 0, 0, 0);
            St[kap] = acc;
            __builtin_amdgcn_sched_barrier(0);
        }
        float mx = -3.0e38f;
#pragma unroll
        for (int kap = 0; kap < 16; ++kap) mx = fmaxf(fmaxf(fmaxf(St[kap].x, St[kap].y), fmaxf(St[kap].z, St[kap].w)), mx);
        mx = fmaxf(mx, __shfl_xor(mx, 16)); mx = fmaxf(mx, __shfl_xor(mx, 32));
        float l = 0.f;
#pragma unroll
        for (int kap = 0; kap < 16; ++kap) { St[kap].x = __expf(St[kap].x - mx); St[kap].y = __expf(St[kap].y - mx); St[kap].z = __expf(St[kap].z - mx); St[kap].w = __expf(St[kap].w - mx);
            l += (St[kap].x + St[kap].y) + (St[kap].z + St[kap].w); }
        l += __shfl_xor(l, 16); l += __shfl_xor(l, 32);
        inv[ps] = 1.0f / l;
#pragma unroll
        for (int s = 0; s < 8; ++s) Bp[ps][s] = pack_b(St[2 * s], St[2 * s + 1]);
    }
    __syncthreads();
    xattn_stage(lds, Vt, tid);
    __syncthreads();
#pragma unroll
    for (int ps = 0; ps < 1; ++ps) {
        bf16* AO = (bf16*)(P.ws + WS_AO) + (size_t)(tw + 16 * ps + col) * 1024 + h * 256 + 4 * g;
        bf16x8 fr[2][8];
#pragma unroll
        for (int s = 0; s < 8; ++s) fr[0][s] = *(const LAS bf16x8*)(arow + 64 * s);
#pragma unroll
        for (int del = 0; del < 16; ++del) {
            if (del + 1 < 16) {
#pragma unroll
                for (int s = 0; s < 8; ++s) fr[(del + 1) & 1][s] = *(const LAS bf16x8*)(arow + (16 * (del + 1)) * 528 + 64 * s);
            }
            __builtin_amdgcn_sched_barrier(0);
            PIN8(fr[del & 1]);
            f32x4 acc = (f32x4){0.f, 0.f, 0.f, 0.f};
#pragma unroll
            for (int s = 0; s < 8; ++s) acc = __builtin_amdgcn_mfma_f32_16x16x32_bf16(fr[del & 1][s], Bp[ps][s], acc, 0, 0, 0);
            v2u o; o.x = pk2(acc.x * inv[ps], acc.y * inv[ps]); o.y = pk2(acc.z * inv[ps], acc.w * inv[ps]);
            *(v2u*)(AO + 16 * del) = o;
            __builtin_amdgcn_sched_barrier(0);
        }
    }
    __syncthreads();
}

__device__ __forceinline__ unsigned key_enc(float f) { const unsigned u = __builtin_bit_cast(unsigned, f); return (u & 0x80000000u) ? ~u : (u | 0x80000000u); }
__device__ __forceinline__ float key_dec(unsigned k) { const unsigned u = (k & 0x80000000u) ? (k & 0x7fffffffu) : ~k; return __builtin_bit_cast(float, u); }
#define INS16(L, kv) do { unsigned carry_ = (kv); _Pragma("unroll") for (int q_ = 0; q_ < 16; ++q_) { const unsigned hi_ = max(L[q_], carry_); carry_ = min(L[q_], carry_); L[q_] = hi_; } } while (0)
__device__ __forceinline__ void peer_topk_item(const Params& P, LAS unsigned char* lds, int item, int tid, int lane, int wave) {
    const unsigned char* ws = P.ws;
    const int h = item & 7, tile = item >> 3, tt0 = tile * 256;
    LAS float* S = (LAS float*)lds;
    LAS int* tab = (LAS int*)(lds + 140 * 1024);
    if (tid == 0) { int id = 0; for (int a = 0; a < 16; ++a) for (int bq = 0; bq < 16 / (a + 1); ++bq) tab[id++] = a * 16 + bq; }
    const bf16* PQ = (const bf16*)(ws + WS_PQ); const bf16* SUBK = (const bf16*)(ws + WS_SUBK);
    const int col = lane & 15, g = lane >> 4;
    unsigned L1[16], L2[16];
#pragma unroll
    for (int q = 0; q < 16; ++q) { L1[q] = 0u; L2[q] = 0u; }
#pragma unroll
    for (int p = 0; p < 2; ++p) {
        {
            bf16x8 Af[2][4];
#pragma unroll
            for (int rho = 0; rho < 2; ++rho)
#pragma unroll
                for (int s = 0; s < 4; ++s) Af[rho][s] = *(const bf16x8*)(PQ + (size_t)(tt0 + 32 * wave + 16 * rho + col) * 2048 + h * 256 + p * 128 + 32 * s + 8 * g);
#pragma unroll
            for (int kap = 0; kap < 8; ++kap) {
                f32x4 a0 = (f32x4){0.f, 0.f, 0.f, 0.f}, a1 = a0;
#pragma unroll
                for (int s = 0; s < 4; ++s) { const bf16x8 bk = *(const bf16x8*)(SUBK + (size_t)((h * 2 + p) * 128 + 16 * kap + col) * 128 + 32 * s + 8 * g);
                    a0 = __builtin_amdgcn_mfma_f32_16x16x32_bf16(Af[0][s], bk, a0, 0, 0, 0); a1 = __builtin_amdgcn_mfma_f32_16x16x32_bf16(Af[1][s], bk, a1, 0, 0, 0); }
#pragma unroll
                for (int i = 0; i < 4; ++i) { S[(32 * wave + 4 * g + i) * 132 + 16 * kap + col] = a0[i]; S[(32 * wave + 16 + 4 * g + i) * 132 + 16 * kap + col] = a1[i]; }
            }
        }
        __syncthreads();
        if (tid < 256) {
            const LAS float* row = S + tid * 132;
#pragma unroll 2
            for (int k4 = 0; k4 < 32; ++k4) { const f32x4 v = *(const LAS f32x4*)(row + 4 * k4);
#pragma unroll
                for (int e = 0; e < 4; ++e) { const unsigned kv = (key_enc(v[e]) & ~127u) | (unsigned)(127 - (4 * k4 + e));
                    if (p == 0) INS16(L1, kv); else INS16(L2, kv); } }
        }
        __syncthreads();
    }
    if (tid < 256) {
        float v1[16], v2[16];
        LAS int* il = (LAS int*)lds + tid * 33;
#pragma unroll
        for (int q = 0; q < 16; ++q) { v1[q] = key_dec((L1[q] & ~127u) | 64u); v2[q] = key_dec((L2[q] & ~127u) | 64u); il[q] = 127 - (int)(L1[q] & 127u); il[16 + q] = 127 - (int)(L2[q] & 127u); }
        unsigned C[16];
#pragma unroll
        for (int q = 0; q < 16; ++q) C[q] = 0u;
        {
            int id = 0;
#pragma unroll
            for (int a = 0; a < 16; ++a)
#pragma unroll
                for (int bq = 0; bq < 16 / (a + 1); ++bq) { const unsigned kv = (key_enc(v1[a] + v2[bq]) & ~63u) | (unsigned)(63 - id); INS16(C, kv); ++id; }
        }
        LDS_WAIT(); asm volatile("" ::: "memory");
        float best[16], e[16], sum = 0.f; int ex[16];
#pragma unroll
        for (int q = 0; q < 16; ++q) { best[q] = key_dec((C[q] & ~63u) | 32u); const int ab = tab[63 - (int)(C[q] & 63u)]; ex[q] = il[ab >> 4] * 128 + il[16 + (ab & 15)]; }
#pragma unroll
        for (int q = 0; q < 16; ++q) { e[q] = __expf(best[q] - best[0]); sum += e[q]; }
        const float inv = 1.0f / sum;
        int* IDX = (int*)(P.ws + WS_IDX) + ((size_t)(tt0 + tid) * 8 + h) * 16; float* GW = (float*)(P.ws + WS_GW) + ((size_t)(tt0 + tid) * 8 + h) * 16;
#pragma unroll
        for (int q = 0; q < 16; ++q) { IDX[q] = ex[q]; GW[q] = e[q] * inv; }
    }
    __syncthreads();
}

typedef float f32x2 __attribute__((ext_vector_type(2)));
__device__ __forceinline__ void cvt_table_fp8(const float* src, unsigned char* dst, float* scl, int gw, int ngw, int lane) {
    for (int row = gw; row < 16384; row += ngw) {
        const f32x4* sp = (const f32x4*)(src + (size_t)row * 1024 + 16 * lane);
        const f32x4 a0 = sp[0], a1 = sp[1], a2 = sp[2], a3 = sp[3];
        float m = fmaxf(fmaxf(fmaxf(fabsf(a0.x), fabsf(a0.y)), fmaxf(fabsf(a0.z), fabsf(a0.w))), fmaxf(fmaxf(fabsf(a1.x), fabsf(a1.y)), fmaxf(fabsf(a1.z), fabsf(a1.w))));
        m = fmaxf(m, fmaxf(fmaxf(fmaxf(fabsf(a2.x), fabsf(a2.y)), fmaxf(fabsf(a2.z), fabsf(a2.w))), fmaxf(fmaxf(fabsf(a3.x), fabsf(a3.y)), fmaxf(fabsf(a3.z), fabsf(a3.w)))));
#pragma unroll
        for (int o = 1; o < 64; o <<= 1) m = fmaxf(m, __shfl_xor(m, o));
        m = fmaxf(m, 1e-30f);
        const float q = 224.0f / m;
        v4u o;
        int p;
        p = __builtin_amdgcn_cvt_pk_fp8_f32(a0.x * q, a0.y * q, 0, false); p = __builtin_amdgcn_cvt_pk_fp8_f32(a0.z * q, a0.w * q, p, true); o.x = (unsigned)p;
        p = __builtin_amdgcn_cvt_pk_fp8_f32(a1.x * q, a1.y * q, 0, false); p = __builtin_amdgcn_cvt_pk_fp8_f32(a1.z * q, a1.w * q, p, true); o.y = (unsigned)p;
        p = __builtin_amdgcn_cvt_pk_fp8_f32(a2.x * q, a2.y * q, 0, false); p = __builtin_amdgcn_cvt_pk_fp8_f32(a2.z * q, a2.w * q, p, true); o.z = (unsigned)p;
        p = __builtin_amdgcn_cvt_pk_fp8_f32(a3.x * q, a3.y * q, 0, false); p = __builtin_amdgcn_cvt_pk_fp8_f32(a3.z * q, a3.w * q, p, true); o.w = (unsigned)p;
        *(v4u*)(dst + (size_t)row * 1024 + 16 * lane) = o;
        if (lane == 0) scl[row] = m * (1.0f / 224.0f);
    }
}
__device__ __forceinline__ void peer_token(const Params& P, int t, int lane, float* dstbase) {
    const unsigned char* ws = P.ws;
    const float* xrow = P.out + (size_t)t * 1024 + 16 * lane;
    const float rstd2 = rsqrtf(((const float*)(ws + WS_SSQ2))[t] * (1.0f / 1024.0f) + 1e-6f);
    f32x4 x2[4]; f32x2 hn[8], acc[8];
#pragma unroll
    for (int i = 0; i < 4; ++i) { x2[i] = ((const f32x4*)xrow)[i]; const f32x4 w = ((const f32x4*)(P.norm_ffn_w + 16 * lane))[i];
        hn[2 * i] = (f32x2){x2[i].x * rstd2 * w.x, x2[i].y * rstd2 * w.y}; hn[2 * i + 1] = (f32x2){x2[i].z * rstd2 * w.z, x2[i].w * rstd2 * w.w}; }
#pragma unroll
    for (int i = 0; i < 8; ++i) acc[i] = (f32x2){0.f, 0.f};
    const int* IDX = (const int*)(ws + WS_IDX) + (size_t)t * 128; const float* GW = (const float*)(ws + WS_GW) + (size_t)t * 128;
    const unsigned char* UB8 = ws + WS_UB; const unsigned char* VB8 = ws + WS_VB;
    const float* USC = (const float*)(ws + WS_UB + 16 * MiB); const float* VSC = (const float*)(ws + WS_VB + 16 * MiB);
    const int myk = (lane >> 2) & 15;
#pragma unroll 1
    for (int hh = 0; hh < 8; ++hh) {
        const int idv = IDX[hh * 16 + (lane & 15)];
        const float gsc = GW[hh * 16 + (lane & 15)] * VSC[idv], usc = USC[idv];
        v4u uq[16], vq[16];
#pragma unroll
        for (int k = 0; k < 16; ++k) { const int e = __builtin_amdgcn_readlane(idv, k);
            uq[k] = *(const v4u*)(UB8 + (size_t)e * 1024 + 16 * lane); vq[k] = *(const v4u*)(VB8 + (size_t)e * 1024 + 16 * lane); }
        float d[16];
#pragma unroll
        for (int k = 0; k < 16; ++k) {
            f32x2 s = __builtin_amdgcn_cvt_pk_f32_fp8((int)uq[k].x, false) * hn[0];
            s = __builtin_elementwise_fma(__builtin_amdgcn_cvt_pk_f32_fp8((int)uq[k].x, true), hn[1], s);
            s = __builtin_elementwise_fma(__builtin_amdgcn_cvt_pk_f32_fp8((int)uq[k].y, false), hn[2], s);
            s = __builtin_elementwise_fma(__builtin_amdgcn_cvt_pk_f32_fp8((int)uq[k].y, true), hn[3], s);
            s = __builtin_elementwise_fma(__builtin_amdgcn_cvt_pk_f32_fp8((int)uq[k].z, false), hn[4], s);
            s = __builtin_elementwise_fma(__builtin_amdgcn_cvt_pk_f32_fp8((int)uq[k].z, true), hn[5], s);
            s = __builtin_elementwise_fma(__builtin_amdgcn_cvt_pk_f32_fp8((int)uq[k].w, false), hn[6], s);
            s = __builtin_elementwise_fma(__builtin_amdgcn_cvt_pk_f32_fp8((int)uq[k].w, true), hn[7], s);
            d[k] = s.x + s.y;
        }
        float r8[8], r4[4], r2[2], r1;
        { const bool up = (lane & 32) != 0;
#pragma unroll
          for (int i = 0; i < 8; ++i) { const float keep = up ? d[8 + i] : d[i], send = up ? d[i] : d[8 + i]; r8[i] = keep + __shfl_xor(send, 32); } }
        { const bool up = (lane & 16) != 0;
#pragma unroll
          for (int i = 0; i < 4; ++i) { const float keep = up ? r8[4 + i] : r8[i], send = up ? r8[i] : r8[4 + i]; r4[i] = keep + __shfl_xor(send, 16); } }
        { const bool up = (lane & 8) != 0;
#pragma unroll
          for (int i = 0; i < 2; ++i) { const float keep = up ? r4[2 + i] : r4[i], send = up ? r4[i] : r4[2 + i]; r2[i] = keep + __shfl_xor(send, 8); } }
        { const bool up = (lane & 4) != 0; const float keep = up ? r2[1] : r2[0], send = up ? r2[0] : r2[1]; r1 = keep + __shfl_xor(send, 4); }
        r1 += __shfl_xor(r1, 2); r1 += __shfl_xor(r1, 1);
        const float act = gelu_tanh(r1 * __shfl(usc, myk)) * __shfl(gsc, myk);
#pragma unroll
        for (int k = 0; k < 16; ++k) {
            const float a = __builtin_bit_cast(float, __builtin_amdgcn_readlane(__builtin_bit_cast(int, act), 4 * k));
            const f32x2 a2 = (f32x2){a, a};
            acc[0] = __builtin_elementwise_fma(__builtin_amdgcn_cvt_pk_f32_fp8((int)vq[k].x, false), a2, acc[0]);
            acc[1] = __builtin_elementwise_fma(__builtin_amdgcn_cvt_pk_f32_fp8((int)vq[k].x, true), a2, acc[1]);
            acc[2] = __builtin_elementwise_fma(__builtin_amdgcn_cvt_pk_f32_fp8((int)vq[k].y, false), a2, acc[2]);
            acc[3] = __builtin_elementwise_fma(__builtin_amdgcn_cvt_pk_f32_fp8((int)vq[k].y, true), a2, acc[3]);
            acc[4] = __builtin_elementwise_fma(__builtin_amdgcn_cvt_pk_f32_fp8((int)vq[k].z, false), a2, acc[4]);
            acc[5] = __builtin_elementwise_fma(__builtin_amdgcn_cvt_pk_f32_fp8((int)vq[k].z, true), a2, acc[5]);
            acc[6] = __builtin_elementwise_fma(__builtin_amdgcn_cvt_pk_f32_fp8((int)vq[k].w, false), a2, acc[6]);
            acc[7] = __builtin_elementwise_fma(__builtin_amdgcn_cvt_pk_f32_fp8((int)vq[k].w, true), a2, acc[7]);
        }
    }
    float ss = 0.f;
#pragma unroll
    for (int i = 0; i < 4; ++i) { x2[i].x += acc[2 * i].x; x2[i].y += acc[2 * i].y; x2[i].z += acc[2 * i + 1].x; x2[i].w += acc[2 * i + 1].y;
        ss += (x2[i].x * x2[i].x + x2[i].y * x2[i].y) + (x2[i].z * x2[i].z + x2[i].w * x2[i].w); }
    const float rstd3 = rsqrtf(wave_sum(ss) * (1.0f / 1024.0f) + 1e-6f);
    float* orow = dstbase + (size_t)t * 1024 + 16 * lane;
#pragma unroll
    for (int i = 0; i < 4; ++i) { const f32x4 w = ((const f32x4*)(P.norm_final_w + 16 * lane))[i];
        ((f32x4*)orow)[i] = (f32x4){x2[i].x * rstd3 * w.x, x2[i].y * rstd3 * w.y, x2[i].z * rstd3 * w.z, x2[i].w * rstd3 * w.w}; }
}

__global__ void __launch_bounds__(NWAVES * 64, 2) hybrid_fwd(Params P) {
    extern __shared__ __attribute__((aligned(16))) unsigned char lds_raw[];
    LAS unsigned char* lds = (LAS unsigned char*)lds_raw;
    volatile LAS unsigned* MISC = (volatile LAS unsigned*)(lds + MISC_OFF);
    const int tid = threadIdx.x, lane = tid & 63, wave = __builtin_amdgcn_readfirstlane(tid >> 6);
    const int G = gridDim.x, bx = blockIdx.x;
    const int vcu = (G % 8 == 0) ? (bx % 8) * (G / 8) + bx / 8 : bx;
    unsigned char* ws = P.ws;
    for (int u = tid; u < 64; u += NWAVES * 64) MISC[u] = 0u;
    __syncthreads();
    XcdBarrier bar; bar.bar = (unsigned*)(ws + WS_CTL) + CW_BAR; bar.x = 0; bar.st = nullptr;
    if (!MK_PER_PHASE) bar = xcd_barrier_post((unsigned*)(ws + WS_CTL) + CW_BAR, MISC + 8);
    const int lo = P.ph_lo, hi = P.ph_hi;
#ifndef PHASE_MASK
#define PHASE_MASK 0xFFF
#endif
#define IN(k) (((PHASE_MASK >> (k)) & 1) && lo <= (k) && (k) < hi)
#define SEAM(k) do { if (IN(k) && IN((k) + 1)) xcd_barrier(bar); } while (0)
#ifndef REP_MASK
#define REP_MASK 0
#endif
#define REPS(k) for (int rep_ = 0; rep_ < (((REP_MASK >> (k)) & 1) ? 2 : 1); ++rep_, (rep_ < (((REP_MASK >> (k)) & 1) ? 2 : 1) ? xcd_barrier(bar) : (void)0))
    using namespace pg8;
    bf16* XB = (bf16*)(ws + WS_XB);

    if (IN(0)) REPS(0) { p0_prologue(P, lds, tid, lane, wave, vcu, G); }
    SEAM(0);
    if (IN(1)) REPS(1) {
        { Gemm gm{XB, (const bf16_t*)(ws + WS_WIN), T, 3072, 1024}; StaticOrder S; S.init(T, 3072, G, bx);
          EpiBf16Rs E{(bf16_t*)(ws + WS_QKV), 1536, 6, (bf16_t*)(ws + WS_XR), 512, (size_t)T * 512, nullptr, 1.0f};
          gemm_phase<EpiBf16Rs, StaticOrder, PG8_ALIGN, PG8_SP2>(lds, gm, S, E); }
        { Gemm gm{(const bf16_t*)(ws + WS_MEMN), (const bf16_t*)(ws + WS_WKV), 512, 2048, 1024}; StaticOrder S; S.init(512, 2048, G, bx);
          EpiKV E{(bf16_t*)(ws + WS_KB), (bf16_t*)(ws + WS_VTP)};
          gemm_phase<EpiKV, StaticOrder, PG8_ALIGN, PG8_SP2>(lds, gm, S, E); }
    }
    SEAM(1);
    if (IN(2)) REPS(2) {
#ifndef P2_REP_GDN
#define P2_REP_GDN 1
#endif
#ifndef P2_REP_LRU
#define P2_REP_LRU 1
#endif
        for (int rr = 0; rr < P2_REP_GDN; ++rr) for (int it = bx; it < 1024; it += G) gdn_local_item(P, lds, it, tid);
        for (int rr = 0; rr < P2_REP_LRU; ++rr) for (int lt = bx; lt < 256; lt += G) lru_local_item(P, lds, lt, tid, lane, wave);
    }
    SEAM(2);
    if (IN(3)) REPS(3) {
        if (bx < SCAN_WGS) gdn_scan(P, lds, bx, tid, lane, wave);
        else if (bx < SCAN_WGS + 2) lru_carry(P, (bx - SCAN_WGS) * NWAVES + wave, lane);
        else cvt_table_fp8(P.peer_u, ws + WS_UB, (float*)(ws + WS_UB + 16 * MiB), (bx - SCAN_WGS - 2) * NWAVES + wave, (G - SCAN_WGS - 2) * NWAVES, lane);
    }
    SEAM(3);
    if (IN(4)) REPS(4) {
        gdn_gate_norm(P, (size_t)bx * (NWAVES * 64) + tid, (size_t)G * (NWAVES * 64));
        lru_combine(P, (size_t)bx * (NWAVES * 64) + tid, (size_t)G * (NWAVES * 64));
        cvt_table_fp8(P.peer_v, ws + WS_VB, (float*)(ws + WS_VB + 16 * MiB), bx * NWAVES + wave, G * NWAVES, lane);
    }
    SEAM(4);
    if (IN(5)) {
        Gemm gm{(const bf16_t*)(ws + WS_Y), (const bf16_t*)(ws + WS_WOUT), T, 1024, 1024}; StaticOrder S; S.init(T, 1024, G, bx);
        EpiResid E{P.x, P.out, XB, (float*)(ws + WS_SSQ1)};
        gemm_phase<EpiResid, StaticOrder, PG8_ALIGN, PG8_SP2>(lds, gm, S, E);
    }
    SEAM(5);
    if (IN(6)) REPS(6) {
        Gemm gm{XB, (const bf16_t*)(ws + WS_WQ), T, 1024, 1024}; StaticOrder S; S.init(T, 1024, G, bx);
        EpiBf16Rs E{(bf16_t*)(ws + WS_Q), 1024, 4, nullptr, 256, 0, (const float*)(ws + WS_SSQ1), 0.0625f};
        gemm_phase<EpiBf16Rs, StaticOrder, PG8_ALIGN, PG8_SP2>(lds, gm, S, E);
    }
    SEAM(6);
    if (IN(7)) REPS(7) {
        for (int un = bx; un < 512; un += G) xattn_unit(P, lds, un, tid, lane, wave);
    }
    SEAM(7);
    if (IN(8)) {
        Gemm gm{(const bf16_t*)(ws + WS_AO), (const bf16_t*)(ws + WS_WO), T, 1024, 1024}; StaticOrder S; S.init(T, 1024, G, bx);
        EpiResid E{P.out, P.out, XB, (float*)(ws + WS_SSQ2)};
        gemm_phase<EpiResid, StaticOrder, PG8_ALIGN, PG8_SP2>(lds, gm, S, E);
    }
    SEAM(8);
    if (IN(9)) REPS(9) {
        Gemm gm{XB, (const bf16_t*)(ws + WS_PWQ), T, 2048, 1024}; StaticOrder S; S.init(T, 2048, G, bx);
        EpiBf16Rs E{(bf16_t*)(ws + WS_PQ), 2048, 8, nullptr, 256, 0, (const float*)(ws + WS_SSQ2), 1.0f};
        gemm_phase<EpiBf16Rs, StaticOrder, PG8_ALIGN, PG8_SP2>(lds, gm, S, E);
    }
    SEAM(9);
    if (IN(10)) REPS(10) {
        for (int it = bx; it < 512; it += G) peer_topk_item(P, lds, it, tid, lane, wave);
    }
    SEAM(10);
    if (IN(11)) REPS(11) {
        for (int t = bx * NWAVES + wave; t < T; t += G * NWAVES) peer_token(P, t, lane, (((REP_MASK >> 11) & 1) && rep_ == 0) ? (float*)(ws + WS_PQ) : P.out);
    }
#undef IN
#undef SEAM
}

extern "C" void kernel_launch(void* const* d_in, const int* in_sizes, int n_in, void* d_out, int out_size, void* d_ws, size_t ws_size, hipStream_t stream) {
    static int grid = 0;
    if (grid == 0) {
        if (n_in != 27 || in_sizes[0] != T * D || out_size != T * D || ws_size < WS_END) {
            fprintf(stderr, "kernel_launch: unexpected shapes (n_in %d, in0 %d, out %d, ws %zu); nothing launched\n", n_in, n_in > 0 ? in_sizes[0] : -1, out_size, ws_size); grid = -1; return; }
        int dev = 0, cus = 0, per_cu = 0;
        if (hipGetDevice(&dev) != hipSuccess || hipDeviceGetAttribute(&cus, hipDeviceAttributeMultiprocessorCount, dev) != hipSuccess) { grid = -1; return; }
        if (hipFuncSetAttribute((const void*)hybrid_fwd, hipFuncAttributeMaxDynamicSharedMemorySize, LDS_BYTES) != hipSuccess) { fprintf(stderr, "kernel_launch: hipFuncSetAttribute failed\n"); grid = -1; return; }
        if (hipOccupancyMaxActiveBlocksPerMultiprocessor(&per_cu, (const void*)hybrid_fwd, NWAVES * 64, LDS_BYTES) != hipSuccess || per_cu < 1)
            fprintf(stderr, "kernel_launch: note: occupancy query reports %d workgroups per CU\n", per_cu);
        (void)hipGetLastError();
        grid = cus;
        if (grid != 256) fprintf(stderr, "kernel_launch: %d CUs (built for 256)\n", grid);
    }
    if (grid < 0) return;
    if (hipMemsetAsync((char*)d_ws + WS_CTL, 0, CTL_ZERO_BYTES, stream) != hipSuccess) { fprintf(stderr, "kernel_launch: hipMemsetAsync failed\n"); return; }
    Params p{};
    const float** pp = (const float**)&p;
    for (int i = 0; i < 27; ++i) pp[i] = (const float*)d_in[i];
    p.out = (float*)d_out; p.ws = (unsigned char*)d_ws;
#if MK_PER_PHASE
    for (int k = 0; k < N_PHASES; ++k) { p.ph_lo = k; p.ph_hi = k + 1; hipLaunchKernelGGL(hybrid_fwd, dim3(grid), dim3(NWAVES * 64), LDS_BYTES, stream, p); }
#else
    p.ph_lo = 0; p.ph_hi = N_PHASES;
    hipLaunchKernelGGL(hybrid_fwd, dim3(grid), dim3(NWAVES * 64), LDS_BYTES, stream, p);
#endif
    const hipError_t le = hipPeekAtLastError();
    if (le != hipSuccess) fprintf(stderr, "kernel_launch: launch failed: %s\n", hipGetErrorName(le));
}
```

```cpp
#include <hip/hip_runtime.h>
#include <cstdio>
#include <cstdint>
namespace pg8 {
#define PG8_LAS __attribute__((address_space(3)))
typedef unsigned short bf16_t;
typedef short bf16x8 __attribute__((ext_vector_type(8)));
typedef float f32x4 __attribute__((ext_vector_type(4)));
typedef unsigned u32x4 __attribute__((ext_vector_type(4)));
constexpr int BM = 256, BK = 64, HALF = 128, HTB = HALF * BK * 2  , STAGE_BYTES = 8 * HTB, NXCD = 8, WGM = 8;

__host__ __device__ __forceinline__ int lds_byte(int r, int c) { const int st = (r >> 4) * 2 + (c >> 5), rr = r & 15, cc = c & 31, ob = rr * 64 + cc * 2; return st * 1024 + (ob ^ (((ob >> 9) & 1) << 5)); }
__host__ __device__ __forceinline__ void stage_rc(int b, int& R, int& C) { const int st = b / 1024, sb = b % 1024, swz = sb ^ (((sb >> 9) & 1) << 5); R = (st >> 1) * 16 + swz / 64; C = (st & 1) * 32 + (swz % 64) / 2; }
__host__ __device__ __forceinline__ int perm32(int rho) { const int n = rho >> 4, i = rho & 15; return 8 * (i >> 2) + 4 * n + (i & 3); }

struct Unit { int pm, pn; };
struct Gemm { const bf16_t* A; const bf16_t* Bt; int M, N, K; };

struct StaticOrder {
    int nM, nN, nwg, G, c;
    __host__ __device__ void init(int M, int N, int G_, int c_) { nM = M / BM; nN = N / BM; nwg = nM * nN; G = G_; c = c_; }
    __host__ __device__ bool next(int i, Unit& u) const {
        const long L = (long)i * G + c; if (L >= nwg) return false;
        int wgid = (int)L; { const int q = nwg / NXCD, r = nwg % NXCD, xcd = wgid % NXCD, off = wgid / NXCD; wgid = (xcd < r ? xcd * (q + 1) : r * (q + 1) + (xcd - r) * q) + off; }
        const int nig = WGM * nN, gid = wgid / nig, fm = gid * WGM, gsz = (nM - fm) < WGM ? (nM - fm) : WGM;
        u.pm = fm + ((wgid % nig) % gsz); u.pn = (wgid % nig) / gsz; return true;
    }
    __device__ __forceinline__ void a_ready(const Unit&) const {}
    __device__ __forceinline__ void done(const Unit&) const {}
};

__device__ __forceinline__ unsigned cvt_pk_bf16(float lo, float hi) { unsigned r; asm volatile("v_cvt_pk_bf16_f32 %0, %1, %2" : "=v"(r) : "v"(lo), "v"(hi)); return r; }
template <class Epi, class Sched, bool ALIGN_EPI = false, bool SP2 = false>
__device__ __forceinline__ void gemm_phase(PG8_LAS unsigned char* lds, const Gemm g, const Sched& S, const Epi& E) {
    const int tid = threadIdx.x, wid = __builtin_amdgcn_readfirstlane(tid >> 6), lane = tid & 63, wr = wid >> 2, wc = wid & 3, fr = lane & 15, fq = lane >> 4;
    const int K = g.K, nt = K / BK;
    unsigned voffA[2], voffB[2];
#pragma unroll
    for (int i = 0; i < 2; ++i) { int R, C; stage_rc(tid * 16 + i * 8192, R, C); const int Rb = Epi::PERM ? ((R & ~31) + perm32(R & 31)) : R;
        voffA[i] = (unsigned)(R * K + C) * 2u; voffB[i] = (unsigned)(Rb * K + C) * 2u; }
    const size_t kstep = (size_t)(BK * 2);
    const size_t hstep = (size_t)HALF * K * 2;
    const size_t tstep = 2 * hstep;
    const unsigned ldsw = (unsigned)wid * 1024u;
    const int aoff = lds_byte(wr * 64 + fr, fq * 8), boff = lds_byte(wc * 32 + fr, fq * 8);
#define PG8_SA(b, h) (((b) * 2 + (h)) * HTB)
#define PG8_SB(b, h) ((4 + (b) * 2 + (h)) * HTB)
#define PG8_STAGE(bufoff, gbase, voff) do { _Pragma("unroll") for (int _i = 0; _i < 2; ++_i) \
        __builtin_amdgcn_global_load_lds((const unsigned*)((const char*)(gbase) + (voff)[_i]), (PG8_LAS unsigned*)(lds + (bufoff) + ldsw + _i * 8192), 16, 0, 0); } while (0)
#define PG8_LDA(dst, b, h) do { _Pragma("unroll") for (int m = 0; m < 4; ++m) _Pragma("unroll") for (int k = 0; k < 2; ++k) dst[m][k] = *(const PG8_LAS bf16x8*)(lds + PG8_SA(b, h) + aoff + m * 2048 + k * 1024); } while (0)
#define PG8_LDB(dst, b, h) do { _Pragma("unroll") for (int n = 0; n < 2; ++n) _Pragma("unroll") for (int k = 0; k < 2; ++k) dst[n][k] = *(const PG8_LAS bf16x8*)(lds + PG8_SB(b, h) + boff + n * 2048 + k * 1024); } while (0)
#define PG8_MMA(ai, bj, At, Bt) do { __builtin_amdgcn_s_setprio(1); _Pragma("unroll") for (int m = 0; m < 4; ++m) _Pragma("unroll") for (int n = 0; n < 2; ++n) _Pragma("unroll") for (int k = 0; k < 2; ++k) \
        acc[ai][bj][m][n] = __builtin_amdgcn_mfma_f32_16x16x32_bf16(Bt[n][k], At[m][k], acc[ai][bj][m][n], 0, 0, 0); __builtin_amdgcn_s_setprio(0); } while (0)
#define PG8_WAIT_V(n) asm volatile("s_waitcnt vmcnt(" #n ")" ::: "memory")
#define PG8_WAIT_L(n) asm volatile("s_waitcnt lgkmcnt(" #n ")" ::: "memory")
#define PG8_BAR __builtin_amdgcn_s_barrier()
#define PG8_SCHED __builtin_amdgcn_sched_barrier(0)
    Unit cur, nxt; int ui = 0;
    if (!S.next(0, cur)) return;
    f32x4 acc[2][2][4][2];
#pragma unroll
    for (int a = 0; a < 2; ++a)
#pragma unroll
        for (int b = 0; b < 2; ++b)
#pragma unroll
            for (int m = 0; m < 4; ++m)
#pragma unroll
                for (int n = 0; n < 2; ++n) acc[a][b][m][n] = (f32x4){0.f, 0.f, 0.f, 0.f};
    bf16x8 At[4][2], B0[2][2], B1[2][2];
    const char* cA = (const char*)g.A + (size_t)cur.pm * tstep; const char* cB = (const char*)g.Bt + (size_t)cur.pn * tstep;
    S.a_ready(cur);
    if constexpr (SP2) {
        PG8_STAGE(PG8_SB(0, 0), cB, voffB); PG8_STAGE(PG8_SB(0, 1), cB + hstep, voffB); PG8_STAGE(PG8_SA(0, 0), cA, voffA); PG8_STAGE(PG8_SA(0, 1), cA + hstep, voffA);
        if (wr == 1) PG8_BAR;
        PG8_WAIT_V(2); PG8_BAR;
        PG8_STAGE(PG8_SB(1, 0), cB + kstep, voffB); PG8_STAGE(PG8_SA(1, 0), cA + kstep, voffA); PG8_STAGE(PG8_SB(1, 1), cB + hstep + kstep, voffB);
        PG8_WAIT_V(6); PG8_BAR;
    } else {
        PG8_STAGE(PG8_SB(0, 0), cB, voffB); PG8_STAGE(PG8_SA(0, 0), cA, voffA); PG8_STAGE(PG8_SB(0, 1), cB + hstep, voffB); PG8_STAGE(PG8_SA(0, 1), cA + hstep, voffA);
        if (wr == 1) PG8_BAR;
        PG8_WAIT_V(4); PG8_BAR;
        PG8_STAGE(PG8_SB(1, 0), cB + kstep, voffB); PG8_STAGE(PG8_SA(1, 0), cA + kstep, voffA); PG8_STAGE(PG8_SB(1, 1), cB + hstep + kstep, voffB);
        PG8_WAIT_V(6); PG8_BAR;
    }
    for (;;) {
        const bool has_next = S.next(ui + 1, nxt);
        const char* nA = has_next ? (const char*)g.A + (size_t)nxt.pm * tstep : cA; const char* nB = has_next ? (const char*)g.Bt + (size_t)nxt.pn * tstep : cB;
        for (int t = 0; t < nt; t += 2) {
            const bool last = (t == nt - 2);
            const char* a1 = cA + (size_t)(t + 1) * kstep;
            const char* a2 = last ? nA : cA + (size_t)(t + 2) * kstep; const char* b2 = last ? nB : cB + (size_t)(t + 2) * kstep;
            const char* a3 = a2 + kstep; const char* b3 = b2 + kstep;
            if (last && has_next) S.a_ready(nxt);
            if constexpr (SP2) {
            PG8_LDB(B0, 0, 0); PG8_LDB(B1, 0, 1); PG8_SCHED; PG8_LDA(At, 0, 0); PG8_STAGE(PG8_SA(1, 1), a1 + hstep, voffA);
            PG8_WAIT_V(8); PG8_WAIT_L(0); PG8_BAR; PG8_MMA(0, 0, At, B0); PG8_MMA(0, 1, At, B1); PG8_BAR; PG8_SCHED;
            PG8_LDA(At, 0, 1); PG8_STAGE(PG8_SB(0, 0), b2, voffB); PG8_STAGE(PG8_SB(0, 1), b2 + hstep, voffB); PG8_STAGE(PG8_SA(0, 0), a2, voffA);
            PG8_WAIT_V(8); PG8_WAIT_L(0); PG8_BAR; PG8_MMA(1, 0, At, B0); PG8_MMA(1, 1, At, B1); PG8_BAR; PG8_SCHED;
            PG8_LDB(B0, 1, 0); PG8_LDB(B1, 1, 1); PG8_SCHED; PG8_LDA(At, 1, 0); PG8_STAGE(PG8_SA(0, 1), a2 + hstep, voffA);
            PG8_WAIT_V(8); PG8_WAIT_L(0); PG8_BAR; PG8_MMA(0, 0, At, B0); PG8_MMA(0, 1, At, B1); PG8_BAR; PG8_SCHED;
            PG8_LDA(At, 1, 1); PG8_STAGE(PG8_SB(1, 0), b3, voffB); PG8_STAGE(PG8_SB(1, 1), b3 + hstep, voffB); PG8_STAGE(PG8_SA(1, 0), a3, voffA);
            PG8_WAIT_V(8); PG8_WAIT_L(0); PG8_BAR; PG8_MMA(1, 0, At, B0); PG8_MMA(1, 1, At, B1); PG8_BAR; PG8_SCHED;
            } else {
            PG8_LDB(B0, 0, 0); PG8_SCHED; PG8_LDA(At, 0, 0); PG8_STAGE(PG8_SA(1, 1), a1 + hstep, voffA);
            PG8_WAIT_L(8); PG8_BAR; PG8_WAIT_L(0); PG8_MMA(0, 0, At, B0); PG8_BAR; PG8_SCHED;
            PG8_LDB(B1, 0, 1); PG8_STAGE(PG8_SB(0, 0), b2, voffB);
            PG8_BAR; PG8_WAIT_L(0); PG8_MMA(0, 1, At, B1); PG8_BAR;
            PG8_LDA(At, 0, 1); PG8_STAGE(PG8_SA(0, 0), a2, voffA);
            PG8_BAR; PG8_WAIT_L(0); PG8_MMA(1, 0, At, B0); PG8_BAR; PG8_SCHED;
            PG8_STAGE(PG8_SB(0, 1), b2 + hstep, voffB);
            PG8_WAIT_V(6); PG8_BAR; PG8_MMA(1, 1, At, B1); PG8_BAR;
            PG8_LDB(B0, 1, 0); PG8_SCHED; PG8_LDA(At, 1, 0); PG8_STAGE(PG8_SA(0, 1), a2 + hstep, voffA);
            PG8_WAIT_L(8); PG8_BAR; PG8_WAIT_L(0); PG8_MMA(0, 0, At, B0); PG8_BAR; PG8_SCHED;
            PG8_LDB(B1, 1, 1); PG8_STAGE(PG8_SB(1, 0), b3, voffB);
            PG8_BAR; PG8_WAIT_L(0); PG8_MMA(0, 1, At, B1); PG8_BAR;
            PG8_LDA(At, 1, 1); PG8_STAGE(PG8_SA(1, 0), a3, voffA);
            PG8_BAR; PG8_WAIT_L(0); PG8_MMA(1, 0, At, B0); PG8_BAR; PG8_SCHED;
            PG8_STAGE(PG8_SB(1, 1), b3 + hstep, voffB);
            PG8_WAIT_V(6); PG8_BAR; PG8_MMA(1, 1, At, B1); PG8_BAR;
            }
        }
        if constexpr (ALIGN_EPI) { if (wr == 0) PG8_BAR; }
        if constexpr (!Epi::AFTER_DRAIN) { E(acc, cur, wr, wc, fr, fq); S.done(cur); }
        if (!has_next) break;
#pragma unroll
        for (int a = 0; a < 2; ++a)
#pragma unroll
            for (int b = 0; b < 2; ++b)
#pragma unroll
                for (int m = 0; m < 4; ++m)
#pragma unroll
                    for (int n = 0; n < 2; ++n) acc[a][b][m][n] = (f32x4){0.f, 0.f, 0.f, 0.f};
        cur = nxt; cA = nA; cB = nB; ++ui;
        if constexpr (ALIGN_EPI) { if (wr == 1) PG8_BAR; }
    }
    PG8_WAIT_V(0);
    if constexpr (!ALIGN_EPI) { if (wr == 0) PG8_BAR; }
    PG8_BAR;
    if constexpr (Epi::AFTER_DRAIN) { E.fused(acc, cur, wr, wc, fr, fq, lds, wid, lane); S.done(cur); }
#undef PG8_SA
#undef PG8_SB
#undef PG8_STAGE
#undef PG8_LDA
#undef PG8_LDB
#undef PG8_MMA
#undef PG8_WAIT_V
#undef PG8_WAIT_L
#undef PG8_BAR
#undef PG8_SCHED
}
}

namespace pg8 {
__host__ __device__ __forceinline__ int permk(int kl) { return 8 * ((kl & 15) >> 2) + 4 * (kl >> 4) + (kl & 3); }
struct EpiBf16Rs {
    static constexpr bool PERM = true, AFTER_DRAIN = false;
    bf16_t* O0; int ld0; int ntile0; bf16_t* O1; int ld1; size_t stride1; const float* ssq; float cs;
    __device__ __forceinline__ void operator()(const f32x4 (&acc)[2][2][4][2], const Unit& u, int wr, int wc, int fr, int fq) const {
        bf16_t* base; int ld, colt;
        if (u.pn < ntile0) { base = O0; ld = ld0; colt = u.pn * BM; }
        else { const int q = u.pn - ntile0, per = ld1 / BM; base = O1 + (size_t)(q / per) * stride1; ld = ld1; colt = (q % per) * BM; }
        const int row0 = u.pm * BM + wr * 64 + fr, col0 = colt + wc * 32 + 8 * fq;
#pragma unroll
        for (int ai = 0; ai < 2; ++ai)
#pragma unroll
            for (int m = 0; m < 4; ++m) {
                const int row = row0 + ai * HALF + m * 16;
                float sc = cs; if (ssq) sc *= rsqrtf(ssq[row] * (1.0f / 1024.0f) + 1e-6f);
                bf16_t* rowp = base + (size_t)row * ld + col0;
#pragma unroll
                for (int bj = 0; bj < 2; ++bj) { const f32x4 v0 = acc[ai][bj][m][0] * sc, v1 = acc[ai][bj][m][1] * sc;
                    u32x4 w; w.x = cvt_pk_bf16(v0[0], v0[1]); w.y = cvt_pk_bf16(v0[2], v0[3]); w.z = cvt_pk_bf16(v1[0], v1[1]); w.w = cvt_pk_bf16(v1[2], v1[3]);
                    *(u32x4*)(rowp + bj * HALF) = w; } }
    }
};
struct EpiF16Rs {
    static constexpr bool PERM = true, AFTER_DRAIN = false;
    _Float16* O; int ld; const float* ssq;
    __device__ __forceinline__ void operator()(const f32x4 (&acc)[2][2][4][2], const Unit& u, int wr, int wc, int fr, int fq) const {
        typedef _Float16 f16x8 __attribute__((ext_vector_type(8)));
        const int row0 = u.pm * BM + wr * 64 + fr, col0 = u.pn * BM + wc * 32 + 8 * fq;
#pragma unroll
        for (int ai = 0; ai < 2; ++ai)
#pragma unroll
            for (int m = 0; m < 4; ++m) {
                const int row = row0 + ai * HALF + m * 16;
                const float sc = rsqrtf(ssq[row] * (1.0f / 1024.0f) + 1e-6f);
                _Float16* rowp = O + (size_t)row * ld + col0;
#pragma unroll
                for (int bj = 0; bj < 2; ++bj) { const f32x4 v0 = acc[ai][bj][m][0] * sc, v1 = acc[ai][bj][m][1] * sc;
                    f16x8 w; w[0] = (_Float16)v0[0]; w[1] = (_Float16)v0[1]; w[2] = (_Float16)v0[2]; w[3] = (_Float16)v0[3];
                    w[4] = (_Float16)v1[0]; w[5] = (_Float16)v1[1]; w[6] = (_Float16)v1[2]; w[7] = (_Float16)v1[3];
                    *(f16x8*)(rowp + bj * HALF) = w; } }
    }
};
struct EpiResid {
    static constexpr bool PERM = false, AFTER_DRAIN = false;
    const float* base; float* out; bf16_t* xb; float* ssq;
    __device__ __forceinline__ void operator()(const f32x4 (&acc)[2][2][4][2], const Unit& u, int wr, int wc, int fr, int fq) const {
        typedef unsigned u32x2v __attribute__((ext_vector_type(2)));
        const int row0 = u.pm * BM + wr * 64 + fr, col0 = u.pn * BM + wc * 32 + 4 * fq;
#pragma unroll
        for (int ai = 0; ai < 2; ++ai)
#pragma unroll
            for (int m = 0; m < 4; ++m) {
                const int row = row0 + ai * HALF + m * 16; const size_t off = (size_t)row * 1024 + col0; float s = 0.f;
#pragma unroll
                for (int bj = 0; bj < 2; ++bj)
#pragma unroll
                    for (int n = 0; n < 2; ++n) { const size_t o2 = off + bj * HALF + n * 16;
                        const f32x4 o = *(const f32x4*)(base + o2) + acc[ai][bj][m][n];
                        *(f32x4*)(out + o2) = o; s += (o[0] * o[0] + o[1] * o[1]) + (o[2] * o[2] + o[3] * o[3]);
                        u32x2v w; w.x = cvt_pk_bf16(o[0], o[1]); w.y = cvt_pk_bf16(o[2], o[3]); *(u32x2v*)(xb + o2) = w; }
                s += __shfl_xor(s, 16); s += __shfl_xor(s, 32);
                if (fq == 0) atomicAdd(ssq + row, s);
            }
    }
};
struct EpiKV {
    static constexpr bool PERM = false, AFTER_DRAIN = false;
    bf16_t* Kb; bf16_t* VTp;
    __device__ __forceinline__ void operator()(const f32x4 (&acc)[2][2][4][2], const Unit& u, int wr, int wc, int fr, int fq) const {
        typedef unsigned u32x2v __attribute__((ext_vector_type(2)));
        const int row0 = u.pm * BM + wr * 64 + fr, col0 = u.pn * BM + wc * 32 + 4 * fq;
#pragma unroll
        for (int ai = 0; ai < 2; ++ai)
#pragma unroll
            for (int m = 0; m < 4; ++m) {
                const int row = row0 + ai * HALF + m * 16, b = row >> 8, key = row & 255;
#pragma unroll
                for (int bj = 0; bj < 2; ++bj)
#pragma unroll
                    for (int n = 0; n < 2; ++n) { const int col = col0 + bj * HALF + n * 16; const f32x4 v = acc[ai][bj][m][n];
                        const unsigned p01 = cvt_pk_bf16(v[0], v[1]), p23 = cvt_pk_bf16(v[2], v[3]);
                        if (col < 1024) { const int h = col >> 8, dh = col & 255; u32x2v w; w.x = p01; w.y = p23;
                            *(u32x2v*)(Kb + ((size_t)((b * 4 + h) * 256 + key)) * 256 + dh) = w; }
                        else { const int c2 = col - 1024, h = c2 >> 8, dv = c2 & 255, kp = (key & ~31) | permk(key & 31);
                            bf16_t* d = VTp + ((size_t)((b * 4 + h) * 256 + dv)) * 256 + kp;
                            d[0] = (bf16_t)(p01 & 0xffffu); d[256] = (bf16_t)(p01 >> 16); d[512] = (bf16_t)(p23 & 0xffffu); d[768] = (bf16_t)(p23 >> 16); } }
            }
    }
};
}
#ifndef PG8_SP2
#define PG8_SP2 true
#endif
#ifndef PG8_ALIGN
#define PG8_ALIGN true
#endif

constexpr int NWAVES = 8;
#ifndef MK_PER_PHASE
#define MK_PER_PHASE 0
#endif
constexpr int T = 16384, SEQ = 8192, D = 1024;
constexpr int N_PHASES = 12;

constexpr size_t MiB = 1u << 20, KiB = 1u << 10;
constexpr size_t WS_CTL = 0, CTL_ZERO_BYTES = 1 * MiB;
constexpr int CW_BAR = 4096;
constexpr size_t WS_SSQ1 = 64 * KiB, WS_SSQ2 = 128 * KiB;
constexpr size_t WS_AB = 1 * MiB;
constexpr size_t WS_HEND = WS_AB + 512 * KiB, WS_PEND = WS_HEND + 512 * KiB, WS_HIN = WS_PEND + 512 * KiB;
constexpr size_t WS_DEC = WS_HIN + 512 * KiB;
constexpr size_t WS_SUBK = 3 * MiB + 256 * KiB;
constexpr size_t WS_WIN = 4 * MiB, WS_WOUT = 10 * MiB, WS_WQ = 12 * MiB, WS_WKV = 14 * MiB, WS_WO = 18 * MiB, WS_PWQ = 20 * MiB;
constexpr size_t WS_MEMN = 24 * MiB, WS_KB = 25 * MiB, WS_VTP = 26 * MiB, WS_LRUWT = 27 * MiB;
constexpr size_t WS_XB = 28 * MiB;
constexpr size_t WS_HLOC = 28 * MiB, WS_PCUM = 44 * MiB;
constexpr size_t WS_QKV = 60 * MiB;
constexpr size_t WS_Y = 60 * MiB;
constexpr size_t WS_IDX = 60 * MiB, WS_GW = 68 * MiB;
constexpr size_t WS_UB = 92 * MiB;
constexpr size_t WS_XR = 108 * MiB, WS_Z = 124 * MiB, WS_GATE = 140 * MiB;
constexpr size_t WS_WN = 156 * MiB, WS_UF = 172 * MiB, WS_QD = 188 * MiB, WS_KD = 204 * MiB, WS_ATT = 220 * MiB;
constexpr size_t WS_VB = 156 * MiB;
constexpr size_t WS_Q = 188 * MiB, WS_AO = 220 * MiB;
constexpr size_t WS_PQ = 188 * MiB;
constexpr size_t WS_END = 252 * MiB;
static_assert(WS_XR - WS_QKV == (size_t)T * 1536 * 2 && WS_Z - WS_XR == (size_t)T * 512 * 2 && WS_GATE - WS_Z == (size_t)T * 512 * 2, "in-proj outputs are contiguous");

constexpr int LDS_BYTES = 160 * 1024;
constexpr int MISC_OFF = 159 * 1024;

#define GAS __attribute__((address_space(1)))
#define LAS __attribute__((address_space(3)))
typedef unsigned short bf16;
typedef unsigned v4u __attribute__((ext_vector_type(4)));
typedef unsigned v2u __attribute__((ext_vector_type(2)));
typedef float f32x4 __attribute__((ext_vector_type(4)));
typedef short bf16x8 __attribute__((ext_vector_type(8)));
typedef GAS unsigned gu32;
#define LDS_WAIT() asm volatile("s_waitcnt lgkmcnt(0)" ::: "memory")
__device__ __forceinline__ unsigned f2bf(float f) { unsigned u = __builtin_bit_cast(unsigned, f); return (u + 0x7fffu + ((u >> 16) & 1u)) >> 16; }
__device__ __forceinline__ unsigned pk2(float lo, float hi) { return f2bf(lo) | (f2bf(hi) << 16); }
__device__ __forceinline__ float bflo(unsigned u) { return __builtin_bit_cast(float, u << 16); }
__device__ __forceinline__ float bfhi(unsigned u) { return __builtin_bit_cast(float, u & 0xffff0000u); }
__device__ __forceinline__ float bf1(bf16 h) { return __builtin_bit_cast(float, (unsigned)h << 16); }
__device__ __forceinline__ float wave_sum(float v) {
#pragma unroll
    for (int o = 1; o < 64; o <<= 1) v += __shfl_xor(v, o);
    return v;
}
__device__ __forceinline__ float sigmoidf_(float x) { return __builtin_amdgcn_rcpf(1.0f + __expf(-x)); }
__device__ __forceinline__ float softplusf_(float x) { return fmaxf(x, 0.f) + log1pf(__expf(-fabsf(x))); }
__device__ __forceinline__ float siluf_(float x) { return x * __builtin_amdgcn_rcpf(1.0f + __expf(-x)); }
__device__ __forceinline__ float gelu_tanh(float x) { const float y = 0.7978845608028654f * (x + 0.044715f * x * x * x); const float e = __expf(2.0f * y); return x * (1.0f - __builtin_amdgcn_rcpf(1.0f + e)); }
__device__ __forceinline__ int permk(int kl) { return 8 * ((kl & 15) >> 2) + 4 * (kl >> 4) + (kl & 3); }

struct Params {
    const float *x, *mem, *norm_mix_w, *w_in, *conv_qkv_w, *gdn_a_log, *gdn_dt_bias, *gdn_norm_w, *lru_conv_w, *lru_conv_b, *lru_wa, *lru_ba, *lru_wx, *lru_bx, *lru_lambda, *w_out,
                *norm_xattn_w, *norm_mem_w, *xattn_wq, *xattn_wkv, *xattn_wo, *norm_ffn_w, *peer_wq, *peer_subkeys, *peer_u, *peer_v, *norm_final_w;
    float* out; unsigned char* ws; int ph_lo, ph_hi;
};
#define XB_TMO      128
#define XB_XCNT(j)  (256  + 64 * (j))
#define XB_XSUB(j)  (1280 + 64 * (j))
#define XB_XGEN(j)  (2304 + 64 * (j))
#define XB_TOP      3328
#define XB_TOPGEN   3392
#define XCD_BAR_WORDS 3456
#define XB_SPIN_CAP (1u << 18)

__device__ __forceinline__ unsigned xb_ld(unsigned* p)              { return __hip_atomic_load(p, __ATOMIC_RELAXED, __HIP_MEMORY_SCOPE_AGENT); }
__device__ __forceinline__ unsigned xb_add(unsigned* p, unsigned v) { return __hip_atomic_fetch_add(p, v, __ATOMIC_RELAXED, __HIP_MEMORY_SCOPE_AGENT); }
__device__ __forceinline__ unsigned xb_xcc_id() { return (unsigned)__builtin_amdgcn_s_getreg((3 << 11) | 20) & 0xFu; }
#define XB_SPIN(cond, bar) do { unsigned _sp = 0; while (cond) { __builtin_amdgcn_s_sleep(1); \
    if ((++_sp & 255u) == 0u) { if (xb_ld(&(bar)[XB_TMO])) break; if (_sp > XB_SPIN_CAP) { atomicAdd(&(bar)[XB_TMO], 1u); break; } } } } while (0)

struct XcdBarrier {
    unsigned* bar; unsigned x;
    volatile LAS unsigned* st;
};

__device__ __forceinline__ XcdBarrier xcd_barrier_post(unsigned* bar, volatile LAS unsigned* st) {
    XcdBarrier b; b.bar = bar; b.x = xb_xcc_id(); b.st = st;
    if (threadIdx.x == 0) (void)xb_add(&bar[XB_XCNT(b.x)], 1u);
    return b;
}
__device__ __forceinline__ void xcd_barrier_complete(unsigned* bar, unsigned x, unsigned& nloc, unsigned& nx) {
    const unsigned G = gridDim.x * gridDim.y * gridDim.z;
    unsigned sum, cnt, mine, sp = 0u;
    for (;;) {
        sum = 0u; cnt = 0u; mine = 0u;
#pragma unroll
        for (unsigned j = 0; j < 16; ++j) { const unsigned c = xb_ld(&bar[XB_XCNT(j)]); sum += c; cnt += (c > 0u) ? 1u : 0u; mine = (j == x) ? c : mine; }
        if (sum == G) break;
        __builtin_amdgcn_s_sleep(1);
        if ((++sp & 255u) == 0u) { if (xb_ld(&bar[XB_TMO])) break; if (sp > XB_SPIN_CAP) { atomicAdd(&bar[XB_TMO], 1u); break; } }
    }
    nloc = mine > 0u ? mine : 1u; nx = cnt > 0u ? cnt : 1u;
}

__device__ __forceinline__ void xcd_barrier(const XcdBarrier& b) {
    asm volatile("s_waitcnt vmcnt(0)" ::: "memory");
    __syncthreads();
    if (threadIdx.x == 0) {
        unsigned* bar = b.bar;
        __builtin_amdgcn_s_waitcnt(0);
        unsigned nloc = b.st[0], nx = b.st[1];
        if (nloc == 0u) { xcd_barrier_complete(bar, b.x, nloc, nx); b.st[0] = nloc; b.st[1] = nx; }
        const unsigned old = xb_add(&bar[XB_XSUB(b.x)], 1u);
        const unsigned gen = old / nloc;
        if (old + 1u == (gen + 1u) * nloc) {
            __builtin_amdgcn_fence(__ATOMIC_RELEASE, "agent");
            asm volatile("s_waitcnt vmcnt(0)" ::: "memory");
            const unsigned og = xb_add(&bar[XB_TOP], 1u);
            const unsigned tg = og / nx;
            if (og + 1u == (tg + 1u) * nx) xb_add(&bar[XB_TOPGEN], 1u);
            else XB_SPIN(xb_ld(&bar[XB_TOPGEN]) == tg, bar);
            __builtin_amdgcn_fence(__ATOMIC_ACQUIRE, "agent");
            xb_add(&bar[XB_XGEN(b.x)], 1u);
            asm volatile("s_waitcnt vmcnt(0)" ::: "memory");
        } else {
            XB_SPIN(xb_ld(&bar[XB_XGEN(b.x)]) == gen, bar);
            __builtin_amdgcn_fence(__ATOMIC_ACQUIRE, "agent");
            asm volatile("s_waitcnt vmcnt(0)" ::: "memory");
        }
    }
    __syncthreads();
}

__device__ __forceinline__ void p0_transpose_item(const float* W, int K, int ldw, int c0, int nblk, bf16* WT, int row_off, const float* ks, LAS float* scr, int item, int lane) {
    const int kb = item / nblk, nb = item % nblk, k0 = 64 * kb, n0 = 32 * nb;
#pragma unroll 8
    for (int i = 0; i < 32; ++i) { const int kk = 2 * i + (lane >> 5); float v = W[(size_t)(k0 + kk) * ldw + c0 + n0 + (lane & 31)]; if (ks) v *= ks[k0 + kk]; scr[kk * 33 + (lane & 31)] = v; }
    LDS_WAIT(); asm volatile("" ::: "memory");
    const int c = lane & 7;
#pragma unroll
    for (int j = 0; j < 4; ++j) { const int n = (lane >> 3) + 8 * j; const LAS float* s = scr + (8 * c) * 33 + n;
        v4u o; o.x = pk2(s[0 * 33], s[1 * 33]); o.y = pk2(s[2 * 33], s[3 * 33]); o.z = pk2(s[4 * 33], s[5 * 33]); o.w = pk2(s[6 * 33], s[7 * 33]);
        *(GAS v4u*)(WT + (size_t)(row_off + n0 + n) * K + k0 + 8 * c) = o; }
    LDS_WAIT(); asm volatile("" ::: "memory");
}

__device__ __forceinline__ void p0_prologue(const Params& P, LAS unsigned char* lds, int tid, int lane, int wave, int vcu, int G) {
    unsigned char* ws = P.ws;
    const int gw = vcu * NWAVES + wave, NGW = G * NWAVES;
    LAS float* wabl = (LAS float*)lds;
    for (int idx = tid; idx < 8192; idx += NWAVES * 64) { const int k = idx >> 3, c = idx & 7, j = k >> 8, l = (k >> 2) & 63, e = k & 3;
        wabl[((((j * 4 + e) * 2 + (c >> 2)) * 64 + l) << 2) + (c & 3)] = P.w_in[(size_t)k * 3080 + 2048 + c]; }
    __syncthreads();
    {
        bf16* XB0 = (bf16*)(ws + WS_XB); float* AB = (float*)(ws + WS_AB);
        f32x4 w4[4];
#pragma unroll
        for (int j = 0; j < 4; ++j) w4[j] = ((const f32x4*)P.norm_mix_w)[64 * j + lane];
        for (int m = gw; m < T; m += NGW) {
            const f32x4* xr = (const f32x4*)(P.x + (size_t)m * D) + lane;
            f32x4 v[4]; float s = 0.f;
#pragma unroll
            for (int j = 0; j < 4; ++j) { v[j] = xr[64 * j]; s += (v[j].x * v[j].x + v[j].y * v[j].y) + (v[j].z * v[j].z + v[j].w * v[j].w); }
            const float rstd = rsqrtf(wave_sum(s) * (1.0f / D) + 1e-6f);
            v2u* o8 = (v2u*)(XB0 + (size_t)m * D) + lane;
            float part[8];
#pragma unroll
            for (int c = 0; c < 8; ++c) part[c] = 0.f;
#pragma unroll
            for (int j = 0; j < 4; ++j) {
                v[j] = v[j] * rstd * w4[j];
                v2u o; o.x = pk2(v[j].x, v[j].y); o.y = pk2(v[j].z, v[j].w); o8[64 * j] = o;
#pragma unroll
                for (int e = 0; e < 4; ++e) {
                    const f32x4 wa = *(const LAS f32x4*)(wabl + ((((j * 4 + e) * 2 + 0) * 64 + lane) << 2));
                    const f32x4 wb = *(const LAS f32x4*)(wabl + ((((j * 4 + e) * 2 + 1) * 64 + lane) << 2));
                    const float hv = v[j][e];
                    part[0] += hv * wa.x; part[1] += hv * wa.y; part[2] += hv * wa.z; part[3] += hv * wa.w;
                    part[4] += hv * wb.x; part[5] += hv * wb.y; part[6] += hv * wb.z; part[7] += hv * wb.w;
                }
            }
#pragma unroll
            for (int c = 0; c < 8; ++c) part[c] = wave_sum(part[c]);
            float o = part[0];
#pragma unroll
            for (int c = 1; c < 8; ++c) o = (lane == c) ? part[c] : o;
            if (lane < 8) AB[(size_t)m * 8 + lane] = o;
        }
    }
    {
        bf16* MEMN = (bf16*)(ws + WS_MEMN);
        for (int m = gw; m < 512; m += NGW) {
            const f32x4* xr = (const f32x4*)(P.mem + (size_t)m * D) + lane;
            f32x4 v[4]; float s = 0.f;
#pragma unroll
            for (int j = 0; j < 4; ++j) { v[j] = xr[64 * j]; s += (v[j].x * v[j].x + v[j].y * v[j].y) + (v[j].z * v[j].z + v[j].w * v[j].w); }
            const float rstd = rsqrtf(wave_sum(s) * (1.0f / D) + 1e-6f);
            v2u* o8 = (v2u*)(MEMN + (size_t)m * D) + lane;
#pragma unroll
            for (int j = 0; j < 4; ++j) { const f32x4 w = ((const f32x4*)P.norm_mem_w)[64 * j + lane]; const f32x4 y = v[j] * rstd * w;
                v2u o; o.x = pk2(y.x, y.y); o.y = pk2(y.z, y.w); o8[64 * j] = o; }
        }
    }
    __syncthreads();
    {
        LAS float* scr = (LAS float*)(lds + wave * 16384);
        constexpr int I_IN1 = 16 * 48, I_IN2 = 16 * 16, I_OUT = 16 * 32, I_Q = 16 * 32, I_KV = 16 * 64, I_O = 16 * 32, I_PQ = 0;
        constexpr int NITEMS = I_IN1 + 3 * I_IN2 + I_OUT + I_Q + I_KV + I_O + I_PQ;
        for (int it = gw; it < NITEMS; it += NGW) {
            int r = it;
            if (r < I_IN1) { p0_transpose_item(P.w_in, 1024, 3080, 0, 48, (bf16*)(ws + WS_WIN), 0, nullptr, scr, r, lane); continue; } r -= I_IN1;
            if (r < I_IN2) { p0_transpose_item(P.w_in, 1024, 3080, 2056, 16, (bf16*)(ws + WS_WIN), 1536, nullptr, scr, r, lane); continue; } r -= I_IN2;
            if (r < I_IN2) { p0_transpose_item(P.w_in, 1024, 3080, 1536, 16, (bf16*)(ws + WS_WIN), 2048, nullptr, scr, r, lane); continue; } r -= I_IN2;
            if (r < I_IN2) { p0_transpose_item(P.w_in, 1024, 3080, 2568, 16, (bf16*)(ws + WS_WIN), 2560, nullptr, scr, r, lane); continue; } r -= I_IN2;
            if (r < I_OUT) { p0_transpose_item(P.w_out, 1024, 1024, 0, 32, (bf16*)(ws + WS_WOUT), 0, nullptr, scr, r, lane); continue; } r -= I_OUT;
            if (r < I_Q) { p0_transpose_item(P.xattn_wq, 1024, 1024, 0, 32, (bf16*)(ws + WS_WQ), 0, P.norm_xattn_w, scr, r, lane); continue; } r -= I_Q;
            if (r < I_KV) { p0_transpose_item(P.xattn_wkv, 1024, 2048, 0, 64, (bf16*)(ws + WS_WKV), 0, nullptr, scr, r, lane); continue; } r -= I_KV;
            if (r < I_O) { p0_transpose_item(P.xattn_wo, 1024, 1024, 0, 32, (bf16*)(ws + WS_WO), 0, nullptr, scr, r, lane); continue; } r -= I_O;
            (void)r;
        }
    }
    {
        bf16* WT = (bf16*)(ws + WS_LRUWT);
        for (int it = vcu * NWAVES * 64 + tid; it < 8 * 2 * 64 * 8; it += G * NWAVES * 64) {
            const int i8 = it & 7, j = (it >> 3) & 63, m = (it >> 9) & 1, g = it >> 10;
            const float* src = (m ? P.lru_wx : P.lru_wa) + (size_t)(g * 64 + 8 * i8) * 64 + j;
            v4u o; o.x = pk2(src[0], src[64]); o.y = pk2(src[128], src[192]); o.z = pk2(src[256], src[320]); o.w = pk2(src[384], src[448]);
            *(v4u*)(WT + (size_t)it * 8) = o;
        }
    }
    {
        bf16* WF = (bf16*)(ws + WS_PWQ);
        const int col = lane & 15, g = lane >> 4;
        for (int it = gw; it < 16 * 64; it += NGW) {
            const int hp = it >> 6, k0 = (it & 63) * 16;
            bf16x8 bq[4];
#pragma unroll
            for (int s = 0; s < 4; ++s) { const f32x4* src = (const f32x4*)(P.peer_wq + (size_t)(k0 + col) * 2048 + hp * 128 + 32 * s + 8 * g);
                const f32x4 a = src[0], c = src[1]; v4u pk; pk.x = pk2(a.x, a.y); pk.y = pk2(a.z, a.w); pk.z = pk2(c.x, c.y); pk.w = pk2(c.z, c.w); bq[s] = __builtin_bit_cast(bf16x8, pk); }
            const float nw = P.norm_ffn_w[k0 + col];
#pragma unroll 2
            for (int kt = 0; kt < 8; ++kt) {
                f32x4 acc = (f32x4){0.f, 0.f, 0.f, 0.f};
#pragma unroll
                for (int s = 0; s < 4; ++s) { const f32x4* src = (const f32x4*)(P.peer_subkeys + (size_t)(hp * 128 + 16 * kt + col) * 128 + 32 * s + 8 * g);
                    const f32x4 a = src[0], c = src[1]; v4u pk; pk.x = pk2(a.x, a.y); pk.y = pk2(a.z, a.w); pk.z = pk2(c.x, c.y); pk.w = pk2(c.z, c.w);
                    acc = __builtin_amdgcn_mfma_f32_16x16x32_bf16(__builtin_bit_cast(bf16x8, pk), bq[s], acc, 0, 0, 0); }
#pragma unroll
                for (int i = 0; i < 4; ++i) WF[(size_t)(hp * 128 + 16 * kt + 4 * g + i) * 1024 + k0 + col] = (bf16)f2bf(acc[i] * nw);
            }
        }
    }
}

constexpr int GL_KS = 0, GL_VS = 33792, GL_KB = 67584, GL_QB = 84992, GL_RAW = 102400, GL_CW = 153856, GL_AMT = 133120, GL_SM = 160000, GL_ATT = 151808, GL_SOL = 67584;
static_assert(GL_CW + 6144 <= GL_SM && GL_SM + 1280 <= MISC_OFF && GL_SOL + 65536 <= GL_AMT && GL_AMT + 17408 <= GL_ATT && GL_ATT + 8192 <= GL_SM && GL_RAW + 51456 <= GL_CW, "gdn_local LDS map");
#ifndef GL_REP_STEP
#define GL_REP_STEP -1
#endif
#define GL_REPF(k) for (int rr_ = 0; rr_ < ((GL_REP_STEP == (k)) ? 2 : 1); ++rr_)
#define GL_BAR() do { asm volatile("s_waitcnt lgkmcnt(0)" ::: "memory"); __builtin_amdgcn_s_barrier(); asm volatile("" ::: "memory"); } while (0)
__device__ __forceinline__ void gdn_local_item(const Params& P, LAS unsigned char* lds, int item, int tid) {
    unsigned char* ws = P.ws;
    asm volatile("" : "+v"(tid));
    const int b = item >> 9, h = (item >> 7) & 3, n = item & 127;
    const int t0 = b * SEQ + n * 64;
    const int lane = tid & 63, wave = __builtin_amdgcn_readfirstlane(tid >> 6);
    LAS float* ks = (LAS float*)(lds + GL_KS);
    LAS float* vs = (LAS float*)(lds + GL_VS);
    LAS bf16* kb16 = (LAS bf16*)(lds + GL_KB);
    LAS bf16* qb16 = (LAS bf16*)(lds + GL_QB);
    LAS bf16* raw = (LAS bf16*)(lds + GL_RAW);
    LAS float* cw = (LAS float*)(lds + GL_CW);
    LAS float* AmT = (LAS float*)(lds + GL_AMT);
    LAS float* sg = (LAS float*)(lds + GL_SM);
    LAS float* sbeta = sg + 64; LAS float* sgc = sbeta + 64; LAS float* seg = sgc + 64; LAS float* sek = seg + 64;
    LAS bf16* atts = (LAS bf16*)(lds + GL_ATT);
    const bf16* QKV = (const bf16*)(ws + WS_QKV);
    const float* AB = (const float*)(ws + WS_AB);
    GL_REPF(0) {
        v4u pr[7];
#pragma unroll
        for (int r = 0; r < 7; ++r) {
            const int id = tid + 512 * r;
            const int row = id / 48, rem = id - row * 48, part = rem >> 4, ck = rem & 15, s = n * 64 + row - 3;
            pr[r] = (v4u){0u, 0u, 0u, 0u};
            if (id < 67 * 48 && s >= 0) pr[r] = *(const v4u*)(QKV + (size_t)(b * SEQ + s) * 1536 + part * 512 + h * 128 + ck * 8);
        }
        f32x4 cwv = (f32x4){0.f, 0.f, 0.f, 0.f};
        if (tid < 384) { const int j = tid / 96, rem = tid - j * 96, part = rem >> 5, c4 = rem & 31; cwv = *(const f32x4*)(P.conv_qkv_w + j * 1536 + part * 512 + h * 128 + c4 * 4); }
        float a_in = 0.f, b_in = 0.f;
        if (tid < 64) { a_in = AB[(size_t)(t0 + tid) * 8 + h]; b_in = AB[(size_t)(t0 + tid) * 8 + 4 + h]; }
#pragma unroll
        for (int r = 0; r < 7; ++r) { const int id = tid + 512 * r; if (id < 67 * 48) *(LAS v4u*)(raw + id * 8) = pr[r]; }
        if (tid < 384) *(LAS f32x4*)(cw + tid * 4) = cwv;
        if (tid < 64) { sg[tid] = -__expf(P.gdn_a_log[h]) * softplusf_(a_in + P.gdn_dt_bias[h]); sbeta[tid] = sigmoidf_(b_in); }
    }
    GL_BAR();
    GL_REPF(1) {
        const int c = tid >> 3, grp = tid & 7;
#pragma unroll 1
        for (int part = 0; part < 3; ++part) {
            float y[16];
#pragma unroll
            for (int i = 0; i < 16; ++i) y[i] = 0.f;
#pragma unroll
            for (int j = 0; j < 4; ++j) {
                const LAS v4u* src = (const LAS v4u*)(raw + (c + j) * 384 + part * 128 + grp * 16);
                const v4u x0 = src[0], x1 = src[1];
                const LAS f32x4* wp = (const LAS f32x4*)(cw + (j * 3 + part) * 128 + grp * 16);
                const f32x4 w0 = wp[0], w1 = wp[1], w2 = wp[2], w3 = wp[3];
                y[0] += w0.x * bflo(x0.x); y[1] += w0.y * bfhi(x0.x); y[2] += w0.z * bflo(x0.y); y[3] += w0.w * bfhi(x0.y);
                y[4] += w1.x * bflo(x0.z); y[5] += w1.y * bfhi(x0.z); y[6] += w1.z * bflo(x0.w); y[7] += w1.w * bfhi(x0.w);
                y[8] += w2.x * bflo(x1.x); y[9] += w2.y * bfhi(x1.x); y[10] += w2.z * bflo(x1.y); y[11] += w2.w * bfhi(x1.y);
                y[12] += w3.x * bflo(x1.z); y[13] += w3.y * bfhi(x1.z); y[14] += w3.z * bflo(x1.w); y[15] += w3.w * bfhi(x1.w);
            }
            float ss = 0.f;
#pragma unroll
            for (int i = 0; i < 16; ++i) { y[i] = siluf_(y[i]); ss += y[i] * y[i]; }
            if (part < 2) {
                ss += __shfl_xor(ss, 1); ss += __shfl_xor(ss, 2); ss += __shfl_xor(ss, 4);
                const float sc = rsqrtf(ss + 1e-6f) * (part == 0 ? 0.08838834764831845f : 1.0f);
#pragma unroll
                for (int i = 0; i < 16; ++i) y[i] *= sc;
            }
            if (part >= 1) {
                LAS float* dst = (part == 1 ? ks : vs) + c * 132 + grp * 16;
#pragma unroll
                for (int i = 0; i < 4; ++i) *(LAS f32x4*)(dst + 4 * i) = (f32x4){y[4 * i], y[4 * i + 1], y[4 * i + 2], y[4 * i + 3]};
            }
            if (part <= 1) {
                LAS bf16* dst = (part == 0 ? qb16 : kb16) + c * 136 + grp * 16;
                v4u o0, o1; o0.x = pk2(y[0], y[1]); o0.y = pk2(y[2], y[3]); o0.z = pk2(y[4], y[5]); o0.w = pk2(y[6], y[7]);
                o1.x = pk2(y[8], y[9]); o1.y = pk2(y[10], y[11]); o1.z = pk2(y[12], y[13]); o1.w = pk2(y[14], y[15]);
                *(LAS v4u*)dst = o0; *(LAS v4u*)(dst + 8) = o1;
            }
        }
    }
    if (tid < 64) {
        float v = sg[tid];
#pragma unroll
        for (int off = 1; off < 64; off <<= 1) { const float t = __shfl_up(v, off); if (tid >= off) v += t; }
        sgc[tid] = v; seg[tid] = __expf(v);
        const float gl = __shfl(v, 63);
        sek[tid] = __expf(gl - v);
        if (tid == 63) ((float*)(ws + WS_DEC))[item] = __expf(v);
    }
    GL_BAR();
    {
        const int mat = wave >> 2, rho = wave & 3, col = lane & 15, g = lane >> 4;
        const LAS bf16* X = mat ? qb16 : kb16;
        bf16x8 af[4];
#pragma unroll
        for (int s = 0; s < 4; ++s) af[s] = *(const LAS bf16x8*)(X + (16 * rho + col) * 136 + 32 * s + 8 * g);
#pragma unroll
        for (int sig = 0; sig < 4; ++sig) {
            f32x4 acc = (f32x4){0.f, 0.f, 0.f, 0.f};
#pragma unroll
            for (int s = 0; s < 4; ++s) { const bf16x8 bfr = *(const LAS bf16x8*)(kb16 + (16 * sig + col) * 136 + 32 * s + 8 * g); acc = __builtin_amdgcn_mfma_f32_16x16x32_bf16(af[s], bfr, acc, 0, 0, 0); }
            const int sidx = 16 * sig + col; const float gs = sgc[sidx];
#pragma unroll
            for (int i = 0; i < 4; ++i) {
                const int c = 16 * rho + 4 * g + i;
                const float dec = (c >= sidx) ? __expf(sgc[c] - gs) : 0.f;
                if (mat == 0) AmT[sidx * 68 + c] = (c > sidx) ? sbeta[c] * acc[i] * dec : 0.f;
                else atts[c * 64 + sidx] = (bf16)f2bf(acc[i] * dec);
            }
        }
    }
    GL_BAR();
    GL_REPF(4) {
        bf16* QD = (bf16*)(ws + WS_QD) + (size_t)item * 8192;
        bf16* KD = (bf16*)(ws + WS_KD) + (size_t)item * 8192;
        bf16* ATT = (bf16*)(ws + WS_ATT) + (size_t)item * 4096;
#pragma unroll
        for (int r = 0; r < 2; ++r) {
            const int id = tid + 512 * r;
            { const int c = id >> 4, gam = id & 15, s32 = gam >> 2, g = gam & 3;
              const v2u lo = *(const LAS v2u*)(qb16 + c * 136 + 32 * s32 + 4 * g), hi = *(const LAS v2u*)(qb16 + c * 136 + 32 * s32 + 16 + 4 * g);
              const float e = seg[c];
              v4u o; o.x = pk2(bflo(lo.x) * e, bfhi(lo.x) * e); o.y = pk2(bflo(lo.y) * e, bfhi(lo.y) * e); o.z = pk2(bflo(hi.x) * e, bfhi(hi.x) * e); o.w = pk2(bflo(hi.y) * e, bfhi(hi.y) * e);
              *(v4u*)(QD + c * 128 + 8 * gam) = o; }
            { const int dk = id >> 3, gam = id & 7, s32 = gam >> 2, g = gam & 3, c0 = 32 * s32 + 4 * g;
              float v[8];
#pragma unroll
              for (int j = 0; j < 4; ++j) { v[j] = ks[(c0 + j) * 132 + dk] * sek[c0 + j]; v[4 + j] = ks[(c0 + 16 + j) * 132 + dk] * sek[c0 + 16 + j]; }
              v4u o; o.x = pk2(v[0], v[1]); o.y = pk2(v[2], v[3]); o.z = pk2(v[4], v[5]); o.w = pk2(v[6], v[7]);
              *(v4u*)(KD + dk * 64 + 8 * gam) = o; }
        }
        { const int c = tid >> 3, gam = tid & 7, s32 = gam >> 2, g = gam & 3;
          const v2u lo = *(const LAS v2u*)(atts + c * 64 + 32 * s32 + 4 * g), hi = *(const LAS v2u*)(atts + c * 64 + 32 * s32 + 16 + 4 * g);
          v4u o; o.x = lo.x; o.y = lo.y; o.z = hi.x; o.w = hi.y;
          *(v4u*)(ATT + c * 64 + 8 * gam) = o; }
    }
    GL_BAR();
    GL_REPF(5) {
        LAS float* xcol = (LAS float*)(lds + GL_SOL);
        LAS bf16* tinv = (LAS bf16*)(lds + GL_SOL + 17408);
        const int j = tid >> 3, part = tid & 7, jb = j >> 4, jo = j & 15;
#pragma unroll 1
        for (int rb = jb; rb < 4; ++rb) {
            float acc[16];
#pragma unroll
            for (int i = 0; i < 16; ++i) acc[i] = 0.f;
            if (rb > jb) {
#pragma unroll 2
                for (int s = 16 * jb + part; s < 16 * rb; s += 8) {
                    const float sv = xcol[j * 68 + s];
                    const LAS float* ar = AmT + s * 68 + 16 * rb;
#pragma unroll
                    for (int q = 0; q < 4; ++q) { const f32x4 A4 = *(const LAS f32x4*)(ar + 4 * q);
                        acc[4 * q] -= A4.x * sv; acc[4 * q + 1] -= A4.y * sv; acc[4 * q + 2] -= A4.z * sv; acc[4 * q + 3] -= A4.w * sv; }
                }
#pragma unroll
                for (int i = 0; i < 16; ++i) {
                    acc[i] += __builtin_bit_cast(float, __builtin_amdgcn_update_dpp(0, __builtin_bit_cast(int, acc[i]), 0xB1, 0xF, 0xF, true));
                    acc[i] += __builtin_bit_cast(float, __builtin_amdgcn_update_dpp(0, __builtin_bit_cast(int, acc[i]), 0x4E, 0xF, 0xF, true));
                    acc[i] += __builtin_bit_cast(float, __builtin_amdgcn_update_dpp(0, __builtin_bit_cast(int, acc[i]), 0x141, 0xF, 0xF, true));
                }
            } else {
#pragma unroll
                for (int i = 0; i < 16; ++i) acc[i] = (i == jo) ? 1.f : 0.f;
            }
#pragma unroll
            for (int i = 0; i < 16; ++i) {
                const float sv = acc[i];
                const LAS float* ar = AmT + (16 * rb + i) * 68 + 16 * rb;
#pragma unroll
                for (int q = (i + 1) / 4; q < 4; ++q) { const f32x4 A4 = *(const LAS f32x4*)(ar + 4 * q);
                    if (4 * q > i) acc[4 * q] -= A4.x * sv; if (4 * q + 1 > i) acc[4 * q + 1] -= A4.y * sv; if (4 * q + 2 > i) acc[4 * q + 2] -= A4.z * sv; if (4 * q + 3 > i) acc[4 * q + 3] -= A4.w * sv; }
            }
            if (part == 0) {
#pragma unroll
                for (int i = 0; i < 16; ++i) { xcol[j * 68 + 16 * rb + i] = acc[i]; tinv[(16 * rb + i) * 72 + j] = (bf16)f2bf(acc[i]); }
            }
            LDS_WAIT(); asm volatile("" ::: "memory");
        }
        for (int rb = 0; rb < jb; ++rb) {
            if (part == 0) {
#pragma unroll
                for (int i = 0; i < 16; ++i) tinv[(16 * rb + i) * 72 + j] = (bf16)0;
            }
        }
    }
    GL_BAR();
    GL_REPF(6) {
        const LAS bf16* tinv = (const LAS bf16*)(lds + GL_SOL + 17408);
        LAS bf16* wst = (LAS bf16*)(lds + GL_SOL + 17408 + 9216);
        const int col = lane & 15, g = lane >> 4, isw = wave >> 2;
        bf16x8 af[4][2];
#pragma unroll
        for (int rho = 0; rho < 4; ++rho)
#pragma unroll
            for (int s2 = 0; s2 < 2; ++s2) af[rho][s2] = *(const LAS bf16x8*)(tinv + (16 * rho + col) * 72 + 32 * s2 + 8 * g);
        bf16* UF = (bf16*)(ws + WS_UF) + (size_t)item * 8192;
#pragma unroll
        for (int sig = 0; sig < 2; ++sig) {
            const int jj = 32 * (wave & 3) + 16 * sig + col;
            const LAS float* src = (isw ? ks : vs) + jj;
            bf16x8 bfr[2];
#pragma unroll
            for (int s2 = 0; s2 < 2; ++s2) {
                float v[8];
#pragma unroll
                for (int e = 0; e < 8; ++e) { const int sidx = 32 * s2 + 8 * g + e; float x = src[sidx * 132] * sbeta[sidx]; if (isw) x *= seg[sidx]; v[e] = x; }
                v4u pk; pk.x = pk2(v[0], v[1]); pk.y = pk2(v[2], v[3]); pk.z = pk2(v[4], v[5]); pk.w = pk2(v[6], v[7]);
                bfr[s2] = __builtin_bit_cast(bf16x8, pk);
            }
            f32x4 acc[4];
#pragma unroll
            for (int rho = 0; rho < 4; ++rho) { acc[rho] = (f32x4){0.f, 0.f, 0.f, 0.f};
#pragma unroll
                for (int s2 = 0; s2 < 2; ++s2) acc[rho] = __builtin_amdgcn_mfma_f32_16x16x32_bf16(af[rho][s2], bfr[s2], acc[rho], 0, 0, 0); }
            if (!isw) {
                v4u o0, o1;
                o0.x = pk2(acc[0].x, acc[0].y); o0.y = pk2(acc[0].z, acc[0].w); o0.z = pk2(acc[1].x, acc[1].y); o0.w = pk2(acc[1].z, acc[1].w);
                o1.x = pk2(acc[2].x, acc[2].y); o1.y = pk2(acc[2].z, acc[2].w); o1.z = pk2(acc[3].x, acc[3].y); o1.w = pk2(acc[3].z, acc[3].w);
                v4u* d = (v4u*)(UF + (size_t)(2 * (wave & 3) + sig) * 1024 + lane * 16);
                d[0] = o0; d[1] = o1;
            } else {
#pragma unroll
                for (int rho = 0; rho < 4; ++rho)
#pragma unroll
                    for (int i = 0; i < 4; ++i) wst[(16 * rho + 4 * g + i) * 136 + jj] = (bf16)f2bf(-acc[rho][i]);
            }
        }
    }
    GL_BAR();
    {
        const LAS bf16* wst = (const LAS bf16*)(lds + GL_SOL + 17408 + 9216);
        bf16* WN = (bf16*)(ws + WS_WN) + (size_t)item * 8192;
#pragma unroll
        for (int r = 0; r < 2; ++r) {
            const int id = tid + 512 * r, c = id >> 4, gam = id & 15, s32 = gam >> 2, g = gam & 3;
            const v2u lo = *(const LAS v2u*)(wst + c * 136 + 32 * s32 + 4 * g), hi = *(const LAS v2u*)(wst + c * 136 + 32 * s32 + 16 + 4 * g);
            v4u o; o.x = lo.x; o.y = lo.y; o.z = hi.x; o.w = hi.y;
            *(v4u*)(WN + c * 128 + 8 * gam) = o;
        }
    }
    GL_BAR();
}

constexpr int LL_XCB = 68608;
static_assert(LL_XCB + 64 * 1040 <= MISC_OFF, "lru_local LDS map");
__device__ __forceinline__ float expm1_small(float x) {
    const float p = x * (1.0f + x * (0.5f + x * (0.16666667f + x * (0.041666668f + x * 0.008333334f))));
    return (x > -0.25f) ? p : (__expf(x) - 1.0f);
}
__device__ __forceinline__ void lru_local_item(const Params& P, LAS unsigned char* lds, int lt, int tid, int lane, int wave) {
    unsigned char* ws = P.ws;
    asm volatile("" : "+v"(tid));
    const int b = lt >> 7, n = lt & 127, t0 = b * SEQ + n * 64;
    LAS bf16* rawx = (LAS bf16*)lds;
    LAS bf16* xcb = (LAS bf16*)(lds + LL_XCB);
    const bf16* XR = (const bf16*)(ws + WS_XR);
    {
        v4u pr[9];
#pragma unroll
        for (int r = 0; r < 9; ++r) { const int id = tid + 512 * r, row = id >> 6, ck = id & 63, s = n * 64 + row - 3;
            pr[r] = (v4u){0u, 0u, 0u, 0u};
            if (id < 67 * 64 && s >= 0) pr[r] = *(const v4u*)(XR + (size_t)(b * SEQ + s) * 512 + ck * 8); }
#pragma unroll
        for (int r = 0; r < 9; ++r) { const int id = tid + 512 * r; if (id < 67 * 64) *(LAS v4u*)(rawx + id * 8) = pr[r]; }
    }
    GL_BAR();
    {
        const int chg = tid & 63, tseg = tid >> 6, ch0 = chg * 8;
        float w[4][8], cb[8];
#pragma unroll
        for (int j = 0; j < 4; ++j) { const f32x4 a = *(const f32x4*)(P.lru_conv_w + j * 512 + ch0), c = *(const f32x4*)(P.lru_conv_w + j * 512 + ch0 + 4);
            w[j][0] = a.x; w[j][1] = a.y; w[j][2] = a.z; w[j][3] = a.w; w[j][4] = c.x; w[j][5] = c.y; w[j][6] = c.z; w[j][7] = c.w; }
        { const f32x4 a = *(const f32x4*)(P.lru_conv_b + ch0), c = *(const f32x4*)(P.lru_conv_b + ch0 + 4);
          cb[0] = a.x; cb[1] = a.y; cb[2] = a.z; cb[3] = a.w; cb[4] = c.x; cb[5] = c.y; cb[6] = c.z; cb[7] = c.w; }
        v4u xr[11];
#pragma unroll
        for (int r = 0; r < 11; ++r) xr[r] = *(const LAS v4u*)(rawx + (tseg * 8 + r) * 512 + ch0);
#pragma unroll
        for (int tk = 0; tk < 8; ++tk) {
            float y[8];
#pragma unroll
            for (int e = 0; e < 8; ++e) y[e] = cb[e];
#pragma unroll
            for (int j = 0; j < 4; ++j) { const v4u x = xr[tk + j];
                y[0] += w[j][0] * bflo(x.x); y[1] += w[j][1] * bfhi(x.x); y[2] += w[j][2] * bflo(x.y); y[3] += w[j][3] * bfhi(x.y);
                y[4] += w[j][4] * bflo(x.z); y[5] += w[j][5] * bfhi(x.z); y[6] += w[j][6] * bflo(x.w); y[7] += w[j][7] * bfhi(x.w); }
            v4u o; o.x = pk2(y[0], y[1]); o.y = pk2(y[2], y[3]); o.z = pk2(y[4], y[5]); o.w = pk2(y[6], y[7]);
            *(LAS v4u*)(xcb + (tseg * 8 + tk) * 520 + ch0) = o;
        }
    }
    GL_BAR();
    {
        const int g = wave, col = lane & 15, g4 = lane >> 4;
        LAS bf16* AM = (LAS bf16*)(lds + wave * 8192); LAS bf16* BT = AM + 2048;
        const bf16* WT = (const bf16*)(ws + WS_LRUWT) + (size_t)g * 8192;
        bf16x8 Bw[2][4][2];
#pragma unroll
        for (int m = 0; m < 2; ++m)
#pragma unroll
            for (int jt = 0; jt < 4; ++jt)
#pragma unroll
                for (int s2 = 0; s2 < 2; ++s2) Bw[m][jt][s2] = *(const bf16x8*)(WT + m * 4096 + (16 * jt + col) * 64 + 32 * s2 + 8 * g4);
        float cba[4], cbx[4], csp[4];
#pragma unroll
        for (int jt = 0; jt < 4; ++jt) { const int ch = g * 64 + 16 * jt + col; cba[jt] = P.lru_ba[ch]; cbx[jt] = P.lru_bx[ch]; csp[jt] = softplusf_(-P.lru_lambda[ch]); }
        bf16* HLOC = (bf16*)(ws + WS_HLOC); bf16* PCUM = (bf16*)(ws + WS_PCUM);
        const int chs = g * 64 + lane;
        float hst = 0.f, pc = 1.f;
#pragma unroll 1
        for (int half = 0; half < 2; ++half) {
            bf16x8 Af[2][2];
#pragma unroll
            for (int rho = 0; rho < 2; ++rho)
#pragma unroll
                for (int s2 = 0; s2 < 2; ++s2) Af[rho][s2] = *(const LAS bf16x8*)(xcb + (32 * half + 16 * rho + col) * 520 + g * 64 + 32 * s2 + 8 * g4);
#pragma unroll
            for (int jt = 0; jt < 4; ++jt) {
#pragma unroll
                for (int rho = 0; rho < 2; ++rho) {
                    f32x4 ra = (f32x4){0.f, 0.f, 0.f, 0.f}, rx = ra;
#pragma unroll
                    for (int s2 = 0; s2 < 2; ++s2) { ra = __builtin_amdgcn_mfma_f32_16x16x32_bf16(Af[rho][s2], Bw[0][jt][s2], ra, 0, 0, 0); rx = __builtin_amdgcn_mfma_f32_16x16x32_bf16(Af[rho][s2], Bw[1][jt][s2], rx, 0, 0, 0); }
#pragma unroll
                    for (int i = 0; i < 4; ++i) {
                        const int tokl = 16 * rho + 4 * g4 + i, chl = 16 * jt + col;
                        const float r = sigmoidf_(ra[i] + cba[jt]), ig = sigmoidf_(rx[i] + cbx[jt]);
                        const float log_a = -8.0f * r * csp[jt];
                        const float am = -expm1_small(log_a), a = 1.0f - am;
                        const float xo = bf1(xcb[(32 * half + tokl) * 520 + g * 64 + chl]);
                        const float bt = __builtin_amdgcn_sqrtf(fmaxf(am * (1.0f + a), 0.f)) * (ig * xo);
                        AM[tokl * 64 + chl] = (bf16)f2bf(am); BT[tokl * 64 + chl] = (bf16)f2bf(bt);
                    }
                }
            }
            LDS_WAIT(); asm volatile("" ::: "memory");
#pragma unroll 8
            for (int tk = 0; tk < 32; ++tk) {
                const float am = bf1(AM[tk * 64 + lane]), bt = bf1(BT[tk * 64 + lane]);
                hst = (hst - am * hst) + bt; pc = pc - am * pc;
                const size_t o = (size_t)(t0 + 32 * half + tk) * 512 + chs;
                HLOC[o] = (bf16)f2bf(hst); PCUM[o] = (bf16)f2bf(pc);
            }
            LDS_WAIT(); asm volatile("" ::: "memory");
        }
        ((float*)(ws + WS_HEND))[(size_t)lt * 512 + chs] = hst; ((float*)(ws + WS_PEND))[(size_t)lt * 512 + chs] = pc;
    }
    GL_BAR();
}

constexpr int SC_WN = 0, SC_QD = 64 * 272, SC_KD = 2 * 64 * 272, SC_ATT = 2 * 64 * 272 + 128 * 144, SC_BUF = 2 * 64 * 272 + 128 * 144 + 64 * 144;
constexpr int SC_SSQ = 2 * SC_BUF;
__device__ __forceinline__ int sc_lds_off(int id) {
    if (id < 1024) return SC_WN + (id >> 4) * 272 + (id & 15) * 16;
    if (id < 2048) { const int q = id - 1024; return SC_QD + (q >> 4) * 272 + (q & 15) * 16; }
    if (id < 3072) { const int q = id - 2048; return SC_KD + (q >> 3) * 144 + (q & 7) * 16; }
    const int q = id - 3072; return SC_ATT + (q >> 3) * 144 + (q & 7) * 16;
}
__device__ __forceinline__ const v4u* sc_src(const unsigned char* ws, int item, int id) {
    if (id < 1024) return (const v4u*)(ws + WS_WN + (size_t)item * 16384) + id;
    if (id < 2048) return (const v4u*)(ws + WS_QD + (size_t)item * 16384) + (id - 1024);
    if (id < 3072) return (const v4u*)(ws + WS_KD + (size_t)item * 16384) + (id - 2048);
    return (const v4u*)(ws + WS_ATT + (size_t)item * 8192) + (id - 3072);
}
__device__ __forceinline__ bf16x8 pack_b(const f32x4 a, const f32x4 b) {
    v4u r; r.x = pk2(a.x, a.y); r.y = pk2(a.z, a.w); r.z = pk2(b.x, b.y); r.w = pk2(b.z, b.w);
    return __builtin_bit_cast(bf16x8, r);
}
#define SC_BAR() do { asm volatile("s_waitcnt lgkmcnt(0)" ::: "memory"); __builtin_amdgcn_s_barrier(); asm volatile("" ::: "memory"); } while (0)
#define SC_GLD(dst, ptr) asm volatile("global_load_dwordx4 %0, %1, off" : "=v"(dst) : "v"(ptr) : "memory")
#define PIN8(a) asm volatile("" : "+v"(a[0]), "+v"(a[1]), "+v"(a[2]), "+v"(a[3]), "+v"(a[4]), "+v"(a[5]), "+v"(a[6]), "+v"(a[7]))
#define PIN16(a) asm volatile("" : "+v"(a[0]), "+v"(a[1]), "+v"(a[2]), "+v"(a[3]), "+v"(a[4]), "+v"(a[5]), "+v"(a[6]), "+v"(a[7]), "+v"(a[8]), "+v"(a[9]), "+v"(a[10]), "+v"(a[11]), "+v"(a[12]), "+v"(a[13]), "+v"(a[14]), "+v"(a[15]))
constexpr int SCAN_NWC = 2, SCAN_PARTS = 4, SCAN_WGS = 8 * SCAN_PARTS;
constexpr int SC_UFS = 2 * SC_BUF;
constexpr int SC_DECS = SC_UFS + 2 * SCAN_NWC * 2048;
constexpr int SC_OT = SC_DECS + 512;
constexpr int SC_END = SC_OT + 2 * 64 * 36 * 4;
static_assert(SC_END <= MISC_OFF, "scan LDS");
#ifndef SCAN_REPS
#define SCAN_REPS 1
#endif
#ifndef SCAN_EXP
#define SCAN_EXP 0
#endif
__device__ __forceinline__ int sc3_lds_off(int id) {
    if (id < 3584) return sc_lds_off(id);
    return SC_UFS + (id - 3584) * 16;
}
__device__ __forceinline__ const v4u* sc3_src(const unsigned char* ws, int item, int id, int part) {
    if (id < 3584) return sc_src(ws, item, id);
    return (const v4u*)(ws + WS_UF + (size_t)item * 16384 + (size_t)(part * SCAN_NWC) * 2048) + (id - 3584);
}
__device__ __forceinline__ void gdn_scan(const Params& P, LAS unsigned char* lds, int sb, int tid, int lane, int wave) {
    const unsigned char* ws = P.ws;
    constexpr int NCH = 128 * SCAN_REPS, NPC = 15;
    const int bh = sb & 7, part = sb >> 3;
    const int b = bh >> 2, h = bh & 3, col = lane & 15, g = lane >> 4;
    const int item0 = bh * 128;
    const float* DEC = (const float*)(ws + WS_DEC);
    if (wave >= 4) {
        constexpr int NP = 15, DEP = 3;
        const int lt = tid - 256;
        const unsigned voff = (unsigned)lt * 16u;
        const int lA = (lt >> 4) * 272 + (lt & 15) * 16, lB = (lt >> 3) * 144 + (lt & 7) * 16, lU = SC_UFS + lt * 16;
        v4u rs[DEP][NP];
#define SC_ISSUE(set, itm) do { const unsigned char* gq_ = ws + (size_t)(itm) * 16384; const unsigned char* ga_ = ws + WS_ATT + (size_t)(itm) * 8192; \
            asm volatile("s_nop 4\n\tglobal_load_dwordx4 %0, %8, %9\n\tglobal_load_dwordx4 %1, %8, %10\n\tglobal_load_dwordx4 %2, %8, %11\n\tglobal_load_dwordx4 %3, %8, %12\n\t" \
                         "global_load_dwordx4 %4, %8, %13\n\tglobal_load_dwordx4 %5, %8, %14\n\tglobal_load_dwordx4 %6, %8, %15\n\tglobal_load_dwordx4 %7, %8, %16" \
                : "=&v"(rs[set][0]), "=&v"(rs[set][1]), "=&v"(rs[set][2]), "=&v"(rs[set][3]), "=&v"(rs[set][4]), "=&v"(rs[set][5]), "=&v"(rs[set][6]), "=&v"(rs[set][7]) \
                : "v"(voff), "s"(gq_ + WS_WN), "s"(gq_ + WS_WN + 4096), "s"(gq_ + WS_WN + 8192), "s"(gq_ + WS_WN + 12288), \
                  "s"(gq_ + WS_QD), "s"(gq_ + WS_QD + 4096), "s"(gq_ + WS_QD + 8192), "s"(gq_ + WS_QD + 12288) : "memory"); \
            asm volatile("s_nop 4\n\tglobal_load_dwordx4 %0, %7, %8\n\tglobal_load_dwordx4 %1, %7, %9\n\tglobal_load_dwordx4 %2, %7, %10\n\tglobal_load_dwordx4 %3, %7, %11\n\t" \
                         "global_load_dwordx4 %4, %7, %12\n\tglobal_load_dwordx4 %5, %7, %13\n\tglobal_load_dwordx4 %6, %7, %14" \
                : "=&v"(rs[set][8]), "=&v"(rs[set][9]), "=&v"(rs[set][10]), "=&v"(rs[set][11]), "=&v"(rs[set][12]), "=&v"(rs[set][13]), "=&v"(rs[set][14]) \
                : "v"(voff), "s"(gq_ + WS_KD), "s"(gq_ + WS_KD + 4096), "s"(gq_ + WS_KD + 8192), "s"(gq_ + WS_KD + 12288), \
                  "s"(ga_), "s"(ga_ + 4096), "s"(gq_ + WS_UF + (size_t)(part * SCAN_NWC) * 2048) : "memory"); } while (0)
#define SC_WAITSET(set, cnt) asm volatile("s_waitcnt " cnt : "+v"(rs[set][0]), "+v"(rs[set][1]), "+v"(rs[set][2]), "+v"(rs[set][3]), "+v"(rs[set][4]), "+v"(rs[set][5]), "+v"(rs[set][6]), "+v"(rs[set][7]), \
            "+v"(rs[set][8]), "+v"(rs[set][9]), "+v"(rs[set][10]), "+v"(rs[set][11]), "+v"(rs[set][12]), "+v"(rs[set][13]), "+v"(rs[set][14]) :: "memory")
#define SC_WRITE(set, par) do { LAS unsigned char* wb_ = lds + (par) * SC_BUF; \
            _Pragma("unroll") for (int r = 0; r < 4; ++r) { *(LAS v4u*)(wb_ + SC_WN + lA + r * (16 * 272)) = rs[set][r]; *(LAS v4u*)(wb_ + SC_QD + lA + r * (16 * 272)) = rs[set][4 + r]; \
                                                          *(LAS v4u*)(wb_ + SC_KD + lB + r * (32 * 144)) = rs[set][8 + r]; } \
            *(LAS v4u*)(wb_ + SC_ATT + lB) = rs[set][12]; *(LAS v4u*)(wb_ + SC_ATT + lB + 32 * 144) = rs[set][13]; \
            *(LAS v4u*)(lds + lU + (par) * (SCAN_NWC * 2048)) = rs[set][14]; } while (0)
        {
#pragma unroll
            for (int r = 0; r < NP; ++r) { const int id = lt + 256 * r; *(LAS v4u*)(lds + sc3_lds_off(id)) = *sc3_src(ws, item0, id, part); }
            if (lt < 128) ((LAS float*)(lds + SC_DECS))[lt] = DEC[item0 + lt];
            asm volatile("s_waitcnt vmcnt(0)" ::: "memory");
        }
        SC_ISSUE(1, item0 + 1); SC_ISSUE(2, item0 + 2); SC_ISSUE(0, item0 + 3);
        SC_BAR();
        int n2 = 0;
#define SC_INTERVAL(set) do { SC_WAITSET(set, "vmcnt(30)"); SC_WRITE(set, (n2 + 1) & 1); SC_WAITSET(set, "lgkmcnt(0)"); SC_ISSUE(set, item0 + ((n2 + 1 + DEP) & 127)); SC_BAR(); ++n2; } while (0)
#pragma unroll 1
        for (int it = 0; it < NCH / 3; ++it) { SC_INTERVAL(1); SC_INTERVAL(2); SC_INTERVAL(0); }
        if (NCH % 3 >= 1) SC_INTERVAL(1);
        if (NCH % 3 >= 2) SC_INTERVAL(2);
        SC_WAITSET(0, "vmcnt(0)"); SC_WAITSET(1, "vmcnt(0)"); SC_WAITSET(2, "vmcnt(0)");
#undef SC_INTERVAL
#undef SC_WRITE
#undef SC_WAITSET
#undef SC_ISSUE
        return;
    }
    if (wave == 3) {
        SC_BAR();
#pragma unroll 1
        for (int n2 = 0; n2 < NCH; ++n2) SC_BAR();
        return;
    }
    if (wave == 2) {
        const int row = lane;
        bf16* Y = (bf16*)(P.ws + WS_Y);
        float* SSQG = P.out;
        SC_BAR();
#pragma unroll 1
        for (int n2 = 0; n2 <= NCH; ++n2) {
            if (n2 > 0) {
                const int n = (n2 - 1) & 127, t = b * SEQ + n * 64 + row;
                const LAS float* src = (const LAS float*)(lds + SC_OT + ((n2 - 1) & 1) * (64 * 36 * 4)) + row * 36;
                f32x4 a[8]; float s2 = 0.f;
#pragma unroll
                for (int q = 0; q < 8; ++q) { a[q] = *(const LAS f32x4*)(src + 4 * q); s2 += (a[q].x * a[q].x + a[q].y * a[q].y) + (a[q].z * a[q].z + a[q].w * a[q].w); }
                SSQG[(size_t)t * 32 + h * 8 + part] = s2;
                v4u* d = (v4u*)(Y + (size_t)t * 1024 + h * 128 + 32 * part);
#pragma unroll
                for (int q = 0; q < 4; ++q) { v4u o; o.x = pk2(a[2 * q].x, a[2 * q].y); o.y = pk2(a[2 * q].z, a[2 * q].w); o.z = pk2(a[2 * q + 1].x, a[2 * q + 1].y); o.w = pk2(a[2 * q + 1].z, a[2 * q + 1].w); d[q] = o; }
            }
            if (n2 < NCH) SC_BAR();
        }
        return;
    }
    f32x4 S[8];
#pragma unroll
    for (int i = 0; i < 8; ++i) S[i] = (f32x4){0.f, 0.f, 0.f, 0.f};
    SC_BAR();
#pragma unroll 1
    for (int n2 = 0; n2 < NCH; ++n2) {
        if (SCAN_REPS > 1 && (n2 & 127) == 0) {
#pragma unroll
            for (int i = 0; i < 8; ++i) S[i] = (f32x4){0.f, 0.f, 0.f, 0.f};
        }
        if (SCAN_EXP == 2 && n2 < 128) { SC_BAR(); continue; }
        const int par = n2 & 1;
        LAS unsigned char* buf = lds + par * SC_BUF;
        bf16x8 fA[16], fB[16], fC[16], fD[8];
#pragma unroll
        for (int rho = 0; rho < 4; ++rho)
#pragma unroll
            for (int s = 0; s < 4; ++s) fA[rho * 4 + s] = *(const LAS bf16x8*)(buf + SC_WN + (16 * rho + col) * 272 + (32 * s + 8 * g) * 2);
#pragma unroll
        for (int rho = 0; rho < 4; ++rho)
#pragma unroll
            for (int s = 0; s < 4; ++s) fB[rho * 4 + s] = *(const LAS bf16x8*)(buf + SC_QD + (16 * rho + col) * 272 + (32 * s + 8 * g) * 2);
        const LAS v4u* ufp = (const LAS v4u*)(lds + SC_UFS + par * (SCAN_NWC * 2048) + wave * 2048 + lane * 32);
        const v4u uf0 = ufp[0], uf1 = ufp[1];
        const float dec = ((const LAS float*)(lds + SC_DECS))[n2 & 127];
        bf16x8 Bs[4];
#pragma unroll
        for (int s = 0; s < 4; ++s) Bs[s] = pack_b(S[2 * s], S[2 * s + 1]);
        f32x4 Vn[4], Oc[4];
        Vn[0] = (f32x4){bflo(uf0.x), bfhi(uf0.x), bflo(uf0.y), bfhi(uf0.y)}; Vn[1] = (f32x4){bflo(uf0.z), bfhi(uf0.z), bflo(uf0.w), bfhi(uf0.w)};
        Vn[2] = (f32x4){bflo(uf1.x), bfhi(uf1.x), bflo(uf1.y), bfhi(uf1.y)}; Vn[3] = (f32x4){bflo(uf1.z), bfhi(uf1.z), bflo(uf1.w), bfhi(uf1.w)};
        __builtin_amdgcn_sched_barrier(0);
        PIN16(fA);
#pragma unroll
        for (int s = 0; s < 4; ++s)
#pragma unroll
            for (int rho = 0; rho < 4; ++rho) Vn[rho] = __builtin_amdgcn_mfma_f32_16x16x32_bf16(fA[rho * 4 + s], Bs[s], Vn[rho], 0, 0, 0);
        __builtin_amdgcn_sched_barrier(0);
#pragma unroll
        for (int tau = 0; tau < 8; ++tau)
#pragma unroll
            for (int s = 0; s < 2; ++s) fC[tau * 2 + s] = *(const LAS bf16x8*)(buf + SC_KD + (16 * tau + col) * 144 + (32 * s + 8 * g) * 2);
        __builtin_amdgcn_sched_barrier(0);
        PIN16(fB);
#pragma unroll
        for (int rho = 0; rho < 4; ++rho) Oc[rho] = (f32x4){0.f, 0.f, 0.f, 0.f};
#pragma unroll
        for (int s = 0; s < 4; ++s)
#pragma unroll
            for (int rho = 0; rho < 4; ++rho) Oc[rho] = __builtin_amdgcn_mfma_f32_16x16x32_bf16(fB[rho * 4 + s], Bs[s], Oc[rho], 0, 0, 0);
        __builtin_amdgcn_sched_barrier(0);
#pragma unroll
        for (int rho = 0; rho < 4; ++rho)
#pragma unroll
            for (int s = 0; s < 2; ++s) fD[rho * 2 + s] = *(const LAS bf16x8*)(buf + SC_ATT + (16 * rho + col) * 144 + (32 * s + 8 * g) * 2);
        bf16x8 Bv[2];
        Bv[0] = pack_b(Vn[0], Vn[1]); Bv[1] = pack_b(Vn[2], Vn[3]);
#pragma unroll
        for (int tau = 0; tau < 8; ++tau) S[tau] = S[tau] * dec;
        __builtin_amdgcn_sched_barrier(0);
        PIN16(fC);
#pragma unroll
        for (int s = 0; s < 2; ++s)
#pragma unroll
            for (int tau = 0; tau < 8; ++tau) S[tau] = __builtin_amdgcn_mfma_f32_16x16x32_bf16(fC[tau * 2 + s], Bv[s], S[tau], 0, 0, 0);
        __builtin_amdgcn_sched_barrier(0);
        PIN8(fD);
#pragma unroll
        for (int s = 0; s < 2; ++s)
#pragma unroll
            for (int rho = 0; rho < 4; ++rho) Oc[rho] = __builtin_amdgcn_mfma_f32_16x16x32_bf16(fD[rho * 2 + s], Bv[s], Oc[rho], 0, 0, 0);
        LAS float* ot = (LAS float*)(lds + SC_OT + par * (64 * 36 * 4)) + 16 * wave + col;
#pragma unroll
        for (int rho = 0; rho < 4; ++rho)
#pragma unroll
            for (int i = 0; i < 4; ++i) ot[(16 * rho + 4 * g + i) * 36] = Oc[rho][i];
        SC_BAR();
    }
}

__device__ __forceinline__ void lru_carry(const Params& P, int gwv, int lane) {
    unsigned char* ws = P.ws;
    const int b = gwv >> 3, g = gwv & 7, ch = g * 64 + lane;
    const float* HEND = (const float*)(ws + WS_HEND); const float* PEND = (const float*)(ws + WS_PEND); float* HIN = (float*)(ws + WS_HIN);
    float hin = 0.f;
#pragma unroll 1
    for (int n0 = 0; n0 < 128; n0 += 16) {
        float he[16], pe[16];
#pragma unroll
        for (int i = 0; i < 16; ++i) { const size_t o = (size_t)(b * 128 + n0 + i) * 512 + ch; he[i] = HEND[o]; pe[i] = PEND[o]; }
#pragma unroll
        for (int i = 0; i < 16; ++i) { HIN[(size_t)(b * 128 + n0 + i) * 512 + ch] = hin; hin = he[i] + pe[i] * hin; }
    }
}

__device__ __forceinline__ void cvt_table(const float* src, bf16* dst, size_t n8, size_t wi, size_t nw) {
    for (size_t i = wi; i < n8; i += nw) {
        const f32x4 a = ((const f32x4*)src)[2 * i], c = ((const f32x4*)src)[2 * i + 1];
        v4u o; o.x = pk2(a.x, a.y); o.y = pk2(a.z, a.w); o.z = pk2(c.x, c.y); o.w = pk2(c.z, c.w);
        ((v4u*)dst)[i] = o;
    }
}

__device__ __forceinline__ void lru_combine(const Params& P, size_t wi, size_t nw) {
    unsigned char* ws = P.ws;
    const v4u* HLOC = (const v4u*)(ws + WS_HLOC); const v4u* PCUM = (const v4u*)(ws + WS_PCUM); const v4u* GATE = (const v4u*)(ws + WS_GATE);
    const float* HIN = (const float*)(ws + WS_HIN); bf16* Y = (bf16*)(ws + WS_Y);
    for (size_t i = wi; i < (size_t)T * 64; i += nw) {
        const size_t t = i >> 6; const int ch0 = (int)(i & 63) * 8;
        const v4u hl = HLOC[i], pc = PCUM[i], gt = GATE[i];
        const f32x4 h0 = *(const f32x4*)(HIN + (t >> 6) * 512 + ch0), h1 = *(const f32x4*)(HIN + (t >> 6) * 512 + ch0 + 4);
        float y[8];
        y[0] = (bflo(hl.x) + bflo(pc.x) * h0.x) * gelu_tanh(bflo(gt.x)); y[1] = (bfhi(hl.x) + bfhi(pc.x) * h0.y) * gelu_tanh(bfhi(gt.x));
        y[2] = (bflo(hl.y) + bflo(pc.y) * h0.z) * gelu_tanh(bflo(gt.y)); y[3] = (bfhi(hl.y) + bfhi(pc.y) * h0.w) * gelu_tanh(bfhi(gt.y));
        y[4] = (bflo(hl.z) + bflo(pc.z) * h1.x) * gelu_tanh(bflo(gt.z)); y[5] = (bfhi(hl.z) + bfhi(pc.z) * h1.y) * gelu_tanh(bfhi(gt.z));
        y[6] = (bflo(hl.w) + bflo(pc.w) * h1.z) * gelu_tanh(bflo(gt.w)); y[7] = (bfhi(hl.w) + bfhi(pc.w) * h1.w) * gelu_tanh(bfhi(gt.w));
        v4u o; o.x = pk2(y[0], y[1]); o.y = pk2(y[2], y[3]); o.z = pk2(y[4], y[5]); o.w = pk2(y[6], y[7]);
        *(v4u*)(Y + t * 1024 + 512 + ch0) = o;
    }
}

__device__ __forceinline__ void gdn_gate_norm(const Params& P, size_t wi, size_t nw) {
    unsigned char* ws = P.ws;
    bf16* Y = (bf16*)(ws + WS_Y); const v4u* Z = (const v4u*)(ws + WS_Z); const float* SSQG = P.out;
    for (size_t i = wi; i < (size_t)T * 64; i += nw) {
        const size_t t = i >> 6; const int c0 = (int)(i & 63) * 8, h = c0 >> 7;
        const f32x4 q0 = *(const f32x4*)(SSQG + t * 32 + h * 8);
        const float rstd = rsqrtf(((q0.x + q0.y) + (q0.z + q0.w)) * (1.0f / 128.0f) + 1e-6f);
        const v4u o = *(const v4u*)(Y + t * 1024 + c0), z = Z[i];
        const f32x4 w0 = *(const f32x4*)(P.gdn_norm_w + (c0 & 127)), w1 = *(const f32x4*)(P.gdn_norm_w + (c0 & 127) + 4);
        float y[8];
        y[0] = bflo(o.x) * rstd * w0.x * siluf_(bflo(z.x)); y[1] = bfhi(o.x) * rstd * w0.y * siluf_(bfhi(z.x));
        y[2] = bflo(o.y) * rstd * w0.z * siluf_(bflo(z.y)); y[3] = bfhi(o.y) * rstd * w0.w * siluf_(bfhi(z.y));
        y[4] = bflo(o.z) * rstd * w1.x * siluf_(bflo(z.z)); y[5] = bfhi(o.z) * rstd * w1.y * siluf_(bfhi(z.z));
        y[6] = bflo(o.w) * rstd * w1.z * siluf_(bflo(z.w)); y[7] = bfhi(o.w) * rstd * w1.w * siluf_(bfhi(z.w));
        v4u r; r.x = pk2(y[0], y[1]); r.y = pk2(y[2], y[3]); r.z = pk2(y[4], y[5]); r.w = pk2(y[6], y[7]);
        *(v4u*)(Y + t * 1024 + c0) = r;
    }
}

__device__ __forceinline__ void xattn_stage(LAS unsigned char* lds, const bf16* src, int tid) {
    v4u tmp[16];
#pragma unroll
    for (int r = 0; r < 16; ++r) tmp[r] = *(const v4u*)(src + (size_t)(tid + 512 * r) * 8);
#pragma unroll
    for (int r = 0; r < 16; ++r) { const int id = tid + 512 * r; *(LAS v4u*)(lds + (id >> 5) * 528 + (id & 31) * 16) = tmp[r]; }
}
__device__ __forceinline__ void xattn_unit(const Params& P, LAS unsigned char* lds, int unit, int tid, int lane, int wave) {
    const unsigned char* ws = P.ws;
    const int h = unit & 3, qb = (unit >> 2) & 63, b = unit >> 8, col = lane & 15, g = lane >> 4;
    const int tw = b * SEQ + qb * 128 + 16 * wave;
    const bf16* Kb = (const bf16*)(ws + WS_KB) + (size_t)((b * 4 + h) * 256) * 256;
    const bf16* Vt = (const bf16*)(ws + WS_VTP) + (size_t)((b * 4 + h) * 256) * 256;
    xattn_stage(lds, Kb, tid);
    __syncthreads();
    const LAS unsigned char* arow = lds + col * 528 + g * 16;
    bf16x8 Bp[1][8]; float inv[1];
#pragma unroll
    for (int ps = 0; ps < 1; ++ps) {
        const bf16* Q = (const bf16*)(ws + WS_Q) + (size_t)(tw + 16 * ps + col) * 1024 + h * 256 + 8 * g;
        bf16x8 Bq[8];
#pragma unroll
        for (int s = 0; s < 8; ++s) Bq[s] = *(const bf16x8*)(Q + 32 * s);
        f32x4 St[16];
        bf16x8 fr[2][8];
#pragma unroll
        for (int s = 0; s < 8; ++s) fr[0][s] = *(const LAS bf16x8*)(arow + 64 * s);
#pragma unroll
        for (int kap = 0; kap < 16; ++kap) {
            if (kap + 1 < 16) {
#pragma unroll
                for (int s = 0; s < 8; ++s) fr[(kap + 1) & 1][s] = *(const LAS bf16x8*)(arow + (16 * (kap + 1)) * 528 + 64 * s);
            }
            __builtin_amdgcn_sched_barrier(0);
            PIN8(fr[kap & 1]);
            f32x4 acc = (f32x4){0.f, 0.f, 0.f, 0.f};
#pragma unroll
            for (int s = 0; s < 8; ++s) acc = __builtin_amdgcn_mfma_f32_16x16x32_bf16(fr[kap & 1][s], Bq[s], acc, 0, 0, 0);
            St[kap] = acc;
            __builtin_amdgcn_sched_barrier(0);
        }
        float mx = -3.0e38f;
#pragma unroll
        for (int kap = 0; kap < 16; ++kap) mx = fmaxf(fmaxf(fmaxf(St[kap].x, St[kap].y), fmaxf(St[kap].z, St[kap].w)), mx);
        mx = fmaxf(mx, __shfl_xor(mx, 16)); mx = fmaxf(mx, __shfl_xor(mx, 32));
        float l = 0.f;
#pragma unroll
        for (int kap = 0; kap < 16; ++kap) { St[kap].x = __expf(St[kap].x - mx); St[kap].y = __expf(St[kap].y - mx); St[kap].z = __expf(St[kap].z - mx); St[kap].w = __expf(St[kap].w - mx);
            l += (St[kap].x + St[kap].y) + (St[kap].z + St[kap].w); }
        l += __shfl_xor(l, 16); l += __shfl_xor(l, 32);
        inv[ps] = 1.0f / l;
#pragma unroll
        for (int s = 0; s < 8; ++s) Bp[ps][s] = pack_b(St[2 * s], St[2 * s + 1]);
    }
    __syncthreads();
    xattn_stage(lds, Vt, tid);
    __syncthreads();
#pragma unroll
    for (int ps = 0; ps < 1; ++ps) {
        bf16* AO = (bf16*)(P.ws + WS_AO) + (size_t)(tw + 16 * ps + col) * 1024 + h * 256 + 4 * g;
        bf16x8 fr[2][8];
#pragma unroll
        for (int s = 0; s < 8; ++s) fr[0][s] = *(const LAS bf16x8*)(arow + 64 * s);
#pragma unroll
        for (int del = 0; del < 16; ++del) {
            if (del + 1 < 16) {
#pragma unroll
                for (int s = 0; s < 8; ++s) fr[(del + 1) & 1][s] = *(const LAS bf16x8*)(arow + (16 * (del + 1)) * 528 + 64 * s);
            }
            __builtin_amdgcn_sched_barrier(0);
            PIN8(fr[del & 1]);
            f32x4 acc = (f32x4){0.f, 0.f, 0.f, 0.f};
#pragma unroll
            for (int s = 0; s < 8; ++s) acc = __builtin_amdgcn_mfma_f32_16x16x32_bf16(fr[del & 1][s], Bp[ps][s], acc, 0, 0, 0);
            v2u o; o.x = pk2(acc.x * inv[ps], acc.y * inv[ps]); o.y = pk2(acc.z * inv[ps], acc.w * inv[ps]);
            *(v2u*)(AO + 16 * del) = o;
            __builtin_amdgcn_sched_barrier(0);
        }
    }
    __syncthreads();
}

__device__ __forceinline__ unsigned key_enc(float f) { const unsigned u = __builtin_bit_cast(unsigned, f); return (u & 0x80000000u) ? ~u : (u | 0x80000000u); }
__device__ __forceinline__ float key_dec(unsigned k) { const unsigned u = (k & 0x80000000u) ? (k & 0x7fffffffu) : ~k; return __builtin_bit_cast(float, u); }
#define TK_CAS(a, b) do { const unsigned hi_ = max(a, b), lo_ = min(a, b); a = hi_; b = lo_; } while (0)
__device__ __forceinline__ void tk_merge16(unsigned (&a)[16]) {
#pragma unroll
    for (int j = 8; j > 0; j >>= 1)
#pragma unroll
        for (int i = 0; i < 16; ++i) { const int l = i ^ j; if (l > i) TK_CAS(a[i], a[l]); }
}
__device__ __forceinline__ void tk_sort16(unsigned (&a)[16]) {
#pragma unroll
    for (int k = 2; k <= 16; k <<= 1)
#pragma unroll
        for (int j = k >> 1; j > 0; j >>= 1)
#pragma unroll
            for (int i = 0; i < 16; ++i) { const int l = i ^ j; if (l > i) { if ((i & k) == 0) TK_CAS(a[i], a[l]); else TK_CAS(a[l], a[i]); } }
}
__device__ __forceinline__ void tk_top16_merge(unsigned (&L)[16], const unsigned (&G)[16]) {
#pragma unroll
    for (int i = 0; i < 16; ++i) L[i] = max(L[i], G[15 - i]);
    tk_merge16(L);
}
__device__ __forceinline__ void tk_pair_merge(unsigned (&L)[16]) {
    unsigned Pp[16];
#pragma unroll
    for (int i = 0; i < 16; ++i) Pp[i] = (unsigned)__builtin_amdgcn_update_dpp(0, (int)L[i], 0xB1, 0xF, 0xF, true);
    tk_top16_merge(L, Pp);
}
__device__ __forceinline__ void peer_topk_rows(const Params& P, LAS unsigned char* lds, int rowbase, int tid) {
    const unsigned char* ws = P.ws;
    typedef _Float16 f16x8 __attribute__((ext_vector_type(8)));
    const int rl = tid >> 1, hf = tid & 1, grow = rowbase + rl, t = grow >> 3, h = grow & 7;
    const _Float16* SC = (const _Float16*)(ws + WS_PQ) + (size_t)t * 2048 + h * 256 + 64 * hf;
    f16x8 raw[2][8];
#pragma unroll
    for (int p = 0; p < 2; ++p)
#pragma unroll
        for (int q = 0; q < 8; ++q) raw[p][q] = *(const f16x8*)(SC + p * 128 + 8 * q);
    unsigned L1[16], L2[16];
#pragma unroll
    for (int p = 0; p < 2; ++p) {
        unsigned L[16];
#pragma unroll
        for (int grp = 0; grp < 4; ++grp) {
            unsigned G[16];
#pragma unroll
            for (int e = 0; e < 16; ++e) G[e] = (key_enc((float)raw[p][2 * grp + (e >> 3)][e & 7]) & ~127u) | (unsigned)(127 - (64 * hf + 16 * grp + e));
            tk_sort16(G);
            if (grp == 0) {
#pragma unroll
                for (int i = 0; i < 16; ++i) L[i] = G[i];
            } else tk_top16_merge(L, G);
        }
        tk_pair_merge(L);
#pragma unroll
        for (int i = 0; i < 16; ++i) { if (p == 0) L1[i] = L[i]; else L2[i] = L[i]; }
    }
    {
        float v1[16], v2[16];
        LAS int* il = (LAS int*)lds + rl * 33;
#pragma unroll
        for (int q = 0; q < 16; ++q) { v1[q] = key_dec((L1[q] & ~127u) | 64u); v2[q] = key_dec((L2[q] & ~127u) | 64u); }
        if (hf == 0) {
#pragma unroll
            for (int q = 0; q < 16; ++q) { il[q] = 127 - (int)(L1[q] & 127u); il[16 + q] = 127 - (int)(L2[q] & 127u); }
        }
        unsigned C[16], D[16];
        float w1[8];
        const unsigned hf16 = (unsigned)hf * 16u, evenmask = (unsigned)hf - 1u;
#pragma unroll
        for (int k = 0; k < 8; ++k) w1[k] = __builtin_bit_cast(float, (__builtin_bit_cast(unsigned, v1[2 * k]) & evenmask) | (__builtin_bit_cast(unsigned, v1[2 * k + 1]) & ~evenmask));
#define TK_SLOT(dst, k, bq, valid_odd) do { const unsigned pos_ = (unsigned)(16 * (2 * (k)) + (bq)) + hf16; unsigned kv_ = (key_enc(w1[k] + v2[bq]) & ~255u) | (255u - pos_); if (!(valid_odd)) kv_ &= evenmask; dst = kv_; } while (0)
        TK_SLOT(C[0], 0, 0, true);
        TK_SLOT(C[1], 0, 1, true);
        TK_SLOT(C[2], 0, 2, true);
        TK_SLOT(C[3], 0, 3, true);
        TK_SLOT(C[4], 0, 4, true);
        TK_SLOT(C[5], 0, 5, true);
        TK_SLOT(C[6], 0, 6, true);
        TK_SLOT(C[7], 0, 7, true);
        TK_SLOT(C[8], 0, 8, false);
        TK_SLOT(C[9], 0, 9, false);
        TK_SLOT(C[10], 0, 10, false);
        TK_SLOT(C[11], 0, 11, false);
        TK_SLOT(C[12], 0, 12, false);
        TK_SLOT(C[13], 0, 13, false);
        TK_SLOT(C[14], 0, 14, false);
        TK_SLOT(C[15], 0, 15, false);
        TK_SLOT(D[0], 1, 0, true);
        TK_SLOT(D[1], 1, 1, true);
        TK_SLOT(D[2], 1, 2, true);
        TK_SLOT(D[3], 1, 3, true);
        TK_SLOT(D[4], 1, 4, false);
        TK_SLOT(D[5], 2, 0, true);
        TK_SLOT(D[6], 2, 1, true);
        TK_SLOT(D[7], 2, 2, false);
        TK_SLOT(D[8], 3, 0, true);
        TK_SLOT(D[9], 3, 1, true);
        TK_SLOT(D[10], 4, 0, true);
        TK_SLOT(D[11], 5, 0, true);
        TK_SLOT(D[12], 6, 0, true);
        TK_SLOT(D[13], 7, 0, true);
        D[14] = 0u; D[15] = 0u;
#undef TK_SLOT
        tk_sort16(C); tk_sort16(D); tk_top16_merge(C, D); tk_pair_merge(C);
        LDS_WAIT(); asm volatile("" ::: "memory");
        float best[16], e[16], sum = 0.f;
#pragma unroll
        for (int q = 0; q < 16; ++q) { best[q] = key_dec((C[q] & ~255u) | 128u); e[q] = __expf(best[q] - best[0]); sum += e[q]; }
        const float inv = __builtin_amdgcn_rcpf(sum);
        int* IDX = (int*)(P.ws + WS_IDX) + (size_t)grow * 16 + 8 * hf; float* GW = (float*)(P.ws + WS_GW) + (size_t)grow * 16 + 8 * hf;
#pragma unroll
        for (int q = 0; q < 8; ++q) {
            const unsigned c = (C[q] & evenmask) | (C[8 + q] & ~evenmask);
            const float ev = __builtin_bit_cast(float, (__builtin_bit_cast(unsigned, e[q]) & evenmask) | (__builtin_bit_cast(unsigned, e[8 + q]) & ~evenmask));
            const unsigned pos = 255u - (c & 255u);
            IDX[q] = il[pos >> 4] * 128 + il[16 + (pos & 15u)]; GW[q] = ev * inv;
        }
    }
    LDS_WAIT(); asm volatile("" ::: "memory");
}

typedef float f32x2 __attribute__((ext_vector_type(2)));
__device__ __forceinline__ void cvt_table_fp8(const float* src, unsigned char* dst, float* scl, int gw, int ngw, int lane) {
    for (int row = gw; row < 16384; row += ngw) {
        const f32x4* sp = (const f32x4*)(src + (size_t)row * 1024 + 16 * lane);
        const f32x4 a0 = sp[0], a1 = sp[1], a2 = sp[2], a3 = sp[3];
        float m = fmaxf(fmaxf(fmaxf(fabsf(a0.x), fabsf(a0.y)), fmaxf(fabsf(a0.z), fabsf(a0.w))), fmaxf(fmaxf(fabsf(a1.x), fabsf(a1.y)), fmaxf(fabsf(a1.z), fabsf(a1.w))));
        m = fmaxf(m, fmaxf(fmaxf(fmaxf(fabsf(a2.x), fabsf(a2.y)), fmaxf(fabsf(a2.z), fabsf(a2.w))), fmaxf(fmaxf(fabsf(a3.x), fabsf(a3.y)), fmaxf(fabsf(a3.z), fabsf(a3.w)))));
#pragma unroll
        for (int o = 1; o < 64; o <<= 1) m = fmaxf(m, __shfl_xor(m, o));
        m = fmaxf(m, 1e-30f);
        const float q = 224.0f / m;
        v4u o;
        int p;
        p = __builtin_amdgcn_cvt_pk_fp8_f32(a0.x * q, a0.y * q, 0, false); p = __builtin_amdgcn_cvt_pk_fp8_f32(a0.z * q, a0.w * q, p, true); o.x = (unsigned)p;
        p = __builtin_amdgcn_cvt_pk_fp8_f32(a1.x * q, a1.y * q, 0, false); p = __builtin_amdgcn_cvt_pk_fp8_f32(a1.z * q, a1.w * q, p, true); o.y = (unsigned)p;
        p = __builtin_amdgcn_cvt_pk_fp8_f32(a2.x * q, a2.y * q, 0, false); p = __builtin_amdgcn_cvt_pk_fp8_f32(a2.z * q, a2.w * q, p, true); o.z = (unsigned)p;
        p = __builtin_amdgcn_cvt_pk_fp8_f32(a3.x * q, a3.y * q, 0, false); p = __builtin_amdgcn_cvt_pk_fp8_f32(a3.z * q, a3.w * q, p, true); o.w = (unsigned)p;
        *(v4u*)(dst + (size_t)row * 1024 + 16 * lane) = o;
        if (lane == 0) scl[row] = m * (1.0f / 224.0f);
    }
}
__device__ __forceinline__ void peer_token(const Params& P, int t, int lane, float* dstbase) {
    const unsigned char* ws = P.ws;
    const float* xrow = P.out + (size_t)t * 1024 + 16 * lane;
    const float rstd2 = rsqrtf(((const float*)(ws + WS_SSQ2))[t] * (1.0f / 1024.0f) + 1e-6f);
    f32x4 x2[4]; f32x2 hn[8], acc[8];
#pragma unroll
    for (int i = 0; i < 4; ++i) { x2[i] = ((const f32x4*)xrow)[i]; const f32x4 w = ((const f32x4*)(P.norm_ffn_w + 16 * lane))[i];
        hn[2 * i] = (f32x2){x2[i].x * rstd2 * w.x, x2[i].y * rstd2 * w.y}; hn[2 * i + 1] = (f32x2){x2[i].z * rstd2 * w.z, x2[i].w * rstd2 * w.w}; }
#pragma unroll
    for (int i = 0; i < 8; ++i) acc[i] = (f32x2){0.f, 0.f};
    const int* IDX = (const int*)(ws + WS_IDX) + (size_t)t * 128; const float* GW = (const float*)(ws + WS_GW) + (size_t)t * 128;
    const unsigned char* UB8 = ws + WS_UB; const unsigned char* VB8 = ws + WS_VB;
    const float* USC = (const float*)(ws + WS_UB + 16 * MiB); const float* VSC = (const float*)(ws + WS_VB + 16 * MiB);
    const int myk = (lane >> 2) & 15;
#pragma unroll 1
    for (int hh = 0; hh < 8; ++hh) {
        const int idv = IDX[hh * 16 + (lane & 15)];
        const float gsc = GW[hh * 16 + (lane & 15)] * VSC[idv], usc = USC[idv];
        v4u uq[16], vq[16];
#pragma unroll
        for (int k = 0; k < 16; ++k) { const int e = __builtin_amdgcn_readlane(idv, k);
            uq[k] = *(const v4u*)(UB8 + (size_t)e * 1024 + 16 * lane); vq[k] = *(const v4u*)(VB8 + (size_t)e * 1024 + 16 * lane); }
        float d[16];
#pragma unroll
        for (int k = 0; k < 16; ++k) {
            f32x2 s = __builtin_amdgcn_cvt_pk_f32_fp8((int)uq[k].x, false) * hn[0];
            s = __builtin_elementwise_fma(__builtin_amdgcn_cvt_pk_f32_fp8((int)uq[k].x, true), hn[1], s);
            s = __builtin_elementwise_fma(__builtin_amdgcn_cvt_pk_f32_fp8((int)uq[k].y, false), hn[2], s);
            s = __builtin_elementwise_fma(__builtin_amdgcn_cvt_pk_f32_fp8((int)uq[k].y, true), hn[3], s);
            s = __builtin_elementwise_fma(__builtin_amdgcn_cvt_pk_f32_fp8((int)uq[k].z, false), hn[4], s);
            s = __builtin_elementwise_fma(__builtin_amdgcn_cvt_pk_f32_fp8((int)uq[k].z, true), hn[5], s);
            s = __builtin_elementwise_fma(__builtin_amdgcn_cvt_pk_f32_fp8((int)uq[k].w, false), hn[6], s);
            s = __builtin_elementwise_fma(__builtin_amdgcn_cvt_pk_f32_fp8((int)uq[k].w, true), hn[7], s);
            d[k] = s.x + s.y;
        }
        float r8[8], r4[4], r2[2], r1;
        { const bool up = (lane & 32) != 0;
#pragma unroll
          for (int i = 0; i < 8; ++i) { const float keep = up ? d[8 + i] : d[i], send = up ? d[i] : d[8 + i]; r8[i] = keep + __shfl_xor(send, 32); } }
        { const bool up = (lane & 16) != 0;
#pragma unroll
          for (int i = 0; i < 4; ++i) { const float keep = up ? r8[4 + i] : r8[i], send = up ? r8[i] : r8[4 + i]; r4[i] = keep + __shfl_xor(send, 16); } }
        { const bool up = (lane & 8) != 0;
#pragma unroll
          for (int i = 0; i < 2; ++i) { const float keep = up ? r4[2 + i] : r4[i], send = up ? r4[i] : r4[2 + i]; r2[i] = keep + __shfl_xor(send, 8); } }
        { const bool up = (lane & 4) != 0; const float keep = up ? r2[1] : r2[0], send = up ? r2[0] : r2[1]; r1 = keep + __shfl_xor(send, 4); }
        r1 += __shfl_xor(r1, 2); r1 += __shfl_xor(r1, 1);
        const float act = gelu_tanh(r1 * __shfl(usc, myk)) * __shfl(gsc, myk);
#pragma unroll
        for (int k = 0; k < 16; ++k) {
            const float a = __builtin_bit_cast(float, __builtin_amdgcn_readlane(__builtin_bit_cast(int, act), 4 * k));
            const f32x2 a2 = (f32x2){a, a};
            acc[0] = __builtin_elementwise_fma(__builtin_amdgcn_cvt_pk_f32_fp8((int)vq[k].x, false), a2, acc[0]);
            acc[1] = __builtin_elementwise_fma(__builtin_amdgcn_cvt_pk_f32_fp8((int)vq[k].x, true), a2, acc[1]);
            acc[2] = __builtin_elementwise_fma(__builtin_amdgcn_cvt_pk_f32_fp8((int)vq[k].y, false), a2, acc[2]);
            acc[3] = __builtin_elementwise_fma(__builtin_amdgcn_cvt_pk_f32_fp8((int)vq[k].y, true), a2, acc[3]);
            acc[4] = __builtin_elementwise_fma(__builtin_amdgcn_cvt_pk_f32_fp8((int)vq[k].z, false), a2, acc[4]);
            acc[5] = __builtin_elementwise_fma(__builtin_amdgcn_cvt_pk_f32_fp8((int)vq[k].z, true), a2, acc[5]);
            acc[6] = __builtin_elementwise_fma(__builtin_amdgcn_cvt_pk_f32_fp8((int)vq[k].w, false), a2, acc[6]);
            acc[7] = __builtin_elementwise_fma(__builtin_amdgcn_cvt_pk_f32_fp8((int)vq[k].w, true), a2, acc[7]);
        }
    }
    float ss = 0.f;
#pragma unroll
    for (int i = 0; i < 4; ++i) { x2[i].x += acc[2 * i].x; x2[i].y += acc[2 * i].y; x2[i].z += acc[2 * i + 1].x; x2[i].w += acc[2 * i + 1].y;
        ss += (x2[i].x * x2[i].x + x2[i].y * x2[i].y) + (x2[i].z * x2[i].z + x2[i].w * x2[i].w); }
    const float rstd3 = rsqrtf(wave_sum(ss) * (1.0f / 1024.0f) + 1e-6f);
    float* orow = dstbase + (size_t)t * 1024 + 16 * lane;
#pragma unroll
    for (int i = 0; i < 4; ++i) { const f32x4 w = ((const f32x4*)(P.norm_final_w + 16 * lane))[i];
        ((f32x4*)orow)[i] = (f32x4){x2[i].x * rstd3 * w.x, x2[i].y * rstd3 * w.y, x2[i].z * rstd3 * w.z, x2[i].w * rstd3 * w.w}; }
}

__global__ void __launch_bounds__(NWAVES * 64, 2) hybrid_fwd(Params P) {
    extern __shared__ __attribute__((aligned(16))) unsigned char lds_raw[];
    LAS unsigned char* lds = (LAS unsigned char*)lds_raw;
    volatile LAS unsigned* MISC = (volatile LAS unsigned*)(lds + MISC_OFF);
    const int tid = threadIdx.x, lane = tid & 63, wave = __builtin_amdgcn_readfirstlane(tid >> 6);
    const int G = gridDim.x, bx = blockIdx.x;
    const int vcu = (G % 8 == 0) ? (bx % 8) * (G / 8) + bx / 8 : bx;
    unsigned char* ws = P.ws;
    for (int u = tid; u < 64; u += NWAVES * 64) MISC[u] = 0u;
    __syncthreads();
    XcdBarrier bar; bar.bar = (unsigned*)(ws + WS_CTL) + CW_BAR; bar.x = 0; bar.st = nullptr;
    if (!MK_PER_PHASE) bar = xcd_barrier_post((unsigned*)(ws + WS_CTL) + CW_BAR, MISC + 8);
    const int lo = P.ph_lo, hi = P.ph_hi;
#ifndef PHASE_MASK
#define PHASE_MASK 0xFFF
#endif
#define IN(k) (((PHASE_MASK >> (k)) & 1) && lo <= (k) && (k) < hi)
#define SEAM(k) do { if (IN(k) && IN((k) + 1)) xcd_barrier(bar); } while (0)
#ifndef REP_MASK
#define REP_MASK 0
#endif
#define REPS(k) for (int rep_ = 0; rep_ < (((REP_MASK >> (k)) & 1) ? 2 : 1); ++rep_, (rep_ < (((REP_MASK >> (k)) & 1) ? 2 : 1) ? xcd_barrier(bar) : (void)0))
    using namespace pg8;
    bf16* XB = (bf16*)(ws + WS_XB);

    if (IN(0)) REPS(0) { p0_prologue(P, lds, tid, lane, wave, vcu, G); }
    SEAM(0);
    if (IN(1)) REPS(1) {
        { Gemm gm{XB, (const bf16_t*)(ws + WS_WIN), T, 3072, 1024}; StaticOrder S; S.init(T, 3072, G, bx);
          EpiBf16Rs E{(bf16_t*)(ws + WS_QKV), 1536, 6, (bf16_t*)(ws + WS_XR), 512, (size_t)T * 512, nullptr, 1.0f};
          gemm_phase<EpiBf16Rs, StaticOrder, PG8_ALIGN, PG8_SP2>(lds, gm, S, E); }
        { Gemm gm{(const bf16_t*)(ws + WS_MEMN), (const bf16_t*)(ws + WS_WKV), 512, 2048, 1024}; StaticOrder S; S.init(512, 2048, G, bx);
          EpiKV E{(bf16_t*)(ws + WS_KB), (bf16_t*)(ws + WS_VTP)};
          gemm_phase<EpiKV, StaticOrder, PG8_ALIGN, PG8_SP2>(lds, gm, S, E); }
    }
    SEAM(1);
    if (IN(2)) REPS(2) {
#ifndef P2_REP_GDN
#define P2_REP_GDN 1
#endif
#ifndef P2_REP_LRU
#define P2_REP_LRU 1
#endif
        for (int rr = 0; rr < P2_REP_GDN; ++rr) for (int it = bx; it < 1024; it += G) gdn_local_item(P, lds, it, tid);
        for (int rr = 0; rr < P2_REP_LRU; ++rr) for (int lt = bx; lt < 256; lt += G) lru_local_item(P, lds, lt, tid, lane, wave);
    }
    SEAM(2);
    if (IN(3)) REPS(3) {
        if (bx < SCAN_WGS) gdn_scan(P, lds, bx, tid, lane, wave);
        else if (bx < SCAN_WGS + 2) lru_carry(P, (bx - SCAN_WGS) * NWAVES + wave, lane);
        else cvt_table_fp8(P.peer_u, ws + WS_UB, (float*)(ws + WS_UB + 16 * MiB), (bx - SCAN_WGS - 2) * NWAVES + wave, (G - SCAN_WGS - 2) * NWAVES, lane);
    }
    SEAM(3);
    if (IN(4)) REPS(4) {
        gdn_gate_norm(P, (size_t)bx * (NWAVES * 64) + tid, (size_t)G * (NWAVES * 64));
        lru_combine(P, (size_t)bx * (NWAVES * 64) + tid, (size_t)G * (NWAVES * 64));
        cvt_table_fp8(P.peer_v, ws + WS_VB, (float*)(ws + WS_VB + 16 * MiB), bx * NWAVES + wave, G * NWAVES, lane);
    }
    SEAM(4);
    if (IN(5)) {
        Gemm gm{(const bf16_t*)(ws + WS_Y), (const bf16_t*)(ws + WS_WOUT), T, 1024, 1024}; StaticOrder S; S.init(T, 1024, G, bx);
        EpiResid E{P.x, P.out, XB, (float*)(ws + WS_SSQ1)};
        gemm_phase<EpiResid, StaticOrder, PG8_ALIGN, PG8_SP2>(lds, gm, S, E);
    }
    SEAM(5);
    if (IN(6)) REPS(6) {
        Gemm gm{XB, (const bf16_t*)(ws + WS_WQ), T, 1024, 1024}; StaticOrder S; S.init(T, 1024, G, bx);
        EpiBf16Rs E{(bf16_t*)(ws + WS_Q), 1024, 4, nullptr, 256, 0, (const float*)(ws + WS_SSQ1), 0.0625f};
        gemm_phase<EpiBf16Rs, StaticOrder, PG8_ALIGN, PG8_SP2>(lds, gm, S, E);
    }
    SEAM(6);
    if (IN(7)) REPS(7) {
        for (int un = bx; un < 512; un += G) xattn_unit(P, lds, un, tid, lane, wave);
    }
    SEAM(7);
    if (IN(8)) {
        Gemm gm{(const bf16_t*)(ws + WS_AO), (const bf16_t*)(ws + WS_WO), T, 1024, 1024}; StaticOrder S; S.init(T, 1024, G, bx);
        EpiResid E{P.out, P.out, XB, (float*)(ws + WS_SSQ2)};
        gemm_phase<EpiResid, StaticOrder, PG8_ALIGN, PG8_SP2>(lds, gm, S, E);
    }
    SEAM(8);
    if (IN(9)) REPS(9) {
        Gemm gm{XB, (const bf16_t*)(ws + WS_PWQ), T, 2048, 1024}; StaticOrder S; S.init(T, 2048, G, bx);
        EpiF16Rs E{(_Float16*)(ws + WS_PQ), 2048, (const float*)(ws + WS_SSQ2)};
        gemm_phase<EpiF16Rs, StaticOrder, PG8_ALIGN, PG8_SP2>(lds, gm, S, E);
    }
    SEAM(9);
    if (IN(10)) REPS(10) {
        for (int rb = bx * 256; rb < T * 8; rb += G * 256) peer_topk_rows(P, lds, rb, tid);
    }
    SEAM(10);
    if (IN(11)) REPS(11) {
        for (int t = bx * NWAVES + wave; t < T; t += G * NWAVES) peer_token(P, t, lane, (((REP_MASK >> 11) & 1) && rep_ == 0) ? (float*)(ws + WS_PQ) : P.out);
    }
#undef IN
#undef SEAM
}

extern "C" void kernel_launch(void* const* d_in, const int* in_sizes, int n_in, void* d_out, int out_size, void* d_ws, size_t ws_size, hipStream_t stream) {
    static int grid = 0;
    if (grid == 0) {
        if (n_in != 27 || in_sizes[0] != T * D || out_size != T * D || ws_size < WS_END) {
            fprintf(stderr, "kernel_launch: unexpected shapes (n_in %d, in0 %d, out %d, ws %zu); nothing launched\n", n_in, n_in > 0 ? in_sizes[0] : -1, out_size, ws_size); grid = -1; return; }
        int dev = 0, cus = 0, per_cu = 0;
        if (hipGetDevice(&dev) != hipSuccess || hipDeviceGetAttribute(&cus, hipDeviceAttributeMultiprocessorCount, dev) != hipSuccess) { grid = -1; return; }
        if (hipFuncSetAttribute((const void*)hybrid_fwd, hipFuncAttributeMaxDynamicSharedMemorySize, LDS_BYTES) != hipSuccess) { fprintf(stderr, "kernel_launch: hipFuncSetAttribute failed\n"); grid = -1; return; }
        if (hipOccupancyMaxActiveBlocksPerMultiprocessor(&per_cu, (const void*)hybrid_fwd, NWAVES * 64, LDS_BYTES) != hipSuccess || per_cu < 1)
            fprintf(stderr, "kernel_launch: note: occupancy query reports %d workgroups per CU\n", per_cu);
        (void)hipGetLastError();
        grid = cus;
        if (grid != 256) fprintf(stderr, "kernel_launch: %d CUs (built for 256)\n", grid);
    }
    if (grid < 0) return;
    if (hipMemsetAsync((char*)d_ws + WS_CTL, 0, CTL_ZERO_BYTES, stream) != hipSuccess) { fprintf(stderr, "kernel_launch: hipMemsetAsync failed\n"); return; }
    Params p{};
    const float** pp = (const float**)&p;
    for (int i = 0; i < 27; ++i) pp[i] = (const float*)d_in[i];
    p.out = (float*)d_out; p.ws = (unsigned char*)d_ws;
#if MK_PER_PHASE
    for (int k = 0; k < N_PHASES; ++k) { p.ph_lo = k; p.ph_hi = k + 1; hipLaunchKernelGGL(hybrid_fwd, dim3(grid), dim3(NWAVES * 64), LDS_BYTES, stream, p); }
#else
    p.ph_lo = 0; p.ph_hi = N_PHASES;
    hipLaunchKernelGGL(hybrid_fwd, dim3(grid), dim3(NWAVES * 64), LDS_BYTES, stream, p);
#endif
    const hipError_t le = hipPeekAtLastError();
    if (le != hipSuccess) fprintf(stderr, "kernel_launch: launch failed: %s\n", hipGetErrorName(le));
}
```

```cpp
#include <hip/hip_runtime.h>
#include <cstdio>
#include <cstdint>
namespace pg8 {
#define PG8_LAS __attribute__((address_space(3)))
typedef unsigned short bf16_t;
typedef short bf16x8 __attribute__((ext_vector_type(8)));
typedef float f32x4 __attribute__((ext_vector_type(4)));
typedef unsigned u32x4 __attribute__((ext_vector_type(4)));
constexpr int BM = 256, BK = 64, HALF = 128, HTB = HALF * BK * 2  , STAGE_BYTES = 8 * HTB, NXCD = 8, WGM = 8;

__host__ __device__ __forceinline__ int lds_byte(int r, int c) { const int st = (r >> 4) * 2 + (c >> 5), rr = r & 15, cc = c & 31, ob = rr * 64 + cc * 2; return st * 1024 + (ob ^ (((ob >> 9) & 1) << 5)); }
__host__ __device__ __forceinline__ void stage_rc(int b, int& R, int& C) { const int st = b / 1024, sb = b % 1024, swz = sb ^ (((sb >> 9) & 1) << 5); R = (st >> 1) * 16 + swz / 64; C = (st & 1) * 32 + (swz % 64) / 2; }
__host__ __device__ __forceinline__ int perm32(int rho) { const int n = rho >> 4, i = rho & 15; return 8 * (i >> 2) + 4 * n + (i & 3); }

struct Unit { int pm, pn; };
struct Gemm { const bf16_t* A; const bf16_t* Bt; int M, N, K; };

struct StaticOrder {
    int nM, nN, nwg, G, c;
    __host__ __device__ void init(int M, int N, int G_, int c_) { nM = M / BM; nN = N / BM; nwg = nM * nN; G = G_; c = c_; }
    __host__ __device__ bool next(int i, Unit& u) const {
        const long L = (long)i * G + c; if (L >= nwg) return false;
        int wgid = (int)L; { const int q = nwg / NXCD, r = nwg % NXCD, xcd = wgid % NXCD, off = wgid / NXCD; wgid = (xcd < r ? xcd * (q + 1) : r * (q + 1) + (xcd - r) * q) + off; }
        const int nig = WGM * nN, gid = wgid / nig, fm = gid * WGM, gsz = (nM - fm) < WGM ? (nM - fm) : WGM;
        u.pm = fm + ((wgid % nig) % gsz); u.pn = (wgid % nig) / gsz; return true;
    }
    __device__ __forceinline__ void a_ready(const Unit&) const {}
    __device__ __forceinline__ void done(const Unit&) const {}
};

__device__ __forceinline__ unsigned cvt_pk_bf16(float lo, float hi) { unsigned r; asm volatile("v_cvt_pk_bf16_f32 %0, %1, %2" : "=v"(r) : "v"(lo), "v"(hi)); return r; }
template <class Epi, class Sched, bool ALIGN_EPI = false, bool SP2 = false>
__device__ __forceinline__ void gemm_phase(PG8_LAS unsigned char* lds, const Gemm g, const Sched& S, const Epi& E) {
    const int tid = threadIdx.x, wid = __builtin_amdgcn_readfirstlane(tid >> 6), lane = tid & 63, wr = wid >> 2, wc = wid & 3, fr = lane & 15, fq = lane >> 4;
    const int K = g.K, nt = K / BK;
    unsigned voffA[2], voffB[2];
#pragma unroll
    for (int i = 0; i < 2; ++i) { int R, C; stage_rc(tid * 16 + i * 8192, R, C); const int Rb = Epi::PERM ? ((R & ~31) + perm32(R & 31)) : R;
        voffA[i] = (unsigned)(R * K + C) * 2u; voffB[i] = (unsigned)(Rb * K + C) * 2u; }
    const size_t kstep = (size_t)(BK * 2);
    const size_t hstep = (size_t)HALF * K * 2;
    const size_t tstep = 2 * hstep;
    const unsigned ldsw = (unsigned)wid * 1024u;
    const int aoff = lds_byte(wr * 64 + fr, fq * 8), boff = lds_byte(wc * 32 + fr, fq * 8);
#define PG8_SA(b, h) (((b) * 2 + (h)) * HTB)
#define PG8_SB(b, h) ((4 + (b) * 2 + (h)) * HTB)
#define PG8_STAGE(bufoff, gbase, voff) do { _Pragma("unroll") for (int _i = 0; _i < 2; ++_i) \
        __builtin_amdgcn_global_load_lds((const unsigned*)((const char*)(gbase) + (voff)[_i]), (PG8_LAS unsigned*)(lds + (bufoff) + ldsw + _i * 8192), 16, 0, 0); } while (0)
#define PG8_LDA(dst, b, h) do { _Pragma("unroll") for (int m = 0; m < 4; ++m) _Pragma("unroll") for (int k = 0; k < 2; ++k) dst[m][k] = *(const PG8_LAS bf16x8*)(lds + PG8_SA(b, h) + aoff + m * 2048 + k * 1024); } while (0)
#define PG8_LDB(dst, b, h) do { _Pragma("unroll") for (int n = 0; n < 2; ++n) _Pragma("unroll") for (int k = 0; k < 2; ++k) dst[n][k] = *(const PG8_LAS bf16x8*)(lds + PG8_SB(b, h) + boff + n * 2048 + k * 1024); } while (0)
#define PG8_MMA(ai, bj, At, Bt) do { __builtin_amdgcn_s_setprio(1); _Pragma("unroll") for (int m = 0; m < 4; ++m) _Pragma("unroll") for (int n = 0; n < 2; ++n) _Pragma("unroll") for (int k = 0; k < 2; ++k) \
        acc[ai][bj][m][n] = __builtin_amdgcn_mfma_f32_16x16x32_bf16(Bt[n][k], At[m][k], acc[ai][bj][m][n], 0, 0, 0); __builtin_amdgcn_s_setprio(0); } while (0)
#define PG8_WAIT_V(n) asm volatile("s_waitcnt vmcnt(" #n ")" ::: "memory")
#define PG8_WAIT_L(n) asm volatile("s_waitcnt lgkmcnt(" #n ")" ::: "memory")
#define PG8_BAR __builtin_amdgcn_s_barrier()
#define PG8_SCHED __builtin_amdgcn_sched_barrier(0)
    Unit cur, nxt; int ui = 0;
    if (!S.next(0, cur)) return;
    f32x4 acc[2][2][4][2];
#pragma unroll
    for (int a = 0; a < 2; ++a)
#pragma unroll
        for (int b = 0; b < 2; ++b)
#pragma unroll
            for (int m = 0; m < 4; ++m)
#pragma unroll
                for (int n = 0; n < 2; ++n) acc[a][b][m][n] = (f32x4){0.f, 0.f, 0.f, 0.f};
    bf16x8 At[4][2], B0[2][2], B1[2][2];
    const char* cA = (const char*)g.A + (size_t)cur.pm * tstep; const char* cB = (const char*)g.Bt + (size_t)cur.pn * tstep;
    S.a_ready(cur);
    if constexpr (SP2) {
        PG8_STAGE(PG8_SB(0, 0), cB, voffB); PG8_STAGE(PG8_SB(0, 1), cB + hstep, voffB); PG8_STAGE(PG8_SA(0, 0), cA, voffA); PG8_STAGE(PG8_SA(0, 1), cA + hstep, voffA);
        if (wr == 1) PG8_BAR;
        PG8_WAIT_V(2); PG8_BAR;
        PG8_STAGE(PG8_SB(1, 0), cB + kstep, voffB); PG8_STAGE(PG8_SA(1, 0), cA + kstep, voffA); PG8_STAGE(PG8_SB(1, 1), cB + hstep + kstep, voffB);
        PG8_WAIT_V(6); PG8_BAR;
    } else {
        PG8_STAGE(PG8_SB(0, 0), cB, voffB); PG8_STAGE(PG8_SA(0, 0), cA, voffA); PG8_STAGE(PG8_SB(0, 1), cB + hstep, voffB); PG8_STAGE(PG8_SA(0, 1), cA + hstep, voffA);
        if (wr == 1) PG8_BAR;
        PG8_WAIT_V(4); PG8_BAR;
        PG8_STAGE(PG8_SB(1, 0), cB + kstep, voffB); PG8_STAGE(PG8_SA(1, 0), cA + kstep, voffA); PG8_STAGE(PG8_SB(1, 1), cB + hstep + kstep, voffB);
        PG8_WAIT_V(6); PG8_BAR;
    }
    for (;;) {
        const bool has_next = S.next(ui + 1, nxt);
        const char* nA = has_next ? (const char*)g.A + (size_t)nxt.pm * tstep : cA; const char* nB = has_next ? (const char*)g.Bt + (size_t)nxt.pn * tstep : cB;
        for (int t = 0; t < nt; t += 2) {
            const bool last = (t == nt - 2);
            const char* a1 = cA + (size_t)(t + 1) * kstep;
            const char* a2 = last ? nA : cA + (size_t)(t + 2) * kstep; const char* b2 = last ? nB : cB + (size_t)(t + 2) * kstep;
            const char* a3 = a2 + kstep; const char* b3 = b2 + kstep;
            if (last && has_next) S.a_ready(nxt);
            if constexpr (SP2) {
            PG8_LDB(B0, 0, 0); PG8_LDB(B1, 0, 1); PG8_SCHED; PG8_LDA(At, 0, 0); PG8_STAGE(PG8_SA(1, 1), a1 + hstep, voffA);
            PG8_WAIT_V(8); PG8_WAIT_L(0); PG8_BAR; PG8_MMA(0, 0, At, B0); PG8_MMA(0, 1, At, B1); PG8_BAR; PG8_SCHED;
            PG8_LDA(At, 0, 1); PG8_STAGE(PG8_SB(0, 0), b2, voffB); PG8_STAGE(PG8_SB(0, 1), b2 + hstep, voffB); PG8_STAGE(PG8_SA(0, 0), a2, voffA);
            PG8_WAIT_V(8); PG8_WAIT_L(0); PG8_BAR; PG8_MMA(1, 0, At, B0); PG8_MMA(1, 1, At, B1); PG8_BAR; PG8_SCHED;
            PG8_LDB(B0, 1, 0); PG8_LDB(B1, 1, 1); PG8_SCHED; PG8_LDA(At, 1, 0); PG8_STAGE(PG8_SA(0, 1), a2 + hstep, voffA);
            PG8_WAIT_V(8); PG8_WAIT_L(0); PG8_BAR; PG8_MMA(0, 0, At, B0); PG8_MMA(0, 1, At, B1); PG8_BAR; PG8_SCHED;
            PG8_LDA(At, 1, 1); PG8_STAGE(PG8_SB(1, 0), b3, voffB); PG8_STAGE(PG8_SB(1, 1), b3 + hstep, voffB); PG8_STAGE(PG8_SA(1, 0), a3, voffA);
            PG8_WAIT_V(8); PG8_WAIT_L(0); PG8_BAR; PG8_MMA(1, 0, At, B0); PG8_MMA(1, 1, At, B1); PG8_BAR; PG8_SCHED;
            } else {
            PG8_LDB(B0, 0, 0); PG8_SCHED; PG8_LDA(At, 0, 0); PG8_STAGE(PG8_SA(1, 1), a1 + hstep, voffA);
            PG8_WAIT_L(8); PG8_BAR; PG8_WAIT_L(0); PG8_MMA(0, 0, At, B0); PG8_BAR; PG8_SCHED;
            PG8_LDB(B1, 0, 1); PG8_STAGE(PG8_SB(0, 0), b2, voffB);
            PG8_BAR; PG8_WAIT_L(0); PG8_MMA(0, 1, At, B1); PG8_BAR;
            PG8_LDA(At, 0, 1); PG8_STAGE(PG8_SA(0, 0), a2, voffA);
            PG8_BAR; PG8_WAIT_L(0); PG8_MMA(1, 0, At, B0); PG8_BAR; PG8_SCHED;
            PG8_STAGE(PG8_SB(0, 1), b2 + hstep, voffB);
            PG8_WAIT_V(6); PG8_BAR; PG8_MMA(1, 1, At, B1); PG8_BAR;
            PG8_LDB(B0, 1, 0); PG8_SCHED; PG8_LDA(At, 1, 0); PG8_STAGE(PG8_SA(0, 1), a2 + hstep, voffA);
            PG8_WAIT_L(8); PG8_BAR; PG8_WAIT_L(0); PG8_MMA(0, 0, At, B0); PG8_BAR; PG8_SCHED;
            PG8_LDB(B1, 1, 1); PG8_STAGE(PG8_SB(1, 0), b3, voffB);
            PG8_BAR; PG8_WAIT_L(0); PG8_MMA(0, 1, At, B1); PG8_BAR;
            PG8_LDA(At, 1, 1); PG8_STAGE(PG8_SA(1, 0), a3, voffA);
            PG8_BAR; PG8_WAIT_L(0); PG8_MMA(1, 0, At, B0); PG8_BAR; PG8_SCHED;
            PG8_STAGE(PG8_SB(1, 1), b3 + hstep, voffB);
            PG8_WAIT_V(6); PG8_BAR; PG8_MMA(1, 1, At, B1); PG8_BAR;
            }
        }
        if constexpr (ALIGN_EPI) { if (wr == 0) PG8_BAR; }
        if constexpr (!Epi::AFTER_DRAIN) { E(acc, cur, wr, wc, fr, fq); S.done(cur); }
        if (!has_next) break;
#pragma unroll
        for (int a = 0; a < 2; ++a)
#pragma unroll
            for (int b = 0; b < 2; ++b)
#pragma unroll
                for (int m = 0; m < 4; ++m)
#pragma unroll
                    for (int n = 0; n < 2; ++n) acc[a][b][m][n] = (f32x4){0.f, 0.f, 0.f, 0.f};
        cur = nxt; cA = nA; cB = nB; ++ui;
        if constexpr (ALIGN_EPI) { if (wr == 1) PG8_BAR; }
    }
    PG8_WAIT_V(0);
    if constexpr (!ALIGN_EPI) { if (wr == 0) PG8_BAR; }
    PG8_BAR;
    if constexpr (Epi::AFTER_DRAIN) { E.fused(acc, cur, wr, wc, fr, fq, lds, wid, lane); S.done(cur); }
#undef PG8_SA
#undef PG8_SB
#undef PG8_STAGE
#undef PG8_LDA
#undef PG8_LDB
#undef PG8_MMA
#undef PG8_WAIT_V
#undef PG8_WAIT_L
#undef PG8_BAR
#undef PG8_SCHED
}
}

namespace pg8 {
__host__ __device__ __forceinline__ int permk(int kl) { return 8 * ((kl & 15) >> 2) + 4 * (kl >> 4) + (kl & 3); }
struct EpiBf16Rs {
    static constexpr bool PERM = true, AFTER_DRAIN = false;
    bf16_t* O0; int ld0; int ntile0; bf16_t* O1; int ld1; size_t stride1; const float* ssq; float cs;
    __device__ __forceinline__ void operator()(const f32x4 (&acc)[2][2][4][2], const Unit& u, int wr, int wc, int fr, int fq) const {
        bf16_t* base; int ld, colt;
        if (u.pn < ntile0) { base = O0; ld = ld0; colt = u.pn * BM; }
        else { const int q = u.pn - ntile0, per = ld1 / BM; base = O1 + (size_t)(q / per) * stride1; ld = ld1; colt = (q % per) * BM; }
        const int row0 = u.pm * BM + wr * 64 + fr, col0 = colt + wc * 32 + 8 * fq;
#pragma unroll
        for (int ai = 0; ai < 2; ++ai)
#pragma unroll
            for (int m = 0; m < 4; ++m) {
                const int row = row0 + ai * HALF + m * 16;
                float sc = cs; if (ssq) sc *= rsqrtf(ssq[row] * (1.0f / 1024.0f) + 1e-6f);
                bf16_t* rowp = base + (size_t)row * ld + col0;
#pragma unroll
                for (int bj = 0; bj < 2; ++bj) { const f32x4 v0 = acc[ai][bj][m][0] * sc, v1 = acc[ai][bj][m][1] * sc;
                    u32x4 w; w.x = cvt_pk_bf16(v0[0], v0[1]); w.y = cvt_pk_bf16(v0[2], v0[3]); w.z = cvt_pk_bf16(v1[0], v1[1]); w.w = cvt_pk_bf16(v1[2], v1[3]);
                    *(u32x4*)(rowp + bj * HALF) = w; } }
    }
};
struct EpiF16Rs {
    static constexpr bool PERM = true, AFTER_DRAIN = false;
    _Float16* O; int ld; const float* ssq;
    __device__ __forceinline__ void operator()(const f32x4 (&acc)[2][2][4][2], const Unit& u, int wr, int wc, int fr, int fq) const {
        typedef _Float16 f16x8 __attribute__((ext_vector_type(8)));
        const int row0 = u.pm * BM + wr * 64 + fr, col0 = u.pn * BM + wc * 32 + 8 * fq;
#pragma unroll
        for (int ai = 0; ai < 2; ++ai)
#pragma unroll
            for (int m = 0; m < 4; ++m) {
                const int row = row0 + ai * HALF + m * 16;
                const float sc = rsqrtf(ssq[row] * (1.0f / 1024.0f) + 1e-6f);
                _Float16* rowp = O + (size_t)row * ld + col0;
#pragma unroll
                for (int bj = 0; bj < 2; ++bj) { const f32x4 v0 = acc[ai][bj][m][0] * sc, v1 = acc[ai][bj][m][1] * sc;
                    f16x8 w; w[0] = (_Float16)v0[0]; w[1] = (_Float16)v0[1]; w[2] = (_Float16)v0[2]; w[3] = (_Float16)v0[3];
                    w[4] = (_Float16)v1[0]; w[5] = (_Float16)v1[1]; w[6] = (_Float16)v1[2]; w[7] = (_Float16)v1[3];
                    *(f16x8*)(rowp + bj * HALF) = w; } }
    }
};
struct EpiResid {
    static constexpr bool PERM = false, AFTER_DRAIN = false;
    const float* base; float* out; bf16_t* xb; float* ssq;
    __device__ __forceinline__ void operator()(const f32x4 (&acc)[2][2][4][2], const Unit& u, int wr, int wc, int fr, int fq) const {
        typedef unsigned u32x2v __attribute__((ext_vector_type(2)));
        const int row0 = u.pm * BM + wr * 64 + fr, col0 = u.pn * BM + wc * 32 + 4 * fq;
#pragma unroll
        for (int ai = 0; ai < 2; ++ai)
#pragma unroll
            for (int m = 0; m < 4; ++m) {
                const int row = row0 + ai * HALF + m * 16; const size_t off = (size_t)row * 1024 + col0; float s = 0.f;
#pragma unroll
                for (int bj = 0; bj < 2; ++bj)
#pragma unroll
                    for (int n = 0; n < 2; ++n) { const size_t o2 = off + bj * HALF + n * 16;
                        const f32x4 o = *(const f32x4*)(base + o2) + acc[ai][bj][m][n];
                        *(f32x4*)(out + o2) = o; s += (o[0] * o[0] + o[1] * o[1]) + (o[2] * o[2] + o[3] * o[3]);
                        u32x2v w; w.x = cvt_pk_bf16(o[0], o[1]); w.y = cvt_pk_bf16(o[2], o[3]); *(u32x2v*)(xb + o2) = w; }
                s += __shfl_xor(s, 16); s += __shfl_xor(s, 32);
                if (fq == 0) atomicAdd(ssq + row, s);
            }
    }
};
struct EpiKV {
    static constexpr bool PERM = false, AFTER_DRAIN = false;
    bf16_t* Kb; bf16_t* VTp;
    __device__ __forceinline__ void operator()(const f32x4 (&acc)[2][2][4][2], const Unit& u, int wr, int wc, int fr, int fq) const {
        typedef unsigned u32x2v __attribute__((ext_vector_type(2)));
        const int row0 = u.pm * BM + wr * 64 + fr, col0 = u.pn * BM + wc * 32 + 4 * fq;
#pragma unroll
        for (int ai = 0; ai < 2; ++ai)
#pragma unroll
            for (int m = 0; m < 4; ++m) {
                const int row = row0 + ai * HALF + m * 16, b = row >> 8, key = row & 255;
#pragma unroll
                for (int bj = 0; bj < 2; ++bj)
#pragma unroll
                    for (int n = 0; n < 2; ++n) { const int col = col0 + bj * HALF + n * 16; const f32x4 v = acc[ai][bj][m][n];
                        const unsigned p01 = cvt_pk_bf16(v[0], v[1]), p23 = cvt_pk_bf16(v[2], v[3]);
                        if (col < 1024) { const int h = col >> 8, dh = col & 255; u32x2v w; w.x = p01; w.y = p23;
                            *(u32x2v*)(Kb + ((size_t)((b * 4 + h) * 256 + key)) * 256 + dh) = w; }
                        else { const int c2 = col - 1024, h = c2 >> 8, dv = c2 & 255, kp = (key & ~31) | permk(key & 31);
                            bf16_t* d = VTp + ((size_t)((b * 4 + h) * 256 + dv)) * 256 + kp;
                            d[0] = (bf16_t)(p01 & 0xffffu); d[256] = (bf16_t)(p01 >> 16); d[512] = (bf16_t)(p23 & 0xffffu); d[768] = (bf16_t)(p23 >> 16); } }
            }
    }
};
}
#ifndef PG8_SP2
#define PG8_SP2 true
#endif
#ifndef PG8_ALIGN
#define PG8_ALIGN true
#endif

constexpr int NWAVES = 8;
#ifndef MK_PER_PHASE
#define MK_PER_PHASE 0
#endif
constexpr int T = 16384, SEQ = 8192, D = 1024;
constexpr int N_PHASES = 12;

constexpr size_t MiB = 1u << 20, KiB = 1u << 10;
constexpr size_t WS_CTL = 0, CTL_ZERO_BYTES = 1 * MiB;
constexpr int CW_BAR = 4096;
constexpr size_t WS_SSQ1 = 64 * KiB, WS_SSQ2 = 128 * KiB;
constexpr size_t WS_AB = 1 * MiB;
constexpr size_t WS_HEND = WS_AB + 512 * KiB, WS_PEND = WS_HEND + 512 * KiB, WS_HIN = WS_PEND + 512 * KiB;
constexpr size_t WS_DEC = WS_HIN + 512 * KiB;
constexpr size_t WS_SUBK = 3 * MiB + 256 * KiB;
constexpr size_t WS_WIN = 4 * MiB, WS_WOUT = 10 * MiB, WS_WQ = 12 * MiB, WS_WKV = 14 * MiB, WS_WO = 18 * MiB, WS_PWQ = 20 * MiB;
constexpr size_t WS_MEMN = 24 * MiB, WS_KB = 25 * MiB, WS_VTP = 26 * MiB, WS_LRUWT = 27 * MiB, WS_USC = 27 * MiB + 256 * KiB, WS_VSC = 27 * MiB + 384 * KiB;
constexpr size_t WS_XB = 28 * MiB;
constexpr size_t WS_HLOC = 28 * MiB, WS_PCUM = 44 * MiB;
constexpr size_t WS_QKV = 60 * MiB;
constexpr size_t WS_Y = 60 * MiB;
constexpr size_t WS_IDX = 60 * MiB, WS_GW = 68 * MiB;
constexpr size_t WS_UB = 92 * MiB;
constexpr size_t WS_XR = 108 * MiB, WS_Z = 124 * MiB, WS_GATE = 140 * MiB;
constexpr size_t WS_WN = 156 * MiB, WS_UF = 172 * MiB, WS_QD = 188 * MiB, WS_KD = 204 * MiB, WS_ATT = 220 * MiB;
constexpr size_t WS_VB = 228 * MiB;
constexpr size_t WS_Q = 188 * MiB, WS_AO = 124 * MiB;
constexpr size_t WS_PQ = 108 * MiB;
constexpr size_t WS_END = 244 * MiB;
constexpr int CW_LRUCNT = 8192;
static_assert(WS_XR - WS_QKV == (size_t)T * 1536 * 2 && WS_Z - WS_XR == (size_t)T * 512 * 2 && WS_GATE - WS_Z == (size_t)T * 512 * 2, "in-proj outputs are contiguous");

constexpr int LDS_BYTES = 160 * 1024;
constexpr int MISC_OFF = 159 * 1024;

#define GAS __attribute__((address_space(1)))
#define LAS __attribute__((address_space(3)))
typedef unsigned short bf16;
typedef unsigned v4u __attribute__((ext_vector_type(4)));
typedef unsigned v2u __attribute__((ext_vector_type(2)));
typedef float f32x4 __attribute__((ext_vector_type(4)));
typedef short bf16x8 __attribute__((ext_vector_type(8)));
typedef GAS unsigned gu32;
#define LDS_WAIT() asm volatile("s_waitcnt lgkmcnt(0)" ::: "memory")
__device__ __forceinline__ unsigned f2bf(float f) { unsigned u = __builtin_bit_cast(unsigned, f); return (u + 0x7fffu + ((u >> 16) & 1u)) >> 16; }
__device__ __forceinline__ unsigned pk2(float lo, float hi) { return f2bf(lo) | (f2bf(hi) << 16); }
__device__ __forceinline__ float bflo(unsigned u) { return __builtin_bit_cast(float, u << 16); }
__device__ __forceinline__ float bfhi(unsigned u) { return __builtin_bit_cast(float, u & 0xffff0000u); }
__device__ __forceinline__ float bf1(bf16 h) { return __builtin_bit_cast(float, (unsigned)h << 16); }
__device__ __forceinline__ float wave_sum(float v) {
#pragma unroll
    for (int o = 1; o < 64; o <<= 1) v += __shfl_xor(v, o);
    return v;
}
__device__ __forceinline__ float row16_sum(float v) {
    v += __builtin_bit_cast(float, __builtin_amdgcn_update_dpp(0, __builtin_bit_cast(int, v), 0xB1, 0xF, 0xF, true));
    v += __builtin_bit_cast(float, __builtin_amdgcn_update_dpp(0, __builtin_bit_cast(int, v), 0x4E, 0xF, 0xF, true));
    v += __builtin_bit_cast(float, __builtin_amdgcn_update_dpp(0, __builtin_bit_cast(int, v), 0x141, 0xF, 0xF, true));
    v += __builtin_bit_cast(float, __builtin_amdgcn_update_dpp(0, __builtin_bit_cast(int, v), 0x140, 0xF, 0xF, true));
    return v;
}
__device__ __forceinline__ float sigmoidf_(float x) { return __builtin_amdgcn_rcpf(1.0f + __expf(-x)); }
__device__ __forceinline__ float softplusf_(float x) { return fmaxf(x, 0.f) + log1pf(__expf(-fabsf(x))); }
__device__ __forceinline__ float siluf_(float x) { return x * __builtin_amdgcn_rcpf(1.0f + __expf(-x)); }
__device__ __forceinline__ float gelu_tanh(float x) { const float y = 0.7978845608028654f * (x + 0.044715f * x * x * x); const float e = __expf(2.0f * y); return x * (1.0f - __builtin_amdgcn_rcpf(1.0f + e)); }
__device__ __forceinline__ int permk(int kl) { return 8 * ((kl & 15) >> 2) + 4 * (kl >> 4) + (kl & 3); }

struct Params {
    const float *x, *mem, *norm_mix_w, *w_in, *conv_qkv_w, *gdn_a_log, *gdn_dt_bias, *gdn_norm_w, *lru_conv_w, *lru_conv_b, *lru_wa, *lru_ba, *lru_wx, *lru_bx, *lru_lambda, *w_out,
                *norm_xattn_w, *norm_mem_w, *xattn_wq, *xattn_wkv, *xattn_wo, *norm_ffn_w, *peer_wq, *peer_subkeys, *peer_u, *peer_v, *norm_final_w;
    float* out; unsigned char* ws; int ph_lo, ph_hi;
};
#define XB_TMO      128
#define XB_XCNT(j)  (256  + 64 * (j))
#define XB_XSUB(j)  (1280 + 64 * (j))
#define XB_XGEN(j)  (2304 + 64 * (j))
#define XB_TOP      3328
#define XB_TOPGEN   3392
#define XCD_BAR_WORDS 3456
#define XB_SPIN_CAP (1u << 18)

__device__ __forceinline__ unsigned xb_ld(unsigned* p)              { return __hip_atomic_load(p, __ATOMIC_RELAXED, __HIP_MEMORY_SCOPE_AGENT); }
__device__ __forceinline__ unsigned xb_add(unsigned* p, unsigned v) { return __hip_atomic_fetch_add(p, v, __ATOMIC_RELAXED, __HIP_MEMORY_SCOPE_AGENT); }
__device__ __forceinline__ unsigned xb_xcc_id() { return (unsigned)__builtin_amdgcn_s_getreg((3 << 11) | 20) & 0xFu; }
#define XB_SPIN(cond, bar) do { unsigned _sp = 0; while (cond) { __builtin_amdgcn_s_sleep(1); \
    if ((++_sp & 255u) == 0u) { if (xb_ld(&(bar)[XB_TMO])) break; if (_sp > XB_SPIN_CAP) { atomicAdd(&(bar)[XB_TMO], 1u); break; } } } } while (0)

struct XcdBarrier {
    unsigned* bar; unsigned x;
    volatile LAS unsigned* st;
};

__device__ __forceinline__ XcdBarrier xcd_barrier_post(unsigned* bar, volatile LAS unsigned* st) {
    XcdBarrier b; b.bar = bar; b.x = xb_xcc_id(); b.st = st;
    if (threadIdx.x == 0) (void)xb_add(&bar[XB_XCNT(b.x)], 1u);
    return b;
}
__device__ __forceinline__ void xcd_barrier_complete(unsigned* bar, unsigned x, unsigned& nloc, unsigned& nx) {
    const unsigned G = gridDim.x * gridDim.y * gridDim.z;
    unsigned sum, cnt, mine, sp = 0u;
    for (;;) {
        sum = 0u; cnt = 0u; mine = 0u;
#pragma unroll
        for (unsigned j = 0; j < 16; ++j) { const unsigned c = xb_ld(&bar[XB_XCNT(j)]); sum += c; cnt += (c > 0u) ? 1u : 0u; mine = (j == x) ? c : mine; }
        if (sum == G) break;
        __builtin_amdgcn_s_sleep(1);
        if ((++sp & 255u) == 0u) { if (xb_ld(&bar[XB_TMO])) break; if (sp > XB_SPIN_CAP) { atomicAdd(&bar[XB_TMO], 1u); break; } }
    }
    nloc = mine > 0u ? mine : 1u; nx = cnt > 0u ? cnt : 1u;
}

__device__ __forceinline__ void xcd_barrier(const XcdBarrier& b) {
    asm volatile("s_waitcnt vmcnt(0)" ::: "memory");
    __syncthreads();
    if (threadIdx.x == 0) {
        unsigned* bar = b.bar;
        __builtin_amdgcn_s_waitcnt(0);
        unsigned nloc = b.st[0], nx = b.st[1];
        if (nloc == 0u) { xcd_barrier_complete(bar, b.x, nloc, nx); b.st[0] = nloc; b.st[1] = nx; }
        const unsigned old = xb_add(&bar[XB_XSUB(b.x)], 1u);
        const unsigned gen = old / nloc;
        if (old + 1u == (gen + 1u) * nloc) {
            __builtin_amdgcn_fence(__ATOMIC_RELEASE, "agent");
            asm volatile("s_waitcnt vmcnt(0)" ::: "memory");
            const unsigned og = xb_add(&bar[XB_TOP], 1u);
            const unsigned tg = og / nx;
            if (og + 1u == (tg + 1u) * nx) xb_add(&bar[XB_TOPGEN], 1u);
            else XB_SPIN(xb_ld(&bar[XB_TOPGEN]) == tg, bar);
            __builtin_amdgcn_fence(__ATOMIC_ACQUIRE, "agent");
            xb_add(&bar[XB_XGEN(b.x)], 1u);
            asm volatile("s_waitcnt vmcnt(0)" ::: "memory");
        } else {
            XB_SPIN(xb_ld(&bar[XB_XGEN(b.x)]) == gen, bar);
            __builtin_amdgcn_fence(__ATOMIC_ACQUIRE, "agent");
            asm volatile("s_waitcnt vmcnt(0)" ::: "memory");
        }
    }
    __syncthreads();
}

__device__ __forceinline__ void p0_transpose_item(const float* W, int K, int ldw, int c0, int nblk, bf16* WT, int row_off, const float* ks, LAS float* scr, int item, int lane) {
    const int kb = item / nblk, nb = item % nblk, k0 = 64 * kb, n0 = 32 * nb;
#pragma unroll 8
    for (int i = 0; i < 32; ++i) { const int kk = 2 * i + (lane >> 5); float v = W[(size_t)(k0 + kk) * ldw + c0 + n0 + (lane & 31)]; if (ks) v *= ks[k0 + kk]; scr[kk * 33 + (lane & 31)] = v; }
    LDS_WAIT(); asm volatile("" ::: "memory");
    const int c = lane & 7;
#pragma unroll
    for (int j = 0; j < 4; ++j) { const int n = (lane >> 3) + 8 * j; const LAS float* s = scr + (8 * c) * 33 + n;
        v4u o; o.x = pk2(s[0 * 33], s[1 * 33]); o.y = pk2(s[2 * 33], s[3 * 33]); o.z = pk2(s[4 * 33], s[5 * 33]); o.w = pk2(s[6 * 33], s[7 * 33]);
        *(GAS v4u*)(WT + (size_t)(row_off + n0 + n) * K + k0 + 8 * c) = o; }
    LDS_WAIT(); asm volatile("" ::: "memory");
}

__device__ __forceinline__ void p0_prologue(const Params& P, LAS unsigned char* lds, int tid, int lane, int wave, int vcu, int G) {
    unsigned char* ws = P.ws;
    const int gw = vcu * NWAVES + wave, NGW = G * NWAVES;
    LAS float* wabl = (LAS float*)lds;
    for (int idx = tid; idx < 8192; idx += NWAVES * 64) { const int k = idx >> 3, c = idx & 7, j = k >> 8, l = (k >> 2) & 63, e = k & 3;
        wabl[((((j * 4 + e) * 2 + (c >> 2)) * 64 + l) << 2) + (c & 3)] = P.w_in[(size_t)k * 3080 + 2048 + c]; }
    __syncthreads();
    {
        bf16* XB0 = (bf16*)(ws + WS_XB); float* AB = (float*)(ws + WS_AB);
        f32x4 w4[4];
#pragma unroll
        for (int j = 0; j < 4; ++j) w4[j] = ((const f32x4*)P.norm_mix_w)[64 * j + lane];
        for (int m = gw; m < T; m += NGW) {
            const f32x4* xr = (const f32x4*)(P.x + (size_t)m * D) + lane;
            f32x4 v[4]; float s = 0.f;
#pragma unroll
            for (int j = 0; j < 4; ++j) { v[j] = xr[64 * j]; s += (v[j].x * v[j].x + v[j].y * v[j].y) + (v[j].z * v[j].z + v[j].w * v[j].w); }
            const float rstd = rsqrtf(wave_sum(s) * (1.0f / D) + 1e-6f);
            v2u* o8 = (v2u*)(XB0 + (size_t)m * D) + lane;
            float part[8];
#pragma unroll
            for (int c = 0; c < 8; ++c) part[c] = 0.f;
#pragma unroll
            for (int j = 0; j < 4; ++j) {
                v[j] = v[j] * rstd * w4[j];
                v2u o; o.x = pk2(v[j].x, v[j].y); o.y = pk2(v[j].z, v[j].w); o8[64 * j] = o;
#pragma unroll
                for (int e = 0; e < 4; ++e) {
                    const f32x4 wa = *(const LAS f32x4*)(wabl + ((((j * 4 + e) * 2 + 0) * 64 + lane) << 2));
                    const f32x4 wb = *(const LAS f32x4*)(wabl + ((((j * 4 + e) * 2 + 1) * 64 + lane) << 2));
                    const float hv = v[j][e];
                    part[0] += hv * wa.x; part[1] += hv * wa.y; part[2] += hv * wa.z; part[3] += hv * wa.w;
                    part[4] += hv * wb.x; part[5] += hv * wb.y; part[6] += hv * wb.z; part[7] += hv * wb.w;
                }
            }
#pragma unroll
            for (int c = 0; c < 8; ++c) part[c] = wave_sum(part[c]);
            float o = part[0];
#pragma unroll
            for (int c = 1; c < 8; ++c) o = (lane == c) ? part[c] : o;
            if (lane < 8) AB[(size_t)m * 8 + lane] = o;
        }
    }
    {
        bf16* MEMN = (bf16*)(ws + WS_MEMN);
        for (int m = gw; m < 512; m += NGW) {
            const f32x4* xr = (const f32x4*)(P.mem + (size_t)m * D) + lane;
            f32x4 v[4]; float s = 0.f;
#pragma unroll
            for (int j = 0; j < 4; ++j) { v[j] = xr[64 * j]; s += (v[j].x * v[j].x + v[j].y * v[j].y) + (v[j].z * v[j].z + v[j].w * v[j].w); }
            const float rstd = rsqrtf(wave_sum(s) * (1.0f / D) + 1e-6f);
            v2u* o8 = (v2u*)(MEMN + (size_t)m * D) + lane;
#pragma unroll
            for (int j = 0; j < 4; ++j) { const f32x4 w = ((const f32x4*)P.norm_mem_w)[64 * j + lane]; const f32x4 y = v[j] * rstd * w;
                v2u o; o.x = pk2(y.x, y.y); o.y = pk2(y.z, y.w); o8[64 * j] = o; }
        }
    }
    __syncthreads();
    {
        LAS float* scr = (LAS float*)(lds + wave * 16384);
        constexpr int I_IN1 = 16 * 48, I_IN2 = 16 * 16, I_KV = 16 * 64;
        constexpr int NITEMS = I_IN1 + 3 * I_IN2 + I_KV;
        for (int it = gw; it < NITEMS; it += NGW) {
            int r = it;
            if (r < I_IN1) { p0_transpose_item(P.w_in, 1024, 3080, 0, 48, (bf16*)(ws + WS_WIN), 0, nullptr, scr, r, lane); continue; } r -= I_IN1;
            if (r < I_IN2) { p0_transpose_item(P.w_in, 1024, 3080, 2056, 16, (bf16*)(ws + WS_WIN), 1536, nullptr, scr, r, lane); continue; } r -= I_IN2;
            if (r < I_IN2) { p0_transpose_item(P.w_in, 1024, 3080, 1536, 16, (bf16*)(ws + WS_WIN), 2048, nullptr, scr, r, lane); continue; } r -= I_IN2;
            if (r < I_IN2) { p0_transpose_item(P.w_in, 1024, 3080, 2568, 16, (bf16*)(ws + WS_WIN), 2560, nullptr, scr, r, lane); continue; } r -= I_IN2;
            p0_transpose_item(P.xattn_wkv, 1024, 2048, 0, 64, (bf16*)(ws + WS_WKV), 0, nullptr, scr, r, lane);
        }
    }
    {
        bf16* WT = (bf16*)(ws + WS_LRUWT);
        for (int it = vcu * NWAVES * 64 + tid; it < 8 * 2 * 64 * 8; it += G * NWAVES * 64) {
            const int i8 = it & 7, j = (it >> 3) & 63, m = (it >> 9) & 1, g = it >> 10;
            const float* src = (m ? P.lru_wx : P.lru_wa) + (size_t)(g * 64 + 8 * i8) * 64 + j;
            v4u o; o.x = pk2(src[0], src[64]); o.y = pk2(src[128], src[192]); o.z = pk2(src[256], src[320]); o.w = pk2(src[384], src[448]);
            *(v4u*)(WT + (size_t)it * 8) = o;
        }
    }
}

__device__ __forceinline__ void late_weight_prep(const Params& P, LAS unsigned char* lds, int lane, int wave, int gw, int NGW) {
    unsigned char* ws = P.ws;
    {
        LAS float* scr = (LAS float*)(lds + wave * 16384);
        constexpr int I_OUT = 16 * 32, I_Q = 16 * 32, I_O = 16 * 32;
        for (int it = gw; it < I_OUT + I_Q + I_O; it += NGW) {
            int r = it;
            if (r < I_OUT) { p0_transpose_item(P.w_out, 1024, 1024, 0, 32, (bf16*)(ws + WS_WOUT), 0, nullptr, scr, r, lane); continue; } r -= I_OUT;
            if (r < I_Q) { p0_transpose_item(P.xattn_wq, 1024, 1024, 0, 32, (bf16*)(ws + WS_WQ), 0, P.norm_xattn_w, scr, r, lane); continue; } r -= I_Q;
            p0_transpose_item(P.xattn_wo, 1024, 1024, 0, 32, (bf16*)(ws + WS_WO), 0, nullptr, scr, r, lane);
        }
    }
    {
        bf16* WF = (bf16*)(ws + WS_PWQ);
        const int col = lane & 15, g = lane >> 4;
        for (int it = gw; it < 16 * 64; it += NGW) {
            const int hp = it >> 6, k0 = (it & 63) * 16;
            bf16x8 bq[4];
#pragma unroll
            for (int s = 0; s < 4; ++s) { const f32x4* src = (const f32x4*)(P.peer_wq + (size_t)(k0 + col) * 2048 + hp * 128 + 32 * s + 8 * g);
                const f32x4 a = src[0], c = src[1]; v4u pk; pk.x = pk2(a.x, a.y); pk.y = pk2(a.z, a.w); pk.z = pk2(c.x, c.y); pk.w = pk2(c.z, c.w); bq[s] = __builtin_bit_cast(bf16x8, pk); }
            const float nw = P.norm_ffn_w[k0 + col];
#pragma unroll 2
            for (int kt = 0; kt < 8; ++kt) {
                f32x4 acc = (f32x4){0.f, 0.f, 0.f, 0.f};
#pragma unroll
                for (int s = 0; s < 4; ++s) { const f32x4* src = (const f32x4*)(P.peer_subkeys + (size_t)(hp * 128 + 16 * kt + col) * 128 + 32 * s + 8 * g);
                    const f32x4 a = src[0], c = src[1]; v4u pk; pk.x = pk2(a.x, a.y); pk.y = pk2(a.z, a.w); pk.z = pk2(c.x, c.y); pk.w = pk2(c.z, c.w);
                    acc = __builtin_amdgcn_mfma_f32_16x16x32_bf16(__builtin_bit_cast(bf16x8, pk), bq[s], acc, 0, 0, 0); }
#pragma unroll
                for (int i = 0; i < 4; ++i) WF[(size_t)(hp * 128 + 16 * kt + 4 * g + i) * 1024 + k0 + col] = (bf16)f2bf(acc[i] * nw);
            }
        }
    }
}

constexpr int GL_KS = 0, GL_VS = 33792, GL_KB = 67584, GL_QB = 84992, GL_RAW = 102400, GL_CW = 153856, GL_AMT = 133120, GL_SM = 160000, GL_ATT = 151808, GL_SOL = 67584;
static_assert(GL_CW + 6144 <= GL_SM && GL_SM + 1280 <= MISC_OFF && GL_SOL + 65536 <= GL_AMT && GL_AMT + 17408 <= GL_ATT && GL_ATT + 8192 <= GL_SM && GL_RAW + 51456 <= GL_CW, "gdn_local LDS map");
#ifndef GL_REP_STEP
#define GL_REP_STEP -1
#endif
#define GL_REPF(k) for (int rr_ = 0; rr_ < ((GL_REP_STEP == (k)) ? 2 : 1); ++rr_)
#define GL_BAR() do { asm volatile("s_waitcnt lgkmcnt(0)" ::: "memory"); __builtin_amdgcn_s_barrier(); asm volatile("" ::: "memory"); } while (0)
__device__ __forceinline__ void gdn_local_item(const Params& P, LAS unsigned char* lds, int item, int tid) {
    unsigned char* ws = P.ws;
    asm volatile("" : "+v"(tid));
    const int b = item >> 9, h = (item >> 7) & 3, n = item & 127;
    const int t0 = b * SEQ + n * 64;
    const int lane = tid & 63, wave = __builtin_amdgcn_readfirstlane(tid >> 6);
    LAS float* ks = (LAS float*)(lds + GL_KS);
    LAS float* vs = (LAS float*)(lds + GL_VS);
    LAS bf16* kb16 = (LAS bf16*)(lds + GL_KB);
    LAS bf16* qb16 = (LAS bf16*)(lds + GL_QB);
    LAS bf16* raw = (LAS bf16*)(lds + GL_RAW);
    LAS float* cw = (LAS float*)(lds + GL_CW);
    LAS float* AmT = (LAS float*)(lds + GL_AMT);
    LAS float* sg = (LAS float*)(lds + GL_SM);
    LAS float* sbeta = sg + 64; LAS float* sgc = sbeta + 64; LAS float* seg = sgc + 64; LAS float* sek = seg + 64;
    LAS bf16* atts = (LAS bf16*)(lds + GL_ATT);
    const bf16* QKV = (const bf16*)(ws + WS_QKV);
    const float* AB = (const float*)(ws + WS_AB);
    GL_REPF(0) {
        v4u pr[7];
#pragma unroll
        for (int r = 0; r < 7; ++r) {
            const int id = tid + 512 * r;
            const int row = id / 48, rem = id - row * 48, part = rem >> 4, ck = rem & 15, s = n * 64 + row - 3;
            pr[r] = (v4u){0u, 0u, 0u, 0u};
            if (id < 67 * 48 && s >= 0) pr[r] = *(const v4u*)(QKV + (size_t)(b * SEQ + s) * 1536 + part * 512 + h * 128 + ck * 8);
        }
        f32x4 cwv = (f32x4){0.f, 0.f, 0.f, 0.f};
        if (tid < 384) { const int j = tid / 96, rem = tid - j * 96, part = rem >> 5, c4 = rem & 31; cwv = *(const f32x4*)(P.conv_qkv_w + j * 1536 + part * 512 + h * 128 + c4 * 4); }
        float a_in = 0.f, b_in = 0.f;
        if (tid < 64) { a_in = AB[(size_t)(t0 + tid) * 8 + h]; b_in = AB[(size_t)(t0 + tid) * 8 + 4 + h]; }
#pragma unroll
        for (int r = 0; r < 7; ++r) { const int id = tid + 512 * r; if (id < 67 * 48) *(LAS v4u*)(raw + id * 8) = pr[r]; }
        if (tid < 384) *(LAS f32x4*)(cw + tid * 4) = cwv;
        if (tid < 64) { sg[tid] = -__expf(P.gdn_a_log[h]) * softplusf_(a_in + P.gdn_dt_bias[h]); sbeta[tid] = sigmoidf_(b_in); }
    }
    GL_BAR();
    GL_REPF(1) {
        const int c = tid >> 3, grp = tid & 7;
#pragma unroll 1
        for (int part = 0; part < 3; ++part) {
            float y[16];
#pragma unroll
            for (int i = 0; i < 16; ++i) y[i] = 0.f;
#pragma unroll
            for (int j = 0; j < 4; ++j) {
                const LAS v4u* src = (const LAS v4u*)(raw + (c + j) * 384 + part * 128 + grp * 16);
                const v4u x0 = src[0], x1 = src[1];
                const LAS f32x4* wp = (const LAS f32x4*)(cw + (j * 3 + part) * 128 + grp * 16);
                const f32x4 w0 = wp[0], w1 = wp[1], w2 = wp[2], w3 = wp[3];
                y[0] += w0.x * bflo(x0.x); y[1] += w0.y * bfhi(x0.x); y[2] += w0.z * bflo(x0.y); y[3] += w0.w * bfhi(x0.y);
                y[4] += w1.x * bflo(x0.z); y[5] += w1.y * bfhi(x0.z); y[6] += w1.z * bflo(x0.w); y[7] += w1.w * bfhi(x0.w);
                y[8] += w2.x * bflo(x1.x); y[9] += w2.y * bfhi(x1.x); y[10] += w2.z * bflo(x1.y); y[11] += w2.w * bfhi(x1.y);
                y[12] += w3.x * bflo(x1.z); y[13] += w3.y * bfhi(x1.z); y[14] += w3.z * bflo(x1.w); y[15] += w3.w * bfhi(x1.w);
            }
            float ss = 0.f;
#pragma unroll
            for (int i = 0; i < 16; ++i) { y[i] = siluf_(y[i]); ss += y[i] * y[i]; }
            if (part < 2) {
                ss += __shfl_xor(ss, 1); ss += __shfl_xor(ss, 2); ss += __shfl_xor(ss, 4);
                const float sc = rsqrtf(ss + 1e-6f) * (part == 0 ? 0.08838834764831845f : 1.0f);
#pragma unroll
                for (int i = 0; i < 16; ++i) y[i] *= sc;
            }
            if (part >= 1) {
                LAS float* dst = (part == 1 ? ks : vs) + c * 132 + grp * 16;
#pragma unroll
                for (int i = 0; i < 4; ++i) *(LAS f32x4*)(dst + 4 * i) = (f32x4){y[4 * i], y[4 * i + 1], y[4 * i + 2], y[4 * i + 3]};
            }
            if (part <= 1) {
                LAS bf16* dst = (part == 0 ? qb16 : kb16) + c * 136 + grp * 16;
                v4u o0, o1; o0.x = pk2(y[0], y[1]); o0.y = pk2(y[2], y[3]); o0.z = pk2(y[4], y[5]); o0.w = pk2(y[6], y[7]);
                o1.x = pk2(y[8], y[9]); o1.y = pk2(y[10], y[11]); o1.z = pk2(y[12], y[13]); o1.w = pk2(y[14], y[15]);
                *(LAS v4u*)dst = o0; *(LAS v4u*)(dst + 8) = o1;
            }
        }
    }
    if (tid < 64) {
        float v = sg[tid];
#pragma unroll
        for (int off = 1; off < 64; off <<= 1) { const float t = __shfl_up(v, off); if (tid >= off) v += t; }
        sgc[tid] = v; seg[tid] = __expf(v);
        const float gl = __shfl(v, 63);
        sek[tid] = __expf(gl - v);
        if (tid == 63) ((float*)(ws + WS_DEC))[item] = __expf(v);
    }
    GL_BAR();
    {
        const int mat = wave >> 2, rho = wave & 3, col = lane & 15, g = lane >> 4;
        const LAS bf16* X = mat ? qb16 : kb16;
        bf16x8 af[4];
#pragma unroll
        for (int s = 0; s < 4; ++s) af[s] = *(const LAS bf16x8*)(X + (16 * rho + col) * 136 + 32 * s + 8 * g);
#pragma unroll
        for (int sig = 0; sig < 4; ++sig) {
            f32x4 acc = (f32x4){0.f, 0.f, 0.f, 0.f};
#pragma unroll
            for (int s = 0; s < 4; ++s) { const bf16x8 bfr = *(const LAS bf16x8*)(kb16 + (16 * sig + col) * 136 + 32 * s + 8 * g); acc = __builtin_amdgcn_mfma_f32_16x16x32_bf16(af[s], bfr, acc, 0, 0, 0); }
            const int sidx = 16 * sig + col; const float gs = sgc[sidx];
#pragma unroll
            for (int i = 0; i < 4; ++i) {
                const int c = 16 * rho + 4 * g + i;
                const float dec = (c >= sidx) ? __expf(sgc[c] - gs) : 0.f;
                if (mat == 0) AmT[sidx * 68 + c] = (c > sidx) ? sbeta[c] * acc[i] * dec : 0.f;
                else atts[c * 64 + sidx] = (bf16)f2bf(acc[i] * dec);
            }
        }
    }
    GL_BAR();
    GL_REPF(4) {
        bf16* QD = (bf16*)(ws + WS_QD) + (size_t)item * 8192;
        bf16* KD = (bf16*)(ws + WS_KD) + (size_t)item * 8192;
        bf16* ATT = (bf16*)(ws + WS_ATT) + (size_t)item * 4096;
#pragma unroll
        for (int r = 0; r < 2; ++r) {
            const int id = tid + 512 * r;
            { const int c = id >> 4, gam = id & 15, s32 = gam >> 2, g = gam & 3;
              const v2u lo = *(const LAS v2u*)(qb16 + c * 136 + 32 * s32 + 4 * g), hi = *(const LAS v2u*)(qb16 + c * 136 + 32 * s32 + 16 + 4 * g);
              const float e = seg[c];
              v4u o; o.x = pk2(bflo(lo.x) * e, bfhi(lo.x) * e); o.y = pk2(bflo(lo.y) * e, bfhi(lo.y) * e); o.z = pk2(bflo(hi.x) * e, bfhi(hi.x) * e); o.w = pk2(bflo(hi.y) * e, bfhi(hi.y) * e);
              *(v4u*)(QD + c * 128 + 8 * gam) = o; }
            { const int dk = id >> 3, gam = id & 7, s32 = gam >> 2, g = gam & 3, c0 = 32 * s32 + 4 * g;
              float v[8];
#pragma unroll
              for (int j = 0; j < 4; ++j) { v[j] = ks[(c0 + j) * 132 + dk] * sek[c0 + j]; v[4 + j] = ks[(c0 + 16 + j) * 132 + dk] * sek[c0 + 16 + j]; }
              v4u o; o.x = pk2(v[0], v[1]); o.y = pk2(v[2], v[3]); o.z = pk2(v[4], v[5]); o.w = pk2(v[6], v[7]);
              *(v4u*)(KD + dk * 64 + 8 * gam) = o; }
        }
        { const int c = tid >> 3, gam = tid & 7, s32 = gam >> 2, g = gam & 3;
          const v2u lo = *(const LAS v2u*)(atts + c * 64 + 32 * s32 + 4 * g), hi = *(const LAS v2u*)(atts + c * 64 + 32 * s32 + 16 + 4 * g);
          v4u o; o.x = lo.x; o.y = lo.y; o.z = hi.x; o.w = hi.y;
          *(v4u*)(ATT + c * 64 + 8 * gam) = o; }
    }
    GL_BAR();
    GL_REPF(5) {
        LAS float* xcol = (LAS float*)(lds + GL_SOL);
        LAS bf16* tinv = (LAS bf16*)(lds + GL_SOL + 17408);
        const int j = tid >> 3, part = tid & 7, jb = j >> 4, jo = j & 15;
#pragma unroll 1
        for (int rb = jb; rb < 4; ++rb) {
            float acc[16];
#pragma unroll
            for (int i = 0; i < 16; ++i) acc[i] = 0.f;
            if (rb > jb) {
#pragma unroll 2
                for (int s = 16 * jb + part; s < 16 * rb; s += 8) {
                    const float sv = xcol[j * 68 + s];
                    const LAS float* ar = AmT + s * 68 + 16 * rb;
#pragma unroll
                    for (int q = 0; q < 4; ++q) { const f32x4 A4 = *(const LAS f32x4*)(ar + 4 * q);
                        acc[4 * q] -= A4.x * sv; acc[4 * q + 1] -= A4.y * sv; acc[4 * q + 2] -= A4.z * sv; acc[4 * q + 3] -= A4.w * sv; }
                }
#pragma unroll
                for (int i = 0; i < 16; ++i) {
                    acc[i] += __builtin_bit_cast(float, __builtin_amdgcn_update_dpp(0, __builtin_bit_cast(int, acc[i]), 0xB1, 0xF, 0xF, true));
                    acc[i] += __builtin_bit_cast(float, __builtin_amdgcn_update_dpp(0, __builtin_bit_cast(int, acc[i]), 0x4E, 0xF, 0xF, true));
                    acc[i] += __builtin_bit_cast(float, __builtin_amdgcn_update_dpp(0, __builtin_bit_cast(int, acc[i]), 0x141, 0xF, 0xF, true));
                }
            } else {
#pragma unroll
                for (int i = 0; i < 16; ++i) acc[i] = (i == jo) ? 1.f : 0.f;
            }
#pragma unroll
            for (int i = 0; i < 16; ++i) {
                const float sv = acc[i];
                const LAS float* ar = AmT + (16 * rb + i) * 68 + 16 * rb;
#pragma unroll
                for (int q = (i + 1) / 4; q < 4; ++q) { const f32x4 A4 = *(const LAS f32x4*)(ar + 4 * q);
                    if (4 * q > i) acc[4 * q] -= A4.x * sv; if (4 * q + 1 > i) acc[4 * q + 1] -= A4.y * sv; if (4 * q + 2 > i) acc[4 * q + 2] -= A4.z * sv; if (4 * q + 3 > i) acc[4 * q + 3] -= A4.w * sv; }
            }
            if (part == 0) {
#pragma unroll
                for (int i = 0; i < 16; ++i) { xcol[j * 68 + 16 * rb + i] = acc[i]; tinv[(16 * rb + i) * 72 + j] = (bf16)f2bf(acc[i]); }
            }
            LDS_WAIT(); asm volatile("" ::: "memory");
        }
        for (int rb = 0; rb < jb; ++rb) {
            if (part == 0) {
#pragma unroll
                for (int i = 0; i < 16; ++i) tinv[(16 * rb + i) * 72 + j] = (bf16)0;
            }
        }
    }
    GL_BAR();
    GL_REPF(6) {
        const LAS bf16* tinv = (const LAS bf16*)(lds + GL_SOL + 17408);
        LAS bf16* wst = (LAS bf16*)(lds + GL_SOL + 17408 + 9216);
        const int col = lane & 15, g = lane >> 4, isw = wave >> 2;
        bf16x8 af[4][2];
#pragma unroll
        for (int rho = 0; rho < 4; ++rho)
#pragma unroll
            for (int s2 = 0; s2 < 2; ++s2) af[rho][s2] = *(const LAS bf16x8*)(tinv + (16 * rho + col) * 72 + 32 * s2 + 8 * g);
        bf16* UF = (bf16*)(ws + WS_UF) + (size_t)item * 8192;
#pragma unroll
        for (int sig = 0; sig < 2; ++sig) {
            const int jj = 32 * (wave & 3) + 16 * sig + col;
            const LAS float* src = (isw ? ks : vs) + jj;
            bf16x8 bfr[2];
#pragma unroll
            for (int s2 = 0; s2 < 2; ++s2) {
                float v[8];
#pragma unroll
                for (int e = 0; e < 8; ++e) { const int sidx = 32 * s2 + 8 * g + e; float x = src[sidx * 132] * sbeta[sidx]; if (isw) x *= seg[sidx]; v[e] = x; }
                v4u pk; pk.x = pk2(v[0], v[1]); pk.y = pk2(v[2], v[3]); pk.z = pk2(v[4], v[5]); pk.w = pk2(v[6], v[7]);
                bfr[s2] = __builtin_bit_cast(bf16x8, pk);
            }
            f32x4 acc[4];
#pragma unroll
            for (int rho = 0; rho < 4; ++rho) { acc[rho] = (f32x4){0.f, 0.f, 0.f, 0.f};
#pragma unroll
                for (int s2 = 0; s2 < 2; ++s2) acc[rho] = __builtin_amdgcn_mfma_f32_16x16x32_bf16(af[rho][s2], bfr[s2], acc[rho], 0, 0, 0); }
            if (!isw) {
                v4u o0, o1;
                o0.x = pk2(acc[0].x, acc[0].y); o0.y = pk2(acc[0].z, acc[0].w); o0.z = pk2(acc[1].x, acc[1].y); o0.w = pk2(acc[1].z, acc[1].w);
                o1.x = pk2(acc[2].x, acc[2].y); o1.y = pk2(acc[2].z, acc[2].w); o1.z = pk2(acc[3].x, acc[3].y); o1.w = pk2(acc[3].z, acc[3].w);
                v4u* d = (v4u*)(UF + (size_t)(2 * (wave & 3) + sig) * 1024 + lane * 16);
                d[0] = o0; d[1] = o1;
            } else {
#pragma unroll
                for (int rho = 0; rho < 4; ++rho)
#pragma unroll
                    for (int i = 0; i < 4; ++i) wst[(16 * rho + 4 * g + i) * 136 + jj] = (bf16)f2bf(-acc[rho][i]);
            }
        }
    }
    GL_BAR();
    {
        const LAS bf16* wst = (const LAS bf16*)(lds + GL_SOL + 17408 + 9216);
        bf16* WN = (bf16*)(ws + WS_WN) + (size_t)item * 8192;
#pragma unroll
        for (int r = 0; r < 2; ++r) {
            const int id = tid + 512 * r, c = id >> 4, gam = id & 15, s32 = gam >> 2, g = gam & 3;
            const v2u lo = *(const LAS v2u*)(wst + c * 136 + 32 * s32 + 4 * g), hi = *(const LAS v2u*)(wst + c * 136 + 32 * s32 + 16 + 4 * g);
            v4u o; o.x = lo.x; o.y = lo.y; o.z = hi.x; o.w = hi.y;
            *(v4u*)(WN + c * 128 + 8 * gam) = o;
        }
    }
    GL_BAR();
}

constexpr int LL_XCB = 68608;
static_assert(LL_XCB + 64 * 1040 <= MISC_OFF, "lru_local LDS map");
__device__ __forceinline__ float expm1_small(float x) {
    const float p = x * (1.0f + x * (0.5f + x * (0.16666667f + x * (0.041666668f + x * 0.008333334f))));
    return (x > -0.25f) ? p : (__expf(x) - 1.0f);
}
__device__ __forceinline__ void lru_local_item(const Params& P, LAS unsigned char* lds, int lt, int tid, int lane, int wave) {
    unsigned char* ws = P.ws;
    asm volatile("" : "+v"(tid));
    const int b = lt >> 7, n = lt & 127, t0 = b * SEQ + n * 64;
    LAS bf16* rawx = (LAS bf16*)lds;
    LAS bf16* xcb = (LAS bf16*)(lds + LL_XCB);
    const bf16* XR = (const bf16*)(ws + WS_XR);
    {
        v4u pr[9];
#pragma unroll
        for (int r = 0; r < 9; ++r) { const int id = tid + 512 * r, row = id >> 6, ck = id & 63, s = n * 64 + row - 3;
            pr[r] = (v4u){0u, 0u, 0u, 0u};
            if (id < 67 * 64 && s >= 0) pr[r] = *(const v4u*)(XR + (size_t)(b * SEQ + s) * 512 + ck * 8); }
#pragma unroll
        for (int r = 0; r < 9; ++r) { const int id = tid + 512 * r; if (id < 67 * 64) *(LAS v4u*)(rawx + id * 8) = pr[r]; }
    }
    GL_BAR();
    {
        const int chg = tid & 63, tseg = tid >> 6, ch0 = chg * 8;
        float w[4][8], cb[8];
#pragma unroll
        for (int j = 0; j < 4; ++j) { const f32x4 a = *(const f32x4*)(P.lru_conv_w + j * 512 + ch0), c = *(const f32x4*)(P.lru_conv_w + j * 512 + ch0 + 4);
            w[j][0] = a.x; w[j][1] = a.y; w[j][2] = a.z; w[j][3] = a.w; w[j][4] = c.x; w[j][5] = c.y; w[j][6] = c.z; w[j][7] = c.w; }
        { const f32x4 a = *(const f32x4*)(P.lru_conv_b + ch0), c = *(const f32x4*)(P.lru_conv_b + ch0 + 4);
          cb[0] = a.x; cb[1] = a.y; cb[2] = a.z; cb[3] = a.w; cb[4] = c.x; cb[5] = c.y; cb[6] = c.z; cb[7] = c.w; }
        v4u xr[11];
#pragma unroll
        for (int r = 0; r < 11; ++r) xr[r] = *(const LAS v4u*)(rawx + (tseg * 8 + r) * 512 + ch0);
#pragma unroll
        for (int tk = 0; tk < 8; ++tk) {
            float y[8];
#pragma unroll
            for (int e = 0; e < 8; ++e) y[e] = cb[e];
#pragma unroll
            for (int j = 0; j < 4; ++j) { const v4u x = xr[tk + j];
                y[0] += w[j][0] * bflo(x.x); y[1] += w[j][1] * bfhi(x.x); y[2] += w[j][2] * bflo(x.y); y[3] += w[j][3] * bfhi(x.y);
                y[4] += w[j][4] * bflo(x.z); y[5] += w[j][5] * bfhi(x.z); y[6] += w[j][6] * bflo(x.w); y[7] += w[j][7] * bfhi(x.w); }
            v4u o; o.x = pk2(y[0], y[1]); o.y = pk2(y[2], y[3]); o.z = pk2(y[4], y[5]); o.w = pk2(y[6], y[7]);
            *(LAS v4u*)(xcb + (tseg * 8 + tk) * 520 + ch0) = o;
        }
    }
    GL_BAR();
    {
        const int g = wave, col = lane & 15, g4 = lane >> 4;
        LAS bf16* AM = (LAS bf16*)(lds + wave * 8192); LAS bf16* BT = AM + 2048;
        const bf16* WT = (const bf16*)(ws + WS_LRUWT) + (size_t)g * 8192;
        bf16x8 Bw[2][4][2];
#pragma unroll
        for (int m = 0; m < 2; ++m)
#pragma unroll
            for (int jt = 0; jt < 4; ++jt)
#pragma unroll
                for (int s2 = 0; s2 < 2; ++s2) Bw[m][jt][s2] = *(const bf16x8*)(WT + m * 4096 + (16 * jt + col) * 64 + 32 * s2 + 8 * g4);
        float cba[4], cbx[4], csp[4];
#pragma unroll
        for (int jt = 0; jt < 4; ++jt) { const int ch = g * 64 + 16 * jt + col; cba[jt] = P.lru_ba[ch]; cbx[jt] = P.lru_bx[ch]; csp[jt] = softplusf_(-P.lru_lambda[ch]); }
        bf16* HLOC = (bf16*)(ws + WS_HLOC); bf16* PCUM = (bf16*)(ws + WS_PCUM);
        const int chs = g * 64 + lane;
        float hst = 0.f, pc = 1.f;
#pragma unroll 1
        for (int half = 0; half < 2; ++half) {
            bf16x8 Af[2][2];
#pragma unroll
            for (int rho = 0; rho < 2; ++rho)
#pragma unroll
                for (int s2 = 0; s2 < 2; ++s2) Af[rho][s2] = *(const LAS bf16x8*)(xcb + (32 * half + 16 * rho + col) * 520 + g * 64 + 32 * s2 + 8 * g4);
#pragma unroll
            for (int jt = 0; jt < 4; ++jt) {
#pragma unroll
                for (int rho = 0; rho < 2; ++rho) {
                    f32x4 ra = (f32x4){0.f, 0.f, 0.f, 0.f}, rx = ra;
#pragma unroll
                    for (int s2 = 0; s2 < 2; ++s2) { ra = __builtin_amdgcn_mfma_f32_16x16x32_bf16(Af[rho][s2], Bw[0][jt][s2], ra, 0, 0, 0); rx = __builtin_amdgcn_mfma_f32_16x16x32_bf16(Af[rho][s2], Bw[1][jt][s2], rx, 0, 0, 0); }
#pragma unroll
                    for (int i = 0; i < 4; ++i) {
                        const int tokl = 16 * rho + 4 * g4 + i, chl = 16 * jt + col;
                        const float r = sigmoidf_(ra[i] + cba[jt]), ig = sigmoidf_(rx[i] + cbx[jt]);
                        const float log_a = -8.0f * r * csp[jt];
                        const float am = -expm1_small(log_a), a = 1.0f - am;
                        const float xo = bf1(xcb[(32 * half + tokl) * 520 + g * 64 + chl]);
                        const float bt = __builtin_amdgcn_sqrtf(fmaxf(am * (1.0f + a), 0.f)) * (ig * xo);
                        AM[tokl * 64 + chl] = (bf16)f2bf(am); BT[tokl * 64 + chl] = (bf16)f2bf(bt);
                    }
                }
            }
            LDS_WAIT(); asm volatile("" ::: "memory");
#pragma unroll 8
            for (int tk = 0; tk < 32; ++tk) {
                const float am = bf1(AM[tk * 64 + lane]), bt = bf1(BT[tk * 64 + lane]);
                hst = (hst - am * hst) + bt; pc = pc - am * pc;
                const size_t o = (size_t)(t0 + 32 * half + tk) * 512 + chs;
                HLOC[o] = (bf16)f2bf(hst); PCUM[o] = (bf16)f2bf(pc);
            }
            LDS_WAIT(); asm volatile("" ::: "memory");
        }
        ((float*)(ws + WS_HEND))[(size_t)lt * 512 + chs] = hst; ((float*)(ws + WS_PEND))[(size_t)lt * 512 + chs] = pc;
    }
    GL_BAR();
}

constexpr int SC_WN = 0, SC_QD = 64 * 272, SC_KD = 2 * 64 * 272, SC_ATT = 2 * 64 * 272 + 128 * 144, SC_BUF = 2 * 64 * 272 + 128 * 144 + 64 * 144;
constexpr int SC_SSQ = 2 * SC_BUF;
__device__ __forceinline__ int sc_lds_off(int id) {
    if (id < 1024) return SC_WN + (id >> 4) * 272 + (id & 15) * 16;
    if (id < 2048) { const int q = id - 1024; return SC_QD + (q >> 4) * 272 + (q & 15) * 16; }
    if (id < 3072) { const int q = id - 2048; return SC_KD + (q >> 3) * 144 + (q & 7) * 16; }
    const int q = id - 3072; return SC_ATT + (q >> 3) * 144 + (q & 7) * 16;
}
__device__ __forceinline__ const v4u* sc_src(const unsigned char* ws, int item, int id) {
    if (id < 1024) return (const v4u*)(ws + WS_WN + (size_t)item * 16384) + id;
    if (id < 2048) return (const v4u*)(ws + WS_QD + (size_t)item * 16384) + (id - 1024);
    if (id < 3072) return (const v4u*)(ws + WS_KD + (size_t)item * 16384) + (id - 2048);
    return (const v4u*)(ws + WS_ATT + (size_t)item * 8192) + (id - 3072);
}
__device__ __forceinline__ bf16x8 pack_b(const f32x4 a, const f32x4 b) {
    v4u r; r.x = pk2(a.x, a.y); r.y = pk2(a.z, a.w); r.z = pk2(b.x, b.y); r.w = pk2(b.z, b.w);
    return __builtin_bit_cast(bf16x8, r);
}
#define SC_BAR() do { asm volatile("s_waitcnt lgkmcnt(0)" ::: "memory"); __builtin_amdgcn_s_barrier(); asm volatile("" ::: "memory"); } while (0)
#define SC_GLD(dst, ptr) asm volatile("global_load_dwordx4 %0, %1, off" : "=v"(dst) : "v"(ptr) : "memory")
#define PIN8(a) asm volatile("" : "+v"(a[0]), "+v"(a[1]), "+v"(a[2]), "+v"(a[3]), "+v"(a[4]), "+v"(a[5]), "+v"(a[6]), "+v"(a[7]))
#define PIN16(a) asm volatile("" : "+v"(a[0]), "+v"(a[1]), "+v"(a[2]), "+v"(a[3]), "+v"(a[4]), "+v"(a[5]), "+v"(a[6]), "+v"(a[7]), "+v"(a[8]), "+v"(a[9]), "+v"(a[10]), "+v"(a[11]), "+v"(a[12]), "+v"(a[13]), "+v"(a[14]), "+v"(a[15]))
constexpr int SCAN_NWC = 2, SCAN_PARTS = 4, SCAN_WGS = 8 * SCAN_PARTS;
constexpr int SC_UFS = 2 * SC_BUF;
constexpr int SC_DECS = SC_UFS + 2 * SCAN_NWC * 2048;
constexpr int SC_OT = SC_DECS + 512;
constexpr int SC_END = SC_OT + 2 * 64 * 36 * 4;
static_assert(SC_END <= MISC_OFF, "scan LDS");
#ifndef SCAN_REPS
#define SCAN_REPS 1
#endif
#ifndef SCAN_EXP
#define SCAN_EXP 0
#endif
__device__ __forceinline__ int sc3_lds_off(int id) {
    if (id < 3584) return sc_lds_off(id);
    return SC_UFS + (id - 3584) * 16;
}
__device__ __forceinline__ const v4u* sc3_src(const unsigned char* ws, int item, int id, int part) {
    if (id < 3584) return sc_src(ws, item, id);
    return (const v4u*)(ws + WS_UF + (size_t)item * 16384 + (size_t)(part * SCAN_NWC) * 2048) + (id - 3584);
}
__device__ __forceinline__ void gdn_scan(const Params& P, LAS unsigned char* lds, int sb, int tid, int lane, int wave) {
    const unsigned char* ws = P.ws;
    constexpr int NCH = 128 * SCAN_REPS, NPC = 15;
    const int bh = sb & 7, part = sb >> 3;
    const int b = bh >> 2, h = bh & 3, col = lane & 15, g = lane >> 4;
    const int item0 = bh * 128;
    const float* DEC = (const float*)(ws + WS_DEC);
    if (wave >= 4) {
        constexpr int NP = 15, DEP = 3;
        const int lt = tid - 256;
        const unsigned voff = (unsigned)lt * 16u;
        const int lA = (lt >> 4) * 272 + (lt & 15) * 16, lB = (lt >> 3) * 144 + (lt & 7) * 16, lU = SC_UFS + lt * 16;
        v4u rs[DEP][NP];
#define SC_ISSUE(set, itm) do { const unsigned char* gq_ = ws + (size_t)(itm) * 16384; const unsigned char* ga_ = ws + WS_ATT + (size_t)(itm) * 8192; \
            asm volatile("s_nop 4\n\tglobal_load_dwordx4 %0, %8, %9\n\tglobal_load_dwordx4 %1, %8, %10\n\tglobal_load_dwordx4 %2, %8, %11\n\tglobal_load_dwordx4 %3, %8, %12\n\t" \
                         "global_load_dwordx4 %4, %8, %13\n\tglobal_load_dwordx4 %5, %8, %14\n\tglobal_load_dwordx4 %6, %8, %15\n\tglobal_load_dwordx4 %7, %8, %16" \
                : "=&v"(rs[set][0]), "=&v"(rs[set][1]), "=&v"(rs[set][2]), "=&v"(rs[set][3]), "=&v"(rs[set][4]), "=&v"(rs[set][5]), "=&v"(rs[set][6]), "=&v"(rs[set][7]) \
                : "v"(voff), "s"(gq_ + WS_WN), "s"(gq_ + WS_WN + 4096), "s"(gq_ + WS_WN + 8192), "s"(gq_ + WS_WN + 12288), \
                  "s"(gq_ + WS_QD), "s"(gq_ + WS_QD + 4096), "s"(gq_ + WS_QD + 8192), "s"(gq_ + WS_QD + 12288) : "memory"); \
            asm volatile("s_nop 4\n\tglobal_load_dwordx4 %0, %7, %8\n\tglobal_load_dwordx4 %1, %7, %9\n\tglobal_load_dwordx4 %2, %7, %10\n\tglobal_load_dwordx4 %3, %7, %11\n\t" \
                         "global_load_dwordx4 %4, %7, %12\n\tglobal_load_dwordx4 %5, %7, %13\n\tglobal_load_dwordx4 %6, %7, %14" \
                : "=&v"(rs[set][8]), "=&v"(rs[set][9]), "=&v"(rs[set][10]), "=&v"(rs[set][11]), "=&v"(rs[set][12]), "=&v"(rs[set][13]), "=&v"(rs[set][14]) \
                : "v"(voff), "s"(gq_ + WS_KD), "s"(gq_ + WS_KD + 4096), "s"(gq_ + WS_KD + 8192), "s"(gq_ + WS_KD + 12288), \
                  "s"(ga_), "s"(ga_ + 4096), "s"(gq_ + WS_UF + (size_t)(part * SCAN_NWC) * 2048) : "memory"); } while (0)
#define SC_WAITSET(set, cnt) asm volatile("s_waitcnt " cnt : "+v"(rs[set][0]), "+v"(rs[set][1]), "+v"(rs[set][2]), "+v"(rs[set][3]), "+v"(rs[set][4]), "+v"(rs[set][5]), "+v"(rs[set][6]), "+v"(rs[set][7]), \
            "+v"(rs[set][8]), "+v"(rs[set][9]), "+v"(rs[set][10]), "+v"(rs[set][11]), "+v"(rs[set][12]), "+v"(rs[set][13]), "+v"(rs[set][14]) :: "memory")
#define SC_WRITE(set, par) do { LAS unsigned char* wb_ = lds + (par) * SC_BUF; \
            _Pragma("unroll") for (int r = 0; r < 4; ++r) { *(LAS v4u*)(wb_ + SC_WN + lA + r * (16 * 272)) = rs[set][r]; *(LAS v4u*)(wb_ + SC_QD + lA + r * (16 * 272)) = rs[set][4 + r]; \
                                                          *(LAS v4u*)(wb_ + SC_KD + lB + r * (32 * 144)) = rs[set][8 + r]; } \
            *(LAS v4u*)(wb_ + SC_ATT + lB) = rs[set][12]; *(LAS v4u*)(wb_ + SC_ATT + lB + 32 * 144) = rs[set][13]; \
            *(LAS v4u*)(lds + lU + (par) * (SCAN_NWC * 2048)) = rs[set][14]; } while (0)
        {
#pragma unroll
            for (int r = 0; r < NP; ++r) { const int id = lt + 256 * r; *(LAS v4u*)(lds + sc3_lds_off(id)) = *sc3_src(ws, item0, id, part); }
            if (lt < 128) ((LAS float*)(lds + SC_DECS))[lt] = DEC[item0 + lt];
            asm volatile("s_waitcnt vmcnt(0)" ::: "memory");
        }
        SC_ISSUE(1, item0 + 1); SC_ISSUE(2, item0 + 2); SC_ISSUE(0, item0 + 3);
        SC_BAR();
        int n2 = 0;
#define SC_INTERVAL(set) do { SC_WAITSET(set, "vmcnt(30)"); SC_WRITE(set, (n2 + 1) & 1); SC_WAITSET(set, "lgkmcnt(0)"); SC_ISSUE(set, item0 + ((n2 + 1 + DEP) & 127)); SC_BAR(); ++n2; } while (0)
#pragma unroll 1
        for (int it = 0; it < NCH / 3; ++it) { SC_INTERVAL(1); SC_INTERVAL(2); SC_INTERVAL(0); }
        if (NCH % 3 >= 1) SC_INTERVAL(1);
        if (NCH % 3 >= 2) SC_INTERVAL(2);
        SC_WAITSET(0, "vmcnt(0)"); SC_WAITSET(1, "vmcnt(0)"); SC_WAITSET(2, "vmcnt(0)");
#undef SC_INTERVAL
#undef SC_WRITE
#undef SC_WAITSET
#undef SC_ISSUE
        return;
    }
    if (wave == 3) {
        SC_BAR();
#pragma unroll 1
        for (int n2 = 0; n2 < NCH; ++n2) SC_BAR();
        return;
    }
    if (wave == 2) {
        const int row = lane;
        bf16* Y = (bf16*)(P.ws + WS_Y);
        float* SSQG = P.out;
        SC_BAR();
#pragma unroll 1
        for (int n2 = 0; n2 <= NCH; ++n2) {
            if (n2 > 0) {
                const int n = (n2 - 1) & 127, t = b * SEQ + n * 64 + row;
                const LAS float* src = (const LAS float*)(lds + SC_OT + ((n2 - 1) & 1) * (64 * 36 * 4)) + row * 36;
                f32x4 a[8]; float s2 = 0.f;
#pragma unroll
                for (int q = 0; q < 8; ++q) { a[q] = *(const LAS f32x4*)(src + 4 * q); s2 += (a[q].x * a[q].x + a[q].y * a[q].y) + (a[q].z * a[q].z + a[q].w * a[q].w); }
                SSQG[(size_t)t * 32 + h * 8 + part] = s2;
                v4u* d = (v4u*)(Y + (size_t)t * 1024 + h * 128 + 32 * part);
#pragma unroll
                for (int q = 0; q < 4; ++q) { v4u o; o.x = pk2(a[2 * q].x, a[2 * q].y); o.y = pk2(a[2 * q].z, a[2 * q].w); o.z = pk2(a[2 * q + 1].x, a[2 * q + 1].y); o.w = pk2(a[2 * q + 1].z, a[2 * q + 1].w); d[q] = o; }
            }
            if (n2 < NCH) SC_BAR();
        }
        return;
    }
    f32x4 S[8];
#pragma unroll
    for (int i = 0; i < 8; ++i) S[i] = (f32x4){0.f, 0.f, 0.f, 0.f};
    SC_BAR();
#pragma unroll 1
    for (int n2 = 0; n2 < NCH; ++n2) {
        if (SCAN_REPS > 1 && (n2 & 127) == 0) {
#pragma unroll
            for (int i = 0; i < 8; ++i) S[i] = (f32x4){0.f, 0.f, 0.f, 0.f};
        }
        if (SCAN_EXP == 2 && n2 < 128) { SC_BAR(); continue; }
        const int par = n2 & 1;
        LAS unsigned char* buf = lds + par * SC_BUF;
        bf16x8 fA[16], fB[16], fC[16], fD[8];
#pragma unroll
        for (int rho = 0; rho < 4; ++rho)
#pragma unroll
            for (int s = 0; s < 4; ++s) fA[rho * 4 + s] = *(const LAS bf16x8*)(buf + SC_WN + (16 * rho + col) * 272 + (32 * s + 8 * g) * 2);
#pragma unroll
        for (int rho = 0; rho < 4; ++rho)
#pragma unroll
            for (int s = 0; s < 4; ++s) fB[rho * 4 + s] = *(const LAS bf16x8*)(buf + SC_QD + (16 * rho + col) * 272 + (32 * s + 8 * g) * 2);
        const LAS v4u* ufp = (const LAS v4u*)(lds + SC_UFS + par * (SCAN_NWC * 2048) + wave * 2048 + lane * 32);
        const v4u uf0 = ufp[0], uf1 = ufp[1];
        const float dec = ((const LAS float*)(lds + SC_DECS))[n2 & 127];
        bf16x8 Bs[4];
#pragma unroll
        for (int s = 0; s < 4; ++s) Bs[s] = pack_b(S[2 * s], S[2 * s + 1]);
        f32x4 Vn[4], Oc[4];
        Vn[0] = (f32x4){bflo(uf0.x), bfhi(uf0.x), bflo(uf0.y), bfhi(uf0.y)}; Vn[1] = (f32x4){bflo(uf0.z), bfhi(uf0.z), bflo(uf0.w), bfhi(uf0.w)};
        Vn[2] = (f32x4){bflo(uf1.x), bfhi(uf1.x), bflo(uf1.y), bfhi(uf1.y)}; Vn[3] = (f32x4){bflo(uf1.z), bfhi(uf1.z), bflo(uf1.w), bfhi(uf1.w)};
        __builtin_amdgcn_sched_barrier(0);
        PIN16(fA);
#pragma unroll
        for (int s = 0; s < 4; ++s)
#pragma unroll
            for (int rho = 0; rho < 4; ++rho) Vn[rho] = __builtin_amdgcn_mfma_f32_16x16x32_bf16(fA[rho * 4 + s], Bs[s], Vn[rho], 0, 0, 0);
        __builtin_amdgcn_sched_barrier(0);
#pragma unroll
        for (int tau = 0; tau < 8; ++tau)
#pragma unroll
            for (int s = 0; s < 2; ++s) fC[tau * 2 + s] = *(const LAS bf16x8*)(buf + SC_KD + (16 * tau + col) * 144 + (32 * s + 8 * g) * 2);
        __builtin_amdgcn_sched_barrier(0);
        PIN16(fB);
#pragma unroll
        for (int rho = 0; rho < 4; ++rho) Oc[rho] = (f32x4){0.f, 0.f, 0.f, 0.f};
#pragma unroll
        for (int s = 0; s < 4; ++s)
#pragma unroll
            for (int rho = 0; rho < 4; ++rho) Oc[rho] = __builtin_amdgcn_mfma_f32_16x16x32_bf16(fB[rho * 4 + s], Bs[s], Oc[rho], 0, 0, 0);
        __builtin_amdgcn_sched_barrier(0);
#pragma unroll
        for (int rho = 0; rho < 4; ++rho)
#pragma unroll
            for (int s = 0; s < 2; ++s) fD[rho * 2 + s] = *(const LAS bf16x8*)(buf + SC_ATT + (16 * rho + col) * 144 + (32 * s + 8 * g) * 2);
        bf16x8 Bv[2];
        Bv[0] = pack_b(Vn[0], Vn[1]); Bv[1] = pack_b(Vn[2], Vn[3]);
#pragma unroll
        for (int tau = 0; tau < 8; ++tau) S[tau] = S[tau] * dec;
        __builtin_amdgcn_sched_barrier(0);
        PIN16(fC);
#pragma unroll
        for (int s = 0; s < 2; ++s)
#pragma unroll
            for (int tau = 0; tau < 8; ++tau) S[tau] = __builtin_amdgcn_mfma_f32_16x16x32_bf16(fC[tau * 2 + s], Bv[s], S[tau], 0, 0, 0);
        __builtin_amdgcn_sched_barrier(0);
        PIN8(fD);
#pragma unroll
        for (int s = 0; s < 2; ++s)
#pragma unroll
            for (int rho = 0; rho < 4; ++rho) Oc[rho] = __builtin_amdgcn_mfma_f32_16x16x32_bf16(fD[rho * 2 + s], Bv[s], Oc[rho], 0, 0, 0);
        LAS float* ot = (LAS float*)(lds + SC_OT + par * (64 * 36 * 4)) + 16 * wave + col;
#pragma unroll
        for (int rho = 0; rho < 4; ++rho)
#pragma unroll
            for (int i = 0; i < 4; ++i) ot[(16 * rho + 4 * g + i) * 36] = Oc[rho][i];
        SC_BAR();
    }
}

__device__ __forceinline__ void lru_carry(const Params& P, int gwv, int lane) {
    unsigned char* ws = P.ws;
    const int b = gwv >> 3, g = gwv & 7, ch = g * 64 + lane;
    const float* HEND = (const float*)(ws + WS_HEND); const float* PEND = (const float*)(ws + WS_PEND); float* HIN = (float*)(ws + WS_HIN);
    float hin = 0.f;
#pragma unroll 1
    for (int n0 = 0; n0 < 128; n0 += 16) {
        float he[16], pe[16];
#pragma unroll
        for (int i = 0; i < 16; ++i) { const size_t o = (size_t)(b * 128 + n0 + i) * 512 + ch; he[i] = HEND[o]; pe[i] = PEND[o]; }
#pragma unroll
        for (int i = 0; i < 16; ++i) { HIN[(size_t)(b * 128 + n0 + i) * 512 + ch] = hin; hin = he[i] + pe[i] * hin; }
    }
}

__device__ __forceinline__ void cvt_table(const float* src, bf16* dst, size_t n8, size_t wi, size_t nw) {
    for (size_t i = wi; i < n8; i += nw) {
        const f32x4 a = ((const f32x4*)src)[2 * i], c = ((const f32x4*)src)[2 * i + 1];
        v4u o; o.x = pk2(a.x, a.y); o.y = pk2(a.z, a.w); o.z = pk2(c.x, c.y); o.w = pk2(c.z, c.w);
        ((v4u*)dst)[i] = o;
    }
}

__device__ __forceinline__ void lru_combine(const Params& P, size_t wi, size_t nw) {
    unsigned char* ws = P.ws;
    const v4u* HLOC = (const v4u*)(ws + WS_HLOC); const v4u* PCUM = (const v4u*)(ws + WS_PCUM); const v4u* GATE = (const v4u*)(ws + WS_GATE);
    const float* HIN = (const float*)(ws + WS_HIN); bf16* Y = (bf16*)(ws + WS_Y);
    for (size_t i = wi; i < (size_t)T * 64; i += nw) {
        const size_t t = i >> 6; const int ch0 = (int)(i & 63) * 8;
        const v4u hl = HLOC[i], pc = PCUM[i], gt = GATE[i];
        const f32x4 h0 = *(const f32x4*)(HIN + (t >> 6) * 512 + ch0), h1 = *(const f32x4*)(HIN + (t >> 6) * 512 + ch0 + 4);
        float y[8];
        y[0] = (bflo(hl.x) + bflo(pc.x) * h0.x) * gelu_tanh(bflo(gt.x)); y[1] = (bfhi(hl.x) + bfhi(pc.x) * h0.y) * gelu_tanh(bfhi(gt.x));
        y[2] = (bflo(hl.y) + bflo(pc.y) * h0.z) * gelu_tanh(bflo(gt.y)); y[3] = (bfhi(hl.y) + bfhi(pc.y) * h0.w) * gelu_tanh(bfhi(gt.y));
        y[4] = (bflo(hl.z) + bflo(pc.z) * h1.x) * gelu_tanh(bflo(gt.z)); y[5] = (bfhi(hl.z) + bfhi(pc.z) * h1.y) * gelu_tanh(bfhi(gt.z));
        y[6] = (bflo(hl.w) + bflo(pc.w) * h1.z) * gelu_tanh(bflo(gt.w)); y[7] = (bfhi(hl.w) + bfhi(pc.w) * h1.w) * gelu_tanh(bfhi(gt.w));
        v4u o; o.x = pk2(y[0], y[1]); o.y = pk2(y[2], y[3]); o.z = pk2(y[4], y[5]); o.w = pk2(y[6], y[7]);
        *(v4u*)(Y + t * 1024 + 512 + ch0) = o;
    }
}

__device__ __forceinline__ void gdn_gate_norm(const Params& P, size_t wi, size_t nw) {
    unsigned char* ws = P.ws;
    bf16* Y = (bf16*)(ws + WS_Y); const v4u* Z = (const v4u*)(ws + WS_Z); const float* SSQG = P.out;
    for (size_t i = wi; i < (size_t)T * 64; i += nw) {
        const size_t t = i >> 6; const int c0 = (int)(i & 63) * 8, h = c0 >> 7;
        const f32x4 q0 = *(const f32x4*)(SSQG + t * 32 + h * 8);
        const float rstd = rsqrtf(((q0.x + q0.y) + (q0.z + q0.w)) * (1.0f / 128.0f) + 1e-6f);
        const v4u o = *(const v4u*)(Y + t * 1024 + c0), z = Z[i];
        const f32x4 w0 = *(const f32x4*)(P.gdn_norm_w + (c0 & 127)), w1 = *(const f32x4*)(P.gdn_norm_w + (c0 & 127) + 4);
        float y[8];
        y[0] = bflo(o.x) * rstd * w0.x * siluf_(bflo(z.x)); y[1] = bfhi(o.x) * rstd * w0.y * siluf_(bfhi(z.x));
        y[2] = bflo(o.y) * rstd * w0.z * siluf_(bflo(z.y)); y[3] = bfhi(o.y) * rstd * w0.w * siluf_(bfhi(z.y));
        y[4] = bflo(o.z) * rstd * w1.x * siluf_(bflo(z.z)); y[5] = bfhi(o.z) * rstd * w1.y * siluf_(bfhi(z.z));
        y[6] = bflo(o.w) * rstd * w1.z * siluf_(bflo(z.w)); y[7] = bfhi(o.w) * rstd * w1.w * siluf_(bfhi(z.w));
        v4u r; r.x = pk2(y[0], y[1]); r.y = pk2(y[2], y[3]); r.z = pk2(y[4], y[5]); r.w = pk2(y[6], y[7]);
        *(v4u*)(Y + t * 1024 + c0) = r;
    }
}

__device__ __forceinline__ void xattn_stage(LAS unsigned char* lds, const bf16* src, int tid) {
    v4u tmp[16];
#pragma unroll
    for (int r = 0; r < 16; ++r) tmp[r] = *(const v4u*)(src + (size_t)(tid + 512 * r) * 8);
#pragma unroll
    for (int r = 0; r < 16; ++r) { const int id = tid + 512 * r; *(LAS v4u*)(lds + (id >> 5) * 528 + (id & 31) * 16) = tmp[r]; }
}
__device__ __forceinline__ void xattn_unit(const Params& P, LAS unsigned char* lds, int unit, int tid, int lane, int wave) {
    const unsigned char* ws = P.ws;
    const int h = unit & 3, qb = (unit >> 2) & 63, b = unit >> 8, col = lane & 15, g = lane >> 4;
    const int tw = b * SEQ + qb * 128 + 16 * wave;
    const bf16* Kb = (const bf16*)(ws + WS_KB) + (size_t)((b * 4 + h) * 256) * 256;
    const bf16* Vt = (const bf16*)(ws + WS_VTP) + (size_t)((b * 4 + h) * 256) * 256;
    xattn_stage(lds, Kb, tid);
    __syncthreads();
    const LAS unsigned char* arow = lds + col * 528 + g * 16;
    bf16x8 Bp[1][8]; float inv[1];
#pragma unroll
    for (int ps = 0; ps < 1; ++ps) {
        const bf16* Q = (const bf16*)(ws + WS_Q) + (size_t)(tw + 16 * ps + col) * 1024 + h * 256 + 8 * g;
        bf16x8 Bq[8];
#pragma unroll
        for (int s = 0; s < 8; ++s) Bq[s] = *(const bf16x8*)(Q + 32 * s);
        f32x4 St[16];
        bf16x8 fr[2][8];
#pragma unroll
        for (int s = 0; s < 8; ++s) fr[0][s] = *(const LAS bf16x8*)(arow + 64 * s);
#pragma unroll
        for (int kap = 0; kap < 16; ++kap) {
            if (kap + 1 < 16) {
#pragma unroll
                for (int s = 0; s < 8; ++s) fr[(kap + 1) & 1][s] = *(const LAS bf16x8*)(arow + (16 * (kap + 1)) * 528 + 64 * s);
            }
            __builtin_amdgcn_sched_barrier(0);
            PIN8(fr[kap & 1]);
            f32x4 acc = (f32x4){0.f, 0.f, 0.f, 0.f};
#pragma unroll
            for (int s = 0; s < 8; ++s) acc = __builtin_amdgcn_mfma_f32_16x16x32_bf16(fr[kap & 1][s], Bq[s], acc, 0, 0, 0);
            St[kap] = acc;
            __builtin_amdgcn_sched_barrier(0);
        }
        float mx = -3.0e38f;
#pragma unroll
        for (int kap = 0; kap < 16; ++kap) mx = fmaxf(fmaxf(fmaxf(St[kap].x, St[kap].y), fmaxf(St[kap].z, St[kap].w)), mx);
        mx = fmaxf(mx, __shfl_xor(mx, 16)); mx = fmaxf(mx, __shfl_xor(mx, 32));
        float l = 0.f;
#pragma unroll
        for (int kap = 0; kap < 16; ++kap) { St[kap].x = __expf(St[kap].x - mx); St[kap].y = __expf(St[kap].y - mx); St[kap].z = __expf(St[kap].z - mx); St[kap].w = __expf(St[kap].w - mx);
            l += (St[kap].x + St[kap].y) + (St[kap].z + St[kap].w); }
        l += __shfl_xor(l, 16); l += __shfl_xor(l, 32);
        inv[ps] = 1.0f / l;
#pragma unroll
        for (int s = 0; s < 8; ++s) Bp[ps][s] = pack_b(St[2 * s], St[2 * s + 1]);
    }
    __syncthreads();
    xattn_stage(lds, Vt, tid);
    __syncthreads();
#pragma unroll
    for (int ps = 0; ps < 1; ++ps) {
        bf16* AO = (bf16*)(P.ws + WS_AO) + (size_t)(tw + 16 * ps + col) * 1024 + h * 256 + 4 * g;
        bf16x8 fr[2][8];
#pragma unroll
        for (int s = 0; s < 8; ++s) fr[0][s] = *(const LAS bf16x8*)(arow + 64 * s);
#pragma unroll
        for (int del = 0; del < 16; ++del) {
            if (del + 1 < 16) {
#pragma unroll
                for (int s = 0; s < 8; ++s) fr[(del + 1) & 1][s] = *(const LAS bf16x8*)(arow + (16 * (del + 1)) * 528 + 64 * s);
            }
            __builtin_amdgcn_sched_barrier(0);
            PIN8(fr[del & 1]);
            f32x4 acc = (f32x4){0.f, 0.f, 0.f, 0.f};
#pragma unroll
            for (int s = 0; s < 8; ++s) acc = __builtin_amdgcn_mfma_f32_16x16x32_bf16(fr[del & 1][s], Bp[ps][s], acc, 0, 0, 0);
            v2u o; o.x = pk2(acc.x * inv[ps], acc.y * inv[ps]); o.y = pk2(acc.z * inv[ps], acc.w * inv[ps]);
            *(v2u*)(AO + 16 * del) = o;
            __builtin_amdgcn_sched_barrier(0);
        }
    }
    __syncthreads();
}

__device__ __forceinline__ unsigned key_enc(float f) { const unsigned u = __builtin_bit_cast(unsigned, f); return (u & 0x80000000u) ? ~u : (u | 0x80000000u); }
__device__ __forceinline__ float key_dec(unsigned k) { const unsigned u = (k & 0x80000000u) ? (k & 0x7fffffffu) : ~k; return __builtin_bit_cast(float, u); }
#define TK_CAS(a, b) do { const unsigned hi_ = max(a, b), lo_ = min(a, b); a = hi_; b = lo_; } while (0)
__device__ __forceinline__ void tk_merge16(unsigned (&a)[16]) {
#pragma unroll
    for (int j = 8; j > 0; j >>= 1)
#pragma unroll
        for (int i = 0; i < 16; ++i) { const int l = i ^ j; if (l > i) TK_CAS(a[i], a[l]); }
}
__device__ __forceinline__ void tk_sort16(unsigned (&a)[16]) {
#pragma unroll
    for (int k = 2; k <= 16; k <<= 1)
#pragma unroll
        for (int j = k >> 1; j > 0; j >>= 1)
#pragma unroll
            for (int i = 0; i < 16; ++i) { const int l = i ^ j; if (l > i) { if ((i & k) == 0) TK_CAS(a[i], a[l]); else TK_CAS(a[l], a[i]); } }
}
__device__ __forceinline__ void tk_top16_merge(unsigned (&L)[16], const unsigned (&G)[16]) {
#pragma unroll
    for (int i = 0; i < 16; ++i) L[i] = max(L[i], G[15 - i]);
    tk_merge16(L);
}
__device__ __forceinline__ void tk_pair_merge(unsigned (&L)[16]) {
    unsigned Pp[16];
#pragma unroll
    for (int i = 0; i < 16; ++i) Pp[i] = (unsigned)__builtin_amdgcn_update_dpp(0, (int)L[i], 0xB1, 0xF, 0xF, true);
    tk_top16_merge(L, Pp);
}
__device__ __forceinline__ void peer_topk_rows(const Params& P, LAS unsigned char* lds, int rowbase, int tid) {
    const unsigned char* ws = P.ws;
    typedef _Float16 f16x8 __attribute__((ext_vector_type(8)));
    const int rl = tid >> 1, hf = tid & 1, grow = rowbase + rl, t = grow >> 3, h = grow & 7;
    const _Float16* SC = (const _Float16*)(ws + WS_PQ) + (size_t)t * 2048 + h * 256 + 64 * hf;
    f16x8 raw[2][8];
#pragma unroll
    for (int p = 0; p < 2; ++p)
#pragma unroll
        for (int q = 0; q < 8; ++q) raw[p][q] = *(const f16x8*)(SC + p * 128 + 8 * q);
    unsigned L1[16], L2[16];
#pragma unroll
    for (int p = 0; p < 2; ++p) {
        unsigned L[16];
#pragma unroll
        for (int grp = 0; grp < 4; ++grp) {
            unsigned G[16];
#pragma unroll
            for (int e = 0; e < 16; ++e) G[e] = (key_enc((float)raw[p][2 * grp + (e >> 3)][e & 7]) & ~127u) | (unsigned)(127 - (64 * hf + 16 * grp + e));
            tk_sort16(G);
            if (grp == 0) {
#pragma unroll
                for (int i = 0; i < 16; ++i) L[i] = G[i];
            } else tk_top16_merge(L, G);
        }
        tk_pair_merge(L);
#pragma unroll
        for (int i = 0; i < 16; ++i) { if (p == 0) L1[i] = L[i]; else L2[i] = L[i]; }
    }
    {
        float v1[16], v2[16];
        LAS int* il = (LAS int*)lds + rl * 33;
#pragma unroll
        for (int q = 0; q < 16; ++q) { v1[q] = key_dec((L1[q] & ~127u) | 64u); v2[q] = key_dec((L2[q] & ~127u) | 64u); }
        if (hf == 0) {
#pragma unroll
            for (int q = 0; q < 16; ++q) { il[q] = 127 - (int)(L1[q] & 127u); il[16 + q] = 127 - (int)(L2[q] & 127u); }
        }
        unsigned C[16], D[16];
        float w1[8];
        const unsigned hf16 = (unsigned)hf * 16u, evenmask = (unsigned)hf - 1u;
#pragma unroll
        for (int k = 0; k < 8; ++k) w1[k] = __builtin_bit_cast(float, (__builtin_bit_cast(unsigned, v1[2 * k]) & evenmask) | (__builtin_bit_cast(unsigned, v1[2 * k + 1]) & ~evenmask));
#define TK_SLOT(dst, k, bq, valid_odd) do { const unsigned pos_ = (unsigned)(16 * (2 * (k)) + (bq)) + hf16; unsigned kv_ = (key_enc(w1[k] + v2[bq]) & ~255u) | (255u - pos_); if (!(valid_odd)) kv_ &= evenmask; dst = kv_; } while (0)
        TK_SLOT(C[0], 0, 0, true);
        TK_SLOT(C[1], 0, 1, true);
        TK_SLOT(C[2], 0, 2, true);
        TK_SLOT(C[3], 0, 3, true);
        TK_SLOT(C[4], 0, 4, true);
        TK_SLOT(C[5], 0, 5, true);
        TK_SLOT(C[6], 0, 6, true);
        TK_SLOT(C[7], 0, 7, true);
        TK_SLOT(C[8], 0, 8, false);
        TK_SLOT(C[9], 0, 9, false);
        TK_SLOT(C[10], 0, 10, false);
        TK_SLOT(C[11], 0, 11, false);
        TK_SLOT(C[12], 0, 12, false);
        TK_SLOT(C[13], 0, 13, false);
        TK_SLOT(C[14], 0, 14, false);
        TK_SLOT(C[15], 0, 15, false);
        TK_SLOT(D[0], 1, 0, true);
        TK_SLOT(D[1], 1, 1, true);
        TK_SLOT(D[2], 1, 2, true);
        TK_SLOT(D[3], 1, 3, true);
        TK_SLOT(D[4], 1, 4, false);
        TK_SLOT(D[5], 2, 0, true);
        TK_SLOT(D[6], 2, 1, true);
        TK_SLOT(D[7], 2, 2, false);
        TK_SLOT(D[8], 3, 0, true);
        TK_SLOT(D[9], 3, 1, true);
        TK_SLOT(D[10], 4, 0, true);
        TK_SLOT(D[11], 5, 0, true);
        TK_SLOT(D[12], 6, 0, true);
        TK_SLOT(D[13], 7, 0, true);
        D[14] = 0u; D[15] = 0u;
#undef TK_SLOT
        tk_sort16(C); tk_sort16(D); tk_top16_merge(C, D); tk_pair_merge(C);
        LDS_WAIT(); asm volatile("" ::: "memory");
        float best[16], e[16], sum = 0.f;
#pragma unroll
        for (int q = 0; q < 16; ++q) { best[q] = key_dec((C[q] & ~255u) | 128u); e[q] = __expf(best[q] - best[0]); sum += e[q]; }
        const float inv = __builtin_amdgcn_rcpf(sum);
        int* IDX = (int*)(P.ws + WS_IDX) + (size_t)grow * 16 + 8 * hf; float* GW = (float*)(P.ws + WS_GW) + (size_t)grow * 16 + 8 * hf;
#pragma unroll
        for (int q = 0; q < 8; ++q) {
            const unsigned c = (C[q] & evenmask) | (C[8 + q] & ~evenmask);
            const float ev = __builtin_bit_cast(float, (__builtin_bit_cast(unsigned, e[q]) & evenmask) | (__builtin_bit_cast(unsigned, e[8 + q]) & ~evenmask));
            const unsigned pos = 255u - (c & 255u);
            IDX[q] = il[pos >> 4] * 128 + il[16 + (pos & 15u)]; GW[q] = ev * inv;
        }
    }
    LDS_WAIT(); asm volatile("" ::: "memory");
}

typedef float f32x2 __attribute__((ext_vector_type(2)));
__device__ __forceinline__ void cvt_table_fp8(const float* src, unsigned char* dst, float* scl, int gw, int ngw, int lane) {
    for (int row = gw; row < 16384; row += ngw) {
        const f32x4* sp = (const f32x4*)(src + (size_t)row * 1024 + 16 * lane);
        const f32x4 a0 = sp[0], a1 = sp[1], a2 = sp[2], a3 = sp[3];
        float m = fmaxf(fmaxf(fmaxf(fabsf(a0.x), fabsf(a0.y)), fmaxf(fabsf(a0.z), fabsf(a0.w))), fmaxf(fmaxf(fabsf(a1.x), fabsf(a1.y)), fmaxf(fabsf(a1.z), fabsf(a1.w))));
        m = fmaxf(m, fmaxf(fmaxf(fmaxf(fabsf(a2.x), fabsf(a2.y)), fmaxf(fabsf(a2.z), fabsf(a2.w))), fmaxf(fmaxf(fabsf(a3.x), fabsf(a3.y)), fmaxf(fabsf(a3.z), fabsf(a3.w)))));
#pragma unroll
        for (int o = 1; o < 64; o <<= 1) m = fmaxf(m, __shfl_xor(m, o));
        m = fmaxf(m, 1e-30f);
        const float q = 224.0f / m;
        v4u o;
        int p;
        p = __builtin_amdgcn_cvt_pk_fp8_f32(a0.x * q, a0.y * q, 0, false); p = __builtin_amdgcn_cvt_pk_fp8_f32(a0.z * q, a0.w * q, p, true); o.x = (unsigned)p;
        p = __builtin_amdgcn_cvt_pk_fp8_f32(a1.x * q, a1.y * q, 0, false); p = __builtin_amdgcn_cvt_pk_fp8_f32(a1.z * q, a1.w * q, p, true); o.y = (unsigned)p;
        p = __builtin_amdgcn_cvt_pk_fp8_f32(a2.x * q, a2.y * q, 0, false); p = __builtin_amdgcn_cvt_pk_fp8_f32(a2.z * q, a2.w * q, p, true); o.z = (unsigned)p;
        p = __builtin_amdgcn_cvt_pk_fp8_f32(a3.x * q, a3.y * q, 0, false); p = __builtin_amdgcn_cvt_pk_fp8_f32(a3.z * q, a3.w * q, p, true); o.w = (unsigned)p;
        *(v4u*)(dst + (size_t)row * 1024 + 16 * lane) = o;
        if (lane == 0) scl[row] = m * (1.0f / 224.0f);
    }
}
constexpr int PE_NT = 4, PE_NR = 16, PE_SH = 10;
constexpr int PE_LDS_TOK = 128 * 4 + 36 * 4;
__device__ __forceinline__ void peer_pass(const Params& P, LAS unsigned char* lds, int tbase, int lane, int wave, float* dstbase) {
    const unsigned char* ws = P.ws;
    const unsigned char* UB8 = ws + WS_UB; const unsigned char* VB8 = ws + WS_VB;
    const float* USC = (const float*)(ws + WS_USC); const float* VSC = (const float*)(ws + WS_VSC);
    f32x2 hn[PE_NT][8], acc[PE_NT][8];
    LAS unsigned* lw = (LAS unsigned*)(lds + wave * (PE_NT * PE_LDS_TOK));
#pragma unroll
    for (int j = 0; j < PE_NT; ++j) {
        const int t = tbase + j;
        const float* xrow = P.out + (size_t)t * 1024 + 16 * lane;
        const float rstd2 = rsqrtf(((const float*)(ws + WS_SSQ2))[t] * (1.0f / 1024.0f) + 1e-6f);
#pragma unroll
        for (int i = 0; i < 4; ++i) { const f32x4 xv = ((const f32x4*)xrow)[i]; const f32x4 w = ((const f32x4*)(P.norm_ffn_w + 16 * lane))[i];
            hn[j][2 * i] = (f32x2){xv.x * rstd2 * w.x, xv.y * rstd2 * w.y}; hn[j][2 * i + 1] = (f32x2){xv.z * rstd2 * w.z, xv.w * rstd2 * w.w}; }
#pragma unroll
        for (int i = 0; i < 8; ++i) acc[j][i] = (f32x2){0.f, 0.f};
        const int e0 = ((const int*)(ws + WS_IDX))[(size_t)t * 128 + 2 * lane], e1 = ((const int*)(ws + WS_IDX))[(size_t)t * 128 + 2 * lane + 1];
        const float g0 = ((const float*)(ws + WS_GW))[(size_t)t * 128 + 2 * lane], g1 = ((const float*)(ws + WS_GW))[(size_t)t * 128 + 2 * lane + 1];
        const unsigned p0 = (unsigned)e0 | (f2bf(g0) << 16), p1 = (unsigned)e1 | (f2bf(g1) << 16);
        const int b0 = e0 >> PE_SH, b1 = e1 >> PE_SH;
        LAS unsigned* lt = lw + j * (PE_LDS_TOK / 4);
        int run = 0;
#pragma unroll 1
        for (int bk = 0; bk < PE_NR; ++bk) {
            const unsigned long long m0 = __ballot(b0 == bk), m1 = __ballot(b1 == bk);
            const int c0 = __popcll(m0), c1 = __popcll(m1);
            const unsigned long long lower = (1ull << lane) - 1ull;
            if (b0 == bk) lt[run + __popcll(m0 & lower)] = p0;
            if (b1 == bk) lt[run + c0 + __popcll(m1 & lower)] = p1;
            if (lane == 0) lt[128 + bk] = (unsigned)run;
            run += c0 + c1;
        }
        if (lane == 0) lt[128 + PE_NR] = 128u;
    }
    LDS_WAIT(); asm volatile("" ::: "memory");
#pragma unroll 1
    for (int rd = 0; rd < PE_NR; ++rd) {
#pragma unroll
        for (int j = 0; j < PE_NT; ++j) {
            const LAS unsigned* lt = lw + j * (PE_LDS_TOK / 4);
            const int n0 = __builtin_amdgcn_readfirstlane((int)lt[128 + rd]), n1 = __builtin_amdgcn_readfirstlane((int)lt[128 + rd + 1]);
#pragma unroll 1
            for (int i0 = n0; i0 < n1; i0 += 8) {
                const int cnt = (n1 - i0) < 8 ? (n1 - i0) : 8;
                const unsigned pk = (lane < cnt) ? lt[i0 + lane] : 0u;
                const int ev = (int)(pk & 0x3fffu);
                const float usc = (lane < cnt) ? USC[ev] : 0.f;
                const float gsc = (lane < cnt) ? bfhi(pk) * VSC[ev] : 0.f;
                v4u uq[8], vq[8];
#pragma unroll
                for (int k = 0; k < 8; ++k) {
                    if (k < cnt) { const int e = __builtin_amdgcn_readlane(ev, k);
                        uq[k] = *(const v4u*)(UB8 + (size_t)e * 1024 + 16 * lane); vq[k] = *(const v4u*)(VB8 + (size_t)e * 1024 + 16 * lane); }
                }
                float d[8];
#pragma unroll
                for (int k = 0; k < 8; ++k) {
                    d[k] = 0.f;
                    if (k >= cnt) continue;
                    f32x2 s = __builtin_amdgcn_cvt_pk_f32_fp8((int)uq[k].x, false) * hn[j][0];
                    s = __builtin_elementwise_fma(__builtin_amdgcn_cvt_pk_f32_fp8((int)uq[k].x, true), hn[j][1], s);
                    s = __builtin_elementwise_fma(__builtin_amdgcn_cvt_pk_f32_fp8((int)uq[k].y, false), hn[j][2], s);
                    s = __builtin_elementwise_fma(__builtin_amdgcn_cvt_pk_f32_fp8((int)uq[k].y, true), hn[j][3], s);
                    s = __builtin_elementwise_fma(__builtin_amdgcn_cvt_pk_f32_fp8((int)uq[k].z, false), hn[j][4], s);
                    s = __builtin_elementwise_fma(__builtin_amdgcn_cvt_pk_f32_fp8((int)uq[k].z, true), hn[j][5], s);
                    s = __builtin_elementwise_fma(__builtin_amdgcn_cvt_pk_f32_fp8((int)uq[k].w, false), hn[j][6], s);
                    s = __builtin_elementwise_fma(__builtin_amdgcn_cvt_pk_f32_fp8((int)uq[k].w, true), hn[j][7], s);
                    d[k] = s.x + s.y;
                }
                float r4[4], r2[2], r1;
                { const bool up = (lane & 32) != 0;
#pragma unroll
                  for (int i = 0; i < 4; ++i) { const float keep = up ? d[4 + i] : d[i], send = up ? d[i] : d[4 + i]; r4[i] = keep + __shfl_xor(send, 32); } }
                { const bool up = (lane & 16) != 0;
#pragma unroll
                  for (int i = 0; i < 2; ++i) { const float keep = up ? r4[2 + i] : r4[i], send = up ? r4[i] : r4[2 + i]; r2[i] = keep + __shfl_xor(send, 16); } }
                { const bool up = (lane & 8) != 0; const float keep = up ? r2[1] : r2[0], send = up ? r2[0] : r2[1]; r1 = keep + __shfl_xor(send, 8); }
                r1 += __shfl_xor(r1, 4); r1 += __shfl_xor(r1, 2); r1 += __shfl_xor(r1, 1);
                const int myk = (lane >> 3) & 7;
                const float act = gelu_tanh(r1 * __shfl(usc, myk)) * __shfl(gsc, myk);
#pragma unroll
                for (int k = 0; k < 8; ++k) {
                    if (k >= cnt) continue;
                    const float a = __builtin_bit_cast(float, __builtin_amdgcn_readlane(__builtin_bit_cast(int, act), 8 * k));
                    const f32x2 a2 = (f32x2){a, a};
                    acc[j][0] = __builtin_elementwise_fma(__builtin_amdgcn_cvt_pk_f32_fp8((int)vq[k].x, false), a2, acc[j][0]);
                    acc[j][1] = __builtin_elementwise_fma(__builtin_amdgcn_cvt_pk_f32_fp8((int)vq[k].x, true), a2, acc[j][1]);
                    acc[j][2] = __builtin_elementwise_fma(__builtin_amdgcn_cvt_pk_f32_fp8((int)vq[k].y, false), a2, acc[j][2]);
                    acc[j][3] = __builtin_elementwise_fma(__builtin_amdgcn_cvt_pk_f32_fp8((int)vq[k].y, true), a2, acc[j][3]);
                    acc[j][4] = __builtin_elementwise_fma(__builtin_amdgcn_cvt_pk_f32_fp8((int)vq[k].z, false), a2, acc[j][4]);
                    acc[j][5] = __builtin_elementwise_fma(__builtin_amdgcn_cvt_pk_f32_fp8((int)vq[k].z, true), a2, acc[j][5]);
                    acc[j][6] = __builtin_elementwise_fma(__builtin_amdgcn_cvt_pk_f32_fp8((int)vq[k].w, false), a2, acc[j][6]);
                    acc[j][7] = __builtin_elementwise_fma(__builtin_amdgcn_cvt_pk_f32_fp8((int)vq[k].w, true), a2, acc[j][7]);
                }
            }
        }
    }
#pragma unroll
    for (int j = 0; j < PE_NT; ++j) {
        const int t = tbase + j;
        float ss = 0.f; f32x4 xo[4];
        const float* xrow = P.out + (size_t)t * 1024 + 16 * lane;
#pragma unroll
        for (int i = 0; i < 4; ++i) { xo[i] = ((const f32x4*)xrow)[i]; xo[i].x += acc[j][2 * i].x; xo[i].y += acc[j][2 * i].y; xo[i].z += acc[j][2 * i + 1].x; xo[i].w += acc[j][2 * i + 1].y;
            ss += (xo[i].x * xo[i].x + xo[i].y * xo[i].y) + (xo[i].z * xo[i].z + xo[i].w * xo[i].w); }
        const float rstd3 = rsqrtf(wave_sum(ss) * (1.0f / 1024.0f) + 1e-6f);
        float* orow = dstbase + (size_t)t * 1024 + 16 * lane;
#pragma unroll
        for (int i = 0; i < 4; ++i) { const f32x4 w = ((const f32x4*)(P.norm_final_w + 16 * lane))[i];
            ((f32x4*)orow)[i] = (f32x4){xo[i].x * rstd3 * w.x, xo[i].y * rstd3 * w.y, xo[i].z * rstd3 * w.z, xo[i].w * rstd3 * w.w}; }
    }
    LDS_WAIT(); asm volatile("" ::: "memory");
}


__global__ void __launch_bounds__(NWAVES * 64, 2) hybrid_fwd(Params P) {
    extern __shared__ __attribute__((aligned(16))) unsigned char lds_raw[];
    LAS unsigned char* lds = (LAS unsigned char*)lds_raw;
    volatile LAS unsigned* MISC = (volatile LAS unsigned*)(lds + MISC_OFF);
    const int tid = threadIdx.x, lane = tid & 63, wave = __builtin_amdgcn_readfirstlane(tid >> 6);
    const int G = gridDim.x, bx = blockIdx.x;
    const int vcu = (G % 8 == 0) ? (bx % 8) * (G / 8) + bx / 8 : bx;
    unsigned char* ws = P.ws;
    for (int u = tid; u < 64; u += NWAVES * 64) MISC[u] = 0u;
    __syncthreads();
    XcdBarrier bar; bar.bar = (unsigned*)(ws + WS_CTL) + CW_BAR; bar.x = 0; bar.st = nullptr;
    if (!MK_PER_PHASE) bar = xcd_barrier_post((unsigned*)(ws + WS_CTL) + CW_BAR, MISC + 8);
    const int lo = P.ph_lo, hi = P.ph_hi;
#ifndef PHASE_MASK
#define PHASE_MASK 0xFFF
#endif
#define IN(k) (((PHASE_MASK >> (k)) & 1) && lo <= (k) && (k) < hi)
#define SEAM(k) do { if (IN(k) && IN((k) + 1)) xcd_barrier(bar); } while (0)
#ifndef REP_MASK
#define REP_MASK 0
#endif
#define REPS(k) for (int rep_ = 0; rep_ < (((REP_MASK >> (k)) & 1) ? 2 : 1); ++rep_, (rep_ < (((REP_MASK >> (k)) & 1) ? 2 : 1) ? xcd_barrier(bar) : (void)0))
    using namespace pg8;
    bf16* XB = (bf16*)(ws + WS_XB);

    if (IN(0)) REPS(0) { p0_prologue(P, lds, tid, lane, wave, vcu, G); }
    SEAM(0);
    if (IN(1)) REPS(1) {
        { Gemm gm{XB, (const bf16_t*)(ws + WS_WIN), T, 3072, 1024}; StaticOrder S; S.init(T, 3072, G, bx);
          EpiBf16Rs E{(bf16_t*)(ws + WS_QKV), 1536, 6, (bf16_t*)(ws + WS_XR), 512, (size_t)T * 512, nullptr, 1.0f};
          gemm_phase<EpiBf16Rs, StaticOrder, PG8_ALIGN, PG8_SP2>(lds, gm, S, E); }
    }
    SEAM(1);
    if (IN(2)) REPS(2) {
#ifndef P2_REP_GDN
#define P2_REP_GDN 1
#endif
#ifndef P2_REP_LRU
#define P2_REP_LRU 1
#endif
        for (int rr = 0; rr < P2_REP_GDN; ++rr) for (int it = bx; it < 1024; it += G) gdn_local_item(P, lds, it, tid);
    }
    SEAM(2);
    if (IN(3)) REPS(3) {
        if (bx < SCAN_WGS) gdn_scan(P, lds, bx, tid, lane, wave);
        else {
            const int wk = bx - SCAN_WGS, NWK = G - SCAN_WGS;
            unsigned* lcnt = (unsigned*)(ws + WS_CTL) + CW_LRUCNT;
            if (wk < 16) {
                struct OneUnit { int pm, pn; __device__ bool next(int i, Unit& u) const { if (i > 0) return false; u.pm = pm; u.pn = pn; return true; }
                                 __device__ void a_ready(const Unit&) const {} __device__ void done(const Unit&) const {} };
                Gemm gm{(const bf16_t*)(ws + WS_MEMN), (const bf16_t*)(ws + WS_WKV), 512, 2048, 1024}; OneUnit S{wk >> 3, wk & 7};
                EpiKV E{(bf16_t*)(ws + WS_KB), (bf16_t*)(ws + WS_VTP)};
                gemm_phase<EpiKV, OneUnit, PG8_ALIGN, PG8_SP2>(lds, gm, S, E);
            }
            unsigned ndone = 0;
            for (int lt = wk; lt < 256; lt += NWK) { lru_local_item(P, lds, lt, tid, lane, wave); ++ndone; }
            asm volatile("s_waitcnt vmcnt(0)" ::: "memory");
            __syncthreads();
            if (tid == 0 && ndone) { __builtin_amdgcn_fence(__ATOMIC_RELEASE, "agent"); asm volatile("s_waitcnt vmcnt(0)" ::: "memory");
                                     __hip_atomic_fetch_add(lcnt, ndone, __ATOMIC_RELAXED, __HIP_MEMORY_SCOPE_AGENT); }
            if (wk == 16 || wk == 17) {
                if (tid == 0) { unsigned sp = 0;
                    while (__hip_atomic_load(lcnt, __ATOMIC_RELAXED, __HIP_MEMORY_SCOPE_AGENT) < 256u) { __builtin_amdgcn_s_sleep(8); if (++sp > (1u << 22)) break; }
                    __builtin_amdgcn_fence(__ATOMIC_ACQUIRE, "agent"); asm volatile("s_waitcnt vmcnt(0)" ::: "memory"); }
                __syncthreads();
                lru_carry(P, (wk - 16) * NWAVES + wave, lane);
            } else {
                const int w2 = (wk < 16 ? wk : wk - 2), N2 = NWK - 2;
                cvt_table_fp8(P.peer_u, ws + WS_UB, (float*)(ws + WS_USC), w2 * NWAVES + wave, N2 * NWAVES, lane);
                cvt_table_fp8(P.peer_v, ws + WS_VB, (float*)(ws + WS_VSC), w2 * NWAVES + wave, N2 * NWAVES, lane);
                late_weight_prep(P, lds, lane, wave, w2 * NWAVES + wave, N2 * NWAVES);
            }
        }
    }
    SEAM(3);
    if (IN(4)) REPS(4) {
        gdn_gate_norm(P, (size_t)bx * (NWAVES * 64) + tid, (size_t)G * (NWAVES * 64));
        lru_combine(P, (size_t)bx * (NWAVES * 64) + tid, (size_t)G * (NWAVES * 64));
    }
    SEAM(4);
    if (IN(5)) {
        Gemm gm{(const bf16_t*)(ws + WS_Y), (const bf16_t*)(ws + WS_WOUT), T, 1024, 1024}; StaticOrder S; S.init(T, 1024, G, bx);
        EpiResid E{P.x, P.out, XB, (float*)(ws + WS_SSQ1)};
        gemm_phase<EpiResid, StaticOrder, PG8_ALIGN, PG8_SP2>(lds, gm, S, E);
    }
    SEAM(5);
    if (IN(6)) REPS(6) {
        Gemm gm{XB, (const bf16_t*)(ws + WS_WQ), T, 1024, 1024}; StaticOrder S; S.init(T, 1024, G, bx);
        EpiBf16Rs E{(bf16_t*)(ws + WS_Q), 1024, 4, nullptr, 256, 0, (const float*)(ws + WS_SSQ1), 0.0625f};
        gemm_phase<EpiBf16Rs, StaticOrder, PG8_ALIGN, PG8_SP2>(lds, gm, S, E);
    }
    SEAM(6);
    if (IN(7)) REPS(7) {
        for (int un = bx; un < 512; un += G) xattn_unit(P, lds, un, tid, lane, wave);
    }
    SEAM(7);
    if (IN(8)) {
        Gemm gm{(const bf16_t*)(ws + WS_AO), (const bf16_t*)(ws + WS_WO), T, 1024, 1024}; StaticOrder S; S.init(T, 1024, G, bx);
        EpiResid E{P.out, P.out, XB, (float*)(ws + WS_SSQ2)};
        gemm_phase<EpiResid, StaticOrder, PG8_ALIGN, PG8_SP2>(lds, gm, S, E);
    }
    SEAM(8);
    if (IN(9)) REPS(9) {
        Gemm gm{XB, (const bf16_t*)(ws + WS_PWQ), T, 2048, 1024}; StaticOrder S; S.init(T, 2048, G, bx);
        EpiF16Rs E{(_Float16*)(ws + WS_PQ), 2048, (const float*)(ws + WS_SSQ2)};
        gemm_phase<EpiF16Rs, StaticOrder, PG8_ALIGN, PG8_SP2>(lds, gm, S, E);
    }
    SEAM(9);
    if (IN(10)) REPS(10) {
        for (int rb = bx * 256; rb < T * 8; rb += G * 256) peer_topk_rows(P, lds, rb, tid);
    }
    SEAM(10);
    if (IN(11)) REPS(11) {
        for (int tb = (bx * NWAVES + wave) * PE_NT; tb < T; tb += G * NWAVES * PE_NT) peer_pass(P, lds, tb, lane, wave, (((REP_MASK >> 11) & 1) && rep_ == 0) ? (float*)(ws + WS_PQ) : P.out);
    }
#undef IN
#undef SEAM
}

extern "C" void kernel_launch(void* const* d_in, const int* in_sizes, int n_in, void* d_out, int out_size, void* d_ws, size_t ws_size, hipStream_t stream) {
    static int grid = 0;
    if (grid == 0) {
        if (n_in != 27 || in_sizes[0] != T * D || out_size != T * D || ws_size < WS_END) {
            fprintf(stderr, "kernel_launch: unexpected shapes (n_in %d, in0 %d, out %d, ws %zu); nothing launched\n", n_in, n_in > 0 ? in_sizes[0] : -1, out_size, ws_size); grid = -1; return; }
        int dev = 0, cus = 0, per_cu = 0;
        if (hipGetDevice(&dev) != hipSuccess || hipDeviceGetAttribute(&cus, hipDeviceAttributeMultiprocessorCount, dev) != hipSuccess) { grid = -1; return; }
        if (hipFuncSetAttribute((const void*)hybrid_fwd, hipFuncAttributeMaxDynamicSharedMemorySize, LDS_BYTES) != hipSuccess) { fprintf(stderr, "kernel_launch: hipFuncSetAttribute failed\n"); grid = -1; return; }
        if (hipOccupancyMaxActiveBlocksPerMultiprocessor(&per_cu, (const void*)hybrid_fwd, NWAVES * 64, LDS_BYTES) != hipSuccess || per_cu < 1)
            fprintf(stderr, "kernel_launch: note: occupancy query reports %d workgroups per CU\n", per_cu);
        (void)hipGetLastError();
        grid = cus;
        if (grid != 256) fprintf(stderr, "kernel_launch: %d CUs (built for 256)\n", grid);
    }
    if (grid < 0) return;
    if (hipMemsetAsync((char*)d_ws + WS_CTL, 0, CTL_ZERO_BYTES, stream) != hipSuccess) { fprintf(stderr, "kernel_launch: hipMemsetAsync failed\n"); return; }
    Params p{};
    const float** pp = (const float**)&p;
    for (int i = 0; i < 27; ++i) pp[i] = (const float*)d_in[i];
    p.out = (float*)d_out; p.ws = (unsigned char*)d_ws;
#if MK_PER_PHASE
    for (int k = 0; k < N_PHASES; ++k) { p.ph_lo = k; p.ph_hi = k + 1; hipLaunchKernelGGL(hybrid_fwd, dim3(grid), dim3(NWAVES * 64), LDS_BYTES, stream, p); }
#else
    p.ph_lo = 0; p.ph_hi = N_PHASES;
    hipLaunchKernelGGL(hybrid_fwd, dim3(grid), dim3(NWAVES * 64), LDS_BYTES, stream, p);
#endif
    const hipError_t le = hipPeekAtLastError();
    if (le != hipSuccess) fprintf(stderr, "kernel_launch: launch failed: %s\n", hipGetErrorName(le));
}
```

```cpp
#include <hip/hip_runtime.h>
#include <cstdio>
#include <cstdint>
namespace pg8 {
#define PG8_LAS __attribute__((address_space(3)))
typedef unsigned short bf16_t;
typedef short bf16x8 __attribute__((ext_vector_type(8)));
typedef float f32x4 __attribute__((ext_vector_type(4)));
typedef unsigned u32x4 __attribute__((ext_vector_type(4)));
constexpr int BM = 256, BK = 64, HALF = 128, HTB = HALF * BK * 2  , STAGE_BYTES = 8 * HTB, NXCD = 8, WGM = 8;

__host__ __device__ __forceinline__ int lds_byte(int r, int c) { const int st = (r >> 4) * 2 + (c >> 5), rr = r & 15, cc = c & 31, ob = rr * 64 + cc * 2; return st * 1024 + (ob ^ (((ob >> 9) & 1) << 5)); }
__host__ __device__ __forceinline__ void stage_rc(int b, int& R, int& C) { const int st = b / 1024, sb = b % 1024, swz = sb ^ (((sb >> 9) & 1) << 5); R = (st >> 1) * 16 + swz / 64; C = (st & 1) * 32 + (swz % 64) / 2; }
__host__ __device__ __forceinline__ int perm32(int rho) { const int n = rho >> 4, i = rho & 15; return 8 * (i >> 2) + 4 * n + (i & 3); }

struct Unit { int pm, pn; };
struct Gemm { const bf16_t* A; const bf16_t* Bt; int M, N, K; };

struct StaticOrder {
    int nM, nN, nwg, G, c;
    __host__ __device__ void init(int M, int N, int G_, int c_) { nM = M / BM; nN = N / BM; nwg = nM * nN; G = G_; c = c_; }
    __host__ __device__ bool next(int i, Unit& u) const {
        const long L = (long)i * G + c; if (L >= nwg) return false;
        int wgid = (int)L; { const int q = nwg / NXCD, r = nwg % NXCD, xcd = wgid % NXCD, off = wgid / NXCD; wgid = (xcd < r ? xcd * (q + 1) : r * (q + 1) + (xcd - r) * q) + off; }
        const int nig = WGM * nN, gid = wgid / nig, fm = gid * WGM, gsz = (nM - fm) < WGM ? (nM - fm) : WGM;
        u.pm = fm + ((wgid % nig) % gsz); u.pn = (wgid % nig) / gsz; return true;
    }
    __device__ __forceinline__ void a_ready(const Unit&) const {}
    __device__ __forceinline__ void done(const Unit&) const {}
};

__device__ __forceinline__ unsigned cvt_pk_bf16(float lo, float hi) { unsigned r; asm volatile("v_cvt_pk_bf16_f32 %0, %1, %2" : "=v"(r) : "v"(lo), "v"(hi)); return r; }
template <class Epi, class Sched, bool ALIGN_EPI = false, bool SP2 = false>
__device__ __forceinline__ void gemm_phase(PG8_LAS unsigned char* lds, const Gemm g, const Sched& S, const Epi& E) {
    const int tid = threadIdx.x, wid = __builtin_amdgcn_readfirstlane(tid >> 6), lane = tid & 63, wr = wid >> 2, wc = wid & 3, fr = lane & 15, fq = lane >> 4;
    const int K = g.K, nt = K / BK;
    unsigned voffA[2], voffB[2];
#pragma unroll
    for (int i = 0; i < 2; ++i) { int R, C; stage_rc(tid * 16 + i * 8192, R, C); const int Rb = Epi::PERM ? ((R & ~31) + perm32(R & 31)) : R;
        voffA[i] = (unsigned)(R * K + C) * 2u; voffB[i] = (unsigned)(Rb * K + C) * 2u; }
    const size_t kstep = (size_t)(BK * 2);
    const size_t hstep = (size_t)HALF * K * 2;
    const size_t tstep = 2 * hstep;
    const unsigned ldsw = (unsigned)wid * 1024u;
    const int aoff = lds_byte(wr * 64 + fr, fq * 8), boff = lds_byte(wc * 32 + fr, fq * 8);
#define PG8_SA(b, h) (((b) * 2 + (h)) * HTB)
#define PG8_SB(b, h) ((4 + (b) * 2 + (h)) * HTB)
#define PG8_STAGE(bufoff, gbase, voff) do { _Pragma("unroll") for (int _i = 0; _i < 2; ++_i) \
        __builtin_amdgcn_global_load_lds((const unsigned*)((const char*)(gbase) + (voff)[_i]), (PG8_LAS unsigned*)(lds + (bufoff) + ldsw + _i * 8192), 16, 0, 0); } while (0)
#define PG8_LDA(dst, b, h) do { _Pragma("unroll") for (int m = 0; m < 4; ++m) _Pragma("unroll") for (int k = 0; k < 2; ++k) dst[m][k] = *(const PG8_LAS bf16x8*)(lds + PG8_SA(b, h) + aoff + m * 2048 + k * 1024); } while (0)
#define PG8_LDB(dst, b, h) do { _Pragma("unroll") for (int n = 0; n < 2; ++n) _Pragma("unroll") for (int k = 0; k < 2; ++k) dst[n][k] = *(const PG8_LAS bf16x8*)(lds + PG8_SB(b, h) + boff + n * 2048 + k * 1024); } while (0)
#define PG8_MMA(ai, bj, At, Bt) do { __builtin_amdgcn_s_setprio(1); _Pragma("unroll") for (int m = 0; m < 4; ++m) _Pragma("unroll") for (int n = 0; n < 2; ++n) _Pragma("unroll") for (int k = 0; k < 2; ++k) \
        acc[ai][bj][m][n] = __builtin_amdgcn_mfma_f32_16x16x32_bf16(Bt[n][k], At[m][k], acc[ai][bj][m][n], 0, 0, 0); __builtin_amdgcn_s_setprio(0); } while (0)
#define PG8_WAIT_V(n) asm volatile("s_waitcnt vmcnt(" #n ")" ::: "memory")
#define PG8_WAIT_L(n) asm volatile("s_waitcnt lgkmcnt(" #n ")" ::: "memory")
#define PG8_BAR __builtin_amdgcn_s_barrier()
#define PG8_SCHED __builtin_amdgcn_sched_barrier(0)
    Unit cur, nxt; int ui = 0;
    if (!S.next(0, cur)) return;
    f32x4 acc[2][2][4][2];
#pragma unroll
    for (int a = 0; a < 2; ++a)
#pragma unroll
        for (int b = 0; b < 2; ++b)
#pragma unroll
            for (int m = 0; m < 4; ++m)
#pragma unroll
                for (int n = 0; n < 2; ++n) acc[a][b][m][n] = (f32x4){0.f, 0.f, 0.f, 0.f};
    bf16x8 At[4][2], B0[2][2], B1[2][2];
    const char* cA = (const char*)g.A + (size_t)cur.pm * tstep; const char* cB = (const char*)g.Bt + (size_t)cur.pn * tstep;
    S.a_ready(cur);
    if constexpr (SP2) {
        PG8_STAGE(PG8_SB(0, 0), cB, voffB); PG8_STAGE(PG8_SB(0, 1), cB + hstep, voffB); PG8_STAGE(PG8_SA(0, 0), cA, voffA); PG8_STAGE(PG8_SA(0, 1), cA + hstep, voffA);
        if (wr == 1) PG8_BAR;
        PG8_WAIT_V(2); PG8_BAR;
        PG8_STAGE(PG8_SB(1, 0), cB + kstep, voffB); PG8_STAGE(PG8_SA(1, 0), cA + kstep, voffA); PG8_STAGE(PG8_SB(1, 1), cB + hstep + kstep, voffB);
        PG8_WAIT_V(6); PG8_BAR;
    } else {
        PG8_STAGE(PG8_SB(0, 0), cB, voffB); PG8_STAGE(PG8_SA(0, 0), cA, voffA); PG8_STAGE(PG8_SB(0, 1), cB + hstep, voffB); PG8_STAGE(PG8_SA(0, 1), cA + hstep, voffA);
        if (wr == 1) PG8_BAR;
        PG8_WAIT_V(4); PG8_BAR;
        PG8_STAGE(PG8_SB(1, 0), cB + kstep, voffB); PG8_STAGE(PG8_SA(1, 0), cA + kstep, voffA); PG8_STAGE(PG8_SB(1, 1), cB + hstep + kstep, voffB);
        PG8_WAIT_V(6); PG8_BAR;
    }
    for (;;) {
        const bool has_next = S.next(ui + 1, nxt);
        const char* nA = has_next ? (const char*)g.A + (size_t)nxt.pm * tstep : cA; const char* nB = has_next ? (const char*)g.Bt + (size_t)nxt.pn * tstep : cB;
        for (int t = 0; t < nt; t += 2) {
            const bool last = (t == nt - 2);
            const char* a1 = cA + (size_t)(t + 1) * kstep;
            const char* a2 = last ? nA : cA + (size_t)(t + 2) * kstep; const char* b2 = last ? nB : cB + (size_t)(t + 2) * kstep;
            const char* a3 = a2 + kstep; const char* b3 = b2 + kstep;
            if (last && has_next) S.a_ready(nxt);
            if constexpr (SP2) {
            PG8_LDB(B0, 0, 0); PG8_LDB(B1, 0, 1); PG8_SCHED; PG8_LDA(At, 0, 0); PG8_STAGE(PG8_SA(1, 1), a1 + hstep, voffA);
            PG8_WAIT_V(8); PG8_WAIT_L(0); PG8_BAR; PG8_MMA(0, 0, At, B0); PG8_MMA(0, 1, At, B1); PG8_BAR; PG8_SCHED;
            PG8_LDA(At, 0, 1); PG8_STAGE(PG8_SB(0, 0), b2, voffB); PG8_STAGE(PG8_SB(0, 1), b2 + hstep, voffB); PG8_STAGE(PG8_SA(0, 0), a2, voffA);
            PG8_WAIT_V(8); PG8_WAIT_L(0); PG8_BAR; PG8_MMA(1, 0, At, B0); PG8_MMA(1, 1, At, B1); PG8_BAR; PG8_SCHED;
            PG8_LDB(B0, 1, 0); PG8_LDB(B1, 1, 1); PG8_SCHED; PG8_LDA(At, 1, 0); PG8_STAGE(PG8_SA(0, 1), a2 + hstep, voffA);
            PG8_WAIT_V(8); PG8_WAIT_L(0); PG8_BAR; PG8_MMA(0, 0, At, B0); PG8_MMA(0, 1, At, B1); PG8_BAR; PG8_SCHED;
            PG8_LDA(At, 1, 1); PG8_STAGE(PG8_SB(1, 0), b3, voffB); PG8_STAGE(PG8_SB(1, 1), b3 + hstep, voffB); PG8_STAGE(PG8_SA(1, 0), a3, voffA);
            PG8_WAIT_V(8); PG8_WAIT_L(0); PG8_BAR; PG8_MMA(1, 0, At, B0); PG8_MMA(1, 1, At, B1); PG8_BAR; PG8_SCHED;
            } else {
            PG8_LDB(B0, 0, 0); PG8_SCHED; PG8_LDA(At, 0, 0); PG8_STAGE(PG8_SA(1, 1), a1 + hstep, voffA);
            PG8_WAIT_L(8); PG8_BAR; PG8_WAIT_L(0); PG8_MMA(0, 0, At, B0); PG8_BAR; PG8_SCHED;
            PG8_LDB(B1, 0, 1); PG8_STAGE(PG8_SB(0, 0), b2, voffB);
            PG8_BAR; PG8_WAIT_L(0); PG8_MMA(0, 1, At, B1); PG8_BAR;
            PG8_LDA(At, 0, 1); PG8_STAGE(PG8_SA(0, 0), a2, voffA);
            PG8_BAR; PG8_WAIT_L(0); PG8_MMA(1, 0, At, B0); PG8_BAR; PG8_SCHED;
            PG8_STAGE(PG8_SB(0, 1), b2 + hstep, voffB);
            PG8_WAIT_V(6); PG8_BAR; PG8_MMA(1, 1, At, B1); PG8_BAR;
            PG8_LDB(B0, 1, 0); PG8_SCHED; PG8_LDA(At, 1, 0); PG8_STAGE(PG8_SA(0, 1), a2 + hstep, voffA);
            PG8_WAIT_L(8); PG8_BAR; PG8_WAIT_L(0); PG8_MMA(0, 0, At, B0); PG8_BAR; PG8_SCHED;
            PG8_LDB(B1, 1, 1); PG8_STAGE(PG8_SB(1, 0), b3, voffB);
            PG8_BAR; PG8_WAIT_L(0); PG8_MMA(0, 1, At, B1); PG8_BAR;
            PG8_LDA(At, 1, 1); PG8_STAGE(PG8_SA(1, 0), a3, voffA);
            PG8_BAR; PG8_WAIT_L(0); PG8_MMA(1, 0, At, B0); PG8_BAR; PG8_SCHED;
            PG8_STAGE(PG8_SB(1, 1), b3 + hstep, voffB);
            PG8_WAIT_V(6); PG8_BAR; PG8_MMA(1, 1, At, B1); PG8_BAR;
            }
        }
        if constexpr (ALIGN_EPI) { if (wr == 0) PG8_BAR; }
        if constexpr (!Epi::AFTER_DRAIN) { E(acc, cur, wr, wc, fr, fq); S.done(cur); }
        if (!has_next) break;
#pragma unroll
        for (int a = 0; a < 2; ++a)
#pragma unroll
            for (int b = 0; b < 2; ++b)
#pragma unroll
                for (int m = 0; m < 4; ++m)
#pragma unroll
                    for (int n = 0; n < 2; ++n) acc[a][b][m][n] = (f32x4){0.f, 0.f, 0.f, 0.f};
        cur = nxt; cA = nA; cB = nB; ++ui;
        if constexpr (ALIGN_EPI) { if (wr == 1) PG8_BAR; }
    }
    PG8_WAIT_V(0);
    if constexpr (!ALIGN_EPI) { if (wr == 0) PG8_BAR; }
    PG8_BAR;
    if constexpr (Epi::AFTER_DRAIN) { E.fused(acc, cur, wr, wc, fr, fq, lds, wid, lane); S.done(cur); }
#undef PG8_SA
#undef PG8_SB
#undef PG8_STAGE
#undef PG8_LDA
#undef PG8_LDB
#undef PG8_MMA
#undef PG8_WAIT_V
#undef PG8_WAIT_L
#undef PG8_BAR
#undef PG8_SCHED
}
}

namespace pg8 {
__host__ __device__ __forceinline__ int permk(int kl) { return 8 * ((kl & 15) >> 2) + 4 * (kl >> 4) + (kl & 3); }
struct EpiBf16Rs {
    static constexpr bool PERM = true, AFTER_DRAIN = false;
    bf16_t* O0; int ld0; int ntile0; bf16_t* O1; int ld1; size_t stride1; const float* ssq; float cs;
    __device__ __forceinline__ void operator()(const f32x4 (&acc)[2][2][4][2], const Unit& u, int wr, int wc, int fr, int fq) const {
        bf16_t* base; int ld, colt;
        if (u.pn < ntile0) { base = O0; ld = ld0; colt = u.pn * BM; }
        else { const int q = u.pn - ntile0, per = ld1 / BM; base = O1 + (size_t)(q / per) * stride1; ld = ld1; colt = (q % per) * BM; }
        const int row0 = u.pm * BM + wr * 64 + fr, col0 = colt + wc * 32 + 8 * fq;
#pragma unroll
        for (int ai = 0; ai < 2; ++ai)
#pragma unroll
            for (int m = 0; m < 4; ++m) {
                const int row = row0 + ai * HALF + m * 16;
                float sc = cs; if (ssq) sc *= rsqrtf(ssq[row] * (1.0f / 1024.0f) + 1e-6f);
                bf16_t* rowp = base + (size_t)row * ld + col0;
#pragma unroll
                for (int bj = 0; bj < 2; ++bj) { const f32x4 v0 = acc[ai][bj][m][0] * sc, v1 = acc[ai][bj][m][1] * sc;
                    u32x4 w; w.x = cvt_pk_bf16(v0[0], v0[1]); w.y = cvt_pk_bf16(v0[2], v0[3]); w.z = cvt_pk_bf16(v1[0], v1[1]); w.w = cvt_pk_bf16(v1[2], v1[3]);
                    *(u32x4*)(rowp + bj * HALF) = w; } }
    }
};
struct EpiF16Rs {
    static constexpr bool PERM = true, AFTER_DRAIN = false;
    _Float16* O; int ld; const float* ssq;
    __device__ __forceinline__ void operator()(const f32x4 (&acc)[2][2][4][2], const Unit& u, int wr, int wc, int fr, int fq) const {
        typedef _Float16 f16x8 __attribute__((ext_vector_type(8)));
        const int row0 = u.pm * BM + wr * 64 + fr, col0 = u.pn * BM + wc * 32 + 8 * fq;
#pragma unroll
        for (int ai = 0; ai < 2; ++ai)
#pragma unroll
            for (int m = 0; m < 4; ++m) {
                const int row = row0 + ai * HALF + m * 16;
                const float sc = rsqrtf(ssq[row] * (1.0f / 1024.0f) + 1e-6f);
                _Float16* rowp = O + (size_t)row * ld + col0;
#pragma unroll
                for (int bj = 0; bj < 2; ++bj) { const f32x4 v0 = acc[ai][bj][m][0] * sc, v1 = acc[ai][bj][m][1] * sc;
                    f16x8 w; w[0] = (_Float16)v0[0]; w[1] = (_Float16)v0[1]; w[2] = (_Float16)v0[2]; w[3] = (_Float16)v0[3];
                    w[4] = (_Float16)v1[0]; w[5] = (_Float16)v1[1]; w[6] = (_Float16)v1[2]; w[7] = (_Float16)v1[3];
                    *(f16x8*)(rowp + bj * HALF) = w; } }
    }
};
struct EpiResid {
    static constexpr bool PERM = false, AFTER_DRAIN = false;
    const float* base; float* out; bf16_t* xb; float* ssq;
    __device__ __forceinline__ void operator()(const f32x4 (&acc)[2][2][4][2], const Unit& u, int wr, int wc, int fr, int fq) const {
        typedef unsigned u32x2v __attribute__((ext_vector_type(2)));
        const int row0 = u.pm * BM + wr * 64 + fr, col0 = u.pn * BM + wc * 32 + 4 * fq;
#pragma unroll
        for (int ai = 0; ai < 2; ++ai)
#pragma unroll
            for (int m = 0; m < 4; ++m) {
                const int row = row0 + ai * HALF + m * 16; const size_t off = (size_t)row * 1024 + col0; float s = 0.f;
#pragma unroll
                for (int bj = 0; bj < 2; ++bj)
#pragma unroll
                    for (int n = 0; n < 2; ++n) { const size_t o2 = off + bj * HALF + n * 16;
                        const f32x4 o = *(const f32x4*)(base + o2) + acc[ai][bj][m][n];
                        *(f32x4*)(out + o2) = o; s += (o[0] * o[0] + o[1] * o[1]) + (o[2] * o[2] + o[3] * o[3]);
                        u32x2v w; w.x = cvt_pk_bf16(o[0], o[1]); w.y = cvt_pk_bf16(o[2], o[3]); *(u32x2v*)(xb + o2) = w; }
                s += __shfl_xor(s, 16); s += __shfl_xor(s, 32);
                if (fq == 0) atomicAdd(ssq + row, s);
            }
    }
};
struct EpiKV {
    static constexpr bool PERM = false, AFTER_DRAIN = false;
    bf16_t* Kb; bf16_t* VTp;
    __device__ __forceinline__ void operator()(const f32x4 (&acc)[2][2][4][2], const Unit& u, int wr, int wc, int fr, int fq) const {
        typedef unsigned u32x2v __attribute__((ext_vector_type(2)));
        const int row0 = u.pm * BM + wr * 64 + fr, col0 = u.pn * BM + wc * 32 + 4 * fq;
#pragma unroll
        for (int ai = 0; ai < 2; ++ai)
#pragma unroll
            for (int m = 0; m < 4; ++m) {
                const int row = row0 + ai * HALF + m * 16, b = row >> 8, key = row & 255;
#pragma unroll
                for (int bj = 0; bj < 2; ++bj)
#pragma unroll
                    for (int n = 0; n < 2; ++n) { const int col = col0 + bj * HALF + n * 16; const f32x4 v = acc[ai][bj][m][n];
                        const unsigned p01 = cvt_pk_bf16(v[0], v[1]), p23 = cvt_pk_bf16(v[2], v[3]);
                        if (col < 1024) { const int h = col >> 8, dh = col & 255; u32x2v w; w.x = p01; w.y = p23;
                            *(u32x2v*)(Kb + ((size_t)((b * 4 + h) * 256 + key)) * 256 + dh) = w; }
                        else { const int c2 = col - 1024, h = c2 >> 8, dv = c2 & 255, kp = (key & ~31) | permk(key & 31);
                            bf16_t* d = VTp + ((size_t)((b * 4 + h) * 256 + dv)) * 256 + kp;
                            d[0] = (bf16_t)(p01 & 0xffffu); d[256] = (bf16_t)(p01 >> 16); d[512] = (bf16_t)(p23 & 0xffffu); d[768] = (bf16_t)(p23 >> 16); } }
            }
    }
};
}
#ifndef PG8_SP2
#define PG8_SP2 true
#endif
#ifndef PG8_ALIGN
#define PG8_ALIGN true
#endif

constexpr int NWAVES = 8;
#ifndef MK_PER_PHASE
#define MK_PER_PHASE 0
#endif
constexpr int T = 16384, SEQ = 8192, D = 1024;
constexpr int N_PHASES = 12;

constexpr size_t MiB = 1u << 20, KiB = 1u << 10;
constexpr size_t WS_CTL = 0, CTL_ZERO_BYTES = 1 * MiB;
constexpr int CW_BAR = 4096;
constexpr size_t WS_SSQ1 = 64 * KiB, WS_SSQ2 = 128 * KiB;
constexpr size_t WS_AB = 1 * MiB;
constexpr size_t WS_HEND = WS_AB + 512 * KiB, WS_PEND = WS_HEND + 512 * KiB, WS_HIN = WS_PEND + 512 * KiB;
constexpr size_t WS_DEC = WS_HIN + 512 * KiB;
constexpr size_t WS_SUBK = 3 * MiB + 256 * KiB;
constexpr size_t WS_WIN = 4 * MiB, WS_WOUT = 10 * MiB, WS_WQ = 12 * MiB, WS_WKV = 14 * MiB, WS_WO = 18 * MiB, WS_PWQ = 20 * MiB;
constexpr size_t WS_MEMN = 24 * MiB, WS_KB = 25 * MiB, WS_VTP = 26 * MiB, WS_LRUWT = 27 * MiB, WS_USC = 27 * MiB + 256 * KiB, WS_VSC = 27 * MiB + 384 * KiB;
constexpr size_t WS_XB = 28 * MiB;
constexpr size_t WS_HLOC = 28 * MiB, WS_PCUM = 44 * MiB;
constexpr size_t WS_QKV = 60 * MiB;
constexpr size_t WS_Y = 60 * MiB;
constexpr size_t WS_IDX = 60 * MiB, WS_GW = 68 * MiB;
constexpr size_t WS_UB = 92 * MiB;
constexpr size_t WS_XR = 108 * MiB, WS_Z = 124 * MiB, WS_GATE = 140 * MiB;
constexpr size_t WS_WN = 156 * MiB, WS_UF = 172 * MiB, WS_QD = 188 * MiB, WS_KD = 204 * MiB, WS_ATT = 220 * MiB;
constexpr size_t WS_VB = 228 * MiB;
constexpr size_t WS_Q = 188 * MiB, WS_AO = 124 * MiB;
constexpr size_t WS_PQ = 108 * MiB;
constexpr size_t WS_END = 244 * MiB;
constexpr int CW_LRUCNT = 8192;
static_assert(WS_XR - WS_QKV == (size_t)T * 1536 * 2 && WS_Z - WS_XR == (size_t)T * 512 * 2 && WS_GATE - WS_Z == (size_t)T * 512 * 2, "in-proj outputs are contiguous");

constexpr int LDS_BYTES = 160 * 1024;
constexpr int MISC_OFF = 159 * 1024;

#define GAS __attribute__((address_space(1)))
#define LAS __attribute__((address_space(3)))
typedef unsigned short bf16;
typedef unsigned v4u __attribute__((ext_vector_type(4)));
typedef unsigned v2u __attribute__((ext_vector_type(2)));
typedef float f32x4 __attribute__((ext_vector_type(4)));
typedef short bf16x8 __attribute__((ext_vector_type(8)));
typedef GAS unsigned gu32;
#define LDS_WAIT() asm volatile("s_waitcnt lgkmcnt(0)" ::: "memory")
__device__ __forceinline__ unsigned f2bf(float f) { unsigned u = __builtin_bit_cast(unsigned, f); return (u + 0x7fffu + ((u >> 16) & 1u)) >> 16; }
__device__ __forceinline__ unsigned pk2(float lo, float hi) { return f2bf(lo) | (f2bf(hi) << 16); }
__device__ __forceinline__ float bflo(unsigned u) { return __builtin_bit_cast(float, u << 16); }
__device__ __forceinline__ float bfhi(unsigned u) { return __builtin_bit_cast(float, u & 0xffff0000u); }
__device__ __forceinline__ float bf1(bf16 h) { return __builtin_bit_cast(float, (unsigned)h << 16); }
__device__ __forceinline__ float wave_sum(float v) {
#pragma unroll
    for (int o = 1; o < 64; o <<= 1) v += __shfl_xor(v, o);
    return v;
}
__device__ __forceinline__ float row16_sum(float v) {
    v += __builtin_bit_cast(float, __builtin_amdgcn_update_dpp(0, __builtin_bit_cast(int, v), 0xB1, 0xF, 0xF, true));
    v += __builtin_bit_cast(float, __builtin_amdgcn_update_dpp(0, __builtin_bit_cast(int, v), 0x4E, 0xF, 0xF, true));
    v += __builtin_bit_cast(float, __builtin_amdgcn_update_dpp(0, __builtin_bit_cast(int, v), 0x141, 0xF, 0xF, true));
    v += __builtin_bit_cast(float, __builtin_amdgcn_update_dpp(0, __builtin_bit_cast(int, v), 0x140, 0xF, 0xF, true));
    return v;
}
__device__ __forceinline__ float sigmoidf_(float x) { return __builtin_amdgcn_rcpf(1.0f + __expf(-x)); }
__device__ __forceinline__ float softplusf_(float x) { return fmaxf(x, 0.f) + log1pf(__expf(-fabsf(x))); }
__device__ __forceinline__ float siluf_(float x) { return x * __builtin_amdgcn_rcpf(1.0f + __expf(-x)); }
__device__ __forceinline__ float gelu_tanh(float x) { const float y = 0.7978845608028654f * (x + 0.044715f * x * x * x); const float e = __expf(2.0f * y); return x * (1.0f - __builtin_amdgcn_rcpf(1.0f + e)); }
__device__ __forceinline__ int permk(int kl) { return 8 * ((kl & 15) >> 2) + 4 * (kl >> 4) + (kl & 3); }

struct Params {
    const float *x, *mem, *norm_mix_w, *w_in, *conv_qkv_w, *gdn_a_log, *gdn_dt_bias, *gdn_norm_w, *lru_conv_w, *lru_conv_b, *lru_wa, *lru_ba, *lru_wx, *lru_bx, *lru_lambda, *w_out,
                *norm_xattn_w, *norm_mem_w, *xattn_wq, *xattn_wkv, *xattn_wo, *norm_ffn_w, *peer_wq, *peer_subkeys, *peer_u, *peer_v, *norm_final_w;
    float* out; unsigned char* ws; int ph_lo, ph_hi;
};
#define XB_TMO      128
#define XB_XCNT(j)  (256  + 64 * (j))
#define XB_XSUB(j)  (1280 + 64 * (j))
#define XB_XGEN(j)  (2304 + 64 * (j))
#define XB_TOP      3328
#define XB_TOPGEN   3392
#define XCD_BAR_WORDS 3456
#define XB_SPIN_CAP (1u << 18)

__device__ __forceinline__ unsigned xb_ld(unsigned* p)              { return __hip_atomic_load(p, __ATOMIC_RELAXED, __HIP_MEMORY_SCOPE_AGENT); }
__device__ __forceinline__ unsigned xb_add(unsigned* p, unsigned v) { return __hip_atomic_fetch_add(p, v, __ATOMIC_RELAXED, __HIP_MEMORY_SCOPE_AGENT); }
__device__ __forceinline__ unsigned xb_xcc_id() { return (unsigned)__builtin_amdgcn_s_getreg((3 << 11) | 20) & 0xFu; }
#define XB_SPIN(cond, bar) do { unsigned _sp = 0; while (cond) { __builtin_amdgcn_s_sleep(1); \
    if ((++_sp & 255u) == 0u) { if (xb_ld(&(bar)[XB_TMO])) break; if (_sp > XB_SPIN_CAP) { atomicAdd(&(bar)[XB_TMO], 1u); break; } } } } while (0)

struct XcdBarrier {
    unsigned* bar; unsigned x;
    volatile LAS unsigned* st;
};

__device__ __forceinline__ XcdBarrier xcd_barrier_post(unsigned* bar, volatile LAS unsigned* st) {
    XcdBarrier b; b.bar = bar; b.x = xb_xcc_id(); b.st = st;
    if (threadIdx.x == 0) (void)xb_add(&bar[XB_XCNT(b.x)], 1u);
    return b;
}
__device__ __forceinline__ void xcd_barrier_complete(unsigned* bar, unsigned x, unsigned& nloc, unsigned& nx) {
    const unsigned G = gridDim.x * gridDim.y * gridDim.z;
    unsigned sum, cnt, mine, sp = 0u;
    for (;;) {
        sum = 0u; cnt = 0u; mine = 0u;
#pragma unroll
        for (unsigned j = 0; j < 16; ++j) { const unsigned c = xb_ld(&bar[XB_XCNT(j)]); sum += c; cnt += (c > 0u) ? 1u : 0u; mine = (j == x) ? c : mine; }
        if (sum == G) break;
        __builtin_amdgcn_s_sleep(1);
        if ((++sp & 255u) == 0u) { if (xb_ld(&bar[XB_TMO])) break; if (sp > XB_SPIN_CAP) { atomicAdd(&bar[XB_TMO], 1u); break; } }
    }
    nloc = mine > 0u ? mine : 1u; nx = cnt > 0u ? cnt : 1u;
}

__device__ __forceinline__ void xcd_barrier(const XcdBarrier& b) {
    asm volatile("s_waitcnt vmcnt(0)" ::: "memory");
    __syncthreads();
    if (threadIdx.x == 0) {
        unsigned* bar = b.bar;
        __builtin_amdgcn_s_waitcnt(0);
        unsigned nloc = b.st[0], nx = b.st[1];
        if (nloc == 0u) { xcd_barrier_complete(bar, b.x, nloc, nx); b.st[0] = nloc; b.st[1] = nx; }
        const unsigned old = xb_add(&bar[XB_XSUB(b.x)], 1u);
        const unsigned gen = old / nloc;
        if (old + 1u == (gen + 1u) * nloc) {
            __builtin_amdgcn_fence(__ATOMIC_RELEASE, "agent");
            asm volatile("s_waitcnt vmcnt(0)" ::: "memory");
            const unsigned og = xb_add(&bar[XB_TOP], 1u);
            const unsigned tg = og / nx;
            if (og + 1u == (tg + 1u) * nx) xb_add(&bar[XB_TOPGEN], 1u);
            else XB_SPIN(xb_ld(&bar[XB_TOPGEN]) == tg, bar);
            __builtin_amdgcn_fence(__ATOMIC_ACQUIRE, "agent");
            xb_add(&bar[XB_XGEN(b.x)], 1u);
            asm volatile("s_waitcnt vmcnt(0)" ::: "memory");
        } else {
            XB_SPIN(xb_ld(&bar[XB_XGEN(b.x)]) == gen, bar);
            __builtin_amdgcn_fence(__ATOMIC_ACQUIRE, "agent");
            asm volatile("s_waitcnt vmcnt(0)" ::: "memory");
        }
    }
    __syncthreads();
}

__device__ __forceinline__ void p0_transpose_item(const float* W, int K, int ldw, int c0, int nblk, bf16* WT, int row_off, const float* ks, LAS float* scr, int item, int lane) {
    const int kb = item / nblk, nb = item % nblk, k0 = 64 * kb, n0 = 32 * nb;
#pragma unroll 8
    for (int i = 0; i < 32; ++i) { const int kk = 2 * i + (lane >> 5); float v = W[(size_t)(k0 + kk) * ldw + c0 + n0 + (lane & 31)]; if (ks) v *= ks[k0 + kk]; scr[kk * 33 + (lane & 31)] = v; }
    LDS_WAIT(); asm volatile("" ::: "memory");
    const int c = lane & 7;
#pragma unroll
    for (int j = 0; j < 4; ++j) { const int n = (lane >> 3) + 8 * j; const LAS float* s = scr + (8 * c) * 33 + n;
        v4u o; o.x = pk2(s[0 * 33], s[1 * 33]); o.y = pk2(s[2 * 33], s[3 * 33]); o.z = pk2(s[4 * 33], s[5 * 33]); o.w = pk2(s[6 * 33], s[7 * 33]);
        *(GAS v4u*)(WT + (size_t)(row_off + n0 + n) * K + k0 + 8 * c) = o; }
    LDS_WAIT(); asm volatile("" ::: "memory");
}

__device__ __forceinline__ void p0_prologue(const Params& P, LAS unsigned char* lds, int tid, int lane, int wave, int vcu, int G) {
    unsigned char* ws = P.ws;
    const int gw = vcu * NWAVES + wave, NGW = G * NWAVES;
    LAS float* wabl = (LAS float*)lds;
    for (int idx = tid; idx < 8192; idx += NWAVES * 64) { const int k = idx >> 3, c = idx & 7, j = k >> 8, l = (k >> 2) & 63, e = k & 3;
        wabl[((((j * 4 + e) * 2 + (c >> 2)) * 64 + l) << 2) + (c & 3)] = P.w_in[(size_t)k * 3080 + 2048 + c]; }
    __syncthreads();
    {
        bf16* XB0 = (bf16*)(ws + WS_XB); float* AB = (float*)(ws + WS_AB);
        f32x4 w4[4];
#pragma unroll
        for (int j = 0; j < 4; ++j) w4[j] = ((const f32x4*)P.norm_mix_w)[64 * j + lane];
        for (int m = gw; m < T; m += NGW) {
            const f32x4* xr = (const f32x4*)(P.x + (size_t)m * D) + lane;
            f32x4 v[4]; float s = 0.f;
#pragma unroll
            for (int j = 0; j < 4; ++j) { v[j] = xr[64 * j]; s += (v[j].x * v[j].x + v[j].y * v[j].y) + (v[j].z * v[j].z + v[j].w * v[j].w); }
            const float rstd = rsqrtf(wave_sum(s) * (1.0f / D) + 1e-6f);
            v2u* o8 = (v2u*)(XB0 + (size_t)m * D) + lane;
            float part[8];
#pragma unroll
            for (int c = 0; c < 8; ++c) part[c] = 0.f;
#pragma unroll
            for (int j = 0; j < 4; ++j) {
                v[j] = v[j] * rstd * w4[j];
                v2u o; o.x = pk2(v[j].x, v[j].y); o.y = pk2(v[j].z, v[j].w); o8[64 * j] = o;
#pragma unroll
                for (int e = 0; e < 4; ++e) {
                    const f32x4 wa = *(const LAS f32x4*)(wabl + ((((j * 4 + e) * 2 + 0) * 64 + lane) << 2));
                    const f32x4 wb = *(const LAS f32x4*)(wabl + ((((j * 4 + e) * 2 + 1) * 64 + lane) << 2));
                    const float hv = v[j][e];
                    part[0] += hv * wa.x; part[1] += hv * wa.y; part[2] += hv * wa.z; part[3] += hv * wa.w;
                    part[4] += hv * wb.x; part[5] += hv * wb.y; part[6] += hv * wb.z; part[7] += hv * wb.w;
                }
            }
#pragma unroll
            for (int c = 0; c < 8; ++c) part[c] = wave_sum(part[c]);
            float o = part[0];
#pragma unroll
            for (int c = 1; c < 8; ++c) o = (lane == c) ? part[c] : o;
            if (lane < 8) AB[(size_t)m * 8 + lane] = o;
        }
    }
    {
        bf16* MEMN = (bf16*)(ws + WS_MEMN);
        for (int m = gw; m < 512; m += NGW) {
            const f32x4* xr = (const f32x4*)(P.mem + (size_t)m * D) + lane;
            f32x4 v[4]; float s = 0.f;
#pragma unroll
            for (int j = 0; j < 4; ++j) { v[j] = xr[64 * j]; s += (v[j].x * v[j].x + v[j].y * v[j].y) + (v[j].z * v[j].z + v[j].w * v[j].w); }
            const float rstd = rsqrtf(wave_sum(s) * (1.0f / D) + 1e-6f);
            v2u* o8 = (v2u*)(MEMN + (size_t)m * D) + lane;
#pragma unroll
            for (int j = 0; j < 4; ++j) { const f32x4 w = ((const f32x4*)P.norm_mem_w)[64 * j + lane]; const f32x4 y = v[j] * rstd * w;
                v2u o; o.x = pk2(y.x, y.y); o.y = pk2(y.z, y.w); o8[64 * j] = o; }
        }
    }
    __syncthreads();
    {
        LAS float* scr = (LAS float*)(lds + wave * 16384);
        constexpr int I_IN1 = 16 * 48, I_IN2 = 16 * 16, I_KV = 16 * 64;
        constexpr int NITEMS = I_IN1 + 3 * I_IN2 + I_KV;
        for (int it = gw; it < NITEMS; it += NGW) {
            int r = it;
            if (r < I_IN1) { p0_transpose_item(P.w_in, 1024, 3080, 0, 48, (bf16*)(ws + WS_WIN), 0, nullptr, scr, r, lane); continue; } r -= I_IN1;
            if (r < I_IN2) { p0_transpose_item(P.w_in, 1024, 3080, 2056, 16, (bf16*)(ws + WS_WIN), 1536, nullptr, scr, r, lane); continue; } r -= I_IN2;
            if (r < I_IN2) { p0_transpose_item(P.w_in, 1024, 3080, 1536, 16, (bf16*)(ws + WS_WIN), 2048, nullptr, scr, r, lane); continue; } r -= I_IN2;
            if (r < I_IN2) { p0_transpose_item(P.w_in, 1024, 3080, 2568, 16, (bf16*)(ws + WS_WIN), 2560, nullptr, scr, r, lane); continue; } r -= I_IN2;
            p0_transpose_item(P.xattn_wkv, 1024, 2048, 0, 64, (bf16*)(ws + WS_WKV), 0, nullptr, scr, r, lane);
        }
    }
    {
        bf16* WT = (bf16*)(ws + WS_LRUWT);
        for (int it = vcu * NWAVES * 64 + tid; it < 8 * 2 * 64 * 8; it += G * NWAVES * 64) {
            const int i8 = it & 7, j = (it >> 3) & 63, m = (it >> 9) & 1, g = it >> 10;
            const float* src = (m ? P.lru_wx : P.lru_wa) + (size_t)(g * 64 + 8 * i8) * 64 + j;
            v4u o; o.x = pk2(src[0], src[64]); o.y = pk2(src[128], src[192]); o.z = pk2(src[256], src[320]); o.w = pk2(src[384], src[448]);
            *(v4u*)(WT + (size_t)it * 8) = o;
        }
    }
}

__device__ __forceinline__ void late_weight_prep(const Params& P, LAS unsigned char* lds, int lane, int wave, int gw, int NGW) {
    unsigned char* ws = P.ws;
    {
        LAS float* scr = (LAS float*)(lds + wave * 16384);
        constexpr int I_OUT = 16 * 32, I_Q = 16 * 32, I_O = 16 * 32;
        for (int it = gw; it < I_OUT + I_Q + I_O; it += NGW) {
            int r = it;
            if (r < I_OUT) { p0_transpose_item(P.w_out, 1024, 1024, 0, 32, (bf16*)(ws + WS_WOUT), 0, nullptr, scr, r, lane); continue; } r -= I_OUT;
            if (r < I_Q) { p0_transpose_item(P.xattn_wq, 1024, 1024, 0, 32, (bf16*)(ws + WS_WQ), 0, P.norm_xattn_w, scr, r, lane); continue; } r -= I_Q;
            p0_transpose_item(P.xattn_wo, 1024, 1024, 0, 32, (bf16*)(ws + WS_WO), 0, nullptr, scr, r, lane);
        }
    }
    {
        bf16* WF = (bf16*)(ws + WS_PWQ);
        const int col = lane & 15, g = lane >> 4;
        for (int it = gw; it < 16 * 64; it += NGW) {
            const int hp = it >> 6, k0 = (it & 63) * 16;
            bf16x8 bq[4];
#pragma unroll
            for (int s = 0; s < 4; ++s) { const f32x4* src = (const f32x4*)(P.peer_wq + (size_t)(k0 + col) * 2048 + hp * 128 + 32 * s + 8 * g);
                const f32x4 a = src[0], c = src[1]; v4u pk; pk.x = pk2(a.x, a.y); pk.y = pk2(a.z, a.w); pk.z = pk2(c.x, c.y); pk.w = pk2(c.z, c.w); bq[s] = __builtin_bit_cast(bf16x8, pk); }
            const float nw = P.norm_ffn_w[k0 + col];
#pragma unroll 2
            for (int kt = 0; kt < 8; ++kt) {
                f32x4 acc = (f32x4){0.f, 0.f, 0.f, 0.f};
#pragma unroll
                for (int s = 0; s < 4; ++s) { const f32x4* src = (const f32x4*)(P.peer_subkeys + (size_t)(hp * 128 + 16 * kt + col) * 128 + 32 * s + 8 * g);
                    const f32x4 a = src[0], c = src[1]; v4u pk; pk.x = pk2(a.x, a.y); pk.y = pk2(a.z, a.w); pk.z = pk2(c.x, c.y); pk.w = pk2(c.z, c.w);
                    acc = __builtin_amdgcn_mfma_f32_16x16x32_bf16(__builtin_bit_cast(bf16x8, pk), bq[s], acc, 0, 0, 0); }
#pragma unroll
                for (int i = 0; i < 4; ++i) WF[(size_t)(hp * 128 + 16 * kt + 4 * g + i) * 1024 + k0 + col] = (bf16)f2bf(acc[i] * nw);
            }
        }
    }
}

constexpr int GL_KS = 0, GL_VS = 33792, GL_KB = 67584, GL_QB = 84992, GL_RAW = 102400, GL_CW = 153856, GL_AMT = 133120, GL_SM = 160000, GL_ATT = 151808, GL_SOL = 67584;
static_assert(GL_CW + 6144 <= GL_SM && GL_SM + 1280 <= MISC_OFF && GL_SOL + 65536 <= GL_AMT && GL_AMT + 17408 <= GL_ATT && GL_ATT + 8192 <= GL_SM && GL_RAW + 51456 <= GL_CW, "gdn_local LDS map");
#ifndef GL_REP_STEP
#define GL_REP_STEP -1
#endif
#define GL_REPF(k) for (int rr_ = 0; rr_ < ((GL_REP_STEP == (k)) ? 2 : 1); ++rr_)
#define GL_BAR() do { asm volatile("s_waitcnt lgkmcnt(0)" ::: "memory"); __builtin_amdgcn_s_barrier(); asm volatile("" ::: "memory"); } while (0)
__device__ __forceinline__ void gdn_local_item(const Params& P, LAS unsigned char* lds, int item, int tid) {
    unsigned char* ws = P.ws;
    asm volatile("" : "+v"(tid));
    const int b = item >> 9, h = (item >> 7) & 3, n = item & 127;
    const int t0 = b * SEQ + n * 64;
    const int lane = tid & 63, wave = __builtin_amdgcn_readfirstlane(tid >> 6);
    LAS float* ks = (LAS float*)(lds + GL_KS);
    LAS float* vs = (LAS float*)(lds + GL_VS);
    LAS bf16* kb16 = (LAS bf16*)(lds + GL_KB);
    LAS bf16* qb16 = (LAS bf16*)(lds + GL_QB);
    LAS bf16* raw = (LAS bf16*)(lds + GL_RAW);
    LAS float* cw = (LAS float*)(lds + GL_CW);
    LAS float* AmT = (LAS float*)(lds + GL_AMT);
    LAS float* sg = (LAS float*)(lds + GL_SM);
    LAS float* sbeta = sg + 64; LAS float* sgc = sbeta + 64; LAS float* seg = sgc + 64; LAS float* sek = seg + 64;
    LAS bf16* atts = (LAS bf16*)(lds + GL_ATT);
    const bf16* QKV = (const bf16*)(ws + WS_QKV);
    const float* AB = (const float*)(ws + WS_AB);
    GL_REPF(0) {
        v4u pr[7];
#pragma unroll
        for (int r = 0; r < 7; ++r) {
            const int id = tid + 512 * r;
            const int row = id / 48, rem = id - row * 48, part = rem >> 4, ck = rem & 15, s = n * 64 + row - 3;
            pr[r] = (v4u){0u, 0u, 0u, 0u};
            if (id < 67 * 48 && s >= 0) pr[r] = *(const v4u*)(QKV + (size_t)(b * SEQ + s) * 1536 + part * 512 + h * 128 + ck * 8);
        }
        f32x4 cwv = (f32x4){0.f, 0.f, 0.f, 0.f};
        if (tid < 384) { const int j = tid / 96, rem = tid - j * 96, part = rem >> 5, c4 = rem & 31; cwv = *(const f32x4*)(P.conv_qkv_w + j * 1536 + part * 512 + h * 128 + c4 * 4); }
        float a_in = 0.f, b_in = 0.f;
        if (tid < 64) { a_in = AB[(size_t)(t0 + tid) * 8 + h]; b_in = AB[(size_t)(t0 + tid) * 8 + 4 + h]; }
#pragma unroll
        for (int r = 0; r < 7; ++r) { const int id = tid + 512 * r; if (id < 67 * 48) *(LAS v4u*)(raw + id * 8) = pr[r]; }
        if (tid < 384) *(LAS f32x4*)(cw + tid * 4) = cwv;
        if (tid < 64) { sg[tid] = -__expf(P.gdn_a_log[h]) * softplusf_(a_in + P.gdn_dt_bias[h]); sbeta[tid] = sigmoidf_(b_in); }
    }
    GL_BAR();
    GL_REPF(1) {
        const int c = tid >> 3, grp = tid & 7;
#pragma unroll 1
        for (int part = 0; part < 3; ++part) {
            float y[16];
#pragma unroll
            for (int i = 0; i < 16; ++i) y[i] = 0.f;
#pragma unroll
            for (int j = 0; j < 4; ++j) {
                const LAS v4u* src = (const LAS v4u*)(raw + (c + j) * 384 + part * 128 + grp * 16);
                const v4u x0 = src[0], x1 = src[1];
                const LAS f32x4* wp = (const LAS f32x4*)(cw + (j * 3 + part) * 128 + grp * 16);
                const f32x4 w0 = wp[0], w1 = wp[1], w2 = wp[2], w3 = wp[3];
                y[0] += w0.x * bflo(x0.x); y[1] += w0.y * bfhi(x0.x); y[2] += w0.z * bflo(x0.y); y[3] += w0.w * bfhi(x0.y);
                y[4] += w1.x * bflo(x0.z); y[5] += w1.y * bfhi(x0.z); y[6] += w1.z * bflo(x0.w); y[7] += w1.w * bfhi(x0.w);
                y[8] += w2.x * bflo(x1.x); y[9] += w2.y * bfhi(x1.x); y[10] += w2.z * bflo(x1.y); y[11] += w2.w * bfhi(x1.y);
                y[12] += w3.x * bflo(x1.z); y[13] += w3.y * bfhi(x1.z); y[14] += w3.z * bflo(x1.w); y[15] += w3.w * bfhi(x1.w);
            }
            float ss = 0.f;
#pragma unroll
            for (int i = 0; i < 16; ++i) { y[i] = siluf_(y[i]); ss += y[i] * y[i]; }
            if (part < 2) {
                ss += __shfl_xor(ss, 1); ss += __shfl_xor(ss, 2); ss += __shfl_xor(ss, 4);
                const float sc = rsqrtf(ss + 1e-6f) * (part == 0 ? 0.08838834764831845f : 1.0f);
#pragma unroll
                for (int i = 0; i < 16; ++i) y[i] *= sc;
            }
            if (part >= 1) {
                LAS float* dst = (part == 1 ? ks : vs) + c * 132 + grp * 16;
#pragma unroll
                for (int i = 0; i < 4; ++i) *(LAS f32x4*)(dst + 4 * i) = (f32x4){y[4 * i], y[4 * i + 1], y[4 * i + 2], y[4 * i + 3]};
            }
            if (part <= 1) {
                LAS bf16* dst = (part == 0 ? qb16 : kb16) + c * 136 + grp * 16;
                v4u o0, o1; o0.x = pk2(y[0], y[1]); o0.y = pk2(y[2], y[3]); o0.z = pk2(y[4], y[5]); o0.w = pk2(y[6], y[7]);
                o1.x = pk2(y[8], y[9]); o1.y = pk2(y[10], y[11]); o1.z = pk2(y[12], y[13]); o1.w = pk2(y[14], y[15]);
                *(LAS v4u*)dst = o0; *(LAS v4u*)(dst + 8) = o1;
            }
        }
    }
    if (tid < 64) {
        float v = sg[tid];
#pragma unroll
        for (int off = 1; off < 64; off <<= 1) { const float t = __shfl_up(v, off); if (tid >= off) v += t; }
        sgc[tid] = v; seg[tid] = __expf(v);
        const float gl = __shfl(v, 63);
        sek[tid] = __expf(gl - v);
        if (tid == 63) ((float*)(ws + WS_DEC))[item] = __expf(v);
    }
    GL_BAR();
    {
        const int mat = wave >> 2, rho = wave & 3, col = lane & 15, g = lane >> 4;
        const LAS bf16* X = mat ? qb16 : kb16;
        bf16x8 af[4];
#pragma unroll
        for (int s = 0; s < 4; ++s) af[s] = *(const LAS bf16x8*)(X + (16 * rho + col) * 136 + 32 * s + 8 * g);
#pragma unroll
        for (int sig = 0; sig < 4; ++sig) {
            f32x4 acc = (f32x4){0.f, 0.f, 0.f, 0.f};
#pragma unroll
            for (int s = 0; s < 4; ++s) { const bf16x8 bfr = *(const LAS bf16x8*)(kb16 + (16 * sig + col) * 136 + 32 * s + 8 * g); acc = __builtin_amdgcn_mfma_f32_16x16x32_bf16(af[s], bfr, acc, 0, 0, 0); }
            const int sidx = 16 * sig + col; const float gs = sgc[sidx];
#pragma unroll
            for (int i = 0; i < 4; ++i) {
                const int c = 16 * rho + 4 * g + i;
                const float dec = (c >= sidx) ? __expf(sgc[c] - gs) : 0.f;
                if (mat == 0) AmT[sidx * 68 + c] = (c > sidx) ? sbeta[c] * acc[i] * dec : 0.f;
                else atts[c * 64 + sidx] = (bf16)f2bf(acc[i] * dec);
            }
        }
    }
    GL_BAR();
    GL_REPF(4) {
        bf16* QD = (bf16*)(ws + WS_QD) + (size_t)item * 8192;
        bf16* KD = (bf16*)(ws + WS_KD) + (size_t)item * 8192;
        bf16* ATT = (bf16*)(ws + WS_ATT) + (size_t)item * 4096;
#pragma unroll
        for (int r = 0; r < 2; ++r) {
            const int id = tid + 512 * r;
            { const int c = id >> 4, gam = id & 15, s32 = gam >> 2, g = gam & 3;
              const v2u lo = *(const LAS v2u*)(qb16 + c * 136 + 32 * s32 + 4 * g), hi = *(const LAS v2u*)(qb16 + c * 136 + 32 * s32 + 16 + 4 * g);
              const float e = seg[c];
              v4u o; o.x = pk2(bflo(lo.x) * e, bfhi(lo.x) * e); o.y = pk2(bflo(lo.y) * e, bfhi(lo.y) * e); o.z = pk2(bflo(hi.x) * e, bfhi(hi.x) * e); o.w = pk2(bflo(hi.y) * e, bfhi(hi.y) * e);
              *(v4u*)(QD + c * 128 + 8 * gam) = o; }
            { const int dk = id >> 3, gam = id & 7, s32 = gam >> 2, g = gam & 3, c0 = 32 * s32 + 4 * g;
              float v[8];
#pragma unroll
              for (int j = 0; j < 4; ++j) { v[j] = ks[(c0 + j) * 132 + dk] * sek[c0 + j]; v[4 + j] = ks[(c0 + 16 + j) * 132 + dk] * sek[c0 + 16 + j]; }
              v4u o; o.x = pk2(v[0], v[1]); o.y = pk2(v[2], v[3]); o.z = pk2(v[4], v[5]); o.w = pk2(v[6], v[7]);
              *(v4u*)(KD + dk * 64 + 8 * gam) = o; }
        }
        { const int c = tid >> 3, gam = tid & 7, s32 = gam >> 2, g = gam & 3;
          const v2u lo = *(const LAS v2u*)(atts + c * 64 + 32 * s32 + 4 * g), hi = *(const LAS v2u*)(atts + c * 64 + 32 * s32 + 16 + 4 * g);
          v4u o; o.x = lo.x; o.y = lo.y; o.z = hi.x; o.w = hi.y;
          *(v4u*)(ATT + c * 64 + 8 * gam) = o; }
    }
    GL_BAR();
    GL_REPF(5) {
        LAS float* xcol = (LAS float*)(lds + GL_SOL);
        LAS bf16* tinv = (LAS bf16*)(lds + GL_SOL + 17408);
        const int j = tid >> 3, part = tid & 7, jb = j >> 4, jo = j & 15;
#pragma unroll 1
        for (int rb = jb; rb < 4; ++rb) {
            float acc[16];
#pragma unroll
            for (int i = 0; i < 16; ++i) acc[i] = 0.f;
            if (rb > jb) {
#pragma unroll 2
                for (int s = 16 * jb + part; s < 16 * rb; s += 8) {
                    const float sv = xcol[j * 68 + s];
                    const LAS float* ar = AmT + s * 68 + 16 * rb;
#pragma unroll
                    for (int q = 0; q < 4; ++q) { const f32x4 A4 = *(const LAS f32x4*)(ar + 4 * q);
                        acc[4 * q] -= A4.x * sv; acc[4 * q + 1] -= A4.y * sv; acc[4 * q + 2] -= A4.z * sv; acc[4 * q + 3] -= A4.w * sv; }
                }
#pragma unroll
                for (int i = 0; i < 16; ++i) {
                    acc[i] += __builtin_bit_cast(float, __builtin_amdgcn_update_dpp(0, __builtin_bit_cast(int, acc[i]), 0xB1, 0xF, 0xF, true));
                    acc[i] += __builtin_bit_cast(float, __builtin_amdgcn_update_dpp(0, __builtin_bit_cast(int, acc[i]), 0x4E, 0xF, 0xF, true));
                    acc[i] += __builtin_bit_cast(float, __builtin_amdgcn_update_dpp(0, __builtin_bit_cast(int, acc[i]), 0x141, 0xF, 0xF, true));
                }
            } else {
#pragma unroll
                for (int i = 0; i < 16; ++i) acc[i] = (i == jo) ? 1.f : 0.f;
            }
#pragma unroll
            for (int i = 0; i < 16; ++i) {
                const float sv = acc[i];
                const LAS float* ar = AmT + (16 * rb + i) * 68 + 16 * rb;
#pragma unroll
                for (int q = (i + 1) / 4; q < 4; ++q) { const f32x4 A4 = *(const LAS f32x4*)(ar + 4 * q);
                    if (4 * q > i) acc[4 * q] -= A4.x * sv; if (4 * q + 1 > i) acc[4 * q + 1] -= A4.y * sv; if (4 * q + 2 > i) acc[4 * q + 2] -= A4.z * sv; if (4 * q + 3 > i) acc[4 * q + 3] -= A4.w * sv; }
            }
            if (part == 0) {
#pragma unroll
                for (int i = 0; i < 16; ++i) { xcol[j * 68 + 16 * rb + i] = acc[i]; tinv[(16 * rb + i) * 72 + j] = (bf16)f2bf(acc[i]); }
            }
            LDS_WAIT(); asm volatile("" ::: "memory");
        }
        for (int rb = 0; rb < jb; ++rb) {
            if (part == 0) {
#pragma unroll
                for (int i = 0; i < 16; ++i) tinv[(16 * rb + i) * 72 + j] = (bf16)0;
            }
        }
    }
    GL_BAR();
    GL_REPF(6) {
        const LAS bf16* tinv = (const LAS bf16*)(lds + GL_SOL + 17408);
        LAS bf16* wst = (LAS bf16*)(lds + GL_SOL + 17408 + 9216);
        const int col = lane & 15, g = lane >> 4, isw = wave >> 2;
        bf16x8 af[4][2];
#pragma unroll
        for (int rho = 0; rho < 4; ++rho)
#pragma unroll
            for (int s2 = 0; s2 < 2; ++s2) af[rho][s2] = *(const LAS bf16x8*)(tinv + (16 * rho + col) * 72 + 32 * s2 + 8 * g);
        bf16* UF = (bf16*)(ws + WS_UF) + (size_t)item * 8192;
#pragma unroll
        for (int sig = 0; sig < 2; ++sig) {
            const int jj = 32 * (wave & 3) + 16 * sig + col;
            const LAS float* src = (isw ? ks : vs) + jj;
            bf16x8 bfr[2];
#pragma unroll
            for (int s2 = 0; s2 < 2; ++s2) {
                float v[8];
#pragma unroll
                for (int e = 0; e < 8; ++e) { const int sidx = 32 * s2 + 8 * g + e; float x = src[sidx * 132] * sbeta[sidx]; if (isw) x *= seg[sidx]; v[e] = x; }
                v4u pk; pk.x = pk2(v[0], v[1]); pk.y = pk2(v[2], v[3]); pk.z = pk2(v[4], v[5]); pk.w = pk2(v[6], v[7]);
                bfr[s2] = __builtin_bit_cast(bf16x8, pk);
            }
            f32x4 acc[4];
#pragma unroll
            for (int rho = 0; rho < 4; ++rho) { acc[rho] = (f32x4){0.f, 0.f, 0.f, 0.f};
#pragma unroll
                for (int s2 = 0; s2 < 2; ++s2) acc[rho] = __builtin_amdgcn_mfma_f32_16x16x32_bf16(af[rho][s2], bfr[s2], acc[rho], 0, 0, 0); }
            if (!isw) {
                v4u o0, o1;
                o0.x = pk2(acc[0].x, acc[0].y); o0.y = pk2(acc[0].z, acc[0].w); o0.z = pk2(acc[1].x, acc[1].y); o0.w = pk2(acc[1].z, acc[1].w);
                o1.x = pk2(acc[2].x, acc[2].y); o1.y = pk2(acc[2].z, acc[2].w); o1.z = pk2(acc[3].x, acc[3].y); o1.w = pk2(acc[3].z, acc[3].w);
                v4u* d = (v4u*)(UF + (size_t)(2 * (wave & 3) + sig) * 1024 + lane * 16);
                d[0] = o0; d[1] = o1;
            } else {
#pragma unroll
                for (int rho = 0; rho < 4; ++rho)
#pragma unroll
                    for (int i = 0; i < 4; ++i) wst[(16 * rho + 4 * g + i) * 136 + jj] = (bf16)f2bf(-acc[rho][i]);
            }
        }
    }
    GL_BAR();
    {
        const LAS bf16* wst = (const LAS bf16*)(lds + GL_SOL + 17408 + 9216);
        bf16* WN = (bf16*)(ws + WS_WN) + (size_t)item * 8192;
#pragma unroll
        for (int r = 0; r < 2; ++r) {
            const int id = tid + 512 * r, c = id >> 4, gam = id & 15, s32 = gam >> 2, g = gam & 3;
            const v2u lo = *(const LAS v2u*)(wst + c * 136 + 32 * s32 + 4 * g), hi = *(const LAS v2u*)(wst + c * 136 + 32 * s32 + 16 + 4 * g);
            v4u o; o.x = lo.x; o.y = lo.y; o.z = hi.x; o.w = hi.y;
            *(v4u*)(WN + c * 128 + 8 * gam) = o;
        }
    }
    GL_BAR();
}

constexpr int LL_XCB = 68608;
static_assert(LL_XCB + 64 * 1040 <= MISC_OFF, "lru_local LDS map");
__device__ __forceinline__ float expm1_small(float x) {
    const float p = x * (1.0f + x * (0.5f + x * (0.16666667f + x * (0.041666668f + x * 0.008333334f))));
    return (x > -0.25f) ? p : (__expf(x) - 1.0f);
}
__device__ __forceinline__ void lru_local_item(const Params& P, LAS unsigned char* lds, int lt, int tid, int lane, int wave) {
    unsigned char* ws = P.ws;
    asm volatile("" : "+v"(tid));
    const int b = lt >> 7, n = lt & 127, t0 = b * SEQ + n * 64;
    LAS bf16* rawx = (LAS bf16*)lds;
    LAS bf16* xcb = (LAS bf16*)(lds + LL_XCB);
    const bf16* XR = (const bf16*)(ws + WS_XR);
    {
        v4u pr[9];
#pragma unroll
        for (int r = 0; r < 9; ++r) { const int id = tid + 512 * r, row = id >> 6, ck = id & 63, s = n * 64 + row - 3;
            pr[r] = (v4u){0u, 0u, 0u, 0u};
            if (id < 67 * 64 && s >= 0) pr[r] = *(const v4u*)(XR + (size_t)(b * SEQ + s) * 512 + ck * 8); }
#pragma unroll
        for (int r = 0; r < 9; ++r) { const int id = tid + 512 * r; if (id < 67 * 64) *(LAS v4u*)(rawx + id * 8) = pr[r]; }
    }
    GL_BAR();
    {
        const int chg = tid & 63, tseg = tid >> 6, ch0 = chg * 8;
        float w[4][8], cb[8];
#pragma unroll
        for (int j = 0; j < 4; ++j) { const f32x4 a = *(const f32x4*)(P.lru_conv_w + j * 512 + ch0), c = *(const f32x4*)(P.lru_conv_w + j * 512 + ch0 + 4);
            w[j][0] = a.x; w[j][1] = a.y; w[j][2] = a.z; w[j][3] = a.w; w[j][4] = c.x; w[j][5] = c.y; w[j][6] = c.z; w[j][7] = c.w; }
        { const f32x4 a = *(const f32x4*)(P.lru_conv_b + ch0), c = *(const f32x4*)(P.lru_conv_b + ch0 + 4);
          cb[0] = a.x; cb[1] = a.y; cb[2] = a.z; cb[3] = a.w; cb[4] = c.x; cb[5] = c.y; cb[6] = c.z; cb[7] = c.w; }
        v4u xr[11];
#pragma unroll
        for (int r = 0; r < 11; ++r) xr[r] = *(const LAS v4u*)(rawx + (tseg * 8 + r) * 512 + ch0);
#pragma unroll
        for (int tk = 0; tk < 8; ++tk) {
            float y[8];
#pragma unroll
            for (int e = 0; e < 8; ++e) y[e] = cb[e];
#pragma unroll
            for (int j = 0; j < 4; ++j) { const v4u x = xr[tk + j];
                y[0] += w[j][0] * bflo(x.x); y[1] += w[j][1] * bfhi(x.x); y[2] += w[j][2] * bflo(x.y); y[3] += w[j][3] * bfhi(x.y);
                y[4] += w[j][4] * bflo(x.z); y[5] += w[j][5] * bfhi(x.z); y[6] += w[j][6] * bflo(x.w); y[7] += w[j][7] * bfhi(x.w); }
            v4u o; o.x = pk2(y[0], y[1]); o.y = pk2(y[2], y[3]); o.z = pk2(y[4], y[5]); o.w = pk2(y[6], y[7]);
            *(LAS v4u*)(xcb + (tseg * 8 + tk) * 520 + ch0) = o;
        }
    }
    GL_BAR();
    {
        const int g = wave, col = lane & 15, g4 = lane >> 4;
        LAS bf16* AM = (LAS bf16*)(lds + wave * 8192); LAS bf16* BT = AM + 2048;
        const bf16* WT = (const bf16*)(ws + WS_LRUWT) + (size_t)g * 8192;
        bf16x8 Bw[2][4][2];
#pragma unroll
        for (int m = 0; m < 2; ++m)
#pragma unroll
            for (int jt = 0; jt < 4; ++jt)
#pragma unroll
                for (int s2 = 0; s2 < 2; ++s2) Bw[m][jt][s2] = *(const bf16x8*)(WT + m * 4096 + (16 * jt + col) * 64 + 32 * s2 + 8 * g4);
        float cba[4], cbx[4], csp[4];
#pragma unroll
        for (int jt = 0; jt < 4; ++jt) { const int ch = g * 64 + 16 * jt + col; cba[jt] = P.lru_ba[ch]; cbx[jt] = P.lru_bx[ch]; csp[jt] = softplusf_(-P.lru_lambda[ch]); }
        bf16* HLOC = (bf16*)(ws + WS_HLOC); bf16* PCUM = (bf16*)(ws + WS_PCUM);
        const int chs = g * 64 + lane;
        float hst = 0.f, pc = 1.f;
#pragma unroll 1
        for (int half = 0; half < 2; ++half) {
            bf16x8 Af[2][2];
#pragma unroll
            for (int rho = 0; rho < 2; ++rho)
#pragma unroll
                for (int s2 = 0; s2 < 2; ++s2) Af[rho][s2] = *(const LAS bf16x8*)(xcb + (32 * half + 16 * rho + col) * 520 + g * 64 + 32 * s2 + 8 * g4);
#pragma unroll
            for (int jt = 0; jt < 4; ++jt) {
#pragma unroll
                for (int rho = 0; rho < 2; ++rho) {
                    f32x4 ra = (f32x4){0.f, 0.f, 0.f, 0.f}, rx = ra;
#pragma unroll
                    for (int s2 = 0; s2 < 2; ++s2) { ra = __builtin_amdgcn_mfma_f32_16x16x32_bf16(Af[rho][s2], Bw[0][jt][s2], ra, 0, 0, 0); rx = __builtin_amdgcn_mfma_f32_16x16x32_bf16(Af[rho][s2], Bw[1][jt][s2], rx, 0, 0, 0); }
#pragma unroll
                    for (int i = 0; i < 4; ++i) {
                        const int tokl = 16 * rho + 4 * g4 + i, chl = 16 * jt + col;
                        const float r = sigmoidf_(ra[i] + cba[jt]), ig = sigmoidf_(rx[i] + cbx[jt]);
                        const float log_a = -8.0f * r * csp[jt];
                        const float am = -expm1_small(log_a), a = 1.0f - am;
                        const float xo = bf1(xcb[(32 * half + tokl) * 520 + g * 64 + chl]);
                        const float bt = __builtin_amdgcn_sqrtf(fmaxf(am * (1.0f + a), 0.f)) * (ig * xo);
                        AM[tokl * 64 + chl] = (bf16)f2bf(am); BT[tokl * 64 + chl] = (bf16)f2bf(bt);
                    }
                }
            }
            LDS_WAIT(); asm volatile("" ::: "memory");
#pragma unroll 8
            for (int tk = 0; tk < 32; ++tk) {
                const float am = bf1(AM[tk * 64 + lane]), bt = bf1(BT[tk * 64 + lane]);
                hst = (hst - am * hst) + bt; pc = pc - am * pc;
                const size_t o = (size_t)(t0 + 32 * half + tk) * 512 + chs;
                HLOC[o] = (bf16)f2bf(hst); PCUM[o] = (bf16)f2bf(pc);
            }
            LDS_WAIT(); asm volatile("" ::: "memory");
        }
        ((float*)(ws + WS_HEND))[(size_t)lt * 512 + chs] = hst; ((float*)(ws + WS_PEND))[(size_t)lt * 512 + chs] = pc;
    }
    GL_BAR();
}

constexpr int SC_WN = 0, SC_QD = 64 * 272, SC_KD = 2 * 64 * 272, SC_ATT = 2 * 64 * 272 + 128 * 144, SC_BUF = 2 * 64 * 272 + 128 * 144 + 64 * 144;
constexpr int SC_SSQ = 2 * SC_BUF;
__device__ __forceinline__ int sc_lds_off(int id) {
    if (id < 1024) return SC_WN + (id >> 4) * 272 + (id & 15) * 16;
    if (id < 2048) { const int q = id - 1024; return SC_QD + (q >> 4) * 272 + (q & 15) * 16; }
    if (id < 3072) { const int q = id - 2048; return SC_KD + (q >> 3) * 144 + (q & 7) * 16; }
    const int q = id - 3072; return SC_ATT + (q >> 3) * 144 + (q & 7) * 16;
}
__device__ __forceinline__ const v4u* sc_src(const unsigned char* ws, int item, int id) {
    if (id < 1024) return (const v4u*)(ws + WS_WN + (size_t)item * 16384) + id;
    if (id < 2048) return (const v4u*)(ws + WS_QD + (size_t)item * 16384) + (id - 1024);
    if (id < 3072) return (const v4u*)(ws + WS_KD + (size_t)item * 16384) + (id - 2048);
    return (const v4u*)(ws + WS_ATT + (size_t)item * 8192) + (id - 3072);
}
__device__ __forceinline__ bf16x8 pack_b(const f32x4 a, const f32x4 b) {
    v4u r; r.x = pk2(a.x, a.y); r.y = pk2(a.z, a.w); r.z = pk2(b.x, b.y); r.w = pk2(b.z, b.w);
    return __builtin_bit_cast(bf16x8, r);
}
#define SC_BAR() do { asm volatile("s_waitcnt lgkmcnt(0)" ::: "memory"); __builtin_amdgcn_s_barrier(); asm volatile("" ::: "memory"); } while (0)
#define SC_GLD(dst, ptr) asm volatile("global_load_dwordx4 %0, %1, off" : "=v"(dst) : "v"(ptr) : "memory")
#define PIN8(a) asm volatile("" : "+v"(a[0]), "+v"(a[1]), "+v"(a[2]), "+v"(a[3]), "+v"(a[4]), "+v"(a[5]), "+v"(a[6]), "+v"(a[7]))
#define PIN16(a) asm volatile("" : "+v"(a[0]), "+v"(a[1]), "+v"(a[2]), "+v"(a[3]), "+v"(a[4]), "+v"(a[5]), "+v"(a[6]), "+v"(a[7]), "+v"(a[8]), "+v"(a[9]), "+v"(a[10]), "+v"(a[11]), "+v"(a[12]), "+v"(a[13]), "+v"(a[14]), "+v"(a[15]))
constexpr int SCAN_NWC = 2, SCAN_PARTS = 4, SCAN_WGS = 8 * SCAN_PARTS;
constexpr int SC_UFS = 2 * SC_BUF;
constexpr int SC_DECS = SC_UFS + 2 * SCAN_NWC * 2048;
constexpr int SC_OT = SC_DECS + 512;
constexpr int SC_END = SC_OT + 2 * 64 * 36 * 4;
static_assert(SC_END <= MISC_OFF, "scan LDS");
#ifndef SCAN_REPS
#define SCAN_REPS 1
#endif
#ifndef SCAN_EXP
#define SCAN_EXP 0
#endif
__device__ __forceinline__ int sc3_lds_off(int id) {
    if (id < 3584) return sc_lds_off(id);
    return SC_UFS + (id - 3584) * 16;
}
__device__ __forceinline__ const v4u* sc3_src(const unsigned char* ws, int item, int id, int part) {
    if (id < 3584) return sc_src(ws, item, id);
    return (const v4u*)(ws + WS_UF + (size_t)item * 16384 + (size_t)(part * SCAN_NWC) * 2048) + (id - 3584);
}
__device__ __forceinline__ void gdn_scan(const Params& P, LAS unsigned char* lds, int sb, int tid, int lane, int wave) {
    const unsigned char* ws = P.ws;
    constexpr int NCH = 128 * SCAN_REPS, NPC = 15;
    const int bh = sb & 7, part = sb >> 3;
    const int b = bh >> 2, h = bh & 3, col = lane & 15, g = lane >> 4;
    const int item0 = bh * 128;
    const float* DEC = (const float*)(ws + WS_DEC);
    if (wave >= 4) {
        constexpr int NP = 15, DEP = 3;
        const int lt = tid - 256;
        const unsigned voff = (unsigned)lt * 16u;
        const int lA = (lt >> 4) * 272 + (lt & 15) * 16, lB = (lt >> 3) * 144 + (lt & 7) * 16, lU = SC_UFS + lt * 16;
        v4u rs[DEP][NP];
#define SC_ISSUE(set, itm) do { const unsigned char* gq_ = ws + (size_t)(itm) * 16384; const unsigned char* ga_ = ws + WS_ATT + (size_t)(itm) * 8192; \
            asm volatile("s_nop 4\n\tglobal_load_dwordx4 %0, %8, %9\n\tglobal_load_dwordx4 %1, %8, %10\n\tglobal_load_dwordx4 %2, %8, %11\n\tglobal_load_dwordx4 %3, %8, %12\n\t" \
                         "global_load_dwordx4 %4, %8, %13\n\tglobal_load_dwordx4 %5, %8, %14\n\tglobal_load_dwordx4 %6, %8, %15\n\tglobal_load_dwordx4 %7, %8, %16" \
                : "=&v"(rs[set][0]), "=&v"(rs[set][1]), "=&v"(rs[set][2]), "=&v"(rs[set][3]), "=&v"(rs[set][4]), "=&v"(rs[set][5]), "=&v"(rs[set][6]), "=&v"(rs[set][7]) \
                : "v"(voff), "s"(gq_ + WS_WN), "s"(gq_ + WS_WN + 4096), "s"(gq_ + WS_WN + 8192), "s"(gq_ + WS_WN + 12288), \
                  "s"(gq_ + WS_QD), "s"(gq_ + WS_QD + 4096), "s"(gq_ + WS_QD + 8192), "s"(gq_ + WS_QD + 12288) : "memory"); \
            asm volatile("s_nop 4\n\tglobal_load_dwordx4 %0, %7, %8\n\tglobal_load_dwordx4 %1, %7, %9\n\tglobal_load_dwordx4 %2, %7, %10\n\tglobal_load_dwordx4 %3, %7, %11\n\t" \
                         "global_load_dwordx4 %4, %7, %12\n\tglobal_load_dwordx4 %5, %7, %13\n\tglobal_load_dwordx4 %6, %7, %14" \
                : "=&v"(rs[set][8]), "=&v"(rs[set][9]), "=&v"(rs[set][10]), "=&v"(rs[set][11]), "=&v"(rs[set][12]), "=&v"(rs[set][13]), "=&v"(rs[set][14]) \
                : "v"(voff), "s"(gq_ + WS_KD), "s"(gq_ + WS_KD + 4096), "s"(gq_ + WS_KD + 8192), "s"(gq_ + WS_KD + 12288), \
                  "s"(ga_), "s"(ga_ + 4096), "s"(gq_ + WS_UF + (size_t)(part * SCAN_NWC) * 2048) : "memory"); } while (0)
#define SC_WAITSET(set, cnt) asm volatile("s_waitcnt " cnt : "+v"(rs[set][0]), "+v"(rs[set][1]), "+v"(rs[set][2]), "+v"(rs[set][3]), "+v"(rs[set][4]), "+v"(rs[set][5]), "+v"(rs[set][6]), "+v"(rs[set][7]), \
            "+v"(rs[set][8]), "+v"(rs[set][9]), "+v"(rs[set][10]), "+v"(rs[set][11]), "+v"(rs[set][12]), "+v"(rs[set][13]), "+v"(rs[set][14]) :: "memory")
#define SC_WRITE(set, par) do { LAS unsigned char* wb_ = lds + (par) * SC_BUF; \
            _Pragma("unroll") for (int r = 0; r < 4; ++r) { *(LAS v4u*)(wb_ + SC_WN + lA + r * (16 * 272)) = rs[set][r]; *(LAS v4u*)(wb_ + SC_QD + lA + r * (16 * 272)) = rs[set][4 + r]; \
                                                          *(LAS v4u*)(wb_ + SC_KD + lB + r * (32 * 144)) = rs[set][8 + r]; } \
            *(LAS v4u*)(wb_ + SC_ATT + lB) = rs[set][12]; *(LAS v4u*)(wb_ + SC_ATT + lB + 32 * 144) = rs[set][13]; \
            *(LAS v4u*)(lds + lU + (par) * (SCAN_NWC * 2048)) = rs[set][14]; } while (0)
        {
#pragma unroll
            for (int r = 0; r < NP; ++r) { const int id = lt + 256 * r; *(LAS v4u*)(lds + sc3_lds_off(id)) = *sc3_src(ws, item0, id, part); }
            if (lt < 128) ((LAS float*)(lds + SC_DECS))[lt] = DEC[item0 + lt];
            asm volatile("s_waitcnt vmcnt(0)" ::: "memory");
        }
        SC_ISSUE(1, item0 + 1); SC_ISSUE(2, item0 + 2); SC_ISSUE(0, item0 + 3);
        SC_BAR();
        int n2 = 0;
#define SC_INTERVAL(set) do { SC_WAITSET(set, "vmcnt(30)"); SC_WRITE(set, (n2 + 1) & 1); SC_WAITSET(set, "lgkmcnt(0)"); SC_ISSUE(set, item0 + ((n2 + 1 + DEP) & 127)); SC_BAR(); ++n2; } while (0)
#pragma unroll 1
        for (int it = 0; it < NCH / 3; ++it) { SC_INTERVAL(1); SC_INTERVAL(2); SC_INTERVAL(0); }
        if (NCH % 3 >= 1) SC_INTERVAL(1);
        if (NCH % 3 >= 2) SC_INTERVAL(2);
        SC_WAITSET(0, "vmcnt(0)"); SC_WAITSET(1, "vmcnt(0)"); SC_WAITSET(2, "vmcnt(0)");
#undef SC_INTERVAL
#undef SC_WRITE
#undef SC_WAITSET
#undef SC_ISSUE
        return;
    }
    if (wave == 3) {
        SC_BAR();
#pragma unroll 1
        for (int n2 = 0; n2 < NCH; ++n2) SC_BAR();
        return;
    }
    if (wave == 2) {
        const int row = lane;
        bf16* Y = (bf16*)(P.ws + WS_Y);
        float* SSQG = P.out;
        SC_BAR();
#pragma unroll 1
        for (int n2 = 0; n2 <= NCH; ++n2) {
            if (n2 > 0) {
                const int n = (n2 - 1) & 127, t = b * SEQ + n * 64 + row;
                const LAS float* src = (const LAS float*)(lds + SC_OT + ((n2 - 1) & 1) * (64 * 36 * 4)) + row * 36;
                f32x4 a[8]; float s2 = 0.f;
#pragma unroll
                for (int q = 0; q < 8; ++q) { a[q] = *(const LAS f32x4*)(src + 4 * q); s2 += (a[q].x * a[q].x + a[q].y * a[q].y) + (a[q].z * a[q].z + a[q].w * a[q].w); }
                SSQG[(size_t)t * 32 + h * 8 + part] = s2;
                v4u* d = (v4u*)(Y + (size_t)t * 1024 + h * 128 + 32 * part);
#pragma unroll
                for (int q = 0; q < 4; ++q) { v4u o; o.x = pk2(a[2 * q].x, a[2 * q].y); o.y = pk2(a[2 * q].z, a[2 * q].w); o.z = pk2(a[2 * q + 1].x, a[2 * q + 1].y); o.w = pk2(a[2 * q + 1].z, a[2 * q + 1].w); d[q] = o; }
            }
            if (n2 < NCH) SC_BAR();
        }
        return;
    }
    f32x4 S[8];
#pragma unroll
    for (int i = 0; i < 8; ++i) S[i] = (f32x4){0.f, 0.f, 0.f, 0.f};
    SC_BAR();
#pragma unroll 1
    for (int n2 = 0; n2 < NCH; ++n2) {
        if (SCAN_REPS > 1 && (n2 & 127) == 0) {
#pragma unroll
            for (int i = 0; i < 8; ++i) S[i] = (f32x4){0.f, 0.f, 0.f, 0.f};
        }
        if (SCAN_EXP == 2 && n2 < 128) { SC_BAR(); continue; }
        const int par = n2 & 1;
        LAS unsigned char* buf = lds + par * SC_BUF;
        bf16x8 fA[16], fB[16], fC[16], fD[8];
#pragma unroll
        for (int rho = 0; rho < 4; ++rho)
#pragma unroll
            for (int s = 0; s < 4; ++s) fA[rho * 4 + s] = *(const LAS bf16x8*)(buf + SC_WN + (16 * rho + col) * 272 + (32 * s + 8 * g) * 2);
#pragma unroll
        for (int rho = 0; rho < 4; ++rho)
#pragma unroll
            for (int s = 0; s < 4; ++s) fB[rho * 4 + s] = *(const LAS bf16x8*)(buf + SC_QD + (16 * rho + col) * 272 + (32 * s + 8 * g) * 2);
        const LAS v4u* ufp = (const LAS v4u*)(lds + SC_UFS + par * (SCAN_NWC * 2048) + wave * 2048 + lane * 32);
        const v4u uf0 = ufp[0], uf1 = ufp[1];
        const float dec = ((const LAS float*)(lds + SC_DECS))[n2 & 127];
        bf16x8 Bs[4];
#pragma unroll
        for (int s = 0; s < 4; ++s) Bs[s] = pack_b(S[2 * s], S[2 * s + 1]);
        f32x4 Vn[4], Oc[4];
        Vn[0] = (f32x4){bflo(uf0.x), bfhi(uf0.x), bflo(uf0.y), bfhi(uf0.y)}; Vn[1] = (f32x4){bflo(uf0.z), bfhi(uf0.z), bflo(uf0.w), bfhi(uf0.w)};
        Vn[2] = (f32x4){bflo(uf1.x), bfhi(uf1.x), bflo(uf1.y), bfhi(uf1.y)}; Vn[3] = (f32x4){bflo(uf1.z), bfhi(uf1.z), bflo(uf1.w), bfhi(uf1.w)};
        __builtin_amdgcn_sched_barrier(0);
        PIN16(fA);
#pragma unroll
        for (int s = 0; s < 4; ++s)
#pragma unroll
            for (int rho = 0; rho < 4; ++rho) Vn[rho] = __builtin_amdgcn_mfma_f32_16x16x32_bf16(fA[rho * 4 + s], Bs[s], Vn[rho], 0, 0, 0);
        __builtin_amdgcn_sched_barrier(0);
#pragma unroll
        for (int tau = 0; tau < 8; ++tau)
#pragma unroll
            for (int s = 0; s < 2; ++s) fC[tau * 2 + s] = *(const LAS bf16x8*)(buf + SC_KD + (16 * tau + col) * 144 + (32 * s + 8 * g) * 2);
        __builtin_amdgcn_sched_barrier(0);
        PIN16(fB);
#pragma unroll
        for (int rho = 0; rho < 4; ++rho) Oc[rho] = (f32x4){0.f, 0.f, 0.f, 0.f};
#pragma unroll
        for (int s = 0; s < 4; ++s)
#pragma unroll
            for (int rho = 0; rho < 4; ++rho) Oc[rho] = __builtin_amdgcn_mfma_f32_16x16x32_bf16(fB[rho * 4 + s], Bs[s], Oc[rho], 0, 0, 0);
        __builtin_amdgcn_sched_barrier(0);
#pragma unroll
        for (int rho = 0; rho < 4; ++rho)
#pragma unroll
            for (int s = 0; s < 2; ++s) fD[rho * 2 + s] = *(const LAS bf16x8*)(buf + SC_ATT + (16 * rho + col) * 144 + (32 * s + 8 * g) * 2);
        bf16x8 Bv[2];
        Bv[0] = pack_b(Vn[0], Vn[1]); Bv[1] = pack_b(Vn[2], Vn[3]);
#pragma unroll
        for (int tau = 0; tau < 8; ++tau) S[tau] = S[tau] * dec;
        __builtin_amdgcn_sched_barrier(0);
        PIN16(fC);
#pragma unroll
        for (int s = 0; s < 2; ++s)
#pragma unroll
            for (int tau = 0; tau < 8; ++tau) S[tau] = __builtin_amdgcn_mfma_f32_16x16x32_bf16(fC[tau * 2 + s], Bv[s], S[tau], 0, 0, 0);
        __builtin_amdgcn_sched_barrier(0);
        PIN8(fD);
#pragma unroll
        for (int s = 0; s < 2; ++s)
#pragma unroll
            for (int rho = 0; rho < 4; ++rho) Oc[rho] = __builtin_amdgcn_mfma_f32_16x16x32_bf16(fD[rho * 2 + s], Bv[s], Oc[rho], 0, 0, 0);
        LAS float* ot = (LAS float*)(lds + SC_OT + par * (64 * 36 * 4)) + 16 * wave + col;
#pragma unroll
        for (int rho = 0; rho < 4; ++rho)
#pragma unroll
            for (int i = 0; i < 4; ++i) ot[(16 * rho + 4 * g + i) * 36] = Oc[rho][i];
        SC_BAR();
    }
}

__device__ __forceinline__ void lru_carry(const Params& P, int gwv, int lane) {
    unsigned char* ws = P.ws;
    const int b = gwv >> 3, g = gwv & 7, ch = g * 64 + lane;
    const float* HEND = (const float*)(ws + WS_HEND); const float* PEND = (const float*)(ws + WS_PEND); float* HIN = (float*)(ws + WS_HIN);
    float hin = 0.f;
#pragma unroll 1
    for (int n0 = 0; n0 < 128; n0 += 16) {
        float he[16], pe[16];
#pragma unroll
        for (int i = 0; i < 16; ++i) { const size_t o = (size_t)(b * 128 + n0 + i) * 512 + ch; he[i] = HEND[o]; pe[i] = PEND[o]; }
#pragma unroll
        for (int i = 0; i < 16; ++i) { HIN[(size_t)(b * 128 + n0 + i) * 512 + ch] = hin; hin = he[i] + pe[i] * hin; }
    }
}

__device__ __forceinline__ void cvt_table(const float* src, bf16* dst, size_t n8, size_t wi, size_t nw) {
    for (size_t i = wi; i < n8; i += nw) {
        const f32x4 a = ((const f32x4*)src)[2 * i], c = ((const f32x4*)src)[2 * i + 1];
        v4u o; o.x = pk2(a.x, a.y); o.y = pk2(a.z, a.w); o.z = pk2(c.x, c.y); o.w = pk2(c.z, c.w);
        ((v4u*)dst)[i] = o;
    }
}

__device__ __forceinline__ void lru_combine(const Params& P, size_t wi, size_t nw) {
    unsigned char* ws = P.ws;
    const v4u* HLOC = (const v4u*)(ws + WS_HLOC); const v4u* PCUM = (const v4u*)(ws + WS_PCUM); const v4u* GATE = (const v4u*)(ws + WS_GATE);
    const float* HIN = (const float*)(ws + WS_HIN); bf16* Y = (bf16*)(ws + WS_Y);
    for (size_t i = wi; i < (size_t)T * 64; i += nw) {
        const size_t t = i >> 6; const int ch0 = (int)(i & 63) * 8;
        const v4u hl = HLOC[i], pc = PCUM[i], gt = GATE[i];
        const f32x4 h0 = *(const f32x4*)(HIN + (t >> 6) * 512 + ch0), h1 = *(const f32x4*)(HIN + (t >> 6) * 512 + ch0 + 4);
        float y[8];
        y[0] = (bflo(hl.x) + bflo(pc.x) * h0.x) * gelu_tanh(bflo(gt.x)); y[1] = (bfhi(hl.x) + bfhi(pc.x) * h0.y) * gelu_tanh(bfhi(gt.x));
        y[2] = (bflo(hl.y) + bflo(pc.y) * h0.z) * gelu_tanh(bflo(gt.y)); y[3] = (bfhi(hl.y) + bfhi(pc.y) * h0.w) * gelu_tanh(bfhi(gt.y));
        y[4] = (bflo(hl.z) + bflo(pc.z) * h1.x) * gelu_tanh(bflo(gt.z)); y[5] = (bfhi(hl.z) + bfhi(pc.z) * h1.y) * gelu_tanh(bfhi(gt.z));
        y[6] = (bflo(hl.w) + bflo(pc.w) * h1.z) * gelu_tanh(bflo(gt.w)); y[7] = (bfhi(hl.w) + bfhi(pc.w) * h1.w) * gelu_tanh(bfhi(gt.w));
        v4u o; o.x = pk2(y[0], y[1]); o.y = pk2(y[2], y[3]); o.z = pk2(y[4], y[5]); o.w = pk2(y[6], y[7]);
        *(v4u*)(Y + t * 1024 + 512 + ch0) = o;
    }
}

__device__ __forceinline__ void gdn_gate_norm(const Params& P, size_t wi, size_t nw) {
    unsigned char* ws = P.ws;
    bf16* Y = (bf16*)(ws + WS_Y); const v4u* Z = (const v4u*)(ws + WS_Z); const float* SSQG = P.out;
    for (size_t i = wi; i < (size_t)T * 64; i += nw) {
        const size_t t = i >> 6; const int c0 = (int)(i & 63) * 8, h = c0 >> 7;
        const f32x4 q0 = *(const f32x4*)(SSQG + t * 32 + h * 8);
        const float rstd = rsqrtf(((q0.x + q0.y) + (q0.z + q0.w)) * (1.0f / 128.0f) + 1e-6f);
        const v4u o = *(const v4u*)(Y + t * 1024 + c0), z = Z[i];
        const f32x4 w0 = *(const f32x4*)(P.gdn_norm_w + (c0 & 127)), w1 = *(const f32x4*)(P.gdn_norm_w + (c0 & 127) + 4);
        float y[8];
        y[0] = bflo(o.x) * rstd * w0.x * siluf_(bflo(z.x)); y[1] = bfhi(o.x) * rstd * w0.y * siluf_(bfhi(z.x));
        y[2] = bflo(o.y) * rstd * w0.z * siluf_(bflo(z.y)); y[3] = bfhi(o.y) * rstd * w0.w * siluf_(bfhi(z.y));
        y[4] = bflo(o.z) * rstd * w1.x * siluf_(bflo(z.z)); y[5] = bfhi(o.z) * rstd * w1.y * siluf_(bfhi(z.z));
        y[6] = bflo(o.w) * rstd * w1.z * siluf_(bflo(z.w)); y[7] = bfhi(o.w) * rstd * w1.w * siluf_(bfhi(z.w));
        v4u r; r.x = pk2(y[0], y[1]); r.y = pk2(y[2], y[3]); r.z = pk2(y[4], y[5]); r.w = pk2(y[6], y[7]);
        *(v4u*)(Y + t * 1024 + c0) = r;
    }
}

__device__ __forceinline__ void xattn_stage(LAS unsigned char* lds, const bf16* src, int tid) {
    v4u tmp[16];
#pragma unroll
    for (int r = 0; r < 16; ++r) tmp[r] = *(const v4u*)(src + (size_t)(tid + 512 * r) * 8);
#pragma unroll
    for (int r = 0; r < 16; ++r) { const int id = tid + 512 * r; *(LAS v4u*)(lds + (id >> 5) * 528 + (id & 31) * 16) = tmp[r]; }
}
__device__ __forceinline__ void xattn_unit(const Params& P, LAS unsigned char* lds, int unit, int tid, int lane, int wave) {
    const unsigned char* ws = P.ws;
    const int h = unit & 3, qb = (unit >> 2) & 63, b = unit >> 8, col = lane & 15, g = lane >> 4;
    const int tw = b * SEQ + qb * 128 + 16 * wave;
    const bf16* Kb = (const bf16*)(ws + WS_KB) + (size_t)((b * 4 + h) * 256) * 256;
    const bf16* Vt = (const bf16*)(ws + WS_VTP) + (size_t)((b * 4 + h) * 256) * 256;
    xattn_stage(lds, Kb, tid);
    __syncthreads();
    const LAS unsigned char* arow = lds + col * 528 + g * 16;
    bf16x8 Bp[1][8]; float inv[1];
#pragma unroll
    for (int ps = 0; ps < 1; ++ps) {
        const bf16* Q = (const bf16*)(ws + WS_Q) + (size_t)(tw + 16 * ps + col) * 1024 + h * 256 + 8 * g;
        bf16x8 Bq[8];
#pragma unroll
        for (int s = 0; s < 8; ++s) Bq[s] = *(const bf16x8*)(Q + 32 * s);
        f32x4 St[16];
        bf16x8 fr[2][8];
#pragma unroll
        for (int s = 0; s < 8; ++s) fr[0][s] = *(const LAS bf16x8*)(arow + 64 * s);
#pragma unroll
        for (int kap = 0; kap < 16; ++kap) {
            if (kap + 1 < 16) {
#pragma unroll
                for (int s = 0; s < 8; ++s) fr[(kap + 1) & 1][s] = *(const LAS bf16x8*)(arow + (16 * (kap + 1)) * 528 + 64 * s);
            }
            __builtin_amdgcn_sched_barrier(0);
            PIN8(fr[kap & 1]);
            f32x4 acc = (f32x4){0.f, 0.f, 0.f, 0.f};
#pragma unroll
            for (int s = 0; s < 8; ++s) acc = __builtin_amdgcn_mfma_f32_16x16x32_bf16(fr[kap & 1][s], Bq[s], acc, 0, 0, 0);
            St[kap] = acc;
            __builtin_amdgcn_sched_barrier(0);
        }
        float mx = -3.0e38f;
#pragma unroll
        for (int kap = 0; kap < 16; ++kap) mx = fmaxf(fmaxf(fmaxf(St[kap].x, St[kap].y), fmaxf(St[kap].z, St[kap].w)), mx);
        mx = fmaxf(mx, __shfl_xor(mx, 16)); mx = fmaxf(mx, __shfl_xor(mx, 32));
        float l = 0.f;
#pragma unroll
        for (int kap = 0; kap < 16; ++kap) { St[kap].x = __expf(St[kap].x - mx); St[kap].y = __expf(St[kap].y - mx); St[kap].z = __expf(St[kap].z - mx); St[kap].w = __expf(St[kap].w - mx);
            l += (St[kap].x + St[kap].y) + (St[kap].z + St[kap].w); }
        l += __shfl_xor(l, 16); l += __shfl_xor(l, 32);
        inv[ps] = 1.0f / l;
#pragma unroll
        for (int s = 0; s < 8; ++s) Bp[ps][s] = pack_b(St[2 * s], St[2 * s + 1]);
    }
    __syncthreads();
    xattn_stage(lds, Vt, tid);
    __syncthreads();
#pragma unroll
    for (int ps = 0; ps < 1; ++ps) {
        bf16* AO = (bf16*)(P.ws + WS_AO) + (size_t)(tw + 16 * ps + col) * 1024 + h * 256 + 4 * g;
        bf16x8 fr[2][8];
#pragma unroll
        for (int s = 0; s < 8; ++s) fr[0][s] = *(const LAS bf16x8*)(arow + 64 * s);
#pragma unroll
        for (int del = 0; del < 16; ++del) {
            if (del + 1 < 16) {
#pragma unroll
                for (int s = 0; s < 8; ++s) fr[(del + 1) & 1][s] = *(const LAS bf16x8*)(arow + (16 * (del + 1)) * 528 + 64 * s);
            }
            __builtin_amdgcn_sched_barrier(0);
            PIN8(fr[del & 1]);
            f32x4 acc = (f32x4){0.f, 0.f, 0.f, 0.f};
#pragma unroll
            for (int s = 0; s < 8; ++s) acc = __builtin_amdgcn_mfma_f32_16x16x32_bf16(fr[del & 1][s], Bp[ps][s], acc, 0, 0, 0);
            v2u o; o.x = pk2(acc.x * inv[ps], acc.y * inv[ps]); o.y = pk2(acc.z * inv[ps], acc.w * inv[ps]);
            *(v2u*)(AO + 16 * del) = o;
            __builtin_amdgcn_sched_barrier(0);
        }
    }
    __syncthreads();
}

__device__ __forceinline__ unsigned key_enc(float f) { const unsigned u = __builtin_bit_cast(unsigned, f); return (u & 0x80000000u) ? ~u : (u | 0x80000000u); }
__device__ __forceinline__ float key_dec(unsigned k) { const unsigned u = (k & 0x80000000u) ? (k & 0x7fffffffu) : ~k; return __builtin_bit_cast(float, u); }
#define TK_CAS(a, b) do { const unsigned hi_ = max(a, b), lo_ = min(a, b); a = hi_; b = lo_; } while (0)
__device__ __forceinline__ void tk_merge16(unsigned (&a)[16]) {
#pragma unroll
    for (int j = 8; j > 0; j >>= 1)
#pragma unroll
        for (int i = 0; i < 16; ++i) { const int l = i ^ j; if (l > i) TK_CAS(a[i], a[l]); }
}
__device__ __forceinline__ void tk_sort16(unsigned (&a)[16]) {
#pragma unroll
    for (int k = 2; k <= 16; k <<= 1)
#pragma unroll
        for (int j = k >> 1; j > 0; j >>= 1)
#pragma unroll
            for (int i = 0; i < 16; ++i) { const int l = i ^ j; if (l > i) { if ((i & k) == 0) TK_CAS(a[i], a[l]); else TK_CAS(a[l], a[i]); } }
}
__device__ __forceinline__ void tk_top16_merge(unsigned (&L)[16], const unsigned (&G)[16]) {
#pragma unroll
    for (int i = 0; i < 16; ++i) L[i] = max(L[i], G[15 - i]);
    tk_merge16(L);
}
__device__ __forceinline__ void tk_pair_merge(unsigned (&L)[16]) {
    unsigned Pp[16];
#pragma unroll
    for (int i = 0; i < 16; ++i) Pp[i] = (unsigned)__builtin_amdgcn_update_dpp(0, (int)L[i], 0xB1, 0xF, 0xF, true);
    tk_top16_merge(L, Pp);
}
__device__ __forceinline__ void peer_topk_rows(const Params& P, LAS unsigned char* lds, int rowbase, int tid) {
    const unsigned char* ws = P.ws;
    typedef _Float16 f16x8 __attribute__((ext_vector_type(8)));
    const int rl = tid >> 1, hf = tid & 1, grow = rowbase + rl, t = grow >> 3, h = grow & 7;
    const _Float16* SC = (const _Float16*)(ws + WS_PQ) + (size_t)t * 2048 + h * 256 + 64 * hf;
    f16x8 raw[2][8];
#pragma unroll
    for (int p = 0; p < 2; ++p)
#pragma unroll
        for (int q = 0; q < 8; ++q) raw[p][q] = *(const f16x8*)(SC + p * 128 + 8 * q);
    unsigned L1[16], L2[16];
#pragma unroll
    for (int p = 0; p < 2; ++p) {
        unsigned L[16];
#pragma unroll
        for (int grp = 0; grp < 4; ++grp) {
            unsigned G[16];
#pragma unroll
            for (int e = 0; e < 16; ++e) G[e] = (key_enc((float)raw[p][2 * grp + (e >> 3)][e & 7]) & ~127u) | (unsigned)(127 - (64 * hf + 16 * grp + e));
            tk_sort16(G);
            if (grp == 0) {
#pragma unroll
                for (int i = 0; i < 16; ++i) L[i] = G[i];
            } else tk_top16_merge(L, G);
        }
        tk_pair_merge(L);
#pragma unroll
        for (int i = 0; i < 16; ++i) { if (p == 0) L1[i] = L[i]; else L2[i] = L[i]; }
    }
    {
        float v1[16], v2[16];
        LAS int* il = (LAS int*)lds + rl * 33;
#pragma unroll
        for (int q = 0; q < 16; ++q) { v1[q] = key_dec((L1[q] & ~127u) | 64u); v2[q] = key_dec((L2[q] & ~127u) | 64u); }
        if (hf == 0) {
#pragma unroll
            for (int q = 0; q < 16; ++q) { il[q] = 127 - (int)(L1[q] & 127u); il[16 + q] = 127 - (int)(L2[q] & 127u); }
        }
        unsigned C[16], D[16];
        float w1[8];
        const unsigned hf16 = (unsigned)hf * 16u, evenmask = (unsigned)hf - 1u;
#pragma unroll
        for (int k = 0; k < 8; ++k) w1[k] = __builtin_bit_cast(float, (__builtin_bit_cast(unsigned, v1[2 * k]) & evenmask) | (__builtin_bit_cast(unsigned, v1[2 * k + 1]) & ~evenmask));
#define TK_SLOT(dst, k, bq, valid_odd) do { const unsigned pos_ = (unsigned)(16 * (2 * (k)) + (bq)) + hf16; unsigned kv_ = (key_enc(w1[k] + v2[bq]) & ~255u) | (255u - pos_); if (!(valid_odd)) kv_ &= evenmask; dst = kv_; } while (0)
        TK_SLOT(C[0], 0, 0, true);
        TK_SLOT(C[1], 0, 1, true);
        TK_SLOT(C[2], 0, 2, true);
        TK_SLOT(C[3], 0, 3, true);
        TK_SLOT(C[4], 0, 4, true);
        TK_SLOT(C[5], 0, 5, true);
        TK_SLOT(C[6], 0, 6, true);
        TK_SLOT(C[7], 0, 7, true);
        TK_SLOT(C[8], 0, 8, false);
        TK_SLOT(C[9], 0, 9, false);
        TK_SLOT(C[10], 0, 10, false);
        TK_SLOT(C[11], 0, 11, false);
        TK_SLOT(C[12], 0, 12, false);
        TK_SLOT(C[13], 0, 13, false);
        TK_SLOT(C[14], 0, 14, false);
        TK_SLOT(C[15], 0, 15, false);
        TK_SLOT(D[0], 1, 0, true);
        TK_SLOT(D[1], 1, 1, true);
        TK_SLOT(D[2], 1, 2, true);
        TK_SLOT(D[3], 1, 3, true);
        TK_SLOT(D[4], 1, 4, false);
        TK_SLOT(D[5], 2, 0, true);
        TK_SLOT(D[6], 2, 1, true);
        TK_SLOT(D[7], 2, 2, false);
        TK_SLOT(D[8], 3, 0, true);
        TK_SLOT(D[9], 3, 1, true);
        TK_SLOT(D[10], 4, 0, true);
        TK_SLOT(D[11], 5, 0, true);
        TK_SLOT(D[12], 6, 0, true);
        TK_SLOT(D[13], 7, 0, true);
        D[14] = 0u; D[15] = 0u;
#undef TK_SLOT
        tk_sort16(C); tk_sort16(D); tk_top16_merge(C, D); tk_pair_merge(C);
        LDS_WAIT(); asm volatile("" ::: "memory");
        float best[16], e[16], sum = 0.f;
#pragma unroll
        for (int q = 0; q < 16; ++q) { best[q] = key_dec((C[q] & ~255u) | 128u); e[q] = __expf(best[q] - best[0]); sum += e[q]; }
        const float inv = __builtin_amdgcn_rcpf(sum);
        int* IDX = (int*)(P.ws + WS_IDX) + (size_t)grow * 16 + 8 * hf; float* GW = (float*)(P.ws + WS_GW) + (size_t)grow * 16 + 8 * hf;
#pragma unroll
        for (int q = 0; q < 8; ++q) {
            const unsigned c = (C[q] & evenmask) | (C[8 + q] & ~evenmask);
            const float ev = __builtin_bit_cast(float, (__builtin_bit_cast(unsigned, e[q]) & evenmask) | (__builtin_bit_cast(unsigned, e[8 + q]) & ~evenmask));
            const unsigned pos = 255u - (c & 255u);
            IDX[q] = il[pos >> 4] * 128 + il[16 + (pos & 15u)]; GW[q] = ev * inv;
        }
    }
    LDS_WAIT(); asm volatile("" ::: "memory");
}

typedef float f32x2 __attribute__((ext_vector_type(2)));
__device__ __forceinline__ unsigned q8(float x) { return (unsigned)(int)rintf(x) & 0xffu; }
__device__ __forceinline__ void cvt_table_fp8(const float* src, unsigned char* dst, float* scl, int gw, int ngw, int lane) {
    for (int row = gw; row < 16384; row += ngw) {
        const f32x4* sp = (const f32x4*)(src + (size_t)row * 1024 + 16 * lane);
        const f32x4 a0 = sp[0], a1 = sp[1], a2 = sp[2], a3 = sp[3];
        float m = fmaxf(fmaxf(fmaxf(fabsf(a0.x), fabsf(a0.y)), fmaxf(fabsf(a0.z), fabsf(a0.w))), fmaxf(fmaxf(fabsf(a1.x), fabsf(a1.y)), fmaxf(fabsf(a1.z), fabsf(a1.w))));
        m = fmaxf(m, fmaxf(fmaxf(fmaxf(fabsf(a2.x), fabsf(a2.y)), fmaxf(fabsf(a2.z), fabsf(a2.w))), fmaxf(fmaxf(fabsf(a3.x), fabsf(a3.y)), fmaxf(fabsf(a3.z), fabsf(a3.w)))));
#pragma unroll
        for (int o = 1; o < 64; o <<= 1) m = fmaxf(m, __shfl_xor(m, o));
        m = fmaxf(m, 1e-30f);
        const float q = 127.0f / m;
        v4u o;
        o.x = q8(a0.x * q) | (q8(a0.y * q) << 8) | (q8(a0.z * q) << 16) | (q8(a0.w * q) << 24);
        o.y = q8(a1.x * q) | (q8(a1.y * q) << 8) | (q8(a1.z * q) << 16) | (q8(a1.w * q) << 24);
        o.z = q8(a2.x * q) | (q8(a2.y * q) << 8) | (q8(a2.z * q) << 16) | (q8(a2.w * q) << 24);
        o.w = q8(a3.x * q) | (q8(a3.y * q) << 8) | (q8(a3.z * q) << 16) | (q8(a3.w * q) << 24);
        *(v4u*)(dst + (size_t)row * 1024 + 16 * lane) = o;
        if (lane == 0) scl[row] = m * (1.0f / 127.0f);
    }
}
__device__ __forceinline__ int row16_sum_i(int v) {
    v += __builtin_amdgcn_update_dpp(0, v, 0xB1, 0xF, 0xF, true);
    v += __builtin_amdgcn_update_dpp(0, v, 0x4E, 0xF, 0xF, true);
    v += __builtin_amdgcn_update_dpp(0, v, 0x141, 0xF, 0xF, true);
    v += __builtin_amdgcn_update_dpp(0, v, 0x140, 0xF, 0xF, true);
    return v;
}
constexpr int PE_NT = 2, PE_NR = 16, PE_SH = 10, PE_DEP = 4;
constexpr int PE_TOK_W = 128 * 3 + 20;
constexpr int PE_WAVE_W = PE_NT * PE_TOK_W + 160;
static_assert(8 * PE_WAVE_W * 4 <= MISC_OFF && PE_NR * PE_NT == 32, "peer LDS / batch-list geometry");
#define PE_LD(dst, voff_, sbase_) asm volatile("s_nop 4\n\tglobal_load_dwordx4 %0, %1, %2" : "=&v"(dst) : "v"(voff_), "s"(sbase_) : "memory")
__device__ __forceinline__ void peer_pass(const Params& P, LAS unsigned char* lds, int tbase, int lane, int wave, float* dstbase, int emask = 0x3fff) {
    const unsigned char* ws = P.ws;
    const unsigned char* UB8 = ws + WS_UB; const unsigned char* VB8 = ws + WS_VB;
    const float* USC = (const float*)(ws + WS_USC); const float* VSC = (const float*)(ws + WS_VSC);
    unsigned hq[PE_NT][4]; f32x2 acc[PE_NT][8];
    LAS unsigned* lw = (LAS unsigned*)(lds) + wave * PE_WAVE_W;
    LAS unsigned* ents = lw + PE_NT * PE_TOK_W;
    const unsigned voff = (unsigned)lane * 16u;
#pragma unroll
    for (int j = 0; j < PE_NT; ++j) {
        const int t = tbase + j;
        const float* xrow = P.out + (size_t)t * 1024 + 16 * lane;
        const float rstd2 = rsqrtf(((const float*)(ws + WS_SSQ2))[t] * (1.0f / 1024.0f) + 1e-6f);
        f32x4 hv[4]; float hm = 0.f;
#pragma unroll
        for (int i = 0; i < 4; ++i) { const f32x4 xv = ((const f32x4*)xrow)[i]; const f32x4 w = ((const f32x4*)(P.norm_ffn_w + 16 * lane))[i];
            hv[i] = (f32x4){xv.x * rstd2 * w.x, xv.y * rstd2 * w.y, xv.z * rstd2 * w.z, xv.w * rstd2 * w.w};
            hm = fmaxf(hm, fmaxf(fmaxf(fabsf(hv[i].x), fabsf(hv[i].y)), fmaxf(fabsf(hv[i].z), fabsf(hv[i].w)))); }
#pragma unroll
        for (int o = 1; o < 64; o <<= 1) hm = fmaxf(hm, __shfl_xor(hm, o));
        hm = fmaxf(hm, 1e-30f);
        const float hqs = 127.0f / hm, hs = hm * (1.0f / 127.0f);
#pragma unroll
        for (int i = 0; i < 4; ++i) hq[j][i] = q8(hv[i].x * hqs) | (q8(hv[i].y * hqs) << 8) | (q8(hv[i].z * hqs) << 16) | (q8(hv[i].w * hqs) << 24);
#pragma unroll
        for (int i = 0; i < 8; ++i) acc[j][i] = (f32x2){0.f, 0.f};
        const int e0 = ((const int*)(ws + WS_IDX))[(size_t)t * 128 + 2 * lane] & emask, e1 = ((const int*)(ws + WS_IDX))[(size_t)t * 128 + 2 * lane + 1] & emask;
        const float g0 = ((const float*)(ws + WS_GW))[(size_t)t * 128 + 2 * lane] * VSC[e0], g1 = ((const float*)(ws + WS_GW))[(size_t)t * 128 + 2 * lane + 1] * VSC[e1];
        const float u0 = USC[e0] * hs, u1 = USC[e1] * hs;
        const int b0 = e0 >> PE_SH, b1 = e1 >> PE_SH;
        LAS unsigned* lt = lw + j * PE_TOK_W;
        int run = 0;
#pragma unroll 1
        for (int bk = 0; bk < PE_NR; ++bk) {
            const unsigned long long m0 = __ballot(b0 == bk), m1 = __ballot(b1 == bk);
            const int c0 = __popcll(m0), c1 = __popcll(m1);
            const unsigned long long lower = (1ull << lane) - 1ull;
            if (b0 == bk) { const int p = run + __popcll(m0 & lower); lt[p] = (unsigned)e0; lt[128 + p] = __builtin_bit_cast(unsigned, g0); lt[256 + p] = __builtin_bit_cast(unsigned, u0); }
            if (b1 == bk) { const int p = run + c0 + __popcll(m1 & lower); lt[p] = (unsigned)e1; lt[128 + p] = __builtin_bit_cast(unsigned, g1); lt[256 + p] = __builtin_bit_cast(unsigned, u1); }
            if (lane == 0) lt[384 + bk] = (unsigned)run;
            run += c0 + c1;
        }
        if (lane == 0) lt[384 + PE_NR] = 128u;
        asm volatile("" ::: "memory");
    }
    LDS_WAIT(); asm volatile("" ::: "memory");
    int nb;
    {
        const int rd = (lane & 31) >> 1, j = lane & 1;
        const LAS unsigned* lt = lw + j * PE_TOK_W;
        const int n0 = (int)lt[384 + rd], n1 = (int)lt[384 + rd + 1];
        const int nbl = (lane < 32) ? ((n1 - n0 + 3) >> 2) : 0;
        int inc = nbl;
#pragma unroll
        for (int off = 1; off < 64; off <<= 1) { const int tv = __shfl_up(inc, off); if (lane >= off) inc += tv; }
        nb = __builtin_amdgcn_readlane(inc, 63);
        const int ofs = inc - nbl;
        for (int q = 0; q < nbl; ++q) { const int i0 = n0 + 4 * q, c = (n1 - i0) < 4 ? (n1 - i0) : 4; ents[ofs + q] = (unsigned)j | ((unsigned)c << 2) | ((unsigned)i0 << 5); }
        if (lane < 2 * PE_DEP) ents[nb + lane] = 0u;
    }
    LDS_WAIT(); asm volatile("" ::: "memory");
    v4u ru[PE_DEP][4], rv[PE_DEP][4];
#define PE_ISSUE(S, entv) do { const unsigned en_ = (entv); const int j_ = (int)(en_ & 3u), c_ = (int)((en_ >> 2) & 7u), i_ = (int)(en_ >> 5); \
        const LAS unsigned* lt_ = lw + j_ * PE_TOK_W; const int cl_ = c_ > 0 ? c_ - 1 : 0; \
        const int ev_ = (int)lt_[i_ + (lane < cl_ ? lane : cl_)];                          \
        _Pragma("unroll") for (int k_ = 0; k_ < 4; ++k_) { const size_t eo_ = (size_t)__builtin_amdgcn_readlane(ev_, k_) * 1024; \
            const unsigned char* up_ = UB8 + eo_; const unsigned char* vp_ = VB8 + eo_; PE_LD(ru[S][k_], voff, up_); PE_LD(rv[S][k_], voff, vp_); } } while (0)
#define PE_WAIT8(S, cntstr) asm volatile("s_waitcnt " cntstr : "+v"(ru[S][0]), "+v"(ru[S][1]), "+v"(ru[S][2]), "+v"(ru[S][3]), "+v"(rv[S][0]), "+v"(rv[S][1]), "+v"(rv[S][2]), "+v"(rv[S][3]) :: "memory")
#define PE_COMPUTE_J(S, J, c_, i_) do { const LAS unsigned* lt_ = lw + (J) * PE_TOK_W; \
        const float gsc_ = (lane < c_) ? __builtin_bit_cast(float, lt_[128 + i_ + lane]) : 0.f, usc_ = (lane < c_) ? __builtin_bit_cast(float, lt_[256 + i_ + lane]) : 0.f; \
        int d_[4]; \
        _Pragma("unroll") for (int k_ = 0; k_ < 4; ++k_) { d_[k_] = 0; if (k_ >= c_) continue; \
            int s_ = __builtin_amdgcn_sdot4((int)ru[S][k_].x, (int)hq[J][0], 0, false); s_ = __builtin_amdgcn_sdot4((int)ru[S][k_].y, (int)hq[J][1], s_, false); \
            s_ = __builtin_amdgcn_sdot4((int)ru[S][k_].z, (int)hq[J][2], s_, false); s_ = __builtin_amdgcn_sdot4((int)ru[S][k_].w, (int)hq[J][3], s_, false); d_[k_] = s_; } \
        int r2_[2], r1_; \
        { const bool up_ = (lane & 32) != 0; \
          _Pragma("unroll") for (int q_ = 0; q_ < 2; ++q_) { const int keep_ = up_ ? d_[2 + q_] : d_[q_], send_ = up_ ? d_[q_] : d_[2 + q_]; r2_[q_] = keep_ + __shfl_xor(send_, 32); } } \
        { const bool up_ = (lane & 16) != 0; const int keep_ = up_ ? r2_[1] : r2_[0], send_ = up_ ? r2_[0] : r2_[1]; r1_ = keep_ + __shfl_xor(send_, 16); } \
        r1_ = row16_sum_i(r1_); \
        const int myk_ = (lane >> 4) & 3; \
        const float act_ = gelu_tanh((float)r1_ * __shfl(usc_, myk_)) * __shfl(gsc_, myk_);      \
          \
        const float w0_ = __builtin_bit_cast(float, __builtin_amdgcn_readlane(__builtin_bit_cast(int, act_), 0)), w1_ = __builtin_bit_cast(float, __builtin_amdgcn_readlane(__builtin_bit_cast(int, act_), 16)), \
                    w2_ = __builtin_bit_cast(float, __builtin_amdgcn_readlane(__builtin_bit_cast(int, act_), 32)), w3_ = __builtin_bit_cast(float, __builtin_amdgcn_readlane(__builtin_bit_cast(int, act_), 48)); \
        const float wm_ = fmaxf(fmaxf(fmaxf(fabsf(w0_), fabsf(w1_)), fmaxf(fabsf(w2_), fabsf(w3_))), 1e-30f), wq_ = 127.0f / wm_, ws_ = wm_ * (1.0f / 127.0f); \
        const int w4_ = (int)(q8(w0_ * wq_) | (q8(w1_ * wq_) << 8) | (q8(w2_ * wq_) << 16) | (q8(w3_ * wq_) << 24)); \
        const f32x2 ws2_ = (f32x2){ws_, ws_}; \
        _Pragma("unroll") for (int m_ = 0; m_ < 4; ++m_) { \
            const unsigned R0_ = rv[S][0][m_], R1_ = rv[S][1][m_], R2_ = rv[S][2][m_], R3_ = rv[S][3][m_]; \
            const unsigned X_ = __builtin_amdgcn_perm(R1_, R0_, 0x05010400u), Y_ = __builtin_amdgcn_perm(R1_, R0_, 0x07030602u), Z_ = __builtin_amdgcn_perm(R3_, R2_, 0x05010400u), W_ = __builtin_amdgcn_perm(R3_, R2_, 0x07030602u); \
            const int t0_ = __builtin_amdgcn_sdot4((int)__builtin_amdgcn_perm(Z_, X_, 0x05040100u), w4_, 0, false), t1_ = __builtin_amdgcn_sdot4((int)__builtin_amdgcn_perm(Z_, X_, 0x07060302u), w4_, 0, false), \
                      t2_ = __builtin_amdgcn_sdot4((int)__builtin_amdgcn_perm(W_, Y_, 0x05040100u), w4_, 0, false), t3_ = __builtin_amdgcn_sdot4((int)__builtin_amdgcn_perm(W_, Y_, 0x07060302u), w4_, 0, false); \
            acc[J][2 * m_] = __builtin_elementwise_fma((f32x2){(float)t0_, (float)t1_}, ws2_, acc[J][2 * m_]); \
            acc[J][2 * m_ + 1] = __builtin_elementwise_fma((f32x2){(float)t2_, (float)t3_}, ws2_, acc[J][2 * m_ + 1]); } } while (0)
#define PE_COMPUTE(S, entv) do { const unsigned en_ = (entv); const int jj_ = (int)(en_ & 3u), cc_ = (int)((en_ >> 2) & 7u), ii_ = (int)(en_ >> 5); \
        if (cc_ > 0) { if (jj_ == 0) PE_COMPUTE_J(S, 0, cc_, ii_); else PE_COMPUTE_J(S, 1, cc_, ii_); } } while (0)
    {
        unsigned er[PE_DEP];
#pragma unroll
        for (int q = 0; q < PE_DEP; ++q) { er[q] = __builtin_amdgcn_readfirstlane(ents[q]); PE_ISSUE(q, er[q]); }
#pragma unroll 1
        for (int bi = 0; bi < nb; bi += PE_DEP) {
#pragma unroll
            for (int q = 0; q < PE_DEP; ++q) {
                PE_WAIT8(q, "vmcnt(24)");
                PE_COMPUTE(q, er[q]);
                er[q] = __builtin_amdgcn_readfirstlane(ents[bi + q + PE_DEP]);
                PE_ISSUE(q, er[q]);
            }
        }
#pragma unroll
        for (int q = 0; q < PE_DEP; ++q) PE_WAIT8(q, "vmcnt(0)");
    }
#undef PE_COMPUTE
#undef PE_COMPUTE_J
#undef PE_WAIT8
#undef PE_ISSUE
#pragma unroll
    for (int j = 0; j < PE_NT; ++j) {
        const int t = tbase + j;
        float ss = 0.f; f32x4 xo[4];
        const float* xrow = P.out + (size_t)t * 1024 + 16 * lane;
#pragma unroll
        for (int i = 0; i < 4; ++i) { xo[i] = ((const f32x4*)xrow)[i]; xo[i].x += acc[j][2 * i].x; xo[i].y += acc[j][2 * i].y; xo[i].z += acc[j][2 * i + 1].x; xo[i].w += acc[j][2 * i + 1].y;
            ss += (xo[i].x * xo[i].x + xo[i].y * xo[i].y) + (xo[i].z * xo[i].z + xo[i].w * xo[i].w); }
        const float rstd3 = rsqrtf(wave_sum(ss) * (1.0f / 1024.0f) + 1e-6f);
        float* orow = dstbase + (size_t)t * 1024 + 16 * lane;
#pragma unroll
        for (int i = 0; i < 4; ++i) { const f32x4 w = ((const f32x4*)(P.norm_final_w + 16 * lane))[i];
            ((f32x4*)orow)[i] = (f32x4){xo[i].x * rstd3 * w.x, xo[i].y * rstd3 * w.y, xo[i].z * rstd3 * w.z, xo[i].w * rstd3 * w.w}; }
    }
    LDS_WAIT(); asm volatile("s_waitcnt vmcnt(0)" ::: "memory");
}

__global__ void __launch_bounds__(NWAVES * 64, 2) hybrid_fwd(Params P) {
    extern __shared__ __attribute__((aligned(16))) unsigned char lds_raw[];
    LAS unsigned char* lds = (LAS unsigned char*)lds_raw;
    volatile LAS unsigned* MISC = (volatile LAS unsigned*)(lds + MISC_OFF);
    const int tid = threadIdx.x, lane = tid & 63, wave = __builtin_amdgcn_readfirstlane(tid >> 6);
    const int G = gridDim.x, bx = blockIdx.x;
    const int vcu = (G % 8 == 0) ? (bx % 8) * (G / 8) + bx / 8 : bx;
    unsigned char* ws = P.ws;
    for (int u = tid; u < 64; u += NWAVES * 64) MISC[u] = 0u;
    __syncthreads();
    XcdBarrier bar; bar.bar = (unsigned*)(ws + WS_CTL) + CW_BAR; bar.x = 0; bar.st = nullptr;
    if (!MK_PER_PHASE) bar = xcd_barrier_post((unsigned*)(ws + WS_CTL) + CW_BAR, MISC + 8);
    const int lo = P.ph_lo, hi = P.ph_hi;
#ifndef PHASE_MASK
#define PHASE_MASK 0xFFF
#endif
#define IN(k) (((PHASE_MASK >> (k)) & 1) && lo <= (k) && (k) < hi)
#define SEAM(k) do { if (IN(k) && IN((k) + 1)) xcd_barrier(bar); } while (0)
#ifndef REP_MASK
#define REP_MASK 0
#endif
#ifndef PE_EXP_MASK
#define PE_EXP_MASK 0x3fff
#endif
#define REPS(k) for (int rep_ = 0; rep_ < (((REP_MASK >> (k)) & 1) ? 2 : 1); ++rep_, (rep_ < (((REP_MASK >> (k)) & 1) ? 2 : 1) ? xcd_barrier(bar) : (void)0))
    using namespace pg8;
    bf16* XB = (bf16*)(ws + WS_XB);

    if (IN(0)) REPS(0) { p0_prologue(P, lds, tid, lane, wave, vcu, G); }
    SEAM(0);
    if (IN(1)) REPS(1) {
        { Gemm gm{XB, (const bf16_t*)(ws + WS_WIN), T, 3072, 1024}; StaticOrder S; S.init(T, 3072, G, bx);
          EpiBf16Rs E{(bf16_t*)(ws + WS_QKV), 1536, 6, (bf16_t*)(ws + WS_XR), 512, (size_t)T * 512, nullptr, 1.0f};
          gemm_phase<EpiBf16Rs, StaticOrder, PG8_ALIGN, PG8_SP2>(lds, gm, S, E); }
    }
    SEAM(1);
    if (IN(2)) REPS(2) {
#ifndef P2_REP_GDN
#define P2_REP_GDN 1
#endif
#ifndef P2_REP_LRU
#define P2_REP_LRU 1
#endif
        for (int rr = 0; rr < P2_REP_GDN; ++rr) for (int it = bx; it < 1024; it += G) gdn_local_item(P, lds, it, tid);
    }
    SEAM(2);
    if (IN(3)) REPS(3) {
        if (bx < SCAN_WGS) gdn_scan(P, lds, bx, tid, lane, wave);
        else {
            const int wk = bx - SCAN_WGS, NWK = G - SCAN_WGS;
            unsigned* lcnt = (unsigned*)(ws + WS_CTL) + CW_LRUCNT;
            if (wk < 16) {
                struct OneUnit { int pm, pn; __device__ bool next(int i, Unit& u) const { if (i > 0) return false; u.pm = pm; u.pn = pn; return true; }
                                 __device__ void a_ready(const Unit&) const {} __device__ void done(const Unit&) const {} };
                Gemm gm{(const bf16_t*)(ws + WS_MEMN), (const bf16_t*)(ws + WS_WKV), 512, 2048, 1024}; OneUnit S{wk >> 3, wk & 7};
                EpiKV E{(bf16_t*)(ws + WS_KB), (bf16_t*)(ws + WS_VTP)};
                gemm_phase<EpiKV, OneUnit, PG8_ALIGN, PG8_SP2>(lds, gm, S, E);
            }
            unsigned ndone = 0;
            for (int lt = wk; lt < 256; lt += NWK) { lru_local_item(P, lds, lt, tid, lane, wave); ++ndone; }
            asm volatile("s_waitcnt vmcnt(0)" ::: "memory");
            __syncthreads();
            if (tid == 0 && ndone) { __builtin_amdgcn_fence(__ATOMIC_RELEASE, "agent"); asm volatile("s_waitcnt vmcnt(0)" ::: "memory");
                                     __hip_atomic_fetch_add(lcnt, ndone, __ATOMIC_RELAXED, __HIP_MEMORY_SCOPE_AGENT); }
            if (wk == 16 || wk == 17) {
                if (tid == 0) { unsigned sp = 0;
                    while (__hip_atomic_load(lcnt, __ATOMIC_RELAXED, __HIP_MEMORY_SCOPE_AGENT) < 256u) { __builtin_amdgcn_s_sleep(8); if (++sp > (1u << 22)) break; }
                    __builtin_amdgcn_fence(__ATOMIC_ACQUIRE, "agent"); asm volatile("s_waitcnt vmcnt(0)" ::: "memory"); }
                __syncthreads();
                lru_carry(P, (wk - 16) * NWAVES + wave, lane);
            } else {
                const int w2 = (wk < 16 ? wk : wk - 2), N2 = NWK - 2;
                cvt_table_fp8(P.peer_u, ws + WS_UB, (float*)(ws + WS_USC), w2 * NWAVES + wave, N2 * NWAVES, lane);
                cvt_table_fp8(P.peer_v, ws + WS_VB, (float*)(ws + WS_VSC), w2 * NWAVES + wave, N2 * NWAVES, lane);
                late_weight_prep(P, lds, lane, wave, w2 * NWAVES + wave, N2 * NWAVES);
            }
        }
    }
    SEAM(3);
    if (IN(4)) REPS(4) {
        gdn_gate_norm(P, (size_t)bx * (NWAVES * 64) + tid, (size_t)G * (NWAVES * 64));
        lru_combine(P, (size_t)bx * (NWAVES * 64) + tid, (size_t)G * (NWAVES * 64));
    }
    SEAM(4);
    if (IN(5)) {
        Gemm gm{(const bf16_t*)(ws + WS_Y), (const bf16_t*)(ws + WS_WOUT), T, 1024, 1024}; StaticOrder S; S.init(T, 1024, G, bx);
        EpiResid E{P.x, P.out, XB, (float*)(ws + WS_SSQ1)};
        gemm_phase<EpiResid, StaticOrder, PG8_ALIGN, PG8_SP2>(lds, gm, S, E);
    }
    SEAM(5);
    if (IN(6)) REPS(6) {
        Gemm gm{XB, (const bf16_t*)(ws + WS_WQ), T, 1024, 1024}; StaticOrder S; S.init(T, 1024, G, bx);
        EpiBf16Rs E{(bf16_t*)(ws + WS_Q), 1024, 4, nullptr, 256, 0, (const float*)(ws + WS_SSQ1), 0.0625f};
        gemm_phase<EpiBf16Rs, StaticOrder, PG8_ALIGN, PG8_SP2>(lds, gm, S, E);
    }
    SEAM(6);
    if (IN(7)) REPS(7) {
        for (int un = bx; un < 512; un += G) xattn_unit(P, lds, un, tid, lane, wave);
    }
    SEAM(7);
    if (IN(8)) {
        Gemm gm{(const bf16_t*)(ws + WS_AO), (const bf16_t*)(ws + WS_WO), T, 1024, 1024}; StaticOrder S; S.init(T, 1024, G, bx);
        EpiResid E{P.out, P.out, XB, (float*)(ws + WS_SSQ2)};
        gemm_phase<EpiResid, StaticOrder, PG8_ALIGN, PG8_SP2>(lds, gm, S, E);
    }
    SEAM(8);
    if (IN(9)) REPS(9) {
        Gemm gm{XB, (const bf16_t*)(ws + WS_PWQ), T, 2048, 1024}; StaticOrder S; S.init(T, 2048, G, bx);
        EpiF16Rs E{(_Float16*)(ws + WS_PQ), 2048, (const float*)(ws + WS_SSQ2)};
        gemm_phase<EpiF16Rs, StaticOrder, PG8_ALIGN, PG8_SP2>(lds, gm, S, E);
    }
    SEAM(9);
    if (IN(10)) REPS(10) {
        for (int rb = bx * 256; rb < T * 8; rb += G * 256) peer_topk_rows(P, lds, rb, tid);
    }
    SEAM(10);
    if (IN(11)) REPS(11) {
        for (int tb = (bx * NWAVES + wave) * PE_NT; tb < T; tb += G * NWAVES * PE_NT) peer_pass(P, lds, tb, lane, wave, (((REP_MASK >> 11) & 1) && rep_ == 0) ? (float*)(ws + WS_PQ) : P.out, (((REP_MASK >> 11) & 1) && rep_ == 0) ? PE_EXP_MASK : 0x3fff);
    }
#undef IN
#undef SEAM
}

extern "C" void kernel_launch(void* const* d_in, const int* in_sizes, int n_in, void* d_out, int out_size, void* d_ws, size_t ws_size, hipStream_t stream) {
    static int grid = 0;
    if (grid == 0) {
        if (n_in != 27 || in_sizes[0] != T * D || out_size != T * D || ws_size < WS_END) {
            fprintf(stderr, "kernel_launch: unexpected shapes (n_in %d, in0 %d, out %d, ws %zu); nothing launched\n", n_in, n_in > 0 ? in_sizes[0] : -1, out_size, ws_size); grid = -1; return; }
        int dev = 0, cus = 0, per_cu = 0;
        if (hipGetDevice(&dev) != hipSuccess || hipDeviceGetAttribute(&cus, hipDeviceAttributeMultiprocessorCount, dev) != hipSuccess) { grid = -1; return; }
        if (hipFuncSetAttribute((const void*)hybrid_fwd, hipFuncAttributeMaxDynamicSharedMemorySize, LDS_BYTES) != hipSuccess) { fprintf(stderr, "kernel_launch: hipFuncSetAttribute failed\n"); grid = -1; return; }
        if (hipOccupancyMaxActiveBlocksPerMultiprocessor(&per_cu, (const void*)hybrid_fwd, NWAVES * 64, LDS_BYTES) != hipSuccess || per_cu < 1)
            fprintf(stderr, "kernel_launch: note: occupancy query reports %d workgroups per CU\n", per_cu);
        (void)hipGetLastError();
        grid = cus;
        if (grid != 256) fprintf(stderr, "kernel_launch: %d CUs (built for 256)\n", grid);
    }
    if (grid < 0) return;
    if (hipMemsetAsync((char*)d_ws + WS_CTL, 0, CTL_ZERO_BYTES, stream) != hipSuccess) { fprintf(stderr, "kernel_launch: hipMemsetAsync failed\n"); return; }
    Params p{};
    const float** pp = (const float**)&p;
    for (int i = 0; i < 27; ++i) pp[i] = (const float*)d_in[i];
    p.out = (float*)d_out; p.ws = (unsigned char*)d_ws;
#if MK_PER_PHASE
    for (int k = 0; k < N_PHASES; ++k) { p.ph_lo = k; p.ph_hi = k + 1; hipLaunchKernelGGL(hybrid_fwd, dim3(grid), dim3(NWAVES * 64), LDS_BYTES, stream, p); }
#else
    p.ph_lo = 0; p.ph_hi = N_PHASES;
    hipLaunchKernelGGL(hybrid_fwd, dim3(grid), dim3(NWAVES * 64), LDS_BYTES, stream, p);
#endif
    const hipError_t le = hipPeekAtLastError();
    if (le != hipSuccess) fprintf(stderr, "kernel_launch: launch failed: %s\n", hipGetErrorName(le));
}
```

```cpp
#include <hip/hip_runtime.h>
#include <cstdio>
#include <cstdint>
namespace pg8 {
#define PG8_LAS __attribute__((address_space(3)))
typedef unsigned short bf16_t;
typedef short bf16x8 __attribute__((ext_vector_type(8)));
typedef float f32x4 __attribute__((ext_vector_type(4)));
typedef unsigned u32x4 __attribute__((ext_vector_type(4)));
constexpr int BM = 256, BK = 64, HALF = 128, HTB = HALF * BK * 2  , STAGE_BYTES = 8 * HTB, NXCD = 8, WGM = 8;

__host__ __device__ __forceinline__ int lds_byte(int r, int c) { const int st = (r >> 4) * 2 + (c >> 5), rr = r & 15, cc = c & 31, ob = rr * 64 + cc * 2; return st * 1024 + (ob ^ (((ob >> 9) & 1) << 5)); }
__host__ __device__ __forceinline__ void stage_rc(int b, int& R, int& C) { const int st = b / 1024, sb = b % 1024, swz = sb ^ (((sb >> 9) & 1) << 5); R = (st >> 1) * 16 + swz / 64; C = (st & 1) * 32 + (swz % 64) / 2; }
__host__ __device__ __forceinline__ int perm32(int rho) { const int n = rho >> 4, i = rho & 15; return 8 * (i >> 2) + 4 * n + (i & 3); }

struct Unit { int pm, pn; };
struct Gemm { const bf16_t* A; const bf16_t* Bt; int M, N, K; };

struct StaticOrder {
    int nM, nN, nwg, G, c;
    __host__ __device__ void init(int M, int N, int G_, int c_) { nM = M / BM; nN = N / BM; nwg = nM * nN; G = G_; c = c_; }
    __host__ __device__ bool next(int i, Unit& u) const {
        const long L = (long)i * G + c; if (L >= nwg) return false;
        int wgid = (int)L; { const int q = nwg / NXCD, r = nwg % NXCD, xcd = wgid % NXCD, off = wgid / NXCD; wgid = (xcd < r ? xcd * (q + 1) : r * (q + 1) + (xcd - r) * q) + off; }
        const int nig = WGM * nN, gid = wgid / nig, fm = gid * WGM, gsz = (nM - fm) < WGM ? (nM - fm) : WGM;
        u.pm = fm + ((wgid % nig) % gsz); u.pn = (wgid % nig) / gsz; return true;
    }
    __device__ __forceinline__ void a_ready(const Unit&) const {}
    __device__ __forceinline__ void done(const Unit&) const {}
};

__device__ __forceinline__ unsigned cvt_pk_bf16(float lo, float hi) { unsigned r; asm volatile("v_cvt_pk_bf16_f32 %0, %1, %2" : "=v"(r) : "v"(lo), "v"(hi)); return r; }
template <class Epi, class Sched, bool ALIGN_EPI = false, bool SP2 = false>
__device__ __forceinline__ void gemm_phase(PG8_LAS unsigned char* lds, const Gemm g, const Sched& S, const Epi& E) {
    const int tid = threadIdx.x, wid = __builtin_amdgcn_readfirstlane(tid >> 6), lane = tid & 63, wr = wid >> 2, wc = wid & 3, fr = lane & 15, fq = lane >> 4;
    const int K = g.K, nt = K / BK;
    unsigned voffA[2], voffB[2];
#pragma unroll
    for (int i = 0; i < 2; ++i) { int R, C; stage_rc(tid * 16 + i * 8192, R, C); const int Rb = Epi::PERM ? ((R & ~31) + perm32(R & 31)) : R;
        voffA[i] = (unsigned)(R * K + C) * 2u; voffB[i] = (unsigned)(Rb * K + C) * 2u; }
    const size_t kstep = (size_t)(BK * 2);
    const size_t hstep = (size_t)HALF * K * 2;
    const size_t tstep = 2 * hstep;
    const unsigned ldsw = (unsigned)wid * 1024u;
    const int aoff = lds_byte(wr * 64 + fr, fq * 8), boff = lds_byte(wc * 32 + fr, fq * 8);
#define PG8_SA(b, h) (((b) * 2 + (h)) * HTB)
#define PG8_SB(b, h) ((4 + (b) * 2 + (h)) * HTB)
#define PG8_STAGE(bufoff, gbase, voff) do { _Pragma("unroll") for (int _i = 0; _i < 2; ++_i) \
        __builtin_amdgcn_global_load_lds((const unsigned*)((const char*)(gbase) + (voff)[_i]), (PG8_LAS unsigned*)(lds + (bufoff) + ldsw + _i * 8192), 16, 0, 0); } while (0)
#define PG8_LDA(dst, b, h) do { _Pragma("unroll") for (int m = 0; m < 4; ++m) _Pragma("unroll") for (int k = 0; k < 2; ++k) dst[m][k] = *(const PG8_LAS bf16x8*)(lds + PG8_SA(b, h) + aoff + m * 2048 + k * 1024); } while (0)
#define PG8_LDB(dst, b, h) do { _Pragma("unroll") for (int n = 0; n < 2; ++n) _Pragma("unroll") for (int k = 0; k < 2; ++k) dst[n][k] = *(const PG8_LAS bf16x8*)(lds + PG8_SB(b, h) + boff + n * 2048 + k * 1024); } while (0)
#define PG8_MMA(ai, bj, At, Bt) do { __builtin_amdgcn_s_setprio(1); _Pragma("unroll") for (int m = 0; m < 4; ++m) _Pragma("unroll") for (int n = 0; n < 2; ++n) _Pragma("unroll") for (int k = 0; k < 2; ++k) \
        acc[ai][bj][m][n] = __builtin_amdgcn_mfma_f32_16x16x32_bf16(Bt[n][k], At[m][k], acc[ai][bj][m][n], 0, 0, 0); __builtin_amdgcn_s_setprio(0); } while (0)
#define PG8_WAIT_V(n) asm volatile("s_waitcnt vmcnt(" #n ")" ::: "memory")
#define PG8_WAIT_L(n) asm volatile("s_waitcnt lgkmcnt(" #n ")" ::: "memory")
#define PG8_BAR __builtin_amdgcn_s_barrier()
#define PG8_SCHED __builtin_amdgcn_sched_barrier(0)
    Unit cur, nxt; int ui = 0;
    if (!S.next(0, cur)) return;
    f32x4 acc[2][2][4][2];
#pragma unroll
    for (int a = 0; a < 2; ++a)
#pragma unroll
        for (int b = 0; b < 2; ++b)
#pragma unroll
            for (int m = 0; m < 4; ++m)
#pragma unroll
                for (int n = 0; n < 2; ++n) acc[a][b][m][n] = (f32x4){0.f, 0.f, 0.f, 0.f};
    bf16x8 At[4][2], B0[2][2], B1[2][2];
    const char* cA = (const char*)g.A + (size_t)cur.pm * tstep; const char* cB = (const char*)g.Bt + (size_t)cur.pn * tstep;
    S.a_ready(cur);
    if constexpr (SP2) {
        PG8_STAGE(PG8_SB(0, 0), cB, voffB); PG8_STAGE(PG8_SB(0, 1), cB + hstep, voffB); PG8_STAGE(PG8_SA(0, 0), cA, voffA); PG8_STAGE(PG8_SA(0, 1), cA + hstep, voffA);
        if (wr == 1) PG8_BAR;
        PG8_WAIT_V(2); PG8_BAR;
        PG8_STAGE(PG8_SB(1, 0), cB + kstep, voffB); PG8_STAGE(PG8_SA(1, 0), cA + kstep, voffA); PG8_STAGE(PG8_SB(1, 1), cB + hstep + kstep, voffB);
        PG8_WAIT_V(6); PG8_BAR;
    } else {
        PG8_STAGE(PG8_SB(0, 0), cB, voffB); PG8_STAGE(PG8_SA(0, 0), cA, voffA); PG8_STAGE(PG8_SB(0, 1), cB + hstep, voffB); PG8_STAGE(PG8_SA(0, 1), cA + hstep, voffA);
        if (wr == 1) PG8_BAR;
        PG8_WAIT_V(4); PG8_BAR;
        PG8_STAGE(PG8_SB(1, 0), cB + kstep, voffB); PG8_STAGE(PG8_SA(1, 0), cA + kstep, voffA); PG8_STAGE(PG8_SB(1, 1), cB + hstep + kstep, voffB);
        PG8_WAIT_V(6); PG8_BAR;
    }
    for (;;) {
        const bool has_next = S.next(ui + 1, nxt);
        const char* nA = has_next ? (const char*)g.A + (size_t)nxt.pm * tstep : cA; const char* nB = has_next ? (const char*)g.Bt + (size_t)nxt.pn * tstep : cB;
        for (int t = 0; t < nt; t += 2) {
            const bool last = (t == nt - 2);
            const char* a1 = cA + (size_t)(t + 1) * kstep;
            const char* a2 = last ? nA : cA + (size_t)(t + 2) * kstep; const char* b2 = last ? nB : cB + (size_t)(t + 2) * kstep;
            const char* a3 = a2 + kstep; const char* b3 = b2 + kstep;
            if (last && has_next) S.a_ready(nxt);
            if constexpr (SP2) {
            PG8_LDB(B0, 0, 0); PG8_LDB(B1, 0, 1); PG8_SCHED; PG8_LDA(At, 0, 0); PG8_STAGE(PG8_SA(1, 1), a1 + hstep, voffA);
            PG8_WAIT_V(8); PG8_WAIT_L(0); PG8_BAR; PG8_MMA(0, 0, At, B0); PG8_MMA(0, 1, At, B1); PG8_BAR; PG8_SCHED;
            PG8_LDA(At, 0, 1); PG8_STAGE(PG8_SB(0, 0), b2, voffB); PG8_STAGE(PG8_SB(0, 1), b2 + hstep, voffB); PG8_STAGE(PG8_SA(0, 0), a2, voffA);
            PG8_WAIT_V(8); PG8_WAIT_L(0); PG8_BAR; PG8_MMA(1, 0, At, B0); PG8_MMA(1, 1, At, B1); PG8_BAR; PG8_SCHED;
            PG8_LDB(B0, 1, 0); PG8_LDB(B1, 1, 1); PG8_SCHED; PG8_LDA(At, 1, 0); PG8_STAGE(PG8_SA(0, 1), a2 + hstep, voffA);
            PG8_WAIT_V(8); PG8_WAIT_L(0); PG8_BAR; PG8_MMA(0, 0, At, B0); PG8_MMA(0, 1, At, B1); PG8_BAR; PG8_SCHED;
            PG8_LDA(At, 1, 1); PG8_STAGE(PG8_SB(1, 0), b3, voffB); PG8_STAGE(PG8_SB(1, 1), b3 + hstep, voffB); PG8_STAGE(PG8_SA(1, 0), a3, voffA);
            PG8_WAIT_V(8); PG8_WAIT_L(0); PG8_BAR; PG8_MMA(1, 0, At, B0); PG8_MMA(1, 1, At, B1); PG8_BAR; PG8_SCHED;
            } else {
            PG8_LDB(B0, 0, 0); PG8_SCHED; PG8_LDA(At, 0, 0); PG8_STAGE(PG8_SA(1, 1), a1 + hstep, voffA);
            PG8_WAIT_L(8); PG8_BAR; PG8_WAIT_L(0); PG8_MMA(0, 0, At, B0); PG8_BAR; PG8_SCHED;
            PG8_LDB(B1, 0, 1); PG8_STAGE(PG8_SB(0, 0), b2, voffB);
            PG8_BAR; PG8_WAIT_L(0); PG8_MMA(0, 1, At, B1); PG8_BAR;
            PG8_LDA(At, 0, 1); PG8_STAGE(PG8_SA(0, 0), a2, voffA);
            PG8_BAR; PG8_WAIT_L(0); PG8_MMA(1, 0, At, B0); PG8_BAR; PG8_SCHED;
            PG8_STAGE(PG8_SB(0, 1), b2 + hstep, voffB);
            PG8_WAIT_V(6); PG8_BAR; PG8_MMA(1, 1, At, B1); PG8_BAR;
            PG8_LDB(B0, 1, 0); PG8_SCHED; PG8_LDA(At, 1, 0); PG8_STAGE(PG8_SA(0, 1), a2 + hstep, voffA);
            PG8_WAIT_L(8); PG8_BAR; PG8_WAIT_L(0); PG8_MMA(0, 0, At, B0); PG8_BAR; PG8_SCHED;
            PG8_LDB(B1, 1, 1); PG8_STAGE(PG8_SB(1, 0), b3, voffB);
            PG8_BAR; PG8_WAIT_L(0); PG8_MMA(0, 1, At, B1); PG8_BAR;
            PG8_LDA(At, 1, 1); PG8_STAGE(PG8_SA(1, 0), a3, voffA);
            PG8_BAR; PG8_WAIT_L(0); PG8_MMA(1, 0, At, B0); PG8_BAR; PG8_SCHED;
            PG8_STAGE(PG8_SB(1, 1), b3 + hstep, voffB);
            PG8_WAIT_V(6); PG8_BAR; PG8_MMA(1, 1, At, B1); PG8_BAR;
            }
        }
        if constexpr (ALIGN_EPI) { if (wr == 0) PG8_BAR; }
        if constexpr (!Epi::AFTER_DRAIN) { E(acc, cur, wr, wc, fr, fq); S.done(cur); }
        if (!has_next) break;
#pragma unroll
        for (int a = 0; a < 2; ++a)
#pragma unroll
            for (int b = 0; b < 2; ++b)
#pragma unroll
                for (int m = 0; m < 4; ++m)
#pragma unroll
                    for (int n = 0; n < 2; ++n) acc[a][b][m][n] = (f32x4){0.f, 0.f, 0.f, 0.f};
        cur = nxt; cA = nA; cB = nB; ++ui;
        if constexpr (ALIGN_EPI) { if (wr == 1) PG8_BAR; }
    }
    PG8_WAIT_V(0);
    if constexpr (!ALIGN_EPI) { if (wr == 0) PG8_BAR; }
    PG8_BAR;
    if constexpr (Epi::AFTER_DRAIN) { E.fused(acc, cur, wr, wc, fr, fq, lds, wid, lane); S.done(cur); }
#undef PG8_SA
#undef PG8_SB
#undef PG8_STAGE
#undef PG8_LDA
#undef PG8_LDB
#undef PG8_MMA
#undef PG8_WAIT_V
#undef PG8_WAIT_L
#undef PG8_BAR
#undef PG8_SCHED
}
}

namespace pg8 {
__host__ __device__ __forceinline__ int permk(int kl) { return 8 * ((kl & 15) >> 2) + 4 * (kl >> 4) + (kl & 3); }
struct EpiBf16Rs {
    static constexpr bool PERM = true, AFTER_DRAIN = false;
    bf16_t* O0; int ld0; int ntile0; bf16_t* O1; int ld1; size_t stride1; const float* ssq; float cs;
    __device__ __forceinline__ void operator()(const f32x4 (&acc)[2][2][4][2], const Unit& u, int wr, int wc, int fr, int fq) const {
        bf16_t* base; int ld, colt;
        if (u.pn < ntile0) { base = O0; ld = ld0; colt = u.pn * BM; }
        else { const int q = u.pn - ntile0, per = ld1 / BM; base = O1 + (size_t)(q / per) * stride1; ld = ld1; colt = (q % per) * BM; }
        const int row0 = u.pm * BM + wr * 64 + fr, col0 = colt + wc * 32 + 8 * fq;
#pragma unroll
        for (int ai = 0; ai < 2; ++ai)
#pragma unroll
            for (int m = 0; m < 4; ++m) {
                const int row = row0 + ai * HALF + m * 16;
                float sc = cs; if (ssq) sc *= rsqrtf(ssq[row] * (1.0f / 1024.0f) + 1e-6f);
                bf16_t* rowp = base + (size_t)row * ld + col0;
#pragma unroll
                for (int bj = 0; bj < 2; ++bj) { const f32x4 v0 = acc[ai][bj][m][0] * sc, v1 = acc[ai][bj][m][1] * sc;
                    u32x4 w; w.x = cvt_pk_bf16(v0[0], v0[1]); w.y = cvt_pk_bf16(v0[2], v0[3]); w.z = cvt_pk_bf16(v1[0], v1[1]); w.w = cvt_pk_bf16(v1[2], v1[3]);
                    *(u32x4*)(rowp + bj * HALF) = w; } }
    }
};
struct EpiF16Rs {
    static constexpr bool PERM = true, AFTER_DRAIN = false;
    _Float16* O; int ld; const float* ssq;
    __device__ __forceinline__ void operator()(const f32x4 (&acc)[2][2][4][2], const Unit& u, int wr, int wc, int fr, int fq) const {
        typedef _Float16 f16x8 __attribute__((ext_vector_type(8)));
        const int row0 = u.pm * BM + wr * 64 + fr, col0 = u.pn * BM + wc * 32 + 8 * fq;
#pragma unroll
        for (int ai = 0; ai < 2; ++ai)
#pragma unroll
            for (int m = 0; m < 4; ++m) {
                const int row = row0 + ai * HALF + m * 16;
                const float sc = rsqrtf(ssq[row] * (1.0f / 1024.0f) + 1e-6f);
                _Float16* rowp = O + (size_t)row * ld + col0;
#pragma unroll
                for (int bj = 0; bj < 2; ++bj) { const f32x4 v0 = acc[ai][bj][m][0] * sc, v1 = acc[ai][bj][m][1] * sc;
                    f16x8 w; w[0] = (_Float16)v0[0]; w[1] = (_Float16)v0[1]; w[2] = (_Float16)v0[2]; w[3] = (_Float16)v0[3];
                    w[4] = (_Float16)v1[0]; w[5] = (_Float16)v1[1]; w[6] = (_Float16)v1[2]; w[7] = (_Float16)v1[3];
                    *(f16x8*)(rowp + bj * HALF) = w; } }
    }
};
template <bool BASE_F32> struct EpiResidBf {
    static constexpr bool PERM = true, AFTER_DRAIN = false;
    const float* basef; bf16_t* xb; float* ssq;
    __device__ __forceinline__ void operator()(const f32x4 (&acc)[2][2][4][2], const Unit& u, int wr, int wc, int fr, int fq) const {
        const int row0 = u.pm * BM + wr * 64 + fr, col0 = u.pn * BM + wc * 32 + 8 * fq;
#pragma unroll
        for (int ai = 0; ai < 2; ++ai)
#pragma unroll
            for (int m = 0; m < 4; ++m) {
                const int row = row0 + ai * HALF + m * 16; const size_t off = (size_t)row * 1024 + col0; float s = 0.f;
#pragma unroll
                for (int bj = 0; bj < 2; ++bj) { const size_t o2 = off + bj * HALF;
                    f32x4 b0, b1;
                    if (BASE_F32) { b0 = *(const f32x4*)(basef + o2); b1 = *(const f32x4*)(basef + o2 + 4); }
                    else { const u32x4 p = *(const u32x4*)(xb + o2);
                        b0 = (f32x4){__builtin_bit_cast(float, p.x << 16), __builtin_bit_cast(float, p.x & 0xffff0000u), __builtin_bit_cast(float, p.y << 16), __builtin_bit_cast(float, p.y & 0xffff0000u)};
                        b1 = (f32x4){__builtin_bit_cast(float, p.z << 16), __builtin_bit_cast(float, p.z & 0xffff0000u), __builtin_bit_cast(float, p.w << 16), __builtin_bit_cast(float, p.w & 0xffff0000u)}; }
                    const f32x4 o0 = b0 + acc[ai][bj][m][0], o1 = b1 + acc[ai][bj][m][1];
                    s += ((o0[0] * o0[0] + o0[1] * o0[1]) + (o0[2] * o0[2] + o0[3] * o0[3])) + ((o1[0] * o1[0] + o1[1] * o1[1]) + (o1[2] * o1[2] + o1[3] * o1[3]));
                    u32x4 w; w.x = cvt_pk_bf16(o0[0], o0[1]); w.y = cvt_pk_bf16(o0[2], o0[3]); w.z = cvt_pk_bf16(o1[0], o1[1]); w.w = cvt_pk_bf16(o1[2], o1[3]);
                    *(u32x4*)(xb + o2) = w; }
                s += __shfl_xor(s, 16); s += __shfl_xor(s, 32);
                if (fq == 0) atomicAdd(ssq + row, s);
            }
    }
};
struct EpiKV {
    static constexpr bool PERM = false, AFTER_DRAIN = false;
    bf16_t* Kb; bf16_t* VTp;
    __device__ __forceinline__ void operator()(const f32x4 (&acc)[2][2][4][2], const Unit& u, int wr, int wc, int fr, int fq) const {
        typedef unsigned u32x2v __attribute__((ext_vector_type(2)));
        const int row0 = u.pm * BM + wr * 64 + fr, col0 = u.pn * BM + wc * 32 + 4 * fq;
#pragma unroll
        for (int ai = 0; ai < 2; ++ai)
#pragma unroll
            for (int m = 0; m < 4; ++m) {
                const int row = row0 + ai * HALF + m * 16, b = row >> 8, key = row & 255;
#pragma unroll
                for (int bj = 0; bj < 2; ++bj)
#pragma unroll
                    for (int n = 0; n < 2; ++n) { const int col = col0 + bj * HALF + n * 16; const f32x4 v = acc[ai][bj][m][n];
                        const unsigned p01 = cvt_pk_bf16(v[0], v[1]), p23 = cvt_pk_bf16(v[2], v[3]);
                        if (col < 1024) { const int h = col >> 8, dh = col & 255; u32x2v w; w.x = p01; w.y = p23;
                            *(u32x2v*)(Kb + ((size_t)((b * 4 + h) * 256 + key)) * 256 + dh) = w; }
                        else { const int c2 = col - 1024, h = c2 >> 8, dv = c2 & 255, kp = (key & ~31) | permk(key & 31);
                            bf16_t* d = VTp + ((size_t)((b * 4 + h) * 256 + dv)) * 256 + kp;
                            d[0] = (bf16_t)(p01 & 0xffffu); d[256] = (bf16_t)(p01 >> 16); d[512] = (bf16_t)(p23 & 0xffffu); d[768] = (bf16_t)(p23 >> 16); } }
            }
    }
};
}
#ifndef PG8_SP2
#define PG8_SP2 true
#endif
#ifndef PG8_ALIGN
#define PG8_ALIGN true
#endif

constexpr int NWAVES = 8;
#ifndef MK_PER_PHASE
#define MK_PER_PHASE 0
#endif
constexpr int T = 16384, SEQ = 8192, D = 1024;
constexpr int N_PHASES = 12;

constexpr size_t MiB = 1u << 20, KiB = 1u << 10;
constexpr size_t WS_CTL = 0, CTL_ZERO_BYTES = 1 * MiB;
constexpr int CW_BAR = 4096;
constexpr size_t WS_SSQ1 = 64 * KiB, WS_SSQ2 = 128 * KiB;
constexpr size_t WS_AB = 1 * MiB;
constexpr size_t WS_HEND = WS_AB + 512 * KiB, WS_PEND = WS_HEND + 512 * KiB, WS_HIN = WS_PEND + 512 * KiB;
constexpr size_t WS_DEC = WS_HIN + 512 * KiB;
constexpr size_t WS_SUBK = 3 * MiB + 256 * KiB;
constexpr size_t WS_WIN = 4 * MiB, WS_WOUT = 10 * MiB, WS_WQ = 12 * MiB, WS_WKV = 14 * MiB, WS_WO = 18 * MiB, WS_PWQ = 20 * MiB;
constexpr size_t WS_MEMN = 24 * MiB, WS_KB = 25 * MiB, WS_VTP = 26 * MiB, WS_LRUWT = 27 * MiB, WS_USC = 27 * MiB + 256 * KiB, WS_VSC = 27 * MiB + 384 * KiB;
constexpr size_t WS_XB = 28 * MiB;
constexpr size_t WS_HLOC = 28 * MiB, WS_PCUM = 44 * MiB;
constexpr size_t WS_QKV = 60 * MiB;
constexpr size_t WS_Y = 60 * MiB;
constexpr size_t WS_IDX = 60 * MiB, WS_GW = 68 * MiB;
constexpr size_t WS_UB = 92 * MiB;
constexpr size_t WS_XR = 108 * MiB, WS_Z = 124 * MiB, WS_GATE = 140 * MiB;
constexpr size_t WS_WN = 156 * MiB, WS_UF = 172 * MiB, WS_QD = 188 * MiB, WS_KD = 204 * MiB, WS_ATT = 220 * MiB;
constexpr size_t WS_VB = 228 * MiB;
constexpr size_t WS_Q = 188 * MiB, WS_AO = 124 * MiB;
constexpr size_t WS_PQ = 108 * MiB;
constexpr size_t WS_END = 244 * MiB;
constexpr int CW_LRUCNT = 8192;
static_assert(WS_XR - WS_QKV == (size_t)T * 1536 * 2 && WS_Z - WS_XR == (size_t)T * 512 * 2 && WS_GATE - WS_Z == (size_t)T * 512 * 2, "in-proj outputs are contiguous");

constexpr int LDS_BYTES = 160 * 1024;
constexpr int MISC_OFF = 159 * 1024;

#define GAS __attribute__((address_space(1)))
#define LAS __attribute__((address_space(3)))
typedef unsigned short bf16;
typedef unsigned v4u __attribute__((ext_vector_type(4)));
typedef unsigned v2u __attribute__((ext_vector_type(2)));
typedef float f32x4 __attribute__((ext_vector_type(4)));
typedef short bf16x8 __attribute__((ext_vector_type(8)));
typedef GAS unsigned gu32;
#define LDS_WAIT() asm volatile("s_waitcnt lgkmcnt(0)" ::: "memory")
__device__ __forceinline__ unsigned f2bf(float f) { unsigned u = __builtin_bit_cast(unsigned, f); return (u + 0x7fffu + ((u >> 16) & 1u)) >> 16; }
__device__ __forceinline__ unsigned pk2(float lo, float hi) { return f2bf(lo) | (f2bf(hi) << 16); }
__device__ __forceinline__ float bflo(unsigned u) { return __builtin_bit_cast(float, u << 16); }
__device__ __forceinline__ float bfhi(unsigned u) { return __builtin_bit_cast(float, u & 0xffff0000u); }
__device__ __forceinline__ float bf1(bf16 h) { return __builtin_bit_cast(float, (unsigned)h << 16); }
__device__ __forceinline__ float wave_sum(float v) {
#pragma unroll
    for (int o = 1; o < 64; o <<= 1) v += __shfl_xor(v, o);
    return v;
}
__device__ __forceinline__ float row16_sum(float v) {
    v += __builtin_bit_cast(float, __builtin_amdgcn_update_dpp(0, __builtin_bit_cast(int, v), 0xB1, 0xF, 0xF, true));
    v += __builtin_bit_cast(float, __builtin_amdgcn_update_dpp(0, __builtin_bit_cast(int, v), 0x4E, 0xF, 0xF, true));
    v += __builtin_bit_cast(float, __builtin_amdgcn_update_dpp(0, __builtin_bit_cast(int, v), 0x141, 0xF, 0xF, true));
    v += __builtin_bit_cast(float, __builtin_amdgcn_update_dpp(0, __builtin_bit_cast(int, v), 0x140, 0xF, 0xF, true));
    return v;
}
__device__ __forceinline__ float sigmoidf_(float x) { return __builtin_amdgcn_rcpf(1.0f + __expf(-x)); }
__device__ __forceinline__ float softplusf_(float x) { return fmaxf(x, 0.f) + log1pf(__expf(-fabsf(x))); }
__device__ __forceinline__ float siluf_(float x) { return x * __builtin_amdgcn_rcpf(1.0f + __expf(-x)); }
__device__ __forceinline__ float gelu_tanh(float x) { const float y = 0.7978845608028654f * (x + 0.044715f * x * x * x); const float e = __expf(2.0f * y); return x * (1.0f - __builtin_amdgcn_rcpf(1.0f + e)); }
__device__ __forceinline__ int permk(int kl) { return 8 * ((kl & 15) >> 2) + 4 * (kl >> 4) + (kl & 3); }

struct Params {
    const float *x, *mem, *norm_mix_w, *w_in, *conv_qkv_w, *gdn_a_log, *gdn_dt_bias, *gdn_norm_w, *lru_conv_w, *lru_conv_b, *lru_wa, *lru_ba, *lru_wx, *lru_bx, *lru_lambda, *w_out,
                *norm_xattn_w, *norm_mem_w, *xattn_wq, *xattn_wkv, *xattn_wo, *norm_ffn_w, *peer_wq, *peer_subkeys, *peer_u, *peer_v, *norm_final_w;
    float* out; unsigned char* ws; int ph_lo, ph_hi;
};
#define XB_TMO      128
#define XB_XCNT(j)  (256  + 64 * (j))
#define XB_XSUB(j)  (1280 + 64 * (j))
#define XB_XGEN(j)  (2304 + 64 * (j))
#define XB_TOP      3328
#define XB_TOPGEN   3392
#define XCD_BAR_WORDS 3456
#define XB_SPIN_CAP (1u << 18)

__device__ __forceinline__ unsigned xb_ld(unsigned* p)              { return __hip_atomic_load(p, __ATOMIC_RELAXED, __HIP_MEMORY_SCOPE_AGENT); }
__device__ __forceinline__ unsigned xb_add(unsigned* p, unsigned v) { return __hip_atomic_fetch_add(p, v, __ATOMIC_RELAXED, __HIP_MEMORY_SCOPE_AGENT); }
__device__ __forceinline__ unsigned xb_xcc_id() { return (unsigned)__builtin_amdgcn_s_getreg((3 << 11) | 20) & 0xFu; }
#define XB_SPIN(cond, bar) do { unsigned _sp = 0; while (cond) { __builtin_amdgcn_s_sleep(1); \
    if ((++_sp & 255u) == 0u) { if (xb_ld(&(bar)[XB_TMO])) break; if (_sp > XB_SPIN_CAP) { atomicAdd(&(bar)[XB_TMO], 1u); break; } } } } while (0)

struct XcdBarrier {
    unsigned* bar; unsigned x;
    volatile LAS unsigned* st;
};

__device__ __forceinline__ XcdBarrier xcd_barrier_post(unsigned* bar, volatile LAS unsigned* st) {
    XcdBarrier b; b.bar = bar; b.x = xb_xcc_id(); b.st = st;
    if (threadIdx.x == 0) (void)xb_add(&bar[XB_XCNT(b.x)], 1u);
    return b;
}
__device__ __forceinline__ void xcd_barrier_complete(unsigned* bar, unsigned x, unsigned& nloc, unsigned& nx) {
    const unsigned G = gridDim.x * gridDim.y * gridDim.z;
    unsigned sum, cnt, mine, sp = 0u;
    for (;;) {
        sum = 0u; cnt = 0u; mine = 0u;
#pragma unroll
        for (unsigned j = 0; j < 16; ++j) { const unsigned c = xb_ld(&bar[XB_XCNT(j)]); sum += c; cnt += (c > 0u) ? 1u : 0u; mine = (j == x) ? c : mine; }
        if (sum == G) break;
        __builtin_amdgcn_s_sleep(1);
        if ((++sp & 255u) == 0u) { if (xb_ld(&bar[XB_TMO])) break; if (sp > XB_SPIN_CAP) { atomicAdd(&bar[XB_TMO], 1u); break; } }
    }
    nloc = mine > 0u ? mine : 1u; nx = cnt > 0u ? cnt : 1u;
}

__device__ __forceinline__ void xcd_barrier(const XcdBarrier& b) {
    asm volatile("s_waitcnt vmcnt(0)" ::: "memory");
    __syncthreads();
    if (threadIdx.x == 0) {
        unsigned* bar = b.bar;
        __builtin_amdgcn_s_waitcnt(0);
        unsigned nloc = b.st[0], nx = b.st[1];
        if (nloc == 0u) { xcd_barrier_complete(bar, b.x, nloc, nx); b.st[0] = nloc; b.st[1] = nx; }
        const unsigned old = xb_add(&bar[XB_XSUB(b.x)], 1u);
        const unsigned gen = old / nloc;
        if (old + 1u == (gen + 1u) * nloc) {
            __builtin_amdgcn_fence(__ATOMIC_RELEASE, "agent");
            asm volatile("s_waitcnt vmcnt(0)" ::: "memory");
            const unsigned og = xb_add(&bar[XB_TOP], 1u);
            const unsigned tg = og / nx;
            if (og + 1u == (tg + 1u) * nx) xb_add(&bar[XB_TOPGEN], 1u);
            else XB_SPIN(xb_ld(&bar[XB_TOPGEN]) == tg, bar);
            __builtin_amdgcn_fence(__ATOMIC_ACQUIRE, "agent");
            xb_add(&bar[XB_XGEN(b.x)], 1u);
            asm volatile("s_waitcnt vmcnt(0)" ::: "memory");
        } else {
            XB_SPIN(xb_ld(&bar[XB_XGEN(b.x)]) == gen, bar);
            __builtin_amdgcn_fence(__ATOMIC_ACQUIRE, "agent");
            asm volatile("s_waitcnt vmcnt(0)" ::: "memory");
        }
    }
    __syncthreads();
}

__device__ __forceinline__ void p0_transpose_item(const float* W, int K, int ldw, int c0, int nblk, bf16* WT, int row_off, const float* ks, LAS float* scr, int item, int lane) {
    const int kb = item / nblk, nb = item % nblk, k0 = 64 * kb, n0 = 32 * nb;
#pragma unroll 8
    for (int i = 0; i < 32; ++i) { const int kk = 2 * i + (lane >> 5); float v = W[(size_t)(k0 + kk) * ldw + c0 + n0 + (lane & 31)]; if (ks) v *= ks[k0 + kk]; scr[kk * 33 + (lane & 31)] = v; }
    LDS_WAIT(); asm volatile("" ::: "memory");
    const int c = lane & 7;
#pragma unroll
    for (int j = 0; j < 4; ++j) { const int n = (lane >> 3) + 8 * j; const LAS float* s = scr + (8 * c) * 33 + n;
        v4u o; o.x = pk2(s[0 * 33], s[1 * 33]); o.y = pk2(s[2 * 33], s[3 * 33]); o.z = pk2(s[4 * 33], s[5 * 33]); o.w = pk2(s[6 * 33], s[7 * 33]);
        *(GAS v4u*)(WT + (size_t)(row_off + n0 + n) * K + k0 + 8 * c) = o; }
    LDS_WAIT(); asm volatile("" ::: "memory");
}

__device__ __forceinline__ void p0_prologue(const Params& P, LAS unsigned char* lds, int tid, int lane, int wave, int vcu, int G) {
    unsigned char* ws = P.ws;
    const int gw = vcu * NWAVES + wave, NGW = G * NWAVES;
    LAS float* wabl = (LAS float*)lds;
    for (int idx = tid; idx < 8192; idx += NWAVES * 64) { const int k = idx >> 3, c = idx & 7, j = k >> 8, l = (k >> 2) & 63, e = k & 3;
        wabl[((((j * 4 + e) * 2 + (c >> 2)) * 64 + l) << 2) + (c & 3)] = P.w_in[(size_t)k * 3080 + 2048 + c]; }
    __syncthreads();
    {
        bf16* XB0 = (bf16*)(ws + WS_XB); float* AB = (float*)(ws + WS_AB);
        f32x4 w4[4];
#pragma unroll
        for (int j = 0; j < 4; ++j) w4[j] = ((const f32x4*)P.norm_mix_w)[64 * j + lane];
        for (int m = gw; m < T; m += NGW) {
            const f32x4* xr = (const f32x4*)(P.x + (size_t)m * D) + lane;
            f32x4 v[4]; float s = 0.f;
#pragma unroll
            for (int j = 0; j < 4; ++j) { v[j] = xr[64 * j]; s += (v[j].x * v[j].x + v[j].y * v[j].y) + (v[j].z * v[j].z + v[j].w * v[j].w); }
            const float rstd = rsqrtf(wave_sum(s) * (1.0f / D) + 1e-6f);
            v2u* o8 = (v2u*)(XB0 + (size_t)m * D) + lane;
            float part[8];
#pragma unroll
            for (int c = 0; c < 8; ++c) part[c] = 0.f;
#pragma unroll
            for (int j = 0; j < 4; ++j) {
                v[j] = v[j] * rstd * w4[j];
                v2u o; o.x = pk2(v[j].x, v[j].y); o.y = pk2(v[j].z, v[j].w); o8[64 * j] = o;
#pragma unroll
                for (int e = 0; e < 4; ++e) {
                    const f32x4 wa = *(const LAS f32x4*)(wabl + ((((j * 4 + e) * 2 + 0) * 64 + lane) << 2));
                    const f32x4 wb = *(const LAS f32x4*)(wabl + ((((j * 4 + e) * 2 + 1) * 64 + lane) << 2));
                    const float hv = v[j][e];
                    part[0] += hv * wa.x; part[1] += hv * wa.y; part[2] += hv * wa.z; part[3] += hv * wa.w;
                    part[4] += hv * wb.x; part[5] += hv * wb.y; part[6] += hv * wb.z; part[7] += hv * wb.w;
                }
            }
#pragma unroll
            for (int c = 0; c < 8; ++c) part[c] = wave_sum(part[c]);
            float o = part[0];
#pragma unroll
            for (int c = 1; c < 8; ++c) o = (lane == c) ? part[c] : o;
            if (lane < 8) AB[(size_t)m * 8 + lane] = o;
        }
    }
    {
        bf16* MEMN = (bf16*)(ws + WS_MEMN);
        for (int m = gw; m < 512; m += NGW) {
            const f32x4* xr = (const f32x4*)(P.mem + (size_t)m * D) + lane;
            f32x4 v[4]; float s = 0.f;
#pragma unroll
            for (int j = 0; j < 4; ++j) { v[j] = xr[64 * j]; s += (v[j].x * v[j].x + v[j].y * v[j].y) + (v[j].z * v[j].z + v[j].w * v[j].w); }
            const float rstd = rsqrtf(wave_sum(s) * (1.0f / D) + 1e-6f);
            v2u* o8 = (v2u*)(MEMN + (size_t)m * D) + lane;
#pragma unroll
            for (int j = 0; j < 4; ++j) { const f32x4 w = ((const f32x4*)P.norm_mem_w)[64 * j + lane]; const f32x4 y = v[j] * rstd * w;
                v2u o; o.x = pk2(y.x, y.y); o.y = pk2(y.z, y.w); o8[64 * j] = o; }
        }
    }
    __syncthreads();
    {
        LAS float* scr = (LAS float*)(lds + wave * 16384);
        constexpr int I_IN1 = 16 * 48, I_IN2 = 16 * 16, I_KV = 16 * 64;
        constexpr int NITEMS = I_IN1 + 3 * I_IN2 + I_KV;
        for (int it = gw; it < NITEMS; it += NGW) {
            int r = it;
            if (r < I_IN1) { p0_transpose_item(P.w_in, 1024, 3080, 0, 48, (bf16*)(ws + WS_WIN), 0, nullptr, scr, r, lane); continue; } r -= I_IN1;
            if (r < I_IN2) { p0_transpose_item(P.w_in, 1024, 3080, 2056, 16, (bf16*)(ws + WS_WIN), 1536, nullptr, scr, r, lane); continue; } r -= I_IN2;
            if (r < I_IN2) { p0_transpose_item(P.w_in, 1024, 3080, 1536, 16, (bf16*)(ws + WS_WIN), 2048, nullptr, scr, r, lane); continue; } r -= I_IN2;
            if (r < I_IN2) { p0_transpose_item(P.w_in, 1024, 3080, 2568, 16, (bf16*)(ws + WS_WIN), 2560, nullptr, scr, r, lane); continue; } r -= I_IN2;
            p0_transpose_item(P.xattn_wkv, 1024, 2048, 0, 64, (bf16*)(ws + WS_WKV), 0, nullptr, scr, r, lane);
        }
    }
    {
        bf16* WT = (bf16*)(ws + WS_LRUWT);
        for (int it = vcu * NWAVES * 64 + tid; it < 8 * 2 * 64 * 8; it += G * NWAVES * 64) {
            const int i8 = it & 7, j = (it >> 3) & 63, m = (it >> 9) & 1, g = it >> 10;
            const float* src = (m ? P.lru_wx : P.lru_wa) + (size_t)(g * 64 + 8 * i8) * 64 + j;
            v4u o; o.x = pk2(src[0], src[64]); o.y = pk2(src[128], src[192]); o.z = pk2(src[256], src[320]); o.w = pk2(src[384], src[448]);
            *(v4u*)(WT + (size_t)it * 8) = o;
        }
    }
}

__device__ __forceinline__ void late_weight_prep(const Params& P, LAS unsigned char* lds, int lane, int wave, int gw, int NGW) {
    unsigned char* ws = P.ws;
    {
        LAS float* scr = (LAS float*)(lds + wave * 16384);
        constexpr int I_OUT = 16 * 32, I_Q = 16 * 32, I_O = 16 * 32;
        for (int it = gw; it < I_OUT + I_Q + I_O; it += NGW) {
            int r = it;
            if (r < I_OUT) { p0_transpose_item(P.w_out, 1024, 1024, 0, 32, (bf16*)(ws + WS_WOUT), 0, nullptr, scr, r, lane); continue; } r -= I_OUT;
            if (r < I_Q) { p0_transpose_item(P.xattn_wq, 1024, 1024, 0, 32, (bf16*)(ws + WS_WQ), 0, P.norm_xattn_w, scr, r, lane); continue; } r -= I_Q;
            p0_transpose_item(P.xattn_wo, 1024, 1024, 0, 32, (bf16*)(ws + WS_WO), 0, nullptr, scr, r, lane);
        }
    }
    {
        bf16* WF = (bf16*)(ws + WS_PWQ);
        const int col = lane & 15, g = lane >> 4;
        for (int it = gw; it < 16 * 64; it += NGW) {
            const int hp = it >> 6, k0 = (it & 63) * 16;
            bf16x8 bq[4];
#pragma unroll
            for (int s = 0; s < 4; ++s) { const f32x4* src = (const f32x4*)(P.peer_wq + (size_t)(k0 + col) * 2048 + hp * 128 + 32 * s + 8 * g);
                const f32x4 a = src[0], c = src[1]; v4u pk; pk.x = pk2(a.x, a.y); pk.y = pk2(a.z, a.w); pk.z = pk2(c.x, c.y); pk.w = pk2(c.z, c.w); bq[s] = __builtin_bit_cast(bf16x8, pk); }
            const float nw = P.norm_ffn_w[k0 + col];
#pragma unroll 2
            for (int kt = 0; kt < 8; ++kt) {
                f32x4 acc = (f32x4){0.f, 0.f, 0.f, 0.f};
#pragma unroll
                for (int s = 0; s < 4; ++s) { const f32x4* src = (const f32x4*)(P.peer_subkeys + (size_t)(hp * 128 + 16 * kt + col) * 128 + 32 * s + 8 * g);
                    const f32x4 a = src[0], c = src[1]; v4u pk; pk.x = pk2(a.x, a.y); pk.y = pk2(a.z, a.w); pk.z = pk2(c.x, c.y); pk.w = pk2(c.z, c.w);
                    acc = __builtin_amdgcn_mfma_f32_16x16x32_bf16(__builtin_bit_cast(bf16x8, pk), bq[s], acc, 0, 0, 0); }
#pragma unroll
                for (int i = 0; i < 4; ++i) WF[(size_t)(hp * 128 + 16 * kt + 4 * g + i) * 1024 + k0 + col] = (bf16)f2bf(acc[i] * nw);
            }
        }
    }
}

constexpr int GL_KS = 0, GL_VS = 33792, GL_KB = 67584, GL_QB = 84992, GL_RAW = 102400, GL_CW = 153856, GL_AMT = 133120, GL_SM = 160000, GL_ATT = 151808, GL_SOL = 67584;
static_assert(GL_CW + 6144 <= GL_SM && GL_SM + 1280 <= MISC_OFF && GL_SOL + 65536 <= GL_AMT && GL_AMT + 17408 <= GL_ATT && GL_ATT + 8192 <= GL_SM && GL_RAW + 51456 <= GL_CW, "gdn_local LDS map");
#ifndef GL_REP_STEP
#define GL_REP_STEP -1
#endif
#define GL_REPF(k) for (int rr_ = 0; rr_ < ((GL_REP_STEP == (k)) ? 2 : 1); ++rr_)
#define GL_BAR() do { asm volatile("s_waitcnt lgkmcnt(0)" ::: "memory"); __builtin_amdgcn_s_barrier(); asm volatile("" ::: "memory"); } while (0)
__device__ __forceinline__ void gdn_local_item(const Params& P, LAS unsigned char* lds, int item, int tid) {
    unsigned char* ws = P.ws;
    asm volatile("" : "+v"(tid));
    const int b = item >> 9, h = (item >> 7) & 3, n = item & 127;
    const int t0 = b * SEQ + n * 64;
    const int lane = tid & 63, wave = __builtin_amdgcn_readfirstlane(tid >> 6);
    LAS float* ks = (LAS float*)(lds + GL_KS);
    LAS float* vs = (LAS float*)(lds + GL_VS);
    LAS bf16* kb16 = (LAS bf16*)(lds + GL_KB);
    LAS bf16* qb16 = (LAS bf16*)(lds + GL_QB);
    LAS bf16* raw = (LAS bf16*)(lds + GL_RAW);
    LAS float* cw = (LAS float*)(lds + GL_CW);
    LAS float* AmT = (LAS float*)(lds + GL_AMT);
    LAS float* sg = (LAS float*)(lds + GL_SM);
    LAS float* sbeta = sg + 64; LAS float* sgc = sbeta + 64; LAS float* seg = sgc + 64; LAS float* sek = seg + 64;
    LAS bf16* atts = (LAS bf16*)(lds + GL_ATT);
    const bf16* QKV = (const bf16*)(ws + WS_QKV);
    const float* AB = (const float*)(ws + WS_AB);
    GL_REPF(0) {
        v4u pr[7];
#pragma unroll
        for (int r = 0; r < 7; ++r) {
            const int id = tid + 512 * r;
            const int row = id / 48, rem = id - row * 48, part = rem >> 4, ck = rem & 15, s = n * 64 + row - 3;
            pr[r] = (v4u){0u, 0u, 0u, 0u};
            if (id < 67 * 48 && s >= 0) pr[r] = *(const v4u*)(QKV + (size_t)(b * SEQ + s) * 1536 + part * 512 + h * 128 + ck * 8);
        }
        f32x4 cwv = (f32x4){0.f, 0.f, 0.f, 0.f};
        if (tid < 384) { const int j = tid / 96, rem = tid - j * 96, part = rem >> 5, c4 = rem & 31; cwv = *(const f32x4*)(P.conv_qkv_w + j * 1536 + part * 512 + h * 128 + c4 * 4); }
        float a_in = 0.f, b_in = 0.f;
        if (tid < 64) { a_in = AB[(size_t)(t0 + tid) * 8 + h]; b_in = AB[(size_t)(t0 + tid) * 8 + 4 + h]; }
#pragma unroll
        for (int r = 0; r < 7; ++r) { const int id = tid + 512 * r; if (id < 67 * 48) *(LAS v4u*)(raw + id * 8) = pr[r]; }
        if (tid < 384) *(LAS f32x4*)(cw + tid * 4) = cwv;
        if (tid < 64) { sg[tid] = -__expf(P.gdn_a_log[h]) * softplusf_(a_in + P.gdn_dt_bias[h]); sbeta[tid] = sigmoidf_(b_in); }
    }
    GL_BAR();
    GL_REPF(1) {
        const int c = tid >> 3, grp = tid & 7;
#pragma unroll 1
        for (int part = 0; part < 3; ++part) {
            float y[16];
#pragma unroll
            for (int i = 0; i < 16; ++i) y[i] = 0.f;
#pragma unroll
            for (int j = 0; j < 4; ++j) {
                const LAS v4u* src = (const LAS v4u*)(raw + (c + j) * 384 + part * 128 + grp * 16);
                const v4u x0 = src[0], x1 = src[1];
                const LAS f32x4* wp = (const LAS f32x4*)(cw + (j * 3 + part) * 128 + grp * 16);
                const f32x4 w0 = wp[0], w1 = wp[1], w2 = wp[2], w3 = wp[3];
                y[0] += w0.x * bflo(x0.x); y[1] += w0.y * bfhi(x0.x); y[2] += w0.z * bflo(x0.y); y[3] += w0.w * bfhi(x0.y);
                y[4] += w1.x * bflo(x0.z); y[5] += w1.y * bfhi(x0.z); y[6] += w1.z * bflo(x0.w); y[7] += w1.w * bfhi(x0.w);
                y[8] += w2.x * bflo(x1.x); y[9] += w2.y * bfhi(x1.x); y[10] += w2.z * bflo(x1.y); y[11] += w2.w * bfhi(x1.y);
                y[12] += w3.x * bflo(x1.z); y[13] += w3.y * bfhi(x1.z); y[14] += w3.z * bflo(x1.w); y[15] += w3.w * bfhi(x1.w);
            }
            float ss = 0.f;
#pragma unroll
            for (int i = 0; i < 16; ++i) { y[i] = siluf_(y[i]); ss += y[i] * y[i]; }
            if (part < 2) {
                ss += __shfl_xor(ss, 1); ss += __shfl_xor(ss, 2); ss += __shfl_xor(ss, 4);
                const float sc = rsqrtf(ss + 1e-6f) * (part == 0 ? 0.08838834764831845f : 1.0f);
#pragma unroll
                for (int i = 0; i < 16; ++i) y[i] *= sc;
            }
            if (part >= 1) {
                LAS float* dst = (part == 1 ? ks : vs) + c * 132 + grp * 16;
#pragma unroll
                for (int i = 0; i < 4; ++i) *(LAS f32x4*)(dst + 4 * i) = (f32x4){y[4 * i], y[4 * i + 1], y[4 * i + 2], y[4 * i + 3]};
            }
            if (part <= 1) {
                LAS bf16* dst = (part == 0 ? qb16 : kb16) + c * 136 + grp * 16;
                v4u o0, o1; o0.x = pk2(y[0], y[1]); o0.y = pk2(y[2], y[3]); o0.z = pk2(y[4], y[5]); o0.w = pk2(y[6], y[7]);
                o1.x = pk2(y[8], y[9]); o1.y = pk2(y[10], y[11]); o1.z = pk2(y[12], y[13]); o1.w = pk2(y[14], y[15]);
                *(LAS v4u*)dst = o0; *(LAS v4u*)(dst + 8) = o1;
            }
        }
    }
    if (tid < 64) {
        float v = sg[tid];
#pragma unroll
        for (int off = 1; off < 64; off <<= 1) { const float t = __shfl_up(v, off); if (tid >= off) v += t; }
        sgc[tid] = v; seg[tid] = __expf(v);
        const float gl = __shfl(v, 63);
        sek[tid] = __expf(gl - v);
        if (tid == 63) ((float*)(ws + WS_DEC))[item] = __expf(v);
    }
    GL_BAR();
    {
        const int mat = wave >> 2, rho = wave & 3, col = lane & 15, g = lane >> 4;
        const LAS bf16* X = mat ? qb16 : kb16;
        bf16x8 af[4];
#pragma unroll
        for (int s = 0; s < 4; ++s) af[s] = *(const LAS bf16x8*)(X + (16 * rho + col) * 136 + 32 * s + 8 * g);
#pragma unroll
        for (int sig = 0; sig < 4; ++sig) {
            f32x4 acc = (f32x4){0.f, 0.f, 0.f, 0.f};
#pragma unroll
            for (int s = 0; s < 4; ++s) { const bf16x8 bfr = *(const LAS bf16x8*)(kb16 + (16 * sig + col) * 136 + 32 * s + 8 * g); acc = __builtin_amdgcn_mfma_f32_16x16x32_bf16(af[s], bfr, acc, 0, 0, 0); }
            const int sidx = 16 * sig + col; const float gs = sgc[sidx];
#pragma unroll
            for (int i = 0; i < 4; ++i) {
                const int c = 16 * rho + 4 * g + i;
                const float dec = (c >= sidx) ? __expf(sgc[c] - gs) : 0.f;
                if (mat == 0) AmT[sidx * 68 + c] = (c > sidx) ? sbeta[c] * acc[i] * dec : 0.f;
                else atts[c * 64 + sidx] = (bf16)f2bf(acc[i] * dec);
            }
        }
    }
    GL_BAR();
    GL_REPF(4) {
        bf16* QD = (bf16*)(ws + WS_QD) + (size_t)item * 8192;
        bf16* KD = (bf16*)(ws + WS_KD) + (size_t)item * 8192;
        bf16* ATT = (bf16*)(ws + WS_ATT) + (size_t)item * 4096;
#pragma unroll
        for (int r = 0; r < 2; ++r) {
            const int id = tid + 512 * r;
            { const int c = id >> 4, gam = id & 15, s32 = gam >> 2, g = gam & 3;
              const v2u lo = *(const LAS v2u*)(qb16 + c * 136 + 32 * s32 + 4 * g), hi = *(const LAS v2u*)(qb16 + c * 136 + 32 * s32 + 16 + 4 * g);
              const float e = seg[c];
              v4u o; o.x = pk2(bflo(lo.x) * e, bfhi(lo.x) * e); o.y = pk2(bflo(lo.y) * e, bfhi(lo.y) * e); o.z = pk2(bflo(hi.x) * e, bfhi(hi.x) * e); o.w = pk2(bflo(hi.y) * e, bfhi(hi.y) * e);
              *(v4u*)(QD + c * 128 + 8 * gam) = o; }
            { const int dk = id >> 3, gam = id & 7, s32 = gam >> 2, g = gam & 3, c0 = 32 * s32 + 4 * g;
              float v[8];
#pragma unroll
              for (int j = 0; j < 4; ++j) { v[j] = ks[(c0 + j) * 132 + dk] * sek[c0 + j]; v[4 + j] = ks[(c0 + 16 + j) * 132 + dk] * sek[c0 + 16 + j]; }
              v4u o; o.x = pk2(v[0], v[1]); o.y = pk2(v[2], v[3]); o.z = pk2(v[4], v[5]); o.w = pk2(v[6], v[7]);
              *(v4u*)(KD + dk * 64 + 8 * gam) = o; }
        }
        { const int c = tid >> 3, gam = tid & 7, s32 = gam >> 2, g = gam & 3;
          const v2u lo = *(const LAS v2u*)(atts + c * 64 + 32 * s32 + 4 * g), hi = *(const LAS v2u*)(atts + c * 64 + 32 * s32 + 16 + 4 * g);
          v4u o; o.x = lo.x; o.y = lo.y; o.z = hi.x; o.w = hi.y;
          *(v4u*)(ATT + c * 64 + 8 * gam) = o; }
    }
    GL_BAR();
    GL_REPF(5) {
        LAS float* xcol = (LAS float*)(lds + GL_SOL);
        LAS bf16* tinv = (LAS bf16*)(lds + GL_SOL + 17408);
        const int j = tid >> 3, part = tid & 7, jb = j >> 4, jo = j & 15;
#pragma unroll 1
        for (int rb = jb; rb < 4; ++rb) {
            float acc[16];
#pragma unroll
            for (int i = 0; i < 16; ++i) acc[i] = 0.f;
            if (rb > jb) {
#pragma unroll 2
                for (int s = 16 * jb + part; s < 16 * rb; s += 8) {
                    const float sv = xcol[j * 68 + s];
                    const LAS float* ar = AmT + s * 68 + 16 * rb;
#pragma unroll
                    for (int q = 0; q < 4; ++q) { const f32x4 A4 = *(const LAS f32x4*)(ar + 4 * q);
                        acc[4 * q] -= A4.x * sv; acc[4 * q + 1] -= A4.y * sv; acc[4 * q + 2] -= A4.z * sv; acc[4 * q + 3] -= A4.w * sv; }
                }
#pragma unroll
                for (int i = 0; i < 16; ++i) {
                    acc[i] += __builtin_bit_cast(float, __builtin_amdgcn_update_dpp(0, __builtin_bit_cast(int, acc[i]), 0xB1, 0xF, 0xF, true));
                    acc[i] += __builtin_bit_cast(float, __builtin_amdgcn_update_dpp(0, __builtin_bit_cast(int, acc[i]), 0x4E, 0xF, 0xF, true));
                    acc[i] += __builtin_bit_cast(float, __builtin_amdgcn_update_dpp(0, __builtin_bit_cast(int, acc[i]), 0x141, 0xF, 0xF, true));
                }
            } else {
#pragma unroll
                for (int i = 0; i < 16; ++i) acc[i] = (i == jo) ? 1.f : 0.f;
            }
#pragma unroll
            for (int i = 0; i < 16; ++i) {
                const float sv = acc[i];
                const LAS float* ar = AmT + (16 * rb + i) * 68 + 16 * rb;
#pragma unroll
                for (int q = (i + 1) / 4; q < 4; ++q) { const f32x4 A4 = *(const LAS f32x4*)(ar + 4 * q);
                    if (4 * q > i) acc[4 * q] -= A4.x * sv; if (4 * q + 1 > i) acc[4 * q + 1] -= A4.y * sv; if (4 * q + 2 > i) acc[4 * q + 2] -= A4.z * sv; if (4 * q + 3 > i) acc[4 * q + 3] -= A4.w * sv; }
            }
            if (part == 0) {
#pragma unroll
                for (int i = 0; i < 16; ++i) { xcol[j * 68 + 16 * rb + i] = acc[i]; tinv[(16 * rb + i) * 72 + j] = (bf16)f2bf(acc[i]); }
            }
            LDS_WAIT(); asm volatile("" ::: "memory");
        }
        for (int rb = 0; rb < jb; ++rb) {
            if (part == 0) {
#pragma unroll
                for (int i = 0; i < 16; ++i) tinv[(16 * rb + i) * 72 + j] = (bf16)0;
            }
        }
    }
    GL_BAR();
    GL_REPF(6) {
        const LAS bf16* tinv = (const LAS bf16*)(lds + GL_SOL + 17408);
        LAS bf16* wst = (LAS bf16*)(lds + GL_SOL + 17408 + 9216);
        const int col = lane & 15, g = lane >> 4, isw = wave >> 2;
        bf16x8 af[4][2];
#pragma unroll
        for (int rho = 0; rho < 4; ++rho)
#pragma unroll
            for (int s2 = 0; s2 < 2; ++s2) af[rho][s2] = *(const LAS bf16x8*)(tinv + (16 * rho + col) * 72 + 32 * s2 + 8 * g);
        bf16* UF = (bf16*)(ws + WS_UF) + (size_t)item * 8192;
#pragma unroll
        for (int sig = 0; sig < 2; ++sig) {
            const int jj = 32 * (wave & 3) + 16 * sig + col;
            const LAS float* src = (isw ? ks : vs) + jj;
            bf16x8 bfr[2];
#pragma unroll
            for (int s2 = 0; s2 < 2; ++s2) {
                float v[8];
#pragma unroll
                for (int e = 0; e < 8; ++e) { const int sidx = 32 * s2 + 8 * g + e; float x = src[sidx * 132] * sbeta[sidx]; if (isw) x *= seg[sidx]; v[e] = x; }
                v4u pk; pk.x = pk2(v[0], v[1]); pk.y = pk2(v[2], v[3]); pk.z = pk2(v[4], v[5]); pk.w = pk2(v[6], v[7]);
                bfr[s2] = __builtin_bit_cast(bf16x8, pk);
            }
            f32x4 acc[4];
#pragma unroll
            for (int rho = 0; rho < 4; ++rho) { acc[rho] = (f32x4){0.f, 0.f, 0.f, 0.f};
#pragma unroll
                for (int s2 = 0; s2 < 2; ++s2) acc[rho] = __builtin_amdgcn_mfma_f32_16x16x32_bf16(af[rho][s2], bfr[s2], acc[rho], 0, 0, 0); }
            if (!isw) {
                v4u o0, o1;
                o0.x = pk2(acc[0].x, acc[0].y); o0.y = pk2(acc[0].z, acc[0].w); o0.z = pk2(acc[1].x, acc[1].y); o0.w = pk2(acc[1].z, acc[1].w);
                o1.x = pk2(acc[2].x, acc[2].y); o1.y = pk2(acc[2].z, acc[2].w); o1.z = pk2(acc[3].x, acc[3].y); o1.w = pk2(acc[3].z, acc[3].w);
                v4u* d = (v4u*)(UF + (size_t)(2 * (wave & 3) + sig) * 1024 + lane * 16);
                d[0] = o0; d[1] = o1;
            } else {
#pragma unroll
                for (int rho = 0; rho < 4; ++rho)
#pragma unroll
                    for (int i = 0; i < 4; ++i) wst[(16 * rho + 4 * g + i) * 136 + jj] = (bf16)f2bf(-acc[rho][i]);
            }
        }
    }
    GL_BAR();
    {
        const LAS bf16* wst = (const LAS bf16*)(lds + GL_SOL + 17408 + 9216);
        bf16* WN = (bf16*)(ws + WS_WN) + (size_t)item * 8192;
#pragma unroll
        for (int r = 0; r < 2; ++r) {
            const int id = tid + 512 * r, c = id >> 4, gam = id & 15, s32 = gam >> 2, g = gam & 3;
            const v2u lo = *(const LAS v2u*)(wst + c * 136 + 32 * s32 + 4 * g), hi = *(const LAS v2u*)(wst + c * 136 + 32 * s32 + 16 + 4 * g);
            v4u o; o.x = lo.x; o.y = lo.y; o.z = hi.x; o.w = hi.y;
            *(v4u*)(WN + c * 128 + 8 * gam) = o;
        }
    }
    GL_BAR();
}

constexpr int LL_XCB = 68608;
static_assert(LL_XCB + 64 * 1040 <= MISC_OFF, "lru_local LDS map");
__device__ __forceinline__ float expm1_small(float x) {
    const float p = x * (1.0f + x * (0.5f + x * (0.16666667f + x * (0.041666668f + x * 0.008333334f))));
    return (x > -0.25f) ? p : (__expf(x) - 1.0f);
}
__device__ __forceinline__ void lru_local_item(const Params& P, LAS unsigned char* lds, int lt, int tid, int lane, int wave) {
    unsigned char* ws = P.ws;
    asm volatile("" : "+v"(tid));
    const int b = lt >> 7, n = lt & 127, t0 = b * SEQ + n * 64;
    LAS bf16* rawx = (LAS bf16*)lds;
    LAS bf16* xcb = (LAS bf16*)(lds + LL_XCB);
    const bf16* XR = (const bf16*)(ws + WS_XR);
    {
        v4u pr[9];
#pragma unroll
        for (int r = 0; r < 9; ++r) { const int id = tid + 512 * r, row = id >> 6, ck = id & 63, s = n * 64 + row - 3;
            pr[r] = (v4u){0u, 0u, 0u, 0u};
            if (id < 67 * 64 && s >= 0) pr[r] = *(const v4u*)(XR + (size_t)(b * SEQ + s) * 512 + ck * 8); }
#pragma unroll
        for (int r = 0; r < 9; ++r) { const int id = tid + 512 * r; if (id < 67 * 64) *(LAS v4u*)(rawx + id * 8) = pr[r]; }
    }
    GL_BAR();
    {
        const int chg = tid & 63, tseg = tid >> 6, ch0 = chg * 8;
        float w[4][8], cb[8];
#pragma unroll
        for (int j = 0; j < 4; ++j) { const f32x4 a = *(const f32x4*)(P.lru_conv_w + j * 512 + ch0), c = *(const f32x4*)(P.lru_conv_w + j * 512 + ch0 + 4);
            w[j][0] = a.x; w[j][1] = a.y; w[j][2] = a.z; w[j][3] = a.w; w[j][4] = c.x; w[j][5] = c.y; w[j][6] = c.z; w[j][7] = c.w; }
        { const f32x4 a = *(const f32x4*)(P.lru_conv_b + ch0), c = *(const f32x4*)(P.lru_conv_b + ch0 + 4);
          cb[0] = a.x; cb[1] = a.y; cb[2] = a.z; cb[3] = a.w; cb[4] = c.x; cb[5] = c.y; cb[6] = c.z; cb[7] = c.w; }
        v4u xr[11];
#pragma unroll
        for (int r = 0; r < 11; ++r) xr[r] = *(const LAS v4u*)(rawx + (tseg * 8 + r) * 512 + ch0);
#pragma unroll
        for (int tk = 0; tk < 8; ++tk) {
            float y[8];
#pragma unroll
            for (int e = 0; e < 8; ++e) y[e] = cb[e];
#pragma unroll
            for (int j = 0; j < 4; ++j) { const v4u x = xr[tk + j];
                y[0] += w[j][0] * bflo(x.x); y[1] += w[j][1] * bfhi(x.x); y[2] += w[j][2] * bflo(x.y); y[3] += w[j][3] * bfhi(x.y);
                y[4] += w[j][4] * bflo(x.z); y[5] += w[j][5] * bfhi(x.z); y[6] += w[j][6] * bflo(x.w); y[7] += w[j][7] * bfhi(x.w); }
            v4u o; o.x = pk2(y[0], y[1]); o.y = pk2(y[2], y[3]); o.z = pk2(y[4], y[5]); o.w = pk2(y[6], y[7]);
            *(LAS v4u*)(xcb + (tseg * 8 + tk) * 520 + ch0) = o;
        }
    }
    GL_BAR();
    {
        const int g = wave, col = lane & 15, g4 = lane >> 4;
        LAS bf16* AM = (LAS bf16*)(lds + wave * 8192); LAS bf16* BT = AM + 2048;
        const bf16* WT = (const bf16*)(ws + WS_LRUWT) + (size_t)g * 8192;
        bf16x8 Bw[2][4][2];
#pragma unroll
        for (int m = 0; m < 2; ++m)
#pragma unroll
            for (int jt = 0; jt < 4; ++jt)
#pragma unroll
                for (int s2 = 0; s2 < 2; ++s2) Bw[m][jt][s2] = *(const bf16x8*)(WT + m * 4096 + (16 * jt + col) * 64 + 32 * s2 + 8 * g4);
        float cba[4], cbx[4], csp[4];
#pragma unroll
        for (int jt = 0; jt < 4; ++jt) { const int ch = g * 64 + 16 * jt + col; cba[jt] = P.lru_ba[ch]; cbx[jt] = P.lru_bx[ch]; csp[jt] = softplusf_(-P.lru_lambda[ch]); }
        bf16* HLOC = (bf16*)(ws + WS_HLOC); bf16* PCUM = (bf16*)(ws + WS_PCUM);
        const int chs = g * 64 + lane;
        float hst = 0.f, pc = 1.f;
#pragma unroll 1
        for (int half = 0; half < 2; ++half) {
            bf16x8 Af[2][2];
#pragma unroll
            for (int rho = 0; rho < 2; ++rho)
#pragma unroll
                for (int s2 = 0; s2 < 2; ++s2) Af[rho][s2] = *(const LAS bf16x8*)(xcb + (32 * half + 16 * rho + col) * 520 + g * 64 + 32 * s2 + 8 * g4);
#pragma unroll
            for (int jt = 0; jt < 4; ++jt) {
#pragma unroll
                for (int rho = 0; rho < 2; ++rho) {
                    f32x4 ra = (f32x4){0.f, 0.f, 0.f, 0.f}, rx = ra;
#pragma unroll
                    for (int s2 = 0; s2 < 2; ++s2) { ra = __builtin_amdgcn_mfma_f32_16x16x32_bf16(Af[rho][s2], Bw[0][jt][s2], ra, 0, 0, 0); rx = __builtin_amdgcn_mfma_f32_16x16x32_bf16(Af[rho][s2], Bw[1][jt][s2], rx, 0, 0, 0); }
#pragma unroll
                    for (int i = 0; i < 4; ++i) {
                        const int tokl = 16 * rho + 4 * g4 + i, chl = 16 * jt + col;
                        const float r = sigmoidf_(ra[i] + cba[jt]), ig = sigmoidf_(rx[i] + cbx[jt]);
                        const float log_a = -8.0f * r * csp[jt];
                        const float am = -expm1_small(log_a), a = 1.0f - am;
                        const float xo = bf1(xcb[(32 * half + tokl) * 520 + g * 64 + chl]);
                        const float bt = __builtin_amdgcn_sqrtf(fmaxf(am * (1.0f + a), 0.f)) * (ig * xo);
                        AM[tokl * 64 + chl] = (bf16)f2bf(am); BT[tokl * 64 + chl] = (bf16)f2bf(bt);
                    }
                }
            }
            LDS_WAIT(); asm volatile("" ::: "memory");
#pragma unroll 8
            for (int tk = 0; tk < 32; ++tk) {
                const float am = bf1(AM[tk * 64 + lane]), bt = bf1(BT[tk * 64 + lane]);
                hst = (hst - am * hst) + bt; pc = pc - am * pc;
                const size_t o = (size_t)(t0 + 32 * half + tk) * 512 + chs;
                HLOC[o] = (bf16)f2bf(hst); PCUM[o] = (bf16)f2bf(pc);
            }
            LDS_WAIT(); asm volatile("" ::: "memory");
        }
        ((float*)(ws + WS_HEND))[(size_t)lt * 512 + chs] = hst; ((float*)(ws + WS_PEND))[(size_t)lt * 512 + chs] = pc;
    }
    GL_BAR();
}

constexpr int SC_WN = 0, SC_QD = 64 * 272, SC_KD = 2 * 64 * 272, SC_ATT = 2 * 64 * 272 + 128 * 144, SC_BUF = 2 * 64 * 272 + 128 * 144 + 64 * 144;
constexpr int SC_SSQ = 2 * SC_BUF;
__device__ __forceinline__ int sc_lds_off(int id) {
    if (id < 1024) return SC_WN + (id >> 4) * 272 + (id & 15) * 16;
    if (id < 2048) { const int q = id - 1024; return SC_QD + (q >> 4) * 272 + (q & 15) * 16; }
    if (id < 3072) { const int q = id - 2048; return SC_KD + (q >> 3) * 144 + (q & 7) * 16; }
    const int q = id - 3072; return SC_ATT + (q >> 3) * 144 + (q & 7) * 16;
}
__device__ __forceinline__ const v4u* sc_src(const unsigned char* ws, int item, int id) {
    if (id < 1024) return (const v4u*)(ws + WS_WN + (size_t)item * 16384) + id;
    if (id < 2048) return (const v4u*)(ws + WS_QD + (size_t)item * 16384) + (id - 1024);
    if (id < 3072) return (const v4u*)(ws + WS_KD + (size_t)item * 16384) + (id - 2048);
    return (const v4u*)(ws + WS_ATT + (size_t)item * 8192) + (id - 3072);
}
__device__ __forceinline__ bf16x8 pack_b(const f32x4 a, const f32x4 b) {
    v4u r; r.x = pk2(a.x, a.y); r.y = pk2(a.z, a.w); r.z = pk2(b.x, b.y); r.w = pk2(b.z, b.w);
    return __builtin_bit_cast(bf16x8, r);
}
#define SC_BAR() do { asm volatile("s_waitcnt lgkmcnt(0)" ::: "memory"); __builtin_amdgcn_s_barrier(); asm volatile("" ::: "memory"); } while (0)
#define SC_GLD(dst, ptr) asm volatile("global_load_dwordx4 %0, %1, off" : "=v"(dst) : "v"(ptr) : "memory")
#define PIN8(a) asm volatile("" : "+v"(a[0]), "+v"(a[1]), "+v"(a[2]), "+v"(a[3]), "+v"(a[4]), "+v"(a[5]), "+v"(a[6]), "+v"(a[7]))
#define PIN16(a) asm volatile("" : "+v"(a[0]), "+v"(a[1]), "+v"(a[2]), "+v"(a[3]), "+v"(a[4]), "+v"(a[5]), "+v"(a[6]), "+v"(a[7]), "+v"(a[8]), "+v"(a[9]), "+v"(a[10]), "+v"(a[11]), "+v"(a[12]), "+v"(a[13]), "+v"(a[14]), "+v"(a[15]))
constexpr int SCAN_NWC = 2, SCAN_PARTS = 4, SCAN_WGS = 8 * SCAN_PARTS;
constexpr int SC_UFS = 2 * SC_BUF;
constexpr int SC_DECS = SC_UFS + 2 * SCAN_NWC * 2048;
constexpr int SC_OT = SC_DECS + 512;
constexpr int SC_END = SC_OT + 2 * 64 * 36 * 4;
static_assert(SC_END <= MISC_OFF, "scan LDS");
#ifndef SCAN_REPS
#define SCAN_REPS 1
#endif
#ifndef SCAN_EXP
#define SCAN_EXP 0
#endif
__device__ __forceinline__ int sc3_lds_off(int id) {
    if (id < 3584) return sc_lds_off(id);
    return SC_UFS + (id - 3584) * 16;
}
__device__ __forceinline__ const v4u* sc3_src(const unsigned char* ws, int item, int id, int part) {
    if (id < 3584) return sc_src(ws, item, id);
    return (const v4u*)(ws + WS_UF + (size_t)item * 16384 + (size_t)(part * SCAN_NWC) * 2048) + (id - 3584);
}
__device__ __forceinline__ void gdn_scan(const Params& P, LAS unsigned char* lds, int sb, int tid, int lane, int wave) {
    const unsigned char* ws = P.ws;
    constexpr int NCH = 128 * SCAN_REPS, NPC = 15;
    const int bh = sb & 7, part = sb >> 3;
    const int b = bh >> 2, h = bh & 3, col = lane & 15, g = lane >> 4;
    const int item0 = bh * 128;
    const float* DEC = (const float*)(ws + WS_DEC);
    if (wave >= 4) {
        constexpr int NP = 15, DEP = 3;
        const int lt = tid - 256;
        const unsigned voff = (unsigned)lt * 16u;
        const int lA = (lt >> 4) * 272 + (lt & 15) * 16, lB = (lt >> 3) * 144 + (lt & 7) * 16, lU = SC_UFS + lt * 16;
        v4u rs[DEP][NP];
#define SC_ISSUE(set, itm) do { const unsigned char* gq_ = ws + (size_t)(itm) * 16384; const unsigned char* ga_ = ws + WS_ATT + (size_t)(itm) * 8192; \
            asm volatile("s_nop 4\n\tglobal_load_dwordx4 %0, %8, %9\n\tglobal_load_dwordx4 %1, %8, %10\n\tglobal_load_dwordx4 %2, %8, %11\n\tglobal_load_dwordx4 %3, %8, %12\n\t" \
                         "global_load_dwordx4 %4, %8, %13\n\tglobal_load_dwordx4 %5, %8, %14\n\tglobal_load_dwordx4 %6, %8, %15\n\tglobal_load_dwordx4 %7, %8, %16" \
                : "=&v"(rs[set][0]), "=&v"(rs[set][1]), "=&v"(rs[set][2]), "=&v"(rs[set][3]), "=&v"(rs[set][4]), "=&v"(rs[set][5]), "=&v"(rs[set][6]), "=&v"(rs[set][7]) \
                : "v"(voff), "s"(gq_ + WS_WN), "s"(gq_ + WS_WN + 4096), "s"(gq_ + WS_WN + 8192), "s"(gq_ + WS_WN + 12288), \
                  "s"(gq_ + WS_QD), "s"(gq_ + WS_QD + 4096), "s"(gq_ + WS_QD + 8192), "s"(gq_ + WS_QD + 12288) : "memory"); \
            asm volatile("s_nop 4\n\tglobal_load_dwordx4 %0, %7, %8\n\tglobal_load_dwordx4 %1, %7, %9\n\tglobal_load_dwordx4 %2, %7, %10\n\tglobal_load_dwordx4 %3, %7, %11\n\t" \
                         "global_load_dwordx4 %4, %7, %12\n\tglobal_load_dwordx4 %5, %7, %13\n\tglobal_load_dwordx4 %6, %7, %14" \
                : "=&v"(rs[set][8]), "=&v"(rs[set][9]), "=&v"(rs[set][10]), "=&v"(rs[set][11]), "=&v"(rs[set][12]), "=&v"(rs[set][13]), "=&v"(rs[set][14]) \
                : "v"(voff), "s"(gq_ + WS_KD), "s"(gq_ + WS_KD + 4096), "s"(gq_ + WS_KD + 8192), "s"(gq_ + WS_KD + 12288), \
                  "s"(ga_), "s"(ga_ + 4096), "s"(gq_ + WS_UF + (size_t)(part * SCAN_NWC) * 2048) : "memory"); } while (0)
#define SC_WAITSET(set, cnt) asm volatile("s_waitcnt " cnt : "+v"(rs[set][0]), "+v"(rs[set][1]), "+v"(rs[set][2]), "+v"(rs[set][3]), "+v"(rs[set][4]), "+v"(rs[set][5]), "+v"(rs[set][6]), "+v"(rs[set][7]), \
            "+v"(rs[set][8]), "+v"(rs[set][9]), "+v"(rs[set][10]), "+v"(rs[set][11]), "+v"(rs[set][12]), "+v"(rs[set][13]), "+v"(rs[set][14]) :: "memory")
#define SC_WRITE(set, par) do { LAS unsigned char* wb_ = lds + (par) * SC_BUF; \
            _Pragma("unroll") for (int r = 0; r < 4; ++r) { *(LAS v4u*)(wb_ + SC_WN + lA + r * (16 * 272)) = rs[set][r]; *(LAS v4u*)(wb_ + SC_QD + lA + r * (16 * 272)) = rs[set][4 + r]; \
                                                          *(LAS v4u*)(wb_ + SC_KD + lB + r * (32 * 144)) = rs[set][8 + r]; } \
            *(LAS v4u*)(wb_ + SC_ATT + lB) = rs[set][12]; *(LAS v4u*)(wb_ + SC_ATT + lB + 32 * 144) = rs[set][13]; \
            *(LAS v4u*)(lds + lU + (par) * (SCAN_NWC * 2048)) = rs[set][14]; } while (0)
        {
#pragma unroll
            for (int r = 0; r < NP; ++r) { const int id = lt + 256 * r; *(LAS v4u*)(lds + sc3_lds_off(id)) = *sc3_src(ws, item0, id, part); }
            if (lt < 128) ((LAS float*)(lds + SC_DECS))[lt] = DEC[item0 + lt];
            asm volatile("s_waitcnt vmcnt(0)" ::: "memory");
        }
        SC_ISSUE(1, item0 + 1); SC_ISSUE(2, item0 + 2); SC_ISSUE(0, item0 + 3);
        SC_BAR();
        int n2 = 0;
#define SC_INTERVAL(set) do { SC_WAITSET(set, "vmcnt(30)"); SC_WRITE(set, (n2 + 1) & 1); SC_WAITSET(set, "lgkmcnt(0)"); SC_ISSUE(set, item0 + ((n2 + 1 + DEP) & 127)); SC_BAR(); ++n2; } while (0)
#pragma unroll 1
        for (int it = 0; it < NCH / 3; ++it) { SC_INTERVAL(1); SC_INTERVAL(2); SC_INTERVAL(0); }
        if (NCH % 3 >= 1) SC_INTERVAL(1);
        if (NCH % 3 >= 2) SC_INTERVAL(2);
        SC_WAITSET(0, "vmcnt(0)"); SC_WAITSET(1, "vmcnt(0)"); SC_WAITSET(2, "vmcnt(0)");
#undef SC_INTERVAL
#undef SC_WRITE
#undef SC_WAITSET
#undef SC_ISSUE
        return;
    }
    if (wave == 3) {
        SC_BAR();
#pragma unroll 1
        for (int n2 = 0; n2 < NCH; ++n2) SC_BAR();
        return;
    }
    if (wave == 2) {
        const int row = lane;
        bf16* Y = (bf16*)(P.ws + WS_Y);
        float* SSQG = P.out;
        SC_BAR();
#pragma unroll 1
        for (int n2 = 0; n2 <= NCH; ++n2) {
            if (n2 > 0) {
                const int n = (n2 - 1) & 127, t = b * SEQ + n * 64 + row;
                const LAS float* src = (const LAS float*)(lds + SC_OT + ((n2 - 1) & 1) * (64 * 36 * 4)) + row * 36;
                f32x4 a[8]; float s2 = 0.f;
#pragma unroll
                for (int q = 0; q < 8; ++q) { a[q] = *(const LAS f32x4*)(src + 4 * q); s2 += (a[q].x * a[q].x + a[q].y * a[q].y) + (a[q].z * a[q].z + a[q].w * a[q].w); }
                SSQG[(size_t)t * 32 + h * 8 + part] = s2;
                v4u* d = (v4u*)(Y + (size_t)t * 1024 + h * 128 + 32 * part);
#pragma unroll
                for (int q = 0; q < 4; ++q) { v4u o; o.x = pk2(a[2 * q].x, a[2 * q].y); o.y = pk2(a[2 * q].z, a[2 * q].w); o.z = pk2(a[2 * q + 1].x, a[2 * q + 1].y); o.w = pk2(a[2 * q + 1].z, a[2 * q + 1].w); d[q] = o; }
            }
            if (n2 < NCH) SC_BAR();
        }
        return;
    }
    f32x4 S[8];
#pragma unroll
    for (int i = 0; i < 8; ++i) S[i] = (f32x4){0.f, 0.f, 0.f, 0.f};
    SC_BAR();
#pragma unroll 1
    for (int n2 = 0; n2 < NCH; ++n2) {
        if (SCAN_REPS > 1 && (n2 & 127) == 0) {
#pragma unroll
            for (int i = 0; i < 8; ++i) S[i] = (f32x4){0.f, 0.f, 0.f, 0.f};
        }
        if (SCAN_EXP == 2 && n2 < 128) { SC_BAR(); continue; }
        const int par = n2 & 1;
        LAS unsigned char* buf = lds + par * SC_BUF;
        bf16x8 fA[16], fB[16], fC[16], fD[8];
#pragma unroll
        for (int rho = 0; rho < 4; ++rho)
#pragma unroll
            for (int s = 0; s < 4; ++s) fA[rho * 4 + s] = *(const LAS bf16x8*)(buf + SC_WN + (16 * rho + col) * 272 + (32 * s + 8 * g) * 2);
#pragma unroll
        for (int rho = 0; rho < 4; ++rho)
#pragma unroll
            for (int s = 0; s < 4; ++s) fB[rho * 4 + s] = *(const LAS bf16x8*)(buf + SC_QD + (16 * rho + col) * 272 + (32 * s + 8 * g) * 2);
        const LAS v4u* ufp = (const LAS v4u*)(lds + SC_UFS + par * (SCAN_NWC * 2048) + wave * 2048 + lane * 32);
        const v4u uf0 = ufp[0], uf1 = ufp[1];
        const float dec = ((const LAS float*)(lds + SC_DECS))[n2 & 127];
        bf16x8 Bs[4];
#pragma unroll
        for (int s = 0; s < 4; ++s) Bs[s] = pack_b(S[2 * s], S[2 * s + 1]);
        f32x4 Vn[4], Oc[4];
        Vn[0] = (f32x4){bflo(uf0.x), bfhi(uf0.x), bflo(uf0.y), bfhi(uf0.y)}; Vn[1] = (f32x4){bflo(uf0.z), bfhi(uf0.z), bflo(uf0.w), bfhi(uf0.w)};
        Vn[2] = (f32x4){bflo(uf1.x), bfhi(uf1.x), bflo(uf1.y), bfhi(uf1.y)}; Vn[3] = (f32x4){bflo(uf1.z), bfhi(uf1.z), bflo(uf1.w), bfhi(uf1.w)};
        __builtin_amdgcn_sched_barrier(0);
        PIN16(fA);
#pragma unroll
        for (int s = 0; s < 4; ++s)
#pragma unroll
            for (int rho = 0; rho < 4; ++rho) Vn[rho] = __builtin_amdgcn_mfma_f32_16x16x32_bf16(fA[rho * 4 + s], Bs[s], Vn[rho], 0, 0, 0);
        __builtin_amdgcn_sched_barrier(0);
#pragma unroll
        for (int tau = 0; tau < 8; ++tau)
#pragma unroll
            for (int s = 0; s < 2; ++s) fC[tau * 2 + s] = *(const LAS bf16x8*)(buf + SC_KD + (16 * tau + col) * 144 + (32 * s + 8 * g) * 2);
        __builtin_amdgcn_sched_barrier(0);
        PIN16(fB);
#pragma unroll
        for (int rho = 0; rho < 4; ++rho) Oc[rho] = (f32x4){0.f, 0.f, 0.f, 0.f};
#pragma unroll
        for (int s = 0; s < 4; ++s)
#pragma unroll
            for (int rho = 0; rho < 4; ++rho) Oc[rho] = __builtin_amdgcn_mfma_f32_16x16x32_bf16(fB[rho * 4 + s], Bs[s], Oc[rho], 0, 0, 0);
        __builtin_amdgcn_sched_barrier(0);
#pragma unroll
        for (int rho = 0; rho < 4; ++rho)
#pragma unroll
            for (int s = 0; s < 2; ++s) fD[rho * 2 + s] = *(const LAS bf16x8*)(buf + SC_ATT + (16 * rho + col) * 144 + (32 * s + 8 * g) * 2);
        bf16x8 Bv[2];
        Bv[0] = pack_b(Vn[0], Vn[1]); Bv[1] = pack_b(Vn[2], Vn[3]);
#pragma unroll
        for (int tau = 0; tau < 8; ++tau) S[tau] = S[tau] * dec;
        __builtin_amdgcn_sched_barrier(0);
        PIN16(fC);
#pragma unroll
        for (int s = 0; s < 2; ++s)
#pragma unroll
            for (int tau = 0; tau < 8; ++tau) S[tau] = __builtin_amdgcn_mfma_f32_16x16x32_bf16(fC[tau * 2 + s], Bv[s], S[tau], 0, 0, 0);
        __builtin_amdgcn_sched_barrier(0);
        PIN8(fD);
#pragma unroll
        for (int s = 0; s < 2; ++s)
#pragma unroll
            for (int rho = 0; rho < 4; ++rho) Oc[rho] = __builtin_amdgcn_mfma_f32_16x16x32_bf16(fD[rho * 2 + s], Bv[s], Oc[rho], 0, 0, 0);
        LAS float* ot = (LAS float*)(lds + SC_OT + par * (64 * 36 * 4)) + 16 * wave + col;
#pragma unroll
        for (int rho = 0; rho < 4; ++rho)
#pragma unroll
            for (int i = 0; i < 4; ++i) ot[(16 * rho + 4 * g + i) * 36] = Oc[rho][i];
        SC_BAR();
    }
}

__device__ __forceinline__ void lru_carry(const Params& P, int gwv, int lane) {
    unsigned char* ws = P.ws;
    const int b = gwv >> 3, g = gwv & 7, ch = g * 64 + lane;
    const float* HEND = (const float*)(ws + WS_HEND); const float* PEND = (const float*)(ws + WS_PEND); float* HIN = (float*)(ws + WS_HIN);
    float hin = 0.f;
#pragma unroll 1
    for (int n0 = 0; n0 < 128; n0 += 16) {
        float he[16], pe[16];
#pragma unroll
        for (int i = 0; i < 16; ++i) { const size_t o = (size_t)(b * 128 + n0 + i) * 512 + ch; he[i] = HEND[o]; pe[i] = PEND[o]; }
#pragma unroll
        for (int i = 0; i < 16; ++i) { HIN[(size_t)(b * 128 + n0 + i) * 512 + ch] = hin; hin = he[i] + pe[i] * hin; }
    }
}

__device__ __forceinline__ void cvt_table(const float* src, bf16* dst, size_t n8, size_t wi, size_t nw) {
    for (size_t i = wi; i < n8; i += nw) {
        const f32x4 a = ((const f32x4*)src)[2 * i], c = ((const f32x4*)src)[2 * i + 1];
        v4u o; o.x = pk2(a.x, a.y); o.y = pk2(a.z, a.w); o.z = pk2(c.x, c.y); o.w = pk2(c.z, c.w);
        ((v4u*)dst)[i] = o;
    }
}

__device__ __forceinline__ void lru_combine(const Params& P, size_t wi, size_t nw) {
    unsigned char* ws = P.ws;
    const v4u* HLOC = (const v4u*)(ws + WS_HLOC); const v4u* PCUM = (const v4u*)(ws + WS_PCUM); const v4u* GATE = (const v4u*)(ws + WS_GATE);
    const float* HIN = (const float*)(ws + WS_HIN); bf16* Y = (bf16*)(ws + WS_Y);
    for (size_t i = wi; i < (size_t)T * 64; i += nw) {
        const size_t t = i >> 6; const int ch0 = (int)(i & 63) * 8;
        const v4u hl = HLOC[i], pc = PCUM[i], gt = GATE[i];
        const f32x4 h0 = *(const f32x4*)(HIN + (t >> 6) * 512 + ch0), h1 = *(const f32x4*)(HIN + (t >> 6) * 512 + ch0 + 4);
        float y[8];
        y[0] = (bflo(hl.x) + bflo(pc.x) * h0.x) * gelu_tanh(bflo(gt.x)); y[1] = (bfhi(hl.x) + bfhi(pc.x) * h0.y) * gelu_tanh(bfhi(gt.x));
        y[2] = (bflo(hl.y) + bflo(pc.y) * h0.z) * gelu_tanh(bflo(gt.y)); y[3] = (bfhi(hl.y) + bfhi(pc.y) * h0.w) * gelu_tanh(bfhi(gt.y));
        y[4] = (bflo(hl.z) + bflo(pc.z) * h1.x) * gelu_tanh(bflo(gt.z)); y[5] = (bfhi(hl.z) + bfhi(pc.z) * h1.y) * gelu_tanh(bfhi(gt.z));
        y[6] = (bflo(hl.w) + bflo(pc.w) * h1.z) * gelu_tanh(bflo(gt.w)); y[7] = (bfhi(hl.w) + bfhi(pc.w) * h1.w) * gelu_tanh(bfhi(gt.w));
        v4u o; o.x = pk2(y[0], y[1]); o.y = pk2(y[2], y[3]); o.z = pk2(y[4], y[5]); o.w = pk2(y[6], y[7]);
        *(v4u*)(Y + t * 1024 + 512 + ch0) = o;
    }
}

__device__ __forceinline__ void gdn_gate_norm(const Params& P, size_t wi, size_t nw) {
    unsigned char* ws = P.ws;
    bf16* Y = (bf16*)(ws + WS_Y); const v4u* Z = (const v4u*)(ws + WS_Z); const float* SSQG = P.out;
    for (size_t i = wi; i < (size_t)T * 64; i += nw) {
        const size_t t = i >> 6; const int c0 = (int)(i & 63) * 8, h = c0 >> 7;
        const f32x4 q0 = *(const f32x4*)(SSQG + t * 32 + h * 8);
        const float rstd = rsqrtf(((q0.x + q0.y) + (q0.z + q0.w)) * (1.0f / 128.0f) + 1e-6f);
        const v4u o = *(const v4u*)(Y + t * 1024 + c0), z = Z[i];
        const f32x4 w0 = *(const f32x4*)(P.gdn_norm_w + (c0 & 127)), w1 = *(const f32x4*)(P.gdn_norm_w + (c0 & 127) + 4);
        float y[8];
        y[0] = bflo(o.x) * rstd * w0.x * siluf_(bflo(z.x)); y[1] = bfhi(o.x) * rstd * w0.y * siluf_(bfhi(z.x));
        y[2] = bflo(o.y) * rstd * w0.z * siluf_(bflo(z.y)); y[3] = bfhi(o.y) * rstd * w0.w * siluf_(bfhi(z.y));
        y[4] = bflo(o.z) * rstd * w1.x * siluf_(bflo(z.z)); y[5] = bfhi(o.z) * rstd * w1.y * siluf_(bfhi(z.z));
        y[6] = bflo(o.w) * rstd * w1.z * siluf_(bflo(z.w)); y[7] = bfhi(o.w) * rstd * w1.w * siluf_(bfhi(z.w));
        v4u r; r.x = pk2(y[0], y[1]); r.y = pk2(y[2], y[3]); r.z = pk2(y[4], y[5]); r.w = pk2(y[6], y[7]);
        *(v4u*)(Y + t * 1024 + c0) = r;
    }
}

__device__ __forceinline__ void xattn_stage(LAS unsigned char* lds, const bf16* src, int tid) {
    v4u tmp[16];
    const unsigned voff = (unsigned)tid * 16u;
#pragma unroll
    for (int r = 0; r < 16; ++r) { const unsigned char* sb = (const unsigned char*)src + r * 8192;
        asm volatile("s_nop 4\n\tglobal_load_dwordx4 %0, %1, %2" : "=&v"(tmp[r]) : "v"(voff), "s"(sb) : "memory"); }
    asm volatile("s_waitcnt vmcnt(0)" : "+v"(tmp[0]), "+v"(tmp[1]), "+v"(tmp[2]), "+v"(tmp[3]), "+v"(tmp[4]), "+v"(tmp[5]), "+v"(tmp[6]), "+v"(tmp[7]),
                                        "+v"(tmp[8]), "+v"(tmp[9]), "+v"(tmp[10]), "+v"(tmp[11]), "+v"(tmp[12]), "+v"(tmp[13]), "+v"(tmp[14]), "+v"(tmp[15]) :: "memory");
#pragma unroll
    for (int r = 0; r < 16; ++r) { const int id = tid + 512 * r; *(LAS v4u*)(lds + (id >> 5) * 528 + (id & 31) * 16) = tmp[r]; }
}
__device__ __forceinline__ void xattn_unit(const Params& P, LAS unsigned char* lds, int unit, int tid, int lane, int wave) {
    const unsigned char* ws = P.ws;
    const int h = unit & 3, qb = (unit >> 2) & 63, b = unit >> 8, col = lane & 15, g = lane >> 4;
    const int tw = b * SEQ + qb * 128 + 16 * wave;
    const bf16* Kb = (const bf16*)(ws + WS_KB) + (size_t)((b * 4 + h) * 256) * 256;
    const bf16* Vt = (const bf16*)(ws + WS_VTP) + (size_t)((b * 4 + h) * 256) * 256;
    xattn_stage(lds, Kb, tid);
    __syncthreads();
    const LAS unsigned char* arow = lds + col * 528 + g * 16;
    bf16x8 Bp[1][8]; float inv[1];
#pragma unroll
    for (int ps = 0; ps < 1; ++ps) {
        const bf16* Q = (const bf16*)(ws + WS_Q) + (size_t)(tw + 16 * ps + col) * 1024 + h * 256 + 8 * g;
        bf16x8 Bq[8];
#pragma unroll
        for (int s = 0; s < 8; ++s) Bq[s] = *(const bf16x8*)(Q + 32 * s);
        f32x4 St[16];
        bf16x8 fr[2][8];
#pragma unroll
        for (int s = 0; s < 8; ++s) fr[0][s] = *(const LAS bf16x8*)(arow + 64 * s);
#pragma unroll
        for (int kap = 0; kap < 16; ++kap) {
            if (kap + 1 < 16) {
#pragma unroll
                for (int s = 0; s < 8; ++s) fr[(kap + 1) & 1][s] = *(const LAS bf16x8*)(arow + (16 * (kap + 1)) * 528 + 64 * s);
            }
            __builtin_amdgcn_sched_barrier(0);
            PIN8(fr[kap & 1]);
            f32x4 acc = (f32x4){0.f, 0.f, 0.f, 0.f};
#pragma unroll
            for (int s = 0; s < 8; ++s) acc = __builtin_amdgcn_mfma_f32_16x16x32_bf16(fr[kap & 1][s], Bq[s], acc, 0, 0, 0);
            St[kap] = acc;
            __builtin_amdgcn_sched_barrier(0);
        }
        float mx = -3.0e38f;
#pragma unroll
        for (int kap = 0; kap < 16; ++kap) mx = fmaxf(fmaxf(fmaxf(St[kap].x, St[kap].y), fmaxf(St[kap].z, St[kap].w)), mx);
        mx = fmaxf(mx, __shfl_xor(mx, 16)); mx = fmaxf(mx, __shfl_xor(mx, 32));
        float l = 0.f;
#pragma unroll
        for (int kap = 0; kap < 16; ++kap) { St[kap].x = __expf(St[kap].x - mx); St[kap].y = __expf(St[kap].y - mx); St[kap].z = __expf(St[kap].z - mx); St[kap].w = __expf(St[kap].w - mx);
            l += (St[kap].x + St[kap].y) + (St[kap].z + St[kap].w); }
        l += __shfl_xor(l, 16); l += __shfl_xor(l, 32);
        inv[ps] = 1.0f / l;
#pragma unroll
        for (int s = 0; s < 8; ++s) Bp[ps][s] = pack_b(St[2 * s], St[2 * s + 1]);
    }
    __syncthreads();
    xattn_stage(lds, Vt, tid);
    __syncthreads();
#pragma unroll
    for (int ps = 0; ps < 1; ++ps) {
        bf16* AO = (bf16*)(P.ws + WS_AO) + (size_t)(tw + 16 * ps + col) * 1024 + h * 256 + 4 * g;
        bf16x8 fr[2][8];
#pragma unroll
        for (int s = 0; s < 8; ++s) fr[0][s] = *(const LAS bf16x8*)(arow + 64 * s);
#pragma unroll
        for (int del = 0; del < 16; ++del) {
            if (del + 1 < 16) {
#pragma unroll
                for (int s = 0; s < 8; ++s) fr[(del + 1) & 1][s] = *(const LAS bf16x8*)(arow + (16 * (del + 1)) * 528 + 64 * s);
            }
            __builtin_amdgcn_sched_barrier(0);
            PIN8(fr[del & 1]);
            f32x4 acc = (f32x4){0.f, 0.f, 0.f, 0.f};
#pragma unroll
            for (int s = 0; s < 8; ++s) acc = __builtin_amdgcn_mfma_f32_16x16x32_bf16(fr[del & 1][s], Bp[ps][s], acc, 0, 0, 0);
            v2u o; o.x = pk2(acc.x * inv[ps], acc.y * inv[ps]); o.y = pk2(acc.z * inv[ps], acc.w * inv[ps]);
            *(v2u*)(AO + 16 * del) = o;
            __builtin_amdgcn_sched_barrier(0);
        }
    }
    __syncthreads();
}

__device__ __forceinline__ unsigned key_enc(float f) { const unsigned u = __builtin_bit_cast(unsigned, f); return (u & 0x80000000u) ? ~u : (u | 0x80000000u); }
__device__ __forceinline__ float key_dec(unsigned k) { const unsigned u = (k & 0x80000000u) ? (k & 0x7fffffffu) : ~k; return __builtin_bit_cast(float, u); }
#define TK_CAS(a, b) do { const unsigned hi_ = max(a, b), lo_ = min(a, b); a = hi_; b = lo_; } while (0)
__device__ __forceinline__ void tk_merge16(unsigned (&a)[16]) {
#pragma unroll
    for (int j = 8; j > 0; j >>= 1)
#pragma unroll
        for (int i = 0; i < 16; ++i) { const int l = i ^ j; if (l > i) TK_CAS(a[i], a[l]); }
}
__device__ __forceinline__ void tk_sort16(unsigned (&a)[16]) {
#pragma unroll
    for (int k = 2; k <= 16; k <<= 1)
#pragma unroll
        for (int j = k >> 1; j > 0; j >>= 1)
#pragma unroll
            for (int i = 0; i < 16; ++i) { const int l = i ^ j; if (l > i) { if ((i & k) == 0) TK_CAS(a[i], a[l]); else TK_CAS(a[l], a[i]); } }
}
__device__ __forceinline__ void tk_top16_merge(unsigned (&L)[16], const unsigned (&G)[16]) {
#pragma unroll
    for (int i = 0; i < 16; ++i) L[i] = max(L[i], G[15 - i]);
    tk_merge16(L);
}
__device__ __forceinline__ void tk_pair_merge(unsigned (&L)[16]) {
    unsigned Pp[16];
#pragma unroll
    for (int i = 0; i < 16; ++i) Pp[i] = (unsigned)__builtin_amdgcn_update_dpp(0, (int)L[i], 0xB1, 0xF, 0xF, true);
    tk_top16_merge(L, Pp);
}
__device__ __forceinline__ void peer_topk_rows(const Params& P, LAS unsigned char* lds, int rowbase, int tid) {
    const unsigned char* ws = P.ws;
    typedef _Float16 f16x8 __attribute__((ext_vector_type(8)));
    const int rl = tid >> 1, hf = tid & 1, grow = rowbase + rl, t = grow >> 3, h = grow & 7;
    const _Float16* SC = (const _Float16*)(ws + WS_PQ) + (size_t)t * 2048 + h * 256 + 64 * hf;
    f16x8 raw[2][8];
#pragma unroll
    for (int p = 0; p < 2; ++p)
#pragma unroll
        for (int q = 0; q < 8; ++q) raw[p][q] = *(const f16x8*)(SC + p * 128 + 8 * q);
    unsigned L1[16], L2[16];
#pragma unroll
    for (int p = 0; p < 2; ++p) {
        unsigned L[16];
#pragma unroll
        for (int grp = 0; grp < 4; ++grp) {
            unsigned G[16];
#pragma unroll
            for (int e = 0; e < 16; ++e) G[e] = (key_enc((float)raw[p][2 * grp + (e >> 3)][e & 7]) & ~127u) | (unsigned)(127 - (64 * hf + 16 * grp + e));
            tk_sort16(G);
            if (grp == 0) {
#pragma unroll
                for (int i = 0; i < 16; ++i) L[i] = G[i];
            } else tk_top16_merge(L, G);
        }
        tk_pair_merge(L);
#pragma unroll
        for (int i = 0; i < 16; ++i) { if (p == 0) L1[i] = L[i]; else L2[i] = L[i]; }
    }
    {
        float v1[16], v2[16];
        LAS int* il = (LAS int*)lds + rl * 33;
#pragma unroll
        for (int q = 0; q < 16; ++q) { v1[q] = key_dec((L1[q] & ~127u) | 64u); v2[q] = key_dec((L2[q] & ~127u) | 64u); }
        if (hf == 0) {
#pragma unroll
            for (int q = 0; q < 16; ++q) { il[q] = 127 - (int)(L1[q] & 127u); il[16 + q] = 127 - (int)(L2[q] & 127u); }
        }
        unsigned C[16], D[16];
        float w1[8];
        const unsigned hf16 = (unsigned)hf * 16u, evenmask = (unsigned)hf - 1u;
#pragma unroll
        for (int k = 0; k < 8; ++k) w1[k] = __builtin_bit_cast(float, (__builtin_bit_cast(unsigned, v1[2 * k]) & evenmask) | (__builtin_bit_cast(unsigned, v1[2 * k + 1]) & ~evenmask));
#define TK_SLOT(dst, k, bq, valid_odd) do { const unsigned pos_ = (unsigned)(16 * (2 * (k)) + (bq)) + hf16; unsigned kv_ = (key_enc(w1[k] + v2[bq]) & ~255u) | (255u - pos_); if (!(valid_odd)) kv_ &= evenmask; dst = kv_; } while (0)
        TK_SLOT(C[0], 0, 0, true);
        TK_SLOT(C[1], 0, 1, true);
        TK_SLOT(C[2], 0, 2, true);
        TK_SLOT(C[3], 0, 3, true);
        TK_SLOT(C[4], 0, 4, true);
        TK_SLOT(C[5], 0, 5, true);
        TK_SLOT(C[6], 0, 6, true);
        TK_SLOT(C[7], 0, 7, true);
        TK_SLOT(C[8], 0, 8, false);
        TK_SLOT(C[9], 0, 9, false);
        TK_SLOT(C[10], 0, 10, false);
        TK_SLOT(C[11], 0, 11, false);
        TK_SLOT(C[12], 0, 12, false);
        TK_SLOT(C[13], 0, 13, false);
        TK_SLOT(C[14], 0, 14, false);
        TK_SLOT(C[15], 0, 15, false);
        TK_SLOT(D[0], 1, 0, true);
        TK_SLOT(D[1], 1, 1, true);
        TK_SLOT(D[2], 1, 2, true);
        TK_SLOT(D[3], 1, 3, true);
        TK_SLOT(D[4], 1, 4, false);
        TK_SLOT(D[5], 2, 0, true);
        TK_SLOT(D[6], 2, 1, true);
        TK_SLOT(D[7], 2, 2, false);
        TK_SLOT(D[8], 3, 0, true);
        TK_SLOT(D[9], 3, 1, true);
        TK_SLOT(D[10], 4, 0, true);
        TK_SLOT(D[11], 5, 0, true);
        TK_SLOT(D[12], 6, 0, true);
        TK_SLOT(D[13], 7, 0, true);
        D[14] = 0u; D[15] = 0u;
#undef TK_SLOT
        tk_sort16(C); tk_sort16(D); tk_top16_merge(C, D); tk_pair_merge(C);
        LDS_WAIT(); asm volatile("" ::: "memory");
        float best[16], e[16], sum = 0.f;
#pragma unroll
        for (int q = 0; q < 16; ++q) { best[q] = key_dec((C[q] & ~255u) | 128u); e[q] = __expf(best[q] - best[0]); sum += e[q]; }
        const float inv = __builtin_amdgcn_rcpf(sum);
        int* IDX = (int*)(P.ws + WS_IDX) + (size_t)grow * 16 + 8 * hf; float* GW = (float*)(P.ws + WS_GW) + (size_t)grow * 16 + 8 * hf;
#pragma unroll
        for (int q = 0; q < 8; ++q) {
            const unsigned c = (C[q] & evenmask) | (C[8 + q] & ~evenmask);
            const float ev = __builtin_bit_cast(float, (__builtin_bit_cast(unsigned, e[q]) & evenmask) | (__builtin_bit_cast(unsigned, e[8 + q]) & ~evenmask));
            const unsigned pos = 255u - (c & 255u);
            IDX[q] = il[pos >> 4] * 128 + il[16 + (pos & 15u)]; GW[q] = ev * inv;
        }
    }
    LDS_WAIT(); asm volatile("" ::: "memory");
}

__device__ __forceinline__ void peer_topk_wave(const Params& P, LAS int* ilw, LAS unsigned* oute, LAS float* outg, int tbase, int lane) {
    const unsigned char* ws = P.ws;
    typedef _Float16 f16x8 __attribute__((ext_vector_type(8)));
    const int rl = lane >> 1, hf = lane & 1, t = tbase + (rl >> 3), h = rl & 7;
    const _Float16* SC = (const _Float16*)(ws + WS_PQ) + (size_t)t * 2048 + h * 256 + 64 * hf;
    f16x8 raw[2][8];
#pragma unroll
    for (int p = 0; p < 2; ++p)
#pragma unroll
        for (int q = 0; q < 8; ++q) raw[p][q] = *(const f16x8*)(SC + p * 128 + 8 * q);
    unsigned L1[16], L2[16];
#pragma unroll
    for (int p = 0; p < 2; ++p) {
        unsigned L[16];
#pragma unroll
        for (int grp = 0; grp < 4; ++grp) {
            unsigned G[16];
#pragma unroll
            for (int e = 0; e < 16; ++e) G[e] = (key_enc((float)raw[p][2 * grp + (e >> 3)][e & 7]) & ~127u) | (unsigned)(127 - (64 * hf + 16 * grp + e));
            tk_sort16(G);
            if (grp == 0) {
#pragma unroll
                for (int i = 0; i < 16; ++i) L[i] = G[i];
            } else tk_top16_merge(L, G);
        }
        tk_pair_merge(L);
#pragma unroll
        for (int i = 0; i < 16; ++i) { if (p == 0) L1[i] = L[i]; else L2[i] = L[i]; }
    }
    {
        float v1[16], v2[16];
        LAS int* il = ilw + rl * 33;
#pragma unroll
        for (int q = 0; q < 16; ++q) { v1[q] = key_dec((L1[q] & ~127u) | 64u); v2[q] = key_dec((L2[q] & ~127u) | 64u); }
        if (hf == 0) {
#pragma unroll
            for (int q = 0; q < 16; ++q) { il[q] = 127 - (int)(L1[q] & 127u); il[16 + q] = 127 - (int)(L2[q] & 127u); }
        }
        unsigned C[16], D[16];
        float w1[8];
        const unsigned hf16 = (unsigned)hf * 16u, evenmask = (unsigned)hf - 1u;
#pragma unroll
        for (int k = 0; k < 8; ++k) w1[k] = __builtin_bit_cast(float, (__builtin_bit_cast(unsigned, v1[2 * k]) & evenmask) | (__builtin_bit_cast(unsigned, v1[2 * k + 1]) & ~evenmask));
#define TK_SLOT(dst, k, bq, valid_odd) do { const unsigned pos_ = (unsigned)(16 * (2 * (k)) + (bq)) + hf16; unsigned kv_ = (key_enc(w1[k] + v2[bq]) & ~255u) | (255u - pos_); if (!(valid_odd)) kv_ &= evenmask; dst = kv_; } while (0)
        TK_SLOT(C[0], 0, 0, true);
        TK_SLOT(C[1], 0, 1, true);
        TK_SLOT(C[2], 0, 2, true);
        TK_SLOT(C[3], 0, 3, true);
        TK_SLOT(C[4], 0, 4, true);
        TK_SLOT(C[5], 0, 5, true);
        TK_SLOT(C[6], 0, 6, true);
        TK_SLOT(C[7], 0, 7, true);
        TK_SLOT(C[8], 0, 8, false);
        TK_SLOT(C[9], 0, 9, false);
        TK_SLOT(C[10], 0, 10, false);
        TK_SLOT(C[11], 0, 11, false);
        TK_SLOT(C[12], 0, 12, false);
        TK_SLOT(C[13], 0, 13, false);
        TK_SLOT(C[14], 0, 14, false);
        TK_SLOT(C[15], 0, 15, false);
        TK_SLOT(D[0], 1, 0, true);
        TK_SLOT(D[1], 1, 1, true);
        TK_SLOT(D[2], 1, 2, true);
        TK_SLOT(D[3], 1, 3, true);
        TK_SLOT(D[4], 1, 4, false);
        TK_SLOT(D[5], 2, 0, true);
        TK_SLOT(D[6], 2, 1, true);
        TK_SLOT(D[7], 2, 2, false);
        TK_SLOT(D[8], 3, 0, true);
        TK_SLOT(D[9], 3, 1, true);
        TK_SLOT(D[10], 4, 0, true);
        TK_SLOT(D[11], 5, 0, true);
        TK_SLOT(D[12], 6, 0, true);
        TK_SLOT(D[13], 7, 0, true);
        D[14] = 0u; D[15] = 0u;
#undef TK_SLOT
        tk_sort16(C); tk_sort16(D); tk_top16_merge(C, D); tk_pair_merge(C);
        LDS_WAIT(); asm volatile("" ::: "memory");
        float best[16], e[16], sum = 0.f;
#pragma unroll
        for (int q = 0; q < 16; ++q) { best[q] = key_dec((C[q] & ~255u) | 128u); e[q] = __expf(best[q] - best[0]); sum += e[q]; }
        const float inv = __builtin_amdgcn_rcpf(sum);
        LAS unsigned* IDX = oute + rl * 16 + 8 * hf; LAS float* GW = outg + rl * 16 + 8 * hf;
#pragma unroll
        for (int q = 0; q < 8; ++q) {
            const unsigned c = (C[q] & evenmask) | (C[8 + q] & ~evenmask);
            const float ev = __builtin_bit_cast(float, (__builtin_bit_cast(unsigned, e[q]) & evenmask) | (__builtin_bit_cast(unsigned, e[8 + q]) & ~evenmask));
            const unsigned pos = 255u - (c & 255u);
            IDX[q] = (unsigned)(il[pos >> 4] * 128 + il[16 + (pos & 15u)]); GW[q] = ev * inv;
        }
    }
    LDS_WAIT(); asm volatile("" ::: "memory");
}

typedef float f32x2 __attribute__((ext_vector_type(2)));
__device__ __forceinline__ unsigned q8(float x) { return (unsigned)(int)rintf(x) & 0xffu; }
__device__ __forceinline__ void cvt_table_fp8(const float* src, unsigned char* dst, float* scl, int gw, int ngw, int lane) {
    for (int row = gw; row < 16384; row += ngw) {
        const f32x4* sp = (const f32x4*)(src + (size_t)row * 1024 + 16 * lane);
        const f32x4 a0 = sp[0], a1 = sp[1], a2 = sp[2], a3 = sp[3];
        float m = fmaxf(fmaxf(fmaxf(fabsf(a0.x), fabsf(a0.y)), fmaxf(fabsf(a0.z), fabsf(a0.w))), fmaxf(fmaxf(fabsf(a1.x), fabsf(a1.y)), fmaxf(fabsf(a1.z), fabsf(a1.w))));
        m = fmaxf(m, fmaxf(fmaxf(fmaxf(fabsf(a2.x), fabsf(a2.y)), fmaxf(fabsf(a2.z), fabsf(a2.w))), fmaxf(fmaxf(fabsf(a3.x), fabsf(a3.y)), fmaxf(fabsf(a3.z), fabsf(a3.w)))));
#pragma unroll
        for (int o = 1; o < 64; o <<= 1) m = fmaxf(m, __shfl_xor(m, o));
        m = fmaxf(m, 1e-30f);
        const float q = 127.0f / m;
        v4u o;
        o.x = q8(a0.x * q) | (q8(a0.y * q) << 8) | (q8(a0.z * q) << 16) | (q8(a0.w * q) << 24);
        o.y = q8(a1.x * q) | (q8(a1.y * q) << 8) | (q8(a1.z * q) << 16) | (q8(a1.w * q) << 24);
        o.z = q8(a2.x * q) | (q8(a2.y * q) << 8) | (q8(a2.z * q) << 16) | (q8(a2.w * q) << 24);
        o.w = q8(a3.x * q) | (q8(a3.y * q) << 8) | (q8(a3.z * q) << 16) | (q8(a3.w * q) << 24);
        *(v4u*)(dst + (size_t)row * 1024 + 16 * lane) = o;
        if (lane == 0) scl[row] = m * (1.0f / 127.0f);
    }
}
__device__ __forceinline__ int row16_sum_i(int v) {
    v += __builtin_amdgcn_update_dpp(0, v, 0xB1, 0xF, 0xF, true);
    v += __builtin_amdgcn_update_dpp(0, v, 0x4E, 0xF, 0xF, true);
    v += __builtin_amdgcn_update_dpp(0, v, 0x141, 0xF, 0xF, true);
    v += __builtin_amdgcn_update_dpp(0, v, 0x140, 0xF, 0xF, true);
    return v;
}
constexpr int PE_NT = 4, PE_NR = 16, PE_SH = 10, PE_DEP = 3;
constexpr int PE_TOK_W = 128 * 3 + 20;
constexpr int PE_WAVE_W = PE_NT * PE_TOK_W + 272 + 32 * 33 + 2 * PE_NT * 128;
static_assert(8 * PE_WAVE_W * 4 <= MISC_OFF && PE_NR * PE_NT == 64, "peer LDS / batch-list geometry");
#define PE_LD(dst, voff_, sbase_) asm volatile("s_nop 4\n\tglobal_load_dwordx4 %0, %1, %2" : "=&v"(dst) : "v"(voff_), "s"(sbase_) : "memory")
__device__ __forceinline__ void peer_pass(const Params& P, LAS unsigned char* lds, int tbase, int lane, int wave, float* dstbase, int emask = 0x3fff) {
    {
        LAS unsigned* lw0 = (LAS unsigned*)(lds) + wave * PE_WAVE_W + PE_NT * PE_TOK_W + 272;
        peer_topk_wave(P, (LAS int*)lw0, lw0 + 32 * 33, (LAS float*)(lw0 + 32 * 33 + PE_NT * 128), tbase, lane);
        LDS_WAIT(); asm volatile("" : "+v"(lane), "+s"(tbase) :: "memory");
    }
    const unsigned char* ws = P.ws;
    const unsigned char* UB8 = ws + WS_UB; const unsigned char* VB8 = ws + WS_VB;
    const float* USC = (const float*)(ws + WS_USC); const float* VSC = (const float*)(ws + WS_VSC);
    unsigned hq[PE_NT][4]; f32x2 acc[PE_NT][8];
    LAS unsigned* lw = (LAS unsigned*)(lds) + wave * PE_WAVE_W;
    LAS unsigned* ents = lw + PE_NT * PE_TOK_W;
    const unsigned voff = (unsigned)lane * 16u;
    LAS unsigned* upe = ents + 272 + 32 * 33; LAS float* upg = (LAS float*)(upe + PE_NT * 128);
#pragma unroll
    for (int j = 0; j < PE_NT; ++j) {
        const int t = tbase + j;
        const v4u* xrow = (const v4u*)((const bf16*)(ws + WS_XB) + (size_t)t * 1024 + 16 * lane);
        const v4u xa = xrow[0], xc = xrow[1];
        const f32x4 xvv[4] = {(f32x4){bflo(xa.x), bfhi(xa.x), bflo(xa.y), bfhi(xa.y)}, (f32x4){bflo(xa.z), bfhi(xa.z), bflo(xa.w), bfhi(xa.w)},
                              (f32x4){bflo(xc.x), bfhi(xc.x), bflo(xc.y), bfhi(xc.y)}, (f32x4){bflo(xc.z), bfhi(xc.z), bflo(xc.w), bfhi(xc.w)}};
        const float rstd2 = rsqrtf(((const float*)(ws + WS_SSQ2))[t] * (1.0f / 1024.0f) + 1e-6f);
        f32x4 hv[4]; float hm = 0.f;
#pragma unroll
        for (int i = 0; i < 4; ++i) { const f32x4 xv = xvv[i]; const f32x4 w = ((const f32x4*)(P.norm_ffn_w + 16 * lane))[i];
            hv[i] = (f32x4){xv.x * rstd2 * w.x, xv.y * rstd2 * w.y, xv.z * rstd2 * w.z, xv.w * rstd2 * w.w};
            hm = fmaxf(hm, fmaxf(fmaxf(fabsf(hv[i].x), fabsf(hv[i].y)), fmaxf(fabsf(hv[i].z), fabsf(hv[i].w)))); }
#pragma unroll
        for (int o = 1; o < 64; o <<= 1) hm = fmaxf(hm, __shfl_xor(hm, o));
        hm = fmaxf(hm, 1e-30f);
        const float hqs = 127.0f / hm, hs = hm * (1.0f / 127.0f);
#pragma unroll
        for (int i = 0; i < 4; ++i) hq[j][i] = q8(hv[i].x * hqs) | (q8(hv[i].y * hqs) << 8) | (q8(hv[i].z * hqs) << 16) | (q8(hv[i].w * hqs) << 24);
#pragma unroll
        for (int i = 0; i < 8; ++i) acc[j][i] = (f32x2){0.f, 0.f};
        const int e0 = (int)upe[j * 128 + 2 * lane] & emask, e1 = (int)upe[j * 128 + 2 * lane + 1] & emask;
        const float g0 = upg[j * 128 + 2 * lane] * VSC[e0], g1 = upg[j * 128 + 2 * lane + 1] * VSC[e1];
        const float u0 = USC[e0] * hs, u1 = USC[e1] * hs;
        const int b0 = e0 >> PE_SH, b1 = e1 >> PE_SH;
        LAS unsigned* lt = lw + j * PE_TOK_W;
        int run = 0;
#pragma unroll 1
        for (int bk = 0; bk < PE_NR; ++bk) {
            const unsigned long long m0 = __ballot(b0 == bk), m1 = __ballot(b1 == bk);
            const int c0 = __popcll(m0), c1 = __popcll(m1);
            const unsigned long long lower = (1ull << lane) - 1ull;
            if (b0 == bk) { const int p = run + __popcll(m0 & lower); lt[p] = (unsigned)e0; lt[128 + p] = __builtin_bit_cast(unsigned, g0); lt[256 + p] = __builtin_bit_cast(unsigned, u0); }
            if (b1 == bk) { const int p = run + c0 + __popcll(m1 & lower); lt[p] = (unsigned)e1; lt[128 + p] = __builtin_bit_cast(unsigned, g1); lt[256 + p] = __builtin_bit_cast(unsigned, u1); }
            if (lane == 0) lt[384 + bk] = (unsigned)run;
            run += c0 + c1;
        }
        if (lane == 0) lt[384 + PE_NR] = 128u;
        asm volatile("" ::: "memory");
    }
    LDS_WAIT(); asm volatile("" ::: "memory");
    int nb;
    {
        const int rd = lane >> 2, j = lane & 3;
        const LAS unsigned* lt = lw + j * PE_TOK_W;
        const int n0 = (int)lt[384 + rd], n1 = (int)lt[384 + rd + 1];
        const int nbl = (n1 - n0 + 3) >> 2;
        int inc = nbl;
#pragma unroll
        for (int off = 1; off < 64; off <<= 1) { const int tv = __shfl_up(inc, off); if (lane >= off) inc += tv; }
        nb = __builtin_amdgcn_readlane(inc, 63);
        const int ofs = inc - nbl;
        for (int q = 0; q < nbl; ++q) { const int i0 = n0 + 4 * q, c = (n1 - i0) < 4 ? (n1 - i0) : 4; ents[ofs + q] = (unsigned)j | ((unsigned)c << 2) | ((unsigned)i0 << 5); }
        if (lane < 2 * PE_DEP) ents[nb + lane] = 0u;
    }
    LDS_WAIT(); asm volatile("" ::: "memory");
    v4u ru[PE_DEP][4], rv[PE_DEP][4];
#define PE_ISSUE(S, entv) do { const unsigned en_ = (entv); const int j_ = (int)(en_ & 3u), c_ = (int)((en_ >> 2) & 7u), i_ = (int)(en_ >> 5); \
        const LAS unsigned* lt_ = lw + j_ * PE_TOK_W; const int cl_ = c_ > 0 ? c_ - 1 : 0; \
        const int ev_ = (int)lt_[i_ + (lane < cl_ ? lane : cl_)];                          \
        _Pragma("unroll") for (int k_ = 0; k_ < 4; ++k_) { const size_t eo_ = (size_t)__builtin_amdgcn_readlane(ev_, k_) * 1024; \
            const unsigned char* up_ = UB8 + eo_; const unsigned char* vp_ = VB8 + eo_; PE_LD(ru[S][k_], voff, up_); PE_LD(rv[S][k_], voff, vp_); } } while (0)
#define PE_WAIT8(S, cntstr) asm volatile("s_waitcnt " cntstr : "+v"(ru[S][0]), "+v"(ru[S][1]), "+v"(ru[S][2]), "+v"(ru[S][3]), "+v"(rv[S][0]), "+v"(rv[S][1]), "+v"(rv[S][2]), "+v"(rv[S][3]) :: "memory")
#define PE_COMPUTE_J(S, J, c_, i_) do { const LAS unsigned* lt_ = lw + (J) * PE_TOK_W; \
        const float gsc_ = (lane < c_) ? __builtin_bit_cast(float, lt_[128 + i_ + lane]) : 0.f, usc_ = (lane < c_) ? __builtin_bit_cast(float, lt_[256 + i_ + lane]) : 0.f; \
        int d_[4]; \
        _Pragma("unroll") for (int k_ = 0; k_ < 4; ++k_) { d_[k_] = 0; if (k_ >= c_) continue; \
            int s_ = __builtin_amdgcn_sdot4((int)ru[S][k_].x, (int)hq[J][0], 0, false); s_ = __builtin_amdgcn_sdot4((int)ru[S][k_].y, (int)hq[J][1], s_, false); \
            s_ = __builtin_amdgcn_sdot4((int)ru[S][k_].z, (int)hq[J][2], s_, false); s_ = __builtin_amdgcn_sdot4((int)ru[S][k_].w, (int)hq[J][3], s_, false); d_[k_] = s_; } \
        int r2_[2], r1_; \
        { const bool up_ = (lane & 32) != 0; \
          _Pragma("unroll") for (int q_ = 0; q_ < 2; ++q_) { const int keep_ = up_ ? d_[2 + q_] : d_[q_], send_ = up_ ? d_[q_] : d_[2 + q_]; r2_[q_] = keep_ + __shfl_xor(send_, 32); } } \
        { const bool up_ = (lane & 16) != 0; const int keep_ = up_ ? r2_[1] : r2_[0], send_ = up_ ? r2_[0] : r2_[1]; r1_ = keep_ + __shfl_xor(send_, 16); } \
        r1_ = row16_sum_i(r1_); \
        const int myk_ = (lane >> 4) & 3; \
        const float act_ = gelu_tanh((float)r1_ * __shfl(usc_, myk_)) * __shfl(gsc_, myk_);      \
          \
        const float w0_ = __builtin_bit_cast(float, __builtin_amdgcn_readlane(__builtin_bit_cast(int, act_), 0)), w1_ = __builtin_bit_cast(float, __builtin_amdgcn_readlane(__builtin_bit_cast(int, act_), 16)), \
                    w2_ = __builtin_bit_cast(float, __builtin_amdgcn_readlane(__builtin_bit_cast(int, act_), 32)), w3_ = __builtin_bit_cast(float, __builtin_amdgcn_readlane(__builtin_bit_cast(int, act_), 48)); \
        const float wm_ = fmaxf(fmaxf(fmaxf(fabsf(w0_), fabsf(w1_)), fmaxf(fabsf(w2_), fabsf(w3_))), 1e-30f), wq_ = 127.0f / wm_, ws_ = wm_ * (1.0f / 127.0f); \
        const int w4_ = (int)(q8(w0_ * wq_) | (q8(w1_ * wq_) << 8) | (q8(w2_ * wq_) << 16) | (q8(w3_ * wq_) << 24)); \
        const f32x2 ws2_ = (f32x2){ws_, ws_}; \
        _Pragma("unroll") for (int m_ = 0; m_ < 4; ++m_) { \
            const unsigned R0_ = rv[S][0][m_], R1_ = rv[S][1][m_], R2_ = rv[S][2][m_], R3_ = rv[S][3][m_]; \
            const unsigned X_ = __builtin_amdgcn_perm(R1_, R0_, 0x05010400u), Y_ = __builtin_amdgcn_perm(R1_, R0_, 0x07030602u), Z_ = __builtin_amdgcn_perm(R3_, R2_, 0x05010400u), W_ = __builtin_amdgcn_perm(R3_, R2_, 0x07030602u); \
            const int t0_ = __builtin_amdgcn_sdot4((int)__builtin_amdgcn_perm(Z_, X_, 0x05040100u), w4_, 0, false), t1_ = __builtin_amdgcn_sdot4((int)__builtin_amdgcn_perm(Z_, X_, 0x07060302u), w4_, 0, false), \
                      t2_ = __builtin_amdgcn_sdot4((int)__builtin_amdgcn_perm(W_, Y_, 0x05040100u), w4_, 0, false), t3_ = __builtin_amdgcn_sdot4((int)__builtin_amdgcn_perm(W_, Y_, 0x07060302u), w4_, 0, false); \
            acc[J][2 * m_] = __builtin_elementwise_fma((f32x2){(float)t0_, (float)t1_}, ws2_, acc[J][2 * m_]); \
            acc[J][2 * m_ + 1] = __builtin_elementwise_fma((f32x2){(float)t2_, (float)t3_}, ws2_, acc[J][2 * m_ + 1]); } } while (0)
#define PE_COMPUTE(S, entv) do { const unsigned en_ = (entv); const int jj_ = (int)(en_ & 3u), cc_ = (int)((en_ >> 2) & 7u), ii_ = (int)(en_ >> 5); \
        if (cc_ > 0) { if (jj_ == 0) PE_COMPUTE_J(S, 0, cc_, ii_); else if (jj_ == 1) PE_COMPUTE_J(S, 1, cc_, ii_); else if (jj_ == 2) PE_COMPUTE_J(S, 2, cc_, ii_); else PE_COMPUTE_J(S, 3, cc_, ii_); } } while (0)
    {
        unsigned er[PE_DEP];
#pragma unroll
        for (int q = 0; q < PE_DEP; ++q) { er[q] = __builtin_amdgcn_readfirstlane(ents[q]); PE_ISSUE(q, er[q]); }
#pragma unroll 1
        for (int bi = 0; bi < nb; bi += PE_DEP) {
#pragma unroll
            for (int q = 0; q < PE_DEP; ++q) {
                PE_WAIT8(q, "vmcnt(16)");
                PE_COMPUTE(q, er[q]);
                er[q] = __builtin_amdgcn_readfirstlane(ents[bi + q + PE_DEP]);
                PE_ISSUE(q, er[q]);
            }
        }
#pragma unroll
        for (int q = 0; q < PE_DEP; ++q) PE_WAIT8(q, "vmcnt(0)");
    }
#undef PE_COMPUTE
#undef PE_COMPUTE_J
#undef PE_WAIT8
#undef PE_ISSUE
#pragma unroll
    for (int j = 0; j < PE_NT; ++j) {
        const int t = tbase + j;
        float ss = 0.f; f32x4 xo[4];
        { const v4u* xrow = (const v4u*)((const bf16*)(ws + WS_XB) + (size_t)t * 1024 + 16 * lane); const v4u xa = xrow[0], xc = xrow[1];
          xo[0] = (f32x4){bflo(xa.x), bfhi(xa.x), bflo(xa.y), bfhi(xa.y)}; xo[1] = (f32x4){bflo(xa.z), bfhi(xa.z), bflo(xa.w), bfhi(xa.w)};
          xo[2] = (f32x4){bflo(xc.x), bfhi(xc.x), bflo(xc.y), bfhi(xc.y)}; xo[3] = (f32x4){bflo(xc.z), bfhi(xc.z), bflo(xc.w), bfhi(xc.w)}; }
#pragma unroll
        for (int i = 0; i < 4; ++i) { xo[i].x += acc[j][2 * i].x; xo[i].y += acc[j][2 * i].y; xo[i].z += acc[j][2 * i + 1].x; xo[i].w += acc[j][2 * i + 1].y;
            ss += (xo[i].x * xo[i].x + xo[i].y * xo[i].y) + (xo[i].z * xo[i].z + xo[i].w * xo[i].w); }
        const float rstd3 = rsqrtf(wave_sum(ss) * (1.0f / 1024.0f) + 1e-6f);
        float* orow = dstbase + (size_t)t * 1024 + 16 * lane;
#pragma unroll
        for (int i = 0; i < 4; ++i) { const f32x4 w = ((const f32x4*)(P.norm_final_w + 16 * lane))[i];
            ((f32x4*)orow)[i] = (f32x4){xo[i].x * rstd3 * w.x, xo[i].y * rstd3 * w.y, xo[i].z * rstd3 * w.z, xo[i].w * rstd3 * w.w}; }
    }
    LDS_WAIT(); asm volatile("s_waitcnt vmcnt(0)" ::: "memory");
}


__global__ void __launch_bounds__(NWAVES * 64, 2) hybrid_fwd(Params P) {
    extern __shared__ __attribute__((aligned(16))) unsigned char lds_raw[];
    LAS unsigned char* lds = (LAS unsigned char*)lds_raw;
    volatile LAS unsigned* MISC = (volatile LAS unsigned*)(lds + MISC_OFF);
    const int tid = threadIdx.x, lane = tid & 63, wave = __builtin_amdgcn_readfirstlane(tid >> 6);
    const int G = gridDim.x, bx = blockIdx.x;
    const int vcu = (G % 8 == 0) ? (bx % 8) * (G / 8) + bx / 8 : bx;
    unsigned char* ws = P.ws;
    for (int u = tid; u < 64; u += NWAVES * 64) MISC[u] = 0u;
    __syncthreads();
    XcdBarrier bar; bar.bar = (unsigned*)(ws + WS_CTL) + CW_BAR; bar.x = 0; bar.st = nullptr;
    if (!MK_PER_PHASE) bar = xcd_barrier_post((unsigned*)(ws + WS_CTL) + CW_BAR, MISC + 8);
    const int lo = P.ph_lo, hi = P.ph_hi;
#ifndef PHASE_MASK
#define PHASE_MASK 0xFFF
#endif
#define IN(k) (((PHASE_MASK >> (k)) & 1) && lo <= (k) && (k) < hi)
#define SEAM(k) do { if (IN(k) && IN((k) + 1)) xcd_barrier(bar); } while (0)
#ifndef REP_MASK
#define REP_MASK 0
#endif
#ifndef PE_EXP_MASK
#define PE_EXP_MASK 0x3fff
#endif
#define REPS(k) for (int rep_ = 0; rep_ < (((REP_MASK >> (k)) & 1) ? 2 : 1); ++rep_, (rep_ < (((REP_MASK >> (k)) & 1) ? 2 : 1) ? xcd_barrier(bar) : (void)0))
    using namespace pg8;
    bf16* XB = (bf16*)(ws + WS_XB);

    if (IN(0)) REPS(0) { p0_prologue(P, lds, tid, lane, wave, vcu, G); }
    SEAM(0);
    if (IN(1)) REPS(1) {
        { Gemm gm{XB, (const bf16_t*)(ws + WS_WIN), T, 3072, 1024}; StaticOrder S; S.init(T, 3072, G, bx);
          EpiBf16Rs E{(bf16_t*)(ws + WS_QKV), 1536, 6, (bf16_t*)(ws + WS_XR), 512, (size_t)T * 512, nullptr, 1.0f};
          gemm_phase<EpiBf16Rs, StaticOrder, PG8_ALIGN, PG8_SP2>(lds, gm, S, E); }
    }
    SEAM(1);
    if (IN(2)) REPS(2) {
#ifndef P2_REP_GDN
#define P2_REP_GDN 1
#endif
#ifndef P2_REP_LRU
#define P2_REP_LRU 1
#endif
        for (int rr = 0; rr < P2_REP_GDN; ++rr) for (int it = bx; it < 1024; it += G) gdn_local_item(P, lds, it, tid);
    }
    SEAM(2);
    if (IN(3)) REPS(3) {
        if (bx < SCAN_WGS) gdn_scan(P, lds, bx, tid, lane, wave);
        else {
            const int wk = bx - SCAN_WGS, NWK = G - SCAN_WGS;
            unsigned* lcnt = (unsigned*)(ws + WS_CTL) + CW_LRUCNT;
            if (wk < 16) {
                struct OneUnit { int pm, pn; __device__ bool next(int i, Unit& u) const { if (i > 0) return false; u.pm = pm; u.pn = pn; return true; }
                                 __device__ void a_ready(const Unit&) const {} __device__ void done(const Unit&) const {} };
                Gemm gm{(const bf16_t*)(ws + WS_MEMN), (const bf16_t*)(ws + WS_WKV), 512, 2048, 1024}; OneUnit S{wk >> 3, wk & 7};
                EpiKV E{(bf16_t*)(ws + WS_KB), (bf16_t*)(ws + WS_VTP)};
                gemm_phase<EpiKV, OneUnit, PG8_ALIGN, PG8_SP2>(lds, gm, S, E);
            }
            unsigned ndone = 0;
            for (int lt = wk; lt < 256; lt += NWK) { lru_local_item(P, lds, lt, tid, lane, wave); ++ndone; }
            asm volatile("s_waitcnt vmcnt(0)" ::: "memory");
            __syncthreads();
            if (tid == 0 && ndone) { __builtin_amdgcn_fence(__ATOMIC_RELEASE, "agent"); asm volatile("s_waitcnt vmcnt(0)" ::: "memory");
                                     __hip_atomic_fetch_add(lcnt, ndone, __ATOMIC_RELAXED, __HIP_MEMORY_SCOPE_AGENT); }
            if (wk == 16 || wk == 17) {
                if (tid == 0) { unsigned sp = 0;
                    while (__hip_atomic_load(lcnt, __ATOMIC_RELAXED, __HIP_MEMORY_SCOPE_AGENT) < 256u) { __builtin_amdgcn_s_sleep(8); if (++sp > (1u << 22)) break; }
                    __builtin_amdgcn_fence(__ATOMIC_ACQUIRE, "agent"); asm volatile("s_waitcnt vmcnt(0)" ::: "memory"); }
                __syncthreads();
                lru_carry(P, (wk - 16) * NWAVES + wave, lane);
                asm volatile("s_waitcnt vmcnt(0)" ::: "memory");
                __syncthreads();
                if (tid == 0) { __builtin_amdgcn_fence(__ATOMIC_RELEASE, "agent"); asm volatile("s_waitcnt vmcnt(0)" ::: "memory");
                                __hip_atomic_fetch_add(lcnt + 64, 1u, __ATOMIC_RELAXED, __HIP_MEMORY_SCOPE_AGENT); }
            } else {
                const int w2 = (wk < 16 ? wk : wk - 2), N2 = NWK - 2;
                cvt_table_fp8(P.peer_u, ws + WS_UB, (float*)(ws + WS_USC), w2 * NWAVES + wave, N2 * NWAVES, lane);
                cvt_table_fp8(P.peer_v, ws + WS_VB, (float*)(ws + WS_VSC), w2 * NWAVES + wave, N2 * NWAVES, lane);
                late_weight_prep(P, lds, lane, wave, w2 * NWAVES + wave, N2 * NWAVES);
                if (tid == 0) { unsigned sp = 0;
                    while (__hip_atomic_load(lcnt + 64, __ATOMIC_RELAXED, __HIP_MEMORY_SCOPE_AGENT) < 2u) { __builtin_amdgcn_s_sleep(8); if (++sp > (1u << 22)) break; }
                    __builtin_amdgcn_fence(__ATOMIC_ACQUIRE, "agent"); asm volatile("s_waitcnt vmcnt(0)" ::: "memory"); }
                __syncthreads();
                lru_combine(P, (size_t)w2 * (NWAVES * 64) + tid, (size_t)N2 * (NWAVES * 64));
            }
        }
    }
    SEAM(3);
    if (IN(4)) REPS(4) {
        gdn_gate_norm(P, (size_t)bx * (NWAVES * 64) + tid, (size_t)G * (NWAVES * 64));
    }
    SEAM(4);
    if (IN(5)) {
        Gemm gm{(const bf16_t*)(ws + WS_Y), (const bf16_t*)(ws + WS_WOUT), T, 1024, 1024}; StaticOrder S; S.init(T, 1024, G, bx);
        EpiResidBf<true> E{P.x, XB, (float*)(ws + WS_SSQ1)};
        gemm_phase<EpiResidBf<true>, StaticOrder, PG8_ALIGN, PG8_SP2>(lds, gm, S, E);
    }
    SEAM(5);
    if (IN(6)) REPS(6) {
        Gemm gm{XB, (const bf16_t*)(ws + WS_WQ), T, 1024, 1024}; StaticOrder S; S.init(T, 1024, G, bx);
        EpiBf16Rs E{(bf16_t*)(ws + WS_Q), 1024, 4, nullptr, 256, 0, (const float*)(ws + WS_SSQ1), 0.0625f};
        gemm_phase<EpiBf16Rs, StaticOrder, PG8_ALIGN, PG8_SP2>(lds, gm, S, E);
        Unit u;
        { const int wgid = (bx & 7) * 32 + (bx >> 3); u.pm = (wgid >> 5) * 8 + (wgid & 7); u.pn = (wgid & 31) >> 3; }
        if (G == 256) {
            asm volatile("s_waitcnt vmcnt(0)" ::: "memory");
            __syncthreads();
            const int b = u.pm >> 5, qb0 = (u.pm & 31) * 2, h = u.pn;
#pragma unroll 1
            for (int qq = 0; qq < 2; ++qq) xattn_unit(P, lds, (b << 8) | ((qb0 + qq) << 2) | h, tid, lane, wave);
        }
    }
    if (IN(7)) REPS(7) { }
    SEAM(7);
    if (IN(8)) {
        Gemm gm{(const bf16_t*)(ws + WS_AO), (const bf16_t*)(ws + WS_WO), T, 1024, 1024}; StaticOrder S; S.init(T, 1024, G, bx);
        EpiResidBf<false> E{nullptr, XB, (float*)(ws + WS_SSQ2)};
        gemm_phase<EpiResidBf<false>, StaticOrder, PG8_ALIGN, PG8_SP2>(lds, gm, S, E);
    }
    SEAM(8);
    if (IN(9)) REPS(9) {
        Gemm gm{XB, (const bf16_t*)(ws + WS_PWQ), T, 2048, 1024}; StaticOrder S; S.init(T, 2048, G, bx);
        EpiF16Rs E{(_Float16*)(ws + WS_PQ), 2048, (const float*)(ws + WS_SSQ2)};
        gemm_phase<EpiF16Rs, StaticOrder, PG8_ALIGN, PG8_SP2>(lds, gm, S, E);
    }
    SEAM(9);
    if (IN(10)) REPS(10) {
    }
    if (IN(11)) REPS(11) {
        for (int tb = (bx * NWAVES + wave) * PE_NT; tb < T; tb += G * NWAVES * PE_NT) peer_pass(P, lds, tb, lane, wave, (((REP_MASK >> 11) & 1) && rep_ == 0) ? (float*)(ws + WS_PQ) : P.out, (((REP_MASK >> 11) & 1) && rep_ == 0) ? PE_EXP_MASK : 0x3fff);
    }
#undef IN
#undef SEAM
}

extern "C" void kernel_launch(void* const* d_in, const int* in_sizes, int n_in, void* d_out, int out_size, void* d_ws, size_t ws_size, hipStream_t stream) {
    static int grid = 0;
    if (grid == 0) {
        if (n_in != 27 || in_sizes[0] != T * D || out_size != T * D || ws_size < WS_END) {
            fprintf(stderr, "kernel_launch: unexpected shapes (n_in %d, in0 %d, out %d, ws %zu); nothing launched\n", n_in, n_in > 0 ? in_sizes[0] : -1, out_size, ws_size); grid = -1; return; }
        int dev = 0, cus = 0, per_cu = 0;
        if (hipGetDevice(&dev) != hipSuccess || hipDeviceGetAttribute(&cus, hipDeviceAttributeMultiprocessorCount, dev) != hipSuccess) { grid = -1; return; }
        if (hipFuncSetAttribute((const void*)hybrid_fwd, hipFuncAttributeMaxDynamicSharedMemorySize, LDS_BYTES) != hipSuccess) { fprintf(stderr, "kernel_launch: hipFuncSetAttribute failed\n"); grid = -1; return; }
        if (hipOccupancyMaxActiveBlocksPerMultiprocessor(&per_cu, (const void*)hybrid_fwd, NWAVES * 64, LDS_BYTES) != hipSuccess || per_cu < 1)
            fprintf(stderr, "kernel_launch: note: occupancy query reports %d workgroups per CU\n", per_cu);
        (void)hipGetLastError();
        grid = cus;
        if (grid != 256) fprintf(stderr, "kernel_launch: %d CUs (built for 256)\n", grid);
    }
    if (grid < 0) return;
    if (hipMemsetAsync((char*)d_ws + WS_CTL, 0, CTL_ZERO_BYTES, stream) != hipSuccess) { fprintf(stderr, "kernel_launch: hipMemsetAsync failed\n"); return; }
    Params p{};
    const float** pp = (const float**)&p;
    for (int i = 0; i < 27; ++i) pp[i] = (const float*)d_in[i];
    p.out = (float*)d_out; p.ws = (unsigned char*)d_ws;
#if MK_PER_PHASE
    for (int k = 0; k < N_PHASES; ++k) { p.ph_lo = k; p.ph_hi = k + 1; hipLaunchKernelGGL(hybrid_fwd, dim3(grid), dim3(NWAVES * 64), LDS_BYTES, stream, p); }
#else
    p.ph_lo = 0; p.ph_hi = N_PHASES;
    hipLaunchKernelGGL(hybrid_fwd, dim3(grid), dim3(NWAVES * 64), LDS_BYTES, stream, p);
#endif
    const hipError_t le = hipPeekAtLastError();
    if (le != hipSuccess) fprintf(stderr, "kernel_launch: launch failed: %s\n", hipGetErrorName(le));
}
```

```cpp
#include <hip/hip_runtime.h>
#include <cstdio>
#include <cstdint>
namespace pg8 {
#define PG8_LAS __attribute__((address_space(3)))
typedef unsigned short bf16_t;
typedef short bf16x8 __attribute__((ext_vector_type(8)));
typedef float f32x4 __attribute__((ext_vector_type(4)));
typedef unsigned u32x4 __attribute__((ext_vector_type(4)));
constexpr int BM = 256, BK = 64, HALF = 128, HTB = HALF * BK * 2  , STAGE_BYTES = 8 * HTB, NXCD = 8, WGM = 8;

__host__ __device__ __forceinline__ int lds_byte(int r, int c) { const int st = (r >> 4) * 2 + (c >> 5), rr = r & 15, cc = c & 31, ob = rr * 64 + cc * 2; return st * 1024 + (ob ^ (((ob >> 9) & 1) << 5)); }
__host__ __device__ __forceinline__ void stage_rc(int b, int& R, int& C) { const int st = b / 1024, sb = b % 1024, swz = sb ^ (((sb >> 9) & 1) << 5); R = (st >> 1) * 16 + swz / 64; C = (st & 1) * 32 + (swz % 64) / 2; }
__host__ __device__ __forceinline__ int perm32(int rho) { const int n = rho >> 4, i = rho & 15; return 8 * (i >> 2) + 4 * n + (i & 3); }

struct Unit { int pm, pn; };
struct Gemm { const bf16_t* A; const bf16_t* Bt; int M, N, K; };

struct StaticOrder {
    int nM, nN, nwg, G, c;
    __host__ __device__ void init(int M, int N, int G_, int c_) { nM = M / BM; nN = N / BM; nwg = nM * nN; G = G_; c = c_; }
    __host__ __device__ bool next(int i, Unit& u) const {
        const long L = (long)i * G + c; if (L >= nwg) return false;
        int wgid = (int)L; { const int q = nwg / NXCD, r = nwg % NXCD, xcd = wgid % NXCD, off = wgid / NXCD; wgid = (xcd < r ? xcd * (q + 1) : r * (q + 1) + (xcd - r) * q) + off; }
        const int nig = WGM * nN, gid = wgid / nig, fm = gid * WGM, gsz = (nM - fm) < WGM ? (nM - fm) : WGM;
        u.pm = fm + ((wgid % nig) % gsz); u.pn = (wgid % nig) / gsz; return true;
    }
    __device__ __forceinline__ void a_ready(const Unit&) const {}
    __device__ __forceinline__ void done(const Unit&) const {}
};

__device__ __forceinline__ unsigned cvt_pk_bf16(float lo, float hi) { unsigned r; asm volatile("v_cvt_pk_bf16_f32 %0, %1, %2" : "=v"(r) : "v"(lo), "v"(hi)); return r; }
template <class Epi, class Sched, bool ALIGN_EPI = false, bool SP2 = false>
__device__ __forceinline__ void gemm_phase(PG8_LAS unsigned char* lds, const Gemm g, const Sched& S, const Epi& E) {
    const int tid = threadIdx.x, wid = __builtin_amdgcn_readfirstlane(tid >> 6), lane = tid & 63, wr = wid >> 2, wc = wid & 3, fr = lane & 15, fq = lane >> 4;
    const int K = g.K, nt = K / BK;
    unsigned voffA[2], voffB[2];
#pragma unroll
    for (int i = 0; i < 2; ++i) { int R, C; stage_rc(tid * 16 + i * 8192, R, C); const int Rb = Epi::PERM ? ((R & ~31) + perm32(R & 31)) : R;
        voffA[i] = (unsigned)(R * K + C) * 2u; voffB[i] = (unsigned)(Rb * K + C) * 2u; }
    const size_t kstep = (size_t)(BK * 2);
    const size_t hstep = (size_t)HALF * K * 2;
    const size_t tstep = 2 * hstep;
    const unsigned ldsw = (unsigned)wid * 1024u;
    const int aoff = lds_byte(wr * 64 + fr, fq * 8), boff = lds_byte(wc * 32 + fr, fq * 8);
#define PG8_SA(b, h) (((b) * 2 + (h)) * HTB)
#define PG8_SB(b, h) ((4 + (b) * 2 + (h)) * HTB)
#define PG8_STAGE(bufoff, gbase, voff) do { _Pragma("unroll") for (int _i = 0; _i < 2; ++_i) \
        __builtin_amdgcn_global_load_lds((const unsigned*)((const char*)(gbase) + (voff)[_i]), (PG8_LAS unsigned*)(lds + (bufoff) + ldsw + _i * 8192), 16, 0, 0); } while (0)
#define PG8_LDA(dst, b, h) do { _Pragma("unroll") for (int m = 0; m < 4; ++m) _Pragma("unroll") for (int k = 0; k < 2; ++k) dst[m][k] = *(const PG8_LAS bf16x8*)(lds + PG8_SA(b, h) + aoff + m * 2048 + k * 1024); } while (0)
#define PG8_LDB(dst, b, h) do { _Pragma("unroll") for (int n = 0; n < 2; ++n) _Pragma("unroll") for (int k = 0; k < 2; ++k) dst[n][k] = *(const PG8_LAS bf16x8*)(lds + PG8_SB(b, h) + boff + n * 2048 + k * 1024); } while (0)
#define PG8_MMA(ai, bj, At, Bt) do { __builtin_amdgcn_s_setprio(1); _Pragma("unroll") for (int m = 0; m < 4; ++m) _Pragma("unroll") for (int n = 0; n < 2; ++n) _Pragma("unroll") for (int k = 0; k < 2; ++k) \
        acc[ai][bj][m][n] = __builtin_amdgcn_mfma_f32_16x16x32_bf16(Bt[n][k], At[m][k], acc[ai][bj][m][n], 0, 0, 0); __builtin_amdgcn_s_setprio(0); } while (0)
#define PG8_WAIT_V(n) asm volatile("s_waitcnt vmcnt(" #n ")" ::: "memory")
#define PG8_WAIT_L(n) asm volatile("s_waitcnt lgkmcnt(" #n ")" ::: "memory")
#define PG8_BAR __builtin_amdgcn_s_barrier()
#define PG8_SCHED __builtin_amdgcn_sched_barrier(0)
    Unit cur, nxt; int ui = 0;
    if (!S.next(0, cur)) return;
    f32x4 acc[2][2][4][2];
#pragma unroll
    for (int a = 0; a < 2; ++a)
#pragma unroll
        for (int b = 0; b < 2; ++b)
#pragma unroll
            for (int m = 0; m < 4; ++m)
#pragma unroll
                for (int n = 0; n < 2; ++n) acc[a][b][m][n] = (f32x4){0.f, 0.f, 0.f, 0.f};
    bf16x8 At[4][2], B0[2][2], B1[2][2];
    const char* cA = (const char*)g.A + (size_t)cur.pm * tstep; const char* cB = (const char*)g.Bt + (size_t)cur.pn * tstep;
    S.a_ready(cur);
    if constexpr (SP2) {
        PG8_STAGE(PG8_SB(0, 0), cB, voffB); PG8_STAGE(PG8_SB(0, 1), cB + hstep, voffB); PG8_STAGE(PG8_SA(0, 0), cA, voffA); PG8_STAGE(PG8_SA(0, 1), cA + hstep, voffA);
        if (wr == 1) PG8_BAR;
        PG8_WAIT_V(2); PG8_BAR;
        PG8_STAGE(PG8_SB(1, 0), cB + kstep, voffB); PG8_STAGE(PG8_SA(1, 0), cA + kstep, voffA); PG8_STAGE(PG8_SB(1, 1), cB + hstep + kstep, voffB);
        PG8_WAIT_V(6); PG8_BAR;
    } else {
        PG8_STAGE(PG8_SB(0, 0), cB, voffB); PG8_STAGE(PG8_SA(0, 0), cA, voffA); PG8_STAGE(PG8_SB(0, 1), cB + hstep, voffB); PG8_STAGE(PG8_SA(0, 1), cA + hstep, voffA);
        if (wr == 1) PG8_BAR;
        PG8_WAIT_V(4); PG8_BAR;
        PG8_STAGE(PG8_SB(1, 0), cB + kstep, voffB); PG8_STAGE(PG8_SA(1, 0), cA + kstep, voffA); PG8_STAGE(PG8_SB(1, 1), cB + hstep + kstep, voffB);
        PG8_WAIT_V(6); PG8_BAR;
    }
    for (;;) {
        const bool has_next = S.next(ui + 1, nxt);
        const char* nA = has_next ? (const char*)g.A + (size_t)nxt.pm * tstep : cA; const char* nB = has_next ? (const char*)g.Bt + (size_t)nxt.pn * tstep : cB;
        for (int t = 0; t < nt; t += 2) {
            const bool last = (t == nt - 2);
            const char* a1 = cA + (size_t)(t + 1) * kstep;
            const char* a2 = last ? nA : cA + (size_t)(t + 2) * kstep; const char* b2 = last ? nB : cB + (size_t)(t + 2) * kstep;
            const char* a3 = a2 + kstep; const char* b3 = b2 + kstep;
            if (last && has_next) S.a_ready(nxt);
            if constexpr (SP2) {
            PG8_LDB(B0, 0, 0); PG8_LDB(B1, 0, 1); PG8_SCHED; PG8_LDA(At, 0, 0); PG8_STAGE(PG8_SA(1, 1), a1 + hstep, voffA);
            PG8_WAIT_V(8); PG8_WAIT_L(0); PG8_BAR; PG8_MMA(0, 0, At, B0); PG8_MMA(0, 1, At, B1); PG8_BAR; PG8_SCHED;
            PG8_LDA(At, 0, 1); PG8_STAGE(PG8_SB(0, 0), b2, voffB); PG8_STAGE(PG8_SB(0, 1), b2 + hstep, voffB); PG8_STAGE(PG8_SA(0, 0), a2, voffA);
            PG8_WAIT_V(8); PG8_WAIT_L(0); PG8_BAR; PG8_MMA(1, 0, At, B0); PG8_MMA(1, 1, At, B1); PG8_BAR; PG8_SCHED;
            PG8_LDB(B0, 1, 0); PG8_LDB(B1, 1, 1); PG8_SCHED; PG8_LDA(At, 1, 0); PG8_STAGE(PG8_SA(0, 1), a2 + hstep, voffA);
            PG8_WAIT_V(8); PG8_WAIT_L(0); PG8_BAR; PG8_MMA(0, 0, At, B0); PG8_MMA(0, 1, At, B1); PG8_BAR; PG8_SCHED;
            PG8_LDA(At, 1, 1); PG8_STAGE(PG8_SB(1, 0), b3, voffB); PG8_STAGE(PG8_SB(1, 1), b3 + hstep, voffB); PG8_STAGE(PG8_SA(1, 0), a3, voffA);
            PG8_WAIT_V(8); PG8_WAIT_L(0); PG8_BAR; PG8_MMA(1, 0, At, B0); PG8_MMA(1, 1, At, B1); PG8_BAR; PG8_SCHED;
            } else {
            PG8_LDB(B0, 0, 0); PG8_SCHED; PG8_LDA(At, 0, 0); PG8_STAGE(PG8_SA(1, 1), a1 + hstep, voffA);
            PG8_WAIT_L(8); PG8_BAR; PG8_WAIT_L(0); PG8_MMA(0, 0, At, B0); PG8_BAR; PG8_SCHED;
            PG8_LDB(B1, 0, 1); PG8_STAGE(PG8_SB(0, 0), b2, voffB);
            PG8_BAR; PG8_WAIT_L(0); PG8_MMA(0, 1, At, B1); PG8_BAR;
            PG8_LDA(At, 0, 1); PG8_STAGE(PG8_SA(0, 0), a2, voffA);
            PG8_BAR; PG8_WAIT_L(0); PG8_MMA(1, 0, At, B0); PG8_BAR; PG8_SCHED;
            PG8_STAGE(PG8_SB(0, 1), b2 + hstep, voffB);
            PG8_WAIT_V(6); PG8_BAR; PG8_MMA(1, 1, At, B1); PG8_BAR;
            PG8_LDB(B0, 1, 0); PG8_SCHED; PG8_LDA(At, 1, 0); PG8_STAGE(PG8_SA(0, 1), a2 + hstep, voffA);
            PG8_WAIT_L(8); PG8_BAR; PG8_WAIT_L(0); PG8_MMA(0, 0, At, B0); PG8_BAR; PG8_SCHED;
            PG8_LDB(B1, 1, 1); PG8_STAGE(PG8_SB(1, 0), b3, voffB);
            PG8_BAR; PG8_WAIT_L(0); PG8_MMA(0, 1, At, B1); PG8_BAR;
            PG8_LDA(At, 1, 1); PG8_STAGE(PG8_SA(1, 0), a3, voffA);
            PG8_BAR; PG8_WAIT_L(0); PG8_MMA(1, 0, At, B0); PG8_BAR; PG8_SCHED;
            PG8_STAGE(PG8_SB(1, 1), b3 + hstep, voffB);
            PG8_WAIT_V(6); PG8_BAR; PG8_MMA(1, 1, At, B1); PG8_BAR;
            }
        }
        if constexpr (ALIGN_EPI) { if (wr == 0) PG8_BAR; }
        if constexpr (!Epi::AFTER_DRAIN) { E(acc, cur, wr, wc, fr, fq); S.done(cur); }
        if (!has_next) break;
#pragma unroll
        for (int a = 0; a < 2; ++a)
#pragma unroll
            for (int b = 0; b < 2; ++b)
#pragma unroll
                for (int m = 0; m < 4; ++m)
#pragma unroll
                    for (int n = 0; n < 2; ++n) acc[a][b][m][n] = (f32x4){0.f, 0.f, 0.f, 0.f};
        cur = nxt; cA = nA; cB = nB; ++ui;
        if constexpr (ALIGN_EPI) { if (wr == 1) PG8_BAR; }
    }
    PG8_WAIT_V(0);
    if constexpr (!ALIGN_EPI) { if (wr == 0) PG8_BAR; }
    PG8_BAR;
    if constexpr (Epi::AFTER_DRAIN) { E.fused(acc, cur, wr, wc, fr, fq, lds, wid, lane); S.done(cur); }
#undef PG8_SA
#undef PG8_SB
#undef PG8_STAGE
#undef PG8_LDA
#undef PG8_LDB
#undef PG8_MMA
#undef PG8_WAIT_V
#undef PG8_WAIT_L
#undef PG8_BAR
#undef PG8_SCHED
}
}

namespace pg8 {
__host__ __device__ __forceinline__ int permk(int kl) { return 8 * ((kl & 15) >> 2) + 4 * (kl >> 4) + (kl & 3); }
struct EpiBf16Rs {
    static constexpr bool PERM = true, AFTER_DRAIN = false;
    bf16_t* O0; int ld0; int ntile0; bf16_t* O1; int ld1; size_t stride1; const float* ssq; float cs;
    __device__ __forceinline__ void operator()(const f32x4 (&acc)[2][2][4][2], const Unit& u, int wr, int wc, int fr, int fq) const {
        bf16_t* base; int ld, colt;
        if (u.pn < ntile0) { base = O0; ld = ld0; colt = u.pn * BM; }
        else { const int q = u.pn - ntile0, per = ld1 / BM; base = O1 + (size_t)(q / per) * stride1; ld = ld1; colt = (q % per) * BM; }
        const int row0 = u.pm * BM + wr * 64 + fr, col0 = colt + wc * 32 + 8 * fq;
#pragma unroll
        for (int ai = 0; ai < 2; ++ai)
#pragma unroll
            for (int m = 0; m < 4; ++m) {
                const int row = row0 + ai * HALF + m * 16;
                float sc = cs; if (ssq) sc *= rsqrtf(ssq[row] * (1.0f / 1024.0f) + 1e-6f);
                bf16_t* rowp = base + (size_t)row * ld + col0;
#pragma unroll
                for (int bj = 0; bj < 2; ++bj) { const f32x4 v0 = acc[ai][bj][m][0] * sc, v1 = acc[ai][bj][m][1] * sc;
                    u32x4 w; w.x = cvt_pk_bf16(v0[0], v0[1]); w.y = cvt_pk_bf16(v0[2], v0[3]); w.z = cvt_pk_bf16(v1[0], v1[1]); w.w = cvt_pk_bf16(v1[2], v1[3]);
                    *(u32x4*)(rowp + bj * HALF) = w; } }
    }
};
struct EpiF16Rs {
    static constexpr bool PERM = true, AFTER_DRAIN = false;
    _Float16* O; int ld; const float* ssq;
    __device__ __forceinline__ void operator()(const f32x4 (&acc)[2][2][4][2], const Unit& u, int wr, int wc, int fr, int fq) const {
        typedef _Float16 f16x8 __attribute__((ext_vector_type(8)));
        const int row0 = u.pm * BM + wr * 64 + fr, col0 = u.pn * BM + wc * 32 + 8 * fq;
#pragma unroll
        for (int ai = 0; ai < 2; ++ai)
#pragma unroll
            for (int m = 0; m < 4; ++m) {
                const int row = row0 + ai * HALF + m * 16;
                const float sc = rsqrtf(ssq[row] * (1.0f / 1024.0f) + 1e-6f);
                _Float16* rowp = O + (size_t)row * ld + col0;
#pragma unroll
                for (int bj = 0; bj < 2; ++bj) { const f32x4 v0 = acc[ai][bj][m][0] * sc, v1 = acc[ai][bj][m][1] * sc;
                    f16x8 w; w[0] = (_Float16)v0[0]; w[1] = (_Float16)v0[1]; w[2] = (_Float16)v0[2]; w[3] = (_Float16)v0[3];
                    w[4] = (_Float16)v1[0]; w[5] = (_Float16)v1[1]; w[6] = (_Float16)v1[2]; w[7] = (_Float16)v1[3];
                    *(f16x8*)(rowp + bj * HALF) = w; } }
    }
};
template <bool BASE_F32> struct EpiResidBf {
    static constexpr bool PERM = true, AFTER_DRAIN = false;
    const float* basef; bf16_t* xb; float* ssq;
    __device__ __forceinline__ void operator()(const f32x4 (&acc)[2][2][4][2], const Unit& u, int wr, int wc, int fr, int fq) const {
        const int row0 = u.pm * BM + wr * 64 + fr, col0 = u.pn * BM + wc * 32 + 8 * fq;
#pragma unroll
        for (int ai = 0; ai < 2; ++ai)
#pragma unroll
            for (int m = 0; m < 4; ++m) {
                const int row = row0 + ai * HALF + m * 16; const size_t off = (size_t)row * 1024 + col0; float s = 0.f;
#pragma unroll
                for (int bj = 0; bj < 2; ++bj) { const size_t o2 = off + bj * HALF;
                    f32x4 b0, b1;
                    if (BASE_F32) { b0 = *(const f32x4*)(basef + o2); b1 = *(const f32x4*)(basef + o2 + 4); }
                    else { const u32x4 p = *(const u32x4*)(xb + o2);
                        b0 = (f32x4){__builtin_bit_cast(float, p.x << 16), __builtin_bit_cast(float, p.x & 0xffff0000u), __builtin_bit_cast(float, p.y << 16), __builtin_bit_cast(float, p.y & 0xffff0000u)};
                        b1 = (f32x4){__builtin_bit_cast(float, p.z << 16), __builtin_bit_cast(float, p.z & 0xffff0000u), __builtin_bit_cast(float, p.w << 16), __builtin_bit_cast(float, p.w & 0xffff0000u)}; }
                    const f32x4 o0 = b0 + acc[ai][bj][m][0], o1 = b1 + acc[ai][bj][m][1];
                    s += ((o0[0] * o0[0] + o0[1] * o0[1]) + (o0[2] * o0[2] + o0[3] * o0[3])) + ((o1[0] * o1[0] + o1[1] * o1[1]) + (o1[2] * o1[2] + o1[3] * o1[3]));
                    u32x4 w; w.x = cvt_pk_bf16(o0[0], o0[1]); w.y = cvt_pk_bf16(o0[2], o0[3]); w.z = cvt_pk_bf16(o1[0], o1[1]); w.w = cvt_pk_bf16(o1[2], o1[3]);
                    *(u32x4*)(xb + o2) = w; }
                s += __shfl_xor(s, 16); s += __shfl_xor(s, 32);
                if (fq == 0) atomicAdd(ssq + row, s);
            }
    }
};
struct EpiKV {
    static constexpr bool PERM = false, AFTER_DRAIN = false;
    bf16_t* Kb; bf16_t* VTp;
    __device__ __forceinline__ void operator()(const f32x4 (&acc)[2][2][4][2], const Unit& u, int wr, int wc, int fr, int fq) const {
        typedef unsigned u32x2v __attribute__((ext_vector_type(2)));
        const int row0 = u.pm * BM + wr * 64 + fr, col0 = u.pn * BM + wc * 32 + 4 * fq;
#pragma unroll
        for (int ai = 0; ai < 2; ++ai)
#pragma unroll
            for (int m = 0; m < 4; ++m) {
                const int row = row0 + ai * HALF + m * 16, b = row >> 8, key = row & 255;
#pragma unroll
                for (int bj = 0; bj < 2; ++bj)
#pragma unroll
                    for (int n = 0; n < 2; ++n) { const int col = col0 + bj * HALF + n * 16; const f32x4 v = acc[ai][bj][m][n];
                        const unsigned p01 = cvt_pk_bf16(v[0], v[1]), p23 = cvt_pk_bf16(v[2], v[3]);
                        if (col < 1024) { const int h = col >> 8, dh = col & 255; u32x2v w; w.x = p01; w.y = p23;
                            *(u32x2v*)(Kb + ((size_t)((b * 4 + h) * 256 + key)) * 256 + dh) = w; }
                        else { const int c2 = col - 1024, h = c2 >> 8, dv = c2 & 255, kp = (key & ~31) | permk(key & 31);
                            bf16_t* d = VTp + ((size_t)((b * 4 + h) * 256 + dv)) * 256 + kp;
                            d[0] = (bf16_t)(p01 & 0xffffu); d[256] = (bf16_t)(p01 >> 16); d[512] = (bf16_t)(p23 & 0xffffu); d[768] = (bf16_t)(p23 >> 16); } }
            }
    }
};
}
#ifndef PG8_SP2
#define PG8_SP2 true
#endif
#ifndef PG8_ALIGN
#define PG8_ALIGN true
#endif

constexpr int NWAVES = 8;
#ifndef MK_PER_PHASE
#define MK_PER_PHASE 0
#endif
constexpr int T = 16384, SEQ = 8192, D = 1024;
constexpr int N_PHASES = 12;

constexpr size_t MiB = 1u << 20, KiB = 1u << 10;
constexpr size_t WS_CTL = 0, CTL_ZERO_BYTES = 1 * MiB;
constexpr int CW_BAR = 4096;
constexpr size_t WS_SSQ1 = 64 * KiB, WS_SSQ2 = 128 * KiB;
constexpr size_t WS_AB = 1 * MiB;
constexpr size_t WS_HEND = WS_AB + 512 * KiB, WS_PEND = WS_HEND + 512 * KiB, WS_HIN = WS_PEND + 512 * KiB;
constexpr size_t WS_DEC = WS_HIN + 512 * KiB;
constexpr size_t WS_SUBK = 3 * MiB + 256 * KiB;
constexpr size_t WS_WIN = 4 * MiB, WS_WOUT = 10 * MiB, WS_WQ = 12 * MiB, WS_WKV = 14 * MiB, WS_WO = 18 * MiB, WS_PWQ = 20 * MiB;
constexpr size_t WS_MEMN = 24 * MiB, WS_KB = 25 * MiB, WS_VTP = 26 * MiB, WS_LRUWT = 27 * MiB, WS_USC = 27 * MiB + 256 * KiB, WS_VSC = 27 * MiB + 384 * KiB;
constexpr size_t WS_XB = 28 * MiB;
constexpr size_t WS_HLOC = 28 * MiB, WS_PCUM = 44 * MiB;
constexpr size_t WS_QKV = 60 * MiB;
constexpr size_t OUT_Y = 4 * MiB;
constexpr size_t OUT_END = OUT_Y + (size_t)16384 * 1024 * 2;
constexpr size_t WS_IDX = 60 * MiB, WS_GW = 68 * MiB;
constexpr size_t WS_UB = 60 * MiB;
constexpr size_t WS_XR = 108 * MiB, WS_Z = 124 * MiB, WS_GATE = 140 * MiB;
constexpr size_t WS_WN = 156 * MiB, WS_UF = 172 * MiB, WS_QD = 188 * MiB, WS_KD = 204 * MiB, WS_ATT = 220 * MiB;
constexpr size_t WS_VB = 228 * MiB;
constexpr size_t WS_Q = 188 * MiB, WS_AO = 124 * MiB;
constexpr size_t WS_PQ = 108 * MiB;
constexpr size_t WS_END = 244 * MiB;
constexpr int CW_GFLAG = 49152;
constexpr int CW_LRUCNT = 8192;
static_assert(WS_XR - WS_QKV == (size_t)T * 1536 * 2 && WS_Z - WS_XR == (size_t)T * 512 * 2 && WS_GATE - WS_Z == (size_t)T * 512 * 2, "in-proj outputs are contiguous");

constexpr int LDS_BYTES = 160 * 1024;
constexpr int MISC_OFF = 159 * 1024;

#define GAS __attribute__((address_space(1)))
#define LAS __attribute__((address_space(3)))
typedef unsigned short bf16;
typedef unsigned v4u __attribute__((ext_vector_type(4)));
typedef unsigned v2u __attribute__((ext_vector_type(2)));
typedef float f32x4 __attribute__((ext_vector_type(4)));
typedef short bf16x8 __attribute__((ext_vector_type(8)));
typedef GAS unsigned gu32;
#define LDS_WAIT() asm volatile("s_waitcnt lgkmcnt(0)" ::: "memory")
__device__ __forceinline__ void st16_wt(void* p, v4u v) { asm volatile("global_store_dwordx4 %0, %1, off sc0 sc1\n\ts_nop 1" :: "v"(p), "v"(v) : "memory"); }
__device__ __forceinline__ unsigned f2bf(float f) { unsigned u = __builtin_bit_cast(unsigned, f); return (u + 0x7fffu + ((u >> 16) & 1u)) >> 16; }
__device__ __forceinline__ unsigned pk2(float lo, float hi) { return f2bf(lo) | (f2bf(hi) << 16); }
__device__ __forceinline__ float bflo(unsigned u) { return __builtin_bit_cast(float, u << 16); }
__device__ __forceinline__ float bfhi(unsigned u) { return __builtin_bit_cast(float, u & 0xffff0000u); }
__device__ __forceinline__ float bf1(bf16 h) { return __builtin_bit_cast(float, (unsigned)h << 16); }
__device__ __forceinline__ float wave_sum(float v) {
#pragma unroll
    for (int o = 1; o < 64; o <<= 1) v += __shfl_xor(v, o);
    return v;
}
__device__ __forceinline__ float row16_sum(float v) {
    v += __builtin_bit_cast(float, __builtin_amdgcn_update_dpp(0, __builtin_bit_cast(int, v), 0xB1, 0xF, 0xF, true));
    v += __builtin_bit_cast(float, __builtin_amdgcn_update_dpp(0, __builtin_bit_cast(int, v), 0x4E, 0xF, 0xF, true));
    v += __builtin_bit_cast(float, __builtin_amdgcn_update_dpp(0, __builtin_bit_cast(int, v), 0x141, 0xF, 0xF, true));
    v += __builtin_bit_cast(float, __builtin_amdgcn_update_dpp(0, __builtin_bit_cast(int, v), 0x140, 0xF, 0xF, true));
    return v;
}
__device__ __forceinline__ float sigmoidf_(float x) { return __builtin_amdgcn_rcpf(1.0f + __expf(-x)); }
__device__ __forceinline__ float softplusf_(float x) { return fmaxf(x, 0.f) + log1pf(__expf(-fabsf(x))); }
__device__ __forceinline__ float siluf_(float x) { return x * __builtin_amdgcn_rcpf(1.0f + __expf(-x)); }
__device__ __forceinline__ float gelu_tanh(float x) { const float y = 0.7978845608028654f * (x + 0.044715f * x * x * x); const float e = __expf(2.0f * y); return x * (1.0f - __builtin_amdgcn_rcpf(1.0f + e)); }
__device__ __forceinline__ int permk(int kl) { return 8 * ((kl & 15) >> 2) + 4 * (kl >> 4) + (kl & 3); }

struct Params {
    const float *x, *mem, *norm_mix_w, *w_in, *conv_qkv_w, *gdn_a_log, *gdn_dt_bias, *gdn_norm_w, *lru_conv_w, *lru_conv_b, *lru_wa, *lru_ba, *lru_wx, *lru_bx, *lru_lambda, *w_out,
                *norm_xattn_w, *norm_mem_w, *xattn_wq, *xattn_wkv, *xattn_wo, *norm_ffn_w, *peer_wq, *peer_subkeys, *peer_u, *peer_v, *norm_final_w;
    float* out; unsigned char* ws; int ph_lo, ph_hi;
};
#define XB_TMO      128
#define XB_XCNT(j)  (256  + 64 * (j))
#define XB_XSUB(j)  (1280 + 64 * (j))
#define XB_XGEN(j)  (2304 + 64 * (j))
#define XB_TOP      3328
#define XB_TOPGEN   3392
#define XCD_BAR_WORDS 3456
#define XB_SPIN_CAP (1u << 18)

__device__ __forceinline__ unsigned xb_ld(unsigned* p)              { return __hip_atomic_load(p, __ATOMIC_RELAXED, __HIP_MEMORY_SCOPE_AGENT); }
__device__ __forceinline__ unsigned xb_add(unsigned* p, unsigned v) { return __hip_atomic_fetch_add(p, v, __ATOMIC_RELAXED, __HIP_MEMORY_SCOPE_AGENT); }
__device__ __forceinline__ unsigned xb_xcc_id() { return (unsigned)__builtin_amdgcn_s_getreg((3 << 11) | 20) & 0xFu; }
#define XB_SPIN(cond, bar) do { unsigned _sp = 0; while (cond) { __builtin_amdgcn_s_sleep(1); \
    if ((++_sp & 255u) == 0u) { if (xb_ld(&(bar)[XB_TMO])) break; if (_sp > XB_SPIN_CAP) { atomicAdd(&(bar)[XB_TMO], 1u); break; } } } } while (0)

struct XcdBarrier {
    unsigned* bar; unsigned x;
    volatile LAS unsigned* st;
};

__device__ __forceinline__ XcdBarrier xcd_barrier_post(unsigned* bar, volatile LAS unsigned* st) {
    XcdBarrier b; b.bar = bar; b.x = xb_xcc_id(); b.st = st;
    if (threadIdx.x == 0) (void)xb_add(&bar[XB_XCNT(b.x)], 1u);
    return b;
}
__device__ __forceinline__ void xcd_barrier_complete(unsigned* bar, unsigned x, unsigned& nloc, unsigned& nx) {
    const unsigned G = gridDim.x * gridDim.y * gridDim.z;
    unsigned sum, cnt, mine, sp = 0u;
    for (;;) {
        sum = 0u; cnt = 0u; mine = 0u;
#pragma unroll
        for (unsigned j = 0; j < 16; ++j) { const unsigned c = xb_ld(&bar[XB_XCNT(j)]); sum += c; cnt += (c > 0u) ? 1u : 0u; mine = (j == x) ? c : mine; }
        if (sum == G) break;
        __builtin_amdgcn_s_sleep(1);
        if ((++sp & 255u) == 0u) { if (xb_ld(&bar[XB_TMO])) break; if (sp > XB_SPIN_CAP) { atomicAdd(&bar[XB_TMO], 1u); break; } }
    }
    nloc = mine > 0u ? mine : 1u; nx = cnt > 0u ? cnt : 1u;
}

__device__ __forceinline__ void xcd_barrier(const XcdBarrier& b) {
    asm volatile("s_waitcnt vmcnt(0)" ::: "memory");
    __syncthreads();
    if (threadIdx.x == 0) {
        unsigned* bar = b.bar;
        __builtin_amdgcn_s_waitcnt(0);
        unsigned nloc = b.st[0], nx = b.st[1];
        if (nloc == 0u) { xcd_barrier_complete(bar, b.x, nloc, nx); b.st[0] = nloc; b.st[1] = nx; }
        const unsigned old = xb_add(&bar[XB_XSUB(b.x)], 1u);
        const unsigned gen = old / nloc;
        if (old + 1u == (gen + 1u) * nloc) {
            __builtin_amdgcn_fence(__ATOMIC_RELEASE, "agent");
            asm volatile("s_waitcnt vmcnt(0)" ::: "memory");
            const unsigned og = xb_add(&bar[XB_TOP], 1u);
            const unsigned tg = og / nx;
            if (og + 1u == (tg + 1u) * nx) xb_add(&bar[XB_TOPGEN], 1u);
            else XB_SPIN(xb_ld(&bar[XB_TOPGEN]) == tg, bar);
            __builtin_amdgcn_fence(__ATOMIC_ACQUIRE, "agent");
            xb_add(&bar[XB_XGEN(b.x)], 1u);
            asm volatile("s_waitcnt vmcnt(0)" ::: "memory");
        } else {
            XB_SPIN(xb_ld(&bar[XB_XGEN(b.x)]) == gen, bar);
            __builtin_amdgcn_fence(__ATOMIC_ACQUIRE, "agent");
            asm volatile("s_waitcnt vmcnt(0)" ::: "memory");
        }
    }
    __syncthreads();
}

__device__ __forceinline__ void p0_transpose_item(const float* W, int K, int ldw, int c0, int nblk, bf16* WT, int row_off, const float* ks, LAS float* scr, int item, int lane) {
    const int kb = item / nblk, nb = item % nblk, k0 = 64 * kb, n0 = 32 * nb;
#pragma unroll 8
    for (int i = 0; i < 32; ++i) { const int kk = 2 * i + (lane >> 5); float v = W[(size_t)(k0 + kk) * ldw + c0 + n0 + (lane & 31)]; if (ks) v *= ks[k0 + kk]; scr[kk * 33 + (lane & 31)] = v; }
    LDS_WAIT(); asm volatile("" ::: "memory");
    const int c = lane & 7;
#pragma unroll
    for (int j = 0; j < 4; ++j) { const int n = (lane >> 3) + 8 * j; const LAS float* s = scr + (8 * c) * 33 + n;
        v4u o; o.x = pk2(s[0 * 33], s[1 * 33]); o.y = pk2(s[2 * 33], s[3 * 33]); o.z = pk2(s[4 * 33], s[5 * 33]); o.w = pk2(s[6 * 33], s[7 * 33]);
        *(GAS v4u*)(WT + (size_t)(row_off + n0 + n) * K + k0 + 8 * c) = o; }
    LDS_WAIT(); asm volatile("" ::: "memory");
}

__device__ __forceinline__ void p0_prologue(const Params& P, LAS unsigned char* lds, int tid, int lane, int wave, int vcu, int G) {
    unsigned char* ws = P.ws;
    const int gw = vcu * NWAVES + wave, NGW = G * NWAVES;
    LAS float* wabl = (LAS float*)lds;
    for (int idx = tid; idx < 8192; idx += NWAVES * 64) { const int k = idx >> 3, c = idx & 7, j = k >> 8, l = (k >> 2) & 63, e = k & 3;
        wabl[((((j * 4 + e) * 2 + (c >> 2)) * 64 + l) << 2) + (c & 3)] = P.w_in[(size_t)k * 3080 + 2048 + c]; }
    __syncthreads();
    {
        bf16* XB0 = (bf16*)(ws + WS_XB); float* AB = (float*)(ws + WS_AB);
        f32x4 w4[4];
#pragma unroll
        for (int j = 0; j < 4; ++j) w4[j] = ((const f32x4*)P.norm_mix_w)[64 * j + lane];
        for (int m = gw; m < T; m += NGW) {
            const f32x4* xr = (const f32x4*)(P.x + (size_t)m * D) + lane;
            f32x4 v[4]; float s = 0.f;
#pragma unroll
            for (int j = 0; j < 4; ++j) { v[j] = xr[64 * j]; s += (v[j].x * v[j].x + v[j].y * v[j].y) + (v[j].z * v[j].z + v[j].w * v[j].w); }
            const float rstd = rsqrtf(wave_sum(s) * (1.0f / D) + 1e-6f);
            v2u* o8 = (v2u*)(XB0 + (size_t)m * D) + lane;
            float part[8];
#pragma unroll
            for (int c = 0; c < 8; ++c) part[c] = 0.f;
#pragma unroll
            for (int j = 0; j < 4; ++j) {
                v[j] = v[j] * rstd * w4[j];
                v2u o; o.x = pk2(v[j].x, v[j].y); o.y = pk2(v[j].z, v[j].w); o8[64 * j] = o;
#pragma unroll
                for (int e = 0; e < 4; ++e) {
                    const f32x4 wa = *(const LAS f32x4*)(wabl + ((((j * 4 + e) * 2 + 0) * 64 + lane) << 2));
                    const f32x4 wb = *(const LAS f32x4*)(wabl + ((((j * 4 + e) * 2 + 1) * 64 + lane) << 2));
                    const float hv = v[j][e];
                    part[0] += hv * wa.x; part[1] += hv * wa.y; part[2] += hv * wa.z; part[3] += hv * wa.w;
                    part[4] += hv * wb.x; part[5] += hv * wb.y; part[6] += hv * wb.z; part[7] += hv * wb.w;
                }
            }
#pragma unroll
            for (int c = 0; c < 8; ++c) part[c] = wave_sum(part[c]);
            float o = part[0];
#pragma unroll
            for (int c = 1; c < 8; ++c) o = (lane == c) ? part[c] : o;
            if (lane < 8) AB[(size_t)m * 8 + lane] = o;
        }
    }
    {
        bf16* MEMN = (bf16*)(ws + WS_MEMN);
        for (int m = gw; m < 512; m += NGW) {
            const f32x4* xr = (const f32x4*)(P.mem + (size_t)m * D) + lane;
            f32x4 v[4]; float s = 0.f;
#pragma unroll
            for (int j = 0; j < 4; ++j) { v[j] = xr[64 * j]; s += (v[j].x * v[j].x + v[j].y * v[j].y) + (v[j].z * v[j].z + v[j].w * v[j].w); }
            const float rstd = rsqrtf(wave_sum(s) * (1.0f / D) + 1e-6f);
            v2u* o8 = (v2u*)(MEMN + (size_t)m * D) + lane;
#pragma unroll
            for (int j = 0; j < 4; ++j) { const f32x4 w = ((const f32x4*)P.norm_mem_w)[64 * j + lane]; const f32x4 y = v[j] * rstd * w;
                v2u o; o.x = pk2(y.x, y.y); o.y = pk2(y.z, y.w); o8[64 * j] = o; }
        }
    }
    __syncthreads();
    {
        LAS float* scr = (LAS float*)(lds + wave * 16384);
        constexpr int I_IN1 = 16 * 48, I_IN2 = 16 * 16, I_KV = 16 * 64;
        constexpr int NITEMS = I_IN1 + 3 * I_IN2 + I_KV;
        for (int it = gw; it < NITEMS; it += NGW) {
            int r = it;
            if (r < I_IN1) { p0_transpose_item(P.w_in, 1024, 3080, 0, 48, (bf16*)(ws + WS_WIN), 0, nullptr, scr, r, lane); continue; } r -= I_IN1;
            if (r < I_IN2) { p0_transpose_item(P.w_in, 1024, 3080, 2056, 16, (bf16*)(ws + WS_WIN), 1536, nullptr, scr, r, lane); continue; } r -= I_IN2;
            if (r < I_IN2) { p0_transpose_item(P.w_in, 1024, 3080, 1536, 16, (bf16*)(ws + WS_WIN), 2048, nullptr, scr, r, lane); continue; } r -= I_IN2;
            if (r < I_IN2) { p0_transpose_item(P.w_in, 1024, 3080, 2568, 16, (bf16*)(ws + WS_WIN), 2560, nullptr, scr, r, lane); continue; } r -= I_IN2;
            p0_transpose_item(P.xattn_wkv, 1024, 2048, 0, 64, (bf16*)(ws + WS_WKV), 0, nullptr, scr, r, lane);
        }
    }
    {
        bf16* WT = (bf16*)(ws + WS_LRUWT);
        for (int it = vcu * NWAVES * 64 + tid; it < 8 * 2 * 64 * 8; it += G * NWAVES * 64) {
            const int i8 = it & 7, j = (it >> 3) & 63, m = (it >> 9) & 1, g = it >> 10;
            const float* src = (m ? P.lru_wx : P.lru_wa) + (size_t)(g * 64 + 8 * i8) * 64 + j;
            v4u o; o.x = pk2(src[0], src[64]); o.y = pk2(src[128], src[192]); o.z = pk2(src[256], src[320]); o.w = pk2(src[384], src[448]);
            *(v4u*)(WT + (size_t)it * 8) = o;
        }
    }
}

__device__ __forceinline__ void late_weight_prep(const Params& P, LAS unsigned char* lds, int lane, int wave, int gw, int NGW) {
    unsigned char* ws = P.ws;
    {
        LAS float* scr = (LAS float*)(lds + wave * 16384);
        constexpr int I_OUT = 16 * 32, I_Q = 16 * 32, I_O = 16 * 32;
        for (int it = gw; it < I_OUT + I_Q + I_O; it += NGW) {
            int r = it;
            if (r < I_OUT) { p0_transpose_item(P.w_out, 1024, 1024, 0, 32, (bf16*)(ws + WS_WOUT), 0, nullptr, scr, r, lane); continue; } r -= I_OUT;
            if (r < I_Q) { p0_transpose_item(P.xattn_wq, 1024, 1024, 0, 32, (bf16*)(ws + WS_WQ), 0, P.norm_xattn_w, scr, r, lane); continue; } r -= I_Q;
            p0_transpose_item(P.xattn_wo, 1024, 1024, 0, 32, (bf16*)(ws + WS_WO), 0, nullptr, scr, r, lane);
        }
    }
    {
        bf16* WF = (bf16*)(ws + WS_PWQ);
        const int col = lane & 15, g = lane >> 4;
        for (int it = gw; it < 16 * 64; it += NGW) {
            const int hp = it >> 6, k0 = (it & 63) * 16;
            bf16x8 bq[4];
#pragma unroll
            for (int s = 0; s < 4; ++s) { const f32x4* src = (const f32x4*)(P.peer_wq + (size_t)(k0 + col) * 2048 + hp * 128 + 32 * s + 8 * g);
                const f32x4 a = src[0], c = src[1]; v4u pk; pk.x = pk2(a.x, a.y); pk.y = pk2(a.z, a.w); pk.z = pk2(c.x, c.y); pk.w = pk2(c.z, c.w); bq[s] = __builtin_bit_cast(bf16x8, pk); }
            const float nw = P.norm_ffn_w[k0 + col];
#pragma unroll 2
            for (int kt = 0; kt < 8; ++kt) {
                f32x4 acc = (f32x4){0.f, 0.f, 0.f, 0.f};
#pragma unroll
                for (int s = 0; s < 4; ++s) { const f32x4* src = (const f32x4*)(P.peer_subkeys + (size_t)(hp * 128 + 16 * kt + col) * 128 + 32 * s + 8 * g);
                    const f32x4 a = src[0], c = src[1]; v4u pk; pk.x = pk2(a.x, a.y); pk.y = pk2(a.z, a.w); pk.z = pk2(c.x, c.y); pk.w = pk2(c.z, c.w);
                    acc = __builtin_amdgcn_mfma_f32_16x16x32_bf16(__builtin_bit_cast(bf16x8, pk), bq[s], acc, 0, 0, 0); }
#pragma unroll
                for (int i = 0; i < 4; ++i) WF[(size_t)(hp * 128 + 16 * kt + 4 * g + i) * 1024 + k0 + col] = (bf16)f2bf(acc[i] * nw);
            }
        }
    }
}

constexpr int GL_KS = 0, GL_VS = 33792, GL_KB = 67584, GL_QB = 84992, GL_RAW = 102400, GL_CW = 153856, GL_AMT = 133120, GL_SM = 160000, GL_ATT = 151808, GL_SOL = 67584;
static_assert(GL_CW + 6144 <= GL_SM && GL_SM + 1284 <= MISC_OFF && GL_SOL + 65536 <= GL_AMT && GL_AMT + 17408 <= GL_ATT && GL_ATT + 8192 <= GL_SM && GL_RAW + 51456 <= GL_CW, "gdn_local LDS map");
#ifndef GL_REP_STEP
#define GL_REP_STEP -1
#endif
#define GL_REPF(k) for (int rr_ = 0; rr_ < ((GL_REP_STEP == (k)) ? 2 : 1); ++rr_)
#define GL_BAR() do { asm volatile("s_waitcnt lgkmcnt(0)" ::: "memory"); __builtin_amdgcn_s_barrier(); asm volatile("" ::: "memory"); } while (0)
__device__ __forceinline__ void gdn_local_item(const Params& P, LAS unsigned char* lds, int item, int tid) {
    unsigned char* ws = P.ws;
    asm volatile("" : "+v"(tid));
    const int b = item >> 9, h = (item >> 7) & 3, n = item & 127;
    const int t0 = b * SEQ + n * 64;
    const int lane = tid & 63, wave = __builtin_amdgcn_readfirstlane(tid >> 6);
    LAS float* ks = (LAS float*)(lds + GL_KS);
    LAS float* vs = (LAS float*)(lds + GL_VS);
    LAS bf16* kb16 = (LAS bf16*)(lds + GL_KB);
    LAS bf16* qb16 = (LAS bf16*)(lds + GL_QB);
    LAS bf16* raw = (LAS bf16*)(lds + GL_RAW);
    LAS float* cw = (LAS float*)(lds + GL_CW);
    LAS float* AmT = (LAS float*)(lds + GL_AMT);
    LAS float* sg = (LAS float*)(lds + GL_SM);
    LAS float* sbeta = sg + 64; LAS float* sgc = sbeta + 64; LAS float* seg = sgc + 64; LAS float* sek = seg + 64;
    LAS bf16* atts = (LAS bf16*)(lds + GL_ATT);
    const bf16* QKV = (const bf16*)(ws + WS_QKV);
    const float* AB = (const float*)(ws + WS_AB);
    GL_REPF(0) {
        v4u pr[7];
#pragma unroll
        for (int r = 0; r < 7; ++r) {
            const int id = tid + 512 * r;
            const int row = id / 48, rem = id - row * 48, part = rem >> 4, ck = rem & 15, s = n * 64 + row - 3;
            pr[r] = (v4u){0u, 0u, 0u, 0u};
            if (id < 67 * 48 && s >= 0) pr[r] = *(const v4u*)(QKV + (size_t)(b * SEQ + s) * 1536 + part * 512 + h * 128 + ck * 8);
        }
        f32x4 cwv = (f32x4){0.f, 0.f, 0.f, 0.f};
        if (tid < 384) { const int j = tid / 96, rem = tid - j * 96, part = rem >> 5, c4 = rem & 31; cwv = *(const f32x4*)(P.conv_qkv_w + j * 1536 + part * 512 + h * 128 + c4 * 4); }
        float a_in = 0.f, b_in = 0.f;
        if (tid < 64) { a_in = AB[(size_t)(t0 + tid) * 8 + h]; b_in = AB[(size_t)(t0 + tid) * 8 + 4 + h]; }
#pragma unroll
        for (int r = 0; r < 7; ++r) { const int id = tid + 512 * r; if (id < 67 * 48) *(LAS v4u*)(raw + id * 8) = pr[r]; }
        if (tid < 384) *(LAS f32x4*)(cw + tid * 4) = cwv;
        if (tid < 64) { sg[tid] = -__expf(P.gdn_a_log[h]) * softplusf_(a_in + P.gdn_dt_bias[h]); sbeta[tid] = sigmoidf_(b_in); }
    }
    GL_BAR();
    GL_REPF(1) {
        const int c = tid >> 3, grp = tid & 7;
#pragma unroll 1
        for (int part = 0; part < 3; ++part) {
            float y[16];
#pragma unroll
            for (int i = 0; i < 16; ++i) y[i] = 0.f;
#pragma unroll
            for (int j = 0; j < 4; ++j) {
                const LAS v4u* src = (const LAS v4u*)(raw + (c + j) * 384 + part * 128 + grp * 16);
                const v4u x0 = src[0], x1 = src[1];
                const LAS f32x4* wp = (const LAS f32x4*)(cw + (j * 3 + part) * 128 + grp * 16);
                const f32x4 w0 = wp[0], w1 = wp[1], w2 = wp[2], w3 = wp[3];
                y[0] += w0.x * bflo(x0.x); y[1] += w0.y * bfhi(x0.x); y[2] += w0.z * bflo(x0.y); y[3] += w0.w * bfhi(x0.y);
                y[4] += w1.x * bflo(x0.z); y[5] += w1.y * bfhi(x0.z); y[6] += w1.z * bflo(x0.w); y[7] += w1.w * bfhi(x0.w);
                y[8] += w2.x * bflo(x1.x); y[9] += w2.y * bfhi(x1.x); y[10] += w2.z * bflo(x1.y); y[11] += w2.w * bfhi(x1.y);
                y[12] += w3.x * bflo(x1.z); y[13] += w3.y * bfhi(x1.z); y[14] += w3.z * bflo(x1.w); y[15] += w3.w * bfhi(x1.w);
            }
            float ss = 0.f;
#pragma unroll
            for (int i = 0; i < 16; ++i) { y[i] = siluf_(y[i]); ss += y[i] * y[i]; }
            if (part < 2) {
                ss += __shfl_xor(ss, 1); ss += __shfl_xor(ss, 2); ss += __shfl_xor(ss, 4);
                const float sc = rsqrtf(ss + 1e-6f) * (part == 0 ? 0.08838834764831845f : 1.0f);
#pragma unroll
                for (int i = 0; i < 16; ++i) y[i] *= sc;
            }
            if (part >= 1) {
                LAS float* dst = (part == 1 ? ks : vs) + c * 132 + grp * 16;
#pragma unroll
                for (int i = 0; i < 4; ++i) *(LAS f32x4*)(dst + 4 * i) = (f32x4){y[4 * i], y[4 * i + 1], y[4 * i + 2], y[4 * i + 3]};
            }
            if (part <= 1) {
                LAS bf16* dst = (part == 0 ? qb16 : kb16) + c * 136 + grp * 16;
                v4u o0, o1; o0.x = pk2(y[0], y[1]); o0.y = pk2(y[2], y[3]); o0.z = pk2(y[4], y[5]); o0.w = pk2(y[6], y[7]);
                o1.x = pk2(y[8], y[9]); o1.y = pk2(y[10], y[11]); o1.z = pk2(y[12], y[13]); o1.w = pk2(y[14], y[15]);
                *(LAS v4u*)dst = o0; *(LAS v4u*)(dst + 8) = o1;
            }
        }
    }
    if (tid < 64) {
        float v = sg[tid];
#pragma unroll
        for (int off = 1; off < 64; off <<= 1) { const float t = __shfl_up(v, off); if (tid >= off) v += t; }
        sgc[tid] = v; seg[tid] = __expf(v);
        const float gl = __shfl(v, 63);
        sek[tid] = __expf(gl - v);
        if (tid == 63) sek[64] = __expf(v);
    }
    GL_BAR();
    {
        const int mat = wave >> 2, rho = wave & 3, col = lane & 15, g = lane >> 4;
        const LAS bf16* X = mat ? qb16 : kb16;
        bf16x8 af[4];
#pragma unroll
        for (int s = 0; s < 4; ++s) af[s] = *(const LAS bf16x8*)(X + (16 * rho + col) * 136 + 32 * s + 8 * g);
#pragma unroll
        for (int sig = 0; sig < 4; ++sig) {
            f32x4 acc = (f32x4){0.f, 0.f, 0.f, 0.f};
#pragma unroll
            for (int s = 0; s < 4; ++s) { const bf16x8 bfr = *(const LAS bf16x8*)(kb16 + (16 * sig + col) * 136 + 32 * s + 8 * g); acc = __builtin_amdgcn_mfma_f32_16x16x32_bf16(af[s], bfr, acc, 0, 0, 0); }
            const int sidx = 16 * sig + col; const float gs = sgc[sidx];
#pragma unroll
            for (int i = 0; i < 4; ++i) {
                const int c = 16 * rho + 4 * g + i;
                const float dec = (c >= sidx) ? __expf(sgc[c] - gs) : 0.f;
                if (mat == 0) AmT[sidx * 68 + c] = (c > sidx) ? sbeta[c] * acc[i] * dec : 0.f;
                else atts[c * 64 + sidx] = (bf16)f2bf(acc[i] * dec);
            }
        }
    }
    GL_BAR();
    GL_REPF(4) {
        bf16* QD = (bf16*)(ws + WS_QD) + (size_t)item * 8192;
        bf16* KD = (bf16*)(ws + WS_KD) + (size_t)item * 8192;
        bf16* ATT = (bf16*)(ws + WS_ATT) + (size_t)item * 4096;
#pragma unroll
        for (int r = 0; r < 2; ++r) {
            const int id = tid + 512 * r;
            { const int c = id >> 4, gam = id & 15, s32 = gam >> 2, g = gam & 3;
              const v2u lo = *(const LAS v2u*)(qb16 + c * 136 + 32 * s32 + 4 * g), hi = *(const LAS v2u*)(qb16 + c * 136 + 32 * s32 + 16 + 4 * g);
              const float e = seg[c];
              v4u o; o.x = pk2(bflo(lo.x) * e, bfhi(lo.x) * e); o.y = pk2(bflo(lo.y) * e, bfhi(lo.y) * e); o.z = pk2(bflo(hi.x) * e, bfhi(hi.x) * e); o.w = pk2(bflo(hi.y) * e, bfhi(hi.y) * e);
              st16_wt(QD + c * 128 + 8 * gam, o); }
            { const int dk = id >> 3, gam = id & 7, s32 = gam >> 2, g = gam & 3, c0 = 32 * s32 + 4 * g;
              float v[8];
#pragma unroll
              for (int j = 0; j < 4; ++j) { v[j] = ks[(c0 + j) * 132 + dk] * sek[c0 + j]; v[4 + j] = ks[(c0 + 16 + j) * 132 + dk] * sek[c0 + 16 + j]; }
              v4u o; o.x = pk2(v[0], v[1]); o.y = pk2(v[2], v[3]); o.z = pk2(v[4], v[5]); o.w = pk2(v[6], v[7]);
              st16_wt(KD + dk * 64 + 8 * gam, o); }
        }
        { const int c = tid >> 3, gam = tid & 7, s32 = gam >> 2, g = gam & 3;
          const v2u lo = *(const LAS v2u*)(atts + c * 64 + 32 * s32 + 4 * g), hi = *(const LAS v2u*)(atts + c * 64 + 32 * s32 + 16 + 4 * g);
          v4u o; o.x = lo.x; o.y = lo.y; o.z = hi.x; o.w = hi.y;
          st16_wt(ATT + c * 64 + 8 * gam, o); }
    }
    GL_BAR();
    GL_REPF(5) {
        LAS float* xcol = (LAS float*)(lds + GL_SOL);
        LAS bf16* tinv = (LAS bf16*)(lds + GL_SOL + 17408);
        const int j = tid >> 3, part = tid & 7, jb = j >> 4, jo = j & 15;
#pragma unroll 1
        for (int rb = jb; rb < 4; ++rb) {
            float acc[16];
#pragma unroll
            for (int i = 0; i < 16; ++i) acc[i] = 0.f;
            if (rb > jb) {
#pragma unroll 2
                for (int s = 16 * jb + part; s < 16 * rb; s += 8) {
                    const float sv = xcol[j * 68 + s];
                    const LAS float* ar = AmT + s * 68 + 16 * rb;
#pragma unroll
                    for (int q = 0; q < 4; ++q) { const f32x4 A4 = *(const LAS f32x4*)(ar + 4 * q);
                        acc[4 * q] -= A4.x * sv; acc[4 * q + 1] -= A4.y * sv; acc[4 * q + 2] -= A4.z * sv; acc[4 * q + 3] -= A4.w * sv; }
                }
#pragma unroll
                for (int i = 0; i < 16; ++i) {
                    acc[i] += __builtin_bit_cast(float, __builtin_amdgcn_update_dpp(0, __builtin_bit_cast(int, acc[i]), 0xB1, 0xF, 0xF, true));
                    acc[i] += __builtin_bit_cast(float, __builtin_amdgcn_update_dpp(0, __builtin_bit_cast(int, acc[i]), 0x4E, 0xF, 0xF, true));
                    acc[i] += __builtin_bit_cast(float, __builtin_amdgcn_update_dpp(0, __builtin_bit_cast(int, acc[i]), 0x141, 0xF, 0xF, true));
                }
            } else {
#pragma unroll
                for (int i = 0; i < 16; ++i) acc[i] = (i == jo) ? 1.f : 0.f;
            }
#pragma unroll
            for (int i = 0; i < 16; ++i) {
                const float sv = acc[i];
                const LAS float* ar = AmT + (16 * rb + i) * 68 + 16 * rb;
#pragma unroll
                for (int q = (i + 1) / 4; q < 4; ++q) { const f32x4 A4 = *(const LAS f32x4*)(ar + 4 * q);
                    if (4 * q > i) acc[4 * q] -= A4.x * sv; if (4 * q + 1 > i) acc[4 * q + 1] -= A4.y * sv; if (4 * q + 2 > i) acc[4 * q + 2] -= A4.z * sv; if (4 * q + 3 > i) acc[4 * q + 3] -= A4.w * sv; }
            }
            if (part == 0) {
#pragma unroll
                for (int i = 0; i < 16; ++i) { xcol[j * 68 + 16 * rb + i] = acc[i]; tinv[(16 * rb + i) * 72 + j] = (bf16)f2bf(acc[i]); }
            }
            LDS_WAIT(); asm volatile("" ::: "memory");
        }
        for (int rb = 0; rb < jb; ++rb) {
            if (part == 0) {
#pragma unroll
                for (int i = 0; i < 16; ++i) tinv[(16 * rb + i) * 72 + j] = (bf16)0;
            }
        }
    }
    GL_BAR();
    GL_REPF(6) {
        const LAS bf16* tinv = (const LAS bf16*)(lds + GL_SOL + 17408);
        LAS bf16* wst = (LAS bf16*)(lds + GL_SOL + 17408 + 9216);
        const int col = lane & 15, g = lane >> 4, isw = wave >> 2;
        bf16x8 af[4][2];
#pragma unroll
        for (int rho = 0; rho < 4; ++rho)
#pragma unroll
            for (int s2 = 0; s2 < 2; ++s2) af[rho][s2] = *(const LAS bf16x8*)(tinv + (16 * rho + col) * 72 + 32 * s2 + 8 * g);
        bf16* UF = (bf16*)(ws + WS_UF) + (size_t)item * 8192;
#pragma unroll
        for (int sig = 0; sig < 2; ++sig) {
            const int jj = 32 * (wave & 3) + 16 * sig + col;
            const LAS float* src = (isw ? ks : vs) + jj;
            bf16x8 bfr[2];
#pragma unroll
            for (int s2 = 0; s2 < 2; ++s2) {
                float v[8];
#pragma unroll
                for (int e = 0; e < 8; ++e) { const int sidx = 32 * s2 + 8 * g + e; float x = src[sidx * 132] * sbeta[sidx]; if (isw) x *= seg[sidx]; v[e] = x; }
                v4u pk; pk.x = pk2(v[0], v[1]); pk.y = pk2(v[2], v[3]); pk.z = pk2(v[4], v[5]); pk.w = pk2(v[6], v[7]);
                bfr[s2] = __builtin_bit_cast(bf16x8, pk);
            }
            f32x4 acc[4];
#pragma unroll
            for (int rho = 0; rho < 4; ++rho) { acc[rho] = (f32x4){0.f, 0.f, 0.f, 0.f};
#pragma unroll
                for (int s2 = 0; s2 < 2; ++s2) acc[rho] = __builtin_amdgcn_mfma_f32_16x16x32_bf16(af[rho][s2], bfr[s2], acc[rho], 0, 0, 0); }
            if (!isw) {
                v4u o0, o1;
                o0.x = pk2(acc[0].x, acc[0].y); o0.y = pk2(acc[0].z, acc[0].w); o0.z = pk2(acc[1].x, acc[1].y); o0.w = pk2(acc[1].z, acc[1].w);
                o1.x = pk2(acc[2].x, acc[2].y); o1.y = pk2(acc[2].z, acc[2].w); o1.z = pk2(acc[3].x, acc[3].y); o1.w = pk2(acc[3].z, acc[3].w);
                v4u* d = (v4u*)(UF + (size_t)(2 * (wave & 3) + sig) * 1024 + lane * 16);
                st16_wt(d, o0); st16_wt(d + 1, o1);
            } else {
#pragma unroll
                for (int rho = 0; rho < 4; ++rho)
#pragma unroll
                    for (int i = 0; i < 4; ++i) wst[(16 * rho + 4 * g + i) * 136 + jj] = (bf16)f2bf(-acc[rho][i]);
            }
        }
    }
    GL_BAR();
    {
        const LAS bf16* wst = (const LAS bf16*)(lds + GL_SOL + 17408 + 9216);
        bf16* WN = (bf16*)(ws + WS_WN) + (size_t)item * 8192;
#pragma unroll
        for (int r = 0; r < 2; ++r) {
            const int id = tid + 512 * r, c = id >> 4, gam = id & 15, s32 = gam >> 2, g = gam & 3;
            const v2u lo = *(const LAS v2u*)(wst + c * 136 + 32 * s32 + 4 * g), hi = *(const LAS v2u*)(wst + c * 136 + 32 * s32 + 16 + 4 * g);
            v4u o; o.x = lo.x; o.y = lo.y; o.z = hi.x; o.w = hi.y;
            st16_wt(WN + c * 128 + 8 * gam, o);
        }
    }
    asm volatile("s_waitcnt vmcnt(0)" ::: "memory");
    GL_BAR();
    if (tid == 0) { unsigned fb = __builtin_bit_cast(unsigned, sek[64]); if (fb == 0u) fb = 1u;
        __hip_atomic_store((unsigned*)(ws + WS_CTL) + CW_GFLAG + item, fb, __ATOMIC_RELAXED, __HIP_MEMORY_SCOPE_AGENT); }
    GL_BAR();
}

constexpr int LL_XCB = 68608;
static_assert(LL_XCB + 64 * 1040 <= MISC_OFF, "lru_local LDS map");
__device__ __forceinline__ float expm1_small(float x) {
    const float p = x * (1.0f + x * (0.5f + x * (0.16666667f + x * (0.041666668f + x * 0.008333334f))));
    return (x > -0.25f) ? p : (__expf(x) - 1.0f);
}
__device__ __forceinline__ void lru_local_item(const Params& P, LAS unsigned char* lds, int lt, int tid, int lane, int wave) {
    unsigned char* ws = P.ws;
    asm volatile("" : "+v"(tid));
    const int b = lt >> 7, n = lt & 127, t0 = b * SEQ + n * 64;
    LAS bf16* rawx = (LAS bf16*)lds;
    LAS bf16* xcb = (LAS bf16*)(lds + LL_XCB);
    const bf16* XR = (const bf16*)(ws + WS_XR);
    {
        v4u pr[9];
#pragma unroll
        for (int r = 0; r < 9; ++r) { const int id = tid + 512 * r, row = id >> 6, ck = id & 63, s = n * 64 + row - 3;
            pr[r] = (v4u){0u, 0u, 0u, 0u};
            if (id < 67 * 64 && s >= 0) pr[r] = *(const v4u*)(XR + (size_t)(b * SEQ + s) * 512 + ck * 8); }
#pragma unroll
        for (int r = 0; r < 9; ++r) { const int id = tid + 512 * r; if (id < 67 * 64) *(LAS v4u*)(rawx + id * 8) = pr[r]; }
    }
    GL_BAR();
    {
        const int chg = tid & 63, tseg = tid >> 6, ch0 = chg * 8;
        float w[4][8], cb[8];
#pragma unroll
        for (int j = 0; j < 4; ++j) { const f32x4 a = *(const f32x4*)(P.lru_conv_w + j * 512 + ch0), c = *(const f32x4*)(P.lru_conv_w + j * 512 + ch0 + 4);
            w[j][0] = a.x; w[j][1] = a.y; w[j][2] = a.z; w[j][3] = a.w; w[j][4] = c.x; w[j][5] = c.y; w[j][6] = c.z; w[j][7] = c.w; }
        { const f32x4 a = *(const f32x4*)(P.lru_conv_b + ch0), c = *(const f32x4*)(P.lru_conv_b + ch0 + 4);
          cb[0] = a.x; cb[1] = a.y; cb[2] = a.z; cb[3] = a.w; cb[4] = c.x; cb[5] = c.y; cb[6] = c.z; cb[7] = c.w; }
        v4u xr[11];
#pragma unroll
        for (int r = 0; r < 11; ++r) xr[r] = *(const LAS v4u*)(rawx + (tseg * 8 + r) * 512 + ch0);
#pragma unroll
        for (int tk = 0; tk < 8; ++tk) {
            float y[8];
#pragma unroll
            for (int e = 0; e < 8; ++e) y[e] = cb[e];
#pragma unroll
            for (int j = 0; j < 4; ++j) { const v4u x = xr[tk + j];
                y[0] += w[j][0] * bflo(x.x); y[1] += w[j][1] * bfhi(x.x); y[2] += w[j][2] * bflo(x.y); y[3] += w[j][3] * bfhi(x.y);
                y[4] += w[j][4] * bflo(x.z); y[5] += w[j][5] * bfhi(x.z); y[6] += w[j][6] * bflo(x.w); y[7] += w[j][7] * bfhi(x.w); }
            v4u o; o.x = pk2(y[0], y[1]); o.y = pk2(y[2], y[3]); o.z = pk2(y[4], y[5]); o.w = pk2(y[6], y[7]);
            *(LAS v4u*)(xcb + (tseg * 8 + tk) * 520 + ch0) = o;
        }
    }
    GL_BAR();
    {
        const int g = wave, col = lane & 15, g4 = lane >> 4;
        LAS bf16* AM = (LAS bf16*)(lds + wave * 8192); LAS bf16* BT = AM + 2048;
        const bf16* WT = (const bf16*)(ws + WS_LRUWT) + (size_t)g * 8192;
        bf16x8 Bw[2][4][2];
#pragma unroll
        for (int m = 0; m < 2; ++m)
#pragma unroll
            for (int jt = 0; jt < 4; ++jt)
#pragma unroll
                for (int s2 = 0; s2 < 2; ++s2) Bw[m][jt][s2] = *(const bf16x8*)(WT + m * 4096 + (16 * jt + col) * 64 + 32 * s2 + 8 * g4);
        float cba[4], cbx[4], csp[4];
#pragma unroll
        for (int jt = 0; jt < 4; ++jt) { const int ch = g * 64 + 16 * jt + col; cba[jt] = P.lru_ba[ch]; cbx[jt] = P.lru_bx[ch]; csp[jt] = softplusf_(-P.lru_lambda[ch]); }
        bf16* HLOC = (bf16*)(ws + WS_HLOC); bf16* PCUM = (bf16*)(ws + WS_PCUM);
        const int chs = g * 64 + lane;
        float hst = 0.f, pc = 1.f;
#pragma unroll 1
        for (int half = 0; half < 2; ++half) {
            bf16x8 Af[2][2];
#pragma unroll
            for (int rho = 0; rho < 2; ++rho)
#pragma unroll
                for (int s2 = 0; s2 < 2; ++s2) Af[rho][s2] = *(const LAS bf16x8*)(xcb + (32 * half + 16 * rho + col) * 520 + g * 64 + 32 * s2 + 8 * g4);
#pragma unroll
            for (int jt = 0; jt < 4; ++jt) {
#pragma unroll
                for (int rho = 0; rho < 2; ++rho) {
                    f32x4 ra = (f32x4){0.f, 0.f, 0.f, 0.f}, rx = ra;
#pragma unroll
                    for (int s2 = 0; s2 < 2; ++s2) { ra = __builtin_amdgcn_mfma_f32_16x16x32_bf16(Af[rho][s2], Bw[0][jt][s2], ra, 0, 0, 0); rx = __builtin_amdgcn_mfma_f32_16x16x32_bf16(Af[rho][s2], Bw[1][jt][s2], rx, 0, 0, 0); }
#pragma unroll
                    for (int i = 0; i < 4; ++i) {
                        const int tokl = 16 * rho + 4 * g4 + i, chl = 16 * jt + col;
                        const float r = sigmoidf_(ra[i] + cba[jt]), ig = sigmoidf_(rx[i] + cbx[jt]);
                        const float log_a = -8.0f * r * csp[jt];
                        const float am = -expm1_small(log_a), a = 1.0f - am;
                        const float xo = bf1(xcb[(32 * half + tokl) * 520 + g * 64 + chl]);
                        const float bt = __builtin_amdgcn_sqrtf(fmaxf(am * (1.0f + a), 0.f)) * (ig * xo);
                        AM[tokl * 64 + chl] = (bf16)f2bf(am); BT[tokl * 64 + chl] = (bf16)f2bf(bt);
                    }
                }
            }
            LDS_WAIT(); asm volatile("" ::: "memory");
#pragma unroll 8
            for (int tk = 0; tk < 32; ++tk) {
                const float am = bf1(AM[tk * 64 + lane]), bt = bf1(BT[tk * 64 + lane]);
                hst = (hst - am * hst) + bt; pc = pc - am * pc;
                const size_t o = (size_t)(t0 + 32 * half + tk) * 512 + chs;
                HLOC[o] = (bf16)f2bf(hst); PCUM[o] = (bf16)f2bf(pc);
            }
            LDS_WAIT(); asm volatile("" ::: "memory");
        }
        ((float*)(ws + WS_HEND))[(size_t)lt * 512 + chs] = hst; ((float*)(ws + WS_PEND))[(size_t)lt * 512 + chs] = pc;
    }
    GL_BAR();
}

constexpr int SC_WN = 0, SC_QD = 64 * 272, SC_KD = 2 * 64 * 272, SC_ATT = 2 * 64 * 272 + 128 * 144, SC_BUF = 2 * 64 * 272 + 128 * 144 + 64 * 144;
constexpr int SC_SSQ = 2 * SC_BUF;
__device__ __forceinline__ int sc_lds_off(int id) {
    if (id < 1024) return SC_WN + (id >> 4) * 272 + (id & 15) * 16;
    if (id < 2048) { const int q = id - 1024; return SC_QD + (q >> 4) * 272 + (q & 15) * 16; }
    if (id < 3072) { const int q = id - 2048; return SC_KD + (q >> 3) * 144 + (q & 7) * 16; }
    const int q = id - 3072; return SC_ATT + (q >> 3) * 144 + (q & 7) * 16;
}
__device__ __forceinline__ const v4u* sc_src(const unsigned char* ws, int item, int id) {
    if (id < 1024) return (const v4u*)(ws + WS_WN + (size_t)item * 16384) + id;
    if (id < 2048) return (const v4u*)(ws + WS_QD + (size_t)item * 16384) + (id - 1024);
    if (id < 3072) return (const v4u*)(ws + WS_KD + (size_t)item * 16384) + (id - 2048);
    return (const v4u*)(ws + WS_ATT + (size_t)item * 8192) + (id - 3072);
}
__device__ __forceinline__ bf16x8 pack_b(const f32x4 a, const f32x4 b) {
    v4u r; r.x = pk2(a.x, a.y); r.y = pk2(a.z, a.w); r.z = pk2(b.x, b.y); r.w = pk2(b.z, b.w);
    return __builtin_bit_cast(bf16x8, r);
}
#define SC_BAR() do { asm volatile("s_waitcnt lgkmcnt(0)" ::: "memory"); __builtin_amdgcn_s_barrier(); asm volatile("" ::: "memory"); } while (0)
#define SC_GLD(dst, ptr) asm volatile("global_load_dwordx4 %0, %1, off" : "=v"(dst) : "v"(ptr) : "memory")
#define PIN8(a) asm volatile("" : "+v"(a[0]), "+v"(a[1]), "+v"(a[2]), "+v"(a[3]), "+v"(a[4]), "+v"(a[5]), "+v"(a[6]), "+v"(a[7]))
#define PIN16(a) asm volatile("" : "+v"(a[0]), "+v"(a[1]), "+v"(a[2]), "+v"(a[3]), "+v"(a[4]), "+v"(a[5]), "+v"(a[6]), "+v"(a[7]), "+v"(a[8]), "+v"(a[9]), "+v"(a[10]), "+v"(a[11]), "+v"(a[12]), "+v"(a[13]), "+v"(a[14]), "+v"(a[15]))
constexpr int SCAN_NWC = 2, SCAN_PARTS = 4, SCAN_WGS = 8 * SCAN_PARTS;
constexpr int SC_UFS = 2 * SC_BUF;
constexpr int SC_DECS = SC_UFS + 2 * SCAN_NWC * 2048;
constexpr int SC_OT = SC_DECS + 512;
constexpr int SC_RDY = SC_OT + 2 * 64 * 36 * 4;
constexpr int SC_END = SC_RDY + 64;
static_assert(SC_END <= MISC_OFF, "scan LDS");
#ifndef SCAN_REPS
#define SCAN_REPS 1
#endif
#ifndef SCAN_EXP
#define SCAN_EXP 0
#endif
__device__ __forceinline__ int sc3_lds_off(int id) {
    if (id < 3584) return sc_lds_off(id);
    return SC_UFS + (id - 3584) * 16;
}
__device__ __forceinline__ const v4u* sc3_src(const unsigned char* ws, int item, int id, int part) {
    if (id < 3584) return sc_src(ws, item, id);
    return (const v4u*)(ws + WS_UF + (size_t)item * 16384 + (size_t)(part * SCAN_NWC) * 2048) + (id - 3584);
}
__device__ __forceinline__ void gdn_scan(const Params& P, LAS unsigned char* lds, int sb, int tid, int lane, int wave) {
    const unsigned char* ws = P.ws;
    constexpr int NCH = 128 * SCAN_REPS, NPC = 15;
    const int bh = sb & 7, part = sb >> 3;
    const int b = bh >> 2, h = bh & 3, col = lane & 15, g = lane >> 4;
    const int item0 = bh * 128;
    if (tid == 0) *(volatile LAS unsigned*)(lds + SC_RDY) = 0u;
    SC_BAR();
    if (wave >= 4) {
        constexpr int NP = 15, DEP = 3;
        const int lt = tid - 256;
        const unsigned voff = (unsigned)lt * 16u;
        const int lA = (lt >> 4) * 272 + (lt & 15) * 16, lB = (lt >> 3) * 144 + (lt & 7) * 16, lU = SC_UFS + lt * 16;
        v4u rs[DEP][NP];
#define SC_ISSUE(set, itm) do { const unsigned char* gq_ = ws + (size_t)(itm) * 16384; const unsigned char* ga_ = ws + WS_ATT + (size_t)(itm) * 8192; \
            asm volatile("s_nop 4\n\tglobal_load_dwordx4 %0, %8, %9 sc0 sc1\n\tglobal_load_dwordx4 %1, %8, %10 sc0 sc1\n\tglobal_load_dwordx4 %2, %8, %11 sc0 sc1\n\tglobal_load_dwordx4 %3, %8, %12 sc0 sc1\n\t" \
                         "global_load_dwordx4 %4, %8, %13 sc0 sc1\n\tglobal_load_dwordx4 %5, %8, %14 sc0 sc1\n\tglobal_load_dwordx4 %6, %8, %15 sc0 sc1\n\tglobal_load_dwordx4 %7, %8, %16 sc0 sc1" \
                : "=&v"(rs[set][0]), "=&v"(rs[set][1]), "=&v"(rs[set][2]), "=&v"(rs[set][3]), "=&v"(rs[set][4]), "=&v"(rs[set][5]), "=&v"(rs[set][6]), "=&v"(rs[set][7]) \
                : "v"(voff), "s"(gq_ + WS_WN), "s"(gq_ + WS_WN + 4096), "s"(gq_ + WS_WN + 8192), "s"(gq_ + WS_WN + 12288), \
                  "s"(gq_ + WS_QD), "s"(gq_ + WS_QD + 4096), "s"(gq_ + WS_QD + 8192), "s"(gq_ + WS_QD + 12288) : "memory"); \
            asm volatile("s_nop 4\n\tglobal_load_dwordx4 %0, %7, %8 sc0 sc1\n\tglobal_load_dwordx4 %1, %7, %9 sc0 sc1\n\tglobal_load_dwordx4 %2, %7, %10 sc0 sc1\n\tglobal_load_dwordx4 %3, %7, %11 sc0 sc1\n\t" \
                         "global_load_dwordx4 %4, %7, %12 sc0 sc1\n\tglobal_load_dwordx4 %5, %7, %13 sc0 sc1\n\tglobal_load_dwordx4 %6, %7, %14 sc0 sc1" \
                : "=&v"(rs[set][8]), "=&v"(rs[set][9]), "=&v"(rs[set][10]), "=&v"(rs[set][11]), "=&v"(rs[set][12]), "=&v"(rs[set][13]), "=&v"(rs[set][14]) \
                : "v"(voff), "s"(gq_ + WS_KD), "s"(gq_ + WS_KD + 4096), "s"(gq_ + WS_KD + 8192), "s"(gq_ + WS_KD + 12288), \
                  "s"(ga_), "s"(ga_ + 4096), "s"(gq_ + WS_UF + (size_t)(part * SCAN_NWC) * 2048) : "memory"); } while (0)
#define SC_WAITSET(set, cnt) asm volatile("s_waitcnt " cnt : "+v"(rs[set][0]), "+v"(rs[set][1]), "+v"(rs[set][2]), "+v"(rs[set][3]), "+v"(rs[set][4]), "+v"(rs[set][5]), "+v"(rs[set][6]), "+v"(rs[set][7]), \
            "+v"(rs[set][8]), "+v"(rs[set][9]), "+v"(rs[set][10]), "+v"(rs[set][11]), "+v"(rs[set][12]), "+v"(rs[set][13]), "+v"(rs[set][14]) :: "memory")
#define SC_WRITE(set, par) do { LAS unsigned char* wb_ = lds + (par) * SC_BUF; \
            _Pragma("unroll") for (int r = 0; r < 4; ++r) { *(LAS v4u*)(wb_ + SC_WN + lA + r * (16 * 272)) = rs[set][r]; *(LAS v4u*)(wb_ + SC_QD + lA + r * (16 * 272)) = rs[set][4 + r]; \
                                                          *(LAS v4u*)(wb_ + SC_KD + lB + r * (32 * 144)) = rs[set][8 + r]; } \
            *(LAS v4u*)(wb_ + SC_ATT + lB) = rs[set][12]; *(LAS v4u*)(wb_ + SC_ATT + lB + 32 * 144) = rs[set][13]; \
            *(LAS v4u*)(lds + lU + (par) * (SCAN_NWC * 2048)) = rs[set][14]; } while (0)
#define SC_NEED(c) do { unsigned sp_ = 0; while (*(volatile LAS unsigned*)(lds + SC_RDY) <= (unsigned)(c) && ++sp_ < (1u << 24)) __builtin_amdgcn_s_sleep(2); } while (0)
        SC_NEED(0); SC_ISSUE(0, item0);
        SC_WAITSET(0, "vmcnt(0)"); SC_WRITE(0, 0); SC_WAITSET(0, "lgkmcnt(0)");
        SC_NEED(3); SC_ISSUE(1, item0 + 1); SC_ISSUE(2, item0 + 2); SC_ISSUE(0, item0 + 3);
        SC_BAR();
        int n2 = 0;
#define SC_INTERVAL(set) do { SC_WAITSET(set, "vmcnt(30)"); SC_WRITE(set, (n2 + 1) & 1); SC_WAITSET(set, "lgkmcnt(0)"); if (n2 + 1 + DEP < 128) SC_NEED(n2 + 1 + DEP); SC_ISSUE(set, item0 + ((n2 + 1 + DEP) & 127)); SC_BAR(); ++n2; } while (0)
#pragma unroll 1
        for (int it = 0; it < NCH / 3; ++it) { SC_INTERVAL(1); SC_INTERVAL(2); SC_INTERVAL(0); }
        if (NCH % 3 >= 1) SC_INTERVAL(1);
        if (NCH % 3 >= 2) SC_INTERVAL(2);
        SC_WAITSET(0, "vmcnt(0)"); SC_WAITSET(1, "vmcnt(0)"); SC_WAITSET(2, "vmcnt(0)");
#undef SC_INTERVAL
#undef SC_NEED
#undef SC_WRITE
#undef SC_WAITSET
#undef SC_ISSUE
        return;
    }
    if (wave == 3) {
        const unsigned* flags = (const unsigned*)(ws + WS_CTL) + CW_GFLAG + item0;
        unsigned rdy = 0;
#define SC_POLLSTEP() do { if (rdy < 128u) { const unsigned idx_ = rdy + (unsigned)lane; \
            const unsigned fv_ = (idx_ < 128u) ? __hip_atomic_load(flags + idx_, __ATOMIC_RELAXED, __HIP_MEMORY_SCOPE_AGENT) : 0u; \
            const unsigned long long m_ = __ballot(fv_ != 0u); const unsigned nrun_ = (m_ == ~0ull) ? 64u : (unsigned)__builtin_ctzll(~m_);     \
            if ((unsigned)lane < nrun_) ((LAS float*)(lds + SC_DECS))[idx_] = __builtin_bit_cast(float, fv_); \
            rdy += nrun_; LDS_WAIT(); if (lane == 0) *(volatile LAS unsigned*)(lds + SC_RDY) = rdy; } } while (0)
        { unsigned sp = 0; while (rdy < 4u && ++sp < (1u << 22)) { SC_POLLSTEP(); if (rdy < 4u) __builtin_amdgcn_s_sleep(16); } }
        SC_BAR();
#pragma unroll 1
        for (int n2 = 0; n2 < NCH; ++n2) {
            { const unsigned need = (unsigned)(n2 + 1 + 3) < 128u ? (unsigned)(n2 + 1 + 3) : 127u; unsigned sp = 0;
              while (rdy <= need && rdy < 128u && ++sp < (1u << 22)) { SC_POLLSTEP(); if (rdy <= need) __builtin_amdgcn_s_sleep(8); } }
            if (rdy < 128u && rdy < (unsigned)(n2 & 127) + 16u) SC_POLLSTEP();
            SC_BAR();
        }
#undef SC_POLLSTEP
        return;
    }
    if (wave == 2) {
        const int row = lane;
        bf16* Y = (bf16*)((unsigned char*)P.out + OUT_Y);
        float* SSQG = P.out;
        SC_BAR();
#pragma unroll 1
        for (int n2 = 0; n2 <= NCH; ++n2) {
            if (n2 > 0) {
                const int n = (n2 - 1) & 127, t = b * SEQ + n * 64 + row;
                const LAS float* src = (const LAS float*)(lds + SC_OT + ((n2 - 1) & 1) * (64 * 36 * 4)) + row * 36;
                f32x4 a[8]; float s2 = 0.f;
#pragma unroll
                for (int q = 0; q < 8; ++q) { a[q] = *(const LAS f32x4*)(src + 4 * q); s2 += (a[q].x * a[q].x + a[q].y * a[q].y) + (a[q].z * a[q].z + a[q].w * a[q].w); }
                SSQG[(size_t)t * 32 + h * 8 + part] = s2;
                v4u* d = (v4u*)(Y + (size_t)t * 1024 + h * 128 + 32 * part);
#pragma unroll
                for (int q = 0; q < 4; ++q) { v4u o; o.x = pk2(a[2 * q].x, a[2 * q].y); o.y = pk2(a[2 * q].z, a[2 * q].w); o.z = pk2(a[2 * q + 1].x, a[2 * q + 1].y); o.w = pk2(a[2 * q + 1].z, a[2 * q + 1].w); d[q] = o; }
            }
            if (n2 < NCH) SC_BAR();
        }
        return;
    }
    f32x4 S[8];
#pragma unroll
    for (int i = 0; i < 8; ++i) S[i] = (f32x4){0.f, 0.f, 0.f, 0.f};
    SC_BAR();
#pragma unroll 1
    for (int n2 = 0; n2 < NCH; ++n2) {
        if (SCAN_REPS > 1 && (n2 & 127) == 0) {
#pragma unroll
            for (int i = 0; i < 8; ++i) S[i] = (f32x4){0.f, 0.f, 0.f, 0.f};
        }
        if (SCAN_EXP == 2 && n2 < 128) { SC_BAR(); continue; }
        const int par = n2 & 1;
        LAS unsigned char* buf = lds + par * SC_BUF;
        bf16x8 fA[16], fB[16], fC[16], fD[8];
#pragma unroll
        for (int rho = 0; rho < 4; ++rho)
#pragma unroll
            for (int s = 0; s < 4; ++s) fA[rho * 4 + s] = *(const LAS bf16x8*)(buf + SC_WN + (16 * rho + col) * 272 + (32 * s + 8 * g) * 2);
#pragma unroll
        for (int rho = 0; rho < 4; ++rho)
#pragma unroll
            for (int s = 0; s < 4; ++s) fB[rho * 4 + s] = *(const LAS bf16x8*)(buf + SC_QD + (16 * rho + col) * 272 + (32 * s + 8 * g) * 2);
        const LAS v4u* ufp = (const LAS v4u*)(lds + SC_UFS + par * (SCAN_NWC * 2048) + wave * 2048 + lane * 32);
        const v4u uf0 = ufp[0], uf1 = ufp[1];
        const float dec = ((const LAS float*)(lds + SC_DECS))[n2 & 127];
        bf16x8 Bs[4];
#pragma unroll
        for (int s = 0; s < 4; ++s) Bs[s] = pack_b(S[2 * s], S[2 * s + 1]);
        f32x4 Vn[4], Oc[4];
        Vn[0] = (f32x4){bflo(uf0.x), bfhi(uf0.x), bflo(uf0.y), bfhi(uf0.y)}; Vn[1] = (f32x4){bflo(uf0.z), bfhi(uf0.z), bflo(uf0.w), bfhi(uf0.w)};
        Vn[2] = (f32x4){bflo(uf1.x), bfhi(uf1.x), bflo(uf1.y), bfhi(uf1.y)}; Vn[3] = (f32x4){bflo(uf1.z), bfhi(uf1.z), bflo(uf1.w), bfhi(uf1.w)};
        __builtin_amdgcn_sched_barrier(0);
        PIN16(fA);
#pragma unroll
        for (int s = 0; s < 4; ++s)
#pragma unroll
            for (int rho = 0; rho < 4; ++rho) Vn[rho] = __builtin_amdgcn_mfma_f32_16x16x32_bf16(fA[rho * 4 + s], Bs[s], Vn[rho], 0, 0, 0);
        __builtin_amdgcn_sched_barrier(0);
#pragma unroll
        for (int tau = 0; tau < 8; ++tau)
#pragma unroll
            for (int s = 0; s < 2; ++s) fC[tau * 2 + s] = *(const LAS bf16x8*)(buf + SC_KD + (16 * tau + col) * 144 + (32 * s + 8 * g) * 2);
        __builtin_amdgcn_sched_barrier(0);
        PIN16(fB);
#pragma unroll
        for (int rho = 0; rho < 4; ++rho) Oc[rho] = (f32x4){0.f, 0.f, 0.f, 0.f};
#pragma unroll
        for (int s = 0; s < 4; ++s)
#pragma unroll
            for (int rho = 0; rho < 4; ++rho) Oc[rho] = __builtin_amdgcn_mfma_f32_16x16x32_bf16(fB[rho * 4 + s], Bs[s], Oc[rho], 0, 0, 0);
        __builtin_amdgcn_sched_barrier(0);
#pragma unroll
        for (int rho = 0; rho < 4; ++rho)
#pragma unroll
            for (int s = 0; s < 2; ++s) fD[rho * 2 + s] = *(const LAS bf16x8*)(buf + SC_ATT + (16 * rho + col) * 144 + (32 * s + 8 * g) * 2);
        bf16x8 Bv[2];
        Bv[0] = pack_b(Vn[0], Vn[1]); Bv[1] = pack_b(Vn[2], Vn[3]);
#pragma unroll
        for (int tau = 0; tau < 8; ++tau) S[tau] = S[tau] * dec;
        __builtin_amdgcn_sched_barrier(0);
        PIN16(fC);
#pragma unroll
        for (int s = 0; s < 2; ++s)
#pragma unroll
            for (int tau = 0; tau < 8; ++tau) S[tau] = __builtin_amdgcn_mfma_f32_16x16x32_bf16(fC[tau * 2 + s], Bv[s], S[tau], 0, 0, 0);
        __builtin_amdgcn_sched_barrier(0);
        PIN8(fD);
#pragma unroll
        for (int s = 0; s < 2; ++s)
#pragma unroll
            for (int rho = 0; rho < 4; ++rho) Oc[rho] = __builtin_amdgcn_mfma_f32_16x16x32_bf16(fD[rho * 2 + s], Bv[s], Oc[rho], 0, 0, 0);
        LAS float* ot = (LAS float*)(lds + SC_OT + par * (64 * 36 * 4)) + 16 * wave + col;
#pragma unroll
        for (int rho = 0; rho < 4; ++rho)
#pragma unroll
            for (int i = 0; i < 4; ++i) ot[(16 * rho + 4 * g + i) * 36] = Oc[rho][i];
        SC_BAR();
    }
}

__device__ __forceinline__ void lru_carry(const Params& P, int gwv, int lane) {
    unsigned char* ws = P.ws;
    const int b = gwv >> 3, g = gwv & 7, ch = g * 64 + lane;
    const float* HEND = (const float*)(ws + WS_HEND); const float* PEND = (const float*)(ws + WS_PEND); float* HIN = (float*)(ws + WS_HIN);
    float hin = 0.f;
#pragma unroll 1
    for (int n0 = 0; n0 < 128; n0 += 16) {
        float he[16], pe[16];
#pragma unroll
        for (int i = 0; i < 16; ++i) { const size_t o = (size_t)(b * 128 + n0 + i) * 512 + ch; he[i] = HEND[o]; pe[i] = PEND[o]; }
#pragma unroll
        for (int i = 0; i < 16; ++i) { HIN[(size_t)(b * 128 + n0 + i) * 512 + ch] = hin; hin = he[i] + pe[i] * hin; }
    }
}

__device__ __forceinline__ void cvt_table(const float* src, bf16* dst, size_t n8, size_t wi, size_t nw) {
    for (size_t i = wi; i < n8; i += nw) {
        const f32x4 a = ((const f32x4*)src)[2 * i], c = ((const f32x4*)src)[2 * i + 1];
        v4u o; o.x = pk2(a.x, a.y); o.y = pk2(a.z, a.w); o.z = pk2(c.x, c.y); o.w = pk2(c.z, c.w);
        ((v4u*)dst)[i] = o;
    }
}

__device__ __forceinline__ void lru_combine(const Params& P, size_t wi, size_t nw) {
    unsigned char* ws = P.ws;
    const v4u* HLOC = (const v4u*)(ws + WS_HLOC); const v4u* PCUM = (const v4u*)(ws + WS_PCUM); const v4u* GATE = (const v4u*)(ws + WS_GATE);
    const float* HIN = (const float*)(ws + WS_HIN); bf16* Y = (bf16*)((unsigned char*)P.out + OUT_Y);
    for (size_t i = wi; i < (size_t)T * 64; i += nw) {
        const size_t t = i >> 6; const int ch0 = (int)(i & 63) * 8;
        const v4u hl = HLOC[i], pc = PCUM[i], gt = GATE[i];
        const f32x4 h0 = *(const f32x4*)(HIN + (t >> 6) * 512 + ch0), h1 = *(const f32x4*)(HIN + (t >> 6) * 512 + ch0 + 4);
        float y[8];
        y[0] = (bflo(hl.x) + bflo(pc.x) * h0.x) * gelu_tanh(bflo(gt.x)); y[1] = (bfhi(hl.x) + bfhi(pc.x) * h0.y) * gelu_tanh(bfhi(gt.x));
        y[2] = (bflo(hl.y) + bflo(pc.y) * h0.z) * gelu_tanh(bflo(gt.y)); y[3] = (bfhi(hl.y) + bfhi(pc.y) * h0.w) * gelu_tanh(bfhi(gt.y));
        y[4] = (bflo(hl.z) + bflo(pc.z) * h1.x) * gelu_tanh(bflo(gt.z)); y[5] = (bfhi(hl.z) + bfhi(pc.z) * h1.y) * gelu_tanh(bfhi(gt.z));
        y[6] = (bflo(hl.w) + bflo(pc.w) * h1.z) * gelu_tanh(bflo(gt.w)); y[7] = (bfhi(hl.w) + bfhi(pc.w) * h1.w) * gelu_tanh(bfhi(gt.w));
        v4u o; o.x = pk2(y[0], y[1]); o.y = pk2(y[2], y[3]); o.z = pk2(y[4], y[5]); o.w = pk2(y[6], y[7]);
        *(v4u*)(Y + t * 1024 + 512 + ch0) = o;
    }
}

__device__ __forceinline__ void gdn_gate_norm(const Params& P, size_t wi, size_t nw) {
    unsigned char* ws = P.ws;
    bf16* Y = (bf16*)((unsigned char*)P.out + OUT_Y); const v4u* Z = (const v4u*)(ws + WS_Z); const float* SSQG = P.out;
    for (size_t i = wi; i < (size_t)T * 64; i += nw) {
        const size_t t = i >> 6; const int c0 = (int)(i & 63) * 8, h = c0 >> 7;
        const f32x4 q0 = *(const f32x4*)(SSQG + t * 32 + h * 8);
        const float rstd = rsqrtf(((q0.x + q0.y) + (q0.z + q0.w)) * (1.0f / 128.0f) + 1e-6f);
        const v4u o = *(const v4u*)(Y + t * 1024 + c0), z = Z[i];
        const f32x4 w0 = *(const f32x4*)(P.gdn_norm_w + (c0 & 127)), w1 = *(const f32x4*)(P.gdn_norm_w + (c0 & 127) + 4);
        float y[8];
        y[0] = bflo(o.x) * rstd * w0.x * siluf_(bflo(z.x)); y[1] = bfhi(o.x) * rstd * w0.y * siluf_(bfhi(z.x));
        y[2] = bflo(o.y) * rstd * w0.z * siluf_(bflo(z.y)); y[3] = bfhi(o.y) * rstd * w0.w * siluf_(bfhi(z.y));
        y[4] = bflo(o.z) * rstd * w1.x * siluf_(bflo(z.z)); y[5] = bfhi(o.z) * rstd * w1.y * siluf_(bfhi(z.z));
        y[6] = bflo(o.w) * rstd * w1.z * siluf_(bflo(z.w)); y[7] = bfhi(o.w) * rstd * w1.w * siluf_(bfhi(z.w));
        v4u r; r.x = pk2(y[0], y[1]); r.y = pk2(y[2], y[3]); r.z = pk2(y[4], y[5]); r.w = pk2(y[6], y[7]);
        *(v4u*)(Y + t * 1024 + c0) = r;
    }
}

__device__ __forceinline__ void xattn_stage(LAS unsigned char* lds, const bf16* src, int tid) {
    v4u tmp[16];
    const unsigned voff = (unsigned)tid * 16u;
#pragma unroll
    for (int r = 0; r < 16; ++r) { const unsigned char* sb = (const unsigned char*)src + r * 8192;
        asm volatile("s_nop 4\n\tglobal_load_dwordx4 %0, %1, %2" : "=&v"(tmp[r]) : "v"(voff), "s"(sb) : "memory"); }
    asm volatile("s_waitcnt vmcnt(0)" : "+v"(tmp[0]), "+v"(tmp[1]), "+v"(tmp[2]), "+v"(tmp[3]), "+v"(tmp[4]), "+v"(tmp[5]), "+v"(tmp[6]), "+v"(tmp[7]),
                                        "+v"(tmp[8]), "+v"(tmp[9]), "+v"(tmp[10]), "+v"(tmp[11]), "+v"(tmp[12]), "+v"(tmp[13]), "+v"(tmp[14]), "+v"(tmp[15]) :: "memory");
#pragma unroll
    for (int r = 0; r < 16; ++r) { const int id = tid + 512 * r; *(LAS v4u*)(lds + (id >> 5) * 528 + (id & 31) * 16) = tmp[r]; }
}
__device__ __forceinline__ void xattn_unit(const Params& P, LAS unsigned char* lds, int unit, int tid, int lane, int wave) {
    const unsigned char* ws = P.ws;
    const int h = unit & 3, qb = (unit >> 2) & 63, b = unit >> 8, col = lane & 15, g = lane >> 4;
    const int tw = b * SEQ + qb * 128 + 16 * wave;
    const bf16* Kb = (const bf16*)(ws + WS_KB) + (size_t)((b * 4 + h) * 256) * 256;
    const bf16* Vt = (const bf16*)(ws + WS_VTP) + (size_t)((b * 4 + h) * 256) * 256;
    xattn_stage(lds, Kb, tid);
    __syncthreads();
    const LAS unsigned char* arow = lds + col * 528 + g * 16;
    bf16x8 Bp[1][8]; float inv[1];
#pragma unroll
    for (int ps = 0; ps < 1; ++ps) {
        const bf16* Q = (const bf16*)(ws + WS_Q) + (size_t)(tw + 16 * ps + col) * 1024 + h * 256 + 8 * g;
        bf16x8 Bq[8];
#pragma unroll
        for (int s = 0; s < 8; ++s) Bq[s] = *(const bf16x8*)(Q + 32 * s);
        f32x4 St[16];
        bf16x8 fr[2][8];
#pragma unroll
        for (int s = 0; s < 8; ++s) fr[0][s] = *(const LAS bf16x8*)(arow + 64 * s);
#pragma unroll
        for (int kap = 0; kap < 16; ++kap) {
            if (kap + 1 < 16) {
#pragma unroll
                for (int s = 0; s < 8; ++s) fr[(kap + 1) & 1][s] = *(const LAS bf16x8*)(arow + (16 * (kap + 1)) * 528 + 64 * s);
            }
            __builtin_amdgcn_sched_barrier(0);
            PIN8(fr[kap & 1]);
            f32x4 acc = (f32x4){0.f, 0.f, 0.f, 0.f};
#pragma unroll
            for (int s = 0; s < 8; ++s) acc = __builtin_amdgcn_mfma_f32_16x16x32_bf16(fr[kap & 1][s], Bq[s], acc, 0, 0, 0);
            St[kap] = acc;
            __builtin_amdgcn_sched_barrier(0);
        }
        float mx = -3.0e38f;
#pragma unroll
        for (int kap = 0; kap < 16; ++kap) mx = fmaxf(fmaxf(fmaxf(St[kap].x, St[kap].y), fmaxf(St[kap].z, St[kap].w)), mx);
        mx = fmaxf(mx, __shfl_xor(mx, 16)); mx = fmaxf(mx, __shfl_xor(mx, 32));
        float l = 0.f;
#pragma unroll
        for (int kap = 0; kap < 16; ++kap) { St[kap].x = __expf(St[kap].x - mx); St[kap].y = __expf(St[kap].y - mx); St[kap].z = __expf(St[kap].z - mx); St[kap].w = __expf(St[kap].w - mx);
            l += (St[kap].x + St[kap].y) + (St[kap].z + St[kap].w); }
        l += __shfl_xor(l, 16); l += __shfl_xor(l, 32);
        inv[ps] = 1.0f / l;
#pragma unroll
        for (int s = 0; s < 8; ++s) Bp[ps][s] = pack_b(St[2 * s], St[2 * s + 1]);
    }
    __syncthreads();
    xattn_stage(lds, Vt, tid);
    __syncthreads();
#pragma unroll
    for (int ps = 0; ps < 1; ++ps) {
        bf16* AO = (bf16*)(P.ws + WS_AO) + (size_t)(tw + 16 * ps + col) * 1024 + h * 256 + 4 * g;
        bf16x8 fr[2][8];
#pragma unroll
        for (int s = 0; s < 8; ++s) fr[0][s] = *(const LAS bf16x8*)(arow + 64 * s);
#pragma unroll
        for (int del = 0; del < 16; ++del) {
            if (del + 1 < 16) {
#pragma unroll
                for (int s = 0; s < 8; ++s) fr[(del + 1) & 1][s] = *(const LAS bf16x8*)(arow + (16 * (del + 1)) * 528 + 64 * s);
            }
            __builtin_amdgcn_sched_barrier(0);
            PIN8(fr[del & 1]);
            f32x4 acc = (f32x4){0.f, 0.f, 0.f, 0.f};
#pragma unroll
            for (int s = 0; s < 8; ++s) acc = __builtin_amdgcn_mfma_f32_16x16x32_bf16(fr[del & 1][s], Bp[ps][s], acc, 0, 0, 0);
            v2u o; o.x = pk2(acc.x * inv[ps], acc.y * inv[ps]); o.y = pk2(acc.z * inv[ps], acc.w * inv[ps]);
            *(v2u*)(AO + 16 * del) = o;
            __builtin_amdgcn_sched_barrier(0);
        }
    }
    __syncthreads();
}

__device__ __forceinline__ unsigned key_enc(float f) { const unsigned u = __builtin_bit_cast(unsigned, f); return (u & 0x80000000u) ? ~u : (u | 0x80000000u); }
__device__ __forceinline__ float key_dec(unsigned k) { const unsigned u = (k & 0x80000000u) ? (k & 0x7fffffffu) : ~k; return __builtin_bit_cast(float, u); }
#define TK_CAS(a, b) do { const unsigned hi_ = max(a, b), lo_ = min(a, b); a = hi_; b = lo_; } while (0)
__device__ __forceinline__ void tk_merge16(unsigned (&a)[16]) {
#pragma unroll
    for (int j = 8; j > 0; j >>= 1)
#pragma unroll
        for (int i = 0; i < 16; ++i) { const int l = i ^ j; if (l > i) TK_CAS(a[i], a[l]); }
}
__device__ __forceinline__ void tk_sort16(unsigned (&a)[16]) {
#pragma unroll
    for (int k = 2; k <= 16; k <<= 1)
#pragma unroll
        for (int j = k >> 1; j > 0; j >>= 1)
#pragma unroll
            for (int i = 0; i < 16; ++i) { const int l = i ^ j; if (l > i) { if ((i & k) == 0) TK_CAS(a[i], a[l]); else TK_CAS(a[l], a[i]); } }
}
__device__ __forceinline__ void tk_top16_merge(unsigned (&L)[16], const unsigned (&G)[16]) {
#pragma unroll
    for (int i = 0; i < 16; ++i) L[i] = max(L[i], G[15 - i]);
    tk_merge16(L);
}
__device__ __forceinline__ void tk_pair_merge(unsigned (&L)[16]) {
    unsigned Pp[16];
#pragma unroll
    for (int i = 0; i < 16; ++i) Pp[i] = (unsigned)__builtin_amdgcn_update_dpp(0, (int)L[i], 0xB1, 0xF, 0xF, true);
    tk_top16_merge(L, Pp);
}
__device__ __forceinline__ void peer_topk_rows(const Params& P, LAS unsigned char* lds, int rowbase, int tid) {
    const unsigned char* ws = P.ws;
    typedef _Float16 f16x8 __attribute__((ext_vector_type(8)));
    const int rl = tid >> 1, hf = tid & 1, grow = rowbase + rl, t = grow >> 3, h = grow & 7;
    const _Float16* SC = (const _Float16*)(ws + WS_PQ) + (size_t)t * 2048 + h * 256 + 64 * hf;
    f16x8 raw[2][8];
#pragma unroll
    for (int p = 0; p < 2; ++p)
#pragma unroll
        for (int q = 0; q < 8; ++q) raw[p][q] = *(const f16x8*)(SC + p * 128 + 8 * q);
    unsigned L1[16], L2[16];
#pragma unroll
    for (int p = 0; p < 2; ++p) {
        unsigned L[16];
#pragma unroll
        for (int grp = 0; grp < 4; ++grp) {
            unsigned G[16];
#pragma unroll
            for (int e = 0; e < 16; ++e) G[e] = (key_enc((float)raw[p][2 * grp + (e >> 3)][e & 7]) & ~127u) | (unsigned)(127 - (64 * hf + 16 * grp + e));
            tk_sort16(G);
            if (grp == 0) {
#pragma unroll
                for (int i = 0; i < 16; ++i) L[i] = G[i];
            } else tk_top16_merge(L, G);
        }
        tk_pair_merge(L);
#pragma unroll
        for (int i = 0; i < 16; ++i) { if (p == 0) L1[i] = L[i]; else L2[i] = L[i]; }
    }
    {
        float v1[16], v2[16];
        LAS int* il = (LAS int*)lds + rl * 33;
#pragma unroll
        for (int q = 0; q < 16; ++q) { v1[q] = key_dec((L1[q] & ~127u) | 64u); v2[q] = key_dec((L2[q] & ~127u) | 64u); }
        if (hf == 0) {
#pragma unroll
            for (int q = 0; q < 16; ++q) { il[q] = 127 - (int)(L1[q] & 127u); il[16 + q] = 127 - (int)(L2[q] & 127u); }
        }
        unsigned C[16], D[16];
        float w1[8];
        const unsigned hf16 = (unsigned)hf * 16u, evenmask = (unsigned)hf - 1u;
#pragma unroll
        for (int k = 0; k < 8; ++k) w1[k] = __builtin_bit_cast(float, (__builtin_bit_cast(unsigned, v1[2 * k]) & evenmask) | (__builtin_bit_cast(unsigned, v1[2 * k + 1]) & ~evenmask));
#define TK_SLOT(dst, k, bq, valid_odd) do { const unsigned pos_ = (unsigned)(16 * (2 * (k)) + (bq)) + hf16; unsigned kv_ = (key_enc(w1[k] + v2[bq]) & ~255u) | (255u - pos_); if (!(valid_odd)) kv_ &= evenmask; dst = kv_; } while (0)
        TK_SLOT(C[0], 0, 0, true);
        TK_SLOT(C[1], 0, 1, true);
        TK_SLOT(C[2], 0, 2, true);
        TK_SLOT(C[3], 0, 3, true);
        TK_SLOT(C[4], 0, 4, true);
        TK_SLOT(C[5], 0, 5, true);
        TK_SLOT(C[6], 0, 6, true);
        TK_SLOT(C[7], 0, 7, true);
        TK_SLOT(C[8], 0, 8, false);
        TK_SLOT(C[9], 0, 9, false);
        TK_SLOT(C[10], 0, 10, false);
        TK_SLOT(C[11], 0, 11, false);
        TK_SLOT(C[12], 0, 12, false);
        TK_SLOT(C[13], 0, 13, false);
        TK_SLOT(C[14], 0, 14, false);
        TK_SLOT(C[15], 0, 15, false);
        TK_SLOT(D[0], 1, 0, true);
        TK_SLOT(D[1], 1, 1, true);
        TK_SLOT(D[2], 1, 2, true);
        TK_SLOT(D[3], 1, 3, true);
        TK_SLOT(D[4], 1, 4, false);
        TK_SLOT(D[5], 2, 0, true);
        TK_SLOT(D[6], 2, 1, true);
        TK_SLOT(D[7], 2, 2, false);
        TK_SLOT(D[8], 3, 0, true);
        TK_SLOT(D[9], 3, 1, true);
        TK_SLOT(D[10], 4, 0, true);
        TK_SLOT(D[11], 5, 0, true);
        TK_SLOT(D[12], 6, 0, true);
        TK_SLOT(D[13], 7, 0, true);
        D[14] = 0u; D[15] = 0u;
#undef TK_SLOT
        tk_sort16(C); tk_sort16(D); tk_top16_merge(C, D); tk_pair_merge(C);
        LDS_WAIT(); asm volatile("" ::: "memory");
        float best[16], e[16], sum = 0.f;
#pragma unroll
        for (int q = 0; q < 16; ++q) { best[q] = key_dec((C[q] & ~255u) | 128u); e[q] = __expf(best[q] - best[0]); sum += e[q]; }
        const float inv = __builtin_amdgcn_rcpf(sum);
        int* IDX = (int*)(P.ws + WS_IDX) + (size_t)grow * 16 + 8 * hf; float* GW = (float*)(P.ws + WS_GW) + (size_t)grow * 16 + 8 * hf;
#pragma unroll
        for (int q = 0; q < 8; ++q) {
            const unsigned c = (C[q] & evenmask) | (C[8 + q] & ~evenmask);
            const float ev = __builtin_bit_cast(float, (__builtin_bit_cast(unsigned, e[q]) & evenmask) | (__builtin_bit_cast(unsigned, e[8 + q]) & ~evenmask));
            const unsigned pos = 255u - (c & 255u);
            IDX[q] = il[pos >> 4] * 128 + il[16 + (pos & 15u)]; GW[q] = ev * inv;
        }
    }
    LDS_WAIT(); asm volatile("" ::: "memory");
}

__device__ __forceinline__ void peer_topk_wave(const Params& P, LAS int* ilw, LAS unsigned* oute, LAS float* outg, int tbase, int lane) {
    const unsigned char* ws = P.ws;
    typedef _Float16 f16x8 __attribute__((ext_vector_type(8)));
    const int rl = lane >> 1, hf = lane & 1, t = tbase + (rl >> 3), h = rl & 7;
    const _Float16* SC = (const _Float16*)(ws + WS_PQ) + (size_t)t * 2048 + h * 256 + 64 * hf;
    f16x8 raw[2][8];
#pragma unroll
    for (int p = 0; p < 2; ++p)
#pragma unroll
        for (int q = 0; q < 8; ++q) raw[p][q] = *(const f16x8*)(SC + p * 128 + 8 * q);
    unsigned L1[16], L2[16];
#pragma unroll
    for (int p = 0; p < 2; ++p) {
        unsigned L[16];
#pragma unroll
        for (int grp = 0; grp < 4; ++grp) {
            unsigned G[16];
#pragma unroll
            for (int e = 0; e < 16; ++e) G[e] = (key_enc((float)raw[p][2 * grp + (e >> 3)][e & 7]) & ~127u) | (unsigned)(127 - (64 * hf + 16 * grp + e));
            tk_sort16(G);
            if (grp == 0) {
#pragma unroll
                for (int i = 0; i < 16; ++i) L[i] = G[i];
            } else tk_top16_merge(L, G);
        }
        tk_pair_merge(L);
#pragma unroll
        for (int i = 0; i < 16; ++i) { if (p == 0) L1[i] = L[i]; else L2[i] = L[i]; }
    }
    {
        float v1[16], v2[16];
        LAS int* il = ilw + rl * 33;
#pragma unroll
        for (int q = 0; q < 16; ++q) { v1[q] = key_dec((L1[q] & ~127u) | 64u); v2[q] = key_dec((L2[q] & ~127u) | 64u); }
        if (hf == 0) {
#pragma unroll
            for (int q = 0; q < 16; ++q) { il[q] = 127 - (int)(L1[q] & 127u); il[16 + q] = 127 - (int)(L2[q] & 127u); }
        }
        unsigned C[16], D[16];
        float w1[8];
        const unsigned hf16 = (unsigned)hf * 16u, evenmask = (unsigned)hf - 1u;
#pragma unroll
        for (int k = 0; k < 8; ++k) w1[k] = __builtin_bit_cast(float, (__builtin_bit_cast(unsigned, v1[2 * k]) & evenmask) | (__builtin_bit_cast(unsigned, v1[2 * k + 1]) & ~evenmask));
#define TK_SLOT(dst, k, bq, valid_odd) do { const unsigned pos_ = (unsigned)(16 * (2 * (k)) + (bq)) + hf16; unsigned kv_ = (key_enc(w1[k] + v2[bq]) & ~255u) | (255u - pos_); if (!(valid_odd)) kv_ &= evenmask; dst = kv_; } while (0)
        TK_SLOT(C[0], 0, 0, true);
        TK_SLOT(C[1], 0, 1, true);
        TK_SLOT(C[2], 0, 2, true);
        TK_SLOT(C[3], 0, 3, true);
        TK_SLOT(C[4], 0, 4, true);
        TK_SLOT(C[5], 0, 5, true);
        TK_SLOT(C[6], 0, 6, true);
        TK_SLOT(C[7], 0, 7, true);
        TK_SLOT(C[8], 0, 8, false);
        TK_SLOT(C[9], 0, 9, false);
        TK_SLOT(C[10], 0, 10, false);
        TK_SLOT(C[11], 0, 11, false);
        TK_SLOT(C[12], 0, 12, false);
        TK_SLOT(C[13], 0, 13, false);
        TK_SLOT(C[14], 0, 14, false);
        TK_SLOT(C[15], 0, 15, false);
        TK_SLOT(D[0], 1, 0, true);
        TK_SLOT(D[1], 1, 1, true);
        TK_SLOT(D[2], 1, 2, true);
        TK_SLOT(D[3], 1, 3, true);
        TK_SLOT(D[4], 1, 4, false);
        TK_SLOT(D[5], 2, 0, true);
        TK_SLOT(D[6], 2, 1, true);
        TK_SLOT(D[7], 2, 2, false);
        TK_SLOT(D[8], 3, 0, true);
        TK_SLOT(D[9], 3, 1, true);
        TK_SLOT(D[10], 4, 0, true);
        TK_SLOT(D[11], 5, 0, true);
        TK_SLOT(D[12], 6, 0, true);
        TK_SLOT(D[13], 7, 0, true);
        D[14] = 0u; D[15] = 0u;
#undef TK_SLOT
        tk_sort16(C); tk_sort16(D); tk_top16_merge(C, D); tk_pair_merge(C);
        LDS_WAIT(); asm volatile("" ::: "memory");
        float best[16], e[16], sum = 0.f;
#pragma unroll
        for (int q = 0; q < 16; ++q) { best[q] = key_dec((C[q] & ~255u) | 128u); e[q] = __expf(best[q] - best[0]); sum += e[q]; }
        const float inv = __builtin_amdgcn_rcpf(sum);
        LAS unsigned* IDX = oute + rl * 16 + 8 * hf; LAS float* GW = outg + rl * 16 + 8 * hf;
#pragma unroll
        for (int q = 0; q < 8; ++q) {
            const unsigned c = (C[q] & evenmask) | (C[8 + q] & ~evenmask);
            const float ev = __builtin_bit_cast(float, (__builtin_bit_cast(unsigned, e[q]) & evenmask) | (__builtin_bit_cast(unsigned, e[8 + q]) & ~evenmask));
            const unsigned pos = 255u - (c & 255u);
            IDX[q] = (unsigned)(il[pos >> 4] * 128 + il[16 + (pos & 15u)]); GW[q] = ev * inv;
        }
    }
    LDS_WAIT(); asm volatile("" ::: "memory");
}

typedef float f32x2 __attribute__((ext_vector_type(2)));
__device__ __forceinline__ unsigned q8(float x) { return (unsigned)(int)rintf(x) & 0xffu; }
__device__ __forceinline__ void cvt_table_fp8(const float* src, unsigned char* dst, float* scl, int gw, int ngw, int lane) {
    for (int row = gw; row < 16384; row += ngw) {
        const f32x4* sp = (const f32x4*)(src + (size_t)row * 1024 + 16 * lane);
        const f32x4 a0 = sp[0], a1 = sp[1], a2 = sp[2], a3 = sp[3];
        float m = fmaxf(fmaxf(fmaxf(fabsf(a0.x), fabsf(a0.y)), fmaxf(fabsf(a0.z), fabsf(a0.w))), fmaxf(fmaxf(fabsf(a1.x), fabsf(a1.y)), fmaxf(fabsf(a1.z), fabsf(a1.w))));
        m = fmaxf(m, fmaxf(fmaxf(fmaxf(fabsf(a2.x), fabsf(a2.y)), fmaxf(fabsf(a2.z), fabsf(a2.w))), fmaxf(fmaxf(fabsf(a3.x), fabsf(a3.y)), fmaxf(fabsf(a3.z), fabsf(a3.w)))));
#pragma unroll
        for (int o = 1; o < 64; o <<= 1) m = fmaxf(m, __shfl_xor(m, o));
        m = fmaxf(m, 1e-30f);
        const float q = 127.0f / m;
        v4u o;
        o.x = q8(a0.x * q) | (q8(a0.y * q) << 8) | (q8(a0.z * q) << 16) | (q8(a0.w * q) << 24);
        o.y = q8(a1.x * q) | (q8(a1.y * q) << 8) | (q8(a1.z * q) << 16) | (q8(a1.w * q) << 24);
        o.z = q8(a2.x * q) | (q8(a2.y * q) << 8) | (q8(a2.z * q) << 16) | (q8(a2.w * q) << 24);
        o.w = q8(a3.x * q) | (q8(a3.y * q) << 8) | (q8(a3.z * q) << 16) | (q8(a3.w * q) << 24);
        *(v4u*)(dst + (size_t)row * 1024 + 16 * lane) = o;
        if (lane == 0) scl[row] = m * (1.0f / 127.0f);
    }
}
__device__ __forceinline__ int row16_sum_i(int v) {
    v += __builtin_amdgcn_update_dpp(0, v, 0xB1, 0xF, 0xF, true);
    v += __builtin_amdgcn_update_dpp(0, v, 0x4E, 0xF, 0xF, true);
    v += __builtin_amdgcn_update_dpp(0, v, 0x141, 0xF, 0xF, true);
    v += __builtin_amdgcn_update_dpp(0, v, 0x140, 0xF, 0xF, true);
    return v;
}
constexpr int PE_NT = 4, PE_NR = 16, PE_SH = 10, PE_DEP = 3;
constexpr int PE_TOK_W = 128 * 3 + 20;
constexpr int PE_WAVE_W = PE_NT * PE_TOK_W + 272 + 32 * 33 + 2 * PE_NT * 128;
static_assert(8 * PE_WAVE_W * 4 <= MISC_OFF && PE_NR * PE_NT == 64, "peer LDS / batch-list geometry");
#define PE_LD(dst, voff_, sbase_) asm volatile("s_nop 4\n\tglobal_load_dwordx4 %0, %1, %2" : "=&v"(dst) : "v"(voff_), "s"(sbase_) : "memory")
__device__ __forceinline__ void peer_pass(const Params& P, LAS unsigned char* lds, int tbase, int lane, int wave, float* dstbase, int emask = 0x3fff) {
    {
        LAS unsigned* lw0 = (LAS unsigned*)(lds) + wave * PE_WAVE_W + PE_NT * PE_TOK_W + 272;
        peer_topk_wave(P, (LAS int*)lw0, lw0 + 32 * 33, (LAS float*)(lw0 + 32 * 33 + PE_NT * 128), tbase, lane);
        LDS_WAIT(); asm volatile("" : "+v"(lane), "+s"(tbase) :: "memory");
    }
    const unsigned char* ws = P.ws;
    const unsigned char* UB8 = ws + WS_UB; const unsigned char* VB8 = ws + WS_VB;
    const float* USC = (const float*)(ws + WS_USC); const float* VSC = (const float*)(ws + WS_VSC);
    unsigned hq[PE_NT][4]; f32x2 acc[PE_NT][8];
    LAS unsigned* lw = (LAS unsigned*)(lds) + wave * PE_WAVE_W;
    LAS unsigned* ents = lw + PE_NT * PE_TOK_W;
    const unsigned voff = (unsigned)lane * 16u;
    LAS unsigned* upe = ents + 272 + 32 * 33; LAS float* upg = (LAS float*)(upe + PE_NT * 128);
#pragma unroll
    for (int j = 0; j < PE_NT; ++j) {
        const int t = tbase + j;
        const v4u* xrow = (const v4u*)((const bf16*)(ws + WS_XB) + (size_t)t * 1024 + 16 * lane);
        const v4u xa = xrow[0], xc = xrow[1];
        const f32x4 xvv[4] = {(f32x4){bflo(xa.x), bfhi(xa.x), bflo(xa.y), bfhi(xa.y)}, (f32x4){bflo(xa.z), bfhi(xa.z), bflo(xa.w), bfhi(xa.w)},
                              (f32x4){bflo(xc.x), bfhi(xc.x), bflo(xc.y), bfhi(xc.y)}, (f32x4){bflo(xc.z), bfhi(xc.z), bflo(xc.w), bfhi(xc.w)}};
        const float rstd2 = rsqrtf(((const float*)(ws + WS_SSQ2))[t] * (1.0f / 1024.0f) + 1e-6f);
        f32x4 hv[4]; float hm = 0.f;
#pragma unroll
        for (int i = 0; i < 4; ++i) { const f32x4 xv = xvv[i]; const f32x4 w = ((const f32x4*)(P.norm_ffn_w + 16 * lane))[i];
            hv[i] = (f32x4){xv.x * rstd2 * w.x, xv.y * rstd2 * w.y, xv.z * rstd2 * w.z, xv.w * rstd2 * w.w};
            hm = fmaxf(hm, fmaxf(fmaxf(fabsf(hv[i].x), fabsf(hv[i].y)), fmaxf(fabsf(hv[i].z), fabsf(hv[i].w)))); }
#pragma unroll
        for (int o = 1; o < 64; o <<= 1) hm = fmaxf(hm, __shfl_xor(hm, o));
        hm = fmaxf(hm, 1e-30f);
        const float hqs = 127.0f / hm, hs = hm * (1.0f / 127.0f);
#pragma unroll
        for (int i = 0; i < 4; ++i) hq[j][i] = q8(hv[i].x * hqs) | (q8(hv[i].y * hqs) << 8) | (q8(hv[i].z * hqs) << 16) | (q8(hv[i].w * hqs) << 24);
#pragma unroll
        for (int i = 0; i < 8; ++i) acc[j][i] = (f32x2){0.f, 0.f};
        const int e0 = (int)upe[j * 128 + 2 * lane] & emask, e1 = (int)upe[j * 128 + 2 * lane + 1] & emask;
        const float g0 = upg[j * 128 + 2 * lane] * VSC[e0], g1 = upg[j * 128 + 2 * lane + 1] * VSC[e1];
        const float u0 = USC[e0] * hs, u1 = USC[e1] * hs;
        const int b0 = e0 >> PE_SH, b1 = e1 >> PE_SH;
        LAS unsigned* lt = lw + j * PE_TOK_W;
        int run = 0;
#pragma unroll 1
        for (int bk = 0; bk < PE_NR; ++bk) {
            const unsigned long long m0 = __ballot(b0 == bk), m1 = __ballot(b1 == bk);
            const int c0 = __popcll(m0), c1 = __popcll(m1);
            const unsigned long long lower = (1ull << lane) - 1ull;
            if (b0 == bk) { const int p = run + __popcll(m0 & lower); lt[p] = (unsigned)e0; lt[128 + p] = __builtin_bit_cast(unsigned, g0); lt[256 + p] = __builtin_bit_cast(unsigned, u0); }
            if (b1 == bk) { const int p = run + c0 + __popcll(m1 & lower); lt[p] = (unsigned)e1; lt[128 + p] = __builtin_bit_cast(unsigned, g1); lt[256 + p] = __builtin_bit_cast(unsigned, u1); }
            if (lane == 0) lt[384 + bk] = (unsigned)run;
            run += c0 + c1;
        }
        if (lane == 0) lt[384 + PE_NR] = 128u;
        asm volatile("" ::: "memory");
    }
    LDS_WAIT(); asm volatile("" ::: "memory");
    int nb;
    {
        const int rd = lane >> 2, j = lane & 3;
        const LAS unsigned* lt = lw + j * PE_TOK_W;
        const int n0 = (int)lt[384 + rd], n1 = (int)lt[384 + rd + 1];
        const int nbl = (n1 - n0 + 3) >> 2;
        int inc = nbl;
#pragma unroll
        for (int off = 1; off < 64; off <<= 1) { const int tv = __shfl_up(inc, off); if (lane >= off) inc += tv; }
        nb = __builtin_amdgcn_readlane(inc, 63);
        const int ofs = inc - nbl;
        for (int q = 0; q < nbl; ++q) { const int i0 = n0 + 4 * q, c = (n1 - i0) < 4 ? (n1 - i0) : 4; ents[ofs + q] = (unsigned)j | ((unsigned)c << 2) | ((unsigned)i0 << 5); }
        if (lane < 2 * PE_DEP) ents[nb + lane] = 0u;
    }
    LDS_WAIT(); asm volatile("" ::: "memory");
    v4u ru[PE_DEP][4], rv[PE_DEP][4];
#define PE_ISSUE(S, entv) do { const unsigned en_ = (entv); const int j_ = (int)(en_ & 3u), c_ = (int)((en_ >> 2) & 7u), i_ = (int)(en_ >> 5); \
        const LAS unsigned* lt_ = lw + j_ * PE_TOK_W; const int cl_ = c_ > 0 ? c_ - 1 : 0; \
        const int ev_ = (int)lt_[i_ + (lane < cl_ ? lane : cl_)];                          \
        _Pragma("unroll") for (int k_ = 0; k_ < 4; ++k_) { const size_t eo_ = (size_t)__builtin_amdgcn_readlane(ev_, k_) * 1024; \
            const unsigned char* up_ = UB8 + eo_; const unsigned char* vp_ = VB8 + eo_; PE_LD(ru[S][k_], voff, up_); PE_LD(rv[S][k_], voff, vp_); } } while (0)
#define PE_WAIT8(S, cntstr) asm volatile("s_waitcnt " cntstr : "+v"(ru[S][0]), "+v"(ru[S][1]), "+v"(ru[S][2]), "+v"(ru[S][3]), "+v"(rv[S][0]), "+v"(rv[S][1]), "+v"(rv[S][2]), "+v"(rv[S][3]) :: "memory")
#define PE_COMPUTE_J(S, J, c_, i_) do { const LAS unsigned* lt_ = lw + (J) * PE_TOK_W; \
        const float gsc_ = (lane < c_) ? __builtin_bit_cast(float, lt_[128 + i_ + lane]) : 0.f, usc_ = (lane < c_) ? __builtin_bit_cast(float, lt_[256 + i_ + lane]) : 0.f; \
        int d_[4]; \
        _Pragma("unroll") for (int k_ = 0; k_ < 4; ++k_) { d_[k_] = 0; if (k_ >= c_) continue; \
            int s_ = __builtin_amdgcn_sdot4((int)ru[S][k_].x, (int)hq[J][0], 0, false); s_ = __builtin_amdgcn_sdot4((int)ru[S][k_].y, (int)hq[J][1], s_, false); \
            s_ = __builtin_amdgcn_sdot4((int)ru[S][k_].z, (int)hq[J][2], s_, false); s_ = __builtin_amdgcn_sdot4((int)ru[S][k_].w, (int)hq[J][3], s_, false); d_[k_] = s_; } \
        int r2_[2], r1_; \
        { const bool up_ = (lane & 32) != 0; \
          _Pragma("unroll") for (int q_ = 0; q_ < 2; ++q_) { const int keep_ = up_ ? d_[2 + q_] : d_[q_], send_ = up_ ? d_[q_] : d_[2 + q_]; r2_[q_] = keep_ + __shfl_xor(send_, 32); } } \
        { const bool up_ = (lane & 16) != 0; const int keep_ = up_ ? r2_[1] : r2_[0], send_ = up_ ? r2_[0] : r2_[1]; r1_ = keep_ + __shfl_xor(send_, 16); } \
        r1_ = row16_sum_i(r1_); \
        const int myk_ = (lane >> 4) & 3; \
        const float act_ = gelu_tanh((float)r1_ * __shfl(usc_, myk_)) * __shfl(gsc_, myk_);      \
          \
        const float w0_ = __builtin_bit_cast(float, __builtin_amdgcn_readlane(__builtin_bit_cast(int, act_), 0)), w1_ = __builtin_bit_cast(float, __builtin_amdgcn_readlane(__builtin_bit_cast(int, act_), 16)), \
                    w2_ = __builtin_bit_cast(float, __builtin_amdgcn_readlane(__builtin_bit_cast(int, act_), 32)), w3_ = __builtin_bit_cast(float, __builtin_amdgcn_readlane(__builtin_bit_cast(int, act_), 48)); \
        const float wm_ = fmaxf(fmaxf(fmaxf(fabsf(w0_), fabsf(w1_)), fmaxf(fabsf(w2_), fabsf(w3_))), 1e-30f), wq_ = 127.0f / wm_, ws_ = wm_ * (1.0f / 127.0f); \
        const int w4_ = (int)(q8(w0_ * wq_) | (q8(w1_ * wq_) << 8) | (q8(w2_ * wq_) << 16) | (q8(w3_ * wq_) << 24)); \
        const f32x2 ws2_ = (f32x2){ws_, ws_}; \
        _Pragma("unroll") for (int m_ = 0; m_ < 4; ++m_) { \
            const unsigned R0_ = rv[S][0][m_], R1_ = rv[S][1][m_], R2_ = rv[S][2][m_], R3_ = rv[S][3][m_]; \
            const unsigned X_ = __builtin_amdgcn_perm(R1_, R0_, 0x05010400u), Y_ = __builtin_amdgcn_perm(R1_, R0_, 0x07030602u), Z_ = __builtin_amdgcn_perm(R3_, R2_, 0x05010400u), W_ = __builtin_amdgcn_perm(R3_, R2_, 0x07030602u); \
            const int t0_ = __builtin_amdgcn_sdot4((int)__builtin_amdgcn_perm(Z_, X_, 0x05040100u), w4_, 0, false), t1_ = __builtin_amdgcn_sdot4((int)__builtin_amdgcn_perm(Z_, X_, 0x07060302u), w4_, 0, false), \
                      t2_ = __builtin_amdgcn_sdot4((int)__builtin_amdgcn_perm(W_, Y_, 0x05040100u), w4_, 0, false), t3_ = __builtin_amdgcn_sdot4((int)__builtin_amdgcn_perm(W_, Y_, 0x07060302u), w4_, 0, false); \
            acc[J][2 * m_] = __builtin_elementwise_fma((f32x2){(float)t0_, (float)t1_}, ws2_, acc[J][2 * m_]); \
            acc[J][2 * m_ + 1] = __builtin_elementwise_fma((f32x2){(float)t2_, (float)t3_}, ws2_, acc[J][2 * m_ + 1]); } } while (0)
#define PE_COMPUTE(S, entv) do { const unsigned en_ = (entv); const int jj_ = (int)(en_ & 3u), cc_ = (int)((en_ >> 2) & 7u), ii_ = (int)(en_ >> 5); \
        if (cc_ > 0) { if (jj_ == 0) PE_COMPUTE_J(S, 0, cc_, ii_); else if (jj_ == 1) PE_COMPUTE_J(S, 1, cc_, ii_); else if (jj_ == 2) PE_COMPUTE_J(S, 2, cc_, ii_); else PE_COMPUTE_J(S, 3, cc_, ii_); } } while (0)
    {
        unsigned er[PE_DEP];
#pragma unroll
        for (int q = 0; q < PE_DEP; ++q) { er[q] = __builtin_amdgcn_readfirstlane(ents[q]); PE_ISSUE(q, er[q]); }
#pragma unroll 1
        for (int bi = 0; bi < nb; bi += PE_DEP) {
#pragma unroll
            for (int q = 0; q < PE_DEP; ++q) {
                PE_WAIT8(q, "vmcnt(16)");
                PE_COMPUTE(q, er[q]);
                er[q] = __builtin_amdgcn_readfirstlane(ents[bi + q + PE_DEP]);
                PE_ISSUE(q, er[q]);
            }
        }
#pragma unroll
        for (int q = 0; q < PE_DEP; ++q) PE_WAIT8(q, "vmcnt(0)");
    }
#undef PE_COMPUTE
#undef PE_COMPUTE_J
#undef PE_WAIT8
#undef PE_ISSUE
#pragma unroll
    for (int j = 0; j < PE_NT; ++j) {
        const int t = tbase + j;
        float ss = 0.f; f32x4 xo[4];
        { const v4u* xrow = (const v4u*)((const bf16*)(ws + WS_XB) + (size_t)t * 1024 + 16 * lane); const v4u xa = xrow[0], xc = xrow[1];
          xo[0] = (f32x4){bflo(xa.x), bfhi(xa.x), bflo(xa.y), bfhi(xa.y)}; xo[1] = (f32x4){bflo(xa.z), bfhi(xa.z), bflo(xa.w), bfhi(xa.w)};
          xo[2] = (f32x4){bflo(xc.x), bfhi(xc.x), bflo(xc.y), bfhi(xc.y)}; xo[3] = (f32x4){bflo(xc.z), bfhi(xc.z), bflo(xc.w), bfhi(xc.w)}; }
#pragma unroll
        for (int i = 0; i < 4; ++i) { xo[i].x += acc[j][2 * i].x; xo[i].y += acc[j][2 * i].y; xo[i].z += acc[j][2 * i + 1].x; xo[i].w += acc[j][2 * i + 1].y;
            ss += (xo[i].x * xo[i].x + xo[i].y * xo[i].y) + (xo[i].z * xo[i].z + xo[i].w * xo[i].w); }
        const float rstd3 = rsqrtf(wave_sum(ss) * (1.0f / 1024.0f) + 1e-6f);
        float* orow = dstbase + (size_t)t * 1024 + 16 * lane;
#pragma unroll
        for (int i = 0; i < 4; ++i) { const f32x4 w = ((const f32x4*)(P.norm_final_w + 16 * lane))[i];
            ((f32x4*)orow)[i] = (f32x4){xo[i].x * rstd3 * w.x, xo[i].y * rstd3 * w.y, xo[i].z * rstd3 * w.z, xo[i].w * rstd3 * w.w}; }
    }
    LDS_WAIT(); asm volatile("s_waitcnt vmcnt(0)" ::: "memory");
}


__global__ void __launch_bounds__(NWAVES * 64, 2) hybrid_fwd(Params P) {
    extern __shared__ __attribute__((aligned(16))) unsigned char lds_raw[];
    LAS unsigned char* lds = (LAS unsigned char*)lds_raw;
    volatile LAS unsigned* MISC = (volatile LAS unsigned*)(lds + MISC_OFF);
    const int tid = threadIdx.x, lane = tid & 63, wave = __builtin_amdgcn_readfirstlane(tid >> 6);
    const int G = gridDim.x, bx = blockIdx.x;
    const int vcu = (G % 8 == 0) ? (bx % 8) * (G / 8) + bx / 8 : bx;
    unsigned char* ws = P.ws;
    for (int u = tid; u < 64; u += NWAVES * 64) MISC[u] = 0u;
    __syncthreads();
    XcdBarrier bar; bar.bar = (unsigned*)(ws + WS_CTL) + CW_BAR; bar.x = 0; bar.st = nullptr;
    if (!MK_PER_PHASE) bar = xcd_barrier_post((unsigned*)(ws + WS_CTL) + CW_BAR, MISC + 8);
    const int lo = P.ph_lo, hi = P.ph_hi;
#ifndef PHASE_MASK
#define PHASE_MASK 0xFFF
#endif
#define IN(k) (((PHASE_MASK >> (k)) & 1) && lo <= (k) && (k) < hi)
#define SEAM(k) do { if (IN(k) && IN((k) + 1)) xcd_barrier(bar); } while (0)
#ifndef REP_MASK
#define REP_MASK 0
#endif
#ifndef PE_EXP_MASK
#define PE_EXP_MASK 0x3fff
#endif
#define REPS(k) for (int rep_ = 0; rep_ < (((REP_MASK >> (k)) & 1) ? 2 : 1); ++rep_, (rep_ < (((REP_MASK >> (k)) & 1) ? 2 : 1) ? xcd_barrier(bar) : (void)0))
    using namespace pg8;
    bf16* XB = (bf16*)(ws + WS_XB);

    if (IN(0)) REPS(0) { p0_prologue(P, lds, tid, lane, wave, vcu, G); }
    SEAM(0);
    if (IN(1)) REPS(1) {
        { Gemm gm{XB, (const bf16_t*)(ws + WS_WIN), T, 3072, 1024}; StaticOrder S; S.init(T, 3072, G, bx);
          EpiBf16Rs E{(bf16_t*)(ws + WS_QKV), 1536, 6, (bf16_t*)(ws + WS_XR), 512, (size_t)T * 512, nullptr, 1.0f};
          gemm_phase<EpiBf16Rs, StaticOrder, PG8_ALIGN, PG8_SP2>(lds, gm, S, E); }
    }
    SEAM(1);
    if (IN(3)) REPS(3) {
        if (bx < SCAN_WGS) gdn_scan(P, lds, bx, tid, lane, wave);
        else {
            const int wk = bx - SCAN_WGS, NWK = G - SCAN_WGS;
            unsigned* lcnt = (unsigned*)(ws + WS_CTL) + CW_LRUCNT;
            for (int q = wk; q < 1024; q += NWK) gdn_local_item(P, lds, (q & 7) * 128 + (q >> 3), tid);
            if (wk < 16) {
                struct OneUnit { int pm, pn; __device__ bool next(int i, Unit& u) const { if (i > 0) return false; u.pm = pm; u.pn = pn; return true; }
                                 __device__ void a_ready(const Unit&) const {} __device__ void done(const Unit&) const {} };
                Gemm gm{(const bf16_t*)(ws + WS_MEMN), (const bf16_t*)(ws + WS_WKV), 512, 2048, 1024}; OneUnit S{wk >> 3, wk & 7};
                EpiKV E{(bf16_t*)(ws + WS_KB), (bf16_t*)(ws + WS_VTP)};
                gemm_phase<EpiKV, OneUnit, PG8_ALIGN, PG8_SP2>(lds, gm, S, E);
            }
            unsigned ndone = 0;
            for (int lt = wk; lt < 256; lt += NWK) { lru_local_item(P, lds, lt, tid, lane, wave); ++ndone; }
            asm volatile("s_waitcnt vmcnt(0)" ::: "memory");
            __syncthreads();
            if (tid == 0 && ndone) { __builtin_amdgcn_fence(__ATOMIC_RELEASE, "agent"); asm volatile("s_waitcnt vmcnt(0)" ::: "memory");
                                     __hip_atomic_fetch_add(lcnt, ndone, __ATOMIC_RELAXED, __HIP_MEMORY_SCOPE_AGENT); }
            if (wk == 16 || wk == 17) {
                if (tid == 0) { unsigned sp = 0;
                    while (__hip_atomic_load(lcnt, __ATOMIC_RELAXED, __HIP_MEMORY_SCOPE_AGENT) < 256u) { __builtin_amdgcn_s_sleep(8); if (++sp > (1u << 22)) break; }
                    __builtin_amdgcn_fence(__ATOMIC_ACQUIRE, "agent"); asm volatile("s_waitcnt vmcnt(0)" ::: "memory"); }
                __syncthreads();
                lru_carry(P, (wk - 16) * NWAVES + wave, lane);
                asm volatile("s_waitcnt vmcnt(0)" ::: "memory");
                __syncthreads();
                if (tid == 0) { __builtin_amdgcn_fence(__ATOMIC_RELEASE, "agent"); asm volatile("s_waitcnt vmcnt(0)" ::: "memory");
                                __hip_atomic_fetch_add(lcnt + 64, 1u, __ATOMIC_RELAXED, __HIP_MEMORY_SCOPE_AGENT); }
            } else {
                const int w2 = (wk < 16 ? wk : wk - 2), N2 = NWK - 2;
                cvt_table_fp8(P.peer_v, ws + WS_VB, (float*)(ws + WS_VSC), w2 * NWAVES + wave, N2 * NWAVES, lane);
                late_weight_prep(P, lds, lane, wave, w2 * NWAVES + wave, N2 * NWAVES);
                if (tid == 0) { unsigned sp = 0;
                    while (__hip_atomic_load(lcnt + 64, __ATOMIC_RELAXED, __HIP_MEMORY_SCOPE_AGENT) < 2u) { __builtin_amdgcn_s_sleep(8); if (++sp > (1u << 22)) break; }
                    __builtin_amdgcn_fence(__ATOMIC_ACQUIRE, "agent"); asm volatile("s_waitcnt vmcnt(0)" ::: "memory"); }
                __syncthreads();
                lru_combine(P, (size_t)w2 * (NWAVES * 64) + tid, (size_t)N2 * (NWAVES * 64));
            }
        }
    }
    SEAM(3);
    if (IN(4)) REPS(4) {
        gdn_gate_norm(P, (size_t)bx * (NWAVES * 64) + tid, (size_t)G * (NWAVES * 64));
        cvt_table_fp8(P.peer_u, ws + WS_UB, (float*)(ws + WS_USC), bx * NWAVES + wave, G * NWAVES, lane);
    }
    SEAM(4);
    if (IN(5)) {
        Gemm gm{(const bf16_t*)((const unsigned char*)P.out + OUT_Y), (const bf16_t*)(ws + WS_WOUT), T, 1024, 1024}; StaticOrder S; S.init(T, 1024, G, bx);
        EpiResidBf<true> E{P.x, XB, (float*)(ws + WS_SSQ1)};
        gemm_phase<EpiResidBf<true>, StaticOrder, PG8_ALIGN, PG8_SP2>(lds, gm, S, E);
    }
    SEAM(5);
    if (IN(6)) REPS(6) {
        Gemm gm{XB, (const bf16_t*)(ws + WS_WQ), T, 1024, 1024}; StaticOrder S; S.init(T, 1024, G, bx);
        EpiBf16Rs E{(bf16_t*)(ws + WS_Q), 1024, 4, nullptr, 256, 0, (const float*)(ws + WS_SSQ1), 0.0625f};
        gemm_phase<EpiBf16Rs, StaticOrder, PG8_ALIGN, PG8_SP2>(lds, gm, S, E);
        Unit u;
        { const int wgid = (bx & 7) * 32 + (bx >> 3); u.pm = (wgid >> 5) * 8 + (wgid & 7); u.pn = (wgid & 31) >> 3; }
        if (G == 256) {
            asm volatile("s_waitcnt vmcnt(0)" ::: "memory");
            __syncthreads();
            const int b = u.pm >> 5, qb0 = (u.pm & 31) * 2, h = u.pn;
#pragma unroll 1
            for (int qq = 0; qq < 2; ++qq) xattn_unit(P, lds, (b << 8) | ((qb0 + qq) << 2) | h, tid, lane, wave);
        }
    }
    if (IN(7)) REPS(7) { }
    SEAM(7);
    if (IN(8)) {
        Gemm gm{(const bf16_t*)(ws + WS_AO), (const bf16_t*)(ws + WS_WO), T, 1024, 1024}; StaticOrder S; S.init(T, 1024, G, bx);
        EpiResidBf<false> E{nullptr, XB, (float*)(ws + WS_SSQ2)};
        gemm_phase<EpiResidBf<false>, StaticOrder, PG8_ALIGN, PG8_SP2>(lds, gm, S, E);
    }
    SEAM(8);
    if (IN(9)) REPS(9) {
        Gemm gm{XB, (const bf16_t*)(ws + WS_PWQ), T, 2048, 1024}; StaticOrder S; S.init(T, 2048, G, bx);
        EpiF16Rs E{(_Float16*)(ws + WS_PQ), 2048, (const float*)(ws + WS_SSQ2)};
        gemm_phase<EpiF16Rs, StaticOrder, PG8_ALIGN, PG8_SP2>(lds, gm, S, E);
    }
    SEAM(9);
    if (IN(10)) REPS(10) {
    }
    if (IN(11)) REPS(11) {
        for (int tb = (bx * NWAVES + wave) * PE_NT; tb < T; tb += G * NWAVES * PE_NT) peer_pass(P, lds, tb, lane, wave, (((REP_MASK >> 11) & 1) && rep_ == 0) ? (float*)(ws + WS_PQ) : P.out, (((REP_MASK >> 11) & 1) && rep_ == 0) ? PE_EXP_MASK : 0x3fff);
    }
#undef IN
#undef SEAM
}

extern "C" void kernel_launch(void* const* d_in, const int* in_sizes, int n_in, void* d_out, int out_size, void* d_ws, size_t ws_size, hipStream_t stream) {
    static int grid = 0;
    if (grid == 0) {
        if (n_in != 27 || in_sizes[0] != T * D || out_size != T * D || ws_size < WS_END) {
            fprintf(stderr, "kernel_launch: unexpected shapes (n_in %d, in0 %d, out %d, ws %zu); nothing launched\n", n_in, n_in > 0 ? in_sizes[0] : -1, out_size, ws_size); grid = -1; return; }
        int dev = 0, cus = 0, per_cu = 0;
        if (hipGetDevice(&dev) != hipSuccess || hipDeviceGetAttribute(&cus, hipDeviceAttributeMultiprocessorCount, dev) != hipSuccess) { grid = -1; return; }
        if (hipFuncSetAttribute((const void*)hybrid_fwd, hipFuncAttributeMaxDynamicSharedMemorySize, LDS_BYTES) != hipSuccess) { fprintf(stderr, "kernel_launch: hipFuncSetAttribute failed\n"); grid = -1; return; }
        if (hipOccupancyMaxActiveBlocksPerMultiprocessor(&per_cu, (const void*)hybrid_fwd, NWAVES * 64, LDS_BYTES) != hipSuccess || per_cu < 1)
            fprintf(stderr, "kernel_launch: note: occupancy query reports %d workgroups per CU\n", per_cu);
        (void)hipGetLastError();
        grid = cus;
        if (grid != 256) fprintf(stderr, "kernel_launch: %d CUs (built for 256)\n", grid);
    }
    if (grid < 0) return;
    if (hipMemsetAsync((char*)d_ws + WS_CTL, 0, CTL_ZERO_BYTES, stream) != hipSuccess) { fprintf(stderr, "kernel_launch: hipMemsetAsync failed\n"); return; }
    Params p{};
    const float** pp = (const float**)&p;
    for (int i = 0; i < 27; ++i) pp[i] = (const float*)d_in[i];
    p.out = (float*)d_out; p.ws = (unsigned char*)d_ws;
#if MK_PER_PHASE
    for (int k = 0; k < N_PHASES; ++k) { p.ph_lo = k; p.ph_hi = k + 1; hipLaunchKernelGGL(hybrid_fwd, dim3(grid), dim3(NWAVES * 64), LDS_BYTES, stream, p); }
#else
    p.ph_lo = 0; p.ph_hi = N_PHASES;
    hipLaunchKernelGGL(hybrid_fwd, dim3(grid), dim3(NWAVES * 64), LDS_BYTES, stream, p);
#endif
    const hipError_t le = hipPeekAtLastError();
    if (le != hipSuccess) fprintf(stderr, "kernel_launch: launch failed: %s\n", hipGetErrorName(le));
}
```

```cpp
#include <hip/hip_runtime.h>
#include <cstdio>
#include <cstdint>
namespace pg8 {
#define PG8_LAS __attribute__((address_space(3)))
typedef unsigned short bf16_t;
typedef short bf16x8 __attribute__((ext_vector_type(8)));
typedef float f32x4 __attribute__((ext_vector_type(4)));
typedef unsigned u32x4 __attribute__((ext_vector_type(4)));
constexpr int BM = 256, BK = 64, HALF = 128, HTB = HALF * BK * 2  , STAGE_BYTES = 8 * HTB, NXCD = 8, WGM = 8;

__host__ __device__ __forceinline__ int lds_byte(int r, int c) { const int st = (r >> 4) * 2 + (c >> 5), rr = r & 15, cc = c & 31, ob = rr * 64 + cc * 2; return st * 1024 + (ob ^ (((ob >> 9) & 1) << 5)); }
__host__ __device__ __forceinline__ void stage_rc(int b, int& R, int& C) { const int st = b / 1024, sb = b % 1024, swz = sb ^ (((sb >> 9) & 1) << 5); R = (st >> 1) * 16 + swz / 64; C = (st & 1) * 32 + (swz % 64) / 2; }
__host__ __device__ __forceinline__ int perm32(int rho) { const int n = rho >> 4, i = rho & 15; return 8 * (i >> 2) + 4 * n + (i & 3); }

struct Unit { int pm, pn; };
struct Gemm { const bf16_t* A; const bf16_t* Bt; int M, N, K; };

struct StaticOrder {
    int nM, nN, nwg, G, c;
    __host__ __device__ void init(int M, int N, int G_, int c_) { nM = M / BM; nN = N / BM; nwg = nM * nN; G = G_; c = c_; }
    __host__ __device__ bool next(int i, Unit& u) const {
        const long L = (long)i * G + c; if (L >= nwg) return false;
        int wgid = (int)L; { const int q = nwg / NXCD, r = nwg % NXCD, xcd = wgid % NXCD, off = wgid / NXCD; wgid = (xcd < r ? xcd * (q + 1) : r * (q + 1) + (xcd - r) * q) + off; }
        const int nig = WGM * nN, gid = wgid / nig, fm = gid * WGM, gsz = (nM - fm) < WGM ? (nM - fm) : WGM;
        u.pm = fm + ((wgid % nig) % gsz); u.pn = (wgid % nig) / gsz; return true;
    }
    __device__ __forceinline__ void a_ready(const Unit&) const {}
    __device__ __forceinline__ void done(const Unit&) const {}
};

__device__ __forceinline__ unsigned cvt_pk_bf16(float lo, float hi) { unsigned r; asm volatile("v_cvt_pk_bf16_f32 %0, %1, %2" : "=v"(r) : "v"(lo), "v"(hi)); return r; }
template <class Epi, class Sched, bool ALIGN_EPI = false, bool SP2 = false>
__device__ __forceinline__ void gemm_phase(PG8_LAS unsigned char* lds, const Gemm g, const Sched& S, const Epi& E) {
    const int tid = threadIdx.x, wid = __builtin_amdgcn_readfirstlane(tid >> 6), lane = tid & 63, wr = wid >> 2, wc = wid & 3, fr = lane & 15, fq = lane >> 4;
    const int K = g.K, nt = K / BK;
    unsigned voffA[2], voffB[2];
#pragma unroll
    for (int i = 0; i < 2; ++i) { int R, C; stage_rc(tid * 16 + i * 8192, R, C); const int Rb = Epi::PERM ? ((R & ~31) + perm32(R & 31)) : R;
        voffA[i] = (unsigned)(R * K + C) * 2u; voffB[i] = (unsigned)(Rb * K + C) * 2u; }
    const size_t kstep = (size_t)(BK * 2);
    const size_t hstep = (size_t)HALF * K * 2;
    const size_t tstep = 2 * hstep;
    const unsigned ldsw = (unsigned)wid * 1024u;
    const int aoff = lds_byte(wr * 64 + fr, fq * 8), boff = lds_byte(wc * 32 + fr, fq * 8);
#define PG8_SA(b, h) (((b) * 2 + (h)) * HTB)
#define PG8_SB(b, h) ((4 + (b) * 2 + (h)) * HTB)
#define PG8_STAGE(bufoff, gbase, voff) do { _Pragma("unroll") for (int _i = 0; _i < 2; ++_i) \
        __builtin_amdgcn_global_load_lds((const unsigned*)((const char*)(gbase) + (voff)[_i]), (PG8_LAS unsigned*)(lds + (bufoff) + ldsw + _i * 8192), 16, 0, 0); } while (0)
#define PG8_LDA(dst, b, h) do { _Pragma("unroll") for (int m = 0; m < 4; ++m) _Pragma("unroll") for (int k = 0; k < 2; ++k) dst[m][k] = *(const PG8_LAS bf16x8*)(lds + PG8_SA(b, h) + aoff + m * 2048 + k * 1024); } while (0)
#define PG8_LDB(dst, b, h) do { _Pragma("unroll") for (int n = 0; n < 2; ++n) _Pragma("unroll") for (int k = 0; k < 2; ++k) dst[n][k] = *(const PG8_LAS bf16x8*)(lds + PG8_SB(b, h) + boff + n * 2048 + k * 1024); } while (0)
#define PG8_MMA(ai, bj, At, Bt) do { __builtin_amdgcn_s_setprio(1); _Pragma("unroll") for (int m = 0; m < 4; ++m) _Pragma("unroll") for (int n = 0; n < 2; ++n) _Pragma("unroll") for (int k = 0; k < 2; ++k) \
        acc[ai][bj][m][n] = __builtin_amdgcn_mfma_f32_16x16x32_bf16(Bt[n][k], At[m][k], acc[ai][bj][m][n], 0, 0, 0); __builtin_amdgcn_s_setprio(0); } while (0)
#define PG8_WAIT_V(n) asm volatile("s_waitcnt vmcnt(" #n ")" ::: "memory")
#define PG8_WAIT_L(n) asm volatile("s_waitcnt lgkmcnt(" #n ")" ::: "memory")
#define PG8_BAR __builtin_amdgcn_s_barrier()
#define PG8_SCHED __builtin_amdgcn_sched_barrier(0)
    Unit cur, nxt; int ui = 0;
    if (!S.next(0, cur)) return;
    f32x4 acc[2][2][4][2];
#pragma unroll
    for (int a = 0; a < 2; ++a)
#pragma unroll
        for (int b = 0; b < 2; ++b)
#pragma unroll
            for (int m = 0; m < 4; ++m)
#pragma unroll
                for (int n = 0; n < 2; ++n) acc[a][b][m][n] = (f32x4){0.f, 0.f, 0.f, 0.f};
    bf16x8 At[4][2], B0[2][2], B1[2][2];
    const char* cA = (const char*)g.A + (size_t)cur.pm * tstep; const char* cB = (const char*)g.Bt + (size_t)cur.pn * tstep;
    S.a_ready(cur);
    if constexpr (SP2) {
        PG8_STAGE(PG8_SB(0, 0), cB, voffB); PG8_STAGE(PG8_SB(0, 1), cB + hstep, voffB); PG8_STAGE(PG8_SA(0, 0), cA, voffA); PG8_STAGE(PG8_SA(0, 1), cA + hstep, voffA);
        if (wr == 1) PG8_BAR;
        PG8_WAIT_V(2); PG8_BAR;
        PG8_STAGE(PG8_SB(1, 0), cB + kstep, voffB); PG8_STAGE(PG8_SA(1, 0), cA + kstep, voffA); PG8_STAGE(PG8_SB(1, 1), cB + hstep + kstep, voffB);
        PG8_WAIT_V(6); PG8_BAR;
    } else {
        PG8_STAGE(PG8_SB(0, 0), cB, voffB); PG8_STAGE(PG8_SA(0, 0), cA, voffA); PG8_STAGE(PG8_SB(0, 1), cB + hstep, voffB); PG8_STAGE(PG8_SA(0, 1), cA + hstep, voffA);
        if (wr == 1) PG8_BAR;
        PG8_WAIT_V(4); PG8_BAR;
        PG8_STAGE(PG8_SB(1, 0), cB + kstep, voffB); PG8_STAGE(PG8_SA(1, 0), cA + kstep, voffA); PG8_STAGE(PG8_SB(1, 1), cB + hstep + kstep, voffB);
        PG8_WAIT_V(6); PG8_BAR;
    }
    for (;;) {
        const bool has_next = S.next(ui + 1, nxt);
        const char* nA = has_next ? (const char*)g.A + (size_t)nxt.pm * tstep : cA; const char* nB = has_next ? (const char*)g.Bt + (size_t)nxt.pn * tstep : cB;
        for (int t = 0; t < nt; t += 2) {
            const bool last = (t == nt - 2);
            const char* a1 = cA + (size_t)(t + 1) * kstep;
            const char* a2 = last ? nA : cA + (size_t)(t + 2) * kstep; const char* b2 = last ? nB : cB + (size_t)(t + 2) * kstep;
            const char* a3 = a2 + kstep; const char* b3 = b2 + kstep;
            if (last && has_next) S.a_ready(nxt);
            if constexpr (SP2) {
            PG8_LDB(B0, 0, 0); PG8_LDB(B1, 0, 1); PG8_SCHED; PG8_LDA(At, 0, 0); PG8_STAGE(PG8_SA(1, 1), a1 + hstep, voffA);
            PG8_WAIT_V(8); PG8_WAIT_L(0); PG8_BAR; PG8_MMA(0, 0, At, B0); PG8_MMA(0, 1, At, B1); PG8_BAR; PG8_SCHED;
            PG8_LDA(At, 0, 1); PG8_STAGE(PG8_SB(0, 0), b2, voffB); PG8_STAGE(PG8_SB(0, 1), b2 + hstep, voffB); PG8_STAGE(PG8_SA(0, 0), a2, voffA);
            PG8_WAIT_V(8); PG8_WAIT_L(0); PG8_BAR; PG8_MMA(1, 0, At, B0); PG8_MMA(1, 1, At, B1); PG8_BAR; PG8_SCHED;
            PG8_LDB(B0, 1, 0); PG8_LDB(B1, 1, 1); PG8_SCHED; PG8_LDA(At, 1, 0); PG8_STAGE(PG8_SA(0, 1), a2 + hstep, voffA);
            PG8_WAIT_V(8); PG8_WAIT_L(0); PG8_BAR; PG8_MMA(0, 0, At, B0); PG8_MMA(0, 1, At, B1); PG8_BAR; PG8_SCHED;
            PG8_LDA(At, 1, 1); PG8_STAGE(PG8_SB(1, 0), b3, voffB); PG8_STAGE(PG8_SB(1, 1), b3 + hstep, voffB); PG8_STAGE(PG8_SA(1, 0), a3, voffA);
            PG8_WAIT_V(8); PG8_WAIT_L(0); PG8_BAR; PG8_MMA(1, 0, At, B0); PG8_MMA(1, 1, At, B1); PG8_BAR; PG8_SCHED;
            } else {
            PG8_LDB(B0, 0, 0); PG8_SCHED; PG8_LDA(At, 0, 0); PG8_STAGE(PG8_SA(1, 1), a1 + hstep, voffA);
            PG8_WAIT_L(8); PG8_BAR; PG8_WAIT_L(0); PG8_MMA(0, 0, At, B0); PG8_BAR; PG8_SCHED;
            PG8_LDB(B1, 0, 1); PG8_STAGE(PG8_SB(0, 0), b2, voffB);
            PG8_BAR; PG8_WAIT_L(0); PG8_MMA(0, 1, At, B1); PG8_BAR;
            PG8_LDA(At, 0, 1); PG8_STAGE(PG8_SA(0, 0), a2, voffA);
            PG8_BAR; PG8_WAIT_L(0); PG8_MMA(1, 0, At, B0); PG8_BAR; PG8_SCHED;
            PG8_STAGE(PG8_SB(0, 1), b2 + hstep, voffB);
            PG8_WAIT_V(6); PG8_BAR; PG8_MMA(1, 1, At, B1); PG8_BAR;
            PG8_LDB(B0, 1, 0); PG8_SCHED; PG8_LDA(At, 1, 0); PG8_STAGE(PG8_SA(0, 1), a2 + hstep, voffA);
            PG8_WAIT_L(8); PG8_BAR; PG8_WAIT_L(0); PG8_MMA(0, 0, At, B0); PG8_BAR; PG8_SCHED;
            PG8_LDB(B1, 1, 1); PG8_STAGE(PG8_SB(1, 0), b3, voffB);
            PG8_BAR; PG8_WAIT_L(0); PG8_MMA(0, 1, At, B1); PG8_BAR;
            PG8_LDA(At, 1, 1); PG8_STAGE(PG8_SA(1, 0), a3, voffA);
            PG8_BAR; PG8_WAIT_L(0); PG8_MMA(1, 0, At, B0); PG8_BAR; PG8_SCHED;
            PG8_STAGE(PG8_SB(1, 1), b3 + hstep, voffB);
            PG8_WAIT_V(6); PG8_BAR; PG8_MMA(1, 1, At, B1); PG8_BAR;
            }
        }
        if constexpr (ALIGN_EPI) { if (wr == 0) PG8_BAR; }
        if constexpr (!Epi::AFTER_DRAIN) { E(acc, cur, wr, wc, fr, fq); S.done(cur); }
        if (!has_next) break;
#pragma unroll
        for (int a = 0; a < 2; ++a)
#pragma unroll
            for (int b = 0; b < 2; ++b)
#pragma unroll
                for (int m = 0; m < 4; ++m)
#pragma unroll
                    for (int n = 0; n < 2; ++n) acc[a][b][m][n] = (f32x4){0.f, 0.f, 0.f, 0.f};
        cur = nxt; cA = nA; cB = nB; ++ui;
        if constexpr (ALIGN_EPI) { if (wr == 1) PG8_BAR; }
    }
    PG8_WAIT_V(0);
    if constexpr (!ALIGN_EPI) { if (wr == 0) PG8_BAR; }
    PG8_BAR;
    if constexpr (Epi::AFTER_DRAIN) { E.fused(acc, cur, wr, wc, fr, fq, lds, wid, lane); S.done(cur); }
#undef PG8_SA
#undef PG8_SB
#undef PG8_STAGE
#undef PG8_LDA
#undef PG8_LDB
#undef PG8_MMA
#undef PG8_WAIT_V
#undef PG8_WAIT_L
#undef PG8_BAR
#undef PG8_SCHED
}
}

namespace pg8 {
__host__ __device__ __forceinline__ int permk(int kl) { return 8 * ((kl & 15) >> 2) + 4 * (kl >> 4) + (kl & 3); }
struct EpiBf16Rs {
    static constexpr bool PERM = true, AFTER_DRAIN = false;
    bf16_t* O0; int ld0; int ntile0; bf16_t* O1; int ld1; size_t stride1; const float* ssq; float cs;
    __device__ __forceinline__ void operator()(const f32x4 (&acc)[2][2][4][2], const Unit& u, int wr, int wc, int fr, int fq) const {
        bf16_t* base; int ld, colt;
        if (u.pn < ntile0) { base = O0; ld = ld0; colt = u.pn * BM; }
        else { const int q = u.pn - ntile0, per = ld1 / BM; base = O1 + (size_t)(q / per) * stride1; ld = ld1; colt = (q % per) * BM; }
        const int row0 = u.pm * BM + wr * 64 + fr, col0 = colt + wc * 32 + 8 * fq;
#pragma unroll
        for (int ai = 0; ai < 2; ++ai)
#pragma unroll
            for (int m = 0; m < 4; ++m) {
                const int row = row0 + ai * HALF + m * 16;
                float sc = cs; if (ssq) sc *= rsqrtf(ssq[row] * (1.0f / 1024.0f) + 1e-6f);
                bf16_t* rowp = base + (size_t)row * ld + col0;
#pragma unroll
                for (int bj = 0; bj < 2; ++bj) { const f32x4 v0 = acc[ai][bj][m][0] * sc, v1 = acc[ai][bj][m][1] * sc;
                    u32x4 w; w.x = cvt_pk_bf16(v0[0], v0[1]); w.y = cvt_pk_bf16(v0[2], v0[3]); w.z = cvt_pk_bf16(v1[0], v1[1]); w.w = cvt_pk_bf16(v1[2], v1[3]);
                    *(u32x4*)(rowp + bj * HALF) = w; } }
    }
};
struct EpiF16Rs {
    static constexpr bool PERM = true, AFTER_DRAIN = false;
    _Float16* O; int ld; const float* ssq;
    __device__ __forceinline__ void operator()(const f32x4 (&acc)[2][2][4][2], const Unit& u, int wr, int wc, int fr, int fq) const {
        typedef _Float16 f16x8 __attribute__((ext_vector_type(8)));
        const int row0 = u.pm * BM + wr * 64 + fr, col0 = u.pn * BM + wc * 32 + 8 * fq;
#pragma unroll
        for (int ai = 0; ai < 2; ++ai)
#pragma unroll
            for (int m = 0; m < 4; ++m) {
                const int row = row0 + ai * HALF + m * 16;
                const float sc = rsqrtf(ssq[row] * (1.0f / 1024.0f) + 1e-6f);
                _Float16* rowp = O + (size_t)row * ld + col0;
#pragma unroll
                for (int bj = 0; bj < 2; ++bj) { const f32x4 v0 = acc[ai][bj][m][0] * sc, v1 = acc[ai][bj][m][1] * sc;
                    f16x8 w; w[0] = (_Float16)v0[0]; w[1] = (_Float16)v0[1]; w[2] = (_Float16)v0[2]; w[3] = (_Float16)v0[3];
                    w[4] = (_Float16)v1[0]; w[5] = (_Float16)v1[1]; w[6] = (_Float16)v1[2]; w[7] = (_Float16)v1[3];
                    *(f16x8*)(rowp + bj * HALF) = w; } }
    }
};
template <bool BASE_F32> struct EpiResidBf {
    static constexpr bool PERM = true, AFTER_DRAIN = false;
    const float* basef; bf16_t* xb; float* ssq;
    __device__ __forceinline__ void operator()(const f32x4 (&acc)[2][2][4][2], const Unit& u, int wr, int wc, int fr, int fq) const {
        const int row0 = u.pm * BM + wr * 64 + fr, col0 = u.pn * BM + wc * 32 + 8 * fq;
#pragma unroll
        for (int ai = 0; ai < 2; ++ai)
#pragma unroll
            for (int m = 0; m < 4; ++m) {
                const int row = row0 + ai * HALF + m * 16; const size_t off = (size_t)row * 1024 + col0; float s = 0.f;
#pragma unroll
                for (int bj = 0; bj < 2; ++bj) { const size_t o2 = off + bj * HALF;
                    f32x4 b0, b1;
                    if (BASE_F32) { b0 = *(const f32x4*)(basef + o2); b1 = *(const f32x4*)(basef + o2 + 4); }
                    else { const u32x4 p = *(const u32x4*)(xb + o2);
                        b0 = (f32x4){__builtin_bit_cast(float, p.x << 16), __builtin_bit_cast(float, p.x & 0xffff0000u), __builtin_bit_cast(float, p.y << 16), __builtin_bit_cast(float, p.y & 0xffff0000u)};
                        b1 = (f32x4){__builtin_bit_cast(float, p.z << 16), __builtin_bit_cast(float, p.z & 0xffff0000u), __builtin_bit_cast(float, p.w << 16), __builtin_bit_cast(float, p.w & 0xffff0000u)}; }
                    const f32x4 o0 = b0 + acc[ai][bj][m][0], o1 = b1 + acc[ai][bj][m][1];
                    s += ((o0[0] * o0[0] + o0[1] * o0[1]) + (o0[2] * o0[2] + o0[3] * o0[3])) + ((o1[0] * o1[0] + o1[1] * o1[1]) + (o1[2] * o1[2] + o1[3] * o1[3]));
                    u32x4 w; w.x = cvt_pk_bf16(o0[0], o0[1]); w.y = cvt_pk_bf16(o0[2], o0[3]); w.z = cvt_pk_bf16(o1[0], o1[1]); w.w = cvt_pk_bf16(o1[2], o1[3]);
                    *(u32x4*)(xb + o2) = w; }
                s += __shfl_xor(s, 16); s += __shfl_xor(s, 32);
                if (fq == 0) atomicAdd(ssq + row, s);
            }
    }
};
struct EpiKV {
    static constexpr bool PERM = false, AFTER_DRAIN = false;
    bf16_t* Kb; bf16_t* VTp;
    __device__ __forceinline__ void operator()(const f32x4 (&acc)[2][2][4][2], const Unit& u, int wr, int wc, int fr, int fq) const {
        typedef unsigned u32x2v __attribute__((ext_vector_type(2)));
        const int row0 = u.pm * BM + wr * 64 + fr, col0 = u.pn * BM + wc * 32 + 4 * fq;
#pragma unroll
        for (int ai = 0; ai < 2; ++ai)
#pragma unroll
            for (int m = 0; m < 4; ++m) {
                const int row = row0 + ai * HALF + m * 16, b = row >> 8, key = row & 255;
#pragma unroll
                for (int bj = 0; bj < 2; ++bj)
#pragma unroll
                    for (int n = 0; n < 2; ++n) { const int col = col0 + bj * HALF + n * 16; const f32x4 v = acc[ai][bj][m][n];
                        const unsigned p01 = cvt_pk_bf16(v[0], v[1]), p23 = cvt_pk_bf16(v[2], v[3]);
                        if (col < 1024) { const int h = col >> 8, dh = col & 255; u32x2v w; w.x = p01; w.y = p23;
                            *(u32x2v*)(Kb + ((size_t)((b * 4 + h) * 256 + key)) * 256 + dh) = w; }
                        else { const int c2 = col - 1024, h = c2 >> 8, dv = c2 & 255, kp = (key & ~31) | permk(key & 31);
                            bf16_t* d = VTp + ((size_t)((b * 4 + h) * 256 + dv)) * 256 + kp;
                            d[0] = (bf16_t)(p01 & 0xffffu); d[256] = (bf16_t)(p01 >> 16); d[512] = (bf16_t)(p23 & 0xffffu); d[768] = (bf16_t)(p23 >> 16); } }
            }
    }
};
}
#ifndef PG8_SP2
#define PG8_SP2 true
#endif
#ifndef PG8_ALIGN
#define PG8_ALIGN true
#endif

constexpr int NWAVES = 8;
#ifndef MK_PER_PHASE
#define MK_PER_PHASE 0
#endif
constexpr int T = 16384, SEQ = 8192, D = 1024;
constexpr int N_PHASES = 12;

constexpr size_t MiB = 1u << 20, KiB = 1u << 10;
constexpr size_t WS_CTL = 0, CTL_ZERO_BYTES = 1 * MiB;
constexpr int CW_BAR = 4096;
constexpr size_t WS_SSQ1 = 64 * KiB, WS_SSQ2 = 128 * KiB;
constexpr size_t WS_AB = 1 * MiB;
constexpr size_t WS_HEND = WS_AB + 512 * KiB, WS_PEND = WS_HEND + 512 * KiB, WS_HIN = WS_PEND + 512 * KiB;
constexpr size_t WS_DEC = WS_HIN + 512 * KiB;
constexpr size_t WS_SUBK = 3 * MiB + 256 * KiB;
constexpr size_t WS_WIN = 4 * MiB, WS_WOUT = 10 * MiB, WS_WQ = 12 * MiB, WS_WKV = 14 * MiB, WS_WO = 18 * MiB, WS_PWQ = 20 * MiB;
constexpr size_t WS_MEMN = 24 * MiB, WS_KB = 25 * MiB, WS_VTP = 26 * MiB, WS_LRUWT = 27 * MiB, WS_USC = 27 * MiB + 256 * KiB, WS_VSC = 27 * MiB + 384 * KiB;
constexpr size_t WS_XB = 28 * MiB;
constexpr size_t WS_HLOC = 28 * MiB, WS_PCUM = 44 * MiB;
constexpr size_t WS_QKV = 60 * MiB;
constexpr size_t OUT_Y = 4 * MiB;
constexpr size_t OUT_END = OUT_Y + (size_t)16384 * 1024 * 2;
constexpr size_t WS_IDX = 60 * MiB, WS_GW = 68 * MiB;
constexpr size_t WS_UB = 60 * MiB;
constexpr size_t WS_XR = 108 * MiB, WS_Z = 124 * MiB, WS_GATE = 140 * MiB;
constexpr size_t WS_WN = 156 * MiB, WS_UF = 172 * MiB, WS_QD = 188 * MiB, WS_KD = 204 * MiB, WS_ATT = 220 * MiB;
constexpr size_t WS_VB = 228 * MiB;
constexpr size_t WS_Q = 188 * MiB, WS_AO = 124 * MiB;
constexpr size_t WS_PQ = 108 * MiB;
constexpr size_t WS_END = 244 * MiB;
constexpr int CW_GFLAG = 49152;
constexpr int CW_LRUCNT = 8192;
static_assert(WS_XR - WS_QKV == (size_t)T * 1536 * 2 && WS_Z - WS_XR == (size_t)T * 512 * 2 && WS_GATE - WS_Z == (size_t)T * 512 * 2, "in-proj outputs are contiguous");

constexpr int LDS_BYTES = 160 * 1024;
constexpr int MISC_OFF = 159 * 1024;

#define GAS __attribute__((address_space(1)))
#define LAS __attribute__((address_space(3)))
typedef unsigned short bf16;
typedef unsigned v4u __attribute__((ext_vector_type(4)));
typedef unsigned v2u __attribute__((ext_vector_type(2)));
typedef float f32x4 __attribute__((ext_vector_type(4)));
typedef short bf16x8 __attribute__((ext_vector_type(8)));
typedef GAS unsigned gu32;
#define LDS_WAIT() asm volatile("s_waitcnt lgkmcnt(0)" ::: "memory")
__device__ __forceinline__ void st16_wt(void* p, v4u v) { asm volatile("global_store_dwordx4 %0, %1, off sc0 sc1\n\ts_nop 1" :: "v"(p), "v"(v) : "memory"); }
__device__ __forceinline__ unsigned f2bf(float f) { unsigned u = __builtin_bit_cast(unsigned, f); return (u + 0x7fffu + ((u >> 16) & 1u)) >> 16; }
__device__ __forceinline__ unsigned pk2(float lo, float hi) { return f2bf(lo) | (f2bf(hi) << 16); }
__device__ __forceinline__ float bflo(unsigned u) { return __builtin_bit_cast(float, u << 16); }
__device__ __forceinline__ float bfhi(unsigned u) { return __builtin_bit_cast(float, u & 0xffff0000u); }
__device__ __forceinline__ float bf1(bf16 h) { return __builtin_bit_cast(float, (unsigned)h << 16); }
__device__ __forceinline__ float wave_sum(float v) {
#pragma unroll
    for (int o = 1; o < 64; o <<= 1) v += __shfl_xor(v, o);
    return v;
}
__device__ __forceinline__ float row16_sum(float v) {
    v += __builtin_bit_cast(float, __builtin_amdgcn_update_dpp(0, __builtin_bit_cast(int, v), 0xB1, 0xF, 0xF, true));
    v += __builtin_bit_cast(float, __builtin_amdgcn_update_dpp(0, __builtin_bit_cast(int, v), 0x4E, 0xF, 0xF, true));
    v += __builtin_bit_cast(float, __builtin_amdgcn_update_dpp(0, __builtin_bit_cast(int, v), 0x141, 0xF, 0xF, true));
    v += __builtin_bit_cast(float, __builtin_amdgcn_update_dpp(0, __builtin_bit_cast(int, v), 0x140, 0xF, 0xF, true));
    return v;
}
__device__ __forceinline__ float sigmoidf_(float x) { return __builtin_amdgcn_rcpf(1.0f + __expf(-x)); }
__device__ __forceinline__ float softplusf_(float x) { return fmaxf(x, 0.f) + log1pf(__expf(-fabsf(x))); }
__device__ __forceinline__ float siluf_(float x) { return x * __builtin_amdgcn_rcpf(1.0f + __expf(-x)); }
__device__ __forceinline__ float gelu_tanh(float x) { const float y = 0.7978845608028654f * (x + 0.044715f * x * x * x); const float e = __expf(2.0f * y); return x * (1.0f - __builtin_amdgcn_rcpf(1.0f + e)); }
__device__ __forceinline__ int permk(int kl) { return 8 * ((kl & 15) >> 2) + 4 * (kl >> 4) + (kl & 3); }

struct Params {
    const float *x, *mem, *norm_mix_w, *w_in, *conv_qkv_w, *gdn_a_log, *gdn_dt_bias, *gdn_norm_w, *lru_conv_w, *lru_conv_b, *lru_wa, *lru_ba, *lru_wx, *lru_bx, *lru_lambda, *w_out,
                *norm_xattn_w, *norm_mem_w, *xattn_wq, *xattn_wkv, *xattn_wo, *norm_ffn_w, *peer_wq, *peer_subkeys, *peer_u, *peer_v, *norm_final_w;
    float* out; unsigned char* ws; int ph_lo, ph_hi;
};
#define XB_TMO      128
#define XB_XCNT(j)  (256  + 64 * (j))
#define XB_XSUB(j)  (1280 + 64 * (j))
#define XB_XGEN(j)  (2304 + 64 * (j))
#define XB_TOP      3328
#define XB_TOPGEN   3392
#define XCD_BAR_WORDS 3456
#define XB_SPIN_CAP (1u << 18)

__device__ __forceinline__ unsigned xb_ld(unsigned* p)              { return __hip_atomic_load(p, __ATOMIC_RELAXED, __HIP_MEMORY_SCOPE_AGENT); }
__device__ __forceinline__ unsigned xb_add(unsigned* p, unsigned v) { return __hip_atomic_fetch_add(p, v, __ATOMIC_RELAXED, __HIP_MEMORY_SCOPE_AGENT); }
__device__ __forceinline__ unsigned xb_xcc_id() { return (unsigned)__builtin_amdgcn_s_getreg((3 << 11) | 20) & 0xFu; }
#define XB_SPIN(cond, bar) do { unsigned _sp = 0; while (cond) { __builtin_amdgcn_s_sleep(1); \
    if ((++_sp & 255u) == 0u) { if (xb_ld(&(bar)[XB_TMO])) break; if (_sp > XB_SPIN_CAP) { atomicAdd(&(bar)[XB_TMO], 1u); break; } } } } while (0)

struct XcdBarrier {
    unsigned* bar; unsigned x;
    volatile LAS unsigned* st;
};

__device__ __forceinline__ XcdBarrier xcd_barrier_post(unsigned* bar, volatile LAS unsigned* st) {
    XcdBarrier b; b.bar = bar; b.x = xb_xcc_id(); b.st = st;
    if (threadIdx.x == 0) (void)xb_add(&bar[XB_XCNT(b.x)], 1u);
    return b;
}
__device__ __forceinline__ void xcd_barrier_complete(unsigned* bar, unsigned x, unsigned& nloc, unsigned& nx) {
    const unsigned G = gridDim.x * gridDim.y * gridDim.z;
    unsigned sum, cnt, mine, sp = 0u;
    for (;;) {
        sum = 0u; cnt = 0u; mine = 0u;
#pragma unroll
        for (unsigned j = 0; j < 16; ++j) { const unsigned c = xb_ld(&bar[XB_XCNT(j)]); sum += c; cnt += (c > 0u) ? 1u : 0u; mine = (j == x) ? c : mine; }
        if (sum == G) break;
        __builtin_amdgcn_s_sleep(1);
        if ((++sp & 255u) == 0u) { if (xb_ld(&bar[XB_TMO])) break; if (sp > XB_SPIN_CAP) { atomicAdd(&bar[XB_TMO], 1u); break; } }
    }
    nloc = mine > 0u ? mine : 1u; nx = cnt > 0u ? cnt : 1u;
}

__device__ __forceinline__ void xcd_barrier(const XcdBarrier& b) {
    asm volatile("s_waitcnt vmcnt(0)" ::: "memory");
    __syncthreads();
    if (threadIdx.x == 0) {
        unsigned* bar = b.bar;
        __builtin_amdgcn_s_waitcnt(0);
        unsigned nloc = b.st[0], nx = b.st[1];
        if (nloc == 0u) { xcd_barrier_complete(bar, b.x, nloc, nx); b.st[0] = nloc; b.st[1] = nx; }
        const unsigned old = xb_add(&bar[XB_XSUB(b.x)], 1u);
        const unsigned gen = old / nloc;
        if (old + 1u == (gen + 1u) * nloc) {
            __builtin_amdgcn_fence(__ATOMIC_RELEASE, "agent");
            asm volatile("s_waitcnt vmcnt(0)" ::: "memory");
            const unsigned og = xb_add(&bar[XB_TOP], 1u);
            const unsigned tg = og / nx;
            if (og + 1u == (tg + 1u) * nx) xb_add(&bar[XB_TOPGEN], 1u);
            else XB_SPIN(xb_ld(&bar[XB_TOPGEN]) == tg, bar);
            __builtin_amdgcn_fence(__ATOMIC_ACQUIRE, "agent");
            xb_add(&bar[XB_XGEN(b.x)], 1u);
            asm volatile("s_waitcnt vmcnt(0)" ::: "memory");
        } else {
            XB_SPIN(xb_ld(&bar[XB_XGEN(b.x)]) == gen, bar);
            __builtin_amdgcn_fence(__ATOMIC_ACQUIRE, "agent");
            asm volatile("s_waitcnt vmcnt(0)" ::: "memory");
        }
    }
    __syncthreads();
}

__device__ __forceinline__ void p0_transpose_item(const float* W, int K, int ldw, int c0, int nblk, bf16* WT, int row_off, const float* ks, LAS float* scr, int item, int lane) {
    const int kb = item / nblk, nb = item % nblk, k0 = 64 * kb, n0 = 32 * nb;
#pragma unroll 8
    for (int i = 0; i < 32; ++i) { const int kk = 2 * i + (lane >> 5); float v = W[(size_t)(k0 + kk) * ldw + c0 + n0 + (lane & 31)]; if (ks) v *= ks[k0 + kk]; scr[kk * 33 + (lane & 31)] = v; }
    LDS_WAIT(); asm volatile("" ::: "memory");
    const int c = lane & 7;
#pragma unroll
    for (int j = 0; j < 4; ++j) { const int n = (lane >> 3) + 8 * j; const LAS float* s = scr + (8 * c) * 33 + n;
        v4u o; o.x = pk2(s[0 * 33], s[1 * 33]); o.y = pk2(s[2 * 33], s[3 * 33]); o.z = pk2(s[4 * 33], s[5 * 33]); o.w = pk2(s[6 * 33], s[7 * 33]);
        *(GAS v4u*)(WT + (size_t)(row_off + n0 + n) * K + k0 + 8 * c) = o; }
    LDS_WAIT(); asm volatile("" ::: "memory");
}

__device__ __forceinline__ void p0_prologue(const Params& P, LAS unsigned char* lds, int tid, int lane, int wave, int vcu, int G) {
    unsigned char* ws = P.ws;
    const int gw = vcu * NWAVES + wave, NGW = G * NWAVES;
    LAS float* wabl = (LAS float*)lds;
    for (int idx = tid; idx < 8192; idx += NWAVES * 64) { const int k = idx >> 3, c = idx & 7, j = k >> 8, l = (k >> 2) & 63, e = k & 3;
        wabl[((((j * 4 + e) * 2 + (c >> 2)) * 64 + l) << 2) + (c & 3)] = P.w_in[(size_t)k * 3080 + 2048 + c]; }
    __syncthreads();
    {
        bf16* XB0 = (bf16*)(ws + WS_XB); float* AB = (float*)(ws + WS_AB);
        f32x4 w4[4];
#pragma unroll
        for (int j = 0; j < 4; ++j) w4[j] = ((const f32x4*)P.norm_mix_w)[64 * j + lane];
        for (int m = gw; m < T; m += NGW) {
            const f32x4* xr = (const f32x4*)(P.x + (size_t)m * D) + lane;
            f32x4 v[4]; float s = 0.f;
#pragma unroll
            for (int j = 0; j < 4; ++j) { v[j] = xr[64 * j]; s += (v[j].x * v[j].x + v[j].y * v[j].y) + (v[j].z * v[j].z + v[j].w * v[j].w); }
            const float rstd = rsqrtf(wave_sum(s) * (1.0f / D) + 1e-6f);
            v2u* o8 = (v2u*)(XB0 + (size_t)m * D) + lane;
            float part[8];
#pragma unroll
            for (int c = 0; c < 8; ++c) part[c] = 0.f;
#pragma unroll
            for (int j = 0; j < 4; ++j) {
                v[j] = v[j] * rstd * w4[j];
                v2u o; o.x = pk2(v[j].x, v[j].y); o.y = pk2(v[j].z, v[j].w); o8[64 * j] = o;
#pragma unroll
                for (int e = 0; e < 4; ++e) {
                    const f32x4 wa = *(const LAS f32x4*)(wabl + ((((j * 4 + e) * 2 + 0) * 64 + lane) << 2));
                    const f32x4 wb = *(const LAS f32x4*)(wabl + ((((j * 4 + e) * 2 + 1) * 64 + lane) << 2));
                    const float hv = v[j][e];
                    part[0] += hv * wa.x; part[1] += hv * wa.y; part[2] += hv * wa.z; part[3] += hv * wa.w;
                    part[4] += hv * wb.x; part[5] += hv * wb.y; part[6] += hv * wb.z; part[7] += hv * wb.w;
                }
            }
#pragma unroll
            for (int c = 0; c < 8; ++c) part[c] = wave_sum(part[c]);
            float o = part[0];
#pragma unroll
            for (int c = 1; c < 8; ++c) o = (lane == c) ? part[c] : o;
            if (lane < 8) AB[(size_t)m * 8 + lane] = o;
        }
    }
    {
        bf16* MEMN = (bf16*)(ws + WS_MEMN);
        for (int m = gw; m < 512; m += NGW) {
            const f32x4* xr = (const f32x4*)(P.mem + (size_t)m * D) + lane;
            f32x4 v[4]; float s = 0.f;
#pragma unroll
            for (int j = 0; j < 4; ++j) { v[j] = xr[64 * j]; s += (v[j].x * v[j].x + v[j].y * v[j].y) + (v[j].z * v[j].z + v[j].w * v[j].w); }
            const float rstd = rsqrtf(wave_sum(s) * (1.0f / D) + 1e-6f);
            v2u* o8 = (v2u*)(MEMN + (size_t)m * D) + lane;
#pragma unroll
            for (int j = 0; j < 4; ++j) { const f32x4 w = ((const f32x4*)P.norm_mem_w)[64 * j + lane]; const f32x4 y = v[j] * rstd * w;
                v2u o; o.x = pk2(y.x, y.y); o.y = pk2(y.z, y.w); o8[64 * j] = o; }
        }
    }
    __syncthreads();
    {
        LAS float* scr = (LAS float*)(lds + wave * 16384);
        constexpr int I_IN1 = 16 * 48, I_IN2 = 16 * 16, I_KV = 16 * 64;
        constexpr int NITEMS = I_IN1 + 3 * I_IN2 + I_KV;
        for (int it = gw; it < NITEMS; it += NGW) {
            int r = it;
            if (r < I_IN1) { p0_transpose_item(P.w_in, 1024, 3080, 0, 48, (bf16*)(ws + WS_WIN), 0, nullptr, scr, r, lane); continue; } r -= I_IN1;
            if (r < I_IN2) { p0_transpose_item(P.w_in, 1024, 3080, 2056, 16, (bf16*)(ws + WS_WIN), 1536, nullptr, scr, r, lane); continue; } r -= I_IN2;
            if (r < I_IN2) { p0_transpose_item(P.w_in, 1024, 3080, 1536, 16, (bf16*)(ws + WS_WIN), 2048, nullptr, scr, r, lane); continue; } r -= I_IN2;
            if (r < I_IN2) { p0_transpose_item(P.w_in, 1024, 3080, 2568, 16, (bf16*)(ws + WS_WIN), 2560, nullptr, scr, r, lane); continue; } r -= I_IN2;
            p0_transpose_item(P.xattn_wkv, 1024, 2048, 0, 64, (bf16*)(ws + WS_WKV), 0, nullptr, scr, r, lane);
        }
    }
    {
        bf16* WT = (bf16*)(ws + WS_LRUWT);
        for (int it = vcu * NWAVES * 64 + tid; it < 8 * 2 * 64 * 8; it += G * NWAVES * 64) {
            const int i8 = it & 7, j = (it >> 3) & 63, m = (it >> 9) & 1, g = it >> 10;
            const float* src = (m ? P.lru_wx : P.lru_wa) + (size_t)(g * 64 + 8 * i8) * 64 + j;
            v4u o; o.x = pk2(src[0], src[64]); o.y = pk2(src[128], src[192]); o.z = pk2(src[256], src[320]); o.w = pk2(src[384], src[448]);
            *(v4u*)(WT + (size_t)it * 8) = o;
        }
    }
}

__device__ __forceinline__ void late_weight_prep(const Params& P, LAS unsigned char* lds, int lane, int wave, int gw, int NGW) {
    unsigned char* ws = P.ws;
    {
        LAS float* scr = (LAS float*)(lds + wave * 16384);
        constexpr int I_OUT = 16 * 32, I_Q = 16 * 32, I_O = 16 * 32;
        for (int it = gw; it < I_OUT + I_Q + I_O; it += NGW) {
            int r = it;
            if (r < I_OUT) { p0_transpose_item(P.w_out, 1024, 1024, 0, 32, (bf16*)(ws + WS_WOUT), 0, nullptr, scr, r, lane); continue; } r -= I_OUT;
            if (r < I_Q) { p0_transpose_item(P.xattn_wq, 1024, 1024, 0, 32, (bf16*)(ws + WS_WQ), 0, P.norm_xattn_w, scr, r, lane); continue; } r -= I_Q;
            p0_transpose_item(P.xattn_wo, 1024, 1024, 0, 32, (bf16*)(ws + WS_WO), 0, nullptr, scr, r, lane);
        }
    }
    {
        bf16* WF = (bf16*)(ws + WS_PWQ);
        const int col = lane & 15, g = lane >> 4;
        for (int it = gw; it < 16 * 64; it += NGW) {
            const int hp = it >> 6, k0 = (it & 63) * 16;
            bf16x8 bq[4];
#pragma unroll
            for (int s = 0; s < 4; ++s) { const f32x4* src = (const f32x4*)(P.peer_wq + (size_t)(k0 + col) * 2048 + hp * 128 + 32 * s + 8 * g);
                const f32x4 a = src[0], c = src[1]; v4u pk; pk.x = pk2(a.x, a.y); pk.y = pk2(a.z, a.w); pk.z = pk2(c.x, c.y); pk.w = pk2(c.z, c.w); bq[s] = __builtin_bit_cast(bf16x8, pk); }
            const float nw = P.norm_ffn_w[k0 + col];
#pragma unroll 2
            for (int kt = 0; kt < 8; ++kt) {
                f32x4 acc = (f32x4){0.f, 0.f, 0.f, 0.f};
#pragma unroll
                for (int s = 0; s < 4; ++s) { const f32x4* src = (const f32x4*)(P.peer_subkeys + (size_t)(hp * 128 + 16 * kt + col) * 128 + 32 * s + 8 * g);
                    const f32x4 a = src[0], c = src[1]; v4u pk; pk.x = pk2(a.x, a.y); pk.y = pk2(a.z, a.w); pk.z = pk2(c.x, c.y); pk.w = pk2(c.z, c.w);
                    acc = __builtin_amdgcn_mfma_f32_16x16x32_bf16(__builtin_bit_cast(bf16x8, pk), bq[s], acc, 0, 0, 0); }
#pragma unroll
                for (int i = 0; i < 4; ++i) WF[(size_t)(hp * 128 + 16 * kt + 4 * g + i) * 1024 + k0 + col] = (bf16)f2bf(acc[i] * nw);
            }
        }
    }
}

constexpr int GL_KS = 0, GL_VS = 33792, GL_KB = 67584, GL_QB = 84992, GL_RAW = 102400, GL_CW = 153856, GL_AMT = 133120, GL_SM = 160000, GL_ATT = 151808, GL_SOL = 67584;
static_assert(GL_CW + 6144 <= GL_SM && GL_SM + 1284 <= MISC_OFF && GL_SOL + 65536 <= GL_AMT && GL_AMT + 17408 <= GL_ATT && GL_ATT + 8192 <= GL_SM && GL_RAW + 51456 <= GL_CW, "gdn_local LDS map");
#ifndef GL_REP_STEP
#define GL_REP_STEP -1
#endif
#define GL_REPF(k) for (int rr_ = 0; rr_ < ((GL_REP_STEP == (k)) ? 2 : 1); ++rr_)
#define GL_BAR() do { asm volatile("s_waitcnt lgkmcnt(0)" ::: "memory"); __builtin_amdgcn_s_barrier(); asm volatile("" ::: "memory"); } while (0)
__device__ __forceinline__ void gdn_local_item(const Params& P, LAS unsigned char* lds, int item, int tid) {
    unsigned char* ws = P.ws;
    asm volatile("" : "+v"(tid));
    const int b = item >> 9, h = (item >> 7) & 3, n = item & 127;
    const int t0 = b * SEQ + n * 64;
    const int lane = tid & 63, wave = __builtin_amdgcn_readfirstlane(tid >> 6);
    LAS float* ks = (LAS float*)(lds + GL_KS);
    LAS float* vs = (LAS float*)(lds + GL_VS);
    LAS bf16* kb16 = (LAS bf16*)(lds + GL_KB);
    LAS bf16* qb16 = (LAS bf16*)(lds + GL_QB);
    LAS bf16* raw = (LAS bf16*)(lds + GL_RAW);
    LAS float* cw = (LAS float*)(lds + GL_CW);
    LAS float* AmT = (LAS float*)(lds + GL_AMT);
    LAS float* sg = (LAS float*)(lds + GL_SM);
    LAS float* sbeta = sg + 64; LAS float* sgc = sbeta + 64; LAS float* seg = sgc + 64; LAS float* sek = seg + 64;
    LAS bf16* atts = (LAS bf16*)(lds + GL_ATT);
    const bf16* QKV = (const bf16*)(ws + WS_QKV);
    const float* AB = (const float*)(ws + WS_AB);
    GL_REPF(0) {
        v4u pr[7];
#pragma unroll
        for (int r = 0; r < 7; ++r) {
            const int id = tid + 512 * r;
            const int row = id / 48, rem = id - row * 48, part = rem >> 4, ck = rem & 15, s = n * 64 + row - 3;
            pr[r] = (v4u){0u, 0u, 0u, 0u};
            if (id < 67 * 48 && s >= 0) pr[r] = *(const v4u*)(QKV + (size_t)(b * SEQ + s) * 1536 + part * 512 + h * 128 + ck * 8);
        }
        f32x4 cwv = (f32x4){0.f, 0.f, 0.f, 0.f};
        if (tid < 384) { const int j = tid / 96, rem = tid - j * 96, part = rem >> 5, c4 = rem & 31; cwv = *(const f32x4*)(P.conv_qkv_w + j * 1536 + part * 512 + h * 128 + c4 * 4); }
        float a_in = 0.f, b_in = 0.f;
        if (tid < 64) { a_in = AB[(size_t)(t0 + tid) * 8 + h]; b_in = AB[(size_t)(t0 + tid) * 8 + 4 + h]; }
#pragma unroll
        for (int r = 0; r < 7; ++r) { const int id = tid + 512 * r; if (id < 67 * 48) *(LAS v4u*)(raw + id * 8) = pr[r]; }
        if (tid < 384) *(LAS f32x4*)(cw + tid * 4) = cwv;
        if (tid < 64) { sg[tid] = -__expf(P.gdn_a_log[h]) * softplusf_(a_in + P.gdn_dt_bias[h]); sbeta[tid] = sigmoidf_(b_in); }
    }
    GL_BAR();
    GL_REPF(1) {
        const int c = tid >> 3, grp = tid & 7;
#pragma unroll 1
        for (int part = 0; part < 3; ++part) {
            float y[16];
#pragma unroll
            for (int i = 0; i < 16; ++i) y[i] = 0.f;
#pragma unroll
            for (int j = 0; j < 4; ++j) {
                const LAS v4u* src = (const LAS v4u*)(raw + (c + j) * 384 + part * 128 + grp * 16);
                const v4u x0 = src[0], x1 = src[1];
                const LAS f32x4* wp = (const LAS f32x4*)(cw + (j * 3 + part) * 128 + grp * 16);
                const f32x4 w0 = wp[0], w1 = wp[1], w2 = wp[2], w3 = wp[3];
                y[0] += w0.x * bflo(x0.x); y[1] += w0.y * bfhi(x0.x); y[2] += w0.z * bflo(x0.y); y[3] += w0.w * bfhi(x0.y);
                y[4] += w1.x * bflo(x0.z); y[5] += w1.y * bfhi(x0.z); y[6] += w1.z * bflo(x0.w); y[7] += w1.w * bfhi(x0.w);
                y[8] += w2.x * bflo(x1.x); y[9] += w2.y * bfhi(x1.x); y[10] += w2.z * bflo(x1.y); y[11] += w2.w * bfhi(x1.y);
                y[12] += w3.x * bflo(x1.z); y[13] += w3.y * bfhi(x1.z); y[14] += w3.z * bflo(x1.w); y[15] += w3.w * bfhi(x1.w);
            }
            float ss = 0.f;
#pragma unroll
            for (int i = 0; i < 16; ++i) { y[i] = siluf_(y[i]); ss += y[i] * y[i]; }
            if (part < 2) {
                ss += __shfl_xor(ss, 1); ss += __shfl_xor(ss, 2); ss += __shfl_xor(ss, 4);
                const float sc = rsqrtf(ss + 1e-6f) * (part == 0 ? 0.08838834764831845f : 1.0f);
#pragma unroll
                for (int i = 0; i < 16; ++i) y[i] *= sc;
            }
            if (part >= 1) {
                LAS float* dst = (part == 1 ? ks : vs) + c * 132 + grp * 16;
#pragma unroll
                for (int i = 0; i < 4; ++i) *(LAS f32x4*)(dst + 4 * i) = (f32x4){y[4 * i], y[4 * i + 1], y[4 * i + 2], y[4 * i + 3]};
            }
            if (part <= 1) {
                LAS bf16* dst = (part == 0 ? qb16 : kb16) + c * 136 + grp * 16;
                v4u o0, o1; o0.x = pk2(y[0], y[1]); o0.y = pk2(y[2], y[3]); o0.z = pk2(y[4], y[5]); o0.w = pk2(y[6], y[7]);
                o1.x = pk2(y[8], y[9]); o1.y = pk2(y[10], y[11]); o1.z = pk2(y[12], y[13]); o1.w = pk2(y[14], y[15]);
                *(LAS v4u*)dst = o0; *(LAS v4u*)(dst + 8) = o1;
            }
        }
    }
    if (tid < 64) {
        float v = sg[tid];
#pragma unroll
        for (int off = 1; off < 64; off <<= 1) { const float t = __shfl_up(v, off); if (tid >= off) v += t; }
        sgc[tid] = v; seg[tid] = __expf(v);
        const float gl = __shfl(v, 63);
        sek[tid] = __expf(gl - v);
        if (tid == 63) sek[64] = __expf(v);
    }
    GL_BAR();
    {
        const int mat = wave >> 2, rho = wave & 3, col = lane & 15, g = lane >> 4;
        const LAS bf16* X = mat ? qb16 : kb16;
        bf16x8 af[4];
#pragma unroll
        for (int s = 0; s < 4; ++s) af[s] = *(const LAS bf16x8*)(X + (16 * rho + col) * 136 + 32 * s + 8 * g);
#pragma unroll
        for (int sig = 0; sig < 4; ++sig) {
            f32x4 acc = (f32x4){0.f, 0.f, 0.f, 0.f};
#pragma unroll
            for (int s = 0; s < 4; ++s) { const bf16x8 bfr = *(const LAS bf16x8*)(kb16 + (16 * sig + col) * 136 + 32 * s + 8 * g); acc = __builtin_amdgcn_mfma_f32_16x16x32_bf16(af[s], bfr, acc, 0, 0, 0); }
            const int sidx = 16 * sig + col; const float gs = sgc[sidx];
#pragma unroll
            for (int i = 0; i < 4; ++i) {
                const int c = 16 * rho + 4 * g + i;
                const float dec = (c >= sidx) ? __expf(sgc[c] - gs) : 0.f;
                if (mat == 0) AmT[sidx * 68 + c] = (c > sidx) ? sbeta[c] * acc[i] * dec : 0.f;
                else atts[c * 64 + sidx] = (bf16)f2bf(acc[i] * dec);
            }
        }
    }
    GL_BAR();
    GL_REPF(4) {
        bf16* QD = (bf16*)(ws + WS_QD) + (size_t)item * 8192;
        bf16* KD = (bf16*)(ws + WS_KD) + (size_t)item * 8192;
        bf16* ATT = (bf16*)(ws + WS_ATT) + (size_t)item * 4096;
#pragma unroll
        for (int r = 0; r < 2; ++r) {
            const int id = tid + 512 * r;
            { const int c = id >> 4, gam = id & 15, s32 = gam >> 2, g = gam & 3;
              const v2u lo = *(const LAS v2u*)(qb16 + c * 136 + 32 * s32 + 4 * g), hi = *(const LAS v2u*)(qb16 + c * 136 + 32 * s32 + 16 + 4 * g);
              const float e = seg[c];
              v4u o; o.x = pk2(bflo(lo.x) * e, bfhi(lo.x) * e); o.y = pk2(bflo(lo.y) * e, bfhi(lo.y) * e); o.z = pk2(bflo(hi.x) * e, bfhi(hi.x) * e); o.w = pk2(bflo(hi.y) * e, bfhi(hi.y) * e);
              st16_wt(QD + c * 128 + 8 * gam, o); }
            { const int dk = id >> 3, gam = id & 7, s32 = gam >> 2, g = gam & 3, c0 = 32 * s32 + 4 * g;
              float v[8];
#pragma unroll
              for (int j = 0; j < 4; ++j) { v[j] = ks[(c0 + j) * 132 + dk] * sek[c0 + j]; v[4 + j] = ks[(c0 + 16 + j) * 132 + dk] * sek[c0 + 16 + j]; }
              v4u o; o.x = pk2(v[0], v[1]); o.y = pk2(v[2], v[3]); o.z = pk2(v[4], v[5]); o.w = pk2(v[6], v[7]);
              st16_wt(KD + dk * 64 + 8 * gam, o); }
        }
        { const int c = tid >> 3, gam = tid & 7, s32 = gam >> 2, g = gam & 3;
          const v2u lo = *(const LAS v2u*)(atts + c * 64 + 32 * s32 + 4 * g), hi = *(const LAS v2u*)(atts + c * 64 + 32 * s32 + 16 + 4 * g);
          v4u o; o.x = lo.x; o.y = lo.y; o.z = hi.x; o.w = hi.y;
          st16_wt(ATT + c * 64 + 8 * gam, o); }
    }
    GL_BAR();
    GL_REPF(5) {
        LAS float* xcol = (LAS float*)(lds + GL_SOL);
        LAS bf16* tinv = (LAS bf16*)(lds + GL_SOL + 17408);
        const int j = tid >> 3, part = tid & 7, jb = j >> 4, jo = j & 15;
#pragma unroll 1
        for (int rb = jb; rb < 4; ++rb) {
            float acc[16];
#pragma unroll
            for (int i = 0; i < 16; ++i) acc[i] = 0.f;
            if (rb > jb) {
#pragma unroll 2
                for (int s = 16 * jb + part; s < 16 * rb; s += 8) {
                    const float sv = xcol[j * 68 + s];
                    const LAS float* ar = AmT + s * 68 + 16 * rb;
#pragma unroll
                    for (int q = 0; q < 4; ++q) { const f32x4 A4 = *(const LAS f32x4*)(ar + 4 * q);
                        acc[4 * q] -= A4.x * sv; acc[4 * q + 1] -= A4.y * sv; acc[4 * q + 2] -= A4.z * sv; acc[4 * q + 3] -= A4.w * sv; }
                }
#pragma unroll
                for (int i = 0; i < 16; ++i) {
                    acc[i] += __builtin_bit_cast(float, __builtin_amdgcn_update_dpp(0, __builtin_bit_cast(int, acc[i]), 0xB1, 0xF, 0xF, true));
                    acc[i] += __builtin_bit_cast(float, __builtin_amdgcn_update_dpp(0, __builtin_bit_cast(int, acc[i]), 0x4E, 0xF, 0xF, true));
                    acc[i] += __builtin_bit_cast(float, __builtin_amdgcn_update_dpp(0, __builtin_bit_cast(int, acc[i]), 0x141, 0xF, 0xF, true));
                }
            } else {
#pragma unroll
                for (int i = 0; i < 16; ++i) acc[i] = (i == jo) ? 1.f : 0.f;
            }
#pragma unroll
            for (int i = 0; i < 16; ++i) {
                const float sv = acc[i];
                const LAS float* ar = AmT + (16 * rb + i) * 68 + 16 * rb;
#pragma unroll
                for (int q = (i + 1) / 4; q < 4; ++q) { const f32x4 A4 = *(const LAS f32x4*)(ar + 4 * q);
                    if (4 * q > i) acc[4 * q] -= A4.x * sv; if (4 * q + 1 > i) acc[4 * q + 1] -= A4.y * sv; if (4 * q + 2 > i) acc[4 * q + 2] -= A4.z * sv; if (4 * q + 3 > i) acc[4 * q + 3] -= A4.w * sv; }
            }
            if (part == 0) {
#pragma unroll
                for (int i = 0; i < 16; ++i) { xcol[j * 68 + 16 * rb + i] = acc[i]; tinv[(16 * rb + i) * 72 + j] = (bf16)f2bf(acc[i]); }
            }
            LDS_WAIT(); asm volatile("" ::: "memory");
        }
        for (int rb = 0; rb < jb; ++rb) {
            if (part == 0) {
#pragma unroll
                for (int i = 0; i < 16; ++i) tinv[(16 * rb + i) * 72 + j] = (bf16)0;
            }
        }
    }
    GL_BAR();
    GL_REPF(6) {
        const LAS bf16* tinv = (const LAS bf16*)(lds + GL_SOL + 17408);
        LAS bf16* wst = (LAS bf16*)(lds + GL_SOL + 17408 + 9216);
        const int col = lane & 15, g = lane >> 4, isw = wave >> 2;
        bf16x8 af[4][2];
#pragma unroll
        for (int rho = 0; rho < 4; ++rho)
#pragma unroll
            for (int s2 = 0; s2 < 2; ++s2) af[rho][s2] = *(const LAS bf16x8*)(tinv + (16 * rho + col) * 72 + 32 * s2 + 8 * g);
        bf16* UF = (bf16*)(ws + WS_UF) + (size_t)item * 8192;
#pragma unroll
        for (int sig = 0; sig < 2; ++sig) {
            const int jj = 32 * (wave & 3) + 16 * sig + col;
            const LAS float* src = (isw ? ks : vs) + jj;
            bf16x8 bfr[2];
#pragma unroll
            for (int s2 = 0; s2 < 2; ++s2) {
                float v[8];
#pragma unroll
                for (int e = 0; e < 8; ++e) { const int sidx = 32 * s2 + 8 * g + e; float x = src[sidx * 132] * sbeta[sidx]; if (isw) x *= seg[sidx]; v[e] = x; }
                v4u pk; pk.x = pk2(v[0], v[1]); pk.y = pk2(v[2], v[3]); pk.z = pk2(v[4], v[5]); pk.w = pk2(v[6], v[7]);
                bfr[s2] = __builtin_bit_cast(bf16x8, pk);
            }
            f32x4 acc[4];
#pragma unroll
            for (int rho = 0; rho < 4; ++rho) { acc[rho] = (f32x4){0.f, 0.f, 0.f, 0.f};
#pragma unroll
                for (int s2 = 0; s2 < 2; ++s2) acc[rho] = __builtin_amdgcn_mfma_f32_16x16x32_bf16(af[rho][s2], bfr[s2], acc[rho], 0, 0, 0); }
            if (!isw) {
                v4u o0, o1;
                o0.x = pk2(acc[0].x, acc[0].y); o0.y = pk2(acc[0].z, acc[0].w); o0.z = pk2(acc[1].x, acc[1].y); o0.w = pk2(acc[1].z, acc[1].w);
                o1.x = pk2(acc[2].x, acc[2].y); o1.y = pk2(acc[2].z, acc[2].w); o1.z = pk2(acc[3].x, acc[3].y); o1.w = pk2(acc[3].z, acc[3].w);
                v4u* d = (v4u*)(UF + (size_t)(2 * (wave & 3) + sig) * 1024 + lane * 16);
                st16_wt(d, o0); st16_wt(d + 1, o1);
            } else {
#pragma unroll
                for (int rho = 0; rho < 4; ++rho)
#pragma unroll
                    for (int i = 0; i < 4; ++i) wst[(16 * rho + 4 * g + i) * 136 + jj] = (bf16)f2bf(-acc[rho][i]);
            }
        }
    }
    GL_BAR();
    {
        const LAS bf16* wst = (const LAS bf16*)(lds + GL_SOL + 17408 + 9216);
        bf16* WN = (bf16*)(ws + WS_WN) + (size_t)item * 8192;
#pragma unroll
        for (int r = 0; r < 2; ++r) {
            const int id = tid + 512 * r, c = id >> 4, gam = id & 15, s32 = gam >> 2, g = gam & 3;
            const v2u lo = *(const LAS v2u*)(wst + c * 136 + 32 * s32 + 4 * g), hi = *(const LAS v2u*)(wst + c * 136 + 32 * s32 + 16 + 4 * g);
            v4u o; o.x = lo.x; o.y = lo.y; o.z = hi.x; o.w = hi.y;
            st16_wt(WN + c * 128 + 8 * gam, o);
        }
    }
    asm volatile("s_waitcnt vmcnt(0)" ::: "memory");
    GL_BAR();
    if (tid == 0) { unsigned fb = __builtin_bit_cast(unsigned, sek[64]); if (fb == 0u) fb = 1u;
        __hip_atomic_store((unsigned*)(ws + WS_CTL) + CW_GFLAG + item, fb, __ATOMIC_RELAXED, __HIP_MEMORY_SCOPE_AGENT); }
    GL_BAR();
}

constexpr int LL_XCB = 68608;
static_assert(LL_XCB + 64 * 1040 <= MISC_OFF, "lru_local LDS map");
__device__ __forceinline__ float expm1_small(float x) {
    const float p = x * (1.0f + x * (0.5f + x * (0.16666667f + x * (0.041666668f + x * 0.008333334f))));
    return (x > -0.25f) ? p : (__expf(x) - 1.0f);
}
__device__ __forceinline__ void lru_local_item(const Params& P, LAS unsigned char* lds, int lt, int tid, int lane, int wave) {
    unsigned char* ws = P.ws;
    asm volatile("" : "+v"(tid));
    const int b = lt >> 7, n = lt & 127, t0 = b * SEQ + n * 64;
    LAS bf16* rawx = (LAS bf16*)lds;
    LAS bf16* xcb = (LAS bf16*)(lds + LL_XCB);
    const bf16* XR = (const bf16*)(ws + WS_XR);
    {
        v4u pr[9];
#pragma unroll
        for (int r = 0; r < 9; ++r) { const int id = tid + 512 * r, row = id >> 6, ck = id & 63, s = n * 64 + row - 3;
            pr[r] = (v4u){0u, 0u, 0u, 0u};
            if (id < 67 * 64 && s >= 0) pr[r] = *(const v4u*)(XR + (size_t)(b * SEQ + s) * 512 + ck * 8); }
#pragma unroll
        for (int r = 0; r < 9; ++r) { const int id = tid + 512 * r; if (id < 67 * 64) *(LAS v4u*)(rawx + id * 8) = pr[r]; }
    }
    GL_BAR();
    {
        const int chg = tid & 63, tseg = tid >> 6, ch0 = chg * 8;
        float w[4][8], cb[8];
#pragma unroll
        for (int j = 0; j < 4; ++j) { const f32x4 a = *(const f32x4*)(P.lru_conv_w + j * 512 + ch0), c = *(const f32x4*)(P.lru_conv_w + j * 512 + ch0 + 4);
            w[j][0] = a.x; w[j][1] = a.y; w[j][2] = a.z; w[j][3] = a.w; w[j][4] = c.x; w[j][5] = c.y; w[j][6] = c.z; w[j][7] = c.w; }
        { const f32x4 a = *(const f32x4*)(P.lru_conv_b + ch0), c = *(const f32x4*)(P.lru_conv_b + ch0 + 4);
          cb[0] = a.x; cb[1] = a.y; cb[2] = a.z; cb[3] = a.w; cb[4] = c.x; cb[5] = c.y; cb[6] = c.z; cb[7] = c.w; }
        v4u xr[11];
#pragma unroll
        for (int r = 0; r < 11; ++r) xr[r] = *(const LAS v4u*)(rawx + (tseg * 8 + r) * 512 + ch0);
#pragma unroll
        for (int tk = 0; tk < 8; ++tk) {
            float y[8];
#pragma unroll
            for (int e = 0; e < 8; ++e) y[e] = cb[e];
#pragma unroll
            for (int j = 0; j < 4; ++j) { const v4u x = xr[tk + j];
                y[0] += w[j][0] * bflo(x.x); y[1] += w[j][1] * bfhi(x.x); y[2] += w[j][2] * bflo(x.y); y[3] += w[j][3] * bfhi(x.y);
                y[4] += w[j][4] * bflo(x.z); y[5] += w[j][5] * bfhi(x.z); y[6] += w[j][6] * bflo(x.w); y[7] += w[j][7] * bfhi(x.w); }
            v4u o; o.x = pk2(y[0], y[1]); o.y = pk2(y[2], y[3]); o.z = pk2(y[4], y[5]); o.w = pk2(y[6], y[7]);
            *(LAS v4u*)(xcb + (tseg * 8 + tk) * 520 + ch0) = o;
        }
    }
    GL_BAR();
    {
        const int g = wave, col = lane & 15, g4 = lane >> 4;
        LAS bf16* AM = (LAS bf16*)(lds + wave * 8192); LAS bf16* BT = AM + 2048;
        const bf16* WT = (const bf16*)(ws + WS_LRUWT) + (size_t)g * 8192;
        bf16x8 Bw[2][4][2];
#pragma unroll
        for (int m = 0; m < 2; ++m)
#pragma unroll
            for (int jt = 0; jt < 4; ++jt)
#pragma unroll
                for (int s2 = 0; s2 < 2; ++s2) Bw[m][jt][s2] = *(const bf16x8*)(WT + m * 4096 + (16 * jt + col) * 64 + 32 * s2 + 8 * g4);
        float cba[4], cbx[4], csp[4];
#pragma unroll
        for (int jt = 0; jt < 4; ++jt) { const int ch = g * 64 + 16 * jt + col; cba[jt] = P.lru_ba[ch]; cbx[jt] = P.lru_bx[ch]; csp[jt] = softplusf_(-P.lru_lambda[ch]); }
        bf16* HLOC = (bf16*)(ws + WS_HLOC); bf16* PCUM = (bf16*)(ws + WS_PCUM);
        const int chs = g * 64 + lane;
        float hst = 0.f, pc = 1.f;
#pragma unroll 1
        for (int half = 0; half < 2; ++half) {
            bf16x8 Af[2][2];
#pragma unroll
            for (int rho = 0; rho < 2; ++rho)
#pragma unroll
                for (int s2 = 0; s2 < 2; ++s2) Af[rho][s2] = *(const LAS bf16x8*)(xcb + (32 * half + 16 * rho + col) * 520 + g * 64 + 32 * s2 + 8 * g4);
#pragma unroll
            for (int jt = 0; jt < 4; ++jt) {
#pragma unroll
                for (int rho = 0; rho < 2; ++rho) {
                    f32x4 ra = (f32x4){0.f, 0.f, 0.f, 0.f}, rx = ra;
#pragma unroll
                    for (int s2 = 0; s2 < 2; ++s2) { ra = __builtin_amdgcn_mfma_f32_16x16x32_bf16(Af[rho][s2], Bw[0][jt][s2], ra, 0, 0, 0); rx = __builtin_amdgcn_mfma_f32_16x16x32_bf16(Af[rho][s2], Bw[1][jt][s2], rx, 0, 0, 0); }
#pragma unroll
                    for (int i = 0; i < 4; ++i) {
                        const int tokl = 16 * rho + 4 * g4 + i, chl = 16 * jt + col;
                        const float r = sigmoidf_(ra[i] + cba[jt]), ig = sigmoidf_(rx[i] + cbx[jt]);
                        const float log_a = -8.0f * r * csp[jt];
                        const float am = -expm1_small(log_a), a = 1.0f - am;
                        const float xo = bf1(xcb[(32 * half + tokl) * 520 + g * 64 + chl]);
                        const float bt = __builtin_amdgcn_sqrtf(fmaxf(am * (1.0f + a), 0.f)) * (ig * xo);
                        AM[tokl * 64 + chl] = (bf16)f2bf(am); BT[tokl * 64 + chl] = (bf16)f2bf(bt);
                    }
                }
            }
            LDS_WAIT(); asm volatile("" ::: "memory");
#pragma unroll 8
            for (int tk = 0; tk < 32; ++tk) {
                const float am = bf1(AM[tk * 64 + lane]), bt = bf1(BT[tk * 64 + lane]);
                hst = (hst - am * hst) + bt; pc = pc - am * pc;
                const size_t o = (size_t)(t0 + 32 * half + tk) * 512 + chs;
                HLOC[o] = (bf16)f2bf(hst); PCUM[o] = (bf16)f2bf(pc);
            }
            LDS_WAIT(); asm volatile("" ::: "memory");
        }
        ((float*)(ws + WS_HEND))[(size_t)lt * 512 + chs] = hst; ((float*)(ws + WS_PEND))[(size_t)lt * 512 + chs] = pc;
    }
    GL_BAR();
}

constexpr int SC_WN = 0, SC_QD = 64 * 272, SC_KD = 2 * 64 * 272, SC_ATT = 2 * 64 * 272 + 128 * 144, SC_BUF = 2 * 64 * 272 + 128 * 144 + 64 * 144;
constexpr int SC_SSQ = 2 * SC_BUF;
__device__ __forceinline__ int sc_lds_off(int id) {
    if (id < 1024) return SC_WN + (id >> 4) * 272 + (id & 15) * 16;
    if (id < 2048) { const int q = id - 1024; return SC_QD + (q >> 4) * 272 + (q & 15) * 16; }
    if (id < 3072) { const int q = id - 2048; return SC_KD + (q >> 3) * 144 + (q & 7) * 16; }
    const int q = id - 3072; return SC_ATT + (q >> 3) * 144 + (q & 7) * 16;
}
__device__ __forceinline__ const v4u* sc_src(const unsigned char* ws, int item, int id) {
    if (id < 1024) return (const v4u*)(ws + WS_WN + (size_t)item * 16384) + id;
    if (id < 2048) return (const v4u*)(ws + WS_QD + (size_t)item * 16384) + (id - 1024);
    if (id < 3072) return (const v4u*)(ws + WS_KD + (size_t)item * 16384) + (id - 2048);
    return (const v4u*)(ws + WS_ATT + (size_t)item * 8192) + (id - 3072);
}
__device__ __forceinline__ bf16x8 pack_b(const f32x4 a, const f32x4 b) {
    v4u r; r.x = pk2(a.x, a.y); r.y = pk2(a.z, a.w); r.z = pk2(b.x, b.y); r.w = pk2(b.z, b.w);
    return __builtin_bit_cast(bf16x8, r);
}
#define SC_BAR() do { asm volatile("s_waitcnt lgkmcnt(0)" ::: "memory"); __builtin_amdgcn_s_barrier(); asm volatile("" ::: "memory"); } while (0)
#define SC_GLD(dst, ptr) asm volatile("global_load_dwordx4 %0, %1, off" : "=v"(dst) : "v"(ptr) : "memory")
#define PIN8(a) asm volatile("" : "+v"(a[0]), "+v"(a[1]), "+v"(a[2]), "+v"(a[3]), "+v"(a[4]), "+v"(a[5]), "+v"(a[6]), "+v"(a[7]))
#define PIN16(a) asm volatile("" : "+v"(a[0]), "+v"(a[1]), "+v"(a[2]), "+v"(a[3]), "+v"(a[4]), "+v"(a[5]), "+v"(a[6]), "+v"(a[7]), "+v"(a[8]), "+v"(a[9]), "+v"(a[10]), "+v"(a[11]), "+v"(a[12]), "+v"(a[13]), "+v"(a[14]), "+v"(a[15]))
constexpr int SCAN_NWC = 2, SCAN_PARTS = 4, SCAN_WGS = 8 * SCAN_PARTS;
constexpr int SC_UFS = 2 * SC_BUF;
constexpr int SC_DECS = SC_UFS + 2 * SCAN_NWC * 2048;
constexpr int SC_OT = SC_DECS + 512;
constexpr int SC_RDY = SC_OT + 2 * 64 * 36 * 4;
constexpr int SC_END = SC_RDY + 64;
static_assert(SC_END <= MISC_OFF, "scan LDS");
#ifndef SCAN_REPS
#define SCAN_REPS 1
#endif
#ifndef SCAN_EXP
#define SCAN_EXP 0
#endif
__device__ __forceinline__ int sc3_lds_off(int id) {
    if (id < 3584) return sc_lds_off(id);
    return SC_UFS + (id - 3584) * 16;
}
__device__ __forceinline__ const v4u* sc3_src(const unsigned char* ws, int item, int id, int part) {
    if (id < 3584) return sc_src(ws, item, id);
    return (const v4u*)(ws + WS_UF + (size_t)item * 16384 + (size_t)(part * SCAN_NWC) * 2048) + (id - 3584);
}
__device__ __forceinline__ void gdn_scan(const Params& P, LAS unsigned char* lds, int sb, int tid, int lane, int wave) {
    const unsigned char* ws = P.ws;
    constexpr int NCH = 128 * SCAN_REPS, NPC = 15;
    const int bh = sb & 7, part = sb >> 3;
    const int b = bh >> 2, h = bh & 3, col = lane & 15, g = lane >> 4;
    const int item0 = bh * 128;
    if (tid == 0) *(volatile LAS unsigned*)(lds + SC_RDY) = 0u;
    SC_BAR();
    if (wave >= 4) {
        constexpr int NP = 15, DEP = 3;
        const int lt = tid - 256;
        const unsigned voff = (unsigned)lt * 16u;
        const int lA = (lt >> 4) * 272 + (lt & 15) * 16, lB = (lt >> 3) * 144 + (lt & 7) * 16, lU = SC_UFS + lt * 16;
        v4u rs[DEP][NP];
#define SC_ISSUE(set, itm) do { const unsigned char* gq_ = ws + (size_t)(itm) * 16384; const unsigned char* ga_ = ws + WS_ATT + (size_t)(itm) * 8192; \
            asm volatile("s_nop 4\n\tglobal_load_dwordx4 %0, %8, %9 sc0 sc1\n\tglobal_load_dwordx4 %1, %8, %10 sc0 sc1\n\tglobal_load_dwordx4 %2, %8, %11 sc0 sc1\n\tglobal_load_dwordx4 %3, %8, %12 sc0 sc1\n\t" \
                         "global_load_dwordx4 %4, %8, %13 sc0 sc1\n\tglobal_load_dwordx4 %5, %8, %14 sc0 sc1\n\tglobal_load_dwordx4 %6, %8, %15 sc0 sc1\n\tglobal_load_dwordx4 %7, %8, %16 sc0 sc1" \
                : "=&v"(rs[set][0]), "=&v"(rs[set][1]), "=&v"(rs[set][2]), "=&v"(rs[set][3]), "=&v"(rs[set][4]), "=&v"(rs[set][5]), "=&v"(rs[set][6]), "=&v"(rs[set][7]) \
                : "v"(voff), "s"(gq_ + WS_WN), "s"(gq_ + WS_WN + 4096), "s"(gq_ + WS_WN + 8192), "s"(gq_ + WS_WN + 12288), \
                  "s"(gq_ + WS_QD), "s"(gq_ + WS_QD + 4096), "s"(gq_ + WS_QD + 8192), "s"(gq_ + WS_QD + 12288) : "memory"); \
            asm volatile("s_nop 4\n\tglobal_load_dwordx4 %0, %7, %8 sc0 sc1\n\tglobal_load_dwordx4 %1, %7, %9 sc0 sc1\n\tglobal_load_dwordx4 %2, %7, %10 sc0 sc1\n\tglobal_load_dwordx4 %3, %7, %11 sc0 sc1\n\t" \
                         "global_load_dwordx4 %4, %7, %12 sc0 sc1\n\tglobal_load_dwordx4 %5, %7, %13 sc0 sc1\n\tglobal_load_dwordx4 %6, %7, %14 sc0 sc1" \
                : "=&v"(rs[set][8]), "=&v"(rs[set][9]), "=&v"(rs[set][10]), "=&v"(rs[set][11]), "=&v"(rs[set][12]), "=&v"(rs[set][13]), "=&v"(rs[set][14]) \
                : "v"(voff), "s"(gq_ + WS_KD), "s"(gq_ + WS_KD + 4096), "s"(gq_ + WS_KD + 8192), "s"(gq_ + WS_KD + 12288), \
                  "s"(ga_), "s"(ga_ + 4096), "s"(gq_ + WS_UF + (size_t)(part * SCAN_NWC) * 2048) : "memory"); } while (0)
#define SC_WAITSET(set, cnt) asm volatile("s_waitcnt " cnt : "+v"(rs[set][0]), "+v"(rs[set][1]), "+v"(rs[set][2]), "+v"(rs[set][3]), "+v"(rs[set][4]), "+v"(rs[set][5]), "+v"(rs[set][6]), "+v"(rs[set][7]), \
            "+v"(rs[set][8]), "+v"(rs[set][9]), "+v"(rs[set][10]), "+v"(rs[set][11]), "+v"(rs[set][12]), "+v"(rs[set][13]), "+v"(rs[set][14]) :: "memory")
#define SC_WRITE(set, par) do { LAS unsigned char* wb_ = lds + (par) * SC_BUF; \
            _Pragma("unroll") for (int r = 0; r < 4; ++r) { *(LAS v4u*)(wb_ + SC_WN + lA + r * (16 * 272)) = rs[set][r]; *(LAS v4u*)(wb_ + SC_QD + lA + r * (16 * 272)) = rs[set][4 + r]; \
                                                          *(LAS v4u*)(wb_ + SC_KD + lB + r * (32 * 144)) = rs[set][8 + r]; } \
            *(LAS v4u*)(wb_ + SC_ATT + lB) = rs[set][12]; *(LAS v4u*)(wb_ + SC_ATT + lB + 32 * 144) = rs[set][13]; \
            *(LAS v4u*)(lds + lU + (par) * (SCAN_NWC * 2048)) = rs[set][14]; } while (0)
#define SC_NEED(c) do { unsigned sp_ = 0; while (*(volatile LAS unsigned*)(lds + SC_RDY) <= (unsigned)(c) && ++sp_ < (1u << 24)) __builtin_amdgcn_s_sleep(2); } while (0)
        SC_NEED(0); SC_ISSUE(0, item0);
        SC_WAITSET(0, "vmcnt(0)"); SC_WRITE(0, 0); SC_WAITSET(0, "lgkmcnt(0)");
        SC_NEED(3); SC_ISSUE(1, item0 + 1); SC_ISSUE(2, item0 + 2); SC_ISSUE(0, item0 + 3);
        SC_BAR();
        int n2 = 0;
#define SC_INTERVAL(set) do { SC_WAITSET(set, "vmcnt(30)"); SC_WRITE(set, (n2 + 1) & 1); SC_WAITSET(set, "lgkmcnt(0)"); if (n2 + 1 + DEP < 128) SC_NEED(n2 + 1 + DEP); SC_ISSUE(set, item0 + ((n2 + 1 + DEP) & 127)); SC_BAR(); ++n2; } while (0)
#pragma unroll 1
        for (int it = 0; it < NCH / 3; ++it) { SC_INTERVAL(1); SC_INTERVAL(2); SC_INTERVAL(0); }
        if (NCH % 3 >= 1) SC_INTERVAL(1);
        if (NCH % 3 >= 2) SC_INTERVAL(2);
        SC_WAITSET(0, "vmcnt(0)"); SC_WAITSET(1, "vmcnt(0)"); SC_WAITSET(2, "vmcnt(0)");
#undef SC_INTERVAL
#undef SC_NEED
#undef SC_WRITE
#undef SC_WAITSET
#undef SC_ISSUE
        return;
    }
    if (wave == 3) {
        const unsigned* flags = (const unsigned*)(ws + WS_CTL) + CW_GFLAG + item0;
        unsigned rdy = 0;
#define SC_POLLSTEP() do { if (rdy < 128u) { const unsigned idx_ = rdy + (unsigned)lane; \
            const unsigned fv_ = (idx_ < 128u) ? __hip_atomic_load(flags + idx_, __ATOMIC_RELAXED, __HIP_MEMORY_SCOPE_AGENT) : 0u; \
            const unsigned long long m_ = __ballot(fv_ != 0u); const unsigned nrun_ = (m_ == ~0ull) ? 64u : (unsigned)__builtin_ctzll(~m_);     \
            if ((unsigned)lane < nrun_) ((LAS float*)(lds + SC_DECS))[idx_] = __builtin_bit_cast(float, fv_); \
            rdy += nrun_; LDS_WAIT(); if (lane == 0) *(volatile LAS unsigned*)(lds + SC_RDY) = rdy; } } while (0)
        { unsigned sp = 0; while (rdy < 4u && ++sp < (1u << 22)) { SC_POLLSTEP(); if (rdy < 4u) __builtin_amdgcn_s_sleep(16); } }
        SC_BAR();
#pragma unroll 1
        for (int n2 = 0; n2 < NCH; ++n2) {
            { const unsigned need = (unsigned)(n2 + 1 + 3) < 128u ? (unsigned)(n2 + 1 + 3) : 127u; unsigned sp = 0;
              while (rdy <= need && rdy < 128u && ++sp < (1u << 22)) { SC_POLLSTEP(); if (rdy <= need) __builtin_amdgcn_s_sleep(8); } }
            if (rdy < 128u && rdy < (unsigned)(n2 & 127) + 16u) SC_POLLSTEP();
            SC_BAR();
        }
#undef SC_POLLSTEP
        return;
    }
    if (wave == 2) {
        const int row = lane;
        bf16* Y = (bf16*)((unsigned char*)P.out + OUT_Y);
        float* SSQG = P.out;
        SC_BAR();
#pragma unroll 1
        for (int n2 = 0; n2 <= NCH; ++n2) {
            if (n2 > 0) {
                const int n = (n2 - 1) & 127, t = b * SEQ + n * 64 + row;
                const LAS float* src = (const LAS float*)(lds + SC_OT + ((n2 - 1) & 1) * (64 * 36 * 4)) + row * 36;
                f32x4 a[8]; float s2 = 0.f;
#pragma unroll
                for (int q = 0; q < 8; ++q) { a[q] = *(const LAS f32x4*)(src + 4 * q); s2 += (a[q].x * a[q].x + a[q].y * a[q].y) + (a[q].z * a[q].z + a[q].w * a[q].w); }
                SSQG[(size_t)t * 32 + h * 8 + part] = s2;
                v4u* d = (v4u*)(Y + (size_t)t * 1024 + h * 128 + 32 * part);
#pragma unroll
                for (int q = 0; q < 4; ++q) { v4u o; o.x = pk2(a[2 * q].x, a[2 * q].y); o.y = pk2(a[2 * q].z, a[2 * q].w); o.z = pk2(a[2 * q + 1].x, a[2 * q + 1].y); o.w = pk2(a[2 * q + 1].z, a[2 * q + 1].w); d[q] = o; }
            }
            if (n2 < NCH) SC_BAR();
        }
        return;
    }
    f32x4 S[8];
#pragma unroll
    for (int i = 0; i < 8; ++i) S[i] = (f32x4){0.f, 0.f, 0.f, 0.f};
    SC_BAR();
#pragma unroll 1
    for (int n2 = 0; n2 < NCH; ++n2) {
        if (SCAN_REPS > 1 && (n2 & 127) == 0) {
#pragma unroll
            for (int i = 0; i < 8; ++i) S[i] = (f32x4){0.f, 0.f, 0.f, 0.f};
        }
        if (SCAN_EXP == 2 && n2 < 128) { SC_BAR(); continue; }
        const int par = n2 & 1;
        LAS unsigned char* buf = lds + par * SC_BUF;
        bf16x8 fA[16], fB[16], fC[16], fD[8];
#pragma unroll
        for (int rho = 0; rho < 4; ++rho)
#pragma unroll
            for (int s = 0; s < 4; ++s) fA[rho * 4 + s] = *(const LAS bf16x8*)(buf + SC_WN + (16 * rho + col) * 272 + (32 * s + 8 * g) * 2);
#pragma unroll
        for (int rho = 0; rho < 4; ++rho)
#pragma unroll
            for (int s = 0; s < 4; ++s) fB[rho * 4 + s] = *(const LAS bf16x8*)(buf + SC_QD + (16 * rho + col) * 272 + (32 * s + 8 * g) * 2);
        const LAS v4u* ufp = (const LAS v4u*)(lds + SC_UFS + par * (SCAN_NWC * 2048) + wave * 2048 + lane * 32);
        const v4u uf0 = ufp[0], uf1 = ufp[1];
        const float dec = ((const LAS float*)(lds + SC_DECS))[n2 & 127];
        bf16x8 Bs[4];
#pragma unroll
        for (int s = 0; s < 4; ++s) Bs[s] = pack_b(S[2 * s], S[2 * s + 1]);
        f32x4 Vn[4], Oc[4];
        Vn[0] = (f32x4){bflo(uf0.x), bfhi(uf0.x), bflo(uf0.y), bfhi(uf0.y)}; Vn[1] = (f32x4){bflo(uf0.z), bfhi(uf0.z), bflo(uf0.w), bfhi(uf0.w)};
        Vn[2] = (f32x4){bflo(uf1.x), bfhi(uf1.x), bflo(uf1.y), bfhi(uf1.y)}; Vn[3] = (f32x4){bflo(uf1.z), bfhi(uf1.z), bflo(uf1.w), bfhi(uf1.w)};
        __builtin_amdgcn_sched_barrier(0);
        PIN16(fA);
#pragma unroll
        for (int s = 0; s < 4; ++s)
#pragma unroll
            for (int rho = 0; rho < 4; ++rho) Vn[rho] = __builtin_amdgcn_mfma_f32_16x16x32_bf16(fA[rho * 4 + s], Bs[s], Vn[rho], 0, 0, 0);
        __builtin_amdgcn_sched_barrier(0);
#pragma unroll
        for (int tau = 0; tau < 8; ++tau)
#pragma unroll
            for (int s = 0; s < 2; ++s) fC[tau * 2 + s] = *(const LAS bf16x8*)(buf + SC_KD + (16 * tau + col) * 144 + (32 * s + 8 * g) * 2);
        __builtin_amdgcn_sched_barrier(0);
        PIN16(fB);
#pragma unroll
        for (int rho = 0; rho < 4; ++rho) Oc[rho] = (f32x4){0.f, 0.f, 0.f, 0.f};
#pragma unroll
        for (int s = 0; s < 4; ++s)
#pragma unroll
            for (int rho = 0; rho < 4; ++rho) Oc[rho] = __builtin_amdgcn_mfma_f32_16x16x32_bf16(fB[rho * 4 + s], Bs[s], Oc[rho], 0, 0, 0);
        __builtin_amdgcn_sched_barrier(0);
#pragma unroll
        for (int rho = 0; rho < 4; ++rho)
#pragma unroll
            for (int s = 0; s < 2; ++s) fD[rho * 2 + s] = *(const LAS bf16x8*)(buf + SC_ATT + (16 * rho + col) * 144 + (32 * s + 8 * g) * 2);
        bf16x8 Bv[2];
        Bv[0] = pack_b(Vn[0], Vn[1]); Bv[1] = pack_b(Vn[2], Vn[3]);
#pragma unroll
        for (int tau = 0; tau < 8; ++tau) S[tau] = S[tau] * dec;
        __builtin_amdgcn_sched_barrier(0);
        PIN16(fC);
#pragma unroll
        for (int s = 0; s < 2; ++s)
#pragma unroll
            for (int tau = 0; tau < 8; ++tau) S[tau] = __builtin_amdgcn_mfma_f32_16x16x32_bf16(fC[tau * 2 + s], Bv[s], S[tau], 0, 0, 0);
        __builtin_amdgcn_sched_barrier(0);
        PIN8(fD);
#pragma unroll
        for (int s = 0; s < 2; ++s)
#pragma unroll
            for (int rho = 0; rho < 4; ++rho) Oc[rho] = __builtin_amdgcn_mfma_f32_16x16x32_bf16(fD[rho * 2 + s], Bv[s], Oc[rho], 0, 0, 0);
        LAS float* ot = (LAS float*)(lds + SC_OT + par * (64 * 36 * 4)) + 16 * wave + col;
#pragma unroll
        for (int rho = 0; rho < 4; ++rho)
#pragma unroll
            for (int i = 0; i < 4; ++i) ot[(16 * rho + 4 * g + i) * 36] = Oc[rho][i];
        SC_BAR();
    }
}

__device__ __forceinline__ void lru_carry(const Params& P, int gwv, int lane) {
    unsigned char* ws = P.ws;
    const int b = gwv >> 3, g = gwv & 7, ch = g * 64 + lane;
    const float* HEND = (const float*)(ws + WS_HEND); const float* PEND = (const float*)(ws + WS_PEND); float* HIN = (float*)(ws + WS_HIN);
    float hin = 0.f;
#pragma unroll 1
    for (int n0 = 0; n0 < 128; n0 += 16) {
        float he[16], pe[16];
#pragma unroll
        for (int i = 0; i < 16; ++i) { const size_t o = (size_t)(b * 128 + n0 + i) * 512 + ch; he[i] = HEND[o]; pe[i] = PEND[o]; }
#pragma unroll
        for (int i = 0; i < 16; ++i) { HIN[(size_t)(b * 128 + n0 + i) * 512 + ch] = hin; hin = he[i] + pe[i] * hin; }
    }
}

__device__ __forceinline__ void cvt_table(const float* src, bf16* dst, size_t n8, size_t wi, size_t nw) {
    for (size_t i = wi; i < n8; i += nw) {
        const f32x4 a = ((const f32x4*)src)[2 * i], c = ((const f32x4*)src)[2 * i + 1];
        v4u o; o.x = pk2(a.x, a.y); o.y = pk2(a.z, a.w); o.z = pk2(c.x, c.y); o.w = pk2(c.z, c.w);
        ((v4u*)dst)[i] = o;
    }
}

__device__ __forceinline__ void lru_combine(const Params& P, size_t wi, size_t nw) {
    unsigned char* ws = P.ws;
    const v4u* HLOC = (const v4u*)(ws + WS_HLOC); const v4u* PCUM = (const v4u*)(ws + WS_PCUM); const v4u* GATE = (const v4u*)(ws + WS_GATE);
    const float* HIN = (const float*)(ws + WS_HIN); bf16* Y = (bf16*)((unsigned char*)P.out + OUT_Y);
    for (size_t i = wi; i < (size_t)T * 64; i += nw) {
        const size_t t = i >> 6; const int ch0 = (int)(i & 63) * 8;
        const v4u hl = HLOC[i], pc = PCUM[i], gt = GATE[i];
        const f32x4 h0 = *(const f32x4*)(HIN + (t >> 6) * 512 + ch0), h1 = *(const f32x4*)(HIN + (t >> 6) * 512 + ch0 + 4);
        float y[8];
        y[0] = (bflo(hl.x) + bflo(pc.x) * h0.x) * gelu_tanh(bflo(gt.x)); y[1] = (bfhi(hl.x) + bfhi(pc.x) * h0.y) * gelu_tanh(bfhi(gt.x));
        y[2] = (bflo(hl.y) + bflo(pc.y) * h0.z) * gelu_tanh(bflo(gt.y)); y[3] = (bfhi(hl.y) + bfhi(pc.y) * h0.w) * gelu_tanh(bfhi(gt.y));
        y[4] = (bflo(hl.z) + bflo(pc.z) * h1.x) * gelu_tanh(bflo(gt.z)); y[5] = (bfhi(hl.z) + bfhi(pc.z) * h1.y) * gelu_tanh(bfhi(gt.z));
        y[6] = (bflo(hl.w) + bflo(pc.w) * h1.z) * gelu_tanh(bflo(gt.w)); y[7] = (bfhi(hl.w) + bfhi(pc.w) * h1.w) * gelu_tanh(bfhi(gt.w));
        v4u o; o.x = pk2(y[0], y[1]); o.y = pk2(y[2], y[3]); o.z = pk2(y[4], y[5]); o.w = pk2(y[6], y[7]);
        *(v4u*)(Y + t * 1024 + 512 + ch0) = o;
    }
}

__device__ __forceinline__ void gdn_gate_norm(const Params& P, size_t wi, size_t nw) {
    unsigned char* ws = P.ws;
    bf16* Y = (bf16*)((unsigned char*)P.out + OUT_Y); const v4u* Z = (const v4u*)(ws + WS_Z); const float* SSQG = P.out;
    for (size_t i = wi; i < (size_t)T * 64; i += nw) {
        const size_t t = i >> 6; const int c0 = (int)(i & 63) * 8, h = c0 >> 7;
        const f32x4 q0 = *(const f32x4*)(SSQG + t * 32 + h * 8);
        const float rstd = rsqrtf(((q0.x + q0.y) + (q0.z + q0.w)) * (1.0f / 128.0f) + 1e-6f);
        const v4u o = *(const v4u*)(Y + t * 1024 + c0), z = Z[i];
        const f32x4 w0 = *(const f32x4*)(P.gdn_norm_w + (c0 & 127)), w1 = *(const f32x4*)(P.gdn_norm_w + (c0 & 127) + 4);
        float y[8];
        y[0] = bflo(o.x) * rstd * w0.x * siluf_(bflo(z.x)); y[1] = bfhi(o.x) * rstd * w0.y * siluf_(bfhi(z.x));
        y[2] = bflo(o.y) * rstd * w0.z * siluf_(bflo(z.y)); y[3] = bfhi(o.y) * rstd * w0.w * siluf_(bfhi(z.y));
        y[4] = bflo(o.z) * rstd * w1.x * siluf_(bflo(z.z)); y[5] = bfhi(o.z) * rstd * w1.y * siluf_(bfhi(z.z));
        y[6] = bflo(o.w) * rstd * w1.z * siluf_(bflo(z.w)); y[7] = bfhi(o.w) * rstd * w1.w * siluf_(bfhi(z.w));
        v4u r; r.x = pk2(y[0], y[1]); r.y = pk2(y[2], y[3]); r.z = pk2(y[4], y[5]); r.w = pk2(y[6], y[7]);
        *(v4u*)(Y + t * 1024 + c0) = r;
    }
}

__device__ __forceinline__ void xattn_stage(LAS unsigned char* lds, const bf16* src, int tid) {
    v4u tmp[16];
    const unsigned voff = (unsigned)tid * 16u;
#pragma unroll
    for (int r = 0; r < 16; ++r) { const unsigned char* sb = (const unsigned char*)src + r * 8192;
        asm volatile("s_nop 4\n\tglobal_load_dwordx4 %0, %1, %2" : "=&v"(tmp[r]) : "v"(voff), "s"(sb) : "memory"); }
    asm volatile("s_waitcnt vmcnt(0)" : "+v"(tmp[0]), "+v"(tmp[1]), "+v"(tmp[2]), "+v"(tmp[3]), "+v"(tmp[4]), "+v"(tmp[5]), "+v"(tmp[6]), "+v"(tmp[7]),
                                        "+v"(tmp[8]), "+v"(tmp[9]), "+v"(tmp[10]), "+v"(tmp[11]), "+v"(tmp[12]), "+v"(tmp[13]), "+v"(tmp[14]), "+v"(tmp[15]) :: "memory");
#pragma unroll
    for (int r = 0; r < 16; ++r) { const int id = tid + 512 * r; *(LAS v4u*)(lds + (id >> 5) * 528 + (id & 31) * 16) = tmp[r]; }
}
__device__ __forceinline__ void xattn_unit(const Params& P, LAS unsigned char* lds, int unit, int tid, int lane, int wave) {
    const unsigned char* ws = P.ws;
    const int h = unit & 3, qb = (unit >> 2) & 63, b = unit >> 8, col = lane & 15, g = lane >> 4;
    const int tw = b * SEQ + qb * 128 + 16 * wave;
    const bf16* Kb = (const bf16*)(ws + WS_KB) + (size_t)((b * 4 + h) * 256) * 256;
    const bf16* Vt = (const bf16*)(ws + WS_VTP) + (size_t)((b * 4 + h) * 256) * 256;
    xattn_stage(lds, Kb, tid);
    __syncthreads();
    const LAS unsigned char* arow = lds + col * 528 + g * 16;
    bf16x8 Bp[1][8]; float inv[1];
#pragma unroll
    for (int ps = 0; ps < 1; ++ps) {
        const bf16* Q = (const bf16*)(ws + WS_Q) + (size_t)(tw + 16 * ps + col) * 1024 + h * 256 + 8 * g;
        bf16x8 Bq[8];
#pragma unroll
        for (int s = 0; s < 8; ++s) Bq[s] = *(const bf16x8*)(Q + 32 * s);
        f32x4 St[16];
        bf16x8 fr[2][8];
#pragma unroll
        for (int s = 0; s < 8; ++s) fr[0][s] = *(const LAS bf16x8*)(arow + 64 * s);
#pragma unroll
        for (int kap = 0; kap < 16; ++kap) {
            if (kap + 1 < 16) {
#pragma unroll
                for (int s = 0; s < 8; ++s) fr[(kap + 1) & 1][s] = *(const LAS bf16x8*)(arow + (16 * (kap + 1)) * 528 + 64 * s);
            }
            __builtin_amdgcn_sched_barrier(0);
            PIN8(fr[kap & 1]);
            f32x4 acc = (f32x4){0.f, 0.f, 0.f, 0.f};
#pragma unroll
            for (int s = 0; s < 8; ++s) acc = __builtin_amdgcn_mfma_f32_16x16x32_bf16(fr[kap & 1][s], Bq[s], acc, 0, 0, 0);
            St[kap] = acc;
            __builtin_amdgcn_sched_barrier(0);
        }
        float mx = -3.0e38f;
#pragma unroll
        for (int kap = 0; kap < 16; ++kap) mx = fmaxf(fmaxf(fmaxf(St[kap].x, St[kap].y), fmaxf(St[kap].z, St[kap].w)), mx);
        mx = fmaxf(mx, __shfl_xor(mx, 16)); mx = fmaxf(mx, __shfl_xor(mx, 32));
        float l = 0.f;
#pragma unroll
        for (int kap = 0; kap < 16; ++kap) { St[kap].x = __expf(St[kap].x - mx); St[kap].y = __expf(St[kap].y - mx); St[kap].z = __expf(St[kap].z - mx); St[kap].w = __expf(St[kap].w - mx);
            l += (St[kap].x + St[kap].y) + (St[kap].z + St[kap].w); }
        l += __shfl_xor(l, 16); l += __shfl_xor(l, 32);
        inv[ps] = 1.0f / l;
#pragma unroll
        for (int s = 0; s < 8; ++s) Bp[ps][s] = pack_b(St[2 * s], St[2 * s + 1]);
    }
    __syncthreads();
    xattn_stage(lds, Vt, tid);
    __syncthreads();
#pragma unroll
    for (int ps = 0; ps < 1; ++ps) {
        bf16* AO = (bf16*)(P.ws + WS_AO) + (size_t)(tw + 16 * ps + col) * 1024 + h * 256 + 4 * g;
        bf16x8 fr[2][8];
#pragma unroll
        for (int s = 0; s < 8; ++s) fr[0][s] = *(const LAS bf16x8*)(arow + 64 * s);
#pragma unroll
        for (int del = 0; del < 16; ++del) {
            if (del + 1 < 16) {
#pragma unroll
                for (int s = 0; s < 8; ++s) fr[(del + 1) & 1][s] = *(const LAS bf16x8*)(arow + (16 * (del + 1)) * 528 + 64 * s);
            }
            __builtin_amdgcn_sched_barrier(0);
            PIN8(fr[del & 1]);
            f32x4 acc = (f32x4){0.f, 0.f, 0.f, 0.f};
#pragma unroll
            for (int s = 0; s < 8; ++s) acc = __builtin_amdgcn_mfma_f32_16x16x32_bf16(fr[del & 1][s], Bp[ps][s], acc, 0, 0, 0);
            v2u o; o.x = pk2(acc.x * inv[ps], acc.y * inv[ps]); o.y = pk2(acc.z * inv[ps], acc.w * inv[ps]);
            *(v2u*)(AO + 16 * del) = o;
            __builtin_amdgcn_sched_barrier(0);
        }
    }
    __syncthreads();
}

__device__ __forceinline__ unsigned key_enc(float f) { const unsigned u = __builtin_bit_cast(unsigned, f); return (u & 0x80000000u) ? ~u : (u | 0x80000000u); }
__device__ __forceinline__ float key_dec(unsigned k) { const unsigned u = (k & 0x80000000u) ? (k & 0x7fffffffu) : ~k; return __builtin_bit_cast(float, u); }
#define TK_CAS(a, b) do { const unsigned hi_ = max(a, b), lo_ = min(a, b); a = hi_; b = lo_; } while (0)
__device__ __forceinline__ void tk_merge16(unsigned (&a)[16]) {
#pragma unroll
    for (int j = 8; j > 0; j >>= 1)
#pragma unroll
        for (int i = 0; i < 16; ++i) { const int l = i ^ j; if (l > i) TK_CAS(a[i], a[l]); }
}
__device__ __forceinline__ void tk_sort16(unsigned (&a)[16]) {
#pragma unroll
    for (int k = 2; k <= 16; k <<= 1)
#pragma unroll
        for (int j = k >> 1; j > 0; j >>= 1)
#pragma unroll
            for (int i = 0; i < 16; ++i) { const int l = i ^ j; if (l > i) { if ((i & k) == 0) TK_CAS(a[i], a[l]); else TK_CAS(a[l], a[i]); } }
}
__device__ __forceinline__ void tk_top16_merge(unsigned (&L)[16], const unsigned (&G)[16]) {
#pragma unroll
    for (int i = 0; i < 16; ++i) L[i] = max(L[i], G[15 - i]);
    tk_merge16(L);
}
__device__ __forceinline__ void tk_pair_merge(unsigned (&L)[16]) {
    unsigned Pp[16];
#pragma unroll
    for (int i = 0; i < 16; ++i) Pp[i] = (unsigned)__builtin_amdgcn_update_dpp(0, (int)L[i], 0xB1, 0xF, 0xF, true);
    tk_top16_merge(L, Pp);
}
__device__ __forceinline__ void peer_topk_rows(const Params& P, LAS unsigned char* lds, int rowbase, int tid) {
    const unsigned char* ws = P.ws;
    typedef _Float16 f16x8 __attribute__((ext_vector_type(8)));
    const int rl = tid >> 1, hf = tid & 1, grow = rowbase + rl, t = grow >> 3, h = grow & 7;
    const _Float16* SC = (const _Float16*)(ws + WS_PQ) + (size_t)t * 2048 + h * 256 + 64 * hf;
    f16x8 raw[2][8];
#pragma unroll
    for (int p = 0; p < 2; ++p)
#pragma unroll
        for (int q = 0; q < 8; ++q) raw[p][q] = *(const f16x8*)(SC + p * 128 + 8 * q);
    unsigned L1[16], L2[16];
#pragma unroll
    for (int p = 0; p < 2; ++p) {
        unsigned L[16];
#pragma unroll
        for (int grp = 0; grp < 4; ++grp) {
            unsigned G[16];
#pragma unroll
            for (int e = 0; e < 16; ++e) G[e] = (key_enc((float)raw[p][2 * grp + (e >> 3)][e & 7]) & ~127u) | (unsigned)(127 - (64 * hf + 16 * grp + e));
            tk_sort16(G);
            if (grp == 0) {
#pragma unroll
                for (int i = 0; i < 16; ++i) L[i] = G[i];
            } else tk_top16_merge(L, G);
        }
        tk_pair_merge(L);
#pragma unroll
        for (int i = 0; i < 16; ++i) { if (p == 0) L1[i] = L[i]; else L2[i] = L[i]; }
    }
    {
        float v1[16], v2[16];
        LAS int* il = (LAS int*)lds + rl * 33;
#pragma unroll
        for (int q = 0; q < 16; ++q) { v1[q] = key_dec((L1[q] & ~127u) | 64u); v2[q] = key_dec((L2[q] & ~127u) | 64u); }
        if (hf == 0) {
#pragma unroll
            for (int q = 0; q < 16; ++q) { il[q] = 127 - (int)(L1[q] & 127u); il[16 + q] = 127 - (int)(L2[q] & 127u); }
        }
        unsigned C[16], D[16];
        float w1[8];
        const unsigned hf16 = (unsigned)hf * 16u, evenmask = (unsigned)hf - 1u;
#pragma unroll
        for (int k = 0; k < 8; ++k) w1[k] = __builtin_bit_cast(float, (__builtin_bit_cast(unsigned, v1[2 * k]) & evenmask) | (__builtin_bit_cast(unsigned, v1[2 * k + 1]) & ~evenmask));
#define TK_SLOT(dst, k, bq, valid_odd) do { const unsigned pos_ = (unsigned)(16 * (2 * (k)) + (bq)) + hf16; unsigned kv_ = (key_enc(w1[k] + v2[bq]) & ~255u) | (255u - pos_); if (!(valid_odd)) kv_ &= evenmask; dst = kv_; } while (0)
        TK_SLOT(C[0], 0, 0, true);
        TK_SLOT(C[1], 0, 1, true);
        TK_SLOT(C[2], 0, 2, true);
        TK_SLOT(C[3], 0, 3, true);
        TK_SLOT(C[4], 0, 4, true);
        TK_SLOT(C[5], 0, 5, true);
        TK_SLOT(C[6], 0, 6, true);
        TK_SLOT(C[7], 0, 7, true);
        TK_SLOT(C[8], 0, 8, false);
        TK_SLOT(C[9], 0, 9, false);
        TK_SLOT(C[10], 0, 10, false);
        TK_SLOT(C[11], 0, 11, false);
        TK_SLOT(C[12], 0, 12, false);
        TK_SLOT(C[13], 0, 13, false);
        TK_SLOT(C[14], 0, 14, false);
        TK_SLOT(C[15], 0, 15, false);
        TK_SLOT(D[0], 1, 0, true);
        TK_SLOT(D[1], 1, 1, true);
        TK_SLOT(D[2], 1, 2, true);
        TK_SLOT(D[3], 1, 3, true);
        TK_SLOT(D[4], 1, 4, false);
        TK_SLOT(D[5], 2, 0, true);
        TK_SLOT(D[6], 2, 1, true);
        TK_SLOT(D[7], 2, 2, false);
        TK_SLOT(D[8], 3, 0, true);
        TK_SLOT(D[9], 3, 1, true);
        TK_SLOT(D[10], 4, 0, true);
        TK_SLOT(D[11], 5, 0, true);
        TK_SLOT(D[12], 6, 0, true);
        TK_SLOT(D[13], 7, 0, true);
        D[14] = 0u; D[15] = 0u;
#undef TK_SLOT
        tk_sort16(C); tk_sort16(D); tk_top16_merge(C, D); tk_pair_merge(C);
        LDS_WAIT(); asm volatile("" ::: "memory");
        float best[16], e[16], sum = 0.f;
#pragma unroll
        for (int q = 0; q < 16; ++q) { best[q] = key_dec((C[q] & ~255u) | 128u); e[q] = __expf(best[q] - best[0]); sum += e[q]; }
        const float inv = __builtin_amdgcn_rcpf(sum);
        int* IDX = (int*)(P.ws + WS_IDX) + (size_t)grow * 16 + 8 * hf; float* GW = (float*)(P.ws + WS_GW) + (size_t)grow * 16 + 8 * hf;
#pragma unroll
        for (int q = 0; q < 8; ++q) {
            const unsigned c = (C[q] & evenmask) | (C[8 + q] & ~evenmask);
            const float ev = __builtin_bit_cast(float, (__builtin_bit_cast(unsigned, e[q]) & evenmask) | (__builtin_bit_cast(unsigned, e[8 + q]) & ~evenmask));
            const unsigned pos = 255u - (c & 255u);
            IDX[q] = il[pos >> 4] * 128 + il[16 + (pos & 15u)]; GW[q] = ev * inv;
        }
    }
    LDS_WAIT(); asm volatile("" ::: "memory");
}

__device__ __forceinline__ void peer_topk_wave(const Params& P, LAS int* ilw, LAS unsigned* oute, LAS float* outg, int tbase, int lane) {
    const unsigned char* ws = P.ws;
    typedef _Float16 f16x8 __attribute__((ext_vector_type(8)));
    const int rl = lane >> 1, hf = lane & 1, t = tbase + (rl >> 3), h = rl & 7;
    const _Float16* SC = (const _Float16*)(ws + WS_PQ) + (size_t)t * 2048 + h * 256 + 64 * hf;
    f16x8 raw[2][8];
#pragma unroll
    for (int p = 0; p < 2; ++p)
#pragma unroll
        for (int q = 0; q < 8; ++q) raw[p][q] = *(const f16x8*)(SC + p * 128 + 8 * q);
    unsigned L1[16], L2[16];
#pragma unroll
    for (int p = 0; p < 2; ++p) {
        unsigned L[16];
#pragma unroll
        for (int grp = 0; grp < 4; ++grp) {
            unsigned G[16];
#pragma unroll
            for (int e = 0; e < 16; ++e) G[e] = (key_enc((float)raw[p][2 * grp + (e >> 3)][e & 7]) & ~127u) | (unsigned)(127 - (64 * hf + 16 * grp + e));
            tk_sort16(G);
            if (grp == 0) {
#pragma unroll
                for (int i = 0; i < 16; ++i) L[i] = G[i];
            } else tk_top16_merge(L, G);
        }
        tk_pair_merge(L);
#pragma unroll
        for (int i = 0; i < 16; ++i) { if (p == 0) L1[i] = L[i]; else L2[i] = L[i]; }
    }
    {
        float v1[16], v2[16];
        LAS int* il = ilw + rl * 33;
#pragma unroll
        for (int q = 0; q < 16; ++q) { v1[q] = key_dec((L1[q] & ~127u) | 64u); v2[q] = key_dec((L2[q] & ~127u) | 64u); }
        if (hf == 0) {
#pragma unroll
            for (int q = 0; q < 16; ++q) { il[q] = 127 - (int)(L1[q] & 127u); il[16 + q] = 127 - (int)(L2[q] & 127u); }
        }
        unsigned C[16], D[16];
        float w1[8];
        const unsigned hf16 = (unsigned)hf * 16u, evenmask = (unsigned)hf - 1u;
#pragma unroll
        for (int k = 0; k < 8; ++k) w1[k] = __builtin_bit_cast(float, (__builtin_bit_cast(unsigned, v1[2 * k]) & evenmask) | (__builtin_bit_cast(unsigned, v1[2 * k + 1]) & ~evenmask));
#define TK_SLOT(dst, k, bq, valid_odd) do { const unsigned pos_ = (unsigned)(16 * (2 * (k)) + (bq)) + hf16; unsigned kv_ = (key_enc(w1[k] + v2[bq]) & ~255u) | (255u - pos_); if (!(valid_odd)) kv_ &= evenmask; dst = kv_; } while (0)
        TK_SLOT(C[0], 0, 0, true);
        TK_SLOT(C[1], 0, 1, true);
        TK_SLOT(C[2], 0, 2, true);
        TK_SLOT(C[3], 0, 3, true);
        TK_SLOT(C[4], 0, 4, true);
        TK_SLOT(C[5], 0, 5, true);
        TK_SLOT(C[6], 0, 6, true);
        TK_SLOT(C[7], 0, 7, true);
        TK_SLOT(C[8], 0, 8, false);
        TK_SLOT(C[9], 0, 9, false);
        TK_SLOT(C[10], 0, 10, false);
        TK_SLOT(C[11], 0, 11, false);
        TK_SLOT(C[12], 0, 12, false);
        TK_SLOT(C[13], 0, 13, false);
        TK_SLOT(C[14], 0, 14, false);
        TK_SLOT(C[15], 0, 15, false);
        TK_SLOT(D[0], 1, 0, true);
        TK_SLOT(D[1], 1, 1, true);
        TK_SLOT(D[2], 1, 2, true);
        TK_SLOT(D[3], 1, 3, true);
        TK_SLOT(D[4], 1, 4, false);
        TK_SLOT(D[5], 2, 0, true);
        TK_SLOT(D[6], 2, 1, true);
        TK_SLOT(D[7], 2, 2, false);
        TK_SLOT(D[8], 3, 0, true);
        TK_SLOT(D[9], 3, 1, true);
        TK_SLOT(D[10], 4, 0, true);
        TK_SLOT(D[11], 5, 0, true);
        TK_SLOT(D[12], 6, 0, true);
        TK_SLOT(D[13], 7, 0, true);
        D[14] = 0u; D[15] = 0u;
#undef TK_SLOT
        tk_sort16(C); tk_sort16(D); tk_top16_merge(C, D); tk_pair_merge(C);
        LDS_WAIT(); asm volatile("" ::: "memory");
        float best[16], e[16], sum = 0.f;
#pragma unroll
        for (int q = 0; q < 16; ++q) { best[q] = key_dec((C[q] & ~255u) | 128u); e[q] = __expf(best[q] - best[0]); sum += e[q]; }
        const float inv = __builtin_amdgcn_rcpf(sum);
        LAS unsigned* IDX = oute + rl * 16 + 8 * hf; LAS float* GW = outg + rl * 16 + 8 * hf;
#pragma unroll
        for (int q = 0; q < 8; ++q) {
            const unsigned c = (C[q] & evenmask) | (C[8 + q] & ~evenmask);
            const float ev = __builtin_bit_cast(float, (__builtin_bit_cast(unsigned, e[q]) & evenmask) | (__builtin_bit_cast(unsigned, e[8 + q]) & ~evenmask));
            const unsigned pos = 255u - (c & 255u);
            IDX[q] = (unsigned)(il[pos >> 4] * 128 + il[16 + (pos & 15u)]); GW[q] = ev * inv;
        }
    }
    LDS_WAIT(); asm volatile("" ::: "memory");
}

typedef float f32x2 __attribute__((ext_vector_type(2)));
__device__ __forceinline__ unsigned q8(float x) { return (unsigned)(int)rintf(x) & 0xffu; }
__device__ __forceinline__ void cvt_table_fp8(const float* src, unsigned char* dst, float* scl, int gw, int ngw, int lane) {
    for (int row = gw; row < 16384; row += ngw) {
        const f32x4* sp = (const f32x4*)(src + (size_t)row * 1024 + 16 * lane);
        const f32x4 a0 = sp[0], a1 = sp[1], a2 = sp[2], a3 = sp[3];
        float m = fmaxf(fmaxf(fmaxf(fabsf(a0.x), fabsf(a0.y)), fmaxf(fabsf(a0.z), fabsf(a0.w))), fmaxf(fmaxf(fabsf(a1.x), fabsf(a1.y)), fmaxf(fabsf(a1.z), fabsf(a1.w))));
        m = fmaxf(m, fmaxf(fmaxf(fmaxf(fabsf(a2.x), fabsf(a2.y)), fmaxf(fabsf(a2.z), fabsf(a2.w))), fmaxf(fmaxf(fabsf(a3.x), fabsf(a3.y)), fmaxf(fabsf(a3.z), fabsf(a3.w)))));
#pragma unroll
        for (int o = 1; o < 64; o <<= 1) m = fmaxf(m, __shfl_xor(m, o));
        m = fmaxf(m, 1e-30f);
        const float q = 127.0f / m;
        v4u o;
        o.x = q8(a0.x * q) | (q8(a0.y * q) << 8) | (q8(a0.z * q) << 16) | (q8(a0.w * q) << 24);
        o.y = q8(a1.x * q) | (q8(a1.y * q) << 8) | (q8(a1.z * q) << 16) | (q8(a1.w * q) << 24);
        o.z = q8(a2.x * q) | (q8(a2.y * q) << 8) | (q8(a2.z * q) << 16) | (q8(a2.w * q) << 24);
        o.w = q8(a3.x * q) | (q8(a3.y * q) << 8) | (q8(a3.z * q) << 16) | (q8(a3.w * q) << 24);
        *(v4u*)(dst + (size_t)row * 1024 + 16 * lane) = o;
        if (lane == 0) scl[row] = m * (1.0f / 127.0f);
    }
}
__device__ __forceinline__ int row16_sum_i(int v) {
    v += __builtin_amdgcn_update_dpp(0, v, 0xB1, 0xF, 0xF, true);
    v += __builtin_amdgcn_update_dpp(0, v, 0x4E, 0xF, 0xF, true);
    v += __builtin_amdgcn_update_dpp(0, v, 0x141, 0xF, 0xF, true);
    v += __builtin_amdgcn_update_dpp(0, v, 0x140, 0xF, 0xF, true);
    return v;
}
constexpr int PE_NT = 4, PE_NR = 16, PE_SH = 10, PE_DEP = 3;
constexpr int PE_TOK_W = 128 * 3 + 20;
constexpr int PE_WAVE_W = PE_NT * PE_TOK_W + 272 + 32 * 33 + 2 * PE_NT * 128;
static_assert(8 * PE_WAVE_W * 4 <= MISC_OFF && PE_NR * PE_NT == 64, "peer LDS / batch-list geometry");
#define PE_LD(dst, voff_, sbase_) asm volatile("s_nop 4\n\tglobal_load_dwordx4 %0, %1, %2" : "=&v"(dst) : "v"(voff_), "s"(sbase_) : "memory")
__device__ __forceinline__ void peer_pass(const Params& P, LAS unsigned char* lds, int tbase, int lane, int wave, float* dstbase, int emask = 0x3fff) {
    {
        LAS unsigned* lw0 = (LAS unsigned*)(lds) + wave * PE_WAVE_W + PE_NT * PE_TOK_W + 272;
        peer_topk_wave(P, (LAS int*)lw0, lw0 + 32 * 33, (LAS float*)(lw0 + 32 * 33 + PE_NT * 128), tbase, lane);
        LDS_WAIT(); asm volatile("" : "+v"(lane), "+s"(tbase) :: "memory");
    }
    const unsigned char* ws = P.ws;
    const unsigned char* UB8 = ws + WS_UB; const unsigned char* VB8 = ws + WS_VB;
    const float* USC = (const float*)(ws + WS_USC); const float* VSC = (const float*)(ws + WS_VSC);
    unsigned hq[PE_NT][4]; f32x2 acc[PE_NT][8];
    LAS unsigned* lw = (LAS unsigned*)(lds) + wave * PE_WAVE_W;
    LAS unsigned* ents = lw + PE_NT * PE_TOK_W;
    const unsigned voff = (unsigned)lane * 16u;
    LAS unsigned* upe = ents + 272 + 32 * 33; LAS float* upg = (LAS float*)(upe + PE_NT * 128);
#pragma unroll
    for (int j = 0; j < PE_NT; ++j) {
        const int t = tbase + j;
        const v4u* xrow = (const v4u*)((const bf16*)(ws + WS_XB) + (size_t)t * 1024 + 16 * lane);
        const v4u xa = xrow[0], xc = xrow[1];
        const f32x4 xvv[4] = {(f32x4){bflo(xa.x), bfhi(xa.x), bflo(xa.y), bfhi(xa.y)}, (f32x4){bflo(xa.z), bfhi(xa.z), bflo(xa.w), bfhi(xa.w)},
                              (f32x4){bflo(xc.x), bfhi(xc.x), bflo(xc.y), bfhi(xc.y)}, (f32x4){bflo(xc.z), bfhi(xc.z), bflo(xc.w), bfhi(xc.w)}};
        const float rstd2 = rsqrtf(((const float*)(ws + WS_SSQ2))[t] * (1.0f / 1024.0f) + 1e-6f);
        f32x4 hv[4]; float hm = 0.f;
#pragma unroll
        for (int i = 0; i < 4; ++i) { const f32x4 xv = xvv[i]; const f32x4 w = ((const f32x4*)(P.norm_ffn_w + 16 * lane))[i];
            hv[i] = (f32x4){xv.x * rstd2 * w.x, xv.y * rstd2 * w.y, xv.z * rstd2 * w.z, xv.w * rstd2 * w.w};
            hm = fmaxf(hm, fmaxf(fmaxf(fabsf(hv[i].x), fabsf(hv[i].y)), fmaxf(fabsf(hv[i].z), fabsf(hv[i].w)))); }
#pragma unroll
        for (int o = 1; o < 64; o <<= 1) hm = fmaxf(hm, __shfl_xor(hm, o));
        hm = fmaxf(hm, 1e-30f);
        const float hqs = 127.0f / hm, hs = hm * (1.0f / 127.0f);
#pragma unroll
        for (int i = 0; i < 4; ++i) hq[j][i] = q8(hv[i].x * hqs) | (q8(hv[i].y * hqs) << 8) | (q8(hv[i].z * hqs) << 16) | (q8(hv[i].w * hqs) << 24);
#pragma unroll
        for (int i = 0; i < 8; ++i) acc[j][i] = (f32x2){0.f, 0.f};
        const int e0 = (int)upe[j * 128 + 2 * lane] & emask, e1 = (int)upe[j * 128 + 2 * lane + 1] & emask;
        const float g0 = upg[j * 128 + 2 * lane] * VSC[e0], g1 = upg[j * 128 + 2 * lane + 1] * VSC[e1];
        const float u0 = USC[e0] * hs, u1 = USC[e1] * hs;
        const int b0 = e0 >> PE_SH, b1 = e1 >> PE_SH;
        LAS unsigned* lt = lw + j * PE_TOK_W;
        int run = 0;
#pragma unroll 1
        for (int bk = 0; bk < PE_NR; ++bk) {
            const unsigned long long m0 = __ballot(b0 == bk), m1 = __ballot(b1 == bk);
            const int c0 = __popcll(m0), c1 = __popcll(m1);
            const unsigned long long lower = (1ull << lane) - 1ull;
            if (b0 == bk) { const int p = run + __popcll(m0 & lower); lt[p] = (unsigned)e0; lt[128 + p] = __builtin_bit_cast(unsigned, g0); lt[256 + p] = __builtin_bit_cast(unsigned, u0); }
            if (b1 == bk) { const int p = run + c0 + __popcll(m1 & lower); lt[p] = (unsigned)e1; lt[128 + p] = __builtin_bit_cast(unsigned, g1); lt[256 + p] = __builtin_bit_cast(unsigned, u1); }
            if (lane == 0) lt[384 + bk] = (unsigned)run;
            run += c0 + c1;
        }
        if (lane == 0) lt[384 + PE_NR] = 128u;
        asm volatile("" ::: "memory");
    }
    LDS_WAIT(); asm volatile("" ::: "memory");
    int nb;
    {
        const int rd = lane >> 2, j = lane & 3;
        const LAS unsigned* lt = lw + j * PE_TOK_W;
        const int n0 = (int)lt[384 + rd], n1 = (int)lt[384 + rd + 1];
        const int nbl = (n1 - n0 + 3) >> 2;
        int inc = nbl;
#pragma unroll
        for (int off = 1; off < 64; off <<= 1) { const int tv = __shfl_up(inc, off); if (lane >= off) inc += tv; }
        nb = __builtin_amdgcn_readlane(inc, 63);
        const int ofs = inc - nbl;
        for (int q = 0; q < nbl; ++q) { const int i0 = n0 + 4 * q, c = (n1 - i0) < 4 ? (n1 - i0) : 4; ents[ofs + q] = (unsigned)j | ((unsigned)c << 2) | ((unsigned)i0 << 5); }
        if (lane < 2 * PE_DEP) ents[nb + lane] = 0u;
    }
    LDS_WAIT(); asm volatile("" ::: "memory");
    v4u ru[PE_DEP][4], rv[PE_DEP][4];
#define PE_LDO(dst, vo_, sbase_) asm volatile("global_load_dwordx4 %0, %1, %2" : "=&v"(dst) : "v"(vo_), "s"(sbase_) : "memory")
#define PE_ISSUE(S, entv) do { const unsigned en_ = (entv); const int j_ = (int)(en_ & 3u), c_ = (int)((en_ >> 2) & 7u), i_ = (int)(en_ >> 5); \
        const LAS unsigned* lt_ = lw + j_ * PE_TOK_W; const int cl_ = c_ > 0 ? c_ - 1 : 0; \
        const int ev_ = (int)lt_[i_ + (lane < cl_ ? lane : cl_)];                          \
        _Pragma("unroll") for (int k_ = 0; k_ < 4; ++k_) { const unsigned vo_ = ((unsigned)__builtin_amdgcn_readlane(ev_, k_) << 10) + voff; \
            PE_LDO(ru[S][k_], vo_, UB8); PE_LDO(rv[S][k_], vo_, VB8); } } while (0)
#define PE_WAIT8(S, cntstr) asm volatile("s_waitcnt " cntstr : "+v"(ru[S][0]), "+v"(ru[S][1]), "+v"(ru[S][2]), "+v"(ru[S][3]), "+v"(rv[S][0]), "+v"(rv[S][1]), "+v"(rv[S][2]), "+v"(rv[S][3]) :: "memory")
#define PE_COMPUTE_J(S, J, c_, i_, SG) do { const LAS unsigned* lt_ = lw + (J) * PE_TOK_W; \
        const float gsc_ = (lane < c_) ? __builtin_bit_cast(float, lt_[128 + i_ + lane]) : 0.f, usc_ = (lane < c_) ? __builtin_bit_cast(float, lt_[256 + i_ + lane]) : 0.f; \
        int d_[4]; \
        _Pragma("unroll") for (int k_ = 0; k_ < 4; ++k_) { d_[k_] = 0; if (k_ >= c_) continue; \
            int s_ = __builtin_amdgcn_sdot4((int)ru[S][k_].x, (int)hq[J][0], 0, false); s_ = __builtin_amdgcn_sdot4((int)ru[S][k_].y, (int)hq[J][1], s_, false); \
            s_ = __builtin_amdgcn_sdot4((int)ru[S][k_].z, (int)hq[J][2], s_, false); s_ = __builtin_amdgcn_sdot4((int)ru[S][k_].w, (int)hq[J][3], s_, false); d_[k_] = s_; } \
        int r2_[2], r1_; \
        { const bool up_ = (lane & 32) != 0; \
          _Pragma("unroll") for (int q_ = 0; q_ < 2; ++q_) { const int keep_ = up_ ? d_[2 + q_] : d_[q_], send_ = up_ ? d_[q_] : d_[2 + q_]; r2_[q_] = keep_ + __shfl_xor(send_, 32); } } \
        { const bool up_ = (lane & 16) != 0; const int keep_ = up_ ? r2_[1] : r2_[0], send_ = up_ ? r2_[0] : r2_[1]; r1_ = keep_ + __shfl_xor(send_, 16); } \
        r1_ = row16_sum_i(r1_); \
        const int myk_ = (lane >> 4) & 3; \
        const float act_ = gelu_tanh((float)r1_ * __shfl(usc_, myk_)) * __shfl(gsc_, myk_);      \
          \
        const float w0_ = __builtin_bit_cast(float, __builtin_amdgcn_readlane(__builtin_bit_cast(int, act_), 0)), w1_ = __builtin_bit_cast(float, __builtin_amdgcn_readlane(__builtin_bit_cast(int, act_), 16)), \
                    w2_ = __builtin_bit_cast(float, __builtin_amdgcn_readlane(__builtin_bit_cast(int, act_), 32)), w3_ = __builtin_bit_cast(float, __builtin_amdgcn_readlane(__builtin_bit_cast(int, act_), 48)); \
        const float wm_ = fmaxf(fmaxf(fmaxf(fabsf(w0_), fabsf(w1_)), fmaxf(fabsf(w2_), fabsf(w3_))), 1e-30f), wq_ = 127.0f / wm_, ws_ = (SG) * wm_ * (1.0f / 127.0f); \
        const int w4_ = (int)(q8(w0_ * wq_) | (q8(w1_ * wq_) << 8) | (q8(w2_ * wq_) << 16) | (q8(w3_ * wq_) << 24)); \
        const f32x2 ws2_ = (f32x2){ws_, ws_}; \
        _Pragma("unroll") for (int m_ = 0; m_ < 4; ++m_) { \
            const unsigned R0_ = rv[S][0][m_], R1_ = rv[S][1][m_], R2_ = rv[S][2][m_], R3_ = rv[S][3][m_]; \
            const unsigned X_ = __builtin_amdgcn_perm(R1_, R0_, 0x05010400u), Y_ = __builtin_amdgcn_perm(R1_, R0_, 0x07030602u), Z_ = __builtin_amdgcn_perm(R3_, R2_, 0x05010400u), W_ = __builtin_amdgcn_perm(R3_, R2_, 0x07030602u); \
            const int t0_ = __builtin_amdgcn_sdot4((int)__builtin_amdgcn_perm(Z_, X_, 0x05040100u), w4_, 0, false), t1_ = __builtin_amdgcn_sdot4((int)__builtin_amdgcn_perm(Z_, X_, 0x07060302u), w4_, 0, false), \
                      t2_ = __builtin_amdgcn_sdot4((int)__builtin_amdgcn_perm(W_, Y_, 0x05040100u), w4_, 0, false), t3_ = __builtin_amdgcn_sdot4((int)__builtin_amdgcn_perm(W_, Y_, 0x07060302u), w4_, 0, false); \
            acc[J][2 * m_] = __builtin_elementwise_fma((f32x2){(float)t0_, (float)t1_}, ws2_, acc[J][2 * m_]); \
            acc[J][2 * m_ + 1] = __builtin_elementwise_fma((f32x2){(float)t2_, (float)t3_}, ws2_, acc[J][2 * m_ + 1]); } } while (0)
#define PE_COMPUTE_S(S, entv, SG) do { const unsigned en_ = (entv); const int jj_ = (int)(en_ & 3u), cc_ = (int)((en_ >> 2) & 7u), ii_ = (int)(en_ >> 5); \
        if (cc_ > 0) { if (jj_ == 0) PE_COMPUTE_J(S, 0, cc_, ii_, SG); else if (jj_ == 1) PE_COMPUTE_J(S, 1, cc_, ii_, SG); else if (jj_ == 2) PE_COMPUTE_J(S, 2, cc_, ii_, SG); else PE_COMPUTE_J(S, 3, cc_, ii_, SG); } } while (0)
#ifdef PE_VALU3
#define PE_COMPUTE(S, entv) do { PE_COMPUTE_S(S, entv, 1.0f); PE_WAIT8(S, "vmcnt(16)"); PE_COMPUTE_S(S, entv, -1.0f); PE_WAIT8(S, "vmcnt(16)"); PE_COMPUTE_S(S, entv, 1.0f); } while (0)
#else
#define PE_COMPUTE(S, entv) PE_COMPUTE_S(S, entv, 1.0f)
#endif
    {
        unsigned er[PE_DEP];
#pragma unroll
        for (int q = 0; q < PE_DEP; ++q) { er[q] = __builtin_amdgcn_readfirstlane(ents[q]); PE_ISSUE(q, er[q]); }
#pragma unroll 1
        for (int bi = 0; bi < nb; bi += PE_DEP) {
#pragma unroll
            for (int q = 0; q < PE_DEP; ++q) {
                PE_WAIT8(q, "vmcnt(16)");
                PE_COMPUTE(q, er[q]);
                er[q] = __builtin_amdgcn_readfirstlane(ents[bi + q + PE_DEP]);
                PE_ISSUE(q, er[q]);
            }
        }
#pragma unroll
        for (int q = 0; q < PE_DEP; ++q) PE_WAIT8(q, "vmcnt(0)");
    }
#undef PE_COMPUTE
#undef PE_COMPUTE_S
#undef PE_COMPUTE_J
#undef PE_WAIT8
#undef PE_ISSUE
#pragma unroll
    for (int j = 0; j < PE_NT; ++j) {
        const int t = tbase + j;
        float ss = 0.f; f32x4 xo[4];
        { const v4u* xrow = (const v4u*)((const bf16*)(ws + WS_XB) + (size_t)t * 1024 + 16 * lane); const v4u xa = xrow[0], xc = xrow[1];
          xo[0] = (f32x4){bflo(xa.x), bfhi(xa.x), bflo(xa.y), bfhi(xa.y)}; xo[1] = (f32x4){bflo(xa.z), bfhi(xa.z), bflo(xa.w), bfhi(xa.w)};
          xo[2] = (f32x4){bflo(xc.x), bfhi(xc.x), bflo(xc.y), bfhi(xc.y)}; xo[3] = (f32x4){bflo(xc.z), bfhi(xc.z), bflo(xc.w), bfhi(xc.w)}; }
#pragma unroll
        for (int i = 0; i < 4; ++i) { xo[i].x += acc[j][2 * i].x; xo[i].y += acc[j][2 * i].y; xo[i].z += acc[j][2 * i + 1].x; xo[i].w += acc[j][2 * i + 1].y;
            ss += (xo[i].x * xo[i].x + xo[i].y * xo[i].y) + (xo[i].z * xo[i].z + xo[i].w * xo[i].w); }
        const float rstd3 = rsqrtf(wave_sum(ss) * (1.0f / 1024.0f) + 1e-6f);
        float* orow = dstbase + (size_t)t * 1024 + 16 * lane;
#pragma unroll
        for (int i = 0; i < 4; ++i) { const f32x4 w = ((const f32x4*)(P.norm_final_w + 16 * lane))[i];
            ((f32x4*)orow)[i] = (f32x4){xo[i].x * rstd3 * w.x, xo[i].y * rstd3 * w.y, xo[i].z * rstd3 * w.z, xo[i].w * rstd3 * w.w}; }
    }
    LDS_WAIT(); asm volatile("s_waitcnt vmcnt(0)" ::: "memory");
}


#ifndef TWICE_MASK
#define TWICE_MASK 0
#endif
struct TwiceOrder { pg8::StaticOrder S; int per, reps;
    __device__ bool next(int i, pg8::Unit& u) const { if (i >= per * reps) return false; return S.next(i % per, u); }
    __device__ __forceinline__ void a_ready(const pg8::Unit&) const {} __device__ __forceinline__ void done(const pg8::Unit&) const {} };
template <class B> __device__ __forceinline__ bool rep_again(volatile LAS unsigned* MISC, B& bar) {
    __syncthreads(); const unsigned c = MISC[20]; __syncthreads();
    if (threadIdx.x == 0) MISC[20] = c ^ 1u;
    __syncthreads();
    if (c == 0u) { xcd_barrier(bar); return true; }
    return false;
}
__global__ void __launch_bounds__(NWAVES * 64, 2) hybrid_fwd(Params P) {
    extern __shared__ __attribute__((aligned(16))) unsigned char lds_raw[];
    LAS unsigned char* lds = (LAS unsigned char*)lds_raw;
    volatile LAS unsigned* MISC = (volatile LAS unsigned*)(lds + MISC_OFF);
    const int tid = threadIdx.x, lane = tid & 63, wave = __builtin_amdgcn_readfirstlane(tid >> 6);
    const int G = gridDim.x, bx = blockIdx.x;
    const int vcu = (G % 8 == 0) ? (bx % 8) * (G / 8) + bx / 8 : bx;
    unsigned char* ws = P.ws;
    for (int u = tid; u < 64; u += NWAVES * 64) MISC[u] = 0u;
    __syncthreads();
    XcdBarrier bar; bar.bar = (unsigned*)(ws + WS_CTL) + CW_BAR; bar.x = 0; bar.st = nullptr;
    if (!MK_PER_PHASE) bar = xcd_barrier_post((unsigned*)(ws + WS_CTL) + CW_BAR, MISC + 8);
    const int lo = P.ph_lo, hi = P.ph_hi;
#ifndef PHASE_MASK
#define PHASE_MASK 0xFFF
#endif
#define IN(k) (((PHASE_MASK >> (k)) & 1) && lo <= (k) && (k) < hi)
#define SEAM(k) do { if (IN(k) && IN((k) + 1)) xcd_barrier(bar); } while (0)
#ifndef REP_MASK
#define REP_MASK 0
#endif
#ifndef PE_EXP_MASK
#define PE_EXP_MASK 0x3fff
#endif
#define REPS(k) for (bool again_ = true; again_; again_ = (((REP_MASK >> (k)) & 1) ? rep_again(MISC, bar) : false))
    using namespace pg8;
    bf16* XB = (bf16*)(ws + WS_XB);

    if (IN(0)) REPS(0) { p0_prologue(P, lds, tid, lane, wave, vcu, G); }
    SEAM(0);
    if (IN(1)) REPS(1) {
        { Gemm gm{XB, (const bf16_t*)(ws + WS_WIN), T, 3072, 1024}; StaticOrder S; S.init(T, 3072, G, bx);
          EpiBf16Rs E{(bf16_t*)(ws + WS_QKV), 1536, 6, (bf16_t*)(ws + WS_XR), 512, (size_t)T * 512, nullptr, 1.0f};
          gemm_phase<EpiBf16Rs, StaticOrder, PG8_ALIGN, PG8_SP2>(lds, gm, S, E); }
    }
    SEAM(1);
    if (IN(3)) REPS(3) {
        if (bx < SCAN_WGS) gdn_scan(P, lds, bx, tid, lane, wave);
        else {
            const int wk = bx - SCAN_WGS, NWK = G - SCAN_WGS;
            unsigned* lcnt = (unsigned*)(ws + WS_CTL) + CW_LRUCNT;
            for (int q = wk; q < 1024; q += NWK) gdn_local_item(P, lds, (q & 7) * 128 + (q >> 3), tid);
            if (wk < 16) {
                struct OneUnit { int pm, pn; __device__ bool next(int i, Unit& u) const { if (i > 0) return false; u.pm = pm; u.pn = pn; return true; }
                                 __device__ void a_ready(const Unit&) const {} __device__ void done(const Unit&) const {} };
                Gemm gm{(const bf16_t*)(ws + WS_MEMN), (const bf16_t*)(ws + WS_WKV), 512, 2048, 1024}; OneUnit S{wk >> 3, wk & 7};
                EpiKV E{(bf16_t*)(ws + WS_KB), (bf16_t*)(ws + WS_VTP)};
                gemm_phase<EpiKV, OneUnit, PG8_ALIGN, PG8_SP2>(lds, gm, S, E);
            }
            unsigned ndone = 0;
            for (int lt = wk; lt < 256; lt += NWK) { lru_local_item(P, lds, lt, tid, lane, wave); ++ndone; }
            asm volatile("s_waitcnt vmcnt(0)" ::: "memory");
            __syncthreads();
            if (tid == 0 && ndone) { __builtin_amdgcn_fence(__ATOMIC_RELEASE, "agent"); asm volatile("s_waitcnt vmcnt(0)" ::: "memory");
                                     __hip_atomic_fetch_add(lcnt, ndone, __ATOMIC_RELAXED, __HIP_MEMORY_SCOPE_AGENT); }
            if (wk == 16 || wk == 17) {
                if (tid == 0) { unsigned sp = 0;
                    while (__hip_atomic_load(lcnt, __ATOMIC_RELAXED, __HIP_MEMORY_SCOPE_AGENT) < 256u) { __builtin_amdgcn_s_sleep(8); if (++sp > (1u << 22)) break; }
                    __builtin_amdgcn_fence(__ATOMIC_ACQUIRE, "agent"); asm volatile("s_waitcnt vmcnt(0)" ::: "memory"); }
                __syncthreads();
                lru_carry(P, (wk - 16) * NWAVES + wave, lane);
                asm volatile("s_waitcnt vmcnt(0)" ::: "memory");
                __syncthreads();
                if (tid == 0) { __builtin_amdgcn_fence(__ATOMIC_RELEASE, "agent"); asm volatile("s_waitcnt vmcnt(0)" ::: "memory");
                                __hip_atomic_fetch_add(lcnt + 64, 1u, __ATOMIC_RELAXED, __HIP_MEMORY_SCOPE_AGENT); }
            } else {
                const int w2 = (wk < 16 ? wk : wk - 2), N2 = NWK - 2;
                cvt_table_fp8(P.peer_v, ws + WS_VB, (float*)(ws + WS_VSC), w2 * NWAVES + wave, N2 * NWAVES, lane);
                late_weight_prep(P, lds, lane, wave, w2 * NWAVES + wave, N2 * NWAVES);
                if (tid == 0) { unsigned sp = 0;
                    while (__hip_atomic_load(lcnt + 64, __ATOMIC_RELAXED, __HIP_MEMORY_SCOPE_AGENT) < 2u) { __builtin_amdgcn_s_sleep(8); if (++sp > (1u << 22)) break; }
                    __builtin_amdgcn_fence(__ATOMIC_ACQUIRE, "agent"); asm volatile("s_waitcnt vmcnt(0)" ::: "memory"); }
                __syncthreads();
                lru_combine(P, (size_t)w2 * (NWAVES * 64) + tid, (size_t)N2 * (NWAVES * 64));
            }
        }
    }
    SEAM(3);
    if (IN(4)) REPS(4) {
        gdn_gate_norm(P, (size_t)bx * (NWAVES * 64) + tid, (size_t)G * (NWAVES * 64));
        cvt_table_fp8(P.peer_u, ws + WS_UB, (float*)(ws + WS_USC), bx * NWAVES + wave, G * NWAVES, lane);
    }
    SEAM(4);
    if (IN(5)) {
        Gemm gm{(const bf16_t*)((const unsigned char*)P.out + OUT_Y), (const bf16_t*)(ws + WS_WOUT), T, 1024, 1024}; StaticOrder S; S.init(T, 1024, G, bx);
        EpiResidBf<true> E{P.x, XB, (float*)(ws + WS_SSQ1)};
        gemm_phase<EpiResidBf<true>, StaticOrder, PG8_ALIGN, PG8_SP2>(lds, gm, S, E);
    }
    SEAM(5);
    if (IN(6)) REPS(6) {
        Gemm gm{XB, (const bf16_t*)(ws + WS_WQ), T, 1024, 1024};
        EpiBf16Rs E{(bf16_t*)(ws + WS_Q), 1024, 4, nullptr, 256, 0, (const float*)(ws + WS_SSQ1), 0.0625f};
#if (TWICE_MASK >> 6) & 1
        { TwiceOrder S; S.S.init(T, 1024, G, bx); S.per = 1; S.reps = 2;
          gemm_phase<EpiBf16Rs, TwiceOrder, PG8_ALIGN, PG8_SP2>(lds, gm, S, E); }
#else
        { StaticOrder S; S.init(T, 1024, G, bx);
          gemm_phase<EpiBf16Rs, StaticOrder, PG8_ALIGN, PG8_SP2>(lds, gm, S, E); }
#endif
        Unit u;
        { const int wgid = (bx & 7) * 32 + (bx >> 3); u.pm = (wgid >> 5) * 8 + (wgid & 7); u.pn = (wgid & 31) >> 3; }
        if (G == 256) {
            asm volatile("s_waitcnt vmcnt(0)" ::: "memory");
            __syncthreads();
            const int b = u.pm >> 5, qb0 = (u.pm & 31) * 2, h = u.pn;
#pragma unroll 1
            for (int qq = 0; qq < (((TWICE_MASK >> 7) & 1) ? 4 : 2); ++qq) xattn_unit(P, lds, (b << 8) | ((qb0 + (qq & 1)) << 2) | h, tid, lane, wave);
        }
    }
    if (IN(7)) REPS(7) { }
    SEAM(7);
    if (IN(8)) {
        Gemm gm{(const bf16_t*)(ws + WS_AO), (const bf16_t*)(ws + WS_WO), T, 1024, 1024}; StaticOrder S; S.init(T, 1024, G, bx);
        EpiResidBf<false> E{nullptr, XB, (float*)(ws + WS_SSQ2)};
        gemm_phase<EpiResidBf<false>, StaticOrder, PG8_ALIGN, PG8_SP2>(lds, gm, S, E);
    }
    SEAM(8);
    if (IN(9)) REPS(9) {
        Gemm gm{XB, (const bf16_t*)(ws + WS_PWQ), T, 2048, 1024};
        EpiF16Rs E{(_Float16*)(ws + WS_PQ), 2048, (const float*)(ws + WS_SSQ2)};
#if (TWICE_MASK >> 9) & 1
        TwiceOrder S; S.S.init(T, 2048, G, bx); S.per = 2; S.reps = 2;
        gemm_phase<EpiF16Rs, TwiceOrder, PG8_ALIGN, PG8_SP2>(lds, gm, S, E);
#else
        StaticOrder S; S.init(T, 2048, G, bx);
        gemm_phase<EpiF16Rs, StaticOrder, PG8_ALIGN, PG8_SP2>(lds, gm, S, E);
#endif
    }
    SEAM(9);
    if (IN(10)) REPS(10) {
    }
    if (IN(11)) REPS(11) {
#if (TWICE_MASK >> 11) & 1
        for (int it = 0; it < 4; ++it) { const int tb = (bx * NWAVES + wave) * PE_NT + (it >> 1) * (G * NWAVES * PE_NT); if (tb < T) peer_pass(P, lds, tb, lane, wave, P.out, (it & 1) ? 0x3fff : PE_EXP_MASK); }
#else
        for (int tb = (bx * NWAVES + wave) * PE_NT; tb < T; tb += G * NWAVES * PE_NT) peer_pass(P, lds, tb, lane, wave, P.out);
#endif
    }
#undef IN
#undef SEAM
}

extern "C" void kernel_launch(void* const* d_in, const int* in_sizes, int n_in, void* d_out, int out_size, void* d_ws, size_t ws_size, hipStream_t stream) {
    static int grid = 0;
    if (grid == 0) {
        if (n_in != 27 || in_sizes[0] != T * D || out_size != T * D || ws_size < WS_END) {
            fprintf(stderr, "kernel_launch: unexpected shapes (n_in %d, in0 %d, out %d, ws %zu); nothing launched\n", n_in, n_in > 0 ? in_sizes[0] : -1, out_size, ws_size); grid = -1; return; }
        int dev = 0, cus = 0, per_cu = 0;
        if (hipGetDevice(&dev) != hipSuccess || hipDeviceGetAttribute(&cus, hipDeviceAttributeMultiprocessorCount, dev) != hipSuccess) { grid = -1; return; }
        if (hipFuncSetAttribute((const void*)hybrid_fwd, hipFuncAttributeMaxDynamicSharedMemorySize, LDS_BYTES) != hipSuccess) { fprintf(stderr, "kernel_launch: hipFuncSetAttribute failed\n"); grid = -1; return; }
        if (hipOccupancyMaxActiveBlocksPerMultiprocessor(&per_cu, (const void*)hybrid_fwd, NWAVES * 64, LDS_BYTES) != hipSuccess || per_cu < 1)
            fprintf(stderr, "kernel_launch: note: occupancy query reports %d workgroups per CU\n", per_cu);
        (void)hipGetLastError();
        grid = cus;
        if (grid != 256) fprintf(stderr, "kernel_launch: %d CUs (built for 256)\n", grid);
    }
    if (grid < 0) return;
    if (hipMemsetAsync((char*)d_ws + WS_CTL, 0, CTL_ZERO_BYTES, stream) != hipSuccess) { fprintf(stderr, "kernel_launch: hipMemsetAsync failed\n"); return; }
    Params p{};
    const float** pp = (const float**)&p;
    for (int i = 0; i < 27; ++i) pp[i] = (const float*)d_in[i];
    p.out = (float*)d_out; p.ws = (unsigned char*)d_ws;
#if MK_PER_PHASE
    for (int k = 0; k < N_PHASES; ++k) { p.ph_lo = k; p.ph_hi = k + 1; hipLaunchKernelGGL(hybrid_fwd, dim3(grid), dim3(NWAVES * 64), LDS_BYTES, stream, p); }
#else
    p.ph_lo = 0; p.ph_hi = N_PHASES;
    hipLaunchKernelGGL(hybrid_fwd, dim3(grid), dim3(NWAVES * 64), LDS_BYTES, stream, p);
#endif
    const hipError_t le = hipPeekAtLastError();
    if (le != hipSuccess) fprintf(stderr, "kernel_launch: launch failed: %s\n", hipGetErrorName(le));
}
```

```cpp
#include <hip/hip_runtime.h>
#include <cstdio>
#include <cstdint>
namespace pg8 {
#define PG8_LAS __attribute__((address_space(3)))
typedef unsigned short bf16_t;
typedef short bf16x8 __attribute__((ext_vector_type(8)));
typedef float f32x4 __attribute__((ext_vector_type(4)));
typedef unsigned u32x4 __attribute__((ext_vector_type(4)));
constexpr int BM = 256, BK = 64, HALF = 128, HTB = HALF * BK * 2  , STAGE_BYTES = 8 * HTB, NXCD = 8, WGM = 8;

__host__ __device__ __forceinline__ int lds_byte(int r, int c) { const int st = (r >> 4) * 2 + (c >> 5), rr = r & 15, cc = c & 31, ob = rr * 64 + cc * 2; return st * 1024 + (ob ^ (((ob >> 9) & 1) << 5)); }
__host__ __device__ __forceinline__ void stage_rc(int b, int& R, int& C) { const int st = b / 1024, sb = b % 1024, swz = sb ^ (((sb >> 9) & 1) << 5); R = (st >> 1) * 16 + swz / 64; C = (st & 1) * 32 + (swz % 64) / 2; }
__host__ __device__ __forceinline__ int perm32(int rho) { const int n = rho >> 4, i = rho & 15; return 8 * (i >> 2) + 4 * n + (i & 3); }

struct Unit { int pm, pn; };
struct Gemm { const bf16_t* A; const bf16_t* Bt; int M, N, K; };

struct StaticOrder {
    int nM, nN, nwg, G, c;
    __host__ __device__ void init(int M, int N, int G_, int c_) { nM = M / BM; nN = N / BM; nwg = nM * nN; G = G_; c = c_; }
    __host__ __device__ bool next(int i, Unit& u) const {
        const long L = (long)i * G + c; if (L >= nwg) return false;
        int wgid = (int)L; { const int q = nwg / NXCD, r = nwg % NXCD, xcd = wgid % NXCD, off = wgid / NXCD; wgid = (xcd < r ? xcd * (q + 1) : r * (q + 1) + (xcd - r) * q) + off; }
        const int nig = WGM * nN, gid = wgid / nig, fm = gid * WGM, gsz = (nM - fm) < WGM ? (nM - fm) : WGM;
        u.pm = fm + ((wgid % nig) % gsz); u.pn = (wgid % nig) / gsz; return true;
    }
    __device__ __forceinline__ void a_ready(const Unit&) const {}
    __device__ __forceinline__ void done(const Unit&) const {}
};

__device__ __forceinline__ unsigned cvt_pk_bf16(float lo, float hi) { unsigned r; asm volatile("v_cvt_pk_bf16_f32 %0, %1, %2" : "=v"(r) : "v"(lo), "v"(hi)); return r; }
template <class Epi, class Sched, bool ALIGN_EPI = false, bool SP2 = false>
__device__ __forceinline__ void gemm_phase(PG8_LAS unsigned char* lds, const Gemm g, const Sched& S, const Epi& E) {
    const int tid = threadIdx.x, wid = __builtin_amdgcn_readfirstlane(tid >> 6), lane = tid & 63, wr = wid >> 2, wc = wid & 3, fr = lane & 15, fq = lane >> 4;
    const int K = g.K, nt = K / BK;
    unsigned voffA[2], voffB[2];
#pragma unroll
    for (int i = 0; i < 2; ++i) { int R, C; stage_rc(tid * 16 + i * 8192, R, C); const int Rb = Epi::PERM ? ((R & ~31) + perm32(R & 31)) : R;
        voffA[i] = (unsigned)(R * K + C) * 2u; voffB[i] = (unsigned)(Rb * K + C) * 2u; }
    const size_t kstep = (size_t)(BK * 2);
    const size_t hstep = (size_t)HALF * K * 2;
    const size_t tstep = 2 * hstep;
    const unsigned ldsw = (unsigned)wid * 1024u;
    const int aoff = lds_byte(wr * 64 + fr, fq * 8), boff = lds_byte(wc * 32 + fr, fq * 8);
#define PG8_SA(b, h) (((b) * 2 + (h)) * HTB)
#define PG8_SB(b, h) ((4 + (b) * 2 + (h)) * HTB)
#define PG8_STAGE(bufoff, gbase, voff) do { _Pragma("unroll") for (int _i = 0; _i < 2; ++_i) \
        __builtin_amdgcn_global_load_lds((const unsigned*)((const char*)(gbase) + (voff)[_i]), (PG8_LAS unsigned*)(lds + (bufoff) + ldsw + _i * 8192), 16, 0, 0); } while (0)
#define PG8_LDA(dst, b, h) do { _Pragma("unroll") for (int m = 0; m < 4; ++m) _Pragma("unroll") for (int k = 0; k < 2; ++k) dst[m][k] = *(const PG8_LAS bf16x8*)(lds + PG8_SA(b, h) + aoff + m * 2048 + k * 1024); } while (0)
#define PG8_LDB(dst, b, h) do { _Pragma("unroll") for (int n = 0; n < 2; ++n) _Pragma("unroll") for (int k = 0; k < 2; ++k) dst[n][k] = *(const PG8_LAS bf16x8*)(lds + PG8_SB(b, h) + boff + n * 2048 + k * 1024); } while (0)
#define PG8_MMA(ai, bj, At, Bt) do { __builtin_amdgcn_s_setprio(1); _Pragma("unroll") for (int m = 0; m < 4; ++m) _Pragma("unroll") for (int n = 0; n < 2; ++n) _Pragma("unroll") for (int k = 0; k < 2; ++k) \
        acc[ai][bj][m][n] = __builtin_amdgcn_mfma_f32_16x16x32_bf16(Bt[n][k], At[m][k], acc[ai][bj][m][n], 0, 0, 0); __builtin_amdgcn_s_setprio(0); } while (0)
#define PG8_WAIT_V(n) asm volatile("s_waitcnt vmcnt(" #n ")" ::: "memory")
#define PG8_WAIT_L(n) asm volatile("s_waitcnt lgkmcnt(" #n ")" ::: "memory")
#define PG8_BAR __builtin_amdgcn_s_barrier()
#define PG8_SCHED __builtin_amdgcn_sched_barrier(0)
    Unit cur, nxt; int ui = 0;
    if (!S.next(0, cur)) return;
    f32x4 acc[2][2][4][2];
#pragma unroll
    for (int a = 0; a < 2; ++a)
#pragma unroll
        for (int b = 0; b < 2; ++b)
#pragma unroll
            for (int m = 0; m < 4; ++m)
#pragma unroll
                for (int n = 0; n < 2; ++n) acc[a][b][m][n] = (f32x4){0.f, 0.f, 0.f, 0.f};
    bf16x8 At[4][2], B0[2][2], B1[2][2];
    const char* cA = (const char*)g.A + (size_t)cur.pm * tstep; const char* cB = (const char*)g.Bt + (size_t)cur.pn * tstep;
    S.a_ready(cur);
    if constexpr (SP2) {
        PG8_STAGE(PG8_SB(0, 0), cB, voffB); PG8_STAGE(PG8_SB(0, 1), cB + hstep, voffB); PG8_STAGE(PG8_SA(0, 0), cA, voffA); PG8_STAGE(PG8_SA(0, 1), cA + hstep, voffA);
        if (wr == 1) PG8_BAR;
        PG8_WAIT_V(2); PG8_BAR;
        PG8_STAGE(PG8_SB(1, 0), cB + kstep, voffB); PG8_STAGE(PG8_SA(1, 0), cA + kstep, voffA); PG8_STAGE(PG8_SB(1, 1), cB + hstep + kstep, voffB);
        PG8_WAIT_V(6); PG8_BAR;
    } else {
        PG8_STAGE(PG8_SB(0, 0), cB, voffB); PG8_STAGE(PG8_SA(0, 0), cA, voffA); PG8_STAGE(PG8_SB(0, 1), cB + hstep, voffB); PG8_STAGE(PG8_SA(0, 1), cA + hstep, voffA);
        if (wr == 1) PG8_BAR;
        PG8_WAIT_V(4); PG8_BAR;
        PG8_STAGE(PG8_SB(1, 0), cB + kstep, voffB); PG8_STAGE(PG8_SA(1, 0), cA + kstep, voffA); PG8_STAGE(PG8_SB(1, 1), cB + hstep + kstep, voffB);
        PG8_WAIT_V(6); PG8_BAR;
    }
    for (;;) {
        const bool has_next = S.next(ui + 1, nxt);
        const char* nA = has_next ? (const char*)g.A + (size_t)nxt.pm * tstep : cA; const char* nB = has_next ? (const char*)g.Bt + (size_t)nxt.pn * tstep : cB;
        for (int t = 0; t < nt; t += 2) {
            const bool last = (t == nt - 2);
            const char* a1 = cA + (size_t)(t + 1) * kstep;
            const char* a2 = last ? nA : cA + (size_t)(t + 2) * kstep; const char* b2 = last ? nB : cB + (size_t)(t + 2) * kstep;
            const char* a3 = a2 + kstep; const char* b3 = b2 + kstep;
            if (last && has_next) S.a_ready(nxt);
            if constexpr (SP2) {
            PG8_LDB(B0, 0, 0); PG8_LDB(B1, 0, 1); PG8_SCHED; PG8_LDA(At, 0, 0); PG8_STAGE(PG8_SA(1, 1), a1 + hstep, voffA);
            PG8_WAIT_V(8); PG8_WAIT_L(0); PG8_BAR; PG8_MMA(0, 0, At, B0); PG8_MMA(0, 1, At, B1); PG8_BAR; PG8_SCHED;
            PG8_LDA(At, 0, 1); PG8_STAGE(PG8_SB(0, 0), b2, voffB); PG8_STAGE(PG8_SB(0, 1), b2 + hstep, voffB); PG8_STAGE(PG8_SA(0, 0), a2, voffA);
            PG8_WAIT_V(8); PG8_WAIT_L(0); PG8_BAR; PG8_MMA(1, 0, At, B0); PG8_MMA(1, 1, At, B1); PG8_BAR; PG8_SCHED;
            PG8_LDB(B0, 1, 0); PG8_LDB(B1, 1, 1); PG8_SCHED; PG8_LDA(At, 1, 0); PG8_STAGE(PG8_SA(0, 1), a2 + hstep, voffA);
            PG8_WAIT_V(8); PG8_WAIT_L(0); PG8_BAR; PG8_MMA(0, 0, At, B0); PG8_MMA(0, 1, At, B1); PG8_BAR; PG8_SCHED;
            PG8_LDA(At, 1, 1); PG8_STAGE(PG8_SB(1, 0), b3, voffB); PG8_STAGE(PG8_SB(1, 1), b3 + hstep, voffB); PG8_STAGE(PG8_SA(1, 0), a3, voffA);
            PG8_WAIT_V(8); PG8_WAIT_L(0); PG8_BAR; PG8_MMA(1, 0, At, B0); PG8_MMA(1, 1, At, B1); PG8_BAR; PG8_SCHED;
            } else {
            PG8_LDB(B0, 0, 0); PG8_SCHED; PG8_LDA(At, 0, 0); PG8_STAGE(PG8_SA(1, 1), a1 + hstep, voffA);
            PG8_WAIT_L(8); PG8_BAR; PG8_WAIT_L(0); PG8_MMA(0, 0, At, B0); PG8_BAR; PG8_SCHED;
            PG8_LDB(B1, 0, 1); PG8_STAGE(PG8_SB(0, 0), b2, voffB);
            PG8_BAR; PG8_WAIT_L(0); PG8_MMA(0, 1, At, B1); PG8_BAR;
            PG8_LDA(At, 0, 1); PG8_STAGE(PG8_SA(0, 0), a2, voffA);
            PG8_BAR; PG8_WAIT_L(0); PG8_MMA(1, 0, At, B0); PG8_BAR; PG8_SCHED;
            PG8_STAGE(PG8_SB(0, 1), b2 + hstep, voffB);
            PG8_WAIT_V(6); PG8_BAR; PG8_MMA(1, 1, At, B1); PG8_BAR;
            PG8_LDB(B0, 1, 0); PG8_SCHED; PG8_LDA(At, 1, 0); PG8_STAGE(PG8_SA(0, 1), a2 + hstep, voffA);
            PG8_WAIT_L(8); PG8_BAR; PG8_WAIT_L(0); PG8_MMA(0, 0, At, B0); PG8_BAR; PG8_SCHED;
            PG8_LDB(B1, 1, 1); PG8_STAGE(PG8_SB(1, 0), b3, voffB);
            PG8_BAR; PG8_WAIT_L(0); PG8_MMA(0, 1, At, B1); PG8_BAR;
            PG8_LDA(At, 1, 1); PG8_STAGE(PG8_SA(1, 0), a3, voffA);
            PG8_BAR; PG8_WAIT_L(0); PG8_MMA(1, 0, At, B0); PG8_BAR; PG8_SCHED;
            PG8_STAGE(PG8_SB(1, 1), b3 + hstep, voffB);
            PG8_WAIT_V(6); PG8_BAR; PG8_MMA(1, 1, At, B1); PG8_BAR;
            }
        }
        if constexpr (ALIGN_EPI) { if (wr == 0) PG8_BAR; }
        if constexpr (!Epi::AFTER_DRAIN) { E(acc, cur, wr, wc, fr, fq); S.done(cur); }
        if (!has_next) break;
#pragma unroll
        for (int a = 0; a < 2; ++a)
#pragma unroll
            for (int b = 0; b < 2; ++b)
#pragma unroll
                for (int m = 0; m < 4; ++m)
#pragma unroll
                    for (int n = 0; n < 2; ++n) acc[a][b][m][n] = (f32x4){0.f, 0.f, 0.f, 0.f};
        cur = nxt; cA = nA; cB = nB; ++ui;
        if constexpr (ALIGN_EPI) { if (wr == 1) PG8_BAR; }
    }
    PG8_WAIT_V(0);
    if constexpr (!ALIGN_EPI) { if (wr == 0) PG8_BAR; }
    PG8_BAR;
    if constexpr (Epi::AFTER_DRAIN) { E.fused(acc, cur, wr, wc, fr, fq, lds, wid, lane); S.done(cur); }
#undef PG8_SA
#undef PG8_SB
#undef PG8_STAGE
#undef PG8_LDA
#undef PG8_LDB
#undef PG8_MMA
#undef PG8_WAIT_V
#undef PG8_WAIT_L
#undef PG8_BAR
#undef PG8_SCHED
}
}

namespace pg8 {
__host__ __device__ __forceinline__ int permk(int kl) { return 8 * ((kl & 15) >> 2) + 4 * (kl >> 4) + (kl & 3); }
struct EpiBf16Rs {
    static constexpr bool PERM = true, AFTER_DRAIN = false;
    bf16_t* O0; int ld0; int ntile0; bf16_t* O1; int ld1; size_t stride1; const float* ssq; float cs;
    __device__ __forceinline__ void operator()(const f32x4 (&acc)[2][2][4][2], const Unit& u, int wr, int wc, int fr, int fq) const {
        bf16_t* base; int ld, colt;
        if (u.pn < ntile0) { base = O0; ld = ld0; colt = u.pn * BM; }
        else { const int q = u.pn - ntile0, per = ld1 / BM; base = O1 + (size_t)(q / per) * stride1; ld = ld1; colt = (q % per) * BM; }
        const int row0 = u.pm * BM + wr * 64 + fr, col0 = colt + wc * 32 + 8 * fq;
#pragma unroll
        for (int ai = 0; ai < 2; ++ai)
#pragma unroll
            for (int m = 0; m < 4; ++m) {
                const int row = row0 + ai * HALF + m * 16;
                float sc = cs; if (ssq) sc *= rsqrtf(ssq[row] * (1.0f / 1024.0f) + 1e-6f);
                bf16_t* rowp = base + (size_t)row * ld + col0;
#pragma unroll
                for (int bj = 0; bj < 2; ++bj) { const f32x4 v0 = acc[ai][bj][m][0] * sc, v1 = acc[ai][bj][m][1] * sc;
                    u32x4 w; w.x = cvt_pk_bf16(v0[0], v0[1]); w.y = cvt_pk_bf16(v0[2], v0[3]); w.z = cvt_pk_bf16(v1[0], v1[1]); w.w = cvt_pk_bf16(v1[2], v1[3]);
                    *(u32x4*)(rowp + bj * HALF) = w; } }
    }
};
struct EpiF16Rs {
    static constexpr bool PERM = true, AFTER_DRAIN = false;
    _Float16* O; int ld; const float* ssq;
    __device__ __forceinline__ void operator()(const f32x4 (&acc)[2][2][4][2], const Unit& u, int wr, int wc, int fr, int fq) const {
        typedef _Float16 f16x8 __attribute__((ext_vector_type(8)));
        const int row0 = u.pm * BM + wr * 64 + fr, col0 = u.pn * BM + wc * 32 + 8 * fq;
#pragma unroll
        for (int ai = 0; ai < 2; ++ai)
#pragma unroll
            for (int m = 0; m < 4; ++m) {
                const int row = row0 + ai * HALF + m * 16;
                const float sc = rsqrtf(ssq[row] * (1.0f / 1024.0f) + 1e-6f);
                _Float16* rowp = O + (size_t)row * ld + col0;
#pragma unroll
                for (int bj = 0; bj < 2; ++bj) { const f32x4 v0 = acc[ai][bj][m][0] * sc, v1 = acc[ai][bj][m][1] * sc;
                    f16x8 w; w[0] = (_Float16)v0[0]; w[1] = (_Float16)v0[1]; w[2] = (_Float16)v0[2]; w[3] = (_Float16)v0[3];
                    w[4] = (_Float16)v1[0]; w[5] = (_Float16)v1[1]; w[6] = (_Float16)v1[2]; w[7] = (_Float16)v1[3];
                    *(f16x8*)(rowp + bj * HALF) = w; } }
    }
};
template <bool BASE_F32> struct EpiResidBf {
    static constexpr bool PERM = true, AFTER_DRAIN = false;
    const float* basef; bf16_t* xb; float* ssq;
    __device__ __forceinline__ void operator()(const f32x4 (&acc)[2][2][4][2], const Unit& u, int wr, int wc, int fr, int fq) const {
        const int row0 = u.pm * BM + wr * 64 + fr, col0 = u.pn * BM + wc * 32 + 8 * fq;
#pragma unroll
        for (int ai = 0; ai < 2; ++ai)
#pragma unroll
            for (int m = 0; m < 4; ++m) {
                const int row = row0 + ai * HALF + m * 16; const size_t off = (size_t)row * 1024 + col0; float s = 0.f;
#pragma unroll
                for (int bj = 0; bj < 2; ++bj) { const size_t o2 = off + bj * HALF;
                    f32x4 b0, b1;
                    if (BASE_F32) { b0 = *(const f32x4*)(basef + o2); b1 = *(const f32x4*)(basef + o2 + 4); }
                    else { const u32x4 p = *(const u32x4*)(xb + o2);
                        b0 = (f32x4){__builtin_bit_cast(float, p.x << 16), __builtin_bit_cast(float, p.x & 0xffff0000u), __builtin_bit_cast(float, p.y << 16), __builtin_bit_cast(float, p.y & 0xffff0000u)};
                        b1 = (f32x4){__builtin_bit_cast(float, p.z << 16), __builtin_bit_cast(float, p.z & 0xffff0000u), __builtin_bit_cast(float, p.w << 16), __builtin_bit_cast(float, p.w & 0xffff0000u)}; }
                    const f32x4 o0 = b0 + acc[ai][bj][m][0], o1 = b1 + acc[ai][bj][m][1];
                    s += ((o0[0] * o0[0] + o0[1] * o0[1]) + (o0[2] * o0[2] + o0[3] * o0[3])) + ((o1[0] * o1[0] + o1[1] * o1[1]) + (o1[2] * o1[2] + o1[3] * o1[3]));
                    u32x4 w; w.x = cvt_pk_bf16(o0[0], o0[1]); w.y = cvt_pk_bf16(o0[2], o0[3]); w.z = cvt_pk_bf16(o1[0], o1[1]); w.w = cvt_pk_bf16(o1[2], o1[3]);
                    *(u32x4*)(xb + o2) = w; }
                s += __shfl_xor(s, 16); s += __shfl_xor(s, 32);
                if (fq == 0) atomicAdd(ssq + row, s);
            }
    }
};
struct EpiKV {
    static constexpr bool PERM = false, AFTER_DRAIN = false;
    bf16_t* Kb; bf16_t* VTp;
    __device__ __forceinline__ void operator()(const f32x4 (&acc)[2][2][4][2], const Unit& u, int wr, int wc, int fr, int fq) const {
        typedef unsigned u32x2v __attribute__((ext_vector_type(2)));
        const int row0 = u.pm * BM + wr * 64 + fr, col0 = u.pn * BM + wc * 32 + 4 * fq;
#pragma unroll
        for (int ai = 0; ai < 2; ++ai)
#pragma unroll
            for (int m = 0; m < 4; ++m) {
                const int row = row0 + ai * HALF + m * 16, b = row >> 8, key = row & 255;
#pragma unroll
                for (int bj = 0; bj < 2; ++bj)
#pragma unroll
                    for (int n = 0; n < 2; ++n) { const int col = col0 + bj * HALF + n * 16; const f32x4 v = acc[ai][bj][m][n];
                        const unsigned p01 = cvt_pk_bf16(v[0], v[1]), p23 = cvt_pk_bf16(v[2], v[3]);
                        if (col < 1024) { const int h = col >> 8, dh = col & 255; u32x2v w; w.x = p01; w.y = p23;
                            *(u32x2v*)(Kb + ((size_t)((b * 4 + h) * 256 + key)) * 256 + dh) = w; }
                        else { const int c2 = col - 1024, h = c2 >> 8, dv = c2 & 255, kp = (key & ~31) | permk(key & 31);
                            bf16_t* d = VTp + ((size_t)((b * 4 + h) * 256 + dv)) * 256 + kp;
                            d[0] = (bf16_t)(p01 & 0xffffu); d[256] = (bf16_t)(p01 >> 16); d[512] = (bf16_t)(p23 & 0xffffu); d[768] = (bf16_t)(p23 >> 16); } }
            }
    }
};
}
#ifndef PG8_SP2
#define PG8_SP2 true
#endif
#ifndef PG8_ALIGN
#define PG8_ALIGN true
#endif

constexpr int NWAVES = 8;
#ifndef MK_PER_PHASE
#define MK_PER_PHASE 0
#endif
constexpr int T = 16384, SEQ = 8192, D = 1024;
constexpr int N_PHASES = 12;

constexpr size_t MiB = 1u << 20, KiB = 1u << 10;
constexpr size_t WS_CTL = 0, CTL_ZERO_BYTES = 1 * MiB;
constexpr int CW_BAR = 4096;
constexpr size_t WS_SSQ1 = 64 * KiB, WS_SSQ2 = 128 * KiB;
constexpr size_t WS_AB = 1 * MiB;
constexpr size_t WS_HEND = WS_AB + 512 * KiB, WS_PEND = WS_HEND + 512 * KiB, WS_HIN = WS_PEND + 512 * KiB;
constexpr size_t WS_DEC = WS_HIN + 512 * KiB;
constexpr size_t WS_SUBK = 3 * MiB + 256 * KiB;
constexpr size_t WS_WIN = 4 * MiB, WS_WOUT = 10 * MiB, WS_WQ = 12 * MiB, WS_WKV = 14 * MiB, WS_WO = 18 * MiB, WS_PWQ = 20 * MiB;
constexpr size_t WS_MEMN = 24 * MiB, WS_KB = 25 * MiB, WS_VTP = 26 * MiB, WS_LRUWT = 27 * MiB, WS_USC = 27 * MiB + 256 * KiB, WS_VSC = 27 * MiB + 384 * KiB;
constexpr size_t WS_XB = 28 * MiB;
constexpr size_t WS_HLOC = 28 * MiB, WS_PCUM = 44 * MiB;
constexpr size_t WS_QKV = 60 * MiB;
constexpr size_t OUT_Y = 4 * MiB;
constexpr size_t OUT_END = OUT_Y + (size_t)16384 * 1024 * 2;
constexpr size_t WS_IDX = 60 * MiB, WS_GW = 68 * MiB;
constexpr size_t WS_UB = 60 * MiB;
constexpr size_t WS_XR = 108 * MiB, WS_Z = 124 * MiB, WS_GATE = 140 * MiB;
constexpr size_t WS_WN = 156 * MiB, WS_UF = 172 * MiB, WS_QD = 188 * MiB, WS_KD = 204 * MiB, WS_ATT = 220 * MiB;
constexpr size_t WS_VB = 228 * MiB;
constexpr size_t WS_Q = 188 * MiB, WS_AO = 124 * MiB;
constexpr size_t WS_PQ = 108 * MiB;
constexpr size_t WS_END = 244 * MiB;
constexpr int CW_GFLAG = 49152;
constexpr int CW_LRUCNT = 8192;
static_assert(WS_XR - WS_QKV == (size_t)T * 1536 * 2 && WS_Z - WS_XR == (size_t)T * 512 * 2 && WS_GATE - WS_Z == (size_t)T * 512 * 2, "in-proj outputs are contiguous");

constexpr int LDS_BYTES = 160 * 1024;
constexpr int MISC_OFF = 159 * 1024;

#define GAS __attribute__((address_space(1)))
#define LAS __attribute__((address_space(3)))
typedef unsigned short bf16;
typedef unsigned v4u __attribute__((ext_vector_type(4)));
typedef unsigned v2u __attribute__((ext_vector_type(2)));
typedef float f32x4 __attribute__((ext_vector_type(4)));
typedef short bf16x8 __attribute__((ext_vector_type(8)));
typedef GAS unsigned gu32;
#define LDS_WAIT() asm volatile("s_waitcnt lgkmcnt(0)" ::: "memory")
__device__ __forceinline__ void st16_wt(void* p, v4u v) { asm volatile("global_store_dwordx4 %0, %1, off sc0 sc1\n\ts_nop 1" :: "v"(p), "v"(v) : "memory"); }
__device__ __forceinline__ unsigned f2bf(float f) { unsigned u = __builtin_bit_cast(unsigned, f); return (u + 0x7fffu + ((u >> 16) & 1u)) >> 16; }
__device__ __forceinline__ unsigned pk2(float lo, float hi) { return f2bf(lo) | (f2bf(hi) << 16); }
__device__ __forceinline__ float bflo(unsigned u) { return __builtin_bit_cast(float, u << 16); }
__device__ __forceinline__ float bfhi(unsigned u) { return __builtin_bit_cast(float, u & 0xffff0000u); }
__device__ __forceinline__ float bf1(bf16 h) { return __builtin_bit_cast(float, (unsigned)h << 16); }
__device__ __forceinline__ float wave_sum(float v) {
#pragma unroll
    for (int o = 1; o < 64; o <<= 1) v += __shfl_xor(v, o);
    return v;
}
__device__ __forceinline__ float row16_sum(float v) {
    v += __builtin_bit_cast(float, __builtin_amdgcn_update_dpp(0, __builtin_bit_cast(int, v), 0xB1, 0xF, 0xF, true));
    v += __builtin_bit_cast(float, __builtin_amdgcn_update_dpp(0, __builtin_bit_cast(int, v), 0x4E, 0xF, 0xF, true));
    v += __builtin_bit_cast(float, __builtin_amdgcn_update_dpp(0, __builtin_bit_cast(int, v), 0x141, 0xF, 0xF, true));
    v += __builtin_bit_cast(float, __builtin_amdgcn_update_dpp(0, __builtin_bit_cast(int, v), 0x140, 0xF, 0xF, true));
    return v;
}
__device__ __forceinline__ float sigmoidf_(float x) { return __builtin_amdgcn_rcpf(1.0f + __expf(-x)); }
__device__ __forceinline__ float softplusf_(float x) { return fmaxf(x, 0.f) + log1pf(__expf(-fabsf(x))); }
__device__ __forceinline__ float siluf_(float x) { return x * __builtin_amdgcn_rcpf(1.0f + __expf(-x)); }
__device__ __forceinline__ float gelu_tanh(float x) { const float y = 0.7978845608028654f * (x + 0.044715f * x * x * x); const float e = __expf(2.0f * y); return x * (1.0f - __builtin_amdgcn_rcpf(1.0f + e)); }
__device__ __forceinline__ int permk(int kl) { return 8 * ((kl & 15) >> 2) + 4 * (kl >> 4) + (kl & 3); }

struct Params {
    const float *x, *mem, *norm_mix_w, *w_in, *conv_qkv_w, *gdn_a_log, *gdn_dt_bias, *gdn_norm_w, *lru_conv_w, *lru_conv_b, *lru_wa, *lru_ba, *lru_wx, *lru_bx, *lru_lambda, *w_out,
                *norm_xattn_w, *norm_mem_w, *xattn_wq, *xattn_wkv, *xattn_wo, *norm_ffn_w, *peer_wq, *peer_subkeys, *peer_u, *peer_v, *norm_final_w;
    float* out; unsigned char* ws; int ph_lo, ph_hi;
};
#define XB_TMO      128
#define XB_XCNT(j)  (256  + 64 * (j))
#define XB_XSUB(j)  (1280 + 64 * (j))
#define XB_XGEN(j)  (2304 + 64 * (j))
#define XB_TOP      3328
#define XB_TOPGEN   3392
#define XCD_BAR_WORDS 3456
#define XB_SPIN_CAP (1u << 18)

__device__ __forceinline__ unsigned xb_ld(unsigned* p)              { return __hip_atomic_load(p, __ATOMIC_RELAXED, __HIP_MEMORY_SCOPE_AGENT); }
__device__ __forceinline__ unsigned xb_add(unsigned* p, unsigned v) { return __hip_atomic_fetch_add(p, v, __ATOMIC_RELAXED, __HIP_MEMORY_SCOPE_AGENT); }
__device__ __forceinline__ unsigned xb_xcc_id() { return (unsigned)__builtin_amdgcn_s_getreg((3 << 11) | 20) & 0xFu; }
#define XB_SPIN(cond, bar) do { unsigned _sp = 0; while (cond) { __builtin_amdgcn_s_sleep(1); \
    if ((++_sp & 255u) == 0u) { if (xb_ld(&(bar)[XB_TMO])) break; if (_sp > XB_SPIN_CAP) { atomicAdd(&(bar)[XB_TMO], 1u); break; } } } } while (0)

struct XcdBarrier {
    unsigned* bar; unsigned x;
    volatile LAS unsigned* st;
};

__device__ __forceinline__ XcdBarrier xcd_barrier_post(unsigned* bar, volatile LAS unsigned* st) {
    XcdBarrier b; b.bar = bar; b.x = xb_xcc_id(); b.st = st;
    if (threadIdx.x == 0) (void)xb_add(&bar[XB_XCNT(b.x)], 1u);
    return b;
}
__device__ __forceinline__ void xcd_barrier_complete(unsigned* bar, unsigned x, unsigned& nloc, unsigned& nx) {
    const unsigned G = gridDim.x * gridDim.y * gridDim.z;
    unsigned sum, cnt, mine, sp = 0u;
    for (;;) {
        sum = 0u; cnt = 0u; mine = 0u;
#pragma unroll
        for (unsigned j = 0; j < 16; ++j) { const unsigned c = xb_ld(&bar[XB_XCNT(j)]); sum += c; cnt += (c > 0u) ? 1u : 0u; mine = (j == x) ? c : mine; }
        if (sum == G) break;
        __builtin_amdgcn_s_sleep(1);
        if ((++sp & 255u) == 0u) { if (xb_ld(&bar[XB_TMO])) break; if (sp > XB_SPIN_CAP) { atomicAdd(&bar[XB_TMO], 1u); break; } }
    }
    nloc = mine > 0u ? mine : 1u; nx = cnt > 0u ? cnt : 1u;
}

__device__ __forceinline__ void xcd_barrier(const XcdBarrier& b) {
    asm volatile("s_waitcnt vmcnt(0)" ::: "memory");
    __syncthreads();
    if (threadIdx.x == 0) {
        unsigned* bar = b.bar;
        __builtin_amdgcn_s_waitcnt(0);
        unsigned nloc = b.st[0], nx = b.st[1];
        if (nloc == 0u) { xcd_barrier_complete(bar, b.x, nloc, nx); b.st[0] = nloc; b.st[1] = nx; }
        const unsigned old = xb_add(&bar[XB_XSUB(b.x)], 1u);
        const unsigned gen = old / nloc;
        if (old + 1u == (gen + 1u) * nloc) {
            __builtin_amdgcn_fence(__ATOMIC_RELEASE, "agent");
            asm volatile("s_waitcnt vmcnt(0)" ::: "memory");
            const unsigned og = xb_add(&bar[XB_TOP], 1u);
            const unsigned tg = og / nx;
            if (og + 1u == (tg + 1u) * nx) xb_add(&bar[XB_TOPGEN], 1u);
            else XB_SPIN(xb_ld(&bar[XB_TOPGEN]) == tg, bar);
            __builtin_amdgcn_fence(__ATOMIC_ACQUIRE, "agent");
            xb_add(&bar[XB_XGEN(b.x)], 1u);
            asm volatile("s_waitcnt vmcnt(0)" ::: "memory");
        } else {
            XB_SPIN(xb_ld(&bar[XB_XGEN(b.x)]) == gen, bar);
            __builtin_amdgcn_fence(__ATOMIC_ACQUIRE, "agent");
            asm volatile("s_waitcnt vmcnt(0)" ::: "memory");
        }
    }
    __syncthreads();
}

__device__ __forceinline__ void p0_transpose_item(const float* W, int K, int ldw, int c0, int nblk, bf16* WT, int row_off, const float* ks, LAS float* scr, int item, int lane) {
    const int kb = item / nblk, nb = item % nblk, k0 = 64 * kb, n0 = 32 * nb;
#pragma unroll 8
    for (int i = 0; i < 32; ++i) { const int kk = 2 * i + (lane >> 5); float v = W[(size_t)(k0 + kk) * ldw + c0 + n0 + (lane & 31)]; if (ks) v *= ks[k0 + kk]; scr[kk * 33 + (lane & 31)] = v; }
    LDS_WAIT(); asm volatile("" ::: "memory");
    const int c = lane & 7;
#pragma unroll
    for (int j = 0; j < 4; ++j) { const int n = (lane >> 3) + 8 * j; const LAS float* s = scr + (8 * c) * 33 + n;
        v4u o; o.x = pk2(s[0 * 33], s[1 * 33]); o.y = pk2(s[2 * 33], s[3 * 33]); o.z = pk2(s[4 * 33], s[5 * 33]); o.w = pk2(s[6 * 33], s[7 * 33]);
        *(GAS v4u*)(WT + (size_t)(row_off + n0 + n) * K + k0 + 8 * c) = o; }
    LDS_WAIT(); asm volatile("" ::: "memory");
}

__device__ __forceinline__ void p0_prologue(const Params& P, LAS unsigned char* lds, int tid, int lane, int wave, int vcu, int G) {
    unsigned char* ws = P.ws;
    const int gw = vcu * NWAVES + wave, NGW = G * NWAVES;
    LAS float* wabl = (LAS float*)lds;
    for (int idx = tid; idx < 8192; idx += NWAVES * 64) { const int k = idx >> 3, c = idx & 7, j = k >> 8, l = (k >> 2) & 63, e = k & 3;
        wabl[((((j * 4 + e) * 2 + (c >> 2)) * 64 + l) << 2) + (c & 3)] = P.w_in[(size_t)k * 3080 + 2048 + c]; }
    __syncthreads();
    {
        bf16* XB0 = (bf16*)(ws + WS_XB); float* AB = (float*)(ws + WS_AB);
        f32x4 w4[4];
#pragma unroll
        for (int j = 0; j < 4; ++j) w4[j] = ((const f32x4*)P.norm_mix_w)[64 * j + lane];
        for (int m = gw; m < T; m += NGW) {
            const f32x4* xr = (const f32x4*)(P.x + (size_t)m * D) + lane;
            f32x4 v[4]; float s = 0.f;
#pragma unroll
            for (int j = 0; j < 4; ++j) { v[j] = xr[64 * j]; s += (v[j].x * v[j].x + v[j].y * v[j].y) + (v[j].z * v[j].z + v[j].w * v[j].w); }
            const float rstd = rsqrtf(wave_sum(s) * (1.0f / D) + 1e-6f);
            v2u* o8 = (v2u*)(XB0 + (size_t)m * D) + lane;
            float part[8];
#pragma unroll
            for (int c = 0; c < 8; ++c) part[c] = 0.f;
#pragma unroll
            for (int j = 0; j < 4; ++j) {
                v[j] = v[j] * rstd * w4[j];
                v2u o; o.x = pk2(v[j].x, v[j].y); o.y = pk2(v[j].z, v[j].w); o8[64 * j] = o;
#pragma unroll
                for (int e = 0; e < 4; ++e) {
                    const f32x4 wa = *(const LAS f32x4*)(wabl + ((((j * 4 + e) * 2 + 0) * 64 + lane) << 2));
                    const f32x4 wb = *(const LAS f32x4*)(wabl + ((((j * 4 + e) * 2 + 1) * 64 + lane) << 2));
                    const float hv = v[j][e];
                    part[0] += hv * wa.x; part[1] += hv * wa.y; part[2] += hv * wa.z; part[3] += hv * wa.w;
                    part[4] += hv * wb.x; part[5] += hv * wb.y; part[6] += hv * wb.z; part[7] += hv * wb.w;
                }
            }
#pragma unroll
            for (int c = 0; c < 8; ++c) part[c] = wave_sum(part[c]);
            float o = part[0];
#pragma unroll
            for (int c = 1; c < 8; ++c) o = (lane == c) ? part[c] : o;
            if (lane < 8) AB[(size_t)m * 8 + lane] = o;
        }
    }
    {
        bf16* MEMN = (bf16*)(ws + WS_MEMN);
        for (int m = gw; m < 512; m += NGW) {
            const f32x4* xr = (const f32x4*)(P.mem + (size_t)m * D) + lane;
            f32x4 v[4]; float s = 0.f;
#pragma unroll
            for (int j = 0; j < 4; ++j) { v[j] = xr[64 * j]; s += (v[j].x * v[j].x + v[j].y * v[j].y) + (v[j].z * v[j].z + v[j].w * v[j].w); }
            const float rstd = rsqrtf(wave_sum(s) * (1.0f / D) + 1e-6f);
            v2u* o8 = (v2u*)(MEMN + (size_t)m * D) + lane;
#pragma unroll
            for (int j = 0; j < 4; ++j) { const f32x4 w = ((const f32x4*)P.norm_mem_w)[64 * j + lane]; const f32x4 y = v[j] * rstd * w;
                v2u o; o.x = pk2(y.x, y.y); o.y = pk2(y.z, y.w); o8[64 * j] = o; }
        }
    }
    __syncthreads();
    {
        LAS float* scr = (LAS float*)(lds + wave * 16384);
        constexpr int I_IN1 = 16 * 48, I_IN2 = 16 * 16, I_KV = 16 * 64;
        constexpr int NITEMS = I_IN1 + 3 * I_IN2 + I_KV;
        for (int it = gw; it < NITEMS; it += NGW) {
            int r = it;
            if (r < I_IN1) { p0_transpose_item(P.w_in, 1024, 3080, 0, 48, (bf16*)(ws + WS_WIN), 0, nullptr, scr, r, lane); continue; } r -= I_IN1;
            if (r < I_IN2) { p0_transpose_item(P.w_in, 1024, 3080, 2056, 16, (bf16*)(ws + WS_WIN), 1536, nullptr, scr, r, lane); continue; } r -= I_IN2;
            if (r < I_IN2) { p0_transpose_item(P.w_in, 1024, 3080, 1536, 16, (bf16*)(ws + WS_WIN), 2048, nullptr, scr, r, lane); continue; } r -= I_IN2;
            if (r < I_IN2) { p0_transpose_item(P.w_in, 1024, 3080, 2568, 16, (bf16*)(ws + WS_WIN), 2560, nullptr, scr, r, lane); continue; } r -= I_IN2;
            p0_transpose_item(P.xattn_wkv, 1024, 2048, 0, 64, (bf16*)(ws + WS_WKV), 0, nullptr, scr, r, lane);
        }
    }
    {
        bf16* WT = (bf16*)(ws + WS_LRUWT);
        for (int it = vcu * NWAVES * 64 + tid; it < 8 * 2 * 64 * 8; it += G * NWAVES * 64) {
            const int i8 = it & 7, j = (it >> 3) & 63, m = (it >> 9) & 1, g = it >> 10;
            const float* src = (m ? P.lru_wx : P.lru_wa) + (size_t)(g * 64 + 8 * i8) * 64 + j;
            v4u o; o.x = pk2(src[0], src[64]); o.y = pk2(src[128], src[192]); o.z = pk2(src[256], src[320]); o.w = pk2(src[384], src[448]);
            *(v4u*)(WT + (size_t)it * 8) = o;
        }
    }
}

__device__ __forceinline__ void late_weight_prep(const Params& P, LAS unsigned char* lds, int lane, int wave, int gw, int NGW) {
    unsigned char* ws = P.ws;
    {
        LAS float* scr = (LAS float*)(lds + wave * 16384);
        constexpr int I_OUT = 16 * 32, I_Q = 16 * 32, I_O = 16 * 32;
        for (int it = gw; it < I_OUT + I_Q + I_O; it += NGW) {
            int r = it;
            if (r < I_OUT) { p0_transpose_item(P.w_out, 1024, 1024, 0, 32, (bf16*)(ws + WS_WOUT), 0, nullptr, scr, r, lane); continue; } r -= I_OUT;
            if (r < I_Q) { p0_transpose_item(P.xattn_wq, 1024, 1024, 0, 32, (bf16*)(ws + WS_WQ), 0, P.norm_xattn_w, scr, r, lane); continue; } r -= I_Q;
            p0_transpose_item(P.xattn_wo, 1024, 1024, 0, 32, (bf16*)(ws + WS_WO), 0, nullptr, scr, r, lane);
        }
    }
    {
        bf16* WF = (bf16*)(ws + WS_PWQ);
        const int col = lane & 15, g = lane >> 4;
        for (int it = gw; it < 16 * 64; it += NGW) {
            const int hp = it >> 6, k0 = (it & 63) * 16;
            bf16x8 bq[4];
#pragma unroll
            for (int s = 0; s < 4; ++s) { const f32x4* src = (const f32x4*)(P.peer_wq + (size_t)(k0 + col) * 2048 + hp * 128 + 32 * s + 8 * g);
                const f32x4 a = src[0], c = src[1]; v4u pk; pk.x = pk2(a.x, a.y); pk.y = pk2(a.z, a.w); pk.z = pk2(c.x, c.y); pk.w = pk2(c.z, c.w); bq[s] = __builtin_bit_cast(bf16x8, pk); }
            const float nw = P.norm_ffn_w[k0 + col];
#pragma unroll 2
            for (int kt = 0; kt < 8; ++kt) {
                f32x4 acc = (f32x4){0.f, 0.f, 0.f, 0.f};
#pragma unroll
                for (int s = 0; s < 4; ++s) { const f32x4* src = (const f32x4*)(P.peer_subkeys + (size_t)(hp * 128 + 16 * kt + col) * 128 + 32 * s + 8 * g);
                    const f32x4 a = src[0], c = src[1]; v4u pk; pk.x = pk2(a.x, a.y); pk.y = pk2(a.z, a.w); pk.z = pk2(c.x, c.y); pk.w = pk2(c.z, c.w);
                    acc = __builtin_amdgcn_mfma_f32_16x16x32_bf16(__builtin_bit_cast(bf16x8, pk), bq[s], acc, 0, 0, 0); }
#pragma unroll
                for (int i = 0; i < 4; ++i) WF[(size_t)(hp * 128 + 16 * kt + 4 * g + i) * 1024 + k0 + col] = (bf16)f2bf(acc[i] * nw);
            }
        }
    }
}

constexpr int GL_KS = 0, GL_VS = 33792, GL_KB = 67584, GL_QB = 84992, GL_RAW = 102400, GL_CW = 153856, GL_AMT = 133120, GL_SM = 160000, GL_ATT = 151808, GL_SOL = 67584;
static_assert(GL_CW + 6144 <= GL_SM && GL_SM + 1284 <= MISC_OFF && GL_SOL + 65536 <= GL_AMT && GL_AMT + 17408 <= GL_ATT && GL_ATT + 8192 <= GL_SM && GL_RAW + 51456 <= GL_CW, "gdn_local LDS map");
#ifndef GL_REP_STEP
#define GL_REP_STEP -1
#endif
#define GL_REPF(k) for (int rr_ = 0; rr_ < ((GL_REP_STEP == (k)) ? 2 : 1); ++rr_)
#define GL_BAR() do { asm volatile("s_waitcnt lgkmcnt(0)" ::: "memory"); __builtin_amdgcn_s_barrier(); asm volatile("" ::: "memory"); } while (0)
__device__ __forceinline__ void gdn_local_item(const Params& P, LAS unsigned char* lds, int item, int tid) {
    unsigned char* ws = P.ws;
    asm volatile("" : "+v"(tid));
    const int b = item >> 9, h = (item >> 7) & 3, n = item & 127;
    const int t0 = b * SEQ + n * 64;
    const int lane = tid & 63, wave = __builtin_amdgcn_readfirstlane(tid >> 6);
    LAS float* ks = (LAS float*)(lds + GL_KS);
    LAS float* vs = (LAS float*)(lds + GL_VS);
    LAS bf16* kb16 = (LAS bf16*)(lds + GL_KB);
    LAS bf16* qb16 = (LAS bf16*)(lds + GL_QB);
    LAS bf16* raw = (LAS bf16*)(lds + GL_RAW);
    LAS float* cw = (LAS float*)(lds + GL_CW);
    LAS float* AmT = (LAS float*)(lds + GL_AMT);
    LAS float* sg = (LAS float*)(lds + GL_SM);
    LAS float* sbeta = sg + 64; LAS float* sgc = sbeta + 64; LAS float* seg = sgc + 64; LAS float* sek = seg + 64;
    LAS bf16* atts = (LAS bf16*)(lds + GL_ATT);
    const bf16* QKV = (const bf16*)(ws + WS_QKV);
    const float* AB = (const float*)(ws + WS_AB);
    GL_REPF(0) {
        v4u pr[7];
#pragma unroll
        for (int r = 0; r < 7; ++r) {
            const int id = tid + 512 * r;
            const int row = id / 48, rem = id - row * 48, part = rem >> 4, ck = rem & 15, s = n * 64 + row - 3;
            pr[r] = (v4u){0u, 0u, 0u, 0u};
            if (id < 67 * 48 && s >= 0) pr[r] = *(const v4u*)(QKV + (size_t)(b * SEQ + s) * 1536 + part * 512 + h * 128 + ck * 8);
        }
        f32x4 cwv = (f32x4){0.f, 0.f, 0.f, 0.f};
        if (tid < 384) { const int j = tid / 96, rem = tid - j * 96, part = rem >> 5, c4 = rem & 31; cwv = *(const f32x4*)(P.conv_qkv_w + j * 1536 + part * 512 + h * 128 + c4 * 4); }
        float a_in = 0.f, b_in = 0.f;
        if (tid < 64) { a_in = AB[(size_t)(t0 + tid) * 8 + h]; b_in = AB[(size_t)(t0 + tid) * 8 + 4 + h]; }
#pragma unroll
        for (int r = 0; r < 7; ++r) { const int id = tid + 512 * r; if (id < 67 * 48) *(LAS v4u*)(raw + id * 8) = pr[r]; }
        if (tid < 384) *(LAS f32x4*)(cw + tid * 4) = cwv;
        if (tid < 64) { sg[tid] = -__expf(P.gdn_a_log[h]) * softplusf_(a_in + P.gdn_dt_bias[h]); sbeta[tid] = sigmoidf_(b_in); }
    }
    GL_BAR();
    GL_REPF(1) {
        const int c = tid >> 3, grp = tid & 7;
#pragma unroll 1
        for (int part = 0; part < 3; ++part) {
            float y[16];
#pragma unroll
            for (int i = 0; i < 16; ++i) y[i] = 0.f;
#pragma unroll
            for (int j = 0; j < 4; ++j) {
                const LAS v4u* src = (const LAS v4u*)(raw + (c + j) * 384 + part * 128 + grp * 16);
                const v4u x0 = src[0], x1 = src[1];
                const LAS f32x4* wp = (const LAS f32x4*)(cw + (j * 3 + part) * 128 + grp * 16);
                const f32x4 w0 = wp[0], w1 = wp[1], w2 = wp[2], w3 = wp[3];
                y[0] += w0.x * bflo(x0.x); y[1] += w0.y * bfhi(x0.x); y[2] += w0.z * bflo(x0.y); y[3] += w0.w * bfhi(x0.y);
                y[4] += w1.x * bflo(x0.z); y[5] += w1.y * bfhi(x0.z); y[6] += w1.z * bflo(x0.w); y[7] += w1.w * bfhi(x0.w);
                y[8] += w2.x * bflo(x1.x); y[9] += w2.y * bfhi(x1.x); y[10] += w2.z * bflo(x1.y); y[11] += w2.w * bfhi(x1.y);
                y[12] += w3.x * bflo(x1.z); y[13] += w3.y * bfhi(x1.z); y[14] += w3.z * bflo(x1.w); y[15] += w3.w * bfhi(x1.w);
            }
            float ss = 0.f;
#pragma unroll
            for (int i = 0; i < 16; ++i) { y[i] = siluf_(y[i]); ss += y[i] * y[i]; }
            if (part < 2) {
                ss += __shfl_xor(ss, 1); ss += __shfl_xor(ss, 2); ss += __shfl_xor(ss, 4);
                const float sc = rsqrtf(ss + 1e-6f) * (part == 0 ? 0.08838834764831845f : 1.0f);
#pragma unroll
                for (int i = 0; i < 16; ++i) y[i] *= sc;
            }
            if (part >= 1) {
                LAS float* dst = (part == 1 ? ks : vs) + c * 132 + grp * 16;
#pragma unroll
                for (int i = 0; i < 4; ++i) *(LAS f32x4*)(dst + 4 * i) = (f32x4){y[4 * i], y[4 * i + 1], y[4 * i + 2], y[4 * i + 3]};
            }
            if (part <= 1) {
                LAS bf16* dst = (part == 0 ? qb16 : kb16) + c * 136 + grp * 16;
                v4u o0, o1; o0.x = pk2(y[0], y[1]); o0.y = pk2(y[2], y[3]); o0.z = pk2(y[4], y[5]); o0.w = pk2(y[6], y[7]);
                o1.x = pk2(y[8], y[9]); o1.y = pk2(y[10], y[11]); o1.z = pk2(y[12], y[13]); o1.w = pk2(y[14], y[15]);
                *(LAS v4u*)dst = o0; *(LAS v4u*)(dst + 8) = o1;
            }
        }
    }
    if (tid < 64) {
        float v = sg[tid];
#pragma unroll
        for (int off = 1; off < 64; off <<= 1) { const float t = __shfl_up(v, off); if (tid >= off) v += t; }
        sgc[tid] = v; seg[tid] = __expf(v);
        const float gl = __shfl(v, 63);
        sek[tid] = __expf(gl - v);
        if (tid == 63) sek[64] = __expf(v);
    }
    GL_BAR();
    {
        const int mat = wave >> 2, rho = wave & 3, col = lane & 15, g = lane >> 4;
        const LAS bf16* X = mat ? qb16 : kb16;
        bf16x8 af[4];
#pragma unroll
        for (int s = 0; s < 4; ++s) af[s] = *(const LAS bf16x8*)(X + (16 * rho + col) * 136 + 32 * s + 8 * g);
#pragma unroll
        for (int sig = 0; sig < 4; ++sig) {
            f32x4 acc = (f32x4){0.f, 0.f, 0.f, 0.f};
#pragma unroll
            for (int s = 0; s < 4; ++s) { const bf16x8 bfr = *(const LAS bf16x8*)(kb16 + (16 * sig + col) * 136 + 32 * s + 8 * g); acc = __builtin_amdgcn_mfma_f32_16x16x32_bf16(af[s], bfr, acc, 0, 0, 0); }
            const int sidx = 16 * sig + col; const float gs = sgc[sidx];
#pragma unroll
            for (int i = 0; i < 4; ++i) {
                const int c = 16 * rho + 4 * g + i;
                const float dec = (c >= sidx) ? __expf(sgc[c] - gs) : 0.f;
                if (mat == 0) AmT[sidx * 68 + c] = (c > sidx) ? sbeta[c] * acc[i] * dec : 0.f;
                else atts[c * 64 + sidx] = (bf16)f2bf(acc[i] * dec);
            }
        }
    }
    GL_BAR();
    GL_REPF(4) {
        bf16* QD = (bf16*)(ws + WS_QD) + (size_t)item * 8192;
        bf16* KD = (bf16*)(ws + WS_KD) + (size_t)item * 8192;
        bf16* ATT = (bf16*)(ws + WS_ATT) + (size_t)item * 4096;
#pragma unroll
        for (int r = 0; r < 2; ++r) {
            const int id = tid + 512 * r;
            { const int c = id >> 4, gam = id & 15, s32 = gam >> 2, g = gam & 3;
              const v2u lo = *(const LAS v2u*)(qb16 + c * 136 + 32 * s32 + 4 * g), hi = *(const LAS v2u*)(qb16 + c * 136 + 32 * s32 + 16 + 4 * g);
              const float e = seg[c];
              v4u o; o.x = pk2(bflo(lo.x) * e, bfhi(lo.x) * e); o.y = pk2(bflo(lo.y) * e, bfhi(lo.y) * e); o.z = pk2(bflo(hi.x) * e, bfhi(hi.x) * e); o.w = pk2(bflo(hi.y) * e, bfhi(hi.y) * e);
              st16_wt(QD + c * 128 + 8 * gam, o); }
            { const int dk = id >> 3, gam = id & 7, s32 = gam >> 2, g = gam & 3, c0 = 32 * s32 + 4 * g;
              float v[8];
#pragma unroll
              for (int j = 0; j < 4; ++j) { v[j] = ks[(c0 + j) * 132 + dk] * sek[c0 + j]; v[4 + j] = ks[(c0 + 16 + j) * 132 + dk] * sek[c0 + 16 + j]; }
              v4u o; o.x = pk2(v[0], v[1]); o.y = pk2(v[2], v[3]); o.z = pk2(v[4], v[5]); o.w = pk2(v[6], v[7]);
              st16_wt(KD + dk * 64 + 8 * gam, o); }
        }
        { const int c = tid >> 3, gam = tid & 7, s32 = gam >> 2, g = gam & 3;
          const v2u lo = *(const LAS v2u*)(atts + c * 64 + 32 * s32 + 4 * g), hi = *(const LAS v2u*)(atts + c * 64 + 32 * s32 + 16 + 4 * g);
          v4u o; o.x = lo.x; o.y = lo.y; o.z = hi.x; o.w = hi.y;
          st16_wt(ATT + c * 64 + 8 * gam, o); }
    }
    GL_BAR();
    GL_REPF(5) {
        LAS float* xcol = (LAS float*)(lds + GL_SOL);
        LAS bf16* tinv = (LAS bf16*)(lds + GL_SOL + 17408);
        const int j = tid >> 3, part = tid & 7, jb = j >> 4, jo = j & 15;
#pragma unroll 1
        for (int rb = jb; rb < 4; ++rb) {
            float acc[16];
#pragma unroll
            for (int i = 0; i < 16; ++i) acc[i] = 0.f;
            if (rb > jb) {
#pragma unroll 2
                for (int s = 16 * jb + part; s < 16 * rb; s += 8) {
                    const float sv = xcol[j * 68 + s];
                    const LAS float* ar = AmT + s * 68 + 16 * rb;
#pragma unroll
                    for (int q = 0; q < 4; ++q) { const f32x4 A4 = *(const LAS f32x4*)(ar + 4 * q);
                        acc[4 * q] -= A4.x * sv; acc[4 * q + 1] -= A4.y * sv; acc[4 * q + 2] -= A4.z * sv; acc[4 * q + 3] -= A4.w * sv; }
                }
#pragma unroll
                for (int i = 0; i < 16; ++i) {
                    acc[i] += __builtin_bit_cast(float, __builtin_amdgcn_update_dpp(0, __builtin_bit_cast(int, acc[i]), 0xB1, 0xF, 0xF, true));
                    acc[i] += __builtin_bit_cast(float, __builtin_amdgcn_update_dpp(0, __builtin_bit_cast(int, acc[i]), 0x4E, 0xF, 0xF, true));
                    acc[i] += __builtin_bit_cast(float, __builtin_amdgcn_update_dpp(0, __builtin_bit_cast(int, acc[i]), 0x141, 0xF, 0xF, true));
                }
            } else {
#pragma unroll
                for (int i = 0; i < 16; ++i) acc[i] = (i == jo) ? 1.f : 0.f;
            }
#pragma unroll
            for (int i = 0; i < 16; ++i) {
                const float sv = acc[i];
                const LAS float* ar = AmT + (16 * rb + i) * 68 + 16 * rb;
#pragma unroll
                for (int q = (i + 1) / 4; q < 4; ++q) { const f32x4 A4 = *(const LAS f32x4*)(ar + 4 * q);
                    if (4 * q > i) acc[4 * q] -= A4.x * sv; if (4 * q + 1 > i) acc[4 * q + 1] -= A4.y * sv; if (4 * q + 2 > i) acc[4 * q + 2] -= A4.z * sv; if (4 * q + 3 > i) acc[4 * q + 3] -= A4.w * sv; }
            }
            if (part == 0) {
#pragma unroll
                for (int i = 0; i < 16; ++i) { xcol[j * 68 + 16 * rb + i] = acc[i]; tinv[(16 * rb + i) * 72 + j] = (bf16)f2bf(acc[i]); }
            }
            LDS_WAIT(); asm volatile("" ::: "memory");
        }
        for (int rb = 0; rb < jb; ++rb) {
            if (part == 0) {
#pragma unroll
                for (int i = 0; i < 16; ++i) tinv[(16 * rb + i) * 72 + j] = (bf16)0;
            }
        }
    }
    GL_BAR();
    GL_REPF(6) {
        const LAS bf16* tinv = (const LAS bf16*)(lds + GL_SOL + 17408);
        LAS bf16* wst = (LAS bf16*)(lds + GL_SOL + 17408 + 9216);
        const int col = lane & 15, g = lane >> 4, isw = wave >> 2;
        bf16x8 af[4][2];
#pragma unroll
        for (int rho = 0; rho < 4; ++rho)
#pragma unroll
            for (int s2 = 0; s2 < 2; ++s2) af[rho][s2] = *(const LAS bf16x8*)(tinv + (16 * rho + col) * 72 + 32 * s2 + 8 * g);
        bf16* UF = (bf16*)(ws + WS_UF) + (size_t)item * 8192;
#pragma unroll
        for (int sig = 0; sig < 2; ++sig) {
            const int jj = 32 * (wave & 3) + 16 * sig + col;
            const LAS float* src = (isw ? ks : vs) + jj;
            bf16x8 bfr[2];
#pragma unroll
            for (int s2 = 0; s2 < 2; ++s2) {
                float v[8];
#pragma unroll
                for (int e = 0; e < 8; ++e) { const int sidx = 32 * s2 + 8 * g + e; float x = src[sidx * 132] * sbeta[sidx]; if (isw) x *= seg[sidx]; v[e] = x; }
                v4u pk; pk.x = pk2(v[0], v[1]); pk.y = pk2(v[2], v[3]); pk.z = pk2(v[4], v[5]); pk.w = pk2(v[6], v[7]);
                bfr[s2] = __builtin_bit_cast(bf16x8, pk);
            }
            f32x4 acc[4];
#pragma unroll
            for (int rho = 0; rho < 4; ++rho) { acc[rho] = (f32x4){0.f, 0.f, 0.f, 0.f};
#pragma unroll
                for (int s2 = 0; s2 < 2; ++s2) acc[rho] = __builtin_amdgcn_mfma_f32_16x16x32_bf16(af[rho][s2], bfr[s2], acc[rho], 0, 0, 0); }
            if (!isw) {
                v4u o0, o1;
                o0.x = pk2(acc[0].x, acc[0].y); o0.y = pk2(acc[0].z, acc[0].w); o0.z = pk2(acc[1].x, acc[1].y); o0.w = pk2(acc[1].z, acc[1].w);
                o1.x = pk2(acc[2].x, acc[2].y); o1.y = pk2(acc[2].z, acc[2].w); o1.z = pk2(acc[3].x, acc[3].y); o1.w = pk2(acc[3].z, acc[3].w);
                v4u* d = (v4u*)(UF + (size_t)(2 * (wave & 3) + sig) * 1024 + lane * 16);
                st16_wt(d, o0); st16_wt(d + 1, o1);
            } else {
#pragma unroll
                for (int rho = 0; rho < 4; ++rho)
#pragma unroll
                    for (int i = 0; i < 4; ++i) wst[(16 * rho + 4 * g + i) * 136 + jj] = (bf16)f2bf(-acc[rho][i]);
            }
        }
    }
    GL_BAR();
    {
        const LAS bf16* wst = (const LAS bf16*)(lds + GL_SOL + 17408 + 9216);
        bf16* WN = (bf16*)(ws + WS_WN) + (size_t)item * 8192;
#pragma unroll
        for (int r = 0; r < 2; ++r) {
            const int id = tid + 512 * r, c = id >> 4, gam = id & 15, s32 = gam >> 2, g = gam & 3;
            const v2u lo = *(const LAS v2u*)(wst + c * 136 + 32 * s32 + 4 * g), hi = *(const LAS v2u*)(wst + c * 136 + 32 * s32 + 16 + 4 * g);
            v4u o; o.x = lo.x; o.y = lo.y; o.z = hi.x; o.w = hi.y;
            st16_wt(WN + c * 128 + 8 * gam, o);
        }
    }
    asm volatile("s_waitcnt vmcnt(0)" ::: "memory");
    GL_BAR();
    if (tid == 0) { unsigned fb = __builtin_bit_cast(unsigned, sek[64]); if (fb == 0u) fb = 1u;
        __hip_atomic_store((unsigned*)(ws + WS_CTL) + CW_GFLAG + item, fb, __ATOMIC_RELAXED, __HIP_MEMORY_SCOPE_AGENT); }
    GL_BAR();
}

constexpr int LL_XCB = 68608;
static_assert(LL_XCB + 64 * 1040 <= MISC_OFF, "lru_local LDS map");
__device__ __forceinline__ float expm1_small(float x) {
    const float p = x * (1.0f + x * (0.5f + x * (0.16666667f + x * (0.041666668f + x * 0.008333334f))));
    return (x > -0.25f) ? p : (__expf(x) - 1.0f);
}
__device__ __forceinline__ void lru_local_item(const Params& P, LAS unsigned char* lds, int lt, int tid, int lane, int wave) {
    unsigned char* ws = P.ws;
    asm volatile("" : "+v"(tid));
    const int b = lt >> 7, n = lt & 127, t0 = b * SEQ + n * 64;
    LAS bf16* rawx = (LAS bf16*)lds;
    LAS bf16* xcb = (LAS bf16*)(lds + LL_XCB);
    const bf16* XR = (const bf16*)(ws + WS_XR);
    {
        v4u pr[9];
#pragma unroll
        for (int r = 0; r < 9; ++r) { const int id = tid + 512 * r, row = id >> 6, ck = id & 63, s = n * 64 + row - 3;
            pr[r] = (v4u){0u, 0u, 0u, 0u};
            if (id < 67 * 64 && s >= 0) pr[r] = *(const v4u*)(XR + (size_t)(b * SEQ + s) * 512 + ck * 8); }
#pragma unroll
        for (int r = 0; r < 9; ++r) { const int id = tid + 512 * r; if (id < 67 * 64) *(LAS v4u*)(rawx + id * 8) = pr[r]; }
    }
    GL_BAR();
    {
        const int chg = tid & 63, tseg = tid >> 6, ch0 = chg * 8;
        float w[4][8], cb[8];
#pragma unroll
        for (int j = 0; j < 4; ++j) { const f32x4 a = *(const f32x4*)(P.lru_conv_w + j * 512 + ch0), c = *(const f32x4*)(P.lru_conv_w + j * 512 + ch0 + 4);
            w[j][0] = a.x; w[j][1] = a.y; w[j][2] = a.z; w[j][3] = a.w; w[j][4] = c.x; w[j][5] = c.y; w[j][6] = c.z; w[j][7] = c.w; }
        { const f32x4 a = *(const f32x4*)(P.lru_conv_b + ch0), c = *(const f32x4*)(P.lru_conv_b + ch0 + 4);
          cb[0] = a.x; cb[1] = a.y; cb[2] = a.z; cb[3] = a.w; cb[4] = c.x; cb[5] = c.y; cb[6] = c.z; cb[7] = c.w; }
        v4u xr[11];
#pragma unroll
        for (int r = 0; r < 11; ++r) xr[r] = *(const LAS v4u*)(rawx + (tseg * 8 + r) * 512 + ch0);
#pragma unroll
        for (int tk = 0; tk < 8; ++tk) {
            float y[8];
#pragma unroll
            for (int e = 0; e < 8; ++e) y[e] = cb[e];
#pragma unroll
            for (int j = 0; j < 4; ++j) { const v4u x = xr[tk + j];
                y[0] += w[j][0] * bflo(x.x); y[1] += w[j][1] * bfhi(x.x); y[2] += w[j][2] * bflo(x.y); y[3] += w[j][3] * bfhi(x.y);
                y[4] += w[j][4] * bflo(x.z); y[5] += w[j][5] * bfhi(x.z); y[6] += w[j][6] * bflo(x.w); y[7] += w[j][7] * bfhi(x.w); }
            v4u o; o.x = pk2(y[0], y[1]); o.y = pk2(y[2], y[3]); o.z = pk2(y[4], y[5]); o.w = pk2(y[6], y[7]);
            *(LAS v4u*)(xcb + (tseg * 8 + tk) * 520 + ch0) = o;
        }
    }
    GL_BAR();
    {
        const int g = wave, col = lane & 15, g4 = lane >> 4;
        LAS bf16* AM = (LAS bf16*)(lds + wave * 8192); LAS bf16* BT = AM + 2048;
        const bf16* WT = (const bf16*)(ws + WS_LRUWT) + (size_t)g * 8192;
        bf16x8 Bw[2][4][2];
#pragma unroll
        for (int m = 0; m < 2; ++m)
#pragma unroll
            for (int jt = 0; jt < 4; ++jt)
#pragma unroll
                for (int s2 = 0; s2 < 2; ++s2) Bw[m][jt][s2] = *(const bf16x8*)(WT + m * 4096 + (16 * jt + col) * 64 + 32 * s2 + 8 * g4);
        float cba[4], cbx[4], csp[4];
#pragma unroll
        for (int jt = 0; jt < 4; ++jt) { const int ch = g * 64 + 16 * jt + col; cba[jt] = P.lru_ba[ch]; cbx[jt] = P.lru_bx[ch]; csp[jt] = softplusf_(-P.lru_lambda[ch]); }
        bf16* HLOC = (bf16*)(ws + WS_HLOC); bf16* PCUM = (bf16*)(ws + WS_PCUM);
        const int chs = g * 64 + lane;
        float hst = 0.f, pc = 1.f;
#pragma unroll 1
        for (int half = 0; half < 2; ++half) {
            bf16x8 Af[2][2];
#pragma unroll
            for (int rho = 0; rho < 2; ++rho)
#pragma unroll
                for (int s2 = 0; s2 < 2; ++s2) Af[rho][s2] = *(const LAS bf16x8*)(xcb + (32 * half + 16 * rho + col) * 520 + g * 64 + 32 * s2 + 8 * g4);
#pragma unroll
            for (int jt = 0; jt < 4; ++jt) {
#pragma unroll
                for (int rho = 0; rho < 2; ++rho) {
                    f32x4 ra = (f32x4){0.f, 0.f, 0.f, 0.f}, rx = ra;
#pragma unroll
                    for (int s2 = 0; s2 < 2; ++s2) { ra = __builtin_amdgcn_mfma_f32_16x16x32_bf16(Af[rho][s2], Bw[0][jt][s2], ra, 0, 0, 0); rx = __builtin_amdgcn_mfma_f32_16x16x32_bf16(Af[rho][s2], Bw[1][jt][s2], rx, 0, 0, 0); }
#pragma unroll
                    for (int i = 0; i < 4; ++i) {
                        const int tokl = 16 * rho + 4 * g4 + i, chl = 16 * jt + col;
                        const float r = sigmoidf_(ra[i] + cba[jt]), ig = sigmoidf_(rx[i] + cbx[jt]);
                        const float log_a = -8.0f * r * csp[jt];
                        const float am = -expm1_small(log_a), a = 1.0f - am;
                        const float xo = bf1(xcb[(32 * half + tokl) * 520 + g * 64 + chl]);
                        const float bt = __builtin_amdgcn_sqrtf(fmaxf(am * (1.0f + a), 0.f)) * (ig * xo);
                        AM[tokl * 64 + chl] = (bf16)f2bf(am); BT[tokl * 64 + chl] = (bf16)f2bf(bt);
                    }
                }
            }
            LDS_WAIT(); asm volatile("" ::: "memory");
#pragma unroll 8
            for (int tk = 0; tk < 32; ++tk) {
                const float am = bf1(AM[tk * 64 + lane]), bt = bf1(BT[tk * 64 + lane]);
                hst = (hst - am * hst) + bt; pc = pc - am * pc;
                const size_t o = (size_t)(t0 + 32 * half + tk) * 512 + chs;
                HLOC[o] = (bf16)f2bf(hst); PCUM[o] = (bf16)f2bf(pc);
            }
            LDS_WAIT(); asm volatile("" ::: "memory");
        }
        ((float*)(ws + WS_HEND))[(size_t)lt * 512 + chs] = hst; ((float*)(ws + WS_PEND))[(size_t)lt * 512 + chs] = pc;
    }
    GL_BAR();
}

constexpr int SC_WN = 0, SC_QD = 64 * 272, SC_KD = 2 * 64 * 272, SC_ATT = 2 * 64 * 272 + 128 * 144, SC_BUF = 2 * 64 * 272 + 128 * 144 + 64 * 144;
constexpr int SC_SSQ = 2 * SC_BUF;
__device__ __forceinline__ int sc_lds_off(int id) {
    if (id < 1024) return SC_WN + (id >> 4) * 272 + (id & 15) * 16;
    if (id < 2048) { const int q = id - 1024; return SC_QD + (q >> 4) * 272 + (q & 15) * 16; }
    if (id < 3072) { const int q = id - 2048; return SC_KD + (q >> 3) * 144 + (q & 7) * 16; }
    const int q = id - 3072; return SC_ATT + (q >> 3) * 144 + (q & 7) * 16;
}
__device__ __forceinline__ const v4u* sc_src(const unsigned char* ws, int item, int id) {
    if (id < 1024) return (const v4u*)(ws + WS_WN + (size_t)item * 16384) + id;
    if (id < 2048) return (const v4u*)(ws + WS_QD + (size_t)item * 16384) + (id - 1024);
    if (id < 3072) return (const v4u*)(ws + WS_KD + (size_t)item * 16384) + (id - 2048);
    return (const v4u*)(ws + WS_ATT + (size_t)item * 8192) + (id - 3072);
}
__device__ __forceinline__ bf16x8 pack_b(const f32x4 a, const f32x4 b) {
    v4u r; r.x = pk2(a.x, a.y); r.y = pk2(a.z, a.w); r.z = pk2(b.x, b.y); r.w = pk2(b.z, b.w);
    return __builtin_bit_cast(bf16x8, r);
}
#define SC_BAR() do { asm volatile("s_waitcnt lgkmcnt(0)" ::: "memory"); __builtin_amdgcn_s_barrier(); asm volatile("" ::: "memory"); } while (0)
#define SC_GLD(dst, ptr) asm volatile("global_load_dwordx4 %0, %1, off" : "=v"(dst) : "v"(ptr) : "memory")
#define PIN8(a) asm volatile("" : "+v"(a[0]), "+v"(a[1]), "+v"(a[2]), "+v"(a[3]), "+v"(a[4]), "+v"(a[5]), "+v"(a[6]), "+v"(a[7]))
#define PIN16(a) asm volatile("" : "+v"(a[0]), "+v"(a[1]), "+v"(a[2]), "+v"(a[3]), "+v"(a[4]), "+v"(a[5]), "+v"(a[6]), "+v"(a[7]), "+v"(a[8]), "+v"(a[9]), "+v"(a[10]), "+v"(a[11]), "+v"(a[12]), "+v"(a[13]), "+v"(a[14]), "+v"(a[15]))
constexpr int SCAN_NWC = 2, SCAN_PARTS = 4, SCAN_WGS = 8 * SCAN_PARTS;
constexpr int SC_UFS = 2 * SC_BUF;
constexpr int SC_DECS = SC_UFS + 2 * SCAN_NWC * 2048;
constexpr int SC_OT = SC_DECS + 512;
constexpr int SC_RDY = SC_OT + 2 * 64 * 36 * 4;
constexpr int SC_END = SC_RDY + 64;
static_assert(SC_END <= MISC_OFF, "scan LDS");
#ifndef SCAN_REPS
#define SCAN_REPS 1
#endif
#ifndef SCAN_EXP
#define SCAN_EXP 0
#endif
__device__ __forceinline__ int sc3_lds_off(int id) {
    if (id < 3584) return sc_lds_off(id);
    return SC_UFS + (id - 3584) * 16;
}
__device__ __forceinline__ const v4u* sc3_src(const unsigned char* ws, int item, int id, int part) {
    if (id < 3584) return sc_src(ws, item, id);
    return (const v4u*)(ws + WS_UF + (size_t)item * 16384 + (size_t)(part * SCAN_NWC) * 2048) + (id - 3584);
}
__device__ __forceinline__ void gdn_scan(const Params& P, LAS unsigned char* lds, int sb, int tid, int lane, int wave) {
    const unsigned char* ws = P.ws;
    constexpr int NCH = 128 * SCAN_REPS, NPC = 15;
    const int bh = sb & 7, part = sb >> 3;
    const int b = bh >> 2, h = bh & 3, col = lane & 15, g = lane >> 4;
    const int item0 = bh * 128;
    if (tid == 0) *(volatile LAS unsigned*)(lds + SC_RDY) = 0u;
    SC_BAR();
    if (wave >= 4) {
        constexpr int NP = 15, DEP = 3;
        const int lt = tid - 256;
        const unsigned voff = (unsigned)lt * 16u;
        const int lA = (lt >> 4) * 272 + (lt & 15) * 16, lB = (lt >> 3) * 144 + (lt & 7) * 16, lU = SC_UFS + lt * 16;
        v4u rs[DEP][NP];
#define SC_ISSUE(set, itm) do { const unsigned char* gq_ = ws + (size_t)(itm) * 16384; const unsigned char* ga_ = ws + WS_ATT + (size_t)(itm) * 8192; \
            asm volatile("s_nop 4\n\tglobal_load_dwordx4 %0, %8, %9 sc0 sc1\n\tglobal_load_dwordx4 %1, %8, %10 sc0 sc1\n\tglobal_load_dwordx4 %2, %8, %11 sc0 sc1\n\tglobal_load_dwordx4 %3, %8, %12 sc0 sc1\n\t" \
                         "global_load_dwordx4 %4, %8, %13 sc0 sc1\n\tglobal_load_dwordx4 %5, %8, %14 sc0 sc1\n\tglobal_load_dwordx4 %6, %8, %15 sc0 sc1\n\tglobal_load_dwordx4 %7, %8, %16 sc0 sc1" \
                : "=&v"(rs[set][0]), "=&v"(rs[set][1]), "=&v"(rs[set][2]), "=&v"(rs[set][3]), "=&v"(rs[set][4]), "=&v"(rs[set][5]), "=&v"(rs[set][6]), "=&v"(rs[set][7]) \
                : "v"(voff), "s"(gq_ + WS_WN), "s"(gq_ + WS_WN + 4096), "s"(gq_ + WS_WN + 8192), "s"(gq_ + WS_WN + 12288), \
                  "s"(gq_ + WS_QD), "s"(gq_ + WS_QD + 4096), "s"(gq_ + WS_QD + 8192), "s"(gq_ + WS_QD + 12288) : "memory"); \
            asm volatile("s_nop 4\n\tglobal_load_dwordx4 %0, %7, %8 sc0 sc1\n\tglobal_load_dwordx4 %1, %7, %9 sc0 sc1\n\tglobal_load_dwordx4 %2, %7, %10 sc0 sc1\n\tglobal_load_dwordx4 %3, %7, %11 sc0 sc1\n\t" \
                         "global_load_dwordx4 %4, %7, %12 sc0 sc1\n\tglobal_load_dwordx4 %5, %7, %13 sc0 sc1\n\tglobal_load_dwordx4 %6, %7, %14 sc0 sc1" \
                : "=&v"(rs[set][8]), "=&v"(rs[set][9]), "=&v"(rs[set][10]), "=&v"(rs[set][11]), "=&v"(rs[set][12]), "=&v"(rs[set][13]), "=&v"(rs[set][14]) \
                : "v"(voff), "s"(gq_ + WS_KD), "s"(gq_ + WS_KD + 4096), "s"(gq_ + WS_KD + 8192), "s"(gq_ + WS_KD + 12288), \
                  "s"(ga_), "s"(ga_ + 4096), "s"(gq_ + WS_UF + (size_t)(part * SCAN_NWC) * 2048) : "memory"); } while (0)
#define SC_WAITSET(set, cnt) asm volatile("s_waitcnt " cnt : "+v"(rs[set][0]), "+v"(rs[set][1]), "+v"(rs[set][2]), "+v"(rs[set][3]), "+v"(rs[set][4]), "+v"(rs[set][5]), "+v"(rs[set][6]), "+v"(rs[set][7]), \
            "+v"(rs[set][8]), "+v"(rs[set][9]), "+v"(rs[set][10]), "+v"(rs[set][11]), "+v"(rs[set][12]), "+v"(rs[set][13]), "+v"(rs[set][14]) :: "memory")
#define SC_WRITE(set, par) do { LAS unsigned char* wb_ = lds + (par) * SC_BUF; \
            _Pragma("unroll") for (int r = 0; r < 4; ++r) { *(LAS v4u*)(wb_ + SC_WN + lA + r * (16 * 272)) = rs[set][r]; *(LAS v4u*)(wb_ + SC_QD + lA + r * (16 * 272)) = rs[set][4 + r]; \
                                                          *(LAS v4u*)(wb_ + SC_KD + lB + r * (32 * 144)) = rs[set][8 + r]; } \
            *(LAS v4u*)(wb_ + SC_ATT + lB) = rs[set][12]; *(LAS v4u*)(wb_ + SC_ATT + lB + 32 * 144) = rs[set][13]; \
            *(LAS v4u*)(lds + lU + (par) * (SCAN_NWC * 2048)) = rs[set][14]; } while (0)
#define SC_NEED(c) do { unsigned sp_ = 0; while (*(volatile LAS unsigned*)(lds + SC_RDY) <= (unsigned)(c) && ++sp_ < (1u << 24)) __builtin_amdgcn_s_sleep(2); } while (0)
        SC_NEED(0); SC_ISSUE(0, item0);
        SC_WAITSET(0, "vmcnt(0)"); SC_WRITE(0, 0); SC_WAITSET(0, "lgkmcnt(0)");
        SC_NEED(3); SC_ISSUE(1, item0 + 1); SC_ISSUE(2, item0 + 2); SC_ISSUE(0, item0 + 3);
        SC_BAR();
        int n2 = 0;
#define SC_INTERVAL(set) do { SC_WAITSET(set, "vmcnt(30)"); SC_WRITE(set, (n2 + 1) & 1); SC_WAITSET(set, "lgkmcnt(0)"); if (n2 + 1 + DEP < 128) SC_NEED(n2 + 1 + DEP); SC_ISSUE(set, item0 + ((n2 + 1 + DEP) & 127)); SC_BAR(); ++n2; } while (0)
#pragma unroll 1
        for (int it = 0; it < NCH / 3; ++it) { SC_INTERVAL(1); SC_INTERVAL(2); SC_INTERVAL(0); }
        if (NCH % 3 >= 1) SC_INTERVAL(1);
        if (NCH % 3 >= 2) SC_INTERVAL(2);
        SC_WAITSET(0, "vmcnt(0)"); SC_WAITSET(1, "vmcnt(0)"); SC_WAITSET(2, "vmcnt(0)");
#undef SC_INTERVAL
#undef SC_NEED
#undef SC_WRITE
#undef SC_WAITSET
#undef SC_ISSUE
        return;
    }
    if (wave == 3) {
        const unsigned* flags = (const unsigned*)(ws + WS_CTL) + CW_GFLAG + item0;
        unsigned rdy = 0;
#define SC_POLLSTEP() do { if (rdy < 128u) { const unsigned idx_ = rdy + (unsigned)lane; \
            const unsigned fv_ = (idx_ < 128u) ? __hip_atomic_load(flags + idx_, __ATOMIC_RELAXED, __HIP_MEMORY_SCOPE_AGENT) : 0u; \
            const unsigned long long m_ = __ballot(fv_ != 0u); const unsigned nrun_ = (m_ == ~0ull) ? 64u : (unsigned)__builtin_ctzll(~m_);     \
            if ((unsigned)lane < nrun_) ((LAS float*)(lds + SC_DECS))[idx_] = __builtin_bit_cast(float, fv_); \
            rdy += nrun_; LDS_WAIT(); if (lane == 0) *(volatile LAS unsigned*)(lds + SC_RDY) = rdy; } } while (0)
        { unsigned sp = 0; while (rdy < 4u && ++sp < (1u << 22)) { SC_POLLSTEP(); if (rdy < 4u) __builtin_amdgcn_s_sleep(16); } }
        SC_BAR();
#pragma unroll 1
        for (int n2 = 0; n2 < NCH; ++n2) {
            { const unsigned need = (unsigned)(n2 + 1 + 3) < 128u ? (unsigned)(n2 + 1 + 3) : 127u; unsigned sp = 0;
              while (rdy <= need && rdy < 128u && ++sp < (1u << 22)) { SC_POLLSTEP(); if (rdy <= need) __builtin_amdgcn_s_sleep(8); } }
            if (rdy < 128u && rdy < (unsigned)(n2 & 127) + 16u) SC_POLLSTEP();
            SC_BAR();
        }
#undef SC_POLLSTEP
        return;
    }
    if (wave == 2) {
        const int row = lane;
        bf16* Y = (bf16*)((unsigned char*)P.out + OUT_Y);
        float* SSQG = P.out;
        SC_BAR();
#pragma unroll 1
        for (int n2 = 0; n2 <= NCH; ++n2) {
            if (n2 > 0) {
                const int n = (n2 - 1) & 127, t = b * SEQ + n * 64 + row;
                const LAS float* src = (const LAS float*)(lds + SC_OT + ((n2 - 1) & 1) * (64 * 36 * 4)) + row * 36;
                f32x4 a[8]; float s2 = 0.f;
#pragma unroll
                for (int q = 0; q < 8; ++q) { a[q] = *(const LAS f32x4*)(src + 4 * q); s2 += (a[q].x * a[q].x + a[q].y * a[q].y) + (a[q].z * a[q].z + a[q].w * a[q].w); }
                SSQG[(size_t)t * 32 + h * 8 + part] = s2;
                v4u* d = (v4u*)(Y + (size_t)t * 1024 + h * 128 + 32 * part);
#pragma unroll
                for (int q = 0; q < 4; ++q) { v4u o; o.x = pk2(a[2 * q].x, a[2 * q].y); o.y = pk2(a[2 * q].z, a[2 * q].w); o.z = pk2(a[2 * q + 1].x, a[2 * q + 1].y); o.w = pk2(a[2 * q + 1].z, a[2 * q + 1].w); d[q] = o; }
            }
            if (n2 < NCH) SC_BAR();
        }
        return;
    }
    f32x4 S[8];
#pragma unroll
    for (int i = 0; i < 8; ++i) S[i] = (f32x4){0.f, 0.f, 0.f, 0.f};
    SC_BAR();
#pragma unroll 1
    for (int n2 = 0; n2 < NCH; ++n2) {
        if (SCAN_REPS > 1 && (n2 & 127) == 0) {
#pragma unroll
            for (int i = 0; i < 8; ++i) S[i] = (f32x4){0.f, 0.f, 0.f, 0.f};
        }
        if (SCAN_EXP == 2 && n2 < 128) { SC_BAR(); continue; }
        const int par = n2 & 1;
        LAS unsigned char* buf = lds + par * SC_BUF;
        bf16x8 fA[16], fB[16], fC[16], fD[8];
#pragma unroll
        for (int rho = 0; rho < 4; ++rho)
#pragma unroll
            for (int s = 0; s < 4; ++s) fA[rho * 4 + s] = *(const LAS bf16x8*)(buf + SC_WN + (16 * rho + col) * 272 + (32 * s + 8 * g) * 2);
#pragma unroll
        for (int rho = 0; rho < 4; ++rho)
#pragma unroll
            for (int s = 0; s < 4; ++s) fB[rho * 4 + s] = *(const LAS bf16x8*)(buf + SC_QD + (16 * rho + col) * 272 + (32 * s + 8 * g) * 2);
        const LAS v4u* ufp = (const LAS v4u*)(lds + SC_UFS + par * (SCAN_NWC * 2048) + wave * 2048 + lane * 32);
        const v4u uf0 = ufp[0], uf1 = ufp[1];
        const float dec = ((const LAS float*)(lds + SC_DECS))[n2 & 127];
        bf16x8 Bs[4];
#pragma unroll
        for (int s = 0; s < 4; ++s) Bs[s] = pack_b(S[2 * s], S[2 * s + 1]);
        f32x4 Vn[4], Oc[4];
        Vn[0] = (f32x4){bflo(uf0.x), bfhi(uf0.x), bflo(uf0.y), bfhi(uf0.y)}; Vn[1] = (f32x4){bflo(uf0.z), bfhi(uf0.z), bflo(uf0.w), bfhi(uf0.w)};
        Vn[2] = (f32x4){bflo(uf1.x), bfhi(uf1.x), bflo(uf1.y), bfhi(uf1.y)}; Vn[3] = (f32x4){bflo(uf1.z), bfhi(uf1.z), bflo(uf1.w), bfhi(uf1.w)};
        __builtin_amdgcn_sched_barrier(0);
        PIN16(fA);
#pragma unroll
        for (int s = 0; s < 4; ++s)
#pragma unroll
            for (int rho = 0; rho < 4; ++rho) Vn[rho] = __builtin_amdgcn_mfma_f32_16x16x32_bf16(fA[rho * 4 + s], Bs[s], Vn[rho], 0, 0, 0);
        __builtin_amdgcn_sched_barrier(0);
#pragma unroll
        for (int tau = 0; tau < 8; ++tau)
#pragma unroll
            for (int s = 0; s < 2; ++s) fC[tau * 2 + s] = *(const LAS bf16x8*)(buf + SC_KD + (16 * tau + col) * 144 + (32 * s + 8 * g) * 2);
        __builtin_amdgcn_sched_barrier(0);
        PIN16(fB);
#pragma unroll
        for (int rho = 0; rho < 4; ++rho) Oc[rho] = (f32x4){0.f, 0.f, 0.f, 0.f};
#pragma unroll
        for (int s = 0; s < 4; ++s)
#pragma unroll
            for (int rho = 0; rho < 4; ++rho) Oc[rho] = __builtin_amdgcn_mfma_f32_16x16x32_bf16(fB[rho * 4 + s], Bs[s], Oc[rho], 0, 0, 0);
        __builtin_amdgcn_sched_barrier(0);
#pragma unroll
        for (int rho = 0; rho < 4; ++rho)
#pragma unroll
            for (int s = 0; s < 2; ++s) fD[rho * 2 + s] = *(const LAS bf16x8*)(buf + SC_ATT + (16 * rho + col) * 144 + (32 * s + 8 * g) * 2);
        bf16x8 Bv[2];
        Bv[0] = pack_b(Vn[0], Vn[1]); Bv[1] = pack_b(Vn[2], Vn[3]);
#pragma unroll
        for (int tau = 0; tau < 8; ++tau) S[tau] = S[tau] * dec;
        __builtin_amdgcn_sched_barrier(0);
        PIN16(fC);
#pragma unroll
        for (int s = 0; s < 2; ++s)
#pragma unroll
            for (int tau = 0; tau < 8; ++tau) S[tau] = __builtin_amdgcn_mfma_f32_16x16x32_bf16(fC[tau * 2 + s], Bv[s], S[tau], 0, 0, 0);
        __builtin_amdgcn_sched_barrier(0);
        PIN8(fD);
#pragma unroll
        for (int s = 0; s < 2; ++s)
#pragma unroll
            for (int rho = 0; rho < 4; ++rho) Oc[rho] = __builtin_amdgcn_mfma_f32_16x16x32_bf16(fD[rho * 2 + s], Bv[s], Oc[rho], 0, 0, 0);
        LAS float* ot = (LAS float*)(lds + SC_OT + par * (64 * 36 * 4)) + 16 * wave + col;
#pragma unroll
        for (int rho = 0; rho < 4; ++rho)
#pragma unroll
            for (int i = 0; i < 4; ++i) ot[(16 * rho + 4 * g + i) * 36] = Oc[rho][i];
        SC_BAR();
    }
}

__device__ __forceinline__ void lru_carry(const Params& P, int gwv, int lane) {
    unsigned char* ws = P.ws;
    const int b = gwv >> 3, g = gwv & 7, ch = g * 64 + lane;
    const float* HEND = (const float*)(ws + WS_HEND); const float* PEND = (const float*)(ws + WS_PEND); float* HIN = (float*)(ws + WS_HIN);
    float hin = 0.f;
#pragma unroll 1
    for (int n0 = 0; n0 < 128; n0 += 16) {
        float he[16], pe[16];
#pragma unroll
        for (int i = 0; i < 16; ++i) { const size_t o = (size_t)(b * 128 + n0 + i) * 512 + ch; he[i] = HEND[o]; pe[i] = PEND[o]; }
#pragma unroll
        for (int i = 0; i < 16; ++i) { HIN[(size_t)(b * 128 + n0 + i) * 512 + ch] = hin; hin = he[i] + pe[i] * hin; }
    }
}

__device__ __forceinline__ void cvt_table(const float* src, bf16* dst, size_t n8, size_t wi, size_t nw) {
    for (size_t i = wi; i < n8; i += nw) {
        const f32x4 a = ((const f32x4*)src)[2 * i], c = ((const f32x4*)src)[2 * i + 1];
        v4u o; o.x = pk2(a.x, a.y); o.y = pk2(a.z, a.w); o.z = pk2(c.x, c.y); o.w = pk2(c.z, c.w);
        ((v4u*)dst)[i] = o;
    }
}

__device__ __forceinline__ void lru_combine(const Params& P, size_t wi, size_t nw) {
    unsigned char* ws = P.ws;
    const v4u* HLOC = (const v4u*)(ws + WS_HLOC); const v4u* PCUM = (const v4u*)(ws + WS_PCUM); const v4u* GATE = (const v4u*)(ws + WS_GATE);
    const float* HIN = (const float*)(ws + WS_HIN); bf16* Y = (bf16*)((unsigned char*)P.out + OUT_Y);
    for (size_t i = wi; i < (size_t)T * 64; i += nw) {
        const size_t t = i >> 6; const int ch0 = (int)(i & 63) * 8;
        const v4u hl = HLOC[i], pc = PCUM[i], gt = GATE[i];
        const f32x4 h0 = *(const f32x4*)(HIN + (t >> 6) * 512 + ch0), h1 = *(const f32x4*)(HIN + (t >> 6) * 512 + ch0 + 4);
        float y[8];
        y[0] = (bflo(hl.x) + bflo(pc.x) * h0.x) * gelu_tanh(bflo(gt.x)); y[1] = (bfhi(hl.x) + bfhi(pc.x) * h0.y) * gelu_tanh(bfhi(gt.x));
        y[2] = (bflo(hl.y) + bflo(pc.y) * h0.z) * gelu_tanh(bflo(gt.y)); y[3] = (bfhi(hl.y) + bfhi(pc.y) * h0.w) * gelu_tanh(bfhi(gt.y));
        y[4] = (bflo(hl.z) + bflo(pc.z) * h1.x) * gelu_tanh(bflo(gt.z)); y[5] = (bfhi(hl.z) + bfhi(pc.z) * h1.y) * gelu_tanh(bfhi(gt.z));
        y[6] = (bflo(hl.w) + bflo(pc.w) * h1.z) * gelu_tanh(bflo(gt.w)); y[7] = (bfhi(hl.w) + bfhi(pc.w) * h1.w) * gelu_tanh(bfhi(gt.w));
        v4u o; o.x = pk2(y[0], y[1]); o.y = pk2(y[2], y[3]); o.z = pk2(y[4], y[5]); o.w = pk2(y[6], y[7]);
        *(v4u*)(Y + t * 1024 + 512 + ch0) = o;
    }
}

__device__ __forceinline__ void gdn_gate_norm(const Params& P, size_t wi, size_t nw) {
    unsigned char* ws = P.ws;
    bf16* Y = (bf16*)((unsigned char*)P.out + OUT_Y); const v4u* Z = (const v4u*)(ws + WS_Z); const float* SSQG = P.out;
    for (size_t i = wi; i < (size_t)T * 64; i += nw) {
        const size_t t = i >> 6; const int c0 = (int)(i & 63) * 8, h = c0 >> 7;
        const f32x4 q0 = *(const f32x4*)(SSQG + t * 32 + h * 8);
        const float rstd = rsqrtf(((q0.x + q0.y) + (q0.z + q0.w)) * (1.0f / 128.0f) + 1e-6f);
        const v4u o = *(const v4u*)(Y + t * 1024 + c0), z = Z[i];
        const f32x4 w0 = *(const f32x4*)(P.gdn_norm_w + (c0 & 127)), w1 = *(const f32x4*)(P.gdn_norm_w + (c0 & 127) + 4);
        float y[8];
        y[0] = bflo(o.x) * rstd * w0.x * siluf_(bflo(z.x)); y[1] = bfhi(o.x) * rstd * w0.y * siluf_(bfhi(z.x));
        y[2] = bflo(o.y) * rstd * w0.z * siluf_(bflo(z.y)); y[3] = bfhi(o.y) * rstd * w0.w * siluf_(bfhi(z.y));
        y[4] = bflo(o.z) * rstd * w1.x * siluf_(bflo(z.z)); y[5] = bfhi(o.z) * rstd * w1.y * siluf_(bfhi(z.z));
        y[6] = bflo(o.w) * rstd * w1.z * siluf_(bflo(z.w)); y[7] = bfhi(o.w) * rstd * w1.w * siluf_(bfhi(z.w));
        v4u r; r.x = pk2(y[0], y[1]); r.y = pk2(y[2], y[3]); r.z = pk2(y[4], y[5]); r.w = pk2(y[6], y[7]);
        *(v4u*)(Y + t * 1024 + c0) = r;
    }
}

__device__ __forceinline__ void xattn_stage(LAS unsigned char* lds, const bf16* src, int tid) {
    v4u tmp[16];
    const unsigned voff = (unsigned)tid * 16u;
#pragma unroll
    for (int r = 0; r < 16; ++r) { const unsigned char* sb = (const unsigned char*)src + r * 8192;
        asm volatile("s_nop 4\n\tglobal_load_dwordx4 %0, %1, %2" : "=&v"(tmp[r]) : "v"(voff), "s"(sb) : "memory"); }
    asm volatile("s_waitcnt vmcnt(0)" : "+v"(tmp[0]), "+v"(tmp[1]), "+v"(tmp[2]), "+v"(tmp[3]), "+v"(tmp[4]), "+v"(tmp[5]), "+v"(tmp[6]), "+v"(tmp[7]),
                                        "+v"(tmp[8]), "+v"(tmp[9]), "+v"(tmp[10]), "+v"(tmp[11]), "+v"(tmp[12]), "+v"(tmp[13]), "+v"(tmp[14]), "+v"(tmp[15]) :: "memory");
#pragma unroll
    for (int r = 0; r < 16; ++r) { const int id = tid + 512 * r; *(LAS v4u*)(lds + (id >> 5) * 528 + (id & 31) * 16) = tmp[r]; }
}
__device__ __forceinline__ void xattn_unit(const Params& P, LAS unsigned char* lds, int unit, int tid, int lane, int wave) {
    const unsigned char* ws = P.ws;
    const int h = unit & 3, qb = (unit >> 2) & 63, b = unit >> 8, col = lane & 15, g = lane >> 4;
    const int tw = b * SEQ + qb * 128 + 16 * wave;
    const bf16* Kb = (const bf16*)(ws + WS_KB) + (size_t)((b * 4 + h) * 256) * 256;
    const bf16* Vt = (const bf16*)(ws + WS_VTP) + (size_t)((b * 4 + h) * 256) * 256;
    xattn_stage(lds, Kb, tid);
    __syncthreads();
    const LAS unsigned char* arow = lds + col * 528 + g * 16;
    bf16x8 Bp[1][8]; float inv[1];
#pragma unroll
    for (int ps = 0; ps < 1; ++ps) {
        const bf16* Q = (const bf16*)(ws + WS_Q) + (size_t)(tw + 16 * ps + col) * 1024 + h * 256 + 8 * g;
        bf16x8 Bq[8];
#pragma unroll
        for (int s = 0; s < 8; ++s) Bq[s] = *(const bf16x8*)(Q + 32 * s);
        f32x4 St[16];
        bf16x8 fr[2][8];
#pragma unroll
        for (int s = 0; s < 8; ++s) fr[0][s] = *(const LAS bf16x8*)(arow + 64 * s);
#pragma unroll
        for (int kap = 0; kap < 16; ++kap) {
            if (kap + 1 < 16) {
#pragma unroll
                for (int s = 0; s < 8; ++s) fr[(kap + 1) & 1][s] = *(const LAS bf16x8*)(arow + (16 * (kap + 1)) * 528 + 64 * s);
            }
            __builtin_amdgcn_sched_barrier(0);
            PIN8(fr[kap & 1]);
            f32x4 acc = (f32x4){0.f, 0.f, 0.f, 0.f};
#pragma unroll
            for (int s = 0; s < 8; ++s) acc = __builtin_amdgcn_mfma_f32_16x16x32_bf16(fr[kap & 1][s], Bq[s], acc, 0, 0, 0);
            St[kap] = acc;
            __builtin_amdgcn_sched_barrier(0);
        }
        float mx = -3.0e38f;
#pragma unroll
        for (int kap = 0; kap < 16; ++kap) mx = fmaxf(fmaxf(fmaxf(St[kap].x, St[kap].y), fmaxf(St[kap].z, St[kap].w)), mx);
        mx = fmaxf(mx, __shfl_xor(mx, 16)); mx = fmaxf(mx, __shfl_xor(mx, 32));
        float l = 0.f;
#pragma unroll
        for (int kap = 0; kap < 16; ++kap) { St[kap].x = __expf(St[kap].x - mx); St[kap].y = __expf(St[kap].y - mx); St[kap].z = __expf(St[kap].z - mx); St[kap].w = __expf(St[kap].w - mx);
            l += (St[kap].x + St[kap].y) + (St[kap].z + St[kap].w); }
        l += __shfl_xor(l, 16); l += __shfl_xor(l, 32);
        inv[ps] = 1.0f / l;
#pragma unroll
        for (int s = 0; s < 8; ++s) Bp[ps][s] = pack_b(St[2 * s], St[2 * s + 1]);
    }
    __syncthreads();
    xattn_stage(lds, Vt, tid);
    __syncthreads();
#pragma unroll
    for (int ps = 0; ps < 1; ++ps) {
        bf16* AO = (bf16*)(P.ws + WS_AO) + (size_t)(tw + 16 * ps + col) * 1024 + h * 256 + 4 * g;
        bf16x8 fr[2][8];
#pragma unroll
        for (int s = 0; s < 8; ++s) fr[0][s] = *(const LAS bf16x8*)(arow + 64 * s);
#pragma unroll
        for (int del = 0; del < 16; ++del) {
            if (del + 1 < 16) {
#pragma unroll
                for (int s = 0; s < 8; ++s) fr[(del + 1) & 1][s] = *(const LAS bf16x8*)(arow + (16 * (del + 1)) * 528 + 64 * s);
            }
            __builtin_amdgcn_sched_barrier(0);
            PIN8(fr[del & 1]);
            f32x4 acc = (f32x4){0.f, 0.f, 0.f, 0.f};
#pragma unroll
            for (int s = 0; s < 8; ++s) acc = __builtin_amdgcn_mfma_f32_16x16x32_bf16(fr[del & 1][s], Bp[ps][s], acc, 0, 0, 0);
            v2u o; o.x = pk2(acc.x * inv[ps], acc.y * inv[ps]); o.y = pk2(acc.z * inv[ps], acc.w * inv[ps]);
            *(v2u*)(AO + 16 * del) = o;
            __builtin_amdgcn_sched_barrier(0);
        }
    }
    __syncthreads();
}

__device__ __forceinline__ unsigned key_enc(float f) { const unsigned u = __builtin_bit_cast(unsigned, f); return (u & 0x80000000u) ? ~u : (u | 0x80000000u); }
__device__ __forceinline__ float key_dec(unsigned k) { const unsigned u = (k & 0x80000000u) ? (k & 0x7fffffffu) : ~k; return __builtin_bit_cast(float, u); }
#define TK_CAS(a, b) do { const unsigned hi_ = max(a, b), lo_ = min(a, b); a = hi_; b = lo_; } while (0)
__device__ __forceinline__ void tk_merge16(unsigned (&a)[16]) {
#pragma unroll
    for (int j = 8; j > 0; j >>= 1)
#pragma unroll
        for (int i = 0; i < 16; ++i) { const int l = i ^ j; if (l > i) TK_CAS(a[i], a[l]); }
}
__device__ __forceinline__ void tk_sort16(unsigned (&a)[16]) {
#pragma unroll
    for (int k = 2; k <= 16; k <<= 1)
#pragma unroll
        for (int j = k >> 1; j > 0; j >>= 1)
#pragma unroll
            for (int i = 0; i < 16; ++i) { const int l = i ^ j; if (l > i) { if ((i & k) == 0) TK_CAS(a[i], a[l]); else TK_CAS(a[l], a[i]); } }
}
__device__ __forceinline__ void tk_top16_merge(unsigned (&L)[16], const unsigned (&G)[16]) {
#pragma unroll
    for (int i = 0; i < 16; ++i) L[i] = max(L[i], G[15 - i]);
    tk_merge16(L);
}
__device__ __forceinline__ void tk_pair_merge(unsigned (&L)[16]) {
    unsigned Pp[16];
#pragma unroll
    for (int i = 0; i < 16; ++i) Pp[i] = (unsigned)__builtin_amdgcn_update_dpp(0, (int)L[i], 0xB1, 0xF, 0xF, true);
    tk_top16_merge(L, Pp);
}
__device__ __forceinline__ void peer_topk_rows(const Params& P, LAS unsigned char* lds, int rowbase, int tid) {
    const unsigned char* ws = P.ws;
    typedef _Float16 f16x8 __attribute__((ext_vector_type(8)));
    const int rl = tid >> 1, hf = tid & 1, grow = rowbase + rl, t = grow >> 3, h = grow & 7;
    const _Float16* SC = (const _Float16*)(ws + WS_PQ) + (size_t)t * 2048 + h * 256 + 64 * hf;
    f16x8 raw[2][8];
#pragma unroll
    for (int p = 0; p < 2; ++p)
#pragma unroll
        for (int q = 0; q < 8; ++q) raw[p][q] = *(const f16x8*)(SC + p * 128 + 8 * q);
    unsigned L1[16], L2[16];
#pragma unroll
    for (int p = 0; p < 2; ++p) {
        unsigned L[16];
#pragma unroll
        for (int grp = 0; grp < 4; ++grp) {
            unsigned G[16];
#pragma unroll
            for (int e = 0; e < 16; ++e) G[e] = (key_enc((float)raw[p][2 * grp + (e >> 3)][e & 7]) & ~127u) | (unsigned)(127 - (64 * hf + 16 * grp + e));
            tk_sort16(G);
            if (grp == 0) {
#pragma unroll
                for (int i = 0; i < 16; ++i) L[i] = G[i];
            } else tk_top16_merge(L, G);
        }
        tk_pair_merge(L);
#pragma unroll
        for (int i = 0; i < 16; ++i) { if (p == 0) L1[i] = L[i]; else L2[i] = L[i]; }
    }
    {
        float v1[16], v2[16];
        LAS int* il = (LAS int*)lds + rl * 33;
#pragma unroll
        for (int q = 0; q < 16; ++q) { v1[q] = key_dec((L1[q] & ~127u) | 64u); v2[q] = key_dec((L2[q] & ~127u) | 64u); }
        if (hf == 0) {
#pragma unroll
            for (int q = 0; q < 16; ++q) { il[q] = 127 - (int)(L1[q] & 127u); il[16 + q] = 127 - (int)(L2[q] & 127u); }
        }
        unsigned C[16], D[16];
        float w1[8];
        const unsigned hf16 = (unsigned)hf * 16u, evenmask = (unsigned)hf - 1u;
#pragma unroll
        for (int k = 0; k < 8; ++k) w1[k] = __builtin_bit_cast(float, (__builtin_bit_cast(unsigned, v1[2 * k]) & evenmask) | (__builtin_bit_cast(unsigned, v1[2 * k + 1]) & ~evenmask));
#define TK_SLOT(dst, k, bq, valid_odd) do { const unsigned pos_ = (unsigned)(16 * (2 * (k)) + (bq)) + hf16; unsigned kv_ = (key_enc(w1[k] + v2[bq]) & ~255u) | (255u - pos_); if (!(valid_odd)) kv_ &= evenmask; dst = kv_; } while (0)
        TK_SLOT(C[0], 0, 0, true);
        TK_SLOT(C[1], 0, 1, true);
        TK_SLOT(C[2], 0, 2, true);
        TK_SLOT(C[3], 0, 3, true);
        TK_SLOT(C[4], 0, 4, true);
        TK_SLOT(C[5], 0, 5, true);
        TK_SLOT(C[6], 0, 6, true);
        TK_SLOT(C[7], 0, 7, true);
        TK_SLOT(C[8], 0, 8, false);
        TK_SLOT(C[9], 0, 9, false);
        TK_SLOT(C[10], 0, 10, false);
        TK_SLOT(C[11], 0, 11, false);
        TK_SLOT(C[12], 0, 12, false);
        TK_SLOT(C[13], 0, 13, false);
        TK_SLOT(C[14], 0, 14, false);
        TK_SLOT(C[15], 0, 15, false);
        TK_SLOT(D[0], 1, 0, true);
        TK_SLOT(D[1], 1, 1, true);
        TK_SLOT(D[2], 1, 2, true);
        TK_SLOT(D[3], 1, 3, true);
        TK_SLOT(D[4], 1, 4, false);
        TK_SLOT(D[5], 2, 0, true);
        TK_SLOT(D[6], 2, 1, true);
        TK_SLOT(D[7], 2, 2, false);
        TK_SLOT(D[8], 3, 0, true);
        TK_SLOT(D[9], 3, 1, true);
        TK_SLOT(D[10], 4, 0, true);
        TK_SLOT(D[11], 5, 0, true);
        TK_SLOT(D[12], 6, 0, true);
        TK_SLOT(D[13], 7, 0, true);
        D[14] = 0u; D[15] = 0u;
#undef TK_SLOT
        tk_sort16(C); tk_sort16(D); tk_top16_merge(C, D); tk_pair_merge(C);
        LDS_WAIT(); asm volatile("" ::: "memory");
        float best[16], e[16], sum = 0.f;
#pragma unroll
        for (int q = 0; q < 16; ++q) { best[q] = key_dec((C[q] & ~255u) | 128u); e[q] = __expf(best[q] - best[0]); sum += e[q]; }
        const float inv = __builtin_amdgcn_rcpf(sum);
        int* IDX = (int*)(P.ws + WS_IDX) + (size_t)grow * 16 + 8 * hf; float* GW = (float*)(P.ws + WS_GW) + (size_t)grow * 16 + 8 * hf;
#pragma unroll
        for (int q = 0; q < 8; ++q) {
            const unsigned c = (C[q] & evenmask) | (C[8 + q] & ~evenmask);
            const float ev = __builtin_bit_cast(float, (__builtin_bit_cast(unsigned, e[q]) & evenmask) | (__builtin_bit_cast(unsigned, e[8 + q]) & ~evenmask));
            const unsigned pos = 255u - (c & 255u);
            IDX[q] = il[pos >> 4] * 128 + il[16 + (pos & 15u)]; GW[q] = ev * inv;
        }
    }
    LDS_WAIT(); asm volatile("" ::: "memory");
}

__device__ __forceinline__ void peer_topk_wave(const Params& P, LAS int* ilw, LAS unsigned* oute, LAS float* outg, int tbase, int lane) {
    const unsigned char* ws = P.ws;
    typedef _Float16 f16x8 __attribute__((ext_vector_type(8)));
    const int rl = lane >> 1, hf = lane & 1, t = tbase + (rl >> 3), h = rl & 7;
    const _Float16* SC = (const _Float16*)(ws + WS_PQ) + (size_t)t * 2048 + h * 256 + 64 * hf;
    f16x8 raw[2][8];
#pragma unroll
    for (int p = 0; p < 2; ++p)
#pragma unroll
        for (int q = 0; q < 8; ++q) raw[p][q] = *(const f16x8*)(SC + p * 128 + 8 * q);
    unsigned L1[16], L2[16];
#pragma unroll
    for (int p = 0; p < 2; ++p) {
        unsigned L[16];
#pragma unroll
        for (int grp = 0; grp < 4; ++grp) {
            unsigned G[16];
#pragma unroll
            for (int e = 0; e < 16; ++e) G[e] = (key_enc((float)raw[p][2 * grp + (e >> 3)][e & 7]) & ~127u) | (unsigned)(127 - (64 * hf + 16 * grp + e));
            tk_sort16(G);
            if (grp == 0) {
#pragma unroll
                for (int i = 0; i < 16; ++i) L[i] = G[i];
            } else tk_top16_merge(L, G);
        }
        tk_pair_merge(L);
#pragma unroll
        for (int i = 0; i < 16; ++i) { if (p == 0) L1[i] = L[i]; else L2[i] = L[i]; }
    }
    {
        float v1[16], v2[16];
        LAS int* il = ilw + rl * 33;
#pragma unroll
        for (int q = 0; q < 16; ++q) { v1[q] = key_dec((L1[q] & ~127u) | 64u); v2[q] = key_dec((L2[q] & ~127u) | 64u); }
        if (hf == 0) {
#pragma unroll
            for (int q = 0; q < 16; ++q) { il[q] = 127 - (int)(L1[q] & 127u); il[16 + q] = 127 - (int)(L2[q] & 127u); }
        }
        unsigned C[16], D[16];
        float w1[8];
        const unsigned hf16 = (unsigned)hf * 16u, evenmask = (unsigned)hf - 1u;
#pragma unroll
        for (int k = 0; k < 8; ++k) w1[k] = __builtin_bit_cast(float, (__builtin_bit_cast(unsigned, v1[2 * k]) & evenmask) | (__builtin_bit_cast(unsigned, v1[2 * k + 1]) & ~evenmask));
#define TK_SLOT(dst, k, bq, valid_odd) do { const unsigned pos_ = (unsigned)(16 * (2 * (k)) + (bq)) + hf16; unsigned kv_ = (key_enc(w1[k] + v2[bq]) & ~255u) | (255u - pos_); if (!(valid_odd)) kv_ &= evenmask; dst = kv_; } while (0)
        TK_SLOT(C[0], 0, 0, true);
        TK_SLOT(C[1], 0, 1, true);
        TK_SLOT(C[2], 0, 2, true);
        TK_SLOT(C[3], 0, 3, true);
        TK_SLOT(C[4], 0, 4, true);
        TK_SLOT(C[5], 0, 5, true);
        TK_SLOT(C[6], 0, 6, true);
        TK_SLOT(C[7], 0, 7, true);
        TK_SLOT(C[8], 0, 8, false);
        TK_SLOT(C[9], 0, 9, false);
        TK_SLOT(C[10], 0, 10, false);
        TK_SLOT(C[11], 0, 11, false);
        TK_SLOT(C[12], 0, 12, false);
        TK_SLOT(C[13], 0, 13, false);
        TK_SLOT(C[14], 0, 14, false);
        TK_SLOT(C[15], 0, 15, false);
        TK_SLOT(D[0], 1, 0, true);
        TK_SLOT(D[1], 1, 1, true);
        TK_SLOT(D[2], 1, 2, true);
        TK_SLOT(D[3], 1, 3, true);
        TK_SLOT(D[4], 1, 4, false);
        TK_SLOT(D[5], 2, 0, true);
        TK_SLOT(D[6], 2, 1, true);
        TK_SLOT(D[7], 2, 2, false);
        TK_SLOT(D[8], 3, 0, true);
        TK_SLOT(D[9], 3, 1, true);
        TK_SLOT(D[10], 4, 0, true);
        TK_SLOT(D[11], 5, 0, true);
        TK_SLOT(D[12], 6, 0, true);
        TK_SLOT(D[13], 7, 0, true);
        D[14] = 0u; D[15] = 0u;
#undef TK_SLOT
        tk_sort16(C); tk_sort16(D); tk_top16_merge(C, D); tk_pair_merge(C);
        LDS_WAIT(); asm volatile("" ::: "memory");
        float best[16], e[16], sum = 0.f;
#pragma unroll
        for (int q = 0; q < 16; ++q) { best[q] = key_dec((C[q] & ~255u) | 128u); e[q] = __expf(best[q] - best[0]); sum += e[q]; }
        const float inv = __builtin_amdgcn_rcpf(sum);
        LAS unsigned* IDX = oute + rl * 16 + 8 * hf; LAS float* GW = outg + rl * 16 + 8 * hf;
#pragma unroll
        for (int q = 0; q < 8; ++q) {
            const unsigned c = (C[q] & evenmask) | (C[8 + q] & ~evenmask);
            const float ev = __builtin_bit_cast(float, (__builtin_bit_cast(unsigned, e[q]) & evenmask) | (__builtin_bit_cast(unsigned, e[8 + q]) & ~evenmask));
            const unsigned pos = 255u - (c & 255u);
            IDX[q] = (unsigned)(il[pos >> 4] * 128 + il[16 + (pos & 15u)]); GW[q] = ev * inv;
        }
    }
    LDS_WAIT(); asm volatile("" ::: "memory");
}

typedef float f32x2 __attribute__((ext_vector_type(2)));
__device__ __forceinline__ unsigned q8(float x) { return (unsigned)(int)rintf(x) & 0xffu; }
__device__ __forceinline__ void cvt_table_fp8(const float* src, unsigned char* dst, float* scl, int gw, int ngw, int lane) {
    for (int row = gw; row < 16384; row += ngw) {
        const f32x4* sp = (const f32x4*)(src + (size_t)row * 1024 + 16 * lane);
        const f32x4 a0 = sp[0], a1 = sp[1], a2 = sp[2], a3 = sp[3];
        float m = fmaxf(fmaxf(fmaxf(fabsf(a0.x), fabsf(a0.y)), fmaxf(fabsf(a0.z), fabsf(a0.w))), fmaxf(fmaxf(fabsf(a1.x), fabsf(a1.y)), fmaxf(fabsf(a1.z), fabsf(a1.w))));
        m = fmaxf(m, fmaxf(fmaxf(fmaxf(fabsf(a2.x), fabsf(a2.y)), fmaxf(fabsf(a2.z), fabsf(a2.w))), fmaxf(fmaxf(fabsf(a3.x), fabsf(a3.y)), fmaxf(fabsf(a3.z), fabsf(a3.w)))));
#pragma unroll
        for (int o = 1; o < 64; o <<= 1) m = fmaxf(m, __shfl_xor(m, o));
        m = fmaxf(m, 1e-30f);
        const float q = 127.0f / m;
        v4u o;
        o.x = q8(a0.x * q) | (q8(a0.y * q) << 8) | (q8(a0.z * q) << 16) | (q8(a0.w * q) << 24);
        o.y = q8(a1.x * q) | (q8(a1.y * q) << 8) | (q8(a1.z * q) << 16) | (q8(a1.w * q) << 24);
        o.z = q8(a2.x * q) | (q8(a2.y * q) << 8) | (q8(a2.z * q) << 16) | (q8(a2.w * q) << 24);
        o.w = q8(a3.x * q) | (q8(a3.y * q) << 8) | (q8(a3.z * q) << 16) | (q8(a3.w * q) << 24);
        *(v4u*)(dst + (size_t)row * 1024 + 16 * lane) = o;
        if (lane == 0) scl[row] = m * (1.0f / 127.0f);
    }
}
__device__ __forceinline__ int row16_sum_i(int v) {
    v += __builtin_amdgcn_update_dpp(0, v, 0xB1, 0xF, 0xF, true);
    v += __builtin_amdgcn_update_dpp(0, v, 0x4E, 0xF, 0xF, true);
    v += __builtin_amdgcn_update_dpp(0, v, 0x141, 0xF, 0xF, true);
    v += __builtin_amdgcn_update_dpp(0, v, 0x140, 0xF, 0xF, true);
    return v;
}
constexpr int PE_NT = 4, PE_NR = 16, PE_SH = 10, PE_DEP = 3;
constexpr int PE_TOK_W = 128 * 3 + 20;
constexpr int PE_WAVE_W = PE_NT * PE_TOK_W + 272 + 32 * 33 + 2 * PE_NT * 128;
static_assert(8 * PE_WAVE_W * 4 <= MISC_OFF && PE_NR * PE_NT == 64, "peer LDS / batch-list geometry");
#define PE_LD(dst, voff_, sbase_) asm volatile("s_nop 4\n\tglobal_load_dwordx4 %0, %1, %2" : "=&v"(dst) : "v"(voff_), "s"(sbase_) : "memory")
__device__ __forceinline__ void peer_pass(const Params& P, LAS unsigned char* lds, int tbase, int lane, int wave, float* dstbase, int emask = 0x3fff) {
    {
        LAS unsigned* lw0 = (LAS unsigned*)(lds) + wave * PE_WAVE_W + PE_NT * PE_TOK_W + 272;
        peer_topk_wave(P, (LAS int*)lw0, lw0 + 32 * 33, (LAS float*)(lw0 + 32 * 33 + PE_NT * 128), tbase, lane);
        LDS_WAIT(); asm volatile("" : "+v"(lane), "+s"(tbase) :: "memory");
    }
    const unsigned char* ws = P.ws;
    const unsigned char* UB8 = ws + WS_UB; const unsigned char* VB8 = ws + WS_VB;
    const float* USC = (const float*)(ws + WS_USC); const float* VSC = (const float*)(ws + WS_VSC);
    unsigned hq[PE_NT][4]; f32x2 acc[PE_NT][8];
    LAS unsigned* lw = (LAS unsigned*)(lds) + wave * PE_WAVE_W;
    LAS unsigned* ents = lw + PE_NT * PE_TOK_W;
    const unsigned voff = (unsigned)lane * 16u;
    LAS unsigned* upe = ents + 272 + 32 * 33; LAS float* upg = (LAS float*)(upe + PE_NT * 128);
#pragma unroll
    for (int j = 0; j < PE_NT; ++j) {
        const int t = tbase + j;
        const v4u* xrow = (const v4u*)((const bf16*)(ws + WS_XB) + (size_t)t * 1024 + 16 * lane);
        const v4u xa = xrow[0], xc = xrow[1];
        const f32x4 xvv[4] = {(f32x4){bflo(xa.x), bfhi(xa.x), bflo(xa.y), bfhi(xa.y)}, (f32x4){bflo(xa.z), bfhi(xa.z), bflo(xa.w), bfhi(xa.w)},
                              (f32x4){bflo(xc.x), bfhi(xc.x), bflo(xc.y), bfhi(xc.y)}, (f32x4){bflo(xc.z), bfhi(xc.z), bflo(xc.w), bfhi(xc.w)}};
        const float rstd2 = rsqrtf(((const float*)(ws + WS_SSQ2))[t] * (1.0f / 1024.0f) + 1e-6f);
        f32x4 hv[4]; float hm = 0.f;
#pragma unroll
        for (int i = 0; i < 4; ++i) { const f32x4 xv = xvv[i]; const f32x4 w = ((const f32x4*)(P.norm_ffn_w + 16 * lane))[i];
            hv[i] = (f32x4){xv.x * rstd2 * w.x, xv.y * rstd2 * w.y, xv.z * rstd2 * w.z, xv.w * rstd2 * w.w};
            hm = fmaxf(hm, fmaxf(fmaxf(fabsf(hv[i].x), fabsf(hv[i].y)), fmaxf(fabsf(hv[i].z), fabsf(hv[i].w)))); }
#pragma unroll
        for (int o = 1; o < 64; o <<= 1) hm = fmaxf(hm, __shfl_xor(hm, o));
        hm = fmaxf(hm, 1e-30f);
        const float hqs = 127.0f / hm, hs = hm * (1.0f / 127.0f);
#pragma unroll
        for (int i = 0; i < 4; ++i) hq[j][i] = q8(hv[i].x * hqs) | (q8(hv[i].y * hqs) << 8) | (q8(hv[i].z * hqs) << 16) | (q8(hv[i].w * hqs) << 24);
#pragma unroll
        for (int i = 0; i < 8; ++i) acc[j][i] = (f32x2){0.f, 0.f};
        const int e0 = (int)upe[j * 128 + 2 * lane] & emask, e1 = (int)upe[j * 128 + 2 * lane + 1] & emask;
        const float g0 = upg[j * 128 + 2 * lane] * VSC[e0], g1 = upg[j * 128 + 2 * lane + 1] * VSC[e1];
        const float u0 = USC[e0] * hs, u1 = USC[e1] * hs;
        const int b0 = e0 >> PE_SH, b1 = e1 >> PE_SH;
        LAS unsigned* lt = lw + j * PE_TOK_W;
        int run = 0;
#pragma unroll 1
        for (int bk = 0; bk < PE_NR; ++bk) {
            const unsigned long long m0 = __ballot(b0 == bk), m1 = __ballot(b1 == bk);
            const int c0 = __popcll(m0), c1 = __popcll(m1);
            const unsigned long long lower = (1ull << lane) - 1ull;
            if (b0 == bk) { const int p = run + __popcll(m0 & lower); lt[p] = (unsigned)e0; lt[128 + p] = __builtin_bit_cast(unsigned, g0); lt[256 + p] = __builtin_bit_cast(unsigned, u0); }
            if (b1 == bk) { const int p = run + c0 + __popcll(m1 & lower); lt[p] = (unsigned)e1; lt[128 + p] = __builtin_bit_cast(unsigned, g1); lt[256 + p] = __builtin_bit_cast(unsigned, u1); }
            if (lane == 0) lt[384 + bk] = (unsigned)run;
            run += c0 + c1;
        }
        if (lane == 0) lt[384 + PE_NR] = 128u;
        asm volatile("" ::: "memory");
    }
    LDS_WAIT(); asm volatile("" ::: "memory");
    int nb;
    {
        const int rd = lane >> 2, j = lane & 3;
        const LAS unsigned* lt = lw + j * PE_TOK_W;
        const int n0 = (int)lt[384 + rd], n1 = (int)lt[384 + rd + 1];
        const int nbl = (n1 - n0 + 3) >> 2;
        int inc = nbl;
#pragma unroll
        for (int off = 1; off < 64; off <<= 1) { const int tv = __shfl_up(inc, off); if (lane >= off) inc += tv; }
        nb = __builtin_amdgcn_readlane(inc, 63);
        const int ofs = inc - nbl;
        for (int q = 0; q < nbl; ++q) { const int i0 = n0 + 4 * q, c = (n1 - i0) < 4 ? (n1 - i0) : 4; ents[ofs + q] = (unsigned)j | ((unsigned)c << 2) | ((unsigned)i0 << 5); }
        if (lane < 2 * PE_DEP) ents[nb + lane] = 0u;
    }
    LDS_WAIT(); asm volatile("" ::: "memory");
    v4u ru[PE_DEP][4], rv[PE_DEP][4];
#define PE_LDO(dst, vo_, sbase_) asm volatile("global_load_dwordx4 %0, %1, %2" : "=&v"(dst) : "v"(vo_), "s"(sbase_) : "memory")
#define PE_ISSUE(S, entv) do { const unsigned en_ = (entv); const int j_ = (int)(en_ & 3u), c_ = (int)((en_ >> 2) & 7u), i_ = (int)(en_ >> 5); \
        const LAS unsigned* lt_ = lw + j_ * PE_TOK_W; const int cl_ = c_ > 0 ? c_ - 1 : 0; \
        const int ev_ = (int)lt_[i_ + (lane < cl_ ? lane : cl_)];                          \
        _Pragma("unroll") for (int k_ = 0; k_ < 4; ++k_) { const unsigned vo_ = ((unsigned)__builtin_amdgcn_readlane(ev_, k_) << 10) + voff; \
            PE_LDO(ru[S][k_], vo_, UB8); PE_LDO(rv[S][k_], vo_, VB8); } } while (0)
#define PE_WAIT8(S, cntstr) asm volatile("s_waitcnt " cntstr : "+v"(ru[S][0]), "+v"(ru[S][1]), "+v"(ru[S][2]), "+v"(ru[S][3]), "+v"(rv[S][0]), "+v"(rv[S][1]), "+v"(rv[S][2]), "+v"(rv[S][3]) :: "memory")
#define PE_COMPUTE_J(S, J, c_, i_, SG) do { const LAS unsigned* lt_ = lw + (J) * PE_TOK_W; \
        const int myk_ = lane >> 4; \
        float gsc_ = __builtin_bit_cast(float, lt_[128 + i_ + myk_]), usc_ = __builtin_bit_cast(float, lt_[256 + i_ + myk_]);     \
        int d_[4]; \
        _Pragma("unroll") for (int k_ = 0; k_ < 4; ++k_) { int s_ = __builtin_amdgcn_sdot4((int)ru[S][k_].x, (int)hq[J][0], 0, false); s_ = __builtin_amdgcn_sdot4((int)ru[S][k_].y, (int)hq[J][1], s_, false); \
            s_ = __builtin_amdgcn_sdot4((int)ru[S][k_].z, (int)hq[J][2], s_, false); s_ = __builtin_amdgcn_sdot4((int)ru[S][k_].w, (int)hq[J][3], s_, false); d_[k_] = s_; } \
        int r1_; \
        { const v2u p02_ = __builtin_amdgcn_permlane32_swap((unsigned)d_[0], (unsigned)d_[2], false, false), p13_ = __builtin_amdgcn_permlane32_swap((unsigned)d_[1], (unsigned)d_[3], false, false); \
          const v2u q_ = __builtin_amdgcn_permlane16_swap(p02_.x + p02_.y, p13_.x + p13_.y, false, false); r1_ = row16_sum_i((int)(q_.x + q_.y)); }     \
        float act_; \
        { const float x_ = (float)r1_ * usc_, e_ = __builtin_amdgcn_exp2f(x_ * __builtin_fmaf(x_ * x_, -0.10294324f, -2.3022082f));     \
          act_ = x_ * __builtin_amdgcn_rcpf(1.0f + e_) * gsc_; act_ = (myk_ < c_) ? act_ : 0.f; } \
        float wm_; \
        { unsigned wmu_ = __builtin_bit_cast(unsigned, act_) & 0x7fffffffu;                 \
          v2u t_ = __builtin_amdgcn_permlane32_swap(wmu_, wmu_, false, false); wmu_ = t_.x > t_.y ? t_.x : t_.y; \
          t_ = __builtin_amdgcn_permlane16_swap(wmu_, wmu_, false, false); wmu_ = t_.x > t_.y ? t_.x : t_.y; \
          wm_ = fmaxf(__builtin_bit_cast(float, wmu_), 1e-30f); } \
        const float wq_ = 127.0f * __builtin_amdgcn_rcpf(wm_), ws_ = (SG) * wm_ * (1.0f / 127.0f); \
        unsigned w4u_ = (__builtin_bit_cast(unsigned, __builtin_fmaf(act_, wq_, 12582912.0f)) & 0xffu) << (8 * myk_); \
        { v2u t_ = __builtin_amdgcn_permlane32_swap(w4u_, w4u_, false, false); w4u_ = t_.x | t_.y; t_ = __builtin_amdgcn_permlane16_swap(w4u_, w4u_, false, false); w4u_ = t_.x | t_.y; } \
        const int w4_ = (int)w4u_; const f32x2 ws2_ = (f32x2){ws_, ws_}; \
        _Pragma("unroll") for (int m_ = 0; m_ < 4; ++m_) { \
            const unsigned R0_ = rv[S][0][m_], R1_ = rv[S][1][m_], R2_ = rv[S][2][m_], R3_ = rv[S][3][m_]; \
            const unsigned X_ = __builtin_amdgcn_perm(R1_, R0_, 0x05010400u), Y_ = __builtin_amdgcn_perm(R1_, R0_, 0x07030602u), Z_ = __builtin_amdgcn_perm(R3_, R2_, 0x05010400u), W_ = __builtin_amdgcn_perm(R3_, R2_, 0x07030602u); \
            const int t0_ = __builtin_amdgcn_sdot4((int)__builtin_amdgcn_perm(Z_, X_, 0x05040100u), w4_, 0, false), t1_ = __builtin_amdgcn_sdot4((int)__builtin_amdgcn_perm(Z_, X_, 0x07060302u), w4_, 0, false), \
                      t2_ = __builtin_amdgcn_sdot4((int)__builtin_amdgcn_perm(W_, Y_, 0x05040100u), w4_, 0, false), t3_ = __builtin_amdgcn_sdot4((int)__builtin_amdgcn_perm(W_, Y_, 0x07060302u), w4_, 0, false); \
            acc[J][2 * m_] = __builtin_elementwise_fma((f32x2){(float)t0_, (float)t1_}, ws2_, acc[J][2 * m_]); \
            acc[J][2 * m_ + 1] = __builtin_elementwise_fma((f32x2){(float)t2_, (float)t3_}, ws2_, acc[J][2 * m_ + 1]); } } while (0)
#define PE_COMPUTE_S(S, entv, SG) do { const unsigned en_ = (entv); const int jj_ = (int)(en_ & 3u), cc_ = (int)((en_ >> 2) & 7u), ii_ = (int)(en_ >> 5); \
        if (cc_ > 0) { if (jj_ == 0) PE_COMPUTE_J(S, 0, cc_, ii_, SG); else if (jj_ == 1) PE_COMPUTE_J(S, 1, cc_, ii_, SG); else if (jj_ == 2) PE_COMPUTE_J(S, 2, cc_, ii_, SG); else PE_COMPUTE_J(S, 3, cc_, ii_, SG); } } while (0)
#ifdef PE_VALU3
#define PE_COMPUTE(S, entv) do { PE_COMPUTE_S(S, entv, 1.0f); PE_WAIT8(S, "vmcnt(16)"); PE_COMPUTE_S(S, entv, -1.0f); PE_WAIT8(S, "vmcnt(16)"); PE_COMPUTE_S(S, entv, 1.0f); } while (0)
#else
#define PE_COMPUTE(S, entv) PE_COMPUTE_S(S, entv, 1.0f)
#endif
    {
        unsigned er[PE_DEP];
#pragma unroll
        for (int q = 0; q < PE_DEP; ++q) { er[q] = __builtin_amdgcn_readfirstlane(ents[q]); PE_ISSUE(q, er[q]); }
#pragma unroll 1
        for (int bi = 0; bi < nb; bi += PE_DEP) {
#pragma unroll
            for (int q = 0; q < PE_DEP; ++q) {
                PE_WAIT8(q, "vmcnt(16)");
                PE_COMPUTE(q, er[q]);
                er[q] = __builtin_amdgcn_readfirstlane(ents[bi + q + PE_DEP]);
                PE_ISSUE(q, er[q]);
            }
        }
#pragma unroll
        for (int q = 0; q < PE_DEP; ++q) PE_WAIT8(q, "vmcnt(0)");
    }
#undef PE_COMPUTE
#undef PE_COMPUTE_S
#undef PE_COMPUTE_J
#undef PE_WAIT8
#undef PE_ISSUE
#pragma unroll
    for (int j = 0; j < PE_NT; ++j) {
        const int t = tbase + j;
        float ss = 0.f; f32x4 xo[4];
        { const v4u* xrow = (const v4u*)((const bf16*)(ws + WS_XB) + (size_t)t * 1024 + 16 * lane); const v4u xa = xrow[0], xc = xrow[1];
          xo[0] = (f32x4){bflo(xa.x), bfhi(xa.x), bflo(xa.y), bfhi(xa.y)}; xo[1] = (f32x4){bflo(xa.z), bfhi(xa.z), bflo(xa.w), bfhi(xa.w)};
          xo[2] = (f32x4){bflo(xc.x), bfhi(xc.x), bflo(xc.y), bfhi(xc.y)}; xo[3] = (f32x4){bflo(xc.z), bfhi(xc.z), bflo(xc.w), bfhi(xc.w)}; }
#pragma unroll
        for (int i = 0; i < 4; ++i) { xo[i].x += acc[j][2 * i].x; xo[i].y += acc[j][2 * i].y; xo[i].z += acc[j][2 * i + 1].x; xo[i].w += acc[j][2 * i + 1].y;
            ss += (xo[i].x * xo[i].x + xo[i].y * xo[i].y) + (xo[i].z * xo[i].z + xo[i].w * xo[i].w); }
        const float rstd3 = rsqrtf(wave_sum(ss) * (1.0f / 1024.0f) + 1e-6f);
        float* orow = dstbase + (size_t)t * 1024 + 16 * lane;
#pragma unroll
        for (int i = 0; i < 4; ++i) { const f32x4 w = ((const f32x4*)(P.norm_final_w + 16 * lane))[i];
            ((f32x4*)orow)[i] = (f32x4){xo[i].x * rstd3 * w.x, xo[i].y * rstd3 * w.y, xo[i].z * rstd3 * w.z, xo[i].w * rstd3 * w.w}; }
    }
    LDS_WAIT(); asm volatile("s_waitcnt vmcnt(0)" ::: "memory");
}


#ifndef TWICE_MASK
#define TWICE_MASK 0
#endif
struct TwiceOrder { pg8::StaticOrder S; int per, reps;
    __device__ bool next(int i, pg8::Unit& u) const { if (i >= per * reps) return false; return S.next(i % per, u); }
    __device__ __forceinline__ void a_ready(const pg8::Unit&) const {} __device__ __forceinline__ void done(const pg8::Unit&) const {} };
template <class B> __device__ __forceinline__ bool rep_again(volatile LAS unsigned* MISC, B& bar) {
    __syncthreads(); const unsigned c = MISC[20]; __syncthreads();
    if (threadIdx.x == 0) MISC[20] = c ^ 1u;
    __syncthreads();
    if (c == 0u) { xcd_barrier(bar); return true; }
    return false;
}
__global__ void __launch_bounds__(NWAVES * 64, 2) hybrid_fwd(Params P) {
    extern __shared__ __attribute__((aligned(16))) unsigned char lds_raw[];
    LAS unsigned char* lds = (LAS unsigned char*)lds_raw;
    volatile LAS unsigned* MISC = (volatile LAS unsigned*)(lds + MISC_OFF);
    const int tid = threadIdx.x, lane = tid & 63, wave = __builtin_amdgcn_readfirstlane(tid >> 6);
    const int G = gridDim.x, bx = blockIdx.x;
    const int vcu = (G % 8 == 0) ? (bx % 8) * (G / 8) + bx / 8 : bx;
    unsigned char* ws = P.ws;
    for (int u = tid; u < 64; u += NWAVES * 64) MISC[u] = 0u;
    __syncthreads();
    XcdBarrier bar; bar.bar = (unsigned*)(ws + WS_CTL) + CW_BAR; bar.x = 0; bar.st = nullptr;
    if (!MK_PER_PHASE) bar = xcd_barrier_post((unsigned*)(ws + WS_CTL) + CW_BAR, MISC + 8);
    const int lo = P.ph_lo, hi = P.ph_hi;
#ifndef PHASE_MASK
#define PHASE_MASK 0xFFF
#endif
#define IN(k) (((PHASE_MASK >> (k)) & 1) && lo <= (k) && (k) < hi)
#define SEAM(k) do { if (IN(k) && IN((k) + 1)) xcd_barrier(bar); } while (0)
#ifndef REP_MASK
#define REP_MASK 0
#endif
#ifndef PE_EXP_MASK
#define PE_EXP_MASK 0x3fff
#endif
#define REPS(k) for (bool again_ = true; again_; again_ = (((REP_MASK >> (k)) & 1) ? rep_again(MISC, bar) : false))
    using namespace pg8;
    bf16* XB = (bf16*)(ws + WS_XB);

    if (IN(0)) REPS(0) { p0_prologue(P, lds, tid, lane, wave, vcu, G); }
    SEAM(0);
    if (IN(1)) REPS(1) {
        { Gemm gm{XB, (const bf16_t*)(ws + WS_WIN), T, 3072, 1024}; StaticOrder S; S.init(T, 3072, G, bx);
          EpiBf16Rs E{(bf16_t*)(ws + WS_QKV), 1536, 6, (bf16_t*)(ws + WS_XR), 512, (size_t)T * 512, nullptr, 1.0f};
          gemm_phase<EpiBf16Rs, StaticOrder, PG8_ALIGN, PG8_SP2>(lds, gm, S, E); }
    }
    SEAM(1);
    if (IN(3)) REPS(3) {
        if (bx < SCAN_WGS) gdn_scan(P, lds, bx, tid, lane, wave);
        else {
            const int wk = bx - SCAN_WGS, NWK = G - SCAN_WGS;
            unsigned* lcnt = (unsigned*)(ws + WS_CTL) + CW_LRUCNT;
            for (int q = wk; q < 1024; q += NWK) gdn_local_item(P, lds, (q & 7) * 128 + (q >> 3), tid);
            if (wk < 16) {
                struct OneUnit { int pm, pn; __device__ bool next(int i, Unit& u) const { if (i > 0) return false; u.pm = pm; u.pn = pn; return true; }
                                 __device__ void a_ready(const Unit&) const {} __device__ void done(const Unit&) const {} };
                Gemm gm{(const bf16_t*)(ws + WS_MEMN), (const bf16_t*)(ws + WS_WKV), 512, 2048, 1024}; OneUnit S{wk >> 3, wk & 7};
                EpiKV E{(bf16_t*)(ws + WS_KB), (bf16_t*)(ws + WS_VTP)};
                gemm_phase<EpiKV, OneUnit, PG8_ALIGN, PG8_SP2>(lds, gm, S, E);
            }
            unsigned ndone = 0;
            for (int lt = wk; lt < 256; lt += NWK) { lru_local_item(P, lds, lt, tid, lane, wave); ++ndone; }
            asm volatile("s_waitcnt vmcnt(0)" ::: "memory");
            __syncthreads();
            if (tid == 0 && ndone) { __builtin_amdgcn_fence(__ATOMIC_RELEASE, "agent"); asm volatile("s_waitcnt vmcnt(0)" ::: "memory");
                                     __hip_atomic_fetch_add(lcnt, ndone, __ATOMIC_RELAXED, __HIP_MEMORY_SCOPE_AGENT); }
            if (wk == 16 || wk == 17) {
                if (tid == 0) { unsigned sp = 0;
                    while (__hip_atomic_load(lcnt, __ATOMIC_RELAXED, __HIP_MEMORY_SCOPE_AGENT) < 256u) { __builtin_amdgcn_s_sleep(8); if (++sp > (1u << 22)) break; }
                    __builtin_amdgcn_fence(__ATOMIC_ACQUIRE, "agent"); asm volatile("s_waitcnt vmcnt(0)" ::: "memory"); }
                __syncthreads();
                lru_carry(P, (wk - 16) * NWAVES + wave, lane);
                asm volatile("s_waitcnt vmcnt(0)" ::: "memory");
                __syncthreads();
                if (tid == 0) { __builtin_amdgcn_fence(__ATOMIC_RELEASE, "agent"); asm volatile("s_waitcnt vmcnt(0)" ::: "memory");
                                __hip_atomic_fetch_add(lcnt + 64, 1u, __ATOMIC_RELAXED, __HIP_MEMORY_SCOPE_AGENT); }
            } else {
                const int w2 = (wk < 16 ? wk : wk - 2), N2 = NWK - 2;
                cvt_table_fp8(P.peer_v, ws + WS_VB, (float*)(ws + WS_VSC), w2 * NWAVES + wave, N2 * NWAVES, lane);
                late_weight_prep(P, lds, lane, wave, w2 * NWAVES + wave, N2 * NWAVES);
                if (tid == 0) { unsigned sp = 0;
                    while (__hip_atomic_load(lcnt + 64, __ATOMIC_RELAXED, __HIP_MEMORY_SCOPE_AGENT) < 2u) { __builtin_amdgcn_s_sleep(8); if (++sp > (1u << 22)) break; }
                    __builtin_amdgcn_fence(__ATOMIC_ACQUIRE, "agent"); asm volatile("s_waitcnt vmcnt(0)" ::: "memory"); }
                __syncthreads();
                lru_combine(P, (size_t)w2 * (NWAVES * 64) + tid, (size_t)N2 * (NWAVES * 64));
            }
        }
    }
    SEAM(3);
    if (IN(4)) REPS(4) {
        gdn_gate_norm(P, (size_t)bx * (NWAVES * 64) + tid, (size_t)G * (NWAVES * 64));
        cvt_table_fp8(P.peer_u, ws + WS_UB, (float*)(ws + WS_USC), bx * NWAVES + wave, G * NWAVES, lane);
    }
    SEAM(4);
    if (IN(5)) {
        Gemm gm{(const bf16_t*)((const unsigned char*)P.out + OUT_Y), (const bf16_t*)(ws + WS_WOUT), T, 1024, 1024}; StaticOrder S; S.init(T, 1024, G, bx);
        EpiResidBf<true> E{P.x, XB, (float*)(ws + WS_SSQ1)};
        gemm_phase<EpiResidBf<true>, StaticOrder, PG8_ALIGN, PG8_SP2>(lds, gm, S, E);
    }
    SEAM(5);
    if (IN(6)) REPS(6) {
        Gemm gm{XB, (const bf16_t*)(ws + WS_WQ), T, 1024, 1024};
        EpiBf16Rs E{(bf16_t*)(ws + WS_Q), 1024, 4, nullptr, 256, 0, (const float*)(ws + WS_SSQ1), 0.0625f};
#if (TWICE_MASK >> 6) & 1
        { TwiceOrder S; S.S.init(T, 1024, G, bx); S.per = 1; S.reps = 2;
          gemm_phase<EpiBf16Rs, TwiceOrder, PG8_ALIGN, PG8_SP2>(lds, gm, S, E); }
#else
        { StaticOrder S; S.init(T, 1024, G, bx);
          gemm_phase<EpiBf16Rs, StaticOrder, PG8_ALIGN, PG8_SP2>(lds, gm, S, E); }
#endif
        Unit u;
        { const int wgid = (bx & 7) * 32 + (bx >> 3); u.pm = (wgid >> 5) * 8 + (wgid & 7); u.pn = (wgid & 31) >> 3; }
        if (G == 256) {
            asm volatile("s_waitcnt vmcnt(0)" ::: "memory");
            __syncthreads();
            const int b = u.pm >> 5, qb0 = (u.pm & 31) * 2, h = u.pn;
#pragma unroll 1
            for (int qq = 0; qq < (((TWICE_MASK >> 7) & 1) ? 4 : 2); ++qq) xattn_unit(P, lds, (b << 8) | ((qb0 + (qq & 1)) << 2) | h, tid, lane, wave);
        }
    }
    if (IN(7)) REPS(7) { }
    SEAM(7);
    if (IN(8)) {
        Gemm gm{(const bf16_t*)(ws + WS_AO), (const bf16_t*)(ws + WS_WO), T, 1024, 1024}; StaticOrder S; S.init(T, 1024, G, bx);
        EpiResidBf<false> E{nullptr, XB, (float*)(ws + WS_SSQ2)};
        gemm_phase<EpiResidBf<false>, StaticOrder, PG8_ALIGN, PG8_SP2>(lds, gm, S, E);
    }
    SEAM(8);
    if (IN(9)) REPS(9) {
        Gemm gm{XB, (const bf16_t*)(ws + WS_PWQ), T, 2048, 1024};
        EpiF16Rs E{(_Float16*)(ws + WS_PQ), 2048, (const float*)(ws + WS_SSQ2)};
#if (TWICE_MASK >> 9) & 1
        TwiceOrder S; S.S.init(T, 2048, G, bx); S.per = 2; S.reps = 2;
        gemm_phase<EpiF16Rs, TwiceOrder, PG8_ALIGN, PG8_SP2>(lds, gm, S, E);
#else
        StaticOrder S; S.init(T, 2048, G, bx);
        gemm_phase<EpiF16Rs, StaticOrder, PG8_ALIGN, PG8_SP2>(lds, gm, S, E);
#endif
    }
    SEAM(9);
    if (IN(10)) REPS(10) {
    }
    if (IN(11)) REPS(11) {
#if (TWICE_MASK >> 11) & 1
        for (int it = 0; it < 4; ++it) { const int tb = (bx * NWAVES + wave) * PE_NT + (it >> 1) * (G * NWAVES * PE_NT); if (tb < T) peer_pass(P, lds, tb, lane, wave, P.out, (it & 1) ? 0x3fff : PE_EXP_MASK); }
#else
        for (int tb = (bx * NWAVES + wave) * PE_NT; tb < T; tb += G * NWAVES * PE_NT) peer_pass(P, lds, tb, lane, wave, P.out);
#endif
    }
#undef IN
#undef SEAM
}

extern "C" void kernel_launch(void* const* d_in, const int* in_sizes, int n_in, void* d_out, int out_size, void* d_ws, size_t ws_size, hipStream_t stream) {
    static int grid = 0;
    if (grid == 0) {
        if (n_in != 27 || in_sizes[0] != T * D || out_size != T * D || ws_size < WS_END) {
            fprintf(stderr, "kernel_launch: unexpected shapes (n_in %d, in0 %d, out %d, ws %zu); nothing launched\n", n_in, n_in > 0 ? in_sizes[0] : -1, out_size, ws_size); grid = -1; return; }
        int dev = 0, cus = 0, per_cu = 0;
        if (hipGetDevice(&dev) != hipSuccess || hipDeviceGetAttribute(&cus, hipDeviceAttributeMultiprocessorCount, dev) != hipSuccess) { grid = -1; return; }
        if (hipFuncSetAttribute((const void*)hybrid_fwd, hipFuncAttributeMaxDynamicSharedMemorySize, LDS_BYTES) != hipSuccess) { fprintf(stderr, "kernel_launch: hipFuncSetAttribute failed\n"); grid = -1; return; }
        if (hipOccupancyMaxActiveBlocksPerMultiprocessor(&per_cu, (const void*)hybrid_fwd, NWAVES * 64, LDS_BYTES) != hipSuccess || per_cu < 1)
            fprintf(stderr, "kernel_launch: note: occupancy query reports %d workgroups per CU\n", per_cu);
        (void)hipGetLastError();
        grid = cus;
        if (grid != 256) fprintf(stderr, "kernel_launch: %d CUs (built for 256)\n", grid);
    }
    if (grid < 0) return;
    if (hipMemsetAsync((char*)d_ws + WS_CTL, 0, CTL_ZERO_BYTES, stream) != hipSuccess) { fprintf(stderr, "kernel_launch: hipMemsetAsync failed\n"); return; }
    Params p{};
    const float** pp = (const float**)&p;
    for (int i = 0; i < 27; ++i) pp[i] = (const float*)d_in[i];
    p.out = (float*)d_out; p.ws = (unsigned char*)d_ws;
#if MK_PER_PHASE
    for (int k = 0; k < N_PHASES; ++k) { p.ph_lo = k; p.ph_hi = k + 1; hipLaunchKernelGGL(hybrid_fwd, dim3(grid), dim3(NWAVES * 64), LDS_BYTES, stream, p); }
#else
    p.ph_lo = 0; p.ph_hi = N_PHASES;
    hipLaunchKernelGGL(hybrid_fwd, dim3(grid), dim3(NWAVES * 64), LDS_BYTES, stream, p);
#endif
    const hipError_t le = hipPeekAtLastError();
    if (le != hipSuccess) fprintf(stderr, "kernel_launch: launch failed: %s\n", hipGetErrorName(le));
}
```

```cpp
#include <hip/hip_runtime.h>
#include <cstdio>
#include <cstdint>
namespace pg8 {
#define PG8_LAS __attribute__((address_space(3)))
typedef unsigned short bf16_t;
typedef short bf16x8 __attribute__((ext_vector_type(8)));
typedef float f32x4 __attribute__((ext_vector_type(4)));
typedef unsigned u32x4 __attribute__((ext_vector_type(4)));
constexpr int BM = 256, BK = 64, HALF = 128, HTB = HALF * BK * 2  , STAGE_BYTES = 8 * HTB, NXCD = 8, WGM = 8;

__host__ __device__ __forceinline__ int lds_byte(int r, int c) { const int st = (r >> 4) * 2 + (c >> 5), rr = r & 15, cc = c & 31, ob = rr * 64 + cc * 2; return st * 1024 + (ob ^ (((ob >> 9) & 1) << 5)); }
__host__ __device__ __forceinline__ void stage_rc(int b, int& R, int& C) { const int st = b / 1024, sb = b % 1024, swz = sb ^ (((sb >> 9) & 1) << 5); R = (st >> 1) * 16 + swz / 64; C = (st & 1) * 32 + (swz % 64) / 2; }
__host__ __device__ __forceinline__ int perm32(int rho) { const int n = rho >> 4, i = rho & 15; return 8 * (i >> 2) + 4 * n + (i & 3); }

struct Unit { int pm, pn; };
struct Gemm { const bf16_t* A; const bf16_t* Bt; int M, N, K; };

struct StaticOrder {
    int nM, nN, nwg, G, c;
    __host__ __device__ void init(int M, int N, int G_, int c_) { nM = M / BM; nN = N / BM; nwg = nM * nN; G = G_; c = c_; }
    __host__ __device__ bool next(int i, Unit& u) const {
        const long L = (long)i * G + c; if (L >= nwg) return false;
        int wgid = (int)L; { const int q = nwg / NXCD, r = nwg % NXCD, xcd = wgid % NXCD, off = wgid / NXCD; wgid = (xcd < r ? xcd * (q + 1) : r * (q + 1) + (xcd - r) * q) + off; }
        const int nig = WGM * nN, gid = wgid / nig, fm = gid * WGM, gsz = (nM - fm) < WGM ? (nM - fm) : WGM;
        u.pm = fm + ((wgid % nig) % gsz); u.pn = (wgid % nig) / gsz; return true;
    }
    __device__ __forceinline__ void a_ready(const Unit&) const {}
    __device__ __forceinline__ void done(const Unit&) const {}
};

__device__ __forceinline__ unsigned cvt_pk_bf16(float lo, float hi) { unsigned r; asm volatile("v_cvt_pk_bf16_f32 %0, %1, %2" : "=v"(r) : "v"(lo), "v"(hi)); return r; }
template <class Epi, class Sched, bool ALIGN_EPI = false, bool SP2 = false>
__device__ __forceinline__ void gemm_phase(PG8_LAS unsigned char* lds, const Gemm g, const Sched& S, const Epi& E) {
    const int tid = threadIdx.x, wid = __builtin_amdgcn_readfirstlane(tid >> 6), lane = tid & 63, wr = wid >> 2, wc = wid & 3, fr = lane & 15, fq = lane >> 4;
    const int K = g.K, nt = K / BK;
    unsigned voffA[2], voffB[2];
#pragma unroll
    for (int i = 0; i < 2; ++i) { int R, C; stage_rc(tid * 16 + i * 8192, R, C); const int Rb = Epi::PERM ? ((R & ~31) + perm32(R & 31)) : R;
        voffA[i] = (unsigned)(R * K + C) * 2u; voffB[i] = (unsigned)(Rb * K + C) * 2u; }
    const size_t kstep = (size_t)(BK * 2);
    const size_t hstep = (size_t)HALF * K * 2;
    const size_t tstep = 2 * hstep;
    const unsigned ldsw = (unsigned)wid * 1024u;
    const int aoff = lds_byte(wr * 64 + fr, fq * 8), boff = lds_byte(wc * 32 + fr, fq * 8);
#define PG8_SA(b, h) (((b) * 2 + (h)) * HTB)
#define PG8_SB(b, h) ((4 + (b) * 2 + (h)) * HTB)
#define PG8_STAGE(bufoff, gbase, voff) do { _Pragma("unroll") for (int _i = 0; _i < 2; ++_i) \
        __builtin_amdgcn_global_load_lds((const unsigned*)((const char*)(gbase) + (voff)[_i]), (PG8_LAS unsigned*)(lds + (bufoff) + ldsw + _i * 8192), 16, 0, 0); } while (0)
#define PG8_LDA(dst, b, h) do { _Pragma("unroll") for (int m = 0; m < 4; ++m) _Pragma("unroll") for (int k = 0; k < 2; ++k) dst[m][k] = *(const PG8_LAS bf16x8*)(lds + PG8_SA(b, h) + aoff + m * 2048 + k * 1024); } while (0)
#define PG8_LDB(dst, b, h) do { _Pragma("unroll") for (int n = 0; n < 2; ++n) _Pragma("unroll") for (int k = 0; k < 2; ++k) dst[n][k] = *(const PG8_LAS bf16x8*)(lds + PG8_SB(b, h) + boff + n * 2048 + k * 1024); } while (0)
#define PG8_MMA(ai, bj, At, Bt) do { __builtin_amdgcn_s_setprio(1); _Pragma("unroll") for (int m = 0; m < 4; ++m) _Pragma("unroll") for (int n = 0; n < 2; ++n) _Pragma("unroll") for (int k = 0; k < 2; ++k) \
        acc[ai][bj][m][n] = __builtin_amdgcn_mfma_f32_16x16x32_bf16(Bt[n][k], At[m][k], acc[ai][bj][m][n], 0, 0, 0); __builtin_amdgcn_s_setprio(0); } while (0)
#define PG8_WAIT_V(n) asm volatile("s_waitcnt vmcnt(" #n ")" ::: "memory")
#define PG8_WAIT_L(n) asm volatile("s_waitcnt lgkmcnt(" #n ")" ::: "memory")
#define PG8_BAR __builtin_amdgcn_s_barrier()
#define PG8_SCHED __builtin_amdgcn_sched_barrier(0)
    Unit cur, nxt; int ui = 0;
    if (!S.next(0, cur)) return;
    f32x4 acc[2][2][4][2];
#pragma unroll
    for (int a = 0; a < 2; ++a)
#pragma unroll
        for (int b = 0; b < 2; ++b)
#pragma unroll
            for (int m = 0; m < 4; ++m)
#pragma unroll
                for (int n = 0; n < 2; ++n) acc[a][b][m][n] = (f32x4){0.f, 0.f, 0.f, 0.f};
    bf16x8 At[4][2], B0[2][2], B1[2][2];
    const char* cA = (const char*)g.A + (size_t)cur.pm * tstep; const char* cB = (const char*)g.Bt + (size_t)cur.pn * tstep;
    S.a_ready(cur);
    if constexpr (SP2) {
        PG8_STAGE(PG8_SB(0, 0), cB, voffB); PG8_STAGE(PG8_SB(0, 1), cB + hstep, voffB); PG8_STAGE(PG8_SA(0, 0), cA, voffA); PG8_STAGE(PG8_SA(0, 1), cA + hstep, voffA);
        if (wr == 1) PG8_BAR;
        PG8_WAIT_V(2); PG8_BAR;
        PG8_STAGE(PG8_SB(1, 0), cB + kstep, voffB); PG8_STAGE(PG8_SA(1, 0), cA + kstep, voffA); PG8_STAGE(PG8_SB(1, 1), cB + hstep + kstep, voffB);
        PG8_WAIT_V(6); PG8_BAR;
    } else {
        PG8_STAGE(PG8_SB(0, 0), cB, voffB); PG8_STAGE(PG8_SA(0, 0), cA, voffA); PG8_STAGE(PG8_SB(0, 1), cB + hstep, voffB); PG8_STAGE(PG8_SA(0, 1), cA + hstep, voffA);
        if (wr == 1) PG8_BAR;
        PG8_WAIT_V(4); PG8_BAR;
        PG8_STAGE(PG8_SB(1, 0), cB + kstep, voffB); PG8_STAGE(PG8_SA(1, 0), cA + kstep, voffA); PG8_STAGE(PG8_SB(1, 1), cB + hstep + kstep, voffB);
        PG8_WAIT_V(6); PG8_BAR;
    }
    for (;;) {
        const bool has_next = S.next(ui + 1, nxt);
        const char* nA = has_next ? (const char*)g.A + (size_t)nxt.pm * tstep : cA; const char* nB = has_next ? (const char*)g.Bt + (size_t)nxt.pn * tstep : cB;
        for (int t = 0; t < nt; t += 2) {
            const bool last = (t == nt - 2);
            const char* a1 = cA + (size_t)(t + 1) * kstep;
            const char* a2 = last ? nA : cA + (size_t)(t + 2) * kstep; const char* b2 = last ? nB : cB + (size_t)(t + 2) * kstep;
            const char* a3 = a2 + kstep; const char* b3 = b2 + kstep;
            if (last && has_next) S.a_ready(nxt);
            if constexpr (SP2) {
            PG8_LDB(B0, 0, 0); PG8_LDB(B1, 0, 1); PG8_SCHED; PG8_LDA(At, 0, 0); PG8_STAGE(PG8_SA(1, 1), a1 + hstep, voffA);
            PG8_WAIT_V(8); PG8_WAIT_L(0); PG8_BAR; PG8_MMA(0, 0, At, B0); PG8_MMA(0, 1, At, B1); PG8_BAR; PG8_SCHED;
            PG8_LDA(At, 0, 1); PG8_STAGE(PG8_SB(0, 0), b2, voffB); PG8_STAGE(PG8_SB(0, 1), b2 + hstep, voffB); PG8_STAGE(PG8_SA(0, 0), a2, voffA);
            PG8_WAIT_V(8); PG8_WAIT_L(0); PG8_BAR; PG8_MMA(1, 0, At, B0); PG8_MMA(1, 1, At, B1); PG8_BAR; PG8_SCHED;
            PG8_LDB(B0, 1, 0); PG8_LDB(B1, 1, 1); PG8_SCHED; PG8_LDA(At, 1, 0); PG8_STAGE(PG8_SA(0, 1), a2 + hstep, voffA);
            PG8_WAIT_V(8); PG8_WAIT_L(0); PG8_BAR; PG8_MMA(0, 0, At, B0); PG8_MMA(0, 1, At, B1); PG8_BAR; PG8_SCHED;
            PG8_LDA(At, 1, 1); PG8_STAGE(PG8_SB(1, 0), b3, voffB); PG8_STAGE(PG8_SB(1, 1), b3 + hstep, voffB); PG8_STAGE(PG8_SA(1, 0), a3, voffA);
            PG8_WAIT_V(8); PG8_WAIT_L(0); PG8_BAR; PG8_MMA(1, 0, At, B0); PG8_MMA(1, 1, At, B1); PG8_BAR; PG8_SCHED;
            } else {
            PG8_LDB(B0, 0, 0); PG8_SCHED; PG8_LDA(At, 0, 0); PG8_STAGE(PG8_SA(1, 1), a1 + hstep, voffA);
            PG8_WAIT_L(8); PG8_BAR; PG8_WAIT_L(0); PG8_MMA(0, 0, At, B0); PG8_BAR; PG8_SCHED;
            PG8_LDB(B1, 0, 1); PG8_STAGE(PG8_SB(0, 0), b2, voffB);
            PG8_BAR; PG8_WAIT_L(0); PG8_MMA(0, 1, At, B1); PG8_BAR;
            PG8_LDA(At, 0, 1); PG8_STAGE(PG8_SA(0, 0), a2, voffA);
            PG8_BAR; PG8_WAIT_L(0); PG8_MMA(1, 0, At, B0); PG8_BAR; PG8_SCHED;
            PG8_STAGE(PG8_SB(0, 1), b2 + hstep, voffB);
            PG8_WAIT_V(6); PG8_BAR; PG8_MMA(1, 1, At, B1); PG8_BAR;
            PG8_LDB(B0, 1, 0); PG8_SCHED; PG8_LDA(At, 1, 0); PG8_STAGE(PG8_SA(0, 1), a2 + hstep, voffA);
            PG8_WAIT_L(8); PG8_BAR; PG8_WAIT_L(0); PG8_MMA(0, 0, At, B0); PG8_BAR; PG8_SCHED;
            PG8_LDB(B1, 1, 1); PG8_STAGE(PG8_SB(1, 0), b3, voffB);
            PG8_BAR; PG8_WAIT_L(0); PG8_MMA(0, 1, At, B1); PG8_BAR;
            PG8_LDA(At, 1, 1); PG8_STAGE(PG8_SA(1, 0), a3, voffA);
            PG8_BAR; PG8_WAIT_L(0); PG8_MMA(1, 0, At, B0); PG8_BAR; PG8_SCHED;
            PG8_STAGE(PG8_SB(1, 1), b3 + hstep, voffB);
            PG8_WAIT_V(6); PG8_BAR; PG8_MMA(1, 1, At, B1); PG8_BAR;
            }
        }
        if constexpr (ALIGN_EPI) { if (wr == 0) PG8_BAR; }
        if constexpr (!Epi::AFTER_DRAIN) { E(acc, cur, wr, wc, fr, fq); S.done(cur); }
        if (!has_next) break;
#pragma unroll
        for (int a = 0; a < 2; ++a)
#pragma unroll
            for (int b = 0; b < 2; ++b)
#pragma unroll
                for (int m = 0; m < 4; ++m)
#pragma unroll
                    for (int n = 0; n < 2; ++n) acc[a][b][m][n] = (f32x4){0.f, 0.f, 0.f, 0.f};
        cur = nxt; cA = nA; cB = nB; ++ui;
        if constexpr (ALIGN_EPI) { if (wr == 1) PG8_BAR; }
    }
    PG8_WAIT_V(0);
    if constexpr (!ALIGN_EPI) { if (wr == 0) PG8_BAR; }
    PG8_BAR;
    if constexpr (Epi::AFTER_DRAIN) { E.fused(acc, cur, wr, wc, fr, fq, lds, wid, lane); S.done(cur); }
#undef PG8_SA
#undef PG8_SB
#undef PG8_STAGE
#undef PG8_LDA
#undef PG8_LDB
#undef PG8_MMA
#undef PG8_WAIT_V
#undef PG8_WAIT_L
#undef PG8_BAR
#undef PG8_SCHED
}
}

namespace pg8 {
__host__ __device__ __forceinline__ int permk(int kl) { return 8 * ((kl & 15) >> 2) + 4 * (kl >> 4) + (kl & 3); }
struct EpiBf16Rs {
    static constexpr bool PERM = true, AFTER_DRAIN = false;
    bf16_t* O0; int ld0; int ntile0; bf16_t* O1; int ld1; size_t stride1; const float* ssq; float cs;
    __device__ __forceinline__ void operator()(const f32x4 (&acc)[2][2][4][2], const Unit& u, int wr, int wc, int fr, int fq) const {
        bf16_t* base; int ld, colt;
        if (u.pn < ntile0) { base = O0; ld = ld0; colt = u.pn * BM; }
        else { const int q = u.pn - ntile0, per = ld1 / BM; base = O1 + (size_t)(q / per) * stride1; ld = ld1; colt = (q % per) * BM; }
        const int row0 = u.pm * BM + wr * 64 + fr, col0 = colt + wc * 32 + 8 * fq;
#pragma unroll
        for (int ai = 0; ai < 2; ++ai)
#pragma unroll
            for (int m = 0; m < 4; ++m) {
                const int row = row0 + ai * HALF + m * 16;
                float sc = cs; if (ssq) sc *= rsqrtf(ssq[row] * (1.0f / 1024.0f) + 1e-6f);
                bf16_t* rowp = base + (size_t)row * ld + col0;
#pragma unroll
                for (int bj = 0; bj < 2; ++bj) { const f32x4 v0 = acc[ai][bj][m][0] * sc, v1 = acc[ai][bj][m][1] * sc;
                    u32x4 w; w.x = cvt_pk_bf16(v0[0], v0[1]); w.y = cvt_pk_bf16(v0[2], v0[3]); w.z = cvt_pk_bf16(v1[0], v1[1]); w.w = cvt_pk_bf16(v1[2], v1[3]);
                    *(u32x4*)(rowp + bj * HALF) = w; } }
    }
};
struct EpiF16Rs {
    static constexpr bool PERM = true, AFTER_DRAIN = false;
    _Float16* O; int ld; const float* ssq;
    __device__ __forceinline__ void operator()(const f32x4 (&acc)[2][2][4][2], const Unit& u, int wr, int wc, int fr, int fq) const {
        typedef _Float16 f16x8 __attribute__((ext_vector_type(8)));
        const int row0 = u.pm * BM + wr * 64 + fr, col0 = u.pn * BM + wc * 32 + 8 * fq;
#pragma unroll
        for (int ai = 0; ai < 2; ++ai)
#pragma unroll
            for (int m = 0; m < 4; ++m) {
                const int row = row0 + ai * HALF + m * 16;
                const float sc = rsqrtf(ssq[row] * (1.0f / 1024.0f) + 1e-6f);
                _Float16* rowp = O + (size_t)row * ld + col0;
#pragma unroll
                for (int bj = 0; bj < 2; ++bj) { const f32x4 v0 = acc[ai][bj][m][0] * sc, v1 = acc[ai][bj][m][1] * sc;
                    f16x8 w; w[0] = (_Float16)v0[0]; w[1] = (_Float16)v0[1]; w[2] = (_Float16)v0[2]; w[3] = (_Float16)v0[3];
                    w[4] = (_Float16)v1[0]; w[5] = (_Float16)v1[1]; w[6] = (_Float16)v1[2]; w[7] = (_Float16)v1[3];
                    *(f16x8*)(rowp + bj * HALF) = w; } }
    }
};
template <bool BASE_F32> struct EpiResidBf {
    static constexpr bool PERM = true, AFTER_DRAIN = false;
    const float* basef; bf16_t* xb; float* ssq;
    __device__ __forceinline__ void operator()(const f32x4 (&acc)[2][2][4][2], const Unit& u, int wr, int wc, int fr, int fq) const {
        const int row0 = u.pm * BM + wr * 64 + fr, col0 = u.pn * BM + wc * 32 + 8 * fq;
#pragma unroll
        for (int ai = 0; ai < 2; ++ai)
#pragma unroll
            for (int m = 0; m < 4; ++m) {
                const int row = row0 + ai * HALF + m * 16; const size_t off = (size_t)row * 1024 + col0; float s = 0.f;
#pragma unroll
                for (int bj = 0; bj < 2; ++bj) { const size_t o2 = off + bj * HALF;
                    f32x4 b0, b1;
                    if (BASE_F32) { b0 = *(const f32x4*)(basef + o2); b1 = *(const f32x4*)(basef + o2 + 4); }
                    else { const u32x4 p = *(const u32x4*)(xb + o2);
                        b0 = (f32x4){__builtin_bit_cast(float, p.x << 16), __builtin_bit_cast(float, p.x & 0xffff0000u), __builtin_bit_cast(float, p.y << 16), __builtin_bit_cast(float, p.y & 0xffff0000u)};
                        b1 = (f32x4){__builtin_bit_cast(float, p.z << 16), __builtin_bit_cast(float, p.z & 0xffff0000u), __builtin_bit_cast(float, p.w << 16), __builtin_bit_cast(float, p.w & 0xffff0000u)}; }
                    const f32x4 o0 = b0 + acc[ai][bj][m][0], o1 = b1 + acc[ai][bj][m][1];
                    s += ((o0[0] * o0[0] + o0[1] * o0[1]) + (o0[2] * o0[2] + o0[3] * o0[3])) + ((o1[0] * o1[0] + o1[1] * o1[1]) + (o1[2] * o1[2] + o1[3] * o1[3]));
                    u32x4 w; w.x = cvt_pk_bf16(o0[0], o0[1]); w.y = cvt_pk_bf16(o0[2], o0[3]); w.z = cvt_pk_bf16(o1[0], o1[1]); w.w = cvt_pk_bf16(o1[2], o1[3]);
                    *(u32x4*)(xb + o2) = w; }
                s += __shfl_xor(s, 16); s += __shfl_xor(s, 32);
                if (fq == 0) atomicAdd(ssq + row, s);
            }
    }
};
struct EpiKV {
    static constexpr bool PERM = false, AFTER_DRAIN = false;
    bf16_t* Kb; bf16_t* VTp;
    __device__ __forceinline__ void operator()(const f32x4 (&acc)[2][2][4][2], const Unit& u, int wr, int wc, int fr, int fq) const {
        typedef unsigned u32x2v __attribute__((ext_vector_type(2)));
        const int row0 = u.pm * BM + wr * 64 + fr, col0 = u.pn * BM + wc * 32 + 4 * fq;
#pragma unroll
        for (int ai = 0; ai < 2; ++ai)
#pragma unroll
            for (int m = 0; m < 4; ++m) {
                const int row = row0 + ai * HALF + m * 16, b = row >> 8, key = row & 255;
#pragma unroll
                for (int bj = 0; bj < 2; ++bj)
#pragma unroll
                    for (int n = 0; n < 2; ++n) { const int col = col0 + bj * HALF + n * 16; const f32x4 v = acc[ai][bj][m][n];
                        const unsigned p01 = cvt_pk_bf16(v[0], v[1]), p23 = cvt_pk_bf16(v[2], v[3]);
                        if (col < 1024) { const int h = col >> 8, dh = col & 255; u32x2v w; w.x = p01; w.y = p23;
                            *(u32x2v*)(Kb + ((size_t)((b * 4 + h) * 256 + key)) * 256 + dh) = w; }
                        else { const int c2 = col - 1024, h = c2 >> 8, dv = c2 & 255, kp = (key & ~31) | permk(key & 31);
                            bf16_t* d = VTp + ((size_t)((b * 4 + h) * 256 + dv)) * 256 + kp;
                            d[0] = (bf16_t)(p01 & 0xffffu); d[256] = (bf16_t)(p01 >> 16); d[512] = (bf16_t)(p23 & 0xffffu); d[768] = (bf16_t)(p23 >> 16); } }
            }
    }
};
}
#ifndef PG8_SP2
#define PG8_SP2 true
#endif
#ifndef PG8_ALIGN
#define PG8_ALIGN true
#endif

constexpr int NWAVES = 8;
#ifndef MK_PER_PHASE
#define MK_PER_PHASE 0
#endif
constexpr int T = 16384, SEQ = 8192, D = 1024;
constexpr int N_PHASES = 12;

constexpr size_t MiB = 1u << 20, KiB = 1u << 10;
constexpr size_t WS_CTL = 0, CTL_ZERO_BYTES = 1 * MiB;
constexpr int CW_BAR = 4096;
constexpr size_t WS_SSQ1 = 64 * KiB, WS_SSQ2 = 128 * KiB;
constexpr size_t WS_AB = 1 * MiB;
constexpr size_t WS_HEND = WS_AB + 512 * KiB, WS_PEND = WS_HEND + 512 * KiB, WS_HIN = WS_PEND + 512 * KiB;
constexpr size_t WS_DEC = WS_HIN + 512 * KiB;
constexpr size_t WS_SUBK = 3 * MiB + 256 * KiB;
constexpr size_t WS_WIN = 4 * MiB, WS_WOUT = 10 * MiB, WS_WQ = 12 * MiB, WS_WKV = 14 * MiB, WS_WO = 18 * MiB, WS_PWQ = 20 * MiB;
constexpr size_t WS_MEMN = 24 * MiB, WS_KB = 25 * MiB, WS_VTP = 26 * MiB, WS_LRUWT = 27 * MiB, WS_USC = 27 * MiB + 256 * KiB, WS_VSC = 27 * MiB + 384 * KiB;
constexpr size_t WS_XB = 28 * MiB;
constexpr size_t WS_HLOC = 28 * MiB, WS_PCUM = 44 * MiB;
constexpr size_t WS_QKV = 60 * MiB;
constexpr size_t OUT_Y = 4 * MiB;
constexpr size_t OUT_END = OUT_Y + (size_t)16384 * 1024 * 2;
constexpr size_t WS_IDX = 60 * MiB, WS_GW = 68 * MiB;
constexpr size_t WS_UB = 60 * MiB;
constexpr size_t WS_XR = 108 * MiB, WS_Z = 124 * MiB, WS_GATE = 140 * MiB;
constexpr size_t WS_WN = 156 * MiB, WS_UF = 172 * MiB, WS_QD = 188 * MiB, WS_KD = 204 * MiB, WS_ATT = 220 * MiB;
constexpr size_t WS_VB = 228 * MiB;
constexpr size_t WS_Q = 188 * MiB, WS_AO = 124 * MiB;
constexpr size_t WS_PQ = 108 * MiB;
constexpr size_t WS_END = 244 * MiB;
constexpr int CW_GFLAG = 49152;
constexpr int CW_LRUCNT = 8192;
static_assert(WS_XR - WS_QKV == (size_t)T * 1536 * 2 && WS_Z - WS_XR == (size_t)T * 512 * 2 && WS_GATE - WS_Z == (size_t)T * 512 * 2, "in-proj outputs are contiguous");

constexpr int LDS_BYTES = 160 * 1024;
constexpr int MISC_OFF = 159 * 1024;

#define GAS __attribute__((address_space(1)))
#define LAS __attribute__((address_space(3)))
typedef unsigned short bf16;
typedef unsigned v4u __attribute__((ext_vector_type(4)));
typedef unsigned v2u __attribute__((ext_vector_type(2)));
typedef float f32x4 __attribute__((ext_vector_type(4)));
typedef short bf16x8 __attribute__((ext_vector_type(8)));
typedef GAS unsigned gu32;
#define LDS_WAIT() asm volatile("s_waitcnt lgkmcnt(0)" ::: "memory")
__device__ __forceinline__ void st16_wt(void* p, v4u v) { asm volatile("global_store_dwordx4 %0, %1, off sc0 sc1\n\ts_nop 1" :: "v"(p), "v"(v) : "memory"); }
__device__ __forceinline__ unsigned f2bf(float f) { unsigned u = __builtin_bit_cast(unsigned, f); return (u + 0x7fffu + ((u >> 16) & 1u)) >> 16; }
__device__ __forceinline__ unsigned pk2(float lo, float hi) { return f2bf(lo) | (f2bf(hi) << 16); }
__device__ __forceinline__ float bflo(unsigned u) { return __builtin_bit_cast(float, u << 16); }
__device__ __forceinline__ float bfhi(unsigned u) { return __builtin_bit_cast(float, u & 0xffff0000u); }
__device__ __forceinline__ float bf1(bf16 h) { return __builtin_bit_cast(float, (unsigned)h << 16); }
__device__ __forceinline__ float wave_sum(float v) {
#pragma unroll
    for (int o = 1; o < 64; o <<= 1) v += __shfl_xor(v, o);
    return v;
}
__device__ __forceinline__ float row16_sum(float v) {
    v += __builtin_bit_cast(float, __builtin_amdgcn_update_dpp(0, __builtin_bit_cast(int, v), 0xB1, 0xF, 0xF, true));
    v += __builtin_bit_cast(float, __builtin_amdgcn_update_dpp(0, __builtin_bit_cast(int, v), 0x4E, 0xF, 0xF, true));
    v += __builtin_bit_cast(float, __builtin_amdgcn_update_dpp(0, __builtin_bit_cast(int, v), 0x141, 0xF, 0xF, true));
    v += __builtin_bit_cast(float, __builtin_amdgcn_update_dpp(0, __builtin_bit_cast(int, v), 0x140, 0xF, 0xF, true));
    return v;
}
__device__ __forceinline__ float sigmoidf_(float x) { return __builtin_amdgcn_rcpf(1.0f + __expf(-x)); }
__device__ __forceinline__ float softplusf_(float x) { return fmaxf(x, 0.f) + log1pf(__expf(-fabsf(x))); }
__device__ __forceinline__ float siluf_(float x) { return x * __builtin_amdgcn_rcpf(1.0f + __expf(-x)); }
__device__ __forceinline__ float gelu_tanh(float x) { const float y = 0.7978845608028654f * (x + 0.044715f * x * x * x); const float e = __expf(2.0f * y); return x * (1.0f - __builtin_amdgcn_rcpf(1.0f + e)); }
__device__ __forceinline__ int permk(int kl) { return 8 * ((kl & 15) >> 2) + 4 * (kl >> 4) + (kl & 3); }

struct Params {
    const float *x, *mem, *norm_mix_w, *w_in, *conv_qkv_w, *gdn_a_log, *gdn_dt_bias, *gdn_norm_w, *lru_conv_w, *lru_conv_b, *lru_wa, *lru_ba, *lru_wx, *lru_bx, *lru_lambda, *w_out,
                *norm_xattn_w, *norm_mem_w, *xattn_wq, *xattn_wkv, *xattn_wo, *norm_ffn_w, *peer_wq, *peer_subkeys, *peer_u, *peer_v, *norm_final_w;
    float* out; unsigned char* ws; int ph_lo, ph_hi;
};
#define XB_TMO      128
#define XB_XCNT(j)  (256  + 64 * (j))
#define XB_XSUB(j)  (1280 + 64 * (j))
#define XB_XGEN(j)  (2304 + 64 * (j))
#define XB_TOP      3328
#define XB_TOPGEN   3392
#define XCD_BAR_WORDS 3456
#define XB_SPIN_CAP (1u << 18)

__device__ __forceinline__ unsigned xb_ld(unsigned* p)              { return __hip_atomic_load(p, __ATOMIC_RELAXED, __HIP_MEMORY_SCOPE_AGENT); }
__device__ __forceinline__ unsigned xb_add(unsigned* p, unsigned v) { return __hip_atomic_fetch_add(p, v, __ATOMIC_RELAXED, __HIP_MEMORY_SCOPE_AGENT); }
__device__ __forceinline__ unsigned xb_xcc_id() { return (unsigned)__builtin_amdgcn_s_getreg((3 << 11) | 20) & 0xFu; }
#define XB_SPIN(cond, bar) do { unsigned _sp = 0; while (cond) { __builtin_amdgcn_s_sleep(1); \
    if ((++_sp & 255u) == 0u) { if (xb_ld(&(bar)[XB_TMO])) break; if (_sp > XB_SPIN_CAP) { atomicAdd(&(bar)[XB_TMO], 1u); break; } } } } while (0)

struct XcdBarrier {
    unsigned* bar; unsigned x;
    volatile LAS unsigned* st;
};

__device__ __forceinline__ XcdBarrier xcd_barrier_post(unsigned* bar, volatile LAS unsigned* st) {
    XcdBarrier b; b.bar = bar; b.x = xb_xcc_id(); b.st = st;
    if (threadIdx.x == 0) (void)xb_add(&bar[XB_XCNT(b.x)], 1u);
    return b;
}
__device__ __forceinline__ void xcd_barrier_complete(unsigned* bar, unsigned x, unsigned& nloc, unsigned& nx) {
    const unsigned G = gridDim.x * gridDim.y * gridDim.z;
    unsigned sum, cnt, mine, sp = 0u;
    for (;;) {
        sum = 0u; cnt = 0u; mine = 0u;
#pragma unroll
        for (unsigned j = 0; j < 16; ++j) { const unsigned c = xb_ld(&bar[XB_XCNT(j)]); sum += c; cnt += (c > 0u) ? 1u : 0u; mine = (j == x) ? c : mine; }
        if (sum == G) break;
        __builtin_amdgcn_s_sleep(1);
        if ((++sp & 255u) == 0u) { if (xb_ld(&bar[XB_TMO])) break; if (sp > XB_SPIN_CAP) { atomicAdd(&bar[XB_TMO], 1u); break; } }
    }
    nloc = mine > 0u ? mine : 1u; nx = cnt > 0u ? cnt : 1u;
}

__device__ __forceinline__ void xcd_barrier(const XcdBarrier& b) {
    asm volatile("s_waitcnt vmcnt(0)" ::: "memory");
    __syncthreads();
    if (threadIdx.x == 0) {
        unsigned* bar = b.bar;
        __builtin_amdgcn_s_waitcnt(0);
        unsigned nloc = b.st[0], nx = b.st[1];
        if (nloc == 0u) { xcd_barrier_complete(bar, b.x, nloc, nx); b.st[0] = nloc; b.st[1] = nx; }
        const unsigned old = xb_add(&bar[XB_XSUB(b.x)], 1u);
        const unsigned gen = old / nloc;
        if (old + 1u == (gen + 1u) * nloc) {
            __builtin_amdgcn_fence(__ATOMIC_RELEASE, "agent");
            asm volatile("s_waitcnt vmcnt(0)" ::: "memory");
            const unsigned og = xb_add(&bar[XB_TOP], 1u);
            const unsigned tg = og / nx;
            if (og + 1u == (tg + 1u) * nx) xb_add(&bar[XB_TOPGEN], 1u);
            else XB_SPIN(xb_ld(&bar[XB_TOPGEN]) == tg, bar);
            __builtin_amdgcn_fence(__ATOMIC_ACQUIRE, "agent");
            xb_add(&bar[XB_XGEN(b.x)], 1u);
            asm volatile("s_waitcnt vmcnt(0)" ::: "memory");
        } else {
            XB_SPIN(xb_ld(&bar[XB_XGEN(b.x)]) == gen, bar);
            __builtin_amdgcn_fence(__ATOMIC_ACQUIRE, "agent");
            asm volatile("s_waitcnt vmcnt(0)" ::: "memory");
        }
    }
    __syncthreads();
}

__device__ __forceinline__ void p0_transpose_item(const float* W, int K, int ldw, int c0, int nblk, bf16* WT, int row_off, const float* ks, LAS float* scr, int item, int lane) {
    const int kb = item / nblk, nb = item % nblk, k0 = 64 * kb, n0 = 32 * nb;
#pragma unroll 8
    for (int i = 0; i < 32; ++i) { const int kk = 2 * i + (lane >> 5); float v = W[(size_t)(k0 + kk) * ldw + c0 + n0 + (lane & 31)]; if (ks) v *= ks[k0 + kk]; scr[kk * 33 + (lane & 31)] = v; }
    LDS_WAIT(); asm volatile("" ::: "memory");
    const int c = lane & 7;
#pragma unroll
    for (int j = 0; j < 4; ++j) { const int n = (lane >> 3) + 8 * j; const LAS float* s = scr + (8 * c) * 33 + n;
        v4u o; o.x = pk2(s[0 * 33], s[1 * 33]); o.y = pk2(s[2 * 33], s[3 * 33]); o.z = pk2(s[4 * 33], s[5 * 33]); o.w = pk2(s[6 * 33], s[7 * 33]);
        *(GAS v4u*)(WT + (size_t)(row_off + n0 + n) * K + k0 + 8 * c) = o; }
    LDS_WAIT(); asm volatile("" ::: "memory");
}

__device__ __forceinline__ void p0_prologue(const Params& P, LAS unsigned char* lds, int tid, int lane, int wave, int vcu, int G) {
    unsigned char* ws = P.ws;
    const int gw = vcu * NWAVES + wave, NGW = G * NWAVES;
    LAS float* wabl = (LAS float*)lds;
    for (int idx = tid; idx < 8192; idx += NWAVES * 64) { const int k = idx >> 3, c = idx & 7, j = k >> 8, l = (k >> 2) & 63, e = k & 3;
        wabl[((((j * 4 + e) * 2 + (c >> 2)) * 64 + l) << 2) + (c & 3)] = P.w_in[(size_t)k * 3080 + 2048 + c]; }
    __syncthreads();
    {
        bf16* XB0 = (bf16*)(ws + WS_XB); float* AB = (float*)(ws + WS_AB);
        f32x4 w4[4];
#pragma unroll
        for (int j = 0; j < 4; ++j) w4[j] = ((const f32x4*)P.norm_mix_w)[64 * j + lane];
        for (int m = gw; m < T; m += NGW) {
            const f32x4* xr = (const f32x4*)(P.x + (size_t)m * D) + lane;
            f32x4 v[4]; float s = 0.f;
#pragma unroll
            for (int j = 0; j < 4; ++j) { v[j] = xr[64 * j]; s += (v[j].x * v[j].x + v[j].y * v[j].y) + (v[j].z * v[j].z + v[j].w * v[j].w); }
            const float rstd = rsqrtf(wave_sum(s) * (1.0f / D) + 1e-6f);
            v2u* o8 = (v2u*)(XB0 + (size_t)m * D) + lane;
            float part[8];
#pragma unroll
            for (int c = 0; c < 8; ++c) part[c] = 0.f;
#pragma unroll
            for (int j = 0; j < 4; ++j) {
                v[j] = v[j] * rstd * w4[j];
                v2u o; o.x = pk2(v[j].x, v[j].y); o.y = pk2(v[j].z, v[j].w); o8[64 * j] = o;
#pragma unroll
                for (int e = 0; e < 4; ++e) {
                    const f32x4 wa = *(const LAS f32x4*)(wabl + ((((j * 4 + e) * 2 + 0) * 64 + lane) << 2));
                    const f32x4 wb = *(const LAS f32x4*)(wabl + ((((j * 4 + e) * 2 + 1) * 64 + lane) << 2));
                    const float hv = v[j][e];
                    part[0] += hv * wa.x; part[1] += hv * wa.y; part[2] += hv * wa.z; part[3] += hv * wa.w;
                    part[4] += hv * wb.x; part[5] += hv * wb.y; part[6] += hv * wb.z; part[7] += hv * wb.w;
                }
            }
#pragma unroll
            for (int c = 0; c < 8; ++c) part[c] = wave_sum(part[c]);
            float o = part[0];
#pragma unroll
            for (int c = 1; c < 8; ++c) o = (lane == c) ? part[c] : o;
            if (lane < 8) AB[(size_t)m * 8 + lane] = o;
        }
    }
    {
        bf16* MEMN = (bf16*)(ws + WS_MEMN);
        for (int m = gw; m < 512; m += NGW) {
            const f32x4* xr = (const f32x4*)(P.mem + (size_t)m * D) + lane;
            f32x4 v[4]; float s = 0.f;
#pragma unroll
            for (int j = 0; j < 4; ++j) { v[j] = xr[64 * j]; s += (v[j].x * v[j].x + v[j].y * v[j].y) + (v[j].z * v[j].z + v[j].w * v[j].w); }
            const float rstd = rsqrtf(wave_sum(s) * (1.0f / D) + 1e-6f);
            v2u* o8 = (v2u*)(MEMN + (size_t)m * D) + lane;
#pragma unroll
            for (int j = 0; j < 4; ++j) { const f32x4 w = ((const f32x4*)P.norm_mem_w)[64 * j + lane]; const f32x4 y = v[j] * rstd * w;
                v2u o; o.x = pk2(y.x, y.y); o.y = pk2(y.z, y.w); o8[64 * j] = o; }
        }
    }
    __syncthreads();
    {
        LAS float* scr = (LAS float*)(lds + wave * 16384);
        constexpr int I_IN1 = 16 * 48, I_IN2 = 16 * 16, I_KV = 16 * 64;
        constexpr int NITEMS = I_IN1 + 3 * I_IN2 + I_KV;
        for (int it = gw; it < NITEMS; it += NGW) {
            int r = it;
            if (r < I_IN1) { p0_transpose_item(P.w_in, 1024, 3080, 0, 48, (bf16*)(ws + WS_WIN), 0, nullptr, scr, r, lane); continue; } r -= I_IN1;
            if (r < I_IN2) { p0_transpose_item(P.w_in, 1024, 3080, 2056, 16, (bf16*)(ws + WS_WIN), 1536, nullptr, scr, r, lane); continue; } r -= I_IN2;
            if (r < I_IN2) { p0_transpose_item(P.w_in, 1024, 3080, 1536, 16, (bf16*)(ws + WS_WIN), 2048, nullptr, scr, r, lane); continue; } r -= I_IN2;
            if (r < I_IN2) { p0_transpose_item(P.w_in, 1024, 3080, 2568, 16, (bf16*)(ws + WS_WIN), 2560, nullptr, scr, r, lane); continue; } r -= I_IN2;
            p0_transpose_item(P.xattn_wkv, 1024, 2048, 0, 64, (bf16*)(ws + WS_WKV), 0, nullptr, scr, r, lane);
        }
    }
    {
        bf16* WT = (bf16*)(ws + WS_LRUWT);
        for (int it = vcu * NWAVES * 64 + tid; it < 8 * 2 * 64 * 8; it += G * NWAVES * 64) {
            const int i8 = it & 7, j = (it >> 3) & 63, m = (it >> 9) & 1, g = it >> 10;
            const float* src = (m ? P.lru_wx : P.lru_wa) + (size_t)(g * 64 + 8 * i8) * 64 + j;
            v4u o; o.x = pk2(src[0], src[64]); o.y = pk2(src[128], src[192]); o.z = pk2(src[256], src[320]); o.w = pk2(src[384], src[448]);
            *(v4u*)(WT + (size_t)it * 8) = o;
        }
    }
}

__device__ __forceinline__ void late_weight_prep(const Params& P, LAS unsigned char* lds, int lane, int wave, int gw, int NGW) {
    unsigned char* ws = P.ws;
    {
        LAS float* scr = (LAS float*)(lds + wave * 16384);
        constexpr int I_OUT = 16 * 32, I_Q = 16 * 32, I_O = 16 * 32;
        for (int it = gw; it < I_OUT + I_Q + I_O; it += NGW) {
            int r = it;
            if (r < I_OUT) { p0_transpose_item(P.w_out, 1024, 1024, 0, 32, (bf16*)(ws + WS_WOUT), 0, nullptr, scr, r, lane); continue; } r -= I_OUT;
            if (r < I_Q) { p0_transpose_item(P.xattn_wq, 1024, 1024, 0, 32, (bf16*)(ws + WS_WQ), 0, P.norm_xattn_w, scr, r, lane); continue; } r -= I_Q;
            p0_transpose_item(P.xattn_wo, 1024, 1024, 0, 32, (bf16*)(ws + WS_WO), 0, nullptr, scr, r, lane);
        }
    }
    {
        bf16* WF = (bf16*)(ws + WS_PWQ);
        const int col = lane & 15, g = lane >> 4;
        for (int it = gw; it < 16 * 64; it += NGW) {
            const int hp = it >> 6, k0 = (it & 63) * 16;
            bf16x8 bq[4];
#pragma unroll
            for (int s = 0; s < 4; ++s) { const f32x4* src = (const f32x4*)(P.peer_wq + (size_t)(k0 + col) * 2048 + hp * 128 + 32 * s + 8 * g);
                const f32x4 a = src[0], c = src[1]; v4u pk; pk.x = pk2(a.x, a.y); pk.y = pk2(a.z, a.w); pk.z = pk2(c.x, c.y); pk.w = pk2(c.z, c.w); bq[s] = __builtin_bit_cast(bf16x8, pk); }
            const float nw = P.norm_ffn_w[k0 + col];
#pragma unroll 2
            for (int kt = 0; kt < 8; ++kt) {
                f32x4 acc = (f32x4){0.f, 0.f, 0.f, 0.f};
#pragma unroll
                for (int s = 0; s < 4; ++s) { const f32x4* src = (const f32x4*)(P.peer_subkeys + (size_t)(hp * 128 + 16 * kt + col) * 128 + 32 * s + 8 * g);
                    const f32x4 a = src[0], c = src[1]; v4u pk; pk.x = pk2(a.x, a.y); pk.y = pk2(a.z, a.w); pk.z = pk2(c.x, c.y); pk.w = pk2(c.z, c.w);
                    acc = __builtin_amdgcn_mfma_f32_16x16x32_bf16(__builtin_bit_cast(bf16x8, pk), bq[s], acc, 0, 0, 0); }
#pragma unroll
                for (int i = 0; i < 4; ++i) WF[(size_t)(hp * 128 + 16 * kt + 4 * g + i) * 1024 + k0 + col] = (bf16)f2bf(acc[i] * nw);
            }
        }
    }
}

constexpr int GL_KS = 0, GL_VS = 33792, GL_KB = 67584, GL_QB = 84992, GL_RAW = 102400, GL_CW = 153856, GL_AMT = 133120, GL_SM = 160000, GL_ATT = 151808, GL_SOL = 67584;
static_assert(GL_CW + 6144 <= GL_SM && GL_SM + 1284 <= MISC_OFF && GL_SOL + 65536 <= GL_AMT && GL_AMT + 17408 <= GL_ATT && GL_ATT + 8192 <= GL_SM && GL_RAW + 51456 <= GL_CW, "gdn_local LDS map");
#ifndef GL_REP_STEP
#define GL_REP_STEP -1
#endif
#define GL_REPF(k) for (int rr_ = 0; rr_ < ((GL_REP_STEP == (k)) ? 2 : 1); ++rr_)
#define GL_BAR() do { asm volatile("s_waitcnt lgkmcnt(0)" ::: "memory"); __builtin_amdgcn_s_barrier(); asm volatile("" ::: "memory"); } while (0)
__device__ __forceinline__ void gdn_local_item(const Params& P, LAS unsigned char* lds, int item, int tid) {
    unsigned char* ws = P.ws;
    asm volatile("" : "+v"(tid));
    const int b = item >> 9, h = (item >> 7) & 3, n = item & 127;
    const int t0 = b * SEQ + n * 64;
    const int lane = tid & 63, wave = __builtin_amdgcn_readfirstlane(tid >> 6);
    LAS float* ks = (LAS float*)(lds + GL_KS);
    LAS float* vs = (LAS float*)(lds + GL_VS);
    LAS bf16* kb16 = (LAS bf16*)(lds + GL_KB);
    LAS bf16* qb16 = (LAS bf16*)(lds + GL_QB);
    LAS bf16* raw = (LAS bf16*)(lds + GL_RAW);
    LAS float* cw = (LAS float*)(lds + GL_CW);
    LAS float* AmT = (LAS float*)(lds + GL_AMT);
    LAS float* sg = (LAS float*)(lds + GL_SM);
    LAS float* sbeta = sg + 64; LAS float* sgc = sbeta + 64; LAS float* seg = sgc + 64; LAS float* sek = seg + 64;
    LAS bf16* atts = (LAS bf16*)(lds + GL_ATT);
    const bf16* QKV = (const bf16*)(ws + WS_QKV);
    const float* AB = (const float*)(ws + WS_AB);
    GL_REPF(0) {
        v4u pr[7];
#pragma unroll
        for (int r = 0; r < 7; ++r) {
            const int id = tid + 512 * r;
            const int row = id / 48, rem = id - row * 48, part = rem >> 4, ck = rem & 15, s = n * 64 + row - 3;
            pr[r] = (v4u){0u, 0u, 0u, 0u};
            if (id < 67 * 48 && s >= 0) pr[r] = *(const v4u*)(QKV + (size_t)(b * SEQ + s) * 1536 + part * 512 + h * 128 + ck * 8);
        }
        f32x4 cwv = (f32x4){0.f, 0.f, 0.f, 0.f};
        if (tid < 384) { const int j = tid / 96, rem = tid - j * 96, part = rem >> 5, c4 = rem & 31; cwv = *(const f32x4*)(P.conv_qkv_w + j * 1536 + part * 512 + h * 128 + c4 * 4); }
        float a_in = 0.f, b_in = 0.f;
        if (tid < 64) { a_in = AB[(size_t)(t0 + tid) * 8 + h]; b_in = AB[(size_t)(t0 + tid) * 8 + 4 + h]; }
#pragma unroll
        for (int r = 0; r < 7; ++r) { const int id = tid + 512 * r; if (id < 67 * 48) *(LAS v4u*)(raw + id * 8) = pr[r]; }
        if (tid < 384) *(LAS f32x4*)(cw + tid * 4) = cwv;
        if (tid < 64) { sg[tid] = -__expf(P.gdn_a_log[h]) * softplusf_(a_in + P.gdn_dt_bias[h]); sbeta[tid] = sigmoidf_(b_in); }
    }
    GL_BAR();
    GL_REPF(1) {
        const int c = tid >> 3, grp = tid & 7;
#pragma unroll 1
        for (int part = 0; part < 3; ++part) {
            float y[16];
#pragma unroll
            for (int i = 0; i < 16; ++i) y[i] = 0.f;
#pragma unroll
            for (int j = 0; j < 4; ++j) {
                const LAS v4u* src = (const LAS v4u*)(raw + (c + j) * 384 + part * 128 + grp * 16);
                const v4u x0 = src[0], x1 = src[1];
                const LAS f32x4* wp = (const LAS f32x4*)(cw + (j * 3 + part) * 128 + grp * 16);
                const f32x4 w0 = wp[0], w1 = wp[1], w2 = wp[2], w3 = wp[3];
                y[0] += w0.x * bflo(x0.x); y[1] += w0.y * bfhi(x0.x); y[2] += w0.z * bflo(x0.y); y[3] += w0.w * bfhi(x0.y);
                y[4] += w1.x * bflo(x0.z); y[5] += w1.y * bfhi(x0.z); y[6] += w1.z * bflo(x0.w); y[7] += w1.w * bfhi(x0.w);
                y[8] += w2.x * bflo(x1.x); y[9] += w2.y * bfhi(x1.x); y[10] += w2.z * bflo(x1.y); y[11] += w2.w * bfhi(x1.y);
                y[12] += w3.x * bflo(x1.z); y[13] += w3.y * bfhi(x1.z); y[14] += w3.z * bflo(x1.w); y[15] += w3.w * bfhi(x1.w);
            }
            float ss = 0.f;
#pragma unroll
            for (int i = 0; i < 16; ++i) { y[i] = siluf_(y[i]); ss += y[i] * y[i]; }
            if (part < 2) {
                ss += __shfl_xor(ss, 1); ss += __shfl_xor(ss, 2); ss += __shfl_xor(ss, 4);
                const float sc = rsqrtf(ss + 1e-6f) * (part == 0 ? 0.08838834764831845f : 1.0f);
#pragma unroll
                for (int i = 0; i < 16; ++i) y[i] *= sc;
            }
            if (part >= 1) {
                LAS float* dst = (part == 1 ? ks : vs) + c * 132 + grp * 16;
#pragma unroll
                for (int i = 0; i < 4; ++i) *(LAS f32x4*)(dst + 4 * i) = (f32x4){y[4 * i], y[4 * i + 1], y[4 * i + 2], y[4 * i + 3]};
            }
            if (part <= 1) {
                LAS bf16* dst = (part == 0 ? qb16 : kb16) + c * 136 + grp * 16;
                v4u o0, o1; o0.x = pk2(y[0], y[1]); o0.y = pk2(y[2], y[3]); o0.z = pk2(y[4], y[5]); o0.w = pk2(y[6], y[7]);
                o1.x = pk2(y[8], y[9]); o1.y = pk2(y[10], y[11]); o1.z = pk2(y[12], y[13]); o1.w = pk2(y[14], y[15]);
                *(LAS v4u*)dst = o0; *(LAS v4u*)(dst + 8) = o1;
            }
        }
    }
    if (tid < 64) {
        float v = sg[tid];
#pragma unroll
        for (int off = 1; off < 64; off <<= 1) { const float t = __shfl_up(v, off); if (tid >= off) v += t; }
        sgc[tid] = v; seg[tid] = __expf(v);
        const float gl = __shfl(v, 63);
        sek[tid] = __expf(gl - v);
        if (tid == 63) sek[64] = __expf(v);
    }
    GL_BAR();
    {
        const int mat = wave >> 2, rho = wave & 3, col = lane & 15, g = lane >> 4;
        const LAS bf16* X = mat ? qb16 : kb16;
        bf16x8 af[4];
#pragma unroll
        for (int s = 0; s < 4; ++s) af[s] = *(const LAS bf16x8*)(X + (16 * rho + col) * 136 + 32 * s + 8 * g);
#pragma unroll
        for (int sig = 0; sig < 4; ++sig) {
            f32x4 acc = (f32x4){0.f, 0.f, 0.f, 0.f};
#pragma unroll
            for (int s = 0; s < 4; ++s) { const bf16x8 bfr = *(const LAS bf16x8*)(kb16 + (16 * sig + col) * 136 + 32 * s + 8 * g); acc = __builtin_amdgcn_mfma_f32_16x16x32_bf16(af[s], bfr, acc, 0, 0, 0); }
            const int sidx = 16 * sig + col; const float gs = sgc[sidx];
#pragma unroll
            for (int i = 0; i < 4; ++i) {
                const int c = 16 * rho + 4 * g + i;
                const float dec = (c >= sidx) ? __expf(sgc[c] - gs) : 0.f;
                if (mat == 0) AmT[sidx * 68 + c] = (c > sidx) ? sbeta[c] * acc[i] * dec : 0.f;
                else atts[c * 64 + sidx] = (bf16)f2bf(acc[i] * dec);
            }
        }
    }
    GL_BAR();
    GL_REPF(4) {
        bf16* QD = (bf16*)(ws + WS_QD) + (size_t)item * 8192;
        bf16* KD = (bf16*)(ws + WS_KD) + (size_t)item * 8192;
        bf16* ATT = (bf16*)(ws + WS_ATT) + (size_t)item * 4096;
#pragma unroll
        for (int r = 0; r < 2; ++r) {
            const int id = tid + 512 * r;
            { const int c = id >> 4, gam = id & 15, s32 = gam >> 2, g = gam & 3;
              const v2u lo = *(const LAS v2u*)(qb16 + c * 136 + 32 * s32 + 4 * g), hi = *(const LAS v2u*)(qb16 + c * 136 + 32 * s32 + 16 + 4 * g);
              const float e = seg[c];
              v4u o; o.x = pk2(bflo(lo.x) * e, bfhi(lo.x) * e); o.y = pk2(bflo(lo.y) * e, bfhi(lo.y) * e); o.z = pk2(bflo(hi.x) * e, bfhi(hi.x) * e); o.w = pk2(bflo(hi.y) * e, bfhi(hi.y) * e);
              st16_wt(QD + c * 128 + 8 * gam, o); }
            { const int dk = id >> 3, gam = id & 7, s32 = gam >> 2, g = gam & 3, c0 = 32 * s32 + 4 * g;
              float v[8];
#pragma unroll
              for (int j = 0; j < 4; ++j) { v[j] = ks[(c0 + j) * 132 + dk] * sek[c0 + j]; v[4 + j] = ks[(c0 + 16 + j) * 132 + dk] * sek[c0 + 16 + j]; }
              v4u o; o.x = pk2(v[0], v[1]); o.y = pk2(v[2], v[3]); o.z = pk2(v[4], v[5]); o.w = pk2(v[6], v[7]);
              st16_wt(KD + dk * 64 + 8 * gam, o); }
        }
        { const int c = tid >> 3, gam = tid & 7, s32 = gam >> 2, g = gam & 3;
          const v2u lo = *(const LAS v2u*)(atts + c * 64 + 32 * s32 + 4 * g), hi = *(const LAS v2u*)(atts + c * 64 + 32 * s32 + 16 + 4 * g);
          v4u o; o.x = lo.x; o.y = lo.y; o.z = hi.x; o.w = hi.y;
          st16_wt(ATT + c * 64 + 8 * gam, o); }
    }
    GL_BAR();
    GL_REPF(5) {
        LAS float* xcol = (LAS float*)(lds + GL_SOL);
        LAS bf16* tinv = (LAS bf16*)(lds + GL_SOL + 17408);
        const int j = tid >> 3, part = tid & 7, jb = j >> 4, jo = j & 15;
#pragma unroll 1
        for (int rb = jb; rb < 4; ++rb) {
            float acc[16];
#pragma unroll
            for (int i = 0; i < 16; ++i) acc[i] = 0.f;
            if (rb > jb) {
#pragma unroll 2
                for (int s = 16 * jb + part; s < 16 * rb; s += 8) {
                    const float sv = xcol[j * 68 + s];
                    const LAS float* ar = AmT + s * 68 + 16 * rb;
#pragma unroll
                    for (int q = 0; q < 4; ++q) { const f32x4 A4 = *(const LAS f32x4*)(ar + 4 * q);
                        acc[4 * q] -= A4.x * sv; acc[4 * q + 1] -= A4.y * sv; acc[4 * q + 2] -= A4.z * sv; acc[4 * q + 3] -= A4.w * sv; }
                }
#pragma unroll
                for (int i = 0; i < 16; ++i) {
                    acc[i] += __builtin_bit_cast(float, __builtin_amdgcn_update_dpp(0, __builtin_bit_cast(int, acc[i]), 0xB1, 0xF, 0xF, true));
                    acc[i] += __builtin_bit_cast(float, __builtin_amdgcn_update_dpp(0, __builtin_bit_cast(int, acc[i]), 0x4E, 0xF, 0xF, true));
                    acc[i] += __builtin_bit_cast(float, __builtin_amdgcn_update_dpp(0, __builtin_bit_cast(int, acc[i]), 0x141, 0xF, 0xF, true));
                }
            } else {
#pragma unroll
                for (int i = 0; i < 16; ++i) acc[i] = (i == jo) ? 1.f : 0.f;
            }
#pragma unroll
            for (int i = 0; i < 16; ++i) {
                const float sv = acc[i];
                const LAS float* ar = AmT + (16 * rb + i) * 68 + 16 * rb;
#pragma unroll
                for (int q = (i + 1) / 4; q < 4; ++q) { const f32x4 A4 = *(const LAS f32x4*)(ar + 4 * q);
                    if (4 * q > i) acc[4 * q] -= A4.x * sv; if (4 * q + 1 > i) acc[4 * q + 1] -= A4.y * sv; if (4 * q + 2 > i) acc[4 * q + 2] -= A4.z * sv; if (4 * q + 3 > i) acc[4 * q + 3] -= A4.w * sv; }
            }
            if (part == 0) {
#pragma unroll
                for (int i = 0; i < 16; ++i) { xcol[j * 68 + 16 * rb + i] = acc[i]; tinv[(16 * rb + i) * 72 + j] = (bf16)f2bf(acc[i]); }
            }
            LDS_WAIT(); asm volatile("" ::: "memory");
        }
        for (int rb = 0; rb < jb; ++rb) {
            if (part == 0) {
#pragma unroll
                for (int i = 0; i < 16; ++i) tinv[(16 * rb + i) * 72 + j] = (bf16)0;
            }
        }
    }
    GL_BAR();
    GL_REPF(6) {
        const LAS bf16* tinv = (const LAS bf16*)(lds + GL_SOL + 17408);
        LAS bf16* wst = (LAS bf16*)(lds + GL_SOL + 17408 + 9216);
        const int col = lane & 15, g = lane >> 4, isw = wave >> 2;
        bf16x8 af[4][2];
#pragma unroll
        for (int rho = 0; rho < 4; ++rho)
#pragma unroll
            for (int s2 = 0; s2 < 2; ++s2) af[rho][s2] = *(const LAS bf16x8*)(tinv + (16 * rho + col) * 72 + 32 * s2 + 8 * g);
        bf16* UF = (bf16*)(ws + WS_UF) + (size_t)item * 8192;
#pragma unroll
        for (int sig = 0; sig < 2; ++sig) {
            const int jj = 32 * (wave & 3) + 16 * sig + col;
            const LAS float* src = (isw ? ks : vs) + jj;
            bf16x8 bfr[2];
#pragma unroll
            for (int s2 = 0; s2 < 2; ++s2) {
                float v[8];
#pragma unroll
                for (int e = 0; e < 8; ++e) { const int sidx = 32 * s2 + 8 * g + e; float x = src[sidx * 132] * sbeta[sidx]; if (isw) x *= seg[sidx]; v[e] = x; }
                v4u pk; pk.x = pk2(v[0], v[1]); pk.y = pk2(v[2], v[3]); pk.z = pk2(v[4], v[5]); pk.w = pk2(v[6], v[7]);
                bfr[s2] = __builtin_bit_cast(bf16x8, pk);
            }
            f32x4 acc[4];
#pragma unroll
            for (int rho = 0; rho < 4; ++rho) { acc[rho] = (f32x4){0.f, 0.f, 0.f, 0.f};
#pragma unroll
                for (int s2 = 0; s2 < 2; ++s2) acc[rho] = __builtin_amdgcn_mfma_f32_16x16x32_bf16(af[rho][s2], bfr[s2], acc[rho], 0, 0, 0); }
            if (!isw) {
                v4u o0, o1;
                o0.x = pk2(acc[0].x, acc[0].y); o0.y = pk2(acc[0].z, acc[0].w); o0.z = pk2(acc[1].x, acc[1].y); o0.w = pk2(acc[1].z, acc[1].w);
                o1.x = pk2(acc[2].x, acc[2].y); o1.y = pk2(acc[2].z, acc[2].w); o1.z = pk2(acc[3].x, acc[3].y); o1.w = pk2(acc[3].z, acc[3].w);
                v4u* d = (v4u*)(UF + (size_t)(2 * (wave & 3) + sig) * 1024 + lane * 16);
                st16_wt(d, o0); st16_wt(d + 1, o1);
            } else {
#pragma unroll
                for (int rho = 0; rho < 4; ++rho)
#pragma unroll
                    for (int i = 0; i < 4; ++i) wst[(16 * rho + 4 * g + i) * 136 + jj] = (bf16)f2bf(-acc[rho][i]);
            }
        }
    }
    GL_BAR();
    {
        const LAS bf16* wst = (const LAS bf16*)(lds + GL_SOL + 17408 + 9216);
        bf16* WN = (bf16*)(ws + WS_WN) + (size_t)item * 8192;
#pragma unroll
        for (int r = 0; r < 2; ++r) {
            const int id = tid + 512 * r, c = id >> 4, gam = id & 15, s32 = gam >> 2, g = gam & 3;
            const v2u lo = *(const LAS v2u*)(wst + c * 136 + 32 * s32 + 4 * g), hi = *(const LAS v2u*)(wst + c * 136 + 32 * s32 + 16 + 4 * g);
            v4u o; o.x = lo.x; o.y = lo.y; o.z = hi.x; o.w = hi.y;
            st16_wt(WN + c * 128 + 8 * gam, o);
        }
    }
    asm volatile("s_waitcnt vmcnt(0)" ::: "memory");
    GL_BAR();
    if (tid == 0) { unsigned fb = __builtin_bit_cast(unsigned, sek[64]); if (fb == 0u) fb = 1u;
        __hip_atomic_store((unsigned*)(ws + WS_CTL) + CW_GFLAG + item, fb, __ATOMIC_RELAXED, __HIP_MEMORY_SCOPE_AGENT); }
    GL_BAR();
}

constexpr int LL_XCB = 68608;
static_assert(LL_XCB + 64 * 1040 <= MISC_OFF, "lru_local LDS map");
__device__ __forceinline__ float expm1_small(float x) {
    const float p = x * (1.0f + x * (0.5f + x * (0.16666667f + x * (0.041666668f + x * 0.008333334f))));
    return (x > -0.25f) ? p : (__expf(x) - 1.0f);
}
__device__ __forceinline__ void lru_local_item(const Params& P, LAS unsigned char* lds, int lt, int tid, int lane, int wave) {
    unsigned char* ws = P.ws;
    asm volatile("" : "+v"(tid));
    const int b = lt >> 7, n = lt & 127, t0 = b * SEQ + n * 64;
    LAS bf16* rawx = (LAS bf16*)lds;
    LAS bf16* xcb = (LAS bf16*)(lds + LL_XCB);
    const bf16* XR = (const bf16*)(ws + WS_XR);
    {
        v4u pr[9];
#pragma unroll
        for (int r = 0; r < 9; ++r) { const int id = tid + 512 * r, row = id >> 6, ck = id & 63, s = n * 64 + row - 3;
            pr[r] = (v4u){0u, 0u, 0u, 0u};
            if (id < 67 * 64 && s >= 0) pr[r] = *(const v4u*)(XR + (size_t)(b * SEQ + s) * 512 + ck * 8); }
#pragma unroll
        for (int r = 0; r < 9; ++r) { const int id = tid + 512 * r; if (id < 67 * 64) *(LAS v4u*)(rawx + id * 8) = pr[r]; }
    }
    GL_BAR();
    {
        const int chg = tid & 63, tseg = tid >> 6, ch0 = chg * 8;
        float w[4][8], cb[8];
#pragma unroll
        for (int j = 0; j < 4; ++j) { const f32x4 a = *(const f32x4*)(P.lru_conv_w + j * 512 + ch0), c = *(const f32x4*)(P.lru_conv_w + j * 512 + ch0 + 4);
            w[j][0] = a.x; w[j][1] = a.y; w[j][2] = a.z; w[j][3] = a.w; w[j][4] = c.x; w[j][5] = c.y; w[j][6] = c.z; w[j][7] = c.w; }
        { const f32x4 a = *(const f32x4*)(P.lru_conv_b + ch0), c = *(const f32x4*)(P.lru_conv_b + ch0 + 4);
          cb[0] = a.x; cb[1] = a.y; cb[2] = a.z; cb[3] = a.w; cb[4] = c.x; cb[5] = c.y; cb[6] = c.z; cb[7] = c.w; }
        v4u xr[11];
#pragma unroll
        for (int r = 0; r < 11; ++r) xr[r] = *(const LAS v4u*)(rawx + (tseg * 8 + r) * 512 + ch0);
#pragma unroll
        for (int tk = 0; tk < 8; ++tk) {
            float y[8];
#pragma unroll
            for (int e = 0; e < 8; ++e) y[e] = cb[e];
#pragma unroll
            for (int j = 0; j < 4; ++j) { const v4u x = xr[tk + j];
                y[0] += w[j][0] * bflo(x.x); y[1] += w[j][1] * bfhi(x.x); y[2] += w[j][2] * bflo(x.y); y[3] += w[j][3] * bfhi(x.y);
                y[4] += w[j][4] * bflo(x.z); y[5] += w[j][5] * bfhi(x.z); y[6] += w[j][6] * bflo(x.w); y[7] += w[j][7] * bfhi(x.w); }
            v4u o; o.x = pk2(y[0], y[1]); o.y = pk2(y[2], y[3]); o.z = pk2(y[4], y[5]); o.w = pk2(y[6], y[7]);
            *(LAS v4u*)(xcb + (tseg * 8 + tk) * 520 + ch0) = o;
        }
    }
    GL_BAR();
    {
        const int g = wave, col = lane & 15, g4 = lane >> 4;
        LAS bf16* AM = (LAS bf16*)(lds + wave * 8192); LAS bf16* BT = AM + 2048;
        const bf16* WT = (const bf16*)(ws + WS_LRUWT) + (size_t)g * 8192;
        bf16x8 Bw[2][4][2];
#pragma unroll
        for (int m = 0; m < 2; ++m)
#pragma unroll
            for (int jt = 0; jt < 4; ++jt)
#pragma unroll
                for (int s2 = 0; s2 < 2; ++s2) Bw[m][jt][s2] = *(const bf16x8*)(WT + m * 4096 + (16 * jt + col) * 64 + 32 * s2 + 8 * g4);
        float cba[4], cbx[4], csp[4];
#pragma unroll
        for (int jt = 0; jt < 4; ++jt) { const int ch = g * 64 + 16 * jt + col; cba[jt] = P.lru_ba[ch]; cbx[jt] = P.lru_bx[ch]; csp[jt] = softplusf_(-P.lru_lambda[ch]); }
        bf16* HLOC = (bf16*)(ws + WS_HLOC); bf16* PCUM = (bf16*)(ws + WS_PCUM);
        const int chs = g * 64 + lane;
        float hst = 0.f, pc = 1.f;
#pragma unroll 1
        for (int half = 0; half < 2; ++half) {
            bf16x8 Af[2][2];
#pragma unroll
            for (int rho = 0; rho < 2; ++rho)
#pragma unroll
                for (int s2 = 0; s2 < 2; ++s2) Af[rho][s2] = *(const LAS bf16x8*)(xcb + (32 * half + 16 * rho + col) * 520 + g * 64 + 32 * s2 + 8 * g4);
#pragma unroll
            for (int jt = 0; jt < 4; ++jt) {
#pragma unroll
                for (int rho = 0; rho < 2; ++rho) {
                    f32x4 ra = (f32x4){0.f, 0.f, 0.f, 0.f}, rx = ra;
#pragma unroll
                    for (int s2 = 0; s2 < 2; ++s2) { ra = __builtin_amdgcn_mfma_f32_16x16x32_bf16(Af[rho][s2], Bw[0][jt][s2], ra, 0, 0, 0); rx = __builtin_amdgcn_mfma_f32_16x16x32_bf16(Af[rho][s2], Bw[1][jt][s2], rx, 0, 0, 0); }
#pragma unroll
                    for (int i = 0; i < 4; ++i) {
                        const int tokl = 16 * rho + 4 * g4 + i, chl = 16 * jt + col;
                        const float r = sigmoidf_(ra[i] + cba[jt]), ig = sigmoidf_(rx[i] + cbx[jt]);
                        const float log_a = -8.0f * r * csp[jt];
                        const float am = -expm1_small(log_a), a = 1.0f - am;
                        const float xo = bf1(xcb[(32 * half + tokl) * 520 + g * 64 + chl]);
                        const float bt = __builtin_amdgcn_sqrtf(fmaxf(am * (1.0f + a), 0.f)) * (ig * xo);
                        AM[tokl * 64 + chl] = (bf16)f2bf(am); BT[tokl * 64 + chl] = (bf16)f2bf(bt);
                    }
                }
            }
            LDS_WAIT(); asm volatile("" ::: "memory");
#pragma unroll 8
            for (int tk = 0; tk < 32; ++tk) {
                const float am = bf1(AM[tk * 64 + lane]), bt = bf1(BT[tk * 64 + lane]);
                hst = (hst - am * hst) + bt; pc = pc - am * pc;
                const size_t o = (size_t)(t0 + 32 * half + tk) * 512 + chs;
                HLOC[o] = (bf16)f2bf(hst); PCUM[o] = (bf16)f2bf(pc);
            }
            LDS_WAIT(); asm volatile("" ::: "memory");
        }
        ((float*)(ws + WS_HEND))[(size_t)lt * 512 + chs] = hst; ((float*)(ws + WS_PEND))[(size_t)lt * 512 + chs] = pc;
    }
    GL_BAR();
}

constexpr int SC_WN = 0, SC_QD = 64 * 272, SC_KD = 2 * 64 * 272, SC_ATT = 2 * 64 * 272 + 128 * 144, SC_BUF = 2 * 64 * 272 + 128 * 144 + 64 * 144;
constexpr int SC_SSQ = 2 * SC_BUF;
__device__ __forceinline__ int sc_lds_off(int id) {
    if (id < 1024) return SC_WN + (id >> 4) * 272 + (id & 15) * 16;
    if (id < 2048) { const int q = id - 1024; return SC_QD + (q >> 4) * 272 + (q & 15) * 16; }
    if (id < 3072) { const int q = id - 2048; return SC_KD + (q >> 3) * 144 + (q & 7) * 16; }
    const int q = id - 3072; return SC_ATT + (q >> 3) * 144 + (q & 7) * 16;
}
__device__ __forceinline__ const v4u* sc_src(const unsigned char* ws, int item, int id) {
    if (id < 1024) return (const v4u*)(ws + WS_WN + (size_t)item * 16384) + id;
    if (id < 2048) return (const v4u*)(ws + WS_QD + (size_t)item * 16384) + (id - 1024);
    if (id < 3072) return (const v4u*)(ws + WS_KD + (size_t)item * 16384) + (id - 2048);
    return (const v4u*)(ws + WS_ATT + (size_t)item * 8192) + (id - 3072);
}
__device__ __forceinline__ bf16x8 pack_b(const f32x4 a, const f32x4 b) {
    v4u r; r.x = pk2(a.x, a.y); r.y = pk2(a.z, a.w); r.z = pk2(b.x, b.y); r.w = pk2(b.z, b.w);
    return __builtin_bit_cast(bf16x8, r);
}
#define SC_BAR() do { asm volatile("s_waitcnt lgkmcnt(0)" ::: "memory"); __builtin_amdgcn_s_barrier(); asm volatile("" ::: "memory"); } while (0)
#define SC_GLD(dst, ptr) asm volatile("global_load_dwordx4 %0, %1, off" : "=v"(dst) : "v"(ptr) : "memory")
#define PIN8(a) asm volatile("" : "+v"(a[0]), "+v"(a[1]), "+v"(a[2]), "+v"(a[3]), "+v"(a[4]), "+v"(a[5]), "+v"(a[6]), "+v"(a[7]))
#define PIN16(a) asm volatile("" : "+v"(a[0]), "+v"(a[1]), "+v"(a[2]), "+v"(a[3]), "+v"(a[4]), "+v"(a[5]), "+v"(a[6]), "+v"(a[7]), "+v"(a[8]), "+v"(a[9]), "+v"(a[10]), "+v"(a[11]), "+v"(a[12]), "+v"(a[13]), "+v"(a[14]), "+v"(a[15]))
constexpr int SCAN_NWC = 2, SCAN_PARTS = 4, SCAN_WGS = 8 * SCAN_PARTS;
constexpr int SC_UFS = 2 * SC_BUF;
constexpr int SC_DECS = SC_UFS + 2 * SCAN_NWC * 2048;
constexpr int SC_OT = SC_DECS + 512;
constexpr int SC_RDY = SC_OT + 2 * 64 * 36 * 4;
constexpr int SC_END = SC_RDY + 64;
static_assert(SC_END <= MISC_OFF, "scan LDS");
#ifndef SCAN_REPS
#define SCAN_REPS 1
#endif
#ifndef SCAN_EXP
#define SCAN_EXP 0
#endif
__device__ __forceinline__ int sc3_lds_off(int id) {
    if (id < 3584) return sc_lds_off(id);
    return SC_UFS + (id - 3584) * 16;
}
__device__ __forceinline__ const v4u* sc3_src(const unsigned char* ws, int item, int id, int part) {
    if (id < 3584) return sc_src(ws, item, id);
    return (const v4u*)(ws + WS_UF + (size_t)item * 16384 + (size_t)(part * SCAN_NWC) * 2048) + (id - 3584);
}
__device__ __forceinline__ void gdn_scan(const Params& P, LAS unsigned char* lds, int sb, int tid, int lane, int wave) {
    const unsigned char* ws = P.ws;
    constexpr int NCH = 128 * SCAN_REPS, NPC = 15;
    const int bh = sb & 7, part = sb >> 3;
    const int b = bh >> 2, h = bh & 3, col = lane & 15, g = lane >> 4;
    const int item0 = bh * 128;
    if (tid == 0) *(volatile LAS unsigned*)(lds + SC_RDY) = 0u;
    SC_BAR();
    if (wave >= 4) {
        constexpr int NP = 15, DEP = 3;
        const int lt = tid - 256;
        const unsigned voff = (unsigned)lt * 16u;
        const int lA = (lt >> 4) * 272 + (lt & 15) * 16, lB = (lt >> 3) * 144 + (lt & 7) * 16, lU = SC_UFS + lt * 16;
        v4u rs[DEP][NP];
#define SC_ISSUE(set, itm) do { const unsigned char* gq_ = ws + (size_t)(itm) * 16384; const unsigned char* ga_ = ws + WS_ATT + (size_t)(itm) * 8192; \
            asm volatile("s_nop 4\n\tglobal_load_dwordx4 %0, %8, %9 sc0 sc1\n\tglobal_load_dwordx4 %1, %8, %10 sc0 sc1\n\tglobal_load_dwordx4 %2, %8, %11 sc0 sc1\n\tglobal_load_dwordx4 %3, %8, %12 sc0 sc1\n\t" \
                         "global_load_dwordx4 %4, %8, %13 sc0 sc1\n\tglobal_load_dwordx4 %5, %8, %14 sc0 sc1\n\tglobal_load_dwordx4 %6, %8, %15 sc0 sc1\n\tglobal_load_dwordx4 %7, %8, %16 sc0 sc1" \
                : "=&v"(rs[set][0]), "=&v"(rs[set][1]), "=&v"(rs[set][2]), "=&v"(rs[set][3]), "=&v"(rs[set][4]), "=&v"(rs[set][5]), "=&v"(rs[set][6]), "=&v"(rs[set][7]) \
                : "v"(voff), "s"(gq_ + WS_WN), "s"(gq_ + WS_WN + 4096), "s"(gq_ + WS_WN + 8192), "s"(gq_ + WS_WN + 12288), \
                  "s"(gq_ + WS_QD), "s"(gq_ + WS_QD + 4096), "s"(gq_ + WS_QD + 8192), "s"(gq_ + WS_QD + 12288) : "memory"); \
            asm volatile("s_nop 4\n\tglobal_load_dwordx4 %0, %7, %8 sc0 sc1\n\tglobal_load_dwordx4 %1, %7, %9 sc0 sc1\n\tglobal_load_dwordx4 %2, %7, %10 sc0 sc1\n\tglobal_load_dwordx4 %3, %7, %11 sc0 sc1\n\t" \
                         "global_load_dwordx4 %4, %7, %12 sc0 sc1\n\tglobal_load_dwordx4 %5, %7, %13 sc0 sc1\n\tglobal_load_dwordx4 %6, %7, %14 sc0 sc1" \
                : "=&v"(rs[set][8]), "=&v"(rs[set][9]), "=&v"(rs[set][10]), "=&v"(rs[set][11]), "=&v"(rs[set][12]), "=&v"(rs[set][13]), "=&v"(rs[set][14]) \
                : "v"(voff), "s"(gq_ + WS_KD), "s"(gq_ + WS_KD + 4096), "s"(gq_ + WS_KD + 8192), "s"(gq_ + WS_KD + 12288), \
                  "s"(ga_), "s"(ga_ + 4096), "s"(gq_ + WS_UF + (size_t)(part * SCAN_NWC) * 2048) : "memory"); } while (0)
#define SC_WAITSET(set, cnt) asm volatile("s_waitcnt " cnt : "+v"(rs[set][0]), "+v"(rs[set][1]), "+v"(rs[set][2]), "+v"(rs[set][3]), "+v"(rs[set][4]), "+v"(rs[set][5]), "+v"(rs[set][6]), "+v"(rs[set][7]), \
            "+v"(rs[set][8]), "+v"(rs[set][9]), "+v"(rs[set][10]), "+v"(rs[set][11]), "+v"(rs[set][12]), "+v"(rs[set][13]), "+v"(rs[set][14]) :: "memory")
#define SC_WRITE(set, par) do { LAS unsigned char* wb_ = lds + (par) * SC_BUF; \
            _Pragma("unroll") for (int r = 0; r < 4; ++r) { *(LAS v4u*)(wb_ + SC_WN + lA + r * (16 * 272)) = rs[set][r]; *(LAS v4u*)(wb_ + SC_QD + lA + r * (16 * 272)) = rs[set][4 + r]; \
                                                          *(LAS v4u*)(wb_ + SC_KD + lB + r * (32 * 144)) = rs[set][8 + r]; } \
            *(LAS v4u*)(wb_ + SC_ATT + lB) = rs[set][12]; *(LAS v4u*)(wb_ + SC_ATT + lB + 32 * 144) = rs[set][13]; \
            *(LAS v4u*)(lds + lU + (par) * (SCAN_NWC * 2048)) = rs[set][14]; } while (0)
#define SC_NEED(c) do { unsigned sp_ = 0; while (*(volatile LAS unsigned*)(lds + SC_RDY) <= (unsigned)(c) && ++sp_ < (1u << 24)) __builtin_amdgcn_s_sleep(2); } while (0)
        SC_NEED(0); SC_ISSUE(0, item0);
        SC_WAITSET(0, "vmcnt(0)"); SC_WRITE(0, 0); SC_WAITSET(0, "lgkmcnt(0)");
        SC_NEED(3); SC_ISSUE(1, item0 + 1); SC_ISSUE(2, item0 + 2); SC_ISSUE(0, item0 + 3);
        SC_BAR();
        int n2 = 0;
#define SC_INTERVAL(set) do { SC_WAITSET(set, "vmcnt(30)"); SC_WRITE(set, (n2 + 1) & 1); SC_WAITSET(set, "lgkmcnt(0)"); if (n2 + 1 + DEP < 128) SC_NEED(n2 + 1 + DEP); SC_ISSUE(set, item0 + ((n2 + 1 + DEP) & 127)); SC_BAR(); ++n2; } while (0)
#pragma unroll 1
        for (int it = 0; it < NCH / 3; ++it) { SC_INTERVAL(1); SC_INTERVAL(2); SC_INTERVAL(0); }
        if (NCH % 3 >= 1) SC_INTERVAL(1);
        if (NCH % 3 >= 2) SC_INTERVAL(2);
        SC_WAITSET(0, "vmcnt(0)"); SC_WAITSET(1, "vmcnt(0)"); SC_WAITSET(2, "vmcnt(0)");
#undef SC_INTERVAL
#undef SC_NEED
#undef SC_WRITE
#undef SC_WAITSET
#undef SC_ISSUE
        return;
    }
    if (wave == 3) {
        const unsigned* flags = (const unsigned*)(ws + WS_CTL) + CW_GFLAG + item0;
        unsigned rdy = 0;
#define SC_POLLSTEP() do { if (rdy < 128u) { const unsigned idx_ = rdy + (unsigned)lane; \
            const unsigned fv_ = (idx_ < 128u) ? __hip_atomic_load(flags + idx_, __ATOMIC_RELAXED, __HIP_MEMORY_SCOPE_AGENT) : 0u; \
            const unsigned long long m_ = __ballot(fv_ != 0u); const unsigned nrun_ = (m_ == ~0ull) ? 64u : (unsigned)__builtin_ctzll(~m_);     \
            if ((unsigned)lane < nrun_) ((LAS float*)(lds + SC_DECS))[idx_] = __builtin_bit_cast(float, fv_); \
            rdy += nrun_; LDS_WAIT(); if (lane == 0) *(volatile LAS unsigned*)(lds + SC_RDY) = rdy; } } while (0)
        { unsigned sp = 0; while (rdy < 4u && ++sp < (1u << 22)) { SC_POLLSTEP(); if (rdy < 4u) __builtin_amdgcn_s_sleep(16); } }
        SC_BAR();
#pragma unroll 1
        for (int n2 = 0; n2 < NCH; ++n2) {
            { const unsigned need = (unsigned)(n2 + 1 + 3) < 128u ? (unsigned)(n2 + 1 + 3) : 127u; unsigned sp = 0;
              while (rdy <= need && rdy < 128u && ++sp < (1u << 22)) { SC_POLLSTEP(); if (rdy <= need) __builtin_amdgcn_s_sleep(8); } }
            if (rdy < 128u && rdy < (unsigned)(n2 & 127) + 16u) SC_POLLSTEP();
            SC_BAR();
        }
#undef SC_POLLSTEP
        return;
    }
    if (wave == 2) {
        const int row = lane;
        bf16* Y = (bf16*)((unsigned char*)P.out + OUT_Y);
        float* SSQG = P.out;
        SC_BAR();
#pragma unroll 1
        for (int n2 = 0; n2 <= NCH; ++n2) {
            if (n2 > 0) {
                const int n = (n2 - 1) & 127, t = b * SEQ + n * 64 + row;
                const LAS float* src = (const LAS float*)(lds + SC_OT + ((n2 - 1) & 1) * (64 * 36 * 4)) + row * 36;
                f32x4 a[8]; float s2 = 0.f;
#pragma unroll
                for (int q = 0; q < 8; ++q) { a[q] = *(const LAS f32x4*)(src + 4 * q); s2 += (a[q].x * a[q].x + a[q].y * a[q].y) + (a[q].z * a[q].z + a[q].w * a[q].w); }
                SSQG[(size_t)t * 32 + h * 8 + part] = s2;
                v4u* d = (v4u*)(Y + (size_t)t * 1024 + h * 128 + 32 * part);
#pragma unroll
                for (int q = 0; q < 4; ++q) { v4u o; o.x = pk2(a[2 * q].x, a[2 * q].y); o.y = pk2(a[2 * q].z, a[2 * q].w); o.z = pk2(a[2 * q + 1].x, a[2 * q + 1].y); o.w = pk2(a[2 * q + 1].z, a[2 * q + 1].w); d[q] = o; }
            }
            if (n2 < NCH) SC_BAR();
        }
        return;
    }
    f32x4 S[8];
#pragma unroll
    for (int i = 0; i < 8; ++i) S[i] = (f32x4){0.f, 0.f, 0.f, 0.f};
    SC_BAR();
#pragma unroll 1
    for (int n2 = 0; n2 < NCH; ++n2) {
        if (SCAN_REPS > 1 && (n2 & 127) == 0) {
#pragma unroll
            for (int i = 0; i < 8; ++i) S[i] = (f32x4){0.f, 0.f, 0.f, 0.f};
        }
        if (SCAN_EXP == 2 && n2 < 128) { SC_BAR(); continue; }
        const int par = n2 & 1;
        LAS unsigned char* buf = lds + par * SC_BUF;
        bf16x8 fA[16], fB[16], fC[16], fD[8];
#pragma unroll
        for (int rho = 0; rho < 4; ++rho)
#pragma unroll
            for (int s = 0; s < 4; ++s) fA[rho * 4 + s] = *(const LAS bf16x8*)(buf + SC_WN + (16 * rho + col) * 272 + (32 * s + 8 * g) * 2);
#pragma unroll
        for (int rho = 0; rho < 4; ++rho)
#pragma unroll
            for (int s = 0; s < 4; ++s) fB[rho * 4 + s] = *(const LAS bf16x8*)(buf + SC_QD + (16 * rho + col) * 272 + (32 * s + 8 * g) * 2);
        const LAS v4u* ufp = (const LAS v4u*)(lds + SC_UFS + par * (SCAN_NWC * 2048) + wave * 2048 + lane * 32);
        const v4u uf0 = ufp[0], uf1 = ufp[1];
        const float dec = ((const LAS float*)(lds + SC_DECS))[n2 & 127];
        bf16x8 Bs[4];
#pragma unroll
        for (int s = 0; s < 4; ++s) Bs[s] = pack_b(S[2 * s], S[2 * s + 1]);
        f32x4 Vn[4], Oc[4];
        Vn[0] = (f32x4){bflo(uf0.x), bfhi(uf0.x), bflo(uf0.y), bfhi(uf0.y)}; Vn[1] = (f32x4){bflo(uf0.z), bfhi(uf0.z), bflo(uf0.w), bfhi(uf0.w)};
        Vn[2] = (f32x4){bflo(uf1.x), bfhi(uf1.x), bflo(uf1.y), bfhi(uf1.y)}; Vn[3] = (f32x4){bflo(uf1.z), bfhi(uf1.z), bflo(uf1.w), bfhi(uf1.w)};
        __builtin_amdgcn_sched_barrier(0);
        PIN16(fA);
#pragma unroll
        for (int s = 0; s < 4; ++s)
#pragma unroll
            for (int rho = 0; rho < 4; ++rho) Vn[rho] = __builtin_amdgcn_mfma_f32_16x16x32_bf16(fA[rho * 4 + s], Bs[s], Vn[rho], 0, 0, 0);
        __builtin_amdgcn_sched_barrier(0);
#pragma unroll
        for (int tau = 0; tau < 8; ++tau)
#pragma unroll
            for (int s = 0; s < 2; ++s) fC[tau * 2 + s] = *(const LAS bf16x8*)(buf + SC_KD + (16 * tau + col) * 144 + (32 * s + 8 * g) * 2);
        __builtin_amdgcn_sched_barrier(0);
        PIN16(fB);
#pragma unroll
        for (int rho = 0; rho < 4; ++rho) Oc[rho] = (f32x4){0.f, 0.f, 0.f, 0.f};
#pragma unroll
        for (int s = 0; s < 4; ++s)
#pragma unroll
            for (int rho = 0; rho < 4; ++rho) Oc[rho] = __builtin_amdgcn_mfma_f32_16x16x32_bf16(fB[rho * 4 + s], Bs[s], Oc[rho], 0, 0, 0);
        __builtin_amdgcn_sched_barrier(0);
#pragma unroll
        for (int rho = 0; rho < 4; ++rho)
#pragma unroll
            for (int s = 0; s < 2; ++s) fD[rho * 2 + s] = *(const LAS bf16x8*)(buf + SC_ATT + (16 * rho + col) * 144 + (32 * s + 8 * g) * 2);
        bf16x8 Bv[2];
        Bv[0] = pack_b(Vn[0], Vn[1]); Bv[1] = pack_b(Vn[2], Vn[3]);
#pragma unroll
        for (int tau = 0; tau < 8; ++tau) S[tau] = S[tau] * dec;
        __builtin_amdgcn_sched_barrier(0);
        PIN16(fC);
#pragma unroll
        for (int s = 0; s < 2; ++s)
#pragma unroll
            for (int tau = 0; tau < 8; ++tau) S[tau] = __builtin_amdgcn_mfma_f32_16x16x32_bf16(fC[tau * 2 + s], Bv[s], S[tau], 0, 0, 0);
        __builtin_amdgcn_sched_barrier(0);
        PIN8(fD);
#pragma unroll
        for (int s = 0; s < 2; ++s)
#pragma unroll
            for (int rho = 0; rho < 4; ++rho) Oc[rho] = __builtin_amdgcn_mfma_f32_16x16x32_bf16(fD[rho * 2 + s], Bv[s], Oc[rho], 0, 0, 0);
        LAS float* ot = (LAS float*)(lds + SC_OT + par * (64 * 36 * 4)) + 16 * wave + col;
#pragma unroll
        for (int rho = 0; rho < 4; ++rho)
#pragma unroll
            for (int i = 0; i < 4; ++i) ot[(16 * rho + 4 * g + i) * 36] = Oc[rho][i];
        SC_BAR();
    }
}

__device__ __forceinline__ void lru_carry(const Params& P, int gwv, int lane) {
    unsigned char* ws = P.ws;
    const int b = gwv >> 3, g = gwv & 7, ch = g * 64 + lane;
    const float* HEND = (const float*)(ws + WS_HEND); const float* PEND = (const float*)(ws + WS_PEND); float* HIN = (float*)(ws + WS_HIN);
    float hin = 0.f;
#pragma unroll 1
    for (int n0 = 0; n0 < 128; n0 += 16) {
        float he[16], pe[16];
#pragma unroll
        for (int i = 0; i < 16; ++i) { const size_t o = (size_t)(b * 128 + n0 + i) * 512 + ch; he[i] = HEND[o]; pe[i] = PEND[o]; }
#pragma unroll
        for (int i = 0; i < 16; ++i) { HIN[(size_t)(b * 128 + n0 + i) * 512 + ch] = hin; hin = he[i] + pe[i] * hin; }
    }
}

__device__ __forceinline__ void cvt_table(const float* src, bf16* dst, size_t n8, size_t wi, size_t nw) {
    for (size_t i = wi; i < n8; i += nw) {
        const f32x4 a = ((const f32x4*)src)[2 * i], c = ((const f32x4*)src)[2 * i + 1];
        v4u o; o.x = pk2(a.x, a.y); o.y = pk2(a.z, a.w); o.z = pk2(c.x, c.y); o.w = pk2(c.z, c.w);
        ((v4u*)dst)[i] = o;
    }
}

__device__ __forceinline__ void lru_combine(const Params& P, size_t wi, size_t nw) {
    unsigned char* ws = P.ws;
    const v4u* HLOC = (const v4u*)(ws + WS_HLOC); const v4u* PCUM = (const v4u*)(ws + WS_PCUM); const v4u* GATE = (const v4u*)(ws + WS_GATE);
    const float* HIN = (const float*)(ws + WS_HIN); bf16* Y = (bf16*)((unsigned char*)P.out + OUT_Y);
    for (size_t i = wi; i < (size_t)T * 64; i += nw) {
        const size_t t = i >> 6; const int ch0 = (int)(i & 63) * 8;
        const v4u hl = HLOC[i], pc = PCUM[i], gt = GATE[i];
        const f32x4 h0 = *(const f32x4*)(HIN + (t >> 6) * 512 + ch0), h1 = *(const f32x4*)(HIN + (t >> 6) * 512 + ch0 + 4);
        float y[8];
        y[0] = (bflo(hl.x) + bflo(pc.x) * h0.x) * gelu_tanh(bflo(gt.x)); y[1] = (bfhi(hl.x) + bfhi(pc.x) * h0.y) * gelu_tanh(bfhi(gt.x));
        y[2] = (bflo(hl.y) + bflo(pc.y) * h0.z) * gelu_tanh(bflo(gt.y)); y[3] = (bfhi(hl.y) + bfhi(pc.y) * h0.w) * gelu_tanh(bfhi(gt.y));
        y[4] = (bflo(hl.z) + bflo(pc.z) * h1.x) * gelu_tanh(bflo(gt.z)); y[5] = (bfhi(hl.z) + bfhi(pc.z) * h1.y) * gelu_tanh(bfhi(gt.z));
        y[6] = (bflo(hl.w) + bflo(pc.w) * h1.z) * gelu_tanh(bflo(gt.w)); y[7] = (bfhi(hl.w) + bfhi(pc.w) * h1.w) * gelu_tanh(bfhi(gt.w));
        v4u o; o.x = pk2(y[0], y[1]); o.y = pk2(y[2], y[3]); o.z = pk2(y[4], y[5]); o.w = pk2(y[6], y[7]);
        *(v4u*)(Y + t * 1024 + 512 + ch0) = o;
    }
}

__device__ __forceinline__ void gdn_gate_norm(const Params& P, size_t wi, size_t nw) {
    unsigned char* ws = P.ws;
    bf16* Y = (bf16*)((unsigned char*)P.out + OUT_Y); const v4u* Z = (const v4u*)(ws + WS_Z); const float* SSQG = P.out;
    for (size_t i = wi; i < (size_t)T * 64; i += nw) {
        const size_t t = i >> 6; const int c0 = (int)(i & 63) * 8, h = c0 >> 7;
        const f32x4 q0 = *(const f32x4*)(SSQG + t * 32 + h * 8);
        const float rstd = rsqrtf(((q0.x + q0.y) + (q0.z + q0.w)) * (1.0f / 128.0f) + 1e-6f);
        const v4u o = *(const v4u*)(Y + t * 1024 + c0), z = Z[i];
        const f32x4 w0 = *(const f32x4*)(P.gdn_norm_w + (c0 & 127)), w1 = *(const f32x4*)(P.gdn_norm_w + (c0 & 127) + 4);
        float y[8];
        y[0] = bflo(o.x) * rstd * w0.x * siluf_(bflo(z.x)); y[1] = bfhi(o.x) * rstd * w0.y * siluf_(bfhi(z.x));
        y[2] = bflo(o.y) * rstd * w0.z * siluf_(bflo(z.y)); y[3] = bfhi(o.y) * rstd * w0.w * siluf_(bfhi(z.y));
        y[4] = bflo(o.z) * rstd * w1.x * siluf_(bflo(z.z)); y[5] = bfhi(o.z) * rstd * w1.y * siluf_(bfhi(z.z));
        y[6] = bflo(o.w) * rstd * w1.z * siluf_(bflo(z.w)); y[7] = bfhi(o.w) * rstd * w1.w * siluf_(bfhi(z.w));
        v4u r; r.x = pk2(y[0], y[1]); r.y = pk2(y[2], y[3]); r.z = pk2(y[4], y[5]); r.w = pk2(y[6], y[7]);
        *(v4u*)(Y + t * 1024 + c0) = r;
    }
}

__device__ __forceinline__ void xattn_stage(LAS unsigned char* lds, const bf16* src, int tid) {
    v4u tmp[16];
    const unsigned voff = (unsigned)tid * 16u;
#pragma unroll
    for (int r = 0; r < 16; ++r) { const unsigned char* sb = (const unsigned char*)src + r * 8192;
        asm volatile("s_nop 4\n\tglobal_load_dwordx4 %0, %1, %2" : "=&v"(tmp[r]) : "v"(voff), "s"(sb) : "memory"); }
    asm volatile("s_waitcnt vmcnt(0)" : "+v"(tmp[0]), "+v"(tmp[1]), "+v"(tmp[2]), "+v"(tmp[3]), "+v"(tmp[4]), "+v"(tmp[5]), "+v"(tmp[6]), "+v"(tmp[7]),
                                        "+v"(tmp[8]), "+v"(tmp[9]), "+v"(tmp[10]), "+v"(tmp[11]), "+v"(tmp[12]), "+v"(tmp[13]), "+v"(tmp[14]), "+v"(tmp[15]) :: "memory");
#pragma unroll
    for (int r = 0; r < 16; ++r) { const int id = tid + 512 * r; *(LAS v4u*)(lds + (id >> 5) * 528 + (id & 31) * 16) = tmp[r]; }
}
__device__ __forceinline__ void xattn_unit(const Params& P, LAS unsigned char* lds, int unit, int tid, int lane, int wave) {
    const unsigned char* ws = P.ws;
    const int h = unit & 3, qb = (unit >> 2) & 63, b = unit >> 8, col = lane & 15, g = lane >> 4;
    const int tw = b * SEQ + qb * 128 + 16 * wave;
    const bf16* Kb = (const bf16*)(ws + WS_KB) + (size_t)((b * 4 + h) * 256) * 256;
    const bf16* Vt = (const bf16*)(ws + WS_VTP) + (size_t)((b * 4 + h) * 256) * 256;
    xattn_stage(lds, Kb, tid);
    __syncthreads();
    const LAS unsigned char* arow = lds + col * 528 + g * 16;
    bf16x8 Bp[1][8]; float inv[1];
#pragma unroll
    for (int ps = 0; ps < 1; ++ps) {
        const bf16* Q = (const bf16*)(ws + WS_Q) + (size_t)(tw + 16 * ps + col) * 1024 + h * 256 + 8 * g;
        bf16x8 Bq[8];
#pragma unroll
        for (int s = 0; s < 8; ++s) Bq[s] = *(const bf16x8*)(Q + 32 * s);
        f32x4 St[16];
        bf16x8 fr[2][8];
#pragma unroll
        for (int s = 0; s < 8; ++s) fr[0][s] = *(const LAS bf16x8*)(arow + 64 * s);
#pragma unroll
        for (int kap = 0; kap < 16; ++kap) {
            if (kap + 1 < 16) {
#pragma unroll
                for (int s = 0; s < 8; ++s) fr[(kap + 1) & 1][s] = *(const LAS bf16x8*)(arow + (16 * (kap + 1)) * 528 + 64 * s);
            }
            __builtin_amdgcn_sched_barrier(0);
            PIN8(fr[kap & 1]);
            f32x4 acc = (f32x4){0.f, 0.f, 0.f, 0.f};
#pragma unroll
            for (int s = 0; s < 8; ++s) acc = __builtin_amdgcn_mfma_f32_16x16x32_bf16(fr[kap & 1][s], Bq[s], acc, 0, 0, 0);
            St[kap] = acc;
            __builtin_amdgcn_sched_barrier(0);
        }
        float mx = -3.0e38f;
#pragma unroll
        for (int kap = 0; kap < 16; ++kap) mx = fmaxf(fmaxf(fmaxf(St[kap].x, St[kap].y), fmaxf(St[kap].z, St[kap].w)), mx);
        mx = fmaxf(mx, __shfl_xor(mx, 16)); mx = fmaxf(mx, __shfl_xor(mx, 32));
        float l = 0.f;
#pragma unroll
        for (int kap = 0; kap < 16; ++kap) { St[kap].x = __expf(St[kap].x - mx); St[kap].y = __expf(St[kap].y - mx); St[kap].z = __expf(St[kap].z - mx); St[kap].w = __expf(St[kap].w - mx);
            l += (St[kap].x + St[kap].y) + (St[kap].z + St[kap].w); }
        l += __shfl_xor(l, 16); l += __shfl_xor(l, 32);
        inv[ps] = 1.0f / l;
#pragma unroll
        for (int s = 0; s < 8; ++s) Bp[ps][s] = pack_b(St[2 * s], St[2 * s + 1]);
    }
    __syncthreads();
    xattn_stage(lds, Vt, tid);
    __syncthreads();
#pragma unroll
    for (int ps = 0; ps < 1; ++ps) {
        bf16* AO = (bf16*)(P.ws + WS_AO) + (size_t)(tw + 16 * ps + col) * 1024 + h * 256 + 4 * g;
        bf16x8 fr[2][8];
#pragma unroll
        for (int s = 0; s < 8; ++s) fr[0][s] = *(const LAS bf16x8*)(arow + 64 * s);
#pragma unroll
        for (int del = 0; del < 16; ++del) {
            if (del + 1 < 16) {
#pragma unroll
                for (int s = 0; s < 8; ++s) fr[(del + 1) & 1][s] = *(const LAS bf16x8*)(arow + (16 * (del + 1)) * 528 + 64 * s);
            }
            __builtin_amdgcn_sched_barrier(0);
            PIN8(fr[del & 1]);
            f32x4 acc = (f32x4){0.f, 0.f, 0.f, 0.f};
#pragma unroll
            for (int s = 0; s < 8; ++s) acc = __builtin_amdgcn_mfma_f32_16x16x32_bf16(fr[del & 1][s], Bp[ps][s], acc, 0, 0, 0);
            v2u o; o.x = pk2(acc.x * inv[ps], acc.y * inv[ps]); o.y = pk2(acc.z * inv[ps], acc.w * inv[ps]);
            *(v2u*)(AO + 16 * del) = o;
            __builtin_amdgcn_sched_barrier(0);
        }
    }
    __syncthreads();
}

__device__ __forceinline__ unsigned key_enc(float f) { const unsigned u = __builtin_bit_cast(unsigned, f); return (u & 0x80000000u) ? ~u : (u | 0x80000000u); }
__device__ __forceinline__ float key_dec(unsigned k) { const unsigned u = (k & 0x80000000u) ? (k & 0x7fffffffu) : ~k; return __builtin_bit_cast(float, u); }
#define TK_CAS(a, b) do { const unsigned hi_ = max(a, b), lo_ = min(a, b); a = hi_; b = lo_; } while (0)
__device__ __forceinline__ void tk_merge16(unsigned (&a)[16]) {
#pragma unroll
    for (int j = 8; j > 0; j >>= 1)
#pragma unroll
        for (int i = 0; i < 16; ++i) { const int l = i ^ j; if (l > i) TK_CAS(a[i], a[l]); }
}
__device__ __forceinline__ void tk_sort16(unsigned (&a)[16]) {
#pragma unroll
    for (int k = 2; k <= 16; k <<= 1)
#pragma unroll
        for (int j = k >> 1; j > 0; j >>= 1)
#pragma unroll
            for (int i = 0; i < 16; ++i) { const int l = i ^ j; if (l > i) { if ((i & k) == 0) TK_CAS(a[i], a[l]); else TK_CAS(a[l], a[i]); } }
}
__device__ __forceinline__ void tk_top16_merge(unsigned (&L)[16], const unsigned (&G)[16]) {
#pragma unroll
    for (int i = 0; i < 16; ++i) L[i] = max(L[i], G[15 - i]);
    tk_merge16(L);
}
__device__ __forceinline__ void tk_pair_merge(unsigned (&L)[16]) {
    unsigned Pp[16];
#pragma unroll
    for (int i = 0; i < 16; ++i) Pp[i] = (unsigned)__builtin_amdgcn_update_dpp(0, (int)L[i], 0xB1, 0xF, 0xF, true);
    tk_top16_merge(L, Pp);
}
__device__ __forceinline__ void peer_topk_rows(const Params& P, LAS unsigned char* lds, int rowbase, int tid) {
    const unsigned char* ws = P.ws;
    typedef _Float16 f16x8 __attribute__((ext_vector_type(8)));
    const int rl = tid >> 1, hf = tid & 1, grow = rowbase + rl, t = grow >> 3, h = grow & 7;
    const _Float16* SC = (const _Float16*)(ws + WS_PQ) + (size_t)t * 2048 + h * 256 + 64 * hf;
    f16x8 raw[2][8];
#pragma unroll
    for (int p = 0; p < 2; ++p)
#pragma unroll
        for (int q = 0; q < 8; ++q) raw[p][q] = *(const f16x8*)(SC + p * 128 + 8 * q);
    unsigned L1[16], L2[16];
#pragma unroll
    for (int p = 0; p < 2; ++p) {
        unsigned L[16];
#pragma unroll
        for (int grp = 0; grp < 4; ++grp) {
            unsigned G[16];
#pragma unroll
            for (int e = 0; e < 16; ++e) G[e] = (key_enc((float)raw[p][2 * grp + (e >> 3)][e & 7]) & ~127u) | (unsigned)(127 - (64 * hf + 16 * grp + e));
            tk_sort16(G);
            if (grp == 0) {
#pragma unroll
                for (int i = 0; i < 16; ++i) L[i] = G[i];
            } else tk_top16_merge(L, G);
        }
        tk_pair_merge(L);
#pragma unroll
        for (int i = 0; i < 16; ++i) { if (p == 0) L1[i] = L[i]; else L2[i] = L[i]; }
    }
    {
        float v1[16], v2[16];
        LAS int* il = (LAS int*)lds + rl * 33;
#pragma unroll
        for (int q = 0; q < 16; ++q) { v1[q] = key_dec((L1[q] & ~127u) | 64u); v2[q] = key_dec((L2[q] & ~127u) | 64u); }
        if (hf == 0) {
#pragma unroll
            for (int q = 0; q < 16; ++q) { il[q] = 127 - (int)(L1[q] & 127u); il[16 + q] = 127 - (int)(L2[q] & 127u); }
        }
        unsigned C[16], D[16];
        float w1[8];
        const unsigned hf16 = (unsigned)hf * 16u, evenmask = (unsigned)hf - 1u;
#pragma unroll
        for (int k = 0; k < 8; ++k) w1[k] = __builtin_bit_cast(float, (__builtin_bit_cast(unsigned, v1[2 * k]) & evenmask) | (__builtin_bit_cast(unsigned, v1[2 * k + 1]) & ~evenmask));
#define TK_SLOT(dst, k, bq, valid_odd) do { const unsigned pos_ = (unsigned)(16 * (2 * (k)) + (bq)) + hf16; unsigned kv_ = (key_enc(w1[k] + v2[bq]) & ~255u) | (255u - pos_); if (!(valid_odd)) kv_ &= evenmask; dst = kv_; } while (0)
        TK_SLOT(C[0], 0, 0, true);
        TK_SLOT(C[1], 0, 1, true);
        TK_SLOT(C[2], 0, 2, true);
        TK_SLOT(C[3], 0, 3, true);
        TK_SLOT(C[4], 0, 4, true);
        TK_SLOT(C[5], 0, 5, true);
        TK_SLOT(C[6], 0, 6, true);
        TK_SLOT(C[7], 0, 7, true);
        TK_SLOT(C[8], 0, 8, false);
        TK_SLOT(C[9], 0, 9, false);
        TK_SLOT(C[10], 0, 10, false);
        TK_SLOT(C[11], 0, 11, false);
        TK_SLOT(C[12], 0, 12, false);
        TK_SLOT(C[13], 0, 13, false);
        TK_SLOT(C[14], 0, 14, false);
        TK_SLOT(C[15], 0, 15, false);
        TK_SLOT(D[0], 1, 0, true);
        TK_SLOT(D[1], 1, 1, true);
        TK_SLOT(D[2], 1, 2, true);
        TK_SLOT(D[3], 1, 3, true);
        TK_SLOT(D[4], 1, 4, false);
        TK_SLOT(D[5], 2, 0, true);
        TK_SLOT(D[6], 2, 1, true);
        TK_SLOT(D[7], 2, 2, false);
        TK_SLOT(D[8], 3, 0, true);
        TK_SLOT(D[9], 3, 1, true);
        TK_SLOT(D[10], 4, 0, true);
        TK_SLOT(D[11], 5, 0, true);
        TK_SLOT(D[12], 6, 0, true);
        TK_SLOT(D[13], 7, 0, true);
        D[14] = 0u; D[15] = 0u;
#undef TK_SLOT
        tk_sort16(C); tk_sort16(D); tk_top16_merge(C, D); tk_pair_merge(C);
        LDS_WAIT(); asm volatile("" ::: "memory");
        float best[16], e[16], sum = 0.f;
#pragma unroll
        for (int q = 0; q < 16; ++q) { best[q] = key_dec((C[q] & ~255u) | 128u); e[q] = __expf(best[q] - best[0]); sum += e[q]; }
        const float inv = __builtin_amdgcn_rcpf(sum);
        int* IDX = (int*)(P.ws + WS_IDX) + (size_t)grow * 16 + 8 * hf; float* GW = (float*)(P.ws + WS_GW) + (size_t)grow * 16 + 8 * hf;
#pragma unroll
        for (int q = 0; q < 8; ++q) {
            const unsigned c = (C[q] & evenmask) | (C[8 + q] & ~evenmask);
            const float ev = __builtin_bit_cast(float, (__builtin_bit_cast(unsigned, e[q]) & evenmask) | (__builtin_bit_cast(unsigned, e[8 + q]) & ~evenmask));
            const unsigned pos = 255u - (c & 255u);
            IDX[q] = il[pos >> 4] * 128 + il[16 + (pos & 15u)]; GW[q] = ev * inv;
        }
    }
    LDS_WAIT(); asm volatile("" ::: "memory");
}

__device__ __forceinline__ void peer_topk_wave(const Params& P, LAS int* ilw, LAS unsigned* oute, LAS float* outg, int tbase, int lane) {
    const unsigned char* ws = P.ws;
    typedef _Float16 f16x8 __attribute__((ext_vector_type(8)));
    const int rl = lane >> 1, hf = lane & 1, t = tbase + (rl >> 3), h = rl & 7;
    const _Float16* SC = (const _Float16*)(ws + WS_PQ) + (size_t)t * 2048 + h * 256 + 64 * hf;
    f16x8 raw[2][8];
#pragma unroll
    for (int p = 0; p < 2; ++p)
#pragma unroll
        for (int q = 0; q < 8; ++q) raw[p][q] = *(const f16x8*)(SC + p * 128 + 8 * q);
    unsigned L1[16], L2[16];
#pragma unroll
    for (int p = 0; p < 2; ++p) {
        unsigned L[16];
#pragma unroll
        for (int grp = 0; grp < 4; ++grp) {
            unsigned G[16];
#pragma unroll
            for (int e = 0; e < 16; ++e) G[e] = (key_enc((float)raw[p][2 * grp + (e >> 3)][e & 7]) & ~127u) | (unsigned)(127 - (64 * hf + 16 * grp + e));
            tk_sort16(G);
            if (grp == 0) {
#pragma unroll
                for (int i = 0; i < 16; ++i) L[i] = G[i];
            } else tk_top16_merge(L, G);
        }
        tk_pair_merge(L);
#pragma unroll
        for (int i = 0; i < 16; ++i) { if (p == 0) L1[i] = L[i]; else L2[i] = L[i]; }
    }
    {
        float v1[16], v2[16];
        LAS int* il = ilw + rl * 33;
#pragma unroll
        for (int q = 0; q < 16; ++q) { v1[q] = key_dec((L1[q] & ~127u) | 64u); v2[q] = key_dec((L2[q] & ~127u) | 64u); }
        if (hf == 0) {
#pragma unroll
            for (int q = 0; q < 16; ++q) { il[q] = 127 - (int)(L1[q] & 127u); il[16 + q] = 127 - (int)(L2[q] & 127u); }
        }
        unsigned C[16], D[16];
        float w1[8];
        const unsigned hf16 = (unsigned)hf * 16u, evenmask = (unsigned)hf - 1u;
#pragma unroll
        for (int k = 0; k < 8; ++k) w1[k] = __builtin_bit_cast(float, (__builtin_bit_cast(unsigned, v1[2 * k]) & evenmask) | (__builtin_bit_cast(unsigned, v1[2 * k + 1]) & ~evenmask));
#define TK_SLOT(dst, k, bq, valid_odd) do { const unsigned pos_ = (unsigned)(16 * (2 * (k)) + (bq)) + hf16; unsigned kv_ = (key_enc(w1[k] + v2[bq]) & ~255u) | (255u - pos_); if (!(valid_odd)) kv_ &= evenmask; dst = kv_; } while (0)
        TK_SLOT(C[0], 0, 0, true);
        TK_SLOT(C[1], 0, 1, true);
        TK_SLOT(C[2], 0, 2, true);
        TK_SLOT(C[3], 0, 3, true);
        TK_SLOT(C[4], 0, 4, true);
        TK_SLOT(C[5], 0, 5, true);
        TK_SLOT(C[6], 0, 6, true);
        TK_SLOT(C[7], 0, 7, true);
        TK_SLOT(C[8], 0, 8, false);
        TK_SLOT(C[9], 0, 9, false);
        TK_SLOT(C[10], 0, 10, false);
        TK_SLOT(C[11], 0, 11, false);
        TK_SLOT(C[12], 0, 12, false);
        TK_SLOT(C[13], 0, 13, false);
        TK_SLOT(C[14], 0, 14, false);
        TK_SLOT(C[15], 0, 15, false);
        TK_SLOT(D[0], 1, 0, true);
        TK_SLOT(D[1], 1, 1, true);
        TK_SLOT(D[2], 1, 2, true);
        TK_SLOT(D[3], 1, 3, true);
        TK_SLOT(D[4], 1, 4, false);
        TK_SLOT(D[5], 2, 0, true);
        TK_SLOT(D[6], 2, 1, true);
        TK_SLOT(D[7], 2, 2, false);
        TK_SLOT(D[8], 3, 0, true);
        TK_SLOT(D[9], 3, 1, true);
        TK_SLOT(D[10], 4, 0, true);
        TK_SLOT(D[11], 5, 0, true);
        TK_SLOT(D[12], 6, 0, true);
        TK_SLOT(D[13], 7, 0, true);
        D[14] = 0u; D[15] = 0u;
#undef TK_SLOT
        tk_sort16(C); tk_sort16(D); tk_top16_merge(C, D); tk_pair_merge(C);
        LDS_WAIT(); asm volatile("" ::: "memory");
        float best[16], e[16], sum = 0.f;
#pragma unroll
        for (int q = 0; q < 16; ++q) { best[q] = key_dec((C[q] & ~255u) | 128u); e[q] = __expf(best[q] - best[0]); sum += e[q]; }
        const float inv = __builtin_amdgcn_rcpf(sum);
        LAS unsigned* IDX = oute + rl * 16 + 8 * hf; LAS float* GW = outg + rl * 16 + 8 * hf;
#pragma unroll
        for (int q = 0; q < 8; ++q) {
            const unsigned c = (C[q] & evenmask) | (C[8 + q] & ~evenmask);
            const float ev = __builtin_bit_cast(float, (__builtin_bit_cast(unsigned, e[q]) & evenmask) | (__builtin_bit_cast(unsigned, e[8 + q]) & ~evenmask));
            const unsigned pos = 255u - (c & 255u);
            IDX[q] = (unsigned)(il[pos >> 4] * 128 + il[16 + (pos & 15u)]); GW[q] = ev * inv;
        }
    }
    LDS_WAIT(); asm volatile("" ::: "memory");
}

typedef float f32x2 __attribute__((ext_vector_type(2)));
__device__ __forceinline__ unsigned q8(float x) { return (unsigned)(int)rintf(x) & 0xffu; }
__device__ __forceinline__ void cvt_table_fp8(const float* src, unsigned char* dst, float* scl, int gw, int ngw, int lane) {
    for (int row = gw; row < 16384; row += ngw) {
        const f32x4* sp = (const f32x4*)(src + (size_t)row * 1024 + 16 * lane);
        const f32x4 a0 = sp[0], a1 = sp[1], a2 = sp[2], a3 = sp[3];
        float m = fmaxf(fmaxf(fmaxf(fabsf(a0.x), fabsf(a0.y)), fmaxf(fabsf(a0.z), fabsf(a0.w))), fmaxf(fmaxf(fabsf(a1.x), fabsf(a1.y)), fmaxf(fabsf(a1.z), fabsf(a1.w))));
        m = fmaxf(m, fmaxf(fmaxf(fmaxf(fabsf(a2.x), fabsf(a2.y)), fmaxf(fabsf(a2.z), fabsf(a2.w))), fmaxf(fmaxf(fabsf(a3.x), fabsf(a3.y)), fmaxf(fabsf(a3.z), fabsf(a3.w)))));
#pragma unroll
        for (int o = 1; o < 64; o <<= 1) m = fmaxf(m, __shfl_xor(m, o));
        m = fmaxf(m, 1e-30f);
        const float q = 127.0f / m;
        v4u o;
        o.x = q8(a0.x * q) | (q8(a0.y * q) << 8) | (q8(a0.z * q) << 16) | (q8(a0.w * q) << 24);
        o.y = q8(a1.x * q) | (q8(a1.y * q) << 8) | (q8(a1.z * q) << 16) | (q8(a1.w * q) << 24);
        o.z = q8(a2.x * q) | (q8(a2.y * q) << 8) | (q8(a2.z * q) << 16) | (q8(a2.w * q) << 24);
        o.w = q8(a3.x * q) | (q8(a3.y * q) << 8) | (q8(a3.z * q) << 16) | (q8(a3.w * q) << 24);
        *(v4u*)(dst + (size_t)row * 1024 + 16 * lane) = o;
        if (lane == 0) scl[row] = m * (1.0f / 127.0f);
    }
}
__device__ __forceinline__ int row16_sum_i(int v) {
    v += __builtin_amdgcn_update_dpp(0, v, 0xB1, 0xF, 0xF, true);
    v += __builtin_amdgcn_update_dpp(0, v, 0x4E, 0xF, 0xF, true);
    v += __builtin_amdgcn_update_dpp(0, v, 0x141, 0xF, 0xF, true);
    v += __builtin_amdgcn_update_dpp(0, v, 0x140, 0xF, 0xF, true);
    return v;
}
constexpr int PE_NT = 4, PE_NR = 16, PE_SH = 10, PE_DEP = 3;
constexpr int PE_TOK_W = 128 * 3 + 20;
constexpr int PE_WAVE_W = PE_NT * PE_TOK_W + 272 + 32 * 33 + 2 * PE_NT * 128;
static_assert(8 * PE_WAVE_W * 4 <= MISC_OFF && PE_NR * PE_NT == 64, "peer LDS / batch-list geometry");
#define PE_LD(dst, voff_, sbase_) asm volatile("s_nop 4\n\tglobal_load_dwordx4 %0, %1, %2" : "=&v"(dst) : "v"(voff_), "s"(sbase_) : "memory")
__device__ __forceinline__ void peer_pass(const Params& P, LAS unsigned char* lds, int tbase, int lane, int wave, float* dstbase, int emask = 0x3fff) {
    {
        LAS unsigned* lw0 = (LAS unsigned*)(lds) + wave * PE_WAVE_W + PE_NT * PE_TOK_W + 272;
        peer_topk_wave(P, (LAS int*)lw0, lw0 + 32 * 33, (LAS float*)(lw0 + 32 * 33 + PE_NT * 128), tbase, lane);
        LDS_WAIT(); asm volatile("" : "+v"(lane), "+s"(tbase) :: "memory");
    }
    const unsigned char* ws = P.ws;
    const unsigned char* UB8 = ws + WS_UB; const unsigned char* VB8 = ws + WS_VB;
    const float* USC = (const float*)(ws + WS_USC); const float* VSC = (const float*)(ws + WS_VSC);
    f32x2 acc[PE_NT][8];
    LAS unsigned* lw = (LAS unsigned*)(lds) + wave * PE_WAVE_W;
    LAS unsigned* ents = lw + PE_NT * PE_TOK_W;
    const unsigned voff = (unsigned)lane * 16u;
    LAS unsigned* upe = ents + 272 + 32 * 33; LAS float* upg = (LAS float*)(upe + PE_NT * 128);
    LAS unsigned* hql = ents + 272;
#pragma unroll
    for (int j = 0; j < PE_NT; ++j) {
        const int t = tbase + j;
        const v4u* xrow = (const v4u*)((const bf16*)(ws + WS_XB) + (size_t)t * 1024 + 16 * lane);
        const v4u xa = xrow[0], xc = xrow[1];
        const f32x4 xvv[4] = {(f32x4){bflo(xa.x), bfhi(xa.x), bflo(xa.y), bfhi(xa.y)}, (f32x4){bflo(xa.z), bfhi(xa.z), bflo(xa.w), bfhi(xa.w)},
                              (f32x4){bflo(xc.x), bfhi(xc.x), bflo(xc.y), bfhi(xc.y)}, (f32x4){bflo(xc.z), bfhi(xc.z), bflo(xc.w), bfhi(xc.w)}};
        const float rstd2 = rsqrtf(((const float*)(ws + WS_SSQ2))[t] * (1.0f / 1024.0f) + 1e-6f);
        f32x4 hv[4]; float hm = 0.f;
#pragma unroll
        for (int i = 0; i < 4; ++i) { const f32x4 xv = xvv[i]; const f32x4 w = ((const f32x4*)(P.norm_ffn_w + 16 * lane))[i];
            hv[i] = (f32x4){xv.x * rstd2 * w.x, xv.y * rstd2 * w.y, xv.z * rstd2 * w.z, xv.w * rstd2 * w.w};
            hm = fmaxf(hm, fmaxf(fmaxf(fabsf(hv[i].x), fabsf(hv[i].y)), fmaxf(fabsf(hv[i].z), fabsf(hv[i].w)))); }
#pragma unroll
        for (int o = 1; o < 64; o <<= 1) hm = fmaxf(hm, __shfl_xor(hm, o));
        hm = fmaxf(hm, 1e-30f);
        const float hqs = 127.0f / hm, hs = hm * (1.0f / 127.0f);
        { unsigned hqv[4];
#pragma unroll
          for (int i = 0; i < 4; ++i) hqv[i] = q8(hv[i].x * hqs) | (q8(hv[i].y * hqs) << 8) | (q8(hv[i].z * hqs) << 16) | (q8(hv[i].w * hqs) << 24);
          *(LAS v4u*)(hql + (j * 64 + lane) * 4) = (v4u){hqv[0], hqv[1], hqv[2], hqv[3]}; }
#pragma unroll
        for (int i = 0; i < 8; ++i) acc[j][i] = (f32x2){0.f, 0.f};
        const int e0 = (int)upe[j * 128 + 2 * lane] & emask, e1 = (int)upe[j * 128 + 2 * lane + 1] & emask;
        const float g0 = upg[j * 128 + 2 * lane] * VSC[e0], g1 = upg[j * 128 + 2 * lane + 1] * VSC[e1];
        const float u0 = USC[e0] * hs, u1 = USC[e1] * hs;
        const int b0 = e0 >> PE_SH, b1 = e1 >> PE_SH;
        LAS unsigned* lt = lw + j * PE_TOK_W;
        int run = 0;
#pragma unroll 1
        for (int bk = 0; bk < PE_NR; ++bk) {
            const unsigned long long m0 = __ballot(b0 == bk), m1 = __ballot(b1 == bk);
            const int c0 = __popcll(m0), c1 = __popcll(m1);
            const unsigned long long lower = (1ull << lane) - 1ull;
            if (b0 == bk) { const int p = run + __popcll(m0 & lower); lt[p] = (unsigned)e0; lt[128 + p] = __builtin_bit_cast(unsigned, g0); lt[256 + p] = __builtin_bit_cast(unsigned, u0); }
            if (b1 == bk) { const int p = run + c0 + __popcll(m1 & lower); lt[p] = (unsigned)e1; lt[128 + p] = __builtin_bit_cast(unsigned, g1); lt[256 + p] = __builtin_bit_cast(unsigned, u1); }
            if (lane == 0) lt[384 + bk] = (unsigned)run;
            run += c0 + c1;
        }
        if (lane == 0) lt[384 + PE_NR] = 128u;
        asm volatile("" ::: "memory");
    }
    LDS_WAIT(); asm volatile("" ::: "memory");
    int nb;
    {
        const int rd = lane >> 2, j = lane & 3;
        const LAS unsigned* lt = lw + j * PE_TOK_W;
        const int n0 = (int)lt[384 + rd], n1 = (int)lt[384 + rd + 1];
        const int nbl = (n1 - n0 + 3) >> 2;
        int inc = nbl;
#pragma unroll
        for (int off = 1; off < 64; off <<= 1) { const int tv = __shfl_up(inc, off); if (lane >= off) inc += tv; }
        nb = __builtin_amdgcn_readlane(inc, 63);
        const int ofs = inc - nbl;
        for (int q = 0; q < nbl; ++q) { const int i0 = n0 + 4 * q, c = (n1 - i0) < 4 ? (n1 - i0) : 4; ents[ofs + q] = (unsigned)j | ((unsigned)c << 2) | ((unsigned)i0 << 5); }
        if (lane < 2 * PE_DEP) ents[nb + lane] = 0u;
    }
    LDS_WAIT(); asm volatile("" ::: "memory");
    v4u ru[PE_DEP][4], rv[PE_DEP][4];
#define PE_LDO(dst, vo_, sbase_) asm volatile("global_load_dwordx4 %0, %1, %2" : "=&v"(dst) : "v"(vo_), "s"(sbase_) : "memory")
#define PE_ISSUE(S, entv) do { const unsigned en_ = (entv); const int j_ = (int)(en_ & 3u), c_ = (int)((en_ >> 2) & 7u), i_ = (int)(en_ >> 5); \
        const LAS unsigned* lt_ = lw + j_ * PE_TOK_W; const int cl_ = c_ > 0 ? c_ - 1 : 0; \
        const int ev_ = (int)lt_[i_ + (lane < cl_ ? lane : cl_)];                          \
        _Pragma("unroll") for (int k_ = 0; k_ < 4; ++k_) { const unsigned vo_ = ((unsigned)__builtin_amdgcn_readlane(ev_, k_) << 10) + voff; \
            PE_LDO(ru[S][k_], vo_, UB8); PE_LDO(rv[S][k_], vo_, VB8); } } while (0)
#define PE_WAIT8(S, cntstr) asm volatile("s_waitcnt " cntstr : "+v"(ru[S][0]), "+v"(ru[S][1]), "+v"(ru[S][2]), "+v"(ru[S][3]), "+v"(rv[S][0]), "+v"(rv[S][1]), "+v"(rv[S][2]), "+v"(rv[S][3]) :: "memory")
#define PE_UDOTS(S) asm("v_dot4_i32_i8 %0, %4, %20, 0\n\tv_dot4_i32_i8 %1, %8, %20, 0\n\tv_dot4_i32_i8 %2, %12, %20, 0\n\tv_dot4_i32_i8 %3, %16, %20, 0\n\t" \
                        "v_dot4_i32_i8 %0, %5, %21, %0\n\tv_dot4_i32_i8 %1, %9, %21, %1\n\tv_dot4_i32_i8 %2, %13, %21, %2\n\tv_dot4_i32_i8 %3, %17, %21, %3\n\t" \
                        "v_dot4_i32_i8 %0, %6, %22, %0\n\tv_dot4_i32_i8 %1, %10, %22, %1\n\tv_dot4_i32_i8 %2, %14, %22, %2\n\tv_dot4_i32_i8 %3, %18, %22, %3\n\t" \
                        "v_dot4_i32_i8 %0, %7, %23, %0\n\tv_dot4_i32_i8 %1, %11, %23, %1\n\tv_dot4_i32_i8 %2, %15, %23, %2\n\tv_dot4_i32_i8 %3, %19, %23, %3\n\ts_nop 2" \
        : "=&v"(d_[0]), "=&v"(d_[1]), "=&v"(d_[2]), "=&v"(d_[3]) \
        : "v"(ru[S][0].x), "v"(ru[S][0].y), "v"(ru[S][0].z), "v"(ru[S][0].w), "v"(ru[S][1].x), "v"(ru[S][1].y), "v"(ru[S][1].z), "v"(ru[S][1].w), \
          "v"(ru[S][2].x), "v"(ru[S][2].y), "v"(ru[S][2].z), "v"(ru[S][2].w), "v"(ru[S][3].x), "v"(ru[S][3].y), "v"(ru[S][3].z), "v"(ru[S][3].w), \
          "v"(hcur.x), "v"(hcur.y), "v"(hcur.z), "v"(hcur.w))
#define PE_UDOTS_SAFE(S) do { _Pragma("unroll") for (int k_ = 0; k_ < 4; ++k_) { int s_ = __builtin_amdgcn_sdot4((int)ru[S][k_].x, (int)hcur.x, 0, false); s_ = __builtin_amdgcn_sdot4((int)ru[S][k_].y, (int)hcur.y, s_, false); \
            s_ = __builtin_amdgcn_sdot4((int)ru[S][k_].z, (int)hcur.z, s_, false); s_ = __builtin_amdgcn_sdot4((int)ru[S][k_].w, (int)hcur.w, s_, false); d_[k_] = s_; } } while (0)
#define PE_VDOTS_SAFE(f0, f1, f2, f3, b0, b1, b2, b3, w) do { f0 = (float)__builtin_amdgcn_sdot4((int)(b0), (int)(w), 0, false); f1 = (float)__builtin_amdgcn_sdot4((int)(b1), (int)(w), 0, false); \
            f2 = (float)__builtin_amdgcn_sdot4((int)(b2), (int)(w), 0, false); f3 = (float)__builtin_amdgcn_sdot4((int)(b3), (int)(w), 0, false); } while (0)
#define PE_VDOTS(f0, f1, f2, f3, b0, b1, b2, b3, w) asm("v_dot4_i32_i8 %0, %4, %8, 0\n\tv_dot4_i32_i8 %1, %5, %8, 0\n\tv_dot4_i32_i8 %2, %6, %8, 0\n\tv_dot4_i32_i8 %3, %7, %8, 0\n\t" \
                        "v_cvt_f32_i32_e32 %0, %0\n\tv_cvt_f32_i32_e32 %1, %1\n\tv_cvt_f32_i32_e32 %2, %2\n\tv_cvt_f32_i32_e32 %3, %3" \
        : "=&v"(f0), "=&v"(f1), "=&v"(f2), "=&v"(f3) : "v"(b0), "v"(b1), "v"(b2), "v"(b3), "v"(w))
#define PE_COMPUTE_B(S, c_, i_, j_, SG) do { const LAS unsigned* lt_ = lw + (j_) * PE_TOK_W; \
        const int myk_ = lane >> 4; \
        float gsc_ = __builtin_bit_cast(float, lt_[128 + i_ + myk_]), usc_ = __builtin_bit_cast(float, lt_[256 + i_ + myk_]);     \
        int d_[4]; \
        PE_UDOTS(S); \
        int r1_; \
        { const v2u p02_ = __builtin_amdgcn_permlane32_swap((unsigned)d_[0], (unsigned)d_[2], false, false), p13_ = __builtin_amdgcn_permlane32_swap((unsigned)d_[1], (unsigned)d_[3], false, false); \
          const v2u q_ = __builtin_amdgcn_permlane16_swap(p02_.x + p02_.y, p13_.x + p13_.y, false, false); r1_ = row16_sum_i((int)(q_.x + q_.y)); }     \
        float act_; \
        { const float x_ = (float)r1_ * usc_, e_ = __builtin_amdgcn_exp2f(x_ * __builtin_fmaf(x_ * x_, -0.10294324f, -2.3022082f));     \
          act_ = x_ * __builtin_amdgcn_rcpf(1.0f + e_) * gsc_; act_ = (myk_ < c_) ? act_ : 0.f; } \
        float wm_; \
        { unsigned wmu_ = __builtin_bit_cast(unsigned, act_) & 0x7fffffffu;                 \
          v2u t_ = __builtin_amdgcn_permlane32_swap(wmu_, wmu_, false, false); wmu_ = t_.x > t_.y ? t_.x : t_.y; \
          t_ = __builtin_amdgcn_permlane16_swap(wmu_, wmu_, false, false); wmu_ = t_.x > t_.y ? t_.x : t_.y; \
          wm_ = fmaxf(__builtin_bit_cast(float, wmu_), 1e-30f); } \
        const float wq_ = 127.0f * __builtin_amdgcn_rcpf(wm_), ws_ = (SG) * wm_ * (1.0f / 127.0f); \
        unsigned w4u_ = (__builtin_bit_cast(unsigned, __builtin_fmaf(act_, wq_, 12582912.0f)) & 0xffu) << (8 * myk_); \
        { v2u t_ = __builtin_amdgcn_permlane32_swap(w4u_, w4u_, false, false); w4u_ = t_.x | t_.y; t_ = __builtin_amdgcn_permlane16_swap(w4u_, w4u_, false, false); w4u_ = t_.x | t_.y; } \
        const f32x2 ws2_ = (f32x2){ws_, ws_}; \
        _Pragma("unroll") for (int m_ = 0; m_ < 4; ++m_) { \
            const unsigned R0_ = rv[S][0][m_], R1_ = rv[S][1][m_], R2_ = rv[S][2][m_], R3_ = rv[S][3][m_]; \
            const unsigned X_ = __builtin_amdgcn_perm(R1_, R0_, 0x05010400u), Y_ = __builtin_amdgcn_perm(R1_, R0_, 0x07030602u), Z_ = __builtin_amdgcn_perm(R3_, R2_, 0x05010400u), W_ = __builtin_amdgcn_perm(R3_, R2_, 0x07030602u); \
            float t0_, t1_, t2_, t3_; \
            const unsigned b0_ = __builtin_amdgcn_perm(Z_, X_, 0x05040100u), b1_ = __builtin_amdgcn_perm(Z_, X_, 0x07060302u), b2_ = __builtin_amdgcn_perm(W_, Y_, 0x05040100u), b3_ = __builtin_amdgcn_perm(W_, Y_, 0x07060302u); \
            PE_VDOTS(t0_, t1_, t2_, t3_, b0_, b1_, b2_, b3_, w4u_); \
            cur[2 * m_] = __builtin_elementwise_fma((f32x2){t0_, t1_}, ws2_, cur[2 * m_]); \
            cur[2 * m_ + 1] = __builtin_elementwise_fma((f32x2){t2_, t3_}, ws2_, cur[2 * m_ + 1]); } } while (0)
#define PE_FLUSH() do { _Pragma("unroll") for (int J_ = 0; J_ < PE_NT; ++J_) { const float sel_ = (jcur == J_) ? 1.0f : 0.0f; const f32x2 sel2_ = (f32x2){sel_, sel_};     \
            _Pragma("unroll") for (int i_ = 0; i_ < 8; ++i_) acc[J_][i_] = __builtin_elementwise_fma(cur[i_], sel2_, acc[J_][i_]); } \
        _Pragma("unroll") for (int i_ = 0; i_ < 8; ++i_) cur[i_] = (f32x2){0.f, 0.f}; } while (0)
#define PE_COMPUTE_S(S, entv, SG) do { const unsigned en_ = (entv); const int jj_ = (int)(en_ & 3u), cc_ = (int)((en_ >> 2) & 7u), ii_ = (int)(en_ >> 5); \
        if (cc_ > 0) { if (jj_ != jcur) { PE_FLUSH(); jcur = jj_; hcur = *(const LAS v4u*)(hql + (jj_ * 64 + lane) * 4); } \
                       PE_COMPUTE_B(S, cc_, ii_, jj_, SG); } } while (0)
#ifdef PE_VALU3
#define PE_COMPUTE(S, entv) do { PE_COMPUTE_S(S, entv, 1.0f); PE_WAIT8(S, "vmcnt(16)"); PE_COMPUTE_S(S, entv, -1.0f); PE_WAIT8(S, "vmcnt(16)"); PE_COMPUTE_S(S, entv, 1.0f); } while (0)
#else
#define PE_COMPUTE(S, entv) PE_COMPUTE_S(S, entv, 1.0f)
#endif
    {
        unsigned er[PE_DEP];
#pragma unroll
        for (int q = 0; q < PE_DEP; ++q) { er[q] = __builtin_amdgcn_readfirstlane(ents[q]); PE_ISSUE(q, er[q]); }
        f32x2 cur[8];
#pragma unroll
        for (int i = 0; i < 8; ++i) cur[i] = (f32x2){0.f, 0.f};
        int jcur = (int)(er[0] & 3u);
        v4u hcur = *(const LAS v4u*)(hql + (jcur * 64 + lane) * 4);
#pragma unroll 1
        for (int bi = 0; bi < nb; bi += PE_DEP) {
#pragma unroll
            for (int q = 0; q < PE_DEP; ++q) {
                PE_WAIT8(q, "vmcnt(16)");
                PE_COMPUTE(q, er[q]);
                er[q] = __builtin_amdgcn_readfirstlane(ents[bi + q + PE_DEP]);
                PE_ISSUE(q, er[q]);
            }
        }
#pragma unroll
        for (int q = 0; q < PE_DEP; ++q) PE_WAIT8(q, "vmcnt(0)");
        PE_FLUSH();
    }
#undef PE_COMPUTE
#undef PE_COMPUTE_S
#undef PE_COMPUTE_B
#undef PE_FLUSH
#undef PE_WAIT8
#undef PE_ISSUE
#undef PE_LDO
#undef PE_UDOTS
#undef PE_VDOTS
#pragma unroll
    for (int j = 0; j < PE_NT; ++j) {
        const int t = tbase + j;
        float ss = 0.f; f32x4 xo[4];
        { const v4u* xrow = (const v4u*)((const bf16*)(ws + WS_XB) + (size_t)t * 1024 + 16 * lane); const v4u xa = xrow[0], xc = xrow[1];
          xo[0] = (f32x4){bflo(xa.x), bfhi(xa.x), bflo(xa.y), bfhi(xa.y)}; xo[1] = (f32x4){bflo(xa.z), bfhi(xa.z), bflo(xa.w), bfhi(xa.w)};
          xo[2] = (f32x4){bflo(xc.x), bfhi(xc.x), bflo(xc.y), bfhi(xc.y)}; xo[3] = (f32x4){bflo(xc.z), bfhi(xc.z), bflo(xc.w), bfhi(xc.w)}; }
#pragma unroll
        for (int i = 0; i < 4; ++i) { xo[i].x += acc[j][2 * i].x; xo[i].y += acc[j][2 * i].y; xo[i].z += acc[j][2 * i + 1].x; xo[i].w += acc[j][2 * i + 1].y;
            ss += (xo[i].x * xo[i].x + xo[i].y * xo[i].y) + (xo[i].z * xo[i].z + xo[i].w * xo[i].w); }
        const float rstd3 = rsqrtf(wave_sum(ss) * (1.0f / 1024.0f) + 1e-6f);
        float* orow = dstbase + (size_t)t * 1024 + 16 * lane;
#pragma unroll
        for (int i = 0; i < 4; ++i) { const f32x4 w = ((const f32x4*)(P.norm_final_w + 16 * lane))[i];
            ((f32x4*)orow)[i] = (f32x4){xo[i].x * rstd3 * w.x, xo[i].y * rstd3 * w.y, xo[i].z * rstd3 * w.z, xo[i].w * rstd3 * w.w}; }
    }
    LDS_WAIT(); asm volatile("s_waitcnt vmcnt(0)" ::: "memory");
}


#ifndef TWICE_MASK
#define TWICE_MASK 0
#endif
struct TwiceOrder { pg8::StaticOrder S; int per, reps;
    __device__ bool next(int i, pg8::Unit& u) const { if (i >= per * reps) return false; return S.next(i % per, u); }
    __device__ __forceinline__ void a_ready(const pg8::Unit&) const {} __device__ __forceinline__ void done(const pg8::Unit&) const {} };
template <class B> __device__ __forceinline__ bool rep_again(volatile LAS unsigned* MISC, B& bar) {
    __syncthreads(); const unsigned c = MISC[20]; __syncthreads();
    if (threadIdx.x == 0) MISC[20] = c ^ 1u;
    __syncthreads();
    if (c == 0u) { xcd_barrier(bar); return true; }
    return false;
}
__global__ void __launch_bounds__(NWAVES * 64, 2) hybrid_fwd(Params P) {
    extern __shared__ __attribute__((aligned(16))) unsigned char lds_raw[];
    LAS unsigned char* lds = (LAS unsigned char*)lds_raw;
    volatile LAS unsigned* MISC = (volatile LAS unsigned*)(lds + MISC_OFF);
    const int tid = threadIdx.x, lane = tid & 63, wave = __builtin_amdgcn_readfirstlane(tid >> 6);
    const int G = gridDim.x, bx = blockIdx.x;
    const int vcu = (G % 8 == 0) ? (bx % 8) * (G / 8) + bx / 8 : bx;
    unsigned char* ws = P.ws;
    for (int u = tid; u < 64; u += NWAVES * 64) MISC[u] = 0u;
    __syncthreads();
    XcdBarrier bar; bar.bar = (unsigned*)(ws + WS_CTL) + CW_BAR; bar.x = 0; bar.st = nullptr;
    if (!MK_PER_PHASE) bar = xcd_barrier_post((unsigned*)(ws + WS_CTL) + CW_BAR, MISC + 8);
    const int lo = P.ph_lo, hi = P.ph_hi;
#ifndef PHASE_MASK
#define PHASE_MASK 0xFFF
#endif
#define IN(k) (((PHASE_MASK >> (k)) & 1) && lo <= (k) && (k) < hi)
#define SEAM(k) do { if (IN(k) && IN((k) + 1)) xcd_barrier(bar); } while (0)
#ifndef REP_MASK
#define REP_MASK 0
#endif
#ifndef PE_EXP_MASK
#define PE_EXP_MASK 0x3fff
#endif
#define REPS(k) for (bool again_ = true; again_; again_ = (((REP_MASK >> (k)) & 1) ? rep_again(MISC, bar) : false))
    using namespace pg8;
    bf16* XB = (bf16*)(ws + WS_XB);

    if (IN(0)) REPS(0) { p0_prologue(P, lds, tid, lane, wave, vcu, G); }
    SEAM(0);
    if (IN(1)) REPS(1) {
        { Gemm gm{XB, (const bf16_t*)(ws + WS_WIN), T, 3072, 1024}; StaticOrder S; S.init(T, 3072, G, bx);
          EpiBf16Rs E{(bf16_t*)(ws + WS_QKV), 1536, 6, (bf16_t*)(ws + WS_XR), 512, (size_t)T * 512, nullptr, 1.0f};
          gemm_phase<EpiBf16Rs, StaticOrder, PG8_ALIGN, PG8_SP2>(lds, gm, S, E); }
    }
    SEAM(1);
    if (IN(3)) REPS(3) {
        if (bx < SCAN_WGS) gdn_scan(P, lds, bx, tid, lane, wave);
        else {
            const int wk = bx - SCAN_WGS, NWK = G - SCAN_WGS;
            unsigned* lcnt = (unsigned*)(ws + WS_CTL) + CW_LRUCNT;
            for (int q = wk; q < 1024; q += NWK) gdn_local_item(P, lds, (q & 7) * 128 + (q >> 3), tid);
            if (wk < 16) {
                struct OneUnit { int pm, pn; __device__ bool next(int i, Unit& u) const { if (i > 0) return false; u.pm = pm; u.pn = pn; return true; }
                                 __device__ void a_ready(const Unit&) const {} __device__ void done(const Unit&) const {} };
                Gemm gm{(const bf16_t*)(ws + WS_MEMN), (const bf16_t*)(ws + WS_WKV), 512, 2048, 1024}; OneUnit S{wk >> 3, wk & 7};
                EpiKV E{(bf16_t*)(ws + WS_KB), (bf16_t*)(ws + WS_VTP)};
                gemm_phase<EpiKV, OneUnit, PG8_ALIGN, PG8_SP2>(lds, gm, S, E);
            }
            unsigned ndone = 0;
            for (int lt = wk; lt < 256; lt += NWK) { lru_local_item(P, lds, lt, tid, lane, wave); ++ndone; }
            asm volatile("s_waitcnt vmcnt(0)" ::: "memory");
            __syncthreads();
            if (tid == 0 && ndone) { __builtin_amdgcn_fence(__ATOMIC_RELEASE, "agent"); asm volatile("s_waitcnt vmcnt(0)" ::: "memory");
                                     __hip_atomic_fetch_add(lcnt, ndone, __ATOMIC_RELAXED, __HIP_MEMORY_SCOPE_AGENT); }
            if (wk == 16 || wk == 17) {
                if (tid == 0) { unsigned sp = 0;
                    while (__hip_atomic_load(lcnt, __ATOMIC_RELAXED, __HIP_MEMORY_SCOPE_AGENT) < 256u) { __builtin_amdgcn_s_sleep(8); if (++sp > (1u << 22)) break; }
                    __builtin_amdgcn_fence(__ATOMIC_ACQUIRE, "agent"); asm volatile("s_waitcnt vmcnt(0)" ::: "memory"); }
                __syncthreads();
                lru_carry(P, (wk - 16) * NWAVES + wave, lane);
                asm volatile("s_waitcnt vmcnt(0)" ::: "memory");
                __syncthreads();
                if (tid == 0) { __builtin_amdgcn_fence(__ATOMIC_RELEASE, "agent"); asm volatile("s_waitcnt vmcnt(0)" ::: "memory");
                                __hip_atomic_fetch_add(lcnt + 64, 1u, __ATOMIC_RELAXED, __HIP_MEMORY_SCOPE_AGENT); }
            } else {
                const int w2 = (wk < 16 ? wk : wk - 2), N2 = NWK - 2;
                cvt_table_fp8(P.peer_v, ws + WS_VB, (float*)(ws + WS_VSC), w2 * NWAVES + wave, N2 * NWAVES, lane);
                late_weight_prep(P, lds, lane, wave, w2 * NWAVES + wave, N2 * NWAVES);
                if (tid == 0) { unsigned sp = 0;
                    while (__hip_atomic_load(lcnt + 64, __ATOMIC_RELAXED, __HIP_MEMORY_SCOPE_AGENT) < 2u) { __builtin_amdgcn_s_sleep(8); if (++sp > (1u << 22)) break; }
                    __builtin_amdgcn_fence(__ATOMIC_ACQUIRE, "agent"); asm volatile("s_waitcnt vmcnt(0)" ::: "memory"); }
                __syncthreads();
                lru_combine(P, (size_t)w2 * (NWAVES * 64) + tid, (size_t)N2 * (NWAVES * 64));
            }
        }
    }
    SEAM(3);
    if (IN(4)) REPS(4) {
        gdn_gate_norm(P, (size_t)bx * (NWAVES * 64) + tid, (size_t)G * (NWAVES * 64));
        cvt_table_fp8(P.peer_u, ws + WS_UB, (float*)(ws + WS_USC), bx * NWAVES + wave, G * NWAVES, lane);
    }
    SEAM(4);
    if (IN(5)) {
        Gemm gm{(const bf16_t*)((const unsigned char*)P.out + OUT_Y), (const bf16_t*)(ws + WS_WOUT), T, 1024, 1024}; StaticOrder S; S.init(T, 1024, G, bx);
        EpiResidBf<true> E{P.x, XB, (float*)(ws + WS_SSQ1)};
        gemm_phase<EpiResidBf<true>, StaticOrder, PG8_ALIGN, PG8_SP2>(lds, gm, S, E);
    }
    SEAM(5);
    if (IN(6)) REPS(6) {
        Gemm gm{XB, (const bf16_t*)(ws + WS_WQ), T, 1024, 1024};
        EpiBf16Rs E{(bf16_t*)(ws + WS_Q), 1024, 4, nullptr, 256, 0, (const float*)(ws + WS_SSQ1), 0.0625f};
#if (TWICE_MASK >> 6) & 1
        { TwiceOrder S; S.S.init(T, 1024, G, bx); S.per = 1; S.reps = 2;
          gemm_phase<EpiBf16Rs, TwiceOrder, PG8_ALIGN, PG8_SP2>(lds, gm, S, E); }
#else
        { StaticOrder S; S.init(T, 1024, G, bx);
          gemm_phase<EpiBf16Rs, StaticOrder, PG8_ALIGN, PG8_SP2>(lds, gm, S, E); }
#endif
        Unit u;
        { const int wgid = (bx & 7) * 32 + (bx >> 3); u.pm = (wgid >> 5) * 8 + (wgid & 7); u.pn = (wgid & 31) >> 3; }
        if (G == 256) {
            asm volatile("s_waitcnt vmcnt(0)" ::: "memory");
            __syncthreads();
            const int b = u.pm >> 5, qb0 = (u.pm & 31) * 2, h = u.pn;
#pragma unroll 1
            for (int qq = 0; qq < (((TWICE_MASK >> 7) & 1) ? 4 : 2); ++qq) xattn_unit(P, lds, (b << 8) | ((qb0 + (qq & 1)) << 2) | h, tid, lane, wave);
        }
    }
    if (IN(7)) REPS(7) { }
    SEAM(7);
    if (IN(8)) {
        Gemm gm{(const bf16_t*)(ws + WS_AO), (const bf16_t*)(ws + WS_WO), T, 1024, 1024}; StaticOrder S; S.init(T, 1024, G, bx);
        EpiResidBf<false> E{nullptr, XB, (float*)(ws + WS_SSQ2)};
        gemm_phase<EpiResidBf<false>, StaticOrder, PG8_ALIGN, PG8_SP2>(lds, gm, S, E);
    }
    SEAM(8);
    if (IN(9)) REPS(9) {
        Gemm gm{XB, (const bf16_t*)(ws + WS_PWQ), T, 2048, 1024};
        EpiF16Rs E{(_Float16*)(ws + WS_PQ), 2048, (const float*)(ws + WS_SSQ2)};
#if (TWICE_MASK >> 9) & 1
        TwiceOrder S; S.S.init(T, 2048, G, bx); S.per = 2; S.reps = 2;
        gemm_phase<EpiF16Rs, TwiceOrder, PG8_ALIGN, PG8_SP2>(lds, gm, S, E);
#else
        StaticOrder S; S.init(T, 2048, G, bx);
        gemm_phase<EpiF16Rs, StaticOrder, PG8_ALIGN, PG8_SP2>(lds, gm, S, E);
#endif
    }
    SEAM(9);
    if (IN(10)) REPS(10) {
    }
    if (IN(11)) REPS(11) {
#if (TWICE_MASK >> 11) & 1
        for (int it = 0; it < 4; ++it) { const int tb = (bx * NWAVES + wave) * PE_NT + (it >> 1) * (G * NWAVES * PE_NT); if (tb < T) peer_pass(P, lds, tb, lane, wave, P.out, (it & 1) ? 0x3fff : PE_EXP_MASK); }
#else
        for (int tb = (bx * NWAVES + wave) * PE_NT; tb < T; tb += G * NWAVES * PE_NT) peer_pass(P, lds, tb, lane, wave, P.out);
#endif
    }
#undef IN
#undef SEAM
}

extern "C" void kernel_launch(void* const* d_in, const int* in_sizes, int n_in, void* d_out, int out_size, void* d_ws, size_t ws_size, hipStream_t stream) {
    static int grid = 0;
    if (grid == 0) {
        if (n_in != 27 || in_sizes[0] != T * D || out_size != T * D || ws_size < WS_END) {
            fprintf(stderr, "kernel_launch: unexpected shapes (n_in %d, in0 %d, out %d, ws %zu); nothing launched\n", n_in, n_in > 0 ? in_sizes[0] : -1, out_size, ws_size); grid = -1; return; }
        int dev = 0, cus = 0, per_cu = 0;
        if (hipGetDevice(&dev) != hipSuccess || hipDeviceGetAttribute(&cus, hipDeviceAttributeMultiprocessorCount, dev) != hipSuccess) { grid = -1; return; }
        if (hipFuncSetAttribute((const void*)hybrid_fwd, hipFuncAttributeMaxDynamicSharedMemorySize, LDS_BYTES) != hipSuccess) { fprintf(stderr, "kernel_launch: hipFuncSetAttribute failed\n"); grid = -1; return; }
        if (hipOccupancyMaxActiveBlocksPerMultiprocessor(&per_cu, (const void*)hybrid_fwd, NWAVES * 64, LDS_BYTES) != hipSuccess || per_cu < 1)
            fprintf(stderr, "kernel_launch: note: occupancy query reports %d workgroups per CU\n", per_cu);
        (void)hipGetLastError();
        grid = cus;
        if (grid != 256) fprintf(stderr, "kernel_launch: %d CUs (built for 256)\n", grid);
    }
    if (grid < 0) return;
    if (hipMemsetAsync((char*)d_ws + WS_CTL, 0, CTL_ZERO_BYTES, stream) != hipSuccess) { fprintf(stderr, "kernel_launch: hipMemsetAsync failed\n"); return; }
    Params p{};
    const float** pp = (const float**)&p;
    for (int i = 0; i < 27; ++i) pp[i] = (const float*)d_in[i];
    p.out = (float*)d_out; p.ws = (unsigned char*)d_ws;
#if MK_PER_PHASE
    for (int k = 0; k < N_PHASES; ++k) { p.ph_lo = k; p.ph_hi = k + 1; hipLaunchKernelGGL(hybrid_fwd, dim3(grid), dim3(NWAVES * 64), LDS_BYTES, stream, p); }
#else
    p.ph_lo = 0; p.ph_hi = N_PHASES;
    hipLaunchKernelGGL(hybrid_fwd, dim3(grid), dim3(NWAVES * 64), LDS_BYTES, stream, p);
#endif
    const hipError_t le = hipPeekAtLastError();
    if (le != hipSuccess) fprintf(stderr, "kernel_launch: launch failed: %s\n", hipGetErrorName(le));
}
```

```cpp
#include <hip/hip_runtime.h>
#include <cstdio>
#include <cstdint>
namespace pg8 {
#define PG8_LAS __attribute__((address_space(3)))
typedef unsigned short bf16_t;
typedef short bf16x8 __attribute__((ext_vector_type(8)));
typedef float f32x4 __attribute__((ext_vector_type(4)));
typedef unsigned u32x4 __attribute__((ext_vector_type(4)));
constexpr int BM = 256, BK = 64, HALF = 128, HTB = HALF * BK * 2  , STAGE_BYTES = 8 * HTB, NXCD = 8, WGM = 8;

__host__ __device__ __forceinline__ int lds_byte(int r, int c) { const int st = (r >> 4) * 2 + (c >> 5), rr = r & 15, cc = c & 31, ob = rr * 64 + cc * 2; return st * 1024 + (ob ^ (((ob >> 9) & 1) << 5)); }
__host__ __device__ __forceinline__ void stage_rc(int b, int& R, int& C) { const int st = b / 1024, sb = b % 1024, swz = sb ^ (((sb >> 9) & 1) << 5); R = (st >> 1) * 16 + swz / 64; C = (st & 1) * 32 + (swz % 64) / 2; }
__host__ __device__ __forceinline__ int perm32(int rho) { const int n = rho >> 4, i = rho & 15; return 8 * (i >> 2) + 4 * n + (i & 3); }

struct Unit { int pm, pn; };
struct Gemm { const bf16_t* A; const bf16_t* Bt; int M, N, K; };

struct StaticOrder {
    int nM, nN, nwg, G, c;
    __host__ __device__ void init(int M, int N, int G_, int c_) { nM = M / BM; nN = N / BM; nwg = nM * nN; G = G_; c = c_; }
    __host__ __device__ bool next(int i, Unit& u) const {
        const long L = (long)i * G + c; if (L >= nwg) return false;
        int wgid = (int)L; { const int q = nwg / NXCD, r = nwg % NXCD, xcd = wgid % NXCD, off = wgid / NXCD; wgid = (xcd < r ? xcd * (q + 1) : r * (q + 1) + (xcd - r) * q) + off; }
        const int nig = WGM * nN, gid = wgid / nig, fm = gid * WGM, gsz = (nM - fm) < WGM ? (nM - fm) : WGM;
        u.pm = fm + ((wgid % nig) % gsz); u.pn = (wgid % nig) / gsz; return true;
    }
    __device__ __forceinline__ void a_ready(const Unit&) const {}
    __device__ __forceinline__ void done(const Unit&) const {}
};

__device__ __forceinline__ unsigned cvt_pk_bf16(float lo, float hi) { unsigned r; asm volatile("v_cvt_pk_bf16_f32 %0, %1, %2" : "=v"(r) : "v"(lo), "v"(hi)); return r; }
template <class Epi, class Sched, bool ALIGN_EPI = false, bool SP2 = false>
__device__ __forceinline__ void gemm_phase(PG8_LAS unsigned char* lds, const Gemm g, const Sched& S, const Epi& E) {
    const int tid = threadIdx.x, wid = __builtin_amdgcn_readfirstlane(tid >> 6), lane = tid & 63, wr = wid >> 2, wc = wid & 3, fr = lane & 15, fq = lane >> 4;
    const int K = g.K, nt = K / BK;
    unsigned voffA[2], voffB[2];
#pragma unroll
    for (int i = 0; i < 2; ++i) { int R, C; stage_rc(tid * 16 + i * 8192, R, C); const int Rb = Epi::PERM ? ((R & ~31) + perm32(R & 31)) : R;
        voffA[i] = (unsigned)(R * K + C) * 2u; voffB[i] = (unsigned)(Rb * K + C) * 2u; }
    const size_t kstep = (size_t)(BK * 2);
    const size_t hstep = (size_t)HALF * K * 2;
    const size_t tstep = 2 * hstep;
    const unsigned ldsw = (unsigned)wid * 1024u;
    const int aoff = lds_byte(wr * 64 + fr, fq * 8), boff = lds_byte(wc * 32 + fr, fq * 8);
#define PG8_SA(b, h) (((b) * 2 + (h)) * HTB)
#define PG8_SB(b, h) ((4 + (b) * 2 + (h)) * HTB)
#define PG8_STAGE(bufoff, gbase, voff) do { _Pragma("unroll") for (int _i = 0; _i < 2; ++_i) \
        __builtin_amdgcn_global_load_lds((const unsigned*)((const char*)(gbase) + (voff)[_i]), (PG8_LAS unsigned*)(lds + (bufoff) + ldsw + _i * 8192), 16, 0, 0); } while (0)
#define PG8_LDA(dst, b, h) do { _Pragma("unroll") for (int m = 0; m < 4; ++m) _Pragma("unroll") for (int k = 0; k < 2; ++k) dst[m][k] = *(const PG8_LAS bf16x8*)(lds + PG8_SA(b, h) + aoff + m * 2048 + k * 1024); } while (0)
#define PG8_LDB(dst, b, h) do { _Pragma("unroll") for (int n = 0; n < 2; ++n) _Pragma("unroll") for (int k = 0; k < 2; ++k) dst[n][k] = *(const PG8_LAS bf16x8*)(lds + PG8_SB(b, h) + boff + n * 2048 + k * 1024); } while (0)
#define PG8_MMA(ai, bj, At, Bt) do { __builtin_amdgcn_s_setprio(1); _Pragma("unroll") for (int m = 0; m < 4; ++m) _Pragma("unroll") for (int n = 0; n < 2; ++n) _Pragma("unroll") for (int k = 0; k < 2; ++k) \
        acc[ai][bj][m][n] = __builtin_amdgcn_mfma_f32_16x16x32_bf16(Bt[n][k], At[m][k], acc[ai][bj][m][n], 0, 0, 0); __builtin_amdgcn_s_setprio(0); } while (0)
#define PG8_WAIT_V(n) asm volatile("s_waitcnt vmcnt(" #n ")" ::: "memory")
#define PG8_WAIT_L(n) asm volatile("s_waitcnt lgkmcnt(" #n ")" ::: "memory")
#define PG8_BAR __builtin_amdgcn_s_barrier()
#define PG8_SCHED __builtin_amdgcn_sched_barrier(0)
    Unit cur, nxt; int ui = 0;
    if (!S.next(0, cur)) return;
    f32x4 acc[2][2][4][2];
#pragma unroll
    for (int a = 0; a < 2; ++a)
#pragma unroll
        for (int b = 0; b < 2; ++b)
#pragma unroll
            for (int m = 0; m < 4; ++m)
#pragma unroll
                for (int n = 0; n < 2; ++n) acc[a][b][m][n] = (f32x4){0.f, 0.f, 0.f, 0.f};
    bf16x8 At[4][2], B0[2][2], B1[2][2];
    const char* cA = (const char*)g.A + (size_t)cur.pm * tstep; const char* cB = (const char*)g.Bt + (size_t)cur.pn * tstep;
    S.a_ready(cur);
    if constexpr (SP2) {
        PG8_STAGE(PG8_SB(0, 0), cB, voffB); PG8_STAGE(PG8_SB(0, 1), cB + hstep, voffB); PG8_STAGE(PG8_SA(0, 0), cA, voffA); PG8_STAGE(PG8_SA(0, 1), cA + hstep, voffA);
        if (wr == 1) PG8_BAR;
        PG8_WAIT_V(2); PG8_BAR;
        PG8_STAGE(PG8_SB(1, 0), cB + kstep, voffB); PG8_STAGE(PG8_SA(1, 0), cA + kstep, voffA); PG8_STAGE(PG8_SB(1, 1), cB + hstep + kstep, voffB);
        PG8_WAIT_V(6); PG8_BAR;
    } else {
        PG8_STAGE(PG8_SB(0, 0), cB, voffB); PG8_STAGE(PG8_SA(0, 0), cA, voffA); PG8_STAGE(PG8_SB(0, 1), cB + hstep, voffB); PG8_STAGE(PG8_SA(0, 1), cA + hstep, voffA);
        if (wr == 1) PG8_BAR;
        PG8_WAIT_V(4); PG8_BAR;
        PG8_STAGE(PG8_SB(1, 0), cB + kstep, voffB); PG8_STAGE(PG8_SA(1, 0), cA + kstep, voffA); PG8_STAGE(PG8_SB(1, 1), cB + hstep + kstep, voffB);
        PG8_WAIT_V(6); PG8_BAR;
    }
    for (;;) {
        const bool has_next = S.next(ui + 1, nxt);
        const char* nA = has_next ? (const char*)g.A + (size_t)nxt.pm * tstep : cA; const char* nB = has_next ? (const char*)g.Bt + (size_t)nxt.pn * tstep : cB;
        for (int t = 0; t < nt; t += 2) {
            const bool last = (t == nt - 2);
            const char* a1 = cA + (size_t)(t + 1) * kstep;
            const char* a2 = last ? nA : cA + (size_t)(t + 2) * kstep; const char* b2 = last ? nB : cB + (size_t)(t + 2) * kstep;
            const char* a3 = a2 + kstep; const char* b3 = b2 + kstep;
            if (last && has_next) S.a_ready(nxt);
            if constexpr (SP2) {
            PG8_LDB(B0, 0, 0); PG8_LDB(B1, 0, 1); PG8_SCHED; PG8_LDA(At, 0, 0); PG8_STAGE(PG8_SA(1, 1), a1 + hstep, voffA);
            PG8_WAIT_V(8); PG8_WAIT_L(0); PG8_BAR; PG8_MMA(0, 0, At, B0); PG8_MMA(0, 1, At, B1); PG8_BAR; PG8_SCHED;
            PG8_LDA(At, 0, 1); PG8_STAGE(PG8_SB(0, 0), b2, voffB); PG8_STAGE(PG8_SB(0, 1), b2 + hstep, voffB); PG8_STAGE(PG8_SA(0, 0), a2, voffA);
            PG8_WAIT_V(8); PG8_WAIT_L(0); PG8_BAR; PG8_MMA(1, 0, At, B0); PG8_MMA(1, 1, At, B1); PG8_BAR; PG8_SCHED;
            PG8_LDB(B0, 1, 0); PG8_LDB(B1, 1, 1); PG8_SCHED; PG8_LDA(At, 1, 0); PG8_STAGE(PG8_SA(0, 1), a2 + hstep, voffA);
            PG8_WAIT_V(8); PG8_WAIT_L(0); PG8_BAR; PG8_MMA(0, 0, At, B0); PG8_MMA(0, 1, At, B1); PG8_BAR; PG8_SCHED;
            PG8_LDA(At, 1, 1); PG8_STAGE(PG8_SB(1, 0), b3, voffB); PG8_STAGE(PG8_SB(1, 1), b3 + hstep, voffB); PG8_STAGE(PG8_SA(1, 0), a3, voffA);
            PG8_WAIT_V(8); PG8_WAIT_L(0); PG8_BAR; PG8_MMA(1, 0, At, B0); PG8_MMA(1, 1, At, B1); PG8_BAR; PG8_SCHED;
            } else {
            PG8_LDB(B0, 0, 0); PG8_SCHED; PG8_LDA(At, 0, 0); PG8_STAGE(PG8_SA(1, 1), a1 + hstep, voffA);
            PG8_WAIT_L(8); PG8_BAR; PG8_WAIT_L(0); PG8_MMA(0, 0, At, B0); PG8_BAR; PG8_SCHED;
            PG8_LDB(B1, 0, 1); PG8_STAGE(PG8_SB(0, 0), b2, voffB);
            PG8_BAR; PG8_WAIT_L(0); PG8_MMA(0, 1, At, B1); PG8_BAR;
            PG8_LDA(At, 0, 1); PG8_STAGE(PG8_SA(0, 0), a2, voffA);
            PG8_BAR; PG8_WAIT_L(0); PG8_MMA(1, 0, At, B0); PG8_BAR; PG8_SCHED;
            PG8_STAGE(PG8_SB(0, 1), b2 + hstep, voffB);
            PG8_WAIT_V(6); PG8_BAR; PG8_MMA(1, 1, At, B1); PG8_BAR;
            PG8_LDB(B0, 1, 0); PG8_SCHED; PG8_LDA(At, 1, 0); PG8_STAGE(PG8_SA(0, 1), a2 + hstep, voffA);
            PG8_WAIT_L(8); PG8_BAR; PG8_WAIT_L(0); PG8_MMA(0, 0, At, B0); PG8_BAR; PG8_SCHED;
            PG8_LDB(B1, 1, 1); PG8_STAGE(PG8_SB(1, 0), b3, voffB);
            PG8_BAR; PG8_WAIT_L(0); PG8_MMA(0, 1, At, B1); PG8_BAR;
            PG8_LDA(At, 1, 1); PG8_STAGE(PG8_SA(1, 0), a3, voffA);
            PG8_BAR; PG8_WAIT_L(0); PG8_MMA(1, 0, At, B0); PG8_BAR; PG8_SCHED;
            PG8_STAGE(PG8_SB(1, 1), b3 + hstep, voffB);
            PG8_WAIT_V(6); PG8_BAR; PG8_MMA(1, 1, At, B1); PG8_BAR;
            }
        }
        if constexpr (ALIGN_EPI) { if (wr == 0) PG8_BAR; }
        if constexpr (!Epi::AFTER_DRAIN) { E(acc, cur, wr, wc, fr, fq); S.done(cur); }
        if (!has_next) break;
#pragma unroll
        for (int a = 0; a < 2; ++a)
#pragma unroll
            for (int b = 0; b < 2; ++b)
#pragma unroll
                for (int m = 0; m < 4; ++m)
#pragma unroll
                    for (int n = 0; n < 2; ++n) acc[a][b][m][n] = (f32x4){0.f, 0.f, 0.f, 0.f};
        cur = nxt; cA = nA; cB = nB; ++ui;
        if constexpr (ALIGN_EPI) { if (wr == 1) PG8_BAR; }
    }
    PG8_WAIT_V(0);
    if constexpr (!ALIGN_EPI) { if (wr == 0) PG8_BAR; }
    PG8_BAR;
    if constexpr (Epi::AFTER_DRAIN) { E.fused(acc, cur, wr, wc, fr, fq, lds, wid, lane); S.done(cur); }
#undef PG8_SA
#undef PG8_SB
#undef PG8_STAGE
#undef PG8_LDA
#undef PG8_LDB
#undef PG8_MMA
#undef PG8_WAIT_V
#undef PG8_WAIT_L
#undef PG8_BAR
#undef PG8_SCHED
}
}

namespace pg8 {
__host__ __device__ __forceinline__ int permk(int kl) { return 8 * ((kl & 15) >> 2) + 4 * (kl >> 4) + (kl & 3); }
struct EpiBf16Rs {
    static constexpr bool PERM = true, AFTER_DRAIN = false;
    bf16_t* O0; int ld0; int ntile0; bf16_t* O1; int ld1; size_t stride1; const float* ssq; float cs;
    __device__ __forceinline__ void operator()(const f32x4 (&acc)[2][2][4][2], const Unit& u, int wr, int wc, int fr, int fq) const {
        bf16_t* base; int ld, colt;
        if (u.pn < ntile0) { base = O0; ld = ld0; colt = u.pn * BM; }
        else { const int q = u.pn - ntile0, per = ld1 / BM; base = O1 + (size_t)(q / per) * stride1; ld = ld1; colt = (q % per) * BM; }
        const int row0 = u.pm * BM + wr * 64 + fr, col0 = colt + wc * 32 + 8 * fq;
#pragma unroll
        for (int ai = 0; ai < 2; ++ai)
#pragma unroll
            for (int m = 0; m < 4; ++m) {
                const int row = row0 + ai * HALF + m * 16;
                float sc = cs; if (ssq) sc *= rsqrtf(ssq[row] * (1.0f / 1024.0f) + 1e-6f);
                bf16_t* rowp = base + (size_t)row * ld + col0;
#pragma unroll
                for (int bj = 0; bj < 2; ++bj) { const f32x4 v0 = acc[ai][bj][m][0] * sc, v1 = acc[ai][bj][m][1] * sc;
                    u32x4 w; w.x = cvt_pk_bf16(v0[0], v0[1]); w.y = cvt_pk_bf16(v0[2], v0[3]); w.z = cvt_pk_bf16(v1[0], v1[1]); w.w = cvt_pk_bf16(v1[2], v1[3]);
                    *(u32x4*)(rowp + bj * HALF) = w; } }
    }
};
struct EpiF16Rs {
    static constexpr bool PERM = true, AFTER_DRAIN = false;
    _Float16* O; int ld; const float* ssq;
    __device__ __forceinline__ void operator()(const f32x4 (&acc)[2][2][4][2], const Unit& u, int wr, int wc, int fr, int fq) const {
        typedef _Float16 f16x8 __attribute__((ext_vector_type(8)));
        const int row0 = u.pm * BM + wr * 64 + fr, col0 = u.pn * BM + wc * 32 + 8 * fq;
#pragma unroll
        for (int ai = 0; ai < 2; ++ai)
#pragma unroll
            for (int m = 0; m < 4; ++m) {
                const int row = row0 + ai * HALF + m * 16;
                const float sc = rsqrtf(ssq[row] * (1.0f / 1024.0f) + 1e-6f);
                _Float16* rowp = O + (size_t)row * ld + col0;
#pragma unroll
                for (int bj = 0; bj < 2; ++bj) { const f32x4 v0 = acc[ai][bj][m][0] * sc, v1 = acc[ai][bj][m][1] * sc;
                    f16x8 w; w[0] = (_Float16)v0[0]; w[1] = (_Float16)v0[1]; w[2] = (_Float16)v0[2]; w[3] = (_Float16)v0[3];
                    w[4] = (_Float16)v1[0]; w[5] = (_Float16)v1[1]; w[6] = (_Float16)v1[2]; w[7] = (_Float16)v1[3];
                    *(f16x8*)(rowp + bj * HALF) = w; } }
    }
};
template <bool BASE_F32> struct EpiResidBf {
    static constexpr bool PERM = true, AFTER_DRAIN = false;
    const float* basef; bf16_t* xb; float* ssq;
    __device__ __forceinline__ void operator()(const f32x4 (&acc)[2][2][4][2], const Unit& u, int wr, int wc, int fr, int fq) const {
        const int row0 = u.pm * BM + wr * 64 + fr, col0 = u.pn * BM + wc * 32 + 8 * fq;
#pragma unroll
        for (int ai = 0; ai < 2; ++ai)
#pragma unroll
            for (int m = 0; m < 4; ++m) {
                const int row = row0 + ai * HALF + m * 16; const size_t off = (size_t)row * 1024 + col0; float s = 0.f;
#pragma unroll
                for (int bj = 0; bj < 2; ++bj) { const size_t o2 = off + bj * HALF;
                    f32x4 b0, b1;
                    if (BASE_F32) { b0 = *(const f32x4*)(basef + o2); b1 = *(const f32x4*)(basef + o2 + 4); }
                    else { const u32x4 p = *(const u32x4*)(xb + o2);
                        b0 = (f32x4){__builtin_bit_cast(float, p.x << 16), __builtin_bit_cast(float, p.x & 0xffff0000u), __builtin_bit_cast(float, p.y << 16), __builtin_bit_cast(float, p.y & 0xffff0000u)};
                        b1 = (f32x4){__builtin_bit_cast(float, p.z << 16), __builtin_bit_cast(float, p.z & 0xffff0000u), __builtin_bit_cast(float, p.w << 16), __builtin_bit_cast(float, p.w & 0xffff0000u)}; }
                    const f32x4 o0 = b0 + acc[ai][bj][m][0], o1 = b1 + acc[ai][bj][m][1];
                    s += ((o0[0] * o0[0] + o0[1] * o0[1]) + (o0[2] * o0[2] + o0[3] * o0[3])) + ((o1[0] * o1[0] + o1[1] * o1[1]) + (o1[2] * o1[2] + o1[3] * o1[3]));
                    u32x4 w; w.x = cvt_pk_bf16(o0[0], o0[1]); w.y = cvt_pk_bf16(o0[2], o0[3]); w.z = cvt_pk_bf16(o1[0], o1[1]); w.w = cvt_pk_bf16(o1[2], o1[3]);
                    *(u32x4*)(xb + o2) = w; }
                s += __shfl_xor(s, 16); s += __shfl_xor(s, 32);
                if (fq == 0) atomicAdd(ssq + row, s);
            }
    }
};
struct EpiKV {
    static constexpr bool PERM = false, AFTER_DRAIN = false;
    bf16_t* Kb; bf16_t* VTp;
    __device__ __forceinline__ void operator()(const f32x4 (&acc)[2][2][4][2], const Unit& u, int wr, int wc, int fr, int fq) const {
        typedef unsigned u32x2v __attribute__((ext_vector_type(2)));
        const int row0 = u.pm * BM + wr * 64 + fr, col0 = u.pn * BM + wc * 32 + 4 * fq;
#pragma unroll
        for (int ai = 0; ai < 2; ++ai)
#pragma unroll
            for (int m = 0; m < 4; ++m) {
                const int row = row0 + ai * HALF + m * 16, b = row >> 8, key = row & 255;
#pragma unroll
                for (int bj = 0; bj < 2; ++bj)
#pragma unroll
                    for (int n = 0; n < 2; ++n) { const int col = col0 + bj * HALF + n * 16; const f32x4 v = acc[ai][bj][m][n];
                        const unsigned p01 = cvt_pk_bf16(v[0], v[1]), p23 = cvt_pk_bf16(v[2], v[3]);
                        if (col < 1024) { const int h = col >> 8, dh = col & 255; u32x2v w; w.x = p01; w.y = p23;
                            *(u32x2v*)(Kb + ((size_t)((b * 4 + h) * 256 + key)) * 256 + dh) = w; }
                        else { const int c2 = col - 1024, h = c2 >> 8, dv = c2 & 255, kp = (key & ~31) | permk(key & 31);
                            bf16_t* d = VTp + ((size_t)((b * 4 + h) * 256 + dv)) * 256 + kp;
                            d[0] = (bf16_t)(p01 & 0xffffu); d[256] = (bf16_t)(p01 >> 16); d[512] = (bf16_t)(p23 & 0xffffu); d[768] = (bf16_t)(p23 >> 16); } }
            }
    }
};
}
#ifndef PG8_SP2
#define PG8_SP2 true
#endif
#ifndef PG8_ALIGN
#define PG8_ALIGN true
#endif

constexpr int NWAVES = 8;
#ifndef MK_PER_PHASE
#define MK_PER_PHASE 0
#endif
constexpr int T = 16384, SEQ = 8192, D = 1024;
constexpr int N_PHASES = 12;

constexpr size_t MiB = 1u << 20, KiB = 1u << 10;
constexpr size_t WS_CTL = 0, CTL_ZERO_BYTES = 1 * MiB;
constexpr int CW_BAR = 4096;
constexpr size_t WS_SSQ1 = 64 * KiB, WS_SSQ2 = 128 * KiB;
constexpr size_t WS_AB = 1 * MiB;
constexpr size_t WS_HEND = WS_AB + 512 * KiB, WS_PEND = WS_HEND + 512 * KiB, WS_HIN = WS_PEND + 512 * KiB;
constexpr size_t WS_DEC = WS_HIN + 512 * KiB;
constexpr size_t WS_SUBK = 3 * MiB + 256 * KiB;
constexpr size_t WS_WIN = 4 * MiB, WS_WOUT = 10 * MiB, WS_WQ = 12 * MiB, WS_WKV = 14 * MiB, WS_WO = 18 * MiB, WS_PWQ = 20 * MiB;
constexpr size_t WS_MEMN = 24 * MiB, WS_KB = 25 * MiB, WS_VTP = 26 * MiB, WS_LRUWT = 27 * MiB, WS_USC = 27 * MiB + 256 * KiB, WS_VSC = 27 * MiB + 384 * KiB;
constexpr size_t WS_XB = 28 * MiB;
constexpr size_t WS_HLOC = 28 * MiB, WS_PCUM = 44 * MiB;
constexpr size_t WS_QKV = 60 * MiB;
constexpr size_t OUT_Y = 4 * MiB;
constexpr size_t OUT_END = OUT_Y + (size_t)16384 * 1024 * 2;
constexpr size_t WS_IDX = 60 * MiB, WS_GW = 68 * MiB;
constexpr size_t WS_UB = 60 * MiB;
constexpr size_t WS_XR = 108 * MiB, WS_Z = 124 * MiB, WS_GATE = 140 * MiB;
constexpr size_t WS_WN = 156 * MiB, WS_UF = 172 * MiB, WS_QD = 188 * MiB, WS_KD = 204 * MiB, WS_ATT = 220 * MiB;
constexpr size_t WS_VB = 228 * MiB;
constexpr size_t WS_Q = 188 * MiB, WS_AO = 124 * MiB;
constexpr size_t WS_PQ = 108 * MiB;
constexpr size_t WS_END = 244 * MiB;
constexpr int CW_GFLAG = 49152;
constexpr int CW_LRUCNT = 8192;
static_assert(WS_XR - WS_QKV == (size_t)T * 1536 * 2 && WS_Z - WS_XR == (size_t)T * 512 * 2 && WS_GATE - WS_Z == (size_t)T * 512 * 2, "in-proj outputs are contiguous");

constexpr int LDS_BYTES = 160 * 1024;
constexpr int MISC_OFF = 159 * 1024;

#define GAS __attribute__((address_space(1)))
#define LAS __attribute__((address_space(3)))
typedef unsigned short bf16;
typedef unsigned v4u __attribute__((ext_vector_type(4)));
typedef unsigned v2u __attribute__((ext_vector_type(2)));
typedef float f32x4 __attribute__((ext_vector_type(4)));
typedef short bf16x8 __attribute__((ext_vector_type(8)));
typedef GAS unsigned gu32;
#define LDS_WAIT() asm volatile("s_waitcnt lgkmcnt(0)" ::: "memory")
__device__ __forceinline__ void st16_wt(void* p, v4u v) { asm volatile("global_store_dwordx4 %0, %1, off sc0 sc1\n\ts_nop 1" :: "v"(p), "v"(v) : "memory"); }
__device__ __forceinline__ unsigned f2bf(float f) { unsigned u = __builtin_bit_cast(unsigned, f); return (u + 0x7fffu + ((u >> 16) & 1u)) >> 16; }
__device__ __forceinline__ unsigned pk2(float lo, float hi) { return f2bf(lo) | (f2bf(hi) << 16); }
__device__ __forceinline__ float bflo(unsigned u) { return __builtin_bit_cast(float, u << 16); }
__device__ __forceinline__ float bfhi(unsigned u) { return __builtin_bit_cast(float, u & 0xffff0000u); }
__device__ __forceinline__ float bf1(bf16 h) { return __builtin_bit_cast(float, (unsigned)h << 16); }
__device__ __forceinline__ float wave_sum(float v) {
#pragma unroll
    for (int o = 1; o < 64; o <<= 1) v += __shfl_xor(v, o);
    return v;
}
__device__ __forceinline__ float row16_sum(float v) {
    v += __builtin_bit_cast(float, __builtin_amdgcn_update_dpp(0, __builtin_bit_cast(int, v), 0xB1, 0xF, 0xF, true));
    v += __builtin_bit_cast(float, __builtin_amdgcn_update_dpp(0, __builtin_bit_cast(int, v), 0x4E, 0xF, 0xF, true));
    v += __builtin_bit_cast(float, __builtin_amdgcn_update_dpp(0, __builtin_bit_cast(int, v), 0x141, 0xF, 0xF, true));
    v += __builtin_bit_cast(float, __builtin_amdgcn_update_dpp(0, __builtin_bit_cast(int, v), 0x140, 0xF, 0xF, true));
    return v;
}
__device__ __forceinline__ float sigmoidf_(float x) { return __builtin_amdgcn_rcpf(1.0f + __expf(-x)); }
__device__ __forceinline__ float softplusf_(float x) { return fmaxf(x, 0.f) + log1pf(__expf(-fabsf(x))); }
__device__ __forceinline__ float siluf_(float x) { return x * __builtin_amdgcn_rcpf(1.0f + __expf(-x)); }
__device__ __forceinline__ float gelu_tanh(float x) { const float y = 0.7978845608028654f * (x + 0.044715f * x * x * x); const float e = __expf(2.0f * y); return x * (1.0f - __builtin_amdgcn_rcpf(1.0f + e)); }
__device__ __forceinline__ int permk(int kl) { return 8 * ((kl & 15) >> 2) + 4 * (kl >> 4) + (kl & 3); }

struct Params {
    const float *x, *mem, *norm_mix_w, *w_in, *conv_qkv_w, *gdn_a_log, *gdn_dt_bias, *gdn_norm_w, *lru_conv_w, *lru_conv_b, *lru_wa, *lru_ba, *lru_wx, *lru_bx, *lru_lambda, *w_out,
                *norm_xattn_w, *norm_mem_w, *xattn_wq, *xattn_wkv, *xattn_wo, *norm_ffn_w, *peer_wq, *peer_subkeys, *peer_u, *peer_v, *norm_final_w;
    float* out; unsigned char* ws; int ph_lo, ph_hi;
};
#define XB_TMO      128
#define XB_XCNT(j)  (256  + 64 * (j))
#define XB_XSUB(j)  (1280 + 64 * (j))
#define XB_XGEN(j)  (2304 + 64 * (j))
#define XB_TOP      3328
#define XB_TOPGEN   3392
#define XCD_BAR_WORDS 3456
#define XB_SPIN_CAP (1u << 18)

__device__ __forceinline__ unsigned xb_ld(unsigned* p)              { return __hip_atomic_load(p, __ATOMIC_RELAXED, __HIP_MEMORY_SCOPE_AGENT); }
__device__ __forceinline__ unsigned xb_add(unsigned* p, unsigned v) { return __hip_atomic_fetch_add(p, v, __ATOMIC_RELAXED, __HIP_MEMORY_SCOPE_AGENT); }
__device__ __forceinline__ unsigned xb_xcc_id() { return (unsigned)__builtin_amdgcn_s_getreg((3 << 11) | 20) & 0xFu; }
#define XB_SPIN(cond, bar) do { unsigned _sp = 0; while (cond) { __builtin_amdgcn_s_sleep(1); \
    if ((++_sp & 255u) == 0u) { if (xb_ld(&(bar)[XB_TMO])) break; if (_sp > XB_SPIN_CAP) { atomicAdd(&(bar)[XB_TMO], 1u); break; } } } } while (0)

struct XcdBarrier {
    unsigned* bar; unsigned x;
    volatile LAS unsigned* st;
};

__device__ __forceinline__ XcdBarrier xcd_barrier_post(unsigned* bar, volatile LAS unsigned* st) {
    XcdBarrier b; b.bar = bar; b.x = xb_xcc_id(); b.st = st;
    if (threadIdx.x == 0) (void)xb_add(&bar[XB_XCNT(b.x)], 1u);
    return b;
}
__device__ __forceinline__ void xcd_barrier_complete(unsigned* bar, unsigned x, unsigned& nloc, unsigned& nx) {
    const unsigned G = gridDim.x * gridDim.y * gridDim.z;
    unsigned sum, cnt, mine, sp = 0u;
    for (;;) {
        sum = 0u; cnt = 0u; mine = 0u;
#pragma unroll
        for (unsigned j = 0; j < 16; ++j) { const unsigned c = xb_ld(&bar[XB_XCNT(j)]); sum += c; cnt += (c > 0u) ? 1u : 0u; mine = (j == x) ? c : mine; }
        if (sum == G) break;
        __builtin_amdgcn_s_sleep(1);
        if ((++sp & 255u) == 0u) { if (xb_ld(&bar[XB_TMO])) break; if (sp > XB_SPIN_CAP) { atomicAdd(&bar[XB_TMO], 1u); break; } }
    }
    nloc = mine > 0u ? mine : 1u; nx = cnt > 0u ? cnt : 1u;
}

__device__ __forceinline__ void xcd_barrier(const XcdBarrier& b) {
    asm volatile("s_waitcnt vmcnt(0)" ::: "memory");
    __syncthreads();
    if (threadIdx.x == 0) {
        unsigned* bar = b.bar;
        __builtin_amdgcn_s_waitcnt(0);
        unsigned nloc = b.st[0], nx = b.st[1];
        if (nloc == 0u) { xcd_barrier_complete(bar, b.x, nloc, nx); b.st[0] = nloc; b.st[1] = nx; }
        const unsigned old = xb_add(&bar[XB_XSUB(b.x)], 1u);
        const unsigned gen = old / nloc;
        if (old + 1u == (gen + 1u) * nloc) {
            __builtin_amdgcn_fence(__ATOMIC_RELEASE, "agent");
            asm volatile("s_waitcnt vmcnt(0)" ::: "memory");
            const unsigned og = xb_add(&bar[XB_TOP], 1u);
            const unsigned tg = og / nx;
            if (og + 1u == (tg + 1u) * nx) xb_add(&bar[XB_TOPGEN], 1u);
            else XB_SPIN(xb_ld(&bar[XB_TOPGEN]) == tg, bar);
            __builtin_amdgcn_fence(__ATOMIC_ACQUIRE, "agent");
            xb_add(&bar[XB_XGEN(b.x)], 1u);
            asm volatile("s_waitcnt vmcnt(0)" ::: "memory");
        } else {
            XB_SPIN(xb_ld(&bar[XB_XGEN(b.x)]) == gen, bar);
            __builtin_amdgcn_fence(__ATOMIC_ACQUIRE, "agent");
            asm volatile("s_waitcnt vmcnt(0)" ::: "memory");
        }
    }
    __syncthreads();
}

__device__ __forceinline__ void p0_transpose_item(const float* W, int K, int ldw, int c0, int nblk, bf16* WT, int row_off, const float* ks, LAS float* scr, int item, int lane) {
    const int kb = item / nblk, nb = item % nblk, k0 = 64 * kb, n0 = 32 * nb;
#pragma unroll 8
    for (int i = 0; i < 32; ++i) { const int kk = 2 * i + (lane >> 5); float v = W[(size_t)(k0 + kk) * ldw + c0 + n0 + (lane & 31)]; if (ks) v *= ks[k0 + kk]; scr[kk * 33 + (lane & 31)] = v; }
    LDS_WAIT(); asm volatile("" ::: "memory");
    const int c = lane & 7;
#pragma unroll
    for (int j = 0; j < 4; ++j) { const int n = (lane >> 3) + 8 * j; const LAS float* s = scr + (8 * c) * 33 + n;
        v4u o; o.x = pk2(s[0 * 33], s[1 * 33]); o.y = pk2(s[2 * 33], s[3 * 33]); o.z = pk2(s[4 * 33], s[5 * 33]); o.w = pk2(s[6 * 33], s[7 * 33]);
        *(GAS v4u*)(WT + (size_t)(row_off + n0 + n) * K + k0 + 8 * c) = o; }
    LDS_WAIT(); asm volatile("" ::: "memory");
}

__device__ __forceinline__ void p0_prologue(const Params& P, LAS unsigned char* lds, int tid, int lane, int wave, int vcu, int G) {
    unsigned char* ws = P.ws;
    const int gw = vcu * NWAVES + wave, NGW = G * NWAVES;
    LAS float* wabl = (LAS float*)lds;
    for (int idx = tid; idx < 8192; idx += NWAVES * 64) { const int k = idx >> 3, c = idx & 7, j = k >> 8, l = (k >> 2) & 63, e = k & 3;
        wabl[((((j * 4 + e) * 2 + (c >> 2)) * 64 + l) << 2) + (c & 3)] = P.w_in[(size_t)k * 3080 + 2048 + c]; }
    __syncthreads();
    {
        bf16* XB0 = (bf16*)(ws + WS_XB); float* AB = (float*)(ws + WS_AB);
        f32x4 w4[4];
#pragma unroll
        for (int j = 0; j < 4; ++j) w4[j] = ((const f32x4*)P.norm_mix_w)[64 * j + lane];
        for (int m = gw; m < T; m += NGW) {
            const f32x4* xr = (const f32x4*)(P.x + (size_t)m * D) + lane;
            f32x4 v[4]; float s = 0.f;
#pragma unroll
            for (int j = 0; j < 4; ++j) { v[j] = xr[64 * j]; s += (v[j].x * v[j].x + v[j].y * v[j].y) + (v[j].z * v[j].z + v[j].w * v[j].w); }
            const float rstd = rsqrtf(wave_sum(s) * (1.0f / D) + 1e-6f);
            v2u* o8 = (v2u*)(XB0 + (size_t)m * D) + lane;
            float part[8];
#pragma unroll
            for (int c = 0; c < 8; ++c) part[c] = 0.f;
#pragma unroll
            for (int j = 0; j < 4; ++j) {
                v[j] = v[j] * rstd * w4[j];
                v2u o; o.x = pk2(v[j].x, v[j].y); o.y = pk2(v[j].z, v[j].w); o8[64 * j] = o;
#pragma unroll
                for (int e = 0; e < 4; ++e) {
                    const f32x4 wa = *(const LAS f32x4*)(wabl + ((((j * 4 + e) * 2 + 0) * 64 + lane) << 2));
                    const f32x4 wb = *(const LAS f32x4*)(wabl + ((((j * 4 + e) * 2 + 1) * 64 + lane) << 2));
                    const float hv = v[j][e];
                    part[0] += hv * wa.x; part[1] += hv * wa.y; part[2] += hv * wa.z; part[3] += hv * wa.w;
                    part[4] += hv * wb.x; part[5] += hv * wb.y; part[6] += hv * wb.z; part[7] += hv * wb.w;
                }
            }
#pragma unroll
            for (int c = 0; c < 8; ++c) part[c] = wave_sum(part[c]);
            float o = part[0];
#pragma unroll
            for (int c = 1; c < 8; ++c) o = (lane == c) ? part[c] : o;
            if (lane < 8) AB[(size_t)m * 8 + lane] = o;
        }
    }
    {
        bf16* MEMN = (bf16*)(ws + WS_MEMN);
        for (int m = gw; m < 512; m += NGW) {
            const f32x4* xr = (const f32x4*)(P.mem + (size_t)m * D) + lane;
            f32x4 v[4]; float s = 0.f;
#pragma unroll
            for (int j = 0; j < 4; ++j) { v[j] = xr[64 * j]; s += (v[j].x * v[j].x + v[j].y * v[j].y) + (v[j].z * v[j].z + v[j].w * v[j].w); }
            const float rstd = rsqrtf(wave_sum(s) * (1.0f / D) + 1e-6f);
            v2u* o8 = (v2u*)(MEMN + (size_t)m * D) + lane;
#pragma unroll
            for (int j = 0; j < 4; ++j) { const f32x4 w = ((const f32x4*)P.norm_mem_w)[64 * j + lane]; const f32x4 y = v[j] * rstd * w;
                v2u o; o.x = pk2(y.x, y.y); o.y = pk2(y.z, y.w); o8[64 * j] = o; }
        }
    }
    __syncthreads();
    {
        LAS float* scr = (LAS float*)(lds + wave * 16384);
        constexpr int I_IN1 = 16 * 48, I_IN2 = 16 * 16, I_KV = 16 * 64;
        constexpr int NITEMS = I_IN1 + 3 * I_IN2 + I_KV;
        for (int it = gw; it < NITEMS; it += NGW) {
            int r = it;
            if (r < I_IN1) { p0_transpose_item(P.w_in, 1024, 3080, 0, 48, (bf16*)(ws + WS_WIN), 0, nullptr, scr, r, lane); continue; } r -= I_IN1;
            if (r < I_IN2) { p0_transpose_item(P.w_in, 1024, 3080, 2056, 16, (bf16*)(ws + WS_WIN), 1536, nullptr, scr, r, lane); continue; } r -= I_IN2;
            if (r < I_IN2) { p0_transpose_item(P.w_in, 1024, 3080, 1536, 16, (bf16*)(ws + WS_WIN), 2048, nullptr, scr, r, lane); continue; } r -= I_IN2;
            if (r < I_IN2) { p0_transpose_item(P.w_in, 1024, 3080, 2568, 16, (bf16*)(ws + WS_WIN), 2560, nullptr, scr, r, lane); continue; } r -= I_IN2;
            p0_transpose_item(P.xattn_wkv, 1024, 2048, 0, 64, (bf16*)(ws + WS_WKV), 0, nullptr, scr, r, lane);
        }
    }
    {
        bf16* WT = (bf16*)(ws + WS_LRUWT);
        for (int it = vcu * NWAVES * 64 + tid; it < 8 * 2 * 64 * 8; it += G * NWAVES * 64) {
            const int i8 = it & 7, j = (it >> 3) & 63, m = (it >> 9) & 1, g = it >> 10;
            const float* src = (m ? P.lru_wx : P.lru_wa) + (size_t)(g * 64 + 8 * i8) * 64 + j;
            v4u o; o.x = pk2(src[0], src[64]); o.y = pk2(src[128], src[192]); o.z = pk2(src[256], src[320]); o.w = pk2(src[384], src[448]);
            *(v4u*)(WT + (size_t)it * 8) = o;
        }
    }
}

__device__ __forceinline__ void late_weight_prep(const Params& P, LAS unsigned char* lds, int lane, int wave, int gw, int NGW) {
    unsigned char* ws = P.ws;
    {
        LAS float* scr = (LAS float*)(lds + wave * 16384);
        constexpr int I_OUT = 16 * 32, I_Q = 16 * 32, I_O = 16 * 32;
        for (int it = gw; it < I_OUT + I_Q + I_O; it += NGW) {
            int r = it;
            if (r < I_OUT) { p0_transpose_item(P.w_out, 1024, 1024, 0, 32, (bf16*)(ws + WS_WOUT), 0, nullptr, scr, r, lane); continue; } r -= I_OUT;
            if (r < I_Q) { p0_transpose_item(P.xattn_wq, 1024, 1024, 0, 32, (bf16*)(ws + WS_WQ), 0, P.norm_xattn_w, scr, r, lane); continue; } r -= I_Q;
            p0_transpose_item(P.xattn_wo, 1024, 1024, 0, 32, (bf16*)(ws + WS_WO), 0, nullptr, scr, r, lane);
        }
    }
    {
        bf16* WF = (bf16*)(ws + WS_PWQ);
        const int col = lane & 15, g = lane >> 4;
        for (int it = gw; it < 16 * 64; it += NGW) {
            const int hp = it >> 6, k0 = (it & 63) * 16;
            bf16x8 bq[4];
#pragma unroll
            for (int s = 0; s < 4; ++s) { const f32x4* src = (const f32x4*)(P.peer_wq + (size_t)(k0 + col) * 2048 + hp * 128 + 32 * s + 8 * g);
                const f32x4 a = src[0], c = src[1]; v4u pk; pk.x = pk2(a.x, a.y); pk.y = pk2(a.z, a.w); pk.z = pk2(c.x, c.y); pk.w = pk2(c.z, c.w); bq[s] = __builtin_bit_cast(bf16x8, pk); }
            const float nw = P.norm_ffn_w[k0 + col];
#pragma unroll 2
            for (int kt = 0; kt < 8; ++kt) {
                f32x4 acc = (f32x4){0.f, 0.f, 0.f, 0.f};
#pragma unroll
                for (int s = 0; s < 4; ++s) { const f32x4* src = (const f32x4*)(P.peer_subkeys + (size_t)(hp * 128 + 16 * kt + col) * 128 + 32 * s + 8 * g);
                    const f32x4 a = src[0], c = src[1]; v4u pk; pk.x = pk2(a.x, a.y); pk.y = pk2(a.z, a.w); pk.z = pk2(c.x, c.y); pk.w = pk2(c.z, c.w);
                    acc = __builtin_amdgcn_mfma_f32_16x16x32_bf16(__builtin_bit_cast(bf16x8, pk), bq[s], acc, 0, 0, 0); }
#pragma unroll
                for (int i = 0; i < 4; ++i) WF[(size_t)(hp * 128 + 16 * kt + 4 * g + i) * 1024 + k0 + col] = (bf16)f2bf(acc[i] * nw);
            }
        }
    }
}

constexpr int GL_KS = 0, GL_VS = 33792, GL_KB = 67584, GL_QB = 84992, GL_RAW = 102400, GL_CW = 153856, GL_AMT = 133120, GL_SM = 160000, GL_ATT = 151808, GL_SOL = 67584;
static_assert(GL_CW + 6144 <= GL_SM && GL_SM + 1284 <= MISC_OFF && GL_SOL + 65536 <= GL_AMT && GL_AMT + 17408 <= GL_ATT && GL_ATT + 8192 <= GL_SM && GL_RAW + 51456 <= GL_CW, "gdn_local LDS map");
#ifndef GL_REP_STEP
#define GL_REP_STEP -1
#endif
#define GL_REPF(k) for (int rr_ = 0; rr_ < ((GL_REP_STEP == (k)) ? 2 : 1); ++rr_)
#define GL_BAR() do { asm volatile("s_waitcnt lgkmcnt(0)" ::: "memory"); __builtin_amdgcn_s_barrier(); asm volatile("" ::: "memory"); } while (0)
__device__ __forceinline__ void gdn_local_item(const Params& P, LAS unsigned char* lds, int item, int tid) {
    unsigned char* ws = P.ws;
    asm volatile("" : "+v"(tid));
    const int b = item >> 9, h = (item >> 7) & 3, n = item & 127;
    const int t0 = b * SEQ + n * 64;
    const int lane = tid & 63, wave = __builtin_amdgcn_readfirstlane(tid >> 6);
    LAS float* ks = (LAS float*)(lds + GL_KS);
    LAS float* vs = (LAS float*)(lds + GL_VS);
    LAS bf16* kb16 = (LAS bf16*)(lds + GL_KB);
    LAS bf16* qb16 = (LAS bf16*)(lds + GL_QB);
    LAS bf16* raw = (LAS bf16*)(lds + GL_RAW);
    LAS float* cw = (LAS float*)(lds + GL_CW);
    LAS float* AmT = (LAS float*)(lds + GL_AMT);
    LAS float* sg = (LAS float*)(lds + GL_SM);
    LAS float* sbeta = sg + 64; LAS float* sgc = sbeta + 64; LAS float* seg = sgc + 64; LAS float* sek = seg + 64;
    LAS bf16* atts = (LAS bf16*)(lds + GL_ATT);
    const bf16* QKV = (const bf16*)(ws + WS_QKV);
    const float* AB = (const float*)(ws + WS_AB);
    GL_REPF(0) {
        v4u pr[7];
#pragma unroll
        for (int r = 0; r < 7; ++r) {
            const int id = tid + 512 * r;
            const int row = id / 48, rem = id - row * 48, part = rem >> 4, ck = rem & 15, s = n * 64 + row - 3;
            pr[r] = (v4u){0u, 0u, 0u, 0u};
            if (id < 67 * 48 && s >= 0) pr[r] = *(const v4u*)(QKV + (size_t)(b * SEQ + s) * 1536 + part * 512 + h * 128 + ck * 8);
        }
        f32x4 cwv = (f32x4){0.f, 0.f, 0.f, 0.f};
        if (tid < 384) { const int j = tid / 96, rem = tid - j * 96, part = rem >> 5, c4 = rem & 31; cwv = *(const f32x4*)(P.conv_qkv_w + j * 1536 + part * 512 + h * 128 + c4 * 4); }
        float a_in = 0.f, b_in = 0.f;
        if (tid < 64) { a_in = AB[(size_t)(t0 + tid) * 8 + h]; b_in = AB[(size_t)(t0 + tid) * 8 + 4 + h]; }
#pragma unroll
        for (int r = 0; r < 7; ++r) { const int id = tid + 512 * r; if (id < 67 * 48) *(LAS v4u*)(raw + id * 8) = pr[r]; }
        if (tid < 384) *(LAS f32x4*)(cw + tid * 4) = cwv;
        if (tid < 64) { sg[tid] = -__expf(P.gdn_a_log[h]) * softplusf_(a_in + P.gdn_dt_bias[h]); sbeta[tid] = sigmoidf_(b_in); }
    }
    GL_BAR();
    GL_REPF(1) {
        const int c = tid >> 3, grp = tid & 7;
#pragma unroll 1
        for (int part = 0; part < 3; ++part) {
            float y[16];
#pragma unroll
            for (int i = 0; i < 16; ++i) y[i] = 0.f;
#pragma unroll
            for (int j = 0; j < 4; ++j) {
                const LAS v4u* src = (const LAS v4u*)(raw + (c + j) * 384 + part * 128 + grp * 16);
                const v4u x0 = src[0], x1 = src[1];
                const LAS f32x4* wp = (const LAS f32x4*)(cw + (j * 3 + part) * 128 + grp * 16);
                const f32x4 w0 = wp[0], w1 = wp[1], w2 = wp[2], w3 = wp[3];
                y[0] += w0.x * bflo(x0.x); y[1] += w0.y * bfhi(x0.x); y[2] += w0.z * bflo(x0.y); y[3] += w0.w * bfhi(x0.y);
                y[4] += w1.x * bflo(x0.z); y[5] += w1.y * bfhi(x0.z); y[6] += w1.z * bflo(x0.w); y[7] += w1.w * bfhi(x0.w);
                y[8] += w2.x * bflo(x1.x); y[9] += w2.y * bfhi(x1.x); y[10] += w2.z * bflo(x1.y); y[11] += w2.w * bfhi(x1.y);
                y[12] += w3.x * bflo(x1.z); y[13] += w3.y * bfhi(x1.z); y[14] += w3.z * bflo(x1.w); y[15] += w3.w * bfhi(x1.w);
            }
            float ss = 0.f;
#pragma unroll
            for (int i = 0; i < 16; ++i) { y[i] = siluf_(y[i]); ss += y[i] * y[i]; }
            if (part < 2) {
                ss += __shfl_xor(ss, 1); ss += __shfl_xor(ss, 2); ss += __shfl_xor(ss, 4);
                const float sc = rsqrtf(ss + 1e-6f) * (part == 0 ? 0.08838834764831845f : 1.0f);
#pragma unroll
                for (int i = 0; i < 16; ++i) y[i] *= sc;
            }
            if (part >= 1) {
                LAS float* dst = (part == 1 ? ks : vs) + c * 132 + grp * 16;
#pragma unroll
                for (int i = 0; i < 4; ++i) *(LAS f32x4*)(dst + 4 * i) = (f32x4){y[4 * i], y[4 * i + 1], y[4 * i + 2], y[4 * i + 3]};
            }
            if (part <= 1) {
                LAS bf16* dst = (part == 0 ? qb16 : kb16) + c * 136 + grp * 16;
                v4u o0, o1; o0.x = pk2(y[0], y[1]); o0.y = pk2(y[2], y[3]); o0.z = pk2(y[4], y[5]); o0.w = pk2(y[6], y[7]);
                o1.x = pk2(y[8], y[9]); o1.y = pk2(y[10], y[11]); o1.z = pk2(y[12], y[13]); o1.w = pk2(y[14], y[15]);
                *(LAS v4u*)dst = o0; *(LAS v4u*)(dst + 8) = o1;
            }
        }
    }
    if (tid < 64) {
        float v = sg[tid];
#pragma unroll
        for (int off = 1; off < 64; off <<= 1) { const float t = __shfl_up(v, off); if (tid >= off) v += t; }
        sgc[tid] = v; seg[tid] = __expf(v);
        const float gl = __shfl(v, 63);
        sek[tid] = __expf(gl - v);
        if (tid == 63) sek[64] = __expf(v);
    }
    GL_BAR();
    {
        const int mat = wave >> 2, rho = wave & 3, col = lane & 15, g = lane >> 4;
        const LAS bf16* X = mat ? qb16 : kb16;
        bf16x8 af[4];
#pragma unroll
        for (int s = 0; s < 4; ++s) af[s] = *(const LAS bf16x8*)(X + (16 * rho + col) * 136 + 32 * s + 8 * g);
#pragma unroll
        for (int sig = 0; sig < 4; ++sig) {
            f32x4 acc = (f32x4){0.f, 0.f, 0.f, 0.f};
#pragma unroll
            for (int s = 0; s < 4; ++s) { const bf16x8 bfr = *(const LAS bf16x8*)(kb16 + (16 * sig + col) * 136 + 32 * s + 8 * g); acc = __builtin_amdgcn_mfma_f32_16x16x32_bf16(af[s], bfr, acc, 0, 0, 0); }
            const int sidx = 16 * sig + col; const float gs = sgc[sidx];
#pragma unroll
            for (int i = 0; i < 4; ++i) {
                const int c = 16 * rho + 4 * g + i;
                const float dec = (c >= sidx) ? __expf(sgc[c] - gs) : 0.f;
                if (mat == 0) AmT[sidx * 68 + c] = (c > sidx) ? sbeta[c] * acc[i] * dec : 0.f;
                else atts[c * 64 + sidx] = (bf16)f2bf(acc[i] * dec);
            }
        }
    }
    GL_BAR();
    GL_REPF(4) {
        bf16* QD = (bf16*)(ws + WS_QD) + (size_t)item * 8192;
        bf16* KD = (bf16*)(ws + WS_KD) + (size_t)item * 8192;
        bf16* ATT = (bf16*)(ws + WS_ATT) + (size_t)item * 4096;
#pragma unroll
        for (int r = 0; r < 2; ++r) {
            const int id = tid + 512 * r;
            { const int c = id >> 4, gam = id & 15, s32 = gam >> 2, g = gam & 3;
              const v2u lo = *(const LAS v2u*)(qb16 + c * 136 + 32 * s32 + 4 * g), hi = *(const LAS v2u*)(qb16 + c * 136 + 32 * s32 + 16 + 4 * g);
              const float e = seg[c];
              v4u o; o.x = pk2(bflo(lo.x) * e, bfhi(lo.x) * e); o.y = pk2(bflo(lo.y) * e, bfhi(lo.y) * e); o.z = pk2(bflo(hi.x) * e, bfhi(hi.x) * e); o.w = pk2(bflo(hi.y) * e, bfhi(hi.y) * e);
              st16_wt(QD + c * 128 + 8 * gam, o); }
            { const int dk = id >> 3, gam = id & 7, s32 = gam >> 2, g = gam & 3, c0 = 32 * s32 + 4 * g;
              float v[8];
#pragma unroll
              for (int j = 0; j < 4; ++j) { v[j] = ks[(c0 + j) * 132 + dk] * sek[c0 + j]; v[4 + j] = ks[(c0 + 16 + j) * 132 + dk] * sek[c0 + 16 + j]; }
              v4u o; o.x = pk2(v[0], v[1]); o.y = pk2(v[2], v[3]); o.z = pk2(v[4], v[5]); o.w = pk2(v[6], v[7]);
              st16_wt(KD + dk * 64 + 8 * gam, o); }
        }
        { const int c = tid >> 3, gam = tid & 7, s32 = gam >> 2, g = gam & 3;
          const v2u lo = *(const LAS v2u*)(atts + c * 64 + 32 * s32 + 4 * g), hi = *(const LAS v2u*)(atts + c * 64 + 32 * s32 + 16 + 4 * g);
          v4u o; o.x = lo.x; o.y = lo.y; o.z = hi.x; o.w = hi.y;
          st16_wt(ATT + c * 64 + 8 * gam, o); }
    }
    GL_BAR();
    GL_REPF(5) {
        LAS float* xcol = (LAS float*)(lds + GL_SOL);
        LAS bf16* tinv = (LAS bf16*)(lds + GL_SOL + 17408);
        const int j = tid >> 3, part = tid & 7, jb = j >> 4, jo = j & 15;
#pragma unroll 1
        for (int rb = jb; rb < 4; ++rb) {
            float acc[16];
#pragma unroll
            for (int i = 0; i < 16; ++i) acc[i] = 0.f;
            if (rb > jb) {
#pragma unroll 2
                for (int s = 16 * jb + part; s < 16 * rb; s += 8) {
                    const float sv = xcol[j * 68 + s];
                    const LAS float* ar = AmT + s * 68 + 16 * rb;
#pragma unroll
                    for (int q = 0; q < 4; ++q) { const f32x4 A4 = *(const LAS f32x4*)(ar + 4 * q);
                        acc[4 * q] -= A4.x * sv; acc[4 * q + 1] -= A4.y * sv; acc[4 * q + 2] -= A4.z * sv; acc[4 * q + 3] -= A4.w * sv; }
                }
#pragma unroll
                for (int i = 0; i < 16; ++i) {
                    acc[i] += __builtin_bit_cast(float, __builtin_amdgcn_update_dpp(0, __builtin_bit_cast(int, acc[i]), 0xB1, 0xF, 0xF, true));
                    acc[i] += __builtin_bit_cast(float, __builtin_amdgcn_update_dpp(0, __builtin_bit_cast(int, acc[i]), 0x4E, 0xF, 0xF, true));
                    acc[i] += __builtin_bit_cast(float, __builtin_amdgcn_update_dpp(0, __builtin_bit_cast(int, acc[i]), 0x141, 0xF, 0xF, true));
                }
            } else {
#pragma unroll
                for (int i = 0; i < 16; ++i) acc[i] = (i == jo) ? 1.f : 0.f;
            }
#pragma unroll
            for (int i = 0; i < 16; ++i) {
                const float sv = acc[i];
                const LAS float* ar = AmT + (16 * rb + i) * 68 + 16 * rb;
#pragma unroll
                for (int q = (i + 1) / 4; q < 4; ++q) { const f32x4 A4 = *(const LAS f32x4*)(ar + 4 * q);
                    if (4 * q > i) acc[4 * q] -= A4.x * sv; if (4 * q + 1 > i) acc[4 * q + 1] -= A4.y * sv; if (4 * q + 2 > i) acc[4 * q + 2] -= A4.z * sv; if (4 * q + 3 > i) acc[4 * q + 3] -= A4.w * sv; }
            }
            if (part == 0) {
#pragma unroll
                for (int i = 0; i < 16; ++i) { xcol[j * 68 + 16 * rb + i] = acc[i]; tinv[(16 * rb + i) * 72 + j] = (bf16)f2bf(acc[i]); }
            }
            LDS_WAIT(); asm volatile("" ::: "memory");
        }
        for (int rb = 0; rb < jb; ++rb) {
            if (part == 0) {
#pragma unroll
                for (int i = 0; i < 16; ++i) tinv[(16 * rb + i) * 72 + j] = (bf16)0;
            }
        }
    }
    GL_BAR();
    GL_REPF(6) {
        const LAS bf16* tinv = (const LAS bf16*)(lds + GL_SOL + 17408);
        LAS bf16* wst = (LAS bf16*)(lds + GL_SOL + 17408 + 9216);
        const int col = lane & 15, g = lane >> 4, isw = wave >> 2;
        bf16x8 af[4][2];
#pragma unroll
        for (int rho = 0; rho < 4; ++rho)
#pragma unroll
            for (int s2 = 0; s2 < 2; ++s2) af[rho][s2] = *(const LAS bf16x8*)(tinv + (16 * rho + col) * 72 + 32 * s2 + 8 * g);
        bf16* UF = (bf16*)(ws + WS_UF) + (size_t)item * 8192;
#pragma unroll
        for (int sig = 0; sig < 2; ++sig) {
            const int jj = 32 * (wave & 3) + 16 * sig + col;
            const LAS float* src = (isw ? ks : vs) + jj;
            bf16x8 bfr[2];
#pragma unroll
            for (int s2 = 0; s2 < 2; ++s2) {
                float v[8];
#pragma unroll
                for (int e = 0; e < 8; ++e) { const int sidx = 32 * s2 + 8 * g + e; float x = src[sidx * 132] * sbeta[sidx]; if (isw) x *= seg[sidx]; v[e] = x; }
                v4u pk; pk.x = pk2(v[0], v[1]); pk.y = pk2(v[2], v[3]); pk.z = pk2(v[4], v[5]); pk.w = pk2(v[6], v[7]);
                bfr[s2] = __builtin_bit_cast(bf16x8, pk);
            }
            f32x4 acc[4];
#pragma unroll
            for (int rho = 0; rho < 4; ++rho) { acc[rho] = (f32x4){0.f, 0.f, 0.f, 0.f};
#pragma unroll
                for (int s2 = 0; s2 < 2; ++s2) acc[rho] = __builtin_amdgcn_mfma_f32_16x16x32_bf16(af[rho][s2], bfr[s2], acc[rho], 0, 0, 0); }
            if (!isw) {
                v4u o0, o1;
                o0.x = pk2(acc[0].x, acc[0].y); o0.y = pk2(acc[0].z, acc[0].w); o0.z = pk2(acc[1].x, acc[1].y); o0.w = pk2(acc[1].z, acc[1].w);
                o1.x = pk2(acc[2].x, acc[2].y); o1.y = pk2(acc[2].z, acc[2].w); o1.z = pk2(acc[3].x, acc[3].y); o1.w = pk2(acc[3].z, acc[3].w);
                v4u* d = (v4u*)(UF + (size_t)(2 * (wave & 3) + sig) * 1024 + lane * 16);
                st16_wt(d, o0); st16_wt(d + 1, o1);
            } else {
#pragma unroll
                for (int rho = 0; rho < 4; ++rho)
#pragma unroll
                    for (int i = 0; i < 4; ++i) wst[(16 * rho + 4 * g + i) * 136 + jj] = (bf16)f2bf(-acc[rho][i]);
            }
        }
    }
    GL_BAR();
    {
        const LAS bf16* wst = (const LAS bf16*)(lds + GL_SOL + 17408 + 9216);
        bf16* WN = (bf16*)(ws + WS_WN) + (size_t)item * 8192;
#pragma unroll
        for (int r = 0; r < 2; ++r) {
            const int id = tid + 512 * r, c = id >> 4, gam = id & 15, s32 = gam >> 2, g = gam & 3;
            const v2u lo = *(const LAS v2u*)(wst + c * 136 + 32 * s32 + 4 * g), hi = *(const LAS v2u*)(wst + c * 136 + 32 * s32 + 16 + 4 * g);
            v4u o; o.x = lo.x; o.y = lo.y; o.z = hi.x; o.w = hi.y;
            st16_wt(WN + c * 128 + 8 * gam, o);
        }
    }
    asm volatile("s_waitcnt vmcnt(0)" ::: "memory");
    GL_BAR();
    if (tid == 0) { unsigned fb = __builtin_bit_cast(unsigned, sek[64]); if (fb == 0u) fb = 1u;
        __hip_atomic_store((unsigned*)(ws + WS_CTL) + CW_GFLAG + item, fb, __ATOMIC_RELAXED, __HIP_MEMORY_SCOPE_AGENT); }
    GL_BAR();
}

constexpr int LL_XCB = 68608;
static_assert(LL_XCB + 64 * 1040 <= MISC_OFF, "lru_local LDS map");
__device__ __forceinline__ float expm1_small(float x) {
    const float p = x * (1.0f + x * (0.5f + x * (0.16666667f + x * (0.041666668f + x * 0.008333334f))));
    return (x > -0.25f) ? p : (__expf(x) - 1.0f);
}
__device__ __forceinline__ void lru_local_item(const Params& P, LAS unsigned char* lds, int lt, int tid, int lane, int wave) {
    unsigned char* ws = P.ws;
    asm volatile("" : "+v"(tid));
    const int b = lt >> 7, n = lt & 127, t0 = b * SEQ + n * 64;
    LAS bf16* rawx = (LAS bf16*)lds;
    LAS bf16* xcb = (LAS bf16*)(lds + LL_XCB);
    const bf16* XR = (const bf16*)(ws + WS_XR);
    {
        v4u pr[9];
#pragma unroll
        for (int r = 0; r < 9; ++r) { const int id = tid + 512 * r, row = id >> 6, ck = id & 63, s = n * 64 + row - 3;
            pr[r] = (v4u){0u, 0u, 0u, 0u};
            if (id < 67 * 64 && s >= 0) pr[r] = *(const v4u*)(XR + (size_t)(b * SEQ + s) * 512 + ck * 8); }
#pragma unroll
        for (int r = 0; r < 9; ++r) { const int id = tid + 512 * r; if (id < 67 * 64) *(LAS v4u*)(rawx + id * 8) = pr[r]; }
    }
    GL_BAR();
    {
        const int chg = tid & 63, tseg = tid >> 6, ch0 = chg * 8;
        float w[4][8], cb[8];
#pragma unroll
        for (int j = 0; j < 4; ++j) { const f32x4 a = *(const f32x4*)(P.lru_conv_w + j * 512 + ch0), c = *(const f32x4*)(P.lru_conv_w + j * 512 + ch0 + 4);
            w[j][0] = a.x; w[j][1] = a.y; w[j][2] = a.z; w[j][3] = a.w; w[j][4] = c.x; w[j][5] = c.y; w[j][6] = c.z; w[j][7] = c.w; }
        { const f32x4 a = *(const f32x4*)(P.lru_conv_b + ch0), c = *(const f32x4*)(P.lru_conv_b + ch0 + 4);
          cb[0] = a.x; cb[1] = a.y; cb[2] = a.z; cb[3] = a.w; cb[4] = c.x; cb[5] = c.y; cb[6] = c.z; cb[7] = c.w; }
        v4u xr[11];
#pragma unroll
        for (int r = 0; r < 11; ++r) xr[r] = *(const LAS v4u*)(rawx + (tseg * 8 + r) * 512 + ch0);
#pragma unroll
        for (int tk = 0; tk < 8; ++tk) {
            float y[8];
#pragma unroll
            for (int e = 0; e < 8; ++e) y[e] = cb[e];
#pragma unroll
            for (int j = 0; j < 4; ++j) { const v4u x = xr[tk + j];
                y[0] += w[j][0] * bflo(x.x); y[1] += w[j][1] * bfhi(x.x); y[2] += w[j][2] * bflo(x.y); y[3] += w[j][3] * bfhi(x.y);
                y[4] += w[j][4] * bflo(x.z); y[5] += w[j][5] * bfhi(x.z); y[6] += w[j][6] * bflo(x.w); y[7] += w[j][7] * bfhi(x.w); }
            v4u o; o.x = pk2(y[0], y[1]); o.y = pk2(y[2], y[3]); o.z = pk2(y[4], y[5]); o.w = pk2(y[6], y[7]);
            *(LAS v4u*)(xcb + (tseg * 8 + tk) * 520 + ch0) = o;
        }
    }
    GL_BAR();
    {
        const int g = wave, col = lane & 15, g4 = lane >> 4;
        LAS bf16* AM = (LAS bf16*)(lds + wave * 8192); LAS bf16* BT = AM + 2048;
        const bf16* WT = (const bf16*)(ws + WS_LRUWT) + (size_t)g * 8192;
        bf16x8 Bw[2][4][2];
#pragma unroll
        for (int m = 0; m < 2; ++m)
#pragma unroll
            for (int jt = 0; jt < 4; ++jt)
#pragma unroll
                for (int s2 = 0; s2 < 2; ++s2) Bw[m][jt][s2] = *(const bf16x8*)(WT + m * 4096 + (16 * jt + col) * 64 + 32 * s2 + 8 * g4);
        float cba[4], cbx[4], csp[4];
#pragma unroll
        for (int jt = 0; jt < 4; ++jt) { const int ch = g * 64 + 16 * jt + col; cba[jt] = P.lru_ba[ch]; cbx[jt] = P.lru_bx[ch]; csp[jt] = softplusf_(-P.lru_lambda[ch]); }
        bf16* HLOC = (bf16*)(ws + WS_HLOC); bf16* PCUM = (bf16*)(ws + WS_PCUM);
        const int chs = g * 64 + lane;
        float hst = 0.f, pc = 1.f;
#pragma unroll 1
        for (int half = 0; half < 2; ++half) {
            bf16x8 Af[2][2];
#pragma unroll
            for (int rho = 0; rho < 2; ++rho)
#pragma unroll
                for (int s2 = 0; s2 < 2; ++s2) Af[rho][s2] = *(const LAS bf16x8*)(xcb + (32 * half + 16 * rho + col) * 520 + g * 64 + 32 * s2 + 8 * g4);
#pragma unroll
            for (int jt = 0; jt < 4; ++jt) {
#pragma unroll
                for (int rho = 0; rho < 2; ++rho) {
                    f32x4 ra = (f32x4){0.f, 0.f, 0.f, 0.f}, rx = ra;
#pragma unroll
                    for (int s2 = 0; s2 < 2; ++s2) { ra = __builtin_amdgcn_mfma_f32_16x16x32_bf16(Af[rho][s2], Bw[0][jt][s2], ra, 0, 0, 0); rx = __builtin_amdgcn_mfma_f32_16x16x32_bf16(Af[rho][s2], Bw[1][jt][s2], rx, 0, 0, 0); }
#pragma unroll
                    for (int i = 0; i < 4; ++i) {
                        const int tokl = 16 * rho + 4 * g4 + i, chl = 16 * jt + col;
                        const float r = sigmoidf_(ra[i] + cba[jt]), ig = sigmoidf_(rx[i] + cbx[jt]);
                        const float log_a = -8.0f * r * csp[jt];
                        const float am = -expm1_small(log_a), a = 1.0f - am;
                        const float xo = bf1(xcb[(32 * half + tokl) * 520 + g * 64 + chl]);
                        const float bt = __builtin_amdgcn_sqrtf(fmaxf(am * (1.0f + a), 0.f)) * (ig * xo);
                        AM[tokl * 64 + chl] = (bf16)f2bf(am); BT[tokl * 64 + chl] = (bf16)f2bf(bt);
                    }
                }
            }
            LDS_WAIT(); asm volatile("" ::: "memory");
#pragma unroll 8
            for (int tk = 0; tk < 32; ++tk) {
                const float am = bf1(AM[tk * 64 + lane]), bt = bf1(BT[tk * 64 + lane]);
                hst = (hst - am * hst) + bt; pc = pc - am * pc;
                const size_t o = (size_t)(t0 + 32 * half + tk) * 512 + chs;
                HLOC[o] = (bf16)f2bf(hst); PCUM[o] = (bf16)f2bf(pc);
            }
            LDS_WAIT(); asm volatile("" ::: "memory");
        }
        ((float*)(ws + WS_HEND))[(size_t)lt * 512 + chs] = hst; ((float*)(ws + WS_PEND))[(size_t)lt * 512 + chs] = pc;
    }
    GL_BAR();
}

constexpr int SC_WN = 0, SC_QD = 64 * 272, SC_KD = 2 * 64 * 272, SC_ATT = 2 * 64 * 272 + 128 * 144, SC_BUF = 2 * 64 * 272 + 128 * 144 + 64 * 144;
constexpr int SC_SSQ = 2 * SC_BUF;
__device__ __forceinline__ int sc_lds_off(int id) {
    if (id < 1024) return SC_WN + (id >> 4) * 272 + (id & 15) * 16;
    if (id < 2048) { const int q = id - 1024; return SC_QD + (q >> 4) * 272 + (q & 15) * 16; }
    if (id < 3072) { const int q = id - 2048; return SC_KD + (q >> 3) * 144 + (q & 7) * 16; }
    const int q = id - 3072; return SC_ATT + (q >> 3) * 144 + (q & 7) * 16;
}
__device__ __forceinline__ const v4u* sc_src(const unsigned char* ws, int item, int id) {
    if (id < 1024) return (const v4u*)(ws + WS_WN + (size_t)item * 16384) + id;
    if (id < 2048) return (const v4u*)(ws + WS_QD + (size_t)item * 16384) + (id - 1024);
    if (id < 3072) return (const v4u*)(ws + WS_KD + (size_t)item * 16384) + (id - 2048);
    return (const v4u*)(ws + WS_ATT + (size_t)item * 8192) + (id - 3072);
}
__device__ __forceinline__ bf16x8 pack_b(const f32x4 a, const f32x4 b) {
    v4u r; r.x = pk2(a.x, a.y); r.y = pk2(a.z, a.w); r.z = pk2(b.x, b.y); r.w = pk2(b.z, b.w);
    return __builtin_bit_cast(bf16x8, r);
}
#define SC_BAR() do { asm volatile("s_waitcnt lgkmcnt(0)" ::: "memory"); __builtin_amdgcn_s_barrier(); asm volatile("" ::: "memory"); } while (0)
#define SC_GLD(dst, ptr) asm volatile("global_load_dwordx4 %0, %1, off" : "=v"(dst) : "v"(ptr) : "memory")
#define PIN8(a) asm volatile("" : "+v"(a[0]), "+v"(a[1]), "+v"(a[2]), "+v"(a[3]), "+v"(a[4]), "+v"(a[5]), "+v"(a[6]), "+v"(a[7]))
#define PIN16(a) asm volatile("" : "+v"(a[0]), "+v"(a[1]), "+v"(a[2]), "+v"(a[3]), "+v"(a[4]), "+v"(a[5]), "+v"(a[6]), "+v"(a[7]), "+v"(a[8]), "+v"(a[9]), "+v"(a[10]), "+v"(a[11]), "+v"(a[12]), "+v"(a[13]), "+v"(a[14]), "+v"(a[15]))
constexpr int SCAN_NWC = 2, SCAN_PARTS = 4, SCAN_WGS = 8 * SCAN_PARTS;
constexpr int SC_UFS = 2 * SC_BUF;
constexpr int SC_DECS = SC_UFS + 2 * SCAN_NWC * 2048;
constexpr int SC_OT = SC_DECS + 512;
constexpr int SC_RDY = SC_OT + 2 * 64 * 36 * 4;
constexpr int SC_END = SC_RDY + 64;
static_assert(SC_END <= MISC_OFF, "scan LDS");
#ifndef SCAN_REPS
#define SCAN_REPS 1
#endif
#ifndef SCAN_EXP
#define SCAN_EXP 0
#endif
__device__ __forceinline__ int sc3_lds_off(int id) {
    if (id < 3584) return sc_lds_off(id);
    return SC_UFS + (id - 3584) * 16;
}
__device__ __forceinline__ const v4u* sc3_src(const unsigned char* ws, int item, int id, int part) {
    if (id < 3584) return sc_src(ws, item, id);
    return (const v4u*)(ws + WS_UF + (size_t)item * 16384 + (size_t)(part * SCAN_NWC) * 2048) + (id - 3584);
}
__device__ __forceinline__ void gdn_scan(const Params& P, LAS unsigned char* lds, int sb, int tid, int lane, int wave) {
    const unsigned char* ws = P.ws;
    constexpr int NCH = 128 * SCAN_REPS, NPC = 15;
    const int bh = sb & 7, part = sb >> 3;
    const int b = bh >> 2, h = bh & 3, col = lane & 15, g = lane >> 4;
    const int item0 = bh * 128;
    if (tid == 0) *(volatile LAS unsigned*)(lds + SC_RDY) = 0u;
    SC_BAR();
    if (wave >= 4) {
        constexpr int NP = 15, DEP = 3;
        const int lt = tid - 256;
        const unsigned voff = (unsigned)lt * 16u;
        const int lA = (lt >> 4) * 272 + (lt & 15) * 16, lB = (lt >> 3) * 144 + (lt & 7) * 16, lU = SC_UFS + lt * 16;
        v4u rs[DEP][NP];
#define SC_ISSUE(set, itm) do { const unsigned char* gq_ = ws + (size_t)(itm) * 16384; const unsigned char* ga_ = ws + WS_ATT + (size_t)(itm) * 8192; \
            asm volatile("s_nop 4\n\tglobal_load_dwordx4 %0, %8, %9 sc0 sc1\n\tglobal_load_dwordx4 %1, %8, %10 sc0 sc1\n\tglobal_load_dwordx4 %2, %8, %11 sc0 sc1\n\tglobal_load_dwordx4 %3, %8, %12 sc0 sc1\n\t" \
                         "global_load_dwordx4 %4, %8, %13 sc0 sc1\n\tglobal_load_dwordx4 %5, %8, %14 sc0 sc1\n\tglobal_load_dwordx4 %6, %8, %15 sc0 sc1\n\tglobal_load_dwordx4 %7, %8, %16 sc0 sc1" \
                : "=&v"(rs[set][0]), "=&v"(rs[set][1]), "=&v"(rs[set][2]), "=&v"(rs[set][3]), "=&v"(rs[set][4]), "=&v"(rs[set][5]), "=&v"(rs[set][6]), "=&v"(rs[set][7]) \
                : "v"(voff), "s"(gq_ + WS_WN), "s"(gq_ + WS_WN + 4096), "s"(gq_ + WS_WN + 8192), "s"(gq_ + WS_WN + 12288), \
                  "s"(gq_ + WS_QD), "s"(gq_ + WS_QD + 4096), "s"(gq_ + WS_QD + 8192), "s"(gq_ + WS_QD + 12288) : "memory"); \
            asm volatile("s_nop 4\n\tglobal_load_dwordx4 %0, %7, %8 sc0 sc1\n\tglobal_load_dwordx4 %1, %7, %9 sc0 sc1\n\tglobal_load_dwordx4 %2, %7, %10 sc0 sc1\n\tglobal_load_dwordx4 %3, %7, %11 sc0 sc1\n\t" \
                         "global_load_dwordx4 %4, %7, %12 sc0 sc1\n\tglobal_load_dwordx4 %5, %7, %13 sc0 sc1\n\tglobal_load_dwordx4 %6, %7, %14 sc0 sc1" \
                : "=&v"(rs[set][8]), "=&v"(rs[set][9]), "=&v"(rs[set][10]), "=&v"(rs[set][11]), "=&v"(rs[set][12]), "=&v"(rs[set][13]), "=&v"(rs[set][14]) \
                : "v"(voff), "s"(gq_ + WS_KD), "s"(gq_ + WS_KD + 4096), "s"(gq_ + WS_KD + 8192), "s"(gq_ + WS_KD + 12288), \
                  "s"(ga_), "s"(ga_ + 4096), "s"(gq_ + WS_UF + (size_t)(part * SCAN_NWC) * 2048) : "memory"); } while (0)
#define SC_WAITSET(set, cnt) asm volatile("s_waitcnt " cnt : "+v"(rs[set][0]), "+v"(rs[set][1]), "+v"(rs[set][2]), "+v"(rs[set][3]), "+v"(rs[set][4]), "+v"(rs[set][5]), "+v"(rs[set][6]), "+v"(rs[set][7]), \
            "+v"(rs[set][8]), "+v"(rs[set][9]), "+v"(rs[set][10]), "+v"(rs[set][11]), "+v"(rs[set][12]), "+v"(rs[set][13]), "+v"(rs[set][14]) :: "memory")
#define SC_WRITE(set, par) do { LAS unsigned char* wb_ = lds + (par) * SC_BUF; \
            _Pragma("unroll") for (int r = 0; r < 4; ++r) { *(LAS v4u*)(wb_ + SC_WN + lA + r * (16 * 272)) = rs[set][r]; *(LAS v4u*)(wb_ + SC_QD + lA + r * (16 * 272)) = rs[set][4 + r]; \
                                                          *(LAS v4u*)(wb_ + SC_KD + lB + r * (32 * 144)) = rs[set][8 + r]; } \
            *(LAS v4u*)(wb_ + SC_ATT + lB) = rs[set][12]; *(LAS v4u*)(wb_ + SC_ATT + lB + 32 * 144) = rs[set][13]; \
            *(LAS v4u*)(lds + lU + (par) * (SCAN_NWC * 2048)) = rs[set][14]; } while (0)
#define SC_NEED(c) do { unsigned sp_ = 0; while (*(volatile LAS unsigned*)(lds + SC_RDY) <= (unsigned)(c) && ++sp_ < (1u << 24)) __builtin_amdgcn_s_sleep(2); } while (0)
        SC_NEED(0); SC_ISSUE(0, item0);
        SC_WAITSET(0, "vmcnt(0)"); SC_WRITE(0, 0); SC_WAITSET(0, "lgkmcnt(0)");
        SC_NEED(3); SC_ISSUE(1, item0 + 1); SC_ISSUE(2, item0 + 2); SC_ISSUE(0, item0 + 3);
        SC_BAR();
        int n2 = 0;
#define SC_INTERVAL(set) do { SC_WAITSET(set, "vmcnt(30)"); SC_WRITE(set, (n2 + 1) & 1); SC_WAITSET(set, "lgkmcnt(0)"); if (n2 + 1 + DEP < 128) SC_NEED(n2 + 1 + DEP); SC_ISSUE(set, item0 + ((n2 + 1 + DEP) & 127)); SC_BAR(); ++n2; } while (0)
#pragma unroll 1
        for (int it = 0; it < NCH / 3; ++it) { SC_INTERVAL(1); SC_INTERVAL(2); SC_INTERVAL(0); }
        if (NCH % 3 >= 1) SC_INTERVAL(1);
        if (NCH % 3 >= 2) SC_INTERVAL(2);
        SC_WAITSET(0, "vmcnt(0)"); SC_WAITSET(1, "vmcnt(0)"); SC_WAITSET(2, "vmcnt(0)");
#undef SC_INTERVAL
#undef SC_NEED
#undef SC_WRITE
#undef SC_WAITSET
#undef SC_ISSUE
        return;
    }
    if (wave == 3) {
        const unsigned* flags = (const unsigned*)(ws + WS_CTL) + CW_GFLAG + item0;
        unsigned rdy = 0;
#define SC_POLLSTEP() do { if (rdy < 128u) { const unsigned idx_ = rdy + (unsigned)lane; \
            const unsigned fv_ = (idx_ < 128u) ? __hip_atomic_load(flags + idx_, __ATOMIC_RELAXED, __HIP_MEMORY_SCOPE_AGENT) : 0u; \
            const unsigned long long m_ = __ballot(fv_ != 0u); const unsigned nrun_ = (m_ == ~0ull) ? 64u : (unsigned)__builtin_ctzll(~m_);     \
            if ((unsigned)lane < nrun_) ((LAS float*)(lds + SC_DECS))[idx_] = __builtin_bit_cast(float, fv_); \
            rdy += nrun_; LDS_WAIT(); if (lane == 0) *(volatile LAS unsigned*)(lds + SC_RDY) = rdy; } } while (0)
        { unsigned sp = 0; while (rdy < 4u && ++sp < (1u << 22)) { SC_POLLSTEP(); if (rdy < 4u) __builtin_amdgcn_s_sleep(16); } }
        SC_BAR();
#pragma unroll 1
        for (int n2 = 0; n2 < NCH; ++n2) {
            { const unsigned need = (unsigned)(n2 + 1 + 3) < 128u ? (unsigned)(n2 + 1 + 3) : 127u; unsigned sp = 0;
              while (rdy <= need && rdy < 128u && ++sp < (1u << 22)) { SC_POLLSTEP(); if (rdy <= need) __builtin_amdgcn_s_sleep(8); } }
            if (rdy < 128u && rdy < (unsigned)(n2 & 127) + 16u) SC_POLLSTEP();
            SC_BAR();
        }
#undef SC_POLLSTEP
        return;
    }
    if (wave == 2) {
        const int row = lane;
        bf16* Y = (bf16*)((unsigned char*)P.out + OUT_Y);
        float* SSQG = P.out;
        SC_BAR();
#pragma unroll 1
        for (int n2 = 0; n2 <= NCH; ++n2) {
            if (n2 > 0) {
                const int n = (n2 - 1) & 127, t = b * SEQ + n * 64 + row;
                const LAS float* src = (const LAS float*)(lds + SC_OT + ((n2 - 1) & 1) * (64 * 36 * 4)) + row * 36;
                f32x4 a[8]; float s2 = 0.f;
#pragma unroll
                for (int q = 0; q < 8; ++q) { a[q] = *(const LAS f32x4*)(src + 4 * q); s2 += (a[q].x * a[q].x + a[q].y * a[q].y) + (a[q].z * a[q].z + a[q].w * a[q].w); }
                SSQG[(size_t)t * 32 + h * 8 + part] = s2;
                v4u* d = (v4u*)(Y + (size_t)t * 1024 + h * 128 + 32 * part);
#pragma unroll
                for (int q = 0; q < 4; ++q) { v4u o; o.x = pk2(a[2 * q].x, a[2 * q].y); o.y = pk2(a[2 * q].z, a[2 * q].w); o.z = pk2(a[2 * q + 1].x, a[2 * q + 1].y); o.w = pk2(a[2 * q + 1].z, a[2 * q + 1].w); d[q] = o; }
            }
            if (n2 < NCH) SC_BAR();
        }
        return;
    }
    f32x4 S[8];
#pragma unroll
    for (int i = 0; i < 8; ++i) S[i] = (f32x4){0.f, 0.f, 0.f, 0.f};
    SC_BAR();
#pragma unroll 1
    for (int n2 = 0; n2 < NCH; ++n2) {
        if (SCAN_REPS > 1 && (n2 & 127) == 0) {
#pragma unroll
            for (int i = 0; i < 8; ++i) S[i] = (f32x4){0.f, 0.f, 0.f, 0.f};
        }
        if (SCAN_EXP == 2 && n2 < 128) { SC_BAR(); continue; }
        const int par = n2 & 1;
        LAS unsigned char* buf = lds + par * SC_BUF;
        bf16x8 fA[16], fB[16], fC[16], fD[8];
#pragma unroll
        for (int rho = 0; rho < 4; ++rho)
#pragma unroll
            for (int s = 0; s < 4; ++s) fA[rho * 4 + s] = *(const LAS bf16x8*)(buf + SC_WN + (16 * rho + col) * 272 + (32 * s + 8 * g) * 2);
#pragma unroll
        for (int rho = 0; rho < 4; ++rho)
#pragma unroll
            for (int s = 0; s < 4; ++s) fB[rho * 4 + s] = *(const LAS bf16x8*)(buf + SC_QD + (16 * rho + col) * 272 + (32 * s + 8 * g) * 2);
        const LAS v4u* ufp = (const LAS v4u*)(lds + SC_UFS + par * (SCAN_NWC * 2048) + wave * 2048 + lane * 32);
        const v4u uf0 = ufp[0], uf1 = ufp[1];
        const float dec = ((const LAS float*)(lds + SC_DECS))[n2 & 127];
        bf16x8 Bs[4];
#pragma unroll
        for (int s = 0; s < 4; ++s) Bs[s] = pack_b(S[2 * s], S[2 * s + 1]);
        f32x4 Vn[4], Oc[4];
        Vn[0] = (f32x4){bflo(uf0.x), bfhi(uf0.x), bflo(uf0.y), bfhi(uf0.y)}; Vn[1] = (f32x4){bflo(uf0.z), bfhi(uf0.z), bflo(uf0.w), bfhi(uf0.w)};
        Vn[2] = (f32x4){bflo(uf1.x), bfhi(uf1.x), bflo(uf1.y), bfhi(uf1.y)}; Vn[3] = (f32x4){bflo(uf1.z), bfhi(uf1.z), bflo(uf1.w), bfhi(uf1.w)};
        __builtin_amdgcn_sched_barrier(0);
        PIN16(fA);
#pragma unroll
        for (int s = 0; s < 4; ++s)
#pragma unroll
            for (int rho = 0; rho < 4; ++rho) Vn[rho] = __builtin_amdgcn_mfma_f32_16x16x32_bf16(fA[rho * 4 + s], Bs[s], Vn[rho], 0, 0, 0);
        __builtin_amdgcn_sched_barrier(0);
#pragma unroll
        for (int tau = 0; tau < 8; ++tau)
#pragma unroll
            for (int s = 0; s < 2; ++s) fC[tau * 2 + s] = *(const LAS bf16x8*)(buf + SC_KD + (16 * tau + col) * 144 + (32 * s + 8 * g) * 2);
        __builtin_amdgcn_sched_barrier(0);
        PIN16(fB);
#pragma unroll
        for (int rho = 0; rho < 4; ++rho) Oc[rho] = (f32x4){0.f, 0.f, 0.f, 0.f};
#pragma unroll
        for (int s = 0; s < 4; ++s)
#pragma unroll
            for (int rho = 0; rho < 4; ++rho) Oc[rho] = __builtin_amdgcn_mfma_f32_16x16x32_bf16(fB[rho * 4 + s], Bs[s], Oc[rho], 0, 0, 0);
        __builtin_amdgcn_sched_barrier(0);
#pragma unroll
        for (int rho = 0; rho < 4; ++rho)
#pragma unroll
            for (int s = 0; s < 2; ++s) fD[rho * 2 + s] = *(const LAS bf16x8*)(buf + SC_ATT + (16 * rho + col) * 144 + (32 * s + 8 * g) * 2);
        bf16x8 Bv[2];
        Bv[0] = pack_b(Vn[0], Vn[1]); Bv[1] = pack_b(Vn[2], Vn[3]);
#pragma unroll
        for (int tau = 0; tau < 8; ++tau) S[tau] = S[tau] * dec;
        __builtin_amdgcn_sched_barrier(0);
        PIN16(fC);
#pragma unroll
        for (int s = 0; s < 2; ++s)
#pragma unroll
            for (int tau = 0; tau < 8; ++tau) S[tau] = __builtin_amdgcn_mfma_f32_16x16x32_bf16(fC[tau * 2 + s], Bv[s], S[tau], 0, 0, 0);
        __builtin_amdgcn_sched_barrier(0);
        PIN8(fD);
#pragma unroll
        for (int s = 0; s < 2; ++s)
#pragma unroll
            for (int rho = 0; rho < 4; ++rho) Oc[rho] = __builtin_amdgcn_mfma_f32_16x16x32_bf16(fD[rho * 2 + s], Bv[s], Oc[rho], 0, 0, 0);
        LAS float* ot = (LAS float*)(lds + SC_OT + par * (64 * 36 * 4)) + 16 * wave + col;
#pragma unroll
        for (int rho = 0; rho < 4; ++rho)
#pragma unroll
            for (int i = 0; i < 4; ++i) ot[(16 * rho + 4 * g + i) * 36] = Oc[rho][i];
        SC_BAR();
    }
}

__device__ __forceinline__ void lru_carry(const Params& P, int gwv, int lane) {
    unsigned char* ws = P.ws;
    const int b = gwv >> 3, g = gwv & 7, ch = g * 64 + lane;
    const float* HEND = (const float*)(ws + WS_HEND); const float* PEND = (const float*)(ws + WS_PEND); float* HIN = (float*)(ws + WS_HIN);
    float hin = 0.f;
#pragma unroll 1
    for (int n0 = 0; n0 < 128; n0 += 16) {
        float he[16], pe[16];
#pragma unroll
        for (int i = 0; i < 16; ++i) { const size_t o = (size_t)(b * 128 + n0 + i) * 512 + ch; he[i] = HEND[o]; pe[i] = PEND[o]; }
#pragma unroll
        for (int i = 0; i < 16; ++i) { HIN[(size_t)(b * 128 + n0 + i) * 512 + ch] = hin; hin = he[i] + pe[i] * hin; }
    }
}

__device__ __forceinline__ void cvt_table(const float* src, bf16* dst, size_t n8, size_t wi, size_t nw) {
    for (size_t i = wi; i < n8; i += nw) {
        const f32x4 a = ((const f32x4*)src)[2 * i], c = ((const f32x4*)src)[2 * i + 1];
        v4u o; o.x = pk2(a.x, a.y); o.y = pk2(a.z, a.w); o.z = pk2(c.x, c.y); o.w = pk2(c.z, c.w);
        ((v4u*)dst)[i] = o;
    }
}

__device__ __forceinline__ void lru_combine(const Params& P, size_t wi, size_t nw) {
    unsigned char* ws = P.ws;
    const v4u* HLOC = (const v4u*)(ws + WS_HLOC); const v4u* PCUM = (const v4u*)(ws + WS_PCUM); const v4u* GATE = (const v4u*)(ws + WS_GATE);
    const float* HIN = (const float*)(ws + WS_HIN); bf16* Y = (bf16*)((unsigned char*)P.out + OUT_Y);
    for (size_t i = wi; i < (size_t)T * 64; i += nw) {
        const size_t t = i >> 6; const int ch0 = (int)(i & 63) * 8;
        const v4u hl = HLOC[i], pc = PCUM[i], gt = GATE[i];
        const f32x4 h0 = *(const f32x4*)(HIN + (t >> 6) * 512 + ch0), h1 = *(const f32x4*)(HIN + (t >> 6) * 512 + ch0 + 4);
        float y[8];
        y[0] = (bflo(hl.x) + bflo(pc.x) * h0.x) * gelu_tanh(bflo(gt.x)); y[1] = (bfhi(hl.x) + bfhi(pc.x) * h0.y) * gelu_tanh(bfhi(gt.x));
        y[2] = (bflo(hl.y) + bflo(pc.y) * h0.z) * gelu_tanh(bflo(gt.y)); y[3] = (bfhi(hl.y) + bfhi(pc.y) * h0.w) * gelu_tanh(bfhi(gt.y));
        y[4] = (bflo(hl.z) + bflo(pc.z) * h1.x) * gelu_tanh(bflo(gt.z)); y[5] = (bfhi(hl.z) + bfhi(pc.z) * h1.y) * gelu_tanh(bfhi(gt.z));
        y[6] = (bflo(hl.w) + bflo(pc.w) * h1.z) * gelu_tanh(bflo(gt.w)); y[7] = (bfhi(hl.w) + bfhi(pc.w) * h1.w) * gelu_tanh(bfhi(gt.w));
        v4u o; o.x = pk2(y[0], y[1]); o.y = pk2(y[2], y[3]); o.z = pk2(y[4], y[5]); o.w = pk2(y[6], y[7]);
        *(v4u*)(Y + t * 1024 + 512 + ch0) = o;
    }
}

__device__ __forceinline__ void gdn_gate_norm(const Params& P, size_t wi, size_t nw) {
    unsigned char* ws = P.ws;
    bf16* Y = (bf16*)((unsigned char*)P.out + OUT_Y); const v4u* Z = (const v4u*)(ws + WS_Z); const float* SSQG = P.out;
    for (size_t i = wi; i < (size_t)T * 64; i += nw) {
        const size_t t = i >> 6; const int c0 = (int)(i & 63) * 8, h = c0 >> 7;
        const f32x4 q0 = *(const f32x4*)(SSQG + t * 32 + h * 8);
        const float rstd = rsqrtf(((q0.x + q0.y) + (q0.z + q0.w)) * (1.0f / 128.0f) + 1e-6f);
        const v4u o = *(const v4u*)(Y + t * 1024 + c0), z = Z[i];
        const f32x4 w0 = *(const f32x4*)(P.gdn_norm_w + (c0 & 127)), w1 = *(const f32x4*)(P.gdn_norm_w + (c0 & 127) + 4);
        float y[8];
        y[0] = bflo(o.x) * rstd * w0.x * siluf_(bflo(z.x)); y[1] = bfhi(o.x) * rstd * w0.y * siluf_(bfhi(z.x));
        y[2] = bflo(o.y) * rstd * w0.z * siluf_(bflo(z.y)); y[3] = bfhi(o.y) * rstd * w0.w * siluf_(bfhi(z.y));
        y[4] = bflo(o.z) * rstd * w1.x * siluf_(bflo(z.z)); y[5] = bfhi(o.z) * rstd * w1.y * siluf_(bfhi(z.z));
        y[6] = bflo(o.w) * rstd * w1.z * siluf_(bflo(z.w)); y[7] = bfhi(o.w) * rstd * w1.w * siluf_(bfhi(z.w));
        v4u r; r.x = pk2(y[0], y[1]); r.y = pk2(y[2], y[3]); r.z = pk2(y[4], y[5]); r.w = pk2(y[6], y[7]);
        *(v4u*)(Y + t * 1024 + c0) = r;
    }
}

__device__ __forceinline__ void xattn_stage(LAS unsigned char* lds, const bf16* src, int tid) {
    v4u tmp[16];
    const unsigned voff = (unsigned)tid * 16u;
#pragma unroll
    for (int r = 0; r < 16; ++r) { const unsigned char* sb = (const unsigned char*)src + r * 8192;
        asm volatile("s_nop 4\n\tglobal_load_dwordx4 %0, %1, %2" : "=&v"(tmp[r]) : "v"(voff), "s"(sb) : "memory"); }
    asm volatile("s_waitcnt vmcnt(0)" : "+v"(tmp[0]), "+v"(tmp[1]), "+v"(tmp[2]), "+v"(tmp[3]), "+v"(tmp[4]), "+v"(tmp[5]), "+v"(tmp[6]), "+v"(tmp[7]),
                                        "+v"(tmp[8]), "+v"(tmp[9]), "+v"(tmp[10]), "+v"(tmp[11]), "+v"(tmp[12]), "+v"(tmp[13]), "+v"(tmp[14]), "+v"(tmp[15]) :: "memory");
#pragma unroll
    for (int r = 0; r < 16; ++r) { const int id = tid + 512 * r; *(LAS v4u*)(lds + (id >> 5) * 528 + (id & 31) * 16) = tmp[r]; }
}
__device__ __forceinline__ void xattn_unit(const Params& P, LAS unsigned char* lds, int unit, int tid, int lane, int wave) {
    const unsigned char* ws = P.ws;
    const int h = unit & 3, qb = (unit >> 2) & 63, b = unit >> 8, col = lane & 15, g = lane >> 4;
    const int tw = b * SEQ + qb * 128 + 16 * wave;
    const bf16* Kb = (const bf16*)(ws + WS_KB) + (size_t)((b * 4 + h) * 256) * 256;
    const bf16* Vt = (const bf16*)(ws + WS_VTP) + (size_t)((b * 4 + h) * 256) * 256;
    xattn_stage(lds, Kb, tid);
    __syncthreads();
    const LAS unsigned char* arow = lds + col * 528 + g * 16;
    bf16x8 Bp[1][8]; float inv[1];
#pragma unroll
    for (int ps = 0; ps < 1; ++ps) {
        const bf16* Q = (const bf16*)(ws + WS_Q) + (size_t)(tw + 16 * ps + col) * 1024 + h * 256 + 8 * g;
        bf16x8 Bq[8];
#pragma unroll
        for (int s = 0; s < 8; ++s) Bq[s] = *(const bf16x8*)(Q + 32 * s);
        f32x4 St[16];
        bf16x8 fr[2][8];
#pragma unroll
        for (int s = 0; s < 8; ++s) fr[0][s] = *(const LAS bf16x8*)(arow + 64 * s);
#pragma unroll
        for (int kap = 0; kap < 16; ++kap) {
            if (kap + 1 < 16) {
#pragma unroll
                for (int s = 0; s < 8; ++s) fr[(kap + 1) & 1][s] = *(const LAS bf16x8*)(arow + (16 * (kap + 1)) * 528 + 64 * s);
            }
            __builtin_amdgcn_sched_barrier(0);
            PIN8(fr[kap & 1]);
            f32x4 acc = (f32x4){0.f, 0.f, 0.f, 0.f};
#pragma unroll
            for (int s = 0; s < 8; ++s) acc = __builtin_amdgcn_mfma_f32_16x16x32_bf16(fr[kap & 1][s], Bq[s], acc, 0, 0, 0);
            St[kap] = acc;
            __builtin_amdgcn_sched_barrier(0);
        }
        float mx = -3.0e38f;
#pragma unroll
        for (int kap = 0; kap < 16; ++kap) mx = fmaxf(fmaxf(fmaxf(St[kap].x, St[kap].y), fmaxf(St[kap].z, St[kap].w)), mx);
        mx = fmaxf(mx, __shfl_xor(mx, 16)); mx = fmaxf(mx, __shfl_xor(mx, 32));
        float l = 0.f;
#pragma unroll
        for (int kap = 0; kap < 16; ++kap) { St[kap].x = __expf(St[kap].x - mx); St[kap].y = __expf(St[kap].y - mx); St[kap].z = __expf(St[kap].z - mx); St[kap].w = __expf(St[kap].w - mx);
            l += (St[kap].x + St[kap].y) + (St[kap].z + St[kap].w); }
        l += __shfl_xor(l, 16); l += __shfl_xor(l, 32);
        inv[ps] = 1.0f / l;
#pragma unroll
        for (int s = 0; s < 8; ++s) Bp[ps][s] = pack_b(St[2 * s], St[2 * s + 1]);
    }
    __syncthreads();
    xattn_stage(lds, Vt, tid);
    __syncthreads();
#pragma unroll
    for (int ps = 0; ps < 1; ++ps) {
        bf16* AO = (bf16*)(P.ws + WS_AO) + (size_t)(tw + 16 * ps + col) * 1024 + h * 256 + 4 * g;
        bf16x8 fr[2][8];
#pragma unroll
        for (int s = 0; s < 8; ++s) fr[0][s] = *(const LAS bf16x8*)(arow + 64 * s);
#pragma unroll
        for (int del = 0; del < 16; ++del) {
            if (del + 1 < 16) {
#pragma unroll
                for (int s = 0; s < 8; ++s) fr[(del + 1) & 1][s] = *(const LAS bf16x8*)(arow + (16 * (del + 1)) * 528 + 64 * s);
            }
            __builtin_amdgcn_sched_barrier(0);
            PIN8(fr[del & 1]);
            f32x4 acc = (f32x4){0.f, 0.f, 0.f, 0.f};
#pragma unroll
            for (int s = 0; s < 8; ++s) acc = __builtin_amdgcn_mfma_f32_16x16x32_bf16(fr[del & 1][s], Bp[ps][s], acc, 0, 0, 0);
            v2u o; o.x = pk2(acc.x * inv[ps], acc.y * inv[ps]); o.y = pk2(acc.z * inv[ps], acc.w * inv[ps]);
            *(v2u*)(AO + 16 * del) = o;
            __builtin_amdgcn_sched_barrier(0);
        }
    }
    __syncthreads();
}

__device__ __forceinline__ unsigned key_enc(float f) { const unsigned u = __builtin_bit_cast(unsigned, f); return (u & 0x80000000u) ? ~u : (u | 0x80000000u); }
__device__ __forceinline__ float key_dec(unsigned k) { const unsigned u = (k & 0x80000000u) ? (k & 0x7fffffffu) : ~k; return __builtin_bit_cast(float, u); }
#define TK_CAS(a, b) do { const unsigned hi_ = max(a, b), lo_ = min(a, b); a = hi_; b = lo_; } while (0)
__device__ __forceinline__ void tk_merge16(unsigned (&a)[16]) {
#pragma unroll
    for (int j = 8; j > 0; j >>= 1)
#pragma unroll
        for (int i = 0; i < 16; ++i) { const int l = i ^ j; if (l > i) TK_CAS(a[i], a[l]); }
}
__device__ __forceinline__ void tk_sort16(unsigned (&a)[16]) {
#pragma unroll
    for (int k = 2; k <= 16; k <<= 1)
#pragma unroll
        for (int j = k >> 1; j > 0; j >>= 1)
#pragma unroll
            for (int i = 0; i < 16; ++i) { const int l = i ^ j; if (l > i) { if ((i & k) == 0) TK_CAS(a[i], a[l]); else TK_CAS(a[l], a[i]); } }
}
__device__ __forceinline__ void tk_top16_merge(unsigned (&L)[16], const unsigned (&G)[16]) {
#pragma unroll
    for (int i = 0; i < 16; ++i) L[i] = max(L[i], G[15 - i]);
    tk_merge16(L);
}
__device__ __forceinline__ void tk_pair_merge(unsigned (&L)[16]) {
    unsigned Pp[16];
#pragma unroll
    for (int i = 0; i < 16; ++i) Pp[i] = (unsigned)__builtin_amdgcn_update_dpp(0, (int)L[i], 0xB1, 0xF, 0xF, true);
    tk_top16_merge(L, Pp);
}
__device__ __forceinline__ void peer_topk_rows(const Params& P, LAS unsigned char* lds, int rowbase, int tid) {
    const unsigned char* ws = P.ws;
    typedef _Float16 f16x8 __attribute__((ext_vector_type(8)));
    const int rl = tid >> 1, hf = tid & 1, grow = rowbase + rl, t = grow >> 3, h = grow & 7;
    const _Float16* SC = (const _Float16*)(ws + WS_PQ) + (size_t)t * 2048 + h * 256 + 64 * hf;
    f16x8 raw[2][8];
#pragma unroll
    for (int p = 0; p < 2; ++p)
#pragma unroll
        for (int q = 0; q < 8; ++q) raw[p][q] = *(const f16x8*)(SC + p * 128 + 8 * q);
    unsigned L1[16], L2[16];
#pragma unroll
    for (int p = 0; p < 2; ++p) {
        unsigned L[16];
#pragma unroll
        for (int grp = 0; grp < 4; ++grp) {
            unsigned G[16];
#pragma unroll
            for (int e = 0; e < 16; ++e) G[e] = (key_enc((float)raw[p][2 * grp + (e >> 3)][e & 7]) & ~127u) | (unsigned)(127 - (64 * hf + 16 * grp + e));
            tk_sort16(G);
            if (grp == 0) {
#pragma unroll
                for (int i = 0; i < 16; ++i) L[i] = G[i];
            } else tk_top16_merge(L, G);
        }
        tk_pair_merge(L);
#pragma unroll
        for (int i = 0; i < 16; ++i) { if (p == 0) L1[i] = L[i]; else L2[i] = L[i]; }
    }
    {
        float v1[16], v2[16];
        LAS int* il = (LAS int*)lds + rl * 33;
#pragma unroll
        for (int q = 0; q < 16; ++q) { v1[q] = key_dec((L1[q] & ~127u) | 64u); v2[q] = key_dec((L2[q] & ~127u) | 64u); }
        if (hf == 0) {
#pragma unroll
            for (int q = 0; q < 16; ++q) { il[q] = 127 - (int)(L1[q] & 127u); il[16 + q] = 127 - (int)(L2[q] & 127u); }
        }
        unsigned C[16], D[16];
        float w1[8];
        const unsigned hf16 = (unsigned)hf * 16u, evenmask = (unsigned)hf - 1u;
#pragma unroll
        for (int k = 0; k < 8; ++k) w1[k] = __builtin_bit_cast(float, (__builtin_bit_cast(unsigned, v1[2 * k]) & evenmask) | (__builtin_bit_cast(unsigned, v1[2 * k + 1]) & ~evenmask));
#define TK_SLOT(dst, k, bq, valid_odd) do { const unsigned pos_ = (unsigned)(16 * (2 * (k)) + (bq)) + hf16; unsigned kv_ = (key_enc(w1[k] + v2[bq]) & ~255u) | (255u - pos_); if (!(valid_odd)) kv_ &= evenmask; dst = kv_; } while (0)
        TK_SLOT(C[0], 0, 0, true);
        TK_SLOT(C[1], 0, 1, true);
        TK_SLOT(C[2], 0, 2, true);
        TK_SLOT(C[3], 0, 3, true);
        TK_SLOT(C[4], 0, 4, true);
        TK_SLOT(C[5], 0, 5, true);
        TK_SLOT(C[6], 0, 6, true);
        TK_SLOT(C[7], 0, 7, true);
        TK_SLOT(C[8], 0, 8, false);
        TK_SLOT(C[9], 0, 9, false);
        TK_SLOT(C[10], 0, 10, false);
        TK_SLOT(C[11], 0, 11, false);
        TK_SLOT(C[12], 0, 12, false);
        TK_SLOT(C[13], 0, 13, false);
        TK_SLOT(C[14], 0, 14, false);
        TK_SLOT(C[15], 0, 15, false);
        TK_SLOT(D[0], 1, 0, true);
        TK_SLOT(D[1], 1, 1, true);
        TK_SLOT(D[2], 1, 2, true);
        TK_SLOT(D[3], 1, 3, true);
        TK_SLOT(D[4], 1, 4, false);
        TK_SLOT(D[5], 2, 0, true);
        TK_SLOT(D[6], 2, 1, true);
        TK_SLOT(D[7], 2, 2, false);
        TK_SLOT(D[8], 3, 0, true);
        TK_SLOT(D[9], 3, 1, true);
        TK_SLOT(D[10], 4, 0, true);
        TK_SLOT(D[11], 5, 0, true);
        TK_SLOT(D[12], 6, 0, true);
        TK_SLOT(D[13], 7, 0, true);
        D[14] = 0u; D[15] = 0u;
#undef TK_SLOT
        tk_sort16(C); tk_sort16(D); tk_top16_merge(C, D); tk_pair_merge(C);
        LDS_WAIT(); asm volatile("" ::: "memory");
        float best[16], e[16], sum = 0.f;
#pragma unroll
        for (int q = 0; q < 16; ++q) { best[q] = key_dec((C[q] & ~255u) | 128u); e[q] = __expf(best[q] - best[0]); sum += e[q]; }
        const float inv = __builtin_amdgcn_rcpf(sum);
        int* IDX = (int*)(P.ws + WS_IDX) + (size_t)grow * 16 + 8 * hf; float* GW = (float*)(P.ws + WS_GW) + (size_t)grow * 16 + 8 * hf;
#pragma unroll
        for (int q = 0; q < 8; ++q) {
            const unsigned c = (C[q] & evenmask) | (C[8 + q] & ~evenmask);
            const float ev = __builtin_bit_cast(float, (__builtin_bit_cast(unsigned, e[q]) & evenmask) | (__builtin_bit_cast(unsigned, e[8 + q]) & ~evenmask));
            const unsigned pos = 255u - (c & 255u);
            IDX[q] = il[pos >> 4] * 128 + il[16 + (pos & 15u)]; GW[q] = ev * inv;
        }
    }
    LDS_WAIT(); asm volatile("" ::: "memory");
}

__device__ __forceinline__ void peer_topk_wave(const Params& P, LAS int* ilw, LAS unsigned* oute, LAS float* outg, int tbase, int lane) {
    const unsigned char* ws = P.ws;
    typedef _Float16 f16x8 __attribute__((ext_vector_type(8)));
    const int rl = lane >> 1, hf = lane & 1, t = tbase + (rl >> 3), h = rl & 7;
    const _Float16* SC = (const _Float16*)(ws + WS_PQ) + (size_t)t * 2048 + h * 256 + 64 * hf;
    f16x8 raw[2][8];
#pragma unroll
    for (int p = 0; p < 2; ++p)
#pragma unroll
        for (int q = 0; q < 8; ++q) raw[p][q] = *(const f16x8*)(SC + p * 128 + 8 * q);
    unsigned L1[16], L2[16];
#pragma unroll
    for (int p = 0; p < 2; ++p) {
        unsigned L[16];
#pragma unroll
        for (int grp = 0; grp < 4; ++grp) {
            unsigned G[16];
#pragma unroll
            for (int e = 0; e < 16; ++e) G[e] = (key_enc((float)raw[p][2 * grp + (e >> 3)][e & 7]) & ~127u) | (unsigned)(127 - (64 * hf + 16 * grp + e));
            tk_sort16(G);
            if (grp == 0) {
#pragma unroll
                for (int i = 0; i < 16; ++i) L[i] = G[i];
            } else tk_top16_merge(L, G);
        }
        tk_pair_merge(L);
#pragma unroll
        for (int i = 0; i < 16; ++i) { if (p == 0) L1[i] = L[i]; else L2[i] = L[i]; }
    }
    {
        float v1[16], v2[16];
        LAS int* il = ilw + rl * 33;
#pragma unroll
        for (int q = 0; q < 16; ++q) { v1[q] = key_dec((L1[q] & ~127u) | 64u); v2[q] = key_dec((L2[q] & ~127u) | 64u); }
        if (hf == 0) {
#pragma unroll
            for (int q = 0; q < 16; ++q) { il[q] = 127 - (int)(L1[q] & 127u); il[16 + q] = 127 - (int)(L2[q] & 127u); }
        }
        unsigned C[16], D[16];
        float w1[8];
        const unsigned hf16 = (unsigned)hf * 16u, evenmask = (unsigned)hf - 1u;
#pragma unroll
        for (int k = 0; k < 8; ++k) w1[k] = __builtin_bit_cast(float, (__builtin_bit_cast(unsigned, v1[2 * k]) & evenmask) | (__builtin_bit_cast(unsigned, v1[2 * k + 1]) & ~evenmask));
#define TK_SLOT(dst, k, bq, valid_odd) do { const unsigned pos_ = (unsigned)(16 * (2 * (k)) + (bq)) + hf16; unsigned kv_ = (key_enc(w1[k] + v2[bq]) & ~255u) | (255u - pos_); if (!(valid_odd)) kv_ &= evenmask; dst = kv_; } while (0)
        TK_SLOT(C[0], 0, 0, true);
        TK_SLOT(C[1], 0, 1, true);
        TK_SLOT(C[2], 0, 2, true);
        TK_SLOT(C[3], 0, 3, true);
        TK_SLOT(C[4], 0, 4, true);
        TK_SLOT(C[5], 0, 5, true);
        TK_SLOT(C[6], 0, 6, true);
        TK_SLOT(C[7], 0, 7, true);
        TK_SLOT(C[8], 0, 8, false);
        TK_SLOT(C[9], 0, 9, false);
        TK_SLOT(C[10], 0, 10, false);
        TK_SLOT(C[11], 0, 11, false);
        TK_SLOT(C[12], 0, 12, false);
        TK_SLOT(C[13], 0, 13, false);
        TK_SLOT(C[14], 0, 14, false);
        TK_SLOT(C[15], 0, 15, false);
        TK_SLOT(D[0], 1, 0, true);
        TK_SLOT(D[1], 1, 1, true);
        TK_SLOT(D[2], 1, 2, true);
        TK_SLOT(D[3], 1, 3, true);
        TK_SLOT(D[4], 1, 4, false);
        TK_SLOT(D[5], 2, 0, true);
        TK_SLOT(D[6], 2, 1, true);
        TK_SLOT(D[7], 2, 2, false);
        TK_SLOT(D[8], 3, 0, true);
        TK_SLOT(D[9], 3, 1, true);
        TK_SLOT(D[10], 4, 0, true);
        TK_SLOT(D[11], 5, 0, true);
        TK_SLOT(D[12], 6, 0, true);
        TK_SLOT(D[13], 7, 0, true);
        D[14] = 0u; D[15] = 0u;
#undef TK_SLOT
        tk_sort16(C); tk_sort16(D); tk_top16_merge(C, D); tk_pair_merge(C);
        LDS_WAIT(); asm volatile("" ::: "memory");
        float best[16], e[16], sum = 0.f;
#pragma unroll
        for (int q = 0; q < 16; ++q) { best[q] = key_dec((C[q] & ~255u) | 128u); e[q] = __expf(best[q] - best[0]); sum += e[q]; }
        const float inv = __builtin_amdgcn_rcpf(sum);
        LAS unsigned* IDX = oute + rl * 16 + 8 * hf; LAS float* GW = outg + rl * 16 + 8 * hf;
#pragma unroll
        for (int q = 0; q < 8; ++q) {
            const unsigned c = (C[q] & evenmask) | (C[8 + q] & ~evenmask);
            const float ev = __builtin_bit_cast(float, (__builtin_bit_cast(unsigned, e[q]) & evenmask) | (__builtin_bit_cast(unsigned, e[8 + q]) & ~evenmask));
            const unsigned pos = 255u - (c & 255u);
            IDX[q] = (unsigned)(il[pos >> 4] * 128 + il[16 + (pos & 15u)]); GW[q] = ev * inv;
        }
    }
    LDS_WAIT(); asm volatile("" ::: "memory");
}

typedef float f32x2 __attribute__((ext_vector_type(2)));
__device__ __forceinline__ unsigned q8(float x) { return (unsigned)(int)rintf(x) & 0xffu; }
__device__ __forceinline__ void cvt_table_fp8(const float* src, unsigned char* dst, float* scl, int gw, int ngw, int lane) {
    for (int row = gw; row < 16384; row += ngw) {
        const f32x4* sp = (const f32x4*)(src + (size_t)row * 1024 + 16 * lane);
        const f32x4 a0 = sp[0], a1 = sp[1], a2 = sp[2], a3 = sp[3];
        float m = fmaxf(fmaxf(fmaxf(fabsf(a0.x), fabsf(a0.y)), fmaxf(fabsf(a0.z), fabsf(a0.w))), fmaxf(fmaxf(fabsf(a1.x), fabsf(a1.y)), fmaxf(fabsf(a1.z), fabsf(a1.w))));
        m = fmaxf(m, fmaxf(fmaxf(fmaxf(fabsf(a2.x), fabsf(a2.y)), fmaxf(fabsf(a2.z), fabsf(a2.w))), fmaxf(fmaxf(fabsf(a3.x), fabsf(a3.y)), fmaxf(fabsf(a3.z), fabsf(a3.w)))));
#pragma unroll
        for (int o = 1; o < 64; o <<= 1) m = fmaxf(m, __shfl_xor(m, o));
        m = fmaxf(m, 1e-30f);
        const float q = 127.0f / m;
        v4u o;
        o.x = q8(a0.x * q) | (q8(a0.y * q) << 8) | (q8(a0.z * q) << 16) | (q8(a0.w * q) << 24);
        o.y = q8(a1.x * q) | (q8(a1.y * q) << 8) | (q8(a1.z * q) << 16) | (q8(a1.w * q) << 24);
        o.z = q8(a2.x * q) | (q8(a2.y * q) << 8) | (q8(a2.z * q) << 16) | (q8(a2.w * q) << 24);
        o.w = q8(a3.x * q) | (q8(a3.y * q) << 8) | (q8(a3.z * q) << 16) | (q8(a3.w * q) << 24);
        *(v4u*)(dst + (size_t)row * 1024 + 16 * lane) = o;
        if (lane == 0) scl[row] = m * (1.0f / 127.0f);
    }
}
__device__ __forceinline__ int row16_sum_i(int v) {
    v += __builtin_amdgcn_update_dpp(0, v, 0xB1, 0xF, 0xF, true);
    v += __builtin_amdgcn_update_dpp(0, v, 0x4E, 0xF, 0xF, true);
    v += __builtin_amdgcn_update_dpp(0, v, 0x141, 0xF, 0xF, true);
    v += __builtin_amdgcn_update_dpp(0, v, 0x140, 0xF, 0xF, true);
    return v;
}
constexpr int PE_NT = 4, PE_NR = 16, PE_SH = 10, PE_DEP = 3;
constexpr int PE_TOK_W = 128 * 3 + 20;
constexpr int PE_ENT_W = 272 * 4;
constexpr int PE_WAVE_W = PE_NT * PE_TOK_W + PE_ENT_W + 32 * 33 + 2 * PE_NT * 128;
static_assert(8 * PE_WAVE_W * 4 <= MISC_OFF && PE_NR * PE_NT == 64, "peer LDS / batch-list geometry");
#define PE_LD(dst, voff_, sbase_) asm volatile("s_nop 4\n\tglobal_load_dwordx4 %0, %1, %2" : "=&v"(dst) : "v"(voff_), "s"(sbase_) : "memory")
__device__ __forceinline__ void peer_pass(const Params& P, LAS unsigned char* lds, int tbase, int lane, int wave, float* dstbase, int emask = 0x3fff) {
    asm volatile("v_mbcnt_lo_u32_b32 %0, -1, 0\n\tv_mbcnt_hi_u32_b32 %0, -1, %0" : "=v"(lane));
    {
        LAS unsigned* lw0 = (LAS unsigned*)(lds) + wave * PE_WAVE_W + PE_NT * PE_TOK_W + PE_ENT_W;
        peer_topk_wave(P, (LAS int*)lw0, lw0 + 32 * 33, (LAS float*)(lw0 + 32 * 33 + PE_NT * 128), tbase, lane);
        LDS_WAIT(); asm volatile("" : "+v"(lane), "+s"(tbase) :: "memory");
    }
    const unsigned char* ws = P.ws;
    const unsigned char* UB8 = ws + WS_UB; const unsigned char* VB8 = ws + WS_VB;
    const float* USC = (const float*)(ws + WS_USC); const float* VSC = (const float*)(ws + WS_VSC);
    f32x2 acc[PE_NT][8];
    LAS unsigned* lw = (LAS unsigned*)(lds) + wave * PE_WAVE_W;
    LAS unsigned* ents = lw + PE_NT * PE_TOK_W;
    const unsigned voff = (unsigned)lane * 16u;
    LAS unsigned* upe = ents + PE_ENT_W + 32 * 33; LAS float* upg = (LAS float*)(upe + PE_NT * 128);
    LAS unsigned* hql = ents + PE_ENT_W;
#pragma unroll
    for (int j = 0; j < PE_NT; ++j) {
        const int t = tbase + j;
        const v4u* xrow = (const v4u*)((const bf16*)(ws + WS_XB) + (size_t)t * 1024 + 16 * lane);
        const v4u xa = xrow[0], xc = xrow[1];
        const f32x4 xvv[4] = {(f32x4){bflo(xa.x), bfhi(xa.x), bflo(xa.y), bfhi(xa.y)}, (f32x4){bflo(xa.z), bfhi(xa.z), bflo(xa.w), bfhi(xa.w)},
                              (f32x4){bflo(xc.x), bfhi(xc.x), bflo(xc.y), bfhi(xc.y)}, (f32x4){bflo(xc.z), bfhi(xc.z), bflo(xc.w), bfhi(xc.w)}};
        const float rstd2 = rsqrtf(((const float*)(ws + WS_SSQ2))[t] * (1.0f / 1024.0f) + 1e-6f);
        f32x4 hv[4]; float hm = 0.f;
#pragma unroll
        for (int i = 0; i < 4; ++i) { const f32x4 xv = xvv[i]; const f32x4 w = ((const f32x4*)(P.norm_ffn_w + 16 * lane))[i];
            hv[i] = (f32x4){xv.x * rstd2 * w.x, xv.y * rstd2 * w.y, xv.z * rstd2 * w.z, xv.w * rstd2 * w.w};
            hm = fmaxf(hm, fmaxf(fmaxf(fabsf(hv[i].x), fabsf(hv[i].y)), fmaxf(fabsf(hv[i].z), fabsf(hv[i].w)))); }
#pragma unroll
        for (int o = 1; o < 64; o <<= 1) hm = fmaxf(hm, __shfl_xor(hm, o));
        hm = fmaxf(hm, 1e-30f);
        const float hqs = 127.0f / hm, hs = hm * (1.0f / 127.0f);
        { unsigned hqv[4];
#pragma unroll
          for (int i = 0; i < 4; ++i) hqv[i] = q8(hv[i].x * hqs) | (q8(hv[i].y * hqs) << 8) | (q8(hv[i].z * hqs) << 16) | (q8(hv[i].w * hqs) << 24);
          *(LAS v4u*)(hql + (j * 64 + lane) * 4) = (v4u){hqv[0], hqv[1], hqv[2], hqv[3]}; }
#pragma unroll
        for (int i = 0; i < 8; ++i) acc[j][i] = (f32x2){0.f, 0.f};
        const int e0 = (int)upe[j * 128 + 2 * lane] & emask, e1 = (int)upe[j * 128 + 2 * lane + 1] & emask;
        const float g0 = upg[j * 128 + 2 * lane] * VSC[e0], g1 = upg[j * 128 + 2 * lane + 1] * VSC[e1];
        const float u0 = USC[e0] * hs, u1 = USC[e1] * hs;
        const int b0 = e0 >> PE_SH, b1 = e1 >> PE_SH;
        LAS unsigned* lt = lw + j * PE_TOK_W;
        int run = 0;
#pragma unroll 1
        for (int bk = 0; bk < PE_NR; ++bk) {
            const unsigned long long m0 = __ballot(b0 == bk), m1 = __ballot(b1 == bk);
            const int c0 = __popcll(m0), c1 = __popcll(m1);
            const unsigned long long lower = (1ull << lane) - 1ull;
            if (b0 == bk) { const int p = run + __popcll(m0 & lower); lt[p] = (unsigned)e0; lt[128 + p] = __builtin_bit_cast(unsigned, g0); lt[256 + p] = __builtin_bit_cast(unsigned, u0); }
            if (b1 == bk) { const int p = run + c0 + __popcll(m1 & lower); lt[p] = (unsigned)e1; lt[128 + p] = __builtin_bit_cast(unsigned, g1); lt[256 + p] = __builtin_bit_cast(unsigned, u1); }
            if (lane == 0) lt[384 + bk] = (unsigned)run;
            run += c0 + c1;
        }
        if (lane == 0) lt[384 + PE_NR] = 128u;
        asm volatile("" ::: "memory");
    }
    LDS_WAIT(); asm volatile("" ::: "memory");
    int nb;
    {
        const int rd = lane >> 2, j = lane & 3;
        const LAS unsigned* lt = lw + j * PE_TOK_W;
        const int n0 = (int)lt[384 + rd], n1 = (int)lt[384 + rd + 1];
        const int nbl = (n1 - n0 + 3) >> 2;
        int inc = nbl;
#pragma unroll
        for (int off = 1; off < 64; off <<= 1) { const int tv = __shfl_up(inc, off); if (lane >= off) inc += tv; }
        nb = __builtin_amdgcn_readlane(inc, 63);
        const int ofs = inc - nbl;
#pragma unroll 1
        for (int q = 0; q < nbl; ++q) { const int i0 = n0 + 4 * q, c = (n1 - i0) < 4 ? (n1 - i0) : 4;
            const unsigned e0 = lt[i0], e1 = lt[i0 + (c > 1 ? 1 : c - 1)], e2 = lt[i0 + (c > 2 ? 2 : c - 1)], e3 = lt[i0 + (c > 3 ? 3 : c - 1)];
            *(LAS v4u*)(ents + 4 * (ofs + q)) = (v4u){e0 | (((unsigned)j | ((unsigned)c << 2) | ((unsigned)i0 << 5)) << 14), e1, e2, e3}; }
        if (lane < 2 * PE_DEP) *(LAS v4u*)(ents + 4 * (nb + lane)) = (v4u){0u, 0u, 0u, 0u};
    }
    LDS_WAIT(); asm volatile("" ::: "memory");
    v4u ru[PE_DEP][4], rv[PE_DEP][4];
#define PE_LDO(dst, vo_, sbase_) asm volatile("global_load_dwordx4 %0, %1, %2" : "=&v"(dst) : "v"(vo_), "s"(sbase_) : "memory")
#define PE_ISSUE(S, rec_) do { const unsigned e0_ = (rec_).x & 0x3fffu; \
        { const unsigned vo_ = (e0_ << 10) + voff; PE_LDO(ru[S][0], vo_, UB8); PE_LDO(rv[S][0], vo_, VB8); } \
        { const unsigned vo_ = ((rec_).y << 10) + voff; PE_LDO(ru[S][1], vo_, UB8); PE_LDO(rv[S][1], vo_, VB8); } \
        { const unsigned vo_ = ((rec_).z << 10) + voff; PE_LDO(ru[S][2], vo_, UB8); PE_LDO(rv[S][2], vo_, VB8); } \
        { const unsigned vo_ = ((rec_).w << 10) + voff; PE_LDO(ru[S][3], vo_, UB8); PE_LDO(rv[S][3], vo_, VB8); } } while (0)
#define PE_WAIT8(S, cntstr) asm volatile("s_waitcnt " cntstr : "+v"(ru[S][0]), "+v"(ru[S][1]), "+v"(ru[S][2]), "+v"(ru[S][3]), "+v"(rv[S][0]), "+v"(rv[S][1]), "+v"(rv[S][2]), "+v"(rv[S][3]) :: "memory")
#define PE_UDOTS(S) asm("v_dot4_i32_i8 %0, %4, %20, 0\n\tv_dot4_i32_i8 %1, %8, %20, 0\n\tv_dot4_i32_i8 %2, %12, %20, 0\n\tv_dot4_i32_i8 %3, %16, %20, 0\n\t" \
                        "v_dot4_i32_i8 %0, %5, %21, %0\n\tv_dot4_i32_i8 %1, %9, %21, %1\n\tv_dot4_i32_i8 %2, %13, %21, %2\n\tv_dot4_i32_i8 %3, %17, %21, %3\n\t" \
                        "v_dot4_i32_i8 %0, %6, %22, %0\n\tv_dot4_i32_i8 %1, %10, %22, %1\n\tv_dot4_i32_i8 %2, %14, %22, %2\n\tv_dot4_i32_i8 %3, %18, %22, %3\n\t" \
                        "v_dot4_i32_i8 %0, %7, %23, %0\n\tv_dot4_i32_i8 %1, %11, %23, %1\n\tv_dot4_i32_i8 %2, %15, %23, %2\n\tv_dot4_i32_i8 %3, %19, %23, %3\n\ts_nop 2" \
        : "=&v"(d_[0]), "=&v"(d_[1]), "=&v"(d_[2]), "=&v"(d_[3]) \
        : "v"(ru[S][0].x), "v"(ru[S][0].y), "v"(ru[S][0].z), "v"(ru[S][0].w), "v"(ru[S][1].x), "v"(ru[S][1].y), "v"(ru[S][1].z), "v"(ru[S][1].w), \
          "v"(ru[S][2].x), "v"(ru[S][2].y), "v"(ru[S][2].z), "v"(ru[S][2].w), "v"(ru[S][3].x), "v"(ru[S][3].y), "v"(ru[S][3].z), "v"(ru[S][3].w), \
          "v"(hcur.x), "v"(hcur.y), "v"(hcur.z), "v"(hcur.w))
#define PE_UDOTS_SAFE(S) do { _Pragma("unroll") for (int k_ = 0; k_ < 4; ++k_) { int s_ = __builtin_amdgcn_sdot4((int)ru[S][k_].x, (int)hcur.x, 0, false); s_ = __builtin_amdgcn_sdot4((int)ru[S][k_].y, (int)hcur.y, s_, false); \
            s_ = __builtin_amdgcn_sdot4((int)ru[S][k_].z, (int)hcur.z, s_, false); s_ = __builtin_amdgcn_sdot4((int)ru[S][k_].w, (int)hcur.w, s_, false); d_[k_] = s_; } } while (0)
#define PE_VDOTS_SAFE(f0, f1, f2, f3, b0, b1, b2, b3, w) do { f0 = (float)__builtin_amdgcn_sdot4((int)(b0), (int)(w), 0, false); f1 = (float)__builtin_amdgcn_sdot4((int)(b1), (int)(w), 0, false); \
            f2 = (float)__builtin_amdgcn_sdot4((int)(b2), (int)(w), 0, false); f3 = (float)__builtin_amdgcn_sdot4((int)(b3), (int)(w), 0, false); } while (0)
#define PE_VDOTS(f0, f1, f2, f3, b0, b1, b2, b3, w) asm("v_dot4_i32_i8 %0, %4, %8, 0\n\tv_dot4_i32_i8 %1, %5, %8, 0\n\tv_dot4_i32_i8 %2, %6, %8, 0\n\tv_dot4_i32_i8 %3, %7, %8, 0\n\t" \
                        "v_cvt_f32_i32_e32 %0, %0\n\tv_cvt_f32_i32_e32 %1, %1\n\tv_cvt_f32_i32_e32 %2, %2\n\tv_cvt_f32_i32_e32 %3, %3" \
        : "=&v"(f0), "=&v"(f1), "=&v"(f2), "=&v"(f3) : "v"(b0), "v"(b1), "v"(b2), "v"(b3), "v"(w))
#define PE_COMPUTE_B(S, c_, i_, j_, SG) do { const LAS unsigned* lt_ = lw + (j_) * PE_TOK_W; \
        const int myk_ = lane >> 4; \
        float gsc_ = __builtin_bit_cast(float, lt_[128 + i_ + myk_]), usc_ = __builtin_bit_cast(float, lt_[256 + i_ + myk_]);     \
        int d_[4]; \
        PE_UDOTS(S); \
        int r1_; \
        { const v2u p02_ = __builtin_amdgcn_permlane32_swap((unsigned)d_[0], (unsigned)d_[2], false, false), p13_ = __builtin_amdgcn_permlane32_swap((unsigned)d_[1], (unsigned)d_[3], false, false); \
          const v2u q_ = __builtin_amdgcn_permlane16_swap(p02_.x + p02_.y, p13_.x + p13_.y, false, false); r1_ = row16_sum_i((int)(q_.x + q_.y)); }     \
        float act_; \
        { const float x_ = (float)r1_ * usc_, e_ = __builtin_amdgcn_exp2f(x_ * __builtin_fmaf(x_ * x_, -0.10294324f, -2.3022082f));     \
          act_ = x_ * __builtin_amdgcn_rcpf(1.0f + e_) * gsc_; act_ = (myk_ < c_) ? act_ : 0.f; } \
        float wm_; \
        { unsigned wmu_ = __builtin_bit_cast(unsigned, act_) & 0x7fffffffu;                 \
          v2u t_ = __builtin_amdgcn_permlane32_swap(wmu_, wmu_, false, false); wmu_ = t_.x > t_.y ? t_.x : t_.y; \
          t_ = __builtin_amdgcn_permlane16_swap(wmu_, wmu_, false, false); wmu_ = t_.x > t_.y ? t_.x : t_.y; \
          wm_ = fmaxf(__builtin_bit_cast(float, wmu_), 1e-30f); } \
        const float wq_ = 127.0f * __builtin_amdgcn_rcpf(wm_), ws_ = (SG) * wm_ * (1.0f / 127.0f); \
        unsigned w4u_ = (__builtin_bit_cast(unsigned, __builtin_fmaf(act_, wq_, 12582912.0f)) & 0xffu) << (8 * myk_); \
        { v2u t_ = __builtin_amdgcn_permlane32_swap(w4u_, w4u_, false, false); w4u_ = t_.x | t_.y; t_ = __builtin_amdgcn_permlane16_swap(w4u_, w4u_, false, false); w4u_ = t_.x | t_.y; } \
        const f32x2 ws2_ = (f32x2){ws_, ws_}; \
        _Pragma("unroll") for (int m_ = 0; m_ < 4; ++m_) { \
            const unsigned R0_ = rv[S][0][m_], R1_ = rv[S][1][m_], R2_ = rv[S][2][m_], R3_ = rv[S][3][m_]; \
            const unsigned X_ = __builtin_amdgcn_perm(R1_, R0_, 0x05010400u), Y_ = __builtin_amdgcn_perm(R1_, R0_, 0x07030602u), Z_ = __builtin_amdgcn_perm(R3_, R2_, 0x05010400u), W_ = __builtin_amdgcn_perm(R3_, R2_, 0x07030602u); \
            float t0_, t1_, t2_, t3_; \
            const unsigned b0_ = __builtin_amdgcn_perm(Z_, X_, 0x05040100u), b1_ = __builtin_amdgcn_perm(Z_, X_, 0x07060302u), b2_ = __builtin_amdgcn_perm(W_, Y_, 0x05040100u), b3_ = __builtin_amdgcn_perm(W_, Y_, 0x07060302u); \
            PE_VDOTS(t0_, t1_, t2_, t3_, b0_, b1_, b2_, b3_, w4u_); \
            cur[2 * m_] = __builtin_elementwise_fma((f32x2){t0_, t1_}, ws2_, cur[2 * m_]); \
            cur[2 * m_ + 1] = __builtin_elementwise_fma((f32x2){t2_, t3_}, ws2_, cur[2 * m_ + 1]); } } while (0)
#define PE_FLUSH() do { _Pragma("unroll") for (int J_ = 0; J_ < PE_NT; ++J_) { const float sel_ = (jcur == J_) ? 1.0f : 0.0f; const f32x2 sel2_ = (f32x2){sel_, sel_};     \
            _Pragma("unroll") for (int i_ = 0; i_ < 8; ++i_) acc[J_][i_] = __builtin_elementwise_fma(cur[i_], sel2_, acc[J_][i_]); } \
        _Pragma("unroll") for (int i_ = 0; i_ < 8; ++i_) cur[i_] = (f32x2){0.f, 0.f}; } while (0)
#define PE_COMPUTE_S(S, entv, SG) do { const unsigned en_ = (entv) >> 14; const int jj_ = (int)(en_ & 3u), cc_ = (int)((en_ >> 2) & 7u), ii_ = (int)(en_ >> 5); \
        if (cc_ > 0) { if (jj_ != jcur) { PE_FLUSH(); jcur = jj_; hcur = *(const LAS v4u*)(hql + (jj_ * 64 + lane) * 4); } \
                       PE_COMPUTE_B(S, cc_, ii_, jj_, SG); } } while (0)
#ifdef PE_VALU3
#define PE_COMPUTE(S, entv) do { PE_COMPUTE_S(S, entv, 1.0f); PE_WAIT8(S, "vmcnt(16)"); PE_COMPUTE_S(S, entv, -1.0f); PE_WAIT8(S, "vmcnt(16)"); PE_COMPUTE_S(S, entv, 1.0f); } while (0)
#else
#define PE_COMPUTE(S, entv) PE_COMPUTE_S(S, entv, 1.0f)
#endif
    {
        unsigned er[PE_DEP];
#pragma unroll
        for (int q = 0; q < PE_DEP; ++q) { const v4u rec = *(const LAS v4u*)(ents + 4 * q); er[q] = __builtin_amdgcn_readfirstlane(rec.x); PE_ISSUE(q, rec); }
        f32x2 cur[8];
#pragma unroll
        for (int i = 0; i < 8; ++i) cur[i] = (f32x2){0.f, 0.f};
        int jcur = (int)((er[0] >> 14) & 3u);
        v4u hcur = *(const LAS v4u*)(hql + (jcur * 64 + lane) * 4);
#pragma unroll 1
        for (int bi = 0; bi < nb; bi += PE_DEP) {
#pragma unroll
            for (int q = 0; q < PE_DEP; ++q) {
                PE_WAIT8(q, "vmcnt(16)");
                const v4u nrec = *(const LAS v4u*)(ents + 4 * (bi + q + PE_DEP));
                PE_COMPUTE(q, er[q]);
                er[q] = __builtin_amdgcn_readfirstlane(nrec.x);
                PE_ISSUE(q, nrec);
            }
        }
#pragma unroll
        for (int q = 0; q < PE_DEP; ++q) PE_WAIT8(q, "vmcnt(0)");
        PE_FLUSH();
    }
#undef PE_COMPUTE
#undef PE_COMPUTE_S
#undef PE_COMPUTE_B
#undef PE_FLUSH
#undef PE_WAIT8
#undef PE_ISSUE
#undef PE_LDO
#undef PE_UDOTS
#undef PE_VDOTS
    asm volatile("v_mbcnt_lo_u32_b32 %0, -1, 0\n\tv_mbcnt_hi_u32_b32 %0, -1, %0" : "=v"(lane)); asm volatile("" : "+s"(tbase));
#pragma unroll
    for (int j = 0; j < PE_NT; ++j) {
        const int t = tbase + j;
        float ss = 0.f; f32x4 xo[4];
        { const v4u* xrow = (const v4u*)((const bf16*)(ws + WS_XB) + (size_t)t * 1024 + 16 * lane); const v4u xa = xrow[0], xc = xrow[1];
          xo[0] = (f32x4){bflo(xa.x), bfhi(xa.x), bflo(xa.y), bfhi(xa.y)}; xo[1] = (f32x4){bflo(xa.z), bfhi(xa.z), bflo(xa.w), bfhi(xa.w)};
          xo[2] = (f32x4){bflo(xc.x), bfhi(xc.x), bflo(xc.y), bfhi(xc.y)}; xo[3] = (f32x4){bflo(xc.z), bfhi(xc.z), bflo(xc.w), bfhi(xc.w)}; }
#pragma unroll
        for (int i = 0; i < 4; ++i) { xo[i].x += acc[j][2 * i].x; xo[i].y += acc[j][2 * i].y; xo[i].z += acc[j][2 * i + 1].x; xo[i].w += acc[j][2 * i + 1].y;
            ss += (xo[i].x * xo[i].x + xo[i].y * xo[i].y) + (xo[i].z * xo[i].z + xo[i].w * xo[i].w); }
        const float rstd3 = rsqrtf(wave_sum(ss) * (1.0f / 1024.0f) + 1e-6f);
        float* orow = dstbase + (size_t)t * 1024 + 16 * lane;
#pragma unroll
        for (int i = 0; i < 4; ++i) { const f32x4 w = ((const f32x4*)(P.norm_final_w + 16 * lane))[i];
            ((f32x4*)orow)[i] = (f32x4){xo[i].x * rstd3 * w.x, xo[i].y * rstd3 * w.y, xo[i].z * rstd3 * w.z, xo[i].w * rstd3 * w.w}; }
    }
    LDS_WAIT(); asm volatile("s_waitcnt vmcnt(0)" ::: "memory");
}


#ifndef TWICE_MASK
#define TWICE_MASK 0
#endif
struct TwiceOrder { pg8::StaticOrder S; int per, reps;
    __device__ bool next(int i, pg8::Unit& u) const { if (i >= per * reps) return false; return S.next(i % per, u); }
    __device__ __forceinline__ void a_ready(const pg8::Unit&) const {} __device__ __forceinline__ void done(const pg8::Unit&) const {} };
template <class B> __device__ __forceinline__ bool rep_again(volatile LAS unsigned* MISC, B& bar) {
    __syncthreads(); const unsigned c = MISC[20]; __syncthreads();
    if (threadIdx.x == 0) MISC[20] = c ^ 1u;
    __syncthreads();
    if (c == 0u) { xcd_barrier(bar); return true; }
    return false;
}
__global__ void __launch_bounds__(NWAVES * 64, 2) hybrid_fwd(Params P) {
    extern __shared__ __attribute__((aligned(16))) unsigned char lds_raw[];
    LAS unsigned char* lds = (LAS unsigned char*)lds_raw;
    volatile LAS unsigned* MISC = (volatile LAS unsigned*)(lds + MISC_OFF);
    const int tid = threadIdx.x, lane = tid & 63, wave = __builtin_amdgcn_readfirstlane(tid >> 6);
    const int G = gridDim.x, bx = blockIdx.x;
    const int vcu = (G % 8 == 0) ? (bx % 8) * (G / 8) + bx / 8 : bx;
    unsigned char* ws = P.ws;
    for (int u = tid; u < 64; u += NWAVES * 64) MISC[u] = 0u;
    __syncthreads();
    XcdBarrier bar; bar.bar = (unsigned*)(ws + WS_CTL) + CW_BAR; bar.x = 0; bar.st = nullptr;
    if (!MK_PER_PHASE) bar = xcd_barrier_post((unsigned*)(ws + WS_CTL) + CW_BAR, MISC + 8);
    const int lo = P.ph_lo, hi = P.ph_hi;
#ifndef PHASE_MASK
#define PHASE_MASK 0xFFF
#endif
#define IN(k) (((PHASE_MASK >> (k)) & 1) && lo <= (k) && (k) < hi)
#define SEAM(k) do { if (IN(k) && IN((k) + 1)) xcd_barrier(bar); } while (0)
#ifndef REP_MASK
#define REP_MASK 0
#endif
#ifndef PE_EXP_MASK
#define PE_EXP_MASK 0x3fff
#endif
#define REPS(k) for (bool again_ = true; again_; again_ = (((REP_MASK >> (k)) & 1) ? rep_again(MISC, bar) : false))
    using namespace pg8;
    bf16* XB = (bf16*)(ws + WS_XB);

    if (IN(0)) REPS(0) { p0_prologue(P, lds, tid, lane, wave, vcu, G); }
    SEAM(0);
    if (IN(1)) REPS(1) {
        { Gemm gm{XB, (const bf16_t*)(ws + WS_WIN), T, 3072, 1024}; StaticOrder S; S.init(T, 3072, G, bx);
          EpiBf16Rs E{(bf16_t*)(ws + WS_QKV), 1536, 6, (bf16_t*)(ws + WS_XR), 512, (size_t)T * 512, nullptr, 1.0f};
          gemm_phase<EpiBf16Rs, StaticOrder, PG8_ALIGN, PG8_SP2>(lds, gm, S, E); }
    }
    SEAM(1);
    if (IN(3)) REPS(3) {
        if (bx < SCAN_WGS) gdn_scan(P, lds, bx, tid, lane, wave);
        else {
            const int wk = bx - SCAN_WGS, NWK = G - SCAN_WGS;
            unsigned* lcnt = (unsigned*)(ws + WS_CTL) + CW_LRUCNT;
            for (int q = wk; q < 1024; q += NWK) gdn_local_item(P, lds, (q & 7) * 128 + (q >> 3), tid);
            if (wk < 16) {
                struct OneUnit { int pm, pn; __device__ bool next(int i, Unit& u) const { if (i > 0) return false; u.pm = pm; u.pn = pn; return true; }
                                 __device__ void a_ready(const Unit&) const {} __device__ void done(const Unit&) const {} };
                Gemm gm{(const bf16_t*)(ws + WS_MEMN), (const bf16_t*)(ws + WS_WKV), 512, 2048, 1024}; OneUnit S{wk >> 3, wk & 7};
                EpiKV E{(bf16_t*)(ws + WS_KB), (bf16_t*)(ws + WS_VTP)};
                gemm_phase<EpiKV, OneUnit, PG8_ALIGN, PG8_SP2>(lds, gm, S, E);
            }
            unsigned ndone = 0;
            for (int lt = wk; lt < 256; lt += NWK) { lru_local_item(P, lds, lt, tid, lane, wave); ++ndone; }
            asm volatile("s_waitcnt vmcnt(0)" ::: "memory");
            __syncthreads();
            if (tid == 0 && ndone) { __builtin_amdgcn_fence(__ATOMIC_RELEASE, "agent"); asm volatile("s_waitcnt vmcnt(0)" ::: "memory");
                                     __hip_atomic_fetch_add(lcnt, ndone, __ATOMIC_RELAXED, __HIP_MEMORY_SCOPE_AGENT); }
            if (wk == 16 || wk == 17) {
                if (tid == 0) { unsigned sp = 0;
                    while (__hip_atomic_load(lcnt, __ATOMIC_RELAXED, __HIP_MEMORY_SCOPE_AGENT) < 256u) { __builtin_amdgcn_s_sleep(8); if (++sp > (1u << 22)) break; }
                    __builtin_amdgcn_fence(__ATOMIC_ACQUIRE, "agent"); asm volatile("s_waitcnt vmcnt(0)" ::: "memory"); }
                __syncthreads();
                lru_carry(P, (wk - 16) * NWAVES + wave, lane);
                asm volatile("s_waitcnt vmcnt(0)" ::: "memory");
                __syncthreads();
                if (tid == 0) { __builtin_amdgcn_fence(__ATOMIC_RELEASE, "agent"); asm volatile("s_waitcnt vmcnt(0)" ::: "memory");
                                __hip_atomic_fetch_add(lcnt + 64, 1u, __ATOMIC_RELAXED, __HIP_MEMORY_SCOPE_AGENT); }
            } else {
                const int w2 = (wk < 16 ? wk : wk - 2), N2 = NWK - 2;
                cvt_table_fp8(P.peer_v, ws + WS_VB, (float*)(ws + WS_VSC), w2 * NWAVES + wave, N2 * NWAVES, lane);
                late_weight_prep(P, lds, lane, wave, w2 * NWAVES + wave, N2 * NWAVES);
                if (tid == 0) { unsigned sp = 0;
                    while (__hip_atomic_load(lcnt + 64, __ATOMIC_RELAXED, __HIP_MEMORY_SCOPE_AGENT) < 2u) { __builtin_amdgcn_s_sleep(8); if (++sp > (1u << 22)) break; }
                    __builtin_amdgcn_fence(__ATOMIC_ACQUIRE, "agent"); asm volatile("s_waitcnt vmcnt(0)" ::: "memory"); }
                __syncthreads();
                lru_combine(P, (size_t)w2 * (NWAVES * 64) + tid, (size_t)N2 * (NWAVES * 64));
            }
        }
    }
    SEAM(3);
    if (IN(4)) REPS(4) {
        gdn_gate_norm(P, (size_t)bx * (NWAVES * 64) + tid, (size_t)G * (NWAVES * 64));
        cvt_table_fp8(P.peer_u, ws + WS_UB, (float*)(ws + WS_USC), bx * NWAVES + wave, G * NWAVES, lane);
    }
    SEAM(4);
    if (IN(5)) {
        Gemm gm{(const bf16_t*)((const unsigned char*)P.out + OUT_Y), (const bf16_t*)(ws + WS_WOUT), T, 1024, 1024}; StaticOrder S; S.init(T, 1024, G, bx);
        EpiResidBf<true> E{P.x, XB, (float*)(ws + WS_SSQ1)};
        gemm_phase<EpiResidBf<true>, StaticOrder, PG8_ALIGN, PG8_SP2>(lds, gm, S, E);
    }
    SEAM(5);
    if (IN(6)) REPS(6) {
        Gemm gm{XB, (const bf16_t*)(ws + WS_WQ), T, 1024, 1024};
        EpiBf16Rs E{(bf16_t*)(ws + WS_Q), 1024, 4, nullptr, 256, 0, (const float*)(ws + WS_SSQ1), 0.0625f};
#if (TWICE_MASK >> 6) & 1
        { TwiceOrder S; S.S.init(T, 1024, G, bx); S.per = 1; S.reps = 2;
          gemm_phase<EpiBf16Rs, TwiceOrder, PG8_ALIGN, PG8_SP2>(lds, gm, S, E); }
#else
        { StaticOrder S; S.init(T, 1024, G, bx);
          gemm_phase<EpiBf16Rs, StaticOrder, PG8_ALIGN, PG8_SP2>(lds, gm, S, E); }
#endif
        Unit u;
        { const int wgid = (bx & 7) * 32 + (bx >> 3); u.pm = (wgid >> 5) * 8 + (wgid & 7); u.pn = (wgid & 31) >> 3; }
        if (G == 256) {
            asm volatile("s_waitcnt vmcnt(0)" ::: "memory");
            __syncthreads();
            const int b = u.pm >> 5, qb0 = (u.pm & 31) * 2, h = u.pn;
#pragma unroll 1
            for (int qq = 0; qq < (((TWICE_MASK >> 7) & 1) ? 4 : 2); ++qq) xattn_unit(P, lds, (b << 8) | ((qb0 + (qq & 1)) << 2) | h, tid, lane, wave);
        }
    }
    if (IN(7)) REPS(7) { }
    SEAM(7);
    if (IN(8)) {
        Gemm gm{(const bf16_t*)(ws + WS_AO), (const bf16_t*)(ws + WS_WO), T, 1024, 1024}; StaticOrder S; S.init(T, 1024, G, bx);
        EpiResidBf<false> E{nullptr, XB, (float*)(ws + WS_SSQ2)};
        gemm_phase<EpiResidBf<false>, StaticOrder, PG8_ALIGN, PG8_SP2>(lds, gm, S, E);
    }
    SEAM(8);
    if (IN(9)) REPS(9) {
        Gemm gm{XB, (const bf16_t*)(ws + WS_PWQ), T, 2048, 1024};
        EpiF16Rs E{(_Float16*)(ws + WS_PQ), 2048, (const float*)(ws + WS_SSQ2)};
#if (TWICE_MASK >> 9) & 1
        TwiceOrder S; S.S.init(T, 2048, G, bx); S.per = 2; S.reps = 2;
        gemm_phase<EpiF16Rs, TwiceOrder, PG8_ALIGN, PG8_SP2>(lds, gm, S, E);
#else
        StaticOrder S; S.init(T, 2048, G, bx);
        gemm_phase<EpiF16Rs, StaticOrder, PG8_ALIGN, PG8_SP2>(lds, gm, S, E);
#endif
    }
    SEAM(9);
    if (IN(10)) REPS(10) {
    }
    if (IN(11)) REPS(11) {
#if (TWICE_MASK >> 11) & 1
        for (int it = 0; it < 4; ++it) { const int tb = (bx * NWAVES + wave) * PE_NT + (it >> 1) * (G * NWAVES * PE_NT); if (tb < T) peer_pass(P, lds, tb, lane, wave, P.out, (it & 1) ? 0x3fff : PE_EXP_MASK); }
#else
#ifndef PE_PASS_BARRIER
#define PE_PASS_BARRIER 0
#endif
        for (int tb = (bx * NWAVES + wave) * PE_NT, np = 0; tb < T; tb += G * NWAVES * PE_NT, ++np) {
            if (PE_PASS_BARRIER && np > 0 && (T % (G * NWAVES * PE_NT)) == 0) xcd_barrier(bar);
            peer_pass(P, lds, tb, lane, wave, P.out);
        }
#endif
    }
#undef IN
#undef SEAM
}

extern "C" void kernel_launch(void* const* d_in, const int* in_sizes, int n_in, void* d_out, int out_size, void* d_ws, size_t ws_size, hipStream_t stream) {
    static int grid = 0;
    if (grid == 0) {
        if (n_in != 27 || in_sizes[0] != T * D || out_size != T * D || ws_size < WS_END) {
            fprintf(stderr, "kernel_launch: unexpected shapes (n_in %d, in0 %d, out %d, ws %zu); nothing launched\n", n_in, n_in > 0 ? in_sizes[0] : -1, out_size, ws_size); grid = -1; return; }
        int dev = 0, cus = 0, per_cu = 0;
        if (hipGetDevice(&dev) != hipSuccess || hipDeviceGetAttribute(&cus, hipDeviceAttributeMultiprocessorCount, dev) != hipSuccess) { grid = -1; return; }
        if (hipFuncSetAttribute((const void*)hybrid_fwd, hipFuncAttributeMaxDynamicSharedMemorySize, LDS_BYTES) != hipSuccess) { fprintf(stderr, "kernel_launch: hipFuncSetAttribute failed\n"); grid = -1; return; }
        if (hipOccupancyMaxActiveBlocksPerMultiprocessor(&per_cu, (const void*)hybrid_fwd, NWAVES * 64, LDS_BYTES) != hipSuccess || per_cu < 1)
            fprintf(stderr, "kernel_launch: note: occupancy query reports %d workgroups per CU\n", per_cu);
        (void)hipGetLastError();
        grid = cus;
        if (grid != 256) fprintf(stderr, "kernel_launch: %d CUs (built for 256)\n", grid);
    }
    if (grid < 0) return;
    if (hipMemsetAsync((char*)d_ws + WS_CTL, 0, CTL_ZERO_BYTES, stream) != hipSuccess) { fprintf(stderr, "kernel_launch: hipMemsetAsync failed\n"); return; }
    Params p{};
    const float** pp = (const float**)&p;
    for (int i = 0; i < 27; ++i) pp[i] = (const float*)d_in[i];
    p.out = (float*)d_out; p.ws = (unsigned char*)d_ws;
#if MK_PER_PHASE
    for (int k = 0; k < N_PHASES; ++k) { p.ph_lo = k; p.ph_hi = k + 1; hipLaunchKernelGGL(hybrid_fwd, dim3(grid), dim3(NWAVES * 64), LDS_BYTES, stream, p); }
#else
    p.ph_lo = 0; p.ph_hi = N_PHASES;
    hipLaunchKernelGGL(hybrid_fwd, dim3(grid), dim3(NWAVES * 64), LDS_BYTES, stream, p);
#endif
    const hipError_t le = hipPeekAtLastError();
    if (le != hipSuccess) fprintf(stderr, "kernel_launch: launch failed: %s\n", hipGetErrorName(le));
}
```

```cpp
#include <hip/hip_runtime.h>
#include <cstdio>
#include <cstdint>
namespace pg8 {
#define PG8_LAS __attribute__((address_space(3)))
typedef unsigned short bf16_t;
typedef short bf16x8 __attribute__((ext_vector_type(8)));
typedef float f32x4 __attribute__((ext_vector_type(4)));
typedef unsigned u32x4 __attribute__((ext_vector_type(4)));
constexpr int BM = 256, BK = 64, HALF = 128, HTB = HALF * BK * 2  , STAGE_BYTES = 8 * HTB, NXCD = 8, WGM = 8;

__host__ __device__ __forceinline__ int lds_byte(int r, int c) { const int st = (r >> 4) * 2 + (c >> 5), rr = r & 15, cc = c & 31, ob = rr * 64 + cc * 2; return st * 1024 + (ob ^ (((ob >> 9) & 1) << 5)); }
__host__ __device__ __forceinline__ void stage_rc(int b, int& R, int& C) { const int st = b / 1024, sb = b % 1024, swz = sb ^ (((sb >> 9) & 1) << 5); R = (st >> 1) * 16 + swz / 64; C = (st & 1) * 32 + (swz % 64) / 2; }
__host__ __device__ __forceinline__ int perm32(int rho) { const int n = rho >> 4, i = rho & 15; return 8 * (i >> 2) + 4 * n + (i & 3); }

struct Unit { int pm, pn; };
struct Gemm { const bf16_t* A; const bf16_t* Bt; int M, N, K; };

struct StaticOrder {
    int nM, nN, nwg, G, c;
    __host__ __device__ void init(int M, int N, int G_, int c_) { nM = M / BM; nN = N / BM; nwg = nM * nN; G = G_; c = c_; }
    __host__ __device__ bool next(int i, Unit& u) const {
        const long L = (long)i * G + c; if (L >= nwg) return false;
        int wgid = (int)L; { const int q = nwg / NXCD, r = nwg % NXCD, xcd = wgid % NXCD, off = wgid / NXCD; wgid = (xcd < r ? xcd * (q + 1) : r * (q + 1) + (xcd - r) * q) + off; }
        const int nig = WGM * nN, gid = wgid / nig, fm = gid * WGM, gsz = (nM - fm) < WGM ? (nM - fm) : WGM;
        u.pm = fm + ((wgid % nig) % gsz); u.pn = (wgid % nig) / gsz; return true;
    }
    __device__ __forceinline__ void a_ready(const Unit&) const {}
    __device__ __forceinline__ void done(const Unit&) const {}
};

__device__ __forceinline__ unsigned cvt_pk_bf16(float lo, float hi) { unsigned r; asm volatile("v_cvt_pk_bf16_f32 %0, %1, %2" : "=v"(r) : "v"(lo), "v"(hi)); return r; }
template <class Epi, class Sched, bool ALIGN_EPI = false, bool SP2 = false>
__device__ __forceinline__ void gemm_phase(PG8_LAS unsigned char* lds, const Gemm g, const Sched& S, const Epi& E) {
    const int tid = threadIdx.x, wid = __builtin_amdgcn_readfirstlane(tid >> 6), lane = tid & 63, wr = wid >> 2, wc = wid & 3, fr = lane & 15, fq = lane >> 4;
    const int K = g.K, nt = K / BK;
    unsigned voffA[2], voffB[2];
#pragma unroll
    for (int i = 0; i < 2; ++i) { int R, C; stage_rc(tid * 16 + i * 8192, R, C); const int Rb = Epi::PERM ? ((R & ~31) + perm32(R & 31)) : R;
        voffA[i] = (unsigned)(R * K + C) * 2u; voffB[i] = (unsigned)(Rb * K + C) * 2u; }
    const size_t kstep = (size_t)(BK * 2);
    const size_t hstep = (size_t)HALF * K * 2;
    const size_t tstep = 2 * hstep;
    const unsigned ldsw = (unsigned)wid * 1024u;
    const int aoff = lds_byte(wr * 64 + fr, fq * 8), boff = lds_byte(wc * 32 + fr, fq * 8);
#define PG8_SA(b, h) (((b) * 2 + (h)) * HTB)
#define PG8_SB(b, h) ((4 + (b) * 2 + (h)) * HTB)
#define PG8_STAGE(bufoff, gbase, voff) do { _Pragma("unroll") for (int _i = 0; _i < 2; ++_i) \
        __builtin_amdgcn_global_load_lds((const unsigned*)((const char*)(gbase) + (voff)[_i]), (PG8_LAS unsigned*)(lds + (bufoff) + ldsw + _i * 8192), 16, 0, 0); } while (0)
#define PG8_LDA(dst, b, h) do { _Pragma("unroll") for (int m = 0; m < 4; ++m) _Pragma("unroll") for (int k = 0; k < 2; ++k) dst[m][k] = *(const PG8_LAS bf16x8*)(lds + PG8_SA(b, h) + aoff + m * 2048 + k * 1024); } while (0)
#define PG8_LDB(dst, b, h) do { _Pragma("unroll") for (int n = 0; n < 2; ++n) _Pragma("unroll") for (int k = 0; k < 2; ++k) dst[n][k] = *(const PG8_LAS bf16x8*)(lds + PG8_SB(b, h) + boff + n * 2048 + k * 1024); } while (0)
#define PG8_MMA(ai, bj, At, Bt) do { __builtin_amdgcn_s_setprio(1); _Pragma("unroll") for (int m = 0; m < 4; ++m) _Pragma("unroll") for (int n = 0; n < 2; ++n) _Pragma("unroll") for (int k = 0; k < 2; ++k) \
        acc[ai][bj][m][n] = __builtin_amdgcn_mfma_f32_16x16x32_bf16(Bt[n][k], At[m][k], acc[ai][bj][m][n], 0, 0, 0); __builtin_amdgcn_s_setprio(0); } while (0)
#define PG8_WAIT_V(n) asm volatile("s_waitcnt vmcnt(" #n ")" ::: "memory")
#define PG8_WAIT_L(n) asm volatile("s_waitcnt lgkmcnt(" #n ")" ::: "memory")
#define PG8_BAR __builtin_amdgcn_s_barrier()
#define PG8_SCHED __builtin_amdgcn_sched_barrier(0)
    Unit cur, nxt; int ui = 0;
    if (!S.next(0, cur)) return;
    f32x4 acc[2][2][4][2];
#pragma unroll
    for (int a = 0; a < 2; ++a)
#pragma unroll
        for (int b = 0; b < 2; ++b)
#pragma unroll
            for (int m = 0; m < 4; ++m)
#pragma unroll
                for (int n = 0; n < 2; ++n) acc[a][b][m][n] = (f32x4){0.f, 0.f, 0.f, 0.f};
    bf16x8 At[4][2], B0[2][2], B1[2][2];
    const char* cA = (const char*)g.A + (size_t)cur.pm * tstep; const char* cB = (const char*)g.Bt + (size_t)cur.pn * tstep;
    S.a_ready(cur);
    if constexpr (SP2) {
        PG8_STAGE(PG8_SB(0, 0), cB, voffB); PG8_STAGE(PG8_SB(0, 1), cB + hstep, voffB); PG8_STAGE(PG8_SA(0, 0), cA, voffA); PG8_STAGE(PG8_SA(0, 1), cA + hstep, voffA);
        if (wr == 1) PG8_BAR;
        PG8_WAIT_V(2); PG8_BAR;
        PG8_STAGE(PG8_SB(1, 0), cB + kstep, voffB); PG8_STAGE(PG8_SA(1, 0), cA + kstep, voffA); PG8_STAGE(PG8_SB(1, 1), cB + hstep + kstep, voffB);
        PG8_WAIT_V(6); PG8_BAR;
    } else {
        PG8_STAGE(PG8_SB(0, 0), cB, voffB); PG8_STAGE(PG8_SA(0, 0), cA, voffA); PG8_STAGE(PG8_SB(0, 1), cB + hstep, voffB); PG8_STAGE(PG8_SA(0, 1), cA + hstep, voffA);
        if (wr == 1) PG8_BAR;
        PG8_WAIT_V(4); PG8_BAR;
        PG8_STAGE(PG8_SB(1, 0), cB + kstep, voffB); PG8_STAGE(PG8_SA(1, 0), cA + kstep, voffA); PG8_STAGE(PG8_SB(1, 1), cB + hstep + kstep, voffB);
        PG8_WAIT_V(6); PG8_BAR;
    }
    for (;;) {
        const bool has_next = S.next(ui + 1, nxt);
        const char* nA = has_next ? (const char*)g.A + (size_t)nxt.pm * tstep : cA; const char* nB = has_next ? (const char*)g.Bt + (size_t)nxt.pn * tstep : cB;
        for (int t = 0; t < nt; t += 2) {
            const bool last = (t == nt - 2);
            const char* a1 = cA + (size_t)(t + 1) * kstep;
            const char* a2 = last ? nA : cA + (size_t)(t + 2) * kstep; const char* b2 = last ? nB : cB + (size_t)(t + 2) * kstep;
            const char* a3 = a2 + kstep; const char* b3 = b2 + kstep;
            if (last && has_next) S.a_ready(nxt);
            if constexpr (SP2) {
            PG8_LDB(B0, 0, 0); PG8_LDB(B1, 0, 1); PG8_SCHED; PG8_LDA(At, 0, 0); PG8_STAGE(PG8_SA(1, 1), a1 + hstep, voffA);
            PG8_WAIT_V(8); PG8_WAIT_L(0); PG8_BAR; PG8_MMA(0, 0, At, B0); PG8_MMA(0, 1, At, B1); PG8_BAR; PG8_SCHED;
            PG8_LDA(At, 0, 1); PG8_STAGE(PG8_SB(0, 0), b2, voffB); PG8_STAGE(PG8_SB(0, 1), b2 + hstep, voffB); PG8_STAGE(PG8_SA(0, 0), a2, voffA);
            PG8_WAIT_V(8); PG8_WAIT_L(0); PG8_BAR; PG8_MMA(1, 0, At, B0); PG8_MMA(1, 1, At, B1); PG8_BAR; PG8_SCHED;
            PG8_LDB(B0, 1, 0); PG8_LDB(B1, 1, 1); PG8_SCHED; PG8_LDA(At, 1, 0); PG8_STAGE(PG8_SA(0, 1), a2 + hstep, voffA);
            PG8_WAIT_V(8); PG8_WAIT_L(0); PG8_BAR; PG8_MMA(0, 0, At, B0); PG8_MMA(0, 1, At, B1); PG8_BAR; PG8_SCHED;
            PG8_LDA(At, 1, 1); PG8_STAGE(PG8_SB(1, 0), b3, voffB); PG8_STAGE(PG8_SB(1, 1), b3 + hstep, voffB); PG8_STAGE(PG8_SA(1, 0), a3, voffA);
            PG8_WAIT_V(8); PG8_WAIT_L(0); PG8_BAR; PG8_MMA(1, 0, At, B0); PG8_MMA(1, 1, At, B1); PG8_BAR; PG8_SCHED;
            } else {
            PG8_LDB(B0, 0, 0); PG8_SCHED; PG8_LDA(At, 0, 0); PG8_STAGE(PG8_SA(1, 1), a1 + hstep, voffA);
            PG8_WAIT_L(8); PG8_BAR; PG8_WAIT_L(0); PG8_MMA(0, 0, At, B0); PG8_BAR; PG8_SCHED;
            PG8_LDB(B1, 0, 1); PG8_STAGE(PG8_SB(0, 0), b2, voffB);
            PG8_BAR; PG8_WAIT_L(0); PG8_MMA(0, 1, At, B1); PG8_BAR;
            PG8_LDA(At, 0, 1); PG8_STAGE(PG8_SA(0, 0), a2, voffA);
            PG8_BAR; PG8_WAIT_L(0); PG8_MMA(1, 0, At, B0); PG8_BAR; PG8_SCHED;
            PG8_STAGE(PG8_SB(0, 1), b2 + hstep, voffB);
            PG8_WAIT_V(6); PG8_BAR; PG8_MMA(1, 1, At, B1); PG8_BAR;
            PG8_LDB(B0, 1, 0); PG8_SCHED; PG8_LDA(At, 1, 0); PG8_STAGE(PG8_SA(0, 1), a2 + hstep, voffA);
            PG8_WAIT_L(8); PG8_BAR; PG8_WAIT_L(0); PG8_MMA(0, 0, At, B0); PG8_BAR; PG8_SCHED;
            PG8_LDB(B1, 1, 1); PG8_STAGE(PG8_SB(1, 0), b3, voffB);
            PG8_BAR; PG8_WAIT_L(0); PG8_MMA(0, 1, At, B1); PG8_BAR;
            PG8_LDA(At, 1, 1); PG8_STAGE(PG8_SA(1, 0), a3, voffA);
            PG8_BAR; PG8_WAIT_L(0); PG8_MMA(1, 0, At, B0); PG8_BAR; PG8_SCHED;
            PG8_STAGE(PG8_SB(1, 1), b3 + hstep, voffB);
            PG8_WAIT_V(6); PG8_BAR; PG8_MMA(1, 1, At, B1); PG8_BAR;
            }
        }
        if constexpr (ALIGN_EPI) { if (wr == 0) PG8_BAR; }
        if constexpr (!Epi::AFTER_DRAIN) { E(acc, cur, wr, wc, fr, fq); S.done(cur); }
        if (!has_next) break;
#pragma unroll
        for (int a = 0; a < 2; ++a)
#pragma unroll
            for (int b = 0; b < 2; ++b)
#pragma unroll
                for (int m = 0; m < 4; ++m)
#pragma unroll
                    for (int n = 0; n < 2; ++n) acc[a][b][m][n] = (f32x4){0.f, 0.f, 0.f, 0.f};
        cur = nxt; cA = nA; cB = nB; ++ui;
        if constexpr (ALIGN_EPI) { if (wr == 1) PG8_BAR; }
    }
    PG8_WAIT_V(0);
    if constexpr (!ALIGN_EPI) { if (wr == 0) PG8_BAR; }
    PG8_BAR;
    if constexpr (Epi::AFTER_DRAIN) { E.fused(acc, cur, wr, wc, fr, fq, lds, wid, lane); S.done(cur); }
#undef PG8_SA
#undef PG8_SB
#undef PG8_STAGE
#undef PG8_LDA
#undef PG8_LDB
#undef PG8_MMA
#undef PG8_WAIT_V
#undef PG8_WAIT_L
#undef PG8_BAR
#undef PG8_SCHED
}
}

namespace pg8 {
__host__ __device__ __forceinline__ int permk(int kl) { return 8 * ((kl & 15) >> 2) + 4 * (kl >> 4) + (kl & 3); }
struct EpiBf16Rs {
    static constexpr bool PERM = true, AFTER_DRAIN = false;
    bf16_t* O0; int ld0; int ntile0; bf16_t* O1; int ld1; size_t stride1; const float* ssq; float cs;
    __device__ __forceinline__ void operator()(const f32x4 (&acc)[2][2][4][2], const Unit& u, int wr, int wc, int fr, int fq) const {
        bf16_t* base; int ld, colt;
        if (u.pn < ntile0) { base = O0; ld = ld0; colt = u.pn * BM; }
        else { const int q = u.pn - ntile0, per = ld1 / BM; base = O1 + (size_t)(q / per) * stride1; ld = ld1; colt = (q % per) * BM; }
        const int row0 = u.pm * BM + wr * 64 + fr, col0 = colt + wc * 32 + 8 * fq;
#pragma unroll
        for (int ai = 0; ai < 2; ++ai)
#pragma unroll
            for (int m = 0; m < 4; ++m) {
                const int row = row0 + ai * HALF + m * 16;
                float sc = cs; if (ssq) sc *= rsqrtf(ssq[row] * (1.0f / 1024.0f) + 1e-6f);
                bf16_t* rowp = base + (size_t)row * ld + col0;
#pragma unroll
                for (int bj = 0; bj < 2; ++bj) { const f32x4 v0 = acc[ai][bj][m][0] * sc, v1 = acc[ai][bj][m][1] * sc;
                    u32x4 w; w.x = cvt_pk_bf16(v0[0], v0[1]); w.y = cvt_pk_bf16(v0[2], v0[3]); w.z = cvt_pk_bf16(v1[0], v1[1]); w.w = cvt_pk_bf16(v1[2], v1[3]);
                    *(u32x4*)(rowp + bj * HALF) = w; } }
    }
};
struct EpiF16Rs {
    static constexpr bool PERM = true, AFTER_DRAIN = false;
    _Float16* O; int ld; const float* ssq;
    __device__ __forceinline__ void operator()(const f32x4 (&acc)[2][2][4][2], const Unit& u, int wr, int wc, int fr, int fq) const {
        typedef _Float16 f16x8 __attribute__((ext_vector_type(8)));
        const int row0 = u.pm * BM + wr * 64 + fr, col0 = u.pn * BM + wc * 32 + 8 * fq;
#pragma unroll
        for (int ai = 0; ai < 2; ++ai)
#pragma unroll
            for (int m = 0; m < 4; ++m) {
                const int row = row0 + ai * HALF + m * 16;
                const float sc = rsqrtf(ssq[row] * (1.0f / 1024.0f) + 1e-6f);
                _Float16* rowp = O + (size_t)row * ld + col0;
#pragma unroll
                for (int bj = 0; bj < 2; ++bj) { const f32x4 v0 = acc[ai][bj][m][0] * sc, v1 = acc[ai][bj][m][1] * sc;
                    f16x8 w; w[0] = (_Float16)v0[0]; w[1] = (_Float16)v0[1]; w[2] = (_Float16)v0[2]; w[3] = (_Float16)v0[3];
                    w[4] = (_Float16)v1[0]; w[5] = (_Float16)v1[1]; w[6] = (_Float16)v1[2]; w[7] = (_Float16)v1[3];
                    *(f16x8*)(rowp + bj * HALF) = w; } }
    }
};
template <bool BASE_F32> struct EpiResidBf {
    static constexpr bool PERM = true, AFTER_DRAIN = false;
    const float* basef; bf16_t* xb; float* ssq;
    __device__ __forceinline__ void operator()(const f32x4 (&acc)[2][2][4][2], const Unit& u, int wr, int wc, int fr, int fq) const {
        const int row0 = u.pm * BM + wr * 64 + fr, col0 = u.pn * BM + wc * 32 + 8 * fq;
#pragma unroll
        for (int ai = 0; ai < 2; ++ai)
#pragma unroll
            for (int m = 0; m < 4; ++m) {
                const int row = row0 + ai * HALF + m * 16; const size_t off = (size_t)row * 1024 + col0; float s = 0.f;
#pragma unroll
                for (int bj = 0; bj < 2; ++bj) { const size_t o2 = off + bj * HALF;
                    f32x4 b0, b1;
                    if (BASE_F32) { b0 = *(const f32x4*)(basef + o2); b1 = *(const f32x4*)(basef + o2 + 4); }
                    else { const u32x4 p = *(const u32x4*)(xb + o2);
                        b0 = (f32x4){__builtin_bit_cast(float, p.x << 16), __builtin_bit_cast(float, p.x & 0xffff0000u), __builtin_bit_cast(float, p.y << 16), __builtin_bit_cast(float, p.y & 0xffff0000u)};
                        b1 = (f32x4){__builtin_bit_cast(float, p.z << 16), __builtin_bit_cast(float, p.z & 0xffff0000u), __builtin_bit_cast(float, p.w << 16), __builtin_bit_cast(float, p.w & 0xffff0000u)}; }
                    const f32x4 o0 = b0 + acc[ai][bj][m][0], o1 = b1 + acc[ai][bj][m][1];
                    s += ((o0[0] * o0[0] + o0[1] * o0[1]) + (o0[2] * o0[2] + o0[3] * o0[3])) + ((o1[0] * o1[0] + o1[1] * o1[1]) + (o1[2] * o1[2] + o1[3] * o1[3]));
                    u32x4 w; w.x = cvt_pk_bf16(o0[0], o0[1]); w.y = cvt_pk_bf16(o0[2], o0[3]); w.z = cvt_pk_bf16(o1[0], o1[1]); w.w = cvt_pk_bf16(o1[2], o1[3]);
                    *(u32x4*)(xb + o2) = w; }
                s += __shfl_xor(s, 16); s += __shfl_xor(s, 32);
                if (fq == 0) atomicAdd(ssq + row, s);
            }
    }
};
struct EpiKV {
    static constexpr bool PERM = false, AFTER_DRAIN = false;
    bf16_t* Kb; bf16_t* VTp;
    __device__ __forceinline__ void operator()(const f32x4 (&acc)[2][2][4][2], const Unit& u, int wr, int wc, int fr, int fq) const {
        typedef unsigned u32x2v __attribute__((ext_vector_type(2)));
        const int row0 = u.pm * BM + wr * 64 + fr, col0 = u.pn * BM + wc * 32 + 4 * fq;
#pragma unroll
        for (int ai = 0; ai < 2; ++ai)
#pragma unroll
            for (int m = 0; m < 4; ++m) {
                const int row = row0 + ai * HALF + m * 16, b = row >> 8, key = row & 255;
#pragma unroll
                for (int bj = 0; bj < 2; ++bj)
#pragma unroll
                    for (int n = 0; n < 2; ++n) { const int col = col0 + bj * HALF + n * 16; const f32x4 v = acc[ai][bj][m][n];
                        const unsigned p01 = cvt_pk_bf16(v[0], v[1]), p23 = cvt_pk_bf16(v[2], v[3]);
                        if (col < 1024) { const int h = col >> 8, dh = col & 255; u32x2v w; w.x = p01; w.y = p23;
                            *(u32x2v*)(Kb + ((size_t)((b * 4 + h) * 256 + key)) * 256 + dh) = w; }
                        else { const int c2 = col - 1024, h = c2 >> 8, dv = c2 & 255, kp = (key & ~31) | permk(key & 31);
                            bf16_t* d = VTp + ((size_t)((b * 4 + h) * 256 + dv)) * 256 + kp;
                            d[0] = (bf16_t)(p01 & 0xffffu); d[256] = (bf16_t)(p01 >> 16); d[512] = (bf16_t)(p23 & 0xffffu); d[768] = (bf16_t)(p23 >> 16); } }
            }
    }
};
}
#ifndef PG8_SP2
#define PG8_SP2 true
#endif
#ifndef PG8_ALIGN
#define PG8_ALIGN true
#endif

constexpr int NWAVES = 8;
#ifndef MK_PER_PHASE
#define MK_PER_PHASE 0
#endif
constexpr int T = 16384, SEQ = 8192, D = 1024;
constexpr int N_PHASES = 12;

constexpr size_t MiB = 1u << 20, KiB = 1u << 10;
constexpr size_t WS_CTL = 0, CTL_ZERO_BYTES = 1 * MiB;
constexpr int CW_BAR = 4096;
constexpr size_t WS_SSQ1 = 64 * KiB, WS_SSQ2 = 128 * KiB;
constexpr size_t WS_AB = 1 * MiB;
constexpr size_t WS_HEND = WS_AB + 512 * KiB, WS_PEND = WS_HEND + 512 * KiB, WS_HIN = WS_PEND + 512 * KiB;
constexpr size_t WS_DEC = WS_HIN + 512 * KiB;
constexpr size_t WS_SUBK = 3 * MiB + 256 * KiB;
constexpr size_t WS_WIN = 4 * MiB, WS_WOUT = 10 * MiB, WS_WQ = 12 * MiB, WS_WKV = 14 * MiB, WS_WO = 18 * MiB, WS_PWQ = 20 * MiB;
constexpr size_t WS_MEMN = 24 * MiB, WS_KB = 25 * MiB, WS_VTP = 26 * MiB, WS_LRUWT = 27 * MiB, WS_USC = 27 * MiB + 256 * KiB, WS_VSC = 27 * MiB + 384 * KiB;
constexpr size_t WS_XB = 28 * MiB;
constexpr size_t WS_HLOC = 28 * MiB, WS_PCUM = 44 * MiB;
constexpr size_t WS_QKV = 60 * MiB;
constexpr size_t OUT_Y = 4 * MiB;
constexpr size_t OUT_END = OUT_Y + (size_t)16384 * 1024 * 2;
constexpr size_t WS_IDX = 60 * MiB, WS_GW = 68 * MiB;
constexpr size_t WS_UB = 60 * MiB;
constexpr size_t WS_XR = 108 * MiB, WS_Z = 124 * MiB, WS_GATE = 140 * MiB;
constexpr size_t WS_WN = 156 * MiB, WS_UF = 172 * MiB, WS_QD = 188 * MiB, WS_KD = 204 * MiB, WS_ATT = 220 * MiB;
constexpr size_t WS_VB = 228 * MiB;
constexpr size_t WS_Q = 188 * MiB, WS_AO = 124 * MiB;
constexpr size_t WS_PQ = 108 * MiB;
constexpr size_t WS_END = 244 * MiB;
constexpr int CW_GFLAG = 49152;
constexpr int CW_LRUCNT = 8192;
static_assert(WS_XR - WS_QKV == (size_t)T * 1536 * 2 && WS_Z - WS_XR == (size_t)T * 512 * 2 && WS_GATE - WS_Z == (size_t)T * 512 * 2, "in-proj outputs are contiguous");

constexpr int LDS_BYTES = 160 * 1024;
constexpr int MISC_OFF = 159 * 1024;

#define GAS __attribute__((address_space(1)))
#define LAS __attribute__((address_space(3)))
typedef unsigned short bf16;
typedef unsigned v4u __attribute__((ext_vector_type(4)));
typedef unsigned v2u __attribute__((ext_vector_type(2)));
typedef float f32x4 __attribute__((ext_vector_type(4)));
typedef short bf16x8 __attribute__((ext_vector_type(8)));
typedef GAS unsigned gu32;
#define LDS_WAIT() asm volatile("s_waitcnt lgkmcnt(0)" ::: "memory")
__device__ __forceinline__ void st16_wt(void* p, v4u v) { asm volatile("global_store_dwordx4 %0, %1, off sc0 sc1\n\ts_nop 1" :: "v"(p), "v"(v) : "memory"); }
__device__ __forceinline__ unsigned f2bf(float f) { unsigned u = __builtin_bit_cast(unsigned, f); return (u + 0x7fffu + ((u >> 16) & 1u)) >> 16; }
__device__ __forceinline__ unsigned pk2(float lo, float hi) { return f2bf(lo) | (f2bf(hi) << 16); }
__device__ __forceinline__ float bflo(unsigned u) { return __builtin_bit_cast(float, u << 16); }
__device__ __forceinline__ float bfhi(unsigned u) { return __builtin_bit_cast(float, u & 0xffff0000u); }
__device__ __forceinline__ float bf1(bf16 h) { return __builtin_bit_cast(float, (unsigned)h << 16); }
__device__ __forceinline__ float wave_sum(float v) {
#pragma unroll
    for (int o = 1; o < 64; o <<= 1) v += __shfl_xor(v, o);
    return v;
}
__device__ __forceinline__ float row16_sum(float v) {
    v += __builtin_bit_cast(float, __builtin_amdgcn_update_dpp(0, __builtin_bit_cast(int, v), 0xB1, 0xF, 0xF, true));
    v += __builtin_bit_cast(float, __builtin_amdgcn_update_dpp(0, __builtin_bit_cast(int, v), 0x4E, 0xF, 0xF, true));
    v += __builtin_bit_cast(float, __builtin_amdgcn_update_dpp(0, __builtin_bit_cast(int, v), 0x141, 0xF, 0xF, true));
    v += __builtin_bit_cast(float, __builtin_amdgcn_update_dpp(0, __builtin_bit_cast(int, v), 0x140, 0xF, 0xF, true));
    return v;
}
__device__ __forceinline__ float sigmoidf_(float x) { return __builtin_amdgcn_rcpf(1.0f + __expf(-x)); }
__device__ __forceinline__ float softplusf_(float x) { return fmaxf(x, 0.f) + log1pf(__expf(-fabsf(x))); }
__device__ __forceinline__ float siluf_(float x) { return x * __builtin_amdgcn_rcpf(1.0f + __expf(-x)); }
__device__ __forceinline__ float gelu_tanh(float x) { const float y = 0.7978845608028654f * (x + 0.044715f * x * x * x); const float e = __expf(2.0f * y); return x * (1.0f - __builtin_amdgcn_rcpf(1.0f + e)); }
__device__ __forceinline__ int permk(int kl) { return 8 * ((kl & 15) >> 2) + 4 * (kl >> 4) + (kl & 3); }

struct Params {
    const float *x, *mem, *norm_mix_w, *w_in, *conv_qkv_w, *gdn_a_log, *gdn_dt_bias, *gdn_norm_w, *lru_conv_w, *lru_conv_b, *lru_wa, *lru_ba, *lru_wx, *lru_bx, *lru_lambda, *w_out,
                *norm_xattn_w, *norm_mem_w, *xattn_wq, *xattn_wkv, *xattn_wo, *norm_ffn_w, *peer_wq, *peer_subkeys, *peer_u, *peer_v, *norm_final_w;
    float* out; unsigned char* ws; int ph_lo, ph_hi;
};
#define XB_TMO      128
#define XB_XCNT(j)  (256  + 64 * (j))
#define XB_XSUB(j)  (1280 + 64 * (j))
#define XB_XGEN(j)  (2304 + 64 * (j))
#define XB_TOP      3328
#define XB_TOPGEN   3392
#define XCD_BAR_WORDS 3456
#define XB_SPIN_CAP (1u << 18)

__device__ __forceinline__ unsigned xb_ld(unsigned* p)              { return __hip_atomic_load(p, __ATOMIC_RELAXED, __HIP_MEMORY_SCOPE_AGENT); }
__device__ __forceinline__ unsigned xb_add(unsigned* p, unsigned v) { return __hip_atomic_fetch_add(p, v, __ATOMIC_RELAXED, __HIP_MEMORY_SCOPE_AGENT); }
__device__ __forceinline__ unsigned xb_xcc_id() { return (unsigned)__builtin_amdgcn_s_getreg((3 << 11) | 20) & 0xFu; }
#define XB_SPIN(cond, bar) do { unsigned _sp = 0; while (cond) { __builtin_amdgcn_s_sleep(1); \
    if ((++_sp & 255u) == 0u) { if (xb_ld(&(bar)[XB_TMO])) break; if (_sp > XB_SPIN_CAP) { atomicAdd(&(bar)[XB_TMO], 1u); break; } } } } while (0)

struct XcdBarrier {
    unsigned* bar; unsigned x;
    volatile LAS unsigned* st;
};

__device__ __forceinline__ XcdBarrier xcd_barrier_post(unsigned* bar, volatile LAS unsigned* st) {
    XcdBarrier b; b.bar = bar; b.x = xb_xcc_id(); b.st = st;
    if (threadIdx.x == 0) (void)xb_add(&bar[XB_XCNT(b.x)], 1u);
    return b;
}
__device__ __forceinline__ void xcd_barrier_complete(unsigned* bar, unsigned x, unsigned& nloc, unsigned& nx) {
    const unsigned G = gridDim.x * gridDim.y * gridDim.z;
    unsigned sum, cnt, mine, sp = 0u;
    for (;;) {
        sum = 0u; cnt = 0u; mine = 0u;
#pragma unroll
        for (unsigned j = 0; j < 16; ++j) { const unsigned c = xb_ld(&bar[XB_XCNT(j)]); sum += c; cnt += (c > 0u) ? 1u : 0u; mine = (j == x) ? c : mine; }
        if (sum == G) break;
        __builtin_amdgcn_s_sleep(1);
        if ((++sp & 255u) == 0u) { if (xb_ld(&bar[XB_TMO])) break; if (sp > XB_SPIN_CAP) { atomicAdd(&bar[XB_TMO], 1u); break; } }
    }
    nloc = mine > 0u ? mine : 1u; nx = cnt > 0u ? cnt : 1u;
}

__device__ __forceinline__ void xcd_barrier(const XcdBarrier& b) {
    asm volatile("s_waitcnt vmcnt(0)" ::: "memory");
    __syncthreads();
    if (threadIdx.x == 0) {
        unsigned* bar = b.bar;
        __builtin_amdgcn_s_waitcnt(0);
        unsigned nloc = b.st[0], nx = b.st[1];
        if (nloc == 0u) { xcd_barrier_complete(bar, b.x, nloc, nx); b.st[0] = nloc; b.st[1] = nx; }
        const unsigned old = xb_add(&bar[XB_XSUB(b.x)], 1u);
        const unsigned gen = old / nloc;
        if (old + 1u == (gen + 1u) * nloc) {
            __builtin_amdgcn_fence(__ATOMIC_RELEASE, "agent");
            asm volatile("s_waitcnt vmcnt(0)" ::: "memory");
            const unsigned og = xb_add(&bar[XB_TOP], 1u);
            const unsigned tg = og / nx;
            if (og + 1u == (tg + 1u) * nx) xb_add(&bar[XB_TOPGEN], 1u);
            else XB_SPIN(xb_ld(&bar[XB_TOPGEN]) == tg, bar);
            __builtin_amdgcn_fence(__ATOMIC_ACQUIRE, "agent");
            xb_add(&bar[XB_XGEN(b.x)], 1u);
            asm volatile("s_waitcnt vmcnt(0)" ::: "memory");
        } else {
            XB_SPIN(xb_ld(&bar[XB_XGEN(b.x)]) == gen, bar);
            __builtin_amdgcn_fence(__ATOMIC_ACQUIRE, "agent");
            asm volatile("s_waitcnt vmcnt(0)" ::: "memory");
        }
    }
    __syncthreads();
}

__device__ __forceinline__ void p0_transpose_item(const float* W, int K, int ldw, int c0, int nblk, bf16* WT, int row_off, const float* ks, LAS float* scr, int item, int lane) {
    const int kb = item / nblk, nb = item % nblk, k0 = 64 * kb, n0 = 32 * nb;
#pragma unroll 8
    for (int i = 0; i < 32; ++i) { const int kk = 2 * i + (lane >> 5); float v = W[(size_t)(k0 + kk) * ldw + c0 + n0 + (lane & 31)]; if (ks) v *= ks[k0 + kk]; scr[kk * 33 + (lane & 31)] = v; }
    LDS_WAIT(); asm volatile("" ::: "memory");
    const int c = lane & 7;
#pragma unroll
    for (int j = 0; j < 4; ++j) { const int n = (lane >> 3) + 8 * j; const LAS float* s = scr + (8 * c) * 33 + n;
        v4u o; o.x = pk2(s[0 * 33], s[1 * 33]); o.y = pk2(s[2 * 33], s[3 * 33]); o.z = pk2(s[4 * 33], s[5 * 33]); o.w = pk2(s[6 * 33], s[7 * 33]);
        *(GAS v4u*)(WT + (size_t)(row_off + n0 + n) * K + k0 + 8 * c) = o; }
    LDS_WAIT(); asm volatile("" ::: "memory");
}

__device__ __forceinline__ void p0_prologue(const Params& P, LAS unsigned char* lds, int tid, int lane, int wave, int vcu, int G) {
    unsigned char* ws = P.ws;
    const int gw = vcu * NWAVES + wave, NGW = G * NWAVES;
    LAS float* wabl = (LAS float*)lds;
    for (int idx = tid; idx < 8192; idx += NWAVES * 64) { const int k = idx >> 3, c = idx & 7, j = k >> 8, l = (k >> 2) & 63, e = k & 3;
        wabl[((((j * 4 + e) * 2 + (c >> 2)) * 64 + l) << 2) + (c & 3)] = P.w_in[(size_t)k * 3080 + 2048 + c]; }
    __syncthreads();
    {
        bf16* XB0 = (bf16*)(ws + WS_XB); float* AB = (float*)(ws + WS_AB);
        f32x4 w4[4];
#pragma unroll
        for (int j = 0; j < 4; ++j) w4[j] = ((const f32x4*)P.norm_mix_w)[64 * j + lane];
        for (int m = gw; m < T; m += NGW) {
            const f32x4* xr = (const f32x4*)(P.x + (size_t)m * D) + lane;
            f32x4 v[4]; float s = 0.f;
#pragma unroll
            for (int j = 0; j < 4; ++j) { v[j] = xr[64 * j]; s += (v[j].x * v[j].x + v[j].y * v[j].y) + (v[j].z * v[j].z + v[j].w * v[j].w); }
            const float rstd = rsqrtf(wave_sum(s) * (1.0f / D) + 1e-6f);
            v2u* o8 = (v2u*)(XB0 + (size_t)m * D) + lane;
            float part[8];
#pragma unroll
            for (int c = 0; c < 8; ++c) part[c] = 0.f;
#pragma unroll
            for (int j = 0; j < 4; ++j) {
                v[j] = v[j] * rstd * w4[j];
                v2u o; o.x = pk2(v[j].x, v[j].y); o.y = pk2(v[j].z, v[j].w); o8[64 * j] = o;
#pragma unroll
                for (int e = 0; e < 4; ++e) {
                    const f32x4 wa = *(const LAS f32x4*)(wabl + ((((j * 4 + e) * 2 + 0) * 64 + lane) << 2));
                    const f32x4 wb = *(const LAS f32x4*)(wabl + ((((j * 4 + e) * 2 + 1) * 64 + lane) << 2));
                    const float hv = v[j][e];
                    part[0] += hv * wa.x; part[1] += hv * wa.y; part[2] += hv * wa.z; part[3] += hv * wa.w;
                    part[4] += hv * wb.x; part[5] += hv * wb.y; part[6] += hv * wb.z; part[7] += hv * wb.w;
                }
            }
#pragma unroll
            for (int c = 0; c < 8; ++c) part[c] = wave_sum(part[c]);
            float o = part[0];
#pragma unroll
            for (int c = 1; c < 8; ++c) o = (lane == c) ? part[c] : o;
            if (lane < 8) AB[(size_t)m * 8 + lane] = o;
        }
    }
    {
        bf16* MEMN = (bf16*)(ws + WS_MEMN);
        for (int m = gw; m < 512; m += NGW) {
            const f32x4* xr = (const f32x4*)(P.mem + (size_t)m * D) + lane;
            f32x4 v[4]; float s = 0.f;
#pragma unroll
            for (int j = 0; j < 4; ++j) { v[j] = xr[64 * j]; s += (v[j].x * v[j].x + v[j].y * v[j].y) + (v[j].z * v[j].z + v[j].w * v[j].w); }
            const float rstd = rsqrtf(wave_sum(s) * (1.0f / D) + 1e-6f);
            v2u* o8 = (v2u*)(MEMN + (size_t)m * D) + lane;
#pragma unroll
            for (int j = 0; j < 4; ++j) { const f32x4 w = ((const f32x4*)P.norm_mem_w)[64 * j + lane]; const f32x4 y = v[j] * rstd * w;
                v2u o; o.x = pk2(y.x, y.y); o.y = pk2(y.z, y.w); o8[64 * j] = o; }
        }
    }
    __syncthreads();
    {
        LAS float* scr = (LAS float*)(lds + wave * 16384);
        constexpr int I_IN1 = 16 * 48, I_IN2 = 16 * 16, I_KV = 16 * 64;
        constexpr int NITEMS = I_IN1 + 3 * I_IN2 + I_KV;
        for (int it = gw; it < NITEMS; it += NGW) {
            int r = it;
            if (r < I_IN1) { p0_transpose_item(P.w_in, 1024, 3080, 0, 48, (bf16*)(ws + WS_WIN), 0, nullptr, scr, r, lane); continue; } r -= I_IN1;
            if (r < I_IN2) { p0_transpose_item(P.w_in, 1024, 3080, 2056, 16, (bf16*)(ws + WS_WIN), 1536, nullptr, scr, r, lane); continue; } r -= I_IN2;
            if (r < I_IN2) { p0_transpose_item(P.w_in, 1024, 3080, 1536, 16, (bf16*)(ws + WS_WIN), 2048, nullptr, scr, r, lane); continue; } r -= I_IN2;
            if (r < I_IN2) { p0_transpose_item(P.w_in, 1024, 3080, 2568, 16, (bf16*)(ws + WS_WIN), 2560, nullptr, scr, r, lane); continue; } r -= I_IN2;
            p0_transpose_item(P.xattn_wkv, 1024, 2048, 0, 64, (bf16*)(ws + WS_WKV), 0, nullptr, scr, r, lane);
        }
    }
    {
        bf16* WT = (bf16*)(ws + WS_LRUWT);
        for (int it = vcu * NWAVES * 64 + tid; it < 8 * 2 * 64 * 8; it += G * NWAVES * 64) {
            const int i8 = it & 7, j = (it >> 3) & 63, m = (it >> 9) & 1, g = it >> 10;
            const float* src = (m ? P.lru_wx : P.lru_wa) + (size_t)(g * 64 + 8 * i8) * 64 + j;
            v4u o; o.x = pk2(src[0], src[64]); o.y = pk2(src[128], src[192]); o.z = pk2(src[256], src[320]); o.w = pk2(src[384], src[448]);
            *(v4u*)(WT + (size_t)it * 8) = o;
        }
    }
}

__device__ __forceinline__ void late_weight_prep(const Params& P, LAS unsigned char* lds, int lane, int wave, int gw, int NGW) {
    unsigned char* ws = P.ws;
    {
        LAS float* scr = (LAS float*)(lds + wave * 16384);
        constexpr int I_OUT = 16 * 32, I_Q = 16 * 32, I_O = 16 * 32;
        for (int it = gw; it < I_OUT + I_Q + I_O; it += NGW) {
            int r = it;
            if (r < I_OUT) { p0_transpose_item(P.w_out, 1024, 1024, 0, 32, (bf16*)(ws + WS_WOUT), 0, nullptr, scr, r, lane); continue; } r -= I_OUT;
            if (r < I_Q) { p0_transpose_item(P.xattn_wq, 1024, 1024, 0, 32, (bf16*)(ws + WS_WQ), 0, P.norm_xattn_w, scr, r, lane); continue; } r -= I_Q;
            p0_transpose_item(P.xattn_wo, 1024, 1024, 0, 32, (bf16*)(ws + WS_WO), 0, nullptr, scr, r, lane);
        }
    }
    {
        bf16* WF = (bf16*)(ws + WS_PWQ);
        const int col = lane & 15, g = lane >> 4;
        for (int it = gw; it < 16 * 64; it += NGW) {
            const int hp = it >> 6, k0 = (it & 63) * 16;
            bf16x8 bq[4];
#pragma unroll
            for (int s = 0; s < 4; ++s) { const f32x4* src = (const f32x4*)(P.peer_wq + (size_t)(k0 + col) * 2048 + hp * 128 + 32 * s + 8 * g);
                const f32x4 a = src[0], c = src[1]; v4u pk; pk.x = pk2(a.x, a.y); pk.y = pk2(a.z, a.w); pk.z = pk2(c.x, c.y); pk.w = pk2(c.z, c.w); bq[s] = __builtin_bit_cast(bf16x8, pk); }
            const float nw = P.norm_ffn_w[k0 + col];
#pragma unroll 2
            for (int kt = 0; kt < 8; ++kt) {
                f32x4 acc = (f32x4){0.f, 0.f, 0.f, 0.f};
#pragma unroll
                for (int s = 0; s < 4; ++s) { const f32x4* src = (const f32x4*)(P.peer_subkeys + (size_t)(hp * 128 + 16 * kt + col) * 128 + 32 * s + 8 * g);
                    const f32x4 a = src[0], c = src[1]; v4u pk; pk.x = pk2(a.x, a.y); pk.y = pk2(a.z, a.w); pk.z = pk2(c.x, c.y); pk.w = pk2(c.z, c.w);
                    acc = __builtin_amdgcn_mfma_f32_16x16x32_bf16(__builtin_bit_cast(bf16x8, pk), bq[s], acc, 0, 0, 0); }
#pragma unroll
                for (int i = 0; i < 4; ++i) WF[(size_t)(hp * 128 + 16 * kt + 4 * g + i) * 1024 + k0 + col] = (bf16)f2bf(acc[i] * nw);
            }
        }
    }
}

constexpr int GL_KS = 0, GL_VS = 33792, GL_KB = 67584, GL_QB = 84992, GL_RAW = 102400, GL_CW = 153856, GL_AMT = 133120, GL_SM = 160000, GL_ATT = 151808, GL_SOL = 67584;
static_assert(GL_CW + 6144 <= GL_SM && GL_SM + 1284 <= MISC_OFF && GL_SOL + 65536 <= GL_AMT && GL_AMT + 17408 <= GL_ATT && GL_ATT + 8192 <= GL_SM && GL_RAW + 51456 <= GL_CW, "gdn_local LDS map");
#ifndef GL_REP_STEP
#define GL_REP_STEP -1
#endif
#define GL_REPF(k) for (int rr_ = 0; rr_ < ((GL_REP_STEP == (k)) ? 2 : 1); ++rr_)
#define GL_BAR() do { asm volatile("s_waitcnt lgkmcnt(0)" ::: "memory"); __builtin_amdgcn_s_barrier(); asm volatile("" ::: "memory"); } while (0)
__device__ __forceinline__ void gdn_local_item(const Params& P, LAS unsigned char* lds, int item, int tid) {
    unsigned char* ws = P.ws;
    asm volatile("" : "+v"(tid));
    const int b = item >> 9, h = (item >> 7) & 3, n = item & 127;
    const int t0 = b * SEQ + n * 64;
    const int lane = tid & 63, wave = __builtin_amdgcn_readfirstlane(tid >> 6);
    LAS float* ks = (LAS float*)(lds + GL_KS);
    LAS float* vs = (LAS float*)(lds + GL_VS);
    LAS bf16* kb16 = (LAS bf16*)(lds + GL_KB);
    LAS bf16* qb16 = (LAS bf16*)(lds + GL_QB);
    LAS bf16* raw = (LAS bf16*)(lds + GL_RAW);
    LAS float* cw = (LAS float*)(lds + GL_CW);
    LAS float* AmT = (LAS float*)(lds + GL_AMT);
    LAS float* sg = (LAS float*)(lds + GL_SM);
    LAS float* sbeta = sg + 64; LAS float* sgc = sbeta + 64; LAS float* seg = sgc + 64; LAS float* sek = seg + 64;
    LAS bf16* atts = (LAS bf16*)(lds + GL_ATT);
    const bf16* QKV = (const bf16*)(ws + WS_QKV);
    const float* AB = (const float*)(ws + WS_AB);
    GL_REPF(0) {
        v4u pr[7];
#pragma unroll
        for (int r = 0; r < 7; ++r) {
            const int id = tid + 512 * r;
            const int row = id / 48, rem = id - row * 48, part = rem >> 4, ck = rem & 15, s = n * 64 + row - 3;
            pr[r] = (v4u){0u, 0u, 0u, 0u};
            if (id < 67 * 48 && s >= 0) pr[r] = *(const v4u*)(QKV + (size_t)(b * SEQ + s) * 1536 + part * 512 + h * 128 + ck * 8);
        }
        f32x4 cwv = (f32x4){0.f, 0.f, 0.f, 0.f};
        if (tid < 384) { const int j = tid / 96, rem = tid - j * 96, part = rem >> 5, c4 = rem & 31; cwv = *(const f32x4*)(P.conv_qkv_w + j * 1536 + part * 512 + h * 128 + c4 * 4); }
        float a_in = 0.f, b_in = 0.f;
        if (tid < 64) { a_in = AB[(size_t)(t0 + tid) * 8 + h]; b_in = AB[(size_t)(t0 + tid) * 8 + 4 + h]; }
#pragma unroll
        for (int r = 0; r < 7; ++r) { const int id = tid + 512 * r; if (id < 67 * 48) *(LAS v4u*)(raw + id * 8) = pr[r]; }
        if (tid < 384) *(LAS f32x4*)(cw + tid * 4) = cwv;
        if (tid < 64) { sg[tid] = -__expf(P.gdn_a_log[h]) * softplusf_(a_in + P.gdn_dt_bias[h]); sbeta[tid] = sigmoidf_(b_in); }
    }
    GL_BAR();
    GL_REPF(1) {
        const int c = tid >> 3, grp = tid & 7;
#pragma unroll 1
        for (int part = 0; part < 3; ++part) {
            float y[16];
#pragma unroll
            for (int i = 0; i < 16; ++i) y[i] = 0.f;
#pragma unroll
            for (int j = 0; j < 4; ++j) {
                const LAS v4u* src = (const LAS v4u*)(raw + (c + j) * 384 + part * 128 + grp * 16);
                const v4u x0 = src[0], x1 = src[1];
                const LAS f32x4* wp = (const LAS f32x4*)(cw + (j * 3 + part) * 128 + grp * 16);
                const f32x4 w0 = wp[0], w1 = wp[1], w2 = wp[2], w3 = wp[3];
                y[0] += w0.x * bflo(x0.x); y[1] += w0.y * bfhi(x0.x); y[2] += w0.z * bflo(x0.y); y[3] += w0.w * bfhi(x0.y);
                y[4] += w1.x * bflo(x0.z); y[5] += w1.y * bfhi(x0.z); y[6] += w1.z * bflo(x0.w); y[7] += w1.w * bfhi(x0.w);
                y[8] += w2.x * bflo(x1.x); y[9] += w2.y * bfhi(x1.x); y[10] += w2.z * bflo(x1.y); y[11] += w2.w * bfhi(x1.y);
                y[12] += w3.x * bflo(x1.z); y[13] += w3.y * bfhi(x1.z); y[14] += w3.z * bflo(x1.w); y[15] += w3.w * bfhi(x1.w);
            }
            float ss = 0.f;
#pragma unroll
            for (int i = 0; i < 16; ++i) { y[i] = siluf_(y[i]); ss += y[i] * y[i]; }
            if (part < 2) {
                ss += __shfl_xor(ss, 1); ss += __shfl_xor(ss, 2); ss += __shfl_xor(ss, 4);
                const float sc = rsqrtf(ss + 1e-6f) * (part == 0 ? 0.08838834764831845f : 1.0f);
#pragma unroll
                for (int i = 0; i < 16; ++i) y[i] *= sc;
            }
            if (part >= 1) {
                LAS float* dst = (part == 1 ? ks : vs) + c * 132 + grp * 16;
#pragma unroll
                for (int i = 0; i < 4; ++i) *(LAS f32x4*)(dst + 4 * i) = (f32x4){y[4 * i], y[4 * i + 1], y[4 * i + 2], y[4 * i + 3]};
            }
            if (part <= 1) {
                LAS bf16* dst = (part == 0 ? qb16 : kb16) + c * 136 + grp * 16;
                v4u o0, o1; o0.x = pk2(y[0], y[1]); o0.y = pk2(y[2], y[3]); o0.z = pk2(y[4], y[5]); o0.w = pk2(y[6], y[7]);
                o1.x = pk2(y[8], y[9]); o1.y = pk2(y[10], y[11]); o1.z = pk2(y[12], y[13]); o1.w = pk2(y[14], y[15]);
                *(LAS v4u*)dst = o0; *(LAS v4u*)(dst + 8) = o1;
            }
        }
    }
    if (tid < 64) {
        float v = sg[tid];
#pragma unroll
        for (int off = 1; off < 64; off <<= 1) { const float t = __shfl_up(v, off); if (tid >= off) v += t; }
        sgc[tid] = v; seg[tid] = __expf(v);
        const float gl = __shfl(v, 63);
        sek[tid] = __expf(gl - v);
        if (tid == 63) sek[64] = __expf(v);
    }
    GL_BAR();
    {
        const int mat = wave >> 2, rho = wave & 3, col = lane & 15, g = lane >> 4;
        const LAS bf16* X = mat ? qb16 : kb16;
        bf16x8 af[4];
#pragma unroll
        for (int s = 0; s < 4; ++s) af[s] = *(const LAS bf16x8*)(X + (16 * rho + col) * 136 + 32 * s + 8 * g);
#pragma unroll
        for (int sig = 0; sig < 4; ++sig) {
            f32x4 acc = (f32x4){0.f, 0.f, 0.f, 0.f};
#pragma unroll
            for (int s = 0; s < 4; ++s) { const bf16x8 bfr = *(const LAS bf16x8*)(kb16 + (16 * sig + col) * 136 + 32 * s + 8 * g); acc = __builtin_amdgcn_mfma_f32_16x16x32_bf16(af[s], bfr, acc, 0, 0, 0); }
            const int sidx = 16 * sig + col; const float gs = sgc[sidx];
#pragma unroll
            for (int i = 0; i < 4; ++i) {
                const int c = 16 * rho + 4 * g + i;
                const float dec = (c >= sidx) ? __expf(sgc[c] - gs) : 0.f;
                if (mat == 0) AmT[sidx * 68 + c] = (c > sidx) ? sbeta[c] * acc[i] * dec : 0.f;
                else atts[c * 64 + sidx] = (bf16)f2bf(acc[i] * dec);
            }
        }
    }
    GL_BAR();
    GL_REPF(4) {
        bf16* QD = (bf16*)(ws + WS_QD) + (size_t)item * 8192;
        bf16* KD = (bf16*)(ws + WS_KD) + (size_t)item * 8192;
        bf16* ATT = (bf16*)(ws + WS_ATT) + (size_t)item * 4096;
#pragma unroll
        for (int r = 0; r < 2; ++r) {
            const int id = tid + 512 * r;
            { const int c = id >> 4, gam = id & 15, s32 = gam >> 2, g = gam & 3;
              const v2u lo = *(const LAS v2u*)(qb16 + c * 136 + 32 * s32 + 4 * g), hi = *(const LAS v2u*)(qb16 + c * 136 + 32 * s32 + 16 + 4 * g);
              const float e = seg[c];
              v4u o; o.x = pk2(bflo(lo.x) * e, bfhi(lo.x) * e); o.y = pk2(bflo(lo.y) * e, bfhi(lo.y) * e); o.z = pk2(bflo(hi.x) * e, bfhi(hi.x) * e); o.w = pk2(bflo(hi.y) * e, bfhi(hi.y) * e);
              st16_wt(QD + c * 128 + 8 * gam, o); }
            { const int dk = id >> 3, gam = id & 7, s32 = gam >> 2, g = gam & 3, c0 = 32 * s32 + 4 * g;
              float v[8];
#pragma unroll
              for (int j = 0; j < 4; ++j) { v[j] = ks[(c0 + j) * 132 + dk] * sek[c0 + j]; v[4 + j] = ks[(c0 + 16 + j) * 132 + dk] * sek[c0 + 16 + j]; }
              v4u o; o.x = pk2(v[0], v[1]); o.y = pk2(v[2], v[3]); o.z = pk2(v[4], v[5]); o.w = pk2(v[6], v[7]);
              st16_wt(KD + dk * 64 + 8 * gam, o); }
        }
        { const int c = tid >> 3, gam = tid & 7, s32 = gam >> 2, g = gam & 3;
          const v2u lo = *(const LAS v2u*)(atts + c * 64 + 32 * s32 + 4 * g), hi = *(const LAS v2u*)(atts + c * 64 + 32 * s32 + 16 + 4 * g);
          v4u o; o.x = lo.x; o.y = lo.y; o.z = hi.x; o.w = hi.y;
          st16_wt(ATT + c * 64 + 8 * gam, o); }
    }
    GL_BAR();
    GL_REPF(5) {
        LAS float* xcol = (LAS float*)(lds + GL_SOL);
        LAS bf16* tinv = (LAS bf16*)(lds + GL_SOL + 17408);
        const int j = tid >> 3, part = tid & 7, jb = j >> 4, jo = j & 15;
#pragma unroll 1
        for (int rb = jb; rb < 4; ++rb) {
            float acc[16];
#pragma unroll
            for (int i = 0; i < 16; ++i) acc[i] = 0.f;
            if (rb > jb) {
#pragma unroll 2
                for (int s = 16 * jb + part; s < 16 * rb; s += 8) {
                    const float sv = xcol[j * 68 + s];
                    const LAS float* ar = AmT + s * 68 + 16 * rb;
#pragma unroll
                    for (int q = 0; q < 4; ++q) { const f32x4 A4 = *(const LAS f32x4*)(ar + 4 * q);
                        acc[4 * q] -= A4.x * sv; acc[4 * q + 1] -= A4.y * sv; acc[4 * q + 2] -= A4.z * sv; acc[4 * q + 3] -= A4.w * sv; }
                }
#pragma unroll
                for (int i = 0; i < 16; ++i) {
                    acc[i] += __builtin_bit_cast(float, __builtin_amdgcn_update_dpp(0, __builtin_bit_cast(int, acc[i]), 0xB1, 0xF, 0xF, true));
                    acc[i] += __builtin_bit_cast(float, __builtin_amdgcn_update_dpp(0, __builtin_bit_cast(int, acc[i]), 0x4E, 0xF, 0xF, true));
                    acc[i] += __builtin_bit_cast(float, __builtin_amdgcn_update_dpp(0, __builtin_bit_cast(int, acc[i]), 0x141, 0xF, 0xF, true));
                }
            } else {
#pragma unroll
                for (int i = 0; i < 16; ++i) acc[i] = (i == jo) ? 1.f : 0.f;
            }
#pragma unroll
            for (int i = 0; i < 16; ++i) {
                const float sv = acc[i];
                const LAS float* ar = AmT + (16 * rb + i) * 68 + 16 * rb;
#pragma unroll
                for (int q = (i + 1) / 4; q < 4; ++q) { const f32x4 A4 = *(const LAS f32x4*)(ar + 4 * q);
                    if (4 * q > i) acc[4 * q] -= A4.x * sv; if (4 * q + 1 > i) acc[4 * q + 1] -= A4.y * sv; if (4 * q + 2 > i) acc[4 * q + 2] -= A4.z * sv; if (4 * q + 3 > i) acc[4 * q + 3] -= A4.w * sv; }
            }
            if (part == 0) {
#pragma unroll
                for (int i = 0; i < 16; ++i) { xcol[j * 68 + 16 * rb + i] = acc[i]; tinv[(16 * rb + i) * 72 + j] = (bf16)f2bf(acc[i]); }
            }
            LDS_WAIT(); asm volatile("" ::: "memory");
        }
        for (int rb = 0; rb < jb; ++rb) {
            if (part == 0) {
#pragma unroll
                for (int i = 0; i < 16; ++i) tinv[(16 * rb + i) * 72 + j] = (bf16)0;
            }
        }
    }
    GL_BAR();
    GL_REPF(6) {
        const LAS bf16* tinv = (const LAS bf16*)(lds + GL_SOL + 17408);
        LAS bf16* wst = (LAS bf16*)(lds + GL_SOL + 17408 + 9216);
        const int col = lane & 15, g = lane >> 4, isw = wave >> 2;
        bf16x8 af[4][2];
#pragma unroll
        for (int rho = 0; rho < 4; ++rho)
#pragma unroll
            for (int s2 = 0; s2 < 2; ++s2) af[rho][s2] = *(const LAS bf16x8*)(tinv + (16 * rho + col) * 72 + 32 * s2 + 8 * g);
        bf16* UF = (bf16*)(ws + WS_UF) + (size_t)item * 8192;
#pragma unroll
        for (int sig = 0; sig < 2; ++sig) {
            const int jj = 32 * (wave & 3) + 16 * sig + col;
            const LAS float* src = (isw ? ks : vs) + jj;
            bf16x8 bfr[2];
#pragma unroll
            for (int s2 = 0; s2 < 2; ++s2) {
                float v[8];
#pragma unroll
                for (int e = 0; e < 8; ++e) { const int sidx = 32 * s2 + 8 * g + e; float x = src[sidx * 132] * sbeta[sidx]; if (isw) x *= seg[sidx]; v[e] = x; }
                v4u pk; pk.x = pk2(v[0], v[1]); pk.y = pk2(v[2], v[3]); pk.z = pk2(v[4], v[5]); pk.w = pk2(v[6], v[7]);
                bfr[s2] = __builtin_bit_cast(bf16x8, pk);
            }
            f32x4 acc[4];
#pragma unroll
            for (int rho = 0; rho < 4; ++rho) { acc[rho] = (f32x4){0.f, 0.f, 0.f, 0.f};
#pragma unroll
                for (int s2 = 0; s2 < 2; ++s2) acc[rho] = __builtin_amdgcn_mfma_f32_16x16x32_bf16(af[rho][s2], bfr[s2], acc[rho], 0, 0, 0); }
            if (!isw) {
                v4u o0, o1;
                o0.x = pk2(acc[0].x, acc[0].y); o0.y = pk2(acc[0].z, acc[0].w); o0.z = pk2(acc[1].x, acc[1].y); o0.w = pk2(acc[1].z, acc[1].w);
                o1.x = pk2(acc[2].x, acc[2].y); o1.y = pk2(acc[2].z, acc[2].w); o1.z = pk2(acc[3].x, acc[3].y); o1.w = pk2(acc[3].z, acc[3].w);
                v4u* d = (v4u*)(UF + (size_t)(2 * (wave & 3) + sig) * 1024 + lane * 16);
                st16_wt(d, o0); st16_wt(d + 1, o1);
            } else {
#pragma unroll
                for (int rho = 0; rho < 4; ++rho)
#pragma unroll
                    for (int i = 0; i < 4; ++i) wst[(16 * rho + 4 * g + i) * 136 + jj] = (bf16)f2bf(-acc[rho][i]);
            }
        }
    }
    GL_BAR();
    {
        const LAS bf16* wst = (const LAS bf16*)(lds + GL_SOL + 17408 + 9216);
        bf16* WN = (bf16*)(ws + WS_WN) + (size_t)item * 8192;
#pragma unroll
        for (int r = 0; r < 2; ++r) {
            const int id = tid + 512 * r, c = id >> 4, gam = id & 15, s32 = gam >> 2, g = gam & 3;
            const v2u lo = *(const LAS v2u*)(wst + c * 136 + 32 * s32 + 4 * g), hi = *(const LAS v2u*)(wst + c * 136 + 32 * s32 + 16 + 4 * g);
            v4u o; o.x = lo.x; o.y = lo.y; o.z = hi.x; o.w = hi.y;
            st16_wt(WN + c * 128 + 8 * gam, o);
        }
    }
    asm volatile("s_waitcnt vmcnt(0)" ::: "memory");
    GL_BAR();
    if (tid == 0) { unsigned fb = __builtin_bit_cast(unsigned, sek[64]); if (fb == 0u) fb = 1u;
        __hip_atomic_store((unsigned*)(ws + WS_CTL) + CW_GFLAG + item, fb, __ATOMIC_RELAXED, __HIP_MEMORY_SCOPE_AGENT); }
    GL_BAR();
}

constexpr int LL_XCB = 68608;
static_assert(LL_XCB + 64 * 1040 <= MISC_OFF, "lru_local LDS map");
__device__ __forceinline__ float expm1_small(float x) {
    const float p = x * (1.0f + x * (0.5f + x * (0.16666667f + x * (0.041666668f + x * 0.008333334f))));
    return (x > -0.25f) ? p : (__expf(x) - 1.0f);
}
__device__ __forceinline__ void lru_local_item(const Params& P, LAS unsigned char* lds, int lt, int tid, int lane, int wave) {
    unsigned char* ws = P.ws;
    asm volatile("" : "+v"(tid));
    const int b = lt >> 7, n = lt & 127, t0 = b * SEQ + n * 64;
    LAS bf16* rawx = (LAS bf16*)lds;
    LAS bf16* xcb = (LAS bf16*)(lds + LL_XCB);
    const bf16* XR = (const bf16*)(ws + WS_XR);
    {
        v4u pr[9];
#pragma unroll
        for (int r = 0; r < 9; ++r) { const int id = tid + 512 * r, row = id >> 6, ck = id & 63, s = n * 64 + row - 3;
            pr[r] = (v4u){0u, 0u, 0u, 0u};
            if (id < 67 * 64 && s >= 0) pr[r] = *(const v4u*)(XR + (size_t)(b * SEQ + s) * 512 + ck * 8); }
#pragma unroll
        for (int r = 0; r < 9; ++r) { const int id = tid + 512 * r; if (id < 67 * 64) *(LAS v4u*)(rawx + id * 8) = pr[r]; }
    }
    GL_BAR();
    {
        const int chg = tid & 63, tseg = tid >> 6, ch0 = chg * 8;
        float w[4][8], cb[8];
#pragma unroll
        for (int j = 0; j < 4; ++j) { const f32x4 a = *(const f32x4*)(P.lru_conv_w + j * 512 + ch0), c = *(const f32x4*)(P.lru_conv_w + j * 512 + ch0 + 4);
            w[j][0] = a.x; w[j][1] = a.y; w[j][2] = a.z; w[j][3] = a.w; w[j][4] = c.x; w[j][5] = c.y; w[j][6] = c.z; w[j][7] = c.w; }
        { const f32x4 a = *(const f32x4*)(P.lru_conv_b + ch0), c = *(const f32x4*)(P.lru_conv_b + ch0 + 4);
          cb[0] = a.x; cb[1] = a.y; cb[2] = a.z; cb[3] = a.w; cb[4] = c.x; cb[5] = c.y; cb[6] = c.z; cb[7] = c.w; }
        v4u xr[11];
#pragma unroll
        for (int r = 0; r < 11; ++r) xr[r] = *(const LAS v4u*)(rawx + (tseg * 8 + r) * 512 + ch0);
#pragma unroll
        for (int tk = 0; tk < 8; ++tk) {
            float y[8];
#pragma unroll
            for (int e = 0; e < 8; ++e) y[e] = cb[e];
#pragma unroll
            for (int j = 0; j < 4; ++j) { const v4u x = xr[tk + j];
                y[0] += w[j][0] * bflo(x.x); y[1] += w[j][1] * bfhi(x.x); y[2] += w[j][2] * bflo(x.y); y[3] += w[j][3] * bfhi(x.y);
                y[4] += w[j][4] * bflo(x.z); y[5] += w[j][5] * bfhi(x.z); y[6] += w[j][6] * bflo(x.w); y[7] += w[j][7] * bfhi(x.w); }
            v4u o; o.x = pk2(y[0], y[1]); o.y = pk2(y[2], y[3]); o.z = pk2(y[4], y[5]); o.w = pk2(y[6], y[7]);
            *(LAS v4u*)(xcb + (tseg * 8 + tk) * 520 + ch0) = o;
        }
    }
    GL_BAR();
    {
        const int g = wave, col = lane & 15, g4 = lane >> 4;
        LAS bf16* AM = (LAS bf16*)(lds + wave * 8192); LAS bf16* BT = AM + 2048;
        const bf16* WT = (const bf16*)(ws + WS_LRUWT) + (size_t)g * 8192;
        bf16x8 Bw[2][4][2];
#pragma unroll
        for (int m = 0; m < 2; ++m)
#pragma unroll
            for (int jt = 0; jt < 4; ++jt)
#pragma unroll
                for (int s2 = 0; s2 < 2; ++s2) Bw[m][jt][s2] = *(const bf16x8*)(WT + m * 4096 + (16 * jt + col) * 64 + 32 * s2 + 8 * g4);
        float cba[4], cbx[4], csp[4];
#pragma unroll
        for (int jt = 0; jt < 4; ++jt) { const int ch = g * 64 + 16 * jt + col; cba[jt] = P.lru_ba[ch]; cbx[jt] = P.lru_bx[ch]; csp[jt] = softplusf_(-P.lru_lambda[ch]); }
        bf16* HLOC = (bf16*)(ws + WS_HLOC); bf16* PCUM = (bf16*)(ws + WS_PCUM);
        const int chs = g * 64 + lane;
        float hst = 0.f, pc = 1.f;
#pragma unroll 1
        for (int half = 0; half < 2; ++half) {
            bf16x8 Af[2][2];
#pragma unroll
            for (int rho = 0; rho < 2; ++rho)
#pragma unroll
                for (int s2 = 0; s2 < 2; ++s2) Af[rho][s2] = *(const LAS bf16x8*)(xcb + (32 * half + 16 * rho + col) * 520 + g * 64 + 32 * s2 + 8 * g4);
#pragma unroll
            for (int jt = 0; jt < 4; ++jt) {
#pragma unroll
                for (int rho = 0; rho < 2; ++rho) {
                    f32x4 ra = (f32x4){0.f, 0.f, 0.f, 0.f}, rx = ra;
#pragma unroll
                    for (int s2 = 0; s2 < 2; ++s2) { ra = __builtin_amdgcn_mfma_f32_16x16x32_bf16(Af[rho][s2], Bw[0][jt][s2], ra, 0, 0, 0); rx = __builtin_amdgcn_mfma_f32_16x16x32_bf16(Af[rho][s2], Bw[1][jt][s2], rx, 0, 0, 0); }
#pragma unroll
                    for (int i = 0; i < 4; ++i) {
                        const int tokl = 16 * rho + 4 * g4 + i, chl = 16 * jt + col;
                        const float r = sigmoidf_(ra[i] + cba[jt]), ig = sigmoidf_(rx[i] + cbx[jt]);
                        const float log_a = -8.0f * r * csp[jt];
                        const float am = -expm1_small(log_a), a = 1.0f - am;
                        const float xo = bf1(xcb[(32 * half + tokl) * 520 + g * 64 + chl]);
                        const float bt = __builtin_amdgcn_sqrtf(fmaxf(am * (1.0f + a), 0.f)) * (ig * xo);
                        AM[tokl * 64 + chl] = (bf16)f2bf(am); BT[tokl * 64 + chl] = (bf16)f2bf(bt);
                    }
                }
            }
            LDS_WAIT(); asm volatile("" ::: "memory");
#pragma unroll 8
            for (int tk = 0; tk < 32; ++tk) {
                const float am = bf1(AM[tk * 64 + lane]), bt = bf1(BT[tk * 64 + lane]);
                hst = (hst - am * hst) + bt; pc = pc - am * pc;
                const size_t o = (size_t)(t0 + 32 * half + tk) * 512 + chs;
                HLOC[o] = (bf16)f2bf(hst); PCUM[o] = (bf16)f2bf(pc);
            }
            LDS_WAIT(); asm volatile("" ::: "memory");
        }
        ((float*)(ws + WS_HEND))[(size_t)lt * 512 + chs] = hst; ((float*)(ws + WS_PEND))[(size_t)lt * 512 + chs] = pc;
    }
    GL_BAR();
}

constexpr int SC_WN = 0, SC_QD = 64 * 272, SC_KD = 2 * 64 * 272, SC_ATT = 2 * 64 * 272 + 128 * 144, SC_BUF = 2 * 64 * 272 + 128 * 144 + 64 * 144;
constexpr int SC_SSQ = 2 * SC_BUF;
__device__ __forceinline__ int sc_lds_off(int id) {
    if (id < 1024) return SC_WN + (id >> 4) * 272 + (id & 15) * 16;
    if (id < 2048) { const int q = id - 1024; return SC_QD + (q >> 4) * 272 + (q & 15) * 16; }
    if (id < 3072) { const int q = id - 2048; return SC_KD + (q >> 3) * 144 + (q & 7) * 16; }
    const int q = id - 3072; return SC_ATT + (q >> 3) * 144 + (q & 7) * 16;
}
__device__ __forceinline__ const v4u* sc_src(const unsigned char* ws, int item, int id) {
    if (id < 1024) return (const v4u*)(ws + WS_WN + (size_t)item * 16384) + id;
    if (id < 2048) return (const v4u*)(ws + WS_QD + (size_t)item * 16384) + (id - 1024);
    if (id < 3072) return (const v4u*)(ws + WS_KD + (size_t)item * 16384) + (id - 2048);
    return (const v4u*)(ws + WS_ATT + (size_t)item * 8192) + (id - 3072);
}
__device__ __forceinline__ bf16x8 pack_b(const f32x4 a, const f32x4 b) {
    v4u r; r.x = pk2(a.x, a.y); r.y = pk2(a.z, a.w); r.z = pk2(b.x, b.y); r.w = pk2(b.z, b.w);
    return __builtin_bit_cast(bf16x8, r);
}
#define SC_BAR() do { asm volatile("s_waitcnt lgkmcnt(0)" ::: "memory"); __builtin_amdgcn_s_barrier(); asm volatile("" ::: "memory"); } while (0)
#define SC_GLD(dst, ptr) asm volatile("global_load_dwordx4 %0, %1, off" : "=v"(dst) : "v"(ptr) : "memory")
#define PIN8(a) asm volatile("" : "+v"(a[0]), "+v"(a[1]), "+v"(a[2]), "+v"(a[3]), "+v"(a[4]), "+v"(a[5]), "+v"(a[6]), "+v"(a[7]))
#define PIN16(a) asm volatile("" : "+v"(a[0]), "+v"(a[1]), "+v"(a[2]), "+v"(a[3]), "+v"(a[4]), "+v"(a[5]), "+v"(a[6]), "+v"(a[7]), "+v"(a[8]), "+v"(a[9]), "+v"(a[10]), "+v"(a[11]), "+v"(a[12]), "+v"(a[13]), "+v"(a[14]), "+v"(a[15]))
constexpr int SCAN_NWC = 2, SCAN_PARTS = 4, SCAN_WGS = 8 * SCAN_PARTS;
constexpr int SC_UFS = 2 * SC_BUF;
constexpr int SC_DECS = SC_UFS + 2 * SCAN_NWC * 2048;
constexpr int SC_OT = SC_DECS + 512;
constexpr int SC_RDY = SC_OT + 2 * 64 * 36 * 4;
constexpr int SC_END = SC_RDY + 64;
static_assert(SC_END <= MISC_OFF, "scan LDS");
#ifndef SCAN_REPS
#define SCAN_REPS 1
#endif
#ifndef SCAN_EXP
#define SCAN_EXP 0
#endif
__device__ __forceinline__ int sc3_lds_off(int id) {
    if (id < 3584) return sc_lds_off(id);
    return SC_UFS + (id - 3584) * 16;
}
__device__ __forceinline__ const v4u* sc3_src(const unsigned char* ws, int item, int id, int part) {
    if (id < 3584) return sc_src(ws, item, id);
    return (const v4u*)(ws + WS_UF + (size_t)item * 16384 + (size_t)(part * SCAN_NWC) * 2048) + (id - 3584);
}
__device__ __forceinline__ void gdn_scan(const Params& P, LAS unsigned char* lds, int sb, int tid, int lane, int wave) {
    const unsigned char* ws = P.ws;
    constexpr int NCH = 128 * SCAN_REPS, NPC = 15;
    const int bh = sb & 7, part = sb >> 3;
    const int b = bh >> 2, h = bh & 3, col = lane & 15, g = lane >> 4;
    const int item0 = bh * 128;
    if (tid == 0) *(volatile LAS unsigned*)(lds + SC_RDY) = 0u;
    SC_BAR();
    if (wave >= 4) {
        constexpr int NP = 15, DEP = 3;
        const int lt = tid - 256;
        const unsigned voff = (unsigned)lt * 16u;
        const int lA = (lt >> 4) * 272 + (lt & 15) * 16, lB = (lt >> 3) * 144 + (lt & 7) * 16, lU = SC_UFS + lt * 16;
        v4u rs[DEP][NP];
#define SC_ISSUE(set, itm) do { const unsigned char* gq_ = ws + (size_t)(itm) * 16384; const unsigned char* ga_ = ws + WS_ATT + (size_t)(itm) * 8192; \
            asm volatile("s_nop 4\n\tglobal_load_dwordx4 %0, %8, %9 sc0 sc1\n\tglobal_load_dwordx4 %1, %8, %10 sc0 sc1\n\tglobal_load_dwordx4 %2, %8, %11 sc0 sc1\n\tglobal_load_dwordx4 %3, %8, %12 sc0 sc1\n\t" \
                         "global_load_dwordx4 %4, %8, %13 sc0 sc1\n\tglobal_load_dwordx4 %5, %8, %14 sc0 sc1\n\tglobal_load_dwordx4 %6, %8, %15 sc0 sc1\n\tglobal_load_dwordx4 %7, %8, %16 sc0 sc1" \
                : "=&v"(rs[set][0]), "=&v"(rs[set][1]), "=&v"(rs[set][2]), "=&v"(rs[set][3]), "=&v"(rs[set][4]), "=&v"(rs[set][5]), "=&v"(rs[set][6]), "=&v"(rs[set][7]) \
                : "v"(voff), "s"(gq_ + WS_WN), "s"(gq_ + WS_WN + 4096), "s"(gq_ + WS_WN + 8192), "s"(gq_ + WS_WN + 12288), \
                  "s"(gq_ + WS_QD), "s"(gq_ + WS_QD + 4096), "s"(gq_ + WS_QD + 8192), "s"(gq_ + WS_QD + 12288) : "memory"); \
            asm volatile("s_nop 4\n\tglobal_load_dwordx4 %0, %7, %8 sc0 sc1\n\tglobal_load_dwordx4 %1, %7, %9 sc0 sc1\n\tglobal_load_dwordx4 %2, %7, %10 sc0 sc1\n\tglobal_load_dwordx4 %3, %7, %11 sc0 sc1\n\t" \
                         "global_load_dwordx4 %4, %7, %12 sc0 sc1\n\tglobal_load_dwordx4 %5, %7, %13 sc0 sc1\n\tglobal_load_dwordx4 %6, %7, %14 sc0 sc1" \
                : "=&v"(rs[set][8]), "=&v"(rs[set][9]), "=&v"(rs[set][10]), "=&v"(rs[set][11]), "=&v"(rs[set][12]), "=&v"(rs[set][13]), "=&v"(rs[set][14]) \
                : "v"(voff), "s"(gq_ + WS_KD), "s"(gq_ + WS_KD + 4096), "s"(gq_ + WS_KD + 8192), "s"(gq_ + WS_KD + 12288), \
                  "s"(ga_), "s"(ga_ + 4096), "s"(gq_ + WS_UF + (size_t)(part * SCAN_NWC) * 2048) : "memory"); } while (0)
#define SC_WAITSET(set, cnt) asm volatile("s_waitcnt " cnt : "+v"(rs[set][0]), "+v"(rs[set][1]), "+v"(rs[set][2]), "+v"(rs[set][3]), "+v"(rs[set][4]), "+v"(rs[set][5]), "+v"(rs[set][6]), "+v"(rs[set][7]), \
            "+v"(rs[set][8]), "+v"(rs[set][9]), "+v"(rs[set][10]), "+v"(rs[set][11]), "+v"(rs[set][12]), "+v"(rs[set][13]), "+v"(rs[set][14]) :: "memory")
#define SC_WRITE(set, par) do { LAS unsigned char* wb_ = lds + (par) * SC_BUF; \
            _Pragma("unroll") for (int r = 0; r < 4; ++r) { *(LAS v4u*)(wb_ + SC_WN + lA + r * (16 * 272)) = rs[set][r]; *(LAS v4u*)(wb_ + SC_QD + lA + r * (16 * 272)) = rs[set][4 + r]; \
                                                          *(LAS v4u*)(wb_ + SC_KD + lB + r * (32 * 144)) = rs[set][8 + r]; } \
            *(LAS v4u*)(wb_ + SC_ATT + lB) = rs[set][12]; *(LAS v4u*)(wb_ + SC_ATT + lB + 32 * 144) = rs[set][13]; \
            *(LAS v4u*)(lds + lU + (par) * (SCAN_NWC * 2048)) = rs[set][14]; } while (0)
#define SC_NEED(c) do { unsigned sp_ = 0; while (*(volatile LAS unsigned*)(lds + SC_RDY) <= (unsigned)(c) && ++sp_ < (1u << 24)) __builtin_amdgcn_s_sleep(2); } while (0)
        SC_NEED(0); SC_ISSUE(0, item0);
        SC_WAITSET(0, "vmcnt(0)"); SC_WRITE(0, 0); SC_WAITSET(0, "lgkmcnt(0)");
        SC_NEED(3); SC_ISSUE(1, item0 + 1); SC_ISSUE(2, item0 + 2); SC_ISSUE(0, item0 + 3);
        SC_BAR();
        int n2 = 0;
#define SC_INTERVAL(set) do { SC_WAITSET(set, "vmcnt(30)"); SC_WRITE(set, (n2 + 1) & 1); SC_WAITSET(set, "lgkmcnt(0)"); if (n2 + 1 + DEP < 128) SC_NEED(n2 + 1 + DEP); SC_ISSUE(set, item0 + ((n2 + 1 + DEP) & 127)); SC_BAR(); ++n2; } while (0)
#pragma unroll 1
        for (int it = 0; it < NCH / 3; ++it) { SC_INTERVAL(1); SC_INTERVAL(2); SC_INTERVAL(0); }
        if (NCH % 3 >= 1) SC_INTERVAL(1);
        if (NCH % 3 >= 2) SC_INTERVAL(2);
        SC_WAITSET(0, "vmcnt(0)"); SC_WAITSET(1, "vmcnt(0)"); SC_WAITSET(2, "vmcnt(0)");
#undef SC_INTERVAL
#undef SC_NEED
#undef SC_WRITE
#undef SC_WAITSET
#undef SC_ISSUE
        return;
    }
    if (wave == 3) {
        const unsigned* flags = (const unsigned*)(ws + WS_CTL) + CW_GFLAG + item0;
        unsigned rdy = 0;
#define SC_POLLSTEP() do { if (rdy < 128u) { const unsigned idx_ = rdy + (unsigned)lane; \
            const unsigned fv_ = (idx_ < 128u) ? __hip_atomic_load(flags + idx_, __ATOMIC_RELAXED, __HIP_MEMORY_SCOPE_AGENT) : 0u; \
            const unsigned long long m_ = __ballot(fv_ != 0u); const unsigned nrun_ = (m_ == ~0ull) ? 64u : (unsigned)__builtin_ctzll(~m_);     \
            if ((unsigned)lane < nrun_) ((LAS float*)(lds + SC_DECS))[idx_] = __builtin_bit_cast(float, fv_); \
            rdy += nrun_; LDS_WAIT(); if (lane == 0) *(volatile LAS unsigned*)(lds + SC_RDY) = rdy; } } while (0)
        { unsigned sp = 0; while (rdy < 4u && ++sp < (1u << 22)) { SC_POLLSTEP(); if (rdy < 4u) __builtin_amdgcn_s_sleep(16); } }
        SC_BAR();
#pragma unroll 1
        for (int n2 = 0; n2 < NCH; ++n2) {
            { const unsigned need = (unsigned)(n2 + 1 + 3) < 128u ? (unsigned)(n2 + 1 + 3) : 127u; unsigned sp = 0;
              while (rdy <= need && rdy < 128u && ++sp < (1u << 22)) { SC_POLLSTEP(); if (rdy <= need) __builtin_amdgcn_s_sleep(8); } }
            if (rdy < 128u && rdy < (unsigned)(n2 & 127) + 16u) SC_POLLSTEP();
            SC_BAR();
        }
#undef SC_POLLSTEP
        return;
    }
    if (wave == 2) {
        const int row = lane;
        bf16* Y = (bf16*)((unsigned char*)P.out + OUT_Y);
        float* SSQG = P.out;
        SC_BAR();
#pragma unroll 1
        for (int n2 = 0; n2 <= NCH; ++n2) {
            if (n2 > 0) {
                const int n = (n2 - 1) & 127, t = b * SEQ + n * 64 + row;
                const LAS float* src = (const LAS float*)(lds + SC_OT + ((n2 - 1) & 1) * (64 * 36 * 4)) + row * 36;
                f32x4 a[8]; float s2 = 0.f;
#pragma unroll
                for (int q = 0; q < 8; ++q) { a[q] = *(const LAS f32x4*)(src + 4 * q); s2 += (a[q].x * a[q].x + a[q].y * a[q].y) + (a[q].z * a[q].z + a[q].w * a[q].w); }
                SSQG[(size_t)t * 32 + h * 8 + part] = s2;
                v4u* d = (v4u*)(Y + (size_t)t * 1024 + h * 128 + 32 * part);
#pragma unroll
                for (int q = 0; q < 4; ++q) { v4u o; o.x = pk2(a[2 * q].x, a[2 * q].y); o.y = pk2(a[2 * q].z, a[2 * q].w); o.z = pk2(a[2 * q + 1].x, a[2 * q + 1].y); o.w = pk2(a[2 * q + 1].z, a[2 * q + 1].w); d[q] = o; }
            }
            if (n2 < NCH) SC_BAR();
        }
        return;
    }
    f32x4 S[8];
#pragma unroll
    for (int i = 0; i < 8; ++i) S[i] = (f32x4){0.f, 0.f, 0.f, 0.f};
    SC_BAR();
#pragma unroll 1
    for (int n2 = 0; n2 < NCH; ++n2) {
        if (SCAN_REPS > 1 && (n2 & 127) == 0) {
#pragma unroll
            for (int i = 0; i < 8; ++i) S[i] = (f32x4){0.f, 0.f, 0.f, 0.f};
        }
        if (SCAN_EXP == 2 && n2 < 128) { SC_BAR(); continue; }
        const int par = n2 & 1;
        LAS unsigned char* buf = lds + par * SC_BUF;
        bf16x8 fA[16], fB[16], fC[16], fD[8];
#pragma unroll
        for (int rho = 0; rho < 4; ++rho)
#pragma unroll
            for (int s = 0; s < 4; ++s) fA[rho * 4 + s] = *(const LAS bf16x8*)(buf + SC_WN + (16 * rho + col) * 272 + (32 * s + 8 * g) * 2);
#pragma unroll
        for (int rho = 0; rho < 4; ++rho)
#pragma unroll
            for (int s = 0; s < 4; ++s) fB[rho * 4 + s] = *(const LAS bf16x8*)(buf + SC_QD + (16 * rho + col) * 272 + (32 * s + 8 * g) * 2);
        const LAS v4u* ufp = (const LAS v4u*)(lds + SC_UFS + par * (SCAN_NWC * 2048) + wave * 2048 + lane * 32);
        const v4u uf0 = ufp[0], uf1 = ufp[1];
        const float dec = ((const LAS float*)(lds + SC_DECS))[n2 & 127];
        bf16x8 Bs[4];
#pragma unroll
        for (int s = 0; s < 4; ++s) Bs[s] = pack_b(S[2 * s], S[2 * s + 1]);
        f32x4 Vn[4], Oc[4];
        Vn[0] = (f32x4){bflo(uf0.x), bfhi(uf0.x), bflo(uf0.y), bfhi(uf0.y)}; Vn[1] = (f32x4){bflo(uf0.z), bfhi(uf0.z), bflo(uf0.w), bfhi(uf0.w)};
        Vn[2] = (f32x4){bflo(uf1.x), bfhi(uf1.x), bflo(uf1.y), bfhi(uf1.y)}; Vn[3] = (f32x4){bflo(uf1.z), bfhi(uf1.z), bflo(uf1.w), bfhi(uf1.w)};
        __builtin_amdgcn_sched_barrier(0);
        PIN16(fA);
#pragma unroll
        for (int s = 0; s < 4; ++s)
#pragma unroll
            for (int rho = 0; rho < 4; ++rho) Vn[rho] = __builtin_amdgcn_mfma_f32_16x16x32_bf16(fA[rho * 4 + s], Bs[s], Vn[rho], 0, 0, 0);
        __builtin_amdgcn_sched_barrier(0);
#pragma unroll
        for (int tau = 0; tau < 8; ++tau)
#pragma unroll
            for (int s = 0; s < 2; ++s) fC[tau * 2 + s] = *(const LAS bf16x8*)(buf + SC_KD + (16 * tau + col) * 144 + (32 * s + 8 * g) * 2);
        __builtin_amdgcn_sched_barrier(0);
        PIN16(fB);
#pragma unroll
        for (int rho = 0; rho < 4; ++rho) Oc[rho] = (f32x4){0.f, 0.f, 0.f, 0.f};
#pragma unroll
        for (int s = 0; s < 4; ++s)
#pragma unroll
            for (int rho = 0; rho < 4; ++rho) Oc[rho] = __builtin_amdgcn_mfma_f32_16x16x32_bf16(fB[rho * 4 + s], Bs[s], Oc[rho], 0, 0, 0);
        __builtin_amdgcn_sched_barrier(0);
#pragma unroll
        for (int rho = 0; rho < 4; ++rho)
#pragma unroll
            for (int s = 0; s < 2; ++s) fD[rho * 2 + s] = *(const LAS bf16x8*)(buf + SC_ATT + (16 * rho + col) * 144 + (32 * s + 8 * g) * 2);
        bf16x8 Bv[2];
        Bv[0] = pack_b(Vn[0], Vn[1]); Bv[1] = pack_b(Vn[2], Vn[3]);
#pragma unroll
        for (int tau = 0; tau < 8; ++tau) S[tau] = S[tau] * dec;
        __builtin_amdgcn_sched_barrier(0);
        PIN16(fC);
#pragma unroll
        for (int s = 0; s < 2; ++s)
#pragma unroll
            for (int tau = 0; tau < 8; ++tau) S[tau] = __builtin_amdgcn_mfma_f32_16x16x32_bf16(fC[tau * 2 + s], Bv[s], S[tau], 0, 0, 0);
        __builtin_amdgcn_sched_barrier(0);
        PIN8(fD);
#pragma unroll
        for (int s = 0; s < 2; ++s)
#pragma unroll
            for (int rho = 0; rho < 4; ++rho) Oc[rho] = __builtin_amdgcn_mfma_f32_16x16x32_bf16(fD[rho * 2 + s], Bv[s], Oc[rho], 0, 0, 0);
        LAS float* ot = (LAS float*)(lds + SC_OT + par * (64 * 36 * 4)) + 16 * wave + col;
#pragma unroll
        for (int rho = 0; rho < 4; ++rho)
#pragma unroll
            for (int i = 0; i < 4; ++i) ot[(16 * rho + 4 * g + i) * 36] = Oc[rho][i];
        SC_BAR();
    }
}

__device__ __forceinline__ void lru_carry(const Params& P, int gwv, int lane) {
    unsigned char* ws = P.ws;
    const int b = gwv >> 3, g = gwv & 7, ch = g * 64 + lane;
    const float* HEND = (const float*)(ws + WS_HEND); const float* PEND = (const float*)(ws + WS_PEND); float* HIN = (float*)(ws + WS_HIN);
    float hin = 0.f;
#pragma unroll 1
    for (int n0 = 0; n0 < 128; n0 += 16) {
        float he[16], pe[16];
#pragma unroll
        for (int i = 0; i < 16; ++i) { const size_t o = (size_t)(b * 128 + n0 + i) * 512 + ch; he[i] = HEND[o]; pe[i] = PEND[o]; }
#pragma unroll
        for (int i = 0; i < 16; ++i) { HIN[(size_t)(b * 128 + n0 + i) * 512 + ch] = hin; hin = he[i] + pe[i] * hin; }
    }
}

__device__ __forceinline__ void cvt_table(const float* src, bf16* dst, size_t n8, size_t wi, size_t nw) {
    for (size_t i = wi; i < n8; i += nw) {
        const f32x4 a = ((const f32x4*)src)[2 * i], c = ((const f32x4*)src)[2 * i + 1];
        v4u o; o.x = pk2(a.x, a.y); o.y = pk2(a.z, a.w); o.z = pk2(c.x, c.y); o.w = pk2(c.z, c.w);
        ((v4u*)dst)[i] = o;
    }
}

__device__ __forceinline__ void lru_combine(const Params& P, size_t wi, size_t nw) {
    unsigned char* ws = P.ws;
    const v4u* HLOC = (const v4u*)(ws + WS_HLOC); const v4u* PCUM = (const v4u*)(ws + WS_PCUM); const v4u* GATE = (const v4u*)(ws + WS_GATE);
    const float* HIN = (const float*)(ws + WS_HIN); bf16* Y = (bf16*)((unsigned char*)P.out + OUT_Y);
    for (size_t i = wi; i < (size_t)T * 64; i += nw) {
        const size_t t = i >> 6; const int ch0 = (int)(i & 63) * 8;
        const v4u hl = HLOC[i], pc = PCUM[i], gt = GATE[i];
        const f32x4 h0 = *(const f32x4*)(HIN + (t >> 6) * 512 + ch0), h1 = *(const f32x4*)(HIN + (t >> 6) * 512 + ch0 + 4);
        float y[8];
        y[0] = (bflo(hl.x) + bflo(pc.x) * h0.x) * gelu_tanh(bflo(gt.x)); y[1] = (bfhi(hl.x) + bfhi(pc.x) * h0.y) * gelu_tanh(bfhi(gt.x));
        y[2] = (bflo(hl.y) + bflo(pc.y) * h0.z) * gelu_tanh(bflo(gt.y)); y[3] = (bfhi(hl.y) + bfhi(pc.y) * h0.w) * gelu_tanh(bfhi(gt.y));
        y[4] = (bflo(hl.z) + bflo(pc.z) * h1.x) * gelu_tanh(bflo(gt.z)); y[5] = (bfhi(hl.z) + bfhi(pc.z) * h1.y) * gelu_tanh(bfhi(gt.z));
        y[6] = (bflo(hl.w) + bflo(pc.w) * h1.z) * gelu_tanh(bflo(gt.w)); y[7] = (bfhi(hl.w) + bfhi(pc.w) * h1.w) * gelu_tanh(bfhi(gt.w));
        v4u o; o.x = pk2(y[0], y[1]); o.y = pk2(y[2], y[3]); o.z = pk2(y[4], y[5]); o.w = pk2(y[6], y[7]);
        *(v4u*)(Y + t * 1024 + 512 + ch0) = o;
    }
}

__device__ __forceinline__ void gdn_gate_norm(const Params& P, size_t wi, size_t nw) {
    unsigned char* ws = P.ws;
    bf16* Y = (bf16*)((unsigned char*)P.out + OUT_Y); const v4u* Z = (const v4u*)(ws + WS_Z); const float* SSQG = P.out;
    for (size_t i = wi; i < (size_t)T * 64; i += nw) {
        const size_t t = i >> 6; const int c0 = (int)(i & 63) * 8, h = c0 >> 7;
        const f32x4 q0 = *(const f32x4*)(SSQG + t * 32 + h * 8);
        const float rstd = rsqrtf(((q0.x + q0.y) + (q0.z + q0.w)) * (1.0f / 128.0f) + 1e-6f);
        const v4u o = *(const v4u*)(Y + t * 1024 + c0), z = Z[i];
        const f32x4 w0 = *(const f32x4*)(P.gdn_norm_w + (c0 & 127)), w1 = *(const f32x4*)(P.gdn_norm_w + (c0 & 127) + 4);
        float y[8];
        y[0] = bflo(o.x) * rstd * w0.x * siluf_(bflo(z.x)); y[1] = bfhi(o.x) * rstd * w0.y * siluf_(bfhi(z.x));
        y[2] = bflo(o.y) * rstd * w0.z * siluf_(bflo(z.y)); y[3] = bfhi(o.y) * rstd * w0.w * siluf_(bfhi(z.y));
        y[4] = bflo(o.z) * rstd * w1.x * siluf_(bflo(z.z)); y[5] = bfhi(o.z) * rstd * w1.y * siluf_(bfhi(z.z));
        y[6] = bflo(o.w) * rstd * w1.z * siluf_(bflo(z.w)); y[7] = bfhi(o.w) * rstd * w1.w * siluf_(bfhi(z.w));
        v4u r; r.x = pk2(y[0], y[1]); r.y = pk2(y[2], y[3]); r.z = pk2(y[4], y[5]); r.w = pk2(y[6], y[7]);
        *(v4u*)(Y + t * 1024 + c0) = r;
    }
}

__device__ __forceinline__ void xattn_stage(LAS unsigned char* lds, const bf16* src, int tid) {
    v4u tmp[16];
    const unsigned voff = (unsigned)tid * 16u;
#pragma unroll
    for (int r = 0; r < 16; ++r) { const unsigned char* sb = (const unsigned char*)src + r * 8192;
        asm volatile("s_nop 4\n\tglobal_load_dwordx4 %0, %1, %2" : "=&v"(tmp[r]) : "v"(voff), "s"(sb) : "memory"); }
    asm volatile("s_waitcnt vmcnt(0)" : "+v"(tmp[0]), "+v"(tmp[1]), "+v"(tmp[2]), "+v"(tmp[3]), "+v"(tmp[4]), "+v"(tmp[5]), "+v"(tmp[6]), "+v"(tmp[7]),
                                        "+v"(tmp[8]), "+v"(tmp[9]), "+v"(tmp[10]), "+v"(tmp[11]), "+v"(tmp[12]), "+v"(tmp[13]), "+v"(tmp[14]), "+v"(tmp[15]) :: "memory");
#pragma unroll
    for (int r = 0; r < 16; ++r) { const int id = tid + 512 * r; *(LAS v4u*)(lds + (id >> 5) * 528 + (id & 31) * 16) = tmp[r]; }
}
__device__ __forceinline__ void xattn_unit(const Params& P, LAS unsigned char* lds, int unit, int tid, int lane, int wave) {
    const unsigned char* ws = P.ws;
    const int h = unit & 3, qb = (unit >> 2) & 63, b = unit >> 8, col = lane & 15, g = lane >> 4;
    const int tw = b * SEQ + qb * 128 + 16 * wave;
    const bf16* Kb = (const bf16*)(ws + WS_KB) + (size_t)((b * 4 + h) * 256) * 256;
    const bf16* Vt = (const bf16*)(ws + WS_VTP) + (size_t)((b * 4 + h) * 256) * 256;
    xattn_stage(lds, Kb, tid);
    __syncthreads();
    const LAS unsigned char* arow = lds + col * 528 + g * 16;
    bf16x8 Bp[1][8]; float inv[1];
#pragma unroll
    for (int ps = 0; ps < 1; ++ps) {
        const bf16* Q = (const bf16*)(ws + WS_Q) + (size_t)(tw + 16 * ps + col) * 1024 + h * 256 + 8 * g;
        bf16x8 Bq[8];
#pragma unroll
        for (int s = 0; s < 8; ++s) Bq[s] = *(const bf16x8*)(Q + 32 * s);
        f32x4 St[16];
        bf16x8 fr[2][8];
#pragma unroll
        for (int s = 0; s < 8; ++s) fr[0][s] = *(const LAS bf16x8*)(arow + 64 * s);
#pragma unroll
        for (int kap = 0; kap < 16; ++kap) {
            if (kap + 1 < 16) {
#pragma unroll
                for (int s = 0; s < 8; ++s) fr[(kap + 1) & 1][s] = *(const LAS bf16x8*)(arow + (16 * (kap + 1)) * 528 + 64 * s);
            }
            __builtin_amdgcn_sched_barrier(0);
            PIN8(fr[kap & 1]);
            f32x4 acc = (f32x4){0.f, 0.f, 0.f, 0.f};
#pragma unroll
            for (int s = 0; s < 8; ++s) acc = __builtin_amdgcn_mfma_f32_16x16x32_bf16(fr[kap & 1][s], Bq[s], acc, 0, 0, 0);
            St[kap] = acc;
            __builtin_amdgcn_sched_barrier(0);
        }
        float mx = -3.0e38f;
#pragma unroll
        for (int kap = 0; kap < 16; ++kap) mx = fmaxf(fmaxf(fmaxf(St[kap].x, St[kap].y), fmaxf(St[kap].z, St[kap].w)), mx);
        mx = fmaxf(mx, __shfl_xor(mx, 16)); mx = fmaxf(mx, __shfl_xor(mx, 32));
        float l = 0.f;
#pragma unroll
        for (int kap = 0; kap < 16; ++kap) { St[kap].x = __expf(St[kap].x - mx); St[kap].y = __expf(St[kap].y - mx); St[kap].z = __expf(St[kap].z - mx); St[kap].w = __expf(St[kap].w - mx);
            l += (St[kap].x + St[kap].y) + (St[kap].z + St[kap].w); }
        l += __shfl_xor(l, 16); l += __shfl_xor(l, 32);
        inv[ps] = 1.0f / l;
#pragma unroll
        for (int s = 0; s < 8; ++s) Bp[ps][s] = pack_b(St[2 * s], St[2 * s + 1]);
    }
    __syncthreads();
    xattn_stage(lds, Vt, tid);
    __syncthreads();
#pragma unroll
    for (int ps = 0; ps < 1; ++ps) {
        bf16* AO = (bf16*)(P.ws + WS_AO) + (size_t)(tw + 16 * ps + col) * 1024 + h * 256 + 4 * g;
        bf16x8 fr[2][8];
#pragma unroll
        for (int s = 0; s < 8; ++s) fr[0][s] = *(const LAS bf16x8*)(arow + 64 * s);
#pragma unroll
        for (int del = 0; del < 16; ++del) {
            if (del + 1 < 16) {
#pragma unroll
                for (int s = 0; s < 8; ++s) fr[(del + 1) & 1][s] = *(const LAS bf16x8*)(arow + (16 * (del + 1)) * 528 + 64 * s);
            }
            __builtin_amdgcn_sched_barrier(0);
            PIN8(fr[del & 1]);
            f32x4 acc = (f32x4){0.f, 0.f, 0.f, 0.f};
#pragma unroll
            for (int s = 0; s < 8; ++s) acc = __builtin_amdgcn_mfma_f32_16x16x32_bf16(fr[del & 1][s], Bp[ps][s], acc, 0, 0, 0);
            v2u o; o.x = pk2(acc.x * inv[ps], acc.y * inv[ps]); o.y = pk2(acc.z * inv[ps], acc.w * inv[ps]);
            *(v2u*)(AO + 16 * del) = o;
            __builtin_amdgcn_sched_barrier(0);
        }
    }
    __syncthreads();
}

__device__ __forceinline__ unsigned key_enc(float f) { const unsigned u = __builtin_bit_cast(unsigned, f); return (u & 0x80000000u) ? ~u : (u | 0x80000000u); }
__device__ __forceinline__ float key_dec(unsigned k) { const unsigned u = (k & 0x80000000u) ? (k & 0x7fffffffu) : ~k; return __builtin_bit_cast(float, u); }
#define TK_CAS(a, b) do { const unsigned hi_ = max(a, b), lo_ = min(a, b); a = hi_; b = lo_; } while (0)
__device__ __forceinline__ void tk_merge16(unsigned (&a)[16]) {
#pragma unroll
    for (int j = 8; j > 0; j >>= 1)
#pragma unroll
        for (int i = 0; i < 16; ++i) { const int l = i ^ j; if (l > i) TK_CAS(a[i], a[l]); }
}
__device__ __forceinline__ void tk_sort16(unsigned (&a)[16]) {
#pragma unroll
    for (int k = 2; k <= 16; k <<= 1)
#pragma unroll
        for (int j = k >> 1; j > 0; j >>= 1)
#pragma unroll
            for (int i = 0; i < 16; ++i) { const int l = i ^ j; if (l > i) { if ((i & k) == 0) TK_CAS(a[i], a[l]); else TK_CAS(a[l], a[i]); } }
}
__device__ __forceinline__ void tk_top16_merge(unsigned (&L)[16], const unsigned (&G)[16]) {
#pragma unroll
    for (int i = 0; i < 16; ++i) L[i] = max(L[i], G[15 - i]);
    tk_merge16(L);
}
__device__ __forceinline__ void tk_pair_merge(unsigned (&L)[16]) {
    unsigned Pp[16];
#pragma unroll
    for (int i = 0; i < 16; ++i) Pp[i] = (unsigned)__builtin_amdgcn_update_dpp(0, (int)L[i], 0xB1, 0xF, 0xF, true);
    tk_top16_merge(L, Pp);
}
__device__ __forceinline__ void peer_topk_rows(const Params& P, LAS unsigned char* lds, int rowbase, int tid) {
    const unsigned char* ws = P.ws;
    typedef _Float16 f16x8 __attribute__((ext_vector_type(8)));
    const int rl = tid >> 1, hf = tid & 1, grow = rowbase + rl, t = grow >> 3, h = grow & 7;
    const _Float16* SC = (const _Float16*)(ws + WS_PQ) + (size_t)t * 2048 + h * 256 + 64 * hf;
    f16x8 raw[2][8];
#pragma unroll
    for (int p = 0; p < 2; ++p)
#pragma unroll
        for (int q = 0; q < 8; ++q) raw[p][q] = *(const f16x8*)(SC + p * 128 + 8 * q);
    unsigned L1[16], L2[16];
#pragma unroll
    for (int p = 0; p < 2; ++p) {
        unsigned L[16];
#pragma unroll
        for (int grp = 0; grp < 4; ++grp) {
            unsigned G[16];
#pragma unroll
            for (int e = 0; e < 16; ++e) G[e] = (key_enc((float)raw[p][2 * grp + (e >> 3)][e & 7]) & ~127u) | (unsigned)(127 - (64 * hf + 16 * grp + e));
            tk_sort16(G);
            if (grp == 0) {
#pragma unroll
                for (int i = 0; i < 16; ++i) L[i] = G[i];
            } else tk_top16_merge(L, G);
        }
        tk_pair_merge(L);
#pragma unroll
        for (int i = 0; i < 16; ++i) { if (p == 0) L1[i] = L[i]; else L2[i] = L[i]; }
    }
    {
        float v1[16], v2[16];
        LAS int* il = (LAS int*)lds + rl * 33;
#pragma unroll
        for (int q = 0; q < 16; ++q) { v1[q] = key_dec((L1[q] & ~127u) | 64u); v2[q] = key_dec((L2[q] & ~127u) | 64u); }
        if (hf == 0) {
#pragma unroll
            for (int q = 0; q < 16; ++q) { il[q] = 127 - (int)(L1[q] & 127u); il[16 + q] = 127 - (int)(L2[q] & 127u); }
        }
        unsigned C[16], D[16];
        float w1[8];
        const unsigned hf16 = (unsigned)hf * 16u, evenmask = (unsigned)hf - 1u;
#pragma unroll
        for (int k = 0; k < 8; ++k) w1[k] = __builtin_bit_cast(float, (__builtin_bit_cast(unsigned, v1[2 * k]) & evenmask) | (__builtin_bit_cast(unsigned, v1[2 * k + 1]) & ~evenmask));
#define TK_SLOT(dst, k, bq, valid_odd) do { const unsigned pos_ = (unsigned)(16 * (2 * (k)) + (bq)) + hf16; unsigned kv_ = (key_enc(w1[k] + v2[bq]) & ~255u) | (255u - pos_); if (!(valid_odd)) kv_ &= evenmask; dst = kv_; } while (0)
        TK_SLOT(C[0], 0, 0, true);
        TK_SLOT(C[1], 0, 1, true);
        TK_SLOT(C[2], 0, 2, true);
        TK_SLOT(C[3], 0, 3, true);
        TK_SLOT(C[4], 0, 4, true);
        TK_SLOT(C[5], 0, 5, true);
        TK_SLOT(C[6], 0, 6, true);
        TK_SLOT(C[7], 0, 7, true);
        TK_SLOT(C[8], 0, 8, false);
        TK_SLOT(C[9], 0, 9, false);
        TK_SLOT(C[10], 0, 10, false);
        TK_SLOT(C[11], 0, 11, false);
        TK_SLOT(C[12], 0, 12, false);
        TK_SLOT(C[13], 0, 13, false);
        TK_SLOT(C[14], 0, 14, false);
        TK_SLOT(C[15], 0, 15, false);
        TK_SLOT(D[0], 1, 0, true);
        TK_SLOT(D[1], 1, 1, true);
        TK_SLOT(D[2], 1, 2, true);
        TK_SLOT(D[3], 1, 3, true);
        TK_SLOT(D[4], 1, 4, false);
        TK_SLOT(D[5], 2, 0, true);
        TK_SLOT(D[6], 2, 1, true);
        TK_SLOT(D[7], 2, 2, false);
        TK_SLOT(D[8], 3, 0, true);
        TK_SLOT(D[9], 3, 1, true);
        TK_SLOT(D[10], 4, 0, true);
        TK_SLOT(D[11], 5, 0, true);
        TK_SLOT(D[12], 6, 0, true);
        TK_SLOT(D[13], 7, 0, true);
        D[14] = 0u; D[15] = 0u;
#undef TK_SLOT
        tk_sort16(C); tk_sort16(D); tk_top16_merge(C, D); tk_pair_merge(C);
        LDS_WAIT(); asm volatile("" ::: "memory");
        float best[16], e[16], sum = 0.f;
#pragma unroll
        for (int q = 0; q < 16; ++q) { best[q] = key_dec((C[q] & ~255u) | 128u); e[q] = __expf(best[q] - best[0]); sum += e[q]; }
        const float inv = __builtin_amdgcn_rcpf(sum);
        int* IDX = (int*)(P.ws + WS_IDX) + (size_t)grow * 16 + 8 * hf; float* GW = (float*)(P.ws + WS_GW) + (size_t)grow * 16 + 8 * hf;
#pragma unroll
        for (int q = 0; q < 8; ++q) {
            const unsigned c = (C[q] & evenmask) | (C[8 + q] & ~evenmask);
            const float ev = __builtin_bit_cast(float, (__builtin_bit_cast(unsigned, e[q]) & evenmask) | (__builtin_bit_cast(unsigned, e[8 + q]) & ~evenmask));
            const unsigned pos = 255u - (c & 255u);
            IDX[q] = il[pos >> 4] * 128 + il[16 + (pos & 15u)]; GW[q] = ev * inv;
        }
    }
    LDS_WAIT(); asm volatile("" ::: "memory");
}

__device__ __forceinline__ void peer_topk_wave(const Params& P, LAS int* ilw, LAS unsigned* oute, LAS float* outg, int tbase, int lane) {
    const unsigned char* ws = P.ws;
    typedef _Float16 f16x8 __attribute__((ext_vector_type(8)));
    const int rl = lane >> 1, hf = lane & 1, t = tbase + (rl >> 3), h = rl & 7;
    const _Float16* SC = (const _Float16*)(ws + WS_PQ) + (size_t)t * 2048 + h * 256 + 64 * hf;
    f16x8 raw[2][8];
#pragma unroll
    for (int p = 0; p < 2; ++p)
#pragma unroll
        for (int q = 0; q < 8; ++q) raw[p][q] = *(const f16x8*)(SC + p * 128 + 8 * q);
    unsigned L1[16], L2[16];
#pragma unroll
    for (int p = 0; p < 2; ++p) {
        unsigned L[16];
#pragma unroll
        for (int grp = 0; grp < 4; ++grp) {
            unsigned G[16];
#pragma unroll
            for (int e = 0; e < 16; ++e) G[e] = (key_enc((float)raw[p][2 * grp + (e >> 3)][e & 7]) & ~127u) | (unsigned)(127 - (64 * hf + 16 * grp + e));
            tk_sort16(G);
            if (grp == 0) {
#pragma unroll
                for (int i = 0; i < 16; ++i) L[i] = G[i];
            } else tk_top16_merge(L, G);
        }
        tk_pair_merge(L);
#pragma unroll
        for (int i = 0; i < 16; ++i) { if (p == 0) L1[i] = L[i]; else L2[i] = L[i]; }
    }
    {
        float v1[16], v2[16];
        LAS int* il = ilw + rl * 33;
#pragma unroll
        for (int q = 0; q < 16; ++q) { v1[q] = key_dec((L1[q] & ~127u) | 64u); v2[q] = key_dec((L2[q] & ~127u) | 64u); }
        if (hf == 0) {
#pragma unroll
            for (int q = 0; q < 16; ++q) { il[q] = 127 - (int)(L1[q] & 127u); il[16 + q] = 127 - (int)(L2[q] & 127u); }
        }
        unsigned C[16], D[16];
        float w1[8];
        const unsigned hf16 = (unsigned)hf * 16u, evenmask = (unsigned)hf - 1u;
#pragma unroll
        for (int k = 0; k < 8; ++k) w1[k] = __builtin_bit_cast(float, (__builtin_bit_cast(unsigned, v1[2 * k]) & evenmask) | (__builtin_bit_cast(unsigned, v1[2 * k + 1]) & ~evenmask));
#define TK_SLOT(dst, k, bq, valid_odd) do { const unsigned pos_ = (unsigned)(16 * (2 * (k)) + (bq)) + hf16; unsigned kv_ = (key_enc(w1[k] + v2[bq]) & ~255u) | (255u - pos_); if (!(valid_odd)) kv_ &= evenmask; dst = kv_; } while (0)
        TK_SLOT(C[0], 0, 0, true);
        TK_SLOT(C[1], 0, 1, true);
        TK_SLOT(C[2], 0, 2, true);
        TK_SLOT(C[3], 0, 3, true);
        TK_SLOT(C[4], 0, 4, true);
        TK_SLOT(C[5], 0, 5, true);
        TK_SLOT(C[6], 0, 6, true);
        TK_SLOT(C[7], 0, 7, true);
        TK_SLOT(C[8], 0, 8, false);
        TK_SLOT(C[9], 0, 9, false);
        TK_SLOT(C[10], 0, 10, false);
        TK_SLOT(C[11], 0, 11, false);
        TK_SLOT(C[12], 0, 12, false);
        TK_SLOT(C[13], 0, 13, false);
        TK_SLOT(C[14], 0, 14, false);
        TK_SLOT(C[15], 0, 15, false);
        TK_SLOT(D[0], 1, 0, true);
        TK_SLOT(D[1], 1, 1, true);
        TK_SLOT(D[2], 1, 2, true);
        TK_SLOT(D[3], 1, 3, true);
        TK_SLOT(D[4], 1, 4, false);
        TK_SLOT(D[5], 2, 0, true);
        TK_SLOT(D[6], 2, 1, true);
        TK_SLOT(D[7], 2, 2, false);
        TK_SLOT(D[8], 3, 0, true);
        TK_SLOT(D[9], 3, 1, true);
        TK_SLOT(D[10], 4, 0, true);
        TK_SLOT(D[11], 5, 0, true);
        TK_SLOT(D[12], 6, 0, true);
        TK_SLOT(D[13], 7, 0, true);
        D[14] = 0u; D[15] = 0u;
#undef TK_SLOT
        tk_sort16(C); tk_sort16(D); tk_top16_merge(C, D); tk_pair_merge(C);
        LDS_WAIT(); asm volatile("" ::: "memory");
        float best[16], e[16], sum = 0.f;
#pragma unroll
        for (int q = 0; q < 16; ++q) { best[q] = key_dec((C[q] & ~255u) | 128u); e[q] = __expf(best[q] - best[0]); sum += e[q]; }
        const float inv = __builtin_amdgcn_rcpf(sum);
        LAS unsigned* IDX = oute + rl * 16 + 8 * hf; LAS float* GW = outg + rl * 16 + 8 * hf;
#pragma unroll
        for (int q = 0; q < 8; ++q) {
            const unsigned c = (C[q] & evenmask) | (C[8 + q] & ~evenmask);
            const float ev = __builtin_bit_cast(float, (__builtin_bit_cast(unsigned, e[q]) & evenmask) | (__builtin_bit_cast(unsigned, e[8 + q]) & ~evenmask));
            const unsigned pos = 255u - (c & 255u);
            IDX[q] = (unsigned)(il[pos >> 4] * 128 + il[16 + (pos & 15u)]); GW[q] = ev * inv;
        }
    }
    LDS_WAIT(); asm volatile("" ::: "memory");
}

typedef float f32x2 __attribute__((ext_vector_type(2)));
__device__ __forceinline__ unsigned q8(float x) { return (unsigned)(int)rintf(x) & 0xffu; }
__device__ __forceinline__ void cvt_table_fp8(const float* src, unsigned char* dst, float* scl, int gw, int ngw, int lane) {
    for (int row = gw; row < 16384; row += ngw) {
        const f32x4* sp = (const f32x4*)(src + (size_t)row * 1024 + 16 * lane);
        const f32x4 a0 = sp[0], a1 = sp[1], a2 = sp[2], a3 = sp[3];
        float m = fmaxf(fmaxf(fmaxf(fabsf(a0.x), fabsf(a0.y)), fmaxf(fabsf(a0.z), fabsf(a0.w))), fmaxf(fmaxf(fabsf(a1.x), fabsf(a1.y)), fmaxf(fabsf(a1.z), fabsf(a1.w))));
        m = fmaxf(m, fmaxf(fmaxf(fmaxf(fabsf(a2.x), fabsf(a2.y)), fmaxf(fabsf(a2.z), fabsf(a2.w))), fmaxf(fmaxf(fabsf(a3.x), fabsf(a3.y)), fmaxf(fabsf(a3.z), fabsf(a3.w)))));
#pragma unroll
        for (int o = 1; o < 64; o <<= 1) m = fmaxf(m, __shfl_xor(m, o));
        m = fmaxf(m, 1e-30f);
        const float q = 127.0f / m;
        v4u o;
        o.x = q8(a0.x * q) | (q8(a0.y * q) << 8) | (q8(a0.z * q) << 16) | (q8(a0.w * q) << 24);
        o.y = q8(a1.x * q) | (q8(a1.y * q) << 8) | (q8(a1.z * q) << 16) | (q8(a1.w * q) << 24);
        o.z = q8(a2.x * q) | (q8(a2.y * q) << 8) | (q8(a2.z * q) << 16) | (q8(a2.w * q) << 24);
        o.w = q8(a3.x * q) | (q8(a3.y * q) << 8) | (q8(a3.z * q) << 16) | (q8(a3.w * q) << 24);
        *(v4u*)(dst + (size_t)row * 1024 + 16 * lane) = o;
        if (lane == 0) scl[row] = m * (1.0f / 127.0f);
    }
}
__device__ __forceinline__ int row16_sum_i(int v) {
    v += __builtin_amdgcn_update_dpp(0, v, 0xB1, 0xF, 0xF, true);
    v += __builtin_amdgcn_update_dpp(0, v, 0x4E, 0xF, 0xF, true);
    v += __builtin_amdgcn_update_dpp(0, v, 0x141, 0xF, 0xF, true);
    v += __builtin_amdgcn_update_dpp(0, v, 0x140, 0xF, 0xF, true);
    return v;
}
constexpr int PE_NT = 4, PE_NR = 16, PE_SH = 10, PE_DEP = 3;
constexpr int PE_TOK_W = 128 * 3 + 20;
constexpr int PE_ENT_W = 272 * 4;
constexpr int PE_WAVE_W = PE_NT * PE_TOK_W + PE_ENT_W + 32 * 33 + 2 * PE_NT * 128;
static_assert(8 * PE_WAVE_W * 4 <= MISC_OFF && PE_NR * PE_NT == 64, "peer LDS / batch-list geometry");
#define PE_LD(dst, voff_, sbase_) asm volatile("s_nop 4\n\tglobal_load_dwordx4 %0, %1, %2" : "=&v"(dst) : "v"(voff_), "s"(sbase_) : "memory")
__device__ __forceinline__ void peer_pass(const Params& P, LAS unsigned char* lds, int tbase, int lane, int wave, float* dstbase, int emask = 0x3fff) {
    asm volatile("v_mbcnt_lo_u32_b32 %0, -1, 0\n\tv_mbcnt_hi_u32_b32 %0, -1, %0" : "=v"(lane));
    {
        LAS unsigned* lw0 = (LAS unsigned*)(lds) + wave * PE_WAVE_W + PE_NT * PE_TOK_W + PE_ENT_W;
        peer_topk_wave(P, (LAS int*)lw0, lw0 + 32 * 33, (LAS float*)(lw0 + 32 * 33 + PE_NT * 128), tbase, lane);
        LDS_WAIT(); asm volatile("" : "+v"(lane), "+s"(tbase) :: "memory");
    }
    const unsigned char* ws = P.ws;
    const unsigned char* UB8 = ws + WS_UB; const unsigned char* VB8 = ws + WS_VB;
    const float* USC = (const float*)(ws + WS_USC); const float* VSC = (const float*)(ws + WS_VSC);
    f32x2 acc[PE_NT][8];
    LAS unsigned* lw = (LAS unsigned*)(lds) + wave * PE_WAVE_W;
    LAS unsigned* ents = lw + PE_NT * PE_TOK_W;
    const unsigned voff = (unsigned)lane * 16u;
    LAS unsigned* upe = ents + PE_ENT_W + 32 * 33; LAS float* upg = (LAS float*)(upe + PE_NT * 128);
    LAS unsigned* hql = ents + PE_ENT_W;
#pragma unroll
    for (int j = 0; j < PE_NT; ++j) {
        const int t = tbase + j;
        const v4u* xrow = (const v4u*)((const bf16*)(ws + WS_XB) + (size_t)t * 1024 + 16 * lane);
        const v4u xa = xrow[0], xc = xrow[1];
        const f32x4 xvv[4] = {(f32x4){bflo(xa.x), bfhi(xa.x), bflo(xa.y), bfhi(xa.y)}, (f32x4){bflo(xa.z), bfhi(xa.z), bflo(xa.w), bfhi(xa.w)},
                              (f32x4){bflo(xc.x), bfhi(xc.x), bflo(xc.y), bfhi(xc.y)}, (f32x4){bflo(xc.z), bfhi(xc.z), bflo(xc.w), bfhi(xc.w)}};
        const float rstd2 = rsqrtf(((const float*)(ws + WS_SSQ2))[t] * (1.0f / 1024.0f) + 1e-6f);
        f32x4 hv[4]; float hm = 0.f;
#pragma unroll
        for (int i = 0; i < 4; ++i) { const f32x4 xv = xvv[i]; const f32x4 w = ((const f32x4*)(P.norm_ffn_w + 16 * lane))[i];
            hv[i] = (f32x4){xv.x * rstd2 * w.x, xv.y * rstd2 * w.y, xv.z * rstd2 * w.z, xv.w * rstd2 * w.w};
            hm = fmaxf(hm, fmaxf(fmaxf(fabsf(hv[i].x), fabsf(hv[i].y)), fmaxf(fabsf(hv[i].z), fabsf(hv[i].w)))); }
#pragma unroll
        for (int o = 1; o < 64; o <<= 1) hm = fmaxf(hm, __shfl_xor(hm, o));
        hm = fmaxf(hm, 1e-30f);
        const float hqs = 127.0f / hm, hs = hm * (1.0f / 127.0f);
        { unsigned hqv[4];
#pragma unroll
          for (int i = 0; i < 4; ++i) hqv[i] = q8(hv[i].x * hqs) | (q8(hv[i].y * hqs) << 8) | (q8(hv[i].z * hqs) << 16) | (q8(hv[i].w * hqs) << 24);
          *(LAS v4u*)(hql + (j * 64 + lane) * 4) = (v4u){hqv[0], hqv[1], hqv[2], hqv[3]}; }
#pragma unroll
        for (int i = 0; i < 8; ++i) acc[j][i] = (f32x2){0.f, 0.f};
        const int e0 = (int)upe[j * 128 + 2 * lane] & emask, e1 = (int)upe[j * 128 + 2 * lane + 1] & emask;
        const float g0 = upg[j * 128 + 2 * lane] * VSC[e0], g1 = upg[j * 128 + 2 * lane + 1] * VSC[e1];
        const float u0 = USC[e0] * hs, u1 = USC[e1] * hs;
        const int rev = (tbase >= T / 2) ? (PE_NR - 1) : 0;
        const int b0 = (e0 >> PE_SH) ^ rev, b1 = (e1 >> PE_SH) ^ rev;
        LAS unsigned* lt = lw + j * PE_TOK_W;
        int run = 0;
#pragma unroll 1
        for (int bk = 0; bk < PE_NR; ++bk) {
            const unsigned long long m0 = __ballot(b0 == bk), m1 = __ballot(b1 == bk);
            const int c0 = __popcll(m0), c1 = __popcll(m1);
            const unsigned long long lower = (1ull << lane) - 1ull;
            if (b0 == bk) { const int p = run + __popcll(m0 & lower); lt[p] = (unsigned)e0; lt[128 + p] = __builtin_bit_cast(unsigned, g0); lt[256 + p] = __builtin_bit_cast(unsigned, u0); }
            if (b1 == bk) { const int p = run + c0 + __popcll(m1 & lower); lt[p] = (unsigned)e1; lt[128 + p] = __builtin_bit_cast(unsigned, g1); lt[256 + p] = __builtin_bit_cast(unsigned, u1); }
            if (lane == 0) lt[384 + bk] = (unsigned)run;
            run += c0 + c1;
        }
        if (lane == 0) lt[384 + PE_NR] = 128u;
        asm volatile("" ::: "memory");
    }
    LDS_WAIT(); asm volatile("" ::: "memory");
    int nb;
    {
        const int rd = lane >> 2, j = lane & 3;
        const LAS unsigned* lt = lw + j * PE_TOK_W;
        const int n0 = (int)lt[384 + rd], n1 = (int)lt[384 + rd + 1];
        const int nbl = (n1 - n0 + 3) >> 2;
        int inc = nbl;
#pragma unroll
        for (int off = 1; off < 64; off <<= 1) { const int tv = __shfl_up(inc, off); if (lane >= off) inc += tv; }
        nb = __builtin_amdgcn_readlane(inc, 63);
        const int ofs = inc - nbl;
#pragma unroll 1
        for (int q = 0; q < nbl; ++q) { const int i0 = n0 + 4 * q, c = (n1 - i0) < 4 ? (n1 - i0) : 4;
            const unsigned e0 = lt[i0], e1 = lt[i0 + (c > 1 ? 1 : c - 1)], e2 = lt[i0 + (c > 2 ? 2 : c - 1)], e3 = lt[i0 + (c > 3 ? 3 : c - 1)];
            *(LAS v4u*)(ents + 4 * (ofs + q)) = (v4u){e0 | (((unsigned)j | ((unsigned)c << 2) | ((unsigned)i0 << 5)) << 14), e1, e2, e3}; }
        if (lane < 2 * PE_DEP) *(LAS v4u*)(ents + 4 * (nb + lane)) = (v4u){0u, 0u, 0u, 0u};
    }
    LDS_WAIT(); asm volatile("" ::: "memory");
    v4u ru[PE_DEP][4], rv[PE_DEP][4];
#define PE_LDO(dst, vo_, sbase_) asm volatile("global_load_dwordx4 %0, %1, %2" : "=&v"(dst) : "v"(vo_), "s"(sbase_) : "memory")
#define PE_ISSUE(S, rec_) do { const unsigned e0_ = (rec_).x & 0x3fffu; \
        { const unsigned vo_ = (e0_ << 10) + voff; PE_LDO(ru[S][0], vo_, UB8); PE_LDO(rv[S][0], vo_, VB8); } \
        { const unsigned vo_ = ((rec_).y << 10) + voff; PE_LDO(ru[S][1], vo_, UB8); PE_LDO(rv[S][1], vo_, VB8); } \
        { const unsigned vo_ = ((rec_).z << 10) + voff; PE_LDO(ru[S][2], vo_, UB8); PE_LDO(rv[S][2], vo_, VB8); } \
        { const unsigned vo_ = ((rec_).w << 10) + voff; PE_LDO(ru[S][3], vo_, UB8); PE_LDO(rv[S][3], vo_, VB8); } } while (0)
#define PE_WAIT8(S, cntstr) asm volatile("s_waitcnt " cntstr : "+v"(ru[S][0]), "+v"(ru[S][1]), "+v"(ru[S][2]), "+v"(ru[S][3]), "+v"(rv[S][0]), "+v"(rv[S][1]), "+v"(rv[S][2]), "+v"(rv[S][3]) :: "memory")
#define PE_UDOTS(S) asm("v_dot4_i32_i8 %0, %4, %20, 0\n\tv_dot4_i32_i8 %1, %8, %20, 0\n\tv_dot4_i32_i8 %2, %12, %20, 0\n\tv_dot4_i32_i8 %3, %16, %20, 0\n\t" \
                        "v_dot4_i32_i8 %0, %5, %21, %0\n\tv_dot4_i32_i8 %1, %9, %21, %1\n\tv_dot4_i32_i8 %2, %13, %21, %2\n\tv_dot4_i32_i8 %3, %17, %21, %3\n\t" \
                        "v_dot4_i32_i8 %0, %6, %22, %0\n\tv_dot4_i32_i8 %1, %10, %22, %1\n\tv_dot4_i32_i8 %2, %14, %22, %2\n\tv_dot4_i32_i8 %3, %18, %22, %3\n\t" \
                        "v_dot4_i32_i8 %0, %7, %23, %0\n\tv_dot4_i32_i8 %1, %11, %23, %1\n\tv_dot4_i32_i8 %2, %15, %23, %2\n\tv_dot4_i32_i8 %3, %19, %23, %3\n\ts_nop 2" \
        : "=&v"(d_[0]), "=&v"(d_[1]), "=&v"(d_[2]), "=&v"(d_[3]) \
        : "v"(ru[S][0].x), "v"(ru[S][0].y), "v"(ru[S][0].z), "v"(ru[S][0].w), "v"(ru[S][1].x), "v"(ru[S][1].y), "v"(ru[S][1].z), "v"(ru[S][1].w), \
          "v"(ru[S][2].x), "v"(ru[S][2].y), "v"(ru[S][2].z), "v"(ru[S][2].w), "v"(ru[S][3].x), "v"(ru[S][3].y), "v"(ru[S][3].z), "v"(ru[S][3].w), \
          "v"(hcur.x), "v"(hcur.y), "v"(hcur.z), "v"(hcur.w))
#define PE_UDOTS_SAFE(S) do { _Pragma("unroll") for (int k_ = 0; k_ < 4; ++k_) { int s_ = __builtin_amdgcn_sdot4((int)ru[S][k_].x, (int)hcur.x, 0, false); s_ = __builtin_amdgcn_sdot4((int)ru[S][k_].y, (int)hcur.y, s_, false); \
            s_ = __builtin_amdgcn_sdot4((int)ru[S][k_].z, (int)hcur.z, s_, false); s_ = __builtin_amdgcn_sdot4((int)ru[S][k_].w, (int)hcur.w, s_, false); d_[k_] = s_; } } while (0)
#define PE_VDOTS_SAFE(f0, f1, f2, f3, b0, b1, b2, b3, w) do { f0 = (float)__builtin_amdgcn_sdot4((int)(b0), (int)(w), 0, false); f1 = (float)__builtin_amdgcn_sdot4((int)(b1), (int)(w), 0, false); \
            f2 = (float)__builtin_amdgcn_sdot4((int)(b2), (int)(w), 0, false); f3 = (float)__builtin_amdgcn_sdot4((int)(b3), (int)(w), 0, false); } while (0)
#define PE_VDOTS(f0, f1, f2, f3, b0, b1, b2, b3, w) asm("v_dot4_i32_i8 %0, %4, %8, 0\n\tv_dot4_i32_i8 %1, %5, %8, 0\n\tv_dot4_i32_i8 %2, %6, %8, 0\n\tv_dot4_i32_i8 %3, %7, %8, 0\n\t" \
                        "v_cvt_f32_i32_e32 %0, %0\n\tv_cvt_f32_i32_e32 %1, %1\n\tv_cvt_f32_i32_e32 %2, %2\n\tv_cvt_f32_i32_e32 %3, %3" \
        : "=&v"(f0), "=&v"(f1), "=&v"(f2), "=&v"(f3) : "v"(b0), "v"(b1), "v"(b2), "v"(b3), "v"(w))
#define PE_COMPUTE_B(S, c_, i_, j_, SG) do { const LAS unsigned* lt_ = lw + (j_) * PE_TOK_W; \
        const int myk_ = lane >> 4; \
        float gsc_ = __builtin_bit_cast(float, lt_[128 + i_ + myk_]), usc_ = __builtin_bit_cast(float, lt_[256 + i_ + myk_]);     \
        int d_[4]; \
        PE_UDOTS(S); \
        int r1_; \
        { const v2u p02_ = __builtin_amdgcn_permlane32_swap((unsigned)d_[0], (unsigned)d_[2], false, false), p13_ = __builtin_amdgcn_permlane32_swap((unsigned)d_[1], (unsigned)d_[3], false, false); \
          const v2u q_ = __builtin_amdgcn_permlane16_swap(p02_.x + p02_.y, p13_.x + p13_.y, false, false); r1_ = row16_sum_i((int)(q_.x + q_.y)); }     \
        float act_; \
        { const float x_ = (float)r1_ * usc_, e_ = __builtin_amdgcn_exp2f(x_ * __builtin_fmaf(x_ * x_, -0.10294324f, -2.3022082f));     \
          act_ = x_ * __builtin_amdgcn_rcpf(1.0f + e_) * gsc_; act_ = (myk_ < c_) ? act_ : 0.f; } \
        float wm_; \
        { unsigned wmu_ = __builtin_bit_cast(unsigned, act_) & 0x7fffffffu;                 \
          v2u t_ = __builtin_amdgcn_permlane32_swap(wmu_, wmu_, false, false); wmu_ = t_.x > t_.y ? t_.x : t_.y; \
          t_ = __builtin_amdgcn_permlane16_swap(wmu_, wmu_, false, false); wmu_ = t_.x > t_.y ? t_.x : t_.y; \
          wm_ = fmaxf(__builtin_bit_cast(float, wmu_), 1e-30f); } \
        const float wq_ = 127.0f * __builtin_amdgcn_rcpf(wm_), ws_ = (SG) * wm_ * (1.0f / 127.0f); \
        unsigned w4u_ = (__builtin_bit_cast(unsigned, __builtin_fmaf(act_, wq_, 12582912.0f)) & 0xffu) << (8 * myk_); \
        { v2u t_ = __builtin_amdgcn_permlane32_swap(w4u_, w4u_, false, false); w4u_ = t_.x | t_.y; t_ = __builtin_amdgcn_permlane16_swap(w4u_, w4u_, false, false); w4u_ = t_.x | t_.y; } \
        const f32x2 ws2_ = (f32x2){ws_, ws_}; \
        _Pragma("unroll") for (int m_ = 0; m_ < 4; ++m_) { \
            const unsigned R0_ = rv[S][0][m_], R1_ = rv[S][1][m_], R2_ = rv[S][2][m_], R3_ = rv[S][3][m_]; \
            const unsigned X_ = __builtin_amdgcn_perm(R1_, R0_, 0x05010400u), Y_ = __builtin_amdgcn_perm(R1_, R0_, 0x07030602u), Z_ = __builtin_amdgcn_perm(R3_, R2_, 0x05010400u), W_ = __builtin_amdgcn_perm(R3_, R2_, 0x07030602u); \
            float t0_, t1_, t2_, t3_; \
            const unsigned b0_ = __builtin_amdgcn_perm(Z_, X_, 0x05040100u), b1_ = __builtin_amdgcn_perm(Z_, X_, 0x07060302u), b2_ = __builtin_amdgcn_perm(W_, Y_, 0x05040100u), b3_ = __builtin_amdgcn_perm(W_, Y_, 0x07060302u); \
            PE_VDOTS(t0_, t1_, t2_, t3_, b0_, b1_, b2_, b3_, w4u_); \
            cur[2 * m_] = __builtin_elementwise_fma((f32x2){t0_, t1_}, ws2_, cur[2 * m_]); \
            cur[2 * m_ + 1] = __builtin_elementwise_fma((f32x2){t2_, t3_}, ws2_, cur[2 * m_ + 1]); } } while (0)
#define PE_FLUSH() do { _Pragma("unroll") for (int J_ = 0; J_ < PE_NT; ++J_) { const float sel_ = (jcur == J_) ? 1.0f : 0.0f; const f32x2 sel2_ = (f32x2){sel_, sel_};     \
            _Pragma("unroll") for (int i_ = 0; i_ < 8; ++i_) acc[J_][i_] = __builtin_elementwise_fma(cur[i_], sel2_, acc[J_][i_]); } \
        _Pragma("unroll") for (int i_ = 0; i_ < 8; ++i_) cur[i_] = (f32x2){0.f, 0.f}; } while (0)
#define PE_COMPUTE_S(S, entv, SG) do { const unsigned en_ = (entv) >> 14; const int jj_ = (int)(en_ & 3u), cc_ = (int)((en_ >> 2) & 7u), ii_ = (int)(en_ >> 5); \
        if (cc_ > 0) { if (jj_ != jcur) { PE_FLUSH(); jcur = jj_; hcur = *(const LAS v4u*)(hql + (jj_ * 64 + lane) * 4); } \
                       PE_COMPUTE_B(S, cc_, ii_, jj_, SG); } } while (0)
#ifdef PE_VALU3
#define PE_COMPUTE(S, entv) do { PE_COMPUTE_S(S, entv, 1.0f); PE_WAIT8(S, "vmcnt(16)"); PE_COMPUTE_S(S, entv, -1.0f); PE_WAIT8(S, "vmcnt(16)"); PE_COMPUTE_S(S, entv, 1.0f); } while (0)
#else
#define PE_COMPUTE(S, entv) PE_COMPUTE_S(S, entv, 1.0f)
#endif
    {
        unsigned er[PE_DEP];
#pragma unroll
        for (int q = 0; q < PE_DEP; ++q) { const v4u rec = *(const LAS v4u*)(ents + 4 * q); er[q] = __builtin_amdgcn_readfirstlane(rec.x); PE_ISSUE(q, rec); }
        f32x2 cur[8];
#pragma unroll
        for (int i = 0; i < 8; ++i) cur[i] = (f32x2){0.f, 0.f};
        int jcur = (int)((er[0] >> 14) & 3u);
        v4u hcur = *(const LAS v4u*)(hql + (jcur * 64 + lane) * 4);
#pragma unroll 1
        for (int bi = 0; bi < nb; bi += PE_DEP) {
#pragma unroll
            for (int q = 0; q < PE_DEP; ++q) {
                PE_WAIT8(q, "vmcnt(16)");
                const v4u nrec = *(const LAS v4u*)(ents + 4 * (bi + q + PE_DEP));
                PE_COMPUTE(q, er[q]);
                er[q] = __builtin_amdgcn_readfirstlane(nrec.x);
                PE_ISSUE(q, nrec);
            }
        }
#pragma unroll
        for (int q = 0; q < PE_DEP; ++q) PE_WAIT8(q, "vmcnt(0)");
        PE_FLUSH();
    }
#undef PE_COMPUTE
#undef PE_COMPUTE_S
#undef PE_COMPUTE_B
#undef PE_FLUSH
#undef PE_WAIT8
#undef PE_ISSUE
#undef PE_LDO
#undef PE_UDOTS
#undef PE_VDOTS
    asm volatile("v_mbcnt_lo_u32_b32 %0, -1, 0\n\tv_mbcnt_hi_u32_b32 %0, -1, %0" : "=v"(lane)); asm volatile("" : "+s"(tbase));
#pragma unroll
    for (int j = 0; j < PE_NT; ++j) {
        const int t = tbase + j;
        float ss = 0.f; f32x4 xo[4];
        { const v4u* xrow = (const v4u*)((const bf16*)(ws + WS_XB) + (size_t)t * 1024 + 16 * lane); const v4u xa = xrow[0], xc = xrow[1];
          xo[0] = (f32x4){bflo(xa.x), bfhi(xa.x), bflo(xa.y), bfhi(xa.y)}; xo[1] = (f32x4){bflo(xa.z), bfhi(xa.z), bflo(xa.w), bfhi(xa.w)};
          xo[2] = (f32x4){bflo(xc.x), bfhi(xc.x), bflo(xc.y), bfhi(xc.y)}; xo[3] = (f32x4){bflo(xc.z), bfhi(xc.z), bflo(xc.w), bfhi(xc.w)}; }
#pragma unroll
        for (int i = 0; i < 4; ++i) { xo[i].x += acc[j][2 * i].x; xo[i].y += acc[j][2 * i].y; xo[i].z += acc[j][2 * i + 1].x; xo[i].w += acc[j][2 * i + 1].y;
            ss += (xo[i].x * xo[i].x + xo[i].y * xo[i].y) + (xo[i].z * xo[i].z + xo[i].w * xo[i].w); }
        const float rstd3 = rsqrtf(wave_sum(ss) * (1.0f / 1024.0f) + 1e-6f);
        float* orow = dstbase + (size_t)t * 1024 + 16 * lane;
#pragma unroll
        for (int i = 0; i < 4; ++i) { const f32x4 w = ((const f32x4*)(P.norm_final_w + 16 * lane))[i];
            ((f32x4*)orow)[i] = (f32x4){xo[i].x * rstd3 * w.x, xo[i].y * rstd3 * w.y, xo[i].z * rstd3 * w.z, xo[i].w * rstd3 * w.w}; }
    }
    LDS_WAIT(); asm volatile("s_waitcnt vmcnt(0)" ::: "memory");
}


#ifndef TWICE_MASK
#define TWICE_MASK 0
#endif
struct TwiceOrder { pg8::StaticOrder S; int per, reps;
    __device__ bool next(int i, pg8::Unit& u) const { if (i >= per * reps) return false; return S.next(i % per, u); }
    __device__ __forceinline__ void a_ready(const pg8::Unit&) const {} __device__ __forceinline__ void done(const pg8::Unit&) const {} };
template <class B> __device__ __forceinline__ bool rep_again(volatile LAS unsigned* MISC, B& bar) {
    __syncthreads(); const unsigned c = MISC[20]; __syncthreads();
    if (threadIdx.x == 0) MISC[20] = c ^ 1u;
    __syncthreads();
    if (c == 0u) { xcd_barrier(bar); return true; }
    return false;
}
__global__ void __launch_bounds__(NWAVES * 64, 2) hybrid_fwd(Params P) {
    extern __shared__ __attribute__((aligned(16))) unsigned char lds_raw[];
    LAS unsigned char* lds = (LAS unsigned char*)lds_raw;
    volatile LAS unsigned* MISC = (volatile LAS unsigned*)(lds + MISC_OFF);
    const int tid = threadIdx.x, lane = tid & 63, wave = __builtin_amdgcn_readfirstlane(tid >> 6);
    const int G = gridDim.x, bx = blockIdx.x;
    const int vcu = (G % 8 == 0) ? (bx % 8) * (G / 8) + bx / 8 : bx;
    unsigned char* ws = P.ws;
    for (int u = tid; u < 64; u += NWAVES * 64) MISC[u] = 0u;
    __syncthreads();
    XcdBarrier bar; bar.bar = (unsigned*)(ws + WS_CTL) + CW_BAR; bar.x = 0; bar.st = nullptr;
    if (!MK_PER_PHASE) bar = xcd_barrier_post((unsigned*)(ws + WS_CTL) + CW_BAR, MISC + 8);
    const int lo = P.ph_lo, hi = P.ph_hi;
#ifndef PHASE_MASK
#define PHASE_MASK 0xFFF
#endif
#define IN(k) (((PHASE_MASK >> (k)) & 1) && lo <= (k) && (k) < hi)
#define SEAM(k) do { if (IN(k) && IN((k) + 1)) xcd_barrier(bar); } while (0)
#ifndef REP_MASK
#define REP_MASK 0
#endif
#ifndef PE_EXP_MASK
#define PE_EXP_MASK 0x3fff
#endif
#define REPS(k) for (bool again_ = true; again_; again_ = (((REP_MASK >> (k)) & 1) ? rep_again(MISC, bar) : false))
    using namespace pg8;
    bf16* XB = (bf16*)(ws + WS_XB);

    if (IN(0)) REPS(0) { p0_prologue(P, lds, tid, lane, wave, vcu, G); }
    SEAM(0);
    if (IN(1)) REPS(1) {
        { Gemm gm{XB, (const bf16_t*)(ws + WS_WIN), T, 3072, 1024}; StaticOrder S; S.init(T, 3072, G, bx);
          EpiBf16Rs E{(bf16_t*)(ws + WS_QKV), 1536, 6, (bf16_t*)(ws + WS_XR), 512, (size_t)T * 512, nullptr, 1.0f};
          gemm_phase<EpiBf16Rs, StaticOrder, PG8_ALIGN, PG8_SP2>(lds, gm, S, E); }
    }
    SEAM(1);
    if (IN(3)) REPS(3) {
        if (bx < SCAN_WGS) gdn_scan(P, lds, bx, tid, lane, wave);
        else {
            const int wk = bx - SCAN_WGS, NWK = G - SCAN_WGS;
            unsigned* lcnt = (unsigned*)(ws + WS_CTL) + CW_LRUCNT;
            for (int q = wk; q < 1024; q += NWK) gdn_local_item(P, lds, (q & 7) * 128 + (q >> 3), tid);
            if (wk < 16) {
                struct OneUnit { int pm, pn; __device__ bool next(int i, Unit& u) const { if (i > 0) return false; u.pm = pm; u.pn = pn; return true; }
                                 __device__ void a_ready(const Unit&) const {} __device__ void done(const Unit&) const {} };
                Gemm gm{(const bf16_t*)(ws + WS_MEMN), (const bf16_t*)(ws + WS_WKV), 512, 2048, 1024}; OneUnit S{wk >> 3, wk & 7};
                EpiKV E{(bf16_t*)(ws + WS_KB), (bf16_t*)(ws + WS_VTP)};
                gemm_phase<EpiKV, OneUnit, PG8_ALIGN, PG8_SP2>(lds, gm, S, E);
            }
            unsigned ndone = 0;
            for (int lt = wk; lt < 256; lt += NWK) { lru_local_item(P, lds, lt, tid, lane, wave); ++ndone; }
            asm volatile("s_waitcnt vmcnt(0)" ::: "memory");
            __syncthreads();
            if (tid == 0 && ndone) { __builtin_amdgcn_fence(__ATOMIC_RELEASE, "agent"); asm volatile("s_waitcnt vmcnt(0)" ::: "memory");
                                     __hip_atomic_fetch_add(lcnt, ndone, __ATOMIC_RELAXED, __HIP_MEMORY_SCOPE_AGENT); }
            if (wk == 16 || wk == 17) {
                if (tid == 0) { unsigned sp = 0;
                    while (__hip_atomic_load(lcnt, __ATOMIC_RELAXED, __HIP_MEMORY_SCOPE_AGENT) < 256u) { __builtin_amdgcn_s_sleep(8); if (++sp > (1u << 22)) break; }
                    __builtin_amdgcn_fence(__ATOMIC_ACQUIRE, "agent"); asm volatile("s_waitcnt vmcnt(0)" ::: "memory"); }
                __syncthreads();
                lru_carry(P, (wk - 16) * NWAVES + wave, lane);
                asm volatile("s_waitcnt vmcnt(0)" ::: "memory");
                __syncthreads();
                if (tid == 0) { __builtin_amdgcn_fence(__ATOMIC_RELEASE, "agent"); asm volatile("s_waitcnt vmcnt(0)" ::: "memory");
                                __hip_atomic_fetch_add(lcnt + 64, 1u, __ATOMIC_RELAXED, __HIP_MEMORY_SCOPE_AGENT); }
            } else {
                const int w2 = (wk < 16 ? wk : wk - 2), N2 = NWK - 2;
                cvt_table_fp8(P.peer_v, ws + WS_VB, (float*)(ws + WS_VSC), w2 * NWAVES + wave, N2 * NWAVES, lane);
                late_weight_prep(P, lds, lane, wave, w2 * NWAVES + wave, N2 * NWAVES);
                if (tid == 0) { unsigned sp = 0;
                    while (__hip_atomic_load(lcnt + 64, __ATOMIC_RELAXED, __HIP_MEMORY_SCOPE_AGENT) < 2u) { __builtin_amdgcn_s_sleep(8); if (++sp > (1u << 22)) break; }
                    __builtin_amdgcn_fence(__ATOMIC_ACQUIRE, "agent"); asm volatile("s_waitcnt vmcnt(0)" ::: "memory"); }
                __syncthreads();
                lru_combine(P, (size_t)w2 * (NWAVES * 64) + tid, (size_t)N2 * (NWAVES * 64));
            }
        }
    }
    SEAM(3);
    if (IN(4)) REPS(4) {
        gdn_gate_norm(P, (size_t)bx * (NWAVES * 64) + tid, (size_t)G * (NWAVES * 64));
        cvt_table_fp8(P.peer_u, ws + WS_UB, (float*)(ws + WS_USC), bx * NWAVES + wave, G * NWAVES, lane);
    }
    SEAM(4);
    if (IN(5)) {
        Gemm gm{(const bf16_t*)((const unsigned char*)P.out + OUT_Y), (const bf16_t*)(ws + WS_WOUT), T, 1024, 1024}; StaticOrder S; S.init(T, 1024, G, bx);
        EpiResidBf<true> E{P.x, XB, (float*)(ws + WS_SSQ1)};
        gemm_phase<EpiResidBf<true>, StaticOrder, PG8_ALIGN, PG8_SP2>(lds, gm, S, E);
    }
    SEAM(5);
    if (IN(6)) REPS(6) {
        Gemm gm{XB, (const bf16_t*)(ws + WS_WQ), T, 1024, 1024};
        EpiBf16Rs E{(bf16_t*)(ws + WS_Q), 1024, 4, nullptr, 256, 0, (const float*)(ws + WS_SSQ1), 0.0625f};
#if (TWICE_MASK >> 6) & 1
        { TwiceOrder S; S.S.init(T, 1024, G, bx); S.per = 1; S.reps = 2;
          gemm_phase<EpiBf16Rs, TwiceOrder, PG8_ALIGN, PG8_SP2>(lds, gm, S, E); }
#else
        { StaticOrder S; S.init(T, 1024, G, bx);
          gemm_phase<EpiBf16Rs, StaticOrder, PG8_ALIGN, PG8_SP2>(lds, gm, S, E); }
#endif
        Unit u;
        { const int wgid = (bx & 7) * 32 + (bx >> 3); u.pm = (wgid >> 5) * 8 + (wgid & 7); u.pn = (wgid & 31) >> 3; }
        if (G == 256) {
            asm volatile("s_waitcnt vmcnt(0)" ::: "memory");
            __syncthreads();
            const int b = u.pm >> 5, qb0 = (u.pm & 31) * 2, h = u.pn;
#pragma unroll 1
            for (int qq = 0; qq < (((TWICE_MASK >> 7) & 1) ? 4 : 2); ++qq) xattn_unit(P, lds, (b << 8) | ((qb0 + (qq & 1)) << 2) | h, tid, lane, wave);
        }
    }
    if (IN(7)) REPS(7) { }
    SEAM(7);
    if (IN(8)) {
        Gemm gm{(const bf16_t*)(ws + WS_AO), (const bf16_t*)(ws + WS_WO), T, 1024, 1024}; StaticOrder S; S.init(T, 1024, G, bx);
        EpiResidBf<false> E{nullptr, XB, (float*)(ws + WS_SSQ2)};
        gemm_phase<EpiResidBf<false>, StaticOrder, PG8_ALIGN, PG8_SP2>(lds, gm, S, E);
    }
    SEAM(8);
    if (IN(9)) REPS(9) {
        Gemm gm{XB, (const bf16_t*)(ws + WS_PWQ), T, 2048, 1024};
        EpiF16Rs E{(_Float16*)(ws + WS_PQ), 2048, (const float*)(ws + WS_SSQ2)};
#if (TWICE_MASK >> 9) & 1
        TwiceOrder S; S.S.init(T, 2048, G, bx); S.per = 2; S.reps = 2;
        gemm_phase<EpiF16Rs, TwiceOrder, PG8_ALIGN, PG8_SP2>(lds, gm, S, E);
#else
        StaticOrder S; S.init(T, 2048, G, bx);
        gemm_phase<EpiF16Rs, StaticOrder, PG8_ALIGN, PG8_SP2>(lds, gm, S, E);
#endif
    }
    SEAM(9);
    if (IN(10)) REPS(10) {
    }
    if (IN(11)) REPS(11) {
#if (TWICE_MASK >> 11) & 1
        for (int it = 0; it < 4; ++it) { const int tb = (bx * NWAVES + wave) * PE_NT + (it >> 1) * (G * NWAVES * PE_NT); if (tb < T) peer_pass(P, lds, tb, lane, wave, P.out, (it & 1) ? 0x3fff : PE_EXP_MASK); }
#else
#ifndef PE_PASS_BARRIER
#define PE_PASS_BARRIER 0
#endif
        for (int tb = (bx * NWAVES + wave) * PE_NT, np = 0; tb < T; tb += G * NWAVES * PE_NT, ++np) {
            if (PE_PASS_BARRIER && np > 0 && (T % (G * NWAVES * PE_NT)) == 0) xcd_barrier(bar);
            peer_pass(P, lds, tb, lane, wave, P.out);
        }
#endif
    }
#undef IN
#undef SEAM
}

extern "C" void kernel_launch(void* const* d_in, const int* in_sizes, int n_in, void* d_out, int out_size, void* d_ws, size_t ws_size, hipStream_t stream) {
    static int grid = 0;
    if (grid == 0) {
        if (n_in != 27 || in_sizes[0] != T * D || out_size != T * D || ws_size < WS_END) {
            fprintf(stderr, "kernel_launch: unexpected shapes (n_in %d, in0 %d, out %d, ws %zu); nothing launched\n", n_in, n_in > 0 ? in_sizes[0] : -1, out_size, ws_size); grid = -1; return; }
        int dev = 0, cus = 0, per_cu = 0;
        if (hipGetDevice(&dev) != hipSuccess || hipDeviceGetAttribute(&cus, hipDeviceAttributeMultiprocessorCount, dev) != hipSuccess) { grid = -1; return; }
        if (hipFuncSetAttribute((const void*)hybrid_fwd, hipFuncAttributeMaxDynamicSharedMemorySize, LDS_BYTES) != hipSuccess) { fprintf(stderr, "kernel_launch: hipFuncSetAttribute failed\n"); grid = -1; return; }
        if (hipOccupancyMaxActiveBlocksPerMultiprocessor(&per_cu, (const void*)hybrid_fwd, NWAVES * 64, LDS_BYTES) != hipSuccess || per_cu < 1)
            fprintf(stderr, "kernel_launch: note: occupancy query reports %d workgroups per CU\n", per_cu);
        (void)hipGetLastError();
        grid = cus;
        if (grid != 256) fprintf(stderr, "kernel_launch: %d CUs (built for 256)\n", grid);
    }
    if (grid < 0) return;
    if (hipMemsetAsync((char*)d_ws + WS_CTL, 0, CTL_ZERO_BYTES, stream) != hipSuccess) { fprintf(stderr, "kernel_launch: hipMemsetAsync failed\n"); return; }
    Params p{};
    const float** pp = (const float**)&p;
    for (int i = 0; i < 27; ++i) pp[i] = (const float*)d_in[i];
    p.out = (float*)d_out; p.ws = (unsigned char*)d_ws;
#if MK_PER_PHASE
    for (int k = 0; k < N_PHASES; ++k) { p.ph_lo = k; p.ph_hi = k + 1; hipLaunchKernelGGL(hybrid_fwd, dim3(grid), dim3(NWAVES * 64), LDS_BYTES, stream, p); }
#else
    p.ph_lo = 0; p.ph_hi = N_PHASES;
    hipLaunchKernelGGL(hybrid_fwd, dim3(grid), dim3(NWAVES * 64), LDS_BYTES, stream, p);
#endif
    const hipError_t le = hipPeekAtLastError();
    if (le != hipSuccess) fprintf(stderr, "kernel_launch: launch failed: %s\n", hipGetErrorName(le));
}
```

```cpp
#include <hip/hip_runtime.h>
#include <cstdio>
#include <cstdint>
namespace pg8 {
#define PG8_LAS __attribute__((address_space(3)))
typedef unsigned short bf16_t;
typedef short bf16x8 __attribute__((ext_vector_type(8)));
typedef float f32x4 __attribute__((ext_vector_type(4)));
typedef unsigned u32x4 __attribute__((ext_vector_type(4)));
constexpr int BM = 256, BK = 64, HALF = 128, HTB = HALF * BK * 2  , STAGE_BYTES = 8 * HTB, NXCD = 8, WGM = 8;

__host__ __device__ __forceinline__ int lds_byte(int r, int c) { const int st = (r >> 4) * 2 + (c >> 5), rr = r & 15, cc = c & 31, ob = rr * 64 + cc * 2; return st * 1024 + (ob ^ (((ob >> 9) & 1) << 5)); }
__host__ __device__ __forceinline__ void stage_rc(int b, int& R, int& C) { const int st = b / 1024, sb = b % 1024, swz = sb ^ (((sb >> 9) & 1) << 5); R = (st >> 1) * 16 + swz / 64; C = (st & 1) * 32 + (swz % 64) / 2; }
__host__ __device__ __forceinline__ int perm32(int rho) { const int n = rho >> 4, i = rho & 15; return 8 * (i >> 2) + 4 * n + (i & 3); }

struct Unit { int pm, pn; };
struct Gemm { const bf16_t* A; const bf16_t* Bt; int M, N, K; };

struct StaticOrder {
    int nM, nN, nwg, G, c;
    __host__ __device__ void init(int M, int N, int G_, int c_) { nM = M / BM; nN = N / BM; nwg = nM * nN; G = G_; c = c_; }
    __host__ __device__ bool next(int i, Unit& u) const {
        const long L = (long)i * G + c; if (L >= nwg) return false;
        int wgid = (int)L; { const int q = nwg / NXCD, r = nwg % NXCD, xcd = wgid % NXCD, off = wgid / NXCD; wgid = (xcd < r ? xcd * (q + 1) : r * (q + 1) + (xcd - r) * q) + off; }
        const int nig = WGM * nN, gid = wgid / nig, fm = gid * WGM, gsz = (nM - fm) < WGM ? (nM - fm) : WGM;
        u.pm = fm + ((wgid % nig) % gsz); u.pn = (wgid % nig) / gsz; return true;
    }
    __device__ __forceinline__ void a_ready(const Unit&) const {}
    __device__ __forceinline__ void done(const Unit&) const {}
};

__device__ __forceinline__ unsigned cvt_pk_bf16(float lo, float hi) { unsigned r; asm volatile("v_cvt_pk_bf16_f32 %0, %1, %2" : "=v"(r) : "v"(lo), "v"(hi)); return r; }
template <class Epi, class Sched, bool ALIGN_EPI = false, bool SP2 = false>
__device__ __forceinline__ void gemm_phase(PG8_LAS unsigned char* lds, const Gemm g, const Sched& S, const Epi& E) {
    const int tid = threadIdx.x, wid = __builtin_amdgcn_readfirstlane(tid >> 6), lane = tid & 63, wr = wid >> 2, wc = wid & 3, fr = lane & 15, fq = lane >> 4;
    const int K = g.K, nt = K / BK;
    unsigned voffA[2], voffB[2];
#pragma unroll
    for (int i = 0; i < 2; ++i) { int R, C; stage_rc(tid * 16 + i * 8192, R, C); const int Rb = Epi::PERM ? ((R & ~31) + perm32(R & 31)) : R;
        voffA[i] = (unsigned)(R * K + C) * 2u; voffB[i] = (unsigned)(Rb * K + C) * 2u; }
    const size_t kstep = (size_t)(BK * 2);
    const size_t hstep = (size_t)HALF * K * 2;
    const size_t tstep = 2 * hstep;
    const unsigned ldsw = (unsigned)wid * 1024u;
    const int aoff = lds_byte(wr * 64 + fr, fq * 8), boff = lds_byte(wc * 32 + fr, fq * 8);
#define PG8_SA(b, h) (((b) * 2 + (h)) * HTB)
#define PG8_SB(b, h) ((4 + (b) * 2 + (h)) * HTB)
#define PG8_STAGE(bufoff, gbase, voff) do { _Pragma("unroll") for (int _i = 0; _i < 2; ++_i) \
        __builtin_amdgcn_global_load_lds((const unsigned*)((const char*)(gbase) + (voff)[_i]), (PG8_LAS unsigned*)(lds + (bufoff) + ldsw + _i * 8192), 16, 0, 0); } while (0)
#define PG8_LDA(dst, b, h) do { _Pragma("unroll") for (int m = 0; m < 4; ++m) _Pragma("unroll") for (int k = 0; k < 2; ++k) dst[m][k] = *(const PG8_LAS bf16x8*)(lds + PG8_SA(b, h) + aoff + m * 2048 + k * 1024); } while (0)
#define PG8_LDB(dst, b, h) do { _Pragma("unroll") for (int n = 0; n < 2; ++n) _Pragma("unroll") for (int k = 0; k < 2; ++k) dst[n][k] = *(const PG8_LAS bf16x8*)(lds + PG8_SB(b, h) + boff + n * 2048 + k * 1024); } while (0)
#define PG8_MMA(ai, bj, At, Bt) do { __builtin_amdgcn_s_setprio(1); _Pragma("unroll") for (int m = 0; m < 4; ++m) _Pragma("unroll") for (int n = 0; n < 2; ++n) _Pragma("unroll") for (int k = 0; k < 2; ++k) \
        acc[ai][bj][m][n] = __builtin_amdgcn_mfma_f32_16x16x32_bf16(Bt[n][k], At[m][k], acc[ai][bj][m][n], 0, 0, 0); __builtin_amdgcn_s_setprio(0); } while (0)
#define PG8_WAIT_V(n) asm volatile("s_waitcnt vmcnt(" #n ")" ::: "memory")
#define PG8_WAIT_L(n) asm volatile("s_waitcnt lgkmcnt(" #n ")" ::: "memory")
#define PG8_BAR __builtin_amdgcn_s_barrier()
#define PG8_SCHED __builtin_amdgcn_sched_barrier(0)
    Unit cur, nxt; int ui = 0;
    if (!S.next(0, cur)) return;
    f32x4 acc[2][2][4][2];
#pragma unroll
    for (int a = 0; a < 2; ++a)
#pragma unroll
        for (int b = 0; b < 2; ++b)
#pragma unroll
            for (int m = 0; m < 4; ++m)
#pragma unroll
                for (int n = 0; n < 2; ++n) acc[a][b][m][n] = (f32x4){0.f, 0.f, 0.f, 0.f};
    bf16x8 At[4][2], B0[2][2], B1[2][2];
    const char* cA = (const char*)g.A + (size_t)cur.pm * tstep; const char* cB = (const char*)g.Bt + (size_t)cur.pn * tstep;
    S.a_ready(cur);
    if constexpr (SP2) {
        PG8_STAGE(PG8_SB(0, 0), cB, voffB); PG8_STAGE(PG8_SB(0, 1), cB + hstep, voffB); PG8_STAGE(PG8_SA(0, 0), cA, voffA); PG8_STAGE(PG8_SA(0, 1), cA + hstep, voffA);
        if (wr == 1) PG8_BAR;
        PG8_WAIT_V(2); PG8_BAR;
        PG8_STAGE(PG8_SB(1, 0), cB + kstep, voffB); PG8_STAGE(PG8_SA(1, 0), cA + kstep, voffA); PG8_STAGE(PG8_SB(1, 1), cB + hstep + kstep, voffB);
        PG8_WAIT_V(6); PG8_BAR;
    } else {
        PG8_STAGE(PG8_SB(0, 0), cB, voffB); PG8_STAGE(PG8_SA(0, 0), cA, voffA); PG8_STAGE(PG8_SB(0, 1), cB + hstep, voffB); PG8_STAGE(PG8_SA(0, 1), cA + hstep, voffA);
        if (wr == 1) PG8_BAR;
        PG8_WAIT_V(4); PG8_BAR;
        PG8_STAGE(PG8_SB(1, 0), cB + kstep, voffB); PG8_STAGE(PG8_SA(1, 0), cA + kstep, voffA); PG8_STAGE(PG8_SB(1, 1), cB + hstep + kstep, voffB);
        PG8_WAIT_V(6); PG8_BAR;
    }
    for (;;) {
        const bool has_next = S.next(ui + 1, nxt);
        const char* nA = has_next ? (const char*)g.A + (size_t)nxt.pm * tstep : cA; const char* nB = has_next ? (const char*)g.Bt + (size_t)nxt.pn * tstep : cB;
        for (int t = 0; t < nt; t += 2) {
            const bool last = (t == nt - 2);
            const char* a1 = cA + (size_t)(t + 1) * kstep;
            const char* a2 = last ? nA : cA + (size_t)(t + 2) * kstep; const char* b2 = last ? nB : cB + (size_t)(t + 2) * kstep;
            const char* a3 = a2 + kstep; const char* b3 = b2 + kstep;
            if (last && has_next) S.a_ready(nxt);
            if constexpr (SP2) {
            PG8_LDB(B0, 0, 0); PG8_LDB(B1, 0, 1); PG8_SCHED; PG8_LDA(At, 0, 0); PG8_STAGE(PG8_SA(1, 1), a1 + hstep, voffA);
            PG8_WAIT_V(8); PG8_WAIT_L(0); PG8_BAR; PG8_MMA(0, 0, At, B0); PG8_MMA(0, 1, At, B1); PG8_BAR; PG8_SCHED;
            PG8_LDA(At, 0, 1); PG8_STAGE(PG8_SB(0, 0), b2, voffB); PG8_STAGE(PG8_SB(0, 1), b2 + hstep, voffB); PG8_STAGE(PG8_SA(0, 0), a2, voffA);
            PG8_WAIT_V(8); PG8_WAIT_L(0); PG8_BAR; PG8_MMA(1, 0, At, B0); PG8_MMA(1, 1, At, B1); PG8_BAR; PG8_SCHED;
            PG8_LDB(B0, 1, 0); PG8_LDB(B1, 1, 1); PG8_SCHED; PG8_LDA(At, 1, 0); PG8_STAGE(PG8_SA(0, 1), a2 + hstep, voffA);
            PG8_WAIT_V(8); PG8_WAIT_L(0); PG8_BAR; PG8_MMA(0, 0, At, B0); PG8_MMA(0, 1, At, B1); PG8_BAR; PG8_SCHED;
            PG8_LDA(At, 1, 1); PG8_STAGE(PG8_SB(1, 0), b3, voffB); PG8_STAGE(PG8_SB(1, 1), b3 + hstep, voffB); PG8_STAGE(PG8_SA(1, 0), a3, voffA);
            PG8_WAIT_V(8); PG8_WAIT_L(0); PG8_BAR; PG8_MMA(1, 0, At, B0); PG8_MMA(1, 1, At, B1); PG8_BAR; PG8_SCHED;
            } else {
            PG8_LDB(B0, 0, 0); PG8_SCHED; PG8_LDA(At, 0, 0); PG8_STAGE(PG8_SA(1, 1), a1 + hstep, voffA);
            PG8_WAIT_L(8); PG8_BAR; PG8_WAIT_L(0); PG8_MMA(0, 0, At, B0); PG8_BAR; PG8_SCHED;
            PG8_LDB(B1, 0, 1); PG8_STAGE(PG8_SB(0, 0), b2, voffB);
            PG8_BAR; PG8_WAIT_L(0); PG8_MMA(0, 1, At, B1); PG8_BAR;
            PG8_LDA(At, 0, 1); PG8_STAGE(PG8_SA(0, 0), a2, voffA);
            PG8_BAR; PG8_WAIT_L(0); PG8_MMA(1, 0, At, B0); PG8_BAR; PG8_SCHED;
            PG8_STAGE(PG8_SB(0, 1), b2 + hstep, voffB);
            PG8_WAIT_V(6); PG8_BAR; PG8_MMA(1, 1, At, B1); PG8_BAR;
            PG8_LDB(B0, 1, 0); PG8_SCHED; PG8_LDA(At, 1, 0); PG8_STAGE(PG8_SA(0, 1), a2 + hstep, voffA);
            PG8_WAIT_L(8); PG8_BAR; PG8_WAIT_L(0); PG8_MMA(0, 0, At, B0); PG8_BAR; PG8_SCHED;
            PG8_LDB(B1, 1, 1); PG8_STAGE(PG8_SB(1, 0), b3, voffB);
            PG8_BAR; PG8_WAIT_L(0); PG8_MMA(0, 1, At, B1); PG8_BAR;
            PG8_LDA(At, 1, 1); PG8_STAGE(PG8_SA(1, 0), a3, voffA);
            PG8_BAR; PG8_WAIT_L(0); PG8_MMA(1, 0, At, B0); PG8_BAR; PG8_SCHED;
            PG8_STAGE(PG8_SB(1, 1), b3 + hstep, voffB);
            PG8_WAIT_V(6); PG8_BAR; PG8_MMA(1, 1, At, B1); PG8_BAR;
            }
        }
        if constexpr (ALIGN_EPI) { if (wr == 0) PG8_BAR; }
        if constexpr (!Epi::AFTER_DRAIN) { E(acc, cur, wr, wc, fr, fq); S.done(cur); }
        if (!has_next) break;
#pragma unroll
        for (int a = 0; a < 2; ++a)
#pragma unroll
            for (int b = 0; b < 2; ++b)
#pragma unroll
                for (int m = 0; m < 4; ++m)
#pragma unroll
                    for (int n = 0; n < 2; ++n) acc[a][b][m][n] = (f32x4){0.f, 0.f, 0.f, 0.f};
        cur = nxt; cA = nA; cB = nB; ++ui;
        if constexpr (ALIGN_EPI) { if (wr == 1) PG8_BAR; }
    }
    PG8_WAIT_V(0);
    if constexpr (!ALIGN_EPI) { if (wr == 0) PG8_BAR; }
    PG8_BAR;
    if constexpr (Epi::AFTER_DRAIN) { E.fused(acc, cur, wr, wc, fr, fq, lds, wid, lane); S.done(cur); }
#undef PG8_SA
#undef PG8_SB
#undef PG8_STAGE
#undef PG8_LDA
#undef PG8_LDB
#undef PG8_MMA
#undef PG8_WAIT_V
#undef PG8_WAIT_L
#undef PG8_BAR
#undef PG8_SCHED
}
}

namespace pg8 {
__host__ __device__ __forceinline__ int permk(int kl) { return 8 * ((kl & 15) >> 2) + 4 * (kl >> 4) + (kl & 3); }
struct EpiBf16Rs {
    static constexpr bool PERM = true, AFTER_DRAIN = false;
    bf16_t* O0; int ld0; int ntile0; bf16_t* O1; int ld1; size_t stride1; const float* ssq; float cs;
    __device__ __forceinline__ void operator()(const f32x4 (&acc)[2][2][4][2], const Unit& u, int wr, int wc, int fr, int fq) const {
        bf16_t* base; int ld, colt;
        if (u.pn < ntile0) { base = O0; ld = ld0; colt = u.pn * BM; }
        else { const int q = u.pn - ntile0, per = ld1 / BM; base = O1 + (size_t)(q / per) * stride1; ld = ld1; colt = (q % per) * BM; }
        const int row0 = u.pm * BM + wr * 64 + fr, col0 = colt + wc * 32 + 8 * fq;
#pragma unroll
        for (int ai = 0; ai < 2; ++ai)
#pragma unroll
            for (int m = 0; m < 4; ++m) {
                const int row = row0 + ai * HALF + m * 16;
                float sc = cs; if (ssq) sc *= rsqrtf(ssq[row] * (1.0f / 1024.0f) + 1e-6f);
                bf16_t* rowp = base + (size_t)row * ld + col0;
#pragma unroll
                for (int bj = 0; bj < 2; ++bj) { const f32x4 v0 = acc[ai][bj][m][0] * sc, v1 = acc[ai][bj][m][1] * sc;
                    u32x4 w; w.x = cvt_pk_bf16(v0[0], v0[1]); w.y = cvt_pk_bf16(v0[2], v0[3]); w.z = cvt_pk_bf16(v1[0], v1[1]); w.w = cvt_pk_bf16(v1[2], v1[3]);
                    *(u32x4*)(rowp + bj * HALF) = w; } }
    }
};
struct EpiF16Rs {
    static constexpr bool PERM = true, AFTER_DRAIN = false;
    _Float16* O; int ld; const float* ssq;
    __device__ __forceinline__ void operator()(const f32x4 (&acc)[2][2][4][2], const Unit& u, int wr, int wc, int fr, int fq) const {
        typedef _Float16 f16x8 __attribute__((ext_vector_type(8)));
        const int row0 = u.pm * BM + wr * 64 + fr, col0 = u.pn * BM + wc * 32 + 8 * fq;
#pragma unroll
        for (int ai = 0; ai < 2; ++ai)
#pragma unroll
            for (int m = 0; m < 4; ++m) {
                const int row = row0 + ai * HALF + m * 16;
                const float sc = rsqrtf(ssq[row] * (1.0f / 1024.0f) + 1e-6f);
                _Float16* rowp = O + (size_t)row * ld + col0;
#pragma unroll
                for (int bj = 0; bj < 2; ++bj) { const f32x4 v0 = acc[ai][bj][m][0] * sc, v1 = acc[ai][bj][m][1] * sc;
                    f16x8 w; w[0] = (_Float16)v0[0]; w[1] = (_Float16)v0[1]; w[2] = (_Float16)v0[2]; w[3] = (_Float16)v0[3];
                    w[4] = (_Float16)v1[0]; w[5] = (_Float16)v1[1]; w[6] = (_Float16)v1[2]; w[7] = (_Float16)v1[3];
                    *(f16x8*)(rowp + bj * HALF) = w; } }
    }
};
template <bool BASE_F32> struct EpiResidBf {
    static constexpr bool PERM = true, AFTER_DRAIN = false;
    const float* basef; bf16_t* xb; float* ssq;
    __device__ __forceinline__ void operator()(const f32x4 (&acc)[2][2][4][2], const Unit& u, int wr, int wc, int fr, int fq) const {
        const int row0 = u.pm * BM + wr * 64 + fr, col0 = u.pn * BM + wc * 32 + 8 * fq;
#pragma unroll
        for (int ai = 0; ai < 2; ++ai)
#pragma unroll
            for (int m = 0; m < 4; ++m) {
                const int row = row0 + ai * HALF + m * 16; const size_t off = (size_t)row * 1024 + col0; float s = 0.f;
#pragma unroll
                for (int bj = 0; bj < 2; ++bj) { const size_t o2 = off + bj * HALF;
                    f32x4 b0, b1;
                    if (BASE_F32) { b0 = *(const f32x4*)(basef + o2); b1 = *(const f32x4*)(basef + o2 + 4); }
                    else { const u32x4 p = *(const u32x4*)(xb + o2);
                        b0 = (f32x4){__builtin_bit_cast(float, p.x << 16), __builtin_bit_cast(float, p.x & 0xffff0000u), __builtin_bit_cast(float, p.y << 16), __builtin_bit_cast(float, p.y & 0xffff0000u)};
                        b1 = (f32x4){__builtin_bit_cast(float, p.z << 16), __builtin_bit_cast(float, p.z & 0xffff0000u), __builtin_bit_cast(float, p.w << 16), __builtin_bit_cast(float, p.w & 0xffff0000u)}; }
                    const f32x4 o0 = b0 + acc[ai][bj][m][0], o1 = b1 + acc[ai][bj][m][1];
                    s += ((o0[0] * o0[0] + o0[1] * o0[1]) + (o0[2] * o0[2] + o0[3] * o0[3])) + ((o1[0] * o1[0] + o1[1] * o1[1]) + (o1[2] * o1[2] + o1[3] * o1[3]));
                    u32x4 w; w.x = cvt_pk_bf16(o0[0], o0[1]); w.y = cvt_pk_bf16(o0[2], o0[3]); w.z = cvt_pk_bf16(o1[0], o1[1]); w.w = cvt_pk_bf16(o1[2], o1[3]);
                    *(u32x4*)(xb + o2) = w; }
                s += __shfl_xor(s, 16); s += __shfl_xor(s, 32);
                if (fq == 0) atomicAdd(ssq + row, s);
            }
    }
};
struct EpiKV {
    static constexpr bool PERM = false, AFTER_DRAIN = false;
    bf16_t* Kb; bf16_t* VTp;
    __device__ __forceinline__ void operator()(const f32x4 (&acc)[2][2][4][2], const Unit& u, int wr, int wc, int fr, int fq) const {
        typedef unsigned u32x2v __attribute__((ext_vector_type(2)));
        const int row0 = u.pm * BM + wr * 64 + fr, col0 = u.pn * BM + wc * 32 + 4 * fq;
#pragma unroll
        for (int ai = 0; ai < 2; ++ai)
#pragma unroll
            for (int m = 0; m < 4; ++m) {
                const int row = row0 + ai * HALF + m * 16, b = row >> 8, key = row & 255;
#pragma unroll
                for (int bj = 0; bj < 2; ++bj)
#pragma unroll
                    for (int n = 0; n < 2; ++n) { const int col = col0 + bj * HALF + n * 16; const f32x4 v = acc[ai][bj][m][n];
                        const unsigned p01 = cvt_pk_bf16(v[0], v[1]), p23 = cvt_pk_bf16(v[2], v[3]);
                        if (col < 1024) { const int h = col >> 8, dh = col & 255; u32x2v w; w.x = p01; w.y = p23;
                            *(u32x2v*)(Kb + ((size_t)((b * 4 + h) * 256 + key)) * 256 + dh) = w; }
                        else { const int c2 = col - 1024, h = c2 >> 8, dv = c2 & 255, kp = (key & ~31) | permk(key & 31);
                            bf16_t* d = VTp + ((size_t)((b * 4 + h) * 256 + dv)) * 256 + kp;
                            d[0] = (bf16_t)(p01 & 0xffffu); d[256] = (bf16_t)(p01 >> 16); d[512] = (bf16_t)(p23 & 0xffffu); d[768] = (bf16_t)(p23 >> 16); } }
            }
    }
};
}
#ifndef PG8_SP2
#define PG8_SP2 true
#endif
#ifndef PG8_ALIGN
#define PG8_ALIGN true
#endif

constexpr int NWAVES = 8;
#ifndef MK_PER_PHASE
#define MK_PER_PHASE 0
#endif
constexpr int T = 16384, SEQ = 8192, D = 1024;
constexpr int N_PHASES = 12;

constexpr size_t MiB = 1u << 20, KiB = 1u << 10;
constexpr size_t WS_CTL = 0, CTL_ZERO_BYTES = 1 * MiB;
constexpr int CW_BAR = 4096;
constexpr size_t WS_SSQ1 = 64 * KiB, WS_SSQ2 = 128 * KiB;
constexpr size_t WS_AB = 1 * MiB;
constexpr size_t WS_HEND = WS_AB + 512 * KiB, WS_PEND = WS_HEND + 512 * KiB, WS_HIN = WS_PEND + 512 * KiB;
constexpr size_t WS_DEC = WS_HIN + 512 * KiB;
constexpr size_t WS_SUBK = 3 * MiB + 256 * KiB;
constexpr size_t WS_WIN = 4 * MiB, WS_WOUT = 10 * MiB, WS_WQ = 12 * MiB, WS_WKV = 14 * MiB, WS_WO = 18 * MiB, WS_PWQ = 20 * MiB;
constexpr size_t WS_MEMN = 24 * MiB, WS_KB = 25 * MiB, WS_VTP = 26 * MiB, WS_LRUWT = 27 * MiB, WS_USC = 27 * MiB + 256 * KiB, WS_VSC = 27 * MiB + 384 * KiB;
constexpr size_t WS_XB = 28 * MiB;
constexpr size_t WS_HLOC = 28 * MiB, WS_PCUM = 44 * MiB;
constexpr size_t WS_QKV = 60 * MiB;
constexpr size_t OUT_Y = 4 * MiB;
constexpr size_t OUT_END = OUT_Y + (size_t)16384 * 1024 * 2;
constexpr size_t WS_IDX = 60 * MiB, WS_GW = 68 * MiB;
constexpr size_t WS_UB = 60 * MiB;
constexpr size_t WS_XR = 108 * MiB, WS_Z = 124 * MiB, WS_GATE = 140 * MiB;
constexpr size_t WS_WN = 156 * MiB, WS_UF = 172 * MiB, WS_QD = 188 * MiB, WS_KD = 204 * MiB, WS_ATT = 220 * MiB;
constexpr size_t WS_VB = 228 * MiB;
constexpr size_t WS_Q = 188 * MiB, WS_AO = 124 * MiB;
constexpr size_t WS_PQ = 108 * MiB;
constexpr size_t WS_END = 244 * MiB;
constexpr int CW_GFLAG = 49152;
constexpr int CW_LRUCNT = 8192;
static_assert(WS_XR - WS_QKV == (size_t)T * 1536 * 2 && WS_Z - WS_XR == (size_t)T * 512 * 2 && WS_GATE - WS_Z == (size_t)T * 512 * 2, "in-proj outputs are contiguous");

constexpr int LDS_BYTES = 160 * 1024;
constexpr int MISC_OFF = 159 * 1024;

#define GAS __attribute__((address_space(1)))
#define LAS __attribute__((address_space(3)))
typedef unsigned short bf16;
typedef unsigned v4u __attribute__((ext_vector_type(4)));
typedef unsigned v2u __attribute__((ext_vector_type(2)));
typedef float f32x4 __attribute__((ext_vector_type(4)));
typedef short bf16x8 __attribute__((ext_vector_type(8)));
typedef GAS unsigned gu32;
#define LDS_WAIT() asm volatile("s_waitcnt lgkmcnt(0)" ::: "memory")
__device__ __forceinline__ void st16_wt(void* p, v4u v) { asm volatile("global_store_dwordx4 %0, %1, off sc0 sc1\n\ts_nop 1" :: "v"(p), "v"(v) : "memory"); }
__device__ __forceinline__ unsigned f2bf(float f) { unsigned u = __builtin_bit_cast(unsigned, f); return (u + 0x7fffu + ((u >> 16) & 1u)) >> 16; }
__device__ __forceinline__ unsigned pk2(float lo, float hi) { return f2bf(lo) | (f2bf(hi) << 16); }
__device__ __forceinline__ float bflo(unsigned u) { return __builtin_bit_cast(float, u << 16); }
__device__ __forceinline__ float bfhi(unsigned u) { return __builtin_bit_cast(float, u & 0xffff0000u); }
__device__ __forceinline__ float bf1(bf16 h) { return __builtin_bit_cast(float, (unsigned)h << 16); }
__device__ __forceinline__ float wave_sum(float v) {
#pragma unroll
    for (int o = 1; o < 64; o <<= 1) v += __shfl_xor(v, o);
    return v;
}
__device__ __forceinline__ float row16_sum(float v) {
    v += __builtin_bit_cast(float, __builtin_amdgcn_update_dpp(0, __builtin_bit_cast(int, v), 0xB1, 0xF, 0xF, true));
    v += __builtin_bit_cast(float, __builtin_amdgcn_update_dpp(0, __builtin_bit_cast(int, v), 0x4E, 0xF, 0xF, true));
    v += __builtin_bit_cast(float, __builtin_amdgcn_update_dpp(0, __builtin_bit_cast(int, v), 0x141, 0xF, 0xF, true));
    v += __builtin_bit_cast(float, __builtin_amdgcn_update_dpp(0, __builtin_bit_cast(int, v), 0x140, 0xF, 0xF, true));
    return v;
}
__device__ __forceinline__ float sigmoidf_(float x) { return __builtin_amdgcn_rcpf(1.0f + __expf(-x)); }
__device__ __forceinline__ float softplusf_(float x) { return fmaxf(x, 0.f) + log1pf(__expf(-fabsf(x))); }
__device__ __forceinline__ float siluf_(float x) { return x * __builtin_amdgcn_rcpf(1.0f + __expf(-x)); }
__device__ __forceinline__ float gelu_tanh(float x) { const float y = 0.7978845608028654f * (x + 0.044715f * x * x * x); const float e = __expf(2.0f * y); return x * (1.0f - __builtin_amdgcn_rcpf(1.0f + e)); }
__device__ __forceinline__ int permk(int kl) { return 8 * ((kl & 15) >> 2) + 4 * (kl >> 4) + (kl & 3); }

struct Params {
    const float *x, *mem, *norm_mix_w, *w_in, *conv_qkv_w, *gdn_a_log, *gdn_dt_bias, *gdn_norm_w, *lru_conv_w, *lru_conv_b, *lru_wa, *lru_ba, *lru_wx, *lru_bx, *lru_lambda, *w_out,
                *norm_xattn_w, *norm_mem_w, *xattn_wq, *xattn_wkv, *xattn_wo, *norm_ffn_w, *peer_wq, *peer_subkeys, *peer_u, *peer_v, *norm_final_w;
    float* out; unsigned char* ws; int ph_lo, ph_hi;
};
#define XB_TMO      128
#define XB_XCNT(j)  (256  + 64 * (j))
#define XB_XSUB(j)  (1280 + 64 * (j))
#define XB_XGEN(j)  (2304 + 64 * (j))
#define XB_TOP      3328
#define XB_TOPGEN   3392
#define XCD_BAR_WORDS 3456
#define XB_SPIN_CAP (1u << 18)

__device__ __forceinline__ unsigned xb_ld(unsigned* p)              { return __hip_atomic_load(p, __ATOMIC_RELAXED, __HIP_MEMORY_SCOPE_AGENT); }
__device__ __forceinline__ unsigned xb_add(unsigned* p, unsigned v) { return __hip_atomic_fetch_add(p, v, __ATOMIC_RELAXED, __HIP_MEMORY_SCOPE_AGENT); }
__device__ __forceinline__ unsigned xb_xcc_id() { return (unsigned)__builtin_amdgcn_s_getreg((3 << 11) | 20) & 0xFu; }
#define XB_SPIN(cond, bar) do { unsigned _sp = 0; while (cond) { __builtin_amdgcn_s_sleep(1); \
    if ((++_sp & 255u) == 0u) { if (xb_ld(&(bar)[XB_TMO])) break; if (_sp > XB_SPIN_CAP) { atomicAdd(&(bar)[XB_TMO], 1u); break; } } } } while (0)

struct XcdBarrier {
    unsigned* bar; unsigned x;
    volatile LAS unsigned* st;
};

__device__ __forceinline__ XcdBarrier xcd_barrier_post(unsigned* bar, volatile LAS unsigned* st) {
    XcdBarrier b; b.bar = bar; b.x = xb_xcc_id(); b.st = st;
    if (threadIdx.x == 0) (void)xb_add(&bar[XB_XCNT(b.x)], 1u);
    return b;
}
__device__ __forceinline__ void xcd_barrier_complete(unsigned* bar, unsigned x, unsigned& nloc, unsigned& nx) {
    const unsigned G = gridDim.x * gridDim.y * gridDim.z;
    unsigned sum, cnt, mine, sp = 0u;
    for (;;) {
        sum = 0u; cnt = 0u; mine = 0u;
#pragma unroll
        for (unsigned j = 0; j < 16; ++j) { const unsigned c = xb_ld(&bar[XB_XCNT(j)]); sum += c; cnt += (c > 0u) ? 1u : 0u; mine = (j == x) ? c : mine; }
        if (sum == G) break;
        __builtin_amdgcn_s_sleep(1);
        if ((++sp & 255u) == 0u) { if (xb_ld(&bar[XB_TMO])) break; if (sp > XB_SPIN_CAP) { atomicAdd(&bar[XB_TMO], 1u); break; } }
    }
    nloc = mine > 0u ? mine : 1u; nx = cnt > 0u ? cnt : 1u;
}

__device__ __forceinline__ void xcd_barrier(const XcdBarrier& b) {
    asm volatile("s_waitcnt vmcnt(0)" ::: "memory");
    __syncthreads();
    if (threadIdx.x == 0) {
        unsigned* bar = b.bar;
        __builtin_amdgcn_s_waitcnt(0);
        unsigned nloc = b.st[0], nx = b.st[1];
        if (nloc == 0u) { xcd_barrier_complete(bar, b.x, nloc, nx); b.st[0] = nloc; b.st[1] = nx; }
        const unsigned old = xb_add(&bar[XB_XSUB(b.x)], 1u);
        const unsigned gen = old / nloc;
        if (old + 1u == (gen + 1u) * nloc) {
            __builtin_amdgcn_fence(__ATOMIC_RELEASE, "agent");
            asm volatile("s_waitcnt vmcnt(0)" ::: "memory");
            const unsigned og = xb_add(&bar[XB_TOP], 1u);
            const unsigned tg = og / nx;
            if (og + 1u == (tg + 1u) * nx) xb_add(&bar[XB_TOPGEN], 1u);
            else XB_SPIN(xb_ld(&bar[XB_TOPGEN]) == tg, bar);
            __builtin_amdgcn_fence(__ATOMIC_ACQUIRE, "agent");
            xb_add(&bar[XB_XGEN(b.x)], 1u);
            asm volatile("s_waitcnt vmcnt(0)" ::: "memory");
        } else {
            XB_SPIN(xb_ld(&bar[XB_XGEN(b.x)]) == gen, bar);
            __builtin_amdgcn_fence(__ATOMIC_ACQUIRE, "agent");
            asm volatile("s_waitcnt vmcnt(0)" ::: "memory");
        }
    }
    __syncthreads();
}

__device__ __forceinline__ void p0_transpose_item(const float* W, int K, int ldw, int c0, int nblk, bf16* WT, int row_off, const float* ks, LAS float* scr, int item, int lane) {
    const int kb = item / nblk, nb = item % nblk, k0 = 64 * kb, n0 = 32 * nb;
#pragma unroll 8
    for (int i = 0; i < 32; ++i) { const int kk = 2 * i + (lane >> 5); float v = W[(size_t)(k0 + kk) * ldw + c0 + n0 + (lane & 31)]; if (ks) v *= ks[k0 + kk]; scr[kk * 33 + (lane & 31)] = v; }
    LDS_WAIT(); asm volatile("" ::: "memory");
    const int c = lane & 7;
#pragma unroll
    for (int j = 0; j < 4; ++j) { const int n = (lane >> 3) + 8 * j; const LAS float* s = scr + (8 * c) * 33 + n;
        v4u o; o.x = pk2(s[0 * 33], s[1 * 33]); o.y = pk2(s[2 * 33], s[3 * 33]); o.z = pk2(s[4 * 33], s[5 * 33]); o.w = pk2(s[6 * 33], s[7 * 33]);
        *(GAS v4u*)(WT + (size_t)(row_off + n0 + n) * K + k0 + 8 * c) = o; }
    LDS_WAIT(); asm volatile("" ::: "memory");
}

__device__ __forceinline__ void p0_prologue(const Params& P, LAS unsigned char* lds, int tid, int lane, int wave, int vcu, int G) {
    unsigned char* ws = P.ws;
    const int gw = vcu * NWAVES + wave, NGW = G * NWAVES;
    LAS float* wabl = (LAS float*)lds;
    for (int idx = tid; idx < 8192; idx += NWAVES * 64) { const int k = idx >> 3, c = idx & 7, j = k >> 8, l = (k >> 2) & 63, e = k & 3;
        wabl[((((j * 4 + e) * 2 + (c >> 2)) * 64 + l) << 2) + (c & 3)] = P.w_in[(size_t)k * 3080 + 2048 + c]; }
    __syncthreads();
    {
        bf16* XB0 = (bf16*)(ws + WS_XB); float* AB = (float*)(ws + WS_AB);
        f32x4 w4[4];
#pragma unroll
        for (int j = 0; j < 4; ++j) w4[j] = ((const f32x4*)P.norm_mix_w)[64 * j + lane];
        for (int m = gw; m < T; m += NGW) {
            const f32x4* xr = (const f32x4*)(P.x + (size_t)m * D) + lane;
            f32x4 v[4]; float s = 0.f;
#pragma unroll
            for (int j = 0; j < 4; ++j) { v[j] = xr[64 * j]; s += (v[j].x * v[j].x + v[j].y * v[j].y) + (v[j].z * v[j].z + v[j].w * v[j].w); }
            const float rstd = rsqrtf(wave_sum(s) * (1.0f / D) + 1e-6f);
            v2u* o8 = (v2u*)(XB0 + (size_t)m * D) + lane;
            float part[8];
#pragma unroll
            for (int c = 0; c < 8; ++c) part[c] = 0.f;
#pragma unroll
            for (int j = 0; j < 4; ++j) {
                v[j] = v[j] * rstd * w4[j];
                v2u o; o.x = pk2(v[j].x, v[j].y); o.y = pk2(v[j].z, v[j].w); o8[64 * j] = o;
#pragma unroll
                for (int e = 0; e < 4; ++e) {
                    const f32x4 wa = *(const LAS f32x4*)(wabl + ((((j * 4 + e) * 2 + 0) * 64 + lane) << 2));
                    const f32x4 wb = *(const LAS f32x4*)(wabl + ((((j * 4 + e) * 2 + 1) * 64 + lane) << 2));
                    const float hv = v[j][e];
                    part[0] += hv * wa.x; part[1] += hv * wa.y; part[2] += hv * wa.z; part[3] += hv * wa.w;
                    part[4] += hv * wb.x; part[5] += hv * wb.y; part[6] += hv * wb.z; part[7] += hv * wb.w;
                }
            }
#pragma unroll
            for (int c = 0; c < 8; ++c) part[c] = wave_sum(part[c]);
            float o = part[0];
#pragma unroll
            for (int c = 1; c < 8; ++c) o = (lane == c) ? part[c] : o;
            if (lane < 8) AB[(size_t)m * 8 + lane] = o;
        }
    }
    {
        bf16* MEMN = (bf16*)(ws + WS_MEMN);
        for (int m = gw; m < 512; m += NGW) {
            const f32x4* xr = (const f32x4*)(P.mem + (size_t)m * D) + lane;
            f32x4 v[4]; float s = 0.f;
#pragma unroll
            for (int j = 0; j < 4; ++j) { v[j] = xr[64 * j]; s += (v[j].x * v[j].x + v[j].y * v[j].y) + (v[j].z * v[j].z + v[j].w * v[j].w); }
            const float rstd = rsqrtf(wave_sum(s) * (1.0f / D) + 1e-6f);
            v2u* o8 = (v2u*)(MEMN + (size_t)m * D) + lane;
#pragma unroll
            for (int j = 0; j < 4; ++j) { const f32x4 w = ((const f32x4*)P.norm_mem_w)[64 * j + lane]; const f32x4 y = v[j] * rstd * w;
                v2u o; o.x = pk2(y.x, y.y); o.y = pk2(y.z, y.w); o8[64 * j] = o; }
        }
    }
    __syncthreads();
    {
        LAS float* scr = (LAS float*)(lds + wave * 16384);
        constexpr int I_IN1 = 16 * 48, I_IN2 = 16 * 16, I_KV = 16 * 64;
        constexpr int NITEMS = I_IN1 + 3 * I_IN2 + I_KV;
        for (int it = gw; it < NITEMS; it += NGW) {
            int r = it;
            if (r < I_IN1) { p0_transpose_item(P.w_in, 1024, 3080, 0, 48, (bf16*)(ws + WS_WIN), 0, nullptr, scr, r, lane); continue; } r -= I_IN1;
            if (r < I_IN2) { p0_transpose_item(P.w_in, 1024, 3080, 2056, 16, (bf16*)(ws + WS_WIN), 1536, nullptr, scr, r, lane); continue; } r -= I_IN2;
            if (r < I_IN2) { p0_transpose_item(P.w_in, 1024, 3080, 1536, 16, (bf16*)(ws + WS_WIN), 2048, nullptr, scr, r, lane); continue; } r -= I_IN2;
            if (r < I_IN2) { p0_transpose_item(P.w_in, 1024, 3080, 2568, 16, (bf16*)(ws + WS_WIN), 2560, nullptr, scr, r, lane); continue; } r -= I_IN2;
            p0_transpose_item(P.xattn_wkv, 1024, 2048, 0, 64, (bf16*)(ws + WS_WKV), 0, nullptr, scr, r, lane);
        }
    }
    {
        bf16* WT = (bf16*)(ws + WS_LRUWT);
        for (int it = vcu * NWAVES * 64 + tid; it < 8 * 2 * 64 * 8; it += G * NWAVES * 64) {
            const int i8 = it & 7, j = (it >> 3) & 63, m = (it >> 9) & 1, g = it >> 10;
            const float* src = (m ? P.lru_wx : P.lru_wa) + (size_t)(g * 64 + 8 * i8) * 64 + j;
            v4u o; o.x = pk2(src[0], src[64]); o.y = pk2(src[128], src[192]); o.z = pk2(src[256], src[320]); o.w = pk2(src[384], src[448]);
            *(v4u*)(WT + (size_t)it * 8) = o;
        }
    }
}

__device__ __forceinline__ void late_weight_prep(const Params& P, LAS unsigned char* lds, int lane, int wave, int gw, int NGW) {
    unsigned char* ws = P.ws;
    {
        LAS float* scr = (LAS float*)(lds + wave * 16384);
        constexpr int I_OUT = 16 * 32, I_Q = 16 * 32, I_O = 16 * 32;
        for (int it = gw; it < I_OUT + I_Q + I_O; it += NGW) {
            int r = it;
            if (r < I_OUT) { p0_transpose_item(P.w_out, 1024, 1024, 0, 32, (bf16*)(ws + WS_WOUT), 0, nullptr, scr, r, lane); continue; } r -= I_OUT;
            if (r < I_Q) { p0_transpose_item(P.xattn_wq, 1024, 1024, 0, 32, (bf16*)(ws + WS_WQ), 0, P.norm_xattn_w, scr, r, lane); continue; } r -= I_Q;
            p0_transpose_item(P.xattn_wo, 1024, 1024, 0, 32, (bf16*)(ws + WS_WO), 0, nullptr, scr, r, lane);
        }
    }
    {
        bf16* WF = (bf16*)(ws + WS_PWQ);
        const int col = lane & 15, g = lane >> 4;
        for (int it = gw; it < 16 * 64; it += NGW) {
            const int hp = it >> 6, k0 = (it & 63) * 16;
            bf16x8 bq[4];
#pragma unroll
            for (int s = 0; s < 4; ++s) { const f32x4* src = (const f32x4*)(P.peer_wq + (size_t)(k0 + col) * 2048 + hp * 128 + 32 * s + 8 * g);
                const f32x4 a = src[0], c = src[1]; v4u pk; pk.x = pk2(a.x, a.y); pk.y = pk2(a.z, a.w); pk.z = pk2(c.x, c.y); pk.w = pk2(c.z, c.w); bq[s] = __builtin_bit_cast(bf16x8, pk); }
            const float nw = P.norm_ffn_w[k0 + col];
#pragma unroll 2
            for (int kt = 0; kt < 8; ++kt) {
                f32x4 acc = (f32x4){0.f, 0.f, 0.f, 0.f};
#pragma unroll
                for (int s = 0; s < 4; ++s) { const f32x4* src = (const f32x4*)(P.peer_subkeys + (size_t)(hp * 128 + 16 * kt + col) * 128 + 32 * s + 8 * g);
                    const f32x4 a = src[0], c = src[1]; v4u pk; pk.x = pk2(a.x, a.y); pk.y = pk2(a.z, a.w); pk.z = pk2(c.x, c.y); pk.w = pk2(c.z, c.w);
                    acc = __builtin_amdgcn_mfma_f32_16x16x32_bf16(__builtin_bit_cast(bf16x8, pk), bq[s], acc, 0, 0, 0); }
#pragma unroll
                for (int i = 0; i < 4; ++i) WF[(size_t)(hp * 128 + 16 * kt + 4 * g + i) * 1024 + k0 + col] = (bf16)f2bf(acc[i] * nw);
            }
        }
    }
}

constexpr int GL_KS = 0, GL_VS = 33792, GL_KB = 67584, GL_QB = 84992, GL_RAW = 102400, GL_CW = 153856, GL_AMT = 133120, GL_SM = 160000, GL_ATT = 151808, GL_SOL = 67584;
static_assert(GL_CW + 6144 <= GL_SM && GL_SM + 1284 <= MISC_OFF && GL_SOL + 65536 <= GL_AMT && GL_AMT + 17408 <= GL_ATT && GL_ATT + 8192 <= GL_SM && GL_RAW + 51456 <= GL_CW, "gdn_local LDS map");
#ifndef GL_REP_STEP
#define GL_REP_STEP -1
#endif
#define GL_REPF(k) for (int rr_ = 0; rr_ < ((GL_REP_STEP == (k)) ? 2 : 1); ++rr_)
#define GL_BAR() do { asm volatile("s_waitcnt lgkmcnt(0)" ::: "memory"); __builtin_amdgcn_s_barrier(); asm volatile("" ::: "memory"); } while (0)
__device__ __forceinline__ void gdn_local_item(const Params& P, LAS unsigned char* lds, int item, int tid) {
    unsigned char* ws = P.ws;
    asm volatile("" : "+v"(tid));
    const int b = item >> 9, h = (item >> 7) & 3, n = item & 127;
    const int t0 = b * SEQ + n * 64;
    const int lane = tid & 63, wave = __builtin_amdgcn_readfirstlane(tid >> 6);
    LAS float* ks = (LAS float*)(lds + GL_KS);
    LAS float* vs = (LAS float*)(lds + GL_VS);
    LAS bf16* kb16 = (LAS bf16*)(lds + GL_KB);
    LAS bf16* qb16 = (LAS bf16*)(lds + GL_QB);
    LAS bf16* raw = (LAS bf16*)(lds + GL_RAW);
    LAS float* cw = (LAS float*)(lds + GL_CW);
    LAS float* AmT = (LAS float*)(lds + GL_AMT);
    LAS float* sg = (LAS float*)(lds + GL_SM);
    LAS float* sbeta = sg + 64; LAS float* sgc = sbeta + 64; LAS float* seg = sgc + 64; LAS float* sek = seg + 64;
    LAS bf16* atts = (LAS bf16*)(lds + GL_ATT);
    const bf16* QKV = (const bf16*)(ws + WS_QKV);
    const float* AB = (const float*)(ws + WS_AB);
    GL_REPF(0) {
        v4u pr[7];
#pragma unroll
        for (int r = 0; r < 7; ++r) {
            const int id = tid + 512 * r;
            const int row = id / 48, rem = id - row * 48, part = rem >> 4, ck = rem & 15, s = n * 64 + row - 3;
            pr[r] = (v4u){0u, 0u, 0u, 0u};
            if (id < 67 * 48 && s >= 0) pr[r] = *(const v4u*)(QKV + (size_t)(b * SEQ + s) * 1536 + part * 512 + h * 128 + ck * 8);
        }
        f32x4 cwv = (f32x4){0.f, 0.f, 0.f, 0.f};
        if (tid < 384) { const int j = tid / 96, rem = tid - j * 96, part = rem >> 5, c4 = rem & 31; cwv = *(const f32x4*)(P.conv_qkv_w + j * 1536 + part * 512 + h * 128 + c4 * 4); }
        float a_in = 0.f, b_in = 0.f;
        if (tid < 64) { a_in = AB[(size_t)(t0 + tid) * 8 + h]; b_in = AB[(size_t)(t0 + tid) * 8 + 4 + h]; }
#pragma unroll
        for (int r = 0; r < 7; ++r) { const int id = tid + 512 * r; if (id < 67 * 48) *(LAS v4u*)(raw + id * 8) = pr[r]; }
        if (tid < 384) *(LAS f32x4*)(cw + tid * 4) = cwv;
        if (tid < 64) { sg[tid] = -__expf(P.gdn_a_log[h]) * softplusf_(a_in + P.gdn_dt_bias[h]); sbeta[tid] = sigmoidf_(b_in); }
    }
    GL_BAR();
    GL_REPF(1) {
        const int c = tid >> 3, grp = tid & 7;
#pragma unroll 1
        for (int part = 0; part < 3; ++part) {
            float y[16];
#pragma unroll
            for (int i = 0; i < 16; ++i) y[i] = 0.f;
#pragma unroll
            for (int j = 0; j < 4; ++j) {
                const LAS v4u* src = (const LAS v4u*)(raw + (c + j) * 384 + part * 128 + grp * 16);
                const v4u x0 = src[0], x1 = src[1];
                const LAS f32x4* wp = (const LAS f32x4*)(cw + (j * 3 + part) * 128 + grp * 16);
                const f32x4 w0 = wp[0], w1 = wp[1], w2 = wp[2], w3 = wp[3];
                y[0] += w0.x * bflo(x0.x); y[1] += w0.y * bfhi(x0.x); y[2] += w0.z * bflo(x0.y); y[3] += w0.w * bfhi(x0.y);
                y[4] += w1.x * bflo(x0.z); y[5] += w1.y * bfhi(x0.z); y[6] += w1.z * bflo(x0.w); y[7] += w1.w * bfhi(x0.w);
                y[8] += w2.x * bflo(x1.x); y[9] += w2.y * bfhi(x1.x); y[10] += w2.z * bflo(x1.y); y[11] += w2.w * bfhi(x1.y);
                y[12] += w3.x * bflo(x1.z); y[13] += w3.y * bfhi(x1.z); y[14] += w3.z * bflo(x1.w); y[15] += w3.w * bfhi(x1.w);
            }
            float ss = 0.f;
#pragma unroll
            for (int i = 0; i < 16; ++i) { y[i] = siluf_(y[i]); ss += y[i] * y[i]; }
            if (part < 2) {
                ss += __shfl_xor(ss, 1); ss += __shfl_xor(ss, 2); ss += __shfl_xor(ss, 4);
                const float sc = rsqrtf(ss + 1e-6f) * (part == 0 ? 0.08838834764831845f : 1.0f);
#pragma unroll
                for (int i = 0; i < 16; ++i) y[i] *= sc;
            }
            if (part >= 1) {
                LAS float* dst = (part == 1 ? ks : vs) + c * 132 + grp * 16;
#pragma unroll
                for (int i = 0; i < 4; ++i) *(LAS f32x4*)(dst + 4 * i) = (f32x4){y[4 * i], y[4 * i + 1], y[4 * i + 2], y[4 * i + 3]};
            }
            if (part <= 1) {
                LAS bf16* dst = (part == 0 ? qb16 : kb16) + c * 136 + grp * 16;
                v4u o0, o1; o0.x = pk2(y[0], y[1]); o0.y = pk2(y[2], y[3]); o0.z = pk2(y[4], y[5]); o0.w = pk2(y[6], y[7]);
                o1.x = pk2(y[8], y[9]); o1.y = pk2(y[10], y[11]); o1.z = pk2(y[12], y[13]); o1.w = pk2(y[14], y[15]);
                *(LAS v4u*)dst = o0; *(LAS v4u*)(dst + 8) = o1;
            }
        }
    }
    if (tid < 64) {
        float v = sg[tid];
#pragma unroll
        for (int off = 1; off < 64; off <<= 1) { const float t = __shfl_up(v, off); if (tid >= off) v += t; }
        sgc[tid] = v; seg[tid] = __expf(v);
        const float gl = __shfl(v, 63);
        sek[tid] = __expf(gl - v);
        if (tid == 63) sek[64] = __expf(v);
    }
    GL_BAR();
    {
        const int mat = wave >> 2, rho = wave & 3, col = lane & 15, g = lane >> 4;
        const LAS bf16* X = mat ? qb16 : kb16;
        bf16x8 af[4];
#pragma unroll
        for (int s = 0; s < 4; ++s) af[s] = *(const LAS bf16x8*)(X + (16 * rho + col) * 136 + 32 * s + 8 * g);
#pragma unroll
        for (int sig = 0; sig < 4; ++sig) {
            f32x4 acc = (f32x4){0.f, 0.f, 0.f, 0.f};
#pragma unroll
            for (int s = 0; s < 4; ++s) { const bf16x8 bfr = *(const LAS bf16x8*)(kb16 + (16 * sig + col) * 136 + 32 * s + 8 * g); acc = __builtin_amdgcn_mfma_f32_16x16x32_bf16(af[s], bfr, acc, 0, 0, 0); }
            const int sidx = 16 * sig + col; const float gs = sgc[sidx];
#pragma unroll
            for (int i = 0; i < 4; ++i) {
                const int c = 16 * rho + 4 * g + i;
                const float dec = (c >= sidx) ? __expf(sgc[c] - gs) : 0.f;
                if (mat == 0) AmT[sidx * 68 + c] = (c > sidx) ? sbeta[c] * acc[i] * dec : 0.f;
                else atts[c * 64 + sidx] = (bf16)f2bf(acc[i] * dec);
            }
        }
    }
    GL_BAR();
    GL_REPF(4) {
        bf16* QD = (bf16*)(ws + WS_QD) + (size_t)item * 8192;
        bf16* KD = (bf16*)(ws + WS_KD) + (size_t)item * 8192;
        bf16* ATT = (bf16*)(ws + WS_ATT) + (size_t)item * 4096;
#pragma unroll
        for (int r = 0; r < 2; ++r) {
            const int id = tid + 512 * r;
            { const int c = id >> 4, gam = id & 15, s32 = gam >> 2, g = gam & 3;
              const v2u lo = *(const LAS v2u*)(qb16 + c * 136 + 32 * s32 + 4 * g), hi = *(const LAS v2u*)(qb16 + c * 136 + 32 * s32 + 16 + 4 * g);
              const float e = seg[c];
              v4u o; o.x = pk2(bflo(lo.x) * e, bfhi(lo.x) * e); o.y = pk2(bflo(lo.y) * e, bfhi(lo.y) * e); o.z = pk2(bflo(hi.x) * e, bfhi(hi.x) * e); o.w = pk2(bflo(hi.y) * e, bfhi(hi.y) * e);
              st16_wt(QD + c * 128 + 8 * gam, o); }
            { const int dk = id >> 3, gam = id & 7, s32 = gam >> 2, g = gam & 3, c0 = 32 * s32 + 4 * g;
              float v[8];
#pragma unroll
              for (int j = 0; j < 4; ++j) { v[j] = ks[(c0 + j) * 132 + dk] * sek[c0 + j]; v[4 + j] = ks[(c0 + 16 + j) * 132 + dk] * sek[c0 + 16 + j]; }
              v4u o; o.x = pk2(v[0], v[1]); o.y = pk2(v[2], v[3]); o.z = pk2(v[4], v[5]); o.w = pk2(v[6], v[7]);
              st16_wt(KD + dk * 64 + 8 * gam, o); }
        }
        { const int c = tid >> 3, gam = tid & 7, s32 = gam >> 2, g = gam & 3;
          const v2u lo = *(const LAS v2u*)(atts + c * 64 + 32 * s32 + 4 * g), hi = *(const LAS v2u*)(atts + c * 64 + 32 * s32 + 16 + 4 * g);
          v4u o; o.x = lo.x; o.y = lo.y; o.z = hi.x; o.w = hi.y;
          st16_wt(ATT + c * 64 + 8 * gam, o); }
    }
    GL_BAR();
    GL_REPF(5) {
        LAS float* xcol = (LAS float*)(lds + GL_SOL);
        LAS bf16* tinv = (LAS bf16*)(lds + GL_SOL + 17408);
        const int j = tid >> 3, part = tid & 7, jb = j >> 4, jo = j & 15;
#pragma unroll 1
        for (int rb = jb; rb < 4; ++rb) {
            float acc[16];
#pragma unroll
            for (int i = 0; i < 16; ++i) acc[i] = 0.f;
            if (rb > jb) {
#pragma unroll 2
                for (int s = 16 * jb + part; s < 16 * rb; s += 8) {
                    const float sv = xcol[j * 68 + s];
                    const LAS float* ar = AmT + s * 68 + 16 * rb;
#pragma unroll
                    for (int q = 0; q < 4; ++q) { const f32x4 A4 = *(const LAS f32x4*)(ar + 4 * q);
                        acc[4 * q] -= A4.x * sv; acc[4 * q + 1] -= A4.y * sv; acc[4 * q + 2] -= A4.z * sv; acc[4 * q + 3] -= A4.w * sv; }
                }
#pragma unroll
                for (int i = 0; i < 16; ++i) {
                    acc[i] += __builtin_bit_cast(float, __builtin_amdgcn_update_dpp(0, __builtin_bit_cast(int, acc[i]), 0xB1, 0xF, 0xF, true));
                    acc[i] += __builtin_bit_cast(float, __builtin_amdgcn_update_dpp(0, __builtin_bit_cast(int, acc[i]), 0x4E, 0xF, 0xF, true));
                    acc[i] += __builtin_bit_cast(float, __builtin_amdgcn_update_dpp(0, __builtin_bit_cast(int, acc[i]), 0x141, 0xF, 0xF, true));
                }
            } else {
#pragma unroll
                for (int i = 0; i < 16; ++i) acc[i] = (i == jo) ? 1.f : 0.f;
            }
#pragma unroll
            for (int i = 0; i < 16; ++i) {
                const float sv = acc[i];
                const LAS float* ar = AmT + (16 * rb + i) * 68 + 16 * rb;
#pragma unroll
                for (int q = (i + 1) / 4; q < 4; ++q) { const f32x4 A4 = *(const LAS f32x4*)(ar + 4 * q);
                    if (4 * q > i) acc[4 * q] -= A4.x * sv; if (4 * q + 1 > i) acc[4 * q + 1] -= A4.y * sv; if (4 * q + 2 > i) acc[4 * q + 2] -= A4.z * sv; if (4 * q + 3 > i) acc[4 * q + 3] -= A4.w * sv; }
            }
            if (part == 0) {
#pragma unroll
                for (int i = 0; i < 16; ++i) { xcol[j * 68 + 16 * rb + i] = acc[i]; tinv[(16 * rb + i) * 72 + j] = (bf16)f2bf(acc[i]); }
            }
            LDS_WAIT(); asm volatile("" ::: "memory");
        }
        for (int rb = 0; rb < jb; ++rb) {
            if (part == 0) {
#pragma unroll
                for (int i = 0; i < 16; ++i) tinv[(16 * rb + i) * 72 + j] = (bf16)0;
            }
        }
    }
    GL_BAR();
    GL_REPF(6) {
        const LAS bf16* tinv = (const LAS bf16*)(lds + GL_SOL + 17408);
        LAS bf16* wst = (LAS bf16*)(lds + GL_SOL + 17408 + 9216);
        const int col = lane & 15, g = lane >> 4, isw = wave >> 2;
        bf16x8 af[4][2];
#pragma unroll
        for (int rho = 0; rho < 4; ++rho)
#pragma unroll
            for (int s2 = 0; s2 < 2; ++s2) af[rho][s2] = *(const LAS bf16x8*)(tinv + (16 * rho + col) * 72 + 32 * s2 + 8 * g);
        bf16* UF = (bf16*)(ws + WS_UF) + (size_t)item * 8192;
#pragma unroll
        for (int sig = 0; sig < 2; ++sig) {
            const int jj = 32 * (wave & 3) + 16 * sig + col;
            const LAS float* src = (isw ? ks : vs) + jj;
            bf16x8 bfr[2];
#pragma unroll
            for (int s2 = 0; s2 < 2; ++s2) {
                float v[8];
#pragma unroll
                for (int e = 0; e < 8; ++e) { const int sidx = 32 * s2 + 8 * g + e; float x = src[sidx * 132] * sbeta[sidx]; if (isw) x *= seg[sidx]; v[e] = x; }
                v4u pk; pk.x = pk2(v[0], v[1]); pk.y = pk2(v[2], v[3]); pk.z = pk2(v[4], v[5]); pk.w = pk2(v[6], v[7]);
                bfr[s2] = __builtin_bit_cast(bf16x8, pk);
            }
            f32x4 acc[4];
#pragma unroll
            for (int rho = 0; rho < 4; ++rho) { acc[rho] = (f32x4){0.f, 0.f, 0.f, 0.f};
#pragma unroll
                for (int s2 = 0; s2 < 2; ++s2) acc[rho] = __builtin_amdgcn_mfma_f32_16x16x32_bf16(af[rho][s2], bfr[s2], acc[rho], 0, 0, 0); }
            if (!isw) {
                v4u o0, o1;
                o0.x = pk2(acc[0].x, acc[0].y); o0.y = pk2(acc[0].z, acc[0].w); o0.z = pk2(acc[1].x, acc[1].y); o0.w = pk2(acc[1].z, acc[1].w);
                o1.x = pk2(acc[2].x, acc[2].y); o1.y = pk2(acc[2].z, acc[2].w); o1.z = pk2(acc[3].x, acc[3].y); o1.w = pk2(acc[3].z, acc[3].w);
                v4u* d = (v4u*)(UF + (size_t)(2 * (wave & 3) + sig) * 1024 + lane * 16);
                st16_wt(d, o0); st16_wt(d + 1, o1);
            } else {
#pragma unroll
                for (int rho = 0; rho < 4; ++rho)
#pragma unroll
                    for (int i = 0; i < 4; ++i) wst[(16 * rho + 4 * g + i) * 136 + jj] = (bf16)f2bf(-acc[rho][i]);
            }
        }
    }
    GL_BAR();
    {
        const LAS bf16* wst = (const LAS bf16*)(lds + GL_SOL + 17408 + 9216);
        bf16* WN = (bf16*)(ws + WS_WN) + (size_t)item * 8192;
#pragma unroll
        for (int r = 0; r < 2; ++r) {
            const int id = tid + 512 * r, c = id >> 4, gam = id & 15, s32 = gam >> 2, g = gam & 3;
            const v2u lo = *(const LAS v2u*)(wst + c * 136 + 32 * s32 + 4 * g), hi = *(const LAS v2u*)(wst + c * 136 + 32 * s32 + 16 + 4 * g);
            v4u o; o.x = lo.x; o.y = lo.y; o.z = hi.x; o.w = hi.y;
            st16_wt(WN + c * 128 + 8 * gam, o);
        }
    }
    asm volatile("s_waitcnt vmcnt(0)" ::: "memory");
    GL_BAR();
    if (tid == 0) { unsigned fb = __builtin_bit_cast(unsigned, sek[64]); if (fb == 0u) fb = 1u;
        __hip_atomic_store((unsigned*)(ws + WS_CTL) + CW_GFLAG + item, fb, __ATOMIC_RELAXED, __HIP_MEMORY_SCOPE_AGENT); }
    GL_BAR();
}

constexpr int LL_XCB = 68608;
static_assert(LL_XCB + 64 * 1040 <= MISC_OFF, "lru_local LDS map");
__device__ __forceinline__ float expm1_small(float x) {
    const float p = x * (1.0f + x * (0.5f + x * (0.16666667f + x * (0.041666668f + x * 0.008333334f))));
    return (x > -0.25f) ? p : (__expf(x) - 1.0f);
}
__device__ __forceinline__ void lru_local_item(const Params& P, LAS unsigned char* lds, int lt, int tid, int lane, int wave) {
    unsigned char* ws = P.ws;
    asm volatile("" : "+v"(tid));
    const int b = lt >> 7, n = lt & 127, t0 = b * SEQ + n * 64;
    LAS bf16* rawx = (LAS bf16*)lds;
    LAS bf16* xcb = (LAS bf16*)(lds + LL_XCB);
    const bf16* XR = (const bf16*)(ws + WS_XR);
    {
        v4u pr[9];
#pragma unroll
        for (int r = 0; r < 9; ++r) { const int id = tid + 512 * r, row = id >> 6, ck = id & 63, s = n * 64 + row - 3;
            pr[r] = (v4u){0u, 0u, 0u, 0u};
            if (id < 67 * 64 && s >= 0) pr[r] = *(const v4u*)(XR + (size_t)(b * SEQ + s) * 512 + ck * 8); }
#pragma unroll
        for (int r = 0; r < 9; ++r) { const int id = tid + 512 * r; if (id < 67 * 64) *(LAS v4u*)(rawx + id * 8) = pr[r]; }
    }
    GL_BAR();
    {
        const int chg = tid & 63, tseg = tid >> 6, ch0 = chg * 8;
        float w[4][8], cb[8];
#pragma unroll
        for (int j = 0; j < 4; ++j) { const f32x4 a = *(const f32x4*)(P.lru_conv_w + j * 512 + ch0), c = *(const f32x4*)(P.lru_conv_w + j * 512 + ch0 + 4);
            w[j][0] = a.x; w[j][1] = a.y; w[j][2] = a.z; w[j][3] = a.w; w[j][4] = c.x; w[j][5] = c.y; w[j][6] = c.z; w[j][7] = c.w; }
        { const f32x4 a = *(const f32x4*)(P.lru_conv_b + ch0), c = *(const f32x4*)(P.lru_conv_b + ch0 + 4);
          cb[0] = a.x; cb[1] = a.y; cb[2] = a.z; cb[3] = a.w; cb[4] = c.x; cb[5] = c.y; cb[6] = c.z; cb[7] = c.w; }
        v4u xr[11];
#pragma unroll
        for (int r = 0; r < 11; ++r) xr[r] = *(const LAS v4u*)(rawx + (tseg * 8 + r) * 512 + ch0);
#pragma unroll
        for (int tk = 0; tk < 8; ++tk) {
            float y[8];
#pragma unroll
            for (int e = 0; e < 8; ++e) y[e] = cb[e];
#pragma unroll
            for (int j = 0; j < 4; ++j) { const v4u x = xr[tk + j];
                y[0] += w[j][0] * bflo(x.x); y[1] += w[j][1] * bfhi(x.x); y[2] += w[j][2] * bflo(x.y); y[3] += w[j][3] * bfhi(x.y);
                y[4] += w[j][4] * bflo(x.z); y[5] += w[j][5] * bfhi(x.z); y[6] += w[j][6] * bflo(x.w); y[7] += w[j][7] * bfhi(x.w); }
            v4u o; o.x = pk2(y[0], y[1]); o.y = pk2(y[2], y[3]); o.z = pk2(y[4], y[5]); o.w = pk2(y[6], y[7]);
            *(LAS v4u*)(xcb + (tseg * 8 + tk) * 520 + ch0) = o;
        }
    }
    GL_BAR();
    {
        const int g = wave, col = lane & 15, g4 = lane >> 4;
        LAS bf16* AM = (LAS bf16*)(lds + wave * 8192); LAS bf16* BT = AM + 2048;
        const bf16* WT = (const bf16*)(ws + WS_LRUWT) + (size_t)g * 8192;
        bf16x8 Bw[2][4][2];
#pragma unroll
        for (int m = 0; m < 2; ++m)
#pragma unroll
            for (int jt = 0; jt < 4; ++jt)
#pragma unroll
                for (int s2 = 0; s2 < 2; ++s2) Bw[m][jt][s2] = *(const bf16x8*)(WT + m * 4096 + (16 * jt + col) * 64 + 32 * s2 + 8 * g4);
        float cba[4], cbx[4], csp[4];
#pragma unroll
        for (int jt = 0; jt < 4; ++jt) { const int ch = g * 64 + 16 * jt + col; cba[jt] = P.lru_ba[ch]; cbx[jt] = P.lru_bx[ch]; csp[jt] = softplusf_(-P.lru_lambda[ch]); }
        bf16* HLOC = (bf16*)(ws + WS_HLOC); bf16* PCUM = (bf16*)(ws + WS_PCUM);
        const int chs = g * 64 + lane;
        float hst = 0.f, pc = 1.f;
#pragma unroll 1
        for (int half = 0; half < 2; ++half) {
            bf16x8 Af[2][2];
#pragma unroll
            for (int rho = 0; rho < 2; ++rho)
#pragma unroll
                for (int s2 = 0; s2 < 2; ++s2) Af[rho][s2] = *(const LAS bf16x8*)(xcb + (32 * half + 16 * rho + col) * 520 + g * 64 + 32 * s2 + 8 * g4);
#pragma unroll
            for (int jt = 0; jt < 4; ++jt) {
#pragma unroll
                for (int rho = 0; rho < 2; ++rho) {
                    f32x4 ra = (f32x4){0.f, 0.f, 0.f, 0.f}, rx = ra;
#pragma unroll
                    for (int s2 = 0; s2 < 2; ++s2) { ra = __builtin_amdgcn_mfma_f32_16x16x32_bf16(Af[rho][s2], Bw[0][jt][s2], ra, 0, 0, 0); rx = __builtin_amdgcn_mfma_f32_16x16x32_bf16(Af[rho][s2], Bw[1][jt][s2], rx, 0, 0, 0); }
#pragma unroll
                    for (int i = 0; i < 4; ++i) {
                        const int tokl = 16 * rho + 4 * g4 + i, chl = 16 * jt + col;
                        const float r = sigmoidf_(ra[i] + cba[jt]), ig = sigmoidf_(rx[i] + cbx[jt]);
                        const float log_a = -8.0f * r * csp[jt];
                        const float am = -expm1_small(log_a), a = 1.0f - am;
                        const float xo = bf1(xcb[(32 * half + tokl) * 520 + g * 64 + chl]);
                        const float bt = __builtin_amdgcn_sqrtf(fmaxf(am * (1.0f + a), 0.f)) * (ig * xo);
                        AM[tokl * 64 + chl] = (bf16)f2bf(am); BT[tokl * 64 + chl] = (bf16)f2bf(bt);
                    }
                }
            }
            LDS_WAIT(); asm volatile("" ::: "memory");
#pragma unroll 8
            for (int tk = 0; tk < 32; ++tk) {
                const float am = bf1(AM[tk * 64 + lane]), bt = bf1(BT[tk * 64 + lane]);
                hst = (hst - am * hst) + bt; pc = pc - am * pc;
                const size_t o = (size_t)(t0 + 32 * half + tk) * 512 + chs;
                HLOC[o] = (bf16)f2bf(hst); PCUM[o] = (bf16)f2bf(pc);
            }
            LDS_WAIT(); asm volatile("" ::: "memory");
        }
        ((float*)(ws + WS_HEND))[(size_t)lt * 512 + chs] = hst; ((float*)(ws + WS_PEND))[(size_t)lt * 512 + chs] = pc;
    }
    GL_BAR();
}

constexpr int SC_WN = 0, SC_QD = 64 * 272, SC_KD = 2 * 64 * 272, SC_ATT = 2 * 64 * 272 + 128 * 144, SC_BUF = 2 * 64 * 272 + 128 * 144 + 64 * 144;
constexpr int SC_SSQ = 2 * SC_BUF;
__device__ __forceinline__ int sc_lds_off(int id) {
    if (id < 1024) return SC_WN + (id >> 4) * 272 + (id & 15) * 16;
    if (id < 2048) { const int q = id - 1024; return SC_QD + (q >> 4) * 272 + (q & 15) * 16; }
    if (id < 3072) { const int q = id - 2048; return SC_KD + (q >> 3) * 144 + (q & 7) * 16; }
    const int q = id - 3072; return SC_ATT + (q >> 3) * 144 + (q & 7) * 16;
}
__device__ __forceinline__ const v4u* sc_src(const unsigned char* ws, int item, int id) {
    if (id < 1024) return (const v4u*)(ws + WS_WN + (size_t)item * 16384) + id;
    if (id < 2048) return (const v4u*)(ws + WS_QD + (size_t)item * 16384) + (id - 1024);
    if (id < 3072) return (const v4u*)(ws + WS_KD + (size_t)item * 16384) + (id - 2048);
    return (const v4u*)(ws + WS_ATT + (size_t)item * 8192) + (id - 3072);
}
__device__ __forceinline__ bf16x8 pack_b(const f32x4 a, const f32x4 b) {
    v4u r; r.x = pk2(a.x, a.y); r.y = pk2(a.z, a.w); r.z = pk2(b.x, b.y); r.w = pk2(b.z, b.w);
    return __builtin_bit_cast(bf16x8, r);
}
#define SC_BAR() do { asm volatile("s_waitcnt lgkmcnt(0)" ::: "memory"); __builtin_amdgcn_s_barrier(); asm volatile("" ::: "memory"); } while (0)
#define SC_GLD(dst, ptr) asm volatile("global_load_dwordx4 %0, %1, off" : "=v"(dst) : "v"(ptr) : "memory")
#define PIN8(a) asm volatile("" : "+v"(a[0]), "+v"(a[1]), "+v"(a[2]), "+v"(a[3]), "+v"(a[4]), "+v"(a[5]), "+v"(a[6]), "+v"(a[7]))
#define PIN16(a) asm volatile("" : "+v"(a[0]), "+v"(a[1]), "+v"(a[2]), "+v"(a[3]), "+v"(a[4]), "+v"(a[5]), "+v"(a[6]), "+v"(a[7]), "+v"(a[8]), "+v"(a[9]), "+v"(a[10]), "+v"(a[11]), "+v"(a[12]), "+v"(a[13]), "+v"(a[14]), "+v"(a[15]))
constexpr int SCAN_NWC = 2, SCAN_PARTS = 4, SCAN_WGS = 8 * SCAN_PARTS;
constexpr int SC_UFS = 2 * SC_BUF;
constexpr int SC_DECS = SC_UFS + 2 * SCAN_NWC * 2048;
constexpr int SC_OT = SC_DECS + 512;
constexpr int SC_RDY = SC_OT + 2 * 64 * 36 * 4;
constexpr int SC_END = SC_RDY + 64;
static_assert(SC_END <= MISC_OFF, "scan LDS");
#ifndef SCAN_REPS
#define SCAN_REPS 1
#endif
#ifndef SCAN_EXP
#define SCAN_EXP 0
#endif
__device__ __forceinline__ int sc3_lds_off(int id) {
    if (id < 3584) return sc_lds_off(id);
    return SC_UFS + (id - 3584) * 16;
}
__device__ __forceinline__ const v4u* sc3_src(const unsigned char* ws, int item, int id, int part) {
    if (id < 3584) return sc_src(ws, item, id);
    return (const v4u*)(ws + WS_UF + (size_t)item * 16384 + (size_t)(part * SCAN_NWC) * 2048) + (id - 3584);
}
__device__ __forceinline__ void gdn_scan(const Params& P, LAS unsigned char* lds, int sb, int tid, int lane, int wave) {
    const unsigned char* ws = P.ws;
    constexpr int NCH = 128 * SCAN_REPS, NPC = 15;
    const int bh = sb & 7, part = sb >> 3;
    const int b = bh >> 2, h = bh & 3, col = lane & 15, g = lane >> 4;
    const int item0 = bh * 128;
    if (tid == 0) *(volatile LAS unsigned*)(lds + SC_RDY) = 0u;
    SC_BAR();
    if (wave >= 4) {
        constexpr int NP = 15, DEP = 3;
        const int lt = tid - 256;
        const unsigned voff = (unsigned)lt * 16u;
        const int lA = (lt >> 4) * 272 + (lt & 15) * 16, lB = (lt >> 3) * 144 + (lt & 7) * 16, lU = SC_UFS + lt * 16;
        v4u rs[DEP][NP];
#define SC_ISSUE(set, itm) do { const unsigned char* gq_ = ws + (size_t)(itm) * 16384; const unsigned char* ga_ = ws + WS_ATT + (size_t)(itm) * 8192; \
            asm volatile("s_nop 4\n\tglobal_load_dwordx4 %0, %8, %9 sc0 sc1\n\tglobal_load_dwordx4 %1, %8, %10 sc0 sc1\n\tglobal_load_dwordx4 %2, %8, %11 sc0 sc1\n\tglobal_load_dwordx4 %3, %8, %12 sc0 sc1\n\t" \
                         "global_load_dwordx4 %4, %8, %13 sc0 sc1\n\tglobal_load_dwordx4 %5, %8, %14 sc0 sc1\n\tglobal_load_dwordx4 %6, %8, %15 sc0 sc1\n\tglobal_load_dwordx4 %7, %8, %16 sc0 sc1" \
                : "=&v"(rs[set][0]), "=&v"(rs[set][1]), "=&v"(rs[set][2]), "=&v"(rs[set][3]), "=&v"(rs[set][4]), "=&v"(rs[set][5]), "=&v"(rs[set][6]), "=&v"(rs[set][7]) \
                : "v"(voff), "s"(gq_ + WS_WN), "s"(gq_ + WS_WN + 4096), "s"(gq_ + WS_WN + 8192), "s"(gq_ + WS_WN + 12288), \
                  "s"(gq_ + WS_QD), "s"(gq_ + WS_QD + 4096), "s"(gq_ + WS_QD + 8192), "s"(gq_ + WS_QD + 12288) : "memory"); \
            asm volatile("s_nop 4\n\tglobal_load_dwordx4 %0, %7, %8 sc0 sc1\n\tglobal_load_dwordx4 %1, %7, %9 sc0 sc1\n\tglobal_load_dwordx4 %2, %7, %10 sc0 sc1\n\tglobal_load_dwordx4 %3, %7, %11 sc0 sc1\n\t" \
                         "global_load_dwordx4 %4, %7, %12 sc0 sc1\n\tglobal_load_dwordx4 %5, %7, %13 sc0 sc1\n\tglobal_load_dwordx4 %6, %7, %14 sc0 sc1" \
                : "=&v"(rs[set][8]), "=&v"(rs[set][9]), "=&v"(rs[set][10]), "=&v"(rs[set][11]), "=&v"(rs[set][12]), "=&v"(rs[set][13]), "=&v"(rs[set][14]) \
                : "v"(voff), "s"(gq_ + WS_KD), "s"(gq_ + WS_KD + 4096), "s"(gq_ + WS_KD + 8192), "s"(gq_ + WS_KD + 12288), \
                  "s"(ga_), "s"(ga_ + 4096), "s"(gq_ + WS_UF + (size_t)(part * SCAN_NWC) * 2048) : "memory"); } while (0)
#define SC_WAITSET(set, cnt) asm volatile("s_waitcnt " cnt : "+v"(rs[set][0]), "+v"(rs[set][1]), "+v"(rs[set][2]), "+v"(rs[set][3]), "+v"(rs[set][4]), "+v"(rs[set][5]), "+v"(rs[set][6]), "+v"(rs[set][7]), \
            "+v"(rs[set][8]), "+v"(rs[set][9]), "+v"(rs[set][10]), "+v"(rs[set][11]), "+v"(rs[set][12]), "+v"(rs[set][13]), "+v"(rs[set][14]) :: "memory")
#define SC_WRITE(set, par) do { LAS unsigned char* wb_ = lds + (par) * SC_BUF; \
            _Pragma("unroll") for (int r = 0; r < 4; ++r) { *(LAS v4u*)(wb_ + SC_WN + lA + r * (16 * 272)) = rs[set][r]; *(LAS v4u*)(wb_ + SC_QD + lA + r * (16 * 272)) = rs[set][4 + r]; \
                                                          *(LAS v4u*)(wb_ + SC_KD + lB + r * (32 * 144)) = rs[set][8 + r]; } \
            *(LAS v4u*)(wb_ + SC_ATT + lB) = rs[set][12]; *(LAS v4u*)(wb_ + SC_ATT + lB + 32 * 144) = rs[set][13]; \
            *(LAS v4u*)(lds + lU + (par) * (SCAN_NWC * 2048)) = rs[set][14]; } while (0)
#define SC_NEED(c) do { unsigned sp_ = 0; while (*(volatile LAS unsigned*)(lds + SC_RDY) <= (unsigned)(c) && ++sp_ < (1u << 24)) __builtin_amdgcn_s_sleep(2); } while (0)
        SC_NEED(0); SC_ISSUE(0, item0);
        SC_WAITSET(0, "vmcnt(0)"); SC_WRITE(0, 0); SC_WAITSET(0, "lgkmcnt(0)");
        SC_NEED(3); SC_ISSUE(1, item0 + 1); SC_ISSUE(2, item0 + 2); SC_ISSUE(0, item0 + 3);
        SC_BAR();
        int n2 = 0;
#define SC_INTERVAL(set) do { SC_WAITSET(set, "vmcnt(30)"); SC_WRITE(set, (n2 + 1) & 1); SC_WAITSET(set, "lgkmcnt(0)"); if (n2 + 1 + DEP < 128) SC_NEED(n2 + 1 + DEP); SC_ISSUE(set, item0 + ((n2 + 1 + DEP) & 127)); SC_BAR(); ++n2; } while (0)
#pragma unroll 1
        for (int it = 0; it < NCH / 3; ++it) { SC_INTERVAL(1); SC_INTERVAL(2); SC_INTERVAL(0); }
        if (NCH % 3 >= 1) SC_INTERVAL(1);
        if (NCH % 3 >= 2) SC_INTERVAL(2);
        SC_WAITSET(0, "vmcnt(0)"); SC_WAITSET(1, "vmcnt(0)"); SC_WAITSET(2, "vmcnt(0)");
#undef SC_INTERVAL
#undef SC_NEED
#undef SC_WRITE
#undef SC_WAITSET
#undef SC_ISSUE
        return;
    }
    if (wave == 3) {
        const unsigned* flags = (const unsigned*)(ws + WS_CTL) + CW_GFLAG + item0;
        unsigned rdy = 0;
#define SC_POLLSTEP() do { if (rdy < 128u) { const unsigned idx_ = rdy + (unsigned)lane; \
            const unsigned fv_ = (idx_ < 128u) ? __hip_atomic_load(flags + idx_, __ATOMIC_RELAXED, __HIP_MEMORY_SCOPE_AGENT) : 0u; \
            const unsigned long long m_ = __ballot(fv_ != 0u); const unsigned nrun_ = (m_ == ~0ull) ? 64u : (unsigned)__builtin_ctzll(~m_);     \
            if ((unsigned)lane < nrun_) ((LAS float*)(lds + SC_DECS))[idx_] = __builtin_bit_cast(float, fv_); \
            rdy += nrun_; LDS_WAIT(); if (lane == 0) *(volatile LAS unsigned*)(lds + SC_RDY) = rdy; } } while (0)
        { unsigned sp = 0; while (rdy < 4u && ++sp < (1u << 22)) { SC_POLLSTEP(); if (rdy < 4u) __builtin_amdgcn_s_sleep(16); } }
        SC_BAR();
#pragma unroll 1
        for (int n2 = 0; n2 < NCH; ++n2) {
            { const unsigned need = (unsigned)(n2 + 1 + 3) < 128u ? (unsigned)(n2 + 1 + 3) : 127u; unsigned sp = 0;
              while (rdy <= need && rdy < 128u && ++sp < (1u << 22)) { SC_POLLSTEP(); if (rdy <= need) __builtin_amdgcn_s_sleep(8); } }
            if (rdy < 128u && rdy < (unsigned)(n2 & 127) + 16u) SC_POLLSTEP();
            SC_BAR();
        }
#undef SC_POLLSTEP
        return;
    }
    if (wave == 2) {
        const int row = lane;
        bf16* Y = (bf16*)((unsigned char*)P.out + OUT_Y);
        float* SSQG = P.out;
        SC_BAR();
#pragma unroll 1
        for (int n2 = 0; n2 <= NCH; ++n2) {
            if (n2 > 0) {
                const int n = (n2 - 1) & 127, t = b * SEQ + n * 64 + row;
                const LAS float* src = (const LAS float*)(lds + SC_OT + ((n2 - 1) & 1) * (64 * 36 * 4)) + row * 36;
                f32x4 a[8]; float s2 = 0.f;
#pragma unroll
                for (int q = 0; q < 8; ++q) { a[q] = *(const LAS f32x4*)(src + 4 * q); s2 += (a[q].x * a[q].x + a[q].y * a[q].y) + (a[q].z * a[q].z + a[q].w * a[q].w); }
                SSQG[(size_t)t * 32 + h * 8 + part] = s2;
                v4u* d = (v4u*)(Y + (size_t)t * 1024 + h * 128 + 32 * part);
#pragma unroll
                for (int q = 0; q < 4; ++q) { v4u o; o.x = pk2(a[2 * q].x, a[2 * q].y); o.y = pk2(a[2 * q].z, a[2 * q].w); o.z = pk2(a[2 * q + 1].x, a[2 * q + 1].y); o.w = pk2(a[2 * q + 1].z, a[2 * q + 1].w); d[q] = o; }
            }
            if (n2 < NCH) SC_BAR();
        }
        return;
    }
    f32x4 S[8];
#pragma unroll
    for (int i = 0; i < 8; ++i) S[i] = (f32x4){0.f, 0.f, 0.f, 0.f};
    SC_BAR();
#pragma unroll 1
    for (int n2 = 0; n2 < NCH; ++n2) {
        if (SCAN_REPS > 1 && (n2 & 127) == 0) {
#pragma unroll
            for (int i = 0; i < 8; ++i) S[i] = (f32x4){0.f, 0.f, 0.f, 0.f};
        }
        if (SCAN_EXP == 2 && n2 < 128) { SC_BAR(); continue; }
        const int par = n2 & 1;
        LAS unsigned char* buf = lds + par * SC_BUF;
        bf16x8 fA[16], fB[16], fC[16], fD[8];
#pragma unroll
        for (int rho = 0; rho < 4; ++rho)
#pragma unroll
            for (int s = 0; s < 4; ++s) fA[rho * 4 + s] = *(const LAS bf16x8*)(buf + SC_WN + (16 * rho + col) * 272 + (32 * s + 8 * g) * 2);
#pragma unroll
        for (int rho = 0; rho < 4; ++rho)
#pragma unroll
            for (int s = 0; s < 4; ++s) fB[rho * 4 + s] = *(const LAS bf16x8*)(buf + SC_QD + (16 * rho + col) * 272 + (32 * s + 8 * g) * 2);
        const LAS v4u* ufp = (const LAS v4u*)(lds + SC_UFS + par * (SCAN_NWC * 2048) + wave * 2048 + lane * 32);
        const v4u uf0 = ufp[0], uf1 = ufp[1];
        const float dec = ((const LAS float*)(lds + SC_DECS))[n2 & 127];
        bf16x8 Bs[4];
#pragma unroll
        for (int s = 0; s < 4; ++s) Bs[s] = pack_b(S[2 * s], S[2 * s + 1]);
        f32x4 Vn[4], Oc[4];
        Vn[0] = (f32x4){bflo(uf0.x), bfhi(uf0.x), bflo(uf0.y), bfhi(uf0.y)}; Vn[1] = (f32x4){bflo(uf0.z), bfhi(uf0.z), bflo(uf0.w), bfhi(uf0.w)};
        Vn[2] = (f32x4){bflo(uf1.x), bfhi(uf1.x), bflo(uf1.y), bfhi(uf1.y)}; Vn[3] = (f32x4){bflo(uf1.z), bfhi(uf1.z), bflo(uf1.w), bfhi(uf1.w)};
        __builtin_amdgcn_sched_barrier(0);
        PIN16(fA);
#pragma unroll
        for (int s = 0; s < 4; ++s)
#pragma unroll
            for (int rho = 0; rho < 4; ++rho) Vn[rho] = __builtin_amdgcn_mfma_f32_16x16x32_bf16(fA[rho * 4 + s], Bs[s], Vn[rho], 0, 0, 0);
        __builtin_amdgcn_sched_barrier(0);
#pragma unroll
        for (int tau = 0; tau < 8; ++tau)
#pragma unroll
            for (int s = 0; s < 2; ++s) fC[tau * 2 + s] = *(const LAS bf16x8*)(buf + SC_KD + (16 * tau + col) * 144 + (32 * s + 8 * g) * 2);
        __builtin_amdgcn_sched_barrier(0);
        PIN16(fB);
#pragma unroll
        for (int rho = 0; rho < 4; ++rho) Oc[rho] = (f32x4){0.f, 0.f, 0.f, 0.f};
#pragma unroll
        for (int s = 0; s < 4; ++s)
#pragma unroll
            for (int rho = 0; rho < 4; ++rho) Oc[rho] = __builtin_amdgcn_mfma_f32_16x16x32_bf16(fB[rho * 4 + s], Bs[s], Oc[rho], 0, 0, 0);
        __builtin_amdgcn_sched_barrier(0);
#pragma unroll
        for (int rho = 0; rho < 4; ++rho)
#pragma unroll
            for (int s = 0; s < 2; ++s) fD[rho * 2 + s] = *(const LAS bf16x8*)(buf + SC_ATT + (16 * rho + col) * 144 + (32 * s + 8 * g) * 2);
        bf16x8 Bv[2];
        Bv[0] = pack_b(Vn[0], Vn[1]); Bv[1] = pack_b(Vn[2], Vn[3]);
#pragma unroll
        for (int tau = 0; tau < 8; ++tau) S[tau] = S[tau] * dec;
        __builtin_amdgcn_sched_barrier(0);
        PIN16(fC);
#pragma unroll
        for (int s = 0; s < 2; ++s)
#pragma unroll
            for (int tau = 0; tau < 8; ++tau) S[tau] = __builtin_amdgcn_mfma_f32_16x16x32_bf16(fC[tau * 2 + s], Bv[s], S[tau], 0, 0, 0);
        __builtin_amdgcn_sched_barrier(0);
        PIN8(fD);
#pragma unroll
        for (int s = 0; s < 2; ++s)
#pragma unroll
            for (int rho = 0; rho < 4; ++rho) Oc[rho] = __builtin_amdgcn_mfma_f32_16x16x32_bf16(fD[rho * 2 + s], Bv[s], Oc[rho], 0, 0, 0);
        LAS float* ot = (LAS float*)(lds + SC_OT + par * (64 * 36 * 4)) + 16 * wave + col;
#pragma unroll
        for (int rho = 0; rho < 4; ++rho)
#pragma unroll
            for (int i = 0; i < 4; ++i) ot[(16 * rho + 4 * g + i) * 36] = Oc[rho][i];
        SC_BAR();
    }
}

__device__ __forceinline__ void lru_carry(const Params& P, int gwv, int lane) {
    unsigned char* ws = P.ws;
    const int b = gwv >> 3, g = gwv & 7, ch = g * 64 + lane;
    const float* HEND = (const float*)(ws + WS_HEND); const float* PEND = (const float*)(ws + WS_PEND); float* HIN = (float*)(ws + WS_HIN);
    float hin = 0.f;
#pragma unroll 1
    for (int n0 = 0; n0 < 128; n0 += 16) {
        float he[16], pe[16];
#pragma unroll
        for (int i = 0; i < 16; ++i) { const size_t o = (size_t)(b * 128 + n0 + i) * 512 + ch; he[i] = HEND[o]; pe[i] = PEND[o]; }
#pragma unroll
        for (int i = 0; i < 16; ++i) { HIN[(size_t)(b * 128 + n0 + i) * 512 + ch] = hin; hin = he[i] + pe[i] * hin; }
    }
}

__device__ __forceinline__ void cvt_table(const float* src, bf16* dst, size_t n8, size_t wi, size_t nw) {
    for (size_t i = wi; i < n8; i += nw) {
        const f32x4 a = ((const f32x4*)src)[2 * i], c = ((const f32x4*)src)[2 * i + 1];
        v4u o; o.x = pk2(a.x, a.y); o.y = pk2(a.z, a.w); o.z = pk2(c.x, c.y); o.w = pk2(c.z, c.w);
        ((v4u*)dst)[i] = o;
    }
}

__device__ __forceinline__ void lru_combine(const Params& P, size_t wi, size_t nw) {
    unsigned char* ws = P.ws;
    const v4u* HLOC = (const v4u*)(ws + WS_HLOC); const v4u* PCUM = (const v4u*)(ws + WS_PCUM); const v4u* GATE = (const v4u*)(ws + WS_GATE);
    const float* HIN = (const float*)(ws + WS_HIN); bf16* Y = (bf16*)((unsigned char*)P.out + OUT_Y);
    for (size_t i = wi; i < (size_t)T * 64; i += nw) {
        const size_t t = i >> 6; const int ch0 = (int)(i & 63) * 8;
        const v4u hl = HLOC[i], pc = PCUM[i], gt = GATE[i];
        const f32x4 h0 = *(const f32x4*)(HIN + (t >> 6) * 512 + ch0), h1 = *(const f32x4*)(HIN + (t >> 6) * 512 + ch0 + 4);
        float y[8];
        y[0] = (bflo(hl.x) + bflo(pc.x) * h0.x) * gelu_tanh(bflo(gt.x)); y[1] = (bfhi(hl.x) + bfhi(pc.x) * h0.y) * gelu_tanh(bfhi(gt.x));
        y[2] = (bflo(hl.y) + bflo(pc.y) * h0.z) * gelu_tanh(bflo(gt.y)); y[3] = (bfhi(hl.y) + bfhi(pc.y) * h0.w) * gelu_tanh(bfhi(gt.y));
        y[4] = (bflo(hl.z) + bflo(pc.z) * h1.x) * gelu_tanh(bflo(gt.z)); y[5] = (bfhi(hl.z) + bfhi(pc.z) * h1.y) * gelu_tanh(bfhi(gt.z));
        y[6] = (bflo(hl.w) + bflo(pc.w) * h1.z) * gelu_tanh(bflo(gt.w)); y[7] = (bfhi(hl.w) + bfhi(pc.w) * h1.w) * gelu_tanh(bfhi(gt.w));
        v4u o; o.x = pk2(y[0], y[1]); o.y = pk2(y[2], y[3]); o.z = pk2(y[4], y[5]); o.w = pk2(y[6], y[7]);
        *(v4u*)(Y + t * 1024 + 512 + ch0) = o;
    }
}

__device__ __forceinline__ void gdn_gate_norm(const Params& P, size_t wi, size_t nw) {
    unsigned char* ws = P.ws;
    bf16* Y = (bf16*)((unsigned char*)P.out + OUT_Y); const v4u* Z = (const v4u*)(ws + WS_Z); const float* SSQG = P.out;
    for (size_t i = wi; i < (size_t)T * 64; i += nw) {
        const size_t t = i >> 6; const int c0 = (int)(i & 63) * 8, h = c0 >> 7;
        const f32x4 q0 = *(const f32x4*)(SSQG + t * 32 + h * 8);
        const float rstd = rsqrtf(((q0.x + q0.y) + (q0.z + q0.w)) * (1.0f / 128.0f) + 1e-6f);
        const v4u o = *(const v4u*)(Y + t * 1024 + c0), z = Z[i];
        const f32x4 w0 = *(const f32x4*)(P.gdn_norm_w + (c0 & 127)), w1 = *(const f32x4*)(P.gdn_norm_w + (c0 & 127) + 4);
        float y[8];
        y[0] = bflo(o.x) * rstd * w0.x * siluf_(bflo(z.x)); y[1] = bfhi(o.x) * rstd * w0.y * siluf_(bfhi(z.x));
        y[2] = bflo(o.y) * rstd * w0.z * siluf_(bflo(z.y)); y[3] = bfhi(o.y) * rstd * w0.w * siluf_(bfhi(z.y));
        y[4] = bflo(o.z) * rstd * w1.x * siluf_(bflo(z.z)); y[5] = bfhi(o.z) * rstd * w1.y * siluf_(bfhi(z.z));
        y[6] = bflo(o.w) * rstd * w1.z * siluf_(bflo(z.w)); y[7] = bfhi(o.w) * rstd * w1.w * siluf_(bfhi(z.w));
        v4u r; r.x = pk2(y[0], y[1]); r.y = pk2(y[2], y[3]); r.z = pk2(y[4], y[5]); r.w = pk2(y[6], y[7]);
        *(v4u*)(Y + t * 1024 + c0) = r;
    }
}

__device__ __forceinline__ void xattn_stage(LAS unsigned char* lds, const bf16* src, int tid) {
    v4u tmp[16];
    const unsigned voff = (unsigned)tid * 16u;
#pragma unroll
    for (int r = 0; r < 16; ++r) { const unsigned char* sb = (const unsigned char*)src + r * 8192;
        asm volatile("s_nop 4\n\tglobal_load_dwordx4 %0, %1, %2" : "=&v"(tmp[r]) : "v"(voff), "s"(sb) : "memory"); }
    asm volatile("s_waitcnt vmcnt(0)" : "+v"(tmp[0]), "+v"(tmp[1]), "+v"(tmp[2]), "+v"(tmp[3]), "+v"(tmp[4]), "+v"(tmp[5]), "+v"(tmp[6]), "+v"(tmp[7]),
                                        "+v"(tmp[8]), "+v"(tmp[9]), "+v"(tmp[10]), "+v"(tmp[11]), "+v"(tmp[12]), "+v"(tmp[13]), "+v"(tmp[14]), "+v"(tmp[15]) :: "memory");
#pragma unroll
    for (int r = 0; r < 16; ++r) { const int id = tid + 512 * r; *(LAS v4u*)(lds + (id >> 5) * 528 + (id & 31) * 16) = tmp[r]; }
}
__device__ __forceinline__ void xattn_unit(const Params& P, LAS unsigned char* lds, int unit, int tid, int lane, int wave) {
    const unsigned char* ws = P.ws;
    const int h = unit & 3, qb = (unit >> 2) & 63, b = unit >> 8, col = lane & 15, g = lane >> 4;
    const int tw = b * SEQ + qb * 128 + 16 * wave;
    const bf16* Kb = (const bf16*)(ws + WS_KB) + (size_t)((b * 4 + h) * 256) * 256;
    const bf16* Vt = (const bf16*)(ws + WS_VTP) + (size_t)((b * 4 + h) * 256) * 256;
    xattn_stage(lds, Kb, tid);
    __syncthreads();
    const LAS unsigned char* arow = lds + col * 528 + g * 16;
    bf16x8 Bp[1][8]; float inv[1];
#pragma unroll
    for (int ps = 0; ps < 1; ++ps) {
        const bf16* Q = (const bf16*)(ws + WS_Q) + (size_t)(tw + 16 * ps + col) * 1024 + h * 256 + 8 * g;
        bf16x8 Bq[8];
#pragma unroll
        for (int s = 0; s < 8; ++s) Bq[s] = *(const bf16x8*)(Q + 32 * s);
        f32x4 St[16];
        bf16x8 fr[2][8];
#pragma unroll
        for (int s = 0; s < 8; ++s) fr[0][s] = *(const LAS bf16x8*)(arow + 64 * s);
#pragma unroll
        for (int kap = 0; kap < 16; ++kap) {
            if (kap + 1 < 16) {
#pragma unroll
                for (int s = 0; s < 8; ++s) fr[(kap + 1) & 1][s] = *(const LAS bf16x8*)(arow + (16 * (kap + 1)) * 528 + 64 * s);
            }
            __builtin_amdgcn_sched_barrier(0);
            PIN8(fr[kap & 1]);
            f32x4 acc = (f32x4){0.f, 0.f, 0.f, 0.f};
#pragma unroll
            for (int s = 0; s < 8; ++s) acc = __builtin_amdgcn_mfma_f32_16x16x32_bf16(fr[kap & 1][s], Bq[s], acc, 0, 0, 0);
            St[kap] = acc;
            __builtin_amdgcn_sched_barrier(0);
        }
        float mx = -3.0e38f;
#pragma unroll
        for (int kap = 0; kap < 16; ++kap) mx = fmaxf(fmaxf(fmaxf(St[kap].x, St[kap].y), fmaxf(St[kap].z, St[kap].w)), mx);
        mx = fmaxf(mx, __shfl_xor(mx, 16)); mx = fmaxf(mx, __shfl_xor(mx, 32));
        float l = 0.f;
#pragma unroll
        for (int kap = 0; kap < 16; ++kap) { St[kap].x = __expf(St[kap].x - mx); St[kap].y = __expf(St[kap].y - mx); St[kap].z = __expf(St[kap].z - mx); St[kap].w = __expf(St[kap].w - mx);
            l += (St[kap].x + St[kap].y) + (St[kap].z + St[kap].w); }
        l += __shfl_xor(l, 16); l += __shfl_xor(l, 32);
        inv[ps] = 1.0f / l;
#pragma unroll
        for (int s = 0; s < 8; ++s) Bp[ps][s] = pack_b(St[2 * s], St[2 * s + 1]);
    }
    __syncthreads();
    xattn_stage(lds, Vt, tid);
    __syncthreads();
#pragma unroll
    for (int ps = 0; ps < 1; ++ps) {
        bf16* AO = (bf16*)(P.ws + WS_AO) + (size_t)(tw + 16 * ps + col) * 1024 + h * 256 + 4 * g;
        bf16x8 fr[2][8];
#pragma unroll
        for (int s = 0; s < 8; ++s) fr[0][s] = *(const LAS bf16x8*)(arow + 64 * s);
#pragma unroll
        for (int del = 0; del < 16; ++del) {
            if (del + 1 < 16) {
#pragma unroll
                for (int s = 0; s < 8; ++s) fr[(del + 1) & 1][s] = *(const LAS bf16x8*)(arow + (16 * (del + 1)) * 528 + 64 * s);
            }
            __builtin_amdgcn_sched_barrier(0);
            PIN8(fr[del & 1]);
            f32x4 acc = (f32x4){0.f, 0.f, 0.f, 0.f};
#pragma unroll
            for (int s = 0; s < 8; ++s) acc = __builtin_amdgcn_mfma_f32_16x16x32_bf16(fr[del & 1][s], Bp[ps][s], acc, 0, 0, 0);
            v2u o; o.x = pk2(acc.x * inv[ps], acc.y * inv[ps]); o.y = pk2(acc.z * inv[ps], acc.w * inv[ps]);
            *(v2u*)(AO + 16 * del) = o;
            __builtin_amdgcn_sched_barrier(0);
        }
    }
    __syncthreads();
}

__device__ __forceinline__ unsigned key_enc(float f) { const unsigned u = __builtin_bit_cast(unsigned, f); return (u & 0x80000000u) ? ~u : (u | 0x80000000u); }
__device__ __forceinline__ float key_dec(unsigned k) { const unsigned u = (k & 0x80000000u) ? (k & 0x7fffffffu) : ~k; return __builtin_bit_cast(float, u); }
#define TK_CAS(a, b) do { const unsigned hi_ = max(a, b), lo_ = min(a, b); a = hi_; b = lo_; } while (0)
__device__ __forceinline__ void tk_merge16(unsigned (&a)[16]) {
#pragma unroll
    for (int j = 8; j > 0; j >>= 1)
#pragma unroll
        for (int i = 0; i < 16; ++i) { const int l = i ^ j; if (l > i) TK_CAS(a[i], a[l]); }
}
__device__ __forceinline__ void tk_sort16(unsigned (&a)[16]) {
#pragma unroll
    for (int k = 2; k <= 16; k <<= 1)
#pragma unroll
        for (int j = k >> 1; j > 0; j >>= 1)
#pragma unroll
            for (int i = 0; i < 16; ++i) { const int l = i ^ j; if (l > i) { if ((i & k) == 0) TK_CAS(a[i], a[l]); else TK_CAS(a[l], a[i]); } }
}
__device__ __forceinline__ void tk_top16_merge(unsigned (&L)[16], const unsigned (&G)[16]) {
#pragma unroll
    for (int i = 0; i < 16; ++i) L[i] = max(L[i], G[15 - i]);
    tk_merge16(L);
}
__device__ __forceinline__ void tk_pair_merge(unsigned (&L)[16]) {
    unsigned Pp[16];
#pragma unroll
    for (int i = 0; i < 16; ++i) Pp[i] = (unsigned)__builtin_amdgcn_update_dpp(0, (int)L[i], 0xB1, 0xF, 0xF, true);
    tk_top16_merge(L, Pp);
}
__device__ __forceinline__ void peer_topk_rows(const Params& P, LAS unsigned char* lds, int rowbase, int tid) {
    const unsigned char* ws = P.ws;
    typedef _Float16 f16x8 __attribute__((ext_vector_type(8)));
    const int rl = tid >> 1, hf = tid & 1, grow = rowbase + rl, t = grow >> 3, h = grow & 7;
    const _Float16* SC = (const _Float16*)(ws + WS_PQ) + (size_t)t * 2048 + h * 256 + 64 * hf;
    f16x8 raw[2][8];
#pragma unroll
    for (int p = 0; p < 2; ++p)
#pragma unroll
        for (int q = 0; q < 8; ++q) raw[p][q] = *(const f16x8*)(SC + p * 128 + 8 * q);
    unsigned L1[16], L2[16];
#pragma unroll
    for (int p = 0; p < 2; ++p) {
        unsigned L[16];
#pragma unroll
        for (int grp = 0; grp < 4; ++grp) {
            unsigned G[16];
#pragma unroll
            for (int e = 0; e < 16; ++e) G[e] = (key_enc((float)raw[p][2 * grp + (e >> 3)][e & 7]) & ~127u) | (unsigned)(127 - (64 * hf + 16 * grp + e));
            tk_sort16(G);
            if (grp == 0) {
#pragma unroll
                for (int i = 0; i < 16; ++i) L[i] = G[i];
            } else tk_top16_merge(L, G);
        }
        tk_pair_merge(L);
#pragma unroll
        for (int i = 0; i < 16; ++i) { if (p == 0) L1[i] = L[i]; else L2[i] = L[i]; }
    }
    {
        float v1[16], v2[16];
        LAS int* il = (LAS int*)lds + rl * 33;
#pragma unroll
        for (int q = 0; q < 16; ++q) { v1[q] = key_dec((L1[q] & ~127u) | 64u); v2[q] = key_dec((L2[q] & ~127u) | 64u); }
        if (hf == 0) {
#pragma unroll
            for (int q = 0; q < 16; ++q) { il[q] = 127 - (int)(L1[q] & 127u); il[16 + q] = 127 - (int)(L2[q] & 127u); }
        }
        unsigned C[16], D[16];
        float w1[8];
        const unsigned hf16 = (unsigned)hf * 16u, evenmask = (unsigned)hf - 1u;
#pragma unroll
        for (int k = 0; k < 8; ++k) w1[k] = __builtin_bit_cast(float, (__builtin_bit_cast(unsigned, v1[2 * k]) & evenmask) | (__builtin_bit_cast(unsigned, v1[2 * k + 1]) & ~evenmask));
#define TK_SLOT(dst, k, bq, valid_odd) do { const unsigned pos_ = (unsigned)(16 * (2 * (k)) + (bq)) + hf16; unsigned kv_ = (key_enc(w1[k] + v2[bq]) & ~255u) | (255u - pos_); if (!(valid_odd)) kv_ &= evenmask; dst = kv_; } while (0)
        TK_SLOT(C[0], 0, 0, true);
        TK_SLOT(C[1], 0, 1, true);
        TK_SLOT(C[2], 0, 2, true);
        TK_SLOT(C[3], 0, 3, true);
        TK_SLOT(C[4], 0, 4, true);
        TK_SLOT(C[5], 0, 5, true);
        TK_SLOT(C[6], 0, 6, true);
        TK_SLOT(C[7], 0, 7, true);
        TK_SLOT(C[8], 0, 8, false);
        TK_SLOT(C[9], 0, 9, false);
        TK_SLOT(C[10], 0, 10, false);
        TK_SLOT(C[11], 0, 11, false);
        TK_SLOT(C[12], 0, 12, false);
        TK_SLOT(C[13], 0, 13, false);
        TK_SLOT(C[14], 0, 14, false);
        TK_SLOT(C[15], 0, 15, false);
        TK_SLOT(D[0], 1, 0, true);
        TK_SLOT(D[1], 1, 1, true);
        TK_SLOT(D[2], 1, 2, true);
        TK_SLOT(D[3], 1, 3, true);
        TK_SLOT(D[4], 1, 4, false);
        TK_SLOT(D[5], 2, 0, true);
        TK_SLOT(D[6], 2, 1, true);
        TK_SLOT(D[7], 2, 2, false);
        TK_SLOT(D[8], 3, 0, true);
        TK_SLOT(D[9], 3, 1, true);
        TK_SLOT(D[10], 4, 0, true);
        TK_SLOT(D[11], 5, 0, true);
        TK_SLOT(D[12], 6, 0, true);
        TK_SLOT(D[13], 7, 0, true);
        D[14] = 0u; D[15] = 0u;
#undef TK_SLOT
        tk_sort16(C); tk_sort16(D); tk_top16_merge(C, D); tk_pair_merge(C);
        LDS_WAIT(); asm volatile("" ::: "memory");
        float best[16], e[16], sum = 0.f;
#pragma unroll
        for (int q = 0; q < 16; ++q) { best[q] = key_dec((C[q] & ~255u) | 128u); e[q] = __expf(best[q] - best[0]); sum += e[q]; }
        const float inv = __builtin_amdgcn_rcpf(sum);
        int* IDX = (int*)(P.ws + WS_IDX) + (size_t)grow * 16 + 8 * hf; float* GW = (float*)(P.ws + WS_GW) + (size_t)grow * 16 + 8 * hf;
#pragma unroll
        for (int q = 0; q < 8; ++q) {
            const unsigned c = (C[q] & evenmask) | (C[8 + q] & ~evenmask);
            const float ev = __builtin_bit_cast(float, (__builtin_bit_cast(unsigned, e[q]) & evenmask) | (__builtin_bit_cast(unsigned, e[8 + q]) & ~evenmask));
            const unsigned pos = 255u - (c & 255u);
            IDX[q] = il[pos >> 4] * 128 + il[16 + (pos & 15u)]; GW[q] = ev * inv;
        }
    }
    LDS_WAIT(); asm volatile("" ::: "memory");
}

__device__ __forceinline__ void peer_topk_wave(const Params& P, LAS int* ilw, LAS unsigned* oute, LAS float* outg, int tbase, int lane) {
    const unsigned char* ws = P.ws;
    typedef _Float16 f16x8 __attribute__((ext_vector_type(8)));
    const int rl = lane >> 1, hf = lane & 1, t = tbase + (rl >> 3), h = rl & 7;
    const _Float16* SC = (const _Float16*)(ws + WS_PQ) + (size_t)t * 2048 + h * 256 + 64 * hf;
    f16x8 raw[2][8];
#pragma unroll
    for (int p = 0; p < 2; ++p)
#pragma unroll
        for (int q = 0; q < 8; ++q) raw[p][q] = *(const f16x8*)(SC + p * 128 + 8 * q);
    unsigned L1[16], L2[16];
#pragma unroll
    for (int p = 0; p < 2; ++p) {
        unsigned L[16];
#pragma unroll
        for (int grp = 0; grp < 4; ++grp) {
            unsigned G[16];
#pragma unroll
            for (int e = 0; e < 16; ++e) G[e] = (key_enc((float)raw[p][2 * grp + (e >> 3)][e & 7]) & ~127u) | (unsigned)(127 - (64 * hf + 16 * grp + e));
            tk_sort16(G);
            if (grp == 0) {
#pragma unroll
                for (int i = 0; i < 16; ++i) L[i] = G[i];
            } else tk_top16_merge(L, G);
        }
        tk_pair_merge(L);
#pragma unroll
        for (int i = 0; i < 16; ++i) { if (p == 0) L1[i] = L[i]; else L2[i] = L[i]; }
    }
    {
        float v1[16], v2[16];
        LAS int* il = ilw + rl * 33;
#pragma unroll
        for (int q = 0; q < 16; ++q) { v1[q] = key_dec((L1[q] & ~127u) | 64u); v2[q] = key_dec((L2[q] & ~127u) | 64u); }
        if (hf == 0) {
#pragma unroll
            for (int q = 0; q < 16; ++q) { il[q] = 127 - (int)(L1[q] & 127u); il[16 + q] = 127 - (int)(L2[q] & 127u); }
        }
        unsigned C[16], D[16];
        float w1[8];
        const unsigned hf16 = (unsigned)hf * 16u, evenmask = (unsigned)hf - 1u;
#pragma unroll
        for (int k = 0; k < 8; ++k) w1[k] = __builtin_bit_cast(float, (__builtin_bit_cast(unsigned, v1[2 * k]) & evenmask) | (__builtin_bit_cast(unsigned, v1[2 * k + 1]) & ~evenmask));
#define TK_SLOT(dst, k, bq, valid_odd) do { const unsigned pos_ = (unsigned)(16 * (2 * (k)) + (bq)) + hf16; unsigned kv_ = (key_enc(w1[k] + v2[bq]) & ~255u) | (255u - pos_); if (!(valid_odd)) kv_ &= evenmask; dst = kv_; } while (0)
        TK_SLOT(C[0], 0, 0, true);
        TK_SLOT(C[1], 0, 1, true);
        TK_SLOT(C[2], 0, 2, true);
        TK_SLOT(C[3], 0, 3, true);
        TK_SLOT(C[4], 0, 4, true);
        TK_SLOT(C[5], 0, 5, true);
        TK_SLOT(C[6], 0, 6, true);
        TK_SLOT(C[7], 0, 7, true);
        TK_SLOT(C[8], 0, 8, false);
        TK_SLOT(C[9], 0, 9, false);
        TK_SLOT(C[10], 0, 10, false);
        TK_SLOT(C[11], 0, 11, false);
        TK_SLOT(C[12], 0, 12, false);
        TK_SLOT(C[13], 0, 13, false);
        TK_SLOT(C[14], 0, 14, false);
        TK_SLOT(C[15], 0, 15, false);
        TK_SLOT(D[0], 1, 0, true);
        TK_SLOT(D[1], 1, 1, true);
        TK_SLOT(D[2], 1, 2, true);
        TK_SLOT(D[3], 1, 3, true);
        TK_SLOT(D[4], 1, 4, false);
        TK_SLOT(D[5], 2, 0, true);
        TK_SLOT(D[6], 2, 1, true);
        TK_SLOT(D[7], 2, 2, false);
        TK_SLOT(D[8], 3, 0, true);
        TK_SLOT(D[9], 3, 1, true);
        TK_SLOT(D[10], 4, 0, true);
        TK_SLOT(D[11], 5, 0, true);
        TK_SLOT(D[12], 6, 0, true);
        TK_SLOT(D[13], 7, 0, true);
        D[14] = 0u; D[15] = 0u;
#undef TK_SLOT
        tk_sort16(C); tk_sort16(D); tk_top16_merge(C, D); tk_pair_merge(C);
        LDS_WAIT(); asm volatile("" ::: "memory");
        float best[16], e[16], sum = 0.f;
#pragma unroll
        for (int q = 0; q < 16; ++q) { best[q] = key_dec((C[q] & ~255u) | 128u); e[q] = __expf(best[q] - best[0]); sum += e[q]; }
        const float inv = __builtin_amdgcn_rcpf(sum);
        LAS unsigned* IDX = oute + rl * 16 + 8 * hf; LAS float* GW = outg + rl * 16 + 8 * hf;
#pragma unroll
        for (int q = 0; q < 8; ++q) {
            const unsigned c = (C[q] & evenmask) | (C[8 + q] & ~evenmask);
            const float ev = __builtin_bit_cast(float, (__builtin_bit_cast(unsigned, e[q]) & evenmask) | (__builtin_bit_cast(unsigned, e[8 + q]) & ~evenmask));
            const unsigned pos = 255u - (c & 255u);
            IDX[q] = (unsigned)(il[pos >> 4] * 128 + il[16 + (pos & 15u)]); GW[q] = ev * inv;
        }
    }
    LDS_WAIT(); asm volatile("" ::: "memory");
}

typedef float f32x2 __attribute__((ext_vector_type(2)));
__device__ __forceinline__ unsigned q8(float x) { return (unsigned)(int)rintf(x) & 0xffu; }
__device__ __forceinline__ void cvt_table_fp8(const float* src, unsigned char* dst, float* scl, int gw, int ngw, int lane) {
    for (int row = gw; row < 16384; row += ngw) {
        const f32x4* sp = (const f32x4*)(src + (size_t)row * 1024 + 16 * lane);
        const f32x4 a0 = sp[0], a1 = sp[1], a2 = sp[2], a3 = sp[3];
        float m = fmaxf(fmaxf(fmaxf(fabsf(a0.x), fabsf(a0.y)), fmaxf(fabsf(a0.z), fabsf(a0.w))), fmaxf(fmaxf(fabsf(a1.x), fabsf(a1.y)), fmaxf(fabsf(a1.z), fabsf(a1.w))));
        m = fmaxf(m, fmaxf(fmaxf(fmaxf(fabsf(a2.x), fabsf(a2.y)), fmaxf(fabsf(a2.z), fabsf(a2.w))), fmaxf(fmaxf(fabsf(a3.x), fabsf(a3.y)), fmaxf(fabsf(a3.z), fabsf(a3.w)))));
#pragma unroll
        for (int o = 1; o < 64; o <<= 1) m = fmaxf(m, __shfl_xor(m, o));
        m = fmaxf(m, 1e-30f);
        const float q = 127.0f / m;
        v4u o;
        o.x = q8(a0.x * q) | (q8(a0.y * q) << 8) | (q8(a0.z * q) << 16) | (q8(a0.w * q) << 24);
        o.y = q8(a1.x * q) | (q8(a1.y * q) << 8) | (q8(a1.z * q) << 16) | (q8(a1.w * q) << 24);
        o.z = q8(a2.x * q) | (q8(a2.y * q) << 8) | (q8(a2.z * q) << 16) | (q8(a2.w * q) << 24);
        o.w = q8(a3.x * q) | (q8(a3.y * q) << 8) | (q8(a3.z * q) << 16) | (q8(a3.w * q) << 24);
        *(v4u*)(dst + (size_t)row * 1024 + 16 * lane) = o;
        if (lane == 0) scl[row] = m * (1.0f / 127.0f);
    }
}
__device__ __forceinline__ int row16_sum_i(int v) {
    v += __builtin_amdgcn_update_dpp(0, v, 0xB1, 0xF, 0xF, true);
    v += __builtin_amdgcn_update_dpp(0, v, 0x4E, 0xF, 0xF, true);
    v += __builtin_amdgcn_update_dpp(0, v, 0x141, 0xF, 0xF, true);
    v += __builtin_amdgcn_update_dpp(0, v, 0x140, 0xF, 0xF, true);
    return v;
}
constexpr int PE_NT = 4, PE_NR = 16, PE_SH = 10, PE_DEP = 3;
constexpr int PE_TOK_W = 128 * 3 + 20;
constexpr int PE_ENT_W = 272 * 4;
constexpr int PE_WAVE_W = PE_NT * PE_TOK_W + PE_ENT_W + 32 * 33 + 2 * PE_NT * 128;
static_assert(8 * PE_WAVE_W * 4 <= MISC_OFF && PE_NR * PE_NT == 64, "peer LDS / batch-list geometry");
#define PE_LD(dst, voff_, sbase_) asm volatile("s_nop 4\n\tglobal_load_dwordx4 %0, %1, %2" : "=&v"(dst) : "v"(voff_), "s"(sbase_) : "memory")
__device__ __forceinline__ void peer_pass(const Params& P, LAS unsigned char* lds, int tbase, int lane, int wave, float* dstbase, int emask = 0x3fff) {
    asm volatile("v_mbcnt_lo_u32_b32 %0, -1, 0\n\tv_mbcnt_hi_u32_b32 %0, -1, %0" : "=v"(lane));
    {
        LAS unsigned* lw0 = (LAS unsigned*)(lds) + wave * PE_WAVE_W + PE_NT * PE_TOK_W + PE_ENT_W;
        peer_topk_wave(P, (LAS int*)lw0, lw0 + 32 * 33, (LAS float*)(lw0 + 32 * 33 + PE_NT * 128), tbase, lane);
        LDS_WAIT(); asm volatile("" : "+v"(lane), "+s"(tbase) :: "memory");
    }
    const unsigned char* ws = P.ws;
    const unsigned char* UB8 = ws + WS_UB; const unsigned char* VB8 = ws + WS_VB;
    const float* USC = (const float*)(ws + WS_USC); const float* VSC = (const float*)(ws + WS_VSC);
    f32x2 acc[PE_NT][8];
    LAS unsigned* lw = (LAS unsigned*)(lds) + wave * PE_WAVE_W;
    LAS unsigned* ents = lw + PE_NT * PE_TOK_W;
    const unsigned voff = (unsigned)lane * 16u;
    LAS unsigned* upe = ents + PE_ENT_W + 32 * 33; LAS float* upg = (LAS float*)(upe + PE_NT * 128);
    LAS unsigned* hql = ents + PE_ENT_W;
#pragma unroll
    for (int j = 0; j < PE_NT; ++j) {
        const int t = tbase + j;
        const v4u* xrow = (const v4u*)((const bf16*)(ws + WS_XB) + (size_t)t * 1024 + 16 * lane);
        const v4u xa = xrow[0], xc = xrow[1];
        const f32x4 xvv[4] = {(f32x4){bflo(xa.x), bfhi(xa.x), bflo(xa.y), bfhi(xa.y)}, (f32x4){bflo(xa.z), bfhi(xa.z), bflo(xa.w), bfhi(xa.w)},
                              (f32x4){bflo(xc.x), bfhi(xc.x), bflo(xc.y), bfhi(xc.y)}, (f32x4){bflo(xc.z), bfhi(xc.z), bflo(xc.w), bfhi(xc.w)}};
        const float rstd2 = rsqrtf(((const float*)(ws + WS_SSQ2))[t] * (1.0f / 1024.0f) + 1e-6f);
        f32x4 hv[4]; float hm = 0.f;
#pragma unroll
        for (int i = 0; i < 4; ++i) { const f32x4 xv = xvv[i]; const f32x4 w = ((const f32x4*)(P.norm_ffn_w + 16 * lane))[i];
            hv[i] = (f32x4){xv.x * rstd2 * w.x, xv.y * rstd2 * w.y, xv.z * rstd2 * w.z, xv.w * rstd2 * w.w};
            hm = fmaxf(hm, fmaxf(fmaxf(fabsf(hv[i].x), fabsf(hv[i].y)), fmaxf(fabsf(hv[i].z), fabsf(hv[i].w)))); }
#pragma unroll
        for (int o = 1; o < 64; o <<= 1) hm = fmaxf(hm, __shfl_xor(hm, o));
        hm = fmaxf(hm, 1e-30f);
        const float hqs = 127.0f / hm, hs = hm * (1.0f / 127.0f);
        { unsigned hqv[4];
#pragma unroll
          for (int i = 0; i < 4; ++i) hqv[i] = q8(hv[i].x * hqs) | (q8(hv[i].y * hqs) << 8) | (q8(hv[i].z * hqs) << 16) | (q8(hv[i].w * hqs) << 24);
          *(LAS v4u*)(hql + (j * 64 + lane) * 4) = (v4u){hqv[0], hqv[1], hqv[2], hqv[3]}; }
#pragma unroll
        for (int i = 0; i < 8; ++i) acc[j][i] = (f32x2){0.f, 0.f};
        const int e0 = (int)upe[j * 128 + 2 * lane] & emask, e1 = (int)upe[j * 128 + 2 * lane + 1] & emask;
        const float g0 = upg[j * 128 + 2 * lane] * VSC[e0], g1 = upg[j * 128 + 2 * lane + 1] * VSC[e1];
        const float u0 = USC[e0] * hs, u1 = USC[e1] * hs;
        const int rev = (tbase >= T / 2) ? (PE_NR - 1) : 0;
        const int b0 = (e0 >> PE_SH) ^ rev, b1 = (e1 >> PE_SH) ^ rev;
        LAS unsigned* lt = lw + j * PE_TOK_W;
        int run = 0;
#pragma unroll 1
        for (int bk = 0; bk < PE_NR; ++bk) {
            const unsigned long long m0 = __ballot(b0 == bk), m1 = __ballot(b1 == bk);
            const int c0 = __popcll(m0), c1 = __popcll(m1);
            const unsigned long long lower = (1ull << lane) - 1ull;
            if (b0 == bk) { const int p = run + __popcll(m0 & lower); lt[p] = (unsigned)e0; lt[128 + p] = __builtin_bit_cast(unsigned, g0); lt[256 + p] = __builtin_bit_cast(unsigned, u0); }
            if (b1 == bk) { const int p = run + c0 + __popcll(m1 & lower); lt[p] = (unsigned)e1; lt[128 + p] = __builtin_bit_cast(unsigned, g1); lt[256 + p] = __builtin_bit_cast(unsigned, u1); }
            if (lane == 0) lt[384 + bk] = (unsigned)run;
            run += c0 + c1;
        }
        if (lane == 0) lt[384 + PE_NR] = 128u;
        asm volatile("" ::: "memory");
    }
    LDS_WAIT(); asm volatile("" ::: "memory");
    int nb;
    {
        const int rd = lane >> 2, j = (rd & 1) ? 3 - (lane & 3) : (lane & 3);
        const LAS unsigned* lt = lw + j * PE_TOK_W;
        const int n0 = (int)lt[384 + rd], n1 = (int)lt[384 + rd + 1];
        const int nbl = (n1 - n0 + 3) >> 2;
        int inc = nbl;
#pragma unroll
        for (int off = 1; off < 64; off <<= 1) { const int tv = __shfl_up(inc, off); if (lane >= off) inc += tv; }
        nb = __builtin_amdgcn_readlane(inc, 63);
        const int ofs = inc - nbl;
#pragma unroll 1
        for (int q = 0; q < nbl; ++q) { const int i0 = n0 + 4 * q, c = (n1 - i0) < 4 ? (n1 - i0) : 4;
            const unsigned e0 = lt[i0], e1 = lt[i0 + (c > 1 ? 1 : c - 1)], e2 = lt[i0 + (c > 2 ? 2 : c - 1)], e3 = lt[i0 + (c > 3 ? 3 : c - 1)];
            *(LAS v4u*)(ents + 4 * (ofs + q)) = (v4u){e0 | (((unsigned)j | ((unsigned)c << 2) | ((unsigned)i0 << 5)) << 14), e1, e2, e3}; }
        if (lane < 2 * PE_DEP) *(LAS v4u*)(ents + 4 * (nb + lane)) = (v4u){0u, 0u, 0u, 0u};
    }
    LDS_WAIT(); asm volatile("" ::: "memory");
    v4u ru[PE_DEP][4], rv[PE_DEP][4];
#define PE_LDO(dst, vo_, sbase_) asm volatile("global_load_dwordx4 %0, %1, %2" : "=&v"(dst) : "v"(vo_), "s"(sbase_) : "memory")
#define PE_ISSUE(S, rec_) do { const unsigned e0_ = (rec_).x & 0x3fffu; \
        { const unsigned vo_ = (e0_ << 10) + voff; PE_LDO(ru[S][0], vo_, UB8); PE_LDO(rv[S][0], vo_, VB8); } \
        { const unsigned vo_ = ((rec_).y << 10) + voff; PE_LDO(ru[S][1], vo_, UB8); PE_LDO(rv[S][1], vo_, VB8); } \
        { const unsigned vo_ = ((rec_).z << 10) + voff; PE_LDO(ru[S][2], vo_, UB8); PE_LDO(rv[S][2], vo_, VB8); } \
        { const unsigned vo_ = ((rec_).w << 10) + voff; PE_LDO(ru[S][3], vo_, UB8); PE_LDO(rv[S][3], vo_, VB8); } } while (0)
#define PE_WAIT8(S, cntstr) asm volatile("s_waitcnt " cntstr : "+v"(ru[S][0]), "+v"(ru[S][1]), "+v"(ru[S][2]), "+v"(ru[S][3]), "+v"(rv[S][0]), "+v"(rv[S][1]), "+v"(rv[S][2]), "+v"(rv[S][3]) :: "memory")
#define PE_UDOTS(S) asm("v_dot4_i32_i8 %0, %4, %20, 0\n\tv_dot4_i32_i8 %1, %8, %20, 0\n\tv_dot4_i32_i8 %2, %12, %20, 0\n\tv_dot4_i32_i8 %3, %16, %20, 0\n\t" \
                        "v_dot4_i32_i8 %0, %5, %21, %0\n\tv_dot4_i32_i8 %1, %9, %21, %1\n\tv_dot4_i32_i8 %2, %13, %21, %2\n\tv_dot4_i32_i8 %3, %17, %21, %3\n\t" \
                        "v_dot4_i32_i8 %0, %6, %22, %0\n\tv_dot4_i32_i8 %1, %10, %22, %1\n\tv_dot4_i32_i8 %2, %14, %22, %2\n\tv_dot4_i32_i8 %3, %18, %22, %3\n\t" \
                        "v_dot4_i32_i8 %0, %7, %23, %0\n\tv_dot4_i32_i8 %1, %11, %23, %1\n\tv_dot4_i32_i8 %2, %15, %23, %2\n\tv_dot4_i32_i8 %3, %19, %23, %3\n\ts_nop 2" \
        : "=&v"(d_[0]), "=&v"(d_[1]), "=&v"(d_[2]), "=&v"(d_[3]) \
        : "v"(ru[S][0].x), "v"(ru[S][0].y), "v"(ru[S][0].z), "v"(ru[S][0].w), "v"(ru[S][1].x), "v"(ru[S][1].y), "v"(ru[S][1].z), "v"(ru[S][1].w), \
          "v"(ru[S][2].x), "v"(ru[S][2].y), "v"(ru[S][2].z), "v"(ru[S][2].w), "v"(ru[S][3].x), "v"(ru[S][3].y), "v"(ru[S][3].z), "v"(ru[S][3].w), \
          "v"(hcur.x), "v"(hcur.y), "v"(hcur.z), "v"(hcur.w))
#define PE_UDOTS_SAFE(S) do { _Pragma("unroll") for (int k_ = 0; k_ < 4; ++k_) { int s_ = __builtin_amdgcn_sdot4((int)ru[S][k_].x, (int)hcur.x, 0, false); s_ = __builtin_amdgcn_sdot4((int)ru[S][k_].y, (int)hcur.y, s_, false); \
            s_ = __builtin_amdgcn_sdot4((int)ru[S][k_].z, (int)hcur.z, s_, false); s_ = __builtin_amdgcn_sdot4((int)ru[S][k_].w, (int)hcur.w, s_, false); d_[k_] = s_; } } while (0)
#define PE_VDOTS_SAFE(f0, f1, f2, f3, b0, b1, b2, b3, w) do { f0 = (float)__builtin_amdgcn_sdot4((int)(b0), (int)(w), 0, false); f1 = (float)__builtin_amdgcn_sdot4((int)(b1), (int)(w), 0, false); \
            f2 = (float)__builtin_amdgcn_sdot4((int)(b2), (int)(w), 0, false); f3 = (float)__builtin_amdgcn_sdot4((int)(b3), (int)(w), 0, false); } while (0)
#define PE_VDOTS(f0, f1, f2, f3, b0, b1, b2, b3, w) asm("v_dot4_i32_i8 %0, %4, %8, 0\n\tv_dot4_i32_i8 %1, %5, %8, 0\n\tv_dot4_i32_i8 %2, %6, %8, 0\n\tv_dot4_i32_i8 %3, %7, %8, 0\n\t" \
                        "v_cvt_f32_i32_e32 %0, %0\n\tv_cvt_f32_i32_e32 %1, %1\n\tv_cvt_f32_i32_e32 %2, %2\n\tv_cvt_f32_i32_e32 %3, %3" \
        : "=&v"(f0), "=&v"(f1), "=&v"(f2), "=&v"(f3) : "v"(b0), "v"(b1), "v"(b2), "v"(b3), "v"(w))
#define PE_COMPUTE_B(S, c_, i_, j_, SG) do { const LAS unsigned* lt_ = lw + (j_) * PE_TOK_W; \
        const int myk_ = lane >> 4; \
        float gsc_ = __builtin_bit_cast(float, lt_[128 + i_ + myk_]), usc_ = __builtin_bit_cast(float, lt_[256 + i_ + myk_]);     \
        int d_[4]; \
        PE_UDOTS(S); \
        int r1_; \
        { const v2u p02_ = __builtin_amdgcn_permlane32_swap((unsigned)d_[0], (unsigned)d_[2], false, false), p13_ = __builtin_amdgcn_permlane32_swap((unsigned)d_[1], (unsigned)d_[3], false, false); \
          const v2u q_ = __builtin_amdgcn_permlane16_swap(p02_.x + p02_.y, p13_.x + p13_.y, false, false); r1_ = row16_sum_i((int)(q_.x + q_.y)); }     \
        float act_; \
        { const float x_ = (float)r1_ * usc_, e_ = __builtin_amdgcn_exp2f(x_ * __builtin_fmaf(x_ * x_, -0.10294324f, -2.3022082f));     \
          act_ = x_ * __builtin_amdgcn_rcpf(1.0f + e_) * gsc_; act_ = (myk_ < c_) ? act_ : 0.f; } \
        float wm_; \
        { unsigned wmu_ = __builtin_bit_cast(unsigned, act_) & 0x7fffffffu;                 \
          v2u t_ = __builtin_amdgcn_permlane32_swap(wmu_, wmu_, false, false); wmu_ = t_.x > t_.y ? t_.x : t_.y; \
          t_ = __builtin_amdgcn_permlane16_swap(wmu_, wmu_, false, false); wmu_ = t_.x > t_.y ? t_.x : t_.y; \
          wm_ = fmaxf(__builtin_bit_cast(float, wmu_), 1e-30f); } \
        const float wq_ = 127.0f * __builtin_amdgcn_rcpf(wm_), ws_ = (SG) * wm_ * (1.0f / 127.0f); \
        unsigned w4u_ = (__builtin_bit_cast(unsigned, __builtin_fmaf(act_, wq_, 12582912.0f)) & 0xffu) << (8 * myk_); \
        { v2u t_ = __builtin_amdgcn_permlane32_swap(w4u_, w4u_, false, false); w4u_ = t_.x | t_.y; t_ = __builtin_amdgcn_permlane16_swap(w4u_, w4u_, false, false); w4u_ = t_.x | t_.y; } \
        const f32x2 ws2_ = (f32x2){ws_, ws_}; \
        _Pragma("unroll") for (int m_ = 0; m_ < 4; ++m_) { \
            const unsigned R0_ = rv[S][0][m_], R1_ = rv[S][1][m_], R2_ = rv[S][2][m_], R3_ = rv[S][3][m_]; \
            const unsigned X_ = __builtin_amdgcn_perm(R1_, R0_, 0x05010400u), Y_ = __builtin_amdgcn_perm(R1_, R0_, 0x07030602u), Z_ = __builtin_amdgcn_perm(R3_, R2_, 0x05010400u), W_ = __builtin_amdgcn_perm(R3_, R2_, 0x07030602u); \
            float t0_, t1_, t2_, t3_; \
            const unsigned b0_ = __builtin_amdgcn_perm(Z_, X_, 0x05040100u), b1_ = __builtin_amdgcn_perm(Z_, X_, 0x07060302u), b2_ = __builtin_amdgcn_perm(W_, Y_, 0x05040100u), b3_ = __builtin_amdgcn_perm(W_, Y_, 0x07060302u); \
            PE_VDOTS(t0_, t1_, t2_, t3_, b0_, b1_, b2_, b3_, w4u_); \
            cur[2 * m_] = __builtin_elementwise_fma((f32x2){t0_, t1_}, ws2_, cur[2 * m_]); \
            cur[2 * m_ + 1] = __builtin_elementwise_fma((f32x2){t2_, t3_}, ws2_, cur[2 * m_ + 1]); } } while (0)
#define PE_FLUSH() do { _Pragma("unroll") for (int J_ = 0; J_ < PE_NT; ++J_) { const float sel_ = (jcur == J_) ? 1.0f : 0.0f; const f32x2 sel2_ = (f32x2){sel_, sel_};     \
            _Pragma("unroll") for (int i_ = 0; i_ < 8; ++i_) acc[J_][i_] = __builtin_elementwise_fma(cur[i_], sel2_, acc[J_][i_]); } \
        _Pragma("unroll") for (int i_ = 0; i_ < 8; ++i_) cur[i_] = (f32x2){0.f, 0.f}; } while (0)
#define PE_COMPUTE_S(S, entv, SG) do { const unsigned en_ = (entv) >> 14; const int jj_ = (int)(en_ & 3u), cc_ = (int)((en_ >> 2) & 7u), ii_ = (int)(en_ >> 5); \
        if (cc_ > 0) { if (jj_ != jcur) { PE_FLUSH(); jcur = jj_; hcur = *(const LAS v4u*)(hql + (jj_ * 64 + lane) * 4); } \
                       PE_COMPUTE_B(S, cc_, ii_, jj_, SG); } } while (0)
#ifdef PE_VALU3
#define PE_COMPUTE(S, entv) do { PE_COMPUTE_S(S, entv, 1.0f); PE_WAIT8(S, "vmcnt(16)"); PE_COMPUTE_S(S, entv, -1.0f); PE_WAIT8(S, "vmcnt(16)"); PE_COMPUTE_S(S, entv, 1.0f); } while (0)
#else
#define PE_COMPUTE(S, entv) PE_COMPUTE_S(S, entv, 1.0f)
#endif
    {
        unsigned er[PE_DEP];
#pragma unroll
        for (int q = 0; q < PE_DEP; ++q) { const v4u rec = *(const LAS v4u*)(ents + 4 * q); er[q] = __builtin_amdgcn_readfirstlane(rec.x); PE_ISSUE(q, rec); }
        f32x2 cur[8];
#pragma unroll
        for (int i = 0; i < 8; ++i) cur[i] = (f32x2){0.f, 0.f};
        int jcur = (int)((er[0] >> 14) & 3u);
        v4u hcur = *(const LAS v4u*)(hql + (jcur * 64 + lane) * 4);
        v4u nrec = *(const LAS v4u*)(ents + 4 * PE_DEP);
#pragma unroll 1
        for (int bi = 0; bi < nb; bi += PE_DEP) {
#pragma unroll
            for (int q = 0; q < PE_DEP; ++q) {
                PE_WAIT8(q, "vmcnt(16)");
                PE_COMPUTE(q, er[q]);
                er[q] = __builtin_amdgcn_readfirstlane(nrec.x);
                PE_ISSUE(q, nrec);
                nrec = *(const LAS v4u*)(ents + 4 * (bi + q + PE_DEP + 1));
            }
        }
#pragma unroll
        for (int q = 0; q < PE_DEP; ++q) PE_WAIT8(q, "vmcnt(0)");
        PE_FLUSH();
    }
#undef PE_COMPUTE
#undef PE_COMPUTE_S
#undef PE_COMPUTE_B
#undef PE_FLUSH
#undef PE_WAIT8
#undef PE_ISSUE
#undef PE_LDO
#undef PE_UDOTS
#undef PE_VDOTS
    asm volatile("v_mbcnt_lo_u32_b32 %0, -1, 0\n\tv_mbcnt_hi_u32_b32 %0, -1, %0" : "=v"(lane)); asm volatile("" : "+s"(tbase));
#pragma unroll
    for (int j = 0; j < PE_NT; ++j) {
        const int t = tbase + j;
        float ss = 0.f; f32x4 xo[4];
        { const v4u* xrow = (const v4u*)((const bf16*)(ws + WS_XB) + (size_t)t * 1024 + 16 * lane); const v4u xa = xrow[0], xc = xrow[1];
          xo[0] = (f32x4){bflo(xa.x), bfhi(xa.x), bflo(xa.y), bfhi(xa.y)}; xo[1] = (f32x4){bflo(xa.z), bfhi(xa.z), bflo(xa.w), bfhi(xa.w)};
          xo[2] = (f32x4){bflo(xc.x), bfhi(xc.x), bflo(xc.y), bfhi(xc.y)}; xo[3] = (f32x4){bflo(xc.z), bfhi(xc.z), bflo(xc.w), bfhi(xc.w)}; }
#pragma unroll
        for (int i = 0; i < 4; ++i) { xo[i].x += acc[j][2 * i].x; xo[i].y += acc[j][2 * i].y; xo[i].z += acc[j][2 * i + 1].x; xo[i].w += acc[j][2 * i + 1].y;
            ss += (xo[i].x * xo[i].x + xo[i].y * xo[i].y) + (xo[i].z * xo[i].z + xo[i].w * xo[i].w); }
        const float rstd3 = rsqrtf(wave_sum(ss) * (1.0f / 1024.0f) + 1e-6f);
        float* orow = dstbase + (size_t)t * 1024 + 16 * lane;
#pragma unroll
        for (int i = 0; i < 4; ++i) { const f32x4 w = ((const f32x4*)(P.norm_final_w + 16 * lane))[i];
            ((f32x4*)orow)[i] = (f32x4){xo[i].x * rstd3 * w.x, xo[i].y * rstd3 * w.y, xo[i].z * rstd3 * w.z, xo[i].w * rstd3 * w.w}; }
    }
    LDS_WAIT(); asm volatile("s_waitcnt vmcnt(0)" ::: "memory");
}


#ifndef TWICE_MASK
#define TWICE_MASK 0
#endif
struct TwiceOrder { pg8::StaticOrder S; int per, reps;
    __device__ bool next(int i, pg8::Unit& u) const { if (i >= per * reps) return false; return S.next(i % per, u); }
    __device__ __forceinline__ void a_ready(const pg8::Unit&) const {} __device__ __forceinline__ void done(const pg8::Unit&) const {} };
template <class B> __device__ __forceinline__ bool rep_again(volatile LAS unsigned* MISC, B& bar) {
    __syncthreads(); const unsigned c = MISC[20]; __syncthreads();
    if (threadIdx.x == 0) MISC[20] = c ^ 1u;
    __syncthreads();
    if (c == 0u) { xcd_barrier(bar); return true; }
    return false;
}
__global__ void __launch_bounds__(NWAVES * 64, 2) hybrid_fwd(Params P) {
    extern __shared__ __attribute__((aligned(16))) unsigned char lds_raw[];
    LAS unsigned char* lds = (LAS unsigned char*)lds_raw;
    volatile LAS unsigned* MISC = (volatile LAS unsigned*)(lds + MISC_OFF);
    const int tid = threadIdx.x, lane = tid & 63, wave = __builtin_amdgcn_readfirstlane(tid >> 6);
    const int G = gridDim.x, bx = blockIdx.x;
    const int vcu = (G % 8 == 0) ? (bx % 8) * (G / 8) + bx / 8 : bx;
    unsigned char* ws = P.ws;
    for (int u = tid; u < 64; u += NWAVES * 64) MISC[u] = 0u;
    __syncthreads();
    XcdBarrier bar; bar.bar = (unsigned*)(ws + WS_CTL) + CW_BAR; bar.x = 0; bar.st = nullptr;
    if (!MK_PER_PHASE) bar = xcd_barrier_post((unsigned*)(ws + WS_CTL) + CW_BAR, MISC + 8);
    const int lo = P.ph_lo, hi = P.ph_hi;
#ifndef PHASE_MASK
#define PHASE_MASK 0xFFF
#endif
#define IN(k) (((PHASE_MASK >> (k)) & 1) && lo <= (k) && (k) < hi)
#define SEAM(k) do { if (IN(k) && IN((k) + 1)) xcd_barrier(bar); } while (0)
#ifndef REP_MASK
#define REP_MASK 0
#endif
#ifndef PE_EXP_MASK
#define PE_EXP_MASK 0x3fff
#endif
#define REPS(k) for (bool again_ = true; again_; again_ = (((REP_MASK >> (k)) & 1) ? rep_again(MISC, bar) : false))
    using namespace pg8;
    bf16* XB = (bf16*)(ws + WS_XB);

    if (IN(0)) REPS(0) { p0_prologue(P, lds, tid, lane, wave, vcu, G); }
    SEAM(0);
    if (IN(1)) REPS(1) {
        { Gemm gm{XB, (const bf16_t*)(ws + WS_WIN), T, 3072, 1024}; StaticOrder S; S.init(T, 3072, G, bx);
          EpiBf16Rs E{(bf16_t*)(ws + WS_QKV), 1536, 6, (bf16_t*)(ws + WS_XR), 512, (size_t)T * 512, nullptr, 1.0f};
          gemm_phase<EpiBf16Rs, StaticOrder, PG8_ALIGN, PG8_SP2>(lds, gm, S, E); }
    }
    SEAM(1);
    if (IN(3)) REPS(3) {
        if (bx < SCAN_WGS) gdn_scan(P, lds, bx, tid, lane, wave);
        else {
            const int wk = bx - SCAN_WGS, NWK = G - SCAN_WGS;
            unsigned* lcnt = (unsigned*)(ws + WS_CTL) + CW_LRUCNT;
            for (int q = wk; q < 1024; q += NWK) gdn_local_item(P, lds, (q & 7) * 128 + (q >> 3), tid);
            if (wk < 16) {
                struct OneUnit { int pm, pn; __device__ bool next(int i, Unit& u) const { if (i > 0) return false; u.pm = pm; u.pn = pn; return true; }
                                 __device__ void a_ready(const Unit&) const {} __device__ void done(const Unit&) const {} };
                Gemm gm{(const bf16_t*)(ws + WS_MEMN), (const bf16_t*)(ws + WS_WKV), 512, 2048, 1024}; OneUnit S{wk >> 3, wk & 7};
                EpiKV E{(bf16_t*)(ws + WS_KB), (bf16_t*)(ws + WS_VTP)};
                gemm_phase<EpiKV, OneUnit, PG8_ALIGN, PG8_SP2>(lds, gm, S, E);
            }
            unsigned ndone = 0;
            for (int lt = wk; lt < 256; lt += NWK) { lru_local_item(P, lds, lt, tid, lane, wave); ++ndone; }
            asm volatile("s_waitcnt vmcnt(0)" ::: "memory");
            __syncthreads();
            if (tid == 0 && ndone) { __builtin_amdgcn_fence(__ATOMIC_RELEASE, "agent"); asm volatile("s_waitcnt vmcnt(0)" ::: "memory");
                                     __hip_atomic_fetch_add(lcnt, ndone, __ATOMIC_RELAXED, __HIP_MEMORY_SCOPE_AGENT); }
            if (wk == 16 || wk == 17) {
                if (tid == 0) { unsigned sp = 0;
                    while (__hip_atomic_load(lcnt, __ATOMIC_RELAXED, __HIP_MEMORY_SCOPE_AGENT) < 256u) { __builtin_amdgcn_s_sleep(8); if (++sp > (1u << 22)) break; }
                    __builtin_amdgcn_fence(__ATOMIC_ACQUIRE, "agent"); asm volatile("s_waitcnt vmcnt(0)" ::: "memory"); }
                __syncthreads();
                lru_carry(P, (wk - 16) * NWAVES + wave, lane);
                asm volatile("s_waitcnt vmcnt(0)" ::: "memory");
                __syncthreads();
                if (tid == 0) { __builtin_amdgcn_fence(__ATOMIC_RELEASE, "agent"); asm volatile("s_waitcnt vmcnt(0)" ::: "memory");
                                __hip_atomic_fetch_add(lcnt + 64, 1u, __ATOMIC_RELAXED, __HIP_MEMORY_SCOPE_AGENT); }
            } else {
                const int w2 = (wk < 16 ? wk : wk - 2), N2 = NWK - 2;
                cvt_table_fp8(P.peer_v, ws + WS_VB, (float*)(ws + WS_VSC), w2 * NWAVES + wave, N2 * NWAVES, lane);
                late_weight_prep(P, lds, lane, wave, w2 * NWAVES + wave, N2 * NWAVES);
                if (tid == 0) { unsigned sp = 0;
                    while (__hip_atomic_load(lcnt + 64, __ATOMIC_RELAXED, __HIP_MEMORY_SCOPE_AGENT) < 2u) { __builtin_amdgcn_s_sleep(8); if (++sp > (1u << 22)) break; }
                    __builtin_amdgcn_fence(__ATOMIC_ACQUIRE, "agent"); asm volatile("s_waitcnt vmcnt(0)" ::: "memory"); }
                __syncthreads();
                lru_combine(P, (size_t)w2 * (NWAVES * 64) + tid, (size_t)N2 * (NWAVES * 64));
            }
        }
    }
    SEAM(3);
    if (IN(4)) REPS(4) {
        gdn_gate_norm(P, (size_t)bx * (NWAVES * 64) + tid, (size_t)G * (NWAVES * 64));
        cvt_table_fp8(P.peer_u, ws + WS_UB, (float*)(ws + WS_USC), bx * NWAVES + wave, G * NWAVES, lane);
    }
    SEAM(4);
    if (IN(5)) {
        Gemm gm{(const bf16_t*)((const unsigned char*)P.out + OUT_Y), (const bf16_t*)(ws + WS_WOUT), T, 1024, 1024}; StaticOrder S; S.init(T, 1024, G, bx);
        EpiResidBf<true> E{P.x, XB, (float*)(ws + WS_SSQ1)};
        gemm_phase<EpiResidBf<true>, StaticOrder, PG8_ALIGN, PG8_SP2>(lds, gm, S, E);
    }
    SEAM(5);
    if (IN(6)) REPS(6) {
        Gemm gm{XB, (const bf16_t*)(ws + WS_WQ), T, 1024, 1024};
        EpiBf16Rs E{(bf16_t*)(ws + WS_Q), 1024, 4, nullptr, 256, 0, (const float*)(ws + WS_SSQ1), 0.0625f};
#if (TWICE_MASK >> 6) & 1
        { TwiceOrder S; S.S.init(T, 1024, G, bx); S.per = 1; S.reps = 2;
          gemm_phase<EpiBf16Rs, TwiceOrder, PG8_ALIGN, PG8_SP2>(lds, gm, S, E); }
#else
        { StaticOrder S; S.init(T, 1024, G, bx);
          gemm_phase<EpiBf16Rs, StaticOrder, PG8_ALIGN, PG8_SP2>(lds, gm, S, E); }
#endif
        Unit u;
        { const int wgid = (bx & 7) * 32 + (bx >> 3); u.pm = (wgid >> 5) * 8 + (wgid & 7); u.pn = (wgid & 31) >> 3; }
        if (G == 256) {
            asm volatile("s_waitcnt vmcnt(0)" ::: "memory");
            __syncthreads();
            const int b = u.pm >> 5, qb0 = (u.pm & 31) * 2, h = u.pn;
#pragma unroll 1
            for (int qq = 0; qq < (((TWICE_MASK >> 7) & 1) ? 4 : 2); ++qq) xattn_unit(P, lds, (b << 8) | ((qb0 + (qq & 1)) << 2) | h, tid, lane, wave);
        }
    }
    if (IN(7)) REPS(7) { }
    SEAM(7);
    if (IN(8)) {
        Gemm gm{(const bf16_t*)(ws + WS_AO), (const bf16_t*)(ws + WS_WO), T, 1024, 1024}; StaticOrder S; S.init(T, 1024, G, bx);
        EpiResidBf<false> E{nullptr, XB, (float*)(ws + WS_SSQ2)};
        gemm_phase<EpiResidBf<false>, StaticOrder, PG8_ALIGN, PG8_SP2>(lds, gm, S, E);
    }
    SEAM(8);
    if (IN(9)) REPS(9) {
        Gemm gm{XB, (const bf16_t*)(ws + WS_PWQ), T, 2048, 1024};
        EpiF16Rs E{(_Float16*)(ws + WS_PQ), 2048, (const float*)(ws + WS_SSQ2)};
#if (TWICE_MASK >> 9) & 1
        TwiceOrder S; S.S.init(T, 2048, G, bx); S.per = 2; S.reps = 2;
        gemm_phase<EpiF16Rs, TwiceOrder, PG8_ALIGN, PG8_SP2>(lds, gm, S, E);
#else
        StaticOrder S; S.init(T, 2048, G, bx);
        gemm_phase<EpiF16Rs, StaticOrder, PG8_ALIGN, PG8_SP2>(lds, gm, S, E);
#endif
    }
    SEAM(9);
    if (IN(10)) REPS(10) {
    }
    if (IN(11)) REPS(11) {
#if (TWICE_MASK >> 11) & 1
        for (int it = 0; it < 4; ++it) { const int tb = (bx * NWAVES + wave) * PE_NT + (it >> 1) * (G * NWAVES * PE_NT); if (tb < T) peer_pass(P, lds, tb, lane, wave, P.out, (it & 1) ? 0x3fff : PE_EXP_MASK); }
#else
#ifndef PE_PASS_BARRIER
#define PE_PASS_BARRIER 0
#endif
        for (int tb = (bx * NWAVES + wave) * PE_NT, np = 0; tb < T; tb += G * NWAVES * PE_NT, ++np) {
            if (PE_PASS_BARRIER && np > 0 && (T % (G * NWAVES * PE_NT)) == 0) xcd_barrier(bar);
            peer_pass(P, lds, tb, lane, wave, P.out);
        }
#endif
    }
#undef IN
#undef SEAM
}

extern "C" void kernel_launch(void* const* d_in, const int* in_sizes, int n_in, void* d_out, int out_size, void* d_ws, size_t ws_size, hipStream_t stream) {
    static int grid = 0;
    if (grid == 0) {
        if (n_in != 27 || in_sizes[0] != T * D || out_size != T * D || ws_size < WS_END) {
            fprintf(stderr, "kernel_launch: unexpected shapes (n_in %d, in0 %d, out %d, ws %zu); nothing launched\n", n_in, n_in > 0 ? in_sizes[0] : -1, out_size, ws_size); grid = -1; return; }
        int dev = 0, cus = 0, per_cu = 0;
        if (hipGetDevice(&dev) != hipSuccess || hipDeviceGetAttribute(&cus, hipDeviceAttributeMultiprocessorCount, dev) != hipSuccess) { grid = -1; return; }
        if (hipFuncSetAttribute((const void*)hybrid_fwd, hipFuncAttributeMaxDynamicSharedMemorySize, LDS_BYTES) != hipSuccess) { fprintf(stderr, "kernel_launch: hipFuncSetAttribute failed\n"); grid = -1; return; }
        if (hipOccupancyMaxActiveBlocksPerMultiprocessor(&per_cu, (const void*)hybrid_fwd, NWAVES * 64, LDS_BYTES) != hipSuccess || per_cu < 1)
            fprintf(stderr, "kernel_launch: note: occupancy query reports %d workgroups per CU\n", per_cu);
        (void)hipGetLastError();
        grid = cus;
        if (grid != 256) fprintf(stderr, "kernel_launch: %d CUs (built for 256)\n", grid);
    }
    if (grid < 0) return;
    if (hipMemsetAsync((char*)d_ws + WS_CTL, 0, CTL_ZERO_BYTES, stream) != hipSuccess) { fprintf(stderr, "kernel_launch: hipMemsetAsync failed\n"); return; }
    Params p{};
    const float** pp = (const float**)&p;
    for (int i = 0; i < 27; ++i) pp[i] = (const float*)d_in[i];
    p.out = (float*)d_out; p.ws = (unsigned char*)d_ws;
#if MK_PER_PHASE
    for (int k = 0; k < N_PHASES; ++k) { p.ph_lo = k; p.ph_hi = k + 1; hipLaunchKernelGGL(hybrid_fwd, dim3(grid), dim3(NWAVES * 64), LDS_BYTES, stream, p); }
#else
    p.ph_lo = 0; p.ph_hi = N_PHASES;
    hipLaunchKernelGGL(hybrid_fwd, dim3(grid), dim3(NWAVES * 64), LDS_BYTES, stream, p);
#endif
    const hipError_t le = hipPeekAtLastError();
    if (le != hipSuccess) fprintf(stderr, "kernel_launch: launch failed: %s\n", hipGetErrorName(le));
}
```

```cpp
#include <hip/hip_runtime.h>
#include <cstdio>
#include <cstdint>
namespace pg8 {
#define PG8_LAS __attribute__((address_space(3)))
typedef unsigned short bf16_t;
typedef short bf16x8 __attribute__((ext_vector_type(8)));
typedef float f32x4 __attribute__((ext_vector_type(4)));
typedef unsigned u32x4 __attribute__((ext_vector_type(4)));
constexpr int BM = 256, BK = 64, HALF = 128, HTB = HALF * BK * 2  , STAGE_BYTES = 8 * HTB, NXCD = 8, WGM = 8;

__host__ __device__ __forceinline__ int lds_byte(int r, int c) { const int st = (r >> 4) * 2 + (c >> 5), rr = r & 15, cc = c & 31, ob = rr * 64 + cc * 2; return st * 1024 + (ob ^ (((ob >> 9) & 1) << 5)); }
__host__ __device__ __forceinline__ void stage_rc(int b, int& R, int& C) { const int st = b / 1024, sb = b % 1024, swz = sb ^ (((sb >> 9) & 1) << 5); R = (st >> 1) * 16 + swz / 64; C = (st & 1) * 32 + (swz % 64) / 2; }
__host__ __device__ __forceinline__ int perm32(int rho) { const int n = rho >> 4, i = rho & 15; return 8 * (i >> 2) + 4 * n + (i & 3); }

struct Unit { int pm, pn; };
struct Gemm { const bf16_t* A; const bf16_t* Bt; int M, N, K; };

struct StaticOrder {
    int nM, nN, nwg, G, c;
    __host__ __device__ void init(int M, int N, int G_, int c_) { nM = M / BM; nN = N / BM; nwg = nM * nN; G = G_; c = c_; }
    __host__ __device__ bool next(int i, Unit& u) const {
        const long L = (long)i * G + c; if (L >= nwg) return false;
        int wgid = (int)L; { const int q = nwg / NXCD, r = nwg % NXCD, xcd = wgid % NXCD, off = wgid / NXCD; wgid = (xcd < r ? xcd * (q + 1) : r * (q + 1) + (xcd - r) * q) + off; }
        const int nig = WGM * nN, gid = wgid / nig, fm = gid * WGM, gsz = (nM - fm) < WGM ? (nM - fm) : WGM;
        u.pm = fm + ((wgid % nig) % gsz); u.pn = (wgid % nig) / gsz; return true;
    }
    __device__ __forceinline__ void a_ready(const Unit&) const {}
    __device__ __forceinline__ void done(const Unit&) const {}
};

__device__ __forceinline__ unsigned cvt_pk_bf16(float lo, float hi) { unsigned r; asm volatile("v_cvt_pk_bf16_f32 %0, %1, %2" : "=v"(r) : "v"(lo), "v"(hi)); return r; }
template <class Epi, class Sched, bool ALIGN_EPI = false, bool SP2 = false>
__device__ __forceinline__ void gemm_phase(PG8_LAS unsigned char* lds, const Gemm g, const Sched& S, const Epi& E) {
    const int tid = threadIdx.x, wid = __builtin_amdgcn_readfirstlane(tid >> 6), lane = tid & 63, wr = wid >> 2, wc = wid & 3, fr = lane & 15, fq = lane >> 4;
    const int K = g.K, nt = K / BK;
    unsigned voffA[2], voffB[2];
#pragma unroll
    for (int i = 0; i < 2; ++i) { int R, C; stage_rc(tid * 16 + i * 8192, R, C); const int Rb = Epi::PERM ? ((R & ~31) + perm32(R & 31)) : R;
        voffA[i] = (unsigned)(R * K + C) * 2u; voffB[i] = (unsigned)(Rb * K + C) * 2u; }
    const size_t kstep = (size_t)(BK * 2);
    const size_t hstep = (size_t)HALF * K * 2;
    const size_t tstep = 2 * hstep;
    const unsigned ldsw = (unsigned)wid * 1024u;
    const int aoff = lds_byte(wr * 64 + fr, fq * 8), boff = lds_byte(wc * 32 + fr, fq * 8);
#define PG8_SA(b, h) (((b) * 2 + (h)) * HTB)
#define PG8_SB(b, h) ((4 + (b) * 2 + (h)) * HTB)
#define PG8_STAGE(bufoff, gbase, voff) do { _Pragma("unroll") for (int _i = 0; _i < 2; ++_i) \
        __builtin_amdgcn_global_load_lds((const unsigned*)((const char*)(gbase) + (voff)[_i]), (PG8_LAS unsigned*)(lds + (bufoff) + ldsw + _i * 8192), 16, 0, 0); } while (0)
#define PG8_LDA(dst, b, h) do { _Pragma("unroll") for (int m = 0; m < 4; ++m) _Pragma("unroll") for (int k = 0; k < 2; ++k) dst[m][k] = *(const PG8_LAS bf16x8*)(lds + PG8_SA(b, h) + aoff + m * 2048 + k * 1024); } while (0)
#define PG8_LDB(dst, b, h) do { _Pragma("unroll") for (int n = 0; n < 2; ++n) _Pragma("unroll") for (int k = 0; k < 2; ++k) dst[n][k] = *(const PG8_LAS bf16x8*)(lds + PG8_SB(b, h) + boff + n * 2048 + k * 1024); } while (0)
#define PG8_MMA(ai, bj, At, Bt) do { __builtin_amdgcn_s_setprio(1); _Pragma("unroll") for (int m = 0; m < 4; ++m) _Pragma("unroll") for (int n = 0; n < 2; ++n) _Pragma("unroll") for (int k = 0; k < 2; ++k) \
        acc[ai][bj][m][n] = __builtin_amdgcn_mfma_f32_16x16x32_bf16(Bt[n][k], At[m][k], acc[ai][bj][m][n], 0, 0, 0); __builtin_amdgcn_s_setprio(0); } while (0)
#define PG8_WAIT_V(n) asm volatile("s_waitcnt vmcnt(" #n ")" ::: "memory")
#define PG8_WAIT_L(n) asm volatile("s_waitcnt lgkmcnt(" #n ")" ::: "memory")
#define PG8_BAR __builtin_amdgcn_s_barrier()
#define PG8_SCHED __builtin_amdgcn_sched_barrier(0)
    Unit cur, nxt; int ui = 0;
    if (!S.next(0, cur)) return;
    f32x4 acc[2][2][4][2];
#pragma unroll
    for (int a = 0; a < 2; ++a)
#pragma unroll
        for (int b = 0; b < 2; ++b)
#pragma unroll
            for (int m = 0; m < 4; ++m)
#pragma unroll
                for (int n = 0; n < 2; ++n) acc[a][b][m][n] = (f32x4){0.f, 0.f, 0.f, 0.f};
    bf16x8 At[4][2], B0[2][2], B1[2][2];
    const char* cA = (const char*)g.A + (size_t)cur.pm * tstep; const char* cB = (const char*)g.Bt + (size_t)cur.pn * tstep;
    S.a_ready(cur);
    if constexpr (SP2) {
        PG8_STAGE(PG8_SB(0, 0), cB, voffB); PG8_STAGE(PG8_SB(0, 1), cB + hstep, voffB); PG8_STAGE(PG8_SA(0, 0), cA, voffA); PG8_STAGE(PG8_SA(0, 1), cA + hstep, voffA);
        if (wr == 1) PG8_BAR;
        PG8_WAIT_V(2); PG8_BAR;
        PG8_STAGE(PG8_SB(1, 0), cB + kstep, voffB); PG8_STAGE(PG8_SA(1, 0), cA + kstep, voffA); PG8_STAGE(PG8_SB(1, 1), cB + hstep + kstep, voffB);
        PG8_WAIT_V(6); PG8_BAR;
    } else {
        PG8_STAGE(PG8_SB(0, 0), cB, voffB); PG8_STAGE(PG8_SA(0, 0), cA, voffA); PG8_STAGE(PG8_SB(0, 1), cB + hstep, voffB); PG8_STAGE(PG8_SA(0, 1), cA + hstep, voffA);
        if (wr == 1) PG8_BAR;
        PG8_WAIT_V(4); PG8_BAR;
        PG8_STAGE(PG8_SB(1, 0), cB + kstep, voffB); PG8_STAGE(PG8_SA(1, 0), cA + kstep, voffA); PG8_STAGE(PG8_SB(1, 1), cB + hstep + kstep, voffB);
        PG8_WAIT_V(6); PG8_BAR;
    }
    for (;;) {
        const bool has_next = S.next(ui + 1, nxt);
        const char* nA = has_next ? (const char*)g.A + (size_t)nxt.pm * tstep : cA; const char* nB = has_next ? (const char*)g.Bt + (size_t)nxt.pn * tstep : cB;
        for (int t = 0; t < nt; t += 2) {
            const bool last = (t == nt - 2);
            const char* a1 = cA + (size_t)(t + 1) * kstep;
            const char* a2 = last ? nA : cA + (size_t)(t + 2) * kstep; const char* b2 = last ? nB : cB + (size_t)(t + 2) * kstep;
            const char* a3 = a2 + kstep; const char* b3 = b2 + kstep;
            if (last && has_next) S.a_ready(nxt);
            if constexpr (SP2) {
            PG8_LDB(B0, 0, 0); PG8_LDB(B1, 0, 1); PG8_SCHED; PG8_LDA(At, 0, 0); PG8_STAGE(PG8_SA(1, 1), a1 + hstep, voffA);
            PG8_WAIT_V(8); PG8_WAIT_L(0); PG8_BAR; PG8_MMA(0, 0, At, B0); PG8_MMA(0, 1, At, B1); PG8_BAR; PG8_SCHED;
            PG8_LDA(At, 0, 1); PG8_STAGE(PG8_SB(0, 0), b2, voffB); PG8_STAGE(PG8_SB(0, 1), b2 + hstep, voffB); PG8_STAGE(PG8_SA(0, 0), a2, voffA);
            PG8_WAIT_V(8); PG8_WAIT_L(0); PG8_BAR; PG8_MMA(1, 0, At, B0); PG8_MMA(1, 1, At, B1); PG8_BAR; PG8_SCHED;
            PG8_LDB(B0, 1, 0); PG8_LDB(B1, 1, 1); PG8_SCHED; PG8_LDA(At, 1, 0); PG8_STAGE(PG8_SA(0, 1), a2 + hstep, voffA);
            PG8_WAIT_V(8); PG8_WAIT_L(0); PG8_BAR; PG8_MMA(0, 0, At, B0); PG8_MMA(0, 1, At, B1); PG8_BAR; PG8_SCHED;
            PG8_LDA(At, 1, 1); PG8_STAGE(PG8_SB(1, 0), b3, voffB); PG8_STAGE(PG8_SB(1, 1), b3 + hstep, voffB); PG8_STAGE(PG8_SA(1, 0), a3, voffA);
            PG8_WAIT_V(8); PG8_WAIT_L(0); PG8_BAR; PG8_MMA(1, 0, At, B0); PG8_MMA(1, 1, At, B1); PG8_BAR; PG8_SCHED;
            } else {
            PG8_LDB(B0, 0, 0); PG8_SCHED; PG8_LDA(At, 0, 0); PG8_STAGE(PG8_SA(1, 1), a1 + hstep, voffA);
            PG8_WAIT_L(8); PG8_BAR; PG8_WAIT_L(0); PG8_MMA(0, 0, At, B0); PG8_BAR; PG8_SCHED;
            PG8_LDB(B1, 0, 1); PG8_STAGE(PG8_SB(0, 0), b2, voffB);
            PG8_BAR; PG8_WAIT_L(0); PG8_MMA(0, 1, At, B1); PG8_BAR;
            PG8_LDA(At, 0, 1); PG8_STAGE(PG8_SA(0, 0), a2, voffA);
            PG8_BAR; PG8_WAIT_L(0); PG8_MMA(1, 0, At, B0); PG8_BAR; PG8_SCHED;
            PG8_STAGE(PG8_SB(0, 1), b2 + hstep, voffB);
            PG8_WAIT_V(6); PG8_BAR; PG8_MMA(1, 1, At, B1); PG8_BAR;
            PG8_LDB(B0, 1, 0); PG8_SCHED; PG8_LDA(At, 1, 0); PG8_STAGE(PG8_SA(0, 1), a2 + hstep, voffA);
            PG8_WAIT_L(8); PG8_BAR; PG8_WAIT_L(0); PG8_MMA(0, 0, At, B0); PG8_BAR; PG8_SCHED;
            PG8_LDB(B1, 1, 1); PG8_STAGE(PG8_SB(1, 0), b3, voffB);
            PG8_BAR; PG8_WAIT_L(0); PG8_MMA(0, 1, At, B1); PG8_BAR;
            PG8_LDA(At, 1, 1); PG8_STAGE(PG8_SA(1, 0), a3, voffA);
            PG8_BAR; PG8_WAIT_L(0); PG8_MMA(1, 0, At, B0); PG8_BAR; PG8_SCHED;
            PG8_STAGE(PG8_SB(1, 1), b3 + hstep, voffB);
            PG8_WAIT_V(6); PG8_BAR; PG8_MMA(1, 1, At, B1); PG8_BAR;
            }
        }
        if constexpr (ALIGN_EPI) { if (wr == 0) PG8_BAR; }
        if constexpr (!Epi::AFTER_DRAIN) { E(acc, cur, wr, wc, fr, fq); S.done(cur); }
        if (!has_next) break;
#pragma unroll
        for (int a = 0; a < 2; ++a)
#pragma unroll
            for (int b = 0; b < 2; ++b)
#pragma unroll
                for (int m = 0; m < 4; ++m)
#pragma unroll
                    for (int n = 0; n < 2; ++n) acc[a][b][m][n] = (f32x4){0.f, 0.f, 0.f, 0.f};
        cur = nxt; cA = nA; cB = nB; ++ui;
        if constexpr (ALIGN_EPI) { if (wr == 1) PG8_BAR; }
    }
    PG8_WAIT_V(0);
    if constexpr (!ALIGN_EPI) { if (wr == 0) PG8_BAR; }
    PG8_BAR;
    if constexpr (Epi::AFTER_DRAIN) { E.fused(acc, cur, wr, wc, fr, fq, lds, wid, lane); S.done(cur); }
#undef PG8_SA
#undef PG8_SB
#undef PG8_STAGE
#undef PG8_LDA
#undef PG8_LDB
#undef PG8_MMA
#undef PG8_WAIT_V
#undef PG8_WAIT_L
#undef PG8_BAR
#undef PG8_SCHED
}
}

namespace pg8 {
__host__ __device__ __forceinline__ int permk(int kl) { return 8 * ((kl & 15) >> 2) + 4 * (kl >> 4) + (kl & 3); }
struct EpiBf16Rs {
    static constexpr bool PERM = true, AFTER_DRAIN = false;
    bf16_t* O0; int ld0; int ntile0; bf16_t* O1; int ld1; size_t stride1; const float* ssq; float cs;
    __device__ __forceinline__ void operator()(const f32x4 (&acc)[2][2][4][2], const Unit& u, int wr, int wc, int fr, int fq) const {
        bf16_t* base; int ld, colt;
        if (u.pn < ntile0) { base = O0; ld = ld0; colt = u.pn * BM; }
        else { const int q = u.pn - ntile0, per = ld1 / BM; base = O1 + (size_t)(q / per) * stride1; ld = ld1; colt = (q % per) * BM; }
        const int row0 = u.pm * BM + wr * 64 + fr, col0 = colt + wc * 32 + 8 * fq;
#pragma unroll
        for (int ai = 0; ai < 2; ++ai)
#pragma unroll
            for (int m = 0; m < 4; ++m) {
                const int row = row0 + ai * HALF + m * 16;
                float sc = cs; if (ssq) sc *= rsqrtf(ssq[row] * (1.0f / 1024.0f) + 1e-6f);
                bf16_t* rowp = base + (size_t)row * ld + col0;
#pragma unroll
                for (int bj = 0; bj < 2; ++bj) { const f32x4 v0 = acc[ai][bj][m][0] * sc, v1 = acc[ai][bj][m][1] * sc;
                    u32x4 w; w.x = cvt_pk_bf16(v0[0], v0[1]); w.y = cvt_pk_bf16(v0[2], v0[3]); w.z = cvt_pk_bf16(v1[0], v1[1]); w.w = cvt_pk_bf16(v1[2], v1[3]);
                    *(u32x4*)(rowp + bj * HALF) = w; } }
    }
};
struct EpiF16Rs {
    static constexpr bool PERM = true, AFTER_DRAIN = false;
    _Float16* O; int ld; const float* ssq;
    __device__ __forceinline__ void operator()(const f32x4 (&acc)[2][2][4][2], const Unit& u, int wr, int wc, int fr, int fq) const {
        typedef _Float16 f16x8 __attribute__((ext_vector_type(8)));
        const int row0 = u.pm * BM + wr * 64 + fr, col0 = u.pn * BM + wc * 32 + 8 * fq;
#pragma unroll
        for (int ai = 0; ai < 2; ++ai)
#pragma unroll
            for (int m = 0; m < 4; ++m) {
                const int row = row0 + ai * HALF + m * 16;
                const float sc = rsqrtf(ssq[row] * (1.0f / 1024.0f) + 1e-6f);
                _Float16* rowp = O + (size_t)row * ld + col0;
#pragma unroll
                for (int bj = 0; bj < 2; ++bj) { const f32x4 v0 = acc[ai][bj][m][0] * sc, v1 = acc[ai][bj][m][1] * sc;
                    f16x8 w; w[0] = (_Float16)v0[0]; w[1] = (_Float16)v0[1]; w[2] = (_Float16)v0[2]; w[3] = (_Float16)v0[3];
                    w[4] = (_Float16)v1[0]; w[5] = (_Float16)v1[1]; w[6] = (_Float16)v1[2]; w[7] = (_Float16)v1[3];
                    *(f16x8*)(rowp + bj * HALF) = w; } }
    }
};
template <bool BASE_F32> struct EpiResidBf {
    static constexpr bool PERM = true, AFTER_DRAIN = false;
    const float* basef; bf16_t* xb; float* ssq;
    __device__ __forceinline__ void operator()(const f32x4 (&acc)[2][2][4][2], const Unit& u, int wr, int wc, int fr, int fq) const {
        const int row0 = u.pm * BM + wr * 64 + fr, col0 = u.pn * BM + wc * 32 + 8 * fq;
#pragma unroll
        for (int ai = 0; ai < 2; ++ai)
#pragma unroll
            for (int m = 0; m < 4; ++m) {
                const int row = row0 + ai * HALF + m * 16; const size_t off = (size_t)row * 1024 + col0; float s = 0.f;
#pragma unroll
                for (int bj = 0; bj < 2; ++bj) { const size_t o2 = off + bj * HALF;
                    f32x4 b0, b1;
                    if (BASE_F32) { b0 = *(const f32x4*)(basef + o2); b1 = *(const f32x4*)(basef + o2 + 4); }
                    else { const u32x4 p = *(const u32x4*)(xb + o2);
                        b0 = (f32x4){__builtin_bit_cast(float, p.x << 16), __builtin_bit_cast(float, p.x & 0xffff0000u), __builtin_bit_cast(float, p.y << 16), __builtin_bit_cast(float, p.y & 0xffff0000u)};
                        b1 = (f32x4){__builtin_bit_cast(float, p.z << 16), __builtin_bit_cast(float, p.z & 0xffff0000u), __builtin_bit_cast(float, p.w << 16), __builtin_bit_cast(float, p.w & 0xffff0000u)}; }
                    const f32x4 o0 = b0 + acc[ai][bj][m][0], o1 = b1 + acc[ai][bj][m][1];
                    s += ((o0[0] * o0[0] + o0[1] * o0[1]) + (o0[2] * o0[2] + o0[3] * o0[3])) + ((o1[0] * o1[0] + o1[1] * o1[1]) + (o1[2] * o1[2] + o1[3] * o1[3]));
                    u32x4 w; w.x = cvt_pk_bf16(o0[0], o0[1]); w.y = cvt_pk_bf16(o0[2], o0[3]); w.z = cvt_pk_bf16(o1[0], o1[1]); w.w = cvt_pk_bf16(o1[2], o1[3]);
                    *(u32x4*)(xb + o2) = w; }
                s += __shfl_xor(s, 16); s += __shfl_xor(s, 32);
                if (fq == 0) atomicAdd(ssq + row, s);
            }
    }
};
struct EpiKV {
    static constexpr bool PERM = false, AFTER_DRAIN = false;
    bf16_t* Kb; bf16_t* VTp;
    __device__ __forceinline__ void operator()(const f32x4 (&acc)[2][2][4][2], const Unit& u, int wr, int wc, int fr, int fq) const {
        typedef unsigned u32x2v __attribute__((ext_vector_type(2)));
        const int row0 = u.pm * BM + wr * 64 + fr, col0 = u.pn * BM + wc * 32 + 4 * fq;
#pragma unroll
        for (int ai = 0; ai < 2; ++ai)
#pragma unroll
            for (int m = 0; m < 4; ++m) {
                const int row = row0 + ai * HALF + m * 16, b = row >> 8, key = row & 255;
#pragma unroll
                for (int bj = 0; bj < 2; ++bj)
#pragma unroll
                    for (int n = 0; n < 2; ++n) { const int col = col0 + bj * HALF + n * 16; const f32x4 v = acc[ai][bj][m][n];
                        const unsigned p01 = cvt_pk_bf16(v[0], v[1]), p23 = cvt_pk_bf16(v[2], v[3]);
                        if (col < 1024) { const int h = col >> 8, dh = col & 255; u32x2v w; w.x = p01; w.y = p23;
                            *(u32x2v*)(Kb + ((size_t)((b * 4 + h) * 256 + key)) * 256 + dh) = w; }
                        else { const int c2 = col - 1024, h = c2 >> 8, dv = c2 & 255, kp = (key & ~31) | permk(key & 31);
                            bf16_t* d = VTp + ((size_t)((b * 4 + h) * 256 + dv)) * 256 + kp;
                            d[0] = (bf16_t)(p01 & 0xffffu); d[256] = (bf16_t)(p01 >> 16); d[512] = (bf16_t)(p23 & 0xffffu); d[768] = (bf16_t)(p23 >> 16); } }
            }
    }
};
}
#ifndef PG8_SP2
#define PG8_SP2 true
#endif
#ifndef PG8_ALIGN
#define PG8_ALIGN true
#endif

constexpr int NWAVES = 8;
#ifndef MK_PER_PHASE
#define MK_PER_PHASE 0
#endif
constexpr int T = 16384, SEQ = 8192, D = 1024;
constexpr int N_PHASES = 12;

constexpr size_t MiB = 1u << 20, KiB = 1u << 10;
constexpr size_t WS_CTL = 0, CTL_ZERO_BYTES = 1 * MiB;
constexpr int CW_BAR = 4096;
constexpr size_t WS_SSQ1 = 64 * KiB, WS_SSQ2 = 128 * KiB;
constexpr size_t WS_AB = 1 * MiB;
constexpr size_t WS_HEND = WS_AB + 512 * KiB, WS_PEND = WS_HEND + 512 * KiB, WS_HIN = WS_PEND + 512 * KiB;
constexpr size_t WS_DEC = WS_HIN + 512 * KiB;
constexpr size_t WS_SUBK = 3 * MiB + 256 * KiB;
constexpr size_t WS_WIN = 4 * MiB, WS_WOUT = 10 * MiB, WS_WQ = 12 * MiB, WS_WKV = 14 * MiB, WS_WO = 18 * MiB, WS_PWQ = 20 * MiB;
constexpr size_t WS_MEMN = 24 * MiB, WS_KB = 25 * MiB, WS_VTP = 26 * MiB, WS_LRUWT = 27 * MiB, WS_USC = 27 * MiB + 256 * KiB, WS_VSC = 27 * MiB + 384 * KiB;
constexpr size_t WS_XB = 28 * MiB;
constexpr size_t WS_HLOC = 28 * MiB, WS_PCUM = 44 * MiB;
constexpr size_t WS_QKV = 60 * MiB;
constexpr size_t OUT_Y = 4 * MiB;
constexpr size_t OUT_END = OUT_Y + (size_t)16384 * 1024 * 2;
constexpr size_t WS_IDX = 60 * MiB, WS_GW = 68 * MiB;
constexpr size_t WS_UB = 60 * MiB;
constexpr size_t WS_XR = 108 * MiB, WS_Z = 124 * MiB, WS_GATE = 140 * MiB;
constexpr size_t WS_WN = 156 * MiB, WS_UF = 172 * MiB, WS_QD = 188 * MiB, WS_KD = 204 * MiB, WS_ATT = 220 * MiB;
constexpr size_t WS_VB = 228 * MiB;
constexpr size_t WS_Q = 188 * MiB, WS_AO = 124 * MiB;
constexpr size_t WS_PQ = 108 * MiB;
constexpr size_t WS_END = 244 * MiB;
constexpr int CW_GFLAG = 49152;
constexpr int CW_LRUCNT = 8192;
static_assert(WS_XR - WS_QKV == (size_t)T * 1536 * 2 && WS_Z - WS_XR == (size_t)T * 512 * 2 && WS_GATE - WS_Z == (size_t)T * 512 * 2, "in-proj outputs are contiguous");

constexpr int LDS_BYTES = 160 * 1024;
constexpr int MISC_OFF = 159 * 1024;

#define GAS __attribute__((address_space(1)))
#define LAS __attribute__((address_space(3)))
typedef unsigned short bf16;
typedef unsigned v4u __attribute__((ext_vector_type(4)));
typedef unsigned v2u __attribute__((ext_vector_type(2)));
typedef float f32x4 __attribute__((ext_vector_type(4)));
typedef short bf16x8 __attribute__((ext_vector_type(8)));
typedef GAS unsigned gu32;
#define LDS_WAIT() asm volatile("s_waitcnt lgkmcnt(0)" ::: "memory")
__device__ __forceinline__ void st16_wt(void* p, v4u v) { asm volatile("global_store_dwordx4 %0, %1, off sc0 sc1\n\ts_nop 1" :: "v"(p), "v"(v) : "memory"); }
__device__ __forceinline__ unsigned f2bf(float f) { unsigned u = __builtin_bit_cast(unsigned, f); return (u + 0x7fffu + ((u >> 16) & 1u)) >> 16; }
__device__ __forceinline__ unsigned pk2(float lo, float hi) { return f2bf(lo) | (f2bf(hi) << 16); }
__device__ __forceinline__ float bflo(unsigned u) { return __builtin_bit_cast(float, u << 16); }
__device__ __forceinline__ float bfhi(unsigned u) { return __builtin_bit_cast(float, u & 0xffff0000u); }
__device__ __forceinline__ float bf1(bf16 h) { return __builtin_bit_cast(float, (unsigned)h << 16); }
__device__ __forceinline__ float wave_sum(float v) {
#pragma unroll
    for (int o = 1; o < 64; o <<= 1) v += __shfl_xor(v, o);
    return v;
}
__device__ __forceinline__ float row16_sum(float v) {
    v += __builtin_bit_cast(float, __builtin_amdgcn_update_dpp(0, __builtin_bit_cast(int, v), 0xB1, 0xF, 0xF, true));
    v += __builtin_bit_cast(float, __builtin_amdgcn_update_dpp(0, __builtin_bit_cast(int, v), 0x4E, 0xF, 0xF, true));
    v += __builtin_bit_cast(float, __builtin_amdgcn_update_dpp(0, __builtin_bit_cast(int, v), 0x141, 0xF, 0xF, true));
    v += __builtin_bit_cast(float, __builtin_amdgcn_update_dpp(0, __builtin_bit_cast(int, v), 0x140, 0xF, 0xF, true));
    return v;
}
__device__ __forceinline__ float sigmoidf_(float x) { return __builtin_amdgcn_rcpf(1.0f + __expf(-x)); }
__device__ __forceinline__ float softplusf_(float x) { return fmaxf(x, 0.f) + log1pf(__expf(-fabsf(x))); }
__device__ __forceinline__ float siluf_(float x) { return x * __builtin_amdgcn_rcpf(1.0f + __expf(-x)); }
__device__ __forceinline__ float gelu_tanh(float x) { const float y = 0.7978845608028654f * (x + 0.044715f * x * x * x); const float e = __expf(2.0f * y); return x * (1.0f - __builtin_amdgcn_rcpf(1.0f + e)); }
__device__ __forceinline__ int permk(int kl) { return 8 * ((kl & 15) >> 2) + 4 * (kl >> 4) + (kl & 3); }

struct Params {
    const float *x, *mem, *norm_mix_w, *w_in, *conv_qkv_w, *gdn_a_log, *gdn_dt_bias, *gdn_norm_w, *lru_conv_w, *lru_conv_b, *lru_wa, *lru_ba, *lru_wx, *lru_bx, *lru_lambda, *w_out,
                *norm_xattn_w, *norm_mem_w, *xattn_wq, *xattn_wkv, *xattn_wo, *norm_ffn_w, *peer_wq, *peer_subkeys, *peer_u, *peer_v, *norm_final_w;
    float* out; unsigned char* ws; int ph_lo, ph_hi;
};
#define XB_TMO      128
#define XB_XCNT(j)  (256  + 64 * (j))
#define XB_XSUB(j)  (1280 + 64 * (j))
#define XB_XGEN(j)  (2304 + 64 * (j))
#define XB_TOP      3328
#define XB_TOPGEN   3392
#define XCD_BAR_WORDS 3456
#define XB_SPIN_CAP (1u << 18)

__device__ __forceinline__ unsigned xb_ld(unsigned* p)              { return __hip_atomic_load(p, __ATOMIC_RELAXED, __HIP_MEMORY_SCOPE_AGENT); }
__device__ __forceinline__ unsigned xb_add(unsigned* p, unsigned v) { return __hip_atomic_fetch_add(p, v, __ATOMIC_RELAXED, __HIP_MEMORY_SCOPE_AGENT); }
__device__ __forceinline__ unsigned xb_xcc_id() { return (unsigned)__builtin_amdgcn_s_getreg((3 << 11) | 20) & 0xFu; }
#define XB_SPIN(cond, bar) do { unsigned _sp = 0; while (cond) { __builtin_amdgcn_s_sleep(1); \
    if ((++_sp & 255u) == 0u) { if (xb_ld(&(bar)[XB_TMO])) break; if (_sp > XB_SPIN_CAP) { atomicAdd(&(bar)[XB_TMO], 1u); break; } } } } while (0)

struct XcdBarrier {
    unsigned* bar; unsigned x;
    volatile LAS unsigned* st;
};

__device__ __forceinline__ XcdBarrier xcd_barrier_post(unsigned* bar, volatile LAS unsigned* st) {
    XcdBarrier b; b.bar = bar; b.x = xb_xcc_id(); b.st = st;
    if (threadIdx.x == 0) (void)xb_add(&bar[XB_XCNT(b.x)], 1u);
    return b;
}
__device__ __forceinline__ void xcd_barrier_complete(unsigned* bar, unsigned x, unsigned& nloc, unsigned& nx) {
    const unsigned G = gridDim.x * gridDim.y * gridDim.z;
    unsigned sum, cnt, mine, sp = 0u;
    for (;;) {
        sum = 0u; cnt = 0u; mine = 0u;
#pragma unroll
        for (unsigned j = 0; j < 16; ++j) { const unsigned c = xb_ld(&bar[XB_XCNT(j)]); sum += c; cnt += (c > 0u) ? 1u : 0u; mine = (j == x) ? c : mine; }
        if (sum == G) break;
        __builtin_amdgcn_s_sleep(1);
        if ((++sp & 255u) == 0u) { if (xb_ld(&bar[XB_TMO])) break; if (sp > XB_SPIN_CAP) { atomicAdd(&bar[XB_TMO], 1u); break; } }
    }
    nloc = mine > 0u ? mine : 1u; nx = cnt > 0u ? cnt : 1u;
}

__device__ __forceinline__ void xcd_barrier(const XcdBarrier& b) {
    asm volatile("s_waitcnt vmcnt(0)" ::: "memory");
    __syncthreads();
    if (threadIdx.x == 0) {
        unsigned* bar = b.bar;
        __builtin_amdgcn_s_waitcnt(0);
        unsigned nloc = b.st[0], nx = b.st[1];
        if (nloc == 0u) { xcd_barrier_complete(bar, b.x, nloc, nx); b.st[0] = nloc; b.st[1] = nx; }
        const unsigned old = xb_add(&bar[XB_XSUB(b.x)], 1u);
        const unsigned gen = old / nloc;
        if (old + 1u == (gen + 1u) * nloc) {
            __builtin_amdgcn_fence(__ATOMIC_RELEASE, "agent");
            asm volatile("s_waitcnt vmcnt(0)" ::: "memory");
            const unsigned og = xb_add(&bar[XB_TOP], 1u);
            const unsigned tg = og / nx;
            if (og + 1u == (tg + 1u) * nx) xb_add(&bar[XB_TOPGEN], 1u);
            else XB_SPIN(xb_ld(&bar[XB_TOPGEN]) == tg, bar);
            __builtin_amdgcn_fence(__ATOMIC_ACQUIRE, "agent");
            xb_add(&bar[XB_XGEN(b.x)], 1u);
            asm volatile("s_waitcnt vmcnt(0)" ::: "memory");
        } else {
            XB_SPIN(xb_ld(&bar[XB_XGEN(b.x)]) == gen, bar);
            __builtin_amdgcn_fence(__ATOMIC_ACQUIRE, "agent");
            asm volatile("s_waitcnt vmcnt(0)" ::: "memory");
        }
    }
    __syncthreads();
}

__device__ __forceinline__ void p0_transpose_item(const float* W, int K, int ldw, int c0, int nblk, bf16* WT, int row_off, const float* ks, LAS float* scr, int item, int lane) {
    const int kb = item / nblk, nb = item % nblk, k0 = 64 * kb, n0 = 32 * nb;
#pragma unroll 8
    for (int i = 0; i < 32; ++i) { const int kk = 2 * i + (lane >> 5); float v = W[(size_t)(k0 + kk) * ldw + c0 + n0 + (lane & 31)]; if (ks) v *= ks[k0 + kk]; scr[kk * 33 + (lane & 31)] = v; }
    LDS_WAIT(); asm volatile("" ::: "memory");
    const int c = lane & 7;
#pragma unroll
    for (int j = 0; j < 4; ++j) { const int n = (lane >> 3) + 8 * j; const LAS float* s = scr + (8 * c) * 33 + n;
        v4u o; o.x = pk2(s[0 * 33], s[1 * 33]); o.y = pk2(s[2 * 33], s[3 * 33]); o.z = pk2(s[4 * 33], s[5 * 33]); o.w = pk2(s[6 * 33], s[7 * 33]);
        *(GAS v4u*)(WT + (size_t)(row_off + n0 + n) * K + k0 + 8 * c) = o; }
    LDS_WAIT(); asm volatile("" ::: "memory");
}

__device__ __forceinline__ void p0_prologue(const Params& P, LAS unsigned char* lds, int tid, int lane, int wave, int vcu, int G) {
    unsigned char* ws = P.ws;
    const int gw = vcu * NWAVES + wave, NGW = G * NWAVES;
    LAS float* wabl = (LAS float*)lds;
    for (int idx = tid; idx < 8192; idx += NWAVES * 64) { const int k = idx >> 3, c = idx & 7, j = k >> 8, l = (k >> 2) & 63, e = k & 3;
        wabl[((((j * 4 + e) * 2 + (c >> 2)) * 64 + l) << 2) + (c & 3)] = P.w_in[(size_t)k * 3080 + 2048 + c]; }
    __syncthreads();
    {
        bf16* XB0 = (bf16*)(ws + WS_XB); float* AB = (float*)(ws + WS_AB);
        f32x4 w4[4];
#pragma unroll
        for (int j = 0; j < 4; ++j) w4[j] = ((const f32x4*)P.norm_mix_w)[64 * j + lane];
        for (int m = gw; m < T; m += NGW) {
            const f32x4* xr = (const f32x4*)(P.x + (size_t)m * D) + lane;
            f32x4 v[4]; float s = 0.f;
#pragma unroll
            for (int j = 0; j < 4; ++j) { v[j] = xr[64 * j]; s += (v[j].x * v[j].x + v[j].y * v[j].y) + (v[j].z * v[j].z + v[j].w * v[j].w); }
            const float rstd = rsqrtf(wave_sum(s) * (1.0f / D) + 1e-6f);
            v2u* o8 = (v2u*)(XB0 + (size_t)m * D) + lane;
            float part[8];
#pragma unroll
            for (int c = 0; c < 8; ++c) part[c] = 0.f;
#pragma unroll
            for (int j = 0; j < 4; ++j) {
                v[j] = v[j] * rstd * w4[j];
                v2u o; o.x = pk2(v[j].x, v[j].y); o.y = pk2(v[j].z, v[j].w); o8[64 * j] = o;
#pragma unroll
                for (int e = 0; e < 4; ++e) {
                    const f32x4 wa = *(const LAS f32x4*)(wabl + ((((j * 4 + e) * 2 + 0) * 64 + lane) << 2));
                    const f32x4 wb = *(const LAS f32x4*)(wabl + ((((j * 4 + e) * 2 + 1) * 64 + lane) << 2));
                    const float hv = v[j][e];
                    part[0] += hv * wa.x; part[1] += hv * wa.y; part[2] += hv * wa.z; part[3] += hv * wa.w;
                    part[4] += hv * wb.x; part[5] += hv * wb.y; part[6] += hv * wb.z; part[7] += hv * wb.w;
                }
            }
#pragma unroll
            for (int c = 0; c < 8; ++c) part[c] = wave_sum(part[c]);
            float o = part[0];
#pragma unroll
            for (int c = 1; c < 8; ++c) o = (lane == c) ? part[c] : o;
            if (lane < 8) AB[(size_t)m * 8 + lane] = o;
        }
    }
    {
        bf16* MEMN = (bf16*)(ws + WS_MEMN);
        for (int m = gw; m < 512; m += NGW) {
            const f32x4* xr = (const f32x4*)(P.mem + (size_t)m * D) + lane;
            f32x4 v[4]; float s = 0.f;
#pragma unroll
            for (int j = 0; j < 4; ++j) { v[j] = xr[64 * j]; s += (v[j].x * v[j].x + v[j].y * v[j].y) + (v[j].z * v[j].z + v[j].w * v[j].w); }
            const float rstd = rsqrtf(wave_sum(s) * (1.0f / D) + 1e-6f);
            v2u* o8 = (v2u*)(MEMN + (size_t)m * D) + lane;
#pragma unroll
            for (int j = 0; j < 4; ++j) { const f32x4 w = ((const f32x4*)P.norm_mem_w)[64 * j + lane]; const f32x4 y = v[j] * rstd * w;
                v2u o; o.x = pk2(y.x, y.y); o.y = pk2(y.z, y.w); o8[64 * j] = o; }
        }
    }
    __syncthreads();
    {
        LAS float* scr = (LAS float*)(lds + wave * 16384);
        constexpr int I_IN1 = 16 * 48, I_IN2 = 16 * 16, I_KV = 16 * 64;
        constexpr int NITEMS = I_IN1 + 3 * I_IN2 + I_KV;
        for (int it = gw; it < NITEMS; it += NGW) {
            int r = it;
            if (r < I_IN1) { p0_transpose_item(P.w_in, 1024, 3080, 0, 48, (bf16*)(ws + WS_WIN), 0, nullptr, scr, r, lane); continue; } r -= I_IN1;
            if (r < I_IN2) { p0_transpose_item(P.w_in, 1024, 3080, 2056, 16, (bf16*)(ws + WS_WIN), 1536, nullptr, scr, r, lane); continue; } r -= I_IN2;
            if (r < I_IN2) { p0_transpose_item(P.w_in, 1024, 3080, 1536, 16, (bf16*)(ws + WS_WIN), 2048, nullptr, scr, r, lane); continue; } r -= I_IN2;
            if (r < I_IN2) { p0_transpose_item(P.w_in, 1024, 3080, 2568, 16, (bf16*)(ws + WS_WIN), 2560, nullptr, scr, r, lane); continue; } r -= I_IN2;
            p0_transpose_item(P.xattn_wkv, 1024, 2048, 0, 64, (bf16*)(ws + WS_WKV), 0, nullptr, scr, r, lane);
        }
    }
    {
        bf16* WT = (bf16*)(ws + WS_LRUWT);
        for (int it = vcu * NWAVES * 64 + tid; it < 8 * 2 * 64 * 8; it += G * NWAVES * 64) {
            const int i8 = it & 7, j = (it >> 3) & 63, m = (it >> 9) & 1, g = it >> 10;
            const float* src = (m ? P.lru_wx : P.lru_wa) + (size_t)(g * 64 + 8 * i8) * 64 + j;
            v4u o; o.x = pk2(src[0], src[64]); o.y = pk2(src[128], src[192]); o.z = pk2(src[256], src[320]); o.w = pk2(src[384], src[448]);
            *(v4u*)(WT + (size_t)it * 8) = o;
        }
    }
}

__device__ __forceinline__ void late_weight_prep(const Params& P, LAS unsigned char* lds, int lane, int wave, int gw, int NGW) {
    unsigned char* ws = P.ws;
    {
        LAS float* scr = (LAS float*)(lds + wave * 16384);
        constexpr int I_OUT = 16 * 32, I_Q = 16 * 32, I_O = 16 * 32;
        for (int it = gw; it < I_OUT + I_Q + I_O; it += NGW) {
            int r = it;
            if (r < I_OUT) { p0_transpose_item(P.w_out, 1024, 1024, 0, 32, (bf16*)(ws + WS_WOUT), 0, nullptr, scr, r, lane); continue; } r -= I_OUT;
            if (r < I_Q) { p0_transpose_item(P.xattn_wq, 1024, 1024, 0, 32, (bf16*)(ws + WS_WQ), 0, P.norm_xattn_w, scr, r, lane); continue; } r -= I_Q;
            p0_transpose_item(P.xattn_wo, 1024, 1024, 0, 32, (bf16*)(ws + WS_WO), 0, nullptr, scr, r, lane);
        }
    }
    {
        bf16* WF = (bf16*)(ws + WS_PWQ);
        const int col = lane & 15, g = lane >> 4;
        for (int it = gw; it < 16 * 64; it += NGW) {
            const int hp = it >> 6, k0 = (it & 63) * 16;
            bf16x8 bq[4];
#pragma unroll
            for (int s = 0; s < 4; ++s) { const f32x4* src = (const f32x4*)(P.peer_wq + (size_t)(k0 + col) * 2048 + hp * 128 + 32 * s + 8 * g);
                const f32x4 a = src[0], c = src[1]; v4u pk; pk.x = pk2(a.x, a.y); pk.y = pk2(a.z, a.w); pk.z = pk2(c.x, c.y); pk.w = pk2(c.z, c.w); bq[s] = __builtin_bit_cast(bf16x8, pk); }
            const float nw = P.norm_ffn_w[k0 + col];
#pragma unroll 2
            for (int kt = 0; kt < 8; ++kt) {
                f32x4 acc = (f32x4){0.f, 0.f, 0.f, 0.f};
#pragma unroll
                for (int s = 0; s < 4; ++s) { const f32x4* src = (const f32x4*)(P.peer_subkeys + (size_t)(hp * 128 + 16 * kt + col) * 128 + 32 * s + 8 * g);
                    const f32x4 a = src[0], c = src[1]; v4u pk; pk.x = pk2(a.x, a.y); pk.y = pk2(a.z, a.w); pk.z = pk2(c.x, c.y); pk.w = pk2(c.z, c.w);
                    acc = __builtin_amdgcn_mfma_f32_16x16x32_bf16(__builtin_bit_cast(bf16x8, pk), bq[s], acc, 0, 0, 0); }
#pragma unroll
                for (int i = 0; i < 4; ++i) WF[(size_t)(hp * 128 + 16 * kt + 4 * g + i) * 1024 + k0 + col] = (bf16)f2bf(acc[i] * nw);
            }
        }
    }
}

constexpr int GL_KS = 0, GL_VS = 33792, GL_KB = 67584, GL_QB = 84992, GL_RAW = 102400, GL_CW = 153856, GL_AMT = 133120, GL_SM = 160000, GL_ATT = 151808, GL_SOL = 67584;
static_assert(GL_CW + 6144 <= GL_SM && GL_SM + 1284 <= MISC_OFF && GL_SOL + 65536 <= GL_AMT && GL_AMT + 17408 <= GL_ATT && GL_ATT + 8192 <= GL_SM && GL_RAW + 51456 <= GL_CW, "gdn_local LDS map");
#ifndef GL_REP_STEP
#define GL_REP_STEP -1
#endif
#define GL_REPF(k) for (int rr_ = 0; rr_ < ((GL_REP_STEP == (k)) ? 2 : 1); ++rr_)
#define GL_BAR() do { asm volatile("s_waitcnt lgkmcnt(0)" ::: "memory"); __builtin_amdgcn_s_barrier(); asm volatile("" ::: "memory"); } while (0)
__device__ __forceinline__ void gdn_local_item(const Params& P, LAS unsigned char* lds, int item, int tid) {
    unsigned char* ws = P.ws;
    asm volatile("" : "+v"(tid));
    const int b = item >> 9, h = (item >> 7) & 3, n = item & 127;
    const int t0 = b * SEQ + n * 64;
    const int lane = tid & 63, wave = __builtin_amdgcn_readfirstlane(tid >> 6);
    LAS float* ks = (LAS float*)(lds + GL_KS);
    LAS float* vs = (LAS float*)(lds + GL_VS);
    LAS bf16* kb16 = (LAS bf16*)(lds + GL_KB);
    LAS bf16* qb16 = (LAS bf16*)(lds + GL_QB);
    LAS bf16* raw = (LAS bf16*)(lds + GL_RAW);
    LAS float* cw = (LAS float*)(lds + GL_CW);
    LAS float* AmT = (LAS float*)(lds + GL_AMT);
    LAS float* sg = (LAS float*)(lds + GL_SM);
    LAS float* sbeta = sg + 64; LAS float* sgc = sbeta + 64; LAS float* seg = sgc + 64; LAS float* sek = seg + 64;
    LAS bf16* atts = (LAS bf16*)(lds + GL_ATT);
    const bf16* QKV = (const bf16*)(ws + WS_QKV);
    const float* AB = (const float*)(ws + WS_AB);
    GL_REPF(0) {
        v4u pr[7];
#pragma unroll
        for (int r = 0; r < 7; ++r) {
            const int id = tid + 512 * r;
            const int row = id / 48, rem = id - row * 48, part = rem >> 4, ck = rem & 15, s = n * 64 + row - 3;
            pr[r] = (v4u){0u, 0u, 0u, 0u};
            if (id < 67 * 48 && s >= 0) pr[r] = *(const v4u*)(QKV + (size_t)(b * SEQ + s) * 1536 + part * 512 + h * 128 + ck * 8);
        }
        f32x4 cwv = (f32x4){0.f, 0.f, 0.f, 0.f};
        if (tid < 384) { const int j = tid / 96, rem = tid - j * 96, part = rem >> 5, c4 = rem & 31; cwv = *(const f32x4*)(P.conv_qkv_w + j * 1536 + part * 512 + h * 128 + c4 * 4); }
        float a_in = 0.f, b_in = 0.f;
        if (tid < 64) { a_in = AB[(size_t)(t0 + tid) * 8 + h]; b_in = AB[(size_t)(t0 + tid) * 8 + 4 + h]; }
#pragma unroll
        for (int r = 0; r < 7; ++r) { const int id = tid + 512 * r; if (id < 67 * 48) *(LAS v4u*)(raw + id * 8) = pr[r]; }
        if (tid < 384) *(LAS f32x4*)(cw + tid * 4) = cwv;
        if (tid < 64) { sg[tid] = -__expf(P.gdn_a_log[h]) * softplusf_(a_in + P.gdn_dt_bias[h]); sbeta[tid] = sigmoidf_(b_in); }
    }
    GL_BAR();
    GL_REPF(1) {
        const int c = tid >> 3, grp = tid & 7;
#pragma unroll 1
        for (int part = 0; part < 3; ++part) {
            float y[16];
#pragma unroll
            for (int i = 0; i < 16; ++i) y[i] = 0.f;
#pragma unroll
            for (int j = 0; j < 4; ++j) {
                const LAS v4u* src = (const LAS v4u*)(raw + (c + j) * 384 + part * 128 + grp * 16);
                const v4u x0 = src[0], x1 = src[1];
                const LAS f32x4* wp = (const LAS f32x4*)(cw + (j * 3 + part) * 128 + grp * 16);
                const f32x4 w0 = wp[0], w1 = wp[1], w2 = wp[2], w3 = wp[3];
                y[0] += w0.x * bflo(x0.x); y[1] += w0.y * bfhi(x0.x); y[2] += w0.z * bflo(x0.y); y[3] += w0.w * bfhi(x0.y);
                y[4] += w1.x * bflo(x0.z); y[5] += w1.y * bfhi(x0.z); y[6] += w1.z * bflo(x0.w); y[7] += w1.w * bfhi(x0.w);
                y[8] += w2.x * bflo(x1.x); y[9] += w2.y * bfhi(x1.x); y[10] += w2.z * bflo(x1.y); y[11] += w2.w * bfhi(x1.y);
                y[12] += w3.x * bflo(x1.z); y[13] += w3.y * bfhi(x1.z); y[14] += w3.z * bflo(x1.w); y[15] += w3.w * bfhi(x1.w);
            }
            float ss = 0.f;
#pragma unroll
            for (int i = 0; i < 16; ++i) { y[i] = siluf_(y[i]); ss += y[i] * y[i]; }
            if (part < 2) {
                ss += __shfl_xor(ss, 1); ss += __shfl_xor(ss, 2); ss += __shfl_xor(ss, 4);
                const float sc = rsqrtf(ss + 1e-6f) * (part == 0 ? 0.08838834764831845f : 1.0f);
#pragma unroll
                for (int i = 0; i < 16; ++i) y[i] *= sc;
            }
            if (part >= 1) {
                LAS float* dst = (part == 1 ? ks : vs) + c * 132 + grp * 16;
#pragma unroll
                for (int i = 0; i < 4; ++i) *(LAS f32x4*)(dst + 4 * i) = (f32x4){y[4 * i], y[4 * i + 1], y[4 * i + 2], y[4 * i + 3]};
            }
            if (part <= 1) {
                LAS bf16* dst = (part == 0 ? qb16 : kb16) + c * 136 + grp * 16;
                v4u o0, o1; o0.x = pk2(y[0], y[1]); o0.y = pk2(y[2], y[3]); o0.z = pk2(y[4], y[5]); o0.w = pk2(y[6], y[7]);
                o1.x = pk2(y[8], y[9]); o1.y = pk2(y[10], y[11]); o1.z = pk2(y[12], y[13]); o1.w = pk2(y[14], y[15]);
                *(LAS v4u*)dst = o0; *(LAS v4u*)(dst + 8) = o1;
            }
        }
    }
    if (tid < 64) {
        float v = sg[tid];
#pragma unroll
        for (int off = 1; off < 64; off <<= 1) { const float t = __shfl_up(v, off); if (tid >= off) v += t; }
        sgc[tid] = v; seg[tid] = __expf(v);
        const float gl = __shfl(v, 63);
        sek[tid] = __expf(gl - v);
        if (tid == 63) sek[64] = __expf(v);
    }
    GL_BAR();
    {
        const int mat = wave >> 2, rho = wave & 3, col = lane & 15, g = lane >> 4;
        const LAS bf16* X = mat ? qb16 : kb16;
        bf16x8 af[4];
#pragma unroll
        for (int s = 0; s < 4; ++s) af[s] = *(const LAS bf16x8*)(X + (16 * rho + col) * 136 + 32 * s + 8 * g);
#pragma unroll
        for (int sig = 0; sig < 4; ++sig) {
            f32x4 acc = (f32x4){0.f, 0.f, 0.f, 0.f};
#pragma unroll
            for (int s = 0; s < 4; ++s) { const bf16x8 bfr = *(const LAS bf16x8*)(kb16 + (16 * sig + col) * 136 + 32 * s + 8 * g); acc = __builtin_amdgcn_mfma_f32_16x16x32_bf16(af[s], bfr, acc, 0, 0, 0); }
            const int sidx = 16 * sig + col; const float gs = sgc[sidx];
#pragma unroll
            for (int i = 0; i < 4; ++i) {
                const int c = 16 * rho + 4 * g + i;
                const float dec = (c >= sidx) ? __expf(sgc[c] - gs) : 0.f;
                if (mat == 0) AmT[sidx * 68 + c] = (c > sidx) ? sbeta[c] * acc[i] * dec : 0.f;
                else atts[c * 64 + sidx] = (bf16)f2bf(acc[i] * dec);
            }
        }
    }
    GL_BAR();
    GL_REPF(4) {
        bf16* QD = (bf16*)(ws + WS_QD) + (size_t)item * 8192;
        bf16* KD = (bf16*)(ws + WS_KD) + (size_t)item * 8192;
        bf16* ATT = (bf16*)(ws + WS_ATT) + (size_t)item * 4096;
#pragma unroll
        for (int r = 0; r < 2; ++r) {
            const int id = tid + 512 * r;
            { const int c = id >> 4, gam = id & 15, s32 = gam >> 2, g = gam & 3;
              const v2u lo = *(const LAS v2u*)(qb16 + c * 136 + 32 * s32 + 4 * g), hi = *(const LAS v2u*)(qb16 + c * 136 + 32 * s32 + 16 + 4 * g);
              const float e = seg[c];
              v4u o; o.x = pk2(bflo(lo.x) * e, bfhi(lo.x) * e); o.y = pk2(bflo(lo.y) * e, bfhi(lo.y) * e); o.z = pk2(bflo(hi.x) * e, bfhi(hi.x) * e); o.w = pk2(bflo(hi.y) * e, bfhi(hi.y) * e);
              st16_wt(QD + c * 128 + 8 * gam, o); }
            { const int dk = id >> 3, gam = id & 7, s32 = gam >> 2, g = gam & 3, c0 = 32 * s32 + 4 * g;
              float v[8];
#pragma unroll
              for (int j = 0; j < 4; ++j) { v[j] = ks[(c0 + j) * 132 + dk] * sek[c0 + j]; v[4 + j] = ks[(c0 + 16 + j) * 132 + dk] * sek[c0 + 16 + j]; }
              v4u o; o.x = pk2(v[0], v[1]); o.y = pk2(v[2], v[3]); o.z = pk2(v[4], v[5]); o.w = pk2(v[6], v[7]);
              st16_wt(KD + dk * 64 + 8 * gam, o); }
        }
        { const int c = tid >> 3, gam = tid & 7, s32 = gam >> 2, g = gam & 3;
          const v2u lo = *(const LAS v2u*)(atts + c * 64 + 32 * s32 + 4 * g), hi = *(const LAS v2u*)(atts + c * 64 + 32 * s32 + 16 + 4 * g);
          v4u o; o.x = lo.x; o.y = lo.y; o.z = hi.x; o.w = hi.y;
          st16_wt(ATT + c * 64 + 8 * gam, o); }
    }
    GL_BAR();
    GL_REPF(5) {
        LAS float* xcol = (LAS float*)(lds + GL_SOL);
        LAS bf16* tinv = (LAS bf16*)(lds + GL_SOL + 17408);
        const int j = tid >> 3, part = tid & 7, jb = j >> 4, jo = j & 15;
#pragma unroll 1
        for (int rb = jb; rb < 4; ++rb) {
            float acc[16];
#pragma unroll
            for (int i = 0; i < 16; ++i) acc[i] = 0.f;
            if (rb > jb) {
#pragma unroll 2
                for (int s = 16 * jb + part; s < 16 * rb; s += 8) {
                    const float sv = xcol[j * 68 + s];
                    const LAS float* ar = AmT + s * 68 + 16 * rb;
#pragma unroll
                    for (int q = 0; q < 4; ++q) { const f32x4 A4 = *(const LAS f32x4*)(ar + 4 * q);
                        acc[4 * q] -= A4.x * sv; acc[4 * q + 1] -= A4.y * sv; acc[4 * q + 2] -= A4.z * sv; acc[4 * q + 3] -= A4.w * sv; }
                }
#pragma unroll
                for (int i = 0; i < 16; ++i) {
                    acc[i] += __builtin_bit_cast(float, __builtin_amdgcn_update_dpp(0, __builtin_bit_cast(int, acc[i]), 0xB1, 0xF, 0xF, true));
                    acc[i] += __builtin_bit_cast(float, __builtin_amdgcn_update_dpp(0, __builtin_bit_cast(int, acc[i]), 0x4E, 0xF, 0xF, true));
                    acc[i] += __builtin_bit_cast(float, __builtin_amdgcn_update_dpp(0, __builtin_bit_cast(int, acc[i]), 0x141, 0xF, 0xF, true));
                }
            } else {
#pragma unroll
                for (int i = 0; i < 16; ++i) acc[i] = (i == jo) ? 1.f : 0.f;
            }
#pragma unroll
            for (int i = 0; i < 16; ++i) {
                const float sv = acc[i];
                const LAS float* ar = AmT + (16 * rb + i) * 68 + 16 * rb;
#pragma unroll
                for (int q = (i + 1) / 4; q < 4; ++q) { const f32x4 A4 = *(const LAS f32x4*)(ar + 4 * q);
                    if (4 * q > i) acc[4 * q] -= A4.x * sv; if (4 * q + 1 > i) acc[4 * q + 1] -= A4.y * sv; if (4 * q + 2 > i) acc[4 * q + 2] -= A4.z * sv; if (4 * q + 3 > i) acc[4 * q + 3] -= A4.w * sv; }
            }
            if (part == 0) {
#pragma unroll
                for (int i = 0; i < 16; ++i) { xcol[j * 68 + 16 * rb + i] = acc[i]; tinv[(16 * rb + i) * 72 + j] = (bf16)f2bf(acc[i]); }
            }
            LDS_WAIT(); asm volatile("" ::: "memory");
        }
        for (int rb = 0; rb < jb; ++rb) {
            if (part == 0) {
#pragma unroll
                for (int i = 0; i < 16; ++i) tinv[(16 * rb + i) * 72 + j] = (bf16)0;
            }
        }
    }
    GL_BAR();
    GL_REPF(6) {
        const LAS bf16* tinv = (const LAS bf16*)(lds + GL_SOL + 17408);
        LAS bf16* wst = (LAS bf16*)(lds + GL_SOL + 17408 + 9216);
        const int col = lane & 15, g = lane >> 4, isw = wave >> 2;
        bf16x8 af[4][2];
#pragma unroll
        for (int rho = 0; rho < 4; ++rho)
#pragma unroll
            for (int s2 = 0; s2 < 2; ++s2) af[rho][s2] = *(const LAS bf16x8*)(tinv + (16 * rho + col) * 72 + 32 * s2 + 8 * g);
        bf16* UF = (bf16*)(ws + WS_UF) + (size_t)item * 8192;
#pragma unroll
        for (int sig = 0; sig < 2; ++sig) {
            const int jj = 32 * (wave & 3) + 16 * sig + col;
            const LAS float* src = (isw ? ks : vs) + jj;
            bf16x8 bfr[2];
#pragma unroll
            for (int s2 = 0; s2 < 2; ++s2) {
                float v[8];
#pragma unroll
                for (int e = 0; e < 8; ++e) { const int sidx = 32 * s2 + 8 * g + e; float x = src[sidx * 132] * sbeta[sidx]; if (isw) x *= seg[sidx]; v[e] = x; }
                v4u pk; pk.x = pk2(v[0], v[1]); pk.y = pk2(v[2], v[3]); pk.z = pk2(v[4], v[5]); pk.w = pk2(v[6], v[7]);
                bfr[s2] = __builtin_bit_cast(bf16x8, pk);
            }
            f32x4 acc[4];
#pragma unroll
            for (int rho = 0; rho < 4; ++rho) { acc[rho] = (f32x4){0.f, 0.f, 0.f, 0.f};
#pragma unroll
                for (int s2 = 0; s2 < 2; ++s2) acc[rho] = __builtin_amdgcn_mfma_f32_16x16x32_bf16(af[rho][s2], bfr[s2], acc[rho], 0, 0, 0); }
            if (!isw) {
                v4u o0, o1;
                o0.x = pk2(acc[0].x, acc[0].y); o0.y = pk2(acc[0].z, acc[0].w); o0.z = pk2(acc[1].x, acc[1].y); o0.w = pk2(acc[1].z, acc[1].w);
                o1.x = pk2(acc[2].x, acc[2].y); o1.y = pk2(acc[2].z, acc[2].w); o1.z = pk2(acc[3].x, acc[3].y); o1.w = pk2(acc[3].z, acc[3].w);
                v4u* d = (v4u*)(UF + (size_t)(2 * (wave & 3) + sig) * 1024 + lane * 16);
                st16_wt(d, o0); st16_wt(d + 1, o1);
            } else {
#pragma unroll
                for (int rho = 0; rho < 4; ++rho)
#pragma unroll
                    for (int i = 0; i < 4; ++i) wst[(16 * rho + 4 * g + i) * 136 + jj] = (bf16)f2bf(-acc[rho][i]);
            }
        }
    }
    GL_BAR();
    {
        const LAS bf16* wst = (const LAS bf16*)(lds + GL_SOL + 17408 + 9216);
        bf16* WN = (bf16*)(ws + WS_WN) + (size_t)item * 8192;
#pragma unroll
        for (int r = 0; r < 2; ++r) {
            const int id = tid + 512 * r, c = id >> 4, gam = id & 15, s32 = gam >> 2, g = gam & 3;
            const v2u lo = *(const LAS v2u*)(wst + c * 136 + 32 * s32 + 4 * g), hi = *(const LAS v2u*)(wst + c * 136 + 32 * s32 + 16 + 4 * g);
            v4u o; o.x = lo.x; o.y = lo.y; o.z = hi.x; o.w = hi.y;
            st16_wt(WN + c * 128 + 8 * gam, o);
        }
    }
    asm volatile("s_waitcnt vmcnt(0)" ::: "memory");
    GL_BAR();
    if (tid == 0) { unsigned fb = __builtin_bit_cast(unsigned, sek[64]); if (fb == 0u) fb = 1u;
        __hip_atomic_store((unsigned*)(ws + WS_CTL) + CW_GFLAG + item, fb, __ATOMIC_RELAXED, __HIP_MEMORY_SCOPE_AGENT); }
    GL_BAR();
}

constexpr int LL_XCB = 68608;
static_assert(LL_XCB + 64 * 1040 <= MISC_OFF, "lru_local LDS map");
__device__ __forceinline__ float expm1_small(float x) {
    const float p = x * (1.0f + x * (0.5f + x * (0.16666667f + x * (0.041666668f + x * 0.008333334f))));
    return (x > -0.25f) ? p : (__expf(x) - 1.0f);
}
__device__ __forceinline__ void lru_local_item(const Params& P, LAS unsigned char* lds, int lt, int tid, int lane, int wave) {
    unsigned char* ws = P.ws;
    asm volatile("" : "+v"(tid));
    const int b = lt >> 7, n = lt & 127, t0 = b * SEQ + n * 64;
    LAS bf16* rawx = (LAS bf16*)lds;
    LAS bf16* xcb = (LAS bf16*)(lds + LL_XCB);
    const bf16* XR = (const bf16*)(ws + WS_XR);
    {
        v4u pr[9];
#pragma unroll
        for (int r = 0; r < 9; ++r) { const int id = tid + 512 * r, row = id >> 6, ck = id & 63, s = n * 64 + row - 3;
            pr[r] = (v4u){0u, 0u, 0u, 0u};
            if (id < 67 * 64 && s >= 0) pr[r] = *(const v4u*)(XR + (size_t)(b * SEQ + s) * 512 + ck * 8); }
#pragma unroll
        for (int r = 0; r < 9; ++r) { const int id = tid + 512 * r; if (id < 67 * 64) *(LAS v4u*)(rawx + id * 8) = pr[r]; }
    }
    GL_BAR();
    {
        const int chg = tid & 63, tseg = tid >> 6, ch0 = chg * 8;
        float w[4][8], cb[8];
#pragma unroll
        for (int j = 0; j < 4; ++j) { const f32x4 a = *(const f32x4*)(P.lru_conv_w + j * 512 + ch0), c = *(const f32x4*)(P.lru_conv_w + j * 512 + ch0 + 4);
            w[j][0] = a.x; w[j][1] = a.y; w[j][2] = a.z; w[j][3] = a.w; w[j][4] = c.x; w[j][5] = c.y; w[j][6] = c.z; w[j][7] = c.w; }
        { const f32x4 a = *(const f32x4*)(P.lru_conv_b + ch0), c = *(const f32x4*)(P.lru_conv_b + ch0 + 4);
          cb[0] = a.x; cb[1] = a.y; cb[2] = a.z; cb[3] = a.w; cb[4] = c.x; cb[5] = c.y; cb[6] = c.z; cb[7] = c.w; }
        v4u xr[11];
#pragma unroll
        for (int r = 0; r < 11; ++r) xr[r] = *(const LAS v4u*)(rawx + (tseg * 8 + r) * 512 + ch0);
#pragma unroll
        for (int tk = 0; tk < 8; ++tk) {
            float y[8];
#pragma unroll
            for (int e = 0; e < 8; ++e) y[e] = cb[e];
#pragma unroll
            for (int j = 0; j < 4; ++j) { const v4u x = xr[tk + j];
                y[0] += w[j][0] * bflo(x.x); y[1] += w[j][1] * bfhi(x.x); y[2] += w[j][2] * bflo(x.y); y[3] += w[j][3] * bfhi(x.y);
                y[4] += w[j][4] * bflo(x.z); y[5] += w[j][5] * bfhi(x.z); y[6] += w[j][6] * bflo(x.w); y[7] += w[j][7] * bfhi(x.w); }
            v4u o; o.x = pk2(y[0], y[1]); o.y = pk2(y[2], y[3]); o.z = pk2(y[4], y[5]); o.w = pk2(y[6], y[7]);
            *(LAS v4u*)(xcb + (tseg * 8 + tk) * 520 + ch0) = o;
        }
    }
    GL_BAR();
    {
        const int g = wave, col = lane & 15, g4 = lane >> 4;
        LAS bf16* AM = (LAS bf16*)(lds + wave * 8192); LAS bf16* BT = AM + 2048;
        const bf16* WT = (const bf16*)(ws + WS_LRUWT) + (size_t)g * 8192;
        bf16x8 Bw[2][4][2];
#pragma unroll
        for (int m = 0; m < 2; ++m)
#pragma unroll
            for (int jt = 0; jt < 4; ++jt)
#pragma unroll
                for (int s2 = 0; s2 < 2; ++s2) Bw[m][jt][s2] = *(const bf16x8*)(WT + m * 4096 + (16 * jt + col) * 64 + 32 * s2 + 8 * g4);
        float cba[4], cbx[4], csp[4];
#pragma unroll
        for (int jt = 0; jt < 4; ++jt) { const int ch = g * 64 + 16 * jt + col; cba[jt] = P.lru_ba[ch]; cbx[jt] = P.lru_bx[ch]; csp[jt] = softplusf_(-P.lru_lambda[ch]); }
        bf16* HLOC = (bf16*)(ws + WS_HLOC); bf16* PCUM = (bf16*)(ws + WS_PCUM);
        const int chs = g * 64 + lane;
        float hst = 0.f, pc = 1.f;
#pragma unroll 1
        for (int half = 0; half < 2; ++half) {
            bf16x8 Af[2][2];
#pragma unroll
            for (int rho = 0; rho < 2; ++rho)
#pragma unroll
                for (int s2 = 0; s2 < 2; ++s2) Af[rho][s2] = *(const LAS bf16x8*)(xcb + (32 * half + 16 * rho + col) * 520 + g * 64 + 32 * s2 + 8 * g4);
#pragma unroll
            for (int jt = 0; jt < 4; ++jt) {
#pragma unroll
                for (int rho = 0; rho < 2; ++rho) {
                    f32x4 ra = (f32x4){0.f, 0.f, 0.f, 0.f}, rx = ra;
#pragma unroll
                    for (int s2 = 0; s2 < 2; ++s2) { ra = __builtin_amdgcn_mfma_f32_16x16x32_bf16(Af[rho][s2], Bw[0][jt][s2], ra, 0, 0, 0); rx = __builtin_amdgcn_mfma_f32_16x16x32_bf16(Af[rho][s2], Bw[1][jt][s2], rx, 0, 0, 0); }
#pragma unroll
                    for (int i = 0; i < 4; ++i) {
                        const int tokl = 16 * rho + 4 * g4 + i, chl = 16 * jt + col;
                        const float r = sigmoidf_(ra[i] + cba[jt]), ig = sigmoidf_(rx[i] + cbx[jt]);
                        const float log_a = -8.0f * r * csp[jt];
                        const float am = -expm1_small(log_a), a = 1.0f - am;
                        const float xo = bf1(xcb[(32 * half + tokl) * 520 + g * 64 + chl]);
                        const float bt = __builtin_amdgcn_sqrtf(fmaxf(am * (1.0f + a), 0.f)) * (ig * xo);
                        AM[tokl * 64 + chl] = (bf16)f2bf(am); BT[tokl * 64 + chl] = (bf16)f2bf(bt);
                    }
                }
            }
            LDS_WAIT(); asm volatile("" ::: "memory");
#pragma unroll 8
            for (int tk = 0; tk < 32; ++tk) {
                const float am = bf1(AM[tk * 64 + lane]), bt = bf1(BT[tk * 64 + lane]);
                hst = (hst - am * hst) + bt; pc = pc - am * pc;
                const size_t o = (size_t)(t0 + 32 * half + tk) * 512 + chs;
                HLOC[o] = (bf16)f2bf(hst); PCUM[o] = (bf16)f2bf(pc);
            }
            LDS_WAIT(); asm volatile("" ::: "memory");
        }
        ((float*)(ws + WS_HEND))[(size_t)lt * 512 + chs] = hst; ((float*)(ws + WS_PEND))[(size_t)lt * 512 + chs] = pc;
    }
    GL_BAR();
}

constexpr int SC_WN = 0, SC_QD = 64 * 272, SC_KD = 2 * 64 * 272, SC_ATT = 2 * 64 * 272 + 128 * 144, SC_BUF = 2 * 64 * 272 + 128 * 144 + 64 * 144;
constexpr int SC_SSQ = 2 * SC_BUF;
__device__ __forceinline__ int sc_lds_off(int id) {
    if (id < 1024) return SC_WN + (id >> 4) * 272 + (id & 15) * 16;
    if (id < 2048) { const int q = id - 1024; return SC_QD + (q >> 4) * 272 + (q & 15) * 16; }
    if (id < 3072) { const int q = id - 2048; return SC_KD + (q >> 3) * 144 + (q & 7) * 16; }
    const int q = id - 3072; return SC_ATT + (q >> 3) * 144 + (q & 7) * 16;
}
__device__ __forceinline__ const v4u* sc_src(const unsigned char* ws, int item, int id) {
    if (id < 1024) return (const v4u*)(ws + WS_WN + (size_t)item * 16384) + id;
    if (id < 2048) return (const v4u*)(ws + WS_QD + (size_t)item * 16384) + (id - 1024);
    if (id < 3072) return (const v4u*)(ws + WS_KD + (size_t)item * 16384) + (id - 2048);
    return (const v4u*)(ws + WS_ATT + (size_t)item * 8192) + (id - 3072);
}
__device__ __forceinline__ bf16x8 pack_b(const f32x4 a, const f32x4 b) {
    v4u r; r.x = pk2(a.x, a.y); r.y = pk2(a.z, a.w); r.z = pk2(b.x, b.y); r.w = pk2(b.z, b.w);
    return __builtin_bit_cast(bf16x8, r);
}
#define SC_BAR() do { asm volatile("s_waitcnt lgkmcnt(0)" ::: "memory"); __builtin_amdgcn_s_barrier(); asm volatile("" ::: "memory"); } while (0)
#define SC_GLD(dst, ptr) asm volatile("global_load_dwordx4 %0, %1, off" : "=v"(dst) : "v"(ptr) : "memory")
#define PIN8(a) asm volatile("" : "+v"(a[0]), "+v"(a[1]), "+v"(a[2]), "+v"(a[3]), "+v"(a[4]), "+v"(a[5]), "+v"(a[6]), "+v"(a[7]))
#define PIN16(a) asm volatile("" : "+v"(a[0]), "+v"(a[1]), "+v"(a[2]), "+v"(a[3]), "+v"(a[4]), "+v"(a[5]), "+v"(a[6]), "+v"(a[7]), "+v"(a[8]), "+v"(a[9]), "+v"(a[10]), "+v"(a[11]), "+v"(a[12]), "+v"(a[13]), "+v"(a[14]), "+v"(a[15]))
constexpr int SCAN_NWC = 2, SCAN_PARTS = 4, SCAN_WGS = 8 * SCAN_PARTS;
constexpr int SC_UFS = 2 * SC_BUF;
constexpr int SC_DECS = SC_UFS + 2 * SCAN_NWC * 2048;
constexpr int SC_OT = SC_DECS + 512;
constexpr int SC_RDY = SC_OT + 2 * 64 * 36 * 4;
constexpr int SC_END = SC_RDY + 64;
static_assert(SC_END <= MISC_OFF, "scan LDS");
#ifndef SCAN_REPS
#define SCAN_REPS 1
#endif
#ifndef SCAN_EXP
#define SCAN_EXP 0
#endif
__device__ __forceinline__ int sc3_lds_off(int id) {
    if (id < 3584) return sc_lds_off(id);
    return SC_UFS + (id - 3584) * 16;
}
__device__ __forceinline__ const v4u* sc3_src(const unsigned char* ws, int item, int id, int part) {
    if (id < 3584) return sc_src(ws, item, id);
    return (const v4u*)(ws + WS_UF + (size_t)item * 16384 + (size_t)(part * SCAN_NWC) * 2048) + (id - 3584);
}
__device__ __forceinline__ void gdn_scan(const Params& P, LAS unsigned char* lds, int sb, int tid, int lane, int wave) {
    const unsigned char* ws = P.ws;
    constexpr int NCH = 128 * SCAN_REPS, NPC = 15;
    const int bh = sb & 7, part = sb >> 3;
    const int b = bh >> 2, h = bh & 3, col = lane & 15, g = lane >> 4;
    const int item0 = bh * 128;
    if (tid == 0) *(volatile LAS unsigned*)(lds + SC_RDY) = 0u;
    SC_BAR();
    if (wave >= 4) {
        constexpr int NP = 15, DEP = 3;
        const int lt = tid - 256;
        const unsigned voff = (unsigned)lt * 16u;
        const int lA = (lt >> 4) * 272 + (lt & 15) * 16, lB = (lt >> 3) * 144 + (lt & 7) * 16, lU = SC_UFS + lt * 16;
        v4u rs[DEP][NP];
#define SC_ISSUE(set, itm) do { const unsigned char* gq_ = ws + (size_t)(itm) * 16384; const unsigned char* ga_ = ws + WS_ATT + (size_t)(itm) * 8192; \
            asm volatile("s_nop 4\n\tglobal_load_dwordx4 %0, %8, %9 sc0 sc1\n\tglobal_load_dwordx4 %1, %8, %10 sc0 sc1\n\tglobal_load_dwordx4 %2, %8, %11 sc0 sc1\n\tglobal_load_dwordx4 %3, %8, %12 sc0 sc1\n\t" \
                         "global_load_dwordx4 %4, %8, %13 sc0 sc1\n\tglobal_load_dwordx4 %5, %8, %14 sc0 sc1\n\tglobal_load_dwordx4 %6, %8, %15 sc0 sc1\n\tglobal_load_dwordx4 %7, %8, %16 sc0 sc1" \
                : "=&v"(rs[set][0]), "=&v"(rs[set][1]), "=&v"(rs[set][2]), "=&v"(rs[set][3]), "=&v"(rs[set][4]), "=&v"(rs[set][5]), "=&v"(rs[set][6]), "=&v"(rs[set][7]) \
                : "v"(voff), "s"(gq_ + WS_WN), "s"(gq_ + WS_WN + 4096), "s"(gq_ + WS_WN + 8192), "s"(gq_ + WS_WN + 12288), \
                  "s"(gq_ + WS_QD), "s"(gq_ + WS_QD + 4096), "s"(gq_ + WS_QD + 8192), "s"(gq_ + WS_QD + 12288) : "memory"); \
            asm volatile("s_nop 4\n\tglobal_load_dwordx4 %0, %7, %8 sc0 sc1\n\tglobal_load_dwordx4 %1, %7, %9 sc0 sc1\n\tglobal_load_dwordx4 %2, %7, %10 sc0 sc1\n\tglobal_load_dwordx4 %3, %7, %11 sc0 sc1\n\t" \
                         "global_load_dwordx4 %4, %7, %12 sc0 sc1\n\tglobal_load_dwordx4 %5, %7, %13 sc0 sc1\n\tglobal_load_dwordx4 %6, %7, %14 sc0 sc1" \
                : "=&v"(rs[set][8]), "=&v"(rs[set][9]), "=&v"(rs[set][10]), "=&v"(rs[set][11]), "=&v"(rs[set][12]), "=&v"(rs[set][13]), "=&v"(rs[set][14]) \
                : "v"(voff), "s"(gq_ + WS_KD), "s"(gq_ + WS_KD + 4096), "s"(gq_ + WS_KD + 8192), "s"(gq_ + WS_KD + 12288), \
                  "s"(ga_), "s"(ga_ + 4096), "s"(gq_ + WS_UF + (size_t)(part * SCAN_NWC) * 2048) : "memory"); } while (0)
#define SC_WAITSET(set, cnt) asm volatile("s_waitcnt " cnt : "+v"(rs[set][0]), "+v"(rs[set][1]), "+v"(rs[set][2]), "+v"(rs[set][3]), "+v"(rs[set][4]), "+v"(rs[set][5]), "+v"(rs[set][6]), "+v"(rs[set][7]), \
            "+v"(rs[set][8]), "+v"(rs[set][9]), "+v"(rs[set][10]), "+v"(rs[set][11]), "+v"(rs[set][12]), "+v"(rs[set][13]), "+v"(rs[set][14]) :: "memory")
#define SC_WRITE(set, par) do { LAS unsigned char* wb_ = lds + (par) * SC_BUF; \
            _Pragma("unroll") for (int r = 0; r < 4; ++r) { *(LAS v4u*)(wb_ + SC_WN + lA + r * (16 * 272)) = rs[set][r]; *(LAS v4u*)(wb_ + SC_QD + lA + r * (16 * 272)) = rs[set][4 + r]; \
                                                          *(LAS v4u*)(wb_ + SC_KD + lB + r * (32 * 144)) = rs[set][8 + r]; } \
            *(LAS v4u*)(wb_ + SC_ATT + lB) = rs[set][12]; *(LAS v4u*)(wb_ + SC_ATT + lB + 32 * 144) = rs[set][13]; \
            *(LAS v4u*)(lds + lU + (par) * (SCAN_NWC * 2048)) = rs[set][14]; } while (0)
#define SC_NEED(c) do { unsigned sp_ = 0; while (*(volatile LAS unsigned*)(lds + SC_RDY) <= (unsigned)(c) && ++sp_ < (1u << 24)) __builtin_amdgcn_s_sleep(2); } while (0)
        SC_NEED(0); SC_ISSUE(0, item0);
        SC_WAITSET(0, "vmcnt(0)"); SC_WRITE(0, 0); SC_WAITSET(0, "lgkmcnt(0)");
        SC_NEED(3); SC_ISSUE(1, item0 + 1); SC_ISSUE(2, item0 + 2); SC_ISSUE(0, item0 + 3);
        SC_BAR();
        int n2 = 0;
#define SC_INTERVAL(set) do { SC_WAITSET(set, "vmcnt(30)"); SC_WRITE(set, (n2 + 1) & 1); SC_WAITSET(set, "lgkmcnt(0)"); if (n2 + 1 + DEP < 128) SC_NEED(n2 + 1 + DEP); SC_ISSUE(set, item0 + ((n2 + 1 + DEP) & 127)); SC_BAR(); ++n2; } while (0)
#pragma unroll 1
        for (int it = 0; it < NCH / 3; ++it) { SC_INTERVAL(1); SC_INTERVAL(2); SC_INTERVAL(0); }
        if (NCH % 3 >= 1) SC_INTERVAL(1);
        if (NCH % 3 >= 2) SC_INTERVAL(2);
        SC_WAITSET(0, "vmcnt(0)"); SC_WAITSET(1, "vmcnt(0)"); SC_WAITSET(2, "vmcnt(0)");
#undef SC_INTERVAL
#undef SC_NEED
#undef SC_WRITE
#undef SC_WAITSET
#undef SC_ISSUE
        return;
    }
    if (wave == 3) {
        const unsigned* flags = (const unsigned*)(ws + WS_CTL) + CW_GFLAG + item0;
        unsigned rdy = 0;
#define SC_POLLSTEP() do { if (rdy < 128u) { const unsigned idx_ = rdy + (unsigned)lane; \
            const unsigned fv_ = (idx_ < 128u) ? __hip_atomic_load(flags + idx_, __ATOMIC_RELAXED, __HIP_MEMORY_SCOPE_AGENT) : 0u; \
            const unsigned long long m_ = __ballot(fv_ != 0u); const unsigned nrun_ = (m_ == ~0ull) ? 64u : (unsigned)__builtin_ctzll(~m_);     \
            if ((unsigned)lane < nrun_) ((LAS float*)(lds + SC_DECS))[idx_] = __builtin_bit_cast(float, fv_); \
            rdy += nrun_; LDS_WAIT(); if (lane == 0) *(volatile LAS unsigned*)(lds + SC_RDY) = rdy; } } while (0)
        { unsigned sp = 0; while (rdy < 4u && ++sp < (1u << 22)) { SC_POLLSTEP(); if (rdy < 4u) __builtin_amdgcn_s_sleep(16); } }
        SC_BAR();
#pragma unroll 1
        for (int n2 = 0; n2 < NCH; ++n2) {
            { const unsigned need = (unsigned)(n2 + 1 + 3) < 128u ? (unsigned)(n2 + 1 + 3) : 127u; unsigned sp = 0;
              while (rdy <= need && rdy < 128u && ++sp < (1u << 22)) { SC_POLLSTEP(); if (rdy <= need) __builtin_amdgcn_s_sleep(8); } }
            if (rdy < 128u && rdy < (unsigned)(n2 & 127) + 16u) SC_POLLSTEP();
            SC_BAR();
        }
#undef SC_POLLSTEP
        return;
    }
    if (wave == 2) {
        const int row = lane;
        bf16* Y = (bf16*)((unsigned char*)P.out + OUT_Y);
        float* SSQG = P.out;
        SC_BAR();
#pragma unroll 1
        for (int n2 = 0; n2 <= NCH; ++n2) {
            if (n2 > 0) {
                const int n = (n2 - 1) & 127, t = b * SEQ + n * 64 + row;
                const LAS float* src = (const LAS float*)(lds + SC_OT + ((n2 - 1) & 1) * (64 * 36 * 4)) + row * 36;
                f32x4 a[8]; float s2 = 0.f;
#pragma unroll
                for (int q = 0; q < 8; ++q) { a[q] = *(const LAS f32x4*)(src + 4 * q); s2 += (a[q].x * a[q].x + a[q].y * a[q].y) + (a[q].z * a[q].z + a[q].w * a[q].w); }
                SSQG[(size_t)t * 32 + h * 8 + part] = s2;
                v4u* d = (v4u*)(Y + (size_t)t * 1024 + h * 128 + 32 * part);
#pragma unroll
                for (int q = 0; q < 4; ++q) { v4u o; o.x = pk2(a[2 * q].x, a[2 * q].y); o.y = pk2(a[2 * q].z, a[2 * q].w); o.z = pk2(a[2 * q + 1].x, a[2 * q + 1].y); o.w = pk2(a[2 * q + 1].z, a[2 * q + 1].w); d[q] = o; }
            }
            if (n2 < NCH) SC_BAR();
        }
        return;
    }
    f32x4 S[8];
#pragma unroll
    for (int i = 0; i < 8; ++i) S[i] = (f32x4){0.f, 0.f, 0.f, 0.f};
    SC_BAR();
#pragma unroll 1
    for (int n2 = 0; n2 < NCH; ++n2) {
        if (SCAN_REPS > 1 && (n2 & 127) == 0) {
#pragma unroll
            for (int i = 0; i < 8; ++i) S[i] = (f32x4){0.f, 0.f, 0.f, 0.f};
        }
        if (SCAN_EXP == 2 && n2 < 128) { SC_BAR(); continue; }
        const int par = n2 & 1;
        LAS unsigned char* buf = lds + par * SC_BUF;
        bf16x8 fA[16], fB[16], fC[16], fD[8];
#pragma unroll
        for (int rho = 0; rho < 4; ++rho)
#pragma unroll
            for (int s = 0; s < 4; ++s) fA[rho * 4 + s] = *(const LAS bf16x8*)(buf + SC_WN + (16 * rho + col) * 272 + (32 * s + 8 * g) * 2);
#pragma unroll
        for (int rho = 0; rho < 4; ++rho)
#pragma unroll
            for (int s = 0; s < 4; ++s) fB[rho * 4 + s] = *(const LAS bf16x8*)(buf + SC_QD + (16 * rho + col) * 272 + (32 * s + 8 * g) * 2);
        const LAS v4u* ufp = (const LAS v4u*)(lds + SC_UFS + par * (SCAN_NWC * 2048) + wave * 2048 + lane * 32);
        const v4u uf0 = ufp[0], uf1 = ufp[1];
        const float dec = ((const LAS float*)(lds + SC_DECS))[n2 & 127];
        bf16x8 Bs[4];
#pragma unroll
        for (int s = 0; s < 4; ++s) Bs[s] = pack_b(S[2 * s], S[2 * s + 1]);
        f32x4 Vn[4], Oc[4];
        Vn[0] = (f32x4){bflo(uf0.x), bfhi(uf0.x), bflo(uf0.y), bfhi(uf0.y)}; Vn[1] = (f32x4){bflo(uf0.z), bfhi(uf0.z), bflo(uf0.w), bfhi(uf0.w)};
        Vn[2] = (f32x4){bflo(uf1.x), bfhi(uf1.x), bflo(uf1.y), bfhi(uf1.y)}; Vn[3] = (f32x4){bflo(uf1.z), bfhi(uf1.z), bflo(uf1.w), bfhi(uf1.w)};
        __builtin_amdgcn_sched_barrier(0);
        PIN16(fA);
#pragma unroll
        for (int s = 0; s < 4; ++s)
#pragma unroll
            for (int rho = 0; rho < 4; ++rho) Vn[rho] = __builtin_amdgcn_mfma_f32_16x16x32_bf16(fA[rho * 4 + s], Bs[s], Vn[rho], 0, 0, 0);
        __builtin_amdgcn_sched_barrier(0);
#pragma unroll
        for (int tau = 0; tau < 8; ++tau)
#pragma unroll
            for (int s = 0; s < 2; ++s) fC[tau * 2 + s] = *(const LAS bf16x8*)(buf + SC_KD + (16 * tau + col) * 144 + (32 * s + 8 * g) * 2);
        __builtin_amdgcn_sched_barrier(0);
        PIN16(fB);
#pragma unroll
        for (int rho = 0; rho < 4; ++rho) Oc[rho] = (f32x4){0.f, 0.f, 0.f, 0.f};
#pragma unroll
        for (int s = 0; s < 4; ++s)
#pragma unroll
            for (int rho = 0; rho < 4; ++rho) Oc[rho] = __builtin_amdgcn_mfma_f32_16x16x32_bf16(fB[rho * 4 + s], Bs[s], Oc[rho], 0, 0, 0);
        __builtin_amdgcn_sched_barrier(0);
#pragma unroll
        for (int rho = 0; rho < 4; ++rho)
#pragma unroll
            for (int s = 0; s < 2; ++s) fD[rho * 2 + s] = *(const LAS bf16x8*)(buf + SC_ATT + (16 * rho + col) * 144 + (32 * s + 8 * g) * 2);
        bf16x8 Bv[2];
        Bv[0] = pack_b(Vn[0], Vn[1]); Bv[1] = pack_b(Vn[2], Vn[3]);
#pragma unroll
        for (int tau = 0; tau < 8; ++tau) S[tau] = S[tau] * dec;
        __builtin_amdgcn_sched_barrier(0);
        PIN16(fC);
#pragma unroll
        for (int s = 0; s < 2; ++s)
#pragma unroll
            for (int tau = 0; tau < 8; ++tau) S[tau] = __builtin_amdgcn_mfma_f32_16x16x32_bf16(fC[tau * 2 + s], Bv[s], S[tau], 0, 0, 0);
        __builtin_amdgcn_sched_barrier(0);
        PIN8(fD);
#pragma unroll
        for (int s = 0; s < 2; ++s)
#pragma unroll
            for (int rho = 0; rho < 4; ++rho) Oc[rho] = __builtin_amdgcn_mfma_f32_16x16x32_bf16(fD[rho * 2 + s], Bv[s], Oc[rho], 0, 0, 0);
        LAS float* ot = (LAS float*)(lds + SC_OT + par * (64 * 36 * 4)) + 16 * wave + col;
#pragma unroll
        for (int rho = 0; rho < 4; ++rho)
#pragma unroll
            for (int i = 0; i < 4; ++i) ot[(16 * rho + 4 * g + i) * 36] = Oc[rho][i];
        SC_BAR();
    }
}

__device__ __forceinline__ void lru_carry(const Params& P, int gwv, int lane) {
    unsigned char* ws = P.ws;
    const int b = gwv >> 3, g = gwv & 7, ch = g * 64 + lane;
    const float* HEND = (const float*)(ws + WS_HEND); const float* PEND = (const float*)(ws + WS_PEND); float* HIN = (float*)(ws + WS_HIN);
    float hin = 0.f;
#pragma unroll 1
    for (int n0 = 0; n0 < 128; n0 += 32) {
        float he[32], pe[32];
#pragma unroll
        for (int i = 0; i < 32; ++i) { const size_t o = (size_t)(b * 128 + n0 + i) * 512 + ch; he[i] = HEND[o]; pe[i] = PEND[o]; }
#pragma unroll
        for (int i = 0; i < 32; ++i) { HIN[(size_t)(b * 128 + n0 + i) * 512 + ch] = hin; hin = he[i] + pe[i] * hin; }
    }
}

__device__ __forceinline__ void cvt_table(const float* src, bf16* dst, size_t n8, size_t wi, size_t nw) {
    for (size_t i = wi; i < n8; i += nw) {
        const f32x4 a = ((const f32x4*)src)[2 * i], c = ((const f32x4*)src)[2 * i + 1];
        v4u o; o.x = pk2(a.x, a.y); o.y = pk2(a.z, a.w); o.z = pk2(c.x, c.y); o.w = pk2(c.z, c.w);
        ((v4u*)dst)[i] = o;
    }
}

__device__ __forceinline__ void lru_combine(const Params& P, size_t wi, size_t nw) {
    unsigned char* ws = P.ws;
    const v4u* HLOC = (const v4u*)(ws + WS_HLOC); const v4u* PCUM = (const v4u*)(ws + WS_PCUM); const v4u* GATE = (const v4u*)(ws + WS_GATE);
    const float* HIN = (const float*)(ws + WS_HIN); bf16* Y = (bf16*)((unsigned char*)P.out + OUT_Y);
    for (size_t i = wi; i < (size_t)T * 64; i += nw) {
        const size_t t = i >> 6; const int ch0 = (int)(i & 63) * 8;
        const v4u hl = HLOC[i], pc = PCUM[i], gt = GATE[i];
        const f32x4 h0 = *(const f32x4*)(HIN + (t >> 6) * 512 + ch0), h1 = *(const f32x4*)(HIN + (t >> 6) * 512 + ch0 + 4);
        float y[8];
        y[0] = (bflo(hl.x) + bflo(pc.x) * h0.x) * gelu_tanh(bflo(gt.x)); y[1] = (bfhi(hl.x) + bfhi(pc.x) * h0.y) * gelu_tanh(bfhi(gt.x));
        y[2] = (bflo(hl.y) + bflo(pc.y) * h0.z) * gelu_tanh(bflo(gt.y)); y[3] = (bfhi(hl.y) + bfhi(pc.y) * h0.w) * gelu_tanh(bfhi(gt.y));
        y[4] = (bflo(hl.z) + bflo(pc.z) * h1.x) * gelu_tanh(bflo(gt.z)); y[5] = (bfhi(hl.z) + bfhi(pc.z) * h1.y) * gelu_tanh(bfhi(gt.z));
        y[6] = (bflo(hl.w) + bflo(pc.w) * h1.z) * gelu_tanh(bflo(gt.w)); y[7] = (bfhi(hl.w) + bfhi(pc.w) * h1.w) * gelu_tanh(bfhi(gt.w));
        v4u o; o.x = pk2(y[0], y[1]); o.y = pk2(y[2], y[3]); o.z = pk2(y[4], y[5]); o.w = pk2(y[6], y[7]);
        *(v4u*)(Y + t * 1024 + 512 + ch0) = o;
    }
}

__device__ __forceinline__ void gdn_gate_norm(const Params& P, size_t wi, size_t nw) {
    unsigned char* ws = P.ws;
    bf16* Y = (bf16*)((unsigned char*)P.out + OUT_Y); const v4u* Z = (const v4u*)(ws + WS_Z); const float* SSQG = P.out;
    for (size_t i = wi; i < (size_t)T * 64; i += nw) {
        const size_t t = i >> 6; const int c0 = (int)(i & 63) * 8, h = c0 >> 7;
        const f32x4 q0 = *(const f32x4*)(SSQG + t * 32 + h * 8);
        const float rstd = rsqrtf(((q0.x + q0.y) + (q0.z + q0.w)) * (1.0f / 128.0f) + 1e-6f);
        const v4u o = *(const v4u*)(Y + t * 1024 + c0), z = Z[i];
        const f32x4 w0 = *(const f32x4*)(P.gdn_norm_w + (c0 & 127)), w1 = *(const f32x4*)(P.gdn_norm_w + (c0 & 127) + 4);
        float y[8];
        y[0] = bflo(o.x) * rstd * w0.x * siluf_(bflo(z.x)); y[1] = bfhi(o.x) * rstd * w0.y * siluf_(bfhi(z.x));
        y[2] = bflo(o.y) * rstd * w0.z * siluf_(bflo(z.y)); y[3] = bfhi(o.y) * rstd * w0.w * siluf_(bfhi(z.y));
        y[4] = bflo(o.z) * rstd * w1.x * siluf_(bflo(z.z)); y[5] = bfhi(o.z) * rstd * w1.y * siluf_(bfhi(z.z));
        y[6] = bflo(o.w) * rstd * w1.z * siluf_(bflo(z.w)); y[7] = bfhi(o.w) * rstd * w1.w * siluf_(bfhi(z.w));
        v4u r; r.x = pk2(y[0], y[1]); r.y = pk2(y[2], y[3]); r.z = pk2(y[4], y[5]); r.w = pk2(y[6], y[7]);
        *(v4u*)(Y + t * 1024 + c0) = r;
    }
}

__device__ __forceinline__ void xattn_stage(LAS unsigned char* lds, const bf16* src, int tid) {
    v4u tmp[16];
    const unsigned voff = (unsigned)tid * 16u;
#pragma unroll
    for (int r = 0; r < 16; ++r) { const unsigned char* sb = (const unsigned char*)src + r * 8192;
        asm volatile("s_nop 4\n\tglobal_load_dwordx4 %0, %1, %2" : "=&v"(tmp[r]) : "v"(voff), "s"(sb) : "memory"); }
    asm volatile("s_waitcnt vmcnt(0)" : "+v"(tmp[0]), "+v"(tmp[1]), "+v"(tmp[2]), "+v"(tmp[3]), "+v"(tmp[4]), "+v"(tmp[5]), "+v"(tmp[6]), "+v"(tmp[7]),
                                        "+v"(tmp[8]), "+v"(tmp[9]), "+v"(tmp[10]), "+v"(tmp[11]), "+v"(tmp[12]), "+v"(tmp[13]), "+v"(tmp[14]), "+v"(tmp[15]) :: "memory");
#pragma unroll
    for (int r = 0; r < 16; ++r) { const int id = tid + 512 * r; *(LAS v4u*)(lds + (id >> 5) * 528 + (id & 31) * 16) = tmp[r]; }
}
__device__ __forceinline__ void xattn_unit(const Params& P, LAS unsigned char* lds, int unit, int tid, int lane, int wave) {
    const unsigned char* ws = P.ws;
    const int h = unit & 3, qb = (unit >> 2) & 63, b = unit >> 8, col = lane & 15, g = lane >> 4;
    const int tw = b * SEQ + qb * 128 + 16 * wave;
    const bf16* Kb = (const bf16*)(ws + WS_KB) + (size_t)((b * 4 + h) * 256) * 256;
    const bf16* Vt = (const bf16*)(ws + WS_VTP) + (size_t)((b * 4 + h) * 256) * 256;
    xattn_stage(lds, Kb, tid);
    __syncthreads();
    const LAS unsigned char* arow = lds + col * 528 + g * 16;
    bf16x8 Bp[1][8]; float inv[1];
#pragma unroll
    for (int ps = 0; ps < 1; ++ps) {
        const bf16* Q = (const bf16*)(ws + WS_Q) + (size_t)(tw + 16 * ps + col) * 1024 + h * 256 + 8 * g;
        bf16x8 Bq[8];
#pragma unroll
        for (int s = 0; s < 8; ++s) Bq[s] = *(const bf16x8*)(Q + 32 * s);
        f32x4 St[16];
        bf16x8 fr[2][8];
#pragma unroll
        for (int s = 0; s < 8; ++s) fr[0][s] = *(const LAS bf16x8*)(arow + 64 * s);
#pragma unroll
        for (int kap = 0; kap < 16; ++kap) {
            if (kap + 1 < 16) {
#pragma unroll
                for (int s = 0; s < 8; ++s) fr[(kap + 1) & 1][s] = *(const LAS bf16x8*)(arow + (16 * (kap + 1)) * 528 + 64 * s);
            }
            __builtin_amdgcn_sched_barrier(0);
            PIN8(fr[kap & 1]);
            f32x4 acc = (f32x4){0.f, 0.f, 0.f, 0.f};
#pragma unroll
            for (int s = 0; s < 8; ++s) acc = __builtin_amdgcn_mfma_f32_16x16x32_bf16(fr[kap & 1][s], Bq[s], acc, 0, 0, 0);
            St[kap] = acc;
            __builtin_amdgcn_sched_barrier(0);
        }
        float mx = -3.0e38f;
#pragma unroll
        for (int kap = 0; kap < 16; ++kap) mx = fmaxf(fmaxf(fmaxf(St[kap].x, St[kap].y), fmaxf(St[kap].z, St[kap].w)), mx);
        mx = fmaxf(mx, __shfl_xor(mx, 16)); mx = fmaxf(mx, __shfl_xor(mx, 32));
        float l = 0.f;
#pragma unroll
        for (int kap = 0; kap < 16; ++kap) { St[kap].x = __expf(St[kap].x - mx); St[kap].y = __expf(St[kap].y - mx); St[kap].z = __expf(St[kap].z - mx); St[kap].w = __expf(St[kap].w - mx);
            l += (St[kap].x + St[kap].y) + (St[kap].z + St[kap].w); }
        l += __shfl_xor(l, 16); l += __shfl_xor(l, 32);
        inv[ps] = 1.0f / l;
#pragma unroll
        for (int s = 0; s < 8; ++s) Bp[ps][s] = pack_b(St[2 * s], St[2 * s + 1]);
    }
    __syncthreads();
    xattn_stage(lds, Vt, tid);
    __syncthreads();
#pragma unroll
    for (int ps = 0; ps < 1; ++ps) {
        bf16* AO = (bf16*)(P.ws + WS_AO) + (size_t)(tw + 16 * ps + col) * 1024 + h * 256 + 4 * g;
        bf16x8 fr[2][8];
#pragma unroll
        for (int s = 0; s < 8; ++s) fr[0][s] = *(const LAS bf16x8*)(arow + 64 * s);
#pragma unroll
        for (int del = 0; del < 16; ++del) {
            if (del + 1 < 16) {
#pragma unroll
                for (int s = 0; s < 8; ++s) fr[(del + 1) & 1][s] = *(const LAS bf16x8*)(arow + (16 * (del + 1)) * 528 + 64 * s);
            }
            __builtin_amdgcn_sched_barrier(0);
            PIN8(fr[del & 1]);
            f32x4 acc = (f32x4){0.f, 0.f, 0.f, 0.f};
#pragma unroll
            for (int s = 0; s < 8; ++s) acc = __builtin_amdgcn_mfma_f32_16x16x32_bf16(fr[del & 1][s], Bp[ps][s], acc, 0, 0, 0);
            v2u o; o.x = pk2(acc.x * inv[ps], acc.y * inv[ps]); o.y = pk2(acc.z * inv[ps], acc.w * inv[ps]);
            *(v2u*)(AO + 16 * del) = o;
            __builtin_amdgcn_sched_barrier(0);
        }
    }
    __syncthreads();
}

__device__ __forceinline__ unsigned key_enc(float f) { const unsigned u = __builtin_bit_cast(unsigned, f); return (u & 0x80000000u) ? ~u : (u | 0x80000000u); }
__device__ __forceinline__ float key_dec(unsigned k) { const unsigned u = (k & 0x80000000u) ? (k & 0x7fffffffu) : ~k; return __builtin_bit_cast(float, u); }
#define TK_CAS(a, b) do { const unsigned hi_ = max(a, b), lo_ = min(a, b); a = hi_; b = lo_; } while (0)
__device__ __forceinline__ void tk_merge16(unsigned (&a)[16]) {
#pragma unroll
    for (int j = 8; j > 0; j >>= 1)
#pragma unroll
        for (int i = 0; i < 16; ++i) { const int l = i ^ j; if (l > i) TK_CAS(a[i], a[l]); }
}
__device__ __forceinline__ void tk_sort16(unsigned (&a)[16]) {
#pragma unroll
    for (int k = 2; k <= 16; k <<= 1)
#pragma unroll
        for (int j = k >> 1; j > 0; j >>= 1)
#pragma unroll
            for (int i = 0; i < 16; ++i) { const int l = i ^ j; if (l > i) { if ((i & k) == 0) TK_CAS(a[i], a[l]); else TK_CAS(a[l], a[i]); } }
}
__device__ __forceinline__ void tk_top16_merge(unsigned (&L)[16], const unsigned (&G)[16]) {
#pragma unroll
    for (int i = 0; i < 16; ++i) L[i] = max(L[i], G[15 - i]);
    tk_merge16(L);
}
__device__ __forceinline__ void tk_pair_merge(unsigned (&L)[16]) {
    unsigned Pp[16];
#pragma unroll
    for (int i = 0; i < 16; ++i) Pp[i] = (unsigned)__builtin_amdgcn_update_dpp(0, (int)L[i], 0xB1, 0xF, 0xF, true);
    tk_top16_merge(L, Pp);
}
__device__ __forceinline__ void peer_topk_rows(const Params& P, LAS unsigned char* lds, int rowbase, int tid) {
    const unsigned char* ws = P.ws;
    typedef _Float16 f16x8 __attribute__((ext_vector_type(8)));
    const int rl = tid >> 1, hf = tid & 1, grow = rowbase + rl, t = grow >> 3, h = grow & 7;
    const _Float16* SC = (const _Float16*)(ws + WS_PQ) + (size_t)t * 2048 + h * 256 + 64 * hf;
    f16x8 raw[2][8];
#pragma unroll
    for (int p = 0; p < 2; ++p)
#pragma unroll
        for (int q = 0; q < 8; ++q) raw[p][q] = *(const f16x8*)(SC + p * 128 + 8 * q);
    unsigned L1[16], L2[16];
#pragma unroll
    for (int p = 0; p < 2; ++p) {
        unsigned L[16];
#pragma unroll
        for (int grp = 0; grp < 4; ++grp) {
            unsigned G[16];
#pragma unroll
            for (int e = 0; e < 16; ++e) G[e] = (key_enc((float)raw[p][2 * grp + (e >> 3)][e & 7]) & ~127u) | (unsigned)(127 - (64 * hf + 16 * grp + e));
            tk_sort16(G);
            if (grp == 0) {
#pragma unroll
                for (int i = 0; i < 16; ++i) L[i] = G[i];
            } else tk_top16_merge(L, G);
        }
        tk_pair_merge(L);
#pragma unroll
        for (int i = 0; i < 16; ++i) { if (p == 0) L1[i] = L[i]; else L2[i] = L[i]; }
    }
    {
        float v1[16], v2[16];
        LAS int* il = (LAS int*)lds + rl * 33;
#pragma unroll
        for (int q = 0; q < 16; ++q) { v1[q] = key_dec((L1[q] & ~127u) | 64u); v2[q] = key_dec((L2[q] & ~127u) | 64u); }
        if (hf == 0) {
#pragma unroll
            for (int q = 0; q < 16; ++q) { il[q] = 127 - (int)(L1[q] & 127u); il[16 + q] = 127 - (int)(L2[q] & 127u); }
        }
        unsigned C[16], D[16];
        float w1[8];
        const unsigned hf16 = (unsigned)hf * 16u, evenmask = (unsigned)hf - 1u;
#pragma unroll
        for (int k = 0; k < 8; ++k) w1[k] = __builtin_bit_cast(float, (__builtin_bit_cast(unsigned, v1[2 * k]) & evenmask) | (__builtin_bit_cast(unsigned, v1[2 * k + 1]) & ~evenmask));
#define TK_SLOT(dst, k, bq, valid_odd) do { const unsigned pos_ = (unsigned)(16 * (2 * (k)) + (bq)) + hf16; unsigned kv_ = (key_enc(w1[k] + v2[bq]) & ~255u) | (255u - pos_); if (!(valid_odd)) kv_ &= evenmask; dst = kv_; } while (0)
        TK_SLOT(C[0], 0, 0, true);
        TK_SLOT(C[1], 0, 1, true);
        TK_SLOT(C[2], 0, 2, true);
        TK_SLOT(C[3], 0, 3, true);
        TK_SLOT(C[4], 0, 4, true);
        TK_SLOT(C[5], 0, 5, true);
        TK_SLOT(C[6], 0, 6, true);
        TK_SLOT(C[7], 0, 7, true);
        TK_SLOT(C[8], 0, 8, false);
        TK_SLOT(C[9], 0, 9, false);
        TK_SLOT(C[10], 0, 10, false);
        TK_SLOT(C[11], 0, 11, false);
        TK_SLOT(C[12], 0, 12, false);
        TK_SLOT(C[13], 0, 13, false);
        TK_SLOT(C[14], 0, 14, false);
        TK_SLOT(C[15], 0, 15, false);
        TK_SLOT(D[0], 1, 0, true);
        TK_SLOT(D[1], 1, 1, true);
        TK_SLOT(D[2], 1, 2, true);
        TK_SLOT(D[3], 1, 3, true);
        TK_SLOT(D[4], 1, 4, false);
        TK_SLOT(D[5], 2, 0, true);
        TK_SLOT(D[6], 2, 1, true);
        TK_SLOT(D[7], 2, 2, false);
        TK_SLOT(D[8], 3, 0, true);
        TK_SLOT(D[9], 3, 1, true);
        TK_SLOT(D[10], 4, 0, true);
        TK_SLOT(D[11], 5, 0, true);
        TK_SLOT(D[12], 6, 0, true);
        TK_SLOT(D[13], 7, 0, true);
        D[14] = 0u; D[15] = 0u;
#undef TK_SLOT
        tk_sort16(C); tk_sort16(D); tk_top16_merge(C, D); tk_pair_merge(C);
        LDS_WAIT(); asm volatile("" ::: "memory");
        float best[16], e[16], sum = 0.f;
#pragma unroll
        for (int q = 0; q < 16; ++q) { best[q] = key_dec((C[q] & ~255u) | 128u); e[q] = __expf(best[q] - best[0]); sum += e[q]; }
        const float inv = __builtin_amdgcn_rcpf(sum);
        int* IDX = (int*)(P.ws + WS_IDX) + (size_t)grow * 16 + 8 * hf; float* GW = (float*)(P.ws + WS_GW) + (size_t)grow * 16 + 8 * hf;
#pragma unroll
        for (int q = 0; q < 8; ++q) {
            const unsigned c = (C[q] & evenmask) | (C[8 + q] & ~evenmask);
            const float ev = __builtin_bit_cast(float, (__builtin_bit_cast(unsigned, e[q]) & evenmask) | (__builtin_bit_cast(unsigned, e[8 + q]) & ~evenmask));
            const unsigned pos = 255u - (c & 255u);
            IDX[q] = il[pos >> 4] * 128 + il[16 + (pos & 15u)]; GW[q] = ev * inv;
        }
    }
    LDS_WAIT(); asm volatile("" ::: "memory");
}

__device__ __forceinline__ void peer_topk_wave(const Params& P, LAS int* ilw, LAS unsigned* oute, LAS float* outg, int tbase, int lane) {
    const unsigned char* ws = P.ws;
    typedef _Float16 f16x8 __attribute__((ext_vector_type(8)));
    const int rl = lane >> 1, hf = lane & 1, t = tbase + (rl >> 3), h = rl & 7;
    const _Float16* SC = (const _Float16*)(ws + WS_PQ) + (size_t)t * 2048 + h * 256 + 64 * hf;
    f16x8 raw[2][8];
#pragma unroll
    for (int p = 0; p < 2; ++p)
#pragma unroll
        for (int q = 0; q < 8; ++q) raw[p][q] = *(const f16x8*)(SC + p * 128 + 8 * q);
    unsigned L1[16], L2[16];
#pragma unroll
    for (int p = 0; p < 2; ++p) {
        unsigned L[16];
#pragma unroll
        for (int grp = 0; grp < 4; ++grp) {
            unsigned G[16];
#pragma unroll
            for (int e = 0; e < 16; ++e) G[e] = (key_enc((float)raw[p][2 * grp + (e >> 3)][e & 7]) & ~127u) | (unsigned)(127 - (64 * hf + 16 * grp + e));
            tk_sort16(G);
            if (grp == 0) {
#pragma unroll
                for (int i = 0; i < 16; ++i) L[i] = G[i];
            } else tk_top16_merge(L, G);
        }
        tk_pair_merge(L);
#pragma unroll
        for (int i = 0; i < 16; ++i) { if (p == 0) L1[i] = L[i]; else L2[i] = L[i]; }
    }
    {
        float v1[16], v2[16];
        LAS int* il = ilw + rl * 33;
#pragma unroll
        for (int q = 0; q < 16; ++q) { v1[q] = key_dec((L1[q] & ~127u) | 64u); v2[q] = key_dec((L2[q] & ~127u) | 64u); }
        if (hf == 0) {
#pragma unroll
            for (int q = 0; q < 16; ++q) { il[q] = 127 - (int)(L1[q] & 127u); il[16 + q] = 127 - (int)(L2[q] & 127u); }
        }
        unsigned C[16], D[16];
        float w1[8];
        const unsigned hf16 = (unsigned)hf * 16u, evenmask = (unsigned)hf - 1u;
#pragma unroll
        for (int k = 0; k < 8; ++k) w1[k] = __builtin_bit_cast(float, (__builtin_bit_cast(unsigned, v1[2 * k]) & evenmask) | (__builtin_bit_cast(unsigned, v1[2 * k + 1]) & ~evenmask));
#define TK_SLOT(dst, k, bq, valid_odd) do { const unsigned pos_ = (unsigned)(16 * (2 * (k)) + (bq)) + hf16; unsigned kv_ = (key_enc(w1[k] + v2[bq]) & ~255u) | (255u - pos_); if (!(valid_odd)) kv_ &= evenmask; dst = kv_; } while (0)
        TK_SLOT(C[0], 0, 0, true);
        TK_SLOT(C[1], 0, 1, true);
        TK_SLOT(C[2], 0, 2, true);
        TK_SLOT(C[3], 0, 3, true);
        TK_SLOT(C[4], 0, 4, true);
        TK_SLOT(C[5], 0, 5, true);
        TK_SLOT(C[6], 0, 6, true);
        TK_SLOT(C[7], 0, 7, true);
        TK_SLOT(C[8], 0, 8, false);
        TK_SLOT(C[9], 0, 9, false);
        TK_SLOT(C[10], 0, 10, false);
        TK_SLOT(C[11], 0, 11, false);
        TK_SLOT(C[12], 0, 12, false);
        TK_SLOT(C[13], 0, 13, false);
        TK_SLOT(C[14], 0, 14, false);
        TK_SLOT(C[15], 0, 15, false);
        TK_SLOT(D[0], 1, 0, true);
        TK_SLOT(D[1], 1, 1, true);
        TK_SLOT(D[2], 1, 2, true);
        TK_SLOT(D[3], 1, 3, true);
        TK_SLOT(D[4], 1, 4, false);
        TK_SLOT(D[5], 2, 0, true);
        TK_SLOT(D[6], 2, 1, true);
        TK_SLOT(D[7], 2, 2, false);
        TK_SLOT(D[8], 3, 0, true);
        TK_SLOT(D[9], 3, 1, true);
        TK_SLOT(D[10], 4, 0, true);
        TK_SLOT(D[11], 5, 0, true);
        TK_SLOT(D[12], 6, 0, true);
        TK_SLOT(D[13], 7, 0, true);
        D[14] = 0u; D[15] = 0u;
#undef TK_SLOT
        tk_sort16(C); tk_sort16(D); tk_top16_merge(C, D); tk_pair_merge(C);
        LDS_WAIT(); asm volatile("" ::: "memory");
        float best[16], e[16], sum = 0.f;
#pragma unroll
        for (int q = 0; q < 16; ++q) { best[q] = key_dec((C[q] & ~255u) | 128u); e[q] = __expf(best[q] - best[0]); sum += e[q]; }
        const float inv = __builtin_amdgcn_rcpf(sum);
        LAS unsigned* IDX = oute + rl * 16 + 8 * hf; LAS float* GW = outg + rl * 16 + 8 * hf;
#pragma unroll
        for (int q = 0; q < 8; ++q) {
            const unsigned c = (C[q] & evenmask) | (C[8 + q] & ~evenmask);
            const float ev = __builtin_bit_cast(float, (__builtin_bit_cast(unsigned, e[q]) & evenmask) | (__builtin_bit_cast(unsigned, e[8 + q]) & ~evenmask));
            const unsigned pos = 255u - (c & 255u);
            IDX[q] = (unsigned)(il[pos >> 4] * 128 + il[16 + (pos & 15u)]); GW[q] = ev * inv;
        }
    }
    LDS_WAIT(); asm volatile("" ::: "memory");
}

typedef float f32x2 __attribute__((ext_vector_type(2)));
__device__ __forceinline__ unsigned q8(float x) { return (unsigned)(int)rintf(x) & 0xffu; }
__device__ __forceinline__ void cvt_table_fp8(const float* src, unsigned char* dst, float* scl, int gw, int ngw, int lane) {
    for (int row = gw; row < 16384; row += ngw) {
        const f32x4* sp = (const f32x4*)(src + (size_t)row * 1024 + 16 * lane);
        const f32x4 a0 = sp[0], a1 = sp[1], a2 = sp[2], a3 = sp[3];
        float m = fmaxf(fmaxf(fmaxf(fabsf(a0.x), fabsf(a0.y)), fmaxf(fabsf(a0.z), fabsf(a0.w))), fmaxf(fmaxf(fabsf(a1.x), fabsf(a1.y)), fmaxf(fabsf(a1.z), fabsf(a1.w))));
        m = fmaxf(m, fmaxf(fmaxf(fmaxf(fabsf(a2.x), fabsf(a2.y)), fmaxf(fabsf(a2.z), fabsf(a2.w))), fmaxf(fmaxf(fabsf(a3.x), fabsf(a3.y)), fmaxf(fabsf(a3.z), fabsf(a3.w)))));
#pragma unroll
        for (int o = 1; o < 64; o <<= 1) m = fmaxf(m, __shfl_xor(m, o));
        m = fmaxf(m, 1e-30f);
        const float q = 127.0f / m;
        v4u o;
        o.x = q8(a0.x * q) | (q8(a0.y * q) << 8) | (q8(a0.z * q) << 16) | (q8(a0.w * q) << 24);
        o.y = q8(a1.x * q) | (q8(a1.y * q) << 8) | (q8(a1.z * q) << 16) | (q8(a1.w * q) << 24);
        o.z = q8(a2.x * q) | (q8(a2.y * q) << 8) | (q8(a2.z * q) << 16) | (q8(a2.w * q) << 24);
        o.w = q8(a3.x * q) | (q8(a3.y * q) << 8) | (q8(a3.z * q) << 16) | (q8(a3.w * q) << 24);
        *(v4u*)(dst + (size_t)row * 1024 + 16 * lane) = o;
        if (lane == 0) scl[row] = m * (1.0f / 127.0f);
    }
}
__device__ __forceinline__ int row16_sum_i(int v) {
    v += __builtin_amdgcn_update_dpp(0, v, 0xB1, 0xF, 0xF, true);
    v += __builtin_amdgcn_update_dpp(0, v, 0x4E, 0xF, 0xF, true);
    v += __builtin_amdgcn_update_dpp(0, v, 0x141, 0xF, 0xF, true);
    v += __builtin_amdgcn_update_dpp(0, v, 0x140, 0xF, 0xF, true);
    return v;
}
constexpr int PE_NT = 4, PE_NR = 16, PE_SH = 10, PE_DEP = 3;
constexpr int PE_TOK_W = 128 * 3 + 20;
constexpr int PE_ENT_W = 272 * 4;
constexpr int PE_WAVE_W = PE_NT * PE_TOK_W + PE_ENT_W + 32 * 33 + 2 * PE_NT * 128;
static_assert(8 * PE_WAVE_W * 4 <= MISC_OFF && PE_NR * PE_NT == 64, "peer LDS / batch-list geometry");
#define PE_LD(dst, voff_, sbase_) asm volatile("s_nop 4\n\tglobal_load_dwordx4 %0, %1, %2" : "=&v"(dst) : "v"(voff_), "s"(sbase_) : "memory")
__device__ __forceinline__ void peer_pass(const Params& P, LAS unsigned char* lds, int tbase, int lane, int wave, float* dstbase, int emask = 0x3fff) {
    asm volatile("v_mbcnt_lo_u32_b32 %0, -1, 0\n\tv_mbcnt_hi_u32_b32 %0, -1, %0" : "=v"(lane));
    {
        LAS unsigned* lw0 = (LAS unsigned*)(lds) + wave * PE_WAVE_W + PE_NT * PE_TOK_W + PE_ENT_W;
        peer_topk_wave(P, (LAS int*)lw0, lw0 + 32 * 33, (LAS float*)(lw0 + 32 * 33 + PE_NT * 128), tbase, lane);
        LDS_WAIT(); asm volatile("" : "+v"(lane), "+s"(tbase) :: "memory");
    }
    const unsigned char* ws = P.ws;
    const unsigned char* UB8 = ws + WS_UB; const unsigned char* VB8 = ws + WS_VB;
    const float* USC = (const float*)(ws + WS_USC); const float* VSC = (const float*)(ws + WS_VSC);
    f32x2 acc[PE_NT][8];
    LAS unsigned* lw = (LAS unsigned*)(lds) + wave * PE_WAVE_W;
    LAS unsigned* ents = lw + PE_NT * PE_TOK_W;
    const unsigned voff = (unsigned)lane * 16u;
    LAS unsigned* upe = ents + PE_ENT_W + 32 * 33; LAS float* upg = (LAS float*)(upe + PE_NT * 128);
    LAS unsigned* hql = ents + PE_ENT_W;
#pragma unroll
    for (int j = 0; j < PE_NT; ++j) {
        const int t = tbase + j;
        const v4u* xrow = (const v4u*)((const bf16*)(ws + WS_XB) + (size_t)t * 1024 + 16 * lane);
        const v4u xa = xrow[0], xc = xrow[1];
        const f32x4 xvv[4] = {(f32x4){bflo(xa.x), bfhi(xa.x), bflo(xa.y), bfhi(xa.y)}, (f32x4){bflo(xa.z), bfhi(xa.z), bflo(xa.w), bfhi(xa.w)},
                              (f32x4){bflo(xc.x), bfhi(xc.x), bflo(xc.y), bfhi(xc.y)}, (f32x4){bflo(xc.z), bfhi(xc.z), bflo(xc.w), bfhi(xc.w)}};
        const float rstd2 = rsqrtf(((const float*)(ws + WS_SSQ2))[t] * (1.0f / 1024.0f) + 1e-6f);
        f32x4 hv[4]; float hm = 0.f;
#pragma unroll
        for (int i = 0; i < 4; ++i) { const f32x4 xv = xvv[i]; const f32x4 w = ((const f32x4*)(P.norm_ffn_w + 16 * lane))[i];
            hv[i] = (f32x4){xv.x * rstd2 * w.x, xv.y * rstd2 * w.y, xv.z * rstd2 * w.z, xv.w * rstd2 * w.w};
            hm = fmaxf(hm, fmaxf(fmaxf(fabsf(hv[i].x), fabsf(hv[i].y)), fmaxf(fabsf(hv[i].z), fabsf(hv[i].w)))); }
#pragma unroll
        for (int o = 1; o < 64; o <<= 1) hm = fmaxf(hm, __shfl_xor(hm, o));
        hm = fmaxf(hm, 1e-30f);
        const float hqs = 127.0f / hm, hs = hm * (1.0f / 127.0f);
        { unsigned hqv[4];
#pragma unroll
          for (int i = 0; i < 4; ++i) hqv[i] = q8(hv[i].x * hqs) | (q8(hv[i].y * hqs) << 8) | (q8(hv[i].z * hqs) << 16) | (q8(hv[i].w * hqs) << 24);
          *(LAS v4u*)(hql + (j * 64 + lane) * 4) = (v4u){hqv[0], hqv[1], hqv[2], hqv[3]}; }
#pragma unroll
        for (int i = 0; i < 8; ++i) acc[j][i] = (f32x2){0.f, 0.f};
        const int e0 = (int)upe[j * 128 + 2 * lane] & emask, e1 = (int)upe[j * 128 + 2 * lane + 1] & emask;
        const float g0 = upg[j * 128 + 2 * lane] * VSC[e0], g1 = upg[j * 128 + 2 * lane + 1] * VSC[e1];
        const float u0 = USC[e0] * hs, u1 = USC[e1] * hs;
        const int rev = (tbase >= T / 2) ? (PE_NR - 1) : 0;
        const int b0 = (e0 >> PE_SH) ^ rev, b1 = (e1 >> PE_SH) ^ rev;
        LAS unsigned* lt = lw + j * PE_TOK_W;
        int run = 0;
#pragma unroll 1
        for (int bk = 0; bk < PE_NR; ++bk) {
            const unsigned long long m0 = __ballot(b0 == bk), m1 = __ballot(b1 == bk);
            const int c0 = __popcll(m0), c1 = __popcll(m1);
            const unsigned long long lower = (1ull << lane) - 1ull;
            if (b0 == bk) { const int p = run + __popcll(m0 & lower); lt[p] = (unsigned)e0; lt[128 + p] = __builtin_bit_cast(unsigned, g0); lt[256 + p] = __builtin_bit_cast(unsigned, u0); }
            if (b1 == bk) { const int p = run + c0 + __popcll(m1 & lower); lt[p] = (unsigned)e1; lt[128 + p] = __builtin_bit_cast(unsigned, g1); lt[256 + p] = __builtin_bit_cast(unsigned, u1); }
            if (lane == 0) lt[384 + bk] = (unsigned)run;
            run += c0 + c1;
        }
        if (lane == 0) lt[384 + PE_NR] = 128u;
        asm volatile("" ::: "memory");
    }
    LDS_WAIT(); asm volatile("" ::: "memory");
    int nb;
    {
        const int rd = lane >> 2, j = (rd & 1) ? 3 - (lane & 3) : (lane & 3);
        const LAS unsigned* lt = lw + j * PE_TOK_W;
        const int n0 = (int)lt[384 + rd], n1 = (int)lt[384 + rd + 1];
        const int nbl = (n1 - n0 + 3) >> 2;
        int inc = nbl;
#pragma unroll
        for (int off = 1; off < 64; off <<= 1) { const int tv = __shfl_up(inc, off); if (lane >= off) inc += tv; }
        nb = __builtin_amdgcn_readlane(inc, 63);
        const int ofs = inc - nbl;
#pragma unroll 1
        for (int q = 0; q < nbl; ++q) { const int i0 = n0 + 4 * q, c = (n1 - i0) < 4 ? (n1 - i0) : 4;
            const unsigned e0 = lt[i0], e1 = lt[i0 + (c > 1 ? 1 : c - 1)], e2 = lt[i0 + (c > 2 ? 2 : c - 1)], e3 = lt[i0 + (c > 3 ? 3 : c - 1)];
            *(LAS v4u*)(ents + 4 * (ofs + q)) = (v4u){e0 | (((unsigned)j | ((unsigned)c << 2) | ((unsigned)i0 << 5)) << 14), e1, e2, e3}; }
        if (lane < 2 * PE_DEP) *(LAS v4u*)(ents + 4 * (nb + lane)) = (v4u){0u, 0u, 0u, 0u};
    }
    LDS_WAIT(); asm volatile("" ::: "memory");
    v4u ru[PE_DEP][4], rv[PE_DEP][4];
#define PE_LDO(dst, vo_, sbase_) asm volatile("global_load_dwordx4 %0, %1, %2" : "=&v"(dst) : "v"(vo_), "s"(sbase_) : "memory")
#define PE_ISSUE(S, rec_) do { const unsigned e0_ = (rec_).x & 0x3fffu; \
        { const unsigned vo_ = (e0_ << 10) + voff; PE_LDO(ru[S][0], vo_, UB8); PE_LDO(rv[S][0], vo_, VB8); } \
        { const unsigned vo_ = ((rec_).y << 10) + voff; PE_LDO(ru[S][1], vo_, UB8); PE_LDO(rv[S][1], vo_, VB8); } \
        { const unsigned vo_ = ((rec_).z << 10) + voff; PE_LDO(ru[S][2], vo_, UB8); PE_LDO(rv[S][2], vo_, VB8); } \
        { const unsigned vo_ = ((rec_).w << 10) + voff; PE_LDO(ru[S][3], vo_, UB8); PE_LDO(rv[S][3], vo_, VB8); } } while (0)
#define PE_WAIT8(S, cntstr) asm volatile("s_waitcnt " cntstr : "+v"(ru[S][0]), "+v"(ru[S][1]), "+v"(ru[S][2]), "+v"(ru[S][3]), "+v"(rv[S][0]), "+v"(rv[S][1]), "+v"(rv[S][2]), "+v"(rv[S][3]) :: "memory")
#define PE_UDOTS(S) asm("v_dot4_i32_i8 %0, %4, %20, 0\n\tv_dot4_i32_i8 %1, %8, %20, 0\n\tv_dot4_i32_i8 %2, %12, %20, 0\n\tv_dot4_i32_i8 %3, %16, %20, 0\n\t" \
                        "v_dot4_i32_i8 %0, %5, %21, %0\n\tv_dot4_i32_i8 %1, %9, %21, %1\n\tv_dot4_i32_i8 %2, %13, %21, %2\n\tv_dot4_i32_i8 %3, %17, %21, %3\n\t" \
                        "v_dot4_i32_i8 %0, %6, %22, %0\n\tv_dot4_i32_i8 %1, %10, %22, %1\n\tv_dot4_i32_i8 %2, %14, %22, %2\n\tv_dot4_i32_i8 %3, %18, %22, %3\n\t" \
                        "v_dot4_i32_i8 %0, %7, %23, %0\n\tv_dot4_i32_i8 %1, %11, %23, %1\n\tv_dot4_i32_i8 %2, %15, %23, %2\n\tv_dot4_i32_i8 %3, %19, %23, %3\n\ts_nop 2" \
        : "=&v"(d_[0]), "=&v"(d_[1]), "=&v"(d_[2]), "=&v"(d_[3]) \
        : "v"(ru[S][0].x), "v"(ru[S][0].y), "v"(ru[S][0].z), "v"(ru[S][0].w), "v"(ru[S][1].x), "v"(ru[S][1].y), "v"(ru[S][1].z), "v"(ru[S][1].w), \
          "v"(ru[S][2].x), "v"(ru[S][2].y), "v"(ru[S][2].z), "v"(ru[S][2].w), "v"(ru[S][3].x), "v"(ru[S][3].y), "v"(ru[S][3].z), "v"(ru[S][3].w), \
          "v"(hcur.x), "v"(hcur.y), "v"(hcur.z), "v"(hcur.w))
#define PE_UDOTS_SAFE(S) do { _Pragma("unroll") for (int k_ = 0; k_ < 4; ++k_) { int s_ = __builtin_amdgcn_sdot4((int)ru[S][k_].x, (int)hcur.x, 0, false); s_ = __builtin_amdgcn_sdot4((int)ru[S][k_].y, (int)hcur.y, s_, false); \
            s_ = __builtin_amdgcn_sdot4((int)ru[S][k_].z, (int)hcur.z, s_, false); s_ = __builtin_amdgcn_sdot4((int)ru[S][k_].w, (int)hcur.w, s_, false); d_[k_] = s_; } } while (0)
#define PE_VDOTS_SAFE(f0, f1, f2, f3, b0, b1, b2, b3, w) do { f0 = (float)__builtin_amdgcn_sdot4((int)(b0), (int)(w), 0, false); f1 = (float)__builtin_amdgcn_sdot4((int)(b1), (int)(w), 0, false); \
            f2 = (float)__builtin_amdgcn_sdot4((int)(b2), (int)(w), 0, false); f3 = (float)__builtin_amdgcn_sdot4((int)(b3), (int)(w), 0, false); } while (0)
#define PE_VDOTS(f0, f1, f2, f3, b0, b1, b2, b3, w) asm("v_dot4_i32_i8 %0, %4, %8, 0\n\tv_dot4_i32_i8 %1, %5, %8, 0\n\tv_dot4_i32_i8 %2, %6, %8, 0\n\tv_dot4_i32_i8 %3, %7, %8, 0\n\t" \
                        "v_cvt_f32_i32_e32 %0, %0\n\tv_cvt_f32_i32_e32 %1, %1\n\tv_cvt_f32_i32_e32 %2, %2\n\tv_cvt_f32_i32_e32 %3, %3" \
        : "=&v"(f0), "=&v"(f1), "=&v"(f2), "=&v"(f3) : "v"(b0), "v"(b1), "v"(b2), "v"(b3), "v"(w))
#define PE_COMPUTE_B(S, c_, i_, j_, SG) do { const LAS unsigned* lt_ = lw + (j_) * PE_TOK_W; \
        const int myk_ = lane >> 4; \
        float gsc_ = __builtin_bit_cast(float, lt_[128 + i_ + myk_]), usc_ = __builtin_bit_cast(float, lt_[256 + i_ + myk_]);     \
        int d_[4]; \
        PE_UDOTS(S); \
        int r1_; \
        { const v2u p02_ = __builtin_amdgcn_permlane32_swap((unsigned)d_[0], (unsigned)d_[2], false, false), p13_ = __builtin_amdgcn_permlane32_swap((unsigned)d_[1], (unsigned)d_[3], false, false); \
          const v2u q_ = __builtin_amdgcn_permlane16_swap(p02_.x + p02_.y, p13_.x + p13_.y, false, false); r1_ = row16_sum_i((int)(q_.x + q_.y)); }     \
        float act_; \
        { const float x_ = (float)r1_ * usc_, e_ = __builtin_amdgcn_exp2f(x_ * __builtin_fmaf(x_ * x_, -0.10294324f, -2.3022082f));     \
          act_ = x_ * __builtin_amdgcn_rcpf(1.0f + e_) * gsc_; act_ = (myk_ < c_) ? act_ : 0.f; } \
        float wm_; \
        { unsigned wmu_ = __builtin_bit_cast(unsigned, act_) & 0x7fffffffu;                 \
          v2u t_ = __builtin_amdgcn_permlane32_swap(wmu_, wmu_, false, false); wmu_ = t_.x > t_.y ? t_.x : t_.y; \
          t_ = __builtin_amdgcn_permlane16_swap(wmu_, wmu_, false, false); wmu_ = t_.x > t_.y ? t_.x : t_.y; \
          wm_ = fmaxf(__builtin_bit_cast(float, wmu_), 1e-30f); } \
        const float wq_ = 127.0f * __builtin_amdgcn_rcpf(wm_), ws_ = (SG) * wm_ * (1.0f / 127.0f); \
        unsigned w4u_ = (__builtin_bit_cast(unsigned, __builtin_fmaf(act_, wq_, 12582912.0f)) & 0xffu) << (8 * myk_); \
        { v2u t_ = __builtin_amdgcn_permlane32_swap(w4u_, w4u_, false, false); w4u_ = t_.x | t_.y; t_ = __builtin_amdgcn_permlane16_swap(w4u_, w4u_, false, false); w4u_ = t_.x | t_.y; } \
        const f32x2 ws2_ = (f32x2){ws_, ws_}; \
        _Pragma("unroll") for (int m_ = 0; m_ < 4; ++m_) { \
            const unsigned R0_ = rv[S][0][m_], R1_ = rv[S][1][m_], R2_ = rv[S][2][m_], R3_ = rv[S][3][m_]; \
            const unsigned X_ = __builtin_amdgcn_perm(R1_, R0_, 0x05010400u), Y_ = __builtin_amdgcn_perm(R1_, R0_, 0x07030602u), Z_ = __builtin_amdgcn_perm(R3_, R2_, 0x05010400u), W_ = __builtin_amdgcn_perm(R3_, R2_, 0x07030602u); \
            float t0_, t1_, t2_, t3_; \
            const unsigned b0_ = __builtin_amdgcn_perm(Z_, X_, 0x05040100u), b1_ = __builtin_amdgcn_perm(Z_, X_, 0x07060302u), b2_ = __builtin_amdgcn_perm(W_, Y_, 0x05040100u), b3_ = __builtin_amdgcn_perm(W_, Y_, 0x07060302u); \
            PE_VDOTS(t0_, t1_, t2_, t3_, b0_, b1_, b2_, b3_, w4u_); \
            cur[2 * m_] = __builtin_elementwise_fma((f32x2){t0_, t1_}, ws2_, cur[2 * m_]); \
            cur[2 * m_ + 1] = __builtin_elementwise_fma((f32x2){t2_, t3_}, ws2_, cur[2 * m_ + 1]); } } while (0)
#define PE_FLUSH() do { _Pragma("unroll") for (int J_ = 0; J_ < PE_NT; ++J_) { const float sel_ = (jcur == J_) ? 1.0f : 0.0f; const f32x2 sel2_ = (f32x2){sel_, sel_};     \
            _Pragma("unroll") for (int i_ = 0; i_ < 8; ++i_) acc[J_][i_] = __builtin_elementwise_fma(cur[i_], sel2_, acc[J_][i_]); } \
        _Pragma("unroll") for (int i_ = 0; i_ < 8; ++i_) cur[i_] = (f32x2){0.f, 0.f}; } while (0)
#define PE_COMPUTE_S(S, entv, SG) do { const unsigned en_ = (entv) >> 14; const int jj_ = (int)(en_ & 3u), cc_ = (int)((en_ >> 2) & 7u), ii_ = (int)(en_ >> 5); \
        if (cc_ > 0) { if (jj_ != jcur) { PE_FLUSH(); jcur = jj_; hcur = *(const LAS v4u*)(hql + (jj_ * 64 + lane) * 4); } \
                       PE_COMPUTE_B(S, cc_, ii_, jj_, SG); } } while (0)
#ifdef PE_VALU3
#define PE_COMPUTE(S, entv) do { PE_COMPUTE_S(S, entv, 1.0f); PE_WAIT8(S, "vmcnt(16)"); PE_COMPUTE_S(S, entv, -1.0f); PE_WAIT8(S, "vmcnt(16)"); PE_COMPUTE_S(S, entv, 1.0f); } while (0)
#else
#define PE_COMPUTE(S, entv) PE_COMPUTE_S(S, entv, 1.0f)
#endif
    {
        unsigned er[PE_DEP];
#pragma unroll
        for (int q = 0; q < PE_DEP; ++q) { const v4u rec = *(const LAS v4u*)(ents + 4 * q); er[q] = __builtin_amdgcn_readfirstlane(rec.x); PE_ISSUE(q, rec); }
        f32x2 cur[8];
#pragma unroll
        for (int i = 0; i < 8; ++i) cur[i] = (f32x2){0.f, 0.f};
        int jcur = (int)((er[0] >> 14) & 3u);
        v4u hcur = *(const LAS v4u*)(hql + (jcur * 64 + lane) * 4);
        v4u nrec = *(const LAS v4u*)(ents + 4 * PE_DEP);
#pragma unroll 1
        for (int bi = 0; bi < nb; bi += PE_DEP) {
#pragma unroll
            for (int q = 0; q < PE_DEP; ++q) {
                PE_WAIT8(q, "vmcnt(16)");
                PE_COMPUTE(q, er[q]);
                er[q] = __builtin_amdgcn_readfirstlane(nrec.x);
                PE_ISSUE(q, nrec);
                nrec = *(const LAS v4u*)(ents + 4 * (bi + q + PE_DEP + 1));
            }
        }
#pragma unroll
        for (int q = 0; q < PE_DEP; ++q) PE_WAIT8(q, "vmcnt(0)");
        PE_FLUSH();
    }
#undef PE_COMPUTE
#undef PE_COMPUTE_S
#undef PE_COMPUTE_B
#undef PE_FLUSH
#undef PE_WAIT8
#undef PE_ISSUE
#undef PE_LDO
#undef PE_UDOTS
#undef PE_VDOTS
    asm volatile("v_mbcnt_lo_u32_b32 %0, -1, 0\n\tv_mbcnt_hi_u32_b32 %0, -1, %0" : "=v"(lane)); asm volatile("" : "+s"(tbase));
#pragma unroll
    for (int j = 0; j < PE_NT; ++j) {
        const int t = tbase + j;
        float ss = 0.f; f32x4 xo[4];
        { const v4u* xrow = (const v4u*)((const bf16*)(ws + WS_XB) + (size_t)t * 1024 + 16 * lane); const v4u xa = xrow[0], xc = xrow[1];
          xo[0] = (f32x4){bflo(xa.x), bfhi(xa.x), bflo(xa.y), bfhi(xa.y)}; xo[1] = (f32x4){bflo(xa.z), bfhi(xa.z), bflo(xa.w), bfhi(xa.w)};
          xo[2] = (f32x4){bflo(xc.x), bfhi(xc.x), bflo(xc.y), bfhi(xc.y)}; xo[3] = (f32x4){bflo(xc.z), bfhi(xc.z), bflo(xc.w), bfhi(xc.w)}; }
#pragma unroll
        for (int i = 0; i < 4; ++i) { xo[i].x += acc[j][2 * i].x; xo[i].y += acc[j][2 * i].y; xo[i].z += acc[j][2 * i + 1].x; xo[i].w += acc[j][2 * i + 1].y;
            ss += (xo[i].x * xo[i].x + xo[i].y * xo[i].y) + (xo[i].z * xo[i].z + xo[i].w * xo[i].w); }
        const float rstd3 = rsqrtf(wave_sum(ss) * (1.0f / 1024.0f) + 1e-6f);
        float* orow = dstbase + (size_t)t * 1024 + 16 * lane;
#pragma unroll
        for (int i = 0; i < 4; ++i) { const f32x4 w = ((const f32x4*)(P.norm_final_w + 16 * lane))[i];
            ((f32x4*)orow)[i] = (f32x4){xo[i].x * rstd3 * w.x, xo[i].y * rstd3 * w.y, xo[i].z * rstd3 * w.z, xo[i].w * rstd3 * w.w}; }
    }
    LDS_WAIT(); asm volatile("s_waitcnt vmcnt(0)" ::: "memory");
}


#ifndef TWICE_MASK
#define TWICE_MASK 0
#endif
struct TwiceOrder { pg8::StaticOrder S; int per, reps;
    __device__ bool next(int i, pg8::Unit& u) const { if (i >= per * reps) return false; return S.next(i % per, u); }
    __device__ __forceinline__ void a_ready(const pg8::Unit&) const {} __device__ __forceinline__ void done(const pg8::Unit&) const {} };
template <class B> __device__ __forceinline__ bool rep_again(volatile LAS unsigned* MISC, B& bar) {
    __syncthreads(); const unsigned c = MISC[20]; __syncthreads();
    if (threadIdx.x == 0) MISC[20] = c ^ 1u;
    __syncthreads();
    if (c == 0u) { xcd_barrier(bar); return true; }
    return false;
}
__global__ void __launch_bounds__(NWAVES * 64, 2) hybrid_fwd(Params P) {
    extern __shared__ __attribute__((aligned(16))) unsigned char lds_raw[];
    LAS unsigned char* lds = (LAS unsigned char*)lds_raw;
    volatile LAS unsigned* MISC = (volatile LAS unsigned*)(lds + MISC_OFF);
    const int tid = threadIdx.x, lane = tid & 63, wave = __builtin_amdgcn_readfirstlane(tid >> 6);
    const int G = gridDim.x, bx = blockIdx.x;
    const int vcu = (G % 8 == 0) ? (bx % 8) * (G / 8) + bx / 8 : bx;
    unsigned char* ws = P.ws;
    for (int u = tid; u < 64; u += NWAVES * 64) MISC[u] = 0u;
    __syncthreads();
    XcdBarrier bar; bar.bar = (unsigned*)(ws + WS_CTL) + CW_BAR; bar.x = 0; bar.st = nullptr;
    if (!MK_PER_PHASE) bar = xcd_barrier_post((unsigned*)(ws + WS_CTL) + CW_BAR, MISC + 8);
    const int lo = P.ph_lo, hi = P.ph_hi;
#ifndef PHASE_MASK
#define PHASE_MASK 0xFFF
#endif
#define IN(k) (((PHASE_MASK >> (k)) & 1) && lo <= (k) && (k) < hi)
#define SEAM(k) do { if (IN(k) && IN((k) + 1)) xcd_barrier(bar); } while (0)
#ifndef REP_MASK
#define REP_MASK 0
#endif
#ifndef PE_EXP_MASK
#define PE_EXP_MASK 0x3fff
#endif
#define REPS(k) for (bool again_ = true; again_; again_ = (((REP_MASK >> (k)) & 1) ? rep_again(MISC, bar) : false))
    using namespace pg8;
    bf16* XB = (bf16*)(ws + WS_XB);

    if (IN(0)) REPS(0) { p0_prologue(P, lds, tid, lane, wave, vcu, G); }
    SEAM(0);
    if (IN(1)) REPS(1) {
        { Gemm gm{XB, (const bf16_t*)(ws + WS_WIN), T, 3072, 1024}; StaticOrder S; S.init(T, 3072, G, bx);
          EpiBf16Rs E{(bf16_t*)(ws + WS_QKV), 1536, 6, (bf16_t*)(ws + WS_XR), 512, (size_t)T * 512, nullptr, 1.0f};
          gemm_phase<EpiBf16Rs, StaticOrder, PG8_ALIGN, PG8_SP2>(lds, gm, S, E); }
    }
    SEAM(1);
    if (IN(3)) REPS(3) {
        if (bx < SCAN_WGS) gdn_scan(P, lds, bx, tid, lane, wave);
        else {
            const int wk = bx - SCAN_WGS, NWK = G - SCAN_WGS;
            unsigned* lcnt = (unsigned*)(ws + WS_CTL) + CW_LRUCNT;
            for (int q = wk; q < 1024; q += NWK) gdn_local_item(P, lds, (q & 7) * 128 + (q >> 3), tid);
            unsigned ndone = 0;
            for (int lt = wk; lt < 256; lt += NWK) { lru_local_item(P, lds, lt, tid, lane, wave); ++ndone; }
            asm volatile("s_waitcnt vmcnt(0)" ::: "memory");
            __syncthreads();
            if (tid == 0 && ndone) { __builtin_amdgcn_fence(__ATOMIC_RELEASE, "agent"); asm volatile("s_waitcnt vmcnt(0)" ::: "memory");
                                     __hip_atomic_fetch_add(lcnt, ndone, __ATOMIC_RELAXED, __HIP_MEMORY_SCOPE_AGENT); }
            if (wk < 16) {
                struct OneUnit { int pm, pn; __device__ bool next(int i, Unit& u) const { if (i > 0) return false; u.pm = pm; u.pn = pn; return true; }
                                 __device__ void a_ready(const Unit&) const {} __device__ void done(const Unit&) const {} };
                Gemm gm{(const bf16_t*)(ws + WS_MEMN), (const bf16_t*)(ws + WS_WKV), 512, 2048, 1024}; OneUnit S{wk >> 3, wk & 7};
                EpiKV E{(bf16_t*)(ws + WS_KB), (bf16_t*)(ws + WS_VTP)};
                gemm_phase<EpiKV, OneUnit, PG8_ALIGN, PG8_SP2>(lds, gm, S, E);
            }
            if (wk == 16 || wk == 17) {
                if (tid == 0) { unsigned sp = 0;
                    while (__hip_atomic_load(lcnt, __ATOMIC_RELAXED, __HIP_MEMORY_SCOPE_AGENT) < 256u) { __builtin_amdgcn_s_sleep(8); if (++sp > (1u << 22)) break; }
                    __builtin_amdgcn_fence(__ATOMIC_ACQUIRE, "agent"); asm volatile("s_waitcnt vmcnt(0)" ::: "memory"); }
                __syncthreads();
                lru_carry(P, (wk - 16) * NWAVES + wave, lane);
                asm volatile("s_waitcnt vmcnt(0)" ::: "memory");
                __syncthreads();
                if (tid == 0) { __builtin_amdgcn_fence(__ATOMIC_RELEASE, "agent"); asm volatile("s_waitcnt vmcnt(0)" ::: "memory");
                                __hip_atomic_fetch_add(lcnt + 64, 1u, __ATOMIC_RELAXED, __HIP_MEMORY_SCOPE_AGENT); }
            } else {
                const int w2 = (wk < 16 ? wk : wk - 2), N2 = NWK - 2;
                cvt_table_fp8(P.peer_v, ws + WS_VB, (float*)(ws + WS_VSC), w2 * NWAVES + wave, N2 * NWAVES, lane);
                late_weight_prep(P, lds, lane, wave, w2 * NWAVES + wave, N2 * NWAVES);
                if (tid == 0) { unsigned sp = 0;
                    while (__hip_atomic_load(lcnt + 64, __ATOMIC_RELAXED, __HIP_MEMORY_SCOPE_AGENT) < 2u) { __builtin_amdgcn_s_sleep(8); if (++sp > (1u << 22)) break; }
                    __builtin_amdgcn_fence(__ATOMIC_ACQUIRE, "agent"); asm volatile("s_waitcnt vmcnt(0)" ::: "memory"); }
                __syncthreads();
                lru_combine(P, (size_t)w2 * (NWAVES * 64) + tid, (size_t)N2 * (NWAVES * 64));
            }
        }
    }
    SEAM(3);
    if (IN(4)) REPS(4) {
        gdn_gate_norm(P, (size_t)bx * (NWAVES * 64) + tid, (size_t)G * (NWAVES * 64));
        cvt_table_fp8(P.peer_u, ws + WS_UB, (float*)(ws + WS_USC), bx * NWAVES + wave, G * NWAVES, lane);
    }
    SEAM(4);
    if (IN(5)) {
        Gemm gm{(const bf16_t*)((const unsigned char*)P.out + OUT_Y), (const bf16_t*)(ws + WS_WOUT), T, 1024, 1024}; StaticOrder S; S.init(T, 1024, G, bx);
        EpiResidBf<true> E{P.x, XB, (float*)(ws + WS_SSQ1)};
        gemm_phase<EpiResidBf<true>, StaticOrder, PG8_ALIGN, PG8_SP2>(lds, gm, S, E);
    }
    SEAM(5);
    if (IN(6)) REPS(6) {
        Gemm gm{XB, (const bf16_t*)(ws + WS_WQ), T, 1024, 1024};
        EpiBf16Rs E{(bf16_t*)(ws + WS_Q), 1024, 4, nullptr, 256, 0, (const float*)(ws + WS_SSQ1), 0.0625f};
#if (TWICE_MASK >> 6) & 1
        { TwiceOrder S; S.S.init(T, 1024, G, bx); S.per = 1; S.reps = 2;
          gemm_phase<EpiBf16Rs, TwiceOrder, PG8_ALIGN, PG8_SP2>(lds, gm, S, E); }
#else
        { StaticOrder S; S.init(T, 1024, G, bx);
          gemm_phase<EpiBf16Rs, StaticOrder, PG8_ALIGN, PG8_SP2>(lds, gm, S, E); }
#endif
        Unit u;
        { const int wgid = (bx & 7) * 32 + (bx >> 3); u.pm = (wgid >> 5) * 8 + (wgid & 7); u.pn = (wgid & 31) >> 3; }
        if (G == 256) {
            asm volatile("s_waitcnt vmcnt(0)" ::: "memory");
            __syncthreads();
            const int b = u.pm >> 5, qb0 = (u.pm & 31) * 2, h = u.pn;
#pragma unroll 1
            for (int qq = 0; qq < (((TWICE_MASK >> 7) & 1) ? 4 : 2); ++qq) xattn_unit(P, lds, (b << 8) | ((qb0 + (qq & 1)) << 2) | h, tid, lane, wave);
        }
    }
    if (IN(7)) REPS(7) { }
    SEAM(7);
    if (IN(8)) {
        Gemm gm{(const bf16_t*)(ws + WS_AO), (const bf16_t*)(ws + WS_WO), T, 1024, 1024}; StaticOrder S; S.init(T, 1024, G, bx);
        EpiResidBf<false> E{nullptr, XB, (float*)(ws + WS_SSQ2)};
        gemm_phase<EpiResidBf<false>, StaticOrder, PG8_ALIGN, PG8_SP2>(lds, gm, S, E);
    }
    SEAM(8);
    if (IN(9)) REPS(9) {
        Gemm gm{XB, (const bf16_t*)(ws + WS_PWQ), T, 2048, 1024};
        EpiF16Rs E{(_Float16*)(ws + WS_PQ), 2048, (const float*)(ws + WS_SSQ2)};
#if (TWICE_MASK >> 9) & 1
        TwiceOrder S; S.S.init(T, 2048, G, bx); S.per = 2; S.reps = 2;
        gemm_phase<EpiF16Rs, TwiceOrder, PG8_ALIGN, PG8_SP2>(lds, gm, S, E);
#else
        StaticOrder S; S.init(T, 2048, G, bx);
        gemm_phase<EpiF16Rs, StaticOrder, PG8_ALIGN, PG8_SP2>(lds, gm, S, E);
#endif
    }
    SEAM(9);
    if (IN(10)) REPS(10) {
    }
    if (IN(11)) REPS(11) {
#if (TWICE_MASK >> 11) & 1
        for (int it = 0; it < 4; ++it) { const int tb = (bx * NWAVES + wave) * PE_NT + (it >> 1) * (G * NWAVES * PE_NT); if (tb < T) peer_pass(P, lds, tb, lane, wave, P.out, (it & 1) ? 0x3fff : PE_EXP_MASK); }
#else
#ifndef PE_PASS_BARRIER
#define PE_PASS_BARRIER 0
#endif
        for (int tb = (bx * NWAVES + wave) * PE_NT, np = 0; tb < T; tb += G * NWAVES * PE_NT, ++np) {
            if (PE_PASS_BARRIER && np > 0 && (T % (G * NWAVES * PE_NT)) == 0) xcd_barrier(bar);
            peer_pass(P, lds, tb, lane, wave, P.out);
        }
#endif
    }
#undef IN
#undef SEAM
}

extern "C" void kernel_launch(void* const* d_in, const int* in_sizes, int n_in, void* d_out, int out_size, void* d_ws, size_t ws_size, hipStream_t stream) {
    static int grid = 0;
    if (grid == 0) {
        if (n_in != 27 || in_sizes[0] != T * D || out_size != T * D || ws_size < WS_END) {
            fprintf(stderr, "kernel_launch: unexpected shapes (n_in %d, in0 %d, out %d, ws %zu); nothing launched\n", n_in, n_in > 0 ? in_sizes[0] : -1, out_size, ws_size); grid = -1; return; }
        int dev = 0, cus = 0, per_cu = 0;
        if (hipGetDevice(&dev) != hipSuccess || hipDeviceGetAttribute(&cus, hipDeviceAttributeMultiprocessorCount, dev) != hipSuccess) { grid = -1; return; }
        if (hipFuncSetAttribute((const void*)hybrid_fwd, hipFuncAttributeMaxDynamicSharedMemorySize, LDS_BYTES) != hipSuccess) { fprintf(stderr, "kernel_launch: hipFuncSetAttribute failed\n"); grid = -1; return; }
        if (hipOccupancyMaxActiveBlocksPerMultiprocessor(&per_cu, (const void*)hybrid_fwd, NWAVES * 64, LDS_BYTES) != hipSuccess || per_cu < 1)
            fprintf(stderr, "kernel_launch: note: occupancy query reports %d workgroups per CU\n", per_cu);
        (void)hipGetLastError();
        grid = cus;
        if (grid != 256) fprintf(stderr, "kernel_launch: %d CUs (built for 256)\n", grid);
    }
    if (grid < 0) return;
    if (hipMemsetAsync((char*)d_ws + WS_CTL, 0, CTL_ZERO_BYTES, stream) != hipSuccess) { fprintf(stderr, "kernel_launch: hipMemsetAsync failed\n"); return; }
    Params p{};
    const float** pp = (const float**)&p;
    for (int i = 0; i < 27; ++i) pp[i] = (const float*)d_in[i];
    p.out = (float*)d_out; p.ws = (unsigned char*)d_ws;
#if MK_PER_PHASE
    for (int k = 0; k < N_PHASES; ++k) { p.ph_lo = k; p.ph_hi = k + 1; hipLaunchKernelGGL(hybrid_fwd, dim3(grid), dim3(NWAVES * 64), LDS_BYTES, stream, p); }
#else
    p.ph_lo = 0; p.ph_hi = N_PHASES;
    hipLaunchKernelGGL(hybrid_fwd, dim3(grid), dim3(NWAVES * 64), LDS_BYTES, stream, p);
#endif
    const hipError_t le = hipPeekAtLastError();
    if (le != hipSuccess) fprintf(stderr, "kernel_launch: launch failed: %s\n", hipGetErrorName(le));
}
```

```cpp
#include <hip/hip_runtime.h>
#include <cstdio>
#include <cstdint>
namespace pg8 {
#define PG8_LAS __attribute__((address_space(3)))
typedef unsigned short bf16_t;
typedef short bf16x8 __attribute__((ext_vector_type(8)));
typedef float f32x4 __attribute__((ext_vector_type(4)));
typedef unsigned u32x4 __attribute__((ext_vector_type(4)));
constexpr int BM = 256, BK = 64, HALF = 128, HTB = HALF * BK * 2  , STAGE_BYTES = 8 * HTB, NXCD = 8, WGM = 8;

__host__ __device__ __forceinline__ int lds_byte(int r, int c) { const int st = (r >> 4) * 2 + (c >> 5), rr = r & 15, cc = c & 31, ob = rr * 64 + cc * 2; return st * 1024 + (ob ^ (((ob >> 9) & 1) << 5)); }
__host__ __device__ __forceinline__ void stage_rc(int b, int& R, int& C) { const int st = b / 1024, sb = b % 1024, swz = sb ^ (((sb >> 9) & 1) << 5); R = (st >> 1) * 16 + swz / 64; C = (st & 1) * 32 + (swz % 64) / 2; }
__host__ __device__ __forceinline__ int perm32(int rho) { const int n = rho >> 4, i = rho & 15; return 8 * (i >> 2) + 4 * n + (i & 3); }

struct Unit { int pm, pn; };
struct Gemm { const bf16_t* A; const bf16_t* Bt; int M, N, K; };

struct StaticOrder {
    int nM, nN, nwg, G, c;
    __host__ __device__ void init(int M, int N, int G_, int c_) { nM = M / BM; nN = N / BM; nwg = nM * nN; G = G_; c = c_; }
    __host__ __device__ bool next(int i, Unit& u) const {
        const long L = (long)i * G + c; if (L >= nwg) return false;
        int wgid = (int)L; { const int q = nwg / NXCD, r = nwg % NXCD, xcd = wgid % NXCD, off = wgid / NXCD; wgid = (xcd < r ? xcd * (q + 1) : r * (q + 1) + (xcd - r) * q) + off; }
        const int nig = WGM * nN, gid = wgid / nig, fm = gid * WGM, gsz = (nM - fm) < WGM ? (nM - fm) : WGM;
        u.pm = fm + ((wgid % nig) % gsz); u.pn = (wgid % nig) / gsz; return true;
    }
    __device__ __forceinline__ void a_ready(const Unit&) const {}
    __device__ __forceinline__ void done(const Unit&) const {}
};

__device__ __forceinline__ unsigned cvt_pk_bf16(float lo, float hi) { unsigned r; asm volatile("v_cvt_pk_bf16_f32 %0, %1, %2" : "=v"(r) : "v"(lo), "v"(hi)); return r; }
template <class Epi, class Sched, bool ALIGN_EPI = false, bool SP2 = false>
__device__ __forceinline__ void gemm_phase(PG8_LAS unsigned char* lds, const Gemm g, const Sched& S, const Epi& E) {
    const int tid = threadIdx.x, wid = __builtin_amdgcn_readfirstlane(tid >> 6), lane = tid & 63, wr = wid >> 2, wc = wid & 3, fr = lane & 15, fq = lane >> 4;
    const int K = g.K, nt = K / BK;
    unsigned voffA[2], voffB[2];
#pragma unroll
    for (int i = 0; i < 2; ++i) { int R, C; stage_rc(tid * 16 + i * 8192, R, C); const int Rb = Epi::PERM ? ((R & ~31) + perm32(R & 31)) : R;
        voffA[i] = (unsigned)(R * K + C) * 2u; voffB[i] = (unsigned)(Rb * K + C) * 2u; }
    const size_t kstep = (size_t)(BK * 2);
    const size_t hstep = (size_t)HALF * K * 2;
    const size_t tstep = 2 * hstep;
    const unsigned ldsw = (unsigned)wid * 1024u;
    const int aoff = lds_byte(wr * 64 + fr, fq * 8), boff = lds_byte(wc * 32 + fr, fq * 8);
#define PG8_SA(b, h) (((b) * 2 + (h)) * HTB)
#define PG8_SB(b, h) ((4 + (b) * 2 + (h)) * HTB)
#define PG8_STAGE(bufoff, gbase, voff) do { _Pragma("unroll") for (int _i = 0; _i < 2; ++_i) \
        __builtin_amdgcn_global_load_lds((const unsigned*)((const char*)(gbase) + (voff)[_i]), (PG8_LAS unsigned*)(lds + (bufoff) + ldsw + _i * 8192), 16, 0, 0); } while (0)
#define PG8_LDA(dst, b, h) do { _Pragma("unroll") for (int m = 0; m < 4; ++m) _Pragma("unroll") for (int k = 0; k < 2; ++k) dst[m][k] = *(const PG8_LAS bf16x8*)(lds + PG8_SA(b, h) + aoff + m * 2048 + k * 1024); } while (0)
#define PG8_LDB(dst, b, h) do { _Pragma("unroll") for (int n = 0; n < 2; ++n) _Pragma("unroll") for (int k = 0; k < 2; ++k) dst[n][k] = *(const PG8_LAS bf16x8*)(lds + PG8_SB(b, h) + boff + n * 2048 + k * 1024); } while (0)
#define PG8_MMA(ai, bj, At, Bt) do { __builtin_amdgcn_s_setprio(1); _Pragma("unroll") for (int m = 0; m < 4; ++m) _Pragma("unroll") for (int n = 0; n < 2; ++n) _Pragma("unroll") for (int k = 0; k < 2; ++k) \
        acc[ai][bj][m][n] = __builtin_amdgcn_mfma_f32_16x16x32_bf16(Bt[n][k], At[m][k], acc[ai][bj][m][n], 0, 0, 0); __builtin_amdgcn_s_setprio(0); } while (0)
#define PG8_WAIT_V(n) asm volatile("s_waitcnt vmcnt(" #n ")" ::: "memory")
#define PG8_WAIT_L(n) asm volatile("s_waitcnt lgkmcnt(" #n ")" ::: "memory")
#define PG8_BAR __builtin_amdgcn_s_barrier()
#define PG8_SCHED __builtin_amdgcn_sched_barrier(0)
    Unit cur, nxt; int ui = 0;
    if (!S.next(0, cur)) return;
    f32x4 acc[2][2][4][2];
#pragma unroll
    for (int a = 0; a < 2; ++a)
#pragma unroll
        for (int b = 0; b < 2; ++b)
#pragma unroll
            for (int m = 0; m < 4; ++m)
#pragma unroll
                for (int n = 0; n < 2; ++n) acc[a][b][m][n] = (f32x4){0.f, 0.f, 0.f, 0.f};
    bf16x8 At[4][2], B0[2][2], B1[2][2];
    const char* cA = (const char*)g.A + (size_t)cur.pm * tstep; const char* cB = (const char*)g.Bt + (size_t)cur.pn * tstep;
    S.a_ready(cur);
    if constexpr (SP2) {
        PG8_STAGE(PG8_SB(0, 0), cB, voffB); PG8_STAGE(PG8_SB(0, 1), cB + hstep, voffB); PG8_STAGE(PG8_SA(0, 0), cA, voffA); PG8_STAGE(PG8_SA(0, 1), cA + hstep, voffA);
        if (wr == 1) PG8_BAR;
        PG8_WAIT_V(2); PG8_BAR;
        PG8_STAGE(PG8_SB(1, 0), cB + kstep, voffB); PG8_STAGE(PG8_SA(1, 0), cA + kstep, voffA); PG8_STAGE(PG8_SB(1, 1), cB + hstep + kstep, voffB);
        PG8_WAIT_V(6); PG8_BAR;
    } else {
        PG8_STAGE(PG8_SB(0, 0), cB, voffB); PG8_STAGE(PG8_SA(0, 0), cA, voffA); PG8_STAGE(PG8_SB(0, 1), cB + hstep, voffB); PG8_STAGE(PG8_SA(0, 1), cA + hstep, voffA);
        if (wr == 1) PG8_BAR;
        PG8_WAIT_V(4); PG8_BAR;
        PG8_STAGE(PG8_SB(1, 0), cB + kstep, voffB); PG8_STAGE(PG8_SA(1, 0), cA + kstep, voffA); PG8_STAGE(PG8_SB(1, 1), cB + hstep + kstep, voffB);
        PG8_WAIT_V(6); PG8_BAR;
    }
    for (;;) {
        const bool has_next = S.next(ui + 1, nxt);
        const char* nA = has_next ? (const char*)g.A + (size_t)nxt.pm * tstep : cA; const char* nB = has_next ? (const char*)g.Bt + (size_t)nxt.pn * tstep : cB;
        for (int t = 0; t < nt; t += 2) {
            const bool last = (t == nt - 2);
            const char* a1 = cA + (size_t)(t + 1) * kstep;
            const char* a2 = last ? nA : cA + (size_t)(t + 2) * kstep; const char* b2 = last ? nB : cB + (size_t)(t + 2) * kstep;
            const char* a3 = a2 + kstep; const char* b3 = b2 + kstep;
            if (last && has_next) S.a_ready(nxt);
            if constexpr (SP2) {
            PG8_LDB(B0, 0, 0); PG8_LDB(B1, 0, 1); PG8_SCHED; PG8_LDA(At, 0, 0); PG8_STAGE(PG8_SA(1, 1), a1 + hstep, voffA);
            PG8_WAIT_V(8); PG8_WAIT_L(0); PG8_BAR; PG8_MMA(0, 0, At, B0); PG8_MMA(0, 1, At, B1); PG8_BAR; PG8_SCHED;
            PG8_LDA(At, 0, 1); PG8_STAGE(PG8_SB(0, 0), b2, voffB); PG8_STAGE(PG8_SB(0, 1), b2 + hstep, voffB); PG8_STAGE(PG8_SA(0, 0), a2, voffA);
            PG8_WAIT_V(8); PG8_WAIT_L(0); PG8_BAR; PG8_MMA(1, 0, At, B0); PG8_MMA(1, 1, At, B1); PG8_BAR; PG8_SCHED;
            PG8_LDB(B0, 1, 0); PG8_LDB(B1, 1, 1); PG8_SCHED; PG8_LDA(At, 1, 0); PG8_STAGE(PG8_SA(0, 1), a2 + hstep, voffA);
            PG8_WAIT_V(8); PG8_WAIT_L(0); PG8_BAR; PG8_MMA(0, 0, At, B0); PG8_MMA(0, 1, At, B1); PG8_BAR; PG8_SCHED;
            PG8_LDA(At, 1, 1); PG8_STAGE(PG8_SB(1, 0), b3, voffB); PG8_STAGE(PG8_SB(1, 1), b3 + hstep, voffB); PG8_STAGE(PG8_SA(1, 0), a3, voffA);
            PG8_WAIT_V(8); PG8_WAIT_L(0); PG8_BAR; PG8_MMA(1, 0, At, B0); PG8_MMA(1, 1, At, B1); PG8_BAR; PG8_SCHED;
            } else {
            PG8_LDB(B0, 0, 0); PG8_SCHED; PG8_LDA(At, 0, 0); PG8_STAGE(PG8_SA(1, 1), a1 + hstep, voffA);
            PG8_WAIT_L(8); PG8_BAR; PG8_WAIT_L(0); PG8_MMA(0, 0, At, B0); PG8_BAR; PG8_SCHED;
            PG8_LDB(B1, 0, 1); PG8_STAGE(PG8_SB(0, 0), b2, voffB);
            PG8_BAR; PG8_WAIT_L(0); PG8_MMA(0, 1, At, B1); PG8_BAR;
            PG8_LDA(At, 0, 1); PG8_STAGE(PG8_SA(0, 0), a2, voffA);
            PG8_BAR; PG8_WAIT_L(0); PG8_MMA(1, 0, At, B0); PG8_BAR; PG8_SCHED;
            PG8_STAGE(PG8_SB(0, 1), b2 + hstep, voffB);
            PG8_WAIT_V(6); PG8_BAR; PG8_MMA(1, 1, At, B1); PG8_BAR;
            PG8_LDB(B0, 1, 0); PG8_SCHED; PG8_LDA(At, 1, 0); PG8_STAGE(PG8_SA(0, 1), a2 + hstep, voffA);
            PG8_WAIT_L(8); PG8_BAR; PG8_WAIT_L(0); PG8_MMA(0, 0, At, B0); PG8_BAR; PG8_SCHED;
            PG8_LDB(B1, 1, 1); PG8_STAGE(PG8_SB(1, 0), b3, voffB);
            PG8_BAR; PG8_WAIT_L(0); PG8_MMA(0, 1, At, B1); PG8_BAR;
            PG8_LDA(At, 1, 1); PG8_STAGE(PG8_SA(1, 0), a3, voffA);
            PG8_BAR; PG8_WAIT_L(0); PG8_MMA(1, 0, At, B0); PG8_BAR; PG8_SCHED;
            PG8_STAGE(PG8_SB(1, 1), b3 + hstep, voffB);
            PG8_WAIT_V(6); PG8_BAR; PG8_MMA(1, 1, At, B1); PG8_BAR;
            }
        }
        if constexpr (ALIGN_EPI) { if (wr == 0) PG8_BAR; }
        if constexpr (!Epi::AFTER_DRAIN) { E(acc, cur, wr, wc, fr, fq); S.done(cur); }
        if (!has_next) break;
#pragma unroll
        for (int a = 0; a < 2; ++a)
#pragma unroll
            for (int b = 0; b < 2; ++b)
#pragma unroll
                for (int m = 0; m < 4; ++m)
#pragma unroll
                    for (int n = 0; n < 2; ++n) acc[a][b][m][n] = (f32x4){0.f, 0.f, 0.f, 0.f};
        cur = nxt; cA = nA; cB = nB; ++ui;
        if constexpr (ALIGN_EPI) { if (wr == 1) PG8_BAR; }
    }
    PG8_WAIT_V(0);
    if constexpr (!ALIGN_EPI) { if (wr == 0) PG8_BAR; }
    PG8_BAR;
    if constexpr (Epi::AFTER_DRAIN) { E.fused(acc, cur, wr, wc, fr, fq, lds, wid, lane); S.done(cur); }
#undef PG8_SA
#undef PG8_SB
#undef PG8_STAGE
#undef PG8_LDA
#undef PG8_LDB
#undef PG8_MMA
#undef PG8_WAIT_V
#undef PG8_WAIT_L
#undef PG8_BAR
#undef PG8_SCHED
}
}

namespace pg8 {
__host__ __device__ __forceinline__ int permk(int kl) { return 8 * ((kl & 15) >> 2) + 4 * (kl >> 4) + (kl & 3); }
struct EpiBf16Rs {
    static constexpr bool PERM = true, AFTER_DRAIN = false;
    bf16_t* O0; int ld0; int ntile0; bf16_t* O1; int ld1; size_t stride1; const float* ssq; float cs;
    __device__ __forceinline__ void operator()(const f32x4 (&acc)[2][2][4][2], const Unit& u, int wr, int wc, int fr, int fq) const {
        bf16_t* base; int ld, colt;
        if (u.pn < ntile0) { base = O0; ld = ld0; colt = u.pn * BM; }
        else { const int q = u.pn - ntile0, per = ld1 / BM; base = O1 + (size_t)(q / per) * stride1; ld = ld1; colt = (q % per) * BM; }
        const int row0 = u.pm * BM + wr * 64 + fr, col0 = colt + wc * 32 + 8 * fq;
#pragma unroll
        for (int ai = 0; ai < 2; ++ai)
#pragma unroll
            for (int m = 0; m < 4; ++m) {
                const int row = row0 + ai * HALF + m * 16;
                float sc = cs; if (ssq) sc *= rsqrtf(ssq[row] * (1.0f / 1024.0f) + 1e-6f);
                bf16_t* rowp = base + (size_t)row * ld + col0;
#pragma unroll
                for (int bj = 0; bj < 2; ++bj) { const f32x4 v0 = acc[ai][bj][m][0] * sc, v1 = acc[ai][bj][m][1] * sc;
                    u32x4 w; w.x = cvt_pk_bf16(v0[0], v0[1]); w.y = cvt_pk_bf16(v0[2], v0[3]); w.z = cvt_pk_bf16(v1[0], v1[1]); w.w = cvt_pk_bf16(v1[2], v1[3]);
                    *(u32x4*)(rowp + bj * HALF) = w; } }
    }
};
struct EpiF16Rs {
    static constexpr bool PERM = true, AFTER_DRAIN = false;
    _Float16* O; int ld; const float* ssq;
    __device__ __forceinline__ void operator()(const f32x4 (&acc)[2][2][4][2], const Unit& u, int wr, int wc, int fr, int fq) const {
        typedef _Float16 f16x8 __attribute__((ext_vector_type(8)));
        const int row0 = u.pm * BM + wr * 64 + fr, col0 = u.pn * BM + wc * 32 + 8 * fq;
#pragma unroll
        for (int ai = 0; ai < 2; ++ai)
#pragma unroll
            for (int m = 0; m < 4; ++m) {
                const int row = row0 + ai * HALF + m * 16;
                const float sc = rsqrtf(ssq[row] * (1.0f / 1024.0f) + 1e-6f);
                _Float16* rowp = O + (size_t)row * ld + col0;
#pragma unroll
                for (int bj = 0; bj < 2; ++bj) { const f32x4 v0 = acc[ai][bj][m][0] * sc, v1 = acc[ai][bj][m][1] * sc;
                    f16x8 w; w[0] = (_Float16)v0[0]; w[1] = (_Float16)v0[1]; w[2] = (_Float16)v0[2]; w[3] = (_Float16)v0[3];
                    w[4] = (_Float16)v1[0]; w[5] = (_Float16)v1[1]; w[6] = (_Float16)v1[2]; w[7] = (_Float16)v1[3];
                    *(f16x8*)(rowp + bj * HALF) = w; } }
    }
};
template <bool BASE_F32> struct EpiResidBf {
    static constexpr bool PERM = true, AFTER_DRAIN = false;
    const float* basef; bf16_t* xb; float* ssq;
    __device__ __forceinline__ void operator()(const f32x4 (&acc)[2][2][4][2], const Unit& u, int wr, int wc, int fr, int fq) const {
        const int row0 = u.pm * BM + wr * 64 + fr, col0 = u.pn * BM + wc * 32 + 8 * fq;
#pragma unroll
        for (int ai = 0; ai < 2; ++ai)
#pragma unroll
            for (int m = 0; m < 4; ++m) {
                const int row = row0 + ai * HALF + m * 16; const size_t off = (size_t)row * 1024 + col0; float s = 0.f;
#pragma unroll
                for (int bj = 0; bj < 2; ++bj) { const size_t o2 = off + bj * HALF;
                    f32x4 b0, b1;
                    if (BASE_F32) { b0 = *(const f32x4*)(basef + o2); b1 = *(const f32x4*)(basef + o2 + 4); }
                    else { const u32x4 p = *(const u32x4*)(xb + o2);
                        b0 = (f32x4){__builtin_bit_cast(float, p.x << 16), __builtin_bit_cast(float, p.x & 0xffff0000u), __builtin_bit_cast(float, p.y << 16), __builtin_bit_cast(float, p.y & 0xffff0000u)};
                        b1 = (f32x4){__builtin_bit_cast(float, p.z << 16), __builtin_bit_cast(float, p.z & 0xffff0000u), __builtin_bit_cast(float, p.w << 16), __builtin_bit_cast(float, p.w & 0xffff0000u)}; }
                    const f32x4 o0 = b0 + acc[ai][bj][m][0], o1 = b1 + acc[ai][bj][m][1];
                    s += ((o0[0] * o0[0] + o0[1] * o0[1]) + (o0[2] * o0[2] + o0[3] * o0[3])) + ((o1[0] * o1[0] + o1[1] * o1[1]) + (o1[2] * o1[2] + o1[3] * o1[3]));
                    u32x4 w; w.x = cvt_pk_bf16(o0[0], o0[1]); w.y = cvt_pk_bf16(o0[2], o0[3]); w.z = cvt_pk_bf16(o1[0], o1[1]); w.w = cvt_pk_bf16(o1[2], o1[3]);
                    *(u32x4*)(xb + o2) = w; }
                s += __shfl_xor(s, 16); s += __shfl_xor(s, 32);
                if (fq == 0) atomicAdd(ssq + row, s);
            }
    }
};
struct EpiKV {
    static constexpr bool PERM = false, AFTER_DRAIN = false;
    bf16_t* Kb; bf16_t* VTp;
    __device__ __forceinline__ void operator()(const f32x4 (&acc)[2][2][4][2], const Unit& u, int wr, int wc, int fr, int fq) const {
        typedef unsigned u32x2v __attribute__((ext_vector_type(2)));
        const int row0 = u.pm * BM + wr * 64 + fr, col0 = u.pn * BM + wc * 32 + 4 * fq;
#pragma unroll
        for (int ai = 0; ai < 2; ++ai)
#pragma unroll
            for (int m = 0; m < 4; ++m) {
                const int row = row0 + ai * HALF + m * 16, b = row >> 8, key = row & 255;
#pragma unroll
                for (int bj = 0; bj < 2; ++bj)
#pragma unroll
                    for (int n = 0; n < 2; ++n) { const int col = col0 + bj * HALF + n * 16; const f32x4 v = acc[ai][bj][m][n];
                        const unsigned p01 = cvt_pk_bf16(v[0], v[1]), p23 = cvt_pk_bf16(v[2], v[3]);
                        if (col < 1024) { const int h = col >> 8, dh = col & 255; u32x2v w; w.x = p01; w.y = p23;
                            *(u32x2v*)(Kb + ((size_t)((b * 4 + h) * 256 + key)) * 256 + dh) = w; }
                        else { const int c2 = col - 1024, h = c2 >> 8, dv = c2 & 255, kp = (key & ~31) | permk(key & 31);
                            bf16_t* d = VTp + ((size_t)((b * 4 + h) * 256 + dv)) * 256 + kp;
                            d[0] = (bf16_t)(p01 & 0xffffu); d[256] = (bf16_t)(p01 >> 16); d[512] = (bf16_t)(p23 & 0xffffu); d[768] = (bf16_t)(p23 >> 16); } }
            }
    }
};
}
#ifndef PG8_SP2
#define PG8_SP2 true
#endif
#ifndef PG8_ALIGN
#define PG8_ALIGN true
#endif

constexpr int NWAVES = 8;
#ifndef MK_PER_PHASE
#define MK_PER_PHASE 0
#endif
constexpr int T = 16384, SEQ = 8192, D = 1024;
constexpr int N_PHASES = 12;

constexpr size_t MiB = 1u << 20, KiB = 1u << 10;
constexpr size_t WS_CTL = 0, CTL_ZERO_BYTES = 1 * MiB;
constexpr int CW_BAR = 4096;
constexpr size_t WS_SSQ1 = 64 * KiB, WS_SSQ2 = 128 * KiB;
constexpr size_t WS_AB = 1 * MiB;
constexpr size_t WS_HEND = WS_AB + 512 * KiB, WS_PEND = WS_HEND + 512 * KiB, WS_HIN = WS_PEND + 512 * KiB;
constexpr size_t WS_DEC = WS_HIN + 512 * KiB;
constexpr size_t WS_SUBK = 3 * MiB + 256 * KiB;
constexpr size_t WS_WIN = 4 * MiB, WS_WOUT = 10 * MiB, WS_WQ = 12 * MiB, WS_WKV = 14 * MiB, WS_WO = 18 * MiB, WS_PWQ = 20 * MiB;
constexpr size_t WS_MEMN = 24 * MiB, WS_KB = 25 * MiB, WS_VTP = 26 * MiB, WS_LRUWT = 27 * MiB, WS_USC = 27 * MiB + 256 * KiB, WS_VSC = 27 * MiB + 384 * KiB;
constexpr size_t WS_XB = 28 * MiB;
constexpr size_t WS_HLOC = 28 * MiB, WS_PCUM = 44 * MiB;
constexpr size_t WS_QKV = 60 * MiB;
constexpr size_t OUT_Y = 4 * MiB;
constexpr size_t OUT_END = OUT_Y + (size_t)16384 * 1024 * 2;
constexpr size_t WS_IDX = 60 * MiB, WS_GW = 68 * MiB;
constexpr size_t WS_UB = 60 * MiB;
constexpr size_t WS_XR = 108 * MiB, WS_Z = 124 * MiB, WS_GATE = 140 * MiB;
constexpr size_t WS_WN = 156 * MiB, WS_UF = 172 * MiB, WS_QD = 188 * MiB, WS_KD = 204 * MiB, WS_ATT = 220 * MiB;
constexpr size_t WS_VB = 228 * MiB;
constexpr size_t WS_Q = 188 * MiB, WS_AO = 124 * MiB;
constexpr size_t WS_PQ = 108 * MiB;
constexpr size_t WS_END = 244 * MiB;
constexpr int CW_GFLAG = 49152;
constexpr int CW_LRUCNT = 8192;
static_assert(WS_XR - WS_QKV == (size_t)T * 1536 * 2 && WS_Z - WS_XR == (size_t)T * 512 * 2 && WS_GATE - WS_Z == (size_t)T * 512 * 2, "in-proj outputs are contiguous");

constexpr int LDS_BYTES = 160 * 1024;
constexpr int MISC_OFF = 159 * 1024;

#define GAS __attribute__((address_space(1)))
#define LAS __attribute__((address_space(3)))
typedef unsigned short bf16;
typedef unsigned v4u __attribute__((ext_vector_type(4)));
typedef unsigned v2u __attribute__((ext_vector_type(2)));
typedef float f32x4 __attribute__((ext_vector_type(4)));
typedef short bf16x8 __attribute__((ext_vector_type(8)));
typedef GAS unsigned gu32;
#define LDS_WAIT() asm volatile("s_waitcnt lgkmcnt(0)" ::: "memory")
__device__ __forceinline__ void st16_wt(void* p, v4u v) { asm volatile("global_store_dwordx4 %0, %1, off sc0 sc1\n\ts_nop 1" :: "v"(p), "v"(v) : "memory"); }
__device__ __forceinline__ unsigned f2bf(float f) { unsigned u = __builtin_bit_cast(unsigned, f); return (u + 0x7fffu + ((u >> 16) & 1u)) >> 16; }
__device__ __forceinline__ unsigned pk2(float lo, float hi) { return f2bf(lo) | (f2bf(hi) << 16); }
__device__ __forceinline__ float bflo(unsigned u) { return __builtin_bit_cast(float, u << 16); }
__device__ __forceinline__ float bfhi(unsigned u) { return __builtin_bit_cast(float, u & 0xffff0000u); }
__device__ __forceinline__ float bf1(bf16 h) { return __builtin_bit_cast(float, (unsigned)h << 16); }
__device__ __forceinline__ float wave_sum(float v) {
#pragma unroll
    for (int o = 1; o < 64; o <<= 1) v += __shfl_xor(v, o);
    return v;
}
__device__ __forceinline__ float row16_sum(float v) {
    v += __builtin_bit_cast(float, __builtin_amdgcn_update_dpp(0, __builtin_bit_cast(int, v), 0xB1, 0xF, 0xF, true));
    v += __builtin_bit_cast(float, __builtin_amdgcn_update_dpp(0, __builtin_bit_cast(int, v), 0x4E, 0xF, 0xF, true));
    v += __builtin_bit_cast(float, __builtin_amdgcn_update_dpp(0, __builtin_bit_cast(int, v), 0x141, 0xF, 0xF, true));
    v += __builtin_bit_cast(float, __builtin_amdgcn_update_dpp(0, __builtin_bit_cast(int, v), 0x140, 0xF, 0xF, true));
    return v;
}
__device__ __forceinline__ float sigmoidf_(float x) { return __builtin_amdgcn_rcpf(1.0f + __expf(-x)); }
__device__ __forceinline__ float softplusf_(float x) { return fmaxf(x, 0.f) + log1pf(__expf(-fabsf(x))); }
__device__ __forceinline__ float siluf_(float x) { return x * __builtin_amdgcn_rcpf(1.0f + __expf(-x)); }
__device__ __forceinline__ float gelu_tanh(float x) { const float y = 0.7978845608028654f * (x + 0.044715f * x * x * x); const float e = __expf(2.0f * y); return x * (1.0f - __builtin_amdgcn_rcpf(1.0f + e)); }
__device__ __forceinline__ int permk(int kl) { return 8 * ((kl & 15) >> 2) + 4 * (kl >> 4) + (kl & 3); }

struct Params {
    const float *x, *mem, *norm_mix_w, *w_in, *conv_qkv_w, *gdn_a_log, *gdn_dt_bias, *gdn_norm_w, *lru_conv_w, *lru_conv_b, *lru_wa, *lru_ba, *lru_wx, *lru_bx, *lru_lambda, *w_out,
                *norm_xattn_w, *norm_mem_w, *xattn_wq, *xattn_wkv, *xattn_wo, *norm_ffn_w, *peer_wq, *peer_subkeys, *peer_u, *peer_v, *norm_final_w;
    float* out; unsigned char* ws; int ph_lo, ph_hi;
};
#define XB_TMO      128
#define XB_XCNT(j)  (256  + 64 * (j))
#define XB_XSUB(j)  (1280 + 64 * (j))
#define XB_XGEN(j)  (2304 + 64 * (j))
#define XB_TOP      3328
#define XB_TOPGEN   3392
#define XCD_BAR_WORDS 3456
#define XB_SPIN_CAP (1u << 18)

__device__ __forceinline__ unsigned xb_ld(unsigned* p)              { return __hip_atomic_load(p, __ATOMIC_RELAXED, __HIP_MEMORY_SCOPE_AGENT); }
__device__ __forceinline__ unsigned xb_add(unsigned* p, unsigned v) { return __hip_atomic_fetch_add(p, v, __ATOMIC_RELAXED, __HIP_MEMORY_SCOPE_AGENT); }
__device__ __forceinline__ unsigned xb_xcc_id() { return (unsigned)__builtin_amdgcn_s_getreg((3 << 11) | 20) & 0xFu; }
#define XB_SPIN(cond, bar) do { unsigned _sp = 0; while (cond) { __builtin_amdgcn_s_sleep(1); \
    if ((++_sp & 255u) == 0u) { if (xb_ld(&(bar)[XB_TMO])) break; if (_sp > XB_SPIN_CAP) { atomicAdd(&(bar)[XB_TMO], 1u); break; } } } } while (0)

struct XcdBarrier {
    unsigned* bar; unsigned x;
    volatile LAS unsigned* st;
};

__device__ __forceinline__ XcdBarrier xcd_barrier_post(unsigned* bar, volatile LAS unsigned* st) {
    XcdBarrier b; b.bar = bar; b.x = xb_xcc_id(); b.st = st;
    if (threadIdx.x == 0) (void)xb_add(&bar[XB_XCNT(b.x)], 1u);
    return b;
}
__device__ __forceinline__ void xcd_barrier_complete(unsigned* bar, unsigned x, unsigned& nloc, unsigned& nx) {
    const unsigned G = gridDim.x * gridDim.y * gridDim.z;
    unsigned sum, cnt, mine, sp = 0u;
    for (;;) {
        sum = 0u; cnt = 0u; mine = 0u;
#pragma unroll
        for (unsigned j = 0; j < 16; ++j) { const unsigned c = xb_ld(&bar[XB_XCNT(j)]); sum += c; cnt += (c > 0u) ? 1u : 0u; mine = (j == x) ? c : mine; }
        if (sum == G) break;
        __builtin_amdgcn_s_sleep(1);
        if ((++sp & 255u) == 0u) { if (xb_ld(&bar[XB_TMO])) break; if (sp > XB_SPIN_CAP) { atomicAdd(&bar[XB_TMO], 1u); break; } }
    }
    nloc = mine > 0u ? mine : 1u; nx = cnt > 0u ? cnt : 1u;
}

__device__ __forceinline__ void xcd_barrier(const XcdBarrier& b) {
    asm volatile("s_waitcnt vmcnt(0)" ::: "memory");
    __syncthreads();
    if (threadIdx.x == 0) {
        unsigned* bar = b.bar;
        __builtin_amdgcn_s_waitcnt(0);
        unsigned nloc = b.st[0], nx = b.st[1];
        if (nloc == 0u) { xcd_barrier_complete(bar, b.x, nloc, nx); b.st[0] = nloc; b.st[1] = nx; }
        const unsigned old = xb_add(&bar[XB_XSUB(b.x)], 1u);
        const unsigned gen = old / nloc;
        if (old + 1u == (gen + 1u) * nloc) {
            __builtin_amdgcn_fence(__ATOMIC_RELEASE, "agent");
            asm volatile("s_waitcnt vmcnt(0)" ::: "memory");
            const unsigned og = xb_add(&bar[XB_TOP], 1u);
            const unsigned tg = og / nx;
            if (og + 1u == (tg + 1u) * nx) xb_add(&bar[XB_TOPGEN], 1u);
            else XB_SPIN(xb_ld(&bar[XB_TOPGEN]) == tg, bar);
            __builtin_amdgcn_fence(__ATOMIC_ACQUIRE, "agent");
            xb_add(&bar[XB_XGEN(b.x)], 1u);
            asm volatile("s_waitcnt vmcnt(0)" ::: "memory");
        } else {
            XB_SPIN(xb_ld(&bar[XB_XGEN(b.x)]) == gen, bar);
            __builtin_amdgcn_fence(__ATOMIC_ACQUIRE, "agent");
            asm volatile("s_waitcnt vmcnt(0)" ::: "memory");
        }
    }
    __syncthreads();
}

__device__ __forceinline__ void p0_transpose_item(const float* W, int K, int ldw, int c0, int nblk, bf16* WT, int row_off, const float* ks, LAS float* scr, int item, int lane) {
    const int kb = item / nblk, nb = item % nblk, k0 = 64 * kb, n0 = 32 * nb;
#pragma unroll 8
    for (int i = 0; i < 32; ++i) { const int kk = 2 * i + (lane >> 5); float v = W[(size_t)(k0 + kk) * ldw + c0 + n0 + (lane & 31)]; if (ks) v *= ks[k0 + kk]; scr[kk * 33 + (lane & 31)] = v; }
    LDS_WAIT(); asm volatile("" ::: "memory");
    const int c = lane & 7;
#pragma unroll
    for (int j = 0; j < 4; ++j) { const int n = (lane >> 3) + 8 * j; const LAS float* s = scr + (8 * c) * 33 + n;
        v4u o; o.x = pk2(s[0 * 33], s[1 * 33]); o.y = pk2(s[2 * 33], s[3 * 33]); o.z = pk2(s[4 * 33], s[5 * 33]); o.w = pk2(s[6 * 33], s[7 * 33]);
        *(GAS v4u*)(WT + (size_t)(row_off + n0 + n) * K + k0 + 8 * c) = o; }
    LDS_WAIT(); asm volatile("" ::: "memory");
}

__device__ __forceinline__ void p0_prologue(const Params& P, LAS unsigned char* lds, int tid, int lane, int wave, int vcu, int G) {
    unsigned char* ws = P.ws;
    const int gw = vcu * NWAVES + wave, NGW = G * NWAVES;
    LAS float* wabl = (LAS float*)lds;
    for (int idx = tid; idx < 8192; idx += NWAVES * 64) { const int k = idx >> 3, c = idx & 7, j = k >> 8, l = (k >> 2) & 63, e = k & 3;
        wabl[((((j * 4 + e) * 2 + (c >> 2)) * 64 + l) << 2) + (c & 3)] = P.w_in[(size_t)k * 3080 + 2048 + c]; }
    __syncthreads();
    {
        bf16* XB0 = (bf16*)(ws + WS_XB); float* AB = (float*)(ws + WS_AB);
        f32x4 w4[4];
#pragma unroll
        for (int j = 0; j < 4; ++j) w4[j] = ((const f32x4*)P.norm_mix_w)[64 * j + lane];
        for (int m = gw; m < T; m += NGW) {
            const f32x4* xr = (const f32x4*)(P.x + (size_t)m * D) + lane;
            f32x4 v[4]; float s = 0.f;
#pragma unroll
            for (int j = 0; j < 4; ++j) { v[j] = xr[64 * j]; s += (v[j].x * v[j].x + v[j].y * v[j].y) + (v[j].z * v[j].z + v[j].w * v[j].w); }
            const float rstd = rsqrtf(wave_sum(s) * (1.0f / D) + 1e-6f);
            v2u* o8 = (v2u*)(XB0 + (size_t)m * D) + lane;
            float part[8];
#pragma unroll
            for (int c = 0; c < 8; ++c) part[c] = 0.f;
#pragma unroll
            for (int j = 0; j < 4; ++j) {
                v[j] = v[j] * rstd * w4[j];
                v2u o; o.x = pk2(v[j].x, v[j].y); o.y = pk2(v[j].z, v[j].w); o8[64 * j] = o;
#pragma unroll
                for (int e = 0; e < 4; ++e) {
                    const f32x4 wa = *(const LAS f32x4*)(wabl + ((((j * 4 + e) * 2 + 0) * 64 + lane) << 2));
                    const f32x4 wb = *(const LAS f32x4*)(wabl + ((((j * 4 + e) * 2 + 1) * 64 + lane) << 2));
                    const float hv = v[j][e];
                    part[0] += hv * wa.x; part[1] += hv * wa.y; part[2] += hv * wa.z; part[3] += hv * wa.w;
                    part[4] += hv * wb.x; part[5] += hv * wb.y; part[6] += hv * wb.z; part[7] += hv * wb.w;
                }
            }
#pragma unroll
            for (int c = 0; c < 8; ++c) part[c] = wave_sum(part[c]);
            float o = part[0];
#pragma unroll
            for (int c = 1; c < 8; ++c) o = (lane == c) ? part[c] : o;
            if (lane < 8) AB[(size_t)m * 8 + lane] = o;
        }
    }
    {
        bf16* MEMN = (bf16*)(ws + WS_MEMN);
        for (int m = gw; m < 512; m += NGW) {
            const f32x4* xr = (const f32x4*)(P.mem + (size_t)m * D) + lane;
            f32x4 v[4]; float s = 0.f;
#pragma unroll
            for (int j = 0; j < 4; ++j) { v[j] = xr[64 * j]; s += (v[j].x * v[j].x + v[j].y * v[j].y) + (v[j].z * v[j].z + v[j].w * v[j].w); }
            const float rstd = rsqrtf(wave_sum(s) * (1.0f / D) + 1e-6f);
            v2u* o8 = (v2u*)(MEMN + (size_t)m * D) + lane;
#pragma unroll
            for (int j = 0; j < 4; ++j) { const f32x4 w = ((const f32x4*)P.norm_mem_w)[64 * j + lane]; const f32x4 y = v[j] * rstd * w;
                v2u o; o.x = pk2(y.x, y.y); o.y = pk2(y.z, y.w); o8[64 * j] = o; }
        }
    }
    __syncthreads();
    {
        LAS float* scr = (LAS float*)(lds + wave * 16384);
        constexpr int I_IN1 = 16 * 48, I_IN2 = 16 * 16, I_KV = 16 * 64;
        constexpr int NITEMS = I_IN1 + 3 * I_IN2 + I_KV;
        for (int it = gw; it < NITEMS; it += NGW) {
            int r = it;
            if (r < I_IN1) { p0_transpose_item(P.w_in, 1024, 3080, 0, 48, (bf16*)(ws + WS_WIN), 0, nullptr, scr, r, lane); continue; } r -= I_IN1;
            if (r < I_IN2) { p0_transpose_item(P.w_in, 1024, 3080, 2056, 16, (bf16*)(ws + WS_WIN), 1536, nullptr, scr, r, lane); continue; } r -= I_IN2;
            if (r < I_IN2) { p0_transpose_item(P.w_in, 1024, 3080, 1536, 16, (bf16*)(ws + WS_WIN), 2048, nullptr, scr, r, lane); continue; } r -= I_IN2;
            if (r < I_IN2) { p0_transpose_item(P.w_in, 1024, 3080, 2568, 16, (bf16*)(ws + WS_WIN), 2560, nullptr, scr, r, lane); continue; } r -= I_IN2;
            p0_transpose_item(P.xattn_wkv, 1024, 2048, 0, 64, (bf16*)(ws + WS_WKV), 0, nullptr, scr, r, lane);
        }
    }
    {
        bf16* WT = (bf16*)(ws + WS_LRUWT);
        for (int it = vcu * NWAVES * 64 + tid; it < 8 * 2 * 64 * 8; it += G * NWAVES * 64) {
            const int i8 = it & 7, j = (it >> 3) & 63, m = (it >> 9) & 1, g = it >> 10;
            const float* src = (m ? P.lru_wx : P.lru_wa) + (size_t)(g * 64 + 8 * i8) * 64 + j;
            v4u o; o.x = pk2(src[0], src[64]); o.y = pk2(src[128], src[192]); o.z = pk2(src[256], src[320]); o.w = pk2(src[384], src[448]);
            *(v4u*)(WT + (size_t)it * 8) = o;
        }
    }
}

__device__ __forceinline__ void late_weight_prep(const Params& P, LAS unsigned char* lds, int lane, int wave, int gw, int NGW) {
    unsigned char* ws = P.ws;
    {
        LAS float* scr = (LAS float*)(lds + wave * 16384);
        constexpr int I_OUT = 16 * 32, I_Q = 16 * 32, I_O = 16 * 32;
        for (int it = gw; it < I_OUT + I_Q + I_O; it += NGW) {
            int r = it;
            if (r < I_OUT) { p0_transpose_item(P.w_out, 1024, 1024, 0, 32, (bf16*)(ws + WS_WOUT), 0, nullptr, scr, r, lane); continue; } r -= I_OUT;
            if (r < I_Q) { p0_transpose_item(P.xattn_wq, 1024, 1024, 0, 32, (bf16*)(ws + WS_WQ), 0, P.norm_xattn_w, scr, r, lane); continue; } r -= I_Q;
            p0_transpose_item(P.xattn_wo, 1024, 1024, 0, 32, (bf16*)(ws + WS_WO), 0, nullptr, scr, r, lane);
        }
    }
    {
        bf16* WF = (bf16*)(ws + WS_PWQ);
        const int col = lane & 15, g = lane >> 4;
        for (int it = gw; it < 16 * 64; it += NGW) {
            const int hp = it >> 6, k0 = (it & 63) * 16;
            bf16x8 bq[4];
#pragma unroll
            for (int s = 0; s < 4; ++s) { const f32x4* src = (const f32x4*)(P.peer_wq + (size_t)(k0 + col) * 2048 + hp * 128 + 32 * s + 8 * g);
                const f32x4 a = src[0], c = src[1]; v4u pk; pk.x = pk2(a.x, a.y); pk.y = pk2(a.z, a.w); pk.z = pk2(c.x, c.y); pk.w = pk2(c.z, c.w); bq[s] = __builtin_bit_cast(bf16x8, pk); }
            const float nw = P.norm_ffn_w[k0 + col];
#pragma unroll 2
            for (int kt = 0; kt < 8; ++kt) {
                f32x4 acc = (f32x4){0.f, 0.f, 0.f, 0.f};
#pragma unroll
                for (int s = 0; s < 4; ++s) { const f32x4* src = (const f32x4*)(P.peer_subkeys + (size_t)(hp * 128 + 16 * kt + col) * 128 + 32 * s + 8 * g);
                    const f32x4 a = src[0], c = src[1]; v4u pk; pk.x = pk2(a.x, a.y); pk.y = pk2(a.z, a.w); pk.z = pk2(c.x, c.y); pk.w = pk2(c.z, c.w);
                    acc = __builtin_amdgcn_mfma_f32_16x16x32_bf16(__builtin_bit_cast(bf16x8, pk), bq[s], acc, 0, 0, 0); }
#pragma unroll
                for (int i = 0; i < 4; ++i) WF[(size_t)(hp * 128 + 16 * kt + 4 * g + i) * 1024 + k0 + col] = (bf16)f2bf(acc[i] * nw);
            }
        }
    }
}

constexpr int GL_KS = 0, GL_VS = 33792, GL_KB = 67584, GL_QB = 84992, GL_RAW = 102400, GL_CW = 153856, GL_AMT = 133120, GL_SM = 160000, GL_ATT = 151808, GL_SOL = 67584;
static_assert(GL_CW + 6144 <= GL_SM && GL_SM + 1284 <= MISC_OFF && GL_SOL + 65536 <= GL_AMT && GL_AMT + 17408 <= GL_ATT && GL_ATT + 8192 <= GL_SM && GL_RAW + 51456 <= GL_CW, "gdn_local LDS map");
#ifndef GL_REP_STEP
#define GL_REP_STEP -1
#endif
#define GL_REPF(k) for (int rr_ = 0; rr_ < ((GL_REP_STEP == (k)) ? 2 : 1); ++rr_)
#define GL_BAR() do { asm volatile("s_waitcnt lgkmcnt(0)" ::: "memory"); __builtin_amdgcn_s_barrier(); asm volatile("" ::: "memory"); } while (0)
__device__ __forceinline__ void gdn_local_item(const Params& P, LAS unsigned char* lds, int item, int tid) {
    unsigned char* ws = P.ws;
    asm volatile("" : "+v"(tid));
    const int b = item >> 9, h = (item >> 7) & 3, n = item & 127;
    const int t0 = b * SEQ + n * 64;
    const int lane = tid & 63, wave = __builtin_amdgcn_readfirstlane(tid >> 6);
    LAS float* ks = (LAS float*)(lds + GL_KS);
    LAS float* vs = (LAS float*)(lds + GL_VS);
    LAS bf16* kb16 = (LAS bf16*)(lds + GL_KB);
    LAS bf16* qb16 = (LAS bf16*)(lds + GL_QB);
    LAS bf16* raw = (LAS bf16*)(lds + GL_RAW);
    LAS float* cw = (LAS float*)(lds + GL_CW);
    LAS float* AmT = (LAS float*)(lds + GL_AMT);
    LAS float* sg = (LAS float*)(lds + GL_SM);
    LAS float* sbeta = sg + 64; LAS float* sgc = sbeta + 64; LAS float* seg = sgc + 64; LAS float* sek = seg + 64;
    LAS bf16* atts = (LAS bf16*)(lds + GL_ATT);
    const bf16* QKV = (const bf16*)(ws + WS_QKV);
    const float* AB = (const float*)(ws + WS_AB);
    GL_REPF(0) {
        v4u pr[7];
#pragma unroll
        for (int r = 0; r < 7; ++r) {
            const int id = tid + 512 * r;
            const int row = id / 48, rem = id - row * 48, part = rem >> 4, ck = rem & 15, s = n * 64 + row - 3;
            pr[r] = (v4u){0u, 0u, 0u, 0u};
            if (id < 67 * 48 && s >= 0) pr[r] = *(const v4u*)(QKV + (size_t)(b * SEQ + s) * 1536 + part * 512 + h * 128 + ck * 8);
        }
        f32x4 cwv = (f32x4){0.f, 0.f, 0.f, 0.f};
        if (tid < 384) { const int j = tid / 96, rem = tid - j * 96, part = rem >> 5, c4 = rem & 31; cwv = *(const f32x4*)(P.conv_qkv_w + j * 1536 + part * 512 + h * 128 + c4 * 4); }
        float a_in = 0.f, b_in = 0.f;
        if (tid < 64) { a_in = AB[(size_t)(t0 + tid) * 8 + h]; b_in = AB[(size_t)(t0 + tid) * 8 + 4 + h]; }
#pragma unroll
        for (int r = 0; r < 7; ++r) { const int id = tid + 512 * r; if (id < 67 * 48) *(LAS v4u*)(raw + id * 8) = pr[r]; }
        if (tid < 384) *(LAS f32x4*)(cw + tid * 4) = cwv;
        if (tid < 64) { sg[tid] = -__expf(P.gdn_a_log[h]) * softplusf_(a_in + P.gdn_dt_bias[h]); sbeta[tid] = sigmoidf_(b_in); }
    }
    GL_BAR();
    GL_REPF(1) {
        const int c = tid >> 3, grp = tid & 7;
#pragma unroll 1
        for (int part = 0; part < 3; ++part) {
            float y[16];
#pragma unroll
            for (int i = 0; i < 16; ++i) y[i] = 0.f;
#pragma unroll
            for (int j = 0; j < 4; ++j) {
                const LAS v4u* src = (const LAS v4u*)(raw + (c + j) * 384 + part * 128 + grp * 16);
                const v4u x0 = src[0], x1 = src[1];
                const LAS f32x4* wp = (const LAS f32x4*)(cw + (j * 3 + part) * 128 + grp * 16);
                const f32x4 w0 = wp[0], w1 = wp[1], w2 = wp[2], w3 = wp[3];
                y[0] += w0.x * bflo(x0.x); y[1] += w0.y * bfhi(x0.x); y[2] += w0.z * bflo(x0.y); y[3] += w0.w * bfhi(x0.y);
                y[4] += w1.x * bflo(x0.z); y[5] += w1.y * bfhi(x0.z); y[6] += w1.z * bflo(x0.w); y[7] += w1.w * bfhi(x0.w);
                y[8] += w2.x * bflo(x1.x); y[9] += w2.y * bfhi(x1.x); y[10] += w2.z * bflo(x1.y); y[11] += w2.w * bfhi(x1.y);
                y[12] += w3.x * bflo(x1.z); y[13] += w3.y * bfhi(x1.z); y[14] += w3.z * bflo(x1.w); y[15] += w3.w * bfhi(x1.w);
            }
            float ss = 0.f;
#pragma unroll
            for (int i = 0; i < 16; ++i) { y[i] = siluf_(y[i]); ss += y[i] * y[i]; }
            if (part < 2) {
                ss += __shfl_xor(ss, 1); ss += __shfl_xor(ss, 2); ss += __shfl_xor(ss, 4);
                const float sc = rsqrtf(ss + 1e-6f) * (part == 0 ? 0.08838834764831845f : 1.0f);
#pragma unroll
                for (int i = 0; i < 16; ++i) y[i] *= sc;
            }
            if (part >= 1) {
                LAS float* dst = (part == 1 ? ks : vs) + c * 132 + grp * 16;
#pragma unroll
                for (int i = 0; i < 4; ++i) *(LAS f32x4*)(dst + 4 * i) = (f32x4){y[4 * i], y[4 * i + 1], y[4 * i + 2], y[4 * i + 3]};
            }
            if (part <= 1) {
                LAS bf16* dst = (part == 0 ? qb16 : kb16) + c * 136 + grp * 16;
                v4u o0, o1; o0.x = pk2(y[0], y[1]); o0.y = pk2(y[2], y[3]); o0.z = pk2(y[4], y[5]); o0.w = pk2(y[6], y[7]);
                o1.x = pk2(y[8], y[9]); o1.y = pk2(y[10], y[11]); o1.z = pk2(y[12], y[13]); o1.w = pk2(y[14], y[15]);
                *(LAS v4u*)dst = o0; *(LAS v4u*)(dst + 8) = o1;
            }
        }
    }
    if (tid < 64) {
        float v = sg[tid];
#pragma unroll
        for (int off = 1; off < 64; off <<= 1) { const float t = __shfl_up(v, off); if (tid >= off) v += t; }
        sgc[tid] = v; seg[tid] = __expf(v);
        const float gl = __shfl(v, 63);
        sek[tid] = __expf(gl - v);
        if (tid == 63) sek[64] = __expf(v);
    }
    GL_BAR();
    {
        const int mat = wave >> 2, rho = wave & 3, col = lane & 15, g = lane >> 4;
        const LAS bf16* X = mat ? qb16 : kb16;
        bf16x8 af[4];
#pragma unroll
        for (int s = 0; s < 4; ++s) af[s] = *(const LAS bf16x8*)(X + (16 * rho + col) * 136 + 32 * s + 8 * g);
#pragma unroll
        for (int sig = 0; sig < 4; ++sig) {
            f32x4 acc = (f32x4){0.f, 0.f, 0.f, 0.f};
#pragma unroll
            for (int s = 0; s < 4; ++s) { const bf16x8 bfr = *(const LAS bf16x8*)(kb16 + (16 * sig + col) * 136 + 32 * s + 8 * g); acc = __builtin_amdgcn_mfma_f32_16x16x32_bf16(af[s], bfr, acc, 0, 0, 0); }
            const int sidx = 16 * sig + col; const float gs = sgc[sidx];
#pragma unroll
            for (int i = 0; i < 4; ++i) {
                const int c = 16 * rho + 4 * g + i;
                const float dec = (c >= sidx) ? __expf(sgc[c] - gs) : 0.f;
                if (mat == 0) AmT[sidx * 68 + c] = (c > sidx) ? sbeta[c] * acc[i] * dec : 0.f;
                else atts[c * 64 + sidx] = (bf16)f2bf(acc[i] * dec);
            }
        }
    }
    GL_BAR();
    GL_REPF(4) {
        bf16* QD = (bf16*)(ws + WS_QD) + (size_t)item * 8192;
        bf16* KD = (bf16*)(ws + WS_KD) + (size_t)item * 8192;
        bf16* ATT = (bf16*)(ws + WS_ATT) + (size_t)item * 4096;
#pragma unroll
        for (int r = 0; r < 2; ++r) {
            const int id = tid + 512 * r;
            { const int c = id >> 4, gam = id & 15, s32 = gam >> 2, g = gam & 3;
              const v2u lo = *(const LAS v2u*)(qb16 + c * 136 + 32 * s32 + 4 * g), hi = *(const LAS v2u*)(qb16 + c * 136 + 32 * s32 + 16 + 4 * g);
              const float e = seg[c];
              v4u o; o.x = pk2(bflo(lo.x) * e, bfhi(lo.x) * e); o.y = pk2(bflo(lo.y) * e, bfhi(lo.y) * e); o.z = pk2(bflo(hi.x) * e, bfhi(hi.x) * e); o.w = pk2(bflo(hi.y) * e, bfhi(hi.y) * e);
              st16_wt(QD + c * 128 + 8 * gam, o); }
            { const int dk = id >> 3, gam = id & 7, s32 = gam >> 2, g = gam & 3, c0 = 32 * s32 + 4 * g;
              float v[8];
#pragma unroll
              for (int j = 0; j < 4; ++j) { v[j] = ks[(c0 + j) * 132 + dk] * sek[c0 + j]; v[4 + j] = ks[(c0 + 16 + j) * 132 + dk] * sek[c0 + 16 + j]; }
              v4u o; o.x = pk2(v[0], v[1]); o.y = pk2(v[2], v[3]); o.z = pk2(v[4], v[5]); o.w = pk2(v[6], v[7]);
              st16_wt(KD + dk * 64 + 8 * gam, o); }
        }
        { const int c = tid >> 3, gam = tid & 7, s32 = gam >> 2, g = gam & 3;
          const v2u lo = *(const LAS v2u*)(atts + c * 64 + 32 * s32 + 4 * g), hi = *(const LAS v2u*)(atts + c * 64 + 32 * s32 + 16 + 4 * g);
          v4u o; o.x = lo.x; o.y = lo.y; o.z = hi.x; o.w = hi.y;
          st16_wt(ATT + c * 64 + 8 * gam, o); }
    }
    GL_BAR();
    GL_REPF(5) {
        LAS float* xcol = (LAS float*)(lds + GL_SOL);
        LAS bf16* tinv = (LAS bf16*)(lds + GL_SOL + 17408);
        const int j = tid >> 3, part = tid & 7, jb = j >> 4, jo = j & 15;
#pragma unroll 1
        for (int rb = jb; rb < 4; ++rb) {
            float acc[16];
#pragma unroll
            for (int i = 0; i < 16; ++i) acc[i] = 0.f;
            if (rb > jb) {
#pragma unroll 2
                for (int s = 16 * jb + part; s < 16 * rb; s += 8) {
                    const float sv = xcol[j * 68 + s];
                    const LAS float* ar = AmT + s * 68 + 16 * rb;
#pragma unroll
                    for (int q = 0; q < 4; ++q) { const f32x4 A4 = *(const LAS f32x4*)(ar + 4 * q);
                        acc[4 * q] -= A4.x * sv; acc[4 * q + 1] -= A4.y * sv; acc[4 * q + 2] -= A4.z * sv; acc[4 * q + 3] -= A4.w * sv; }
                }
#pragma unroll
                for (int i = 0; i < 16; ++i) {
                    acc[i] += __builtin_bit_cast(float, __builtin_amdgcn_update_dpp(0, __builtin_bit_cast(int, acc[i]), 0xB1, 0xF, 0xF, true));
                    acc[i] += __builtin_bit_cast(float, __builtin_amdgcn_update_dpp(0, __builtin_bit_cast(int, acc[i]), 0x4E, 0xF, 0xF, true));
                    acc[i] += __builtin_bit_cast(float, __builtin_amdgcn_update_dpp(0, __builtin_bit_cast(int, acc[i]), 0x141, 0xF, 0xF, true));
                }
            } else {
#pragma unroll
                for (int i = 0; i < 16; ++i) acc[i] = (i == jo) ? 1.f : 0.f;
            }
#pragma unroll
            for (int i = 0; i < 16; ++i) {
                const float sv = acc[i];
                const LAS float* ar = AmT + (16 * rb + i) * 68 + 16 * rb;
#pragma unroll
                for (int q = (i + 1) / 4; q < 4; ++q) { const f32x4 A4 = *(const LAS f32x4*)(ar + 4 * q);
                    if (4 * q > i) acc[4 * q] -= A4.x * sv; if (4 * q + 1 > i) acc[4 * q + 1] -= A4.y * sv; if (4 * q + 2 > i) acc[4 * q + 2] -= A4.z * sv; if (4 * q + 3 > i) acc[4 * q + 3] -= A4.w * sv; }
            }
            if (part == 0) {
#pragma unroll
                for (int i = 0; i < 16; ++i) { xcol[j * 68 + 16 * rb + i] = acc[i]; tinv[(16 * rb + i) * 72 + j] = (bf16)f2bf(acc[i]); }
            }
            LDS_WAIT(); asm volatile("" ::: "memory");
        }
        for (int rb = 0; rb < jb; ++rb) {
            if (part == 0) {
#pragma unroll
                for (int i = 0; i < 16; ++i) tinv[(16 * rb + i) * 72 + j] = (bf16)0;
            }
        }
    }
    GL_BAR();
    GL_REPF(6) {
        const LAS bf16* tinv = (const LAS bf16*)(lds + GL_SOL + 17408);
        LAS bf16* wst = (LAS bf16*)(lds + GL_SOL + 17408 + 9216);
        const int col = lane & 15, g = lane >> 4, isw = wave >> 2;
        bf16x8 af[4][2];
#pragma unroll
        for (int rho = 0; rho < 4; ++rho)
#pragma unroll
            for (int s2 = 0; s2 < 2; ++s2) af[rho][s2] = *(const LAS bf16x8*)(tinv + (16 * rho + col) * 72 + 32 * s2 + 8 * g);
        bf16* UF = (bf16*)(ws + WS_UF) + (size_t)item * 8192;
#pragma unroll
        for (int sig = 0; sig < 2; ++sig) {
            const int jj = 32 * (wave & 3) + 16 * sig + col;
            const LAS float* src = (isw ? ks : vs) + jj;
            bf16x8 bfr[2];
#pragma unroll
            for (int s2 = 0; s2 < 2; ++s2) {
                float v[8];
#pragma unroll
                for (int e = 0; e < 8; ++e) { const int sidx = 32 * s2 + 8 * g + e; float x = src[sidx * 132] * sbeta[sidx]; if (isw) x *= seg[sidx]; v[e] = x; }
                v4u pk; pk.x = pk2(v[0], v[1]); pk.y = pk2(v[2], v[3]); pk.z = pk2(v[4], v[5]); pk.w = pk2(v[6], v[7]);
                bfr[s2] = __builtin_bit_cast(bf16x8, pk);
            }
            f32x4 acc[4];
#pragma unroll
            for (int rho = 0; rho < 4; ++rho) { acc[rho] = (f32x4){0.f, 0.f, 0.f, 0.f};
#pragma unroll
                for (int s2 = 0; s2 < 2; ++s2) acc[rho] = __builtin_amdgcn_mfma_f32_16x16x32_bf16(af[rho][s2], bfr[s2], acc[rho], 0, 0, 0); }
            if (!isw) {
                v4u o0, o1;
                o0.x = pk2(acc[0].x, acc[0].y); o0.y = pk2(acc[0].z, acc[0].w); o0.z = pk2(acc[1].x, acc[1].y); o0.w = pk2(acc[1].z, acc[1].w);
                o1.x = pk2(acc[2].x, acc[2].y); o1.y = pk2(acc[2].z, acc[2].w); o1.z = pk2(acc[3].x, acc[3].y); o1.w = pk2(acc[3].z, acc[3].w);
                v4u* d = (v4u*)(UF + (size_t)(2 * (wave & 3) + sig) * 1024 + lane * 16);
                st16_wt(d, o0); st16_wt(d + 1, o1);
            } else {
#pragma unroll
                for (int rho = 0; rho < 4; ++rho)
#pragma unroll
                    for (int i = 0; i < 4; ++i) wst[(16 * rho + 4 * g + i) * 136 + jj] = (bf16)f2bf(-acc[rho][i]);
            }
        }
    }
    GL_BAR();
    {
        const LAS bf16* wst = (const LAS bf16*)(lds + GL_SOL + 17408 + 9216);
        bf16* WN = (bf16*)(ws + WS_WN) + (size_t)item * 8192;
#pragma unroll
        for (int r = 0; r < 2; ++r) {
            const int id = tid + 512 * r, c = id >> 4, gam = id & 15, s32 = gam >> 2, g = gam & 3;
            const v2u lo = *(const LAS v2u*)(wst + c * 136 + 32 * s32 + 4 * g), hi = *(const LAS v2u*)(wst + c * 136 + 32 * s32 + 16 + 4 * g);
            v4u o; o.x = lo.x; o.y = lo.y; o.z = hi.x; o.w = hi.y;
            st16_wt(WN + c * 128 + 8 * gam, o);
        }
    }
    asm volatile("s_waitcnt vmcnt(0)" ::: "memory");
    GL_BAR();
    if (tid == 0) { unsigned fb = __builtin_bit_cast(unsigned, sek[64]); if (fb == 0u) fb = 1u;
        __hip_atomic_store((unsigned*)(ws + WS_CTL) + CW_GFLAG + item, fb, __ATOMIC_RELAXED, __HIP_MEMORY_SCOPE_AGENT); }
    GL_BAR();
}

constexpr int LL_XCB = 68608;
static_assert(LL_XCB + 64 * 1040 <= MISC_OFF, "lru_local LDS map");
__device__ __forceinline__ float expm1_small(float x) {
    const float p = x * (1.0f + x * (0.5f + x * (0.16666667f + x * (0.041666668f + x * 0.008333334f))));
    return (x > -0.25f) ? p : (__expf(x) - 1.0f);
}
__device__ __forceinline__ void lru_local_item(const Params& P, LAS unsigned char* lds, int lt, int tid, int lane, int wave) {
    unsigned char* ws = P.ws;
    asm volatile("" : "+v"(tid));
    const int b = lt >> 7, n = lt & 127, t0 = b * SEQ + n * 64;
    LAS bf16* rawx = (LAS bf16*)lds;
    LAS bf16* xcb = (LAS bf16*)(lds + LL_XCB);
    const bf16* XR = (const bf16*)(ws + WS_XR);
    {
        v4u pr[9];
#pragma unroll
        for (int r = 0; r < 9; ++r) { const int id = tid + 512 * r, row = id >> 6, ck = id & 63, s = n * 64 + row - 3;
            pr[r] = (v4u){0u, 0u, 0u, 0u};
            if (id < 67 * 64 && s >= 0) pr[r] = *(const v4u*)(XR + (size_t)(b * SEQ + s) * 512 + ck * 8); }
#pragma unroll
        for (int r = 0; r < 9; ++r) { const int id = tid + 512 * r; if (id < 67 * 64) *(LAS v4u*)(rawx + id * 8) = pr[r]; }
    }
    GL_BAR();
    {
        const int chg = tid & 63, tseg = tid >> 6, ch0 = chg * 8;
        float w[4][8], cb[8];
#pragma unroll
        for (int j = 0; j < 4; ++j) { const f32x4 a = *(const f32x4*)(P.lru_conv_w + j * 512 + ch0), c = *(const f32x4*)(P.lru_conv_w + j * 512 + ch0 + 4);
            w[j][0] = a.x; w[j][1] = a.y; w[j][2] = a.z; w[j][3] = a.w; w[j][4] = c.x; w[j][5] = c.y; w[j][6] = c.z; w[j][7] = c.w; }
        { const f32x4 a = *(const f32x4*)(P.lru_conv_b + ch0), c = *(const f32x4*)(P.lru_conv_b + ch0 + 4);
          cb[0] = a.x; cb[1] = a.y; cb[2] = a.z; cb[3] = a.w; cb[4] = c.x; cb[5] = c.y; cb[6] = c.z; cb[7] = c.w; }
        v4u xr[11];
#pragma unroll
        for (int r = 0; r < 11; ++r) xr[r] = *(const LAS v4u*)(rawx + (tseg * 8 + r) * 512 + ch0);
#pragma unroll
        for (int tk = 0; tk < 8; ++tk) {
            float y[8];
#pragma unroll
            for (int e = 0; e < 8; ++e) y[e] = cb[e];
#pragma unroll
            for (int j = 0; j < 4; ++j) { const v4u x = xr[tk + j];
                y[0] += w[j][0] * bflo(x.x); y[1] += w[j][1] * bfhi(x.x); y[2] += w[j][2] * bflo(x.y); y[3] += w[j][3] * bfhi(x.y);
                y[4] += w[j][4] * bflo(x.z); y[5] += w[j][5] * bfhi(x.z); y[6] += w[j][6] * bflo(x.w); y[7] += w[j][7] * bfhi(x.w); }
            v4u o; o.x = pk2(y[0], y[1]); o.y = pk2(y[2], y[3]); o.z = pk2(y[4], y[5]); o.w = pk2(y[6], y[7]);
            *(LAS v4u*)(xcb + (tseg * 8 + tk) * 520 + ch0) = o;
        }
    }
    GL_BAR();
    {
        const int g = wave, col = lane & 15, g4 = lane >> 4;
        LAS bf16* AM = (LAS bf16*)(lds + wave * 8192); LAS bf16* BT = AM + 2048;
        const bf16* WT = (const bf16*)(ws + WS_LRUWT) + (size_t)g * 8192;
        bf16x8 Bw[2][4][2];
#pragma unroll
        for (int m = 0; m < 2; ++m)
#pragma unroll
            for (int jt = 0; jt < 4; ++jt)
#pragma unroll
                for (int s2 = 0; s2 < 2; ++s2) Bw[m][jt][s2] = *(const bf16x8*)(WT + m * 4096 + (16 * jt + col) * 64 + 32 * s2 + 8 * g4);
        float cba[4], cbx[4], csp[4];
#pragma unroll
        for (int jt = 0; jt < 4; ++jt) { const int ch = g * 64 + 16 * jt + col; cba[jt] = P.lru_ba[ch]; cbx[jt] = P.lru_bx[ch]; csp[jt] = softplusf_(-P.lru_lambda[ch]); }
        bf16* HLOC = (bf16*)(ws + WS_HLOC); bf16* PCUM = (bf16*)(ws + WS_PCUM);
        const int chs = g * 64 + lane;
        float hst = 0.f, pc = 1.f;
#pragma unroll 1
        for (int half = 0; half < 2; ++half) {
            bf16x8 Af[2][2];
#pragma unroll
            for (int rho = 0; rho < 2; ++rho)
#pragma unroll
                for (int s2 = 0; s2 < 2; ++s2) Af[rho][s2] = *(const LAS bf16x8*)(xcb + (32 * half + 16 * rho + col) * 520 + g * 64 + 32 * s2 + 8 * g4);
#pragma unroll
            for (int jt = 0; jt < 4; ++jt) {
#pragma unroll
                for (int rho = 0; rho < 2; ++rho) {
                    f32x4 ra = (f32x4){0.f, 0.f, 0.f, 0.f}, rx = ra;
#pragma unroll
                    for (int s2 = 0; s2 < 2; ++s2) { ra = __builtin_amdgcn_mfma_f32_16x16x32_bf16(Af[rho][s2], Bw[0][jt][s2], ra, 0, 0, 0); rx = __builtin_amdgcn_mfma_f32_16x16x32_bf16(Af[rho][s2], Bw[1][jt][s2], rx, 0, 0, 0); }
#pragma unroll
                    for (int i = 0; i < 4; ++i) {
                        const int tokl = 16 * rho + 4 * g4 + i, chl = 16 * jt + col;
                        const float r = sigmoidf_(ra[i] + cba[jt]), ig = sigmoidf_(rx[i] + cbx[jt]);
                        const float log_a = -8.0f * r * csp[jt];
                        const float am = -expm1_small(log_a), a = 1.0f - am;
                        const float xo = bf1(xcb[(32 * half + tokl) * 520 + g * 64 + chl]);
                        const float bt = __builtin_amdgcn_sqrtf(fmaxf(am * (1.0f + a), 0.f)) * (ig * xo);
                        AM[tokl * 64 + chl] = (bf16)f2bf(am); BT[tokl * 64 + chl] = (bf16)f2bf(bt);
                    }
                }
            }
            LDS_WAIT(); asm volatile("" ::: "memory");
#pragma unroll 8
            for (int tk = 0; tk < 32; ++tk) {
                const float am = bf1(AM[tk * 64 + lane]), bt = bf1(BT[tk * 64 + lane]);
                hst = (hst - am * hst) + bt; pc = pc - am * pc;
                const size_t o = (size_t)(t0 + 32 * half + tk) * 512 + chs;
                HLOC[o] = (bf16)f2bf(hst); PCUM[o] = (bf16)f2bf(pc);
            }
            LDS_WAIT(); asm volatile("" ::: "memory");
        }
        ((float*)(ws + WS_HEND))[(size_t)lt * 512 + chs] = hst; ((float*)(ws + WS_PEND))[(size_t)lt * 512 + chs] = pc;
    }
    GL_BAR();
}

constexpr int SC_WN = 0, SC_QD = 64 * 272, SC_KD = 2 * 64 * 272, SC_ATT = 2 * 64 * 272 + 128 * 144, SC_BUF = 2 * 64 * 272 + 128 * 144 + 64 * 144;
constexpr int SC_SSQ = 2 * SC_BUF;
__device__ __forceinline__ int sc_lds_off(int id) {
    if (id < 1024) return SC_WN + (id >> 4) * 272 + (id & 15) * 16;
    if (id < 2048) { const int q = id - 1024; return SC_QD + (q >> 4) * 272 + (q & 15) * 16; }
    if (id < 3072) { const int q = id - 2048; return SC_KD + (q >> 3) * 144 + (q & 7) * 16; }
    const int q = id - 3072; return SC_ATT + (q >> 3) * 144 + (q & 7) * 16;
}
__device__ __forceinline__ const v4u* sc_src(const unsigned char* ws, int item, int id) {
    if (id < 1024) return (const v4u*)(ws + WS_WN + (size_t)item * 16384) + id;
    if (id < 2048) return (const v4u*)(ws + WS_QD + (size_t)item * 16384) + (id - 1024);
    if (id < 3072) return (const v4u*)(ws + WS_KD + (size_t)item * 16384) + (id - 2048);
    return (const v4u*)(ws + WS_ATT + (size_t)item * 8192) + (id - 3072);
}
__device__ __forceinline__ bf16x8 pack_b(const f32x4 a, const f32x4 b) {
    v4u r; r.x = pk2(a.x, a.y); r.y = pk2(a.z, a.w); r.z = pk2(b.x, b.y); r.w = pk2(b.z, b.w);
    return __builtin_bit_cast(bf16x8, r);
}
#define SC_BAR() do { asm volatile("s_waitcnt lgkmcnt(0)" ::: "memory"); __builtin_amdgcn_s_barrier(); asm volatile("" ::: "memory"); } while (0)
#define SC_GLD(dst, ptr) asm volatile("global_load_dwordx4 %0, %1, off" : "=v"(dst) : "v"(ptr) : "memory")
#define PIN8(a) asm volatile("" : "+v"(a[0]), "+v"(a[1]), "+v"(a[2]), "+v"(a[3]), "+v"(a[4]), "+v"(a[5]), "+v"(a[6]), "+v"(a[7]))
#define PIN16(a) asm volatile("" : "+v"(a[0]), "+v"(a[1]), "+v"(a[2]), "+v"(a[3]), "+v"(a[4]), "+v"(a[5]), "+v"(a[6]), "+v"(a[7]), "+v"(a[8]), "+v"(a[9]), "+v"(a[10]), "+v"(a[11]), "+v"(a[12]), "+v"(a[13]), "+v"(a[14]), "+v"(a[15]))
constexpr int SCAN_NWC = 2, SCAN_PARTS = 4, SCAN_WGS = 8 * SCAN_PARTS;
constexpr int SC_UFS = 2 * SC_BUF;
constexpr int SC_DECS = SC_UFS + 2 * SCAN_NWC * 2048;
constexpr int SC_OT = SC_DECS + 512;
constexpr int SC_RDY = SC_OT + 2 * 64 * 36 * 4;
constexpr int SC_END = SC_RDY + 64;
static_assert(SC_END <= MISC_OFF, "scan LDS");
#ifndef SCAN_REPS
#define SCAN_REPS 1
#endif
#ifndef SCAN_EXP
#define SCAN_EXP 0
#endif
__device__ __forceinline__ int sc3_lds_off(int id) {
    if (id < 3584) return sc_lds_off(id);
    return SC_UFS + (id - 3584) * 16;
}
__device__ __forceinline__ const v4u* sc3_src(const unsigned char* ws, int item, int id, int part) {
    if (id < 3584) return sc_src(ws, item, id);
    return (const v4u*)(ws + WS_UF + (size_t)item * 16384 + (size_t)(part * SCAN_NWC) * 2048) + (id - 3584);
}
__device__ __forceinline__ void gdn_scan(const Params& P, LAS unsigned char* lds, int sb, int tid, int lane, int wave) {
    const unsigned char* ws = P.ws;
    constexpr int NCH = 128 * SCAN_REPS, NPC = 15;
    const int bh = sb & 7, part = sb >> 3;
    const int b = bh >> 2, h = bh & 3, col = lane & 15, g = lane >> 4;
    const int item0 = bh * 128;
    if (tid == 0) *(volatile LAS unsigned*)(lds + SC_RDY) = 0u;
    SC_BAR();
    if (wave >= 4) {
        constexpr int NP = 15, DEP = 3;
        const int lt = tid - 256;
        const unsigned voff = (unsigned)lt * 16u;
        const int lA = (lt >> 4) * 272 + (lt & 15) * 16, lB = (lt >> 3) * 144 + (lt & 7) * 16, lU = SC_UFS + lt * 16;
        v4u rs[DEP][NP];
#define SC_ISSUE(set, itm) do { const unsigned char* gq_ = ws + (size_t)(itm) * 16384; const unsigned char* ga_ = ws + WS_ATT + (size_t)(itm) * 8192; \
            asm volatile("s_nop 4\n\tglobal_load_dwordx4 %0, %8, %9 sc0 sc1\n\tglobal_load_dwordx4 %1, %8, %10 sc0 sc1\n\tglobal_load_dwordx4 %2, %8, %11 sc0 sc1\n\tglobal_load_dwordx4 %3, %8, %12 sc0 sc1\n\t" \
                         "global_load_dwordx4 %4, %8, %13 sc0 sc1\n\tglobal_load_dwordx4 %5, %8, %14 sc0 sc1\n\tglobal_load_dwordx4 %6, %8, %15 sc0 sc1\n\tglobal_load_dwordx4 %7, %8, %16 sc0 sc1" \
                : "=&v"(rs[set][0]), "=&v"(rs[set][1]), "=&v"(rs[set][2]), "=&v"(rs[set][3]), "=&v"(rs[set][4]), "=&v"(rs[set][5]), "=&v"(rs[set][6]), "=&v"(rs[set][7]) \
                : "v"(voff), "s"(gq_ + WS_WN), "s"(gq_ + WS_WN + 4096), "s"(gq_ + WS_WN + 8192), "s"(gq_ + WS_WN + 12288), \
                  "s"(gq_ + WS_QD), "s"(gq_ + WS_QD + 4096), "s"(gq_ + WS_QD + 8192), "s"(gq_ + WS_QD + 12288) : "memory"); \
            asm volatile("s_nop 4\n\tglobal_load_dwordx4 %0, %7, %8 sc0 sc1\n\tglobal_load_dwordx4 %1, %7, %9 sc0 sc1\n\tglobal_load_dwordx4 %2, %7, %10 sc0 sc1\n\tglobal_load_dwordx4 %3, %7, %11 sc0 sc1\n\t" \
                         "global_load_dwordx4 %4, %7, %12 sc0 sc1\n\tglobal_load_dwordx4 %5, %7, %13 sc0 sc1\n\tglobal_load_dwordx4 %6, %7, %14 sc0 sc1" \
                : "=&v"(rs[set][8]), "=&v"(rs[set][9]), "=&v"(rs[set][10]), "=&v"(rs[set][11]), "=&v"(rs[set][12]), "=&v"(rs[set][13]), "=&v"(rs[set][14]) \
                : "v"(voff), "s"(gq_ + WS_KD), "s"(gq_ + WS_KD + 4096), "s"(gq_ + WS_KD + 8192), "s"(gq_ + WS_KD + 12288), \
                  "s"(ga_), "s"(ga_ + 4096), "s"(gq_ + WS_UF + (size_t)(part * SCAN_NWC) * 2048) : "memory"); } while (0)
#define SC_WAITSET(set, cnt) asm volatile("s_waitcnt " cnt : "+v"(rs[set][0]), "+v"(rs[set][1]), "+v"(rs[set][2]), "+v"(rs[set][3]), "+v"(rs[set][4]), "+v"(rs[set][5]), "+v"(rs[set][6]), "+v"(rs[set][7]), \
            "+v"(rs[set][8]), "+v"(rs[set][9]), "+v"(rs[set][10]), "+v"(rs[set][11]), "+v"(rs[set][12]), "+v"(rs[set][13]), "+v"(rs[set][14]) :: "memory")
#define SC_WRITE(set, par) do { LAS unsigned char* wb_ = lds + (par) * SC_BUF; \
            _Pragma("unroll") for (int r = 0; r < 4; ++r) { *(LAS v4u*)(wb_ + SC_WN + lA + r * (16 * 272)) = rs[set][r]; *(LAS v4u*)(wb_ + SC_QD + lA + r * (16 * 272)) = rs[set][4 + r]; \
                                                          *(LAS v4u*)(wb_ + SC_KD + lB + r * (32 * 144)) = rs[set][8 + r]; } \
            *(LAS v4u*)(wb_ + SC_ATT + lB) = rs[set][12]; *(LAS v4u*)(wb_ + SC_ATT + lB + 32 * 144) = rs[set][13]; \
            *(LAS v4u*)(lds + lU + (par) * (SCAN_NWC * 2048)) = rs[set][14]; } while (0)
#define SC_NEED(c) do { unsigned sp_ = 0; while (*(volatile LAS unsigned*)(lds + SC_RDY) <= (unsigned)(c) && ++sp_ < (1u << 24)) __builtin_amdgcn_s_sleep(2); } while (0)
        SC_NEED(0); SC_ISSUE(0, item0);
        SC_WAITSET(0, "vmcnt(0)"); SC_WRITE(0, 0); SC_WAITSET(0, "lgkmcnt(0)");
        SC_NEED(3); SC_ISSUE(1, item0 + 1); SC_ISSUE(2, item0 + 2); SC_ISSUE(0, item0 + 3);
        SC_BAR();
        int n2 = 0;
#define SC_INTERVAL(set) do { SC_WAITSET(set, "vmcnt(30)"); SC_WRITE(set, (n2 + 1) & 1); SC_WAITSET(set, "lgkmcnt(0)"); if (n2 + 1 + DEP < 128) SC_NEED(n2 + 1 + DEP); SC_ISSUE(set, item0 + ((n2 + 1 + DEP) & 127)); SC_BAR(); ++n2; } while (0)
#pragma unroll 1
        for (int it = 0; it < NCH / 3; ++it) { SC_INTERVAL(1); SC_INTERVAL(2); SC_INTERVAL(0); }
        if (NCH % 3 >= 1) SC_INTERVAL(1);
        if (NCH % 3 >= 2) SC_INTERVAL(2);
        SC_WAITSET(0, "vmcnt(0)"); SC_WAITSET(1, "vmcnt(0)"); SC_WAITSET(2, "vmcnt(0)");
#undef SC_INTERVAL
#undef SC_NEED
#undef SC_WRITE
#undef SC_WAITSET
#undef SC_ISSUE
        return;
    }
    if (wave == 3) {
        const unsigned* flags = (const unsigned*)(ws + WS_CTL) + CW_GFLAG + item0;
        unsigned rdy = 0;
#define SC_POLLSTEP() do { if (rdy < 128u) { const unsigned idx_ = rdy + (unsigned)lane; \
            const unsigned fv_ = (idx_ < 128u) ? __hip_atomic_load(flags + idx_, __ATOMIC_RELAXED, __HIP_MEMORY_SCOPE_AGENT) : 0u; \
            const unsigned long long m_ = __ballot(fv_ != 0u); const unsigned nrun_ = (m_ == ~0ull) ? 64u : (unsigned)__builtin_ctzll(~m_);     \
            if ((unsigned)lane < nrun_) ((LAS float*)(lds + SC_DECS))[idx_] = __builtin_bit_cast(float, fv_); \
            rdy += nrun_; LDS_WAIT(); if (lane == 0) *(volatile LAS unsigned*)(lds + SC_RDY) = rdy; } } while (0)
        { unsigned sp = 0; while (rdy < 4u && ++sp < (1u << 22)) { SC_POLLSTEP(); if (rdy < 4u) __builtin_amdgcn_s_sleep(16); } }
        SC_BAR();
#pragma unroll 1
        for (int n2 = 0; n2 < NCH; ++n2) {
            { const unsigned need = (unsigned)(n2 + 1 + 3) < 128u ? (unsigned)(n2 + 1 + 3) : 127u; unsigned sp = 0;
              while (rdy <= need && rdy < 128u && ++sp < (1u << 22)) { SC_POLLSTEP(); if (rdy <= need) __builtin_amdgcn_s_sleep(8); } }
            if (rdy < 128u && rdy < (unsigned)(n2 & 127) + 16u) SC_POLLSTEP();
            SC_BAR();
        }
#undef SC_POLLSTEP
        return;
    }
    if (wave == 2) {
        const int row = lane;
        bf16* Y = (bf16*)((unsigned char*)P.out + OUT_Y);
        float* SSQG = P.out;
        SC_BAR();
#pragma unroll 1
        for (int n2 = 0; n2 <= NCH; ++n2) {
            if (n2 > 0) {
                const int n = (n2 - 1) & 127, t = b * SEQ + n * 64 + row;
                const LAS float* src = (const LAS float*)(lds + SC_OT + ((n2 - 1) & 1) * (64 * 36 * 4)) + row * 36;
                f32x4 a[8]; float s2 = 0.f;
#pragma unroll
                for (int q = 0; q < 8; ++q) { a[q] = *(const LAS f32x4*)(src + 4 * q); s2 += (a[q].x * a[q].x + a[q].y * a[q].y) + (a[q].z * a[q].z + a[q].w * a[q].w); }
                SSQG[(size_t)t * 32 + h * 8 + part] = s2;
                v4u* d = (v4u*)(Y + (size_t)t * 1024 + h * 128 + 32 * part);
#pragma unroll
                for (int q = 0; q < 4; ++q) { v4u o; o.x = pk2(a[2 * q].x, a[2 * q].y); o.y = pk2(a[2 * q].z, a[2 * q].w); o.z = pk2(a[2 * q + 1].x, a[2 * q + 1].y); o.w = pk2(a[2 * q + 1].z, a[2 * q + 1].w); d[q] = o; }
            }
            if (n2 < NCH) SC_BAR();
        }
        return;
    }
    f32x4 S[8];
#pragma unroll
    for (int i = 0; i < 8; ++i) S[i] = (f32x4){0.f, 0.f, 0.f, 0.f};
    SC_BAR();
#pragma unroll 1
    for (int n2 = 0; n2 < NCH; ++n2) {
        if (SCAN_REPS > 1 && (n2 & 127) == 0) {
#pragma unroll
            for (int i = 0; i < 8; ++i) S[i] = (f32x4){0.f, 0.f, 0.f, 0.f};
        }
        if (SCAN_EXP == 2 && n2 < 128) { SC_BAR(); continue; }
        const int par = n2 & 1;
        LAS unsigned char* buf = lds + par * SC_BUF;
        bf16x8 fA[16], fB[16], fC[16], fD[8];
#pragma unroll
        for (int rho = 0; rho < 4; ++rho)
#pragma unroll
            for (int s = 0; s < 4; ++s) fA[rho * 4 + s] = *(const LAS bf16x8*)(buf + SC_WN + (16 * rho + col) * 272 + (32 * s + 8 * g) * 2);
#pragma unroll
        for (int rho = 0; rho < 4; ++rho)
#pragma unroll
            for (int s = 0; s < 4; ++s) fB[rho * 4 + s] = *(const LAS bf16x8*)(buf + SC_QD + (16 * rho + col) * 272 + (32 * s + 8 * g) * 2);
        const LAS v4u* ufp = (const LAS v4u*)(lds + SC_UFS + par * (SCAN_NWC * 2048) + wave * 2048 + lane * 32);
        const v4u uf0 = ufp[0], uf1 = ufp[1];
        const float dec = ((const LAS float*)(lds + SC_DECS))[n2 & 127];
        bf16x8 Bs[4];
#pragma unroll
        for (int s = 0; s < 4; ++s) Bs[s] = pack_b(S[2 * s], S[2 * s + 1]);
        f32x4 Vn[4], Oc[4];
        Vn[0] = (f32x4){bflo(uf0.x), bfhi(uf0.x), bflo(uf0.y), bfhi(uf0.y)}; Vn[1] = (f32x4){bflo(uf0.z), bfhi(uf0.z), bflo(uf0.w), bfhi(uf0.w)};
        Vn[2] = (f32x4){bflo(uf1.x), bfhi(uf1.x), bflo(uf1.y), bfhi(uf1.y)}; Vn[3] = (f32x4){bflo(uf1.z), bfhi(uf1.z), bflo(uf1.w), bfhi(uf1.w)};
        __builtin_amdgcn_sched_barrier(0);
        PIN16(fA);
#pragma unroll
        for (int s = 0; s < 4; ++s)
#pragma unroll
            for (int rho = 0; rho < 4; ++rho) Vn[rho] = __builtin_amdgcn_mfma_f32_16x16x32_bf16(fA[rho * 4 + s], Bs[s], Vn[rho], 0, 0, 0);
        __builtin_amdgcn_sched_barrier(0);
#pragma unroll
        for (int tau = 0; tau < 8; ++tau)
#pragma unroll
            for (int s = 0; s < 2; ++s) fC[tau * 2 + s] = *(const LAS bf16x8*)(buf + SC_KD + (16 * tau + col) * 144 + (32 * s + 8 * g) * 2);
        __builtin_amdgcn_sched_barrier(0);
        PIN16(fB);
#pragma unroll
        for (int rho = 0; rho < 4; ++rho) Oc[rho] = (f32x4){0.f, 0.f, 0.f, 0.f};
#pragma unroll
        for (int s = 0; s < 4; ++s)
#pragma unroll
            for (int rho = 0; rho < 4; ++rho) Oc[rho] = __builtin_amdgcn_mfma_f32_16x16x32_bf16(fB[rho * 4 + s], Bs[s], Oc[rho], 0, 0, 0);
        __builtin_amdgcn_sched_barrier(0);
#pragma unroll
        for (int rho = 0; rho < 4; ++rho)
#pragma unroll
            for (int s = 0; s < 2; ++s) fD[rho * 2 + s] = *(const LAS bf16x8*)(buf + SC_ATT + (16 * rho + col) * 144 + (32 * s + 8 * g) * 2);
        bf16x8 Bv[2];
        Bv[0] = pack_b(Vn[0], Vn[1]); Bv[1] = pack_b(Vn[2], Vn[3]);
#pragma unroll
        for (int tau = 0; tau < 8; ++tau) S[tau] = S[tau] * dec;
        __builtin_amdgcn_sched_barrier(0);
        PIN16(fC);
#pragma unroll
        for (int s = 0; s < 2; ++s)
#pragma unroll
            for (int tau = 0; tau < 8; ++tau) S[tau] = __builtin_amdgcn_mfma_f32_16x16x32_bf16(fC[tau * 2 + s], Bv[s], S[tau], 0, 0, 0);
        __builtin_amdgcn_sched_barrier(0);
        PIN8(fD);
#pragma unroll
        for (int s = 0; s < 2; ++s)
#pragma unroll
            for (int rho = 0; rho < 4; ++rho) Oc[rho] = __builtin_amdgcn_mfma_f32_16x16x32_bf16(fD[rho * 2 + s], Bv[s], Oc[rho], 0, 0, 0);
        LAS float* ot = (LAS float*)(lds + SC_OT + par * (64 * 36 * 4)) + 16 * wave + col;
#pragma unroll
        for (int rho = 0; rho < 4; ++rho)
#pragma unroll
            for (int i = 0; i < 4; ++i) ot[(16 * rho + 4 * g + i) * 36] = Oc[rho][i];
        SC_BAR();
    }
}

__device__ __forceinline__ void lru_carry(const Params& P, int gwv, int lane) {
    unsigned char* ws = P.ws;
    const int b = gwv >> 3, g = gwv & 7, ch = g * 64 + lane;
    const float* HEND = (const float*)(ws + WS_HEND); const float* PEND = (const float*)(ws + WS_PEND); float* HIN = (float*)(ws + WS_HIN);
    float hin = 0.f;
#pragma unroll 1
    for (int n0 = 0; n0 < 128; n0 += 32) {
        float he[32], pe[32];
#pragma unroll
        for (int i = 0; i < 32; ++i) { const size_t o = (size_t)(b * 128 + n0 + i) * 512 + ch; he[i] = HEND[o]; pe[i] = PEND[o]; }
#pragma unroll
        for (int i = 0; i < 32; ++i) { HIN[(size_t)(b * 128 + n0 + i) * 512 + ch] = hin; hin = he[i] + pe[i] * hin; }
    }
}

__device__ __forceinline__ void cvt_table(const float* src, bf16* dst, size_t n8, size_t wi, size_t nw) {
    for (size_t i = wi; i < n8; i += nw) {
        const f32x4 a = ((const f32x4*)src)[2 * i], c = ((const f32x4*)src)[2 * i + 1];
        v4u o; o.x = pk2(a.x, a.y); o.y = pk2(a.z, a.w); o.z = pk2(c.x, c.y); o.w = pk2(c.z, c.w);
        ((v4u*)dst)[i] = o;
    }
}

__device__ __forceinline__ void lru_combine(const Params& P, size_t wi, size_t nw) {
    unsigned char* ws = P.ws;
    const v4u* HLOC = (const v4u*)(ws + WS_HLOC); const v4u* PCUM = (const v4u*)(ws + WS_PCUM); const v4u* GATE = (const v4u*)(ws + WS_GATE);
    const float* HIN = (const float*)(ws + WS_HIN); bf16* Y = (bf16*)((unsigned char*)P.out + OUT_Y);
    for (size_t i = wi; i < (size_t)T * 64; i += nw) {
        const size_t t = i >> 6; const int ch0 = (int)(i & 63) * 8;
        const v4u hl = HLOC[i], pc = PCUM[i], gt = GATE[i];
        const f32x4 h0 = *(const f32x4*)(HIN + (t >> 6) * 512 + ch0), h1 = *(const f32x4*)(HIN + (t >> 6) * 512 + ch0 + 4);
        float y[8];
        y[0] = (bflo(hl.x) + bflo(pc.x) * h0.x) * gelu_tanh(bflo(gt.x)); y[1] = (bfhi(hl.x) + bfhi(pc.x) * h0.y) * gelu_tanh(bfhi(gt.x));
        y[2] = (bflo(hl.y) + bflo(pc.y) * h0.z) * gelu_tanh(bflo(gt.y)); y[3] = (bfhi(hl.y) + bfhi(pc.y) * h0.w) * gelu_tanh(bfhi(gt.y));
        y[4] = (bflo(hl.z) + bflo(pc.z) * h1.x) * gelu_tanh(bflo(gt.z)); y[5] = (bfhi(hl.z) + bfhi(pc.z) * h1.y) * gelu_tanh(bfhi(gt.z));
        y[6] = (bflo(hl.w) + bflo(pc.w) * h1.z) * gelu_tanh(bflo(gt.w)); y[7] = (bfhi(hl.w) + bfhi(pc.w) * h1.w) * gelu_tanh(bfhi(gt.w));
        v4u o; o.x = pk2(y[0], y[1]); o.y = pk2(y[2], y[3]); o.z = pk2(y[4], y[5]); o.w = pk2(y[6], y[7]);
        *(v4u*)(Y + t * 1024 + 512 + ch0) = o;
    }
}

__device__ __forceinline__ void gdn_gate_norm(const Params& P, size_t wi, size_t nw) {
    unsigned char* ws = P.ws;
    bf16* Y = (bf16*)((unsigned char*)P.out + OUT_Y); const v4u* Z = (const v4u*)(ws + WS_Z); const float* SSQG = P.out;
    for (size_t i = wi; i < (size_t)T * 64; i += nw) {
        const size_t t = i >> 6; const int c0 = (int)(i & 63) * 8, h = c0 >> 7;
        const f32x4 q0 = *(const f32x4*)(SSQG + t * 32 + h * 8);
        const float rstd = rsqrtf(((q0.x + q0.y) + (q0.z + q0.w)) * (1.0f / 128.0f) + 1e-6f);
        const v4u o = *(const v4u*)(Y + t * 1024 + c0), z = Z[i];
        const f32x4 w0 = *(const f32x4*)(P.gdn_norm_w + (c0 & 127)), w1 = *(const f32x4*)(P.gdn_norm_w + (c0 & 127) + 4);
        float y[8];
        y[0] = bflo(o.x) * rstd * w0.x * siluf_(bflo(z.x)); y[1] = bfhi(o.x) * rstd * w0.y * siluf_(bfhi(z.x));
        y[2] = bflo(o.y) * rstd * w0.z * siluf_(bflo(z.y)); y[3] = bfhi(o.y) * rstd * w0.w * siluf_(bfhi(z.y));
        y[4] = bflo(o.z) * rstd * w1.x * siluf_(bflo(z.z)); y[5] = bfhi(o.z) * rstd * w1.y * siluf_(bfhi(z.z));
        y[6] = bflo(o.w) * rstd * w1.z * siluf_(bflo(z.w)); y[7] = bfhi(o.w) * rstd * w1.w * siluf_(bfhi(z.w));
        v4u r; r.x = pk2(y[0], y[1]); r.y = pk2(y[2], y[3]); r.z = pk2(y[4], y[5]); r.w = pk2(y[6], y[7]);
        *(v4u*)(Y + t * 1024 + c0) = r;
    }
}

__device__ __forceinline__ void xattn_stage(LAS unsigned char* lds, const bf16* src, int tid) {
    v4u tmp[16];
    asm volatile("" : "+v"(tid));
    const unsigned voff = (unsigned)tid * 16u;
#pragma unroll
    for (int r = 0; r < 16; ++r) { const unsigned char* sb = (const unsigned char*)src + r * 8192;
        asm volatile("s_nop 4\n\tglobal_load_dwordx4 %0, %1, %2" : "=&v"(tmp[r]) : "v"(voff), "s"(sb) : "memory"); }
    asm volatile("s_waitcnt vmcnt(0)" : "+v"(tmp[0]), "+v"(tmp[1]), "+v"(tmp[2]), "+v"(tmp[3]), "+v"(tmp[4]), "+v"(tmp[5]), "+v"(tmp[6]), "+v"(tmp[7]),
                                        "+v"(tmp[8]), "+v"(tmp[9]), "+v"(tmp[10]), "+v"(tmp[11]), "+v"(tmp[12]), "+v"(tmp[13]), "+v"(tmp[14]), "+v"(tmp[15]) :: "memory");
#pragma unroll
    for (int r = 0; r < 16; ++r) { const int id = tid + 512 * r; *(LAS v4u*)(lds + (id >> 5) * 528 + (id & 31) * 16) = tmp[r]; }
}
#ifndef XA_NPS
#define XA_NPS 2
#endif
__device__ __forceinline__ void xattn_unit(const Params& P, LAS unsigned char* lds, int unit, int tid, int lane, int wave) {
    const unsigned char* ws = P.ws;
    const int h = unit & 3, qb = (unit >> 2) & 63, b = unit >> 8; int col = lane & 15, g = lane >> 4;
    const int tw = b * SEQ + qb * 128 + 16 * wave;
    const bf16* Kb = (const bf16*)(ws + WS_KB) + (size_t)((b * 4 + h) * 256) * 256;
    const bf16* Vt = (const bf16*)(ws + WS_VTP) + (size_t)((b * 4 + h) * 256) * 256;
    xattn_stage(lds, Kb, tid);
    __syncthreads();
    const LAS unsigned char* arow = lds + col * 528 + g * 16;
    bf16x8 Bp[XA_NPS][8]; float inv[XA_NPS];
#pragma unroll
    for (int ps = 0; ps < XA_NPS; ++ps) {
        __builtin_amdgcn_sched_barrier(0); asm volatile("" : "+v"(col), "+v"(g) :: "memory");
        const bf16* Q = (const bf16*)(ws + WS_Q) + (size_t)(tw + 128 * ps + col) * 1024 + h * 256 + 8 * g;
        bf16x8 Bq[8];
#pragma unroll
        for (int s = 0; s < 8; ++s) Bq[s] = *(const bf16x8*)(Q + 32 * s);
        f32x4 St[16];
        bf16x8 fr[2][8];
#pragma unroll
        for (int s = 0; s < 8; ++s) fr[0][s] = *(const LAS bf16x8*)(arow + 64 * s);
#pragma unroll
        for (int kap = 0; kap < 16; ++kap) {
            if (kap + 1 < 16) {
#pragma unroll
                for (int s = 0; s < 8; ++s) fr[(kap + 1) & 1][s] = *(const LAS bf16x8*)(arow + (16 * (kap + 1)) * 528 + 64 * s);
            }
            __builtin_amdgcn_sched_barrier(0);
            PIN8(fr[kap & 1]);
            f32x4 acc = (f32x4){0.f, 0.f, 0.f, 0.f};
#pragma unroll
            for (int s = 0; s < 8; ++s) acc = __builtin_amdgcn_mfma_f32_16x16x32_bf16(fr[kap & 1][s], Bq[s], acc, 0, 0, 0);
            St[kap] = acc;
            __builtin_amdgcn_sched_barrier(0);
        }
        float mx = -3.0e38f;
#pragma unroll
        for (int kap = 0; kap < 16; ++kap) mx = fmaxf(fmaxf(fmaxf(St[kap].x, St[kap].y), fmaxf(St[kap].z, St[kap].w)), mx);
        mx = fmaxf(mx, __shfl_xor(mx, 16)); mx = fmaxf(mx, __shfl_xor(mx, 32));
        float l = 0.f;
#pragma unroll
        for (int kap = 0; kap < 16; ++kap) { St[kap].x = __expf(St[kap].x - mx); St[kap].y = __expf(St[kap].y - mx); St[kap].z = __expf(St[kap].z - mx); St[kap].w = __expf(St[kap].w - mx);
            l += (St[kap].x + St[kap].y) + (St[kap].z + St[kap].w); }
        l += __shfl_xor(l, 16); l += __shfl_xor(l, 32);
        inv[ps] = 1.0f / l;
#pragma unroll
        for (int s = 0; s < 8; ++s) Bp[ps][s] = pack_b(St[2 * s], St[2 * s + 1]);
    }
    __syncthreads();
    xattn_stage(lds, Vt, tid);
    __syncthreads();
#pragma unroll
    for (int ps = 0; ps < XA_NPS; ++ps) {
        __builtin_amdgcn_sched_barrier(0); asm volatile("" : "+v"(col), "+v"(g) :: "memory");
        bf16* AO = (bf16*)(P.ws + WS_AO) + (size_t)(tw + 128 * ps + col) * 1024 + h * 256 + 4 * g;
        bf16x8 fr[2][8];
#pragma unroll
        for (int s = 0; s < 8; ++s) fr[0][s] = *(const LAS bf16x8*)(arow + 64 * s);
#pragma unroll
        for (int del = 0; del < 16; ++del) {
            if (del + 1 < 16) {
#pragma unroll
                for (int s = 0; s < 8; ++s) fr[(del + 1) & 1][s] = *(const LAS bf16x8*)(arow + (16 * (del + 1)) * 528 + 64 * s);
            }
            __builtin_amdgcn_sched_barrier(0);
            PIN8(fr[del & 1]);
            f32x4 acc = (f32x4){0.f, 0.f, 0.f, 0.f};
#pragma unroll
            for (int s = 0; s < 8; ++s) acc = __builtin_amdgcn_mfma_f32_16x16x32_bf16(fr[del & 1][s], Bp[ps][s], acc, 0, 0, 0);
            v2u o; o.x = pk2(acc.x * inv[ps], acc.y * inv[ps]); o.y = pk2(acc.z * inv[ps], acc.w * inv[ps]);
            *(v2u*)(AO + 16 * del) = o;
            __builtin_amdgcn_sched_barrier(0);
        }
    }
    __syncthreads();
}

__device__ __forceinline__ unsigned key_enc(float f) { const unsigned u = __builtin_bit_cast(unsigned, f); return (u & 0x80000000u) ? ~u : (u | 0x80000000u); }
__device__ __forceinline__ float key_dec(unsigned k) { const unsigned u = (k & 0x80000000u) ? (k & 0x7fffffffu) : ~k; return __builtin_bit_cast(float, u); }
#define TK_CAS(a, b) do { const unsigned hi_ = max(a, b), lo_ = min(a, b); a = hi_; b = lo_; } while (0)
__device__ __forceinline__ void tk_merge16(unsigned (&a)[16]) {
#pragma unroll
    for (int j = 8; j > 0; j >>= 1)
#pragma unroll
        for (int i = 0; i < 16; ++i) { const int l = i ^ j; if (l > i) TK_CAS(a[i], a[l]); }
}
__device__ __forceinline__ void tk_sort16(unsigned (&a)[16]) {
#pragma unroll
    for (int k = 2; k <= 16; k <<= 1)
#pragma unroll
        for (int j = k >> 1; j > 0; j >>= 1)
#pragma unroll
            for (int i = 0; i < 16; ++i) { const int l = i ^ j; if (l > i) { if ((i & k) == 0) TK_CAS(a[i], a[l]); else TK_CAS(a[l], a[i]); } }
}
__device__ __forceinline__ void tk_top16_merge(unsigned (&L)[16], const unsigned (&G)[16]) {
#pragma unroll
    for (int i = 0; i < 16; ++i) L[i] = max(L[i], G[15 - i]);
    tk_merge16(L);
}
__device__ __forceinline__ void tk_pair_merge(unsigned (&L)[16]) {
    unsigned Pp[16];
#pragma unroll
    for (int i = 0; i < 16; ++i) Pp[i] = (unsigned)__builtin_amdgcn_update_dpp(0, (int)L[i], 0xB1, 0xF, 0xF, true);
    tk_top16_merge(L, Pp);
}
__device__ __forceinline__ void peer_topk_rows(const Params& P, LAS unsigned char* lds, int rowbase, int tid) {
    const unsigned char* ws = P.ws;
    typedef _Float16 f16x8 __attribute__((ext_vector_type(8)));
    const int rl = tid >> 1, hf = tid & 1, grow = rowbase + rl, t = grow >> 3, h = grow & 7;
    const _Float16* SC = (const _Float16*)(ws + WS_PQ) + (size_t)t * 2048 + h * 256 + 64 * hf;
    f16x8 raw[2][8];
#pragma unroll
    for (int p = 0; p < 2; ++p)
#pragma unroll
        for (int q = 0; q < 8; ++q) raw[p][q] = *(const f16x8*)(SC + p * 128 + 8 * q);
    unsigned L1[16], L2[16];
#pragma unroll
    for (int p = 0; p < 2; ++p) {
        unsigned L[16];
#pragma unroll
        for (int grp = 0; grp < 4; ++grp) {
            unsigned G[16];
#pragma unroll
            for (int e = 0; e < 16; ++e) G[e] = (key_enc((float)raw[p][2 * grp + (e >> 3)][e & 7]) & ~127u) | (unsigned)(127 - (64 * hf + 16 * grp + e));
            tk_sort16(G);
            if (grp == 0) {
#pragma unroll
                for (int i = 0; i < 16; ++i) L[i] = G[i];
            } else tk_top16_merge(L, G);
        }
        tk_pair_merge(L);
#pragma unroll
        for (int i = 0; i < 16; ++i) { if (p == 0) L1[i] = L[i]; else L2[i] = L[i]; }
    }
    {
        float v1[16], v2[16];
        LAS int* il = (LAS int*)lds + rl * 33;
#pragma unroll
        for (int q = 0; q < 16; ++q) { v1[q] = key_dec((L1[q] & ~127u) | 64u); v2[q] = key_dec((L2[q] & ~127u) | 64u); }
        if (hf == 0) {
#pragma unroll
            for (int q = 0; q < 16; ++q) { il[q] = 127 - (int)(L1[q] & 127u); il[16 + q] = 127 - (int)(L2[q] & 127u); }
        }
        unsigned C[16], D[16];
        float w1[8];
        const unsigned hf16 = (unsigned)hf * 16u, evenmask = (unsigned)hf - 1u;
#pragma unroll
        for (int k = 0; k < 8; ++k) w1[k] = __builtin_bit_cast(float, (__builtin_bit_cast(unsigned, v1[2 * k]) & evenmask) | (__builtin_bit_cast(unsigned, v1[2 * k + 1]) & ~evenmask));
#define TK_SLOT(dst, k, bq, valid_odd) do { const unsigned pos_ = (unsigned)(16 * (2 * (k)) + (bq)) + hf16; unsigned kv_ = (key_enc(w1[k] + v2[bq]) & ~255u) | (255u - pos_); if (!(valid_odd)) kv_ &= evenmask; dst = kv_; } while (0)
        TK_SLOT(C[0], 0, 0, true);
        TK_SLOT(C[1], 0, 1, true);
        TK_SLOT(C[2], 0, 2, true);
        TK_SLOT(C[3], 0, 3, true);
        TK_SLOT(C[4], 0, 4, true);
        TK_SLOT(C[5], 0, 5, true);
        TK_SLOT(C[6], 0, 6, true);
        TK_SLOT(C[7], 0, 7, true);
        TK_SLOT(C[8], 0, 8, false);
        TK_SLOT(C[9], 0, 9, false);
        TK_SLOT(C[10], 0, 10, false);
        TK_SLOT(C[11], 0, 11, false);
        TK_SLOT(C[12], 0, 12, false);
        TK_SLOT(C[13], 0, 13, false);
        TK_SLOT(C[14], 0, 14, false);
        TK_SLOT(C[15], 0, 15, false);
        TK_SLOT(D[0], 1, 0, true);
        TK_SLOT(D[1], 1, 1, true);
        TK_SLOT(D[2], 1, 2, true);
        TK_SLOT(D[3], 1, 3, true);
        TK_SLOT(D[4], 1, 4, false);
        TK_SLOT(D[5], 2, 0, true);
        TK_SLOT(D[6], 2, 1, true);
        TK_SLOT(D[7], 2, 2, false);
        TK_SLOT(D[8], 3, 0, true);
        TK_SLOT(D[9], 3, 1, true);
        TK_SLOT(D[10], 4, 0, true);
        TK_SLOT(D[11], 5, 0, true);
        TK_SLOT(D[12], 6, 0, true);
        TK_SLOT(D[13], 7, 0, true);
        D[14] = 0u; D[15] = 0u;
#undef TK_SLOT
        tk_sort16(C); tk_sort16(D); tk_top16_merge(C, D); tk_pair_merge(C);
        LDS_WAIT(); asm volatile("" ::: "memory");
        float best[16], e[16], sum = 0.f;
#pragma unroll
        for (int q = 0; q < 16; ++q) { best[q] = key_dec((C[q] & ~255u) | 128u); e[q] = __expf(best[q] - best[0]); sum += e[q]; }
        const float inv = __builtin_amdgcn_rcpf(sum);
        int* IDX = (int*)(P.ws + WS_IDX) + (size_t)grow * 16 + 8 * hf; float* GW = (float*)(P.ws + WS_GW) + (size_t)grow * 16 + 8 * hf;
#pragma unroll
        for (int q = 0; q < 8; ++q) {
            const unsigned c = (C[q] & evenmask) | (C[8 + q] & ~evenmask);
            const float ev = __builtin_bit_cast(float, (__builtin_bit_cast(unsigned, e[q]) & evenmask) | (__builtin_bit_cast(unsigned, e[8 + q]) & ~evenmask));
            const unsigned pos = 255u - (c & 255u);
            IDX[q] = il[pos >> 4] * 128 + il[16 + (pos & 15u)]; GW[q] = ev * inv;
        }
    }
    LDS_WAIT(); asm volatile("" ::: "memory");
}

__device__ __forceinline__ void peer_topk_wave(const Params& P, LAS int* ilw, LAS unsigned* oute, LAS float* outg, int tbase, int lane) {
    const unsigned char* ws = P.ws;
    typedef _Float16 f16x8 __attribute__((ext_vector_type(8)));
    const int rl = lane >> 1, hf = lane & 1, t = tbase + (rl >> 3), h = rl & 7;
    const _Float16* SC = (const _Float16*)(ws + WS_PQ) + (size_t)t * 2048 + h * 256 + 64 * hf;
    f16x8 raw[2][8];
#pragma unroll
    for (int p = 0; p < 2; ++p)
#pragma unroll
        for (int q = 0; q < 8; ++q) raw[p][q] = *(const f16x8*)(SC + p * 128 + 8 * q);
    unsigned L1[16], L2[16];
#pragma unroll
    for (int p = 0; p < 2; ++p) {
        unsigned L[16];
#pragma unroll
        for (int grp = 0; grp < 4; ++grp) {
            unsigned G[16];
#pragma unroll
            for (int e = 0; e < 16; ++e) G[e] = (key_enc((float)raw[p][2 * grp + (e >> 3)][e & 7]) & ~127u) | (unsigned)(127 - (64 * hf + 16 * grp + e));
            tk_sort16(G);
            if (grp == 0) {
#pragma unroll
                for (int i = 0; i < 16; ++i) L[i] = G[i];
            } else tk_top16_merge(L, G);
        }
        tk_pair_merge(L);
#pragma unroll
        for (int i = 0; i < 16; ++i) { if (p == 0) L1[i] = L[i]; else L2[i] = L[i]; }
    }
    {
        float v1[16], v2[16];
        LAS int* il = ilw + rl * 33;
#pragma unroll
        for (int q = 0; q < 16; ++q) { v1[q] = key_dec((L1[q] & ~127u) | 64u); v2[q] = key_dec((L2[q] & ~127u) | 64u); }
        if (hf == 0) {
#pragma unroll
            for (int q = 0; q < 16; ++q) { il[q] = 127 - (int)(L1[q] & 127u); il[16 + q] = 127 - (int)(L2[q] & 127u); }
        }
        unsigned C[16], D[16];
        float w1[8];
        const unsigned hf16 = (unsigned)hf * 16u, evenmask = (unsigned)hf - 1u;
#pragma unroll
        for (int k = 0; k < 8; ++k) w1[k] = __builtin_bit_cast(float, (__builtin_bit_cast(unsigned, v1[2 * k]) & evenmask) | (__builtin_bit_cast(unsigned, v1[2 * k + 1]) & ~evenmask));
#define TK_SLOT(dst, k, bq, valid_odd) do { const unsigned pos_ = (unsigned)(16 * (2 * (k)) + (bq)) + hf16; unsigned kv_ = (key_enc(w1[k] + v2[bq]) & ~255u) | (255u - pos_); if (!(valid_odd)) kv_ &= evenmask; dst = kv_; } while (0)
        TK_SLOT(C[0], 0, 0, true);
        TK_SLOT(C[1], 0, 1, true);
        TK_SLOT(C[2], 0, 2, true);
        TK_SLOT(C[3], 0, 3, true);
        TK_SLOT(C[4], 0, 4, true);
        TK_SLOT(C[5], 0, 5, true);
        TK_SLOT(C[6], 0, 6, true);
        TK_SLOT(C[7], 0, 7, true);
        TK_SLOT(C[8], 0, 8, false);
        TK_SLOT(C[9], 0, 9, false);
        TK_SLOT(C[10], 0, 10, false);
        TK_SLOT(C[11], 0, 11, false);
        TK_SLOT(C[12], 0, 12, false);
        TK_SLOT(C[13], 0, 13, false);
        TK_SLOT(C[14], 0, 14, false);
        TK_SLOT(C[15], 0, 15, false);
        TK_SLOT(D[0], 1, 0, true);
        TK_SLOT(D[1], 1, 1, true);
        TK_SLOT(D[2], 1, 2, true);
        TK_SLOT(D[3], 1, 3, true);
        TK_SLOT(D[4], 1, 4, false);
        TK_SLOT(D[5], 2, 0, true);
        TK_SLOT(D[6], 2, 1, true);
        TK_SLOT(D[7], 2, 2, false);
        TK_SLOT(D[8], 3, 0, true);
        TK_SLOT(D[9], 3, 1, true);
        TK_SLOT(D[10], 4, 0, true);
        TK_SLOT(D[11], 5, 0, true);
        TK_SLOT(D[12], 6, 0, true);
        TK_SLOT(D[13], 7, 0, true);
        D[14] = 0u; D[15] = 0u;
#undef TK_SLOT
        tk_sort16(C); tk_sort16(D); tk_top16_merge(C, D); tk_pair_merge(C);
        LDS_WAIT(); asm volatile("" ::: "memory");
        float best[16], e[16], sum = 0.f;
#pragma unroll
        for (int q = 0; q < 16; ++q) { best[q] = key_dec((C[q] & ~255u) | 128u); e[q] = __expf(best[q] - best[0]); sum += e[q]; }
        const float inv = __builtin_amdgcn_rcpf(sum);
        LAS unsigned* IDX = oute + rl * 16 + 8 * hf; LAS float* GW = outg + rl * 16 + 8 * hf;
#pragma unroll
        for (int q = 0; q < 8; ++q) {
            const unsigned c = (C[q] & evenmask) | (C[8 + q] & ~evenmask);
            const float ev = __builtin_bit_cast(float, (__builtin_bit_cast(unsigned, e[q]) & evenmask) | (__builtin_bit_cast(unsigned, e[8 + q]) & ~evenmask));
            const unsigned pos = 255u - (c & 255u);
            IDX[q] = (unsigned)(il[pos >> 4] * 128 + il[16 + (pos & 15u)]); GW[q] = ev * inv;
        }
    }
    LDS_WAIT(); asm volatile("" ::: "memory");
}

typedef float f32x2 __attribute__((ext_vector_type(2)));
__device__ __forceinline__ unsigned q8(float x) { return (unsigned)(int)rintf(x) & 0xffu; }
__device__ __forceinline__ void cvt_table_fp8(const float* src, unsigned char* dst, float* scl, int gw, int ngw, int lane) {
    for (int row = gw; row < 16384; row += ngw) {
        const f32x4* sp = (const f32x4*)(src + (size_t)row * 1024 + 16 * lane);
        const f32x4 a0 = sp[0], a1 = sp[1], a2 = sp[2], a3 = sp[3];
        float m = fmaxf(fmaxf(fmaxf(fabsf(a0.x), fabsf(a0.y)), fmaxf(fabsf(a0.z), fabsf(a0.w))), fmaxf(fmaxf(fabsf(a1.x), fabsf(a1.y)), fmaxf(fabsf(a1.z), fabsf(a1.w))));
        m = fmaxf(m, fmaxf(fmaxf(fmaxf(fabsf(a2.x), fabsf(a2.y)), fmaxf(fabsf(a2.z), fabsf(a2.w))), fmaxf(fmaxf(fabsf(a3.x), fabsf(a3.y)), fmaxf(fabsf(a3.z), fabsf(a3.w)))));
#pragma unroll
        for (int o = 1; o < 64; o <<= 1) m = fmaxf(m, __shfl_xor(m, o));
        m = fmaxf(m, 1e-30f);
        const float q = 127.0f / m;
        v4u o;
        o.x = q8(a0.x * q) | (q8(a0.y * q) << 8) | (q8(a0.z * q) << 16) | (q8(a0.w * q) << 24);
        o.y = q8(a1.x * q) | (q8(a1.y * q) << 8) | (q8(a1.z * q) << 16) | (q8(a1.w * q) << 24);
        o.z = q8(a2.x * q) | (q8(a2.y * q) << 8) | (q8(a2.z * q) << 16) | (q8(a2.w * q) << 24);
        o.w = q8(a3.x * q) | (q8(a3.y * q) << 8) | (q8(a3.z * q) << 16) | (q8(a3.w * q) << 24);
        *(v4u*)(dst + (size_t)row * 1024 + 16 * lane) = o;
        if (lane == 0) scl[row] = m * (1.0f / 127.0f);
    }
}
__device__ __forceinline__ int row16_sum_i(int v) {
    v += __builtin_amdgcn_update_dpp(0, v, 0xB1, 0xF, 0xF, true);
    v += __builtin_amdgcn_update_dpp(0, v, 0x4E, 0xF, 0xF, true);
    v += __builtin_amdgcn_update_dpp(0, v, 0x141, 0xF, 0xF, true);
    v += __builtin_amdgcn_update_dpp(0, v, 0x140, 0xF, 0xF, true);
    return v;
}
constexpr int PE_NT = 4, PE_NR = 16, PE_SH = 10, PE_DEP = 3;
constexpr int PE_TOK_W = 128 * 3 + 20;
constexpr int PE_ENT_W = 272 * 4;
constexpr int PE_WAVE_W = PE_NT * PE_TOK_W + PE_ENT_W + 32 * 33 + 2 * PE_NT * 128;
static_assert(8 * PE_WAVE_W * 4 <= MISC_OFF && PE_NR * PE_NT == 64, "peer LDS / batch-list geometry");
#define PE_LD(dst, voff_, sbase_) asm volatile("s_nop 4\n\tglobal_load_dwordx4 %0, %1, %2" : "=&v"(dst) : "v"(voff_), "s"(sbase_) : "memory")
__device__ __forceinline__ void peer_pass(const Params& P, LAS unsigned char* lds, int tbase, int lane, int wave, float* dstbase, int emask = 0x3fff) {
    asm volatile("v_mbcnt_lo_u32_b32 %0, -1, 0\n\tv_mbcnt_hi_u32_b32 %0, -1, %0" : "=v"(lane));
    {
        LAS unsigned* lw0 = (LAS unsigned*)(lds) + wave * PE_WAVE_W + PE_NT * PE_TOK_W + PE_ENT_W;
        peer_topk_wave(P, (LAS int*)lw0, lw0 + 32 * 33, (LAS float*)(lw0 + 32 * 33 + PE_NT * 128), tbase, lane);
        LDS_WAIT(); asm volatile("" : "+v"(lane), "+s"(tbase) :: "memory");
    }
    const unsigned char* ws = P.ws;
    const unsigned char* UB8 = ws + WS_UB; const unsigned char* VB8 = ws + WS_VB;
    const float* USC = (const float*)(ws + WS_USC); const float* VSC = (const float*)(ws + WS_VSC);
    f32x2 acc[PE_NT][8];
    LAS unsigned* lw = (LAS unsigned*)(lds) + wave * PE_WAVE_W;
    LAS unsigned* ents = lw + PE_NT * PE_TOK_W;
    const unsigned voff = (unsigned)lane * 16u;
    LAS unsigned* upe = ents + PE_ENT_W + 32 * 33; LAS float* upg = (LAS float*)(upe + PE_NT * 128);
    LAS unsigned* hql = ents + PE_ENT_W;
#pragma unroll
    for (int j = 0; j < PE_NT; ++j) {
        const int t = tbase + j;
        const v4u* xrow = (const v4u*)((const bf16*)(ws + WS_XB) + (size_t)t * 1024 + 16 * lane);
        const v4u xa = xrow[0], xc = xrow[1];
        const f32x4 xvv[4] = {(f32x4){bflo(xa.x), bfhi(xa.x), bflo(xa.y), bfhi(xa.y)}, (f32x4){bflo(xa.z), bfhi(xa.z), bflo(xa.w), bfhi(xa.w)},
                              (f32x4){bflo(xc.x), bfhi(xc.x), bflo(xc.y), bfhi(xc.y)}, (f32x4){bflo(xc.z), bfhi(xc.z), bflo(xc.w), bfhi(xc.w)}};
        const float rstd2 = rsqrtf(((const float*)(ws + WS_SSQ2))[t] * (1.0f / 1024.0f) + 1e-6f);
        f32x4 hv[4]; float hm = 0.f;
#pragma unroll
        for (int i = 0; i < 4; ++i) { const f32x4 xv = xvv[i]; const f32x4 w = ((const f32x4*)(P.norm_ffn_w + 16 * lane))[i];
            hv[i] = (f32x4){xv.x * rstd2 * w.x, xv.y * rstd2 * w.y, xv.z * rstd2 * w.z, xv.w * rstd2 * w.w};
            hm = fmaxf(hm, fmaxf(fmaxf(fabsf(hv[i].x), fabsf(hv[i].y)), fmaxf(fabsf(hv[i].z), fabsf(hv[i].w)))); }
#pragma unroll
        for (int o = 1; o < 64; o <<= 1) hm = fmaxf(hm, __shfl_xor(hm, o));
        hm = fmaxf(hm, 1e-30f);
        const float hqs = 127.0f / hm, hs = hm * (1.0f / 127.0f);
        { unsigned hqv[4];
#pragma unroll
          for (int i = 0; i < 4; ++i) hqv[i] = q8(hv[i].x * hqs) | (q8(hv[i].y * hqs) << 8) | (q8(hv[i].z * hqs) << 16) | (q8(hv[i].w * hqs) << 24);
          *(LAS v4u*)(hql + (j * 64 + lane) * 4) = (v4u){hqv[0], hqv[1], hqv[2], hqv[3]}; }
#pragma unroll
        for (int i = 0; i < 8; ++i) acc[j][i] = (f32x2){0.f, 0.f};
        const int e0 = (int)upe[j * 128 + 2 * lane] & emask, e1 = (int)upe[j * 128 + 2 * lane + 1] & emask;
        const float g0 = upg[j * 128 + 2 * lane] * VSC[e0], g1 = upg[j * 128 + 2 * lane + 1] * VSC[e1];
        const float u0 = USC[e0] * hs, u1 = USC[e1] * hs;
        const int rev = (tbase >= T / 2) ? (PE_NR - 1) : 0;
        const int b0 = (e0 >> PE_SH) ^ rev, b1 = (e1 >> PE_SH) ^ rev;
        LAS unsigned* lt = lw + j * PE_TOK_W;
        int run = 0;
#pragma unroll 1
        for (int bk = 0; bk < PE_NR; ++bk) {
            const unsigned long long m0 = __ballot(b0 == bk), m1 = __ballot(b1 == bk);
            const int c0 = __popcll(m0), c1 = __popcll(m1);
            const unsigned long long lower = (1ull << lane) - 1ull;
            if (b0 == bk) { const int p = run + __popcll(m0 & lower); lt[p] = (unsigned)e0; lt[128 + p] = __builtin_bit_cast(unsigned, g0); lt[256 + p] = __builtin_bit_cast(unsigned, u0); }
            if (b1 == bk) { const int p = run + c0 + __popcll(m1 & lower); lt[p] = (unsigned)e1; lt[128 + p] = __builtin_bit_cast(unsigned, g1); lt[256 + p] = __builtin_bit_cast(unsigned, u1); }
            if (lane == 0) lt[384 + bk] = (unsigned)run;
            run += c0 + c1;
        }
        if (lane == 0) lt[384 + PE_NR] = 128u;
        asm volatile("" ::: "memory");
    }
    LDS_WAIT(); asm volatile("" ::: "memory");
    int nb;
    {
        const int rd = lane >> 2, j = (rd & 1) ? 3 - (lane & 3) : (lane & 3);
        const LAS unsigned* lt = lw + j * PE_TOK_W;
        const int n0 = (int)lt[384 + rd], n1 = (int)lt[384 + rd + 1];
        const int nbl = (n1 - n0 + 3) >> 2;
        int inc = nbl;
#pragma unroll
        for (int off = 1; off < 64; off <<= 1) { const int tv = __shfl_up(inc, off); if (lane >= off) inc += tv; }
        nb = __builtin_amdgcn_readlane(inc, 63);
        const int ofs = inc - nbl;
#pragma unroll 1
        for (int q = 0; q < nbl; ++q) { const int i0 = n0 + 4 * q, c = (n1 - i0) < 4 ? (n1 - i0) : 4;
            const unsigned e0 = lt[i0], e1 = lt[i0 + (c > 1 ? 1 : c - 1)], e2 = lt[i0 + (c > 2 ? 2 : c - 1)], e3 = lt[i0 + (c > 3 ? 3 : c - 1)];
            *(LAS v4u*)(ents + 4 * (ofs + q)) = (v4u){e0 | (((unsigned)j | ((unsigned)c << 2) | ((unsigned)i0 << 5)) << 14), e1, e2, e3}; }
        if (lane < 2 * PE_DEP) *(LAS v4u*)(ents + 4 * (nb + lane)) = (v4u){0u, 0u, 0u, 0u};
    }
    LDS_WAIT(); asm volatile("" ::: "memory");
    v4u ru[PE_DEP][4], rv[PE_DEP][4];
#define PE_LDO(dst, vo_, sbase_) asm volatile("global_load_dwordx4 %0, %1, %2" : "=&v"(dst) : "v"(vo_), "s"(sbase_) : "memory")
#define PE_ISSUE(S, rec_) do { const unsigned e0_ = (rec_).x & 0x3fffu; \
        { const unsigned vo_ = (e0_ << 10) + voff; PE_LDO(ru[S][0], vo_, UB8); PE_LDO(rv[S][0], vo_, VB8); } \
        { const unsigned vo_ = ((rec_).y << 10) + voff; PE_LDO(ru[S][1], vo_, UB8); PE_LDO(rv[S][1], vo_, VB8); } \
        { const unsigned vo_ = ((rec_).z << 10) + voff; PE_LDO(ru[S][2], vo_, UB8); PE_LDO(rv[S][2], vo_, VB8); } \
        { const unsigned vo_ = ((rec_).w << 10) + voff; PE_LDO(ru[S][3], vo_, UB8); PE_LDO(rv[S][3], vo_, VB8); } } while (0)
#define PE_WAIT8(S, cntstr) asm volatile("s_waitcnt " cntstr : "+v"(ru[S][0]), "+v"(ru[S][1]), "+v"(ru[S][2]), "+v"(ru[S][3]), "+v"(rv[S][0]), "+v"(rv[S][1]), "+v"(rv[S][2]), "+v"(rv[S][3]) :: "memory")
#define PE_UDOTS(S) asm("v_dot4_i32_i8 %0, %4, %20, 0\n\tv_dot4_i32_i8 %1, %8, %20, 0\n\tv_dot4_i32_i8 %2, %12, %20, 0\n\tv_dot4_i32_i8 %3, %16, %20, 0\n\t" \
                        "v_dot4_i32_i8 %0, %5, %21, %0\n\tv_dot4_i32_i8 %1, %9, %21, %1\n\tv_dot4_i32_i8 %2, %13, %21, %2\n\tv_dot4_i32_i8 %3, %17, %21, %3\n\t" \
                        "v_dot4_i32_i8 %0, %6, %22, %0\n\tv_dot4_i32_i8 %1, %10, %22, %1\n\tv_dot4_i32_i8 %2, %14, %22, %2\n\tv_dot4_i32_i8 %3, %18, %22, %3\n\t" \
                        "v_dot4_i32_i8 %0, %7, %23, %0\n\tv_dot4_i32_i8 %1, %11, %23, %1\n\tv_dot4_i32_i8 %2, %15, %23, %2\n\tv_dot4_i32_i8 %3, %19, %23, %3\n\ts_nop 2" \
        : "=&v"(d_[0]), "=&v"(d_[1]), "=&v"(d_[2]), "=&v"(d_[3]) \
        : "v"(ru[S][0].x), "v"(ru[S][0].y), "v"(ru[S][0].z), "v"(ru[S][0].w), "v"(ru[S][1].x), "v"(ru[S][1].y), "v"(ru[S][1].z), "v"(ru[S][1].w), \
          "v"(ru[S][2].x), "v"(ru[S][2].y), "v"(ru[S][2].z), "v"(ru[S][2].w), "v"(ru[S][3].x), "v"(ru[S][3].y), "v"(ru[S][3].z), "v"(ru[S][3].w), \
          "v"(hcur.x), "v"(hcur.y), "v"(hcur.z), "v"(hcur.w))
#define PE_UDOTS_SAFE(S) do { _Pragma("unroll") for (int k_ = 0; k_ < 4; ++k_) { int s_ = __builtin_amdgcn_sdot4((int)ru[S][k_].x, (int)hcur.x, 0, false); s_ = __builtin_amdgcn_sdot4((int)ru[S][k_].y, (int)hcur.y, s_, false); \
            s_ = __builtin_amdgcn_sdot4((int)ru[S][k_].z, (int)hcur.z, s_, false); s_ = __builtin_amdgcn_sdot4((int)ru[S][k_].w, (int)hcur.w, s_, false); d_[k_] = s_; } } while (0)
#define PE_VDOTS_SAFE(f0, f1, f2, f3, b0, b1, b2, b3, w) do { f0 = (float)__builtin_amdgcn_sdot4((int)(b0), (int)(w), 0, false); f1 = (float)__builtin_amdgcn_sdot4((int)(b1), (int)(w), 0, false); \
            f2 = (float)__builtin_amdgcn_sdot4((int)(b2), (int)(w), 0, false); f3 = (float)__builtin_amdgcn_sdot4((int)(b3), (int)(w), 0, false); } while (0)
#define PE_VDOTS(f0, f1, f2, f3, b0, b1, b2, b3, w) asm("v_dot4_i32_i8 %0, %4, %8, 0\n\tv_dot4_i32_i8 %1, %5, %8, 0\n\tv_dot4_i32_i8 %2, %6, %8, 0\n\tv_dot4_i32_i8 %3, %7, %8, 0\n\t" \
                        "v_cvt_f32_i32_e32 %0, %0\n\tv_cvt_f32_i32_e32 %1, %1\n\tv_cvt_f32_i32_e32 %2, %2\n\tv_cvt_f32_i32_e32 %3, %3" \
        : "=&v"(f0), "=&v"(f1), "=&v"(f2), "=&v"(f3) : "v"(b0), "v"(b1), "v"(b2), "v"(b3), "v"(w))
#define PE_COMPUTE_B(S, c_, i_, j_, SG) do { const LAS unsigned* lt_ = lw + (j_) * PE_TOK_W; \
        const int myk_ = lane >> 4; \
        float gsc_ = __builtin_bit_cast(float, lt_[128 + i_ + myk_]), usc_ = __builtin_bit_cast(float, lt_[256 + i_ + myk_]);     \
        int d_[4]; \
        PE_UDOTS(S); \
        int r1_; \
        { const v2u p02_ = __builtin_amdgcn_permlane32_swap((unsigned)d_[0], (unsigned)d_[2], false, false), p13_ = __builtin_amdgcn_permlane32_swap((unsigned)d_[1], (unsigned)d_[3], false, false); \
          const v2u q_ = __builtin_amdgcn_permlane16_swap(p02_.x + p02_.y, p13_.x + p13_.y, false, false); r1_ = row16_sum_i((int)(q_.x + q_.y)); }     \
        float act_; \
        { const float x_ = (float)r1_ * usc_, e_ = __builtin_amdgcn_exp2f(x_ * __builtin_fmaf(x_ * x_, -0.10294324f, -2.3022082f));     \
          act_ = x_ * __builtin_amdgcn_rcpf(1.0f + e_) * gsc_; act_ = (myk_ < c_) ? act_ : 0.f; } \
        float wm_; \
        { unsigned wmu_ = __builtin_bit_cast(unsigned, act_) & 0x7fffffffu;                 \
          v2u t_ = __builtin_amdgcn_permlane32_swap(wmu_, wmu_, false, false); wmu_ = t_.x > t_.y ? t_.x : t_.y; \
          t_ = __builtin_amdgcn_permlane16_swap(wmu_, wmu_, false, false); wmu_ = t_.x > t_.y ? t_.x : t_.y; \
          wm_ = fmaxf(__builtin_bit_cast(float, wmu_), 1e-30f); } \
        const float wq_ = 127.0f * __builtin_amdgcn_rcpf(wm_), ws_ = (SG) * wm_ * (1.0f / 127.0f); \
        unsigned w4u_ = (__builtin_bit_cast(unsigned, __builtin_fmaf(act_, wq_, 12582912.0f)) & 0xffu) << (8 * myk_); \
        { v2u t_ = __builtin_amdgcn_permlane32_swap(w4u_, w4u_, false, false); w4u_ = t_.x | t_.y; t_ = __builtin_amdgcn_permlane16_swap(w4u_, w4u_, false, false); w4u_ = t_.x | t_.y; } \
        const f32x2 ws2_ = (f32x2){ws_, ws_}; \
        _Pragma("unroll") for (int m_ = 0; m_ < 4; ++m_) { \
            const unsigned R0_ = rv[S][0][m_], R1_ = rv[S][1][m_], R2_ = rv[S][2][m_], R3_ = rv[S][3][m_]; \
            const unsigned X_ = __builtin_amdgcn_perm(R1_, R0_, 0x05010400u), Y_ = __builtin_amdgcn_perm(R1_, R0_, 0x07030602u), Z_ = __builtin_amdgcn_perm(R3_, R2_, 0x05010400u), W_ = __builtin_amdgcn_perm(R3_, R2_, 0x07030602u); \
            float t0_, t1_, t2_, t3_; \
            const unsigned b0_ = __builtin_amdgcn_perm(Z_, X_, 0x05040100u), b1_ = __builtin_amdgcn_perm(Z_, X_, 0x07060302u), b2_ = __builtin_amdgcn_perm(W_, Y_, 0x05040100u), b3_ = __builtin_amdgcn_perm(W_, Y_, 0x07060302u); \
            PE_VDOTS(t0_, t1_, t2_, t3_, b0_, b1_, b2_, b3_, w4u_); \
            cur[2 * m_] = __builtin_elementwise_fma((f32x2){t0_, t1_}, ws2_, cur[2 * m_]); \
            cur[2 * m_ + 1] = __builtin_elementwise_fma((f32x2){t2_, t3_}, ws2_, cur[2 * m_ + 1]); } } while (0)
#define PE_FLUSH() do { _Pragma("unroll") for (int J_ = 0; J_ < PE_NT; ++J_) { const float sel_ = (jcur == J_) ? 1.0f : 0.0f; const f32x2 sel2_ = (f32x2){sel_, sel_};     \
            _Pragma("unroll") for (int i_ = 0; i_ < 8; ++i_) acc[J_][i_] = __builtin_elementwise_fma(cur[i_], sel2_, acc[J_][i_]); } \
        _Pragma("unroll") for (int i_ = 0; i_ < 8; ++i_) cur[i_] = (f32x2){0.f, 0.f}; } while (0)
#define PE_COMPUTE_S(S, entv, SG) do { const unsigned en_ = (entv) >> 14; const int jj_ = (int)(en_ & 3u), cc_ = (int)((en_ >> 2) & 7u), ii_ = (int)(en_ >> 5); \
        if (cc_ > 0) { if (jj_ != jcur) { PE_FLUSH(); jcur = jj_; hcur = *(const LAS v4u*)(hql + (jj_ * 64 + lane) * 4); } \
                       PE_COMPUTE_B(S, cc_, ii_, jj_, SG); } } while (0)
#ifdef PE_VALU3
#define PE_COMPUTE(S, entv) do { PE_COMPUTE_S(S, entv, 1.0f); PE_WAIT8(S, "vmcnt(16)"); PE_COMPUTE_S(S, entv, -1.0f); PE_WAIT8(S, "vmcnt(16)"); PE_COMPUTE_S(S, entv, 1.0f); } while (0)
#else
#define PE_COMPUTE(S, entv) PE_COMPUTE_S(S, entv, 1.0f)
#endif
    {
        unsigned er[PE_DEP];
#pragma unroll
        for (int q = 0; q < PE_DEP; ++q) { const v4u rec = *(const LAS v4u*)(ents + 4 * q); er[q] = __builtin_amdgcn_readfirstlane(rec.x); PE_ISSUE(q, rec); }
        f32x2 cur[8];
#pragma unroll
        for (int i = 0; i < 8; ++i) cur[i] = (f32x2){0.f, 0.f};
        int jcur = (int)((er[0] >> 14) & 3u);
        v4u hcur = *(const LAS v4u*)(hql + (jcur * 64 + lane) * 4);
        v4u nrec = *(const LAS v4u*)(ents + 4 * PE_DEP);
#pragma unroll 1
        for (int bi = 0; bi < nb; bi += PE_DEP) {
#pragma unroll
            for (int q = 0; q < PE_DEP; ++q) {
                PE_WAIT8(q, "vmcnt(16)");
                PE_COMPUTE(q, er[q]);
                er[q] = __builtin_amdgcn_readfirstlane(nrec.x);
                PE_ISSUE(q, nrec);
                nrec = *(const LAS v4u*)(ents + 4 * (bi + q + PE_DEP + 1));
            }
        }
#pragma unroll
        for (int q = 0; q < PE_DEP; ++q) PE_WAIT8(q, "vmcnt(0)");
        PE_FLUSH();
    }
#undef PE_COMPUTE
#undef PE_COMPUTE_S
#undef PE_COMPUTE_B
#undef PE_FLUSH
#undef PE_WAIT8
#undef PE_ISSUE
#undef PE_LDO
#undef PE_UDOTS
#undef PE_VDOTS
    asm volatile("v_mbcnt_lo_u32_b32 %0, -1, 0\n\tv_mbcnt_hi_u32_b32 %0, -1, %0" : "=v"(lane)); asm volatile("" : "+s"(tbase));
#pragma unroll
    for (int j = 0; j < PE_NT; ++j) {
        const int t = tbase + j;
        float ss = 0.f; f32x4 xo[4];
        { const v4u* xrow = (const v4u*)((const bf16*)(ws + WS_XB) + (size_t)t * 1024 + 16 * lane); const v4u xa = xrow[0], xc = xrow[1];
          xo[0] = (f32x4){bflo(xa.x), bfhi(xa.x), bflo(xa.y), bfhi(xa.y)}; xo[1] = (f32x4){bflo(xa.z), bfhi(xa.z), bflo(xa.w), bfhi(xa.w)};
          xo[2] = (f32x4){bflo(xc.x), bfhi(xc.x), bflo(xc.y), bfhi(xc.y)}; xo[3] = (f32x4){bflo(xc.z), bfhi(xc.z), bflo(xc.w), bfhi(xc.w)}; }
#pragma unroll
        for (int i = 0; i < 4; ++i) { xo[i].x += acc[j][2 * i].x; xo[i].y += acc[j][2 * i].y; xo[i].z += acc[j][2 * i + 1].x; xo[i].w += acc[j][2 * i + 1].y;
            ss += (xo[i].x * xo[i].x + xo[i].y * xo[i].y) + (xo[i].z * xo[i].z + xo[i].w * xo[i].w); }
        const float rstd3 = rsqrtf(wave_sum(ss) * (1.0f / 1024.0f) + 1e-6f);
        float* orow = dstbase + (size_t)t * 1024 + 16 * lane;
#pragma unroll
        for (int i = 0; i < 4; ++i) { const f32x4 w = ((const f32x4*)(P.norm_final_w + 16 * lane))[i];
            ((f32x4*)orow)[i] = (f32x4){xo[i].x * rstd3 * w.x, xo[i].y * rstd3 * w.y, xo[i].z * rstd3 * w.z, xo[i].w * rstd3 * w.w}; }
    }
    LDS_WAIT(); asm volatile("s_waitcnt vmcnt(0)" ::: "memory");
}


#ifndef TWICE_MASK
#define TWICE_MASK 0
#endif
struct TwiceOrder { pg8::StaticOrder S; int per, reps;
    __device__ bool next(int i, pg8::Unit& u) const { if (i >= per * reps) return false; return S.next(i % per, u); }
    __device__ __forceinline__ void a_ready(const pg8::Unit&) const {} __device__ __forceinline__ void done(const pg8::Unit&) const {} };
template <class B> __device__ __forceinline__ bool rep_again(volatile LAS unsigned* MISC, B& bar) {
    __syncthreads(); const unsigned c = MISC[20]; __syncthreads();
    if (threadIdx.x == 0) MISC[20] = c ^ 1u;
    __syncthreads();
    if (c == 0u) { xcd_barrier(bar); return true; }
    return false;
}
__global__ void __launch_bounds__(NWAVES * 64, 2) hybrid_fwd(Params P) {
    extern __shared__ __attribute__((aligned(16))) unsigned char lds_raw[];
    LAS unsigned char* lds = (LAS unsigned char*)lds_raw;
    volatile LAS unsigned* MISC = (volatile LAS unsigned*)(lds + MISC_OFF);
    const int tid = threadIdx.x, lane = tid & 63, wave = __builtin_amdgcn_readfirstlane(tid >> 6);
    const int G = gridDim.x, bx = blockIdx.x;
    const int vcu = (G % 8 == 0) ? (bx % 8) * (G / 8) + bx / 8 : bx;
    unsigned char* ws = P.ws;
    for (int u = tid; u < 64; u += NWAVES * 64) MISC[u] = 0u;
    __syncthreads();
    XcdBarrier bar; bar.bar = (unsigned*)(ws + WS_CTL) + CW_BAR; bar.x = 0; bar.st = nullptr;
    if (!MK_PER_PHASE) bar = xcd_barrier_post((unsigned*)(ws + WS_CTL) + CW_BAR, MISC + 8);
    const int lo = P.ph_lo, hi = P.ph_hi;
#ifndef PHASE_MASK
#define PHASE_MASK 0xFFF
#endif
#define IN(k) (((PHASE_MASK >> (k)) & 1) && lo <= (k) && (k) < hi)
#define SEAM(k) do { if (IN(k) && IN((k) + 1)) xcd_barrier(bar); } while (0)
#ifndef REP_MASK
#define REP_MASK 0
#endif
#ifndef PE_EXP_MASK
#define PE_EXP_MASK 0x3fff
#endif
#define REPS(k) for (bool again_ = true; again_; again_ = (((REP_MASK >> (k)) & 1) ? rep_again(MISC, bar) : false))
    using namespace pg8;
    bf16* XB = (bf16*)(ws + WS_XB);

    if (IN(0)) REPS(0) { p0_prologue(P, lds, tid, lane, wave, vcu, G); }
    SEAM(0);
    if (IN(1)) REPS(1) {
        { Gemm gm{XB, (const bf16_t*)(ws + WS_WIN), T, 3072, 1024}; StaticOrder S; S.init(T, 3072, G, bx);
          EpiBf16Rs E{(bf16_t*)(ws + WS_QKV), 1536, 6, (bf16_t*)(ws + WS_XR), 512, (size_t)T * 512, nullptr, 1.0f};
          gemm_phase<EpiBf16Rs, StaticOrder, PG8_ALIGN, PG8_SP2>(lds, gm, S, E); }
    }
    SEAM(1);
    if (IN(3)) REPS(3) {
        if (bx < SCAN_WGS) gdn_scan(P, lds, bx, tid, lane, wave);
        else {
            const int wk = bx - SCAN_WGS, NWK = G - SCAN_WGS;
            unsigned* lcnt = (unsigned*)(ws + WS_CTL) + CW_LRUCNT;
            for (int q = wk; q < 1024; q += NWK) gdn_local_item(P, lds, (q & 7) * 128 + (q >> 3), tid);
            unsigned ndone = 0;
            for (int lt = wk; lt < 256; lt += NWK) { lru_local_item(P, lds, lt, tid, lane, wave); ++ndone; }
            asm volatile("s_waitcnt vmcnt(0)" ::: "memory");
            __syncthreads();
            if (tid == 0 && ndone) { __builtin_amdgcn_fence(__ATOMIC_RELEASE, "agent"); asm volatile("s_waitcnt vmcnt(0)" ::: "memory");
                                     __hip_atomic_fetch_add(lcnt, ndone, __ATOMIC_RELAXED, __HIP_MEMORY_SCOPE_AGENT); }
            if (wk < 16) {
                struct OneUnit { int pm, pn; __device__ bool next(int i, Unit& u) const { if (i > 0) return false; u.pm = pm; u.pn = pn; return true; }
                                 __device__ void a_ready(const Unit&) const {} __device__ void done(const Unit&) const {} };
                Gemm gm{(const bf16_t*)(ws + WS_MEMN), (const bf16_t*)(ws + WS_WKV), 512, 2048, 1024}; OneUnit S{wk >> 3, wk & 7};
                EpiKV E{(bf16_t*)(ws + WS_KB), (bf16_t*)(ws + WS_VTP)};
                gemm_phase<EpiKV, OneUnit, PG8_ALIGN, PG8_SP2>(lds, gm, S, E);
            }
            if (wk == 16 || wk == 17) {
                if (tid == 0) { unsigned sp = 0;
                    while (__hip_atomic_load(lcnt, __ATOMIC_RELAXED, __HIP_MEMORY_SCOPE_AGENT) < 256u) { __builtin_amdgcn_s_sleep(8); if (++sp > (1u << 22)) break; }
                    __builtin_amdgcn_fence(__ATOMIC_ACQUIRE, "agent"); asm volatile("s_waitcnt vmcnt(0)" ::: "memory"); }
                __syncthreads();
                lru_carry(P, (wk - 16) * NWAVES + wave, lane);
                asm volatile("s_waitcnt vmcnt(0)" ::: "memory");
                __syncthreads();
                if (tid == 0) { __builtin_amdgcn_fence(__ATOMIC_RELEASE, "agent"); asm volatile("s_waitcnt vmcnt(0)" ::: "memory");
                                __hip_atomic_fetch_add(lcnt + 64, 1u, __ATOMIC_RELAXED, __HIP_MEMORY_SCOPE_AGENT); }
            } else {
                const int w2 = (wk < 16 ? wk : wk - 2), N2 = NWK - 2;
                cvt_table_fp8(P.peer_v, ws + WS_VB, (float*)(ws + WS_VSC), w2 * NWAVES + wave, N2 * NWAVES, lane);
                late_weight_prep(P, lds, lane, wave, w2 * NWAVES + wave, N2 * NWAVES);
                if (tid == 0) { unsigned sp = 0;
                    while (__hip_atomic_load(lcnt + 64, __ATOMIC_RELAXED, __HIP_MEMORY_SCOPE_AGENT) < 2u) { __builtin_amdgcn_s_sleep(8); if (++sp > (1u << 22)) break; }
                    __builtin_amdgcn_fence(__ATOMIC_ACQUIRE, "agent"); asm volatile("s_waitcnt vmcnt(0)" ::: "memory"); }
                __syncthreads();
                lru_combine(P, (size_t)w2 * (NWAVES * 64) + tid, (size_t)N2 * (NWAVES * 64));
            }
        }
    }
    SEAM(3);
    if (IN(4)) REPS(4) {
        gdn_gate_norm(P, (size_t)bx * (NWAVES * 64) + tid, (size_t)G * (NWAVES * 64));
        cvt_table_fp8(P.peer_u, ws + WS_UB, (float*)(ws + WS_USC), bx * NWAVES + wave, G * NWAVES, lane);
    }
    SEAM(4);
    if (IN(5)) {
        Gemm gm{(const bf16_t*)((const unsigned char*)P.out + OUT_Y), (const bf16_t*)(ws + WS_WOUT), T, 1024, 1024}; StaticOrder S; S.init(T, 1024, G, bx);
        EpiResidBf<true> E{P.x, XB, (float*)(ws + WS_SSQ1)};
        gemm_phase<EpiResidBf<true>, StaticOrder, PG8_ALIGN, PG8_SP2>(lds, gm, S, E);
    }
    SEAM(5);
    if (IN(6)) REPS(6) {
        Gemm gm{XB, (const bf16_t*)(ws + WS_WQ), T, 1024, 1024};
        EpiBf16Rs E{(bf16_t*)(ws + WS_Q), 1024, 4, nullptr, 256, 0, (const float*)(ws + WS_SSQ1), 0.0625f};
#if (TWICE_MASK >> 6) & 1
        { TwiceOrder S; S.S.init(T, 1024, G, bx); S.per = 1; S.reps = 2;
          gemm_phase<EpiBf16Rs, TwiceOrder, PG8_ALIGN, PG8_SP2>(lds, gm, S, E); }
#else
        { StaticOrder S; S.init(T, 1024, G, bx);
          gemm_phase<EpiBf16Rs, StaticOrder, PG8_ALIGN, PG8_SP2>(lds, gm, S, E); }
#endif
        Unit u;
        { const int wgid = (bx & 7) * 32 + (bx >> 3); u.pm = (wgid >> 5) * 8 + (wgid & 7); u.pn = (wgid & 31) >> 3; }
        if (G == 256) {
            asm volatile("s_waitcnt vmcnt(0)" ::: "memory");
            __syncthreads();
            const int b = u.pm >> 5, qb0 = (u.pm & 31) * 2, h = u.pn;
#pragma unroll 1
            for (int qq = 0; qq < (((TWICE_MASK >> 7) & 1) ? 4 : 2); qq += XA_NPS) xattn_unit(P, lds, (b << 8) | ((qb0 + (qq & 1)) << 2) | h, tid, lane, wave);
        }
    }
    if (IN(7)) REPS(7) { }
    SEAM(7);
    if (IN(8)) {
        Gemm gm{(const bf16_t*)(ws + WS_AO), (const bf16_t*)(ws + WS_WO), T, 1024, 1024}; StaticOrder S; S.init(T, 1024, G, bx);
        EpiResidBf<false> E{nullptr, XB, (float*)(ws + WS_SSQ2)};
        gemm_phase<EpiResidBf<false>, StaticOrder, PG8_ALIGN, PG8_SP2>(lds, gm, S, E);
    }
    SEAM(8);
    if (IN(9)) REPS(9) {
        Gemm gm{XB, (const bf16_t*)(ws + WS_PWQ), T, 2048, 1024};
        EpiF16Rs E{(_Float16*)(ws + WS_PQ), 2048, (const float*)(ws + WS_SSQ2)};
#if (TWICE_MASK >> 9) & 1
        TwiceOrder S; S.S.init(T, 2048, G, bx); S.per = 2; S.reps = 2;
        gemm_phase<EpiF16Rs, TwiceOrder, PG8_ALIGN, PG8_SP2>(lds, gm, S, E);
#else
        StaticOrder S; S.init(T, 2048, G, bx);
        gemm_phase<EpiF16Rs, StaticOrder, PG8_ALIGN, PG8_SP2>(lds, gm, S, E);
#endif
    }
    SEAM(9);
    if (IN(10)) REPS(10) {
    }
    if (IN(11)) REPS(11) {
#if (TWICE_MASK >> 11) & 1
        for (int it = 0; it < 4; ++it) { const int tb = (bx * NWAVES + wave) * PE_NT + (it >> 1) * (G * NWAVES * PE_NT); if (tb < T) peer_pass(P, lds, tb, lane, wave, P.out, (it & 1) ? 0x3fff : PE_EXP_MASK); }
#else
#ifndef PE_PASS_BARRIER
#define PE_PASS_BARRIER 0
#endif
        for (int tb = (bx * NWAVES + wave) * PE_NT, np = 0; tb < T; tb += G * NWAVES * PE_NT, ++np) {
            if (PE_PASS_BARRIER && np > 0 && (T % (G * NWAVES * PE_NT)) == 0) xcd_barrier(bar);
            peer_pass(P, lds, tb, lane, wave, P.out);
        }
#endif
    }
#undef IN
#undef SEAM
}

extern "C" void kernel_launch(void* const* d_in, const int* in_sizes, int n_in, void* d_out, int out_size, void* d_ws, size_t ws_size, hipStream_t stream) {
    static int grid = 0;
    if (grid == 0) {
        if (n_in != 27 || in_sizes[0] != T * D || out_size != T * D || ws_size < WS_END) {
            fprintf(stderr, "kernel_launch: unexpected shapes (n_in %d, in0 %d, out %d, ws %zu); nothing launched\n", n_in, n_in > 0 ? in_sizes[0] : -1, out_size, ws_size); grid = -1; return; }
        int dev = 0, cus = 0, per_cu = 0;
        if (hipGetDevice(&dev) != hipSuccess || hipDeviceGetAttribute(&cus, hipDeviceAttributeMultiprocessorCount, dev) != hipSuccess) { grid = -1; return; }
        if (hipFuncSetAttribute((const void*)hybrid_fwd, hipFuncAttributeMaxDynamicSharedMemorySize, LDS_BYTES) != hipSuccess) { fprintf(stderr, "kernel_launch: hipFuncSetAttribute failed\n"); grid = -1; return; }
        if (hipOccupancyMaxActiveBlocksPerMultiprocessor(&per_cu, (const void*)hybrid_fwd, NWAVES * 64, LDS_BYTES) != hipSuccess || per_cu < 1)
            fprintf(stderr, "kernel_launch: note: occupancy query reports %d workgroups per CU\n", per_cu);
        (void)hipGetLastError();
        grid = cus;
        if (grid != 256) fprintf(stderr, "kernel_launch: %d CUs (built for 256)\n", grid);
    }
    if (grid < 0) return;
    if (hipMemsetAsync((char*)d_ws + WS_CTL, 0, CTL_ZERO_BYTES, stream) != hipSuccess) { fprintf(stderr, "kernel_launch: hipMemsetAsync failed\n"); return; }
    Params p{};
    const float** pp = (const float**)&p;
    for (int i = 0; i < 27; ++i) pp[i] = (const float*)d_in[i];
    p.out = (float*)d_out; p.ws = (unsigned char*)d_ws;
#if MK_PER_PHASE
    for (int k = 0; k < N_PHASES; ++k) { p.ph_lo = k; p.ph_hi = k + 1; hipLaunchKernelGGL(hybrid_fwd, dim3(grid), dim3(NWAVES * 64), LDS_BYTES, stream, p); }
#else
    p.ph_lo = 0; p.ph_hi = N_PHASES;
    hipLaunchKernelGGL(hybrid_fwd, dim3(grid), dim3(NWAVES * 64), LDS_BYTES, stream, p);
#endif
    const hipError_t le = hipPeekAtLastError();
    if (le != hipSuccess) fprintf(stderr, "kernel_launch: launch failed: %s\n", hipGetErrorName(le));
}
```

```cpp
#include <hip/hip_runtime.h>
#include <cstdio>
#include <cstdint>
namespace pg8 {
#define PG8_LAS __attribute__((address_space(3)))
typedef unsigned short bf16_t;
typedef short bf16x8 __attribute__((ext_vector_type(8)));
typedef float f32x4 __attribute__((ext_vector_type(4)));
typedef unsigned u32x4 __attribute__((ext_vector_type(4)));
constexpr int BM = 256, BK = 64, HALF = 128, HTB = HALF * BK * 2  , STAGE_BYTES = 8 * HTB, NXCD = 8, WGM = 8;

__host__ __device__ __forceinline__ int lds_byte(int r, int c) { const int st = (r >> 4) * 2 + (c >> 5), rr = r & 15, cc = c & 31, ob = rr * 64 + cc * 2; return st * 1024 + (ob ^ (((ob >> 9) & 1) << 5)); }
__host__ __device__ __forceinline__ void stage_rc(int b, int& R, int& C) { const int st = b / 1024, sb = b % 1024, swz = sb ^ (((sb >> 9) & 1) << 5); R = (st >> 1) * 16 + swz / 64; C = (st & 1) * 32 + (swz % 64) / 2; }
__host__ __device__ __forceinline__ int perm32(int rho) { const int n = rho >> 4, i = rho & 15; return 8 * (i >> 2) + 4 * n + (i & 3); }

struct Unit { int pm, pn; };
struct Gemm { const bf16_t* A; const bf16_t* Bt; int M, N, K; };

struct StaticOrder {
    int nM, nN, nwg, G, c;
    __host__ __device__ void init(int M, int N, int G_, int c_) { nM = M / BM; nN = N / BM; nwg = nM * nN; G = G_; c = c_; }
    __host__ __device__ bool next(int i, Unit& u) const {
        const long L = (long)i * G + c; if (L >= nwg) return false;
        int wgid = (int)L; { const int q = nwg / NXCD, r = nwg % NXCD, xcd = wgid % NXCD, off = wgid / NXCD; wgid = (xcd < r ? xcd * (q + 1) : r * (q + 1) + (xcd - r) * q) + off; }
        const int nig = WGM * nN, gid = wgid / nig, fm = gid * WGM, gsz = (nM - fm) < WGM ? (nM - fm) : WGM;
        u.pm = fm + ((wgid % nig) % gsz); u.pn = (wgid % nig) / gsz; return true;
    }
    __device__ __forceinline__ void a_ready(const Unit&) const {}
    __device__ __forceinline__ void done(const Unit&) const {}
};

__device__ __forceinline__ unsigned cvt_pk_bf16(float lo, float hi) { unsigned r; asm volatile("v_cvt_pk_bf16_f32 %0, %1, %2" : "=v"(r) : "v"(lo), "v"(hi)); return r; }
template <class Epi, class Sched, bool ALIGN_EPI = false, bool SP2 = false>
__device__ __forceinline__ void gemm_phase(PG8_LAS unsigned char* lds, const Gemm g, const Sched& S, const Epi& E) {
    const int tid = threadIdx.x, wid = __builtin_amdgcn_readfirstlane(tid >> 6), lane = tid & 63, wr = wid >> 2, wc = wid & 3, fr = lane & 15, fq = lane >> 4;
    const int K = g.K, nt = K / BK;
    unsigned voffA[2], voffB[2];
#pragma unroll
    for (int i = 0; i < 2; ++i) { int R, C; stage_rc(tid * 16 + i * 8192, R, C); const int Rb = Epi::PERM ? ((R & ~31) + perm32(R & 31)) : R;
        voffA[i] = (unsigned)(R * K + C) * 2u; voffB[i] = (unsigned)(Rb * K + C) * 2u; }
    const size_t kstep = (size_t)(BK * 2);
    const size_t hstep = (size_t)HALF * K * 2;
    const size_t tstep = 2 * hstep;
    const unsigned ldsw = (unsigned)wid * 1024u;
    const int aoff = lds_byte(wr * 64 + fr, fq * 8), boff = lds_byte(wc * 32 + fr, fq * 8);
#define PG8_SA(b, h) (((b) * 2 + (h)) * HTB)
#define PG8_SB(b, h) ((4 + (b) * 2 + (h)) * HTB)
#define PG8_STAGE(bufoff, gbase, voff) do { _Pragma("unroll") for (int _i = 0; _i < 2; ++_i) \
        __builtin_amdgcn_global_load_lds((const unsigned*)((const char*)(gbase) + (voff)[_i]), (PG8_LAS unsigned*)(lds + (bufoff) + ldsw + _i * 8192), 16, 0, 0); } while (0)
#define PG8_LDA(dst, b, h) do { _Pragma("unroll") for (int m = 0; m < 4; ++m) _Pragma("unroll") for (int k = 0; k < 2; ++k) dst[m][k] = *(const PG8_LAS bf16x8*)(lds + PG8_SA(b, h) + aoff + m * 2048 + k * 1024); } while (0)
#define PG8_LDB(dst, b, h) do { _Pragma("unroll") for (int n = 0; n < 2; ++n) _Pragma("unroll") for (int k = 0; k < 2; ++k) dst[n][k] = *(const PG8_LAS bf16x8*)(lds + PG8_SB(b, h) + boff + n * 2048 + k * 1024); } while (0)
#define PG8_MMA(ai, bj, At, Bt) do { __builtin_amdgcn_s_setprio(1); _Pragma("unroll") for (int m = 0; m < 4; ++m) _Pragma("unroll") for (int n = 0; n < 2; ++n) _Pragma("unroll") for (int k = 0; k < 2; ++k) \
        acc[ai][bj][m][n] = __builtin_amdgcn_mfma_f32_16x16x32_bf16(Bt[n][k], At[m][k], acc[ai][bj][m][n], 0, 0, 0); __builtin_amdgcn_s_setprio(0); } while (0)
#define PG8_WAIT_V(n) asm volatile("s_waitcnt vmcnt(" #n ")" ::: "memory")
#define PG8_WAIT_L(n) asm volatile("s_waitcnt lgkmcnt(" #n ")" ::: "memory")
#define PG8_BAR __builtin_amdgcn_s_barrier()
#define PG8_SCHED __builtin_amdgcn_sched_barrier(0)
    Unit cur, nxt; int ui = 0;
    if (!S.next(0, cur)) return;
    f32x4 acc[2][2][4][2];
#pragma unroll
    for (int a = 0; a < 2; ++a)
#pragma unroll
        for (int b = 0; b < 2; ++b)
#pragma unroll
            for (int m = 0; m < 4; ++m)
#pragma unroll
                for (int n = 0; n < 2; ++n) acc[a][b][m][n] = (f32x4){0.f, 0.f, 0.f, 0.f};
    bf16x8 At[4][2], B0[2][2], B1[2][2];
    const char* cA = (const char*)g.A + (size_t)cur.pm * tstep; const char* cB = (const char*)g.Bt + (size_t)cur.pn * tstep;
    S.a_ready(cur);
    if constexpr (SP2) {
        PG8_STAGE(PG8_SB(0, 0), cB, voffB); PG8_STAGE(PG8_SB(0, 1), cB + hstep, voffB); PG8_STAGE(PG8_SA(0, 0), cA, voffA); PG8_STAGE(PG8_SA(0, 1), cA + hstep, voffA);
        if (wr == 1) PG8_BAR;
        PG8_WAIT_V(2); PG8_BAR;
        PG8_STAGE(PG8_SB(1, 0), cB + kstep, voffB); PG8_STAGE(PG8_SA(1, 0), cA + kstep, voffA); PG8_STAGE(PG8_SB(1, 1), cB + hstep + kstep, voffB);
        PG8_WAIT_V(6); PG8_BAR;
    } else {
        PG8_STAGE(PG8_SB(0, 0), cB, voffB); PG8_STAGE(PG8_SA(0, 0), cA, voffA); PG8_STAGE(PG8_SB(0, 1), cB + hstep, voffB); PG8_STAGE(PG8_SA(0, 1), cA + hstep, voffA);
        if (wr == 1) PG8_BAR;
        PG8_WAIT_V(4); PG8_BAR;
        PG8_STAGE(PG8_SB(1, 0), cB + kstep, voffB); PG8_STAGE(PG8_SA(1, 0), cA + kstep, voffA); PG8_STAGE(PG8_SB(1, 1), cB + hstep + kstep, voffB);
        PG8_WAIT_V(6); PG8_BAR;
    }
    for (;;) {
        const bool has_next = S.next(ui + 1, nxt);
        const char* nA = has_next ? (const char*)g.A + (size_t)nxt.pm * tstep : cA; const char* nB = has_next ? (const char*)g.Bt + (size_t)nxt.pn * tstep : cB;
        for (int t = 0; t < nt; t += 2) {
            const bool last = (t == nt - 2);
            const char* a1 = cA + (size_t)(t + 1) * kstep;
            const char* a2 = last ? nA : cA + (size_t)(t + 2) * kstep; const char* b2 = last ? nB : cB + (size_t)(t + 2) * kstep;
            const char* a3 = a2 + kstep; const char* b3 = b2 + kstep;
            if (last && has_next) S.a_ready(nxt);
            if constexpr (SP2) {
            PG8_LDB(B0, 0, 0); PG8_LDB(B1, 0, 1); PG8_SCHED; PG8_LDA(At, 0, 0); PG8_STAGE(PG8_SA(1, 1), a1 + hstep, voffA);
            PG8_WAIT_V(8); PG8_WAIT_L(0); PG8_BAR; PG8_MMA(0, 0, At, B0); PG8_MMA(0, 1, At, B1); PG8_BAR; PG8_SCHED;
            PG8_LDA(At, 0, 1); PG8_STAGE(PG8_SB(0, 0), b2, voffB); PG8_STAGE(PG8_SB(0, 1), b2 + hstep, voffB); PG8_STAGE(PG8_SA(0, 0), a2, voffA);
            PG8_WAIT_V(8); PG8_WAIT_L(0); PG8_BAR; PG8_MMA(1, 0, At, B0); PG8_MMA(1, 1, At, B1); PG8_BAR; PG8_SCHED;
            PG8_LDB(B0, 1, 0); PG8_LDB(B1, 1, 1); PG8_SCHED; PG8_LDA(At, 1, 0); PG8_STAGE(PG8_SA(0, 1), a2 + hstep, voffA);
            PG8_WAIT_V(8); PG8_WAIT_L(0); PG8_BAR; PG8_MMA(0, 0, At, B0); PG8_MMA(0, 1, At, B1); PG8_BAR; PG8_SCHED;
            PG8_LDA(At, 1, 1); PG8_STAGE(PG8_SB(1, 0), b3, voffB); PG8_STAGE(PG8_SB(1, 1), b3 + hstep, voffB); PG8_STAGE(PG8_SA(1, 0), a3, voffA);
            PG8_WAIT_V(8); PG8_WAIT_L(0); PG8_BAR; PG8_MMA(1, 0, At, B0); PG8_MMA(1, 1, At, B1); PG8_BAR; PG8_SCHED;
            } else {
            PG8_LDB(B0, 0, 0); PG8_SCHED; PG8_LDA(At, 0, 0); PG8_STAGE(PG8_SA(1, 1), a1 + hstep, voffA);
            PG8_WAIT_L(8); PG8_BAR; PG8_WAIT_L(0); PG8_MMA(0, 0, At, B0); PG8_BAR; PG8_SCHED;
            PG8_LDB(B1, 0, 1); PG8_STAGE(PG8_SB(0, 0), b2, voffB);
            PG8_BAR; PG8_WAIT_L(0); PG8_MMA(0, 1, At, B1); PG8_BAR;
            PG8_LDA(At, 0, 1); PG8_STAGE(PG8_SA(0, 0), a2, voffA);
            PG8_BAR; PG8_WAIT_L(0); PG8_MMA(1, 0, At, B0); PG8_BAR; PG8_SCHED;
            PG8_STAGE(PG8_SB(0, 1), b2 + hstep, voffB);
            PG8_WAIT_V(6); PG8_BAR; PG8_MMA(1, 1, At, B1); PG8_BAR;
            PG8_LDB(B0, 1, 0); PG8_SCHED; PG8_LDA(At, 1, 0); PG8_STAGE(PG8_SA(0, 1), a2 + hstep, voffA);
            PG8_WAIT_L(8); PG8_BAR; PG8_WAIT_L(0); PG8_MMA(0, 0, At, B0); PG8_BAR; PG8_SCHED;
            PG8_LDB(B1, 1, 1); PG8_STAGE(PG8_SB(1, 0), b3, voffB);
            PG8_BAR; PG8_WAIT_L(0); PG8_MMA(0, 1, At, B1); PG8_BAR;
            PG8_LDA(At, 1, 1); PG8_STAGE(PG8_SA(1, 0), a3, voffA);
            PG8_BAR; PG8_WAIT_L(0); PG8_MMA(1, 0, At, B0); PG8_BAR; PG8_SCHED;
            PG8_STAGE(PG8_SB(1, 1), b3 + hstep, voffB);
            PG8_WAIT_V(6); PG8_BAR; PG8_MMA(1, 1, At, B1); PG8_BAR;
            }
        }
        if constexpr (ALIGN_EPI) { if (wr == 0) PG8_BAR; }
        if constexpr (!Epi::AFTER_DRAIN) { E(acc, cur, wr, wc, fr, fq); S.done(cur); }
        if (!has_next) break;
#pragma unroll
        for (int a = 0; a < 2; ++a)
#pragma unroll
            for (int b = 0; b < 2; ++b)
#pragma unroll
                for (int m = 0; m < 4; ++m)
#pragma unroll
                    for (int n = 0; n < 2; ++n) acc[a][b][m][n] = (f32x4){0.f, 0.f, 0.f, 0.f};
        cur = nxt; cA = nA; cB = nB; ++ui;
        if constexpr (ALIGN_EPI) { if (wr == 1) PG8_BAR; }
    }
    PG8_WAIT_V(0);
    if constexpr (!ALIGN_EPI) { if (wr == 0) PG8_BAR; }
    PG8_BAR;
    if constexpr (Epi::AFTER_DRAIN) { E.fused(acc, cur, wr, wc, fr, fq, lds, wid, lane); S.done(cur); }
#undef PG8_SA
#undef PG8_SB
#undef PG8_STAGE
#undef PG8_LDA
#undef PG8_LDB
#undef PG8_MMA
#undef PG8_WAIT_V
#undef PG8_WAIT_L
#undef PG8_BAR
#undef PG8_SCHED
}
}

namespace pg8 {
__host__ __device__ __forceinline__ int permk(int kl) { return 8 * ((kl & 15) >> 2) + 4 * (kl >> 4) + (kl & 3); }
struct EpiBf16Rs {
    static constexpr bool PERM = true, AFTER_DRAIN = false;
    bf16_t* O0; int ld0; int ntile0; bf16_t* O1; int ld1; size_t stride1; const float* ssq; float cs;
    __device__ __forceinline__ void operator()(const f32x4 (&acc)[2][2][4][2], const Unit& u, int wr, int wc, int fr, int fq) const {
        bf16_t* base; int ld, colt;
        if (u.pn < ntile0) { base = O0; ld = ld0; colt = u.pn * BM; }
        else { const int q = u.pn - ntile0, per = ld1 / BM; base = O1 + (size_t)(q / per) * stride1; ld = ld1; colt = (q % per) * BM; }
        const int row0 = u.pm * BM + wr * 64 + fr, col0 = colt + wc * 32 + 8 * fq;
#pragma unroll
        for (int ai = 0; ai < 2; ++ai)
#pragma unroll
            for (int m = 0; m < 4; ++m) {
                const int row = row0 + ai * HALF + m * 16;
                float sc = cs; if (ssq) sc *= rsqrtf(ssq[row] * (1.0f / 1024.0f) + 1e-6f);
                bf16_t* rowp = base + (size_t)row * ld + col0;
#pragma unroll
                for (int bj = 0; bj < 2; ++bj) { const f32x4 v0 = acc[ai][bj][m][0] * sc, v1 = acc[ai][bj][m][1] * sc;
                    u32x4 w; w.x = cvt_pk_bf16(v0[0], v0[1]); w.y = cvt_pk_bf16(v0[2], v0[3]); w.z = cvt_pk_bf16(v1[0], v1[1]); w.w = cvt_pk_bf16(v1[2], v1[3]);
                    *(u32x4*)(rowp + bj * HALF) = w; } }
    }
};
struct EpiF16Rs {
    static constexpr bool PERM = true, AFTER_DRAIN = false;
    _Float16* O; int ld; const float* ssq;
    __device__ __forceinline__ void operator()(const f32x4 (&acc)[2][2][4][2], const Unit& u, int wr, int wc, int fr, int fq) const {
        typedef _Float16 f16x8 __attribute__((ext_vector_type(8)));
        const int row0 = u.pm * BM + wr * 64 + fr, col0 = u.pn * BM + wc * 32 + 8 * fq;
#pragma unroll
        for (int ai = 0; ai < 2; ++ai)
#pragma unroll
            for (int m = 0; m < 4; ++m) {
                const int row = row0 + ai * HALF + m * 16;
                const float sc = rsqrtf(ssq[row] * (1.0f / 1024.0f) + 1e-6f);
                _Float16* rowp = O + (size_t)row * ld + col0;
#pragma unroll
                for (int bj = 0; bj < 2; ++bj) { const f32x4 v0 = acc[ai][bj][m][0] * sc, v1 = acc[ai][bj][m][1] * sc;
                    f16x8 w; w[0] = (_Float16)v0[0]; w[1] = (_Float16)v0[1]; w[2] = (_Float16)v0[2]; w[3] = (_Float16)v0[3];
                    w[4] = (_Float16)v1[0]; w[5] = (_Float16)v1[1]; w[6] = (_Float16)v1[2]; w[7] = (_Float16)v1[3];
                    *(f16x8*)(rowp + bj * HALF) = w; } }
    }
};
template <bool BASE_F32> struct EpiResidBf {
    static constexpr bool PERM = true, AFTER_DRAIN = false;
    const float* basef; bf16_t* xb; float* ssq;
    __device__ __forceinline__ void operator()(const f32x4 (&acc)[2][2][4][2], const Unit& u, int wr, int wc, int fr, int fq) const {
        const int row0 = u.pm * BM + wr * 64 + fr, col0 = u.pn * BM + wc * 32 + 8 * fq;
#pragma unroll
        for (int ai = 0; ai < 2; ++ai)
#pragma unroll
            for (int m = 0; m < 4; ++m) {
                const int row = row0 + ai * HALF + m * 16; const size_t off = (size_t)row * 1024 + col0; float s = 0.f;
#pragma unroll
                for (int bj = 0; bj < 2; ++bj) { const size_t o2 = off + bj * HALF;
                    f32x4 b0, b1;
                    if (BASE_F32) { b0 = *(const f32x4*)(basef + o2); b1 = *(const f32x4*)(basef + o2 + 4); }
                    else { const u32x4 p = *(const u32x4*)(xb + o2);
                        b0 = (f32x4){__builtin_bit_cast(float, p.x << 16), __builtin_bit_cast(float, p.x & 0xffff0000u), __builtin_bit_cast(float, p.y << 16), __builtin_bit_cast(float, p.y & 0xffff0000u)};
                        b1 = (f32x4){__builtin_bit_cast(float, p.z << 16), __builtin_bit_cast(float, p.z & 0xffff0000u), __builtin_bit_cast(float, p.w << 16), __builtin_bit_cast(float, p.w & 0xffff0000u)}; }
                    const f32x4 o0 = b0 + acc[ai][bj][m][0], o1 = b1 + acc[ai][bj][m][1];
                    s += ((o0[0] * o0[0] + o0[1] * o0[1]) + (o0[2] * o0[2] + o0[3] * o0[3])) + ((o1[0] * o1[0] + o1[1] * o1[1]) + (o1[2] * o1[2] + o1[3] * o1[3]));
                    u32x4 w; w.x = cvt_pk_bf16(o0[0], o0[1]); w.y = cvt_pk_bf16(o0[2], o0[3]); w.z = cvt_pk_bf16(o1[0], o1[1]); w.w = cvt_pk_bf16(o1[2], o1[3]);
                    *(u32x4*)(xb + o2) = w; }
                s += __shfl_xor(s, 16); s += __shfl_xor(s, 32);
                if (fq == 0) atomicAdd(ssq + row, s);
            }
    }
};
struct EpiKV {
    static constexpr bool PERM = false, AFTER_DRAIN = false;
    bf16_t* Kb; bf16_t* VTp;
    __device__ __forceinline__ void operator()(const f32x4 (&acc)[2][2][4][2], const Unit& u, int wr, int wc, int fr, int fq) const {
        typedef unsigned u32x2v __attribute__((ext_vector_type(2)));
        const int row0 = u.pm * BM + wr * 64 + fr, col0 = u.pn * BM + wc * 32 + 4 * fq;
#pragma unroll
        for (int ai = 0; ai < 2; ++ai)
#pragma unroll
            for (int m = 0; m < 4; ++m) {
                const int row = row0 + ai * HALF + m * 16, b = row >> 8, key = row & 255;
#pragma unroll
                for (int bj = 0; bj < 2; ++bj)
#pragma unroll
                    for (int n = 0; n < 2; ++n) { const int col = col0 + bj * HALF + n * 16; const f32x4 v = acc[ai][bj][m][n];
                        const unsigned p01 = cvt_pk_bf16(v[0], v[1]), p23 = cvt_pk_bf16(v[2], v[3]);
                        if (col < 1024) { const int h = col >> 8, dh = col & 255; u32x2v w; w.x = p01; w.y = p23;
                            *(u32x2v*)(Kb + ((size_t)((b * 4 + h) * 256 + key)) * 256 + dh) = w; }
                        else { const int c2 = col - 1024, h = c2 >> 8, dv = c2 & 255, kp = (key & ~31) | permk(key & 31);
                            bf16_t* d = VTp + ((size_t)((b * 4 + h) * 256 + dv)) * 256 + kp;
                            d[0] = (bf16_t)(p01 & 0xffffu); d[256] = (bf16_t)(p01 >> 16); d[512] = (bf16_t)(p23 & 0xffffu); d[768] = (bf16_t)(p23 >> 16); } }
            }
    }
};
}
#ifndef PG8_SP2
#define PG8_SP2 true
#endif
#ifndef PG8_ALIGN
#define PG8_ALIGN true
#endif

constexpr int NWAVES = 8;
#ifndef MK_PER_PHASE
#define MK_PER_PHASE 0
#endif
constexpr int T = 16384, SEQ = 8192, D = 1024;
constexpr int N_PHASES = 12;

constexpr size_t MiB = 1u << 20, KiB = 1u << 10;
constexpr size_t WS_CTL = 0, CTL_ZERO_BYTES = 1 * MiB;
constexpr int CW_BAR = 4096;
constexpr size_t WS_SSQ1 = 64 * KiB, WS_SSQ2 = 128 * KiB;
constexpr size_t WS_AB = 1 * MiB;
constexpr size_t WS_HEND = WS_AB + 512 * KiB, WS_PEND = WS_HEND + 512 * KiB, WS_HIN = WS_PEND + 512 * KiB;
constexpr size_t WS_DEC = WS_HIN + 512 * KiB;
constexpr size_t WS_SUBK = 3 * MiB + 256 * KiB;
constexpr size_t WS_WIN = 4 * MiB, WS_WOUT = 10 * MiB, WS_WQ = 12 * MiB, WS_WKV = 14 * MiB, WS_WO = 18 * MiB, WS_PWQ = 20 * MiB;
constexpr size_t WS_MEMN = 24 * MiB, WS_KB = 25 * MiB, WS_VTP = 26 * MiB, WS_LRUWT = 27 * MiB, WS_USC = 27 * MiB + 256 * KiB, WS_VSC = 27 * MiB + 384 * KiB;
constexpr size_t WS_XB = 28 * MiB;
constexpr size_t WS_HLOC = 28 * MiB, WS_PCUM = 44 * MiB;
constexpr size_t WS_QKV = 60 * MiB;
constexpr size_t OUT_Y = 4 * MiB;
constexpr size_t OUT_END = OUT_Y + (size_t)16384 * 1024 * 2;
constexpr size_t WS_IDX = 60 * MiB, WS_GW = 68 * MiB;
constexpr size_t WS_UB = 60 * MiB;
constexpr size_t WS_XR = 108 * MiB, WS_Z = 124 * MiB, WS_GATE = 140 * MiB;
constexpr size_t WS_WN = 156 * MiB, WS_UF = 172 * MiB, WS_QD = 188 * MiB, WS_KD = 204 * MiB, WS_ATT = 220 * MiB;
constexpr size_t WS_VB = 228 * MiB;
constexpr size_t WS_Q = 188 * MiB, WS_AO = 124 * MiB;
constexpr size_t WS_PQ = 108 * MiB;
constexpr size_t WS_END = 244 * MiB;
constexpr int CW_GFLAG = 49152;
constexpr int CW_LRUCNT = 8192;
static_assert(WS_XR - WS_QKV == (size_t)T * 1536 * 2 && WS_Z - WS_XR == (size_t)T * 512 * 2 && WS_GATE - WS_Z == (size_t)T * 512 * 2, "in-proj outputs are contiguous");

constexpr int LDS_BYTES = 160 * 1024;
constexpr int MISC_OFF = 159 * 1024;

#define GAS __attribute__((address_space(1)))
#define LAS __attribute__((address_space(3)))
typedef unsigned short bf16;
typedef unsigned v4u __attribute__((ext_vector_type(4)));
typedef unsigned v2u __attribute__((ext_vector_type(2)));
typedef float f32x4 __attribute__((ext_vector_type(4)));
typedef short bf16x8 __attribute__((ext_vector_type(8)));
typedef GAS unsigned gu32;
#define LDS_WAIT() asm volatile("s_waitcnt lgkmcnt(0)" ::: "memory")
__device__ __forceinline__ void st16_wt(void* p, v4u v) { asm volatile("global_store_dwordx4 %0, %1, off sc0 sc1\n\ts_nop 1" :: "v"(p), "v"(v) : "memory"); }
__device__ __forceinline__ unsigned f2bf(float f) { unsigned u = __builtin_bit_cast(unsigned, f); return (u + 0x7fffu + ((u >> 16) & 1u)) >> 16; }
__device__ __forceinline__ unsigned pk2(float lo, float hi) { return f2bf(lo) | (f2bf(hi) << 16); }
__device__ __forceinline__ float bflo(unsigned u) { return __builtin_bit_cast(float, u << 16); }
__device__ __forceinline__ float bfhi(unsigned u) { return __builtin_bit_cast(float, u & 0xffff0000u); }
__device__ __forceinline__ float bf1(bf16 h) { return __builtin_bit_cast(float, (unsigned)h << 16); }
__device__ __forceinline__ float wave_sum(float v) {
#pragma unroll
    for (int o = 1; o < 64; o <<= 1) v += __shfl_xor(v, o);
    return v;
}
__device__ __forceinline__ float row16_sum(float v) {
    v += __builtin_bit_cast(float, __builtin_amdgcn_update_dpp(0, __builtin_bit_cast(int, v), 0xB1, 0xF, 0xF, true));
    v += __builtin_bit_cast(float, __builtin_amdgcn_update_dpp(0, __builtin_bit_cast(int, v), 0x4E, 0xF, 0xF, true));
    v += __builtin_bit_cast(float, __builtin_amdgcn_update_dpp(0, __builtin_bit_cast(int, v), 0x141, 0xF, 0xF, true));
    v += __builtin_bit_cast(float, __builtin_amdgcn_update_dpp(0, __builtin_bit_cast(int, v), 0x140, 0xF, 0xF, true));
    return v;
}
__device__ __forceinline__ float sigmoidf_(float x) { return __builtin_amdgcn_rcpf(1.0f + __expf(-x)); }
__device__ __forceinline__ float softplusf_(float x) { return fmaxf(x, 0.f) + log1pf(__expf(-fabsf(x))); }
__device__ __forceinline__ float siluf_(float x) { return x * __builtin_amdgcn_rcpf(1.0f + __expf(-x)); }
__device__ __forceinline__ float gelu_tanh(float x) { const float y = 0.7978845608028654f * (x + 0.044715f * x * x * x); const float e = __expf(2.0f * y); return x * (1.0f - __builtin_amdgcn_rcpf(1.0f + e)); }
__device__ __forceinline__ int permk(int kl) { return 8 * ((kl & 15) >> 2) + 4 * (kl >> 4) + (kl & 3); }

struct Params {
    const float *x, *mem, *norm_mix_w, *w_in, *conv_qkv_w, *gdn_a_log, *gdn_dt_bias, *gdn_norm_w, *lru_conv_w, *lru_conv_b, *lru_wa, *lru_ba, *lru_wx, *lru_bx, *lru_lambda, *w_out,
                *norm_xattn_w, *norm_mem_w, *xattn_wq, *xattn_wkv, *xattn_wo, *norm_ffn_w, *peer_wq, *peer_subkeys, *peer_u, *peer_v, *norm_final_w;
    float* out; unsigned char* ws; int ph_lo, ph_hi;
};
#define XB_TMO      128
#define XB_XCNT(j)  (256  + 64 * (j))
#define XB_XSUB(j)  (1280 + 64 * (j))
#define XB_XGEN(j)  (2304 + 64 * (j))
#define XB_TOP      3328
#define XB_TOPGEN   3392
#define XCD_BAR_WORDS 3456
#define XB_SPIN_CAP (1u << 18)

__device__ __forceinline__ unsigned xb_ld(unsigned* p)              { return __hip_atomic_load(p, __ATOMIC_RELAXED, __HIP_MEMORY_SCOPE_AGENT); }
__device__ __forceinline__ unsigned xb_add(unsigned* p, unsigned v) { return __hip_atomic_fetch_add(p, v, __ATOMIC_RELAXED, __HIP_MEMORY_SCOPE_AGENT); }
__device__ __forceinline__ unsigned xb_xcc_id() { return (unsigned)__builtin_amdgcn_s_getreg((3 << 11) | 20) & 0xFu; }
#define XB_SPIN(cond, bar) do { unsigned _sp = 0; while (cond) { __builtin_amdgcn_s_sleep(1); \
    if ((++_sp & 255u) == 0u) { if (xb_ld(&(bar)[XB_TMO])) break; if (_sp > XB_SPIN_CAP) { atomicAdd(&(bar)[XB_TMO], 1u); break; } } } } while (0)

struct XcdBarrier {
    unsigned* bar; unsigned x;
    volatile LAS unsigned* st;
};

__device__ __forceinline__ XcdBarrier xcd_barrier_post(unsigned* bar, volatile LAS unsigned* st) {
    XcdBarrier b; b.bar = bar; b.x = xb_xcc_id(); b.st = st;
    if (threadIdx.x == 0) (void)xb_add(&bar[XB_XCNT(b.x)], 1u);
    return b;
}
__device__ __forceinline__ void xcd_barrier_complete(unsigned* bar, unsigned x, unsigned& nloc, unsigned& nx) {
    const unsigned G = gridDim.x * gridDim.y * gridDim.z;
    unsigned sum, cnt, mine, sp = 0u;
    for (;;) {
        sum = 0u; cnt = 0u; mine = 0u;
#pragma unroll
        for (unsigned j = 0; j < 16; ++j) { const unsigned c = xb_ld(&bar[XB_XCNT(j)]); sum += c; cnt += (c > 0u) ? 1u : 0u; mine = (j == x) ? c : mine; }
        if (sum == G) break;
        __builtin_amdgcn_s_sleep(1);
        if ((++sp & 255u) == 0u) { if (xb_ld(&bar[XB_TMO])) break; if (sp > XB_SPIN_CAP) { atomicAdd(&bar[XB_TMO], 1u); break; } }
    }
    nloc = mine > 0u ? mine : 1u; nx = cnt > 0u ? cnt : 1u;
}

__device__ __forceinline__ void xcd_barrier(const XcdBarrier& b) {
    asm volatile("s_waitcnt vmcnt(0)" ::: "memory");
    __syncthreads();
    if (threadIdx.x == 0) {
        unsigned* bar = b.bar;
        __builtin_amdgcn_s_waitcnt(0);
        unsigned nloc = b.st[0], nx = b.st[1];
        if (nloc == 0u) { xcd_barrier_complete(bar, b.x, nloc, nx); b.st[0] = nloc; b.st[1] = nx; }
        const unsigned old = xb_add(&bar[XB_XSUB(b.x)], 1u);
        const unsigned gen = old / nloc;
        if (old + 1u == (gen + 1u) * nloc) {
            __builtin_amdgcn_fence(__ATOMIC_RELEASE, "agent");
            asm volatile("s_waitcnt vmcnt(0)" ::: "memory");
            const unsigned og = xb_add(&bar[XB_TOP], 1u);
            const unsigned tg = og / nx;
            if (og + 1u == (tg + 1u) * nx) xb_add(&bar[XB_TOPGEN], 1u);
            else XB_SPIN(xb_ld(&bar[XB_TOPGEN]) == tg, bar);
            __builtin_amdgcn_fence(__ATOMIC_ACQUIRE, "agent");
            xb_add(&bar[XB_XGEN(b.x)], 1u);
            asm volatile("s_waitcnt vmcnt(0)" ::: "memory");
        } else {
            XB_SPIN(xb_ld(&bar[XB_XGEN(b.x)]) == gen, bar);
            __builtin_amdgcn_fence(__ATOMIC_ACQUIRE, "agent");
            asm volatile("s_waitcnt vmcnt(0)" ::: "memory");
        }
    }
    __syncthreads();
}

__device__ __forceinline__ void p0_transpose_item(const float* W, int K, int ldw, int c0, int nblk, bf16* WT, int row_off, const float* ks, LAS float* scr, int item, int lane) {
    const int kb = item / nblk, nb = item % nblk, k0 = 64 * kb, n0 = 32 * nb;
#pragma unroll 8
    for (int i = 0; i < 32; ++i) { const int kk = 2 * i + (lane >> 5); float v = W[(size_t)(k0 + kk) * ldw + c0 + n0 + (lane & 31)]; if (ks) v *= ks[k0 + kk]; scr[kk * 33 + (lane & 31)] = v; }
    LDS_WAIT(); asm volatile("" ::: "memory");
    const int c = lane & 7;
#pragma unroll
    for (int j = 0; j < 4; ++j) { const int n = (lane >> 3) + 8 * j; const LAS float* s = scr + (8 * c) * 33 + n;
        v4u o; o.x = pk2(s[0 * 33], s[1 * 33]); o.y = pk2(s[2 * 33], s[3 * 33]); o.z = pk2(s[4 * 33], s[5 * 33]); o.w = pk2(s[6 * 33], s[7 * 33]);
        *(GAS v4u*)(WT + (size_t)(row_off + n0 + n) * K + k0 + 8 * c) = o; }
    LDS_WAIT(); asm volatile("" ::: "memory");
}

__device__ __forceinline__ void p0_prologue(const Params& P, LAS unsigned char* lds, int tid, int lane, int wave, int vcu, int G) {
    unsigned char* ws = P.ws;
    const int gw = vcu * NWAVES + wave, NGW = G * NWAVES;
    LAS float* wabl = (LAS float*)lds;
    for (int idx = tid; idx < 8192; idx += NWAVES * 64) { const int k = idx >> 3, c = idx & 7, j = k >> 8, l = (k >> 2) & 63, e = k & 3;
        wabl[((((j * 4 + e) * 2 + (c >> 2)) * 64 + l) << 2) + (c & 3)] = P.w_in[(size_t)k * 3080 + 2048 + c]; }
    __syncthreads();
    {
        bf16* XB0 = (bf16*)(ws + WS_XB); float* AB = (float*)(ws + WS_AB);
        f32x4 w4[4];
#pragma unroll
        for (int j = 0; j < 4; ++j) w4[j] = ((const f32x4*)P.norm_mix_w)[64 * j + lane];
        for (int m = gw; m < T; m += NGW) {
            const f32x4* xr = (const f32x4*)(P.x + (size_t)m * D) + lane;
            f32x4 v[4]; float s = 0.f;
#pragma unroll
            for (int j = 0; j < 4; ++j) { v[j] = xr[64 * j]; s += (v[j].x * v[j].x + v[j].y * v[j].y) + (v[j].z * v[j].z + v[j].w * v[j].w); }
            const float rstd = rsqrtf(wave_sum(s) * (1.0f / D) + 1e-6f);
            v2u* o8 = (v2u*)(XB0 + (size_t)m * D) + lane;
            float part[8];
#pragma unroll
            for (int c = 0; c < 8; ++c) part[c] = 0.f;
#pragma unroll
            for (int j = 0; j < 4; ++j) {
                v[j] = v[j] * rstd * w4[j];
                v2u o; o.x = pk2(v[j].x, v[j].y); o.y = pk2(v[j].z, v[j].w); o8[64 * j] = o;
#pragma unroll
                for (int e = 0; e < 4; ++e) {
                    const f32x4 wa = *(const LAS f32x4*)(wabl + ((((j * 4 + e) * 2 + 0) * 64 + lane) << 2));
                    const f32x4 wb = *(const LAS f32x4*)(wabl + ((((j * 4 + e) * 2 + 1) * 64 + lane) << 2));
                    const float hv = v[j][e];
                    part[0] += hv * wa.x; part[1] += hv * wa.y; part[2] += hv * wa.z; part[3] += hv * wa.w;
                    part[4] += hv * wb.x; part[5] += hv * wb.y; part[6] += hv * wb.z; part[7] += hv * wb.w;
                }
            }
#pragma unroll
            for (int c = 0; c < 8; ++c) part[c] = wave_sum(part[c]);
            float o = part[0];
#pragma unroll
            for (int c = 1; c < 8; ++c) o = (lane == c) ? part[c] : o;
            if (lane < 8) AB[(size_t)m * 8 + lane] = o;
        }
    }
    {
        bf16* MEMN = (bf16*)(ws + WS_MEMN);
        for (int m = gw; m < 512; m += NGW) {
            const f32x4* xr = (const f32x4*)(P.mem + (size_t)m * D) + lane;
            f32x4 v[4]; float s = 0.f;
#pragma unroll
            for (int j = 0; j < 4; ++j) { v[j] = xr[64 * j]; s += (v[j].x * v[j].x + v[j].y * v[j].y) + (v[j].z * v[j].z + v[j].w * v[j].w); }
            const float rstd = rsqrtf(wave_sum(s) * (1.0f / D) + 1e-6f);
            v2u* o8 = (v2u*)(MEMN + (size_t)m * D) + lane;
#pragma unroll
            for (int j = 0; j < 4; ++j) { const f32x4 w = ((const f32x4*)P.norm_mem_w)[64 * j + lane]; const f32x4 y = v[j] * rstd * w;
                v2u o; o.x = pk2(y.x, y.y); o.y = pk2(y.z, y.w); o8[64 * j] = o; }
        }
    }
    __syncthreads();
    {
        LAS float* scr = (LAS float*)(lds + wave * 16384);
        constexpr int I_IN1 = 16 * 48, I_IN2 = 16 * 16, I_KV = 16 * 64;
        constexpr int NITEMS = I_IN1 + 3 * I_IN2 + I_KV;
        for (int it = gw; it < NITEMS; it += NGW) {
            int r = it;
            if (r < I_IN1) { p0_transpose_item(P.w_in, 1024, 3080, 0, 48, (bf16*)(ws + WS_WIN), 0, nullptr, scr, r, lane); continue; } r -= I_IN1;
            if (r < I_IN2) { p0_transpose_item(P.w_in, 1024, 3080, 2056, 16, (bf16*)(ws + WS_WIN), 1536, nullptr, scr, r, lane); continue; } r -= I_IN2;
            if (r < I_IN2) { p0_transpose_item(P.w_in, 1024, 3080, 1536, 16, (bf16*)(ws + WS_WIN), 2048, nullptr, scr, r, lane); continue; } r -= I_IN2;
            if (r < I_IN2) { p0_transpose_item(P.w_in, 1024, 3080, 2568, 16, (bf16*)(ws + WS_WIN), 2560, nullptr, scr, r, lane); continue; } r -= I_IN2;
            p0_transpose_item(P.xattn_wkv, 1024, 2048, 0, 64, (bf16*)(ws + WS_WKV), 0, nullptr, scr, r, lane);
        }
    }
    {
        bf16* WT = (bf16*)(ws + WS_LRUWT);
        for (int it = vcu * NWAVES * 64 + tid; it < 8 * 2 * 64 * 8; it += G * NWAVES * 64) {
            const int i8 = it & 7, j = (it >> 3) & 63, m = (it >> 9) & 1, g = it >> 10;
            const float* src = (m ? P.lru_wx : P.lru_wa) + (size_t)(g * 64 + 8 * i8) * 64 + j;
            v4u o; o.x = pk2(src[0], src[64]); o.y = pk2(src[128], src[192]); o.z = pk2(src[256], src[320]); o.w = pk2(src[384], src[448]);
            *(v4u*)(WT + (size_t)it * 8) = o;
        }
    }
}

__device__ __forceinline__ void late_weight_prep(const Params& P, LAS unsigned char* lds, int lane, int wave, int gw, int NGW) {
    unsigned char* ws = P.ws;
    {
        LAS float* scr = (LAS float*)(lds + wave * 16384);
        constexpr int I_OUT = 16 * 32, I_Q = 16 * 32, I_O = 16 * 32;
        for (int it = gw; it < I_OUT + I_Q + I_O; it += NGW) {
            int r = it;
            if (r < I_OUT) { p0_transpose_item(P.w_out, 1024, 1024, 0, 32, (bf16*)(ws + WS_WOUT), 0, nullptr, scr, r, lane); continue; } r -= I_OUT;
            if (r < I_Q) { p0_transpose_item(P.xattn_wq, 1024, 1024, 0, 32, (bf16*)(ws + WS_WQ), 0, P.norm_xattn_w, scr, r, lane); continue; } r -= I_Q;
            p0_transpose_item(P.xattn_wo, 1024, 1024, 0, 32, (bf16*)(ws + WS_WO), 0, nullptr, scr, r, lane);
        }
    }
    {
        bf16* WF = (bf16*)(ws + WS_PWQ);
        const int col = lane & 15, g = lane >> 4;
        for (int it = gw; it < 16 * 64; it += NGW) {
            const int hp = it >> 6, k0 = (it & 63) * 16;
            bf16x8 bq[4];
#pragma unroll
            for (int s = 0; s < 4; ++s) { const f32x4* src = (const f32x4*)(P.peer_wq + (size_t)(k0 + col) * 2048 + hp * 128 + 32 * s + 8 * g);
                const f32x4 a = src[0], c = src[1]; v4u pk; pk.x = pk2(a.x, a.y); pk.y = pk2(a.z, a.w); pk.z = pk2(c.x, c.y); pk.w = pk2(c.z, c.w); bq[s] = __builtin_bit_cast(bf16x8, pk); }
            const float nw = P.norm_ffn_w[k0 + col];
#pragma unroll 2
            for (int kt = 0; kt < 8; ++kt) {
                f32x4 acc = (f32x4){0.f, 0.f, 0.f, 0.f};
#pragma unroll
                for (int s = 0; s < 4; ++s) { const f32x4* src = (const f32x4*)(P.peer_subkeys + (size_t)(hp * 128 + 16 * kt + col) * 128 + 32 * s + 8 * g);
                    const f32x4 a = src[0], c = src[1]; v4u pk; pk.x = pk2(a.x, a.y); pk.y = pk2(a.z, a.w); pk.z = pk2(c.x, c.y); pk.w = pk2(c.z, c.w);
                    acc = __builtin_amdgcn_mfma_f32_16x16x32_bf16(__builtin_bit_cast(bf16x8, pk), bq[s], acc, 0, 0, 0); }
#pragma unroll
                for (int i = 0; i < 4; ++i) WF[(size_t)(hp * 128 + 16 * kt + 4 * g + i) * 1024 + k0 + col] = (bf16)f2bf(acc[i] * nw);
            }
        }
    }
}

constexpr int GL_KS = 0, GL_VS = 33792, GL_KB = 67584, GL_QB = 84992, GL_RAW = 102400, GL_CW = 153856, GL_AMT = 133120, GL_SM = 160000, GL_ATT = 151808, GL_SOL = 67584;
static_assert(GL_CW + 6144 <= GL_SM && GL_SM + 1284 <= MISC_OFF && GL_SOL + 65536 <= GL_AMT && GL_AMT + 17408 <= GL_ATT && GL_ATT + 8192 <= GL_SM && GL_RAW + 51456 <= GL_CW, "gdn_local LDS map");
#ifndef GL_REP_STEP
#define GL_REP_STEP -1
#endif
#define GL_REPF(k) for (int rr_ = 0; rr_ < ((GL_REP_STEP == (k)) ? 2 : 1); ++rr_)
#define GL_BAR() do { asm volatile("s_waitcnt lgkmcnt(0)" ::: "memory"); __builtin_amdgcn_s_barrier(); asm volatile("" ::: "memory"); } while (0)
__device__ __forceinline__ void gdn_local_item(const Params& P, LAS unsigned char* lds, int item, int tid) {
    unsigned char* ws = P.ws;
    asm volatile("" : "+v"(tid));
    const int b = item >> 9, h = (item >> 7) & 3, n = item & 127;
    const int t0 = b * SEQ + n * 64;
    const int lane = tid & 63, wave = __builtin_amdgcn_readfirstlane(tid >> 6);
    LAS float* ks = (LAS float*)(lds + GL_KS);
    LAS float* vs = (LAS float*)(lds + GL_VS);
    LAS bf16* kb16 = (LAS bf16*)(lds + GL_KB);
    LAS bf16* qb16 = (LAS bf16*)(lds + GL_QB);
    LAS bf16* raw = (LAS bf16*)(lds + GL_RAW);
    LAS float* cw = (LAS float*)(lds + GL_CW);
    LAS float* AmT = (LAS float*)(lds + GL_AMT);
    LAS float* sg = (LAS float*)(lds + GL_SM);
    LAS float* sbeta = sg + 64; LAS float* sgc = sbeta + 64; LAS float* seg = sgc + 64; LAS float* sek = seg + 64;
    LAS bf16* atts = (LAS bf16*)(lds + GL_ATT);
    const bf16* QKV = (const bf16*)(ws + WS_QKV);
    const float* AB = (const float*)(ws + WS_AB);
    GL_REPF(0) {
        v4u pr[7];
#pragma unroll
        for (int r = 0; r < 7; ++r) {
            const int id = tid + 512 * r;
            const int row = id / 48, rem = id - row * 48, part = rem >> 4, ck = rem & 15, s = n * 64 + row - 3;
            pr[r] = (v4u){0u, 0u, 0u, 0u};
            if (id < 67 * 48 && s >= 0) pr[r] = *(const v4u*)(QKV + (size_t)(b * SEQ + s) * 1536 + part * 512 + h * 128 + ck * 8);
        }
        f32x4 cwv = (f32x4){0.f, 0.f, 0.f, 0.f};
        if (tid < 384) { const int j = tid / 96, rem = tid - j * 96, part = rem >> 5, c4 = rem & 31; cwv = *(const f32x4*)(P.conv_qkv_w + j * 1536 + part * 512 + h * 128 + c4 * 4); }
        float a_in = 0.f, b_in = 0.f;
        if (tid < 64) { a_in = AB[(size_t)(t0 + tid) * 8 + h]; b_in = AB[(size_t)(t0 + tid) * 8 + 4 + h]; }
#pragma unroll
        for (int r = 0; r < 7; ++r) { const int id = tid + 512 * r; if (id < 67 * 48) *(LAS v4u*)(raw + id * 8) = pr[r]; }
        if (tid < 384) *(LAS f32x4*)(cw + tid * 4) = cwv;
        if (tid < 64) { sg[tid] = -__expf(P.gdn_a_log[h]) * softplusf_(a_in + P.gdn_dt_bias[h]); sbeta[tid] = sigmoidf_(b_in); }
    }
    GL_BAR();
    GL_REPF(1) {
        const int c = tid >> 3, grp = tid & 7;
#pragma unroll 1
        for (int part = 0; part < 3; ++part) {
            float y[16];
#pragma unroll
            for (int i = 0; i < 16; ++i) y[i] = 0.f;
#pragma unroll
            for (int j = 0; j < 4; ++j) {
                const LAS v4u* src = (const LAS v4u*)(raw + (c + j) * 384 + part * 128 + grp * 16);
                const v4u x0 = src[0], x1 = src[1];
                const LAS f32x4* wp = (const LAS f32x4*)(cw + (j * 3 + part) * 128 + grp * 16);
                const f32x4 w0 = wp[0], w1 = wp[1], w2 = wp[2], w3 = wp[3];
                y[0] += w0.x * bflo(x0.x); y[1] += w0.y * bfhi(x0.x); y[2] += w0.z * bflo(x0.y); y[3] += w0.w * bfhi(x0.y);
                y[4] += w1.x * bflo(x0.z); y[5] += w1.y * bfhi(x0.z); y[6] += w1.z * bflo(x0.w); y[7] += w1.w * bfhi(x0.w);
                y[8] += w2.x * bflo(x1.x); y[9] += w2.y * bfhi(x1.x); y[10] += w2.z * bflo(x1.y); y[11] += w2.w * bfhi(x1.y);
                y[12] += w3.x * bflo(x1.z); y[13] += w3.y * bfhi(x1.z); y[14] += w3.z * bflo(x1.w); y[15] += w3.w * bfhi(x1.w);
            }
            float ss = 0.f;
#pragma unroll
            for (int i = 0; i < 16; ++i) { y[i] = siluf_(y[i]); ss += y[i] * y[i]; }
            if (part < 2) {
                ss += __shfl_xor(ss, 1); ss += __shfl_xor(ss, 2); ss += __shfl_xor(ss, 4);
                const float sc = rsqrtf(ss + 1e-6f) * (part == 0 ? 0.08838834764831845f : 1.0f);
#pragma unroll
                for (int i = 0; i < 16; ++i) y[i] *= sc;
            }
            if (part >= 1) {
                LAS float* dst = (part == 1 ? ks : vs) + c * 132 + grp * 16;
#pragma unroll
                for (int i = 0; i < 4; ++i) *(LAS f32x4*)(dst + 4 * i) = (f32x4){y[4 * i], y[4 * i + 1], y[4 * i + 2], y[4 * i + 3]};
            }
            if (part <= 1) {
                LAS bf16* dst = (part == 0 ? qb16 : kb16) + c * 136 + grp * 16;
                v4u o0, o1; o0.x = pk2(y[0], y[1]); o0.y = pk2(y[2], y[3]); o0.z = pk2(y[4], y[5]); o0.w = pk2(y[6], y[7]);
                o1.x = pk2(y[8], y[9]); o1.y = pk2(y[10], y[11]); o1.z = pk2(y[12], y[13]); o1.w = pk2(y[14], y[15]);
                *(LAS v4u*)dst = o0; *(LAS v4u*)(dst + 8) = o1;
            }
        }
    }
    if (tid < 64) {
        float v = sg[tid];
#pragma unroll
        for (int off = 1; off < 64; off <<= 1) { const float t = __shfl_up(v, off); if (tid >= off) v += t; }
        sgc[tid] = v; seg[tid] = __expf(v);
        const float gl = __shfl(v, 63);
        sek[tid] = __expf(gl - v);
        if (tid == 63) sek[64] = __expf(v);
    }
    GL_BAR();
    {
        const int mat = wave >> 2, rho = wave & 3, col = lane & 15, g = lane >> 4;
        const LAS bf16* X = mat ? qb16 : kb16;
        bf16x8 af[4];
#pragma unroll
        for (int s = 0; s < 4; ++s) af[s] = *(const LAS bf16x8*)(X + (16 * rho + col) * 136 + 32 * s + 8 * g);
#pragma unroll
        for (int sig = 0; sig < 4; ++sig) {
            f32x4 acc = (f32x4){0.f, 0.f, 0.f, 0.f};
#pragma unroll
            for (int s = 0; s < 4; ++s) { const bf16x8 bfr = *(const LAS bf16x8*)(kb16 + (16 * sig + col) * 136 + 32 * s + 8 * g); acc = __builtin_amdgcn_mfma_f32_16x16x32_bf16(af[s], bfr, acc, 0, 0, 0); }
            const int sidx = 16 * sig + col; const float gs = sgc[sidx];
#pragma unroll
            for (int i = 0; i < 4; ++i) {
                const int c = 16 * rho + 4 * g + i;
                const float dec = (c >= sidx) ? __expf(sgc[c] - gs) : 0.f;
                if (mat == 0) AmT[sidx * 68 + c] = (c > sidx) ? sbeta[c] * acc[i] * dec : 0.f;
                else atts[c * 64 + sidx] = (bf16)f2bf(acc[i] * dec);
            }
        }
    }
    GL_BAR();
    GL_REPF(4) {
        bf16* QD = (bf16*)(ws + WS_QD) + (size_t)item * 8192;
        bf16* KD = (bf16*)(ws + WS_KD) + (size_t)item * 8192;
        bf16* ATT = (bf16*)(ws + WS_ATT) + (size_t)item * 4096;
#pragma unroll
        for (int r = 0; r < 2; ++r) {
            const int id = tid + 512 * r;
            { const int c = id >> 4, gam = id & 15, s32 = gam >> 2, g = gam & 3;
              const v2u lo = *(const LAS v2u*)(qb16 + c * 136 + 32 * s32 + 4 * g), hi = *(const LAS v2u*)(qb16 + c * 136 + 32 * s32 + 16 + 4 * g);
              const float e = seg[c];
              v4u o; o.x = pk2(bflo(lo.x) * e, bfhi(lo.x) * e); o.y = pk2(bflo(lo.y) * e, bfhi(lo.y) * e); o.z = pk2(bflo(hi.x) * e, bfhi(hi.x) * e); o.w = pk2(bflo(hi.y) * e, bfhi(hi.y) * e);
              st16_wt(QD + c * 128 + 8 * gam, o); }
            { const int dk = id >> 3, gam = id & 7, s32 = gam >> 2, g = gam & 3, c0 = 32 * s32 + 4 * g;
              float v[8];
#pragma unroll
              for (int j = 0; j < 4; ++j) { v[j] = ks[(c0 + j) * 132 + dk] * sek[c0 + j]; v[4 + j] = ks[(c0 + 16 + j) * 132 + dk] * sek[c0 + 16 + j]; }
              v4u o; o.x = pk2(v[0], v[1]); o.y = pk2(v[2], v[3]); o.z = pk2(v[4], v[5]); o.w = pk2(v[6], v[7]);
              st16_wt(KD + dk * 64 + 8 * gam, o); }
        }
        { const int c = tid >> 3, gam = tid & 7, s32 = gam >> 2, g = gam & 3;
          const v2u lo = *(const LAS v2u*)(atts + c * 64 + 32 * s32 + 4 * g), hi = *(const LAS v2u*)(atts + c * 64 + 32 * s32 + 16 + 4 * g);
          v4u o; o.x = lo.x; o.y = lo.y; o.z = hi.x; o.w = hi.y;
          st16_wt(ATT + c * 64 + 8 * gam, o); }
    }
    GL_BAR();
    GL_REPF(5) {
        LAS float* xcol = (LAS float*)(lds + GL_SOL);
        LAS bf16* tinv = (LAS bf16*)(lds + GL_SOL + 17408);
        const int j = tid >> 3, part = tid & 7, jb = j >> 4, jo = j & 15;
#pragma unroll 1
        for (int rb = jb; rb < 4; ++rb) {
            float acc[16];
#pragma unroll
            for (int i = 0; i < 16; ++i) acc[i] = 0.f;
            if (rb > jb) {
#pragma unroll 2
                for (int s = 16 * jb + part; s < 16 * rb; s += 8) {
                    const float sv = xcol[j * 68 + s];
                    const LAS float* ar = AmT + s * 68 + 16 * rb;
#pragma unroll
                    for (int q = 0; q < 4; ++q) { const f32x4 A4 = *(const LAS f32x4*)(ar + 4 * q);
                        acc[4 * q] -= A4.x * sv; acc[4 * q + 1] -= A4.y * sv; acc[4 * q + 2] -= A4.z * sv; acc[4 * q + 3] -= A4.w * sv; }
                }
#pragma unroll
                for (int i = 0; i < 16; ++i) {
                    acc[i] += __builtin_bit_cast(float, __builtin_amdgcn_update_dpp(0, __builtin_bit_cast(int, acc[i]), 0xB1, 0xF, 0xF, true));
                    acc[i] += __builtin_bit_cast(float, __builtin_amdgcn_update_dpp(0, __builtin_bit_cast(int, acc[i]), 0x4E, 0xF, 0xF, true));
                    acc[i] += __builtin_bit_cast(float, __builtin_amdgcn_update_dpp(0, __builtin_bit_cast(int, acc[i]), 0x141, 0xF, 0xF, true));
                }
            } else {
#pragma unroll
                for (int i = 0; i < 16; ++i) acc[i] = (i == jo) ? 1.f : 0.f;
            }
#pragma unroll
            for (int i = 0; i < 16; ++i) {
                const float sv = acc[i];
                const LAS float* ar = AmT + (16 * rb + i) * 68 + 16 * rb;
#pragma unroll
                for (int q = (i + 1) / 4; q < 4; ++q) { const f32x4 A4 = *(const LAS f32x4*)(ar + 4 * q);
                    if (4 * q > i) acc[4 * q] -= A4.x * sv; if (4 * q + 1 > i) acc[4 * q + 1] -= A4.y * sv; if (4 * q + 2 > i) acc[4 * q + 2] -= A4.z * sv; if (4 * q + 3 > i) acc[4 * q + 3] -= A4.w * sv; }
            }
            if (part == 0) {
#pragma unroll
                for (int i = 0; i < 16; ++i) { xcol[j * 68 + 16 * rb + i] = acc[i]; tinv[(16 * rb + i) * 72 + j] = (bf16)f2bf(acc[i]); }
            }
            LDS_WAIT(); asm volatile("" ::: "memory");
        }
        for (int rb = 0; rb < jb; ++rb) {
            if (part == 0) {
#pragma unroll
                for (int i = 0; i < 16; ++i) tinv[(16 * rb + i) * 72 + j] = (bf16)0;
            }
        }
    }
    GL_BAR();
    GL_REPF(6) {
        const LAS bf16* tinv = (const LAS bf16*)(lds + GL_SOL + 17408);
        LAS bf16* wst = (LAS bf16*)(lds + GL_SOL + 17408 + 9216);
        const int col = lane & 15, g = lane >> 4, isw = wave >> 2;
        bf16x8 af[4][2];
#pragma unroll
        for (int rho = 0; rho < 4; ++rho)
#pragma unroll
            for (int s2 = 0; s2 < 2; ++s2) af[rho][s2] = *(const LAS bf16x8*)(tinv + (16 * rho + col) * 72 + 32 * s2 + 8 * g);
        bf16* UF = (bf16*)(ws + WS_UF) + (size_t)item * 8192;
#pragma unroll
        for (int sig = 0; sig < 2; ++sig) {
            const int jj = 32 * (wave & 3) + 16 * sig + col;
            const LAS float* src = (isw ? ks : vs) + jj;
            bf16x8 bfr[2];
#pragma unroll
            for (int s2 = 0; s2 < 2; ++s2) {
                float v[8];
#pragma unroll
                for (int e = 0; e < 8; ++e) { const int sidx = 32 * s2 + 8 * g + e; float x = src[sidx * 132] * sbeta[sidx]; if (isw) x *= seg[sidx]; v[e] = x; }
                v4u pk; pk.x = pk2(v[0], v[1]); pk.y = pk2(v[2], v[3]); pk.z = pk2(v[4], v[5]); pk.w = pk2(v[6], v[7]);
                bfr[s2] = __builtin_bit_cast(bf16x8, pk);
            }
            f32x4 acc[4];
#pragma unroll
            for (int rho = 0; rho < 4; ++rho) { acc[rho] = (f32x4){0.f, 0.f, 0.f, 0.f};
#pragma unroll
                for (int s2 = 0; s2 < 2; ++s2) acc[rho] = __builtin_amdgcn_mfma_f32_16x16x32_bf16(af[rho][s2], bfr[s2], acc[rho], 0, 0, 0); }
            if (!isw) {
                v4u o0, o1;
                o0.x = pk2(acc[0].x, acc[0].y); o0.y = pk2(acc[0].z, acc[0].w); o0.z = pk2(acc[1].x, acc[1].y); o0.w = pk2(acc[1].z, acc[1].w);
                o1.x = pk2(acc[2].x, acc[2].y); o1.y = pk2(acc[2].z, acc[2].w); o1.z = pk2(acc[3].x, acc[3].y); o1.w = pk2(acc[3].z, acc[3].w);
                v4u* d = (v4u*)(UF + (size_t)(2 * (wave & 3) + sig) * 1024 + lane * 16);
                st16_wt(d, o0); st16_wt(d + 1, o1);
            } else {
#pragma unroll
                for (int rho = 0; rho < 4; ++rho)
#pragma unroll
                    for (int i = 0; i < 4; ++i) wst[(16 * rho + 4 * g + i) * 136 + jj] = (bf16)f2bf(-acc[rho][i]);
            }
        }
    }
    GL_BAR();
    {
        const LAS bf16* wst = (const LAS bf16*)(lds + GL_SOL + 17408 + 9216);
        bf16* WN = (bf16*)(ws + WS_WN) + (size_t)item * 8192;
#pragma unroll
        for (int r = 0; r < 2; ++r) {
            const int id = tid + 512 * r, c = id >> 4, gam = id & 15, s32 = gam >> 2, g = gam & 3;
            const v2u lo = *(const LAS v2u*)(wst + c * 136 + 32 * s32 + 4 * g), hi = *(const LAS v2u*)(wst + c * 136 + 32 * s32 + 16 + 4 * g);
            v4u o; o.x = lo.x; o.y = lo.y; o.z = hi.x; o.w = hi.y;
            st16_wt(WN + c * 128 + 8 * gam, o);
        }
    }
    asm volatile("s_waitcnt vmcnt(0)" ::: "memory");
    GL_BAR();
    if (tid == 0) { unsigned fb = __builtin_bit_cast(unsigned, sek[64]); if (fb == 0u) fb = 1u;
        __hip_atomic_store((unsigned*)(ws + WS_CTL) + CW_GFLAG + item, fb, __ATOMIC_RELAXED, __HIP_MEMORY_SCOPE_AGENT); }
    GL_BAR();
}

constexpr int LL_XCB = 68608;
static_assert(LL_XCB + 64 * 1040 <= MISC_OFF, "lru_local LDS map");
__device__ __forceinline__ float expm1_small(float x) {
    const float p = x * (1.0f + x * (0.5f + x * (0.16666667f + x * (0.041666668f + x * 0.008333334f))));
    return (x > -0.25f) ? p : (__expf(x) - 1.0f);
}
__device__ __forceinline__ void lru_local_item(const Params& P, LAS unsigned char* lds, int lt, int tid, int lane, int wave) {
    unsigned char* ws = P.ws;
    asm volatile("" : "+v"(tid));
    const int b = lt >> 7, n = lt & 127, t0 = b * SEQ + n * 64;
    LAS bf16* rawx = (LAS bf16*)lds;
    LAS bf16* xcb = (LAS bf16*)(lds + LL_XCB);
    const bf16* XR = (const bf16*)(ws + WS_XR);
    {
        v4u pr[9];
#pragma unroll
        for (int r = 0; r < 9; ++r) { const int id = tid + 512 * r, row = id >> 6, ck = id & 63, s = n * 64 + row - 3;
            pr[r] = (v4u){0u, 0u, 0u, 0u};
            if (id < 67 * 64 && s >= 0) pr[r] = *(const v4u*)(XR + (size_t)(b * SEQ + s) * 512 + ck * 8); }
#pragma unroll
        for (int r = 0; r < 9; ++r) { const int id = tid + 512 * r; if (id < 67 * 64) *(LAS v4u*)(rawx + id * 8) = pr[r]; }
    }
    GL_BAR();
    {
        const int chg = tid & 63, tseg = tid >> 6, ch0 = chg * 8;
        float w[4][8], cb[8];
#pragma unroll
        for (int j = 0; j < 4; ++j) { const f32x4 a = *(const f32x4*)(P.lru_conv_w + j * 512 + ch0), c = *(const f32x4*)(P.lru_conv_w + j * 512 + ch0 + 4);
            w[j][0] = a.x; w[j][1] = a.y; w[j][2] = a.z; w[j][3] = a.w; w[j][4] = c.x; w[j][5] = c.y; w[j][6] = c.z; w[j][7] = c.w; }
        { const f32x4 a = *(const f32x4*)(P.lru_conv_b + ch0), c = *(const f32x4*)(P.lru_conv_b + ch0 + 4);
          cb[0] = a.x; cb[1] = a.y; cb[2] = a.z; cb[3] = a.w; cb[4] = c.x; cb[5] = c.y; cb[6] = c.z; cb[7] = c.w; }
        v4u xr[11];
#pragma unroll
        for (int r = 0; r < 11; ++r) xr[r] = *(const LAS v4u*)(rawx + (tseg * 8 + r) * 512 + ch0);
#pragma unroll
        for (int tk = 0; tk < 8; ++tk) {
            float y[8];
#pragma unroll
            for (int e = 0; e < 8; ++e) y[e] = cb[e];
#pragma unroll
            for (int j = 0; j < 4; ++j) { const v4u x = xr[tk + j];
                y[0] += w[j][0] * bflo(x.x); y[1] += w[j][1] * bfhi(x.x); y[2] += w[j][2] * bflo(x.y); y[3] += w[j][3] * bfhi(x.y);
                y[4] += w[j][4] * bflo(x.z); y[5] += w[j][5] * bfhi(x.z); y[6] += w[j][6] * bflo(x.w); y[7] += w[j][7] * bfhi(x.w); }
            v4u o; o.x = pk2(y[0], y[1]); o.y = pk2(y[2], y[3]); o.z = pk2(y[4], y[5]); o.w = pk2(y[6], y[7]);
            *(LAS v4u*)(xcb + (tseg * 8 + tk) * 520 + ch0) = o;
        }
    }
    GL_BAR();
    {
        const int g = wave, col = lane & 15, g4 = lane >> 4;
        LAS bf16* AM = (LAS bf16*)(lds + wave * 8192); LAS bf16* BT = AM + 2048;
        const bf16* WT = (const bf16*)(ws + WS_LRUWT) + (size_t)g * 8192;
        bf16x8 Bw[2][4][2];
#pragma unroll
        for (int m = 0; m < 2; ++m)
#pragma unroll
            for (int jt = 0; jt < 4; ++jt)
#pragma unroll
                for (int s2 = 0; s2 < 2; ++s2) Bw[m][jt][s2] = *(const bf16x8*)(WT + m * 4096 + (16 * jt + col) * 64 + 32 * s2 + 8 * g4);
        float cba[4], cbx[4], csp[4];
#pragma unroll
        for (int jt = 0; jt < 4; ++jt) { const int ch = g * 64 + 16 * jt + col; cba[jt] = P.lru_ba[ch]; cbx[jt] = P.lru_bx[ch]; csp[jt] = softplusf_(-P.lru_lambda[ch]); }
        bf16* HLOC = (bf16*)(ws + WS_HLOC); bf16* PCUM = (bf16*)(ws + WS_PCUM);
        const int chs = g * 64 + lane;
        float hst = 0.f, pc = 1.f;
#pragma unroll 1
        for (int half = 0; half < 2; ++half) {
            bf16x8 Af[2][2];
#pragma unroll
            for (int rho = 0; rho < 2; ++rho)
#pragma unroll
                for (int s2 = 0; s2 < 2; ++s2) Af[rho][s2] = *(const LAS bf16x8*)(xcb + (32 * half + 16 * rho + col) * 520 + g * 64 + 32 * s2 + 8 * g4);
#pragma unroll
            for (int jt = 0; jt < 4; ++jt) {
#pragma unroll
                for (int rho = 0; rho < 2; ++rho) {
                    f32x4 ra = (f32x4){0.f, 0.f, 0.f, 0.f}, rx = ra;
#pragma unroll
                    for (int s2 = 0; s2 < 2; ++s2) { ra = __builtin_amdgcn_mfma_f32_16x16x32_bf16(Af[rho][s2], Bw[0][jt][s2], ra, 0, 0, 0); rx = __builtin_amdgcn_mfma_f32_16x16x32_bf16(Af[rho][s2], Bw[1][jt][s2], rx, 0, 0, 0); }
#pragma unroll
                    for (int i = 0; i < 4; ++i) {
                        const int tokl = 16 * rho + 4 * g4 + i, chl = 16 * jt + col;
                        const float r = sigmoidf_(ra[i] + cba[jt]), ig = sigmoidf_(rx[i] + cbx[jt]);
                        const float log_a = -8.0f * r * csp[jt];
                        const float am = -expm1_small(log_a), a = 1.0f - am;
                        const float xo = bf1(xcb[(32 * half + tokl) * 520 + g * 64 + chl]);
                        const float bt = __builtin_amdgcn_sqrtf(fmaxf(am * (1.0f + a), 0.f)) * (ig * xo);
                        AM[tokl * 64 + chl] = (bf16)f2bf(am); BT[tokl * 64 + chl] = (bf16)f2bf(bt);
                    }
                }
            }
            LDS_WAIT(); asm volatile("" ::: "memory");
#pragma unroll 8
            for (int tk = 0; tk < 32; ++tk) {
                const float am = bf1(AM[tk * 64 + lane]), bt = bf1(BT[tk * 64 + lane]);
                hst = (hst - am * hst) + bt; pc = pc - am * pc;
                const size_t o = (size_t)(t0 + 32 * half + tk) * 512 + chs;
                HLOC[o] = (bf16)f2bf(hst); PCUM[o] = (bf16)f2bf(pc);
            }
            LDS_WAIT(); asm volatile("" ::: "memory");
        }
        ((float*)(ws + WS_HEND))[(size_t)lt * 512 + chs] = hst; ((float*)(ws + WS_PEND))[(size_t)lt * 512 + chs] = pc;
    }
    GL_BAR();
}

constexpr int SC_WN = 0, SC_QD = 64 * 272, SC_KD = 2 * 64 * 272, SC_ATT = 2 * 64 * 272 + 128 * 144, SC_BUF = 2 * 64 * 272 + 128 * 144 + 64 * 144;
constexpr int SC_SSQ = 2 * SC_BUF;
__device__ __forceinline__ int sc_lds_off(int id) {
    if (id < 1024) return SC_WN + (id >> 4) * 272 + (id & 15) * 16;
    if (id < 2048) { const int q = id - 1024; return SC_QD + (q >> 4) * 272 + (q & 15) * 16; }
    if (id < 3072) { const int q = id - 2048; return SC_KD + (q >> 3) * 144 + (q & 7) * 16; }
    const int q = id - 3072; return SC_ATT + (q >> 3) * 144 + (q & 7) * 16;
}
__device__ __forceinline__ const v4u* sc_src(const unsigned char* ws, int item, int id) {
    if (id < 1024) return (const v4u*)(ws + WS_WN + (size_t)item * 16384) + id;
    if (id < 2048) return (const v4u*)(ws + WS_QD + (size_t)item * 16384) + (id - 1024);
    if (id < 3072) return (const v4u*)(ws + WS_KD + (size_t)item * 16384) + (id - 2048);
    return (const v4u*)(ws + WS_ATT + (size_t)item * 8192) + (id - 3072);
}
__device__ __forceinline__ bf16x8 pack_b(const f32x4 a, const f32x4 b) {
    v4u r; r.x = pk2(a.x, a.y); r.y = pk2(a.z, a.w); r.z = pk2(b.x, b.y); r.w = pk2(b.z, b.w);
    return __builtin_bit_cast(bf16x8, r);
}
#define SC_BAR() do { asm volatile("s_waitcnt lgkmcnt(0)" ::: "memory"); __builtin_amdgcn_s_barrier(); asm volatile("" ::: "memory"); } while (0)
#define SC_GLD(dst, ptr) asm volatile("global_load_dwordx4 %0, %1, off" : "=v"(dst) : "v"(ptr) : "memory")
#define PIN8(a) asm volatile("" : "+v"(a[0]), "+v"(a[1]), "+v"(a[2]), "+v"(a[3]), "+v"(a[4]), "+v"(a[5]), "+v"(a[6]), "+v"(a[7]))
#define PIN16(a) asm volatile("" : "+v"(a[0]), "+v"(a[1]), "+v"(a[2]), "+v"(a[3]), "+v"(a[4]), "+v"(a[5]), "+v"(a[6]), "+v"(a[7]), "+v"(a[8]), "+v"(a[9]), "+v"(a[10]), "+v"(a[11]), "+v"(a[12]), "+v"(a[13]), "+v"(a[14]), "+v"(a[15]))
constexpr int SCAN_NWC = 2, SCAN_PARTS = 4, SCAN_WGS = 8 * SCAN_PARTS;
constexpr int SC_UFS = 2 * SC_BUF;
constexpr int SC_DECS = SC_UFS + 2 * SCAN_NWC * 2048;
constexpr int SC_OT = SC_DECS + 512;
constexpr int SC_RDY = SC_OT + 2 * 64 * 36 * 4;
constexpr int SC_END = SC_RDY + 64;
static_assert(SC_END <= MISC_OFF, "scan LDS");
#ifndef SCAN_REPS
#define SCAN_REPS 1
#endif
#ifndef SCAN_EXP
#define SCAN_EXP 0
#endif
__device__ __forceinline__ int sc3_lds_off(int id) {
    if (id < 3584) return sc_lds_off(id);
    return SC_UFS + (id - 3584) * 16;
}
__device__ __forceinline__ const v4u* sc3_src(const unsigned char* ws, int item, int id, int part) {
    if (id < 3584) return sc_src(ws, item, id);
    return (const v4u*)(ws + WS_UF + (size_t)item * 16384 + (size_t)(part * SCAN_NWC) * 2048) + (id - 3584);
}
__device__ __forceinline__ void gdn_scan(const Params& P, LAS unsigned char* lds, int sb, int tid, int lane, int wave) {
    const unsigned char* ws = P.ws;
    constexpr int NCH = 128 * SCAN_REPS, NPC = 15;
    const int bh = sb & 7, part = sb >> 3;
    const int b = bh >> 2, h = bh & 3, col = lane & 15, g = lane >> 4;
    const int item0 = bh * 128;
    if (tid == 0) *(volatile LAS unsigned*)(lds + SC_RDY) = 0u;
    SC_BAR();
    if (wave >= 4) {
        constexpr int NP = 15, DEP = 3;
        const int lt = tid - 256;
        const unsigned voff = (unsigned)lt * 16u;
        const int lA = (lt >> 4) * 272 + (lt & 15) * 16, lB = (lt >> 3) * 144 + (lt & 7) * 16, lU = SC_UFS + lt * 16;
        v4u rs[DEP][NP];
#define SC_ISSUE(set, itm) do { const unsigned char* gq_ = ws + (size_t)(itm) * 16384; const unsigned char* ga_ = ws + WS_ATT + (size_t)(itm) * 8192; \
            asm volatile("s_nop 4\n\tglobal_load_dwordx4 %0, %8, %9 sc0 sc1\n\tglobal_load_dwordx4 %1, %8, %10 sc0 sc1\n\tglobal_load_dwordx4 %2, %8, %11 sc0 sc1\n\tglobal_load_dwordx4 %3, %8, %12 sc0 sc1\n\t" \
                         "global_load_dwordx4 %4, %8, %13 sc0 sc1\n\tglobal_load_dwordx4 %5, %8, %14 sc0 sc1\n\tglobal_load_dwordx4 %6, %8, %15 sc0 sc1\n\tglobal_load_dwordx4 %7, %8, %16 sc0 sc1" \
                : "=&v"(rs[set][0]), "=&v"(rs[set][1]), "=&v"(rs[set][2]), "=&v"(rs[set][3]), "=&v"(rs[set][4]), "=&v"(rs[set][5]), "=&v"(rs[set][6]), "=&v"(rs[set][7]) \
                : "v"(voff), "s"(gq_ + WS_WN), "s"(gq_ + WS_WN + 4096), "s"(gq_ + WS_WN + 8192), "s"(gq_ + WS_WN + 12288), \
                  "s"(gq_ + WS_QD), "s"(gq_ + WS_QD + 4096), "s"(gq_ + WS_QD + 8192), "s"(gq_ + WS_QD + 12288) : "memory"); \
            asm volatile("s_nop 4\n\tglobal_load_dwordx4 %0, %7, %8 sc0 sc1\n\tglobal_load_dwordx4 %1, %7, %9 sc0 sc1\n\tglobal_load_dwordx4 %2, %7, %10 sc0 sc1\n\tglobal_load_dwordx4 %3, %7, %11 sc0 sc1\n\t" \
                         "global_load_dwordx4 %4, %7, %12 sc0 sc1\n\tglobal_load_dwordx4 %5, %7, %13 sc0 sc1\n\tglobal_load_dwordx4 %6, %7, %14 sc0 sc1" \
                : "=&v"(rs[set][8]), "=&v"(rs[set][9]), "=&v"(rs[set][10]), "=&v"(rs[set][11]), "=&v"(rs[set][12]), "=&v"(rs[set][13]), "=&v"(rs[set][14]) \
                : "v"(voff), "s"(gq_ + WS_KD), "s"(gq_ + WS_KD + 4096), "s"(gq_ + WS_KD + 8192), "s"(gq_ + WS_KD + 12288), \
                  "s"(ga_), "s"(ga_ + 4096), "s"(gq_ + WS_UF + (size_t)(part * SCAN_NWC) * 2048) : "memory"); } while (0)
#define SC_WAITSET(set, cnt) asm volatile("s_waitcnt " cnt : "+v"(rs[set][0]), "+v"(rs[set][1]), "+v"(rs[set][2]), "+v"(rs[set][3]), "+v"(rs[set][4]), "+v"(rs[set][5]), "+v"(rs[set][6]), "+v"(rs[set][7]), \
            "+v"(rs[set][8]), "+v"(rs[set][9]), "+v"(rs[set][10]), "+v"(rs[set][11]), "+v"(rs[set][12]), "+v"(rs[set][13]), "+v"(rs[set][14]) :: "memory")
#define SC_WRITE(set, par) do { LAS unsigned char* wb_ = lds + (par) * SC_BUF; \
            _Pragma("unroll") for (int r = 0; r < 4; ++r) { *(LAS v4u*)(wb_ + SC_WN + lA + r * (16 * 272)) = rs[set][r]; *(LAS v4u*)(wb_ + SC_QD + lA + r * (16 * 272)) = rs[set][4 + r]; \
                                                          *(LAS v4u*)(wb_ + SC_KD + lB + r * (32 * 144)) = rs[set][8 + r]; } \
            *(LAS v4u*)(wb_ + SC_ATT + lB) = rs[set][12]; *(LAS v4u*)(wb_ + SC_ATT + lB + 32 * 144) = rs[set][13]; \
            *(LAS v4u*)(lds + lU + (par) * (SCAN_NWC * 2048)) = rs[set][14]; } while (0)
#define SC_NEED(c) do { unsigned sp_ = 0; while (*(volatile LAS unsigned*)(lds + SC_RDY) <= (unsigned)(c) && ++sp_ < (1u << 24)) __builtin_amdgcn_s_sleep(2); } while (0)
        SC_NEED(0); SC_ISSUE(0, item0);
        SC_WAITSET(0, "vmcnt(0)"); SC_WRITE(0, 0); SC_WAITSET(0, "lgkmcnt(0)");
        SC_NEED(3); SC_ISSUE(1, item0 + 1); SC_ISSUE(2, item0 + 2); SC_ISSUE(0, item0 + 3);
        SC_BAR();
        int n2 = 0;
#define SC_INTERVAL(set) do { SC_WAITSET(set, "vmcnt(30)"); SC_WRITE(set, (n2 + 1) & 1); SC_WAITSET(set, "lgkmcnt(0)"); if (n2 + 1 + DEP < 128) SC_NEED(n2 + 1 + DEP); SC_ISSUE(set, item0 + ((n2 + 1 + DEP) & 127)); SC_BAR(); ++n2; } while (0)
#pragma unroll 1
        for (int it = 0; it < NCH / 3; ++it) { SC_INTERVAL(1); SC_INTERVAL(2); SC_INTERVAL(0); }
        if (NCH % 3 >= 1) SC_INTERVAL(1);
        if (NCH % 3 >= 2) SC_INTERVAL(2);
        SC_WAITSET(0, "vmcnt(0)"); SC_WAITSET(1, "vmcnt(0)"); SC_WAITSET(2, "vmcnt(0)");
#undef SC_INTERVAL
#undef SC_NEED
#undef SC_WRITE
#undef SC_WAITSET
#undef SC_ISSUE
        return;
    }
    if (wave == 3) {
        const unsigned* flags = (const unsigned*)(ws + WS_CTL) + CW_GFLAG + item0;
        unsigned rdy = 0;
#define SC_POLLSTEP() do { if (rdy < 128u) { const unsigned idx_ = rdy + (unsigned)lane; \
            const unsigned fv_ = (idx_ < 128u) ? __hip_atomic_load(flags + idx_, __ATOMIC_RELAXED, __HIP_MEMORY_SCOPE_AGENT) : 0u; \
            const unsigned long long m_ = __ballot(fv_ != 0u); const unsigned nrun_ = (m_ == ~0ull) ? 64u : (unsigned)__builtin_ctzll(~m_);     \
            if ((unsigned)lane < nrun_) ((LAS float*)(lds + SC_DECS))[idx_] = __builtin_bit_cast(float, fv_); \
            rdy += nrun_; LDS_WAIT(); if (lane == 0) *(volatile LAS unsigned*)(lds + SC_RDY) = rdy; } } while (0)
        { unsigned sp = 0; while (rdy < 4u && ++sp < (1u << 22)) { SC_POLLSTEP(); if (rdy < 4u) __builtin_amdgcn_s_sleep(16); } }
        SC_BAR();
#pragma unroll 1
        for (int n2 = 0; n2 < NCH; ++n2) {
            { const unsigned need = (unsigned)(n2 + 1 + 3) < 128u ? (unsigned)(n2 + 1 + 3) : 127u; unsigned sp = 0;
              while (rdy <= need && rdy < 128u && ++sp < (1u << 22)) { SC_POLLSTEP(); if (rdy <= need) __builtin_amdgcn_s_sleep(8); } }
            if (rdy < 128u && rdy < (unsigned)(n2 & 127) + 16u) SC_POLLSTEP();
            SC_BAR();
        }
#undef SC_POLLSTEP
        return;
    }
    if (wave == 2) {
        const int row = lane;
        bf16* Y = (bf16*)((unsigned char*)P.out + OUT_Y);
        float* SSQG = P.out;
        SC_BAR();
#pragma unroll 1
        for (int n2 = 0; n2 <= NCH; ++n2) {
            if (n2 > 0) {
                const int n = (n2 - 1) & 127, t = b * SEQ + n * 64 + row;
                const LAS float* src = (const LAS float*)(lds + SC_OT + ((n2 - 1) & 1) * (64 * 36 * 4)) + row * 36;
                f32x4 a[8]; float s2 = 0.f;
#pragma unroll
                for (int q = 0; q < 8; ++q) { a[q] = *(const LAS f32x4*)(src + 4 * q); s2 += (a[q].x * a[q].x + a[q].y * a[q].y) + (a[q].z * a[q].z + a[q].w * a[q].w); }
                SSQG[(size_t)t * 32 + h * 8 + part] = s2;
                v4u* d = (v4u*)(Y + (size_t)t * 1024 + h * 128 + 32 * part);
#pragma unroll
                for (int q = 0; q < 4; ++q) { v4u o; o.x = pk2(a[2 * q].x, a[2 * q].y); o.y = pk2(a[2 * q].z, a[2 * q].w); o.z = pk2(a[2 * q + 1].x, a[2 * q + 1].y); o.w = pk2(a[2 * q + 1].z, a[2 * q + 1].w); d[q] = o; }
            }
            if (n2 < NCH) SC_BAR();
        }
        return;
    }
    f32x4 S[8];
#pragma unroll
    for (int i = 0; i < 8; ++i) S[i] = (f32x4){0.f, 0.f, 0.f, 0.f};
    SC_BAR();
#pragma unroll 1
    for (int n2 = 0; n2 < NCH; ++n2) {
        if (SCAN_REPS > 1 && (n2 & 127) == 0) {
#pragma unroll
            for (int i = 0; i < 8; ++i) S[i] = (f32x4){0.f, 0.f, 0.f, 0.f};
        }
        if (SCAN_EXP == 2 && n2 < 128) { SC_BAR(); continue; }
        const int par = n2 & 1;
        LAS unsigned char* buf = lds + par * SC_BUF;
        bf16x8 fA[16], fB[16], fC[16], fD[8];
#pragma unroll
        for (int rho = 0; rho < 4; ++rho)
#pragma unroll
            for (int s = 0; s < 4; ++s) fA[rho * 4 + s] = *(const LAS bf16x8*)(buf + SC_WN + (16 * rho + col) * 272 + (32 * s + 8 * g) * 2);
#pragma unroll
        for (int rho = 0; rho < 4; ++rho)
#pragma unroll
            for (int s = 0; s < 4; ++s) fB[rho * 4 + s] = *(const LAS bf16x8*)(buf + SC_QD + (16 * rho + col) * 272 + (32 * s + 8 * g) * 2);
        const LAS v4u* ufp = (const LAS v4u*)(lds + SC_UFS + par * (SCAN_NWC * 2048) + wave * 2048 + lane * 32);
        const v4u uf0 = ufp[0], uf1 = ufp[1];
        const float dec = ((const LAS float*)(lds + SC_DECS))[n2 & 127];
        bf16x8 Bs[4];
#pragma unroll
        for (int s = 0; s < 4; ++s) Bs[s] = pack_b(S[2 * s], S[2 * s + 1]);
        f32x4 Vn[4], Oc[4];
        Vn[0] = (f32x4){bflo(uf0.x), bfhi(uf0.x), bflo(uf0.y), bfhi(uf0.y)}; Vn[1] = (f32x4){bflo(uf0.z), bfhi(uf0.z), bflo(uf0.w), bfhi(uf0.w)};
        Vn[2] = (f32x4){bflo(uf1.x), bfhi(uf1.x), bflo(uf1.y), bfhi(uf1.y)}; Vn[3] = (f32x4){bflo(uf1.z), bfhi(uf1.z), bflo(uf1.w), bfhi(uf1.w)};
        __builtin_amdgcn_sched_barrier(0);
        PIN16(fA);
#pragma unroll
        for (int s = 0; s < 4; ++s)
#pragma unroll
            for (int rho = 0; rho < 4; ++rho) Vn[rho] = __builtin_amdgcn_mfma_f32_16x16x32_bf16(fA[rho * 4 + s], Bs[s], Vn[rho], 0, 0, 0);
        __builtin_amdgcn_sched_barrier(0);
#pragma unroll
        for (int tau = 0; tau < 8; ++tau)
#pragma unroll
            for (int s = 0; s < 2; ++s) fC[tau * 2 + s] = *(const LAS bf16x8*)(buf + SC_KD + (16 * tau + col) * 144 + (32 * s + 8 * g) * 2);
        __builtin_amdgcn_sched_barrier(0);
        PIN16(fB);
#pragma unroll
        for (int rho = 0; rho < 4; ++rho) Oc[rho] = (f32x4){0.f, 0.f, 0.f, 0.f};
#pragma unroll
        for (int s = 0; s < 4; ++s)
#pragma unroll
            for (int rho = 0; rho < 4; ++rho) Oc[rho] = __builtin_amdgcn_mfma_f32_16x16x32_bf16(fB[rho * 4 + s], Bs[s], Oc[rho], 0, 0, 0);
        __builtin_amdgcn_sched_barrier(0);
#pragma unroll
        for (int rho = 0; rho < 4; ++rho)
#pragma unroll
            for (int s = 0; s < 2; ++s) fD[rho * 2 + s] = *(const LAS bf16x8*)(buf + SC_ATT + (16 * rho + col) * 144 + (32 * s + 8 * g) * 2);
        bf16x8 Bv[2];
        Bv[0] = pack_b(Vn[0], Vn[1]); Bv[1] = pack_b(Vn[2], Vn[3]);
#pragma unroll
        for (int tau = 0; tau < 8; ++tau) S[tau] = S[tau] * dec;
        __builtin_amdgcn_sched_barrier(0);
        PIN16(fC);
#pragma unroll
        for (int s = 0; s < 2; ++s)
#pragma unroll
            for (int tau = 0; tau < 8; ++tau) S[tau] = __builtin_amdgcn_mfma_f32_16x16x32_bf16(fC[tau * 2 + s], Bv[s], S[tau], 0, 0, 0);
        __builtin_amdgcn_sched_barrier(0);
        PIN8(fD);
#pragma unroll
        for (int s = 0; s < 2; ++s)
#pragma unroll
            for (int rho = 0; rho < 4; ++rho) Oc[rho] = __builtin_amdgcn_mfma_f32_16x16x32_bf16(fD[rho * 2 + s], Bv[s], Oc[rho], 0, 0, 0);
        LAS float* ot = (LAS float*)(lds + SC_OT + par * (64 * 36 * 4)) + 16 * wave + col;
#pragma unroll
        for (int rho = 0; rho < 4; ++rho)
#pragma unroll
            for (int i = 0; i < 4; ++i) ot[(16 * rho + 4 * g + i) * 36] = Oc[rho][i];
        SC_BAR();
    }
}

__device__ __forceinline__ void lru_carry(const Params& P, int gwv, int lane) {
    unsigned char* ws = P.ws;
    const int b = gwv >> 3, g = gwv & 7, ch = g * 64 + lane;
    const float* HEND = (const float*)(ws + WS_HEND); const float* PEND = (const float*)(ws + WS_PEND); float* HIN = (float*)(ws + WS_HIN);
    float hin = 0.f;
#pragma unroll 1
    for (int n0 = 0; n0 < 128; n0 += 32) {
        float he[32], pe[32];
#pragma unroll
        for (int i = 0; i < 32; ++i) { const size_t o = (size_t)(b * 128 + n0 + i) * 512 + ch; he[i] = HEND[o]; pe[i] = PEND[o]; }
#pragma unroll
        for (int i = 0; i < 32; ++i) { HIN[(size_t)(b * 128 + n0 + i) * 512 + ch] = hin; hin = he[i] + pe[i] * hin; }
    }
}

__device__ __forceinline__ void cvt_table(const float* src, bf16* dst, size_t n8, size_t wi, size_t nw) {
    for (size_t i = wi; i < n8; i += nw) {
        const f32x4 a = ((const f32x4*)src)[2 * i], c = ((const f32x4*)src)[2 * i + 1];
        v4u o; o.x = pk2(a.x, a.y); o.y = pk2(a.z, a.w); o.z = pk2(c.x, c.y); o.w = pk2(c.z, c.w);
        ((v4u*)dst)[i] = o;
    }
}

__device__ __forceinline__ void lru_combine(const Params& P, size_t wi, size_t nw) {
    unsigned char* ws = P.ws;
    const v4u* HLOC = (const v4u*)(ws + WS_HLOC); const v4u* PCUM = (const v4u*)(ws + WS_PCUM); const v4u* GATE = (const v4u*)(ws + WS_GATE);
    const float* HIN = (const float*)(ws + WS_HIN); bf16* Y = (bf16*)((unsigned char*)P.out + OUT_Y);
    for (size_t i = wi; i < (size_t)T * 64; i += nw) {
        const size_t t = i >> 6; const int ch0 = (int)(i & 63) * 8;
        const v4u hl = HLOC[i], pc = PCUM[i], gt = GATE[i];
        const f32x4 h0 = *(const f32x4*)(HIN + (t >> 6) * 512 + ch0), h1 = *(const f32x4*)(HIN + (t >> 6) * 512 + ch0 + 4);
        float y[8];
        y[0] = (bflo(hl.x) + bflo(pc.x) * h0.x) * gelu_tanh(bflo(gt.x)); y[1] = (bfhi(hl.x) + bfhi(pc.x) * h0.y) * gelu_tanh(bfhi(gt.x));
        y[2] = (bflo(hl.y) + bflo(pc.y) * h0.z) * gelu_tanh(bflo(gt.y)); y[3] = (bfhi(hl.y) + bfhi(pc.y) * h0.w) * gelu_tanh(bfhi(gt.y));
        y[4] = (bflo(hl.z) + bflo(pc.z) * h1.x) * gelu_tanh(bflo(gt.z)); y[5] = (bfhi(hl.z) + bfhi(pc.z) * h1.y) * gelu_tanh(bfhi(gt.z));
        y[6] = (bflo(hl.w) + bflo(pc.w) * h1.z) * gelu_tanh(bflo(gt.w)); y[7] = (bfhi(hl.w) + bfhi(pc.w) * h1.w) * gelu_tanh(bfhi(gt.w));
        v4u o; o.x = pk2(y[0], y[1]); o.y = pk2(y[2], y[3]); o.z = pk2(y[4], y[5]); o.w = pk2(y[6], y[7]);
        *(v4u*)(Y + t * 1024 + 512 + ch0) = o;
    }
}

__device__ __forceinline__ void gdn_gate_norm(const Params& P, size_t wi, size_t nw) {
    unsigned char* ws = P.ws;
    bf16* Y = (bf16*)((unsigned char*)P.out + OUT_Y); const v4u* Z = (const v4u*)(ws + WS_Z); const float* SSQG = P.out;
    for (size_t i = wi; i < (size_t)T * 64; i += nw) {
        const size_t t = i >> 6; const int c0 = (int)(i & 63) * 8, h = c0 >> 7;
        const f32x4 q0 = *(const f32x4*)(SSQG + t * 32 + h * 8);
        const float rstd = rsqrtf(((q0.x + q0.y) + (q0.z + q0.w)) * (1.0f / 128.0f) + 1e-6f);
        const v4u o = *(const v4u*)(Y + t * 1024 + c0), z = Z[i];
        const f32x4 w0 = *(const f32x4*)(P.gdn_norm_w + (c0 & 127)), w1 = *(const f32x4*)(P.gdn_norm_w + (c0 & 127) + 4);
        float y[8];
        y[0] = bflo(o.x) * rstd * w0.x * siluf_(bflo(z.x)); y[1] = bfhi(o.x) * rstd * w0.y * siluf_(bfhi(z.x));
        y[2] = bflo(o.y) * rstd * w0.z * siluf_(bflo(z.y)); y[3] = bfhi(o.y) * rstd * w0.w * siluf_(bfhi(z.y));
        y[4] = bflo(o.z) * rstd * w1.x * siluf_(bflo(z.z)); y[5] = bfhi(o.z) * rstd * w1.y * siluf_(bfhi(z.z));
        y[6] = bflo(o.w) * rstd * w1.z * siluf_(bflo(z.w)); y[7] = bfhi(o.w) * rstd * w1.w * siluf_(bfhi(z.w));
        v4u r; r.x = pk2(y[0], y[1]); r.y = pk2(y[2], y[3]); r.z = pk2(y[4], y[5]); r.w = pk2(y[6], y[7]);
        *(v4u*)(Y + t * 1024 + c0) = r;
    }
}

__device__ __forceinline__ void xattn_stage(LAS unsigned char* lds, const bf16* src, int tid) {
    v4u tmp[16];
    asm volatile("" : "+v"(tid));
    const unsigned voff = (unsigned)tid * 16u;
#pragma unroll
    for (int r = 0; r < 16; ++r) { const unsigned char* sb = (const unsigned char*)src + r * 8192;
        asm volatile("s_nop 4\n\tglobal_load_dwordx4 %0, %1, %2" : "=&v"(tmp[r]) : "v"(voff), "s"(sb) : "memory"); }
    asm volatile("s_waitcnt vmcnt(0)" : "+v"(tmp[0]), "+v"(tmp[1]), "+v"(tmp[2]), "+v"(tmp[3]), "+v"(tmp[4]), "+v"(tmp[5]), "+v"(tmp[6]), "+v"(tmp[7]),
                                        "+v"(tmp[8]), "+v"(tmp[9]), "+v"(tmp[10]), "+v"(tmp[11]), "+v"(tmp[12]), "+v"(tmp[13]), "+v"(tmp[14]), "+v"(tmp[15]) :: "memory");
#pragma unroll
    for (int r = 0; r < 16; ++r) { const int id = tid + 512 * r; *(LAS v4u*)(lds + (id >> 5) * 528 + (id & 31) * 16) = tmp[r]; }
}
#ifndef XA_NPS
#define XA_NPS 2
#endif
__device__ __forceinline__ void xattn_unit(const Params& P, LAS unsigned char* lds, int unit, int tid, int lane, int wave) {
    const unsigned char* ws = P.ws;
    const int h = unit & 3, qb = (unit >> 2) & 63, b = unit >> 8; int col = lane & 15, g = lane >> 4;
    const int tw = b * SEQ + qb * 128 + 16 * wave;
    const bf16* Kb = (const bf16*)(ws + WS_KB) + (size_t)((b * 4 + h) * 256) * 256;
    const bf16* Vt = (const bf16*)(ws + WS_VTP) + (size_t)((b * 4 + h) * 256) * 256;
    xattn_stage(lds, Kb, tid);
    __syncthreads();
    const LAS unsigned char* arow = lds + col * 528 + g * 16;
    bf16x8 Bp[XA_NPS][8]; float inv[XA_NPS];
#pragma unroll
    for (int ps = 0; ps < XA_NPS; ++ps) {
        __builtin_amdgcn_sched_barrier(0); asm volatile("" : "+v"(col), "+v"(g) :: "memory");
        const bf16* Q = (const bf16*)(ws + WS_Q) + (size_t)(tw + 128 * ps + col) * 1024 + h * 256 + 8 * g;
        bf16x8 Bq[8];
#pragma unroll
        for (int s = 0; s < 8; ++s) Bq[s] = *(const bf16x8*)(Q + 32 * s);
        f32x4 St[16];
        bf16x8 fr[2][8];
#pragma unroll
        for (int s = 0; s < 8; ++s) fr[0][s] = *(const LAS bf16x8*)(arow + 64 * s);
#pragma unroll
        for (int kap = 0; kap < 16; ++kap) {
            if (kap + 1 < 16) {
#pragma unroll
                for (int s = 0; s < 8; ++s) fr[(kap + 1) & 1][s] = *(const LAS bf16x8*)(arow + (16 * (kap + 1)) * 528 + 64 * s);
            }
            __builtin_amdgcn_sched_barrier(0);
            PIN8(fr[kap & 1]);
            f32x4 acc = (f32x4){0.f, 0.f, 0.f, 0.f};
#pragma unroll
            for (int s = 0; s < 8; ++s) acc = __builtin_amdgcn_mfma_f32_16x16x32_bf16(fr[kap & 1][s], Bq[s], acc, 0, 0, 0);
            St[kap] = acc;
            __builtin_amdgcn_sched_barrier(0);
        }
        float mx = -3.0e38f;
#pragma unroll
        for (int kap = 0; kap < 16; ++kap) mx = fmaxf(fmaxf(fmaxf(St[kap].x, St[kap].y), fmaxf(St[kap].z, St[kap].w)), mx);
        mx = fmaxf(mx, __shfl_xor(mx, 16)); mx = fmaxf(mx, __shfl_xor(mx, 32));
        float l = 0.f;
#pragma unroll
        for (int kap = 0; kap < 16; ++kap) { St[kap].x = __expf(St[kap].x - mx); St[kap].y = __expf(St[kap].y - mx); St[kap].z = __expf(St[kap].z - mx); St[kap].w = __expf(St[kap].w - mx);
            l += (St[kap].x + St[kap].y) + (St[kap].z + St[kap].w); }
        l += __shfl_xor(l, 16); l += __shfl_xor(l, 32);
        inv[ps] = 1.0f / l;
#pragma unroll
        for (int s = 0; s < 8; ++s) Bp[ps][s] = pack_b(St[2 * s], St[2 * s + 1]);
    }
    __syncthreads();
    xattn_stage(lds, Vt, tid);
    __syncthreads();
#pragma unroll
    for (int ps = 0; ps < XA_NPS; ++ps) {
        __builtin_amdgcn_sched_barrier(0); asm volatile("" : "+v"(col), "+v"(g) :: "memory");
        bf16* AO = (bf16*)(P.ws + WS_AO) + (size_t)(tw + 128 * ps + col) * 1024 + h * 256 + 4 * g;
        bf16x8 fr[2][8];
#pragma unroll
        for (int s = 0; s < 8; ++s) fr[0][s] = *(const LAS bf16x8*)(arow + 64 * s);
#pragma unroll
        for (int del = 0; del < 16; ++del) {
            if (del + 1 < 16) {
#pragma unroll
                for (int s = 0; s < 8; ++s) fr[(del + 1) & 1][s] = *(const LAS bf16x8*)(arow + (16 * (del + 1)) * 528 + 64 * s);
            }
            __builtin_amdgcn_sched_barrier(0);
            PIN8(fr[del & 1]);
            f32x4 acc = (f32x4){0.f, 0.f, 0.f, 0.f};
#pragma unroll
            for (int s = 0; s < 8; ++s) acc = __builtin_amdgcn_mfma_f32_16x16x32_bf16(fr[del & 1][s], Bp[ps][s], acc, 0, 0, 0);
            v2u o; o.x = pk2(acc.x * inv[ps], acc.y * inv[ps]); o.y = pk2(acc.z * inv[ps], acc.w * inv[ps]);
            *(v2u*)(AO + 16 * del) = o;
            __builtin_amdgcn_sched_barrier(0);
        }
    }
    __syncthreads();
}

__device__ __forceinline__ unsigned key_enc(float f) { const unsigned u = __builtin_bit_cast(unsigned, f); return (u & 0x80000000u) ? ~u : (u | 0x80000000u); }
__device__ __forceinline__ float key_dec(unsigned k) { const unsigned u = (k & 0x80000000u) ? (k & 0x7fffffffu) : ~k; return __builtin_bit_cast(float, u); }
#define TK_CAS(a, b) do { const unsigned hi_ = max(a, b), lo_ = min(a, b); a = hi_; b = lo_; } while (0)
__device__ __forceinline__ void tk_merge16(unsigned (&a)[16]) {
#pragma unroll
    for (int j = 8; j > 0; j >>= 1)
#pragma unroll
        for (int i = 0; i < 16; ++i) { const int l = i ^ j; if (l > i) TK_CAS(a[i], a[l]); }
}
__device__ __forceinline__ void tk_sort16(unsigned (&a)[16]) {
#define TK_L(...) do { const int pr_[] = {__VA_ARGS__}; _Pragma("unroll") for (int q_ = 0; q_ < (int)(sizeof(pr_) / sizeof(int)); q_ += 2) TK_CAS(a[pr_[q_]], a[pr_[q_ + 1]]); } while (0)
    TK_CAS(a[0], a[13]); TK_CAS(a[1], a[12]); TK_CAS(a[2], a[15]); TK_CAS(a[3], a[14]); TK_CAS(a[4], a[8]); TK_CAS(a[5], a[6]); TK_CAS(a[7], a[11]); TK_CAS(a[9], a[10]);
    TK_CAS(a[0], a[5]); TK_CAS(a[1], a[7]); TK_CAS(a[2], a[9]); TK_CAS(a[3], a[4]); TK_CAS(a[6], a[13]); TK_CAS(a[8], a[14]); TK_CAS(a[10], a[15]); TK_CAS(a[11], a[12]);
    TK_CAS(a[0], a[1]); TK_CAS(a[2], a[3]); TK_CAS(a[4], a[5]); TK_CAS(a[6], a[8]); TK_CAS(a[7], a[9]); TK_CAS(a[10], a[11]); TK_CAS(a[12], a[13]); TK_CAS(a[14], a[15]);
    TK_CAS(a[0], a[2]); TK_CAS(a[1], a[3]); TK_CAS(a[4], a[10]); TK_CAS(a[5], a[11]); TK_CAS(a[6], a[7]); TK_CAS(a[8], a[9]); TK_CAS(a[12], a[14]); TK_CAS(a[13], a[15]);
    TK_CAS(a[1], a[2]); TK_CAS(a[3], a[12]); TK_CAS(a[4], a[6]); TK_CAS(a[5], a[7]); TK_CAS(a[8], a[10]); TK_CAS(a[9], a[11]); TK_CAS(a[13], a[14]);
    TK_CAS(a[1], a[4]); TK_CAS(a[2], a[6]); TK_CAS(a[5], a[8]); TK_CAS(a[7], a[10]); TK_CAS(a[9], a[13]); TK_CAS(a[11], a[14]);
    TK_CAS(a[2], a[4]); TK_CAS(a[3], a[6]); TK_CAS(a[9], a[12]); TK_CAS(a[11], a[13]);
    TK_CAS(a[3], a[5]); TK_CAS(a[6], a[8]); TK_CAS(a[7], a[9]); TK_CAS(a[10], a[12]);
    TK_CAS(a[3], a[4]); TK_CAS(a[5], a[6]); TK_CAS(a[7], a[8]); TK_CAS(a[9], a[10]); TK_CAS(a[11], a[12]);
    TK_CAS(a[6], a[7]); TK_CAS(a[8], a[9]);
#undef TK_L
}
__device__ __forceinline__ void tk_top16_merge(unsigned (&L)[16], const unsigned (&G)[16]) {
#pragma unroll
    for (int i = 0; i < 16; ++i) L[i] = max(L[i], G[15 - i]);
    tk_merge16(L);
}
__device__ __forceinline__ void tk_pair_merge(unsigned (&L)[16]) {
    unsigned Pp[16];
#pragma unroll
    for (int i = 0; i < 16; ++i) Pp[i] = (unsigned)__builtin_amdgcn_update_dpp(0, (int)L[i], 0xB1, 0xF, 0xF, true);
    tk_top16_merge(L, Pp);
}
__device__ __forceinline__ void peer_topk_rows(const Params& P, LAS unsigned char* lds, int rowbase, int tid) {
    const unsigned char* ws = P.ws;
    typedef _Float16 f16x8 __attribute__((ext_vector_type(8)));
    const int rl = tid >> 1, hf = tid & 1, grow = rowbase + rl, t = grow >> 3, h = grow & 7;
    const _Float16* SC = (const _Float16*)(ws + WS_PQ) + (size_t)t * 2048 + h * 256 + 64 * hf;
    f16x8 raw[2][8];
#pragma unroll
    for (int p = 0; p < 2; ++p)
#pragma unroll
        for (int q = 0; q < 8; ++q) raw[p][q] = *(const f16x8*)(SC + p * 128 + 8 * q);
    unsigned L1[16], L2[16];
#pragma unroll
    for (int p = 0; p < 2; ++p) {
        unsigned L[16];
#pragma unroll
        for (int grp = 0; grp < 4; ++grp) {
            unsigned G[16];
#pragma unroll
            for (int e = 0; e < 16; ++e) G[e] = (key_enc((float)raw[p][2 * grp + (e >> 3)][e & 7]) & ~127u) | (unsigned)(127 - (64 * hf + 16 * grp + e));
            tk_sort16(G);
            if (grp == 0) {
#pragma unroll
                for (int i = 0; i < 16; ++i) L[i] = G[i];
            } else tk_top16_merge(L, G);
        }
        tk_pair_merge(L);
#pragma unroll
        for (int i = 0; i < 16; ++i) { if (p == 0) L1[i] = L[i]; else L2[i] = L[i]; }
    }
    {
        float v1[16], v2[16];
        LAS int* il = (LAS int*)lds + rl * 33;
#pragma unroll
        for (int q = 0; q < 16; ++q) { v1[q] = key_dec((L1[q] & ~127u) | 64u); v2[q] = key_dec((L2[q] & ~127u) | 64u); }
        if (hf == 0) {
#pragma unroll
            for (int q = 0; q < 16; ++q) { il[q] = 127 - (int)(L1[q] & 127u); il[16 + q] = 127 - (int)(L2[q] & 127u); }
        }
        unsigned C[16], D[16];
        float w1[8];
        const unsigned hf16 = (unsigned)hf * 16u, evenmask = (unsigned)hf - 1u;
#pragma unroll
        for (int k = 0; k < 8; ++k) w1[k] = __builtin_bit_cast(float, (__builtin_bit_cast(unsigned, v1[2 * k]) & evenmask) | (__builtin_bit_cast(unsigned, v1[2 * k + 1]) & ~evenmask));
#define TK_SLOT(dst, k, bq, valid_odd) do { const unsigned pos_ = (unsigned)(16 * (2 * (k)) + (bq)) + hf16; unsigned kv_ = (key_enc(w1[k] + v2[bq]) & ~255u) | (255u - pos_); if (!(valid_odd)) kv_ &= evenmask; dst = kv_; } while (0)
        TK_SLOT(C[0], 0, 0, true);
        TK_SLOT(C[1], 0, 1, true);
        TK_SLOT(C[2], 0, 2, true);
        TK_SLOT(C[3], 0, 3, true);
        TK_SLOT(C[4], 0, 4, true);
        TK_SLOT(C[5], 0, 5, true);
        TK_SLOT(C[6], 0, 6, true);
        TK_SLOT(C[7], 0, 7, true);
        TK_SLOT(C[8], 0, 8, false);
        TK_SLOT(C[9], 0, 9, false);
        TK_SLOT(C[10], 0, 10, false);
        TK_SLOT(C[11], 0, 11, false);
        TK_SLOT(C[12], 0, 12, false);
        TK_SLOT(C[13], 0, 13, false);
        TK_SLOT(C[14], 0, 14, false);
        TK_SLOT(C[15], 0, 15, false);
        TK_SLOT(D[0], 1, 0, true);
        TK_SLOT(D[1], 1, 1, true);
        TK_SLOT(D[2], 1, 2, true);
        TK_SLOT(D[3], 1, 3, true);
        TK_SLOT(D[4], 1, 4, false);
        TK_SLOT(D[5], 2, 0, true);
        TK_SLOT(D[6], 2, 1, true);
        TK_SLOT(D[7], 2, 2, false);
        TK_SLOT(D[8], 3, 0, true);
        TK_SLOT(D[9], 3, 1, true);
        TK_SLOT(D[10], 4, 0, true);
        TK_SLOT(D[11], 5, 0, true);
        TK_SLOT(D[12], 6, 0, true);
        TK_SLOT(D[13], 7, 0, true);
        D[14] = 0u; D[15] = 0u;
#undef TK_SLOT
        tk_sort16(C); tk_sort16(D); tk_top16_merge(C, D); tk_pair_merge(C);
        LDS_WAIT(); asm volatile("" ::: "memory");
        float best[16], e[16], sum = 0.f;
#pragma unroll
        for (int q = 0; q < 16; ++q) { best[q] = key_dec((C[q] & ~255u) | 128u); e[q] = __expf(best[q] - best[0]); sum += e[q]; }
        const float inv = __builtin_amdgcn_rcpf(sum);
        int* IDX = (int*)(P.ws + WS_IDX) + (size_t)grow * 16 + 8 * hf; float* GW = (float*)(P.ws + WS_GW) + (size_t)grow * 16 + 8 * hf;
#pragma unroll
        for (int q = 0; q < 8; ++q) {
            const unsigned c = (C[q] & evenmask) | (C[8 + q] & ~evenmask);
            const float ev = __builtin_bit_cast(float, (__builtin_bit_cast(unsigned, e[q]) & evenmask) | (__builtin_bit_cast(unsigned, e[8 + q]) & ~evenmask));
            const unsigned pos = 255u - (c & 255u);
            IDX[q] = il[pos >> 4] * 128 + il[16 + (pos & 15u)]; GW[q] = ev * inv;
        }
    }
    LDS_WAIT(); asm volatile("" ::: "memory");
}

__device__ __forceinline__ void peer_topk_wave(const Params& P, LAS int* ilw, LAS unsigned* oute, LAS float* outg, int tbase, int lane) {
    const unsigned char* ws = P.ws;
    typedef _Float16 f16x8 __attribute__((ext_vector_type(8)));
    const int rl = lane >> 1, hf = lane & 1, t = tbase + (rl >> 3), h = rl & 7;
    const _Float16* SC = (const _Float16*)(ws + WS_PQ) + (size_t)t * 2048 + h * 256 + 64 * hf;
    f16x8 raw[2][8];
#pragma unroll
    for (int p = 0; p < 2; ++p)
#pragma unroll
        for (int q = 0; q < 8; ++q) raw[p][q] = *(const f16x8*)(SC + p * 128 + 8 * q);
    unsigned L1[16], L2[16];
#pragma unroll
    for (int p = 0; p < 2; ++p) {
        unsigned L[16];
#pragma unroll
        for (int grp = 0; grp < 4; ++grp) {
            unsigned G[16];
#pragma unroll
            for (int e = 0; e < 16; ++e) G[e] = (key_enc((float)raw[p][2 * grp + (e >> 3)][e & 7]) & ~127u) | (unsigned)(127 - (64 * hf + 16 * grp + e));
            tk_sort16(G);
            if (grp == 0) {
#pragma unroll
                for (int i = 0; i < 16; ++i) L[i] = G[i];
            } else tk_top16_merge(L, G);
        }
        tk_pair_merge(L);
#pragma unroll
        for (int i = 0; i < 16; ++i) { if (p == 0) L1[i] = L[i]; else L2[i] = L[i]; }
    }
    {
        float v1[16], v2[16];
        LAS int* il = ilw + rl * 33;
#pragma unroll
        for (int q = 0; q < 16; ++q) { v1[q] = key_dec((L1[q] & ~127u) | 64u); v2[q] = key_dec((L2[q] & ~127u) | 64u); }
        if (hf == 0) {
#pragma unroll
            for (int q = 0; q < 16; ++q) { il[q] = 127 - (int)(L1[q] & 127u); il[16 + q] = 127 - (int)(L2[q] & 127u); }
        }
        unsigned C[16], D[16];
        float w1[8];
        const unsigned hf16 = (unsigned)hf * 16u, evenmask = (unsigned)hf - 1u;
#pragma unroll
        for (int k = 0; k < 8; ++k) w1[k] = __builtin_bit_cast(float, (__builtin_bit_cast(unsigned, v1[2 * k]) & evenmask) | (__builtin_bit_cast(unsigned, v1[2 * k + 1]) & ~evenmask));
#define TK_SLOT(dst, k, bq, valid_odd) do { const unsigned pos_ = (unsigned)(16 * (2 * (k)) + (bq)) + hf16; unsigned kv_ = (key_enc(w1[k] + v2[bq]) & ~255u) | (255u - pos_); if (!(valid_odd)) kv_ &= evenmask; dst = kv_; } while (0)
        TK_SLOT(C[0], 0, 0, true);
        TK_SLOT(C[1], 0, 1, true);
        TK_SLOT(C[2], 0, 2, true);
        TK_SLOT(C[3], 0, 3, true);
        TK_SLOT(C[4], 0, 4, true);
        TK_SLOT(C[5], 0, 5, true);
        TK_SLOT(C[6], 0, 6, true);
        TK_SLOT(C[7], 0, 7, true);
        TK_SLOT(C[8], 0, 8, false);
        TK_SLOT(C[9], 0, 9, false);
        TK_SLOT(C[10], 0, 10, false);
        TK_SLOT(C[11], 0, 11, false);
        TK_SLOT(C[12], 0, 12, false);
        TK_SLOT(C[13], 0, 13, false);
        TK_SLOT(C[14], 0, 14, false);
        TK_SLOT(C[15], 0, 15, false);
        TK_SLOT(D[0], 1, 0, true);
        TK_SLOT(D[1], 1, 1, true);
        TK_SLOT(D[2], 1, 2, true);
        TK_SLOT(D[3], 1, 3, true);
        TK_SLOT(D[4], 1, 4, false);
        TK_SLOT(D[5], 2, 0, true);
        TK_SLOT(D[6], 2, 1, true);
        TK_SLOT(D[7], 2, 2, false);
        TK_SLOT(D[8], 3, 0, true);
        TK_SLOT(D[9], 3, 1, true);
        TK_SLOT(D[10], 4, 0, true);
        TK_SLOT(D[11], 5, 0, true);
        TK_SLOT(D[12], 6, 0, true);
        TK_SLOT(D[13], 7, 0, true);
        D[14] = 0u; D[15] = 0u;
#undef TK_SLOT
        tk_sort16(C); tk_sort16(D); tk_top16_merge(C, D); tk_pair_merge(C);
        LDS_WAIT(); asm volatile("" ::: "memory");
        float best[16], e[16], sum = 0.f;
#pragma unroll
        for (int q = 0; q < 16; ++q) { best[q] = key_dec((C[q] & ~255u) | 128u); e[q] = __expf(best[q] - best[0]); sum += e[q]; }
        const float inv = __builtin_amdgcn_rcpf(sum);
        LAS unsigned* IDX = oute + rl * 16 + 8 * hf; LAS float* GW = outg + rl * 16 + 8 * hf;
#pragma unroll
        for (int q = 0; q < 8; ++q) {
            const unsigned c = (C[q] & evenmask) | (C[8 + q] & ~evenmask);
            const float ev = __builtin_bit_cast(float, (__builtin_bit_cast(unsigned, e[q]) & evenmask) | (__builtin_bit_cast(unsigned, e[8 + q]) & ~evenmask));
            const unsigned pos = 255u - (c & 255u);
            IDX[q] = (unsigned)(il[pos >> 4] * 128 + il[16 + (pos & 15u)]); GW[q] = ev * inv;
        }
    }
    LDS_WAIT(); asm volatile("" ::: "memory");
}

typedef float f32x2 __attribute__((ext_vector_type(2)));
__device__ __forceinline__ unsigned q8(float x) { return (unsigned)(int)rintf(x) & 0xffu; }
__device__ __forceinline__ void cvt_table_fp8(const float* src, unsigned char* dst, float* scl, int gw, int ngw, int lane) {
    for (int row = gw; row < 16384; row += ngw) {
        const f32x4* sp = (const f32x4*)(src + (size_t)row * 1024 + 16 * lane);
        const f32x4 a0 = sp[0], a1 = sp[1], a2 = sp[2], a3 = sp[3];
        float m = fmaxf(fmaxf(fmaxf(fabsf(a0.x), fabsf(a0.y)), fmaxf(fabsf(a0.z), fabsf(a0.w))), fmaxf(fmaxf(fabsf(a1.x), fabsf(a1.y)), fmaxf(fabsf(a1.z), fabsf(a1.w))));
        m = fmaxf(m, fmaxf(fmaxf(fmaxf(fabsf(a2.x), fabsf(a2.y)), fmaxf(fabsf(a2.z), fabsf(a2.w))), fmaxf(fmaxf(fabsf(a3.x), fabsf(a3.y)), fmaxf(fabsf(a3.z), fabsf(a3.w)))));
#pragma unroll
        for (int o = 1; o < 64; o <<= 1) m = fmaxf(m, __shfl_xor(m, o));
        m = fmaxf(m, 1e-30f);
        const float q = 127.0f / m;
        v4u o;
        o.x = q8(a0.x * q) | (q8(a0.y * q) << 8) | (q8(a0.z * q) << 16) | (q8(a0.w * q) << 24);
        o.y = q8(a1.x * q) | (q8(a1.y * q) << 8) | (q8(a1.z * q) << 16) | (q8(a1.w * q) << 24);
        o.z = q8(a2.x * q) | (q8(a2.y * q) << 8) | (q8(a2.z * q) << 16) | (q8(a2.w * q) << 24);
        o.w = q8(a3.x * q) | (q8(a3.y * q) << 8) | (q8(a3.z * q) << 16) | (q8(a3.w * q) << 24);
        *(v4u*)(dst + (size_t)row * 1024 + 16 * lane) = o;
        if (lane == 0) scl[row] = m * (1.0f / 127.0f);
    }
}
__device__ __forceinline__ int row16_sum_i(int v) {
    v += __builtin_amdgcn_update_dpp(0, v, 0xB1, 0xF, 0xF, true);
    v += __builtin_amdgcn_update_dpp(0, v, 0x4E, 0xF, 0xF, true);
    v += __builtin_amdgcn_update_dpp(0, v, 0x141, 0xF, 0xF, true);
    v += __builtin_amdgcn_update_dpp(0, v, 0x140, 0xF, 0xF, true);
    return v;
}
constexpr int PE_NT = 4, PE_NR = 16, PE_SH = 10, PE_DEP = 3;
constexpr int PE_TOK_W = 128 * 3 + 20;
constexpr int PE_ENT_W = 272 * 4;
constexpr int PE_WAVE_W = PE_NT * PE_TOK_W + PE_ENT_W + 32 * 33 + 2 * PE_NT * 128;
static_assert(8 * PE_WAVE_W * 4 <= MISC_OFF && PE_NR * PE_NT == 64, "peer LDS / batch-list geometry");
#define PE_LD(dst, voff_, sbase_) asm volatile("s_nop 4\n\tglobal_load_dwordx4 %0, %1, %2" : "=&v"(dst) : "v"(voff_), "s"(sbase_) : "memory")
__device__ __forceinline__ void peer_pass(const Params& P, LAS unsigned char* lds, int tbase, int lane, int wave, float* dstbase, int emask = 0x3fff) {
    asm volatile("v_mbcnt_lo_u32_b32 %0, -1, 0\n\tv_mbcnt_hi_u32_b32 %0, -1, %0" : "=v"(lane));
    {
        LAS unsigned* lw0 = (LAS unsigned*)(lds) + wave * PE_WAVE_W + PE_NT * PE_TOK_W + PE_ENT_W;
        peer_topk_wave(P, (LAS int*)lw0, lw0 + 32 * 33, (LAS float*)(lw0 + 32 * 33 + PE_NT * 128), tbase, lane);
        LDS_WAIT(); asm volatile("" : "+v"(lane), "+s"(tbase) :: "memory");
    }
    const unsigned char* ws = P.ws;
    const unsigned char* UB8 = ws + WS_UB; const unsigned char* VB8 = ws + WS_VB;
    const float* USC = (const float*)(ws + WS_USC); const float* VSC = (const float*)(ws + WS_VSC);
    f32x2 acc[PE_NT][8];
    LAS unsigned* lw = (LAS unsigned*)(lds) + wave * PE_WAVE_W;
    LAS unsigned* ents = lw + PE_NT * PE_TOK_W;
    const unsigned voff = (unsigned)lane * 16u;
    LAS unsigned* upe = ents + PE_ENT_W + 32 * 33; LAS float* upg = (LAS float*)(upe + PE_NT * 128);
    LAS unsigned* hql = ents + PE_ENT_W;
#pragma unroll
    for (int j = 0; j < PE_NT; ++j) {
        const int t = tbase + j;
        const v4u* xrow = (const v4u*)((const bf16*)(ws + WS_XB) + (size_t)t * 1024 + 16 * lane);
        const v4u xa = xrow[0], xc = xrow[1];
        const f32x4 xvv[4] = {(f32x4){bflo(xa.x), bfhi(xa.x), bflo(xa.y), bfhi(xa.y)}, (f32x4){bflo(xa.z), bfhi(xa.z), bflo(xa.w), bfhi(xa.w)},
                              (f32x4){bflo(xc.x), bfhi(xc.x), bflo(xc.y), bfhi(xc.y)}, (f32x4){bflo(xc.z), bfhi(xc.z), bflo(xc.w), bfhi(xc.w)}};
        const float rstd2 = rsqrtf(((const float*)(ws + WS_SSQ2))[t] * (1.0f / 1024.0f) + 1e-6f);
        f32x4 hv[4]; float hm = 0.f;
#pragma unroll
        for (int i = 0; i < 4; ++i) { const f32x4 xv = xvv[i]; const f32x4 w = ((const f32x4*)(P.norm_ffn_w + 16 * lane))[i];
            hv[i] = (f32x4){xv.x * rstd2 * w.x, xv.y * rstd2 * w.y, xv.z * rstd2 * w.z, xv.w * rstd2 * w.w};
            hm = fmaxf(hm, fmaxf(fmaxf(fabsf(hv[i].x), fabsf(hv[i].y)), fmaxf(fabsf(hv[i].z), fabsf(hv[i].w)))); }
#pragma unroll
        for (int o = 1; o < 64; o <<= 1) hm = fmaxf(hm, __shfl_xor(hm, o));
        hm = fmaxf(hm, 1e-30f);
        const float hqs = 127.0f / hm, hs = hm * (1.0f / 127.0f);
        { unsigned hqv[4];
#pragma unroll
          for (int i = 0; i < 4; ++i) hqv[i] = q8(hv[i].x * hqs) | (q8(hv[i].y * hqs) << 8) | (q8(hv[i].z * hqs) << 16) | (q8(hv[i].w * hqs) << 24);
          *(LAS v4u*)(hql + (j * 64 + lane) * 4) = (v4u){hqv[0], hqv[1], hqv[2], hqv[3]}; }
#pragma unroll
        for (int i = 0; i < 8; ++i) acc[j][i] = (f32x2){0.f, 0.f};
        const int e0 = (int)upe[j * 128 + 2 * lane] & emask, e1 = (int)upe[j * 128 + 2 * lane + 1] & emask;
        const float g0 = upg[j * 128 + 2 * lane] * VSC[e0], g1 = upg[j * 128 + 2 * lane + 1] * VSC[e1];
        const float u0 = USC[e0] * hs, u1 = USC[e1] * hs;
        const int rev = (tbase >= T / 2) ? (PE_NR - 1) : 0;
        const int b0 = (e0 >> PE_SH) ^ rev, b1 = (e1 >> PE_SH) ^ rev;
        LAS unsigned* lt = lw + j * PE_TOK_W;
        int run = 0;
#pragma unroll 1
        for (int bk = 0; bk < PE_NR; ++bk) {
            const unsigned long long m0 = __ballot(b0 == bk), m1 = __ballot(b1 == bk);
            const int c0 = __popcll(m0), c1 = __popcll(m1);
            const unsigned long long lower = (1ull << lane) - 1ull;
            if (b0 == bk) { const int p = run + __popcll(m0 & lower); lt[p] = (unsigned)e0; lt[128 + p] = __builtin_bit_cast(unsigned, g0); lt[256 + p] = __builtin_bit_cast(unsigned, u0); }
            if (b1 == bk) { const int p = run + c0 + __popcll(m1 & lower); lt[p] = (unsigned)e1; lt[128 + p] = __builtin_bit_cast(unsigned, g1); lt[256 + p] = __builtin_bit_cast(unsigned, u1); }
            if (lane == 0) lt[384 + bk] = (unsigned)run;
            run += c0 + c1;
        }
        if (lane == 0) lt[384 + PE_NR] = 128u;
        asm volatile("" ::: "memory");
    }
    LDS_WAIT(); asm volatile("" ::: "memory");
    int nb;
    {
        const int rd = lane >> 2, j = (rd & 1) ? 3 - (lane & 3) : (lane & 3);
        const LAS unsigned* lt = lw + j * PE_TOK_W;
        const int n0 = (int)lt[384 + rd], n1 = (int)lt[384 + rd + 1];
        const int nbl = (n1 - n0 + 3) >> 2;
        int inc = nbl;
#pragma unroll
        for (int off = 1; off < 64; off <<= 1) { const int tv = __shfl_up(inc, off); if (lane >= off) inc += tv; }
        nb = __builtin_amdgcn_readlane(inc, 63);
        const int ofs = inc - nbl;
#pragma unroll 1
        for (int q = 0; q < nbl; ++q) { const int i0 = n0 + 4 * q, c = (n1 - i0) < 4 ? (n1 - i0) : 4;
            const unsigned e0 = lt[i0], e1 = lt[i0 + (c > 1 ? 1 : c - 1)], e2 = lt[i0 + (c > 2 ? 2 : c - 1)], e3 = lt[i0 + (c > 3 ? 3 : c - 1)];
            *(LAS v4u*)(ents + 4 * (ofs + q)) = (v4u){e0 | (((unsigned)j | ((unsigned)c << 2) | ((unsigned)i0 << 5)) << 14), e1, e2, e3}; }
        if (lane < 2 * PE_DEP) *(LAS v4u*)(ents + 4 * (nb + lane)) = (v4u){0u, 0u, 0u, 0u};
    }
    LDS_WAIT(); asm volatile("" ::: "memory");
    v4u ru[PE_DEP][4], rv[PE_DEP][4];
#define PE_LDO(dst, vo_, sbase_) asm volatile("global_load_dwordx4 %0, %1, %2" : "=&v"(dst) : "v"(vo_), "s"(sbase_) : "memory")
#define PE_ISSUE(S, rec_) do { const unsigned e0_ = (rec_).x & 0x3fffu; \
        { const unsigned vo_ = (e0_ << 10) + voff; PE_LDO(ru[S][0], vo_, UB8); PE_LDO(rv[S][0], vo_, VB8); } \
        { const unsigned vo_ = ((rec_).y << 10) + voff; PE_LDO(ru[S][1], vo_, UB8); PE_LDO(rv[S][1], vo_, VB8); } \
        { const unsigned vo_ = ((rec_).z << 10) + voff; PE_LDO(ru[S][2], vo_, UB8); PE_LDO(rv[S][2], vo_, VB8); } \
        { const unsigned vo_ = ((rec_).w << 10) + voff; PE_LDO(ru[S][3], vo_, UB8); PE_LDO(rv[S][3], vo_, VB8); } } while (0)
#define PE_WAIT8(S, cntstr) asm volatile("s_waitcnt " cntstr : "+v"(ru[S][0]), "+v"(ru[S][1]), "+v"(ru[S][2]), "+v"(ru[S][3]), "+v"(rv[S][0]), "+v"(rv[S][1]), "+v"(rv[S][2]), "+v"(rv[S][3]) :: "memory")
#define PE_UDOTS(S) asm("v_dot4_i32_i8 %0, %4, %20, 0\n\tv_dot4_i32_i8 %1, %8, %20, 0\n\tv_dot4_i32_i8 %2, %12, %20, 0\n\tv_dot4_i32_i8 %3, %16, %20, 0\n\t" \
                        "v_dot4_i32_i8 %0, %5, %21, %0\n\tv_dot4_i32_i8 %1, %9, %21, %1\n\tv_dot4_i32_i8 %2, %13, %21, %2\n\tv_dot4_i32_i8 %3, %17, %21, %3\n\t" \
                        "v_dot4_i32_i8 %0, %6, %22, %0\n\tv_dot4_i32_i8 %1, %10, %22, %1\n\tv_dot4_i32_i8 %2, %14, %22, %2\n\tv_dot4_i32_i8 %3, %18, %22, %3\n\t" \
                        "v_dot4_i32_i8 %0, %7, %23, %0\n\tv_dot4_i32_i8 %1, %11, %23, %1\n\tv_dot4_i32_i8 %2, %15, %23, %2\n\tv_dot4_i32_i8 %3, %19, %23, %3\n\ts_nop 2" \
        : "=&v"(d_[0]), "=&v"(d_[1]), "=&v"(d_[2]), "=&v"(d_[3]) \
        : "v"(ru[S][0].x), "v"(ru[S][0].y), "v"(ru[S][0].z), "v"(ru[S][0].w), "v"(ru[S][1].x), "v"(ru[S][1].y), "v"(ru[S][1].z), "v"(ru[S][1].w), \
          "v"(ru[S][2].x), "v"(ru[S][2].y), "v"(ru[S][2].z), "v"(ru[S][2].w), "v"(ru[S][3].x), "v"(ru[S][3].y), "v"(ru[S][3].z), "v"(ru[S][3].w), \
          "v"(hcur.x), "v"(hcur.y), "v"(hcur.z), "v"(hcur.w))
#define PE_UDOTS_SAFE(S) do { _Pragma("unroll") for (int k_ = 0; k_ < 4; ++k_) { int s_ = __builtin_amdgcn_sdot4((int)ru[S][k_].x, (int)hcur.x, 0, false); s_ = __builtin_amdgcn_sdot4((int)ru[S][k_].y, (int)hcur.y, s_, false); \
            s_ = __builtin_amdgcn_sdot4((int)ru[S][k_].z, (int)hcur.z, s_, false); s_ = __builtin_amdgcn_sdot4((int)ru[S][k_].w, (int)hcur.w, s_, false); d_[k_] = s_; } } while (0)
#define PE_VDOTS_SAFE(f0, f1, f2, f3, b0, b1, b2, b3, w) do { f0 = (float)__builtin_amdgcn_sdot4((int)(b0), (int)(w), 0, false); f1 = (float)__builtin_amdgcn_sdot4((int)(b1), (int)(w), 0, false); \
            f2 = (float)__builtin_amdgcn_sdot4((int)(b2), (int)(w), 0, false); f3 = (float)__builtin_amdgcn_sdot4((int)(b3), (int)(w), 0, false); } while (0)
#define PE_VDOTS(f0, f1, f2, f3, b0, b1, b2, b3, w) asm("v_dot4_i32_i8 %0, %4, %8, 0\n\tv_dot4_i32_i8 %1, %5, %8, 0\n\tv_dot4_i32_i8 %2, %6, %8, 0\n\tv_dot4_i32_i8 %3, %7, %8, 0\n\t" \
                        "v_cvt_f32_i32_e32 %0, %0\n\tv_cvt_f32_i32_e32 %1, %1\n\tv_cvt_f32_i32_e32 %2, %2\n\tv_cvt_f32_i32_e32 %3, %3" \
        : "=&v"(f0), "=&v"(f1), "=&v"(f2), "=&v"(f3) : "v"(b0), "v"(b1), "v"(b2), "v"(b3), "v"(w))
#define PE_COMPUTE_B(S, c_, i_, j_, SG) do { const LAS unsigned* lt_ = lw + (j_) * PE_TOK_W; \
        const int myk_ = lane >> 4; \
        float gsc_ = __builtin_bit_cast(float, lt_[128 + i_ + myk_]), usc_ = __builtin_bit_cast(float, lt_[256 + i_ + myk_]);     \
        int d_[4]; \
        PE_UDOTS(S); \
        int r1_; \
        { const v2u p02_ = __builtin_amdgcn_permlane32_swap((unsigned)d_[0], (unsigned)d_[2], false, false), p13_ = __builtin_amdgcn_permlane32_swap((unsigned)d_[1], (unsigned)d_[3], false, false); \
          const v2u q_ = __builtin_amdgcn_permlane16_swap(p02_.x + p02_.y, p13_.x + p13_.y, false, false); r1_ = row16_sum_i((int)(q_.x + q_.y)); }     \
        float act_; \
        { const float x_ = (float)r1_ * usc_, e_ = __builtin_amdgcn_exp2f(x_ * __builtin_fmaf(x_ * x_, -0.10294324f, -2.3022082f));     \
          act_ = x_ * __builtin_amdgcn_rcpf(1.0f + e_) * gsc_; act_ = (myk_ < c_) ? act_ : 0.f; } \
        float wm_; \
        { unsigned wmu_ = __builtin_bit_cast(unsigned, act_) & 0x7fffffffu;                 \
          v2u t_ = __builtin_amdgcn_permlane32_swap(wmu_, wmu_, false, false); wmu_ = t_.x > t_.y ? t_.x : t_.y; \
          t_ = __builtin_amdgcn_permlane16_swap(wmu_, wmu_, false, false); wmu_ = t_.x > t_.y ? t_.x : t_.y; \
          wm_ = fmaxf(__builtin_bit_cast(float, wmu_), 1e-30f); } \
        const float wq_ = 127.0f * __builtin_amdgcn_rcpf(wm_), ws_ = (SG) * wm_ * (1.0f / 127.0f); \
        unsigned w4u_ = (__builtin_bit_cast(unsigned, __builtin_fmaf(act_, wq_, 12582912.0f)) & 0xffu) << (8 * myk_); \
        { v2u t_ = __builtin_amdgcn_permlane32_swap(w4u_, w4u_, false, false); w4u_ = t_.x | t_.y; t_ = __builtin_amdgcn_permlane16_swap(w4u_, w4u_, false, false); w4u_ = t_.x | t_.y; } \
        const f32x2 ws2_ = (f32x2){ws_, ws_}; \
        _Pragma("unroll") for (int m_ = 0; m_ < 4; ++m_) { \
            const unsigned R0_ = rv[S][0][m_], R1_ = rv[S][1][m_], R2_ = rv[S][2][m_], R3_ = rv[S][3][m_]; \
            const unsigned X_ = __builtin_amdgcn_perm(R1_, R0_, 0x05010400u), Y_ = __builtin_amdgcn_perm(R1_, R0_, 0x07030602u), Z_ = __builtin_amdgcn_perm(R3_, R2_, 0x05010400u), W_ = __builtin_amdgcn_perm(R3_, R2_, 0x07030602u); \
            float t0_, t1_, t2_, t3_; \
            const unsigned b0_ = __builtin_amdgcn_perm(Z_, X_, 0x05040100u), b1_ = __builtin_amdgcn_perm(Z_, X_, 0x07060302u), b2_ = __builtin_amdgcn_perm(W_, Y_, 0x05040100u), b3_ = __builtin_amdgcn_perm(W_, Y_, 0x07060302u); \
            PE_VDOTS(t0_, t1_, t2_, t3_, b0_, b1_, b2_, b3_, w4u_); \
            cur[2 * m_] = __builtin_elementwise_fma((f32x2){t0_, t1_}, ws2_, cur[2 * m_]); \
            cur[2 * m_ + 1] = __builtin_elementwise_fma((f32x2){t2_, t3_}, ws2_, cur[2 * m_ + 1]); } } while (0)
#define PE_FLUSH() do { _Pragma("unroll") for (int J_ = 0; J_ < PE_NT; ++J_) { const float sel_ = (jcur == J_) ? 1.0f : 0.0f; const f32x2 sel2_ = (f32x2){sel_, sel_};     \
            _Pragma("unroll") for (int i_ = 0; i_ < 8; ++i_) acc[J_][i_] = __builtin_elementwise_fma(cur[i_], sel2_, acc[J_][i_]); } \
        _Pragma("unroll") for (int i_ = 0; i_ < 8; ++i_) cur[i_] = (f32x2){0.f, 0.f}; } while (0)
#define PE_COMPUTE_S(S, entv, SG) do { const unsigned en_ = (entv) >> 14; const int jj_ = (int)(en_ & 3u), cc_ = (int)((en_ >> 2) & 7u), ii_ = (int)(en_ >> 5); \
        if (cc_ > 0) { if (jj_ != jcur) { PE_FLUSH(); jcur = jj_; hcur = *(const LAS v4u*)(hql + (jj_ * 64 + lane) * 4); } \
                       PE_COMPUTE_B(S, cc_, ii_, jj_, SG); } } while (0)
#ifdef PE_VALU3
#define PE_COMPUTE(S, entv) do { PE_COMPUTE_S(S, entv, 1.0f); PE_WAIT8(S, "vmcnt(16)"); PE_COMPUTE_S(S, entv, -1.0f); PE_WAIT8(S, "vmcnt(16)"); PE_COMPUTE_S(S, entv, 1.0f); } while (0)
#else
#define PE_COMPUTE(S, entv) PE_COMPUTE_S(S, entv, 1.0f)
#endif
    {
        unsigned er[PE_DEP];
#pragma unroll
        for (int q = 0; q < PE_DEP; ++q) { const v4u rec = *(const LAS v4u*)(ents + 4 * q); er[q] = __builtin_amdgcn_readfirstlane(rec.x); PE_ISSUE(q, rec); }
        f32x2 cur[8];
#pragma unroll
        for (int i = 0; i < 8; ++i) cur[i] = (f32x2){0.f, 0.f};
        int jcur = (int)((er[0] >> 14) & 3u);
        v4u hcur = *(const LAS v4u*)(hql + (jcur * 64 + lane) * 4);
        v4u nrec = *(const LAS v4u*)(ents + 4 * PE_DEP);
#pragma unroll 1
        for (int bi = 0; bi < nb; bi += PE_DEP) {
#pragma unroll
            for (int q = 0; q < PE_DEP; ++q) {
                PE_WAIT8(q, "vmcnt(16)");
                PE_COMPUTE(q, er[q]);
                er[q] = __builtin_amdgcn_readfirstlane(nrec.x);
                PE_ISSUE(q, nrec);
                nrec = *(const LAS v4u*)(ents + 4 * (bi + q + PE_DEP + 1));
            }
        }
#pragma unroll
        for (int q = 0; q < PE_DEP; ++q) PE_WAIT8(q, "vmcnt(0)");
        PE_FLUSH();
    }
#undef PE_COMPUTE
#undef PE_COMPUTE_S
#undef PE_COMPUTE_B
#undef PE_FLUSH
#undef PE_WAIT8
#undef PE_ISSUE
#undef PE_LDO
#undef PE_UDOTS
#undef PE_VDOTS
    asm volatile("v_mbcnt_lo_u32_b32 %0, -1, 0\n\tv_mbcnt_hi_u32_b32 %0, -1, %0" : "=v"(lane)); asm volatile("" : "+s"(tbase));
#pragma unroll
    for (int j = 0; j < PE_NT; ++j) {
        const int t = tbase + j;
        float ss = 0.f; f32x4 xo[4];
        { const v4u* xrow = (const v4u*)((const bf16*)(ws + WS_XB) + (size_t)t * 1024 + 16 * lane); const v4u xa = xrow[0], xc = xrow[1];
          xo[0] = (f32x4){bflo(xa.x), bfhi(xa.x), bflo(xa.y), bfhi(xa.y)}; xo[1] = (f32x4){bflo(xa.z), bfhi(xa.z), bflo(xa.w), bfhi(xa.w)};
          xo[2] = (f32x4){bflo(xc.x), bfhi(xc.x), bflo(xc.y), bfhi(xc.y)}; xo[3] = (f32x4){bflo(xc.z), bfhi(xc.z), bflo(xc.w), bfhi(xc.w)}; }
#pragma unroll
        for (int i = 0; i < 4; ++i) { xo[i].x += acc[j][2 * i].x; xo[i].y += acc[j][2 * i].y; xo[i].z += acc[j][2 * i + 1].x; xo[i].w += acc[j][2 * i + 1].y;
            ss += (xo[i].x * xo[i].x + xo[i].y * xo[i].y) + (xo[i].z * xo[i].z + xo[i].w * xo[i].w); }
        const float rstd3 = rsqrtf(wave_sum(ss) * (1.0f / 1024.0f) + 1e-6f);
        float* orow = dstbase + (size_t)t * 1024 + 16 * lane;
#pragma unroll
        for (int i = 0; i < 4; ++i) { const f32x4 w = ((const f32x4*)(P.norm_final_w + 16 * lane))[i];
            ((f32x4*)orow)[i] = (f32x4){xo[i].x * rstd3 * w.x, xo[i].y * rstd3 * w.y, xo[i].z * rstd3 * w.z, xo[i].w * rstd3 * w.w}; }
    }
    LDS_WAIT(); asm volatile("s_waitcnt vmcnt(0)" ::: "memory");
}


#ifndef TWICE_MASK
#define TWICE_MASK 0
#endif
struct TwiceOrder { pg8::StaticOrder S; int per, reps;
    __device__ bool next(int i, pg8::Unit& u) const { if (i >= per * reps) return false; return S.next(i % per, u); }
    __device__ __forceinline__ void a_ready(const pg8::Unit&) const {} __device__ __forceinline__ void done(const pg8::Unit&) const {} };
template <class B> __device__ __forceinline__ bool rep_again(volatile LAS unsigned* MISC, B& bar) {
    __syncthreads(); const unsigned c = MISC[20]; __syncthreads();
    if (threadIdx.x == 0) MISC[20] = c ^ 1u;
    __syncthreads();
    if (c == 0u) { xcd_barrier(bar); return true; }
    return false;
}
__global__ void __launch_bounds__(NWAVES * 64, 2) hybrid_fwd(Params P) {
    extern __shared__ __attribute__((aligned(16))) unsigned char lds_raw[];
    LAS unsigned char* lds = (LAS unsigned char*)lds_raw;
    volatile LAS unsigned* MISC = (volatile LAS unsigned*)(lds + MISC_OFF);
    const int tid = threadIdx.x, lane = tid & 63, wave = __builtin_amdgcn_readfirstlane(tid >> 6);
    const int G = gridDim.x, bx = blockIdx.x;
    const int vcu = (G % 8 == 0) ? (bx % 8) * (G / 8) + bx / 8 : bx;
    unsigned char* ws = P.ws;
    for (int u = tid; u < 64; u += NWAVES * 64) MISC[u] = 0u;
    __syncthreads();
    XcdBarrier bar; bar.bar = (unsigned*)(ws + WS_CTL) + CW_BAR; bar.x = 0; bar.st = nullptr;
    if (!MK_PER_PHASE) bar = xcd_barrier_post((unsigned*)(ws + WS_CTL) + CW_BAR, MISC + 8);
    const int lo = P.ph_lo, hi = P.ph_hi;
#ifndef PHASE_MASK
#define PHASE_MASK 0xFFF
#endif
#define IN(k) (((PHASE_MASK >> (k)) & 1) && lo <= (k) && (k) < hi)
#define SEAM(k) do { if (IN(k) && IN((k) + 1)) xcd_barrier(bar); } while (0)
#ifndef REP_MASK
#define REP_MASK 0
#endif
#ifndef PE_EXP_MASK
#define PE_EXP_MASK 0x3fff
#endif
#define REPS(k) for (bool again_ = true; again_; again_ = (((REP_MASK >> (k)) & 1) ? rep_again(MISC, bar) : false))
    using namespace pg8;
    bf16* XB = (bf16*)(ws + WS_XB);

    if (IN(0)) REPS(0) { p0_prologue(P, lds, tid, lane, wave, vcu, G); }
    SEAM(0);
    if (IN(1)) REPS(1) {
        { Gemm gm{XB, (const bf16_t*)(ws + WS_WIN), T, 3072, 1024}; StaticOrder S; S.init(T, 3072, G, bx);
          EpiBf16Rs E{(bf16_t*)(ws + WS_QKV), 1536, 6, (bf16_t*)(ws + WS_XR), 512, (size_t)T * 512, nullptr, 1.0f};
          gemm_phase<EpiBf16Rs, StaticOrder, PG8_ALIGN, PG8_SP2>(lds, gm, S, E); }
    }
    SEAM(1);
    if (IN(3)) REPS(3) {
        if (bx < SCAN_WGS) gdn_scan(P, lds, bx, tid, lane, wave);
        else {
            const int wk = bx - SCAN_WGS, NWK = G - SCAN_WGS;
            unsigned* lcnt = (unsigned*)(ws + WS_CTL) + CW_LRUCNT;
            for (int q = wk; q < 1024; q += NWK) gdn_local_item(P, lds, (q & 7) * 128 + (q >> 3), tid);
            unsigned ndone = 0;
            for (int lt = wk; lt < 256; lt += NWK) { lru_local_item(P, lds, lt, tid, lane, wave); ++ndone; }
            asm volatile("s_waitcnt vmcnt(0)" ::: "memory");
            __syncthreads();
            if (tid == 0 && ndone) { __builtin_amdgcn_fence(__ATOMIC_RELEASE, "agent"); asm volatile("s_waitcnt vmcnt(0)" ::: "memory");
                                     __hip_atomic_fetch_add(lcnt, ndone, __ATOMIC_RELAXED, __HIP_MEMORY_SCOPE_AGENT); }
            if (wk < 16) {
                struct OneUnit { int pm, pn; __device__ bool next(int i, Unit& u) const { if (i > 0) return false; u.pm = pm; u.pn = pn; return true; }
                                 __device__ void a_ready(const Unit&) const {} __device__ void done(const Unit&) const {} };
                Gemm gm{(const bf16_t*)(ws + WS_MEMN), (const bf16_t*)(ws + WS_WKV), 512, 2048, 1024}; OneUnit S{wk >> 3, wk & 7};
                EpiKV E{(bf16_t*)(ws + WS_KB), (bf16_t*)(ws + WS_VTP)};
                gemm_phase<EpiKV, OneUnit, PG8_ALIGN, PG8_SP2>(lds, gm, S, E);
            }
            if (wk == 16 || wk == 17) {
                if (tid == 0) { unsigned sp = 0;
                    while (__hip_atomic_load(lcnt, __ATOMIC_RELAXED, __HIP_MEMORY_SCOPE_AGENT) < 256u) { __builtin_amdgcn_s_sleep(8); if (++sp > (1u << 22)) break; }
                    __builtin_amdgcn_fence(__ATOMIC_ACQUIRE, "agent"); asm volatile("s_waitcnt vmcnt(0)" ::: "memory"); }
                __syncthreads();
                lru_carry(P, (wk - 16) * NWAVES + wave, lane);
                asm volatile("s_waitcnt vmcnt(0)" ::: "memory");
                __syncthreads();
                if (tid == 0) { __builtin_amdgcn_fence(__ATOMIC_RELEASE, "agent"); asm volatile("s_waitcnt vmcnt(0)" ::: "memory");
                                __hip_atomic_fetch_add(lcnt + 64, 1u, __ATOMIC_RELAXED, __HIP_MEMORY_SCOPE_AGENT); }
            } else {
                const int w2 = (wk < 16 ? wk : wk - 2), N2 = NWK - 2;
                cvt_table_fp8(P.peer_v, ws + WS_VB, (float*)(ws + WS_VSC), w2 * NWAVES + wave, N2 * NWAVES, lane);
                late_weight_prep(P, lds, lane, wave, w2 * NWAVES + wave, N2 * NWAVES);
                if (tid == 0) { unsigned sp = 0;
                    while (__hip_atomic_load(lcnt + 64, __ATOMIC_RELAXED, __HIP_MEMORY_SCOPE_AGENT) < 2u) { __builtin_amdgcn_s_sleep(8); if (++sp > (1u << 22)) break; }
                    __builtin_amdgcn_fence(__ATOMIC_ACQUIRE, "agent"); asm volatile("s_waitcnt vmcnt(0)" ::: "memory"); }
                __syncthreads();
                lru_combine(P, (size_t)w2 * (NWAVES * 64) + tid, (size_t)N2 * (NWAVES * 64));
            }
        }
    }
    SEAM(3);
    if (IN(4)) REPS(4) {
        gdn_gate_norm(P, (size_t)bx * (NWAVES * 64) + tid, (size_t)G * (NWAVES * 64));
        cvt_table_fp8(P.peer_u, ws + WS_UB, (float*)(ws + WS_USC), bx * NWAVES + wave, G * NWAVES, lane);
    }
    SEAM(4);
    if (IN(5)) {
        Gemm gm{(const bf16_t*)((const unsigned char*)P.out + OUT_Y), (const bf16_t*)(ws + WS_WOUT), T, 1024, 1024}; StaticOrder S; S.init(T, 1024, G, bx);
        EpiResidBf<true> E{P.x, XB, (float*)(ws + WS_SSQ1)};
        gemm_phase<EpiResidBf<true>, StaticOrder, PG8_ALIGN, PG8_SP2>(lds, gm, S, E);
    }
    SEAM(5);
    if (IN(6)) REPS(6) {
        Gemm gm{XB, (const bf16_t*)(ws + WS_WQ), T, 1024, 1024};
        EpiBf16Rs E{(bf16_t*)(ws + WS_Q), 1024, 4, nullptr, 256, 0, (const float*)(ws + WS_SSQ1), 0.0625f};
#if (TWICE_MASK >> 6) & 1
        { TwiceOrder S; S.S.init(T, 1024, G, bx); S.per = 1; S.reps = 2;
          gemm_phase<EpiBf16Rs, TwiceOrder, PG8_ALIGN, PG8_SP2>(lds, gm, S, E); }
#else
        { StaticOrder S; S.init(T, 1024, G, bx);
          gemm_phase<EpiBf16Rs, StaticOrder, PG8_ALIGN, PG8_SP2>(lds, gm, S, E); }
#endif
        Unit u;
        { const int wgid = (bx & 7) * 32 + (bx >> 3); u.pm = (wgid >> 5) * 8 + (wgid & 7); u.pn = (wgid & 31) >> 3; }
        if (G == 256) {
            asm volatile("s_waitcnt vmcnt(0)" ::: "memory");
            __syncthreads();
            const int b = u.pm >> 5, qb0 = (u.pm & 31) * 2, h = u.pn;
#pragma unroll 1
            for (int qq = 0; qq < (((TWICE_MASK >> 7) & 1) ? 4 : 2); qq += XA_NPS) xattn_unit(P, lds, (b << 8) | ((qb0 + (qq & 1)) << 2) | h, tid, lane, wave);
        }
    }
    if (IN(7)) REPS(7) { }
    SEAM(7);
    if (IN(8)) {
        Gemm gm{(const bf16_t*)(ws + WS_AO), (const bf16_t*)(ws + WS_WO), T, 1024, 1024}; StaticOrder S; S.init(T, 1024, G, bx);
        EpiResidBf<false> E{nullptr, XB, (float*)(ws + WS_SSQ2)};
        gemm_phase<EpiResidBf<false>, StaticOrder, PG8_ALIGN, PG8_SP2>(lds, gm, S, E);
    }
    SEAM(8);
    if (IN(9)) REPS(9) {
        Gemm gm{XB, (const bf16_t*)(ws + WS_PWQ), T, 2048, 1024};
        EpiF16Rs E{(_Float16*)(ws + WS_PQ), 2048, (const float*)(ws + WS_SSQ2)};
#if (TWICE_MASK >> 9) & 1
        TwiceOrder S; S.S.init(T, 2048, G, bx); S.per = 2; S.reps = 2;
        gemm_phase<EpiF16Rs, TwiceOrder, PG8_ALIGN, PG8_SP2>(lds, gm, S, E);
#else
        StaticOrder S; S.init(T, 2048, G, bx);
        gemm_phase<EpiF16Rs, StaticOrder, PG8_ALIGN, PG8_SP2>(lds, gm, S, E);
#endif
    }
    SEAM(9);
    if (IN(10)) REPS(10) {
    }
    if (IN(11)) REPS(11) {
#if (TWICE_MASK >> 11) & 1
        for (int it = 0; it < 4; ++it) { const int tb = (bx * NWAVES + wave) * PE_NT + (it >> 1) * (G * NWAVES * PE_NT); if (tb < T) peer_pass(P, lds, tb, lane, wave, P.out, (it & 1) ? 0x3fff : PE_EXP_MASK); }
#else
#ifndef PE_PASS_BARRIER
#define PE_PASS_BARRIER 0
#endif
        for (int tb = (bx * NWAVES + wave) * PE_NT, np = 0; tb < T; tb += G * NWAVES * PE_NT, ++np) {
            if (PE_PASS_BARRIER && np > 0 && (T % (G * NWAVES * PE_NT)) == 0) xcd_barrier(bar);
            peer_pass(P, lds, tb, lane, wave, P.out);
        }
#endif
    }
#undef IN
#undef SEAM
}

extern "C" void kernel_launch(void* const* d_in, const int* in_sizes, int n_in, void* d_out, int out_size, void* d_ws, size_t ws_size, hipStream_t stream) {
    static int grid = 0;
    if (grid == 0) {
        if (n_in != 27 || in_sizes[0] != T * D || out_size != T * D || ws_size < WS_END) {
            fprintf(stderr, "kernel_launch: unexpected shapes (n_in %d, in0 %d, out %d, ws %zu); nothing launched\n", n_in, n_in > 0 ? in_sizes[0] : -1, out_size, ws_size); grid = -1; return; }
        int dev = 0, cus = 0, per_cu = 0;
        if (hipGetDevice(&dev) != hipSuccess || hipDeviceGetAttribute(&cus, hipDeviceAttributeMultiprocessorCount, dev) != hipSuccess) { grid = -1; return; }
        if (hipFuncSetAttribute((const void*)hybrid_fwd, hipFuncAttributeMaxDynamicSharedMemorySize, LDS_BYTES) != hipSuccess) { fprintf(stderr, "kernel_launch: hipFuncSetAttribute failed\n"); grid = -1; return; }
        if (hipOccupancyMaxActiveBlocksPerMultiprocessor(&per_cu, (const void*)hybrid_fwd, NWAVES * 64, LDS_BYTES) != hipSuccess || per_cu < 1)
            fprintf(stderr, "kernel_launch: note: occupancy query reports %d workgroups per CU\n", per_cu);
        (void)hipGetLastError();
        grid = cus;
        if (grid != 256) fprintf(stderr, "kernel_launch: %d CUs (built for 256)\n", grid);
    }
    if (grid < 0) return;
    if (hipMemsetAsync((char*)d_ws + WS_CTL, 0, CTL_ZERO_BYTES, stream) != hipSuccess) { fprintf(stderr, "kernel_launch: hipMemsetAsync failed\n"); return; }
    Params p{};
    const float** pp = (const float**)&p;
    for (int i = 0; i < 27; ++i) pp[i] = (const float*)d_in[i];
    p.out = (float*)d_out; p.ws = (unsigned char*)d_ws;
#if MK_PER_PHASE
    for (int k = 0; k < N_PHASES; ++k) { p.ph_lo = k; p.ph_hi = k + 1; hipLaunchKernelGGL(hybrid_fwd, dim3(grid), dim3(NWAVES * 64), LDS_BYTES, stream, p); }
#else
    p.ph_lo = 0; p.ph_hi = N_PHASES;
    hipLaunchKernelGGL(hybrid_fwd, dim3(grid), dim3(NWAVES * 64), LDS_BYTES, stream, p);
#endif
    const hipError_t le = hipPeekAtLastError();
    if (le != hipSuccess) fprintf(stderr, "kernel_launch: launch failed: %s\n", hipGetErrorName(le));
}
```

```cpp
#include <hip/hip_runtime.h>
#include <cstdio>
#include <cstdint>
namespace pg8 {
#define PG8_LAS __attribute__((address_space(3)))
typedef unsigned short bf16_t;
typedef short bf16x8 __attribute__((ext_vector_type(8)));
typedef float f32x4 __attribute__((ext_vector_type(4)));
typedef unsigned u32x4 __attribute__((ext_vector_type(4)));
constexpr int BM = 256, BK = 64, HALF = 128, HTB = HALF * BK * 2  , STAGE_BYTES = 8 * HTB, NXCD = 8, WGM = 8;

__host__ __device__ __forceinline__ int lds_byte(int r, int c) { const int st = (r >> 4) * 2 + (c >> 5), rr = r & 15, cc = c & 31, ob = rr * 64 + cc * 2; return st * 1024 + (ob ^ (((ob >> 9) & 1) << 5)); }
__host__ __device__ __forceinline__ void stage_rc(int b, int& R, int& C) { const int st = b / 1024, sb = b % 1024, swz = sb ^ (((sb >> 9) & 1) << 5); R = (st >> 1) * 16 + swz / 64; C = (st & 1) * 32 + (swz % 64) / 2; }
__host__ __device__ __forceinline__ int perm32(int rho) { const int n = rho >> 4, i = rho & 15; return 8 * (i >> 2) + 4 * n + (i & 3); }

struct Unit { int pm, pn; };
struct Gemm { const bf16_t* A; const bf16_t* Bt; int M, N, K; };

struct StaticOrder {
    int nM, nN, nwg, G, c;
    __host__ __device__ void init(int M, int N, int G_, int c_) { nM = M / BM; nN = N / BM; nwg = nM * nN; G = G_; c = c_; }
    __host__ __device__ bool next(int i, Unit& u) const {
        const long L = (long)i * G + c; if (L >= nwg) return false;
        int wgid = (int)L; { const int q = nwg / NXCD, r = nwg % NXCD, xcd = wgid % NXCD, off = wgid / NXCD; wgid = (xcd < r ? xcd * (q + 1) : r * (q + 1) + (xcd - r) * q) + off; }
        const int nig = WGM * nN, gid = wgid / nig, fm = gid * WGM, gsz = (nM - fm) < WGM ? (nM - fm) : WGM;
        u.pm = fm + ((wgid % nig) % gsz); u.pn = (wgid % nig) / gsz; return true;
    }
    __device__ __forceinline__ void a_ready(const Unit&) const {}
    __device__ __forceinline__ void done(const Unit&) const {}
};

__device__ __forceinline__ unsigned cvt_pk_bf16(float lo, float hi) { unsigned r; asm volatile("v_cvt_pk_bf16_f32 %0, %1, %2" : "=v"(r) : "v"(lo), "v"(hi)); return r; }
template <class Epi, class Sched, bool ALIGN_EPI = false, bool SP2 = false>
__device__ __forceinline__ void gemm_phase(PG8_LAS unsigned char* lds, const Gemm g, const Sched& S, const Epi& E) {
    const int tid = threadIdx.x, wid = __builtin_amdgcn_readfirstlane(tid >> 6), lane = tid & 63, wr = wid >> 2, wc = wid & 3, fr = lane & 15, fq = lane >> 4;
    const int K = g.K, nt = K / BK;
    unsigned voffA[2], voffB[2];
#pragma unroll
    for (int i = 0; i < 2; ++i) { int R, C; stage_rc(tid * 16 + i * 8192, R, C); const int Rb = Epi::PERM ? ((R & ~31) + perm32(R & 31)) : R;
        voffA[i] = (unsigned)(R * K + C) * 2u; voffB[i] = (unsigned)(Rb * K + C) * 2u; }
    const size_t kstep = (size_t)(BK * 2);
    const size_t hstep = (size_t)HALF * K * 2;
    const size_t tstep = 2 * hstep;
    const unsigned ldsw = (unsigned)wid * 1024u;
    const int aoff = lds_byte(wr * 64 + fr, fq * 8), boff = lds_byte(wc * 32 + fr, fq * 8);
#define PG8_SA(b, h) (((b) * 2 + (h)) * HTB)
#define PG8_SB(b, h) ((4 + (b) * 2 + (h)) * HTB)
#define PG8_STAGE(bufoff, gbase, voff) do { _Pragma("unroll") for (int _i = 0; _i < 2; ++_i) \
        __builtin_amdgcn_global_load_lds((const unsigned*)((const char*)(gbase) + (voff)[_i]), (PG8_LAS unsigned*)(lds + (bufoff) + ldsw + _i * 8192), 16, 0, 0); } while (0)
#define PG8_LDA(dst, b, h) do { _Pragma("unroll") for (int m = 0; m < 4; ++m) _Pragma("unroll") for (int k = 0; k < 2; ++k) dst[m][k] = *(const PG8_LAS bf16x8*)(lds + PG8_SA(b, h) + aoff + m * 2048 + k * 1024); } while (0)
#define PG8_LDB(dst, b, h) do { _Pragma("unroll") for (int n = 0; n < 2; ++n) _Pragma("unroll") for (int k = 0; k < 2; ++k) dst[n][k] = *(const PG8_LAS bf16x8*)(lds + PG8_SB(b, h) + boff + n * 2048 + k * 1024); } while (0)
#define PG8_MMA(ai, bj, At, Bt) do { __builtin_amdgcn_s_setprio(1); _Pragma("unroll") for (int m = 0; m < 4; ++m) _Pragma("unroll") for (int n = 0; n < 2; ++n) _Pragma("unroll") for (int k = 0; k < 2; ++k) \
        acc[ai][bj][m][n] = __builtin_amdgcn_mfma_f32_16x16x32_bf16(Bt[n][k], At[m][k], acc[ai][bj][m][n], 0, 0, 0); __builtin_amdgcn_s_setprio(0); } while (0)
#define PG8_WAIT_V(n) asm volatile("s_waitcnt vmcnt(" #n ")" ::: "memory")
#define PG8_WAIT_L(n) asm volatile("s_waitcnt lgkmcnt(" #n ")" ::: "memory")
#define PG8_BAR __builtin_amdgcn_s_barrier()
#define PG8_SCHED __builtin_amdgcn_sched_barrier(0)
    Unit cur, nxt; int ui = 0;
    if (!S.next(0, cur)) return;
    f32x4 acc[2][2][4][2];
#pragma unroll
    for (int a = 0; a < 2; ++a)
#pragma unroll
        for (int b = 0; b < 2; ++b)
#pragma unroll
            for (int m = 0; m < 4; ++m)
#pragma unroll
                for (int n = 0; n < 2; ++n) acc[a][b][m][n] = (f32x4){0.f, 0.f, 0.f, 0.f};
    bf16x8 At[4][2], B0[2][2], B1[2][2];
    const char* cA = (const char*)g.A + (size_t)cur.pm * tstep; const char* cB = (const char*)g.Bt + (size_t)cur.pn * tstep;
    S.a_ready(cur);
    if constexpr (SP2) {
        PG8_STAGE(PG8_SB(0, 0), cB, voffB); PG8_STAGE(PG8_SB(0, 1), cB + hstep, voffB); PG8_STAGE(PG8_SA(0, 0), cA, voffA); PG8_STAGE(PG8_SA(0, 1), cA + hstep, voffA);
        if (wr == 1) PG8_BAR;
        PG8_WAIT_V(2); PG8_BAR;
        PG8_STAGE(PG8_SB(1, 0), cB + kstep, voffB); PG8_STAGE(PG8_SA(1, 0), cA + kstep, voffA); PG8_STAGE(PG8_SB(1, 1), cB + hstep + kstep, voffB);
        PG8_WAIT_V(6); PG8_BAR;
    } else {
        PG8_STAGE(PG8_SB(0, 0), cB, voffB); PG8_STAGE(PG8_SA(0, 0), cA, voffA); PG8_STAGE(PG8_SB(0, 1), cB + hstep, voffB); PG8_STAGE(PG8_SA(0, 1), cA + hstep, voffA);
        if (wr == 1) PG8_BAR;
        PG8_WAIT_V(4); PG8_BAR;
        PG8_STAGE(PG8_SB(1, 0), cB + kstep, voffB); PG8_STAGE(PG8_SA(1, 0), cA + kstep, voffA); PG8_STAGE(PG8_SB(1, 1), cB + hstep + kstep, voffB);
        PG8_WAIT_V(6); PG8_BAR;
    }
    for (;;) {
        const bool has_next = S.next(ui + 1, nxt);
        const char* nA = has_next ? (const char*)g.A + (size_t)nxt.pm * tstep : cA; const char* nB = has_next ? (const char*)g.Bt + (size_t)nxt.pn * tstep : cB;
        for (int t = 0; t < nt; t += 2) {
            const bool last = (t == nt - 2);
            const char* a1 = cA + (size_t)(t + 1) * kstep;
            const char* a2 = last ? nA : cA + (size_t)(t + 2) * kstep; const char* b2 = last ? nB : cB + (size_t)(t + 2) * kstep;
            const char* a3 = a2 + kstep; const char* b3 = b2 + kstep;
            if (last && has_next) S.a_ready(nxt);
            if constexpr (SP2) {
            PG8_LDB(B0, 0, 0); PG8_LDB(B1, 0, 1); PG8_SCHED; PG8_LDA(At, 0, 0); PG8_STAGE(PG8_SA(1, 1), a1 + hstep, voffA);
            PG8_WAIT_V(8); PG8_WAIT_L(0); PG8_BAR; PG8_MMA(0, 0, At, B0); PG8_MMA(0, 1, At, B1); PG8_BAR; PG8_SCHED;
            PG8_LDA(At, 0, 1); PG8_STAGE(PG8_SB(0, 0), b2, voffB); PG8_STAGE(PG8_SB(0, 1), b2 + hstep, voffB); PG8_STAGE(PG8_SA(0, 0), a2, voffA);
            PG8_WAIT_V(8); PG8_WAIT_L(0); PG8_BAR; PG8_MMA(1, 0, At, B0); PG8_MMA(1, 1, At, B1); PG8_BAR; PG8_SCHED;
            PG8_LDB(B0, 1, 0); PG8_LDB(B1, 1, 1); PG8_SCHED; PG8_LDA(At, 1, 0); PG8_STAGE(PG8_SA(0, 1), a2 + hstep, voffA);
            PG8_WAIT_V(8); PG8_WAIT_L(0); PG8_BAR; PG8_MMA(0, 0, At, B0); PG8_MMA(0, 1, At, B1); PG8_BAR; PG8_SCHED;
            PG8_LDA(At, 1, 1); PG8_STAGE(PG8_SB(1, 0), b3, voffB); PG8_STAGE(PG8_SB(1, 1), b3 + hstep, voffB); PG8_STAGE(PG8_SA(1, 0), a3, voffA);
            PG8_WAIT_V(8); PG8_WAIT_L(0); PG8_BAR; PG8_MMA(1, 0, At, B0); PG8_MMA(1, 1, At, B1); PG8_BAR; PG8_SCHED;
            } else {
            PG8_LDB(B0, 0, 0); PG8_SCHED; PG8_LDA(At, 0, 0); PG8_STAGE(PG8_SA(1, 1), a1 + hstep, voffA);
            PG8_WAIT_L(8); PG8_BAR; PG8_WAIT_L(0); PG8_MMA(0, 0, At, B0); PG8_BAR; PG8_SCHED;
            PG8_LDB(B1, 0, 1); PG8_STAGE(PG8_SB(0, 0), b2, voffB);
            PG8_BAR; PG8_WAIT_L(0); PG8_MMA(0, 1, At, B1); PG8_BAR;
            PG8_LDA(At, 0, 1); PG8_STAGE(PG8_SA(0, 0), a2, voffA);
            PG8_BAR; PG8_WAIT_L(0); PG8_MMA(1, 0, At, B0); PG8_BAR; PG8_SCHED;
            PG8_STAGE(PG8_SB(0, 1), b2 + hstep, voffB);
            PG8_WAIT_V(6); PG8_BAR; PG8_MMA(1, 1, At, B1); PG8_BAR;
            PG8_LDB(B0, 1, 0); PG8_SCHED; PG8_LDA(At, 1, 0); PG8_STAGE(PG8_SA(0, 1), a2 + hstep, voffA);
            PG8_WAIT_L(8); PG8_BAR; PG8_WAIT_L(0); PG8_MMA(0, 0, At, B0); PG8_BAR; PG8_SCHED;
            PG8_LDB(B1, 1, 1); PG8_STAGE(PG8_SB(1, 0), b3, voffB);
            PG8_BAR; PG8_WAIT_L(0); PG8_MMA(0, 1, At, B1); PG8_BAR;
            PG8_LDA(At, 1, 1); PG8_STAGE(PG8_SA(1, 0), a3, voffA);
            PG8_BAR; PG8_WAIT_L(0); PG8_MMA(1, 0, At, B0); PG8_BAR; PG8_SCHED;
            PG8_STAGE(PG8_SB(1, 1), b3 + hstep, voffB);
            PG8_WAIT_V(6); PG8_BAR; PG8_MMA(1, 1, At, B1); PG8_BAR;
            }
        }
        if constexpr (ALIGN_EPI) { if (wr == 0) PG8_BAR; }
        if constexpr (!Epi::AFTER_DRAIN) { E(acc, cur, wr, wc, fr, fq); S.done(cur); }
        if (!has_next) break;
#pragma unroll
        for (int a = 0; a < 2; ++a)
#pragma unroll
            for (int b = 0; b < 2; ++b)
#pragma unroll
                for (int m = 0; m < 4; ++m)
#pragma unroll
                    for (int n = 0; n < 2; ++n) acc[a][b][m][n] = (f32x4){0.f, 0.f, 0.f, 0.f};
        cur = nxt; cA = nA; cB = nB; ++ui;
        if constexpr (ALIGN_EPI) { if (wr == 1) PG8_BAR; }
    }
    PG8_WAIT_V(0);
    if constexpr (!ALIGN_EPI) { if (wr == 0) PG8_BAR; }
    PG8_BAR;
    if constexpr (Epi::AFTER_DRAIN) { E.fused(acc, cur, wr, wc, fr, fq, lds, wid, lane); S.done(cur); }
#undef PG8_SA
#undef PG8_SB
#undef PG8_STAGE
#undef PG8_LDA
#undef PG8_LDB
#undef PG8_MMA
#undef PG8_WAIT_V
#undef PG8_WAIT_L
#undef PG8_BAR
#undef PG8_SCHED
}
}

namespace pg8 {
__host__ __device__ __forceinline__ int permk(int kl) { return 8 * ((kl & 15) >> 2) + 4 * (kl >> 4) + (kl & 3); }
struct EpiBf16Rs {
    static constexpr bool PERM = true, AFTER_DRAIN = false;
    bf16_t* O0; int ld0; int ntile0; bf16_t* O1; int ld1; size_t stride1; const float* ssq; float cs;
    __device__ __forceinline__ void operator()(const f32x4 (&acc)[2][2][4][2], const Unit& u, int wr, int wc, int fr, int fq) const {
        bf16_t* base; int ld, colt;
        if (u.pn < ntile0) { base = O0; ld = ld0; colt = u.pn * BM; }
        else { const int q = u.pn - ntile0, per = ld1 / BM; base = O1 + (size_t)(q / per) * stride1; ld = ld1; colt = (q % per) * BM; }
        const int row0 = u.pm * BM + wr * 64 + fr, col0 = colt + wc * 32 + 8 * fq;
#pragma unroll
        for (int ai = 0; ai < 2; ++ai)
#pragma unroll
            for (int m = 0; m < 4; ++m) {
                const int row = row0 + ai * HALF + m * 16;
                float sc = cs; if (ssq) sc *= rsqrtf(ssq[row] * (1.0f / 1024.0f) + 1e-6f);
                bf16_t* rowp = base + (size_t)row * ld + col0;
#pragma unroll
                for (int bj = 0; bj < 2; ++bj) { const f32x4 v0 = acc[ai][bj][m][0] * sc, v1 = acc[ai][bj][m][1] * sc;
                    u32x4 w; w.x = cvt_pk_bf16(v0[0], v0[1]); w.y = cvt_pk_bf16(v0[2], v0[3]); w.z = cvt_pk_bf16(v1[0], v1[1]); w.w = cvt_pk_bf16(v1[2], v1[3]);
                    *(u32x4*)(rowp + bj * HALF) = w; } }
    }
};
struct EpiF16Rs {
    static constexpr bool PERM = true, AFTER_DRAIN = false;
    _Float16* O; int ld; const float* ssq;
    __device__ __forceinline__ void operator()(const f32x4 (&acc)[2][2][4][2], const Unit& u, int wr, int wc, int fr, int fq) const {
        typedef _Float16 f16x8 __attribute__((ext_vector_type(8)));
        const int row0 = u.pm * BM + wr * 64 + fr, col0 = u.pn * BM + wc * 32 + 8 * fq;
#pragma unroll
        for (int ai = 0; ai < 2; ++ai)
#pragma unroll
            for (int m = 0; m < 4; ++m) {
                const int row = row0 + ai * HALF + m * 16;
                const float sc = rsqrtf(ssq[row] * (1.0f / 1024.0f) + 1e-6f);
                _Float16* rowp = O + (size_t)row * ld + col0;
#pragma unroll
                for (int bj = 0; bj < 2; ++bj) { const f32x4 v0 = acc[ai][bj][m][0] * sc, v1 = acc[ai][bj][m][1] * sc;
                    f16x8 w; w[0] = (_Float16)v0[0]; w[1] = (_Float16)v0[1]; w[2] = (_Float16)v0[2]; w[3] = (_Float16)v0[3];
                    w[4] = (_Float16)v1[0]; w[5] = (_Float16)v1[1]; w[6] = (_Float16)v1[2]; w[7] = (_Float16)v1[3];
                    *(f16x8*)(rowp + bj * HALF) = w; } }
    }
};
template <bool BASE_F32> struct EpiResidBf {
    static constexpr bool PERM = true, AFTER_DRAIN = false;
    const float* basef; bf16_t* xb; float* ssq;
    __device__ __forceinline__ void operator()(const f32x4 (&acc)[2][2][4][2], const Unit& u, int wr, int wc, int fr, int fq) const {
        const int row0 = u.pm * BM + wr * 64 + fr, col0 = u.pn * BM + wc * 32 + 8 * fq;
#pragma unroll
        for (int ai = 0; ai < 2; ++ai)
#pragma unroll
            for (int m = 0; m < 4; ++m) {
                const int row = row0 + ai * HALF + m * 16; const size_t off = (size_t)row * 1024 + col0; float s = 0.f;
#pragma unroll
                for (int bj = 0; bj < 2; ++bj) { const size_t o2 = off + bj * HALF;
                    f32x4 b0, b1;
                    if (BASE_F32) { b0 = *(const f32x4*)(basef + o2); b1 = *(const f32x4*)(basef + o2 + 4); }
                    else { const u32x4 p = *(const u32x4*)(xb + o2);
                        b0 = (f32x4){__builtin_bit_cast(float, p.x << 16), __builtin_bit_cast(float, p.x & 0xffff0000u), __builtin_bit_cast(float, p.y << 16), __builtin_bit_cast(float, p.y & 0xffff0000u)};
                        b1 = (f32x4){__builtin_bit_cast(float, p.z << 16), __builtin_bit_cast(float, p.z & 0xffff0000u), __builtin_bit_cast(float, p.w << 16), __builtin_bit_cast(float, p.w & 0xffff0000u)}; }
                    const f32x4 o0 = b0 + acc[ai][bj][m][0], o1 = b1 + acc[ai][bj][m][1];
                    s += ((o0[0] * o0[0] + o0[1] * o0[1]) + (o0[2] * o0[2] + o0[3] * o0[3])) + ((o1[0] * o1[0] + o1[1] * o1[1]) + (o1[2] * o1[2] + o1[3] * o1[3]));
                    u32x4 w; w.x = cvt_pk_bf16(o0[0], o0[1]); w.y = cvt_pk_bf16(o0[2], o0[3]); w.z = cvt_pk_bf16(o1[0], o1[1]); w.w = cvt_pk_bf16(o1[2], o1[3]);
                    *(u32x4*)(xb + o2) = w; }
                s += __shfl_xor(s, 16); s += __shfl_xor(s, 32);
                if (fq == 0) atomicAdd(ssq + row, s);
            }
    }
};
struct EpiKV {
    static constexpr bool PERM = false, AFTER_DRAIN = false;
    bf16_t* Kb; bf16_t* VTp;
    __device__ __forceinline__ void operator()(const f32x4 (&acc)[2][2][4][2], const Unit& u, int wr, int wc, int fr, int fq) const {
        typedef unsigned u32x2v __attribute__((ext_vector_type(2)));
        const int row0 = u.pm * BM + wr * 64 + fr, col0 = u.pn * BM + wc * 32 + 4 * fq;
#pragma unroll
        for (int ai = 0; ai < 2; ++ai)
#pragma unroll
            for (int m = 0; m < 4; ++m) {
                const int row = row0 + ai * HALF + m * 16, b = row >> 8, key = row & 255;
#pragma unroll
                for (int bj = 0; bj < 2; ++bj)
#pragma unroll
                    for (int n = 0; n < 2; ++n) { const int col = col0 + bj * HALF + n * 16; const f32x4 v = acc[ai][bj][m][n];
                        const unsigned p01 = cvt_pk_bf16(v[0], v[1]), p23 = cvt_pk_bf16(v[2], v[3]);
                        if (col < 1024) { const int h = col >> 8, dh = col & 255; u32x2v w; w.x = p01; w.y = p23;
                            *(u32x2v*)(Kb + ((size_t)((b * 4 + h) * 256 + key)) * 256 + dh) = w; }
                        else { const int c2 = col - 1024, h = c2 >> 8, dv = c2 & 255, kp = (key & ~31) | permk(key & 31);
                            bf16_t* d = VTp + ((size_t)((b * 4 + h) * 256 + dv)) * 256 + kp;
                            d[0] = (bf16_t)(p01 & 0xffffu); d[256] = (bf16_t)(p01 >> 16); d[512] = (bf16_t)(p23 & 0xffffu); d[768] = (bf16_t)(p23 >> 16); } }
            }
    }
};
}
#ifndef PG8_SP2
#define PG8_SP2 true
#endif
#ifndef PG8_ALIGN
#define PG8_ALIGN true
#endif

constexpr int NWAVES = 8;
#ifndef MK_PER_PHASE
#define MK_PER_PHASE 0
#endif
constexpr int T = 16384, SEQ = 8192, D = 1024;
constexpr int N_PHASES = 12;

constexpr size_t MiB = 1u << 20, KiB = 1u << 10;
constexpr size_t WS_CTL = 0, CTL_ZERO_BYTES = 1 * MiB;
constexpr int CW_BAR = 4096;
constexpr size_t WS_SSQ1 = 64 * KiB, WS_SSQ2 = 128 * KiB;
constexpr size_t WS_AB = 1 * MiB;
constexpr size_t WS_HEND = WS_AB + 512 * KiB, WS_PEND = WS_HEND + 512 * KiB, WS_HIN = WS_PEND + 512 * KiB;
constexpr size_t WS_DEC = WS_HIN + 512 * KiB;
constexpr size_t WS_SUBK = 3 * MiB + 256 * KiB;
constexpr size_t WS_WIN = 4 * MiB, WS_WOUT = 10 * MiB, WS_WQ = 12 * MiB, WS_WKV = 14 * MiB, WS_WO = 18 * MiB, WS_PWQ = 20 * MiB;
constexpr size_t WS_MEMN = 24 * MiB, WS_KB = 25 * MiB, WS_VTP = 26 * MiB, WS_LRUWT = 27 * MiB, WS_USC = 27 * MiB + 256 * KiB, WS_VSC = 27 * MiB + 384 * KiB;
constexpr size_t WS_XB = 28 * MiB;
constexpr size_t WS_HLOC = 28 * MiB, WS_PCUM = 44 * MiB;
constexpr size_t WS_QKV = 60 * MiB;
constexpr size_t OUT_Y = 4 * MiB;
constexpr size_t OUT_END = OUT_Y + (size_t)16384 * 1024 * 2;
constexpr size_t WS_IDX = 60 * MiB, WS_GW = 68 * MiB;
constexpr size_t WS_UB = 60 * MiB;
constexpr size_t WS_XR = 108 * MiB, WS_Z = 124 * MiB, WS_GATE = 140 * MiB;
constexpr size_t WS_WN = 156 * MiB, WS_UF = 172 * MiB, WS_QD = 188 * MiB, WS_KD = 204 * MiB, WS_ATT = 220 * MiB;
constexpr size_t WS_VB = 228 * MiB;
constexpr size_t WS_Q = 188 * MiB, WS_AO = 124 * MiB;
constexpr size_t WS_PQ = 108 * MiB;
constexpr size_t WS_END = 244 * MiB;
constexpr int CW_GFLAG = 49152;
constexpr int CW_LRUCNT = 8192;
static_assert(WS_XR - WS_QKV == (size_t)T * 1536 * 2 && WS_Z - WS_XR == (size_t)T * 512 * 2 && WS_GATE - WS_Z == (size_t)T * 512 * 2, "in-proj outputs are contiguous");

constexpr int LDS_BYTES = 160 * 1024;
constexpr int MISC_OFF = 159 * 1024;

#define GAS __attribute__((address_space(1)))
#define LAS __attribute__((address_space(3)))
typedef unsigned short bf16;
typedef unsigned v4u __attribute__((ext_vector_type(4)));
typedef unsigned v2u __attribute__((ext_vector_type(2)));
typedef float f32x4 __attribute__((ext_vector_type(4)));
typedef short bf16x8 __attribute__((ext_vector_type(8)));
typedef GAS unsigned gu32;
#define LDS_WAIT() asm volatile("s_waitcnt lgkmcnt(0)" ::: "memory")
__device__ __forceinline__ void st16_wt(void* p, v4u v) { asm volatile("global_store_dwordx4 %0, %1, off sc0 sc1\n\ts_nop 1" :: "v"(p), "v"(v) : "memory"); }
__device__ __forceinline__ unsigned f2bf(float f) { unsigned u = __builtin_bit_cast(unsigned, f); return (u + 0x7fffu + ((u >> 16) & 1u)) >> 16; }
__device__ __forceinline__ unsigned pk2(float lo, float hi) { return f2bf(lo) | (f2bf(hi) << 16); }
__device__ __forceinline__ float bflo(unsigned u) { return __builtin_bit_cast(float, u << 16); }
__device__ __forceinline__ float bfhi(unsigned u) { return __builtin_bit_cast(float, u & 0xffff0000u); }
__device__ __forceinline__ float bf1(bf16 h) { return __builtin_bit_cast(float, (unsigned)h << 16); }
__device__ __forceinline__ float wave_sum(float v) {
#pragma unroll
    for (int o = 1; o < 64; o <<= 1) v += __shfl_xor(v, o);
    return v;
}
__device__ __forceinline__ float row16_sum(float v) {
    v += __builtin_bit_cast(float, __builtin_amdgcn_update_dpp(0, __builtin_bit_cast(int, v), 0xB1, 0xF, 0xF, true));
    v += __builtin_bit_cast(float, __builtin_amdgcn_update_dpp(0, __builtin_bit_cast(int, v), 0x4E, 0xF, 0xF, true));
    v += __builtin_bit_cast(float, __builtin_amdgcn_update_dpp(0, __builtin_bit_cast(int, v), 0x141, 0xF, 0xF, true));
    v += __builtin_bit_cast(float, __builtin_amdgcn_update_dpp(0, __builtin_bit_cast(int, v), 0x140, 0xF, 0xF, true));
    return v;
}
__device__ __forceinline__ float sigmoidf_(float x) { return __builtin_amdgcn_rcpf(1.0f + __expf(-x)); }
__device__ __forceinline__ float softplusf_(float x) { return fmaxf(x, 0.f) + log1pf(__expf(-fabsf(x))); }
__device__ __forceinline__ float siluf_(float x) { return x * __builtin_amdgcn_rcpf(1.0f + __expf(-x)); }
__device__ __forceinline__ float gelu_tanh(float x) { const float y = 0.7978845608028654f * (x + 0.044715f * x * x * x); const float e = __expf(2.0f * y); return x * (1.0f - __builtin_amdgcn_rcpf(1.0f + e)); }
__device__ __forceinline__ int permk(int kl) { return 8 * ((kl & 15) >> 2) + 4 * (kl >> 4) + (kl & 3); }

struct Params {
    const float *x, *mem, *norm_mix_w, *w_in, *conv_qkv_w, *gdn_a_log, *gdn_dt_bias, *gdn_norm_w, *lru_conv_w, *lru_conv_b, *lru_wa, *lru_ba, *lru_wx, *lru_bx, *lru_lambda, *w_out,
                *norm_xattn_w, *norm_mem_w, *xattn_wq, *xattn_wkv, *xattn_wo, *norm_ffn_w, *peer_wq, *peer_subkeys, *peer_u, *peer_v, *norm_final_w;
    float* out; unsigned char* ws; int ph_lo, ph_hi;
};
#define XB_TMO      128
#define XB_XCNT(j)  (256  + 64 * (j))
#define XB_XSUB(j)  (1280 + 64 * (j))
#define XB_XGEN(j)  (2304 + 64 * (j))
#define XB_TOP      3328
#define XB_TOPGEN   3392
#define XCD_BAR_WORDS 3456
#define XB_SPIN_CAP (1u << 18)

__device__ __forceinline__ unsigned xb_ld(unsigned* p)              { return __hip_atomic_load(p, __ATOMIC_RELAXED, __HIP_MEMORY_SCOPE_AGENT); }
__device__ __forceinline__ unsigned xb_add(unsigned* p, unsigned v) { return __hip_atomic_fetch_add(p, v, __ATOMIC_RELAXED, __HIP_MEMORY_SCOPE_AGENT); }
__device__ __forceinline__ unsigned xb_xcc_id() { return (unsigned)__builtin_amdgcn_s_getreg((3 << 11) | 20) & 0xFu; }
#define XB_SPIN(cond, bar) do { unsigned _sp = 0; while (cond) { __builtin_amdgcn_s_sleep(1); \
    if ((++_sp & 255u) == 0u) { if (xb_ld(&(bar)[XB_TMO])) break; if (_sp > XB_SPIN_CAP) { atomicAdd(&(bar)[XB_TMO], 1u); break; } } } } while (0)

struct XcdBarrier {
    unsigned* bar; unsigned x;
    volatile LAS unsigned* st;
};

__device__ __forceinline__ XcdBarrier xcd_barrier_post(unsigned* bar, volatile LAS unsigned* st) {
    XcdBarrier b; b.bar = bar; b.x = xb_xcc_id(); b.st = st;
    if (threadIdx.x == 0) (void)xb_add(&bar[XB_XCNT(b.x)], 1u);
    return b;
}
__device__ __forceinline__ void xcd_barrier_complete(unsigned* bar, unsigned x, unsigned& nloc, unsigned& nx) {
    const unsigned G = gridDim.x * gridDim.y * gridDim.z;
    unsigned sum, cnt, mine, sp = 0u;
    for (;;) {
        sum = 0u; cnt = 0u; mine = 0u;
#pragma unroll
        for (unsigned j = 0; j < 16; ++j) { const unsigned c = xb_ld(&bar[XB_XCNT(j)]); sum += c; cnt += (c > 0u) ? 1u : 0u; mine = (j == x) ? c : mine; }
        if (sum == G) break;
        __builtin_amdgcn_s_sleep(1);
        if ((++sp & 255u) == 0u) { if (xb_ld(&bar[XB_TMO])) break; if (sp > XB_SPIN_CAP) { atomicAdd(&bar[XB_TMO], 1u); break; } }
    }
    nloc = mine > 0u ? mine : 1u; nx = cnt > 0u ? cnt : 1u;
}

__device__ __forceinline__ void xcd_barrier(const XcdBarrier& b) {
    asm volatile("s_waitcnt vmcnt(0)" ::: "memory");
    __syncthreads();
    if (threadIdx.x == 0) {
        unsigned* bar = b.bar;
        __builtin_amdgcn_s_waitcnt(0);
        unsigned nloc = b.st[0], nx = b.st[1];
        if (nloc == 0u) { xcd_barrier_complete(bar, b.x, nloc, nx); b.st[0] = nloc; b.st[1] = nx; }
        const unsigned old = xb_add(&bar[XB_XSUB(b.x)], 1u);
        const unsigned gen = old / nloc;
        if (old + 1u == (gen + 1u) * nloc) {
            __builtin_amdgcn_fence(__ATOMIC_RELEASE, "agent");
            asm volatile("s_waitcnt vmcnt(0)" ::: "memory");
            const unsigned og = xb_add(&bar[XB_TOP], 1u);
            const unsigned tg = og / nx;
            if (og + 1u == (tg + 1u) * nx) xb_add(&bar[XB_TOPGEN], 1u);
            else XB_SPIN(xb_ld(&bar[XB_TOPGEN]) == tg, bar);
            __builtin_amdgcn_fence(__ATOMIC_ACQUIRE, "agent");
            xb_add(&bar[XB_XGEN(b.x)], 1u);
            asm volatile("s_waitcnt vmcnt(0)" ::: "memory");
        } else {
            XB_SPIN(xb_ld(&bar[XB_XGEN(b.x)]) == gen, bar);
            __builtin_amdgcn_fence(__ATOMIC_ACQUIRE, "agent");
            asm volatile("s_waitcnt vmcnt(0)" ::: "memory");
        }
    }
    __syncthreads();
}

__device__ __forceinline__ void p0_transpose_item(const float* W, int K, int ldw, int c0, int nblk, bf16* WT, int row_off, const float* ks, LAS float* scr, int item, int lane) {
    const int kb = item / nblk, nb = item % nblk, k0 = 64 * kb, n0 = 32 * nb;
#pragma unroll 8
    for (int i = 0; i < 32; ++i) { const int kk = 2 * i + (lane >> 5); float v = W[(size_t)(k0 + kk) * ldw + c0 + n0 + (lane & 31)]; if (ks) v *= ks[k0 + kk]; scr[kk * 33 + (lane & 31)] = v; }
    LDS_WAIT(); asm volatile("" ::: "memory");
    const int c = lane & 7;
#pragma unroll
    for (int j = 0; j < 4; ++j) { const int n = (lane >> 3) + 8 * j; const LAS float* s = scr + (8 * c) * 33 + n;
        v4u o; o.x = pk2(s[0 * 33], s[1 * 33]); o.y = pk2(s[2 * 33], s[3 * 33]); o.z = pk2(s[4 * 33], s[5 * 33]); o.w = pk2(s[6 * 33], s[7 * 33]);
        *(GAS v4u*)(WT + (size_t)(row_off + n0 + n) * K + k0 + 8 * c) = o; }
    LDS_WAIT(); asm volatile("" ::: "memory");
}

__device__ __forceinline__ void p0_prologue(const Params& P, LAS unsigned char* lds, int tid, int lane, int wave, int vcu, int G) {
    unsigned char* ws = P.ws;
    const int gw = vcu * NWAVES + wave, NGW = G * NWAVES;
    LAS float* wabl = (LAS float*)lds;
    for (int idx = tid; idx < 8192; idx += NWAVES * 64) { const int k = idx >> 3, c = idx & 7, j = k >> 8, l = (k >> 2) & 63, e = k & 3;
        wabl[((((j * 4 + e) * 2 + (c >> 2)) * 64 + l) << 2) + (c & 3)] = P.w_in[(size_t)k * 3080 + 2048 + c]; }
    __syncthreads();
    {
        bf16* XB0 = (bf16*)(ws + WS_XB); float* AB = (float*)(ws + WS_AB);
        f32x4 w4[4];
#pragma unroll
        for (int j = 0; j < 4; ++j) w4[j] = ((const f32x4*)P.norm_mix_w)[64 * j + lane];
        for (int m = gw; m < T; m += NGW) {
            const f32x4* xr = (const f32x4*)(P.x + (size_t)m * D) + lane;
            f32x4 v[4]; float s = 0.f;
#pragma unroll
            for (int j = 0; j < 4; ++j) { v[j] = xr[64 * j]; s += (v[j].x * v[j].x + v[j].y * v[j].y) + (v[j].z * v[j].z + v[j].w * v[j].w); }
            const float rstd = rsqrtf(wave_sum(s) * (1.0f / D) + 1e-6f);
            v2u* o8 = (v2u*)(XB0 + (size_t)m * D) + lane;
            float part[8];
#pragma unroll
            for (int c = 0; c < 8; ++c) part[c] = 0.f;
#pragma unroll
            for (int j = 0; j < 4; ++j) {
                v[j] = v[j] * rstd * w4[j];
                v2u o; o.x = pk2(v[j].x, v[j].y); o.y = pk2(v[j].z, v[j].w); o8[64 * j] = o;
#pragma unroll
                for (int e = 0; e < 4; ++e) {
                    const f32x4 wa = *(const LAS f32x4*)(wabl + ((((j * 4 + e) * 2 + 0) * 64 + lane) << 2));
                    const f32x4 wb = *(const LAS f32x4*)(wabl + ((((j * 4 + e) * 2 + 1) * 64 + lane) << 2));
                    const float hv = v[j][e];
                    part[0] += hv * wa.x; part[1] += hv * wa.y; part[2] += hv * wa.z; part[3] += hv * wa.w;
                    part[4] += hv * wb.x; part[5] += hv * wb.y; part[6] += hv * wb.z; part[7] += hv * wb.w;
                }
            }
#pragma unroll
            for (int c = 0; c < 8; ++c) part[c] = wave_sum(part[c]);
            float o = part[0];
#pragma unroll
            for (int c = 1; c < 8; ++c) o = (lane == c) ? part[c] : o;
            if (lane < 8) AB[(size_t)m * 8 + lane] = o;
        }
    }
    {
        bf16* MEMN = (bf16*)(ws + WS_MEMN);
        for (int m = gw; m < 512; m += NGW) {
            const f32x4* xr = (const f32x4*)(P.mem + (size_t)m * D) + lane;
            f32x4 v[4]; float s = 0.f;
#pragma unroll
            for (int j = 0; j < 4; ++j) { v[j] = xr[64 * j]; s += (v[j].x * v[j].x + v[j].y * v[j].y) + (v[j].z * v[j].z + v[j].w * v[j].w); }
            const float rstd = rsqrtf(wave_sum(s) * (1.0f / D) + 1e-6f);
            v2u* o8 = (v2u*)(MEMN + (size_t)m * D) + lane;
#pragma unroll
            for (int j = 0; j < 4; ++j) { const f32x4 w = ((const f32x4*)P.norm_mem_w)[64 * j + lane]; const f32x4 y = v[j] * rstd * w;
                v2u o; o.x = pk2(y.x, y.y); o.y = pk2(y.z, y.w); o8[64 * j] = o; }
        }
    }
    __syncthreads();
    {
        LAS float* scr = (LAS float*)(lds + wave * 16384);
        constexpr int I_IN1 = 16 * 48, I_IN2 = 16 * 16, I_KV = 16 * 64;
        constexpr int NITEMS = I_IN1 + 3 * I_IN2 + I_KV;
        for (int it = gw; it < NITEMS; it += NGW) {
            int r = it;
            if (r < I_IN1) { p0_transpose_item(P.w_in, 1024, 3080, 0, 48, (bf16*)(ws + WS_WIN), 0, nullptr, scr, r, lane); continue; } r -= I_IN1;
            if (r < I_IN2) { p0_transpose_item(P.w_in, 1024, 3080, 2056, 16, (bf16*)(ws + WS_WIN), 1536, nullptr, scr, r, lane); continue; } r -= I_IN2;
            if (r < I_IN2) { p0_transpose_item(P.w_in, 1024, 3080, 1536, 16, (bf16*)(ws + WS_WIN), 2048, nullptr, scr, r, lane); continue; } r -= I_IN2;
            if (r < I_IN2) { p0_transpose_item(P.w_in, 1024, 3080, 2568, 16, (bf16*)(ws + WS_WIN), 2560, nullptr, scr, r, lane); continue; } r -= I_IN2;
            p0_transpose_item(P.xattn_wkv, 1024, 2048, 0, 64, (bf16*)(ws + WS_WKV), 0, nullptr, scr, r, lane);
        }
    }
    {
        bf16* WT = (bf16*)(ws + WS_LRUWT);
        for (int it = vcu * NWAVES * 64 + tid; it < 8 * 2 * 64 * 8; it += G * NWAVES * 64) {
            const int i8 = it & 7, j = (it >> 3) & 63, m = (it >> 9) & 1, g = it >> 10;
            const float* src = (m ? P.lru_wx : P.lru_wa) + (size_t)(g * 64 + 8 * i8) * 64 + j;
            v4u o; o.x = pk2(src[0], src[64]); o.y = pk2(src[128], src[192]); o.z = pk2(src[256], src[320]); o.w = pk2(src[384], src[448]);
            *(v4u*)(WT + (size_t)it * 8) = o;
        }
    }
}

__device__ __forceinline__ void late_weight_prep(const Params& P, LAS unsigned char* lds, int lane, int wave, int gw, int NGW) {
    unsigned char* ws = P.ws;
    {
        LAS float* scr = (LAS float*)(lds + wave * 16384);
        constexpr int I_OUT = 16 * 32, I_Q = 16 * 32, I_O = 16 * 32;
        for (int it = gw; it < I_OUT + I_Q + I_O; it += NGW) {
            int r = it;
            if (r < I_OUT) { p0_transpose_item(P.w_out, 1024, 1024, 0, 32, (bf16*)(ws + WS_WOUT), 0, nullptr, scr, r, lane); continue; } r -= I_OUT;
            if (r < I_Q) { p0_transpose_item(P.xattn_wq, 1024, 1024, 0, 32, (bf16*)(ws + WS_WQ), 0, P.norm_xattn_w, scr, r, lane); continue; } r -= I_Q;
            p0_transpose_item(P.xattn_wo, 1024, 1024, 0, 32, (bf16*)(ws + WS_WO), 0, nullptr, scr, r, lane);
        }
    }
    {
        bf16* WF = (bf16*)(ws + WS_PWQ);
        const int col = lane & 15, g = lane >> 4;
        for (int it = gw; it < 16 * 64; it += NGW) {
            const int hp = it >> 6, k0 = (it & 63) * 16;
            bf16x8 bq[4];
#pragma unroll
            for (int s = 0; s < 4; ++s) { const f32x4* src = (const f32x4*)(P.peer_wq + (size_t)(k0 + col) * 2048 + hp * 128 + 32 * s + 8 * g);
                const f32x4 a = src[0], c = src[1]; v4u pk; pk.x = pk2(a.x, a.y); pk.y = pk2(a.z, a.w); pk.z = pk2(c.x, c.y); pk.w = pk2(c.z, c.w); bq[s] = __builtin_bit_cast(bf16x8, pk); }
            const float nw = P.norm_ffn_w[k0 + col];
#pragma unroll 2
            for (int kt = 0; kt < 8; ++kt) {
                f32x4 acc = (f32x4){0.f, 0.f, 0.f, 0.f};
#pragma unroll
                for (int s = 0; s < 4; ++s) { const f32x4* src = (const f32x4*)(P.peer_subkeys + (size_t)(hp * 128 + 16 * kt + col) * 128 + 32 * s + 8 * g);
                    const f32x4 a = src[0], c = src[1]; v4u pk; pk.x = pk2(a.x, a.y); pk.y = pk2(a.z, a.w); pk.z = pk2(c.x, c.y); pk.w = pk2(c.z, c.w);
                    acc = __builtin_amdgcn_mfma_f32_16x16x32_bf16(__builtin_bit_cast(bf16x8, pk), bq[s], acc, 0, 0, 0); }
#pragma unroll
                for (int i = 0; i < 4; ++i) WF[(size_t)(hp * 128 + 16 * kt + 4 * g + i) * 1024 + k0 + col] = (bf16)f2bf(acc[i] * nw);
            }
        }
    }
}

constexpr int GL_KS = 0, GL_VS = 33792, GL_KB = 67584, GL_QB = 84992, GL_RAW = 102400, GL_CW = 153856, GL_AMT = 133120, GL_SM = 160000, GL_ATT = 151808, GL_SOL = 67584;
static_assert(GL_CW + 6144 <= GL_SM && GL_SM + 1284 <= MISC_OFF && GL_SOL + 65536 <= GL_AMT && GL_AMT + 17408 <= GL_ATT && GL_ATT + 8192 <= GL_SM && GL_RAW + 51456 <= GL_CW, "gdn_local LDS map");
#ifndef GL_REP_STEP
#define GL_REP_STEP -1
#endif
#define GL_REPF(k) for (int rr_ = 0; rr_ < ((GL_REP_STEP == (k)) ? 2 : 1); ++rr_)
#define GL_BAR() do { asm volatile("s_waitcnt lgkmcnt(0)" ::: "memory"); __builtin_amdgcn_s_barrier(); asm volatile("" ::: "memory"); } while (0)
__device__ __forceinline__ void gdn_local_item(const Params& P, LAS unsigned char* lds, int item, int tid) {
    unsigned char* ws = P.ws;
    asm volatile("" : "+v"(tid));
    const int b = item >> 9, h = (item >> 7) & 3, n = item & 127;
    const int t0 = b * SEQ + n * 64;
    const int lane = tid & 63, wave = __builtin_amdgcn_readfirstlane(tid >> 6);
    LAS float* ks = (LAS float*)(lds + GL_KS);
    LAS float* vs = (LAS float*)(lds + GL_VS);
    LAS bf16* kb16 = (LAS bf16*)(lds + GL_KB);
    LAS bf16* qb16 = (LAS bf16*)(lds + GL_QB);
    LAS bf16* raw = (LAS bf16*)(lds + GL_RAW);
    LAS float* cw = (LAS float*)(lds + GL_CW);
    LAS float* AmT = (LAS float*)(lds + GL_AMT);
    LAS float* sg = (LAS float*)(lds + GL_SM);
    LAS float* sbeta = sg + 64; LAS float* sgc = sbeta + 64; LAS float* seg = sgc + 64; LAS float* sek = seg + 64;
    LAS bf16* atts = (LAS bf16*)(lds + GL_ATT);
    const bf16* QKV = (const bf16*)(ws + WS_QKV);
    const float* AB = (const float*)(ws + WS_AB);
    GL_REPF(0) {
        v4u pr[7];
#pragma unroll
        for (int r = 0; r < 7; ++r) {
            const int id = tid + 512 * r;
            const int row = id / 48, rem = id - row * 48, part = rem >> 4, ck = rem & 15, s = n * 64 + row - 3;
            pr[r] = (v4u){0u, 0u, 0u, 0u};
            if (id < 67 * 48 && s >= 0) pr[r] = *(const v4u*)(QKV + (size_t)(b * SEQ + s) * 1536 + part * 512 + h * 128 + ck * 8);
        }
        f32x4 cwv = (f32x4){0.f, 0.f, 0.f, 0.f};
        if (tid < 384) { const int j = tid / 96, rem = tid - j * 96, part = rem >> 5, c4 = rem & 31; cwv = *(const f32x4*)(P.conv_qkv_w + j * 1536 + part * 512 + h * 128 + c4 * 4); }
        float a_in = 0.f, b_in = 0.f;
        if (tid < 64) { a_in = AB[(size_t)(t0 + tid) * 8 + h]; b_in = AB[(size_t)(t0 + tid) * 8 + 4 + h]; }
#pragma unroll
        for (int r = 0; r < 7; ++r) { const int id = tid + 512 * r; if (id < 67 * 48) *(LAS v4u*)(raw + id * 8) = pr[r]; }
        if (tid < 384) *(LAS f32x4*)(cw + tid * 4) = cwv;
        if (tid < 64) { sg[tid] = -__expf(P.gdn_a_log[h]) * softplusf_(a_in + P.gdn_dt_bias[h]); sbeta[tid] = sigmoidf_(b_in); }
    }
    GL_BAR();
    GL_REPF(1) {
        const int c = tid >> 3, grp = tid & 7;
#pragma unroll 1
        for (int part = 0; part < 3; ++part) {
            float y[16];
#pragma unroll
            for (int i = 0; i < 16; ++i) y[i] = 0.f;
#pragma unroll
            for (int j = 0; j < 4; ++j) {
                const LAS v4u* src = (const LAS v4u*)(raw + (c + j) * 384 + part * 128 + grp * 16);
                const v4u x0 = src[0], x1 = src[1];
                const LAS f32x4* wp = (const LAS f32x4*)(cw + (j * 3 + part) * 128 + grp * 16);
                const f32x4 w0 = wp[0], w1 = wp[1], w2 = wp[2], w3 = wp[3];
                y[0] += w0.x * bflo(x0.x); y[1] += w0.y * bfhi(x0.x); y[2] += w0.z * bflo(x0.y); y[3] += w0.w * bfhi(x0.y);
                y[4] += w1.x * bflo(x0.z); y[5] += w1.y * bfhi(x0.z); y[6] += w1.z * bflo(x0.w); y[7] += w1.w * bfhi(x0.w);
                y[8] += w2.x * bflo(x1.x); y[9] += w2.y * bfhi(x1.x); y[10] += w2.z * bflo(x1.y); y[11] += w2.w * bfhi(x1.y);
                y[12] += w3.x * bflo(x1.z); y[13] += w3.y * bfhi(x1.z); y[14] += w3.z * bflo(x1.w); y[15] += w3.w * bfhi(x1.w);
            }
            float ss = 0.f;
#pragma unroll
            for (int i = 0; i < 16; ++i) { y[i] = siluf_(y[i]); ss += y[i] * y[i]; }
            if (part < 2) {
                ss += __shfl_xor(ss, 1); ss += __shfl_xor(ss, 2); ss += __shfl_xor(ss, 4);
                const float sc = rsqrtf(ss + 1e-6f) * (part == 0 ? 0.08838834764831845f : 1.0f);
#pragma unroll
                for (int i = 0; i < 16; ++i) y[i] *= sc;
            }
            if (part >= 1) {
                LAS float* dst = (part == 1 ? ks : vs) + c * 132 + grp * 16;
#pragma unroll
                for (int i = 0; i < 4; ++i) *(LAS f32x4*)(dst + 4 * i) = (f32x4){y[4 * i], y[4 * i + 1], y[4 * i + 2], y[4 * i + 3]};
            }
            if (part <= 1) {
                LAS bf16* dst = (part == 0 ? qb16 : kb16) + c * 136 + grp * 16;
                v4u o0, o1; o0.x = pk2(y[0], y[1]); o0.y = pk2(y[2], y[3]); o0.z = pk2(y[4], y[5]); o0.w = pk2(y[6], y[7]);
                o1.x = pk2(y[8], y[9]); o1.y = pk2(y[10], y[11]); o1.z = pk2(y[12], y[13]); o1.w = pk2(y[14], y[15]);
                *(LAS v4u*)dst = o0; *(LAS v4u*)(dst + 8) = o1;
            }
        }
    }
    if (tid < 64) {
        float v = sg[tid];
#pragma unroll
        for (int off = 1; off < 64; off <<= 1) { const float t = __shfl_up(v, off); if (tid >= off) v += t; }
        sgc[tid] = v; seg[tid] = __expf(v);
        const float gl = __shfl(v, 63);
        sek[tid] = __expf(gl - v);
        if (tid == 63) sek[64] = __expf(v);
    }
    GL_BAR();
    {
        const int mat = wave >> 2, rho = wave & 3, col = lane & 15, g = lane >> 4;
        const LAS bf16* X = mat ? qb16 : kb16;
        bf16x8 af[4];
#pragma unroll
        for (int s = 0; s < 4; ++s) af[s] = *(const LAS bf16x8*)(X + (16 * rho + col) * 136 + 32 * s + 8 * g);
#pragma unroll
        for (int sig = 0; sig < 4; ++sig) {
            f32x4 acc = (f32x4){0.f, 0.f, 0.f, 0.f};
#pragma unroll
            for (int s = 0; s < 4; ++s) { const bf16x8 bfr = *(const LAS bf16x8*)(kb16 + (16 * sig + col) * 136 + 32 * s + 8 * g); acc = __builtin_amdgcn_mfma_f32_16x16x32_bf16(af[s], bfr, acc, 0, 0, 0); }
            const int sidx = 16 * sig + col; const float gs = sgc[sidx];
#pragma unroll
            for (int i = 0; i < 4; ++i) {
                const int c = 16 * rho + 4 * g + i;
                const float dec = (c >= sidx) ? __expf(sgc[c] - gs) : 0.f;
                if (mat == 0) AmT[sidx * 68 + c] = (c > sidx) ? sbeta[c] * acc[i] * dec : 0.f;
                else atts[c * 64 + sidx] = (bf16)f2bf(acc[i] * dec);
            }
        }
    }
    GL_BAR();
    GL_REPF(4) {
        bf16* QD = (bf16*)(ws + WS_QD) + (size_t)item * 8192;
        bf16* KD = (bf16*)(ws + WS_KD) + (size_t)item * 8192;
        bf16* ATT = (bf16*)(ws + WS_ATT) + (size_t)item * 4096;
#pragma unroll
        for (int r = 0; r < 2; ++r) {
            const int id = tid + 512 * r;
            { const int c = id >> 4, gam = id & 15, s32 = gam >> 2, g = gam & 3;
              const v2u lo = *(const LAS v2u*)(qb16 + c * 136 + 32 * s32 + 4 * g), hi = *(const LAS v2u*)(qb16 + c * 136 + 32 * s32 + 16 + 4 * g);
              const float e = seg[c];
              v4u o; o.x = pk2(bflo(lo.x) * e, bfhi(lo.x) * e); o.y = pk2(bflo(lo.y) * e, bfhi(lo.y) * e); o.z = pk2(bflo(hi.x) * e, bfhi(hi.x) * e); o.w = pk2(bflo(hi.y) * e, bfhi(hi.y) * e);
              st16_wt(QD + c * 128 + 8 * gam, o); }
            { const int dk = id >> 3, gam = id & 7, s32 = gam >> 2, g = gam & 3, c0 = 32 * s32 + 4 * g;
              float v[8];
#pragma unroll
              for (int j = 0; j < 4; ++j) { v[j] = ks[(c0 + j) * 132 + dk] * sek[c0 + j]; v[4 + j] = ks[(c0 + 16 + j) * 132 + dk] * sek[c0 + 16 + j]; }
              v4u o; o.x = pk2(v[0], v[1]); o.y = pk2(v[2], v[3]); o.z = pk2(v[4], v[5]); o.w = pk2(v[6], v[7]);
              st16_wt(KD + dk * 64 + 8 * gam, o); }
        }
        { const int c = tid >> 3, gam = tid & 7, s32 = gam >> 2, g = gam & 3;
          const v2u lo = *(const LAS v2u*)(atts + c * 64 + 32 * s32 + 4 * g), hi = *(const LAS v2u*)(atts + c * 64 + 32 * s32 + 16 + 4 * g);
          v4u o; o.x = lo.x; o.y = lo.y; o.z = hi.x; o.w = hi.y;
          st16_wt(ATT + c * 64 + 8 * gam, o); }
    }
    GL_BAR();
    GL_REPF(5) {
        LAS float* xcol = (LAS float*)(lds + GL_SOL);
        LAS bf16* tinv = (LAS bf16*)(lds + GL_SOL + 17408);
        const int j = tid >> 3, part = tid & 7, jb = j >> 4, jo = j & 15;
#pragma unroll 1
        for (int rb = jb; rb < 4; ++rb) {
            float acc[16];
#pragma unroll
            for (int i = 0; i < 16; ++i) acc[i] = 0.f;
            if (rb > jb) {
#pragma unroll 2
                for (int s = 16 * jb + part; s < 16 * rb; s += 8) {
                    const float sv = xcol[j * 68 + s];
                    const LAS float* ar = AmT + s * 68 + 16 * rb;
#pragma unroll
                    for (int q = 0; q < 4; ++q) { const f32x4 A4 = *(const LAS f32x4*)(ar + 4 * q);
                        acc[4 * q] -= A4.x * sv; acc[4 * q + 1] -= A4.y * sv; acc[4 * q + 2] -= A4.z * sv; acc[4 * q + 3] -= A4.w * sv; }
                }
#pragma unroll
                for (int i = 0; i < 16; ++i) {
                    acc[i] += __builtin_bit_cast(float, __builtin_amdgcn_update_dpp(0, __builtin_bit_cast(int, acc[i]), 0xB1, 0xF, 0xF, true));
                    acc[i] += __builtin_bit_cast(float, __builtin_amdgcn_update_dpp(0, __builtin_bit_cast(int, acc[i]), 0x4E, 0xF, 0xF, true));
                    acc[i] += __builtin_bit_cast(float, __builtin_amdgcn_update_dpp(0, __builtin_bit_cast(int, acc[i]), 0x141, 0xF, 0xF, true));
                }
            } else {
#pragma unroll
                for (int i = 0; i < 16; ++i) acc[i] = (i == jo) ? 1.f : 0.f;
            }
#pragma unroll
            for (int i = 0; i < 16; ++i) {
                const float sv = acc[i];
                const LAS float* ar = AmT + (16 * rb + i) * 68 + 16 * rb;
#pragma unroll
                for (int q = (i + 1) / 4; q < 4; ++q) { const f32x4 A4 = *(const LAS f32x4*)(ar + 4 * q);
                    if (4 * q > i) acc[4 * q] -= A4.x * sv; if (4 * q + 1 > i) acc[4 * q + 1] -= A4.y * sv; if (4 * q + 2 > i) acc[4 * q + 2] -= A4.z * sv; if (4 * q + 3 > i) acc[4 * q + 3] -= A4.w * sv; }
            }
            if (part == 0) {
#pragma unroll
                for (int i = 0; i < 16; ++i) { xcol[j * 68 + 16 * rb + i] = acc[i]; tinv[(16 * rb + i) * 72 + j] = (bf16)f2bf(acc[i]); }
            }
            LDS_WAIT(); asm volatile("" ::: "memory");
        }
        for (int rb = 0; rb < jb; ++rb) {
            if (part == 0) {
#pragma unroll
                for (int i = 0; i < 16; ++i) tinv[(16 * rb + i) * 72 + j] = (bf16)0;
            }
        }
    }
    GL_BAR();
    GL_REPF(6) {
        const LAS bf16* tinv = (const LAS bf16*)(lds + GL_SOL + 17408);
        LAS bf16* wst = (LAS bf16*)(lds + GL_SOL + 17408 + 9216);
        const int col = lane & 15, g = lane >> 4, isw = wave >> 2;
        bf16x8 af[4][2];
#pragma unroll
        for (int rho = 0; rho < 4; ++rho)
#pragma unroll
            for (int s2 = 0; s2 < 2; ++s2) af[rho][s2] = *(const LAS bf16x8*)(tinv + (16 * rho + col) * 72 + 32 * s2 + 8 * g);
        bf16* UF = (bf16*)(ws + WS_UF) + (size_t)item * 8192;
#pragma unroll
        for (int sig = 0; sig < 2; ++sig) {
            const int jj = 32 * (wave & 3) + 16 * sig + col;
            const LAS float* src = (isw ? ks : vs) + jj;
            bf16x8 bfr[2];
#pragma unroll
            for (int s2 = 0; s2 < 2; ++s2) {
                float v[8];
#pragma unroll
                for (int e = 0; e < 8; ++e) { const int sidx = 32 * s2 + 8 * g + e; float x = src[sidx * 132] * sbeta[sidx]; if (isw) x *= seg[sidx]; v[e] = x; }
                v4u pk; pk.x = pk2(v[0], v[1]); pk.y = pk2(v[2], v[3]); pk.z = pk2(v[4], v[5]); pk.w = pk2(v[6], v[7]);
                bfr[s2] = __builtin_bit_cast(bf16x8, pk);
            }
            f32x4 acc[4];
#pragma unroll
            for (int rho = 0; rho < 4; ++rho) { acc[rho] = (f32x4){0.f, 0.f, 0.f, 0.f};
#pragma unroll
                for (int s2 = 0; s2 < 2; ++s2) acc[rho] = __builtin_amdgcn_mfma_f32_16x16x32_bf16(af[rho][s2], bfr[s2], acc[rho], 0, 0, 0); }
            if (!isw) {
                v4u o0, o1;
                o0.x = pk2(acc[0].x, acc[0].y); o0.y = pk2(acc[0].z, acc[0].w); o0.z = pk2(acc[1].x, acc[1].y); o0.w = pk2(acc[1].z, acc[1].w);
                o1.x = pk2(acc[2].x, acc[2].y); o1.y = pk2(acc[2].z, acc[2].w); o1.z = pk2(acc[3].x, acc[3].y); o1.w = pk2(acc[3].z, acc[3].w);
                v4u* d = (v4u*)(UF + (size_t)(2 * (wave & 3) + sig) * 1024 + lane * 16);
                st16_wt(d, o0); st16_wt(d + 1, o1);
            } else {
#pragma unroll
                for (int rho = 0; rho < 4; ++rho)
#pragma unroll
                    for (int i = 0; i < 4; ++i) wst[(16 * rho + 4 * g + i) * 136 + jj] = (bf16)f2bf(-acc[rho][i]);
            }
        }
    }
    GL_BAR();
    {
        const LAS bf16* wst = (const LAS bf16*)(lds + GL_SOL + 17408 + 9216);
        bf16* WN = (bf16*)(ws + WS_WN) + (size_t)item * 8192;
#pragma unroll
        for (int r = 0; r < 2; ++r) {
            const int id = tid + 512 * r, c = id >> 4, gam = id & 15, s32 = gam >> 2, g = gam & 3;
            const v2u lo = *(const LAS v2u*)(wst + c * 136 + 32 * s32 + 4 * g), hi = *(const LAS v2u*)(wst + c * 136 + 32 * s32 + 16 + 4 * g);
            v4u o; o.x = lo.x; o.y = lo.y; o.z = hi.x; o.w = hi.y;
            st16_wt(WN + c * 128 + 8 * gam, o);
        }
    }
    asm volatile("s_waitcnt vmcnt(0)" ::: "memory");
    GL_BAR();
    if (tid == 0) { unsigned fb = __builtin_bit_cast(unsigned, sek[64]); if (fb == 0u) fb = 1u;
        __hip_atomic_store((unsigned*)(ws + WS_CTL) + CW_GFLAG + item, fb, __ATOMIC_RELAXED, __HIP_MEMORY_SCOPE_AGENT); }
    GL_BAR();
}

constexpr int LL_XCB = 68608;
static_assert(LL_XCB + 64 * 1040 <= MISC_OFF, "lru_local LDS map");
__device__ __forceinline__ float expm1_small(float x) {
    const float p = x * (1.0f + x * (0.5f + x * (0.16666667f + x * (0.041666668f + x * 0.008333334f))));
    return (x > -0.25f) ? p : (__expf(x) - 1.0f);
}
__device__ __forceinline__ void lru_local_item(const Params& P, LAS unsigned char* lds, int lt, int tid, int lane, int wave) {
    unsigned char* ws = P.ws;
    asm volatile("" : "+v"(tid));
    const int b = lt >> 7, n = lt & 127, t0 = b * SEQ + n * 64;
    LAS bf16* rawx = (LAS bf16*)lds;
    LAS bf16* xcb = (LAS bf16*)(lds + LL_XCB);
    const bf16* XR = (const bf16*)(ws + WS_XR);
    {
        v4u pr[9];
#pragma unroll
        for (int r = 0; r < 9; ++r) { const int id = tid + 512 * r, row = id >> 6, ck = id & 63, s = n * 64 + row - 3;
            pr[r] = (v4u){0u, 0u, 0u, 0u};
            if (id < 67 * 64 && s >= 0) pr[r] = *(const v4u*)(XR + (size_t)(b * SEQ + s) * 512 + ck * 8); }
#pragma unroll
        for (int r = 0; r < 9; ++r) { const int id = tid + 512 * r; if (id < 67 * 64) *(LAS v4u*)(rawx + id * 8) = pr[r]; }
    }
    GL_BAR();
    {
        const int chg = tid & 63, tseg = tid >> 6, ch0 = chg * 8;
        float w[4][8], cb[8];
#pragma unroll
        for (int j = 0; j < 4; ++j) { const f32x4 a = *(const f32x4*)(P.lru_conv_w + j * 512 + ch0), c = *(const f32x4*)(P.lru_conv_w + j * 512 + ch0 + 4);
            w[j][0] = a.x; w[j][1] = a.y; w[j][2] = a.z; w[j][3] = a.w; w[j][4] = c.x; w[j][5] = c.y; w[j][6] = c.z; w[j][7] = c.w; }
        { const f32x4 a = *(const f32x4*)(P.lru_conv_b + ch0), c = *(const f32x4*)(P.lru_conv_b + ch0 + 4);
          cb[0] = a.x; cb[1] = a.y; cb[2] = a.z; cb[3] = a.w; cb[4] = c.x; cb[5] = c.y; cb[6] = c.z; cb[7] = c.w; }
        v4u xr[11];
#pragma unroll
        for (int r = 0; r < 11; ++r) xr[r] = *(const LAS v4u*)(rawx + (tseg * 8 + r) * 512 + ch0);
#pragma unroll
        for (int tk = 0; tk < 8; ++tk) {
            float y[8];
#pragma unroll
            for (int e = 0; e < 8; ++e) y[e] = cb[e];
#pragma unroll
            for (int j = 0; j < 4; ++j) { const v4u x = xr[tk + j];
                y[0] += w[j][0] * bflo(x.x); y[1] += w[j][1] * bfhi(x.x); y[2] += w[j][2] * bflo(x.y); y[3] += w[j][3] * bfhi(x.y);
                y[4] += w[j][4] * bflo(x.z); y[5] += w[j][5] * bfhi(x.z); y[6] += w[j][6] * bflo(x.w); y[7] += w[j][7] * bfhi(x.w); }
            v4u o; o.x = pk2(y[0], y[1]); o.y = pk2(y[2], y[3]); o.z = pk2(y[4], y[5]); o.w = pk2(y[6], y[7]);
            *(LAS v4u*)(xcb + (tseg * 8 + tk) * 520 + ch0) = o;
        }
    }
    GL_BAR();
    {
        const int g = wave, col = lane & 15, g4 = lane >> 4;
        LAS bf16* AM = (LAS bf16*)(lds + wave * 8192); LAS bf16* BT = AM + 2048;
        const bf16* WT = (const bf16*)(ws + WS_LRUWT) + (size_t)g * 8192;
        bf16x8 Bw[2][4][2];
#pragma unroll
        for (int m = 0; m < 2; ++m)
#pragma unroll
            for (int jt = 0; jt < 4; ++jt)
#pragma unroll
                for (int s2 = 0; s2 < 2; ++s2) Bw[m][jt][s2] = *(const bf16x8*)(WT + m * 4096 + (16 * jt + col) * 64 + 32 * s2 + 8 * g4);
        float cba[4], cbx[4], csp[4];
#pragma unroll
        for (int jt = 0; jt < 4; ++jt) { const int ch = g * 64 + 16 * jt + col; cba[jt] = P.lru_ba[ch]; cbx[jt] = P.lru_bx[ch]; csp[jt] = softplusf_(-P.lru_lambda[ch]); }
        bf16* HLOC = (bf16*)(ws + WS_HLOC); bf16* PCUM = (bf16*)(ws + WS_PCUM);
        const int chs = g * 64 + lane;
        float hst = 0.f, pc = 1.f;
#pragma unroll 1
        for (int half = 0; half < 2; ++half) {
            bf16x8 Af[2][2];
#pragma unroll
            for (int rho = 0; rho < 2; ++rho)
#pragma unroll
                for (int s2 = 0; s2 < 2; ++s2) Af[rho][s2] = *(const LAS bf16x8*)(xcb + (32 * half + 16 * rho + col) * 520 + g * 64 + 32 * s2 + 8 * g4);
#pragma unroll
            for (int jt = 0; jt < 4; ++jt) {
#pragma unroll
                for (int rho = 0; rho < 2; ++rho) {
                    f32x4 ra = (f32x4){0.f, 0.f, 0.f, 0.f}, rx = ra;
#pragma unroll
                    for (int s2 = 0; s2 < 2; ++s2) { ra = __builtin_amdgcn_mfma_f32_16x16x32_bf16(Af[rho][s2], Bw[0][jt][s2], ra, 0, 0, 0); rx = __builtin_amdgcn_mfma_f32_16x16x32_bf16(Af[rho][s2], Bw[1][jt][s2], rx, 0, 0, 0); }
#pragma unroll
                    for (int i = 0; i < 4; ++i) {
                        const int tokl = 16 * rho + 4 * g4 + i, chl = 16 * jt + col;
                        const float r = sigmoidf_(ra[i] + cba[jt]), ig = sigmoidf_(rx[i] + cbx[jt]);
                        const float log_a = -8.0f * r * csp[jt];
                        const float am = -expm1_small(log_a), a = 1.0f - am;
                        const float xo = bf1(xcb[(32 * half + tokl) * 520 + g * 64 + chl]);
                        const float bt = __builtin_amdgcn_sqrtf(fmaxf(am * (1.0f + a), 0.f)) * (ig * xo);
                        AM[tokl * 64 + chl] = (bf16)f2bf(am); BT[tokl * 64 + chl] = (bf16)f2bf(bt);
                    }
                }
            }
            LDS_WAIT(); asm volatile("" ::: "memory");
#pragma unroll 8
            for (int tk = 0; tk < 32; ++tk) {
                const float am = bf1(AM[tk * 64 + lane]), bt = bf1(BT[tk * 64 + lane]);
                hst = (hst - am * hst) + bt; pc = pc - am * pc;
                const size_t o = (size_t)(t0 + 32 * half + tk) * 512 + chs;
                HLOC[o] = (bf16)f2bf(hst); PCUM[o] = (bf16)f2bf(pc);
            }
            LDS_WAIT(); asm volatile("" ::: "memory");
        }
        ((float*)(ws + WS_HEND))[(size_t)lt * 512 + chs] = hst; ((float*)(ws + WS_PEND))[(size_t)lt * 512 + chs] = pc;
    }
    GL_BAR();
}

constexpr int SC_WN = 0, SC_QD = 64 * 272, SC_KD = 2 * 64 * 272, SC_ATT = 2 * 64 * 272 + 128 * 144, SC_BUF = 2 * 64 * 272 + 128 * 144 + 64 * 144;
constexpr int SC_SSQ = 2 * SC_BUF;
__device__ __forceinline__ int sc_lds_off(int id) {
    if (id < 1024) return SC_WN + (id >> 4) * 272 + (id & 15) * 16;
    if (id < 2048) { const int q = id - 1024; return SC_QD + (q >> 4) * 272 + (q & 15) * 16; }
    if (id < 3072) { const int q = id - 2048; return SC_KD + (q >> 3) * 144 + (q & 7) * 16; }
    const int q = id - 3072; return SC_ATT + (q >> 3) * 144 + (q & 7) * 16;
}
__device__ __forceinline__ const v4u* sc_src(const unsigned char* ws, int item, int id) {
    if (id < 1024) return (const v4u*)(ws + WS_WN + (size_t)item * 16384) + id;
    if (id < 2048) return (const v4u*)(ws + WS_QD + (size_t)item * 16384) + (id - 1024);
    if (id < 3072) return (const v4u*)(ws + WS_KD + (size_t)item * 16384) + (id - 2048);
    return (const v4u*)(ws + WS_ATT + (size_t)item * 8192) + (id - 3072);
}
__device__ __forceinline__ bf16x8 pack_b(const f32x4 a, const f32x4 b) {
    v4u r; r.x = pk2(a.x, a.y); r.y = pk2(a.z, a.w); r.z = pk2(b.x, b.y); r.w = pk2(b.z, b.w);
    return __builtin_bit_cast(bf16x8, r);
}
#define SC_BAR() do { asm volatile("s_waitcnt lgkmcnt(0)" ::: "memory"); __builtin_amdgcn_s_barrier(); asm volatile("" ::: "memory"); } while (0)
#define SC_GLD(dst, ptr) asm volatile("global_load_dwordx4 %0, %1, off" : "=v"(dst) : "v"(ptr) : "memory")
#define PIN8(a) asm volatile("" : "+v"(a[0]), "+v"(a[1]), "+v"(a[2]), "+v"(a[3]), "+v"(a[4]), "+v"(a[5]), "+v"(a[6]), "+v"(a[7]))
#define PIN16(a) asm volatile("" : "+v"(a[0]), "+v"(a[1]), "+v"(a[2]), "+v"(a[3]), "+v"(a[4]), "+v"(a[5]), "+v"(a[6]), "+v"(a[7]), "+v"(a[8]), "+v"(a[9]), "+v"(a[10]), "+v"(a[11]), "+v"(a[12]), "+v"(a[13]), "+v"(a[14]), "+v"(a[15]))
constexpr int SCAN_NWC = 2, SCAN_PARTS = 4, SCAN_WGS = 8 * SCAN_PARTS;
constexpr int SC_UFS = 2 * SC_BUF;
constexpr int SC_DECS = SC_UFS + 2 * SCAN_NWC * 2048;
constexpr int SC_OT = SC_DECS + 512;
constexpr int SC_RDY = SC_OT + 2 * 64 * 36 * 4;
constexpr int SC_END = SC_RDY + 64;
static_assert(SC_END <= MISC_OFF, "scan LDS");
#ifndef SCAN_REPS
#define SCAN_REPS 1
#endif
#ifndef SCAN_EXP
#define SCAN_EXP 0
#endif
__device__ __forceinline__ int sc3_lds_off(int id) {
    if (id < 3584) return sc_lds_off(id);
    return SC_UFS + (id - 3584) * 16;
}
__device__ __forceinline__ const v4u* sc3_src(const unsigned char* ws, int item, int id, int part) {
    if (id < 3584) return sc_src(ws, item, id);
    return (const v4u*)(ws + WS_UF + (size_t)item * 16384 + (size_t)(part * SCAN_NWC) * 2048) + (id - 3584);
}
__device__ __forceinline__ void gdn_scan(const Params& P, LAS unsigned char* lds, int sb, int tid, int lane, int wave) {
    const unsigned char* ws = P.ws;
    constexpr int NCH = 128 * SCAN_REPS, NPC = 15;
    const int bh = sb & 7, part = sb >> 3;
    const int b = bh >> 2, h = bh & 3, col = lane & 15, g = lane >> 4;
    const int item0 = bh * 128;
    if (tid == 0) *(volatile LAS unsigned*)(lds + SC_RDY) = 0u;
    SC_BAR();
    if (wave >= 4) {
        constexpr int NP = 15, DEP = 3;
        const int lt = tid - 256;
        const unsigned voff = (unsigned)lt * 16u;
        const int lA = (lt >> 4) * 272 + (lt & 15) * 16, lB = (lt >> 3) * 144 + (lt & 7) * 16, lU = SC_UFS + lt * 16;
        v4u rs[DEP][NP];
#define SC_ISSUE(set, itm) do { const unsigned char* gq_ = ws + (size_t)(itm) * 16384; const unsigned char* ga_ = ws + WS_ATT + (size_t)(itm) * 8192; \
            asm volatile("s_nop 4\n\tglobal_load_dwordx4 %0, %8, %9 sc0 sc1\n\tglobal_load_dwordx4 %1, %8, %10 sc0 sc1\n\tglobal_load_dwordx4 %2, %8, %11 sc0 sc1\n\tglobal_load_dwordx4 %3, %8, %12 sc0 sc1\n\t" \
                         "global_load_dwordx4 %4, %8, %13 sc0 sc1\n\tglobal_load_dwordx4 %5, %8, %14 sc0 sc1\n\tglobal_load_dwordx4 %6, %8, %15 sc0 sc1\n\tglobal_load_dwordx4 %7, %8, %16 sc0 sc1" \
                : "=&v"(rs[set][0]), "=&v"(rs[set][1]), "=&v"(rs[set][2]), "=&v"(rs[set][3]), "=&v"(rs[set][4]), "=&v"(rs[set][5]), "=&v"(rs[set][6]), "=&v"(rs[set][7]) \
                : "v"(voff), "s"(gq_ + WS_WN), "s"(gq_ + WS_WN + 4096), "s"(gq_ + WS_WN + 8192), "s"(gq_ + WS_WN + 12288), \
                  "s"(gq_ + WS_QD), "s"(gq_ + WS_QD + 4096), "s"(gq_ + WS_QD + 8192), "s"(gq_ + WS_QD + 12288) : "memory"); \
            asm volatile("s_nop 4\n\tglobal_load_dwordx4 %0, %7, %8 sc0 sc1\n\tglobal_load_dwordx4 %1, %7, %9 sc0 sc1\n\tglobal_load_dwordx4 %2, %7, %10 sc0 sc1\n\tglobal_load_dwordx4 %3, %7, %11 sc0 sc1\n\t" \
                         "global_load_dwordx4 %4, %7, %12 sc0 sc1\n\tglobal_load_dwordx4 %5, %7, %13 sc0 sc1\n\tglobal_load_dwordx4 %6, %7, %14 sc0 sc1" \
                : "=&v"(rs[set][8]), "=&v"(rs[set][9]), "=&v"(rs[set][10]), "=&v"(rs[set][11]), "=&v"(rs[set][12]), "=&v"(rs[set][13]), "=&v"(rs[set][14]) \
                : "v"(voff), "s"(gq_ + WS_KD), "s"(gq_ + WS_KD + 4096), "s"(gq_ + WS_KD + 8192), "s"(gq_ + WS_KD + 12288), \
                  "s"(ga_), "s"(ga_ + 4096), "s"(gq_ + WS_UF + (size_t)(part * SCAN_NWC) * 2048) : "memory"); } while (0)
#define SC_WAITSET(set, cnt) asm volatile("s_waitcnt " cnt : "+v"(rs[set][0]), "+v"(rs[set][1]), "+v"(rs[set][2]), "+v"(rs[set][3]), "+v"(rs[set][4]), "+v"(rs[set][5]), "+v"(rs[set][6]), "+v"(rs[set][7]), \
            "+v"(rs[set][8]), "+v"(rs[set][9]), "+v"(rs[set][10]), "+v"(rs[set][11]), "+v"(rs[set][12]), "+v"(rs[set][13]), "+v"(rs[set][14]) :: "memory")
#define SC_WRITE(set, par) do { LAS unsigned char* wb_ = lds + (par) * SC_BUF; \
            _Pragma("unroll") for (int r = 0; r < 4; ++r) { *(LAS v4u*)(wb_ + SC_WN + lA + r * (16 * 272)) = rs[set][r]; *(LAS v4u*)(wb_ + SC_QD + lA + r * (16 * 272)) = rs[set][4 + r]; \
                                                          *(LAS v4u*)(wb_ + SC_KD + lB + r * (32 * 144)) = rs[set][8 + r]; } \
            *(LAS v4u*)(wb_ + SC_ATT + lB) = rs[set][12]; *(LAS v4u*)(wb_ + SC_ATT + lB + 32 * 144) = rs[set][13]; \
            *(LAS v4u*)(lds + lU + (par) * (SCAN_NWC * 2048)) = rs[set][14]; } while (0)
#define SC_NEED(c) do { unsigned sp_ = 0; while (*(volatile LAS unsigned*)(lds + SC_RDY) <= (unsigned)(c) && ++sp_ < (1u << 24)) __builtin_amdgcn_s_sleep(2); } while (0)
        SC_NEED(0); SC_ISSUE(0, item0);
        SC_WAITSET(0, "vmcnt(0)"); SC_WRITE(0, 0); SC_WAITSET(0, "lgkmcnt(0)");
        SC_NEED(3); SC_ISSUE(1, item0 + 1); SC_ISSUE(2, item0 + 2); SC_ISSUE(0, item0 + 3);
        SC_BAR();
        int n2 = 0;
#define SC_INTERVAL(set) do { SC_WAITSET(set, "vmcnt(30)"); SC_WRITE(set, (n2 + 1) & 1); SC_WAITSET(set, "lgkmcnt(0)"); if (n2 + 1 + DEP < 128) SC_NEED(n2 + 1 + DEP); SC_ISSUE(set, item0 + ((n2 + 1 + DEP) & 127)); SC_BAR(); ++n2; } while (0)
#pragma unroll 1
        for (int it = 0; it < NCH / 3; ++it) { SC_INTERVAL(1); SC_INTERVAL(2); SC_INTERVAL(0); }
        if (NCH % 3 >= 1) SC_INTERVAL(1);
        if (NCH % 3 >= 2) SC_INTERVAL(2);
        SC_WAITSET(0, "vmcnt(0)"); SC_WAITSET(1, "vmcnt(0)"); SC_WAITSET(2, "vmcnt(0)");
#undef SC_INTERVAL
#undef SC_NEED
#undef SC_WRITE
#undef SC_WAITSET
#undef SC_ISSUE
        return;
    }
    if (wave == 3) {
        const unsigned* flags = (const unsigned*)(ws + WS_CTL) + CW_GFLAG + item0;
        unsigned rdy = 0;
#define SC_POLLSTEP() do { if (rdy < 128u) { const unsigned idx_ = rdy + (unsigned)lane; \
            const unsigned fv_ = (idx_ < 128u) ? __hip_atomic_load(flags + idx_, __ATOMIC_RELAXED, __HIP_MEMORY_SCOPE_AGENT) : 0u; \
            const unsigned long long m_ = __ballot(fv_ != 0u); const unsigned nrun_ = (m_ == ~0ull) ? 64u : (unsigned)__builtin_ctzll(~m_);     \
            if ((unsigned)lane < nrun_) ((LAS float*)(lds + SC_DECS))[idx_] = __builtin_bit_cast(float, fv_); \
            rdy += nrun_; LDS_WAIT(); if (lane == 0) *(volatile LAS unsigned*)(lds + SC_RDY) = rdy; } } while (0)
        { unsigned sp = 0; while (rdy < 4u && ++sp < (1u << 22)) { SC_POLLSTEP(); if (rdy < 4u) __builtin_amdgcn_s_sleep(16); } }
        SC_BAR();
#pragma unroll 1
        for (int n2 = 0; n2 < NCH; ++n2) {
            { const unsigned need = (unsigned)(n2 + 1 + 3) < 128u ? (unsigned)(n2 + 1 + 3) : 127u; unsigned sp = 0;
              while (rdy <= need && rdy < 128u && ++sp < (1u << 22)) { SC_POLLSTEP(); if (rdy <= need) __builtin_amdgcn_s_sleep(8); } }
            if (rdy < 128u && rdy < (unsigned)(n2 & 127) + 16u) SC_POLLSTEP();
            SC_BAR();
        }
#undef SC_POLLSTEP
        return;
    }
    if (wave == 2) {
        const int row = lane;
        bf16* Y = (bf16*)((unsigned char*)P.out + OUT_Y);
        float* SSQG = P.out;
        SC_BAR();
#pragma unroll 1
        for (int n2 = 0; n2 <= NCH; ++n2) {
            if (n2 > 0) {
                const int n = (n2 - 1) & 127, t = b * SEQ + n * 64 + row;
                const LAS float* src = (const LAS float*)(lds + SC_OT + ((n2 - 1) & 1) * (64 * 36 * 4)) + row * 36;
                f32x4 a[8]; float s2 = 0.f;
#pragma unroll
                for (int q = 0; q < 8; ++q) { a[q] = *(const LAS f32x4*)(src + 4 * q); s2 += (a[q].x * a[q].x + a[q].y * a[q].y) + (a[q].z * a[q].z + a[q].w * a[q].w); }
                SSQG[(size_t)t * 32 + h * 8 + part] = s2;
                v4u* d = (v4u*)(Y + (size_t)t * 1024 + h * 128 + 32 * part);
#pragma unroll
                for (int q = 0; q < 4; ++q) { v4u o; o.x = pk2(a[2 * q].x, a[2 * q].y); o.y = pk2(a[2 * q].z, a[2 * q].w); o.z = pk2(a[2 * q + 1].x, a[2 * q + 1].y); o.w = pk2(a[2 * q + 1].z, a[2 * q + 1].w); d[q] = o; }
            }
            if (n2 < NCH) SC_BAR();
        }
        return;
    }
    f32x4 S[8];
#pragma unroll
    for (int i = 0; i < 8; ++i) S[i] = (f32x4){0.f, 0.f, 0.f, 0.f};
    SC_BAR();
#pragma unroll 1
    for (int n2 = 0; n2 < NCH; ++n2) {
        if (SCAN_REPS > 1 && (n2 & 127) == 0) {
#pragma unroll
            for (int i = 0; i < 8; ++i) S[i] = (f32x4){0.f, 0.f, 0.f, 0.f};
        }
        if (SCAN_EXP == 2 && n2 < 128) { SC_BAR(); continue; }
        const int par = n2 & 1;
        LAS unsigned char* buf = lds + par * SC_BUF;
        bf16x8 fA[16], fB[16], fC[16], fD[8];
#pragma unroll
        for (int rho = 0; rho < 4; ++rho)
#pragma unroll
            for (int s = 0; s < 4; ++s) fA[rho * 4 + s] = *(const LAS bf16x8*)(buf + SC_WN + (16 * rho + col) * 272 + (32 * s + 8 * g) * 2);
#pragma unroll
        for (int rho = 0; rho < 4; ++rho)
#pragma unroll
            for (int s = 0; s < 4; ++s) fB[rho * 4 + s] = *(const LAS bf16x8*)(buf + SC_QD + (16 * rho + col) * 272 + (32 * s + 8 * g) * 2);
        const LAS v4u* ufp = (const LAS v4u*)(lds + SC_UFS + par * (SCAN_NWC * 2048) + wave * 2048 + lane * 32);
        const v4u uf0 = ufp[0], uf1 = ufp[1];
        const float dec = ((const LAS float*)(lds + SC_DECS))[n2 & 127];
        bf16x8 Bs[4];
#pragma unroll
        for (int s = 0; s < 4; ++s) Bs[s] = pack_b(S[2 * s], S[2 * s + 1]);
        f32x4 Vn[4], Oc[4];
        Vn[0] = (f32x4){bflo(uf0.x), bfhi(uf0.x), bflo(uf0.y), bfhi(uf0.y)}; Vn[1] = (f32x4){bflo(uf0.z), bfhi(uf0.z), bflo(uf0.w), bfhi(uf0.w)};
        Vn[2] = (f32x4){bflo(uf1.x), bfhi(uf1.x), bflo(uf1.y), bfhi(uf1.y)}; Vn[3] = (f32x4){bflo(uf1.z), bfhi(uf1.z), bflo(uf1.w), bfhi(uf1.w)};
        __builtin_amdgcn_sched_barrier(0);
        PIN16(fA);
#pragma unroll
        for (int s = 0; s < 4; ++s)
#pragma unroll
            for (int rho = 0; rho < 4; ++rho) Vn[rho] = __builtin_amdgcn_mfma_f32_16x16x32_bf16(fA[rho * 4 + s], Bs[s], Vn[rho], 0, 0, 0);
        __builtin_amdgcn_sched_barrier(0);
#pragma unroll
        for (int tau = 0; tau < 8; ++tau)
#pragma unroll
            for (int s = 0; s < 2; ++s) fC[tau * 2 + s] = *(const LAS bf16x8*)(buf + SC_KD + (16 * tau + col) * 144 + (32 * s + 8 * g) * 2);
        __builtin_amdgcn_sched_barrier(0);
        PIN16(fB);
#pragma unroll
        for (int rho = 0; rho < 4; ++rho) Oc[rho] = (f32x4){0.f, 0.f, 0.f, 0.f};
#pragma unroll
        for (int s = 0; s < 4; ++s)
#pragma unroll
            for (int rho = 0; rho < 4; ++rho) Oc[rho] = __builtin_amdgcn_mfma_f32_16x16x32_bf16(fB[rho * 4 + s], Bs[s], Oc[rho], 0, 0, 0);
        __builtin_amdgcn_sched_barrier(0);
#pragma unroll
        for (int rho = 0; rho < 4; ++rho)
#pragma unroll
            for (int s = 0; s < 2; ++s) fD[rho * 2 + s] = *(const LAS bf16x8*)(buf + SC_ATT + (16 * rho + col) * 144 + (32 * s + 8 * g) * 2);
        bf16x8 Bv[2];
        Bv[0] = pack_b(Vn[0], Vn[1]); Bv[1] = pack_b(Vn[2], Vn[3]);
#pragma unroll
        for (int tau = 0; tau < 8; ++tau) S[tau] = S[tau] * dec;
        __builtin_amdgcn_sched_barrier(0);
        PIN16(fC);
#pragma unroll
        for (int s = 0; s < 2; ++s)
#pragma unroll
            for (int tau = 0; tau < 8; ++tau) S[tau] = __builtin_amdgcn_mfma_f32_16x16x32_bf16(fC[tau * 2 + s], Bv[s], S[tau], 0, 0, 0);
        __builtin_amdgcn_sched_barrier(0);
        PIN8(fD);
#pragma unroll
        for (int s = 0; s < 2; ++s)
#pragma unroll
            for (int rho = 0; rho < 4; ++rho) Oc[rho] = __builtin_amdgcn_mfma_f32_16x16x32_bf16(fD[rho * 2 + s], Bv[s], Oc[rho], 0, 0, 0);
        LAS float* ot = (LAS float*)(lds + SC_OT + par * (64 * 36 * 4)) + 16 * wave + col;
#pragma unroll
        for (int rho = 0; rho < 4; ++rho)
#pragma unroll
            for (int i = 0; i < 4; ++i) ot[(16 * rho + 4 * g + i) * 36] = Oc[rho][i];
        SC_BAR();
    }
}

__device__ __forceinline__ void lru_carry(const Params& P, int gwv, int lane) {
    unsigned char* ws = P.ws;
    const int b = gwv >> 3, g = gwv & 7, ch = g * 64 + lane;
    const float* HEND = (const float*)(ws + WS_HEND); const float* PEND = (const float*)(ws + WS_PEND); float* HIN = (float*)(ws + WS_HIN);
    float hin = 0.f;
#pragma unroll 1
    for (int n0 = 0; n0 < 128; n0 += 32) {
        float he[32], pe[32];
#pragma unroll
        for (int i = 0; i < 32; ++i) { const size_t o = (size_t)(b * 128 + n0 + i) * 512 + ch; he[i] = HEND[o]; pe[i] = PEND[o]; }
#pragma unroll
        for (int i = 0; i < 32; ++i) { HIN[(size_t)(b * 128 + n0 + i) * 512 + ch] = hin; hin = he[i] + pe[i] * hin; }
    }
}

__device__ __forceinline__ void cvt_table(const float* src, bf16* dst, size_t n8, size_t wi, size_t nw) {
    for (size_t i = wi; i < n8; i += nw) {
        const f32x4 a = ((const f32x4*)src)[2 * i], c = ((const f32x4*)src)[2 * i + 1];
        v4u o; o.x = pk2(a.x, a.y); o.y = pk2(a.z, a.w); o.z = pk2(c.x, c.y); o.w = pk2(c.z, c.w);
        ((v4u*)dst)[i] = o;
    }
}

__device__ __forceinline__ void lru_combine(const Params& P, size_t wi, size_t nw) {
    unsigned char* ws = P.ws;
    const v4u* HLOC = (const v4u*)(ws + WS_HLOC); const v4u* PCUM = (const v4u*)(ws + WS_PCUM); const v4u* GATE = (const v4u*)(ws + WS_GATE);
    const float* HIN = (const float*)(ws + WS_HIN); bf16* Y = (bf16*)((unsigned char*)P.out + OUT_Y);
    for (size_t i = wi; i < (size_t)T * 64; i += nw) {
        const size_t t = i >> 6; const int ch0 = (int)(i & 63) * 8;
        const v4u hl = HLOC[i], pc = PCUM[i], gt = GATE[i];
        const f32x4 h0 = *(const f32x4*)(HIN + (t >> 6) * 512 + ch0), h1 = *(const f32x4*)(HIN + (t >> 6) * 512 + ch0 + 4);
        float y[8];
        y[0] = (bflo(hl.x) + bflo(pc.x) * h0.x) * gelu_tanh(bflo(gt.x)); y[1] = (bfhi(hl.x) + bfhi(pc.x) * h0.y) * gelu_tanh(bfhi(gt.x));
        y[2] = (bflo(hl.y) + bflo(pc.y) * h0.z) * gelu_tanh(bflo(gt.y)); y[3] = (bfhi(hl.y) + bfhi(pc.y) * h0.w) * gelu_tanh(bfhi(gt.y));
        y[4] = (bflo(hl.z) + bflo(pc.z) * h1.x) * gelu_tanh(bflo(gt.z)); y[5] = (bfhi(hl.z) + bfhi(pc.z) * h1.y) * gelu_tanh(bfhi(gt.z));
        y[6] = (bflo(hl.w) + bflo(pc.w) * h1.z) * gelu_tanh(bflo(gt.w)); y[7] = (bfhi(hl.w) + bfhi(pc.w) * h1.w) * gelu_tanh(bfhi(gt.w));
        v4u o; o.x = pk2(y[0], y[1]); o.y = pk2(y[2], y[3]); o.z = pk2(y[4], y[5]); o.w = pk2(y[6], y[7]);
        *(v4u*)(Y + t * 1024 + 512 + ch0) = o;
    }
}

__device__ __forceinline__ void gdn_gate_norm(const Params& P, size_t wi, size_t nw) {
    unsigned char* ws = P.ws;
    bf16* Y = (bf16*)((unsigned char*)P.out + OUT_Y); const v4u* Z = (const v4u*)(ws + WS_Z); const float* SSQG = P.out;
    for (size_t i = wi; i < (size_t)T * 64; i += nw) {
        const size_t t = i >> 6; const int c0 = (int)(i & 63) * 8, h = c0 >> 7;
        const f32x4 q0 = *(const f32x4*)(SSQG + t * 32 + h * 8);
        const float rstd = rsqrtf(((q0.x + q0.y) + (q0.z + q0.w)) * (1.0f / 128.0f) + 1e-6f);
        const v4u o = *(const v4u*)(Y + t * 1024 + c0), z = Z[i];
        const f32x4 w0 = *(const f32x4*)(P.gdn_norm_w + (c0 & 127)), w1 = *(const f32x4*)(P.gdn_norm_w + (c0 & 127) + 4);
        float y[8];
        y[0] = bflo(o.x) * rstd * w0.x * siluf_(bflo(z.x)); y[1] = bfhi(o.x) * rstd * w0.y * siluf_(bfhi(z.x));
        y[2] = bflo(o.y) * rstd * w0.z * siluf_(bflo(z.y)); y[3] = bfhi(o.y) * rstd * w0.w * siluf_(bfhi(z.y));
        y[4] = bflo(o.z) * rstd * w1.x * siluf_(bflo(z.z)); y[5] = bfhi(o.z) * rstd * w1.y * siluf_(bfhi(z.z));
        y[6] = bflo(o.w) * rstd * w1.z * siluf_(bflo(z.w)); y[7] = bfhi(o.w) * rstd * w1.w * siluf_(bfhi(z.w));
        v4u r; r.x = pk2(y[0], y[1]); r.y = pk2(y[2], y[3]); r.z = pk2(y[4], y[5]); r.w = pk2(y[6], y[7]);
        *(v4u*)(Y + t * 1024 + c0) = r;
    }
}

__device__ __forceinline__ void xattn_stage(LAS unsigned char* lds, const bf16* src, int tid) {
    v4u tmp[16];
    asm volatile("" : "+v"(tid));
    const unsigned voff = (unsigned)tid * 16u;
#pragma unroll
    for (int r = 0; r < 16; ++r) { const unsigned char* sb = (const unsigned char*)src + r * 8192;
        asm volatile("s_nop 4\n\tglobal_load_dwordx4 %0, %1, %2" : "=&v"(tmp[r]) : "v"(voff), "s"(sb) : "memory"); }
    asm volatile("s_waitcnt vmcnt(0)" : "+v"(tmp[0]), "+v"(tmp[1]), "+v"(tmp[2]), "+v"(tmp[3]), "+v"(tmp[4]), "+v"(tmp[5]), "+v"(tmp[6]), "+v"(tmp[7]),
                                        "+v"(tmp[8]), "+v"(tmp[9]), "+v"(tmp[10]), "+v"(tmp[11]), "+v"(tmp[12]), "+v"(tmp[13]), "+v"(tmp[14]), "+v"(tmp[15]) :: "memory");
#pragma unroll
    for (int r = 0; r < 16; ++r) { const int id = tid + 512 * r; *(LAS v4u*)(lds + (id >> 5) * 528 + (id & 31) * 16) = tmp[r]; }
}
#ifndef XA_NPS
#define XA_NPS 2
#endif
__device__ __forceinline__ void xattn_unit(const Params& P, LAS unsigned char* lds, int unit, int tid, int lane, int wave) {
    const unsigned char* ws = P.ws;
    const int h = unit & 3, qb = (unit >> 2) & 63, b = unit >> 8; int col = lane & 15, g = lane >> 4;
    const int tw = b * SEQ + qb * 128 + 16 * wave;
    const bf16* Kb = (const bf16*)(ws + WS_KB) + (size_t)((b * 4 + h) * 256) * 256;
    const bf16* Vt = (const bf16*)(ws + WS_VTP) + (size_t)((b * 4 + h) * 256) * 256;
    xattn_stage(lds, Kb, tid);
    __syncthreads();
    const LAS unsigned char* arow = lds + col * 528 + g * 16;
    bf16x8 Bp[XA_NPS][8]; float inv[XA_NPS];
#pragma unroll
    for (int ps = 0; ps < XA_NPS; ++ps) {
        __builtin_amdgcn_sched_barrier(0); asm volatile("" : "+v"(col), "+v"(g) :: "memory");
        const bf16* Q = (const bf16*)(ws + WS_Q) + (size_t)(tw + 128 * ps + col) * 1024 + h * 256 + 8 * g;
        bf16x8 Bq[8];
#pragma unroll
        for (int s = 0; s < 8; ++s) Bq[s] = *(const bf16x8*)(Q + 32 * s);
        f32x4 St[16];
        bf16x8 fr[2][8];
#pragma unroll
        for (int s = 0; s < 8; ++s) fr[0][s] = *(const LAS bf16x8*)(arow + 64 * s);
#pragma unroll
        for (int kap = 0; kap < 16; ++kap) {
            if (kap + 1 < 16) {
#pragma unroll
                for (int s = 0; s < 8; ++s) fr[(kap + 1) & 1][s] = *(const LAS bf16x8*)(arow + (16 * (kap + 1)) * 528 + 64 * s);
            }
            __builtin_amdgcn_sched_barrier(0);
            PIN8(fr[kap & 1]);
            f32x4 acc = (f32x4){0.f, 0.f, 0.f, 0.f};
#pragma unroll
            for (int s = 0; s < 8; ++s) acc = __builtin_amdgcn_mfma_f32_16x16x32_bf16(fr[kap & 1][s], Bq[s], acc, 0, 0, 0);
            St[kap] = acc;
            __builtin_amdgcn_sched_barrier(0);
        }
        float mx = -3.0e38f;
#pragma unroll
        for (int kap = 0; kap < 16; ++kap) mx = fmaxf(fmaxf(fmaxf(St[kap].x, St[kap].y), fmaxf(St[kap].z, St[kap].w)), mx);
        mx = fmaxf(mx, __shfl_xor(mx, 16)); mx = fmaxf(mx, __shfl_xor(mx, 32));
        float l = 0.f;
#pragma unroll
        for (int kap = 0; kap < 16; ++kap) { St[kap].x = __expf(St[kap].x - mx); St[kap].y = __expf(St[kap].y - mx); St[kap].z = __expf(St[kap].z - mx); St[kap].w = __expf(St[kap].w - mx);
            l += (St[kap].x + St[kap].y) + (St[kap].z + St[kap].w); }
        l += __shfl_xor(l, 16); l += __shfl_xor(l, 32);
        inv[ps] = 1.0f / l;
#pragma unroll
        for (int s = 0; s < 8; ++s) Bp[ps][s] = pack_b(St[2 * s], St[2 * s + 1]);
    }
    __syncthreads();
    xattn_stage(lds, Vt, tid);
    __syncthreads();
#pragma unroll
    for (int ps = 0; ps < XA_NPS; ++ps) {
        __builtin_amdgcn_sched_barrier(0); asm volatile("" : "+v"(col), "+v"(g) :: "memory");
        bf16* AO = (bf16*)(P.ws + WS_AO) + (size_t)(tw + 128 * ps + col) * 1024 + h * 256 + 4 * g;
        bf16x8 fr[2][8];
#pragma unroll
        for (int s = 0; s < 8; ++s) fr[0][s] = *(const LAS bf16x8*)(arow + 64 * s);
#pragma unroll
        for (int del = 0; del < 16; ++del) {
            if (del + 1 < 16) {
#pragma unroll
                for (int s = 0; s < 8; ++s) fr[(del + 1) & 1][s] = *(const LAS bf16x8*)(arow + (16 * (del + 1)) * 528 + 64 * s);
            }
            __builtin_amdgcn_sched_barrier(0);
            PIN8(fr[del & 1]);
            f32x4 acc = (f32x4){0.f, 0.f, 0.f, 0.f};
#pragma unroll
            for (int s = 0; s < 8; ++s) acc = __builtin_amdgcn_mfma_f32_16x16x32_bf16(fr[del & 1][s], Bp[ps][s], acc, 0, 0, 0);
            v2u o; o.x = pk2(acc.x * inv[ps], acc.y * inv[ps]); o.y = pk2(acc.z * inv[ps], acc.w * inv[ps]);
            *(v2u*)(AO + 16 * del) = o;
            __builtin_amdgcn_sched_barrier(0);
        }
    }
    __syncthreads();
}

__device__ __forceinline__ unsigned key_enc(float f) { const unsigned u = __builtin_bit_cast(unsigned, f); return (u & 0x80000000u) ? ~u : (u | 0x80000000u); }
__device__ __forceinline__ float key_dec(unsigned k) { const unsigned u = (k & 0x80000000u) ? (k & 0x7fffffffu) : ~k; return __builtin_bit_cast(float, u); }
#define TK_CAS(a, b) do { const unsigned hi_ = max(a, b), lo_ = min(a, b); a = hi_; b = lo_; } while (0)
__device__ __forceinline__ void tk_merge16(unsigned (&a)[16]) {
#pragma unroll
    for (int j = 8; j > 0; j >>= 1)
#pragma unroll
        for (int i = 0; i < 16; ++i) { const int l = i ^ j; if (l > i) TK_CAS(a[i], a[l]); }
}
__device__ __forceinline__ void tk_sort16(unsigned (&a)[16]) {
#define TK_L(...) do { const int pr_[] = {__VA_ARGS__}; _Pragma("unroll") for (int q_ = 0; q_ < (int)(sizeof(pr_) / sizeof(int)); q_ += 2) TK_CAS(a[pr_[q_]], a[pr_[q_ + 1]]); } while (0)
    TK_CAS(a[0], a[13]); TK_CAS(a[1], a[12]); TK_CAS(a[2], a[15]); TK_CAS(a[3], a[14]); TK_CAS(a[4], a[8]); TK_CAS(a[5], a[6]); TK_CAS(a[7], a[11]); TK_CAS(a[9], a[10]);
    TK_CAS(a[0], a[5]); TK_CAS(a[1], a[7]); TK_CAS(a[2], a[9]); TK_CAS(a[3], a[4]); TK_CAS(a[6], a[13]); TK_CAS(a[8], a[14]); TK_CAS(a[10], a[15]); TK_CAS(a[11], a[12]);
    TK_CAS(a[0], a[1]); TK_CAS(a[2], a[3]); TK_CAS(a[4], a[5]); TK_CAS(a[6], a[8]); TK_CAS(a[7], a[9]); TK_CAS(a[10], a[11]); TK_CAS(a[12], a[13]); TK_CAS(a[14], a[15]);
    TK_CAS(a[0], a[2]); TK_CAS(a[1], a[3]); TK_CAS(a[4], a[10]); TK_CAS(a[5], a[11]); TK_CAS(a[6], a[7]); TK_CAS(a[8], a[9]); TK_CAS(a[12], a[14]); TK_CAS(a[13], a[15]);
    TK_CAS(a[1], a[2]); TK_CAS(a[3], a[12]); TK_CAS(a[4], a[6]); TK_CAS(a[5], a[7]); TK_CAS(a[8], a[10]); TK_CAS(a[9], a[11]); TK_CAS(a[13], a[14]);
    TK_CAS(a[1], a[4]); TK_CAS(a[2], a[6]); TK_CAS(a[5], a[8]); TK_CAS(a[7], a[10]); TK_CAS(a[9], a[13]); TK_CAS(a[11], a[14]);
    TK_CAS(a[2], a[4]); TK_CAS(a[3], a[6]); TK_CAS(a[9], a[12]); TK_CAS(a[11], a[13]);
    TK_CAS(a[3], a[5]); TK_CAS(a[6], a[8]); TK_CAS(a[7], a[9]); TK_CAS(a[10], a[12]);
    TK_CAS(a[3], a[4]); TK_CAS(a[5], a[6]); TK_CAS(a[7], a[8]); TK_CAS(a[9], a[10]); TK_CAS(a[11], a[12]);
    TK_CAS(a[6], a[7]); TK_CAS(a[8], a[9]);
#undef TK_L
}
__device__ __forceinline__ void tk_top16_merge(unsigned (&L)[16], const unsigned (&G)[16]) {
#pragma unroll
    for (int i = 0; i < 16; ++i) L[i] = max(L[i], G[15 - i]);
    tk_merge16(L);
}
__device__ __forceinline__ void tk_pair_merge(unsigned (&L)[16]) {
    unsigned Pp[16];
#pragma unroll
    for (int i = 0; i < 16; ++i) Pp[i] = (unsigned)__builtin_amdgcn_update_dpp(0, (int)L[i], 0xB1, 0xF, 0xF, true);
    tk_top16_merge(L, Pp);
}
__device__ __forceinline__ void peer_topk_rows(const Params& P, LAS unsigned char* lds, int rowbase, int tid) {
    const unsigned char* ws = P.ws;
    typedef _Float16 f16x8 __attribute__((ext_vector_type(8)));
    const int rl = tid >> 1, hf = tid & 1, grow = rowbase + rl, t = grow >> 3, h = grow & 7;
    const _Float16* SC = (const _Float16*)(ws + WS_PQ) + (size_t)t * 2048 + h * 256 + 64 * hf;
    f16x8 raw[2][8];
#pragma unroll
    for (int p = 0; p < 2; ++p)
#pragma unroll
        for (int q = 0; q < 8; ++q) raw[p][q] = *(const f16x8*)(SC + p * 128 + 8 * q);
    unsigned L1[16], L2[16];
#pragma unroll
    for (int p = 0; p < 2; ++p) {
        unsigned L[16];
#pragma unroll
        for (int grp = 0; grp < 4; ++grp) {
            unsigned G[16];
#pragma unroll
            for (int e = 0; e < 16; ++e) G[e] = (key_enc((float)raw[p][2 * grp + (e >> 3)][e & 7]) & ~127u) | (unsigned)(127 - (64 * hf + 16 * grp + e));
            tk_sort16(G);
            if (grp == 0) {
#pragma unroll
                for (int i = 0; i < 16; ++i) L[i] = G[i];
            } else tk_top16_merge(L, G);
        }
        tk_pair_merge(L);
#pragma unroll
        for (int i = 0; i < 16; ++i) { if (p == 0) L1[i] = L[i]; else L2[i] = L[i]; }
    }
    {
        float v1[16], v2[16];
        LAS int* il = (LAS int*)lds + rl * 33;
#pragma unroll
        for (int q = 0; q < 16; ++q) { v1[q] = key_dec((L1[q] & ~127u) | 64u); v2[q] = key_dec((L2[q] & ~127u) | 64u); }
        if (hf == 0) {
#pragma unroll
            for (int q = 0; q < 16; ++q) { il[q] = 127 - (int)(L1[q] & 127u); il[16 + q] = 127 - (int)(L2[q] & 127u); }
        }
        unsigned C[16], D[16];
        float w1[8];
        const unsigned hf16 = (unsigned)hf * 16u, evenmask = (unsigned)hf - 1u;
#pragma unroll
        for (int k = 0; k < 8; ++k) w1[k] = __builtin_bit_cast(float, (__builtin_bit_cast(unsigned, v1[2 * k]) & evenmask) | (__builtin_bit_cast(unsigned, v1[2 * k + 1]) & ~evenmask));
#define TK_SLOT(dst, k, bq, valid_odd) do { const unsigned pos_ = (unsigned)(16 * (2 * (k)) + (bq)) + hf16; unsigned kv_ = (key_enc(w1[k] + v2[bq]) & ~255u) | (255u - pos_); if (!(valid_odd)) kv_ &= evenmask; dst = kv_; } while (0)
        TK_SLOT(C[0], 0, 0, true);
        TK_SLOT(C[1], 0, 1, true);
        TK_SLOT(C[2], 0, 2, true);
        TK_SLOT(C[3], 0, 3, true);
        TK_SLOT(C[4], 0, 4, true);
        TK_SLOT(C[5], 0, 5, true);
        TK_SLOT(C[6], 0, 6, true);
        TK_SLOT(C[7], 0, 7, true);
        TK_SLOT(C[8], 0, 8, false);
        TK_SLOT(C[9], 0, 9, false);
        TK_SLOT(C[10], 0, 10, false);
        TK_SLOT(C[11], 0, 11, false);
        TK_SLOT(C[12], 0, 12, false);
        TK_SLOT(C[13], 0, 13, false);
        TK_SLOT(C[14], 0, 14, false);
        TK_SLOT(C[15], 0, 15, false);
        TK_SLOT(D[0], 1, 0, true);
        TK_SLOT(D[1], 1, 1, true);
        TK_SLOT(D[2], 1, 2, true);
        TK_SLOT(D[3], 1, 3, true);
        TK_SLOT(D[4], 1, 4, false);
        TK_SLOT(D[5], 2, 0, true);
        TK_SLOT(D[6], 2, 1, true);
        TK_SLOT(D[7], 2, 2, false);
        TK_SLOT(D[8], 3, 0, true);
        TK_SLOT(D[9], 3, 1, true);
        TK_SLOT(D[10], 4, 0, true);
        TK_SLOT(D[11], 5, 0, true);
        TK_SLOT(D[12], 6, 0, true);
        TK_SLOT(D[13], 7, 0, true);
        D[14] = 0u; D[15] = 0u;
#undef TK_SLOT
        tk_sort16(C); tk_sort16(D); tk_top16_merge(C, D); tk_pair_merge(C);
        LDS_WAIT(); asm volatile("" ::: "memory");
        float best[16], e[16], sum = 0.f;
#pragma unroll
        for (int q = 0; q < 16; ++q) { best[q] = key_dec((C[q] & ~255u) | 128u); e[q] = __expf(best[q] - best[0]); sum += e[q]; }
        const float inv = __builtin_amdgcn_rcpf(sum);
        int* IDX = (int*)(P.ws + WS_IDX) + (size_t)grow * 16 + 8 * hf; float* GW = (float*)(P.ws + WS_GW) + (size_t)grow * 16 + 8 * hf;
#pragma unroll
        for (int q = 0; q < 8; ++q) {
            const unsigned c = (C[q] & evenmask) | (C[8 + q] & ~evenmask);
            const float ev = __builtin_bit_cast(float, (__builtin_bit_cast(unsigned, e[q]) & evenmask) | (__builtin_bit_cast(unsigned, e[8 + q]) & ~evenmask));
            const unsigned pos = 255u - (c & 255u);
            IDX[q] = il[pos >> 4] * 128 + il[16 + (pos & 15u)]; GW[q] = ev * inv;
        }
    }
    LDS_WAIT(); asm volatile("" ::: "memory");
}

__device__ __forceinline__ void peer_topk_wave(const Params& P, LAS int* ilw, LAS unsigned* oute, LAS float* outg, int tbase, int lane) {
    const unsigned char* ws = P.ws;
    typedef _Float16 f16x8 __attribute__((ext_vector_type(8)));
    const int rl = lane >> 1, hf = lane & 1, t = tbase + (rl >> 3), h = rl & 7;
    const _Float16* SC = (const _Float16*)(ws + WS_PQ) + (size_t)t * 2048 + h * 256 + 64 * hf;
    f16x8 raw[2][8];
#pragma unroll
    for (int p = 0; p < 2; ++p)
#pragma unroll
        for (int q = 0; q < 8; ++q) raw[p][q] = *(const f16x8*)(SC + p * 128 + 8 * q);
    unsigned L1[16], L2[16];
    typedef short s16x2 __attribute__((ext_vector_type(2)));
    const unsigned lanebit = 64u - 64u * (unsigned)hf;
#pragma unroll
    for (int p = 0; p < 2; ++p) {
        unsigned L[16];
#pragma unroll
        for (int grp = 0; grp < 4; ++grp) {
            unsigned G[16];
#pragma unroll
            for (int e2 = 0; e2 < 8; ++e2) {
                const v4u wv = __builtin_bit_cast(v4u, raw[p][2 * grp + (e2 >> 2)]);
                const unsigned w = wv[e2 & 3];
                const unsigned m = __builtin_bit_cast(unsigned, __builtin_bit_cast(s16x2, w) >> (s16x2){15, 15}) | 0x80008000u;
                const unsigned k = w ^ m;
                G[2 * e2] = (k << 16) | (unsigned)(63 - (16 * grp + 2 * e2));
                G[2 * e2 + 1] = (k & 0xffff0000u) | (unsigned)(63 - (16 * grp + 2 * e2 + 1));
            }
            tk_sort16(G);
            if (grp == 0) {
#pragma unroll
                for (int i = 0; i < 16; ++i) L[i] = G[i];
            } else tk_top16_merge(L, G);
        }
#pragma unroll
        for (int i = 0; i < 16; ++i) L[i] |= lanebit;
        tk_pair_merge(L);
#pragma unroll
        for (int i = 0; i < 16; ++i) { if (p == 0) L1[i] = L[i]; else L2[i] = L[i]; }
    }
    {
        float v1[16], v2[16];
        LAS int* il = ilw + rl * 33;
#pragma unroll
        for (int q = 0; q < 16; ++q) {
            const unsigned a = L1[q], c = L2[q];
            const unsigned ha = (a >> 16) ^ ((~(unsigned)((int)a >> 31) | 0x8000u) & 0xffffu), hc = (c >> 16) ^ ((~(unsigned)((int)c >> 31) | 0x8000u) & 0xffffu);
            v1[q] = (float)__builtin_bit_cast(_Float16, (unsigned short)ha); v2[q] = (float)__builtin_bit_cast(_Float16, (unsigned short)hc); }
        if (hf == 0) {
#pragma unroll
            for (int q = 0; q < 16; ++q) { il[q] = 127 - (int)(L1[q] & 127u); il[16 + q] = 127 - (int)(L2[q] & 127u); }
        }
        unsigned C[16], D[16];
        float w1[8];
        const unsigned hf16 = (unsigned)hf * 16u, evenmask = (unsigned)hf - 1u;
#pragma unroll
        for (int k = 0; k < 8; ++k) w1[k] = __builtin_bit_cast(float, (__builtin_bit_cast(unsigned, v1[2 * k]) & evenmask) | (__builtin_bit_cast(unsigned, v1[2 * k + 1]) & ~evenmask));
#define TK_SLOT(dst, k, bq, valid_odd) do { const unsigned pos_ = (unsigned)(16 * (2 * (k)) + (bq)) + hf16; unsigned kv_ = (key_enc(w1[k] + v2[bq]) & ~255u) | (255u - pos_); if (!(valid_odd)) kv_ &= evenmask; dst = kv_; } while (0)
        TK_SLOT(C[0], 0, 0, true);
        TK_SLOT(C[1], 0, 1, true);
        TK_SLOT(C[2], 0, 2, true);
        TK_SLOT(C[3], 0, 3, true);
        TK_SLOT(C[4], 0, 4, true);
        TK_SLOT(C[5], 0, 5, true);
        TK_SLOT(C[6], 0, 6, true);
        TK_SLOT(C[7], 0, 7, true);
        TK_SLOT(C[8], 0, 8, false);
        TK_SLOT(C[9], 0, 9, false);
        TK_SLOT(C[10], 0, 10, false);
        TK_SLOT(C[11], 0, 11, false);
        TK_SLOT(C[12], 0, 12, false);
        TK_SLOT(C[13], 0, 13, false);
        TK_SLOT(C[14], 0, 14, false);
        TK_SLOT(C[15], 0, 15, false);
        TK_SLOT(D[0], 1, 0, true);
        TK_SLOT(D[1], 1, 1, true);
        TK_SLOT(D[2], 1, 2, true);
        TK_SLOT(D[3], 1, 3, true);
        TK_SLOT(D[4], 1, 4, false);
        TK_SLOT(D[5], 2, 0, true);
        TK_SLOT(D[6], 2, 1, true);
        TK_SLOT(D[7], 2, 2, false);
        TK_SLOT(D[8], 3, 0, true);
        TK_SLOT(D[9], 3, 1, true);
        TK_SLOT(D[10], 4, 0, true);
        TK_SLOT(D[11], 5, 0, true);
        TK_SLOT(D[12], 6, 0, true);
        TK_SLOT(D[13], 7, 0, true);
        D[14] = 0u; D[15] = 0u;
#undef TK_SLOT
        tk_sort16(C); tk_sort16(D); tk_top16_merge(C, D); tk_pair_merge(C);
        LDS_WAIT(); asm volatile("" ::: "memory");
        float best[16], e[16], sum = 0.f;
#pragma unroll
        for (int q = 0; q < 16; ++q) { best[q] = key_dec((C[q] & ~255u) | 128u); e[q] = __expf(best[q] - best[0]); sum += e[q]; }
        const float inv = __builtin_amdgcn_rcpf(sum);
        LAS unsigned* IDX = oute + rl * 16 + 8 * hf; LAS float* GW = outg + rl * 16 + 8 * hf;
#pragma unroll
        for (int q = 0; q < 8; ++q) {
            const unsigned c = (C[q] & evenmask) | (C[8 + q] & ~evenmask);
            const float ev = __builtin_bit_cast(float, (__builtin_bit_cast(unsigned, e[q]) & evenmask) | (__builtin_bit_cast(unsigned, e[8 + q]) & ~evenmask));
            const unsigned pos = 255u - (c & 255u);
            IDX[q] = (unsigned)(il[pos >> 4] * 128 + il[16 + (pos & 15u)]); GW[q] = ev * inv;
        }
    }
    LDS_WAIT(); asm volatile("" ::: "memory");
}

typedef float f32x2 __attribute__((ext_vector_type(2)));
__device__ __forceinline__ unsigned q8(float x) { return (unsigned)(int)rintf(x) & 0xffu; }
__device__ __forceinline__ void cvt_table_fp8(const float* src, unsigned char* dst, float* scl, int gw, int ngw, int lane) {
    for (int row = gw; row < 16384; row += ngw) {
        const f32x4* sp = (const f32x4*)(src + (size_t)row * 1024 + 16 * lane);
        const f32x4 a0 = sp[0], a1 = sp[1], a2 = sp[2], a3 = sp[3];
        float m = fmaxf(fmaxf(fmaxf(fabsf(a0.x), fabsf(a0.y)), fmaxf(fabsf(a0.z), fabsf(a0.w))), fmaxf(fmaxf(fabsf(a1.x), fabsf(a1.y)), fmaxf(fabsf(a1.z), fabsf(a1.w))));
        m = fmaxf(m, fmaxf(fmaxf(fmaxf(fabsf(a2.x), fabsf(a2.y)), fmaxf(fabsf(a2.z), fabsf(a2.w))), fmaxf(fmaxf(fabsf(a3.x), fabsf(a3.y)), fmaxf(fabsf(a3.z), fabsf(a3.w)))));
#pragma unroll
        for (int o = 1; o < 64; o <<= 1) m = fmaxf(m, __shfl_xor(m, o));
        m = fmaxf(m, 1e-30f);
        const float q = 127.0f / m;
        v4u o;
        o.x = q8(a0.x * q) | (q8(a0.y * q) << 8) | (q8(a0.z * q) << 16) | (q8(a0.w * q) << 24);
        o.y = q8(a1.x * q) | (q8(a1.y * q) << 8) | (q8(a1.z * q) << 16) | (q8(a1.w * q) << 24);
        o.z = q8(a2.x * q) | (q8(a2.y * q) << 8) | (q8(a2.z * q) << 16) | (q8(a2.w * q) << 24);
        o.w = q8(a3.x * q) | (q8(a3.y * q) << 8) | (q8(a3.z * q) << 16) | (q8(a3.w * q) << 24);
        *(v4u*)(dst + (size_t)row * 1024 + 16 * lane) = o;
        if (lane == 0) scl[row] = m * (1.0f / 127.0f);
    }
}
__device__ __forceinline__ int row16_sum_i(int v) {
    v += __builtin_amdgcn_update_dpp(0, v, 0xB1, 0xF, 0xF, true);
    v += __builtin_amdgcn_update_dpp(0, v, 0x4E, 0xF, 0xF, true);
    v += __builtin_amdgcn_update_dpp(0, v, 0x141, 0xF, 0xF, true);
    v += __builtin_amdgcn_update_dpp(0, v, 0x140, 0xF, 0xF, true);
    return v;
}
constexpr int PE_NT = 4, PE_NR = 16, PE_SH = 10, PE_DEP = 3;
constexpr int PE_TOK_W = 128 * 3 + 20;
constexpr int PE_ENT_W = 272 * 4;
constexpr int PE_WAVE_W = PE_NT * PE_TOK_W + PE_ENT_W + 32 * 33 + 2 * PE_NT * 128;
static_assert(8 * PE_WAVE_W * 4 <= MISC_OFF && PE_NR * PE_NT == 64, "peer LDS / batch-list geometry");
#define PE_LD(dst, voff_, sbase_) asm volatile("s_nop 4\n\tglobal_load_dwordx4 %0, %1, %2" : "=&v"(dst) : "v"(voff_), "s"(sbase_) : "memory")
__device__ __forceinline__ void peer_pass(const Params& P, LAS unsigned char* lds, int tbase, int lane, int wave, float* dstbase, int emask = 0x3fff) {
    asm volatile("v_mbcnt_lo_u32_b32 %0, -1, 0\n\tv_mbcnt_hi_u32_b32 %0, -1, %0" : "=v"(lane));
    {
        LAS unsigned* lw0 = (LAS unsigned*)(lds) + wave * PE_WAVE_W + PE_NT * PE_TOK_W + PE_ENT_W;
        peer_topk_wave(P, (LAS int*)lw0, lw0 + 32 * 33, (LAS float*)(lw0 + 32 * 33 + PE_NT * 128), tbase, lane);
        LDS_WAIT(); asm volatile("" : "+v"(lane), "+s"(tbase) :: "memory");
    }
    const unsigned char* ws = P.ws;
    const unsigned char* UB8 = ws + WS_UB; const unsigned char* VB8 = ws + WS_VB;
    const float* USC = (const float*)(ws + WS_USC); const float* VSC = (const float*)(ws + WS_VSC);
    f32x2 acc[PE_NT][8];
    LAS unsigned* lw = (LAS unsigned*)(lds) + wave * PE_WAVE_W;
    LAS unsigned* ents = lw + PE_NT * PE_TOK_W;
    const unsigned voff = (unsigned)lane * 16u;
    LAS unsigned* upe = ents + PE_ENT_W + 32 * 33; LAS float* upg = (LAS float*)(upe + PE_NT * 128);
    LAS unsigned* hql = ents + PE_ENT_W;
#pragma unroll
    for (int j = 0; j < PE_NT; ++j) {
        const int t = tbase + j;
        const v4u* xrow = (const v4u*)((const bf16*)(ws + WS_XB) + (size_t)t * 1024 + 16 * lane);
        const v4u xa = xrow[0], xc = xrow[1];
        const f32x4 xvv[4] = {(f32x4){bflo(xa.x), bfhi(xa.x), bflo(xa.y), bfhi(xa.y)}, (f32x4){bflo(xa.z), bfhi(xa.z), bflo(xa.w), bfhi(xa.w)},
                              (f32x4){bflo(xc.x), bfhi(xc.x), bflo(xc.y), bfhi(xc.y)}, (f32x4){bflo(xc.z), bfhi(xc.z), bflo(xc.w), bfhi(xc.w)}};
        const float rstd2 = rsqrtf(((const float*)(ws + WS_SSQ2))[t] * (1.0f / 1024.0f) + 1e-6f);
        f32x4 hv[4]; float hm = 0.f;
#pragma unroll
        for (int i = 0; i < 4; ++i) { const f32x4 xv = xvv[i]; const f32x4 w = ((const f32x4*)(P.norm_ffn_w + 16 * lane))[i];
            hv[i] = (f32x4){xv.x * rstd2 * w.x, xv.y * rstd2 * w.y, xv.z * rstd2 * w.z, xv.w * rstd2 * w.w};
            hm = fmaxf(hm, fmaxf(fmaxf(fabsf(hv[i].x), fabsf(hv[i].y)), fmaxf(fabsf(hv[i].z), fabsf(hv[i].w)))); }
#pragma unroll
        for (int o = 1; o < 64; o <<= 1) hm = fmaxf(hm, __shfl_xor(hm, o));
        hm = fmaxf(hm, 1e-30f);
        const float hqs = 127.0f / hm, hs = hm * (1.0f / 127.0f);
        { unsigned hqv[4];
#pragma unroll
          for (int i = 0; i < 4; ++i) hqv[i] = q8(hv[i].x * hqs) | (q8(hv[i].y * hqs) << 8) | (q8(hv[i].z * hqs) << 16) | (q8(hv[i].w * hqs) << 24);
          *(LAS v4u*)(hql + (j * 64 + lane) * 4) = (v4u){hqv[0], hqv[1], hqv[2], hqv[3]}; }
#pragma unroll
        for (int i = 0; i < 8; ++i) acc[j][i] = (f32x2){0.f, 0.f};
        const int e0 = (int)upe[j * 128 + 2 * lane] & emask, e1 = (int)upe[j * 128 + 2 * lane + 1] & emask;
        const float g0 = upg[j * 128 + 2 * lane] * VSC[e0], g1 = upg[j * 128 + 2 * lane + 1] * VSC[e1];
        const float u0 = USC[e0] * hs, u1 = USC[e1] * hs;
        const int rev = (tbase >= T / 2) ? (PE_NR - 1) : 0;
        const int b0 = (e0 >> PE_SH) ^ rev, b1 = (e1 >> PE_SH) ^ rev;
        LAS unsigned* lt = lw + j * PE_TOK_W;
        int run = 0;
#pragma unroll 1
        for (int bk = 0; bk < PE_NR; ++bk) {
            const unsigned long long m0 = __ballot(b0 == bk), m1 = __ballot(b1 == bk);
            const int c0 = __popcll(m0), c1 = __popcll(m1);
            const unsigned long long lower = (1ull << lane) - 1ull;
            if (b0 == bk) { const int p = run + __popcll(m0 & lower); lt[p] = (unsigned)e0; lt[128 + p] = __builtin_bit_cast(unsigned, g0); lt[256 + p] = __builtin_bit_cast(unsigned, u0); }
            if (b1 == bk) { const int p = run + c0 + __popcll(m1 & lower); lt[p] = (unsigned)e1; lt[128 + p] = __builtin_bit_cast(unsigned, g1); lt[256 + p] = __builtin_bit_cast(unsigned, u1); }
            if (lane == 0) lt[384 + bk] = (unsigned)run;
            run += c0 + c1;
        }
        if (lane == 0) lt[384 + PE_NR] = 128u;
        asm volatile("" ::: "memory");
    }
    LDS_WAIT(); asm volatile("" ::: "memory");
    int nb;
    {
        const int rd = lane >> 2, j = (rd & 1) ? 3 - (lane & 3) : (lane & 3);
        const LAS unsigned* lt = lw + j * PE_TOK_W;
        const int n0 = (int)lt[384 + rd], n1 = (int)lt[384 + rd + 1];
        const int nbl = (n1 - n0 + 3) >> 2;
        int inc = nbl;
#pragma unroll
        for (int off = 1; off < 64; off <<= 1) { const int tv = __shfl_up(inc, off); if (lane >= off) inc += tv; }
        nb = __builtin_amdgcn_readlane(inc, 63);
        const int ofs = inc - nbl;
#pragma unroll 1
        for (int q = 0; q < nbl; ++q) { const int i0 = n0 + 4 * q, c = (n1 - i0) < 4 ? (n1 - i0) : 4;
            const unsigned e0 = lt[i0], e1 = lt[i0 + (c > 1 ? 1 : c - 1)], e2 = lt[i0 + (c > 2 ? 2 : c - 1)], e3 = lt[i0 + (c > 3 ? 3 : c - 1)];
            *(LAS v4u*)(ents + 4 * (ofs + q)) = (v4u){e0 | (((unsigned)j | ((unsigned)c << 2) | ((unsigned)i0 << 5)) << 14), e1, e2, e3}; }
        if (lane < 2 * PE_DEP) *(LAS v4u*)(ents + 4 * (nb + lane)) = (v4u){0u, 0u, 0u, 0u};
    }
    LDS_WAIT(); asm volatile("" ::: "memory");
    v4u ru[PE_DEP][4], rv[PE_DEP][4];
#define PE_LDO(dst, vo_, sbase_) asm volatile("global_load_dwordx4 %0, %1, %2" : "=&v"(dst) : "v"(vo_), "s"(sbase_) : "memory")
#define PE_ISSUE(S, rec_) do { const unsigned e0_ = (rec_).x & 0x3fffu; \
        { const unsigned vo_ = (e0_ << 10) + voff; PE_LDO(ru[S][0], vo_, UB8); PE_LDO(rv[S][0], vo_, VB8); } \
        { const unsigned vo_ = ((rec_).y << 10) + voff; PE_LDO(ru[S][1], vo_, UB8); PE_LDO(rv[S][1], vo_, VB8); } \
        { const unsigned vo_ = ((rec_).z << 10) + voff; PE_LDO(ru[S][2], vo_, UB8); PE_LDO(rv[S][2], vo_, VB8); } \
        { const unsigned vo_ = ((rec_).w << 10) + voff; PE_LDO(ru[S][3], vo_, UB8); PE_LDO(rv[S][3], vo_, VB8); } } while (0)
#define PE_WAIT8(S, cntstr) asm volatile("s_waitcnt " cntstr : "+v"(ru[S][0]), "+v"(ru[S][1]), "+v"(ru[S][2]), "+v"(ru[S][3]), "+v"(rv[S][0]), "+v"(rv[S][1]), "+v"(rv[S][2]), "+v"(rv[S][3]) :: "memory")
#define PE_UDOTS(S) asm("v_dot4_i32_i8 %0, %4, %20, 0\n\tv_dot4_i32_i8 %1, %8, %20, 0\n\tv_dot4_i32_i8 %2, %12, %20, 0\n\tv_dot4_i32_i8 %3, %16, %20, 0\n\t" \
                        "v_dot4_i32_i8 %0, %5, %21, %0\n\tv_dot4_i32_i8 %1, %9, %21, %1\n\tv_dot4_i32_i8 %2, %13, %21, %2\n\tv_dot4_i32_i8 %3, %17, %21, %3\n\t" \
                        "v_dot4_i32_i8 %0, %6, %22, %0\n\tv_dot4_i32_i8 %1, %10, %22, %1\n\tv_dot4_i32_i8 %2, %14, %22, %2\n\tv_dot4_i32_i8 %3, %18, %22, %3\n\t" \
                        "v_dot4_i32_i8 %0, %7, %23, %0\n\tv_dot4_i32_i8 %1, %11, %23, %1\n\tv_dot4_i32_i8 %2, %15, %23, %2\n\tv_dot4_i32_i8 %3, %19, %23, %3\n\ts_nop 2" \
        : "=&v"(d_[0]), "=&v"(d_[1]), "=&v"(d_[2]), "=&v"(d_[3]) \
        : "v"(ru[S][0].x), "v"(ru[S][0].y), "v"(ru[S][0].z), "v"(ru[S][0].w), "v"(ru[S][1].x), "v"(ru[S][1].y), "v"(ru[S][1].z), "v"(ru[S][1].w), \
          "v"(ru[S][2].x), "v"(ru[S][2].y), "v"(ru[S][2].z), "v"(ru[S][2].w), "v"(ru[S][3].x), "v"(ru[S][3].y), "v"(ru[S][3].z), "v"(ru[S][3].w), \
          "v"(hcur.x), "v"(hcur.y), "v"(hcur.z), "v"(hcur.w))
#define PE_UDOTS_SAFE(S) do { _Pragma("unroll") for (int k_ = 0; k_ < 4; ++k_) { int s_ = __builtin_amdgcn_sdot4((int)ru[S][k_].x, (int)hcur.x, 0, false); s_ = __builtin_amdgcn_sdot4((int)ru[S][k_].y, (int)hcur.y, s_, false); \
            s_ = __builtin_amdgcn_sdot4((int)ru[S][k_].z, (int)hcur.z, s_, false); s_ = __builtin_amdgcn_sdot4((int)ru[S][k_].w, (int)hcur.w, s_, false); d_[k_] = s_; } } while (0)
#define PE_VDOTS_SAFE(f0, f1, f2, f3, b0, b1, b2, b3, w) do { f0 = (float)__builtin_amdgcn_sdot4((int)(b0), (int)(w), 0, false); f1 = (float)__builtin_amdgcn_sdot4((int)(b1), (int)(w), 0, false); \
            f2 = (float)__builtin_amdgcn_sdot4((int)(b2), (int)(w), 0, false); f3 = (float)__builtin_amdgcn_sdot4((int)(b3), (int)(w), 0, false); } while (0)
#define PE_VDOTS(f0, f1, f2, f3, b0, b1, b2, b3, w) asm("v_dot4_i32_i8 %0, %4, %8, 0\n\tv_dot4_i32_i8 %1, %5, %8, 0\n\tv_dot4_i32_i8 %2, %6, %8, 0\n\tv_dot4_i32_i8 %3, %7, %8, 0\n\t" \
                        "v_cvt_f32_i32_e32 %0, %0\n\tv_cvt_f32_i32_e32 %1, %1\n\tv_cvt_f32_i32_e32 %2, %2\n\tv_cvt_f32_i32_e32 %3, %3" \
        : "=&v"(f0), "=&v"(f1), "=&v"(f2), "=&v"(f3) : "v"(b0), "v"(b1), "v"(b2), "v"(b3), "v"(w))
#define PE_COMPUTE_B(S, c_, i_, j_, SG) do { const LAS unsigned* lt_ = lw + (j_) * PE_TOK_W; \
        const int myk_ = lane >> 4; \
        float gsc_ = __builtin_bit_cast(float, lt_[128 + i_ + myk_]), usc_ = __builtin_bit_cast(float, lt_[256 + i_ + myk_]);     \
        int d_[4]; \
        PE_UDOTS(S); \
        int r1_; \
        { const v2u p02_ = __builtin_amdgcn_permlane32_swap((unsigned)d_[0], (unsigned)d_[2], false, false), p13_ = __builtin_amdgcn_permlane32_swap((unsigned)d_[1], (unsigned)d_[3], false, false); \
          const v2u q_ = __builtin_amdgcn_permlane16_swap(p02_.x + p02_.y, p13_.x + p13_.y, false, false); r1_ = row16_sum_i((int)(q_.x + q_.y)); }     \
        float act_; \
        { const float x_ = (float)r1_ * usc_, e_ = __builtin_amdgcn_exp2f(x_ * __builtin_fmaf(x_ * x_, -0.10294324f, -2.3022082f));     \
          act_ = x_ * __builtin_amdgcn_rcpf(1.0f + e_) * gsc_; act_ = (myk_ < c_) ? act_ : 0.f; } \
        float wm_; \
        { unsigned wmu_ = __builtin_bit_cast(unsigned, act_) & 0x7fffffffu;                 \
          v2u t_ = __builtin_amdgcn_permlane32_swap(wmu_, wmu_, false, false); wmu_ = t_.x > t_.y ? t_.x : t_.y; \
          t_ = __builtin_amdgcn_permlane16_swap(wmu_, wmu_, false, false); wmu_ = t_.x > t_.y ? t_.x : t_.y; \
          wm_ = fmaxf(__builtin_bit_cast(float, wmu_), 1e-30f); } \
        const float wq_ = 127.0f * __builtin_amdgcn_rcpf(wm_), ws_ = (SG) * wm_ * (1.0f / 127.0f); \
        unsigned w4u_ = (__builtin_bit_cast(unsigned, __builtin_fmaf(act_, wq_, 12582912.0f)) & 0xffu) << (8 * myk_); \
        { v2u t_ = __builtin_amdgcn_permlane32_swap(w4u_, w4u_, false, false); w4u_ = t_.x | t_.y; t_ = __builtin_amdgcn_permlane16_swap(w4u_, w4u_, false, false); w4u_ = t_.x | t_.y; } \
        const f32x2 ws2_ = (f32x2){ws_, ws_}; \
        _Pragma("unroll") for (int m_ = 0; m_ < 4; ++m_) { \
            const unsigned R0_ = rv[S][0][m_], R1_ = rv[S][1][m_], R2_ = rv[S][2][m_], R3_ = rv[S][3][m_]; \
            const unsigned X_ = __builtin_amdgcn_perm(R1_, R0_, 0x05010400u), Y_ = __builtin_amdgcn_perm(R1_, R0_, 0x07030602u), Z_ = __builtin_amdgcn_perm(R3_, R2_, 0x05010400u), W_ = __builtin_amdgcn_perm(R3_, R2_, 0x07030602u); \
            float t0_, t1_, t2_, t3_; \
            const unsigned b0_ = __builtin_amdgcn_perm(Z_, X_, 0x05040100u), b1_ = __builtin_amdgcn_perm(Z_, X_, 0x07060302u), b2_ = __builtin_amdgcn_perm(W_, Y_, 0x05040100u), b3_ = __builtin_amdgcn_perm(W_, Y_, 0x07060302u); \
            PE_VDOTS(t0_, t1_, t2_, t3_, b0_, b1_, b2_, b3_, w4u_); \
            cur[2 * m_] = __builtin_elementwise_fma((f32x2){t0_, t1_}, ws2_, cur[2 * m_]); \
            cur[2 * m_ + 1] = __builtin_elementwise_fma((f32x2){t2_, t3_}, ws2_, cur[2 * m_ + 1]); } } while (0)
#define PE_FLUSH() do { _Pragma("unroll") for (int J_ = 0; J_ < PE_NT; ++J_) { const float sel_ = (jcur == J_) ? 1.0f : 0.0f; const f32x2 sel2_ = (f32x2){sel_, sel_};     \
            _Pragma("unroll") for (int i_ = 0; i_ < 8; ++i_) acc[J_][i_] = __builtin_elementwise_fma(cur[i_], sel2_, acc[J_][i_]); } \
        _Pragma("unroll") for (int i_ = 0; i_ < 8; ++i_) cur[i_] = (f32x2){0.f, 0.f}; } while (0)
#define PE_COMPUTE_S(S, entv, SG) do { const unsigned en_ = (entv) >> 14; const int jj_ = (int)(en_ & 3u), cc_ = (int)((en_ >> 2) & 7u), ii_ = (int)(en_ >> 5); \
        if (cc_ > 0) { if (jj_ != jcur) { PE_FLUSH(); jcur = jj_; hcur = *(const LAS v4u*)(hql + (jj_ * 64 + lane) * 4); } \
                       PE_COMPUTE_B(S, cc_, ii_, jj_, SG); } } while (0)
#ifdef PE_VALU3
#define PE_COMPUTE(S, entv) do { PE_COMPUTE_S(S, entv, 1.0f); PE_WAIT8(S, "vmcnt(16)"); PE_COMPUTE_S(S, entv, -1.0f); PE_WAIT8(S, "vmcnt(16)"); PE_COMPUTE_S(S, entv, 1.0f); } while (0)
#else
#define PE_COMPUTE(S, entv) PE_COMPUTE_S(S, entv, 1.0f)
#endif
    {
        unsigned er[PE_DEP];
#pragma unroll
        for (int q = 0; q < PE_DEP; ++q) { const v4u rec = *(const LAS v4u*)(ents + 4 * q); er[q] = __builtin_amdgcn_readfirstlane(rec.x); PE_ISSUE(q, rec); }
        f32x2 cur[8];
#pragma unroll
        for (int i = 0; i < 8; ++i) cur[i] = (f32x2){0.f, 0.f};
        int jcur = (int)((er[0] >> 14) & 3u);
        v4u hcur = *(const LAS v4u*)(hql + (jcur * 64 + lane) * 4);
        v4u nrec = *(const LAS v4u*)(ents + 4 * PE_DEP);
#pragma unroll 1
        for (int bi = 0; bi < nb; bi += PE_DEP) {
#pragma unroll
            for (int q = 0; q < PE_DEP; ++q) {
                PE_WAIT8(q, "vmcnt(16)");
                PE_COMPUTE(q, er[q]);
                er[q] = __builtin_amdgcn_readfirstlane(nrec.x);
                PE_ISSUE(q, nrec);
                nrec = *(const LAS v4u*)(ents + 4 * (bi + q + PE_DEP + 1));
            }
        }
#pragma unroll
        for (int q = 0; q < PE_DEP; ++q) PE_WAIT8(q, "vmcnt(0)");
        PE_FLUSH();
    }
#undef PE_COMPUTE
#undef PE_COMPUTE_S
#undef PE_COMPUTE_B
#undef PE_FLUSH
#undef PE_WAIT8
#undef PE_ISSUE
#undef PE_LDO
#undef PE_UDOTS
#undef PE_VDOTS
    asm volatile("v_mbcnt_lo_u32_b32 %0, -1, 0\n\tv_mbcnt_hi_u32_b32 %0, -1, %0" : "=v"(lane)); asm volatile("" : "+s"(tbase));
#pragma unroll
    for (int j = 0; j < PE_NT; ++j) {
        const int t = tbase + j;
        float ss = 0.f; f32x4 xo[4];
        { const v4u* xrow = (const v4u*)((const bf16*)(ws + WS_XB) + (size_t)t * 1024 + 16 * lane); const v4u xa = xrow[0], xc = xrow[1];
          xo[0] = (f32x4){bflo(xa.x), bfhi(xa.x), bflo(xa.y), bfhi(xa.y)}; xo[1] = (f32x4){bflo(xa.z), bfhi(xa.z), bflo(xa.w), bfhi(xa.w)};
          xo[2] = (f32x4){bflo(xc.x), bfhi(xc.x), bflo(xc.y), bfhi(xc.y)}; xo[3] = (f32x4){bflo(xc.z), bfhi(xc.z), bflo(xc.w), bfhi(xc.w)}; }
#pragma unroll
        for (int i = 0; i < 4; ++i) { xo[i].x += acc[j][2 * i].x; xo[i].y += acc[j][2 * i].y; xo[i].z += acc[j][2 * i + 1].x; xo[i].w += acc[j][2 * i + 1].y;
            ss += (xo[i].x * xo[i].x + xo[i].y * xo[i].y) + (xo[i].z * xo[i].z + xo[i].w * xo[i].w); }
        const float rstd3 = rsqrtf(wave_sum(ss) * (1.0f / 1024.0f) + 1e-6f);
        float* orow = dstbase + (size_t)t * 1024 + 16 * lane;
#pragma unroll
        for (int i = 0; i < 4; ++i) { const f32x4 w = ((const f32x4*)(P.norm_final_w + 16 * lane))[i];
            ((f32x4*)orow)[i] = (f32x4){xo[i].x * rstd3 * w.x, xo[i].y * rstd3 * w.y, xo[i].z * rstd3 * w.z, xo[i].w * rstd3 * w.w}; }
    }
    LDS_WAIT(); asm volatile("s_waitcnt vmcnt(0)" ::: "memory");
}


#ifndef TWICE_MASK
#define TWICE_MASK 0
#endif
struct TwiceOrder { pg8::StaticOrder S; int per, reps;
    __device__ bool next(int i, pg8::Unit& u) const { if (i >= per * reps) return false; return S.next(i % per, u); }
    __device__ __forceinline__ void a_ready(const pg8::Unit&) const {} __device__ __forceinline__ void done(const pg8::Unit&) const {} };
template <class B> __device__ __forceinline__ bool rep_again(volatile LAS unsigned* MISC, B& bar) {
    __syncthreads(); const unsigned c = MISC[20]; __syncthreads();
    if (threadIdx.x == 0) MISC[20] = c ^ 1u;
    __syncthreads();
    if (c == 0u) { xcd_barrier(bar); return true; }
    return false;
}
__global__ void __launch_bounds__(NWAVES * 64, 2) hybrid_fwd(Params P) {
    extern __shared__ __attribute__((aligned(16))) unsigned char lds_raw[];
    LAS unsigned char* lds = (LAS unsigned char*)lds_raw;
    volatile LAS unsigned* MISC = (volatile LAS unsigned*)(lds + MISC_OFF);
    const int tid = threadIdx.x, lane = tid & 63, wave = __builtin_amdgcn_readfirstlane(tid >> 6);
    const int G = gridDim.x, bx = blockIdx.x;
    const int vcu = (G % 8 == 0) ? (bx % 8) * (G / 8) + bx / 8 : bx;
    unsigned char* ws = P.ws;
    for (int u = tid; u < 64; u += NWAVES * 64) MISC[u] = 0u;
    __syncthreads();
    XcdBarrier bar; bar.bar = (unsigned*)(ws + WS_CTL) + CW_BAR; bar.x = 0; bar.st = nullptr;
    if (!MK_PER_PHASE) bar = xcd_barrier_post((unsigned*)(ws + WS_CTL) + CW_BAR, MISC + 8);
    const int lo = P.ph_lo, hi = P.ph_hi;
#ifndef PHASE_MASK
#define PHASE_MASK 0xFFF
#endif
#define IN(k) (((PHASE_MASK >> (k)) & 1) && lo <= (k) && (k) < hi)
#define SEAM(k) do { if (IN(k) && IN((k) + 1)) xcd_barrier(bar); } while (0)
#ifndef REP_MASK
#define REP_MASK 0
#endif
#ifndef PE_EXP_MASK
#define PE_EXP_MASK 0x3fff
#endif
#define REPS(k) for (bool again_ = true; again_; again_ = (((REP_MASK >> (k)) & 1) ? rep_again(MISC, bar) : false))
    using namespace pg8;
    bf16* XB = (bf16*)(ws + WS_XB);

    if (IN(0)) REPS(0) { p0_prologue(P, lds, tid, lane, wave, vcu, G); }
    SEAM(0);
    if (IN(1)) REPS(1) {
        { Gemm gm{XB, (const bf16_t*)(ws + WS_WIN), T, 3072, 1024}; StaticOrder S; S.init(T, 3072, G, bx);
          EpiBf16Rs E{(bf16_t*)(ws + WS_QKV), 1536, 6, (bf16_t*)(ws + WS_XR), 512, (size_t)T * 512, nullptr, 1.0f};
          gemm_phase<EpiBf16Rs, StaticOrder, PG8_ALIGN, PG8_SP2>(lds, gm, S, E); }
    }
    SEAM(1);
    if (IN(3)) REPS(3) {
        if (bx < SCAN_WGS) gdn_scan(P, lds, bx, tid, lane, wave);
        else {
            const int wk = bx - SCAN_WGS, NWK = G - SCAN_WGS;
            unsigned* lcnt = (unsigned*)(ws + WS_CTL) + CW_LRUCNT;
            for (int q = wk; q < 1024; q += NWK) gdn_local_item(P, lds, (q & 7) * 128 + (q >> 3), tid);
            unsigned ndone = 0;
            for (int lt = wk; lt < 256; lt += NWK) { lru_local_item(P, lds, lt, tid, lane, wave); ++ndone; }
            asm volatile("s_waitcnt vmcnt(0)" ::: "memory");
            __syncthreads();
            if (tid == 0 && ndone) { __builtin_amdgcn_fence(__ATOMIC_RELEASE, "agent"); asm volatile("s_waitcnt vmcnt(0)" ::: "memory");
                                     __hip_atomic_fetch_add(lcnt, ndone, __ATOMIC_RELAXED, __HIP_MEMORY_SCOPE_AGENT); }
            if (wk < 16) {
                struct OneUnit { int pm, pn; __device__ bool next(int i, Unit& u) const { if (i > 0) return false; u.pm = pm; u.pn = pn; return true; }
                                 __device__ void a_ready(const Unit&) const {} __device__ void done(const Unit&) const {} };
                Gemm gm{(const bf16_t*)(ws + WS_MEMN), (const bf16_t*)(ws + WS_WKV), 512, 2048, 1024}; OneUnit S{wk >> 3, wk & 7};
                EpiKV E{(bf16_t*)(ws + WS_KB), (bf16_t*)(ws + WS_VTP)};
                gemm_phase<EpiKV, OneUnit, PG8_ALIGN, PG8_SP2>(lds, gm, S, E);
            }
            if (wk == 16 || wk == 17) {
                if (tid == 0) { unsigned sp = 0;
                    while (__hip_atomic_load(lcnt, __ATOMIC_RELAXED, __HIP_MEMORY_SCOPE_AGENT) < 256u) { __builtin_amdgcn_s_sleep(8); if (++sp > (1u << 22)) break; }
                    __builtin_amdgcn_fence(__ATOMIC_ACQUIRE, "agent"); asm volatile("s_waitcnt vmcnt(0)" ::: "memory"); }
                __syncthreads();
                lru_carry(P, (wk - 16) * NWAVES + wave, lane);
                asm volatile("s_waitcnt vmcnt(0)" ::: "memory");
                __syncthreads();
                if (tid == 0) { __builtin_amdgcn_fence(__ATOMIC_RELEASE, "agent"); asm volatile("s_waitcnt vmcnt(0)" ::: "memory");
                                __hip_atomic_fetch_add(lcnt + 64, 1u, __ATOMIC_RELAXED, __HIP_MEMORY_SCOPE_AGENT); }
            } else {
                const int w2 = (wk < 16 ? wk : wk - 2), N2 = NWK - 2;
                cvt_table_fp8(P.peer_v, ws + WS_VB, (float*)(ws + WS_VSC), w2 * NWAVES + wave, N2 * NWAVES, lane);
                late_weight_prep(P, lds, lane, wave, w2 * NWAVES + wave, N2 * NWAVES);
                if (tid == 0) { unsigned sp = 0;
                    while (__hip_atomic_load(lcnt + 64, __ATOMIC_RELAXED, __HIP_MEMORY_SCOPE_AGENT) < 2u) { __builtin_amdgcn_s_sleep(8); if (++sp > (1u << 22)) break; }
                    __builtin_amdgcn_fence(__ATOMIC_ACQUIRE, "agent"); asm volatile("s_waitcnt vmcnt(0)" ::: "memory"); }
                __syncthreads();
                lru_combine(P, (size_t)w2 * (NWAVES * 64) + tid, (size_t)N2 * (NWAVES * 64));
            }
        }
    }
    SEAM(3);
    if (IN(4)) REPS(4) {
        gdn_gate_norm(P, (size_t)bx * (NWAVES * 64) + tid, (size_t)G * (NWAVES * 64));
        cvt_table_fp8(P.peer_u, ws + WS_UB, (float*)(ws + WS_USC), bx * NWAVES + wave, G * NWAVES, lane);
    }
    SEAM(4);
    if (IN(5)) {
        Gemm gm{(const bf16_t*)((const unsigned char*)P.out + OUT_Y), (const bf16_t*)(ws + WS_WOUT), T, 1024, 1024}; StaticOrder S; S.init(T, 1024, G, bx);
        EpiResidBf<true> E{P.x, XB, (float*)(ws + WS_SSQ1)};
        gemm_phase<EpiResidBf<true>, StaticOrder, PG8_ALIGN, PG8_SP2>(lds, gm, S, E);
    }
    SEAM(5);
    if (IN(6)) REPS(6) {
        Gemm gm{XB, (const bf16_t*)(ws + WS_WQ), T, 1024, 1024};
        EpiBf16Rs E{(bf16_t*)(ws + WS_Q), 1024, 4, nullptr, 256, 0, (const float*)(ws + WS_SSQ1), 0.0625f};
#if (TWICE_MASK >> 6) & 1
        { TwiceOrder S; S.S.init(T, 1024, G, bx); S.per = 1; S.reps = 2;
          gemm_phase<EpiBf16Rs, TwiceOrder, PG8_ALIGN, PG8_SP2>(lds, gm, S, E); }
#else
        { StaticOrder S; S.init(T, 1024, G, bx);
          gemm_phase<EpiBf16Rs, StaticOrder, PG8_ALIGN, PG8_SP2>(lds, gm, S, E); }
#endif
        Unit u;
        { const int wgid = (bx & 7) * 32 + (bx >> 3); u.pm = (wgid >> 5) * 8 + (wgid & 7); u.pn = (wgid & 31) >> 3; }
        if (G == 256) {
            asm volatile("s_waitcnt vmcnt(0)" ::: "memory");
            __syncthreads();
            const int b = u.pm >> 5, qb0 = (u.pm & 31) * 2, h = u.pn;
#pragma unroll 1
            for (int qq = 0; qq < (((TWICE_MASK >> 7) & 1) ? 4 : 2); qq += XA_NPS) xattn_unit(P, lds, (b << 8) | ((qb0 + (qq & 1)) << 2) | h, tid, lane, wave);
        }
    }
    if (IN(7)) REPS(7) { }
    SEAM(7);
    if (IN(8)) {
        Gemm gm{(const bf16_t*)(ws + WS_AO), (const bf16_t*)(ws + WS_WO), T, 1024, 1024}; StaticOrder S; S.init(T, 1024, G, bx);
        EpiResidBf<false> E{nullptr, XB, (float*)(ws + WS_SSQ2)};
        gemm_phase<EpiResidBf<false>, StaticOrder, PG8_ALIGN, PG8_SP2>(lds, gm, S, E);
    }
    SEAM(8);
    if (IN(9)) REPS(9) {
        Gemm gm{XB, (const bf16_t*)(ws + WS_PWQ), T, 2048, 1024};
        EpiF16Rs E{(_Float16*)(ws + WS_PQ), 2048, (const float*)(ws + WS_SSQ2)};
#if (TWICE_MASK >> 9) & 1
        TwiceOrder S; S.S.init(T, 2048, G, bx); S.per = 2; S.reps = 2;
        gemm_phase<EpiF16Rs, TwiceOrder, PG8_ALIGN, PG8_SP2>(lds, gm, S, E);
#else
        StaticOrder S; S.init(T, 2048, G, bx);
        gemm_phase<EpiF16Rs, StaticOrder, PG8_ALIGN, PG8_SP2>(lds, gm, S, E);
#endif
    }
    SEAM(9);
    if (IN(10)) REPS(10) {
    }
    if (IN(11)) REPS(11) {
#if (TWICE_MASK >> 11) & 1
        for (int it = 0; it < 4; ++it) { const int tb = (bx * NWAVES + wave) * PE_NT + (it >> 1) * (G * NWAVES * PE_NT); if (tb < T) peer_pass(P, lds, tb, lane, wave, P.out, (it & 1) ? 0x3fff : PE_EXP_MASK); }
#else
#ifndef PE_PASS_BARRIER
#define PE_PASS_BARRIER 0
#endif
        for (int tb = (bx * NWAVES + wave) * PE_NT, np = 0; tb < T; tb += G * NWAVES * PE_NT, ++np) {
            if (PE_PASS_BARRIER && np > 0 && (T % (G * NWAVES * PE_NT)) == 0) xcd_barrier(bar);
            peer_pass(P, lds, tb, lane, wave, P.out);
        }
#endif
    }
#undef IN
#undef SEAM
}

extern "C" void kernel_launch(void* const* d_in, const int* in_sizes, int n_in, void* d_out, int out_size, void* d_ws, size_t ws_size, hipStream_t stream) {
    static int grid = 0;
    if (grid == 0) {
        if (n_in != 27 || in_sizes[0] != T * D || out_size != T * D || ws_size < WS_END) {
            fprintf(stderr, "kernel_launch: unexpected shapes (n_in %d, in0 %d, out %d, ws %zu); nothing launched\n", n_in, n_in > 0 ? in_sizes[0] : -1, out_size, ws_size); grid = -1; return; }
        int dev = 0, cus = 0, per_cu = 0;
        if (hipGetDevice(&dev) != hipSuccess || hipDeviceGetAttribute(&cus, hipDeviceAttributeMultiprocessorCount, dev) != hipSuccess) { grid = -1; return; }
        if (hipFuncSetAttribute((const void*)hybrid_fwd, hipFuncAttributeMaxDynamicSharedMemorySize, LDS_BYTES) != hipSuccess) { fprintf(stderr, "kernel_launch: hipFuncSetAttribute failed\n"); grid = -1; return; }
        if (hipOccupancyMaxActiveBlocksPerMultiprocessor(&per_cu, (const void*)hybrid_fwd, NWAVES * 64, LDS_BYTES) != hipSuccess || per_cu < 1)
            fprintf(stderr, "kernel_launch: note: occupancy query reports %d workgroups per CU\n", per_cu);
        (void)hipGetLastError();
        grid = cus;
        if (grid != 256) fprintf(stderr, "kernel_launch: %d CUs (built for 256)\n", grid);
    }
    if (grid < 0) return;
    if (hipMemsetAsync((char*)d_ws + WS_CTL, 0, CTL_ZERO_BYTES, stream) != hipSuccess) { fprintf(stderr, "kernel_launch: hipMemsetAsync failed\n"); return; }
    Params p{};
    const float** pp = (const float**)&p;
    for (int i = 0; i < 27; ++i) pp[i] = (const float*)d_in[i];
    p.out = (float*)d_out; p.ws = (unsigned char*)d_ws;
#if MK_PER_PHASE
    for (int k = 0; k < N_PHASES; ++k) { p.ph_lo = k; p.ph_hi = k + 1; hipLaunchKernelGGL(hybrid_fwd, dim3(grid), dim3(NWAVES * 64), LDS_BYTES, stream, p); }
#else
    p.ph_lo = 0; p.ph_hi = N_PHASES;
    hipLaunchKernelGGL(hybrid_fwd, dim3(grid), dim3(NWAVES * 64), LDS_BYTES, stream, p);
#endif
    const hipError_t le = hipPeekAtLastError();
    if (le != hipSuccess) fprintf(stderr, "kernel_launch: launch failed: %s\n", hipGetErrorName(le));
}
```

```cpp
#include <hip/hip_runtime.h>
#include <cstdio>
#include <cstdint>
namespace pg8 {
#define PG8_LAS __attribute__((address_space(3)))
typedef unsigned short bf16_t;
typedef short bf16x8 __attribute__((ext_vector_type(8)));
typedef float f32x4 __attribute__((ext_vector_type(4)));
typedef unsigned u32x4 __attribute__((ext_vector_type(4)));
constexpr int BM = 256, BK = 64, HALF = 128, HTB = HALF * BK * 2  , STAGE_BYTES = 8 * HTB, NXCD = 8, WGM = 8;

__host__ __device__ __forceinline__ int lds_byte(int r, int c) { const int st = (r >> 4) * 2 + (c >> 5), rr = r & 15, cc = c & 31, ob = rr * 64 + cc * 2; return st * 1024 + (ob ^ (((ob >> 9) & 1) << 5)); }
__host__ __device__ __forceinline__ void stage_rc(int b, int& R, int& C) { const int st = b / 1024, sb = b % 1024, swz = sb ^ (((sb >> 9) & 1) << 5); R = (st >> 1) * 16 + swz / 64; C = (st & 1) * 32 + (swz % 64) / 2; }
__host__ __device__ __forceinline__ int perm32(int rho) { const int n = rho >> 4, i = rho & 15; return 8 * (i >> 2) + 4 * n + (i & 3); }

struct Unit { int pm, pn; };
struct Gemm { const bf16_t* A; const bf16_t* Bt; int M, N, K; };

struct StaticOrder {
    int nM, nN, nwg, G, c;
    __host__ __device__ void init(int M, int N, int G_, int c_) { nM = M / BM; nN = N / BM; nwg = nM * nN; G = G_; c = c_; }
    __host__ __device__ bool next(int i, Unit& u) const {
        const long L = (long)i * G + c; if (L >= nwg) return false;
        int wgid = (int)L; { const int q = nwg / NXCD, r = nwg % NXCD, xcd = wgid % NXCD, off = wgid / NXCD; wgid = (xcd < r ? xcd * (q + 1) : r * (q + 1) + (xcd - r) * q) + off; }
        const int nig = WGM * nN, gid = wgid / nig, fm = gid * WGM, gsz = (nM - fm) < WGM ? (nM - fm) : WGM;
        u.pm = fm + ((wgid % nig) % gsz); u.pn = (wgid % nig) / gsz; return true;
    }
    __device__ __forceinline__ void a_ready(const Unit&) const {}
    __device__ __forceinline__ void done(const Unit&) const {}
};

__device__ __forceinline__ unsigned cvt_pk_bf16(float lo, float hi) { unsigned r; asm volatile("v_cvt_pk_bf16_f32 %0, %1, %2" : "=v"(r) : "v"(lo), "v"(hi)); return r; }
template <class Epi, class Sched, bool ALIGN_EPI = false, bool SP2 = false>
__device__ __forceinline__ void gemm_phase(PG8_LAS unsigned char* lds, const Gemm g, const Sched& S, const Epi& E) {
    const int tid = threadIdx.x, wid = __builtin_amdgcn_readfirstlane(tid >> 6), lane = tid & 63, wr = wid >> 2, wc = wid & 3, fr = lane & 15, fq = lane >> 4;
    const int K = g.K, nt = K / BK;
    unsigned voffA[2], voffB[2];
#pragma unroll
    for (int i = 0; i < 2; ++i) { int R, C; stage_rc(tid * 16 + i * 8192, R, C); const int Rb = Epi::PERM ? ((R & ~31) + perm32(R & 31)) : R;
        voffA[i] = (unsigned)(R * K + C) * 2u; voffB[i] = (unsigned)(Rb * K + C) * 2u; }
    const size_t kstep = (size_t)(BK * 2);
    const size_t hstep = (size_t)HALF * K * 2;
    const size_t tstep = 2 * hstep;
    const unsigned ldsw = (unsigned)wid * 1024u;
    const int aoff = lds_byte(wr * 64 + fr, fq * 8), boff = lds_byte(wc * 32 + fr, fq * 8);
#define PG8_SA(b, h) (((b) * 2 + (h)) * HTB)
#define PG8_SB(b, h) ((4 + (b) * 2 + (h)) * HTB)
#define PG8_STAGE(bufoff, gbase, voff) do { _Pragma("unroll") for (int _i = 0; _i < 2; ++_i) \
        __builtin_amdgcn_global_load_lds((const unsigned*)((const char*)(gbase) + (voff)[_i]), (PG8_LAS unsigned*)(lds + (bufoff) + ldsw + _i * 8192), 16, 0, 0); } while (0)
#define PG8_LDA(dst, b, h) do { _Pragma("unroll") for (int m = 0; m < 4; ++m) _Pragma("unroll") for (int k = 0; k < 2; ++k) dst[m][k] = *(const PG8_LAS bf16x8*)(lds + PG8_SA(b, h) + aoff + m * 2048 + k * 1024); } while (0)
#define PG8_LDB(dst, b, h) do { _Pragma("unroll") for (int n = 0; n < 2; ++n) _Pragma("unroll") for (int k = 0; k < 2; ++k) dst[n][k] = *(const PG8_LAS bf16x8*)(lds + PG8_SB(b, h) + boff + n * 2048 + k * 1024); } while (0)
#define PG8_MMA(ai, bj, At, Bt) do { __builtin_amdgcn_s_setprio(1); _Pragma("unroll") for (int m = 0; m < 4; ++m) _Pragma("unroll") for (int n = 0; n < 2; ++n) _Pragma("unroll") for (int k = 0; k < 2; ++k) \
        acc[ai][bj][m][n] = __builtin_amdgcn_mfma_f32_16x16x32_bf16(Bt[n][k], At[m][k], acc[ai][bj][m][n], 0, 0, 0); __builtin_amdgcn_s_setprio(0); } while (0)
#define PG8_WAIT_V(n) asm volatile("s_waitcnt vmcnt(" #n ")" ::: "memory")
#define PG8_WAIT_L(n) asm volatile("s_waitcnt lgkmcnt(" #n ")" ::: "memory")
#define PG8_BAR __builtin_amdgcn_s_barrier()
#define PG8_SCHED __builtin_amdgcn_sched_barrier(0)
    Unit cur, nxt; int ui = 0;
    if (!S.next(0, cur)) return;
    f32x4 acc[2][2][4][2];
#pragma unroll
    for (int a = 0; a < 2; ++a)
#pragma unroll
        for (int b = 0; b < 2; ++b)
#pragma unroll
            for (int m = 0; m < 4; ++m)
#pragma unroll
                for (int n = 0; n < 2; ++n) acc[a][b][m][n] = (f32x4){0.f, 0.f, 0.f, 0.f};
    bf16x8 At[4][2], B0[2][2], B1[2][2];
    const char* cA = (const char*)g.A + (size_t)cur.pm * tstep; const char* cB = (const char*)g.Bt + (size_t)cur.pn * tstep;
    S.a_ready(cur);
    if constexpr (SP2) {
        PG8_STAGE(PG8_SB(0, 0), cB, voffB); PG8_STAGE(PG8_SB(0, 1), cB + hstep, voffB); PG8_STAGE(PG8_SA(0, 0), cA, voffA); PG8_STAGE(PG8_SA(0, 1), cA + hstep, voffA);
        if (wr == 1) PG8_BAR;
        PG8_WAIT_V(2); PG8_BAR;
        PG8_STAGE(PG8_SB(1, 0), cB + kstep, voffB); PG8_STAGE(PG8_SA(1, 0), cA + kstep, voffA); PG8_STAGE(PG8_SB(1, 1), cB + hstep + kstep, voffB);
        PG8_WAIT_V(6); PG8_BAR;
    } else {
        PG8_STAGE(PG8_SB(0, 0), cB, voffB); PG8_STAGE(PG8_SA(0, 0), cA, voffA); PG8_STAGE(PG8_SB(0, 1), cB + hstep, voffB); PG8_STAGE(PG8_SA(0, 1), cA + hstep, voffA);
        if (wr == 1) PG8_BAR;
        PG8_WAIT_V(4); PG8_BAR;
        PG8_STAGE(PG8_SB(1, 0), cB + kstep, voffB); PG8_STAGE(PG8_SA(1, 0), cA + kstep, voffA); PG8_STAGE(PG8_SB(1, 1), cB + hstep + kstep, voffB);
        PG8_WAIT_V(6); PG8_BAR;
    }
    for (;;) {
        const bool has_next = S.next(ui + 1, nxt);
        const char* nA = has_next ? (const char*)g.A + (size_t)nxt.pm * tstep : cA; const char* nB = has_next ? (const char*)g.Bt + (size_t)nxt.pn * tstep : cB;
        for (int t = 0; t < nt; t += 2) {
            const bool last = (t == nt - 2);
            const char* a1 = cA + (size_t)(t + 1) * kstep;
            const char* a2 = last ? nA : cA + (size_t)(t + 2) * kstep; const char* b2 = last ? nB : cB + (size_t)(t + 2) * kstep;
            const char* a3 = a2 + kstep; const char* b3 = b2 + kstep;
            if (last && has_next) S.a_ready(nxt);
            if constexpr (SP2) {
            PG8_LDB(B0, 0, 0); PG8_LDB(B1, 0, 1); PG8_SCHED; PG8_LDA(At, 0, 0); PG8_STAGE(PG8_SA(1, 1), a1 + hstep, voffA);
            PG8_WAIT_V(8); PG8_WAIT_L(0); PG8_BAR; PG8_MMA(0, 0, At, B0); PG8_MMA(0, 1, At, B1); PG8_BAR; PG8_SCHED;
            PG8_LDA(At, 0, 1); PG8_STAGE(PG8_SB(0, 0), b2, voffB); PG8_STAGE(PG8_SB(0, 1), b2 + hstep, voffB); PG8_STAGE(PG8_SA(0, 0), a2, voffA);
            PG8_WAIT_V(8); PG8_WAIT_L(0); PG8_BAR; PG8_MMA(1, 0, At, B0); PG8_MMA(1, 1, At, B1); PG8_BAR; PG8_SCHED;
            PG8_LDB(B0, 1, 0); PG8_LDB(B1, 1, 1); PG8_SCHED; PG8_LDA(At, 1, 0); PG8_STAGE(PG8_SA(0, 1), a2 + hstep, voffA);
            PG8_WAIT_V(8); PG8_WAIT_L(0); PG8_BAR; PG8_MMA(0, 0, At, B0); PG8_MMA(0, 1, At, B1); PG8_BAR; PG8_SCHED;
            PG8_LDA(At, 1, 1); PG8_STAGE(PG8_SB(1, 0), b3, voffB); PG8_STAGE(PG8_SB(1, 1), b3 + hstep, voffB); PG8_STAGE(PG8_SA(1, 0), a3, voffA);
            PG8_WAIT_V(8); PG8_WAIT_L(0); PG8_BAR; PG8_MMA(1, 0, At, B0); PG8_MMA(1, 1, At, B1); PG8_BAR; PG8_SCHED;
            } else {
            PG8_LDB(B0, 0, 0); PG8_SCHED; PG8_LDA(At, 0, 0); PG8_STAGE(PG8_SA(1, 1), a1 + hstep, voffA);
            PG8_WAIT_L(8); PG8_BAR; PG8_WAIT_L(0); PG8_MMA(0, 0, At, B0); PG8_BAR; PG8_SCHED;
            PG8_LDB(B1, 0, 1); PG8_STAGE(PG8_SB(0, 0), b2, voffB);
            PG8_BAR; PG8_WAIT_L(0); PG8_MMA(0, 1, At, B1); PG8_BAR;
            PG8_LDA(At, 0, 1); PG8_STAGE(PG8_SA(0, 0), a2, voffA);
            PG8_BAR; PG8_WAIT_L(0); PG8_MMA(1, 0, At, B0); PG8_BAR; PG8_SCHED;
            PG8_STAGE(PG8_SB(0, 1), b2 + hstep, voffB);
            PG8_WAIT_V(6); PG8_BAR; PG8_MMA(1, 1, At, B1); PG8_BAR;
            PG8_LDB(B0, 1, 0); PG8_SCHED; PG8_LDA(At, 1, 0); PG8_STAGE(PG8_SA(0, 1), a2 + hstep, voffA);
            PG8_WAIT_L(8); PG8_BAR; PG8_WAIT_L(0); PG8_MMA(0, 0, At, B0); PG8_BAR; PG8_SCHED;
            PG8_LDB(B1, 1, 1); PG8_STAGE(PG8_SB(1, 0), b3, voffB);
            PG8_BAR; PG8_WAIT_L(0); PG8_MMA(0, 1, At, B1); PG8_BAR;
            PG8_LDA(At, 1, 1); PG8_STAGE(PG8_SA(1, 0), a3, voffA);
            PG8_BAR; PG8_WAIT_L(0); PG8_MMA(1, 0, At, B0); PG8_BAR; PG8_SCHED;
            PG8_STAGE(PG8_SB(1, 1), b3 + hstep, voffB);
            PG8_WAIT_V(6); PG8_BAR; PG8_MMA(1, 1, At, B1); PG8_BAR;
            }
        }
        if constexpr (ALIGN_EPI) { if (wr == 0) PG8_BAR; }
        if constexpr (!Epi::AFTER_DRAIN) { E(acc, cur, wr, wc, fr, fq); S.done(cur); }
        if (!has_next) break;
#pragma unroll
        for (int a = 0; a < 2; ++a)
#pragma unroll
            for (int b = 0; b < 2; ++b)
#pragma unroll
                for (int m = 0; m < 4; ++m)
#pragma unroll
                    for (int n = 0; n < 2; ++n) acc[a][b][m][n] = (f32x4){0.f, 0.f, 0.f, 0.f};
        cur = nxt; cA = nA; cB = nB; ++ui;
        if constexpr (ALIGN_EPI) { if (wr == 1) PG8_BAR; }
    }
    PG8_WAIT_V(0);
    if constexpr (!ALIGN_EPI) { if (wr == 0) PG8_BAR; }
    PG8_BAR;
    if constexpr (Epi::AFTER_DRAIN) { E.fused(acc, cur, wr, wc, fr, fq, lds, wid, lane); S.done(cur); }
#undef PG8_SA
#undef PG8_SB
#undef PG8_STAGE
#undef PG8_LDA
#undef PG8_LDB
#undef PG8_MMA
#undef PG8_WAIT_V
#undef PG8_WAIT_L
#undef PG8_BAR
#undef PG8_SCHED
}
}

namespace pg8 {
__host__ __device__ __forceinline__ int permk(int kl) { return 8 * ((kl & 15) >> 2) + 4 * (kl >> 4) + (kl & 3); }
struct EpiBf16Rs {
    static constexpr bool PERM = true, AFTER_DRAIN = false;
    bf16_t* O0; int ld0; int ntile0; bf16_t* O1; int ld1; size_t stride1; const float* ssq; float cs;
    __device__ __forceinline__ void operator()(const f32x4 (&acc)[2][2][4][2], const Unit& u, int wr, int wc, int fr, int fq) const {
        bf16_t* base; int ld, colt;
        if (u.pn < ntile0) { base = O0; ld = ld0; colt = u.pn * BM; }
        else { const int q = u.pn - ntile0, per = ld1 / BM; base = O1 + (size_t)(q / per) * stride1; ld = ld1; colt = (q % per) * BM; }
        const int row0 = u.pm * BM + wr * 64 + fr, col0 = colt + wc * 32 + 8 * fq;
#pragma unroll
        for (int ai = 0; ai < 2; ++ai)
#pragma unroll
            for (int m = 0; m < 4; ++m) {
                const int row = row0 + ai * HALF + m * 16;
                float sc = cs; if (ssq) sc *= rsqrtf(ssq[row] * (1.0f / 1024.0f) + 1e-6f);
                bf16_t* rowp = base + (size_t)row * ld + col0;
#pragma unroll
                for (int bj = 0; bj < 2; ++bj) { const f32x4 v0 = acc[ai][bj][m][0] * sc, v1 = acc[ai][bj][m][1] * sc;
                    u32x4 w; w.x = cvt_pk_bf16(v0[0], v0[1]); w.y = cvt_pk_bf16(v0[2], v0[3]); w.z = cvt_pk_bf16(v1[0], v1[1]); w.w = cvt_pk_bf16(v1[2], v1[3]);
                    *(u32x4*)(rowp + bj * HALF) = w; } }
    }
};
struct EpiF16Rs {
    static constexpr bool PERM = true, AFTER_DRAIN = false;
    _Float16* O; int ld; const float* ssq;
    __device__ __forceinline__ void operator()(const f32x4 (&acc)[2][2][4][2], const Unit& u, int wr, int wc, int fr, int fq) const {
        typedef _Float16 f16x8 __attribute__((ext_vector_type(8)));
        const int row0 = u.pm * BM + wr * 64 + fr, col0 = u.pn * BM + wc * 32 + 8 * fq;
#pragma unroll
        for (int ai = 0; ai < 2; ++ai)
#pragma unroll
            for (int m = 0; m < 4; ++m) {
                const int row = row0 + ai * HALF + m * 16;
                const float sc = rsqrtf(ssq[row] * (1.0f / 1024.0f) + 1e-6f);
                _Float16* rowp = O + (size_t)row * ld + col0;
#pragma unroll
                for (int bj = 0; bj < 2; ++bj) { const f32x4 v0 = acc[ai][bj][m][0] * sc, v1 = acc[ai][bj][m][1] * sc;
                    f16x8 w; w[0] = (_Float16)v0[0]; w[1] = (_Float16)v0[1]; w[2] = (_Float16)v0[2]; w[3] = (_Float16)v0[3];
                    w[4] = (_Float16)v1[0]; w[5] = (_Float16)v1[1]; w[6] = (_Float16)v1[2]; w[7] = (_Float16)v1[3];
                    *(f16x8*)(rowp + bj * HALF) = w; } }
    }
};
template <bool BASE_F32> struct EpiResidBf {
    static constexpr bool PERM = true, AFTER_DRAIN = false;
    const float* basef; bf16_t* xb; float* ssq;
    __device__ __forceinline__ void operator()(const f32x4 (&acc)[2][2][4][2], const Unit& u, int wr, int wc, int fr, int fq) const {
        const int row0 = u.pm * BM + wr * 64 + fr, col0 = u.pn * BM + wc * 32 + 8 * fq;
#pragma unroll
        for (int ai = 0; ai < 2; ++ai)
#pragma unroll
            for (int m = 0; m < 4; ++m) {
                const int row = row0 + ai * HALF + m * 16; const size_t off = (size_t)row * 1024 + col0; float s = 0.f;
#pragma unroll
                for (int bj = 0; bj < 2; ++bj) { const size_t o2 = off + bj * HALF;
                    f32x4 b0, b1;
                    if (BASE_F32) { b0 = *(const f32x4*)(basef + o2); b1 = *(const f32x4*)(basef + o2 + 4); }
                    else { const u32x4 p = *(const u32x4*)(xb + o2);
                        b0 = (f32x4){__builtin_bit_cast(float, p.x << 16), __builtin_bit_cast(float, p.x & 0xffff0000u), __builtin_bit_cast(float, p.y << 16), __builtin_bit_cast(float, p.y & 0xffff0000u)};
                        b1 = (f32x4){__builtin_bit_cast(float, p.z << 16), __builtin_bit_cast(float, p.z & 0xffff0000u), __builtin_bit_cast(float, p.w << 16), __builtin_bit_cast(float, p.w & 0xffff0000u)}; }
                    const f32x4 o0 = b0 + acc[ai][bj][m][0], o1 = b1 + acc[ai][bj][m][1];
                    s += ((o0[0] * o0[0] + o0[1] * o0[1]) + (o0[2] * o0[2] + o0[3] * o0[3])) + ((o1[0] * o1[0] + o1[1] * o1[1]) + (o1[2] * o1[2] + o1[3] * o1[3]));
                    u32x4 w; w.x = cvt_pk_bf16(o0[0], o0[1]); w.y = cvt_pk_bf16(o0[2], o0[3]); w.z = cvt_pk_bf16(o1[0], o1[1]); w.w = cvt_pk_bf16(o1[2], o1[3]);
                    *(u32x4*)(xb + o2) = w; }
                s += __shfl_xor(s, 16); s += __shfl_xor(s, 32);
                if (fq == 0) atomicAdd(ssq + row, s);
            }
    }
};
struct EpiKV {
    static constexpr bool PERM = false, AFTER_DRAIN = false;
    bf16_t* Kb; bf16_t* VTp;
    __device__ __forceinline__ void operator()(const f32x4 (&acc)[2][2][4][2], const Unit& u, int wr, int wc, int fr, int fq) const {
        typedef unsigned u32x2v __attribute__((ext_vector_type(2)));
        const int row0 = u.pm * BM + wr * 64 + fr, col0 = u.pn * BM + wc * 32 + 4 * fq;
#pragma unroll
        for (int ai = 0; ai < 2; ++ai)
#pragma unroll
            for (int m = 0; m < 4; ++m) {
                const int row = row0 + ai * HALF + m * 16, b = row >> 8, key = row & 255;
#pragma unroll
                for (int bj = 0; bj < 2; ++bj)
#pragma unroll
                    for (int n = 0; n < 2; ++n) { const int col = col0 + bj * HALF + n * 16; const f32x4 v = acc[ai][bj][m][n];
                        const unsigned p01 = cvt_pk_bf16(v[0], v[1]), p23 = cvt_pk_bf16(v[2], v[3]);
                        if (col < 1024) { const int h = col >> 8, dh = col & 255; u32x2v w; w.x = p01; w.y = p23;
                            *(u32x2v*)(Kb + ((size_t)((b * 4 + h) * 256 + key)) * 256 + dh) = w; }
                        else { const int c2 = col - 1024, h = c2 >> 8, dv = c2 & 255, kp = (key & ~31) | permk(key & 31);
                            bf16_t* d = VTp + ((size_t)((b * 4 + h) * 256 + dv)) * 256 + kp;
                            d[0] = (bf16_t)(p01 & 0xffffu); d[256] = (bf16_t)(p01 >> 16); d[512] = (bf16_t)(p23 & 0xffffu); d[768] = (bf16_t)(p23 >> 16); } }
            }
    }
};
}
#ifndef PG8_SP2
#define PG8_SP2 true
#endif
#ifndef PG8_ALIGN
#define PG8_ALIGN true
#endif

constexpr int NWAVES = 8;
#ifndef MK_PER_PHASE
#define MK_PER_PHASE 0
#endif
constexpr int T = 16384, SEQ = 8192, D = 1024;
constexpr int N_PHASES = 12;

constexpr size_t MiB = 1u << 20, KiB = 1u << 10;
constexpr size_t WS_CTL = 0, CTL_ZERO_BYTES = 1 * MiB;
constexpr int CW_BAR = 4096;
constexpr size_t WS_SSQ1 = 64 * KiB, WS_SSQ2 = 128 * KiB;
constexpr size_t WS_AB = 1 * MiB;
constexpr size_t WS_HEND = WS_AB + 512 * KiB, WS_PEND = WS_HEND + 512 * KiB, WS_HIN = WS_PEND + 512 * KiB;
constexpr size_t WS_DEC = WS_HIN + 512 * KiB;
constexpr size_t WS_SUBK = 3 * MiB + 256 * KiB;
constexpr size_t WS_WIN = 4 * MiB, WS_WOUT = 10 * MiB, WS_WQ = 12 * MiB, WS_WKV = 14 * MiB, WS_WO = 18 * MiB, WS_PWQ = 20 * MiB;
constexpr size_t WS_MEMN = 24 * MiB, WS_KB = 25 * MiB, WS_VTP = 26 * MiB, WS_LRUWT = 27 * MiB, WS_USC = 27 * MiB + 256 * KiB, WS_VSC = 27 * MiB + 384 * KiB;
constexpr size_t WS_XB = 28 * MiB;
constexpr size_t WS_HLOC = 28 * MiB, WS_PCUM = 44 * MiB;
constexpr size_t WS_QKV = 60 * MiB;
constexpr size_t OUT_Y = 4 * MiB;
constexpr size_t OUT_END = OUT_Y + (size_t)16384 * 1024 * 2;
constexpr size_t WS_IDX = 60 * MiB, WS_GW = 68 * MiB;
constexpr size_t WS_UB = 60 * MiB;
constexpr size_t WS_XR = 108 * MiB, WS_Z = 124 * MiB, WS_GATE = 140 * MiB;
constexpr size_t WS_WN = 156 * MiB, WS_UF = 172 * MiB, WS_QD = 188 * MiB, WS_KD = 204 * MiB, WS_ATT = 220 * MiB;
constexpr size_t WS_VB = 228 * MiB;
constexpr size_t WS_Q = 188 * MiB, WS_AO = 124 * MiB;
constexpr size_t WS_PQ = 108 * MiB;
constexpr size_t WS_END = 244 * MiB;
constexpr int CW_GFLAG = 49152;
constexpr int CW_LRUCNT = 8192;
static_assert(WS_XR - WS_QKV == (size_t)T * 1536 * 2 && WS_Z - WS_XR == (size_t)T * 512 * 2 && WS_GATE - WS_Z == (size_t)T * 512 * 2, "in-proj outputs are contiguous");

constexpr int LDS_BYTES = 160 * 1024;
constexpr int MISC_OFF = 159 * 1024;

#define GAS __attribute__((address_space(1)))
#define LAS __attribute__((address_space(3)))
typedef unsigned short bf16;
typedef unsigned v4u __attribute__((ext_vector_type(4)));
typedef unsigned v2u __attribute__((ext_vector_type(2)));
typedef float f32x4 __attribute__((ext_vector_type(4)));
typedef short bf16x8 __attribute__((ext_vector_type(8)));
typedef GAS unsigned gu32;
#define LDS_WAIT() asm volatile("s_waitcnt lgkmcnt(0)" ::: "memory")
__device__ __forceinline__ void st16_wt(void* p, v4u v) { asm volatile("global_store_dwordx4 %0, %1, off sc0 sc1\n\ts_nop 1" :: "v"(p), "v"(v) : "memory"); }
__device__ __forceinline__ unsigned f2bf(float f) { unsigned u = __builtin_bit_cast(unsigned, f); return (u + 0x7fffu + ((u >> 16) & 1u)) >> 16; }
__device__ __forceinline__ unsigned pk2(float lo, float hi) { return f2bf(lo) | (f2bf(hi) << 16); }
__device__ __forceinline__ float bflo(unsigned u) { return __builtin_bit_cast(float, u << 16); }
__device__ __forceinline__ float bfhi(unsigned u) { return __builtin_bit_cast(float, u & 0xffff0000u); }
__device__ __forceinline__ float bf1(bf16 h) { return __builtin_bit_cast(float, (unsigned)h << 16); }
__device__ __forceinline__ float wave_sum(float v) {
#pragma unroll
    for (int o = 1; o < 64; o <<= 1) v += __shfl_xor(v, o);
    return v;
}
__device__ __forceinline__ float row16_sum(float v) {
    v += __builtin_bit_cast(float, __builtin_amdgcn_update_dpp(0, __builtin_bit_cast(int, v), 0xB1, 0xF, 0xF, true));
    v += __builtin_bit_cast(float, __builtin_amdgcn_update_dpp(0, __builtin_bit_cast(int, v), 0x4E, 0xF, 0xF, true));
    v += __builtin_bit_cast(float, __builtin_amdgcn_update_dpp(0, __builtin_bit_cast(int, v), 0x141, 0xF, 0xF, true));
    v += __builtin_bit_cast(float, __builtin_amdgcn_update_dpp(0, __builtin_bit_cast(int, v), 0x140, 0xF, 0xF, true));
    return v;
}
__device__ __forceinline__ float sigmoidf_(float x) { return __builtin_amdgcn_rcpf(1.0f + __expf(-x)); }
__device__ __forceinline__ float softplusf_(float x) { return fmaxf(x, 0.f) + log1pf(__expf(-fabsf(x))); }
__device__ __forceinline__ float siluf_(float x) { return x * __builtin_amdgcn_rcpf(1.0f + __expf(-x)); }
__device__ __forceinline__ float gelu_tanh(float x) { const float y = 0.7978845608028654f * (x + 0.044715f * x * x * x); const float e = __expf(2.0f * y); return x * (1.0f - __builtin_amdgcn_rcpf(1.0f + e)); }
__device__ __forceinline__ int permk(int kl) { return 8 * ((kl & 15) >> 2) + 4 * (kl >> 4) + (kl & 3); }

struct Params {
    const float *x, *mem, *norm_mix_w, *w_in, *conv_qkv_w, *gdn_a_log, *gdn_dt_bias, *gdn_norm_w, *lru_conv_w, *lru_conv_b, *lru_wa, *lru_ba, *lru_wx, *lru_bx, *lru_lambda, *w_out,
                *norm_xattn_w, *norm_mem_w, *xattn_wq, *xattn_wkv, *xattn_wo, *norm_ffn_w, *peer_wq, *peer_subkeys, *peer_u, *peer_v, *norm_final_w;
    float* out; unsigned char* ws; int ph_lo, ph_hi;
};
#define XB_TMO      128
#define XB_XCNT(j)  (256  + 64 * (j))
#define XB_XSUB(j)  (1280 + 64 * (j))
#define XB_XGEN(j)  (2304 + 64 * (j))
#define XB_TOP      3328
#define XB_TOPGEN   3392
#define XCD_BAR_WORDS 3456
#define XB_SPIN_CAP (1u << 18)

__device__ __forceinline__ unsigned xb_ld(unsigned* p)              { return __hip_atomic_load(p, __ATOMIC_RELAXED, __HIP_MEMORY_SCOPE_AGENT); }
__device__ __forceinline__ unsigned xb_add(unsigned* p, unsigned v) { return __hip_atomic_fetch_add(p, v, __ATOMIC_RELAXED, __HIP_MEMORY_SCOPE_AGENT); }
__device__ __forceinline__ unsigned xb_xcc_id() { return (unsigned)__builtin_amdgcn_s_getreg((3 << 11) | 20) & 0xFu; }
#define XB_SPIN(cond, bar) do { unsigned _sp = 0; while (cond) { __builtin_amdgcn_s_sleep(1); \
    if ((++_sp & 255u) == 0u) { if (xb_ld(&(bar)[XB_TMO])) break; if (_sp > XB_SPIN_CAP) { atomicAdd(&(bar)[XB_TMO], 1u); break; } } } } while (0)

struct XcdBarrier {
    unsigned* bar; unsigned x;
    volatile LAS unsigned* st;
};

__device__ __forceinline__ XcdBarrier xcd_barrier_post(unsigned* bar, volatile LAS unsigned* st) {
    XcdBarrier b; b.bar = bar; b.x = xb_xcc_id(); b.st = st;
    if (threadIdx.x == 0) (void)xb_add(&bar[XB_XCNT(b.x)], 1u);
    return b;
}
__device__ __forceinline__ void xcd_barrier_complete(unsigned* bar, unsigned x, unsigned& nloc, unsigned& nx) {
    const unsigned G = gridDim.x * gridDim.y * gridDim.z;
    unsigned sum, cnt, mine, sp = 0u;
    for (;;) {
        sum = 0u; cnt = 0u; mine = 0u;
#pragma unroll
        for (unsigned j = 0; j < 16; ++j) { const unsigned c = xb_ld(&bar[XB_XCNT(j)]); sum += c; cnt += (c > 0u) ? 1u : 0u; mine = (j == x) ? c : mine; }
        if (sum == G) break;
        __builtin_amdgcn_s_sleep(1);
        if ((++sp & 255u) == 0u) { if (xb_ld(&bar[XB_TMO])) break; if (sp > XB_SPIN_CAP) { atomicAdd(&bar[XB_TMO], 1u); break; } }
    }
    nloc = mine > 0u ? mine : 1u; nx = cnt > 0u ? cnt : 1u;
}

__device__ __forceinline__ void xcd_barrier(const XcdBarrier& b) {
    asm volatile("s_waitcnt vmcnt(0)" ::: "memory");
    __syncthreads();
    if (threadIdx.x == 0) {
        unsigned* bar = b.bar;
        __builtin_amdgcn_s_waitcnt(0);
        unsigned nloc = b.st[0], nx = b.st[1];
        if (nloc == 0u) { xcd_barrier_complete(bar, b.x, nloc, nx); b.st[0] = nloc; b.st[1] = nx; }
        const unsigned old = xb_add(&bar[XB_XSUB(b.x)], 1u);
        const unsigned gen = old / nloc;
        if (old + 1u == (gen + 1u) * nloc) {
            __builtin_amdgcn_fence(__ATOMIC_RELEASE, "agent");
            asm volatile("s_waitcnt vmcnt(0)" ::: "memory");
            const unsigned og = xb_add(&bar[XB_TOP], 1u);
            const unsigned tg = og / nx;
            if (og + 1u == (tg + 1u) * nx) xb_add(&bar[XB_TOPGEN], 1u);
            else XB_SPIN(xb_ld(&bar[XB_TOPGEN]) == tg, bar);
            __builtin_amdgcn_fence(__ATOMIC_ACQUIRE, "agent");
            xb_add(&bar[XB_XGEN(b.x)], 1u);
            asm volatile("s_waitcnt vmcnt(0)" ::: "memory");
        } else {
            XB_SPIN(xb_ld(&bar[XB_XGEN(b.x)]) == gen, bar);
            __builtin_amdgcn_fence(__ATOMIC_ACQUIRE, "agent");
            asm volatile("s_waitcnt vmcnt(0)" ::: "memory");
        }
    }
    __syncthreads();
}

__device__ __forceinline__ void p0_transpose_item(const float* W, int K, int ldw, int c0, int nblk, bf16* WT, int row_off, const float* ks, LAS float* scr, int item, int lane) {
    const int kb = item / nblk, nb = item % nblk, k0 = 64 * kb, n0 = 32 * nb;
#pragma unroll 8
    for (int i = 0; i < 32; ++i) { const int kk = 2 * i + (lane >> 5); float v = W[(size_t)(k0 + kk) * ldw + c0 + n0 + (lane & 31)]; if (ks) v *= ks[k0 + kk]; scr[kk * 33 + (lane & 31)] = v; }
    LDS_WAIT(); asm volatile("" ::: "memory");
    const int c = lane & 7;
#pragma unroll
    for (int j = 0; j < 4; ++j) { const int n = (lane >> 3) + 8 * j; const LAS float* s = scr + (8 * c) * 33 + n;
        v4u o; o.x = pk2(s[0 * 33], s[1 * 33]); o.y = pk2(s[2 * 33], s[3 * 33]); o.z = pk2(s[4 * 33], s[5 * 33]); o.w = pk2(s[6 * 33], s[7 * 33]);
        *(GAS v4u*)(WT + (size_t)(row_off + n0 + n) * K + k0 + 8 * c) = o; }
    LDS_WAIT(); asm volatile("" ::: "memory");
}

__device__ __forceinline__ void p0_prologue(const Params& P, LAS unsigned char* lds, int tid, int lane, int wave, int vcu, int G) {
    unsigned char* ws = P.ws;
    const int gw = vcu * NWAVES + wave, NGW = G * NWAVES;
    LAS float* wabl = (LAS float*)lds;
    for (int idx = tid; idx < 8192; idx += NWAVES * 64) { const int k = idx >> 3, c = idx & 7, j = k >> 8, l = (k >> 2) & 63, e = k & 3;
        wabl[((((j * 4 + e) * 2 + (c >> 2)) * 64 + l) << 2) + (c & 3)] = P.w_in[(size_t)k * 3080 + 2048 + c]; }
    __syncthreads();
    {
        bf16* XB0 = (bf16*)(ws + WS_XB); float* AB = (float*)(ws + WS_AB);
        f32x4 w4[4];
#pragma unroll
        for (int j = 0; j < 4; ++j) w4[j] = ((const f32x4*)P.norm_mix_w)[64 * j + lane];
        for (int m = gw; m < T; m += NGW) {
            const f32x4* xr = (const f32x4*)(P.x + (size_t)m * D) + lane;
            f32x4 v[4]; float s = 0.f;
#pragma unroll
            for (int j = 0; j < 4; ++j) { v[j] = xr[64 * j]; s += (v[j].x * v[j].x + v[j].y * v[j].y) + (v[j].z * v[j].z + v[j].w * v[j].w); }
            const float rstd = rsqrtf(wave_sum(s) * (1.0f / D) + 1e-6f);
            v2u* o8 = (v2u*)(XB0 + (size_t)m * D) + lane;
            float part[8];
#pragma unroll
            for (int c = 0; c < 8; ++c) part[c] = 0.f;
#pragma unroll
            for (int j = 0; j < 4; ++j) {
                v[j] = v[j] * rstd * w4[j];
                v2u o; o.x = pk2(v[j].x, v[j].y); o.y = pk2(v[j].z, v[j].w); o8[64 * j] = o;
#pragma unroll
                for (int e = 0; e < 4; ++e) {
                    const f32x4 wa = *(const LAS f32x4*)(wabl + ((((j * 4 + e) * 2 + 0) * 64 + lane) << 2));
                    const f32x4 wb = *(const LAS f32x4*)(wabl + ((((j * 4 + e) * 2 + 1) * 64 + lane) << 2));
                    const float hv = v[j][e];
                    part[0] += hv * wa.x; part[1] += hv * wa.y; part[2] += hv * wa.z; part[3] += hv * wa.w;
                    part[4] += hv * wb.x; part[5] += hv * wb.y; part[6] += hv * wb.z; part[7] += hv * wb.w;
                }
            }
#pragma unroll
            for (int c = 0; c < 8; ++c) part[c] = wave_sum(part[c]);
            float o = part[0];
#pragma unroll
            for (int c = 1; c < 8; ++c) o = (lane == c) ? part[c] : o;
            if (lane < 8) AB[(size_t)m * 8 + lane] = o;
        }
    }
    {
        bf16* MEMN = (bf16*)(ws + WS_MEMN);
        for (int m = gw; m < 512; m += NGW) {
            const f32x4* xr = (const f32x4*)(P.mem + (size_t)m * D) + lane;
            f32x4 v[4]; float s = 0.f;
#pragma unroll
            for (int j = 0; j < 4; ++j) { v[j] = xr[64 * j]; s += (v[j].x * v[j].x + v[j].y * v[j].y) + (v[j].z * v[j].z + v[j].w * v[j].w); }
            const float rstd = rsqrtf(wave_sum(s) * (1.0f / D) + 1e-6f);
            v2u* o8 = (v2u*)(MEMN + (size_t)m * D) + lane;
#pragma unroll
            for (int j = 0; j < 4; ++j) { const f32x4 w = ((const f32x4*)P.norm_mem_w)[64 * j + lane]; const f32x4 y = v[j] * rstd * w;
                v2u o; o.x = pk2(y.x, y.y); o.y = pk2(y.z, y.w); o8[64 * j] = o; }
        }
    }
    __syncthreads();
    {
        LAS float* scr = (LAS float*)(lds + wave * 16384);
        constexpr int I_IN1 = 16 * 48, I_IN2 = 16 * 16, I_KV = 16 * 64;
        constexpr int NITEMS = I_IN1 + 3 * I_IN2 + I_KV;
        for (int it = gw; it < NITEMS; it += NGW) {
            int r = it;
            if (r < I_IN1) { p0_transpose_item(P.w_in, 1024, 3080, 0, 48, (bf16*)(ws + WS_WIN), 0, nullptr, scr, r, lane); continue; } r -= I_IN1;
            if (r < I_IN2) { p0_transpose_item(P.w_in, 1024, 3080, 2056, 16, (bf16*)(ws + WS_WIN), 1536, nullptr, scr, r, lane); continue; } r -= I_IN2;
            if (r < I_IN2) { p0_transpose_item(P.w_in, 1024, 3080, 1536, 16, (bf16*)(ws + WS_WIN), 2048, nullptr, scr, r, lane); continue; } r -= I_IN2;
            if (r < I_IN2) { p0_transpose_item(P.w_in, 1024, 3080, 2568, 16, (bf16*)(ws + WS_WIN), 2560, nullptr, scr, r, lane); continue; } r -= I_IN2;
            p0_transpose_item(P.xattn_wkv, 1024, 2048, 0, 64, (bf16*)(ws + WS_WKV), 0, nullptr, scr, r, lane);
        }
    }
    {
        bf16* WT = (bf16*)(ws + WS_LRUWT);
        for (int it = vcu * NWAVES * 64 + tid; it < 8 * 2 * 64 * 8; it += G * NWAVES * 64) {
            const int i8 = it & 7, j = (it >> 3) & 63, m = (it >> 9) & 1, g = it >> 10;
            const float* src = (m ? P.lru_wx : P.lru_wa) + (size_t)(g * 64 + 8 * i8) * 64 + j;
            v4u o; o.x = pk2(src[0], src[64]); o.y = pk2(src[128], src[192]); o.z = pk2(src[256], src[320]); o.w = pk2(src[384], src[448]);
            *(v4u*)(WT + (size_t)it * 8) = o;
        }
    }
}

__device__ __forceinline__ void late_weight_prep(const Params& P, LAS unsigned char* lds, int lane, int wave, int gw, int NGW) {
    unsigned char* ws = P.ws;
    {
        LAS float* scr = (LAS float*)(lds + wave * 16384);
        constexpr int I_OUT = 16 * 32, I_Q = 16 * 32, I_O = 16 * 32;
        for (int it = gw; it < I_OUT + I_Q + I_O; it += NGW) {
            int r = it;
            if (r < I_OUT) { p0_transpose_item(P.w_out, 1024, 1024, 0, 32, (bf16*)(ws + WS_WOUT), 0, nullptr, scr, r, lane); continue; } r -= I_OUT;
            if (r < I_Q) { p0_transpose_item(P.xattn_wq, 1024, 1024, 0, 32, (bf16*)(ws + WS_WQ), 0, P.norm_xattn_w, scr, r, lane); continue; } r -= I_Q;
            p0_transpose_item(P.xattn_wo, 1024, 1024, 0, 32, (bf16*)(ws + WS_WO), 0, nullptr, scr, r, lane);
        }
    }
    {
        bf16* WF = (bf16*)(ws + WS_PWQ);
        const int col = lane & 15, g = lane >> 4;
        for (int it = gw; it < 16 * 64; it += NGW) {
            const int hp = it >> 6, k0 = (it & 63) * 16;
            bf16x8 bq[4];
#pragma unroll
            for (int s = 0; s < 4; ++s) { const f32x4* src = (const f32x4*)(P.peer_wq + (size_t)(k0 + col) * 2048 + hp * 128 + 32 * s + 8 * g);
                const f32x4 a = src[0], c = src[1]; v4u pk; pk.x = pk2(a.x, a.y); pk.y = pk2(a.z, a.w); pk.z = pk2(c.x, c.y); pk.w = pk2(c.z, c.w); bq[s] = __builtin_bit_cast(bf16x8, pk); }
            const float nw = P.norm_ffn_w[k0 + col];
#pragma unroll 2
            for (int kt = 0; kt < 8; ++kt) {
                f32x4 acc = (f32x4){0.f, 0.f, 0.f, 0.f};
#pragma unroll
                for (int s = 0; s < 4; ++s) { const f32x4* src = (const f32x4*)(P.peer_subkeys + (size_t)(hp * 128 + 16 * kt + col) * 128 + 32 * s + 8 * g);
                    const f32x4 a = src[0], c = src[1]; v4u pk; pk.x = pk2(a.x, a.y); pk.y = pk2(a.z, a.w); pk.z = pk2(c.x, c.y); pk.w = pk2(c.z, c.w);
                    acc = __builtin_amdgcn_mfma_f32_16x16x32_bf16(__builtin_bit_cast(bf16x8, pk), bq[s], acc, 0, 0, 0); }
#pragma unroll
                for (int i = 0; i < 4; ++i) WF[(size_t)(hp * 128 + 16 * kt + 4 * g + i) * 1024 + k0 + col] = (bf16)f2bf(acc[i] * nw);
            }
        }
    }
}

constexpr int GL_KS = 0, GL_VS = 33792, GL_KB = 67584, GL_QB = 84992, GL_RAW = 102400, GL_CW = 153856, GL_AMT = 133120, GL_SM = 160000, GL_ATT = 151808, GL_SOL = 67584;
static_assert(GL_CW + 6144 <= GL_SM && GL_SM + 1284 <= MISC_OFF && GL_SOL + 65536 <= GL_AMT && GL_AMT + 17408 <= GL_ATT && GL_ATT + 8192 <= GL_SM && GL_RAW + 51456 <= GL_CW, "gdn_local LDS map");
#ifndef GL_REP_STEP
#define GL_REP_STEP -1
#endif
#define GL_REPF(k) for (int rr_ = 0; rr_ < ((GL_REP_STEP == (k)) ? 2 : 1); ++rr_)
#define GL_BAR() do { asm volatile("s_waitcnt lgkmcnt(0)" ::: "memory"); __builtin_amdgcn_s_barrier(); asm volatile("" ::: "memory"); } while (0)
__device__ __forceinline__ void gdn_local_item(const Params& P, LAS unsigned char* lds, int item, int tid) {
    unsigned char* ws = P.ws;
    asm volatile("" : "+v"(tid));
    const int b = item >> 9, h = (item >> 7) & 3, n = item & 127;
    const int t0 = b * SEQ + n * 64;
    const int lane = tid & 63, wave = __builtin_amdgcn_readfirstlane(tid >> 6);
    LAS float* ks = (LAS float*)(lds + GL_KS);
    LAS float* vs = (LAS float*)(lds + GL_VS);
    LAS bf16* kb16 = (LAS bf16*)(lds + GL_KB);
    LAS bf16* qb16 = (LAS bf16*)(lds + GL_QB);
    LAS bf16* raw = (LAS bf16*)(lds + GL_RAW);
    LAS float* cw = (LAS float*)(lds + GL_CW);
    LAS float* AmT = (LAS float*)(lds + GL_AMT);
    LAS float* sg = (LAS float*)(lds + GL_SM);
    LAS float* sbeta = sg + 64; LAS float* sgc = sbeta + 64; LAS float* seg = sgc + 64; LAS float* sek = seg + 64;
    LAS bf16* atts = (LAS bf16*)(lds + GL_ATT);
    const bf16* QKV = (const bf16*)(ws + WS_QKV);
    const float* AB = (const float*)(ws + WS_AB);
    GL_REPF(0) {
        v4u pr[7];
#pragma unroll
        for (int r = 0; r < 7; ++r) {
            const int id = tid + 512 * r;
            const int row = id / 48, rem = id - row * 48, part = rem >> 4, ck = rem & 15, s = n * 64 + row - 3;
            pr[r] = (v4u){0u, 0u, 0u, 0u};
            if (id < 67 * 48 && s >= 0) pr[r] = *(const v4u*)(QKV + (size_t)(b * SEQ + s) * 1536 + part * 512 + h * 128 + ck * 8);
        }
        f32x4 cwv = (f32x4){0.f, 0.f, 0.f, 0.f};
        if (tid < 384) { const int j = tid / 96, rem = tid - j * 96, part = rem >> 5, c4 = rem & 31; cwv = *(const f32x4*)(P.conv_qkv_w + j * 1536 + part * 512 + h * 128 + c4 * 4); }
        float a_in = 0.f, b_in = 0.f;
        if (tid < 64) { a_in = AB[(size_t)(t0 + tid) * 8 + h]; b_in = AB[(size_t)(t0 + tid) * 8 + 4 + h]; }
#pragma unroll
        for (int r = 0; r < 7; ++r) { const int id = tid + 512 * r; if (id < 67 * 48) *(LAS v4u*)(raw + id * 8) = pr[r]; }
        if (tid < 384) *(LAS f32x4*)(cw + tid * 4) = cwv;
        if (tid < 64) { sg[tid] = -__expf(P.gdn_a_log[h]) * softplusf_(a_in + P.gdn_dt_bias[h]); sbeta[tid] = sigmoidf_(b_in); }
    }
    GL_BAR();
    GL_REPF(1) {
        const int c = tid >> 3, grp = tid & 7;
#pragma unroll 1
        for (int part = 0; part < 3; ++part) {
            float y[16];
#pragma unroll
            for (int i = 0; i < 16; ++i) y[i] = 0.f;
#pragma unroll
            for (int j = 0; j < 4; ++j) {
                const LAS v4u* src = (const LAS v4u*)(raw + (c + j) * 384 + part * 128 + grp * 16);
                const v4u x0 = src[0], x1 = src[1];
                const LAS f32x4* wp = (const LAS f32x4*)(cw + (j * 3 + part) * 128 + grp * 16);
                const f32x4 w0 = wp[0], w1 = wp[1], w2 = wp[2], w3 = wp[3];
                y[0] += w0.x * bflo(x0.x); y[1] += w0.y * bfhi(x0.x); y[2] += w0.z * bflo(x0.y); y[3] += w0.w * bfhi(x0.y);
                y[4] += w1.x * bflo(x0.z); y[5] += w1.y * bfhi(x0.z); y[6] += w1.z * bflo(x0.w); y[7] += w1.w * bfhi(x0.w);
                y[8] += w2.x * bflo(x1.x); y[9] += w2.y * bfhi(x1.x); y[10] += w2.z * bflo(x1.y); y[11] += w2.w * bfhi(x1.y);
                y[12] += w3.x * bflo(x1.z); y[13] += w3.y * bfhi(x1.z); y[14] += w3.z * bflo(x1.w); y[15] += w3.w * bfhi(x1.w);
            }
            float ss = 0.f;
#pragma unroll
            for (int i = 0; i < 16; ++i) { y[i] = siluf_(y[i]); ss += y[i] * y[i]; }
            if (part < 2) {
                ss += __shfl_xor(ss, 1); ss += __shfl_xor(ss, 2); ss += __shfl_xor(ss, 4);
                const float sc = rsqrtf(ss + 1e-6f) * (part == 0 ? 0.08838834764831845f : 1.0f);
#pragma unroll
                for (int i = 0; i < 16; ++i) y[i] *= sc;
            }
            if (part >= 1) {
                LAS float* dst = (part == 1 ? ks : vs) + c * 132 + grp * 16;
#pragma unroll
                for (int i = 0; i < 4; ++i) *(LAS f32x4*)(dst + 4 * i) = (f32x4){y[4 * i], y[4 * i + 1], y[4 * i + 2], y[4 * i + 3]};
            }
            if (part <= 1) {
                LAS bf16* dst = (part == 0 ? qb16 : kb16) + c * 136 + grp * 16;
                v4u o0, o1; o0.x = pk2(y[0], y[1]); o0.y = pk2(y[2], y[3]); o0.z = pk2(y[4], y[5]); o0.w = pk2(y[6], y[7]);
                o1.x = pk2(y[8], y[9]); o1.y = pk2(y[10], y[11]); o1.z = pk2(y[12], y[13]); o1.w = pk2(y[14], y[15]);
                *(LAS v4u*)dst = o0; *(LAS v4u*)(dst + 8) = o1;
            }
        }
    }
    if (tid < 64) {
        float v = sg[tid];
#pragma unroll
        for (int off = 1; off < 64; off <<= 1) { const float t = __shfl_up(v, off); if (tid >= off) v += t; }
        sgc[tid] = v; seg[tid] = __expf(v);
        const float gl = __shfl(v, 63);
        sek[tid] = __expf(gl - v);
        if (tid == 63) sek[64] = __expf(v);
    }
    GL_BAR();
    {
        const int mat = wave >> 2, rho = wave & 3, col = lane & 15, g = lane >> 4;
        const LAS bf16* X = mat ? qb16 : kb16;
        bf16x8 af[4];
#pragma unroll
        for (int s = 0; s < 4; ++s) af[s] = *(const LAS bf16x8*)(X + (16 * rho + col) * 136 + 32 * s + 8 * g);
#pragma unroll
        for (int sig = 0; sig < 4; ++sig) {
            f32x4 acc = (f32x4){0.f, 0.f, 0.f, 0.f};
#pragma unroll
            for (int s = 0; s < 4; ++s) { const bf16x8 bfr = *(const LAS bf16x8*)(kb16 + (16 * sig + col) * 136 + 32 * s + 8 * g); acc = __builtin_amdgcn_mfma_f32_16x16x32_bf16(af[s], bfr, acc, 0, 0, 0); }
            const int sidx = 16 * sig + col; const float gs = sgc[sidx];
#pragma unroll
            for (int i = 0; i < 4; ++i) {
                const int c = 16 * rho + 4 * g + i;
                const float dec = (c >= sidx) ? __expf(sgc[c] - gs) : 0.f;
                if (mat == 0) AmT[sidx * 68 + c] = (c > sidx) ? sbeta[c] * acc[i] * dec : 0.f;
                else atts[c * 64 + sidx] = (bf16)f2bf(acc[i] * dec);
            }
        }
    }
    GL_BAR();
    GL_REPF(4) {
        bf16* QD = (bf16*)(ws + WS_QD) + (size_t)item * 8192;
        bf16* KD = (bf16*)(ws + WS_KD) + (size_t)item * 8192;
        bf16* ATT = (bf16*)(ws + WS_ATT) + (size_t)item * 4096;
#pragma unroll
        for (int r = 0; r < 2; ++r) {
            const int id = tid + 512 * r;
            { const int c = id >> 4, gam = id & 15, s32 = gam >> 2, g = gam & 3;
              const v2u lo = *(const LAS v2u*)(qb16 + c * 136 + 32 * s32 + 4 * g), hi = *(const LAS v2u*)(qb16 + c * 136 + 32 * s32 + 16 + 4 * g);
              const float e = seg[c];
              v4u o; o.x = pk2(bflo(lo.x) * e, bfhi(lo.x) * e); o.y = pk2(bflo(lo.y) * e, bfhi(lo.y) * e); o.z = pk2(bflo(hi.x) * e, bfhi(hi.x) * e); o.w = pk2(bflo(hi.y) * e, bfhi(hi.y) * e);
              st16_wt(QD + c * 128 + 8 * gam, o); }
            { const int dk = id >> 3, gam = id & 7, s32 = gam >> 2, g = gam & 3, c0 = 32 * s32 + 4 * g;
              float v[8];
#pragma unroll
              for (int j = 0; j < 4; ++j) { v[j] = ks[(c0 + j) * 132 + dk] * sek[c0 + j]; v[4 + j] = ks[(c0 + 16 + j) * 132 + dk] * sek[c0 + 16 + j]; }
              v4u o; o.x = pk2(v[0], v[1]); o.y = pk2(v[2], v[3]); o.z = pk2(v[4], v[5]); o.w = pk2(v[6], v[7]);
              st16_wt(KD + dk * 64 + 8 * gam, o); }
        }
        { const int c = tid >> 3, gam = tid & 7, s32 = gam >> 2, g = gam & 3;
          const v2u lo = *(const LAS v2u*)(atts + c * 64 + 32 * s32 + 4 * g), hi = *(const LAS v2u*)(atts + c * 64 + 32 * s32 + 16 + 4 * g);
          v4u o; o.x = lo.x; o.y = lo.y; o.z = hi.x; o.w = hi.y;
          st16_wt(ATT + c * 64 + 8 * gam, o); }
    }
    GL_BAR();
    GL_REPF(5) {
        LAS float* xcol = (LAS float*)(lds + GL_SOL);
        LAS bf16* tinv = (LAS bf16*)(lds + GL_SOL + 17408);
        const int j = tid >> 3, part = tid & 7, jb = j >> 4, jo = j & 15;
#pragma unroll 1
        for (int rb = jb; rb < 4; ++rb) {
            float acc[16];
#pragma unroll
            for (int i = 0; i < 16; ++i) acc[i] = 0.f;
            if (rb > jb) {
#pragma unroll 2
                for (int s = 16 * jb + part; s < 16 * rb; s += 8) {
                    const float sv = xcol[j * 68 + s];
                    const LAS float* ar = AmT + s * 68 + 16 * rb;
#pragma unroll
                    for (int q = 0; q < 4; ++q) { const f32x4 A4 = *(const LAS f32x4*)(ar + 4 * q);
                        acc[4 * q] -= A4.x * sv; acc[4 * q + 1] -= A4.y * sv; acc[4 * q + 2] -= A4.z * sv; acc[4 * q + 3] -= A4.w * sv; }
                }
#pragma unroll
                for (int i = 0; i < 16; ++i) {
                    acc[i] += __builtin_bit_cast(float, __builtin_amdgcn_update_dpp(0, __builtin_bit_cast(int, acc[i]), 0xB1, 0xF, 0xF, true));
                    acc[i] += __builtin_bit_cast(float, __builtin_amdgcn_update_dpp(0, __builtin_bit_cast(int, acc[i]), 0x4E, 0xF, 0xF, true));
                    acc[i] += __builtin_bit_cast(float, __builtin_amdgcn_update_dpp(0, __builtin_bit_cast(int, acc[i]), 0x141, 0xF, 0xF, true));
                }
            } else {
#pragma unroll
                for (int i = 0; i < 16; ++i) acc[i] = (i == jo) ? 1.f : 0.f;
            }
#pragma unroll
            for (int i = 0; i < 16; ++i) {
                const float sv = acc[i];
                const LAS float* ar = AmT + (16 * rb + i) * 68 + 16 * rb;
#pragma unroll
                for (int q = (i + 1) / 4; q < 4; ++q) { const f32x4 A4 = *(const LAS f32x4*)(ar + 4 * q);
                    if (4 * q > i) acc[4 * q] -= A4.x * sv; if (4 * q + 1 > i) acc[4 * q + 1] -= A4.y * sv; if (4 * q + 2 > i) acc[4 * q + 2] -= A4.z * sv; if (4 * q + 3 > i) acc[4 * q + 3] -= A4.w * sv; }
            }
            if (part == 0) {
#pragma unroll
                for (int i = 0; i < 16; ++i) { xcol[j * 68 + 16 * rb + i] = acc[i]; tinv[(16 * rb + i) * 72 + j] = (bf16)f2bf(acc[i]); }
            }
            LDS_WAIT(); asm volatile("" ::: "memory");
        }
        for (int rb = 0; rb < jb; ++rb) {
            if (part == 0) {
#pragma unroll
                for (int i = 0; i < 16; ++i) tinv[(16 * rb + i) * 72 + j] = (bf16)0;
            }
        }
    }
    GL_BAR();
    GL_REPF(6) {
        const LAS bf16* tinv = (const LAS bf16*)(lds + GL_SOL + 17408);
        LAS bf16* wst = (LAS bf16*)(lds + GL_SOL + 17408 + 9216);
        const int col = lane & 15, g = lane >> 4, isw = wave >> 2;
        bf16x8 af[4][2];
#pragma unroll
        for (int rho = 0; rho < 4; ++rho)
#pragma unroll
            for (int s2 = 0; s2 < 2; ++s2) af[rho][s2] = *(const LAS bf16x8*)(tinv + (16 * rho + col) * 72 + 32 * s2 + 8 * g);
        bf16* UF = (bf16*)(ws + WS_UF) + (size_t)item * 8192;
#pragma unroll
        for (int sig = 0; sig < 2; ++sig) {
            const int jj = 32 * (wave & 3) + 16 * sig + col;
            const LAS float* src = (isw ? ks : vs) + jj;
            bf16x8 bfr[2];
#pragma unroll
            for (int s2 = 0; s2 < 2; ++s2) {
                float v[8];
#pragma unroll
                for (int e = 0; e < 8; ++e) { const int sidx = 32 * s2 + 8 * g + e; float x = src[sidx * 132] * sbeta[sidx]; if (isw) x *= seg[sidx]; v[e] = x; }
                v4u pk; pk.x = pk2(v[0], v[1]); pk.y = pk2(v[2], v[3]); pk.z = pk2(v[4], v[5]); pk.w = pk2(v[6], v[7]);
                bfr[s2] = __builtin_bit_cast(bf16x8, pk);
            }
            f32x4 acc[4];
#pragma unroll
            for (int rho = 0; rho < 4; ++rho) { acc[rho] = (f32x4){0.f, 0.f, 0.f, 0.f};
#pragma unroll
                for (int s2 = 0; s2 < 2; ++s2) acc[rho] = __builtin_amdgcn_mfma_f32_16x16x32_bf16(af[rho][s2], bfr[s2], acc[rho], 0, 0, 0); }
            if (!isw) {
                v4u o0, o1;
                o0.x = pk2(acc[0].x, acc[0].y); o0.y = pk2(acc[0].z, acc[0].w); o0.z = pk2(acc[1].x, acc[1].y); o0.w = pk2(acc[1].z, acc[1].w);
                o1.x = pk2(acc[2].x, acc[2].y); o1.y = pk2(acc[2].z, acc[2].w); o1.z = pk2(acc[3].x, acc[3].y); o1.w = pk2(acc[3].z, acc[3].w);
                v4u* d = (v4u*)(UF + (size_t)(2 * (wave & 3) + sig) * 1024 + lane * 16);
                st16_wt(d, o0); st16_wt(d + 1, o1);
            } else {
#pragma unroll
                for (int rho = 0; rho < 4; ++rho)
#pragma unroll
                    for (int i = 0; i < 4; ++i) wst[(16 * rho + 4 * g + i) * 136 + jj] = (bf16)f2bf(-acc[rho][i]);
            }
        }
    }
    GL_BAR();
    {
        const LAS bf16* wst = (const LAS bf16*)(lds + GL_SOL + 17408 + 9216);
        bf16* WN = (bf16*)(ws + WS_WN) + (size_t)item * 8192;
#pragma unroll
        for (int r = 0; r < 2; ++r) {
            const int id = tid + 512 * r, c = id >> 4, gam = id & 15, s32 = gam >> 2, g = gam & 3;
            const v2u lo = *(const LAS v2u*)(wst + c * 136 + 32 * s32 + 4 * g), hi = *(const LAS v2u*)(wst + c * 136 + 32 * s32 + 16 + 4 * g);
            v4u o; o.x = lo.x; o.y = lo.y; o.z = hi.x; o.w = hi.y;
            st16_wt(WN + c * 128 + 8 * gam, o);
        }
    }
    asm volatile("s_waitcnt vmcnt(0)" ::: "memory");
    GL_BAR();
    if (tid == 0) { unsigned fb = __builtin_bit_cast(unsigned, sek[64]); if (fb == 0u) fb = 1u;
        __hip_atomic_store((unsigned*)(ws + WS_CTL) + CW_GFLAG + item, fb, __ATOMIC_RELAXED, __HIP_MEMORY_SCOPE_AGENT); }
    GL_BAR();
}

constexpr int LL_XCB = 68608;
static_assert(LL_XCB + 64 * 1040 <= MISC_OFF, "lru_local LDS map");
__device__ __forceinline__ float expm1_small(float x) {
    const float p = x * (1.0f + x * (0.5f + x * (0.16666667f + x * (0.041666668f + x * 0.008333334f))));
    return (x > -0.25f) ? p : (__expf(x) - 1.0f);
}
__device__ __forceinline__ void lru_local_item(const Params& P, LAS unsigned char* lds, int lt, int tid, int lane, int wave) {
    unsigned char* ws = P.ws;
    asm volatile("" : "+v"(tid));
    const int b = lt >> 7, n = lt & 127, t0 = b * SEQ + n * 64;
    LAS bf16* rawx = (LAS bf16*)lds;
    LAS bf16* xcb = (LAS bf16*)(lds + LL_XCB);
    const bf16* XR = (const bf16*)(ws + WS_XR);
    {
        v4u pr[9];
#pragma unroll
        for (int r = 0; r < 9; ++r) { const int id = tid + 512 * r, row = id >> 6, ck = id & 63, s = n * 64 + row - 3;
            pr[r] = (v4u){0u, 0u, 0u, 0u};
            if (id < 67 * 64 && s >= 0) pr[r] = *(const v4u*)(XR + (size_t)(b * SEQ + s) * 512 + ck * 8); }
#pragma unroll
        for (int r = 0; r < 9; ++r) { const int id = tid + 512 * r; if (id < 67 * 64) *(LAS v4u*)(rawx + id * 8) = pr[r]; }
    }
    GL_BAR();
    {
        const int chg = tid & 63, tseg = tid >> 6, ch0 = chg * 8;
        float w[4][8], cb[8];
#pragma unroll
        for (int j = 0; j < 4; ++j) { const f32x4 a = *(const f32x4*)(P.lru_conv_w + j * 512 + ch0), c = *(const f32x4*)(P.lru_conv_w + j * 512 + ch0 + 4);
            w[j][0] = a.x; w[j][1] = a.y; w[j][2] = a.z; w[j][3] = a.w; w[j][4] = c.x; w[j][5] = c.y; w[j][6] = c.z; w[j][7] = c.w; }
        { const f32x4 a = *(const f32x4*)(P.lru_conv_b + ch0), c = *(const f32x4*)(P.lru_conv_b + ch0 + 4);
          cb[0] = a.x; cb[1] = a.y; cb[2] = a.z; cb[3] = a.w; cb[4] = c.x; cb[5] = c.y; cb[6] = c.z; cb[7] = c.w; }
        v4u xr[11];
#pragma unroll
        for (int r = 0; r < 11; ++r) xr[r] = *(const LAS v4u*)(rawx + (tseg * 8 + r) * 512 + ch0);
#pragma unroll
        for (int tk = 0; tk < 8; ++tk) {
            float y[8];
#pragma unroll
            for (int e = 0; e < 8; ++e) y[e] = cb[e];
#pragma unroll
            for (int j = 0; j < 4; ++j) { const v4u x = xr[tk + j];
                y[0] += w[j][0] * bflo(x.x); y[1] += w[j][1] * bfhi(x.x); y[2] += w[j][2] * bflo(x.y); y[3] += w[j][3] * bfhi(x.y);
                y[4] += w[j][4] * bflo(x.z); y[5] += w[j][5] * bfhi(x.z); y[6] += w[j][6] * bflo(x.w); y[7] += w[j][7] * bfhi(x.w); }
            v4u o; o.x = pk2(y[0], y[1]); o.y = pk2(y[2], y[3]); o.z = pk2(y[4], y[5]); o.w = pk2(y[6], y[7]);
            *(LAS v4u*)(xcb + (tseg * 8 + tk) * 520 + ch0) = o;
        }
    }
    GL_BAR();
    {
        const int g = wave, col = lane & 15, g4 = lane >> 4;
        LAS bf16* AM = (LAS bf16*)(lds + wave * 8192); LAS bf16* BT = AM + 2048;
        const bf16* WT = (const bf16*)(ws + WS_LRUWT) + (size_t)g * 8192;
        bf16x8 Bw[2][4][2];
#pragma unroll
        for (int m = 0; m < 2; ++m)
#pragma unroll
            for (int jt = 0; jt < 4; ++jt)
#pragma unroll
                for (int s2 = 0; s2 < 2; ++s2) Bw[m][jt][s2] = *(const bf16x8*)(WT + m * 4096 + (16 * jt + col) * 64 + 32 * s2 + 8 * g4);
        float cba[4], cbx[4], csp[4];
#pragma unroll
        for (int jt = 0; jt < 4; ++jt) { const int ch = g * 64 + 16 * jt + col; cba[jt] = P.lru_ba[ch]; cbx[jt] = P.lru_bx[ch]; csp[jt] = softplusf_(-P.lru_lambda[ch]); }
        bf16* HLOC = (bf16*)(ws + WS_HLOC); bf16* PCUM = (bf16*)(ws + WS_PCUM);
        const int chs = g * 64 + lane;
        float hst = 0.f, pc = 1.f;
#pragma unroll 1
        for (int half = 0; half < 2; ++half) {
            bf16x8 Af[2][2];
#pragma unroll
            for (int rho = 0; rho < 2; ++rho)
#pragma unroll
                for (int s2 = 0; s2 < 2; ++s2) Af[rho][s2] = *(const LAS bf16x8*)(xcb + (32 * half + 16 * rho + col) * 520 + g * 64 + 32 * s2 + 8 * g4);
#pragma unroll
            for (int jt = 0; jt < 4; ++jt) {
#pragma unroll
                for (int rho = 0; rho < 2; ++rho) {
                    f32x4 ra = (f32x4){0.f, 0.f, 0.f, 0.f}, rx = ra;
#pragma unroll
                    for (int s2 = 0; s2 < 2; ++s2) { ra = __builtin_amdgcn_mfma_f32_16x16x32_bf16(Af[rho][s2], Bw[0][jt][s2], ra, 0, 0, 0); rx = __builtin_amdgcn_mfma_f32_16x16x32_bf16(Af[rho][s2], Bw[1][jt][s2], rx, 0, 0, 0); }
#pragma unroll
                    for (int i = 0; i < 4; ++i) {
                        const int tokl = 16 * rho + 4 * g4 + i, chl = 16 * jt + col;
                        const float r = sigmoidf_(ra[i] + cba[jt]), ig = sigmoidf_(rx[i] + cbx[jt]);
                        const float log_a = -8.0f * r * csp[jt];
                        const float am = -expm1_small(log_a), a = 1.0f - am;
                        const float xo = bf1(xcb[(32 * half + tokl) * 520 + g * 64 + chl]);
                        const float bt = __builtin_amdgcn_sqrtf(fmaxf(am * (1.0f + a), 0.f)) * (ig * xo);
                        AM[tokl * 64 + chl] = (bf16)f2bf(am); BT[tokl * 64 + chl] = (bf16)f2bf(bt);
                    }
                }
            }
            LDS_WAIT(); asm volatile("" ::: "memory");
#pragma unroll 8
            for (int tk = 0; tk < 32; ++tk) {
                const float am = bf1(AM[tk * 64 + lane]), bt = bf1(BT[tk * 64 + lane]);
                hst = (hst - am * hst) + bt; pc = pc - am * pc;
                const size_t o = (size_t)(t0 + 32 * half + tk) * 512 + chs;
                HLOC[o] = (bf16)f2bf(hst); PCUM[o] = (bf16)f2bf(pc);
            }
            LDS_WAIT(); asm volatile("" ::: "memory");
        }
        ((float*)(ws + WS_HEND))[(size_t)lt * 512 + chs] = hst; ((float*)(ws + WS_PEND))[(size_t)lt * 512 + chs] = pc;
    }
    GL_BAR();
}

constexpr int SC_WN = 0, SC_QD = 64 * 272, SC_KD = 2 * 64 * 272, SC_ATT = 2 * 64 * 272 + 128 * 144, SC_BUF = 2 * 64 * 272 + 128 * 144 + 64 * 144;
constexpr int SC_SSQ = 2 * SC_BUF;
__device__ __forceinline__ int sc_lds_off(int id) {
    if (id < 1024) return SC_WN + (id >> 4) * 272 + (id & 15) * 16;
    if (id < 2048) { const int q = id - 1024; return SC_QD + (q >> 4) * 272 + (q & 15) * 16; }
    if (id < 3072) { const int q = id - 2048; return SC_KD + (q >> 3) * 144 + (q & 7) * 16; }
    const int q = id - 3072; return SC_ATT + (q >> 3) * 144 + (q & 7) * 16;
}
__device__ __forceinline__ const v4u* sc_src(const unsigned char* ws, int item, int id) {
    if (id < 1024) return (const v4u*)(ws + WS_WN + (size_t)item * 16384) + id;
    if (id < 2048) return (const v4u*)(ws + WS_QD + (size_t)item * 16384) + (id - 1024);
    if (id < 3072) return (const v4u*)(ws + WS_KD + (size_t)item * 16384) + (id - 2048);
    return (const v4u*)(ws + WS_ATT + (size_t)item * 8192) + (id - 3072);
}
__device__ __forceinline__ bf16x8 pack_b(const f32x4 a, const f32x4 b) {
    v4u r; r.x = pk2(a.x, a.y); r.y = pk2(a.z, a.w); r.z = pk2(b.x, b.y); r.w = pk2(b.z, b.w);
    return __builtin_bit_cast(bf16x8, r);
}
#define SC_BAR() do { asm volatile("s_waitcnt lgkmcnt(0)" ::: "memory"); __builtin_amdgcn_s_barrier(); asm volatile("" ::: "memory"); } while (0)
#define SC_GLD(dst, ptr) asm volatile("global_load_dwordx4 %0, %1, off" : "=v"(dst) : "v"(ptr) : "memory")
#define PIN8(a) asm volatile("" : "+v"(a[0]), "+v"(a[1]), "+v"(a[2]), "+v"(a[3]), "+v"(a[4]), "+v"(a[5]), "+v"(a[6]), "+v"(a[7]))
#define PIN16(a) asm volatile("" : "+v"(a[0]), "+v"(a[1]), "+v"(a[2]), "+v"(a[3]), "+v"(a[4]), "+v"(a[5]), "+v"(a[6]), "+v"(a[7]), "+v"(a[8]), "+v"(a[9]), "+v"(a[10]), "+v"(a[11]), "+v"(a[12]), "+v"(a[13]), "+v"(a[14]), "+v"(a[15]))
constexpr int SCAN_NWC = 2, SCAN_PARTS = 4, SCAN_WGS = 8 * SCAN_PARTS;
constexpr int SC_UFS = 2 * SC_BUF;
constexpr int SC_DECS = SC_UFS + 2 * SCAN_NWC * 2048;
constexpr int SC_OT = SC_DECS + 512;
constexpr int SC_RDY = SC_OT + 2 * 64 * 36 * 4;
constexpr int SC_END = SC_RDY + 64;
static_assert(SC_END <= MISC_OFF, "scan LDS");
#ifndef SCAN_REPS
#define SCAN_REPS 1
#endif
#ifndef SCAN_EXP
#define SCAN_EXP 0
#endif
__device__ __forceinline__ int sc3_lds_off(int id) {
    if (id < 3584) return sc_lds_off(id);
    return SC_UFS + (id - 3584) * 16;
}
__device__ __forceinline__ const v4u* sc3_src(const unsigned char* ws, int item, int id, int part) {
    if (id < 3584) return sc_src(ws, item, id);
    return (const v4u*)(ws + WS_UF + (size_t)item * 16384 + (size_t)(part * SCAN_NWC) * 2048) + (id - 3584);
}
__device__ __forceinline__ void gdn_scan(const Params& P, LAS unsigned char* lds, int sb, int tid, int lane, int wave) {
    const unsigned char* ws = P.ws;
    constexpr int NCH = 128 * SCAN_REPS, NPC = 15;
    const int bh = sb & 7, part = sb >> 3;
    const int b = bh >> 2, h = bh & 3, col = lane & 15, g = lane >> 4;
    const int item0 = bh * 128;
    if (tid == 0) *(volatile LAS unsigned*)(lds + SC_RDY) = 0u;
    SC_BAR();
    if (wave >= 4) {
        constexpr int NP = 15, DEP = 3;
        const int lt = tid - 256;
        const unsigned voff = (unsigned)lt * 16u;
        const int lA = (lt >> 4) * 272 + (lt & 15) * 16, lB = (lt >> 3) * 144 + (lt & 7) * 16, lU = SC_UFS + lt * 16;
        v4u rs[DEP][NP];
#define SC_ISSUE(set, itm) do { const unsigned char* gq_ = ws + (size_t)(itm) * 16384; const unsigned char* ga_ = ws + WS_ATT + (size_t)(itm) * 8192; \
            asm volatile("s_nop 4\n\tglobal_load_dwordx4 %0, %8, %9 sc0 sc1\n\tglobal_load_dwordx4 %1, %8, %10 sc0 sc1\n\tglobal_load_dwordx4 %2, %8, %11 sc0 sc1\n\tglobal_load_dwordx4 %3, %8, %12 sc0 sc1\n\t" \
                         "global_load_dwordx4 %4, %8, %13 sc0 sc1\n\tglobal_load_dwordx4 %5, %8, %14 sc0 sc1\n\tglobal_load_dwordx4 %6, %8, %15 sc0 sc1\n\tglobal_load_dwordx4 %7, %8, %16 sc0 sc1" \
                : "=&v"(rs[set][0]), "=&v"(rs[set][1]), "=&v"(rs[set][2]), "=&v"(rs[set][3]), "=&v"(rs[set][4]), "=&v"(rs[set][5]), "=&v"(rs[set][6]), "=&v"(rs[set][7]) \
                : "v"(voff), "s"(gq_ + WS_WN), "s"(gq_ + WS_WN + 4096), "s"(gq_ + WS_WN + 8192), "s"(gq_ + WS_WN + 12288), \
                  "s"(gq_ + WS_QD), "s"(gq_ + WS_QD + 4096), "s"(gq_ + WS_QD + 8192), "s"(gq_ + WS_QD + 12288) : "memory"); \
            asm volatile("s_nop 4\n\tglobal_load_dwordx4 %0, %7, %8 sc0 sc1\n\tglobal_load_dwordx4 %1, %7, %9 sc0 sc1\n\tglobal_load_dwordx4 %2, %7, %10 sc0 sc1\n\tglobal_load_dwordx4 %3, %7, %11 sc0 sc1\n\t" \
                         "global_load_dwordx4 %4, %7, %12 sc0 sc1\n\tglobal_load_dwordx4 %5, %7, %13 sc0 sc1\n\tglobal_load_dwordx4 %6, %7, %14 sc0 sc1" \
                : "=&v"(rs[set][8]), "=&v"(rs[set][9]), "=&v"(rs[set][10]), "=&v"(rs[set][11]), "=&v"(rs[set][12]), "=&v"(rs[set][13]), "=&v"(rs[set][14]) \
                : "v"(voff), "s"(gq_ + WS_KD), "s"(gq_ + WS_KD + 4096), "s"(gq_ + WS_KD + 8192), "s"(gq_ + WS_KD + 12288), \
                  "s"(ga_), "s"(ga_ + 4096), "s"(gq_ + WS_UF + (size_t)(part * SCAN_NWC) * 2048) : "memory"); } while (0)
#define SC_WAITSET(set, cnt) asm volatile("s_waitcnt " cnt : "+v"(rs[set][0]), "+v"(rs[set][1]), "+v"(rs[set][2]), "+v"(rs[set][3]), "+v"(rs[set][4]), "+v"(rs[set][5]), "+v"(rs[set][6]), "+v"(rs[set][7]), \
            "+v"(rs[set][8]), "+v"(rs[set][9]), "+v"(rs[set][10]), "+v"(rs[set][11]), "+v"(rs[set][12]), "+v"(rs[set][13]), "+v"(rs[set][14]) :: "memory")
#define SC_WRITE(set, par) do { LAS unsigned char* wb_ = lds + (par) * SC_BUF; \
            _Pragma("unroll") for (int r = 0; r < 4; ++r) { *(LAS v4u*)(wb_ + SC_WN + lA + r * (16 * 272)) = rs[set][r]; *(LAS v4u*)(wb_ + SC_QD + lA + r * (16 * 272)) = rs[set][4 + r]; \
                                                          *(LAS v4u*)(wb_ + SC_KD + lB + r * (32 * 144)) = rs[set][8 + r]; } \
            *(LAS v4u*)(wb_ + SC_ATT + lB) = rs[set][12]; *(LAS v4u*)(wb_ + SC_ATT + lB + 32 * 144) = rs[set][13]; \
            *(LAS v4u*)(lds + lU + (par) * (SCAN_NWC * 2048)) = rs[set][14]; } while (0)
#define SC_NEED(c) do { unsigned sp_ = 0; while (*(volatile LAS unsigned*)(lds + SC_RDY) <= (unsigned)(c) && ++sp_ < (1u << 24)) __builtin_amdgcn_s_sleep(2); } while (0)
        SC_NEED(0); SC_ISSUE(0, item0);
        SC_WAITSET(0, "vmcnt(0)"); SC_WRITE(0, 0); SC_WAITSET(0, "lgkmcnt(0)");
        SC_NEED(3); SC_ISSUE(1, item0 + 1); SC_ISSUE(2, item0 + 2); SC_ISSUE(0, item0 + 3);
        SC_BAR();
        int n2 = 0;
#define SC_INTERVAL(set) do { SC_WAITSET(set, "vmcnt(30)"); SC_WRITE(set, (n2 + 1) & 1); SC_WAITSET(set, "lgkmcnt(0)"); if (n2 + 1 + DEP < 128) SC_NEED(n2 + 1 + DEP); SC_ISSUE(set, item0 + ((n2 + 1 + DEP) & 127)); SC_BAR(); ++n2; } while (0)
#pragma unroll 1
        for (int it = 0; it < NCH / 3; ++it) { SC_INTERVAL(1); SC_INTERVAL(2); SC_INTERVAL(0); }
        if (NCH % 3 >= 1) SC_INTERVAL(1);
        if (NCH % 3 >= 2) SC_INTERVAL(2);
        SC_WAITSET(0, "vmcnt(0)"); SC_WAITSET(1, "vmcnt(0)"); SC_WAITSET(2, "vmcnt(0)");
#undef SC_INTERVAL
#undef SC_NEED
#undef SC_WRITE
#undef SC_WAITSET
#undef SC_ISSUE
        return;
    }
    if (wave == 3) {
        const unsigned* flags = (const unsigned*)(ws + WS_CTL) + CW_GFLAG + item0;
        unsigned rdy = 0;
#define SC_POLLSTEP() do { if (rdy < 128u) { const unsigned idx_ = rdy + (unsigned)lane; \
            const unsigned fv_ = (idx_ < 128u) ? __hip_atomic_load(flags + idx_, __ATOMIC_RELAXED, __HIP_MEMORY_SCOPE_AGENT) : 0u; \
            const unsigned long long m_ = __ballot(fv_ != 0u); const unsigned nrun_ = (m_ == ~0ull) ? 64u : (unsigned)__builtin_ctzll(~m_);     \
            if ((unsigned)lane < nrun_) ((LAS float*)(lds + SC_DECS))[idx_] = __builtin_bit_cast(float, fv_); \
            rdy += nrun_; LDS_WAIT(); if (lane == 0) *(volatile LAS unsigned*)(lds + SC_RDY) = rdy; } } while (0)
        { unsigned sp = 0; while (rdy < 4u && ++sp < (1u << 22)) { SC_POLLSTEP(); if (rdy < 4u) __builtin_amdgcn_s_sleep(16); } }
        SC_BAR();
#pragma unroll 1
        for (int n2 = 0; n2 < NCH; ++n2) {
            { const unsigned need = (unsigned)(n2 + 1 + 3) < 128u ? (unsigned)(n2 + 1 + 3) : 127u; unsigned sp = 0;
              while (rdy <= need && rdy < 128u && ++sp < (1u << 22)) { SC_POLLSTEP(); if (rdy <= need) __builtin_amdgcn_s_sleep(8); } }
            if (rdy < 128u && rdy < (unsigned)(n2 & 127) + 16u) SC_POLLSTEP();
            SC_BAR();
        }
#undef SC_POLLSTEP
        return;
    }
    if (wave == 2) {
        const int row = lane;
        bf16* Y = (bf16*)((unsigned char*)P.out + OUT_Y);
        float* SSQG = P.out;
        SC_BAR();
#pragma unroll 1
        for (int n2 = 0; n2 <= NCH; ++n2) {
            if (n2 > 0) {
                const int n = (n2 - 1) & 127, t = b * SEQ + n * 64 + row;
                const LAS float* src = (const LAS float*)(lds + SC_OT + ((n2 - 1) & 1) * (64 * 36 * 4)) + row * 36;
                f32x4 a[8]; float s2 = 0.f;
#pragma unroll
                for (int q = 0; q < 8; ++q) { a[q] = *(const LAS f32x4*)(src + 4 * q); s2 += (a[q].x * a[q].x + a[q].y * a[q].y) + (a[q].z * a[q].z + a[q].w * a[q].w); }
                SSQG[(size_t)t * 32 + h * 8 + part] = s2;
                v4u* d = (v4u*)(Y + (size_t)t * 1024 + h * 128 + 32 * part);
#pragma unroll
                for (int q = 0; q < 4; ++q) { v4u o; o.x = pk2(a[2 * q].x, a[2 * q].y); o.y = pk2(a[2 * q].z, a[2 * q].w); o.z = pk2(a[2 * q + 1].x, a[2 * q + 1].y); o.w = pk2(a[2 * q + 1].z, a[2 * q + 1].w); d[q] = o; }
            }
            if (n2 < NCH) SC_BAR();
        }
        return;
    }
    f32x4 S[8];
#pragma unroll
    for (int i = 0; i < 8; ++i) S[i] = (f32x4){0.f, 0.f, 0.f, 0.f};
    SC_BAR();
#pragma unroll 1
    for (int n2 = 0; n2 < NCH; ++n2) {
        if (SCAN_REPS > 1 && (n2 & 127) == 0) {
#pragma unroll
            for (int i = 0; i < 8; ++i) S[i] = (f32x4){0.f, 0.f, 0.f, 0.f};
        }
        if (SCAN_EXP == 2 && n2 < 128) { SC_BAR(); continue; }
        const int par = n2 & 1;
        LAS unsigned char* buf = lds + par * SC_BUF;
        bf16x8 fA[16], fB[16], fC[16], fD[8];
#pragma unroll
        for (int rho = 0; rho < 4; ++rho)
#pragma unroll
            for (int s = 0; s < 4; ++s) fA[rho * 4 + s] = *(const LAS bf16x8*)(buf + SC_WN + (16 * rho + col) * 272 + (32 * s + 8 * g) * 2);
#pragma unroll
        for (int rho = 0; rho < 4; ++rho)
#pragma unroll
            for (int s = 0; s < 4; ++s) fB[rho * 4 + s] = *(const LAS bf16x8*)(buf + SC_QD + (16 * rho + col) * 272 + (32 * s + 8 * g) * 2);
        const LAS v4u* ufp = (const LAS v4u*)(lds + SC_UFS + par * (SCAN_NWC * 2048) + wave * 2048 + lane * 32);
        const v4u uf0 = ufp[0], uf1 = ufp[1];
        const float dec = ((const LAS float*)(lds + SC_DECS))[n2 & 127];
        bf16x8 Bs[4];
#pragma unroll
        for (int s = 0; s < 4; ++s) Bs[s] = pack_b(S[2 * s], S[2 * s + 1]);
        f32x4 Vn[4], Oc[4];
        Vn[0] = (f32x4){bflo(uf0.x), bfhi(uf0.x), bflo(uf0.y), bfhi(uf0.y)}; Vn[1] = (f32x4){bflo(uf0.z), bfhi(uf0.z), bflo(uf0.w), bfhi(uf0.w)};
        Vn[2] = (f32x4){bflo(uf1.x), bfhi(uf1.x), bflo(uf1.y), bfhi(uf1.y)}; Vn[3] = (f32x4){bflo(uf1.z), bfhi(uf1.z), bflo(uf1.w), bfhi(uf1.w)};
        __builtin_amdgcn_sched_barrier(0);
        PIN16(fA);
#pragma unroll
        for (int s = 0; s < 4; ++s)
#pragma unroll
            for (int rho = 0; rho < 4; ++rho) Vn[rho] = __builtin_amdgcn_mfma_f32_16x16x32_bf16(fA[rho * 4 + s], Bs[s], Vn[rho], 0, 0, 0);
        __builtin_amdgcn_sched_barrier(0);
#pragma unroll
        for (int tau = 0; tau < 8; ++tau)
#pragma unroll
            for (int s = 0; s < 2; ++s) fC[tau * 2 + s] = *(const LAS bf16x8*)(buf + SC_KD + (16 * tau + col) * 144 + (32 * s + 8 * g) * 2);
        __builtin_amdgcn_sched_barrier(0);
        PIN16(fB);
#pragma unroll
        for (int rho = 0; rho < 4; ++rho) Oc[rho] = (f32x4){0.f, 0.f, 0.f, 0.f};
#pragma unroll
        for (int s = 0; s < 4; ++s)
#pragma unroll
            for (int rho = 0; rho < 4; ++rho) Oc[rho] = __builtin_amdgcn_mfma_f32_16x16x32_bf16(fB[rho * 4 + s], Bs[s], Oc[rho], 0, 0, 0);
        __builtin_amdgcn_sched_barrier(0);
#pragma unroll
        for (int rho = 0; rho < 4; ++rho)
#pragma unroll
            for (int s = 0; s < 2; ++s) fD[rho * 2 + s] = *(const LAS bf16x8*)(buf + SC_ATT + (16 * rho + col) * 144 + (32 * s + 8 * g) * 2);
        bf16x8 Bv[2];
        Bv[0] = pack_b(Vn[0], Vn[1]); Bv[1] = pack_b(Vn[2], Vn[3]);
#pragma unroll
        for (int tau = 0; tau < 8; ++tau) S[tau] = S[tau] * dec;
        __builtin_amdgcn_sched_barrier(0);
        PIN16(fC);
#pragma unroll
        for (int s = 0; s < 2; ++s)
#pragma unroll
            for (int tau = 0; tau < 8; ++tau) S[tau] = __builtin_amdgcn_mfma_f32_16x16x32_bf16(fC[tau * 2 + s], Bv[s], S[tau], 0, 0, 0);
        __builtin_amdgcn_sched_barrier(0);
        PIN8(fD);
#pragma unroll
        for (int s = 0; s < 2; ++s)
#pragma unroll
            for (int rho = 0; rho < 4; ++rho) Oc[rho] = __builtin_amdgcn_mfma_f32_16x16x32_bf16(fD[rho * 2 + s], Bv[s], Oc[rho], 0, 0, 0);
        LAS float* ot = (LAS float*)(lds + SC_OT + par * (64 * 36 * 4)) + 16 * wave + col;
#pragma unroll
        for (int rho = 0; rho < 4; ++rho)
#pragma unroll
            for (int i = 0; i < 4; ++i) ot[(16 * rho + 4 * g + i) * 36] = Oc[rho][i];
        SC_BAR();
    }
}

__device__ __forceinline__ void lru_carry(const Params& P, int gwv, int lane) {
    unsigned char* ws = P.ws;
    const int b = gwv >> 3, g = gwv & 7, ch = g * 64 + lane;
    const float* HEND = (const float*)(ws + WS_HEND); const float* PEND = (const float*)(ws + WS_PEND); float* HIN = (float*)(ws + WS_HIN);
    float hin = 0.f;
#pragma unroll 1
    for (int n0 = 0; n0 < 128; n0 += 32) {
        float he[32], pe[32];
#pragma unroll
        for (int i = 0; i < 32; ++i) { const size_t o = (size_t)(b * 128 + n0 + i) * 512 + ch; he[i] = HEND[o]; pe[i] = PEND[o]; }
#pragma unroll
        for (int i = 0; i < 32; ++i) { HIN[(size_t)(b * 128 + n0 + i) * 512 + ch] = hin; hin = he[i] + pe[i] * hin; }
    }
}

__device__ __forceinline__ void cvt_table(const float* src, bf16* dst, size_t n8, size_t wi, size_t nw) {
    for (size_t i = wi; i < n8; i += nw) {
        const f32x4 a = ((const f32x4*)src)[2 * i], c = ((const f32x4*)src)[2 * i + 1];
        v4u o; o.x = pk2(a.x, a.y); o.y = pk2(a.z, a.w); o.z = pk2(c.x, c.y); o.w = pk2(c.z, c.w);
        ((v4u*)dst)[i] = o;
    }
}

__device__ __forceinline__ void lru_combine(const Params& P, size_t wi, size_t nw) {
    unsigned char* ws = P.ws;
    const v4u* HLOC = (const v4u*)(ws + WS_HLOC); const v4u* PCUM = (const v4u*)(ws + WS_PCUM); const v4u* GATE = (const v4u*)(ws + WS_GATE);
    const float* HIN = (const float*)(ws + WS_HIN); bf16* Y = (bf16*)((unsigned char*)P.out + OUT_Y);
    for (size_t i = wi; i < (size_t)T * 64; i += nw) {
        const size_t t = i >> 6; const int ch0 = (int)(i & 63) * 8;
        const v4u hl = HLOC[i], pc = PCUM[i], gt = GATE[i];
        const f32x4 h0 = *(const f32x4*)(HIN + (t >> 6) * 512 + ch0), h1 = *(const f32x4*)(HIN + (t >> 6) * 512 + ch0 + 4);
        float y[8];
        y[0] = (bflo(hl.x) + bflo(pc.x) * h0.x) * gelu_tanh(bflo(gt.x)); y[1] = (bfhi(hl.x) + bfhi(pc.x) * h0.y) * gelu_tanh(bfhi(gt.x));
        y[2] = (bflo(hl.y) + bflo(pc.y) * h0.z) * gelu_tanh(bflo(gt.y)); y[3] = (bfhi(hl.y) + bfhi(pc.y) * h0.w) * gelu_tanh(bfhi(gt.y));
        y[4] = (bflo(hl.z) + bflo(pc.z) * h1.x) * gelu_tanh(bflo(gt.z)); y[5] = (bfhi(hl.z) + bfhi(pc.z) * h1.y) * gelu_tanh(bfhi(gt.z));
        y[6] = (bflo(hl.w) + bflo(pc.w) * h1.z) * gelu_tanh(bflo(gt.w)); y[7] = (bfhi(hl.w) + bfhi(pc.w) * h1.w) * gelu_tanh(bfhi(gt.w));
        v4u o; o.x = pk2(y[0], y[1]); o.y = pk2(y[2], y[3]); o.z = pk2(y[4], y[5]); o.w = pk2(y[6], y[7]);
        *(v4u*)(Y + t * 1024 + 512 + ch0) = o;
    }
}

__device__ __forceinline__ void gdn_gate_norm(const Params& P, size_t wi, size_t nw) {
    unsigned char* ws = P.ws;
    bf16* Y = (bf16*)((unsigned char*)P.out + OUT_Y); const v4u* Z = (const v4u*)(ws + WS_Z); const float* SSQG = P.out;
    for (size_t i = wi; i < (size_t)T * 64; i += nw) {
        const size_t t = i >> 6; const int c0 = (int)(i & 63) * 8, h = c0 >> 7;
        const f32x4 q0 = *(const f32x4*)(SSQG + t * 32 + h * 8);
        const float rstd = rsqrtf(((q0.x + q0.y) + (q0.z + q0.w)) * (1.0f / 128.0f) + 1e-6f);
        const v4u o = *(const v4u*)(Y + t * 1024 + c0), z = Z[i];
        const f32x4 w0 = *(const f32x4*)(P.gdn_norm_w + (c0 & 127)), w1 = *(const f32x4*)(P.gdn_norm_w + (c0 & 127) + 4);
        float y[8];
        y[0] = bflo(o.x) * rstd * w0.x * siluf_(bflo(z.x)); y[1] = bfhi(o.x) * rstd * w0.y * siluf_(bfhi(z.x));
        y[2] = bflo(o.y) * rstd * w0.z * siluf_(bflo(z.y)); y[3] = bfhi(o.y) * rstd * w0.w * siluf_(bfhi(z.y));
        y[4] = bflo(o.z) * rstd * w1.x * siluf_(bflo(z.z)); y[5] = bfhi(o.z) * rstd * w1.y * siluf_(bfhi(z.z));
        y[6] = bflo(o.w) * rstd * w1.z * siluf_(bflo(z.w)); y[7] = bfhi(o.w) * rstd * w1.w * siluf_(bfhi(z.w));
        v4u r; r.x = pk2(y[0], y[1]); r.y = pk2(y[2], y[3]); r.z = pk2(y[4], y[5]); r.w = pk2(y[6], y[7]);
        *(v4u*)(Y + t * 1024 + c0) = r;
    }
}

__device__ __forceinline__ void xattn_stage(LAS unsigned char* lds, const bf16* src, int tid) {
    v4u tmp[16];
    asm volatile("" : "+v"(tid));
    const unsigned voff = (unsigned)tid * 16u;
#pragma unroll
    for (int r = 0; r < 16; ++r) { const unsigned char* sb = (const unsigned char*)src + r * 8192;
        asm volatile("s_nop 4\n\tglobal_load_dwordx4 %0, %1, %2" : "=&v"(tmp[r]) : "v"(voff), "s"(sb) : "memory"); }
    asm volatile("s_waitcnt vmcnt(0)" : "+v"(tmp[0]), "+v"(tmp[1]), "+v"(tmp[2]), "+v"(tmp[3]), "+v"(tmp[4]), "+v"(tmp[5]), "+v"(tmp[6]), "+v"(tmp[7]),
                                        "+v"(tmp[8]), "+v"(tmp[9]), "+v"(tmp[10]), "+v"(tmp[11]), "+v"(tmp[12]), "+v"(tmp[13]), "+v"(tmp[14]), "+v"(tmp[15]) :: "memory");
#pragma unroll
    for (int r = 0; r < 16; ++r) { const int id = tid + 512 * r; *(LAS v4u*)(lds + (id >> 5) * 528 + (id & 31) * 16) = tmp[r]; }
}
#ifndef XA_NPS
#define XA_NPS 2
#endif
__device__ __forceinline__ void xattn_unit(const Params& P, LAS unsigned char* lds, int unit, int tid, int lane, int wave) {
    const unsigned char* ws = P.ws;
    const int h = unit & 3, qb = (unit >> 2) & 63, b = unit >> 8; int col = lane & 15, g = lane >> 4;
    const int tw = b * SEQ + qb * 128 + 16 * wave;
    const bf16* Kb = (const bf16*)(ws + WS_KB) + (size_t)((b * 4 + h) * 256) * 256;
    const bf16* Vt = (const bf16*)(ws + WS_VTP) + (size_t)((b * 4 + h) * 256) * 256;
    xattn_stage(lds, Kb, tid);
    __syncthreads();
    const LAS unsigned char* arow = lds + col * 528 + g * 16;
    bf16x8 Bp[XA_NPS][8]; float inv[XA_NPS];
#pragma unroll
    for (int ps = 0; ps < XA_NPS; ++ps) {
        __builtin_amdgcn_sched_barrier(0); asm volatile("" : "+v"(col), "+v"(g) :: "memory");
        const bf16* Q = (const bf16*)(ws + WS_Q) + (size_t)(tw + 128 * ps + col) * 1024 + h * 256 + 8 * g;
        bf16x8 Bq[8];
#pragma unroll
        for (int s = 0; s < 8; ++s) Bq[s] = *(const bf16x8*)(Q + 32 * s);
        f32x4 St[16];
        bf16x8 fr[2][8];
#pragma unroll
        for (int s = 0; s < 8; ++s) fr[0][s] = *(const LAS bf16x8*)(arow + 64 * s);
#pragma unroll
        for (int kap = 0; kap < 16; ++kap) {
            if (kap + 1 < 16) {
#pragma unroll
                for (int s = 0; s < 8; ++s) fr[(kap + 1) & 1][s] = *(const LAS bf16x8*)(arow + (16 * (kap + 1)) * 528 + 64 * s);
            }
            __builtin_amdgcn_sched_barrier(0);
            PIN8(fr[kap & 1]);
            f32x4 acc = (f32x4){0.f, 0.f, 0.f, 0.f};
#pragma unroll
            for (int s = 0; s < 8; ++s) acc = __builtin_amdgcn_mfma_f32_16x16x32_bf16(fr[kap & 1][s], Bq[s], acc, 0, 0, 0);
            St[kap] = acc;
            __builtin_amdgcn_sched_barrier(0);
        }
        float mx = -3.0e38f;
#pragma unroll
        for (int kap = 0; kap < 16; ++kap) mx = fmaxf(fmaxf(fmaxf(St[kap].x, St[kap].y), fmaxf(St[kap].z, St[kap].w)), mx);
        mx = fmaxf(mx, __shfl_xor(mx, 16)); mx = fmaxf(mx, __shfl_xor(mx, 32));
        float l = 0.f;
#pragma unroll
        for (int kap = 0; kap < 16; ++kap) { St[kap].x = __expf(St[kap].x - mx); St[kap].y = __expf(St[kap].y - mx); St[kap].z = __expf(St[kap].z - mx); St[kap].w = __expf(St[kap].w - mx);
            l += (St[kap].x + St[kap].y) + (St[kap].z + St[kap].w); }
        l += __shfl_xor(l, 16); l += __shfl_xor(l, 32);
        inv[ps] = 1.0f / l;
#pragma unroll
        for (int s = 0; s < 8; ++s) Bp[ps][s] = pack_b(St[2 * s], St[2 * s + 1]);
    }
    __syncthreads();
    xattn_stage(lds, Vt, tid);
    __syncthreads();
#pragma unroll
    for (int ps = 0; ps < XA_NPS; ++ps) {
        __builtin_amdgcn_sched_barrier(0); asm volatile("" : "+v"(col), "+v"(g) :: "memory");
        bf16* AO = (bf16*)(P.ws + WS_AO) + (size_t)(tw + 128 * ps + col) * 1024 + h * 256 + 4 * g;
        bf16x8 fr[2][8];
#pragma unroll
        for (int s = 0; s < 8; ++s) fr[0][s] = *(const LAS bf16x8*)(arow + 64 * s);
#pragma unroll
        for (int del = 0; del < 16; ++del) {
            if (del + 1 < 16) {
#pragma unroll
                for (int s = 0; s < 8; ++s) fr[(del + 1) & 1][s] = *(const LAS bf16x8*)(arow + (16 * (del + 1)) * 528 + 64 * s);
            }
            __builtin_amdgcn_sched_barrier(0);
            PIN8(fr[del & 1]);
            f32x4 acc = (f32x4){0.f, 0.f, 0.f, 0.f};
#pragma unroll
            for (int s = 0; s < 8; ++s) acc = __builtin_amdgcn_mfma_f32_16x16x32_bf16(fr[del & 1][s], Bp[ps][s], acc, 0, 0, 0);
            v2u o; o.x = pk2(acc.x * inv[ps], acc.y * inv[ps]); o.y = pk2(acc.z * inv[ps], acc.w * inv[ps]);
            *(v2u*)(AO + 16 * del) = o;
            __builtin_amdgcn_sched_barrier(0);
        }
    }
    __syncthreads();
}

__device__ __forceinline__ unsigned key_enc(float f) { const unsigned u = __builtin_bit_cast(unsigned, f); return (u & 0x80000000u) ? ~u : (u | 0x80000000u); }
__device__ __forceinline__ float key_dec(unsigned k) { const unsigned u = (k & 0x80000000u) ? (k & 0x7fffffffu) : ~k; return __builtin_bit_cast(float, u); }
#define TK_CAS(a, b) do { const unsigned hi_ = max(a, b), lo_ = min(a, b); a = hi_; b = lo_; } while (0)
__device__ __forceinline__ void tk_merge16(unsigned (&a)[16]) {
#pragma unroll
    for (int j = 8; j > 0; j >>= 1)
#pragma unroll
        for (int i = 0; i < 16; ++i) { const int l = i ^ j; if (l > i) TK_CAS(a[i], a[l]); }
}
__device__ __forceinline__ void tk_sort16(unsigned (&a)[16]) {
#define TK_L(...) do { const int pr_[] = {__VA_ARGS__}; _Pragma("unroll") for (int q_ = 0; q_ < (int)(sizeof(pr_) / sizeof(int)); q_ += 2) TK_CAS(a[pr_[q_]], a[pr_[q_ + 1]]); } while (0)
    TK_CAS(a[0], a[13]); TK_CAS(a[1], a[12]); TK_CAS(a[2], a[15]); TK_CAS(a[3], a[14]); TK_CAS(a[4], a[8]); TK_CAS(a[5], a[6]); TK_CAS(a[7], a[11]); TK_CAS(a[9], a[10]);
    TK_CAS(a[0], a[5]); TK_CAS(a[1], a[7]); TK_CAS(a[2], a[9]); TK_CAS(a[3], a[4]); TK_CAS(a[6], a[13]); TK_CAS(a[8], a[14]); TK_CAS(a[10], a[15]); TK_CAS(a[11], a[12]);
    TK_CAS(a[0], a[1]); TK_CAS(a[2], a[3]); TK_CAS(a[4], a[5]); TK_CAS(a[6], a[8]); TK_CAS(a[7], a[9]); TK_CAS(a[10], a[11]); TK_CAS(a[12], a[13]); TK_CAS(a[14], a[15]);
    TK_CAS(a[0], a[2]); TK_CAS(a[1], a[3]); TK_CAS(a[4], a[10]); TK_CAS(a[5], a[11]); TK_CAS(a[6], a[7]); TK_CAS(a[8], a[9]); TK_CAS(a[12], a[14]); TK_CAS(a[13], a[15]);
    TK_CAS(a[1], a[2]); TK_CAS(a[3], a[12]); TK_CAS(a[4], a[6]); TK_CAS(a[5], a[7]); TK_CAS(a[8], a[10]); TK_CAS(a[9], a[11]); TK_CAS(a[13], a[14]);
    TK_CAS(a[1], a[4]); TK_CAS(a[2], a[6]); TK_CAS(a[5], a[8]); TK_CAS(a[7], a[10]); TK_CAS(a[9], a[13]); TK_CAS(a[11], a[14]);
    TK_CAS(a[2], a[4]); TK_CAS(a[3], a[6]); TK_CAS(a[9], a[12]); TK_CAS(a[11], a[13]);
    TK_CAS(a[3], a[5]); TK_CAS(a[6], a[8]); TK_CAS(a[7], a[9]); TK_CAS(a[10], a[12]);
    TK_CAS(a[3], a[4]); TK_CAS(a[5], a[6]); TK_CAS(a[7], a[8]); TK_CAS(a[9], a[10]); TK_CAS(a[11], a[12]);
    TK_CAS(a[6], a[7]); TK_CAS(a[8], a[9]);
#undef TK_L
}
__device__ __forceinline__ void tk_top16_merge(unsigned (&L)[16], const unsigned (&G)[16]) {
#pragma unroll
    for (int i = 0; i < 16; ++i) L[i] = max(L[i], G[15 - i]);
    tk_merge16(L);
}
__device__ __forceinline__ void tk_pair_merge(unsigned (&L)[16]) {
    unsigned Pp[16];
#pragma unroll
    for (int i = 0; i < 16; ++i) Pp[i] = (unsigned)__builtin_amdgcn_update_dpp(0, (int)L[i], 0xB1, 0xF, 0xF, true);
    tk_top16_merge(L, Pp);
}
__device__ __forceinline__ void peer_topk_rows(const Params& P, LAS unsigned char* lds, int rowbase, int tid) {
    const unsigned char* ws = P.ws;
    typedef _Float16 f16x8 __attribute__((ext_vector_type(8)));
    const int rl = tid >> 1, hf = tid & 1, grow = rowbase + rl, t = grow >> 3, h = grow & 7;
    const _Float16* SC = (const _Float16*)(ws + WS_PQ) + (size_t)t * 2048 + h * 256 + 64 * hf;
    f16x8 raw[2][8];
#pragma unroll
    for (int p = 0; p < 2; ++p)
#pragma unroll
        for (int q = 0; q < 8; ++q) raw[p][q] = *(const f16x8*)(SC + p * 128 + 8 * q);
    unsigned L1[16], L2[16];
#pragma unroll
    for (int p = 0; p < 2; ++p) {
        unsigned L[16];
#pragma unroll
        for (int grp = 0; grp < 4; ++grp) {
            unsigned G[16];
#pragma unroll
            for (int e = 0; e < 16; ++e) G[e] = (key_enc((float)raw[p][2 * grp + (e >> 3)][e & 7]) & ~127u) | (unsigned)(127 - (64 * hf + 16 * grp + e));
            tk_sort16(G);
            if (grp == 0) {
#pragma unroll
                for (int i = 0; i < 16; ++i) L[i] = G[i];
            } else tk_top16_merge(L, G);
        }
        tk_pair_merge(L);
#pragma unroll
        for (int i = 0; i < 16; ++i) { if (p == 0) L1[i] = L[i]; else L2[i] = L[i]; }
    }
    {
        float v1[16], v2[16];
        LAS int* il = (LAS int*)lds + rl * 33;
#pragma unroll
        for (int q = 0; q < 16; ++q) { v1[q] = key_dec((L1[q] & ~127u) | 64u); v2[q] = key_dec((L2[q] & ~127u) | 64u); }
        if (hf == 0) {
#pragma unroll
            for (int q = 0; q < 16; ++q) { il[q] = 127 - (int)(L1[q] & 127u); il[16 + q] = 127 - (int)(L2[q] & 127u); }
        }
        unsigned C[16], D[16];
        float w1[8];
        const unsigned hf16 = (unsigned)hf * 16u, evenmask = (unsigned)hf - 1u;
#pragma unroll
        for (int k = 0; k < 8; ++k) w1[k] = __builtin_bit_cast(float, (__builtin_bit_cast(unsigned, v1[2 * k]) & evenmask) | (__builtin_bit_cast(unsigned, v1[2 * k + 1]) & ~evenmask));
#define TK_SLOT(dst, k, bq, valid_odd) do { const unsigned pos_ = (unsigned)(16 * (2 * (k)) + (bq)) + hf16; unsigned kv_ = (key_enc(w1[k] + v2[bq]) & ~255u) | (255u - pos_); if (!(valid_odd)) kv_ &= evenmask; dst = kv_; } while (0)
        TK_SLOT(C[0], 0, 0, true);
        TK_SLOT(C[1], 0, 1, true);
        TK_SLOT(C[2], 0, 2, true);
        TK_SLOT(C[3], 0, 3, true);
        TK_SLOT(C[4], 0, 4, true);
        TK_SLOT(C[5], 0, 5, true);
        TK_SLOT(C[6], 0, 6, true);
        TK_SLOT(C[7], 0, 7, true);
        TK_SLOT(C[8], 0, 8, false);
        TK_SLOT(C[9], 0, 9, false);
        TK_SLOT(C[10], 0, 10, false);
        TK_SLOT(C[11], 0, 11, false);
        TK_SLOT(C[12], 0, 12, false);
        TK_SLOT(C[13], 0, 13, false);
        TK_SLOT(C[14], 0, 14, false);
        TK_SLOT(C[15], 0, 15, false);
        TK_SLOT(D[0], 1, 0, true);
        TK_SLOT(D[1], 1, 1, true);
        TK_SLOT(D[2], 1, 2, true);
        TK_SLOT(D[3], 1, 3, true);
        TK_SLOT(D[4], 1, 4, false);
        TK_SLOT(D[5], 2, 0, true);
        TK_SLOT(D[6], 2, 1, true);
        TK_SLOT(D[7], 2, 2, false);
        TK_SLOT(D[8], 3, 0, true);
        TK_SLOT(D[9], 3, 1, true);
        TK_SLOT(D[10], 4, 0, true);
        TK_SLOT(D[11], 5, 0, true);
        TK_SLOT(D[12], 6, 0, true);
        TK_SLOT(D[13], 7, 0, true);
        D[14] = 0u; D[15] = 0u;
#undef TK_SLOT
        tk_sort16(C); tk_sort16(D); tk_top16_merge(C, D); tk_pair_merge(C);
        LDS_WAIT(); asm volatile("" ::: "memory");
        float best[16], e[16], sum = 0.f;
#pragma unroll
        for (int q = 0; q < 16; ++q) { best[q] = key_dec((C[q] & ~255u) | 128u); e[q] = __expf(best[q] - best[0]); sum += e[q]; }
        const float inv = __builtin_amdgcn_rcpf(sum);
        int* IDX = (int*)(P.ws + WS_IDX) + (size_t)grow * 16 + 8 * hf; float* GW = (float*)(P.ws + WS_GW) + (size_t)grow * 16 + 8 * hf;
#pragma unroll
        for (int q = 0; q < 8; ++q) {
            const unsigned c = (C[q] & evenmask) | (C[8 + q] & ~evenmask);
            const float ev = __builtin_bit_cast(float, (__builtin_bit_cast(unsigned, e[q]) & evenmask) | (__builtin_bit_cast(unsigned, e[8 + q]) & ~evenmask));
            const unsigned pos = 255u - (c & 255u);
            IDX[q] = il[pos >> 4] * 128 + il[16 + (pos & 15u)]; GW[q] = ev * inv;
        }
    }
    LDS_WAIT(); asm volatile("" ::: "memory");
}

__device__ __forceinline__ void peer_topk_wave(const Params& P, LAS int* ilw, LAS unsigned* oute, LAS float* outg, int tbase, int lane) {
    const unsigned char* ws = P.ws;
    typedef _Float16 f16x8 __attribute__((ext_vector_type(8)));
    const int rl = lane >> 1, hf = lane & 1, t = tbase + (rl >> 3), h = rl & 7;
    const _Float16* SC = (const _Float16*)(ws + WS_PQ) + (size_t)t * 2048 + h * 256 + 64 * hf;
    f16x8 raw[2][8];
#pragma unroll
    for (int p = 0; p < 2; ++p)
#pragma unroll
        for (int q = 0; q < 8; ++q) raw[p][q] = *(const f16x8*)(SC + p * 128 + 8 * q);
    unsigned L1[16], L2[16];
    typedef short s16x2 __attribute__((ext_vector_type(2)));
    const unsigned lanebit = 64u - 64u * (unsigned)hf;
#pragma unroll
    for (int p = 0; p < 2; ++p) {
        unsigned L[16];
#pragma unroll
        for (int grp = 0; grp < 4; ++grp) {
            unsigned G[16];
#pragma unroll
            for (int e2 = 0; e2 < 8; ++e2) {
                const v4u wv = __builtin_bit_cast(v4u, raw[p][2 * grp + (e2 >> 2)]);
                const unsigned w = wv[e2 & 3];
                const unsigned m = __builtin_bit_cast(unsigned, __builtin_bit_cast(s16x2, w) >> (s16x2){15, 15}) | 0x80008000u;
                const unsigned k = w ^ m;
                G[2 * e2] = (k << 16) | (unsigned)(63 - (16 * grp + 2 * e2));
                G[2 * e2 + 1] = (k & 0xffff0000u) | (unsigned)(63 - (16 * grp + 2 * e2 + 1));
            }
            tk_sort16(G);
            if (grp == 0) {
#pragma unroll
                for (int i = 0; i < 16; ++i) L[i] = G[i];
            } else tk_top16_merge(L, G);
        }
#pragma unroll
        for (int i = 0; i < 16; ++i) L[i] |= lanebit;
        tk_pair_merge(L);
#pragma unroll
        for (int i = 0; i < 16; ++i) { if (p == 0) L1[i] = L[i]; else L2[i] = L[i]; }
    }
    {
        float v1[16], v2[16];
        LAS int* il = ilw + rl * 33;
#pragma unroll
        for (int q = 0; q < 16; ++q) {
            const unsigned a = L1[q], c = L2[q];
            const unsigned ha = (a >> 16) ^ ((~(unsigned)((int)a >> 31) | 0x8000u) & 0xffffu), hc = (c >> 16) ^ ((~(unsigned)((int)c >> 31) | 0x8000u) & 0xffffu);
            v1[q] = (float)__builtin_bit_cast(_Float16, (unsigned short)ha); v2[q] = (float)__builtin_bit_cast(_Float16, (unsigned short)hc); }
        if (hf == 0) {
#pragma unroll
            for (int q = 0; q < 16; ++q) { il[q] = 127 - (int)(L1[q] & 127u); il[16 + q] = 127 - (int)(L2[q] & 127u); }
        }
        unsigned C[16], D[16];
        float w1[8];
        const unsigned hf16 = (unsigned)hf * 16u, evenmask = (unsigned)hf - 1u;
#pragma unroll
        for (int k = 0; k < 8; ++k) w1[k] = __builtin_bit_cast(float, (__builtin_bit_cast(unsigned, v1[2 * k]) & evenmask) | (__builtin_bit_cast(unsigned, v1[2 * k + 1]) & ~evenmask));
#define TK_SLOT(dst, k, bq, valid_odd) do { const unsigned pos_ = (unsigned)(16 * (2 * (k)) + (bq)) + hf16; unsigned kv_ = (key_enc(w1[k] + v2[bq]) & ~255u) | (255u - pos_); if (!(valid_odd)) kv_ &= evenmask; dst = kv_; } while (0)
        TK_SLOT(C[0], 0, 0, true);
        TK_SLOT(C[1], 0, 1, true);
        TK_SLOT(C[2], 0, 2, true);
        TK_SLOT(C[3], 0, 3, true);
        TK_SLOT(C[4], 0, 4, true);
        TK_SLOT(C[5], 0, 5, true);
        TK_SLOT(C[6], 0, 6, true);
        TK_SLOT(C[7], 0, 7, true);
        TK_SLOT(C[8], 0, 8, false);
        TK_SLOT(C[9], 0, 9, false);
        TK_SLOT(C[10], 0, 10, false);
        TK_SLOT(C[11], 0, 11, false);
        TK_SLOT(C[12], 0, 12, false);
        TK_SLOT(C[13], 0, 13, false);
        TK_SLOT(C[14], 0, 14, false);
        TK_SLOT(C[15], 0, 15, false);
        TK_SLOT(D[0], 1, 0, true);
        TK_SLOT(D[1], 1, 1, true);
        TK_SLOT(D[2], 1, 2, true);
        TK_SLOT(D[3], 1, 3, true);
        TK_SLOT(D[4], 1, 4, false);
        TK_SLOT(D[5], 2, 0, true);
        TK_SLOT(D[6], 2, 1, true);
        TK_SLOT(D[7], 2, 2, false);
        TK_SLOT(D[8], 3, 0, true);
        TK_SLOT(D[9], 3, 1, true);
        TK_SLOT(D[10], 4, 0, true);
        TK_SLOT(D[11], 5, 0, true);
        TK_SLOT(D[12], 6, 0, true);
        TK_SLOT(D[13], 7, 0, true);
        D[14] = 0u; D[15] = 0u;
#undef TK_SLOT
        tk_sort16(C); tk_sort16(D); tk_top16_merge(C, D); tk_pair_merge(C);
        LDS_WAIT(); asm volatile("" ::: "memory");
        float best[16], e[16], sum = 0.f;
#pragma unroll
        for (int q = 0; q < 16; ++q) { best[q] = key_dec((C[q] & ~255u) | 128u); e[q] = __expf(best[q] - best[0]); sum += e[q]; }
        const float inv = __builtin_amdgcn_rcpf(sum);
        LAS unsigned* IDX = oute + rl * 16 + 8 * hf; LAS float* GW = outg + rl * 16 + 8 * hf;
#pragma unroll
        for (int q = 0; q < 8; ++q) {
            const unsigned c = (C[q] & evenmask) | (C[8 + q] & ~evenmask);
            const float ev = __builtin_bit_cast(float, (__builtin_bit_cast(unsigned, e[q]) & evenmask) | (__builtin_bit_cast(unsigned, e[8 + q]) & ~evenmask));
            const unsigned pos = 255u - (c & 255u);
            IDX[q] = (unsigned)(il[pos >> 4] * 128 + il[16 + (pos & 15u)]); GW[q] = ev * inv;
        }
    }
    LDS_WAIT(); asm volatile("" ::: "memory");
}

typedef float f32x2 __attribute__((ext_vector_type(2)));
__device__ __forceinline__ unsigned q8(float x) { return (unsigned)(int)rintf(x) & 0xffu; }
__device__ __forceinline__ void cvt_table_fp8(const float* src, unsigned char* dst, float* scl, int gw, int ngw, int lane) {
    for (int row = gw; row < 16384; row += ngw) {
        const f32x4* sp = (const f32x4*)(src + (size_t)row * 1024 + 16 * lane);
        const f32x4 a0 = sp[0], a1 = sp[1], a2 = sp[2], a3 = sp[3];
        float m = fmaxf(fmaxf(fmaxf(fabsf(a0.x), fabsf(a0.y)), fmaxf(fabsf(a0.z), fabsf(a0.w))), fmaxf(fmaxf(fabsf(a1.x), fabsf(a1.y)), fmaxf(fabsf(a1.z), fabsf(a1.w))));
        m = fmaxf(m, fmaxf(fmaxf(fmaxf(fabsf(a2.x), fabsf(a2.y)), fmaxf(fabsf(a2.z), fabsf(a2.w))), fmaxf(fmaxf(fabsf(a3.x), fabsf(a3.y)), fmaxf(fabsf(a3.z), fabsf(a3.w)))));
#pragma unroll
        for (int o = 1; o < 64; o <<= 1) m = fmaxf(m, __shfl_xor(m, o));
        m = fmaxf(m, 1e-30f);
        const float q = 127.0f / m;
        v4u o;
        o.x = q8(a0.x * q) | (q8(a0.y * q) << 8) | (q8(a0.z * q) << 16) | (q8(a0.w * q) << 24);
        o.y = q8(a1.x * q) | (q8(a1.y * q) << 8) | (q8(a1.z * q) << 16) | (q8(a1.w * q) << 24);
        o.z = q8(a2.x * q) | (q8(a2.y * q) << 8) | (q8(a2.z * q) << 16) | (q8(a2.w * q) << 24);
        o.w = q8(a3.x * q) | (q8(a3.y * q) << 8) | (q8(a3.z * q) << 16) | (q8(a3.w * q) << 24);
        *(v4u*)(dst + (size_t)row * 1024 + 16 * lane) = o;
        if (lane == 0) scl[row] = m * (1.0f / 127.0f);
    }
}
__device__ __forceinline__ int row16_sum_i(int v) {
    v += __builtin_amdgcn_update_dpp(0, v, 0xB1, 0xF, 0xF, true);
    v += __builtin_amdgcn_update_dpp(0, v, 0x4E, 0xF, 0xF, true);
    v += __builtin_amdgcn_update_dpp(0, v, 0x141, 0xF, 0xF, true);
    v += __builtin_amdgcn_update_dpp(0, v, 0x140, 0xF, 0xF, true);
    return v;
}
constexpr int PE_NT = 4, PE_NR = 16, PE_SH = 10, PE_DEP = 3;
constexpr int PE_TOK_W = 128 * 3 + 20;
constexpr int PE_ENT_W = 272 * 4;
constexpr int PE_WAVE_W = PE_NT * PE_TOK_W + PE_ENT_W + 32 * 33 + 2 * PE_NT * 128;
static_assert(8 * PE_WAVE_W * 4 <= MISC_OFF && PE_NR * PE_NT == 64, "peer LDS / batch-list geometry");
#define PE_LD(dst, voff_, sbase_) asm volatile("s_nop 4\n\tglobal_load_dwordx4 %0, %1, %2" : "=&v"(dst) : "v"(voff_), "s"(sbase_) : "memory")
__device__ __forceinline__ void peer_pass(const Params& P, LAS unsigned char* lds, int tbase, int lane, int wave, float* dstbase, int emask = 0x3fff) {
    asm volatile("v_mbcnt_lo_u32_b32 %0, -1, 0\n\tv_mbcnt_hi_u32_b32 %0, -1, %0" : "=v"(lane));
    {
        LAS unsigned* lw0 = (LAS unsigned*)(lds) + wave * PE_WAVE_W + PE_NT * PE_TOK_W + PE_ENT_W;
        peer_topk_wave(P, (LAS int*)lw0, lw0 + 32 * 33, (LAS float*)(lw0 + 32 * 33 + PE_NT * 128), tbase, lane);
        LDS_WAIT(); asm volatile("" : "+v"(lane), "+s"(tbase) :: "memory");
    }
    const unsigned char* ws = P.ws;
    const unsigned char* UB8 = ws + WS_UB; const unsigned char* VB8 = ws + WS_VB;
    const float* USC = (const float*)(ws + WS_USC); const float* VSC = (const float*)(ws + WS_VSC);
    f32x2 acc[PE_NT][8];
    LAS unsigned* lw = (LAS unsigned*)(lds) + wave * PE_WAVE_W;
    LAS unsigned* ents = lw + PE_NT * PE_TOK_W;
    const unsigned voff = (unsigned)lane * 16u;
    LAS unsigned* upe = ents + PE_ENT_W + 32 * 33; LAS float* upg = (LAS float*)(upe + PE_NT * 128);
    LAS unsigned* hql = ents + PE_ENT_W;
#pragma unroll
    for (int j = 0; j < PE_NT; ++j) {
        const int t = tbase + j;
        const v4u* xrow = (const v4u*)((const bf16*)(ws + WS_XB) + (size_t)t * 1024 + 16 * lane);
        const v4u xa = xrow[0], xc = xrow[1];
        const f32x4 xvv[4] = {(f32x4){bflo(xa.x), bfhi(xa.x), bflo(xa.y), bfhi(xa.y)}, (f32x4){bflo(xa.z), bfhi(xa.z), bflo(xa.w), bfhi(xa.w)},
                              (f32x4){bflo(xc.x), bfhi(xc.x), bflo(xc.y), bfhi(xc.y)}, (f32x4){bflo(xc.z), bfhi(xc.z), bflo(xc.w), bfhi(xc.w)}};
        const float rstd2 = rsqrtf(((const float*)(ws + WS_SSQ2))[t] * (1.0f / 1024.0f) + 1e-6f);
        f32x4 hv[4]; float hm = 0.f;
#pragma unroll
        for (int i = 0; i < 4; ++i) { const f32x4 xv = xvv[i]; const f32x4 w = ((const f32x4*)(P.norm_ffn_w + 16 * lane))[i];
            hv[i] = (f32x4){xv.x * rstd2 * w.x, xv.y * rstd2 * w.y, xv.z * rstd2 * w.z, xv.w * rstd2 * w.w};
            hm = fmaxf(hm, fmaxf(fmaxf(fabsf(hv[i].x), fabsf(hv[i].y)), fmaxf(fabsf(hv[i].z), fabsf(hv[i].w)))); }
#pragma unroll
        for (int o = 1; o < 64; o <<= 1) hm = fmaxf(hm, __shfl_xor(hm, o));
        hm = fmaxf(hm, 1e-30f);
        const float hqs = 127.0f / hm, hs = hm * (1.0f / 127.0f);
        { unsigned hqv[4];
#pragma unroll
          for (int i = 0; i < 4; ++i) hqv[i] = q8(hv[i].x * hqs) | (q8(hv[i].y * hqs) << 8) | (q8(hv[i].z * hqs) << 16) | (q8(hv[i].w * hqs) << 24);
          *(LAS v4u*)(hql + (j * 64 + lane) * 4) = (v4u){hqv[0], hqv[1], hqv[2], hqv[3]}; }
#pragma unroll
        for (int i = 0; i < 8; ++i) acc[j][i] = (f32x2){0.f, 0.f};
        const int e0 = (int)upe[j * 128 + 2 * lane] & emask, e1 = (int)upe[j * 128 + 2 * lane + 1] & emask;
        const float g0 = upg[j * 128 + 2 * lane] * VSC[e0], g1 = upg[j * 128 + 2 * lane + 1] * VSC[e1];
        const float u0 = USC[e0] * hs, u1 = USC[e1] * hs;
        const int rev = (tbase >= T / 2) ? (PE_NR - 1) : 0;
        const int b0 = (e0 >> PE_SH) ^ rev, b1 = (e1 >> PE_SH) ^ rev;
        LAS unsigned* lt = lw + j * PE_TOK_W;
        int run = 0, p0 = 0, p1 = 0;
        unsigned mystart = 0;
#pragma unroll
        for (int bk = 0; bk < PE_NR; ++bk) {
            const unsigned long long m0 = __ballot(b0 == bk), m1 = __ballot(b1 == bk);
            const int c0 = __popcll(m0), c1 = __popcll(m1);
            const int r0 = (int)__builtin_amdgcn_mbcnt_hi((unsigned)(m0 >> 32), __builtin_amdgcn_mbcnt_lo((unsigned)m0, 0u));
            const int r1 = (int)__builtin_amdgcn_mbcnt_hi((unsigned)(m1 >> 32), __builtin_amdgcn_mbcnt_lo((unsigned)m1, 0u));
            p0 = (b0 == bk) ? run + r0 : p0;
            p1 = (b1 == bk) ? run + c0 + r1 : p1;
            mystart = (lane == bk) ? (unsigned)run : mystart;
            run += c0 + c1;
        }
        lt[p0] = (unsigned)e0; lt[128 + p0] = __builtin_bit_cast(unsigned, g0); lt[256 + p0] = __builtin_bit_cast(unsigned, u0);
        lt[p1] = (unsigned)e1; lt[128 + p1] = __builtin_bit_cast(unsigned, g1); lt[256 + p1] = __builtin_bit_cast(unsigned, u1);
        if (lane < PE_NR) lt[384 + lane] = mystart;
        if (lane == 0) lt[384 + PE_NR] = 128u;
        asm volatile("" ::: "memory");
    }
    LDS_WAIT(); asm volatile("" ::: "memory");
    int nb;
    {
        const int rd = lane >> 2, j = (rd & 1) ? 3 - (lane & 3) : (lane & 3);
        const LAS unsigned* lt = lw + j * PE_TOK_W;
        const int n0 = (int)lt[384 + rd], n1 = (int)lt[384 + rd + 1];
        const int nbl = (n1 - n0 + 3) >> 2;
        int inc = nbl;
#pragma unroll
        for (int off = 1; off < 64; off <<= 1) { const int tv = __shfl_up(inc, off); if (lane >= off) inc += tv; }
        nb = __builtin_amdgcn_readlane(inc, 63);
        const int ofs = inc - nbl;
#pragma unroll 1
        for (int q = 0; q < nbl; ++q) { const int i0 = n0 + 4 * q, c = (n1 - i0) < 4 ? (n1 - i0) : 4;
            const unsigned e0 = lt[i0], e1 = lt[i0 + (c > 1 ? 1 : c - 1)], e2 = lt[i0 + (c > 2 ? 2 : c - 1)], e3 = lt[i0 + (c > 3 ? 3 : c - 1)];
            *(LAS v4u*)(ents + 4 * (ofs + q)) = (v4u){e0 | (((unsigned)j | ((unsigned)c << 2) | ((unsigned)i0 << 5)) << 14), e1, e2, e3}; }
        if (lane < 2 * PE_DEP) *(LAS v4u*)(ents + 4 * (nb + lane)) = (v4u){0u, 0u, 0u, 0u};
    }
    LDS_WAIT(); asm volatile("" ::: "memory");
    v4u ru[PE_DEP][4], rv[PE_DEP][4];
#define PE_LDO(dst, vo_, sbase_) asm volatile("global_load_dwordx4 %0, %1, %2" : "=&v"(dst) : "v"(vo_), "s"(sbase_) : "memory")
#define PE_ISSUE(S, rec_) do { const unsigned e0_ = (rec_).x & 0x3fffu; \
        { const unsigned vo_ = (e0_ << 10) + voff; PE_LDO(ru[S][0], vo_, UB8); PE_LDO(rv[S][0], vo_, VB8); } \
        { const unsigned vo_ = ((rec_).y << 10) + voff; PE_LDO(ru[S][1], vo_, UB8); PE_LDO(rv[S][1], vo_, VB8); } \
        { const unsigned vo_ = ((rec_).z << 10) + voff; PE_LDO(ru[S][2], vo_, UB8); PE_LDO(rv[S][2], vo_, VB8); } \
        { const unsigned vo_ = ((rec_).w << 10) + voff; PE_LDO(ru[S][3], vo_, UB8); PE_LDO(rv[S][3], vo_, VB8); } } while (0)
#define PE_WAIT8(S, cntstr) asm volatile("s_waitcnt " cntstr : "+v"(ru[S][0]), "+v"(ru[S][1]), "+v"(ru[S][2]), "+v"(ru[S][3]), "+v"(rv[S][0]), "+v"(rv[S][1]), "+v"(rv[S][2]), "+v"(rv[S][3]) :: "memory")
#define PE_UDOTS(S) asm("v_dot4_i32_i8 %0, %4, %20, 0\n\tv_dot4_i32_i8 %1, %8, %20, 0\n\tv_dot4_i32_i8 %2, %12, %20, 0\n\tv_dot4_i32_i8 %3, %16, %20, 0\n\t" \
                        "v_dot4_i32_i8 %0, %5, %21, %0\n\tv_dot4_i32_i8 %1, %9, %21, %1\n\tv_dot4_i32_i8 %2, %13, %21, %2\n\tv_dot4_i32_i8 %3, %17, %21, %3\n\t" \
                        "v_dot4_i32_i8 %0, %6, %22, %0\n\tv_dot4_i32_i8 %1, %10, %22, %1\n\tv_dot4_i32_i8 %2, %14, %22, %2\n\tv_dot4_i32_i8 %3, %18, %22, %3\n\t" \
                        "v_dot4_i32_i8 %0, %7, %23, %0\n\tv_dot4_i32_i8 %1, %11, %23, %1\n\tv_dot4_i32_i8 %2, %15, %23, %2\n\tv_dot4_i32_i8 %3, %19, %23, %3\n\ts_nop 2" \
        : "=&v"(d_[0]), "=&v"(d_[1]), "=&v"(d_[2]), "=&v"(d_[3]) \
        : "v"(ru[S][0].x), "v"(ru[S][0].y), "v"(ru[S][0].z), "v"(ru[S][0].w), "v"(ru[S][1].x), "v"(ru[S][1].y), "v"(ru[S][1].z), "v"(ru[S][1].w), \
          "v"(ru[S][2].x), "v"(ru[S][2].y), "v"(ru[S][2].z), "v"(ru[S][2].w), "v"(ru[S][3].x), "v"(ru[S][3].y), "v"(ru[S][3].z), "v"(ru[S][3].w), \
          "v"(hcur.x), "v"(hcur.y), "v"(hcur.z), "v"(hcur.w))
#define PE_UDOTS_SAFE(S) do { _Pragma("unroll") for (int k_ = 0; k_ < 4; ++k_) { int s_ = __builtin_amdgcn_sdot4((int)ru[S][k_].x, (int)hcur.x, 0, false); s_ = __builtin_amdgcn_sdot4((int)ru[S][k_].y, (int)hcur.y, s_, false); \
            s_ = __builtin_amdgcn_sdot4((int)ru[S][k_].z, (int)hcur.z, s_, false); s_ = __builtin_amdgcn_sdot4((int)ru[S][k_].w, (int)hcur.w, s_, false); d_[k_] = s_; } } while (0)
#define PE_VDOTS_SAFE(f0, f1, f2, f3, b0, b1, b2, b3, w) do { f0 = (float)__builtin_amdgcn_sdot4((int)(b0), (int)(w), 0, false); f1 = (float)__builtin_amdgcn_sdot4((int)(b1), (int)(w), 0, false); \
            f2 = (float)__builtin_amdgcn_sdot4((int)(b2), (int)(w), 0, false); f3 = (float)__builtin_amdgcn_sdot4((int)(b3), (int)(w), 0, false); } while (0)
#define PE_VDOTS(f0, f1, f2, f3, b0, b1, b2, b3, w) asm("v_dot4_i32_i8 %0, %4, %8, 0\n\tv_dot4_i32_i8 %1, %5, %8, 0\n\tv_dot4_i32_i8 %2, %6, %8, 0\n\tv_dot4_i32_i8 %3, %7, %8, 0\n\t" \
                        "v_cvt_f32_i32_e32 %0, %0\n\tv_cvt_f32_i32_e32 %1, %1\n\tv_cvt_f32_i32_e32 %2, %2\n\tv_cvt_f32_i32_e32 %3, %3" \
        : "=&v"(f0), "=&v"(f1), "=&v"(f2), "=&v"(f3) : "v"(b0), "v"(b1), "v"(b2), "v"(b3), "v"(w))
#define PE_COMPUTE_B(S, c_, i_, j_, SG) do { const LAS unsigned* lt_ = lw + (j_) * PE_TOK_W; \
        const int myk_ = lane >> 4; \
        float gsc_ = __builtin_bit_cast(float, lt_[128 + i_ + myk_]), usc_ = __builtin_bit_cast(float, lt_[256 + i_ + myk_]);     \
        int d_[4]; \
        PE_UDOTS(S); \
        int r1_; \
        { const v2u p02_ = __builtin_amdgcn_permlane32_swap((unsigned)d_[0], (unsigned)d_[2], false, false), p13_ = __builtin_amdgcn_permlane32_swap((unsigned)d_[1], (unsigned)d_[3], false, false); \
          const v2u q_ = __builtin_amdgcn_permlane16_swap(p02_.x + p02_.y, p13_.x + p13_.y, false, false); r1_ = row16_sum_i((int)(q_.x + q_.y)); }     \
        float act_; \
        { const float x_ = (float)r1_ * usc_, e_ = __builtin_amdgcn_exp2f(x_ * __builtin_fmaf(x_ * x_, -0.10294324f, -2.3022082f));     \
          act_ = x_ * __builtin_amdgcn_rcpf(1.0f + e_) * gsc_; act_ = (myk_ < c_) ? act_ : 0.f; } \
        float wm_; \
        { unsigned wmu_ = __builtin_bit_cast(unsigned, act_) & 0x7fffffffu;                 \
          v2u t_ = __builtin_amdgcn_permlane32_swap(wmu_, wmu_, false, false); wmu_ = t_.x > t_.y ? t_.x : t_.y; \
          t_ = __builtin_amdgcn_permlane16_swap(wmu_, wmu_, false, false); wmu_ = t_.x > t_.y ? t_.x : t_.y; \
          wm_ = fmaxf(__builtin_bit_cast(float, wmu_), 1e-30f); } \
        const float wq_ = 127.0f * __builtin_amdgcn_rcpf(wm_), ws_ = (SG) * wm_ * (1.0f / 127.0f); \
        unsigned w4u_ = (__builtin_bit_cast(unsigned, __builtin_fmaf(act_, wq_, 12582912.0f)) & 0xffu) << (8 * myk_); \
        { v2u t_ = __builtin_amdgcn_permlane32_swap(w4u_, w4u_, false, false); w4u_ = t_.x | t_.y; t_ = __builtin_amdgcn_permlane16_swap(w4u_, w4u_, false, false); w4u_ = t_.x | t_.y; } \
        const f32x2 ws2_ = (f32x2){ws_, ws_}; \
        _Pragma("unroll") for (int m_ = 0; m_ < 4; ++m_) { \
            const unsigned R0_ = rv[S][0][m_], R1_ = rv[S][1][m_], R2_ = rv[S][2][m_], R3_ = rv[S][3][m_]; \
            const unsigned X_ = __builtin_amdgcn_perm(R1_, R0_, 0x05010400u), Y_ = __builtin_amdgcn_perm(R1_, R0_, 0x07030602u), Z_ = __builtin_amdgcn_perm(R3_, R2_, 0x05010400u), W_ = __builtin_amdgcn_perm(R3_, R2_, 0x07030602u); \
            float t0_, t1_, t2_, t3_; \
            const unsigned b0_ = __builtin_amdgcn_perm(Z_, X_, 0x05040100u), b1_ = __builtin_amdgcn_perm(Z_, X_, 0x07060302u), b2_ = __builtin_amdgcn_perm(W_, Y_, 0x05040100u), b3_ = __builtin_amdgcn_perm(W_, Y_, 0x07060302u); \
            PE_VDOTS(t0_, t1_, t2_, t3_, b0_, b1_, b2_, b3_, w4u_); \
            cur[2 * m_] = __builtin_elementwise_fma((f32x2){t0_, t1_}, ws2_, cur[2 * m_]); \
            cur[2 * m_ + 1] = __builtin_elementwise_fma((f32x2){t2_, t3_}, ws2_, cur[2 * m_ + 1]); } } while (0)
#define PE_FLUSH() do { _Pragma("unroll") for (int J_ = 0; J_ < PE_NT; ++J_) { const float sel_ = (jcur == J_) ? 1.0f : 0.0f; const f32x2 sel2_ = (f32x2){sel_, sel_};     \
            _Pragma("unroll") for (int i_ = 0; i_ < 8; ++i_) acc[J_][i_] = __builtin_elementwise_fma(cur[i_], sel2_, acc[J_][i_]); } \
        _Pragma("unroll") for (int i_ = 0; i_ < 8; ++i_) cur[i_] = (f32x2){0.f, 0.f}; } while (0)
#define PE_COMPUTE_S(S, entv, SG) do { const unsigned en_ = (entv) >> 14; const int jj_ = (int)(en_ & 3u), cc_ = (int)((en_ >> 2) & 7u), ii_ = (int)(en_ >> 5); \
        if (cc_ > 0) { if (jj_ != jcur) { PE_FLUSH(); jcur = jj_; hcur = *(const LAS v4u*)(hql + (jj_ * 64 + lane) * 4); } \
                       PE_COMPUTE_B(S, cc_, ii_, jj_, SG); } } while (0)
#ifdef PE_VALU3
#define PE_COMPUTE(S, entv) do { PE_COMPUTE_S(S, entv, 1.0f); PE_WAIT8(S, "vmcnt(16)"); PE_COMPUTE_S(S, entv, -1.0f); PE_WAIT8(S, "vmcnt(16)"); PE_COMPUTE_S(S, entv, 1.0f); } while (0)
#else
#define PE_COMPUTE(S, entv) PE_COMPUTE_S(S, entv, 1.0f)
#endif
    {
        unsigned er[PE_DEP];
#pragma unroll
        for (int q = 0; q < PE_DEP; ++q) { const v4u rec = *(const LAS v4u*)(ents + 4 * q); er[q] = __builtin_amdgcn_readfirstlane(rec.x); PE_ISSUE(q, rec); }
        f32x2 cur[8];
#pragma unroll
        for (int i = 0; i < 8; ++i) cur[i] = (f32x2){0.f, 0.f};
        int jcur = (int)((er[0] >> 14) & 3u);
        v4u hcur = *(const LAS v4u*)(hql + (jcur * 64 + lane) * 4);
        v4u nrec = *(const LAS v4u*)(ents + 4 * PE_DEP);
#pragma unroll 1
        for (int bi = 0; bi < nb; bi += PE_DEP) {
#pragma unroll
            for (int q = 0; q < PE_DEP; ++q) {
                PE_WAIT8(q, "vmcnt(16)");
                PE_COMPUTE(q, er[q]);
                er[q] = __builtin_amdgcn_readfirstlane(nrec.x);
                PE_ISSUE(q, nrec);
                nrec = *(const LAS v4u*)(ents + 4 * (bi + q + PE_DEP + 1));
            }
        }
#pragma unroll
        for (int q = 0; q < PE_DEP; ++q) PE_WAIT8(q, "vmcnt(0)");
        PE_FLUSH();
    }
#undef PE_COMPUTE
#undef PE_COMPUTE_S
#undef PE_COMPUTE_B
#undef PE_FLUSH
#undef PE_WAIT8
#undef PE_ISSUE
#undef PE_LDO
#undef PE_UDOTS
#undef PE_VDOTS
    asm volatile("v_mbcnt_lo_u32_b32 %0, -1, 0\n\tv_mbcnt_hi_u32_b32 %0, -1, %0" : "=v"(lane)); asm volatile("" : "+s"(tbase));
#pragma unroll
    for (int j = 0; j < PE_NT; ++j) {
        const int t = tbase + j;
        float ss = 0.f; f32x4 xo[4];
        { const v4u* xrow = (const v4u*)((const bf16*)(ws + WS_XB) + (size_t)t * 1024 + 16 * lane); const v4u xa = xrow[0], xc = xrow[1];
          xo[0] = (f32x4){bflo(xa.x), bfhi(xa.x), bflo(xa.y), bfhi(xa.y)}; xo[1] = (f32x4){bflo(xa.z), bfhi(xa.z), bflo(xa.w), bfhi(xa.w)};
          xo[2] = (f32x4){bflo(xc.x), bfhi(xc.x), bflo(xc.y), bfhi(xc.y)}; xo[3] = (f32x4){bflo(xc.z), bfhi(xc.z), bflo(xc.w), bfhi(xc.w)}; }
#pragma unroll
        for (int i = 0; i < 4; ++i) { xo[i].x += acc[j][2 * i].x; xo[i].y += acc[j][2 * i].y; xo[i].z += acc[j][2 * i + 1].x; xo[i].w += acc[j][2 * i + 1].y;
            ss += (xo[i].x * xo[i].x + xo[i].y * xo[i].y) + (xo[i].z * xo[i].z + xo[i].w * xo[i].w); }
        const float rstd3 = rsqrtf(wave_sum(ss) * (1.0f / 1024.0f) + 1e-6f);
        float* orow = dstbase + (size_t)t * 1024 + 16 * lane;
#pragma unroll
        for (int i = 0; i < 4; ++i) { const f32x4 w = ((const f32x4*)(P.norm_final_w + 16 * lane))[i];
            ((f32x4*)orow)[i] = (f32x4){xo[i].x * rstd3 * w.x, xo[i].y * rstd3 * w.y, xo[i].z * rstd3 * w.z, xo[i].w * rstd3 * w.w}; }
    }
    LDS_WAIT(); asm volatile("s_waitcnt vmcnt(0)" ::: "memory");
}


#ifndef TWICE_MASK
#define TWICE_MASK 0
#endif
struct TwiceOrder { pg8::StaticOrder S; int per, reps;
    __device__ bool next(int i, pg8::Unit& u) const { if (i >= per * reps) return false; return S.next(i % per, u); }
    __device__ __forceinline__ void a_ready(const pg8::Unit&) const {} __device__ __forceinline__ void done(const pg8::Unit&) const {} };
template <class B> __device__ __forceinline__ bool rep_again(volatile LAS unsigned* MISC, B& bar) {
    __syncthreads(); const unsigned c = MISC[20]; __syncthreads();
    if (threadIdx.x == 0) MISC[20] = c ^ 1u;
    __syncthreads();
    if (c == 0u) { xcd_barrier(bar); return true; }
    return false;
}
__global__ void __launch_bounds__(NWAVES * 64, 2) hybrid_fwd(Params P) {
    extern __shared__ __attribute__((aligned(16))) unsigned char lds_raw[];
    LAS unsigned char* lds = (LAS unsigned char*)lds_raw;
    volatile LAS unsigned* MISC = (volatile LAS unsigned*)(lds + MISC_OFF);
    const int tid = threadIdx.x, lane = tid & 63, wave = __builtin_amdgcn_readfirstlane(tid >> 6);
    const int G = gridDim.x, bx = blockIdx.x;
    const int vcu = (G % 8 == 0) ? (bx % 8) * (G / 8) + bx / 8 : bx;
    unsigned char* ws = P.ws;
    for (int u = tid; u < 64; u += NWAVES * 64) MISC[u] = 0u;
    __syncthreads();
    XcdBarrier bar; bar.bar = (unsigned*)(ws + WS_CTL) + CW_BAR; bar.x = 0; bar.st = nullptr;
    if (!MK_PER_PHASE) bar = xcd_barrier_post((unsigned*)(ws + WS_CTL) + CW_BAR, MISC + 8);
    const int lo = P.ph_lo, hi = P.ph_hi;
#ifndef PHASE_MASK
#define PHASE_MASK 0xFFF
#endif
#define IN(k) (((PHASE_MASK >> (k)) & 1) && lo <= (k) && (k) < hi)
#define SEAM(k) do { if (IN(k) && IN((k) + 1)) xcd_barrier(bar); } while (0)
#ifndef REP_MASK
#define REP_MASK 0
#endif
#ifndef PE_EXP_MASK
#define PE_EXP_MASK 0x3fff
#endif
#define REPS(k) for (bool again_ = true; again_; again_ = (((REP_MASK >> (k)) & 1) ? rep_again(MISC, bar) : false))
    using namespace pg8;
    bf16* XB = (bf16*)(ws + WS_XB);

    if (IN(0)) REPS(0) { p0_prologue(P, lds, tid, lane, wave, vcu, G); }
    SEAM(0);
    if (IN(1)) REPS(1) {
        { Gemm gm{XB, (const bf16_t*)(ws + WS_WIN), T, 3072, 1024}; StaticOrder S; S.init(T, 3072, G, bx);
          EpiBf16Rs E{(bf16_t*)(ws + WS_QKV), 1536, 6, (bf16_t*)(ws + WS_XR), 512, (size_t)T * 512, nullptr, 1.0f};
          gemm_phase<EpiBf16Rs, StaticOrder, PG8_ALIGN, PG8_SP2>(lds, gm, S, E); }
    }
    SEAM(1);
    if (IN(3)) REPS(3) {
        if (bx < SCAN_WGS) gdn_scan(P, lds, bx, tid, lane, wave);
        else {
            const int wk = bx - SCAN_WGS, NWK = G - SCAN_WGS;
            unsigned* lcnt = (unsigned*)(ws + WS_CTL) + CW_LRUCNT;
            for (int q = wk; q < 1024; q += NWK) gdn_local_item(P, lds, (q & 7) * 128 + (q >> 3), tid);
            unsigned ndone = 0;
            for (int lt = wk; lt < 256; lt += NWK) { lru_local_item(P, lds, lt, tid, lane, wave); ++ndone; }
            asm volatile("s_waitcnt vmcnt(0)" ::: "memory");
            __syncthreads();
            if (tid == 0 && ndone) { __builtin_amdgcn_fence(__ATOMIC_RELEASE, "agent"); asm volatile("s_waitcnt vmcnt(0)" ::: "memory");
                                     __hip_atomic_fetch_add(lcnt, ndone, __ATOMIC_RELAXED, __HIP_MEMORY_SCOPE_AGENT); }
            if (wk < 16) {
                struct OneUnit { int pm, pn; __device__ bool next(int i, Unit& u) const { if (i > 0) return false; u.pm = pm; u.pn = pn; return true; }
                                 __device__ void a_ready(const Unit&) const {} __device__ void done(const Unit&) const {} };
                Gemm gm{(const bf16_t*)(ws + WS_MEMN), (const bf16_t*)(ws + WS_WKV), 512, 2048, 1024}; OneUnit S{wk >> 3, wk & 7};
                EpiKV E{(bf16_t*)(ws + WS_KB), (bf16_t*)(ws + WS_VTP)};
                gemm_phase<EpiKV, OneUnit, PG8_ALIGN, PG8_SP2>(lds, gm, S, E);
            }
            if (wk == 16 || wk == 17) {
                if (tid == 0) { unsigned sp = 0;
                    while (__hip_atomic_load(lcnt, __ATOMIC_RELAXED, __HIP_MEMORY_SCOPE_AGENT) < 256u) { __builtin_amdgcn_s_sleep(8); if (++sp > (1u << 22)) break; }
                    __builtin_amdgcn_fence(__ATOMIC_ACQUIRE, "agent"); asm volatile("s_waitcnt vmcnt(0)" ::: "memory"); }
                __syncthreads();
                lru_carry(P, (wk - 16) * NWAVES + wave, lane);
                asm volatile("s_waitcnt vmcnt(0)" ::: "memory");
                __syncthreads();
                if (tid == 0) { __builtin_amdgcn_fence(__ATOMIC_RELEASE, "agent"); asm volatile("s_waitcnt vmcnt(0)" ::: "memory");
                                __hip_atomic_fetch_add(lcnt + 64, 1u, __ATOMIC_RELAXED, __HIP_MEMORY_SCOPE_AGENT); }
            } else {
                const int w2 = (wk < 16 ? wk : wk - 2), N2 = NWK - 2;
                cvt_table_fp8(P.peer_v, ws + WS_VB, (float*)(ws + WS_VSC), w2 * NWAVES + wave, N2 * NWAVES, lane);
                late_weight_prep(P, lds, lane, wave, w2 * NWAVES + wave, N2 * NWAVES);
                if (tid == 0) { unsigned sp = 0;
                    while (__hip_atomic_load(lcnt + 64, __ATOMIC_RELAXED, __HIP_MEMORY_SCOPE_AGENT) < 2u) { __builtin_amdgcn_s_sleep(8); if (++sp > (1u << 22)) break; }
                    __builtin_amdgcn_fence(__ATOMIC_ACQUIRE, "agent"); asm volatile("s_waitcnt vmcnt(0)" ::: "memory"); }
                __syncthreads();
                lru_combine(P, (size_t)w2 * (NWAVES * 64) + tid, (size_t)N2 * (NWAVES * 64));
            }
        }
    }
    SEAM(3);
    if (IN(4)) REPS(4) {
        gdn_gate_norm(P, (size_t)bx * (NWAVES * 64) + tid, (size_t)G * (NWAVES * 64));
        cvt_table_fp8(P.peer_u, ws + WS_UB, (float*)(ws + WS_USC), bx * NWAVES + wave, G * NWAVES, lane);
    }
    SEAM(4);
    if (IN(5)) {
        Gemm gm{(const bf16_t*)((const unsigned char*)P.out + OUT_Y), (const bf16_t*)(ws + WS_WOUT), T, 1024, 1024}; StaticOrder S; S.init(T, 1024, G, bx);
        EpiResidBf<true> E{P.x, XB, (float*)(ws + WS_SSQ1)};
        gemm_phase<EpiResidBf<true>, StaticOrder, PG8_ALIGN, PG8_SP2>(lds, gm, S, E);
    }
    SEAM(5);
    if (IN(6)) REPS(6) {
        Gemm gm{XB, (const bf16_t*)(ws + WS_WQ), T, 1024, 1024};
        EpiBf16Rs E{(bf16_t*)(ws + WS_Q), 1024, 4, nullptr, 256, 0, (const float*)(ws + WS_SSQ1), 0.0625f};
#if (TWICE_MASK >> 6) & 1
        { TwiceOrder S; S.S.init(T, 1024, G, bx); S.per = 1; S.reps = 2;
          gemm_phase<EpiBf16Rs, TwiceOrder, PG8_ALIGN, PG8_SP2>(lds, gm, S, E); }
#else
        { StaticOrder S; S.init(T, 1024, G, bx);
          gemm_phase<EpiBf16Rs, StaticOrder, PG8_ALIGN, PG8_SP2>(lds, gm, S, E); }
#endif
        Unit u;
        { const int wgid = (bx & 7) * 32 + (bx >> 3); u.pm = (wgid >> 5) * 8 + (wgid & 7); u.pn = (wgid & 31) >> 3; }
        if (G == 256) {
            asm volatile("s_waitcnt vmcnt(0)" ::: "memory");
            __syncthreads();
            const int b = u.pm >> 5, qb0 = (u.pm & 31) * 2, h = u.pn;
#pragma unroll 1
            for (int qq = 0; qq < (((TWICE_MASK >> 7) & 1) ? 4 : 2); qq += XA_NPS) xattn_unit(P, lds, (b << 8) | ((qb0 + (qq & 1)) << 2) | h, tid, lane, wave);
        }
    }
    if (IN(7)) REPS(7) { }
    SEAM(7);
    if (IN(8)) {
        Gemm gm{(const bf16_t*)(ws + WS_AO), (const bf16_t*)(ws + WS_WO), T, 1024, 1024}; StaticOrder S; S.init(T, 1024, G, bx);
        EpiResidBf<false> E{nullptr, XB, (float*)(ws + WS_SSQ2)};
        gemm_phase<EpiResidBf<false>, StaticOrder, PG8_ALIGN, PG8_SP2>(lds, gm, S, E);
    }
    SEAM(8);
    if (IN(9)) REPS(9) {
        Gemm gm{XB, (const bf16_t*)(ws + WS_PWQ), T, 2048, 1024};
        EpiF16Rs E{(_Float16*)(ws + WS_PQ), 2048, (const float*)(ws + WS_SSQ2)};
#if (TWICE_MASK >> 9) & 1
        TwiceOrder S; S.S.init(T, 2048, G, bx); S.per = 2; S.reps = 2;
        gemm_phase<EpiF16Rs, TwiceOrder, PG8_ALIGN, PG8_SP2>(lds, gm, S, E);
#else
        StaticOrder S; S.init(T, 2048, G, bx);
        gemm_phase<EpiF16Rs, StaticOrder, PG8_ALIGN, PG8_SP2>(lds, gm, S, E);
#endif
    }
    SEAM(9);
    if (IN(10)) REPS(10) {
    }
    if (IN(11)) REPS(11) {
#if (TWICE_MASK >> 11) & 1
        for (int it = 0; it < 4; ++it) { const int tb = (bx * NWAVES + wave) * PE_NT + (it >> 1) * (G * NWAVES * PE_NT); if (tb < T) peer_pass(P, lds, tb, lane, wave, P.out, (it & 1) ? 0x3fff : PE_EXP_MASK); }
#else
#ifndef PE_PASS_BARRIER
#define PE_PASS_BARRIER 0
#endif
        for (int tb = (bx * NWAVES + wave) * PE_NT, np = 0; tb < T; tb += G * NWAVES * PE_NT, ++np) {
            if (PE_PASS_BARRIER && np > 0 && (T % (G * NWAVES * PE_NT)) == 0) xcd_barrier(bar);
            peer_pass(P, lds, tb, lane, wave, P.out);
        }
#endif
    }
#undef IN
#undef SEAM
}

extern "C" void kernel_launch(void* const* d_in, const int* in_sizes, int n_in, void* d_out, int out_size, void* d_ws, size_t ws_size, hipStream_t stream) {
    static int grid = 0;
    if (grid == 0) {
        if (n_in != 27 || in_sizes[0] != T * D || out_size != T * D || ws_size < WS_END) {
            fprintf(stderr, "kernel_launch: unexpected shapes (n_in %d, in0 %d, out %d, ws %zu); nothing launched\n", n_in, n_in > 0 ? in_sizes[0] : -1, out_size, ws_size); grid = -1; return; }
        int dev = 0, cus = 0, per_cu = 0;
        if (hipGetDevice(&dev) != hipSuccess || hipDeviceGetAttribute(&cus, hipDeviceAttributeMultiprocessorCount, dev) != hipSuccess) { grid = -1; return; }
        if (hipFuncSetAttribute((const void*)hybrid_fwd, hipFuncAttributeMaxDynamicSharedMemorySize, LDS_BYTES) != hipSuccess) { fprintf(stderr, "kernel_launch: hipFuncSetAttribute failed\n"); grid = -1; return; }
        if (hipOccupancyMaxActiveBlocksPerMultiprocessor(&per_cu, (const void*)hybrid_fwd, NWAVES * 64, LDS_BYTES) != hipSuccess || per_cu < 1)
            fprintf(stderr, "kernel_launch: note: occupancy query reports %d workgroups per CU\n", per_cu);
        (void)hipGetLastError();
        grid = cus;
        if (grid != 256) fprintf(stderr, "kernel_launch: %d CUs (built for 256)\n", grid);
    }
    if (grid < 0) return;
    if (hipMemsetAsync((char*)d_ws + WS_CTL, 0, CTL_ZERO_BYTES, stream) != hipSuccess) { fprintf(stderr, "kernel_launch: hipMemsetAsync failed\n"); return; }
    Params p{};
    const float** pp = (const float**)&p;
    for (int i = 0; i < 27; ++i) pp[i] = (const float*)d_in[i];
    p.out = (float*)d_out; p.ws = (unsigned char*)d_ws;
#if MK_PER_PHASE
    for (int k = 0; k < N_PHASES; ++k) { p.ph_lo = k; p.ph_hi = k + 1; hipLaunchKernelGGL(hybrid_fwd, dim3(grid), dim3(NWAVES * 64), LDS_BYTES, stream, p); }
#else
    p.ph_lo = 0; p.ph_hi = N_PHASES;
    hipLaunchKernelGGL(hybrid_fwd, dim3(grid), dim3(NWAVES * 64), LDS_BYTES, stream, p);
#endif
    const hipError_t le = hipPeekAtLastError();
    if (le != hipSuccess) fprintf(stderr, "kernel_launch: launch failed: %s\n", hipGetErrorName(le));
}
```

```cpp
#include <hip/hip_runtime.h>
#include <cstdio>
#include <cstdint>
namespace pg8 {
#define PG8_LAS __attribute__((address_space(3)))
typedef unsigned short bf16_t;
typedef short bf16x8 __attribute__((ext_vector_type(8)));
typedef float f32x4 __attribute__((ext_vector_type(4)));
typedef unsigned u32x4 __attribute__((ext_vector_type(4)));
constexpr int BM = 256, BK = 64, HALF = 128, HTB = HALF * BK * 2  , STAGE_BYTES = 8 * HTB, NXCD = 8, WGM = 8;

__host__ __device__ __forceinline__ int lds_byte(int r, int c) { const int st = (r >> 4) * 2 + (c >> 5), rr = r & 15, cc = c & 31, ob = rr * 64 + cc * 2; return st * 1024 + (ob ^ (((ob >> 9) & 1) << 5)); }
__host__ __device__ __forceinline__ void stage_rc(int b, int& R, int& C) { const int st = b / 1024, sb = b % 1024, swz = sb ^ (((sb >> 9) & 1) << 5); R = (st >> 1) * 16 + swz / 64; C = (st & 1) * 32 + (swz % 64) / 2; }
__host__ __device__ __forceinline__ int perm32(int rho) { const int n = rho >> 4, i = rho & 15; return 8 * (i >> 2) + 4 * n + (i & 3); }

struct Unit { int pm, pn; };
struct Gemm { const bf16_t* A; const bf16_t* Bt; int M, N, K; };

struct StaticOrder {
    int nM, nN, nwg, G, c;
    __host__ __device__ void init(int M, int N, int G_, int c_) { nM = M / BM; nN = N / BM; nwg = nM * nN; G = G_; c = c_; }
    __host__ __device__ bool next(int i, Unit& u) const {
        const long L = (long)i * G + c; if (L >= nwg) return false;
        int wgid = (int)L; { const int q = nwg / NXCD, r = nwg % NXCD, xcd = wgid % NXCD, off = wgid / NXCD; wgid = (xcd < r ? xcd * (q + 1) : r * (q + 1) + (xcd - r) * q) + off; }
        const int nig = WGM * nN, gid = wgid / nig, fm = gid * WGM, gsz = (nM - fm) < WGM ? (nM - fm) : WGM;
        u.pm = fm + ((wgid % nig) % gsz); u.pn = (wgid % nig) / gsz; return true;
    }
    __device__ __forceinline__ void a_ready(const Unit&) const {}
    __device__ __forceinline__ void done(const Unit&) const {}
};

__device__ __forceinline__ unsigned cvt_pk_bf16(float lo, float hi) { unsigned r; asm volatile("v_cvt_pk_bf16_f32 %0, %1, %2" : "=v"(r) : "v"(lo), "v"(hi)); return r; }
template <class Epi, class Sched, bool ALIGN_EPI = false, bool SP2 = false>
__device__ __forceinline__ void gemm_phase(PG8_LAS unsigned char* lds, const Gemm g, const Sched& S, const Epi& E) {
    const int tid = threadIdx.x, wid = __builtin_amdgcn_readfirstlane(tid >> 6), lane = tid & 63, wr = wid >> 2, wc = wid & 3, fr = lane & 15, fq = lane >> 4;
    const int K = g.K, nt = K / BK;
    unsigned voffA[2], voffB[2];
#pragma unroll
    for (int i = 0; i < 2; ++i) { int R, C; stage_rc(tid * 16 + i * 8192, R, C); const int Rb = Epi::PERM ? ((R & ~31) + perm32(R & 31)) : R;
        voffA[i] = (unsigned)(R * K + C) * 2u; voffB[i] = (unsigned)(Rb * K + C) * 2u; }
    const size_t kstep = (size_t)(BK * 2);
    const size_t hstep = (size_t)HALF * K * 2;
    const size_t tstep = 2 * hstep;
    const unsigned ldsw = (unsigned)wid * 1024u;
    const int aoff = lds_byte(wr * 64 + fr, fq * 8), boff = lds_byte(wc * 32 + fr, fq * 8);
#define PG8_SA(b, h) (((b) * 2 + (h)) * HTB)
#define PG8_SB(b, h) ((4 + (b) * 2 + (h)) * HTB)
#define PG8_STAGE(bufoff, gbase, voff) do { _Pragma("unroll") for (int _i = 0; _i < 2; ++_i) \
        __builtin_amdgcn_global_load_lds((const unsigned*)((const char*)(gbase) + (voff)[_i]), (PG8_LAS unsigned*)(lds + (bufoff) + ldsw + _i * 8192), 16, 0, 0); } while (0)
#define PG8_LDA(dst, b, h) do { _Pragma("unroll") for (int m = 0; m < 4; ++m) _Pragma("unroll") for (int k = 0; k < 2; ++k) dst[m][k] = *(const PG8_LAS bf16x8*)(lds + PG8_SA(b, h) + aoff + m * 2048 + k * 1024); } while (0)
#define PG8_LDB(dst, b, h) do { _Pragma("unroll") for (int n = 0; n < 2; ++n) _Pragma("unroll") for (int k = 0; k < 2; ++k) dst[n][k] = *(const PG8_LAS bf16x8*)(lds + PG8_SB(b, h) + boff + n * 2048 + k * 1024); } while (0)
#define PG8_MMA(ai, bj, At, Bt) do { __builtin_amdgcn_s_setprio(1); _Pragma("unroll") for (int m = 0; m < 4; ++m) _Pragma("unroll") for (int n = 0; n < 2; ++n) _Pragma("unroll") for (int k = 0; k < 2; ++k) \
        acc[ai][bj][m][n] = __builtin_amdgcn_mfma_f32_16x16x32_bf16(Bt[n][k], At[m][k], acc[ai][bj][m][n], 0, 0, 0); __builtin_amdgcn_s_setprio(0); } while (0)
#define PG8_WAIT_V(n) asm volatile("s_waitcnt vmcnt(" #n ")" ::: "memory")
#define PG8_WAIT_L(n) asm volatile("s_waitcnt lgkmcnt(" #n ")" ::: "memory")
#define PG8_BAR __builtin_amdgcn_s_barrier()
#define PG8_SCHED __builtin_amdgcn_sched_barrier(0)
    Unit cur, nxt; int ui = 0;
    if (!S.next(0, cur)) return;
    f32x4 acc[2][2][4][2];
#pragma unroll
    for (int a = 0; a < 2; ++a)
#pragma unroll
        for (int b = 0; b < 2; ++b)
#pragma unroll
            for (int m = 0; m < 4; ++m)
#pragma unroll
                for (int n = 0; n < 2; ++n) acc[a][b][m][n] = (f32x4){0.f, 0.f, 0.f, 0.f};
    bf16x8 At[4][2], B0[2][2], B1[2][2];
    const char* cA = (const char*)g.A + (size_t)cur.pm * tstep; const char* cB = (const char*)g.Bt + (size_t)cur.pn * tstep;
    S.a_ready(cur);
    if constexpr (SP2) {
        PG8_STAGE(PG8_SB(0, 0), cB, voffB); PG8_STAGE(PG8_SB(0, 1), cB + hstep, voffB); PG8_STAGE(PG8_SA(0, 0), cA, voffA); PG8_STAGE(PG8_SA(0, 1), cA + hstep, voffA);
        if (wr == 1) PG8_BAR;
        PG8_WAIT_V(2); PG8_BAR;
        PG8_STAGE(PG8_SB(1, 0), cB + kstep, voffB); PG8_STAGE(PG8_SA(1, 0), cA + kstep, voffA); PG8_STAGE(PG8_SB(1, 1), cB + hstep + kstep, voffB);
        PG8_WAIT_V(6); PG8_BAR;
    } else {
        PG8_STAGE(PG8_SB(0, 0), cB, voffB); PG8_STAGE(PG8_SA(0, 0), cA, voffA); PG8_STAGE(PG8_SB(0, 1), cB + hstep, voffB); PG8_STAGE(PG8_SA(0, 1), cA + hstep, voffA);
        if (wr == 1) PG8_BAR;
        PG8_WAIT_V(4); PG8_BAR;
        PG8_STAGE(PG8_SB(1, 0), cB + kstep, voffB); PG8_STAGE(PG8_SA(1, 0), cA + kstep, voffA); PG8_STAGE(PG8_SB(1, 1), cB + hstep + kstep, voffB);
        PG8_WAIT_V(6); PG8_BAR;
    }
    for (;;) {
        const bool has_next = S.next(ui + 1, nxt);
        const char* nA = has_next ? (const char*)g.A + (size_t)nxt.pm * tstep : cA; const char* nB = has_next ? (const char*)g.Bt + (size_t)nxt.pn * tstep : cB;
        for (int t = 0; t < nt; t += 2) {
            const bool last = (t == nt - 2);
            const char* a1 = cA + (size_t)(t + 1) * kstep;
            const char* a2 = last ? nA : cA + (size_t)(t + 2) * kstep; const char* b2 = last ? nB : cB + (size_t)(t + 2) * kstep;
            const char* a3 = a2 + kstep; const char* b3 = b2 + kstep;
            if (last && has_next) S.a_ready(nxt);
            if constexpr (SP2) {
            PG8_LDB(B0, 0, 0); PG8_LDB(B1, 0, 1); PG8_SCHED; PG8_LDA(At, 0, 0); PG8_STAGE(PG8_SA(1, 1), a1 + hstep, voffA);
            PG8_WAIT_V(8); PG8_WAIT_L(0); PG8_BAR; PG8_MMA(0, 0, At, B0); PG8_MMA(0, 1, At, B1); PG8_BAR; PG8_SCHED;
            PG8_LDA(At, 0, 1); PG8_STAGE(PG8_SB(0, 0), b2, voffB); PG8_STAGE(PG8_SB(0, 1), b2 + hstep, voffB); PG8_STAGE(PG8_SA(0, 0), a2, voffA);
            PG8_WAIT_V(8); PG8_WAIT_L(0); PG8_BAR; PG8_MMA(1, 0, At, B0); PG8_MMA(1, 1, At, B1); PG8_BAR; PG8_SCHED;
            PG8_LDB(B0, 1, 0); PG8_LDB(B1, 1, 1); PG8_SCHED; PG8_LDA(At, 1, 0); PG8_STAGE(PG8_SA(0, 1), a2 + hstep, voffA);
            PG8_WAIT_V(8); PG8_WAIT_L(0); PG8_BAR; PG8_MMA(0, 0, At, B0); PG8_MMA(0, 1, At, B1); PG8_BAR; PG8_SCHED;
            PG8_LDA(At, 1, 1); PG8_STAGE(PG8_SB(1, 0), b3, voffB); PG8_STAGE(PG8_SB(1, 1), b3 + hstep, voffB); PG8_STAGE(PG8_SA(1, 0), a3, voffA);
            PG8_WAIT_V(8); PG8_WAIT_L(0); PG8_BAR; PG8_MMA(1, 0, At, B0); PG8_MMA(1, 1, At, B1); PG8_BAR; PG8_SCHED;
            } else {
            PG8_LDB(B0, 0, 0); PG8_SCHED; PG8_LDA(At, 0, 0); PG8_STAGE(PG8_SA(1, 1), a1 + hstep, voffA);
            PG8_WAIT_L(8); PG8_BAR; PG8_WAIT_L(0); PG8_MMA(0, 0, At, B0); PG8_BAR; PG8_SCHED;
            PG8_LDB(B1, 0, 1); PG8_STAGE(PG8_SB(0, 0), b2, voffB);
            PG8_BAR; PG8_WAIT_L(0); PG8_MMA(0, 1, At, B1); PG8_BAR;
            PG8_LDA(At, 0, 1); PG8_STAGE(PG8_SA(0, 0), a2, voffA);
            PG8_BAR; PG8_WAIT_L(0); PG8_MMA(1, 0, At, B0); PG8_BAR; PG8_SCHED;
            PG8_STAGE(PG8_SB(0, 1), b2 + hstep, voffB);
            PG8_WAIT_V(6); PG8_BAR; PG8_MMA(1, 1, At, B1); PG8_BAR;
            PG8_LDB(B0, 1, 0); PG8_SCHED; PG8_LDA(At, 1, 0); PG8_STAGE(PG8_SA(0, 1), a2 + hstep, voffA);
            PG8_WAIT_L(8); PG8_BAR; PG8_WAIT_L(0); PG8_MMA(0, 0, At, B0); PG8_BAR; PG8_SCHED;
            PG8_LDB(B1, 1, 1); PG8_STAGE(PG8_SB(1, 0), b3, voffB);
            PG8_BAR; PG8_WAIT_L(0); PG8_MMA(0, 1, At, B1); PG8_BAR;
            PG8_LDA(At, 1, 1); PG8_STAGE(PG8_SA(1, 0), a3, voffA);
            PG8_BAR; PG8_WAIT_L(0); PG8_MMA(1, 0, At, B0); PG8_BAR; PG8_SCHED;
            PG8_STAGE(PG8_SB(1, 1), b3 + hstep, voffB);
            PG8_WAIT_V(6); PG8_BAR; PG8_MMA(1, 1, At, B1); PG8_BAR;
            }
        }
        if constexpr (ALIGN_EPI) { if (wr == 0) PG8_BAR; }
        if constexpr (!Epi::AFTER_DRAIN) { E(acc, cur, wr, wc, fr, fq); S.done(cur); }
        if (!has_next) break;
#pragma unroll
        for (int a = 0; a < 2; ++a)
#pragma unroll
            for (int b = 0; b < 2; ++b)
#pragma unroll
                for (int m = 0; m < 4; ++m)
#pragma unroll
                    for (int n = 0; n < 2; ++n) acc[a][b][m][n] = (f32x4){0.f, 0.f, 0.f, 0.f};
        cur = nxt; cA = nA; cB = nB; ++ui;
        if constexpr (ALIGN_EPI) { if (wr == 1) PG8_BAR; }
    }
    PG8_WAIT_V(0);
    if constexpr (!ALIGN_EPI) { if (wr == 0) PG8_BAR; }
    PG8_BAR;
    if constexpr (Epi::AFTER_DRAIN) { E.fused(acc, cur, wr, wc, fr, fq, lds, wid, lane); S.done(cur); }
#undef PG8_SA
#undef PG8_SB
#undef PG8_STAGE
#undef PG8_LDA
#undef PG8_LDB
#undef PG8_MMA
#undef PG8_WAIT_V
#undef PG8_WAIT_L
#undef PG8_BAR
#undef PG8_SCHED
}
}

namespace pg8 {
__host__ __device__ __forceinline__ int permk(int kl) { return 8 * ((kl & 15) >> 2) + 4 * (kl >> 4) + (kl & 3); }
struct EpiBf16Rs {
    static constexpr bool PERM = true, AFTER_DRAIN = false;
    bf16_t* O0; int ld0; int ntile0; bf16_t* O1; int ld1; size_t stride1; const float* ssq; float cs;
    __device__ __forceinline__ void operator()(const f32x4 (&acc)[2][2][4][2], const Unit& u, int wr, int wc, int fr, int fq) const {
        bf16_t* base; int ld, colt;
        if (u.pn < ntile0) { base = O0; ld = ld0; colt = u.pn * BM; }
        else { const int q = u.pn - ntile0, per = ld1 / BM; base = O1 + (size_t)(q / per) * stride1; ld = ld1; colt = (q % per) * BM; }
        const int row0 = u.pm * BM + wr * 64 + fr, col0 = colt + wc * 32 + 8 * fq;
#pragma unroll
        for (int ai = 0; ai < 2; ++ai)
#pragma unroll
            for (int m = 0; m < 4; ++m) {
                const int row = row0 + ai * HALF + m * 16;
                float sc = cs; if (ssq) sc *= rsqrtf(ssq[row] * (1.0f / 1024.0f) + 1e-6f);
                bf16_t* rowp = base + (size_t)row * ld + col0;
#pragma unroll
                for (int bj = 0; bj < 2; ++bj) { const f32x4 v0 = acc[ai][bj][m][0] * sc, v1 = acc[ai][bj][m][1] * sc;
                    u32x4 w; w.x = cvt_pk_bf16(v0[0], v0[1]); w.y = cvt_pk_bf16(v0[2], v0[3]); w.z = cvt_pk_bf16(v1[0], v1[1]); w.w = cvt_pk_bf16(v1[2], v1[3]);
                    *(u32x4*)(rowp + bj * HALF) = w; } }
    }
};
struct EpiF16Rs {
    static constexpr bool PERM = true, AFTER_DRAIN = false;
    _Float16* O; int ld; const float* ssq;
    __device__ __forceinline__ void operator()(const f32x4 (&acc)[2][2][4][2], const Unit& u, int wr, int wc, int fr, int fq) const {
        typedef _Float16 f16x8 __attribute__((ext_vector_type(8)));
        const int row0 = u.pm * BM + wr * 64 + fr, col0 = u.pn * BM + wc * 32 + 8 * fq;
#pragma unroll
        for (int ai = 0; ai < 2; ++ai)
#pragma unroll
            for (int m = 0; m < 4; ++m) {
                const int row = row0 + ai * HALF + m * 16;
                const float sc = rsqrtf(ssq[row] * (1.0f / 1024.0f) + 1e-6f);
                _Float16* rowp = O + (size_t)row * ld + col0;
#pragma unroll
                for (int bj = 0; bj < 2; ++bj) { const f32x4 v0 = acc[ai][bj][m][0] * sc, v1 = acc[ai][bj][m][1] * sc;
                    f16x8 w; w[0] = (_Float16)v0[0]; w[1] = (_Float16)v0[1]; w[2] = (_Float16)v0[2]; w[3] = (_Float16)v0[3];
                    w[4] = (_Float16)v1[0]; w[5] = (_Float16)v1[1]; w[6] = (_Float16)v1[2]; w[7] = (_Float16)v1[3];
                    *(f16x8*)(rowp + bj * HALF) = w; } }
    }
};
template <bool BASE_F32> struct EpiResidBf {
    static constexpr bool PERM = true, AFTER_DRAIN = false;
    const float* basef; bf16_t* xb; float* ssq;
    __device__ __forceinline__ void operator()(const f32x4 (&acc)[2][2][4][2], const Unit& u, int wr, int wc, int fr, int fq) const {
        const int row0 = u.pm * BM + wr * 64 + fr, col0 = u.pn * BM + wc * 32 + 8 * fq;
#pragma unroll
        for (int ai = 0; ai < 2; ++ai)
#pragma unroll
            for (int m = 0; m < 4; ++m) {
                const int row = row0 + ai * HALF + m * 16; const size_t off = (size_t)row * 1024 + col0; float s = 0.f;
#pragma unroll
                for (int bj = 0; bj < 2; ++bj) { const size_t o2 = off + bj * HALF;
                    f32x4 b0, b1;
                    if (BASE_F32) { b0 = *(const f32x4*)(basef + o2); b1 = *(const f32x4*)(basef + o2 + 4); }
                    else { const u32x4 p = *(const u32x4*)(xb + o2);
                        b0 = (f32x4){__builtin_bit_cast(float, p.x << 16), __builtin_bit_cast(float, p.x & 0xffff0000u), __builtin_bit_cast(float, p.y << 16), __builtin_bit_cast(float, p.y & 0xffff0000u)};
                        b1 = (f32x4){__builtin_bit_cast(float, p.z << 16), __builtin_bit_cast(float, p.z & 0xffff0000u), __builtin_bit_cast(float, p.w << 16), __builtin_bit_cast(float, p.w & 0xffff0000u)}; }
                    const f32x4 o0 = b0 + acc[ai][bj][m][0], o1 = b1 + acc[ai][bj][m][1];
                    s += ((o0[0] * o0[0] + o0[1] * o0[1]) + (o0[2] * o0[2] + o0[3] * o0[3])) + ((o1[0] * o1[0] + o1[1] * o1[1]) + (o1[2] * o1[2] + o1[3] * o1[3]));
                    u32x4 w; w.x = cvt_pk_bf16(o0[0], o0[1]); w.y = cvt_pk_bf16(o0[2], o0[3]); w.z = cvt_pk_bf16(o1[0], o1[1]); w.w = cvt_pk_bf16(o1[2], o1[3]);
                    *(u32x4*)(xb + o2) = w; }
                s += __shfl_xor(s, 16); s += __shfl_xor(s, 32);
                if (fq == 0) atomicAdd(ssq + row, s);
            }
    }
};
struct EpiKV {
    static constexpr bool PERM = false, AFTER_DRAIN = false;
    bf16_t* Kb; bf16_t* VTp;
    __device__ __forceinline__ void operator()(const f32x4 (&acc)[2][2][4][2], const Unit& u, int wr, int wc, int fr, int fq) const {
        typedef unsigned u32x2v __attribute__((ext_vector_type(2)));
        const int row0 = u.pm * BM + wr * 64 + fr, col0 = u.pn * BM + wc * 32 + 4 * fq;
#pragma unroll
        for (int ai = 0; ai < 2; ++ai)
#pragma unroll
            for (int m = 0; m < 4; ++m) {
                const int row = row0 + ai * HALF + m * 16, b = row >> 8, key = row & 255;
#pragma unroll
                for (int bj = 0; bj < 2; ++bj)
#pragma unroll
                    for (int n = 0; n < 2; ++n) { const int col = col0 + bj * HALF + n * 16; const f32x4 v = acc[ai][bj][m][n];
                        const unsigned p01 = cvt_pk_bf16(v[0], v[1]), p23 = cvt_pk_bf16(v[2], v[3]);
                        if (col < 1024) { const int h = col >> 8, dh = col & 255; u32x2v w; w.x = p01; w.y = p23;
                            *(u32x2v*)(Kb + ((size_t)((b * 4 + h) * 256 + key)) * 256 + dh) = w; }
                        else { const int c2 = col - 1024, h = c2 >> 8, dv = c2 & 255, kp = (key & ~31) | permk(key & 31);
                            bf16_t* d = VTp + ((size_t)((b * 4 + h) * 256 + dv)) * 256 + kp;
                            d[0] = (bf16_t)(p01 & 0xffffu); d[256] = (bf16_t)(p01 >> 16); d[512] = (bf16_t)(p23 & 0xffffu); d[768] = (bf16_t)(p23 >> 16); } }
            }
    }
};
}
#ifndef PG8_SP2
#define PG8_SP2 true
#endif
#ifndef PG8_ALIGN
#define PG8_ALIGN true
#endif

constexpr int NWAVES = 8;
#ifndef MK_PER_PHASE
#define MK_PER_PHASE 0
#endif
constexpr int T = 16384, SEQ = 8192, D = 1024;
constexpr int N_PHASES = 12;

constexpr size_t MiB = 1u << 20, KiB = 1u << 10;
constexpr size_t WS_CTL = 0, CTL_ZERO_BYTES = 1 * MiB;
constexpr int CW_BAR = 4096;
constexpr size_t WS_SSQ1 = 64 * KiB, WS_SSQ2 = 128 * KiB;
constexpr size_t WS_AB = 1 * MiB;
constexpr size_t WS_HEND = WS_AB + 512 * KiB, WS_PEND = WS_HEND + 512 * KiB, WS_HIN = WS_PEND + 512 * KiB;
constexpr size_t WS_DEC = WS_HIN + 512 * KiB;
constexpr size_t WS_SUBK = 3 * MiB + 256 * KiB;
constexpr size_t WS_WIN = 4 * MiB, WS_WOUT = 10 * MiB, WS_WQ = 12 * MiB, WS_WKV = 14 * MiB, WS_WO = 18 * MiB, WS_PWQ = 20 * MiB;
constexpr size_t WS_MEMN = 24 * MiB, WS_KB = 25 * MiB, WS_VTP = 26 * MiB, WS_LRUWT = 27 * MiB, WS_USC = 27 * MiB + 256 * KiB, WS_VSC = 27 * MiB + 384 * KiB;
constexpr size_t WS_XB = 28 * MiB;
constexpr size_t WS_HLOC = 28 * MiB, WS_PCUM = 44 * MiB;
constexpr size_t WS_QKV = 60 * MiB;
constexpr size_t OUT_Y = 4 * MiB;
constexpr size_t OUT_END = OUT_Y + (size_t)16384 * 1024 * 2;
constexpr size_t WS_IDX = 60 * MiB, WS_GW = 68 * MiB;
constexpr size_t WS_UB = 60 * MiB;
constexpr size_t WS_XR = 108 * MiB, WS_Z = 124 * MiB, WS_GATE = 140 * MiB;
constexpr size_t WS_WN = 156 * MiB, WS_UF = 172 * MiB, WS_QD = 188 * MiB, WS_KD = 204 * MiB, WS_ATT = 220 * MiB;
constexpr size_t WS_VB = 228 * MiB;
constexpr size_t WS_Q = 188 * MiB, WS_AO = 124 * MiB;
constexpr size_t WS_PQ = 108 * MiB;
constexpr size_t WS_END = 244 * MiB;
constexpr int CW_GFLAG = 49152;
constexpr int CW_LRUCNT = 8192;
static_assert(WS_XR - WS_QKV == (size_t)T * 1536 * 2 && WS_Z - WS_XR == (size_t)T * 512 * 2 && WS_GATE - WS_Z == (size_t)T * 512 * 2, "in-proj outputs are contiguous");

constexpr int LDS_BYTES = 160 * 1024;
constexpr int MISC_OFF = 159 * 1024;

#define GAS __attribute__((address_space(1)))
#define LAS __attribute__((address_space(3)))
typedef unsigned short bf16;
typedef unsigned v4u __attribute__((ext_vector_type(4)));
typedef unsigned v2u __attribute__((ext_vector_type(2)));
typedef float f32x4 __attribute__((ext_vector_type(4)));
typedef short bf16x8 __attribute__((ext_vector_type(8)));
typedef GAS unsigned gu32;
#define LDS_WAIT() asm volatile("s_waitcnt lgkmcnt(0)" ::: "memory")
__device__ __forceinline__ void st16_wt(void* p, v4u v) { asm volatile("global_store_dwordx4 %0, %1, off sc0 sc1\n\ts_nop 1" :: "v"(p), "v"(v) : "memory"); }
__device__ __forceinline__ unsigned f2bf(float f) { unsigned u = __builtin_bit_cast(unsigned, f); return (u + 0x7fffu + ((u >> 16) & 1u)) >> 16; }
__device__ __forceinline__ unsigned pk2(float lo, float hi) { return f2bf(lo) | (f2bf(hi) << 16); }
__device__ __forceinline__ float bflo(unsigned u) { return __builtin_bit_cast(float, u << 16); }
__device__ __forceinline__ float bfhi(unsigned u) { return __builtin_bit_cast(float, u & 0xffff0000u); }
__device__ __forceinline__ float bf1(bf16 h) { return __builtin_bit_cast(float, (unsigned)h << 16); }
__device__ __forceinline__ float wave_sum(float v) {
#pragma unroll
    for (int o = 1; o < 64; o <<= 1) v += __shfl_xor(v, o);
    return v;
}
__device__ __forceinline__ float row16_sum(float v) {
    v += __builtin_bit_cast(float, __builtin_amdgcn_update_dpp(0, __builtin_bit_cast(int, v), 0xB1, 0xF, 0xF, true));
    v += __builtin_bit_cast(float, __builtin_amdgcn_update_dpp(0, __builtin_bit_cast(int, v), 0x4E, 0xF, 0xF, true));
    v += __builtin_bit_cast(float, __builtin_amdgcn_update_dpp(0, __builtin_bit_cast(int, v), 0x141, 0xF, 0xF, true));
    v += __builtin_bit_cast(float, __builtin_amdgcn_update_dpp(0, __builtin_bit_cast(int, v), 0x140, 0xF, 0xF, true));
    return v;
}
__device__ __forceinline__ float sigmoidf_(float x) { return __builtin_amdgcn_rcpf(1.0f + __expf(-x)); }
__device__ __forceinline__ float softplusf_(float x) { return fmaxf(x, 0.f) + log1pf(__expf(-fabsf(x))); }
__device__ __forceinline__ float siluf_(float x) { return x * __builtin_amdgcn_rcpf(1.0f + __expf(-x)); }
__device__ __forceinline__ float gelu_tanh(float x) { const float y = 0.7978845608028654f * (x + 0.044715f * x * x * x); const float e = __expf(2.0f * y); return x * (1.0f - __builtin_amdgcn_rcpf(1.0f + e)); }
__device__ __forceinline__ int permk(int kl) { return 8 * ((kl & 15) >> 2) + 4 * (kl >> 4) + (kl & 3); }

struct Params {
    const float *x, *mem, *norm_mix_w, *w_in, *conv_qkv_w, *gdn_a_log, *gdn_dt_bias, *gdn_norm_w, *lru_conv_w, *lru_conv_b, *lru_wa, *lru_ba, *lru_wx, *lru_bx, *lru_lambda, *w_out,
                *norm_xattn_w, *norm_mem_w, *xattn_wq, *xattn_wkv, *xattn_wo, *norm_ffn_w, *peer_wq, *peer_subkeys, *peer_u, *peer_v, *norm_final_w;
    float* out; unsigned char* ws; int ph_lo, ph_hi;
};
#define XB_TMO      128
#define XB_XCNT(j)  (256  + 64 * (j))
#define XB_XSUB(j)  (1280 + 64 * (j))
#define XB_XGEN(j)  (2304 + 64 * (j))
#define XB_TOP      3328
#define XB_TOPGEN   3392
#define XCD_BAR_WORDS 3456
#define XB_SPIN_CAP (1u << 18)

__device__ __forceinline__ unsigned xb_ld(unsigned* p)              { return __hip_atomic_load(p, __ATOMIC_RELAXED, __HIP_MEMORY_SCOPE_AGENT); }
__device__ __forceinline__ unsigned xb_add(unsigned* p, unsigned v) { return __hip_atomic_fetch_add(p, v, __ATOMIC_RELAXED, __HIP_MEMORY_SCOPE_AGENT); }
__device__ __forceinline__ unsigned xb_xcc_id() { return (unsigned)__builtin_amdgcn_s_getreg((3 << 11) | 20) & 0xFu; }
#define XB_SPIN(cond, bar) do { unsigned _sp = 0; while (cond) { __builtin_amdgcn_s_sleep(1); \
    if ((++_sp & 255u) == 0u) { if (xb_ld(&(bar)[XB_TMO])) break; if (_sp > XB_SPIN_CAP) { atomicAdd(&(bar)[XB_TMO], 1u); break; } } } } while (0)

struct XcdBarrier {
    unsigned* bar; unsigned x;
    volatile LAS unsigned* st;
};

__device__ __forceinline__ XcdBarrier xcd_barrier_post(unsigned* bar, volatile LAS unsigned* st) {
    XcdBarrier b; b.bar = bar; b.x = xb_xcc_id(); b.st = st;
    if (threadIdx.x == 0) (void)xb_add(&bar[XB_XCNT(b.x)], 1u);
    return b;
}
__device__ __forceinline__ void xcd_barrier_complete(unsigned* bar, unsigned x, unsigned& nloc, unsigned& nx) {
    const unsigned G = gridDim.x * gridDim.y * gridDim.z;
    unsigned sum, cnt, mine, sp = 0u;
    for (;;) {
        sum = 0u; cnt = 0u; mine = 0u;
#pragma unroll
        for (unsigned j = 0; j < 16; ++j) { const unsigned c = xb_ld(&bar[XB_XCNT(j)]); sum += c; cnt += (c > 0u) ? 1u : 0u; mine = (j == x) ? c : mine; }
        if (sum == G) break;
        __builtin_amdgcn_s_sleep(1);
        if ((++sp & 255u) == 0u) { if (xb_ld(&bar[XB_TMO])) break; if (sp > XB_SPIN_CAP) { atomicAdd(&bar[XB_TMO], 1u); break; } }
    }
    nloc = mine > 0u ? mine : 1u; nx = cnt > 0u ? cnt : 1u;
}

__device__ __forceinline__ void xcd_barrier(const XcdBarrier& b) {
    asm volatile("s_waitcnt vmcnt(0)" ::: "memory");
    __syncthreads();
    if (threadIdx.x == 0) {
        unsigned* bar = b.bar;
        __builtin_amdgcn_s_waitcnt(0);
        unsigned nloc = b.st[0], nx = b.st[1];
        if (nloc == 0u) { xcd_barrier_complete(bar, b.x, nloc, nx); b.st[0] = nloc; b.st[1] = nx; }
        const unsigned old = xb_add(&bar[XB_XSUB(b.x)], 1u);
        const unsigned gen = old / nloc;
        if (old + 1u == (gen + 1u) * nloc) {
            __builtin_amdgcn_fence(__ATOMIC_RELEASE, "agent");
            asm volatile("s_waitcnt vmcnt(0)" ::: "memory");
            const unsigned og = xb_add(&bar[XB_TOP], 1u);
            const unsigned tg = og / nx;
            if (og + 1u == (tg + 1u) * nx) xb_add(&bar[XB_TOPGEN], 1u);
            else XB_SPIN(xb_ld(&bar[XB_TOPGEN]) == tg, bar);
            __builtin_amdgcn_fence(__ATOMIC_ACQUIRE, "agent");
            xb_add(&bar[XB_XGEN(b.x)], 1u);
            asm volatile("s_waitcnt vmcnt(0)" ::: "memory");
        } else {
            XB_SPIN(xb_ld(&bar[XB_XGEN(b.x)]) == gen, bar);
            __builtin_amdgcn_fence(__ATOMIC_ACQUIRE, "agent");
            asm volatile("s_waitcnt vmcnt(0)" ::: "memory");
        }
    }
    __syncthreads();
}

__device__ __forceinline__ void p0_transpose_item(const float* W, int K, int ldw, int c0, int nblk, bf16* WT, int row_off, const float* ks, LAS float* scr, int item, int lane) {
    const int kb = item / nblk, nb = item % nblk, k0 = 64 * kb, n0 = 32 * nb;
#pragma unroll 8
    for (int i = 0; i < 32; ++i) { const int kk = 2 * i + (lane >> 5); float v = W[(size_t)(k0 + kk) * ldw + c0 + n0 + (lane & 31)]; if (ks) v *= ks[k0 + kk]; scr[kk * 33 + (lane & 31)] = v; }
    LDS_WAIT(); asm volatile("" ::: "memory");
    const int c = lane & 7;
#pragma unroll
    for (int j = 0; j < 4; ++j) { const int n = (lane >> 3) + 8 * j; const LAS float* s = scr + (8 * c) * 33 + n;
        v4u o; o.x = pk2(s[0 * 33], s[1 * 33]); o.y = pk2(s[2 * 33], s[3 * 33]); o.z = pk2(s[4 * 33], s[5 * 33]); o.w = pk2(s[6 * 33], s[7 * 33]);
        *(GAS v4u*)(WT + (size_t)(row_off + n0 + n) * K + k0 + 8 * c) = o; }
    LDS_WAIT(); asm volatile("" ::: "memory");
}

__device__ __forceinline__ void p0_prologue(const Params& P, LAS unsigned char* lds, int tid, int lane, int wave, int vcu, int G) {
    unsigned char* ws = P.ws;
    const int gw = vcu * NWAVES + wave, NGW = G * NWAVES;
    LAS float* wabl = (LAS float*)lds;
    for (int idx = tid; idx < 8192; idx += NWAVES * 64) { const int k = idx >> 3, c = idx & 7, j = k >> 8, l = (k >> 2) & 63, e = k & 3;
        wabl[((((j * 4 + e) * 2 + (c >> 2)) * 64 + l) << 2) + (c & 3)] = P.w_in[(size_t)k * 3080 + 2048 + c]; }
    __syncthreads();
    {
        bf16* XB0 = (bf16*)(ws + WS_XB); float* AB = (float*)(ws + WS_AB);
        f32x4 w4[4];
#pragma unroll
        for (int j = 0; j < 4; ++j) w4[j] = ((const f32x4*)P.norm_mix_w)[64 * j + lane];
        for (int m = gw; m < T; m += NGW) {
            const f32x4* xr = (const f32x4*)(P.x + (size_t)m * D) + lane;
            f32x4 v[4]; float s = 0.f;
#pragma unroll
            for (int j = 0; j < 4; ++j) { v[j] = xr[64 * j]; s += (v[j].x * v[j].x + v[j].y * v[j].y) + (v[j].z * v[j].z + v[j].w * v[j].w); }
            const float rstd = rsqrtf(wave_sum(s) * (1.0f / D) + 1e-6f);
            v2u* o8 = (v2u*)(XB0 + (size_t)m * D) + lane;
            float part[8];
#pragma unroll
            for (int c = 0; c < 8; ++c) part[c] = 0.f;
#pragma unroll
            for (int j = 0; j < 4; ++j) {
                v[j] = v[j] * rstd * w4[j];
                v2u o; o.x = pk2(v[j].x, v[j].y); o.y = pk2(v[j].z, v[j].w); o8[64 * j] = o;
#pragma unroll
                for (int e = 0; e < 4; ++e) {
                    const f32x4 wa = *(const LAS f32x4*)(wabl + ((((j * 4 + e) * 2 + 0) * 64 + lane) << 2));
                    const f32x4 wb = *(const LAS f32x4*)(wabl + ((((j * 4 + e) * 2 + 1) * 64 + lane) << 2));
                    const float hv = v[j][e];
                    part[0] += hv * wa.x; part[1] += hv * wa.y; part[2] += hv * wa.z; part[3] += hv * wa.w;
                    part[4] += hv * wb.x; part[5] += hv * wb.y; part[6] += hv * wb.z; part[7] += hv * wb.w;
                }
            }
#pragma unroll
            for (int c = 0; c < 8; ++c) part[c] = wave_sum(part[c]);
            float o = part[0];
#pragma unroll
            for (int c = 1; c < 8; ++c) o = (lane == c) ? part[c] : o;
            if (lane < 8) AB[(size_t)m * 8 + lane] = o;
        }
    }
    {
        bf16* MEMN = (bf16*)(ws + WS_MEMN);
        for (int m = gw; m < 512; m += NGW) {
            const f32x4* xr = (const f32x4*)(P.mem + (size_t)m * D) + lane;
            f32x4 v[4]; float s = 0.f;
#pragma unroll
            for (int j = 0; j < 4; ++j) { v[j] = xr[64 * j]; s += (v[j].x * v[j].x + v[j].y * v[j].y) + (v[j].z * v[j].z + v[j].w * v[j].w); }
            const float rstd = rsqrtf(wave_sum(s) * (1.0f / D) + 1e-6f);
            v2u* o8 = (v2u*)(MEMN + (size_t)m * D) + lane;
#pragma unroll
            for (int j = 0; j < 4; ++j) { const f32x4 w = ((const f32x4*)P.norm_mem_w)[64 * j + lane]; const f32x4 y = v[j] * rstd * w;
                v2u o; o.x = pk2(y.x, y.y); o.y = pk2(y.z, y.w); o8[64 * j] = o; }
        }
    }
    __syncthreads();
    {
        LAS float* scr = (LAS float*)(lds + wave * 16384);
        constexpr int I_IN1 = 16 * 48, I_IN2 = 16 * 16, I_KV = 16 * 64;
        constexpr int NITEMS = I_IN1 + 3 * I_IN2 + I_KV;
        for (int it = gw; it < NITEMS; it += NGW) {
            int r = it;
            if (r < I_IN1) { p0_transpose_item(P.w_in, 1024, 3080, 0, 48, (bf16*)(ws + WS_WIN), 0, nullptr, scr, r, lane); continue; } r -= I_IN1;
            if (r < I_IN2) { p0_transpose_item(P.w_in, 1024, 3080, 2056, 16, (bf16*)(ws + WS_WIN), 1536, nullptr, scr, r, lane); continue; } r -= I_IN2;
            if (r < I_IN2) { p0_transpose_item(P.w_in, 1024, 3080, 1536, 16, (bf16*)(ws + WS_WIN), 2048, nullptr, scr, r, lane); continue; } r -= I_IN2;
            if (r < I_IN2) { p0_transpose_item(P.w_in, 1024, 3080, 2568, 16, (bf16*)(ws + WS_WIN), 2560, nullptr, scr, r, lane); continue; } r -= I_IN2;
            p0_transpose_item(P.xattn_wkv, 1024, 2048, 0, 64, (bf16*)(ws + WS_WKV), 0, nullptr, scr, r, lane);
        }
    }
    {
        bf16* WT = (bf16*)(ws + WS_LRUWT);
        for (int it = vcu * NWAVES * 64 + tid; it < 8 * 2 * 64 * 8; it += G * NWAVES * 64) {
            const int i8 = it & 7, j = (it >> 3) & 63, m = (it >> 9) & 1, g = it >> 10;
            const float* src = (m ? P.lru_wx : P.lru_wa) + (size_t)(g * 64 + 8 * i8) * 64 + j;
            v4u o; o.x = pk2(src[0], src[64]); o.y = pk2(src[128], src[192]); o.z = pk2(src[256], src[320]); o.w = pk2(src[384], src[448]);
            *(v4u*)(WT + (size_t)it * 8) = o;
        }
    }
}

__device__ __forceinline__ void late_weight_prep(const Params& P, LAS unsigned char* lds, int lane, int wave, int gw, int NGW) {
    unsigned char* ws = P.ws;
    {
        LAS float* scr = (LAS float*)(lds + wave * 16384);
        constexpr int I_OUT = 16 * 32, I_Q = 16 * 32, I_O = 16 * 32;
        for (int it = gw; it < I_OUT + I_Q + I_O; it += NGW) {
            int r = it;
            if (r < I_OUT) { p0_transpose_item(P.w_out, 1024, 1024, 0, 32, (bf16*)(ws + WS_WOUT), 0, nullptr, scr, r, lane); continue; } r -= I_OUT;
            if (r < I_Q) { p0_transpose_item(P.xattn_wq, 1024, 1024, 0, 32, (bf16*)(ws + WS_WQ), 0, P.norm_xattn_w, scr, r, lane); continue; } r -= I_Q;
            p0_transpose_item(P.xattn_wo, 1024, 1024, 0, 32, (bf16*)(ws + WS_WO), 0, nullptr, scr, r, lane);
        }
    }
    {
        bf16* WF = (bf16*)(ws + WS_PWQ);
        const int col = lane & 15, g = lane >> 4;
        for (int it = gw; it < 16 * 64; it += NGW) {
            const int hp = it >> 6, k0 = (it & 63) * 16;
            bf16x8 bq[4];
#pragma unroll
            for (int s = 0; s < 4; ++s) { const f32x4* src = (const f32x4*)(P.peer_wq + (size_t)(k0 + col) * 2048 + hp * 128 + 32 * s + 8 * g);
                const f32x4 a = src[0], c = src[1]; v4u pk; pk.x = pk2(a.x, a.y); pk.y = pk2(a.z, a.w); pk.z = pk2(c.x, c.y); pk.w = pk2(c.z, c.w); bq[s] = __builtin_bit_cast(bf16x8, pk); }
            const float nw = P.norm_ffn_w[k0 + col];
#pragma unroll 2
            for (int kt = 0; kt < 8; ++kt) {
                f32x4 acc = (f32x4){0.f, 0.f, 0.f, 0.f};
#pragma unroll
                for (int s = 0; s < 4; ++s) { const f32x4* src = (const f32x4*)(P.peer_subkeys + (size_t)(hp * 128 + 16 * kt + col) * 128 + 32 * s + 8 * g);
                    const f32x4 a = src[0], c = src[1]; v4u pk; pk.x = pk2(a.x, a.y); pk.y = pk2(a.z, a.w); pk.z = pk2(c.x, c.y); pk.w = pk2(c.z, c.w);
                    acc = __builtin_amdgcn_mfma_f32_16x16x32_bf16(__builtin_bit_cast(bf16x8, pk), bq[s], acc, 0, 0, 0); }
#pragma unroll
                for (int i = 0; i < 4; ++i) WF[(size_t)(hp * 128 + 16 * kt + 4 * g + i) * 1024 + k0 + col] = (bf16)f2bf(acc[i] * nw);
            }
        }
    }
}

constexpr int GL_KS = 0, GL_VS = 33792, GL_KB = 67584, GL_QB = 84992, GL_RAW = 102400, GL_CW = 153856, GL_AMT = 133120, GL_SM = 160000, GL_ATT = 151808, GL_SOL = 67584;
static_assert(GL_CW + 6144 <= GL_SM && GL_SM + 1284 <= MISC_OFF && GL_SOL + 65536 <= GL_AMT && GL_AMT + 17408 <= GL_ATT && GL_ATT + 8192 <= GL_SM && GL_RAW + 51456 <= GL_CW, "gdn_local LDS map");
#ifndef GL_REP_STEP
#define GL_REP_STEP -1
#endif
#define GL_REPF(k) for (int rr_ = 0; rr_ < ((GL_REP_STEP == (k)) ? 2 : 1); ++rr_)
#define GL_BAR() do { asm volatile("s_waitcnt lgkmcnt(0)" ::: "memory"); __builtin_amdgcn_s_barrier(); asm volatile("" ::: "memory"); } while (0)
__device__ __forceinline__ void gdn_local_item(const Params& P, LAS unsigned char* lds, int item, int tid) {
    unsigned char* ws = P.ws;
    asm volatile("" : "+v"(tid));
    const int b = item >> 9, h = (item >> 7) & 3, n = item & 127;
    const int t0 = b * SEQ + n * 64;
    const int lane = tid & 63, wave = __builtin_amdgcn_readfirstlane(tid >> 6);
    LAS float* ks = (LAS float*)(lds + GL_KS);
    LAS float* vs = (LAS float*)(lds + GL_VS);
    LAS bf16* kb16 = (LAS bf16*)(lds + GL_KB);
    LAS bf16* qb16 = (LAS bf16*)(lds + GL_QB);
    LAS bf16* raw = (LAS bf16*)(lds + GL_RAW);
    LAS float* cw = (LAS float*)(lds + GL_CW);
    LAS float* AmT = (LAS float*)(lds + GL_AMT);
    LAS float* sg = (LAS float*)(lds + GL_SM);
    LAS float* sbeta = sg + 64; LAS float* sgc = sbeta + 64; LAS float* seg = sgc + 64; LAS float* sek = seg + 64;
    LAS bf16* atts = (LAS bf16*)(lds + GL_ATT);
    const bf16* QKV = (const bf16*)(ws + WS_QKV);
    const float* AB = (const float*)(ws + WS_AB);
    GL_REPF(0) {
        v4u pr[7];
#pragma unroll
        for (int r = 0; r < 7; ++r) {
            const int id = tid + 512 * r;
            const int row = id / 48, rem = id - row * 48, part = rem >> 4, ck = rem & 15, s = n * 64 + row - 3;
            pr[r] = (v4u){0u, 0u, 0u, 0u};
            if (id < 67 * 48 && s >= 0) pr[r] = *(const v4u*)(QKV + (size_t)(b * SEQ + s) * 1536 + part * 512 + h * 128 + ck * 8);
        }
        f32x4 cwv = (f32x4){0.f, 0.f, 0.f, 0.f};
        if (tid < 384) { const int j = tid / 96, rem = tid - j * 96, part = rem >> 5, c4 = rem & 31; cwv = *(const f32x4*)(P.conv_qkv_w + j * 1536 + part * 512 + h * 128 + c4 * 4); }
        float a_in = 0.f, b_in = 0.f;
        if (tid < 64) { a_in = AB[(size_t)(t0 + tid) * 8 + h]; b_in = AB[(size_t)(t0 + tid) * 8 + 4 + h]; }
#pragma unroll
        for (int r = 0; r < 7; ++r) { const int id = tid + 512 * r; if (id < 67 * 48) *(LAS v4u*)(raw + id * 8) = pr[r]; }
        if (tid < 384) *(LAS f32x4*)(cw + tid * 4) = cwv;
        if (tid < 64) { sg[tid] = -__expf(P.gdn_a_log[h]) * softplusf_(a_in + P.gdn_dt_bias[h]); sbeta[tid] = sigmoidf_(b_in); }
    }
    GL_BAR();
    GL_REPF(1) {
        const int c = tid >> 3, grp = tid & 7;
#pragma unroll 1
        for (int part = 0; part < 3; ++part) {
            float y[16];
#pragma unroll
            for (int i = 0; i < 16; ++i) y[i] = 0.f;
#pragma unroll
            for (int j = 0; j < 4; ++j) {
                const LAS v4u* src = (const LAS v4u*)(raw + (c + j) * 384 + part * 128 + grp * 16);
                const v4u x0 = src[0], x1 = src[1];
                const LAS f32x4* wp = (const LAS f32x4*)(cw + (j * 3 + part) * 128 + grp * 16);
                const f32x4 w0 = wp[0], w1 = wp[1], w2 = wp[2], w3 = wp[3];
                y[0] += w0.x * bflo(x0.x); y[1] += w0.y * bfhi(x0.x); y[2] += w0.z * bflo(x0.y); y[3] += w0.w * bfhi(x0.y);
                y[4] += w1.x * bflo(x0.z); y[5] += w1.y * bfhi(x0.z); y[6] += w1.z * bflo(x0.w); y[7] += w1.w * bfhi(x0.w);
                y[8] += w2.x * bflo(x1.x); y[9] += w2.y * bfhi(x1.x); y[10] += w2.z * bflo(x1.y); y[11] += w2.w * bfhi(x1.y);
                y[12] += w3.x * bflo(x1.z); y[13] += w3.y * bfhi(x1.z); y[14] += w3.z * bflo(x1.w); y[15] += w3.w * bfhi(x1.w);
            }
            float ss = 0.f;
#pragma unroll
            for (int i = 0; i < 16; ++i) { y[i] = siluf_(y[i]); ss += y[i] * y[i]; }
            if (part < 2) {
                ss += __shfl_xor(ss, 1); ss += __shfl_xor(ss, 2); ss += __shfl_xor(ss, 4);
                const float sc = rsqrtf(ss + 1e-6f) * (part == 0 ? 0.08838834764831845f : 1.0f);
#pragma unroll
                for (int i = 0; i < 16; ++i) y[i] *= sc;
            }
            if (part >= 1) {
                LAS float* dst = (part == 1 ? ks : vs) + c * 132 + grp * 16;
#pragma unroll
                for (int i = 0; i < 4; ++i) *(LAS f32x4*)(dst + 4 * i) = (f32x4){y[4 * i], y[4 * i + 1], y[4 * i + 2], y[4 * i + 3]};
            }
            if (part <= 1) {
                LAS bf16* dst = (part == 0 ? qb16 : kb16) + c * 136 + grp * 16;
                v4u o0, o1; o0.x = pk2(y[0], y[1]); o0.y = pk2(y[2], y[3]); o0.z = pk2(y[4], y[5]); o0.w = pk2(y[6], y[7]);
                o1.x = pk2(y[8], y[9]); o1.y = pk2(y[10], y[11]); o1.z = pk2(y[12], y[13]); o1.w = pk2(y[14], y[15]);
                *(LAS v4u*)dst = o0; *(LAS v4u*)(dst + 8) = o1;
            }
        }
    }
    if (tid < 64) {
        float v = sg[tid];
#pragma unroll
        for (int off = 1; off < 64; off <<= 1) { const float t = __shfl_up(v, off); if (tid >= off) v += t; }
        sgc[tid] = v; seg[tid] = __expf(v);
        const float gl = __shfl(v, 63);
        sek[tid] = __expf(gl - v);
        if (tid == 63) sek[64] = __expf(v);
    }
    GL_BAR();
    {
        const int mat = wave >> 2, rho = wave & 3, col = lane & 15, g = lane >> 4;
        const LAS bf16* X = mat ? qb16 : kb16;
        bf16x8 af[4];
#pragma unroll
        for (int s = 0; s < 4; ++s) af[s] = *(const LAS bf16x8*)(X + (16 * rho + col) * 136 + 32 * s + 8 * g);
#pragma unroll
        for (int sig = 0; sig < 4; ++sig) {
            f32x4 acc = (f32x4){0.f, 0.f, 0.f, 0.f};
#pragma unroll
            for (int s = 0; s < 4; ++s) { const bf16x8 bfr = *(const LAS bf16x8*)(kb16 + (16 * sig + col) * 136 + 32 * s + 8 * g); acc = __builtin_amdgcn_mfma_f32_16x16x32_bf16(af[s], bfr, acc, 0, 0, 0); }
            const int sidx = 16 * sig + col; const float gs = sgc[sidx];
#pragma unroll
            for (int i = 0; i < 4; ++i) {
                const int c = 16 * rho + 4 * g + i;
                const float dec = (c >= sidx) ? __expf(sgc[c] - gs) : 0.f;
                if (mat == 0) AmT[sidx * 68 + c] = (c > sidx) ? sbeta[c] * acc[i] * dec : 0.f;
                else atts[c * 64 + sidx] = (bf16)f2bf(acc[i] * dec);
            }
        }
    }
    GL_BAR();
    GL_REPF(4) {
        bf16* QD = (bf16*)(ws + WS_QD) + (size_t)item * 8192;
        bf16* KD = (bf16*)(ws + WS_KD) + (size_t)item * 8192;
        bf16* ATT = (bf16*)(ws + WS_ATT) + (size_t)item * 4096;
#pragma unroll
        for (int r = 0; r < 2; ++r) {
            const int id = tid + 512 * r;
            { const int c = id >> 4, gam = id & 15, s32 = gam >> 2, g = gam & 3;
              const v2u lo = *(const LAS v2u*)(qb16 + c * 136 + 32 * s32 + 4 * g), hi = *(const LAS v2u*)(qb16 + c * 136 + 32 * s32 + 16 + 4 * g);
              const float e = seg[c];
              v4u o; o.x = pk2(bflo(lo.x) * e, bfhi(lo.x) * e); o.y = pk2(bflo(lo.y) * e, bfhi(lo.y) * e); o.z = pk2(bflo(hi.x) * e, bfhi(hi.x) * e); o.w = pk2(bflo(hi.y) * e, bfhi(hi.y) * e);
              st16_wt(QD + c * 128 + 8 * gam, o); }
            { const int dk = id >> 3, gam = id & 7, s32 = gam >> 2, g = gam & 3, c0 = 32 * s32 + 4 * g;
              float v[8];
#pragma unroll
              for (int j = 0; j < 4; ++j) { v[j] = ks[(c0 + j) * 132 + dk] * sek[c0 + j]; v[4 + j] = ks[(c0 + 16 + j) * 132 + dk] * sek[c0 + 16 + j]; }
              v4u o; o.x = pk2(v[0], v[1]); o.y = pk2(v[2], v[3]); o.z = pk2(v[4], v[5]); o.w = pk2(v[6], v[7]);
              st16_wt(KD + dk * 64 + 8 * gam, o); }
        }
        { const int c = tid >> 3, gam = tid & 7, s32 = gam >> 2, g = gam & 3;
          const v2u lo = *(const LAS v2u*)(atts + c * 64 + 32 * s32 + 4 * g), hi = *(const LAS v2u*)(atts + c * 64 + 32 * s32 + 16 + 4 * g);
          v4u o; o.x = lo.x; o.y = lo.y; o.z = hi.x; o.w = hi.y;
          st16_wt(ATT + c * 64 + 8 * gam, o); }
    }
    GL_BAR();
    GL_REPF(5) {
        LAS float* xcol = (LAS float*)(lds + GL_SOL);
        LAS bf16* tinv = (LAS bf16*)(lds + GL_SOL + 17408);
        const int j = tid >> 3, part = tid & 7, jb = j >> 4, jo = j & 15;
#pragma unroll 1
        for (int rb = jb; rb < 4; ++rb) {
            float acc[16];
#pragma unroll
            for (int i = 0; i < 16; ++i) acc[i] = 0.f;
            if (rb > jb) {
#pragma unroll 2
                for (int s = 16 * jb + part; s < 16 * rb; s += 8) {
                    const float sv = xcol[j * 68 + s];
                    const LAS float* ar = AmT + s * 68 + 16 * rb;
#pragma unroll
                    for (int q = 0; q < 4; ++q) { const f32x4 A4 = *(const LAS f32x4*)(ar + 4 * q);
                        acc[4 * q] -= A4.x * sv; acc[4 * q + 1] -= A4.y * sv; acc[4 * q + 2] -= A4.z * sv; acc[4 * q + 3] -= A4.w * sv; }
                }
#pragma unroll
                for (int i = 0; i < 16; ++i) {
                    acc[i] += __builtin_bit_cast(float, __builtin_amdgcn_update_dpp(0, __builtin_bit_cast(int, acc[i]), 0xB1, 0xF, 0xF, true));
                    acc[i] += __builtin_bit_cast(float, __builtin_amdgcn_update_dpp(0, __builtin_bit_cast(int, acc[i]), 0x4E, 0xF, 0xF, true));
                    acc[i] += __builtin_bit_cast(float, __builtin_amdgcn_update_dpp(0, __builtin_bit_cast(int, acc[i]), 0x141, 0xF, 0xF, true));
                }
            } else {
#pragma unroll
                for (int i = 0; i < 16; ++i) acc[i] = (i == jo) ? 1.f : 0.f;
            }
#pragma unroll
            for (int i = 0; i < 16; ++i) {
                const float sv = acc[i];
                const LAS float* ar = AmT + (16 * rb + i) * 68 + 16 * rb;
#pragma unroll
                for (int q = (i + 1) / 4; q < 4; ++q) { const f32x4 A4 = *(const LAS f32x4*)(ar + 4 * q);
                    if (4 * q > i) acc[4 * q] -= A4.x * sv; if (4 * q + 1 > i) acc[4 * q + 1] -= A4.y * sv; if (4 * q + 2 > i) acc[4 * q + 2] -= A4.z * sv; if (4 * q + 3 > i) acc[4 * q + 3] -= A4.w * sv; }
            }
            if (part == 0) {
#pragma unroll
                for (int i = 0; i < 16; ++i) { xcol[j * 68 + 16 * rb + i] = acc[i]; tinv[(16 * rb + i) * 72 + j] = (bf16)f2bf(acc[i]); }
            }
            LDS_WAIT(); asm volatile("" ::: "memory");
        }
        for (int rb = 0; rb < jb; ++rb) {
            if (part == 0) {
#pragma unroll
                for (int i = 0; i < 16; ++i) tinv[(16 * rb + i) * 72 + j] = (bf16)0;
            }
        }
    }
    GL_BAR();
    GL_REPF(6) {
        const LAS bf16* tinv = (const LAS bf16*)(lds + GL_SOL + 17408);
        LAS bf16* wst = (LAS bf16*)(lds + GL_SOL + 17408 + 9216);
        const int col = lane & 15, g = lane >> 4, isw = wave >> 2;
        bf16x8 af[4][2];
#pragma unroll
        for (int rho = 0; rho < 4; ++rho)
#pragma unroll
            for (int s2 = 0; s2 < 2; ++s2) af[rho][s2] = *(const LAS bf16x8*)(tinv + (16 * rho + col) * 72 + 32 * s2 + 8 * g);
        bf16* UF = (bf16*)(ws + WS_UF) + (size_t)item * 8192;
#pragma unroll
        for (int sig = 0; sig < 2; ++sig) {
            const int jj = 32 * (wave & 3) + 16 * sig + col;
            const LAS float* src = (isw ? ks : vs) + jj;
            bf16x8 bfr[2];
#pragma unroll
            for (int s2 = 0; s2 < 2; ++s2) {
                float v[8];
#pragma unroll
                for (int e = 0; e < 8; ++e) { const int sidx = 32 * s2 + 8 * g + e; float x = src[sidx * 132] * sbeta[sidx]; if (isw) x *= seg[sidx]; v[e] = x; }
                v4u pk; pk.x = pk2(v[0], v[1]); pk.y = pk2(v[2], v[3]); pk.z = pk2(v[4], v[5]); pk.w = pk2(v[6], v[7]);
                bfr[s2] = __builtin_bit_cast(bf16x8, pk);
            }
            f32x4 acc[4];
#pragma unroll
            for (int rho = 0; rho < 4; ++rho) { acc[rho] = (f32x4){0.f, 0.f, 0.f, 0.f};
#pragma unroll
                for (int s2 = 0; s2 < 2; ++s2) acc[rho] = __builtin_amdgcn_mfma_f32_16x16x32_bf16(af[rho][s2], bfr[s2], acc[rho], 0, 0, 0); }
            if (!isw) {
                v4u o0, o1;
                o0.x = pk2(acc[0].x, acc[0].y); o0.y = pk2(acc[0].z, acc[0].w); o0.z = pk2(acc[1].x, acc[1].y); o0.w = pk2(acc[1].z, acc[1].w);
                o1.x = pk2(acc[2].x, acc[2].y); o1.y = pk2(acc[2].z, acc[2].w); o1.z = pk2(acc[3].x, acc[3].y); o1.w = pk2(acc[3].z, acc[3].w);
                v4u* d = (v4u*)(UF + (size_t)(2 * (wave & 3) + sig) * 1024 + lane * 16);
                st16_wt(d, o0); st16_wt(d + 1, o1);
            } else {
#pragma unroll
                for (int rho = 0; rho < 4; ++rho)
#pragma unroll
                    for (int i = 0; i < 4; ++i) wst[(16 * rho + 4 * g + i) * 136 + jj] = (bf16)f2bf(-acc[rho][i]);
            }
        }
    }
    GL_BAR();
    {
        const LAS bf16* wst = (const LAS bf16*)(lds + GL_SOL + 17408 + 9216);
        bf16* WN = (bf16*)(ws + WS_WN) + (size_t)item * 8192;
#pragma unroll
        for (int r = 0; r < 2; ++r) {
            const int id = tid + 512 * r, c = id >> 4, gam = id & 15, s32 = gam >> 2, g = gam & 3;
            const v2u lo = *(const LAS v2u*)(wst + c * 136 + 32 * s32 + 4 * g), hi = *(const LAS v2u*)(wst + c * 136 + 32 * s32 + 16 + 4 * g);
            v4u o; o.x = lo.x; o.y = lo.y; o.z = hi.x; o.w = hi.y;
            st16_wt(WN + c * 128 + 8 * gam, o);
        }
    }
    asm volatile("s_waitcnt vmcnt(0)" ::: "memory");
    GL_BAR();
    if (tid == 0) { unsigned fb = __builtin_bit_cast(unsigned, sek[64]); if (fb == 0u) fb = 1u;
        __hip_atomic_store((unsigned*)(ws + WS_CTL) + CW_GFLAG + item, fb, __ATOMIC_RELAXED, __HIP_MEMORY_SCOPE_AGENT); }
    GL_BAR();
}

constexpr int LL_XCB = 68608;
static_assert(LL_XCB + 64 * 1040 <= MISC_OFF, "lru_local LDS map");
__device__ __forceinline__ float expm1_small(float x) {
    const float p = x * (1.0f + x * (0.5f + x * (0.16666667f + x * (0.041666668f + x * 0.008333334f))));
    return (x > -0.25f) ? p : (__expf(x) - 1.0f);
}
__device__ __forceinline__ void lru_local_item(const Params& P, LAS unsigned char* lds, int lt, int tid, int lane, int wave) {
    unsigned char* ws = P.ws;
    asm volatile("" : "+v"(tid));
    const int b = lt >> 7, n = lt & 127, t0 = b * SEQ + n * 64;
    LAS bf16* rawx = (LAS bf16*)lds;
    LAS bf16* xcb = (LAS bf16*)(lds + LL_XCB);
    const bf16* XR = (const bf16*)(ws + WS_XR);
    {
        v4u pr[9];
#pragma unroll
        for (int r = 0; r < 9; ++r) { const int id = tid + 512 * r, row = id >> 6, ck = id & 63, s = n * 64 + row - 3;
            pr[r] = (v4u){0u, 0u, 0u, 0u};
            if (id < 67 * 64 && s >= 0) pr[r] = *(const v4u*)(XR + (size_t)(b * SEQ + s) * 512 + ck * 8); }
#pragma unroll
        for (int r = 0; r < 9; ++r) { const int id = tid + 512 * r; if (id < 67 * 64) *(LAS v4u*)(rawx + id * 8) = pr[r]; }
    }
    GL_BAR();
    {
        const int chg = tid & 63, tseg = tid >> 6, ch0 = chg * 8;
        float w[4][8], cb[8];
#pragma unroll
        for (int j = 0; j < 4; ++j) { const f32x4 a = *(const f32x4*)(P.lru_conv_w + j * 512 + ch0), c = *(const f32x4*)(P.lru_conv_w + j * 512 + ch0 + 4);
            w[j][0] = a.x; w[j][1] = a.y; w[j][2] = a.z; w[j][3] = a.w; w[j][4] = c.x; w[j][5] = c.y; w[j][6] = c.z; w[j][7] = c.w; }
        { const f32x4 a = *(const f32x4*)(P.lru_conv_b + ch0), c = *(const f32x4*)(P.lru_conv_b + ch0 + 4);
          cb[0] = a.x; cb[1] = a.y; cb[2] = a.z; cb[3] = a.w; cb[4] = c.x; cb[5] = c.y; cb[6] = c.z; cb[7] = c.w; }
        v4u xr[11];
#pragma unroll
        for (int r = 0; r < 11; ++r) xr[r] = *(const LAS v4u*)(rawx + (tseg * 8 + r) * 512 + ch0);
#pragma unroll
        for (int tk = 0; tk < 8; ++tk) {
            float y[8];
#pragma unroll
            for (int e = 0; e < 8; ++e) y[e] = cb[e];
#pragma unroll
            for (int j = 0; j < 4; ++j) { const v4u x = xr[tk + j];
                y[0] += w[j][0] * bflo(x.x); y[1] += w[j][1] * bfhi(x.x); y[2] += w[j][2] * bflo(x.y); y[3] += w[j][3] * bfhi(x.y);
                y[4] += w[j][4] * bflo(x.z); y[5] += w[j][5] * bfhi(x.z); y[6] += w[j][6] * bflo(x.w); y[7] += w[j][7] * bfhi(x.w); }
            v4u o; o.x = pk2(y[0], y[1]); o.y = pk2(y[2], y[3]); o.z = pk2(y[4], y[5]); o.w = pk2(y[6], y[7]);
            *(LAS v4u*)(xcb + (tseg * 8 + tk) * 520 + ch0) = o;
        }
    }
    GL_BAR();
    {
        const int g = wave, col = lane & 15, g4 = lane >> 4;
        LAS bf16* AM = (LAS bf16*)(lds + wave * 8192); LAS bf16* BT = AM + 2048;
        const bf16* WT = (const bf16*)(ws + WS_LRUWT) + (size_t)g * 8192;
        bf16x8 Bw[2][4][2];
#pragma unroll
        for (int m = 0; m < 2; ++m)
#pragma unroll
            for (int jt = 0; jt < 4; ++jt)
#pragma unroll
                for (int s2 = 0; s2 < 2; ++s2) Bw[m][jt][s2] = *(const bf16x8*)(WT + m * 4096 + (16 * jt + col) * 64 + 32 * s2 + 8 * g4);
        float cba[4], cbx[4], csp[4];
#pragma unroll
        for (int jt = 0; jt < 4; ++jt) { const int ch = g * 64 + 16 * jt + col; cba[jt] = P.lru_ba[ch]; cbx[jt] = P.lru_bx[ch]; csp[jt] = softplusf_(-P.lru_lambda[ch]); }
        bf16* HLOC = (bf16*)(ws + WS_HLOC); bf16* PCUM = (bf16*)(ws + WS_PCUM);
        const int chs = g * 64 + lane;
        float hst = 0.f, pc = 1.f;
#pragma unroll 1
        for (int half = 0; half < 2; ++half) {
            bf16x8 Af[2][2];
#pragma unroll
            for (int rho = 0; rho < 2; ++rho)
#pragma unroll
                for (int s2 = 0; s2 < 2; ++s2) Af[rho][s2] = *(const LAS bf16x8*)(xcb + (32 * half + 16 * rho + col) * 520 + g * 64 + 32 * s2 + 8 * g4);
#pragma unroll
            for (int jt = 0; jt < 4; ++jt) {
#pragma unroll
                for (int rho = 0; rho < 2; ++rho) {
                    f32x4 ra = (f32x4){0.f, 0.f, 0.f, 0.f}, rx = ra;
#pragma unroll
                    for (int s2 = 0; s2 < 2; ++s2) { ra = __builtin_amdgcn_mfma_f32_16x16x32_bf16(Af[rho][s2], Bw[0][jt][s2], ra, 0, 0, 0); rx = __builtin_amdgcn_mfma_f32_16x16x32_bf16(Af[rho][s2], Bw[1][jt][s2], rx, 0, 0, 0); }
#pragma unroll
                    for (int i = 0; i < 4; ++i) {
                        const int tokl = 16 * rho + 4 * g4 + i, chl = 16 * jt + col;
                        const float r = sigmoidf_(ra[i] + cba[jt]), ig = sigmoidf_(rx[i] + cbx[jt]);
                        const float log_a = -8.0f * r * csp[jt];
                        const float am = -expm1_small(log_a), a = 1.0f - am;
                        const float xo = bf1(xcb[(32 * half + tokl) * 520 + g * 64 + chl]);
                        const float bt = __builtin_amdgcn_sqrtf(fmaxf(am * (1.0f + a), 0.f)) * (ig * xo);
                        AM[tokl * 64 + chl] = (bf16)f2bf(am); BT[tokl * 64 + chl] = (bf16)f2bf(bt);
                    }
                }
            }
            LDS_WAIT(); asm volatile("" ::: "memory");
#pragma unroll 8
            for (int tk = 0; tk < 32; ++tk) {
                const float am = bf1(AM[tk * 64 + lane]), bt = bf1(BT[tk * 64 + lane]);
                hst = (hst - am * hst) + bt; pc = pc - am * pc;
                const size_t o = (size_t)(t0 + 32 * half + tk) * 512 + chs;
                HLOC[o] = (bf16)f2bf(hst); PCUM[o] = (bf16)f2bf(pc);
            }
            LDS_WAIT(); asm volatile("" ::: "memory");
        }
        ((float*)(ws + WS_HEND))[(size_t)lt * 512 + chs] = hst; ((float*)(ws + WS_PEND))[(size_t)lt * 512 + chs] = pc;
    }
    GL_BAR();
}

constexpr int SC_WN = 0, SC_QD = 64 * 272, SC_KD = 2 * 64 * 272, SC_ATT = 2 * 64 * 272 + 128 * 144, SC_BUF = 2 * 64 * 272 + 128 * 144 + 64 * 144;
constexpr int SC_SSQ = 2 * SC_BUF;
__device__ __forceinline__ int sc_lds_off(int id) {
    if (id < 1024) return SC_WN + (id >> 4) * 272 + (id & 15) * 16;
    if (id < 2048) { const int q = id - 1024; return SC_QD + (q >> 4) * 272 + (q & 15) * 16; }
    if (id < 3072) { const int q = id - 2048; return SC_KD + (q >> 3) * 144 + (q & 7) * 16; }
    const int q = id - 3072; return SC_ATT + (q >> 3) * 144 + (q & 7) * 16;
}
__device__ __forceinline__ const v4u* sc_src(const unsigned char* ws, int item, int id) {
    if (id < 1024) return (const v4u*)(ws + WS_WN + (size_t)item * 16384) + id;
    if (id < 2048) return (const v4u*)(ws + WS_QD + (size_t)item * 16384) + (id - 1024);
    if (id < 3072) return (const v4u*)(ws + WS_KD + (size_t)item * 16384) + (id - 2048);
    return (const v4u*)(ws + WS_ATT + (size_t)item * 8192) + (id - 3072);
}
__device__ __forceinline__ bf16x8 pack_b(const f32x4 a, const f32x4 b) {
    v4u r; r.x = pk2(a.x, a.y); r.y = pk2(a.z, a.w); r.z = pk2(b.x, b.y); r.w = pk2(b.z, b.w);
    return __builtin_bit_cast(bf16x8, r);
}
#define SC_BAR() do { asm volatile("s_waitcnt lgkmcnt(0)" ::: "memory"); __builtin_amdgcn_s_barrier(); asm volatile("" ::: "memory"); } while (0)
#define SC_GLD(dst, ptr) asm volatile("global_load_dwordx4 %0, %1, off" : "=v"(dst) : "v"(ptr) : "memory")
#define PIN8(a) asm volatile("" : "+v"(a[0]), "+v"(a[1]), "+v"(a[2]), "+v"(a[3]), "+v"(a[4]), "+v"(a[5]), "+v"(a[6]), "+v"(a[7]))
#define PIN16(a) asm volatile("" : "+v"(a[0]), "+v"(a[1]), "+v"(a[2]), "+v"(a[3]), "+v"(a[4]), "+v"(a[5]), "+v"(a[6]), "+v"(a[7]), "+v"(a[8]), "+v"(a[9]), "+v"(a[10]), "+v"(a[11]), "+v"(a[12]), "+v"(a[13]), "+v"(a[14]), "+v"(a[15]))
constexpr int SCAN_NWC = 2, SCAN_PARTS = 4, SCAN_WGS = 8 * SCAN_PARTS;
constexpr int SC_UFS = 2 * SC_BUF;
constexpr int SC_DECS = SC_UFS + 2 * SCAN_NWC * 2048;
constexpr int SC_OT = SC_DECS + 512;
constexpr int SC_RDY = SC_OT + 2 * 64 * 36 * 4;
constexpr int SC_END = SC_RDY + 64;
static_assert(SC_END <= MISC_OFF, "scan LDS");
#ifndef SCAN_REPS
#define SCAN_REPS 1
#endif
#ifndef SCAN_EXP
#define SCAN_EXP 0
#endif
__device__ __forceinline__ int sc3_lds_off(int id) {
    if (id < 3584) return sc_lds_off(id);
    return SC_UFS + (id - 3584) * 16;
}
__device__ __forceinline__ const v4u* sc3_src(const unsigned char* ws, int item, int id, int part) {
    if (id < 3584) return sc_src(ws, item, id);
    return (const v4u*)(ws + WS_UF + (size_t)item * 16384 + (size_t)(part * SCAN_NWC) * 2048) + (id - 3584);
}
__device__ __forceinline__ void gdn_scan(const Params& P, LAS unsigned char* lds, int sb, int tid, int lane, int wave) {
    const unsigned char* ws = P.ws;
    constexpr int NCH = 128 * SCAN_REPS, NPC = 15;
    const int bh = sb & 7, part = sb >> 3;
    const int b = bh >> 2, h = bh & 3, col = lane & 15, g = lane >> 4;
    const int item0 = bh * 128;
    if (tid == 0) *(volatile LAS unsigned*)(lds + SC_RDY) = 0u;
    SC_BAR();
    if (wave >= 4) {
        constexpr int NP = 15, DEP = 3;
        const int lt = tid - 256;
        const unsigned voff = (unsigned)lt * 16u;
        const int lA = (lt >> 4) * 272 + (lt & 15) * 16, lB = (lt >> 3) * 144 + (lt & 7) * 16, lU = SC_UFS + lt * 16;
        v4u rs[DEP][NP];
#define SC_ISSUE(set, itm) do { const unsigned char* gq_ = ws + (size_t)(itm) * 16384; const unsigned char* ga_ = ws + WS_ATT + (size_t)(itm) * 8192; \
            asm volatile("s_nop 4\n\tglobal_load_dwordx4 %0, %8, %9 sc0 sc1\n\tglobal_load_dwordx4 %1, %8, %10 sc0 sc1\n\tglobal_load_dwordx4 %2, %8, %11 sc0 sc1\n\tglobal_load_dwordx4 %3, %8, %12 sc0 sc1\n\t" \
                         "global_load_dwordx4 %4, %8, %13 sc0 sc1\n\tglobal_load_dwordx4 %5, %8, %14 sc0 sc1\n\tglobal_load_dwordx4 %6, %8, %15 sc0 sc1\n\tglobal_load_dwordx4 %7, %8, %16 sc0 sc1" \
                : "=&v"(rs[set][0]), "=&v"(rs[set][1]), "=&v"(rs[set][2]), "=&v"(rs[set][3]), "=&v"(rs[set][4]), "=&v"(rs[set][5]), "=&v"(rs[set][6]), "=&v"(rs[set][7]) \
                : "v"(voff), "s"(gq_ + WS_WN), "s"(gq_ + WS_WN + 4096), "s"(gq_ + WS_WN + 8192), "s"(gq_ + WS_WN + 12288), \
                  "s"(gq_ + WS_QD), "s"(gq_ + WS_QD + 4096), "s"(gq_ + WS_QD + 8192), "s"(gq_ + WS_QD + 12288) : "memory"); \
            asm volatile("s_nop 4\n\tglobal_load_dwordx4 %0, %7, %8 sc0 sc1\n\tglobal_load_dwordx4 %1, %7, %9 sc0 sc1\n\tglobal_load_dwordx4 %2, %7, %10 sc0 sc1\n\tglobal_load_dwordx4 %3, %7, %11 sc0 sc1\n\t" \
                         "global_load_dwordx4 %4, %7, %12 sc0 sc1\n\tglobal_load_dwordx4 %5, %7, %13 sc0 sc1\n\tglobal_load_dwordx4 %6, %7, %14 sc0 sc1" \
                : "=&v"(rs[set][8]), "=&v"(rs[set][9]), "=&v"(rs[set][10]), "=&v"(rs[set][11]), "=&v"(rs[set][12]), "=&v"(rs[set][13]), "=&v"(rs[set][14]) \
                : "v"(voff), "s"(gq_ + WS_KD), "s"(gq_ + WS_KD + 4096), "s"(gq_ + WS_KD + 8192), "s"(gq_ + WS_KD + 12288), \
                  "s"(ga_), "s"(ga_ + 4096), "s"(gq_ + WS_UF + (size_t)(part * SCAN_NWC) * 2048) : "memory"); } while (0)
#define SC_WAITSET(set, cnt) asm volatile("s_waitcnt " cnt : "+v"(rs[set][0]), "+v"(rs[set][1]), "+v"(rs[set][2]), "+v"(rs[set][3]), "+v"(rs[set][4]), "+v"(rs[set][5]), "+v"(rs[set][6]), "+v"(rs[set][7]), \
            "+v"(rs[set][8]), "+v"(rs[set][9]), "+v"(rs[set][10]), "+v"(rs[set][11]), "+v"(rs[set][12]), "+v"(rs[set][13]), "+v"(rs[set][14]) :: "memory")
#define SC_WRITE(set, par) do { LAS unsigned char* wb_ = lds + (par) * SC_BUF; \
            _Pragma("unroll") for (int r = 0; r < 4; ++r) { *(LAS v4u*)(wb_ + SC_WN + lA + r * (16 * 272)) = rs[set][r]; *(LAS v4u*)(wb_ + SC_QD + lA + r * (16 * 272)) = rs[set][4 + r]; \
                                                          *(LAS v4u*)(wb_ + SC_KD + lB + r * (32 * 144)) = rs[set][8 + r]; } \
            *(LAS v4u*)(wb_ + SC_ATT + lB) = rs[set][12]; *(LAS v4u*)(wb_ + SC_ATT + lB + 32 * 144) = rs[set][13]; \
            *(LAS v4u*)(lds + lU + (par) * (SCAN_NWC * 2048)) = rs[set][14]; } while (0)
#define SC_NEED(c) do { unsigned sp_ = 0; while (*(volatile LAS unsigned*)(lds + SC_RDY) <= (unsigned)(c) && ++sp_ < (1u << 24)) __builtin_amdgcn_s_sleep(2); } while (0)
        SC_NEED(0); SC_ISSUE(0, item0);
        SC_WAITSET(0, "vmcnt(0)"); SC_WRITE(0, 0); SC_WAITSET(0, "lgkmcnt(0)");
        SC_NEED(3); SC_ISSUE(1, item0 + 1); SC_ISSUE(2, item0 + 2); SC_ISSUE(0, item0 + 3);
        SC_BAR();
        int n2 = 0;
#define SC_INTERVAL(set) do { SC_WAITSET(set, "vmcnt(30)"); SC_WRITE(set, (n2 + 1) & 1); SC_WAITSET(set, "lgkmcnt(0)"); if (n2 + 1 + DEP < 128) SC_NEED(n2 + 1 + DEP); SC_ISSUE(set, item0 + ((n2 + 1 + DEP) & 127)); SC_BAR(); ++n2; } while (0)
#pragma unroll 1
        for (int it = 0; it < NCH / 3; ++it) { SC_INTERVAL(1); SC_INTERVAL(2); SC_INTERVAL(0); }
        if (NCH % 3 >= 1) SC_INTERVAL(1);
        if (NCH % 3 >= 2) SC_INTERVAL(2);
        SC_WAITSET(0, "vmcnt(0)"); SC_WAITSET(1, "vmcnt(0)"); SC_WAITSET(2, "vmcnt(0)");
#undef SC_INTERVAL
#undef SC_NEED
#undef SC_WRITE
#undef SC_WAITSET
#undef SC_ISSUE
        return;
    }
    if (wave == 3) {
        const unsigned* flags = (const unsigned*)(ws + WS_CTL) + CW_GFLAG + item0;
        unsigned rdy = 0;
#define SC_POLLSTEP() do { if (rdy < 128u) { const unsigned idx_ = rdy + (unsigned)lane; \
            const unsigned fv_ = (idx_ < 128u) ? __hip_atomic_load(flags + idx_, __ATOMIC_RELAXED, __HIP_MEMORY_SCOPE_AGENT) : 0u; \
            const unsigned long long m_ = __ballot(fv_ != 0u); const unsigned nrun_ = (m_ == ~0ull) ? 64u : (unsigned)__builtin_ctzll(~m_);     \
            if ((unsigned)lane < nrun_) ((LAS float*)(lds + SC_DECS))[idx_] = __builtin_bit_cast(float, fv_); \
            rdy += nrun_; LDS_WAIT(); if (lane == 0) *(volatile LAS unsigned*)(lds + SC_RDY) = rdy; } } while (0)
        { unsigned sp = 0; while (rdy < 4u && ++sp < (1u << 22)) { SC_POLLSTEP(); if (rdy < 4u) __builtin_amdgcn_s_sleep(16); } }
        SC_BAR();
#pragma unroll 1
        for (int n2 = 0; n2 < NCH; ++n2) {
            { const unsigned need = (unsigned)(n2 + 1 + 3) < 128u ? (unsigned)(n2 + 1 + 3) : 127u; unsigned sp = 0;
              while (rdy <= need && rdy < 128u && ++sp < (1u << 22)) { SC_POLLSTEP(); if (rdy <= need) __builtin_amdgcn_s_sleep(8); } }
            if (rdy < 128u && rdy < (unsigned)(n2 & 127) + 16u) SC_POLLSTEP();
            SC_BAR();
        }
#undef SC_POLLSTEP
        return;
    }
    if (wave == 2) {
        const int row = lane;
        bf16* Y = (bf16*)((unsigned char*)P.out + OUT_Y);
        float* SSQG = P.out;
        SC_BAR();
#pragma unroll 1
        for (int n2 = 0; n2 <= NCH; ++n2) {
            if (n2 > 0) {
                const int n = (n2 - 1) & 127, t = b * SEQ + n * 64 + row;
                const LAS float* src = (const LAS float*)(lds + SC_OT + ((n2 - 1) & 1) * (64 * 36 * 4)) + row * 36;
                f32x4 a[8]; float s2 = 0.f;
#pragma unroll
                for (int q = 0; q < 8; ++q) { a[q] = *(const LAS f32x4*)(src + 4 * q); s2 += (a[q].x * a[q].x + a[q].y * a[q].y) + (a[q].z * a[q].z + a[q].w * a[q].w); }
                SSQG[(size_t)t * 32 + h * 8 + part] = s2;
                v4u* d = (v4u*)(Y + (size_t)t * 1024 + h * 128 + 32 * part);
#pragma unroll
                for (int q = 0; q < 4; ++q) { v4u o; o.x = pk2(a[2 * q].x, a[2 * q].y); o.y = pk2(a[2 * q].z, a[2 * q].w); o.z = pk2(a[2 * q + 1].x, a[2 * q + 1].y); o.w = pk2(a[2 * q + 1].z, a[2 * q + 1].w); d[q] = o; }
            }
            if (n2 < NCH) SC_BAR();
        }
        return;
    }
    f32x4 S[8];
#pragma unroll
    for (int i = 0; i < 8; ++i) S[i] = (f32x4){0.f, 0.f, 0.f, 0.f};
    SC_BAR();
#pragma unroll 1
    for (int n2 = 0; n2 < NCH; ++n2) {
        if (SCAN_REPS > 1 && (n2 & 127) == 0) {
#pragma unroll
            for (int i = 0; i < 8; ++i) S[i] = (f32x4){0.f, 0.f, 0.f, 0.f};
        }
        if (SCAN_EXP == 2 && n2 < 128) { SC_BAR(); continue; }
        const int par = n2 & 1;
        LAS unsigned char* buf = lds + par * SC_BUF;
        bf16x8 fA[16], fB[16], fC[16], fD[8];
#pragma unroll
        for (int rho = 0; rho < 4; ++rho)
#pragma unroll
            for (int s = 0; s < 4; ++s) fA[rho * 4 + s] = *(const LAS bf16x8*)(buf + SC_WN + (16 * rho + col) * 272 + (32 * s + 8 * g) * 2);
#pragma unroll
        for (int rho = 0; rho < 4; ++rho)
#pragma unroll
            for (int s = 0; s < 4; ++s) fB[rho * 4 + s] = *(const LAS bf16x8*)(buf + SC_QD + (16 * rho + col) * 272 + (32 * s + 8 * g) * 2);
        const LAS v4u* ufp = (const LAS v4u*)(lds + SC_UFS + par * (SCAN_NWC * 2048) + wave * 2048 + lane * 32);
        const v4u uf0 = ufp[0], uf1 = ufp[1];
        const float dec = ((const LAS float*)(lds + SC_DECS))[n2 & 127];
        bf16x8 Bs[4];
#pragma unroll
        for (int s = 0; s < 4; ++s) Bs[s] = pack_b(S[2 * s], S[2 * s + 1]);
        f32x4 Vn[4], Oc[4];
        Vn[0] = (f32x4){bflo(uf0.x), bfhi(uf0.x), bflo(uf0.y), bfhi(uf0.y)}; Vn[1] = (f32x4){bflo(uf0.z), bfhi(uf0.z), bflo(uf0.w), bfhi(uf0.w)};
        Vn[2] = (f32x4){bflo(uf1.x), bfhi(uf1.x), bflo(uf1.y), bfhi(uf1.y)}; Vn[3] = (f32x4){bflo(uf1.z), bfhi(uf1.z), bflo(uf1.w), bfhi(uf1.w)};
        __builtin_amdgcn_sched_barrier(0);
        PIN16(fA);
#pragma unroll
        for (int s = 0; s < 4; ++s)
#pragma unroll
            for (int rho = 0; rho < 4; ++rho) Vn[rho] = __builtin_amdgcn_mfma_f32_16x16x32_bf16(fA[rho * 4 + s], Bs[s], Vn[rho], 0, 0, 0);
        __builtin_amdgcn_sched_barrier(0);
#pragma unroll
        for (int tau = 0; tau < 8; ++tau)
#pragma unroll
            for (int s = 0; s < 2; ++s) fC[tau * 2 + s] = *(const LAS bf16x8*)(buf + SC_KD + (16 * tau + col) * 144 + (32 * s + 8 * g) * 2);
        __builtin_amdgcn_sched_barrier(0);
        PIN16(fB);
#pragma unroll
        for (int rho = 0; rho < 4; ++rho) Oc[rho] = (f32x4){0.f, 0.f, 0.f, 0.f};
#pragma unroll
        for (int s = 0; s < 4; ++s)
#pragma unroll
            for (int rho = 0; rho < 4; ++rho) Oc[rho] = __builtin_amdgcn_mfma_f32_16x16x32_bf16(fB[rho * 4 + s], Bs[s], Oc[rho], 0, 0, 0);
        __builtin_amdgcn_sched_barrier(0);
#pragma unroll
        for (int rho = 0; rho < 4; ++rho)
#pragma unroll
            for (int s = 0; s < 2; ++s) fD[rho * 2 + s] = *(const LAS bf16x8*)(buf + SC_ATT + (16 * rho + col) * 144 + (32 * s + 8 * g) * 2);
        bf16x8 Bv[2];
        Bv[0] = pack_b(Vn[0], Vn[1]); Bv[1] = pack_b(Vn[2], Vn[3]);
#pragma unroll
        for (int tau = 0; tau < 8; ++tau) S[tau] = S[tau] * dec;
        __builtin_amdgcn_sched_barrier(0);
        PIN16(fC);
#pragma unroll
        for (int s = 0; s < 2; ++s)
#pragma unroll
            for (int tau = 0; tau < 8; ++tau) S[tau] = __builtin_amdgcn_mfma_f32_16x16x32_bf16(fC[tau * 2 + s], Bv[s], S[tau], 0, 0, 0);
        __builtin_amdgcn_sched_barrier(0);
        PIN8(fD);
#pragma unroll
        for (int s = 0; s < 2; ++s)
#pragma unroll
            for (int rho = 0; rho < 4; ++rho) Oc[rho] = __builtin_amdgcn_mfma_f32_16x16x32_bf16(fD[rho * 2 + s], Bv[s], Oc[rho], 0, 0, 0);
        LAS float* ot = (LAS float*)(lds + SC_OT + par * (64 * 36 * 4)) + 16 * wave + col;
#pragma unroll
        for (int rho = 0; rho < 4; ++rho)
#pragma unroll
            for (int i = 0; i < 4; ++i) ot[(16 * rho + 4 * g + i) * 36] = Oc[rho][i];
        SC_BAR();
    }
}

__device__ __forceinline__ void lru_carry(const Params& P, int gwv, int lane) {
    unsigned char* ws = P.ws;
    const int b = gwv >> 3, g = gwv & 7, ch = g * 64 + lane;
    const float* HEND = (const float*)(ws + WS_HEND); const float* PEND = (const float*)(ws + WS_PEND); float* HIN = (float*)(ws + WS_HIN);
    float hin = 0.f;
#pragma unroll 1
    for (int n0 = 0; n0 < 128; n0 += 32) {
        float he[32], pe[32];
#pragma unroll
        for (int i = 0; i < 32; ++i) { const size_t o = (size_t)(b * 128 + n0 + i) * 512 + ch; he[i] = HEND[o]; pe[i] = PEND[o]; }
#pragma unroll
        for (int i = 0; i < 32; ++i) { HIN[(size_t)(b * 128 + n0 + i) * 512 + ch] = hin; hin = he[i] + pe[i] * hin; }
    }
}

__device__ __forceinline__ void cvt_table(const float* src, bf16* dst, size_t n8, size_t wi, size_t nw) {
    for (size_t i = wi; i < n8; i += nw) {
        const f32x4 a = ((const f32x4*)src)[2 * i], c = ((const f32x4*)src)[2 * i + 1];
        v4u o; o.x = pk2(a.x, a.y); o.y = pk2(a.z, a.w); o.z = pk2(c.x, c.y); o.w = pk2(c.z, c.w);
        ((v4u*)dst)[i] = o;
    }
}

__device__ __forceinline__ void lru_combine(const Params& P, size_t wi, size_t nw) {
    unsigned char* ws = P.ws;
    const v4u* HLOC = (const v4u*)(ws + WS_HLOC); const v4u* PCUM = (const v4u*)(ws + WS_PCUM); const v4u* GATE = (const v4u*)(ws + WS_GATE);
    const float* HIN = (const float*)(ws + WS_HIN); bf16* Y = (bf16*)((unsigned char*)P.out + OUT_Y);
    for (size_t i = wi; i < (size_t)T * 64; i += nw) {
        const size_t t = i >> 6; const int ch0 = (int)(i & 63) * 8;
        const v4u hl = HLOC[i], pc = PCUM[i], gt = GATE[i];
        const f32x4 h0 = *(const f32x4*)(HIN + (t >> 6) * 512 + ch0), h1 = *(const f32x4*)(HIN + (t >> 6) * 512 + ch0 + 4);
        float y[8];
        y[0] = (bflo(hl.x) + bflo(pc.x) * h0.x) * gelu_tanh(bflo(gt.x)); y[1] = (bfhi(hl.x) + bfhi(pc.x) * h0.y) * gelu_tanh(bfhi(gt.x));
        y[2] = (bflo(hl.y) + bflo(pc.y) * h0.z) * gelu_tanh(bflo(gt.y)); y[3] = (bfhi(hl.y) + bfhi(pc.y) * h0.w) * gelu_tanh(bfhi(gt.y));
        y[4] = (bflo(hl.z) + bflo(pc.z) * h1.x) * gelu_tanh(bflo(gt.z)); y[5] = (bfhi(hl.z) + bfhi(pc.z) * h1.y) * gelu_tanh(bfhi(gt.z));
        y[6] = (bflo(hl.w) + bflo(pc.w) * h1.z) * gelu_tanh(bflo(gt.w)); y[7] = (bfhi(hl.w) + bfhi(pc.w) * h1.w) * gelu_tanh(bfhi(gt.w));
        v4u o; o.x = pk2(y[0], y[1]); o.y = pk2(y[2], y[3]); o.z = pk2(y[4], y[5]); o.w = pk2(y[6], y[7]);
        *(v4u*)(Y + t * 1024 + 512 + ch0) = o;
    }
}

__device__ __forceinline__ void gdn_gate_norm(const Params& P, size_t wi, size_t nw) {
    unsigned char* ws = P.ws;
    bf16* Y = (bf16*)((unsigned char*)P.out + OUT_Y); const v4u* Z = (const v4u*)(ws + WS_Z); const float* SSQG = P.out;
    for (size_t i = wi; i < (size_t)T * 64; i += nw) {
        const size_t t = i >> 6; const int c0 = (int)(i & 63) * 8, h = c0 >> 7;
        const f32x4 q0 = *(const f32x4*)(SSQG + t * 32 + h * 8);
        const float rstd = rsqrtf(((q0.x + q0.y) + (q0.z + q0.w)) * (1.0f / 128.0f) + 1e-6f);
        const v4u o = *(const v4u*)(Y + t * 1024 + c0), z = Z[i];
        const f32x4 w0 = *(const f32x4*)(P.gdn_norm_w + (c0 & 127)), w1 = *(const f32x4*)(P.gdn_norm_w + (c0 & 127) + 4);
        float y[8];
        y[0] = bflo(o.x) * rstd * w0.x * siluf_(bflo(z.x)); y[1] = bfhi(o.x) * rstd * w0.y * siluf_(bfhi(z.x));
        y[2] = bflo(o.y) * rstd * w0.z * siluf_(bflo(z.y)); y[3] = bfhi(o.y) * rstd * w0.w * siluf_(bfhi(z.y));
        y[4] = bflo(o.z) * rstd * w1.x * siluf_(bflo(z.z)); y[5] = bfhi(o.z) * rstd * w1.y * siluf_(bfhi(z.z));
        y[6] = bflo(o.w) * rstd * w1.z * siluf_(bflo(z.w)); y[7] = bfhi(o.w) * rstd * w1.w * siluf_(bfhi(z.w));
        v4u r; r.x = pk2(y[0], y[1]); r.y = pk2(y[2], y[3]); r.z = pk2(y[4], y[5]); r.w = pk2(y[6], y[7]);
        *(v4u*)(Y + t * 1024 + c0) = r;
    }
}

__device__ __forceinline__ void xattn_stage(LAS unsigned char* lds, const bf16* src, int tid) {
    v4u tmp[16];
    asm volatile("" : "+v"(tid));
    const unsigned voff = (unsigned)tid * 16u;
#pragma unroll
    for (int r = 0; r < 16; ++r) { const unsigned char* sb = (const unsigned char*)src + r * 8192;
        asm volatile("s_nop 4\n\tglobal_load_dwordx4 %0, %1, %2" : "=&v"(tmp[r]) : "v"(voff), "s"(sb) : "memory"); }
    asm volatile("s_waitcnt vmcnt(0)" : "+v"(tmp[0]), "+v"(tmp[1]), "+v"(tmp[2]), "+v"(tmp[3]), "+v"(tmp[4]), "+v"(tmp[5]), "+v"(tmp[6]), "+v"(tmp[7]),
                                        "+v"(tmp[8]), "+v"(tmp[9]), "+v"(tmp[10]), "+v"(tmp[11]), "+v"(tmp[12]), "+v"(tmp[13]), "+v"(tmp[14]), "+v"(tmp[15]) :: "memory");
#pragma unroll
    for (int r = 0; r < 16; ++r) { const int id = tid + 512 * r; *(LAS v4u*)(lds + (id >> 5) * 528 + (id & 31) * 16) = tmp[r]; }
}
#ifndef XA_NPS
#define XA_NPS 2
#endif
__device__ __forceinline__ void xattn_unit(const Params& P, LAS unsigned char* lds, int unit, int tid, int lane, int wave) {
    const unsigned char* ws = P.ws;
    const int h = unit & 3, qb = (unit >> 2) & 63, b = unit >> 8; int col = lane & 15, g = lane >> 4;
    const int tw = b * SEQ + qb * 128 + 16 * wave;
    const bf16* Kb = (const bf16*)(ws + WS_KB) + (size_t)((b * 4 + h) * 256) * 256;
    const bf16* Vt = (const bf16*)(ws + WS_VTP) + (size_t)((b * 4 + h) * 256) * 256;
    xattn_stage(lds, Kb, tid);
    __syncthreads();
    const LAS unsigned char* arow = lds + col * 528 + g * 16;
    bf16x8 Bp[XA_NPS][8]; float inv[XA_NPS];
#pragma unroll
    for (int ps = 0; ps < XA_NPS; ++ps) {
        __builtin_amdgcn_sched_barrier(0); asm volatile("" : "+v"(col), "+v"(g) :: "memory");
        const bf16* Q = (const bf16*)(ws + WS_Q) + (size_t)(tw + 128 * ps + col) * 1024 + h * 256 + 8 * g;
        bf16x8 Bq[8];
#pragma unroll
        for (int s = 0; s < 8; ++s) Bq[s] = *(const bf16x8*)(Q + 32 * s);
        f32x4 St[16];
        bf16x8 fr[2][8];
#pragma unroll
        for (int s = 0; s < 8; ++s) fr[0][s] = *(const LAS bf16x8*)(arow + 64 * s);
#pragma unroll
        for (int kap = 0; kap < 16; ++kap) {
            if (kap + 1 < 16) {
#pragma unroll
                for (int s = 0; s < 8; ++s) fr[(kap + 1) & 1][s] = *(const LAS bf16x8*)(arow + (16 * (kap + 1)) * 528 + 64 * s);
            }
            __builtin_amdgcn_sched_barrier(0);
            PIN8(fr[kap & 1]);
            f32x4 acc = (f32x4){0.f, 0.f, 0.f, 0.f};
#pragma unroll
            for (int s = 0; s < 8; ++s) acc = __builtin_amdgcn_mfma_f32_16x16x32_bf16(fr[kap & 1][s], Bq[s], acc, 0, 0, 0);
            St[kap] = acc;
            __builtin_amdgcn_sched_barrier(0);
        }
        float mx = -3.0e38f;
#pragma unroll
        for (int kap = 0; kap < 16; ++kap) mx = fmaxf(fmaxf(fmaxf(St[kap].x, St[kap].y), fmaxf(St[kap].z, St[kap].w)), mx);
        mx = fmaxf(mx, __shfl_xor(mx, 16)); mx = fmaxf(mx, __shfl_xor(mx, 32));
        float l = 0.f;
#pragma unroll
        for (int kap = 0; kap < 16; ++kap) { St[kap].x = __expf(St[kap].x - mx); St[kap].y = __expf(St[kap].y - mx); St[kap].z = __expf(St[kap].z - mx); St[kap].w = __expf(St[kap].w - mx);
            l += (St[kap].x + St[kap].y) + (St[kap].z + St[kap].w); }
        l += __shfl_xor(l, 16); l += __shfl_xor(l, 32);
        inv[ps] = 1.0f / l;
#pragma unroll
        for (int s = 0; s < 8; ++s) Bp[ps][s] = pack_b(St[2 * s], St[2 * s + 1]);
    }
    __syncthreads();
    xattn_stage(lds, Vt, tid);
    __syncthreads();
#pragma unroll
    for (int ps = 0; ps < XA_NPS; ++ps) {
        __builtin_amdgcn_sched_barrier(0); asm volatile("" : "+v"(col), "+v"(g) :: "memory");
        bf16* AO = (bf16*)(P.ws + WS_AO) + (size_t)(tw + 128 * ps + col) * 1024 + h * 256 + 4 * g;
        bf16x8 fr[2][8];
#pragma unroll
        for (int s = 0; s < 8; ++s) fr[0][s] = *(const LAS bf16x8*)(arow + 64 * s);
#pragma unroll
        for (int del = 0; del < 16; ++del) {
            if (del + 1 < 16) {
#pragma unroll
                for (int s = 0; s < 8; ++s) fr[(del + 1) & 1][s] = *(const LAS bf16x8*)(arow + (16 * (del + 1)) * 528 + 64 * s);
            }
            __builtin_amdgcn_sched_barrier(0);
            PIN8(fr[del & 1]);
            f32x4 acc = (f32x4){0.f, 0.f, 0.f, 0.f};
#pragma unroll
            for (int s = 0; s < 8; ++s) acc = __builtin_amdgcn_mfma_f32_16x16x32_bf16(fr[del & 1][s], Bp[ps][s], acc, 0, 0, 0);
            v2u o; o.x = pk2(acc.x * inv[ps], acc.y * inv[ps]); o.y = pk2(acc.z * inv[ps], acc.w * inv[ps]);
            *(v2u*)(AO + 16 * del) = o;
            __builtin_amdgcn_sched_barrier(0);
        }
    }
    __syncthreads();
}

__device__ __forceinline__ unsigned key_enc(float f) { const unsigned u = __builtin_bit_cast(unsigned, f); return (u & 0x80000000u) ? ~u : (u | 0x80000000u); }
__device__ __forceinline__ float key_dec(unsigned k) { const unsigned u = (k & 0x80000000u) ? (k & 0x7fffffffu) : ~k; return __builtin_bit_cast(float, u); }
#define TK_CAS(a, b) do { const unsigned hi_ = max(a, b), lo_ = min(a, b); a = hi_; b = lo_; } while (0)
__device__ __forceinline__ void tk_merge16(unsigned (&a)[16]) {
#pragma unroll
    for (int j = 8; j > 0; j >>= 1)
#pragma unroll
        for (int i = 0; i < 16; ++i) { const int l = i ^ j; if (l > i) TK_CAS(a[i], a[l]); }
}
__device__ __forceinline__ void tk_sort16(unsigned (&a)[16]) {
#define TK_L(...) do { const int pr_[] = {__VA_ARGS__}; _Pragma("unroll") for (int q_ = 0; q_ < (int)(sizeof(pr_) / sizeof(int)); q_ += 2) TK_CAS(a[pr_[q_]], a[pr_[q_ + 1]]); } while (0)
    TK_CAS(a[0], a[13]); TK_CAS(a[1], a[12]); TK_CAS(a[2], a[15]); TK_CAS(a[3], a[14]); TK_CAS(a[4], a[8]); TK_CAS(a[5], a[6]); TK_CAS(a[7], a[11]); TK_CAS(a[9], a[10]);
    TK_CAS(a[0], a[5]); TK_CAS(a[1], a[7]); TK_CAS(a[2], a[9]); TK_CAS(a[3], a[4]); TK_CAS(a[6], a[13]); TK_CAS(a[8], a[14]); TK_CAS(a[10], a[15]); TK_CAS(a[11], a[12]);
    TK_CAS(a[0], a[1]); TK_CAS(a[2], a[3]); TK_CAS(a[4], a[5]); TK_CAS(a[6], a[8]); TK_CAS(a[7], a[9]); TK_CAS(a[10], a[11]); TK_CAS(a[12], a[13]); TK_CAS(a[14], a[15]);
    TK_CAS(a[0], a[2]); TK_CAS(a[1], a[3]); TK_CAS(a[4], a[10]); TK_CAS(a[5], a[11]); TK_CAS(a[6], a[7]); TK_CAS(a[8], a[9]); TK_CAS(a[12], a[14]); TK_CAS(a[13], a[15]);
    TK_CAS(a[1], a[2]); TK_CAS(a[3], a[12]); TK_CAS(a[4], a[6]); TK_CAS(a[5], a[7]); TK_CAS(a[8], a[10]); TK_CAS(a[9], a[11]); TK_CAS(a[13], a[14]);
    TK_CAS(a[1], a[4]); TK_CAS(a[2], a[6]); TK_CAS(a[5], a[8]); TK_CAS(a[7], a[10]); TK_CAS(a[9], a[13]); TK_CAS(a[11], a[14]);
    TK_CAS(a[2], a[4]); TK_CAS(a[3], a[6]); TK_CAS(a[9], a[12]); TK_CAS(a[11], a[13]);
    TK_CAS(a[3], a[5]); TK_CAS(a[6], a[8]); TK_CAS(a[7], a[9]); TK_CAS(a[10], a[12]);
    TK_CAS(a[3], a[4]); TK_CAS(a[5], a[6]); TK_CAS(a[7], a[8]); TK_CAS(a[9], a[10]); TK_CAS(a[11], a[12]);
    TK_CAS(a[6], a[7]); TK_CAS(a[8], a[9]);
#undef TK_L
}
__device__ __forceinline__ void tk_top16_merge(unsigned (&L)[16], const unsigned (&G)[16]) {
#pragma unroll
    for (int i = 0; i < 16; ++i) L[i] = max(L[i], G[15 - i]);
    tk_merge16(L);
}
__device__ __forceinline__ void tk_pair_merge(unsigned (&L)[16]) {
    unsigned Pp[16];
#pragma unroll
    for (int i = 0; i < 16; ++i) Pp[i] = (unsigned)__builtin_amdgcn_update_dpp(0, (int)L[i], 0xB1, 0xF, 0xF, true);
    tk_top16_merge(L, Pp);
}
__device__ __forceinline__ void peer_topk_rows(const Params& P, LAS unsigned char* lds, int rowbase, int tid) {
    const unsigned char* ws = P.ws;
    typedef _Float16 f16x8 __attribute__((ext_vector_type(8)));
    const int rl = tid >> 1, hf = tid & 1, grow = rowbase + rl, t = grow >> 3, h = grow & 7;
    const _Float16* SC = (const _Float16*)(ws + WS_PQ) + (size_t)t * 2048 + h * 256 + 64 * hf;
    f16x8 raw[2][8];
#pragma unroll
    for (int p = 0; p < 2; ++p)
#pragma unroll
        for (int q = 0; q < 8; ++q) raw[p][q] = *(const f16x8*)(SC + p * 128 + 8 * q);
    unsigned L1[16], L2[16];
#pragma unroll
    for (int p = 0; p < 2; ++p) {
        unsigned L[16];
#pragma unroll
        for (int grp = 0; grp < 4; ++grp) {
            unsigned G[16];
#pragma unroll
            for (int e = 0; e < 16; ++e) G[e] = (key_enc((float)raw[p][2 * grp + (e >> 3)][e & 7]) & ~127u) | (unsigned)(127 - (64 * hf + 16 * grp + e));
            tk_sort16(G);
            if (grp == 0) {
#pragma unroll
                for (int i = 0; i < 16; ++i) L[i] = G[i];
            } else tk_top16_merge(L, G);
        }
        tk_pair_merge(L);
#pragma unroll
        for (int i = 0; i < 16; ++i) { if (p == 0) L1[i] = L[i]; else L2[i] = L[i]; }
    }
    {
        float v1[16], v2[16];
        LAS int* il = (LAS int*)lds + rl * 33;
#pragma unroll
        for (int q = 0; q < 16; ++q) { v1[q] = key_dec((L1[q] & ~127u) | 64u); v2[q] = key_dec((L2[q] & ~127u) | 64u); }
        if (hf == 0) {
#pragma unroll
            for (int q = 0; q < 16; ++q) { il[q] = 127 - (int)(L1[q] & 127u); il[16 + q] = 127 - (int)(L2[q] & 127u); }
        }
        unsigned C[16], D[16];
        float w1[8];
        const unsigned hf16 = (unsigned)hf * 16u, evenmask = (unsigned)hf - 1u;
#pragma unroll
        for (int k = 0; k < 8; ++k) w1[k] = __builtin_bit_cast(float, (__builtin_bit_cast(unsigned, v1[2 * k]) & evenmask) | (__builtin_bit_cast(unsigned, v1[2 * k + 1]) & ~evenmask));
#define TK_SLOT(dst, k, bq, valid_odd) do { const unsigned pos_ = (unsigned)(16 * (2 * (k)) + (bq)) + hf16; unsigned kv_ = (key_enc(w1[k] + v2[bq]) & ~255u) | (255u - pos_); if (!(valid_odd)) kv_ &= evenmask; dst = kv_; } while (0)
        TK_SLOT(C[0], 0, 0, true);
        TK_SLOT(C[1], 0, 1, true);
        TK_SLOT(C[2], 0, 2, true);
        TK_SLOT(C[3], 0, 3, true);
        TK_SLOT(C[4], 0, 4, true);
        TK_SLOT(C[5], 0, 5, true);
        TK_SLOT(C[6], 0, 6, true);
        TK_SLOT(C[7], 0, 7, true);
        TK_SLOT(C[8], 0, 8, false);
        TK_SLOT(C[9], 0, 9, false);
        TK_SLOT(C[10], 0, 10, false);
        TK_SLOT(C[11], 0, 11, false);
        TK_SLOT(C[12], 0, 12, false);
        TK_SLOT(C[13], 0, 13, false);
        TK_SLOT(C[14], 0, 14, false);
        TK_SLOT(C[15], 0, 15, false);
        TK_SLOT(D[0], 1, 0, true);
        TK_SLOT(D[1], 1, 1, true);
        TK_SLOT(D[2], 1, 2, true);
        TK_SLOT(D[3], 1, 3, true);
        TK_SLOT(D[4], 1, 4, false);
        TK_SLOT(D[5], 2, 0, true);
        TK_SLOT(D[6], 2, 1, true);
        TK_SLOT(D[7], 2, 2, false);
        TK_SLOT(D[8], 3, 0, true);
        TK_SLOT(D[9], 3, 1, true);
        TK_SLOT(D[10], 4, 0, true);
        TK_SLOT(D[11], 5, 0, true);
        TK_SLOT(D[12], 6, 0, true);
        TK_SLOT(D[13], 7, 0, true);
        D[14] = 0u; D[15] = 0u;
#undef TK_SLOT
        tk_sort16(C); tk_sort16(D); tk_top16_merge(C, D); tk_pair_merge(C);
        LDS_WAIT(); asm volatile("" ::: "memory");
        float best[16], e[16], sum = 0.f;
#pragma unroll
        for (int q = 0; q < 16; ++q) { best[q] = key_dec((C[q] & ~255u) | 128u); e[q] = __expf(best[q] - best[0]); sum += e[q]; }
        const float inv = __builtin_amdgcn_rcpf(sum);
        int* IDX = (int*)(P.ws + WS_IDX) + (size_t)grow * 16 + 8 * hf; float* GW = (float*)(P.ws + WS_GW) + (size_t)grow * 16 + 8 * hf;
#pragma unroll
        for (int q = 0; q < 8; ++q) {
            const unsigned c = (C[q] & evenmask) | (C[8 + q] & ~evenmask);
            const float ev = __builtin_bit_cast(float, (__builtin_bit_cast(unsigned, e[q]) & evenmask) | (__builtin_bit_cast(unsigned, e[8 + q]) & ~evenmask));
            const unsigned pos = 255u - (c & 255u);
            IDX[q] = il[pos >> 4] * 128 + il[16 + (pos & 15u)]; GW[q] = ev * inv;
        }
    }
    LDS_WAIT(); asm volatile("" ::: "memory");
}

__device__ __forceinline__ void peer_topk_wave(const Params& P, LAS int* ilw, LAS unsigned* oute, LAS float* outg, int tbase, int lane) {
    const unsigned char* ws = P.ws;
    typedef _Float16 f16x8 __attribute__((ext_vector_type(8)));
    const int rl = lane >> 1, hf = lane & 1, t = tbase + (rl >> 3), h = rl & 7;
    const _Float16* SC = (const _Float16*)(ws + WS_PQ) + (size_t)t * 2048 + h * 256 + 64 * hf;
    f16x8 raw[2][8];
#pragma unroll
    for (int p = 0; p < 2; ++p)
#pragma unroll
        for (int q = 0; q < 8; ++q) raw[p][q] = *(const f16x8*)(SC + p * 128 + 8 * q);
    unsigned L1[16], L2[16];
    typedef short s16x2 __attribute__((ext_vector_type(2)));
    const unsigned lanebit = 64u - 64u * (unsigned)hf;
#pragma unroll
    for (int p = 0; p < 2; ++p) {
        unsigned L[16];
#pragma unroll
        for (int grp = 0; grp < 4; ++grp) {
            unsigned G[16];
#pragma unroll
            for (int e2 = 0; e2 < 8; ++e2) {
                const v4u wv = __builtin_bit_cast(v4u, raw[p][2 * grp + (e2 >> 2)]);
                const unsigned w = wv[e2 & 3];
                const unsigned m = __builtin_bit_cast(unsigned, __builtin_bit_cast(s16x2, w) >> (s16x2){15, 15}) | 0x80008000u;
                const unsigned k = w ^ m;
                G[2 * e2] = (k << 16) | (unsigned)(63 - (16 * grp + 2 * e2));
                G[2 * e2 + 1] = (k & 0xffff0000u) | (unsigned)(63 - (16 * grp + 2 * e2 + 1));
            }
            tk_sort16(G);
            if (grp == 0) {
#pragma unroll
                for (int i = 0; i < 16; ++i) L[i] = G[i];
            } else tk_top16_merge(L, G);
        }
#pragma unroll
        for (int i = 0; i < 16; ++i) L[i] |= lanebit;
        tk_pair_merge(L);
#pragma unroll
        for (int i = 0; i < 16; ++i) { if (p == 0) L1[i] = L[i]; else L2[i] = L[i]; }
    }
    {
        float v1[16], v2[16];
        LAS int* il = ilw + rl * 33;
#pragma unroll
        for (int q = 0; q < 16; ++q) {
            const unsigned a = L1[q], c = L2[q];
            const unsigned ha = (a >> 16) ^ ((~(unsigned)((int)a >> 31) | 0x8000u) & 0xffffu), hc = (c >> 16) ^ ((~(unsigned)((int)c >> 31) | 0x8000u) & 0xffffu);
            v1[q] = (float)__builtin_bit_cast(_Float16, (unsigned short)ha); v2[q] = (float)__builtin_bit_cast(_Float16, (unsigned short)hc); }
        if (hf == 0) {
#pragma unroll
            for (int q = 0; q < 16; ++q) { il[q] = 127 - (int)(L1[q] & 127u); il[16 + q] = 127 - (int)(L2[q] & 127u); }
        }
        unsigned C[16], D[16];
        float w1[8];
        const unsigned hf16 = (unsigned)hf * 16u, evenmask = (unsigned)hf - 1u;
#pragma unroll
        for (int k = 0; k < 8; ++k) w1[k] = __builtin_bit_cast(float, (__builtin_bit_cast(unsigned, v1[2 * k]) & evenmask) | (__builtin_bit_cast(unsigned, v1[2 * k + 1]) & ~evenmask));
#define TK_SLOT(dst, k, bq, valid_odd) do { const unsigned pos_ = (unsigned)(16 * (2 * (k)) + (bq)) + hf16; unsigned kv_ = (key_enc(w1[k] + v2[bq]) & ~255u) | (255u - pos_); if (!(valid_odd)) kv_ &= evenmask; dst = kv_; } while (0)
        TK_SLOT(C[0], 0, 0, true);
        TK_SLOT(C[1], 0, 1, true);
        TK_SLOT(C[2], 0, 2, true);
        TK_SLOT(C[3], 0, 3, true);
        TK_SLOT(C[4], 0, 4, true);
        TK_SLOT(C[5], 0, 5, true);
        TK_SLOT(C[6], 0, 6, true);
        TK_SLOT(C[7], 0, 7, true);
        TK_SLOT(C[8], 0, 8, false);
        TK_SLOT(C[9], 0, 9, false);
        TK_SLOT(C[10], 0, 10, false);
        TK_SLOT(C[11], 0, 11, false);
        TK_SLOT(C[12], 0, 12, false);
        TK_SLOT(C[13], 0, 13, false);
        TK_SLOT(C[14], 0, 14, false);
        TK_SLOT(C[15], 0, 15, false);
        TK_SLOT(D[0], 1, 0, true);
        TK_SLOT(D[1], 1, 1, true);
        TK_SLOT(D[2], 1, 2, true);
        TK_SLOT(D[3], 1, 3, true);
        TK_SLOT(D[4], 1, 4, false);
        TK_SLOT(D[5], 2, 0, true);
        TK_SLOT(D[6], 2, 1, true);
        TK_SLOT(D[7], 2, 2, false);
        TK_SLOT(D[8], 3, 0, true);
        TK_SLOT(D[9], 3, 1, true);
        TK_SLOT(D[10], 4, 0, true);
        TK_SLOT(D[11], 5, 0, true);
        TK_SLOT(D[12], 6, 0, true);
        TK_SLOT(D[13], 7, 0, true);
        D[14] = 0u; D[15] = 0u;
#undef TK_SLOT
        tk_sort16(C); tk_sort16(D); tk_top16_merge(C, D); tk_pair_merge(C);
        LDS_WAIT(); asm volatile("" ::: "memory");
        float best[16], e[16], sum = 0.f;
#pragma unroll
        for (int q = 0; q < 16; ++q) { best[q] = key_dec((C[q] & ~255u) | 128u); e[q] = __expf(best[q] - best[0]); sum += e[q]; }
        const float inv = __builtin_amdgcn_rcpf(sum);
        LAS unsigned* IDX = oute + rl * 16 + 8 * hf; LAS float* GW = outg + rl * 16 + 8 * hf;
#pragma unroll
        for (int q = 0; q < 8; ++q) {
            const unsigned c = (C[q] & evenmask) | (C[8 + q] & ~evenmask);
            const float ev = __builtin_bit_cast(float, (__builtin_bit_cast(unsigned, e[q]) & evenmask) | (__builtin_bit_cast(unsigned, e[8 + q]) & ~evenmask));
            const unsigned pos = 255u - (c & 255u);
            IDX[q] = (unsigned)(il[pos >> 4] * 128 + il[16 + (pos & 15u)]); GW[q] = ev * inv;
        }
    }
    LDS_WAIT(); asm volatile("" ::: "memory");
}

typedef float f32x2 __attribute__((ext_vector_type(2)));
__device__ __forceinline__ unsigned q8(float x) { return (unsigned)(int)rintf(x) & 0xffu; }
__device__ __forceinline__ void cvt_table_fp8(const float* src, unsigned char* dst, float* scl, int gw, int ngw, int lane) {
    for (int row = gw; row < 16384; row += ngw) {
        const f32x4* sp = (const f32x4*)(src + (size_t)row * 1024 + 16 * lane);
        const f32x4 a0 = sp[0], a1 = sp[1], a2 = sp[2], a3 = sp[3];
        float m = fmaxf(fmaxf(fmaxf(fabsf(a0.x), fabsf(a0.y)), fmaxf(fabsf(a0.z), fabsf(a0.w))), fmaxf(fmaxf(fabsf(a1.x), fabsf(a1.y)), fmaxf(fabsf(a1.z), fabsf(a1.w))));
        m = fmaxf(m, fmaxf(fmaxf(fmaxf(fabsf(a2.x), fabsf(a2.y)), fmaxf(fabsf(a2.z), fabsf(a2.w))), fmaxf(fmaxf(fabsf(a3.x), fabsf(a3.y)), fmaxf(fabsf(a3.z), fabsf(a3.w)))));
#pragma unroll
        for (int o = 1; o < 64; o <<= 1) m = fmaxf(m, __shfl_xor(m, o));
        m = fmaxf(m, 1e-30f);
        const float q = 127.0f / m;
        v4u o;
        o.x = q8(a0.x * q) | (q8(a0.y * q) << 8) | (q8(a0.z * q) << 16) | (q8(a0.w * q) << 24);
        o.y = q8(a1.x * q) | (q8(a1.y * q) << 8) | (q8(a1.z * q) << 16) | (q8(a1.w * q) << 24);
        o.z = q8(a2.x * q) | (q8(a2.y * q) << 8) | (q8(a2.z * q) << 16) | (q8(a2.w * q) << 24);
        o.w = q8(a3.x * q) | (q8(a3.y * q) << 8) | (q8(a3.z * q) << 16) | (q8(a3.w * q) << 24);
        *(v4u*)(dst + (size_t)row * 1024 + 16 * lane) = o;
        if (lane == 0) scl[row] = m * (1.0f / 127.0f);
    }
}
__device__ __forceinline__ int row16_sum_i(int v) {
    v += __builtin_amdgcn_update_dpp(0, v, 0xB1, 0xF, 0xF, true);
    v += __builtin_amdgcn_update_dpp(0, v, 0x4E, 0xF, 0xF, true);
    v += __builtin_amdgcn_update_dpp(0, v, 0x141, 0xF, 0xF, true);
    v += __builtin_amdgcn_update_dpp(0, v, 0x140, 0xF, 0xF, true);
    return v;
}
#ifndef PE_NR_N
#define PE_NR_N 8
#endif
constexpr int PE_NT = 4, PE_NR = PE_NR_N, PE_SH = (PE_NR_N == 16 ? 10 : 11), PE_DEP = 3;
constexpr int PE_TOK_W = 128 * 3 + 20;
constexpr int PE_ENT_W = 272 * 4;
constexpr int PE_WAVE_W = PE_NT * PE_TOK_W + PE_ENT_W + 32 * 33 + 2 * PE_NT * 128;
static_assert(8 * PE_WAVE_W * 4 <= MISC_OFF && PE_NR * PE_NT <= 64, "peer LDS / batch-list geometry");
#define PE_LD(dst, voff_, sbase_) asm volatile("s_nop 4\n\tglobal_load_dwordx4 %0, %1, %2" : "=&v"(dst) : "v"(voff_), "s"(sbase_) : "memory")
__device__ __forceinline__ void peer_pass(const Params& P, LAS unsigned char* lds, int tbase, int lane, int wave, float* dstbase, int emask = 0x3fff) {
    asm volatile("v_mbcnt_lo_u32_b32 %0, -1, 0\n\tv_mbcnt_hi_u32_b32 %0, -1, %0" : "=v"(lane));
    {
        LAS unsigned* lw0 = (LAS unsigned*)(lds) + wave * PE_WAVE_W + PE_NT * PE_TOK_W + PE_ENT_W;
        peer_topk_wave(P, (LAS int*)lw0, lw0 + 32 * 33, (LAS float*)(lw0 + 32 * 33 + PE_NT * 128), tbase, lane);
        LDS_WAIT(); asm volatile("" : "+v"(lane), "+s"(tbase) :: "memory");
    }
    const unsigned char* ws = P.ws;
    const unsigned char* UB8 = ws + WS_UB; const unsigned char* VB8 = ws + WS_VB;
    const float* USC = (const float*)(ws + WS_USC); const float* VSC = (const float*)(ws + WS_VSC);
    f32x2 acc[PE_NT][8];
    LAS unsigned* lw = (LAS unsigned*)(lds) + wave * PE_WAVE_W;
    LAS unsigned* ents = lw + PE_NT * PE_TOK_W;
    const unsigned voff = (unsigned)lane * 16u;
    LAS unsigned* upe = ents + PE_ENT_W + 32 * 33; LAS float* upg = (LAS float*)(upe + PE_NT * 128);
    LAS unsigned* hql = ents + PE_ENT_W;
#pragma unroll
    for (int j = 0; j < PE_NT; ++j) {
        const int t = tbase + j;
        const v4u* xrow = (const v4u*)((const bf16*)(ws + WS_XB) + (size_t)t * 1024 + 16 * lane);
        const v4u xa = xrow[0], xc = xrow[1];
        const f32x4 xvv[4] = {(f32x4){bflo(xa.x), bfhi(xa.x), bflo(xa.y), bfhi(xa.y)}, (f32x4){bflo(xa.z), bfhi(xa.z), bflo(xa.w), bfhi(xa.w)},
                              (f32x4){bflo(xc.x), bfhi(xc.x), bflo(xc.y), bfhi(xc.y)}, (f32x4){bflo(xc.z), bfhi(xc.z), bflo(xc.w), bfhi(xc.w)}};
        const float rstd2 = rsqrtf(((const float*)(ws + WS_SSQ2))[t] * (1.0f / 1024.0f) + 1e-6f);
        f32x4 hv[4]; float hm = 0.f;
#pragma unroll
        for (int i = 0; i < 4; ++i) { const f32x4 xv = xvv[i]; const f32x4 w = ((const f32x4*)(P.norm_ffn_w + 16 * lane))[i];
            hv[i] = (f32x4){xv.x * rstd2 * w.x, xv.y * rstd2 * w.y, xv.z * rstd2 * w.z, xv.w * rstd2 * w.w};
            hm = fmaxf(hm, fmaxf(fmaxf(fabsf(hv[i].x), fabsf(hv[i].y)), fmaxf(fabsf(hv[i].z), fabsf(hv[i].w)))); }
#pragma unroll
        for (int o = 1; o < 64; o <<= 1) hm = fmaxf(hm, __shfl_xor(hm, o));
        hm = fmaxf(hm, 1e-30f);
        const float hqs = 127.0f / hm, hs = hm * (1.0f / 127.0f);
        { unsigned hqv[4];
#pragma unroll
          for (int i = 0; i < 4; ++i) hqv[i] = q8(hv[i].x * hqs) | (q8(hv[i].y * hqs) << 8) | (q8(hv[i].z * hqs) << 16) | (q8(hv[i].w * hqs) << 24);
          *(LAS v4u*)(hql + (j * 64 + lane) * 4) = (v4u){hqv[0], hqv[1], hqv[2], hqv[3]}; }
#pragma unroll
        for (int i = 0; i < 8; ++i) acc[j][i] = (f32x2){0.f, 0.f};
        const int e0 = (int)upe[j * 128 + 2 * lane] & emask, e1 = (int)upe[j * 128 + 2 * lane + 1] & emask;
        const float g0 = upg[j * 128 + 2 * lane] * VSC[e0], g1 = upg[j * 128 + 2 * lane + 1] * VSC[e1];
        const float u0 = USC[e0] * hs, u1 = USC[e1] * hs;
        const int rev = (tbase >= T / 2) ? (PE_NR - 1) : 0;
        const int b0 = (e0 >> PE_SH) ^ rev, b1 = (e1 >> PE_SH) ^ rev;
        LAS unsigned* lt = lw + j * PE_TOK_W;
        int run = 0, p0 = 0, p1 = 0;
        unsigned mystart = 0;
#pragma unroll
        for (int bk = 0; bk < PE_NR; ++bk) {
            const unsigned long long m0 = __ballot(b0 == bk), m1 = __ballot(b1 == bk);
            const int c0 = __popcll(m0), c1 = __popcll(m1);
            const int r0 = (int)__builtin_amdgcn_mbcnt_hi((unsigned)(m0 >> 32), __builtin_amdgcn_mbcnt_lo((unsigned)m0, 0u));
            const int r1 = (int)__builtin_amdgcn_mbcnt_hi((unsigned)(m1 >> 32), __builtin_amdgcn_mbcnt_lo((unsigned)m1, 0u));
            p0 = (b0 == bk) ? run + r0 : p0;
            p1 = (b1 == bk) ? run + c0 + r1 : p1;
            mystart = (lane == bk) ? (unsigned)run : mystart;
            run += c0 + c1;
        }
        lt[p0] = (unsigned)e0; lt[128 + p0] = __builtin_bit_cast(unsigned, g0); lt[256 + p0] = __builtin_bit_cast(unsigned, u0);
        lt[p1] = (unsigned)e1; lt[128 + p1] = __builtin_bit_cast(unsigned, g1); lt[256 + p1] = __builtin_bit_cast(unsigned, u1);
        if (lane < PE_NR) lt[384 + lane] = mystart;
        if (lane == 0) lt[384 + PE_NR] = 128u;
        asm volatile("" ::: "memory");
    }
    LDS_WAIT(); asm volatile("" ::: "memory");
    int nb;
    {
        const int rd = lane >> 2, j = (rd & 1) ? 3 - (lane & 3) : (lane & 3);
        const LAS unsigned* lt = lw + j * PE_TOK_W;
        const int n0 = rd < PE_NR ? (int)lt[384 + rd] : 128, n1 = rd < PE_NR ? (int)lt[384 + rd + 1] : 128;
        const int nbl = (n1 - n0 + 3) >> 2;
        int inc = nbl;
#pragma unroll
        for (int off = 1; off < 64; off <<= 1) { const int tv = __shfl_up(inc, off); if (lane >= off) inc += tv; }
        nb = __builtin_amdgcn_readlane(inc, 63);
        const int ofs = inc - nbl;
#pragma unroll 1
        for (int q = 0; q < nbl; ++q) { const int i0 = n0 + 4 * q, c = (n1 - i0) < 4 ? (n1 - i0) : 4;
            const unsigned e0 = lt[i0], e1 = lt[i0 + (c > 1 ? 1 : c - 1)], e2 = lt[i0 + (c > 2 ? 2 : c - 1)], e3 = lt[i0 + (c > 3 ? 3 : c - 1)];
            *(LAS v4u*)(ents + 4 * (ofs + q)) = (v4u){e0 | (((unsigned)j | ((unsigned)c << 2) | ((unsigned)i0 << 5)) << 14), e1, e2, e3}; }
        if (lane < 12) *(LAS v4u*)(ents + 4 * (nb + lane)) = (v4u){0u, 0u, 0u, 0u};
    }
    LDS_WAIT(); asm volatile("" ::: "memory");
    constexpr int PE_RD = 6;
    v4u rr[PE_RD][4];
#define PE_LDO(dst, vo_, sbase_) asm volatile("global_load_dwordx4 %0, %1, %2" : "=&v"(dst) : "v"(vo_), "s"(sbase_) : "memory")
#define PE_ISSUE(S, rec_, BASE) do { \
        { const unsigned vo_ = (((rec_).x & 0x3fffu) << 10) + voff; PE_LDO(rr[S][0], vo_, BASE); } { const unsigned vo_ = ((rec_).y << 10) + voff; PE_LDO(rr[S][1], vo_, BASE); } \
        { const unsigned vo_ = ((rec_).z << 10) + voff; PE_LDO(rr[S][2], vo_, BASE); } { const unsigned vo_ = ((rec_).w << 10) + voff; PE_LDO(rr[S][3], vo_, BASE); } } while (0)
#define PE_WAIT4(S, cntstr) asm volatile("s_waitcnt " cntstr : "+v"(rr[S][0]), "+v"(rr[S][1]), "+v"(rr[S][2]), "+v"(rr[S][3]) :: "memory")
#define PE_UDOTS(S) asm("v_dot4_i32_i8 %0, %4, %20, 0\n\tv_dot4_i32_i8 %1, %8, %20, 0\n\tv_dot4_i32_i8 %2, %12, %20, 0\n\tv_dot4_i32_i8 %3, %16, %20, 0\n\t" \
                        "v_dot4_i32_i8 %0, %5, %21, %0\n\tv_dot4_i32_i8 %1, %9, %21, %1\n\tv_dot4_i32_i8 %2, %13, %21, %2\n\tv_dot4_i32_i8 %3, %17, %21, %3\n\t" \
                        "v_dot4_i32_i8 %0, %6, %22, %0\n\tv_dot4_i32_i8 %1, %10, %22, %1\n\tv_dot4_i32_i8 %2, %14, %22, %2\n\tv_dot4_i32_i8 %3, %18, %22, %3\n\t" \
                        "v_dot4_i32_i8 %0, %7, %23, %0\n\tv_dot4_i32_i8 %1, %11, %23, %1\n\tv_dot4_i32_i8 %2, %15, %23, %2\n\tv_dot4_i32_i8 %3, %19, %23, %3\n\ts_nop 2" \
        : "=&v"(d_[0]), "=&v"(d_[1]), "=&v"(d_[2]), "=&v"(d_[3]) \
        : "v"(rr[S][0].x), "v"(rr[S][0].y), "v"(rr[S][0].z), "v"(rr[S][0].w), "v"(rr[S][1].x), "v"(rr[S][1].y), "v"(rr[S][1].z), "v"(rr[S][1].w), \
          "v"(rr[S][2].x), "v"(rr[S][2].y), "v"(rr[S][2].z), "v"(rr[S][2].w), "v"(rr[S][3].x), "v"(rr[S][3].y), "v"(rr[S][3].z), "v"(rr[S][3].w), \
          "v"(hcur.x), "v"(hcur.y), "v"(hcur.z), "v"(hcur.w))
#define PE_VDOTS(f0, f1, f2, f3, b0, b1, b2, b3, w) asm("v_dot4_i32_i8 %0, %4, %8, 0\n\tv_dot4_i32_i8 %1, %5, %8, 0\n\tv_dot4_i32_i8 %2, %6, %8, 0\n\tv_dot4_i32_i8 %3, %7, %8, 0\n\t" \
                        "v_cvt_f32_i32_e32 %0, %0\n\tv_cvt_f32_i32_e32 %1, %1\n\tv_cvt_f32_i32_e32 %2, %2\n\tv_cvt_f32_i32_e32 %3, %3" \
        : "=&v"(f0), "=&v"(f1), "=&v"(f2), "=&v"(f3) : "v"(b0), "v"(b1), "v"(b2), "v"(b3), "v"(w))
#define PE_UBATCH(S, entv) do { const unsigned en_ = (entv) >> 14; const int jj_ = (int)(en_ & 3u), cc_ = (int)((en_ >> 2) & 7u), ii_ = (int)(en_ >> 5); \
        if (cc_ > 0) { if (jj_ != jcur) { jcur = jj_; hcur = *(const LAS v4u*)(hql + (jj_ * 64 + lane) * 4); } \
            LAS unsigned* lt_ = lw + jj_ * PE_TOK_W; const int myk_ = lane >> 4; \
            const float gsc_ = __builtin_bit_cast(float, lt_[128 + ii_ + myk_]), usc_ = __builtin_bit_cast(float, lt_[256 + ii_ + myk_]);     \
            int d_[4]; \
            PE_UDOTS(S); \
            int r1_; \
            { const v2u p02_ = __builtin_amdgcn_permlane32_swap((unsigned)d_[0], (unsigned)d_[2], false, false), p13_ = __builtin_amdgcn_permlane32_swap((unsigned)d_[1], (unsigned)d_[3], false, false); \
              const v2u q_ = __builtin_amdgcn_permlane16_swap(p02_.x + p02_.y, p13_.x + p13_.y, false, false); r1_ = row16_sum_i((int)(q_.x + q_.y)); }     \
            const float x_ = (float)r1_ * usc_, e_ = __builtin_amdgcn_exp2f(x_ * __builtin_fmaf(x_ * x_, -0.10294324f, -2.3022082f));     \
            const float act_ = x_ * __builtin_amdgcn_rcpf(1.0f + e_) * gsc_; \
            if ((lane & 15) == 0 && myk_ < cc_) lt_[128 + ii_ + myk_] = __builtin_bit_cast(unsigned, act_); } } while (0)
#define PE_FLUSH() do { _Pragma("unroll") for (int J_ = 0; J_ < PE_NT; ++J_) { const float sel_ = (jcur == J_) ? 1.0f : 0.0f; const f32x2 sel2_ = (f32x2){sel_, sel_};     \
            _Pragma("unroll") for (int i_ = 0; i_ < 8; ++i_) acc[J_][i_] = __builtin_elementwise_fma(cur[i_], sel2_, acc[J_][i_]); } \
        _Pragma("unroll") for (int i_ = 0; i_ < 8; ++i_) cur[i_] = (f32x2){0.f, 0.f}; } while (0)
#define PE_VBATCH(S, entv) do { const unsigned en_ = (entv) >> 14; const int jj_ = (int)(en_ & 3u), cc_ = (int)((en_ >> 2) & 7u), ii_ = (int)(en_ >> 5); \
        if (cc_ > 0) { if (jj_ != jcur) { PE_FLUSH(); jcur = jj_; } \
            const LAS unsigned* lt_ = lw + jj_ * PE_TOK_W + 128 + ii_; \
            const float w0_ = __builtin_bit_cast(float, lt_[0]), w1_ = (cc_ > 1) ? __builtin_bit_cast(float, lt_[1]) : 0.f, w2_ = (cc_ > 2) ? __builtin_bit_cast(float, lt_[2]) : 0.f, w3_ = (cc_ > 3) ? __builtin_bit_cast(float, lt_[3]) : 0.f; \
            const float wm_ = fmaxf(fmaxf(fmaxf(fabsf(w0_), fabsf(w1_)), fmaxf(fabsf(w2_), fabsf(w3_))), 1e-30f), wq_ = 127.0f * __builtin_amdgcn_rcpf(wm_), ws_ = wm_ * (1.0f / 127.0f); \
            const unsigned q0_ = __builtin_bit_cast(unsigned, __builtin_fmaf(w0_, wq_, 12582912.0f)), q1_ = __builtin_bit_cast(unsigned, __builtin_fmaf(w1_, wq_, 12582912.0f)), \
                           q2_ = __builtin_bit_cast(unsigned, __builtin_fmaf(w2_, wq_, 12582912.0f)), q3_ = __builtin_bit_cast(unsigned, __builtin_fmaf(w3_, wq_, 12582912.0f)); \
            const unsigned w4u_ = __builtin_amdgcn_perm(__builtin_amdgcn_perm(q3_, q2_, 0x0c0c0400u), __builtin_amdgcn_perm(q1_, q0_, 0x0c0c0400u), 0x05040100u);     \
            const f32x2 ws2_ = (f32x2){ws_, ws_}; \
            _Pragma("unroll") for (int m_ = 0; m_ < 4; ++m_) { \
                const unsigned R0_ = rr[S][0][m_], R1_ = rr[S][1][m_], R2_ = rr[S][2][m_], R3_ = rr[S][3][m_]; \
                const unsigned X_ = __builtin_amdgcn_perm(R1_, R0_, 0x05010400u), Y_ = __builtin_amdgcn_perm(R1_, R0_, 0x07030602u), Z_ = __builtin_amdgcn_perm(R3_, R2_, 0x05010400u), W_ = __builtin_amdgcn_perm(R3_, R2_, 0x07030602u); \
                float t0_, t1_, t2_, t3_; \
                const unsigned b0_ = __builtin_amdgcn_perm(Z_, X_, 0x05040100u), b1_ = __builtin_amdgcn_perm(Z_, X_, 0x07060302u), b2_ = __builtin_amdgcn_perm(W_, Y_, 0x05040100u), b3_ = __builtin_amdgcn_perm(W_, Y_, 0x07060302u); \
                PE_VDOTS(t0_, t1_, t2_, t3_, b0_, b1_, b2_, b3_, w4u_); \
                cur[2 * m_] = __builtin_elementwise_fma((f32x2){t0_, t1_}, ws2_, cur[2 * m_]); \
                cur[2 * m_ + 1] = __builtin_elementwise_fma((f32x2){t2_, t3_}, ws2_, cur[2 * m_ + 1]); } } } while (0)
    {
        unsigned er[PE_RD];
#pragma unroll
        for (int q = 0; q < PE_RD; ++q) { const v4u rec = *(const LAS v4u*)(ents + 4 * q); er[q] = __builtin_amdgcn_readfirstlane(rec.x); PE_ISSUE(q, rec, UB8); }
        int jcur = (int)((er[0] >> 14) & 3u);
        v4u hcur = *(const LAS v4u*)(hql + (jcur * 64 + lane) * 4);
        v4u nrec = *(const LAS v4u*)(ents + 4 * PE_RD);
#pragma unroll 1
        for (int bi = 0; bi < nb; bi += PE_RD) {
#pragma unroll
            for (int q = 0; q < PE_RD; ++q) {
                PE_WAIT4(q, "vmcnt(20)");
                PE_UBATCH(q, er[q]);
                er[q] = __builtin_amdgcn_readfirstlane(nrec.x);
                PE_ISSUE(q, nrec, UB8);
                nrec = *(const LAS v4u*)(ents + 4 * (bi + q + PE_RD + 1));
            }
        }
#pragma unroll
        for (int q = 0; q < PE_RD; ++q) PE_WAIT4(q, "vmcnt(0)");
    }
    LDS_WAIT(); asm volatile("" ::: "memory");
    {
        unsigned er[PE_RD];
#pragma unroll
        for (int q = 0; q < PE_RD; ++q) { const v4u rec = *(const LAS v4u*)(ents + 4 * q); er[q] = __builtin_amdgcn_readfirstlane(rec.x); PE_ISSUE(q, rec, VB8); }
        f32x2 cur[8];
#pragma unroll
        for (int i = 0; i < 8; ++i) cur[i] = (f32x2){0.f, 0.f};
        int jcur = (int)((er[0] >> 14) & 3u);
        v4u nrec = *(const LAS v4u*)(ents + 4 * PE_RD);
#pragma unroll 1
        for (int bi = 0; bi < nb; bi += PE_RD) {
#pragma unroll
            for (int q = 0; q < PE_RD; ++q) {
                PE_WAIT4(q, "vmcnt(20)");
                PE_VBATCH(q, er[q]);
                er[q] = __builtin_amdgcn_readfirstlane(nrec.x);
                PE_ISSUE(q, nrec, VB8);
                nrec = *(const LAS v4u*)(ents + 4 * (bi + q + PE_RD + 1));
            }
        }
#pragma unroll
        for (int q = 0; q < PE_RD; ++q) PE_WAIT4(q, "vmcnt(0)");
        PE_FLUSH();
    }
#undef PE_UBATCH
#undef PE_VBATCH
#undef PE_FLUSH
#undef PE_WAIT4
#undef PE_ISSUE
#undef PE_LDO
#undef PE_UDOTS
#undef PE_VDOTS
    asm volatile("v_mbcnt_lo_u32_b32 %0, -1, 0\n\tv_mbcnt_hi_u32_b32 %0, -1, %0" : "=v"(lane)); asm volatile("" : "+s"(tbase));
#pragma unroll
    for (int j = 0; j < PE_NT; ++j) {
        const int t = tbase + j;
        float ss = 0.f; f32x4 xo[4];
        { const v4u* xrow = (const v4u*)((const bf16*)(ws + WS_XB) + (size_t)t * 1024 + 16 * lane); const v4u xa = xrow[0], xc = xrow[1];
          xo[0] = (f32x4){bflo(xa.x), bfhi(xa.x), bflo(xa.y), bfhi(xa.y)}; xo[1] = (f32x4){bflo(xa.z), bfhi(xa.z), bflo(xa.w), bfhi(xa.w)};
          xo[2] = (f32x4){bflo(xc.x), bfhi(xc.x), bflo(xc.y), bfhi(xc.y)}; xo[3] = (f32x4){bflo(xc.z), bfhi(xc.z), bflo(xc.w), bfhi(xc.w)}; }
#pragma unroll
        for (int i = 0; i < 4; ++i) { xo[i].x += acc[j][2 * i].x; xo[i].y += acc[j][2 * i].y; xo[i].z += acc[j][2 * i + 1].x; xo[i].w += acc[j][2 * i + 1].y;
            ss += (xo[i].x * xo[i].x + xo[i].y * xo[i].y) + (xo[i].z * xo[i].z + xo[i].w * xo[i].w); }
        const float rstd3 = rsqrtf(wave_sum(ss) * (1.0f / 1024.0f) + 1e-6f);
        float* orow = dstbase + (size_t)t * 1024 + 16 * lane;
#pragma unroll
        for (int i = 0; i < 4; ++i) { const f32x4 w = ((const f32x4*)(P.norm_final_w + 16 * lane))[i];
            ((f32x4*)orow)[i] = (f32x4){xo[i].x * rstd3 * w.x, xo[i].y * rstd3 * w.y, xo[i].z * rstd3 * w.z, xo[i].w * rstd3 * w.w}; }
    }
    LDS_WAIT(); asm volatile("s_waitcnt vmcnt(0)" ::: "memory");
}


#ifndef TWICE_MASK
#define TWICE_MASK 0
#endif
struct TwiceOrder { pg8::StaticOrder S; int per, reps;
    __device__ bool next(int i, pg8::Unit& u) const { if (i >= per * reps) return false; return S.next(i % per, u); }
    __device__ __forceinline__ void a_ready(const pg8::Unit&) const {} __device__ __forceinline__ void done(const pg8::Unit&) const {} };
template <class B> __device__ __forceinline__ bool rep_again(volatile LAS unsigned* MISC, B& bar) {
    __syncthreads(); const unsigned c = MISC[20]; __syncthreads();
    if (threadIdx.x == 0) MISC[20] = c ^ 1u;
    __syncthreads();
    if (c == 0u) { xcd_barrier(bar); return true; }
    return false;
}
__global__ void __launch_bounds__(NWAVES * 64, 2) hybrid_fwd(Params P) {
    extern __shared__ __attribute__((aligned(16))) unsigned char lds_raw[];
    LAS unsigned char* lds = (LAS unsigned char*)lds_raw;
    volatile LAS unsigned* MISC = (volatile LAS unsigned*)(lds + MISC_OFF);
    const int tid = threadIdx.x, lane = tid & 63, wave = __builtin_amdgcn_readfirstlane(tid >> 6);
    const int G = gridDim.x, bx = blockIdx.x;
    const int vcu = (G % 8 == 0) ? (bx % 8) * (G / 8) + bx / 8 : bx;
    unsigned char* ws = P.ws;
    for (int u = tid; u < 64; u += NWAVES * 64) MISC[u] = 0u;
    __syncthreads();
    XcdBarrier bar; bar.bar = (unsigned*)(ws + WS_CTL) + CW_BAR; bar.x = 0; bar.st = nullptr;
    if (!MK_PER_PHASE) bar = xcd_barrier_post((unsigned*)(ws + WS_CTL) + CW_BAR, MISC + 8);
    const int lo = P.ph_lo, hi = P.ph_hi;
#ifndef PHASE_MASK
#define PHASE_MASK 0xFFF
#endif
#define IN(k) (((PHASE_MASK >> (k)) & 1) && lo <= (k) && (k) < hi)
#define SEAM(k) do { if (IN(k) && IN((k) + 1)) xcd_barrier(bar); } while (0)
#ifndef REP_MASK
#define REP_MASK 0
#endif
#ifndef PE_EXP_MASK
#define PE_EXP_MASK 0x3fff
#endif
#define REPS(k) for (bool again_ = true; again_; again_ = (((REP_MASK >> (k)) & 1) ? rep_again(MISC, bar) : false))
    using namespace pg8;
    bf16* XB = (bf16*)(ws + WS_XB);

    if (IN(0)) REPS(0) { p0_prologue(P, lds, tid, lane, wave, vcu, G); }
    SEAM(0);
    if (IN(1)) REPS(1) {
        { Gemm gm{XB, (const bf16_t*)(ws + WS_WIN), T, 3072, 1024}; StaticOrder S; S.init(T, 3072, G, bx);
          EpiBf16Rs E{(bf16_t*)(ws + WS_QKV), 1536, 6, (bf16_t*)(ws + WS_XR), 512, (size_t)T * 512, nullptr, 1.0f};
          gemm_phase<EpiBf16Rs, StaticOrder, PG8_ALIGN, PG8_SP2>(lds, gm, S, E); }
    }
    SEAM(1);
    if (IN(3)) REPS(3) {
        if (bx < SCAN_WGS) gdn_scan(P, lds, bx, tid, lane, wave);
        else {
            const int wk = bx - SCAN_WGS, NWK = G - SCAN_WGS;
            unsigned* lcnt = (unsigned*)(ws + WS_CTL) + CW_LRUCNT;
            for (int q = wk; q < 1024; q += NWK) gdn_local_item(P, lds, (q & 7) * 128 + (q >> 3), tid);
            unsigned ndone = 0;
            for (int lt = wk; lt < 256; lt += NWK) { lru_local_item(P, lds, lt, tid, lane, wave); ++ndone; }
            asm volatile("s_waitcnt vmcnt(0)" ::: "memory");
            __syncthreads();
            if (tid == 0 && ndone) { __builtin_amdgcn_fence(__ATOMIC_RELEASE, "agent"); asm volatile("s_waitcnt vmcnt(0)" ::: "memory");
                                     __hip_atomic_fetch_add(lcnt, ndone, __ATOMIC_RELAXED, __HIP_MEMORY_SCOPE_AGENT); }
            if (wk < 16) {
                struct OneUnit { int pm, pn; __device__ bool next(int i, Unit& u) const { if (i > 0) return false; u.pm = pm; u.pn = pn; return true; }
                                 __device__ void a_ready(const Unit&) const {} __device__ void done(const Unit&) const {} };
                Gemm gm{(const bf16_t*)(ws + WS_MEMN), (const bf16_t*)(ws + WS_WKV), 512, 2048, 1024}; OneUnit S{wk >> 3, wk & 7};
                EpiKV E{(bf16_t*)(ws + WS_KB), (bf16_t*)(ws + WS_VTP)};
                gemm_phase<EpiKV, OneUnit, PG8_ALIGN, PG8_SP2>(lds, gm, S, E);
            }
            if (wk == 16 || wk == 17) {
                if (tid == 0) { unsigned sp = 0;
                    while (__hip_atomic_load(lcnt, __ATOMIC_RELAXED, __HIP_MEMORY_SCOPE_AGENT) < 256u) { __builtin_amdgcn_s_sleep(8); if (++sp > (1u << 22)) break; }
                    __builtin_amdgcn_fence(__ATOMIC_ACQUIRE, "agent"); asm volatile("s_waitcnt vmcnt(0)" ::: "memory"); }
                __syncthreads();
                lru_carry(P, (wk - 16) * NWAVES + wave, lane);
                asm volatile("s_waitcnt vmcnt(0)" ::: "memory");
                __syncthreads();
                if (tid == 0) { __builtin_amdgcn_fence(__ATOMIC_RELEASE, "agent"); asm volatile("s_waitcnt vmcnt(0)" ::: "memory");
                                __hip_atomic_fetch_add(lcnt + 64, 1u, __ATOMIC_RELAXED, __HIP_MEMORY_SCOPE_AGENT); }
            } else {
                const int w2 = (wk < 16 ? wk : wk - 2), N2 = NWK - 2;
                cvt_table_fp8(P.peer_v, ws + WS_VB, (float*)(ws + WS_VSC), w2 * NWAVES + wave, N2 * NWAVES, lane);
                late_weight_prep(P, lds, lane, wave, w2 * NWAVES + wave, N2 * NWAVES);
                if (tid == 0) { unsigned sp = 0;
                    while (__hip_atomic_load(lcnt + 64, __ATOMIC_RELAXED, __HIP_MEMORY_SCOPE_AGENT) < 2u) { __builtin_amdgcn_s_sleep(8); if (++sp > (1u << 22)) break; }
                    __builtin_amdgcn_fence(__ATOMIC_ACQUIRE, "agent"); asm volatile("s_waitcnt vmcnt(0)" ::: "memory"); }
                __syncthreads();
                lru_combine(P, (size_t)w2 * (NWAVES * 64) + tid, (size_t)N2 * (NWAVES * 64));
            }
        }
    }
    SEAM(3);
    if (IN(4)) REPS(4) {
        gdn_gate_norm(P, (size_t)bx * (NWAVES * 64) + tid, (size_t)G * (NWAVES * 64));
        cvt_table_fp8(P.peer_u, ws + WS_UB, (float*)(ws + WS_USC), bx * NWAVES + wave, G * NWAVES, lane);
    }
    SEAM(4);
    if (IN(5)) {
        Gemm gm{(const bf16_t*)((const unsigned char*)P.out + OUT_Y), (const bf16_t*)(ws + WS_WOUT), T, 1024, 1024}; StaticOrder S; S.init(T, 1024, G, bx);
        EpiResidBf<true> E{P.x, XB, (float*)(ws + WS_SSQ1)};
        gemm_phase<EpiResidBf<true>, StaticOrder, PG8_ALIGN, PG8_SP2>(lds, gm, S, E);
    }
    SEAM(5);
    if (IN(6)) REPS(6) {
        Gemm gm{XB, (const bf16_t*)(ws + WS_WQ), T, 1024, 1024};
        EpiBf16Rs E{(bf16_t*)(ws + WS_Q), 1024, 4, nullptr, 256, 0, (const float*)(ws + WS_SSQ1), 0.0625f};
#if (TWICE_MASK >> 6) & 1
        { TwiceOrder S; S.S.init(T, 1024, G, bx); S.per = 1; S.reps = 2;
          gemm_phase<EpiBf16Rs, TwiceOrder, PG8_ALIGN, PG8_SP2>(lds, gm, S, E); }
#else
        { StaticOrder S; S.init(T, 1024, G, bx);
          gemm_phase<EpiBf16Rs, StaticOrder, PG8_ALIGN, PG8_SP2>(lds, gm, S, E); }
#endif
        Unit u;
        { const int wgid = (bx & 7) * 32 + (bx >> 3); u.pm = (wgid >> 5) * 8 + (wgid & 7); u.pn = (wgid & 31) >> 3; }
        if (G == 256) {
            asm volatile("s_waitcnt vmcnt(0)" ::: "memory");
            __syncthreads();
            const int b = u.pm >> 5, qb0 = (u.pm & 31) * 2, h = u.pn;
#pragma unroll 1
            for (int qq = 0; qq < (((TWICE_MASK >> 7) & 1) ? 4 : 2); qq += XA_NPS) xattn_unit(P, lds, (b << 8) | ((qb0 + (qq & 1)) << 2) | h, tid, lane, wave);
        }
    }
    if (IN(7)) REPS(7) { }
    SEAM(7);
    if (IN(8)) {
        Gemm gm{(const bf16_t*)(ws + WS_AO), (const bf16_t*)(ws + WS_WO), T, 1024, 1024}; StaticOrder S; S.init(T, 1024, G, bx);
        EpiResidBf<false> E{nullptr, XB, (float*)(ws + WS_SSQ2)};
        gemm_phase<EpiResidBf<false>, StaticOrder, PG8_ALIGN, PG8_SP2>(lds, gm, S, E);
    }
    SEAM(8);
    if (IN(9)) REPS(9) {
        Gemm gm{XB, (const bf16_t*)(ws + WS_PWQ), T, 2048, 1024};
        EpiF16Rs E{(_Float16*)(ws + WS_PQ), 2048, (const float*)(ws + WS_SSQ2)};
#if (TWICE_MASK >> 9) & 1
        TwiceOrder S; S.S.init(T, 2048, G, bx); S.per = 2; S.reps = 2;
        gemm_phase<EpiF16Rs, TwiceOrder, PG8_ALIGN, PG8_SP2>(lds, gm, S, E);
#else
        StaticOrder S; S.init(T, 2048, G, bx);
        gemm_phase<EpiF16Rs, StaticOrder, PG8_ALIGN, PG8_SP2>(lds, gm, S, E);
#endif
    }
    SEAM(9);
    if (IN(10)) REPS(10) {
    }
    if (IN(11)) REPS(11) {
#if (TWICE_MASK >> 11) & 1
        for (int it = 0; it < 4; ++it) { const int tb = (bx * NWAVES + wave) * PE_NT + (it >> 1) * (G * NWAVES * PE_NT); if (tb < T) peer_pass(P, lds, tb, lane, wave, P.out, (it & 1) ? 0x3fff : PE_EXP_MASK); }
#else
#ifndef PE_PASS_BARRIER
#define PE_PASS_BARRIER 0
#endif
        for (int tb = (bx * NWAVES + wave) * PE_NT, np = 0; tb < T; tb += G * NWAVES * PE_NT, ++np) {
            if (PE_PASS_BARRIER && np > 0 && (T % (G * NWAVES * PE_NT)) == 0) xcd_barrier(bar);
            peer_pass(P, lds, tb, lane, wave, P.out);
        }
#endif
    }
#undef IN
#undef SEAM
}

extern "C" void kernel_launch(void* const* d_in, const int* in_sizes, int n_in, void* d_out, int out_size, void* d_ws, size_t ws_size, hipStream_t stream) {
    static int grid = 0;
    if (grid == 0) {
        if (n_in != 27 || in_sizes[0] != T * D || out_size != T * D || ws_size < WS_END) {
            fprintf(stderr, "kernel_launch: unexpected shapes (n_in %d, in0 %d, out %d, ws %zu); nothing launched\n", n_in, n_in > 0 ? in_sizes[0] : -1, out_size, ws_size); grid = -1; return; }
        int dev = 0, cus = 0, per_cu = 0;
        if (hipGetDevice(&dev) != hipSuccess || hipDeviceGetAttribute(&cus, hipDeviceAttributeMultiprocessorCount, dev) != hipSuccess) { grid = -1; return; }
        if (hipFuncSetAttribute((const void*)hybrid_fwd, hipFuncAttributeMaxDynamicSharedMemorySize, LDS_BYTES) != hipSuccess) { fprintf(stderr, "kernel_launch: hipFuncSetAttribute failed\n"); grid = -1; return; }
        if (hipOccupancyMaxActiveBlocksPerMultiprocessor(&per_cu, (const void*)hybrid_fwd, NWAVES * 64, LDS_BYTES) != hipSuccess || per_cu < 1)
            fprintf(stderr, "kernel_launch: note: occupancy query reports %d workgroups per CU\n", per_cu);
        (void)hipGetLastError();
        grid = cus;
        if (grid != 256) fprintf(stderr, "kernel_launch: %d CUs (built for 256)\n", grid);
    }
    if (grid < 0) return;
    if (hipMemsetAsync((char*)d_ws + WS_CTL, 0, CTL_ZERO_BYTES, stream) != hipSuccess) { fprintf(stderr, "kernel_launch: hipMemsetAsync failed\n"); return; }
    Params p{};
    const float** pp = (const float**)&p;
    for (int i = 0; i < 27; ++i) pp[i] = (const float*)d_in[i];
    p.out = (float*)d_out; p.ws = (unsigned char*)d_ws;
#if MK_PER_PHASE
    for (int k = 0; k < N_PHASES; ++k) { p.ph_lo = k; p.ph_hi = k + 1; hipLaunchKernelGGL(hybrid_fwd, dim3(grid), dim3(NWAVES * 64), LDS_BYTES, stream, p); }
#else
    p.ph_lo = 0; p.ph_hi = N_PHASES;
    hipLaunchKernelGGL(hybrid_fwd, dim3(grid), dim3(NWAVES * 64), LDS_BYTES, stream, p);
#endif
    const hipError_t le = hipPeekAtLastError();
    if (le != hipSuccess) fprintf(stderr, "kernel_launch: launch failed: %s\n", hipGetErrorName(le));
}
```

```cpp
#include <hip/hip_runtime.h>
#include <cstdio>
#include <cstdint>
namespace pg8 {
#define PG8_LAS __attribute__((address_space(3)))
typedef unsigned short bf16_t;
typedef short bf16x8 __attribute__((ext_vector_type(8)));
typedef float f32x4 __attribute__((ext_vector_type(4)));
typedef unsigned u32x4 __attribute__((ext_vector_type(4)));
constexpr int BM = 256, BK = 64, HALF = 128, HTB = HALF * BK * 2  , STAGE_BYTES = 8 * HTB, NXCD = 8, WGM = 8;

__host__ __device__ __forceinline__ int lds_byte(int r, int c) { const int st = (r >> 4) * 2 + (c >> 5), rr = r & 15, cc = c & 31, ob = rr * 64 + cc * 2; return st * 1024 + (ob ^ (((ob >> 9) & 1) << 5)); }
__host__ __device__ __forceinline__ void stage_rc(int b, int& R, int& C) { const int st = b / 1024, sb = b % 1024, swz = sb ^ (((sb >> 9) & 1) << 5); R = (st >> 1) * 16 + swz / 64; C = (st & 1) * 32 + (swz % 64) / 2; }
__host__ __device__ __forceinline__ int perm32(int rho) { const int n = rho >> 4, i = rho & 15; return 8 * (i >> 2) + 4 * n + (i & 3); }

struct Unit { int pm, pn; };
struct Gemm { const bf16_t* A; const bf16_t* Bt; int M, N, K; };

struct StaticOrder {
    int nM, nN, nwg, G, c;
    __host__ __device__ void init(int M, int N, int G_, int c_) { nM = M / BM; nN = N / BM; nwg = nM * nN; G = G_; c = c_; }
    __host__ __device__ bool next(int i, Unit& u) const {
        const long L = (long)i * G + c; if (L >= nwg) return false;
        int wgid = (int)L; { const int q = nwg / NXCD, r = nwg % NXCD, xcd = wgid % NXCD, off = wgid / NXCD; wgid = (xcd < r ? xcd * (q + 1) : r * (q + 1) + (xcd - r) * q) + off; }
        const int nig = WGM * nN, gid = wgid / nig, fm = gid * WGM, gsz = (nM - fm) < WGM ? (nM - fm) : WGM;
        u.pm = fm + ((wgid % nig) % gsz); u.pn = (wgid % nig) / gsz; return true;
    }
    __device__ __forceinline__ void a_ready(const Unit&) const {}
    __device__ __forceinline__ void done(const Unit&) const {}
};

__device__ __forceinline__ unsigned cvt_pk_bf16(float lo, float hi) { unsigned r; asm volatile("v_cvt_pk_bf16_f32 %0, %1, %2" : "=v"(r) : "v"(lo), "v"(hi)); return r; }
template <class Epi, class Sched, bool ALIGN_EPI = false, bool SP2 = false>
__device__ __forceinline__ void gemm_phase(PG8_LAS unsigned char* lds, const Gemm g, const Sched& S, const Epi& E) {
    const int tid = threadIdx.x, wid = __builtin_amdgcn_readfirstlane(tid >> 6), lane = tid & 63, wr = wid >> 2, wc = wid & 3, fr = lane & 15, fq = lane >> 4;
    const int K = g.K, nt = K / BK;
    unsigned voffA[2], voffB[2];
#pragma unroll
    for (int i = 0; i < 2; ++i) { int R, C; stage_rc(tid * 16 + i * 8192, R, C); const int Rb = Epi::PERM ? ((R & ~31) + perm32(R & 31)) : R;
        voffA[i] = (unsigned)(R * K + C) * 2u; voffB[i] = (unsigned)(Rb * K + C) * 2u; }
    const size_t kstep = (size_t)(BK * 2);
    const size_t hstep = (size_t)HALF * K * 2;
    const size_t tstep = 2 * hstep;
    const unsigned ldsw = (unsigned)wid * 1024u;
    const int aoff = lds_byte(wr * 64 + fr, fq * 8), boff = lds_byte(wc * 32 + fr, fq * 8);
#define PG8_SA(b, h) (((b) * 2 + (h)) * HTB)
#define PG8_SB(b, h) ((4 + (b) * 2 + (h)) * HTB)
#define PG8_STAGE(bufoff, gbase, voff) do { _Pragma("unroll") for (int _i = 0; _i < 2; ++_i) \
        __builtin_amdgcn_global_load_lds((const unsigned*)((const char*)(gbase) + (voff)[_i]), (PG8_LAS unsigned*)(lds + (bufoff) + ldsw + _i * 8192), 16, 0, 0); } while (0)
#define PG8_LDA(dst, b, h) do { _Pragma("unroll") for (int m = 0; m < 4; ++m) _Pragma("unroll") for (int k = 0; k < 2; ++k) dst[m][k] = *(const PG8_LAS bf16x8*)(lds + PG8_SA(b, h) + aoff + m * 2048 + k * 1024); } while (0)
#define PG8_LDB(dst, b, h) do { _Pragma("unroll") for (int n = 0; n < 2; ++n) _Pragma("unroll") for (int k = 0; k < 2; ++k) dst[n][k] = *(const PG8_LAS bf16x8*)(lds + PG8_SB(b, h) + boff + n * 2048 + k * 1024); } while (0)
#define PG8_MMA(ai, bj, At, Bt) do { __builtin_amdgcn_s_setprio(1); _Pragma("unroll") for (int m = 0; m < 4; ++m) _Pragma("unroll") for (int n = 0; n < 2; ++n) _Pragma("unroll") for (int k = 0; k < 2; ++k) \
        acc[ai][bj][m][n] = __builtin_amdgcn_mfma_f32_16x16x32_bf16(Bt[n][k], At[m][k], acc[ai][bj][m][n], 0, 0, 0); __builtin_amdgcn_s_setprio(0); } while (0)
#define PG8_WAIT_V(n) asm volatile("s_waitcnt vmcnt(" #n ")" ::: "memory")
#define PG8_WAIT_L(n) asm volatile("s_waitcnt lgkmcnt(" #n ")" ::: "memory")
#define PG8_BAR __builtin_amdgcn_s_barrier()
#define PG8_SCHED __builtin_amdgcn_sched_barrier(0)
    Unit cur, nxt; int ui = 0;
    if (!S.next(0, cur)) return;
    f32x4 acc[2][2][4][2];
#pragma unroll
    for (int a = 0; a < 2; ++a)
#pragma unroll
        for (int b = 0; b < 2; ++b)
#pragma unroll
            for (int m = 0; m < 4; ++m)
#pragma unroll
                for (int n = 0; n < 2; ++n) acc[a][b][m][n] = (f32x4){0.f, 0.f, 0.f, 0.f};
    bf16x8 At[4][2], B0[2][2], B1[2][2];
    const char* cA = (const char*)g.A + (size_t)cur.pm * tstep; const char* cB = (const char*)g.Bt + (size_t)cur.pn * tstep;
    S.a_ready(cur);
    if constexpr (SP2) {
        PG8_STAGE(PG8_SB(0, 0), cB, voffB); PG8_STAGE(PG8_SB(0, 1), cB + hstep, voffB); PG8_STAGE(PG8_SA(0, 0), cA, voffA); PG8_STAGE(PG8_SA(0, 1), cA + hstep, voffA);
        if (wr == 1) PG8_BAR;
        PG8_WAIT_V(2); PG8_BAR;
        PG8_STAGE(PG8_SB(1, 0), cB + kstep, voffB); PG8_STAGE(PG8_SA(1, 0), cA + kstep, voffA); PG8_STAGE(PG8_SB(1, 1), cB + hstep + kstep, voffB);
        PG8_WAIT_V(6); PG8_BAR;
    } else {
        PG8_STAGE(PG8_SB(0, 0), cB, voffB); PG8_STAGE(PG8_SA(0, 0), cA, voffA); PG8_STAGE(PG8_SB(0, 1), cB + hstep, voffB); PG8_STAGE(PG8_SA(0, 1), cA + hstep, voffA);
        if (wr == 1) PG8_BAR;
        PG8_WAIT_V(4); PG8_BAR;
        PG8_STAGE(PG8_SB(1, 0), cB + kstep, voffB); PG8_STAGE(PG8_SA(1, 0), cA + kstep, voffA); PG8_STAGE(PG8_SB(1, 1), cB + hstep + kstep, voffB);
        PG8_WAIT_V(6); PG8_BAR;
    }
    for (;;) {
        const bool has_next = S.next(ui + 1, nxt);
        const char* nA = has_next ? (const char*)g.A + (size_t)nxt.pm * tstep : cA; const char* nB = has_next ? (const char*)g.Bt + (size_t)nxt.pn * tstep : cB;
        for (int t = 0; t < nt; t += 2) {
            const bool last = (t == nt - 2);
            const char* a1 = cA + (size_t)(t + 1) * kstep;
            const char* a2 = last ? nA : cA + (size_t)(t + 2) * kstep; const char* b2 = last ? nB : cB + (size_t)(t + 2) * kstep;
            const char* a3 = a2 + kstep; const char* b3 = b2 + kstep;
            if (last && has_next) S.a_ready(nxt);
            if constexpr (SP2) {
            PG8_LDB(B0, 0, 0); PG8_LDB(B1, 0, 1); PG8_SCHED; PG8_LDA(At, 0, 0); PG8_STAGE(PG8_SA(1, 1), a1 + hstep, voffA);
            PG8_WAIT_V(8); PG8_WAIT_L(0); PG8_BAR; PG8_MMA(0, 0, At, B0); PG8_MMA(0, 1, At, B1); PG8_BAR; PG8_SCHED;
            PG8_LDA(At, 0, 1); PG8_STAGE(PG8_SB(0, 0), b2, voffB); PG8_STAGE(PG8_SB(0, 1), b2 + hstep, voffB); PG8_STAGE(PG8_SA(0, 0), a2, voffA);
            PG8_WAIT_V(8); PG8_WAIT_L(0); PG8_BAR; PG8_MMA(1, 0, At, B0); PG8_MMA(1, 1, At, B1); PG8_BAR; PG8_SCHED;
            PG8_LDB(B0, 1, 0); PG8_LDB(B1, 1, 1); PG8_SCHED; PG8_LDA(At, 1, 0); PG8_STAGE(PG8_SA(0, 1), a2 + hstep, voffA);
            PG8_WAIT_V(8); PG8_WAIT_L(0); PG8_BAR; PG8_MMA(0, 0, At, B0); PG8_MMA(0, 1, At, B1); PG8_BAR; PG8_SCHED;
            PG8_LDA(At, 1, 1); PG8_STAGE(PG8_SB(1, 0), b3, voffB); PG8_STAGE(PG8_SB(1, 1), b3 + hstep, voffB); PG8_STAGE(PG8_SA(1, 0), a3, voffA);
            PG8_WAIT_V(8); PG8_WAIT_L(0); PG8_BAR; PG8_MMA(1, 0, At, B0); PG8_MMA(1, 1, At, B1); PG8_BAR; PG8_SCHED;
            } else {
            PG8_LDB(B0, 0, 0); PG8_SCHED; PG8_LDA(At, 0, 0); PG8_STAGE(PG8_SA(1, 1), a1 + hstep, voffA);
            PG8_WAIT_L(8); PG8_BAR; PG8_WAIT_L(0); PG8_MMA(0, 0, At, B0); PG8_BAR; PG8_SCHED;
            PG8_LDB(B1, 0, 1); PG8_STAGE(PG8_SB(0, 0), b2, voffB);
            PG8_BAR; PG8_WAIT_L(0); PG8_MMA(0, 1, At, B1); PG8_BAR;
            PG8_LDA(At, 0, 1); PG8_STAGE(PG8_SA(0, 0), a2, voffA);
            PG8_BAR; PG8_WAIT_L(0); PG8_MMA(1, 0, At, B0); PG8_BAR; PG8_SCHED;
            PG8_STAGE(PG8_SB(0, 1), b2 + hstep, voffB);
            PG8_WAIT_V(6); PG8_BAR; PG8_MMA(1, 1, At, B1); PG8_BAR;
            PG8_LDB(B0, 1, 0); PG8_SCHED; PG8_LDA(At, 1, 0); PG8_STAGE(PG8_SA(0, 1), a2 + hstep, voffA);
            PG8_WAIT_L(8); PG8_BAR; PG8_WAIT_L(0); PG8_MMA(0, 0, At, B0); PG8_BAR; PG8_SCHED;
            PG8_LDB(B1, 1, 1); PG8_STAGE(PG8_SB(1, 0), b3, voffB);
            PG8_BAR; PG8_WAIT_L(0); PG8_MMA(0, 1, At, B1); PG8_BAR;
            PG8_LDA(At, 1, 1); PG8_STAGE(PG8_SA(1, 0), a3, voffA);
            PG8_BAR; PG8_WAIT_L(0); PG8_MMA(1, 0, At, B0); PG8_BAR; PG8_SCHED;
            PG8_STAGE(PG8_SB(1, 1), b3 + hstep, voffB);
            PG8_WAIT_V(6); PG8_BAR; PG8_MMA(1, 1, At, B1); PG8_BAR;
            }
        }
        if constexpr (ALIGN_EPI) { if (wr == 0) PG8_BAR; }
        if constexpr (!Epi::AFTER_DRAIN) { E(acc, cur, wr, wc, fr, fq); S.done(cur); }
        if (!has_next) break;
#pragma unroll
        for (int a = 0; a < 2; ++a)
#pragma unroll
            for (int b = 0; b < 2; ++b)
#pragma unroll
                for (int m = 0; m < 4; ++m)
#pragma unroll
                    for (int n = 0; n < 2; ++n) acc[a][b][m][n] = (f32x4){0.f, 0.f, 0.f, 0.f};
        cur = nxt; cA = nA; cB = nB; ++ui;
        if constexpr (ALIGN_EPI) { if (wr == 1) PG8_BAR; }
    }
    PG8_WAIT_V(0);
    if constexpr (!ALIGN_EPI) { if (wr == 0) PG8_BAR; }
    PG8_BAR;
    if constexpr (Epi::AFTER_DRAIN) { E.fused(acc, cur, wr, wc, fr, fq, lds, wid, lane); S.done(cur); }
#undef PG8_SA
#undef PG8_SB
#undef PG8_STAGE
#undef PG8_LDA
#undef PG8_LDB
#undef PG8_MMA
#undef PG8_WAIT_V
#undef PG8_WAIT_L
#undef PG8_BAR
#undef PG8_SCHED
}
}

namespace pg8 {
__host__ __device__ __forceinline__ int permk(int kl) { return 8 * ((kl & 15) >> 2) + 4 * (kl >> 4) + (kl & 3); }
struct EpiBf16Rs {
    static constexpr bool PERM = true, AFTER_DRAIN = false;
    bf16_t* O0; int ld0; int ntile0; bf16_t* O1; int ld1; size_t stride1; const float* ssq; float cs;
    __device__ __forceinline__ void operator()(const f32x4 (&acc)[2][2][4][2], const Unit& u, int wr, int wc, int fr, int fq) const {
        bf16_t* base; int ld, colt;
        if (u.pn < ntile0) { base = O0; ld = ld0; colt = u.pn * BM; }
        else { const int q = u.pn - ntile0, per = ld1 / BM; base = O1 + (size_t)(q / per) * stride1; ld = ld1; colt = (q % per) * BM; }
        const int row0 = u.pm * BM + wr * 64 + fr, col0 = colt + wc * 32 + 8 * fq;
#pragma unroll
        for (int ai = 0; ai < 2; ++ai)
#pragma unroll
            for (int m = 0; m < 4; ++m) {
                const int row = row0 + ai * HALF + m * 16;
                float sc = cs; if (ssq) sc *= rsqrtf(ssq[row] * (1.0f / 1024.0f) + 1e-6f);
                bf16_t* rowp = base + (size_t)row * ld + col0;
#pragma unroll
                for (int bj = 0; bj < 2; ++bj) { const f32x4 v0 = acc[ai][bj][m][0] * sc, v1 = acc[ai][bj][m][1] * sc;
                    u32x4 w; w.x = cvt_pk_bf16(v0[0], v0[1]); w.y = cvt_pk_bf16(v0[2], v0[3]); w.z = cvt_pk_bf16(v1[0], v1[1]); w.w = cvt_pk_bf16(v1[2], v1[3]);
                    *(u32x4*)(rowp + bj * HALF) = w; } }
    }
};
struct EpiF16Rs {
    static constexpr bool PERM = true, AFTER_DRAIN = false;
    _Float16* O; int ld; const float* ssq;
    __device__ __forceinline__ void operator()(const f32x4 (&acc)[2][2][4][2], const Unit& u, int wr, int wc, int fr, int fq) const {
        typedef _Float16 f16x8 __attribute__((ext_vector_type(8)));
        const int row0 = u.pm * BM + wr * 64 + fr, col0 = u.pn * BM + wc * 32 + 8 * fq;
#pragma unroll
        for (int ai = 0; ai < 2; ++ai)
#pragma unroll
            for (int m = 0; m < 4; ++m) {
                const int row = row0 + ai * HALF + m * 16;
                const float sc = rsqrtf(ssq[row] * (1.0f / 1024.0f) + 1e-6f);
                _Float16* rowp = O + (size_t)row * ld + col0;
#pragma unroll
                for (int bj = 0; bj < 2; ++bj) { const f32x4 v0 = acc[ai][bj][m][0] * sc, v1 = acc[ai][bj][m][1] * sc;
                    f16x8 w; w[0] = (_Float16)v0[0]; w[1] = (_Float16)v0[1]; w[2] = (_Float16)v0[2]; w[3] = (_Float16)v0[3];
                    w[4] = (_Float16)v1[0]; w[5] = (_Float16)v1[1]; w[6] = (_Float16)v1[2]; w[7] = (_Float16)v1[3];
                    *(f16x8*)(rowp + bj * HALF) = w; } }
    }
};
template <bool BASE_F32> struct EpiResidBf {
    static constexpr bool PERM = true, AFTER_DRAIN = false;
    const float* basef; bf16_t* xb; float* ssq;
    __device__ __forceinline__ void operator()(const f32x4 (&acc)[2][2][4][2], const Unit& u, int wr, int wc, int fr, int fq) const {
        const int row0 = u.pm * BM + wr * 64 + fr, col0 = u.pn * BM + wc * 32 + 8 * fq;
#pragma unroll
        for (int ai = 0; ai < 2; ++ai)
#pragma unroll
            for (int m = 0; m < 4; ++m) {
                const int row = row0 + ai * HALF + m * 16; const size_t off = (size_t)row * 1024 + col0; float s = 0.f;
#pragma unroll
                for (int bj = 0; bj < 2; ++bj) { const size_t o2 = off + bj * HALF;
                    f32x4 b0, b1;
                    if (BASE_F32) { b0 = *(const f32x4*)(basef + o2); b1 = *(const f32x4*)(basef + o2 + 4); }
                    else { const u32x4 p = *(const u32x4*)(xb + o2);
                        b0 = (f32x4){__builtin_bit_cast(float, p.x << 16), __builtin_bit_cast(float, p.x & 0xffff0000u), __builtin_bit_cast(float, p.y << 16), __builtin_bit_cast(float, p.y & 0xffff0000u)};
                        b1 = (f32x4){__builtin_bit_cast(float, p.z << 16), __builtin_bit_cast(float, p.z & 0xffff0000u), __builtin_bit_cast(float, p.w << 16), __builtin_bit_cast(float, p.w & 0xffff0000u)}; }
                    const f32x4 o0 = b0 + acc[ai][bj][m][0], o1 = b1 + acc[ai][bj][m][1];
                    s += ((o0[0] * o0[0] + o0[1] * o0[1]) + (o0[2] * o0[2] + o0[3] * o0[3])) + ((o1[0] * o1[0] + o1[1] * o1[1]) + (o1[2] * o1[2] + o1[3] * o1[3]));
                    u32x4 w; w.x = cvt_pk_bf16(o0[0], o0[1]); w.y = cvt_pk_bf16(o0[2], o0[3]); w.z = cvt_pk_bf16(o1[0], o1[1]); w.w = cvt_pk_bf16(o1[2], o1[3]);
                    *(u32x4*)(xb + o2) = w; }
                s += __shfl_xor(s, 16); s += __shfl_xor(s, 32);
                if (fq == 0) atomicAdd(ssq + row, s);
            }
    }
};
struct EpiKV {
    static constexpr bool PERM = false, AFTER_DRAIN = false;
    bf16_t* Kb; bf16_t* VTp;
    __device__ __forceinline__ void operator()(const f32x4 (&acc)[2][2][4][2], const Unit& u, int wr, int wc, int fr, int fq) const {
        typedef unsigned u32x2v __attribute__((ext_vector_type(2)));
        const int row0 = u.pm * BM + wr * 64 + fr, col0 = u.pn * BM + wc * 32 + 4 * fq;
#pragma unroll
        for (int ai = 0; ai < 2; ++ai)
#pragma unroll
            for (int m = 0; m < 4; ++m) {
                const int row = row0 + ai * HALF + m * 16, b = row >> 8, key = row & 255;
#pragma unroll
                for (int bj = 0; bj < 2; ++bj)
#pragma unroll
                    for (int n = 0; n < 2; ++n) { const int col = col0 + bj * HALF + n * 16; const f32x4 v = acc[ai][bj][m][n];
                        const unsigned p01 = cvt_pk_bf16(v[0], v[1]), p23 = cvt_pk_bf16(v[2], v[3]);
                        if (col < 1024) { const int h = col >> 8, dh = col & 255; u32x2v w; w.x = p01; w.y = p23;
                            *(u32x2v*)(Kb + ((size_t)((b * 4 + h) * 256 + key)) * 256 + dh) = w; }
                        else { const int c2 = col - 1024, h = c2 >> 8, dv = c2 & 255, kp = (key & ~31) | permk(key & 31);
                            bf16_t* d = VTp + ((size_t)((b * 4 + h) * 256 + dv)) * 256 + kp;
                            d[0] = (bf16_t)(p01 & 0xffffu); d[256] = (bf16_t)(p01 >> 16); d[512] = (bf16_t)(p23 & 0xffffu); d[768] = (bf16_t)(p23 >> 16); } }
            }
    }
};
}
#ifndef PG8_SP2
#define PG8_SP2 true
#endif
#ifndef PG8_ALIGN
#define PG8_ALIGN true
#endif

constexpr int NWAVES = 8;
#ifndef MK_PER_PHASE
#define MK_PER_PHASE 0
#endif
constexpr int T = 16384, SEQ = 8192, D = 1024;
constexpr int N_PHASES = 12;

constexpr size_t MiB = 1u << 20, KiB = 1u << 10;
constexpr size_t WS_CTL = 0, CTL_ZERO_BYTES = 1 * MiB;
constexpr int CW_BAR = 4096;
constexpr size_t WS_SSQ1 = 64 * KiB, WS_SSQ2 = 128 * KiB;
constexpr size_t WS_AB = 1 * MiB;
constexpr size_t WS_HEND = WS_AB + 512 * KiB, WS_PEND = WS_HEND + 512 * KiB, WS_HIN = WS_PEND + 512 * KiB;
constexpr size_t WS_DEC = WS_HIN + 512 * KiB;
constexpr size_t WS_SUBK = 3 * MiB + 256 * KiB;
constexpr size_t WS_WIN = 4 * MiB, WS_WOUT = 10 * MiB, WS_WQ = 12 * MiB, WS_WKV = 14 * MiB, WS_WO = 18 * MiB, WS_PWQ = 20 * MiB;
constexpr size_t WS_MEMN = 24 * MiB, WS_KB = 25 * MiB, WS_VTP = 26 * MiB, WS_LRUWT = 27 * MiB, WS_USC = 27 * MiB + 256 * KiB, WS_VSC = 27 * MiB + 384 * KiB;
constexpr size_t WS_XB = 28 * MiB;
constexpr size_t WS_HLOC = 28 * MiB, WS_PCUM = 44 * MiB;
constexpr size_t WS_QKV = 60 * MiB;
constexpr size_t OUT_Y = 4 * MiB;
constexpr size_t OUT_END = OUT_Y + (size_t)16384 * 1024 * 2;
constexpr size_t WS_IDX = 60 * MiB, WS_GW = 68 * MiB;
constexpr size_t WS_UB = 60 * MiB;
constexpr size_t WS_XR = 108 * MiB, WS_Z = 124 * MiB, WS_GATE = 140 * MiB;
constexpr size_t WS_WN = 156 * MiB, WS_UF = 172 * MiB, WS_QD = 188 * MiB, WS_KD = 204 * MiB, WS_ATT = 220 * MiB;
constexpr size_t WS_VB = 228 * MiB;
constexpr size_t WS_Q = 188 * MiB, WS_AO = 124 * MiB;
constexpr size_t WS_PQ = 108 * MiB;
constexpr size_t WS_END = 244 * MiB;
constexpr int CW_GFLAG = 49152;
constexpr int CW_LRUCNT = 8192;
static_assert(WS_XR - WS_QKV == (size_t)T * 1536 * 2 && WS_Z - WS_XR == (size_t)T * 512 * 2 && WS_GATE - WS_Z == (size_t)T * 512 * 2, "in-proj outputs are contiguous");

constexpr int LDS_BYTES = 160 * 1024;
constexpr int MISC_OFF = 159 * 1024;

#define GAS __attribute__((address_space(1)))
#define LAS __attribute__((address_space(3)))
typedef unsigned short bf16;
typedef unsigned v4u __attribute__((ext_vector_type(4)));
typedef unsigned v2u __attribute__((ext_vector_type(2)));
typedef float f32x4 __attribute__((ext_vector_type(4)));
typedef short bf16x8 __attribute__((ext_vector_type(8)));
typedef GAS unsigned gu32;
#define LDS_WAIT() asm volatile("s_waitcnt lgkmcnt(0)" ::: "memory")
__device__ __forceinline__ void st16_wt(void* p, v4u v) { asm volatile("global_store_dwordx4 %0, %1, off sc0 sc1\n\ts_nop 1" :: "v"(p), "v"(v) : "memory"); }
__device__ __forceinline__ unsigned f2bf(float f) { unsigned u = __builtin_bit_cast(unsigned, f); return (u + 0x7fffu + ((u >> 16) & 1u)) >> 16; }
__device__ __forceinline__ unsigned pk2(float lo, float hi) { return f2bf(lo) | (f2bf(hi) << 16); }
__device__ __forceinline__ float bflo(unsigned u) { return __builtin_bit_cast(float, u << 16); }
__device__ __forceinline__ float bfhi(unsigned u) { return __builtin_bit_cast(float, u & 0xffff0000u); }
__device__ __forceinline__ float bf1(bf16 h) { return __builtin_bit_cast(float, (unsigned)h << 16); }
__device__ __forceinline__ float wave_sum(float v) {
#pragma unroll
    for (int o = 1; o < 64; o <<= 1) v += __shfl_xor(v, o);
    return v;
}
__device__ __forceinline__ float row16_sum(float v) {
    v += __builtin_bit_cast(float, __builtin_amdgcn_update_dpp(0, __builtin_bit_cast(int, v), 0xB1, 0xF, 0xF, true));
    v += __builtin_bit_cast(float, __builtin_amdgcn_update_dpp(0, __builtin_bit_cast(int, v), 0x4E, 0xF, 0xF, true));
    v += __builtin_bit_cast(float, __builtin_amdgcn_update_dpp(0, __builtin_bit_cast(int, v), 0x141, 0xF, 0xF, true));
    v += __builtin_bit_cast(float, __builtin_amdgcn_update_dpp(0, __builtin_bit_cast(int, v), 0x140, 0xF, 0xF, true));
    return v;
}
__device__ __forceinline__ float sigmoidf_(float x) { return __builtin_amdgcn_rcpf(1.0f + __expf(-x)); }
__device__ __forceinline__ float softplusf_(float x) { return fmaxf(x, 0.f) + log1pf(__expf(-fabsf(x))); }
__device__ __forceinline__ float siluf_(float x) { return x * __builtin_amdgcn_rcpf(1.0f + __expf(-x)); }
__device__ __forceinline__ float gelu_tanh(float x) { const float y = 0.7978845608028654f * (x + 0.044715f * x * x * x); const float e = __expf(2.0f * y); return x * (1.0f - __builtin_amdgcn_rcpf(1.0f + e)); }
__device__ __forceinline__ int permk(int kl) { return 8 * ((kl & 15) >> 2) + 4 * (kl >> 4) + (kl & 3); }

struct Params {
    const float *x, *mem, *norm_mix_w, *w_in, *conv_qkv_w, *gdn_a_log, *gdn_dt_bias, *gdn_norm_w, *lru_conv_w, *lru_conv_b, *lru_wa, *lru_ba, *lru_wx, *lru_bx, *lru_lambda, *w_out,
                *norm_xattn_w, *norm_mem_w, *xattn_wq, *xattn_wkv, *xattn_wo, *norm_ffn_w, *peer_wq, *peer_subkeys, *peer_u, *peer_v, *norm_final_w;
    float* out; unsigned char* ws; int ph_lo, ph_hi;
};
#define XB_TMO      128
#define XB_XCNT(j)  (256  + 64 * (j))
#define XB_XSUB(j)  (1280 + 64 * (j))
#define XB_XGEN(j)  (2304 + 64 * (j))
#define XB_TOP      3328
#define XB_TOPGEN   3392
#define XCD_BAR_WORDS 3456
#define XB_SPIN_CAP (1u << 18)

__device__ __forceinline__ unsigned xb_ld(unsigned* p)              { return __hip_atomic_load(p, __ATOMIC_RELAXED, __HIP_MEMORY_SCOPE_AGENT); }
__device__ __forceinline__ unsigned xb_add(unsigned* p, unsigned v) { return __hip_atomic_fetch_add(p, v, __ATOMIC_RELAXED, __HIP_MEMORY_SCOPE_AGENT); }
__device__ __forceinline__ unsigned xb_xcc_id() { return (unsigned)__builtin_amdgcn_s_getreg((3 << 11) | 20) & 0xFu; }
#define XB_SPIN(cond, bar) do { unsigned _sp = 0; while (cond) { __builtin_amdgcn_s_sleep(1); \
    if ((++_sp & 255u) == 0u) { if (xb_ld(&(bar)[XB_TMO])) break; if (_sp > XB_SPIN_CAP) { atomicAdd(&(bar)[XB_TMO], 1u); break; } } } } while (0)

struct XcdBarrier {
    unsigned* bar; unsigned x;
    volatile LAS unsigned* st;
};

__device__ __forceinline__ XcdBarrier xcd_barrier_post(unsigned* bar, volatile LAS unsigned* st) {
    XcdBarrier b; b.bar = bar; b.x = xb_xcc_id(); b.st = st;
    if (threadIdx.x == 0) (void)xb_add(&bar[XB_XCNT(b.x)], 1u);
    return b;
}
__device__ __forceinline__ void xcd_barrier_complete(unsigned* bar, unsigned x, unsigned& nloc, unsigned& nx) {
    const unsigned G = gridDim.x * gridDim.y * gridDim.z;
    unsigned sum, cnt, mine, sp = 0u;
    for (;;) {
        sum = 0u; cnt = 0u; mine = 0u;
#pragma unroll
        for (unsigned j = 0; j < 16; ++j) { const unsigned c = xb_ld(&bar[XB_XCNT(j)]); sum += c; cnt += (c > 0u) ? 1u : 0u; mine = (j == x) ? c : mine; }
        if (sum == G) break;
        __builtin_amdgcn_s_sleep(1);
        if ((++sp & 255u) == 0u) { if (xb_ld(&bar[XB_TMO])) break; if (sp > XB_SPIN_CAP) { atomicAdd(&bar[XB_TMO], 1u); break; } }
    }
    nloc = mine > 0u ? mine : 1u; nx = cnt > 0u ? cnt : 1u;
}

__device__ __forceinline__ void xcd_barrier(const XcdBarrier& b) {
    asm volatile("s_waitcnt vmcnt(0)" ::: "memory");
    __syncthreads();
    if (threadIdx.x == 0) {
        unsigned* bar = b.bar;
        __builtin_amdgcn_s_waitcnt(0);
        unsigned nloc = b.st[0], nx = b.st[1];
        if (nloc == 0u) { xcd_barrier_complete(bar, b.x, nloc, nx); b.st[0] = nloc; b.st[1] = nx; }
        const unsigned old = xb_add(&bar[XB_XSUB(b.x)], 1u);
        const unsigned gen = old / nloc;
        if (old + 1u == (gen + 1u) * nloc) {
            __builtin_amdgcn_fence(__ATOMIC_RELEASE, "agent");
            asm volatile("s_waitcnt vmcnt(0)" ::: "memory");
            const unsigned og = xb_add(&bar[XB_TOP], 1u);
            const unsigned tg = og / nx;
            if (og + 1u == (tg + 1u) * nx) xb_add(&bar[XB_TOPGEN], 1u);
            else XB_SPIN(xb_ld(&bar[XB_TOPGEN]) == tg, bar);
            __builtin_amdgcn_fence(__ATOMIC_ACQUIRE, "agent");
            xb_add(&bar[XB_XGEN(b.x)], 1u);
            asm volatile("s_waitcnt vmcnt(0)" ::: "memory");
        } else {
            XB_SPIN(xb_ld(&bar[XB_XGEN(b.x)]) == gen, bar);
            __builtin_amdgcn_fence(__ATOMIC_ACQUIRE, "agent");
            asm volatile("s_waitcnt vmcnt(0)" ::: "memory");
        }
    }
    __syncthreads();
}

__device__ __forceinline__ void p0_transpose_item(const float* W, int K, int ldw, int c0, int nblk, bf16* WT, int row_off, const float* ks, LAS float* scr, int item, int lane) {
    const int kb = item / nblk, nb = item % nblk, k0 = 64 * kb, n0 = 32 * nb;
#pragma unroll 8
    for (int i = 0; i < 32; ++i) { const int kk = 2 * i + (lane >> 5); float v = W[(size_t)(k0 + kk) * ldw + c0 + n0 + (lane & 31)]; if (ks) v *= ks[k0 + kk]; scr[kk * 33 + (lane & 31)] = v; }
    LDS_WAIT(); asm volatile("" ::: "memory");
    const int c = lane & 7;
#pragma unroll
    for (int j = 0; j < 4; ++j) { const int n = (lane >> 3) + 8 * j; const LAS float* s = scr + (8 * c) * 33 + n;
        v4u o; o.x = pk2(s[0 * 33], s[1 * 33]); o.y = pk2(s[2 * 33], s[3 * 33]); o.z = pk2(s[4 * 33], s[5 * 33]); o.w = pk2(s[6 * 33], s[7 * 33]);
        *(GAS v4u*)(WT + (size_t)(row_off + n0 + n) * K + k0 + 8 * c) = o; }
    LDS_WAIT(); asm volatile("" ::: "memory");
}

__device__ __forceinline__ void p0_prologue(const Params& P, LAS unsigned char* lds, int tid, int lane, int wave, int vcu, int G) {
    unsigned char* ws = P.ws;
    const int gw = vcu * NWAVES + wave, NGW = G * NWAVES;
    LAS float* wabl = (LAS float*)lds;
    for (int idx = tid; idx < 8192; idx += NWAVES * 64) { const int k = idx >> 3, c = idx & 7, j = k >> 8, l = (k >> 2) & 63, e = k & 3;
        wabl[((((j * 4 + e) * 2 + (c >> 2)) * 64 + l) << 2) + (c & 3)] = P.w_in[(size_t)k * 3080 + 2048 + c]; }
    __syncthreads();
    {
        bf16* XB0 = (bf16*)(ws + WS_XB); float* AB = (float*)(ws + WS_AB);
        f32x4 w4[4];
#pragma unroll
        for (int j = 0; j < 4; ++j) w4[j] = ((const f32x4*)P.norm_mix_w)[64 * j + lane];
        for (int m = gw; m < T; m += NGW) {
            const f32x4* xr = (const f32x4*)(P.x + (size_t)m * D) + lane;
            f32x4 v[4]; float s = 0.f;
#pragma unroll
            for (int j = 0; j < 4; ++j) { v[j] = xr[64 * j]; s += (v[j].x * v[j].x + v[j].y * v[j].y) + (v[j].z * v[j].z + v[j].w * v[j].w); }
            const float rstd = rsqrtf(wave_sum(s) * (1.0f / D) + 1e-6f);
            v2u* o8 = (v2u*)(XB0 + (size_t)m * D) + lane;
            float part[8];
#pragma unroll
            for (int c = 0; c < 8; ++c) part[c] = 0.f;
#pragma unroll
            for (int j = 0; j < 4; ++j) {
                v[j] = v[j] * rstd * w4[j];
                v2u o; o.x = pk2(v[j].x, v[j].y); o.y = pk2(v[j].z, v[j].w); o8[64 * j] = o;
#pragma unroll
                for (int e = 0; e < 4; ++e) {
                    const f32x4 wa = *(const LAS f32x4*)(wabl + ((((j * 4 + e) * 2 + 0) * 64 + lane) << 2));
                    const f32x4 wb = *(const LAS f32x4*)(wabl + ((((j * 4 + e) * 2 + 1) * 64 + lane) << 2));
                    const float hv = v[j][e];
                    part[0] += hv * wa.x; part[1] += hv * wa.y; part[2] += hv * wa.z; part[3] += hv * wa.w;
                    part[4] += hv * wb.x; part[5] += hv * wb.y; part[6] += hv * wb.z; part[7] += hv * wb.w;
                }
            }
#pragma unroll
            for (int c = 0; c < 8; ++c) part[c] = wave_sum(part[c]);
            float o = part[0];
#pragma unroll
            for (int c = 1; c < 8; ++c) o = (lane == c) ? part[c] : o;
            if (lane < 8) AB[(size_t)m * 8 + lane] = o;
        }
    }
    {
        bf16* MEMN = (bf16*)(ws + WS_MEMN);
        for (int m = gw; m < 512; m += NGW) {
            const f32x4* xr = (const f32x4*)(P.mem + (size_t)m * D) + lane;
            f32x4 v[4]; float s = 0.f;
#pragma unroll
            for (int j = 0; j < 4; ++j) { v[j] = xr[64 * j]; s += (v[j].x * v[j].x + v[j].y * v[j].y) + (v[j].z * v[j].z + v[j].w * v[j].w); }
            const float rstd = rsqrtf(wave_sum(s) * (1.0f / D) + 1e-6f);
            v2u* o8 = (v2u*)(MEMN + (size_t)m * D) + lane;
#pragma unroll
            for (int j = 0; j < 4; ++j) { const f32x4 w = ((const f32x4*)P.norm_mem_w)[64 * j + lane]; const f32x4 y = v[j] * rstd * w;
                v2u o; o.x = pk2(y.x, y.y); o.y = pk2(y.z, y.w); o8[64 * j] = o; }
        }
    }
    __syncthreads();
    {
        LAS float* scr = (LAS float*)(lds + wave * 16384);
        constexpr int I_IN1 = 16 * 48, I_IN2 = 16 * 16, I_KV = 16 * 64;
        constexpr int NITEMS = I_IN1 + 3 * I_IN2 + I_KV;
        for (int it = gw; it < NITEMS; it += NGW) {
            int r = it;
            if (r < I_IN1) { p0_transpose_item(P.w_in, 1024, 3080, 0, 48, (bf16*)(ws + WS_WIN), 0, nullptr, scr, r, lane); continue; } r -= I_IN1;
            if (r < I_IN2) { p0_transpose_item(P.w_in, 1024, 3080, 2056, 16, (bf16*)(ws + WS_WIN), 1536, nullptr, scr, r, lane); continue; } r -= I_IN2;
            if (r < I_IN2) { p0_transpose_item(P.w_in, 1024, 3080, 1536, 16, (bf16*)(ws + WS_WIN), 2048, nullptr, scr, r, lane); continue; } r -= I_IN2;
            if (r < I_IN2) { p0_transpose_item(P.w_in, 1024, 3080, 2568, 16, (bf16*)(ws + WS_WIN), 2560, nullptr, scr, r, lane); continue; } r -= I_IN2;
            p0_transpose_item(P.xattn_wkv, 1024, 2048, 0, 64, (bf16*)(ws + WS_WKV), 0, nullptr, scr, r, lane);
        }
    }
    {
        bf16* WT = (bf16*)(ws + WS_LRUWT);
        for (int it = vcu * NWAVES * 64 + tid; it < 8 * 2 * 64 * 8; it += G * NWAVES * 64) {
            const int i8 = it & 7, j = (it >> 3) & 63, m = (it >> 9) & 1, g = it >> 10;
            const float* src = (m ? P.lru_wx : P.lru_wa) + (size_t)(g * 64 + 8 * i8) * 64 + j;
            v4u o; o.x = pk2(src[0], src[64]); o.y = pk2(src[128], src[192]); o.z = pk2(src[256], src[320]); o.w = pk2(src[384], src[448]);
            *(v4u*)(WT + (size_t)it * 8) = o;
        }
    }
}

__device__ __forceinline__ void late_weight_prep(const Params& P, LAS unsigned char* lds, int lane, int wave, int gw, int NGW) {
    unsigned char* ws = P.ws;
    {
        LAS float* scr = (LAS float*)(lds + wave * 16384);
        constexpr int I_OUT = 16 * 32, I_Q = 16 * 32, I_O = 16 * 32;
        for (int it = gw; it < I_OUT + I_Q + I_O; it += NGW) {
            int r = it;
            if (r < I_OUT) { p0_transpose_item(P.w_out, 1024, 1024, 0, 32, (bf16*)(ws + WS_WOUT), 0, nullptr, scr, r, lane); continue; } r -= I_OUT;
            if (r < I_Q) { p0_transpose_item(P.xattn_wq, 1024, 1024, 0, 32, (bf16*)(ws + WS_WQ), 0, P.norm_xattn_w, scr, r, lane); continue; } r -= I_Q;
            p0_transpose_item(P.xattn_wo, 1024, 1024, 0, 32, (bf16*)(ws + WS_WO), 0, nullptr, scr, r, lane);
        }
    }
    {
        bf16* WF = (bf16*)(ws + WS_PWQ);
        const int col = lane & 15, g = lane >> 4;
        for (int it = gw; it < 16 * 64; it += NGW) {
            const int hp = it >> 6, k0 = (it & 63) * 16;
            bf16x8 bq[4];
#pragma unroll
            for (int s = 0; s < 4; ++s) { const f32x4* src = (const f32x4*)(P.peer_wq + (size_t)(k0 + col) * 2048 + hp * 128 + 32 * s + 8 * g);
                const f32x4 a = src[0], c = src[1]; v4u pk; pk.x = pk2(a.x, a.y); pk.y = pk2(a.z, a.w); pk.z = pk2(c.x, c.y); pk.w = pk2(c.z, c.w); bq[s] = __builtin_bit_cast(bf16x8, pk); }
            const float nw = P.norm_ffn_w[k0 + col];
#pragma unroll 2
            for (int kt = 0; kt < 8; ++kt) {
                f32x4 acc = (f32x4){0.f, 0.f, 0.f, 0.f};
#pragma unroll
                for (int s = 0; s < 4; ++s) { const f32x4* src = (const f32x4*)(P.peer_subkeys + (size_t)(hp * 128 + 16 * kt + col) * 128 + 32 * s + 8 * g);
                    const f32x4 a = src[0], c = src[1]; v4u pk; pk.x = pk2(a.x, a.y); pk.y = pk2(a.z, a.w); pk.z = pk2(c.x, c.y); pk.w = pk2(c.z, c.w);
                    acc = __builtin_amdgcn_mfma_f32_16x16x32_bf16(__builtin_bit_cast(bf16x8, pk), bq[s], acc, 0, 0, 0); }
#pragma unroll
                for (int i = 0; i < 4; ++i) WF[(size_t)(hp * 128 + 16 * kt + 4 * g + i) * 1024 + k0 + col] = (bf16)f2bf(acc[i] * nw);
            }
        }
    }
}

constexpr int GL_KS = 0, GL_VS = 33792, GL_KB = 67584, GL_QB = 84992, GL_RAW = 102400, GL_CW = 153856, GL_AMT = 133120, GL_SM = 160000, GL_ATT = 151808, GL_SOL = 67584;
static_assert(GL_CW + 6144 <= GL_SM && GL_SM + 1284 <= MISC_OFF && GL_SOL + 65536 <= GL_AMT && GL_AMT + 17408 <= GL_ATT && GL_ATT + 8192 <= GL_SM && GL_RAW + 51456 <= GL_CW, "gdn_local LDS map");
#ifndef GL_REP_STEP
#define GL_REP_STEP -1
#endif
#define GL_REPF(k) for (int rr_ = 0; rr_ < ((GL_REP_STEP == (k)) ? 2 : 1); ++rr_)
#define GL_BAR() do { asm volatile("s_waitcnt lgkmcnt(0)" ::: "memory"); __builtin_amdgcn_s_barrier(); asm volatile("" ::: "memory"); } while (0)
__device__ __forceinline__ void gdn_local_item(const Params& P, LAS unsigned char* lds, int item, int tid) {
    unsigned char* ws = P.ws;
    asm volatile("" : "+v"(tid));
    const int b = item >> 9, h = (item >> 7) & 3, n = item & 127;
    const int t0 = b * SEQ + n * 64;
    const int lane = tid & 63, wave = __builtin_amdgcn_readfirstlane(tid >> 6);
    LAS float* ks = (LAS float*)(lds + GL_KS);
    LAS float* vs = (LAS float*)(lds + GL_VS);
    LAS bf16* kb16 = (LAS bf16*)(lds + GL_KB);
    LAS bf16* qb16 = (LAS bf16*)(lds + GL_QB);
    LAS bf16* raw = (LAS bf16*)(lds + GL_RAW);
    LAS float* cw = (LAS float*)(lds + GL_CW);
    LAS float* AmT = (LAS float*)(lds + GL_AMT);
    LAS float* sg = (LAS float*)(lds + GL_SM);
    LAS float* sbeta = sg + 64; LAS float* sgc = sbeta + 64; LAS float* seg = sgc + 64; LAS float* sek = seg + 64;
    LAS bf16* atts = (LAS bf16*)(lds + GL_ATT);
    const bf16* QKV = (const bf16*)(ws + WS_QKV);
    const float* AB = (const float*)(ws + WS_AB);
    GL_REPF(0) {
        v4u pr[7];
#pragma unroll
        for (int r = 0; r < 7; ++r) {
            const int id = tid + 512 * r;
            const int row = id / 48, rem = id - row * 48, part = rem >> 4, ck = rem & 15, s = n * 64 + row - 3;
            pr[r] = (v4u){0u, 0u, 0u, 0u};
            if (id < 67 * 48 && s >= 0) pr[r] = *(const v4u*)(QKV + (size_t)(b * SEQ + s) * 1536 + part * 512 + h * 128 + ck * 8);
        }
        f32x4 cwv = (f32x4){0.f, 0.f, 0.f, 0.f};
        if (tid < 384) { const int j = tid / 96, rem = tid - j * 96, part = rem >> 5, c4 = rem & 31; cwv = *(const f32x4*)(P.conv_qkv_w + j * 1536 + part * 512 + h * 128 + c4 * 4); }
        float a_in = 0.f, b_in = 0.f;
        if (tid < 64) { a_in = AB[(size_t)(t0 + tid) * 8 + h]; b_in = AB[(size_t)(t0 + tid) * 8 + 4 + h]; }
#pragma unroll
        for (int r = 0; r < 7; ++r) { const int id = tid + 512 * r; if (id < 67 * 48) *(LAS v4u*)(raw + id * 8) = pr[r]; }
        if (tid < 384) *(LAS f32x4*)(cw + tid * 4) = cwv;
        if (tid < 64) { sg[tid] = -__expf(P.gdn_a_log[h]) * softplusf_(a_in + P.gdn_dt_bias[h]); sbeta[tid] = sigmoidf_(b_in); }
    }
    GL_BAR();
    GL_REPF(1) {
        const int c = tid >> 3, grp = tid & 7;
#pragma unroll 1
        for (int part = 0; part < 3; ++part) {
            float y[16];
#pragma unroll
            for (int i = 0; i < 16; ++i) y[i] = 0.f;
#pragma unroll
            for (int j = 0; j < 4; ++j) {
                const LAS v4u* src = (const LAS v4u*)(raw + (c + j) * 384 + part * 128 + grp * 16);
                const v4u x0 = src[0], x1 = src[1];
                const LAS f32x4* wp = (const LAS f32x4*)(cw + (j * 3 + part) * 128 + grp * 16);
                const f32x4 w0 = wp[0], w1 = wp[1], w2 = wp[2], w3 = wp[3];
                y[0] += w0.x * bflo(x0.x); y[1] += w0.y * bfhi(x0.x); y[2] += w0.z * bflo(x0.y); y[3] += w0.w * bfhi(x0.y);
                y[4] += w1.x * bflo(x0.z); y[5] += w1.y * bfhi(x0.z); y[6] += w1.z * bflo(x0.w); y[7] += w1.w * bfhi(x0.w);
                y[8] += w2.x * bflo(x1.x); y[9] += w2.y * bfhi(x1.x); y[10] += w2.z * bflo(x1.y); y[11] += w2.w * bfhi(x1.y);
                y[12] += w3.x * bflo(x1.z); y[13] += w3.y * bfhi(x1.z); y[14] += w3.z * bflo(x1.w); y[15] += w3.w * bfhi(x1.w);
            }
            float ss = 0.f;
#pragma unroll
            for (int i = 0; i < 16; ++i) { y[i] = siluf_(y[i]); ss += y[i] * y[i]; }
            if (part < 2) {
                ss += __shfl_xor(ss, 1); ss += __shfl_xor(ss, 2); ss += __shfl_xor(ss, 4);
                const float sc = rsqrtf(ss + 1e-6f) * (part == 0 ? 0.08838834764831845f : 1.0f);
#pragma unroll
                for (int i = 0; i < 16; ++i) y[i] *= sc;
            }
            if (part >= 1) {
                LAS float* dst = (part == 1 ? ks : vs) + c * 132 + grp * 16;
#pragma unroll
                for (int i = 0; i < 4; ++i) *(LAS f32x4*)(dst + 4 * i) = (f32x4){y[4 * i], y[4 * i + 1], y[4 * i + 2], y[4 * i + 3]};
            }
            if (part <= 1) {
                LAS bf16* dst = (part == 0 ? qb16 : kb16) + c * 136 + grp * 16;
                v4u o0, o1; o0.x = pk2(y[0], y[1]); o0.y = pk2(y[2], y[3]); o0.z = pk2(y[4], y[5]); o0.w = pk2(y[6], y[7]);
                o1.x = pk2(y[8], y[9]); o1.y = pk2(y[10], y[11]); o1.z = pk2(y[12], y[13]); o1.w = pk2(y[14], y[15]);
                *(LAS v4u*)dst = o0; *(LAS v4u*)(dst + 8) = o1;
            }
        }
    }
    if (tid < 64) {
        float v = sg[tid];
#pragma unroll
        for (int off = 1; off < 64; off <<= 1) { const float t = __shfl_up(v, off); if (tid >= off) v += t; }
        sgc[tid] = v; seg[tid] = __expf(v);
        const float gl = __shfl(v, 63);
        sek[tid] = __expf(gl - v);
        if (tid == 63) sek[64] = __expf(v);
    }
    GL_BAR();
    {
        const int mat = wave >> 2, rho = wave & 3, col = lane & 15, g = lane >> 4;
        const LAS bf16* X = mat ? qb16 : kb16;
        bf16x8 af[4];
#pragma unroll
        for (int s = 0; s < 4; ++s) af[s] = *(const LAS bf16x8*)(X + (16 * rho + col) * 136 + 32 * s + 8 * g);
#pragma unroll
        for (int sig = 0; sig < 4; ++sig) {
            f32x4 acc = (f32x4){0.f, 0.f, 0.f, 0.f};
#pragma unroll
            for (int s = 0; s < 4; ++s) { const bf16x8 bfr = *(const LAS bf16x8*)(kb16 + (16 * sig + col) * 136 + 32 * s + 8 * g); acc = __builtin_amdgcn_mfma_f32_16x16x32_bf16(af[s], bfr, acc, 0, 0, 0); }
            const int sidx = 16 * sig + col; const float gs = sgc[sidx];
#pragma unroll
            for (int i = 0; i < 4; ++i) {
                const int c = 16 * rho + 4 * g + i;
                const float dec = (c >= sidx) ? __expf(sgc[c] - gs) : 0.f;
                if (mat == 0) AmT[sidx * 68 + c] = (c > sidx) ? sbeta[c] * acc[i] * dec : 0.f;
                else atts[c * 64 + sidx] = (bf16)f2bf(acc[i] * dec);
            }
        }
    }
    GL_BAR();
    GL_REPF(4) {
        bf16* QD = (bf16*)(ws + WS_QD) + (size_t)item * 8192;
        bf16* KD = (bf16*)(ws + WS_KD) + (size_t)item * 8192;
        bf16* ATT = (bf16*)(ws + WS_ATT) + (size_t)item * 4096;
#pragma unroll
        for (int r = 0; r < 2; ++r) {
            const int id = tid + 512 * r;
            { const int c = id >> 4, gam = id & 15, s32 = gam >> 2, g = gam & 3;
              const v2u lo = *(const LAS v2u*)(qb16 + c * 136 + 32 * s32 + 4 * g), hi = *(const LAS v2u*)(qb16 + c * 136 + 32 * s32 + 16 + 4 * g);
              const float e = seg[c];
              v4u o; o.x = pk2(bflo(lo.x) * e, bfhi(lo.x) * e); o.y = pk2(bflo(lo.y) * e, bfhi(lo.y) * e); o.z = pk2(bflo(hi.x) * e, bfhi(hi.x) * e); o.w = pk2(bflo(hi.y) * e, bfhi(hi.y) * e);
              st16_wt(QD + c * 128 + 8 * gam, o); }
            { const int dk = id >> 3, gam = id & 7, s32 = gam >> 2, g = gam & 3, c0 = 32 * s32 + 4 * g;
              float v[8];
#pragma unroll
              for (int j = 0; j < 4; ++j) { v[j] = ks[(c0 + j) * 132 + dk] * sek[c0 + j]; v[4 + j] = ks[(c0 + 16 + j) * 132 + dk] * sek[c0 + 16 + j]; }
              v4u o; o.x = pk2(v[0], v[1]); o.y = pk2(v[2], v[3]); o.z = pk2(v[4], v[5]); o.w = pk2(v[6], v[7]);
              st16_wt(KD + dk * 64 + 8 * gam, o); }
        }
        { const int c = tid >> 3, gam = tid & 7, s32 = gam >> 2, g = gam & 3;
          const v2u lo = *(const LAS v2u*)(atts + c * 64 + 32 * s32 + 4 * g), hi = *(const LAS v2u*)(atts + c * 64 + 32 * s32 + 16 + 4 * g);
          v4u o; o.x = lo.x; o.y = lo.y; o.z = hi.x; o.w = hi.y;
          st16_wt(ATT + c * 64 + 8 * gam, o); }
    }
    GL_BAR();
    GL_REPF(5) {
        LAS float* xcol = (LAS float*)(lds + GL_SOL);
        LAS bf16* tinv = (LAS bf16*)(lds + GL_SOL + 17408);
        const int j = tid >> 3, part = tid & 7, jb = j >> 4, jo = j & 15;
#pragma unroll 1
        for (int rb = jb; rb < 4; ++rb) {
            float acc[16];
#pragma unroll
            for (int i = 0; i < 16; ++i) acc[i] = 0.f;
            if (rb > jb) {
#pragma unroll 2
                for (int s = 16 * jb + part; s < 16 * rb; s += 8) {
                    const float sv = xcol[j * 68 + s];
                    const LAS float* ar = AmT + s * 68 + 16 * rb;
#pragma unroll
                    for (int q = 0; q < 4; ++q) { const f32x4 A4 = *(const LAS f32x4*)(ar + 4 * q);
                        acc[4 * q] -= A4.x * sv; acc[4 * q + 1] -= A4.y * sv; acc[4 * q + 2] -= A4.z * sv; acc[4 * q + 3] -= A4.w * sv; }
                }
#pragma unroll
                for (int i = 0; i < 16; ++i) {
                    acc[i] += __builtin_bit_cast(float, __builtin_amdgcn_update_dpp(0, __builtin_bit_cast(int, acc[i]), 0xB1, 0xF, 0xF, true));
                    acc[i] += __builtin_bit_cast(float, __builtin_amdgcn_update_dpp(0, __builtin_bit_cast(int, acc[i]), 0x4E, 0xF, 0xF, true));
                    acc[i] += __builtin_bit_cast(float, __builtin_amdgcn_update_dpp(0, __builtin_bit_cast(int, acc[i]), 0x141, 0xF, 0xF, true));
                }
            } else {
#pragma unroll
                for (int i = 0; i < 16; ++i) acc[i] = (i == jo) ? 1.f : 0.f;
            }
#pragma unroll
            for (int i = 0; i < 16; ++i) {
                const float sv = acc[i];
                const LAS float* ar = AmT + (16 * rb + i) * 68 + 16 * rb;
#pragma unroll
                for (int q = (i + 1) / 4; q < 4; ++q) { const f32x4 A4 = *(const LAS f32x4*)(ar + 4 * q);
                    if (4 * q > i) acc[4 * q] -= A4.x * sv; if (4 * q + 1 > i) acc[4 * q + 1] -= A4.y * sv; if (4 * q + 2 > i) acc[4 * q + 2] -= A4.z * sv; if (4 * q + 3 > i) acc[4 * q + 3] -= A4.w * sv; }
            }
            if (part == 0) {
#pragma unroll
                for (int i = 0; i < 16; ++i) { xcol[j * 68 + 16 * rb + i] = acc[i]; tinv[(16 * rb + i) * 72 + j] = (bf16)f2bf(acc[i]); }
            }
            LDS_WAIT(); asm volatile("" ::: "memory");
        }
        for (int rb = 0; rb < jb; ++rb) {
            if (part == 0) {
#pragma unroll
                for (int i = 0; i < 16; ++i) tinv[(16 * rb + i) * 72 + j] = (bf16)0;
            }
        }
    }
    GL_BAR();
    GL_REPF(6) {
        const LAS bf16* tinv = (const LAS bf16*)(lds + GL_SOL + 17408);
        LAS bf16* wst = (LAS bf16*)(lds + GL_SOL + 17408 + 9216);
        const int col = lane & 15, g = lane >> 4, isw = wave >> 2;
        bf16x8 af[4][2];
#pragma unroll
        for (int rho = 0; rho < 4; ++rho)
#pragma unroll
            for (int s2 = 0; s2 < 2; ++s2) af[rho][s2] = *(const LAS bf16x8*)(tinv + (16 * rho + col) * 72 + 32 * s2 + 8 * g);
        bf16* UF = (bf16*)(ws + WS_UF) + (size_t)item * 8192;
#pragma unroll
        for (int sig = 0; sig < 2; ++sig) {
            const int jj = 32 * (wave & 3) + 16 * sig + col;
            const LAS float* src = (isw ? ks : vs) + jj;
            bf16x8 bfr[2];
#pragma unroll
            for (int s2 = 0; s2 < 2; ++s2) {
                float v[8];
#pragma unroll
                for (int e = 0; e < 8; ++e) { const int sidx = 32 * s2 + 8 * g + e; float x = src[sidx * 132] * sbeta[sidx]; if (isw) x *= seg[sidx]; v[e] = x; }
                v4u pk; pk.x = pk2(v[0], v[1]); pk.y = pk2(v[2], v[3]); pk.z = pk2(v[4], v[5]); pk.w = pk2(v[6], v[7]);
                bfr[s2] = __builtin_bit_cast(bf16x8, pk);
            }
            f32x4 acc[4];
#pragma unroll
            for (int rho = 0; rho < 4; ++rho) { acc[rho] = (f32x4){0.f, 0.f, 0.f, 0.f};
#pragma unroll
                for (int s2 = 0; s2 < 2; ++s2) acc[rho] = __builtin_amdgcn_mfma_f32_16x16x32_bf16(af[rho][s2], bfr[s2], acc[rho], 0, 0, 0); }
            if (!isw) {
                v4u o0, o1;
                o0.x = pk2(acc[0].x, acc[0].y); o0.y = pk2(acc[0].z, acc[0].w); o0.z = pk2(acc[1].x, acc[1].y); o0.w = pk2(acc[1].z, acc[1].w);
                o1.x = pk2(acc[2].x, acc[2].y); o1.y = pk2(acc[2].z, acc[2].w); o1.z = pk2(acc[3].x, acc[3].y); o1.w = pk2(acc[3].z, acc[3].w);
                v4u* d = (v4u*)(UF + (size_t)(2 * (wave & 3) + sig) * 1024 + lane * 16);
                st16_wt(d, o0); st16_wt(d + 1, o1);
            } else {
#pragma unroll
                for (int rho = 0; rho < 4; ++rho)
#pragma unroll
                    for (int i = 0; i < 4; ++i) wst[(16 * rho + 4 * g + i) * 136 + jj] = (bf16)f2bf(-acc[rho][i]);
            }
        }
    }
    GL_BAR();
    {
        const LAS bf16* wst = (const LAS bf16*)(lds + GL_SOL + 17408 + 9216);
        bf16* WN = (bf16*)(ws + WS_WN) + (size_t)item * 8192;
#pragma unroll
        for (int r = 0; r < 2; ++r) {
            const int id = tid + 512 * r, c = id >> 4, gam = id & 15, s32 = gam >> 2, g = gam & 3;
            const v2u lo = *(const LAS v2u*)(wst + c * 136 + 32 * s32 + 4 * g), hi = *(const LAS v2u*)(wst + c * 136 + 32 * s32 + 16 + 4 * g);
            v4u o; o.x = lo.x; o.y = lo.y; o.z = hi.x; o.w = hi.y;
            st16_wt(WN + c * 128 + 8 * gam, o);
        }
    }
    asm volatile("s_waitcnt vmcnt(0)" ::: "memory");
    GL_BAR();
    if (tid == 0) { unsigned fb = __builtin_bit_cast(unsigned, sek[64]); if (fb == 0u) fb = 1u;
        __hip_atomic_store((unsigned*)(ws + WS_CTL) + CW_GFLAG + item, fb, __ATOMIC_RELAXED, __HIP_MEMORY_SCOPE_AGENT); }
    GL_BAR();
}

constexpr int LL_XCB = 68608;
static_assert(LL_XCB + 64 * 1040 <= MISC_OFF, "lru_local LDS map");
__device__ __forceinline__ float expm1_small(float x) {
    const float p = x * (1.0f + x * (0.5f + x * (0.16666667f + x * (0.041666668f + x * 0.008333334f))));
    return (x > -0.25f) ? p : (__expf(x) - 1.0f);
}
__device__ __forceinline__ void lru_local_item(const Params& P, LAS unsigned char* lds, int lt, int tid, int lane, int wave) {
    unsigned char* ws = P.ws;
    asm volatile("" : "+v"(tid));
    const int b = lt >> 7, n = lt & 127, t0 = b * SEQ + n * 64;
    LAS bf16* rawx = (LAS bf16*)lds;
    LAS bf16* xcb = (LAS bf16*)(lds + LL_XCB);
    const bf16* XR = (const bf16*)(ws + WS_XR);
    {
        v4u pr[9];
#pragma unroll
        for (int r = 0; r < 9; ++r) { const int id = tid + 512 * r, row = id >> 6, ck = id & 63, s = n * 64 + row - 3;
            pr[r] = (v4u){0u, 0u, 0u, 0u};
            if (id < 67 * 64 && s >= 0) pr[r] = *(const v4u*)(XR + (size_t)(b * SEQ + s) * 512 + ck * 8); }
#pragma unroll
        for (int r = 0; r < 9; ++r) { const int id = tid + 512 * r; if (id < 67 * 64) *(LAS v4u*)(rawx + id * 8) = pr[r]; }
    }
    GL_BAR();
    {
        const int chg = tid & 63, tseg = tid >> 6, ch0 = chg * 8;
        float w[4][8], cb[8];
#pragma unroll
        for (int j = 0; j < 4; ++j) { const f32x4 a = *(const f32x4*)(P.lru_conv_w + j * 512 + ch0), c = *(const f32x4*)(P.lru_conv_w + j * 512 + ch0 + 4);
            w[j][0] = a.x; w[j][1] = a.y; w[j][2] = a.z; w[j][3] = a.w; w[j][4] = c.x; w[j][5] = c.y; w[j][6] = c.z; w[j][7] = c.w; }
        { const f32x4 a = *(const f32x4*)(P.lru_conv_b + ch0), c = *(const f32x4*)(P.lru_conv_b + ch0 + 4);
          cb[0] = a.x; cb[1] = a.y; cb[2] = a.z; cb[3] = a.w; cb[4] = c.x; cb[5] = c.y; cb[6] = c.z; cb[7] = c.w; }
        v4u xr[11];
#pragma unroll
        for (int r = 0; r < 11; ++r) xr[r] = *(const LAS v4u*)(rawx + (tseg * 8 + r) * 512 + ch0);
#pragma unroll
        for (int tk = 0; tk < 8; ++tk) {
            float y[8];
#pragma unroll
            for (int e = 0; e < 8; ++e) y[e] = cb[e];
#pragma unroll
            for (int j = 0; j < 4; ++j) { const v4u x = xr[tk + j];
                y[0] += w[j][0] * bflo(x.x); y[1] += w[j][1] * bfhi(x.x); y[2] += w[j][2] * bflo(x.y); y[3] += w[j][3] * bfhi(x.y);
                y[4] += w[j][4] * bflo(x.z); y[5] += w[j][5] * bfhi(x.z); y[6] += w[j][6] * bflo(x.w); y[7] += w[j][7] * bfhi(x.w); }
            v4u o; o.x = pk2(y[0], y[1]); o.y = pk2(y[2], y[3]); o.z = pk2(y[4], y[5]); o.w = pk2(y[6], y[7]);
            *(LAS v4u*)(xcb + (tseg * 8 + tk) * 520 + ch0) = o;
        }
    }
    GL_BAR();
    {
        const int g = wave, col = lane & 15, g4 = lane >> 4;
        LAS bf16* AM = (LAS bf16*)(lds + wave * 8192); LAS bf16* BT = AM + 2048;
        const bf16* WT = (const bf16*)(ws + WS_LRUWT) + (size_t)g * 8192;
        bf16x8 Bw[2][4][2];
#pragma unroll
        for (int m = 0; m < 2; ++m)
#pragma unroll
            for (int jt = 0; jt < 4; ++jt)
#pragma unroll
                for (int s2 = 0; s2 < 2; ++s2) Bw[m][jt][s2] = *(const bf16x8*)(WT + m * 4096 + (16 * jt + col) * 64 + 32 * s2 + 8 * g4);
        float cba[4], cbx[4], csp[4];
#pragma unroll
        for (int jt = 0; jt < 4; ++jt) { const int ch = g * 64 + 16 * jt + col; cba[jt] = P.lru_ba[ch]; cbx[jt] = P.lru_bx[ch]; csp[jt] = softplusf_(-P.lru_lambda[ch]); }
        bf16* HLOC = (bf16*)(ws + WS_HLOC); bf16* PCUM = (bf16*)(ws + WS_PCUM);
        const int chs = g * 64 + lane;
        float hst = 0.f, pc = 1.f;
#pragma unroll 1
        for (int half = 0; half < 2; ++half) {
            bf16x8 Af[2][2];
#pragma unroll
            for (int rho = 0; rho < 2; ++rho)
#pragma unroll
                for (int s2 = 0; s2 < 2; ++s2) Af[rho][s2] = *(const LAS bf16x8*)(xcb + (32 * half + 16 * rho + col) * 520 + g * 64 + 32 * s2 + 8 * g4);
#pragma unroll
            for (int jt = 0; jt < 4; ++jt) {
#pragma unroll
                for (int rho = 0; rho < 2; ++rho) {
                    f32x4 ra = (f32x4){0.f, 0.f, 0.f, 0.f}, rx = ra;
#pragma unroll
                    for (int s2 = 0; s2 < 2; ++s2) { ra = __builtin_amdgcn_mfma_f32_16x16x32_bf16(Af[rho][s2], Bw[0][jt][s2], ra, 0, 0, 0); rx = __builtin_amdgcn_mfma_f32_16x16x32_bf16(Af[rho][s2], Bw[1][jt][s2], rx, 0, 0, 0); }
#pragma unroll
                    for (int i = 0; i < 4; ++i) {
                        const int tokl = 16 * rho + 4 * g4 + i, chl = 16 * jt + col;
                        const float r = sigmoidf_(ra[i] + cba[jt]), ig = sigmoidf_(rx[i] + cbx[jt]);
                        const float log_a = -8.0f * r * csp[jt];
                        const float am = -expm1_small(log_a), a = 1.0f - am;
                        const float xo = bf1(xcb[(32 * half + tokl) * 520 + g * 64 + chl]);
                        const float bt = __builtin_amdgcn_sqrtf(fmaxf(am * (1.0f + a), 0.f)) * (ig * xo);
                        AM[tokl * 64 + chl] = (bf16)f2bf(am); BT[tokl * 64 + chl] = (bf16)f2bf(bt);
                    }
                }
            }
            LDS_WAIT(); asm volatile("" ::: "memory");
#pragma unroll 8
            for (int tk = 0; tk < 32; ++tk) {
                const float am = bf1(AM[tk * 64 + lane]), bt = bf1(BT[tk * 64 + lane]);
                hst = (hst - am * hst) + bt; pc = pc - am * pc;
                const size_t o = (size_t)(t0 + 32 * half + tk) * 512 + chs;
                HLOC[o] = (bf16)f2bf(hst); PCUM[o] = (bf16)f2bf(pc);
            }
            LDS_WAIT(); asm volatile("" ::: "memory");
        }
        ((float*)(ws + WS_HEND))[(size_t)lt * 512 + chs] = hst; ((float*)(ws + WS_PEND))[(size_t)lt * 512 + chs] = pc;
    }
    GL_BAR();
}

constexpr int SC_WN = 0, SC_QD = 64 * 272, SC_KD = 2 * 64 * 272, SC_ATT = 2 * 64 * 272 + 128 * 144, SC_BUF = 2 * 64 * 272 + 128 * 144 + 64 * 144;
constexpr int SC_SSQ = 2 * SC_BUF;
__device__ __forceinline__ int sc_lds_off(int id) {
    if (id < 1024) return SC_WN + (id >> 4) * 272 + (id & 15) * 16;
    if (id < 2048) { const int q = id - 1024; return SC_QD + (q >> 4) * 272 + (q & 15) * 16; }
    if (id < 3072) { const int q = id - 2048; return SC_KD + (q >> 3) * 144 + (q & 7) * 16; }
    const int q = id - 3072; return SC_ATT + (q >> 3) * 144 + (q & 7) * 16;
}
__device__ __forceinline__ const v4u* sc_src(const unsigned char* ws, int item, int id) {
    if (id < 1024) return (const v4u*)(ws + WS_WN + (size_t)item * 16384) + id;
    if (id < 2048) return (const v4u*)(ws + WS_QD + (size_t)item * 16384) + (id - 1024);
    if (id < 3072) return (const v4u*)(ws + WS_KD + (size_t)item * 16384) + (id - 2048);
    return (const v4u*)(ws + WS_ATT + (size_t)item * 8192) + (id - 3072);
}
__device__ __forceinline__ bf16x8 pack_b(const f32x4 a, const f32x4 b) {
    v4u r; r.x = pk2(a.x, a.y); r.y = pk2(a.z, a.w); r.z = pk2(b.x, b.y); r.w = pk2(b.z, b.w);
    return __builtin_bit_cast(bf16x8, r);
}
#define SC_BAR() do { asm volatile("s_waitcnt lgkmcnt(0)" ::: "memory"); __builtin_amdgcn_s_barrier(); asm volatile("" ::: "memory"); } while (0)
#define SC_GLD(dst, ptr) asm volatile("global_load_dwordx4 %0, %1, off" : "=v"(dst) : "v"(ptr) : "memory")
#define PIN8(a) asm volatile("" : "+v"(a[0]), "+v"(a[1]), "+v"(a[2]), "+v"(a[3]), "+v"(a[4]), "+v"(a[5]), "+v"(a[6]), "+v"(a[7]))
#define PIN16(a) asm volatile("" : "+v"(a[0]), "+v"(a[1]), "+v"(a[2]), "+v"(a[3]), "+v"(a[4]), "+v"(a[5]), "+v"(a[6]), "+v"(a[7]), "+v"(a[8]), "+v"(a[9]), "+v"(a[10]), "+v"(a[11]), "+v"(a[12]), "+v"(a[13]), "+v"(a[14]), "+v"(a[15]))
constexpr int SCAN_NWC = 2, SCAN_PARTS = 4, SCAN_WGS = 8 * SCAN_PARTS;
constexpr int SC_UFS = 2 * SC_BUF;
constexpr int SC_DECS = SC_UFS + 2 * SCAN_NWC * 2048;
constexpr int SC_OT = SC_DECS + 512;
constexpr int SC_RDY = SC_OT + 2 * 64 * 36 * 4;
constexpr int SC_END = SC_RDY + 64;
static_assert(SC_END <= MISC_OFF, "scan LDS");
#ifndef SCAN_REPS
#define SCAN_REPS 1
#endif
#ifndef SCAN_EXP
#define SCAN_EXP 0
#endif
__device__ __forceinline__ int sc3_lds_off(int id) {
    if (id < 3584) return sc_lds_off(id);
    return SC_UFS + (id - 3584) * 16;
}
__device__ __forceinline__ const v4u* sc3_src(const unsigned char* ws, int item, int id, int part) {
    if (id < 3584) return sc_src(ws, item, id);
    return (const v4u*)(ws + WS_UF + (size_t)item * 16384 + (size_t)(part * SCAN_NWC) * 2048) + (id - 3584);
}
__device__ __forceinline__ void gdn_scan(const Params& P, LAS unsigned char* lds, int sb, int tid, int lane, int wave) {
    const unsigned char* ws = P.ws;
    constexpr int NCH = 128 * SCAN_REPS, NPC = 15;
    const int bh = sb & 7, part = sb >> 3;
    const int b = bh >> 2, h = bh & 3, col = lane & 15, g = lane >> 4;
    const int item0 = bh * 128;
    if (tid == 0) *(volatile LAS unsigned*)(lds + SC_RDY) = 0u;
    SC_BAR();
    if (wave >= 4) {
        constexpr int NP = 15, DEP = 3;
        const int lt = tid - 256;
        const unsigned voff = (unsigned)lt * 16u;
        const int lA = (lt >> 4) * 272 + (lt & 15) * 16, lB = (lt >> 3) * 144 + (lt & 7) * 16, lU = SC_UFS + lt * 16;
        v4u rs[DEP][NP];
#define SC_ISSUE(set, itm) do { const unsigned char* gq_ = ws + (size_t)(itm) * 16384; const unsigned char* ga_ = ws + WS_ATT + (size_t)(itm) * 8192; \
            asm volatile("s_nop 4\n\tglobal_load_dwordx4 %0, %8, %9 sc0 sc1\n\tglobal_load_dwordx4 %1, %8, %10 sc0 sc1\n\tglobal_load_dwordx4 %2, %8, %11 sc0 sc1\n\tglobal_load_dwordx4 %3, %8, %12 sc0 sc1\n\t" \
                         "global_load_dwordx4 %4, %8, %13 sc0 sc1\n\tglobal_load_dwordx4 %5, %8, %14 sc0 sc1\n\tglobal_load_dwordx4 %6, %8, %15 sc0 sc1\n\tglobal_load_dwordx4 %7, %8, %16 sc0 sc1" \
                : "=&v"(rs[set][0]), "=&v"(rs[set][1]), "=&v"(rs[set][2]), "=&v"(rs[set][3]), "=&v"(rs[set][4]), "=&v"(rs[set][5]), "=&v"(rs[set][6]), "=&v"(rs[set][7]) \
                : "v"(voff), "s"(gq_ + WS_WN), "s"(gq_ + WS_WN + 4096), "s"(gq_ + WS_WN + 8192), "s"(gq_ + WS_WN + 12288), \
                  "s"(gq_ + WS_QD), "s"(gq_ + WS_QD + 4096), "s"(gq_ + WS_QD + 8192), "s"(gq_ + WS_QD + 12288) : "memory"); \
            asm volatile("s_nop 4\n\tglobal_load_dwordx4 %0, %7, %8 sc0 sc1\n\tglobal_load_dwordx4 %1, %7, %9 sc0 sc1\n\tglobal_load_dwordx4 %2, %7, %10 sc0 sc1\n\tglobal_load_dwordx4 %3, %7, %11 sc0 sc1\n\t" \
                         "global_load_dwordx4 %4, %7, %12 sc0 sc1\n\tglobal_load_dwordx4 %5, %7, %13 sc0 sc1\n\tglobal_load_dwordx4 %6, %7, %14 sc0 sc1" \
                : "=&v"(rs[set][8]), "=&v"(rs[set][9]), "=&v"(rs[set][10]), "=&v"(rs[set][11]), "=&v"(rs[set][12]), "=&v"(rs[set][13]), "=&v"(rs[set][14]) \
                : "v"(voff), "s"(gq_ + WS_KD), "s"(gq_ + WS_KD + 4096), "s"(gq_ + WS_KD + 8192), "s"(gq_ + WS_KD + 12288), \
                  "s"(ga_), "s"(ga_ + 4096), "s"(gq_ + WS_UF + (size_t)(part * SCAN_NWC) * 2048) : "memory"); } while (0)
#define SC_WAITSET(set, cnt) asm volatile("s_waitcnt " cnt : "+v"(rs[set][0]), "+v"(rs[set][1]), "+v"(rs[set][2]), "+v"(rs[set][3]), "+v"(rs[set][4]), "+v"(rs[set][5]), "+v"(rs[set][6]), "+v"(rs[set][7]), \
            "+v"(rs[set][8]), "+v"(rs[set][9]), "+v"(rs[set][10]), "+v"(rs[set][11]), "+v"(rs[set][12]), "+v"(rs[set][13]), "+v"(rs[set][14]) :: "memory")
#define SC_WRITE(set, par) do { LAS unsigned char* wb_ = lds + (par) * SC_BUF; \
            _Pragma("unroll") for (int r = 0; r < 4; ++r) { *(LAS v4u*)(wb_ + SC_WN + lA + r * (16 * 272)) = rs[set][r]; *(LAS v4u*)(wb_ + SC_QD + lA + r * (16 * 272)) = rs[set][4 + r]; \
                                                          *(LAS v4u*)(wb_ + SC_KD + lB + r * (32 * 144)) = rs[set][8 + r]; } \
            *(LAS v4u*)(wb_ + SC_ATT + lB) = rs[set][12]; *(LAS v4u*)(wb_ + SC_ATT + lB + 32 * 144) = rs[set][13]; \
            *(LAS v4u*)(lds + lU + (par) * (SCAN_NWC * 2048)) = rs[set][14]; } while (0)
#define SC_NEED(c) do { unsigned sp_ = 0; while (*(volatile LAS unsigned*)(lds + SC_RDY) <= (unsigned)(c) && ++sp_ < (1u << 24)) __builtin_amdgcn_s_sleep(2); } while (0)
        SC_NEED(0); SC_ISSUE(0, item0);
        SC_WAITSET(0, "vmcnt(0)"); SC_WRITE(0, 0); SC_WAITSET(0, "lgkmcnt(0)");
        SC_NEED(3); SC_ISSUE(1, item0 + 1); SC_ISSUE(2, item0 + 2); SC_ISSUE(0, item0 + 3);
        SC_BAR();
        int n2 = 0;
#define SC_INTERVAL(set) do { SC_WAITSET(set, "vmcnt(30)"); SC_WRITE(set, (n2 + 1) & 1); SC_WAITSET(set, "lgkmcnt(0)"); if (n2 + 1 + DEP < 128) SC_NEED(n2 + 1 + DEP); SC_ISSUE(set, item0 + ((n2 + 1 + DEP) & 127)); SC_BAR(); ++n2; } while (0)
#pragma unroll 1
        for (int it = 0; it < NCH / 3; ++it) { SC_INTERVAL(1); SC_INTERVAL(2); SC_INTERVAL(0); }
        if (NCH % 3 >= 1) SC_INTERVAL(1);
        if (NCH % 3 >= 2) SC_INTERVAL(2);
        SC_WAITSET(0, "vmcnt(0)"); SC_WAITSET(1, "vmcnt(0)"); SC_WAITSET(2, "vmcnt(0)");
#undef SC_INTERVAL
#undef SC_NEED
#undef SC_WRITE
#undef SC_WAITSET
#undef SC_ISSUE
        return;
    }
    if (wave == 3) {
        const unsigned* flags = (const unsigned*)(ws + WS_CTL) + CW_GFLAG + item0;
        unsigned rdy = 0;
#define SC_POLLSTEP() do { if (rdy < 128u) { const unsigned idx_ = rdy + (unsigned)lane; \
            const unsigned fv_ = (idx_ < 128u) ? __hip_atomic_load(flags + idx_, __ATOMIC_RELAXED, __HIP_MEMORY_SCOPE_AGENT) : 0u; \
            const unsigned long long m_ = __ballot(fv_ != 0u); const unsigned nrun_ = (m_ == ~0ull) ? 64u : (unsigned)__builtin_ctzll(~m_);     \
            if ((unsigned)lane < nrun_) ((LAS float*)(lds + SC_DECS))[idx_] = __builtin_bit_cast(float, fv_); \
            rdy += nrun_; LDS_WAIT(); if (lane == 0) *(volatile LAS unsigned*)(lds + SC_RDY) = rdy; } } while (0)
        { unsigned sp = 0; while (rdy < 4u && ++sp < (1u << 22)) { SC_POLLSTEP(); if (rdy < 4u) __builtin_amdgcn_s_sleep(16); } }
        SC_BAR();
#pragma unroll 1
        for (int n2 = 0; n2 < NCH; ++n2) {
            { const unsigned need = (unsigned)(n2 + 1 + 3) < 128u ? (unsigned)(n2 + 1 + 3) : 127u; unsigned sp = 0;
              while (rdy <= need && rdy < 128u && ++sp < (1u << 22)) { SC_POLLSTEP(); if (rdy <= need) __builtin_amdgcn_s_sleep(8); } }
            if (rdy < 128u && rdy < (unsigned)(n2 & 127) + 16u) SC_POLLSTEP();
            SC_BAR();
        }
#undef SC_POLLSTEP
        return;
    }
    if (wave == 2) {
        const int row = lane;
        bf16* Y = (bf16*)((unsigned char*)P.out + OUT_Y);
        float* SSQG = P.out;
        SC_BAR();
#pragma unroll 1
        for (int n2 = 0; n2 <= NCH; ++n2) {
            if (n2 > 0) {
                const int n = (n2 - 1) & 127, t = b * SEQ + n * 64 + row;
                const LAS float* src = (const LAS float*)(lds + SC_OT + ((n2 - 1) & 1) * (64 * 36 * 4)) + row * 36;
                f32x4 a[8]; float s2 = 0.f;
#pragma unroll
                for (int q = 0; q < 8; ++q) { a[q] = *(const LAS f32x4*)(src + 4 * q); s2 += (a[q].x * a[q].x + a[q].y * a[q].y) + (a[q].z * a[q].z + a[q].w * a[q].w); }
                SSQG[(size_t)t * 32 + h * 8 + part] = s2;
                v4u* d = (v4u*)(Y + (size_t)t * 1024 + h * 128 + 32 * part);
#pragma unroll
                for (int q = 0; q < 4; ++q) { v4u o; o.x = pk2(a[2 * q].x, a[2 * q].y); o.y = pk2(a[2 * q].z, a[2 * q].w); o.z = pk2(a[2 * q + 1].x, a[2 * q + 1].y); o.w = pk2(a[2 * q + 1].z, a[2 * q + 1].w); d[q] = o; }
            }
            if (n2 < NCH) SC_BAR();
        }
        return;
    }
    f32x4 S[8];
#pragma unroll
    for (int i = 0; i < 8; ++i) S[i] = (f32x4){0.f, 0.f, 0.f, 0.f};
    SC_BAR();
#pragma unroll 1
    for (int n2 = 0; n2 < NCH; ++n2) {
        if (SCAN_REPS > 1 && (n2 & 127) == 0) {
#pragma unroll
            for (int i = 0; i < 8; ++i) S[i] = (f32x4){0.f, 0.f, 0.f, 0.f};
        }
        if (SCAN_EXP == 2 && n2 < 128) { SC_BAR(); continue; }
        const int par = n2 & 1;
        LAS unsigned char* buf = lds + par * SC_BUF;
        bf16x8 fA[16], fB[16], fC[16], fD[8];
#pragma unroll
        for (int rho = 0; rho < 4; ++rho)
#pragma unroll
            for (int s = 0; s < 4; ++s) fA[rho * 4 + s] = *(const LAS bf16x8*)(buf + SC_WN + (16 * rho + col) * 272 + (32 * s + 8 * g) * 2);
#pragma unroll
        for (int rho = 0; rho < 4; ++rho)
#pragma unroll
            for (int s = 0; s < 4; ++s) fB[rho * 4 + s] = *(const LAS bf16x8*)(buf + SC_QD + (16 * rho + col) * 272 + (32 * s + 8 * g) * 2);
        const LAS v4u* ufp = (const LAS v4u*)(lds + SC_UFS + par * (SCAN_NWC * 2048) + wave * 2048 + lane * 32);
        const v4u uf0 = ufp[0], uf1 = ufp[1];
        const float dec = ((const LAS float*)(lds + SC_DECS))[n2 & 127];
        bf16x8 Bs[4];
#pragma unroll
        for (int s = 0; s < 4; ++s) Bs[s] = pack_b(S[2 * s], S[2 * s + 1]);
        f32x4 Vn[4], Oc[4];
        Vn[0] = (f32x4){bflo(uf0.x), bfhi(uf0.x), bflo(uf0.y), bfhi(uf0.y)}; Vn[1] = (f32x4){bflo(uf0.z), bfhi(uf0.z), bflo(uf0.w), bfhi(uf0.w)};
        Vn[2] = (f32x4){bflo(uf1.x), bfhi(uf1.x), bflo(uf1.y), bfhi(uf1.y)}; Vn[3] = (f32x4){bflo(uf1.z), bfhi(uf1.z), bflo(uf1.w), bfhi(uf1.w)};
        __builtin_amdgcn_sched_barrier(0);
        PIN16(fA);
#pragma unroll
        for (int s = 0; s < 4; ++s)
#pragma unroll
            for (int rho = 0; rho < 4; ++rho) Vn[rho] = __builtin_amdgcn_mfma_f32_16x16x32_bf16(fA[rho * 4 + s], Bs[s], Vn[rho], 0, 0, 0);
        __builtin_amdgcn_sched_barrier(0);
#pragma unroll
        for (int tau = 0; tau < 8; ++tau)
#pragma unroll
            for (int s = 0; s < 2; ++s) fC[tau * 2 + s] = *(const LAS bf16x8*)(buf + SC_KD + (16 * tau + col) * 144 + (32 * s + 8 * g) * 2);
        __builtin_amdgcn_sched_barrier(0);
        PIN16(fB);
#pragma unroll
        for (int rho = 0; rho < 4; ++rho) Oc[rho] = (f32x4){0.f, 0.f, 0.f, 0.f};
#pragma unroll
        for (int s = 0; s < 4; ++s)
#pragma unroll
            for (int rho = 0; rho < 4; ++rho) Oc[rho] = __builtin_amdgcn_mfma_f32_16x16x32_bf16(fB[rho * 4 + s], Bs[s], Oc[rho], 0, 0, 0);
        __builtin_amdgcn_sched_barrier(0);
#pragma unroll
        for (int rho = 0; rho < 4; ++rho)
#pragma unroll
            for (int s = 0; s < 2; ++s) fD[rho * 2 + s] = *(const LAS bf16x8*)(buf + SC_ATT + (16 * rho + col) * 144 + (32 * s + 8 * g) * 2);
        bf16x8 Bv[2];
        Bv[0] = pack_b(Vn[0], Vn[1]); Bv[1] = pack_b(Vn[2], Vn[3]);
#pragma unroll
        for (int tau = 0; tau < 8; ++tau) S[tau] = S[tau] * dec;
        __builtin_amdgcn_sched_barrier(0);
        PIN16(fC);
#pragma unroll
        for (int s = 0; s < 2; ++s)
#pragma unroll
            for (int tau = 0; tau < 8; ++tau) S[tau] = __builtin_amdgcn_mfma_f32_16x16x32_bf16(fC[tau * 2 + s], Bv[s], S[tau], 0, 0, 0);
        __builtin_amdgcn_sched_barrier(0);
        PIN8(fD);
#pragma unroll
        for (int s = 0; s < 2; ++s)
#pragma unroll
            for (int rho = 0; rho < 4; ++rho) Oc[rho] = __builtin_amdgcn_mfma_f32_16x16x32_bf16(fD[rho * 2 + s], Bv[s], Oc[rho], 0, 0, 0);
        LAS float* ot = (LAS float*)(lds + SC_OT + par * (64 * 36 * 4)) + 16 * wave + col;
#pragma unroll
        for (int rho = 0; rho < 4; ++rho)
#pragma unroll
            for (int i = 0; i < 4; ++i) ot[(16 * rho + 4 * g + i) * 36] = Oc[rho][i];
        SC_BAR();
    }
}

__device__ __forceinline__ void lru_carry(const Params& P, int gwv, int lane) {
    unsigned char* ws = P.ws;
    const int b = gwv >> 3, g = gwv & 7, ch = g * 64 + lane;
    const float* HEND = (const float*)(ws + WS_HEND); const float* PEND = (const float*)(ws + WS_PEND); float* HIN = (float*)(ws + WS_HIN);
    float hin = 0.f;
#pragma unroll 1
    for (int n0 = 0; n0 < 128; n0 += 32) {
        float he[32], pe[32];
#pragma unroll
        for (int i = 0; i < 32; ++i) { const size_t o = (size_t)(b * 128 + n0 + i) * 512 + ch; he[i] = HEND[o]; pe[i] = PEND[o]; }
#pragma unroll
        for (int i = 0; i < 32; ++i) { HIN[(size_t)(b * 128 + n0 + i) * 512 + ch] = hin; hin = he[i] + pe[i] * hin; }
    }
}

__device__ __forceinline__ void cvt_table(const float* src, bf16* dst, size_t n8, size_t wi, size_t nw) {
    for (size_t i = wi; i < n8; i += nw) {
        const f32x4 a = ((const f32x4*)src)[2 * i], c = ((const f32x4*)src)[2 * i + 1];
        v4u o; o.x = pk2(a.x, a.y); o.y = pk2(a.z, a.w); o.z = pk2(c.x, c.y); o.w = pk2(c.z, c.w);
        ((v4u*)dst)[i] = o;
    }
}

__device__ __forceinline__ void lru_combine(const Params& P, size_t wi, size_t nw) {
    unsigned char* ws = P.ws;
    const v4u* HLOC = (const v4u*)(ws + WS_HLOC); const v4u* PCUM = (const v4u*)(ws + WS_PCUM); const v4u* GATE = (const v4u*)(ws + WS_GATE);
    const float* HIN = (const float*)(ws + WS_HIN); bf16* Y = (bf16*)((unsigned char*)P.out + OUT_Y);
    for (size_t i = wi; i < (size_t)T * 64; i += nw) {
        const size_t t = i >> 6; const int ch0 = (int)(i & 63) * 8;
        const v4u hl = HLOC[i], pc = PCUM[i], gt = GATE[i];
        const f32x4 h0 = *(const f32x4*)(HIN + (t >> 6) * 512 + ch0), h1 = *(const f32x4*)(HIN + (t >> 6) * 512 + ch0 + 4);
        float y[8];
        y[0] = (bflo(hl.x) + bflo(pc.x) * h0.x) * gelu_tanh(bflo(gt.x)); y[1] = (bfhi(hl.x) + bfhi(pc.x) * h0.y) * gelu_tanh(bfhi(gt.x));
        y[2] = (bflo(hl.y) + bflo(pc.y) * h0.z) * gelu_tanh(bflo(gt.y)); y[3] = (bfhi(hl.y) + bfhi(pc.y) * h0.w) * gelu_tanh(bfhi(gt.y));
        y[4] = (bflo(hl.z) + bflo(pc.z) * h1.x) * gelu_tanh(bflo(gt.z)); y[5] = (bfhi(hl.z) + bfhi(pc.z) * h1.y) * gelu_tanh(bfhi(gt.z));
        y[6] = (bflo(hl.w) + bflo(pc.w) * h1.z) * gelu_tanh(bflo(gt.w)); y[7] = (bfhi(hl.w) + bfhi(pc.w) * h1.w) * gelu_tanh(bfhi(gt.w));
        v4u o; o.x = pk2(y[0], y[1]); o.y = pk2(y[2], y[3]); o.z = pk2(y[4], y[5]); o.w = pk2(y[6], y[7]);
        *(v4u*)(Y + t * 1024 + 512 + ch0) = o;
    }
}

__device__ __forceinline__ void gdn_gate_norm(const Params& P, size_t wi, size_t nw) {
    unsigned char* ws = P.ws;
    bf16* Y = (bf16*)((unsigned char*)P.out + OUT_Y); const v4u* Z = (const v4u*)(ws + WS_Z); const float* SSQG = P.out;
    for (size_t i = wi; i < (size_t)T * 64; i += nw) {
        const size_t t = i >> 6; const int c0 = (int)(i & 63) * 8, h = c0 >> 7;
        const f32x4 q0 = *(const f32x4*)(SSQG + t * 32 + h * 8);
        const float rstd = rsqrtf(((q0.x + q0.y) + (q0.z + q0.w)) * (1.0f / 128.0f) + 1e-6f);
        const v4u o = *(const v4u*)(Y + t * 1024 + c0), z = Z[i];
        const f32x4 w0 = *(const f32x4*)(P.gdn_norm_w + (c0 & 127)), w1 = *(const f32x4*)(P.gdn_norm_w + (c0 & 127) + 4);
        float y[8];
        y[0] = bflo(o.x) * rstd * w0.x * siluf_(bflo(z.x)); y[1] = bfhi(o.x) * rstd * w0.y * siluf_(bfhi(z.x));
        y[2] = bflo(o.y) * rstd * w0.z * siluf_(bflo(z.y)); y[3] = bfhi(o.y) * rstd * w0.w * siluf_(bfhi(z.y));
        y[4] = bflo(o.z) * rstd * w1.x * siluf_(bflo(z.z)); y[5] = bfhi(o.z) * rstd * w1.y * siluf_(bfhi(z.z));
        y[6] = bflo(o.w) * rstd * w1.z * siluf_(bflo(z.w)); y[7] = bfhi(o.w) * rstd * w1.w * siluf_(bfhi(z.w));
        v4u r; r.x = pk2(y[0], y[1]); r.y = pk2(y[2], y[3]); r.z = pk2(y[4], y[5]); r.w = pk2(y[6], y[7]);
        *(v4u*)(Y + t * 1024 + c0) = r;
    }
}

__device__ __forceinline__ void xattn_stage(LAS unsigned char* lds, const bf16* src, int tid) {
    v4u tmp[16];
    asm volatile("" : "+v"(tid));
    const unsigned voff = (unsigned)tid * 16u;
#pragma unroll
    for (int r = 0; r < 16; ++r) { const unsigned char* sb = (const unsigned char*)src + r * 8192;
        asm volatile("s_nop 4\n\tglobal_load_dwordx4 %0, %1, %2" : "=&v"(tmp[r]) : "v"(voff), "s"(sb) : "memory"); }
    asm volatile("s_waitcnt vmcnt(0)" : "+v"(tmp[0]), "+v"(tmp[1]), "+v"(tmp[2]), "+v"(tmp[3]), "+v"(tmp[4]), "+v"(tmp[5]), "+v"(tmp[6]), "+v"(tmp[7]),
                                        "+v"(tmp[8]), "+v"(tmp[9]), "+v"(tmp[10]), "+v"(tmp[11]), "+v"(tmp[12]), "+v"(tmp[13]), "+v"(tmp[14]), "+v"(tmp[15]) :: "memory");
#pragma unroll
    for (int r = 0; r < 16; ++r) { const int id = tid + 512 * r; *(LAS v4u*)(lds + (id >> 5) * 528 + (id & 31) * 16) = tmp[r]; }
}
#ifndef XA_NPS
#define XA_NPS 2
#endif
__device__ __forceinline__ void xattn_unit(const Params& P, LAS unsigned char* lds, int unit, int tid, int lane, int wave) {
    const unsigned char* ws = P.ws;
    const int h = unit & 3, qb = (unit >> 2) & 63, b = unit >> 8; int col = lane & 15, g = lane >> 4;
    const int tw = b * SEQ + qb * 128 + 16 * wave;
    const bf16* Kb = (const bf16*)(ws + WS_KB) + (size_t)((b * 4 + h) * 256) * 256;
    const bf16* Vt = (const bf16*)(ws + WS_VTP) + (size_t)((b * 4 + h) * 256) * 256;
    xattn_stage(lds, Kb, tid);
    __syncthreads();
    const LAS unsigned char* arow = lds + col * 528 + g * 16;
    bf16x8 Bp[XA_NPS][8]; float inv[XA_NPS];
#pragma unroll
    for (int ps = 0; ps < XA_NPS; ++ps) {
        __builtin_amdgcn_sched_barrier(0); asm volatile("" : "+v"(col), "+v"(g) :: "memory");
        const bf16* Q = (const bf16*)(ws + WS_Q) + (size_t)(tw + 128 * ps + col) * 1024 + h * 256 + 8 * g;
        bf16x8 Bq[8];
#pragma unroll
        for (int s = 0; s < 8; ++s) Bq[s] = *(const bf16x8*)(Q + 32 * s);
        f32x4 St[16];
        bf16x8 fr[2][8];
#pragma unroll
        for (int s = 0; s < 8; ++s) fr[0][s] = *(const LAS bf16x8*)(arow + 64 * s);
#pragma unroll
        for (int kap = 0; kap < 16; ++kap) {
            if (kap + 1 < 16) {
#pragma unroll
                for (int s = 0; s < 8; ++s) fr[(kap + 1) & 1][s] = *(const LAS bf16x8*)(arow + (16 * (kap + 1)) * 528 + 64 * s);
            }
            __builtin_amdgcn_sched_barrier(0);
            PIN8(fr[kap & 1]);
            f32x4 acc = (f32x4){0.f, 0.f, 0.f, 0.f};
#pragma unroll
            for (int s = 0; s < 8; ++s) acc = __builtin_amdgcn_mfma_f32_16x16x32_bf16(fr[kap & 1][s], Bq[s], acc, 0, 0, 0);
            St[kap] = acc;
            __builtin_amdgcn_sched_barrier(0);
        }
        float mx = -3.0e38f;
#pragma unroll
        for (int kap = 0; kap < 16; ++kap) mx = fmaxf(fmaxf(fmaxf(St[kap].x, St[kap].y), fmaxf(St[kap].z, St[kap].w)), mx);
        mx = fmaxf(mx, __shfl_xor(mx, 16)); mx = fmaxf(mx, __shfl_xor(mx, 32));
        float l = 0.f;
#pragma unroll
        for (int kap = 0; kap < 16; ++kap) { St[kap].x = __expf(St[kap].x - mx); St[kap].y = __expf(St[kap].y - mx); St[kap].z = __expf(St[kap].z - mx); St[kap].w = __expf(St[kap].w - mx);
            l += (St[kap].x + St[kap].y) + (St[kap].z + St[kap].w); }
        l += __shfl_xor(l, 16); l += __shfl_xor(l, 32);
        inv[ps] = 1.0f / l;
#pragma unroll
        for (int s = 0; s < 8; ++s) Bp[ps][s] = pack_b(St[2 * s], St[2 * s + 1]);
    }
    __syncthreads();
    xattn_stage(lds, Vt, tid);
    __syncthreads();
#pragma unroll
    for (int ps = 0; ps < XA_NPS; ++ps) {
        __builtin_amdgcn_sched_barrier(0); asm volatile("" : "+v"(col), "+v"(g) :: "memory");
        bf16* AO = (bf16*)(P.ws + WS_AO) + (size_t)(tw + 128 * ps + col) * 1024 + h * 256 + 4 * g;
        bf16x8 fr[2][8];
#pragma unroll
        for (int s = 0; s < 8; ++s) fr[0][s] = *(const LAS bf16x8*)(arow + 64 * s);
#pragma unroll
        for (int del = 0; del < 16; ++del) {
            if (del + 1 < 16) {
#pragma unroll
                for (int s = 0; s < 8; ++s) fr[(del + 1) & 1][s] = *(const LAS bf16x8*)(arow + (16 * (del + 1)) * 528 + 64 * s);
            }
            __builtin_amdgcn_sched_barrier(0);
            PIN8(fr[del & 1]);
            f32x4 acc = (f32x4){0.f, 0.f, 0.f, 0.f};
#pragma unroll
            for (int s = 0; s < 8; ++s) acc = __builtin_amdgcn_mfma_f32_16x16x32_bf16(fr[del & 1][s], Bp[ps][s], acc, 0, 0, 0);
            v2u o; o.x = pk2(acc.x * inv[ps], acc.y * inv[ps]); o.y = pk2(acc.z * inv[ps], acc.w * inv[ps]);
            *(v2u*)(AO + 16 * del) = o;
            __builtin_amdgcn_sched_barrier(0);
        }
    }
    __syncthreads();
}

__device__ __forceinline__ unsigned key_enc(float f) { const unsigned u = __builtin_bit_cast(unsigned, f); return (u & 0x80000000u) ? ~u : (u | 0x80000000u); }
__device__ __forceinline__ float key_dec(unsigned k) { const unsigned u = (k & 0x80000000u) ? (k & 0x7fffffffu) : ~k; return __builtin_bit_cast(float, u); }
#define TK_CAS(a, b) do { const unsigned hi_ = max(a, b), lo_ = min(a, b); a = hi_; b = lo_; } while (0)
__device__ __forceinline__ void tk_merge16(unsigned (&a)[16]) {
#pragma unroll
    for (int j = 8; j > 0; j >>= 1)
#pragma unroll
        for (int i = 0; i < 16; ++i) { const int l = i ^ j; if (l > i) TK_CAS(a[i], a[l]); }
}
__device__ __forceinline__ void tk_sort16(unsigned (&a)[16]) {
#define TK_L(...) do { const int pr_[] = {__VA_ARGS__}; _Pragma("unroll") for (int q_ = 0; q_ < (int)(sizeof(pr_) / sizeof(int)); q_ += 2) TK_CAS(a[pr_[q_]], a[pr_[q_ + 1]]); } while (0)
    TK_CAS(a[0], a[13]); TK_CAS(a[1], a[12]); TK_CAS(a[2], a[15]); TK_CAS(a[3], a[14]); TK_CAS(a[4], a[8]); TK_CAS(a[5], a[6]); TK_CAS(a[7], a[11]); TK_CAS(a[9], a[10]);
    TK_CAS(a[0], a[5]); TK_CAS(a[1], a[7]); TK_CAS(a[2], a[9]); TK_CAS(a[3], a[4]); TK_CAS(a[6], a[13]); TK_CAS(a[8], a[14]); TK_CAS(a[10], a[15]); TK_CAS(a[11], a[12]);
    TK_CAS(a[0], a[1]); TK_CAS(a[2], a[3]); TK_CAS(a[4], a[5]); TK_CAS(a[6], a[8]); TK_CAS(a[7], a[9]); TK_CAS(a[10], a[11]); TK_CAS(a[12], a[13]); TK_CAS(a[14], a[15]);
    TK_CAS(a[0], a[2]); TK_CAS(a[1], a[3]); TK_CAS(a[4], a[10]); TK_CAS(a[5], a[11]); TK_CAS(a[6], a[7]); TK_CAS(a[8], a[9]); TK_CAS(a[12], a[14]); TK_CAS(a[13], a[15]);
    TK_CAS(a[1], a[2]); TK_CAS(a[3], a[12]); TK_CAS(a[4], a[6]); TK_CAS(a[5], a[7]); TK_CAS(a[8], a[10]); TK_CAS(a[9], a[11]); TK_CAS(a[13], a[14]);
    TK_CAS(a[1], a[4]); TK_CAS(a[2], a[6]); TK_CAS(a[5], a[8]); TK_CAS(a[7], a[10]); TK_CAS(a[9], a[13]); TK_CAS(a[11], a[14]);
    TK_CAS(a[2], a[4]); TK_CAS(a[3], a[6]); TK_CAS(a[9], a[12]); TK_CAS(a[11], a[13]);
    TK_CAS(a[3], a[5]); TK_CAS(a[6], a[8]); TK_CAS(a[7], a[9]); TK_CAS(a[10], a[12]);
    TK_CAS(a[3], a[4]); TK_CAS(a[5], a[6]); TK_CAS(a[7], a[8]); TK_CAS(a[9], a[10]); TK_CAS(a[11], a[12]);
    TK_CAS(a[6], a[7]); TK_CAS(a[8], a[9]);
#undef TK_L
}
__device__ __forceinline__ void tk_top16_merge(unsigned (&L)[16], const unsigned (&G)[16]) {
#pragma unroll
    for (int i = 0; i < 16; ++i) L[i] = max(L[i], G[15 - i]);
    tk_merge16(L);
}
__device__ __forceinline__ void tk_pair_merge(unsigned (&L)[16]) {
    unsigned Pp[16];
#pragma unroll
    for (int i = 0; i < 16; ++i) Pp[i] = (unsigned)__builtin_amdgcn_update_dpp(0, (int)L[i], 0xB1, 0xF, 0xF, true);
    tk_top16_merge(L, Pp);
}
__device__ __forceinline__ void peer_topk_rows(const Params& P, LAS unsigned char* lds, int rowbase, int tid) {
    const unsigned char* ws = P.ws;
    typedef _Float16 f16x8 __attribute__((ext_vector_type(8)));
    const int rl = tid >> 1, hf = tid & 1, grow = rowbase + rl, t = grow >> 3, h = grow & 7;
    const _Float16* SC = (const _Float16*)(ws + WS_PQ) + (size_t)t * 2048 + h * 256 + 64 * hf;
    f16x8 raw[2][8];
#pragma unroll
    for (int p = 0; p < 2; ++p)
#pragma unroll
        for (int q = 0; q < 8; ++q) raw[p][q] = *(const f16x8*)(SC + p * 128 + 8 * q);
    unsigned L1[16], L2[16];
#pragma unroll
    for (int p = 0; p < 2; ++p) {
        unsigned L[16];
#pragma unroll
        for (int grp = 0; grp < 4; ++grp) {
            unsigned G[16];
#pragma unroll
            for (int e = 0; e < 16; ++e) G[e] = (key_enc((float)raw[p][2 * grp + (e >> 3)][e & 7]) & ~127u) | (unsigned)(127 - (64 * hf + 16 * grp + e));
            tk_sort16(G);
            if (grp == 0) {
#pragma unroll
                for (int i = 0; i < 16; ++i) L[i] = G[i];
            } else tk_top16_merge(L, G);
        }
        tk_pair_merge(L);
#pragma unroll
        for (int i = 0; i < 16; ++i) { if (p == 0) L1[i] = L[i]; else L2[i] = L[i]; }
    }
    {
        float v1[16], v2[16];
        LAS int* il = (LAS int*)lds + rl * 33;
#pragma unroll
        for (int q = 0; q < 16; ++q) { v1[q] = key_dec((L1[q] & ~127u) | 64u); v2[q] = key_dec((L2[q] & ~127u) | 64u); }
        if (hf == 0) {
#pragma unroll
            for (int q = 0; q < 16; ++q) { il[q] = 127 - (int)(L1[q] & 127u); il[16 + q] = 127 - (int)(L2[q] & 127u); }
        }
        unsigned C[16], D[16];
        float w1[8];
        const unsigned hf16 = (unsigned)hf * 16u, evenmask = (unsigned)hf - 1u;
#pragma unroll
        for (int k = 0; k < 8; ++k) w1[k] = __builtin_bit_cast(float, (__builtin_bit_cast(unsigned, v1[2 * k]) & evenmask) | (__builtin_bit_cast(unsigned, v1[2 * k + 1]) & ~evenmask));
#define TK_SLOT(dst, k, bq, valid_odd) do { const unsigned pos_ = (unsigned)(16 * (2 * (k)) + (bq)) + hf16; unsigned kv_ = (key_enc(w1[k] + v2[bq]) & ~255u) | (255u - pos_); if (!(valid_odd)) kv_ &= evenmask; dst = kv_; } while (0)
        TK_SLOT(C[0], 0, 0, true);
        TK_SLOT(C[1], 0, 1, true);
        TK_SLOT(C[2], 0, 2, true);
        TK_SLOT(C[3], 0, 3, true);
        TK_SLOT(C[4], 0, 4, true);
        TK_SLOT(C[5], 0, 5, true);
        TK_SLOT(C[6], 0, 6, true);
        TK_SLOT(C[7], 0, 7, true);
        TK_SLOT(C[8], 0, 8, false);
        TK_SLOT(C[9], 0, 9, false);
        TK_SLOT(C[10], 0, 10, false);
        TK_SLOT(C[11], 0, 11, false);
        TK_SLOT(C[12], 0, 12, false);
        TK_SLOT(C[13], 0, 13, false);
        TK_SLOT(C[14], 0, 14, false);
        TK_SLOT(C[15], 0, 15, false);
        TK_SLOT(D[0], 1, 0, true);
        TK_SLOT(D[1], 1, 1, true);
        TK_SLOT(D[2], 1, 2, true);
        TK_SLOT(D[3], 1, 3, true);
        TK_SLOT(D[4], 1, 4, false);
        TK_SLOT(D[5], 2, 0, true);
        TK_SLOT(D[6], 2, 1, true);
        TK_SLOT(D[7], 2, 2, false);
        TK_SLOT(D[8], 3, 0, true);
        TK_SLOT(D[9], 3, 1, true);
        TK_SLOT(D[10], 4, 0, true);
        TK_SLOT(D[11], 5, 0, true);
        TK_SLOT(D[12], 6, 0, true);
        TK_SLOT(D[13], 7, 0, true);
        D[14] = 0u; D[15] = 0u;
#undef TK_SLOT
        tk_sort16(C); tk_sort16(D); tk_top16_merge(C, D); tk_pair_merge(C);
        LDS_WAIT(); asm volatile("" ::: "memory");
        float best[16], e[16], sum = 0.f;
#pragma unroll
        for (int q = 0; q < 16; ++q) { best[q] = key_dec((C[q] & ~255u) | 128u); e[q] = __expf(best[q] - best[0]); sum += e[q]; }
        const float inv = __builtin_amdgcn_rcpf(sum);
        int* IDX = (int*)(P.ws + WS_IDX) + (size_t)grow * 16 + 8 * hf; float* GW = (float*)(P.ws + WS_GW) + (size_t)grow * 16 + 8 * hf;
#pragma unroll
        for (int q = 0; q < 8; ++q) {
            const unsigned c = (C[q] & evenmask) | (C[8 + q] & ~evenmask);
            const float ev = __builtin_bit_cast(float, (__builtin_bit_cast(unsigned, e[q]) & evenmask) | (__builtin_bit_cast(unsigned, e[8 + q]) & ~evenmask));
            const unsigned pos = 255u - (c & 255u);
            IDX[q] = il[pos >> 4] * 128 + il[16 + (pos & 15u)]; GW[q] = ev * inv;
        }
    }
    LDS_WAIT(); asm volatile("" ::: "memory");
}

__device__ __forceinline__ void peer_topk_wave(const Params& P, LAS int* ilw, LAS unsigned* oute, LAS float* outg, int tbase, int lane) {
    const unsigned char* ws = P.ws;
    typedef _Float16 f16x8 __attribute__((ext_vector_type(8)));
    const int rl = lane >> 1, hf = lane & 1, t = tbase + (rl >> 3), h = rl & 7;
    const _Float16* SC = (const _Float16*)(ws + WS_PQ) + (size_t)t * 2048 + h * 256 + 64 * hf;
    f16x8 raw[2][8];
#pragma unroll
    for (int p = 0; p < 2; ++p)
#pragma unroll
        for (int q = 0; q < 8; ++q) raw[p][q] = *(const f16x8*)(SC + p * 128 + 8 * q);
    unsigned L1[16], L2[16];
    typedef short s16x2 __attribute__((ext_vector_type(2)));
    const unsigned lanebit = 64u - 64u * (unsigned)hf;
#pragma unroll
    for (int p = 0; p < 2; ++p) {
        unsigned L[16];
#pragma unroll
        for (int grp = 0; grp < 4; ++grp) {
            unsigned G[16];
#pragma unroll
            for (int e2 = 0; e2 < 8; ++e2) {
                const v4u wv = __builtin_bit_cast(v4u, raw[p][2 * grp + (e2 >> 2)]);
                const unsigned w = wv[e2 & 3];
                const unsigned m = __builtin_bit_cast(unsigned, __builtin_bit_cast(s16x2, w) >> (s16x2){15, 15}) | 0x80008000u;
                const unsigned k = w ^ m;
                G[2 * e2] = (k << 16) | (unsigned)(63 - (16 * grp + 2 * e2));
                G[2 * e2 + 1] = (k & 0xffff0000u) | (unsigned)(63 - (16 * grp + 2 * e2 + 1));
            }
            tk_sort16(G);
            if (grp == 0) {
#pragma unroll
                for (int i = 0; i < 16; ++i) L[i] = G[i];
            } else tk_top16_merge(L, G);
        }
#pragma unroll
        for (int i = 0; i < 16; ++i) L[i] |= lanebit;
        tk_pair_merge(L);
#pragma unroll
        for (int i = 0; i < 16; ++i) { if (p == 0) L1[i] = L[i]; else L2[i] = L[i]; }
    }
    {
        float v1[16], v2[16];
        LAS int* il = ilw + rl * 33;
#pragma unroll
        for (int q = 0; q < 16; ++q) {
            const unsigned a = L1[q], c = L2[q];
            const unsigned ha = (a >> 16) ^ ((~(unsigned)((int)a >> 31) | 0x8000u) & 0xffffu), hc = (c >> 16) ^ ((~(unsigned)((int)c >> 31) | 0x8000u) & 0xffffu);
            v1[q] = (float)__builtin_bit_cast(_Float16, (unsigned short)ha); v2[q] = (float)__builtin_bit_cast(_Float16, (unsigned short)hc); }
        if (hf == 0) {
#pragma unroll
            for (int q = 0; q < 16; ++q) { il[q] = 127 - (int)(L1[q] & 127u); il[16 + q] = 127 - (int)(L2[q] & 127u); }
        }
        unsigned C[16], D[16];
        float w1[8];
        const unsigned hf16 = (unsigned)hf * 16u, evenmask = (unsigned)hf - 1u;
#pragma unroll
        for (int k = 0; k < 8; ++k) w1[k] = __builtin_bit_cast(float, (__builtin_bit_cast(unsigned, v1[2 * k]) & evenmask) | (__builtin_bit_cast(unsigned, v1[2 * k + 1]) & ~evenmask));
#define TK_SLOT(dst, k, bq, valid_odd) do { const unsigned pos_ = (unsigned)(16 * (2 * (k)) + (bq)) + hf16; unsigned kv_ = (key_enc(w1[k] + v2[bq]) & ~255u) | (255u - pos_); if (!(valid_odd)) kv_ &= evenmask; dst = kv_; } while (0)
        TK_SLOT(C[0], 0, 0, true);
        TK_SLOT(C[1], 0, 1, true);
        TK_SLOT(C[2], 0, 2, true);
        TK_SLOT(C[3], 0, 3, true);
        TK_SLOT(C[4], 0, 4, true);
        TK_SLOT(C[5], 0, 5, true);
        TK_SLOT(C[6], 0, 6, true);
        TK_SLOT(C[7], 0, 7, true);
        TK_SLOT(C[8], 0, 8, false);
        TK_SLOT(C[9], 0, 9, false);
        TK_SLOT(C[10], 0, 10, false);
        TK_SLOT(C[11], 0, 11, false);
        TK_SLOT(C[12], 0, 12, false);
        TK_SLOT(C[13], 0, 13, false);
        TK_SLOT(C[14], 0, 14, false);
        TK_SLOT(C[15], 0, 15, false);
        TK_SLOT(D[0], 1, 0, true);
        TK_SLOT(D[1], 1, 1, true);
        TK_SLOT(D[2], 1, 2, true);
        TK_SLOT(D[3], 1, 3, true);
        TK_SLOT(D[4], 1, 4, false);
        TK_SLOT(D[5], 2, 0, true);
        TK_SLOT(D[6], 2, 1, true);
        TK_SLOT(D[7], 2, 2, false);
        TK_SLOT(D[8], 3, 0, true);
        TK_SLOT(D[9], 3, 1, true);
        TK_SLOT(D[10], 4, 0, true);
        TK_SLOT(D[11], 5, 0, true);
        TK_SLOT(D[12], 6, 0, true);
        TK_SLOT(D[13], 7, 0, true);
        D[14] = 0u; D[15] = 0u;
#undef TK_SLOT
        tk_sort16(C); tk_sort16(D); tk_top16_merge(C, D); tk_pair_merge(C);
        LDS_WAIT(); asm volatile("" ::: "memory");
        float best[16], e[16], sum = 0.f;
#pragma unroll
        for (int q = 0; q < 16; ++q) { best[q] = key_dec((C[q] & ~255u) | 128u); e[q] = __expf(best[q] - best[0]); sum += e[q]; }
        const float inv = __builtin_amdgcn_rcpf(sum);
        LAS unsigned* IDX = oute + rl * 16 + 8 * hf; LAS float* GW = outg + rl * 16 + 8 * hf;
#pragma unroll
        for (int q = 0; q < 8; ++q) {
            const unsigned c = (C[q] & evenmask) | (C[8 + q] & ~evenmask);
            const float ev = __builtin_bit_cast(float, (__builtin_bit_cast(unsigned, e[q]) & evenmask) | (__builtin_bit_cast(unsigned, e[8 + q]) & ~evenmask));
            const unsigned pos = 255u - (c & 255u);
            IDX[q] = (unsigned)(il[pos >> 4] * 128 + il[16 + (pos & 15u)]); GW[q] = ev * inv;
        }
    }
    LDS_WAIT(); asm volatile("" ::: "memory");
}

typedef float f32x2 __attribute__((ext_vector_type(2)));
__device__ __forceinline__ unsigned q8(float x) { return (unsigned)(int)rintf(x) & 0xffu; }
__device__ __forceinline__ void cvt_table_fp8(const float* src, unsigned char* dst, float* scl, int gw, int ngw, int lane) {
    for (int row = gw; row < 16384; row += ngw) {
        const f32x4* sp = (const f32x4*)(src + (size_t)row * 1024 + 16 * lane);
        const f32x4 a0 = sp[0], a1 = sp[1], a2 = sp[2], a3 = sp[3];
        float m = fmaxf(fmaxf(fmaxf(fabsf(a0.x), fabsf(a0.y)), fmaxf(fabsf(a0.z), fabsf(a0.w))), fmaxf(fmaxf(fabsf(a1.x), fabsf(a1.y)), fmaxf(fabsf(a1.z), fabsf(a1.w))));
        m = fmaxf(m, fmaxf(fmaxf(fmaxf(fabsf(a2.x), fabsf(a2.y)), fmaxf(fabsf(a2.z), fabsf(a2.w))), fmaxf(fmaxf(fabsf(a3.x), fabsf(a3.y)), fmaxf(fabsf(a3.z), fabsf(a3.w)))));
#pragma unroll
        for (int o = 1; o < 64; o <<= 1) m = fmaxf(m, __shfl_xor(m, o));
        m = fmaxf(m, 1e-30f);
        const float q = 127.0f / m;
        v4u o;
        o.x = q8(a0.x * q) | (q8(a0.y * q) << 8) | (q8(a0.z * q) << 16) | (q8(a0.w * q) << 24);
        o.y = q8(a1.x * q) | (q8(a1.y * q) << 8) | (q8(a1.z * q) << 16) | (q8(a1.w * q) << 24);
        o.z = q8(a2.x * q) | (q8(a2.y * q) << 8) | (q8(a2.z * q) << 16) | (q8(a2.w * q) << 24);
        o.w = q8(a3.x * q) | (q8(a3.y * q) << 8) | (q8(a3.z * q) << 16) | (q8(a3.w * q) << 24);
        *(v4u*)(dst + (size_t)row * 1024 + 16 * lane) = o;
        if (lane == 0) scl[row] = m * (1.0f / 127.0f);
    }
}
__device__ __forceinline__ int row16_sum_i(int v) {
    v += __builtin_amdgcn_update_dpp(0, v, 0xB1, 0xF, 0xF, true);
    v += __builtin_amdgcn_update_dpp(0, v, 0x4E, 0xF, 0xF, true);
    v += __builtin_amdgcn_update_dpp(0, v, 0x141, 0xF, 0xF, true);
    v += __builtin_amdgcn_update_dpp(0, v, 0x140, 0xF, 0xF, true);
    return v;
}
#ifndef PE_NR_N
#define PE_NR_N 16
#endif
#ifndef PE_RD_N
#define PE_RD_N 6
#endif
#define PE_STR2(x) #x
#define PE_STR(x) PE_STR2(x)
#if PE_RD_N == 8
#define PE_VMY 28
#elif PE_RD_N == 6
#define PE_VMY 20
#elif PE_RD_N == 5
#define PE_VMY 16
#else
#define PE_VMY 12
#endif
#define PE_VMW "vmcnt(" PE_STR(PE_VMY) ")"
constexpr int PE_NT = 4, PE_NR = PE_NR_N, PE_SH = (PE_NR_N == 16 ? 10 : PE_NR_N == 8 ? 11 : 12), PE_DEP = 3;
constexpr int PE_TOK_W = 128 * 3 + 20;
constexpr int PE_ENT_W = 272 * 4;
constexpr int PE_WAVE_W = PE_NT * PE_TOK_W + PE_ENT_W + 32 * 33 + 2 * PE_NT * 128;
static_assert(8 * PE_WAVE_W * 4 <= MISC_OFF && PE_NR * PE_NT <= 64, "peer LDS / batch-list geometry");
#define PE_LD(dst, voff_, sbase_) asm volatile("s_nop 4\n\tglobal_load_dwordx4 %0, %1, %2" : "=&v"(dst) : "v"(voff_), "s"(sbase_) : "memory")
__device__ __forceinline__ void peer_pass(const Params& P, LAS unsigned char* lds, int tbase, int lane, int wave, float* dstbase, int emask = 0x3fff) {
    asm volatile("v_mbcnt_lo_u32_b32 %0, -1, 0\n\tv_mbcnt_hi_u32_b32 %0, -1, %0" : "=v"(lane));
    {
        LAS unsigned* lw0 = (LAS unsigned*)(lds) + wave * PE_WAVE_W + PE_NT * PE_TOK_W + PE_ENT_W;
        peer_topk_wave(P, (LAS int*)lw0, lw0 + 32 * 33, (LAS float*)(lw0 + 32 * 33 + PE_NT * 128), tbase, lane);
        LDS_WAIT(); asm volatile("" : "+v"(lane), "+s"(tbase) :: "memory");
    }
    const unsigned char* ws = P.ws;
    const unsigned char* UB8 = ws + WS_UB; const unsigned char* VB8 = ws + WS_VB;
    const float* USC = (const float*)(ws + WS_USC); const float* VSC = (const float*)(ws + WS_VSC);
    f32x2 acc[PE_NT][8];
    LAS unsigned* lw = (LAS unsigned*)(lds) + wave * PE_WAVE_W;
    LAS unsigned* ents = lw + PE_NT * PE_TOK_W;
    const unsigned voff = (unsigned)lane * 16u;
    LAS unsigned* upe = ents + PE_ENT_W + 32 * 33; LAS float* upg = (LAS float*)(upe + PE_NT * 128);
    LAS unsigned* hql = ents + PE_ENT_W;
#pragma unroll
    for (int j = 0; j < PE_NT; ++j) {
        const int t = tbase + j;
        const v4u* xrow = (const v4u*)((const bf16*)(ws + WS_XB) + (size_t)t * 1024 + 16 * lane);
        const v4u xa = xrow[0], xc = xrow[1];
        const f32x4 xvv[4] = {(f32x4){bflo(xa.x), bfhi(xa.x), bflo(xa.y), bfhi(xa.y)}, (f32x4){bflo(xa.z), bfhi(xa.z), bflo(xa.w), bfhi(xa.w)},
                              (f32x4){bflo(xc.x), bfhi(xc.x), bflo(xc.y), bfhi(xc.y)}, (f32x4){bflo(xc.z), bfhi(xc.z), bflo(xc.w), bfhi(xc.w)}};
        const float rstd2 = rsqrtf(((const float*)(ws + WS_SSQ2))[t] * (1.0f / 1024.0f) + 1e-6f);
        f32x4 hv[4]; float hm = 0.f;
#pragma unroll
        for (int i = 0; i < 4; ++i) { const f32x4 xv = xvv[i]; const f32x4 w = ((const f32x4*)(P.norm_ffn_w + 16 * lane))[i];
            hv[i] = (f32x4){xv.x * rstd2 * w.x, xv.y * rstd2 * w.y, xv.z * rstd2 * w.z, xv.w * rstd2 * w.w};
            hm = fmaxf(hm, fmaxf(fmaxf(fabsf(hv[i].x), fabsf(hv[i].y)), fmaxf(fabsf(hv[i].z), fabsf(hv[i].w)))); }
#pragma unroll
        for (int o = 1; o < 64; o <<= 1) hm = fmaxf(hm, __shfl_xor(hm, o));
        hm = fmaxf(hm, 1e-30f);
        const float hqs = 127.0f / hm, hs = hm * (1.0f / 127.0f);
        { unsigned hqv[4];
#pragma unroll
          for (int i = 0; i < 4; ++i) hqv[i] = q8(hv[i].x * hqs) | (q8(hv[i].y * hqs) << 8) | (q8(hv[i].z * hqs) << 16) | (q8(hv[i].w * hqs) << 24);
          *(LAS v4u*)(hql + (j * 64 + lane) * 4) = (v4u){hqv[0], hqv[1], hqv[2], hqv[3]}; }
#pragma unroll
        for (int i = 0; i < 8; ++i) acc[j][i] = (f32x2){0.f, 0.f};
        const int e0 = (int)upe[j * 128 + 2 * lane] & emask, e1 = (int)upe[j * 128 + 2 * lane + 1] & emask;
        const float g0 = upg[j * 128 + 2 * lane] * VSC[e0], g1 = upg[j * 128 + 2 * lane + 1] * VSC[e1];
        const float u0 = USC[e0] * hs, u1 = USC[e1] * hs;
        const int rev = (tbase >= T / 2) ? (PE_NR - 1) : 0;
        const int b0 = (e0 >> PE_SH) ^ rev, b1 = (e1 >> PE_SH) ^ rev;
        LAS unsigned* lt = lw + j * PE_TOK_W;
        int run = 0, p0 = 0, p1 = 0;
        unsigned mystart = 0;
#pragma unroll
        for (int bk = 0; bk < PE_NR; ++bk) {
            const unsigned long long m0 = __ballot(b0 == bk), m1 = __ballot(b1 == bk);
            const int c0 = __popcll(m0), c1 = __popcll(m1);
            const int r0 = (int)__builtin_amdgcn_mbcnt_hi((unsigned)(m0 >> 32), __builtin_amdgcn_mbcnt_lo((unsigned)m0, 0u));
            const int r1 = (int)__builtin_amdgcn_mbcnt_hi((unsigned)(m1 >> 32), __builtin_amdgcn_mbcnt_lo((unsigned)m1, 0u));
            p0 = (b0 == bk) ? run + r0 : p0;
            p1 = (b1 == bk) ? run + c0 + r1 : p1;
            mystart = (lane == bk) ? (unsigned)run : mystart;
            run += c0 + c1;
        }
        lt[p0] = (unsigned)e0; lt[128 + p0] = __builtin_bit_cast(unsigned, g0); lt[256 + p0] = __builtin_bit_cast(unsigned, u0);
        lt[p1] = (unsigned)e1; lt[128 + p1] = __builtin_bit_cast(unsigned, g1); lt[256 + p1] = __builtin_bit_cast(unsigned, u1);
        if (lane < PE_NR) lt[384 + lane] = mystart;
        if (lane == 0) lt[384 + PE_NR] = 128u;
        asm volatile("" ::: "memory");
    }
    LDS_WAIT(); asm volatile("" ::: "memory");
    int nb;
    {
        const int rd = lane >> 2, j = (rd & 1) ? 3 - (lane & 3) : (lane & 3);
        const LAS unsigned* lt = lw + j * PE_TOK_W;
        const int n0 = rd < PE_NR ? (int)lt[384 + rd] : 128, n1 = rd < PE_NR ? (int)lt[384 + rd + 1] : 128;
#ifndef PE_FULLB
#define PE_FULLB 1
#endif
        const int nbl = PE_FULLB ? (n1 >> 2) - (n0 >> 2) : (n1 - n0 + 3) >> 2;
        int inc = nbl;
#pragma unroll
        for (int off = 1; off < 64; off <<= 1) { const int tv = __shfl_up(inc, off); if (lane >= off) inc += tv; }
        nb = __builtin_amdgcn_readlane(inc, 63);
        const int ofs = inc - nbl;
#pragma unroll 1
        for (int q = 0; q < nbl; ++q) { const int i0 = PE_FULLB ? ((n0 >> 2) + q) * 4 : n0 + 4 * q, c = PE_FULLB ? 4 : ((n1 - i0) < 4 ? (n1 - i0) : 4);
            const unsigned e0 = lt[i0], e1 = lt[i0 + (c > 1 ? 1 : c - 1)], e2 = lt[i0 + (c > 2 ? 2 : c - 1)], e3 = lt[i0 + (c > 3 ? 3 : c - 1)];
            *(LAS v4u*)(ents + 4 * (ofs + q)) = (v4u){e0 | (((unsigned)j | ((unsigned)c << 2) | ((unsigned)i0 << 5)) << 14), e1, e2, e3}; }
        if (lane < 2 * PE_RD_N) *(LAS v4u*)(ents + 4 * (nb + lane)) = (v4u){0u, 0u, 0u, 0u};
    }
    LDS_WAIT(); asm volatile("" ::: "memory");
    constexpr int PE_RD = PE_RD_N;
    v4u rr[PE_RD][4];
#define PE_LDO(dst, vo_, sbase_) asm volatile("global_load_dwordx4 %0, %1, %2" : "=&v"(dst) : "v"(vo_), "s"(sbase_) : "memory")
#define PE_ISSUE(S, rec_, BASE) do { \
        { const unsigned vo_ = (((rec_).x & 0x3fffu) << 10) + voff; PE_LDO(rr[S][0], vo_, BASE); } { const unsigned vo_ = ((rec_).y << 10) + voff; PE_LDO(rr[S][1], vo_, BASE); } \
        { const unsigned vo_ = ((rec_).z << 10) + voff; PE_LDO(rr[S][2], vo_, BASE); } { const unsigned vo_ = ((rec_).w << 10) + voff; PE_LDO(rr[S][3], vo_, BASE); } } while (0)
#define PE_WAIT4(S, cntstr) asm volatile("s_waitcnt " cntstr : "+v"(rr[S][0]), "+v"(rr[S][1]), "+v"(rr[S][2]), "+v"(rr[S][3]) :: "memory")
#define PE_UDOTS(S) asm("v_dot4_i32_i8 %0, %4, %20, 0\n\tv_dot4_i32_i8 %1, %8, %20, 0\n\tv_dot4_i32_i8 %2, %12, %20, 0\n\tv_dot4_i32_i8 %3, %16, %20, 0\n\t" \
                        "v_dot4_i32_i8 %0, %5, %21, %0\n\tv_dot4_i32_i8 %1, %9, %21, %1\n\tv_dot4_i32_i8 %2, %13, %21, %2\n\tv_dot4_i32_i8 %3, %17, %21, %3\n\t" \
                        "v_dot4_i32_i8 %0, %6, %22, %0\n\tv_dot4_i32_i8 %1, %10, %22, %1\n\tv_dot4_i32_i8 %2, %14, %22, %2\n\tv_dot4_i32_i8 %3, %18, %22, %3\n\t" \
                        "v_dot4_i32_i8 %0, %7, %23, %0\n\tv_dot4_i32_i8 %1, %11, %23, %1\n\tv_dot4_i32_i8 %2, %15, %23, %2\n\tv_dot4_i32_i8 %3, %19, %23, %3\n\ts_nop 2" \
        : "=&v"(d_[0]), "=&v"(d_[1]), "=&v"(d_[2]), "=&v"(d_[3]) \
        : "v"(rr[S][0].x), "v"(rr[S][0].y), "v"(rr[S][0].z), "v"(rr[S][0].w), "v"(rr[S][1].x), "v"(rr[S][1].y), "v"(rr[S][1].z), "v"(rr[S][1].w), \
          "v"(rr[S][2].x), "v"(rr[S][2].y), "v"(rr[S][2].z), "v"(rr[S][2].w), "v"(rr[S][3].x), "v"(rr[S][3].y), "v"(rr[S][3].z), "v"(rr[S][3].w), \
          "v"(hcur.x), "v"(hcur.y), "v"(hcur.z), "v"(hcur.w))
#define PE_VDOTS(f0, f1, f2, f3, b0, b1, b2, b3, w) asm("v_dot4_i32_i8 %0, %4, %8, 0\n\tv_dot4_i32_i8 %1, %5, %8, 0\n\tv_dot4_i32_i8 %2, %6, %8, 0\n\tv_dot4_i32_i8 %3, %7, %8, 0\n\t" \
                        "v_cvt_f32_i32_e32 %0, %0\n\tv_cvt_f32_i32_e32 %1, %1\n\tv_cvt_f32_i32_e32 %2, %2\n\tv_cvt_f32_i32_e32 %3, %3" \
        : "=&v"(f0), "=&v"(f1), "=&v"(f2), "=&v"(f3) : "v"(b0), "v"(b1), "v"(b2), "v"(b3), "v"(w))
#define PE_UBATCH(S, entv) do { const unsigned en_ = (entv) >> 14; const int jj_ = (int)(en_ & 3u), cc_ = (int)((en_ >> 2) & 7u), ii_ = (int)(en_ >> 5); \
        if (cc_ > 0) { if (jj_ != jcur) { jcur = jj_; hcur = *(const LAS v4u*)(hql + (jj_ * 64 + lane) * 4); } \
            LAS unsigned* lt_ = lw + jj_ * PE_TOK_W; const int myk_ = lane >> 4; \
            const float gsc_ = __builtin_bit_cast(float, lt_[128 + ii_ + myk_]), usc_ = __builtin_bit_cast(float, lt_[256 + ii_ + myk_]);     \
            int d_[4]; \
            PE_UDOTS(S); \
            int r1_; \
            { const v2u p02_ = __builtin_amdgcn_permlane32_swap((unsigned)d_[0], (unsigned)d_[2], false, false), p13_ = __builtin_amdgcn_permlane32_swap((unsigned)d_[1], (unsigned)d_[3], false, false); \
              const v2u q_ = __builtin_amdgcn_permlane16_swap(p02_.x + p02_.y, p13_.x + p13_.y, false, false); r1_ = row16_sum_i((int)(q_.x + q_.y)); }     \
            const float x_ = (float)r1_ * usc_, e_ = __builtin_amdgcn_exp2f(x_ * __builtin_fmaf(x_ * x_, -0.10294324f, -2.3022082f));     \
            const float act_ = x_ * __builtin_amdgcn_rcpf(1.0f + e_) * gsc_; \
            if ((lane & 15) == 0 && myk_ < cc_) lt_[128 + ii_ + myk_] = __builtin_bit_cast(unsigned, act_); } } while (0)
#define PE_FLUSH() do { _Pragma("unroll") for (int J_ = 0; J_ < PE_NT; ++J_) { const float sel_ = (jcur == J_) ? 1.0f : 0.0f; const f32x2 sel2_ = (f32x2){sel_, sel_};     \
            _Pragma("unroll") for (int i_ = 0; i_ < 8; ++i_) acc[J_][i_] = __builtin_elementwise_fma(cur[i_], sel2_, acc[J_][i_]); } \
        _Pragma("unroll") for (int i_ = 0; i_ < 8; ++i_) cur[i_] = (f32x2){0.f, 0.f}; } while (0)
#define PE_VBATCH(S, entv) do { const unsigned en_ = (entv) >> 14; const int jj_ = (int)(en_ & 3u), cc_ = (int)((en_ >> 2) & 7u), ii_ = (int)(en_ >> 5); \
        if (cc_ > 0) { if (jj_ != jcur) { PE_FLUSH(); jcur = jj_; } \
            const LAS unsigned* lt_ = lw + jj_ * PE_TOK_W + 128 + ii_; \
            const float w0_ = __builtin_bit_cast(float, lt_[0]), w1_ = (cc_ > 1) ? __builtin_bit_cast(float, lt_[1]) : 0.f, w2_ = (cc_ > 2) ? __builtin_bit_cast(float, lt_[2]) : 0.f, w3_ = (cc_ > 3) ? __builtin_bit_cast(float, lt_[3]) : 0.f; \
            const float wm_ = fmaxf(fmaxf(fmaxf(fabsf(w0_), fabsf(w1_)), fmaxf(fabsf(w2_), fabsf(w3_))), 1e-30f), wq_ = 127.0f * __builtin_amdgcn_rcpf(wm_), ws_ = wm_ * (1.0f / 127.0f); \
            const unsigned q0_ = __builtin_bit_cast(unsigned, __builtin_fmaf(w0_, wq_, 12582912.0f)), q1_ = __builtin_bit_cast(unsigned, __builtin_fmaf(w1_, wq_, 12582912.0f)), \
                           q2_ = __builtin_bit_cast(unsigned, __builtin_fmaf(w2_, wq_, 12582912.0f)), q3_ = __builtin_bit_cast(unsigned, __builtin_fmaf(w3_, wq_, 12582912.0f)); \
            const unsigned w4u_ = __builtin_amdgcn_perm(__builtin_amdgcn_perm(q3_, q2_, 0x0c0c0400u), __builtin_amdgcn_perm(q1_, q0_, 0x0c0c0400u), 0x05040100u);     \
            const f32x2 ws2_ = (f32x2){ws_, ws_}; \
            _Pragma("unroll") for (int m_ = 0; m_ < 4; ++m_) { \
                const unsigned R0_ = rr[S][0][m_], R1_ = rr[S][1][m_], R2_ = rr[S][2][m_], R3_ = rr[S][3][m_]; \
                const unsigned X_ = __builtin_amdgcn_perm(R1_, R0_, 0x05010400u), Y_ = __builtin_amdgcn_perm(R1_, R0_, 0x07030602u), Z_ = __builtin_amdgcn_perm(R3_, R2_, 0x05010400u), W_ = __builtin_amdgcn_perm(R3_, R2_, 0x07030602u); \
                float t0_, t1_, t2_, t3_; \
                const unsigned b0_ = __builtin_amdgcn_perm(Z_, X_, 0x05040100u), b1_ = __builtin_amdgcn_perm(Z_, X_, 0x07060302u), b2_ = __builtin_amdgcn_perm(W_, Y_, 0x05040100u), b3_ = __builtin_amdgcn_perm(W_, Y_, 0x07060302u); \
                PE_VDOTS(t0_, t1_, t2_, t3_, b0_, b1_, b2_, b3_, w4u_); \
                cur[2 * m_] = __builtin_elementwise_fma((f32x2){t0_, t1_}, ws2_, cur[2 * m_]); \
                cur[2 * m_ + 1] = __builtin_elementwise_fma((f32x2){t2_, t3_}, ws2_, cur[2 * m_ + 1]); } } } while (0)
    {
        unsigned er[PE_RD];
#pragma unroll
        for (int q = 0; q < PE_RD; ++q) { const v4u rec = *(const LAS v4u*)(ents + 4 * q); er[q] = __builtin_amdgcn_readfirstlane(rec.x); PE_ISSUE(q, rec, UB8); }
        int jcur = (int)((er[0] >> 14) & 3u);
        v4u hcur = *(const LAS v4u*)(hql + (jcur * 64 + lane) * 4);
        v4u nrec = *(const LAS v4u*)(ents + 4 * PE_RD);
#pragma unroll 1
        for (int bi = 0; bi < nb; bi += PE_RD) {
#pragma unroll
            for (int q = 0; q < PE_RD; ++q) {
                PE_WAIT4(q, PE_VMW);
                PE_UBATCH(q, er[q]);
                er[q] = __builtin_amdgcn_readfirstlane(nrec.x);
                PE_ISSUE(q, nrec, UB8);
                nrec = *(const LAS v4u*)(ents + 4 * (bi + q + PE_RD + 1));
            }
        }
#pragma unroll
        for (int q = 0; q < PE_RD; ++q) PE_WAIT4(q, "vmcnt(0)");
    }
    LDS_WAIT(); asm volatile("" ::: "memory");
    {
        unsigned er[PE_RD];
#pragma unroll
        for (int q = 0; q < PE_RD; ++q) { const v4u rec = *(const LAS v4u*)(ents + 4 * q); er[q] = __builtin_amdgcn_readfirstlane(rec.x); PE_ISSUE(q, rec, VB8); }
        f32x2 cur[8];
#pragma unroll
        for (int i = 0; i < 8; ++i) cur[i] = (f32x2){0.f, 0.f};
        int jcur = (int)((er[0] >> 14) & 3u);
        v4u nrec = *(const LAS v4u*)(ents + 4 * PE_RD);
#pragma unroll 1
        for (int bi = 0; bi < nb; bi += PE_RD) {
#pragma unroll
            for (int q = 0; q < PE_RD; ++q) {
                PE_WAIT4(q, PE_VMW);
                PE_VBATCH(q, er[q]);
                er[q] = __builtin_amdgcn_readfirstlane(nrec.x);
                PE_ISSUE(q, nrec, VB8);
                nrec = *(const LAS v4u*)(ents + 4 * (bi + q + PE_RD + 1));
            }
        }
#pragma unroll
        for (int q = 0; q < PE_RD; ++q) PE_WAIT4(q, "vmcnt(0)");
        PE_FLUSH();
    }
#undef PE_UBATCH
#undef PE_VBATCH
#undef PE_FLUSH
#undef PE_WAIT4
#undef PE_ISSUE
#undef PE_LDO
#undef PE_UDOTS
#undef PE_VDOTS
    asm volatile("v_mbcnt_lo_u32_b32 %0, -1, 0\n\tv_mbcnt_hi_u32_b32 %0, -1, %0" : "=v"(lane)); asm volatile("" : "+s"(tbase));
#pragma unroll
    for (int j = 0; j < PE_NT; ++j) {
        const int t = tbase + j;
        float ss = 0.f; f32x4 xo[4];
        { const v4u* xrow = (const v4u*)((const bf16*)(ws + WS_XB) + (size_t)t * 1024 + 16 * lane); const v4u xa = xrow[0], xc = xrow[1];
          xo[0] = (f32x4){bflo(xa.x), bfhi(xa.x), bflo(xa.y), bfhi(xa.y)}; xo[1] = (f32x4){bflo(xa.z), bfhi(xa.z), bflo(xa.w), bfhi(xa.w)};
          xo[2] = (f32x4){bflo(xc.x), bfhi(xc.x), bflo(xc.y), bfhi(xc.y)}; xo[3] = (f32x4){bflo(xc.z), bfhi(xc.z), bflo(xc.w), bfhi(xc.w)}; }
#pragma unroll
        for (int i = 0; i < 4; ++i) { xo[i].x += acc[j][2 * i].x; xo[i].y += acc[j][2 * i].y; xo[i].z += acc[j][2 * i + 1].x; xo[i].w += acc[j][2 * i + 1].y;
            ss += (xo[i].x * xo[i].x + xo[i].y * xo[i].y) + (xo[i].z * xo[i].z + xo[i].w * xo[i].w); }
        const float rstd3 = rsqrtf(wave_sum(ss) * (1.0f / 1024.0f) + 1e-6f);
        float* orow = dstbase + (size_t)t * 1024 + 16 * lane;
#pragma unroll
        for (int i = 0; i < 4; ++i) { const f32x4 w = ((const f32x4*)(P.norm_final_w + 16 * lane))[i];
            ((f32x4*)orow)[i] = (f32x4){xo[i].x * rstd3 * w.x, xo[i].y * rstd3 * w.y, xo[i].z * rstd3 * w.z, xo[i].w * rstd3 * w.w}; }
    }
    LDS_WAIT(); asm volatile("s_waitcnt vmcnt(0)" ::: "memory");
}


#ifndef TWICE_MASK
#define TWICE_MASK 0
#endif
struct TwiceOrder { pg8::StaticOrder S; int per, reps;
    __device__ bool next(int i, pg8::Unit& u) const { if (i >= per * reps) return false; return S.next(i % per, u); }
    __device__ __forceinline__ void a_ready(const pg8::Unit&) const {} __device__ __forceinline__ void done(const pg8::Unit&) const {} };
template <class B> __device__ __forceinline__ bool rep_again(volatile LAS unsigned* MISC, B& bar) {
    __syncthreads(); const unsigned c = MISC[20]; __syncthreads();
    if (threadIdx.x == 0) MISC[20] = c ^ 1u;
    __syncthreads();
    if (c == 0u) { xcd_barrier(bar); return true; }
    return false;
}
__global__ void __launch_bounds__(NWAVES * 64, 2) hybrid_fwd(Params P) {
    extern __shared__ __attribute__((aligned(16))) unsigned char lds_raw[];
    LAS unsigned char* lds = (LAS unsigned char*)lds_raw;
    volatile LAS unsigned* MISC = (volatile LAS unsigned*)(lds + MISC_OFF);
    const int tid = threadIdx.x, lane = tid & 63, wave = __builtin_amdgcn_readfirstlane(tid >> 6);
    const int G = gridDim.x, bx = blockIdx.x;
    const int vcu = (G % 8 == 0) ? (bx % 8) * (G / 8) + bx / 8 : bx;
    unsigned char* ws = P.ws;
    for (int u = tid; u < 64; u += NWAVES * 64) MISC[u] = 0u;
    __syncthreads();
    XcdBarrier bar; bar.bar = (unsigned*)(ws + WS_CTL) + CW_BAR; bar.x = 0; bar.st = nullptr;
    if (!MK_PER_PHASE) bar = xcd_barrier_post((unsigned*)(ws + WS_CTL) + CW_BAR, MISC + 8);
    const int lo = P.ph_lo, hi = P.ph_hi;
#ifndef PHASE_MASK
#define PHASE_MASK 0xFFF
#endif
#define IN(k) (((PHASE_MASK >> (k)) & 1) && lo <= (k) && (k) < hi)
#define SEAM(k) do { if (IN(k) && IN((k) + 1)) xcd_barrier(bar); } while (0)
#ifndef REP_MASK
#define REP_MASK 0
#endif
#ifndef PE_EXP_MASK
#define PE_EXP_MASK 0x3fff
#endif
#define REPS(k) for (bool again_ = true; again_; again_ = (((REP_MASK >> (k)) & 1) ? rep_again(MISC, bar) : false))
    using namespace pg8;
    bf16* XB = (bf16*)(ws + WS_XB);

    if (IN(0)) REPS(0) { p0_prologue(P, lds, tid, lane, wave, vcu, G); }
    SEAM(0);
    if (IN(1)) REPS(1) {
        { Gemm gm{XB, (const bf16_t*)(ws + WS_WIN), T, 3072, 1024}; StaticOrder S; S.init(T, 3072, G, bx);
          EpiBf16Rs E{(bf16_t*)(ws + WS_QKV), 1536, 6, (bf16_t*)(ws + WS_XR), 512, (size_t)T * 512, nullptr, 1.0f};
          gemm_phase<EpiBf16Rs, StaticOrder, PG8_ALIGN, PG8_SP2>(lds, gm, S, E); }
    }
    SEAM(1);
    if (IN(3)) REPS(3) {
        if (bx < SCAN_WGS) gdn_scan(P, lds, bx, tid, lane, wave);
        else {
            const int wk = bx - SCAN_WGS, NWK = G - SCAN_WGS;
            unsigned* lcnt = (unsigned*)(ws + WS_CTL) + CW_LRUCNT;
            for (int q = wk; q < 1024; q += NWK) gdn_local_item(P, lds, (q & 7) * 128 + (q >> 3), tid);
            unsigned ndone = 0;
            for (int lt = wk; lt < 256; lt += NWK) { lru_local_item(P, lds, lt, tid, lane, wave); ++ndone; }
            asm volatile("s_waitcnt vmcnt(0)" ::: "memory");
            __syncthreads();
            if (tid == 0 && ndone) { __builtin_amdgcn_fence(__ATOMIC_RELEASE, "agent"); asm volatile("s_waitcnt vmcnt(0)" ::: "memory");
                                     __hip_atomic_fetch_add(lcnt, ndone, __ATOMIC_RELAXED, __HIP_MEMORY_SCOPE_AGENT); }
            if (wk < 16) {
                struct OneUnit { int pm, pn; __device__ bool next(int i, Unit& u) const { if (i > 0) return false; u.pm = pm; u.pn = pn; return true; }
                                 __device__ void a_ready(const Unit&) const {} __device__ void done(const Unit&) const {} };
                Gemm gm{(const bf16_t*)(ws + WS_MEMN), (const bf16_t*)(ws + WS_WKV), 512, 2048, 1024}; OneUnit S{wk >> 3, wk & 7};
                EpiKV E{(bf16_t*)(ws + WS_KB), (bf16_t*)(ws + WS_VTP)};
                gemm_phase<EpiKV, OneUnit, PG8_ALIGN, PG8_SP2>(lds, gm, S, E);
            }
            if (wk == 16 || wk == 17) {
                if (tid == 0) { unsigned sp = 0;
                    while (__hip_atomic_load(lcnt, __ATOMIC_RELAXED, __HIP_MEMORY_SCOPE_AGENT) < 256u) { __builtin_amdgcn_s_sleep(8); if (++sp > (1u << 22)) break; }
                    __builtin_amdgcn_fence(__ATOMIC_ACQUIRE, "agent"); asm volatile("s_waitcnt vmcnt(0)" ::: "memory"); }
                __syncthreads();
                lru_carry(P, (wk - 16) * NWAVES + wave, lane);
                asm volatile("s_waitcnt vmcnt(0)" ::: "memory");
                __syncthreads();
                if (tid == 0) { __builtin_amdgcn_fence(__ATOMIC_RELEASE, "agent"); asm volatile("s_waitcnt vmcnt(0)" ::: "memory");
                                __hip_atomic_fetch_add(lcnt + 64, 1u, __ATOMIC_RELAXED, __HIP_MEMORY_SCOPE_AGENT); }
            } else {
                const int w2 = (wk < 16 ? wk : wk - 2), N2 = NWK - 2;
                cvt_table_fp8(P.peer_v, ws + WS_VB, (float*)(ws + WS_VSC), w2 * NWAVES + wave, N2 * NWAVES, lane);
                late_weight_prep(P, lds, lane, wave, w2 * NWAVES + wave, N2 * NWAVES);
                if (tid == 0) { unsigned sp = 0;
                    while (__hip_atomic_load(lcnt + 64, __ATOMIC_RELAXED, __HIP_MEMORY_SCOPE_AGENT) < 2u) { __builtin_amdgcn_s_sleep(8); if (++sp > (1u << 22)) break; }
                    __builtin_amdgcn_fence(__ATOMIC_ACQUIRE, "agent"); asm volatile("s_waitcnt vmcnt(0)" ::: "memory"); }
                __syncthreads();
                lru_combine(P, (size_t)w2 * (NWAVES * 64) + tid, (size_t)N2 * (NWAVES * 64));
            }
        }
    }
    SEAM(3);
    if (IN(4)) REPS(4) {
        gdn_gate_norm(P, (size_t)bx * (NWAVES * 64) + tid, (size_t)G * (NWAVES * 64));
        cvt_table_fp8(P.peer_u, ws + WS_UB, (float*)(ws + WS_USC), bx * NWAVES + wave, G * NWAVES, lane);
    }
    SEAM(4);
    if (IN(5)) {
        Gemm gm{(const bf16_t*)((const unsigned char*)P.out + OUT_Y), (const bf16_t*)(ws + WS_WOUT), T, 1024, 1024}; StaticOrder S; S.init(T, 1024, G, bx);
        EpiResidBf<true> E{P.x, XB, (float*)(ws + WS_SSQ1)};
        gemm_phase<EpiResidBf<true>, StaticOrder, PG8_ALIGN, PG8_SP2>(lds, gm, S, E);
    }
    SEAM(5);
    if (IN(6)) REPS(6) {
        Gemm gm{XB, (const bf16_t*)(ws + WS_WQ), T, 1024, 1024};
        EpiBf16Rs E{(bf16_t*)(ws + WS_Q), 1024, 4, nullptr, 256, 0, (const float*)(ws + WS_SSQ1), 0.0625f};
#if (TWICE_MASK >> 6) & 1
        { TwiceOrder S; S.S.init(T, 1024, G, bx); S.per = 1; S.reps = 2;
          gemm_phase<EpiBf16Rs, TwiceOrder, PG8_ALIGN, PG8_SP2>(lds, gm, S, E); }
#else
        { StaticOrder S; S.init(T, 1024, G, bx);
          gemm_phase<EpiBf16Rs, StaticOrder, PG8_ALIGN, PG8_SP2>(lds, gm, S, E); }
#endif
        Unit u;
        { const int wgid = (bx & 7) * 32 + (bx >> 3); u.pm = (wgid >> 5) * 8 + (wgid & 7); u.pn = (wgid & 31) >> 3; }
        if (G == 256) {
            asm volatile("s_waitcnt vmcnt(0)" ::: "memory");
            __syncthreads();
            const int b = u.pm >> 5, qb0 = (u.pm & 31) * 2, h = u.pn;
#pragma unroll 1
            for (int qq = 0; qq < (((TWICE_MASK >> 7) & 1) ? 4 : 2); qq += XA_NPS) xattn_unit(P, lds, (b << 8) | ((qb0 + (qq & 1)) << 2) | h, tid, lane, wave);
        }
    }
    if (IN(7)) REPS(7) { }
    SEAM(7);
    if (IN(8)) {
        Gemm gm{(const bf16_t*)(ws + WS_AO), (const bf16_t*)(ws + WS_WO), T, 1024, 1024}; StaticOrder S; S.init(T, 1024, G, bx);
        EpiResidBf<false> E{nullptr, XB, (float*)(ws + WS_SSQ2)};
        gemm_phase<EpiResidBf<false>, StaticOrder, PG8_ALIGN, PG8_SP2>(lds, gm, S, E);
    }
    SEAM(8);
    if (IN(9)) REPS(9) {
        Gemm gm{XB, (const bf16_t*)(ws + WS_PWQ), T, 2048, 1024};
        EpiF16Rs E{(_Float16*)(ws + WS_PQ), 2048, (const float*)(ws + WS_SSQ2)};
#if (TWICE_MASK >> 9) & 1
        TwiceOrder S; S.S.init(T, 2048, G, bx); S.per = 2; S.reps = 2;
        gemm_phase<EpiF16Rs, TwiceOrder, PG8_ALIGN, PG8_SP2>(lds, gm, S, E);
#else
        StaticOrder S; S.init(T, 2048, G, bx);
        gemm_phase<EpiF16Rs, StaticOrder, PG8_ALIGN, PG8_SP2>(lds, gm, S, E);
#endif
    }
    SEAM(9);
    if (IN(10)) REPS(10) {
    }
    if (IN(11)) REPS(11) {
#if (TWICE_MASK >> 11) & 1
        for (int it = 0; it < 4; ++it) { const int tb = (bx * NWAVES + wave) * PE_NT + (it >> 1) * (G * NWAVES * PE_NT); if (tb < T) peer_pass(P, lds, tb, lane, wave, P.out, (it & 1) ? 0x3fff : PE_EXP_MASK); }
#else
#ifndef PE_PASS_BARRIER
#define PE_PASS_BARRIER 0
#endif
        for (int tb = (bx * NWAVES + wave) * PE_NT, np = 0; tb < T; tb += G * NWAVES * PE_NT, ++np) {
            if (PE_PASS_BARRIER && np > 0 && (T % (G * NWAVES * PE_NT)) == 0) xcd_barrier(bar);
            peer_pass(P, lds, tb, lane, wave, P.out);
        }
#endif
    }
#undef IN
#undef SEAM
}

extern "C" void kernel_launch(void* const* d_in, const int* in_sizes, int n_in, void* d_out, int out_size, void* d_ws, size_t ws_size, hipStream_t stream) {
    static int grid = 0;
    if (grid == 0) {
        if (n_in != 27 || in_sizes[0] != T * D || out_size != T * D || ws_size < WS_END) {
            fprintf(stderr, "kernel_launch: unexpected shapes (n_in %d, in0 %d, out %d, ws %zu); nothing launched\n", n_in, n_in > 0 ? in_sizes[0] : -1, out_size, ws_size); grid = -1; return; }
        int dev = 0, cus = 0, per_cu = 0;
        if (hipGetDevice(&dev) != hipSuccess || hipDeviceGetAttribute(&cus, hipDeviceAttributeMultiprocessorCount, dev) != hipSuccess) { grid = -1; return; }
        if (hipFuncSetAttribute((const void*)hybrid_fwd, hipFuncAttributeMaxDynamicSharedMemorySize, LDS_BYTES) != hipSuccess) { fprintf(stderr, "kernel_launch: hipFuncSetAttribute failed\n"); grid = -1; return; }
        if (hipOccupancyMaxActiveBlocksPerMultiprocessor(&per_cu, (const void*)hybrid_fwd, NWAVES * 64, LDS_BYTES) != hipSuccess || per_cu < 1)
            fprintf(stderr, "kernel_launch: note: occupancy query reports %d workgroups per CU\n", per_cu);
        (void)hipGetLastError();
        grid = cus;
        if (grid != 256) fprintf(stderr, "kernel_launch: %d CUs (built for 256)\n", grid);
    }
    if (grid < 0) return;
    if (hipMemsetAsync((char*)d_ws + WS_CTL, 0, CTL_ZERO_BYTES, stream) != hipSuccess) { fprintf(stderr, "kernel_launch: hipMemsetAsync failed\n"); return; }
    Params p{};
    const float** pp = (const float**)&p;
    for (int i = 0; i < 27; ++i) pp[i] = (const float*)d_in[i];
    p.out = (float*)d_out; p.ws = (unsigned char*)d_ws;
#if MK_PER_PHASE
    for (int k = 0; k < N_PHASES; ++k) { p.ph_lo = k; p.ph_hi = k + 1; hipLaunchKernelGGL(hybrid_fwd, dim3(grid), dim3(NWAVES * 64), LDS_BYTES, stream, p); }
#else
    p.ph_lo = 0; p.ph_hi = N_PHASES;
    hipLaunchKernelGGL(hybrid_fwd, dim3(grid), dim3(NWAVES * 64), LDS_BYTES, stream, p);
#endif
    const hipError_t le = hipPeekAtLastError();
    if (le != hipSuccess) fprintf(stderr, "kernel_launch: launch failed: %s\n", hipGetErrorName(le));
}
```

```cpp
#include <hip/hip_runtime.h>
#include <cstdio>
#include <cstdint>
namespace pg8 {
#define PG8_LAS __attribute__((address_space(3)))
typedef unsigned short bf16_t;
typedef short bf16x8 __attribute__((ext_vector_type(8)));
typedef float f32x4 __attribute__((ext_vector_type(4)));
typedef unsigned u32x4 __attribute__((ext_vector_type(4)));
constexpr int BM = 256, BK = 64, HALF = 128, HTB = HALF * BK * 2  , STAGE_BYTES = 8 * HTB, NXCD = 8, WGM = 8;

__host__ __device__ __forceinline__ int lds_byte(int r, int c) { const int st = (r >> 4) * 2 + (c >> 5), rr = r & 15, cc = c & 31, ob = rr * 64 + cc * 2; return st * 1024 + (ob ^ (((ob >> 9) & 1) << 5)); }
__host__ __device__ __forceinline__ void stage_rc(int b, int& R, int& C) { const int st = b / 1024, sb = b % 1024, swz = sb ^ (((sb >> 9) & 1) << 5); R = (st >> 1) * 16 + swz / 64; C = (st & 1) * 32 + (swz % 64) / 2; }
__host__ __device__ __forceinline__ int perm32(int rho) { const int n = rho >> 4, i = rho & 15; return 8 * (i >> 2) + 4 * n + (i & 3); }

struct Unit { int pm, pn; };
struct Gemm { const bf16_t* A; const bf16_t* Bt; int M, N, K; };

struct StaticOrder {
    int nM, nN, nwg, G, c;
    __host__ __device__ void init(int M, int N, int G_, int c_) { nM = M / BM; nN = N / BM; nwg = nM * nN; G = G_; c = c_; }
    __host__ __device__ bool next(int i, Unit& u) const {
        const long L = (long)i * G + c; if (L >= nwg) return false;
        int wgid = (int)L; { const int q = nwg / NXCD, r = nwg % NXCD, xcd = wgid % NXCD, off = wgid / NXCD; wgid = (xcd < r ? xcd * (q + 1) : r * (q + 1) + (xcd - r) * q) + off; }
        const int nig = WGM * nN, gid = wgid / nig, fm = gid * WGM, gsz = (nM - fm) < WGM ? (nM - fm) : WGM;
        u.pm = fm + ((wgid % nig) % gsz); u.pn = (wgid % nig) / gsz; return true;
    }
    __device__ __forceinline__ void a_ready(const Unit&) const {}
    __device__ __forceinline__ void done(const Unit&) const {}
};

__device__ __forceinline__ unsigned cvt_pk_bf16(float lo, float hi) { unsigned r; asm volatile("v_cvt_pk_bf16_f32 %0, %1, %2" : "=v"(r) : "v"(lo), "v"(hi)); return r; }
template <class Epi, class Sched, bool ALIGN_EPI = false, bool SP2 = false>
__device__ __forceinline__ void gemm_phase(PG8_LAS unsigned char* lds, const Gemm g, const Sched& S, const Epi& E) {
    const int tid = threadIdx.x, wid = __builtin_amdgcn_readfirstlane(tid >> 6), lane = tid & 63, wr = wid >> 2, wc = wid & 3, fr = lane & 15, fq = lane >> 4;
    const int K = g.K, nt = K / BK;
    unsigned voffA[2], voffB[2];
#pragma unroll
    for (int i = 0; i < 2; ++i) { int R, C; stage_rc(tid * 16 + i * 8192, R, C); const int Rb = Epi::PERM ? ((R & ~31) + perm32(R & 31)) : R;
        voffA[i] = (unsigned)(R * K + C) * 2u; voffB[i] = (unsigned)(Rb * K + C) * 2u; }
    const size_t kstep = (size_t)(BK * 2);
    const size_t hstep = (size_t)HALF * K * 2;
    const size_t tstep = 2 * hstep;
    const unsigned ldsw = (unsigned)wid * 1024u;
    const int aoff = lds_byte(wr * 64 + fr, fq * 8), boff = lds_byte(wc * 32 + fr, fq * 8);
#define PG8_SA(b, h) (((b) * 2 + (h)) * HTB)
#define PG8_SB(b, h) ((4 + (b) * 2 + (h)) * HTB)
#define PG8_STAGE(bufoff, gbase, voff) do { _Pragma("unroll") for (int _i = 0; _i < 2; ++_i) \
        __builtin_amdgcn_global_load_lds((const unsigned*)((const char*)(gbase) + (voff)[_i]), (PG8_LAS unsigned*)(lds + (bufoff) + ldsw + _i * 8192), 16, 0, 0); } while (0)
#define PG8_LDA(dst, b, h) do { _Pragma("unroll") for (int m = 0; m < 4; ++m) _Pragma("unroll") for (int k = 0; k < 2; ++k) dst[m][k] = *(const PG8_LAS bf16x8*)(lds + PG8_SA(b, h) + aoff + m * 2048 + k * 1024); } while (0)
#define PG8_LDB(dst, b, h) do { _Pragma("unroll") for (int n = 0; n < 2; ++n) _Pragma("unroll") for (int k = 0; k < 2; ++k) dst[n][k] = *(const PG8_LAS bf16x8*)(lds + PG8_SB(b, h) + boff + n * 2048 + k * 1024); } while (0)
#define PG8_MMA(ai, bj, At, Bt) do { __builtin_amdgcn_s_setprio(1); _Pragma("unroll") for (int m = 0; m < 4; ++m) _Pragma("unroll") for (int n = 0; n < 2; ++n) _Pragma("unroll") for (int k = 0; k < 2; ++k) \
        acc[ai][bj][m][n] = __builtin_amdgcn_mfma_f32_16x16x32_bf16(Bt[n][k], At[m][k], acc[ai][bj][m][n], 0, 0, 0); __builtin_amdgcn_s_setprio(0); } while (0)
#define PG8_WAIT_V(n) asm volatile("s_waitcnt vmcnt(" #n ")" ::: "memory")
#define PG8_WAIT_L(n) asm volatile("s_waitcnt lgkmcnt(" #n ")" ::: "memory")
#define PG8_BAR __builtin_amdgcn_s_barrier()
#define PG8_SCHED __builtin_amdgcn_sched_barrier(0)
    Unit cur, nxt; int ui = 0;
    if (!S.next(0, cur)) return;
    f32x4 acc[2][2][4][2];
#pragma unroll
    for (int a = 0; a < 2; ++a)
#pragma unroll
        for (int b = 0; b < 2; ++b)
#pragma unroll
            for (int m = 0; m < 4; ++m)
#pragma unroll
                for (int n = 0; n < 2; ++n) acc[a][b][m][n] = (f32x4){0.f, 0.f, 0.f, 0.f};
    bf16x8 At[4][2], B0[2][2], B1[2][2];
    const char* cA = (const char*)g.A + (size_t)cur.pm * tstep; const char* cB = (const char*)g.Bt + (size_t)cur.pn * tstep;
    S.a_ready(cur);
    if constexpr (SP2) {
        PG8_STAGE(PG8_SB(0, 0), cB, voffB); PG8_STAGE(PG8_SB(0, 1), cB + hstep, voffB); PG8_STAGE(PG8_SA(0, 0), cA, voffA); PG8_STAGE(PG8_SA(0, 1), cA + hstep, voffA);
        if (wr == 1) PG8_BAR;
        PG8_WAIT_V(2); PG8_BAR;
        PG8_STAGE(PG8_SB(1, 0), cB + kstep, voffB); PG8_STAGE(PG8_SA(1, 0), cA + kstep, voffA); PG8_STAGE(PG8_SB(1, 1), cB + hstep + kstep, voffB);
        PG8_WAIT_V(6); PG8_BAR;
    } else {
        PG8_STAGE(PG8_SB(0, 0), cB, voffB); PG8_STAGE(PG8_SA(0, 0), cA, voffA); PG8_STAGE(PG8_SB(0, 1), cB + hstep, voffB); PG8_STAGE(PG8_SA(0, 1), cA + hstep, voffA);
        if (wr == 1) PG8_BAR;
        PG8_WAIT_V(4); PG8_BAR;
        PG8_STAGE(PG8_SB(1, 0), cB + kstep, voffB); PG8_STAGE(PG8_SA(1, 0), cA + kstep, voffA); PG8_STAGE(PG8_SB(1, 1), cB + hstep + kstep, voffB);
        PG8_WAIT_V(6); PG8_BAR;
    }
    for (;;) {
        const bool has_next = S.next(ui + 1, nxt);
        const char* nA = has_next ? (const char*)g.A + (size_t)nxt.pm * tstep : cA; const char* nB = has_next ? (const char*)g.Bt + (size_t)nxt.pn * tstep : cB;
        for (int t = 0; t < nt; t += 2) {
            const bool last = (t == nt - 2);
            const char* a1 = cA + (size_t)(t + 1) * kstep;
            const char* a2 = last ? nA : cA + (size_t)(t + 2) * kstep; const char* b2 = last ? nB : cB + (size_t)(t + 2) * kstep;
            const char* a3 = a2 + kstep; const char* b3 = b2 + kstep;
            if (last && has_next) S.a_ready(nxt);
            if constexpr (SP2) {
            PG8_LDB(B0, 0, 0); PG8_LDB(B1, 0, 1); PG8_SCHED; PG8_LDA(At, 0, 0); PG8_STAGE(PG8_SA(1, 1), a1 + hstep, voffA);
            PG8_WAIT_V(8); PG8_WAIT_L(0); PG8_BAR; PG8_MMA(0, 0, At, B0); PG8_MMA(0, 1, At, B1); PG8_BAR; PG8_SCHED;
            PG8_LDA(At, 0, 1); PG8_STAGE(PG8_SB(0, 0), b2, voffB); PG8_STAGE(PG8_SB(0, 1), b2 + hstep, voffB); PG8_STAGE(PG8_SA(0, 0), a2, voffA);
            PG8_WAIT_V(8); PG8_WAIT_L(0); PG8_BAR; PG8_MMA(1, 0, At, B0); PG8_MMA(1, 1, At, B1); PG8_BAR; PG8_SCHED;
            PG8_LDB(B0, 1, 0); PG8_LDB(B1, 1, 1); PG8_SCHED; PG8_LDA(At, 1, 0); PG8_STAGE(PG8_SA(0, 1), a2 + hstep, voffA);
            PG8_WAIT_V(8); PG8_WAIT_L(0); PG8_BAR; PG8_MMA(0, 0, At, B0); PG8_MMA(0, 1, At, B1); PG8_BAR; PG8_SCHED;
            PG8_LDA(At, 1, 1); PG8_STAGE(PG8_SB(1, 0), b3, voffB); PG8_STAGE(PG8_SB(1, 1), b3 + hstep, voffB); PG8_STAGE(PG8_SA(1, 0), a3, voffA);
            PG8_WAIT_V(8); PG8_WAIT_L(0); PG8_BAR; PG8_MMA(1, 0, At, B0); PG8_MMA(1, 1, At, B1); PG8_BAR; PG8_SCHED;
            } else {
            PG8_LDB(B0, 0, 0); PG8_SCHED; PG8_LDA(At, 0, 0); PG8_STAGE(PG8_SA(1, 1), a1 + hstep, voffA);
            PG8_WAIT_L(8); PG8_BAR; PG8_WAIT_L(0); PG8_MMA(0, 0, At, B0); PG8_BAR; PG8_SCHED;
            PG8_LDB(B1, 0, 1); PG8_STAGE(PG8_SB(0, 0), b2, voffB);
            PG8_BAR; PG8_WAIT_L(0); PG8_MMA(0, 1, At, B1); PG8_BAR;
            PG8_LDA(At, 0, 1); PG8_STAGE(PG8_SA(0, 0), a2, voffA);
            PG8_BAR; PG8_WAIT_L(0); PG8_MMA(1, 0, At, B0); PG8_BAR; PG8_SCHED;
            PG8_STAGE(PG8_SB(0, 1), b2 + hstep, voffB);
            PG8_WAIT_V(6); PG8_BAR; PG8_MMA(1, 1, At, B1); PG8_BAR;
            PG8_LDB(B0, 1, 0); PG8_SCHED; PG8_LDA(At, 1, 0); PG8_STAGE(PG8_SA(0, 1), a2 + hstep, voffA);
            PG8_WAIT_L(8); PG8_BAR; PG8_WAIT_L(0); PG8_MMA(0, 0, At, B0); PG8_BAR; PG8_SCHED;
            PG8_LDB(B1, 1, 1); PG8_STAGE(PG8_SB(1, 0), b3, voffB);
            PG8_BAR; PG8_WAIT_L(0); PG8_MMA(0, 1, At, B1); PG8_BAR;
            PG8_LDA(At, 1, 1); PG8_STAGE(PG8_SA(1, 0), a3, voffA);
            PG8_BAR; PG8_WAIT_L(0); PG8_MMA(1, 0, At, B0); PG8_BAR; PG8_SCHED;
            PG8_STAGE(PG8_SB(1, 1), b3 + hstep, voffB);
            PG8_WAIT_V(6); PG8_BAR; PG8_MMA(1, 1, At, B1); PG8_BAR;
            }
        }
        if constexpr (ALIGN_EPI) { if (wr == 0) PG8_BAR; }
        if constexpr (!Epi::AFTER_DRAIN) { E(acc, cur, wr, wc, fr, fq); S.done(cur); }
        if (!has_next) break;
#pragma unroll
        for (int a = 0; a < 2; ++a)
#pragma unroll
            for (int b = 0; b < 2; ++b)
#pragma unroll
                for (int m = 0; m < 4; ++m)
#pragma unroll
                    for (int n = 0; n < 2; ++n) acc[a][b][m][n] = (f32x4){0.f, 0.f, 0.f, 0.f};
        cur = nxt; cA = nA; cB = nB; ++ui;
        if constexpr (ALIGN_EPI) { if (wr == 1) PG8_BAR; }
    }
    PG8_WAIT_V(0);
    if constexpr (!ALIGN_EPI) { if (wr == 0) PG8_BAR; }
    PG8_BAR;
    if constexpr (Epi::AFTER_DRAIN) { E.fused(acc, cur, wr, wc, fr, fq, lds, wid, lane); S.done(cur); }
#undef PG8_SA
#undef PG8_SB
#undef PG8_STAGE
#undef PG8_LDA
#undef PG8_LDB
#undef PG8_MMA
#undef PG8_WAIT_V
#undef PG8_WAIT_L
#undef PG8_BAR
#undef PG8_SCHED
}
}

namespace pg8 {
__host__ __device__ __forceinline__ int permk(int kl) { return 8 * ((kl & 15) >> 2) + 4 * (kl >> 4) + (kl & 3); }
struct EpiBf16Rs {
    static constexpr bool PERM = true, AFTER_DRAIN = false;
    bf16_t* O0; int ld0; int ntile0; bf16_t* O1; int ld1; size_t stride1; const float* ssq; float cs;
    __device__ __forceinline__ void operator()(const f32x4 (&acc)[2][2][4][2], const Unit& u, int wr, int wc, int fr, int fq) const {
        bf16_t* base; int ld, colt;
        if (u.pn < ntile0) { base = O0; ld = ld0; colt = u.pn * BM; }
        else { const int q = u.pn - ntile0, per = ld1 / BM; base = O1 + (size_t)(q / per) * stride1; ld = ld1; colt = (q % per) * BM; }
        const int row0 = u.pm * BM + wr * 64 + fr, col0 = colt + wc * 32 + 8 * fq;
#pragma unroll
        for (int ai = 0; ai < 2; ++ai)
#pragma unroll
            for (int m = 0; m < 4; ++m) {
                const int row = row0 + ai * HALF + m * 16;
                float sc = cs; if (ssq) sc *= rsqrtf(ssq[row] * (1.0f / 1024.0f) + 1e-6f);
                bf16_t* rowp = base + (size_t)row * ld + col0;
#pragma unroll
                for (int bj = 0; bj < 2; ++bj) { const f32x4 v0 = acc[ai][bj][m][0] * sc, v1 = acc[ai][bj][m][1] * sc;
                    u32x4 w; w.x = cvt_pk_bf16(v0[0], v0[1]); w.y = cvt_pk_bf16(v0[2], v0[3]); w.z = cvt_pk_bf16(v1[0], v1[1]); w.w = cvt_pk_bf16(v1[2], v1[3]);
                    *(u32x4*)(rowp + bj * HALF) = w; } }
    }
};
struct EpiF16Rs {
    static constexpr bool PERM = true, AFTER_DRAIN = false;
    _Float16* O; int ld; const float* ssq;
    __device__ __forceinline__ void operator()(const f32x4 (&acc)[2][2][4][2], const Unit& u, int wr, int wc, int fr, int fq) const {
        typedef _Float16 f16x8 __attribute__((ext_vector_type(8)));
        const int row0 = u.pm * BM + wr * 64 + fr, col0 = u.pn * BM + wc * 32 + 8 * fq;
#pragma unroll
        for (int ai = 0; ai < 2; ++ai)
#pragma unroll
            for (int m = 0; m < 4; ++m) {
                const int row = row0 + ai * HALF + m * 16;
                const float sc = rsqrtf(ssq[row] * (1.0f / 1024.0f) + 1e-6f);
                _Float16* rowp = O + (size_t)row * ld + col0;
#pragma unroll
                for (int bj = 0; bj < 2; ++bj) { const f32x4 v0 = acc[ai][bj][m][0] * sc, v1 = acc[ai][bj][m][1] * sc;
                    f16x8 w; w[0] = (_Float16)v0[0]; w[1] = (_Float16)v0[1]; w[2] = (_Float16)v0[2]; w[3] = (_Float16)v0[3];
                    w[4] = (_Float16)v1[0]; w[5] = (_Float16)v1[1]; w[6] = (_Float16)v1[2]; w[7] = (_Float16)v1[3];
                    *(f16x8*)(rowp + bj * HALF) = w; } }
    }
};
template <bool BASE_F32> struct EpiResidBf {
    static constexpr bool PERM = true, AFTER_DRAIN = false;
    const float* basef; bf16_t* xb; float* ssq;
    __device__ __forceinline__ void operator()(const f32x4 (&acc)[2][2][4][2], const Unit& u, int wr, int wc, int fr, int fq) const {
        const int row0 = u.pm * BM + wr * 64 + fr, col0 = u.pn * BM + wc * 32 + 8 * fq;
#pragma unroll
        for (int ai = 0; ai < 2; ++ai)
#pragma unroll
            for (int m = 0; m < 4; ++m) {
                const int row = row0 + ai * HALF + m * 16; const size_t off = (size_t)row * 1024 + col0; float s = 0.f;
#pragma unroll
                for (int bj = 0; bj < 2; ++bj) { const size_t o2 = off + bj * HALF;
                    f32x4 b0, b1;
                    if (BASE_F32) { b0 = *(const f32x4*)(basef + o2); b1 = *(const f32x4*)(basef + o2 + 4); }
                    else { const u32x4 p = *(const u32x4*)(xb + o2);
                        b0 = (f32x4){__builtin_bit_cast(float, p.x << 16), __builtin_bit_cast(float, p.x & 0xffff0000u), __builtin_bit_cast(float, p.y << 16), __builtin_bit_cast(float, p.y & 0xffff0000u)};
                        b1 = (f32x4){__builtin_bit_cast(float, p.z << 16), __builtin_bit_cast(float, p.z & 0xffff0000u), __builtin_bit_cast(float, p.w << 16), __builtin_bit_cast(float, p.w & 0xffff0000u)}; }
                    const f32x4 o0 = b0 + acc[ai][bj][m][0], o1 = b1 + acc[ai][bj][m][1];
                    s += ((o0[0] * o0[0] + o0[1] * o0[1]) + (o0[2] * o0[2] + o0[3] * o0[3])) + ((o1[0] * o1[0] + o1[1] * o1[1]) + (o1[2] * o1[2] + o1[3] * o1[3]));
                    u32x4 w; w.x = cvt_pk_bf16(o0[0], o0[1]); w.y = cvt_pk_bf16(o0[2], o0[3]); w.z = cvt_pk_bf16(o1[0], o1[1]); w.w = cvt_pk_bf16(o1[2], o1[3]);
                    *(u32x4*)(xb + o2) = w; }
                s += __shfl_xor(s, 16); s += __shfl_xor(s, 32);
                if (fq == 0) atomicAdd(ssq + row, s);
            }
    }
};
struct EpiKV {
    static constexpr bool PERM = false, AFTER_DRAIN = false;
    bf16_t* Kb; bf16_t* VTp;
    __device__ __forceinline__ void operator()(const f32x4 (&acc)[2][2][4][2], const Unit& u, int wr, int wc, int fr, int fq) const {
        typedef unsigned u32x2v __attribute__((ext_vector_type(2)));
        const int row0 = u.pm * BM + wr * 64 + fr, col0 = u.pn * BM + wc * 32 + 4 * fq;
#pragma unroll
        for (int ai = 0; ai < 2; ++ai)
#pragma unroll
            for (int m = 0; m < 4; ++m) {
                const int row = row0 + ai * HALF + m * 16, b = row >> 8, key = row & 255;
#pragma unroll
                for (int bj = 0; bj < 2; ++bj)
#pragma unroll
                    for (int n = 0; n < 2; ++n) { const int col = col0 + bj * HALF + n * 16; const f32x4 v = acc[ai][bj][m][n];
                        const unsigned p01 = cvt_pk_bf16(v[0], v[1]), p23 = cvt_pk_bf16(v[2], v[3]);
                        if (col < 1024) { const int h = col >> 8, dh = col & 255; u32x2v w; w.x = p01; w.y = p23;
                            *(u32x2v*)(Kb + ((size_t)((b * 4 + h) * 256 + key)) * 256 + dh) = w; }
                        else { const int c2 = col - 1024, h = c2 >> 8, dv = c2 & 255, kp = (key & ~31) | permk(key & 31);
                            bf16_t* d = VTp + ((size_t)((b * 4 + h) * 256 + dv)) * 256 + kp;
                            d[0] = (bf16_t)(p01 & 0xffffu); d[256] = (bf16_t)(p01 >> 16); d[512] = (bf16_t)(p23 & 0xffffu); d[768] = (bf16_t)(p23 >> 16); } }
            }
    }
};
}
#ifndef PG8_SP2
#define PG8_SP2 true
#endif
#ifndef PG8_ALIGN
#define PG8_ALIGN true
#endif

constexpr int NWAVES = 8;
#ifndef MK_PER_PHASE
#define MK_PER_PHASE 0
#endif
constexpr int T = 16384, SEQ = 8192, D = 1024;
constexpr int N_PHASES = 12;

constexpr size_t MiB = 1u << 20, KiB = 1u << 10;
constexpr size_t WS_CTL = 0, CTL_ZERO_BYTES = 1 * MiB;
constexpr int CW_BAR = 4096;
constexpr size_t WS_SSQ1 = 64 * KiB, WS_SSQ2 = 128 * KiB;
constexpr size_t WS_AB = 1 * MiB;
constexpr size_t WS_HEND = WS_AB + 512 * KiB, WS_PEND = WS_HEND + 512 * KiB, WS_HIN = WS_PEND + 512 * KiB;
constexpr size_t WS_DEC = WS_HIN + 512 * KiB;
constexpr size_t WS_SUBK = 3 * MiB + 256 * KiB;
constexpr size_t WS_WIN = 4 * MiB, WS_WOUT = 10 * MiB, WS_WQ = 12 * MiB, WS_WKV = 14 * MiB, WS_WO = 18 * MiB, WS_PWQ = 20 * MiB;
constexpr size_t WS_MEMN = 24 * MiB, WS_KB = 25 * MiB, WS_VTP = 26 * MiB, WS_LRUWT = 27 * MiB, WS_USC = 27 * MiB + 256 * KiB, WS_VSC = 27 * MiB + 384 * KiB;
constexpr size_t WS_XB = 28 * MiB;
constexpr size_t WS_HLOC = 28 * MiB, WS_PCUM = 44 * MiB;
constexpr size_t WS_QKV = 60 * MiB;
constexpr size_t OUT_Y = 4 * MiB;
constexpr size_t OUT_END = OUT_Y + (size_t)16384 * 1024 * 2;
constexpr size_t WS_IDX = 60 * MiB, WS_GW = 68 * MiB;
constexpr size_t WS_UB = 60 * MiB;
constexpr size_t WS_XR = 108 * MiB, WS_Z = 124 * MiB, WS_GATE = 140 * MiB;
constexpr size_t WS_WN = 156 * MiB, WS_UF = 172 * MiB, WS_QD = 188 * MiB, WS_KD = 204 * MiB, WS_ATT = 220 * MiB;
constexpr size_t WS_VB = 228 * MiB;
constexpr size_t WS_Q = 188 * MiB, WS_AO = 124 * MiB;
constexpr size_t WS_PQ = 108 * MiB;
constexpr size_t WS_END = 244 * MiB;
constexpr int CW_GFLAG = 49152;
constexpr int CW_LRUCNT = 8192;
static_assert(WS_XR - WS_QKV == (size_t)T * 1536 * 2 && WS_Z - WS_XR == (size_t)T * 512 * 2 && WS_GATE - WS_Z == (size_t)T * 512 * 2, "in-proj outputs are contiguous");

constexpr int LDS_BYTES = 160 * 1024;
constexpr int MISC_OFF = 159 * 1024;

#define GAS __attribute__((address_space(1)))
#define LAS __attribute__((address_space(3)))
typedef unsigned short bf16;
typedef unsigned v4u __attribute__((ext_vector_type(4)));
typedef unsigned v2u __attribute__((ext_vector_type(2)));
typedef float f32x4 __attribute__((ext_vector_type(4)));
typedef short bf16x8 __attribute__((ext_vector_type(8)));
typedef GAS unsigned gu32;
#define LDS_WAIT() asm volatile("s_waitcnt lgkmcnt(0)" ::: "memory")
__device__ __forceinline__ void st16_wt(void* p, v4u v) { asm volatile("global_store_dwordx4 %0, %1, off sc0 sc1\n\ts_nop 1" :: "v"(p), "v"(v) : "memory"); }
__device__ __forceinline__ unsigned f2bf(float f) { unsigned u = __builtin_bit_cast(unsigned, f); return (u + 0x7fffu + ((u >> 16) & 1u)) >> 16; }
__device__ __forceinline__ unsigned pk2(float lo, float hi) { return f2bf(lo) | (f2bf(hi) << 16); }
__device__ __forceinline__ float bflo(unsigned u) { return __builtin_bit_cast(float, u << 16); }
__device__ __forceinline__ float bfhi(unsigned u) { return __builtin_bit_cast(float, u & 0xffff0000u); }
__device__ __forceinline__ float bf1(bf16 h) { return __builtin_bit_cast(float, (unsigned)h << 16); }
__device__ __forceinline__ float wave_sum(float v) {
#pragma unroll
    for (int o = 1; o < 64; o <<= 1) v += __shfl_xor(v, o);
    return v;
}
__device__ __forceinline__ float row16_sum(float v) {
    v += __builtin_bit_cast(float, __builtin_amdgcn_update_dpp(0, __builtin_bit_cast(int, v), 0xB1, 0xF, 0xF, true));
    v += __builtin_bit_cast(float, __builtin_amdgcn_update_dpp(0, __builtin_bit_cast(int, v), 0x4E, 0xF, 0xF, true));
    v += __builtin_bit_cast(float, __builtin_amdgcn_update_dpp(0, __builtin_bit_cast(int, v), 0x141, 0xF, 0xF, true));
    v += __builtin_bit_cast(float, __builtin_amdgcn_update_dpp(0, __builtin_bit_cast(int, v), 0x140, 0xF, 0xF, true));
    return v;
}
__device__ __forceinline__ float sigmoidf_(float x) { return __builtin_amdgcn_rcpf(1.0f + __expf(-x)); }
__device__ __forceinline__ float softplusf_(float x) { return fmaxf(x, 0.f) + log1pf(__expf(-fabsf(x))); }
__device__ __forceinline__ float siluf_(float x) { return x * __builtin_amdgcn_rcpf(1.0f + __expf(-x)); }
__device__ __forceinline__ float gelu_tanh(float x) { const float y = 0.7978845608028654f * (x + 0.044715f * x * x * x); const float e = __expf(2.0f * y); return x * (1.0f - __builtin_amdgcn_rcpf(1.0f + e)); }
__device__ __forceinline__ int permk(int kl) { return 8 * ((kl & 15) >> 2) + 4 * (kl >> 4) + (kl & 3); }

struct Params {
    const float *x, *mem, *norm_mix_w, *w_in, *conv_qkv_w, *gdn_a_log, *gdn_dt_bias, *gdn_norm_w, *lru_conv_w, *lru_conv_b, *lru_wa, *lru_ba, *lru_wx, *lru_bx, *lru_lambda, *w_out,
                *norm_xattn_w, *norm_mem_w, *xattn_wq, *xattn_wkv, *xattn_wo, *norm_ffn_w, *peer_wq, *peer_subkeys, *peer_u, *peer_v, *norm_final_w;
    float* out; unsigned char* ws; int ph_lo, ph_hi;
};
#define XB_TMO      128
#define XB_XCNT(j)  (256  + 64 * (j))
#define XB_XSUB(j)  (1280 + 64 * (j))
#define XB_XGEN(j)  (2304 + 64 * (j))
#define XB_TOP      3328
#define XB_TOPGEN   3392
#define XCD_BAR_WORDS 3456
#define XB_SPIN_CAP (1u << 18)

__device__ __forceinline__ unsigned xb_ld(unsigned* p)              { return __hip_atomic_load(p, __ATOMIC_RELAXED, __HIP_MEMORY_SCOPE_AGENT); }
__device__ __forceinline__ unsigned xb_add(unsigned* p, unsigned v) { return __hip_atomic_fetch_add(p, v, __ATOMIC_RELAXED, __HIP_MEMORY_SCOPE_AGENT); }
__device__ __forceinline__ unsigned xb_xcc_id() { return (unsigned)__builtin_amdgcn_s_getreg((3 << 11) | 20) & 0xFu; }
#define XB_SPIN(cond, bar) do { unsigned _sp = 0; while (cond) { __builtin_amdgcn_s_sleep(1); \
    if ((++_sp & 255u) == 0u) { if (xb_ld(&(bar)[XB_TMO])) break; if (_sp > XB_SPIN_CAP) { atomicAdd(&(bar)[XB_TMO], 1u); break; } } } } while (0)

struct XcdBarrier {
    unsigned* bar; unsigned x;
    volatile LAS unsigned* st;
};

__device__ __forceinline__ XcdBarrier xcd_barrier_post(unsigned* bar, volatile LAS unsigned* st) {
    XcdBarrier b; b.bar = bar; b.x = xb_xcc_id(); b.st = st;
    if (threadIdx.x == 0) (void)xb_add(&bar[XB_XCNT(b.x)], 1u);
    return b;
}
__device__ __forceinline__ void xcd_barrier_complete(unsigned* bar, unsigned x, unsigned& nloc, unsigned& nx) {
    const unsigned G = gridDim.x * gridDim.y * gridDim.z;
    unsigned sum, cnt, mine, sp = 0u;
    for (;;) {
        sum = 0u; cnt = 0u; mine = 0u;
#pragma unroll
        for (unsigned j = 0; j < 16; ++j) { const unsigned c = xb_ld(&bar[XB_XCNT(j)]); sum += c; cnt += (c > 0u) ? 1u : 0u; mine = (j == x) ? c : mine; }
        if (sum == G) break;
        __builtin_amdgcn_s_sleep(1);
        if ((++sp & 255u) == 0u) { if (xb_ld(&bar[XB_TMO])) break; if (sp > XB_SPIN_CAP) { atomicAdd(&bar[XB_TMO], 1u); break; } }
    }
    nloc = mine > 0u ? mine : 1u; nx = cnt > 0u ? cnt : 1u;
}

__device__ __forceinline__ void xcd_barrier(const XcdBarrier& b) {
    asm volatile("s_waitcnt vmcnt(0)" ::: "memory");
    __syncthreads();
    if (threadIdx.x == 0) {
        unsigned* bar = b.bar;
        __builtin_amdgcn_s_waitcnt(0);
        unsigned nloc = b.st[0], nx = b.st[1];
        if (nloc == 0u) { xcd_barrier_complete(bar, b.x, nloc, nx); b.st[0] = nloc; b.st[1] = nx; }
        const unsigned old = xb_add(&bar[XB_XSUB(b.x)], 1u);
        const unsigned gen = old / nloc;
        if (old + 1u == (gen + 1u) * nloc) {
            __builtin_amdgcn_fence(__ATOMIC_RELEASE, "agent");
            asm volatile("s_waitcnt vmcnt(0)" ::: "memory");
            const unsigned og = xb_add(&bar[XB_TOP], 1u);
            const unsigned tg = og / nx;
            if (og + 1u == (tg + 1u) * nx) xb_add(&bar[XB_TOPGEN], 1u);
            else XB_SPIN(xb_ld(&bar[XB_TOPGEN]) == tg, bar);
            __builtin_amdgcn_fence(__ATOMIC_ACQUIRE, "agent");
            xb_add(&bar[XB_XGEN(b.x)], 1u);
            asm volatile("s_waitcnt vmcnt(0)" ::: "memory");
        } else {
            XB_SPIN(xb_ld(&bar[XB_XGEN(b.x)]) == gen, bar);
            __builtin_amdgcn_fence(__ATOMIC_ACQUIRE, "agent");
            asm volatile("s_waitcnt vmcnt(0)" ::: "memory");
        }
    }
    __syncthreads();
}

__device__ __forceinline__ void p0_transpose_item(const float* W, int K, int ldw, int c0, int nblk, bf16* WT, int row_off, const float* ks, LAS float* scr, int item, int lane) {
    const int kb = item / nblk, nb = item % nblk, k0 = 64 * kb, n0 = 32 * nb;
#pragma unroll 8
    for (int i = 0; i < 32; ++i) { const int kk = 2 * i + (lane >> 5); float v = W[(size_t)(k0 + kk) * ldw + c0 + n0 + (lane & 31)]; if (ks) v *= ks[k0 + kk]; scr[kk * 33 + (lane & 31)] = v; }
    LDS_WAIT(); asm volatile("" ::: "memory");
    const int c = lane & 7;
#pragma unroll
    for (int j = 0; j < 4; ++j) { const int n = (lane >> 3) + 8 * j; const LAS float* s = scr + (8 * c) * 33 + n;
        v4u o; o.x = pk2(s[0 * 33], s[1 * 33]); o.y = pk2(s[2 * 33], s[3 * 33]); o.z = pk2(s[4 * 33], s[5 * 33]); o.w = pk2(s[6 * 33], s[7 * 33]);
        *(GAS v4u*)(WT + (size_t)(row_off + n0 + n) * K + k0 + 8 * c) = o; }
    LDS_WAIT(); asm volatile("" ::: "memory");
}

__device__ __forceinline__ void p0_prologue(const Params& P, LAS unsigned char* lds, int tid, int lane, int wave, int vcu, int G) {
    unsigned char* ws = P.ws;
    const int gw = vcu * NWAVES + wave, NGW = G * NWAVES;
    LAS float* wabl = (LAS float*)lds;
    for (int idx = tid; idx < 8192; idx += NWAVES * 64) { const int k = idx >> 3, c = idx & 7, j = k >> 8, l = (k >> 2) & 63, e = k & 3;
        wabl[((((j * 4 + e) * 2 + (c >> 2)) * 64 + l) << 2) + (c & 3)] = P.w_in[(size_t)k * 3080 + 2048 + c]; }
    __syncthreads();
    {
        bf16* XB0 = (bf16*)(ws + WS_XB); float* AB = (float*)(ws + WS_AB);
        f32x4 w4[4];
#pragma unroll
        for (int j = 0; j < 4; ++j) w4[j] = ((const f32x4*)P.norm_mix_w)[64 * j + lane];
        for (int m = gw; m < T; m += NGW) {
            const f32x4* xr = (const f32x4*)(P.x + (size_t)m * D) + lane;
            f32x4 v[4]; float s = 0.f;
#pragma unroll
            for (int j = 0; j < 4; ++j) { v[j] = xr[64 * j]; s += (v[j].x * v[j].x + v[j].y * v[j].y) + (v[j].z * v[j].z + v[j].w * v[j].w); }
            const float rstd = rsqrtf(wave_sum(s) * (1.0f / D) + 1e-6f);
            v2u* o8 = (v2u*)(XB0 + (size_t)m * D) + lane;
            float part[8];
#pragma unroll
            for (int c = 0; c < 8; ++c) part[c] = 0.f;
#pragma unroll
            for (int j = 0; j < 4; ++j) {
                v[j] = v[j] * rstd * w4[j];
                v2u o; o.x = pk2(v[j].x, v[j].y); o.y = pk2(v[j].z, v[j].w); o8[64 * j] = o;
#pragma unroll
                for (int e = 0; e < 4; ++e) {
                    const f32x4 wa = *(const LAS f32x4*)(wabl + ((((j * 4 + e) * 2 + 0) * 64 + lane) << 2));
                    const f32x4 wb = *(const LAS f32x4*)(wabl + ((((j * 4 + e) * 2 + 1) * 64 + lane) << 2));
                    const float hv = v[j][e];
                    part[0] += hv * wa.x; part[1] += hv * wa.y; part[2] += hv * wa.z; part[3] += hv * wa.w;
                    part[4] += hv * wb.x; part[5] += hv * wb.y; part[6] += hv * wb.z; part[7] += hv * wb.w;
                }
            }
#pragma unroll
            for (int c = 0; c < 8; ++c) part[c] = wave_sum(part[c]);
            float o = part[0];
#pragma unroll
            for (int c = 1; c < 8; ++c) o = (lane == c) ? part[c] : o;
            if (lane < 8) AB[(size_t)m * 8 + lane] = o;
        }
    }
    {
        bf16* MEMN = (bf16*)(ws + WS_MEMN);
        for (int m = gw; m < 512; m += NGW) {
            const f32x4* xr = (const f32x4*)(P.mem + (size_t)m * D) + lane;
            f32x4 v[4]; float s = 0.f;
#pragma unroll
            for (int j = 0; j < 4; ++j) { v[j] = xr[64 * j]; s += (v[j].x * v[j].x + v[j].y * v[j].y) + (v[j].z * v[j].z + v[j].w * v[j].w); }
            const float rstd = rsqrtf(wave_sum(s) * (1.0f / D) + 1e-6f);
            v2u* o8 = (v2u*)(MEMN + (size_t)m * D) + lane;
#pragma unroll
            for (int j = 0; j < 4; ++j) { const f32x4 w = ((const f32x4*)P.norm_mem_w)[64 * j + lane]; const f32x4 y = v[j] * rstd * w;
                v2u o; o.x = pk2(y.x, y.y); o.y = pk2(y.z, y.w); o8[64 * j] = o; }
        }
    }
    __syncthreads();
    {
        LAS float* scr = (LAS float*)(lds + wave * 16384);
        constexpr int I_IN1 = 16 * 48, I_IN2 = 16 * 16, I_KV = 16 * 64;
        constexpr int NITEMS = I_IN1 + 3 * I_IN2 + I_KV;
        for (int it = gw; it < NITEMS; it += NGW) {
            int r = it;
            if (r < I_IN1) { p0_transpose_item(P.w_in, 1024, 3080, 0, 48, (bf16*)(ws + WS_WIN), 0, nullptr, scr, r, lane); continue; } r -= I_IN1;
            if (r < I_IN2) { p0_transpose_item(P.w_in, 1024, 3080, 2056, 16, (bf16*)(ws + WS_WIN), 1536, nullptr, scr, r, lane); continue; } r -= I_IN2;
            if (r < I_IN2) { p0_transpose_item(P.w_in, 1024, 3080, 1536, 16, (bf16*)(ws + WS_WIN), 2048, nullptr, scr, r, lane); continue; } r -= I_IN2;
            if (r < I_IN2) { p0_transpose_item(P.w_in, 1024, 3080, 2568, 16, (bf16*)(ws + WS_WIN), 2560, nullptr, scr, r, lane); continue; } r -= I_IN2;
            p0_transpose_item(P.xattn_wkv, 1024, 2048, 0, 64, (bf16*)(ws + WS_WKV), 0, nullptr, scr, r, lane);
        }
    }
    {
        bf16* WT = (bf16*)(ws + WS_LRUWT);
        for (int it = vcu * NWAVES * 64 + tid; it < 8 * 2 * 64 * 8; it += G * NWAVES * 64) {
            const int i8 = it & 7, j = (it >> 3) & 63, m = (it >> 9) & 1, g = it >> 10;
            const float* src = (m ? P.lru_wx : P.lru_wa) + (size_t)(g * 64 + 8 * i8) * 64 + j;
            v4u o; o.x = pk2(src[0], src[64]); o.y = pk2(src[128], src[192]); o.z = pk2(src[256], src[320]); o.w = pk2(src[384], src[448]);
            *(v4u*)(WT + (size_t)it * 8) = o;
        }
    }
}

__device__ __forceinline__ void late_weight_prep(const Params& P, LAS unsigned char* lds, int lane, int wave, int gw, int NGW) {
    unsigned char* ws = P.ws;
    {
        LAS float* scr = (LAS float*)(lds + wave * 16384);
        constexpr int I_OUT = 16 * 32, I_Q = 16 * 32, I_O = 16 * 32;
        for (int it = gw; it < I_OUT + I_Q + I_O; it += NGW) {
            int r = it;
            if (r < I_OUT) { p0_transpose_item(P.w_out, 1024, 1024, 0, 32, (bf16*)(ws + WS_WOUT), 0, nullptr, scr, r, lane); continue; } r -= I_OUT;
            if (r < I_Q) { p0_transpose_item(P.xattn_wq, 1024, 1024, 0, 32, (bf16*)(ws + WS_WQ), 0, P.norm_xattn_w, scr, r, lane); continue; } r -= I_Q;
            p0_transpose_item(P.xattn_wo, 1024, 1024, 0, 32, (bf16*)(ws + WS_WO), 0, nullptr, scr, r, lane);
        }
    }
    {
        bf16* WF = (bf16*)(ws + WS_PWQ);
        const int col = lane & 15, g = lane >> 4;
        for (int it = gw; it < 16 * 64; it += NGW) {
            const int hp = it >> 6, k0 = (it & 63) * 16;
            bf16x8 bq[4];
#pragma unroll
            for (int s = 0; s < 4; ++s) { const f32x4* src = (const f32x4*)(P.peer_wq + (size_t)(k0 + col) * 2048 + hp * 128 + 32 * s + 8 * g);
                const f32x4 a = src[0], c = src[1]; v4u pk; pk.x = pk2(a.x, a.y); pk.y = pk2(a.z, a.w); pk.z = pk2(c.x, c.y); pk.w = pk2(c.z, c.w); bq[s] = __builtin_bit_cast(bf16x8, pk); }
            const float nw = P.norm_ffn_w[k0 + col];
#pragma unroll 2
            for (int kt = 0; kt < 8; ++kt) {
                f32x4 acc = (f32x4){0.f, 0.f, 0.f, 0.f};
#pragma unroll
                for (int s = 0; s < 4; ++s) { const f32x4* src = (const f32x4*)(P.peer_subkeys + (size_t)(hp * 128 + 16 * kt + col) * 128 + 32 * s + 8 * g);
                    const f32x4 a = src[0], c = src[1]; v4u pk; pk.x = pk2(a.x, a.y); pk.y = pk2(a.z, a.w); pk.z = pk2(c.x, c.y); pk.w = pk2(c.z, c.w);
                    acc = __builtin_amdgcn_mfma_f32_16x16x32_bf16(__builtin_bit_cast(bf16x8, pk), bq[s], acc, 0, 0, 0); }
#pragma unroll
                for (int i = 0; i < 4; ++i) WF[(size_t)(hp * 128 + 16 * kt + 4 * g + i) * 1024 + k0 + col] = (bf16)f2bf(acc[i] * nw);
            }
        }
    }
}

constexpr int GL_KS = 0, GL_VS = 33792, GL_KB = 67584, GL_QB = 84992, GL_RAW = 102400, GL_CW = 153856, GL_AMT = 133120, GL_SM = 160000, GL_ATT = 151808, GL_SOL = 67584;
static_assert(GL_CW + 6144 <= GL_SM && GL_SM + 1284 <= MISC_OFF && GL_SOL + 65536 <= GL_AMT && GL_AMT + 17408 <= GL_ATT && GL_ATT + 8192 <= GL_SM && GL_RAW + 51456 <= GL_CW, "gdn_local LDS map");
#ifndef GL_REP_STEP
#define GL_REP_STEP -1
#endif
#define GL_REPF(k) for (int rr_ = 0; rr_ < ((GL_REP_STEP == (k)) ? 2 : 1); ++rr_)
#define GL_BAR() do { asm volatile("s_waitcnt lgkmcnt(0)" ::: "memory"); __builtin_amdgcn_s_barrier(); asm volatile("" ::: "memory"); } while (0)
__device__ __forceinline__ void gdn_local_item(const Params& P, LAS unsigned char* lds, int item, int tid) {
    unsigned char* ws = P.ws;
    asm volatile("" : "+v"(tid));
    const int b = item >> 9, h = (item >> 7) & 3, n = item & 127;
    const int t0 = b * SEQ + n * 64;
    const int lane = tid & 63, wave = __builtin_amdgcn_readfirstlane(tid >> 6);
    LAS float* ks = (LAS float*)(lds + GL_KS);
    LAS float* vs = (LAS float*)(lds + GL_VS);
    LAS bf16* kb16 = (LAS bf16*)(lds + GL_KB);
    LAS bf16* qb16 = (LAS bf16*)(lds + GL_QB);
    LAS bf16* raw = (LAS bf16*)(lds + GL_RAW);
    LAS float* cw = (LAS float*)(lds + GL_CW);
    LAS float* AmT = (LAS float*)(lds + GL_AMT);
    LAS float* sg = (LAS float*)(lds + GL_SM);
    LAS float* sbeta = sg + 64; LAS float* sgc = sbeta + 64; LAS float* seg = sgc + 64; LAS float* sek = seg + 64;
    LAS bf16* atts = (LAS bf16*)(lds + GL_ATT);
    const bf16* QKV = (const bf16*)(ws + WS_QKV);
    const float* AB = (const float*)(ws + WS_AB);
    GL_REPF(0) {
        v4u pr[7];
#pragma unroll
        for (int r = 0; r < 7; ++r) {
            const int id = tid + 512 * r;
            const int row = id / 48, rem = id - row * 48, part = rem >> 4, ck = rem & 15, s = n * 64 + row - 3;
            pr[r] = (v4u){0u, 0u, 0u, 0u};
            if (id < 67 * 48 && s >= 0) pr[r] = *(const v4u*)(QKV + (size_t)(b * SEQ + s) * 1536 + part * 512 + h * 128 + ck * 8);
        }
        f32x4 cwv = (f32x4){0.f, 0.f, 0.f, 0.f};
        if (tid < 384) { const int j = tid / 96, rem = tid - j * 96, part = rem >> 5, c4 = rem & 31; cwv = *(const f32x4*)(P.conv_qkv_w + j * 1536 + part * 512 + h * 128 + c4 * 4); }
        float a_in = 0.f, b_in = 0.f;
        if (tid < 64) { a_in = AB[(size_t)(t0 + tid) * 8 + h]; b_in = AB[(size_t)(t0 + tid) * 8 + 4 + h]; }
#pragma unroll
        for (int r = 0; r < 7; ++r) { const int id = tid + 512 * r; if (id < 67 * 48) *(LAS v4u*)(raw + id * 8) = pr[r]; }
        if (tid < 384) *(LAS f32x4*)(cw + tid * 4) = cwv;
        if (tid < 64) { sg[tid] = -__expf(P.gdn_a_log[h]) * softplusf_(a_in + P.gdn_dt_bias[h]); sbeta[tid] = sigmoidf_(b_in); }
    }
    GL_BAR();
    GL_REPF(1) {
        const int c = tid >> 3, grp = tid & 7;
#pragma unroll 1
        for (int part = 0; part < 3; ++part) {
            float y[16];
#pragma unroll
            for (int i = 0; i < 16; ++i) y[i] = 0.f;
#pragma unroll
            for (int j = 0; j < 4; ++j) {
                const LAS v4u* src = (const LAS v4u*)(raw + (c + j) * 384 + part * 128 + grp * 16);
                const v4u x0 = src[0], x1 = src[1];
                const LAS f32x4* wp = (const LAS f32x4*)(cw + (j * 3 + part) * 128 + grp * 16);
                const f32x4 w0 = wp[0], w1 = wp[1], w2 = wp[2], w3 = wp[3];
                y[0] += w0.x * bflo(x0.x); y[1] += w0.y * bfhi(x0.x); y[2] += w0.z * bflo(x0.y); y[3] += w0.w * bfhi(x0.y);
                y[4] += w1.x * bflo(x0.z); y[5] += w1.y * bfhi(x0.z); y[6] += w1.z * bflo(x0.w); y[7] += w1.w * bfhi(x0.w);
                y[8] += w2.x * bflo(x1.x); y[9] += w2.y * bfhi(x1.x); y[10] += w2.z * bflo(x1.y); y[11] += w2.w * bfhi(x1.y);
                y[12] += w3.x * bflo(x1.z); y[13] += w3.y * bfhi(x1.z); y[14] += w3.z * bflo(x1.w); y[15] += w3.w * bfhi(x1.w);
            }
            float ss = 0.f;
#pragma unroll
            for (int i = 0; i < 16; ++i) { y[i] = siluf_(y[i]); ss += y[i] * y[i]; }
            if (part < 2) {
                ss += __shfl_xor(ss, 1); ss += __shfl_xor(ss, 2); ss += __shfl_xor(ss, 4);
                const float sc = rsqrtf(ss + 1e-6f) * (part == 0 ? 0.08838834764831845f : 1.0f);
#pragma unroll
                for (int i = 0; i < 16; ++i) y[i] *= sc;
            }
            if (part >= 1) {
                LAS float* dst = (part == 1 ? ks : vs) + c * 132 + grp * 16;
#pragma unroll
                for (int i = 0; i < 4; ++i) *(LAS f32x4*)(dst + 4 * i) = (f32x4){y[4 * i], y[4 * i + 1], y[4 * i + 2], y[4 * i + 3]};
            }
            if (part <= 1) {
                LAS bf16* dst = (part == 0 ? qb16 : kb16) + c * 136 + grp * 16;
                v4u o0, o1; o0.x = pk2(y[0], y[1]); o0.y = pk2(y[2], y[3]); o0.z = pk2(y[4], y[5]); o0.w = pk2(y[6], y[7]);
                o1.x = pk2(y[8], y[9]); o1.y = pk2(y[10], y[11]); o1.z = pk2(y[12], y[13]); o1.w = pk2(y[14], y[15]);
                *(LAS v4u*)dst = o0; *(LAS v4u*)(dst + 8) = o1;
            }
        }
    }
    if (tid < 64) {
        float v = sg[tid];
#pragma unroll
        for (int off = 1; off < 64; off <<= 1) { const float t = __shfl_up(v, off); if (tid >= off) v += t; }
        sgc[tid] = v; seg[tid] = __expf(v);
        const float gl = __shfl(v, 63);
        sek[tid] = __expf(gl - v);
        if (tid == 63) sek[64] = __expf(v);
    }
    GL_BAR();
    {
        const int mat = wave >> 2, rho = wave & 3, col = lane & 15, g = lane >> 4;
        const LAS bf16* X = mat ? qb16 : kb16;
        bf16x8 af[4];
#pragma unroll
        for (int s = 0; s < 4; ++s) af[s] = *(const LAS bf16x8*)(X + (16 * rho + col) * 136 + 32 * s + 8 * g);
#pragma unroll
        for (int sig = 0; sig < 4; ++sig) {
            f32x4 acc = (f32x4){0.f, 0.f, 0.f, 0.f};
#pragma unroll
            for (int s = 0; s < 4; ++s) { const bf16x8 bfr = *(const LAS bf16x8*)(kb16 + (16 * sig + col) * 136 + 32 * s + 8 * g); acc = __builtin_amdgcn_mfma_f32_16x16x32_bf16(af[s], bfr, acc, 0, 0, 0); }
            const int sidx = 16 * sig + col; const float gs = sgc[sidx];
#pragma unroll
            for (int i = 0; i < 4; ++i) {
                const int c = 16 * rho + 4 * g + i;
                const float dec = (c >= sidx) ? __expf(sgc[c] - gs) : 0.f;
                if (mat == 0) AmT[sidx * 68 + c] = (c > sidx) ? sbeta[c] * acc[i] * dec : 0.f;
                else atts[c * 64 + sidx] = (bf16)f2bf(acc[i] * dec);
            }
        }
    }
    GL_BAR();
    GL_REPF(4) {
        bf16* QD = (bf16*)(ws + WS_QD) + (size_t)item * 8192;
        bf16* KD = (bf16*)(ws + WS_KD) + (size_t)item * 8192;
        bf16* ATT = (bf16*)(ws + WS_ATT) + (size_t)item * 4096;
#pragma unroll
        for (int r = 0; r < 2; ++r) {
            const int id = tid + 512 * r;
            { const int c = id >> 4, gam = id & 15, s32 = gam >> 2, g = gam & 3;
              const v2u lo = *(const LAS v2u*)(qb16 + c * 136 + 32 * s32 + 4 * g), hi = *(const LAS v2u*)(qb16 + c * 136 + 32 * s32 + 16 + 4 * g);
              const float e = seg[c];
              v4u o; o.x = pk2(bflo(lo.x) * e, bfhi(lo.x) * e); o.y = pk2(bflo(lo.y) * e, bfhi(lo.y) * e); o.z = pk2(bflo(hi.x) * e, bfhi(hi.x) * e); o.w = pk2(bflo(hi.y) * e, bfhi(hi.y) * e);
              st16_wt(QD + c * 128 + 8 * gam, o); }
            { const int dk = id >> 3, gam = id & 7, s32 = gam >> 2, g = gam & 3, c0 = 32 * s32 + 4 * g;
              float v[8];
#pragma unroll
              for (int j = 0; j < 4; ++j) { v[j] = ks[(c0 + j) * 132 + dk] * sek[c0 + j]; v[4 + j] = ks[(c0 + 16 + j) * 132 + dk] * sek[c0 + 16 + j]; }
              v4u o; o.x = pk2(v[0], v[1]); o.y = pk2(v[2], v[3]); o.z = pk2(v[4], v[5]); o.w = pk2(v[6], v[7]);
              st16_wt(KD + dk * 64 + 8 * gam, o); }
        }
        { const int c = tid >> 3, gam = tid & 7, s32 = gam >> 2, g = gam & 3;
          const v2u lo = *(const LAS v2u*)(atts + c * 64 + 32 * s32 + 4 * g), hi = *(const LAS v2u*)(atts + c * 64 + 32 * s32 + 16 + 4 * g);
          v4u o; o.x = lo.x; o.y = lo.y; o.z = hi.x; o.w = hi.y;
          st16_wt(ATT + c * 64 + 8 * gam, o); }
    }
    GL_BAR();
    GL_REPF(5) {
        LAS float* xcol = (LAS float*)(lds + GL_SOL);
        LAS bf16* tinv = (LAS bf16*)(lds + GL_SOL + 17408);
        const int j = tid >> 3, part = tid & 7, jb = j >> 4, jo = j & 15;
#pragma unroll 1
        for (int rb = jb; rb < 4; ++rb) {
            float acc[16];
#pragma unroll
            for (int i = 0; i < 16; ++i) acc[i] = 0.f;
            if (rb > jb) {
#pragma unroll 2
                for (int s = 16 * jb + part; s < 16 * rb; s += 8) {
                    const float sv = xcol[j * 68 + s];
                    const LAS float* ar = AmT + s * 68 + 16 * rb;
#pragma unroll
                    for (int q = 0; q < 4; ++q) { const f32x4 A4 = *(const LAS f32x4*)(ar + 4 * q);
                        acc[4 * q] -= A4.x * sv; acc[4 * q + 1] -= A4.y * sv; acc[4 * q + 2] -= A4.z * sv; acc[4 * q + 3] -= A4.w * sv; }
                }
#pragma unroll
                for (int i = 0; i < 16; ++i) {
                    acc[i] += __builtin_bit_cast(float, __builtin_amdgcn_update_dpp(0, __builtin_bit_cast(int, acc[i]), 0xB1, 0xF, 0xF, true));
                    acc[i] += __builtin_bit_cast(float, __builtin_amdgcn_update_dpp(0, __builtin_bit_cast(int, acc[i]), 0x4E, 0xF, 0xF, true));
                    acc[i] += __builtin_bit_cast(float, __builtin_amdgcn_update_dpp(0, __builtin_bit_cast(int, acc[i]), 0x141, 0xF, 0xF, true));
                }
            } else {
#pragma unroll
                for (int i = 0; i < 16; ++i) acc[i] = (i == jo) ? 1.f : 0.f;
            }
#pragma unroll
            for (int i = 0; i < 16; ++i) {
                const float sv = acc[i];
                const LAS float* ar = AmT + (16 * rb + i) * 68 + 16 * rb;
#pragma unroll
                for (int q = (i + 1) / 4; q < 4; ++q) { const f32x4 A4 = *(const LAS f32x4*)(ar + 4 * q);
                    if (4 * q > i) acc[4 * q] -= A4.x * sv; if (4 * q + 1 > i) acc[4 * q + 1] -= A4.y * sv; if (4 * q + 2 > i) acc[4 * q + 2] -= A4.z * sv; if (4 * q + 3 > i) acc[4 * q + 3] -= A4.w * sv; }
            }
            if (part == 0) {
#pragma unroll
                for (int i = 0; i < 16; ++i) { xcol[j * 68 + 16 * rb + i] = acc[i]; tinv[(16 * rb + i) * 72 + j] = (bf16)f2bf(acc[i]); }
            }
            LDS_WAIT(); asm volatile("" ::: "memory");
        }
        for (int rb = 0; rb < jb; ++rb) {
            if (part == 0) {
#pragma unroll
                for (int i = 0; i < 16; ++i) tinv[(16 * rb + i) * 72 + j] = (bf16)0;
            }
        }
    }
    GL_BAR();
    GL_REPF(6) {
        const LAS bf16* tinv = (const LAS bf16*)(lds + GL_SOL + 17408);
        LAS bf16* wst = (LAS bf16*)(lds + GL_SOL + 17408 + 9216);
        const int col = lane & 15, g = lane >> 4, isw = wave >> 2;
        bf16x8 af[4][2];
#pragma unroll
        for (int rho = 0; rho < 4; ++rho)
#pragma unroll
            for (int s2 = 0; s2 < 2; ++s2) af[rho][s2] = *(const LAS bf16x8*)(tinv + (16 * rho + col) * 72 + 32 * s2 + 8 * g);
        bf16* UF = (bf16*)(ws + WS_UF) + (size_t)item * 8192;
#pragma unroll
        for (int sig = 0; sig < 2; ++sig) {
            const int jj = 32 * (wave & 3) + 16 * sig + col;
            const LAS float* src = (isw ? ks : vs) + jj;
            bf16x8 bfr[2];
#pragma unroll
            for (int s2 = 0; s2 < 2; ++s2) {
                float v[8];
#pragma unroll
                for (int e = 0; e < 8; ++e) { const int sidx = 32 * s2 + 8 * g + e; float x = src[sidx * 132] * sbeta[sidx]; if (isw) x *= seg[sidx]; v[e] = x; }
                v4u pk; pk.x = pk2(v[0], v[1]); pk.y = pk2(v[2], v[3]); pk.z = pk2(v[4], v[5]); pk.w = pk2(v[6], v[7]);
                bfr[s2] = __builtin_bit_cast(bf16x8, pk);
            }
            f32x4 acc[4];
#pragma unroll
            for (int rho = 0; rho < 4; ++rho) { acc[rho] = (f32x4){0.f, 0.f, 0.f, 0.f};
#pragma unroll
                for (int s2 = 0; s2 < 2; ++s2) acc[rho] = __builtin_amdgcn_mfma_f32_16x16x32_bf16(af[rho][s2], bfr[s2], acc[rho], 0, 0, 0); }
            if (!isw) {
                v4u o0, o1;
                o0.x = pk2(acc[0].x, acc[0].y); o0.y = pk2(acc[0].z, acc[0].w); o0.z = pk2(acc[1].x, acc[1].y); o0.w = pk2(acc[1].z, acc[1].w);
                o1.x = pk2(acc[2].x, acc[2].y); o1.y = pk2(acc[2].z, acc[2].w); o1.z = pk2(acc[3].x, acc[3].y); o1.w = pk2(acc[3].z, acc[3].w);
                v4u* d = (v4u*)(UF + (size_t)(2 * (wave & 3) + sig) * 1024 + lane * 16);
                st16_wt(d, o0); st16_wt(d + 1, o1);
            } else {
#pragma unroll
                for (int rho = 0; rho < 4; ++rho)
#pragma unroll
                    for (int i = 0; i < 4; ++i) wst[(16 * rho + 4 * g + i) * 136 + jj] = (bf16)f2bf(-acc[rho][i]);
            }
        }
    }
    GL_BAR();
    {
        const LAS bf16* wst = (const LAS bf16*)(lds + GL_SOL + 17408 + 9216);
        bf16* WN = (bf16*)(ws + WS_WN) + (size_t)item * 8192;
#pragma unroll
        for (int r = 0; r < 2; ++r) {
            const int id = tid + 512 * r, c = id >> 4, gam = id & 15, s32 = gam >> 2, g = gam & 3;
            const v2u lo = *(const LAS v2u*)(wst + c * 136 + 32 * s32 + 4 * g), hi = *(const LAS v2u*)(wst + c * 136 + 32 * s32 + 16 + 4 * g);
            v4u o; o.x = lo.x; o.y = lo.y; o.z = hi.x; o.w = hi.y;
            st16_wt(WN + c * 128 + 8 * gam, o);
        }
    }
    asm volatile("s_waitcnt vmcnt(0)" ::: "memory");
    GL_BAR();
    if (tid == 0) { unsigned fb = __builtin_bit_cast(unsigned, sek[64]); if (fb == 0u) fb = 1u;
        __hip_atomic_store((unsigned*)(ws + WS_CTL) + CW_GFLAG + item, fb, __ATOMIC_RELAXED, __HIP_MEMORY_SCOPE_AGENT); }
    GL_BAR();
}

constexpr int LL_XCB = 68608;
static_assert(LL_XCB + 64 * 1040 <= MISC_OFF, "lru_local LDS map");
__device__ __forceinline__ float expm1_small(float x) {
    const float p = x * (1.0f + x * (0.5f + x * (0.16666667f + x * (0.041666668f + x * 0.008333334f))));
    return (x > -0.25f) ? p : (__expf(x) - 1.0f);
}
__device__ __forceinline__ void lru_local_item(const Params& P, LAS unsigned char* lds, int lt, int tid, int lane, int wave) {
    unsigned char* ws = P.ws;
    asm volatile("" : "+v"(tid));
    const int b = lt >> 7, n = lt & 127, t0 = b * SEQ + n * 64;
    LAS bf16* rawx = (LAS bf16*)lds;
    LAS bf16* xcb = (LAS bf16*)(lds + LL_XCB);
    const bf16* XR = (const bf16*)(ws + WS_XR);
    {
        v4u pr[9];
#pragma unroll
        for (int r = 0; r < 9; ++r) { const int id = tid + 512 * r, row = id >> 6, ck = id & 63, s = n * 64 + row - 3;
            pr[r] = (v4u){0u, 0u, 0u, 0u};
            if (id < 67 * 64 && s >= 0) pr[r] = *(const v4u*)(XR + (size_t)(b * SEQ + s) * 512 + ck * 8); }
#pragma unroll
        for (int r = 0; r < 9; ++r) { const int id = tid + 512 * r; if (id < 67 * 64) *(LAS v4u*)(rawx + id * 8) = pr[r]; }
    }
    GL_BAR();
    {
        const int chg = tid & 63, tseg = tid >> 6, ch0 = chg * 8;
        float w[4][8], cb[8];
#pragma unroll
        for (int j = 0; j < 4; ++j) { const f32x4 a = *(const f32x4*)(P.lru_conv_w + j * 512 + ch0), c = *(const f32x4*)(P.lru_conv_w + j * 512 + ch0 + 4);
            w[j][0] = a.x; w[j][1] = a.y; w[j][2] = a.z; w[j][3] = a.w; w[j][4] = c.x; w[j][5] = c.y; w[j][6] = c.z; w[j][7] = c.w; }
        { const f32x4 a = *(const f32x4*)(P.lru_conv_b + ch0), c = *(const f32x4*)(P.lru_conv_b + ch0 + 4);
          cb[0] = a.x; cb[1] = a.y; cb[2] = a.z; cb[3] = a.w; cb[4] = c.x; cb[5] = c.y; cb[6] = c.z; cb[7] = c.w; }
        v4u xr[11];
#pragma unroll
        for (int r = 0; r < 11; ++r) xr[r] = *(const LAS v4u*)(rawx + (tseg * 8 + r) * 512 + ch0);
#pragma unroll
        for (int tk = 0; tk < 8; ++tk) {
            float y[8];
#pragma unroll
            for (int e = 0; e < 8; ++e) y[e] = cb[e];
#pragma unroll
            for (int j = 0; j < 4; ++j) { const v4u x = xr[tk + j];
                y[0] += w[j][0] * bflo(x.x); y[1] += w[j][1] * bfhi(x.x); y[2] += w[j][2] * bflo(x.y); y[3] += w[j][3] * bfhi(x.y);
                y[4] += w[j][4] * bflo(x.z); y[5] += w[j][5] * bfhi(x.z); y[6] += w[j][6] * bflo(x.w); y[7] += w[j][7] * bfhi(x.w); }
            v4u o; o.x = pk2(y[0], y[1]); o.y = pk2(y[2], y[3]); o.z = pk2(y[4], y[5]); o.w = pk2(y[6], y[7]);
            *(LAS v4u*)(xcb + (tseg * 8 + tk) * 520 + ch0) = o;
        }
    }
    GL_BAR();
    {
        const int g = wave, col = lane & 15, g4 = lane >> 4;
        LAS bf16* AM = (LAS bf16*)(lds + wave * 8192); LAS bf16* BT = AM + 2048;
        const bf16* WT = (const bf16*)(ws + WS_LRUWT) + (size_t)g * 8192;
        bf16x8 Bw[2][4][2];
#pragma unroll
        for (int m = 0; m < 2; ++m)
#pragma unroll
            for (int jt = 0; jt < 4; ++jt)
#pragma unroll
                for (int s2 = 0; s2 < 2; ++s2) Bw[m][jt][s2] = *(const bf16x8*)(WT + m * 4096 + (16 * jt + col) * 64 + 32 * s2 + 8 * g4);
        float cba[4], cbx[4], csp[4];
#pragma unroll
        for (int jt = 0; jt < 4; ++jt) { const int ch = g * 64 + 16 * jt + col; cba[jt] = P.lru_ba[ch]; cbx[jt] = P.lru_bx[ch]; csp[jt] = softplusf_(-P.lru_lambda[ch]); }
        bf16* HLOC = (bf16*)(ws + WS_HLOC); bf16* PCUM = (bf16*)(ws + WS_PCUM);
        const int chs = g * 64 + lane;
        float hst = 0.f, pc = 1.f;
#pragma unroll 1
        for (int half = 0; half < 2; ++half) {
            bf16x8 Af[2][2];
#pragma unroll
            for (int rho = 0; rho < 2; ++rho)
#pragma unroll
                for (int s2 = 0; s2 < 2; ++s2) Af[rho][s2] = *(const LAS bf16x8*)(xcb + (32 * half + 16 * rho + col) * 520 + g * 64 + 32 * s2 + 8 * g4);
#pragma unroll
            for (int jt = 0; jt < 4; ++jt) {
#pragma unroll
                for (int rho = 0; rho < 2; ++rho) {
                    f32x4 ra = (f32x4){0.f, 0.f, 0.f, 0.f}, rx = ra;
#pragma unroll
                    for (int s2 = 0; s2 < 2; ++s2) { ra = __builtin_amdgcn_mfma_f32_16x16x32_bf16(Af[rho][s2], Bw[0][jt][s2], ra, 0, 0, 0); rx = __builtin_amdgcn_mfma_f32_16x16x32_bf16(Af[rho][s2], Bw[1][jt][s2], rx, 0, 0, 0); }
#pragma unroll
                    for (int i = 0; i < 4; ++i) {
                        const int tokl = 16 * rho + 4 * g4 + i, chl = 16 * jt + col;
                        const float r = sigmoidf_(ra[i] + cba[jt]), ig = sigmoidf_(rx[i] + cbx[jt]);
                        const float log_a = -8.0f * r * csp[jt];
                        const float am = -expm1_small(log_a), a = 1.0f - am;
                        const float xo = bf1(xcb[(32 * half + tokl) * 520 + g * 64 + chl]);
                        const float bt = __builtin_amdgcn_sqrtf(fmaxf(am * (1.0f + a), 0.f)) * (ig * xo);
                        AM[tokl * 64 + chl] = (bf16)f2bf(am); BT[tokl * 64 + chl] = (bf16)f2bf(bt);
                    }
                }
            }
            LDS_WAIT(); asm volatile("" ::: "memory");
#pragma unroll 8
            for (int tk = 0; tk < 32; ++tk) {
                const float am = bf1(AM[tk * 64 + lane]), bt = bf1(BT[tk * 64 + lane]);
                hst = (hst - am * hst) + bt; pc = pc - am * pc;
                const size_t o = (size_t)(t0 + 32 * half + tk) * 512 + chs;
                HLOC[o] = (bf16)f2bf(hst); PCUM[o] = (bf16)f2bf(pc);
            }
            LDS_WAIT(); asm volatile("" ::: "memory");
        }
        ((float*)(ws + WS_HEND))[(size_t)lt * 512 + chs] = hst; ((float*)(ws + WS_PEND))[(size_t)lt * 512 + chs] = pc;
    }
    GL_BAR();
}

constexpr int SC_WN = 0, SC_QD = 64 * 272, SC_KD = 2 * 64 * 272, SC_ATT = 2 * 64 * 272 + 128 * 144, SC_BUF = 2 * 64 * 272 + 128 * 144 + 64 * 144;
constexpr int SC_SSQ = 2 * SC_BUF;
__device__ __forceinline__ int sc_lds_off(int id) {
    if (id < 1024) return SC_WN + (id >> 4) * 272 + (id & 15) * 16;
    if (id < 2048) { const int q = id - 1024; return SC_QD + (q >> 4) * 272 + (q & 15) * 16; }
    if (id < 3072) { const int q = id - 2048; return SC_KD + (q >> 3) * 144 + (q & 7) * 16; }
    const int q = id - 3072; return SC_ATT + (q >> 3) * 144 + (q & 7) * 16;
}
__device__ __forceinline__ const v4u* sc_src(const unsigned char* ws, int item, int id) {
    if (id < 1024) return (const v4u*)(ws + WS_WN + (size_t)item * 16384) + id;
    if (id < 2048) return (const v4u*)(ws + WS_QD + (size_t)item * 16384) + (id - 1024);
    if (id < 3072) return (const v4u*)(ws + WS_KD + (size_t)item * 16384) + (id - 2048);
    return (const v4u*)(ws + WS_ATT + (size_t)item * 8192) + (id - 3072);
}
__device__ __forceinline__ bf16x8 pack_b(const f32x4 a, const f32x4 b) {
    v4u r; r.x = pk2(a.x, a.y); r.y = pk2(a.z, a.w); r.z = pk2(b.x, b.y); r.w = pk2(b.z, b.w);
    return __builtin_bit_cast(bf16x8, r);
}
#define SC_BAR() do { asm volatile("s_waitcnt lgkmcnt(0)" ::: "memory"); __builtin_amdgcn_s_barrier(); asm volatile("" ::: "memory"); } while (0)
#define SC_GLD(dst, ptr) asm volatile("global_load_dwordx4 %0, %1, off" : "=v"(dst) : "v"(ptr) : "memory")
#define PIN8(a) asm volatile("" : "+v"(a[0]), "+v"(a[1]), "+v"(a[2]), "+v"(a[3]), "+v"(a[4]), "+v"(a[5]), "+v"(a[6]), "+v"(a[7]))
#define PIN16(a) asm volatile("" : "+v"(a[0]), "+v"(a[1]), "+v"(a[2]), "+v"(a[3]), "+v"(a[4]), "+v"(a[5]), "+v"(a[6]), "+v"(a[7]), "+v"(a[8]), "+v"(a[9]), "+v"(a[10]), "+v"(a[11]), "+v"(a[12]), "+v"(a[13]), "+v"(a[14]), "+v"(a[15]))
constexpr int SCAN_NWC = 2, SCAN_PARTS = 4, SCAN_WGS = 8 * SCAN_PARTS;
constexpr int SC_UFS = 2 * SC_BUF;
constexpr int SC_DECS = SC_UFS + 2 * SCAN_NWC * 2048;
constexpr int SC_OT = SC_DECS + 512;
constexpr int SC_RDY = SC_OT + 2 * 64 * 36 * 4;
constexpr int SC_END = SC_RDY + 64;
static_assert(SC_END <= MISC_OFF, "scan LDS");
#ifndef SCAN_REPS
#define SCAN_REPS 1
#endif
#ifndef SCAN_EXP
#define SCAN_EXP 0
#endif
__device__ __forceinline__ int sc3_lds_off(int id) {
    if (id < 3584) return sc_lds_off(id);
    return SC_UFS + (id - 3584) * 16;
}
__device__ __forceinline__ const v4u* sc3_src(const unsigned char* ws, int item, int id, int part) {
    if (id < 3584) return sc_src(ws, item, id);
    return (const v4u*)(ws + WS_UF + (size_t)item * 16384 + (size_t)(part * SCAN_NWC) * 2048) + (id - 3584);
}
__device__ __forceinline__ void gdn_scan(const Params& P, LAS unsigned char* lds, int sb, int tid, int lane, int wave) {
    const unsigned char* ws = P.ws;
    constexpr int NCH = 128 * SCAN_REPS, NPC = 15;
    const int bh = sb & 7, part = sb >> 3;
    const int b = bh >> 2, h = bh & 3, col = lane & 15, g = lane >> 4;
    const int item0 = bh * 128;
    if (tid == 0) *(volatile LAS unsigned*)(lds + SC_RDY) = 0u;
    SC_BAR();
    if (wave >= 4) {
        constexpr int NP = 15, DEP = 3;
        const int lt = tid - 256;
        const unsigned voff = (unsigned)lt * 16u;
        const int lA = (lt >> 4) * 272 + (lt & 15) * 16, lB = (lt >> 3) * 144 + (lt & 7) * 16, lU = SC_UFS + lt * 16;
        v4u rs[DEP][NP];
#define SC_ISSUE(set, itm) do { const unsigned char* gq_ = ws + (size_t)(itm) * 16384; const unsigned char* ga_ = ws + WS_ATT + (size_t)(itm) * 8192; \
            asm volatile("s_nop 4\n\tglobal_load_dwordx4 %0, %8, %9 sc0 sc1\n\tglobal_load_dwordx4 %1, %8, %10 sc0 sc1\n\tglobal_load_dwordx4 %2, %8, %11 sc0 sc1\n\tglobal_load_dwordx4 %3, %8, %12 sc0 sc1\n\t" \
                         "global_load_dwordx4 %4, %8, %13 sc0 sc1\n\tglobal_load_dwordx4 %5, %8, %14 sc0 sc1\n\tglobal_load_dwordx4 %6, %8, %15 sc0 sc1\n\tglobal_load_dwordx4 %7, %8, %16 sc0 sc1" \
                : "=&v"(rs[set][0]), "=&v"(rs[set][1]), "=&v"(rs[set][2]), "=&v"(rs[set][3]), "=&v"(rs[set][4]), "=&v"(rs[set][5]), "=&v"(rs[set][6]), "=&v"(rs[set][7]) \
                : "v"(voff), "s"(gq_ + WS_WN), "s"(gq_ + WS_WN + 4096), "s"(gq_ + WS_WN + 8192), "s"(gq_ + WS_WN + 12288), \
                  "s"(gq_ + WS_QD), "s"(gq_ + WS_QD + 4096), "s"(gq_ + WS_QD + 8192), "s"(gq_ + WS_QD + 12288) : "memory"); \
            asm volatile("s_nop 4\n\tglobal_load_dwordx4 %0, %7, %8 sc0 sc1\n\tglobal_load_dwordx4 %1, %7, %9 sc0 sc1\n\tglobal_load_dwordx4 %2, %7, %10 sc0 sc1\n\tglobal_load_dwordx4 %3, %7, %11 sc0 sc1\n\t" \
                         "global_load_dwordx4 %4, %7, %12 sc0 sc1\n\tglobal_load_dwordx4 %5, %7, %13 sc0 sc1\n\tglobal_load_dwordx4 %6, %7, %14 sc0 sc1" \
                : "=&v"(rs[set][8]), "=&v"(rs[set][9]), "=&v"(rs[set][10]), "=&v"(rs[set][11]), "=&v"(rs[set][12]), "=&v"(rs[set][13]), "=&v"(rs[set][14]) \
                : "v"(voff), "s"(gq_ + WS_KD), "s"(gq_ + WS_KD + 4096), "s"(gq_ + WS_KD + 8192), "s"(gq_ + WS_KD + 12288), \
                  "s"(ga_), "s"(ga_ + 4096), "s"(gq_ + WS_UF + (size_t)(part * SCAN_NWC) * 2048) : "memory"); } while (0)
#define SC_WAITSET(set, cnt) asm volatile("s_waitcnt " cnt : "+v"(rs[set][0]), "+v"(rs[set][1]), "+v"(rs[set][2]), "+v"(rs[set][3]), "+v"(rs[set][4]), "+v"(rs[set][5]), "+v"(rs[set][6]), "+v"(rs[set][7]), \
            "+v"(rs[set][8]), "+v"(rs[set][9]), "+v"(rs[set][10]), "+v"(rs[set][11]), "+v"(rs[set][12]), "+v"(rs[set][13]), "+v"(rs[set][14]) :: "memory")
#define SC_WRITE(set, par) do { LAS unsigned char* wb_ = lds + (par) * SC_BUF; \
            _Pragma("unroll") for (int r = 0; r < 4; ++r) { *(LAS v4u*)(wb_ + SC_WN + lA + r * (16 * 272)) = rs[set][r]; *(LAS v4u*)(wb_ + SC_QD + lA + r * (16 * 272)) = rs[set][4 + r]; \
                                                          *(LAS v4u*)(wb_ + SC_KD + lB + r * (32 * 144)) = rs[set][8 + r]; } \
            *(LAS v4u*)(wb_ + SC_ATT + lB) = rs[set][12]; *(LAS v4u*)(wb_ + SC_ATT + lB + 32 * 144) = rs[set][13]; \
            *(LAS v4u*)(lds + lU + (par) * (SCAN_NWC * 2048)) = rs[set][14]; } while (0)
#define SC_NEED(c) do { unsigned sp_ = 0; while (*(volatile LAS unsigned*)(lds + SC_RDY) <= (unsigned)(c) && ++sp_ < (1u << 24)) __builtin_amdgcn_s_sleep(2); } while (0)
        SC_NEED(0); SC_ISSUE(0, item0);
        SC_WAITSET(0, "vmcnt(0)"); SC_WRITE(0, 0); SC_WAITSET(0, "lgkmcnt(0)");
        SC_NEED(3); SC_ISSUE(1, item0 + 1); SC_ISSUE(2, item0 + 2); SC_ISSUE(0, item0 + 3);
        SC_BAR();
        int n2 = 0;
#define SC_INTERVAL(set) do { SC_WAITSET(set, "vmcnt(30)"); SC_WRITE(set, (n2 + 1) & 1); SC_WAITSET(set, "lgkmcnt(0)"); if (n2 + 1 + DEP < 128) SC_NEED(n2 + 1 + DEP); SC_ISSUE(set, item0 + ((n2 + 1 + DEP) & 127)); SC_BAR(); ++n2; } while (0)
#pragma unroll 1
        for (int it = 0; it < NCH / 3; ++it) { SC_INTERVAL(1); SC_INTERVAL(2); SC_INTERVAL(0); }
        if (NCH % 3 >= 1) SC_INTERVAL(1);
        if (NCH % 3 >= 2) SC_INTERVAL(2);
        SC_WAITSET(0, "vmcnt(0)"); SC_WAITSET(1, "vmcnt(0)"); SC_WAITSET(2, "vmcnt(0)");
#undef SC_INTERVAL
#undef SC_NEED
#undef SC_WRITE
#undef SC_WAITSET
#undef SC_ISSUE
        return;
    }
    if (wave == 3) {
        const unsigned* flags = (const unsigned*)(ws + WS_CTL) + CW_GFLAG + item0;
        unsigned rdy = 0;
#define SC_POLLSTEP() do { if (rdy < 128u) { const unsigned idx_ = rdy + (unsigned)lane; \
            const unsigned fv_ = (idx_ < 128u) ? __hip_atomic_load(flags + idx_, __ATOMIC_RELAXED, __HIP_MEMORY_SCOPE_AGENT) : 0u; \
            const unsigned long long m_ = __ballot(fv_ != 0u); const unsigned nrun_ = (m_ == ~0ull) ? 64u : (unsigned)__builtin_ctzll(~m_);     \
            if ((unsigned)lane < nrun_) ((LAS float*)(lds + SC_DECS))[idx_] = __builtin_bit_cast(float, fv_); \
            rdy += nrun_; LDS_WAIT(); if (lane == 0) *(volatile LAS unsigned*)(lds + SC_RDY) = rdy; } } while (0)
        { unsigned sp = 0; while (rdy < 4u && ++sp < (1u << 22)) { SC_POLLSTEP(); if (rdy < 4u) __builtin_amdgcn_s_sleep(16); } }
        SC_BAR();
#pragma unroll 1
        for (int n2 = 0; n2 < NCH; ++n2) {
            { const unsigned need = (unsigned)(n2 + 1 + 3) < 128u ? (unsigned)(n2 + 1 + 3) : 127u; unsigned sp = 0;
              while (rdy <= need && rdy < 128u && ++sp < (1u << 22)) { SC_POLLSTEP(); if (rdy <= need) __builtin_amdgcn_s_sleep(8); } }
            if (rdy < 128u && rdy < (unsigned)(n2 & 127) + 16u) SC_POLLSTEP();
            SC_BAR();
        }
#undef SC_POLLSTEP
        return;
    }
    if (wave == 2) {
        const int row = lane;
        bf16* Y = (bf16*)((unsigned char*)P.out + OUT_Y);
        float* SSQG = P.out;
        SC_BAR();
#pragma unroll 1
        for (int n2 = 0; n2 <= NCH; ++n2) {
            if (n2 > 0) {
                const int n = (n2 - 1) & 127, t = b * SEQ + n * 64 + row;
                const LAS float* src = (const LAS float*)(lds + SC_OT + ((n2 - 1) & 1) * (64 * 36 * 4)) + row * 36;
                f32x4 a[8]; float s2 = 0.f;
#pragma unroll
                for (int q = 0; q < 8; ++q) { a[q] = *(const LAS f32x4*)(src + 4 * q); s2 += (a[q].x * a[q].x + a[q].y * a[q].y) + (a[q].z * a[q].z + a[q].w * a[q].w); }
                SSQG[(size_t)t * 32 + h * 8 + part] = s2;
                v4u* d = (v4u*)(Y + (size_t)t * 1024 + h * 128 + 32 * part);
#pragma unroll
                for (int q = 0; q < 4; ++q) { v4u o; o.x = pk2(a[2 * q].x, a[2 * q].y); o.y = pk2(a[2 * q].z, a[2 * q].w); o.z = pk2(a[2 * q + 1].x, a[2 * q + 1].y); o.w = pk2(a[2 * q + 1].z, a[2 * q + 1].w); d[q] = o; }
            }
            if (n2 < NCH) SC_BAR();
        }
        return;
    }
    f32x4 S[8];
#pragma unroll
    for (int i = 0; i < 8; ++i) S[i] = (f32x4){0.f, 0.f, 0.f, 0.f};
    SC_BAR();
#pragma unroll 1
    for (int n2 = 0; n2 < NCH; ++n2) {
        if (SCAN_REPS > 1 && (n2 & 127) == 0) {
#pragma unroll
            for (int i = 0; i < 8; ++i) S[i] = (f32x4){0.f, 0.f, 0.f, 0.f};
        }
        if (SCAN_EXP == 2 && n2 < 128) { SC_BAR(); continue; }
        const int par = n2 & 1;
        LAS unsigned char* buf = lds + par * SC_BUF;
        bf16x8 fA[16], fB[16], fC[16], fD[8];
#pragma unroll
        for (int rho = 0; rho < 4; ++rho)
#pragma unroll
            for (int s = 0; s < 4; ++s) fA[rho * 4 + s] = *(const LAS bf16x8*)(buf + SC_WN + (16 * rho + col) * 272 + (32 * s + 8 * g) * 2);
#pragma unroll
        for (int rho = 0; rho < 4; ++rho)
#pragma unroll
            for (int s = 0; s < 4; ++s) fB[rho * 4 + s] = *(const LAS bf16x8*)(buf + SC_QD + (16 * rho + col) * 272 + (32 * s + 8 * g) * 2);
        const LAS v4u* ufp = (const LAS v4u*)(lds + SC_UFS + par * (SCAN_NWC * 2048) + wave * 2048 + lane * 32);
        const v4u uf0 = ufp[0], uf1 = ufp[1];
        const float dec = ((const LAS float*)(lds + SC_DECS))[n2 & 127];
        bf16x8 Bs[4];
#pragma unroll
        for (int s = 0; s < 4; ++s) Bs[s] = pack_b(S[2 * s], S[2 * s + 1]);
        f32x4 Vn[4], Oc[4];
        Vn[0] = (f32x4){bflo(uf0.x), bfhi(uf0.x), bflo(uf0.y), bfhi(uf0.y)}; Vn[1] = (f32x4){bflo(uf0.z), bfhi(uf0.z), bflo(uf0.w), bfhi(uf0.w)};
        Vn[2] = (f32x4){bflo(uf1.x), bfhi(uf1.x), bflo(uf1.y), bfhi(uf1.y)}; Vn[3] = (f32x4){bflo(uf1.z), bfhi(uf1.z), bflo(uf1.w), bfhi(uf1.w)};
        __builtin_amdgcn_sched_barrier(0);
        PIN16(fA);
#pragma unroll
        for (int s = 0; s < 4; ++s)
#pragma unroll
            for (int rho = 0; rho < 4; ++rho) Vn[rho] = __builtin_amdgcn_mfma_f32_16x16x32_bf16(fA[rho * 4 + s], Bs[s], Vn[rho], 0, 0, 0);
        __builtin_amdgcn_sched_barrier(0);
#pragma unroll
        for (int tau = 0; tau < 8; ++tau)
#pragma unroll
            for (int s = 0; s < 2; ++s) fC[tau * 2 + s] = *(const LAS bf16x8*)(buf + SC_KD + (16 * tau + col) * 144 + (32 * s + 8 * g) * 2);
        __builtin_amdgcn_sched_barrier(0);
        PIN16(fB);
#pragma unroll
        for (int rho = 0; rho < 4; ++rho) Oc[rho] = (f32x4){0.f, 0.f, 0.f, 0.f};
#pragma unroll
        for (int s = 0; s < 4; ++s)
#pragma unroll
            for (int rho = 0; rho < 4; ++rho) Oc[rho] = __builtin_amdgcn_mfma_f32_16x16x32_bf16(fB[rho * 4 + s], Bs[s], Oc[rho], 0, 0, 0);
        __builtin_amdgcn_sched_barrier(0);
#pragma unroll
        for (int rho = 0; rho < 4; ++rho)
#pragma unroll
            for (int s = 0; s < 2; ++s) fD[rho * 2 + s] = *(const LAS bf16x8*)(buf + SC_ATT + (16 * rho + col) * 144 + (32 * s + 8 * g) * 2);
        bf16x8 Bv[2];
        Bv[0] = pack_b(Vn[0], Vn[1]); Bv[1] = pack_b(Vn[2], Vn[3]);
#pragma unroll
        for (int tau = 0; tau < 8; ++tau) S[tau] = S[tau] * dec;
        __builtin_amdgcn_sched_barrier(0);
        PIN16(fC);
#pragma unroll
        for (int s = 0; s < 2; ++s)
#pragma unroll
            for (int tau = 0; tau < 8; ++tau) S[tau] = __builtin_amdgcn_mfma_f32_16x16x32_bf16(fC[tau * 2 + s], Bv[s], S[tau], 0, 0, 0);
        __builtin_amdgcn_sched_barrier(0);
        PIN8(fD);
#pragma unroll
        for (int s = 0; s < 2; ++s)
#pragma unroll
            for (int rho = 0; rho < 4; ++rho) Oc[rho] = __builtin_amdgcn_mfma_f32_16x16x32_bf16(fD[rho * 2 + s], Bv[s], Oc[rho], 0, 0, 0);
        LAS float* ot = (LAS float*)(lds + SC_OT + par * (64 * 36 * 4)) + 16 * wave + col;
#pragma unroll
        for (int rho = 0; rho < 4; ++rho)
#pragma unroll
            for (int i = 0; i < 4; ++i) ot[(16 * rho + 4 * g + i) * 36] = Oc[rho][i];
        SC_BAR();
    }
}

__device__ __forceinline__ void lru_carry(const Params& P, int gwv, int lane) {
    unsigned char* ws = P.ws;
    const int b = gwv >> 3, g = gwv & 7, ch = g * 64 + lane;
    const float* HEND = (const float*)(ws + WS_HEND); const float* PEND = (const float*)(ws + WS_PEND); float* HIN = (float*)(ws + WS_HIN);
    float hin = 0.f;
#pragma unroll 1
    for (int n0 = 0; n0 < 128; n0 += 32) {
        float he[32], pe[32];
#pragma unroll
        for (int i = 0; i < 32; ++i) { const size_t o = (size_t)(b * 128 + n0 + i) * 512 + ch; he[i] = HEND[o]; pe[i] = PEND[o]; }
#pragma unroll
        for (int i = 0; i < 32; ++i) { HIN[(size_t)(b * 128 + n0 + i) * 512 + ch] = hin; hin = he[i] + pe[i] * hin; }
    }
}

__device__ __forceinline__ void cvt_table(const float* src, bf16* dst, size_t n8, size_t wi, size_t nw) {
    for (size_t i = wi; i < n8; i += nw) {
        const f32x4 a = ((const f32x4*)src)[2 * i], c = ((const f32x4*)src)[2 * i + 1];
        v4u o; o.x = pk2(a.x, a.y); o.y = pk2(a.z, a.w); o.z = pk2(c.x, c.y); o.w = pk2(c.z, c.w);
        ((v4u*)dst)[i] = o;
    }
}

__device__ __forceinline__ void lru_combine(const Params& P, size_t wi, size_t nw) {
    unsigned char* ws = P.ws;
    const v4u* HLOC = (const v4u*)(ws + WS_HLOC); const v4u* PCUM = (const v4u*)(ws + WS_PCUM); const v4u* GATE = (const v4u*)(ws + WS_GATE);
    const float* HIN = (const float*)(ws + WS_HIN); bf16* Y = (bf16*)((unsigned char*)P.out + OUT_Y);
    for (size_t i = wi; i < (size_t)T * 64; i += nw) {
        const size_t t = i >> 6; const int ch0 = (int)(i & 63) * 8;
        const v4u hl = HLOC[i], pc = PCUM[i], gt = GATE[i];
        const f32x4 h0 = *(const f32x4*)(HIN + (t >> 6) * 512 + ch0), h1 = *(const f32x4*)(HIN + (t >> 6) * 512 + ch0 + 4);
        float y[8];
        y[0] = (bflo(hl.x) + bflo(pc.x) * h0.x) * gelu_tanh(bflo(gt.x)); y[1] = (bfhi(hl.x) + bfhi(pc.x) * h0.y) * gelu_tanh(bfhi(gt.x));
        y[2] = (bflo(hl.y) + bflo(pc.y) * h0.z) * gelu_tanh(bflo(gt.y)); y[3] = (bfhi(hl.y) + bfhi(pc.y) * h0.w) * gelu_tanh(bfhi(gt.y));
        y[4] = (bflo(hl.z) + bflo(pc.z) * h1.x) * gelu_tanh(bflo(gt.z)); y[5] = (bfhi(hl.z) + bfhi(pc.z) * h1.y) * gelu_tanh(bfhi(gt.z));
        y[6] = (bflo(hl.w) + bflo(pc.w) * h1.z) * gelu_tanh(bflo(gt.w)); y[7] = (bfhi(hl.w) + bfhi(pc.w) * h1.w) * gelu_tanh(bfhi(gt.w));
        v4u o; o.x = pk2(y[0], y[1]); o.y = pk2(y[2], y[3]); o.z = pk2(y[4], y[5]); o.w = pk2(y[6], y[7]);
        *(v4u*)(Y + t * 1024 + 512 + ch0) = o;
    }
}

__device__ __forceinline__ void gdn_gate_norm(const Params& P, size_t wi, size_t nw) {
    unsigned char* ws = P.ws;
    bf16* Y = (bf16*)((unsigned char*)P.out + OUT_Y); const v4u* Z = (const v4u*)(ws + WS_Z); const float* SSQG = P.out;
    for (size_t i = wi; i < (size_t)T * 64; i += nw) {
        const size_t t = i >> 6; const int c0 = (int)(i & 63) * 8, h = c0 >> 7;
        const f32x4 q0 = *(const f32x4*)(SSQG + t * 32 + h * 8);
        const float rstd = rsqrtf(((q0.x + q0.y) + (q0.z + q0.w)) * (1.0f / 128.0f) + 1e-6f);
        const v4u o = *(const v4u*)(Y + t * 1024 + c0), z = Z[i];
        const f32x4 w0 = *(const f32x4*)(P.gdn_norm_w + (c0 & 127)), w1 = *(const f32x4*)(P.gdn_norm_w + (c0 & 127) + 4);
        float y[8];
        y[0] = bflo(o.x) * rstd * w0.x * siluf_(bflo(z.x)); y[1] = bfhi(o.x) * rstd * w0.y * siluf_(bfhi(z.x));
        y[2] = bflo(o.y) * rstd * w0.z * siluf_(bflo(z.y)); y[3] = bfhi(o.y) * rstd * w0.w * siluf_(bfhi(z.y));
        y[4] = bflo(o.z) * rstd * w1.x * siluf_(bflo(z.z)); y[5] = bfhi(o.z) * rstd * w1.y * siluf_(bfhi(z.z));
        y[6] = bflo(o.w) * rstd * w1.z * siluf_(bflo(z.w)); y[7] = bfhi(o.w) * rstd * w1.w * siluf_(bfhi(z.w));
        v4u r; r.x = pk2(y[0], y[1]); r.y = pk2(y[2], y[3]); r.z = pk2(y[4], y[5]); r.w = pk2(y[6], y[7]);
        *(v4u*)(Y + t * 1024 + c0) = r;
    }
}

__device__ __forceinline__ void xattn_stage(LAS unsigned char* lds, const bf16* src, int tid) {
    v4u tmp[16];
    asm volatile("" : "+v"(tid));
    const unsigned voff = (unsigned)tid * 16u;
#pragma unroll
    for (int r = 0; r < 16; ++r) { const unsigned char* sb = (const unsigned char*)src + r * 8192;
        asm volatile("s_nop 4\n\tglobal_load_dwordx4 %0, %1, %2" : "=&v"(tmp[r]) : "v"(voff), "s"(sb) : "memory"); }
    asm volatile("s_waitcnt vmcnt(0)" : "+v"(tmp[0]), "+v"(tmp[1]), "+v"(tmp[2]), "+v"(tmp[3]), "+v"(tmp[4]), "+v"(tmp[5]), "+v"(tmp[6]), "+v"(tmp[7]),
                                        "+v"(tmp[8]), "+v"(tmp[9]), "+v"(tmp[10]), "+v"(tmp[11]), "+v"(tmp[12]), "+v"(tmp[13]), "+v"(tmp[14]), "+v"(tmp[15]) :: "memory");
#pragma unroll
    for (int r = 0; r < 16; ++r) { const int id = tid + 512 * r; *(LAS v4u*)(lds + (id >> 5) * 528 + (id & 31) * 16) = tmp[r]; }
}
#ifndef XA_NPS
#define XA_NPS 2
#endif
__device__ __forceinline__ void xattn_unit(const Params& P, LAS unsigned char* lds, int unit, int tid, int lane, int wave) {
    const unsigned char* ws = P.ws;
    const int h = unit & 3, qb = (unit >> 2) & 63, b = unit >> 8; int col = lane & 15, g = lane >> 4;
    const int tw = b * SEQ + qb * 128 + 16 * wave;
    const bf16* Kb = (const bf16*)(ws + WS_KB) + (size_t)((b * 4 + h) * 256) * 256;
    const bf16* Vt = (const bf16*)(ws + WS_VTP) + (size_t)((b * 4 + h) * 256) * 256;
    xattn_stage(lds, Kb, tid);
    __syncthreads();
    const LAS unsigned char* arow = lds + col * 528 + g * 16;
    bf16x8 Bp[XA_NPS][8]; float inv[XA_NPS];
#pragma unroll
    for (int ps = 0; ps < XA_NPS; ++ps) {
        __builtin_amdgcn_sched_barrier(0); asm volatile("" : "+v"(col), "+v"(g) :: "memory");
        const bf16* Q = (const bf16*)(ws + WS_Q) + (size_t)(tw + 128 * ps + col) * 1024 + h * 256 + 8 * g;
        bf16x8 Bq[8];
#pragma unroll
        for (int s = 0; s < 8; ++s) Bq[s] = *(const bf16x8*)(Q + 32 * s);
        f32x4 St[16];
        bf16x8 fr[2][8];
#pragma unroll
        for (int s = 0; s < 8; ++s) fr[0][s] = *(const LAS bf16x8*)(arow + 64 * s);
#pragma unroll
        for (int kap = 0; kap < 16; ++kap) {
            if (kap + 1 < 16) {
#pragma unroll
                for (int s = 0; s < 8; ++s) fr[(kap + 1) & 1][s] = *(const LAS bf16x8*)(arow + (16 * (kap + 1)) * 528 + 64 * s);
            }
            __builtin_amdgcn_sched_barrier(0);
            PIN8(fr[kap & 1]);
            f32x4 acc = (f32x4){0.f, 0.f, 0.f, 0.f};
#pragma unroll
            for (int s = 0; s < 8; ++s) acc = __builtin_amdgcn_mfma_f32_16x16x32_bf16(fr[kap & 1][s], Bq[s], acc, 0, 0, 0);
            St[kap] = acc;
            __builtin_amdgcn_sched_barrier(0);
        }
        float mx = -3.0e38f;
#pragma unroll
        for (int kap = 0; kap < 16; ++kap) mx = fmaxf(fmaxf(fmaxf(St[kap].x, St[kap].y), fmaxf(St[kap].z, St[kap].w)), mx);
        mx = fmaxf(mx, __shfl_xor(mx, 16)); mx = fmaxf(mx, __shfl_xor(mx, 32));
        float l = 0.f;
#pragma unroll
        for (int kap = 0; kap < 16; ++kap) { St[kap].x = __expf(St[kap].x - mx); St[kap].y = __expf(St[kap].y - mx); St[kap].z = __expf(St[kap].z - mx); St[kap].w = __expf(St[kap].w - mx);
            l += (St[kap].x + St[kap].y) + (St[kap].z + St[kap].w); }
        l += __shfl_xor(l, 16); l += __shfl_xor(l, 32);
        inv[ps] = 1.0f / l;
#pragma unroll
        for (int s = 0; s < 8; ++s) Bp[ps][s] = pack_b(St[2 * s], St[2 * s + 1]);
    }
    __syncthreads();
    xattn_stage(lds, Vt, tid);
    __syncthreads();
#pragma unroll
    for (int ps = 0; ps < XA_NPS; ++ps) {
        __builtin_amdgcn_sched_barrier(0); asm volatile("" : "+v"(col), "+v"(g) :: "memory");
        bf16* AO = (bf16*)(P.ws + WS_AO) + (size_t)(tw + 128 * ps + col) * 1024 + h * 256 + 4 * g;
        bf16x8 fr[2][8];
#pragma unroll
        for (int s = 0; s < 8; ++s) fr[0][s] = *(const LAS bf16x8*)(arow + 64 * s);
#pragma unroll
        for (int del = 0; del < 16; ++del) {
            if (del + 1 < 16) {
#pragma unroll
                for (int s = 0; s < 8; ++s) fr[(del + 1) & 1][s] = *(const LAS bf16x8*)(arow + (16 * (del + 1)) * 528 + 64 * s);
            }
            __builtin_amdgcn_sched_barrier(0);
            PIN8(fr[del & 1]);
            f32x4 acc = (f32x4){0.f, 0.f, 0.f, 0.f};
#pragma unroll
            for (int s = 0; s < 8; ++s) acc = __builtin_amdgcn_mfma_f32_16x16x32_bf16(fr[del & 1][s], Bp[ps][s], acc, 0, 0, 0);
            v2u o; o.x = pk2(acc.x * inv[ps], acc.y * inv[ps]); o.y = pk2(acc.z * inv[ps], acc.w * inv[ps]);
            *(v2u*)(AO + 16 * del) = o;
            __builtin_amdgcn_sched_barrier(0);
        }
    }
    __syncthreads();
}

__device__ __forceinline__ unsigned key_enc(float f) { const unsigned u = __builtin_bit_cast(unsigned, f); return (u & 0x80000000u) ? ~u : (u | 0x80000000u); }
__device__ __forceinline__ float key_dec(unsigned k) { const unsigned u = (k & 0x80000000u) ? (k & 0x7fffffffu) : ~k; return __builtin_bit_cast(float, u); }
#define TK_CAS(a, b) do { const unsigned hi_ = max(a, b), lo_ = min(a, b); a = hi_; b = lo_; } while (0)
__device__ __forceinline__ void tk_merge16(unsigned (&a)[16]) {
#pragma unroll
    for (int j = 8; j > 0; j >>= 1)
#pragma unroll
        for (int i = 0; i < 16; ++i) { const int l = i ^ j; if (l > i) TK_CAS(a[i], a[l]); }
}
__device__ __forceinline__ void tk_sort16(unsigned (&a)[16]) {
#define TK_L(...) do { const int pr_[] = {__VA_ARGS__}; _Pragma("unroll") for (int q_ = 0; q_ < (int)(sizeof(pr_) / sizeof(int)); q_ += 2) TK_CAS(a[pr_[q_]], a[pr_[q_ + 1]]); } while (0)
    TK_CAS(a[0], a[13]); TK_CAS(a[1], a[12]); TK_CAS(a[2], a[15]); TK_CAS(a[3], a[14]); TK_CAS(a[4], a[8]); TK_CAS(a[5], a[6]); TK_CAS(a[7], a[11]); TK_CAS(a[9], a[10]);
    TK_CAS(a[0], a[5]); TK_CAS(a[1], a[7]); TK_CAS(a[2], a[9]); TK_CAS(a[3], a[4]); TK_CAS(a[6], a[13]); TK_CAS(a[8], a[14]); TK_CAS(a[10], a[15]); TK_CAS(a[11], a[12]);
    TK_CAS(a[0], a[1]); TK_CAS(a[2], a[3]); TK_CAS(a[4], a[5]); TK_CAS(a[6], a[8]); TK_CAS(a[7], a[9]); TK_CAS(a[10], a[11]); TK_CAS(a[12], a[13]); TK_CAS(a[14], a[15]);
    TK_CAS(a[0], a[2]); TK_CAS(a[1], a[3]); TK_CAS(a[4], a[10]); TK_CAS(a[5], a[11]); TK_CAS(a[6], a[7]); TK_CAS(a[8], a[9]); TK_CAS(a[12], a[14]); TK_CAS(a[13], a[15]);
    TK_CAS(a[1], a[2]); TK_CAS(a[3], a[12]); TK_CAS(a[4], a[6]); TK_CAS(a[5], a[7]); TK_CAS(a[8], a[10]); TK_CAS(a[9], a[11]); TK_CAS(a[13], a[14]);
    TK_CAS(a[1], a[4]); TK_CAS(a[2], a[6]); TK_CAS(a[5], a[8]); TK_CAS(a[7], a[10]); TK_CAS(a[9], a[13]); TK_CAS(a[11], a[14]);
    TK_CAS(a[2], a[4]); TK_CAS(a[3], a[6]); TK_CAS(a[9], a[12]); TK_CAS(a[11], a[13]);
    TK_CAS(a[3], a[5]); TK_CAS(a[6], a[8]); TK_CAS(a[7], a[9]); TK_CAS(a[10], a[12]);
    TK_CAS(a[3], a[4]); TK_CAS(a[5], a[6]); TK_CAS(a[7], a[8]); TK_CAS(a[9], a[10]); TK_CAS(a[11], a[12]);
    TK_CAS(a[6], a[7]); TK_CAS(a[8], a[9]);
#undef TK_L
}
__device__ __forceinline__ void tk_top16_merge(unsigned (&L)[16], const unsigned (&G)[16]) {
#pragma unroll
    for (int i = 0; i < 16; ++i) L[i] = max(L[i], G[15 - i]);
    tk_merge16(L);
}
__device__ __forceinline__ void tk_pair_merge(unsigned (&L)[16]) {
    unsigned Pp[16];
#pragma unroll
    for (int i = 0; i < 16; ++i) Pp[i] = (unsigned)__builtin_amdgcn_update_dpp(0, (int)L[i], 0xB1, 0xF, 0xF, true);
    tk_top16_merge(L, Pp);
}
__device__ __forceinline__ void peer_topk_rows(const Params& P, LAS unsigned char* lds, int rowbase, int tid) {
    const unsigned char* ws = P.ws;
    typedef _Float16 f16x8 __attribute__((ext_vector_type(8)));
    const int rl = tid >> 1, hf = tid & 1, grow = rowbase + rl, t = grow >> 3, h = grow & 7;
    const _Float16* SC = (const _Float16*)(ws + WS_PQ) + (size_t)t * 2048 + h * 256 + 64 * hf;
    f16x8 raw[2][8];
#pragma unroll
    for (int p = 0; p < 2; ++p)
#pragma unroll
        for (int q = 0; q < 8; ++q) raw[p][q] = *(const f16x8*)(SC + p * 128 + 8 * q);
    unsigned L1[16], L2[16];
#pragma unroll
    for (int p = 0; p < 2; ++p) {
        unsigned L[16];
#pragma unroll
        for (int grp = 0; grp < 4; ++grp) {
            unsigned G[16];
#pragma unroll
            for (int e = 0; e < 16; ++e) G[e] = (key_enc((float)raw[p][2 * grp + (e >> 3)][e & 7]) & ~127u) | (unsigned)(127 - (64 * hf + 16 * grp + e));
            tk_sort16(G);
            if (grp == 0) {
#pragma unroll
                for (int i = 0; i < 16; ++i) L[i] = G[i];
            } else tk_top16_merge(L, G);
        }
        tk_pair_merge(L);
#pragma unroll
        for (int i = 0; i < 16; ++i) { if (p == 0) L1[i] = L[i]; else L2[i] = L[i]; }
    }
    {
        float v1[16], v2[16];
        LAS int* il = (LAS int*)lds + rl * 33;
#pragma unroll
        for (int q = 0; q < 16; ++q) { v1[q] = key_dec((L1[q] & ~127u) | 64u); v2[q] = key_dec((L2[q] & ~127u) | 64u); }
        if (hf == 0) {
#pragma unroll
            for (int q = 0; q < 16; ++q) { il[q] = 127 - (int)(L1[q] & 127u); il[16 + q] = 127 - (int)(L2[q] & 127u); }
        }
        unsigned C[16], D[16];
        float w1[8];
        const unsigned hf16 = (unsigned)hf * 16u, evenmask = (unsigned)hf - 1u;
#pragma unroll
        for (int k = 0; k < 8; ++k) w1[k] = __builtin_bit_cast(float, (__builtin_bit_cast(unsigned, v1[2 * k]) & evenmask) | (__builtin_bit_cast(unsigned, v1[2 * k + 1]) & ~evenmask));
#define TK_SLOT(dst, k, bq, valid_odd) do { const unsigned pos_ = (unsigned)(16 * (2 * (k)) + (bq)) + hf16; unsigned kv_ = (key_enc(w1[k] + v2[bq]) & ~255u) | (255u - pos_); if (!(valid_odd)) kv_ &= evenmask; dst = kv_; } while (0)
        TK_SLOT(C[0], 0, 0, true);
        TK_SLOT(C[1], 0, 1, true);
        TK_SLOT(C[2], 0, 2, true);
        TK_SLOT(C[3], 0, 3, true);
        TK_SLOT(C[4], 0, 4, true);
        TK_SLOT(C[5], 0, 5, true);
        TK_SLOT(C[6], 0, 6, true);
        TK_SLOT(C[7], 0, 7, true);
        TK_SLOT(C[8], 0, 8, false);
        TK_SLOT(C[9], 0, 9, false);
        TK_SLOT(C[10], 0, 10, false);
        TK_SLOT(C[11], 0, 11, false);
        TK_SLOT(C[12], 0, 12, false);
        TK_SLOT(C[13], 0, 13, false);
        TK_SLOT(C[14], 0, 14, false);
        TK_SLOT(C[15], 0, 15, false);
        TK_SLOT(D[0], 1, 0, true);
        TK_SLOT(D[1], 1, 1, true);
        TK_SLOT(D[2], 1, 2, true);
        TK_SLOT(D[3], 1, 3, true);
        TK_SLOT(D[4], 1, 4, false);
        TK_SLOT(D[5], 2, 0, true);
        TK_SLOT(D[6], 2, 1, true);
        TK_SLOT(D[7], 2, 2, false);
        TK_SLOT(D[8], 3, 0, true);
        TK_SLOT(D[9], 3, 1, true);
        TK_SLOT(D[10], 4, 0, true);
        TK_SLOT(D[11], 5, 0, true);
        TK_SLOT(D[12], 6, 0, true);
        TK_SLOT(D[13], 7, 0, true);
        D[14] = 0u; D[15] = 0u;
#undef TK_SLOT
        tk_sort16(C); tk_sort16(D); tk_top16_merge(C, D); tk_pair_merge(C);
        LDS_WAIT(); asm volatile("" ::: "memory");
        float best[16], e[16], sum = 0.f;
#pragma unroll
        for (int q = 0; q < 16; ++q) { best[q] = key_dec((C[q] & ~255u) | 128u); e[q] = __expf(best[q] - best[0]); sum += e[q]; }
        const float inv = __builtin_amdgcn_rcpf(sum);
        int* IDX = (int*)(P.ws + WS_IDX) + (size_t)grow * 16 + 8 * hf; float* GW = (float*)(P.ws + WS_GW) + (size_t)grow * 16 + 8 * hf;
#pragma unroll
        for (int q = 0; q < 8; ++q) {
            const unsigned c = (C[q] & evenmask) | (C[8 + q] & ~evenmask);
            const float ev = __builtin_bit_cast(float, (__builtin_bit_cast(unsigned, e[q]) & evenmask) | (__builtin_bit_cast(unsigned, e[8 + q]) & ~evenmask));
            const unsigned pos = 255u - (c & 255u);
            IDX[q] = il[pos >> 4] * 128 + il[16 + (pos & 15u)]; GW[q] = ev * inv;
        }
    }
    LDS_WAIT(); asm volatile("" ::: "memory");
}

__device__ __forceinline__ void peer_topk_wave(const Params& P, LAS int* ilw, LAS unsigned* oute, LAS float* outg, int tbase, int lane) {
    const unsigned char* ws = P.ws;
    typedef _Float16 f16x8 __attribute__((ext_vector_type(8)));
    const int rl = lane >> 1, hf = lane & 1, t = tbase + (rl >> 3), h = rl & 7;
    const _Float16* SC = (const _Float16*)(ws + WS_PQ) + (size_t)t * 2048 + h * 256 + 64 * hf;
    f16x8 raw[2][8];
#pragma unroll
    for (int p = 0; p < 2; ++p)
#pragma unroll
        for (int q = 0; q < 8; ++q) raw[p][q] = *(const f16x8*)(SC + p * 128 + 8 * q);
    unsigned L1[16], L2[16];
    typedef short s16x2 __attribute__((ext_vector_type(2)));
    const unsigned lanebit = 64u - 64u * (unsigned)hf;
#pragma unroll
    for (int p = 0; p < 2; ++p) {
        unsigned L[16];
#pragma unroll
        for (int grp = 0; grp < 4; ++grp) {
            unsigned G[16];
#pragma unroll
            for (int e2 = 0; e2 < 8; ++e2) {
                const v4u wv = __builtin_bit_cast(v4u, raw[p][2 * grp + (e2 >> 2)]);
                const unsigned w = wv[e2 & 3];
                const unsigned m = __builtin_bit_cast(unsigned, __builtin_bit_cast(s16x2, w) >> (s16x2){15, 15}) | 0x80008000u;
                const unsigned k = w ^ m;
                G[2 * e2] = (k << 16) | (unsigned)(63 - (16 * grp + 2 * e2));
                G[2 * e2 + 1] = (k & 0xffff0000u) | (unsigned)(63 - (16 * grp + 2 * e2 + 1));
            }
            tk_sort16(G);
            if (grp == 0) {
#pragma unroll
                for (int i = 0; i < 16; ++i) L[i] = G[i];
            } else tk_top16_merge(L, G);
        }
#pragma unroll
        for (int i = 0; i < 16; ++i) L[i] |= lanebit;
        tk_pair_merge(L);
#pragma unroll
        for (int i = 0; i < 16; ++i) { if (p == 0) L1[i] = L[i]; else L2[i] = L[i]; }
    }
    {
        float v1[16], v2[16];
        LAS int* il = ilw + rl * 33;
#pragma unroll
        for (int q = 0; q < 16; ++q) {
            const unsigned a = L1[q], c = L2[q];
            const unsigned ha = (a >> 16) ^ ((~(unsigned)((int)a >> 31) | 0x8000u) & 0xffffu), hc = (c >> 16) ^ ((~(unsigned)((int)c >> 31) | 0x8000u) & 0xffffu);
            v1[q] = (float)__builtin_bit_cast(_Float16, (unsigned short)ha); v2[q] = (float)__builtin_bit_cast(_Float16, (unsigned short)hc); }
        if (hf == 0) {
#pragma unroll
            for (int q = 0; q < 16; ++q) { il[q] = 127 - (int)(L1[q] & 127u); il[16 + q] = 127 - (int)(L2[q] & 127u); }
        }
        unsigned C[16], D[16];
        float w1[8];
        const unsigned hf16 = (unsigned)hf * 16u, evenmask = (unsigned)hf - 1u;
#pragma unroll
        for (int k = 0; k < 8; ++k) w1[k] = __builtin_bit_cast(float, (__builtin_bit_cast(unsigned, v1[2 * k]) & evenmask) | (__builtin_bit_cast(unsigned, v1[2 * k + 1]) & ~evenmask));
#define TK_SLOT(dst, k, bq, valid_odd) do { const unsigned pos_ = (unsigned)(16 * (2 * (k)) + (bq)) + hf16; unsigned kv_ = (key_enc(w1[k] + v2[bq]) & ~255u) | (255u - pos_); if (!(valid_odd)) kv_ &= evenmask; dst = kv_; } while (0)
        TK_SLOT(C[0], 0, 0, true);
        TK_SLOT(C[1], 0, 1, true);
        TK_SLOT(C[2], 0, 2, true);
        TK_SLOT(C[3], 0, 3, true);
        TK_SLOT(C[4], 0, 4, true);
        TK_SLOT(C[5], 0, 5, true);
        TK_SLOT(C[6], 0, 6, true);
        TK_SLOT(C[7], 0, 7, true);
        TK_SLOT(C[8], 0, 8, false);
        TK_SLOT(C[9], 0, 9, false);
        TK_SLOT(C[10], 0, 10, false);
        TK_SLOT(C[11], 0, 11, false);
        TK_SLOT(C[12], 0, 12, false);
        TK_SLOT(C[13], 0, 13, false);
        TK_SLOT(C[14], 0, 14, false);
        TK_SLOT(C[15], 0, 15, false);
        TK_SLOT(D[0], 1, 0, true);
        TK_SLOT(D[1], 1, 1, true);
        TK_SLOT(D[2], 1, 2, true);
        TK_SLOT(D[3], 1, 3, true);
        TK_SLOT(D[4], 1, 4, false);
        TK_SLOT(D[5], 2, 0, true);
        TK_SLOT(D[6], 2, 1, true);
        TK_SLOT(D[7], 2, 2, false);
        TK_SLOT(D[8], 3, 0, true);
        TK_SLOT(D[9], 3, 1, true);
        TK_SLOT(D[10], 4, 0, true);
        TK_SLOT(D[11], 5, 0, true);
        TK_SLOT(D[12], 6, 0, true);
        TK_SLOT(D[13], 7, 0, true);
        D[14] = 0u; D[15] = 0u;
#undef TK_SLOT
        tk_sort16(C); tk_sort16(D); tk_top16_merge(C, D); tk_pair_merge(C);
        LDS_WAIT(); asm volatile("" ::: "memory");
        float best[16], e[16], sum = 0.f;
#pragma unroll
        for (int q = 0; q < 16; ++q) { best[q] = key_dec((C[q] & ~255u) | 128u); e[q] = __expf(best[q] - best[0]); sum += e[q]; }
        const float inv = __builtin_amdgcn_rcpf(sum);
        LAS unsigned* IDX = oute + rl * 16 + 8 * hf; LAS float* GW = outg + rl * 16 + 8 * hf;
#pragma unroll
        for (int q = 0; q < 8; ++q) {
            const unsigned c = (C[q] & evenmask) | (C[8 + q] & ~evenmask);
            const float ev = __builtin_bit_cast(float, (__builtin_bit_cast(unsigned, e[q]) & evenmask) | (__builtin_bit_cast(unsigned, e[8 + q]) & ~evenmask));
            const unsigned pos = 255u - (c & 255u);
            IDX[q] = (unsigned)(il[pos >> 4] * 128 + il[16 + (pos & 15u)]); GW[q] = ev * inv;
        }
    }
    LDS_WAIT(); asm volatile("" ::: "memory");
}

typedef float f32x2 __attribute__((ext_vector_type(2)));
__device__ __forceinline__ unsigned q8(float x) { return (unsigned)(int)rintf(x) & 0xffu; }
__device__ __forceinline__ void cvt_table_fp8(const float* src, unsigned char* dst, float* scl, int gw, int ngw, int lane) {
    for (int row = gw; row < 16384; row += ngw) {
        const f32x4* sp = (const f32x4*)(src + (size_t)row * 1024 + 16 * lane);
        const f32x4 a0 = sp[0], a1 = sp[1], a2 = sp[2], a3 = sp[3];
        float m = fmaxf(fmaxf(fmaxf(fabsf(a0.x), fabsf(a0.y)), fmaxf(fabsf(a0.z), fabsf(a0.w))), fmaxf(fmaxf(fabsf(a1.x), fabsf(a1.y)), fmaxf(fabsf(a1.z), fabsf(a1.w))));
        m = fmaxf(m, fmaxf(fmaxf(fmaxf(fabsf(a2.x), fabsf(a2.y)), fmaxf(fabsf(a2.z), fabsf(a2.w))), fmaxf(fmaxf(fabsf(a3.x), fabsf(a3.y)), fmaxf(fabsf(a3.z), fabsf(a3.w)))));
#pragma unroll
        for (int o = 1; o < 64; o <<= 1) m = fmaxf(m, __shfl_xor(m, o));
        m = fmaxf(m, 1e-30f);
        const float q = 127.0f / m;
        v4u o;
        o.x = q8(a0.x * q) | (q8(a0.y * q) << 8) | (q8(a0.z * q) << 16) | (q8(a0.w * q) << 24);
        o.y = q8(a1.x * q) | (q8(a1.y * q) << 8) | (q8(a1.z * q) << 16) | (q8(a1.w * q) << 24);
        o.z = q8(a2.x * q) | (q8(a2.y * q) << 8) | (q8(a2.z * q) << 16) | (q8(a2.w * q) << 24);
        o.w = q8(a3.x * q) | (q8(a3.y * q) << 8) | (q8(a3.z * q) << 16) | (q8(a3.w * q) << 24);
        *(v4u*)(dst + (size_t)row * 1024 + 16 * lane) = o;
        if (lane == 0) scl[row] = m * (1.0f / 127.0f);
    }
}
__device__ __forceinline__ int row16_sum_i(int v) {
    v += __builtin_amdgcn_update_dpp(0, v, 0xB1, 0xF, 0xF, true);
    v += __builtin_amdgcn_update_dpp(0, v, 0x4E, 0xF, 0xF, true);
    v += __builtin_amdgcn_update_dpp(0, v, 0x141, 0xF, 0xF, true);
    v += __builtin_amdgcn_update_dpp(0, v, 0x140, 0xF, 0xF, true);
    return v;
}
#ifndef PE_NR_N
#define PE_NR_N 16
#endif
#ifndef PE_RD_N
#define PE_RD_N 6
#endif
#define PE_STR2(x) #x
#define PE_STR(x) PE_STR2(x)
#if PE_RD_N == 8
#define PE_VMY 28
#elif PE_RD_N == 6
#define PE_VMY 20
#elif PE_RD_N == 5
#define PE_VMY 16
#else
#define PE_VMY 12
#endif
#define PE_VMW "vmcnt(" PE_STR(PE_VMY) ")"
constexpr int PE_NT = 4, PE_NR = PE_NR_N, PE_SH = (PE_NR_N == 32 ? 9 : PE_NR_N == 16 ? 10 : PE_NR_N == 8 ? 11 : 12), PE_DEP = 3;
constexpr int PE_TOK_W = 128 * 3 + 36;
constexpr int PE_ENT_W = 272 * 4;
constexpr int PE_WAVE_W = PE_NT * PE_TOK_W + PE_ENT_W + 32 * 33 + 2 * PE_NT * 128;
static_assert(8 * PE_WAVE_W * 4 <= MISC_OFF && PE_NR <= 32 && PE_NT == 4, "peer LDS / batch-list geometry");
#define PE_LD(dst, voff_, sbase_) asm volatile("s_nop 4\n\tglobal_load_dwordx4 %0, %1, %2" : "=&v"(dst) : "v"(voff_), "s"(sbase_) : "memory")
__device__ __forceinline__ void peer_pass(const Params& P, LAS unsigned char* lds, int tbase, int lane, int wave, float* dstbase, int emask = 0x3fff) {
    asm volatile("v_mbcnt_lo_u32_b32 %0, -1, 0\n\tv_mbcnt_hi_u32_b32 %0, -1, %0" : "=v"(lane));
    {
        LAS unsigned* lw0 = (LAS unsigned*)(lds) + wave * PE_WAVE_W + PE_NT * PE_TOK_W + PE_ENT_W;
        peer_topk_wave(P, (LAS int*)lw0, lw0 + 32 * 33, (LAS float*)(lw0 + 32 * 33 + PE_NT * 128), tbase, lane);
        LDS_WAIT(); asm volatile("" : "+v"(lane), "+s"(tbase) :: "memory");
    }
    const unsigned char* ws = P.ws;
    const unsigned char* UB8 = ws + WS_UB; const unsigned char* VB8 = ws + WS_VB;
    const float* USC = (const float*)(ws + WS_USC); const float* VSC = (const float*)(ws + WS_VSC);
    f32x2 acc[PE_NT][8];
    LAS unsigned* lw = (LAS unsigned*)(lds) + wave * PE_WAVE_W;
    LAS unsigned* ents = lw + PE_NT * PE_TOK_W;
    const unsigned voff = (unsigned)lane * 16u;
    LAS unsigned* upe = ents + PE_ENT_W + 32 * 33; LAS float* upg = (LAS float*)(upe + PE_NT * 128);
    LAS unsigned* hql = ents + PE_ENT_W;
#pragma unroll
    for (int j = 0; j < PE_NT; ++j) {
        const int t = tbase + j;
        const v4u* xrow = (const v4u*)((const bf16*)(ws + WS_XB) + (size_t)t * 1024 + 16 * lane);
        const v4u xa = xrow[0], xc = xrow[1];
        const f32x4 xvv[4] = {(f32x4){bflo(xa.x), bfhi(xa.x), bflo(xa.y), bfhi(xa.y)}, (f32x4){bflo(xa.z), bfhi(xa.z), bflo(xa.w), bfhi(xa.w)},
                              (f32x4){bflo(xc.x), bfhi(xc.x), bflo(xc.y), bfhi(xc.y)}, (f32x4){bflo(xc.z), bfhi(xc.z), bflo(xc.w), bfhi(xc.w)}};
        const float rstd2 = rsqrtf(((const float*)(ws + WS_SSQ2))[t] * (1.0f / 1024.0f) + 1e-6f);
        f32x4 hv[4]; float hm = 0.f;
#pragma unroll
        for (int i = 0; i < 4; ++i) { const f32x4 xv = xvv[i]; const f32x4 w = ((const f32x4*)(P.norm_ffn_w + 16 * lane))[i];
            hv[i] = (f32x4){xv.x * rstd2 * w.x, xv.y * rstd2 * w.y, xv.z * rstd2 * w.z, xv.w * rstd2 * w.w};
            hm = fmaxf(hm, fmaxf(fmaxf(fabsf(hv[i].x), fabsf(hv[i].y)), fmaxf(fabsf(hv[i].z), fabsf(hv[i].w)))); }
#pragma unroll
        for (int o = 1; o < 64; o <<= 1) hm = fmaxf(hm, __shfl_xor(hm, o));
        hm = fmaxf(hm, 1e-30f);
        const float hqs = 127.0f / hm, hs = hm * (1.0f / 127.0f);
        { unsigned hqv[4];
#pragma unroll
          for (int i = 0; i < 4; ++i) hqv[i] = q8(hv[i].x * hqs) | (q8(hv[i].y * hqs) << 8) | (q8(hv[i].z * hqs) << 16) | (q8(hv[i].w * hqs) << 24);
          *(LAS v4u*)(hql + (j * 64 + lane) * 4) = (v4u){hqv[0], hqv[1], hqv[2], hqv[3]}; }
#pragma unroll
        for (int i = 0; i < 8; ++i) acc[j][i] = (f32x2){0.f, 0.f};
        const int e0 = (int)upe[j * 128 + 2 * lane] & emask, e1 = (int)upe[j * 128 + 2 * lane + 1] & emask;
        const float g0 = upg[j * 128 + 2 * lane] * VSC[e0], g1 = upg[j * 128 + 2 * lane + 1] * VSC[e1];
        const float u0 = USC[e0] * hs, u1 = USC[e1] * hs;
        const int rev = (tbase >= T / 2) ? (PE_NR - 1) : 0;
        const int b0 = (e0 >> PE_SH) ^ rev, b1 = (e1 >> PE_SH) ^ rev;
        LAS unsigned* lt = lw + j * PE_TOK_W;
        int run = 0, p0 = 0, p1 = 0;
        unsigned mystart = 0;
#pragma unroll
        for (int bk = 0; bk < PE_NR; ++bk) {
            const unsigned long long m0 = __ballot(b0 == bk), m1 = __ballot(b1 == bk);
            const int c0 = __popcll(m0), c1 = __popcll(m1);
            const int r0 = (int)__builtin_amdgcn_mbcnt_hi((unsigned)(m0 >> 32), __builtin_amdgcn_mbcnt_lo((unsigned)m0, 0u));
            const int r1 = (int)__builtin_amdgcn_mbcnt_hi((unsigned)(m1 >> 32), __builtin_amdgcn_mbcnt_lo((unsigned)m1, 0u));
            p0 = (b0 == bk) ? run + r0 : p0;
            p1 = (b1 == bk) ? run + c0 + r1 : p1;
            mystart = (lane == bk) ? (unsigned)run : mystart;
            run += c0 + c1;
        }
        lt[p0] = (unsigned)e0; lt[128 + p0] = __builtin_bit_cast(unsigned, g0); lt[256 + p0] = __builtin_bit_cast(unsigned, u0);
        lt[p1] = (unsigned)e1; lt[128 + p1] = __builtin_bit_cast(unsigned, g1); lt[256 + p1] = __builtin_bit_cast(unsigned, u1);
        if (lane < PE_NR) lt[384 + lane] = mystart;
        if (lane == 0) lt[384 + PE_NR] = 128u;
        asm volatile("" ::: "memory");
    }
    LDS_WAIT(); asm volatile("" ::: "memory");
    int nb = 0;
#ifndef PE_FULLB
#define PE_FULLB 1
#endif
    static_assert(PE_FULLB == 1, "sweep U leaves the packed weights in the batch's own 4 gate slots: batches must be full");
#pragma unroll 1
    for (int it = 0; it < (PE_NR + 15) / 16; ++it) {
        const int rd = (lane >> 2) + 16 * it, j = (rd & 1) ? 3 - (lane & 3) : (lane & 3);
        const LAS unsigned* lt = lw + j * PE_TOK_W;
        const int n0 = rd < PE_NR ? (int)lt[384 + rd] : 128, n1 = rd < PE_NR ? (int)lt[384 + rd + 1] : 128;
        const int nbl = PE_FULLB ? (n1 >> 2) - (n0 >> 2) : (n1 - n0 + 3) >> 2;
        int inc = nbl;
#pragma unroll
        for (int off = 1; off < 64; off <<= 1) { const int tv = __shfl_up(inc, off); if (lane >= off) inc += tv; }
        const int ofs = nb + inc - nbl;
        nb += __builtin_amdgcn_readlane(inc, 63);
#pragma unroll 1
        for (int q = 0; q < nbl; ++q) { const int i0 = PE_FULLB ? ((n0 >> 2) + q) * 4 : n0 + 4 * q, c = PE_FULLB ? 4 : ((n1 - i0) < 4 ? (n1 - i0) : 4);
            const unsigned e0 = lt[i0], e1 = lt[i0 + (c > 1 ? 1 : c - 1)], e2 = lt[i0 + (c > 2 ? 2 : c - 1)], e3 = lt[i0 + (c > 3 ? 3 : c - 1)];
            *(LAS v4u*)(ents + 4 * (ofs + q)) = (v4u){e0 | (((unsigned)j | ((unsigned)c << 2) | ((unsigned)i0 << 5)) << 14), e1, e2, e3}; }
    }
    if (lane < 2 * PE_RD_N) *(LAS v4u*)(ents + 4 * (nb + lane)) = (v4u){0u, 0u, 0u, 0u};
    LDS_WAIT(); asm volatile("" ::: "memory");
    constexpr int PE_RD = PE_RD_N;
    v4u rr[PE_RD][4];
#define PE_LDO(dst, vo_, sbase_) asm volatile("global_load_dwordx4 %0, %1, %2" : "=&v"(dst) : "v"(vo_), "s"(sbase_) : "memory")
#define PE_ISSUE(S, rec_, BASE) do { \
        { const unsigned vo_ = (((rec_).x & 0x3fffu) << 10) + voff; PE_LDO(rr[S][0], vo_, BASE); } { const unsigned vo_ = ((rec_).y << 10) + voff; PE_LDO(rr[S][1], vo_, BASE); } \
        { const unsigned vo_ = ((rec_).z << 10) + voff; PE_LDO(rr[S][2], vo_, BASE); } { const unsigned vo_ = ((rec_).w << 10) + voff; PE_LDO(rr[S][3], vo_, BASE); } } while (0)
#define PE_WAIT4(S, cntstr) asm volatile("s_waitcnt " cntstr : "+v"(rr[S][0]), "+v"(rr[S][1]), "+v"(rr[S][2]), "+v"(rr[S][3]) :: "memory")
#define PE_UDOTS(S) asm("v_dot4_i32_i8 %0, %4, %20, 0\n\tv_dot4_i32_i8 %1, %8, %20, 0\n\tv_dot4_i32_i8 %2, %12, %20, 0\n\tv_dot4_i32_i8 %3, %16, %20, 0\n\t" \
                        "v_dot4_i32_i8 %0, %5, %21, %0\n\tv_dot4_i32_i8 %1, %9, %21, %1\n\tv_dot4_i32_i8 %2, %13, %21, %2\n\tv_dot4_i32_i8 %3, %17, %21, %3\n\t" \
                        "v_dot4_i32_i8 %0, %6, %22, %0\n\tv_dot4_i32_i8 %1, %10, %22, %1\n\tv_dot4_i32_i8 %2, %14, %22, %2\n\tv_dot4_i32_i8 %3, %18, %22, %3\n\t" \
                        "v_dot4_i32_i8 %0, %7, %23, %0\n\tv_dot4_i32_i8 %1, %11, %23, %1\n\tv_dot4_i32_i8 %2, %15, %23, %2\n\tv_dot4_i32_i8 %3, %19, %23, %3\n\ts_nop 2" \
        : "=&v"(d_[0]), "=&v"(d_[1]), "=&v"(d_[2]), "=&v"(d_[3]) \
        : "v"(rr[S][0].x), "v"(rr[S][0].y), "v"(rr[S][0].z), "v"(rr[S][0].w), "v"(rr[S][1].x), "v"(rr[S][1].y), "v"(rr[S][1].z), "v"(rr[S][1].w), \
          "v"(rr[S][2].x), "v"(rr[S][2].y), "v"(rr[S][2].z), "v"(rr[S][2].w), "v"(rr[S][3].x), "v"(rr[S][3].y), "v"(rr[S][3].z), "v"(rr[S][3].w), \
          "v"(hcur.x), "v"(hcur.y), "v"(hcur.z), "v"(hcur.w))
#define PE_VDOTS(f0, f1, f2, f3, b0, b1, b2, b3, w) asm("v_dot4_i32_i8 %0, %4, %8, 0\n\tv_dot4_i32_i8 %1, %5, %8, 0\n\tv_dot4_i32_i8 %2, %6, %8, 0\n\tv_dot4_i32_i8 %3, %7, %8, 0\n\t" \
                        "v_cvt_f32_i32_e32 %0, %0\n\tv_cvt_f32_i32_e32 %1, %1\n\tv_cvt_f32_i32_e32 %2, %2\n\tv_cvt_f32_i32_e32 %3, %3" \
        : "=&v"(f0), "=&v"(f1), "=&v"(f2), "=&v"(f3) : "v"(b0), "v"(b1), "v"(b2), "v"(b3), "v"(w))
#define PE_UBATCH(S, entv) do { const unsigned en_ = (entv) >> 14; const int jj_ = (int)(en_ & 3u), cc_ = (int)((en_ >> 2) & 7u), ii_ = (int)(en_ >> 5); \
        if (cc_ > 0) { if (jj_ != jcur) { jcur = jj_; hcur = *(const LAS v4u*)(hql + (jj_ * 64 + lane) * 4); } \
            LAS unsigned* lt_ = lw + jj_ * PE_TOK_W; const int myk_ = lane >> 4; \
            const float gsc_ = __builtin_bit_cast(float, lt_[128 + ii_ + myk_]), usc_ = __builtin_bit_cast(float, lt_[256 + ii_ + myk_]);     \
            int d_[4]; \
            PE_UDOTS(S); \
            int r1_; \
            { const v2u p02_ = __builtin_amdgcn_permlane32_swap((unsigned)d_[0], (unsigned)d_[2], false, false), p13_ = __builtin_amdgcn_permlane32_swap((unsigned)d_[1], (unsigned)d_[3], false, false); \
              const v2u q_ = __builtin_amdgcn_permlane16_swap(p02_.x + p02_.y, p13_.x + p13_.y, false, false); r1_ = row16_sum_i((int)(q_.x + q_.y)); }     \
            const float x_ = (float)r1_ * usc_, e_ = __builtin_amdgcn_exp2f(x_ * __builtin_fmaf(x_ * x_, -0.10294324f, -2.3022082f));     \
            const float act_ = (myk_ < cc_) ? x_ * __builtin_amdgcn_rcpf(1.0f + e_) * gsc_ : 0.f; \
              \
            float wm_; \
            { unsigned wmu_ = __builtin_bit_cast(unsigned, act_) & 0x7fffffffu;             \
              v2u t_ = __builtin_amdgcn_permlane32_swap(wmu_, wmu_, false, false); wmu_ = t_.x > t_.y ? t_.x : t_.y; \
              t_ = __builtin_amdgcn_permlane16_swap(wmu_, wmu_, false, false); wmu_ = t_.x > t_.y ? t_.x : t_.y; \
              wm_ = fmaxf(__builtin_bit_cast(float, wmu_), 1e-30f); } \
            const float wq_ = 127.0f * __builtin_amdgcn_rcpf(wm_), ws_ = wm_ * (1.0f / 127.0f); \
            unsigned w4u_ = (__builtin_bit_cast(unsigned, __builtin_fmaf(act_, wq_, 12582912.0f)) & 0xffu) << (8 * myk_); \
            { v2u t_ = __builtin_amdgcn_permlane32_swap(w4u_, w4u_, false, false); w4u_ = t_.x | t_.y; t_ = __builtin_amdgcn_permlane16_swap(w4u_, w4u_, false, false); w4u_ = t_.x | t_.y; } \
            if (lane == 0) { lt_[128 + ii_] = w4u_; lt_[128 + ii_ + 1] = __builtin_bit_cast(unsigned, ws_); }     \
        } } while (0)
#define PE_FLUSH() do { _Pragma("unroll") for (int J_ = 0; J_ < PE_NT; ++J_) { const float sel_ = (jcur == J_) ? 1.0f : 0.0f; const f32x2 sel2_ = (f32x2){sel_, sel_};     \
            _Pragma("unroll") for (int i_ = 0; i_ < 8; ++i_) acc[J_][i_] = __builtin_elementwise_fma(cur[i_], sel2_, acc[J_][i_]); } \
        _Pragma("unroll") for (int i_ = 0; i_ < 8; ++i_) cur[i_] = (f32x2){0.f, 0.f}; } while (0)
#define PE_VBATCH(S, entv) do { const unsigned en_ = (entv) >> 14; const int jj_ = (int)(en_ & 3u), cc_ = (int)((en_ >> 2) & 7u), ii_ = (int)(en_ >> 5); \
        if (cc_ > 0) { if (jj_ != jcur) { PE_FLUSH(); jcur = jj_; } \
            const LAS unsigned* lt_ = lw + jj_ * PE_TOK_W + 128 + ii_; \
            const unsigned w4u_ = lt_[0]; const float ws_ = __builtin_bit_cast(float, lt_[1]);     \
            const f32x2 ws2_ = (f32x2){ws_, ws_}; \
            _Pragma("unroll") for (int m_ = 0; m_ < 4; ++m_) { \
                const unsigned R0_ = rr[S][0][m_], R1_ = rr[S][1][m_], R2_ = rr[S][2][m_], R3_ = rr[S][3][m_]; \
                const unsigned X_ = __builtin_amdgcn_perm(R1_, R0_, 0x05010400u), Y_ = __builtin_amdgcn_perm(R1_, R0_, 0x07030602u), Z_ = __builtin_amdgcn_perm(R3_, R2_, 0x05010400u), W_ = __builtin_amdgcn_perm(R3_, R2_, 0x07030602u); \
                float t0_, t1_, t2_, t3_; \
                const unsigned b0_ = __builtin_amdgcn_perm(Z_, X_, 0x05040100u), b1_ = __builtin_amdgcn_perm(Z_, X_, 0x07060302u), b2_ = __builtin_amdgcn_perm(W_, Y_, 0x05040100u), b3_ = __builtin_amdgcn_perm(W_, Y_, 0x07060302u); \
                PE_VDOTS(t0_, t1_, t2_, t3_, b0_, b1_, b2_, b3_, w4u_); \
                cur[2 * m_] = __builtin_elementwise_fma((f32x2){t0_, t1_}, ws2_, cur[2 * m_]); \
                cur[2 * m_ + 1] = __builtin_elementwise_fma((f32x2){t2_, t3_}, ws2_, cur[2 * m_ + 1]); } } } while (0)
    {
        unsigned er[PE_RD];
#pragma unroll
        for (int q = 0; q < PE_RD; ++q) { const v4u rec = *(const LAS v4u*)(ents + 4 * q); er[q] = __builtin_amdgcn_readfirstlane(rec.x); PE_ISSUE(q, rec, UB8); }
        int jcur = (int)((er[0] >> 14) & 3u);
        v4u hcur = *(const LAS v4u*)(hql + (jcur * 64 + lane) * 4);
        v4u nrec = *(const LAS v4u*)(ents + 4 * PE_RD);
#pragma unroll 1
        for (int bi = 0; bi < nb; bi += PE_RD) {
#pragma unroll
            for (int q = 0; q < PE_RD; ++q) {
                PE_WAIT4(q, PE_VMW);
                PE_UBATCH(q, er[q]);
                er[q] = __builtin_amdgcn_readfirstlane(nrec.x);
                PE_ISSUE(q, nrec, UB8);
                nrec = *(const LAS v4u*)(ents + 4 * (bi + q + PE_RD + 1));
            }
        }
#pragma unroll
        for (int q = 0; q < PE_RD; ++q) PE_WAIT4(q, "vmcnt(0)");
    }
    LDS_WAIT(); asm volatile("" ::: "memory");
    {
        unsigned er[PE_RD];
#pragma unroll
        for (int q = 0; q < PE_RD; ++q) { const v4u rec = *(const LAS v4u*)(ents + 4 * q); er[q] = __builtin_amdgcn_readfirstlane(rec.x); PE_ISSUE(q, rec, VB8); }
        f32x2 cur[8];
#pragma unroll
        for (int i = 0; i < 8; ++i) cur[i] = (f32x2){0.f, 0.f};
        int jcur = (int)((er[0] >> 14) & 3u);
        v4u nrec = *(const LAS v4u*)(ents + 4 * PE_RD);
#pragma unroll 1
        for (int bi = 0; bi < nb; bi += PE_RD) {
#pragma unroll
            for (int q = 0; q < PE_RD; ++q) {
                PE_WAIT4(q, PE_VMW);
                PE_VBATCH(q, er[q]);
                er[q] = __builtin_amdgcn_readfirstlane(nrec.x);
                PE_ISSUE(q, nrec, VB8);
                nrec = *(const LAS v4u*)(ents + 4 * (bi + q + PE_RD + 1));
            }
        }
#pragma unroll
        for (int q = 0; q < PE_RD; ++q) PE_WAIT4(q, "vmcnt(0)");
        PE_FLUSH();
    }
#undef PE_UBATCH
#undef PE_VBATCH
#undef PE_FLUSH
#undef PE_WAIT4
#undef PE_ISSUE
#undef PE_LDO
#undef PE_UDOTS
#undef PE_VDOTS
    asm volatile("v_mbcnt_lo_u32_b32 %0, -1, 0\n\tv_mbcnt_hi_u32_b32 %0, -1, %0" : "=v"(lane)); asm volatile("" : "+s"(tbase));
#pragma unroll
    for (int j = 0; j < PE_NT; ++j) {
        const int t = tbase + j;
        float ss = 0.f; f32x4 xo[4];
        { const v4u* xrow = (const v4u*)((const bf16*)(ws + WS_XB) + (size_t)t * 1024 + 16 * lane); const v4u xa = xrow[0], xc = xrow[1];
          xo[0] = (f32x4){bflo(xa.x), bfhi(xa.x), bflo(xa.y), bfhi(xa.y)}; xo[1] = (f32x4){bflo(xa.z), bfhi(xa.z), bflo(xa.w), bfhi(xa.w)};
          xo[2] = (f32x4){bflo(xc.x), bfhi(xc.x), bflo(xc.y), bfhi(xc.y)}; xo[3] = (f32x4){bflo(xc.z), bfhi(xc.z), bflo(xc.w), bfhi(xc.w)}; }
#pragma unroll
        for (int i = 0; i < 4; ++i) { xo[i].x += acc[j][2 * i].x; xo[i].y += acc[j][2 * i].y; xo[i].z += acc[j][2 * i + 1].x; xo[i].w += acc[j][2 * i + 1].y;
            ss += (xo[i].x * xo[i].x + xo[i].y * xo[i].y) + (xo[i].z * xo[i].z + xo[i].w * xo[i].w); }
        const float rstd3 = rsqrtf(wave_sum(ss) * (1.0f / 1024.0f) + 1e-6f);
        float* orow = dstbase + (size_t)t * 1024 + 16 * lane;
#pragma unroll
        for (int i = 0; i < 4; ++i) { const f32x4 w = ((const f32x4*)(P.norm_final_w + 16 * lane))[i];
            ((f32x4*)orow)[i] = (f32x4){xo[i].x * rstd3 * w.x, xo[i].y * rstd3 * w.y, xo[i].z * rstd3 * w.z, xo[i].w * rstd3 * w.w}; }
    }
    LDS_WAIT(); asm volatile("s_waitcnt vmcnt(0)" ::: "memory");
}


#ifndef TWICE_MASK
#define TWICE_MASK 0
#endif
struct TwiceOrder { pg8::StaticOrder S; int per, reps;
    __device__ bool next(int i, pg8::Unit& u) const { if (i >= per * reps) return false; return S.next(i % per, u); }
    __device__ __forceinline__ void a_ready(const pg8::Unit&) const {} __device__ __forceinline__ void done(const pg8::Unit&) const {} };
template <class B> __device__ __forceinline__ bool rep_again(volatile LAS unsigned* MISC, B& bar) {
    __syncthreads(); const unsigned c = MISC[20]; __syncthreads();
    if (threadIdx.x == 0) MISC[20] = c ^ 1u;
    __syncthreads();
    if (c == 0u) { xcd_barrier(bar); return true; }
    return false;
}
__global__ void __launch_bounds__(NWAVES * 64, 2) hybrid_fwd(Params P) {
    extern __shared__ __attribute__((aligned(16))) unsigned char lds_raw[];
    LAS unsigned char* lds = (LAS unsigned char*)lds_raw;
    volatile LAS unsigned* MISC = (volatile LAS unsigned*)(lds + MISC_OFF);
    const int tid = threadIdx.x, lane = tid & 63, wave = __builtin_amdgcn_readfirstlane(tid >> 6);
    const int G = gridDim.x, bx = blockIdx.x;
    const int vcu = (G % 8 == 0) ? (bx % 8) * (G / 8) + bx / 8 : bx;
    unsigned char* ws = P.ws;
    for (int u = tid; u < 64; u += NWAVES * 64) MISC[u] = 0u;
    __syncthreads();
    XcdBarrier bar; bar.bar = (unsigned*)(ws + WS_CTL) + CW_BAR; bar.x = 0; bar.st = nullptr;
    if (!MK_PER_PHASE) bar = xcd_barrier_post((unsigned*)(ws + WS_CTL) + CW_BAR, MISC + 8);
    const int lo = P.ph_lo, hi = P.ph_hi;
#ifndef PHASE_MASK
#define PHASE_MASK 0xFFF
#endif
#define IN(k) (((PHASE_MASK >> (k)) & 1) && lo <= (k) && (k) < hi)
#define SEAM(k) do { if (IN(k) && IN((k) + 1)) xcd_barrier(bar); } while (0)
#ifndef REP_MASK
#define REP_MASK 0
#endif
#ifndef PE_EXP_MASK
#define PE_EXP_MASK 0x3fff
#endif
#define REPS(k) for (bool again_ = true; again_; again_ = (((REP_MASK >> (k)) & 1) ? rep_again(MISC, bar) : false))
    using namespace pg8;
    bf16* XB = (bf16*)(ws + WS_XB);

    if (IN(0)) REPS(0) { p0_prologue(P, lds, tid, lane, wave, vcu, G); }
    SEAM(0);
    if (IN(1)) REPS(1) {
        { Gemm gm{XB, (const bf16_t*)(ws + WS_WIN), T, 3072, 1024}; StaticOrder S; S.init(T, 3072, G, bx);
          EpiBf16Rs E{(bf16_t*)(ws + WS_QKV), 1536, 6, (bf16_t*)(ws + WS_XR), 512, (size_t)T * 512, nullptr, 1.0f};
          gemm_phase<EpiBf16Rs, StaticOrder, PG8_ALIGN, PG8_SP2>(lds, gm, S, E); }
    }
    SEAM(1);
    if (IN(3)) REPS(3) {
        if (bx < SCAN_WGS) gdn_scan(P, lds, bx, tid, lane, wave);
        else {
            const int wk = bx - SCAN_WGS, NWK = G - SCAN_WGS;
            unsigned* lcnt = (unsigned*)(ws + WS_CTL) + CW_LRUCNT;
            for (int q = wk; q < 1024; q += NWK) gdn_local_item(P, lds, (q & 7) * 128 + (q >> 3), tid);
            unsigned ndone = 0;
            for (int lt = wk; lt < 256; lt += NWK) { lru_local_item(P, lds, lt, tid, lane, wave); ++ndone; }
            asm volatile("s_waitcnt vmcnt(0)" ::: "memory");
            __syncthreads();
            if (tid == 0 && ndone) { __builtin_amdgcn_fence(__ATOMIC_RELEASE, "agent"); asm volatile("s_waitcnt vmcnt(0)" ::: "memory");
                                     __hip_atomic_fetch_add(lcnt, ndone, __ATOMIC_RELAXED, __HIP_MEMORY_SCOPE_AGENT); }
            if (wk < 16) {
                struct OneUnit { int pm, pn; __device__ bool next(int i, Unit& u) const { if (i > 0) return false; u.pm = pm; u.pn = pn; return true; }
                                 __device__ void a_ready(const Unit&) const {} __device__ void done(const Unit&) const {} };
                Gemm gm{(const bf16_t*)(ws + WS_MEMN), (const bf16_t*)(ws + WS_WKV), 512, 2048, 1024}; OneUnit S{wk >> 3, wk & 7};
                EpiKV E{(bf16_t*)(ws + WS_KB), (bf16_t*)(ws + WS_VTP)};
                gemm_phase<EpiKV, OneUnit, PG8_ALIGN, PG8_SP2>(lds, gm, S, E);
            }
            if (wk == 16 || wk == 17) {
                if (tid == 0) { unsigned sp = 0;
                    while (__hip_atomic_load(lcnt, __ATOMIC_RELAXED, __HIP_MEMORY_SCOPE_AGENT) < 256u) { __builtin_amdgcn_s_sleep(8); if (++sp > (1u << 22)) break; }
                    __builtin_amdgcn_fence(__ATOMIC_ACQUIRE, "agent"); asm volatile("s_waitcnt vmcnt(0)" ::: "memory"); }
                __syncthreads();
                lru_carry(P, (wk - 16) * NWAVES + wave, lane);
                asm volatile("s_waitcnt vmcnt(0)" ::: "memory");
                __syncthreads();
                if (tid == 0) { __builtin_amdgcn_fence(__ATOMIC_RELEASE, "agent"); asm volatile("s_waitcnt vmcnt(0)" ::: "memory");
                                __hip_atomic_fetch_add(lcnt + 64, 1u, __ATOMIC_RELAXED, __HIP_MEMORY_SCOPE_AGENT); }
            } else {
                const int w2 = (wk < 16 ? wk : wk - 2), N2 = NWK - 2;
                cvt_table_fp8(P.peer_v, ws + WS_VB, (float*)(ws + WS_VSC), w2 * NWAVES + wave, N2 * NWAVES, lane);
                late_weight_prep(P, lds, lane, wave, w2 * NWAVES + wave, N2 * NWAVES);
                if (tid == 0) { unsigned sp = 0;
                    while (__hip_atomic_load(lcnt + 64, __ATOMIC_RELAXED, __HIP_MEMORY_SCOPE_AGENT) < 2u) { __builtin_amdgcn_s_sleep(8); if (++sp > (1u << 22)) break; }
                    __builtin_amdgcn_fence(__ATOMIC_ACQUIRE, "agent"); asm volatile("s_waitcnt vmcnt(0)" ::: "memory"); }
                __syncthreads();
                lru_combine(P, (size_t)w2 * (NWAVES * 64) + tid, (size_t)N2 * (NWAVES * 64));
            }
        }
    }
    SEAM(3);
    if (IN(4)) REPS(4) {
        gdn_gate_norm(P, (size_t)bx * (NWAVES * 64) + tid, (size_t)G * (NWAVES * 64));
        cvt_table_fp8(P.peer_u, ws + WS_UB, (float*)(ws + WS_USC), bx * NWAVES + wave, G * NWAVES, lane);
    }
    SEAM(4);
    if (IN(5)) {
        Gemm gm{(const bf16_t*)((const unsigned char*)P.out + OUT_Y), (const bf16_t*)(ws + WS_WOUT), T, 1024, 1024}; StaticOrder S; S.init(T, 1024, G, bx);
        EpiResidBf<true> E{P.x, XB, (float*)(ws + WS_SSQ1)};
        gemm_phase<EpiResidBf<true>, StaticOrder, PG8_ALIGN, PG8_SP2>(lds, gm, S, E);
    }
    SEAM(5);
    if (IN(6)) REPS(6) {
        Gemm gm{XB, (const bf16_t*)(ws + WS_WQ), T, 1024, 1024};
        EpiBf16Rs E{(bf16_t*)(ws + WS_Q), 1024, 4, nullptr, 256, 0, (const float*)(ws + WS_SSQ1), 0.0625f};
#if (TWICE_MASK >> 6) & 1
        { TwiceOrder S; S.S.init(T, 1024, G, bx); S.per = 1; S.reps = 2;
          gemm_phase<EpiBf16Rs, TwiceOrder, PG8_ALIGN, PG8_SP2>(lds, gm, S, E); }
#else
        { StaticOrder S; S.init(T, 1024, G, bx);
          gemm_phase<EpiBf16Rs, StaticOrder, PG8_ALIGN, PG8_SP2>(lds, gm, S, E); }
#endif
        Unit u;
        { const int wgid = (bx & 7) * 32 + (bx >> 3); u.pm = (wgid >> 5) * 8 + (wgid & 7); u.pn = (wgid & 31) >> 3; }
        if (G == 256) {
            asm volatile("s_waitcnt vmcnt(0)" ::: "memory");
            __syncthreads();
            const int b = u.pm >> 5, qb0 = (u.pm & 31) * 2, h = u.pn;
#pragma unroll 1
            for (int qq = 0; qq < (((TWICE_MASK >> 7) & 1) ? 4 : 2); qq += XA_NPS) xattn_unit(P, lds, (b << 8) | ((qb0 + (qq & 1)) << 2) | h, tid, lane, wave);
        }
    }
    if (IN(7)) REPS(7) { }
    SEAM(7);
    if (IN(8)) {
        Gemm gm{(const bf16_t*)(ws + WS_AO), (const bf16_t*)(ws + WS_WO), T, 1024, 1024}; StaticOrder S; S.init(T, 1024, G, bx);
        EpiResidBf<false> E{nullptr, XB, (float*)(ws + WS_SSQ2)};
        gemm_phase<EpiResidBf<false>, StaticOrder, PG8_ALIGN, PG8_SP2>(lds, gm, S, E);
    }
    SEAM(8);
    if (IN(9)) REPS(9) {
        Gemm gm{XB, (const bf16_t*)(ws + WS_PWQ), T, 2048, 1024};
        EpiF16Rs E{(_Float16*)(ws + WS_PQ), 2048, (const float*)(ws + WS_SSQ2)};
#if (TWICE_MASK >> 9) & 1
        TwiceOrder S; S.S.init(T, 2048, G, bx); S.per = 2; S.reps = 2;
        gemm_phase<EpiF16Rs, TwiceOrder, PG8_ALIGN, PG8_SP2>(lds, gm, S, E);
#else
        StaticOrder S; S.init(T, 2048, G, bx);
        gemm_phase<EpiF16Rs, StaticOrder, PG8_ALIGN, PG8_SP2>(lds, gm, S, E);
#endif
    }
    SEAM(9);
    if (IN(10)) REPS(10) {
    }
    if (IN(11)) REPS(11) {
#if (TWICE_MASK >> 11) & 1
        for (int it = 0; it < 4; ++it) { const int tb = (bx * NWAVES + wave) * PE_NT + (it >> 1) * (G * NWAVES * PE_NT); if (tb < T) peer_pass(P, lds, tb, lane, wave, P.out, (it & 1) ? 0x3fff : PE_EXP_MASK); }
#else
#ifndef PE_PASS_BARRIER
#define PE_PASS_BARRIER 0
#endif
        for (int tb = (bx * NWAVES + wave) * PE_NT, np = 0; tb < T; tb += G * NWAVES * PE_NT, ++np) {
            if (PE_PASS_BARRIER && np > 0 && (T % (G * NWAVES * PE_NT)) == 0) xcd_barrier(bar);
            peer_pass(P, lds, tb, lane, wave, P.out);
        }
#endif
    }
#undef IN
#undef SEAM
}

extern "C" void kernel_launch(void* const* d_in, const int* in_sizes, int n_in, void* d_out, int out_size, void* d_ws, size_t ws_size, hipStream_t stream) {
    static int grid = 0;
    if (grid == 0) {
        if (n_in != 27 || in_sizes[0] != T * D || out_size != T * D || ws_size < WS_END) {
            fprintf(stderr, "kernel_launch: unexpected shapes (n_in %d, in0 %d, out %d, ws %zu); nothing launched\n", n_in, n_in > 0 ? in_sizes[0] : -1, out_size, ws_size); grid = -1; return; }
        int dev = 0, cus = 0, per_cu = 0;
        if (hipGetDevice(&dev) != hipSuccess || hipDeviceGetAttribute(&cus, hipDeviceAttributeMultiprocessorCount, dev) != hipSuccess) { grid = -1; return; }
        if (hipFuncSetAttribute((const void*)hybrid_fwd, hipFuncAttributeMaxDynamicSharedMemorySize, LDS_BYTES) != hipSuccess) { fprintf(stderr, "kernel_launch: hipFuncSetAttribute failed\n"); grid = -1; return; }
        if (hipOccupancyMaxActiveBlocksPerMultiprocessor(&per_cu, (const void*)hybrid_fwd, NWAVES * 64, LDS_BYTES) != hipSuccess || per_cu < 1)
            fprintf(stderr, "kernel_launch: note: occupancy query reports %d workgroups per CU\n", per_cu);
        (void)hipGetLastError();
        grid = cus;
        if (grid != 256) fprintf(stderr, "kernel_launch: %d CUs (built for 256)\n", grid);
    }
    if (grid < 0) return;
    if (hipMemsetAsync((char*)d_ws + WS_CTL, 0, CTL_ZERO_BYTES, stream) != hipSuccess) { fprintf(stderr, "kernel_launch: hipMemsetAsync failed\n"); return; }
    Params p{};
    const float** pp = (const float**)&p;
    for (int i = 0; i < 27; ++i) pp[i] = (const float*)d_in[i];
    p.out = (float*)d_out; p.ws = (unsigned char*)d_ws;
#if MK_PER_PHASE
    for (int k = 0; k < N_PHASES; ++k) { p.ph_lo = k; p.ph_hi = k + 1; hipLaunchKernelGGL(hybrid_fwd, dim3(grid), dim3(NWAVES * 64), LDS_BYTES, stream, p); }
#else
    p.ph_lo = 0; p.ph_hi = N_PHASES;
    hipLaunchKernelGGL(hybrid_fwd, dim3(grid), dim3(NWAVES * 64), LDS_BYTES, stream, p);
#endif
    const hipError_t le = hipPeekAtLastError();
    if (le != hipSuccess) fprintf(stderr, "kernel_launch: launch failed: %s\n", hipGetErrorName(le));
}
```
